# Optimizing an MI355X kernel written in HIP

```python
import jax, jax.numpy as jnp
from jax import lax
import numpy as np

D_MODEL = 2048
BATCH = 2
SEQ = 8192
DEPTH = 2

N_A_LAYERS = DEPTH // 2
N_B_LAYERS = DEPTH - N_A_LAYERS

HG_EXPAND = 128
HG_HEADS = D_MODEL // HG_EXPAND
HG_DK = HG_EXPAND
HG_DV = D_MODEL // HG_HEADS
HG_CHUNK = 64

ATT_HEADS = 16
ATT_HD = D_MODEL // ATT_HEADS
MOBA_BLOCK = 256
MOBA_TOPK = 3
MOBA_QCHUNK = 16
ROPE_THETA = 10000.0

PEER_HEADS = 8
PEER_NKEYS = 128
PEER_EXPERTS = PEER_NKEYS * PEER_NKEYS
PEER_DKEY = 256
PEER_TOPK = 16
PEER_CHUNK = 128

ALPHA = (2.0 * DEPTH) ** 0.25
BETA = (8.0 * DEPTH) ** -0.25

LN_EPS = 1e-5
RMS_EPS = 1e-6
NEG = -1e30
F32 = jnp.float32

kernel_name = 'hgrn2_moba_peer_yoco_deepnorm'


def layer_norm(x, g, b):
    xf = x.astype(F32)
    mu = xf.mean(-1, keepdims=True)
    var = jnp.square(xf - mu).mean(-1, keepdims=True)
    return ((xf - mu) * lax.rsqrt(var + LN_EPS) * g + b).astype(x.dtype)


def rotary(t, pos):
    half = t.shape[-1] // 2
    inv = ROPE_THETA ** (-jnp.arange(half, dtype=F32) / half)
    ang = pos.astype(F32)[:, None] * inv[None, :]
    cos = jnp.cos(ang).astype(t.dtype)
    sin = jnp.sin(ang).astype(t.dtype)
    t1, t2 = t[..., :half], t[..., half:]
    return jnp.concatenate([t1 * cos - t2 * sin, t1 * sin + t2 * cos], axis=-1)


def hgrn2_mixer(x, w_in, g_norm, w_out, lb):
    B, T, _ = x.shape
    H, dk, dv, C = HG_HEADS, HG_DK, HG_DV, HG_CHUNK
    nc = T // C
    q, fz, i, g = jnp.split(x @ w_in, 4, axis=-1)
    q = jax.nn.silu(q.astype(F32))
    f = lb + (1.0 - lb) * jax.nn.sigmoid(fz.astype(F32))
    logf = jnp.log(f)
    k = 1.0 - f

    def to_chunks(t, d):
        return t.reshape(B, nc, C, H, d).transpose(1, 0, 3, 2, 4)

    qc, kc, lc = to_chunks(q, dk), to_chunks(k, dk), to_chunks(logf, dk)
    ic = to_chunks(i.astype(F32), dv)
    causal = jnp.tril(jnp.ones((C, C), dtype=bool))

    def step(S, inp):
        qj, kj, ij, lj = inp
        b = jnp.cumsum(lj, axis=2)
        inter = jnp.einsum('bhtk,bhkv->bhtv', qj * jnp.exp(b), S)
        diff = b[:, :, :, None, :] - b[:, :, None, :, :]
        decay = jnp.where(causal[:, :, None], jnp.exp(jnp.minimum(diff, 0.0)), 0.0)
        scores = jnp.einsum('bhtk,bhsk,bhtsk->bhts', qj, kj, decay)
        intra = jnp.einsum('bhts,bhsv->bhtv', scores, ij)
        b_last = b[:, :, -1:, :]
        S = jnp.exp(b_last[:, :, 0, :, None]) * S + jnp.einsum(
            'bhsk,bhsv->bhkv', kj * jnp.exp(b_last - b), ij)
        return S, inter + intra

    S0 = jnp.zeros((B, H, dk, dv), F32)
    _, o = lax.scan(step, S0, (qc, kc, ic, lc))
    o = o.transpose(1, 0, 3, 2, 4).reshape(B, T, H, dv)
    o = o * lax.rsqrt(jnp.mean(o * o, axis=-1, keepdims=True) + RMS_EPS) * g_norm
    o = o * jax.nn.silu(g.astype(F32)).reshape(B, T, H, dv)
    return o.reshape(B, T, H * dv).astype(x.dtype) @ w_out


def shared_kv(x, w_kv):
    B, T, _ = x.shape
    H, hd, blk = ATT_HEADS, ATT_HD, MOBA_BLOCK
    nb = -(-T // blk)
    t_pad = nb * blk
    k, v = jnp.split(x @ w_kv, 2, axis=-1)
    k = k.reshape(B, T, H, hd).transpose(0, 2, 1, 3)
    v = v.reshape(B, T, H, hd).transpose(0, 2, 1, 3)
    k = rotary(k, jnp.arange(T))
    pad = ((0, 0), (0, 0), (0, t_pad - T), (0, 0))
    k_blk = jnp.pad(k, pad).reshape(B, H, nb, blk, hd)
    v_blk = jnp.pad(v, pad).reshape(B, H, nb, blk, hd)
    k_mean = k_blk.astype(F32).mean(axis=3)
    return k_blk, v_blk, k_mean


def moba_mixer(x, w_q, w_out, k_blk, v_blk, k_mean):
    B, T, _ = x.shape
    H, hd, blk, K, qcs = ATT_HEADS, ATT_HD, MOBA_BLOCK, MOBA_TOPK, MOBA_QCHUNK
    nb = k_blk.shape[2]
    nq = T // qcs
    pos = jnp.arange(T)
    q = (x @ w_q).reshape(B, T, H, hd).transpose(0, 2, 1, 3)
    q = rotary(q, pos)
    gate = jnp.einsum('bhtd,bhnd->bhtn', q.astype(F32), k_mean)
    past = jnp.arange(nb)[None, :] < (pos // blk)[:, None]
    gate = jnp.where(past, gate, NEG)
    if nb < K:
        gate = jnp.pad(gate, ((0, 0), (0, 0), (0, 0), (0, K - nb)), constant_values=NEG)
    top_val, top_idx = lax.top_k(gate, K)
    sel_ok = top_val > 0.5 * NEG
    top_idx = jnp.minimum(top_idx, nb - 1)

    def chunks(t):
        return jnp.moveaxis(t.reshape(B, H, nq, qcs, *t.shape[3:]), 2, 0)

    bi = jnp.arange(B)[:, None, None, None]
    hi = jnp.arange(H)[None, :, None, None]
    scale = hd ** -0.5

    def attend(args):
        c, qj, idx, ok = args
        start = c * qcs
        blk_id = start // blk
        k_sel = k_blk[bi, hi, idx]
        v_sel = v_blk[bi, hi, idx]
        s_sel = jnp.einsum('bhqd,bhqjkd->bhqjk', qj, k_sel).astype(F32) * scale
        s_sel = jnp.where(ok[..., None], s_sel, NEG)
        k_own = lax.dynamic_index_in_dim(k_blk, blk_id, axis=2, keepdims=False)
        v_own = lax.dynamic_index_in_dim(v_blk, blk_id, axis=2, keepdims=False)
        s_own = jnp.einsum('bhqd,bhkd->bhqk', qj, k_own).astype(F32) * scale
        q_pos = start + jnp.arange(qcs)
        k_pos = blk_id * blk + jnp.arange(blk)
        s_own = jnp.where(k_pos[None, :] <= q_pos[:, None], s_own, NEG)
        p = jax.nn.softmax(jnp.concatenate([s_sel.reshape(B, H, qcs, K * blk), s_own], axis=-1),
                           axis=-1).astype(qj.dtype)
        p_sel = p[..., :K * blk].reshape(B, H, qcs, K, blk)
        p_own = p[..., K * blk:]
        return (jnp.einsum('bhqjk,bhqjkd->bhqd', p_sel, v_sel)
                + jnp.einsum('bhqk,bhkd->bhqd', p_own, v_own))

    o = lax.map(attend, (jnp.arange(nq), chunks(q), chunks(top_idx), chunks(sel_ok)))
    o = jnp.moveaxis(o, 0, 2).reshape(B, H, T, hd).transpose(0, 2, 1, 3).reshape(B, T, H * hd)
    return o @ w_out


def peer_ffn(x, w_query, sub_keys, u, v):
    B, T, D = x.shape
    n = B * T
    xt = x.reshape(n, D)
    q = (xt @ w_query).reshape(n, PEER_HEADS, PEER_DKEY)
    half = PEER_DKEY // 2
    s1 = jnp.einsum('thd,hnd->thn', q[..., :half], sub_keys[0]).astype(F32)
    s2 = jnp.einsum('thd,hnd->thn', q[..., half:], sub_keys[1]).astype(F32)
    v1, i1 = lax.top_k(s1, PEER_TOPK)
    v2, i2 = lax.top_k(s2, PEER_TOPK)
    cand = (v1[..., :, None] + v2[..., None, :]).reshape(n, PEER_HEADS, PEER_TOPK * PEER_TOPK)
    best, flat = lax.top_k(cand, PEER_TOPK)
    expert = (jnp.take_along_axis(i1, flat // PEER_TOPK, axis=-1) * PEER_NKEYS
              + jnp.take_along_axis(i2, flat % PEER_TOPK, axis=-1))
    gate = jax.nn.softmax(best, axis=-1).astype(x.dtype)
    n_chunk = n // PEER_CHUNK
    kk = PEER_HEADS * PEER_TOPK

    def experts(args):
        xc, ec, gc = args
        hidden = jax.nn.gelu(jnp.einsum('td,tkd->tk', xc, u[ec]), approximate=False)
        return jnp.einsum('tk,tkd->td', gc * hidden, v[ec])

    y = lax.map(experts, (xt.reshape(n_chunk, PEER_CHUNK, D),
                          expert.reshape(n_chunk, PEER_CHUNK, kk),
                          gate.reshape(n_chunk, PEER_CHUNK, kk)))
    return y.reshape(B, T, D)


def setup_inputs(seed: int = 0) -> dict:
    key = jax.random.key(seed)
    ks = jax.random.split(key, 14)
    D = D_MODEL
    s = D ** -0.5
    hg_cols = jnp.concatenate([jnp.ones((2 * D,), F32), jnp.full((D,), BETA, F32), jnp.ones((D,), F32)])
    kv_cols = jnp.concatenate([jnp.ones((D,), F32), jnp.full((D,), BETA, F32)])
    return {
        'x': jax.random.normal(ks[0], (BATCH, SEQ, D), F32),
        'hg_w_in': jax.random.normal(ks[1], (N_A_LAYERS, D, 4 * D), F32) * s * hg_cols,
        'hg_norm_g': 1.0 + 0.02 * jax.random.normal(ks[2], (N_A_LAYERS, HG_DV), F32),
        'hg_w_out': jax.random.normal(ks[3], (N_A_LAYERS, D, D), F32) * s * BETA,
        'hg_lb_logits': 0.1 * jax.random.normal(ks[4], (N_A_LAYERS + 1, D), F32),
        'kv_w': jax.random.normal(ks[5], (D, 2 * D), F32) * s * kv_cols,
        'moba_w_q': jax.random.normal(ks[6], (N_B_LAYERS, D, D), F32) * s,
        'moba_w_out': jax.random.normal(ks[7], (N_B_LAYERS, D, D), F32) * s * BETA,
        'peer_w_query': jax.random.normal(ks[8], (DEPTH, D, PEER_HEADS * PEER_DKEY), F32) * s,
        'peer_sub_keys': jax.random.normal(ks[9], (DEPTH, 2, PEER_HEADS, PEER_NKEYS, PEER_DKEY // 2), F32)
                         * (PEER_DKEY // 2) ** -0.5,
        'peer_u': jax.random.normal(ks[10], (DEPTH, PEER_EXPERTS, D), F32) * s,
        'peer_v': jax.random.normal(ks[11], (DEPTH, PEER_EXPERTS, D), F32) * BETA,
        'ln_g': 1.0 + 0.02 * jax.random.normal(ks[12], (DEPTH, 2, D), F32),
        'ln_b': 0.02 * jax.random.normal(ks[13], (DEPTH, 2, D), F32),
    }


def reference(x, hg_w_in, hg_norm_g, hg_w_out, hg_lb_logits, kv_w, moba_w_q, moba_w_out,
              peer_w_query, peer_sub_keys, peer_u, peer_v, ln_g, ln_b):
    lower_bounds = jnp.cumsum(jax.nn.softmax(hg_lb_logits.astype(F32), axis=0), axis=0)
    kv = None
    for layer in range(DEPTH):
        if layer < N_A_LAYERS:
            a = layer
            mixed = hgrn2_mixer(x, hg_w_in[a], hg_norm_g[a], hg_w_out[a], lower_bounds[a])
        else:
            b = layer - N_A_LAYERS
            k_blk, v_blk, k_mean = kv
            mixed = moba_mixer(x, moba_w_q[b], moba_w_out[b], k_blk, v_blk, k_mean)
        x = layer_norm(ALPHA * x + mixed, ln_g[layer, 0], ln_b[layer, 0])
        ffn = peer_ffn(x, peer_w_query[layer], peer_sub_keys[layer], peer_u[layer], peer_v[layer])
        x = layer_norm(ALPHA * x + ffn, ln_g[layer, 1], ln_b[layer, 1])
        if layer == N_A_LAYERS - 1:
            kv = shared_kv(x, kv_w)
    return x
```

```cpp
#define ONE_LAUNCH 1
#include <hip/hip_runtime.h>
#include <hip/hip_cooperative_groups.h>
#include <cstdio>
namespace cg = cooperative_groups;

#ifndef ONE_LAUNCH
#define ONE_LAUNCH 0
#endif
#ifndef ENMASK
#define ENMASK 0xffffffffu
#endif
#define EN(k) ((ENMASK >> (k)) & 1u)

namespace pg8 {
#define PG8_LAS __attribute__((address_space(3)))
typedef unsigned short bf16_t;
typedef short bf16x8 __attribute__((ext_vector_type(8)));
typedef float f32x4 __attribute__((ext_vector_type(4)));
typedef unsigned u32x4 __attribute__((ext_vector_type(4)));
constexpr int BM = 256, BK = 64, HALF = 128, HTB = HALF * BK * 2  , STAGE_BYTES = 8 * HTB, NXCD = 8, WGM = 8;

__host__ __device__ __forceinline__ int lds_byte(int r, int c) { const int st = (r >> 4) * 2 + (c >> 5), rr = r & 15, cc = c & 31, ob = rr * 64 + cc * 2; return st * 1024 + (ob ^ (((ob >> 9) & 1) << 5)); }
__host__ __device__ __forceinline__ void stage_rc(int b, int& R, int& C) { const int st = b / 1024, sb = b % 1024, swz = sb ^ (((sb >> 9) & 1) << 5); R = (st >> 1) * 16 + swz / 64; C = (st & 1) * 32 + (swz % 64) / 2; }
__host__ __device__ __forceinline__ int perm32(int rho) { const int n = rho >> 4, i = rho & 15; return 8 * (i >> 2) + 4 * n + (i & 3); }

struct Unit { int pm, pn; };
struct Gemm { const bf16_t* A; const bf16_t* Bt; int M, N, K; };

struct StaticOrder {
    int nM, nN, nwg, G, c;
    __host__ __device__ void init(int M, int N, int G_, int c_) { nM = M / BM; nN = N / BM; nwg = nM * nN; G = G_; c = c_; }
    __host__ __device__ bool next(int i, Unit& u) const {
        const long L = (long)i * G + c; if (L >= nwg) return false;
        int wgid = (int)L; { const int q = nwg / NXCD, r = nwg % NXCD, xcd = wgid % NXCD, off = wgid / NXCD; wgid = (xcd < r ? xcd * (q + 1) : r * (q + 1) + (xcd - r) * q) + off; }
        const int nig = WGM * nN, gid = wgid / nig, fm = gid * WGM, gsz = (nM - fm) < WGM ? (nM - fm) : WGM;
        u.pm = fm + ((wgid % nig) % gsz); u.pn = (wgid % nig) / gsz; return true;
    }
    __device__ __forceinline__ void a_ready(const Unit&) const {}
    __device__ __forceinline__ void done(const Unit&) const {}
};
struct CountedOrder : StaticOrder {
    const unsigned* ready; unsigned need; unsigned* tmo;
    __device__ __forceinline__ void a_ready(const Unit& u) const {
        if (threadIdx.x < 64) {
            const unsigned long long t0 = __builtin_amdgcn_s_memrealtime(); unsigned polls = 0;
            while ((unsigned)__builtin_amdgcn_readfirstlane(__hip_atomic_load(ready + 64 * u.pm, __ATOMIC_RELAXED, __HIP_MEMORY_SCOPE_AGENT)) < need) {
                if ((++polls & 255u) == 0u && __builtin_amdgcn_readfirstlane(__hip_atomic_load(tmo, __ATOMIC_RELAXED, __HIP_MEMORY_SCOPE_AGENT)) != 0u) break;
                if (__builtin_amdgcn_s_memrealtime() - t0 > 2000000ull) {
                    if (threadIdx.x == 0) { unsigned expect = 0u; __hip_atomic_compare_exchange_strong(tmo + 1, &expect, 0x600u | (unsigned)(u.pm & 0xff), __ATOMIC_RELAXED, __ATOMIC_RELAXED, __HIP_MEMORY_SCOPE_AGENT); __hip_atomic_store(tmo, 1u, __ATOMIC_RELAXED, __HIP_MEMORY_SCOPE_AGENT); }
                    break; }
                __builtin_amdgcn_s_sleep(2); }
            __builtin_amdgcn_fence(__ATOMIC_ACQUIRE, "agent");
            asm volatile("s_waitcnt vmcnt(0)" ::: "memory");
        }
#if !defined(BROKEN_HOOK_NO_BARRIER)
        asm volatile("" ::: "memory"); __builtin_amdgcn_s_barrier(); asm volatile("" ::: "memory");
#endif
    }
};

__device__ __forceinline__ unsigned cvt_pk_bf16(float lo, float hi) { unsigned r; asm volatile("v_cvt_pk_bf16_f32 %0, %1, %2" : "=v"(r) : "v"(lo), "v"(hi)); return r; }
typedef float f32x2 __attribute__((ext_vector_type(2)));
__device__ __forceinline__ f32x2 gelu_pk(f32x2 v) {
    const f32x2 av = __builtin_elementwise_abs(v), d = av * 0.2316418882f + 1.0f;
    f32x2 t; t.x = __builtin_amdgcn_rcpf(d.x); t.y = __builtin_amdgcn_rcpf(d.y);
    f32x2 q = t * 0.5307027145f + (-0.7265760135f); q = q * t + 0.7107068705f; q = q * t + (-0.142248368f); q = q * t + 0.127414796f; q = q * t;
    const f32x2 s = (v * v) * (-0.72134752044f);
    f32x2 e; e.x = __builtin_amdgcn_exp2f(s.x); e.y = __builtin_amdgcn_exp2f(s.y);
    const f32x2 m = v * (q * e), r = v - m;
    f32x2 o; o.x = v.x < 0.f ? m.x : r.x; o.y = v.y < 0.f ? m.y : r.y; return o;
}

struct EpiF32 {
    static constexpr bool PERM = false, AFTER_DRAIN = false;
    float* C; int ldc; const float* bias;
    __device__ __forceinline__ void operator()(const f32x4 (&acc)[2][2][4][2], const Unit& u, int wr, int wc, int fr, int fq) const {
        const int row0 = u.pm * BM + wr * 64 + fr, col0 = u.pn * BM + wc * 32 + 4 * fq;
        f32x4 bv[2][2];
#pragma unroll
        for (int bj = 0; bj < 2; ++bj)
#pragma unroll
            for (int n = 0; n < 2; ++n) bv[bj][n] = bias ? *(const f32x4*)(bias + col0 + bj * HALF + n * 16) : (f32x4){0.f, 0.f, 0.f, 0.f};
#pragma unroll
        for (int ai = 0; ai < 2; ++ai)
#pragma unroll
            for (int m = 0; m < 4; ++m) { float* rowp = C + (size_t)(row0 + ai * HALF + m * 16) * ldc + col0;
#pragma unroll
                for (int bj = 0; bj < 2; ++bj)
#pragma unroll
                    for (int n = 0; n < 2; ++n) *(f32x4*)(rowp + bj * HALF + n * 16) = acc[ai][bj][m][n] + bv[bj][n]; }
    }
};
template <int ACT  > struct EpiBf16 {
    static constexpr bool PERM = true, AFTER_DRAIN = false;
    bf16_t* O; int ldc; const float* bias; int split_cols; size_t split_stride;
    __device__ __forceinline__ void operator()(const f32x4 (&acc)[2][2][4][2], const Unit& u, int wr, int wc, int fr, int fq) const {
        const int row0 = u.pm * BM + wr * 64 + fr; int colt = u.pn * BM; bf16_t* base = O;
        if (split_cols) { const int t = colt / split_cols; base += (size_t)t * split_stride; colt -= t * split_cols; }
        const int col0 = colt + wc * 32 + 8 * fq, bcol0 = u.pn * BM + wc * 32 + 8 * fq;
        f32x4 bv[2][2];
#pragma unroll
        for (int bj = 0; bj < 2; ++bj)
#pragma unroll
            for (int n = 0; n < 2; ++n) bv[bj][n] = bias ? *(const f32x4*)(bias + bcol0 + bj * HALF + 4 * n) : (f32x4){0.f, 0.f, 0.f, 0.f};
#pragma unroll
        for (int ai = 0; ai < 2; ++ai)
#pragma unroll
            for (int m = 0; m < 4; ++m) { bf16_t* rowp = base + (size_t)(row0 + ai * HALF + m * 16) * ldc + col0;
#pragma unroll
                for (int bj = 0; bj < 2; ++bj) { f32x4 v0 = acc[ai][bj][m][0] + bv[bj][0], v1 = acc[ai][bj][m][1] + bv[bj][1];
                    if (ACT == 1) { f32x2 a = gelu_pk((f32x2){v0[0], v0[1]}), b = gelu_pk((f32x2){v0[2], v0[3]}), c = gelu_pk((f32x2){v1[0], v1[1]}), d = gelu_pk((f32x2){v1[2], v1[3]});
                        v0 = (f32x4){a.x, a.y, b.x, b.y}; v1 = (f32x4){c.x, c.y, d.x, d.y}; }
                    if (ACT == 2) {
#pragma unroll
                        for (int j = 0; j < 4; ++j) { v0[j] = 0.5f * v0[j] * (1.0f + erff(v0[j] * 0.70710678f)); v1[j] = 0.5f * v1[j] * (1.0f + erff(v1[j] * 0.70710678f)); } }
                    u32x4 w; w.x = cvt_pk_bf16(v0[0], v0[1]); w.y = cvt_pk_bf16(v0[2], v0[3]); w.z = cvt_pk_bf16(v1[0], v1[1]); w.w = cvt_pk_bf16(v1[2], v1[3]);
                    *(u32x4*)(rowp + bj * HALF) = w; } }
    }
};

template <class Epi, class Sched, bool STAMP = false>
__device__ __forceinline__ void gemm_phase(PG8_LAS unsigned char* lds, const Gemm g, const Sched& S, const Epi& E, unsigned long long* stamps) {
    const int tid = threadIdx.x, wid = __builtin_amdgcn_readfirstlane(tid >> 6), lane = tid & 63, wr = wid >> 2, wc = wid & 3, fr = lane & 15, fq = lane >> 4;
    const int K = g.K, nt = K / BK;
    int ts_lo = 0, ts_hi = 0, nts = 0; const unsigned long long rt_entry = STAMP ? (unsigned long long)wall_clock64() : 0ull;
#define PG8_STAMP() do { if (STAMP && wid == 0 && nts < 64) { const unsigned long long _c = (unsigned long long)clock64(); \
        ts_lo = (lane == nts) ? (int)(unsigned)_c : ts_lo; ts_hi = (lane == nts) ? (int)(unsigned)(_c >> 32) : ts_hi; ++nts; } } while (0)
    PG8_STAMP();
    unsigned voffA[2], voffB[2];
#pragma unroll
    for (int i = 0; i < 2; ++i) { int R, C; stage_rc(tid * 16 + i * 8192, R, C); const int Rb = Epi::PERM ? ((R & ~31) + perm32(R & 31)) : R;
        voffA[i] = (unsigned)(R * K + C) * 2u; voffB[i] = (unsigned)(Rb * K + C) * 2u; }
    const size_t kstep = (size_t)(BK * 2);
    const size_t hstep = (size_t)HALF * K * 2;
    const size_t tstep = 2 * hstep;
    const unsigned ldsw = (unsigned)wid * 1024u;
    const int aoff = lds_byte(wr * 64 + fr, fq * 8), boff = lds_byte(wc * 32 + fr, fq * 8);
#define PG8_SA(b, h) (((b) * 2 + (h)) * HTB)
#define PG8_SB(b, h) ((4 + (b) * 2 + (h)) * HTB)
#define PG8_STAGE(bufoff, gbase, voff) do { _Pragma("unroll") for (int _i = 0; _i < 2; ++_i) \
        __builtin_amdgcn_global_load_lds((const unsigned*)((const char*)(gbase) + (voff)[_i]), (PG8_LAS unsigned*)(lds + (bufoff) + ldsw + _i * 8192), 16, 0, 0); } while (0)
#define PG8_LDA(dst, b, h) do { _Pragma("unroll") for (int m = 0; m < 4; ++m) _Pragma("unroll") for (int k = 0; k < 2; ++k) dst[m][k] = *(const PG8_LAS bf16x8*)(lds + PG8_SA(b, h) + aoff + m * 2048 + k * 1024); } while (0)
#define PG8_LDB(dst, b, h) do { _Pragma("unroll") for (int n = 0; n < 2; ++n) _Pragma("unroll") for (int k = 0; k < 2; ++k) dst[n][k] = *(const PG8_LAS bf16x8*)(lds + PG8_SB(b, h) + boff + n * 2048 + k * 1024); } while (0)
#define PG8_MMA(ai, bj, At, Bt) do { __builtin_amdgcn_s_setprio(1); _Pragma("unroll") for (int m = 0; m < 4; ++m) _Pragma("unroll") for (int n = 0; n < 2; ++n) _Pragma("unroll") for (int k = 0; k < 2; ++k) \
        acc[ai][bj][m][n] = __builtin_amdgcn_mfma_f32_16x16x32_bf16(Bt[n][k], At[m][k], acc[ai][bj][m][n], 0, 0, 0); __builtin_amdgcn_s_setprio(0); } while (0)
#define PG8_WAIT_V(n) asm volatile("s_waitcnt vmcnt(" #n ")" ::: "memory")
#define PG8_WAIT_L(n) asm volatile("s_waitcnt lgkmcnt(" #n ")" ::: "memory")
#define PG8_BAR __builtin_amdgcn_s_barrier()
#define PG8_SCHED __builtin_amdgcn_sched_barrier(0)
    Unit cur, nxt; int ui = 0;
    if (!S.next(0, cur)) return;
    f32x4 acc[2][2][4][2];
#pragma unroll
    for (int a = 0; a < 2; ++a)
#pragma unroll
        for (int b = 0; b < 2; ++b)
#pragma unroll
            for (int m = 0; m < 4; ++m)
#pragma unroll
                for (int n = 0; n < 2; ++n) acc[a][b][m][n] = (f32x4){0.f, 0.f, 0.f, 0.f};
    bf16x8 At[4][2], B0[2][2], B1[2][2];
    const char* cA = (const char*)g.A + (size_t)cur.pm * tstep; const char* cB = (const char*)g.Bt + (size_t)cur.pn * tstep;
    S.a_ready(cur);
    PG8_STAGE(PG8_SB(0, 0), cB, voffB); PG8_STAGE(PG8_SA(0, 0), cA, voffA); PG8_STAGE(PG8_SB(0, 1), cB + hstep, voffB); PG8_STAGE(PG8_SA(0, 1), cA + hstep, voffA);
    if (wr == 1) PG8_BAR;
    PG8_WAIT_V(4); PG8_BAR;
    PG8_STAGE(PG8_SB(1, 0), cB + kstep, voffB); PG8_STAGE(PG8_SA(1, 0), cA + kstep, voffA); PG8_STAGE(PG8_SB(1, 1), cB + hstep + kstep, voffB);
    PG8_WAIT_V(6); PG8_BAR;
    PG8_STAMP();
    for (;;) {
        const bool has_next = S.next(ui + 1, nxt);
        const char* nA = has_next ? (const char*)g.A + (size_t)nxt.pm * tstep : cA; const char* nB = has_next ? (const char*)g.Bt + (size_t)nxt.pn * tstep : cB;
        for (int t = 0; t < nt; t += 2) {
            const bool last = (t == nt - 2);
            const char* a1 = cA + (size_t)(t + 1) * kstep;
            const char* a2 = last ? nA : cA + (size_t)(t + 2) * kstep; const char* b2 = last ? nB : cB + (size_t)(t + 2) * kstep;
            const char* a3 = a2 + kstep; const char* b3 = b2 + kstep;
            if (last && has_next) S.a_ready(nxt);
            PG8_LDB(B0, 0, 0); PG8_SCHED; PG8_LDA(At, 0, 0); PG8_STAGE(PG8_SA(1, 1), a1 + hstep, voffA);
            PG8_WAIT_L(8); PG8_BAR; PG8_WAIT_L(0); PG8_MMA(0, 0, At, B0); PG8_BAR; PG8_SCHED;
            PG8_LDB(B1, 0, 1); PG8_STAGE(PG8_SB(0, 0), b2, voffB);
            PG8_BAR; PG8_WAIT_L(0); PG8_MMA(0, 1, At, B1); PG8_BAR;
            PG8_LDA(At, 0, 1); PG8_STAGE(PG8_SA(0, 0), a2, voffA);
            PG8_BAR; PG8_WAIT_L(0); PG8_MMA(1, 0, At, B0); PG8_BAR; PG8_SCHED;
            PG8_STAGE(PG8_SB(0, 1), b2 + hstep, voffB);
            PG8_WAIT_V(6); PG8_BAR; PG8_MMA(1, 1, At, B1); PG8_BAR;
            PG8_LDB(B0, 1, 0); PG8_SCHED; PG8_LDA(At, 1, 0); PG8_STAGE(PG8_SA(0, 1), a2 + hstep, voffA);
            PG8_WAIT_L(8); PG8_BAR; PG8_WAIT_L(0); PG8_MMA(0, 0, At, B0); PG8_BAR; PG8_SCHED;
            PG8_LDB(B1, 1, 1); PG8_STAGE(PG8_SB(1, 0), b3, voffB);
            PG8_BAR; PG8_WAIT_L(0); PG8_MMA(0, 1, At, B1); PG8_BAR;
            PG8_LDA(At, 1, 1); PG8_STAGE(PG8_SA(1, 0), a3, voffA);
            PG8_BAR; PG8_WAIT_L(0); PG8_MMA(1, 0, At, B0); PG8_BAR; PG8_SCHED;
            PG8_STAGE(PG8_SB(1, 1), b3 + hstep, voffB);
            PG8_WAIT_V(6); PG8_BAR; PG8_MMA(1, 1, At, B1); PG8_BAR;
        }
        PG8_STAMP();
        if constexpr (!Epi::AFTER_DRAIN) { E(acc, cur, wr, wc, fr, fq); S.done(cur); }
        PG8_STAMP();
        if (!has_next) break;
#pragma unroll
        for (int a = 0; a < 2; ++a)
#pragma unroll
            for (int b = 0; b < 2; ++b)
#pragma unroll
                for (int m = 0; m < 4; ++m)
#pragma unroll
                    for (int n = 0; n < 2; ++n) acc[a][b][m][n] = (f32x4){0.f, 0.f, 0.f, 0.f};
        cur = nxt; cA = nA; cB = nB; ++ui;
    }
    PG8_WAIT_V(0);
    if (wr == 0) PG8_BAR;
    PG8_BAR;
    if constexpr (Epi::AFTER_DRAIN) { E.fused(acc, cur, wr, wc, fr, fq, lds, wid, lane); S.done(cur); }
    PG8_STAMP();
    if (STAMP && wid == 0) { stamps[lane] = lane < nts ? (((unsigned long long)(unsigned)ts_hi << 32) | (unsigned)ts_lo) : 0ull;
        if (lane == 62) stamps[62] = rt_entry; if (lane == 63) stamps[63] = (unsigned long long)wall_clock64(); }
#undef PG8_STAMP
#undef PG8_SA
#undef PG8_SB
#undef PG8_STAGE
#undef PG8_LDA
#undef PG8_LDB
#undef PG8_MMA
#undef PG8_WAIT_V
#undef PG8_WAIT_L
#undef PG8_BAR
#undef PG8_SCHED
}
}


#define LAS __attribute__((address_space(3)))
typedef unsigned short bf16_t;
typedef float f32x4 __attribute__((ext_vector_type(4)));
typedef unsigned u32x4 __attribute__((ext_vector_type(4)));
typedef unsigned u32x2 __attribute__((ext_vector_type(2)));

constexpr int MTOK = 16384, DM = 2048, SEQ = 8192, NHEAD = 16;
constexpr float ALPHA = 1.41421356237309515f;
constexpr size_t MiB = (size_t)1 << 20;
constexpr size_t WS_WIN = 0, WS_WOUT = 32 * MiB, WS_WKVQ = 40 * MiB, WS_WO = 64 * MiB, WS_WC = 72 * MiB, WS_UB = 88 * MiB, WS_VB = 216 * MiB, WS_SLOT = 344 * MiB;
constexpr size_t WS_EID = 920 * MiB, WS_GATE = 928 * MiB, WS_COS = 936 * MiB, WS_SIN = 938 * MiB, WS_KMEAN = 940 * MiB, WS_LB = 941 * MiB, WS_END = 942 * MiB;
__host__ __device__ constexpr size_t slot(int i) { return WS_SLOT + (size_t)i * 64 * MiB; }
constexpr int LDS_BYTES = 144 * 1024;
constexpr int NPH = 17;

struct Args { const float* in[14]; float* out; unsigned char* ws; int ph_lo, ph_hi; };

__device__ __forceinline__ float bflo(unsigned w) { return __uint_as_float(w << 16); }
__device__ __forceinline__ float bfhi(unsigned w) { return __uint_as_float(w & 0xffff0000u); }
__device__ __forceinline__ float bf2f(bf16_t b) { return __uint_as_float(((unsigned)b) << 16); }
__device__ __forceinline__ unsigned pk_bf16(float lo, float hi) { unsigned r; asm volatile("v_cvt_pk_bf16_f32 %0, %1, %2" : "=v"(r) : "v"(lo), "v"(hi)); return r; }
__device__ __forceinline__ float wave_sum(float v) {
#pragma unroll
    for (int o = 32; o >= 1; o >>= 1) v += __shfl_xor(v, o);
    return v;
}
__device__ __forceinline__ float wave_max(float v) {
#pragma unroll
    for (int o = 32; o >= 1; o >>= 1) v = fmaxf(v, __shfl_xor(v, o));
    return v;
}
__device__ __forceinline__ float sigmoidf_(float z) { return 1.0f / (1.0f + __expf(-z)); }

struct EpiIn {
    static constexpr bool PERM = true, AFTER_DRAIN = false;
    bf16_t* Q1; float* LF; bf16_t* I1; bf16_t* G1; const float* LB;
    __device__ __forceinline__ void operator()(const pg8::f32x4 (&acc)[2][2][4][2], const pg8::Unit& u, int wr, int wc, int fr, int fq) const {
        const int type = u.pn >> 3;
        const int row0 = u.pm * 256 + wr * 64 + fr, col0 = (u.pn & 7) * 256 + wc * 32 + 8 * fq;
        if (type == 1) {
#pragma unroll
            for (int bj = 0; bj < 2; ++bj) {
                const int c = col0 + bj * 128;
                const f32x4 lb0 = *(const f32x4*)(LB + c), lb1 = *(const f32x4*)(LB + c + 4);
#pragma unroll
                for (int ai = 0; ai < 2; ++ai)
#pragma unroll
                    for (int m = 0; m < 4; ++m) {
                        float* p = LF + (size_t)(row0 + ai * 128 + m * 16) * DM + c;
                        f32x4 o0, o1;
#pragma unroll
                        for (int j = 0; j < 4; ++j) {
                            o0[j] = __logf(lb0[j] + (1.0f - lb0[j]) * sigmoidf_(acc[ai][bj][m][0][j]));
                            o1[j] = __logf(lb1[j] + (1.0f - lb1[j]) * sigmoidf_(acc[ai][bj][m][1][j]));
                        }
                        *(f32x4*)p = o0; *(f32x4*)(p + 4) = o1;
                    }
            }
        } else {
            bf16_t* dst = Q1 + (size_t)(type - (type > 0 ? 1 : 0)) * ((size_t)32 << 20);
            const bool act = (type != 2);
#pragma unroll
            for (int ai = 0; ai < 2; ++ai)
#pragma unroll
                for (int m = 0; m < 4; ++m)
#pragma unroll
                    for (int bj = 0; bj < 2; ++bj) {
                        f32x4 v0 = acc[ai][bj][m][0], v1 = acc[ai][bj][m][1];
                        if (act) {
#pragma unroll
                            for (int j = 0; j < 4; ++j) { v0[j] = v0[j] * sigmoidf_(v0[j]); v1[j] = v1[j] * sigmoidf_(v1[j]); }
                        }
                        u32x4 w; w.x = pk_bf16(v0[0], v0[1]); w.y = pk_bf16(v0[2], v0[3]); w.z = pk_bf16(v1[0], v1[1]); w.w = pk_bf16(v1[2], v1[3]);
                        *(u32x4*)(dst + (size_t)(row0 + ai * 128 + m * 16) * DM + col0 + bj * 128) = w;
                    }
        }
    }
};
struct EpiRes {
    static constexpr bool PERM = false, AFTER_DRAIN = false;
    const float* res; float* Y;
    __device__ __forceinline__ void operator()(const pg8::f32x4 (&acc)[2][2][4][2], const pg8::Unit& u, int wr, int wc, int fr, int fq) const {
        const int row0 = u.pm * 256 + wr * 64 + fr, col0 = u.pn * 256 + wc * 32 + 4 * fq;
#pragma unroll
        for (int ai = 0; ai < 2; ++ai)
#pragma unroll
            for (int m = 0; m < 4; ++m) {
                const size_t off = (size_t)(row0 + ai * 128 + m * 16) * DM + col0;
#pragma unroll
                for (int bj = 0; bj < 2; ++bj)
#pragma unroll
                    for (int n = 0; n < 2; ++n) {
                        const f32x4 r = *(const f32x4*)(res + off + bj * 128 + n * 16);
                        *(f32x4*)(Y + off + bj * 128 + n * 16) = r * ALPHA + acc[ai][bj][m][n];
                    }
            }
    }
};
struct EpiF32 {
    static constexpr bool PERM = false, AFTER_DRAIN = false;
    float* C;
    __device__ __forceinline__ void operator()(const pg8::f32x4 (&acc)[2][2][4][2], const pg8::Unit& u, int wr, int wc, int fr, int fq) const {
        const int row0 = u.pm * 256 + wr * 64 + fr, col0 = u.pn * 256 + wc * 32 + 4 * fq;
#pragma unroll
        for (int ai = 0; ai < 2; ++ai)
#pragma unroll
            for (int m = 0; m < 4; ++m) {
                float* p = C + (size_t)(row0 + ai * 128 + m * 16) * DM + col0;
#pragma unroll
                for (int bj = 0; bj < 2; ++bj)
#pragma unroll
                    for (int n = 0; n < 2; ++n) *(f32x4*)(p + bj * 128 + n * 16) = acc[ai][bj][m][n];
            }
    }
};
struct EpiKVQ {
    static constexpr bool PERM = true, AFTER_DRAIN = false;
    bf16_t* K; bf16_t* V; bf16_t* Q;
    __device__ __forceinline__ void operator()(const pg8::f32x4 (&acc)[2][2][4][2], const pg8::Unit& u, int wr, int wc, int fr, int fq) const {
        const int t = u.pn >> 3;
        bf16_t* dst = K + (size_t)t * ((size_t)32 << 20);
        const int row0 = u.pm * 256 + wr * 64 + fr, col0 = (u.pn & 7) * 256 + wc * 32 + 8 * fq;
#pragma unroll
        for (int ai = 0; ai < 2; ++ai)
#pragma unroll
            for (int m = 0; m < 4; ++m)
#pragma unroll
                for (int bj = 0; bj < 2; ++bj) {
                    const f32x4 v0 = acc[ai][bj][m][0], v1 = acc[ai][bj][m][1];
                    u32x4 w; w.x = pk_bf16(v0[0], v0[1]); w.y = pk_bf16(v0[2], v0[3]); w.z = pk_bf16(v1[0], v1[1]); w.w = pk_bf16(v1[2], v1[3]);
                    *(u32x4*)(dst + (size_t)(row0 + ai * 128 + m * 16) * DM + col0 + bj * 128) = w;
                }
    }
};

__device__ __forceinline__ void transpose_tiles(LAS float* tile, const float* src, int ldn, int K, int N, bf16_t* dst) {
    const int tid = threadIdx.x;
    const int tn = N / 64, ntiles = tn * (K / 64);
    for (int tI = blockIdx.x; tI < ntiles; tI += gridDim.x) {
        const int k0 = (tI / tn) * 64, n0 = (tI % tn) * 64;
#pragma unroll
        for (int r = 0; r < 2; ++r) {
            const int kk = (tid >> 4) + 32 * r, nn = (tid & 15) * 4;
            const f32x4 v = *(const f32x4*)(src + (size_t)(k0 + kk) * ldn + n0 + nn);
            tile[kk * 65 + nn + 0] = v[0]; tile[kk * 65 + nn + 1] = v[1]; tile[kk * 65 + nn + 2] = v[2]; tile[kk * 65 + nn + 3] = v[3];
        }
        __syncthreads();
        {
            const int nn = tid >> 3, kk8 = (tid & 7) * 8;
            float f[8];
#pragma unroll
            for (int j = 0; j < 8; ++j) f[j] = tile[(kk8 + j) * 65 + nn];
            u32x4 w; w.x = pk_bf16(f[0], f[1]); w.y = pk_bf16(f[2], f[3]); w.z = pk_bf16(f[4], f[5]); w.w = pk_bf16(f[6], f[7]);
            *(u32x4*)(dst + (size_t)(n0 + nn) * K + k0 + kk8) = w;
        }
        __syncthreads();
    }
}
__device__ __forceinline__ void convert_bf16(const float* src, bf16_t* dst, size_t n) {
    const size_t stride = (size_t)gridDim.x * 512 * 8;
    for (size_t i = ((size_t)blockIdx.x * 512 + threadIdx.x) * 8; i < n; i += stride) {
        const f32x4 a = *(const f32x4*)(src + i), b = *(const f32x4*)(src + i + 4);
        u32x4 w; w.x = pk_bf16(a[0], a[1]); w.y = pk_bf16(a[2], a[3]); w.z = pk_bf16(b[0], b[1]); w.w = pk_bf16(b[2], b[3]);
        *(u32x4*)(dst + i) = w;
    }
}
__device__ __forceinline__ void fold_peer_keys(LAS float* lds, const float* w_query, const float* sub_keys, bf16_t* WcT) {
    const int tid = threadIdx.x;
    LAS float* Ss = lds;
    LAS float* Ws = lds + 128 * 132;
    for (int item = blockIdx.x; item < 1024; item += gridDim.x) {
        const int l = item >> 9, rem = item & 511, hh = rem >> 5, kb = rem & 31, h = hh >> 1, half = hh & 1;
        const float* sk = sub_keys + (size_t)(((l * 2 + half) * 8 + h) * 128) * 128;
        const float* wq = w_query + (size_t)l * DM * DM + (size_t)(kb * 64) * DM + h * 256 + half * 128;
#pragma unroll
        for (int r = 0; r < 8; ++r) { const int idx = tid + 512 * r, key = idx >> 5, d4 = (idx & 31) * 4; *(LAS f32x4*)(Ss + key * 132 + d4) = *(const f32x4*)(sk + key * 128 + d4); }
#pragma unroll
        for (int r = 0; r < 4; ++r) { const int idx = tid + 512 * r, kin = idx >> 5, d4 = (idx & 31) * 4; *(LAS f32x4*)(Ws + kin * 128 + d4) = *(const f32x4*)(wq + (size_t)kin * DM + d4); }
        __syncthreads();
        const int key = tid & 127, kq = tid >> 7;
        float acc[16];
#pragma unroll
        for (int j = 0; j < 16; ++j) acc[j] = 0.f;
        for (int d4 = 0; d4 < 32; ++d4) {
            const f32x4 s4 = *(const LAS f32x4*)(Ss + key * 132 + d4 * 4);
#pragma unroll
            for (int j = 0; j < 16; ++j) { const f32x4 w4 = *(const LAS f32x4*)(Ws + (kq * 16 + j) * 128 + d4 * 4); acc[j] += s4[0] * w4[0] + s4[1] * w4[1] + s4[2] * w4[2] + s4[3] * w4[3]; }
        }
        bf16_t* o = WcT + (size_t)l * DM * DM + (size_t)(h * 256 + half * 128 + key) * DM + kb * 64 + kq * 16;
        u32x4 w0, w1;
        w0.x = pk_bf16(acc[0], acc[1]); w0.y = pk_bf16(acc[2], acc[3]); w0.z = pk_bf16(acc[4], acc[5]); w0.w = pk_bf16(acc[6], acc[7]);
        w1.x = pk_bf16(acc[8], acc[9]); w1.y = pk_bf16(acc[10], acc[11]); w1.z = pk_bf16(acc[12], acc[13]); w1.w = pk_bf16(acc[14], acc[15]);
        *(u32x4*)o = w0; *(u32x4*)(o + 8) = w1;
        __syncthreads();
    }
}
__device__ __forceinline__ void phase_prep(const Args& a, LAS unsigned char* lds) {
    unsigned char* ws = a.ws;
    LAS float* tile = (LAS float*)lds;
    transpose_tiles(tile, a.in[1], 4 * DM, DM, 4 * DM, (bf16_t*)(ws + WS_WIN));
    transpose_tiles(tile, a.in[3], DM, DM, DM, (bf16_t*)(ws + WS_WOUT));
    transpose_tiles(tile, a.in[5], 2 * DM, DM, 2 * DM, (bf16_t*)(ws + WS_WKVQ));
    transpose_tiles(tile, a.in[6], DM, DM, DM, (bf16_t*)(ws + WS_WKVQ) + (size_t)2 * DM * DM);
    transpose_tiles(tile, a.in[7], DM, DM, DM, (bf16_t*)(ws + WS_WO));
    fold_peer_keys((LAS float*)lds, a.in[8], a.in[9], (bf16_t*)(ws + WS_WC));
    convert_bf16(a.in[0], (bf16_t*)(ws + slot(0)), (size_t)MTOK * DM);
    convert_bf16(a.in[10], (bf16_t*)(ws + WS_UB), (size_t)2 * 16384 * DM);
    convert_bf16(a.in[11], (bf16_t*)(ws + WS_VB), (size_t)2 * 16384 * DM);
    const int gtid = blockIdx.x * 512 + threadIdx.x, gthreads = gridDim.x * 512;
    float* COS = (float*)(ws + WS_COS); float* SIN = (float*)(ws + WS_SIN); float* LB = (float*)(ws + WS_LB);
    for (int i = gtid; i < SEQ * 64; i += gthreads) {
        const int pos = i >> 6, j = i & 63;
        double inv = 1.0; const double r = 0.86596432336006535;
        for (int q = 0; q < j; ++q) inv *= r;
        const float ang = (float)pos * (float)inv;
        const double x = (double)ang;
        const double n = __builtin_rint(x * 0.15915494309189535);
        const float rf = (float)__builtin_fma(-n, 6.283185307179586, x);
        COS[i] = cosf(rf); SIN[i] = sinf(rf);
    }
    for (int c = gtid; c < DM; c += gthreads) { const float l0 = a.in[4][c], l1 = a.in[4][DM + c]; LB[c] = 1.0f / (1.0f + expf(l1 - l0)); }
}

__device__ __forceinline__ void phase_scan_naive(const bf16_t* Q1, const float* LF, const bf16_t* I1, float* O) {
    const int lane = threadIdx.x & 63, gw = blockIdx.x * 8 + (threadIdx.x >> 6), nw = gridDim.x * 8;
    for (int item = gw; item < 2 * NHEAD * 128; item += nw) {
        const int bh = item >> 7, v = item & 127, b = bh >> 4, h = bh & 15;
        const size_t base = (size_t)b * SEQ * DM + h * 128;
        float S0 = 0.f, S1 = 0.f;
#pragma unroll 4
        for (int t = 0; t < SEQ; ++t) {
            const size_t ro = base + (size_t)t * DM;
            const float f0 = __expf(LF[ro + lane]), f1 = __expf(LF[ro + 64 + lane]);
            const float q0 = bf2f(Q1[ro + lane]), q1 = bf2f(Q1[ro + 64 + lane]);
            const float iv = bf2f(I1[ro + v]);
            S0 = f0 * S0 + (1.0f - f0) * iv; S1 = f1 * S1 + (1.0f - f1) * iv;
            const float p = wave_sum(q0 * S0 + q1 * S1);
            if (lane == 0) O[ro + v] = p;
        }
    }
}
__device__ __forceinline__ void phase_onorm(const float* O, const bf16_t* G1, const float* gnorm, bf16_t* OG) {
    const int lane = threadIdx.x & 63, gw = blockIdx.x * 8 + (threadIdx.x >> 6), nw = gridDim.x * 8;
    const float gn0 = gnorm[2 * lane], gn1 = gnorm[2 * lane + 1];
    for (int item = gw; item < MTOK * NHEAD; item += nw) {
        const size_t off = (size_t)item * 128 + 2 * lane;
        const float o0 = O[off], o1 = O[off + 1];
        const float ss = wave_sum(o0 * o0 + o1 * o1);
        const float r = rsqrtf(ss * (1.0f / 128.0f) + 1e-6f);
        const unsigned g = *(const unsigned*)(G1 + off);
        *(unsigned*)(OG + off) = pk_bf16(o0 * r * gn0 * bflo(g), o1 * r * gn1 * bfhi(g));
    }
}

__device__ __forceinline__ void ln_row_store(float (&v)[32], const float* g, const float* bta, float* outf, bf16_t* outb, int lane) {
    float s = 0.f;
#pragma unroll
    for (int i = 0; i < 32; ++i) s += v[i];
    const float mu = wave_sum(s) * (1.0f / DM);
    float q = 0.f;
#pragma unroll
    for (int i = 0; i < 32; ++i) { v[i] -= mu; q += v[i] * v[i]; }
    const float rstd = rsqrtf(wave_sum(q) * (1.0f / DM) + 1e-5f);
#pragma unroll
    for (int i = 0; i < 4; ++i) {
        const int c = 512 * i + 8 * lane;
        const f32x4 g0 = *(const f32x4*)(g + c), g1 = *(const f32x4*)(g + c + 4), b0 = *(const f32x4*)(bta + c), b1 = *(const f32x4*)(bta + c + 4);
        f32x4 o0, o1;
#pragma unroll
        for (int j = 0; j < 4; ++j) { o0[j] = v[i * 8 + j] * rstd * g0[j] + b0[j]; o1[j] = v[i * 8 + 4 + j] * rstd * g1[j] + b1[j]; }
        *(f32x4*)(outf + c) = o0; *(f32x4*)(outf + c + 4) = o1;
        if (outb) { u32x4 w; w.x = pk_bf16(o0[0], o0[1]); w.y = pk_bf16(o0[2], o0[3]); w.z = pk_bf16(o1[0], o1[1]); w.w = pk_bf16(o1[2], o1[3]); *(u32x4*)(outb + c) = w; }
    }
}
__device__ __forceinline__ void phase_ln(const float* Y, const float* g, const float* bta, float* outf, bf16_t* outb) {
    const int lane = threadIdx.x & 63, gw = blockIdx.x * 8 + (threadIdx.x >> 6), nw = gridDim.x * 8;
    for (int row = gw; row < MTOK; row += nw) {
        float v[32];
        const float* p = Y + (size_t)row * DM;
#pragma unroll
        for (int i = 0; i < 4; ++i) {
            const f32x4 a = *(const f32x4*)(p + 512 * i + 8 * lane), b = *(const f32x4*)(p + 512 * i + 8 * lane + 4);
#pragma unroll
            for (int j = 0; j < 4; ++j) { v[i * 8 + j] = a[j]; v[i * 8 + 4 + j] = b[j]; }
        }
        ln_row_store(v, g, bta, outf + (size_t)row * DM, outb ? outb + (size_t)row * DM : nullptr, lane);
    }
}

__device__ __forceinline__ void wave_argmax(float& v, int& idx) {
#pragma unroll
    for (int o = 32; o >= 1; o >>= 1) {
        const float ov = __shfl_xor(v, o); const int oi = __shfl_xor(idx, o);
        if (ov > v || (ov == v && oi < idx)) { v = ov; idx = oi; }
    }
}
__device__ __forceinline__ void phase_topk(const float* SC, int* EID, float* GATE) {
    const int lane = threadIdx.x & 63, gw = blockIdx.x * 8 + (threadIdx.x >> 6), nw = gridDim.x * 8;
    const float NINF = -__builtin_inff();
    for (int item = gw; item < MTOK * 8; item += nw) {
        const float* p = SC + (size_t)item * 256;
        float a0 = p[lane], a1 = p[64 + lane], b0 = p[128 + lane], b1 = p[192 + lane];
        float v1 = NINF, v2 = NINF; int i1 = 0, i2 = 0;
        for (int r = 0; r < 16; ++r) {
            float va = a0 >= a1 ? a0 : a1; int ia = a0 >= a1 ? lane : lane + 64;
            float vb = b0 >= b1 ? b0 : b1; int ib = b0 >= b1 ? lane : lane + 64;
            wave_argmax(va, ia); wave_argmax(vb, ib);
            if (lane == r) { v1 = va; i1 = ia; v2 = vb; i2 = ib; }
            if (ia == lane) a0 = NINF; if (ia == lane + 64) a1 = NINF;
            if (ib == lane) b0 = NINF; if (ib == lane + 64) b1 = NINF;
        }
        const float vb_ = __shfl(v2, lane & 15);
        float c0 = __shfl(v1, (lane >> 4)) + vb_, c1 = __shfl(v1, (lane >> 4) + 4) + vb_, c2 = __shfl(v1, (lane >> 4) + 8) + vb_, c3 = __shfl(v1, (lane >> 4) + 12) + vb_;
        float best = NINF; int flat = 0; float bmax = 0.f;
        for (int r = 0; r < 16; ++r) {
            float v = c0; int id = lane;
            if (c1 > v) { v = c1; id = lane + 64; }
            if (c2 > v) { v = c2; id = lane + 128; }
            if (c3 > v) { v = c3; id = lane + 192; }
            wave_argmax(v, id);
            if (r == 0) bmax = v;
            if (lane == r) { best = v; flat = id; }
            if ((id & 63) == lane) { const int c = id >> 6; if (c == 0) c0 = NINF; else if (c == 1) c1 = NINF; else if (c == 2) c2 = NINF; else c3 = NINF; }
        }
        const float e = lane < 16 ? __expf(best - bmax) : 0.f;
        const float sum = wave_sum(e);
        const int ea = __shfl(i1, flat >> 4), eb = __shfl(i2, flat & 15);
        if (lane < 16) { EID[(size_t)item * 16 + lane] = ea * 128 + eb; GATE[(size_t)item * 16 + lane] = e / sum; }
    }
}

__device__ __forceinline__ float gelu_erf(float x) { return 0.5f * x * (1.0f + erff(x * 0.70710678118654752f)); }
__device__ __forceinline__ void phase_peer(const float* X, const int* EID, const float* GATE, const bf16_t* U, const bf16_t* V, const float* g, const float* bta, float* outf, bf16_t* outb) {
    const int lane = threadIdx.x & 63, gw = blockIdx.x * 8 + (threadIdx.x >> 6), nw = gridDim.x * 8;
    for (int tok = gw; tok < MTOK; tok += nw) {
        float x[32];
        const float* xp = X + (size_t)tok * DM;
#pragma unroll
        for (int i = 0; i < 4; ++i) {
            const f32x4 a = *(const f32x4*)(xp + 512 * i + 8 * lane), b = *(const f32x4*)(xp + 512 * i + 8 * lane + 4);
#pragma unroll
            for (int j = 0; j < 4; ++j) { x[i * 8 + j] = a[j]; x[i * 8 + 4 + j] = b[j]; }
        }
        const int e0 = EID[(size_t)tok * 128 + lane], e1 = EID[(size_t)tok * 128 + 64 + lane];
        const float g0 = GATE[(size_t)tok * 128 + lane], g1 = GATE[(size_t)tok * 128 + 64 + lane];
        float h0 = 0.f, h1 = 0.f;
#pragma unroll 4
        for (int e = 0; e < 128; ++e) {
            const int idx = __builtin_amdgcn_readfirstlane(__shfl(e < 64 ? e0 : e1, e & 63));
            const u32x4* up = (const u32x4*)(U + (size_t)idx * DM) + lane;
            float d = 0.f;
#pragma unroll
            for (int i = 0; i < 4; ++i) {
                const u32x4 w = up[i * 64];
                d += x[i * 8 + 0] * bflo(w.x) + x[i * 8 + 1] * bfhi(w.x) + x[i * 8 + 2] * bflo(w.y) + x[i * 8 + 3] * bfhi(w.y)
                   + x[i * 8 + 4] * bflo(w.z) + x[i * 8 + 5] * bfhi(w.z) + x[i * 8 + 6] * bflo(w.w) + x[i * 8 + 7] * bfhi(w.w);
            }
            d = wave_sum(d);
            if (e < 64) { if (lane == e) h0 = d; } else { if (lane == e - 64) h1 = d; }
        }
        const float w0 = g0 * gelu_erf(h0), w1 = g1 * gelu_erf(h1);
        float y[32];
#pragma unroll
        for (int i = 0; i < 32; ++i) y[i] = 0.f;
#pragma unroll 4
        for (int e = 0; e < 128; ++e) {
            const int idx = __builtin_amdgcn_readfirstlane(__shfl(e < 64 ? e0 : e1, e & 63));
            const float wt = __shfl(e < 64 ? w0 : w1, e & 63);
            const u32x4* vp = (const u32x4*)(V + (size_t)idx * DM) + lane;
#pragma unroll
            for (int i = 0; i < 4; ++i) {
                const u32x4 w = vp[i * 64];
                y[i * 8 + 0] += wt * bflo(w.x); y[i * 8 + 1] += wt * bfhi(w.x); y[i * 8 + 2] += wt * bflo(w.y); y[i * 8 + 3] += wt * bfhi(w.y);
                y[i * 8 + 4] += wt * bflo(w.z); y[i * 8 + 5] += wt * bfhi(w.z); y[i * 8 + 6] += wt * bflo(w.w); y[i * 8 + 7] += wt * bfhi(w.w);
            }
        }
#pragma unroll
        for (int i = 0; i < 32; ++i) y[i] += ALPHA * x[i];
        ln_row_store(y, g, bta, outf + (size_t)tok * DM, outb ? outb + (size_t)tok * DM : nullptr, lane);
    }
}

__device__ __forceinline__ void phase_rot(LAS float* red, bf16_t* KR, bf16_t* QR, const float* COS, const float* SIN, float* KMEAN) {
    const int tid = threadIdx.x, d = tid & 63, rg = tid >> 6;
    for (int item = blockIdx.x; item < 2 * NHEAD * 32; item += gridDim.x) {
        const int bh = item >> 5, j = item & 31, b = bh >> 4, h = bh & 15;
        float s1 = 0.f, s2 = 0.f;
        for (int i = 0; i < 32; ++i) {
            const int pos = j * 256 + rg * 32 + i;
            const size_t off = ((size_t)b * SEQ + pos) * DM + h * 128 + d;
            const float c = COS[pos * 64 + d], s = SIN[pos * 64 + d];
            const float k1 = bf2f(KR[off]), k2 = bf2f(KR[off + 64]);
            const float o1 = k1 * c - k2 * s, o2 = k1 * s + k2 * c;
            s1 += o1; s2 += o2;
            KR[off] = (bf16_t)(pk_bf16(o1, 0.f) & 0xffffu); KR[off + 64] = (bf16_t)(pk_bf16(o2, 0.f) & 0xffffu);
            const float q1 = bf2f(QR[off]), q2 = bf2f(QR[off + 64]);
            QR[off] = (bf16_t)(pk_bf16(q1 * c - q2 * s, 0.f) & 0xffffu); QR[off + 64] = (bf16_t)(pk_bf16(q1 * s + q2 * c, 0.f) & 0xffffu);
        }
        red[rg * 128 + d] = s1; red[rg * 128 + 64 + d] = s2;
        __syncthreads();
        if (tid < 128) {
            float s = 0.f;
#pragma unroll
            for (int r = 0; r < 8; ++r) s += red[r * 128 + tid];
            KMEAN[(size_t)item * 128 + tid] = s * (1.0f / 256.0f);
        }
        __syncthreads();
    }
}

__device__ __forceinline__ void phase_attn_naive(LAS float* lds, const bf16_t* QR, const bf16_t* KR, const bf16_t* V, const float* KMEAN, bf16_t* AO) {
    const int lane = threadIdx.x & 63, wv = threadIdx.x >> 6, gw = blockIdx.x * 8 + wv, nw = gridDim.x * 8;
    LAS float* qs = lds + wv * (128 + 1024);
    LAS float* ps = qs + 128;
    const float NEG = -1e30f, scale = 0.08838834764831845f;
    for (int item = gw; item < 2 * NHEAD * SEQ; item += nw) {
        const int bh = item >> 13, t = item & (SEQ - 1), b = bh >> 4, h = bh & 15, blk = t >> 8;
        const size_t tok = (size_t)b * SEQ + t;
        {
            const unsigned q2 = *(const unsigned*)(QR + tok * DM + h * 128 + 2 * lane);
            qs[2 * lane] = bflo(q2); qs[2 * lane + 1] = bfhi(q2);
        }
        asm volatile("s_waitcnt lgkmcnt(0)" ::: "memory");
        float gsc = NEG;
        if (lane < blk) {
            const float* km = KMEAN + ((size_t)bh * 32 + lane) * 128;
            float s = 0.f;
            for (int d4 = 0; d4 < 32; ++d4) { const f32x4 kv = *(const f32x4*)(km + d4 * 4); const f32x4 qv = *(const LAS f32x4*)(qs + d4 * 4); s += kv[0] * qv[0] + kv[1] * qv[1] + kv[2] * qv[2] + kv[3] * qv[3]; }
            gsc = s;
        }
        int sel[4];
#pragma unroll
        for (int r = 0; r < 3; ++r) {
            float v = gsc; int id = lane;
            wave_argmax(v, id);
            sel[r] = (v > 0.5f * NEG) ? id : -1;
            if (lane == id) gsc = -3e38f;
        }
        sel[3] = blk;
        float sc[4][4];
#pragma unroll
        for (int s = 0; s < 4; ++s) {
            const int jb = __builtin_amdgcn_readfirstlane(sel[s]);
#pragma unroll
            for (int i = 0; i < 4; ++i) sc[s][i] = NEG;
            if (jb >= 0) {
                float accs[4] = {0.f, 0.f, 0.f, 0.f};
                const bf16_t* kb = KR + ((size_t)b * SEQ + jb * 256 + lane) * DM + h * 128;
                for (int dc = 0; dc < 16; ++dc) {
                    const f32x4 qa = *(const LAS f32x4*)(qs + dc * 8), qb = *(const LAS f32x4*)(qs + dc * 8 + 4);
#pragma unroll
                    for (int i = 0; i < 4; ++i) {
                        const u32x4 w = *(const u32x4*)(kb + (size_t)(64 * i) * DM + dc * 8);
                        accs[i] += qa[0] * bflo(w.x) + qa[1] * bfhi(w.x) + qa[2] * bflo(w.y) + qa[3] * bfhi(w.y) + qb[0] * bflo(w.z) + qb[1] * bfhi(w.z) + qb[2] * bflo(w.w) + qb[3] * bfhi(w.w);
                    }
                }
#pragma unroll
                for (int i = 0; i < 4; ++i) { const int kpos = jb * 256 + lane + 64 * i; sc[s][i] = (s < 3 || kpos <= t) ? accs[i] * scale : NEG; }
            }
        }
        float m = NEG;
#pragma unroll
        for (int s = 0; s < 4; ++s)
#pragma unroll
            for (int i = 0; i < 4; ++i) m = fmaxf(m, sc[s][i]);
        m = wave_max(m);
        float sum = 0.f;
#pragma unroll
        for (int s = 0; s < 4; ++s)
#pragma unroll
            for (int i = 0; i < 4; ++i) { const float p = sc[s][i] > 0.5f * NEG ? __expf(sc[s][i] - m) : 0.f; sc[s][i] = p; sum += p; }
        sum = wave_sum(sum);
        const float rs = 1.0f / sum;
#pragma unroll
        for (int s = 0; s < 4; ++s)
#pragma unroll
            for (int i = 0; i < 4; ++i) ps[s * 256 + lane + 64 * i] = sc[s][i] * rs;
        asm volatile("s_waitcnt lgkmcnt(0)" ::: "memory");
        float o0 = 0.f, o1 = 0.f;
#pragma unroll
        for (int s = 0; s < 4; ++s) {
            const int jb = __builtin_amdgcn_readfirstlane(sel[s]);
            if (jb >= 0) {
                const bf16_t* vb = V + ((size_t)b * SEQ + jb * 256) * DM + h * 128 + 2 * lane;
                const int nk = (s == 3) ? ((t & 255) + 1) : 256;
                for (int k = 0; k < nk; ++k) {
                    const float p = ps[s * 256 + k];
                    const unsigned w = *(const unsigned*)(vb + (size_t)k * DM);
                    o0 += p * bflo(w); o1 += p * bfhi(w);
                }
            }
        }
        *(unsigned*)(AO + tok * DM + h * 128 + 2 * lane) = pk_bf16(o0, o1);
        asm volatile("s_waitcnt lgkmcnt(0)" ::: "memory");
    }
}

__device__ __forceinline__ int opaque(int v) { asm volatile("" : "+s"(v)); return v; }
template <bool L1> __device__ __forceinline__ void run_gemm_out(const Args& a, LAS unsigned char* lds) {
    unsigned char* ws = a.ws;
    pg8::Gemm g{(const bf16_t*)(ws + (L1 ? slot(8) : slot(0))), (const bf16_t*)(ws + (L1 ? WS_WO : WS_WOUT)), opaque(MTOK), opaque(DM), opaque(DM)};
    pg8::StaticOrder S; S.init(g.M, g.N, (int)gridDim.x, (int)blockIdx.x);
    EpiRes E{L1 ? (const float*)(ws + slot(0)) : a.in[0], (float*)(ws + (L1 ? slot(3) : slot(1)))};
    pg8::gemm_phase<EpiRes, pg8::StaticOrder>(lds, g, S, E, nullptr);
}
template <bool L1> __device__ __forceinline__ void run_ln(const Args& a) {
    unsigned char* ws = a.ws;
    phase_ln((const float*)(ws + (L1 ? slot(3) : slot(1))), a.in[12] + (L1 ? 2 : 0) * DM, a.in[13] + (L1 ? 2 : 0) * DM,
             (float*)(ws + (L1 ? slot(5) : slot(3))), (bf16_t*)(ws + (L1 ? slot(7) : slot(5))));
}
template <bool L1> __device__ __forceinline__ void run_gemm_sc(const Args& a, LAS unsigned char* lds) {
    unsigned char* ws = a.ws;
    pg8::Gemm g{(const bf16_t*)(ws + (L1 ? slot(7) : slot(5))), (const bf16_t*)(ws + WS_WC) + (L1 ? (size_t)DM * DM : 0), opaque(MTOK), opaque(DM), opaque(DM)};
    pg8::StaticOrder S; S.init(g.M, g.N, (int)gridDim.x, (int)blockIdx.x);
    EpiF32 E{(float*)(ws + (L1 ? slot(0) : slot(6)))};
    pg8::gemm_phase<EpiF32, pg8::StaticOrder>(lds, g, S, E, nullptr);
}
template <bool L1> __device__ __forceinline__ void run_topk(const Args& a) {
    unsigned char* ws = a.ws;
    phase_topk((const float*)(ws + (L1 ? slot(0) : slot(6))), (int*)(ws + WS_EID), (float*)(ws + WS_GATE));
}
template <bool L1> __device__ __forceinline__ void run_peer(const Args& a) {
    unsigned char* ws = a.ws;
    phase_peer((const float*)(ws + (L1 ? slot(5) : slot(3))), (const int*)(ws + WS_EID), (const float*)(ws + WS_GATE),
               (const bf16_t*)(ws + WS_UB) + (L1 ? (size_t)16384 * DM : 0), (const bf16_t*)(ws + WS_VB) + (L1 ? (size_t)16384 * DM : 0),
               a.in[12] + (L1 ? 3 : 1) * DM, a.in[13] + (L1 ? 3 : 1) * DM,
               L1 ? a.out : (float*)(ws + slot(0)), L1 ? (bf16_t*)nullptr : (bf16_t*)(ws + slot(2)));
}

__global__ void __launch_bounds__(512, 2) mk_fwd(Args a) {
    extern __shared__ __attribute__((aligned(16))) unsigned char lds_raw[];
    LAS unsigned char* lds = (LAS unsigned char*)lds_raw;
    cg::grid_group grid = cg::this_grid();
    unsigned char* ws = a.ws;
#define PHASE_BEGIN(k) if (a.ph_lo <= (k) && (k) < a.ph_hi && EN(k)) {
#define PHASE_END(k) __syncthreads(); if ((k) + 1 < a.ph_hi) grid.sync(); }
    PHASE_BEGIN(0) phase_prep(a, lds); PHASE_END(0)
    PHASE_BEGIN(1) {
        pg8::Gemm g{(const bf16_t*)(ws + slot(0)), (const bf16_t*)(ws + WS_WIN), opaque(MTOK), opaque(4 * DM), opaque(DM)};
        pg8::StaticOrder S; S.init(g.M, g.N, (int)gridDim.x, (int)blockIdx.x);
        EpiIn E{(bf16_t*)(ws + slot(1)), (float*)(ws + slot(4)), (bf16_t*)(ws + slot(2)), (bf16_t*)(ws + slot(3)), (const float*)(ws + WS_LB)};
        pg8::gemm_phase<EpiIn, pg8::StaticOrder>(lds, g, S, E, nullptr);
    } PHASE_END(1)
    PHASE_BEGIN(2) phase_scan_naive((const bf16_t*)(ws + slot(1)), (const float*)(ws + slot(4)), (const bf16_t*)(ws + slot(2)), (float*)(ws + slot(6))); PHASE_END(2)
    PHASE_BEGIN(3) phase_onorm((const float*)(ws + slot(6)), (const bf16_t*)(ws + slot(3)), a.in[2], (bf16_t*)(ws + slot(0))); PHASE_END(3)
    PHASE_BEGIN(4) run_gemm_out<false>(a, lds); PHASE_END(4)
    PHASE_BEGIN(5) run_ln<false>(a); PHASE_END(5)
    PHASE_BEGIN(6) run_gemm_sc<false>(a, lds); PHASE_END(6)
    PHASE_BEGIN(7) run_topk<false>(a); PHASE_END(7)
    PHASE_BEGIN(8) run_peer<false>(a); PHASE_END(8)
    PHASE_BEGIN(9) {
        pg8::Gemm g{(const bf16_t*)(ws + slot(2)), (const bf16_t*)(ws + WS_WKVQ), opaque(MTOK), opaque(3 * DM), opaque(DM)};
        pg8::StaticOrder S; S.init(g.M, g.N, (int)gridDim.x, (int)blockIdx.x);
        EpiKVQ E{(bf16_t*)(ws + slot(5)), (bf16_t*)(ws + slot(6)), (bf16_t*)(ws + slot(7))};
        pg8::gemm_phase<EpiKVQ, pg8::StaticOrder>(lds, g, S, E, nullptr);
    } PHASE_END(9)
    PHASE_BEGIN(10) phase_rot((LAS float*)lds, (bf16_t*)(ws + slot(5)), (bf16_t*)(ws + slot(7)), (const float*)(ws + WS_COS), (const float*)(ws + WS_SIN), (float*)(ws + WS_KMEAN)); PHASE_END(10)
    PHASE_BEGIN(11) phase_attn_naive((LAS float*)lds, (const bf16_t*)(ws + slot(7)), (const bf16_t*)(ws + slot(5)), (const bf16_t*)(ws + slot(6)), (const float*)(ws + WS_KMEAN), (bf16_t*)(ws + slot(8))); PHASE_END(11)
    PHASE_BEGIN(12) run_gemm_out<true>(a, lds); PHASE_END(12)
    PHASE_BEGIN(13) run_ln<true>(a); PHASE_END(13)
    PHASE_BEGIN(14) run_gemm_sc<true>(a, lds); PHASE_END(14)
    PHASE_BEGIN(15) run_topk<true>(a); PHASE_END(15)
    PHASE_BEGIN(16) run_peer<true>(a); PHASE_END(16)
}

extern "C" void kernel_launch(void* const* d_in, const int* in_sizes, int n_in, void* d_out, int out_size, void* d_ws, size_t ws_size, hipStream_t stream) {
    static int grid = 0;
    if (grid == 0) {
        if (n_in != 14 || out_size != MTOK * DM || ws_size < WS_END) { fprintf(stderr, "kernel_launch: unexpected shapes (n_in %d, out %d, ws %zu)\n", n_in, out_size, ws_size); grid = -1; return; }
        int dev = 0, cus = 0, per_cu = 0;
        if (hipGetDevice(&dev) != hipSuccess || hipDeviceGetAttribute(&cus, hipDeviceAttributeMultiprocessorCount, dev) != hipSuccess) { grid = -1; return; }
        if (hipFuncSetAttribute((const void*)mk_fwd, hipFuncAttributeMaxDynamicSharedMemorySize, LDS_BYTES) != hipSuccess) { fprintf(stderr, "kernel_launch: hipFuncSetAttribute failed\n"); grid = -1; return; }
        if (hipOccupancyMaxActiveBlocksPerMultiprocessor(&per_cu, (const void*)mk_fwd, 512, LDS_BYTES) != hipSuccess || per_cu < 1) { fprintf(stderr, "kernel_launch: occupancy query failed (%d)\n", per_cu); (void)hipGetLastError(); per_cu = 1; }
        grid = cus * (per_cu > 1 ? 1 : per_cu);
    }
    if (grid < 0) return;
    Args a{};
    for (int i = 0; i < 14; ++i) a.in[i] = (const float*)d_in[i];
    a.out = (float*)d_out; a.ws = (unsigned char*)d_ws;
#if ONE_LAUNCH
    a.ph_lo = 0; a.ph_hi = NPH;
    void* args[] = {&a};
    hipError_t e = hipLaunchCooperativeKernel((const void*)mk_fwd, dim3(grid), dim3(512), args, LDS_BYTES, stream);
    if (e != hipSuccess) fprintf(stderr, "cooperative launch failed: %s (grid %d)\n", hipGetErrorString(e), grid);
#else
    for (int ph = 0; ph < NPH; ++ph) {
        a.ph_lo = ph; a.ph_hi = ph + 1;
        hipLaunchKernelGGL(mk_fwd, dim3(grid), dim3(512), LDS_BYTES, stream, a);
    }
#endif
}
```

```cpp
#define ONE_LAUNCH 1
#include <hip/hip_runtime.h>
#include <hip/hip_cooperative_groups.h>
#include <cstdio>
namespace cg = cooperative_groups;

#ifndef ONE_LAUNCH
#define ONE_LAUNCH 0
#endif
#ifndef ENMASK
#define ENMASK 0xffffffffu
#endif
#define EN(k) ((ENMASK >> (k)) & 1u)

namespace pg8 {
#define PG8_LAS __attribute__((address_space(3)))
typedef unsigned short bf16_t;
typedef short bf16x8 __attribute__((ext_vector_type(8)));
typedef float f32x4 __attribute__((ext_vector_type(4)));
typedef unsigned u32x4 __attribute__((ext_vector_type(4)));
constexpr int BM = 256, BK = 64, HALF = 128, HTB = HALF * BK * 2  , STAGE_BYTES = 8 * HTB, NXCD = 8, WGM = 8;

__host__ __device__ __forceinline__ int lds_byte(int r, int c) { const int st = (r >> 4) * 2 + (c >> 5), rr = r & 15, cc = c & 31, ob = rr * 64 + cc * 2; return st * 1024 + (ob ^ (((ob >> 9) & 1) << 5)); }
__host__ __device__ __forceinline__ void stage_rc(int b, int& R, int& C) { const int st = b / 1024, sb = b % 1024, swz = sb ^ (((sb >> 9) & 1) << 5); R = (st >> 1) * 16 + swz / 64; C = (st & 1) * 32 + (swz % 64) / 2; }
__host__ __device__ __forceinline__ int perm32(int rho) { const int n = rho >> 4, i = rho & 15; return 8 * (i >> 2) + 4 * n + (i & 3); }

struct Unit { int pm, pn; };
struct Gemm { const bf16_t* A; const bf16_t* Bt; int M, N, K; };

struct StaticOrder {
    int nM, nN, nwg, G, c;
    __host__ __device__ void init(int M, int N, int G_, int c_) { nM = M / BM; nN = N / BM; nwg = nM * nN; G = G_; c = c_; }
    __host__ __device__ bool next(int i, Unit& u) const {
        const long L = (long)i * G + c; if (L >= nwg) return false;
        int wgid = (int)L; { const int q = nwg / NXCD, r = nwg % NXCD, xcd = wgid % NXCD, off = wgid / NXCD; wgid = (xcd < r ? xcd * (q + 1) : r * (q + 1) + (xcd - r) * q) + off; }
        const int nig = WGM * nN, gid = wgid / nig, fm = gid * WGM, gsz = (nM - fm) < WGM ? (nM - fm) : WGM;
        u.pm = fm + ((wgid % nig) % gsz); u.pn = (wgid % nig) / gsz; return true;
    }
    __device__ __forceinline__ void a_ready(const Unit&) const {}
    __device__ __forceinline__ void done(const Unit&) const {}
};
struct CountedOrder : StaticOrder {
    const unsigned* ready; unsigned need; unsigned* tmo;
    __device__ __forceinline__ void a_ready(const Unit& u) const {
        if (threadIdx.x < 64) {
            const unsigned long long t0 = __builtin_amdgcn_s_memrealtime(); unsigned polls = 0;
            while ((unsigned)__builtin_amdgcn_readfirstlane(__hip_atomic_load(ready + 64 * u.pm, __ATOMIC_RELAXED, __HIP_MEMORY_SCOPE_AGENT)) < need) {
                if ((++polls & 255u) == 0u && __builtin_amdgcn_readfirstlane(__hip_atomic_load(tmo, __ATOMIC_RELAXED, __HIP_MEMORY_SCOPE_AGENT)) != 0u) break;
                if (__builtin_amdgcn_s_memrealtime() - t0 > 2000000ull) {
                    if (threadIdx.x == 0) { unsigned expect = 0u; __hip_atomic_compare_exchange_strong(tmo + 1, &expect, 0x600u | (unsigned)(u.pm & 0xff), __ATOMIC_RELAXED, __ATOMIC_RELAXED, __HIP_MEMORY_SCOPE_AGENT); __hip_atomic_store(tmo, 1u, __ATOMIC_RELAXED, __HIP_MEMORY_SCOPE_AGENT); }
                    break; }
                __builtin_amdgcn_s_sleep(2); }
            __builtin_amdgcn_fence(__ATOMIC_ACQUIRE, "agent");
            asm volatile("s_waitcnt vmcnt(0)" ::: "memory");
        }
#if !defined(BROKEN_HOOK_NO_BARRIER)
        asm volatile("" ::: "memory"); __builtin_amdgcn_s_barrier(); asm volatile("" ::: "memory");
#endif
    }
};

__device__ __forceinline__ unsigned cvt_pk_bf16(float lo, float hi) { unsigned r; asm volatile("v_cvt_pk_bf16_f32 %0, %1, %2" : "=v"(r) : "v"(lo), "v"(hi)); return r; }
typedef float f32x2 __attribute__((ext_vector_type(2)));
__device__ __forceinline__ f32x2 gelu_pk(f32x2 v) {
    const f32x2 av = __builtin_elementwise_abs(v), d = av * 0.2316418882f + 1.0f;
    f32x2 t; t.x = __builtin_amdgcn_rcpf(d.x); t.y = __builtin_amdgcn_rcpf(d.y);
    f32x2 q = t * 0.5307027145f + (-0.7265760135f); q = q * t + 0.7107068705f; q = q * t + (-0.142248368f); q = q * t + 0.127414796f; q = q * t;
    const f32x2 s = (v * v) * (-0.72134752044f);
    f32x2 e; e.x = __builtin_amdgcn_exp2f(s.x); e.y = __builtin_amdgcn_exp2f(s.y);
    const f32x2 m = v * (q * e), r = v - m;
    f32x2 o; o.x = v.x < 0.f ? m.x : r.x; o.y = v.y < 0.f ? m.y : r.y; return o;
}

struct EpiF32 {
    static constexpr bool PERM = false, AFTER_DRAIN = false;
    float* C; int ldc; const float* bias;
    __device__ __forceinline__ void operator()(const f32x4 (&acc)[2][2][4][2], const Unit& u, int wr, int wc, int fr, int fq) const {
        const int row0 = u.pm * BM + wr * 64 + fr, col0 = u.pn * BM + wc * 32 + 4 * fq;
        f32x4 bv[2][2];
#pragma unroll
        for (int bj = 0; bj < 2; ++bj)
#pragma unroll
            for (int n = 0; n < 2; ++n) bv[bj][n] = bias ? *(const f32x4*)(bias + col0 + bj * HALF + n * 16) : (f32x4){0.f, 0.f, 0.f, 0.f};
#pragma unroll
        for (int ai = 0; ai < 2; ++ai)
#pragma unroll
            for (int m = 0; m < 4; ++m) { float* rowp = C + (size_t)(row0 + ai * HALF + m * 16) * ldc + col0;
#pragma unroll
                for (int bj = 0; bj < 2; ++bj)
#pragma unroll
                    for (int n = 0; n < 2; ++n) *(f32x4*)(rowp + bj * HALF + n * 16) = acc[ai][bj][m][n] + bv[bj][n]; }
    }
};
template <int ACT  > struct EpiBf16 {
    static constexpr bool PERM = true, AFTER_DRAIN = false;
    bf16_t* O; int ldc; const float* bias; int split_cols; size_t split_stride;
    __device__ __forceinline__ void operator()(const f32x4 (&acc)[2][2][4][2], const Unit& u, int wr, int wc, int fr, int fq) const {
        const int row0 = u.pm * BM + wr * 64 + fr; int colt = u.pn * BM; bf16_t* base = O;
        if (split_cols) { const int t = colt / split_cols; base += (size_t)t * split_stride; colt -= t * split_cols; }
        const int col0 = colt + wc * 32 + 8 * fq, bcol0 = u.pn * BM + wc * 32 + 8 * fq;
        f32x4 bv[2][2];
#pragma unroll
        for (int bj = 0; bj < 2; ++bj)
#pragma unroll
            for (int n = 0; n < 2; ++n) bv[bj][n] = bias ? *(const f32x4*)(bias + bcol0 + bj * HALF + 4 * n) : (f32x4){0.f, 0.f, 0.f, 0.f};
#pragma unroll
        for (int ai = 0; ai < 2; ++ai)
#pragma unroll
            for (int m = 0; m < 4; ++m) { bf16_t* rowp = base + (size_t)(row0 + ai * HALF + m * 16) * ldc + col0;
#pragma unroll
                for (int bj = 0; bj < 2; ++bj) { f32x4 v0 = acc[ai][bj][m][0] + bv[bj][0], v1 = acc[ai][bj][m][1] + bv[bj][1];
                    if (ACT == 1) { f32x2 a = gelu_pk((f32x2){v0[0], v0[1]}), b = gelu_pk((f32x2){v0[2], v0[3]}), c = gelu_pk((f32x2){v1[0], v1[1]}), d = gelu_pk((f32x2){v1[2], v1[3]});
                        v0 = (f32x4){a.x, a.y, b.x, b.y}; v1 = (f32x4){c.x, c.y, d.x, d.y}; }
                    if (ACT == 2) {
#pragma unroll
                        for (int j = 0; j < 4; ++j) { v0[j] = 0.5f * v0[j] * (1.0f + erff(v0[j] * 0.70710678f)); v1[j] = 0.5f * v1[j] * (1.0f + erff(v1[j] * 0.70710678f)); } }
                    u32x4 w; w.x = cvt_pk_bf16(v0[0], v0[1]); w.y = cvt_pk_bf16(v0[2], v0[3]); w.z = cvt_pk_bf16(v1[0], v1[1]); w.w = cvt_pk_bf16(v1[2], v1[3]);
                    *(u32x4*)(rowp + bj * HALF) = w; } }
    }
};

template <class Epi, class Sched, bool STAMP = false>
__device__ __forceinline__ void gemm_phase(PG8_LAS unsigned char* lds, const Gemm g, const Sched& S, const Epi& E, unsigned long long* stamps) {
    const int tid = threadIdx.x, wid = __builtin_amdgcn_readfirstlane(tid >> 6), lane = tid & 63, wr = wid >> 2, wc = wid & 3, fr = lane & 15, fq = lane >> 4;
    const int K = g.K, nt = K / BK;
    int ts_lo = 0, ts_hi = 0, nts = 0; const unsigned long long rt_entry = STAMP ? (unsigned long long)wall_clock64() : 0ull;
#define PG8_STAMP() do { if (STAMP && wid == 0 && nts < 64) { const unsigned long long _c = (unsigned long long)clock64(); \
        ts_lo = (lane == nts) ? (int)(unsigned)_c : ts_lo; ts_hi = (lane == nts) ? (int)(unsigned)(_c >> 32) : ts_hi; ++nts; } } while (0)
    PG8_STAMP();
    unsigned voffA[2], voffB[2];
#pragma unroll
    for (int i = 0; i < 2; ++i) { int R, C; stage_rc(tid * 16 + i * 8192, R, C); const int Rb = Epi::PERM ? ((R & ~31) + perm32(R & 31)) : R;
        voffA[i] = (unsigned)(R * K + C) * 2u; voffB[i] = (unsigned)(Rb * K + C) * 2u; }
    const size_t kstep = (size_t)(BK * 2);
    const size_t hstep = (size_t)HALF * K * 2;
    const size_t tstep = 2 * hstep;
    const unsigned ldsw = (unsigned)wid * 1024u;
    const int aoff = lds_byte(wr * 64 + fr, fq * 8), boff = lds_byte(wc * 32 + fr, fq * 8);
#define PG8_SA(b, h) (((b) * 2 + (h)) * HTB)
#define PG8_SB(b, h) ((4 + (b) * 2 + (h)) * HTB)
#define PG8_STAGE(bufoff, gbase, voff) do { _Pragma("unroll") for (int _i = 0; _i < 2; ++_i) \
        __builtin_amdgcn_global_load_lds((const unsigned*)((const char*)(gbase) + (voff)[_i]), (PG8_LAS unsigned*)(lds + (bufoff) + ldsw + _i * 8192), 16, 0, 0); } while (0)
#define PG8_LDA(dst, b, h) do { _Pragma("unroll") for (int m = 0; m < 4; ++m) _Pragma("unroll") for (int k = 0; k < 2; ++k) dst[m][k] = *(const PG8_LAS bf16x8*)(lds + PG8_SA(b, h) + aoff + m * 2048 + k * 1024); } while (0)
#define PG8_LDB(dst, b, h) do { _Pragma("unroll") for (int n = 0; n < 2; ++n) _Pragma("unroll") for (int k = 0; k < 2; ++k) dst[n][k] = *(const PG8_LAS bf16x8*)(lds + PG8_SB(b, h) + boff + n * 2048 + k * 1024); } while (0)
#define PG8_MMA(ai, bj, At, Bt) do { __builtin_amdgcn_s_setprio(1); _Pragma("unroll") for (int m = 0; m < 4; ++m) _Pragma("unroll") for (int n = 0; n < 2; ++n) _Pragma("unroll") for (int k = 0; k < 2; ++k) \
        acc[ai][bj][m][n] = __builtin_amdgcn_mfma_f32_16x16x32_bf16(Bt[n][k], At[m][k], acc[ai][bj][m][n], 0, 0, 0); __builtin_amdgcn_s_setprio(0); } while (0)
#define PG8_WAIT_V(n) asm volatile("s_waitcnt vmcnt(" #n ")" ::: "memory")
#define PG8_WAIT_L(n) asm volatile("s_waitcnt lgkmcnt(" #n ")" ::: "memory")
#define PG8_BAR __builtin_amdgcn_s_barrier()
#define PG8_SCHED __builtin_amdgcn_sched_barrier(0)
    Unit cur, nxt; int ui = 0;
    if (!S.next(0, cur)) return;
    f32x4 acc[2][2][4][2];
#pragma unroll
    for (int a = 0; a < 2; ++a)
#pragma unroll
        for (int b = 0; b < 2; ++b)
#pragma unroll
            for (int m = 0; m < 4; ++m)
#pragma unroll
                for (int n = 0; n < 2; ++n) acc[a][b][m][n] = (f32x4){0.f, 0.f, 0.f, 0.f};
    bf16x8 At[4][2], B0[2][2], B1[2][2];
    const char* cA = (const char*)g.A + (size_t)cur.pm * tstep; const char* cB = (const char*)g.Bt + (size_t)cur.pn * tstep;
    S.a_ready(cur);
    PG8_STAGE(PG8_SB(0, 0), cB, voffB); PG8_STAGE(PG8_SA(0, 0), cA, voffA); PG8_STAGE(PG8_SB(0, 1), cB + hstep, voffB); PG8_STAGE(PG8_SA(0, 1), cA + hstep, voffA);
    if (wr == 1) PG8_BAR;
    PG8_WAIT_V(4); PG8_BAR;
    PG8_STAGE(PG8_SB(1, 0), cB + kstep, voffB); PG8_STAGE(PG8_SA(1, 0), cA + kstep, voffA); PG8_STAGE(PG8_SB(1, 1), cB + hstep + kstep, voffB);
    PG8_WAIT_V(6); PG8_BAR;
    PG8_STAMP();
    for (;;) {
        const bool has_next = S.next(ui + 1, nxt);
        const char* nA = has_next ? (const char*)g.A + (size_t)nxt.pm * tstep : cA; const char* nB = has_next ? (const char*)g.Bt + (size_t)nxt.pn * tstep : cB;
        for (int t = 0; t < nt; t += 2) {
            const bool last = (t == nt - 2);
            const char* a1 = cA + (size_t)(t + 1) * kstep;
            const char* a2 = last ? nA : cA + (size_t)(t + 2) * kstep; const char* b2 = last ? nB : cB + (size_t)(t + 2) * kstep;
            const char* a3 = a2 + kstep; const char* b3 = b2 + kstep;
            if (last && has_next) S.a_ready(nxt);
            PG8_LDB(B0, 0, 0); PG8_SCHED; PG8_LDA(At, 0, 0); PG8_STAGE(PG8_SA(1, 1), a1 + hstep, voffA);
            PG8_WAIT_L(8); PG8_BAR; PG8_WAIT_L(0); PG8_MMA(0, 0, At, B0); PG8_BAR; PG8_SCHED;
            PG8_LDB(B1, 0, 1); PG8_STAGE(PG8_SB(0, 0), b2, voffB);
            PG8_BAR; PG8_WAIT_L(0); PG8_MMA(0, 1, At, B1); PG8_BAR;
            PG8_LDA(At, 0, 1); PG8_STAGE(PG8_SA(0, 0), a2, voffA);
            PG8_BAR; PG8_WAIT_L(0); PG8_MMA(1, 0, At, B0); PG8_BAR; PG8_SCHED;
            PG8_STAGE(PG8_SB(0, 1), b2 + hstep, voffB);
            PG8_WAIT_V(6); PG8_BAR; PG8_MMA(1, 1, At, B1); PG8_BAR;
            PG8_LDB(B0, 1, 0); PG8_SCHED; PG8_LDA(At, 1, 0); PG8_STAGE(PG8_SA(0, 1), a2 + hstep, voffA);
            PG8_WAIT_L(8); PG8_BAR; PG8_WAIT_L(0); PG8_MMA(0, 0, At, B0); PG8_BAR; PG8_SCHED;
            PG8_LDB(B1, 1, 1); PG8_STAGE(PG8_SB(1, 0), b3, voffB);
            PG8_BAR; PG8_WAIT_L(0); PG8_MMA(0, 1, At, B1); PG8_BAR;
            PG8_LDA(At, 1, 1); PG8_STAGE(PG8_SA(1, 0), a3, voffA);
            PG8_BAR; PG8_WAIT_L(0); PG8_MMA(1, 0, At, B0); PG8_BAR; PG8_SCHED;
            PG8_STAGE(PG8_SB(1, 1), b3 + hstep, voffB);
            PG8_WAIT_V(6); PG8_BAR; PG8_MMA(1, 1, At, B1); PG8_BAR;
        }
        PG8_STAMP();
        if constexpr (!Epi::AFTER_DRAIN) { E(acc, cur, wr, wc, fr, fq); S.done(cur); }
        PG8_STAMP();
        if (!has_next) break;
#pragma unroll
        for (int a = 0; a < 2; ++a)
#pragma unroll
            for (int b = 0; b < 2; ++b)
#pragma unroll
                for (int m = 0; m < 4; ++m)
#pragma unroll
                    for (int n = 0; n < 2; ++n) acc[a][b][m][n] = (f32x4){0.f, 0.f, 0.f, 0.f};
        cur = nxt; cA = nA; cB = nB; ++ui;
    }
    PG8_WAIT_V(0);
    if (wr == 0) PG8_BAR;
    PG8_BAR;
    if constexpr (Epi::AFTER_DRAIN) { E.fused(acc, cur, wr, wc, fr, fq, lds, wid, lane); S.done(cur); }
    PG8_STAMP();
    if (STAMP && wid == 0) { stamps[lane] = lane < nts ? (((unsigned long long)(unsigned)ts_hi << 32) | (unsigned)ts_lo) : 0ull;
        if (lane == 62) stamps[62] = rt_entry; if (lane == 63) stamps[63] = (unsigned long long)wall_clock64(); }
#undef PG8_STAMP
#undef PG8_SA
#undef PG8_SB
#undef PG8_STAGE
#undef PG8_LDA
#undef PG8_LDB
#undef PG8_MMA
#undef PG8_WAIT_V
#undef PG8_WAIT_L
#undef PG8_BAR
#undef PG8_SCHED
}
}


#define LAS __attribute__((address_space(3)))
typedef unsigned short bf16_t;
typedef float f32x4 __attribute__((ext_vector_type(4)));
typedef unsigned u32x4 __attribute__((ext_vector_type(4)));
typedef unsigned u32x2 __attribute__((ext_vector_type(2)));

constexpr int MTOK = 16384, DM = 2048, SEQ = 8192, NHEAD = 16;
constexpr float ALPHA = 1.41421356237309515f;
constexpr size_t MiB = (size_t)1 << 20;
constexpr size_t WS_WIN = 0, WS_WOUT = 32 * MiB, WS_WKVQ = 40 * MiB, WS_WO = 64 * MiB, WS_WC = 72 * MiB, WS_UB = 88 * MiB, WS_VB = 216 * MiB, WS_SLOT = 344 * MiB;
constexpr size_t WS_EID = 920 * MiB, WS_GATE = 928 * MiB, WS_COS = 936 * MiB, WS_SIN = 938 * MiB, WS_KMEAN = 940 * MiB, WS_LB = 941 * MiB, WS_LS = 942 * MiB, WS_SUB = 946 * MiB, WS_CNT = 962 * MiB, WS_CTR = 963 * MiB, WS_END = 964 * MiB;
constexpr size_t WS_KNMAX = WS_KMEAN + 768 * 1024;
__host__ __device__ constexpr size_t slot(int i) { return WS_SLOT + (size_t)i * 64 * MiB; }
constexpr int LDS_BYTES = 144 * 1024;
constexpr int NPH = 19;

struct Args { const float* in[14]; float* out; unsigned char* ws; int ph_lo, ph_hi; };

__device__ __forceinline__ float bflo(unsigned w) { return __uint_as_float(w << 16); }
__device__ __forceinline__ float bfhi(unsigned w) { return __uint_as_float(w & 0xffff0000u); }
__device__ __forceinline__ float bf2f(bf16_t b) { return __uint_as_float(((unsigned)b) << 16); }
__device__ __forceinline__ unsigned pk_bf16(float lo, float hi) { unsigned r; asm volatile("v_cvt_pk_bf16_f32 %0, %1, %2" : "=v"(r) : "v"(lo), "v"(hi)); return r; }
__device__ __forceinline__ float wave_sum(float v) {
#pragma unroll
    for (int o = 32; o >= 1; o >>= 1) v += __shfl_xor(v, o);
    return v;
}
__device__ __forceinline__ float wave_max(float v) {
#pragma unroll
    for (int o = 32; o >= 1; o >>= 1) v = fmaxf(v, __shfl_xor(v, o));
    return v;
}
__device__ __forceinline__ float sigmoidf_(float z) { return 1.0f / (1.0f + __expf(-z)); }

struct EpiIn {
    static constexpr bool PERM = true, AFTER_DRAIN = false;
    bf16_t* Q1; float* LF; bf16_t* I1; bf16_t* G1; const float* LB;
    __device__ __forceinline__ void operator()(const pg8::f32x4 (&acc)[2][2][4][2], const pg8::Unit& u, int wr, int wc, int fr, int fq) const {
        const int type = u.pn >> 3;
        const int row0 = u.pm * 256 + wr * 64 + fr, col0 = (u.pn & 7) * 256 + wc * 32 + 8 * fq;
        if (type == 1) {
#pragma unroll
            for (int bj = 0; bj < 2; ++bj) {
                const int c = col0 + bj * 128;
                const f32x4 lb0 = *(const f32x4*)(LB + c), lb1 = *(const f32x4*)(LB + c + 4);
#pragma unroll
                for (int ai = 0; ai < 2; ++ai)
#pragma unroll
                    for (int m = 0; m < 4; ++m) {
                        float* p = LF + (size_t)(row0 + ai * 128 + m * 16) * DM + c;
                        f32x4 o0, o1;
#pragma unroll
                        for (int j = 0; j < 4; ++j) {
                            o0[j] = __logf(lb0[j] + (1.0f - lb0[j]) * sigmoidf_(acc[ai][bj][m][0][j]));
                            o1[j] = __logf(lb1[j] + (1.0f - lb1[j]) * sigmoidf_(acc[ai][bj][m][1][j]));
                        }
                        *(f32x4*)p = o0; *(f32x4*)(p + 4) = o1;
                    }
            }
        } else {
            bf16_t* dst = Q1 + (size_t)(type - (type > 0 ? 1 : 0)) * ((size_t)32 << 20);
            const bool act = (type != 2);
#pragma unroll
            for (int ai = 0; ai < 2; ++ai)
#pragma unroll
                for (int m = 0; m < 4; ++m)
#pragma unroll
                    for (int bj = 0; bj < 2; ++bj) {
                        f32x4 v0 = acc[ai][bj][m][0], v1 = acc[ai][bj][m][1];
                        if (act) {
#pragma unroll
                            for (int j = 0; j < 4; ++j) { v0[j] = v0[j] * sigmoidf_(v0[j]); v1[j] = v1[j] * sigmoidf_(v1[j]); }
                        }
                        u32x4 w; w.x = pk_bf16(v0[0], v0[1]); w.y = pk_bf16(v0[2], v0[3]); w.z = pk_bf16(v1[0], v1[1]); w.w = pk_bf16(v1[2], v1[3]);
                        *(u32x4*)(dst + (size_t)(row0 + ai * 128 + m * 16) * DM + col0 + bj * 128) = w;
                    }
        }
    }
};
struct EpiRes {
    static constexpr bool PERM = false, AFTER_DRAIN = false;
    const float* res; float* Y;
    __device__ __forceinline__ void operator()(const pg8::f32x4 (&acc)[2][2][4][2], const pg8::Unit& u, int wr, int wc, int fr, int fq) const {
        const int row0 = u.pm * 256 + wr * 64 + fr, col0 = u.pn * 256 + wc * 32 + 4 * fq;
#pragma unroll
        for (int ai = 0; ai < 2; ++ai)
#pragma unroll
            for (int m = 0; m < 4; ++m) {
                const size_t off = (size_t)(row0 + ai * 128 + m * 16) * DM + col0;
#pragma unroll
                for (int bj = 0; bj < 2; ++bj)
#pragma unroll
                    for (int n = 0; n < 2; ++n) {
                        const f32x4 r = *(const f32x4*)(res + off + bj * 128 + n * 16);
                        *(f32x4*)(Y + off + bj * 128 + n * 16) = r * ALPHA + acc[ai][bj][m][n];
                    }
            }
    }
};
struct EpiF32 {
    static constexpr bool PERM = false, AFTER_DRAIN = false;
    float* C;
    __device__ __forceinline__ void operator()(const pg8::f32x4 (&acc)[2][2][4][2], const pg8::Unit& u, int wr, int wc, int fr, int fq) const {
        const int row0 = u.pm * 256 + wr * 64 + fr, col0 = u.pn * 256 + wc * 32 + 4 * fq;
#pragma unroll
        for (int ai = 0; ai < 2; ++ai)
#pragma unroll
            for (int m = 0; m < 4; ++m) {
                float* p = C + (size_t)(row0 + ai * 128 + m * 16) * DM + col0;
#pragma unroll
                for (int bj = 0; bj < 2; ++bj)
#pragma unroll
                    for (int n = 0; n < 2; ++n) *(f32x4*)(p + bj * 128 + n * 16) = acc[ai][bj][m][n];
            }
    }
};
struct EpiKVQ {
    static constexpr bool PERM = true, AFTER_DRAIN = false;
    bf16_t* K; bf16_t* V; bf16_t* Q;
    __device__ __forceinline__ void operator()(const pg8::f32x4 (&acc)[2][2][4][2], const pg8::Unit& u, int wr, int wc, int fr, int fq) const {
        const int t = u.pn >> 3;
        bf16_t* dst = K + (size_t)t * ((size_t)32 << 20);
        const int row0 = u.pm * 256 + wr * 64 + fr, col0 = (u.pn & 7) * 256 + wc * 32 + 8 * fq;
#pragma unroll
        for (int ai = 0; ai < 2; ++ai)
#pragma unroll
            for (int m = 0; m < 4; ++m)
#pragma unroll
                for (int bj = 0; bj < 2; ++bj) {
                    const f32x4 v0 = acc[ai][bj][m][0], v1 = acc[ai][bj][m][1];
                    u32x4 w; w.x = pk_bf16(v0[0], v0[1]); w.y = pk_bf16(v0[2], v0[3]); w.z = pk_bf16(v1[0], v1[1]); w.w = pk_bf16(v1[2], v1[3]);
                    *(u32x4*)(dst + (size_t)(row0 + ai * 128 + m * 16) * DM + col0 + bj * 128) = w;
                }
    }
};

__device__ __forceinline__ void transpose_tiles(LAS float* tile, const float* src, int ldn, int K, int N, bf16_t* dst) {
    const int tid = threadIdx.x;
    const int tn = N / 64, ntiles = tn * (K / 64);
    for (int tI = blockIdx.x; tI < ntiles; tI += gridDim.x) {
        const int k0 = (tI / tn) * 64, n0 = (tI % tn) * 64;
#pragma unroll
        for (int r = 0; r < 2; ++r) {
            const int kk = (tid >> 4) + 32 * r, nn = (tid & 15) * 4;
            const f32x4 v = *(const f32x4*)(src + (size_t)(k0 + kk) * ldn + n0 + nn);
            tile[kk * 65 + nn + 0] = v[0]; tile[kk * 65 + nn + 1] = v[1]; tile[kk * 65 + nn + 2] = v[2]; tile[kk * 65 + nn + 3] = v[3];
        }
        __syncthreads();
        {
            const int nn = tid >> 3, kk8 = (tid & 7) * 8;
            float f[8];
#pragma unroll
            for (int j = 0; j < 8; ++j) f[j] = tile[(kk8 + j) * 65 + nn];
            u32x4 w; w.x = pk_bf16(f[0], f[1]); w.y = pk_bf16(f[2], f[3]); w.z = pk_bf16(f[4], f[5]); w.w = pk_bf16(f[6], f[7]);
            *(u32x4*)(dst + (size_t)(n0 + nn) * K + k0 + kk8) = w;
        }
        __syncthreads();
    }
}
__device__ __forceinline__ void convert_bf16(const float* src, bf16_t* dst, size_t n) {
    const size_t stride = (size_t)gridDim.x * 512 * 8;
    for (size_t i = ((size_t)blockIdx.x * 512 + threadIdx.x) * 8; i < n; i += stride) {
        const f32x4 a = *(const f32x4*)(src + i), b = *(const f32x4*)(src + i + 4);
        u32x4 w; w.x = pk_bf16(a[0], a[1]); w.y = pk_bf16(a[2], a[3]); w.z = pk_bf16(b[0], b[1]); w.w = pk_bf16(b[2], b[3]);
        *(u32x4*)(dst + i) = w;
    }
}
__device__ __forceinline__ void fold_peer_keys(LAS float* lds, const float* w_query, const float* sub_keys, bf16_t* WcT) {
    const int tid = threadIdx.x;
    LAS float* Ss = lds;
    LAS float* Ws = lds + 128 * 132;
    for (int item = blockIdx.x; item < 1024; item += gridDim.x) {
        const int l = item >> 9, rem = item & 511, hh = rem >> 5, kb = rem & 31, h = hh >> 1, half = hh & 1;
        const float* sk = sub_keys + (size_t)(((l * 2 + half) * 8 + h) * 128) * 128;
        const float* wq = w_query + (size_t)l * DM * DM + (size_t)(kb * 64) * DM + h * 256 + half * 128;
#pragma unroll
        for (int r = 0; r < 8; ++r) { const int idx = tid + 512 * r, key = idx >> 5, d4 = (idx & 31) * 4; *(LAS f32x4*)(Ss + key * 132 + d4) = *(const f32x4*)(sk + key * 128 + d4); }
#pragma unroll
        for (int r = 0; r < 4; ++r) { const int idx = tid + 512 * r, kin = idx >> 5, d4 = (idx & 31) * 4; *(LAS f32x4*)(Ws + kin * 128 + d4) = *(const f32x4*)(wq + (size_t)kin * DM + d4); }
        __syncthreads();
        const int key = tid & 127, kq = tid >> 7;
        float acc[16];
#pragma unroll
        for (int j = 0; j < 16; ++j) acc[j] = 0.f;
        for (int d4 = 0; d4 < 32; ++d4) {
            const f32x4 s4 = *(const LAS f32x4*)(Ss + key * 132 + d4 * 4);
#pragma unroll
            for (int j = 0; j < 16; ++j) { const f32x4 w4 = *(const LAS f32x4*)(Ws + (kq * 16 + j) * 128 + d4 * 4); acc[j] += s4[0] * w4[0] + s4[1] * w4[1] + s4[2] * w4[2] + s4[3] * w4[3]; }
        }
        bf16_t* o = WcT + (size_t)l * DM * DM + (size_t)(h * 256 + half * 128 + key) * DM + kb * 64 + kq * 16;
        u32x4 w0, w1;
        w0.x = pk_bf16(acc[0], acc[1]); w0.y = pk_bf16(acc[2], acc[3]); w0.z = pk_bf16(acc[4], acc[5]); w0.w = pk_bf16(acc[6], acc[7]);
        w1.x = pk_bf16(acc[8], acc[9]); w1.y = pk_bf16(acc[10], acc[11]); w1.z = pk_bf16(acc[12], acc[13]); w1.w = pk_bf16(acc[14], acc[15]);
        *(u32x4*)o = w0; *(u32x4*)(o + 8) = w1;
        __syncthreads();
    }
}
__device__ __forceinline__ void phase_prep(const Args& a, LAS unsigned char* lds) {
    unsigned char* ws = a.ws;
    LAS float* tile = (LAS float*)lds;
    transpose_tiles(tile, a.in[1], 4 * DM, DM, 4 * DM, (bf16_t*)(ws + WS_WIN));
    transpose_tiles(tile, a.in[3], DM, DM, DM, (bf16_t*)(ws + WS_WOUT));
    transpose_tiles(tile, a.in[5], 2 * DM, DM, 2 * DM, (bf16_t*)(ws + WS_WKVQ));
    transpose_tiles(tile, a.in[6], DM, DM, DM, (bf16_t*)(ws + WS_WKVQ) + (size_t)2 * DM * DM);
    transpose_tiles(tile, a.in[7], DM, DM, DM, (bf16_t*)(ws + WS_WO));
    fold_peer_keys((LAS float*)lds, a.in[8], a.in[9], (bf16_t*)(ws + WS_WC));
    convert_bf16(a.in[0], (bf16_t*)(ws + slot(0)), (size_t)MTOK * DM);
    convert_bf16(a.in[10], (bf16_t*)(ws + WS_UB), (size_t)2 * 16384 * DM);
    convert_bf16(a.in[11], (bf16_t*)(ws + WS_VB), (size_t)2 * 16384 * DM);
    const int gtid = blockIdx.x * 512 + threadIdx.x, gthreads = gridDim.x * 512;
    float* COS = (float*)(ws + WS_COS); float* SIN = (float*)(ws + WS_SIN); float* LB = (float*)(ws + WS_LB);
    for (int i = gtid; i < SEQ * 64; i += gthreads) {
        const int pos = i >> 6, j = i & 63;
        double inv = 1.0; const double r = 0.86596432336006535;
        for (int q = 0; q < j; ++q) inv *= r;
        const float ang = (float)pos * (float)inv;
        const double x = (double)ang;
        const double n = __builtin_rint(x * 0.15915494309189535);
        const float rf = (float)__builtin_fma(-n, 6.283185307179586, x);
        COS[i] = cosf(rf); SIN[i] = sinf(rf);
    }
    for (int c = gtid; c < DM; c += gthreads) { const float l0 = a.in[4][c], l1 = a.in[4][DM + c]; LB[c] = 1.0f / (1.0f + expf(l1 - l0)); }
}

__device__ __forceinline__ void phase_scan_naive(const bf16_t* Q1, const float* LF, const bf16_t* I1, float* O) {
    const int lane = threadIdx.x & 63, gw = blockIdx.x * 8 + (threadIdx.x >> 6), nw = gridDim.x * 8;
    for (int item = gw; item < 2 * NHEAD * 128; item += nw) {
        const int bh = item >> 7, v = item & 127, b = bh >> 4, h = bh & 15;
        const size_t base = (size_t)b * SEQ * DM + h * 128;
        float S0 = 0.f, S1 = 0.f;
#pragma unroll 4
        for (int t = 0; t < SEQ; ++t) {
            const size_t ro = base + (size_t)t * DM;
            const float f0 = __expf(LF[ro + lane]), f1 = __expf(LF[ro + 64 + lane]);
            const float q0 = bf2f(Q1[ro + lane]), q1 = bf2f(Q1[ro + 64 + lane]);
            const float iv = bf2f(I1[ro + v]);
            S0 = f0 * S0 + (1.0f - f0) * iv; S1 = f1 * S1 + (1.0f - f1) * iv;
            const float p = wave_sum(q0 * S0 + q1 * S1);
            if (lane == 0) O[ro + v] = p;
        }
    }
}
__device__ __forceinline__ void phase_onorm(const float* O, const bf16_t* G1, const float* gnorm, bf16_t* OG) {
    const int lane = threadIdx.x & 63, gw = blockIdx.x * 8 + (threadIdx.x >> 6), nw = gridDim.x * 8;
    const float gn0 = gnorm[2 * lane], gn1 = gnorm[2 * lane + 1];
    for (int item = gw; item < MTOK * NHEAD; item += nw) {
        const size_t off = (size_t)item * 128 + 2 * lane;
        const float o0 = O[off], o1 = O[off + 1];
        const float ss = wave_sum(o0 * o0 + o1 * o1);
        const float r = rsqrtf(ss * (1.0f / 128.0f) + 1e-6f);
        const unsigned g = *(const unsigned*)(G1 + off);
        *(unsigned*)(OG + off) = pk_bf16(o0 * r * gn0 * bflo(g), o1 * r * gn1 * bfhi(g));
    }
}

__device__ __forceinline__ void ln_row_store(float (&v)[32], const float* g, const float* bta, float* outf, bf16_t* outb, int lane) {
    float s = 0.f;
#pragma unroll
    for (int i = 0; i < 32; ++i) s += v[i];
    const float mu = wave_sum(s) * (1.0f / DM);
    float q = 0.f;
#pragma unroll
    for (int i = 0; i < 32; ++i) { v[i] -= mu; q += v[i] * v[i]; }
    const float rstd = rsqrtf(wave_sum(q) * (1.0f / DM) + 1e-5f);
#pragma unroll
    for (int i = 0; i < 4; ++i) {
        const int c = 512 * i + 8 * lane;
        const f32x4 g0 = *(const f32x4*)(g + c), g1 = *(const f32x4*)(g + c + 4), b0 = *(const f32x4*)(bta + c), b1 = *(const f32x4*)(bta + c + 4);
        f32x4 o0, o1;
#pragma unroll
        for (int j = 0; j < 4; ++j) { o0[j] = v[i * 8 + j] * rstd * g0[j] + b0[j]; o1[j] = v[i * 8 + 4 + j] * rstd * g1[j] + b1[j]; }
        *(f32x4*)(outf + c) = o0; *(f32x4*)(outf + c + 4) = o1;
        if (outb) { u32x4 w; w.x = pk_bf16(o0[0], o0[1]); w.y = pk_bf16(o0[2], o0[3]); w.z = pk_bf16(o1[0], o1[1]); w.w = pk_bf16(o1[2], o1[3]); *(u32x4*)(outb + c) = w; }
    }
}
__device__ __forceinline__ void phase_ln(const float* Y, const float* g, const float* bta, float* outf, bf16_t* outb) {
    const int lane = threadIdx.x & 63, gw = blockIdx.x * 8 + (threadIdx.x >> 6), nw = gridDim.x * 8;
    for (int row = gw; row < MTOK; row += nw) {
        float v[32];
        const float* p = Y + (size_t)row * DM;
#pragma unroll
        for (int i = 0; i < 4; ++i) {
            const f32x4 a = *(const f32x4*)(p + 512 * i + 8 * lane), b = *(const f32x4*)(p + 512 * i + 8 * lane + 4);
#pragma unroll
            for (int j = 0; j < 4; ++j) { v[i * 8 + j] = a[j]; v[i * 8 + 4 + j] = b[j]; }
        }
        ln_row_store(v, g, bta, outf + (size_t)row * DM, outb ? outb + (size_t)row * DM : nullptr, lane);
    }
}

__device__ __forceinline__ void wave_argmax(float& v, int& idx) {
#pragma unroll
    for (int o = 32; o >= 1; o >>= 1) {
        const float ov = __shfl_xor(v, o); const int oi = __shfl_xor(idx, o);
        if (ov > v || (ov == v && oi < idx)) { v = ov; idx = oi; }
    }
}
__device__ __forceinline__ void phase_topk(const float* SC, int* EID, float* GATE) {
    const int lane = threadIdx.x & 63, gw = blockIdx.x * 8 + (threadIdx.x >> 6), nw = gridDim.x * 8;
    const float NINF = -__builtin_inff();
    for (int item = gw; item < MTOK * 8; item += nw) {
        const float* p = SC + (size_t)item * 256;
        float a0 = p[lane], a1 = p[64 + lane], b0 = p[128 + lane], b1 = p[192 + lane];
        float v1 = NINF, v2 = NINF; int i1 = 0, i2 = 0;
        for (int r = 0; r < 16; ++r) {
            float va = a0 >= a1 ? a0 : a1; int ia = a0 >= a1 ? lane : lane + 64;
            float vb = b0 >= b1 ? b0 : b1; int ib = b0 >= b1 ? lane : lane + 64;
            wave_argmax(va, ia); wave_argmax(vb, ib);
            if (lane == r) { v1 = va; i1 = ia; v2 = vb; i2 = ib; }
            if (ia == lane) a0 = NINF; if (ia == lane + 64) a1 = NINF;
            if (ib == lane) b0 = NINF; if (ib == lane + 64) b1 = NINF;
        }
        const float vb_ = __shfl(v2, lane & 15);
        float c0 = __shfl(v1, (lane >> 4)) + vb_, c1 = __shfl(v1, (lane >> 4) + 4) + vb_, c2 = __shfl(v1, (lane >> 4) + 8) + vb_, c3 = __shfl(v1, (lane >> 4) + 12) + vb_;
        float best = NINF; int flat = 0; float bmax = 0.f;
        for (int r = 0; r < 16; ++r) {
            float v = c0; int id = lane;
            if (c1 > v) { v = c1; id = lane + 64; }
            if (c2 > v) { v = c2; id = lane + 128; }
            if (c3 > v) { v = c3; id = lane + 192; }
            wave_argmax(v, id);
            if (r == 0) bmax = v;
            if (lane == r) { best = v; flat = id; }
            if ((id & 63) == lane) { const int c = id >> 6; if (c == 0) c0 = NINF; else if (c == 1) c1 = NINF; else if (c == 2) c2 = NINF; else c3 = NINF; }
        }
        const float e = lane < 16 ? __expf(best - bmax) : 0.f;
        const float sum = wave_sum(e);
        const int ea = __shfl(i1, flat >> 4), eb = __shfl(i2, flat & 15);
        if (lane < 16) { EID[(size_t)item * 16 + lane] = ea * 128 + eb; GATE[(size_t)item * 16 + lane] = e / sum; }
    }
}

__device__ __forceinline__ float gelu_erf(float x) { return 0.5f * x * (1.0f + erff(x * 0.70710678118654752f)); }
__device__ __forceinline__ void phase_peer(const float* X, const int* EID, const float* GATE, const bf16_t* U, const bf16_t* V, const float* g, const float* bta, float* outf, bf16_t* outb) {
    const int lane = threadIdx.x & 63, gw = blockIdx.x * 8 + (threadIdx.x >> 6), nw = gridDim.x * 8;
    for (int tok = gw; tok < MTOK; tok += nw) {
        float x[32];
        const float* xp = X + (size_t)tok * DM;
#pragma unroll
        for (int i = 0; i < 4; ++i) {
            const f32x4 a = *(const f32x4*)(xp + 512 * i + 8 * lane), b = *(const f32x4*)(xp + 512 * i + 8 * lane + 4);
#pragma unroll
            for (int j = 0; j < 4; ++j) { x[i * 8 + j] = a[j]; x[i * 8 + 4 + j] = b[j]; }
        }
        const int e0 = EID[(size_t)tok * 128 + lane], e1 = EID[(size_t)tok * 128 + 64 + lane];
        const float g0 = GATE[(size_t)tok * 128 + lane], g1 = GATE[(size_t)tok * 128 + 64 + lane];
        float h0 = 0.f, h1 = 0.f;
#pragma unroll 4
        for (int e = 0; e < 128; ++e) {
            const int idx = __builtin_amdgcn_readfirstlane(__shfl(e < 64 ? e0 : e1, e & 63));
            const u32x4* up = (const u32x4*)(U + (size_t)idx * DM) + lane;
            float d = 0.f;
#pragma unroll
            for (int i = 0; i < 4; ++i) {
                const u32x4 w = up[i * 64];
                d += x[i * 8 + 0] * bflo(w.x) + x[i * 8 + 1] * bfhi(w.x) + x[i * 8 + 2] * bflo(w.y) + x[i * 8 + 3] * bfhi(w.y)
                   + x[i * 8 + 4] * bflo(w.z) + x[i * 8 + 5] * bfhi(w.z) + x[i * 8 + 6] * bflo(w.w) + x[i * 8 + 7] * bfhi(w.w);
            }
            d = wave_sum(d);
            if (e < 64) { if (lane == e) h0 = d; } else { if (lane == e - 64) h1 = d; }
        }
        const float w0 = g0 * gelu_erf(h0), w1 = g1 * gelu_erf(h1);
        float y[32];
#pragma unroll
        for (int i = 0; i < 32; ++i) y[i] = 0.f;
#pragma unroll 4
        for (int e = 0; e < 128; ++e) {
            const int idx = __builtin_amdgcn_readfirstlane(__shfl(e < 64 ? e0 : e1, e & 63));
            const float wt = __shfl(e < 64 ? w0 : w1, e & 63);
            const u32x4* vp = (const u32x4*)(V + (size_t)idx * DM) + lane;
#pragma unroll
            for (int i = 0; i < 4; ++i) {
                const u32x4 w = vp[i * 64];
                y[i * 8 + 0] += wt * bflo(w.x); y[i * 8 + 1] += wt * bfhi(w.x); y[i * 8 + 2] += wt * bflo(w.y); y[i * 8 + 3] += wt * bfhi(w.y);
                y[i * 8 + 4] += wt * bflo(w.z); y[i * 8 + 5] += wt * bfhi(w.z); y[i * 8 + 6] += wt * bflo(w.w); y[i * 8 + 7] += wt * bfhi(w.w);
            }
        }
#pragma unroll
        for (int i = 0; i < 32; ++i) y[i] += ALPHA * x[i];
        ln_row_store(y, g, bta, outf + (size_t)tok * DM, outb ? outb + (size_t)tok * DM : nullptr, lane);
    }
}

__device__ __forceinline__ void phase_rot(LAS float* red, bf16_t* KR, bf16_t* QR, const float* COS, const float* SIN, float* KMEAN, float* KNMAX) {
    const int tid = threadIdx.x, d = tid & 63, rg = tid >> 6;
    for (int item = blockIdx.x; item < 2 * NHEAD * 32; item += gridDim.x) {
        const int bh = item >> 5, j = item & 31, b = bh >> 4, h = bh & 15;
        float s1 = 0.f, s2 = 0.f, nmax = 0.f;
        for (int i = 0; i < 32; ++i) {
            const int pos = j * 256 + rg * 32 + i;
            const size_t off = ((size_t)b * SEQ + pos) * DM + h * 128 + d;
            const float c = COS[pos * 64 + d], s = SIN[pos * 64 + d];
            const float k1 = bf2f(KR[off]), k2 = bf2f(KR[off + 64]);
            const float o1 = k1 * c - k2 * s, o2 = k1 * s + k2 * c;
            s1 += o1; s2 += o2;
            nmax = fmaxf(nmax, wave_sum(o1 * o1 + o2 * o2));
            KR[off] = (bf16_t)(pk_bf16(o1, 0.f) & 0xffffu); KR[off + 64] = (bf16_t)(pk_bf16(o2, 0.f) & 0xffffu);
            const float q1 = bf2f(QR[off]), q2 = bf2f(QR[off + 64]);
            QR[off] = (bf16_t)(pk_bf16(q1 * c - q2 * s, 0.f) & 0xffffu); QR[off + 64] = (bf16_t)(pk_bf16(q1 * s + q2 * c, 0.f) & 0xffffu);
        }
        red[rg * 128 + d] = s1; red[rg * 128 + 64 + d] = s2;
        if (d == 0) red[1024 + rg] = nmax;
        __syncthreads();
        if (tid < 128) {
            float s = 0.f;
#pragma unroll
            for (int r = 0; r < 8; ++r) s += red[r * 128 + tid];
            KMEAN[(size_t)item * 128 + tid] = s * (1.0f / 256.0f);
        }
        if (tid == 0) {
            float m = 0.f;
#pragma unroll
            for (int r = 0; r < 8; ++r) m = fmaxf(m, red[1024 + r]);
            KNMAX[item] = sqrtf(m);
        }
        __syncthreads();
    }
}

__device__ __forceinline__ void phase_sel(LAS unsigned char* lds, const bf16_t* QR, const float* KMEAN, unsigned short* SUB, int* CNT, int* ctr) {
    const int tid = threadIdx.x, lane = tid & 63, wv = tid >> 6;
    LAS float* km = (LAS float*)lds;
    LAS float* qs = (LAS float*)(lds + 16896) + wv * 128;
    LAS unsigned short* bucket = (LAS unsigned short*)(lds + 20992);
    LAS int* cnt = (LAS int*)(lds + 37376);
    const float NEG = -1e30f;
    if (blockIdx.x == 0 && tid == 0) *ctr = 0;
    for (int item = blockIdx.x; item < 2 * NHEAD * 32; item += gridDim.x) {
        const int bh = item >> 5, i = item & 31, b = bh >> 4, h = bh & 15;
        if (i == 0) continue;
        if (tid < 32) cnt[tid] = 0;
#pragma unroll
        for (int r = 0; r < 2; ++r) { const int idx = tid + 512 * r, n = idx >> 5, d4 = (idx & 31) * 4; *(LAS f32x4*)(km + n * 132 + d4) = *(const f32x4*)(KMEAN + ((size_t)bh * 32 + n) * 128 + d4); }
        __syncthreads();
        for (int qq = 0; qq < 32; ++qq) {
            const int tl = wv * 32 + qq;
            const size_t tok = (size_t)b * SEQ + i * 256 + tl;
            { const unsigned q2 = *(const unsigned*)(QR + tok * DM + h * 128 + 2 * lane); qs[2 * lane] = bflo(q2); qs[2 * lane + 1] = bfhi(q2); }
            asm volatile("s_waitcnt lgkmcnt(0)" ::: "memory");
            float gsc = NEG;
            if (lane < i) {
                float sacc = 0.f;
#pragma unroll 8
                for (int d4 = 0; d4 < 32; ++d4) { const f32x4 kv = *(const LAS f32x4*)(km + lane * 132 + d4 * 4); const f32x4 qv = *(const LAS f32x4*)(qs + d4 * 4); sacc += kv[0] * qv[0] + kv[1] * qv[1] + kv[2] * qv[2] + kv[3] * qv[3]; }
                gsc = sacc;
            }
#pragma unroll
            for (int r = 0; r < 3; ++r) {
                float v = gsc; int id = lane;
                wave_argmax(v, id);
                if (v > 0.5f * NEG && lane == 0) { const int p = __hip_atomic_fetch_add(cnt + id, 1, __ATOMIC_RELAXED, __HIP_MEMORY_SCOPE_WORKGROUP); bucket[id * 256 + p] = (unsigned short)(tl | (r << 8)); }
                if (lane == id) gsc = -3e38f;
            }
            asm volatile("s_waitcnt lgkmcnt(0)" ::: "memory");
        }
        __syncthreads();
        for (int idx = tid; idx < 32 * 256; idx += 512) {
            const int j = idx >> 8, p = idx & 255;
            if (j < i && p < cnt[j]) SUB[(((size_t)bh * 32 + j) * 32 + i) * 256 + p] = bucket[idx];
        }
        if (tid < i) CNT[((size_t)bh * 32 + tid) * 32 + i] = cnt[tid];
        __syncthreads();
    }
}

typedef short bf16x8 __attribute__((ext_vector_type(8)));
typedef short s16x4 __attribute__((ext_vector_type(4)));
typedef float f32x16 __attribute__((ext_vector_type(16)));
__device__ __forceinline__ unsigned off_b(unsigned row, unsigned ch) { return 256u * row + 16u * (ch ^ (((row & 3u) << 2) | ((row >> 2) & 3u))); }
__device__ __forceinline__ unsigned pi32(unsigned m) { return (m & ~12u) | ((m & 4u) << 1) | ((m & 8u) >> 1); }
__device__ __forceinline__ bf16x8 tr_frag(LAS unsigned char* img, unsigned lane, unsigned c, unsigned ks) {
    const unsigned hh = lane >> 5, blk = (lane >> 4) & 1, q = (lane & 15) >> 2, p = lane & 3;
    const unsigned a0 = off_b(16 * ks + 8 * hh + q, 4 * c + 2 * blk + (p >> 1)) + 8 * (p & 1);
    const unsigned a1 = off_b(16 * ks + 8 * hh + 4 + q, 4 * c + 2 * blk + (p >> 1)) + 8 * (p & 1);
    const s16x4 lo = __builtin_amdgcn_ds_read_tr16_b64_v4i16((LAS s16x4*)(img + a0));
    const s16x4 hi = __builtin_amdgcn_ds_read_tr16_b64_v4i16((LAS s16x4*)(img + a1));
    bf16x8 r; r[0] = lo[0]; r[1] = lo[1]; r[2] = lo[2]; r[3] = lo[3]; r[4] = hi[0]; r[5] = hi[1]; r[6] = hi[2]; r[7] = hi[3];
    return r;
}
__device__ __forceinline__ void phase_att(LAS unsigned char* lds, const bf16_t* QR, const bf16_t* KR, const bf16_t* V, const float* KNMAX, const unsigned short* SUB, const int* CNT, int* ctr,
                                          bf16_t* P012, bf16_t* P3, float* LS) {
    const int tid = threadIdx.x, lane = tid & 63, wv = tid >> 6, r32 = lane & 31, hh = lane >> 5;
    LAS unsigned char* Kimg = lds;
    LAS unsigned char* Vimg = lds + 65536;
    LAS int* misc = (LAS int*)(lds + 131072);
    const float SCL2 = 0.08838834764831845f * 1.4426950408889634f;
    for (;;) {
        __syncthreads();
        if (tid == 0) misc[40] = __hip_atomic_fetch_add(ctr, 1, __ATOMIC_RELAXED, __HIP_MEMORY_SCOPE_AGENT);
        __syncthreads();
        const int item = misc[40];
        if (item >= 2 * NHEAD * 32) break;
        const int j = item >> 5, bh = item & 31, b = bh >> 4, h = bh & 15;
#pragma unroll
        for (int r = 0; r < 8; ++r) {
            const int idx = tid + 512 * r, row = idx >> 4, ch = idx & 15;
            const size_t g = ((size_t)b * SEQ + j * 256 + row) * DM + h * 128 + ch * 8;
            const u32x4 kv = *(const u32x4*)(KR + g), vv = *(const u32x4*)(V + g);
            *(LAS u32x4*)(Kimg + off_b(row, ch)) = kv; *(LAS u32x4*)(Vimg + off_b(row, ch)) = vv;
        }
        if (tid <= 32) { int pre = 0; for (int u = j + 1; u < tid; ++u) pre += CNT[((size_t)bh * 32 + j) * 32 + u]; misc[tid] = pre; }
        float kn = (lane < 32) ? KNMAX[bh * 32 + lane] : 0.f;
        kn = wave_max(kn);
        __syncthreads();
        const int total = misc[32], ntile = (256 + total + 31) >> 5;
        for (int tile = wv; tile < ntile; tile += 8) {
            const int gr = tile * 32 + r32;
            int pos, slot; bool valid = true;
            if (gr < 256) { pos = j * 256 + gr; slot = 3; }
            else {
                const int x = gr - 256; valid = x < total;
                int ii = j + 1;
                for (int u = j + 1; u < 32; ++u) if (misc[u] <= x) ii = u;
                if (valid) { const unsigned e = SUB[(((size_t)bh * 32 + j) * 32 + ii) * 256 + (x - misc[ii])]; pos = ii * 256 + (int)(e & 255u); slot = (int)(e >> 8); }
                else { pos = j * 256; slot = 3; }
            }
            const size_t tok = (size_t)b * SEQ + pos;
            bf16x8 qf[8];
            const bf16_t* qp = QR + tok * DM + h * 128 + 8 * hh;
#pragma unroll
            for (int s = 0; s < 8; ++s) qf[s] = *(const bf16x8*)(qp + 16 * s);
            float qn2 = 0.f;
#pragma unroll
            for (int s = 0; s < 8; ++s)
#pragma unroll
                for (int e = 0; e < 8; ++e) { const float f = bf2f((bf16_t)qf[s][e]); qn2 += f * f; }
            qn2 += __shfl_xor(qn2, 32);
            const float c2 = sqrtf(qn2) * kn * SCL2;
            f32x16 O[4];
#pragma unroll
            for (int dt = 0; dt < 4; ++dt)
#pragma unroll
                for (int e = 0; e < 16; ++e) O[dt][e] = 0.f;
            float l = 0.f;
            const bool own = tile < 8;
            const int kcn = own ? tile + 1 : 8;
            const unsigned krow = pi32((unsigned)r32);
            for (int kc = 0; kc < kcn; ++kc) {
                f32x16 S;
#pragma unroll
                for (int e = 0; e < 16; ++e) S[e] = 0.f;
#pragma unroll
                for (int s = 0; s < 8; ++s) {
                    const bf16x8 kf = *(const LAS bf16x8*)(Kimg + off_b(32 * kc + krow, 2 * s + hh));
                    S = __builtin_amdgcn_mfma_f32_32x32x16_bf16(kf, qf[s], S, 0, 0, 0);
                }
                float p[16];
#pragma unroll
                for (int e = 0; e < 16; ++e) {
                    const unsigned m = (e & 3) + 8 * (e >> 2) + 4 * hh;
                    const int key = j * 256 + 32 * kc + (int)pi32(m);
                    float pe = __builtin_amdgcn_exp2f(S[e] * SCL2 - c2);
                    if (own && key > pos) pe = 0.f;
                    p[e] = pe; l += pe;
                }
                u32x4 w0, w1;
                w0.x = pk_bf16(p[0], p[1]); w0.y = pk_bf16(p[2], p[3]); w0.z = pk_bf16(p[4], p[5]); w0.w = pk_bf16(p[6], p[7]);
                w1.x = pk_bf16(p[8], p[9]); w1.y = pk_bf16(p[10], p[11]); w1.z = pk_bf16(p[12], p[13]); w1.w = pk_bf16(p[14], p[15]);
                const bf16x8 pf0 = __builtin_bit_cast(bf16x8, w0), pf1 = __builtin_bit_cast(bf16x8, w1);
#pragma unroll
                for (int dt = 0; dt < 4; ++dt) {
                    const bf16x8 v0 = tr_frag(Vimg, lane, dt, 2 * kc), v1 = tr_frag(Vimg, lane, dt, 2 * kc + 1);
                    O[dt] = __builtin_amdgcn_mfma_f32_32x32x16_bf16(v0, pf0, O[dt], 0, 0, 0);
                    O[dt] = __builtin_amdgcn_mfma_f32_32x32x16_bf16(v1, pf1, O[dt], 0, 0, 0);
                }
            }
            l += __shfl_xor(l, 32);
            if (valid) {
                bf16_t* pl = (slot < 3 ? P012 + (size_t)slot * ((size_t)32 << 20) : P3) + (tok * NHEAD + h) * 128 + 4 * hh;
#pragma unroll
                for (int dt = 0; dt < 4; ++dt)
#pragma unroll
                    for (int g = 0; g < 4; ++g) {
                        u32x2 w; w.x = pk_bf16(O[dt][4 * g], O[dt][4 * g + 1]); w.y = pk_bf16(O[dt][4 * g + 2], O[dt][4 * g + 3]);
                        *(u32x2*)(pl + 32 * dt + 8 * g) = w;
                    }
                if (hh == 0) LS[(size_t)slot * MTOK * NHEAD + tok * NHEAD + h] = l;
            }
        }
    }
}
__device__ __forceinline__ void phase_comb(const bf16_t* P012, const bf16_t* P3, const float* LS, bf16_t* AO) {
    const size_t n = (size_t)MTOK * NHEAD * 16, stride = (size_t)gridDim.x * 512;
    for (size_t idx = (size_t)blockIdx.x * 512 + threadIdx.x; idx < n; idx += stride) {
        const size_t th = idx >> 4; const int ch = (int)(idx & 15);
        const int t = (int)((th >> 4) & (SEQ - 1)), blk = t >> 8, nsel = blk < 3 ? blk : 3;
        float acc[8];
        float l = LS[(size_t)3 * MTOK * NHEAD + th];
        { const u32x4 w = *(const u32x4*)(P3 + th * 128 + ch * 8);
          acc[0] = bflo(w.x); acc[1] = bfhi(w.x); acc[2] = bflo(w.y); acc[3] = bfhi(w.y); acc[4] = bflo(w.z); acc[5] = bfhi(w.z); acc[6] = bflo(w.w); acc[7] = bfhi(w.w); }
        for (int s = 0; s < nsel; ++s) {
            const u32x4 w = *(const u32x4*)(P012 + (size_t)s * ((size_t)32 << 20) + th * 128 + ch * 8);
            acc[0] += bflo(w.x); acc[1] += bfhi(w.x); acc[2] += bflo(w.y); acc[3] += bfhi(w.y); acc[4] += bflo(w.z); acc[5] += bfhi(w.z); acc[6] += bflo(w.w); acc[7] += bfhi(w.w);
            l += LS[(size_t)s * MTOK * NHEAD + th];
        }
        const float rl = 1.0f / l;
        u32x4 o; o.x = pk_bf16(acc[0] * rl, acc[1] * rl); o.y = pk_bf16(acc[2] * rl, acc[3] * rl); o.z = pk_bf16(acc[4] * rl, acc[5] * rl); o.w = pk_bf16(acc[6] * rl, acc[7] * rl);
        *(u32x4*)(AO + th * 128 + ch * 8) = o;
    }
}

__device__ __forceinline__ int opaque(int v) { asm volatile("" : "+s"(v)); return v; }
template <bool L1> __device__ __forceinline__ void run_gemm_out(const Args& a, LAS unsigned char* lds) {
    unsigned char* ws = a.ws;
    pg8::Gemm g{(const bf16_t*)(ws + (L1 ? slot(3) : slot(0))), (const bf16_t*)(ws + (L1 ? WS_WO : WS_WOUT)), opaque(MTOK), opaque(DM), opaque(DM)};
    pg8::StaticOrder S; S.init(g.M, g.N, (int)gridDim.x, (int)blockIdx.x);
    EpiRes E{L1 ? (const float*)(ws + slot(0)) : a.in[0], (float*)(ws + (L1 ? slot(4) : slot(1)))};
    pg8::gemm_phase<EpiRes, pg8::StaticOrder>(lds, g, S, E, nullptr);
}
template <bool L1> __device__ __forceinline__ void run_ln(const Args& a) {
    unsigned char* ws = a.ws;
    phase_ln((const float*)(ws + (L1 ? slot(4) : slot(1))), a.in[12] + (L1 ? 2 : 0) * DM, a.in[13] + (L1 ? 2 : 0) * DM,
             (float*)(ws + (L1 ? slot(6) : slot(3))), (bf16_t*)(ws + (L1 ? slot(8) : slot(5))));
}
template <bool L1> __device__ __forceinline__ void run_gemm_sc(const Args& a, LAS unsigned char* lds) {
    unsigned char* ws = a.ws;
    pg8::Gemm g{(const bf16_t*)(ws + (L1 ? slot(8) : slot(5))), (const bf16_t*)(ws + WS_WC) + (L1 ? (size_t)DM * DM : 0), opaque(MTOK), opaque(DM), opaque(DM)};
    pg8::StaticOrder S; S.init(g.M, g.N, (int)gridDim.x, (int)blockIdx.x);
    EpiF32 E{(float*)(ws + (L1 ? slot(0) : slot(6)))};
    pg8::gemm_phase<EpiF32, pg8::StaticOrder>(lds, g, S, E, nullptr);
}
template <bool L1> __device__ __forceinline__ void run_topk(const Args& a) {
    unsigned char* ws = a.ws;
    phase_topk((const float*)(ws + (L1 ? slot(0) : slot(6))), (int*)(ws + WS_EID), (float*)(ws + WS_GATE));
}
template <bool L1> __device__ __forceinline__ void run_peer(const Args& a) {
    unsigned char* ws = a.ws;
    phase_peer((const float*)(ws + (L1 ? slot(6) : slot(3))), (const int*)(ws + WS_EID), (const float*)(ws + WS_GATE),
               (const bf16_t*)(ws + WS_UB) + (L1 ? (size_t)16384 * DM : 0), (const bf16_t*)(ws + WS_VB) + (L1 ? (size_t)16384 * DM : 0),
               a.in[12] + (L1 ? 3 : 1) * DM, a.in[13] + (L1 ? 3 : 1) * DM,
               L1 ? a.out : (float*)(ws + slot(0)), L1 ? (bf16_t*)nullptr : (bf16_t*)(ws + slot(2)));
}

__global__ void __launch_bounds__(512, 2) mk_fwd(Args a) {
    extern __shared__ __attribute__((aligned(16))) unsigned char lds_raw[];
    LAS unsigned char* lds = (LAS unsigned char*)lds_raw;
    cg::grid_group grid = cg::this_grid();
    unsigned char* ws = a.ws;
#define PHASE_BEGIN(k) if (a.ph_lo <= (k) && (k) < a.ph_hi && EN(k)) {
#define PHASE_END(k) __syncthreads(); if ((k) + 1 < a.ph_hi) grid.sync(); }
    PHASE_BEGIN(0) phase_prep(a, lds); PHASE_END(0)
    PHASE_BEGIN(1) {
        pg8::Gemm g{(const bf16_t*)(ws + slot(0)), (const bf16_t*)(ws + WS_WIN), opaque(MTOK), opaque(4 * DM), opaque(DM)};
        pg8::StaticOrder S; S.init(g.M, g.N, (int)gridDim.x, (int)blockIdx.x);
        EpiIn E{(bf16_t*)(ws + slot(1)), (float*)(ws + slot(4)), (bf16_t*)(ws + slot(2)), (bf16_t*)(ws + slot(3)), (const float*)(ws + WS_LB)};
        pg8::gemm_phase<EpiIn, pg8::StaticOrder>(lds, g, S, E, nullptr);
    } PHASE_END(1)
    PHASE_BEGIN(2) phase_scan_naive((const bf16_t*)(ws + slot(1)), (const float*)(ws + slot(4)), (const bf16_t*)(ws + slot(2)), (float*)(ws + slot(6))); PHASE_END(2)
    PHASE_BEGIN(3) phase_onorm((const float*)(ws + slot(6)), (const bf16_t*)(ws + slot(3)), a.in[2], (bf16_t*)(ws + slot(0))); PHASE_END(3)
    PHASE_BEGIN(4) run_gemm_out<false>(a, lds); PHASE_END(4)
    PHASE_BEGIN(5) run_ln<false>(a); PHASE_END(5)
    PHASE_BEGIN(6) run_gemm_sc<false>(a, lds); PHASE_END(6)
    PHASE_BEGIN(7) run_topk<false>(a); PHASE_END(7)
    PHASE_BEGIN(8) run_peer<false>(a); PHASE_END(8)
    PHASE_BEGIN(9) {
        pg8::Gemm g{(const bf16_t*)(ws + slot(2)), (const bf16_t*)(ws + WS_WKVQ), opaque(MTOK), opaque(3 * DM), opaque(DM)};
        pg8::StaticOrder S; S.init(g.M, g.N, (int)gridDim.x, (int)blockIdx.x);
        EpiKVQ E{(bf16_t*)(ws + slot(3)), (bf16_t*)(ws + slot(4)), (bf16_t*)(ws + slot(5))};
        pg8::gemm_phase<EpiKVQ, pg8::StaticOrder>(lds, g, S, E, nullptr);
    } PHASE_END(9)
    PHASE_BEGIN(10) phase_rot((LAS float*)lds, (bf16_t*)(ws + slot(3)), (bf16_t*)(ws + slot(5)), (const float*)(ws + WS_COS), (const float*)(ws + WS_SIN), (float*)(ws + WS_KMEAN), (float*)(ws + WS_KNMAX)); PHASE_END(10)
    PHASE_BEGIN(11) phase_sel(lds, (const bf16_t*)(ws + slot(5)), (const float*)(ws + WS_KMEAN), (unsigned short*)(ws + WS_SUB), (int*)(ws + WS_CNT), (int*)(ws + WS_CTR)); PHASE_END(11)
    PHASE_BEGIN(12) phase_att(lds, (const bf16_t*)(ws + slot(5)), (const bf16_t*)(ws + slot(3)), (const bf16_t*)(ws + slot(4)), (const float*)(ws + WS_KNMAX), (const unsigned short*)(ws + WS_SUB),
                              (const int*)(ws + WS_CNT), (int*)(ws + WS_CTR), (bf16_t*)(ws + slot(6)), (bf16_t*)(ws + slot(2)), (float*)(ws + WS_LS)); PHASE_END(12)
    PHASE_BEGIN(13) phase_comb((const bf16_t*)(ws + slot(6)), (const bf16_t*)(ws + slot(2)), (const float*)(ws + WS_LS), (bf16_t*)(ws + slot(3))); PHASE_END(13)
    PHASE_BEGIN(14) run_gemm_out<true>(a, lds); PHASE_END(14)
    PHASE_BEGIN(15) run_ln<true>(a); PHASE_END(15)
    PHASE_BEGIN(16) run_gemm_sc<true>(a, lds); PHASE_END(16)
    PHASE_BEGIN(17) run_topk<true>(a); PHASE_END(17)
    PHASE_BEGIN(18) run_peer<true>(a); PHASE_END(18)
}

extern "C" void kernel_launch(void* const* d_in, const int* in_sizes, int n_in, void* d_out, int out_size, void* d_ws, size_t ws_size, hipStream_t stream) {
    static int grid = 0;
    if (grid == 0) {
        if (n_in != 14 || out_size != MTOK * DM || ws_size < WS_END) { fprintf(stderr, "kernel_launch: unexpected shapes (n_in %d, out %d, ws %zu)\n", n_in, out_size, ws_size); grid = -1; return; }
        int dev = 0, cus = 0, per_cu = 0;
        if (hipGetDevice(&dev) != hipSuccess || hipDeviceGetAttribute(&cus, hipDeviceAttributeMultiprocessorCount, dev) != hipSuccess) { grid = -1; return; }
        if (hipFuncSetAttribute((const void*)mk_fwd, hipFuncAttributeMaxDynamicSharedMemorySize, LDS_BYTES) != hipSuccess) { fprintf(stderr, "kernel_launch: hipFuncSetAttribute failed\n"); grid = -1; return; }
        if (hipOccupancyMaxActiveBlocksPerMultiprocessor(&per_cu, (const void*)mk_fwd, 512, LDS_BYTES) != hipSuccess || per_cu < 1) { fprintf(stderr, "kernel_launch: occupancy query failed (%d)\n", per_cu); (void)hipGetLastError(); per_cu = 1; }
        grid = cus * (per_cu > 1 ? 1 : per_cu);
    }
    if (grid < 0) return;
    Args a{};
    for (int i = 0; i < 14; ++i) a.in[i] = (const float*)d_in[i];
    a.out = (float*)d_out; a.ws = (unsigned char*)d_ws;
#if ONE_LAUNCH
    a.ph_lo = 0; a.ph_hi = NPH;
    void* args[] = {&a};
    hipError_t e = hipLaunchCooperativeKernel((const void*)mk_fwd, dim3(grid), dim3(512), args, LDS_BYTES, stream);
    if (e != hipSuccess) fprintf(stderr, "cooperative launch failed: %s (grid %d)\n", hipGetErrorString(e), grid);
#else
    for (int ph = 0; ph < NPH; ++ph) {
        a.ph_lo = ph; a.ph_hi = ph + 1;
        hipLaunchKernelGGL(mk_fwd, dim3(grid), dim3(512), LDS_BYTES, stream, a);
    }
#endif
}
```

```cpp
#define ONE_LAUNCH 1
#include <hip/hip_runtime.h>
#include <hip/hip_cooperative_groups.h>
#include <cstdio>
namespace cg = cooperative_groups;

#ifndef ONE_LAUNCH
#define ONE_LAUNCH 0
#endif
#ifndef SCAN_DBG
#define SCAN_DBG 0
#endif
#ifndef SCAN_A_VALU
#define SCAN_A_VALU 0
#endif
#ifndef ENMASK
#define ENMASK 0xffffffffu
#endif
#define EN(k) ((ENMASK >> (k)) & 1u)

namespace pg8 {
#define PG8_LAS __attribute__((address_space(3)))
typedef unsigned short bf16_t;
typedef short bf16x8 __attribute__((ext_vector_type(8)));
typedef float f32x4 __attribute__((ext_vector_type(4)));
typedef unsigned u32x4 __attribute__((ext_vector_type(4)));
constexpr int BM = 256, BK = 64, HALF = 128, HTB = HALF * BK * 2  , STAGE_BYTES = 8 * HTB, NXCD = 8, WGM = 8;

__host__ __device__ __forceinline__ int lds_byte(int r, int c) { const int st = (r >> 4) * 2 + (c >> 5), rr = r & 15, cc = c & 31, ob = rr * 64 + cc * 2; return st * 1024 + (ob ^ (((ob >> 9) & 1) << 5)); }
__host__ __device__ __forceinline__ void stage_rc(int b, int& R, int& C) { const int st = b / 1024, sb = b % 1024, swz = sb ^ (((sb >> 9) & 1) << 5); R = (st >> 1) * 16 + swz / 64; C = (st & 1) * 32 + (swz % 64) / 2; }
__host__ __device__ __forceinline__ int perm32(int rho) { const int n = rho >> 4, i = rho & 15; return 8 * (i >> 2) + 4 * n + (i & 3); }

struct Unit { int pm, pn; };
struct Gemm { const bf16_t* A; const bf16_t* Bt; int M, N, K; };

struct StaticOrder {
    int nM, nN, nwg, G, c;
    __host__ __device__ void init(int M, int N, int G_, int c_) { nM = M / BM; nN = N / BM; nwg = nM * nN; G = G_; c = c_; }
    __host__ __device__ bool next(int i, Unit& u) const {
        const long L = (long)i * G + c; if (L >= nwg) return false;
        int wgid = (int)L; { const int q = nwg / NXCD, r = nwg % NXCD, xcd = wgid % NXCD, off = wgid / NXCD; wgid = (xcd < r ? xcd * (q + 1) : r * (q + 1) + (xcd - r) * q) + off; }
        const int nig = WGM * nN, gid = wgid / nig, fm = gid * WGM, gsz = (nM - fm) < WGM ? (nM - fm) : WGM;
        u.pm = fm + ((wgid % nig) % gsz); u.pn = (wgid % nig) / gsz; return true;
    }
    __device__ __forceinline__ void a_ready(const Unit&) const {}
    __device__ __forceinline__ void done(const Unit&) const {}
};
struct CountedOrder : StaticOrder {
    const unsigned* ready; unsigned need; unsigned* tmo;
    __device__ __forceinline__ void a_ready(const Unit& u) const {
        if (threadIdx.x < 64) {
            const unsigned long long t0 = __builtin_amdgcn_s_memrealtime(); unsigned polls = 0;
            while ((unsigned)__builtin_amdgcn_readfirstlane(__hip_atomic_load(ready + 64 * u.pm, __ATOMIC_RELAXED, __HIP_MEMORY_SCOPE_AGENT)) < need) {
                if ((++polls & 255u) == 0u && __builtin_amdgcn_readfirstlane(__hip_atomic_load(tmo, __ATOMIC_RELAXED, __HIP_MEMORY_SCOPE_AGENT)) != 0u) break;
                if (__builtin_amdgcn_s_memrealtime() - t0 > 2000000ull) {
                    if (threadIdx.x == 0) { unsigned expect = 0u; __hip_atomic_compare_exchange_strong(tmo + 1, &expect, 0x600u | (unsigned)(u.pm & 0xff), __ATOMIC_RELAXED, __ATOMIC_RELAXED, __HIP_MEMORY_SCOPE_AGENT); __hip_atomic_store(tmo, 1u, __ATOMIC_RELAXED, __HIP_MEMORY_SCOPE_AGENT); }
                    break; }
                __builtin_amdgcn_s_sleep(2); }
            __builtin_amdgcn_fence(__ATOMIC_ACQUIRE, "agent");
            asm volatile("s_waitcnt vmcnt(0)" ::: "memory");
        }
#if !defined(BROKEN_HOOK_NO_BARRIER)
        asm volatile("" ::: "memory"); __builtin_amdgcn_s_barrier(); asm volatile("" ::: "memory");
#endif
    }
};

__device__ __forceinline__ unsigned cvt_pk_bf16(float lo, float hi) { unsigned r; asm volatile("v_cvt_pk_bf16_f32 %0, %1, %2" : "=v"(r) : "v"(lo), "v"(hi)); return r; }
typedef float f32x2 __attribute__((ext_vector_type(2)));
__device__ __forceinline__ f32x2 gelu_pk(f32x2 v) {
    const f32x2 av = __builtin_elementwise_abs(v), d = av * 0.2316418882f + 1.0f;
    f32x2 t; t.x = __builtin_amdgcn_rcpf(d.x); t.y = __builtin_amdgcn_rcpf(d.y);
    f32x2 q = t * 0.5307027145f + (-0.7265760135f); q = q * t + 0.7107068705f; q = q * t + (-0.142248368f); q = q * t + 0.127414796f; q = q * t;
    const f32x2 s = (v * v) * (-0.72134752044f);
    f32x2 e; e.x = __builtin_amdgcn_exp2f(s.x); e.y = __builtin_amdgcn_exp2f(s.y);
    const f32x2 m = v * (q * e), r = v - m;
    f32x2 o; o.x = v.x < 0.f ? m.x : r.x; o.y = v.y < 0.f ? m.y : r.y; return o;
}

struct EpiF32 {
    static constexpr bool PERM = false, AFTER_DRAIN = false;
    float* C; int ldc; const float* bias;
    __device__ __forceinline__ void operator()(const f32x4 (&acc)[2][2][4][2], const Unit& u, int wr, int wc, int fr, int fq) const {
        const int row0 = u.pm * BM + wr * 64 + fr, col0 = u.pn * BM + wc * 32 + 4 * fq;
        f32x4 bv[2][2];
#pragma unroll
        for (int bj = 0; bj < 2; ++bj)
#pragma unroll
            for (int n = 0; n < 2; ++n) bv[bj][n] = bias ? *(const f32x4*)(bias + col0 + bj * HALF + n * 16) : (f32x4){0.f, 0.f, 0.f, 0.f};
#pragma unroll
        for (int ai = 0; ai < 2; ++ai)
#pragma unroll
            for (int m = 0; m < 4; ++m) { float* rowp = C + (size_t)(row0 + ai * HALF + m * 16) * ldc + col0;
#pragma unroll
                for (int bj = 0; bj < 2; ++bj)
#pragma unroll
                    for (int n = 0; n < 2; ++n) *(f32x4*)(rowp + bj * HALF + n * 16) = acc[ai][bj][m][n] + bv[bj][n]; }
    }
};
template <int ACT  > struct EpiBf16 {
    static constexpr bool PERM = true, AFTER_DRAIN = false;
    bf16_t* O; int ldc; const float* bias; int split_cols; size_t split_stride;
    __device__ __forceinline__ void operator()(const f32x4 (&acc)[2][2][4][2], const Unit& u, int wr, int wc, int fr, int fq) const {
        const int row0 = u.pm * BM + wr * 64 + fr; int colt = u.pn * BM; bf16_t* base = O;
        if (split_cols) { const int t = colt / split_cols; base += (size_t)t * split_stride; colt -= t * split_cols; }
        const int col0 = colt + wc * 32 + 8 * fq, bcol0 = u.pn * BM + wc * 32 + 8 * fq;
        f32x4 bv[2][2];
#pragma unroll
        for (int bj = 0; bj < 2; ++bj)
#pragma unroll
            for (int n = 0; n < 2; ++n) bv[bj][n] = bias ? *(const f32x4*)(bias + bcol0 + bj * HALF + 4 * n) : (f32x4){0.f, 0.f, 0.f, 0.f};
#pragma unroll
        for (int ai = 0; ai < 2; ++ai)
#pragma unroll
            for (int m = 0; m < 4; ++m) { bf16_t* rowp = base + (size_t)(row0 + ai * HALF + m * 16) * ldc + col0;
#pragma unroll
                for (int bj = 0; bj < 2; ++bj) { f32x4 v0 = acc[ai][bj][m][0] + bv[bj][0], v1 = acc[ai][bj][m][1] + bv[bj][1];
                    if (ACT == 1) { f32x2 a = gelu_pk((f32x2){v0[0], v0[1]}), b = gelu_pk((f32x2){v0[2], v0[3]}), c = gelu_pk((f32x2){v1[0], v1[1]}), d = gelu_pk((f32x2){v1[2], v1[3]});
                        v0 = (f32x4){a.x, a.y, b.x, b.y}; v1 = (f32x4){c.x, c.y, d.x, d.y}; }
                    if (ACT == 2) {
#pragma unroll
                        for (int j = 0; j < 4; ++j) { v0[j] = 0.5f * v0[j] * (1.0f + erff(v0[j] * 0.70710678f)); v1[j] = 0.5f * v1[j] * (1.0f + erff(v1[j] * 0.70710678f)); } }
                    u32x4 w; w.x = cvt_pk_bf16(v0[0], v0[1]); w.y = cvt_pk_bf16(v0[2], v0[3]); w.z = cvt_pk_bf16(v1[0], v1[1]); w.w = cvt_pk_bf16(v1[2], v1[3]);
                    *(u32x4*)(rowp + bj * HALF) = w; } }
    }
};

template <class Epi, class Sched, bool STAMP = false>
__device__ __forceinline__ void gemm_phase(PG8_LAS unsigned char* lds, const Gemm g, const Sched& S, const Epi& E, unsigned long long* stamps) {
    const int tid = threadIdx.x, wid = __builtin_amdgcn_readfirstlane(tid >> 6), lane = tid & 63, wr = wid >> 2, wc = wid & 3, fr = lane & 15, fq = lane >> 4;
    const int K = g.K, nt = K / BK;
    int ts_lo = 0, ts_hi = 0, nts = 0; const unsigned long long rt_entry = STAMP ? (unsigned long long)wall_clock64() : 0ull;
#define PG8_STAMP() do { if (STAMP && wid == 0 && nts < 64) { const unsigned long long _c = (unsigned long long)clock64(); \
        ts_lo = (lane == nts) ? (int)(unsigned)_c : ts_lo; ts_hi = (lane == nts) ? (int)(unsigned)(_c >> 32) : ts_hi; ++nts; } } while (0)
    PG8_STAMP();
    unsigned voffA[2], voffB[2];
#pragma unroll
    for (int i = 0; i < 2; ++i) { int R, C; stage_rc(tid * 16 + i * 8192, R, C); const int Rb = Epi::PERM ? ((R & ~31) + perm32(R & 31)) : R;
        voffA[i] = (unsigned)(R * K + C) * 2u; voffB[i] = (unsigned)(Rb * K + C) * 2u; }
    const size_t kstep = (size_t)(BK * 2);
    const size_t hstep = (size_t)HALF * K * 2;
    const size_t tstep = 2 * hstep;
    const unsigned ldsw = (unsigned)wid * 1024u;
    const int aoff = lds_byte(wr * 64 + fr, fq * 8), boff = lds_byte(wc * 32 + fr, fq * 8);
#define PG8_SA(b, h) (((b) * 2 + (h)) * HTB)
#define PG8_SB(b, h) ((4 + (b) * 2 + (h)) * HTB)
#define PG8_STAGE(bufoff, gbase, voff) do { _Pragma("unroll") for (int _i = 0; _i < 2; ++_i) \
        __builtin_amdgcn_global_load_lds((const unsigned*)((const char*)(gbase) + (voff)[_i]), (PG8_LAS unsigned*)(lds + (bufoff) + ldsw + _i * 8192), 16, 0, 0); } while (0)
#define PG8_LDA(dst, b, h) do { _Pragma("unroll") for (int m = 0; m < 4; ++m) _Pragma("unroll") for (int k = 0; k < 2; ++k) dst[m][k] = *(const PG8_LAS bf16x8*)(lds + PG8_SA(b, h) + aoff + m * 2048 + k * 1024); } while (0)
#define PG8_LDB(dst, b, h) do { _Pragma("unroll") for (int n = 0; n < 2; ++n) _Pragma("unroll") for (int k = 0; k < 2; ++k) dst[n][k] = *(const PG8_LAS bf16x8*)(lds + PG8_SB(b, h) + boff + n * 2048 + k * 1024); } while (0)
#define PG8_MMA(ai, bj, At, Bt) do { __builtin_amdgcn_s_setprio(1); _Pragma("unroll") for (int m = 0; m < 4; ++m) _Pragma("unroll") for (int n = 0; n < 2; ++n) _Pragma("unroll") for (int k = 0; k < 2; ++k) \
        acc[ai][bj][m][n] = __builtin_amdgcn_mfma_f32_16x16x32_bf16(Bt[n][k], At[m][k], acc[ai][bj][m][n], 0, 0, 0); __builtin_amdgcn_s_setprio(0); } while (0)
#define PG8_WAIT_V(n) asm volatile("s_waitcnt vmcnt(" #n ")" ::: "memory")
#define PG8_WAIT_L(n) asm volatile("s_waitcnt lgkmcnt(" #n ")" ::: "memory")
#define PG8_BAR __builtin_amdgcn_s_barrier()
#define PG8_SCHED __builtin_amdgcn_sched_barrier(0)
    Unit cur, nxt; int ui = 0;
    if (!S.next(0, cur)) return;
    f32x4 acc[2][2][4][2];
#pragma unroll
    for (int a = 0; a < 2; ++a)
#pragma unroll
        for (int b = 0; b < 2; ++b)
#pragma unroll
            for (int m = 0; m < 4; ++m)
#pragma unroll
                for (int n = 0; n < 2; ++n) acc[a][b][m][n] = (f32x4){0.f, 0.f, 0.f, 0.f};
    bf16x8 At[4][2], B0[2][2], B1[2][2];
    const char* cA = (const char*)g.A + (size_t)cur.pm * tstep; const char* cB = (const char*)g.Bt + (size_t)cur.pn * tstep;
    S.a_ready(cur);
    PG8_STAGE(PG8_SB(0, 0), cB, voffB); PG8_STAGE(PG8_SA(0, 0), cA, voffA); PG8_STAGE(PG8_SB(0, 1), cB + hstep, voffB); PG8_STAGE(PG8_SA(0, 1), cA + hstep, voffA);
    if (wr == 1) PG8_BAR;
    PG8_WAIT_V(4); PG8_BAR;
    PG8_STAGE(PG8_SB(1, 0), cB + kstep, voffB); PG8_STAGE(PG8_SA(1, 0), cA + kstep, voffA); PG8_STAGE(PG8_SB(1, 1), cB + hstep + kstep, voffB);
    PG8_WAIT_V(6); PG8_BAR;
    PG8_STAMP();
    for (;;) {
        const bool has_next = S.next(ui + 1, nxt);
        const char* nA = has_next ? (const char*)g.A + (size_t)nxt.pm * tstep : cA; const char* nB = has_next ? (const char*)g.Bt + (size_t)nxt.pn * tstep : cB;
        for (int t = 0; t < nt; t += 2) {
            const bool last = (t == nt - 2);
            const char* a1 = cA + (size_t)(t + 1) * kstep;
            const char* a2 = last ? nA : cA + (size_t)(t + 2) * kstep; const char* b2 = last ? nB : cB + (size_t)(t + 2) * kstep;
            const char* a3 = a2 + kstep; const char* b3 = b2 + kstep;
            if (last && has_next) S.a_ready(nxt);
            PG8_LDB(B0, 0, 0); PG8_SCHED; PG8_LDA(At, 0, 0); PG8_STAGE(PG8_SA(1, 1), a1 + hstep, voffA);
            PG8_WAIT_L(8); PG8_BAR; PG8_WAIT_L(0); PG8_MMA(0, 0, At, B0); PG8_BAR; PG8_SCHED;
            PG8_LDB(B1, 0, 1); PG8_STAGE(PG8_SB(0, 0), b2, voffB);
            PG8_BAR; PG8_WAIT_L(0); PG8_MMA(0, 1, At, B1); PG8_BAR;
            PG8_LDA(At, 0, 1); PG8_STAGE(PG8_SA(0, 0), a2, voffA);
            PG8_BAR; PG8_WAIT_L(0); PG8_MMA(1, 0, At, B0); PG8_BAR; PG8_SCHED;
            PG8_STAGE(PG8_SB(0, 1), b2 + hstep, voffB);
            PG8_WAIT_V(6); PG8_BAR; PG8_MMA(1, 1, At, B1); PG8_BAR;
            PG8_LDB(B0, 1, 0); PG8_SCHED; PG8_LDA(At, 1, 0); PG8_STAGE(PG8_SA(0, 1), a2 + hstep, voffA);
            PG8_WAIT_L(8); PG8_BAR; PG8_WAIT_L(0); PG8_MMA(0, 0, At, B0); PG8_BAR; PG8_SCHED;
            PG8_LDB(B1, 1, 1); PG8_STAGE(PG8_SB(1, 0), b3, voffB);
            PG8_BAR; PG8_WAIT_L(0); PG8_MMA(0, 1, At, B1); PG8_BAR;
            PG8_LDA(At, 1, 1); PG8_STAGE(PG8_SA(1, 0), a3, voffA);
            PG8_BAR; PG8_WAIT_L(0); PG8_MMA(1, 0, At, B0); PG8_BAR; PG8_SCHED;
            PG8_STAGE(PG8_SB(1, 1), b3 + hstep, voffB);
            PG8_WAIT_V(6); PG8_BAR; PG8_MMA(1, 1, At, B1); PG8_BAR;
        }
        PG8_STAMP();
        if constexpr (!Epi::AFTER_DRAIN) { E(acc, cur, wr, wc, fr, fq); S.done(cur); }
        PG8_STAMP();
        if (!has_next) break;
#pragma unroll
        for (int a = 0; a < 2; ++a)
#pragma unroll
            for (int b = 0; b < 2; ++b)
#pragma unroll
                for (int m = 0; m < 4; ++m)
#pragma unroll
                    for (int n = 0; n < 2; ++n) acc[a][b][m][n] = (f32x4){0.f, 0.f, 0.f, 0.f};
        cur = nxt; cA = nA; cB = nB; ++ui;
    }
    PG8_WAIT_V(0);
    if (wr == 0) PG8_BAR;
    PG8_BAR;
    if constexpr (Epi::AFTER_DRAIN) { E.fused(acc, cur, wr, wc, fr, fq, lds, wid, lane); S.done(cur); }
    PG8_STAMP();
    if (STAMP && wid == 0) { stamps[lane] = lane < nts ? (((unsigned long long)(unsigned)ts_hi << 32) | (unsigned)ts_lo) : 0ull;
        if (lane == 62) stamps[62] = rt_entry; if (lane == 63) stamps[63] = (unsigned long long)wall_clock64(); }
#undef PG8_STAMP
#undef PG8_SA
#undef PG8_SB
#undef PG8_STAGE
#undef PG8_LDA
#undef PG8_LDB
#undef PG8_MMA
#undef PG8_WAIT_V
#undef PG8_WAIT_L
#undef PG8_BAR
#undef PG8_SCHED
}
}


#define LAS __attribute__((address_space(3)))
typedef unsigned short bf16_t;
typedef float f32x4 __attribute__((ext_vector_type(4)));
typedef unsigned u32x4 __attribute__((ext_vector_type(4)));
typedef unsigned u32x2 __attribute__((ext_vector_type(2)));

constexpr int MTOK = 16384, DM = 2048, SEQ = 8192, NHEAD = 16;
constexpr float ALPHA = 1.41421356237309515f;
constexpr size_t MiB = (size_t)1 << 20;
constexpr size_t WS_WIN = 0, WS_WOUT = 32 * MiB, WS_WKVQ = 40 * MiB, WS_WO = 64 * MiB, WS_WC = 72 * MiB, WS_UB = 88 * MiB, WS_VB = 216 * MiB, WS_SLOT = 344 * MiB;
constexpr size_t WS_EID = 920 * MiB, WS_GATE = 928 * MiB, WS_COS = 936 * MiB, WS_SIN = 938 * MiB, WS_KMEAN = 940 * MiB, WS_LB = 941 * MiB, WS_LS = 942 * MiB, WS_SUB = 946 * MiB, WS_CNT = 962 * MiB, WS_CTR = 963 * MiB, WS_DEC = 964 * MiB, WS_END = 966 * MiB;
constexpr size_t WS_KNMAX = WS_KMEAN + 768 * 1024;
__host__ __device__ constexpr size_t slot(int i) { return WS_SLOT + (size_t)i * 64 * MiB; }
constexpr int LDS_BYTES = 144 * 1024;
constexpr int NPH = 20;

struct Args { const float* in[14]; float* out; unsigned char* ws; int ph_lo, ph_hi; };

__device__ __forceinline__ float bflo(unsigned w) { return __uint_as_float(w << 16); }
__device__ __forceinline__ float bfhi(unsigned w) { return __uint_as_float(w & 0xffff0000u); }
__device__ __forceinline__ float bf2f(bf16_t b) { return __uint_as_float(((unsigned)b) << 16); }
typedef __bf16 bf16x2_t __attribute__((ext_vector_type(2)));
typedef float f32x2_t __attribute__((ext_vector_type(2)));
__device__ __forceinline__ unsigned pk_bf16(float lo, float hi) { const f32x2_t f = {lo, hi}; return __builtin_bit_cast(unsigned, __builtin_convertvector(f, bf16x2_t)); }
__device__ __forceinline__ float wave_sum(float v) {
#pragma unroll
    for (int o = 32; o >= 1; o >>= 1) v += __shfl_xor(v, o);
    return v;
}
__device__ __forceinline__ float wave_max(float v) {
#pragma unroll
    for (int o = 32; o >= 1; o >>= 1) v = fmaxf(v, __shfl_xor(v, o));
    return v;
}
__device__ __forceinline__ float sigmoidf_(float z) { return 1.0f / (1.0f + __expf(-z)); }


__device__ __forceinline__ void store_wt16(void* p, u32x4 v) {
    __hip_atomic_store((unsigned long long*)p, ((unsigned long long)v.y << 32) | v.x, __ATOMIC_RELAXED, __HIP_MEMORY_SCOPE_AGENT);
    __hip_atomic_store((unsigned long long*)p + 1, ((unsigned long long)v.w << 32) | v.z, __ATOMIC_RELAXED, __HIP_MEMORY_SCOPE_AGENT);
}
__device__ __forceinline__ void store_wt8(void* p, u32x2 v) {
    __hip_atomic_store((unsigned long long*)p, ((unsigned long long)v.y << 32) | v.x, __ATOMIC_RELAXED, __HIP_MEMORY_SCOPE_AGENT);
}
struct EpiIn {
    static constexpr bool PERM = true, AFTER_DRAIN = false;
    bf16_t* Q1; float* LF; bf16_t* I1; bf16_t* G1; const float* LB;
    __device__ __forceinline__ void operator()(const pg8::f32x4 (&acc)[2][2][4][2], const pg8::Unit& u, int wr, int wc, int fr, int fq) const {
        const int type = u.pn >> 3;
        const int row0 = u.pm * 256 + wr * 64 + fr, col0 = (u.pn & 7) * 256 + wc * 32 + 8 * fq;
        if (type == 1) {
#pragma unroll
            for (int bj = 0; bj < 2; ++bj) {
                const int c = col0 + bj * 128;
                const f32x4 lb0 = *(const f32x4*)(LB + c), lb1 = *(const f32x4*)(LB + c + 4);
#pragma unroll
                for (int ai = 0; ai < 2; ++ai)
#pragma unroll
                    for (int m = 0; m < 4; ++m) {
                        float* p = LF + (size_t)(row0 + ai * 128 + m * 16) * DM + c;
                        f32x4 o0, o1;
#pragma unroll
                        for (int j = 0; j < 4; ++j) {
                            o0[j] = __logf(lb0[j] + (1.0f - lb0[j]) * sigmoidf_(acc[ai][bj][m][0][j]));
                            o1[j] = __logf(lb1[j] + (1.0f - lb1[j]) * sigmoidf_(acc[ai][bj][m][1][j]));
                        }
                        *(f32x4*)p = o0; *(f32x4*)(p + 4) = o1;
                    }
            }
        } else {
            bf16_t* dst = Q1 + (size_t)(type - (type > 0 ? 1 : 0)) * ((size_t)32 << 20);
            const bool act = (type != 2);
#pragma unroll
            for (int ai = 0; ai < 2; ++ai)
#pragma unroll
                for (int m = 0; m < 4; ++m)
#pragma unroll
                    for (int bj = 0; bj < 2; ++bj) {
                        f32x4 v0 = acc[ai][bj][m][0], v1 = acc[ai][bj][m][1];
                        if (act) {
#pragma unroll
                            for (int j = 0; j < 4; ++j) { v0[j] = v0[j] * sigmoidf_(v0[j]); v1[j] = v1[j] * sigmoidf_(v1[j]); }
                        }
                        u32x4 w; w.x = pk_bf16(v0[0], v0[1]); w.y = pk_bf16(v0[2], v0[3]); w.z = pk_bf16(v1[0], v1[1]); w.w = pk_bf16(v1[2], v1[3]);
                        *(u32x4*)(dst + (size_t)(row0 + ai * 128 + m * 16) * DM + col0 + bj * 128) = w;
                    }
        }
    }
};
struct EpiRes {
    static constexpr bool PERM = false, AFTER_DRAIN = false;
    const float* res; float* Y;
    __device__ __forceinline__ void operator()(const pg8::f32x4 (&acc)[2][2][4][2], const pg8::Unit& u, int wr, int wc, int fr, int fq) const {
        const int row0 = u.pm * 256 + wr * 64 + fr, col0 = u.pn * 256 + wc * 32 + 4 * fq;
#pragma unroll
        for (int ai = 0; ai < 2; ++ai)
#pragma unroll
            for (int m = 0; m < 4; ++m) {
                const size_t off = (size_t)(row0 + ai * 128 + m * 16) * DM + col0;
#pragma unroll
                for (int bj = 0; bj < 2; ++bj)
#pragma unroll
                    for (int n = 0; n < 2; ++n) {
                        const f32x4 r = *(const f32x4*)(res + off + bj * 128 + n * 16);
                        *(f32x4*)(Y + off + bj * 128 + n * 16) = r * ALPHA + acc[ai][bj][m][n];
                    }
            }
    }
};
struct EpiF32 {
    static constexpr bool PERM = false, AFTER_DRAIN = false;
    float* C;
    __device__ __forceinline__ void operator()(const pg8::f32x4 (&acc)[2][2][4][2], const pg8::Unit& u, int wr, int wc, int fr, int fq) const {
        const int row0 = u.pm * 256 + wr * 64 + fr, col0 = u.pn * 256 + wc * 32 + 4 * fq;
#pragma unroll
        for (int ai = 0; ai < 2; ++ai)
#pragma unroll
            for (int m = 0; m < 4; ++m) {
                float* p = C + (size_t)(row0 + ai * 128 + m * 16) * DM + col0;
#pragma unroll
                for (int bj = 0; bj < 2; ++bj)
#pragma unroll
                    for (int n = 0; n < 2; ++n) *(f32x4*)(p + bj * 128 + n * 16) = acc[ai][bj][m][n];
            }
    }
};
struct EpiKVQ {
    static constexpr bool PERM = true, AFTER_DRAIN = false;
    bf16_t* K; bf16_t* V; bf16_t* Q;
    __device__ __forceinline__ void operator()(const pg8::f32x4 (&acc)[2][2][4][2], const pg8::Unit& u, int wr, int wc, int fr, int fq) const {
        const int t = u.pn >> 3;
        bf16_t* dst = K + (size_t)t * ((size_t)32 << 20);
        const int row0 = u.pm * 256 + wr * 64 + fr, col0 = (u.pn & 7) * 256 + wc * 32 + 8 * fq;
#pragma unroll
        for (int ai = 0; ai < 2; ++ai)
#pragma unroll
            for (int m = 0; m < 4; ++m)
#pragma unroll
                for (int bj = 0; bj < 2; ++bj) {
                    const f32x4 v0 = acc[ai][bj][m][0], v1 = acc[ai][bj][m][1];
                    u32x4 w; w.x = pk_bf16(v0[0], v0[1]); w.y = pk_bf16(v0[2], v0[3]); w.z = pk_bf16(v1[0], v1[1]); w.w = pk_bf16(v1[2], v1[3]);
                    *(u32x4*)(dst + (size_t)(row0 + ai * 128 + m * 16) * DM + col0 + bj * 128) = w;
                }
    }
};

__device__ __forceinline__ void transpose_tiles(LAS float* tile, const float* src, int ldn, int K, int N, bf16_t* dst) {
    const int tid = threadIdx.x;
    const int tn = N / 64, ntiles = tn * (K / 64);
    for (int tI = blockIdx.x; tI < ntiles; tI += gridDim.x) {
        const int k0 = (tI / tn) * 64, n0 = (tI % tn) * 64;
#pragma unroll
        for (int r = 0; r < 2; ++r) {
            const int kk = (tid >> 4) + 32 * r, nn = (tid & 15) * 4;
            const f32x4 v = *(const f32x4*)(src + (size_t)(k0 + kk) * ldn + n0 + nn);
            tile[kk * 65 + nn + 0] = v[0]; tile[kk * 65 + nn + 1] = v[1]; tile[kk * 65 + nn + 2] = v[2]; tile[kk * 65 + nn + 3] = v[3];
        }
        __syncthreads();
        {
            const int nn = tid >> 3, kk8 = (tid & 7) * 8;
            float f[8];
#pragma unroll
            for (int j = 0; j < 8; ++j) f[j] = tile[(kk8 + j) * 65 + nn];
            u32x4 w; w.x = pk_bf16(f[0], f[1]); w.y = pk_bf16(f[2], f[3]); w.z = pk_bf16(f[4], f[5]); w.w = pk_bf16(f[6], f[7]);
            *(u32x4*)(dst + (size_t)(n0 + nn) * K + k0 + kk8) = w;
        }
        __syncthreads();
    }
}
__device__ __forceinline__ void convert_bf16(const float* src, bf16_t* dst, size_t n) {
    const size_t stride = (size_t)gridDim.x * 512 * 8;
    for (size_t i = ((size_t)blockIdx.x * 512 + threadIdx.x) * 8; i < n; i += stride) {
        const f32x4 a = *(const f32x4*)(src + i), b = *(const f32x4*)(src + i + 4);
        u32x4 w; w.x = pk_bf16(a[0], a[1]); w.y = pk_bf16(a[2], a[3]); w.z = pk_bf16(b[0], b[1]); w.w = pk_bf16(b[2], b[3]);
        *(u32x4*)(dst + i) = w;
    }
}
__device__ __forceinline__ void fold_peer_keys(LAS float* lds, const float* w_query, const float* sub_keys, bf16_t* WcT) {
    const int tid = threadIdx.x;
    LAS float* Ss = lds;
    LAS float* Ws = lds + 128 * 132;
    for (int item = blockIdx.x; item < 1024; item += gridDim.x) {
        const int l = item >> 9, rem = item & 511, hh = rem >> 5, kb = rem & 31, h = hh >> 1, half = hh & 1;
        const float* sk = sub_keys + (size_t)(((l * 2 + half) * 8 + h) * 128) * 128;
        const float* wq = w_query + (size_t)l * DM * DM + (size_t)(kb * 64) * DM + h * 256 + half * 128;
#pragma unroll
        for (int r = 0; r < 8; ++r) { const int idx = tid + 512 * r, key = idx >> 5, d4 = (idx & 31) * 4; *(LAS f32x4*)(Ss + key * 132 + d4) = *(const f32x4*)(sk + key * 128 + d4); }
#pragma unroll
        for (int r = 0; r < 4; ++r) { const int idx = tid + 512 * r, kin = idx >> 5, d4 = (idx & 31) * 4; *(LAS f32x4*)(Ws + kin * 128 + d4) = *(const f32x4*)(wq + (size_t)kin * DM + d4); }
        __syncthreads();
        const int key = tid & 127, kq = tid >> 7;
        float acc[16];
#pragma unroll
        for (int j = 0; j < 16; ++j) acc[j] = 0.f;
        for (int d4 = 0; d4 < 32; ++d4) {
            const f32x4 s4 = *(const LAS f32x4*)(Ss + key * 132 + d4 * 4);
#pragma unroll
            for (int j = 0; j < 16; ++j) { const f32x4 w4 = *(const LAS f32x4*)(Ws + (kq * 16 + j) * 128 + d4 * 4); acc[j] += s4[0] * w4[0] + s4[1] * w4[1] + s4[2] * w4[2] + s4[3] * w4[3]; }
        }
        bf16_t* o = WcT + (size_t)l * DM * DM + (size_t)(h * 256 + half * 128 + key) * DM + kb * 64 + kq * 16;
        u32x4 w0, w1;
        w0.x = pk_bf16(acc[0], acc[1]); w0.y = pk_bf16(acc[2], acc[3]); w0.z = pk_bf16(acc[4], acc[5]); w0.w = pk_bf16(acc[6], acc[7]);
        w1.x = pk_bf16(acc[8], acc[9]); w1.y = pk_bf16(acc[10], acc[11]); w1.z = pk_bf16(acc[12], acc[13]); w1.w = pk_bf16(acc[14], acc[15]);
        *(u32x4*)o = w0; *(u32x4*)(o + 8) = w1;
        __syncthreads();
    }
}
__device__ __forceinline__ void phase_prep(const Args& a, LAS unsigned char* lds) {
    unsigned char* ws = a.ws;
    LAS float* tile = (LAS float*)lds;
    transpose_tiles(tile, a.in[1], 4 * DM, DM, 4 * DM, (bf16_t*)(ws + WS_WIN));
    transpose_tiles(tile, a.in[3], DM, DM, DM, (bf16_t*)(ws + WS_WOUT));
    transpose_tiles(tile, a.in[5], 2 * DM, DM, 2 * DM, (bf16_t*)(ws + WS_WKVQ));
    transpose_tiles(tile, a.in[6], DM, DM, DM, (bf16_t*)(ws + WS_WKVQ) + (size_t)2 * DM * DM);
    transpose_tiles(tile, a.in[7], DM, DM, DM, (bf16_t*)(ws + WS_WO));
    fold_peer_keys((LAS float*)lds, a.in[8], a.in[9], (bf16_t*)(ws + WS_WC));
    convert_bf16(a.in[0], (bf16_t*)(ws + slot(0)), (size_t)MTOK * DM);
    convert_bf16(a.in[10], (bf16_t*)(ws + WS_UB), (size_t)2 * 16384 * DM);
    convert_bf16(a.in[11], (bf16_t*)(ws + WS_VB), (size_t)2 * 16384 * DM);
    const int gtid = blockIdx.x * 512 + threadIdx.x, gthreads = gridDim.x * 512;
    float* COS = (float*)(ws + WS_COS); float* SIN = (float*)(ws + WS_SIN); float* LB = (float*)(ws + WS_LB);
    for (int i = gtid; i < SEQ * 64; i += gthreads) {
        const int pos = i >> 6, j = i & 63;
        double inv = 1.0; const double r = 0.86596432336006535;
        for (int q = 0; q < j; ++q) inv *= r;
        const float ang = (float)pos * (float)inv;
        const double x = (double)ang;
        const double n = __builtin_rint(x * 0.15915494309189535);
        const float rf = (float)__builtin_fma(-n, 6.283185307179586, x);
        COS[i] = cosf(rf); SIN[i] = sinf(rf);
    }
    for (int c = gtid; c < DM; c += gthreads) { const float l0 = a.in[4][c], l1 = a.in[4][DM + c]; LB[c] = 1.0f / (1.0f + expf(l1 - l0)); }
}

__device__ __forceinline__ void phase_scan_naive(const bf16_t* Q1, const float* LF, const bf16_t* I1, float* O) {
    const int lane = threadIdx.x & 63, gw = blockIdx.x * 8 + (threadIdx.x >> 6), nw = gridDim.x * 8;
    for (int item = gw; item < 2 * NHEAD * 128; item += nw) {
        const int bh = item >> 7, v = item & 127, b = bh >> 4, h = bh & 15;
        const size_t base = (size_t)b * SEQ * DM + h * 128;
        float S0 = 0.f, S1 = 0.f;
#pragma unroll 4
        for (int t = 0; t < SEQ; ++t) {
            const size_t ro = base + (size_t)t * DM;
            const float f0 = __expf(LF[ro + lane]), f1 = __expf(LF[ro + 64 + lane]);
            const float q0 = bf2f(Q1[ro + lane]), q1 = bf2f(Q1[ro + 64 + lane]);
            const float iv = bf2f(I1[ro + v]);
            S0 = f0 * S0 + (1.0f - f0) * iv; S1 = f1 * S1 + (1.0f - f1) * iv;
            const float p = wave_sum(q0 * S0 + q1 * S1);
            if (lane == 0) O[ro + v] = p;
        }
    }
}
__device__ __forceinline__ void phase_onorm(const float* O, const bf16_t* G1, const float* gnorm, bf16_t* OG) {
    const int lane = threadIdx.x & 63, gw = blockIdx.x * 8 + (threadIdx.x >> 6), nw = gridDim.x * 8;
    const float gn0 = gnorm[2 * lane], gn1 = gnorm[2 * lane + 1];
    for (int item = gw; item < MTOK * NHEAD; item += nw) {
        const size_t off = (size_t)item * 128 + 2 * lane;
        const float o0 = O[off], o1 = O[off + 1];
        const float ss = wave_sum(o0 * o0 + o1 * o1);
        const float r = rsqrtf(ss * (1.0f / 128.0f) + 1e-6f);
        const unsigned g = *(const unsigned*)(G1 + off);
        *(unsigned*)(OG + off) = pk_bf16(o0 * r * gn0 * bflo(g), o1 * r * gn1 * bfhi(g));
    }
}

__device__ __forceinline__ void ln_row_store(float (&v)[32], const float* g, const float* bta, float* outf, bf16_t* outb, int lane) {
    float s = 0.f;
#pragma unroll
    for (int i = 0; i < 32; ++i) s += v[i];
    const float mu = wave_sum(s) * (1.0f / DM);
    float q = 0.f;
#pragma unroll
    for (int i = 0; i < 32; ++i) { v[i] -= mu; q += v[i] * v[i]; }
    const float rstd = rsqrtf(wave_sum(q) * (1.0f / DM) + 1e-5f);
#pragma unroll
    for (int i = 0; i < 4; ++i) {
        const int c = 512 * i + 8 * lane;
        const f32x4 g0 = *(const f32x4*)(g + c), g1 = *(const f32x4*)(g + c + 4), b0 = *(const f32x4*)(bta + c), b1 = *(const f32x4*)(bta + c + 4);
        f32x4 o0, o1;
#pragma unroll
        for (int j = 0; j < 4; ++j) { o0[j] = v[i * 8 + j] * rstd * g0[j] + b0[j]; o1[j] = v[i * 8 + 4 + j] * rstd * g1[j] + b1[j]; }
        *(f32x4*)(outf + c) = o0; *(f32x4*)(outf + c + 4) = o1;
        if (outb) { u32x4 w; w.x = pk_bf16(o0[0], o0[1]); w.y = pk_bf16(o0[2], o0[3]); w.z = pk_bf16(o1[0], o1[1]); w.w = pk_bf16(o1[2], o1[3]); *(u32x4*)(outb + c) = w; }
    }
}
__device__ __forceinline__ void phase_ln(const float* Y, const float* g, const float* bta, float* outf, bf16_t* outb) {
    const int lane = threadIdx.x & 63, gw = blockIdx.x * 8 + (threadIdx.x >> 6), nw = gridDim.x * 8;
    for (int row = gw; row < MTOK; row += nw) {
        float v[32];
        const float* p = Y + (size_t)row * DM;
#pragma unroll
        for (int i = 0; i < 4; ++i) {
            const f32x4 a = *(const f32x4*)(p + 512 * i + 8 * lane), b = *(const f32x4*)(p + 512 * i + 8 * lane + 4);
#pragma unroll
            for (int j = 0; j < 4; ++j) { v[i * 8 + j] = a[j]; v[i * 8 + 4 + j] = b[j]; }
        }
        ln_row_store(v, g, bta, outf + (size_t)row * DM, outb ? outb + (size_t)row * DM : nullptr, lane);
    }
}

__device__ __forceinline__ void wave_argmax(float& v, int& idx) {
#pragma unroll
    for (int o = 32; o >= 1; o >>= 1) {
        const float ov = __shfl_xor(v, o); const int oi = __shfl_xor(idx, o);
        if (ov > v || (ov == v && oi < idx)) { v = ov; idx = oi; }
    }
}
__device__ __forceinline__ void phase_topk(const float* SC, int* EID, float* GATE) {
    const int lane = threadIdx.x & 63, gw = blockIdx.x * 8 + (threadIdx.x >> 6), nw = gridDim.x * 8;
    const float NINF = -__builtin_inff();
    for (int item = gw; item < MTOK * 8; item += nw) {
        const float* p = SC + (size_t)item * 256;
        float a0 = p[lane], a1 = p[64 + lane], b0 = p[128 + lane], b1 = p[192 + lane];
        float v1 = NINF, v2 = NINF; int i1 = 0, i2 = 0;
        for (int r = 0; r < 16; ++r) {
            float va = a0 >= a1 ? a0 : a1; int ia = a0 >= a1 ? lane : lane + 64;
            float vb = b0 >= b1 ? b0 : b1; int ib = b0 >= b1 ? lane : lane + 64;
            wave_argmax(va, ia); wave_argmax(vb, ib);
            if (lane == r) { v1 = va; i1 = ia; v2 = vb; i2 = ib; }
            if (ia == lane) a0 = NINF; if (ia == lane + 64) a1 = NINF;
            if (ib == lane) b0 = NINF; if (ib == lane + 64) b1 = NINF;
        }
        const float vb_ = __shfl(v2, lane & 15);
        float c0 = __shfl(v1, (lane >> 4)) + vb_, c1 = __shfl(v1, (lane >> 4) + 4) + vb_, c2 = __shfl(v1, (lane >> 4) + 8) + vb_, c3 = __shfl(v1, (lane >> 4) + 12) + vb_;
        float best = NINF; int flat = 0; float bmax = 0.f;
        for (int r = 0; r < 16; ++r) {
            float v = c0; int id = lane;
            if (c1 > v) { v = c1; id = lane + 64; }
            if (c2 > v) { v = c2; id = lane + 128; }
            if (c3 > v) { v = c3; id = lane + 192; }
            wave_argmax(v, id);
            if (r == 0) bmax = v;
            if (lane == r) { best = v; flat = id; }
            if ((id & 63) == lane) { const int c = id >> 6; if (c == 0) c0 = NINF; else if (c == 1) c1 = NINF; else if (c == 2) c2 = NINF; else c3 = NINF; }
        }
        const float e = lane < 16 ? __expf(best - bmax) : 0.f;
        const float sum = wave_sum(e);
        const int ea = __shfl(i1, flat >> 4), eb = __shfl(i2, flat & 15);
        if (lane < 16) { EID[(size_t)item * 16 + lane] = ea * 128 + eb; GATE[(size_t)item * 16 + lane] = e / sum; }
    }
}

__device__ __forceinline__ float gelu_erf(float x) { return 0.5f * x * (1.0f + erff(x * 0.70710678118654752f)); }
__device__ __forceinline__ void phase_peer(const float* X, const int* EID, const float* GATE, const bf16_t* U, const bf16_t* V, const float* g, const float* bta, float* outf, bf16_t* outb) {
    const int lane = threadIdx.x & 63, gw = blockIdx.x * 8 + (threadIdx.x >> 6), nw = gridDim.x * 8;
    for (int tok = gw; tok < MTOK; tok += nw) {
        float x[32];
        const float* xp = X + (size_t)tok * DM;
#pragma unroll
        for (int i = 0; i < 4; ++i) {
            const f32x4 a = *(const f32x4*)(xp + 512 * i + 8 * lane), b = *(const f32x4*)(xp + 512 * i + 8 * lane + 4);
#pragma unroll
            for (int j = 0; j < 4; ++j) { x[i * 8 + j] = a[j]; x[i * 8 + 4 + j] = b[j]; }
        }
        const int e0 = EID[(size_t)tok * 128 + lane], e1 = EID[(size_t)tok * 128 + 64 + lane];
        const float g0 = GATE[(size_t)tok * 128 + lane], g1 = GATE[(size_t)tok * 128 + 64 + lane];
        float h0 = 0.f, h1 = 0.f;
#pragma unroll 4
        for (int e = 0; e < 128; ++e) {
            const int idx = __builtin_amdgcn_readfirstlane(__shfl(e < 64 ? e0 : e1, e & 63));
            const u32x4* up = (const u32x4*)(U + (size_t)idx * DM) + lane;
            float d = 0.f;
#pragma unroll
            for (int i = 0; i < 4; ++i) {
                const u32x4 w = up[i * 64];
                d += x[i * 8 + 0] * bflo(w.x) + x[i * 8 + 1] * bfhi(w.x) + x[i * 8 + 2] * bflo(w.y) + x[i * 8 + 3] * bfhi(w.y)
                   + x[i * 8 + 4] * bflo(w.z) + x[i * 8 + 5] * bfhi(w.z) + x[i * 8 + 6] * bflo(w.w) + x[i * 8 + 7] * bfhi(w.w);
            }
            d = wave_sum(d);
            if (e < 64) { if (lane == e) h0 = d; } else { if (lane == e - 64) h1 = d; }
        }
        const float w0 = g0 * gelu_erf(h0), w1 = g1 * gelu_erf(h1);
        float y[32];
#pragma unroll
        for (int i = 0; i < 32; ++i) y[i] = 0.f;
#pragma unroll 4
        for (int e = 0; e < 128; ++e) {
            const int idx = __builtin_amdgcn_readfirstlane(__shfl(e < 64 ? e0 : e1, e & 63));
            const float wt = __shfl(e < 64 ? w0 : w1, e & 63);
            const u32x4* vp = (const u32x4*)(V + (size_t)idx * DM) + lane;
#pragma unroll
            for (int i = 0; i < 4; ++i) {
                const u32x4 w = vp[i * 64];
                y[i * 8 + 0] += wt * bflo(w.x); y[i * 8 + 1] += wt * bfhi(w.x); y[i * 8 + 2] += wt * bflo(w.y); y[i * 8 + 3] += wt * bfhi(w.y);
                y[i * 8 + 4] += wt * bflo(w.z); y[i * 8 + 5] += wt * bfhi(w.z); y[i * 8 + 6] += wt * bflo(w.w); y[i * 8 + 7] += wt * bfhi(w.w);
            }
        }
#pragma unroll
        for (int i = 0; i < 32; ++i) y[i] += ALPHA * x[i];
        ln_row_store(y, g, bta, outf + (size_t)tok * DM, outb ? outb + (size_t)tok * DM : nullptr, lane);
    }
}

__device__ __forceinline__ void phase_rot(LAS float* red, bf16_t* KR, bf16_t* QR, const float* COS, const float* SIN, float* KMEAN, float* KNMAX) {
    const int tid = threadIdx.x, d = tid & 63, rg = tid >> 6;
    for (int item = blockIdx.x; item < 2 * NHEAD * 32; item += gridDim.x) {
        const int bh = item >> 5, j = item & 31, b = bh >> 4, h = bh & 15;
        float s1 = 0.f, s2 = 0.f, nmax = 0.f;
        for (int i = 0; i < 32; ++i) {
            const int pos = j * 256 + rg * 32 + i;
            const size_t off = ((size_t)b * SEQ + pos) * DM + h * 128 + d;
            const float c = COS[pos * 64 + d], s = SIN[pos * 64 + d];
            const float k1 = bf2f(KR[off]), k2 = bf2f(KR[off + 64]);
            const float o1 = k1 * c - k2 * s, o2 = k1 * s + k2 * c;
            s1 += o1; s2 += o2;
            nmax = fmaxf(nmax, wave_sum(o1 * o1 + o2 * o2));
            KR[off] = (bf16_t)(pk_bf16(o1, 0.f) & 0xffffu); KR[off + 64] = (bf16_t)(pk_bf16(o2, 0.f) & 0xffffu);
            const float q1 = bf2f(QR[off]), q2 = bf2f(QR[off + 64]);
            QR[off] = (bf16_t)(pk_bf16(q1 * c - q2 * s, 0.f) & 0xffffu); QR[off + 64] = (bf16_t)(pk_bf16(q1 * s + q2 * c, 0.f) & 0xffffu);
        }
        red[rg * 128 + d] = s1; red[rg * 128 + 64 + d] = s2;
        if (d == 0) red[1024 + rg] = nmax;
        __syncthreads();
        if (tid < 128) {
            float s = 0.f;
#pragma unroll
            for (int r = 0; r < 8; ++r) s += red[r * 128 + tid];
            KMEAN[(size_t)item * 128 + tid] = s * (1.0f / 256.0f);
        }
        if (tid == 0) {
            float m = 0.f;
#pragma unroll
            for (int r = 0; r < 8; ++r) m = fmaxf(m, red[1024 + r]);
            KNMAX[item] = sqrtf(m);
        }
        __syncthreads();
    }
}

__device__ __forceinline__ void phase_sel(LAS unsigned char* lds, const bf16_t* QR, const float* KMEAN, unsigned short* SUB, int* CNT, int* ctr) {
    const int tid = threadIdx.x, lane = tid & 63, wv = tid >> 6;
    LAS float* km = (LAS float*)lds;
    LAS float* qs = (LAS float*)(lds + 16896) + wv * 128;
    LAS unsigned short* bucket = (LAS unsigned short*)(lds + 20992);
    LAS int* cnt = (LAS int*)(lds + 37376);
    const float NEG = -1e30f;
    if (blockIdx.x == 0 && tid == 0) *ctr = 0;
    for (int item = blockIdx.x; item < 2 * NHEAD * 32; item += gridDim.x) {
        const int bh = item >> 5, i = item & 31, b = bh >> 4, h = bh & 15;
        if (i == 0) continue;
        if (tid < 32) cnt[tid] = 0;
#pragma unroll
        for (int r = 0; r < 2; ++r) { const int idx = tid + 512 * r, n = idx >> 5, d4 = (idx & 31) * 4; *(LAS f32x4*)(km + n * 132 + d4) = *(const f32x4*)(KMEAN + ((size_t)bh * 32 + n) * 128 + d4); }
        __syncthreads();
        for (int qq = 0; qq < 32; ++qq) {
            const int tl = wv * 32 + qq;
            const size_t tok = (size_t)b * SEQ + i * 256 + tl;
            { const unsigned q2 = *(const unsigned*)(QR + tok * DM + h * 128 + 2 * lane); qs[2 * lane] = bflo(q2); qs[2 * lane + 1] = bfhi(q2); }
            asm volatile("s_waitcnt lgkmcnt(0)" ::: "memory");
            float gsc = NEG;
            if (lane < i) {
                float sacc = 0.f;
#pragma unroll 8
                for (int d4 = 0; d4 < 32; ++d4) { const f32x4 kv = *(const LAS f32x4*)(km + lane * 132 + d4 * 4); const f32x4 qv = *(const LAS f32x4*)(qs + d4 * 4); sacc += kv[0] * qv[0] + kv[1] * qv[1] + kv[2] * qv[2] + kv[3] * qv[3]; }
                gsc = sacc;
            }
#pragma unroll
            for (int r = 0; r < 3; ++r) {
                float v = gsc; int id = lane;
                wave_argmax(v, id);
                if (v > 0.5f * NEG && lane == 0) { const int p = __hip_atomic_fetch_add(cnt + id, 1, __ATOMIC_RELAXED, __HIP_MEMORY_SCOPE_WORKGROUP); bucket[id * 256 + p] = (unsigned short)(tl | (r << 8)); }
                if (lane == id) gsc = -3e38f;
            }
            asm volatile("s_waitcnt lgkmcnt(0)" ::: "memory");
        }
        __syncthreads();
        for (int idx = tid; idx < 32 * 256; idx += 512) {
            const int j = idx >> 8, p = idx & 255;
            if (j < i && p < cnt[j]) SUB[(((size_t)bh * 32 + j) * 32 + i) * 256 + p] = bucket[idx];
        }
        if (tid < i) CNT[((size_t)bh * 32 + tid) * 32 + i] = cnt[tid];
        __syncthreads();
    }
}

typedef short bf16x8 __attribute__((ext_vector_type(8)));
typedef short s16x4 __attribute__((ext_vector_type(4)));
typedef float f32x16 __attribute__((ext_vector_type(16)));
__device__ __forceinline__ unsigned off_b(unsigned row, unsigned ch) { return 256u * row + 16u * (ch ^ (((row & 3u) << 2) | ((row >> 2) & 3u))); }
__device__ __forceinline__ unsigned pi32(unsigned m) { return (m & ~12u) | ((m & 4u) << 1) | ((m & 8u) >> 1); }
__device__ __forceinline__ bf16x8 tr_frag(LAS unsigned char* img, unsigned lane, unsigned c, unsigned ks) {
    const unsigned hh = lane >> 5, blk = (lane >> 4) & 1, q = (lane & 15) >> 2, p = lane & 3;
    const unsigned a0 = off_b(16 * ks + 8 * hh + q, 4 * c + 2 * blk + (p >> 1)) + 8 * (p & 1);
    const unsigned a1 = off_b(16 * ks + 8 * hh + 4 + q, 4 * c + 2 * blk + (p >> 1)) + 8 * (p & 1);
    const s16x4 lo = __builtin_amdgcn_ds_read_tr16_b64_v4i16((LAS s16x4*)(img + a0));
    const s16x4 hi = __builtin_amdgcn_ds_read_tr16_b64_v4i16((LAS s16x4*)(img + a1));
    bf16x8 r; r[0] = lo[0]; r[1] = lo[1]; r[2] = lo[2]; r[3] = lo[3]; r[4] = hi[0]; r[5] = hi[1]; r[6] = hi[2]; r[7] = hi[3];
    return r;
}
__device__ __forceinline__ void phase_att(LAS unsigned char* lds, const bf16_t* QR, const bf16_t* KR, const bf16_t* V, const float* KNMAX, const unsigned short* SUB, const int* CNT, int* ctr,
                                          bf16_t* P012, bf16_t* P3, float* LS) {
    const int tid = threadIdx.x, lane = tid & 63, wv = tid >> 6, r32 = lane & 31, hh = lane >> 5;
    LAS unsigned char* Kimg = lds;
    LAS unsigned char* Vimg = lds + 65536;
    LAS int* misc = (LAS int*)(lds + 131072);
    const float SCL2 = 0.08838834764831845f * 1.4426950408889634f;
    for (;;) {
        __syncthreads();
        if (tid == 0) misc[40] = __hip_atomic_fetch_add(ctr, 1, __ATOMIC_RELAXED, __HIP_MEMORY_SCOPE_AGENT);
        __syncthreads();
        const int item = misc[40];
        if (item >= 2 * NHEAD * 32) break;
        const int j = item >> 5, bh = item & 31, b = bh >> 4, h = bh & 15;
#pragma unroll
        for (int r = 0; r < 8; ++r) {
            const int idx = tid + 512 * r, row = idx >> 4, ch = idx & 15;
            const size_t g = ((size_t)b * SEQ + j * 256 + row) * DM + h * 128 + ch * 8;
            const u32x4 kv = *(const u32x4*)(KR + g), vv = *(const u32x4*)(V + g);
            *(LAS u32x4*)(Kimg + off_b(row, ch)) = kv; *(LAS u32x4*)(Vimg + off_b(row, ch)) = vv;
        }
        if (tid <= 32) { int pre = 0; for (int u = j + 1; u < tid; ++u) pre += CNT[((size_t)bh * 32 + j) * 32 + u]; misc[tid] = pre; }
        float kn = (lane < 32) ? KNMAX[bh * 32 + lane] : 0.f;
        kn = wave_max(kn);
        __syncthreads();
        const int total = misc[32], ntile = (256 + total + 31) >> 5;
        for (int tile = wv; tile < ntile; tile += 8) {
            const int gr = tile * 32 + r32;
            int pos, slot; bool valid = true;
            if (gr < 256) { pos = j * 256 + gr; slot = 3; }
            else {
                const int x = gr - 256; valid = x < total;
                int ii = j + 1;
                for (int u = j + 1; u < 32; ++u) if (misc[u] <= x) ii = u;
                if (valid) { const unsigned e = SUB[(((size_t)bh * 32 + j) * 32 + ii) * 256 + (x - misc[ii])]; pos = ii * 256 + (int)(e & 255u); slot = (int)(e >> 8); }
                else { pos = j * 256; slot = 3; }
            }
            const size_t tok = (size_t)b * SEQ + pos;
            bf16x8 qf[8];
            const bf16_t* qp = QR + tok * DM + h * 128 + 8 * hh;
#pragma unroll
            for (int s = 0; s < 8; ++s) qf[s] = *(const bf16x8*)(qp + 16 * s);
            float qn2 = 0.f;
#pragma unroll
            for (int s = 0; s < 8; ++s)
#pragma unroll
                for (int e = 0; e < 8; ++e) { const float f = bf2f((bf16_t)qf[s][e]); qn2 += f * f; }
            qn2 += __shfl_xor(qn2, 32);
            const float c2 = sqrtf(qn2) * kn * SCL2;
            f32x16 O[4];
#pragma unroll
            for (int dt = 0; dt < 4; ++dt)
#pragma unroll
                for (int e = 0; e < 16; ++e) O[dt][e] = 0.f;
            float l = 0.f;
            const bool own = tile < 8;
            const int kcn = own ? tile + 1 : 8;
            const unsigned krow = pi32((unsigned)r32);
            for (int kc = 0; kc < kcn; ++kc) {
                f32x16 S;
#pragma unroll
                for (int e = 0; e < 16; ++e) S[e] = 0.f;
#pragma unroll
                for (int s = 0; s < 8; ++s) {
                    const bf16x8 kf = *(const LAS bf16x8*)(Kimg + off_b(32 * kc + krow, 2 * s + hh));
                    S = __builtin_amdgcn_mfma_f32_32x32x16_bf16(kf, qf[s], S, 0, 0, 0);
                }
                float p[16];
#pragma unroll
                for (int e = 0; e < 16; ++e) {
                    const unsigned m = (e & 3) + 8 * (e >> 2) + 4 * hh;
                    const int key = j * 256 + 32 * kc + (int)pi32(m);
                    float pe = __builtin_amdgcn_exp2f(S[e] * SCL2 - c2);
                    if (own && key > pos) pe = 0.f;
                    p[e] = pe; l += pe;
                }
                u32x4 w0, w1;
                w0.x = pk_bf16(p[0], p[1]); w0.y = pk_bf16(p[2], p[3]); w0.z = pk_bf16(p[4], p[5]); w0.w = pk_bf16(p[6], p[7]);
                w1.x = pk_bf16(p[8], p[9]); w1.y = pk_bf16(p[10], p[11]); w1.z = pk_bf16(p[12], p[13]); w1.w = pk_bf16(p[14], p[15]);
                const bf16x8 pf0 = __builtin_bit_cast(bf16x8, w0), pf1 = __builtin_bit_cast(bf16x8, w1);
#pragma unroll
                for (int dt = 0; dt < 4; ++dt) {
                    const bf16x8 v0 = tr_frag(Vimg, lane, dt, 2 * kc), v1 = tr_frag(Vimg, lane, dt, 2 * kc + 1);
                    O[dt] = __builtin_amdgcn_mfma_f32_32x32x16_bf16(v0, pf0, O[dt], 0, 0, 0);
                    O[dt] = __builtin_amdgcn_mfma_f32_32x32x16_bf16(v1, pf1, O[dt], 0, 0, 0);
                }
            }
            l += __shfl_xor(l, 32);
            if (valid) {
                bf16_t* pl = (slot < 3 ? P012 + (size_t)slot * ((size_t)32 << 20) : P3) + (tok * NHEAD + h) * 128 + 4 * hh;
#pragma unroll
                for (int dt = 0; dt < 4; ++dt)
#pragma unroll
                    for (int g = 0; g < 4; ++g) {
                        u32x2 w; w.x = pk_bf16(O[dt][4 * g], O[dt][4 * g + 1]); w.y = pk_bf16(O[dt][4 * g + 2], O[dt][4 * g + 3]);
                        *(u32x2*)(pl + 32 * dt + 8 * g) = w;
                    }
                if (hh == 0) LS[(size_t)slot * MTOK * NHEAD + tok * NHEAD + h] = l;
            }
        }
    }
}
__device__ __forceinline__ void phase_comb(const bf16_t* P012, const bf16_t* P3, const float* LS, bf16_t* AO) {
    const size_t n = (size_t)MTOK * NHEAD * 16, stride = (size_t)gridDim.x * 512;
    for (size_t idx = (size_t)blockIdx.x * 512 + threadIdx.x; idx < n; idx += stride) {
        const size_t th = idx >> 4; const int ch = (int)(idx & 15);
        const int t = (int)((th >> 4) & (SEQ - 1)), blk = t >> 8, nsel = blk < 3 ? blk : 3;
        float acc[8];
        float l = LS[(size_t)3 * MTOK * NHEAD + th];
        { const u32x4 w = *(const u32x4*)(P3 + th * 128 + ch * 8);
          acc[0] = bflo(w.x); acc[1] = bfhi(w.x); acc[2] = bflo(w.y); acc[3] = bfhi(w.y); acc[4] = bflo(w.z); acc[5] = bfhi(w.z); acc[6] = bflo(w.w); acc[7] = bfhi(w.w); }
        for (int s = 0; s < nsel; ++s) {
            const u32x4 w = *(const u32x4*)(P012 + (size_t)s * ((size_t)32 << 20) + th * 128 + ch * 8);
            acc[0] += bflo(w.x); acc[1] += bfhi(w.x); acc[2] += bflo(w.y); acc[3] += bfhi(w.y); acc[4] += bflo(w.z); acc[5] += bfhi(w.z); acc[6] += bflo(w.w); acc[7] += bfhi(w.w);
            l += LS[(size_t)s * MTOK * NHEAD + th];
        }
        const float rl = 1.0f / l;
        u32x4 o; o.x = pk_bf16(acc[0] * rl, acc[1] * rl); o.y = pk_bf16(acc[2] * rl, acc[3] * rl); o.z = pk_bf16(acc[4] * rl, acc[5] * rl); o.w = pk_bf16(acc[6] * rl, acc[7] * rl);
        *(u32x4*)(AO + th * 128 + ch * 8) = o;
    }
}

__device__ __forceinline__ void phase_scan_a(LAS unsigned char* lds, const float* LF, const bf16_t* I1, bf16_t* LT, float* DEC, unsigned* dbgc = nullptr) {
    unsigned dbg_kt = 0, dbg_acc = 0;
    const int tid = threadIdx.x, lane = tid & 63, wv = tid >> 6, k = tid & 127, part = tid >> 7;
    LAS unsigned char* Iimg = lds; LAS unsigned char* KTimg = lds + 16384;
    LAS float* psum = (LAS float*)(lds + 32768);
    LAS unsigned char* Lst = lds + 36864;
#if SCAN_A_VALU == 2
    for (int item = blockIdx.x; item < 2 * NHEAD * 128; item += gridDim.x) {
        const int bh = item >> 7, c = item & 127, b = bh >> 4, h = bh & 15;
        const size_t tok0 = (size_t)b * SEQ + c * 64;
        for (int idx = tid; idx < 16384; idx += 512) {
            const int v = idx >> 7, kk = idx & 127;
            float g = 1.f, L = 0.f;
            for (int s2 = 63; s2 >= 0; --s2) { const size_t o = (tok0 + s2) * DM + h * 128; const float f = __expf(LF[o + kk]); L += bf2f(I1[o + v]) * (1.0f - f) * g; g *= f; }
            LT[(size_t)item * 16384 + idx] = (bf16_t)(pk_bf16(L, 0.f) & 0xffffu);
        }
    }
    return;
#endif
    for (int item = blockIdx.x; item < 2 * NHEAD * 128; item += gridDim.x) {
        const int bh = item >> 7, c = item & 127, b = bh >> 4, h = bh & 15;
        const size_t tok0 = (size_t)b * SEQ + c * 64;
        float lf[16];
#pragma unroll
        for (int i = 0; i < 16; ++i) lf[i] = LF[(tok0 + 16 * part + i) * DM + h * 128 + k];
#pragma unroll
        for (int r = 0; r < 2; ++r) { const int idx = tid + 512 * r, row = idx >> 4, ch = idx & 15; *(LAS u32x4*)(Iimg + off_b(row, ch)) = *(const u32x4*)(I1 + (tok0 + row) * DM + h * 128 + ch * 8); }
        float cs = 0.f;
#pragma unroll
        for (int i = 0; i < 16; ++i) cs += lf[i];
        psum[part * 128 + k] = cs;
        __syncthreads();
        const float p0 = psum[k], p1 = psum[128 + k], p2 = psum[256 + k], p3 = psum[384 + k];
        const float blast = (p0 + p1) + (p2 + p3);
        float bb = part == 0 ? 0.f : (part == 1 ? p0 : (part == 2 ? p0 + p1 : p0 + p1 + p2));
#pragma unroll
        for (int i = 0; i < 16; ++i) {
            bb += lf[i];
            const float kt = (1.0f - __expf(lf[i])) * __expf(blast - bb);
            if (!(kt - kt == 0.f)) ++dbg_kt;
            const int srow = 16 * part + i;
            *(LAS bf16_t*)(KTimg + off_b(srow, k >> 3) + 2 * (k & 7)) = (bf16_t)(pk_bf16(kt, 0.f) & 0xffffu);
        }
        if (part == 0) DEC[(size_t)item * 128 + k] = __expf(blast);
        __syncthreads();
#if SCAN_A_VALU
        for (int idx = tid; idx < 16384; idx += 512) {
            const int v = idx >> 7, kk = idx & 127;
            float accv = 0.f;
            for (int s2 = 0; s2 < 64; ++s2) accv += bf2f(*(const LAS bf16_t*)(Iimg + off_b(s2, v >> 3) + 2 * (v & 7))) * bf2f(*(const LAS bf16_t*)(KTimg + off_b(s2, kk >> 3) + 2 * (kk & 7)));
            *(LAS bf16_t*)(Lst + v * 272 + 2 * kk) = (bf16_t)(pk_bf16(accv, 0.f) & 0xffffu);
        }
        if (0)
#endif
        {
            const int vt = wv >> 1;
            f32x16 acc0, acc1;
#pragma unroll
            for (int e = 0; e < 16; ++e) { acc0[e] = 0.f; acc1[e] = 0.f; }
#pragma unroll
            for (int ks = 0; ks < 4; ++ks) {
                const bf16x8 af = tr_frag(Iimg, lane, vt, ks);
                const bf16x8 b0 = tr_frag(KTimg, lane, 2 * (wv & 1), ks), b1 = tr_frag(KTimg, lane, 2 * (wv & 1) + 1, ks);
                acc0 = __builtin_amdgcn_mfma_f32_32x32x16_bf16(af, b0, acc0, 0, 0, 0);
                acc1 = __builtin_amdgcn_mfma_f32_32x32x16_bf16(af, b1, acc1, 0, 0, 0);
            }
            const int r32 = lane & 31, hh = lane >> 5;
#pragma unroll
            for (int e = 0; e < 16; ++e) {
                if (!(acc0[e] - acc0[e] == 0.f)) ++dbg_acc; if (!(acc1[e] - acc1[e] == 0.f)) ++dbg_acc;
                const int v = 32 * vt + (e & 3) + 8 * (e >> 2) + 4 * hh;
                *(LAS bf16_t*)(Lst + v * 272 + 2 * (64 * (wv & 1) + r32)) = (bf16_t)(pk_bf16(acc0[e], 0.f) & 0xffffu);
                *(LAS bf16_t*)(Lst + v * 272 + 2 * (64 * (wv & 1) + 32 + r32)) = (bf16_t)(pk_bf16(acc1[e], 0.f) & 0xffffu);
            }
        }
        __syncthreads();
#pragma unroll
        for (int r = 0; r < 4; ++r) { const int idx = tid + 512 * r, row = idx >> 4, ch = idx & 15; store_wt16(LT + (size_t)item * 16384 + row * 128 + ch * 8, *(const LAS u32x4*)(Lst + row * 272 + ch * 16)); }
        __syncthreads();
    }
    if (dbgc) { if (dbg_kt) atomicAdd(dbgc + 0, dbg_kt); if (dbg_acc) atomicAdd(dbgc + 1, dbg_acc); }
}
__device__ __forceinline__ void phase_scan_b(bf16_t* LT, const float* DEC) {
    const int n = 2 * NHEAD * 128 * 32;
    for (int idx = blockIdx.x * 512 + threadIdx.x; idx < n; idx += gridDim.x * 512) {
        const int bh = idx >> 12, vk = idx & 4095, k4 = (vk & 31) * 4;
        float S0 = 0.f, S1 = 0.f, S2 = 0.f, S3 = 0.f;
        bf16_t* p = LT + (size_t)bh * 128 * 16384 + (size_t)vk * 4;
        const float* dp = DEC + (size_t)bh * 128 * 128 + k4;
#pragma unroll 8
        for (int c = 0; c < 128; ++c) {
            const u32x2 w = *(const u32x2*)(p + (size_t)c * 16384);
            const f32x4 d = *(const f32x4*)(dp + c * 128);
            u32x2 o; o.x = pk_bf16(S0, S1); o.y = pk_bf16(S2, S3);
            store_wt8(p + (size_t)c * 16384, o);
            S0 = d[0] * S0 + bflo(w.x); S1 = d[1] * S1 + bfhi(w.x); S2 = d[2] * S2 + bflo(w.y); S3 = d[3] * S3 + bfhi(w.y);
        }
    }
}
__device__ __forceinline__ void phase_scan_c(LAS unsigned char* lds, const bf16_t* Q1, const float* LF, const bf16_t* I1, const bf16_t* G1, const bf16_t* SP, const float* gnorm, bf16_t* OG) {
    const int tid = threadIdx.x, lane = tid & 63, wv = tid >> 6, k = tid & 127, part = tid >> 7, r32 = lane & 31, hh = lane >> 5;
    LAS unsigned char* QTimg = lds; LAS unsigned char* QPimg = lds + 16384; LAS unsigned char* KPimg = lds + 32768; LAS unsigned char* Iimg = lds + 49152; LAS unsigned char* SPimg = lds + 65536;
    LAS float* psum = (LAS float*)(lds + 98304);
    LAS float* ssq = (LAS float*)(lds + 100352);
    LAS unsigned char* OT = lds + 102400;
    for (int item = blockIdx.x; item < 2 * NHEAD * 128; item += gridDim.x) {
        const int bh = item >> 7, c = item & 127, b = bh >> 4, h = bh & 15;
        const size_t tok0 = (size_t)b * SEQ + c * 64;
        float lf[16], qv[16];
#pragma unroll
        for (int i = 0; i < 16; ++i) { const size_t o = (tok0 + 16 * part + i) * DM + h * 128 + k; lf[i] = LF[o]; qv[i] = bf2f(Q1[o]); }
#pragma unroll
        for (int r = 0; r < 2; ++r) { const int idx = tid + 512 * r, row = idx >> 4, ch = idx & 15; *(LAS u32x4*)(Iimg + off_b(row, ch)) = *(const u32x4*)(I1 + (tok0 + row) * DM + h * 128 + ch * 8); }
#pragma unroll
        for (int r = 0; r < 4; ++r) { const int idx = tid + 512 * r, row = idx >> 4, ch = idx & 15; *(LAS u32x4*)(SPimg + off_b(row, ch)) = *(const u32x4*)(SP + (size_t)item * 16384 + row * 128 + ch * 8); }
        float cs = 0.f;
#pragma unroll
        for (int i = 0; i < 16; ++i) cs += lf[i];
        psum[part * 128 + k] = cs;
        __syncthreads();
        const float p0 = psum[k], p1 = psum[128 + k], p2 = psum[256 + k];
        const float rr = p0 + p1;
        float bb = part == 0 ? 0.f : (part == 1 ? p0 : (part == 2 ? p0 + p1 : p0 + p1 + p2));
#pragma unroll
        for (int i = 0; i < 16; ++i) {
            bb += lf[i];
            const float qt = qv[i] * __expf(bb), qp = qv[i] * __expf(bb - rr), kp = (1.0f - __expf(lf[i])) * __expf(rr - bb);
            const unsigned o = off_b(16 * part + i, k >> 3) + 2 * (k & 7);
            *(LAS bf16_t*)(QTimg + o) = (bf16_t)(pk_bf16(qt, 0.f) & 0xffffu);
            *(LAS bf16_t*)(QPimg + o) = (bf16_t)(pk_bf16(qp, 0.f) & 0xffffu);
            *(LAS bf16_t*)(KPimg + o) = (bf16_t)(pk_bf16(kp, 0.f) & 0xffffu);
        }
        __syncthreads();
        const int tt = wv & 1, vt = wv >> 1;
        f32x16 O;
#pragma unroll
        for (int e = 0; e < 16; ++e) O[e] = 0.f;
#pragma unroll
        for (int ks = 0; ks < 8; ++ks) {
            const bf16x8 af = *(const LAS bf16x8*)(SPimg + off_b(32 * vt + r32, 2 * ks + hh));
            const bf16x8 bf = *(const LAS bf16x8*)(QTimg + off_b(32 * tt + r32, 2 * ks + hh));
            O = __builtin_amdgcn_mfma_f32_32x32x16_bf16(af, bf, O, 0, 0, 0);
        }
        const unsigned krow = pi32((unsigned)r32);
        for (int st = 0; st <= tt; ++st) {
            f32x16 S;
#pragma unroll
            for (int e = 0; e < 16; ++e) S[e] = 0.f;
#pragma unroll
            for (int ks = 0; ks < 8; ++ks) {
                const bf16x8 af = *(const LAS bf16x8*)(KPimg + off_b(32 * st + krow, 2 * ks + hh));
                const bf16x8 bf = *(const LAS bf16x8*)(QPimg + off_b(32 * tt + r32, 2 * ks + hh));
                S = __builtin_amdgcn_mfma_f32_32x32x16_bf16(af, bf, S, 0, 0, 0);
            }
            float p[16];
#pragma unroll
            for (int e = 0; e < 16; ++e) {
                const unsigned m = (e & 3) + 8 * (e >> 2) + 4 * hh;
                const int sidx = 32 * st + (int)pi32(m), tidx = 32 * tt + r32;
                p[e] = sidx <= tidx ? S[e] : 0.f;
            }
            u32x4 w0, w1;
            w0.x = pk_bf16(p[0], p[1]); w0.y = pk_bf16(p[2], p[3]); w0.z = pk_bf16(p[4], p[5]); w0.w = pk_bf16(p[6], p[7]);
            w1.x = pk_bf16(p[8], p[9]); w1.y = pk_bf16(p[10], p[11]); w1.z = pk_bf16(p[12], p[13]); w1.w = pk_bf16(p[14], p[15]);
            const bf16x8 pf0 = __builtin_bit_cast(bf16x8, w0), pf1 = __builtin_bit_cast(bf16x8, w1);
            const bf16x8 i0 = tr_frag(Iimg, lane, vt, 2 * st), i1 = tr_frag(Iimg, lane, vt, 2 * st + 1);
            O = __builtin_amdgcn_mfma_f32_32x32x16_bf16(i0, pf0, O, 0, 0, 0);
            O = __builtin_amdgcn_mfma_f32_32x32x16_bf16(i1, pf1, O, 0, 0, 0);
        }
        float sq = 0.f;
#pragma unroll
        for (int e = 0; e < 16; ++e) sq += O[e] * O[e];
        sq += __shfl_xor(sq, 32);
        if (hh == 0) ssq[vt * 64 + 32 * tt + r32] = sq;
        __syncthreads();
        const int tl = 32 * tt + r32;
        const float rstd = rsqrtf((ssq[tl] + ssq[64 + tl] + ssq[128 + tl] + ssq[192 + tl]) * (1.0f / 128.0f) + 1e-6f);
#pragma unroll
        for (int g = 0; g < 4; ++g) {
            const int v0 = 32 * vt + 8 * g + 4 * hh;
            const f32x4 gn = *(const f32x4*)(gnorm + v0);
            u32x2 w; w.x = pk_bf16(O[4 * g] * rstd * gn[0], O[4 * g + 1] * rstd * gn[1]); w.y = pk_bf16(O[4 * g + 2] * rstd * gn[2], O[4 * g + 3] * rstd * gn[3]);
            *(LAS u32x2*)(OT + tl * 272 + v0 * 2) = w;
        }
        __syncthreads();
#pragma unroll
        for (int r = 0; r < 2; ++r) {
            const int idx = tid + 512 * r, row = idx >> 4, ch = idx & 15;
            const u32x4 ov = *(const LAS u32x4*)(OT + row * 272 + ch * 16);
            const size_t go = (tok0 + row) * DM + h * 128 + ch * 8;
            const u32x4 gv = *(const u32x4*)(G1 + go);
            u32x4 w;
            w.x = pk_bf16(bflo(ov.x) * bflo(gv.x), bfhi(ov.x) * bfhi(gv.x)); w.y = pk_bf16(bflo(ov.y) * bflo(gv.y), bfhi(ov.y) * bfhi(gv.y));
            w.z = pk_bf16(bflo(ov.z) * bflo(gv.z), bfhi(ov.z) * bfhi(gv.z)); w.w = pk_bf16(bflo(ov.w) * bflo(gv.w), bfhi(ov.w) * bfhi(gv.w));
            *(u32x4*)(OG + go) = w;
        }
        __syncthreads();
    }
}


#if SCAN_DBG == 2
__device__ __forceinline__ void dbg_compare(LAS float* red, const bf16_t* A, const bf16_t* B, float* DBG) {
    float sd = 0.f, sr = 0.f, nn = 0.f;
    const size_t n = (size_t)MTOK * DM;
    for (size_t i = (size_t)blockIdx.x * 512 + threadIdx.x; i < n; i += (size_t)gridDim.x * 512) {
        const float x = bf2f(A[i]), y = bf2f(B[i]);
        if (!(x - x == 0.f)) nn += 1.f; else { sd += (x - y) * (x - y); sr += y * y; }
    }
    sd = wave_sum(sd); sr = wave_sum(sr); nn = wave_sum(nn);
    const int wv = threadIdx.x >> 6;
    if ((threadIdx.x & 63) == 0) { red[wv * 3] = sd; red[wv * 3 + 1] = sr; red[wv * 3 + 2] = nn; }
    __syncthreads();
    if (threadIdx.x == 0) { float a = 0, b = 0, c = 0; for (int w = 0; w < 8; ++w) { a += red[w * 3]; b += red[w * 3 + 1]; c += red[w * 3 + 2]; } DBG[blockIdx.x * 4] = a; DBG[blockIdx.x * 4 + 1] = b; DBG[blockIdx.x * 4 + 2] = c; }
    __syncthreads();
}
__device__ __forceinline__ void dbg_emit(const float* DBG, float* out) {
    float a = 0, b = 0, c = 0;
    for (int w = 0; w < (int)gridDim.x; ++w) { a += DBG[w * 4]; b += DBG[w * 4 + 1]; c += DBG[w * 4 + 2]; }
    const float rel = sqrtf(a / b);
    int k = (int)rintf(-2.0f * log10f(rel)); k = k < 0 ? 0 : (k > 16 ? 16 : k);
    if (c > 0.f) k = 17;
    const float cc = sqrtf(0.5f * (float)k);
    const size_t n = (size_t)MTOK * DM;
    for (size_t i = (size_t)blockIdx.x * 512 + threadIdx.x; i < n; i += (size_t)gridDim.x * 512) out[i] = cc;
}
#endif

#if SCAN_DBG == 3
__device__ __forceinline__ void dbg_count_bf16(const bf16_t* A, size_t n, unsigned* cnt) {
    unsigned c = 0;
    for (size_t i = (size_t)blockIdx.x * 512 + threadIdx.x; i < n; i += (size_t)gridDim.x * 512) { const float x = bf2f(A[i]); if (!(x - x == 0.f)) ++c; }
    if (c) atomicAdd(cnt, c);
}
__device__ __forceinline__ void dbg_count_f32(const float* A, size_t n, unsigned* cnt) {
    unsigned c = 0;
    for (size_t i = (size_t)blockIdx.x * 512 + threadIdx.x; i < n; i += (size_t)gridDim.x * 512) { const float x = A[i]; if (!(x - x == 0.f)) ++c; }
    if (c) atomicAdd(cnt, c);
}
__device__ __forceinline__ void dbg_emit3(const unsigned* cnt, float* out) {
    float code = 0.f;
    for (int st = 3; st >= 0; --st) { const unsigned c = cnt[st]; if (c) { float lg = log10f((float)c); lg = lg > 9.f ? 9.f : lg; code = (float)(st + 1) + 0.1f * lg; } }
    const float cc = sqrtf(code);
    const size_t n = (size_t)MTOK * DM;
    for (size_t i = (size_t)blockIdx.x * 512 + threadIdx.x; i < n; i += (size_t)gridDim.x * 512) out[i] = cc;
}
#endif

#if SCAN_DBG == 4 || SCAN_DBG == 6
__device__ __forceinline__ void dbg_compare4(LAS float* red, const bf16_t* A, const bf16_t* B, const bf16_t* C, float* DBG) {
    float sd = 0.f, sr = 0.f, nn = 0.f, mm = 0.f;
    const size_t n = (size_t)MTOK * DM;
    for (size_t i = (size_t)blockIdx.x * 512 + threadIdx.x; i < n; i += (size_t)gridDim.x * 512) {
        const float x = bf2f(A[i]), y = bf2f(B[i]);
        if (!(x - x == 0.f)) nn += 1.f; else { sd += (x - y) * (x - y); sr += y * y; }
        if (A[i] != C[i]) mm += 1.f;
    }
    sd = wave_sum(sd); sr = wave_sum(sr); nn = wave_sum(nn); mm = wave_sum(mm);
    const int wv = threadIdx.x >> 6;
    if ((threadIdx.x & 63) == 0) { red[wv * 4] = sd; red[wv * 4 + 1] = sr; red[wv * 4 + 2] = nn; red[wv * 4 + 3] = mm; }
    __syncthreads();
    if (threadIdx.x == 0) { float a = 0, b = 0, c = 0, d = 0; for (int w = 0; w < 8; ++w) { a += red[w * 4]; b += red[w * 4 + 1]; c += red[w * 4 + 2]; d += red[w * 4 + 3]; }
        DBG[blockIdx.x * 4] = a; DBG[blockIdx.x * 4 + 1] = b; DBG[blockIdx.x * 4 + 2] = c; DBG[blockIdx.x * 4 + 3] = d; }
    __syncthreads();
}
__device__ __forceinline__ void dbg_emit4(const float* DBG, float* out) {
    float a = 0, b = 0, c = 0, d = 0;
    for (int w = 0; w < (int)gridDim.x; ++w) { a += DBG[w * 4]; b += DBG[w * 4 + 1]; c += DBG[w * 4 + 2]; d += DBG[w * 4 + 3]; }
    const float rel = sqrtf(a / b);
    int k = (int)rintf(-log10f(rel)); k = k < 0 ? 0 : (k > 8 ? 8 : k);
#if SCAN_DBG == 6
    const float cc = sqrtf((float)k + ((d + c) > 0.f ? 0.5f : 0.f));
#else
    int m = (int)ceilf(log10f(1.0f + d + c)); m = m > 9 ? 9 : m;
    const float cc = sqrtf((float)k + 0.1f * (float)m);
#endif
    const size_t n = (size_t)MTOK * DM;
    for (size_t i = (size_t)blockIdx.x * 512 + threadIdx.x; i < n; i += (size_t)gridDim.x * 512) out[i] = cc;
}
#endif

#if SCAN_DBG == 5
__device__ __forceinline__ void dbg_lds16_test(LAS unsigned char* lds, unsigned* cnt) {
    const int tid = threadIdx.x;
    unsigned bad = 0;
    for (int rep = 0; rep < 64; ++rep) {
        for (int i = tid; i < 1024; i += 512) *(LAS u32x4*)(lds + i * 16) = (u32x4){0x7fc07fc0u, 0x7fc07fc0u, 0x7fc07fc0u, 0x7fc07fc0u};
        __syncthreads();
        const int k = tid & 127, part = tid >> 7;
#pragma unroll
        for (int i = 0; i < 16; ++i) {
            const int row = 16 * part + i;
            *(LAS bf16_t*)(lds + off_b(row, k >> 3) + 2 * (k & 7)) = (bf16_t)((row * 128 + k + rep) & 0x7fff);
        }
        __syncthreads();
        for (int idx = tid; idx < 64 * 128; idx += 512) {
            const int row = idx >> 7, kk = idx & 127;
            const bf16_t got = *(const LAS bf16_t*)(lds + off_b(row, kk >> 3) + 2 * (kk & 7));
            if (got != (bf16_t)((row * 128 + kk + rep) & 0x7fff)) ++bad;
        }
        __syncthreads();
    }
    if (bad) atomicAdd(cnt, bad);
}
__device__ __forceinline__ void dbg_emit5(const unsigned* cnt, float* out) {
    const unsigned c = cnt[0];
    float code = 0.f;
    if (c) { float lg = log10f((float)c); code = 1.0f + (lg > 8.9f ? 8.9f : lg); }
    const float cc = sqrtf(code);
    const size_t n = (size_t)MTOK * DM;
    for (size_t i = (size_t)blockIdx.x * 512 + threadIdx.x; i < n; i += (size_t)gridDim.x * 512) out[i] = cc;
}
#endif

#if SCAN_DBG == 6
__device__ __forceinline__ void dbg_check_a(LAS float* red, const float* LF, const bf16_t* I1, const bf16_t* LT, const bf16_t* LT2, float* DBG) {
    float sd = 0.f, sr = 0.f, mm = 0.f;
    const size_t n = (size_t)4096 * 16384;
    for (size_t i = (size_t)blockIdx.x * 512 + threadIdx.x; i < n; i += (size_t)gridDim.x * 512) {
        const int item = (int)(i >> 14), v = (int)((i >> 7) & 127), k = (int)(i & 127);
        const int bh = item >> 7, c = item & 127, b = bh >> 4, h = bh & 15;
        const size_t tok0 = (size_t)b * SEQ + c * 64;
        float g = 1.f, L = 0.f;
        for (int s2 = 63; s2 >= 0; --s2) {
            const size_t o = (tok0 + s2) * DM + h * 128;
            const float f = __expf(LF[o + k]);
            L += bf2f(I1[o + v]) * (1.0f - f) * g;
            g *= f;
        }
        const float x = bf2f(LT[i]);
        sd += (x - L) * (x - L); sr += L * L;
        if (LT[i] != LT2[i]) mm += 1.f;
    }
    sd = wave_sum(sd); sr = wave_sum(sr); mm = wave_sum(mm);
    const int wv = threadIdx.x >> 6;
    if ((threadIdx.x & 63) == 0) { red[wv * 4] = sd; red[wv * 4 + 1] = sr; red[wv * 4 + 2] = 0.f; red[wv * 4 + 3] = mm; }
    __syncthreads();
    if (threadIdx.x == 0) { float a = 0, b2 = 0, d = 0; for (int w = 0; w < 8; ++w) { a += red[w * 4]; b2 += red[w * 4 + 1]; d += red[w * 4 + 3]; }
        DBG[blockIdx.x * 4] = a; DBG[blockIdx.x * 4 + 1] = b2; DBG[blockIdx.x * 4 + 2] = 0.f; DBG[blockIdx.x * 4 + 3] = d; }
    __syncthreads();
}
#endif

#if SCAN_DBG == 7
#ifndef DBG_FAM
#define DBG_FAM 0
#endif
__device__ __forceinline__ void dbg_check_a7(const float* LF, const bf16_t* I1, const bf16_t* LT, float* DBG) {
    const size_t n = (size_t)4096 * 16384;
    float nbad = 0.f, nnf = 0.f;
    for (size_t i = (size_t)blockIdx.x * 512 + threadIdx.x; i < n; i += (size_t)gridDim.x * 512 * 8) {
        const int item = (int)(i >> 14), v = (int)((i >> 7) & 127), k = (int)(i & 127);
        const int bh = item >> 7, c = item & 127, b = bh >> 4, h = bh & 15;
        const size_t tok0 = (size_t)b * SEQ + c * 64;
        float g = 1.f, L = 0.f;
        for (int s2 = 63; s2 >= 0; --s2) {
            const size_t o = (tok0 + s2) * DM + h * 128;
            const float f = __expf(LF[o + k]);
            L += bf2f(I1[o + v]) * (1.0f - f) * g;
            g *= f;
        }
        const float x = bf2f(LT[i]);
        if (!(x - x == 0.f)) { nnf += 1.f; nbad += 1.f; }
        else if (fabsf(x - L) > 0.02f * fabsf(L) + 1e-2f) nbad += 1.f;
    }
    nbad = wave_sum(nbad); nnf = wave_sum(nnf);
    if ((threadIdx.x & 63) == 0) { atomicAdd(DBG, nbad); atomicAdd(DBG + 1, nnf); }
}
__device__ __forceinline__ void dbg_emit7(const float* DBG, float* out) {
    const float nb = DBG[0], nf = DBG[1];
    int A = nb == 0.f ? 0 : (nb <= 100.f ? 1 : (nb <= 1e4f ? 3 : (nb <= 1e6f ? 5 : 7)));
    int B = nf == 0.f ? 0 : 5;
    const float cc = sqrtf((float)A + 0.1f * (float)B);
    const size_t n = (size_t)MTOK * DM;
    for (size_t i = (size_t)blockIdx.x * 512 + threadIdx.x; i < n; i += (size_t)gridDim.x * 512) out[i] = cc;
}
#endif
__device__ __forceinline__ int opaque(int v) { asm volatile("" : "+s"(v)); return v; }
template <bool L1> __device__ __forceinline__ void run_gemm_out(const Args& a, LAS unsigned char* lds) {
    unsigned char* ws = a.ws;
    pg8::Gemm g{(const bf16_t*)(ws + (L1 ? slot(3) : slot(0))), (const bf16_t*)(ws + (L1 ? WS_WO : WS_WOUT)), opaque(MTOK), opaque(DM), opaque(DM)};
    pg8::StaticOrder S; S.init(g.M, g.N, (int)gridDim.x, (int)blockIdx.x);
    EpiRes E{L1 ? (const float*)(ws + slot(0)) : a.in[0], (float*)(ws + (L1 ? slot(4) : slot(1)))};
    pg8::gemm_phase<EpiRes, pg8::StaticOrder>(lds, g, S, E, nullptr);
}
template <bool L1> __device__ __forceinline__ void run_ln(const Args& a) {
    unsigned char* ws = a.ws;
    phase_ln((const float*)(ws + (L1 ? slot(4) : slot(1))), a.in[12] + (L1 ? 2 : 0) * DM, a.in[13] + (L1 ? 2 : 0) * DM,
             (float*)(ws + (L1 ? slot(6) : slot(3))), (bf16_t*)(ws + (L1 ? slot(8) : slot(5))));
}
template <bool L1> __device__ __forceinline__ void run_gemm_sc(const Args& a, LAS unsigned char* lds) {
    unsigned char* ws = a.ws;
    pg8::Gemm g{(const bf16_t*)(ws + (L1 ? slot(8) : slot(5))), (const bf16_t*)(ws + WS_WC) + (L1 ? (size_t)DM * DM : 0), opaque(MTOK), opaque(DM), opaque(DM)};
    pg8::StaticOrder S; S.init(g.M, g.N, (int)gridDim.x, (int)blockIdx.x);
    EpiF32 E{(float*)(ws + (L1 ? slot(0) : slot(6)))};
    pg8::gemm_phase<EpiF32, pg8::StaticOrder>(lds, g, S, E, nullptr);
}
template <bool L1> __device__ __forceinline__ void run_topk(const Args& a) {
    unsigned char* ws = a.ws;
    phase_topk((const float*)(ws + (L1 ? slot(0) : slot(6))), (int*)(ws + WS_EID), (float*)(ws + WS_GATE));
}
template <bool L1> __device__ __forceinline__ void run_peer(const Args& a) {
    unsigned char* ws = a.ws;
    phase_peer((const float*)(ws + (L1 ? slot(6) : slot(3))), (const int*)(ws + WS_EID), (const float*)(ws + WS_GATE),
               (const bf16_t*)(ws + WS_UB) + (L1 ? (size_t)16384 * DM : 0), (const bf16_t*)(ws + WS_VB) + (L1 ? (size_t)16384 * DM : 0),
               a.in[12] + (L1 ? 3 : 1) * DM, a.in[13] + (L1 ? 3 : 1) * DM,
               L1 ? a.out : (float*)(ws + slot(0)), L1 ? (bf16_t*)nullptr : (bf16_t*)(ws + slot(2)));
}

__global__ void __launch_bounds__(512, 2) mk_fwd(Args a) {
    extern __shared__ __attribute__((aligned(16))) unsigned char lds_raw[];
    LAS unsigned char* lds = (LAS unsigned char*)lds_raw;
    cg::grid_group grid = cg::this_grid();
    unsigned char* ws = a.ws;
#define PHASE_BEGIN(k) if (a.ph_lo <= (k) && (k) < a.ph_hi && EN(k)) {
#define PHASE_END(k) asm volatile("s_waitcnt vmcnt(0)" ::: "memory"); __syncthreads(); if ((k) + 1 < a.ph_hi) { grid.sync(); if (threadIdx.x < 64) { __builtin_amdgcn_fence(__ATOMIC_ACQUIRE, "agent"); asm volatile("s_waitcnt vmcnt(0)" ::: "memory"); } __syncthreads(); } }
    PHASE_BEGIN(0) phase_prep(a, lds);
#if SCAN_DBG == 3 || SCAN_DBG == 5
        if (blockIdx.x == 0 && threadIdx.x < 8) ((unsigned*)(ws + WS_CTR + 8192))[threadIdx.x] = 0u;
#endif
#if SCAN_DBG == 7
        if (blockIdx.x == 0 && threadIdx.x < 32) ((float*)(ws + WS_CTR + 4096))[threadIdx.x] = 0.f;
#endif
    PHASE_END(0)
#if SCAN_DBG == 5
    PHASE_BEGIN(1) dbg_lds16_test(lds, (unsigned*)(ws + WS_CTR + 8192)); PHASE_END(1)
#define SKIP_REST 1
#endif
    PHASE_BEGIN(1) {
        pg8::Gemm g{(const bf16_t*)(ws + slot(0)), (const bf16_t*)(ws + WS_WIN), opaque(MTOK), opaque(4 * DM), opaque(DM)};
        pg8::StaticOrder S; S.init(g.M, g.N, (int)gridDim.x, (int)blockIdx.x);
        EpiIn E{(bf16_t*)(ws + slot(1)), (float*)(ws + slot(4)), (bf16_t*)(ws + slot(2)), (bf16_t*)(ws + slot(3)), (const float*)(ws + WS_LB)};
        pg8::gemm_phase<EpiIn, pg8::StaticOrder>(lds, g, S, E, nullptr);
    } PHASE_END(1)
    PHASE_BEGIN(2) phase_scan_a(lds, (const float*)(ws + slot(4)), (const bf16_t*)(ws + slot(2)), (bf16_t*)(ws + slot(6)), (float*)(ws + WS_DEC)
#if SCAN_DBG == 3
        , (unsigned*)(ws + WS_CTR + 8192)
#endif
        );
#if SCAN_DBG == 7
        asm volatile("s_waitcnt vmcnt(0)" ::: "memory"); __syncthreads(); grid.sync(); if (threadIdx.x < 64) { __builtin_amdgcn_fence(__ATOMIC_ACQUIRE, "agent"); asm volatile("s_waitcnt vmcnt(0)" ::: "memory"); } __syncthreads();
        dbg_check_a7((const float*)(ws + slot(4)), (const bf16_t*)(ws + slot(2)), (const bf16_t*)(ws + slot(6)), (float*)(ws + WS_CTR + 4096));
#endif
#if SCAN_DBG == 6
#define DSYNC6() asm volatile("s_waitcnt vmcnt(0)" ::: "memory"); __syncthreads(); grid.sync(); if (threadIdx.x < 64) { __builtin_amdgcn_fence(__ATOMIC_ACQUIRE, "agent"); asm volatile("s_waitcnt vmcnt(0)" ::: "memory"); } __syncthreads();
        DSYNC6()
        phase_scan_a(lds, (const float*)(ws + slot(4)), (const bf16_t*)(ws + slot(2)), (bf16_t*)a.out, (float*)(ws + WS_DEC));
        DSYNC6()
        dbg_check_a((LAS float*)lds, (const float*)(ws + slot(4)), (const bf16_t*)(ws + slot(2)), (const bf16_t*)(ws + slot(6)), (const bf16_t*)a.out, (float*)(ws + WS_CTR + 4096));
#endif
#if SCAN_DBG == 3
        asm volatile("s_waitcnt vmcnt(0)" ::: "memory"); __syncthreads(); grid.sync();
        dbg_count_bf16((const bf16_t*)(ws + slot(6)), (size_t)4096 * 16384, (unsigned*)(ws + WS_CTR + 8192) + 2);
#endif
    PHASE_END(2)
    PHASE_BEGIN(3) phase_scan_b((bf16_t*)(ws + slot(6)), (const float*)(ws + WS_DEC));
#if SCAN_DBG == 3
        asm volatile("s_waitcnt vmcnt(0)" ::: "memory"); __syncthreads(); grid.sync();

#endif
    PHASE_END(3)
    PHASE_BEGIN(4) phase_scan_c(lds, (const bf16_t*)(ws + slot(1)), (const float*)(ws + slot(4)), (const bf16_t*)(ws + slot(2)), (const bf16_t*)(ws + slot(3)), (const bf16_t*)(ws + slot(6)), a.in[2], (bf16_t*)(ws + slot(0)));
#if SCAN_DBG == 1
        asm volatile("s_waitcnt vmcnt(0)" ::: "memory"); __syncthreads(); grid.sync();
        phase_scan_naive((const bf16_t*)(ws + slot(1)), (const float*)(ws + slot(4)), (const bf16_t*)(ws + slot(2)), (float*)(ws + slot(6)));
        asm volatile("s_waitcnt vmcnt(0)" ::: "memory"); __syncthreads(); grid.sync();
        phase_onorm((const float*)(ws + slot(6)), (const bf16_t*)(ws + slot(3)), a.in[2], (bf16_t*)(ws + slot(0)));
#endif
#if SCAN_DBG == 3
        asm volatile("s_waitcnt vmcnt(0)" ::: "memory"); __syncthreads(); grid.sync();

#endif
#if SCAN_DBG == 4
#define DSYNC() asm volatile("s_waitcnt vmcnt(0)" ::: "memory"); __syncthreads(); grid.sync(); if (threadIdx.x < 64) { __builtin_amdgcn_fence(__ATOMIC_ACQUIRE, "agent"); asm volatile("s_waitcnt vmcnt(0)" ::: "memory"); } __syncthreads();
        DSYNC()
        phase_scan_naive((const bf16_t*)(ws + slot(1)), (const float*)(ws + slot(4)), (const bf16_t*)(ws + slot(2)), (float*)(ws + slot(6)));
        DSYNC()
        phase_onorm((const float*)(ws + slot(6)), (const bf16_t*)(ws + slot(3)), a.in[2], (bf16_t*)(ws + slot(8)));
        DSYNC()
        phase_scan_a(lds, (const float*)(ws + slot(4)), (const bf16_t*)(ws + slot(2)), (bf16_t*)(ws + slot(6)), (float*)(ws + WS_DEC));
        DSYNC()
        phase_scan_b((bf16_t*)(ws + slot(6)), (const float*)(ws + WS_DEC));
        DSYNC()
        phase_scan_c(lds, (const bf16_t*)(ws + slot(1)), (const float*)(ws + slot(4)), (const bf16_t*)(ws + slot(2)), (const bf16_t*)(ws + slot(3)), (const bf16_t*)(ws + slot(6)), a.in[2], (bf16_t*)a.out);
        DSYNC()
        dbg_compare4((LAS float*)lds, (const bf16_t*)(ws + slot(0)), (const bf16_t*)(ws + slot(8)), (const bf16_t*)a.out, (float*)(ws + WS_CTR + 4096));
#endif
#if SCAN_DBG == 2
        asm volatile("s_waitcnt vmcnt(0)" ::: "memory"); __syncthreads(); grid.sync();
        phase_scan_naive((const bf16_t*)(ws + slot(1)), (const float*)(ws + slot(4)), (const bf16_t*)(ws + slot(2)), (float*)(ws + slot(6)));
        asm volatile("s_waitcnt vmcnt(0)" ::: "memory"); __syncthreads(); grid.sync();
        phase_onorm((const float*)(ws + slot(6)), (const bf16_t*)(ws + slot(3)), a.in[2], (bf16_t*)(ws + slot(8)));
        asm volatile("s_waitcnt vmcnt(0)" ::: "memory"); __syncthreads(); grid.sync();
        dbg_compare((LAS float*)lds, (const bf16_t*)(ws + slot(0)), (const bf16_t*)(ws + slot(8)), (float*)(ws + WS_CTR + 4096));
#endif
    PHASE_END(4)
    PHASE_BEGIN(5) run_gemm_out<false>(a, lds); PHASE_END(5)
    PHASE_BEGIN(6) run_ln<false>(a); PHASE_END(6)
    PHASE_BEGIN(7) run_gemm_sc<false>(a, lds); PHASE_END(7)
    PHASE_BEGIN(8) run_topk<false>(a); PHASE_END(8)
    PHASE_BEGIN(9) run_peer<false>(a); PHASE_END(9)
    PHASE_BEGIN(10) {
        pg8::Gemm g{(const bf16_t*)(ws + slot(2)), (const bf16_t*)(ws + WS_WKVQ), opaque(MTOK), opaque(3 * DM), opaque(DM)};
        pg8::StaticOrder S; S.init(g.M, g.N, (int)gridDim.x, (int)blockIdx.x);
        EpiKVQ E{(bf16_t*)(ws + slot(3)), (bf16_t*)(ws + slot(4)), (bf16_t*)(ws + slot(5))};
        pg8::gemm_phase<EpiKVQ, pg8::StaticOrder>(lds, g, S, E, nullptr);
    } PHASE_END(10)
    PHASE_BEGIN(11) phase_rot((LAS float*)lds, (bf16_t*)(ws + slot(3)), (bf16_t*)(ws + slot(5)), (const float*)(ws + WS_COS), (const float*)(ws + WS_SIN), (float*)(ws + WS_KMEAN), (float*)(ws + WS_KNMAX)); PHASE_END(11)
    PHASE_BEGIN(12) phase_sel(lds, (const bf16_t*)(ws + slot(5)), (const float*)(ws + WS_KMEAN), (unsigned short*)(ws + WS_SUB), (int*)(ws + WS_CNT), (int*)(ws + WS_CTR)); PHASE_END(12)
    PHASE_BEGIN(13) phase_att(lds, (const bf16_t*)(ws + slot(5)), (const bf16_t*)(ws + slot(3)), (const bf16_t*)(ws + slot(4)), (const float*)(ws + WS_KNMAX), (const unsigned short*)(ws + WS_SUB),
                              (const int*)(ws + WS_CNT), (int*)(ws + WS_CTR), (bf16_t*)(ws + slot(6)), (bf16_t*)(ws + slot(2)), (float*)(ws + WS_LS)); PHASE_END(13)
    PHASE_BEGIN(14) phase_comb((const bf16_t*)(ws + slot(6)), (const bf16_t*)(ws + slot(2)), (const float*)(ws + WS_LS), (bf16_t*)(ws + slot(3))); PHASE_END(14)
    PHASE_BEGIN(15) run_gemm_out<true>(a, lds); PHASE_END(15)
    PHASE_BEGIN(16) run_ln<true>(a); PHASE_END(16)
    PHASE_BEGIN(17) run_gemm_sc<true>(a, lds); PHASE_END(17)
    PHASE_BEGIN(18) run_topk<true>(a); PHASE_END(18)
#if SCAN_DBG == 7
    PHASE_BEGIN(19) dbg_emit7((const float*)(ws + WS_CTR + 4096), a.out); PHASE_END(19)
#elif SCAN_DBG == 6
    PHASE_BEGIN(19) dbg_emit4((const float*)(ws + WS_CTR + 4096), a.out); PHASE_END(19)
#elif SCAN_DBG == 5
    PHASE_BEGIN(19) dbg_emit5((const unsigned*)(ws + WS_CTR + 8192), a.out); PHASE_END(19)
#elif SCAN_DBG == 4
    PHASE_BEGIN(19) dbg_emit4((const float*)(ws + WS_CTR + 4096), a.out); PHASE_END(19)
#elif SCAN_DBG == 3
    PHASE_BEGIN(19) dbg_emit3((const unsigned*)(ws + WS_CTR + 8192), a.out); PHASE_END(19)
#elif SCAN_DBG == 2
    PHASE_BEGIN(19) dbg_emit((const float*)(ws + WS_CTR + 4096), a.out); PHASE_END(19)
#else
    PHASE_BEGIN(19) run_peer<true>(a); PHASE_END(19)
#endif
}

extern "C" void kernel_launch(void* const* d_in, const int* in_sizes, int n_in, void* d_out, int out_size, void* d_ws, size_t ws_size, hipStream_t stream) {
    static int grid = 0;
    if (grid == 0) {
        if (n_in != 14 || out_size != MTOK * DM || ws_size < WS_END) { fprintf(stderr, "kernel_launch: unexpected shapes (n_in %d, out %d, ws %zu)\n", n_in, out_size, ws_size); grid = -1; return; }
        int dev = 0, cus = 0, per_cu = 0;
        if (hipGetDevice(&dev) != hipSuccess || hipDeviceGetAttribute(&cus, hipDeviceAttributeMultiprocessorCount, dev) != hipSuccess) { grid = -1; return; }
        if (hipFuncSetAttribute((const void*)mk_fwd, hipFuncAttributeMaxDynamicSharedMemorySize, LDS_BYTES) != hipSuccess) { fprintf(stderr, "kernel_launch: hipFuncSetAttribute failed\n"); grid = -1; return; }
        if (hipOccupancyMaxActiveBlocksPerMultiprocessor(&per_cu, (const void*)mk_fwd, 512, LDS_BYTES) != hipSuccess || per_cu < 1) { fprintf(stderr, "kernel_launch: occupancy query failed (%d)\n", per_cu); (void)hipGetLastError(); per_cu = 1; }
        grid = cus * (per_cu > 1 ? 1 : per_cu);
    }
    if (grid < 0) return;
    Args a{};
    for (int i = 0; i < 14; ++i) a.in[i] = (const float*)d_in[i];
    a.out = (float*)d_out; a.ws = (unsigned char*)d_ws;
#if ONE_LAUNCH
    a.ph_lo = 0; a.ph_hi = NPH;
    void* args[] = {&a};
    hipError_t e = hipLaunchCooperativeKernel((const void*)mk_fwd, dim3(grid), dim3(512), args, LDS_BYTES, stream);
    if (e != hipSuccess) fprintf(stderr, "cooperative launch failed: %s (grid %d)\n", hipGetErrorString(e), grid);
#else
    for (int ph = 0; ph < NPH; ++ph) {
        a.ph_lo = ph; a.ph_hi = ph + 1;
        hipLaunchKernelGGL(mk_fwd, dim3(grid), dim3(512), LDS_BYTES, stream, a);
    }
#endif
}
```

```cpp
#define ONE_LAUNCH 1
#include <hip/hip_runtime.h>
#include <hip/hip_cooperative_groups.h>
#include <cstdio>
namespace cg = cooperative_groups;

#ifndef ONE_LAUNCH
#define ONE_LAUNCH 0
#endif
#ifndef SCAN_DBG
#define SCAN_DBG 0
#endif
#ifndef SCAN_A_VALU
#define SCAN_A_VALU 0
#endif
#ifndef ENMASK
#define ENMASK 0xffffffffu
#endif
#define EN(k) ((ENMASK >> (k)) & 1u)

namespace pg8 {
#define PG8_LAS __attribute__((address_space(3)))
typedef unsigned short bf16_t;
typedef short bf16x8 __attribute__((ext_vector_type(8)));
typedef float f32x4 __attribute__((ext_vector_type(4)));
typedef unsigned u32x4 __attribute__((ext_vector_type(4)));
constexpr int BM = 256, BK = 64, HALF = 128, HTB = HALF * BK * 2  , STAGE_BYTES = 8 * HTB, NXCD = 8, WGM = 8;

__host__ __device__ __forceinline__ int lds_byte(int r, int c) { const int st = (r >> 4) * 2 + (c >> 5), rr = r & 15, cc = c & 31, ob = rr * 64 + cc * 2; return st * 1024 + (ob ^ (((ob >> 9) & 1) << 5)); }
__host__ __device__ __forceinline__ void stage_rc(int b, int& R, int& C) { const int st = b / 1024, sb = b % 1024, swz = sb ^ (((sb >> 9) & 1) << 5); R = (st >> 1) * 16 + swz / 64; C = (st & 1) * 32 + (swz % 64) / 2; }
__host__ __device__ __forceinline__ int perm32(int rho) { const int n = rho >> 4, i = rho & 15; return 8 * (i >> 2) + 4 * n + (i & 3); }

struct Unit { int pm, pn; };
struct Gemm { const bf16_t* A; const bf16_t* Bt; int M, N, K; };

struct StaticOrder {
    int nM, nN, nwg, G, c;
    __host__ __device__ void init(int M, int N, int G_, int c_) { nM = M / BM; nN = N / BM; nwg = nM * nN; G = G_; c = c_; }
    __host__ __device__ bool next(int i, Unit& u) const {
        const long L = (long)i * G + c; if (L >= nwg) return false;
        int wgid = (int)L; { const int q = nwg / NXCD, r = nwg % NXCD, xcd = wgid % NXCD, off = wgid / NXCD; wgid = (xcd < r ? xcd * (q + 1) : r * (q + 1) + (xcd - r) * q) + off; }
        const int nig = WGM * nN, gid = wgid / nig, fm = gid * WGM, gsz = (nM - fm) < WGM ? (nM - fm) : WGM;
        u.pm = fm + ((wgid % nig) % gsz); u.pn = (wgid % nig) / gsz; return true;
    }
    __device__ __forceinline__ void a_ready(const Unit&) const {}
    __device__ __forceinline__ void done(const Unit&) const {}
};
struct CountedOrder : StaticOrder {
    const unsigned* ready; unsigned need; unsigned* tmo;
    __device__ __forceinline__ void a_ready(const Unit& u) const {
        if (threadIdx.x < 64) {
            const unsigned long long t0 = __builtin_amdgcn_s_memrealtime(); unsigned polls = 0;
            while ((unsigned)__builtin_amdgcn_readfirstlane(__hip_atomic_load(ready + 64 * u.pm, __ATOMIC_RELAXED, __HIP_MEMORY_SCOPE_AGENT)) < need) {
                if ((++polls & 255u) == 0u && __builtin_amdgcn_readfirstlane(__hip_atomic_load(tmo, __ATOMIC_RELAXED, __HIP_MEMORY_SCOPE_AGENT)) != 0u) break;
                if (__builtin_amdgcn_s_memrealtime() - t0 > 2000000ull) {
                    if (threadIdx.x == 0) { unsigned expect = 0u; __hip_atomic_compare_exchange_strong(tmo + 1, &expect, 0x600u | (unsigned)(u.pm & 0xff), __ATOMIC_RELAXED, __ATOMIC_RELAXED, __HIP_MEMORY_SCOPE_AGENT); __hip_atomic_store(tmo, 1u, __ATOMIC_RELAXED, __HIP_MEMORY_SCOPE_AGENT); }
                    break; }
                __builtin_amdgcn_s_sleep(2); }
            __builtin_amdgcn_fence(__ATOMIC_ACQUIRE, "agent");
            asm volatile("s_waitcnt vmcnt(0)" ::: "memory");
        }
#if !defined(BROKEN_HOOK_NO_BARRIER)
        asm volatile("" ::: "memory"); __builtin_amdgcn_s_barrier(); asm volatile("" ::: "memory");
#endif
    }
};

__device__ __forceinline__ unsigned cvt_pk_bf16(float lo, float hi) { unsigned r; asm volatile("v_cvt_pk_bf16_f32 %0, %1, %2" : "=v"(r) : "v"(lo), "v"(hi)); return r; }
typedef float f32x2 __attribute__((ext_vector_type(2)));
__device__ __forceinline__ f32x2 gelu_pk(f32x2 v) {
    const f32x2 av = __builtin_elementwise_abs(v), d = av * 0.2316418882f + 1.0f;
    f32x2 t; t.x = __builtin_amdgcn_rcpf(d.x); t.y = __builtin_amdgcn_rcpf(d.y);
    f32x2 q = t * 0.5307027145f + (-0.7265760135f); q = q * t + 0.7107068705f; q = q * t + (-0.142248368f); q = q * t + 0.127414796f; q = q * t;
    const f32x2 s = (v * v) * (-0.72134752044f);
    f32x2 e; e.x = __builtin_amdgcn_exp2f(s.x); e.y = __builtin_amdgcn_exp2f(s.y);
    const f32x2 m = v * (q * e), r = v - m;
    f32x2 o; o.x = v.x < 0.f ? m.x : r.x; o.y = v.y < 0.f ? m.y : r.y; return o;
}

struct EpiF32 {
    static constexpr bool PERM = false, AFTER_DRAIN = false;
    float* C; int ldc; const float* bias;
    __device__ __forceinline__ void operator()(const f32x4 (&acc)[2][2][4][2], const Unit& u, int wr, int wc, int fr, int fq) const {
        const int row0 = u.pm * BM + wr * 64 + fr, col0 = u.pn * BM + wc * 32 + 4 * fq;
        f32x4 bv[2][2];
#pragma unroll
        for (int bj = 0; bj < 2; ++bj)
#pragma unroll
            for (int n = 0; n < 2; ++n) bv[bj][n] = bias ? *(const f32x4*)(bias + col0 + bj * HALF + n * 16) : (f32x4){0.f, 0.f, 0.f, 0.f};
#pragma unroll
        for (int ai = 0; ai < 2; ++ai)
#pragma unroll
            for (int m = 0; m < 4; ++m) { float* rowp = C + (size_t)(row0 + ai * HALF + m * 16) * ldc + col0;
#pragma unroll
                for (int bj = 0; bj < 2; ++bj)
#pragma unroll
                    for (int n = 0; n < 2; ++n) *(f32x4*)(rowp + bj * HALF + n * 16) = acc[ai][bj][m][n] + bv[bj][n]; }
    }
};
template <int ACT  > struct EpiBf16 {
    static constexpr bool PERM = true, AFTER_DRAIN = false;
    bf16_t* O; int ldc; const float* bias; int split_cols; size_t split_stride;
    __device__ __forceinline__ void operator()(const f32x4 (&acc)[2][2][4][2], const Unit& u, int wr, int wc, int fr, int fq) const {
        const int row0 = u.pm * BM + wr * 64 + fr; int colt = u.pn * BM; bf16_t* base = O;
        if (split_cols) { const int t = colt / split_cols; base += (size_t)t * split_stride; colt -= t * split_cols; }
        const int col0 = colt + wc * 32 + 8 * fq, bcol0 = u.pn * BM + wc * 32 + 8 * fq;
        f32x4 bv[2][2];
#pragma unroll
        for (int bj = 0; bj < 2; ++bj)
#pragma unroll
            for (int n = 0; n < 2; ++n) bv[bj][n] = bias ? *(const f32x4*)(bias + bcol0 + bj * HALF + 4 * n) : (f32x4){0.f, 0.f, 0.f, 0.f};
#pragma unroll
        for (int ai = 0; ai < 2; ++ai)
#pragma unroll
            for (int m = 0; m < 4; ++m) { bf16_t* rowp = base + (size_t)(row0 + ai * HALF + m * 16) * ldc + col0;
#pragma unroll
                for (int bj = 0; bj < 2; ++bj) { f32x4 v0 = acc[ai][bj][m][0] + bv[bj][0], v1 = acc[ai][bj][m][1] + bv[bj][1];
                    if (ACT == 1) { f32x2 a = gelu_pk((f32x2){v0[0], v0[1]}), b = gelu_pk((f32x2){v0[2], v0[3]}), c = gelu_pk((f32x2){v1[0], v1[1]}), d = gelu_pk((f32x2){v1[2], v1[3]});
                        v0 = (f32x4){a.x, a.y, b.x, b.y}; v1 = (f32x4){c.x, c.y, d.x, d.y}; }
                    if (ACT == 2) {
#pragma unroll
                        for (int j = 0; j < 4; ++j) { v0[j] = 0.5f * v0[j] * (1.0f + erff(v0[j] * 0.70710678f)); v1[j] = 0.5f * v1[j] * (1.0f + erff(v1[j] * 0.70710678f)); } }
                    u32x4 w; w.x = cvt_pk_bf16(v0[0], v0[1]); w.y = cvt_pk_bf16(v0[2], v0[3]); w.z = cvt_pk_bf16(v1[0], v1[1]); w.w = cvt_pk_bf16(v1[2], v1[3]);
                    *(u32x4*)(rowp + bj * HALF) = w; } }
    }
};

template <class Epi, class Sched, bool STAMP = false>
__device__ __forceinline__ void gemm_phase(PG8_LAS unsigned char* lds, const Gemm g, const Sched& S, const Epi& E, unsigned long long* stamps) {
    const int tid = threadIdx.x, wid = __builtin_amdgcn_readfirstlane(tid >> 6), lane = tid & 63, wr = wid >> 2, wc = wid & 3, fr = lane & 15, fq = lane >> 4;
    const int K = g.K, nt = K / BK;
    int ts_lo = 0, ts_hi = 0, nts = 0; const unsigned long long rt_entry = STAMP ? (unsigned long long)wall_clock64() : 0ull;
#define PG8_STAMP() do { if (STAMP && wid == 0 && nts < 64) { const unsigned long long _c = (unsigned long long)clock64(); \
        ts_lo = (lane == nts) ? (int)(unsigned)_c : ts_lo; ts_hi = (lane == nts) ? (int)(unsigned)(_c >> 32) : ts_hi; ++nts; } } while (0)
    PG8_STAMP();
    unsigned voffA[2], voffB[2];
#pragma unroll
    for (int i = 0; i < 2; ++i) { int R, C; stage_rc(tid * 16 + i * 8192, R, C); const int Rb = Epi::PERM ? ((R & ~31) + perm32(R & 31)) : R;
        voffA[i] = (unsigned)(R * K + C) * 2u; voffB[i] = (unsigned)(Rb * K + C) * 2u; }
    const size_t kstep = (size_t)(BK * 2);
    const size_t hstep = (size_t)HALF * K * 2;
    const size_t tstep = 2 * hstep;
    const unsigned ldsw = (unsigned)wid * 1024u;
    const int aoff = lds_byte(wr * 64 + fr, fq * 8), boff = lds_byte(wc * 32 + fr, fq * 8);
#define PG8_SA(b, h) (((b) * 2 + (h)) * HTB)
#define PG8_SB(b, h) ((4 + (b) * 2 + (h)) * HTB)
#define PG8_STAGE(bufoff, gbase, voff) do { _Pragma("unroll") for (int _i = 0; _i < 2; ++_i) \
        __builtin_amdgcn_global_load_lds((const unsigned*)((const char*)(gbase) + (voff)[_i]), (PG8_LAS unsigned*)(lds + (bufoff) + ldsw + _i * 8192), 16, 0, 0); } while (0)
#define PG8_LDA(dst, b, h) do { _Pragma("unroll") for (int m = 0; m < 4; ++m) _Pragma("unroll") for (int k = 0; k < 2; ++k) dst[m][k] = *(const PG8_LAS bf16x8*)(lds + PG8_SA(b, h) + aoff + m * 2048 + k * 1024); } while (0)
#define PG8_LDB(dst, b, h) do { _Pragma("unroll") for (int n = 0; n < 2; ++n) _Pragma("unroll") for (int k = 0; k < 2; ++k) dst[n][k] = *(const PG8_LAS bf16x8*)(lds + PG8_SB(b, h) + boff + n * 2048 + k * 1024); } while (0)
#define PG8_MMA(ai, bj, At, Bt) do { __builtin_amdgcn_s_setprio(1); _Pragma("unroll") for (int m = 0; m < 4; ++m) _Pragma("unroll") for (int n = 0; n < 2; ++n) _Pragma("unroll") for (int k = 0; k < 2; ++k) \
        acc[ai][bj][m][n] = __builtin_amdgcn_mfma_f32_16x16x32_bf16(Bt[n][k], At[m][k], acc[ai][bj][m][n], 0, 0, 0); __builtin_amdgcn_s_setprio(0); } while (0)
#define PG8_WAIT_V(n) asm volatile("s_waitcnt vmcnt(" #n ")" ::: "memory")
#define PG8_WAIT_L(n) asm volatile("s_waitcnt lgkmcnt(" #n ")" ::: "memory")
#define PG8_BAR __builtin_amdgcn_s_barrier()
#define PG8_SCHED __builtin_amdgcn_sched_barrier(0)
    Unit cur, nxt; int ui = 0;
    if (!S.next(0, cur)) return;
    f32x4 acc[2][2][4][2];
#pragma unroll
    for (int a = 0; a < 2; ++a)
#pragma unroll
        for (int b = 0; b < 2; ++b)
#pragma unroll
            for (int m = 0; m < 4; ++m)
#pragma unroll
                for (int n = 0; n < 2; ++n) acc[a][b][m][n] = (f32x4){0.f, 0.f, 0.f, 0.f};
    bf16x8 At[4][2], B0[2][2], B1[2][2];
    const char* cA = (const char*)g.A + (size_t)cur.pm * tstep; const char* cB = (const char*)g.Bt + (size_t)cur.pn * tstep;
    S.a_ready(cur);
    PG8_STAGE(PG8_SB(0, 0), cB, voffB); PG8_STAGE(PG8_SA(0, 0), cA, voffA); PG8_STAGE(PG8_SB(0, 1), cB + hstep, voffB); PG8_STAGE(PG8_SA(0, 1), cA + hstep, voffA);
    if (wr == 1) PG8_BAR;
    PG8_WAIT_V(4); PG8_BAR;
    PG8_STAGE(PG8_SB(1, 0), cB + kstep, voffB); PG8_STAGE(PG8_SA(1, 0), cA + kstep, voffA); PG8_STAGE(PG8_SB(1, 1), cB + hstep + kstep, voffB);
    PG8_WAIT_V(6); PG8_BAR;
    PG8_STAMP();
    for (;;) {
        const bool has_next = S.next(ui + 1, nxt);
        const char* nA = has_next ? (const char*)g.A + (size_t)nxt.pm * tstep : cA; const char* nB = has_next ? (const char*)g.Bt + (size_t)nxt.pn * tstep : cB;
        for (int t = 0; t < nt; t += 2) {
            const bool last = (t == nt - 2);
            const char* a1 = cA + (size_t)(t + 1) * kstep;
            const char* a2 = last ? nA : cA + (size_t)(t + 2) * kstep; const char* b2 = last ? nB : cB + (size_t)(t + 2) * kstep;
            const char* a3 = a2 + kstep; const char* b3 = b2 + kstep;
            if (last && has_next) S.a_ready(nxt);
            PG8_LDB(B0, 0, 0); PG8_SCHED; PG8_LDA(At, 0, 0); PG8_STAGE(PG8_SA(1, 1), a1 + hstep, voffA);
            PG8_WAIT_L(8); PG8_BAR; PG8_WAIT_L(0); PG8_MMA(0, 0, At, B0); PG8_BAR; PG8_SCHED;
            PG8_LDB(B1, 0, 1); PG8_STAGE(PG8_SB(0, 0), b2, voffB);
            PG8_BAR; PG8_WAIT_L(0); PG8_MMA(0, 1, At, B1); PG8_BAR;
            PG8_LDA(At, 0, 1); PG8_STAGE(PG8_SA(0, 0), a2, voffA);
            PG8_BAR; PG8_WAIT_L(0); PG8_MMA(1, 0, At, B0); PG8_BAR; PG8_SCHED;
            PG8_STAGE(PG8_SB(0, 1), b2 + hstep, voffB);
            PG8_WAIT_V(6); PG8_BAR; PG8_MMA(1, 1, At, B1); PG8_BAR;
            PG8_LDB(B0, 1, 0); PG8_SCHED; PG8_LDA(At, 1, 0); PG8_STAGE(PG8_SA(0, 1), a2 + hstep, voffA);
            PG8_WAIT_L(8); PG8_BAR; PG8_WAIT_L(0); PG8_MMA(0, 0, At, B0); PG8_BAR; PG8_SCHED;
            PG8_LDB(B1, 1, 1); PG8_STAGE(PG8_SB(1, 0), b3, voffB);
            PG8_BAR; PG8_WAIT_L(0); PG8_MMA(0, 1, At, B1); PG8_BAR;
            PG8_LDA(At, 1, 1); PG8_STAGE(PG8_SA(1, 0), a3, voffA);
            PG8_BAR; PG8_WAIT_L(0); PG8_MMA(1, 0, At, B0); PG8_BAR; PG8_SCHED;
            PG8_STAGE(PG8_SB(1, 1), b3 + hstep, voffB);
            PG8_WAIT_V(6); PG8_BAR; PG8_MMA(1, 1, At, B1); PG8_BAR;
        }
        PG8_STAMP();
        if constexpr (!Epi::AFTER_DRAIN) { E(acc, cur, wr, wc, fr, fq); S.done(cur); }
        PG8_STAMP();
        if (!has_next) break;
#pragma unroll
        for (int a = 0; a < 2; ++a)
#pragma unroll
            for (int b = 0; b < 2; ++b)
#pragma unroll
                for (int m = 0; m < 4; ++m)
#pragma unroll
                    for (int n = 0; n < 2; ++n) acc[a][b][m][n] = (f32x4){0.f, 0.f, 0.f, 0.f};
        cur = nxt; cA = nA; cB = nB; ++ui;
    }
    PG8_WAIT_V(0);
    if (wr == 0) PG8_BAR;
    PG8_BAR;
    if constexpr (Epi::AFTER_DRAIN) { E.fused(acc, cur, wr, wc, fr, fq, lds, wid, lane); S.done(cur); }
    PG8_STAMP();
    if (STAMP && wid == 0) { stamps[lane] = lane < nts ? (((unsigned long long)(unsigned)ts_hi << 32) | (unsigned)ts_lo) : 0ull;
        if (lane == 62) stamps[62] = rt_entry; if (lane == 63) stamps[63] = (unsigned long long)wall_clock64(); }
#undef PG8_STAMP
#undef PG8_SA
#undef PG8_SB
#undef PG8_STAGE
#undef PG8_LDA
#undef PG8_LDB
#undef PG8_MMA
#undef PG8_WAIT_V
#undef PG8_WAIT_L
#undef PG8_BAR
#undef PG8_SCHED
}
}


#define LAS __attribute__((address_space(3)))
typedef unsigned short bf16_t;
typedef float f32x4 __attribute__((ext_vector_type(4)));
typedef unsigned u32x4 __attribute__((ext_vector_type(4)));
typedef unsigned u32x2 __attribute__((ext_vector_type(2)));

constexpr int MTOK = 16384, DM = 2048, SEQ = 8192, NHEAD = 16;
constexpr float ALPHA = 1.41421356237309515f;
constexpr size_t MiB = (size_t)1 << 20;
constexpr size_t WS_WIN = 0, WS_WOUT = 32 * MiB, WS_WKVQ = 40 * MiB, WS_WO = 64 * MiB, WS_WC = 72 * MiB, WS_UB = 88 * MiB, WS_VB = 216 * MiB, WS_SLOT = 344 * MiB;
constexpr size_t WS_EID = 920 * MiB, WS_GATE = 928 * MiB, WS_COS = 936 * MiB, WS_SIN = 938 * MiB, WS_KMEAN = 940 * MiB, WS_LB = 941 * MiB, WS_LS = 942 * MiB, WS_SUB = 946 * MiB, WS_CNT = 962 * MiB, WS_CTR = 963 * MiB, WS_DEC = 964 * MiB, WS_END = 966 * MiB;
constexpr size_t WS_KNMAX = WS_KMEAN + 768 * 1024;
__host__ __device__ constexpr size_t slot(int i) { return WS_SLOT + (size_t)i * 64 * MiB; }
constexpr int LDS_BYTES = 144 * 1024;
constexpr int NPH = 20;

struct Args { const float* in[14]; float* out; unsigned char* ws; int ph_lo, ph_hi; };

__device__ __forceinline__ float bflo(unsigned w) { return __uint_as_float(w << 16); }
__device__ __forceinline__ float bfhi(unsigned w) { return __uint_as_float(w & 0xffff0000u); }
__device__ __forceinline__ float bf2f(bf16_t b) { return __uint_as_float(((unsigned)b) << 16); }
typedef __bf16 bf16x2_t __attribute__((ext_vector_type(2)));
typedef float f32x2_t __attribute__((ext_vector_type(2)));
__device__ __forceinline__ unsigned pk_bf16(float lo, float hi) { const f32x2_t f = {lo, hi}; return __builtin_bit_cast(unsigned, __builtin_convertvector(f, bf16x2_t)); }
__device__ __forceinline__ float wave_sum(float v) {
#pragma unroll
    for (int o = 32; o >= 1; o >>= 1) v += __shfl_xor(v, o);
    return v;
}
__device__ __forceinline__ float wave_max(float v) {
#pragma unroll
    for (int o = 32; o >= 1; o >>= 1) v = fmaxf(v, __shfl_xor(v, o));
    return v;
}
__device__ __forceinline__ float sigmoidf_(float z) { return 1.0f / (1.0f + __expf(-z)); }


__device__ __forceinline__ void store_wt16(void* p, u32x4 v) {
    __hip_atomic_store((unsigned long long*)p, ((unsigned long long)v.y << 32) | v.x, __ATOMIC_RELAXED, __HIP_MEMORY_SCOPE_AGENT);
    __hip_atomic_store((unsigned long long*)p + 1, ((unsigned long long)v.w << 32) | v.z, __ATOMIC_RELAXED, __HIP_MEMORY_SCOPE_AGENT);
}
__device__ __forceinline__ void store_wt8(void* p, u32x2 v) {
    __hip_atomic_store((unsigned long long*)p, ((unsigned long long)v.y << 32) | v.x, __ATOMIC_RELAXED, __HIP_MEMORY_SCOPE_AGENT);
}
struct EpiIn {
    static constexpr bool PERM = true, AFTER_DRAIN = false;
    bf16_t* Q1; float* LF; bf16_t* I1; bf16_t* G1; const float* LB;
    __device__ __forceinline__ void operator()(const pg8::f32x4 (&acc)[2][2][4][2], const pg8::Unit& u, int wr, int wc, int fr, int fq) const {
        const int type = u.pn >> 3;
        const int row0 = u.pm * 256 + wr * 64 + fr, col0 = (u.pn & 7) * 256 + wc * 32 + 8 * fq;
        if (type == 1) {
#pragma unroll
            for (int bj = 0; bj < 2; ++bj) {
                const int c = col0 + bj * 128;
                const f32x4 lb0 = *(const f32x4*)(LB + c), lb1 = *(const f32x4*)(LB + c + 4);
#pragma unroll
                for (int ai = 0; ai < 2; ++ai)
#pragma unroll
                    for (int m = 0; m < 4; ++m) {
                        float* p = LF + (size_t)(row0 + ai * 128 + m * 16) * DM + c;
                        f32x4 o0, o1;
#pragma unroll
                        for (int j = 0; j < 4; ++j) {
                            o0[j] = __logf(lb0[j] + (1.0f - lb0[j]) * sigmoidf_(acc[ai][bj][m][0][j]));
                            o1[j] = __logf(lb1[j] + (1.0f - lb1[j]) * sigmoidf_(acc[ai][bj][m][1][j]));
                        }
                        *(f32x4*)p = o0; *(f32x4*)(p + 4) = o1;
                    }
            }
        } else {
            bf16_t* dst = Q1 + (size_t)(type - (type > 0 ? 1 : 0)) * ((size_t)32 << 20);
            const bool act = (type != 2);
#pragma unroll
            for (int ai = 0; ai < 2; ++ai)
#pragma unroll
                for (int m = 0; m < 4; ++m)
#pragma unroll
                    for (int bj = 0; bj < 2; ++bj) {
                        f32x4 v0 = acc[ai][bj][m][0], v1 = acc[ai][bj][m][1];
                        if (act) {
#pragma unroll
                            for (int j = 0; j < 4; ++j) { v0[j] = v0[j] * sigmoidf_(v0[j]); v1[j] = v1[j] * sigmoidf_(v1[j]); }
                        }
                        u32x4 w; w.x = pk_bf16(v0[0], v0[1]); w.y = pk_bf16(v0[2], v0[3]); w.z = pk_bf16(v1[0], v1[1]); w.w = pk_bf16(v1[2], v1[3]);
                        *(u32x4*)(dst + (size_t)(row0 + ai * 128 + m * 16) * DM + col0 + bj * 128) = w;
                    }
        }
    }
};
struct EpiRes {
    static constexpr bool PERM = false, AFTER_DRAIN = false;
    const float* res; float* Y;
    __device__ __forceinline__ void operator()(const pg8::f32x4 (&acc)[2][2][4][2], const pg8::Unit& u, int wr, int wc, int fr, int fq) const {
        const int row0 = u.pm * 256 + wr * 64 + fr, col0 = u.pn * 256 + wc * 32 + 4 * fq;
#pragma unroll
        for (int ai = 0; ai < 2; ++ai)
#pragma unroll
            for (int m = 0; m < 4; ++m) {
                const size_t off = (size_t)(row0 + ai * 128 + m * 16) * DM + col0;
#pragma unroll
                for (int bj = 0; bj < 2; ++bj)
#pragma unroll
                    for (int n = 0; n < 2; ++n) {
                        const f32x4 r = *(const f32x4*)(res + off + bj * 128 + n * 16);
                        *(f32x4*)(Y + off + bj * 128 + n * 16) = r * ALPHA + acc[ai][bj][m][n];
                    }
            }
    }
};
struct EpiF32 {
    static constexpr bool PERM = false, AFTER_DRAIN = false;
    float* C;
    __device__ __forceinline__ void operator()(const pg8::f32x4 (&acc)[2][2][4][2], const pg8::Unit& u, int wr, int wc, int fr, int fq) const {
        const int row0 = u.pm * 256 + wr * 64 + fr, col0 = u.pn * 256 + wc * 32 + 4 * fq;
#pragma unroll
        for (int ai = 0; ai < 2; ++ai)
#pragma unroll
            for (int m = 0; m < 4; ++m) {
                float* p = C + (size_t)(row0 + ai * 128 + m * 16) * DM + col0;
#pragma unroll
                for (int bj = 0; bj < 2; ++bj)
#pragma unroll
                    for (int n = 0; n < 2; ++n) *(f32x4*)(p + bj * 128 + n * 16) = acc[ai][bj][m][n];
            }
    }
};
struct EpiKVQ {
    static constexpr bool PERM = true, AFTER_DRAIN = false;
    bf16_t* K; bf16_t* V; bf16_t* Q;
    __device__ __forceinline__ void operator()(const pg8::f32x4 (&acc)[2][2][4][2], const pg8::Unit& u, int wr, int wc, int fr, int fq) const {
        const int t = u.pn >> 3;
        bf16_t* dst = K + (size_t)t * ((size_t)32 << 20);
        const int row0 = u.pm * 256 + wr * 64 + fr, col0 = (u.pn & 7) * 256 + wc * 32 + 8 * fq;
#pragma unroll
        for (int ai = 0; ai < 2; ++ai)
#pragma unroll
            for (int m = 0; m < 4; ++m)
#pragma unroll
                for (int bj = 0; bj < 2; ++bj) {
                    const f32x4 v0 = acc[ai][bj][m][0], v1 = acc[ai][bj][m][1];
                    u32x4 w; w.x = pk_bf16(v0[0], v0[1]); w.y = pk_bf16(v0[2], v0[3]); w.z = pk_bf16(v1[0], v1[1]); w.w = pk_bf16(v1[2], v1[3]);
                    *(u32x4*)(dst + (size_t)(row0 + ai * 128 + m * 16) * DM + col0 + bj * 128) = w;
                }
    }
};

__device__ __forceinline__ void transpose_tiles(LAS float* tile, const float* src, int ldn, int K, int N, bf16_t* dst) {
    const int tid = threadIdx.x;
    const int tn = N / 64, ntiles = tn * (K / 64);
    for (int tI = blockIdx.x; tI < ntiles; tI += gridDim.x) {
        const int k0 = (tI / tn) * 64, n0 = (tI % tn) * 64;
#pragma unroll
        for (int r = 0; r < 2; ++r) {
            const int kk = (tid >> 4) + 32 * r, nn = (tid & 15) * 4;
            const f32x4 v = *(const f32x4*)(src + (size_t)(k0 + kk) * ldn + n0 + nn);
            tile[kk * 65 + nn + 0] = v[0]; tile[kk * 65 + nn + 1] = v[1]; tile[kk * 65 + nn + 2] = v[2]; tile[kk * 65 + nn + 3] = v[3];
        }
        __syncthreads();
        {
            const int nn = tid >> 3, kk8 = (tid & 7) * 8;
            float f[8];
#pragma unroll
            for (int j = 0; j < 8; ++j) f[j] = tile[(kk8 + j) * 65 + nn];
            u32x4 w; w.x = pk_bf16(f[0], f[1]); w.y = pk_bf16(f[2], f[3]); w.z = pk_bf16(f[4], f[5]); w.w = pk_bf16(f[6], f[7]);
            *(u32x4*)(dst + (size_t)(n0 + nn) * K + k0 + kk8) = w;
        }
        __syncthreads();
    }
}
__device__ __forceinline__ void convert_bf16(const float* src, bf16_t* dst, size_t n) {
    const size_t stride = (size_t)gridDim.x * 512 * 8;
    for (size_t i = ((size_t)blockIdx.x * 512 + threadIdx.x) * 8; i < n; i += stride) {
        const f32x4 a = *(const f32x4*)(src + i), b = *(const f32x4*)(src + i + 4);
        u32x4 w; w.x = pk_bf16(a[0], a[1]); w.y = pk_bf16(a[2], a[3]); w.z = pk_bf16(b[0], b[1]); w.w = pk_bf16(b[2], b[3]);
        *(u32x4*)(dst + i) = w;
    }
}
__device__ __forceinline__ void fold_peer_keys(LAS float* lds, const float* w_query, const float* sub_keys, bf16_t* WcT) {
    const int tid = threadIdx.x;
    LAS float* Ss = lds;
    LAS float* Ws = lds + 128 * 132;
    for (int item = blockIdx.x; item < 1024; item += gridDim.x) {
        const int l = item >> 9, rem = item & 511, hh = rem >> 5, kb = rem & 31, h = hh >> 1, half = hh & 1;
        const float* sk = sub_keys + (size_t)(((l * 2 + half) * 8 + h) * 128) * 128;
        const float* wq = w_query + (size_t)l * DM * DM + (size_t)(kb * 64) * DM + h * 256 + half * 128;
#pragma unroll
        for (int r = 0; r < 8; ++r) { const int idx = tid + 512 * r, key = idx >> 5, d4 = (idx & 31) * 4; *(LAS f32x4*)(Ss + key * 132 + d4) = *(const f32x4*)(sk + key * 128 + d4); }
#pragma unroll
        for (int r = 0; r < 4; ++r) { const int idx = tid + 512 * r, kin = idx >> 5, d4 = (idx & 31) * 4; *(LAS f32x4*)(Ws + kin * 128 + d4) = *(const f32x4*)(wq + (size_t)kin * DM + d4); }
        __syncthreads();
        const int key = tid & 127, kq = tid >> 7;
        float acc[16];
#pragma unroll
        for (int j = 0; j < 16; ++j) acc[j] = 0.f;
        for (int d4 = 0; d4 < 32; ++d4) {
            const f32x4 s4 = *(const LAS f32x4*)(Ss + key * 132 + d4 * 4);
#pragma unroll
            for (int j = 0; j < 16; ++j) { const f32x4 w4 = *(const LAS f32x4*)(Ws + (kq * 16 + j) * 128 + d4 * 4); acc[j] += s4[0] * w4[0] + s4[1] * w4[1] + s4[2] * w4[2] + s4[3] * w4[3]; }
        }
        bf16_t* o = WcT + (size_t)l * DM * DM + (size_t)(h * 256 + half * 128 + key) * DM + kb * 64 + kq * 16;
        u32x4 w0, w1;
        w0.x = pk_bf16(acc[0], acc[1]); w0.y = pk_bf16(acc[2], acc[3]); w0.z = pk_bf16(acc[4], acc[5]); w0.w = pk_bf16(acc[6], acc[7]);
        w1.x = pk_bf16(acc[8], acc[9]); w1.y = pk_bf16(acc[10], acc[11]); w1.z = pk_bf16(acc[12], acc[13]); w1.w = pk_bf16(acc[14], acc[15]);
        *(u32x4*)o = w0; *(u32x4*)(o + 8) = w1;
        __syncthreads();
    }
}
__device__ __forceinline__ void phase_prep(const Args& a, LAS unsigned char* lds) {
    unsigned char* ws = a.ws;
    LAS float* tile = (LAS float*)lds;
    transpose_tiles(tile, a.in[1], 4 * DM, DM, 4 * DM, (bf16_t*)(ws + WS_WIN));
    transpose_tiles(tile, a.in[3], DM, DM, DM, (bf16_t*)(ws + WS_WOUT));
    transpose_tiles(tile, a.in[5], 2 * DM, DM, 2 * DM, (bf16_t*)(ws + WS_WKVQ));
    transpose_tiles(tile, a.in[6], DM, DM, DM, (bf16_t*)(ws + WS_WKVQ) + (size_t)2 * DM * DM);
    transpose_tiles(tile, a.in[7], DM, DM, DM, (bf16_t*)(ws + WS_WO));
    fold_peer_keys((LAS float*)lds, a.in[8], a.in[9], (bf16_t*)(ws + WS_WC));
    convert_bf16(a.in[0], (bf16_t*)(ws + slot(0)), (size_t)MTOK * DM);
    convert_bf16(a.in[10], (bf16_t*)(ws + WS_UB), (size_t)2 * 16384 * DM);
    convert_bf16(a.in[11], (bf16_t*)(ws + WS_VB), (size_t)2 * 16384 * DM);
    const int gtid = blockIdx.x * 512 + threadIdx.x, gthreads = gridDim.x * 512;
    float* COS = (float*)(ws + WS_COS); float* SIN = (float*)(ws + WS_SIN); float* LB = (float*)(ws + WS_LB);
    for (int i = gtid; i < SEQ * 64; i += gthreads) {
        const int pos = i >> 6, j = i & 63;
        double inv = 1.0; const double r = 0.86596432336006535;
        for (int q = 0; q < j; ++q) inv *= r;
        const float ang = (float)pos * (float)inv;
        const double x = (double)ang;
        const double n = __builtin_rint(x * 0.15915494309189535);
        const float rf = (float)__builtin_fma(-n, 6.283185307179586, x);
        COS[i] = cosf(rf); SIN[i] = sinf(rf);
    }
    for (int c = gtid; c < DM; c += gthreads) { const float l0 = a.in[4][c], l1 = a.in[4][DM + c]; LB[c] = 1.0f / (1.0f + expf(l1 - l0)); }
}

__device__ __forceinline__ void phase_scan_naive(const bf16_t* Q1, const float* LF, const bf16_t* I1, float* O) {
    const int lane = threadIdx.x & 63, gw = blockIdx.x * 8 + (threadIdx.x >> 6), nw = gridDim.x * 8;
    for (int item = gw; item < 2 * NHEAD * 128; item += nw) {
        const int bh = item >> 7, v = item & 127, b = bh >> 4, h = bh & 15;
        const size_t base = (size_t)b * SEQ * DM + h * 128;
        float S0 = 0.f, S1 = 0.f;
#pragma unroll 4
        for (int t = 0; t < SEQ; ++t) {
            const size_t ro = base + (size_t)t * DM;
            const float f0 = __expf(LF[ro + lane]), f1 = __expf(LF[ro + 64 + lane]);
            const float q0 = bf2f(Q1[ro + lane]), q1 = bf2f(Q1[ro + 64 + lane]);
            const float iv = bf2f(I1[ro + v]);
            S0 = f0 * S0 + (1.0f - f0) * iv; S1 = f1 * S1 + (1.0f - f1) * iv;
            const float p = wave_sum(q0 * S0 + q1 * S1);
            if (lane == 0) O[ro + v] = p;
        }
    }
}
__device__ __forceinline__ void phase_onorm(const float* O, const bf16_t* G1, const float* gnorm, bf16_t* OG) {
    const int lane = threadIdx.x & 63, gw = blockIdx.x * 8 + (threadIdx.x >> 6), nw = gridDim.x * 8;
    const float gn0 = gnorm[2 * lane], gn1 = gnorm[2 * lane + 1];
    for (int item = gw; item < MTOK * NHEAD; item += nw) {
        const size_t off = (size_t)item * 128 + 2 * lane;
        const float o0 = O[off], o1 = O[off + 1];
        const float ss = wave_sum(o0 * o0 + o1 * o1);
        const float r = rsqrtf(ss * (1.0f / 128.0f) + 1e-6f);
        const unsigned g = *(const unsigned*)(G1 + off);
        *(unsigned*)(OG + off) = pk_bf16(o0 * r * gn0 * bflo(g), o1 * r * gn1 * bfhi(g));
    }
}

__device__ __forceinline__ void ln_row_store(float (&v)[32], const float* g, const float* bta, float* outf, bf16_t* outb, int lane) {
    float s = 0.f;
#pragma unroll
    for (int i = 0; i < 32; ++i) s += v[i];
    const float mu = wave_sum(s) * (1.0f / DM);
    float q = 0.f;
#pragma unroll
    for (int i = 0; i < 32; ++i) { v[i] -= mu; q += v[i] * v[i]; }
    const float rstd = rsqrtf(wave_sum(q) * (1.0f / DM) + 1e-5f);
#pragma unroll
    for (int i = 0; i < 4; ++i) {
        const int c = 512 * i + 8 * lane;
        const f32x4 g0 = *(const f32x4*)(g + c), g1 = *(const f32x4*)(g + c + 4), b0 = *(const f32x4*)(bta + c), b1 = *(const f32x4*)(bta + c + 4);
        f32x4 o0, o1;
#pragma unroll
        for (int j = 0; j < 4; ++j) { o0[j] = v[i * 8 + j] * rstd * g0[j] + b0[j]; o1[j] = v[i * 8 + 4 + j] * rstd * g1[j] + b1[j]; }
        *(f32x4*)(outf + c) = o0; *(f32x4*)(outf + c + 4) = o1;
        if (outb) { u32x4 w; w.x = pk_bf16(o0[0], o0[1]); w.y = pk_bf16(o0[2], o0[3]); w.z = pk_bf16(o1[0], o1[1]); w.w = pk_bf16(o1[2], o1[3]); *(u32x4*)(outb + c) = w; }
    }
}
__device__ __forceinline__ void phase_ln(const float* Y, const float* g, const float* bta, float* outf, bf16_t* outb) {
    const int lane = threadIdx.x & 63, gw = blockIdx.x * 8 + (threadIdx.x >> 6), nw = gridDim.x * 8;
    for (int row = gw; row < MTOK; row += nw) {
        float v[32];
        const float* p = Y + (size_t)row * DM;
#pragma unroll
        for (int i = 0; i < 4; ++i) {
            const f32x4 a = *(const f32x4*)(p + 512 * i + 8 * lane), b = *(const f32x4*)(p + 512 * i + 8 * lane + 4);
#pragma unroll
            for (int j = 0; j < 4; ++j) { v[i * 8 + j] = a[j]; v[i * 8 + 4 + j] = b[j]; }
        }
        ln_row_store(v, g, bta, outf + (size_t)row * DM, outb ? outb + (size_t)row * DM : nullptr, lane);
    }
}

__device__ __forceinline__ void wave_argmax(float& v, int& idx) {
#pragma unroll
    for (int o = 32; o >= 1; o >>= 1) {
        const float ov = __shfl_xor(v, o); const int oi = __shfl_xor(idx, o);
        if (ov > v || (ov == v && oi < idx)) { v = ov; idx = oi; }
    }
}
__device__ __forceinline__ unsigned fkey(float x) { const unsigned u = __float_as_uint(x); return u ^ (unsigned)(((int)u >> 31) | 0x80000000); }
__device__ __forceinline__ void phase_topk(LAS unsigned char* lds, const float* SC, int* EID, float* GATE) {
    const int lane = threadIdx.x & 63, wv = threadIdx.x >> 6, gw = blockIdx.x * 8 + wv, nw = gridDim.x * 8;
    LAS float* sv = (LAS float*)(lds + wv * 512);
    LAS int* si = (LAS int*)(lds + wv * 512 + 256);
    for (int item = gw; item < MTOK * 8; item += nw) {
        const float* p = SC + (size_t)item * 256;
        float val[4]; val[0] = p[lane]; val[1] = p[64 + lane]; val[2] = p[128 + lane]; val[3] = p[192 + lane];
        unsigned key[4];
#pragma unroll
        for (int j = 0; j < 4; ++j) key[j] = fkey(val[j]);
#pragma unroll
        for (int half = 0; half < 2; ++half) {
            const unsigned k0 = key[2 * half], k1 = key[2 * half + 1];
            unsigned T = 0;
#pragma unroll
            for (int bit = 31; bit >= 0; --bit) {
                const unsigned cand = T | (1u << bit);
                const int cnt = __popcll(__ballot(k0 >= cand)) + __popcll(__ballot(k1 >= cand));
                if (cnt >= 16) T = cand;
            }
            const unsigned long long g0 = __ballot(k0 > T), g1 = __ballot(k1 > T), e0 = __ballot(k0 == T), e1 = __ballot(k1 == T);
            const int ngt = __popcll(g0) + __popcll(g1), need = 16 - ngt;
            const unsigned long long below = (1ull << lane) - 1ull;
            const int er0 = __popcll(e0 & below), er1 = __popcll(e0) + __popcll(e1 & below);
            const bool s0 = (k0 > T) || (k0 == T && er0 < need), s1 = (k1 > T) || (k1 == T && er1 < need);
            const unsigned long long b0 = __ballot(s0), b1 = __ballot(s1);
            const int r0 = __popcll(b0 & below), r1 = __popcll(b0) + __popcll(b1 & below);
            if (s0) { sv[half * 16 + r0] = val[2 * half]; si[half * 16 + r0] = lane; }
            if (s1) { sv[half * 16 + r1] = val[2 * half + 1]; si[half * 16 + r1] = lane + 64; }
        }
        asm volatile("s_waitcnt lgkmcnt(0)" ::: "memory");
        const float vb = sv[16 + (lane & 15)];
        float cv[4]; unsigned ck[4];
#pragma unroll
        for (int j = 0; j < 4; ++j) { cv[j] = sv[(lane >> 4) + 4 * j] + vb; ck[j] = fkey(cv[j]); }
        unsigned T = 0;
#pragma unroll
        for (int bit = 31; bit >= 0; --bit) {
            const unsigned cand = T | (1u << bit);
            const int cnt = __popcll(__ballot(ck[0] >= cand)) + __popcll(__ballot(ck[1] >= cand)) + __popcll(__ballot(ck[2] >= cand)) + __popcll(__ballot(ck[3] >= cand));
            if (cnt >= 16) T = cand;
        }
        const unsigned long long below = (1ull << lane) - 1ull;
        int ngt = 0;
#pragma unroll
        for (int j = 0; j < 4; ++j) ngt += __popcll(__ballot(ck[j] > T));
        const int need = 16 - ngt;
        int ebase = 0, rbase = 0;
        float bestv = -__builtin_inff(); int bestf = 0; bool have = false;
#pragma unroll
        for (int j = 0; j < 4; ++j) {
            const unsigned long long ej = __ballot(ck[j] == T);
            const int er = ebase + __popcll(ej & below);
            const bool sj = (ck[j] > T) || (ck[j] == T && er < need);
            const unsigned long long bj = __ballot(sj);
            const int rj = rbase + __popcll(bj & below);
            if (sj) { sv[32 + rj] = cv[j]; si[32 + rj] = lane + 64 * j; }
            ebase += __popcll(ej); rbase += __popcll(bj);
        }
        (void)bestv; (void)bestf; (void)have;
        asm volatile("s_waitcnt lgkmcnt(0)" ::: "memory");
        const float best = lane < 16 ? sv[32 + (lane & 15)] : -__builtin_inff();
        const int flat = si[32 + (lane & 15)];
        const float m = wave_max(best);
        const float e = lane < 16 ? __expf(best - m) : 0.f;
        const float sum = wave_sum(e);
        const int ea = si[flat >> 4], eb = si[16 + (flat & 15)];
        if (lane < 16) { EID[(size_t)item * 16 + lane] = ea * 128 + eb; GATE[(size_t)item * 16 + lane] = e / sum; }
        asm volatile("s_waitcnt lgkmcnt(0)" ::: "memory");
    }
}

__device__ __forceinline__ float gelu_erf(float x) { return 0.5f * x * (1.0f + erff(x * 0.70710678118654752f)); }
__device__ __forceinline__ void phase_peer(const float* X, const int* EID, const float* GATE, const bf16_t* U, const bf16_t* V, const float* g, const float* bta, float* outf, bf16_t* outb) {
    const int lane = threadIdx.x & 63, gw = blockIdx.x * 8 + (threadIdx.x >> 6), nw = gridDim.x * 8;
    for (int tok = gw; tok < MTOK; tok += nw) {
        float x[32];
        const float* xp = X + (size_t)tok * DM;
#pragma unroll
        for (int i = 0; i < 4; ++i) {
            const f32x4 a = *(const f32x4*)(xp + 512 * i + 8 * lane), b = *(const f32x4*)(xp + 512 * i + 8 * lane + 4);
#pragma unroll
            for (int j = 0; j < 4; ++j) { x[i * 8 + j] = a[j]; x[i * 8 + 4 + j] = b[j]; }
        }
        const int e0 = EID[(size_t)tok * 128 + lane], e1 = EID[(size_t)tok * 128 + 64 + lane];
        const float g0 = GATE[(size_t)tok * 128 + lane], g1 = GATE[(size_t)tok * 128 + 64 + lane];
        float h0 = 0.f, h1 = 0.f;
#pragma unroll 4
        for (int e = 0; e < 128; ++e) {
            const int idx = __builtin_amdgcn_readfirstlane(__shfl(e < 64 ? e0 : e1, e & 63));
            const u32x4* up = (const u32x4*)(U + (size_t)idx * DM) + lane;
            float d = 0.f;
#pragma unroll
            for (int i = 0; i < 4; ++i) {
                const u32x4 w = up[i * 64];
                d += x[i * 8 + 0] * bflo(w.x) + x[i * 8 + 1] * bfhi(w.x) + x[i * 8 + 2] * bflo(w.y) + x[i * 8 + 3] * bfhi(w.y)
                   + x[i * 8 + 4] * bflo(w.z) + x[i * 8 + 5] * bfhi(w.z) + x[i * 8 + 6] * bflo(w.w) + x[i * 8 + 7] * bfhi(w.w);
            }
            d = wave_sum(d);
            if (e < 64) { if (lane == e) h0 = d; } else { if (lane == e - 64) h1 = d; }
        }
        const float w0 = g0 * gelu_erf(h0), w1 = g1 * gelu_erf(h1);
        float y[32];
#pragma unroll
        for (int i = 0; i < 32; ++i) y[i] = 0.f;
#pragma unroll 4
        for (int e = 0; e < 128; ++e) {
            const int idx = __builtin_amdgcn_readfirstlane(__shfl(e < 64 ? e0 : e1, e & 63));
            const float wt = __shfl(e < 64 ? w0 : w1, e & 63);
            const u32x4* vp = (const u32x4*)(V + (size_t)idx * DM) + lane;
#pragma unroll
            for (int i = 0; i < 4; ++i) {
                const u32x4 w = vp[i * 64];
                y[i * 8 + 0] += wt * bflo(w.x); y[i * 8 + 1] += wt * bfhi(w.x); y[i * 8 + 2] += wt * bflo(w.y); y[i * 8 + 3] += wt * bfhi(w.y);
                y[i * 8 + 4] += wt * bflo(w.z); y[i * 8 + 5] += wt * bfhi(w.z); y[i * 8 + 6] += wt * bflo(w.w); y[i * 8 + 7] += wt * bfhi(w.w);
            }
        }
#pragma unroll
        for (int i = 0; i < 32; ++i) y[i] += ALPHA * x[i];
        ln_row_store(y, g, bta, outf + (size_t)tok * DM, outb ? outb + (size_t)tok * DM : nullptr, lane);
    }
}

__device__ __forceinline__ void phase_rot(LAS float* red, bf16_t* KR, bf16_t* QR, const float* COS, const float* SIN, float* KMEAN, float* KNMAX) {
    const int tid = threadIdx.x, d = tid & 63, rg = tid >> 6;
    for (int item = blockIdx.x; item < 2 * NHEAD * 32; item += gridDim.x) {
        const int bh = item >> 5, j = item & 31, b = bh >> 4, h = bh & 15;
        float s1 = 0.f, s2 = 0.f, nmax = 0.f;
        for (int i = 0; i < 32; ++i) {
            const int pos = j * 256 + rg * 32 + i;
            const size_t off = ((size_t)b * SEQ + pos) * DM + h * 128 + d;
            const float c = COS[pos * 64 + d], s = SIN[pos * 64 + d];
            const float k1 = bf2f(KR[off]), k2 = bf2f(KR[off + 64]);
            const float o1 = k1 * c - k2 * s, o2 = k1 * s + k2 * c;
            s1 += o1; s2 += o2;
            nmax = fmaxf(nmax, wave_sum(o1 * o1 + o2 * o2));
            KR[off] = (bf16_t)(pk_bf16(o1, 0.f) & 0xffffu); KR[off + 64] = (bf16_t)(pk_bf16(o2, 0.f) & 0xffffu);
            const float q1 = bf2f(QR[off]), q2 = bf2f(QR[off + 64]);
            QR[off] = (bf16_t)(pk_bf16(q1 * c - q2 * s, 0.f) & 0xffffu); QR[off + 64] = (bf16_t)(pk_bf16(q1 * s + q2 * c, 0.f) & 0xffffu);
        }
        red[rg * 128 + d] = s1; red[rg * 128 + 64 + d] = s2;
        if (d == 0) red[1024 + rg] = nmax;
        __syncthreads();
        if (tid < 128) {
            float s = 0.f;
#pragma unroll
            for (int r = 0; r < 8; ++r) s += red[r * 128 + tid];
            KMEAN[(size_t)item * 128 + tid] = s * (1.0f / 256.0f);
        }
        if (tid == 0) {
            float m = 0.f;
#pragma unroll
            for (int r = 0; r < 8; ++r) m = fmaxf(m, red[1024 + r]);
            KNMAX[item] = sqrtf(m);
        }
        __syncthreads();
    }
}

__device__ __forceinline__ void phase_sel(LAS unsigned char* lds, const bf16_t* QR, const float* KMEAN, unsigned short* SUB, int* CNT, int* ctr) {
    const int tid = threadIdx.x, lane = tid & 63, wv = tid >> 6;
    LAS float* km = (LAS float*)lds;
    LAS float* qs = (LAS float*)(lds + 16896) + wv * 128;
    LAS unsigned short* bucket = (LAS unsigned short*)(lds + 20992);
    LAS int* cnt = (LAS int*)(lds + 37376);
    const float NEG = -1e30f;
    if (blockIdx.x == 0 && tid == 0) *ctr = 0;
    for (int item = blockIdx.x; item < 2 * NHEAD * 32; item += gridDim.x) {
        const int bh = item >> 5, i = item & 31, b = bh >> 4, h = bh & 15;
        if (i == 0) continue;
        if (tid < 32) cnt[tid] = 0;
#pragma unroll
        for (int r = 0; r < 2; ++r) { const int idx = tid + 512 * r, n = idx >> 5, d4 = (idx & 31) * 4; *(LAS f32x4*)(km + n * 132 + d4) = *(const f32x4*)(KMEAN + ((size_t)bh * 32 + n) * 128 + d4); }
        __syncthreads();
        for (int qq = 0; qq < 32; ++qq) {
            const int tl = wv * 32 + qq;
            const size_t tok = (size_t)b * SEQ + i * 256 + tl;
            { const unsigned q2 = *(const unsigned*)(QR + tok * DM + h * 128 + 2 * lane); qs[2 * lane] = bflo(q2); qs[2 * lane + 1] = bfhi(q2); }
            asm volatile("s_waitcnt lgkmcnt(0)" ::: "memory");
            float gsc = NEG;
            if (lane < i) {
                float sacc = 0.f;
#pragma unroll 8
                for (int d4 = 0; d4 < 32; ++d4) { const f32x4 kv = *(const LAS f32x4*)(km + lane * 132 + d4 * 4); const f32x4 qv = *(const LAS f32x4*)(qs + d4 * 4); sacc += kv[0] * qv[0] + kv[1] * qv[1] + kv[2] * qv[2] + kv[3] * qv[3]; }
                gsc = sacc;
            }
#pragma unroll
            for (int r = 0; r < 3; ++r) {
                float v = gsc; int id = lane;
                wave_argmax(v, id);
                if (v > 0.5f * NEG && lane == 0) { const int p = __hip_atomic_fetch_add(cnt + id, 1, __ATOMIC_RELAXED, __HIP_MEMORY_SCOPE_WORKGROUP); bucket[id * 256 + p] = (unsigned short)(tl | (r << 8)); }
                if (lane == id) gsc = -3e38f;
            }
            asm volatile("s_waitcnt lgkmcnt(0)" ::: "memory");
        }
        __syncthreads();
        for (int idx = tid; idx < 32 * 256; idx += 512) {
            const int j = idx >> 8, p = idx & 255;
            if (j < i && p < cnt[j]) SUB[(((size_t)bh * 32 + j) * 32 + i) * 256 + p] = bucket[idx];
        }
        if (tid < i) CNT[((size_t)bh * 32 + tid) * 32 + i] = cnt[tid];
        __syncthreads();
    }
}

typedef short bf16x8 __attribute__((ext_vector_type(8)));
typedef short s16x4 __attribute__((ext_vector_type(4)));
typedef float f32x16 __attribute__((ext_vector_type(16)));
__device__ __forceinline__ unsigned off_b(unsigned row, unsigned ch) { return 256u * row + 16u * (ch ^ (((row & 3u) << 2) | ((row >> 2) & 3u))); }
__device__ __forceinline__ unsigned pi32(unsigned m) { return (m & ~12u) | ((m & 4u) << 1) | ((m & 8u) >> 1); }
__device__ __forceinline__ bf16x8 tr_frag(LAS unsigned char* img, unsigned lane, unsigned c, unsigned ks) {
    const unsigned hh = lane >> 5, blk = (lane >> 4) & 1, q = (lane & 15) >> 2, p = lane & 3;
    const unsigned a0 = off_b(16 * ks + 8 * hh + q, 4 * c + 2 * blk + (p >> 1)) + 8 * (p & 1);
    const unsigned a1 = off_b(16 * ks + 8 * hh + 4 + q, 4 * c + 2 * blk + (p >> 1)) + 8 * (p & 1);
    const s16x4 lo = __builtin_amdgcn_ds_read_tr16_b64_v4i16((LAS s16x4*)(img + a0));
    const s16x4 hi = __builtin_amdgcn_ds_read_tr16_b64_v4i16((LAS s16x4*)(img + a1));
    bf16x8 r; r[0] = lo[0]; r[1] = lo[1]; r[2] = lo[2]; r[3] = lo[3]; r[4] = hi[0]; r[5] = hi[1]; r[6] = hi[2]; r[7] = hi[3];
    return r;
}
__device__ __forceinline__ void phase_att(LAS unsigned char* lds, const bf16_t* QR, const bf16_t* KR, const bf16_t* V, const float* KNMAX, const unsigned short* SUB, const int* CNT, int* ctr,
                                          bf16_t* P012, bf16_t* P3, float* LS) {
    const int tid = threadIdx.x, lane = tid & 63, wv = tid >> 6, r32 = lane & 31, hh = lane >> 5;
    LAS unsigned char* Kimg = lds;
    LAS unsigned char* Vimg = lds + 65536;
    LAS int* misc = (LAS int*)(lds + 131072);
    const float SCL2 = 0.08838834764831845f * 1.4426950408889634f;
    for (;;) {
        __syncthreads();
        if (tid == 0) misc[40] = __hip_atomic_fetch_add(ctr, 1, __ATOMIC_RELAXED, __HIP_MEMORY_SCOPE_AGENT);
        __syncthreads();
        const int item = misc[40];
        if (item >= 2 * NHEAD * 32) break;
        const int j = item >> 5, bh = item & 31, b = bh >> 4, h = bh & 15;
#pragma unroll
        for (int r = 0; r < 8; ++r) {
            const int idx = tid + 512 * r, row = idx >> 4, ch = idx & 15;
            const size_t g = ((size_t)b * SEQ + j * 256 + row) * DM + h * 128 + ch * 8;
            const u32x4 kv = *(const u32x4*)(KR + g), vv = *(const u32x4*)(V + g);
            *(LAS u32x4*)(Kimg + off_b(row, ch)) = kv; *(LAS u32x4*)(Vimg + off_b(row, ch)) = vv;
        }
        if (tid <= 32) { int pre = 0; for (int u = j + 1; u < tid; ++u) pre += CNT[((size_t)bh * 32 + j) * 32 + u]; misc[tid] = pre; }
        float kn = (lane < 32) ? KNMAX[bh * 32 + lane] : 0.f;
        kn = wave_max(kn);
        __syncthreads();
        const int total = misc[32], ntile = (256 + total + 31) >> 5;
        for (int tile = wv; tile < ntile; tile += 8) {
            const int gr = tile * 32 + r32;
            int pos, slot; bool valid = true;
            if (gr < 256) { pos = j * 256 + gr; slot = 3; }
            else {
                const int x = gr - 256; valid = x < total;
                int ii = j + 1;
                for (int u = j + 1; u < 32; ++u) if (misc[u] <= x) ii = u;
                if (valid) { const unsigned e = SUB[(((size_t)bh * 32 + j) * 32 + ii) * 256 + (x - misc[ii])]; pos = ii * 256 + (int)(e & 255u); slot = (int)(e >> 8); }
                else { pos = j * 256; slot = 3; }
            }
            const size_t tok = (size_t)b * SEQ + pos;
            bf16x8 qf[8];
            const bf16_t* qp = QR + tok * DM + h * 128 + 8 * hh;
#pragma unroll
            for (int s = 0; s < 8; ++s) qf[s] = *(const bf16x8*)(qp + 16 * s);
            float qn2 = 0.f;
#pragma unroll
            for (int s = 0; s < 8; ++s)
#pragma unroll
                for (int e = 0; e < 8; ++e) { const float f = bf2f((bf16_t)qf[s][e]); qn2 += f * f; }
            qn2 += __shfl_xor(qn2, 32);
            const float c2 = sqrtf(qn2) * kn * SCL2;
            f32x16 O[4];
#pragma unroll
            for (int dt = 0; dt < 4; ++dt)
#pragma unroll
                for (int e = 0; e < 16; ++e) O[dt][e] = 0.f;
            float l = 0.f;
            const bool own = tile < 8;
            const int kcn = own ? tile + 1 : 8;
            const unsigned krow = pi32((unsigned)r32);
            for (int kc = 0; kc < kcn; ++kc) {
                f32x16 S;
#pragma unroll
                for (int e = 0; e < 16; ++e) S[e] = 0.f;
#pragma unroll
                for (int s = 0; s < 8; ++s) {
                    const bf16x8 kf = *(const LAS bf16x8*)(Kimg + off_b(32 * kc + krow, 2 * s + hh));
                    S = __builtin_amdgcn_mfma_f32_32x32x16_bf16(kf, qf[s], S, 0, 0, 0);
                }
                float p[16];
#pragma unroll
                for (int e = 0; e < 16; ++e) {
                    const unsigned m = (e & 3) + 8 * (e >> 2) + 4 * hh;
                    const int key = j * 256 + 32 * kc + (int)pi32(m);
                    float pe = __builtin_amdgcn_exp2f(S[e] * SCL2 - c2);
                    if (own && key > pos) pe = 0.f;
                    p[e] = pe; l += pe;
                }
                u32x4 w0, w1;
                w0.x = pk_bf16(p[0], p[1]); w0.y = pk_bf16(p[2], p[3]); w0.z = pk_bf16(p[4], p[5]); w0.w = pk_bf16(p[6], p[7]);
                w1.x = pk_bf16(p[8], p[9]); w1.y = pk_bf16(p[10], p[11]); w1.z = pk_bf16(p[12], p[13]); w1.w = pk_bf16(p[14], p[15]);
                const bf16x8 pf0 = __builtin_bit_cast(bf16x8, w0), pf1 = __builtin_bit_cast(bf16x8, w1);
#pragma unroll
                for (int dt = 0; dt < 4; ++dt) {
                    const bf16x8 v0 = tr_frag(Vimg, lane, dt, 2 * kc), v1 = tr_frag(Vimg, lane, dt, 2 * kc + 1);
                    O[dt] = __builtin_amdgcn_mfma_f32_32x32x16_bf16(v0, pf0, O[dt], 0, 0, 0);
                    O[dt] = __builtin_amdgcn_mfma_f32_32x32x16_bf16(v1, pf1, O[dt], 0, 0, 0);
                }
            }
            l += __shfl_xor(l, 32);
            if (valid) {
                bf16_t* pl = (slot < 3 ? P012 + (size_t)slot * ((size_t)32 << 20) : P3) + (tok * NHEAD + h) * 128 + 4 * hh;
#pragma unroll
                for (int dt = 0; dt < 4; ++dt)
#pragma unroll
                    for (int g = 0; g < 4; ++g) {
                        u32x2 w; w.x = pk_bf16(O[dt][4 * g], O[dt][4 * g + 1]); w.y = pk_bf16(O[dt][4 * g + 2], O[dt][4 * g + 3]);
                        *(u32x2*)(pl + 32 * dt + 8 * g) = w;
                    }
                if (hh == 0) LS[(size_t)slot * MTOK * NHEAD + tok * NHEAD + h] = l;
            }
        }
    }
}
__device__ __forceinline__ void phase_comb(const bf16_t* P012, const bf16_t* P3, const float* LS, bf16_t* AO) {
    const size_t n = (size_t)MTOK * NHEAD * 16, stride = (size_t)gridDim.x * 512;
    for (size_t idx = (size_t)blockIdx.x * 512 + threadIdx.x; idx < n; idx += stride) {
        const size_t th = idx >> 4; const int ch = (int)(idx & 15);
        const int t = (int)((th >> 4) & (SEQ - 1)), blk = t >> 8, nsel = blk < 3 ? blk : 3;
        float acc[8];
        float l = LS[(size_t)3 * MTOK * NHEAD + th];
        { const u32x4 w = *(const u32x4*)(P3 + th * 128 + ch * 8);
          acc[0] = bflo(w.x); acc[1] = bfhi(w.x); acc[2] = bflo(w.y); acc[3] = bfhi(w.y); acc[4] = bflo(w.z); acc[5] = bfhi(w.z); acc[6] = bflo(w.w); acc[7] = bfhi(w.w); }
        for (int s = 0; s < nsel; ++s) {
            const u32x4 w = *(const u32x4*)(P012 + (size_t)s * ((size_t)32 << 20) + th * 128 + ch * 8);
            acc[0] += bflo(w.x); acc[1] += bfhi(w.x); acc[2] += bflo(w.y); acc[3] += bfhi(w.y); acc[4] += bflo(w.z); acc[5] += bfhi(w.z); acc[6] += bflo(w.w); acc[7] += bfhi(w.w);
            l += LS[(size_t)s * MTOK * NHEAD + th];
        }
        const float rl = 1.0f / l;
        u32x4 o; o.x = pk_bf16(acc[0] * rl, acc[1] * rl); o.y = pk_bf16(acc[2] * rl, acc[3] * rl); o.z = pk_bf16(acc[4] * rl, acc[5] * rl); o.w = pk_bf16(acc[6] * rl, acc[7] * rl);
        *(u32x4*)(AO + th * 128 + ch * 8) = o;
    }
}

__device__ __forceinline__ void phase_scan_a(LAS unsigned char* lds, const float* LF, const bf16_t* I1, bf16_t* LT, float* DEC, unsigned* dbgc = nullptr) {
    unsigned dbg_kt = 0, dbg_acc = 0;
    const int tid = threadIdx.x, lane = tid & 63, wv = tid >> 6, k = tid & 127, part = tid >> 7;
    LAS unsigned char* Iimg = lds; LAS unsigned char* KTimg = lds + 16384;
    LAS float* psum = (LAS float*)(lds + 32768);
    LAS unsigned char* Lst = lds + 36864;
#if SCAN_A_VALU == 2
    for (int item = blockIdx.x; item < 2 * NHEAD * 128; item += gridDim.x) {
        const int bh = item >> 7, c = item & 127, b = bh >> 4, h = bh & 15;
        const size_t tok0 = (size_t)b * SEQ + c * 64;
        for (int idx = tid; idx < 16384; idx += 512) {
            const int v = idx >> 7, kk = idx & 127;
            float g = 1.f, L = 0.f;
            for (int s2 = 63; s2 >= 0; --s2) { const size_t o = (tok0 + s2) * DM + h * 128; const float f = __expf(LF[o + kk]); L += bf2f(I1[o + v]) * (1.0f - f) * g; g *= f; }
            LT[(size_t)item * 16384 + idx] = (bf16_t)(pk_bf16(L, 0.f) & 0xffffu);
        }
    }
    return;
#endif
    for (int item = blockIdx.x; item < 2 * NHEAD * 128; item += gridDim.x) {
        const int bh = item >> 7, c = item & 127, b = bh >> 4, h = bh & 15;
        const size_t tok0 = (size_t)b * SEQ + c * 64;
        float lf[16];
#pragma unroll
        for (int i = 0; i < 16; ++i) lf[i] = LF[(tok0 + 16 * part + i) * DM + h * 128 + k];
#pragma unroll
        for (int r = 0; r < 2; ++r) { const int idx = tid + 512 * r, row = idx >> 4, ch = idx & 15; *(LAS u32x4*)(Iimg + off_b(row, ch)) = *(const u32x4*)(I1 + (tok0 + row) * DM + h * 128 + ch * 8); }
        float cs = 0.f;
#pragma unroll
        for (int i = 0; i < 16; ++i) cs += lf[i];
        psum[part * 128 + k] = cs;
        __syncthreads();
        const float p0 = psum[k], p1 = psum[128 + k], p2 = psum[256 + k], p3 = psum[384 + k];
        const float blast = (p0 + p1) + (p2 + p3);
        float bb = part == 0 ? 0.f : (part == 1 ? p0 : (part == 2 ? p0 + p1 : p0 + p1 + p2));
#pragma unroll
        for (int i = 0; i < 16; ++i) {
            bb += lf[i];
            const float kt = (1.0f - __expf(lf[i])) * __expf(blast - bb);
            if (!(kt - kt == 0.f)) ++dbg_kt;
            const int srow = 16 * part + i;
            *(LAS bf16_t*)(KTimg + off_b(srow, k >> 3) + 2 * (k & 7)) = (bf16_t)(pk_bf16(kt, 0.f) & 0xffffu);
        }
        if (part == 0) DEC[(size_t)item * 128 + k] = __expf(blast);
        __syncthreads();
#if SCAN_A_VALU
        for (int idx = tid; idx < 16384; idx += 512) {
            const int v = idx >> 7, kk = idx & 127;
            float accv = 0.f;
            for (int s2 = 0; s2 < 64; ++s2) accv += bf2f(*(const LAS bf16_t*)(Iimg + off_b(s2, v >> 3) + 2 * (v & 7))) * bf2f(*(const LAS bf16_t*)(KTimg + off_b(s2, kk >> 3) + 2 * (kk & 7)));
            *(LAS bf16_t*)(Lst + v * 272 + 2 * kk) = (bf16_t)(pk_bf16(accv, 0.f) & 0xffffu);
        }
        if (0)
#endif
        {
            const int vt = wv >> 1;
            f32x16 acc0, acc1;
#pragma unroll
            for (int e = 0; e < 16; ++e) { acc0[e] = 0.f; acc1[e] = 0.f; }
#pragma unroll
            for (int ks = 0; ks < 4; ++ks) {
                const bf16x8 af = tr_frag(Iimg, lane, vt, ks);
                const bf16x8 b0 = tr_frag(KTimg, lane, 2 * (wv & 1), ks), b1 = tr_frag(KTimg, lane, 2 * (wv & 1) + 1, ks);
                acc0 = __builtin_amdgcn_mfma_f32_32x32x16_bf16(af, b0, acc0, 0, 0, 0);
                acc1 = __builtin_amdgcn_mfma_f32_32x32x16_bf16(af, b1, acc1, 0, 0, 0);
            }
            const int r32 = lane & 31, hh = lane >> 5;
#pragma unroll
            for (int e = 0; e < 16; ++e) {
                if (!(acc0[e] - acc0[e] == 0.f)) ++dbg_acc; if (!(acc1[e] - acc1[e] == 0.f)) ++dbg_acc;
                const int v = 32 * vt + (e & 3) + 8 * (e >> 2) + 4 * hh;
                *(LAS bf16_t*)(Lst + v * 272 + 2 * (64 * (wv & 1) + r32)) = (bf16_t)(pk_bf16(acc0[e], 0.f) & 0xffffu);
                *(LAS bf16_t*)(Lst + v * 272 + 2 * (64 * (wv & 1) + 32 + r32)) = (bf16_t)(pk_bf16(acc1[e], 0.f) & 0xffffu);
            }
        }
        __syncthreads();
#pragma unroll
        for (int r = 0; r < 4; ++r) { const int idx = tid + 512 * r, row = idx >> 4, ch = idx & 15; store_wt16(LT + (size_t)item * 16384 + row * 128 + ch * 8, *(const LAS u32x4*)(Lst + row * 272 + ch * 16)); }
        __syncthreads();
    }
    if (dbgc) { if (dbg_kt) atomicAdd(dbgc + 0, dbg_kt); if (dbg_acc) atomicAdd(dbgc + 1, dbg_acc); }
}
__device__ __forceinline__ void phase_scan_b(bf16_t* LT, const float* DEC) {
    const int n = 2 * NHEAD * 128 * 32;
    for (int idx = blockIdx.x * 512 + threadIdx.x; idx < n; idx += gridDim.x * 512) {
        const int bh = idx >> 12, vk = idx & 4095, k4 = (vk & 31) * 4;
        float S0 = 0.f, S1 = 0.f, S2 = 0.f, S3 = 0.f;
        bf16_t* p = LT + (size_t)bh * 128 * 16384 + (size_t)vk * 4;
        const float* dp = DEC + (size_t)bh * 128 * 128 + k4;
#pragma unroll 8
        for (int c = 0; c < 128; ++c) {
            const u32x2 w = *(const u32x2*)(p + (size_t)c * 16384);
            const f32x4 d = *(const f32x4*)(dp + c * 128);
            u32x2 o; o.x = pk_bf16(S0, S1); o.y = pk_bf16(S2, S3);
            store_wt8(p + (size_t)c * 16384, o);
            S0 = d[0] * S0 + bflo(w.x); S1 = d[1] * S1 + bfhi(w.x); S2 = d[2] * S2 + bflo(w.y); S3 = d[3] * S3 + bfhi(w.y);
        }
    }
}
__device__ __forceinline__ void phase_scan_c(LAS unsigned char* lds, const bf16_t* Q1, const float* LF, const bf16_t* I1, const bf16_t* G1, const bf16_t* SP, const float* gnorm, bf16_t* OG) {
    const int tid = threadIdx.x, lane = tid & 63, wv = tid >> 6, k = tid & 127, part = tid >> 7, r32 = lane & 31, hh = lane >> 5;
    LAS unsigned char* QTimg = lds; LAS unsigned char* QPimg = lds + 16384; LAS unsigned char* KPimg = lds + 32768; LAS unsigned char* Iimg = lds + 49152; LAS unsigned char* SPimg = lds + 65536;
    LAS float* psum = (LAS float*)(lds + 98304);
    LAS float* ssq = (LAS float*)(lds + 100352);
    LAS unsigned char* OT = lds + 102400;
    for (int item = blockIdx.x; item < 2 * NHEAD * 128; item += gridDim.x) {
        const int bh = item >> 7, c = item & 127, b = bh >> 4, h = bh & 15;
        const size_t tok0 = (size_t)b * SEQ + c * 64;
        float lf[16], qv[16];
#pragma unroll
        for (int i = 0; i < 16; ++i) { const size_t o = (tok0 + 16 * part + i) * DM + h * 128 + k; lf[i] = LF[o]; qv[i] = bf2f(Q1[o]); }
#pragma unroll
        for (int r = 0; r < 2; ++r) { const int idx = tid + 512 * r, row = idx >> 4, ch = idx & 15; *(LAS u32x4*)(Iimg + off_b(row, ch)) = *(const u32x4*)(I1 + (tok0 + row) * DM + h * 128 + ch * 8); }
#pragma unroll
        for (int r = 0; r < 4; ++r) { const int idx = tid + 512 * r, row = idx >> 4, ch = idx & 15; *(LAS u32x4*)(SPimg + off_b(row, ch)) = *(const u32x4*)(SP + (size_t)item * 16384 + row * 128 + ch * 8); }
        float cs = 0.f;
#pragma unroll
        for (int i = 0; i < 16; ++i) cs += lf[i];
        psum[part * 128 + k] = cs;
        __syncthreads();
        const float p0 = psum[k], p1 = psum[128 + k], p2 = psum[256 + k];
        const float rr = p0 + p1;
        float bb = part == 0 ? 0.f : (part == 1 ? p0 : (part == 2 ? p0 + p1 : p0 + p1 + p2));
#pragma unroll
        for (int i = 0; i < 16; ++i) {
            bb += lf[i];
            const float qt = qv[i] * __expf(bb), qp = qv[i] * __expf(bb - rr), kp = (1.0f - __expf(lf[i])) * __expf(rr - bb);
            const unsigned o = off_b(16 * part + i, k >> 3) + 2 * (k & 7);
            *(LAS bf16_t*)(QTimg + o) = (bf16_t)(pk_bf16(qt, 0.f) & 0xffffu);
            *(LAS bf16_t*)(QPimg + o) = (bf16_t)(pk_bf16(qp, 0.f) & 0xffffu);
            *(LAS bf16_t*)(KPimg + o) = (bf16_t)(pk_bf16(kp, 0.f) & 0xffffu);
        }
        __syncthreads();
        const int tt = wv & 1, vt = wv >> 1;
        f32x16 O;
#pragma unroll
        for (int e = 0; e < 16; ++e) O[e] = 0.f;
#pragma unroll
        for (int ks = 0; ks < 8; ++ks) {
            const bf16x8 af = *(const LAS bf16x8*)(SPimg + off_b(32 * vt + r32, 2 * ks + hh));
            const bf16x8 bf = *(const LAS bf16x8*)(QTimg + off_b(32 * tt + r32, 2 * ks + hh));
            O = __builtin_amdgcn_mfma_f32_32x32x16_bf16(af, bf, O, 0, 0, 0);
        }
        const unsigned krow = pi32((unsigned)r32);
        for (int st = 0; st <= tt; ++st) {
            f32x16 S;
#pragma unroll
            for (int e = 0; e < 16; ++e) S[e] = 0.f;
#pragma unroll
            for (int ks = 0; ks < 8; ++ks) {
                const bf16x8 af = *(const LAS bf16x8*)(KPimg + off_b(32 * st + krow, 2 * ks + hh));
                const bf16x8 bf = *(const LAS bf16x8*)(QPimg + off_b(32 * tt + r32, 2 * ks + hh));
                S = __builtin_amdgcn_mfma_f32_32x32x16_bf16(af, bf, S, 0, 0, 0);
            }
            float p[16];
#pragma unroll
            for (int e = 0; e < 16; ++e) {
                const unsigned m = (e & 3) + 8 * (e >> 2) + 4 * hh;
                const int sidx = 32 * st + (int)pi32(m), tidx = 32 * tt + r32;
                p[e] = sidx <= tidx ? S[e] : 0.f;
            }
            u32x4 w0, w1;
            w0.x = pk_bf16(p[0], p[1]); w0.y = pk_bf16(p[2], p[3]); w0.z = pk_bf16(p[4], p[5]); w0.w = pk_bf16(p[6], p[7]);
            w1.x = pk_bf16(p[8], p[9]); w1.y = pk_bf16(p[10], p[11]); w1.z = pk_bf16(p[12], p[13]); w1.w = pk_bf16(p[14], p[15]);
            const bf16x8 pf0 = __builtin_bit_cast(bf16x8, w0), pf1 = __builtin_bit_cast(bf16x8, w1);
            const bf16x8 i0 = tr_frag(Iimg, lane, vt, 2 * st), i1 = tr_frag(Iimg, lane, vt, 2 * st + 1);
            O = __builtin_amdgcn_mfma_f32_32x32x16_bf16(i0, pf0, O, 0, 0, 0);
            O = __builtin_amdgcn_mfma_f32_32x32x16_bf16(i1, pf1, O, 0, 0, 0);
        }
        float sq = 0.f;
#pragma unroll
        for (int e = 0; e < 16; ++e) sq += O[e] * O[e];
        sq += __shfl_xor(sq, 32);
        if (hh == 0) ssq[vt * 64 + 32 * tt + r32] = sq;
        __syncthreads();
        const int tl = 32 * tt + r32;
        const float rstd = rsqrtf((ssq[tl] + ssq[64 + tl] + ssq[128 + tl] + ssq[192 + tl]) * (1.0f / 128.0f) + 1e-6f);
#pragma unroll
        for (int g = 0; g < 4; ++g) {
            const int v0 = 32 * vt + 8 * g + 4 * hh;
            const f32x4 gn = *(const f32x4*)(gnorm + v0);
            u32x2 w; w.x = pk_bf16(O[4 * g] * rstd * gn[0], O[4 * g + 1] * rstd * gn[1]); w.y = pk_bf16(O[4 * g + 2] * rstd * gn[2], O[4 * g + 3] * rstd * gn[3]);
            *(LAS u32x2*)(OT + tl * 272 + v0 * 2) = w;
        }
        __syncthreads();
#pragma unroll
        for (int r = 0; r < 2; ++r) {
            const int idx = tid + 512 * r, row = idx >> 4, ch = idx & 15;
            const u32x4 ov = *(const LAS u32x4*)(OT + row * 272 + ch * 16);
            const size_t go = (tok0 + row) * DM + h * 128 + ch * 8;
            const u32x4 gv = *(const u32x4*)(G1 + go);
            u32x4 w;
            w.x = pk_bf16(bflo(ov.x) * bflo(gv.x), bfhi(ov.x) * bfhi(gv.x)); w.y = pk_bf16(bflo(ov.y) * bflo(gv.y), bfhi(ov.y) * bfhi(gv.y));
            w.z = pk_bf16(bflo(ov.z) * bflo(gv.z), bfhi(ov.z) * bfhi(gv.z)); w.w = pk_bf16(bflo(ov.w) * bflo(gv.w), bfhi(ov.w) * bfhi(gv.w));
            *(u32x4*)(OG + go) = w;
        }
        __syncthreads();
    }
}


#if SCAN_DBG == 2
__device__ __forceinline__ void dbg_compare(LAS float* red, const bf16_t* A, const bf16_t* B, float* DBG) {
    float sd = 0.f, sr = 0.f, nn = 0.f;
    const size_t n = (size_t)MTOK * DM;
    for (size_t i = (size_t)blockIdx.x * 512 + threadIdx.x; i < n; i += (size_t)gridDim.x * 512) {
        const float x = bf2f(A[i]), y = bf2f(B[i]);
        if (!(x - x == 0.f)) nn += 1.f; else { sd += (x - y) * (x - y); sr += y * y; }
    }
    sd = wave_sum(sd); sr = wave_sum(sr); nn = wave_sum(nn);
    const int wv = threadIdx.x >> 6;
    if ((threadIdx.x & 63) == 0) { red[wv * 3] = sd; red[wv * 3 + 1] = sr; red[wv * 3 + 2] = nn; }
    __syncthreads();
    if (threadIdx.x == 0) { float a = 0, b = 0, c = 0; for (int w = 0; w < 8; ++w) { a += red[w * 3]; b += red[w * 3 + 1]; c += red[w * 3 + 2]; } DBG[blockIdx.x * 4] = a; DBG[blockIdx.x * 4 + 1] = b; DBG[blockIdx.x * 4 + 2] = c; }
    __syncthreads();
}
__device__ __forceinline__ void dbg_emit(const float* DBG, float* out) {
    float a = 0, b = 0, c = 0;
    for (int w = 0; w < (int)gridDim.x; ++w) { a += DBG[w * 4]; b += DBG[w * 4 + 1]; c += DBG[w * 4 + 2]; }
    const float rel = sqrtf(a / b);
    int k = (int)rintf(-2.0f * log10f(rel)); k = k < 0 ? 0 : (k > 16 ? 16 : k);
    if (c > 0.f) k = 17;
    const float cc = sqrtf(0.5f * (float)k);
    const size_t n = (size_t)MTOK * DM;
    for (size_t i = (size_t)blockIdx.x * 512 + threadIdx.x; i < n; i += (size_t)gridDim.x * 512) out[i] = cc;
}
#endif

#if SCAN_DBG == 3
__device__ __forceinline__ void dbg_count_bf16(const bf16_t* A, size_t n, unsigned* cnt) {
    unsigned c = 0;
    for (size_t i = (size_t)blockIdx.x * 512 + threadIdx.x; i < n; i += (size_t)gridDim.x * 512) { const float x = bf2f(A[i]); if (!(x - x == 0.f)) ++c; }
    if (c) atomicAdd(cnt, c);
}
__device__ __forceinline__ void dbg_count_f32(const float* A, size_t n, unsigned* cnt) {
    unsigned c = 0;
    for (size_t i = (size_t)blockIdx.x * 512 + threadIdx.x; i < n; i += (size_t)gridDim.x * 512) { const float x = A[i]; if (!(x - x == 0.f)) ++c; }
    if (c) atomicAdd(cnt, c);
}
__device__ __forceinline__ void dbg_emit3(const unsigned* cnt, float* out) {
    float code = 0.f;
    for (int st = 3; st >= 0; --st) { const unsigned c = cnt[st]; if (c) { float lg = log10f((float)c); lg = lg > 9.f ? 9.f : lg; code = (float)(st + 1) + 0.1f * lg; } }
    const float cc = sqrtf(code);
    const size_t n = (size_t)MTOK * DM;
    for (size_t i = (size_t)blockIdx.x * 512 + threadIdx.x; i < n; i += (size_t)gridDim.x * 512) out[i] = cc;
}
#endif

#if SCAN_DBG == 4 || SCAN_DBG == 6
__device__ __forceinline__ void dbg_compare4(LAS float* red, const bf16_t* A, const bf16_t* B, const bf16_t* C, float* DBG) {
    float sd = 0.f, sr = 0.f, nn = 0.f, mm = 0.f;
    const size_t n = (size_t)MTOK * DM;
    for (size_t i = (size_t)blockIdx.x * 512 + threadIdx.x; i < n; i += (size_t)gridDim.x * 512) {
        const float x = bf2f(A[i]), y = bf2f(B[i]);
        if (!(x - x == 0.f)) nn += 1.f; else { sd += (x - y) * (x - y); sr += y * y; }
        if (A[i] != C[i]) mm += 1.f;
    }
    sd = wave_sum(sd); sr = wave_sum(sr); nn = wave_sum(nn); mm = wave_sum(mm);
    const int wv = threadIdx.x >> 6;
    if ((threadIdx.x & 63) == 0) { red[wv * 4] = sd; red[wv * 4 + 1] = sr; red[wv * 4 + 2] = nn; red[wv * 4 + 3] = mm; }
    __syncthreads();
    if (threadIdx.x == 0) { float a = 0, b = 0, c = 0, d = 0; for (int w = 0; w < 8; ++w) { a += red[w * 4]; b += red[w * 4 + 1]; c += red[w * 4 + 2]; d += red[w * 4 + 3]; }
        DBG[blockIdx.x * 4] = a; DBG[blockIdx.x * 4 + 1] = b; DBG[blockIdx.x * 4 + 2] = c; DBG[blockIdx.x * 4 + 3] = d; }
    __syncthreads();
}
__device__ __forceinline__ void dbg_emit4(const float* DBG, float* out) {
    float a = 0, b = 0, c = 0, d = 0;
    for (int w = 0; w < (int)gridDim.x; ++w) { a += DBG[w * 4]; b += DBG[w * 4 + 1]; c += DBG[w * 4 + 2]; d += DBG[w * 4 + 3]; }
    const float rel = sqrtf(a / b);
    int k = (int)rintf(-log10f(rel)); k = k < 0 ? 0 : (k > 8 ? 8 : k);
#if SCAN_DBG == 6
    const float cc = sqrtf((float)k + ((d + c) > 0.f ? 0.5f : 0.f));
#else
    int m = (int)ceilf(log10f(1.0f + d + c)); m = m > 9 ? 9 : m;
    const float cc = sqrtf((float)k + 0.1f * (float)m);
#endif
    const size_t n = (size_t)MTOK * DM;
    for (size_t i = (size_t)blockIdx.x * 512 + threadIdx.x; i < n; i += (size_t)gridDim.x * 512) out[i] = cc;
}
#endif

#if SCAN_DBG == 5
__device__ __forceinline__ void dbg_lds16_test(LAS unsigned char* lds, unsigned* cnt) {
    const int tid = threadIdx.x;
    unsigned bad = 0;
    for (int rep = 0; rep < 64; ++rep) {
        for (int i = tid; i < 1024; i += 512) *(LAS u32x4*)(lds + i * 16) = (u32x4){0x7fc07fc0u, 0x7fc07fc0u, 0x7fc07fc0u, 0x7fc07fc0u};
        __syncthreads();
        const int k = tid & 127, part = tid >> 7;
#pragma unroll
        for (int i = 0; i < 16; ++i) {
            const int row = 16 * part + i;
            *(LAS bf16_t*)(lds + off_b(row, k >> 3) + 2 * (k & 7)) = (bf16_t)((row * 128 + k + rep) & 0x7fff);
        }
        __syncthreads();
        for (int idx = tid; idx < 64 * 128; idx += 512) {
            const int row = idx >> 7, kk = idx & 127;
            const bf16_t got = *(const LAS bf16_t*)(lds + off_b(row, kk >> 3) + 2 * (kk & 7));
            if (got != (bf16_t)((row * 128 + kk + rep) & 0x7fff)) ++bad;
        }
        __syncthreads();
    }
    if (bad) atomicAdd(cnt, bad);
}
__device__ __forceinline__ void dbg_emit5(const unsigned* cnt, float* out) {
    const unsigned c = cnt[0];
    float code = 0.f;
    if (c) { float lg = log10f((float)c); code = 1.0f + (lg > 8.9f ? 8.9f : lg); }
    const float cc = sqrtf(code);
    const size_t n = (size_t)MTOK * DM;
    for (size_t i = (size_t)blockIdx.x * 512 + threadIdx.x; i < n; i += (size_t)gridDim.x * 512) out[i] = cc;
}
#endif

#if SCAN_DBG == 6
__device__ __forceinline__ void dbg_check_a(LAS float* red, const float* LF, const bf16_t* I1, const bf16_t* LT, const bf16_t* LT2, float* DBG) {
    float sd = 0.f, sr = 0.f, mm = 0.f;
    const size_t n = (size_t)4096 * 16384;
    for (size_t i = (size_t)blockIdx.x * 512 + threadIdx.x; i < n; i += (size_t)gridDim.x * 512) {
        const int item = (int)(i >> 14), v = (int)((i >> 7) & 127), k = (int)(i & 127);
        const int bh = item >> 7, c = item & 127, b = bh >> 4, h = bh & 15;
        const size_t tok0 = (size_t)b * SEQ + c * 64;
        float g = 1.f, L = 0.f;
        for (int s2 = 63; s2 >= 0; --s2) {
            const size_t o = (tok0 + s2) * DM + h * 128;
            const float f = __expf(LF[o + k]);
            L += bf2f(I1[o + v]) * (1.0f - f) * g;
            g *= f;
        }
        const float x = bf2f(LT[i]);
        sd += (x - L) * (x - L); sr += L * L;
        if (LT[i] != LT2[i]) mm += 1.f;
    }
    sd = wave_sum(sd); sr = wave_sum(sr); mm = wave_sum(mm);
    const int wv = threadIdx.x >> 6;
    if ((threadIdx.x & 63) == 0) { red[wv * 4] = sd; red[wv * 4 + 1] = sr; red[wv * 4 + 2] = 0.f; red[wv * 4 + 3] = mm; }
    __syncthreads();
    if (threadIdx.x == 0) { float a = 0, b2 = 0, d = 0; for (int w = 0; w < 8; ++w) { a += red[w * 4]; b2 += red[w * 4 + 1]; d += red[w * 4 + 3]; }
        DBG[blockIdx.x * 4] = a; DBG[blockIdx.x * 4 + 1] = b2; DBG[blockIdx.x * 4 + 2] = 0.f; DBG[blockIdx.x * 4 + 3] = d; }
    __syncthreads();
}
#endif

#if SCAN_DBG == 7
#ifndef DBG_FAM
#define DBG_FAM 0
#endif
__device__ __forceinline__ void dbg_check_a7(const float* LF, const bf16_t* I1, const bf16_t* LT, float* DBG) {
    const size_t n = (size_t)4096 * 16384;
    float nbad = 0.f, nnf = 0.f;
    for (size_t i = (size_t)blockIdx.x * 512 + threadIdx.x; i < n; i += (size_t)gridDim.x * 512 * 8) {
        const int item = (int)(i >> 14), v = (int)((i >> 7) & 127), k = (int)(i & 127);
        const int bh = item >> 7, c = item & 127, b = bh >> 4, h = bh & 15;
        const size_t tok0 = (size_t)b * SEQ + c * 64;
        float g = 1.f, L = 0.f;
        for (int s2 = 63; s2 >= 0; --s2) {
            const size_t o = (tok0 + s2) * DM + h * 128;
            const float f = __expf(LF[o + k]);
            L += bf2f(I1[o + v]) * (1.0f - f) * g;
            g *= f;
        }
        const float x = bf2f(LT[i]);
        if (!(x - x == 0.f)) { nnf += 1.f; nbad += 1.f; }
        else if (fabsf(x - L) > 0.02f * fabsf(L) + 1e-2f) nbad += 1.f;
    }
    nbad = wave_sum(nbad); nnf = wave_sum(nnf);
    if ((threadIdx.x & 63) == 0) { atomicAdd(DBG, nbad); atomicAdd(DBG + 1, nnf); }
}
__device__ __forceinline__ void dbg_emit7(const float* DBG, float* out) {
    const float nb = DBG[0], nf = DBG[1];
    int A = nb == 0.f ? 0 : (nb <= 100.f ? 1 : (nb <= 1e4f ? 3 : (nb <= 1e6f ? 5 : 7)));
    int B = nf == 0.f ? 0 : 5;
    const float cc = sqrtf((float)A + 0.1f * (float)B);
    const size_t n = (size_t)MTOK * DM;
    for (size_t i = (size_t)blockIdx.x * 512 + threadIdx.x; i < n; i += (size_t)gridDim.x * 512) out[i] = cc;
}
#endif
__device__ __forceinline__ int opaque(int v) { asm volatile("" : "+s"(v)); return v; }
template <bool L1> __device__ __forceinline__ void run_gemm_out(const Args& a, LAS unsigned char* lds) {
    unsigned char* ws = a.ws;
    pg8::Gemm g{(const bf16_t*)(ws + (L1 ? slot(3) : slot(0))), (const bf16_t*)(ws + (L1 ? WS_WO : WS_WOUT)), opaque(MTOK), opaque(DM), opaque(DM)};
    pg8::StaticOrder S; S.init(g.M, g.N, (int)gridDim.x, (int)blockIdx.x);
    EpiRes E{L1 ? (const float*)(ws + slot(0)) : a.in[0], (float*)(ws + (L1 ? slot(4) : slot(1)))};
    pg8::gemm_phase<EpiRes, pg8::StaticOrder>(lds, g, S, E, nullptr);
}
template <bool L1> __device__ __forceinline__ void run_ln(const Args& a) {
    unsigned char* ws = a.ws;
    phase_ln((const float*)(ws + (L1 ? slot(4) : slot(1))), a.in[12] + (L1 ? 2 : 0) * DM, a.in[13] + (L1 ? 2 : 0) * DM,
             (float*)(ws + (L1 ? slot(6) : slot(3))), (bf16_t*)(ws + (L1 ? slot(8) : slot(5))));
}
template <bool L1> __device__ __forceinline__ void run_gemm_sc(const Args& a, LAS unsigned char* lds) {
    unsigned char* ws = a.ws;
    pg8::Gemm g{(const bf16_t*)(ws + (L1 ? slot(8) : slot(5))), (const bf16_t*)(ws + WS_WC) + (L1 ? (size_t)DM * DM : 0), opaque(MTOK), opaque(DM), opaque(DM)};
    pg8::StaticOrder S; S.init(g.M, g.N, (int)gridDim.x, (int)blockIdx.x);
    EpiF32 E{(float*)(ws + (L1 ? slot(0) : slot(6)))};
    pg8::gemm_phase<EpiF32, pg8::StaticOrder>(lds, g, S, E, nullptr);
}
template <bool L1> __device__ __forceinline__ void run_topk(const Args& a, LAS unsigned char* lds) {
    unsigned char* ws = a.ws;
    phase_topk(lds, (const float*)(ws + (L1 ? slot(0) : slot(6))), (int*)(ws + WS_EID), (float*)(ws + WS_GATE));
}
template <bool L1> __device__ __forceinline__ void run_peer(const Args& a) {
    unsigned char* ws = a.ws;
    phase_peer((const float*)(ws + (L1 ? slot(6) : slot(3))), (const int*)(ws + WS_EID), (const float*)(ws + WS_GATE),
               (const bf16_t*)(ws + WS_UB) + (L1 ? (size_t)16384 * DM : 0), (const bf16_t*)(ws + WS_VB) + (L1 ? (size_t)16384 * DM : 0),
               a.in[12] + (L1 ? 3 : 1) * DM, a.in[13] + (L1 ? 3 : 1) * DM,
               L1 ? a.out : (float*)(ws + slot(0)), L1 ? (bf16_t*)nullptr : (bf16_t*)(ws + slot(2)));
}

__global__ void __launch_bounds__(512, 2) mk_fwd(Args a) {
    extern __shared__ __attribute__((aligned(16))) unsigned char lds_raw[];
    LAS unsigned char* lds = (LAS unsigned char*)lds_raw;
    cg::grid_group grid = cg::this_grid();
    unsigned char* ws = a.ws;
#define PHASE_BEGIN(k) if (a.ph_lo <= (k) && (k) < a.ph_hi && EN(k)) {
#define PHASE_END(k) asm volatile("s_waitcnt vmcnt(0)" ::: "memory"); __syncthreads(); if ((k) + 1 < a.ph_hi) { grid.sync(); if (threadIdx.x < 64) { __builtin_amdgcn_fence(__ATOMIC_ACQUIRE, "agent"); asm volatile("s_waitcnt vmcnt(0)" ::: "memory"); } __syncthreads(); } }
    PHASE_BEGIN(0) phase_prep(a, lds);
#if SCAN_DBG == 3 || SCAN_DBG == 5
        if (blockIdx.x == 0 && threadIdx.x < 8) ((unsigned*)(ws + WS_CTR + 8192))[threadIdx.x] = 0u;
#endif
#if SCAN_DBG == 7
        if (blockIdx.x == 0 && threadIdx.x < 32) ((float*)(ws + WS_CTR + 4096))[threadIdx.x] = 0.f;
#endif
    PHASE_END(0)
#if SCAN_DBG == 5
    PHASE_BEGIN(1) dbg_lds16_test(lds, (unsigned*)(ws + WS_CTR + 8192)); PHASE_END(1)
#define SKIP_REST 1
#endif
    PHASE_BEGIN(1) {
        pg8::Gemm g{(const bf16_t*)(ws + slot(0)), (const bf16_t*)(ws + WS_WIN), opaque(MTOK), opaque(4 * DM), opaque(DM)};
        pg8::StaticOrder S; S.init(g.M, g.N, (int)gridDim.x, (int)blockIdx.x);
        EpiIn E{(bf16_t*)(ws + slot(1)), (float*)(ws + slot(4)), (bf16_t*)(ws + slot(2)), (bf16_t*)(ws + slot(3)), (const float*)(ws + WS_LB)};
        pg8::gemm_phase<EpiIn, pg8::StaticOrder>(lds, g, S, E, nullptr);
    } PHASE_END(1)
    PHASE_BEGIN(2) phase_scan_a(lds, (const float*)(ws + slot(4)), (const bf16_t*)(ws + slot(2)), (bf16_t*)(ws + slot(6)), (float*)(ws + WS_DEC)
#if SCAN_DBG == 3
        , (unsigned*)(ws + WS_CTR + 8192)
#endif
        );
#if SCAN_DBG == 7
        asm volatile("s_waitcnt vmcnt(0)" ::: "memory"); __syncthreads(); grid.sync(); if (threadIdx.x < 64) { __builtin_amdgcn_fence(__ATOMIC_ACQUIRE, "agent"); asm volatile("s_waitcnt vmcnt(0)" ::: "memory"); } __syncthreads();
        dbg_check_a7((const float*)(ws + slot(4)), (const bf16_t*)(ws + slot(2)), (const bf16_t*)(ws + slot(6)), (float*)(ws + WS_CTR + 4096));
#endif
#if SCAN_DBG == 6
#define DSYNC6() asm volatile("s_waitcnt vmcnt(0)" ::: "memory"); __syncthreads(); grid.sync(); if (threadIdx.x < 64) { __builtin_amdgcn_fence(__ATOMIC_ACQUIRE, "agent"); asm volatile("s_waitcnt vmcnt(0)" ::: "memory"); } __syncthreads();
        DSYNC6()
        phase_scan_a(lds, (const float*)(ws + slot(4)), (const bf16_t*)(ws + slot(2)), (bf16_t*)a.out, (float*)(ws + WS_DEC));
        DSYNC6()
        dbg_check_a((LAS float*)lds, (const float*)(ws + slot(4)), (const bf16_t*)(ws + slot(2)), (const bf16_t*)(ws + slot(6)), (const bf16_t*)a.out, (float*)(ws + WS_CTR + 4096));
#endif
#if SCAN_DBG == 3
        asm volatile("s_waitcnt vmcnt(0)" ::: "memory"); __syncthreads(); grid.sync();
        dbg_count_bf16((const bf16_t*)(ws + slot(6)), (size_t)4096 * 16384, (unsigned*)(ws + WS_CTR + 8192) + 2);
#endif
    PHASE_END(2)
    PHASE_BEGIN(3) phase_scan_b((bf16_t*)(ws + slot(6)), (const float*)(ws + WS_DEC));
#if SCAN_DBG == 3
        asm volatile("s_waitcnt vmcnt(0)" ::: "memory"); __syncthreads(); grid.sync();

#endif
    PHASE_END(3)
    PHASE_BEGIN(4) phase_scan_c(lds, (const bf16_t*)(ws + slot(1)), (const float*)(ws + slot(4)), (const bf16_t*)(ws + slot(2)), (const bf16_t*)(ws + slot(3)), (const bf16_t*)(ws + slot(6)), a.in[2], (bf16_t*)(ws + slot(0)));
#if SCAN_DBG == 1
        asm volatile("s_waitcnt vmcnt(0)" ::: "memory"); __syncthreads(); grid.sync();
        phase_scan_naive((const bf16_t*)(ws + slot(1)), (const float*)(ws + slot(4)), (const bf16_t*)(ws + slot(2)), (float*)(ws + slot(6)));
        asm volatile("s_waitcnt vmcnt(0)" ::: "memory"); __syncthreads(); grid.sync();
        phase_onorm((const float*)(ws + slot(6)), (const bf16_t*)(ws + slot(3)), a.in[2], (bf16_t*)(ws + slot(0)));
#endif
#if SCAN_DBG == 3
        asm volatile("s_waitcnt vmcnt(0)" ::: "memory"); __syncthreads(); grid.sync();

#endif
#if SCAN_DBG == 4
#define DSYNC() asm volatile("s_waitcnt vmcnt(0)" ::: "memory"); __syncthreads(); grid.sync(); if (threadIdx.x < 64) { __builtin_amdgcn_fence(__ATOMIC_ACQUIRE, "agent"); asm volatile("s_waitcnt vmcnt(0)" ::: "memory"); } __syncthreads();
        DSYNC()
        phase_scan_naive((const bf16_t*)(ws + slot(1)), (const float*)(ws + slot(4)), (const bf16_t*)(ws + slot(2)), (float*)(ws + slot(6)));
        DSYNC()
        phase_onorm((const float*)(ws + slot(6)), (const bf16_t*)(ws + slot(3)), a.in[2], (bf16_t*)(ws + slot(8)));
        DSYNC()
        phase_scan_a(lds, (const float*)(ws + slot(4)), (const bf16_t*)(ws + slot(2)), (bf16_t*)(ws + slot(6)), (float*)(ws + WS_DEC));
        DSYNC()
        phase_scan_b((bf16_t*)(ws + slot(6)), (const float*)(ws + WS_DEC));
        DSYNC()
        phase_scan_c(lds, (const bf16_t*)(ws + slot(1)), (const float*)(ws + slot(4)), (const bf16_t*)(ws + slot(2)), (const bf16_t*)(ws + slot(3)), (const bf16_t*)(ws + slot(6)), a.in[2], (bf16_t*)a.out);
        DSYNC()
        dbg_compare4((LAS float*)lds, (const bf16_t*)(ws + slot(0)), (const bf16_t*)(ws + slot(8)), (const bf16_t*)a.out, (float*)(ws + WS_CTR + 4096));
#endif
#if SCAN_DBG == 2
        asm volatile("s_waitcnt vmcnt(0)" ::: "memory"); __syncthreads(); grid.sync();
        phase_scan_naive((const bf16_t*)(ws + slot(1)), (const float*)(ws + slot(4)), (const bf16_t*)(ws + slot(2)), (float*)(ws + slot(6)));
        asm volatile("s_waitcnt vmcnt(0)" ::: "memory"); __syncthreads(); grid.sync();
        phase_onorm((const float*)(ws + slot(6)), (const bf16_t*)(ws + slot(3)), a.in[2], (bf16_t*)(ws + slot(8)));
        asm volatile("s_waitcnt vmcnt(0)" ::: "memory"); __syncthreads(); grid.sync();
        dbg_compare((LAS float*)lds, (const bf16_t*)(ws + slot(0)), (const bf16_t*)(ws + slot(8)), (float*)(ws + WS_CTR + 4096));
#endif
    PHASE_END(4)
    PHASE_BEGIN(5) run_gemm_out<false>(a, lds); PHASE_END(5)
    PHASE_BEGIN(6) run_ln<false>(a); PHASE_END(6)
    PHASE_BEGIN(7) run_gemm_sc<false>(a, lds); PHASE_END(7)
    PHASE_BEGIN(8) run_topk<false>(a, lds); PHASE_END(8)
    PHASE_BEGIN(9) run_peer<false>(a); PHASE_END(9)
    PHASE_BEGIN(10) {
        pg8::Gemm g{(const bf16_t*)(ws + slot(2)), (const bf16_t*)(ws + WS_WKVQ), opaque(MTOK), opaque(3 * DM), opaque(DM)};
        pg8::StaticOrder S; S.init(g.M, g.N, (int)gridDim.x, (int)blockIdx.x);
        EpiKVQ E{(bf16_t*)(ws + slot(3)), (bf16_t*)(ws + slot(4)), (bf16_t*)(ws + slot(5))};
        pg8::gemm_phase<EpiKVQ, pg8::StaticOrder>(lds, g, S, E, nullptr);
    } PHASE_END(10)
    PHASE_BEGIN(11) phase_rot((LAS float*)lds, (bf16_t*)(ws + slot(3)), (bf16_t*)(ws + slot(5)), (const float*)(ws + WS_COS), (const float*)(ws + WS_SIN), (float*)(ws + WS_KMEAN), (float*)(ws + WS_KNMAX)); PHASE_END(11)
    PHASE_BEGIN(12) phase_sel(lds, (const bf16_t*)(ws + slot(5)), (const float*)(ws + WS_KMEAN), (unsigned short*)(ws + WS_SUB), (int*)(ws + WS_CNT), (int*)(ws + WS_CTR)); PHASE_END(12)
    PHASE_BEGIN(13) phase_att(lds, (const bf16_t*)(ws + slot(5)), (const bf16_t*)(ws + slot(3)), (const bf16_t*)(ws + slot(4)), (const float*)(ws + WS_KNMAX), (const unsigned short*)(ws + WS_SUB),
                              (const int*)(ws + WS_CNT), (int*)(ws + WS_CTR), (bf16_t*)(ws + slot(6)), (bf16_t*)(ws + slot(2)), (float*)(ws + WS_LS)); PHASE_END(13)
    PHASE_BEGIN(14) phase_comb((const bf16_t*)(ws + slot(6)), (const bf16_t*)(ws + slot(2)), (const float*)(ws + WS_LS), (bf16_t*)(ws + slot(3))); PHASE_END(14)
    PHASE_BEGIN(15) run_gemm_out<true>(a, lds); PHASE_END(15)
    PHASE_BEGIN(16) run_ln<true>(a); PHASE_END(16)
    PHASE_BEGIN(17) run_gemm_sc<true>(a, lds); PHASE_END(17)
    PHASE_BEGIN(18) run_topk<true>(a, lds); PHASE_END(18)
#if SCAN_DBG == 7
    PHASE_BEGIN(19) dbg_emit7((const float*)(ws + WS_CTR + 4096), a.out); PHASE_END(19)
#elif SCAN_DBG == 6
    PHASE_BEGIN(19) dbg_emit4((const float*)(ws + WS_CTR + 4096), a.out); PHASE_END(19)
#elif SCAN_DBG == 5
    PHASE_BEGIN(19) dbg_emit5((const unsigned*)(ws + WS_CTR + 8192), a.out); PHASE_END(19)
#elif SCAN_DBG == 4
    PHASE_BEGIN(19) dbg_emit4((const float*)(ws + WS_CTR + 4096), a.out); PHASE_END(19)
#elif SCAN_DBG == 3
    PHASE_BEGIN(19) dbg_emit3((const unsigned*)(ws + WS_CTR + 8192), a.out); PHASE_END(19)
#elif SCAN_DBG == 2
    PHASE_BEGIN(19) dbg_emit((const float*)(ws + WS_CTR + 4096), a.out); PHASE_END(19)
#else
    PHASE_BEGIN(19) run_peer<true>(a); PHASE_END(19)
#endif
}

extern "C" void kernel_launch(void* const* d_in, const int* in_sizes, int n_in, void* d_out, int out_size, void* d_ws, size_t ws_size, hipStream_t stream) {
    static int grid = 0;
    if (grid == 0) {
        if (n_in != 14 || out_size != MTOK * DM || ws_size < WS_END) { fprintf(stderr, "kernel_launch: unexpected shapes (n_in %d, out %d, ws %zu)\n", n_in, out_size, ws_size); grid = -1; return; }
        int dev = 0, cus = 0, per_cu = 0;
        if (hipGetDevice(&dev) != hipSuccess || hipDeviceGetAttribute(&cus, hipDeviceAttributeMultiprocessorCount, dev) != hipSuccess) { grid = -1; return; }
        if (hipFuncSetAttribute((const void*)mk_fwd, hipFuncAttributeMaxDynamicSharedMemorySize, LDS_BYTES) != hipSuccess) { fprintf(stderr, "kernel_launch: hipFuncSetAttribute failed\n"); grid = -1; return; }
        if (hipOccupancyMaxActiveBlocksPerMultiprocessor(&per_cu, (const void*)mk_fwd, 512, LDS_BYTES) != hipSuccess || per_cu < 1) { fprintf(stderr, "kernel_launch: occupancy query failed (%d)\n", per_cu); (void)hipGetLastError(); per_cu = 1; }
        grid = cus * (per_cu > 1 ? 1 : per_cu);
    }
    if (grid < 0) return;
    Args a{};
    for (int i = 0; i < 14; ++i) a.in[i] = (const float*)d_in[i];
    a.out = (float*)d_out; a.ws = (unsigned char*)d_ws;
#if ONE_LAUNCH
    a.ph_lo = 0; a.ph_hi = NPH;
    void* args[] = {&a};
    hipError_t e = hipLaunchCooperativeKernel((const void*)mk_fwd, dim3(grid), dim3(512), args, LDS_BYTES, stream);
    if (e != hipSuccess) fprintf(stderr, "cooperative launch failed: %s (grid %d)\n", hipGetErrorString(e), grid);
#else
    for (int ph = 0; ph < NPH; ++ph) {
        a.ph_lo = ph; a.ph_hi = ph + 1;
        hipLaunchKernelGGL(mk_fwd, dim3(grid), dim3(512), LDS_BYTES, stream, a);
    }
#endif
}
```

```cpp
#define ONE_LAUNCH 1
#include <hip/hip_runtime.h>
#include <hip/hip_cooperative_groups.h>
#include <cstdio>
namespace cg = cooperative_groups;

#ifndef ONE_LAUNCH
#define ONE_LAUNCH 0
#endif
#ifndef SCAN_DBG
#define SCAN_DBG 0
#endif
#ifndef SCAN_A_VALU
#define SCAN_A_VALU 0
#endif
#ifndef ENMASK
#define ENMASK 0xffffffffu
#endif
#define EN(k) ((ENMASK >> (k)) & 1u)

namespace pg8 {
#define PG8_LAS __attribute__((address_space(3)))
typedef unsigned short bf16_t;
typedef short bf16x8 __attribute__((ext_vector_type(8)));
typedef float f32x4 __attribute__((ext_vector_type(4)));
typedef unsigned u32x4 __attribute__((ext_vector_type(4)));
constexpr int BM = 256, BK = 64, HALF = 128, HTB = HALF * BK * 2  , STAGE_BYTES = 8 * HTB, NXCD = 8, WGM = 8;

__host__ __device__ __forceinline__ int lds_byte(int r, int c) { const int st = (r >> 4) * 2 + (c >> 5), rr = r & 15, cc = c & 31, ob = rr * 64 + cc * 2; return st * 1024 + (ob ^ (((ob >> 9) & 1) << 5)); }
__host__ __device__ __forceinline__ void stage_rc(int b, int& R, int& C) { const int st = b / 1024, sb = b % 1024, swz = sb ^ (((sb >> 9) & 1) << 5); R = (st >> 1) * 16 + swz / 64; C = (st & 1) * 32 + (swz % 64) / 2; }
__host__ __device__ __forceinline__ int perm32(int rho) { const int n = rho >> 4, i = rho & 15; return 8 * (i >> 2) + 4 * n + (i & 3); }

struct Unit { int pm, pn; };
struct Gemm { const bf16_t* A; const bf16_t* Bt; int M, N, K; };

struct StaticOrder {
    int nM, nN, nwg, G, c;
    __host__ __device__ void init(int M, int N, int G_, int c_) { nM = M / BM; nN = N / BM; nwg = nM * nN; G = G_; c = c_; }
    __host__ __device__ bool next(int i, Unit& u) const {
        const long L = (long)i * G + c; if (L >= nwg) return false;
        int wgid = (int)L; { const int q = nwg / NXCD, r = nwg % NXCD, xcd = wgid % NXCD, off = wgid / NXCD; wgid = (xcd < r ? xcd * (q + 1) : r * (q + 1) + (xcd - r) * q) + off; }
        const int nig = WGM * nN, gid = wgid / nig, fm = gid * WGM, gsz = (nM - fm) < WGM ? (nM - fm) : WGM;
        u.pm = fm + ((wgid % nig) % gsz); u.pn = (wgid % nig) / gsz; return true;
    }
    __device__ __forceinline__ void a_ready(const Unit&) const {}
    __device__ __forceinline__ void done(const Unit&) const {}
};
struct CountedOrder : StaticOrder {
    const unsigned* ready; unsigned need; unsigned* tmo;
    __device__ __forceinline__ void a_ready(const Unit& u) const {
        if (threadIdx.x < 64) {
            const unsigned long long t0 = __builtin_amdgcn_s_memrealtime(); unsigned polls = 0;
            while ((unsigned)__builtin_amdgcn_readfirstlane(__hip_atomic_load(ready + 64 * u.pm, __ATOMIC_RELAXED, __HIP_MEMORY_SCOPE_AGENT)) < need) {
                if ((++polls & 255u) == 0u && __builtin_amdgcn_readfirstlane(__hip_atomic_load(tmo, __ATOMIC_RELAXED, __HIP_MEMORY_SCOPE_AGENT)) != 0u) break;
                if (__builtin_amdgcn_s_memrealtime() - t0 > 2000000ull) {
                    if (threadIdx.x == 0) { unsigned expect = 0u; __hip_atomic_compare_exchange_strong(tmo + 1, &expect, 0x600u | (unsigned)(u.pm & 0xff), __ATOMIC_RELAXED, __ATOMIC_RELAXED, __HIP_MEMORY_SCOPE_AGENT); __hip_atomic_store(tmo, 1u, __ATOMIC_RELAXED, __HIP_MEMORY_SCOPE_AGENT); }
                    break; }
                __builtin_amdgcn_s_sleep(2); }
            __builtin_amdgcn_fence(__ATOMIC_ACQUIRE, "agent");
            asm volatile("s_waitcnt vmcnt(0)" ::: "memory");
        }
#if !defined(BROKEN_HOOK_NO_BARRIER)
        asm volatile("" ::: "memory"); __builtin_amdgcn_s_barrier(); asm volatile("" ::: "memory");
#endif
    }
};

__device__ __forceinline__ unsigned cvt_pk_bf16(float lo, float hi) { unsigned r; asm volatile("v_cvt_pk_bf16_f32 %0, %1, %2" : "=v"(r) : "v"(lo), "v"(hi)); return r; }
typedef float f32x2 __attribute__((ext_vector_type(2)));
__device__ __forceinline__ f32x2 gelu_pk(f32x2 v) {
    const f32x2 av = __builtin_elementwise_abs(v), d = av * 0.2316418882f + 1.0f;
    f32x2 t; t.x = __builtin_amdgcn_rcpf(d.x); t.y = __builtin_amdgcn_rcpf(d.y);
    f32x2 q = t * 0.5307027145f + (-0.7265760135f); q = q * t + 0.7107068705f; q = q * t + (-0.142248368f); q = q * t + 0.127414796f; q = q * t;
    const f32x2 s = (v * v) * (-0.72134752044f);
    f32x2 e; e.x = __builtin_amdgcn_exp2f(s.x); e.y = __builtin_amdgcn_exp2f(s.y);
    const f32x2 m = v * (q * e), r = v - m;
    f32x2 o; o.x = v.x < 0.f ? m.x : r.x; o.y = v.y < 0.f ? m.y : r.y; return o;
}

struct EpiF32 {
    static constexpr bool PERM = false, AFTER_DRAIN = false;
    float* C; int ldc; const float* bias;
    __device__ __forceinline__ void operator()(const f32x4 (&acc)[2][2][4][2], const Unit& u, int wr, int wc, int fr, int fq) const {
        const int row0 = u.pm * BM + wr * 64 + fr, col0 = u.pn * BM + wc * 32 + 4 * fq;
        f32x4 bv[2][2];
#pragma unroll
        for (int bj = 0; bj < 2; ++bj)
#pragma unroll
            for (int n = 0; n < 2; ++n) bv[bj][n] = bias ? *(const f32x4*)(bias + col0 + bj * HALF + n * 16) : (f32x4){0.f, 0.f, 0.f, 0.f};
#pragma unroll
        for (int ai = 0; ai < 2; ++ai)
#pragma unroll
            for (int m = 0; m < 4; ++m) { float* rowp = C + (size_t)(row0 + ai * HALF + m * 16) * ldc + col0;
#pragma unroll
                for (int bj = 0; bj < 2; ++bj)
#pragma unroll
                    for (int n = 0; n < 2; ++n) *(f32x4*)(rowp + bj * HALF + n * 16) = acc[ai][bj][m][n] + bv[bj][n]; }
    }
};
template <int ACT  > struct EpiBf16 {
    static constexpr bool PERM = true, AFTER_DRAIN = false;
    bf16_t* O; int ldc; const float* bias; int split_cols; size_t split_stride;
    __device__ __forceinline__ void operator()(const f32x4 (&acc)[2][2][4][2], const Unit& u, int wr, int wc, int fr, int fq) const {
        const int row0 = u.pm * BM + wr * 64 + fr; int colt = u.pn * BM; bf16_t* base = O;
        if (split_cols) { const int t = colt / split_cols; base += (size_t)t * split_stride; colt -= t * split_cols; }
        const int col0 = colt + wc * 32 + 8 * fq, bcol0 = u.pn * BM + wc * 32 + 8 * fq;
        f32x4 bv[2][2];
#pragma unroll
        for (int bj = 0; bj < 2; ++bj)
#pragma unroll
            for (int n = 0; n < 2; ++n) bv[bj][n] = bias ? *(const f32x4*)(bias + bcol0 + bj * HALF + 4 * n) : (f32x4){0.f, 0.f, 0.f, 0.f};
#pragma unroll
        for (int ai = 0; ai < 2; ++ai)
#pragma unroll
            for (int m = 0; m < 4; ++m) { bf16_t* rowp = base + (size_t)(row0 + ai * HALF + m * 16) * ldc + col0;
#pragma unroll
                for (int bj = 0; bj < 2; ++bj) { f32x4 v0 = acc[ai][bj][m][0] + bv[bj][0], v1 = acc[ai][bj][m][1] + bv[bj][1];
                    if (ACT == 1) { f32x2 a = gelu_pk((f32x2){v0[0], v0[1]}), b = gelu_pk((f32x2){v0[2], v0[3]}), c = gelu_pk((f32x2){v1[0], v1[1]}), d = gelu_pk((f32x2){v1[2], v1[3]});
                        v0 = (f32x4){a.x, a.y, b.x, b.y}; v1 = (f32x4){c.x, c.y, d.x, d.y}; }
                    if (ACT == 2) {
#pragma unroll
                        for (int j = 0; j < 4; ++j) { v0[j] = 0.5f * v0[j] * (1.0f + erff(v0[j] * 0.70710678f)); v1[j] = 0.5f * v1[j] * (1.0f + erff(v1[j] * 0.70710678f)); } }
                    u32x4 w; w.x = cvt_pk_bf16(v0[0], v0[1]); w.y = cvt_pk_bf16(v0[2], v0[3]); w.z = cvt_pk_bf16(v1[0], v1[1]); w.w = cvt_pk_bf16(v1[2], v1[3]);
                    *(u32x4*)(rowp + bj * HALF) = w; } }
    }
};

template <class Epi, class Sched, bool STAMP = false>
__device__ __forceinline__ void gemm_phase(PG8_LAS unsigned char* lds, const Gemm g, const Sched& S, const Epi& E, unsigned long long* stamps) {
    const int tid = threadIdx.x, wid = __builtin_amdgcn_readfirstlane(tid >> 6), lane = tid & 63, wr = wid >> 2, wc = wid & 3, fr = lane & 15, fq = lane >> 4;
    const int K = g.K, nt = K / BK;
    int ts_lo = 0, ts_hi = 0, nts = 0; const unsigned long long rt_entry = STAMP ? (unsigned long long)wall_clock64() : 0ull;
#define PG8_STAMP() do { if (STAMP && wid == 0 && nts < 64) { const unsigned long long _c = (unsigned long long)clock64(); \
        ts_lo = (lane == nts) ? (int)(unsigned)_c : ts_lo; ts_hi = (lane == nts) ? (int)(unsigned)(_c >> 32) : ts_hi; ++nts; } } while (0)
    PG8_STAMP();
    unsigned voffA[2], voffB[2];
#pragma unroll
    for (int i = 0; i < 2; ++i) { int R, C; stage_rc(tid * 16 + i * 8192, R, C); const int Rb = Epi::PERM ? ((R & ~31) + perm32(R & 31)) : R;
        voffA[i] = (unsigned)(R * K + C) * 2u; voffB[i] = (unsigned)(Rb * K + C) * 2u; }
    const size_t kstep = (size_t)(BK * 2);
    const size_t hstep = (size_t)HALF * K * 2;
    const size_t tstep = 2 * hstep;
    const unsigned ldsw = (unsigned)wid * 1024u;
    const int aoff = lds_byte(wr * 64 + fr, fq * 8), boff = lds_byte(wc * 32 + fr, fq * 8);
#define PG8_SA(b, h) (((b) * 2 + (h)) * HTB)
#define PG8_SB(b, h) ((4 + (b) * 2 + (h)) * HTB)
#define PG8_STAGE(bufoff, gbase, voff) do { _Pragma("unroll") for (int _i = 0; _i < 2; ++_i) \
        __builtin_amdgcn_global_load_lds((const unsigned*)((const char*)(gbase) + (voff)[_i]), (PG8_LAS unsigned*)(lds + (bufoff) + ldsw + _i * 8192), 16, 0, 0); } while (0)
#define PG8_LDA(dst, b, h) do { _Pragma("unroll") for (int m = 0; m < 4; ++m) _Pragma("unroll") for (int k = 0; k < 2; ++k) dst[m][k] = *(const PG8_LAS bf16x8*)(lds + PG8_SA(b, h) + aoff + m * 2048 + k * 1024); } while (0)
#define PG8_LDB(dst, b, h) do { _Pragma("unroll") for (int n = 0; n < 2; ++n) _Pragma("unroll") for (int k = 0; k < 2; ++k) dst[n][k] = *(const PG8_LAS bf16x8*)(lds + PG8_SB(b, h) + boff + n * 2048 + k * 1024); } while (0)
#define PG8_MMA(ai, bj, At, Bt) do { __builtin_amdgcn_s_setprio(1); _Pragma("unroll") for (int m = 0; m < 4; ++m) _Pragma("unroll") for (int n = 0; n < 2; ++n) _Pragma("unroll") for (int k = 0; k < 2; ++k) \
        acc[ai][bj][m][n] = __builtin_amdgcn_mfma_f32_16x16x32_bf16(Bt[n][k], At[m][k], acc[ai][bj][m][n], 0, 0, 0); __builtin_amdgcn_s_setprio(0); } while (0)
#define PG8_WAIT_V(n) asm volatile("s_waitcnt vmcnt(" #n ")" ::: "memory")
#define PG8_WAIT_L(n) asm volatile("s_waitcnt lgkmcnt(" #n ")" ::: "memory")
#define PG8_BAR __builtin_amdgcn_s_barrier()
#define PG8_SCHED __builtin_amdgcn_sched_barrier(0)
    Unit cur, nxt; int ui = 0;
    if (!S.next(0, cur)) return;
    f32x4 acc[2][2][4][2];
#pragma unroll
    for (int a = 0; a < 2; ++a)
#pragma unroll
        for (int b = 0; b < 2; ++b)
#pragma unroll
            for (int m = 0; m < 4; ++m)
#pragma unroll
                for (int n = 0; n < 2; ++n) acc[a][b][m][n] = (f32x4){0.f, 0.f, 0.f, 0.f};
    bf16x8 At[4][2], B0[2][2], B1[2][2];
    const char* cA = (const char*)g.A + (size_t)cur.pm * tstep; const char* cB = (const char*)g.Bt + (size_t)cur.pn * tstep;
    S.a_ready(cur);
    PG8_STAGE(PG8_SB(0, 0), cB, voffB); PG8_STAGE(PG8_SA(0, 0), cA, voffA); PG8_STAGE(PG8_SB(0, 1), cB + hstep, voffB); PG8_STAGE(PG8_SA(0, 1), cA + hstep, voffA);
    if (wr == 1) PG8_BAR;
    PG8_WAIT_V(4); PG8_BAR;
    PG8_STAGE(PG8_SB(1, 0), cB + kstep, voffB); PG8_STAGE(PG8_SA(1, 0), cA + kstep, voffA); PG8_STAGE(PG8_SB(1, 1), cB + hstep + kstep, voffB);
    PG8_WAIT_V(6); PG8_BAR;
    PG8_STAMP();
    for (;;) {
        const bool has_next = S.next(ui + 1, nxt);
        const char* nA = has_next ? (const char*)g.A + (size_t)nxt.pm * tstep : cA; const char* nB = has_next ? (const char*)g.Bt + (size_t)nxt.pn * tstep : cB;
        for (int t = 0; t < nt; t += 2) {
            const bool last = (t == nt - 2);
            const char* a1 = cA + (size_t)(t + 1) * kstep;
            const char* a2 = last ? nA : cA + (size_t)(t + 2) * kstep; const char* b2 = last ? nB : cB + (size_t)(t + 2) * kstep;
            const char* a3 = a2 + kstep; const char* b3 = b2 + kstep;
            if (last && has_next) S.a_ready(nxt);
            PG8_LDB(B0, 0, 0); PG8_SCHED; PG8_LDA(At, 0, 0); PG8_STAGE(PG8_SA(1, 1), a1 + hstep, voffA);
            PG8_WAIT_L(8); PG8_BAR; PG8_WAIT_L(0); PG8_MMA(0, 0, At, B0); PG8_BAR; PG8_SCHED;
            PG8_LDB(B1, 0, 1); PG8_STAGE(PG8_SB(0, 0), b2, voffB);
            PG8_BAR; PG8_WAIT_L(0); PG8_MMA(0, 1, At, B1); PG8_BAR;
            PG8_LDA(At, 0, 1); PG8_STAGE(PG8_SA(0, 0), a2, voffA);
            PG8_BAR; PG8_WAIT_L(0); PG8_MMA(1, 0, At, B0); PG8_BAR; PG8_SCHED;
            PG8_STAGE(PG8_SB(0, 1), b2 + hstep, voffB);
            PG8_WAIT_V(6); PG8_BAR; PG8_MMA(1, 1, At, B1); PG8_BAR;
            PG8_LDB(B0, 1, 0); PG8_SCHED; PG8_LDA(At, 1, 0); PG8_STAGE(PG8_SA(0, 1), a2 + hstep, voffA);
            PG8_WAIT_L(8); PG8_BAR; PG8_WAIT_L(0); PG8_MMA(0, 0, At, B0); PG8_BAR; PG8_SCHED;
            PG8_LDB(B1, 1, 1); PG8_STAGE(PG8_SB(1, 0), b3, voffB);
            PG8_BAR; PG8_WAIT_L(0); PG8_MMA(0, 1, At, B1); PG8_BAR;
            PG8_LDA(At, 1, 1); PG8_STAGE(PG8_SA(1, 0), a3, voffA);
            PG8_BAR; PG8_WAIT_L(0); PG8_MMA(1, 0, At, B0); PG8_BAR; PG8_SCHED;
            PG8_STAGE(PG8_SB(1, 1), b3 + hstep, voffB);
            PG8_WAIT_V(6); PG8_BAR; PG8_MMA(1, 1, At, B1); PG8_BAR;
        }
        PG8_STAMP();
        if constexpr (!Epi::AFTER_DRAIN) { E(acc, cur, wr, wc, fr, fq); S.done(cur); }
        PG8_STAMP();
        if (!has_next) break;
#pragma unroll
        for (int a = 0; a < 2; ++a)
#pragma unroll
            for (int b = 0; b < 2; ++b)
#pragma unroll
                for (int m = 0; m < 4; ++m)
#pragma unroll
                    for (int n = 0; n < 2; ++n) acc[a][b][m][n] = (f32x4){0.f, 0.f, 0.f, 0.f};
        cur = nxt; cA = nA; cB = nB; ++ui;
    }
    PG8_WAIT_V(0);
    if (wr == 0) PG8_BAR;
    PG8_BAR;
    if constexpr (Epi::AFTER_DRAIN) { E.fused(acc, cur, wr, wc, fr, fq, lds, wid, lane); S.done(cur); }
    PG8_STAMP();
    if (STAMP && wid == 0) { stamps[lane] = lane < nts ? (((unsigned long long)(unsigned)ts_hi << 32) | (unsigned)ts_lo) : 0ull;
        if (lane == 62) stamps[62] = rt_entry; if (lane == 63) stamps[63] = (unsigned long long)wall_clock64(); }
#undef PG8_STAMP
#undef PG8_SA
#undef PG8_SB
#undef PG8_STAGE
#undef PG8_LDA
#undef PG8_LDB
#undef PG8_MMA
#undef PG8_WAIT_V
#undef PG8_WAIT_L
#undef PG8_BAR
#undef PG8_SCHED
}
}


#define LAS __attribute__((address_space(3)))
typedef unsigned short bf16_t;
typedef float f32x4 __attribute__((ext_vector_type(4)));
typedef unsigned u32x4 __attribute__((ext_vector_type(4)));
typedef unsigned u32x2 __attribute__((ext_vector_type(2)));

constexpr int MTOK = 16384, DM = 2048, SEQ = 8192, NHEAD = 16;
constexpr float ALPHA = 1.41421356237309515f;
constexpr size_t MiB = (size_t)1 << 20;
constexpr size_t WS_WIN = 0, WS_WOUT = 32 * MiB, WS_WKVQ = 40 * MiB, WS_WO = 64 * MiB, WS_WC = 72 * MiB, WS_UB = 88 * MiB, WS_VB = 152 * MiB, WS_USC = 216 * MiB, WS_VSC = 217 * MiB, WS_SLOT = 344 * MiB;
constexpr size_t WS_EID = 920 * MiB, WS_GATE = 928 * MiB, WS_COS = 936 * MiB, WS_SIN = 938 * MiB, WS_KMEAN = 940 * MiB, WS_LB = 941 * MiB, WS_LS = 942 * MiB, WS_SUB = 946 * MiB, WS_CNT = 962 * MiB, WS_CTR = 963 * MiB, WS_DEC = 964 * MiB, WS_END = 966 * MiB;
constexpr size_t WS_KNMAX = WS_KMEAN + 768 * 1024;
__host__ __device__ constexpr size_t slot(int i) { return WS_SLOT + (size_t)i * 64 * MiB; }
constexpr int LDS_BYTES = 144 * 1024;
constexpr int NPH = 20;

struct Args { const float* in[14]; float* out; unsigned char* ws; int ph_lo, ph_hi; };

__device__ __forceinline__ float bflo(unsigned w) { return __uint_as_float(w << 16); }
__device__ __forceinline__ float bfhi(unsigned w) { return __uint_as_float(w & 0xffff0000u); }
__device__ __forceinline__ float bf2f(bf16_t b) { return __uint_as_float(((unsigned)b) << 16); }
typedef __bf16 bf16x2_t __attribute__((ext_vector_type(2)));
typedef float f32x2_t __attribute__((ext_vector_type(2)));
__device__ __forceinline__ unsigned pk_bf16(float lo, float hi) { const f32x2_t f = {lo, hi}; return __builtin_bit_cast(unsigned, __builtin_convertvector(f, bf16x2_t)); }
__device__ __forceinline__ float wave_sum(float v) {
#pragma unroll
    for (int o = 32; o >= 1; o >>= 1) v += __shfl_xor(v, o);
    return v;
}
__device__ __forceinline__ float wave_max(float v) {
#pragma unroll
    for (int o = 32; o >= 1; o >>= 1) v = fmaxf(v, __shfl_xor(v, o));
    return v;
}
__device__ __forceinline__ float sigmoidf_(float z) { return 1.0f / (1.0f + __expf(-z)); }


__device__ __forceinline__ void store_wt16(void* p, u32x4 v) {
    __hip_atomic_store((unsigned long long*)p, ((unsigned long long)v.y << 32) | v.x, __ATOMIC_RELAXED, __HIP_MEMORY_SCOPE_AGENT);
    __hip_atomic_store((unsigned long long*)p + 1, ((unsigned long long)v.w << 32) | v.z, __ATOMIC_RELAXED, __HIP_MEMORY_SCOPE_AGENT);
}
__device__ __forceinline__ void store_wt8(void* p, u32x2 v) {
    __hip_atomic_store((unsigned long long*)p, ((unsigned long long)v.y << 32) | v.x, __ATOMIC_RELAXED, __HIP_MEMORY_SCOPE_AGENT);
}
struct EpiIn {
    static constexpr bool PERM = true, AFTER_DRAIN = false;
    bf16_t* Q1; float* LF; bf16_t* I1; bf16_t* G1; const float* LB;
    __device__ __forceinline__ void operator()(const pg8::f32x4 (&acc)[2][2][4][2], const pg8::Unit& u, int wr, int wc, int fr, int fq) const {
        const int type = u.pn >> 3;
        const int row0 = u.pm * 256 + wr * 64 + fr, col0 = (u.pn & 7) * 256 + wc * 32 + 8 * fq;
        if (type == 1) {
#pragma unroll
            for (int bj = 0; bj < 2; ++bj) {
                const int c = col0 + bj * 128;
                const f32x4 lb0 = *(const f32x4*)(LB + c), lb1 = *(const f32x4*)(LB + c + 4);
#pragma unroll
                for (int ai = 0; ai < 2; ++ai)
#pragma unroll
                    for (int m = 0; m < 4; ++m) {
                        float* p = LF + (size_t)(row0 + ai * 128 + m * 16) * DM + c;
                        f32x4 o0, o1;
#pragma unroll
                        for (int j = 0; j < 4; ++j) {
                            o0[j] = __logf(lb0[j] + (1.0f - lb0[j]) * sigmoidf_(acc[ai][bj][m][0][j]));
                            o1[j] = __logf(lb1[j] + (1.0f - lb1[j]) * sigmoidf_(acc[ai][bj][m][1][j]));
                        }
                        *(f32x4*)p = o0; *(f32x4*)(p + 4) = o1;
                    }
            }
        } else {
            bf16_t* dst = Q1 + (size_t)(type - (type > 0 ? 1 : 0)) * ((size_t)32 << 20);
            const bool act = (type != 2);
#pragma unroll
            for (int ai = 0; ai < 2; ++ai)
#pragma unroll
                for (int m = 0; m < 4; ++m)
#pragma unroll
                    for (int bj = 0; bj < 2; ++bj) {
                        f32x4 v0 = acc[ai][bj][m][0], v1 = acc[ai][bj][m][1];
                        if (act) {
#pragma unroll
                            for (int j = 0; j < 4; ++j) { v0[j] = v0[j] * sigmoidf_(v0[j]); v1[j] = v1[j] * sigmoidf_(v1[j]); }
                        }
                        u32x4 w; w.x = pk_bf16(v0[0], v0[1]); w.y = pk_bf16(v0[2], v0[3]); w.z = pk_bf16(v1[0], v1[1]); w.w = pk_bf16(v1[2], v1[3]);
                        *(u32x4*)(dst + (size_t)(row0 + ai * 128 + m * 16) * DM + col0 + bj * 128) = w;
                    }
        }
    }
};
struct EpiRes {
    static constexpr bool PERM = false, AFTER_DRAIN = false;
    const float* res; float* Y;
    __device__ __forceinline__ void operator()(const pg8::f32x4 (&acc)[2][2][4][2], const pg8::Unit& u, int wr, int wc, int fr, int fq) const {
        const int row0 = u.pm * 256 + wr * 64 + fr, col0 = u.pn * 256 + wc * 32 + 4 * fq;
#pragma unroll
        for (int ai = 0; ai < 2; ++ai)
#pragma unroll
            for (int m = 0; m < 4; ++m) {
                const size_t off = (size_t)(row0 + ai * 128 + m * 16) * DM + col0;
#pragma unroll
                for (int bj = 0; bj < 2; ++bj)
#pragma unroll
                    for (int n = 0; n < 2; ++n) {
                        const f32x4 r = *(const f32x4*)(res + off + bj * 128 + n * 16);
                        *(f32x4*)(Y + off + bj * 128 + n * 16) = r * ALPHA + acc[ai][bj][m][n];
                    }
            }
    }
};
struct EpiF32 {
    static constexpr bool PERM = false, AFTER_DRAIN = false;
    float* C;
    __device__ __forceinline__ void operator()(const pg8::f32x4 (&acc)[2][2][4][2], const pg8::Unit& u, int wr, int wc, int fr, int fq) const {
        const int row0 = u.pm * 256 + wr * 64 + fr, col0 = u.pn * 256 + wc * 32 + 4 * fq;
#pragma unroll
        for (int ai = 0; ai < 2; ++ai)
#pragma unroll
            for (int m = 0; m < 4; ++m) {
                float* p = C + (size_t)(row0 + ai * 128 + m * 16) * DM + col0;
#pragma unroll
                for (int bj = 0; bj < 2; ++bj)
#pragma unroll
                    for (int n = 0; n < 2; ++n) *(f32x4*)(p + bj * 128 + n * 16) = acc[ai][bj][m][n];
            }
    }
};
struct EpiKVQ {
    static constexpr bool PERM = true, AFTER_DRAIN = false;
    bf16_t* K; bf16_t* V; bf16_t* Q;
    __device__ __forceinline__ void operator()(const pg8::f32x4 (&acc)[2][2][4][2], const pg8::Unit& u, int wr, int wc, int fr, int fq) const {
        const int t = u.pn >> 3;
        bf16_t* dst = K + (size_t)t * ((size_t)32 << 20);
        const int row0 = u.pm * 256 + wr * 64 + fr, col0 = (u.pn & 7) * 256 + wc * 32 + 8 * fq;
#pragma unroll
        for (int ai = 0; ai < 2; ++ai)
#pragma unroll
            for (int m = 0; m < 4; ++m)
#pragma unroll
                for (int bj = 0; bj < 2; ++bj) {
                    const f32x4 v0 = acc[ai][bj][m][0], v1 = acc[ai][bj][m][1];
                    u32x4 w; w.x = pk_bf16(v0[0], v0[1]); w.y = pk_bf16(v0[2], v0[3]); w.z = pk_bf16(v1[0], v1[1]); w.w = pk_bf16(v1[2], v1[3]);
                    *(u32x4*)(dst + (size_t)(row0 + ai * 128 + m * 16) * DM + col0 + bj * 128) = w;
                }
    }
};

__device__ __forceinline__ void transpose_tiles(LAS float* tile, const float* src, int ldn, int K, int N, bf16_t* dst) {
    const int tid = threadIdx.x;
    const int tn = N / 64, ntiles = tn * (K / 64);
    for (int tI = blockIdx.x; tI < ntiles; tI += gridDim.x) {
        const int k0 = (tI / tn) * 64, n0 = (tI % tn) * 64;
#pragma unroll
        for (int r = 0; r < 2; ++r) {
            const int kk = (tid >> 4) + 32 * r, nn = (tid & 15) * 4;
            const f32x4 v = *(const f32x4*)(src + (size_t)(k0 + kk) * ldn + n0 + nn);
            tile[kk * 65 + nn + 0] = v[0]; tile[kk * 65 + nn + 1] = v[1]; tile[kk * 65 + nn + 2] = v[2]; tile[kk * 65 + nn + 3] = v[3];
        }
        __syncthreads();
        {
            const int nn = tid >> 3, kk8 = (tid & 7) * 8;
            float f[8];
#pragma unroll
            for (int j = 0; j < 8; ++j) f[j] = tile[(kk8 + j) * 65 + nn];
            u32x4 w; w.x = pk_bf16(f[0], f[1]); w.y = pk_bf16(f[2], f[3]); w.z = pk_bf16(f[4], f[5]); w.w = pk_bf16(f[6], f[7]);
            *(u32x4*)(dst + (size_t)(n0 + nn) * K + k0 + kk8) = w;
        }
        __syncthreads();
    }
}
__device__ __forceinline__ void convert_bf16(const float* src, bf16_t* dst, size_t n) {
    const size_t stride = (size_t)gridDim.x * 512 * 8;
    for (size_t i = ((size_t)blockIdx.x * 512 + threadIdx.x) * 8; i < n; i += stride) {
        const f32x4 a = *(const f32x4*)(src + i), b = *(const f32x4*)(src + i + 4);
        u32x4 w; w.x = pk_bf16(a[0], a[1]); w.y = pk_bf16(a[2], a[3]); w.z = pk_bf16(b[0], b[1]); w.w = pk_bf16(b[2], b[3]);
        *(u32x4*)(dst + i) = w;
    }
}
__device__ __forceinline__ void fold_peer_keys(LAS float* lds, const float* w_query, const float* sub_keys, bf16_t* WcT) {
    const int tid = threadIdx.x;
    LAS float* Ss = lds;
    LAS float* Ws = lds + 128 * 132;
    for (int item = blockIdx.x; item < 1024; item += gridDim.x) {
        const int l = item >> 9, rem = item & 511, hh = rem >> 5, kb = rem & 31, h = hh >> 1, half = hh & 1;
        const float* sk = sub_keys + (size_t)(((l * 2 + half) * 8 + h) * 128) * 128;
        const float* wq = w_query + (size_t)l * DM * DM + (size_t)(kb * 64) * DM + h * 256 + half * 128;
#pragma unroll
        for (int r = 0; r < 8; ++r) { const int idx = tid + 512 * r, key = idx >> 5, d4 = (idx & 31) * 4; *(LAS f32x4*)(Ss + key * 132 + d4) = *(const f32x4*)(sk + key * 128 + d4); }
#pragma unroll
        for (int r = 0; r < 4; ++r) { const int idx = tid + 512 * r, kin = idx >> 5, d4 = (idx & 31) * 4; *(LAS f32x4*)(Ws + kin * 128 + d4) = *(const f32x4*)(wq + (size_t)kin * DM + d4); }
        __syncthreads();
        const int key = tid & 127, kq = tid >> 7;
        float acc[16];
#pragma unroll
        for (int j = 0; j < 16; ++j) acc[j] = 0.f;
        for (int d4 = 0; d4 < 32; ++d4) {
            const f32x4 s4 = *(const LAS f32x4*)(Ss + key * 132 + d4 * 4);
#pragma unroll
            for (int j = 0; j < 16; ++j) { const f32x4 w4 = *(const LAS f32x4*)(Ws + (kq * 16 + j) * 128 + d4 * 4); acc[j] += s4[0] * w4[0] + s4[1] * w4[1] + s4[2] * w4[2] + s4[3] * w4[3]; }
        }
        bf16_t* o = WcT + (size_t)l * DM * DM + (size_t)(h * 256 + half * 128 + key) * DM + kb * 64 + kq * 16;
        u32x4 w0, w1;
        w0.x = pk_bf16(acc[0], acc[1]); w0.y = pk_bf16(acc[2], acc[3]); w0.z = pk_bf16(acc[4], acc[5]); w0.w = pk_bf16(acc[6], acc[7]);
        w1.x = pk_bf16(acc[8], acc[9]); w1.y = pk_bf16(acc[10], acc[11]); w1.z = pk_bf16(acc[12], acc[13]); w1.w = pk_bf16(acc[14], acc[15]);
        *(u32x4*)o = w0; *(u32x4*)(o + 8) = w1;
        __syncthreads();
    }
}

__device__ __forceinline__ void quant_rows(const float* src, unsigned char* dst, float* scl, int nrows) {
    const int lane = threadIdx.x & 63, gw = blockIdx.x * 8 + (threadIdx.x >> 6), nw = gridDim.x * 8;
    for (int row = gw; row < nrows; row += nw) {
        const float* p = src + (size_t)row * DM;
        f32x4 v[8];
#pragma unroll
        for (int i = 0; i < 2; ++i)
#pragma unroll
            for (int q = 0; q < 4; ++q) v[i * 4 + q] = *(const f32x4*)(p + 1024 * i + 16 * lane + 4 * q);
        float am = 0.f;
#pragma unroll
        for (int i = 0; i < 8; ++i) am = fmaxf(am, fmaxf(fmaxf(fabsf(v[i][0]), fabsf(v[i][1])), fmaxf(fabsf(v[i][2]), fabsf(v[i][3]))));
        am = fmaxf(wave_max(am), 1e-30f);
        const float inv = 127.0f / am;
        if (lane == 0) scl[row] = am * (1.0f / 127.0f);
#pragma unroll
        for (int i = 0; i < 2; ++i) {
            u32x4 w;
#pragma unroll
            for (int q = 0; q < 4; ++q) {
                const f32x4 t = v[i * 4 + q];
                const unsigned b0 = (unsigned)(int)(rintf(t[0] * inv) + 128.0f), b1 = (unsigned)(int)(rintf(t[1] * inv) + 128.0f), b2 = (unsigned)(int)(rintf(t[2] * inv) + 128.0f), b3 = (unsigned)(int)(rintf(t[3] * inv) + 128.0f);
                w[q] = b0 | (b1 << 8) | (b2 << 16) | (b3 << 24);
            }
            *(u32x4*)(dst + (size_t)row * DM + 1024 * i + 16 * lane) = w;
        }
    }
}
__device__ __forceinline__ void phase_prep(const Args& a, LAS unsigned char* lds) {
    unsigned char* ws = a.ws;
    LAS float* tile = (LAS float*)lds;
    transpose_tiles(tile, a.in[1], 4 * DM, DM, 4 * DM, (bf16_t*)(ws + WS_WIN));
    transpose_tiles(tile, a.in[3], DM, DM, DM, (bf16_t*)(ws + WS_WOUT));
    transpose_tiles(tile, a.in[5], 2 * DM, DM, 2 * DM, (bf16_t*)(ws + WS_WKVQ));
    transpose_tiles(tile, a.in[6], DM, DM, DM, (bf16_t*)(ws + WS_WKVQ) + (size_t)2 * DM * DM);
    transpose_tiles(tile, a.in[7], DM, DM, DM, (bf16_t*)(ws + WS_WO));
    fold_peer_keys((LAS float*)lds, a.in[8], a.in[9], (bf16_t*)(ws + WS_WC));
    convert_bf16(a.in[0], (bf16_t*)(ws + slot(0)), (size_t)MTOK * DM);
    quant_rows(a.in[10], ws + WS_UB, (float*)(ws + WS_USC), 2 * 16384);
    quant_rows(a.in[11], ws + WS_VB, (float*)(ws + WS_VSC), 2 * 16384);
    const int gtid = blockIdx.x * 512 + threadIdx.x, gthreads = gridDim.x * 512;
    float* COS = (float*)(ws + WS_COS); float* SIN = (float*)(ws + WS_SIN); float* LB = (float*)(ws + WS_LB);
    for (int i = gtid; i < SEQ * 64; i += gthreads) {
        const int pos = i >> 6, j = i & 63;
        double inv = 1.0; const double r = 0.86596432336006535;
        for (int q = 0; q < j; ++q) inv *= r;
        const float ang = (float)pos * (float)inv;
        const double x = (double)ang;
        const double n = __builtin_rint(x * 0.15915494309189535);
        const float rf = (float)__builtin_fma(-n, 6.283185307179586, x);
        COS[i] = cosf(rf); SIN[i] = sinf(rf);
    }
    for (int c = gtid; c < DM; c += gthreads) { const float l0 = a.in[4][c], l1 = a.in[4][DM + c]; LB[c] = 1.0f / (1.0f + expf(l1 - l0)); }
}

__device__ __forceinline__ void phase_scan_naive(const bf16_t* Q1, const float* LF, const bf16_t* I1, float* O) {
    const int lane = threadIdx.x & 63, gw = blockIdx.x * 8 + (threadIdx.x >> 6), nw = gridDim.x * 8;
    for (int item = gw; item < 2 * NHEAD * 128; item += nw) {
        const int bh = item >> 7, v = item & 127, b = bh >> 4, h = bh & 15;
        const size_t base = (size_t)b * SEQ * DM + h * 128;
        float S0 = 0.f, S1 = 0.f;
#pragma unroll 4
        for (int t = 0; t < SEQ; ++t) {
            const size_t ro = base + (size_t)t * DM;
            const float f0 = __expf(LF[ro + lane]), f1 = __expf(LF[ro + 64 + lane]);
            const float q0 = bf2f(Q1[ro + lane]), q1 = bf2f(Q1[ro + 64 + lane]);
            const float iv = bf2f(I1[ro + v]);
            S0 = f0 * S0 + (1.0f - f0) * iv; S1 = f1 * S1 + (1.0f - f1) * iv;
            const float p = wave_sum(q0 * S0 + q1 * S1);
            if (lane == 0) O[ro + v] = p;
        }
    }
}
__device__ __forceinline__ void phase_onorm(const float* O, const bf16_t* G1, const float* gnorm, bf16_t* OG) {
    const int lane = threadIdx.x & 63, gw = blockIdx.x * 8 + (threadIdx.x >> 6), nw = gridDim.x * 8;
    const float gn0 = gnorm[2 * lane], gn1 = gnorm[2 * lane + 1];
    for (int item = gw; item < MTOK * NHEAD; item += nw) {
        const size_t off = (size_t)item * 128 + 2 * lane;
        const float o0 = O[off], o1 = O[off + 1];
        const float ss = wave_sum(o0 * o0 + o1 * o1);
        const float r = rsqrtf(ss * (1.0f / 128.0f) + 1e-6f);
        const unsigned g = *(const unsigned*)(G1 + off);
        *(unsigned*)(OG + off) = pk_bf16(o0 * r * gn0 * bflo(g), o1 * r * gn1 * bfhi(g));
    }
}

__device__ __forceinline__ void ln_row_store(float (&v)[32], const float* g, const float* bta, float* outf, bf16_t* outb, int lane) {
    float s = 0.f;
#pragma unroll
    for (int i = 0; i < 32; ++i) s += v[i];
    const float mu = wave_sum(s) * (1.0f / DM);
    float q = 0.f;
#pragma unroll
    for (int i = 0; i < 32; ++i) { v[i] -= mu; q += v[i] * v[i]; }
    const float rstd = rsqrtf(wave_sum(q) * (1.0f / DM) + 1e-5f);
#pragma unroll
    for (int i = 0; i < 4; ++i) {
        const int c = 512 * i + 8 * lane;
        const f32x4 g0 = *(const f32x4*)(g + c), g1 = *(const f32x4*)(g + c + 4), b0 = *(const f32x4*)(bta + c), b1 = *(const f32x4*)(bta + c + 4);
        f32x4 o0, o1;
#pragma unroll
        for (int j = 0; j < 4; ++j) { o0[j] = v[i * 8 + j] * rstd * g0[j] + b0[j]; o1[j] = v[i * 8 + 4 + j] * rstd * g1[j] + b1[j]; }
        *(f32x4*)(outf + c) = o0; *(f32x4*)(outf + c + 4) = o1;
        if (outb) { u32x4 w; w.x = pk_bf16(o0[0], o0[1]); w.y = pk_bf16(o0[2], o0[3]); w.z = pk_bf16(o1[0], o1[1]); w.w = pk_bf16(o1[2], o1[3]); *(u32x4*)(outb + c) = w; }
    }
}
__device__ __forceinline__ void ln_row_store16(float (&v)[32], const float* g, const float* bta, float* outf, bf16_t* outb, int lane) {
    float s = 0.f;
#pragma unroll
    for (int i = 0; i < 32; ++i) s += v[i];
    const float mu = wave_sum(s) * (1.0f / DM);
    float q = 0.f;
#pragma unroll
    for (int i = 0; i < 32; ++i) { v[i] -= mu; q += v[i] * v[i]; }
    const float rstd = rsqrtf(wave_sum(q) * (1.0f / DM) + 1e-5f);
#pragma unroll
    for (int i = 0; i < 2; ++i) {
        const int c = 1024 * i + 16 * lane;
        f32x4 o[4];
#pragma unroll
        for (int qd = 0; qd < 4; ++qd) {
            const f32x4 gg = *(const f32x4*)(g + c + 4 * qd), bb = *(const f32x4*)(bta + c + 4 * qd);
#pragma unroll
            for (int j = 0; j < 4; ++j) o[qd][j] = v[16 * i + 4 * qd + j] * rstd * gg[j] + bb[j];
            *(f32x4*)(outf + c + 4 * qd) = o[qd];
        }
        if (outb) {
            u32x4 w0, w1;
            w0.x = pk_bf16(o[0][0], o[0][1]); w0.y = pk_bf16(o[0][2], o[0][3]); w0.z = pk_bf16(o[1][0], o[1][1]); w0.w = pk_bf16(o[1][2], o[1][3]);
            w1.x = pk_bf16(o[2][0], o[2][1]); w1.y = pk_bf16(o[2][2], o[2][3]); w1.z = pk_bf16(o[3][0], o[3][1]); w1.w = pk_bf16(o[3][2], o[3][3]);
            *(u32x4*)(outb + c) = w0; *(u32x4*)(outb + c + 8) = w1;
        }
    }
}
__device__ __forceinline__ void phase_ln(const float* Y, const float* g, const float* bta, float* outf, bf16_t* outb) {
    const int lane = threadIdx.x & 63, gw = blockIdx.x * 8 + (threadIdx.x >> 6), nw = gridDim.x * 8;
    for (int row = gw; row < MTOK; row += nw) {
        float v[32];
        const float* p = Y + (size_t)row * DM;
#pragma unroll
        for (int i = 0; i < 4; ++i) {
            const f32x4 a = *(const f32x4*)(p + 512 * i + 8 * lane), b = *(const f32x4*)(p + 512 * i + 8 * lane + 4);
#pragma unroll
            for (int j = 0; j < 4; ++j) { v[i * 8 + j] = a[j]; v[i * 8 + 4 + j] = b[j]; }
        }
        ln_row_store(v, g, bta, outf + (size_t)row * DM, outb ? outb + (size_t)row * DM : nullptr, lane);
    }
}

__device__ __forceinline__ void wave_argmax(float& v, int& idx) {
#pragma unroll
    for (int o = 32; o >= 1; o >>= 1) {
        const float ov = __shfl_xor(v, o); const int oi = __shfl_xor(idx, o);
        if (ov > v || (ov == v && oi < idx)) { v = ov; idx = oi; }
    }
}
__device__ __forceinline__ unsigned fkey(float x) { const unsigned u = __float_as_uint(x); return u ^ (unsigned)(((int)u >> 31) | 0x80000000); }
__device__ __forceinline__ void phase_topk(LAS unsigned char* lds, const float* SC, int* EID, float* GATE) {
    const int lane = threadIdx.x & 63, wv = threadIdx.x >> 6, gw = blockIdx.x * 8 + wv, nw = gridDim.x * 8;
    LAS float* sv = (LAS float*)(lds + wv * 512);
    LAS int* si = (LAS int*)(lds + wv * 512 + 256);
    for (int item = gw; item < MTOK * 8; item += nw) {
        const float* p = SC + (size_t)item * 256;
        float val[4]; val[0] = p[lane]; val[1] = p[64 + lane]; val[2] = p[128 + lane]; val[3] = p[192 + lane];
        unsigned key[4];
#pragma unroll
        for (int j = 0; j < 4; ++j) key[j] = fkey(val[j]);
#pragma unroll
        for (int half = 0; half < 2; ++half) {
            const unsigned k0 = key[2 * half], k1 = key[2 * half + 1];
            unsigned T = 0;
#pragma unroll
            for (int bit = 31; bit >= 0; --bit) {
                const unsigned cand = T | (1u << bit);
                const int cnt = __popcll(__ballot(k0 >= cand)) + __popcll(__ballot(k1 >= cand));
                if (cnt >= 16) T = cand;
            }
            const unsigned long long g0 = __ballot(k0 > T), g1 = __ballot(k1 > T), e0 = __ballot(k0 == T), e1 = __ballot(k1 == T);
            const int ngt = __popcll(g0) + __popcll(g1), need = 16 - ngt;
            const unsigned long long below = (1ull << lane) - 1ull;
            const int er0 = __popcll(e0 & below), er1 = __popcll(e0) + __popcll(e1 & below);
            const bool s0 = (k0 > T) || (k0 == T && er0 < need), s1 = (k1 > T) || (k1 == T && er1 < need);
            const unsigned long long b0 = __ballot(s0), b1 = __ballot(s1);
            const int r0 = __popcll(b0 & below), r1 = __popcll(b0) + __popcll(b1 & below);
            if (s0) { sv[half * 16 + r0] = val[2 * half]; si[half * 16 + r0] = lane; }
            if (s1) { sv[half * 16 + r1] = val[2 * half + 1]; si[half * 16 + r1] = lane + 64; }
        }
        asm volatile("s_waitcnt lgkmcnt(0)" ::: "memory");
        const float vb = sv[16 + (lane & 15)];
        float cv[4]; unsigned ck[4];
#pragma unroll
        for (int j = 0; j < 4; ++j) { cv[j] = sv[(lane >> 4) + 4 * j] + vb; ck[j] = fkey(cv[j]); }
        unsigned T = 0;
#pragma unroll
        for (int bit = 31; bit >= 0; --bit) {
            const unsigned cand = T | (1u << bit);
            const int cnt = __popcll(__ballot(ck[0] >= cand)) + __popcll(__ballot(ck[1] >= cand)) + __popcll(__ballot(ck[2] >= cand)) + __popcll(__ballot(ck[3] >= cand));
            if (cnt >= 16) T = cand;
        }
        const unsigned long long below = (1ull << lane) - 1ull;
        int ngt = 0;
#pragma unroll
        for (int j = 0; j < 4; ++j) ngt += __popcll(__ballot(ck[j] > T));
        const int need = 16 - ngt;
        int ebase = 0, rbase = 0;
        float bestv = -__builtin_inff(); int bestf = 0; bool have = false;
#pragma unroll
        for (int j = 0; j < 4; ++j) {
            const unsigned long long ej = __ballot(ck[j] == T);
            const int er = ebase + __popcll(ej & below);
            const bool sj = (ck[j] > T) || (ck[j] == T && er < need);
            const unsigned long long bj = __ballot(sj);
            const int rj = rbase + __popcll(bj & below);
            if (sj) { sv[32 + rj] = cv[j]; si[32 + rj] = lane + 64 * j; }
            ebase += __popcll(ej); rbase += __popcll(bj);
        }
        (void)bestv; (void)bestf; (void)have;
        asm volatile("s_waitcnt lgkmcnt(0)" ::: "memory");
        const float best = lane < 16 ? sv[32 + (lane & 15)] : -__builtin_inff();
        const int flat = si[32 + (lane & 15)];
        const float m = wave_max(best);
        const float e = lane < 16 ? __expf(best - m) : 0.f;
        const float sum = wave_sum(e);
        const int ea = si[flat >> 4], eb = si[16 + (flat & 15)];
        if (lane < 16) { EID[(size_t)item * 16 + lane] = ea * 128 + eb; GATE[(size_t)item * 16 + lane] = e / sum; }
        asm volatile("s_waitcnt lgkmcnt(0)" ::: "memory");
    }
}

__device__ __forceinline__ float gelu_erf(float x) { return 0.5f * x * (1.0f + erff(x * 0.70710678118654752f)); }
__device__ __forceinline__ float ub0(unsigned w) { return (float)(w & 0xffu); }
__device__ __forceinline__ float ub1(unsigned w) { return (float)((w >> 8) & 0xffu); }
__device__ __forceinline__ float ub2(unsigned w) { return (float)((w >> 16) & 0xffu); }
__device__ __forceinline__ float ub3(unsigned w) { return (float)(w >> 24); }
__device__ __forceinline__ void phase_peer(LAS unsigned char* lds, const float* X, const int* EID, const float* GATE, const unsigned char* U, const unsigned char* V, const float* USC, const float* VSC,
                                           const float* g, const float* bta, float* outf, bf16_t* outb) {
    const int lane = threadIdx.x & 63, wv = threadIdx.x >> 6, gw = blockIdx.x * 8 + wv, nw = gridDim.x * 8;
    LAS float* hb = (LAS float*)(lds + wv * 512);
    for (int tok = gw; tok < MTOK; tok += nw) {
        float x[32];
        const float* xp = X + (size_t)tok * DM;
#pragma unroll
        for (int i = 0; i < 2; ++i)
#pragma unroll
            for (int q = 0; q < 4; ++q) { const f32x4 t = *(const f32x4*)(xp + 1024 * i + 16 * lane + 4 * q); x[16 * i + 4 * q] = t[0]; x[16 * i + 4 * q + 1] = t[1]; x[16 * i + 4 * q + 2] = t[2]; x[16 * i + 4 * q + 3] = t[3]; }
        float sx = 0.f;
#pragma unroll
        for (int j = 0; j < 32; ++j) sx += x[j];
        const float d0 = -128.0f * sx;
        const int e0 = EID[(size_t)tok * 128 + lane], e1 = EID[(size_t)tok * 128 + 64 + lane];
        const float g0 = GATE[(size_t)tok * 128 + lane], g1 = GATE[(size_t)tok * 128 + 64 + lane];
        for (int bt = 0; bt < 16; ++bt) {
            float d[8];
#pragma unroll
            for (int r = 0; r < 8; ++r) {
                const int e = bt * 8 + r;
                const int idx = __builtin_amdgcn_readfirstlane(__shfl(bt < 8 ? e0 : e1, e & 63));
                const u32x4* up = (const u32x4*)(U + (size_t)idx * DM) + lane;
                float acc = d0;
#pragma unroll
                for (int i = 0; i < 2; ++i) {
                    const u32x4 w = up[i * 64];
                    acc += x[16 * i + 0] * ub0(w.x) + x[16 * i + 1] * ub1(w.x) + x[16 * i + 2] * ub2(w.x) + x[16 * i + 3] * ub3(w.x)
                         + x[16 * i + 4] * ub0(w.y) + x[16 * i + 5] * ub1(w.y) + x[16 * i + 6] * ub2(w.y) + x[16 * i + 7] * ub3(w.y)
                         + x[16 * i + 8] * ub0(w.z) + x[16 * i + 9] * ub1(w.z) + x[16 * i + 10] * ub2(w.z) + x[16 * i + 11] * ub3(w.z)
                         + x[16 * i + 12] * ub0(w.w) + x[16 * i + 13] * ub1(w.w) + x[16 * i + 14] * ub2(w.w) + x[16 * i + 15] * ub3(w.w);
                }
                d[r] = acc;
            }
            const bool b5 = lane & 32, b4 = lane & 16, b3 = lane & 8;
            float t4[4];
#pragma unroll
            for (int q = 0; q < 4; ++q) { const float keep = b5 ? d[4 + q] : d[q], send = b5 ? d[q] : d[4 + q]; t4[q] = keep + __shfl_xor(send, 32); }
            float t2[2];
#pragma unroll
            for (int q = 0; q < 2; ++q) { const float keep = b4 ? t4[2 + q] : t4[q], send = b4 ? t4[q] : t4[2 + q]; t2[q] = keep + __shfl_xor(send, 16); }
            float t1;
            { const float keep = b3 ? t2[1] : t2[0], send = b3 ? t2[0] : t2[1]; t1 = keep + __shfl_xor(send, 8); }
            t1 += __shfl_xor(t1, 4); t1 += __shfl_xor(t1, 2); t1 += __shfl_xor(t1, 1);
            if ((lane & 7) == 0) hb[bt * 8 + (lane >> 3 & 1) + 2 * (lane >> 4 & 1) + 4 * (lane >> 5 & 1)] = t1;
        }
        asm volatile("s_waitcnt lgkmcnt(0)" ::: "memory");
        const float h0 = hb[lane] * USC[e0], h1 = hb[64 + lane] * USC[e1];
        const float w0 = g0 * gelu_erf(h0) * VSC[e0], w1 = g1 * gelu_erf(h1) * VSC[e1];
        float wsum = wave_sum(w0 + w1);
        float y[32];
#pragma unroll
        for (int i = 0; i < 32; ++i) y[i] = 0.f;
#pragma unroll 8
        for (int e = 0; e < 128; ++e) {
            const int idx = __builtin_amdgcn_readfirstlane(__shfl(e < 64 ? e0 : e1, e & 63));
            const float wt = __shfl(e < 64 ? w0 : w1, e & 63);
            const u32x4* vp = (const u32x4*)(V + (size_t)idx * DM) + lane;
#pragma unroll
            for (int i = 0; i < 2; ++i) {
                const u32x4 w = vp[i * 64];
                y[16 * i + 0] += wt * ub0(w.x); y[16 * i + 1] += wt * ub1(w.x); y[16 * i + 2] += wt * ub2(w.x); y[16 * i + 3] += wt * ub3(w.x);
                y[16 * i + 4] += wt * ub0(w.y); y[16 * i + 5] += wt * ub1(w.y); y[16 * i + 6] += wt * ub2(w.y); y[16 * i + 7] += wt * ub3(w.y);
                y[16 * i + 8] += wt * ub0(w.z); y[16 * i + 9] += wt * ub1(w.z); y[16 * i + 10] += wt * ub2(w.z); y[16 * i + 11] += wt * ub3(w.z);
                y[16 * i + 12] += wt * ub0(w.w); y[16 * i + 13] += wt * ub1(w.w); y[16 * i + 14] += wt * ub2(w.w); y[16 * i + 15] += wt * ub3(w.w);
            }
        }
        const float corr = -128.0f * wsum;
#pragma unroll
        for (int i = 0; i < 32; ++i) y[i] = y[i] + corr + ALPHA * x[i];
        ln_row_store16(y, g, bta, outf + (size_t)tok * DM, outb ? outb + (size_t)tok * DM : nullptr, lane);
        asm volatile("s_waitcnt lgkmcnt(0)" ::: "memory");
    }
}

__device__ __forceinline__ void phase_rot(LAS float* red, bf16_t* KR, bf16_t* QR, const float* COS, const float* SIN, float* KMEAN, float* KNMAX) {
    const int tid = threadIdx.x, d = tid & 63, rg = tid >> 6;
    for (int item = blockIdx.x; item < 2 * NHEAD * 32; item += gridDim.x) {
        const int bh = item >> 5, j = item & 31, b = bh >> 4, h = bh & 15;
        float s1 = 0.f, s2 = 0.f, nmax = 0.f;
        for (int i = 0; i < 32; ++i) {
            const int pos = j * 256 + rg * 32 + i;
            const size_t off = ((size_t)b * SEQ + pos) * DM + h * 128 + d;
            const float c = COS[pos * 64 + d], s = SIN[pos * 64 + d];
            const float k1 = bf2f(KR[off]), k2 = bf2f(KR[off + 64]);
            const float o1 = k1 * c - k2 * s, o2 = k1 * s + k2 * c;
            s1 += o1; s2 += o2;
            nmax = fmaxf(nmax, wave_sum(o1 * o1 + o2 * o2));
            KR[off] = (bf16_t)(pk_bf16(o1, 0.f) & 0xffffu); KR[off + 64] = (bf16_t)(pk_bf16(o2, 0.f) & 0xffffu);
            const float q1 = bf2f(QR[off]), q2 = bf2f(QR[off + 64]);
            QR[off] = (bf16_t)(pk_bf16(q1 * c - q2 * s, 0.f) & 0xffffu); QR[off + 64] = (bf16_t)(pk_bf16(q1 * s + q2 * c, 0.f) & 0xffffu);
        }
        red[rg * 128 + d] = s1; red[rg * 128 + 64 + d] = s2;
        if (d == 0) red[1024 + rg] = nmax;
        __syncthreads();
        if (tid < 128) {
            float s = 0.f;
#pragma unroll
            for (int r = 0; r < 8; ++r) s += red[r * 128 + tid];
            KMEAN[(size_t)item * 128 + tid] = s * (1.0f / 256.0f);
        }
        if (tid == 0) {
            float m = 0.f;
#pragma unroll
            for (int r = 0; r < 8; ++r) m = fmaxf(m, red[1024 + r]);
            KNMAX[item] = sqrtf(m);
        }
        __syncthreads();
    }
}

__device__ __forceinline__ void phase_sel(LAS unsigned char* lds, const bf16_t* QR, const float* KMEAN, unsigned short* SUB, int* CNT, int* ctr) {
    const int tid = threadIdx.x, lane = tid & 63, wv = tid >> 6;
    LAS float* km = (LAS float*)lds;
    LAS float* qs = (LAS float*)(lds + 16896) + wv * 128;
    LAS unsigned short* bucket = (LAS unsigned short*)(lds + 20992);
    LAS int* cnt = (LAS int*)(lds + 37376);
    const float NEG = -1e30f;
    if (blockIdx.x == 0 && tid == 0) *ctr = 0;
    for (int item = blockIdx.x; item < 2 * NHEAD * 32; item += gridDim.x) {
        const int bh = item >> 5, i = item & 31, b = bh >> 4, h = bh & 15;
        if (i == 0) continue;
        if (tid < 32) cnt[tid] = 0;
#pragma unroll
        for (int r = 0; r < 2; ++r) { const int idx = tid + 512 * r, n = idx >> 5, d4 = (idx & 31) * 4; *(LAS f32x4*)(km + n * 132 + d4) = *(const f32x4*)(KMEAN + ((size_t)bh * 32 + n) * 128 + d4); }
        __syncthreads();
        for (int qq = 0; qq < 32; ++qq) {
            const int tl = wv * 32 + qq;
            const size_t tok = (size_t)b * SEQ + i * 256 + tl;
            { const unsigned q2 = *(const unsigned*)(QR + tok * DM + h * 128 + 2 * lane); qs[2 * lane] = bflo(q2); qs[2 * lane + 1] = bfhi(q2); }
            asm volatile("s_waitcnt lgkmcnt(0)" ::: "memory");
            float gsc = NEG;
            if (lane < i) {
                float sacc = 0.f;
#pragma unroll 8
                for (int d4 = 0; d4 < 32; ++d4) { const f32x4 kv = *(const LAS f32x4*)(km + lane * 132 + d4 * 4); const f32x4 qv = *(const LAS f32x4*)(qs + d4 * 4); sacc += kv[0] * qv[0] + kv[1] * qv[1] + kv[2] * qv[2] + kv[3] * qv[3]; }
                gsc = sacc;
            }
#pragma unroll
            for (int r = 0; r < 3; ++r) {
                float v = gsc; int id = lane;
                wave_argmax(v, id);
                if (v > 0.5f * NEG && lane == 0) { const int p = __hip_atomic_fetch_add(cnt + id, 1, __ATOMIC_RELAXED, __HIP_MEMORY_SCOPE_WORKGROUP); bucket[id * 256 + p] = (unsigned short)(tl | (r << 8)); }
                if (lane == id) gsc = -3e38f;
            }
            asm volatile("s_waitcnt lgkmcnt(0)" ::: "memory");
        }
        __syncthreads();
        for (int idx = tid; idx < 32 * 256; idx += 512) {
            const int j = idx >> 8, p = idx & 255;
            if (j < i && p < cnt[j]) SUB[(((size_t)bh * 32 + j) * 32 + i) * 256 + p] = bucket[idx];
        }
        if (tid < i) CNT[((size_t)bh * 32 + tid) * 32 + i] = cnt[tid];
        __syncthreads();
    }
}

typedef short bf16x8 __attribute__((ext_vector_type(8)));
typedef short s16x4 __attribute__((ext_vector_type(4)));
typedef float f32x16 __attribute__((ext_vector_type(16)));
__device__ __forceinline__ unsigned off_b(unsigned row, unsigned ch) { return 256u * row + 16u * (ch ^ (((row & 3u) << 2) | ((row >> 2) & 3u))); }
__device__ __forceinline__ unsigned pi32(unsigned m) { return (m & ~12u) | ((m & 4u) << 1) | ((m & 8u) >> 1); }
__device__ __forceinline__ bf16x8 tr_frag(LAS unsigned char* img, unsigned lane, unsigned c, unsigned ks) {
    const unsigned hh = lane >> 5, blk = (lane >> 4) & 1, q = (lane & 15) >> 2, p = lane & 3;
    const unsigned a0 = off_b(16 * ks + 8 * hh + q, 4 * c + 2 * blk + (p >> 1)) + 8 * (p & 1);
    const unsigned a1 = off_b(16 * ks + 8 * hh + 4 + q, 4 * c + 2 * blk + (p >> 1)) + 8 * (p & 1);
    const s16x4 lo = __builtin_amdgcn_ds_read_tr16_b64_v4i16((LAS s16x4*)(img + a0));
    const s16x4 hi = __builtin_amdgcn_ds_read_tr16_b64_v4i16((LAS s16x4*)(img + a1));
    bf16x8 r; r[0] = lo[0]; r[1] = lo[1]; r[2] = lo[2]; r[3] = lo[3]; r[4] = hi[0]; r[5] = hi[1]; r[6] = hi[2]; r[7] = hi[3];
    return r;
}
__device__ __forceinline__ void phase_att(LAS unsigned char* lds, const bf16_t* QR, const bf16_t* KR, const bf16_t* V, const float* KNMAX, const unsigned short* SUB, const int* CNT, int* ctr,
                                          bf16_t* P012, bf16_t* P3, float* LS) {
    const int tid = threadIdx.x, lane = tid & 63, wv = tid >> 6, r32 = lane & 31, hh = lane >> 5;
    LAS unsigned char* Kimg = lds;
    LAS unsigned char* Vimg = lds + 65536;
    LAS int* misc = (LAS int*)(lds + 131072);
    const float SCL2 = 0.08838834764831845f * 1.4426950408889634f;
    for (;;) {
        __syncthreads();
        if (tid == 0) misc[40] = __hip_atomic_fetch_add(ctr, 1, __ATOMIC_RELAXED, __HIP_MEMORY_SCOPE_AGENT);
        __syncthreads();
        const int item = misc[40];
        if (item >= 2 * NHEAD * 32) break;
        const int j = item >> 5, bh = item & 31, b = bh >> 4, h = bh & 15;
#pragma unroll
        for (int r = 0; r < 8; ++r) {
            const int idx = tid + 512 * r, row = idx >> 4, ch = idx & 15;
            const size_t g = ((size_t)b * SEQ + j * 256 + row) * DM + h * 128 + ch * 8;
            const u32x4 kv = *(const u32x4*)(KR + g), vv = *(const u32x4*)(V + g);
            *(LAS u32x4*)(Kimg + off_b(row, ch)) = kv; *(LAS u32x4*)(Vimg + off_b(row, ch)) = vv;
        }
        if (tid <= 32) { int pre = 0; for (int u = j + 1; u < tid; ++u) pre += CNT[((size_t)bh * 32 + j) * 32 + u]; misc[tid] = pre; }
        float kn = (lane < 32) ? KNMAX[bh * 32 + lane] : 0.f;
        kn = wave_max(kn);
        __syncthreads();
        const int total = misc[32], ntile = (256 + total + 31) >> 5;
        for (int tile = wv; tile < ntile; tile += 8) {
            const int gr = tile * 32 + r32;
            int pos, slot; bool valid = true;
            if (gr < 256) { pos = j * 256 + gr; slot = 3; }
            else {
                const int x = gr - 256; valid = x < total;
                int ii = j + 1;
                for (int u = j + 1; u < 32; ++u) if (misc[u] <= x) ii = u;
                if (valid) { const unsigned e = SUB[(((size_t)bh * 32 + j) * 32 + ii) * 256 + (x - misc[ii])]; pos = ii * 256 + (int)(e & 255u); slot = (int)(e >> 8); }
                else { pos = j * 256; slot = 3; }
            }
            const size_t tok = (size_t)b * SEQ + pos;
            bf16x8 qf[8];
            const bf16_t* qp = QR + tok * DM + h * 128 + 8 * hh;
#pragma unroll
            for (int s = 0; s < 8; ++s) qf[s] = *(const bf16x8*)(qp + 16 * s);
            float qn2 = 0.f;
#pragma unroll
            for (int s = 0; s < 8; ++s)
#pragma unroll
                for (int e = 0; e < 8; ++e) { const float f = bf2f((bf16_t)qf[s][e]); qn2 += f * f; }
            qn2 += __shfl_xor(qn2, 32);
            const float c2 = sqrtf(qn2) * kn * SCL2;
            f32x16 O[4];
#pragma unroll
            for (int dt = 0; dt < 4; ++dt)
#pragma unroll
                for (int e = 0; e < 16; ++e) O[dt][e] = 0.f;
            float l = 0.f;
            const bool own = tile < 8;
            const int kcn = own ? tile + 1 : 8;
            const unsigned krow = pi32((unsigned)r32);
            for (int kc = 0; kc < kcn; ++kc) {
                f32x16 S;
#pragma unroll
                for (int e = 0; e < 16; ++e) S[e] = 0.f;
#pragma unroll
                for (int s = 0; s < 8; ++s) {
                    const bf16x8 kf = *(const LAS bf16x8*)(Kimg + off_b(32 * kc + krow, 2 * s + hh));
                    S = __builtin_amdgcn_mfma_f32_32x32x16_bf16(kf, qf[s], S, 0, 0, 0);
                }
                float p[16];
#pragma unroll
                for (int e = 0; e < 16; ++e) {
                    const unsigned m = (e & 3) + 8 * (e >> 2) + 4 * hh;
                    const int key = j * 256 + 32 * kc + (int)pi32(m);
                    float pe = __builtin_amdgcn_exp2f(S[e] * SCL2 - c2);
                    if (own && key > pos) pe = 0.f;
                    p[e] = pe; l += pe;
                }
                u32x4 w0, w1;
                w0.x = pk_bf16(p[0], p[1]); w0.y = pk_bf16(p[2], p[3]); w0.z = pk_bf16(p[4], p[5]); w0.w = pk_bf16(p[6], p[7]);
                w1.x = pk_bf16(p[8], p[9]); w1.y = pk_bf16(p[10], p[11]); w1.z = pk_bf16(p[12], p[13]); w1.w = pk_bf16(p[14], p[15]);
                const bf16x8 pf0 = __builtin_bit_cast(bf16x8, w0), pf1 = __builtin_bit_cast(bf16x8, w1);
#pragma unroll
                for (int dt = 0; dt < 4; ++dt) {
                    const bf16x8 v0 = tr_frag(Vimg, lane, dt, 2 * kc), v1 = tr_frag(Vimg, lane, dt, 2 * kc + 1);
                    O[dt] = __builtin_amdgcn_mfma_f32_32x32x16_bf16(v0, pf0, O[dt], 0, 0, 0);
                    O[dt] = __builtin_amdgcn_mfma_f32_32x32x16_bf16(v1, pf1, O[dt], 0, 0, 0);
                }
            }
            l += __shfl_xor(l, 32);
            if (valid) {
                bf16_t* pl = (slot < 3 ? P012 + (size_t)slot * ((size_t)32 << 20) : P3) + (tok * NHEAD + h) * 128 + 4 * hh;
#pragma unroll
                for (int dt = 0; dt < 4; ++dt)
#pragma unroll
                    for (int g = 0; g < 4; ++g) {
                        u32x2 w; w.x = pk_bf16(O[dt][4 * g], O[dt][4 * g + 1]); w.y = pk_bf16(O[dt][4 * g + 2], O[dt][4 * g + 3]);
                        *(u32x2*)(pl + 32 * dt + 8 * g) = w;
                    }
                if (hh == 0) LS[(size_t)slot * MTOK * NHEAD + tok * NHEAD + h] = l;
            }
        }
    }
}
__device__ __forceinline__ void phase_comb(const bf16_t* P012, const bf16_t* P3, const float* LS, bf16_t* AO) {
    const size_t n = (size_t)MTOK * NHEAD * 16, stride = (size_t)gridDim.x * 512;
    for (size_t idx = (size_t)blockIdx.x * 512 + threadIdx.x; idx < n; idx += stride) {
        const size_t th = idx >> 4; const int ch = (int)(idx & 15);
        const int t = (int)((th >> 4) & (SEQ - 1)), blk = t >> 8, nsel = blk < 3 ? blk : 3;
        float acc[8];
        float l = LS[(size_t)3 * MTOK * NHEAD + th];
        { const u32x4 w = *(const u32x4*)(P3 + th * 128 + ch * 8);
          acc[0] = bflo(w.x); acc[1] = bfhi(w.x); acc[2] = bflo(w.y); acc[3] = bfhi(w.y); acc[4] = bflo(w.z); acc[5] = bfhi(w.z); acc[6] = bflo(w.w); acc[7] = bfhi(w.w); }
        for (int s = 0; s < nsel; ++s) {
            const u32x4 w = *(const u32x4*)(P012 + (size_t)s * ((size_t)32 << 20) + th * 128 + ch * 8);
            acc[0] += bflo(w.x); acc[1] += bfhi(w.x); acc[2] += bflo(w.y); acc[3] += bfhi(w.y); acc[4] += bflo(w.z); acc[5] += bfhi(w.z); acc[6] += bflo(w.w); acc[7] += bfhi(w.w);
            l += LS[(size_t)s * MTOK * NHEAD + th];
        }
        const float rl = 1.0f / l;
        u32x4 o; o.x = pk_bf16(acc[0] * rl, acc[1] * rl); o.y = pk_bf16(acc[2] * rl, acc[3] * rl); o.z = pk_bf16(acc[4] * rl, acc[5] * rl); o.w = pk_bf16(acc[6] * rl, acc[7] * rl);
        *(u32x4*)(AO + th * 128 + ch * 8) = o;
    }
}

__device__ __forceinline__ void phase_scan_a(LAS unsigned char* lds, const float* LF, const bf16_t* I1, bf16_t* LT, float* DEC, unsigned* dbgc = nullptr) {
    unsigned dbg_kt = 0, dbg_acc = 0;
    const int tid = threadIdx.x, lane = tid & 63, wv = tid >> 6, k = tid & 127, part = tid >> 7;
    LAS unsigned char* Iimg = lds; LAS unsigned char* KTimg = lds + 16384;
    LAS float* psum = (LAS float*)(lds + 32768);
    LAS unsigned char* Lst = lds + 36864;
#if SCAN_A_VALU == 2
    for (int item = blockIdx.x; item < 2 * NHEAD * 128; item += gridDim.x) {
        const int bh = item >> 7, c = item & 127, b = bh >> 4, h = bh & 15;
        const size_t tok0 = (size_t)b * SEQ + c * 64;
        for (int idx = tid; idx < 16384; idx += 512) {
            const int v = idx >> 7, kk = idx & 127;
            float g = 1.f, L = 0.f;
            for (int s2 = 63; s2 >= 0; --s2) { const size_t o = (tok0 + s2) * DM + h * 128; const float f = __expf(LF[o + kk]); L += bf2f(I1[o + v]) * (1.0f - f) * g; g *= f; }
            LT[(size_t)item * 16384 + idx] = (bf16_t)(pk_bf16(L, 0.f) & 0xffffu);
        }
    }
    return;
#endif
    for (int item = blockIdx.x; item < 2 * NHEAD * 128; item += gridDim.x) {
        const int bh = item >> 7, c = item & 127, b = bh >> 4, h = bh & 15;
        const size_t tok0 = (size_t)b * SEQ + c * 64;
        float lf[16];
#pragma unroll
        for (int i = 0; i < 16; ++i) lf[i] = LF[(tok0 + 16 * part + i) * DM + h * 128 + k];
#pragma unroll
        for (int r = 0; r < 2; ++r) { const int idx = tid + 512 * r, row = idx >> 4, ch = idx & 15; *(LAS u32x4*)(Iimg + off_b(row, ch)) = *(const u32x4*)(I1 + (tok0 + row) * DM + h * 128 + ch * 8); }
        float cs = 0.f;
#pragma unroll
        for (int i = 0; i < 16; ++i) cs += lf[i];
        psum[part * 128 + k] = cs;
        __syncthreads();
        const float p0 = psum[k], p1 = psum[128 + k], p2 = psum[256 + k], p3 = psum[384 + k];
        const float blast = (p0 + p1) + (p2 + p3);
        float bb = part == 0 ? 0.f : (part == 1 ? p0 : (part == 2 ? p0 + p1 : p0 + p1 + p2));
#pragma unroll
        for (int i = 0; i < 16; ++i) {
            bb += lf[i];
            const float kt = (1.0f - __expf(lf[i])) * __expf(blast - bb);
            if (!(kt - kt == 0.f)) ++dbg_kt;
            const int srow = 16 * part + i;
            *(LAS bf16_t*)(KTimg + off_b(srow, k >> 3) + 2 * (k & 7)) = (bf16_t)(pk_bf16(kt, 0.f) & 0xffffu);
        }
        if (part == 0) DEC[(size_t)item * 128 + k] = __expf(blast);
        __syncthreads();
#if SCAN_A_VALU
        for (int idx = tid; idx < 16384; idx += 512) {
            const int v = idx >> 7, kk = idx & 127;
            float accv = 0.f;
            for (int s2 = 0; s2 < 64; ++s2) accv += bf2f(*(const LAS bf16_t*)(Iimg + off_b(s2, v >> 3) + 2 * (v & 7))) * bf2f(*(const LAS bf16_t*)(KTimg + off_b(s2, kk >> 3) + 2 * (kk & 7)));
            *(LAS bf16_t*)(Lst + v * 272 + 2 * kk) = (bf16_t)(pk_bf16(accv, 0.f) & 0xffffu);
        }
        if (0)
#endif
        {
            const int vt = wv >> 1;
            f32x16 acc0, acc1;
#pragma unroll
            for (int e = 0; e < 16; ++e) { acc0[e] = 0.f; acc1[e] = 0.f; }
#pragma unroll
            for (int ks = 0; ks < 4; ++ks) {
                const bf16x8 af = tr_frag(Iimg, lane, vt, ks);
                const bf16x8 b0 = tr_frag(KTimg, lane, 2 * (wv & 1), ks), b1 = tr_frag(KTimg, lane, 2 * (wv & 1) + 1, ks);
                acc0 = __builtin_amdgcn_mfma_f32_32x32x16_bf16(af, b0, acc0, 0, 0, 0);
                acc1 = __builtin_amdgcn_mfma_f32_32x32x16_bf16(af, b1, acc1, 0, 0, 0);
            }
            const int r32 = lane & 31, hh = lane >> 5;
#pragma unroll
            for (int e = 0; e < 16; ++e) {
                if (!(acc0[e] - acc0[e] == 0.f)) ++dbg_acc; if (!(acc1[e] - acc1[e] == 0.f)) ++dbg_acc;
                const int v = 32 * vt + (e & 3) + 8 * (e >> 2) + 4 * hh;
                *(LAS bf16_t*)(Lst + v * 272 + 2 * (64 * (wv & 1) + r32)) = (bf16_t)(pk_bf16(acc0[e], 0.f) & 0xffffu);
                *(LAS bf16_t*)(Lst + v * 272 + 2 * (64 * (wv & 1) + 32 + r32)) = (bf16_t)(pk_bf16(acc1[e], 0.f) & 0xffffu);
            }
        }
        __syncthreads();
#pragma unroll
        for (int r = 0; r < 4; ++r) { const int idx = tid + 512 * r, row = idx >> 4, ch = idx & 15; store_wt16(LT + (size_t)item * 16384 + row * 128 + ch * 8, *(const LAS u32x4*)(Lst + row * 272 + ch * 16)); }
        __syncthreads();
    }
    if (dbgc) { if (dbg_kt) atomicAdd(dbgc + 0, dbg_kt); if (dbg_acc) atomicAdd(dbgc + 1, dbg_acc); }
}
__device__ __forceinline__ void phase_scan_b(bf16_t* LT, const float* DEC) {
    const int n = 2 * NHEAD * 128 * 32;
    for (int idx = blockIdx.x * 512 + threadIdx.x; idx < n; idx += gridDim.x * 512) {
        const int bh = idx >> 12, vk = idx & 4095, k4 = (vk & 31) * 4;
        float S0 = 0.f, S1 = 0.f, S2 = 0.f, S3 = 0.f;
        bf16_t* p = LT + (size_t)bh * 128 * 16384 + (size_t)vk * 4;
        const float* dp = DEC + (size_t)bh * 128 * 128 + k4;
#pragma unroll 8
        for (int c = 0; c < 128; ++c) {
            const u32x2 w = *(const u32x2*)(p + (size_t)c * 16384);
            const f32x4 d = *(const f32x4*)(dp + c * 128);
            u32x2 o; o.x = pk_bf16(S0, S1); o.y = pk_bf16(S2, S3);
            store_wt8(p + (size_t)c * 16384, o);
            S0 = d[0] * S0 + bflo(w.x); S1 = d[1] * S1 + bfhi(w.x); S2 = d[2] * S2 + bflo(w.y); S3 = d[3] * S3 + bfhi(w.y);
        }
    }
}
__device__ __forceinline__ void phase_scan_c(LAS unsigned char* lds, const bf16_t* Q1, const float* LF, const bf16_t* I1, const bf16_t* G1, const bf16_t* SP, const float* gnorm, bf16_t* OG) {
    const int tid = threadIdx.x, lane = tid & 63, wv = tid >> 6, k = tid & 127, part = tid >> 7, r32 = lane & 31, hh = lane >> 5;
    LAS unsigned char* QTimg = lds; LAS unsigned char* QPimg = lds + 16384; LAS unsigned char* KPimg = lds + 32768; LAS unsigned char* Iimg = lds + 49152; LAS unsigned char* SPimg = lds + 65536;
    LAS float* psum = (LAS float*)(lds + 98304);
    LAS float* ssq = (LAS float*)(lds + 100352);
    LAS unsigned char* OT = lds + 102400;
    for (int item = blockIdx.x; item < 2 * NHEAD * 128; item += gridDim.x) {
        const int bh = item >> 7, c = item & 127, b = bh >> 4, h = bh & 15;
        const size_t tok0 = (size_t)b * SEQ + c * 64;
        float lf[16], qv[16];
#pragma unroll
        for (int i = 0; i < 16; ++i) { const size_t o = (tok0 + 16 * part + i) * DM + h * 128 + k; lf[i] = LF[o]; qv[i] = bf2f(Q1[o]); }
#pragma unroll
        for (int r = 0; r < 2; ++r) { const int idx = tid + 512 * r, row = idx >> 4, ch = idx & 15; *(LAS u32x4*)(Iimg + off_b(row, ch)) = *(const u32x4*)(I1 + (tok0 + row) * DM + h * 128 + ch * 8); }
#pragma unroll
        for (int r = 0; r < 4; ++r) { const int idx = tid + 512 * r, row = idx >> 4, ch = idx & 15; *(LAS u32x4*)(SPimg + off_b(row, ch)) = *(const u32x4*)(SP + (size_t)item * 16384 + row * 128 + ch * 8); }
        float cs = 0.f;
#pragma unroll
        for (int i = 0; i < 16; ++i) cs += lf[i];
        psum[part * 128 + k] = cs;
        __syncthreads();
        const float p0 = psum[k], p1 = psum[128 + k], p2 = psum[256 + k];
        const float rr = p0 + p1;
        float bb = part == 0 ? 0.f : (part == 1 ? p0 : (part == 2 ? p0 + p1 : p0 + p1 + p2));
#pragma unroll
        for (int i = 0; i < 16; ++i) {
            bb += lf[i];
            const float qt = qv[i] * __expf(bb), qp = qv[i] * __expf(bb - rr), kp = (1.0f - __expf(lf[i])) * __expf(rr - bb);
            const unsigned o = off_b(16 * part + i, k >> 3) + 2 * (k & 7);
            *(LAS bf16_t*)(QTimg + o) = (bf16_t)(pk_bf16(qt, 0.f) & 0xffffu);
            *(LAS bf16_t*)(QPimg + o) = (bf16_t)(pk_bf16(qp, 0.f) & 0xffffu);
            *(LAS bf16_t*)(KPimg + o) = (bf16_t)(pk_bf16(kp, 0.f) & 0xffffu);
        }
        __syncthreads();
        const int tt = wv & 1, vt = wv >> 1;
        f32x16 O;
#pragma unroll
        for (int e = 0; e < 16; ++e) O[e] = 0.f;
#pragma unroll
        for (int ks = 0; ks < 8; ++ks) {
            const bf16x8 af = *(const LAS bf16x8*)(SPimg + off_b(32 * vt + r32, 2 * ks + hh));
            const bf16x8 bf = *(const LAS bf16x8*)(QTimg + off_b(32 * tt + r32, 2 * ks + hh));
            O = __builtin_amdgcn_mfma_f32_32x32x16_bf16(af, bf, O, 0, 0, 0);
        }
        const unsigned krow = pi32((unsigned)r32);
        for (int st = 0; st <= tt; ++st) {
            f32x16 S;
#pragma unroll
            for (int e = 0; e < 16; ++e) S[e] = 0.f;
#pragma unroll
            for (int ks = 0; ks < 8; ++ks) {
                const bf16x8 af = *(const LAS bf16x8*)(KPimg + off_b(32 * st + krow, 2 * ks + hh));
                const bf16x8 bf = *(const LAS bf16x8*)(QPimg + off_b(32 * tt + r32, 2 * ks + hh));
                S = __builtin_amdgcn_mfma_f32_32x32x16_bf16(af, bf, S, 0, 0, 0);
            }
            float p[16];
#pragma unroll
            for (int e = 0; e < 16; ++e) {
                const unsigned m = (e & 3) + 8 * (e >> 2) + 4 * hh;
                const int sidx = 32 * st + (int)pi32(m), tidx = 32 * tt + r32;
                p[e] = sidx <= tidx ? S[e] : 0.f;
            }
            u32x4 w0, w1;
            w0.x = pk_bf16(p[0], p[1]); w0.y = pk_bf16(p[2], p[3]); w0.z = pk_bf16(p[4], p[5]); w0.w = pk_bf16(p[6], p[7]);
            w1.x = pk_bf16(p[8], p[9]); w1.y = pk_bf16(p[10], p[11]); w1.z = pk_bf16(p[12], p[13]); w1.w = pk_bf16(p[14], p[15]);
            const bf16x8 pf0 = __builtin_bit_cast(bf16x8, w0), pf1 = __builtin_bit_cast(bf16x8, w1);
            const bf16x8 i0 = tr_frag(Iimg, lane, vt, 2 * st), i1 = tr_frag(Iimg, lane, vt, 2 * st + 1);
            O = __builtin_amdgcn_mfma_f32_32x32x16_bf16(i0, pf0, O, 0, 0, 0);
            O = __builtin_amdgcn_mfma_f32_32x32x16_bf16(i1, pf1, O, 0, 0, 0);
        }
        float sq = 0.f;
#pragma unroll
        for (int e = 0; e < 16; ++e) sq += O[e] * O[e];
        sq += __shfl_xor(sq, 32);
        if (hh == 0) ssq[vt * 64 + 32 * tt + r32] = sq;
        __syncthreads();
        const int tl = 32 * tt + r32;
        const float rstd = rsqrtf((ssq[tl] + ssq[64 + tl] + ssq[128 + tl] + ssq[192 + tl]) * (1.0f / 128.0f) + 1e-6f);
#pragma unroll
        for (int g = 0; g < 4; ++g) {
            const int v0 = 32 * vt + 8 * g + 4 * hh;
            const f32x4 gn = *(const f32x4*)(gnorm + v0);
            u32x2 w; w.x = pk_bf16(O[4 * g] * rstd * gn[0], O[4 * g + 1] * rstd * gn[1]); w.y = pk_bf16(O[4 * g + 2] * rstd * gn[2], O[4 * g + 3] * rstd * gn[3]);
            *(LAS u32x2*)(OT + tl * 272 + v0 * 2) = w;
        }
        __syncthreads();
#pragma unroll
        for (int r = 0; r < 2; ++r) {
            const int idx = tid + 512 * r, row = idx >> 4, ch = idx & 15;
            const u32x4 ov = *(const LAS u32x4*)(OT + row * 272 + ch * 16);
            const size_t go = (tok0 + row) * DM + h * 128 + ch * 8;
            const u32x4 gv = *(const u32x4*)(G1 + go);
            u32x4 w;
            w.x = pk_bf16(bflo(ov.x) * bflo(gv.x), bfhi(ov.x) * bfhi(gv.x)); w.y = pk_bf16(bflo(ov.y) * bflo(gv.y), bfhi(ov.y) * bfhi(gv.y));
            w.z = pk_bf16(bflo(ov.z) * bflo(gv.z), bfhi(ov.z) * bfhi(gv.z)); w.w = pk_bf16(bflo(ov.w) * bflo(gv.w), bfhi(ov.w) * bfhi(gv.w));
            *(u32x4*)(OG + go) = w;
        }
        __syncthreads();
    }
}


#if SCAN_DBG == 2
__device__ __forceinline__ void dbg_compare(LAS float* red, const bf16_t* A, const bf16_t* B, float* DBG) {
    float sd = 0.f, sr = 0.f, nn = 0.f;
    const size_t n = (size_t)MTOK * DM;
    for (size_t i = (size_t)blockIdx.x * 512 + threadIdx.x; i < n; i += (size_t)gridDim.x * 512) {
        const float x = bf2f(A[i]), y = bf2f(B[i]);
        if (!(x - x == 0.f)) nn += 1.f; else { sd += (x - y) * (x - y); sr += y * y; }
    }
    sd = wave_sum(sd); sr = wave_sum(sr); nn = wave_sum(nn);
    const int wv = threadIdx.x >> 6;
    if ((threadIdx.x & 63) == 0) { red[wv * 3] = sd; red[wv * 3 + 1] = sr; red[wv * 3 + 2] = nn; }
    __syncthreads();
    if (threadIdx.x == 0) { float a = 0, b = 0, c = 0; for (int w = 0; w < 8; ++w) { a += red[w * 3]; b += red[w * 3 + 1]; c += red[w * 3 + 2]; } DBG[blockIdx.x * 4] = a; DBG[blockIdx.x * 4 + 1] = b; DBG[blockIdx.x * 4 + 2] = c; }
    __syncthreads();
}
__device__ __forceinline__ void dbg_emit(const float* DBG, float* out) {
    float a = 0, b = 0, c = 0;
    for (int w = 0; w < (int)gridDim.x; ++w) { a += DBG[w * 4]; b += DBG[w * 4 + 1]; c += DBG[w * 4 + 2]; }
    const float rel = sqrtf(a / b);
    int k = (int)rintf(-2.0f * log10f(rel)); k = k < 0 ? 0 : (k > 16 ? 16 : k);
    if (c > 0.f) k = 17;
    const float cc = sqrtf(0.5f * (float)k);
    const size_t n = (size_t)MTOK * DM;
    for (size_t i = (size_t)blockIdx.x * 512 + threadIdx.x; i < n; i += (size_t)gridDim.x * 512) out[i] = cc;
}
#endif

#if SCAN_DBG == 3
__device__ __forceinline__ void dbg_count_bf16(const bf16_t* A, size_t n, unsigned* cnt) {
    unsigned c = 0;
    for (size_t i = (size_t)blockIdx.x * 512 + threadIdx.x; i < n; i += (size_t)gridDim.x * 512) { const float x = bf2f(A[i]); if (!(x - x == 0.f)) ++c; }
    if (c) atomicAdd(cnt, c);
}
__device__ __forceinline__ void dbg_count_f32(const float* A, size_t n, unsigned* cnt) {
    unsigned c = 0;
    for (size_t i = (size_t)blockIdx.x * 512 + threadIdx.x; i < n; i += (size_t)gridDim.x * 512) { const float x = A[i]; if (!(x - x == 0.f)) ++c; }
    if (c) atomicAdd(cnt, c);
}
__device__ __forceinline__ void dbg_emit3(const unsigned* cnt, float* out) {
    float code = 0.f;
    for (int st = 3; st >= 0; --st) { const unsigned c = cnt[st]; if (c) { float lg = log10f((float)c); lg = lg > 9.f ? 9.f : lg; code = (float)(st + 1) + 0.1f * lg; } }
    const float cc = sqrtf(code);
    const size_t n = (size_t)MTOK * DM;
    for (size_t i = (size_t)blockIdx.x * 512 + threadIdx.x; i < n; i += (size_t)gridDim.x * 512) out[i] = cc;
}
#endif

#if SCAN_DBG == 4 || SCAN_DBG == 6
__device__ __forceinline__ void dbg_compare4(LAS float* red, const bf16_t* A, const bf16_t* B, const bf16_t* C, float* DBG) {
    float sd = 0.f, sr = 0.f, nn = 0.f, mm = 0.f;
    const size_t n = (size_t)MTOK * DM;
    for (size_t i = (size_t)blockIdx.x * 512 + threadIdx.x; i < n; i += (size_t)gridDim.x * 512) {
        const float x = bf2f(A[i]), y = bf2f(B[i]);
        if (!(x - x == 0.f)) nn += 1.f; else { sd += (x - y) * (x - y); sr += y * y; }
        if (A[i] != C[i]) mm += 1.f;
    }
    sd = wave_sum(sd); sr = wave_sum(sr); nn = wave_sum(nn); mm = wave_sum(mm);
    const int wv = threadIdx.x >> 6;
    if ((threadIdx.x & 63) == 0) { red[wv * 4] = sd; red[wv * 4 + 1] = sr; red[wv * 4 + 2] = nn; red[wv * 4 + 3] = mm; }
    __syncthreads();
    if (threadIdx.x == 0) { float a = 0, b = 0, c = 0, d = 0; for (int w = 0; w < 8; ++w) { a += red[w * 4]; b += red[w * 4 + 1]; c += red[w * 4 + 2]; d += red[w * 4 + 3]; }
        DBG[blockIdx.x * 4] = a; DBG[blockIdx.x * 4 + 1] = b; DBG[blockIdx.x * 4 + 2] = c; DBG[blockIdx.x * 4 + 3] = d; }
    __syncthreads();
}
__device__ __forceinline__ void dbg_emit4(const float* DBG, float* out) {
    float a = 0, b = 0, c = 0, d = 0;
    for (int w = 0; w < (int)gridDim.x; ++w) { a += DBG[w * 4]; b += DBG[w * 4 + 1]; c += DBG[w * 4 + 2]; d += DBG[w * 4 + 3]; }
    const float rel = sqrtf(a / b);
    int k = (int)rintf(-log10f(rel)); k = k < 0 ? 0 : (k > 8 ? 8 : k);
#if SCAN_DBG == 6
    const float cc = sqrtf((float)k + ((d + c) > 0.f ? 0.5f : 0.f));
#else
    int m = (int)ceilf(log10f(1.0f + d + c)); m = m > 9 ? 9 : m;
    const float cc = sqrtf((float)k + 0.1f * (float)m);
#endif
    const size_t n = (size_t)MTOK * DM;
    for (size_t i = (size_t)blockIdx.x * 512 + threadIdx.x; i < n; i += (size_t)gridDim.x * 512) out[i] = cc;
}
#endif

#if SCAN_DBG == 5
__device__ __forceinline__ void dbg_lds16_test(LAS unsigned char* lds, unsigned* cnt) {
    const int tid = threadIdx.x;
    unsigned bad = 0;
    for (int rep = 0; rep < 64; ++rep) {
        for (int i = tid; i < 1024; i += 512) *(LAS u32x4*)(lds + i * 16) = (u32x4){0x7fc07fc0u, 0x7fc07fc0u, 0x7fc07fc0u, 0x7fc07fc0u};
        __syncthreads();
        const int k = tid & 127, part = tid >> 7;
#pragma unroll
        for (int i = 0; i < 16; ++i) {
            const int row = 16 * part + i;
            *(LAS bf16_t*)(lds + off_b(row, k >> 3) + 2 * (k & 7)) = (bf16_t)((row * 128 + k + rep) & 0x7fff);
        }
        __syncthreads();
        for (int idx = tid; idx < 64 * 128; idx += 512) {
            const int row = idx >> 7, kk = idx & 127;
            const bf16_t got = *(const LAS bf16_t*)(lds + off_b(row, kk >> 3) + 2 * (kk & 7));
            if (got != (bf16_t)((row * 128 + kk + rep) & 0x7fff)) ++bad;
        }
        __syncthreads();
    }
    if (bad) atomicAdd(cnt, bad);
}
__device__ __forceinline__ void dbg_emit5(const unsigned* cnt, float* out) {
    const unsigned c = cnt[0];
    float code = 0.f;
    if (c) { float lg = log10f((float)c); code = 1.0f + (lg > 8.9f ? 8.9f : lg); }
    const float cc = sqrtf(code);
    const size_t n = (size_t)MTOK * DM;
    for (size_t i = (size_t)blockIdx.x * 512 + threadIdx.x; i < n; i += (size_t)gridDim.x * 512) out[i] = cc;
}
#endif

#if SCAN_DBG == 6
__device__ __forceinline__ void dbg_check_a(LAS float* red, const float* LF, const bf16_t* I1, const bf16_t* LT, const bf16_t* LT2, float* DBG) {
    float sd = 0.f, sr = 0.f, mm = 0.f;
    const size_t n = (size_t)4096 * 16384;
    for (size_t i = (size_t)blockIdx.x * 512 + threadIdx.x; i < n; i += (size_t)gridDim.x * 512) {
        const int item = (int)(i >> 14), v = (int)((i >> 7) & 127), k = (int)(i & 127);
        const int bh = item >> 7, c = item & 127, b = bh >> 4, h = bh & 15;
        const size_t tok0 = (size_t)b * SEQ + c * 64;
        float g = 1.f, L = 0.f;
        for (int s2 = 63; s2 >= 0; --s2) {
            const size_t o = (tok0 + s2) * DM + h * 128;
            const float f = __expf(LF[o + k]);
            L += bf2f(I1[o + v]) * (1.0f - f) * g;
            g *= f;
        }
        const float x = bf2f(LT[i]);
        sd += (x - L) * (x - L); sr += L * L;
        if (LT[i] != LT2[i]) mm += 1.f;
    }
    sd = wave_sum(sd); sr = wave_sum(sr); mm = wave_sum(mm);
    const int wv = threadIdx.x >> 6;
    if ((threadIdx.x & 63) == 0) { red[wv * 4] = sd; red[wv * 4 + 1] = sr; red[wv * 4 + 2] = 0.f; red[wv * 4 + 3] = mm; }
    __syncthreads();
    if (threadIdx.x == 0) { float a = 0, b2 = 0, d = 0; for (int w = 0; w < 8; ++w) { a += red[w * 4]; b2 += red[w * 4 + 1]; d += red[w * 4 + 3]; }
        DBG[blockIdx.x * 4] = a; DBG[blockIdx.x * 4 + 1] = b2; DBG[blockIdx.x * 4 + 2] = 0.f; DBG[blockIdx.x * 4 + 3] = d; }
    __syncthreads();
}
#endif

#if SCAN_DBG == 7
#ifndef DBG_FAM
#define DBG_FAM 0
#endif
__device__ __forceinline__ void dbg_check_a7(const float* LF, const bf16_t* I1, const bf16_t* LT, float* DBG) {
    const size_t n = (size_t)4096 * 16384;
    float nbad = 0.f, nnf = 0.f;
    for (size_t i = (size_t)blockIdx.x * 512 + threadIdx.x; i < n; i += (size_t)gridDim.x * 512 * 8) {
        const int item = (int)(i >> 14), v = (int)((i >> 7) & 127), k = (int)(i & 127);
        const int bh = item >> 7, c = item & 127, b = bh >> 4, h = bh & 15;
        const size_t tok0 = (size_t)b * SEQ + c * 64;
        float g = 1.f, L = 0.f;
        for (int s2 = 63; s2 >= 0; --s2) {
            const size_t o = (tok0 + s2) * DM + h * 128;
            const float f = __expf(LF[o + k]);
            L += bf2f(I1[o + v]) * (1.0f - f) * g;
            g *= f;
        }
        const float x = bf2f(LT[i]);
        if (!(x - x == 0.f)) { nnf += 1.f; nbad += 1.f; }
        else if (fabsf(x - L) > 0.02f * fabsf(L) + 1e-2f) nbad += 1.f;
    }
    nbad = wave_sum(nbad); nnf = wave_sum(nnf);
    if ((threadIdx.x & 63) == 0) { atomicAdd(DBG, nbad); atomicAdd(DBG + 1, nnf); }
}
__device__ __forceinline__ void dbg_emit7(const float* DBG, float* out) {
    const float nb = DBG[0], nf = DBG[1];
    int A = nb == 0.f ? 0 : (nb <= 100.f ? 1 : (nb <= 1e4f ? 3 : (nb <= 1e6f ? 5 : 7)));
    int B = nf == 0.f ? 0 : 5;
    const float cc = sqrtf((float)A + 0.1f * (float)B);
    const size_t n = (size_t)MTOK * DM;
    for (size_t i = (size_t)blockIdx.x * 512 + threadIdx.x; i < n; i += (size_t)gridDim.x * 512) out[i] = cc;
}
#endif
__device__ __forceinline__ int opaque(int v) { asm volatile("" : "+s"(v)); return v; }
template <bool L1> __device__ __forceinline__ void run_gemm_out(const Args& a, LAS unsigned char* lds) {
    unsigned char* ws = a.ws;
    pg8::Gemm g{(const bf16_t*)(ws + (L1 ? slot(3) : slot(0))), (const bf16_t*)(ws + (L1 ? WS_WO : WS_WOUT)), opaque(MTOK), opaque(DM), opaque(DM)};
    pg8::StaticOrder S; S.init(g.M, g.N, (int)gridDim.x, (int)blockIdx.x);
    EpiRes E{L1 ? (const float*)(ws + slot(0)) : a.in[0], (float*)(ws + (L1 ? slot(4) : slot(1)))};
    pg8::gemm_phase<EpiRes, pg8::StaticOrder>(lds, g, S, E, nullptr);
}
template <bool L1> __device__ __forceinline__ void run_ln(const Args& a) {
    unsigned char* ws = a.ws;
    phase_ln((const float*)(ws + (L1 ? slot(4) : slot(1))), a.in[12] + (L1 ? 2 : 0) * DM, a.in[13] + (L1 ? 2 : 0) * DM,
             (float*)(ws + (L1 ? slot(6) : slot(3))), (bf16_t*)(ws + (L1 ? slot(8) : slot(5))));
}
template <bool L1> __device__ __forceinline__ void run_gemm_sc(const Args& a, LAS unsigned char* lds) {
    unsigned char* ws = a.ws;
    pg8::Gemm g{(const bf16_t*)(ws + (L1 ? slot(8) : slot(5))), (const bf16_t*)(ws + WS_WC) + (L1 ? (size_t)DM * DM : 0), opaque(MTOK), opaque(DM), opaque(DM)};
    pg8::StaticOrder S; S.init(g.M, g.N, (int)gridDim.x, (int)blockIdx.x);
    EpiF32 E{(float*)(ws + (L1 ? slot(0) : slot(6)))};
    pg8::gemm_phase<EpiF32, pg8::StaticOrder>(lds, g, S, E, nullptr);
}
template <bool L1> __device__ __forceinline__ void run_topk(const Args& a, LAS unsigned char* lds) {
    unsigned char* ws = a.ws;
    phase_topk(lds, (const float*)(ws + (L1 ? slot(0) : slot(6))), (int*)(ws + WS_EID), (float*)(ws + WS_GATE));
}
template <bool L1> __device__ __forceinline__ void run_peer(const Args& a, LAS unsigned char* lds) {
    unsigned char* ws = a.ws;
    phase_peer(lds, (const float*)(ws + (L1 ? slot(6) : slot(3))), (const int*)(ws + WS_EID), (const float*)(ws + WS_GATE),
               ws + WS_UB + (L1 ? (size_t)16384 * DM : 0), ws + WS_VB + (L1 ? (size_t)16384 * DM : 0),
               (const float*)(ws + WS_USC) + (L1 ? 16384 : 0), (const float*)(ws + WS_VSC) + (L1 ? 16384 : 0),
               a.in[12] + (L1 ? 3 : 1) * DM, a.in[13] + (L1 ? 3 : 1) * DM,
               L1 ? a.out : (float*)(ws + slot(0)), L1 ? (bf16_t*)nullptr : (bf16_t*)(ws + slot(2)));
}

__global__ void __launch_bounds__(512, 2) mk_fwd(Args a) {
    extern __shared__ __attribute__((aligned(16))) unsigned char lds_raw[];
    LAS unsigned char* lds = (LAS unsigned char*)lds_raw;
    cg::grid_group grid = cg::this_grid();
    unsigned char* ws = a.ws;
#define PHASE_BEGIN(k) if (a.ph_lo <= (k) && (k) < a.ph_hi && EN(k)) {
#define PHASE_END(k) asm volatile("s_waitcnt vmcnt(0)" ::: "memory"); __syncthreads(); if ((k) + 1 < a.ph_hi) { grid.sync(); if (threadIdx.x < 64) { __builtin_amdgcn_fence(__ATOMIC_ACQUIRE, "agent"); asm volatile("s_waitcnt vmcnt(0)" ::: "memory"); } __syncthreads(); } }
    PHASE_BEGIN(0) phase_prep(a, lds);
#if SCAN_DBG == 3 || SCAN_DBG == 5
        if (blockIdx.x == 0 && threadIdx.x < 8) ((unsigned*)(ws + WS_CTR + 8192))[threadIdx.x] = 0u;
#endif
#if SCAN_DBG == 7
        if (blockIdx.x == 0 && threadIdx.x < 32) ((float*)(ws + WS_CTR + 4096))[threadIdx.x] = 0.f;
#endif
    PHASE_END(0)
#if SCAN_DBG == 5
    PHASE_BEGIN(1) dbg_lds16_test(lds, (unsigned*)(ws + WS_CTR + 8192)); PHASE_END(1)
#define SKIP_REST 1
#endif
    PHASE_BEGIN(1) {
        pg8::Gemm g{(const bf16_t*)(ws + slot(0)), (const bf16_t*)(ws + WS_WIN), opaque(MTOK), opaque(4 * DM), opaque(DM)};
        pg8::StaticOrder S; S.init(g.M, g.N, (int)gridDim.x, (int)blockIdx.x);
        EpiIn E{(bf16_t*)(ws + slot(1)), (float*)(ws + slot(4)), (bf16_t*)(ws + slot(2)), (bf16_t*)(ws + slot(3)), (const float*)(ws + WS_LB)};
        pg8::gemm_phase<EpiIn, pg8::StaticOrder>(lds, g, S, E, nullptr);
    } PHASE_END(1)
    PHASE_BEGIN(2) phase_scan_a(lds, (const float*)(ws + slot(4)), (const bf16_t*)(ws + slot(2)), (bf16_t*)(ws + slot(6)), (float*)(ws + WS_DEC)
#if SCAN_DBG == 3
        , (unsigned*)(ws + WS_CTR + 8192)
#endif
        );
#if SCAN_DBG == 7
        asm volatile("s_waitcnt vmcnt(0)" ::: "memory"); __syncthreads(); grid.sync(); if (threadIdx.x < 64) { __builtin_amdgcn_fence(__ATOMIC_ACQUIRE, "agent"); asm volatile("s_waitcnt vmcnt(0)" ::: "memory"); } __syncthreads();
        dbg_check_a7((const float*)(ws + slot(4)), (const bf16_t*)(ws + slot(2)), (const bf16_t*)(ws + slot(6)), (float*)(ws + WS_CTR + 4096));
#endif
#if SCAN_DBG == 6
#define DSYNC6() asm volatile("s_waitcnt vmcnt(0)" ::: "memory"); __syncthreads(); grid.sync(); if (threadIdx.x < 64) { __builtin_amdgcn_fence(__ATOMIC_ACQUIRE, "agent"); asm volatile("s_waitcnt vmcnt(0)" ::: "memory"); } __syncthreads();
        DSYNC6()
        phase_scan_a(lds, (const float*)(ws + slot(4)), (const bf16_t*)(ws + slot(2)), (bf16_t*)a.out, (float*)(ws + WS_DEC));
        DSYNC6()
        dbg_check_a((LAS float*)lds, (const float*)(ws + slot(4)), (const bf16_t*)(ws + slot(2)), (const bf16_t*)(ws + slot(6)), (const bf16_t*)a.out, (float*)(ws + WS_CTR + 4096));
#endif
#if SCAN_DBG == 3
        asm volatile("s_waitcnt vmcnt(0)" ::: "memory"); __syncthreads(); grid.sync();
        dbg_count_bf16((const bf16_t*)(ws + slot(6)), (size_t)4096 * 16384, (unsigned*)(ws + WS_CTR + 8192) + 2);
#endif
    PHASE_END(2)
    PHASE_BEGIN(3) phase_scan_b((bf16_t*)(ws + slot(6)), (const float*)(ws + WS_DEC));
#if SCAN_DBG == 3
        asm volatile("s_waitcnt vmcnt(0)" ::: "memory"); __syncthreads(); grid.sync();

#endif
    PHASE_END(3)
    PHASE_BEGIN(4) phase_scan_c(lds, (const bf16_t*)(ws + slot(1)), (const float*)(ws + slot(4)), (const bf16_t*)(ws + slot(2)), (const bf16_t*)(ws + slot(3)), (const bf16_t*)(ws + slot(6)), a.in[2], (bf16_t*)(ws + slot(0)));
#if SCAN_DBG == 1
        asm volatile("s_waitcnt vmcnt(0)" ::: "memory"); __syncthreads(); grid.sync();
        phase_scan_naive((const bf16_t*)(ws + slot(1)), (const float*)(ws + slot(4)), (const bf16_t*)(ws + slot(2)), (float*)(ws + slot(6)));
        asm volatile("s_waitcnt vmcnt(0)" ::: "memory"); __syncthreads(); grid.sync();
        phase_onorm((const float*)(ws + slot(6)), (const bf16_t*)(ws + slot(3)), a.in[2], (bf16_t*)(ws + slot(0)));
#endif
#if SCAN_DBG == 3
        asm volatile("s_waitcnt vmcnt(0)" ::: "memory"); __syncthreads(); grid.sync();

#endif
#if SCAN_DBG == 4
#define DSYNC() asm volatile("s_waitcnt vmcnt(0)" ::: "memory"); __syncthreads(); grid.sync(); if (threadIdx.x < 64) { __builtin_amdgcn_fence(__ATOMIC_ACQUIRE, "agent"); asm volatile("s_waitcnt vmcnt(0)" ::: "memory"); } __syncthreads();
        DSYNC()
        phase_scan_naive((const bf16_t*)(ws + slot(1)), (const float*)(ws + slot(4)), (const bf16_t*)(ws + slot(2)), (float*)(ws + slot(6)));
        DSYNC()
        phase_onorm((const float*)(ws + slot(6)), (const bf16_t*)(ws + slot(3)), a.in[2], (bf16_t*)(ws + slot(8)));
        DSYNC()
        phase_scan_a(lds, (const float*)(ws + slot(4)), (const bf16_t*)(ws + slot(2)), (bf16_t*)(ws + slot(6)), (float*)(ws + WS_DEC));
        DSYNC()
        phase_scan_b((bf16_t*)(ws + slot(6)), (const float*)(ws + WS_DEC));
        DSYNC()
        phase_scan_c(lds, (const bf16_t*)(ws + slot(1)), (const float*)(ws + slot(4)), (const bf16_t*)(ws + slot(2)), (const bf16_t*)(ws + slot(3)), (const bf16_t*)(ws + slot(6)), a.in[2], (bf16_t*)a.out);
        DSYNC()
        dbg_compare4((LAS float*)lds, (const bf16_t*)(ws + slot(0)), (const bf16_t*)(ws + slot(8)), (const bf16_t*)a.out, (float*)(ws + WS_CTR + 4096));
#endif
#if SCAN_DBG == 2
        asm volatile("s_waitcnt vmcnt(0)" ::: "memory"); __syncthreads(); grid.sync();
        phase_scan_naive((const bf16_t*)(ws + slot(1)), (const float*)(ws + slot(4)), (const bf16_t*)(ws + slot(2)), (float*)(ws + slot(6)));
        asm volatile("s_waitcnt vmcnt(0)" ::: "memory"); __syncthreads(); grid.sync();
        phase_onorm((const float*)(ws + slot(6)), (const bf16_t*)(ws + slot(3)), a.in[2], (bf16_t*)(ws + slot(8)));
        asm volatile("s_waitcnt vmcnt(0)" ::: "memory"); __syncthreads(); grid.sync();
        dbg_compare((LAS float*)lds, (const bf16_t*)(ws + slot(0)), (const bf16_t*)(ws + slot(8)), (float*)(ws + WS_CTR + 4096));
#endif
    PHASE_END(4)
    PHASE_BEGIN(5) run_gemm_out<false>(a, lds); PHASE_END(5)
    PHASE_BEGIN(6) run_ln<false>(a); PHASE_END(6)
    PHASE_BEGIN(7) run_gemm_sc<false>(a, lds); PHASE_END(7)
    PHASE_BEGIN(8) run_topk<false>(a, lds); PHASE_END(8)
    PHASE_BEGIN(9) run_peer<false>(a, lds); PHASE_END(9)
    PHASE_BEGIN(10) {
        pg8::Gemm g{(const bf16_t*)(ws + slot(2)), (const bf16_t*)(ws + WS_WKVQ), opaque(MTOK), opaque(3 * DM), opaque(DM)};
        pg8::StaticOrder S; S.init(g.M, g.N, (int)gridDim.x, (int)blockIdx.x);
        EpiKVQ E{(bf16_t*)(ws + slot(3)), (bf16_t*)(ws + slot(4)), (bf16_t*)(ws + slot(5))};
        pg8::gemm_phase<EpiKVQ, pg8::StaticOrder>(lds, g, S, E, nullptr);
    } PHASE_END(10)
    PHASE_BEGIN(11) phase_rot((LAS float*)lds, (bf16_t*)(ws + slot(3)), (bf16_t*)(ws + slot(5)), (const float*)(ws + WS_COS), (const float*)(ws + WS_SIN), (float*)(ws + WS_KMEAN), (float*)(ws + WS_KNMAX)); PHASE_END(11)
    PHASE_BEGIN(12) phase_sel(lds, (const bf16_t*)(ws + slot(5)), (const float*)(ws + WS_KMEAN), (unsigned short*)(ws + WS_SUB), (int*)(ws + WS_CNT), (int*)(ws + WS_CTR)); PHASE_END(12)
    PHASE_BEGIN(13) phase_att(lds, (const bf16_t*)(ws + slot(5)), (const bf16_t*)(ws + slot(3)), (const bf16_t*)(ws + slot(4)), (const float*)(ws + WS_KNMAX), (const unsigned short*)(ws + WS_SUB),
                              (const int*)(ws + WS_CNT), (int*)(ws + WS_CTR), (bf16_t*)(ws + slot(6)), (bf16_t*)(ws + slot(2)), (float*)(ws + WS_LS)); PHASE_END(13)
    PHASE_BEGIN(14) phase_comb((const bf16_t*)(ws + slot(6)), (const bf16_t*)(ws + slot(2)), (const float*)(ws + WS_LS), (bf16_t*)(ws + slot(3))); PHASE_END(14)
    PHASE_BEGIN(15) run_gemm_out<true>(a, lds); PHASE_END(15)
    PHASE_BEGIN(16) run_ln<true>(a); PHASE_END(16)
    PHASE_BEGIN(17) run_gemm_sc<true>(a, lds); PHASE_END(17)
    PHASE_BEGIN(18) run_topk<true>(a, lds); PHASE_END(18)
#if SCAN_DBG == 7
    PHASE_BEGIN(19) dbg_emit7((const float*)(ws + WS_CTR + 4096), a.out); PHASE_END(19)
#elif SCAN_DBG == 6
    PHASE_BEGIN(19) dbg_emit4((const float*)(ws + WS_CTR + 4096), a.out); PHASE_END(19)
#elif SCAN_DBG == 5
    PHASE_BEGIN(19) dbg_emit5((const unsigned*)(ws + WS_CTR + 8192), a.out); PHASE_END(19)
#elif SCAN_DBG == 4
    PHASE_BEGIN(19) dbg_emit4((const float*)(ws + WS_CTR + 4096), a.out); PHASE_END(19)
#elif SCAN_DBG == 3
    PHASE_BEGIN(19) dbg_emit3((const unsigned*)(ws + WS_CTR + 8192), a.out); PHASE_END(19)
#elif SCAN_DBG == 2
    PHASE_BEGIN(19) dbg_emit((const float*)(ws + WS_CTR + 4096), a.out); PHASE_END(19)
#else
    PHASE_BEGIN(19) run_peer<true>(a, lds); PHASE_END(19)
#endif
}

extern "C" void kernel_launch(void* const* d_in, const int* in_sizes, int n_in, void* d_out, int out_size, void* d_ws, size_t ws_size, hipStream_t stream) {
    static int grid = 0;
    if (grid == 0) {
        if (n_in != 14 || out_size != MTOK * DM || ws_size < WS_END) { fprintf(stderr, "kernel_launch: unexpected shapes (n_in %d, out %d, ws %zu)\n", n_in, out_size, ws_size); grid = -1; return; }
        int dev = 0, cus = 0, per_cu = 0;
        if (hipGetDevice(&dev) != hipSuccess || hipDeviceGetAttribute(&cus, hipDeviceAttributeMultiprocessorCount, dev) != hipSuccess) { grid = -1; return; }
        if (hipFuncSetAttribute((const void*)mk_fwd, hipFuncAttributeMaxDynamicSharedMemorySize, LDS_BYTES) != hipSuccess) { fprintf(stderr, "kernel_launch: hipFuncSetAttribute failed\n"); grid = -1; return; }
        if (hipOccupancyMaxActiveBlocksPerMultiprocessor(&per_cu, (const void*)mk_fwd, 512, LDS_BYTES) != hipSuccess || per_cu < 1) { fprintf(stderr, "kernel_launch: occupancy query failed (%d)\n", per_cu); (void)hipGetLastError(); per_cu = 1; }
        grid = cus * (per_cu > 1 ? 1 : per_cu);
    }
    if (grid < 0) return;
    Args a{};
    for (int i = 0; i < 14; ++i) a.in[i] = (const float*)d_in[i];
    a.out = (float*)d_out; a.ws = (unsigned char*)d_ws;
#if ONE_LAUNCH
    a.ph_lo = 0; a.ph_hi = NPH;
    void* args[] = {&a};
    hipError_t e = hipLaunchCooperativeKernel((const void*)mk_fwd, dim3(grid), dim3(512), args, LDS_BYTES, stream);
    if (e != hipSuccess) fprintf(stderr, "cooperative launch failed: %s (grid %d)\n", hipGetErrorString(e), grid);
#else
    for (int ph = 0; ph < NPH; ++ph) {
        a.ph_lo = ph; a.ph_hi = ph + 1;
        hipLaunchKernelGGL(mk_fwd, dim3(grid), dim3(512), LDS_BYTES, stream, a);
    }
#endif
}
```

```cpp
#define ONE_LAUNCH 1
#include <hip/hip_runtime.h>
#include <hip/hip_cooperative_groups.h>
#include <cstdio>
namespace cg = cooperative_groups;

#ifndef ONE_LAUNCH
#define ONE_LAUNCH 0
#endif
#ifndef SCAN_DBG
#define SCAN_DBG 0
#endif
#ifndef SCAN_A_VALU
#define SCAN_A_VALU 0
#endif
#ifndef ENMASK
#define ENMASK 0xffffffffu
#endif
#define EN(k) ((ENMASK >> (k)) & 1u)

namespace pg8 {
#define PG8_LAS __attribute__((address_space(3)))
typedef unsigned short bf16_t;
typedef short bf16x8 __attribute__((ext_vector_type(8)));
typedef float f32x4 __attribute__((ext_vector_type(4)));
typedef unsigned u32x4 __attribute__((ext_vector_type(4)));
constexpr int BM = 256, BK = 64, HALF = 128, HTB = HALF * BK * 2  , STAGE_BYTES = 8 * HTB, NXCD = 8, WGM = 8;

__host__ __device__ __forceinline__ int lds_byte(int r, int c) { const int st = (r >> 4) * 2 + (c >> 5), rr = r & 15, cc = c & 31, ob = rr * 64 + cc * 2; return st * 1024 + (ob ^ (((ob >> 9) & 1) << 5)); }
__host__ __device__ __forceinline__ void stage_rc(int b, int& R, int& C) { const int st = b / 1024, sb = b % 1024, swz = sb ^ (((sb >> 9) & 1) << 5); R = (st >> 1) * 16 + swz / 64; C = (st & 1) * 32 + (swz % 64) / 2; }
__host__ __device__ __forceinline__ int perm32(int rho) { const int n = rho >> 4, i = rho & 15; return 8 * (i >> 2) + 4 * n + (i & 3); }

struct Unit { int pm, pn; };
struct Gemm { const bf16_t* A; const bf16_t* Bt; int M, N, K; };

struct StaticOrder {
    int nM, nN, nwg, G, c;
    __host__ __device__ void init(int M, int N, int G_, int c_) { nM = M / BM; nN = N / BM; nwg = nM * nN; G = G_; c = c_; }
    __host__ __device__ bool next(int i, Unit& u) const {
        const long L = (long)i * G + c; if (L >= nwg) return false;
        int wgid = (int)L; { const int q = nwg / NXCD, r = nwg % NXCD, xcd = wgid % NXCD, off = wgid / NXCD; wgid = (xcd < r ? xcd * (q + 1) : r * (q + 1) + (xcd - r) * q) + off; }
        const int nig = WGM * nN, gid = wgid / nig, fm = gid * WGM, gsz = (nM - fm) < WGM ? (nM - fm) : WGM;
        u.pm = fm + ((wgid % nig) % gsz); u.pn = (wgid % nig) / gsz; return true;
    }
    __device__ __forceinline__ void a_ready(const Unit&) const {}
    __device__ __forceinline__ void done(const Unit&) const {}
};
struct CountedOrder : StaticOrder {
    const unsigned* ready; unsigned need; unsigned* tmo;
    __device__ __forceinline__ void a_ready(const Unit& u) const {
        if (threadIdx.x < 64) {
            const unsigned long long t0 = __builtin_amdgcn_s_memrealtime(); unsigned polls = 0;
            while ((unsigned)__builtin_amdgcn_readfirstlane(__hip_atomic_load(ready + 64 * u.pm, __ATOMIC_RELAXED, __HIP_MEMORY_SCOPE_AGENT)) < need) {
                if ((++polls & 255u) == 0u && __builtin_amdgcn_readfirstlane(__hip_atomic_load(tmo, __ATOMIC_RELAXED, __HIP_MEMORY_SCOPE_AGENT)) != 0u) break;
                if (__builtin_amdgcn_s_memrealtime() - t0 > 2000000ull) {
                    if (threadIdx.x == 0) { unsigned expect = 0u; __hip_atomic_compare_exchange_strong(tmo + 1, &expect, 0x600u | (unsigned)(u.pm & 0xff), __ATOMIC_RELAXED, __ATOMIC_RELAXED, __HIP_MEMORY_SCOPE_AGENT); __hip_atomic_store(tmo, 1u, __ATOMIC_RELAXED, __HIP_MEMORY_SCOPE_AGENT); }
                    break; }
                __builtin_amdgcn_s_sleep(2); }
            __builtin_amdgcn_fence(__ATOMIC_ACQUIRE, "agent");
            asm volatile("s_waitcnt vmcnt(0)" ::: "memory");
        }
#if !defined(BROKEN_HOOK_NO_BARRIER)
        asm volatile("" ::: "memory"); __builtin_amdgcn_s_barrier(); asm volatile("" ::: "memory");
#endif
    }
};

__device__ __forceinline__ unsigned cvt_pk_bf16(float lo, float hi) { unsigned r; asm volatile("v_cvt_pk_bf16_f32 %0, %1, %2" : "=v"(r) : "v"(lo), "v"(hi)); return r; }
typedef float f32x2 __attribute__((ext_vector_type(2)));
__device__ __forceinline__ f32x2 gelu_pk(f32x2 v) {
    const f32x2 av = __builtin_elementwise_abs(v), d = av * 0.2316418882f + 1.0f;
    f32x2 t; t.x = __builtin_amdgcn_rcpf(d.x); t.y = __builtin_amdgcn_rcpf(d.y);
    f32x2 q = t * 0.5307027145f + (-0.7265760135f); q = q * t + 0.7107068705f; q = q * t + (-0.142248368f); q = q * t + 0.127414796f; q = q * t;
    const f32x2 s = (v * v) * (-0.72134752044f);
    f32x2 e; e.x = __builtin_amdgcn_exp2f(s.x); e.y = __builtin_amdgcn_exp2f(s.y);
    const f32x2 m = v * (q * e), r = v - m;
    f32x2 o; o.x = v.x < 0.f ? m.x : r.x; o.y = v.y < 0.f ? m.y : r.y; return o;
}

struct EpiF32 {
    static constexpr bool PERM = false, AFTER_DRAIN = false;
    float* C; int ldc; const float* bias;
    __device__ __forceinline__ void operator()(const f32x4 (&acc)[2][2][4][2], const Unit& u, int wr, int wc, int fr, int fq) const {
        const int row0 = u.pm * BM + wr * 64 + fr, col0 = u.pn * BM + wc * 32 + 4 * fq;
        f32x4 bv[2][2];
#pragma unroll
        for (int bj = 0; bj < 2; ++bj)
#pragma unroll
            for (int n = 0; n < 2; ++n) bv[bj][n] = bias ? *(const f32x4*)(bias + col0 + bj * HALF + n * 16) : (f32x4){0.f, 0.f, 0.f, 0.f};
#pragma unroll
        for (int ai = 0; ai < 2; ++ai)
#pragma unroll
            for (int m = 0; m < 4; ++m) { float* rowp = C + (size_t)(row0 + ai * HALF + m * 16) * ldc + col0;
#pragma unroll
                for (int bj = 0; bj < 2; ++bj)
#pragma unroll
                    for (int n = 0; n < 2; ++n) *(f32x4*)(rowp + bj * HALF + n * 16) = acc[ai][bj][m][n] + bv[bj][n]; }
    }
};
template <int ACT  > struct EpiBf16 {
    static constexpr bool PERM = true, AFTER_DRAIN = false;
    bf16_t* O; int ldc; const float* bias; int split_cols; size_t split_stride;
    __device__ __forceinline__ void operator()(const f32x4 (&acc)[2][2][4][2], const Unit& u, int wr, int wc, int fr, int fq) const {
        const int row0 = u.pm * BM + wr * 64 + fr; int colt = u.pn * BM; bf16_t* base = O;
        if (split_cols) { const int t = colt / split_cols; base += (size_t)t * split_stride; colt -= t * split_cols; }
        const int col0 = colt + wc * 32 + 8 * fq, bcol0 = u.pn * BM + wc * 32 + 8 * fq;
        f32x4 bv[2][2];
#pragma unroll
        for (int bj = 0; bj < 2; ++bj)
#pragma unroll
            for (int n = 0; n < 2; ++n) bv[bj][n] = bias ? *(const f32x4*)(bias + bcol0 + bj * HALF + 4 * n) : (f32x4){0.f, 0.f, 0.f, 0.f};
#pragma unroll
        for (int ai = 0; ai < 2; ++ai)
#pragma unroll
            for (int m = 0; m < 4; ++m) { bf16_t* rowp = base + (size_t)(row0 + ai * HALF + m * 16) * ldc + col0;
#pragma unroll
                for (int bj = 0; bj < 2; ++bj) { f32x4 v0 = acc[ai][bj][m][0] + bv[bj][0], v1 = acc[ai][bj][m][1] + bv[bj][1];
                    if (ACT == 1) { f32x2 a = gelu_pk((f32x2){v0[0], v0[1]}), b = gelu_pk((f32x2){v0[2], v0[3]}), c = gelu_pk((f32x2){v1[0], v1[1]}), d = gelu_pk((f32x2){v1[2], v1[3]});
                        v0 = (f32x4){a.x, a.y, b.x, b.y}; v1 = (f32x4){c.x, c.y, d.x, d.y}; }
                    if (ACT == 2) {
#pragma unroll
                        for (int j = 0; j < 4; ++j) { v0[j] = 0.5f * v0[j] * (1.0f + erff(v0[j] * 0.70710678f)); v1[j] = 0.5f * v1[j] * (1.0f + erff(v1[j] * 0.70710678f)); } }
                    u32x4 w; w.x = cvt_pk_bf16(v0[0], v0[1]); w.y = cvt_pk_bf16(v0[2], v0[3]); w.z = cvt_pk_bf16(v1[0], v1[1]); w.w = cvt_pk_bf16(v1[2], v1[3]);
                    *(u32x4*)(rowp + bj * HALF) = w; } }
    }
};

template <class Epi, class Sched, bool STAMP = false>
__device__ __forceinline__ void gemm_phase(PG8_LAS unsigned char* lds, const Gemm g, const Sched& S, const Epi& E, unsigned long long* stamps) {
    const int tid = threadIdx.x, wid = __builtin_amdgcn_readfirstlane(tid >> 6), lane = tid & 63, wr = wid >> 2, wc = wid & 3, fr = lane & 15, fq = lane >> 4;
    const int K = g.K, nt = K / BK;
    int ts_lo = 0, ts_hi = 0, nts = 0; const unsigned long long rt_entry = STAMP ? (unsigned long long)wall_clock64() : 0ull;
#define PG8_STAMP() do { if (STAMP && wid == 0 && nts < 64) { const unsigned long long _c = (unsigned long long)clock64(); \
        ts_lo = (lane == nts) ? (int)(unsigned)_c : ts_lo; ts_hi = (lane == nts) ? (int)(unsigned)(_c >> 32) : ts_hi; ++nts; } } while (0)
    PG8_STAMP();
    unsigned voffA[2], voffB[2];
#pragma unroll
    for (int i = 0; i < 2; ++i) { int R, C; stage_rc(tid * 16 + i * 8192, R, C); const int Rb = Epi::PERM ? ((R & ~31) + perm32(R & 31)) : R;
        voffA[i] = (unsigned)(R * K + C) * 2u; voffB[i] = (unsigned)(Rb * K + C) * 2u; }
    const size_t kstep = (size_t)(BK * 2);
    const size_t hstep = (size_t)HALF * K * 2;
    const size_t tstep = 2 * hstep;
    const unsigned ldsw = (unsigned)wid * 1024u;
    const int aoff = lds_byte(wr * 64 + fr, fq * 8), boff = lds_byte(wc * 32 + fr, fq * 8);
#define PG8_SA(b, h) (((b) * 2 + (h)) * HTB)
#define PG8_SB(b, h) ((4 + (b) * 2 + (h)) * HTB)
#define PG8_STAGE(bufoff, gbase, voff) do { _Pragma("unroll") for (int _i = 0; _i < 2; ++_i) \
        __builtin_amdgcn_global_load_lds((const unsigned*)((const char*)(gbase) + (voff)[_i]), (PG8_LAS unsigned*)(lds + (bufoff) + ldsw + _i * 8192), 16, 0, 0); } while (0)
#define PG8_LDA(dst, b, h) do { _Pragma("unroll") for (int m = 0; m < 4; ++m) _Pragma("unroll") for (int k = 0; k < 2; ++k) dst[m][k] = *(const PG8_LAS bf16x8*)(lds + PG8_SA(b, h) + aoff + m * 2048 + k * 1024); } while (0)
#define PG8_LDB(dst, b, h) do { _Pragma("unroll") for (int n = 0; n < 2; ++n) _Pragma("unroll") for (int k = 0; k < 2; ++k) dst[n][k] = *(const PG8_LAS bf16x8*)(lds + PG8_SB(b, h) + boff + n * 2048 + k * 1024); } while (0)
#define PG8_MMA(ai, bj, At, Bt) do { __builtin_amdgcn_s_setprio(1); _Pragma("unroll") for (int m = 0; m < 4; ++m) _Pragma("unroll") for (int n = 0; n < 2; ++n) _Pragma("unroll") for (int k = 0; k < 2; ++k) \
        acc[ai][bj][m][n] = __builtin_amdgcn_mfma_f32_16x16x32_bf16(Bt[n][k], At[m][k], acc[ai][bj][m][n], 0, 0, 0); __builtin_amdgcn_s_setprio(0); } while (0)
#define PG8_WAIT_V(n) asm volatile("s_waitcnt vmcnt(" #n ")" ::: "memory")
#define PG8_WAIT_L(n) asm volatile("s_waitcnt lgkmcnt(" #n ")" ::: "memory")
#define PG8_BAR __builtin_amdgcn_s_barrier()
#define PG8_SCHED __builtin_amdgcn_sched_barrier(0)
    Unit cur, nxt; int ui = 0;
    if (!S.next(0, cur)) return;
    f32x4 acc[2][2][4][2];
#pragma unroll
    for (int a = 0; a < 2; ++a)
#pragma unroll
        for (int b = 0; b < 2; ++b)
#pragma unroll
            for (int m = 0; m < 4; ++m)
#pragma unroll
                for (int n = 0; n < 2; ++n) acc[a][b][m][n] = (f32x4){0.f, 0.f, 0.f, 0.f};
    bf16x8 At[4][2], B0[2][2], B1[2][2];
    const char* cA = (const char*)g.A + (size_t)cur.pm * tstep; const char* cB = (const char*)g.Bt + (size_t)cur.pn * tstep;
    S.a_ready(cur);
    PG8_STAGE(PG8_SB(0, 0), cB, voffB); PG8_STAGE(PG8_SA(0, 0), cA, voffA); PG8_STAGE(PG8_SB(0, 1), cB + hstep, voffB); PG8_STAGE(PG8_SA(0, 1), cA + hstep, voffA);
    if (wr == 1) PG8_BAR;
    PG8_WAIT_V(4); PG8_BAR;
    PG8_STAGE(PG8_SB(1, 0), cB + kstep, voffB); PG8_STAGE(PG8_SA(1, 0), cA + kstep, voffA); PG8_STAGE(PG8_SB(1, 1), cB + hstep + kstep, voffB);
    PG8_WAIT_V(6); PG8_BAR;
    PG8_STAMP();
    for (;;) {
        const bool has_next = S.next(ui + 1, nxt);
        const char* nA = has_next ? (const char*)g.A + (size_t)nxt.pm * tstep : cA; const char* nB = has_next ? (const char*)g.Bt + (size_t)nxt.pn * tstep : cB;
        for (int t = 0; t < nt; t += 2) {
            const bool last = (t == nt - 2);
            const char* a1 = cA + (size_t)(t + 1) * kstep;
            const char* a2 = last ? nA : cA + (size_t)(t + 2) * kstep; const char* b2 = last ? nB : cB + (size_t)(t + 2) * kstep;
            const char* a3 = a2 + kstep; const char* b3 = b2 + kstep;
            if (last && has_next) S.a_ready(nxt);
            PG8_LDB(B0, 0, 0); PG8_SCHED; PG8_LDA(At, 0, 0); PG8_STAGE(PG8_SA(1, 1), a1 + hstep, voffA);
            PG8_WAIT_L(8); PG8_BAR; PG8_WAIT_L(0); PG8_MMA(0, 0, At, B0); PG8_BAR; PG8_SCHED;
            PG8_LDB(B1, 0, 1); PG8_STAGE(PG8_SB(0, 0), b2, voffB);
            PG8_BAR; PG8_WAIT_L(0); PG8_MMA(0, 1, At, B1); PG8_BAR;
            PG8_LDA(At, 0, 1); PG8_STAGE(PG8_SA(0, 0), a2, voffA);
            PG8_BAR; PG8_WAIT_L(0); PG8_MMA(1, 0, At, B0); PG8_BAR; PG8_SCHED;
            PG8_STAGE(PG8_SB(0, 1), b2 + hstep, voffB);
            PG8_WAIT_V(6); PG8_BAR; PG8_MMA(1, 1, At, B1); PG8_BAR;
            PG8_LDB(B0, 1, 0); PG8_SCHED; PG8_LDA(At, 1, 0); PG8_STAGE(PG8_SA(0, 1), a2 + hstep, voffA);
            PG8_WAIT_L(8); PG8_BAR; PG8_WAIT_L(0); PG8_MMA(0, 0, At, B0); PG8_BAR; PG8_SCHED;
            PG8_LDB(B1, 1, 1); PG8_STAGE(PG8_SB(1, 0), b3, voffB);
            PG8_BAR; PG8_WAIT_L(0); PG8_MMA(0, 1, At, B1); PG8_BAR;
            PG8_LDA(At, 1, 1); PG8_STAGE(PG8_SA(1, 0), a3, voffA);
            PG8_BAR; PG8_WAIT_L(0); PG8_MMA(1, 0, At, B0); PG8_BAR; PG8_SCHED;
            PG8_STAGE(PG8_SB(1, 1), b3 + hstep, voffB);
            PG8_WAIT_V(6); PG8_BAR; PG8_MMA(1, 1, At, B1); PG8_BAR;
        }
        PG8_STAMP();
        if constexpr (!Epi::AFTER_DRAIN) { E(acc, cur, wr, wc, fr, fq); S.done(cur); }
        PG8_STAMP();
        if (!has_next) break;
#pragma unroll
        for (int a = 0; a < 2; ++a)
#pragma unroll
            for (int b = 0; b < 2; ++b)
#pragma unroll
                for (int m = 0; m < 4; ++m)
#pragma unroll
                    for (int n = 0; n < 2; ++n) acc[a][b][m][n] = (f32x4){0.f, 0.f, 0.f, 0.f};
        cur = nxt; cA = nA; cB = nB; ++ui;
    }
    PG8_WAIT_V(0);
    if (wr == 0) PG8_BAR;
    PG8_BAR;
    if constexpr (Epi::AFTER_DRAIN) { E.fused(acc, cur, wr, wc, fr, fq, lds, wid, lane); S.done(cur); }
    PG8_STAMP();
    if (STAMP && wid == 0) { stamps[lane] = lane < nts ? (((unsigned long long)(unsigned)ts_hi << 32) | (unsigned)ts_lo) : 0ull;
        if (lane == 62) stamps[62] = rt_entry; if (lane == 63) stamps[63] = (unsigned long long)wall_clock64(); }
#undef PG8_STAMP
#undef PG8_SA
#undef PG8_SB
#undef PG8_STAGE
#undef PG8_LDA
#undef PG8_LDB
#undef PG8_MMA
#undef PG8_WAIT_V
#undef PG8_WAIT_L
#undef PG8_BAR
#undef PG8_SCHED
}
}


#define LAS __attribute__((address_space(3)))
typedef unsigned short bf16_t;
typedef float f32x4 __attribute__((ext_vector_type(4)));
typedef unsigned u32x4 __attribute__((ext_vector_type(4)));
typedef unsigned u32x2 __attribute__((ext_vector_type(2)));
typedef short bf16x8 __attribute__((ext_vector_type(8)));
typedef short s16x4 __attribute__((ext_vector_type(4)));
typedef float f32x16 __attribute__((ext_vector_type(16)));

constexpr int MTOK = 16384, DM = 2048, SEQ = 8192, NHEAD = 16;
constexpr float ALPHA = 1.41421356237309515f;
constexpr size_t MiB = (size_t)1 << 20;
constexpr size_t WS_WIN = 0, WS_WOUT = 32 * MiB, WS_WKVQ = 40 * MiB, WS_WO = 64 * MiB, WS_WC = 72 * MiB, WS_UB = 88 * MiB, WS_VB = 152 * MiB, WS_USC = 216 * MiB, WS_VSC = 217 * MiB, WS_SLOT = 344 * MiB;
constexpr size_t WS_EID = 920 * MiB, WS_GATE = 928 * MiB, WS_COS = 936 * MiB, WS_SIN = 938 * MiB, WS_KMEAN = 940 * MiB, WS_LB = 941 * MiB, WS_LS = 942 * MiB, WS_SUB = 946 * MiB, WS_CNT = 962 * MiB, WS_CTR = 963 * MiB, WS_DEC = 964 * MiB, WS_END = 966 * MiB;
constexpr size_t WS_KNMAX = WS_KMEAN + 768 * 1024;
__host__ __device__ constexpr size_t slot(int i) { return WS_SLOT + (size_t)i * 64 * MiB; }
constexpr int LDS_BYTES = 144 * 1024;
constexpr int NPH = 20;

struct Args { const float* in[14]; float* out; unsigned char* ws; int ph_lo, ph_hi; };

__device__ __forceinline__ float bflo(unsigned w) { return __uint_as_float(w << 16); }
__device__ __forceinline__ float bfhi(unsigned w) { return __uint_as_float(w & 0xffff0000u); }
__device__ __forceinline__ float bf2f(bf16_t b) { return __uint_as_float(((unsigned)b) << 16); }
typedef __bf16 bf16x2_t __attribute__((ext_vector_type(2)));
typedef float f32x2_t __attribute__((ext_vector_type(2)));
__device__ __forceinline__ unsigned pk_bf16(float lo, float hi) { const f32x2_t f = {lo, hi}; return __builtin_bit_cast(unsigned, __builtin_convertvector(f, bf16x2_t)); }
__device__ __forceinline__ float wave_sum(float v) {
#pragma unroll
    for (int o = 32; o >= 1; o >>= 1) v += __shfl_xor(v, o);
    return v;
}
__device__ __forceinline__ float wave_max(float v) {
#pragma unroll
    for (int o = 32; o >= 1; o >>= 1) v = fmaxf(v, __shfl_xor(v, o));
    return v;
}
__device__ __forceinline__ float sigmoidf_(float z) { return 1.0f / (1.0f + __expf(-z)); }


__device__ __forceinline__ void store_wt16(void* p, u32x4 v) {
    __hip_atomic_store((unsigned long long*)p, ((unsigned long long)v.y << 32) | v.x, __ATOMIC_RELAXED, __HIP_MEMORY_SCOPE_AGENT);
    __hip_atomic_store((unsigned long long*)p + 1, ((unsigned long long)v.w << 32) | v.z, __ATOMIC_RELAXED, __HIP_MEMORY_SCOPE_AGENT);
}
__device__ __forceinline__ void store_wt8(void* p, u32x2 v) {
    __hip_atomic_store((unsigned long long*)p, ((unsigned long long)v.y << 32) | v.x, __ATOMIC_RELAXED, __HIP_MEMORY_SCOPE_AGENT);
}
struct EpiIn {
    static constexpr bool PERM = true, AFTER_DRAIN = false;
    bf16_t* Q1; float* LF; bf16_t* I1; bf16_t* G1; const float* LB;
    __device__ __forceinline__ void operator()(const pg8::f32x4 (&acc)[2][2][4][2], const pg8::Unit& u, int wr, int wc, int fr, int fq) const {
        const int type = u.pn >> 3;
        const int row0 = u.pm * 256 + wr * 64 + fr, col0 = (u.pn & 7) * 256 + wc * 32 + 8 * fq;
        if (type == 1) {
#pragma unroll
            for (int bj = 0; bj < 2; ++bj) {
                const int c = col0 + bj * 128;
                const f32x4 lb0 = *(const f32x4*)(LB + c), lb1 = *(const f32x4*)(LB + c + 4);
#pragma unroll
                for (int ai = 0; ai < 2; ++ai)
#pragma unroll
                    for (int m = 0; m < 4; ++m) {
                        float* p = LF + (size_t)(row0 + ai * 128 + m * 16) * DM + c;
                        f32x4 o0, o1;
#pragma unroll
                        for (int j = 0; j < 4; ++j) {
                            o0[j] = __logf(lb0[j] + (1.0f - lb0[j]) * sigmoidf_(acc[ai][bj][m][0][j]));
                            o1[j] = __logf(lb1[j] + (1.0f - lb1[j]) * sigmoidf_(acc[ai][bj][m][1][j]));
                        }
                        *(f32x4*)p = o0; *(f32x4*)(p + 4) = o1;
                    }
            }
        } else {
            bf16_t* dst = Q1 + (size_t)(type - (type > 0 ? 1 : 0)) * ((size_t)32 << 20);
            const bool act = (type != 2);
#pragma unroll
            for (int ai = 0; ai < 2; ++ai)
#pragma unroll
                for (int m = 0; m < 4; ++m)
#pragma unroll
                    for (int bj = 0; bj < 2; ++bj) {
                        f32x4 v0 = acc[ai][bj][m][0], v1 = acc[ai][bj][m][1];
                        if (act) {
#pragma unroll
                            for (int j = 0; j < 4; ++j) { v0[j] = v0[j] * sigmoidf_(v0[j]); v1[j] = v1[j] * sigmoidf_(v1[j]); }
                        }
                        u32x4 w; w.x = pk_bf16(v0[0], v0[1]); w.y = pk_bf16(v0[2], v0[3]); w.z = pk_bf16(v1[0], v1[1]); w.w = pk_bf16(v1[2], v1[3]);
                        *(u32x4*)(dst + (size_t)(row0 + ai * 128 + m * 16) * DM + col0 + bj * 128) = w;
                    }
        }
    }
};
struct EpiRes {
    static constexpr bool PERM = false, AFTER_DRAIN = false;
    const float* res; float* Y;
    __device__ __forceinline__ void operator()(const pg8::f32x4 (&acc)[2][2][4][2], const pg8::Unit& u, int wr, int wc, int fr, int fq) const {
        const int row0 = u.pm * 256 + wr * 64 + fr, col0 = u.pn * 256 + wc * 32 + 4 * fq;
#pragma unroll
        for (int ai = 0; ai < 2; ++ai)
#pragma unroll
            for (int m = 0; m < 4; ++m) {
                const size_t off = (size_t)(row0 + ai * 128 + m * 16) * DM + col0;
#pragma unroll
                for (int bj = 0; bj < 2; ++bj)
#pragma unroll
                    for (int n = 0; n < 2; ++n) {
                        const f32x4 r = *(const f32x4*)(res + off + bj * 128 + n * 16);
                        *(f32x4*)(Y + off + bj * 128 + n * 16) = r * ALPHA + acc[ai][bj][m][n];
                    }
            }
    }
};
struct EpiF32 {
    static constexpr bool PERM = false, AFTER_DRAIN = false;
    float* C; int ldc;
    __device__ __forceinline__ void operator()(const pg8::f32x4 (&acc)[2][2][4][2], const pg8::Unit& u, int wr, int wc, int fr, int fq) const {
        const int row0 = u.pm * 256 + wr * 64 + fr, col0 = u.pn * 256 + wc * 32 + 4 * fq;
#pragma unroll
        for (int ai = 0; ai < 2; ++ai)
#pragma unroll
            for (int m = 0; m < 4; ++m) {
                float* p = C + (size_t)(row0 + ai * 128 + m * 16) * ldc + col0;
#pragma unroll
                for (int bj = 0; bj < 2; ++bj)
#pragma unroll
                    for (int n = 0; n < 2; ++n) *(f32x4*)(p + bj * 128 + n * 16) = acc[ai][bj][m][n];
            }
    }
};
struct EpiKVQ {
    static constexpr bool PERM = true, AFTER_DRAIN = false;
    bf16_t* K; bf16_t* V; bf16_t* Q;
    __device__ __forceinline__ void operator()(const pg8::f32x4 (&acc)[2][2][4][2], const pg8::Unit& u, int wr, int wc, int fr, int fq) const {
        const int t = u.pn >> 3;
        bf16_t* dst = K + (size_t)t * ((size_t)32 << 20);
        const int row0 = u.pm * 256 + wr * 64 + fr, col0 = (u.pn & 7) * 256 + wc * 32 + 8 * fq;
#pragma unroll
        for (int ai = 0; ai < 2; ++ai)
#pragma unroll
            for (int m = 0; m < 4; ++m)
#pragma unroll
                for (int bj = 0; bj < 2; ++bj) {
                    const f32x4 v0 = acc[ai][bj][m][0], v1 = acc[ai][bj][m][1];
                    u32x4 w; w.x = pk_bf16(v0[0], v0[1]); w.y = pk_bf16(v0[2], v0[3]); w.z = pk_bf16(v1[0], v1[1]); w.w = pk_bf16(v1[2], v1[3]);
                    *(u32x4*)(dst + (size_t)(row0 + ai * 128 + m * 16) * DM + col0 + bj * 128) = w;
                }
    }
};

__device__ __forceinline__ void transpose_tiles(LAS float* tile, const float* src, int ldn, int K, int N, bf16_t* dst) {
    const int tid = threadIdx.x;
    const int tn = N / 64, ntiles = tn * (K / 64);
    for (int tI = blockIdx.x; tI < ntiles; tI += gridDim.x) {
        const int k0 = (tI / tn) * 64, n0 = (tI % tn) * 64;
#pragma unroll
        for (int r = 0; r < 2; ++r) {
            const int kk = (tid >> 4) + 32 * r, nn = (tid & 15) * 4;
            const f32x4 v = *(const f32x4*)(src + (size_t)(k0 + kk) * ldn + n0 + nn);
            tile[kk * 65 + nn + 0] = v[0]; tile[kk * 65 + nn + 1] = v[1]; tile[kk * 65 + nn + 2] = v[2]; tile[kk * 65 + nn + 3] = v[3];
        }
        __syncthreads();
        {
            const int nn = tid >> 3, kk8 = (tid & 7) * 8;
            float f[8];
#pragma unroll
            for (int j = 0; j < 8; ++j) f[j] = tile[(kk8 + j) * 65 + nn];
            u32x4 w; w.x = pk_bf16(f[0], f[1]); w.y = pk_bf16(f[2], f[3]); w.z = pk_bf16(f[4], f[5]); w.w = pk_bf16(f[6], f[7]);
            *(u32x4*)(dst + (size_t)(n0 + nn) * K + k0 + kk8) = w;
        }
        __syncthreads();
    }
}
__device__ __forceinline__ void convert_bf16(const float* src, bf16_t* dst, size_t n) {
    const size_t stride = (size_t)gridDim.x * 512 * 8;
    for (size_t i = ((size_t)blockIdx.x * 512 + threadIdx.x) * 8; i < n; i += stride) {
        const f32x4 a = *(const f32x4*)(src + i), b = *(const f32x4*)(src + i + 4);
        u32x4 w; w.x = pk_bf16(a[0], a[1]); w.y = pk_bf16(a[2], a[3]); w.z = pk_bf16(b[0], b[1]); w.w = pk_bf16(b[2], b[3]);
        *(u32x4*)(dst + i) = w;
    }
}
__device__ __forceinline__ void fold_peer_keys(LAS float* lds, const float* w_query, const float* sub_keys, bf16_t* WcT) {
    const int tid = threadIdx.x;
    LAS float* Ss = lds;
    LAS float* Ws = lds + 128 * 132;
    for (int item = blockIdx.x; item < 1024; item += gridDim.x) {
        const int l = item >> 9, rem = item & 511, hh = rem >> 5, kb = rem & 31, h = hh >> 1, half = hh & 1;
        const float* sk = sub_keys + (size_t)(((l * 2 + half) * 8 + h) * 128) * 128;
        const float* wq = w_query + (size_t)l * DM * DM + (size_t)(kb * 64) * DM + h * 256 + half * 128;
#pragma unroll
        for (int r = 0; r < 8; ++r) { const int idx = tid + 512 * r, key = idx >> 5, d4 = (idx & 31) * 4; *(LAS f32x4*)(Ss + key * 132 + d4) = *(const f32x4*)(sk + key * 128 + d4); }
#pragma unroll
        for (int r = 0; r < 4; ++r) { const int idx = tid + 512 * r, kin = idx >> 5, d4 = (idx & 31) * 4; *(LAS f32x4*)(Ws + kin * 128 + d4) = *(const f32x4*)(wq + (size_t)kin * DM + d4); }
        __syncthreads();
        const int key = tid & 127, kq = tid >> 7;
        float acc[16];
#pragma unroll
        for (int j = 0; j < 16; ++j) acc[j] = 0.f;
        for (int d4 = 0; d4 < 32; ++d4) {
            const f32x4 s4 = *(const LAS f32x4*)(Ss + key * 132 + d4 * 4);
#pragma unroll
            for (int j = 0; j < 16; ++j) { const f32x4 w4 = *(const LAS f32x4*)(Ws + (kq * 16 + j) * 128 + d4 * 4); acc[j] += s4[0] * w4[0] + s4[1] * w4[1] + s4[2] * w4[2] + s4[3] * w4[3]; }
        }
        bf16_t* o = WcT + (size_t)l * DM * DM + (size_t)(h * 256 + half * 128 + key) * DM + kb * 64 + kq * 16;
        u32x4 w0, w1;
        w0.x = pk_bf16(acc[0], acc[1]); w0.y = pk_bf16(acc[2], acc[3]); w0.z = pk_bf16(acc[4], acc[5]); w0.w = pk_bf16(acc[6], acc[7]);
        w1.x = pk_bf16(acc[8], acc[9]); w1.y = pk_bf16(acc[10], acc[11]); w1.z = pk_bf16(acc[12], acc[13]); w1.w = pk_bf16(acc[14], acc[15]);
        *(u32x4*)o = w0; *(u32x4*)(o + 8) = w1;
        __syncthreads();
    }
}

__device__ __forceinline__ void quant_rows(const float* src, unsigned char* dst, float* scl, int nrows) {
    const int lane = threadIdx.x & 63, gw = blockIdx.x * 8 + (threadIdx.x >> 6), nw = gridDim.x * 8;
    for (int row = gw; row < nrows; row += nw) {
        const float* p = src + (size_t)row * DM;
        f32x4 v[8];
#pragma unroll
        for (int i = 0; i < 2; ++i)
#pragma unroll
            for (int q = 0; q < 4; ++q) v[i * 4 + q] = *(const f32x4*)(p + 1024 * i + 16 * lane + 4 * q);
        float am = 0.f;
#pragma unroll
        for (int i = 0; i < 8; ++i) am = fmaxf(am, fmaxf(fmaxf(fabsf(v[i][0]), fabsf(v[i][1])), fmaxf(fabsf(v[i][2]), fabsf(v[i][3]))));
        am = fmaxf(wave_max(am), 1e-30f);
        const float inv = 127.0f / am;
        if (lane == 0) scl[row] = am * (1.0f / 127.0f);
#pragma unroll
        for (int i = 0; i < 2; ++i) {
            u32x4 w;
#pragma unroll
            for (int q = 0; q < 4; ++q) {
                const f32x4 t = v[i * 4 + q];
                const unsigned b0 = (unsigned)(int)(rintf(t[0] * inv) + 128.0f), b1 = (unsigned)(int)(rintf(t[1] * inv) + 128.0f), b2 = (unsigned)(int)(rintf(t[2] * inv) + 128.0f), b3 = (unsigned)(int)(rintf(t[3] * inv) + 128.0f);
                w[q] = b0 | (b1 << 8) | (b2 << 16) | (b3 << 24);
            }
            *(u32x4*)(dst + (size_t)row * DM + 1024 * i + 16 * lane) = w;
        }
    }
}
__device__ __forceinline__ void phase_prep(const Args& a, LAS unsigned char* lds) {
    unsigned char* ws = a.ws;
    LAS float* tile = (LAS float*)lds;
    transpose_tiles(tile, a.in[1], 4 * DM, DM, 4 * DM, (bf16_t*)(ws + WS_WIN));
    transpose_tiles(tile, a.in[3], DM, DM, DM, (bf16_t*)(ws + WS_WOUT));
    transpose_tiles(tile, a.in[5], 2 * DM, DM, 2 * DM, (bf16_t*)(ws + WS_WKVQ));
    transpose_tiles(tile, a.in[6], DM, DM, DM, (bf16_t*)(ws + WS_WKVQ) + (size_t)2 * DM * DM);
    transpose_tiles(tile, a.in[7], DM, DM, DM, (bf16_t*)(ws + WS_WO));
    fold_peer_keys((LAS float*)lds, a.in[8], a.in[9], (bf16_t*)(ws + WS_WC));
    convert_bf16(a.in[0], (bf16_t*)(ws + slot(0)), (size_t)MTOK * DM);
    quant_rows(a.in[10], ws + WS_UB, (float*)(ws + WS_USC), 2 * 16384);
    quant_rows(a.in[11], ws + WS_VB, (float*)(ws + WS_VSC), 2 * 16384);
    const int gtid = blockIdx.x * 512 + threadIdx.x, gthreads = gridDim.x * 512;
    float* COS = (float*)(ws + WS_COS); float* SIN = (float*)(ws + WS_SIN); float* LB = (float*)(ws + WS_LB);
    for (int i = gtid; i < SEQ * 64; i += gthreads) {
        const int pos = i >> 6, j = i & 63;
        double inv = 1.0; const double r = 0.86596432336006535;
        for (int q = 0; q < j; ++q) inv *= r;
        const float ang = (float)pos * (float)inv;
        const double x = (double)ang;
        const double n = __builtin_rint(x * 0.15915494309189535);
        const float rf = (float)__builtin_fma(-n, 6.283185307179586, x);
        COS[i] = cosf(rf); SIN[i] = sinf(rf);
    }
    for (int c = gtid; c < DM; c += gthreads) { const float l0 = a.in[4][c], l1 = a.in[4][DM + c]; LB[c] = 1.0f / (1.0f + expf(l1 - l0)); }
}

__device__ __forceinline__ void phase_scan_naive(const bf16_t* Q1, const float* LF, const bf16_t* I1, float* O) {
    const int lane = threadIdx.x & 63, gw = blockIdx.x * 8 + (threadIdx.x >> 6), nw = gridDim.x * 8;
    for (int item = gw; item < 2 * NHEAD * 128; item += nw) {
        const int bh = item >> 7, v = item & 127, b = bh >> 4, h = bh & 15;
        const size_t base = (size_t)b * SEQ * DM + h * 128;
        float S0 = 0.f, S1 = 0.f;
#pragma unroll 4
        for (int t = 0; t < SEQ; ++t) {
            const size_t ro = base + (size_t)t * DM;
            const float f0 = __expf(LF[ro + lane]), f1 = __expf(LF[ro + 64 + lane]);
            const float q0 = bf2f(Q1[ro + lane]), q1 = bf2f(Q1[ro + 64 + lane]);
            const float iv = bf2f(I1[ro + v]);
            S0 = f0 * S0 + (1.0f - f0) * iv; S1 = f1 * S1 + (1.0f - f1) * iv;
            const float p = wave_sum(q0 * S0 + q1 * S1);
            if (lane == 0) O[ro + v] = p;
        }
    }
}
__device__ __forceinline__ void phase_onorm(const float* O, const bf16_t* G1, const float* gnorm, bf16_t* OG) {
    const int lane = threadIdx.x & 63, gw = blockIdx.x * 8 + (threadIdx.x >> 6), nw = gridDim.x * 8;
    const float gn0 = gnorm[2 * lane], gn1 = gnorm[2 * lane + 1];
    for (int item = gw; item < MTOK * NHEAD; item += nw) {
        const size_t off = (size_t)item * 128 + 2 * lane;
        const float o0 = O[off], o1 = O[off + 1];
        const float ss = wave_sum(o0 * o0 + o1 * o1);
        const float r = rsqrtf(ss * (1.0f / 128.0f) + 1e-6f);
        const unsigned g = *(const unsigned*)(G1 + off);
        *(unsigned*)(OG + off) = pk_bf16(o0 * r * gn0 * bflo(g), o1 * r * gn1 * bfhi(g));
    }
}

__device__ __forceinline__ void ln_row_store(float (&v)[32], const float* g, const float* bta, float* outf, bf16_t* outb, int lane) {
    float s = 0.f;
#pragma unroll
    for (int i = 0; i < 32; ++i) s += v[i];
    const float mu = wave_sum(s) * (1.0f / DM);
    float q = 0.f;
#pragma unroll
    for (int i = 0; i < 32; ++i) { v[i] -= mu; q += v[i] * v[i]; }
    const float rstd = rsqrtf(wave_sum(q) * (1.0f / DM) + 1e-5f);
#pragma unroll
    for (int i = 0; i < 4; ++i) {
        const int c = 512 * i + 8 * lane;
        const f32x4 g0 = *(const f32x4*)(g + c), g1 = *(const f32x4*)(g + c + 4), b0 = *(const f32x4*)(bta + c), b1 = *(const f32x4*)(bta + c + 4);
        f32x4 o0, o1;
#pragma unroll
        for (int j = 0; j < 4; ++j) { o0[j] = v[i * 8 + j] * rstd * g0[j] + b0[j]; o1[j] = v[i * 8 + 4 + j] * rstd * g1[j] + b1[j]; }
        *(f32x4*)(outf + c) = o0; *(f32x4*)(outf + c + 4) = o1;
        if (outb) { u32x4 w; w.x = pk_bf16(o0[0], o0[1]); w.y = pk_bf16(o0[2], o0[3]); w.z = pk_bf16(o1[0], o1[1]); w.w = pk_bf16(o1[2], o1[3]); *(u32x4*)(outb + c) = w; }
    }
}
__device__ __forceinline__ void ln_row_store16(float (&v)[32], const float* g, const float* bta, float* outf, bf16_t* outb, int lane) {
    float s = 0.f;
#pragma unroll
    for (int i = 0; i < 32; ++i) s += v[i];
    const float mu = wave_sum(s) * (1.0f / DM);
    float q = 0.f;
#pragma unroll
    for (int i = 0; i < 32; ++i) { v[i] -= mu; q += v[i] * v[i]; }
    const float rstd = rsqrtf(wave_sum(q) * (1.0f / DM) + 1e-5f);
#pragma unroll
    for (int i = 0; i < 2; ++i) {
        const int c = 1024 * i + 16 * lane;
        f32x4 o[4];
#pragma unroll
        for (int qd = 0; qd < 4; ++qd) {
            const f32x4 gg = *(const f32x4*)(g + c + 4 * qd), bb = *(const f32x4*)(bta + c + 4 * qd);
#pragma unroll
            for (int j = 0; j < 4; ++j) o[qd][j] = v[16 * i + 4 * qd + j] * rstd * gg[j] + bb[j];
            *(f32x4*)(outf + c + 4 * qd) = o[qd];
        }
        if (outb) {
            u32x4 w0, w1;
            w0.x = pk_bf16(o[0][0], o[0][1]); w0.y = pk_bf16(o[0][2], o[0][3]); w0.z = pk_bf16(o[1][0], o[1][1]); w0.w = pk_bf16(o[1][2], o[1][3]);
            w1.x = pk_bf16(o[2][0], o[2][1]); w1.y = pk_bf16(o[2][2], o[2][3]); w1.z = pk_bf16(o[3][0], o[3][1]); w1.w = pk_bf16(o[3][2], o[3][3]);
            *(u32x4*)(outb + c) = w0; *(u32x4*)(outb + c + 8) = w1;
        }
    }
}
__device__ __forceinline__ void phase_ln(const float* Y, const float* g, const float* bta, float* outf, bf16_t* outb) {
    const int lane = threadIdx.x & 63, gw = blockIdx.x * 8 + (threadIdx.x >> 6), nw = gridDim.x * 8;
    for (int row = gw; row < MTOK; row += nw) {
        float v[32];
        const float* p = Y + (size_t)row * DM;
#pragma unroll
        for (int i = 0; i < 4; ++i) {
            const f32x4 a = *(const f32x4*)(p + 512 * i + 8 * lane), b = *(const f32x4*)(p + 512 * i + 8 * lane + 4);
#pragma unroll
            for (int j = 0; j < 4; ++j) { v[i * 8 + j] = a[j]; v[i * 8 + 4 + j] = b[j]; }
        }
        ln_row_store(v, g, bta, outf + (size_t)row * DM, outb ? outb + (size_t)row * DM : nullptr, lane);
    }
}

__device__ __forceinline__ void wave_argmax(float& v, int& idx) {
#pragma unroll
    for (int o = 32; o >= 1; o >>= 1) {
        const float ov = __shfl_xor(v, o); const int oi = __shfl_xor(idx, o);
        if (ov > v || (ov == v && oi < idx)) { v = ov; idx = oi; }
    }
}
__device__ __forceinline__ unsigned fkey(float x) { const unsigned u = __float_as_uint(x); return u ^ (unsigned)(((int)u >> 31) | 0x80000000); }
__device__ __forceinline__ float funkey(unsigned k) { const unsigned u = (k & 0x80000000u) ? (k ^ 0x80000000u) : ~k; return __uint_as_float(u); }
__device__ __forceinline__ void sort16_insert(unsigned (&r)[16], unsigned v) {
#pragma unroll
    for (int i = 0; i < 16; ++i) { const unsigned m = r[i] > v ? r[i] : v; v = r[i] > v ? v : r[i]; r[i] = m; }
}
__device__ __forceinline__ void phase_topk(LAS unsigned char* lds, const float* SCT, int* EID, float* GATE) {
    LAS unsigned char* ib = lds + threadIdx.x * 32;
    for (int item = blockIdx.x * 512 + threadIdx.x; item < MTOK * 8; item += gridDim.x * 512) {
        const int h = item >> 14, tok = item & (MTOK - 1);
        const float* p = SCT + (size_t)(h * 256) * MTOK + tok;
        unsigned r1[16], r2[16];
#pragma unroll
        for (int i = 0; i < 16; ++i) { r1[i] = 0u; r2[i] = 0u; }
#pragma unroll 8
        for (int e = 0; e < 128; ++e) {
            const float x1 = p[(size_t)e * MTOK], x2 = p[(size_t)(128 + e) * MTOK];
            sort16_insert(r1, (fkey(x1) & ~0x7Fu) | (unsigned)e);
            sort16_insert(r2, (fkey(x2) & ~0x7Fu) | (unsigned)e);
        }
        float v1[16], v2[16];
#pragma unroll
        for (int i = 0; i < 16; ++i) { v1[i] = funkey(r1[i] & ~0x7Fu); v2[i] = funkey(r2[i] & ~0x7Fu); ib[i] = (unsigned char)(r1[i] & 0x7Fu); ib[16 + i] = (unsigned char)(r2[i] & 0x7Fu); }
        unsigned r3[16];
#pragma unroll
        for (int i = 0; i < 16; ++i) r3[i] = 0u;
#pragma unroll
        for (int a = 0; a < 16; ++a)
#pragma unroll
            for (int bq = 0; bq < 16; ++bq)
                if ((a + 1) * (bq + 1) <= 16) sort16_insert(r3, (fkey(v1[a] + v2[bq]) & ~0xFFu) | (unsigned)(a * 16 + bq));
        const float mx = funkey(r3[0] & ~0xFFu);
        float ev[16]; float sum = 0.f;
#pragma unroll
        for (int i = 0; i < 16; ++i) { ev[i] = __expf(funkey(r3[i] & ~0xFFu) - mx); sum += ev[i]; }
        const float rs = 1.0f / sum;
        int eid[16];
#pragma unroll
        for (int i = 0; i < 16; ++i) { const unsigned f = r3[i] & 0xFFu; eid[i] = (int)ib[f >> 4] * 128 + (int)ib[16 + (f & 15u)]; }
        int* eo = EID + (size_t)tok * 128 + h * 16; float* go = GATE + (size_t)tok * 128 + h * 16;
#pragma unroll
        for (int q = 0; q < 4; ++q) {
            *(u32x4*)(eo + 4 * q) = (u32x4){(unsigned)eid[4 * q], (unsigned)eid[4 * q + 1], (unsigned)eid[4 * q + 2], (unsigned)eid[4 * q + 3]};
            *(f32x4*)(go + 4 * q) = (f32x4){ev[4 * q] * rs, ev[4 * q + 1] * rs, ev[4 * q + 2] * rs, ev[4 * q + 3] * rs};
        }
    }
}

__device__ __forceinline__ float gelu_erf(float x) { return 0.5f * x * (1.0f + erff(x * 0.70710678118654752f)); }
__device__ __forceinline__ float ub0(unsigned w) { return (float)(w & 0xffu); }
__device__ __forceinline__ float ub1(unsigned w) { return (float)((w >> 8) & 0xffu); }
__device__ __forceinline__ float ub2(unsigned w) { return (float)((w >> 16) & 0xffu); }
__device__ __forceinline__ float ub3(unsigned w) { return (float)(w >> 24); }
__device__ __forceinline__ void phase_peer(LAS unsigned char* lds, const float* X, const int* EID, const float* GATE, const unsigned char* U, const unsigned char* V, const float* USC, const float* VSC,
                                           const float* g, const float* bta, float* outf, bf16_t* outb) {
    const int lane = threadIdx.x & 63, wv = threadIdx.x >> 6, gw = blockIdx.x * 8 + wv, nw = gridDim.x * 8;
    LAS float* hb = (LAS float*)(lds + wv * 512);
    for (int tok = gw; tok < MTOK; tok += nw) {
        float x[32];
        const float* xp = X + (size_t)tok * DM;
#pragma unroll
        for (int i = 0; i < 2; ++i)
#pragma unroll
            for (int q = 0; q < 4; ++q) { const f32x4 t = *(const f32x4*)(xp + 1024 * i + 16 * lane + 4 * q); x[16 * i + 4 * q] = t[0]; x[16 * i + 4 * q + 1] = t[1]; x[16 * i + 4 * q + 2] = t[2]; x[16 * i + 4 * q + 3] = t[3]; }
        float sx = 0.f;
#pragma unroll
        for (int j = 0; j < 32; ++j) sx += x[j];
        const float d0 = -128.0f * sx;
        const int e0 = EID[(size_t)tok * 128 + lane], e1 = EID[(size_t)tok * 128 + 64 + lane];
        const float g0 = GATE[(size_t)tok * 128 + lane], g1 = GATE[(size_t)tok * 128 + 64 + lane];
        for (int bt = 0; bt < 16; ++bt) {
            float d[8];
#pragma unroll
            for (int r = 0; r < 8; ++r) {
                const int e = bt * 8 + r;
                const int idx = __builtin_amdgcn_readfirstlane(__shfl(bt < 8 ? e0 : e1, e & 63));
                const u32x4* up = (const u32x4*)(U + (size_t)idx * DM) + lane;
                float acc = d0;
#pragma unroll
                for (int i = 0; i < 2; ++i) {
                    const u32x4 w = up[i * 64];
                    acc += x[16 * i + 0] * ub0(w.x) + x[16 * i + 1] * ub1(w.x) + x[16 * i + 2] * ub2(w.x) + x[16 * i + 3] * ub3(w.x)
                         + x[16 * i + 4] * ub0(w.y) + x[16 * i + 5] * ub1(w.y) + x[16 * i + 6] * ub2(w.y) + x[16 * i + 7] * ub3(w.y)
                         + x[16 * i + 8] * ub0(w.z) + x[16 * i + 9] * ub1(w.z) + x[16 * i + 10] * ub2(w.z) + x[16 * i + 11] * ub3(w.z)
                         + x[16 * i + 12] * ub0(w.w) + x[16 * i + 13] * ub1(w.w) + x[16 * i + 14] * ub2(w.w) + x[16 * i + 15] * ub3(w.w);
                }
                d[r] = acc;
            }
            const bool b5 = lane & 32, b4 = lane & 16, b3 = lane & 8;
            float t4[4];
#pragma unroll
            for (int q = 0; q < 4; ++q) { const float keep = b5 ? d[4 + q] : d[q], send = b5 ? d[q] : d[4 + q]; t4[q] = keep + __shfl_xor(send, 32); }
            float t2[2];
#pragma unroll
            for (int q = 0; q < 2; ++q) { const float keep = b4 ? t4[2 + q] : t4[q], send = b4 ? t4[q] : t4[2 + q]; t2[q] = keep + __shfl_xor(send, 16); }
            float t1;
            { const float keep = b3 ? t2[1] : t2[0], send = b3 ? t2[0] : t2[1]; t1 = keep + __shfl_xor(send, 8); }
            t1 += __shfl_xor(t1, 4); t1 += __shfl_xor(t1, 2); t1 += __shfl_xor(t1, 1);
            if ((lane & 7) == 0) hb[bt * 8 + (lane >> 3 & 1) + 2 * (lane >> 4 & 1) + 4 * (lane >> 5 & 1)] = t1;
        }
        asm volatile("s_waitcnt lgkmcnt(0)" ::: "memory");
        const float h0 = hb[lane] * USC[e0], h1 = hb[64 + lane] * USC[e1];
        const float w0 = g0 * gelu_erf(h0) * VSC[e0], w1 = g1 * gelu_erf(h1) * VSC[e1];
        float wsum = wave_sum(w0 + w1);
        float y[32];
#pragma unroll
        for (int i = 0; i < 32; ++i) y[i] = 0.f;
#pragma unroll 8
        for (int e = 0; e < 128; ++e) {
            const int idx = __builtin_amdgcn_readfirstlane(__shfl(e < 64 ? e0 : e1, e & 63));
            const float wt = __shfl(e < 64 ? w0 : w1, e & 63);
            const u32x4* vp = (const u32x4*)(V + (size_t)idx * DM) + lane;
#pragma unroll
            for (int i = 0; i < 2; ++i) {
                const u32x4 w = vp[i * 64];
                y[16 * i + 0] += wt * ub0(w.x); y[16 * i + 1] += wt * ub1(w.x); y[16 * i + 2] += wt * ub2(w.x); y[16 * i + 3] += wt * ub3(w.x);
                y[16 * i + 4] += wt * ub0(w.y); y[16 * i + 5] += wt * ub1(w.y); y[16 * i + 6] += wt * ub2(w.y); y[16 * i + 7] += wt * ub3(w.y);
                y[16 * i + 8] += wt * ub0(w.z); y[16 * i + 9] += wt * ub1(w.z); y[16 * i + 10] += wt * ub2(w.z); y[16 * i + 11] += wt * ub3(w.z);
                y[16 * i + 12] += wt * ub0(w.w); y[16 * i + 13] += wt * ub1(w.w); y[16 * i + 14] += wt * ub2(w.w); y[16 * i + 15] += wt * ub3(w.w);
            }
        }
        const float corr = -128.0f * wsum;
#pragma unroll
        for (int i = 0; i < 32; ++i) y[i] = y[i] + corr + ALPHA * x[i];
        ln_row_store16(y, g, bta, outf + (size_t)tok * DM, outb ? outb + (size_t)tok * DM : nullptr, lane);
        asm volatile("s_waitcnt lgkmcnt(0)" ::: "memory");
    }
}

__device__ __forceinline__ void phase_rot(LAS float* red, bf16_t* KR, bf16_t* QR, const float* COS, const float* SIN, float* KMEAN, float* KNMAX) {
    const int tid = threadIdx.x, d = tid & 63, rg = tid >> 6;
    for (int item = blockIdx.x; item < 2 * NHEAD * 32; item += gridDim.x) {
        const int bh = item >> 5, j = item & 31, b = bh >> 4, h = bh & 15;
        float s1 = 0.f, s2 = 0.f, nmax = 0.f;
        for (int i = 0; i < 32; ++i) {
            const int pos = j * 256 + rg * 32 + i;
            const size_t off = ((size_t)b * SEQ + pos) * DM + h * 128 + d;
            const float c = COS[pos * 64 + d], s = SIN[pos * 64 + d];
            const float k1 = bf2f(KR[off]), k2 = bf2f(KR[off + 64]);
            const float o1 = k1 * c - k2 * s, o2 = k1 * s + k2 * c;
            s1 += o1; s2 += o2;
            nmax = fmaxf(nmax, wave_sum(o1 * o1 + o2 * o2));
            KR[off] = (bf16_t)(pk_bf16(o1, 0.f) & 0xffffu); KR[off + 64] = (bf16_t)(pk_bf16(o2, 0.f) & 0xffffu);
            const float q1 = bf2f(QR[off]), q2 = bf2f(QR[off + 64]);
            QR[off] = (bf16_t)(pk_bf16(q1 * c - q2 * s, 0.f) & 0xffffu); QR[off + 64] = (bf16_t)(pk_bf16(q1 * s + q2 * c, 0.f) & 0xffffu);
        }
        red[rg * 128 + d] = s1; red[rg * 128 + 64 + d] = s2;
        if (d == 0) red[1024 + rg] = nmax;
        __syncthreads();
        if (tid < 128) {
            float s = 0.f;
#pragma unroll
            for (int r = 0; r < 8; ++r) s += red[r * 128 + tid];
            KMEAN[(size_t)item * 128 + tid] = s * (1.0f / 256.0f);
        }
        if (tid == 0) {
            float m = 0.f;
#pragma unroll
            for (int r = 0; r < 8; ++r) m = fmaxf(m, red[1024 + r]);
            KNMAX[item] = sqrtf(m);
        }
        __syncthreads();
    }
}

__device__ __forceinline__ void top3_insert(float x, int m, float& v0, int& i0, float& v1, int& i1, float& v2, int& i2) {
    const bool c0 = x > v0 || (x == v0 && m < i0), c1 = x > v1 || (x == v1 && m < i1), c2 = x > v2 || (x == v2 && m < i2);
    v2 = c1 ? v1 : (c2 ? x : v2); i2 = c1 ? i1 : (c2 ? m : i2);
    v1 = c0 ? v0 : (c1 ? x : v1); i1 = c0 ? i0 : (c1 ? m : i1);
    v0 = c0 ? x : v0; i0 = c0 ? m : i0;
}
__device__ __forceinline__ void phase_sel(LAS unsigned char* lds, const bf16_t* QR, const float* KMEAN, unsigned short* SUB, int* CNT, int* ctr) {
    const int tid = threadIdx.x, lane = tid & 63, wv = tid >> 6, r32 = lane & 31, hh = lane >> 5;
    LAS unsigned short* bucket = (LAS unsigned short*)lds;
    LAS int* cnt = (LAS int*)(lds + 16384);
    const float NEG = -1e30f;
    if (blockIdx.x == 0 && tid == 0) *ctr = 0;
    for (int item = blockIdx.x; item < 2 * NHEAD * 32; item += gridDim.x) {
        const int bh = item >> 5, i = item & 31, b = bh >> 4, h = bh & 15;
        if (i == 0) continue;
        if (tid < 32) cnt[tid] = 0;
        __syncthreads();
        const float* kmp = KMEAN + ((size_t)bh * 32 + r32) * 128 + 8 * hh;
        const size_t tok = (size_t)b * SEQ + i * 256 + wv * 32 + r32;
        const bf16_t* qp = QR + tok * DM + h * 128 + 8 * hh;
        f32x16 S;
#pragma unroll
        for (int e = 0; e < 16; ++e) S[e] = 0.f;
#pragma unroll
        for (int s2 = 0; s2 < 8; ++s2) {
            const f32x4 ka = *(const f32x4*)(kmp + 16 * s2), kb = *(const f32x4*)(kmp + 16 * s2 + 4);
            const bf16x8 qf = *(const bf16x8*)(qp + 16 * s2);
            u32x4 hi, lo;
            hi.x = pk_bf16(ka[0], ka[1]); hi.y = pk_bf16(ka[2], ka[3]); hi.z = pk_bf16(kb[0], kb[1]); hi.w = pk_bf16(kb[2], kb[3]);
            lo.x = pk_bf16(ka[0] - bflo(hi.x), ka[1] - bfhi(hi.x)); lo.y = pk_bf16(ka[2] - bflo(hi.y), ka[3] - bfhi(hi.y));
            lo.z = pk_bf16(kb[0] - bflo(hi.z), kb[1] - bfhi(hi.z)); lo.w = pk_bf16(kb[2] - bflo(hi.w), kb[3] - bfhi(hi.w));
            S = __builtin_amdgcn_mfma_f32_32x32x16_bf16(__builtin_bit_cast(bf16x8, hi), qf, S, 0, 0, 0);
            S = __builtin_amdgcn_mfma_f32_32x32x16_bf16(__builtin_bit_cast(bf16x8, lo), qf, S, 0, 0, 0);
        }
        float v0 = -3e38f, v1 = -3e38f, v2 = -3e38f; int i0 = 99, i1 = 99, i2 = 99;
#pragma unroll
        for (int e = 0; e < 16; ++e) {
            const int m = (e & 3) + 8 * (e >> 2) + 4 * hh;
            const float x = m < i ? S[e] : NEG;
            top3_insert(x, m, v0, i0, v1, i1, v2, i2);
        }
        {
            const float pv0 = __shfl_xor(v0, 32), pv1 = __shfl_xor(v1, 32), pv2 = __shfl_xor(v2, 32);
            const int pi0 = __shfl_xor(i0, 32), pi1 = __shfl_xor(i1, 32), pi2 = __shfl_xor(i2, 32);
            top3_insert(pv0, pi0, v0, i0, v1, i1, v2, i2); top3_insert(pv1, pi1, v0, i0, v1, i1, v2, i2); top3_insert(pv2, pi2, v0, i0, v1, i1, v2, i2);
        }
        if (hh == 0) {
            const int tl = wv * 32 + r32;
            if (v0 > 0.5f * NEG) { const int p = __hip_atomic_fetch_add(cnt + i0, 1, __ATOMIC_RELAXED, __HIP_MEMORY_SCOPE_WORKGROUP); bucket[i0 * 256 + p] = (unsigned short)(tl | (0 << 8)); }
            if (v1 > 0.5f * NEG) { const int p = __hip_atomic_fetch_add(cnt + i1, 1, __ATOMIC_RELAXED, __HIP_MEMORY_SCOPE_WORKGROUP); bucket[i1 * 256 + p] = (unsigned short)(tl | (1 << 8)); }
            if (v2 > 0.5f * NEG) { const int p = __hip_atomic_fetch_add(cnt + i2, 1, __ATOMIC_RELAXED, __HIP_MEMORY_SCOPE_WORKGROUP); bucket[i2 * 256 + p] = (unsigned short)(tl | (2 << 8)); }
        }
        __syncthreads();
        for (int idx = tid; idx < 32 * 256; idx += 512) {
            const int j = idx >> 8, p = idx & 255;
            if (j < i && p < cnt[j]) SUB[(((size_t)bh * 32 + j) * 32 + i) * 256 + p] = bucket[idx];
        }
        if (tid < i) CNT[((size_t)bh * 32 + tid) * 32 + i] = cnt[tid];
        __syncthreads();
    }
}

__device__ __forceinline__ unsigned off_b(unsigned row, unsigned ch) { return 256u * row + 16u * (ch ^ (((row & 3u) << 2) | ((row >> 2) & 3u))); }
__device__ __forceinline__ unsigned pi32(unsigned m) { return (m & ~12u) | ((m & 4u) << 1) | ((m & 8u) >> 1); }
__device__ __forceinline__ bf16x8 tr_frag(LAS unsigned char* img, unsigned lane, unsigned c, unsigned ks) {
    const unsigned hh = lane >> 5, blk = (lane >> 4) & 1, q = (lane & 15) >> 2, p = lane & 3;
    const unsigned a0 = off_b(16 * ks + 8 * hh + q, 4 * c + 2 * blk + (p >> 1)) + 8 * (p & 1);
    const unsigned a1 = off_b(16 * ks + 8 * hh + 4 + q, 4 * c + 2 * blk + (p >> 1)) + 8 * (p & 1);
    const s16x4 lo = __builtin_amdgcn_ds_read_tr16_b64_v4i16((LAS s16x4*)(img + a0));
    const s16x4 hi = __builtin_amdgcn_ds_read_tr16_b64_v4i16((LAS s16x4*)(img + a1));
    bf16x8 r; r[0] = lo[0]; r[1] = lo[1]; r[2] = lo[2]; r[3] = lo[3]; r[4] = hi[0]; r[5] = hi[1]; r[6] = hi[2]; r[7] = hi[3];
    return r;
}
__device__ __forceinline__ void phase_att(LAS unsigned char* lds, const bf16_t* QR, const bf16_t* KR, const bf16_t* V, const float* KNMAX, const unsigned short* SUB, const int* CNT, int* ctr,
                                          bf16_t* P012, bf16_t* P3, float* LS) {
    const int tid = threadIdx.x, lane = tid & 63, wv = tid >> 6, r32 = lane & 31, hh = lane >> 5;
    LAS unsigned char* Kimg = lds;
    LAS unsigned char* Vimg = lds + 65536;
    LAS int* misc = (LAS int*)(lds + 131072);
    const float SCL2 = 0.08838834764831845f * 1.4426950408889634f;
    for (;;) {
        __syncthreads();
        if (tid == 0) misc[40] = __hip_atomic_fetch_add(ctr, 1, __ATOMIC_RELAXED, __HIP_MEMORY_SCOPE_AGENT);
        __syncthreads();
        const int item = misc[40];
        if (item >= 2 * NHEAD * 32) break;
        const int j = item >> 5, bh = item & 31, b = bh >> 4, h = bh & 15;
#pragma unroll
        for (int r = 0; r < 8; ++r) {
            const int idx = tid + 512 * r, row = idx >> 4, ch = idx & 15;
            const size_t g = ((size_t)b * SEQ + j * 256 + row) * DM + h * 128 + ch * 8;
            const u32x4 kv = *(const u32x4*)(KR + g), vv = *(const u32x4*)(V + g);
            *(LAS u32x4*)(Kimg + off_b(row, ch)) = kv; *(LAS u32x4*)(Vimg + off_b(row, ch)) = vv;
        }
        if (tid <= 32) { int pre = 0; for (int u = j + 1; u < tid; ++u) pre += CNT[((size_t)bh * 32 + j) * 32 + u]; misc[tid] = pre; }
        float kn = (lane < 32) ? KNMAX[bh * 32 + lane] : 0.f;
        kn = wave_max(kn);
        __syncthreads();
        const int total = misc[32], ntile = (256 + total + 31) >> 5;
        for (int tile = wv; tile < ntile; tile += 8) {
            const int gr = tile * 32 + r32;
            int pos, slot; bool valid = true;
            if (gr < 256) { pos = j * 256 + gr; slot = 3; }
            else {
                const int x = gr - 256; valid = x < total;
                int ii = j + 1;
                for (int u = j + 1; u < 32; ++u) if (misc[u] <= x) ii = u;
                if (valid) { const unsigned e = SUB[(((size_t)bh * 32 + j) * 32 + ii) * 256 + (x - misc[ii])]; pos = ii * 256 + (int)(e & 255u); slot = (int)(e >> 8); }
                else { pos = j * 256; slot = 3; }
            }
            const size_t tok = (size_t)b * SEQ + pos;
            bf16x8 qf[8];
            const bf16_t* qp = QR + tok * DM + h * 128 + 8 * hh;
#pragma unroll
            for (int s = 0; s < 8; ++s) qf[s] = *(const bf16x8*)(qp + 16 * s);
            float qn2 = 0.f;
#pragma unroll
            for (int s = 0; s < 8; ++s)
#pragma unroll
                for (int e = 0; e < 8; ++e) { const float f = bf2f((bf16_t)qf[s][e]); qn2 += f * f; }
            qn2 += __shfl_xor(qn2, 32);
            const float c2 = sqrtf(qn2) * kn * SCL2;
            f32x16 O[4];
#pragma unroll
            for (int dt = 0; dt < 4; ++dt)
#pragma unroll
                for (int e = 0; e < 16; ++e) O[dt][e] = 0.f;
            float l = 0.f;
            const bool own = tile < 8;
            const int kcn = own ? tile + 1 : 8;
            const unsigned krow = pi32((unsigned)r32);
            for (int kc = 0; kc < kcn; ++kc) {
                f32x16 S;
#pragma unroll
                for (int e = 0; e < 16; ++e) S[e] = 0.f;
#pragma unroll
                for (int s = 0; s < 8; ++s) {
                    const bf16x8 kf = *(const LAS bf16x8*)(Kimg + off_b(32 * kc + krow, 2 * s + hh));
                    S = __builtin_amdgcn_mfma_f32_32x32x16_bf16(kf, qf[s], S, 0, 0, 0);
                }
                float p[16];
#pragma unroll
                for (int e = 0; e < 16; ++e) {
                    const unsigned m = (e & 3) + 8 * (e >> 2) + 4 * hh;
                    const int key = j * 256 + 32 * kc + (int)pi32(m);
                    float pe = __builtin_amdgcn_exp2f(S[e] * SCL2 - c2);
                    if (own && key > pos) pe = 0.f;
                    p[e] = pe; l += pe;
                }
                u32x4 w0, w1;
                w0.x = pk_bf16(p[0], p[1]); w0.y = pk_bf16(p[2], p[3]); w0.z = pk_bf16(p[4], p[5]); w0.w = pk_bf16(p[6], p[7]);
                w1.x = pk_bf16(p[8], p[9]); w1.y = pk_bf16(p[10], p[11]); w1.z = pk_bf16(p[12], p[13]); w1.w = pk_bf16(p[14], p[15]);
                const bf16x8 pf0 = __builtin_bit_cast(bf16x8, w0), pf1 = __builtin_bit_cast(bf16x8, w1);
#pragma unroll
                for (int dt = 0; dt < 4; ++dt) {
                    const bf16x8 v0 = tr_frag(Vimg, lane, dt, 2 * kc), v1 = tr_frag(Vimg, lane, dt, 2 * kc + 1);
                    O[dt] = __builtin_amdgcn_mfma_f32_32x32x16_bf16(v0, pf0, O[dt], 0, 0, 0);
                    O[dt] = __builtin_amdgcn_mfma_f32_32x32x16_bf16(v1, pf1, O[dt], 0, 0, 0);
                }
            }
            l += __shfl_xor(l, 32);
            if (valid) {
                bf16_t* pl = (slot < 3 ? P012 + (size_t)slot * ((size_t)32 << 20) : P3) + (tok * NHEAD + h) * 128 + 4 * hh;
#pragma unroll
                for (int dt = 0; dt < 4; ++dt)
#pragma unroll
                    for (int g = 0; g < 4; ++g) {
                        u32x2 w; w.x = pk_bf16(O[dt][4 * g], O[dt][4 * g + 1]); w.y = pk_bf16(O[dt][4 * g + 2], O[dt][4 * g + 3]);
                        *(u32x2*)(pl + 32 * dt + 8 * g) = w;
                    }
                if (hh == 0) LS[(size_t)slot * MTOK * NHEAD + tok * NHEAD + h] = l;
            }
        }
    }
}
__device__ __forceinline__ void phase_comb(const bf16_t* P012, const bf16_t* P3, const float* LS, bf16_t* AO) {
    const size_t n = (size_t)MTOK * NHEAD * 16, stride = (size_t)gridDim.x * 512;
    for (size_t idx = (size_t)blockIdx.x * 512 + threadIdx.x; idx < n; idx += stride) {
        const size_t th = idx >> 4; const int ch = (int)(idx & 15);
        const int t = (int)((th >> 4) & (SEQ - 1)), blk = t >> 8, nsel = blk < 3 ? blk : 3;
        float acc[8];
        float l = LS[(size_t)3 * MTOK * NHEAD + th];
        { const u32x4 w = *(const u32x4*)(P3 + th * 128 + ch * 8);
          acc[0] = bflo(w.x); acc[1] = bfhi(w.x); acc[2] = bflo(w.y); acc[3] = bfhi(w.y); acc[4] = bflo(w.z); acc[5] = bfhi(w.z); acc[6] = bflo(w.w); acc[7] = bfhi(w.w); }
        for (int s = 0; s < nsel; ++s) {
            const u32x4 w = *(const u32x4*)(P012 + (size_t)s * ((size_t)32 << 20) + th * 128 + ch * 8);
            acc[0] += bflo(w.x); acc[1] += bfhi(w.x); acc[2] += bflo(w.y); acc[3] += bfhi(w.y); acc[4] += bflo(w.z); acc[5] += bfhi(w.z); acc[6] += bflo(w.w); acc[7] += bfhi(w.w);
            l += LS[(size_t)s * MTOK * NHEAD + th];
        }
        const float rl = 1.0f / l;
        u32x4 o; o.x = pk_bf16(acc[0] * rl, acc[1] * rl); o.y = pk_bf16(acc[2] * rl, acc[3] * rl); o.z = pk_bf16(acc[4] * rl, acc[5] * rl); o.w = pk_bf16(acc[6] * rl, acc[7] * rl);
        *(u32x4*)(AO + th * 128 + ch * 8) = o;
    }
}

__device__ __forceinline__ void phase_scan_a(LAS unsigned char* lds, const float* LF, const bf16_t* I1, bf16_t* LT, float* DEC, unsigned* dbgc = nullptr) {
    unsigned dbg_kt = 0, dbg_acc = 0;
    const int tid = threadIdx.x, lane = tid & 63, wv = tid >> 6, k = tid & 127, part = tid >> 7;
    LAS unsigned char* Iimg = lds; LAS unsigned char* KTimg = lds + 16384;
    LAS float* psum = (LAS float*)(lds + 32768);
    LAS unsigned char* Lst = lds + 36864;
#if SCAN_A_VALU == 2
    for (int item = blockIdx.x; item < 2 * NHEAD * 128; item += gridDim.x) {
        const int bh = item >> 7, c = item & 127, b = bh >> 4, h = bh & 15;
        const size_t tok0 = (size_t)b * SEQ + c * 64;
        for (int idx = tid; idx < 16384; idx += 512) {
            const int v = idx >> 7, kk = idx & 127;
            float g = 1.f, L = 0.f;
            for (int s2 = 63; s2 >= 0; --s2) { const size_t o = (tok0 + s2) * DM + h * 128; const float f = __expf(LF[o + kk]); L += bf2f(I1[o + v]) * (1.0f - f) * g; g *= f; }
            LT[(size_t)item * 16384 + idx] = (bf16_t)(pk_bf16(L, 0.f) & 0xffffu);
        }
    }
    return;
#endif
    for (int item = blockIdx.x; item < 2 * NHEAD * 128; item += gridDim.x) {
        const int bh = item >> 7, c = item & 127, b = bh >> 4, h = bh & 15;
        const size_t tok0 = (size_t)b * SEQ + c * 64;
        float lf[16];
#pragma unroll
        for (int i = 0; i < 16; ++i) lf[i] = LF[(tok0 + 16 * part + i) * DM + h * 128 + k];
#pragma unroll
        for (int r = 0; r < 2; ++r) { const int idx = tid + 512 * r, row = idx >> 4, ch = idx & 15; *(LAS u32x4*)(Iimg + off_b(row, ch)) = *(const u32x4*)(I1 + (tok0 + row) * DM + h * 128 + ch * 8); }
        float cs = 0.f;
#pragma unroll
        for (int i = 0; i < 16; ++i) cs += lf[i];
        psum[part * 128 + k] = cs;
        __syncthreads();
        const float p0 = psum[k], p1 = psum[128 + k], p2 = psum[256 + k], p3 = psum[384 + k];
        const float blast = (p0 + p1) + (p2 + p3);
        float bb = part == 0 ? 0.f : (part == 1 ? p0 : (part == 2 ? p0 + p1 : p0 + p1 + p2));
#pragma unroll
        for (int i = 0; i < 16; ++i) {
            bb += lf[i];
            const float kt = (1.0f - __expf(lf[i])) * __expf(blast - bb);
            if (!(kt - kt == 0.f)) ++dbg_kt;
            const int srow = 16 * part + i;
            *(LAS bf16_t*)(KTimg + off_b(srow, k >> 3) + 2 * (k & 7)) = (bf16_t)(pk_bf16(kt, 0.f) & 0xffffu);
        }
        if (part == 0) DEC[(size_t)item * 128 + k] = __expf(blast);
        __syncthreads();
#if SCAN_A_VALU
        for (int idx = tid; idx < 16384; idx += 512) {
            const int v = idx >> 7, kk = idx & 127;
            float accv = 0.f;
            for (int s2 = 0; s2 < 64; ++s2) accv += bf2f(*(const LAS bf16_t*)(Iimg + off_b(s2, v >> 3) + 2 * (v & 7))) * bf2f(*(const LAS bf16_t*)(KTimg + off_b(s2, kk >> 3) + 2 * (kk & 7)));
            *(LAS bf16_t*)(Lst + v * 272 + 2 * kk) = (bf16_t)(pk_bf16(accv, 0.f) & 0xffffu);
        }
        if (0)
#endif
        {
            const int vt = wv >> 1;
            f32x16 acc0, acc1;
#pragma unroll
            for (int e = 0; e < 16; ++e) { acc0[e] = 0.f; acc1[e] = 0.f; }
#pragma unroll
            for (int ks = 0; ks < 4; ++ks) {
                const bf16x8 af = tr_frag(Iimg, lane, vt, ks);
                const bf16x8 b0 = tr_frag(KTimg, lane, 2 * (wv & 1), ks), b1 = tr_frag(KTimg, lane, 2 * (wv & 1) + 1, ks);
                acc0 = __builtin_amdgcn_mfma_f32_32x32x16_bf16(af, b0, acc0, 0, 0, 0);
                acc1 = __builtin_amdgcn_mfma_f32_32x32x16_bf16(af, b1, acc1, 0, 0, 0);
            }
            const int r32 = lane & 31, hh = lane >> 5;
#pragma unroll
            for (int e = 0; e < 16; ++e) {
                if (!(acc0[e] - acc0[e] == 0.f)) ++dbg_acc; if (!(acc1[e] - acc1[e] == 0.f)) ++dbg_acc;
                const int v = 32 * vt + (e & 3) + 8 * (e >> 2) + 4 * hh;
                *(LAS bf16_t*)(Lst + v * 272 + 2 * (64 * (wv & 1) + r32)) = (bf16_t)(pk_bf16(acc0[e], 0.f) & 0xffffu);
                *(LAS bf16_t*)(Lst + v * 272 + 2 * (64 * (wv & 1) + 32 + r32)) = (bf16_t)(pk_bf16(acc1[e], 0.f) & 0xffffu);
            }
        }
        __syncthreads();
#pragma unroll
        for (int r = 0; r < 4; ++r) { const int idx = tid + 512 * r, row = idx >> 4, ch = idx & 15; store_wt16(LT + (size_t)item * 16384 + row * 128 + ch * 8, *(const LAS u32x4*)(Lst + row * 272 + ch * 16)); }
        __syncthreads();
    }
    if (dbgc) { if (dbg_kt) atomicAdd(dbgc + 0, dbg_kt); if (dbg_acc) atomicAdd(dbgc + 1, dbg_acc); }
}
__device__ __forceinline__ void phase_scan_b(bf16_t* LT, const float* DEC) {
    const int n = 2 * NHEAD * 128 * 32;
    for (int idx = blockIdx.x * 512 + threadIdx.x; idx < n; idx += gridDim.x * 512) {
        const int bh = idx >> 12, vk = idx & 4095, k4 = (vk & 31) * 4;
        float S0 = 0.f, S1 = 0.f, S2 = 0.f, S3 = 0.f;
        bf16_t* p = LT + (size_t)bh * 128 * 16384 + (size_t)vk * 4;
        const float* dp = DEC + (size_t)bh * 128 * 128 + k4;
#pragma unroll 8
        for (int c = 0; c < 128; ++c) {
            const u32x2 w = *(const u32x2*)(p + (size_t)c * 16384);
            const f32x4 d = *(const f32x4*)(dp + c * 128);
            u32x2 o; o.x = pk_bf16(S0, S1); o.y = pk_bf16(S2, S3);
            store_wt8(p + (size_t)c * 16384, o);
            S0 = d[0] * S0 + bflo(w.x); S1 = d[1] * S1 + bfhi(w.x); S2 = d[2] * S2 + bflo(w.y); S3 = d[3] * S3 + bfhi(w.y);
        }
    }
}
__device__ __forceinline__ void phase_scan_c(LAS unsigned char* lds, const bf16_t* Q1, const float* LF, const bf16_t* I1, const bf16_t* G1, const bf16_t* SP, const float* gnorm, bf16_t* OG) {
    const int tid = threadIdx.x, lane = tid & 63, wv = tid >> 6, k = tid & 127, part = tid >> 7, r32 = lane & 31, hh = lane >> 5;
    LAS unsigned char* QTimg = lds; LAS unsigned char* QPimg = lds + 16384; LAS unsigned char* KPimg = lds + 32768; LAS unsigned char* Iimg = lds + 49152; LAS unsigned char* SPimg = lds + 65536;
    LAS float* psum = (LAS float*)(lds + 98304);
    LAS float* ssq = (LAS float*)(lds + 100352);
    LAS unsigned char* OT = lds + 102400;
    for (int item = blockIdx.x; item < 2 * NHEAD * 128; item += gridDim.x) {
        const int bh = item >> 7, c = item & 127, b = bh >> 4, h = bh & 15;
        const size_t tok0 = (size_t)b * SEQ + c * 64;
        float lf[16], qv[16];
#pragma unroll
        for (int i = 0; i < 16; ++i) { const size_t o = (tok0 + 16 * part + i) * DM + h * 128 + k; lf[i] = LF[o]; qv[i] = bf2f(Q1[o]); }
#pragma unroll
        for (int r = 0; r < 2; ++r) { const int idx = tid + 512 * r, row = idx >> 4, ch = idx & 15; *(LAS u32x4*)(Iimg + off_b(row, ch)) = *(const u32x4*)(I1 + (tok0 + row) * DM + h * 128 + ch * 8); }
#pragma unroll
        for (int r = 0; r < 4; ++r) { const int idx = tid + 512 * r, row = idx >> 4, ch = idx & 15; *(LAS u32x4*)(SPimg + off_b(row, ch)) = *(const u32x4*)(SP + (size_t)item * 16384 + row * 128 + ch * 8); }
        float cs = 0.f;
#pragma unroll
        for (int i = 0; i < 16; ++i) cs += lf[i];
        psum[part * 128 + k] = cs;
        __syncthreads();
        const float p0 = psum[k], p1 = psum[128 + k], p2 = psum[256 + k];
        const float rr = p0 + p1;
        float bb = part == 0 ? 0.f : (part == 1 ? p0 : (part == 2 ? p0 + p1 : p0 + p1 + p2));
#pragma unroll
        for (int i = 0; i < 16; ++i) {
            bb += lf[i];
            const float qt = qv[i] * __expf(bb), qp = qv[i] * __expf(bb - rr), kp = (1.0f - __expf(lf[i])) * __expf(rr - bb);
            const unsigned o = off_b(16 * part + i, k >> 3) + 2 * (k & 7);
            *(LAS bf16_t*)(QTimg + o) = (bf16_t)(pk_bf16(qt, 0.f) & 0xffffu);
            *(LAS bf16_t*)(QPimg + o) = (bf16_t)(pk_bf16(qp, 0.f) & 0xffffu);
            *(LAS bf16_t*)(KPimg + o) = (bf16_t)(pk_bf16(kp, 0.f) & 0xffffu);
        }
        __syncthreads();
        const int tt = wv & 1, vt = wv >> 1;
        f32x16 O;
#pragma unroll
        for (int e = 0; e < 16; ++e) O[e] = 0.f;
#pragma unroll
        for (int ks = 0; ks < 8; ++ks) {
            const bf16x8 af = *(const LAS bf16x8*)(SPimg + off_b(32 * vt + r32, 2 * ks + hh));
            const bf16x8 bf = *(const LAS bf16x8*)(QTimg + off_b(32 * tt + r32, 2 * ks + hh));
            O = __builtin_amdgcn_mfma_f32_32x32x16_bf16(af, bf, O, 0, 0, 0);
        }
        const unsigned krow = pi32((unsigned)r32);
        for (int st = 0; st <= tt; ++st) {
            f32x16 S;
#pragma unroll
            for (int e = 0; e < 16; ++e) S[e] = 0.f;
#pragma unroll
            for (int ks = 0; ks < 8; ++ks) {
                const bf16x8 af = *(const LAS bf16x8*)(KPimg + off_b(32 * st + krow, 2 * ks + hh));
                const bf16x8 bf = *(const LAS bf16x8*)(QPimg + off_b(32 * tt + r32, 2 * ks + hh));
                S = __builtin_amdgcn_mfma_f32_32x32x16_bf16(af, bf, S, 0, 0, 0);
            }
            float p[16];
#pragma unroll
            for (int e = 0; e < 16; ++e) {
                const unsigned m = (e & 3) + 8 * (e >> 2) + 4 * hh;
                const int sidx = 32 * st + (int)pi32(m), tidx = 32 * tt + r32;
                p[e] = sidx <= tidx ? S[e] : 0.f;
            }
            u32x4 w0, w1;
            w0.x = pk_bf16(p[0], p[1]); w0.y = pk_bf16(p[2], p[3]); w0.z = pk_bf16(p[4], p[5]); w0.w = pk_bf16(p[6], p[7]);
            w1.x = pk_bf16(p[8], p[9]); w1.y = pk_bf16(p[10], p[11]); w1.z = pk_bf16(p[12], p[13]); w1.w = pk_bf16(p[14], p[15]);
            const bf16x8 pf0 = __builtin_bit_cast(bf16x8, w0), pf1 = __builtin_bit_cast(bf16x8, w1);
            const bf16x8 i0 = tr_frag(Iimg, lane, vt, 2 * st), i1 = tr_frag(Iimg, lane, vt, 2 * st + 1);
            O = __builtin_amdgcn_mfma_f32_32x32x16_bf16(i0, pf0, O, 0, 0, 0);
            O = __builtin_amdgcn_mfma_f32_32x32x16_bf16(i1, pf1, O, 0, 0, 0);
        }
        float sq = 0.f;
#pragma unroll
        for (int e = 0; e < 16; ++e) sq += O[e] * O[e];
        sq += __shfl_xor(sq, 32);
        if (hh == 0) ssq[vt * 64 + 32 * tt + r32] = sq;
        __syncthreads();
        const int tl = 32 * tt + r32;
        const float rstd = rsqrtf((ssq[tl] + ssq[64 + tl] + ssq[128 + tl] + ssq[192 + tl]) * (1.0f / 128.0f) + 1e-6f);
#pragma unroll
        for (int g = 0; g < 4; ++g) {
            const int v0 = 32 * vt + 8 * g + 4 * hh;
            const f32x4 gn = *(const f32x4*)(gnorm + v0);
            u32x2 w; w.x = pk_bf16(O[4 * g] * rstd * gn[0], O[4 * g + 1] * rstd * gn[1]); w.y = pk_bf16(O[4 * g + 2] * rstd * gn[2], O[4 * g + 3] * rstd * gn[3]);
            *(LAS u32x2*)(OT + tl * 272 + v0 * 2) = w;
        }
        __syncthreads();
#pragma unroll
        for (int r = 0; r < 2; ++r) {
            const int idx = tid + 512 * r, row = idx >> 4, ch = idx & 15;
            const u32x4 ov = *(const LAS u32x4*)(OT + row * 272 + ch * 16);
            const size_t go = (tok0 + row) * DM + h * 128 + ch * 8;
            const u32x4 gv = *(const u32x4*)(G1 + go);
            u32x4 w;
            w.x = pk_bf16(bflo(ov.x) * bflo(gv.x), bfhi(ov.x) * bfhi(gv.x)); w.y = pk_bf16(bflo(ov.y) * bflo(gv.y), bfhi(ov.y) * bfhi(gv.y));
            w.z = pk_bf16(bflo(ov.z) * bflo(gv.z), bfhi(ov.z) * bfhi(gv.z)); w.w = pk_bf16(bflo(ov.w) * bflo(gv.w), bfhi(ov.w) * bfhi(gv.w));
            *(u32x4*)(OG + go) = w;
        }
        __syncthreads();
    }
}


#if SCAN_DBG == 2
__device__ __forceinline__ void dbg_compare(LAS float* red, const bf16_t* A, const bf16_t* B, float* DBG) {
    float sd = 0.f, sr = 0.f, nn = 0.f;
    const size_t n = (size_t)MTOK * DM;
    for (size_t i = (size_t)blockIdx.x * 512 + threadIdx.x; i < n; i += (size_t)gridDim.x * 512) {
        const float x = bf2f(A[i]), y = bf2f(B[i]);
        if (!(x - x == 0.f)) nn += 1.f; else { sd += (x - y) * (x - y); sr += y * y; }
    }
    sd = wave_sum(sd); sr = wave_sum(sr); nn = wave_sum(nn);
    const int wv = threadIdx.x >> 6;
    if ((threadIdx.x & 63) == 0) { red[wv * 3] = sd; red[wv * 3 + 1] = sr; red[wv * 3 + 2] = nn; }
    __syncthreads();
    if (threadIdx.x == 0) { float a = 0, b = 0, c = 0; for (int w = 0; w < 8; ++w) { a += red[w * 3]; b += red[w * 3 + 1]; c += red[w * 3 + 2]; } DBG[blockIdx.x * 4] = a; DBG[blockIdx.x * 4 + 1] = b; DBG[blockIdx.x * 4 + 2] = c; }
    __syncthreads();
}
__device__ __forceinline__ void dbg_emit(const float* DBG, float* out) {
    float a = 0, b = 0, c = 0;
    for (int w = 0; w < (int)gridDim.x; ++w) { a += DBG[w * 4]; b += DBG[w * 4 + 1]; c += DBG[w * 4 + 2]; }
    const float rel = sqrtf(a / b);
    int k = (int)rintf(-2.0f * log10f(rel)); k = k < 0 ? 0 : (k > 16 ? 16 : k);
    if (c > 0.f) k = 17;
    const float cc = sqrtf(0.5f * (float)k);
    const size_t n = (size_t)MTOK * DM;
    for (size_t i = (size_t)blockIdx.x * 512 + threadIdx.x; i < n; i += (size_t)gridDim.x * 512) out[i] = cc;
}
#endif

#if SCAN_DBG == 3
__device__ __forceinline__ void dbg_count_bf16(const bf16_t* A, size_t n, unsigned* cnt) {
    unsigned c = 0;
    for (size_t i = (size_t)blockIdx.x * 512 + threadIdx.x; i < n; i += (size_t)gridDim.x * 512) { const float x = bf2f(A[i]); if (!(x - x == 0.f)) ++c; }
    if (c) atomicAdd(cnt, c);
}
__device__ __forceinline__ void dbg_count_f32(const float* A, size_t n, unsigned* cnt) {
    unsigned c = 0;
    for (size_t i = (size_t)blockIdx.x * 512 + threadIdx.x; i < n; i += (size_t)gridDim.x * 512) { const float x = A[i]; if (!(x - x == 0.f)) ++c; }
    if (c) atomicAdd(cnt, c);
}
__device__ __forceinline__ void dbg_emit3(const unsigned* cnt, float* out) {
    float code = 0.f;
    for (int st = 3; st >= 0; --st) { const unsigned c = cnt[st]; if (c) { float lg = log10f((float)c); lg = lg > 9.f ? 9.f : lg; code = (float)(st + 1) + 0.1f * lg; } }
    const float cc = sqrtf(code);
    const size_t n = (size_t)MTOK * DM;
    for (size_t i = (size_t)blockIdx.x * 512 + threadIdx.x; i < n; i += (size_t)gridDim.x * 512) out[i] = cc;
}
#endif

#if SCAN_DBG == 4 || SCAN_DBG == 6
__device__ __forceinline__ void dbg_compare4(LAS float* red, const bf16_t* A, const bf16_t* B, const bf16_t* C, float* DBG) {
    float sd = 0.f, sr = 0.f, nn = 0.f, mm = 0.f;
    const size_t n = (size_t)MTOK * DM;
    for (size_t i = (size_t)blockIdx.x * 512 + threadIdx.x; i < n; i += (size_t)gridDim.x * 512) {
        const float x = bf2f(A[i]), y = bf2f(B[i]);
        if (!(x - x == 0.f)) nn += 1.f; else { sd += (x - y) * (x - y); sr += y * y; }
        if (A[i] != C[i]) mm += 1.f;
    }
    sd = wave_sum(sd); sr = wave_sum(sr); nn = wave_sum(nn); mm = wave_sum(mm);
    const int wv = threadIdx.x >> 6;
    if ((threadIdx.x & 63) == 0) { red[wv * 4] = sd; red[wv * 4 + 1] = sr; red[wv * 4 + 2] = nn; red[wv * 4 + 3] = mm; }
    __syncthreads();
    if (threadIdx.x == 0) { float a = 0, b = 0, c = 0, d = 0; for (int w = 0; w < 8; ++w) { a += red[w * 4]; b += red[w * 4 + 1]; c += red[w * 4 + 2]; d += red[w * 4 + 3]; }
        DBG[blockIdx.x * 4] = a; DBG[blockIdx.x * 4 + 1] = b; DBG[blockIdx.x * 4 + 2] = c; DBG[blockIdx.x * 4 + 3] = d; }
    __syncthreads();
}
__device__ __forceinline__ void dbg_emit4(const float* DBG, float* out) {
    float a = 0, b = 0, c = 0, d = 0;
    for (int w = 0; w < (int)gridDim.x; ++w) { a += DBG[w * 4]; b += DBG[w * 4 + 1]; c += DBG[w * 4 + 2]; d += DBG[w * 4 + 3]; }
    const float rel = sqrtf(a / b);
    int k = (int)rintf(-log10f(rel)); k = k < 0 ? 0 : (k > 8 ? 8 : k);
#if SCAN_DBG == 6
    const float cc = sqrtf((float)k + ((d + c) > 0.f ? 0.5f : 0.f));
#else
    int m = (int)ceilf(log10f(1.0f + d + c)); m = m > 9 ? 9 : m;
    const float cc = sqrtf((float)k + 0.1f * (float)m);
#endif
    const size_t n = (size_t)MTOK * DM;
    for (size_t i = (size_t)blockIdx.x * 512 + threadIdx.x; i < n; i += (size_t)gridDim.x * 512) out[i] = cc;
}
#endif

#if SCAN_DBG == 5
__device__ __forceinline__ void dbg_lds16_test(LAS unsigned char* lds, unsigned* cnt) {
    const int tid = threadIdx.x;
    unsigned bad = 0;
    for (int rep = 0; rep < 64; ++rep) {
        for (int i = tid; i < 1024; i += 512) *(LAS u32x4*)(lds + i * 16) = (u32x4){0x7fc07fc0u, 0x7fc07fc0u, 0x7fc07fc0u, 0x7fc07fc0u};
        __syncthreads();
        const int k = tid & 127, part = tid >> 7;
#pragma unroll
        for (int i = 0; i < 16; ++i) {
            const int row = 16 * part + i;
            *(LAS bf16_t*)(lds + off_b(row, k >> 3) + 2 * (k & 7)) = (bf16_t)((row * 128 + k + rep) & 0x7fff);
        }
        __syncthreads();
        for (int idx = tid; idx < 64 * 128; idx += 512) {
            const int row = idx >> 7, kk = idx & 127;
            const bf16_t got = *(const LAS bf16_t*)(lds + off_b(row, kk >> 3) + 2 * (kk & 7));
            if (got != (bf16_t)((row * 128 + kk + rep) & 0x7fff)) ++bad;
        }
        __syncthreads();
    }
    if (bad) atomicAdd(cnt, bad);
}
__device__ __forceinline__ void dbg_emit5(const unsigned* cnt, float* out) {
    const unsigned c = cnt[0];
    float code = 0.f;
    if (c) { float lg = log10f((float)c); code = 1.0f + (lg > 8.9f ? 8.9f : lg); }
    const float cc = sqrtf(code);
    const size_t n = (size_t)MTOK * DM;
    for (size_t i = (size_t)blockIdx.x * 512 + threadIdx.x; i < n; i += (size_t)gridDim.x * 512) out[i] = cc;
}
#endif

#if SCAN_DBG == 6
__device__ __forceinline__ void dbg_check_a(LAS float* red, const float* LF, const bf16_t* I1, const bf16_t* LT, const bf16_t* LT2, float* DBG) {
    float sd = 0.f, sr = 0.f, mm = 0.f;
    const size_t n = (size_t)4096 * 16384;
    for (size_t i = (size_t)blockIdx.x * 512 + threadIdx.x; i < n; i += (size_t)gridDim.x * 512) {
        const int item = (int)(i >> 14), v = (int)((i >> 7) & 127), k = (int)(i & 127);
        const int bh = item >> 7, c = item & 127, b = bh >> 4, h = bh & 15;
        const size_t tok0 = (size_t)b * SEQ + c * 64;
        float g = 1.f, L = 0.f;
        for (int s2 = 63; s2 >= 0; --s2) {
            const size_t o = (tok0 + s2) * DM + h * 128;
            const float f = __expf(LF[o + k]);
            L += bf2f(I1[o + v]) * (1.0f - f) * g;
            g *= f;
        }
        const float x = bf2f(LT[i]);
        sd += (x - L) * (x - L); sr += L * L;
        if (LT[i] != LT2[i]) mm += 1.f;
    }
    sd = wave_sum(sd); sr = wave_sum(sr); mm = wave_sum(mm);
    const int wv = threadIdx.x >> 6;
    if ((threadIdx.x & 63) == 0) { red[wv * 4] = sd; red[wv * 4 + 1] = sr; red[wv * 4 + 2] = 0.f; red[wv * 4 + 3] = mm; }
    __syncthreads();
    if (threadIdx.x == 0) { float a = 0, b2 = 0, d = 0; for (int w = 0; w < 8; ++w) { a += red[w * 4]; b2 += red[w * 4 + 1]; d += red[w * 4 + 3]; }
        DBG[blockIdx.x * 4] = a; DBG[blockIdx.x * 4 + 1] = b2; DBG[blockIdx.x * 4 + 2] = 0.f; DBG[blockIdx.x * 4 + 3] = d; }
    __syncthreads();
}
#endif

#if SCAN_DBG == 7
#ifndef DBG_FAM
#define DBG_FAM 0
#endif
__device__ __forceinline__ void dbg_check_a7(const float* LF, const bf16_t* I1, const bf16_t* LT, float* DBG) {
    const size_t n = (size_t)4096 * 16384;
    float nbad = 0.f, nnf = 0.f;
    for (size_t i = (size_t)blockIdx.x * 512 + threadIdx.x; i < n; i += (size_t)gridDim.x * 512 * 8) {
        const int item = (int)(i >> 14), v = (int)((i >> 7) & 127), k = (int)(i & 127);
        const int bh = item >> 7, c = item & 127, b = bh >> 4, h = bh & 15;
        const size_t tok0 = (size_t)b * SEQ + c * 64;
        float g = 1.f, L = 0.f;
        for (int s2 = 63; s2 >= 0; --s2) {
            const size_t o = (tok0 + s2) * DM + h * 128;
            const float f = __expf(LF[o + k]);
            L += bf2f(I1[o + v]) * (1.0f - f) * g;
            g *= f;
        }
        const float x = bf2f(LT[i]);
        if (!(x - x == 0.f)) { nnf += 1.f; nbad += 1.f; }
        else if (fabsf(x - L) > 0.02f * fabsf(L) + 1e-2f) nbad += 1.f;
    }
    nbad = wave_sum(nbad); nnf = wave_sum(nnf);
    if ((threadIdx.x & 63) == 0) { atomicAdd(DBG, nbad); atomicAdd(DBG + 1, nnf); }
}
__device__ __forceinline__ void dbg_emit7(const float* DBG, float* out) {
    const float nb = DBG[0], nf = DBG[1];
    int A = nb == 0.f ? 0 : (nb <= 100.f ? 1 : (nb <= 1e4f ? 3 : (nb <= 1e6f ? 5 : 7)));
    int B = nf == 0.f ? 0 : 5;
    const float cc = sqrtf((float)A + 0.1f * (float)B);
    const size_t n = (size_t)MTOK * DM;
    for (size_t i = (size_t)blockIdx.x * 512 + threadIdx.x; i < n; i += (size_t)gridDim.x * 512) out[i] = cc;
}
#endif
__device__ __forceinline__ int opaque(int v) { asm volatile("" : "+s"(v)); return v; }
template <bool L1> __device__ __forceinline__ void run_gemm_out(const Args& a, LAS unsigned char* lds) {
    unsigned char* ws = a.ws;
    pg8::Gemm g{(const bf16_t*)(ws + (L1 ? slot(3) : slot(0))), (const bf16_t*)(ws + (L1 ? WS_WO : WS_WOUT)), opaque(MTOK), opaque(DM), opaque(DM)};
    pg8::StaticOrder S; S.init(g.M, g.N, (int)gridDim.x, (int)blockIdx.x);
    EpiRes E{L1 ? (const float*)(ws + slot(0)) : a.in[0], (float*)(ws + (L1 ? slot(4) : slot(1)))};
    pg8::gemm_phase<EpiRes, pg8::StaticOrder>(lds, g, S, E, nullptr);
}
template <bool L1> __device__ __forceinline__ void run_ln(const Args& a) {
    unsigned char* ws = a.ws;
    phase_ln((const float*)(ws + (L1 ? slot(4) : slot(1))), a.in[12] + (L1 ? 2 : 0) * DM, a.in[13] + (L1 ? 2 : 0) * DM,
             (float*)(ws + (L1 ? slot(6) : slot(3))), (bf16_t*)(ws + (L1 ? slot(8) : slot(5))));
}
template <bool L1> __device__ __forceinline__ void run_gemm_sc(const Args& a, LAS unsigned char* lds) {
    unsigned char* ws = a.ws;
    pg8::Gemm g{(const bf16_t*)(ws + WS_WC) + (L1 ? (size_t)DM * DM : 0), (const bf16_t*)(ws + (L1 ? slot(8) : slot(5))), opaque(DM), opaque(MTOK), opaque(DM)};
    pg8::StaticOrder S; S.init(g.M, g.N, (int)gridDim.x, (int)blockIdx.x);
    EpiF32 E{(float*)(ws + (L1 ? slot(0) : slot(6))), MTOK};
    pg8::gemm_phase<EpiF32, pg8::StaticOrder>(lds, g, S, E, nullptr);
}
template <bool L1> __device__ __forceinline__ void run_topk(const Args& a, LAS unsigned char* lds) {
    unsigned char* ws = a.ws;
    phase_topk(lds, (const float*)(ws + (L1 ? slot(0) : slot(6))), (int*)(ws + WS_EID), (float*)(ws + WS_GATE));
}
template <bool L1> __device__ __forceinline__ void run_peer(const Args& a, LAS unsigned char* lds) {
    unsigned char* ws = a.ws;
    phase_peer(lds, (const float*)(ws + (L1 ? slot(6) : slot(3))), (const int*)(ws + WS_EID), (const float*)(ws + WS_GATE),
               ws + WS_UB + (L1 ? (size_t)16384 * DM : 0), ws + WS_VB + (L1 ? (size_t)16384 * DM : 0),
               (const float*)(ws + WS_USC) + (L1 ? 16384 : 0), (const float*)(ws + WS_VSC) + (L1 ? 16384 : 0),
               a.in[12] + (L1 ? 3 : 1) * DM, a.in[13] + (L1 ? 3 : 1) * DM,
               L1 ? a.out : (float*)(ws + slot(0)), L1 ? (bf16_t*)nullptr : (bf16_t*)(ws + slot(2)));
}

__global__ void __launch_bounds__(512, 2) mk_fwd(Args a) {
    extern __shared__ __attribute__((aligned(16))) unsigned char lds_raw[];
    LAS unsigned char* lds = (LAS unsigned char*)lds_raw;
    cg::grid_group grid = cg::this_grid();
    unsigned char* ws = a.ws;
#define PHASE_BEGIN(k) if (a.ph_lo <= (k) && (k) < a.ph_hi && EN(k)) {
#define PHASE_END(k) asm volatile("s_waitcnt vmcnt(0)" ::: "memory"); __syncthreads(); if ((k) + 1 < a.ph_hi) { grid.sync(); if (threadIdx.x < 64) { __builtin_amdgcn_fence(__ATOMIC_ACQUIRE, "agent"); asm volatile("s_waitcnt vmcnt(0)" ::: "memory"); } __syncthreads(); } }
    PHASE_BEGIN(0) phase_prep(a, lds);
#if SCAN_DBG == 3 || SCAN_DBG == 5
        if (blockIdx.x == 0 && threadIdx.x < 8) ((unsigned*)(ws + WS_CTR + 8192))[threadIdx.x] = 0u;
#endif
#if SCAN_DBG == 7
        if (blockIdx.x == 0 && threadIdx.x < 32) ((float*)(ws + WS_CTR + 4096))[threadIdx.x] = 0.f;
#endif
    PHASE_END(0)
#if SCAN_DBG == 5
    PHASE_BEGIN(1) dbg_lds16_test(lds, (unsigned*)(ws + WS_CTR + 8192)); PHASE_END(1)
#define SKIP_REST 1
#endif
    PHASE_BEGIN(1) {
        pg8::Gemm g{(const bf16_t*)(ws + slot(0)), (const bf16_t*)(ws + WS_WIN), opaque(MTOK), opaque(4 * DM), opaque(DM)};
        pg8::StaticOrder S; S.init(g.M, g.N, (int)gridDim.x, (int)blockIdx.x);
        EpiIn E{(bf16_t*)(ws + slot(1)), (float*)(ws + slot(4)), (bf16_t*)(ws + slot(2)), (bf16_t*)(ws + slot(3)), (const float*)(ws + WS_LB)};
        pg8::gemm_phase<EpiIn, pg8::StaticOrder>(lds, g, S, E, nullptr);
    } PHASE_END(1)
    PHASE_BEGIN(2) phase_scan_a(lds, (const float*)(ws + slot(4)), (const bf16_t*)(ws + slot(2)), (bf16_t*)(ws + slot(6)), (float*)(ws + WS_DEC)
#if SCAN_DBG == 3
        , (unsigned*)(ws + WS_CTR + 8192)
#endif
        );
#if SCAN_DBG == 7
        asm volatile("s_waitcnt vmcnt(0)" ::: "memory"); __syncthreads(); grid.sync(); if (threadIdx.x < 64) { __builtin_amdgcn_fence(__ATOMIC_ACQUIRE, "agent"); asm volatile("s_waitcnt vmcnt(0)" ::: "memory"); } __syncthreads();
        dbg_check_a7((const float*)(ws + slot(4)), (const bf16_t*)(ws + slot(2)), (const bf16_t*)(ws + slot(6)), (float*)(ws + WS_CTR + 4096));
#endif
#if SCAN_DBG == 6
#define DSYNC6() asm volatile("s_waitcnt vmcnt(0)" ::: "memory"); __syncthreads(); grid.sync(); if (threadIdx.x < 64) { __builtin_amdgcn_fence(__ATOMIC_ACQUIRE, "agent"); asm volatile("s_waitcnt vmcnt(0)" ::: "memory"); } __syncthreads();
        DSYNC6()
        phase_scan_a(lds, (const float*)(ws + slot(4)), (const bf16_t*)(ws + slot(2)), (bf16_t*)a.out, (float*)(ws + WS_DEC));
        DSYNC6()
        dbg_check_a((LAS float*)lds, (const float*)(ws + slot(4)), (const bf16_t*)(ws + slot(2)), (const bf16_t*)(ws + slot(6)), (const bf16_t*)a.out, (float*)(ws + WS_CTR + 4096));
#endif
#if SCAN_DBG == 3
        asm volatile("s_waitcnt vmcnt(0)" ::: "memory"); __syncthreads(); grid.sync();
        dbg_count_bf16((const bf16_t*)(ws + slot(6)), (size_t)4096 * 16384, (unsigned*)(ws + WS_CTR + 8192) + 2);
#endif
    PHASE_END(2)
    PHASE_BEGIN(3) phase_scan_b((bf16_t*)(ws + slot(6)), (const float*)(ws + WS_DEC));
#if SCAN_DBG == 3
        asm volatile("s_waitcnt vmcnt(0)" ::: "memory"); __syncthreads(); grid.sync();

#endif
    PHASE_END(3)
    PHASE_BEGIN(4) phase_scan_c(lds, (const bf16_t*)(ws + slot(1)), (const float*)(ws + slot(4)), (const bf16_t*)(ws + slot(2)), (const bf16_t*)(ws + slot(3)), (const bf16_t*)(ws + slot(6)), a.in[2], (bf16_t*)(ws + slot(0)));
#if SCAN_DBG == 1
        asm volatile("s_waitcnt vmcnt(0)" ::: "memory"); __syncthreads(); grid.sync();
        phase_scan_naive((const bf16_t*)(ws + slot(1)), (const float*)(ws + slot(4)), (const bf16_t*)(ws + slot(2)), (float*)(ws + slot(6)));
        asm volatile("s_waitcnt vmcnt(0)" ::: "memory"); __syncthreads(); grid.sync();
        phase_onorm((const float*)(ws + slot(6)), (const bf16_t*)(ws + slot(3)), a.in[2], (bf16_t*)(ws + slot(0)));
#endif
#if SCAN_DBG == 3
        asm volatile("s_waitcnt vmcnt(0)" ::: "memory"); __syncthreads(); grid.sync();

#endif
#if SCAN_DBG == 4
#define DSYNC() asm volatile("s_waitcnt vmcnt(0)" ::: "memory"); __syncthreads(); grid.sync(); if (threadIdx.x < 64) { __builtin_amdgcn_fence(__ATOMIC_ACQUIRE, "agent"); asm volatile("s_waitcnt vmcnt(0)" ::: "memory"); } __syncthreads();
        DSYNC()
        phase_scan_naive((const bf16_t*)(ws + slot(1)), (const float*)(ws + slot(4)), (const bf16_t*)(ws + slot(2)), (float*)(ws + slot(6)));
        DSYNC()
        phase_onorm((const float*)(ws + slot(6)), (const bf16_t*)(ws + slot(3)), a.in[2], (bf16_t*)(ws + slot(8)));
        DSYNC()
        phase_scan_a(lds, (const float*)(ws + slot(4)), (const bf16_t*)(ws + slot(2)), (bf16_t*)(ws + slot(6)), (float*)(ws + WS_DEC));
        DSYNC()
        phase_scan_b((bf16_t*)(ws + slot(6)), (const float*)(ws + WS_DEC));
        DSYNC()
        phase_scan_c(lds, (const bf16_t*)(ws + slot(1)), (const float*)(ws + slot(4)), (const bf16_t*)(ws + slot(2)), (const bf16_t*)(ws + slot(3)), (const bf16_t*)(ws + slot(6)), a.in[2], (bf16_t*)a.out);
        DSYNC()
        dbg_compare4((LAS float*)lds, (const bf16_t*)(ws + slot(0)), (const bf16_t*)(ws + slot(8)), (const bf16_t*)a.out, (float*)(ws + WS_CTR + 4096));
#endif
#if SCAN_DBG == 2
        asm volatile("s_waitcnt vmcnt(0)" ::: "memory"); __syncthreads(); grid.sync();
        phase_scan_naive((const bf16_t*)(ws + slot(1)), (const float*)(ws + slot(4)), (const bf16_t*)(ws + slot(2)), (float*)(ws + slot(6)));
        asm volatile("s_waitcnt vmcnt(0)" ::: "memory"); __syncthreads(); grid.sync();
        phase_onorm((const float*)(ws + slot(6)), (const bf16_t*)(ws + slot(3)), a.in[2], (bf16_t*)(ws + slot(8)));
        asm volatile("s_waitcnt vmcnt(0)" ::: "memory"); __syncthreads(); grid.sync();
        dbg_compare((LAS float*)lds, (const bf16_t*)(ws + slot(0)), (const bf16_t*)(ws + slot(8)), (float*)(ws + WS_CTR + 4096));
#endif
    PHASE_END(4)
    PHASE_BEGIN(5) run_gemm_out<false>(a, lds); PHASE_END(5)
    PHASE_BEGIN(6) run_ln<false>(a); PHASE_END(6)
    PHASE_BEGIN(7) run_gemm_sc<false>(a, lds); PHASE_END(7)
    PHASE_BEGIN(8) run_topk<false>(a, lds); PHASE_END(8)
    PHASE_BEGIN(9) run_peer<false>(a, lds); PHASE_END(9)
    PHASE_BEGIN(10) {
        pg8::Gemm g{(const bf16_t*)(ws + slot(2)), (const bf16_t*)(ws + WS_WKVQ), opaque(MTOK), opaque(3 * DM), opaque(DM)};
        pg8::StaticOrder S; S.init(g.M, g.N, (int)gridDim.x, (int)blockIdx.x);
        EpiKVQ E{(bf16_t*)(ws + slot(3)), (bf16_t*)(ws + slot(4)), (bf16_t*)(ws + slot(5))};
        pg8::gemm_phase<EpiKVQ, pg8::StaticOrder>(lds, g, S, E, nullptr);
    } PHASE_END(10)
    PHASE_BEGIN(11) phase_rot((LAS float*)lds, (bf16_t*)(ws + slot(3)), (bf16_t*)(ws + slot(5)), (const float*)(ws + WS_COS), (const float*)(ws + WS_SIN), (float*)(ws + WS_KMEAN), (float*)(ws + WS_KNMAX)); PHASE_END(11)
    PHASE_BEGIN(12) phase_sel(lds, (const bf16_t*)(ws + slot(5)), (const float*)(ws + WS_KMEAN), (unsigned short*)(ws + WS_SUB), (int*)(ws + WS_CNT), (int*)(ws + WS_CTR)); PHASE_END(12)
    PHASE_BEGIN(13) phase_att(lds, (const bf16_t*)(ws + slot(5)), (const bf16_t*)(ws + slot(3)), (const bf16_t*)(ws + slot(4)), (const float*)(ws + WS_KNMAX), (const unsigned short*)(ws + WS_SUB),
                              (const int*)(ws + WS_CNT), (int*)(ws + WS_CTR), (bf16_t*)(ws + slot(6)), (bf16_t*)(ws + slot(2)), (float*)(ws + WS_LS)); PHASE_END(13)
    PHASE_BEGIN(14) phase_comb((const bf16_t*)(ws + slot(6)), (const bf16_t*)(ws + slot(2)), (const float*)(ws + WS_LS), (bf16_t*)(ws + slot(3))); PHASE_END(14)
    PHASE_BEGIN(15) run_gemm_out<true>(a, lds); PHASE_END(15)
    PHASE_BEGIN(16) run_ln<true>(a); PHASE_END(16)
    PHASE_BEGIN(17) run_gemm_sc<true>(a, lds); PHASE_END(17)
    PHASE_BEGIN(18) run_topk<true>(a, lds); PHASE_END(18)
#if SCAN_DBG == 7
    PHASE_BEGIN(19) dbg_emit7((const float*)(ws + WS_CTR + 4096), a.out); PHASE_END(19)
#elif SCAN_DBG == 6
    PHASE_BEGIN(19) dbg_emit4((const float*)(ws + WS_CTR + 4096), a.out); PHASE_END(19)
#elif SCAN_DBG == 5
    PHASE_BEGIN(19) dbg_emit5((const unsigned*)(ws + WS_CTR + 8192), a.out); PHASE_END(19)
#elif SCAN_DBG == 4
    PHASE_BEGIN(19) dbg_emit4((const float*)(ws + WS_CTR + 4096), a.out); PHASE_END(19)
#elif SCAN_DBG == 3
    PHASE_BEGIN(19) dbg_emit3((const unsigned*)(ws + WS_CTR + 8192), a.out); PHASE_END(19)
#elif SCAN_DBG == 2
    PHASE_BEGIN(19) dbg_emit((const float*)(ws + WS_CTR + 4096), a.out); PHASE_END(19)
#else
    PHASE_BEGIN(19) run_peer<true>(a, lds); PHASE_END(19)
#endif
}

extern "C" void kernel_launch(void* const* d_in, const int* in_sizes, int n_in, void* d_out, int out_size, void* d_ws, size_t ws_size, hipStream_t stream) {
    static int grid = 0;
    if (grid == 0) {
        if (n_in != 14 || out_size != MTOK * DM || ws_size < WS_END) { fprintf(stderr, "kernel_launch: unexpected shapes (n_in %d, out %d, ws %zu)\n", n_in, out_size, ws_size); grid = -1; return; }
        int dev = 0, cus = 0, per_cu = 0;
        if (hipGetDevice(&dev) != hipSuccess || hipDeviceGetAttribute(&cus, hipDeviceAttributeMultiprocessorCount, dev) != hipSuccess) { grid = -1; return; }
        if (hipFuncSetAttribute((const void*)mk_fwd, hipFuncAttributeMaxDynamicSharedMemorySize, LDS_BYTES) != hipSuccess) { fprintf(stderr, "kernel_launch: hipFuncSetAttribute failed\n"); grid = -1; return; }
        if (hipOccupancyMaxActiveBlocksPerMultiprocessor(&per_cu, (const void*)mk_fwd, 512, LDS_BYTES) != hipSuccess || per_cu < 1) { fprintf(stderr, "kernel_launch: occupancy query failed (%d)\n", per_cu); (void)hipGetLastError(); per_cu = 1; }
        grid = cus * (per_cu > 1 ? 1 : per_cu);
    }
    if (grid < 0) return;
    Args a{};
    for (int i = 0; i < 14; ++i) a.in[i] = (const float*)d_in[i];
    a.out = (float*)d_out; a.ws = (unsigned char*)d_ws;
#if ONE_LAUNCH
    a.ph_lo = 0; a.ph_hi = NPH;
    void* args[] = {&a};
    hipError_t e = hipLaunchCooperativeKernel((const void*)mk_fwd, dim3(grid), dim3(512), args, LDS_BYTES, stream);
    if (e != hipSuccess) fprintf(stderr, "cooperative launch failed: %s (grid %d)\n", hipGetErrorString(e), grid);
#else
    for (int ph = 0; ph < NPH; ++ph) {
        a.ph_lo = ph; a.ph_hi = ph + 1;
        hipLaunchKernelGGL(mk_fwd, dim3(grid), dim3(512), LDS_BYTES, stream, a);
    }
#endif
}
```

```cpp
#define ONE_LAUNCH 1
#include <hip/hip_runtime.h>
#include <hip/hip_cooperative_groups.h>
#include <cstdio>
namespace cg = cooperative_groups;

#ifndef ONE_LAUNCH
#define ONE_LAUNCH 0
#endif
#ifndef SCAN_DBG
#define SCAN_DBG 0
#endif
#ifndef SCAN_A_VALU
#define SCAN_A_VALU 0
#endif
#ifndef ENMASK
#define ENMASK 0xffffffffu
#endif
#define EN(k) ((ENMASK >> (k)) & 1u)

namespace pg8 {
#define PG8_LAS __attribute__((address_space(3)))
typedef unsigned short bf16_t;
typedef short bf16x8 __attribute__((ext_vector_type(8)));
typedef float f32x4 __attribute__((ext_vector_type(4)));
typedef unsigned u32x4 __attribute__((ext_vector_type(4)));
constexpr int BM = 256, BK = 64, HALF = 128, HTB = HALF * BK * 2  , STAGE_BYTES = 8 * HTB, NXCD = 8, WGM = 8;

__host__ __device__ __forceinline__ int lds_byte(int r, int c) { const int st = (r >> 4) * 2 + (c >> 5), rr = r & 15, cc = c & 31, ob = rr * 64 + cc * 2; return st * 1024 + (ob ^ (((ob >> 9) & 1) << 5)); }
__host__ __device__ __forceinline__ void stage_rc(int b, int& R, int& C) { const int st = b / 1024, sb = b % 1024, swz = sb ^ (((sb >> 9) & 1) << 5); R = (st >> 1) * 16 + swz / 64; C = (st & 1) * 32 + (swz % 64) / 2; }
__host__ __device__ __forceinline__ int perm32(int rho) { const int n = rho >> 4, i = rho & 15; return 8 * (i >> 2) + 4 * n + (i & 3); }

struct Unit { int pm, pn; };
struct Gemm { const bf16_t* A; const bf16_t* Bt; int M, N, K; };

struct StaticOrder {
    int nM, nN, nwg, G, c;
    __host__ __device__ void init(int M, int N, int G_, int c_) { nM = M / BM; nN = N / BM; nwg = nM * nN; G = G_; c = c_; }
    __host__ __device__ bool next(int i, Unit& u) const {
        const long L = (long)i * G + c; if (L >= nwg) return false;
        int wgid = (int)L; { const int q = nwg / NXCD, r = nwg % NXCD, xcd = wgid % NXCD, off = wgid / NXCD; wgid = (xcd < r ? xcd * (q + 1) : r * (q + 1) + (xcd - r) * q) + off; }
        const int nig = WGM * nN, gid = wgid / nig, fm = gid * WGM, gsz = (nM - fm) < WGM ? (nM - fm) : WGM;
        u.pm = fm + ((wgid % nig) % gsz); u.pn = (wgid % nig) / gsz; return true;
    }
    __device__ __forceinline__ void a_ready(const Unit&) const {}
    __device__ __forceinline__ void done(const Unit&) const {}
};
struct CountedOrder : StaticOrder {
    const unsigned* ready; unsigned need; unsigned* tmo;
    __device__ __forceinline__ void a_ready(const Unit& u) const {
        if (threadIdx.x < 64) {
            const unsigned long long t0 = __builtin_amdgcn_s_memrealtime(); unsigned polls = 0;
            while ((unsigned)__builtin_amdgcn_readfirstlane(__hip_atomic_load(ready + 64 * u.pm, __ATOMIC_RELAXED, __HIP_MEMORY_SCOPE_AGENT)) < need) {
                if ((++polls & 255u) == 0u && __builtin_amdgcn_readfirstlane(__hip_atomic_load(tmo, __ATOMIC_RELAXED, __HIP_MEMORY_SCOPE_AGENT)) != 0u) break;
                if (__builtin_amdgcn_s_memrealtime() - t0 > 2000000ull) {
                    if (threadIdx.x == 0) { unsigned expect = 0u; __hip_atomic_compare_exchange_strong(tmo + 1, &expect, 0x600u | (unsigned)(u.pm & 0xff), __ATOMIC_RELAXED, __ATOMIC_RELAXED, __HIP_MEMORY_SCOPE_AGENT); __hip_atomic_store(tmo, 1u, __ATOMIC_RELAXED, __HIP_MEMORY_SCOPE_AGENT); }
                    break; }
                __builtin_amdgcn_s_sleep(2); }
            __builtin_amdgcn_fence(__ATOMIC_ACQUIRE, "agent");
            asm volatile("s_waitcnt vmcnt(0)" ::: "memory");
        }
#if !defined(BROKEN_HOOK_NO_BARRIER)
        asm volatile("" ::: "memory"); __builtin_amdgcn_s_barrier(); asm volatile("" ::: "memory");
#endif
    }
};

__device__ __forceinline__ unsigned cvt_pk_bf16(float lo, float hi) { unsigned r; asm volatile("v_cvt_pk_bf16_f32 %0, %1, %2" : "=v"(r) : "v"(lo), "v"(hi)); return r; }
typedef float f32x2 __attribute__((ext_vector_type(2)));
__device__ __forceinline__ f32x2 gelu_pk(f32x2 v) {
    const f32x2 av = __builtin_elementwise_abs(v), d = av * 0.2316418882f + 1.0f;
    f32x2 t; t.x = __builtin_amdgcn_rcpf(d.x); t.y = __builtin_amdgcn_rcpf(d.y);
    f32x2 q = t * 0.5307027145f + (-0.7265760135f); q = q * t + 0.7107068705f; q = q * t + (-0.142248368f); q = q * t + 0.127414796f; q = q * t;
    const f32x2 s = (v * v) * (-0.72134752044f);
    f32x2 e; e.x = __builtin_amdgcn_exp2f(s.x); e.y = __builtin_amdgcn_exp2f(s.y);
    const f32x2 m = v * (q * e), r = v - m;
    f32x2 o; o.x = v.x < 0.f ? m.x : r.x; o.y = v.y < 0.f ? m.y : r.y; return o;
}

struct EpiF32 {
    static constexpr bool PERM = false, AFTER_DRAIN = false;
    float* C; int ldc; const float* bias;
    __device__ __forceinline__ void operator()(const f32x4 (&acc)[2][2][4][2], const Unit& u, int wr, int wc, int fr, int fq) const {
        const int row0 = u.pm * BM + wr * 64 + fr, col0 = u.pn * BM + wc * 32 + 4 * fq;
        f32x4 bv[2][2];
#pragma unroll
        for (int bj = 0; bj < 2; ++bj)
#pragma unroll
            for (int n = 0; n < 2; ++n) bv[bj][n] = bias ? *(const f32x4*)(bias + col0 + bj * HALF + n * 16) : (f32x4){0.f, 0.f, 0.f, 0.f};
#pragma unroll
        for (int ai = 0; ai < 2; ++ai)
#pragma unroll
            for (int m = 0; m < 4; ++m) { float* rowp = C + (size_t)(row0 + ai * HALF + m * 16) * ldc + col0;
#pragma unroll
                for (int bj = 0; bj < 2; ++bj)
#pragma unroll
                    for (int n = 0; n < 2; ++n) *(f32x4*)(rowp + bj * HALF + n * 16) = acc[ai][bj][m][n] + bv[bj][n]; }
    }
};
template <int ACT  > struct EpiBf16 {
    static constexpr bool PERM = true, AFTER_DRAIN = false;
    bf16_t* O; int ldc; const float* bias; int split_cols; size_t split_stride;
    __device__ __forceinline__ void operator()(const f32x4 (&acc)[2][2][4][2], const Unit& u, int wr, int wc, int fr, int fq) const {
        const int row0 = u.pm * BM + wr * 64 + fr; int colt = u.pn * BM; bf16_t* base = O;
        if (split_cols) { const int t = colt / split_cols; base += (size_t)t * split_stride; colt -= t * split_cols; }
        const int col0 = colt + wc * 32 + 8 * fq, bcol0 = u.pn * BM + wc * 32 + 8 * fq;
        f32x4 bv[2][2];
#pragma unroll
        for (int bj = 0; bj < 2; ++bj)
#pragma unroll
            for (int n = 0; n < 2; ++n) bv[bj][n] = bias ? *(const f32x4*)(bias + bcol0 + bj * HALF + 4 * n) : (f32x4){0.f, 0.f, 0.f, 0.f};
#pragma unroll
        for (int ai = 0; ai < 2; ++ai)
#pragma unroll
            for (int m = 0; m < 4; ++m) { bf16_t* rowp = base + (size_t)(row0 + ai * HALF + m * 16) * ldc + col0;
#pragma unroll
                for (int bj = 0; bj < 2; ++bj) { f32x4 v0 = acc[ai][bj][m][0] + bv[bj][0], v1 = acc[ai][bj][m][1] + bv[bj][1];
                    if (ACT == 1) { f32x2 a = gelu_pk((f32x2){v0[0], v0[1]}), b = gelu_pk((f32x2){v0[2], v0[3]}), c = gelu_pk((f32x2){v1[0], v1[1]}), d = gelu_pk((f32x2){v1[2], v1[3]});
                        v0 = (f32x4){a.x, a.y, b.x, b.y}; v1 = (f32x4){c.x, c.y, d.x, d.y}; }
                    if (ACT == 2) {
#pragma unroll
                        for (int j = 0; j < 4; ++j) { v0[j] = 0.5f * v0[j] * (1.0f + erff(v0[j] * 0.70710678f)); v1[j] = 0.5f * v1[j] * (1.0f + erff(v1[j] * 0.70710678f)); } }
                    u32x4 w; w.x = cvt_pk_bf16(v0[0], v0[1]); w.y = cvt_pk_bf16(v0[2], v0[3]); w.z = cvt_pk_bf16(v1[0], v1[1]); w.w = cvt_pk_bf16(v1[2], v1[3]);
                    *(u32x4*)(rowp + bj * HALF) = w; } }
    }
};

template <class Epi, class Sched, bool STAMP = false>
__device__ __forceinline__ void gemm_phase(PG8_LAS unsigned char* lds, const Gemm g, const Sched& S, const Epi& E, unsigned long long* stamps) {
    const int tid = threadIdx.x, wid = __builtin_amdgcn_readfirstlane(tid >> 6), lane = tid & 63, wr = wid >> 2, wc = wid & 3, fr = lane & 15, fq = lane >> 4;
    const int K = g.K, nt = K / BK;
    int ts_lo = 0, ts_hi = 0, nts = 0; const unsigned long long rt_entry = STAMP ? (unsigned long long)wall_clock64() : 0ull;
#define PG8_STAMP() do { if (STAMP && wid == 0 && nts < 64) { const unsigned long long _c = (unsigned long long)clock64(); \
        ts_lo = (lane == nts) ? (int)(unsigned)_c : ts_lo; ts_hi = (lane == nts) ? (int)(unsigned)(_c >> 32) : ts_hi; ++nts; } } while (0)
    PG8_STAMP();
    unsigned voffA[2], voffB[2];
#pragma unroll
    for (int i = 0; i < 2; ++i) { int R, C; stage_rc(tid * 16 + i * 8192, R, C); const int Rb = Epi::PERM ? ((R & ~31) + perm32(R & 31)) : R;
        voffA[i] = (unsigned)(R * K + C) * 2u; voffB[i] = (unsigned)(Rb * K + C) * 2u; }
    const size_t kstep = (size_t)(BK * 2);
    const size_t hstep = (size_t)HALF * K * 2;
    const size_t tstep = 2 * hstep;
    const unsigned ldsw = (unsigned)wid * 1024u;
    const int aoff = lds_byte(wr * 64 + fr, fq * 8), boff = lds_byte(wc * 32 + fr, fq * 8);
#define PG8_SA(b, h) (((b) * 2 + (h)) * HTB)
#define PG8_SB(b, h) ((4 + (b) * 2 + (h)) * HTB)
#define PG8_STAGE(bufoff, gbase, voff) do { _Pragma("unroll") for (int _i = 0; _i < 2; ++_i) \
        __builtin_amdgcn_global_load_lds((const unsigned*)((const char*)(gbase) + (voff)[_i]), (PG8_LAS unsigned*)(lds + (bufoff) + ldsw + _i * 8192), 16, 0, 0); } while (0)
#define PG8_LDA(dst, b, h) do { _Pragma("unroll") for (int m = 0; m < 4; ++m) _Pragma("unroll") for (int k = 0; k < 2; ++k) dst[m][k] = *(const PG8_LAS bf16x8*)(lds + PG8_SA(b, h) + aoff + m * 2048 + k * 1024); } while (0)
#define PG8_LDB(dst, b, h) do { _Pragma("unroll") for (int n = 0; n < 2; ++n) _Pragma("unroll") for (int k = 0; k < 2; ++k) dst[n][k] = *(const PG8_LAS bf16x8*)(lds + PG8_SB(b, h) + boff + n * 2048 + k * 1024); } while (0)
#define PG8_MMA(ai, bj, At, Bt) do { __builtin_amdgcn_s_setprio(1); _Pragma("unroll") for (int m = 0; m < 4; ++m) _Pragma("unroll") for (int n = 0; n < 2; ++n) _Pragma("unroll") for (int k = 0; k < 2; ++k) \
        acc[ai][bj][m][n] = __builtin_amdgcn_mfma_f32_16x16x32_bf16(Bt[n][k], At[m][k], acc[ai][bj][m][n], 0, 0, 0); __builtin_amdgcn_s_setprio(0); } while (0)
#define PG8_WAIT_V(n) asm volatile("s_waitcnt vmcnt(" #n ")" ::: "memory")
#define PG8_WAIT_L(n) asm volatile("s_waitcnt lgkmcnt(" #n ")" ::: "memory")
#define PG8_BAR __builtin_amdgcn_s_barrier()
#define PG8_SCHED __builtin_amdgcn_sched_barrier(0)
    Unit cur, nxt; int ui = 0;
    if (!S.next(0, cur)) return;
    f32x4 acc[2][2][4][2];
#pragma unroll
    for (int a = 0; a < 2; ++a)
#pragma unroll
        for (int b = 0; b < 2; ++b)
#pragma unroll
            for (int m = 0; m < 4; ++m)
#pragma unroll
                for (int n = 0; n < 2; ++n) acc[a][b][m][n] = (f32x4){0.f, 0.f, 0.f, 0.f};
    bf16x8 At[4][2], B0[2][2], B1[2][2];
    const char* cA = (const char*)g.A + (size_t)cur.pm * tstep; const char* cB = (const char*)g.Bt + (size_t)cur.pn * tstep;
    S.a_ready(cur);
    PG8_STAGE(PG8_SB(0, 0), cB, voffB); PG8_STAGE(PG8_SA(0, 0), cA, voffA); PG8_STAGE(PG8_SB(0, 1), cB + hstep, voffB); PG8_STAGE(PG8_SA(0, 1), cA + hstep, voffA);
    if (wr == 1) PG8_BAR;
    PG8_WAIT_V(4); PG8_BAR;
    PG8_STAGE(PG8_SB(1, 0), cB + kstep, voffB); PG8_STAGE(PG8_SA(1, 0), cA + kstep, voffA); PG8_STAGE(PG8_SB(1, 1), cB + hstep + kstep, voffB);
    PG8_WAIT_V(6); PG8_BAR;
    PG8_STAMP();
    for (;;) {
        const bool has_next = S.next(ui + 1, nxt);
        const char* nA = has_next ? (const char*)g.A + (size_t)nxt.pm * tstep : cA; const char* nB = has_next ? (const char*)g.Bt + (size_t)nxt.pn * tstep : cB;
        for (int t = 0; t < nt; t += 2) {
            const bool last = (t == nt - 2);
            const char* a1 = cA + (size_t)(t + 1) * kstep;
            const char* a2 = last ? nA : cA + (size_t)(t + 2) * kstep; const char* b2 = last ? nB : cB + (size_t)(t + 2) * kstep;
            const char* a3 = a2 + kstep; const char* b3 = b2 + kstep;
            if (last && has_next) S.a_ready(nxt);
            PG8_LDB(B0, 0, 0); PG8_SCHED; PG8_LDA(At, 0, 0); PG8_STAGE(PG8_SA(1, 1), a1 + hstep, voffA);
            PG8_WAIT_L(8); PG8_BAR; PG8_WAIT_L(0); PG8_MMA(0, 0, At, B0); PG8_BAR; PG8_SCHED;
            PG8_LDB(B1, 0, 1); PG8_STAGE(PG8_SB(0, 0), b2, voffB);
            PG8_BAR; PG8_WAIT_L(0); PG8_MMA(0, 1, At, B1); PG8_BAR;
            PG8_LDA(At, 0, 1); PG8_STAGE(PG8_SA(0, 0), a2, voffA);
            PG8_BAR; PG8_WAIT_L(0); PG8_MMA(1, 0, At, B0); PG8_BAR; PG8_SCHED;
            PG8_STAGE(PG8_SB(0, 1), b2 + hstep, voffB);
            PG8_WAIT_V(6); PG8_BAR; PG8_MMA(1, 1, At, B1); PG8_BAR;
            PG8_LDB(B0, 1, 0); PG8_SCHED; PG8_LDA(At, 1, 0); PG8_STAGE(PG8_SA(0, 1), a2 + hstep, voffA);
            PG8_WAIT_L(8); PG8_BAR; PG8_WAIT_L(0); PG8_MMA(0, 0, At, B0); PG8_BAR; PG8_SCHED;
            PG8_LDB(B1, 1, 1); PG8_STAGE(PG8_SB(1, 0), b3, voffB);
            PG8_BAR; PG8_WAIT_L(0); PG8_MMA(0, 1, At, B1); PG8_BAR;
            PG8_LDA(At, 1, 1); PG8_STAGE(PG8_SA(1, 0), a3, voffA);
            PG8_BAR; PG8_WAIT_L(0); PG8_MMA(1, 0, At, B0); PG8_BAR; PG8_SCHED;
            PG8_STAGE(PG8_SB(1, 1), b3 + hstep, voffB);
            PG8_WAIT_V(6); PG8_BAR; PG8_MMA(1, 1, At, B1); PG8_BAR;
        }
        PG8_STAMP();
        if constexpr (!Epi::AFTER_DRAIN) { E(acc, cur, wr, wc, fr, fq); S.done(cur); }
        PG8_STAMP();
        if (!has_next) break;
#pragma unroll
        for (int a = 0; a < 2; ++a)
#pragma unroll
            for (int b = 0; b < 2; ++b)
#pragma unroll
                for (int m = 0; m < 4; ++m)
#pragma unroll
                    for (int n = 0; n < 2; ++n) acc[a][b][m][n] = (f32x4){0.f, 0.f, 0.f, 0.f};
        cur = nxt; cA = nA; cB = nB; ++ui;
    }
    PG8_WAIT_V(0);
    if (wr == 0) PG8_BAR;
    PG8_BAR;
    if constexpr (Epi::AFTER_DRAIN) { E.fused(acc, cur, wr, wc, fr, fq, lds, wid, lane); S.done(cur); }
    PG8_STAMP();
    if (STAMP && wid == 0) { stamps[lane] = lane < nts ? (((unsigned long long)(unsigned)ts_hi << 32) | (unsigned)ts_lo) : 0ull;
        if (lane == 62) stamps[62] = rt_entry; if (lane == 63) stamps[63] = (unsigned long long)wall_clock64(); }
#undef PG8_STAMP
#undef PG8_SA
#undef PG8_SB
#undef PG8_STAGE
#undef PG8_LDA
#undef PG8_LDB
#undef PG8_MMA
#undef PG8_WAIT_V
#undef PG8_WAIT_L
#undef PG8_BAR
#undef PG8_SCHED
}
}


#define LAS __attribute__((address_space(3)))
typedef unsigned short bf16_t;
typedef float f32x4 __attribute__((ext_vector_type(4)));
typedef unsigned u32x4 __attribute__((ext_vector_type(4)));
typedef unsigned u32x2 __attribute__((ext_vector_type(2)));
typedef short bf16x8 __attribute__((ext_vector_type(8)));
typedef short s16x4 __attribute__((ext_vector_type(4)));
typedef float f32x16 __attribute__((ext_vector_type(16)));

constexpr int MTOK = 16384, DM = 2048, SEQ = 8192, NHEAD = 16;
constexpr float ALPHA = 1.41421356237309515f;
constexpr size_t MiB = (size_t)1 << 20;
constexpr size_t WS_WIN = 0, WS_WOUT = 32 * MiB, WS_WKVQ = 40 * MiB, WS_WO = 64 * MiB, WS_WC = 72 * MiB, WS_UB = 88 * MiB, WS_VB = 152 * MiB, WS_USC = 216 * MiB, WS_VSC = 217 * MiB, WS_H = 224 * MiB, WS_XQ = 232 * MiB, WS_XS = 264 * MiB, WS_SLOT = 344 * MiB;
constexpr size_t WS_EID = 920 * MiB, WS_GATE = 928 * MiB, WS_COS = 936 * MiB, WS_SIN = 938 * MiB, WS_KMEAN = 940 * MiB, WS_LB = 941 * MiB, WS_LS = 942 * MiB, WS_SUB = 946 * MiB, WS_CNT = 962 * MiB, WS_CTR = 963 * MiB, WS_DEC = 964 * MiB, WS_END = 966 * MiB;
constexpr size_t WS_KNMAX = WS_KMEAN + 768 * 1024;
__host__ __device__ constexpr size_t slot(int i) { return WS_SLOT + (size_t)i * 64 * MiB; }
constexpr int LDS_BYTES = 144 * 1024;
constexpr int NPH = 24;

struct Args { const float* in[14]; float* out; unsigned char* ws; int ph_lo, ph_hi; };

__device__ __forceinline__ float bflo(unsigned w) { return __uint_as_float(w << 16); }
__device__ __forceinline__ float bfhi(unsigned w) { return __uint_as_float(w & 0xffff0000u); }
__device__ __forceinline__ float bf2f(bf16_t b) { return __uint_as_float(((unsigned)b) << 16); }
typedef __bf16 bf16x2_t __attribute__((ext_vector_type(2)));
typedef float f32x2_t __attribute__((ext_vector_type(2)));
__device__ __forceinline__ unsigned pk_bf16(float lo, float hi) { const f32x2_t f = {lo, hi}; return __builtin_bit_cast(unsigned, __builtin_convertvector(f, bf16x2_t)); }
__device__ __forceinline__ float wave_sum(float v) {
#pragma unroll
    for (int o = 32; o >= 1; o >>= 1) v += __shfl_xor(v, o);
    return v;
}
__device__ __forceinline__ float wave_max(float v) {
#pragma unroll
    for (int o = 32; o >= 1; o >>= 1) v = fmaxf(v, __shfl_xor(v, o));
    return v;
}
__device__ __forceinline__ float sigmoidf_(float z) { return 1.0f / (1.0f + __expf(-z)); }


__device__ __forceinline__ void store_wt16(void* p, u32x4 v) {
    __hip_atomic_store((unsigned long long*)p, ((unsigned long long)v.y << 32) | v.x, __ATOMIC_RELAXED, __HIP_MEMORY_SCOPE_AGENT);
    __hip_atomic_store((unsigned long long*)p + 1, ((unsigned long long)v.w << 32) | v.z, __ATOMIC_RELAXED, __HIP_MEMORY_SCOPE_AGENT);
}
__device__ __forceinline__ void store_wt8(void* p, u32x2 v) {
    __hip_atomic_store((unsigned long long*)p, ((unsigned long long)v.y << 32) | v.x, __ATOMIC_RELAXED, __HIP_MEMORY_SCOPE_AGENT);
}
struct EpiIn {
    static constexpr bool PERM = true, AFTER_DRAIN = false;
    bf16_t* Q1; float* LF; bf16_t* I1; bf16_t* G1; const float* LB;
    __device__ __forceinline__ void operator()(const pg8::f32x4 (&acc)[2][2][4][2], const pg8::Unit& u, int wr, int wc, int fr, int fq) const {
        const int type = u.pn >> 3;
        const int row0 = u.pm * 256 + wr * 64 + fr, col0 = (u.pn & 7) * 256 + wc * 32 + 8 * fq;
        if (type == 1) {
#pragma unroll
            for (int bj = 0; bj < 2; ++bj) {
                const int c = col0 + bj * 128;
                const f32x4 lb0 = *(const f32x4*)(LB + c), lb1 = *(const f32x4*)(LB + c + 4);
#pragma unroll
                for (int ai = 0; ai < 2; ++ai)
#pragma unroll
                    for (int m = 0; m < 4; ++m) {
                        float* p = LF + (size_t)(row0 + ai * 128 + m * 16) * DM + c;
                        f32x4 o0, o1;
#pragma unroll
                        for (int j = 0; j < 4; ++j) {
                            o0[j] = __logf(lb0[j] + (1.0f - lb0[j]) * sigmoidf_(acc[ai][bj][m][0][j]));
                            o1[j] = __logf(lb1[j] + (1.0f - lb1[j]) * sigmoidf_(acc[ai][bj][m][1][j]));
                        }
                        *(f32x4*)p = o0; *(f32x4*)(p + 4) = o1;
                    }
            }
        } else {
            bf16_t* dst = Q1 + (size_t)(type - (type > 0 ? 1 : 0)) * ((size_t)32 << 20);
            const bool act = (type != 2);
#pragma unroll
            for (int ai = 0; ai < 2; ++ai)
#pragma unroll
                for (int m = 0; m < 4; ++m)
#pragma unroll
                    for (int bj = 0; bj < 2; ++bj) {
                        f32x4 v0 = acc[ai][bj][m][0], v1 = acc[ai][bj][m][1];
                        if (act) {
#pragma unroll
                            for (int j = 0; j < 4; ++j) { v0[j] = v0[j] * sigmoidf_(v0[j]); v1[j] = v1[j] * sigmoidf_(v1[j]); }
                        }
                        u32x4 w; w.x = pk_bf16(v0[0], v0[1]); w.y = pk_bf16(v0[2], v0[3]); w.z = pk_bf16(v1[0], v1[1]); w.w = pk_bf16(v1[2], v1[3]);
                        *(u32x4*)(dst + (size_t)(row0 + ai * 128 + m * 16) * DM + col0 + bj * 128) = w;
                    }
        }
    }
};
struct EpiRes {
    static constexpr bool PERM = false, AFTER_DRAIN = false;
    const float* res; float* Y;
    __device__ __forceinline__ void operator()(const pg8::f32x4 (&acc)[2][2][4][2], const pg8::Unit& u, int wr, int wc, int fr, int fq) const {
        const int row0 = u.pm * 256 + wr * 64 + fr, col0 = u.pn * 256 + wc * 32 + 4 * fq;
#pragma unroll
        for (int ai = 0; ai < 2; ++ai)
#pragma unroll
            for (int m = 0; m < 4; ++m) {
                const size_t off = (size_t)(row0 + ai * 128 + m * 16) * DM + col0;
#pragma unroll
                for (int bj = 0; bj < 2; ++bj)
#pragma unroll
                    for (int n = 0; n < 2; ++n) {
                        const f32x4 r = *(const f32x4*)(res + off + bj * 128 + n * 16);
                        *(f32x4*)(Y + off + bj * 128 + n * 16) = r * ALPHA + acc[ai][bj][m][n];
                    }
            }
    }
};
struct EpiF32 {
    static constexpr bool PERM = false, AFTER_DRAIN = false;
    float* C; int ldc;
    __device__ __forceinline__ void operator()(const pg8::f32x4 (&acc)[2][2][4][2], const pg8::Unit& u, int wr, int wc, int fr, int fq) const {
        const int row0 = u.pm * 256 + wr * 64 + fr, col0 = u.pn * 256 + wc * 32 + 4 * fq;
#pragma unroll
        for (int ai = 0; ai < 2; ++ai)
#pragma unroll
            for (int m = 0; m < 4; ++m) {
                float* p = C + (size_t)(row0 + ai * 128 + m * 16) * ldc + col0;
#pragma unroll
                for (int bj = 0; bj < 2; ++bj)
#pragma unroll
                    for (int n = 0; n < 2; ++n) *(f32x4*)(p + bj * 128 + n * 16) = acc[ai][bj][m][n];
            }
    }
};
struct EpiKVQ {
    static constexpr bool PERM = true, AFTER_DRAIN = false;
    bf16_t* K; bf16_t* V; bf16_t* Q;
    __device__ __forceinline__ void operator()(const pg8::f32x4 (&acc)[2][2][4][2], const pg8::Unit& u, int wr, int wc, int fr, int fq) const {
        const int t = u.pn >> 3;
        bf16_t* dst = K + (size_t)t * ((size_t)32 << 20);
        const int row0 = u.pm * 256 + wr * 64 + fr, col0 = (u.pn & 7) * 256 + wc * 32 + 8 * fq;
#pragma unroll
        for (int ai = 0; ai < 2; ++ai)
#pragma unroll
            for (int m = 0; m < 4; ++m)
#pragma unroll
                for (int bj = 0; bj < 2; ++bj) {
                    const f32x4 v0 = acc[ai][bj][m][0], v1 = acc[ai][bj][m][1];
                    u32x4 w; w.x = pk_bf16(v0[0], v0[1]); w.y = pk_bf16(v0[2], v0[3]); w.z = pk_bf16(v1[0], v1[1]); w.w = pk_bf16(v1[2], v1[3]);
                    *(u32x4*)(dst + (size_t)(row0 + ai * 128 + m * 16) * DM + col0 + bj * 128) = w;
                }
    }
};

__device__ __forceinline__ void transpose_tiles(LAS float* tile, const float* src, int ldn, int K, int N, bf16_t* dst) {
    const int tid = threadIdx.x;
    const int tn = N / 64, ntiles = tn * (K / 64);
    for (int tI = blockIdx.x; tI < ntiles; tI += gridDim.x) {
        const int k0 = (tI / tn) * 64, n0 = (tI % tn) * 64;
#pragma unroll
        for (int r = 0; r < 2; ++r) {
            const int kk = (tid >> 4) + 32 * r, nn = (tid & 15) * 4;
            const f32x4 v = *(const f32x4*)(src + (size_t)(k0 + kk) * ldn + n0 + nn);
            tile[kk * 65 + nn + 0] = v[0]; tile[kk * 65 + nn + 1] = v[1]; tile[kk * 65 + nn + 2] = v[2]; tile[kk * 65 + nn + 3] = v[3];
        }
        __syncthreads();
        {
            const int nn = tid >> 3, kk8 = (tid & 7) * 8;
            float f[8];
#pragma unroll
            for (int j = 0; j < 8; ++j) f[j] = tile[(kk8 + j) * 65 + nn];
            u32x4 w; w.x = pk_bf16(f[0], f[1]); w.y = pk_bf16(f[2], f[3]); w.z = pk_bf16(f[4], f[5]); w.w = pk_bf16(f[6], f[7]);
            *(u32x4*)(dst + (size_t)(n0 + nn) * K + k0 + kk8) = w;
        }
        __syncthreads();
    }
}
__device__ __forceinline__ void convert_bf16(const float* src, bf16_t* dst, size_t n) {
    const size_t stride = (size_t)gridDim.x * 512 * 8;
    for (size_t i = ((size_t)blockIdx.x * 512 + threadIdx.x) * 8; i < n; i += stride) {
        const f32x4 a = *(const f32x4*)(src + i), b = *(const f32x4*)(src + i + 4);
        u32x4 w; w.x = pk_bf16(a[0], a[1]); w.y = pk_bf16(a[2], a[3]); w.z = pk_bf16(b[0], b[1]); w.w = pk_bf16(b[2], b[3]);
        *(u32x4*)(dst + i) = w;
    }
}
__device__ __forceinline__ void fold_peer_keys(LAS float* lds, const float* w_query, const float* sub_keys, bf16_t* WcT) {
    const int tid = threadIdx.x;
    LAS float* Ss = lds;
    LAS float* Ws = lds + 128 * 132;
    for (int item = blockIdx.x; item < 1024; item += gridDim.x) {
        const int l = item >> 9, rem = item & 511, hh = rem >> 5, kb = rem & 31, h = hh >> 1, half = hh & 1;
        const float* sk = sub_keys + (size_t)(((l * 2 + half) * 8 + h) * 128) * 128;
        const float* wq = w_query + (size_t)l * DM * DM + (size_t)(kb * 64) * DM + h * 256 + half * 128;
#pragma unroll
        for (int r = 0; r < 8; ++r) { const int idx = tid + 512 * r, key = idx >> 5, d4 = (idx & 31) * 4; *(LAS f32x4*)(Ss + key * 132 + d4) = *(const f32x4*)(sk + key * 128 + d4); }
#pragma unroll
        for (int r = 0; r < 4; ++r) { const int idx = tid + 512 * r, kin = idx >> 5, d4 = (idx & 31) * 4; *(LAS f32x4*)(Ws + kin * 128 + d4) = *(const f32x4*)(wq + (size_t)kin * DM + d4); }
        __syncthreads();
        const int key = tid & 127, kq = tid >> 7;
        float acc[16];
#pragma unroll
        for (int j = 0; j < 16; ++j) acc[j] = 0.f;
        for (int d4 = 0; d4 < 32; ++d4) {
            const f32x4 s4 = *(const LAS f32x4*)(Ss + key * 132 + d4 * 4);
#pragma unroll
            for (int j = 0; j < 16; ++j) { const f32x4 w4 = *(const LAS f32x4*)(Ws + (kq * 16 + j) * 128 + d4 * 4); acc[j] += s4[0] * w4[0] + s4[1] * w4[1] + s4[2] * w4[2] + s4[3] * w4[3]; }
        }
        bf16_t* o = WcT + (size_t)l * DM * DM + (size_t)(h * 256 + half * 128 + key) * DM + kb * 64 + kq * 16;
        u32x4 w0, w1;
        w0.x = pk_bf16(acc[0], acc[1]); w0.y = pk_bf16(acc[2], acc[3]); w0.z = pk_bf16(acc[4], acc[5]); w0.w = pk_bf16(acc[6], acc[7]);
        w1.x = pk_bf16(acc[8], acc[9]); w1.y = pk_bf16(acc[10], acc[11]); w1.z = pk_bf16(acc[12], acc[13]); w1.w = pk_bf16(acc[14], acc[15]);
        *(u32x4*)o = w0; *(u32x4*)(o + 8) = w1;
        __syncthreads();
    }
}

__device__ __forceinline__ void quant_rows(const float* src, unsigned char* dst, float* scl, int nrows) {
    const int lane = threadIdx.x & 63, gw = blockIdx.x * 8 + (threadIdx.x >> 6), nw = gridDim.x * 8;
    for (int row = gw; row < nrows; row += nw) {
        const float* p = src + (size_t)row * DM;
        f32x4 v[8];
#pragma unroll
        for (int i = 0; i < 2; ++i)
#pragma unroll
            for (int q = 0; q < 4; ++q) v[i * 4 + q] = *(const f32x4*)(p + 1024 * i + 16 * lane + 4 * q);
        float am = 0.f;
#pragma unroll
        for (int i = 0; i < 8; ++i) am = fmaxf(am, fmaxf(fmaxf(fabsf(v[i][0]), fabsf(v[i][1])), fmaxf(fabsf(v[i][2]), fabsf(v[i][3]))));
        am = fmaxf(wave_max(am), 1e-30f);
        const float inv = 127.0f / am;
        if (lane == 0) scl[row] = am * (1.0f / 127.0f);
#pragma unroll
        for (int i = 0; i < 2; ++i) {
            u32x4 w;
#pragma unroll
            for (int q = 0; q < 4; ++q) {
                const f32x4 t = v[i * 4 + q];
                const unsigned b0 = (unsigned)(int)(rintf(t[0] * inv) + 128.0f), b1 = (unsigned)(int)(rintf(t[1] * inv) + 128.0f), b2 = (unsigned)(int)(rintf(t[2] * inv) + 128.0f), b3 = (unsigned)(int)(rintf(t[3] * inv) + 128.0f);
                w[q] = b0 | (b1 << 8) | (b2 << 16) | (b3 << 24);
            }
            *(u32x4*)(dst + (size_t)row * DM + 1024 * i + 16 * lane) = w;
        }
    }
}
__device__ __forceinline__ void phase_prep(const Args& a, LAS unsigned char* lds) {
    unsigned char* ws = a.ws;
    LAS float* tile = (LAS float*)lds;
    transpose_tiles(tile, a.in[1], 4 * DM, DM, 4 * DM, (bf16_t*)(ws + WS_WIN));
    transpose_tiles(tile, a.in[3], DM, DM, DM, (bf16_t*)(ws + WS_WOUT));
    transpose_tiles(tile, a.in[5], 2 * DM, DM, 2 * DM, (bf16_t*)(ws + WS_WKVQ));
    transpose_tiles(tile, a.in[6], DM, DM, DM, (bf16_t*)(ws + WS_WKVQ) + (size_t)2 * DM * DM);
    transpose_tiles(tile, a.in[7], DM, DM, DM, (bf16_t*)(ws + WS_WO));
    fold_peer_keys((LAS float*)lds, a.in[8], a.in[9], (bf16_t*)(ws + WS_WC));
    convert_bf16(a.in[0], (bf16_t*)(ws + slot(0)), (size_t)MTOK * DM);
    quant_rows(a.in[10], ws + WS_UB, (float*)(ws + WS_USC), 2 * 16384);
    quant_rows(a.in[11], ws + WS_VB, (float*)(ws + WS_VSC), 2 * 16384);
    const int gtid = blockIdx.x * 512 + threadIdx.x, gthreads = gridDim.x * 512;
    float* COS = (float*)(ws + WS_COS); float* SIN = (float*)(ws + WS_SIN); float* LB = (float*)(ws + WS_LB);
    for (int i = gtid; i < SEQ * 64; i += gthreads) {
        const int pos = i >> 6, j = i & 63;
        double inv = 1.0; const double r = 0.86596432336006535;
        for (int q = 0; q < j; ++q) inv *= r;
        const float ang = (float)pos * (float)inv;
        const double x = (double)ang;
        const double n = __builtin_rint(x * 0.15915494309189535);
        const float rf = (float)__builtin_fma(-n, 6.283185307179586, x);
        COS[i] = cosf(rf); SIN[i] = sinf(rf);
    }
    for (int c = gtid; c < DM; c += gthreads) { const float l0 = a.in[4][c], l1 = a.in[4][DM + c]; LB[c] = 1.0f / (1.0f + expf(l1 - l0)); }
}

__device__ __forceinline__ void phase_scan_naive(const bf16_t* Q1, const float* LF, const bf16_t* I1, float* O) {
    const int lane = threadIdx.x & 63, gw = blockIdx.x * 8 + (threadIdx.x >> 6), nw = gridDim.x * 8;
    for (int item = gw; item < 2 * NHEAD * 128; item += nw) {
        const int bh = item >> 7, v = item & 127, b = bh >> 4, h = bh & 15;
        const size_t base = (size_t)b * SEQ * DM + h * 128;
        float S0 = 0.f, S1 = 0.f;
#pragma unroll 4
        for (int t = 0; t < SEQ; ++t) {
            const size_t ro = base + (size_t)t * DM;
            const float f0 = __expf(LF[ro + lane]), f1 = __expf(LF[ro + 64 + lane]);
            const float q0 = bf2f(Q1[ro + lane]), q1 = bf2f(Q1[ro + 64 + lane]);
            const float iv = bf2f(I1[ro + v]);
            S0 = f0 * S0 + (1.0f - f0) * iv; S1 = f1 * S1 + (1.0f - f1) * iv;
            const float p = wave_sum(q0 * S0 + q1 * S1);
            if (lane == 0) O[ro + v] = p;
        }
    }
}
__device__ __forceinline__ void phase_onorm(const float* O, const bf16_t* G1, const float* gnorm, bf16_t* OG) {
    const int lane = threadIdx.x & 63, gw = blockIdx.x * 8 + (threadIdx.x >> 6), nw = gridDim.x * 8;
    const float gn0 = gnorm[2 * lane], gn1 = gnorm[2 * lane + 1];
    for (int item = gw; item < MTOK * NHEAD; item += nw) {
        const size_t off = (size_t)item * 128 + 2 * lane;
        const float o0 = O[off], o1 = O[off + 1];
        const float ss = wave_sum(o0 * o0 + o1 * o1);
        const float r = rsqrtf(ss * (1.0f / 128.0f) + 1e-6f);
        const unsigned g = *(const unsigned*)(G1 + off);
        *(unsigned*)(OG + off) = pk_bf16(o0 * r * gn0 * bflo(g), o1 * r * gn1 * bfhi(g));
    }
}

__device__ __forceinline__ void ln_row_store(float (&v)[32], const float* g, const float* bta, float* outf, bf16_t* outb, int lane, signed char* outq = nullptr, float* outs = nullptr) {
    float s = 0.f;
#pragma unroll
    for (int i = 0; i < 32; ++i) s += v[i];
    const float mu = wave_sum(s) * (1.0f / DM);
    float q = 0.f;
#pragma unroll
    for (int i = 0; i < 32; ++i) { v[i] -= mu; q += v[i] * v[i]; }
    const float rstd = rsqrtf(wave_sum(q) * (1.0f / DM) + 1e-5f);
    float am = 0.f;
#pragma unroll
    for (int i = 0; i < 4; ++i) {
        const int c = 512 * i + 8 * lane;
        const f32x4 g0 = *(const f32x4*)(g + c), g1 = *(const f32x4*)(g + c + 4), b0 = *(const f32x4*)(bta + c), b1 = *(const f32x4*)(bta + c + 4);
        f32x4 o0, o1;
#pragma unroll
        for (int j = 0; j < 4; ++j) { o0[j] = v[i * 8 + j] * rstd * g0[j] + b0[j]; o1[j] = v[i * 8 + 4 + j] * rstd * g1[j] + b1[j]; v[i * 8 + j] = o0[j]; v[i * 8 + 4 + j] = o1[j]; am = fmaxf(am, fmaxf(fabsf(o0[j]), fabsf(o1[j]))); }
        *(f32x4*)(outf + c) = o0; *(f32x4*)(outf + c + 4) = o1;
        if (outb) { u32x4 w; w.x = pk_bf16(o0[0], o0[1]); w.y = pk_bf16(o0[2], o0[3]); w.z = pk_bf16(o1[0], o1[1]); w.w = pk_bf16(o1[2], o1[3]); *(u32x4*)(outb + c) = w; }
    }
    if (outq) {
        am = fmaxf(wave_max(am), 1e-30f);
        const float inv = 127.0f / am;
        if (lane == 0) *outs = am * (1.0f / 127.0f);
#pragma unroll
        for (int i = 0; i < 4; ++i) {
            u32x2 w;
            w.x = ((unsigned)(int)rintf(v[i * 8 + 0] * inv) & 0xffu) | (((unsigned)(int)rintf(v[i * 8 + 1] * inv) & 0xffu) << 8) | (((unsigned)(int)rintf(v[i * 8 + 2] * inv) & 0xffu) << 16) | (((unsigned)(int)rintf(v[i * 8 + 3] * inv) & 0xffu) << 24);
            w.y = ((unsigned)(int)rintf(v[i * 8 + 4] * inv) & 0xffu) | (((unsigned)(int)rintf(v[i * 8 + 5] * inv) & 0xffu) << 8) | (((unsigned)(int)rintf(v[i * 8 + 6] * inv) & 0xffu) << 16) | (((unsigned)(int)rintf(v[i * 8 + 7] * inv) & 0xffu) << 24);
            *(u32x2*)(outq + 512 * i + 8 * lane) = w;
        }
    }
}
__device__ __forceinline__ void ln_row_store16(float (&v)[32], const float* g, const float* bta, float* outf, bf16_t* outb, int lane) {
    float s = 0.f;
#pragma unroll
    for (int i = 0; i < 32; ++i) s += v[i];
    const float mu = wave_sum(s) * (1.0f / DM);
    float q = 0.f;
#pragma unroll
    for (int i = 0; i < 32; ++i) { v[i] -= mu; q += v[i] * v[i]; }
    const float rstd = rsqrtf(wave_sum(q) * (1.0f / DM) + 1e-5f);
#pragma unroll
    for (int i = 0; i < 2; ++i) {
        const int c = 1024 * i + 16 * lane;
        f32x4 o[4];
#pragma unroll
        for (int qd = 0; qd < 4; ++qd) {
            const f32x4 gg = *(const f32x4*)(g + c + 4 * qd), bb = *(const f32x4*)(bta + c + 4 * qd);
#pragma unroll
            for (int j = 0; j < 4; ++j) o[qd][j] = v[16 * i + 4 * qd + j] * rstd * gg[j] + bb[j];
            *(f32x4*)(outf + c + 4 * qd) = o[qd];
        }
        if (outb) {
            u32x4 w0, w1;
            w0.x = pk_bf16(o[0][0], o[0][1]); w0.y = pk_bf16(o[0][2], o[0][3]); w0.z = pk_bf16(o[1][0], o[1][1]); w0.w = pk_bf16(o[1][2], o[1][3]);
            w1.x = pk_bf16(o[2][0], o[2][1]); w1.y = pk_bf16(o[2][2], o[2][3]); w1.z = pk_bf16(o[3][0], o[3][1]); w1.w = pk_bf16(o[3][2], o[3][3]);
            *(u32x4*)(outb + c) = w0; *(u32x4*)(outb + c + 8) = w1;
        }
    }
}
__device__ __forceinline__ void phase_ln(const float* Y, const float* g, const float* bta, float* outf, bf16_t* outb, signed char* outq = nullptr, float* outs = nullptr) {
    const int lane = threadIdx.x & 63, gw = blockIdx.x * 8 + (threadIdx.x >> 6), nw = gridDim.x * 8;
    for (int row = gw; row < MTOK; row += nw) {
        float v[32];
        const float* p = Y + (size_t)row * DM;
#pragma unroll
        for (int i = 0; i < 4; ++i) {
            const f32x4 a = *(const f32x4*)(p + 512 * i + 8 * lane), b = *(const f32x4*)(p + 512 * i + 8 * lane + 4);
#pragma unroll
            for (int j = 0; j < 4; ++j) { v[i * 8 + j] = a[j]; v[i * 8 + 4 + j] = b[j]; }
        }
        ln_row_store(v, g, bta, outf + (size_t)row * DM, outb ? outb + (size_t)row * DM : nullptr, lane, outq ? outq + (size_t)row * DM : nullptr, outs ? outs + row : nullptr);
    }
}

__device__ __forceinline__ void wave_argmax(float& v, int& idx) {
#pragma unroll
    for (int o = 32; o >= 1; o >>= 1) {
        const float ov = __shfl_xor(v, o); const int oi = __shfl_xor(idx, o);
        if (ov > v || (ov == v && oi < idx)) { v = ov; idx = oi; }
    }
}
__device__ __forceinline__ unsigned fkey(float x) { const unsigned u = __float_as_uint(x); return u ^ (unsigned)(((int)u >> 31) | 0x80000000); }
__device__ __forceinline__ float funkey(unsigned k) { const unsigned u = (k & 0x80000000u) ? (k ^ 0x80000000u) : ~k; return __uint_as_float(u); }
__device__ __forceinline__ void sort16_insert(unsigned (&r)[16], unsigned v) {
#pragma unroll
    for (int i = 0; i < 16; ++i) { const unsigned m = r[i] > v ? r[i] : v; v = r[i] > v ? v : r[i]; r[i] = m; }
}
__device__ __forceinline__ void phase_topk(LAS unsigned char* lds, const float* SCT, int* EID, float* GATE) {
    LAS unsigned char* ib = lds + threadIdx.x * 32;
    for (int item = blockIdx.x * 512 + threadIdx.x; item < MTOK * 8; item += gridDim.x * 512) {
        const int h = item >> 14, tok = item & (MTOK - 1);
        const float* p = SCT + (size_t)(h * 256) * MTOK + tok;
        unsigned r1[16], r2[16];
#pragma unroll
        for (int i = 0; i < 16; ++i) { r1[i] = 0u; r2[i] = 0u; }
#pragma unroll 8
        for (int e = 0; e < 128; ++e) {
            const float x1 = p[(size_t)e * MTOK], x2 = p[(size_t)(128 + e) * MTOK];
            sort16_insert(r1, (fkey(x1) & ~0x7Fu) | (unsigned)e);
            sort16_insert(r2, (fkey(x2) & ~0x7Fu) | (unsigned)e);
        }
        float v1[16], v2[16];
#pragma unroll
        for (int i = 0; i < 16; ++i) { v1[i] = funkey(r1[i] & ~0x7Fu); v2[i] = funkey(r2[i] & ~0x7Fu); ib[i] = (unsigned char)(r1[i] & 0x7Fu); ib[16 + i] = (unsigned char)(r2[i] & 0x7Fu); }
        unsigned r3[16];
#pragma unroll
        for (int i = 0; i < 16; ++i) r3[i] = 0u;
#pragma unroll
        for (int a = 0; a < 16; ++a)
#pragma unroll
            for (int bq = 0; bq < 16; ++bq)
                if ((a + 1) * (bq + 1) <= 16) sort16_insert(r3, (fkey(v1[a] + v2[bq]) & ~0xFFu) | (unsigned)(a * 16 + bq));
        const float mx = funkey(r3[0] & ~0xFFu);
        float ev[16]; float sum = 0.f;
#pragma unroll
        for (int i = 0; i < 16; ++i) { ev[i] = __expf(funkey(r3[i] & ~0xFFu) - mx); sum += ev[i]; }
        const float rs = 1.0f / sum;
        int eid[16];
#pragma unroll
        for (int i = 0; i < 16; ++i) { const unsigned f = r3[i] & 0xFFu; eid[i] = (int)ib[f >> 4] * 128 + (int)ib[16 + (f & 15u)]; }
        int* eo = EID + (size_t)tok * 128 + h * 16; float* go = GATE + (size_t)tok * 128 + h * 16;
#pragma unroll
        for (int q = 0; q < 4; ++q) {
            *(u32x4*)(eo + 4 * q) = (u32x4){(unsigned)eid[4 * q], (unsigned)eid[4 * q + 1], (unsigned)eid[4 * q + 2], (unsigned)eid[4 * q + 3]};
            *(f32x4*)(go + 4 * q) = (f32x4){ev[4 * q] * rs, ev[4 * q + 1] * rs, ev[4 * q + 2] * rs, ev[4 * q + 3] * rs};
        }
    }
}

__device__ __forceinline__ float gelu_erf(float x) { return 0.5f * x * (1.0f + erff(x * 0.70710678118654752f)); }
__device__ __forceinline__ float ub0(unsigned w) { return (float)(w & 0xffu); }
__device__ __forceinline__ float ub1(unsigned w) { return (float)((w >> 8) & 0xffu); }
__device__ __forceinline__ float ub2(unsigned w) { return (float)((w >> 16) & 0xffu); }
__device__ __forceinline__ float ub3(unsigned w) { return (float)(w >> 24); }
__device__ __forceinline__ void phase_peer(LAS unsigned char* lds, const float* X, const int* EID, const float* GATE, const unsigned char* U, const unsigned char* V, const float* USC, const float* VSC,
                                           const float* g, const float* bta, float* outf, bf16_t* outb) {
    const int lane = threadIdx.x & 63, wv = threadIdx.x >> 6, gw = blockIdx.x * 8 + wv, nw = gridDim.x * 8;
    LAS float* hb = (LAS float*)(lds + wv * 512);
    for (int tok = gw; tok < MTOK; tok += nw) {
        float x[32];
        const float* xp = X + (size_t)tok * DM;
#pragma unroll
        for (int i = 0; i < 2; ++i)
#pragma unroll
            for (int q = 0; q < 4; ++q) { const f32x4 t = *(const f32x4*)(xp + 1024 * i + 16 * lane + 4 * q); x[16 * i + 4 * q] = t[0]; x[16 * i + 4 * q + 1] = t[1]; x[16 * i + 4 * q + 2] = t[2]; x[16 * i + 4 * q + 3] = t[3]; }
        float sx = 0.f;
#pragma unroll
        for (int j = 0; j < 32; ++j) sx += x[j];
        const float d0 = -128.0f * sx;
        const int e0 = EID[(size_t)tok * 128 + lane], e1 = EID[(size_t)tok * 128 + 64 + lane];
        const float g0 = GATE[(size_t)tok * 128 + lane], g1 = GATE[(size_t)tok * 128 + 64 + lane];
        for (int bt = 0; bt < 16; ++bt) {
            float d[8];
#pragma unroll
            for (int r = 0; r < 8; ++r) {
                const int e = bt * 8 + r;
                const int idx = __builtin_amdgcn_readfirstlane(__shfl(bt < 8 ? e0 : e1, e & 63));
                const u32x4* up = (const u32x4*)(U + (size_t)idx * DM) + lane;
                float acc = d0;
#pragma unroll
                for (int i = 0; i < 2; ++i) {
                    const u32x4 w = up[i * 64];
                    acc += x[16 * i + 0] * ub0(w.x) + x[16 * i + 1] * ub1(w.x) + x[16 * i + 2] * ub2(w.x) + x[16 * i + 3] * ub3(w.x)
                         + x[16 * i + 4] * ub0(w.y) + x[16 * i + 5] * ub1(w.y) + x[16 * i + 6] * ub2(w.y) + x[16 * i + 7] * ub3(w.y)
                         + x[16 * i + 8] * ub0(w.z) + x[16 * i + 9] * ub1(w.z) + x[16 * i + 10] * ub2(w.z) + x[16 * i + 11] * ub3(w.z)
                         + x[16 * i + 12] * ub0(w.w) + x[16 * i + 13] * ub1(w.w) + x[16 * i + 14] * ub2(w.w) + x[16 * i + 15] * ub3(w.w);
                }
                d[r] = acc;
            }
            const bool b5 = lane & 32, b4 = lane & 16, b3 = lane & 8;
            float t4[4];
#pragma unroll
            for (int q = 0; q < 4; ++q) { const float keep = b5 ? d[4 + q] : d[q], send = b5 ? d[q] : d[4 + q]; t4[q] = keep + __shfl_xor(send, 32); }
            float t2[2];
#pragma unroll
            for (int q = 0; q < 2; ++q) { const float keep = b4 ? t4[2 + q] : t4[q], send = b4 ? t4[q] : t4[2 + q]; t2[q] = keep + __shfl_xor(send, 16); }
            float t1;
            { const float keep = b3 ? t2[1] : t2[0], send = b3 ? t2[0] : t2[1]; t1 = keep + __shfl_xor(send, 8); }
            t1 += __shfl_xor(t1, 4); t1 += __shfl_xor(t1, 2); t1 += __shfl_xor(t1, 1);
            if ((lane & 7) == 0) hb[bt * 8 + (lane >> 3 & 1) + 2 * (lane >> 4 & 1) + 4 * (lane >> 5 & 1)] = t1;
        }
        asm volatile("s_waitcnt lgkmcnt(0)" ::: "memory");
        const float h0 = hb[lane] * USC[e0], h1 = hb[64 + lane] * USC[e1];
        const float w0 = g0 * gelu_erf(h0) * VSC[e0], w1 = g1 * gelu_erf(h1) * VSC[e1];
        float wsum = wave_sum(w0 + w1);
        float y[32];
#pragma unroll
        for (int i = 0; i < 32; ++i) y[i] = 0.f;
#pragma unroll 8
        for (int e = 0; e < 128; ++e) {
            const int idx = __builtin_amdgcn_readfirstlane(__shfl(e < 64 ? e0 : e1, e & 63));
            const float wt = __shfl(e < 64 ? w0 : w1, e & 63);
            const u32x4* vp = (const u32x4*)(V + (size_t)idx * DM) + lane;
#pragma unroll
            for (int i = 0; i < 2; ++i) {
                const u32x4 w = vp[i * 64];
                y[16 * i + 0] += wt * ub0(w.x); y[16 * i + 1] += wt * ub1(w.x); y[16 * i + 2] += wt * ub2(w.x); y[16 * i + 3] += wt * ub3(w.x);
                y[16 * i + 4] += wt * ub0(w.y); y[16 * i + 5] += wt * ub1(w.y); y[16 * i + 6] += wt * ub2(w.y); y[16 * i + 7] += wt * ub3(w.y);
                y[16 * i + 8] += wt * ub0(w.z); y[16 * i + 9] += wt * ub1(w.z); y[16 * i + 10] += wt * ub2(w.z); y[16 * i + 11] += wt * ub3(w.z);
                y[16 * i + 12] += wt * ub0(w.w); y[16 * i + 13] += wt * ub1(w.w); y[16 * i + 14] += wt * ub2(w.w); y[16 * i + 15] += wt * ub3(w.w);
            }
        }
        const float corr = -128.0f * wsum;
#pragma unroll
        for (int i = 0; i < 32; ++i) y[i] = y[i] + corr + ALPHA * x[i];
        ln_row_store16(y, g, bta, outf + (size_t)tok * DM, outb ? outb + (size_t)tok * DM : nullptr, lane);
        asm volatile("s_waitcnt lgkmcnt(0)" ::: "memory");
    }
}

__device__ __forceinline__ int row_dot_i8(const u32x4 (&xq)[2], const unsigned char* rowp, int lane) {
    const u32x4* up = (const u32x4*)rowp + lane;
    int acc = 0;
#pragma unroll
    for (int i = 0; i < 2; ++i) {
        const u32x4 w = up[i * 64];
        acc = __builtin_amdgcn_sdot4((int)xq[i].x, (int)(w.x ^ 0x80808080u), acc, false); acc = __builtin_amdgcn_sdot4((int)xq[i].y, (int)(w.y ^ 0x80808080u), acc, false);
        acc = __builtin_amdgcn_sdot4((int)xq[i].z, (int)(w.z ^ 0x80808080u), acc, false); acc = __builtin_amdgcn_sdot4((int)xq[i].w, (int)(w.w ^ 0x80808080u), acc, false);
    }
    return acc;
}
__device__ __forceinline__ void phase_peer_u(const signed char* XQ, const float* XS, const int* EID, const unsigned char* U, const float* USC, float* H) {
    const int lane = threadIdx.x & 63, wv = threadIdx.x >> 6;
    const bool b5 = lane & 32, b4 = lane & 16, b3 = lane & 8;
    const int myr = (b3 ? 1 : 0) + (b4 ? 2 : 0) + (b5 ? 4 : 0);
    for (int sl = 0; sl < 16; ++sl) {
        for (int tok = blockIdx.x * 8 + wv; tok < MTOK; tok += gridDim.x * 8) {
            u32x4 xq[2];
            xq[0] = *(const u32x4*)(XQ + (size_t)tok * DM + 16 * lane); xq[1] = *(const u32x4*)(XQ + (size_t)tok * DM + 1024 + 16 * lane);
            const float xs = XS[tok];
            const int e0 = EID[(size_t)tok * 128 + lane], e1 = EID[(size_t)tok * 128 + 64 + lane];
#pragma unroll
            for (int hf = 0; hf < 2; ++hf) {
                const int ev = hf ? e1 : e0;
                unsigned long long m = __ballot((ev >> 10) == sl);
                while (m) {
                    int la[8], ix[8]; int nv = 0;
#pragma unroll
                    for (int r = 0; r < 8; ++r) {
                        const bool ok = m != 0ull;
                        la[r] = ok ? __builtin_ctzll(m) : la[0]; if (ok) { m &= m - 1; ++nv; }
                        ix[r] = __builtin_amdgcn_readfirstlane(__shfl(ev, la[r]));
                    }
                    int d[8];
#pragma unroll
                    for (int r = 0; r < 8; ++r) d[r] = row_dot_i8(xq, U + (size_t)ix[r] * DM, lane);
                    int t4[4], t2[2], t1;
#pragma unroll
                    for (int q = 0; q < 4; ++q) { const int keep = b5 ? d[4 + q] : d[q], send = b5 ? d[q] : d[4 + q]; t4[q] = keep + __shfl_xor(send, 32); }
#pragma unroll
                    for (int q = 0; q < 2; ++q) { const int keep = b4 ? t4[2 + q] : t4[q], send = b4 ? t4[q] : t4[2 + q]; t2[q] = keep + __shfl_xor(send, 16); }
                    { const int keep = b3 ? t2[1] : t2[0], send = b3 ? t2[0] : t2[1]; t1 = keep + __shfl_xor(send, 8); }
                    t1 += __shfl_xor(t1, 4); t1 += __shfl_xor(t1, 2); t1 += __shfl_xor(t1, 1);
                    int mla = la[0], mix = ix[0];
#pragma unroll
                    for (int r = 1; r < 8; ++r) { mla = myr == r ? la[r] : mla; mix = myr == r ? ix[r] : mix; }
                    if ((lane & 7) == 0 && myr < nv) H[(size_t)tok * 128 + hf * 64 + mla] = (float)t1 * xs * USC[mix];
                }
            }
        }
    }
}
__device__ __forceinline__ void phase_peer_v(LAS unsigned char* lds, const float* X, const int* EID, const float* GATE, const float* H, const unsigned char* V, const float* VSC, float* Y) {
    const int lane = threadIdx.x & 63, wv = threadIdx.x >> 6, es = lane >> 3, cc = lane & 7;
    LAS float* wb = (LAS float*)(lds + wv * 1024);
    LAS int* eb = (LAS int*)(lds + wv * 1024 + 512);
    const bool b5 = lane & 32, b4 = lane & 16, b3 = lane & 8;
    for (int sl = 0; sl < 16; ++sl) {
        for (int tok = blockIdx.x * 8 + wv; tok < MTOK; tok += gridDim.x * 8) {
            const int e0 = EID[(size_t)tok * 128 + lane], e1 = EID[(size_t)tok * 128 + 64 + lane];
            const float w0 = GATE[(size_t)tok * 128 + lane] * gelu_erf(H[(size_t)tok * 128 + lane]) * VSC[e0];
            const float w1 = GATE[(size_t)tok * 128 + 64 + lane] * gelu_erf(H[(size_t)tok * 128 + 64 + lane]) * VSC[e1];
            const float corr = -128.0f * wave_sum(w0 + w1);
            wb[lane] = w0; wb[64 + lane] = w1; eb[lane] = e0; eb[64 + lane] = e1;
            asm volatile("s_waitcnt lgkmcnt(0)" ::: "memory");
            f32x2_t ya[8];
#pragma unroll
            for (int j = 0; j < 8; ++j) ya[j] = (f32x2_t){0.f, 0.f};
            const unsigned char* vbase = V + sl * 128 + cc * 16;
#pragma unroll
            for (int i = 0; i < 16; ++i) {
                const int idx = eb[8 * i + es]; const float wt = wb[8 * i + es];
                const f32x2_t wt2 = {wt, wt};
                const u32x4 w = *(const u32x4*)(vbase + (size_t)idx * DM);
                ya[0] = __builtin_elementwise_fma(wt2, (f32x2_t){ub0(w.x), ub1(w.x)}, ya[0]); ya[1] = __builtin_elementwise_fma(wt2, (f32x2_t){ub2(w.x), ub3(w.x)}, ya[1]);
                ya[2] = __builtin_elementwise_fma(wt2, (f32x2_t){ub0(w.y), ub1(w.y)}, ya[2]); ya[3] = __builtin_elementwise_fma(wt2, (f32x2_t){ub2(w.y), ub3(w.y)}, ya[3]);
                ya[4] = __builtin_elementwise_fma(wt2, (f32x2_t){ub0(w.z), ub1(w.z)}, ya[4]); ya[5] = __builtin_elementwise_fma(wt2, (f32x2_t){ub2(w.z), ub3(w.z)}, ya[5]);
                ya[6] = __builtin_elementwise_fma(wt2, (f32x2_t){ub0(w.w), ub1(w.w)}, ya[6]); ya[7] = __builtin_elementwise_fma(wt2, (f32x2_t){ub2(w.w), ub3(w.w)}, ya[7]);
            }
            f32x2_t t4[4], t2[2], t1;
#pragma unroll
            for (int q = 0; q < 4; ++q) { const f32x2_t keep = b5 ? ya[4 + q] : ya[q], send = b5 ? ya[q] : ya[4 + q]; t4[q][0] = keep[0] + __shfl_xor(send[0], 32); t4[q][1] = keep[1] + __shfl_xor(send[1], 32); }
#pragma unroll
            for (int q = 0; q < 2; ++q) { const f32x2_t keep = b4 ? t4[2 + q] : t4[q], send = b4 ? t4[q] : t4[2 + q]; t2[q][0] = keep[0] + __shfl_xor(send[0], 16); t2[q][1] = keep[1] + __shfl_xor(send[1], 16); }
            { const f32x2_t keep = b3 ? t2[1] : t2[0], send = b3 ? t2[0] : t2[1]; t1[0] = keep[0] + __shfl_xor(send[0], 8); t1[1] = keep[1] + __shfl_xor(send[1], 8); }
            const int col = sl * 128 + cc * 16 + (b5 ? 8 : 0) + (b4 ? 4 : 0) + (b3 ? 2 : 0);
            const f32x2_t xr = *(const f32x2_t*)(X + (size_t)tok * DM + col);
            f32x2_t o; o[0] = t1[0] + corr + ALPHA * xr[0]; o[1] = t1[1] + corr + ALPHA * xr[1];
            *(f32x2_t*)(Y + (size_t)tok * DM + col) = o;
            asm volatile("s_waitcnt lgkmcnt(0)" ::: "memory");
        }
    }
}

__device__ __forceinline__ void rot8(const u32x4 lo, const u32x4 hi, const f32x4 c0, const f32x4 c1, const f32x4 s0, const f32x4 s1, float (&o1)[8], float (&o2)[8]) {
    const float a[8] = {bflo(lo.x), bfhi(lo.x), bflo(lo.y), bfhi(lo.y), bflo(lo.z), bfhi(lo.z), bflo(lo.w), bfhi(lo.w)};
    const float b[8] = {bflo(hi.x), bfhi(hi.x), bflo(hi.y), bfhi(hi.y), bflo(hi.z), bfhi(hi.z), bflo(hi.w), bfhi(hi.w)};
    const float c[8] = {c0[0], c0[1], c0[2], c0[3], c1[0], c1[1], c1[2], c1[3]}, sn[8] = {s0[0], s0[1], s0[2], s0[3], s1[0], s1[1], s1[2], s1[3]};
#pragma unroll
    for (int j = 0; j < 8; ++j) { o1[j] = a[j] * c[j] - b[j] * sn[j]; o2[j] = a[j] * sn[j] + b[j] * c[j]; }
}
__device__ __forceinline__ u32x4 pack8(const float (&o)[8]) { u32x4 w; w.x = pk_bf16(o[0], o[1]); w.y = pk_bf16(o[2], o[3]); w.z = pk_bf16(o[4], o[5]); w.w = pk_bf16(o[6], o[7]); return w; }
__device__ __forceinline__ void phase_rot(LAS float* red, bf16_t* KR, bf16_t* QR, const float* COS, const float* SIN, float* KMEAN, float* KNMAX) {
    const int tid = threadIdx.x, ch = tid & 7, rr = tid >> 3, wv = tid >> 6, lane = tid & 63;
    for (int item = blockIdx.x; item < 2 * NHEAD * 32; item += gridDim.x) {
        const int bh = item >> 5, j = item & 31, b = bh >> 4, h = bh & 15;
        float sm1[8], sm2[8]; float nmax = 0.f;
#pragma unroll
        for (int q = 0; q < 8; ++q) { sm1[q] = 0.f; sm2[q] = 0.f; }
#pragma unroll
        for (int ps = 0; ps < 4; ++ps) {
            const int pos = j * 256 + ps * 64 + rr;
            const size_t off = ((size_t)b * SEQ + pos) * DM + h * 128 + ch * 8;
            const f32x4 c0 = *(const f32x4*)(COS + pos * 64 + ch * 8), c1 = *(const f32x4*)(COS + pos * 64 + ch * 8 + 4);
            const f32x4 s0 = *(const f32x4*)(SIN + pos * 64 + ch * 8), s1 = *(const f32x4*)(SIN + pos * 64 + ch * 8 + 4);
            float o1[8], o2[8];
            rot8(*(const u32x4*)(KR + off), *(const u32x4*)(KR + off + 64), c0, c1, s0, s1, o1, o2);
            *(u32x4*)(KR + off) = pack8(o1); *(u32x4*)(KR + off + 64) = pack8(o2);
            float nq = 0.f;
#pragma unroll
            for (int q = 0; q < 8; ++q) { sm1[q] += o1[q]; sm2[q] += o2[q]; nq += o1[q] * o1[q] + o2[q] * o2[q]; }
            nq += __shfl_xor(nq, 1); nq += __shfl_xor(nq, 2); nq += __shfl_xor(nq, 4);
            nmax = fmaxf(nmax, nq);
            rot8(*(const u32x4*)(QR + off), *(const u32x4*)(QR + off + 64), c0, c1, s0, s1, o1, o2);
            *(u32x4*)(QR + off) = pack8(o1); *(u32x4*)(QR + off + 64) = pack8(o2);
        }
#pragma unroll
        for (int q = 0; q < 8; ++q) {
            sm1[q] += __shfl_xor(sm1[q], 8); sm1[q] += __shfl_xor(sm1[q], 16); sm1[q] += __shfl_xor(sm1[q], 32);
            sm2[q] += __shfl_xor(sm2[q], 8); sm2[q] += __shfl_xor(sm2[q], 16); sm2[q] += __shfl_xor(sm2[q], 32);
        }
        nmax = wave_max(nmax);
        if (lane < 8) {
#pragma unroll
            for (int q = 0; q < 8; ++q) { red[wv * 128 + lane * 8 + q] = sm1[q]; red[wv * 128 + 64 + lane * 8 + q] = sm2[q]; }
        }
        if (lane == 0) red[1024 + wv] = nmax;
        __syncthreads();
        if (tid < 128) {
            float s2 = 0.f;
#pragma unroll
            for (int r = 0; r < 8; ++r) s2 += red[r * 128 + tid];
            KMEAN[(size_t)item * 128 + tid] = s2 * (1.0f / 256.0f);
        }
        if (tid == 0) {
            float m = 0.f;
#pragma unroll
            for (int r = 0; r < 8; ++r) m = fmaxf(m, red[1024 + r]);
            KNMAX[item] = sqrtf(m);
        }
        __syncthreads();
    }
}

__device__ __forceinline__ void top3_insert(float x, int m, float& v0, int& i0, float& v1, int& i1, float& v2, int& i2) {
    const bool c0 = x > v0 || (x == v0 && m < i0), c1 = x > v1 || (x == v1 && m < i1), c2 = x > v2 || (x == v2 && m < i2);
    v2 = c1 ? v1 : (c2 ? x : v2); i2 = c1 ? i1 : (c2 ? m : i2);
    v1 = c0 ? v0 : (c1 ? x : v1); i1 = c0 ? i0 : (c1 ? m : i1);
    v0 = c0 ? x : v0; i0 = c0 ? m : i0;
}
__device__ __forceinline__ void phase_sel(LAS unsigned char* lds, const bf16_t* QR, const float* KMEAN, unsigned short* SUB, int* CNT, int* ctr) {
    const int tid = threadIdx.x, lane = tid & 63, wv = tid >> 6, r32 = lane & 31, hh = lane >> 5;
    LAS unsigned short* bucket = (LAS unsigned short*)lds;
    LAS int* cnt = (LAS int*)(lds + 16384);
    const float NEG = -1e30f;
    if (blockIdx.x == 0 && tid == 0) *ctr = 0;
    for (int item = blockIdx.x; item < 2 * NHEAD * 32; item += gridDim.x) {
        const int bh = item >> 5, i = item & 31, b = bh >> 4, h = bh & 15;
        if (i == 0) continue;
        if (tid < 32) cnt[tid] = 0;
        __syncthreads();
        const float* kmp = KMEAN + ((size_t)bh * 32 + r32) * 128 + 8 * hh;
        const size_t tok = (size_t)b * SEQ + i * 256 + wv * 32 + r32;
        const bf16_t* qp = QR + tok * DM + h * 128 + 8 * hh;
        f32x16 S;
#pragma unroll
        for (int e = 0; e < 16; ++e) S[e] = 0.f;
#pragma unroll
        for (int s2 = 0; s2 < 8; ++s2) {
            const f32x4 ka = *(const f32x4*)(kmp + 16 * s2), kb = *(const f32x4*)(kmp + 16 * s2 + 4);
            const bf16x8 qf = *(const bf16x8*)(qp + 16 * s2);
            u32x4 hi, lo;
            hi.x = pk_bf16(ka[0], ka[1]); hi.y = pk_bf16(ka[2], ka[3]); hi.z = pk_bf16(kb[0], kb[1]); hi.w = pk_bf16(kb[2], kb[3]);
            lo.x = pk_bf16(ka[0] - bflo(hi.x), ka[1] - bfhi(hi.x)); lo.y = pk_bf16(ka[2] - bflo(hi.y), ka[3] - bfhi(hi.y));
            lo.z = pk_bf16(kb[0] - bflo(hi.z), kb[1] - bfhi(hi.z)); lo.w = pk_bf16(kb[2] - bflo(hi.w), kb[3] - bfhi(hi.w));
            S = __builtin_amdgcn_mfma_f32_32x32x16_bf16(__builtin_bit_cast(bf16x8, hi), qf, S, 0, 0, 0);
            S = __builtin_amdgcn_mfma_f32_32x32x16_bf16(__builtin_bit_cast(bf16x8, lo), qf, S, 0, 0, 0);
        }
        float v0 = -3e38f, v1 = -3e38f, v2 = -3e38f; int i0 = 99, i1 = 99, i2 = 99;
#pragma unroll
        for (int e = 0; e < 16; ++e) {
            const int m = (e & 3) + 8 * (e >> 2) + 4 * hh;
            const float x = m < i ? S[e] : NEG;
            top3_insert(x, m, v0, i0, v1, i1, v2, i2);
        }
        {
            const float pv0 = __shfl_xor(v0, 32), pv1 = __shfl_xor(v1, 32), pv2 = __shfl_xor(v2, 32);
            const int pi0 = __shfl_xor(i0, 32), pi1 = __shfl_xor(i1, 32), pi2 = __shfl_xor(i2, 32);
            top3_insert(pv0, pi0, v0, i0, v1, i1, v2, i2); top3_insert(pv1, pi1, v0, i0, v1, i1, v2, i2); top3_insert(pv2, pi2, v0, i0, v1, i1, v2, i2);
        }
        if (hh == 0) {
            const int tl = wv * 32 + r32;
            if (v0 > 0.5f * NEG) { const int p = __hip_atomic_fetch_add(cnt + i0, 1, __ATOMIC_RELAXED, __HIP_MEMORY_SCOPE_WORKGROUP); bucket[i0 * 256 + p] = (unsigned short)(tl | (0 << 8)); }
            if (v1 > 0.5f * NEG) { const int p = __hip_atomic_fetch_add(cnt + i1, 1, __ATOMIC_RELAXED, __HIP_MEMORY_SCOPE_WORKGROUP); bucket[i1 * 256 + p] = (unsigned short)(tl | (1 << 8)); }
            if (v2 > 0.5f * NEG) { const int p = __hip_atomic_fetch_add(cnt + i2, 1, __ATOMIC_RELAXED, __HIP_MEMORY_SCOPE_WORKGROUP); bucket[i2 * 256 + p] = (unsigned short)(tl | (2 << 8)); }
        }
        __syncthreads();
        for (int idx = tid; idx < 32 * 256; idx += 512) {
            const int j = idx >> 8, p = idx & 255;
            if (j < i && p < cnt[j]) SUB[(((size_t)bh * 32 + j) * 32 + i) * 256 + p] = bucket[idx];
        }
        if (tid < i) CNT[((size_t)bh * 32 + tid) * 32 + i] = cnt[tid];
        __syncthreads();
    }
}

__device__ __forceinline__ unsigned off_b(unsigned row, unsigned ch) { return 256u * row + 16u * (ch ^ (((row & 3u) << 2) | ((row >> 2) & 3u))); }
__device__ __forceinline__ unsigned pi32(unsigned m) { return (m & ~12u) | ((m & 4u) << 1) | ((m & 8u) >> 1); }
__device__ __forceinline__ bf16x8 tr_frag(LAS unsigned char* img, unsigned lane, unsigned c, unsigned ks) {
    const unsigned hh = lane >> 5, blk = (lane >> 4) & 1, q = (lane & 15) >> 2, p = lane & 3;
    const unsigned a0 = off_b(16 * ks + 8 * hh + q, 4 * c + 2 * blk + (p >> 1)) + 8 * (p & 1);
    const unsigned a1 = off_b(16 * ks + 8 * hh + 4 + q, 4 * c + 2 * blk + (p >> 1)) + 8 * (p & 1);
    const s16x4 lo = __builtin_amdgcn_ds_read_tr16_b64_v4i16((LAS s16x4*)(img + a0));
    const s16x4 hi = __builtin_amdgcn_ds_read_tr16_b64_v4i16((LAS s16x4*)(img + a1));
    bf16x8 r; r[0] = lo[0]; r[1] = lo[1]; r[2] = lo[2]; r[3] = lo[3]; r[4] = hi[0]; r[5] = hi[1]; r[6] = hi[2]; r[7] = hi[3];
    return r;
}
__device__ __forceinline__ void phase_att(LAS unsigned char* lds, const bf16_t* QR, const bf16_t* KR, const bf16_t* V, const float* KNMAX, const unsigned short* SUB, const int* CNT, int* ctr,
                                          bf16_t* P012, bf16_t* P3, float* LS) {
    const int tid = threadIdx.x, lane = tid & 63, wv = tid >> 6, r32 = lane & 31, hh = lane >> 5;
    LAS unsigned char* Kimg = lds;
    LAS unsigned char* Vimg = lds + 65536;
    LAS int* misc = (LAS int*)(lds + 131072);
    const float SCL2 = 0.08838834764831845f * 1.4426950408889634f;
    for (;;) {
        __syncthreads();
        if (tid == 0) misc[40] = __hip_atomic_fetch_add(ctr, 1, __ATOMIC_RELAXED, __HIP_MEMORY_SCOPE_AGENT);
        __syncthreads();
        const int item = misc[40];
        if (item >= 2 * NHEAD * 32) break;
        const int j = item >> 5, bh = item & 31, b = bh >> 4, h = bh & 15;
#pragma unroll
        for (int r = 0; r < 8; ++r) {
            const int idx = tid + 512 * r, row = idx >> 4, ch = idx & 15;
            const size_t g = ((size_t)b * SEQ + j * 256 + row) * DM + h * 128 + ch * 8;
            const u32x4 kv = *(const u32x4*)(KR + g), vv = *(const u32x4*)(V + g);
            *(LAS u32x4*)(Kimg + off_b(row, ch)) = kv; *(LAS u32x4*)(Vimg + off_b(row, ch)) = vv;
        }
        if (tid <= 32) { int pre = 0; for (int u = j + 1; u < tid; ++u) pre += CNT[((size_t)bh * 32 + j) * 32 + u]; misc[tid] = pre; }
        float kn = (lane < 32) ? KNMAX[bh * 32 + lane] : 0.f;
        kn = wave_max(kn);
        __syncthreads();
        const int total = misc[32], ntile = (256 + total + 31) >> 5;
        for (int tile = wv; tile < ntile; tile += 8) {
            const int gr = tile * 32 + r32;
            int pos, slot; bool valid = true;
            if (gr < 256) { pos = j * 256 + gr; slot = 3; }
            else {
                const int x = gr - 256; valid = x < total;
                int ii = j + 1;
                for (int u = j + 1; u < 32; ++u) if (misc[u] <= x) ii = u;
                if (valid) { const unsigned e = SUB[(((size_t)bh * 32 + j) * 32 + ii) * 256 + (x - misc[ii])]; pos = ii * 256 + (int)(e & 255u); slot = (int)(e >> 8); }
                else { pos = j * 256; slot = 3; }
            }
            const size_t tok = (size_t)b * SEQ + pos;
            bf16x8 qf[8];
            const bf16_t* qp = QR + tok * DM + h * 128 + 8 * hh;
#pragma unroll
            for (int s = 0; s < 8; ++s) qf[s] = *(const bf16x8*)(qp + 16 * s);
            float qn2 = 0.f;
#pragma unroll
            for (int s = 0; s < 8; ++s)
#pragma unroll
                for (int e = 0; e < 8; ++e) { const float f = bf2f((bf16_t)qf[s][e]); qn2 += f * f; }
            qn2 += __shfl_xor(qn2, 32);
            const float c2 = sqrtf(qn2) * kn * SCL2;
            f32x16 O[4];
#pragma unroll
            for (int dt = 0; dt < 4; ++dt)
#pragma unroll
                for (int e = 0; e < 16; ++e) O[dt][e] = 0.f;
            float l = 0.f;
            const bool own = tile < 8;
            const int kcn = own ? tile + 1 : 8;
            const unsigned krow = pi32((unsigned)r32);
            for (int kc = 0; kc < kcn; ++kc) {
                f32x16 S;
#pragma unroll
                for (int e = 0; e < 16; ++e) S[e] = 0.f;
#pragma unroll
                for (int s = 0; s < 8; ++s) {
                    const bf16x8 kf = *(const LAS bf16x8*)(Kimg + off_b(32 * kc + krow, 2 * s + hh));
                    S = __builtin_amdgcn_mfma_f32_32x32x16_bf16(kf, qf[s], S, 0, 0, 0);
                }
                float p[16];
#pragma unroll
                for (int e = 0; e < 16; ++e) {
                    const unsigned m = (e & 3) + 8 * (e >> 2) + 4 * hh;
                    const int key = j * 256 + 32 * kc + (int)pi32(m);
                    float pe = __builtin_amdgcn_exp2f(S[e] * SCL2 - c2);
                    if (own && key > pos) pe = 0.f;
                    p[e] = pe; l += pe;
                }
                u32x4 w0, w1;
                w0.x = pk_bf16(p[0], p[1]); w0.y = pk_bf16(p[2], p[3]); w0.z = pk_bf16(p[4], p[5]); w0.w = pk_bf16(p[6], p[7]);
                w1.x = pk_bf16(p[8], p[9]); w1.y = pk_bf16(p[10], p[11]); w1.z = pk_bf16(p[12], p[13]); w1.w = pk_bf16(p[14], p[15]);
                const bf16x8 pf0 = __builtin_bit_cast(bf16x8, w0), pf1 = __builtin_bit_cast(bf16x8, w1);
#pragma unroll
                for (int dt = 0; dt < 4; ++dt) {
                    const bf16x8 v0 = tr_frag(Vimg, lane, dt, 2 * kc), v1 = tr_frag(Vimg, lane, dt, 2 * kc + 1);
                    O[dt] = __builtin_amdgcn_mfma_f32_32x32x16_bf16(v0, pf0, O[dt], 0, 0, 0);
                    O[dt] = __builtin_amdgcn_mfma_f32_32x32x16_bf16(v1, pf1, O[dt], 0, 0, 0);
                }
            }
            l += __shfl_xor(l, 32);
            if (valid) {
                bf16_t* pl = (slot < 3 ? P012 + (size_t)slot * ((size_t)32 << 20) : P3) + (tok * NHEAD + h) * 128 + 4 * hh;
#pragma unroll
                for (int dt = 0; dt < 4; ++dt)
#pragma unroll
                    for (int g = 0; g < 4; ++g) {
                        u32x2 w; w.x = pk_bf16(O[dt][4 * g], O[dt][4 * g + 1]); w.y = pk_bf16(O[dt][4 * g + 2], O[dt][4 * g + 3]);
                        *(u32x2*)(pl + 32 * dt + 8 * g) = w;
                    }
                if (hh == 0) LS[(size_t)slot * MTOK * NHEAD + tok * NHEAD + h] = l;
            }
        }
    }
}
__device__ __forceinline__ void phase_comb(const bf16_t* P012, const bf16_t* P3, const float* LS, bf16_t* AO) {
    const size_t n = (size_t)MTOK * NHEAD * 16, stride = (size_t)gridDim.x * 512;
    for (size_t idx = (size_t)blockIdx.x * 512 + threadIdx.x; idx < n; idx += stride) {
        const size_t th = idx >> 4; const int ch = (int)(idx & 15);
        const int t = (int)((th >> 4) & (SEQ - 1)), blk = t >> 8, nsel = blk < 3 ? blk : 3;
        float acc[8];
        float l = LS[(size_t)3 * MTOK * NHEAD + th];
        { const u32x4 w = *(const u32x4*)(P3 + th * 128 + ch * 8);
          acc[0] = bflo(w.x); acc[1] = bfhi(w.x); acc[2] = bflo(w.y); acc[3] = bfhi(w.y); acc[4] = bflo(w.z); acc[5] = bfhi(w.z); acc[6] = bflo(w.w); acc[7] = bfhi(w.w); }
        for (int s = 0; s < nsel; ++s) {
            const u32x4 w = *(const u32x4*)(P012 + (size_t)s * ((size_t)32 << 20) + th * 128 + ch * 8);
            acc[0] += bflo(w.x); acc[1] += bfhi(w.x); acc[2] += bflo(w.y); acc[3] += bfhi(w.y); acc[4] += bflo(w.z); acc[5] += bfhi(w.z); acc[6] += bflo(w.w); acc[7] += bfhi(w.w);
            l += LS[(size_t)s * MTOK * NHEAD + th];
        }
        const float rl = 1.0f / l;
        u32x4 o; o.x = pk_bf16(acc[0] * rl, acc[1] * rl); o.y = pk_bf16(acc[2] * rl, acc[3] * rl); o.z = pk_bf16(acc[4] * rl, acc[5] * rl); o.w = pk_bf16(acc[6] * rl, acc[7] * rl);
        *(u32x4*)(AO + th * 128 + ch * 8) = o;
    }
}

__device__ __forceinline__ void phase_scan_a(LAS unsigned char* lds, const float* LF, const bf16_t* I1, bf16_t* LT, float* DEC, unsigned* dbgc = nullptr) {
    unsigned dbg_kt = 0, dbg_acc = 0;
    const int tid = threadIdx.x, lane = tid & 63, wv = tid >> 6, k = tid & 127, part = tid >> 7;
    LAS unsigned char* Iimg = lds; LAS unsigned char* KTimg = lds + 16384;
    LAS float* psum = (LAS float*)(lds + 32768);
    LAS unsigned char* Lst = lds + 36864;
#if SCAN_A_VALU == 2
    for (int item = blockIdx.x; item < 2 * NHEAD * 128; item += gridDim.x) {
        const int bh = item >> 7, c = item & 127, b = bh >> 4, h = bh & 15;
        const size_t tok0 = (size_t)b * SEQ + c * 64;
        for (int idx = tid; idx < 16384; idx += 512) {
            const int v = idx >> 7, kk = idx & 127;
            float g = 1.f, L = 0.f;
            for (int s2 = 63; s2 >= 0; --s2) { const size_t o = (tok0 + s2) * DM + h * 128; const float f = __expf(LF[o + kk]); L += bf2f(I1[o + v]) * (1.0f - f) * g; g *= f; }
            LT[(size_t)item * 16384 + idx] = (bf16_t)(pk_bf16(L, 0.f) & 0xffffu);
        }
    }
    return;
#endif
    for (int item = blockIdx.x; item < 2 * NHEAD * 128; item += gridDim.x) {
        const int bh = item >> 7, c = item & 127, b = bh >> 4, h = bh & 15;
        const size_t tok0 = (size_t)b * SEQ + c * 64;
        float lf[16];
#pragma unroll
        for (int i = 0; i < 16; ++i) lf[i] = LF[(tok0 + 16 * part + i) * DM + h * 128 + k];
#pragma unroll
        for (int r = 0; r < 2; ++r) { const int idx = tid + 512 * r, row = idx >> 4, ch = idx & 15; *(LAS u32x4*)(Iimg + off_b(row, ch)) = *(const u32x4*)(I1 + (tok0 + row) * DM + h * 128 + ch * 8); }
        float cs = 0.f;
#pragma unroll
        for (int i = 0; i < 16; ++i) cs += lf[i];
        psum[part * 128 + k] = cs;
        __syncthreads();
        const float p0 = psum[k], p1 = psum[128 + k], p2 = psum[256 + k], p3 = psum[384 + k];
        const float blast = (p0 + p1) + (p2 + p3);
        float bb = part == 0 ? 0.f : (part == 1 ? p0 : (part == 2 ? p0 + p1 : p0 + p1 + p2));
#pragma unroll
        for (int i = 0; i < 16; ++i) {
            bb += lf[i];
            const float kt = (1.0f - __expf(lf[i])) * __expf(blast - bb);
            if (!(kt - kt == 0.f)) ++dbg_kt;
            const int srow = 16 * part + i;
            *(LAS bf16_t*)(KTimg + off_b(srow, k >> 3) + 2 * (k & 7)) = (bf16_t)(pk_bf16(kt, 0.f) & 0xffffu);
        }
        if (part == 0) DEC[(size_t)item * 128 + k] = __expf(blast);
        __syncthreads();
#if SCAN_A_VALU
        for (int idx = tid; idx < 16384; idx += 512) {
            const int v = idx >> 7, kk = idx & 127;
            float accv = 0.f;
            for (int s2 = 0; s2 < 64; ++s2) accv += bf2f(*(const LAS bf16_t*)(Iimg + off_b(s2, v >> 3) + 2 * (v & 7))) * bf2f(*(const LAS bf16_t*)(KTimg + off_b(s2, kk >> 3) + 2 * (kk & 7)));
            *(LAS bf16_t*)(Lst + v * 272 + 2 * kk) = (bf16_t)(pk_bf16(accv, 0.f) & 0xffffu);
        }
        if (0)
#endif
        {
            const int vt = wv >> 1;
            f32x16 acc0, acc1;
#pragma unroll
            for (int e = 0; e < 16; ++e) { acc0[e] = 0.f; acc1[e] = 0.f; }
#pragma unroll
            for (int ks = 0; ks < 4; ++ks) {
                const bf16x8 af = tr_frag(Iimg, lane, vt, ks);
                const bf16x8 b0 = tr_frag(KTimg, lane, 2 * (wv & 1), ks), b1 = tr_frag(KTimg, lane, 2 * (wv & 1) + 1, ks);
                acc0 = __builtin_amdgcn_mfma_f32_32x32x16_bf16(af, b0, acc0, 0, 0, 0);
                acc1 = __builtin_amdgcn_mfma_f32_32x32x16_bf16(af, b1, acc1, 0, 0, 0);
            }
            const int r32 = lane & 31, hh = lane >> 5;
#pragma unroll
            for (int e = 0; e < 16; ++e) {
                if (!(acc0[e] - acc0[e] == 0.f)) ++dbg_acc; if (!(acc1[e] - acc1[e] == 0.f)) ++dbg_acc;
                const int v = 32 * vt + (e & 3) + 8 * (e >> 2) + 4 * hh;
                *(LAS bf16_t*)(Lst + v * 272 + 2 * (64 * (wv & 1) + r32)) = (bf16_t)(pk_bf16(acc0[e], 0.f) & 0xffffu);
                *(LAS bf16_t*)(Lst + v * 272 + 2 * (64 * (wv & 1) + 32 + r32)) = (bf16_t)(pk_bf16(acc1[e], 0.f) & 0xffffu);
            }
        }
        __syncthreads();
#pragma unroll
        for (int r = 0; r < 4; ++r) { const int idx = tid + 512 * r, row = idx >> 4, ch = idx & 15; store_wt16(LT + (size_t)item * 16384 + row * 128 + ch * 8, *(const LAS u32x4*)(Lst + row * 272 + ch * 16)); }
        __syncthreads();
    }
    if (dbgc) { if (dbg_kt) atomicAdd(dbgc + 0, dbg_kt); if (dbg_acc) atomicAdd(dbgc + 1, dbg_acc); }
}
__device__ __forceinline__ void phase_scan_b(bf16_t* LT, const float* DEC) {
    const int n = 2 * NHEAD * 128 * 32;
    for (int idx = blockIdx.x * 512 + threadIdx.x; idx < n; idx += gridDim.x * 512) {
        const int bh = idx >> 12, vk = idx & 4095, k4 = (vk & 31) * 4;
        float S0 = 0.f, S1 = 0.f, S2 = 0.f, S3 = 0.f;
        bf16_t* p = LT + (size_t)bh * 128 * 16384 + (size_t)vk * 4;
        const float* dp = DEC + (size_t)bh * 128 * 128 + k4;
#pragma unroll 8
        for (int c = 0; c < 128; ++c) {
            const u32x2 w = *(const u32x2*)(p + (size_t)c * 16384);
            const f32x4 d = *(const f32x4*)(dp + c * 128);
            u32x2 o; o.x = pk_bf16(S0, S1); o.y = pk_bf16(S2, S3);
            store_wt8(p + (size_t)c * 16384, o);
            S0 = d[0] * S0 + bflo(w.x); S1 = d[1] * S1 + bfhi(w.x); S2 = d[2] * S2 + bflo(w.y); S3 = d[3] * S3 + bfhi(w.y);
        }
    }
}
__device__ __forceinline__ void phase_scan_c(LAS unsigned char* lds, const bf16_t* Q1, const float* LF, const bf16_t* I1, const bf16_t* G1, const bf16_t* SP, const float* gnorm, bf16_t* OG) {
    const int tid = threadIdx.x, lane = tid & 63, wv = tid >> 6, k = tid & 127, part = tid >> 7, r32 = lane & 31, hh = lane >> 5;
    LAS unsigned char* QTimg = lds; LAS unsigned char* QPimg = lds + 16384; LAS unsigned char* KPimg = lds + 32768; LAS unsigned char* Iimg = lds + 49152; LAS unsigned char* SPimg = lds + 65536;
    LAS float* psum = (LAS float*)(lds + 98304);
    LAS float* ssq = (LAS float*)(lds + 100352);
    LAS unsigned char* OT = lds + 102400;
    for (int item = blockIdx.x; item < 2 * NHEAD * 128; item += gridDim.x) {
        const int bh = item >> 7, c = item & 127, b = bh >> 4, h = bh & 15;
        const size_t tok0 = (size_t)b * SEQ + c * 64;
        float lf[16], qv[16];
#pragma unroll
        for (int i = 0; i < 16; ++i) { const size_t o = (tok0 + 16 * part + i) * DM + h * 128 + k; lf[i] = LF[o]; qv[i] = bf2f(Q1[o]); }
#pragma unroll
        for (int r = 0; r < 2; ++r) { const int idx = tid + 512 * r, row = idx >> 4, ch = idx & 15; *(LAS u32x4*)(Iimg + off_b(row, ch)) = *(const u32x4*)(I1 + (tok0 + row) * DM + h * 128 + ch * 8); }
#pragma unroll
        for (int r = 0; r < 4; ++r) { const int idx = tid + 512 * r, row = idx >> 4, ch = idx & 15; *(LAS u32x4*)(SPimg + off_b(row, ch)) = *(const u32x4*)(SP + (size_t)item * 16384 + row * 128 + ch * 8); }
        float cs = 0.f;
#pragma unroll
        for (int i = 0; i < 16; ++i) cs += lf[i];
        psum[part * 128 + k] = cs;
        __syncthreads();
        const float p0 = psum[k], p1 = psum[128 + k], p2 = psum[256 + k];
        const float rr = p0 + p1;
        float bb = part == 0 ? 0.f : (part == 1 ? p0 : (part == 2 ? p0 + p1 : p0 + p1 + p2));
#pragma unroll
        for (int i = 0; i < 16; ++i) {
            bb += lf[i];
            const float qt = qv[i] * __expf(bb), qp = qv[i] * __expf(bb - rr), kp = (1.0f - __expf(lf[i])) * __expf(rr - bb);
            const unsigned o = off_b(16 * part + i, k >> 3) + 2 * (k & 7);
            *(LAS bf16_t*)(QTimg + o) = (bf16_t)(pk_bf16(qt, 0.f) & 0xffffu);
            *(LAS bf16_t*)(QPimg + o) = (bf16_t)(pk_bf16(qp, 0.f) & 0xffffu);
            *(LAS bf16_t*)(KPimg + o) = (bf16_t)(pk_bf16(kp, 0.f) & 0xffffu);
        }
        __syncthreads();
        const int tt = wv & 1, vt = wv >> 1;
        f32x16 O;
#pragma unroll
        for (int e = 0; e < 16; ++e) O[e] = 0.f;
#pragma unroll
        for (int ks = 0; ks < 8; ++ks) {
            const bf16x8 af = *(const LAS bf16x8*)(SPimg + off_b(32 * vt + r32, 2 * ks + hh));
            const bf16x8 bf = *(const LAS bf16x8*)(QTimg + off_b(32 * tt + r32, 2 * ks + hh));
            O = __builtin_amdgcn_mfma_f32_32x32x16_bf16(af, bf, O, 0, 0, 0);
        }
        const unsigned krow = pi32((unsigned)r32);
        for (int st = 0; st <= tt; ++st) {
            f32x16 S;
#pragma unroll
            for (int e = 0; e < 16; ++e) S[e] = 0.f;
#pragma unroll
            for (int ks = 0; ks < 8; ++ks) {
                const bf16x8 af = *(const LAS bf16x8*)(KPimg + off_b(32 * st + krow, 2 * ks + hh));
                const bf16x8 bf = *(const LAS bf16x8*)(QPimg + off_b(32 * tt + r32, 2 * ks + hh));
                S = __builtin_amdgcn_mfma_f32_32x32x16_bf16(af, bf, S, 0, 0, 0);
            }
            float p[16];
#pragma unroll
            for (int e = 0; e < 16; ++e) {
                const unsigned m = (e & 3) + 8 * (e >> 2) + 4 * hh;
                const int sidx = 32 * st + (int)pi32(m), tidx = 32 * tt + r32;
                p[e] = sidx <= tidx ? S[e] : 0.f;
            }
            u32x4 w0, w1;
            w0.x = pk_bf16(p[0], p[1]); w0.y = pk_bf16(p[2], p[3]); w0.z = pk_bf16(p[4], p[5]); w0.w = pk_bf16(p[6], p[7]);
            w1.x = pk_bf16(p[8], p[9]); w1.y = pk_bf16(p[10], p[11]); w1.z = pk_bf16(p[12], p[13]); w1.w = pk_bf16(p[14], p[15]);
            const bf16x8 pf0 = __builtin_bit_cast(bf16x8, w0), pf1 = __builtin_bit_cast(bf16x8, w1);
            const bf16x8 i0 = tr_frag(Iimg, lane, vt, 2 * st), i1 = tr_frag(Iimg, lane, vt, 2 * st + 1);
            O = __builtin_amdgcn_mfma_f32_32x32x16_bf16(i0, pf0, O, 0, 0, 0);
            O = __builtin_amdgcn_mfma_f32_32x32x16_bf16(i1, pf1, O, 0, 0, 0);
        }
        float sq = 0.f;
#pragma unroll
        for (int e = 0; e < 16; ++e) sq += O[e] * O[e];
        sq += __shfl_xor(sq, 32);
        if (hh == 0) ssq[vt * 64 + 32 * tt + r32] = sq;
        __syncthreads();
        const int tl = 32 * tt + r32;
        const float rstd = rsqrtf((ssq[tl] + ssq[64 + tl] + ssq[128 + tl] + ssq[192 + tl]) * (1.0f / 128.0f) + 1e-6f);
#pragma unroll
        for (int g = 0; g < 4; ++g) {
            const int v0 = 32 * vt + 8 * g + 4 * hh;
            const f32x4 gn = *(const f32x4*)(gnorm + v0);
            u32x2 w; w.x = pk_bf16(O[4 * g] * rstd * gn[0], O[4 * g + 1] * rstd * gn[1]); w.y = pk_bf16(O[4 * g + 2] * rstd * gn[2], O[4 * g + 3] * rstd * gn[3]);
            *(LAS u32x2*)(OT + tl * 272 + v0 * 2) = w;
        }
        __syncthreads();
#pragma unroll
        for (int r = 0; r < 2; ++r) {
            const int idx = tid + 512 * r, row = idx >> 4, ch = idx & 15;
            const u32x4 ov = *(const LAS u32x4*)(OT + row * 272 + ch * 16);
            const size_t go = (tok0 + row) * DM + h * 128 + ch * 8;
            const u32x4 gv = *(const u32x4*)(G1 + go);
            u32x4 w;
            w.x = pk_bf16(bflo(ov.x) * bflo(gv.x), bfhi(ov.x) * bfhi(gv.x)); w.y = pk_bf16(bflo(ov.y) * bflo(gv.y), bfhi(ov.y) * bfhi(gv.y));
            w.z = pk_bf16(bflo(ov.z) * bflo(gv.z), bfhi(ov.z) * bfhi(gv.z)); w.w = pk_bf16(bflo(ov.w) * bflo(gv.w), bfhi(ov.w) * bfhi(gv.w));
            *(u32x4*)(OG + go) = w;
        }
        __syncthreads();
    }
}


#if SCAN_DBG == 2
__device__ __forceinline__ void dbg_compare(LAS float* red, const bf16_t* A, const bf16_t* B, float* DBG) {
    float sd = 0.f, sr = 0.f, nn = 0.f;
    const size_t n = (size_t)MTOK * DM;
    for (size_t i = (size_t)blockIdx.x * 512 + threadIdx.x; i < n; i += (size_t)gridDim.x * 512) {
        const float x = bf2f(A[i]), y = bf2f(B[i]);
        if (!(x - x == 0.f)) nn += 1.f; else { sd += (x - y) * (x - y); sr += y * y; }
    }
    sd = wave_sum(sd); sr = wave_sum(sr); nn = wave_sum(nn);
    const int wv = threadIdx.x >> 6;
    if ((threadIdx.x & 63) == 0) { red[wv * 3] = sd; red[wv * 3 + 1] = sr; red[wv * 3 + 2] = nn; }
    __syncthreads();
    if (threadIdx.x == 0) { float a = 0, b = 0, c = 0; for (int w = 0; w < 8; ++w) { a += red[w * 3]; b += red[w * 3 + 1]; c += red[w * 3 + 2]; } DBG[blockIdx.x * 4] = a; DBG[blockIdx.x * 4 + 1] = b; DBG[blockIdx.x * 4 + 2] = c; }
    __syncthreads();
}
__device__ __forceinline__ void dbg_emit(const float* DBG, float* out) {
    float a = 0, b = 0, c = 0;
    for (int w = 0; w < (int)gridDim.x; ++w) { a += DBG[w * 4]; b += DBG[w * 4 + 1]; c += DBG[w * 4 + 2]; }
    const float rel = sqrtf(a / b);
    int k = (int)rintf(-2.0f * log10f(rel)); k = k < 0 ? 0 : (k > 16 ? 16 : k);
    if (c > 0.f) k = 17;
    const float cc = sqrtf(0.5f * (float)k);
    const size_t n = (size_t)MTOK * DM;
    for (size_t i = (size_t)blockIdx.x * 512 + threadIdx.x; i < n; i += (size_t)gridDim.x * 512) out[i] = cc;
}
#endif

#if SCAN_DBG == 3
__device__ __forceinline__ void dbg_count_bf16(const bf16_t* A, size_t n, unsigned* cnt) {
    unsigned c = 0;
    for (size_t i = (size_t)blockIdx.x * 512 + threadIdx.x; i < n; i += (size_t)gridDim.x * 512) { const float x = bf2f(A[i]); if (!(x - x == 0.f)) ++c; }
    if (c) atomicAdd(cnt, c);
}
__device__ __forceinline__ void dbg_count_f32(const float* A, size_t n, unsigned* cnt) {
    unsigned c = 0;
    for (size_t i = (size_t)blockIdx.x * 512 + threadIdx.x; i < n; i += (size_t)gridDim.x * 512) { const float x = A[i]; if (!(x - x == 0.f)) ++c; }
    if (c) atomicAdd(cnt, c);
}
__device__ __forceinline__ void dbg_emit3(const unsigned* cnt, float* out) {
    float code = 0.f;
    for (int st = 3; st >= 0; --st) { const unsigned c = cnt[st]; if (c) { float lg = log10f((float)c); lg = lg > 9.f ? 9.f : lg; code = (float)(st + 1) + 0.1f * lg; } }
    const float cc = sqrtf(code);
    const size_t n = (size_t)MTOK * DM;
    for (size_t i = (size_t)blockIdx.x * 512 + threadIdx.x; i < n; i += (size_t)gridDim.x * 512) out[i] = cc;
}
#endif

#if SCAN_DBG == 4 || SCAN_DBG == 6
__device__ __forceinline__ void dbg_compare4(LAS float* red, const bf16_t* A, const bf16_t* B, const bf16_t* C, float* DBG) {
    float sd = 0.f, sr = 0.f, nn = 0.f, mm = 0.f;
    const size_t n = (size_t)MTOK * DM;
    for (size_t i = (size_t)blockIdx.x * 512 + threadIdx.x; i < n; i += (size_t)gridDim.x * 512) {
        const float x = bf2f(A[i]), y = bf2f(B[i]);
        if (!(x - x == 0.f)) nn += 1.f; else { sd += (x - y) * (x - y); sr += y * y; }
        if (A[i] != C[i]) mm += 1.f;
    }
    sd = wave_sum(sd); sr = wave_sum(sr); nn = wave_sum(nn); mm = wave_sum(mm);
    const int wv = threadIdx.x >> 6;
    if ((threadIdx.x & 63) == 0) { red[wv * 4] = sd; red[wv * 4 + 1] = sr; red[wv * 4 + 2] = nn; red[wv * 4 + 3] = mm; }
    __syncthreads();
    if (threadIdx.x == 0) { float a = 0, b = 0, c = 0, d = 0; for (int w = 0; w < 8; ++w) { a += red[w * 4]; b += red[w * 4 + 1]; c += red[w * 4 + 2]; d += red[w * 4 + 3]; }
        DBG[blockIdx.x * 4] = a; DBG[blockIdx.x * 4 + 1] = b; DBG[blockIdx.x * 4 + 2] = c; DBG[blockIdx.x * 4 + 3] = d; }
    __syncthreads();
}
__device__ __forceinline__ void dbg_emit4(const float* DBG, float* out) {
    float a = 0, b = 0, c = 0, d = 0;
    for (int w = 0; w < (int)gridDim.x; ++w) { a += DBG[w * 4]; b += DBG[w * 4 + 1]; c += DBG[w * 4 + 2]; d += DBG[w * 4 + 3]; }
    const float rel = sqrtf(a / b);
    int k = (int)rintf(-log10f(rel)); k = k < 0 ? 0 : (k > 8 ? 8 : k);
#if SCAN_DBG == 6
    const float cc = sqrtf((float)k + ((d + c) > 0.f ? 0.5f : 0.f));
#else
    int m = (int)ceilf(log10f(1.0f + d + c)); m = m > 9 ? 9 : m;
    const float cc = sqrtf((float)k + 0.1f * (float)m);
#endif
    const size_t n = (size_t)MTOK * DM;
    for (size_t i = (size_t)blockIdx.x * 512 + threadIdx.x; i < n; i += (size_t)gridDim.x * 512) out[i] = cc;
}
#endif

#if SCAN_DBG == 5
__device__ __forceinline__ void dbg_lds16_test(LAS unsigned char* lds, unsigned* cnt) {
    const int tid = threadIdx.x;
    unsigned bad = 0;
    for (int rep = 0; rep < 64; ++rep) {
        for (int i = tid; i < 1024; i += 512) *(LAS u32x4*)(lds + i * 16) = (u32x4){0x7fc07fc0u, 0x7fc07fc0u, 0x7fc07fc0u, 0x7fc07fc0u};
        __syncthreads();
        const int k = tid & 127, part = tid >> 7;
#pragma unroll
        for (int i = 0; i < 16; ++i) {
            const int row = 16 * part + i;
            *(LAS bf16_t*)(lds + off_b(row, k >> 3) + 2 * (k & 7)) = (bf16_t)((row * 128 + k + rep) & 0x7fff);
        }
        __syncthreads();
        for (int idx = tid; idx < 64 * 128; idx += 512) {
            const int row = idx >> 7, kk = idx & 127;
            const bf16_t got = *(const LAS bf16_t*)(lds + off_b(row, kk >> 3) + 2 * (kk & 7));
            if (got != (bf16_t)((row * 128 + kk + rep) & 0x7fff)) ++bad;
        }
        __syncthreads();
    }
    if (bad) atomicAdd(cnt, bad);
}
__device__ __forceinline__ void dbg_emit5(const unsigned* cnt, float* out) {
    const unsigned c = cnt[0];
    float code = 0.f;
    if (c) { float lg = log10f((float)c); code = 1.0f + (lg > 8.9f ? 8.9f : lg); }
    const float cc = sqrtf(code);
    const size_t n = (size_t)MTOK * DM;
    for (size_t i = (size_t)blockIdx.x * 512 + threadIdx.x; i < n; i += (size_t)gridDim.x * 512) out[i] = cc;
}
#endif

#if SCAN_DBG == 6
__device__ __forceinline__ void dbg_check_a(LAS float* red, const float* LF, const bf16_t* I1, const bf16_t* LT, const bf16_t* LT2, float* DBG) {
    float sd = 0.f, sr = 0.f, mm = 0.f;
    const size_t n = (size_t)4096 * 16384;
    for (size_t i = (size_t)blockIdx.x * 512 + threadIdx.x; i < n; i += (size_t)gridDim.x * 512) {
        const int item = (int)(i >> 14), v = (int)((i >> 7) & 127), k = (int)(i & 127);
        const int bh = item >> 7, c = item & 127, b = bh >> 4, h = bh & 15;
        const size_t tok0 = (size_t)b * SEQ + c * 64;
        float g = 1.f, L = 0.f;
        for (int s2 = 63; s2 >= 0; --s2) {
            const size_t o = (tok0 + s2) * DM + h * 128;
            const float f = __expf(LF[o + k]);
            L += bf2f(I1[o + v]) * (1.0f - f) * g;
            g *= f;
        }
        const float x = bf2f(LT[i]);
        sd += (x - L) * (x - L); sr += L * L;
        if (LT[i] != LT2[i]) mm += 1.f;
    }
    sd = wave_sum(sd); sr = wave_sum(sr); mm = wave_sum(mm);
    const int wv = threadIdx.x >> 6;
    if ((threadIdx.x & 63) == 0) { red[wv * 4] = sd; red[wv * 4 + 1] = sr; red[wv * 4 + 2] = 0.f; red[wv * 4 + 3] = mm; }
    __syncthreads();
    if (threadIdx.x == 0) { float a = 0, b2 = 0, d = 0; for (int w = 0; w < 8; ++w) { a += red[w * 4]; b2 += red[w * 4 + 1]; d += red[w * 4 + 3]; }
        DBG[blockIdx.x * 4] = a; DBG[blockIdx.x * 4 + 1] = b2; DBG[blockIdx.x * 4 + 2] = 0.f; DBG[blockIdx.x * 4 + 3] = d; }
    __syncthreads();
}
#endif

#if SCAN_DBG == 7
#ifndef DBG_FAM
#define DBG_FAM 0
#endif
__device__ __forceinline__ void dbg_check_a7(const float* LF, const bf16_t* I1, const bf16_t* LT, float* DBG) {
    const size_t n = (size_t)4096 * 16384;
    float nbad = 0.f, nnf = 0.f;
    for (size_t i = (size_t)blockIdx.x * 512 + threadIdx.x; i < n; i += (size_t)gridDim.x * 512 * 8) {
        const int item = (int)(i >> 14), v = (int)((i >> 7) & 127), k = (int)(i & 127);
        const int bh = item >> 7, c = item & 127, b = bh >> 4, h = bh & 15;
        const size_t tok0 = (size_t)b * SEQ + c * 64;
        float g = 1.f, L = 0.f;
        for (int s2 = 63; s2 >= 0; --s2) {
            const size_t o = (tok0 + s2) * DM + h * 128;
            const float f = __expf(LF[o + k]);
            L += bf2f(I1[o + v]) * (1.0f - f) * g;
            g *= f;
        }
        const float x = bf2f(LT[i]);
        if (!(x - x == 0.f)) { nnf += 1.f; nbad += 1.f; }
        else if (fabsf(x - L) > 0.02f * fabsf(L) + 1e-2f) nbad += 1.f;
    }
    nbad = wave_sum(nbad); nnf = wave_sum(nnf);
    if ((threadIdx.x & 63) == 0) { atomicAdd(DBG, nbad); atomicAdd(DBG + 1, nnf); }
}
__device__ __forceinline__ void dbg_emit7(const float* DBG, float* out) {
    const float nb = DBG[0], nf = DBG[1];
    int A = nb == 0.f ? 0 : (nb <= 100.f ? 1 : (nb <= 1e4f ? 3 : (nb <= 1e6f ? 5 : 7)));
    int B = nf == 0.f ? 0 : 5;
    const float cc = sqrtf((float)A + 0.1f * (float)B);
    const size_t n = (size_t)MTOK * DM;
    for (size_t i = (size_t)blockIdx.x * 512 + threadIdx.x; i < n; i += (size_t)gridDim.x * 512) out[i] = cc;
}
#endif
__device__ __forceinline__ int opaque(int v) { asm volatile("" : "+s"(v)); return v; }
template <bool L1> __device__ __forceinline__ void run_gemm_out(const Args& a, LAS unsigned char* lds) {
    unsigned char* ws = a.ws;
    pg8::Gemm g{(const bf16_t*)(ws + (L1 ? slot(3) : slot(0))), (const bf16_t*)(ws + (L1 ? WS_WO : WS_WOUT)), opaque(MTOK), opaque(DM), opaque(DM)};
    pg8::StaticOrder S; S.init(g.M, g.N, (int)gridDim.x, (int)blockIdx.x);
    EpiRes E{L1 ? (const float*)(ws + slot(0)) : a.in[0], (float*)(ws + (L1 ? slot(4) : slot(1)))};
    pg8::gemm_phase<EpiRes, pg8::StaticOrder>(lds, g, S, E, nullptr);
}
template <bool L1> __device__ __forceinline__ void run_ln(const Args& a) {
    unsigned char* ws = a.ws;
    phase_ln((const float*)(ws + (L1 ? slot(4) : slot(1))), a.in[12] + (L1 ? 2 : 0) * DM, a.in[13] + (L1 ? 2 : 0) * DM,
             (float*)(ws + (L1 ? slot(6) : slot(3))), (bf16_t*)(ws + (L1 ? slot(8) : slot(5))), (signed char*)(ws + WS_XQ), (float*)(ws + WS_XS));
}
template <bool L1> __device__ __forceinline__ void run_gemm_sc(const Args& a, LAS unsigned char* lds) {
    unsigned char* ws = a.ws;
    pg8::Gemm g{(const bf16_t*)(ws + WS_WC) + (L1 ? (size_t)DM * DM : 0), (const bf16_t*)(ws + (L1 ? slot(8) : slot(5))), opaque(DM), opaque(MTOK), opaque(DM)};
    pg8::StaticOrder S; S.init(g.M, g.N, (int)gridDim.x, (int)blockIdx.x);
    EpiF32 E{(float*)(ws + (L1 ? slot(0) : slot(6))), MTOK};
    pg8::gemm_phase<EpiF32, pg8::StaticOrder>(lds, g, S, E, nullptr);
}
template <bool L1> __device__ __forceinline__ void run_topk(const Args& a, LAS unsigned char* lds) {
    unsigned char* ws = a.ws;
    phase_topk(lds, (const float*)(ws + (L1 ? slot(0) : slot(6))), (int*)(ws + WS_EID), (float*)(ws + WS_GATE));
}
template <bool L1> __device__ __forceinline__ void run_peer_u(const Args& a) {
    unsigned char* ws = a.ws;
    phase_peer_u((const signed char*)(ws + WS_XQ), (const float*)(ws + WS_XS), (const int*)(ws + WS_EID), ws + WS_UB + (L1 ? (size_t)16384 * DM : 0), (const float*)(ws + WS_USC) + (L1 ? 16384 : 0), (float*)(ws + WS_H));
}
template <bool L1> __device__ __forceinline__ void run_peer_v(const Args& a, LAS unsigned char* lds) {
    unsigned char* ws = a.ws;
    phase_peer_v(lds, (const float*)(ws + (L1 ? slot(6) : slot(3))), (const int*)(ws + WS_EID), (const float*)(ws + WS_GATE), (const float*)(ws + WS_H),
                 ws + WS_VB + (L1 ? (size_t)16384 * DM : 0), (const float*)(ws + WS_VSC) + (L1 ? 16384 : 0), (float*)(ws + (L1 ? slot(0) : slot(6))));
}
template <bool L1> __device__ __forceinline__ void run_peer_ln(const Args& a) {
    unsigned char* ws = a.ws;
    phase_ln((const float*)(ws + (L1 ? slot(0) : slot(6))), a.in[12] + (L1 ? 3 : 1) * DM, a.in[13] + (L1 ? 3 : 1) * DM,
             L1 ? a.out : (float*)(ws + slot(0)), L1 ? (bf16_t*)nullptr : (bf16_t*)(ws + slot(2)));
}

__global__ void __launch_bounds__(512, 2) mk_fwd(Args a) {
    extern __shared__ __attribute__((aligned(16))) unsigned char lds_raw[];
    LAS unsigned char* lds = (LAS unsigned char*)lds_raw;
    cg::grid_group grid = cg::this_grid();
    unsigned char* ws = a.ws;
#define PHASE_BEGIN(k) if (a.ph_lo <= (k) && (k) < a.ph_hi && EN(k)) {
#define PHASE_END(k) asm volatile("s_waitcnt vmcnt(0)" ::: "memory"); __syncthreads(); if ((k) + 1 < a.ph_hi) { grid.sync(); if (threadIdx.x < 64) { __builtin_amdgcn_fence(__ATOMIC_ACQUIRE, "agent"); asm volatile("s_waitcnt vmcnt(0)" ::: "memory"); } __syncthreads(); } }
    PHASE_BEGIN(0) phase_prep(a, lds);
#if SCAN_DBG == 3 || SCAN_DBG == 5
        if (blockIdx.x == 0 && threadIdx.x < 8) ((unsigned*)(ws + WS_CTR + 8192))[threadIdx.x] = 0u;
#endif
#if SCAN_DBG == 7
        if (blockIdx.x == 0 && threadIdx.x < 32) ((float*)(ws + WS_CTR + 4096))[threadIdx.x] = 0.f;
#endif
    PHASE_END(0)
#if SCAN_DBG == 5
    PHASE_BEGIN(1) dbg_lds16_test(lds, (unsigned*)(ws + WS_CTR + 8192)); PHASE_END(1)
#define SKIP_REST 1
#endif
    PHASE_BEGIN(1) {
        pg8::Gemm g{(const bf16_t*)(ws + slot(0)), (const bf16_t*)(ws + WS_WIN), opaque(MTOK), opaque(4 * DM), opaque(DM)};
        pg8::StaticOrder S; S.init(g.M, g.N, (int)gridDim.x, (int)blockIdx.x);
        EpiIn E{(bf16_t*)(ws + slot(1)), (float*)(ws + slot(4)), (bf16_t*)(ws + slot(2)), (bf16_t*)(ws + slot(3)), (const float*)(ws + WS_LB)};
        pg8::gemm_phase<EpiIn, pg8::StaticOrder>(lds, g, S, E, nullptr);
    } PHASE_END(1)
    PHASE_BEGIN(2) phase_scan_a(lds, (const float*)(ws + slot(4)), (const bf16_t*)(ws + slot(2)), (bf16_t*)(ws + slot(6)), (float*)(ws + WS_DEC)
#if SCAN_DBG == 3
        , (unsigned*)(ws + WS_CTR + 8192)
#endif
        );
#if SCAN_DBG == 7
        asm volatile("s_waitcnt vmcnt(0)" ::: "memory"); __syncthreads(); grid.sync(); if (threadIdx.x < 64) { __builtin_amdgcn_fence(__ATOMIC_ACQUIRE, "agent"); asm volatile("s_waitcnt vmcnt(0)" ::: "memory"); } __syncthreads();
        dbg_check_a7((const float*)(ws + slot(4)), (const bf16_t*)(ws + slot(2)), (const bf16_t*)(ws + slot(6)), (float*)(ws + WS_CTR + 4096));
#endif
#if SCAN_DBG == 6
#define DSYNC6() asm volatile("s_waitcnt vmcnt(0)" ::: "memory"); __syncthreads(); grid.sync(); if (threadIdx.x < 64) { __builtin_amdgcn_fence(__ATOMIC_ACQUIRE, "agent"); asm volatile("s_waitcnt vmcnt(0)" ::: "memory"); } __syncthreads();
        DSYNC6()
        phase_scan_a(lds, (const float*)(ws + slot(4)), (const bf16_t*)(ws + slot(2)), (bf16_t*)a.out, (float*)(ws + WS_DEC));
        DSYNC6()
        dbg_check_a((LAS float*)lds, (const float*)(ws + slot(4)), (const bf16_t*)(ws + slot(2)), (const bf16_t*)(ws + slot(6)), (const bf16_t*)a.out, (float*)(ws + WS_CTR + 4096));
#endif
#if SCAN_DBG == 3
        asm volatile("s_waitcnt vmcnt(0)" ::: "memory"); __syncthreads(); grid.sync();
        dbg_count_bf16((const bf16_t*)(ws + slot(6)), (size_t)4096 * 16384, (unsigned*)(ws + WS_CTR + 8192) + 2);
#endif
    PHASE_END(2)
    PHASE_BEGIN(3) phase_scan_b((bf16_t*)(ws + slot(6)), (const float*)(ws + WS_DEC));
#if SCAN_DBG == 3
        asm volatile("s_waitcnt vmcnt(0)" ::: "memory"); __syncthreads(); grid.sync();

#endif
    PHASE_END(3)
    PHASE_BEGIN(4) phase_scan_c(lds, (const bf16_t*)(ws + slot(1)), (const float*)(ws + slot(4)), (const bf16_t*)(ws + slot(2)), (const bf16_t*)(ws + slot(3)), (const bf16_t*)(ws + slot(6)), a.in[2], (bf16_t*)(ws + slot(0)));
#if SCAN_DBG == 1
        asm volatile("s_waitcnt vmcnt(0)" ::: "memory"); __syncthreads(); grid.sync();
        phase_scan_naive((const bf16_t*)(ws + slot(1)), (const float*)(ws + slot(4)), (const bf16_t*)(ws + slot(2)), (float*)(ws + slot(6)));
        asm volatile("s_waitcnt vmcnt(0)" ::: "memory"); __syncthreads(); grid.sync();
        phase_onorm((const float*)(ws + slot(6)), (const bf16_t*)(ws + slot(3)), a.in[2], (bf16_t*)(ws + slot(0)));
#endif
#if SCAN_DBG == 3
        asm volatile("s_waitcnt vmcnt(0)" ::: "memory"); __syncthreads(); grid.sync();

#endif
#if SCAN_DBG == 4
#define DSYNC() asm volatile("s_waitcnt vmcnt(0)" ::: "memory"); __syncthreads(); grid.sync(); if (threadIdx.x < 64) { __builtin_amdgcn_fence(__ATOMIC_ACQUIRE, "agent"); asm volatile("s_waitcnt vmcnt(0)" ::: "memory"); } __syncthreads();
        DSYNC()
        phase_scan_naive((const bf16_t*)(ws + slot(1)), (const float*)(ws + slot(4)), (const bf16_t*)(ws + slot(2)), (float*)(ws + slot(6)));
        DSYNC()
        phase_onorm((const float*)(ws + slot(6)), (const bf16_t*)(ws + slot(3)), a.in[2], (bf16_t*)(ws + slot(8)));
        DSYNC()
        phase_scan_a(lds, (const float*)(ws + slot(4)), (const bf16_t*)(ws + slot(2)), (bf16_t*)(ws + slot(6)), (float*)(ws + WS_DEC));
        DSYNC()
        phase_scan_b((bf16_t*)(ws + slot(6)), (const float*)(ws + WS_DEC));
        DSYNC()
        phase_scan_c(lds, (const bf16_t*)(ws + slot(1)), (const float*)(ws + slot(4)), (const bf16_t*)(ws + slot(2)), (const bf16_t*)(ws + slot(3)), (const bf16_t*)(ws + slot(6)), a.in[2], (bf16_t*)a.out);
        DSYNC()
        dbg_compare4((LAS float*)lds, (const bf16_t*)(ws + slot(0)), (const bf16_t*)(ws + slot(8)), (const bf16_t*)a.out, (float*)(ws + WS_CTR + 4096));
#endif
#if SCAN_DBG == 2
        asm volatile("s_waitcnt vmcnt(0)" ::: "memory"); __syncthreads(); grid.sync();
        phase_scan_naive((const bf16_t*)(ws + slot(1)), (const float*)(ws + slot(4)), (const bf16_t*)(ws + slot(2)), (float*)(ws + slot(6)));
        asm volatile("s_waitcnt vmcnt(0)" ::: "memory"); __syncthreads(); grid.sync();
        phase_onorm((const float*)(ws + slot(6)), (const bf16_t*)(ws + slot(3)), a.in[2], (bf16_t*)(ws + slot(8)));
        asm volatile("s_waitcnt vmcnt(0)" ::: "memory"); __syncthreads(); grid.sync();
        dbg_compare((LAS float*)lds, (const bf16_t*)(ws + slot(0)), (const bf16_t*)(ws + slot(8)), (float*)(ws + WS_CTR + 4096));
#endif
    PHASE_END(4)
    PHASE_BEGIN(5) run_gemm_out<false>(a, lds); PHASE_END(5)
    PHASE_BEGIN(6) run_ln<false>(a); PHASE_END(6)
    PHASE_BEGIN(7) run_gemm_sc<false>(a, lds); PHASE_END(7)
    PHASE_BEGIN(8) run_topk<false>(a, lds); PHASE_END(8)
    PHASE_BEGIN(9) run_peer_u<false>(a); PHASE_END(9)
    PHASE_BEGIN(10) run_peer_v<false>(a, lds); PHASE_END(10)
    PHASE_BEGIN(11) run_peer_ln<false>(a); PHASE_END(11)
    PHASE_BEGIN(12) {
        pg8::Gemm g{(const bf16_t*)(ws + slot(2)), (const bf16_t*)(ws + WS_WKVQ), opaque(MTOK), opaque(3 * DM), opaque(DM)};
        pg8::StaticOrder S; S.init(g.M, g.N, (int)gridDim.x, (int)blockIdx.x);
        EpiKVQ E{(bf16_t*)(ws + slot(3)), (bf16_t*)(ws + slot(4)), (bf16_t*)(ws + slot(5))};
        pg8::gemm_phase<EpiKVQ, pg8::StaticOrder>(lds, g, S, E, nullptr);
    } PHASE_END(12)
    PHASE_BEGIN(13) phase_rot((LAS float*)lds, (bf16_t*)(ws + slot(3)), (bf16_t*)(ws + slot(5)), (const float*)(ws + WS_COS), (const float*)(ws + WS_SIN), (float*)(ws + WS_KMEAN), (float*)(ws + WS_KNMAX)); PHASE_END(13)
    PHASE_BEGIN(14) phase_sel(lds, (const bf16_t*)(ws + slot(5)), (const float*)(ws + WS_KMEAN), (unsigned short*)(ws + WS_SUB), (int*)(ws + WS_CNT), (int*)(ws + WS_CTR)); PHASE_END(14)
    PHASE_BEGIN(15) phase_att(lds, (const bf16_t*)(ws + slot(5)), (const bf16_t*)(ws + slot(3)), (const bf16_t*)(ws + slot(4)), (const float*)(ws + WS_KNMAX), (const unsigned short*)(ws + WS_SUB),
                              (const int*)(ws + WS_CNT), (int*)(ws + WS_CTR), (bf16_t*)(ws + slot(6)), (bf16_t*)(ws + slot(2)), (float*)(ws + WS_LS)); PHASE_END(15)
    PHASE_BEGIN(16) phase_comb((const bf16_t*)(ws + slot(6)), (const bf16_t*)(ws + slot(2)), (const float*)(ws + WS_LS), (bf16_t*)(ws + slot(3))); PHASE_END(16)
    PHASE_BEGIN(17) run_gemm_out<true>(a, lds); PHASE_END(17)
    PHASE_BEGIN(18) run_ln<true>(a); PHASE_END(18)
    PHASE_BEGIN(19) run_gemm_sc<true>(a, lds); PHASE_END(19)
    PHASE_BEGIN(20) run_topk<true>(a, lds); PHASE_END(20)
#if SCAN_DBG == 7
    PHASE_BEGIN(21) dbg_emit7((const float*)(ws + WS_CTR + 4096), a.out); PHASE_END(21)
#elif SCAN_DBG == 6
    PHASE_BEGIN(21) dbg_emit4((const float*)(ws + WS_CTR + 4096), a.out); PHASE_END(21)
#elif SCAN_DBG == 5
    PHASE_BEGIN(21) dbg_emit5((const unsigned*)(ws + WS_CTR + 8192), a.out); PHASE_END(21)
#elif SCAN_DBG == 4
    PHASE_BEGIN(21) dbg_emit4((const float*)(ws + WS_CTR + 4096), a.out); PHASE_END(21)
#elif SCAN_DBG == 3
    PHASE_BEGIN(21) dbg_emit3((const unsigned*)(ws + WS_CTR + 8192), a.out); PHASE_END(21)
#elif SCAN_DBG == 2
    PHASE_BEGIN(21) dbg_emit((const float*)(ws + WS_CTR + 4096), a.out); PHASE_END(21)
#else
    PHASE_BEGIN(21) run_peer_u<true>(a); PHASE_END(21)
    PHASE_BEGIN(22) run_peer_v<true>(a, lds); PHASE_END(22)
    PHASE_BEGIN(23) run_peer_ln<true>(a); PHASE_END(23)
#endif
}

extern "C" void kernel_launch(void* const* d_in, const int* in_sizes, int n_in, void* d_out, int out_size, void* d_ws, size_t ws_size, hipStream_t stream) {
    static int grid = 0;
    if (grid == 0) {
        if (n_in != 14 || out_size != MTOK * DM || ws_size < WS_END) { fprintf(stderr, "kernel_launch: unexpected shapes (n_in %d, out %d, ws %zu)\n", n_in, out_size, ws_size); grid = -1; return; }
        int dev = 0, cus = 0, per_cu = 0;
        if (hipGetDevice(&dev) != hipSuccess || hipDeviceGetAttribute(&cus, hipDeviceAttributeMultiprocessorCount, dev) != hipSuccess) { grid = -1; return; }
        if (hipFuncSetAttribute((const void*)mk_fwd, hipFuncAttributeMaxDynamicSharedMemorySize, LDS_BYTES) != hipSuccess) { fprintf(stderr, "kernel_launch: hipFuncSetAttribute failed\n"); grid = -1; return; }
        if (hipOccupancyMaxActiveBlocksPerMultiprocessor(&per_cu, (const void*)mk_fwd, 512, LDS_BYTES) != hipSuccess || per_cu < 1) { fprintf(stderr, "kernel_launch: occupancy query failed (%d)\n", per_cu); (void)hipGetLastError(); per_cu = 1; }
        grid = cus * (per_cu > 1 ? 1 : per_cu);
    }
    if (grid < 0) return;
    Args a{};
    for (int i = 0; i < 14; ++i) a.in[i] = (const float*)d_in[i];
    a.out = (float*)d_out; a.ws = (unsigned char*)d_ws;
#if ONE_LAUNCH
    a.ph_lo = 0; a.ph_hi = NPH;
    void* args[] = {&a};
    hipError_t e = hipLaunchCooperativeKernel((const void*)mk_fwd, dim3(grid), dim3(512), args, LDS_BYTES, stream);
    if (e != hipSuccess) fprintf(stderr, "cooperative launch failed: %s (grid %d)\n", hipGetErrorString(e), grid);
#else
    for (int ph = 0; ph < NPH; ++ph) {
        a.ph_lo = ph; a.ph_hi = ph + 1;
        hipLaunchKernelGGL(mk_fwd, dim3(grid), dim3(512), LDS_BYTES, stream, a);
    }
#endif
}
```

```cpp
#define ONE_LAUNCH 1
#include <hip/hip_runtime.h>
#include <hip/hip_cooperative_groups.h>
#include <cstdio>
namespace cg = cooperative_groups;

#ifndef ONE_LAUNCH
#define ONE_LAUNCH 0
#endif
#ifndef SCAN_DBG
#define SCAN_DBG 0
#endif
#ifndef SCAN_A_VALU
#define SCAN_A_VALU 0
#endif
#ifndef ENMASK
#define ENMASK 0xffffffffu
#endif
#define EN(k) ((ENMASK >> (k)) & 1u)

namespace pg8 {
#define PG8_LAS __attribute__((address_space(3)))
typedef unsigned short bf16_t;
typedef short bf16x8 __attribute__((ext_vector_type(8)));
typedef float f32x4 __attribute__((ext_vector_type(4)));
typedef unsigned u32x4 __attribute__((ext_vector_type(4)));
constexpr int BM = 256, BK = 64, HALF = 128, HTB = HALF * BK * 2  , STAGE_BYTES = 8 * HTB, NXCD = 8, WGM = 8;

__host__ __device__ __forceinline__ int lds_byte(int r, int c) { const int st = (r >> 4) * 2 + (c >> 5), rr = r & 15, cc = c & 31, ob = rr * 64 + cc * 2; return st * 1024 + (ob ^ (((ob >> 9) & 1) << 5)); }
__host__ __device__ __forceinline__ void stage_rc(int b, int& R, int& C) { const int st = b / 1024, sb = b % 1024, swz = sb ^ (((sb >> 9) & 1) << 5); R = (st >> 1) * 16 + swz / 64; C = (st & 1) * 32 + (swz % 64) / 2; }
__host__ __device__ __forceinline__ int perm32(int rho) { const int n = rho >> 4, i = rho & 15; return 8 * (i >> 2) + 4 * n + (i & 3); }

struct Unit { int pm, pn; };
struct Gemm { const bf16_t* A; const bf16_t* Bt; int M, N, K; };

struct StaticOrder {
    int nM, nN, nwg, G, c;
    __host__ __device__ void init(int M, int N, int G_, int c_) { nM = M / BM; nN = N / BM; nwg = nM * nN; G = G_; c = c_; }
    __host__ __device__ bool next(int i, Unit& u) const {
        const long L = (long)i * G + c; if (L >= nwg) return false;
        int wgid = (int)L; { const int q = nwg / NXCD, r = nwg % NXCD, xcd = wgid % NXCD, off = wgid / NXCD; wgid = (xcd < r ? xcd * (q + 1) : r * (q + 1) + (xcd - r) * q) + off; }
        const int nig = WGM * nN, gid = wgid / nig, fm = gid * WGM, gsz = (nM - fm) < WGM ? (nM - fm) : WGM;
        u.pm = fm + ((wgid % nig) % gsz); u.pn = (wgid % nig) / gsz; return true;
    }
    __device__ __forceinline__ void a_ready(const Unit&) const {}
    __device__ __forceinline__ void done(const Unit&) const {}
};
struct CountedOrder : StaticOrder {
    const unsigned* ready; unsigned need; unsigned* tmo;
    __device__ __forceinline__ void a_ready(const Unit& u) const {
        if (threadIdx.x < 64) {
            const unsigned long long t0 = __builtin_amdgcn_s_memrealtime(); unsigned polls = 0;
            while ((unsigned)__builtin_amdgcn_readfirstlane(__hip_atomic_load(ready + 64 * u.pm, __ATOMIC_RELAXED, __HIP_MEMORY_SCOPE_AGENT)) < need) {
                if ((++polls & 255u) == 0u && __builtin_amdgcn_readfirstlane(__hip_atomic_load(tmo, __ATOMIC_RELAXED, __HIP_MEMORY_SCOPE_AGENT)) != 0u) break;
                if (__builtin_amdgcn_s_memrealtime() - t0 > 2000000ull) {
                    if (threadIdx.x == 0) { unsigned expect = 0u; __hip_atomic_compare_exchange_strong(tmo + 1, &expect, 0x600u | (unsigned)(u.pm & 0xff), __ATOMIC_RELAXED, __ATOMIC_RELAXED, __HIP_MEMORY_SCOPE_AGENT); __hip_atomic_store(tmo, 1u, __ATOMIC_RELAXED, __HIP_MEMORY_SCOPE_AGENT); }
                    break; }
                __builtin_amdgcn_s_sleep(2); }
            __builtin_amdgcn_fence(__ATOMIC_ACQUIRE, "agent");
            asm volatile("s_waitcnt vmcnt(0)" ::: "memory");
        }
#if !defined(BROKEN_HOOK_NO_BARRIER)
        asm volatile("" ::: "memory"); __builtin_amdgcn_s_barrier(); asm volatile("" ::: "memory");
#endif
    }
};

__device__ __forceinline__ unsigned cvt_pk_bf16(float lo, float hi) { unsigned r; asm volatile("v_cvt_pk_bf16_f32 %0, %1, %2" : "=v"(r) : "v"(lo), "v"(hi)); return r; }
typedef float f32x2 __attribute__((ext_vector_type(2)));
__device__ __forceinline__ f32x2 gelu_pk(f32x2 v) {
    const f32x2 av = __builtin_elementwise_abs(v), d = av * 0.2316418882f + 1.0f;
    f32x2 t; t.x = __builtin_amdgcn_rcpf(d.x); t.y = __builtin_amdgcn_rcpf(d.y);
    f32x2 q = t * 0.5307027145f + (-0.7265760135f); q = q * t + 0.7107068705f; q = q * t + (-0.142248368f); q = q * t + 0.127414796f; q = q * t;
    const f32x2 s = (v * v) * (-0.72134752044f);
    f32x2 e; e.x = __builtin_amdgcn_exp2f(s.x); e.y = __builtin_amdgcn_exp2f(s.y);
    const f32x2 m = v * (q * e), r = v - m;
    f32x2 o; o.x = v.x < 0.f ? m.x : r.x; o.y = v.y < 0.f ? m.y : r.y; return o;
}

struct EpiF32 {
    static constexpr bool PERM = false, AFTER_DRAIN = false;
    float* C; int ldc; const float* bias;
    __device__ __forceinline__ void operator()(const f32x4 (&acc)[2][2][4][2], const Unit& u, int wr, int wc, int fr, int fq) const {
        const int row0 = u.pm * BM + wr * 64 + fr, col0 = u.pn * BM + wc * 32 + 4 * fq;
        f32x4 bv[2][2];
#pragma unroll
        for (int bj = 0; bj < 2; ++bj)
#pragma unroll
            for (int n = 0; n < 2; ++n) bv[bj][n] = bias ? *(const f32x4*)(bias + col0 + bj * HALF + n * 16) : (f32x4){0.f, 0.f, 0.f, 0.f};
#pragma unroll
        for (int ai = 0; ai < 2; ++ai)
#pragma unroll
            for (int m = 0; m < 4; ++m) { float* rowp = C + (size_t)(row0 + ai * HALF + m * 16) * ldc + col0;
#pragma unroll
                for (int bj = 0; bj < 2; ++bj)
#pragma unroll
                    for (int n = 0; n < 2; ++n) *(f32x4*)(rowp + bj * HALF + n * 16) = acc[ai][bj][m][n] + bv[bj][n]; }
    }
};
template <int ACT  > struct EpiBf16 {
    static constexpr bool PERM = true, AFTER_DRAIN = false;
    bf16_t* O; int ldc; const float* bias; int split_cols; size_t split_stride;
    __device__ __forceinline__ void operator()(const f32x4 (&acc)[2][2][4][2], const Unit& u, int wr, int wc, int fr, int fq) const {
        const int row0 = u.pm * BM + wr * 64 + fr; int colt = u.pn * BM; bf16_t* base = O;
        if (split_cols) { const int t = colt / split_cols; base += (size_t)t * split_stride; colt -= t * split_cols; }
        const int col0 = colt + wc * 32 + 8 * fq, bcol0 = u.pn * BM + wc * 32 + 8 * fq;
        f32x4 bv[2][2];
#pragma unroll
        for (int bj = 0; bj < 2; ++bj)
#pragma unroll
            for (int n = 0; n < 2; ++n) bv[bj][n] = bias ? *(const f32x4*)(bias + bcol0 + bj * HALF + 4 * n) : (f32x4){0.f, 0.f, 0.f, 0.f};
#pragma unroll
        for (int ai = 0; ai < 2; ++ai)
#pragma unroll
            for (int m = 0; m < 4; ++m) { bf16_t* rowp = base + (size_t)(row0 + ai * HALF + m * 16) * ldc + col0;
#pragma unroll
                for (int bj = 0; bj < 2; ++bj) { f32x4 v0 = acc[ai][bj][m][0] + bv[bj][0], v1 = acc[ai][bj][m][1] + bv[bj][1];
                    if (ACT == 1) { f32x2 a = gelu_pk((f32x2){v0[0], v0[1]}), b = gelu_pk((f32x2){v0[2], v0[3]}), c = gelu_pk((f32x2){v1[0], v1[1]}), d = gelu_pk((f32x2){v1[2], v1[3]});
                        v0 = (f32x4){a.x, a.y, b.x, b.y}; v1 = (f32x4){c.x, c.y, d.x, d.y}; }
                    if (ACT == 2) {
#pragma unroll
                        for (int j = 0; j < 4; ++j) { v0[j] = 0.5f * v0[j] * (1.0f + erff(v0[j] * 0.70710678f)); v1[j] = 0.5f * v1[j] * (1.0f + erff(v1[j] * 0.70710678f)); } }
                    u32x4 w; w.x = cvt_pk_bf16(v0[0], v0[1]); w.y = cvt_pk_bf16(v0[2], v0[3]); w.z = cvt_pk_bf16(v1[0], v1[1]); w.w = cvt_pk_bf16(v1[2], v1[3]);
                    *(u32x4*)(rowp + bj * HALF) = w; } }
    }
};

template <class Epi, class Sched, bool STAMP = false>
__device__ __forceinline__ void gemm_phase(PG8_LAS unsigned char* lds, const Gemm g, const Sched& S, const Epi& E, unsigned long long* stamps) {
    const int tid = threadIdx.x, wid = __builtin_amdgcn_readfirstlane(tid >> 6), lane = tid & 63, wr = wid >> 2, wc = wid & 3, fr = lane & 15, fq = lane >> 4;
    const int K = g.K, nt = K / BK;
    int ts_lo = 0, ts_hi = 0, nts = 0; const unsigned long long rt_entry = STAMP ? (unsigned long long)wall_clock64() : 0ull;
#define PG8_STAMP() do { if (STAMP && wid == 0 && nts < 64) { const unsigned long long _c = (unsigned long long)clock64(); \
        ts_lo = (lane == nts) ? (int)(unsigned)_c : ts_lo; ts_hi = (lane == nts) ? (int)(unsigned)(_c >> 32) : ts_hi; ++nts; } } while (0)
    PG8_STAMP();
    unsigned voffA[2], voffB[2];
#pragma unroll
    for (int i = 0; i < 2; ++i) { int R, C; stage_rc(tid * 16 + i * 8192, R, C); const int Rb = Epi::PERM ? ((R & ~31) + perm32(R & 31)) : R;
        voffA[i] = (unsigned)(R * K + C) * 2u; voffB[i] = (unsigned)(Rb * K + C) * 2u; }
    const size_t kstep = (size_t)(BK * 2);
    const size_t hstep = (size_t)HALF * K * 2;
    const size_t tstep = 2 * hstep;
    const unsigned ldsw = (unsigned)wid * 1024u;
    const int aoff = lds_byte(wr * 64 + fr, fq * 8), boff = lds_byte(wc * 32 + fr, fq * 8);
#define PG8_SA(b, h) (((b) * 2 + (h)) * HTB)
#define PG8_SB(b, h) ((4 + (b) * 2 + (h)) * HTB)
#define PG8_STAGE(bufoff, gbase, voff) do { _Pragma("unroll") for (int _i = 0; _i < 2; ++_i) \
        __builtin_amdgcn_global_load_lds((const unsigned*)((const char*)(gbase) + (voff)[_i]), (PG8_LAS unsigned*)(lds + (bufoff) + ldsw + _i * 8192), 16, 0, 0); } while (0)
#define PG8_LDA(dst, b, h) do { _Pragma("unroll") for (int m = 0; m < 4; ++m) _Pragma("unroll") for (int k = 0; k < 2; ++k) dst[m][k] = *(const PG8_LAS bf16x8*)(lds + PG8_SA(b, h) + aoff + m * 2048 + k * 1024); } while (0)
#define PG8_LDB(dst, b, h) do { _Pragma("unroll") for (int n = 0; n < 2; ++n) _Pragma("unroll") for (int k = 0; k < 2; ++k) dst[n][k] = *(const PG8_LAS bf16x8*)(lds + PG8_SB(b, h) + boff + n * 2048 + k * 1024); } while (0)
#define PG8_MMA(ai, bj, At, Bt) do { __builtin_amdgcn_s_setprio(1); _Pragma("unroll") for (int m = 0; m < 4; ++m) _Pragma("unroll") for (int n = 0; n < 2; ++n) _Pragma("unroll") for (int k = 0; k < 2; ++k) \
        acc[ai][bj][m][n] = __builtin_amdgcn_mfma_f32_16x16x32_bf16(Bt[n][k], At[m][k], acc[ai][bj][m][n], 0, 0, 0); __builtin_amdgcn_s_setprio(0); } while (0)
#define PG8_WAIT_V(n) asm volatile("s_waitcnt vmcnt(" #n ")" ::: "memory")
#define PG8_WAIT_L(n) asm volatile("s_waitcnt lgkmcnt(" #n ")" ::: "memory")
#define PG8_BAR __builtin_amdgcn_s_barrier()
#define PG8_SCHED __builtin_amdgcn_sched_barrier(0)
    Unit cur, nxt; int ui = 0;
    if (!S.next(0, cur)) return;
    f32x4 acc[2][2][4][2];
#pragma unroll
    for (int a = 0; a < 2; ++a)
#pragma unroll
        for (int b = 0; b < 2; ++b)
#pragma unroll
            for (int m = 0; m < 4; ++m)
#pragma unroll
                for (int n = 0; n < 2; ++n) acc[a][b][m][n] = (f32x4){0.f, 0.f, 0.f, 0.f};
    bf16x8 At[4][2], B0[2][2], B1[2][2];
    const char* cA = (const char*)g.A + (size_t)cur.pm * tstep; const char* cB = (const char*)g.Bt + (size_t)cur.pn * tstep;
    S.a_ready(cur);
    PG8_STAGE(PG8_SB(0, 0), cB, voffB); PG8_STAGE(PG8_SA(0, 0), cA, voffA); PG8_STAGE(PG8_SB(0, 1), cB + hstep, voffB); PG8_STAGE(PG8_SA(0, 1), cA + hstep, voffA);
    if (wr == 1) PG8_BAR;
    PG8_WAIT_V(4); PG8_BAR;
    PG8_STAGE(PG8_SB(1, 0), cB + kstep, voffB); PG8_STAGE(PG8_SA(1, 0), cA + kstep, voffA); PG8_STAGE(PG8_SB(1, 1), cB + hstep + kstep, voffB);
    PG8_WAIT_V(6); PG8_BAR;
    PG8_STAMP();
    for (;;) {
        const bool has_next = S.next(ui + 1, nxt);
        const char* nA = has_next ? (const char*)g.A + (size_t)nxt.pm * tstep : cA; const char* nB = has_next ? (const char*)g.Bt + (size_t)nxt.pn * tstep : cB;
        for (int t = 0; t < nt; t += 2) {
            const bool last = (t == nt - 2);
            const char* a1 = cA + (size_t)(t + 1) * kstep;
            const char* a2 = last ? nA : cA + (size_t)(t + 2) * kstep; const char* b2 = last ? nB : cB + (size_t)(t + 2) * kstep;
            const char* a3 = a2 + kstep; const char* b3 = b2 + kstep;
            if (last && has_next) S.a_ready(nxt);
            PG8_LDB(B0, 0, 0); PG8_SCHED; PG8_LDA(At, 0, 0); PG8_STAGE(PG8_SA(1, 1), a1 + hstep, voffA);
            PG8_WAIT_L(8); PG8_BAR; PG8_WAIT_L(0); PG8_MMA(0, 0, At, B0); PG8_BAR; PG8_SCHED;
            PG8_LDB(B1, 0, 1); PG8_STAGE(PG8_SB(0, 0), b2, voffB);
            PG8_BAR; PG8_WAIT_L(0); PG8_MMA(0, 1, At, B1); PG8_BAR;
            PG8_LDA(At, 0, 1); PG8_STAGE(PG8_SA(0, 0), a2, voffA);
            PG8_BAR; PG8_WAIT_L(0); PG8_MMA(1, 0, At, B0); PG8_BAR; PG8_SCHED;
            PG8_STAGE(PG8_SB(0, 1), b2 + hstep, voffB);
            PG8_WAIT_V(6); PG8_BAR; PG8_MMA(1, 1, At, B1); PG8_BAR;
            PG8_LDB(B0, 1, 0); PG8_SCHED; PG8_LDA(At, 1, 0); PG8_STAGE(PG8_SA(0, 1), a2 + hstep, voffA);
            PG8_WAIT_L(8); PG8_BAR; PG8_WAIT_L(0); PG8_MMA(0, 0, At, B0); PG8_BAR; PG8_SCHED;
            PG8_LDB(B1, 1, 1); PG8_STAGE(PG8_SB(1, 0), b3, voffB);
            PG8_BAR; PG8_WAIT_L(0); PG8_MMA(0, 1, At, B1); PG8_BAR;
            PG8_LDA(At, 1, 1); PG8_STAGE(PG8_SA(1, 0), a3, voffA);
            PG8_BAR; PG8_WAIT_L(0); PG8_MMA(1, 0, At, B0); PG8_BAR; PG8_SCHED;
            PG8_STAGE(PG8_SB(1, 1), b3 + hstep, voffB);
            PG8_WAIT_V(6); PG8_BAR; PG8_MMA(1, 1, At, B1); PG8_BAR;
        }
        PG8_STAMP();
        if constexpr (!Epi::AFTER_DRAIN) { E(acc, cur, wr, wc, fr, fq); S.done(cur); }
        PG8_STAMP();
        if (!has_next) break;
#pragma unroll
        for (int a = 0; a < 2; ++a)
#pragma unroll
            for (int b = 0; b < 2; ++b)
#pragma unroll
                for (int m = 0; m < 4; ++m)
#pragma unroll
                    for (int n = 0; n < 2; ++n) acc[a][b][m][n] = (f32x4){0.f, 0.f, 0.f, 0.f};
        cur = nxt; cA = nA; cB = nB; ++ui;
    }
    PG8_WAIT_V(0);
    if (wr == 0) PG8_BAR;
    PG8_BAR;
    if constexpr (Epi::AFTER_DRAIN) { E.fused(acc, cur, wr, wc, fr, fq, lds, wid, lane); S.done(cur); }
    PG8_STAMP();
    if (STAMP && wid == 0) { stamps[lane] = lane < nts ? (((unsigned long long)(unsigned)ts_hi << 32) | (unsigned)ts_lo) : 0ull;
        if (lane == 62) stamps[62] = rt_entry; if (lane == 63) stamps[63] = (unsigned long long)wall_clock64(); }
#undef PG8_STAMP
#undef PG8_SA
#undef PG8_SB
#undef PG8_STAGE
#undef PG8_LDA
#undef PG8_LDB
#undef PG8_MMA
#undef PG8_WAIT_V
#undef PG8_WAIT_L
#undef PG8_BAR
#undef PG8_SCHED
}
}


#define LAS __attribute__((address_space(3)))
typedef unsigned short bf16_t;
typedef float f32x4 __attribute__((ext_vector_type(4)));
typedef unsigned u32x4 __attribute__((ext_vector_type(4)));
typedef unsigned u32x2 __attribute__((ext_vector_type(2)));
typedef short bf16x8 __attribute__((ext_vector_type(8)));
typedef short s16x4 __attribute__((ext_vector_type(4)));
typedef float f32x16 __attribute__((ext_vector_type(16)));

constexpr int MTOK = 16384, DM = 2048, SEQ = 8192, NHEAD = 16;
constexpr float ALPHA = 1.41421356237309515f;
constexpr size_t MiB = (size_t)1 << 20;
constexpr size_t WS_WIN = 0, WS_WOUT = 32 * MiB, WS_WKVQ = 40 * MiB, WS_WO = 64 * MiB, WS_WC = 72 * MiB, WS_UB = 88 * MiB, WS_VB = 152 * MiB, WS_USC = 216 * MiB, WS_VSC = 217 * MiB, WS_H = 224 * MiB, WS_XQ = 232 * MiB, WS_XS = 264 * MiB, WS_W = 272 * MiB, WS_CS = 280 * MiB, WS_SLOT = 344 * MiB;
constexpr size_t WS_EID = 920 * MiB, WS_GATE = 928 * MiB, WS_COS = 936 * MiB, WS_SIN = 938 * MiB, WS_KMEAN = 940 * MiB, WS_LB = 941 * MiB, WS_LS = 942 * MiB, WS_SUB = 946 * MiB, WS_CNT = 962 * MiB, WS_CTR = 963 * MiB, WS_DEC = 964 * MiB, WS_END = 966 * MiB;
constexpr size_t WS_KNMAX = WS_KMEAN + 768 * 1024;
__host__ __device__ constexpr size_t slot(int i) { return WS_SLOT + (size_t)i * 64 * MiB; }
constexpr int LDS_BYTES = 144 * 1024;
constexpr int NPH = 26;

struct Args { const float* in[14]; float* out; unsigned char* ws; int ph_lo, ph_hi; };

__device__ __forceinline__ float bflo(unsigned w) { return __uint_as_float(w << 16); }
__device__ __forceinline__ float bfhi(unsigned w) { return __uint_as_float(w & 0xffff0000u); }
__device__ __forceinline__ float bf2f(bf16_t b) { return __uint_as_float(((unsigned)b) << 16); }
typedef __bf16 bf16x2_t __attribute__((ext_vector_type(2)));
typedef float f32x2_t __attribute__((ext_vector_type(2)));
__device__ __forceinline__ unsigned pk_bf16(float lo, float hi) { const f32x2_t f = {lo, hi}; return __builtin_bit_cast(unsigned, __builtin_convertvector(f, bf16x2_t)); }
__device__ __forceinline__ float wave_sum(float v) {
#pragma unroll
    for (int o = 32; o >= 1; o >>= 1) v += __shfl_xor(v, o);
    return v;
}
__device__ __forceinline__ float wave_max(float v) {
#pragma unroll
    for (int o = 32; o >= 1; o >>= 1) v = fmaxf(v, __shfl_xor(v, o));
    return v;
}
__device__ __forceinline__ float sigmoidf_(float z) { return 1.0f / (1.0f + __expf(-z)); }


__device__ __forceinline__ void store_wt16(void* p, u32x4 v) {
    __hip_atomic_store((unsigned long long*)p, ((unsigned long long)v.y << 32) | v.x, __ATOMIC_RELAXED, __HIP_MEMORY_SCOPE_AGENT);
    __hip_atomic_store((unsigned long long*)p + 1, ((unsigned long long)v.w << 32) | v.z, __ATOMIC_RELAXED, __HIP_MEMORY_SCOPE_AGENT);
}
__device__ __forceinline__ void store_wt8(void* p, u32x2 v) {
    __hip_atomic_store((unsigned long long*)p, ((unsigned long long)v.y << 32) | v.x, __ATOMIC_RELAXED, __HIP_MEMORY_SCOPE_AGENT);
}
struct EpiIn {
    static constexpr bool PERM = true, AFTER_DRAIN = false;
    bf16_t* Q1; float* LF; bf16_t* I1; bf16_t* G1; const float* LB;
    __device__ __forceinline__ void operator()(const pg8::f32x4 (&acc)[2][2][4][2], const pg8::Unit& u, int wr, int wc, int fr, int fq) const {
        const int type = u.pn >> 3;
        const int row0 = u.pm * 256 + wr * 64 + fr, col0 = (u.pn & 7) * 256 + wc * 32 + 8 * fq;
        if (type == 1) {
#pragma unroll
            for (int bj = 0; bj < 2; ++bj) {
                const int c = col0 + bj * 128;
                const f32x4 lb0 = *(const f32x4*)(LB + c), lb1 = *(const f32x4*)(LB + c + 4);
#pragma unroll
                for (int ai = 0; ai < 2; ++ai)
#pragma unroll
                    for (int m = 0; m < 4; ++m) {
                        float* p = LF + (size_t)(row0 + ai * 128 + m * 16) * DM + c;
                        f32x4 o0, o1;
#pragma unroll
                        for (int j = 0; j < 4; ++j) {
                            o0[j] = __logf(lb0[j] + (1.0f - lb0[j]) * sigmoidf_(acc[ai][bj][m][0][j]));
                            o1[j] = __logf(lb1[j] + (1.0f - lb1[j]) * sigmoidf_(acc[ai][bj][m][1][j]));
                        }
                        *(f32x4*)p = o0; *(f32x4*)(p + 4) = o1;
                    }
            }
        } else {
            bf16_t* dst = Q1 + (size_t)(type - (type > 0 ? 1 : 0)) * ((size_t)32 << 20);
            const bool act = (type != 2);
#pragma unroll
            for (int ai = 0; ai < 2; ++ai)
#pragma unroll
                for (int m = 0; m < 4; ++m)
#pragma unroll
                    for (int bj = 0; bj < 2; ++bj) {
                        f32x4 v0 = acc[ai][bj][m][0], v1 = acc[ai][bj][m][1];
                        if (act) {
#pragma unroll
                            for (int j = 0; j < 4; ++j) { v0[j] = v0[j] * sigmoidf_(v0[j]); v1[j] = v1[j] * sigmoidf_(v1[j]); }
                        }
                        u32x4 w; w.x = pk_bf16(v0[0], v0[1]); w.y = pk_bf16(v0[2], v0[3]); w.z = pk_bf16(v1[0], v1[1]); w.w = pk_bf16(v1[2], v1[3]);
                        *(u32x4*)(dst + (size_t)(row0 + ai * 128 + m * 16) * DM + col0 + bj * 128) = w;
                    }
        }
    }
};
struct EpiRes {
    static constexpr bool PERM = false, AFTER_DRAIN = false;
    const float* res; float* Y;
    __device__ __forceinline__ void operator()(const pg8::f32x4 (&acc)[2][2][4][2], const pg8::Unit& u, int wr, int wc, int fr, int fq) const {
        const int row0 = u.pm * 256 + wr * 64 + fr, col0 = u.pn * 256 + wc * 32 + 4 * fq;
#pragma unroll
        for (int ai = 0; ai < 2; ++ai)
#pragma unroll
            for (int m = 0; m < 4; ++m) {
                const size_t off = (size_t)(row0 + ai * 128 + m * 16) * DM + col0;
#pragma unroll
                for (int bj = 0; bj < 2; ++bj)
#pragma unroll
                    for (int n = 0; n < 2; ++n) {
                        const f32x4 r = *(const f32x4*)(res + off + bj * 128 + n * 16);
                        *(f32x4*)(Y + off + bj * 128 + n * 16) = r * ALPHA + acc[ai][bj][m][n];
                    }
            }
    }
};
struct EpiF32 {
    static constexpr bool PERM = false, AFTER_DRAIN = false;
    float* C; int ldc;
    __device__ __forceinline__ void operator()(const pg8::f32x4 (&acc)[2][2][4][2], const pg8::Unit& u, int wr, int wc, int fr, int fq) const {
        const int row0 = u.pm * 256 + wr * 64 + fr, col0 = u.pn * 256 + wc * 32 + 4 * fq;
#pragma unroll
        for (int ai = 0; ai < 2; ++ai)
#pragma unroll
            for (int m = 0; m < 4; ++m) {
                float* p = C + (size_t)(row0 + ai * 128 + m * 16) * ldc + col0;
#pragma unroll
                for (int bj = 0; bj < 2; ++bj)
#pragma unroll
                    for (int n = 0; n < 2; ++n) *(f32x4*)(p + bj * 128 + n * 16) = acc[ai][bj][m][n];
            }
    }
};
struct EpiKVQ {
    static constexpr bool PERM = true, AFTER_DRAIN = false;
    bf16_t* K; bf16_t* V; bf16_t* Q;
    __device__ __forceinline__ void operator()(const pg8::f32x4 (&acc)[2][2][4][2], const pg8::Unit& u, int wr, int wc, int fr, int fq) const {
        const int t = u.pn >> 3;
        bf16_t* dst = K + (size_t)t * ((size_t)32 << 20);
        const int row0 = u.pm * 256 + wr * 64 + fr, col0 = (u.pn & 7) * 256 + wc * 32 + 8 * fq;
#pragma unroll
        for (int ai = 0; ai < 2; ++ai)
#pragma unroll
            for (int m = 0; m < 4; ++m)
#pragma unroll
                for (int bj = 0; bj < 2; ++bj) {
                    const f32x4 v0 = acc[ai][bj][m][0], v1 = acc[ai][bj][m][1];
                    u32x4 w; w.x = pk_bf16(v0[0], v0[1]); w.y = pk_bf16(v0[2], v0[3]); w.z = pk_bf16(v1[0], v1[1]); w.w = pk_bf16(v1[2], v1[3]);
                    *(u32x4*)(dst + (size_t)(row0 + ai * 128 + m * 16) * DM + col0 + bj * 128) = w;
                }
    }
};

__device__ __forceinline__ void transpose_tiles(LAS float* tile, const float* src, int ldn, int K, int N, bf16_t* dst) {
    const int tid = threadIdx.x;
    const int tn = N / 64, ntiles = tn * (K / 64);
    for (int tI = blockIdx.x; tI < ntiles; tI += gridDim.x) {
        const int k0 = (tI / tn) * 64, n0 = (tI % tn) * 64;
#pragma unroll
        for (int r = 0; r < 2; ++r) {
            const int kk = (tid >> 4) + 32 * r, nn = (tid & 15) * 4;
            const f32x4 v = *(const f32x4*)(src + (size_t)(k0 + kk) * ldn + n0 + nn);
            tile[kk * 65 + nn + 0] = v[0]; tile[kk * 65 + nn + 1] = v[1]; tile[kk * 65 + nn + 2] = v[2]; tile[kk * 65 + nn + 3] = v[3];
        }
        __syncthreads();
        {
            const int nn = tid >> 3, kk8 = (tid & 7) * 8;
            float f[8];
#pragma unroll
            for (int j = 0; j < 8; ++j) f[j] = tile[(kk8 + j) * 65 + nn];
            u32x4 w; w.x = pk_bf16(f[0], f[1]); w.y = pk_bf16(f[2], f[3]); w.z = pk_bf16(f[4], f[5]); w.w = pk_bf16(f[6], f[7]);
            *(u32x4*)(dst + (size_t)(n0 + nn) * K + k0 + kk8) = w;
        }
        __syncthreads();
    }
}
__device__ __forceinline__ void convert_bf16(const float* src, bf16_t* dst, size_t n) {
    const size_t stride = (size_t)gridDim.x * 512 * 8;
    for (size_t i = ((size_t)blockIdx.x * 512 + threadIdx.x) * 8; i < n; i += stride) {
        const f32x4 a = *(const f32x4*)(src + i), b = *(const f32x4*)(src + i + 4);
        u32x4 w; w.x = pk_bf16(a[0], a[1]); w.y = pk_bf16(a[2], a[3]); w.z = pk_bf16(b[0], b[1]); w.w = pk_bf16(b[2], b[3]);
        *(u32x4*)(dst + i) = w;
    }
}
__device__ __forceinline__ void fold_peer_keys(LAS float* lds, const float* w_query, const float* sub_keys, bf16_t* WcT) {
    const int tid = threadIdx.x;
    LAS float* Ss = lds;
    LAS float* Ws = lds + 128 * 132;
    for (int item = blockIdx.x; item < 1024; item += gridDim.x) {
        const int l = item >> 9, rem = item & 511, hh = rem >> 5, kb = rem & 31, h = hh >> 1, half = hh & 1;
        const float* sk = sub_keys + (size_t)(((l * 2 + half) * 8 + h) * 128) * 128;
        const float* wq = w_query + (size_t)l * DM * DM + (size_t)(kb * 64) * DM + h * 256 + half * 128;
#pragma unroll
        for (int r = 0; r < 8; ++r) { const int idx = tid + 512 * r, key = idx >> 5, d4 = (idx & 31) * 4; *(LAS f32x4*)(Ss + key * 132 + d4) = *(const f32x4*)(sk + key * 128 + d4); }
#pragma unroll
        for (int r = 0; r < 4; ++r) { const int idx = tid + 512 * r, kin = idx >> 5, d4 = (idx & 31) * 4; *(LAS f32x4*)(Ws + kin * 128 + d4) = *(const f32x4*)(wq + (size_t)kin * DM + d4); }
        __syncthreads();
        const int key = tid & 127, kq = tid >> 7;
        float acc[16];
#pragma unroll
        for (int j = 0; j < 16; ++j) acc[j] = 0.f;
        for (int d4 = 0; d4 < 32; ++d4) {
            const f32x4 s4 = *(const LAS f32x4*)(Ss + key * 132 + d4 * 4);
#pragma unroll
            for (int j = 0; j < 16; ++j) { const f32x4 w4 = *(const LAS f32x4*)(Ws + (kq * 16 + j) * 128 + d4 * 4); acc[j] += s4[0] * w4[0] + s4[1] * w4[1] + s4[2] * w4[2] + s4[3] * w4[3]; }
        }
        bf16_t* o = WcT + (size_t)l * DM * DM + (size_t)(h * 256 + half * 128 + key) * DM + kb * 64 + kq * 16;
        u32x4 w0, w1;
        w0.x = pk_bf16(acc[0], acc[1]); w0.y = pk_bf16(acc[2], acc[3]); w0.z = pk_bf16(acc[4], acc[5]); w0.w = pk_bf16(acc[6], acc[7]);
        w1.x = pk_bf16(acc[8], acc[9]); w1.y = pk_bf16(acc[10], acc[11]); w1.z = pk_bf16(acc[12], acc[13]); w1.w = pk_bf16(acc[14], acc[15]);
        *(u32x4*)o = w0; *(u32x4*)(o + 8) = w1;
        __syncthreads();
    }
}

__device__ __forceinline__ void quant_rows(const float* src, unsigned char* dst, float* scl, int nrows) {
    const int lane = threadIdx.x & 63, gw = blockIdx.x * 8 + (threadIdx.x >> 6), nw = gridDim.x * 8;
    for (int row = gw; row < nrows; row += nw) {
        const float* p = src + (size_t)row * DM;
        f32x4 v[8];
#pragma unroll
        for (int i = 0; i < 2; ++i)
#pragma unroll
            for (int q = 0; q < 4; ++q) v[i * 4 + q] = *(const f32x4*)(p + 1024 * i + 16 * lane + 4 * q);
        float am = 0.f;
#pragma unroll
        for (int i = 0; i < 8; ++i) am = fmaxf(am, fmaxf(fmaxf(fabsf(v[i][0]), fabsf(v[i][1])), fmaxf(fabsf(v[i][2]), fabsf(v[i][3]))));
        am = fmaxf(wave_max(am), 1e-30f);
        const float inv = 127.0f / am;
        if (lane == 0) scl[row] = am * (1.0f / 127.0f);
#pragma unroll
        for (int i = 0; i < 2; ++i) {
            u32x4 w;
#pragma unroll
            for (int q = 0; q < 4; ++q) {
                const f32x4 t = v[i * 4 + q];
                const unsigned b0 = (unsigned)(int)(rintf(t[0] * inv) + 128.0f), b1 = (unsigned)(int)(rintf(t[1] * inv) + 128.0f), b2 = (unsigned)(int)(rintf(t[2] * inv) + 128.0f), b3 = (unsigned)(int)(rintf(t[3] * inv) + 128.0f);
                w[q] = b0 | (b1 << 8) | (b2 << 16) | (b3 << 24);
            }
            *(u32x4*)(dst + (size_t)row * DM + 1024 * i + 16 * lane) = w;
        }
    }
}
__device__ __forceinline__ void phase_prep(const Args& a, LAS unsigned char* lds) {
    unsigned char* ws = a.ws;
    LAS float* tile = (LAS float*)lds;
    transpose_tiles(tile, a.in[1], 4 * DM, DM, 4 * DM, (bf16_t*)(ws + WS_WIN));
    transpose_tiles(tile, a.in[3], DM, DM, DM, (bf16_t*)(ws + WS_WOUT));
    transpose_tiles(tile, a.in[5], 2 * DM, DM, 2 * DM, (bf16_t*)(ws + WS_WKVQ));
    transpose_tiles(tile, a.in[6], DM, DM, DM, (bf16_t*)(ws + WS_WKVQ) + (size_t)2 * DM * DM);
    transpose_tiles(tile, a.in[7], DM, DM, DM, (bf16_t*)(ws + WS_WO));
    fold_peer_keys((LAS float*)lds, a.in[8], a.in[9], (bf16_t*)(ws + WS_WC));
    convert_bf16(a.in[0], (bf16_t*)(ws + slot(0)), (size_t)MTOK * DM);
    quant_rows(a.in[10], ws + WS_UB, (float*)(ws + WS_USC), 2 * 16384);
    quant_rows(a.in[11], ws + WS_VB, (float*)(ws + WS_VSC), 2 * 16384);
    const int gtid = blockIdx.x * 512 + threadIdx.x, gthreads = gridDim.x * 512;
    float* COS = (float*)(ws + WS_COS); float* SIN = (float*)(ws + WS_SIN); float* LB = (float*)(ws + WS_LB);
    for (int i = gtid; i < SEQ * 64; i += gthreads) {
        const int pos = i >> 6, j = i & 63;
        double inv = 1.0; const double r = 0.86596432336006535;
        for (int q = 0; q < j; ++q) inv *= r;
        const float ang = (float)pos * (float)inv;
        const double x = (double)ang;
        const double n = __builtin_rint(x * 0.15915494309189535);
        const float rf = (float)__builtin_fma(-n, 6.283185307179586, x);
        COS[i] = cosf(rf); SIN[i] = sinf(rf);
    }
    for (int c = gtid; c < DM; c += gthreads) { const float l0 = a.in[4][c], l1 = a.in[4][DM + c]; LB[c] = 1.0f / (1.0f + expf(l1 - l0)); }
}

__device__ __forceinline__ void phase_scan_naive(const bf16_t* Q1, const float* LF, const bf16_t* I1, float* O) {
    const int lane = threadIdx.x & 63, gw = blockIdx.x * 8 + (threadIdx.x >> 6), nw = gridDim.x * 8;
    for (int item = gw; item < 2 * NHEAD * 128; item += nw) {
        const int bh = item >> 7, v = item & 127, b = bh >> 4, h = bh & 15;
        const size_t base = (size_t)b * SEQ * DM + h * 128;
        float S0 = 0.f, S1 = 0.f;
#pragma unroll 4
        for (int t = 0; t < SEQ; ++t) {
            const size_t ro = base + (size_t)t * DM;
            const float f0 = __expf(LF[ro + lane]), f1 = __expf(LF[ro + 64 + lane]);
            const float q0 = bf2f(Q1[ro + lane]), q1 = bf2f(Q1[ro + 64 + lane]);
            const float iv = bf2f(I1[ro + v]);
            S0 = f0 * S0 + (1.0f - f0) * iv; S1 = f1 * S1 + (1.0f - f1) * iv;
            const float p = wave_sum(q0 * S0 + q1 * S1);
            if (lane == 0) O[ro + v] = p;
        }
    }
}
__device__ __forceinline__ void phase_onorm(const float* O, const bf16_t* G1, const float* gnorm, bf16_t* OG) {
    const int lane = threadIdx.x & 63, gw = blockIdx.x * 8 + (threadIdx.x >> 6), nw = gridDim.x * 8;
    const float gn0 = gnorm[2 * lane], gn1 = gnorm[2 * lane + 1];
    for (int item = gw; item < MTOK * NHEAD; item += nw) {
        const size_t off = (size_t)item * 128 + 2 * lane;
        const float o0 = O[off], o1 = O[off + 1];
        const float ss = wave_sum(o0 * o0 + o1 * o1);
        const float r = rsqrtf(ss * (1.0f / 128.0f) + 1e-6f);
        const unsigned g = *(const unsigned*)(G1 + off);
        *(unsigned*)(OG + off) = pk_bf16(o0 * r * gn0 * bflo(g), o1 * r * gn1 * bfhi(g));
    }
}

__device__ __forceinline__ void ln_row_store(float (&v)[32], const float* g, const float* bta, float* outf, bf16_t* outb, int lane, signed char* outq = nullptr, float* outs = nullptr) {
    float s = 0.f;
#pragma unroll
    for (int i = 0; i < 32; ++i) s += v[i];
    const float mu = wave_sum(s) * (1.0f / DM);
    float q = 0.f;
#pragma unroll
    for (int i = 0; i < 32; ++i) { v[i] -= mu; q += v[i] * v[i]; }
    const float rstd = rsqrtf(wave_sum(q) * (1.0f / DM) + 1e-5f);
    float am = 0.f;
#pragma unroll
    for (int i = 0; i < 4; ++i) {
        const int c = 512 * i + 8 * lane;
        const f32x4 g0 = *(const f32x4*)(g + c), g1 = *(const f32x4*)(g + c + 4), b0 = *(const f32x4*)(bta + c), b1 = *(const f32x4*)(bta + c + 4);
        f32x4 o0, o1;
#pragma unroll
        for (int j = 0; j < 4; ++j) { o0[j] = v[i * 8 + j] * rstd * g0[j] + b0[j]; o1[j] = v[i * 8 + 4 + j] * rstd * g1[j] + b1[j]; v[i * 8 + j] = o0[j]; v[i * 8 + 4 + j] = o1[j]; am = fmaxf(am, fmaxf(fabsf(o0[j]), fabsf(o1[j]))); }
        *(f32x4*)(outf + c) = o0; *(f32x4*)(outf + c + 4) = o1;
        if (outb) { u32x4 w; w.x = pk_bf16(o0[0], o0[1]); w.y = pk_bf16(o0[2], o0[3]); w.z = pk_bf16(o1[0], o1[1]); w.w = pk_bf16(o1[2], o1[3]); *(u32x4*)(outb + c) = w; }
    }
    if (outq) {
        am = fmaxf(wave_max(am), 1e-30f);
        const float inv = 127.0f / am;
        if (lane == 0) *outs = am * (1.0f / 127.0f);
#pragma unroll
        for (int i = 0; i < 4; ++i) {
            u32x2 w;
            w.x = ((unsigned)(int)rintf(v[i * 8 + 0] * inv) & 0xffu) | (((unsigned)(int)rintf(v[i * 8 + 1] * inv) & 0xffu) << 8) | (((unsigned)(int)rintf(v[i * 8 + 2] * inv) & 0xffu) << 16) | (((unsigned)(int)rintf(v[i * 8 + 3] * inv) & 0xffu) << 24);
            w.y = ((unsigned)(int)rintf(v[i * 8 + 4] * inv) & 0xffu) | (((unsigned)(int)rintf(v[i * 8 + 5] * inv) & 0xffu) << 8) | (((unsigned)(int)rintf(v[i * 8 + 6] * inv) & 0xffu) << 16) | (((unsigned)(int)rintf(v[i * 8 + 7] * inv) & 0xffu) << 24);
            *(u32x2*)(outq + 512 * i + 8 * lane) = w;
        }
    }
}
__device__ __forceinline__ void ln_row_store16(float (&v)[32], const float* g, const float* bta, float* outf, bf16_t* outb, int lane) {
    float s = 0.f;
#pragma unroll
    for (int i = 0; i < 32; ++i) s += v[i];
    const float mu = wave_sum(s) * (1.0f / DM);
    float q = 0.f;
#pragma unroll
    for (int i = 0; i < 32; ++i) { v[i] -= mu; q += v[i] * v[i]; }
    const float rstd = rsqrtf(wave_sum(q) * (1.0f / DM) + 1e-5f);
#pragma unroll
    for (int i = 0; i < 2; ++i) {
        const int c = 1024 * i + 16 * lane;
        f32x4 o[4];
#pragma unroll
        for (int qd = 0; qd < 4; ++qd) {
            const f32x4 gg = *(const f32x4*)(g + c + 4 * qd), bb = *(const f32x4*)(bta + c + 4 * qd);
#pragma unroll
            for (int j = 0; j < 4; ++j) o[qd][j] = v[16 * i + 4 * qd + j] * rstd * gg[j] + bb[j];
            *(f32x4*)(outf + c + 4 * qd) = o[qd];
        }
        if (outb) {
            u32x4 w0, w1;
            w0.x = pk_bf16(o[0][0], o[0][1]); w0.y = pk_bf16(o[0][2], o[0][3]); w0.z = pk_bf16(o[1][0], o[1][1]); w0.w = pk_bf16(o[1][2], o[1][3]);
            w1.x = pk_bf16(o[2][0], o[2][1]); w1.y = pk_bf16(o[2][2], o[2][3]); w1.z = pk_bf16(o[3][0], o[3][1]); w1.w = pk_bf16(o[3][2], o[3][3]);
            *(u32x4*)(outb + c) = w0; *(u32x4*)(outb + c + 8) = w1;
        }
    }
}
__device__ __forceinline__ void phase_ln(const float* Y, const float* g, const float* bta, float* outf, bf16_t* outb, signed char* outq = nullptr, float* outs = nullptr) {
    const int lane = threadIdx.x & 63, gw = blockIdx.x * 8 + (threadIdx.x >> 6), nw = gridDim.x * 8;
    for (int row = gw; row < MTOK; row += nw) {
        float v[32];
        const float* p = Y + (size_t)row * DM;
#pragma unroll
        for (int i = 0; i < 4; ++i) {
            const f32x4 a = *(const f32x4*)(p + 512 * i + 8 * lane), b = *(const f32x4*)(p + 512 * i + 8 * lane + 4);
#pragma unroll
            for (int j = 0; j < 4; ++j) { v[i * 8 + j] = a[j]; v[i * 8 + 4 + j] = b[j]; }
        }
        ln_row_store(v, g, bta, outf + (size_t)row * DM, outb ? outb + (size_t)row * DM : nullptr, lane, outq ? outq + (size_t)row * DM : nullptr, outs ? outs + row : nullptr);
    }
}

__device__ __forceinline__ void wave_argmax(float& v, int& idx) {
#pragma unroll
    for (int o = 32; o >= 1; o >>= 1) {
        const float ov = __shfl_xor(v, o); const int oi = __shfl_xor(idx, o);
        if (ov > v || (ov == v && oi < idx)) { v = ov; idx = oi; }
    }
}
__device__ __forceinline__ unsigned fkey(float x) { const unsigned u = __float_as_uint(x); return u ^ (unsigned)(((int)u >> 31) | 0x80000000); }
__device__ __forceinline__ float funkey(unsigned k) { const unsigned u = (k & 0x80000000u) ? (k ^ 0x80000000u) : ~k; return __uint_as_float(u); }
__device__ __forceinline__ void sort16_insert(unsigned (&r)[16], unsigned v) {
#pragma unroll
    for (int i = 0; i < 16; ++i) { const unsigned m = r[i] > v ? r[i] : v; v = r[i] > v ? v : r[i]; r[i] = m; }
}
__device__ __forceinline__ void phase_topk(LAS unsigned char* lds, const float* SCT, int* EID, float* GATE) {
    LAS unsigned char* ib = lds + threadIdx.x * 32;
    for (int item = blockIdx.x * 512 + threadIdx.x; item < MTOK * 8; item += gridDim.x * 512) {
        const int h = item >> 14, tok = item & (MTOK - 1);
        const float* p = SCT + (size_t)(h * 256) * MTOK + tok;
        unsigned r1[16], r2[16];
#pragma unroll
        for (int i = 0; i < 16; ++i) { r1[i] = 0u; r2[i] = 0u; }
#pragma unroll 8
        for (int e = 0; e < 128; ++e) {
            const float x1 = p[(size_t)e * MTOK], x2 = p[(size_t)(128 + e) * MTOK];
            sort16_insert(r1, (fkey(x1) & ~0x7Fu) | (unsigned)e);
            sort16_insert(r2, (fkey(x2) & ~0x7Fu) | (unsigned)e);
        }
        float v1[16], v2[16];
#pragma unroll
        for (int i = 0; i < 16; ++i) { v1[i] = funkey(r1[i] & ~0x7Fu); v2[i] = funkey(r2[i] & ~0x7Fu); ib[i] = (unsigned char)(r1[i] & 0x7Fu); ib[16 + i] = (unsigned char)(r2[i] & 0x7Fu); }
        unsigned r3[16];
#pragma unroll
        for (int i = 0; i < 16; ++i) r3[i] = 0u;
#pragma unroll
        for (int a = 0; a < 16; ++a)
#pragma unroll
            for (int bq = 0; bq < 16; ++bq)
                if ((a + 1) * (bq + 1) <= 16) sort16_insert(r3, (fkey(v1[a] + v2[bq]) & ~0xFFu) | (unsigned)(a * 16 + bq));
        const float mx = funkey(r3[0] & ~0xFFu);
        float ev[16]; float sum = 0.f;
#pragma unroll
        for (int i = 0; i < 16; ++i) { ev[i] = __expf(funkey(r3[i] & ~0xFFu) - mx); sum += ev[i]; }
        const float rs = 1.0f / sum;
        int eid[16];
#pragma unroll
        for (int i = 0; i < 16; ++i) { const unsigned f = r3[i] & 0xFFu; eid[i] = (int)ib[f >> 4] * 128 + (int)ib[16 + (f & 15u)]; }
        int* eo = EID + (size_t)tok * 128 + h * 16; float* go = GATE + (size_t)tok * 128 + h * 16;
#pragma unroll
        for (int q = 0; q < 4; ++q) {
            *(u32x4*)(eo + 4 * q) = (u32x4){(unsigned)eid[4 * q], (unsigned)eid[4 * q + 1], (unsigned)eid[4 * q + 2], (unsigned)eid[4 * q + 3]};
            *(f32x4*)(go + 4 * q) = (f32x4){ev[4 * q] * rs, ev[4 * q + 1] * rs, ev[4 * q + 2] * rs, ev[4 * q + 3] * rs};
        }
    }
}

__device__ __forceinline__ float gelu_erf(float x) { return 0.5f * x * (1.0f + erff(x * 0.70710678118654752f)); }
__device__ __forceinline__ float ub0(unsigned w) { return (float)(w & 0xffu); }
__device__ __forceinline__ float ub1(unsigned w) { return (float)((w >> 8) & 0xffu); }
__device__ __forceinline__ float ub2(unsigned w) { return (float)((w >> 16) & 0xffu); }
__device__ __forceinline__ float ub3(unsigned w) { return (float)(w >> 24); }
__device__ __forceinline__ void phase_peer(LAS unsigned char* lds, const float* X, const int* EID, const float* GATE, const unsigned char* U, const unsigned char* V, const float* USC, const float* VSC,
                                           const float* g, const float* bta, float* outf, bf16_t* outb) {
    const int lane = threadIdx.x & 63, wv = threadIdx.x >> 6, gw = blockIdx.x * 8 + wv, nw = gridDim.x * 8;
    LAS float* hb = (LAS float*)(lds + wv * 512);
    for (int tok = gw; tok < MTOK; tok += nw) {
        float x[32];
        const float* xp = X + (size_t)tok * DM;
#pragma unroll
        for (int i = 0; i < 2; ++i)
#pragma unroll
            for (int q = 0; q < 4; ++q) { const f32x4 t = *(const f32x4*)(xp + 1024 * i + 16 * lane + 4 * q); x[16 * i + 4 * q] = t[0]; x[16 * i + 4 * q + 1] = t[1]; x[16 * i + 4 * q + 2] = t[2]; x[16 * i + 4 * q + 3] = t[3]; }
        float sx = 0.f;
#pragma unroll
        for (int j = 0; j < 32; ++j) sx += x[j];
        const float d0 = -128.0f * sx;
        const int e0 = EID[(size_t)tok * 128 + lane], e1 = EID[(size_t)tok * 128 + 64 + lane];
        const float g0 = GATE[(size_t)tok * 128 + lane], g1 = GATE[(size_t)tok * 128 + 64 + lane];
        for (int bt = 0; bt < 16; ++bt) {
            float d[8];
#pragma unroll
            for (int r = 0; r < 8; ++r) {
                const int e = bt * 8 + r;
                const int idx = __builtin_amdgcn_readfirstlane(__shfl(bt < 8 ? e0 : e1, e & 63));
                const u32x4* up = (const u32x4*)(U + (size_t)idx * DM) + lane;
                float acc = d0;
#pragma unroll
                for (int i = 0; i < 2; ++i) {
                    const u32x4 w = up[i * 64];
                    acc += x[16 * i + 0] * ub0(w.x) + x[16 * i + 1] * ub1(w.x) + x[16 * i + 2] * ub2(w.x) + x[16 * i + 3] * ub3(w.x)
                         + x[16 * i + 4] * ub0(w.y) + x[16 * i + 5] * ub1(w.y) + x[16 * i + 6] * ub2(w.y) + x[16 * i + 7] * ub3(w.y)
                         + x[16 * i + 8] * ub0(w.z) + x[16 * i + 9] * ub1(w.z) + x[16 * i + 10] * ub2(w.z) + x[16 * i + 11] * ub3(w.z)
                         + x[16 * i + 12] * ub0(w.w) + x[16 * i + 13] * ub1(w.w) + x[16 * i + 14] * ub2(w.w) + x[16 * i + 15] * ub3(w.w);
                }
                d[r] = acc;
            }
            const bool b5 = lane & 32, b4 = lane & 16, b3 = lane & 8;
            float t4[4];
#pragma unroll
            for (int q = 0; q < 4; ++q) { const float keep = b5 ? d[4 + q] : d[q], send = b5 ? d[q] : d[4 + q]; t4[q] = keep + __shfl_xor(send, 32); }
            float t2[2];
#pragma unroll
            for (int q = 0; q < 2; ++q) { const float keep = b4 ? t4[2 + q] : t4[q], send = b4 ? t4[q] : t4[2 + q]; t2[q] = keep + __shfl_xor(send, 16); }
            float t1;
            { const float keep = b3 ? t2[1] : t2[0], send = b3 ? t2[0] : t2[1]; t1 = keep + __shfl_xor(send, 8); }
            t1 += __shfl_xor(t1, 4); t1 += __shfl_xor(t1, 2); t1 += __shfl_xor(t1, 1);
            if ((lane & 7) == 0) hb[bt * 8 + (lane >> 3 & 1) + 2 * (lane >> 4 & 1) + 4 * (lane >> 5 & 1)] = t1;
        }
        asm volatile("s_waitcnt lgkmcnt(0)" ::: "memory");
        const float h0 = hb[lane] * USC[e0], h1 = hb[64 + lane] * USC[e1];
        const float w0 = g0 * gelu_erf(h0) * VSC[e0], w1 = g1 * gelu_erf(h1) * VSC[e1];
        float wsum = wave_sum(w0 + w1);
        float y[32];
#pragma unroll
        for (int i = 0; i < 32; ++i) y[i] = 0.f;
#pragma unroll 8
        for (int e = 0; e < 128; ++e) {
            const int idx = __builtin_amdgcn_readfirstlane(__shfl(e < 64 ? e0 : e1, e & 63));
            const float wt = __shfl(e < 64 ? w0 : w1, e & 63);
            const u32x4* vp = (const u32x4*)(V + (size_t)idx * DM) + lane;
#pragma unroll
            for (int i = 0; i < 2; ++i) {
                const u32x4 w = vp[i * 64];
                y[16 * i + 0] += wt * ub0(w.x); y[16 * i + 1] += wt * ub1(w.x); y[16 * i + 2] += wt * ub2(w.x); y[16 * i + 3] += wt * ub3(w.x);
                y[16 * i + 4] += wt * ub0(w.y); y[16 * i + 5] += wt * ub1(w.y); y[16 * i + 6] += wt * ub2(w.y); y[16 * i + 7] += wt * ub3(w.y);
                y[16 * i + 8] += wt * ub0(w.z); y[16 * i + 9] += wt * ub1(w.z); y[16 * i + 10] += wt * ub2(w.z); y[16 * i + 11] += wt * ub3(w.z);
                y[16 * i + 12] += wt * ub0(w.w); y[16 * i + 13] += wt * ub1(w.w); y[16 * i + 14] += wt * ub2(w.w); y[16 * i + 15] += wt * ub3(w.w);
            }
        }
        const float corr = -128.0f * wsum;
#pragma unroll
        for (int i = 0; i < 32; ++i) y[i] = y[i] + corr + ALPHA * x[i];
        ln_row_store16(y, g, bta, outf + (size_t)tok * DM, outb ? outb + (size_t)tok * DM : nullptr, lane);
        asm volatile("s_waitcnt lgkmcnt(0)" ::: "memory");
    }
}

__device__ __forceinline__ int row_dot_i8(const u32x4 (&xq)[2], const unsigned char* rowp, int lane) {
    const u32x4* up = (const u32x4*)rowp + lane;
    int acc = 0;
#pragma unroll
    for (int i = 0; i < 2; ++i) {
        const u32x4 w = up[i * 64];
        acc = __builtin_amdgcn_sdot4((int)xq[i].x, (int)(w.x ^ 0x80808080u), acc, false); acc = __builtin_amdgcn_sdot4((int)xq[i].y, (int)(w.y ^ 0x80808080u), acc, false);
        acc = __builtin_amdgcn_sdot4((int)xq[i].z, (int)(w.z ^ 0x80808080u), acc, false); acc = __builtin_amdgcn_sdot4((int)xq[i].w, (int)(w.w ^ 0x80808080u), acc, false);
    }
    return acc;
}
__device__ __forceinline__ void peer_issue8(u32x4 (&seg)[8], const unsigned char* base, const u32x4 ia, const u32x4 ib) {
    seg[0] = *(const u32x4*)(base + (size_t)ia.x * DM); seg[1] = *(const u32x4*)(base + (size_t)ia.y * DM); seg[2] = *(const u32x4*)(base + (size_t)ia.z * DM); seg[3] = *(const u32x4*)(base + (size_t)ia.w * DM);
    seg[4] = *(const u32x4*)(base + (size_t)ib.x * DM); seg[5] = *(const u32x4*)(base + (size_t)ib.y * DM); seg[6] = *(const u32x4*)(base + (size_t)ib.z * DM); seg[7] = *(const u32x4*)(base + (size_t)ib.w * DM);
}
__device__ __forceinline__ void peer_dot8(int (&d)[8], const u32x4 (&seg)[8], const u32x4 xq) {
#pragma unroll
    for (int i = 0; i < 8; ++i) {
        int acc = __builtin_amdgcn_sdot4((int)xq.x, (int)(seg[i].x ^ 0x80808080u), 0, false);
        acc = __builtin_amdgcn_sdot4((int)xq.y, (int)(seg[i].y ^ 0x80808080u), acc, false);
        acc = __builtin_amdgcn_sdot4((int)xq.z, (int)(seg[i].z ^ 0x80808080u), acc, false);
        d[i] = __builtin_amdgcn_sdot4((int)xq.w, (int)(seg[i].w ^ 0x80808080u), acc, false);
    }
}
__device__ __forceinline__ void phase_peer_u(const signed char* XQ, const int* EID, const unsigned char* U, int* P) {
    const int lane = threadIdx.x & 63, wv = threadIdx.x >> 6, es = lane >> 3, cc = lane & 7;
    const bool b2 = cc & 4, b1 = cc & 2, b0 = cc & 1;
    const int nw = gridDim.x * 8, gw = blockIdx.x * 8 + wv, tpw = (MTOK + nw - 1) / nw, tbase = gw * tpw;
    int cnt = MTOK - tbase; cnt = cnt > tpw ? tpw : cnt;
    if (cnt <= 0) return;
    const int nit = 16 * cnt;
    const unsigned char* ub = U + cc * 16;
    u32x4 idA0, idA1, idB0, idB1, xqA; u32x4 sA[8], sB[8];
#define PU_META(k_, half_, I0, I1) { const int* ep_ = EID + (size_t)(tbase + (k_)) * 128 + es * 16 + (half_) * 8; I0 = *(const u32x4*)ep_; I1 = *(const u32x4*)(ep_ + 4); }
#define PU_XQ(sl_, k_, XQv) { XQv = *(const u32x4*)(XQ + (size_t)(tbase + (k_)) * DM + (sl_) * 128 + cc * 16); }
    PU_META(0, 0, idA0, idA1) PU_XQ(0, 0, xqA)
    peer_issue8(sA, ub, idA0, idA1);
    PU_META(0, 1, idB0, idB1)
    int sl = 0, k = 0;
    for (int it = 0; it < nit; ++it) {
        int kn = k + 1, sln = sl; if (kn == cnt) { kn = 0; ++sln; } if (it + 1 == nit) { kn = k; sln = sl; }
        peer_issue8(sB, ub + sl * 128, idB0, idB1);
        const u32x4 xq = xqA;
        PU_META(kn, 0, idA0, idA1) PU_XQ(sln, kn, xqA)
        int dlo[8]; peer_dot8(dlo, sA, xq);
        peer_issue8(sA, ub + sln * 128, idA0, idA1);
        PU_META(kn, 1, idB0, idB1)
        int dhi[8]; peer_dot8(dhi, sB, xq);
        int t8[8], t4[4], t2[2];
#pragma unroll
        for (int q = 0; q < 8; ++q) { const int keep = b2 ? dhi[q] : dlo[q], send = b2 ? dlo[q] : dhi[q]; t8[q] = keep + __shfl_xor(send, 4); }
#pragma unroll
        for (int q = 0; q < 4; ++q) { const int keep = b1 ? t8[4 + q] : t8[q], send = b1 ? t8[q] : t8[4 + q]; t4[q] = keep + __shfl_xor(send, 2); }
#pragma unroll
        for (int q = 0; q < 2; ++q) { const int keep = b0 ? t4[2 + q] : t4[q], send = b0 ? t4[q] : t4[2 + q]; t2[q] = keep + __shfl_xor(send, 1); }
        u32x2 o; o.x = (unsigned)t2[0]; o.y = (unsigned)t2[1];
        *(u32x2*)(P + ((size_t)sl * MTOK + tbase + k) * 128 + es * 16 + (b2 ? 8 : 0) + (b1 ? 4 : 0) + (b0 ? 2 : 0)) = o;
        k = kn; sl = sln;
    }
#undef PU_META
#undef PU_XQ
}
__device__ __forceinline__ void phase_peer_w(const int* P, const float* XS, const int* EID, const float* GATE, const float* USC, const float* VSC, float* W, float* CS) {
    const int lane = threadIdx.x & 63, gw = blockIdx.x * 8 + (threadIdx.x >> 6), nw = gridDim.x * 8;
    for (int tok = gw; tok < MTOK; tok += nw) {
        int h0 = 0, h1 = 0;
#pragma unroll
        for (int sl = 0; sl < 16; ++sl) { h0 += P[((size_t)sl * MTOK + tok) * 128 + lane]; h1 += P[((size_t)sl * MTOK + tok) * 128 + 64 + lane]; }
        const int e0 = EID[(size_t)tok * 128 + lane], e1 = EID[(size_t)tok * 128 + 64 + lane];
        const float xs = XS[tok];
        const float w0 = GATE[(size_t)tok * 128 + lane] * gelu_erf((float)h0 * xs * USC[e0]) * VSC[e0];
        const float w1 = GATE[(size_t)tok * 128 + 64 + lane] * gelu_erf((float)h1 * xs * USC[e1]) * VSC[e1];
        W[(size_t)tok * 128 + lane] = w0; W[(size_t)tok * 128 + 64 + lane] = w1;
        const float cs = wave_sum(w0 + w1);
        if (lane == 0) CS[tok] = cs;
    }
}
__device__ __forceinline__ void peer_fma8(f32x2_t (&ya)[8], const u32x4 (&seg)[8], const f32x4 wa, const f32x4 wb2) {
#pragma unroll
    for (int i = 0; i < 8; ++i) {
        const float wt = i < 4 ? wa[i & 3] : wb2[i & 3];
        const f32x2_t wt2 = {wt, wt};
        const u32x4 w = seg[i];
        ya[0] = __builtin_elementwise_fma(wt2, (f32x2_t){ub0(w.x), ub1(w.x)}, ya[0]); ya[1] = __builtin_elementwise_fma(wt2, (f32x2_t){ub2(w.x), ub3(w.x)}, ya[1]);
        ya[2] = __builtin_elementwise_fma(wt2, (f32x2_t){ub0(w.y), ub1(w.y)}, ya[2]); ya[3] = __builtin_elementwise_fma(wt2, (f32x2_t){ub2(w.y), ub3(w.y)}, ya[3]);
        ya[4] = __builtin_elementwise_fma(wt2, (f32x2_t){ub0(w.z), ub1(w.z)}, ya[4]); ya[5] = __builtin_elementwise_fma(wt2, (f32x2_t){ub2(w.z), ub3(w.z)}, ya[5]);
        ya[6] = __builtin_elementwise_fma(wt2, (f32x2_t){ub0(w.w), ub1(w.w)}, ya[6]); ya[7] = __builtin_elementwise_fma(wt2, (f32x2_t){ub2(w.w), ub3(w.w)}, ya[7]);
    }
}
__device__ __forceinline__ void phase_peer_v(const float* X, const int* EID, const float* W, const float* CS, const unsigned char* V, float* Y) {
    const int lane = threadIdx.x & 63, wv = threadIdx.x >> 6, es = lane >> 3, cc = lane & 7;
    const bool b5 = lane & 32, b4 = lane & 16, b3 = lane & 8;
    const int nw = gridDim.x * 8, gw = blockIdx.x * 8 + wv, tpw = (MTOK + nw - 1) / nw, tbase = gw * tpw;
    int cnt = MTOK - tbase; cnt = cnt > tpw ? tpw : cnt;
    if (cnt <= 0) return;
    const int nit = 16 * cnt;
    const unsigned char* vb = V + cc * 16;
    const int colo = cc * 16 + (b5 ? 8 : 0) + (b4 ? 4 : 0) + (b3 ? 2 : 0);
    u32x4 idA0, idA1, idB0, idB1; f32x4 wA0, wA1, wB0, wB1; f32x2_t xr; float cs; u32x4 sA[8], sB[8];
#define PV_META(k_, half_, I0, I1, W0, W1) { const size_t o_ = (size_t)(tbase + (k_)) * 128 + es * 16 + (half_) * 8; \
        I0 = *(const u32x4*)(EID + o_); I1 = *(const u32x4*)(EID + o_ + 4); W0 = *(const f32x4*)(W + o_); W1 = *(const f32x4*)(W + o_ + 4); }
#define PV_XR(sl_, k_) { xr = *(const f32x2_t*)(X + (size_t)(tbase + (k_)) * DM + (sl_) * 128 + colo); cs = CS[tbase + (k_)]; }
    PV_META(0, 0, idA0, idA1, wA0, wA1)
    peer_issue8(sA, vb, idA0, idA1);
    PV_META(0, 1, idB0, idB1, wB0, wB1) PV_XR(0, 0)
    int sl = 0, k = 0;
    for (int it = 0; it < nit; ++it) {
        int kn = k + 1, sln = sl; if (kn == cnt) { kn = 0; ++sln; } if (it + 1 == nit) { kn = k; sln = sl; }
        peer_issue8(sB, vb + sl * 128, idB0, idB1);
        const f32x4 w0 = wA0, w1 = wA1, w2 = wB0, w3 = wB1; const f32x2_t xrc = xr; const float csc = cs;
        PV_META(kn, 0, idA0, idA1, wA0, wA1)
        f32x2_t ya[8];
#pragma unroll
        for (int j = 0; j < 8; ++j) ya[j] = (f32x2_t){0.f, 0.f};
        peer_fma8(ya, sA, w0, w1);
        peer_issue8(sA, vb + sln * 128, idA0, idA1);
        PV_META(kn, 1, idB0, idB1, wB0, wB1) PV_XR(sln, kn)
        peer_fma8(ya, sB, w2, w3);
        f32x2_t t4[4], t2[2], t1;
#pragma unroll
        for (int q = 0; q < 4; ++q) { const f32x2_t keep = b5 ? ya[4 + q] : ya[q], send = b5 ? ya[q] : ya[4 + q]; t4[q][0] = keep[0] + __shfl_xor(send[0], 32); t4[q][1] = keep[1] + __shfl_xor(send[1], 32); }
#pragma unroll
        for (int q = 0; q < 2; ++q) { const f32x2_t keep = b4 ? t4[2 + q] : t4[q], send = b4 ? t4[q] : t4[2 + q]; t2[q][0] = keep[0] + __shfl_xor(send[0], 16); t2[q][1] = keep[1] + __shfl_xor(send[1], 16); }
        { const f32x2_t keep = b3 ? t2[1] : t2[0], send = b3 ? t2[0] : t2[1]; t1[0] = keep[0] + __shfl_xor(send[0], 8); t1[1] = keep[1] + __shfl_xor(send[1], 8); }
        f32x2_t o; o[0] = t1[0] - 128.0f * csc + ALPHA * xrc[0]; o[1] = t1[1] - 128.0f * csc + ALPHA * xrc[1];
        *(f32x2_t*)(Y + (size_t)(tbase + k) * DM + sl * 128 + colo) = o;
        k = kn; sl = sln;
    }
#undef PV_META
#undef PV_XR
}

__device__ __forceinline__ void rot8(const u32x4 lo, const u32x4 hi, const f32x4 c0, const f32x4 c1, const f32x4 s0, const f32x4 s1, float (&o1)[8], float (&o2)[8]) {
    const float a[8] = {bflo(lo.x), bfhi(lo.x), bflo(lo.y), bfhi(lo.y), bflo(lo.z), bfhi(lo.z), bflo(lo.w), bfhi(lo.w)};
    const float b[8] = {bflo(hi.x), bfhi(hi.x), bflo(hi.y), bfhi(hi.y), bflo(hi.z), bfhi(hi.z), bflo(hi.w), bfhi(hi.w)};
    const float c[8] = {c0[0], c0[1], c0[2], c0[3], c1[0], c1[1], c1[2], c1[3]}, sn[8] = {s0[0], s0[1], s0[2], s0[3], s1[0], s1[1], s1[2], s1[3]};
#pragma unroll
    for (int j = 0; j < 8; ++j) { o1[j] = a[j] * c[j] - b[j] * sn[j]; o2[j] = a[j] * sn[j] + b[j] * c[j]; }
}
__device__ __forceinline__ u32x4 pack8(const float (&o)[8]) { u32x4 w; w.x = pk_bf16(o[0], o[1]); w.y = pk_bf16(o[2], o[3]); w.z = pk_bf16(o[4], o[5]); w.w = pk_bf16(o[6], o[7]); return w; }
__device__ __forceinline__ void phase_rot(LAS float* red, bf16_t* KR, bf16_t* QR, const float* COS, const float* SIN, float* KMEAN, float* KNMAX) {
    const int tid = threadIdx.x, ch = tid & 7, rr = tid >> 3, wv = tid >> 6, lane = tid & 63;
    for (int item = blockIdx.x; item < 2 * NHEAD * 32; item += gridDim.x) {
        const int bh = item >> 5, j = item & 31, b = bh >> 4, h = bh & 15;
        float sm1[8], sm2[8]; float nmax = 0.f;
#pragma unroll
        for (int q = 0; q < 8; ++q) { sm1[q] = 0.f; sm2[q] = 0.f; }
#pragma unroll
        for (int ps = 0; ps < 4; ++ps) {
            const int pos = j * 256 + ps * 64 + rr;
            const size_t off = ((size_t)b * SEQ + pos) * DM + h * 128 + ch * 8;
            const f32x4 c0 = *(const f32x4*)(COS + pos * 64 + ch * 8), c1 = *(const f32x4*)(COS + pos * 64 + ch * 8 + 4);
            const f32x4 s0 = *(const f32x4*)(SIN + pos * 64 + ch * 8), s1 = *(const f32x4*)(SIN + pos * 64 + ch * 8 + 4);
            float o1[8], o2[8];
            rot8(*(const u32x4*)(KR + off), *(const u32x4*)(KR + off + 64), c0, c1, s0, s1, o1, o2);
            *(u32x4*)(KR + off) = pack8(o1); *(u32x4*)(KR + off + 64) = pack8(o2);
            float nq = 0.f;
#pragma unroll
            for (int q = 0; q < 8; ++q) { sm1[q] += o1[q]; sm2[q] += o2[q]; nq += o1[q] * o1[q] + o2[q] * o2[q]; }
            nq += __shfl_xor(nq, 1); nq += __shfl_xor(nq, 2); nq += __shfl_xor(nq, 4);
            nmax = fmaxf(nmax, nq);
            rot8(*(const u32x4*)(QR + off), *(const u32x4*)(QR + off + 64), c0, c1, s0, s1, o1, o2);
            *(u32x4*)(QR + off) = pack8(o1); *(u32x4*)(QR + off + 64) = pack8(o2);
        }
#pragma unroll
        for (int q = 0; q < 8; ++q) {
            sm1[q] += __shfl_xor(sm1[q], 8); sm1[q] += __shfl_xor(sm1[q], 16); sm1[q] += __shfl_xor(sm1[q], 32);
            sm2[q] += __shfl_xor(sm2[q], 8); sm2[q] += __shfl_xor(sm2[q], 16); sm2[q] += __shfl_xor(sm2[q], 32);
        }
        nmax = wave_max(nmax);
        if (lane < 8) {
#pragma unroll
            for (int q = 0; q < 8; ++q) { red[wv * 128 + lane * 8 + q] = sm1[q]; red[wv * 128 + 64 + lane * 8 + q] = sm2[q]; }
        }
        if (lane == 0) red[1024 + wv] = nmax;
        __syncthreads();
        if (tid < 128) {
            float s2 = 0.f;
#pragma unroll
            for (int r = 0; r < 8; ++r) s2 += red[r * 128 + tid];
            KMEAN[(size_t)item * 128 + tid] = s2 * (1.0f / 256.0f);
        }
        if (tid == 0) {
            float m = 0.f;
#pragma unroll
            for (int r = 0; r < 8; ++r) m = fmaxf(m, red[1024 + r]);
            KNMAX[item] = sqrtf(m);
        }
        __syncthreads();
    }
}

__device__ __forceinline__ void top3_insert(float x, int m, float& v0, int& i0, float& v1, int& i1, float& v2, int& i2) {
    const bool c0 = x > v0 || (x == v0 && m < i0), c1 = x > v1 || (x == v1 && m < i1), c2 = x > v2 || (x == v2 && m < i2);
    v2 = c1 ? v1 : (c2 ? x : v2); i2 = c1 ? i1 : (c2 ? m : i2);
    v1 = c0 ? v0 : (c1 ? x : v1); i1 = c0 ? i0 : (c1 ? m : i1);
    v0 = c0 ? x : v0; i0 = c0 ? m : i0;
}
__device__ __forceinline__ void phase_sel(LAS unsigned char* lds, const bf16_t* QR, const float* KMEAN, unsigned short* SUB, int* CNT, int* ctr) {
    const int tid = threadIdx.x, lane = tid & 63, wv = tid >> 6, r32 = lane & 31, hh = lane >> 5;
    LAS unsigned short* bucket = (LAS unsigned short*)lds;
    LAS int* cnt = (LAS int*)(lds + 16384);
    const float NEG = -1e30f;
    if (blockIdx.x == 0 && tid == 0) *ctr = 0;
    for (int item = blockIdx.x; item < 2 * NHEAD * 32; item += gridDim.x) {
        const int bh = item >> 5, i = item & 31, b = bh >> 4, h = bh & 15;
        if (i == 0) continue;
        if (tid < 32) cnt[tid] = 0;
        __syncthreads();
        const float* kmp = KMEAN + ((size_t)bh * 32 + r32) * 128 + 8 * hh;
        const size_t tok = (size_t)b * SEQ + i * 256 + wv * 32 + r32;
        const bf16_t* qp = QR + tok * DM + h * 128 + 8 * hh;
        f32x16 S;
#pragma unroll
        for (int e = 0; e < 16; ++e) S[e] = 0.f;
#pragma unroll
        for (int s2 = 0; s2 < 8; ++s2) {
            const f32x4 ka = *(const f32x4*)(kmp + 16 * s2), kb = *(const f32x4*)(kmp + 16 * s2 + 4);
            const bf16x8 qf = *(const bf16x8*)(qp + 16 * s2);
            u32x4 hi, lo;
            hi.x = pk_bf16(ka[0], ka[1]); hi.y = pk_bf16(ka[2], ka[3]); hi.z = pk_bf16(kb[0], kb[1]); hi.w = pk_bf16(kb[2], kb[3]);
            lo.x = pk_bf16(ka[0] - bflo(hi.x), ka[1] - bfhi(hi.x)); lo.y = pk_bf16(ka[2] - bflo(hi.y), ka[3] - bfhi(hi.y));
            lo.z = pk_bf16(kb[0] - bflo(hi.z), kb[1] - bfhi(hi.z)); lo.w = pk_bf16(kb[2] - bflo(hi.w), kb[3] - bfhi(hi.w));
            S = __builtin_amdgcn_mfma_f32_32x32x16_bf16(__builtin_bit_cast(bf16x8, hi), qf, S, 0, 0, 0);
            S = __builtin_amdgcn_mfma_f32_32x32x16_bf16(__builtin_bit_cast(bf16x8, lo), qf, S, 0, 0, 0);
        }
        float v0 = -3e38f, v1 = -3e38f, v2 = -3e38f; int i0 = 99, i1 = 99, i2 = 99;
#pragma unroll
        for (int e = 0; e < 16; ++e) {
            const int m = (e & 3) + 8 * (e >> 2) + 4 * hh;
            const float x = m < i ? S[e] : NEG;
            top3_insert(x, m, v0, i0, v1, i1, v2, i2);
        }
        {
            const float pv0 = __shfl_xor(v0, 32), pv1 = __shfl_xor(v1, 32), pv2 = __shfl_xor(v2, 32);
            const int pi0 = __shfl_xor(i0, 32), pi1 = __shfl_xor(i1, 32), pi2 = __shfl_xor(i2, 32);
            top3_insert(pv0, pi0, v0, i0, v1, i1, v2, i2); top3_insert(pv1, pi1, v0, i0, v1, i1, v2, i2); top3_insert(pv2, pi2, v0, i0, v1, i1, v2, i2);
        }
        if (hh == 0) {
            const int tl = wv * 32 + r32;
            if (v0 > 0.5f * NEG) { const int p = __hip_atomic_fetch_add(cnt + i0, 1, __ATOMIC_RELAXED, __HIP_MEMORY_SCOPE_WORKGROUP); bucket[i0 * 256 + p] = (unsigned short)(tl | (0 << 8)); }
            if (v1 > 0.5f * NEG) { const int p = __hip_atomic_fetch_add(cnt + i1, 1, __ATOMIC_RELAXED, __HIP_MEMORY_SCOPE_WORKGROUP); bucket[i1 * 256 + p] = (unsigned short)(tl | (1 << 8)); }
            if (v2 > 0.5f * NEG) { const int p = __hip_atomic_fetch_add(cnt + i2, 1, __ATOMIC_RELAXED, __HIP_MEMORY_SCOPE_WORKGROUP); bucket[i2 * 256 + p] = (unsigned short)(tl | (2 << 8)); }
        }
        __syncthreads();
        for (int idx = tid; idx < 32 * 256; idx += 512) {
            const int j = idx >> 8, p = idx & 255;
            if (j < i && p < cnt[j]) SUB[(((size_t)bh * 32 + j) * 32 + i) * 256 + p] = bucket[idx];
        }
        if (tid < i) CNT[((size_t)bh * 32 + tid) * 32 + i] = cnt[tid];
        __syncthreads();
    }
}

__device__ __forceinline__ unsigned off_b(unsigned row, unsigned ch) { return 256u * row + 16u * (ch ^ (((row & 3u) << 2) | ((row >> 2) & 3u))); }
__device__ __forceinline__ unsigned pi32(unsigned m) { return (m & ~12u) | ((m & 4u) << 1) | ((m & 8u) >> 1); }
__device__ __forceinline__ bf16x8 tr_frag(LAS unsigned char* img, unsigned lane, unsigned c, unsigned ks) {
    const unsigned hh = lane >> 5, blk = (lane >> 4) & 1, q = (lane & 15) >> 2, p = lane & 3;
    const unsigned a0 = off_b(16 * ks + 8 * hh + q, 4 * c + 2 * blk + (p >> 1)) + 8 * (p & 1);
    const unsigned a1 = off_b(16 * ks + 8 * hh + 4 + q, 4 * c + 2 * blk + (p >> 1)) + 8 * (p & 1);
    const s16x4 lo = __builtin_amdgcn_ds_read_tr16_b64_v4i16((LAS s16x4*)(img + a0));
    const s16x4 hi = __builtin_amdgcn_ds_read_tr16_b64_v4i16((LAS s16x4*)(img + a1));
    bf16x8 r; r[0] = lo[0]; r[1] = lo[1]; r[2] = lo[2]; r[3] = lo[3]; r[4] = hi[0]; r[5] = hi[1]; r[6] = hi[2]; r[7] = hi[3];
    return r;
}
__device__ __forceinline__ void phase_att(LAS unsigned char* lds, const bf16_t* QR, const bf16_t* KR, const bf16_t* V, const float* KNMAX, const unsigned short* SUB, const int* CNT, int* ctr,
                                          bf16_t* P012, bf16_t* P3, float* LS) {
    const int tid = threadIdx.x, lane = tid & 63, wv = tid >> 6, r32 = lane & 31, hh = lane >> 5;
    LAS unsigned char* Kimg = lds;
    LAS unsigned char* Vimg = lds + 65536;
    LAS int* misc = (LAS int*)(lds + 131072);
    const float SCL2 = 0.08838834764831845f * 1.4426950408889634f;
    for (;;) {
        __syncthreads();
        if (tid == 0) misc[40] = __hip_atomic_fetch_add(ctr, 1, __ATOMIC_RELAXED, __HIP_MEMORY_SCOPE_AGENT);
        __syncthreads();
        const int item = misc[40];
        if (item >= 2 * NHEAD * 32) break;
        const int j = item >> 5, bh = item & 31, b = bh >> 4, h = bh & 15;
#pragma unroll
        for (int r = 0; r < 8; ++r) {
            const int idx = tid + 512 * r, row = idx >> 4, ch = idx & 15;
            const size_t g = ((size_t)b * SEQ + j * 256 + row) * DM + h * 128 + ch * 8;
            const u32x4 kv = *(const u32x4*)(KR + g), vv = *(const u32x4*)(V + g);
            *(LAS u32x4*)(Kimg + off_b(row, ch)) = kv; *(LAS u32x4*)(Vimg + off_b(row, ch)) = vv;
        }
        if (tid <= 32) { int pre = 0; for (int u = j + 1; u < tid; ++u) pre += CNT[((size_t)bh * 32 + j) * 32 + u]; misc[tid] = pre; }
        float kn = (lane < 32) ? KNMAX[bh * 32 + lane] : 0.f;
        kn = wave_max(kn);
        __syncthreads();
        const int total = misc[32], ntile = (256 + total + 31) >> 5;
        for (int tile = wv; tile < ntile; tile += 8) {
            const int gr = tile * 32 + r32;
            int pos, slot; bool valid = true;
            if (gr < 256) { pos = j * 256 + gr; slot = 3; }
            else {
                const int x = gr - 256; valid = x < total;
                int ii = j + 1;
                for (int u = j + 1; u < 32; ++u) if (misc[u] <= x) ii = u;
                if (valid) { const unsigned e = SUB[(((size_t)bh * 32 + j) * 32 + ii) * 256 + (x - misc[ii])]; pos = ii * 256 + (int)(e & 255u); slot = (int)(e >> 8); }
                else { pos = j * 256; slot = 3; }
            }
            const size_t tok = (size_t)b * SEQ + pos;
            bf16x8 qf[8];
            const bf16_t* qp = QR + tok * DM + h * 128 + 8 * hh;
#pragma unroll
            for (int s = 0; s < 8; ++s) qf[s] = *(const bf16x8*)(qp + 16 * s);
            float qn2 = 0.f;
#pragma unroll
            for (int s = 0; s < 8; ++s)
#pragma unroll
                for (int e = 0; e < 8; ++e) { const float f = bf2f((bf16_t)qf[s][e]); qn2 += f * f; }
            qn2 += __shfl_xor(qn2, 32);
            const float c2 = sqrtf(qn2) * kn * SCL2;
            f32x16 O[4];
#pragma unroll
            for (int dt = 0; dt < 4; ++dt)
#pragma unroll
                for (int e = 0; e < 16; ++e) O[dt][e] = 0.f;
            float l = 0.f;
            const bool own = tile < 8;
            const int kcn = own ? tile + 1 : 8;
            const unsigned krow = pi32((unsigned)r32);
            for (int kc = 0; kc < kcn; ++kc) {
                f32x16 S;
#pragma unroll
                for (int e = 0; e < 16; ++e) S[e] = 0.f;
#pragma unroll
                for (int s = 0; s < 8; ++s) {
                    const bf16x8 kf = *(const LAS bf16x8*)(Kimg + off_b(32 * kc + krow, 2 * s + hh));
                    S = __builtin_amdgcn_mfma_f32_32x32x16_bf16(kf, qf[s], S, 0, 0, 0);
                }
                float p[16];
#pragma unroll
                for (int e = 0; e < 16; ++e) {
                    const unsigned m = (e & 3) + 8 * (e >> 2) + 4 * hh;
                    const int key = j * 256 + 32 * kc + (int)pi32(m);
                    float pe = __builtin_amdgcn_exp2f(S[e] * SCL2 - c2);
                    if (own && key > pos) pe = 0.f;
                    p[e] = pe; l += pe;
                }
                u32x4 w0, w1;
                w0.x = pk_bf16(p[0], p[1]); w0.y = pk_bf16(p[2], p[3]); w0.z = pk_bf16(p[4], p[5]); w0.w = pk_bf16(p[6], p[7]);
                w1.x = pk_bf16(p[8], p[9]); w1.y = pk_bf16(p[10], p[11]); w1.z = pk_bf16(p[12], p[13]); w1.w = pk_bf16(p[14], p[15]);
                const bf16x8 pf0 = __builtin_bit_cast(bf16x8, w0), pf1 = __builtin_bit_cast(bf16x8, w1);
#pragma unroll
                for (int dt = 0; dt < 4; ++dt) {
                    const bf16x8 v0 = tr_frag(Vimg, lane, dt, 2 * kc), v1 = tr_frag(Vimg, lane, dt, 2 * kc + 1);
                    O[dt] = __builtin_amdgcn_mfma_f32_32x32x16_bf16(v0, pf0, O[dt], 0, 0, 0);
                    O[dt] = __builtin_amdgcn_mfma_f32_32x32x16_bf16(v1, pf1, O[dt], 0, 0, 0);
                }
            }
            l += __shfl_xor(l, 32);
            if (valid) {
                bf16_t* pl = (slot < 3 ? P012 + (size_t)slot * ((size_t)32 << 20) : P3) + (tok * NHEAD + h) * 128 + 4 * hh;
#pragma unroll
                for (int dt = 0; dt < 4; ++dt)
#pragma unroll
                    for (int g = 0; g < 4; ++g) {
                        u32x2 w; w.x = pk_bf16(O[dt][4 * g], O[dt][4 * g + 1]); w.y = pk_bf16(O[dt][4 * g + 2], O[dt][4 * g + 3]);
                        *(u32x2*)(pl + 32 * dt + 8 * g) = w;
                    }
                if (hh == 0) LS[(size_t)slot * MTOK * NHEAD + tok * NHEAD + h] = l;
            }
        }
    }
}
__device__ __forceinline__ void phase_comb(const bf16_t* P012, const bf16_t* P3, const float* LS, bf16_t* AO) {
    const size_t n = (size_t)MTOK * NHEAD * 16, stride = (size_t)gridDim.x * 512;
    for (size_t idx = (size_t)blockIdx.x * 512 + threadIdx.x; idx < n; idx += stride) {
        const size_t th = idx >> 4; const int ch = (int)(idx & 15);
        const int t = (int)((th >> 4) & (SEQ - 1)), blk = t >> 8, nsel = blk < 3 ? blk : 3;
        float acc[8];
        float l = LS[(size_t)3 * MTOK * NHEAD + th];
        { const u32x4 w = *(const u32x4*)(P3 + th * 128 + ch * 8);
          acc[0] = bflo(w.x); acc[1] = bfhi(w.x); acc[2] = bflo(w.y); acc[3] = bfhi(w.y); acc[4] = bflo(w.z); acc[5] = bfhi(w.z); acc[6] = bflo(w.w); acc[7] = bfhi(w.w); }
        for (int s = 0; s < nsel; ++s) {
            const u32x4 w = *(const u32x4*)(P012 + (size_t)s * ((size_t)32 << 20) + th * 128 + ch * 8);
            acc[0] += bflo(w.x); acc[1] += bfhi(w.x); acc[2] += bflo(w.y); acc[3] += bfhi(w.y); acc[4] += bflo(w.z); acc[5] += bfhi(w.z); acc[6] += bflo(w.w); acc[7] += bfhi(w.w);
            l += LS[(size_t)s * MTOK * NHEAD + th];
        }
        const float rl = 1.0f / l;
        u32x4 o; o.x = pk_bf16(acc[0] * rl, acc[1] * rl); o.y = pk_bf16(acc[2] * rl, acc[3] * rl); o.z = pk_bf16(acc[4] * rl, acc[5] * rl); o.w = pk_bf16(acc[6] * rl, acc[7] * rl);
        *(u32x4*)(AO + th * 128 + ch * 8) = o;
    }
}

__device__ __forceinline__ void phase_scan_a(LAS unsigned char* lds, const float* LF, const bf16_t* I1, bf16_t* LT, float* DEC, unsigned* dbgc = nullptr) {
    unsigned dbg_kt = 0, dbg_acc = 0;
    const int tid = threadIdx.x, lane = tid & 63, wv = tid >> 6, k = tid & 127, part = tid >> 7;
    LAS unsigned char* Iimg = lds; LAS unsigned char* KTimg = lds + 16384;
    LAS float* psum = (LAS float*)(lds + 32768);
    LAS unsigned char* Lst = lds + 36864;
#if SCAN_A_VALU == 2
    for (int item = blockIdx.x; item < 2 * NHEAD * 128; item += gridDim.x) {
        const int bh = item >> 7, c = item & 127, b = bh >> 4, h = bh & 15;
        const size_t tok0 = (size_t)b * SEQ + c * 64;
        for (int idx = tid; idx < 16384; idx += 512) {
            const int v = idx >> 7, kk = idx & 127;
            float g = 1.f, L = 0.f;
            for (int s2 = 63; s2 >= 0; --s2) { const size_t o = (tok0 + s2) * DM + h * 128; const float f = __expf(LF[o + kk]); L += bf2f(I1[o + v]) * (1.0f - f) * g; g *= f; }
            LT[(size_t)item * 16384 + idx] = (bf16_t)(pk_bf16(L, 0.f) & 0xffffu);
        }
    }
    return;
#endif
    for (int item = blockIdx.x; item < 2 * NHEAD * 128; item += gridDim.x) {
        const int bh = item >> 7, c = item & 127, b = bh >> 4, h = bh & 15;
        const size_t tok0 = (size_t)b * SEQ + c * 64;
        float lf[16];
#pragma unroll
        for (int i = 0; i < 16; ++i) lf[i] = LF[(tok0 + 16 * part + i) * DM + h * 128 + k];
#pragma unroll
        for (int r = 0; r < 2; ++r) { const int idx = tid + 512 * r, row = idx >> 4, ch = idx & 15; *(LAS u32x4*)(Iimg + off_b(row, ch)) = *(const u32x4*)(I1 + (tok0 + row) * DM + h * 128 + ch * 8); }
        float cs = 0.f;
#pragma unroll
        for (int i = 0; i < 16; ++i) cs += lf[i];
        psum[part * 128 + k] = cs;
        __syncthreads();
        const float p0 = psum[k], p1 = psum[128 + k], p2 = psum[256 + k], p3 = psum[384 + k];
        const float blast = (p0 + p1) + (p2 + p3);
        float bb = part == 0 ? 0.f : (part == 1 ? p0 : (part == 2 ? p0 + p1 : p0 + p1 + p2));
#pragma unroll
        for (int i = 0; i < 16; ++i) {
            bb += lf[i];
            const float kt = (1.0f - __expf(lf[i])) * __expf(blast - bb);
            if (!(kt - kt == 0.f)) ++dbg_kt;
            const int srow = 16 * part + i;
            *(LAS bf16_t*)(KTimg + off_b(srow, k >> 3) + 2 * (k & 7)) = (bf16_t)(pk_bf16(kt, 0.f) & 0xffffu);
        }
        if (part == 0) DEC[(size_t)item * 128 + k] = __expf(blast);
        __syncthreads();
#if SCAN_A_VALU
        for (int idx = tid; idx < 16384; idx += 512) {
            const int v = idx >> 7, kk = idx & 127;
            float accv = 0.f;
            for (int s2 = 0; s2 < 64; ++s2) accv += bf2f(*(const LAS bf16_t*)(Iimg + off_b(s2, v >> 3) + 2 * (v & 7))) * bf2f(*(const LAS bf16_t*)(KTimg + off_b(s2, kk >> 3) + 2 * (kk & 7)));
            *(LAS bf16_t*)(Lst + v * 272 + 2 * kk) = (bf16_t)(pk_bf16(accv, 0.f) & 0xffffu);
        }
        if (0)
#endif
        {
            const int vt = wv >> 1;
            f32x16 acc0, acc1;
#pragma unroll
            for (int e = 0; e < 16; ++e) { acc0[e] = 0.f; acc1[e] = 0.f; }
#pragma unroll
            for (int ks = 0; ks < 4; ++ks) {
                const bf16x8 af = tr_frag(Iimg, lane, vt, ks);
                const bf16x8 b0 = tr_frag(KTimg, lane, 2 * (wv & 1), ks), b1 = tr_frag(KTimg, lane, 2 * (wv & 1) + 1, ks);
                acc0 = __builtin_amdgcn_mfma_f32_32x32x16_bf16(af, b0, acc0, 0, 0, 0);
                acc1 = __builtin_amdgcn_mfma_f32_32x32x16_bf16(af, b1, acc1, 0, 0, 0);
            }
            const int r32 = lane & 31, hh = lane >> 5;
#pragma unroll
            for (int e = 0; e < 16; ++e) {
                if (!(acc0[e] - acc0[e] == 0.f)) ++dbg_acc; if (!(acc1[e] - acc1[e] == 0.f)) ++dbg_acc;
                const int v = 32 * vt + (e & 3) + 8 * (e >> 2) + 4 * hh;
                *(LAS bf16_t*)(Lst + v * 272 + 2 * (64 * (wv & 1) + r32)) = (bf16_t)(pk_bf16(acc0[e], 0.f) & 0xffffu);
                *(LAS bf16_t*)(Lst + v * 272 + 2 * (64 * (wv & 1) + 32 + r32)) = (bf16_t)(pk_bf16(acc1[e], 0.f) & 0xffffu);
            }
        }
        __syncthreads();
#pragma unroll
        for (int r = 0; r < 4; ++r) { const int idx = tid + 512 * r, row = idx >> 4, ch = idx & 15; store_wt16(LT + (size_t)item * 16384 + row * 128 + ch * 8, *(const LAS u32x4*)(Lst + row * 272 + ch * 16)); }
        __syncthreads();
    }
    if (dbgc) { if (dbg_kt) atomicAdd(dbgc + 0, dbg_kt); if (dbg_acc) atomicAdd(dbgc + 1, dbg_acc); }
}
__device__ __forceinline__ void phase_scan_b(bf16_t* LT, const float* DEC) {
    const int n = 2 * NHEAD * 128 * 32;
    for (int idx = blockIdx.x * 512 + threadIdx.x; idx < n; idx += gridDim.x * 512) {
        const int bh = idx >> 12, vk = idx & 4095, k4 = (vk & 31) * 4;
        float S0 = 0.f, S1 = 0.f, S2 = 0.f, S3 = 0.f;
        bf16_t* p = LT + (size_t)bh * 128 * 16384 + (size_t)vk * 4;
        const float* dp = DEC + (size_t)bh * 128 * 128 + k4;
#pragma unroll 8
        for (int c = 0; c < 128; ++c) {
            const u32x2 w = *(const u32x2*)(p + (size_t)c * 16384);
            const f32x4 d = *(const f32x4*)(dp + c * 128);
            u32x2 o; o.x = pk_bf16(S0, S1); o.y = pk_bf16(S2, S3);
            store_wt8(p + (size_t)c * 16384, o);
            S0 = d[0] * S0 + bflo(w.x); S1 = d[1] * S1 + bfhi(w.x); S2 = d[2] * S2 + bflo(w.y); S3 = d[3] * S3 + bfhi(w.y);
        }
    }
}
__device__ __forceinline__ void phase_scan_c(LAS unsigned char* lds, const bf16_t* Q1, const float* LF, const bf16_t* I1, const bf16_t* G1, const bf16_t* SP, const float* gnorm, bf16_t* OG) {
    const int tid = threadIdx.x, lane = tid & 63, wv = tid >> 6, k = tid & 127, part = tid >> 7, r32 = lane & 31, hh = lane >> 5;
    LAS unsigned char* QTimg = lds; LAS unsigned char* QPimg = lds + 16384; LAS unsigned char* KPimg = lds + 32768; LAS unsigned char* Iimg = lds + 49152; LAS unsigned char* SPimg = lds + 65536;
    LAS float* psum = (LAS float*)(lds + 98304);
    LAS float* ssq = (LAS float*)(lds + 100352);
    LAS unsigned char* OT = lds + 102400;
    for (int item = blockIdx.x; item < 2 * NHEAD * 128; item += gridDim.x) {
        const int bh = item >> 7, c = item & 127, b = bh >> 4, h = bh & 15;
        const size_t tok0 = (size_t)b * SEQ + c * 64;
        float lf[16], qv[16];
#pragma unroll
        for (int i = 0; i < 16; ++i) { const size_t o = (tok0 + 16 * part + i) * DM + h * 128 + k; lf[i] = LF[o]; qv[i] = bf2f(Q1[o]); }
#pragma unroll
        for (int r = 0; r < 2; ++r) { const int idx = tid + 512 * r, row = idx >> 4, ch = idx & 15; *(LAS u32x4*)(Iimg + off_b(row, ch)) = *(const u32x4*)(I1 + (tok0 + row) * DM + h * 128 + ch * 8); }
#pragma unroll
        for (int r = 0; r < 4; ++r) { const int idx = tid + 512 * r, row = idx >> 4, ch = idx & 15; *(LAS u32x4*)(SPimg + off_b(row, ch)) = *(const u32x4*)(SP + (size_t)item * 16384 + row * 128 + ch * 8); }
        float cs = 0.f;
#pragma unroll
        for (int i = 0; i < 16; ++i) cs += lf[i];
        psum[part * 128 + k] = cs;
        __syncthreads();
        const float p0 = psum[k], p1 = psum[128 + k], p2 = psum[256 + k];
        const float rr = p0 + p1;
        float bb = part == 0 ? 0.f : (part == 1 ? p0 : (part == 2 ? p0 + p1 : p0 + p1 + p2));
#pragma unroll
        for (int i = 0; i < 16; ++i) {
            bb += lf[i];
            const float qt = qv[i] * __expf(bb), qp = qv[i] * __expf(bb - rr), kp = (1.0f - __expf(lf[i])) * __expf(rr - bb);
            const unsigned o = off_b(16 * part + i, k >> 3) + 2 * (k & 7);
            *(LAS bf16_t*)(QTimg + o) = (bf16_t)(pk_bf16(qt, 0.f) & 0xffffu);
            *(LAS bf16_t*)(QPimg + o) = (bf16_t)(pk_bf16(qp, 0.f) & 0xffffu);
            *(LAS bf16_t*)(KPimg + o) = (bf16_t)(pk_bf16(kp, 0.f) & 0xffffu);
        }
        __syncthreads();
        const int tt = wv & 1, vt = wv >> 1;
        f32x16 O;
#pragma unroll
        for (int e = 0; e < 16; ++e) O[e] = 0.f;
#pragma unroll
        for (int ks = 0; ks < 8; ++ks) {
            const bf16x8 af = *(const LAS bf16x8*)(SPimg + off_b(32 * vt + r32, 2 * ks + hh));
            const bf16x8 bf = *(const LAS bf16x8*)(QTimg + off_b(32 * tt + r32, 2 * ks + hh));
            O = __builtin_amdgcn_mfma_f32_32x32x16_bf16(af, bf, O, 0, 0, 0);
        }
        const unsigned krow = pi32((unsigned)r32);
        for (int st = 0; st <= tt; ++st) {
            f32x16 S;
#pragma unroll
            for (int e = 0; e < 16; ++e) S[e] = 0.f;
#pragma unroll
            for (int ks = 0; ks < 8; ++ks) {
                const bf16x8 af = *(const LAS bf16x8*)(KPimg + off_b(32 * st + krow, 2 * ks + hh));
                const bf16x8 bf = *(const LAS bf16x8*)(QPimg + off_b(32 * tt + r32, 2 * ks + hh));
                S = __builtin_amdgcn_mfma_f32_32x32x16_bf16(af, bf, S, 0, 0, 0);
            }
            float p[16];
#pragma unroll
            for (int e = 0; e < 16; ++e) {
                const unsigned m = (e & 3) + 8 * (e >> 2) + 4 * hh;
                const int sidx = 32 * st + (int)pi32(m), tidx = 32 * tt + r32;
                p[e] = sidx <= tidx ? S[e] : 0.f;
            }
            u32x4 w0, w1;
            w0.x = pk_bf16(p[0], p[1]); w0.y = pk_bf16(p[2], p[3]); w0.z = pk_bf16(p[4], p[5]); w0.w = pk_bf16(p[6], p[7]);
            w1.x = pk_bf16(p[8], p[9]); w1.y = pk_bf16(p[10], p[11]); w1.z = pk_bf16(p[12], p[13]); w1.w = pk_bf16(p[14], p[15]);
            const bf16x8 pf0 = __builtin_bit_cast(bf16x8, w0), pf1 = __builtin_bit_cast(bf16x8, w1);
            const bf16x8 i0 = tr_frag(Iimg, lane, vt, 2 * st), i1 = tr_frag(Iimg, lane, vt, 2 * st + 1);
            O = __builtin_amdgcn_mfma_f32_32x32x16_bf16(i0, pf0, O, 0, 0, 0);
            O = __builtin_amdgcn_mfma_f32_32x32x16_bf16(i1, pf1, O, 0, 0, 0);
        }
        float sq = 0.f;
#pragma unroll
        for (int e = 0; e < 16; ++e) sq += O[e] * O[e];
        sq += __shfl_xor(sq, 32);
        if (hh == 0) ssq[vt * 64 + 32 * tt + r32] = sq;
        __syncthreads();
        const int tl = 32 * tt + r32;
        const float rstd = rsqrtf((ssq[tl] + ssq[64 + tl] + ssq[128 + tl] + ssq[192 + tl]) * (1.0f / 128.0f) + 1e-6f);
#pragma unroll
        for (int g = 0; g < 4; ++g) {
            const int v0 = 32 * vt + 8 * g + 4 * hh;
            const f32x4 gn = *(const f32x4*)(gnorm + v0);
            u32x2 w; w.x = pk_bf16(O[4 * g] * rstd * gn[0], O[4 * g + 1] * rstd * gn[1]); w.y = pk_bf16(O[4 * g + 2] * rstd * gn[2], O[4 * g + 3] * rstd * gn[3]);
            *(LAS u32x2*)(OT + tl * 272 + v0 * 2) = w;
        }
        __syncthreads();
#pragma unroll
        for (int r = 0; r < 2; ++r) {
            const int idx = tid + 512 * r, row = idx >> 4, ch = idx & 15;
            const u32x4 ov = *(const LAS u32x4*)(OT + row * 272 + ch * 16);
            const size_t go = (tok0 + row) * DM + h * 128 + ch * 8;
            const u32x4 gv = *(const u32x4*)(G1 + go);
            u32x4 w;
            w.x = pk_bf16(bflo(ov.x) * bflo(gv.x), bfhi(ov.x) * bfhi(gv.x)); w.y = pk_bf16(bflo(ov.y) * bflo(gv.y), bfhi(ov.y) * bfhi(gv.y));
            w.z = pk_bf16(bflo(ov.z) * bflo(gv.z), bfhi(ov.z) * bfhi(gv.z)); w.w = pk_bf16(bflo(ov.w) * bflo(gv.w), bfhi(ov.w) * bfhi(gv.w));
            *(u32x4*)(OG + go) = w;
        }
        __syncthreads();
    }
}


#if SCAN_DBG == 2
__device__ __forceinline__ void dbg_compare(LAS float* red, const bf16_t* A, const bf16_t* B, float* DBG) {
    float sd = 0.f, sr = 0.f, nn = 0.f;
    const size_t n = (size_t)MTOK * DM;
    for (size_t i = (size_t)blockIdx.x * 512 + threadIdx.x; i < n; i += (size_t)gridDim.x * 512) {
        const float x = bf2f(A[i]), y = bf2f(B[i]);
        if (!(x - x == 0.f)) nn += 1.f; else { sd += (x - y) * (x - y); sr += y * y; }
    }
    sd = wave_sum(sd); sr = wave_sum(sr); nn = wave_sum(nn);
    const int wv = threadIdx.x >> 6;
    if ((threadIdx.x & 63) == 0) { red[wv * 3] = sd; red[wv * 3 + 1] = sr; red[wv * 3 + 2] = nn; }
    __syncthreads();
    if (threadIdx.x == 0) { float a = 0, b = 0, c = 0; for (int w = 0; w < 8; ++w) { a += red[w * 3]; b += red[w * 3 + 1]; c += red[w * 3 + 2]; } DBG[blockIdx.x * 4] = a; DBG[blockIdx.x * 4 + 1] = b; DBG[blockIdx.x * 4 + 2] = c; }
    __syncthreads();
}
__device__ __forceinline__ void dbg_emit(const float* DBG, float* out) {
    float a = 0, b = 0, c = 0;
    for (int w = 0; w < (int)gridDim.x; ++w) { a += DBG[w * 4]; b += DBG[w * 4 + 1]; c += DBG[w * 4 + 2]; }
    const float rel = sqrtf(a / b);
    int k = (int)rintf(-2.0f * log10f(rel)); k = k < 0 ? 0 : (k > 16 ? 16 : k);
    if (c > 0.f) k = 17;
    const float cc = sqrtf(0.5f * (float)k);
    const size_t n = (size_t)MTOK * DM;
    for (size_t i = (size_t)blockIdx.x * 512 + threadIdx.x; i < n; i += (size_t)gridDim.x * 512) out[i] = cc;
}
#endif

#if SCAN_DBG == 3
__device__ __forceinline__ void dbg_count_bf16(const bf16_t* A, size_t n, unsigned* cnt) {
    unsigned c = 0;
    for (size_t i = (size_t)blockIdx.x * 512 + threadIdx.x; i < n; i += (size_t)gridDim.x * 512) { const float x = bf2f(A[i]); if (!(x - x == 0.f)) ++c; }
    if (c) atomicAdd(cnt, c);
}
__device__ __forceinline__ void dbg_count_f32(const float* A, size_t n, unsigned* cnt) {
    unsigned c = 0;
    for (size_t i = (size_t)blockIdx.x * 512 + threadIdx.x; i < n; i += (size_t)gridDim.x * 512) { const float x = A[i]; if (!(x - x == 0.f)) ++c; }
    if (c) atomicAdd(cnt, c);
}
__device__ __forceinline__ void dbg_emit3(const unsigned* cnt, float* out) {
    float code = 0.f;
    for (int st = 3; st >= 0; --st) { const unsigned c = cnt[st]; if (c) { float lg = log10f((float)c); lg = lg > 9.f ? 9.f : lg; code = (float)(st + 1) + 0.1f * lg; } }
    const float cc = sqrtf(code);
    const size_t n = (size_t)MTOK * DM;
    for (size_t i = (size_t)blockIdx.x * 512 + threadIdx.x; i < n; i += (size_t)gridDim.x * 512) out[i] = cc;
}
#endif

#if SCAN_DBG == 4 || SCAN_DBG == 6
__device__ __forceinline__ void dbg_compare4(LAS float* red, const bf16_t* A, const bf16_t* B, const bf16_t* C, float* DBG) {
    float sd = 0.f, sr = 0.f, nn = 0.f, mm = 0.f;
    const size_t n = (size_t)MTOK * DM;
    for (size_t i = (size_t)blockIdx.x * 512 + threadIdx.x; i < n; i += (size_t)gridDim.x * 512) {
        const float x = bf2f(A[i]), y = bf2f(B[i]);
        if (!(x - x == 0.f)) nn += 1.f; else { sd += (x - y) * (x - y); sr += y * y; }
        if (A[i] != C[i]) mm += 1.f;
    }
    sd = wave_sum(sd); sr = wave_sum(sr); nn = wave_sum(nn); mm = wave_sum(mm);
    const int wv = threadIdx.x >> 6;
    if ((threadIdx.x & 63) == 0) { red[wv * 4] = sd; red[wv * 4 + 1] = sr; red[wv * 4 + 2] = nn; red[wv * 4 + 3] = mm; }
    __syncthreads();
    if (threadIdx.x == 0) { float a = 0, b = 0, c = 0, d = 0; for (int w = 0; w < 8; ++w) { a += red[w * 4]; b += red[w * 4 + 1]; c += red[w * 4 + 2]; d += red[w * 4 + 3]; }
        DBG[blockIdx.x * 4] = a; DBG[blockIdx.x * 4 + 1] = b; DBG[blockIdx.x * 4 + 2] = c; DBG[blockIdx.x * 4 + 3] = d; }
    __syncthreads();
}
__device__ __forceinline__ void dbg_emit4(const float* DBG, float* out) {
    float a = 0, b = 0, c = 0, d = 0;
    for (int w = 0; w < (int)gridDim.x; ++w) { a += DBG[w * 4]; b += DBG[w * 4 + 1]; c += DBG[w * 4 + 2]; d += DBG[w * 4 + 3]; }
    const float rel = sqrtf(a / b);
    int k = (int)rintf(-log10f(rel)); k = k < 0 ? 0 : (k > 8 ? 8 : k);
#if SCAN_DBG == 6
    const float cc = sqrtf((float)k + ((d + c) > 0.f ? 0.5f : 0.f));
#else
    int m = (int)ceilf(log10f(1.0f + d + c)); m = m > 9 ? 9 : m;
    const float cc = sqrtf((float)k + 0.1f * (float)m);
#endif
    const size_t n = (size_t)MTOK * DM;
    for (size_t i = (size_t)blockIdx.x * 512 + threadIdx.x; i < n; i += (size_t)gridDim.x * 512) out[i] = cc;
}
#endif

#if SCAN_DBG == 5
__device__ __forceinline__ void dbg_lds16_test(LAS unsigned char* lds, unsigned* cnt) {
    const int tid = threadIdx.x;
    unsigned bad = 0;
    for (int rep = 0; rep < 64; ++rep) {
        for (int i = tid; i < 1024; i += 512) *(LAS u32x4*)(lds + i * 16) = (u32x4){0x7fc07fc0u, 0x7fc07fc0u, 0x7fc07fc0u, 0x7fc07fc0u};
        __syncthreads();
        const int k = tid & 127, part = tid >> 7;
#pragma unroll
        for (int i = 0; i < 16; ++i) {
            const int row = 16 * part + i;
            *(LAS bf16_t*)(lds + off_b(row, k >> 3) + 2 * (k & 7)) = (bf16_t)((row * 128 + k + rep) & 0x7fff);
        }
        __syncthreads();
        for (int idx = tid; idx < 64 * 128; idx += 512) {
            const int row = idx >> 7, kk = idx & 127;
            const bf16_t got = *(const LAS bf16_t*)(lds + off_b(row, kk >> 3) + 2 * (kk & 7));
            if (got != (bf16_t)((row * 128 + kk + rep) & 0x7fff)) ++bad;
        }
        __syncthreads();
    }
    if (bad) atomicAdd(cnt, bad);
}
__device__ __forceinline__ void dbg_emit5(const unsigned* cnt, float* out) {
    const unsigned c = cnt[0];
    float code = 0.f;
    if (c) { float lg = log10f((float)c); code = 1.0f + (lg > 8.9f ? 8.9f : lg); }
    const float cc = sqrtf(code);
    const size_t n = (size_t)MTOK * DM;
    for (size_t i = (size_t)blockIdx.x * 512 + threadIdx.x; i < n; i += (size_t)gridDim.x * 512) out[i] = cc;
}
#endif

#if SCAN_DBG == 6
__device__ __forceinline__ void dbg_check_a(LAS float* red, const float* LF, const bf16_t* I1, const bf16_t* LT, const bf16_t* LT2, float* DBG) {
    float sd = 0.f, sr = 0.f, mm = 0.f;
    const size_t n = (size_t)4096 * 16384;
    for (size_t i = (size_t)blockIdx.x * 512 + threadIdx.x; i < n; i += (size_t)gridDim.x * 512) {
        const int item = (int)(i >> 14), v = (int)((i >> 7) & 127), k = (int)(i & 127);
        const int bh = item >> 7, c = item & 127, b = bh >> 4, h = bh & 15;
        const size_t tok0 = (size_t)b * SEQ + c * 64;
        float g = 1.f, L = 0.f;
        for (int s2 = 63; s2 >= 0; --s2) {
            const size_t o = (tok0 + s2) * DM + h * 128;
            const float f = __expf(LF[o + k]);
            L += bf2f(I1[o + v]) * (1.0f - f) * g;
            g *= f;
        }
        const float x = bf2f(LT[i]);
        sd += (x - L) * (x - L); sr += L * L;
        if (LT[i] != LT2[i]) mm += 1.f;
    }
    sd = wave_sum(sd); sr = wave_sum(sr); mm = wave_sum(mm);
    const int wv = threadIdx.x >> 6;
    if ((threadIdx.x & 63) == 0) { red[wv * 4] = sd; red[wv * 4 + 1] = sr; red[wv * 4 + 2] = 0.f; red[wv * 4 + 3] = mm; }
    __syncthreads();
    if (threadIdx.x == 0) { float a = 0, b2 = 0, d = 0; for (int w = 0; w < 8; ++w) { a += red[w * 4]; b2 += red[w * 4 + 1]; d += red[w * 4 + 3]; }
        DBG[blockIdx.x * 4] = a; DBG[blockIdx.x * 4 + 1] = b2; DBG[blockIdx.x * 4 + 2] = 0.f; DBG[blockIdx.x * 4 + 3] = d; }
    __syncthreads();
}
#endif

#if SCAN_DBG == 7
#ifndef DBG_FAM
#define DBG_FAM 0
#endif
__device__ __forceinline__ void dbg_check_a7(const float* LF, const bf16_t* I1, const bf16_t* LT, float* DBG) {
    const size_t n = (size_t)4096 * 16384;
    float nbad = 0.f, nnf = 0.f;
    for (size_t i = (size_t)blockIdx.x * 512 + threadIdx.x; i < n; i += (size_t)gridDim.x * 512 * 8) {
        const int item = (int)(i >> 14), v = (int)((i >> 7) & 127), k = (int)(i & 127);
        const int bh = item >> 7, c = item & 127, b = bh >> 4, h = bh & 15;
        const size_t tok0 = (size_t)b * SEQ + c * 64;
        float g = 1.f, L = 0.f;
        for (int s2 = 63; s2 >= 0; --s2) {
            const size_t o = (tok0 + s2) * DM + h * 128;
            const float f = __expf(LF[o + k]);
            L += bf2f(I1[o + v]) * (1.0f - f) * g;
            g *= f;
        }
        const float x = bf2f(LT[i]);
        if (!(x - x == 0.f)) { nnf += 1.f; nbad += 1.f; }
        else if (fabsf(x - L) > 0.02f * fabsf(L) + 1e-2f) nbad += 1.f;
    }
    nbad = wave_sum(nbad); nnf = wave_sum(nnf);
    if ((threadIdx.x & 63) == 0) { atomicAdd(DBG, nbad); atomicAdd(DBG + 1, nnf); }
}
__device__ __forceinline__ void dbg_emit7(const float* DBG, float* out) {
    const float nb = DBG[0], nf = DBG[1];
    int A = nb == 0.f ? 0 : (nb <= 100.f ? 1 : (nb <= 1e4f ? 3 : (nb <= 1e6f ? 5 : 7)));
    int B = nf == 0.f ? 0 : 5;
    const float cc = sqrtf((float)A + 0.1f * (float)B);
    const size_t n = (size_t)MTOK * DM;
    for (size_t i = (size_t)blockIdx.x * 512 + threadIdx.x; i < n; i += (size_t)gridDim.x * 512) out[i] = cc;
}
#endif
__device__ __forceinline__ int opaque(int v) { asm volatile("" : "+s"(v)); return v; }
template <bool L1> __device__ __forceinline__ void run_gemm_out(const Args& a, LAS unsigned char* lds) {
    unsigned char* ws = a.ws;
    pg8::Gemm g{(const bf16_t*)(ws + (L1 ? slot(3) : slot(0))), (const bf16_t*)(ws + (L1 ? WS_WO : WS_WOUT)), opaque(MTOK), opaque(DM), opaque(DM)};
    pg8::StaticOrder S; S.init(g.M, g.N, (int)gridDim.x, (int)blockIdx.x);
    EpiRes E{L1 ? (const float*)(ws + slot(0)) : a.in[0], (float*)(ws + (L1 ? slot(4) : slot(1)))};
    pg8::gemm_phase<EpiRes, pg8::StaticOrder>(lds, g, S, E, nullptr);
}
template <bool L1> __device__ __forceinline__ void run_ln(const Args& a) {
    unsigned char* ws = a.ws;
    phase_ln((const float*)(ws + (L1 ? slot(4) : slot(1))), a.in[12] + (L1 ? 2 : 0) * DM, a.in[13] + (L1 ? 2 : 0) * DM,
             (float*)(ws + (L1 ? slot(6) : slot(3))), (bf16_t*)(ws + (L1 ? slot(8) : slot(5))), (signed char*)(ws + WS_XQ), (float*)(ws + WS_XS));
}
template <bool L1> __device__ __forceinline__ void run_gemm_sc(const Args& a, LAS unsigned char* lds) {
    unsigned char* ws = a.ws;
    pg8::Gemm g{(const bf16_t*)(ws + WS_WC) + (L1 ? (size_t)DM * DM : 0), (const bf16_t*)(ws + (L1 ? slot(8) : slot(5))), opaque(DM), opaque(MTOK), opaque(DM)};
    pg8::StaticOrder S; S.init(g.M, g.N, (int)gridDim.x, (int)blockIdx.x);
    EpiF32 E{(float*)(ws + (L1 ? slot(0) : slot(6))), MTOK};
    pg8::gemm_phase<EpiF32, pg8::StaticOrder>(lds, g, S, E, nullptr);
}
template <bool L1> __device__ __forceinline__ void run_topk(const Args& a, LAS unsigned char* lds) {
    unsigned char* ws = a.ws;
    phase_topk(lds, (const float*)(ws + (L1 ? slot(0) : slot(6))), (int*)(ws + WS_EID), (float*)(ws + WS_GATE));
}
template <bool L1> __device__ __forceinline__ void run_peer_u(const Args& a) {
    unsigned char* ws = a.ws;
    phase_peer_u((const signed char*)(ws + WS_XQ), (const int*)(ws + WS_EID), ws + WS_UB + (L1 ? (size_t)16384 * DM : 0), (int*)(ws + (L1 ? slot(2) : slot(0))));
}
template <bool L1> __device__ __forceinline__ void run_peer_w(const Args& a) {
    unsigned char* ws = a.ws;
    phase_peer_w((const int*)(ws + (L1 ? slot(2) : slot(0))), (const float*)(ws + WS_XS), (const int*)(ws + WS_EID), (const float*)(ws + WS_GATE),
                 (const float*)(ws + WS_USC) + (L1 ? 16384 : 0), (const float*)(ws + WS_VSC) + (L1 ? 16384 : 0), (float*)(ws + WS_W), (float*)(ws + WS_CS));
}
template <bool L1> __device__ __forceinline__ void run_peer_v(const Args& a) {
    unsigned char* ws = a.ws;
    phase_peer_v((const float*)(ws + (L1 ? slot(6) : slot(3))), (const int*)(ws + WS_EID), (const float*)(ws + WS_W), (const float*)(ws + WS_CS),
                 ws + WS_VB + (L1 ? (size_t)16384 * DM : 0), (float*)(ws + (L1 ? slot(0) : slot(6))));
}
template <bool L1> __device__ __forceinline__ void run_peer_ln(const Args& a) {
    unsigned char* ws = a.ws;
    phase_ln((const float*)(ws + (L1 ? slot(0) : slot(6))), a.in[12] + (L1 ? 3 : 1) * DM, a.in[13] + (L1 ? 3 : 1) * DM,
             L1 ? a.out : (float*)(ws + slot(0)), L1 ? (bf16_t*)nullptr : (bf16_t*)(ws + slot(2)));
}

__global__ void __launch_bounds__(512, 2) mk_fwd(Args a) {
    extern __shared__ __attribute__((aligned(16))) unsigned char lds_raw[];
    LAS unsigned char* lds = (LAS unsigned char*)lds_raw;
    cg::grid_group grid = cg::this_grid();
    unsigned char* ws = a.ws;
#define PHASE_BEGIN(k) if (a.ph_lo <= (k) && (k) < a.ph_hi && EN(k)) {
#define PHASE_END(k) asm volatile("s_waitcnt vmcnt(0)" ::: "memory"); __syncthreads(); if ((k) + 1 < a.ph_hi) { grid.sync(); if (threadIdx.x < 64) { __builtin_amdgcn_fence(__ATOMIC_ACQUIRE, "agent"); asm volatile("s_waitcnt vmcnt(0)" ::: "memory"); } __syncthreads(); } }
    PHASE_BEGIN(0) phase_prep(a, lds);
#if SCAN_DBG == 3 || SCAN_DBG == 5
        if (blockIdx.x == 0 && threadIdx.x < 8) ((unsigned*)(ws + WS_CTR + 8192))[threadIdx.x] = 0u;
#endif
#if SCAN_DBG == 7
        if (blockIdx.x == 0 && threadIdx.x < 32) ((float*)(ws + WS_CTR + 4096))[threadIdx.x] = 0.f;
#endif
    PHASE_END(0)
#if SCAN_DBG == 5
    PHASE_BEGIN(1) dbg_lds16_test(lds, (unsigned*)(ws + WS_CTR + 8192)); PHASE_END(1)
#define SKIP_REST 1
#endif
    PHASE_BEGIN(1) {
        pg8::Gemm g{(const bf16_t*)(ws + slot(0)), (const bf16_t*)(ws + WS_WIN), opaque(MTOK), opaque(4 * DM), opaque(DM)};
        pg8::StaticOrder S; S.init(g.M, g.N, (int)gridDim.x, (int)blockIdx.x);
        EpiIn E{(bf16_t*)(ws + slot(1)), (float*)(ws + slot(4)), (bf16_t*)(ws + slot(2)), (bf16_t*)(ws + slot(3)), (const float*)(ws + WS_LB)};
        pg8::gemm_phase<EpiIn, pg8::StaticOrder>(lds, g, S, E, nullptr);
    } PHASE_END(1)
    PHASE_BEGIN(2) phase_scan_a(lds, (const float*)(ws + slot(4)), (const bf16_t*)(ws + slot(2)), (bf16_t*)(ws + slot(6)), (float*)(ws + WS_DEC)
#if SCAN_DBG == 3
        , (unsigned*)(ws + WS_CTR + 8192)
#endif
        );
#if SCAN_DBG == 7
        asm volatile("s_waitcnt vmcnt(0)" ::: "memory"); __syncthreads(); grid.sync(); if (threadIdx.x < 64) { __builtin_amdgcn_fence(__ATOMIC_ACQUIRE, "agent"); asm volatile("s_waitcnt vmcnt(0)" ::: "memory"); } __syncthreads();
        dbg_check_a7((const float*)(ws + slot(4)), (const bf16_t*)(ws + slot(2)), (const bf16_t*)(ws + slot(6)), (float*)(ws + WS_CTR + 4096));
#endif
#if SCAN_DBG == 6
#define DSYNC6() asm volatile("s_waitcnt vmcnt(0)" ::: "memory"); __syncthreads(); grid.sync(); if (threadIdx.x < 64) { __builtin_amdgcn_fence(__ATOMIC_ACQUIRE, "agent"); asm volatile("s_waitcnt vmcnt(0)" ::: "memory"); } __syncthreads();
        DSYNC6()
        phase_scan_a(lds, (const float*)(ws + slot(4)), (const bf16_t*)(ws + slot(2)), (bf16_t*)a.out, (float*)(ws + WS_DEC));
        DSYNC6()
        dbg_check_a((LAS float*)lds, (const float*)(ws + slot(4)), (const bf16_t*)(ws + slot(2)), (const bf16_t*)(ws + slot(6)), (const bf16_t*)a.out, (float*)(ws + WS_CTR + 4096));
#endif
#if SCAN_DBG == 3
        asm volatile("s_waitcnt vmcnt(0)" ::: "memory"); __syncthreads(); grid.sync();
        dbg_count_bf16((const bf16_t*)(ws + slot(6)), (size_t)4096 * 16384, (unsigned*)(ws + WS_CTR + 8192) + 2);
#endif
    PHASE_END(2)
    PHASE_BEGIN(3) phase_scan_b((bf16_t*)(ws + slot(6)), (const float*)(ws + WS_DEC));
#if SCAN_DBG == 3
        asm volatile("s_waitcnt vmcnt(0)" ::: "memory"); __syncthreads(); grid.sync();

#endif
    PHASE_END(3)
    PHASE_BEGIN(4) phase_scan_c(lds, (const bf16_t*)(ws + slot(1)), (const float*)(ws + slot(4)), (const bf16_t*)(ws + slot(2)), (const bf16_t*)(ws + slot(3)), (const bf16_t*)(ws + slot(6)), a.in[2], (bf16_t*)(ws + slot(0)));
#if SCAN_DBG == 1
        asm volatile("s_waitcnt vmcnt(0)" ::: "memory"); __syncthreads(); grid.sync();
        phase_scan_naive((const bf16_t*)(ws + slot(1)), (const float*)(ws + slot(4)), (const bf16_t*)(ws + slot(2)), (float*)(ws + slot(6)));
        asm volatile("s_waitcnt vmcnt(0)" ::: "memory"); __syncthreads(); grid.sync();
        phase_onorm((const float*)(ws + slot(6)), (const bf16_t*)(ws + slot(3)), a.in[2], (bf16_t*)(ws + slot(0)));
#endif
#if SCAN_DBG == 3
        asm volatile("s_waitcnt vmcnt(0)" ::: "memory"); __syncthreads(); grid.sync();

#endif
#if SCAN_DBG == 4
#define DSYNC() asm volatile("s_waitcnt vmcnt(0)" ::: "memory"); __syncthreads(); grid.sync(); if (threadIdx.x < 64) { __builtin_amdgcn_fence(__ATOMIC_ACQUIRE, "agent"); asm volatile("s_waitcnt vmcnt(0)" ::: "memory"); } __syncthreads();
        DSYNC()
        phase_scan_naive((const bf16_t*)(ws + slot(1)), (const float*)(ws + slot(4)), (const bf16_t*)(ws + slot(2)), (float*)(ws + slot(6)));
        DSYNC()
        phase_onorm((const float*)(ws + slot(6)), (const bf16_t*)(ws + slot(3)), a.in[2], (bf16_t*)(ws + slot(8)));
        DSYNC()
        phase_scan_a(lds, (const float*)(ws + slot(4)), (const bf16_t*)(ws + slot(2)), (bf16_t*)(ws + slot(6)), (float*)(ws + WS_DEC));
        DSYNC()
        phase_scan_b((bf16_t*)(ws + slot(6)), (const float*)(ws + WS_DEC));
        DSYNC()
        phase_scan_c(lds, (const bf16_t*)(ws + slot(1)), (const float*)(ws + slot(4)), (const bf16_t*)(ws + slot(2)), (const bf16_t*)(ws + slot(3)), (const bf16_t*)(ws + slot(6)), a.in[2], (bf16_t*)a.out);
        DSYNC()
        dbg_compare4((LAS float*)lds, (const bf16_t*)(ws + slot(0)), (const bf16_t*)(ws + slot(8)), (const bf16_t*)a.out, (float*)(ws + WS_CTR + 4096));
#endif
#if SCAN_DBG == 2
        asm volatile("s_waitcnt vmcnt(0)" ::: "memory"); __syncthreads(); grid.sync();
        phase_scan_naive((const bf16_t*)(ws + slot(1)), (const float*)(ws + slot(4)), (const bf16_t*)(ws + slot(2)), (float*)(ws + slot(6)));
        asm volatile("s_waitcnt vmcnt(0)" ::: "memory"); __syncthreads(); grid.sync();
        phase_onorm((const float*)(ws + slot(6)), (const bf16_t*)(ws + slot(3)), a.in[2], (bf16_t*)(ws + slot(8)));
        asm volatile("s_waitcnt vmcnt(0)" ::: "memory"); __syncthreads(); grid.sync();
        dbg_compare((LAS float*)lds, (const bf16_t*)(ws + slot(0)), (const bf16_t*)(ws + slot(8)), (float*)(ws + WS_CTR + 4096));
#endif
    PHASE_END(4)
    PHASE_BEGIN(5) run_gemm_out<false>(a, lds); PHASE_END(5)
    PHASE_BEGIN(6) run_ln<false>(a); PHASE_END(6)
    PHASE_BEGIN(7) run_gemm_sc<false>(a, lds); PHASE_END(7)
    PHASE_BEGIN(8) run_topk<false>(a, lds); PHASE_END(8)
    PHASE_BEGIN(9) run_peer_u<false>(a); PHASE_END(9)
    PHASE_BEGIN(10) run_peer_w<false>(a); PHASE_END(10)
    PHASE_BEGIN(11) run_peer_v<false>(a); PHASE_END(11)
    PHASE_BEGIN(12) run_peer_ln<false>(a); PHASE_END(12)
    PHASE_BEGIN(13) {
        pg8::Gemm g{(const bf16_t*)(ws + slot(2)), (const bf16_t*)(ws + WS_WKVQ), opaque(MTOK), opaque(3 * DM), opaque(DM)};
        pg8::StaticOrder S; S.init(g.M, g.N, (int)gridDim.x, (int)blockIdx.x);
        EpiKVQ E{(bf16_t*)(ws + slot(3)), (bf16_t*)(ws + slot(4)), (bf16_t*)(ws + slot(5))};
        pg8::gemm_phase<EpiKVQ, pg8::StaticOrder>(lds, g, S, E, nullptr);
    } PHASE_END(13)
    PHASE_BEGIN(14) phase_rot((LAS float*)lds, (bf16_t*)(ws + slot(3)), (bf16_t*)(ws + slot(5)), (const float*)(ws + WS_COS), (const float*)(ws + WS_SIN), (float*)(ws + WS_KMEAN), (float*)(ws + WS_KNMAX)); PHASE_END(14)
    PHASE_BEGIN(15) phase_sel(lds, (const bf16_t*)(ws + slot(5)), (const float*)(ws + WS_KMEAN), (unsigned short*)(ws + WS_SUB), (int*)(ws + WS_CNT), (int*)(ws + WS_CTR)); PHASE_END(15)
    PHASE_BEGIN(16) phase_att(lds, (const bf16_t*)(ws + slot(5)), (const bf16_t*)(ws + slot(3)), (const bf16_t*)(ws + slot(4)), (const float*)(ws + WS_KNMAX), (const unsigned short*)(ws + WS_SUB),
                              (const int*)(ws + WS_CNT), (int*)(ws + WS_CTR), (bf16_t*)(ws + slot(6)), (bf16_t*)(ws + slot(2)), (float*)(ws + WS_LS)); PHASE_END(16)
    PHASE_BEGIN(17) phase_comb((const bf16_t*)(ws + slot(6)), (const bf16_t*)(ws + slot(2)), (const float*)(ws + WS_LS), (bf16_t*)(ws + slot(3))); PHASE_END(17)
    PHASE_BEGIN(18) run_gemm_out<true>(a, lds); PHASE_END(18)
    PHASE_BEGIN(19) run_ln<true>(a); PHASE_END(19)
    PHASE_BEGIN(20) run_gemm_sc<true>(a, lds); PHASE_END(20)
    PHASE_BEGIN(21) run_topk<true>(a, lds); PHASE_END(21)
#if SCAN_DBG == 7
    PHASE_BEGIN(22) dbg_emit7((const float*)(ws + WS_CTR + 4096), a.out); PHASE_END(22)
#elif SCAN_DBG == 6
    PHASE_BEGIN(22) dbg_emit4((const float*)(ws + WS_CTR + 4096), a.out); PHASE_END(22)
#elif SCAN_DBG == 5
    PHASE_BEGIN(22) dbg_emit5((const unsigned*)(ws + WS_CTR + 8192), a.out); PHASE_END(22)
#elif SCAN_DBG == 4
    PHASE_BEGIN(22) dbg_emit4((const float*)(ws + WS_CTR + 4096), a.out); PHASE_END(22)
#elif SCAN_DBG == 3
    PHASE_BEGIN(22) dbg_emit3((const unsigned*)(ws + WS_CTR + 8192), a.out); PHASE_END(22)
#elif SCAN_DBG == 2
    PHASE_BEGIN(22) dbg_emit((const float*)(ws + WS_CTR + 4096), a.out); PHASE_END(22)
#else
    PHASE_BEGIN(22) run_peer_u<true>(a); PHASE_END(22)
    PHASE_BEGIN(23) run_peer_w<true>(a); PHASE_END(23)
    PHASE_BEGIN(24) run_peer_v<true>(a); PHASE_END(24)
    PHASE_BEGIN(25) run_peer_ln<true>(a); PHASE_END(25)
#endif
}

extern "C" void kernel_launch(void* const* d_in, const int* in_sizes, int n_in, void* d_out, int out_size, void* d_ws, size_t ws_size, hipStream_t stream) {
    static int grid = 0;
    if (grid == 0) {
        if (n_in != 14 || out_size != MTOK * DM || ws_size < WS_END) { fprintf(stderr, "kernel_launch: unexpected shapes (n_in %d, out %d, ws %zu)\n", n_in, out_size, ws_size); grid = -1; return; }
        int dev = 0, cus = 0, per_cu = 0;
        if (hipGetDevice(&dev) != hipSuccess || hipDeviceGetAttribute(&cus, hipDeviceAttributeMultiprocessorCount, dev) != hipSuccess) { grid = -1; return; }
        if (hipFuncSetAttribute((const void*)mk_fwd, hipFuncAttributeMaxDynamicSharedMemorySize, LDS_BYTES) != hipSuccess) { fprintf(stderr, "kernel_launch: hipFuncSetAttribute failed\n"); grid = -1; return; }
        if (hipOccupancyMaxActiveBlocksPerMultiprocessor(&per_cu, (const void*)mk_fwd, 512, LDS_BYTES) != hipSuccess || per_cu < 1) { fprintf(stderr, "kernel_launch: occupancy query failed (%d)\n", per_cu); (void)hipGetLastError(); per_cu = 1; }
        grid = cus * (per_cu > 1 ? 1 : per_cu);
    }
    if (grid < 0) return;
    Args a{};
    for (int i = 0; i < 14; ++i) a.in[i] = (const float*)d_in[i];
    a.out = (float*)d_out; a.ws = (unsigned char*)d_ws;
#if ONE_LAUNCH
    a.ph_lo = 0; a.ph_hi = NPH;
    void* args[] = {&a};
    hipError_t e = hipLaunchCooperativeKernel((const void*)mk_fwd, dim3(grid), dim3(512), args, LDS_BYTES, stream);
    if (e != hipSuccess) fprintf(stderr, "cooperative launch failed: %s (grid %d)\n", hipGetErrorString(e), grid);
#else
    for (int ph = 0; ph < NPH; ++ph) {
        a.ph_lo = ph; a.ph_hi = ph + 1;
        hipLaunchKernelGGL(mk_fwd, dim3(grid), dim3(512), LDS_BYTES, stream, a);
    }
#endif
}
```

```cpp
#define ONE_LAUNCH 1
#include <hip/hip_runtime.h>
#include <hip/hip_cooperative_groups.h>
#include <cstdio>
namespace cg = cooperative_groups;

#ifndef ONE_LAUNCH
#define ONE_LAUNCH 0
#endif
#ifndef SCAN_DBG
#define SCAN_DBG 0
#endif
#ifndef SCAN_A_VALU
#define SCAN_A_VALU 0
#endif
#ifndef ENMASK
#define ENMASK 0xffffffffu
#endif
#define EN(k) ((ENMASK >> (k)) & 1u)

namespace pg8 {
#define PG8_LAS __attribute__((address_space(3)))
typedef unsigned short bf16_t;
typedef short bf16x8 __attribute__((ext_vector_type(8)));
typedef float f32x4 __attribute__((ext_vector_type(4)));
typedef unsigned u32x4 __attribute__((ext_vector_type(4)));
constexpr int BM = 256, BK = 64, HALF = 128, HTB = HALF * BK * 2  , STAGE_BYTES = 8 * HTB, NXCD = 8, WGM = 8;

__host__ __device__ __forceinline__ int lds_byte(int r, int c) { const int st = (r >> 4) * 2 + (c >> 5), rr = r & 15, cc = c & 31, ob = rr * 64 + cc * 2; return st * 1024 + (ob ^ (((ob >> 9) & 1) << 5)); }
__host__ __device__ __forceinline__ void stage_rc(int b, int& R, int& C) { const int st = b / 1024, sb = b % 1024, swz = sb ^ (((sb >> 9) & 1) << 5); R = (st >> 1) * 16 + swz / 64; C = (st & 1) * 32 + (swz % 64) / 2; }
__host__ __device__ __forceinline__ int perm32(int rho) { const int n = rho >> 4, i = rho & 15; return 8 * (i >> 2) + 4 * n + (i & 3); }

struct Unit { int pm, pn; };
struct Gemm { const bf16_t* A; const bf16_t* Bt; int M, N, K; };

struct StaticOrder {
    int nM, nN, nwg, G, c;
    __host__ __device__ void init(int M, int N, int G_, int c_) { nM = M / BM; nN = N / BM; nwg = nM * nN; G = G_; c = c_; }
    __host__ __device__ bool next(int i, Unit& u) const {
        const long L = (long)i * G + c; if (L >= nwg) return false;
        int wgid = (int)L; { const int q = nwg / NXCD, r = nwg % NXCD, xcd = wgid % NXCD, off = wgid / NXCD; wgid = (xcd < r ? xcd * (q + 1) : r * (q + 1) + (xcd - r) * q) + off; }
        const int nig = WGM * nN, gid = wgid / nig, fm = gid * WGM, gsz = (nM - fm) < WGM ? (nM - fm) : WGM;
        u.pm = fm + ((wgid % nig) % gsz); u.pn = (wgid % nig) / gsz; return true;
    }
    __device__ __forceinline__ void a_ready(const Unit&) const {}
    __device__ __forceinline__ void done(const Unit&) const {}
};
struct CountedOrder : StaticOrder {
    const unsigned* ready; unsigned need; unsigned* tmo;
    __device__ __forceinline__ void a_ready(const Unit& u) const {
        if (threadIdx.x < 64) {
            const unsigned long long t0 = __builtin_amdgcn_s_memrealtime(); unsigned polls = 0;
            while ((unsigned)__builtin_amdgcn_readfirstlane(__hip_atomic_load(ready + 64 * u.pm, __ATOMIC_RELAXED, __HIP_MEMORY_SCOPE_AGENT)) < need) {
                if ((++polls & 255u) == 0u && __builtin_amdgcn_readfirstlane(__hip_atomic_load(tmo, __ATOMIC_RELAXED, __HIP_MEMORY_SCOPE_AGENT)) != 0u) break;
                if (__builtin_amdgcn_s_memrealtime() - t0 > 2000000ull) {
                    if (threadIdx.x == 0) { unsigned expect = 0u; __hip_atomic_compare_exchange_strong(tmo + 1, &expect, 0x600u | (unsigned)(u.pm & 0xff), __ATOMIC_RELAXED, __ATOMIC_RELAXED, __HIP_MEMORY_SCOPE_AGENT); __hip_atomic_store(tmo, 1u, __ATOMIC_RELAXED, __HIP_MEMORY_SCOPE_AGENT); }
                    break; }
                __builtin_amdgcn_s_sleep(2); }
            __builtin_amdgcn_fence(__ATOMIC_ACQUIRE, "agent");
            asm volatile("s_waitcnt vmcnt(0)" ::: "memory");
        }
#if !defined(BROKEN_HOOK_NO_BARRIER)
        asm volatile("" ::: "memory"); __builtin_amdgcn_s_barrier(); asm volatile("" ::: "memory");
#endif
    }
};

__device__ __forceinline__ unsigned cvt_pk_bf16(float lo, float hi) { unsigned r; asm volatile("v_cvt_pk_bf16_f32 %0, %1, %2" : "=v"(r) : "v"(lo), "v"(hi)); return r; }
typedef float f32x2 __attribute__((ext_vector_type(2)));
__device__ __forceinline__ f32x2 gelu_pk(f32x2 v) {
    const f32x2 av = __builtin_elementwise_abs(v), d = av * 0.2316418882f + 1.0f;
    f32x2 t; t.x = __builtin_amdgcn_rcpf(d.x); t.y = __builtin_amdgcn_rcpf(d.y);
    f32x2 q = t * 0.5307027145f + (-0.7265760135f); q = q * t + 0.7107068705f; q = q * t + (-0.142248368f); q = q * t + 0.127414796f; q = q * t;
    const f32x2 s = (v * v) * (-0.72134752044f);
    f32x2 e; e.x = __builtin_amdgcn_exp2f(s.x); e.y = __builtin_amdgcn_exp2f(s.y);
    const f32x2 m = v * (q * e), r = v - m;
    f32x2 o; o.x = v.x < 0.f ? m.x : r.x; o.y = v.y < 0.f ? m.y : r.y; return o;
}

struct EpiF32 {
    static constexpr bool PERM = false, AFTER_DRAIN = false;
    float* C; int ldc; const float* bias;
    __device__ __forceinline__ void operator()(const f32x4 (&acc)[2][2][4][2], const Unit& u, int wr, int wc, int fr, int fq) const {
        const int row0 = u.pm * BM + wr * 64 + fr, col0 = u.pn * BM + wc * 32 + 4 * fq;
        f32x4 bv[2][2];
#pragma unroll
        for (int bj = 0; bj < 2; ++bj)
#pragma unroll
            for (int n = 0; n < 2; ++n) bv[bj][n] = bias ? *(const f32x4*)(bias + col0 + bj * HALF + n * 16) : (f32x4){0.f, 0.f, 0.f, 0.f};
#pragma unroll
        for (int ai = 0; ai < 2; ++ai)
#pragma unroll
            for (int m = 0; m < 4; ++m) { float* rowp = C + (size_t)(row0 + ai * HALF + m * 16) * ldc + col0;
#pragma unroll
                for (int bj = 0; bj < 2; ++bj)
#pragma unroll
                    for (int n = 0; n < 2; ++n) *(f32x4*)(rowp + bj * HALF + n * 16) = acc[ai][bj][m][n] + bv[bj][n]; }
    }
};
template <int ACT  > struct EpiBf16 {
    static constexpr bool PERM = true, AFTER_DRAIN = false;
    bf16_t* O; int ldc; const float* bias; int split_cols; size_t split_stride;
    __device__ __forceinline__ void operator()(const f32x4 (&acc)[2][2][4][2], const Unit& u, int wr, int wc, int fr, int fq) const {
        const int row0 = u.pm * BM + wr * 64 + fr; int colt = u.pn * BM; bf16_t* base = O;
        if (split_cols) { const int t = colt / split_cols; base += (size_t)t * split_stride; colt -= t * split_cols; }
        const int col0 = colt + wc * 32 + 8 * fq, bcol0 = u.pn * BM + wc * 32 + 8 * fq;
        f32x4 bv[2][2];
#pragma unroll
        for (int bj = 0; bj < 2; ++bj)
#pragma unroll
            for (int n = 0; n < 2; ++n) bv[bj][n] = bias ? *(const f32x4*)(bias + bcol0 + bj * HALF + 4 * n) : (f32x4){0.f, 0.f, 0.f, 0.f};
#pragma unroll
        for (int ai = 0; ai < 2; ++ai)
#pragma unroll
            for (int m = 0; m < 4; ++m) { bf16_t* rowp = base + (size_t)(row0 + ai * HALF + m * 16) * ldc + col0;
#pragma unroll
                for (int bj = 0; bj < 2; ++bj) { f32x4 v0 = acc[ai][bj][m][0] + bv[bj][0], v1 = acc[ai][bj][m][1] + bv[bj][1];
                    if (ACT == 1) { f32x2 a = gelu_pk((f32x2){v0[0], v0[1]}), b = gelu_pk((f32x2){v0[2], v0[3]}), c = gelu_pk((f32x2){v1[0], v1[1]}), d = gelu_pk((f32x2){v1[2], v1[3]});
                        v0 = (f32x4){a.x, a.y, b.x, b.y}; v1 = (f32x4){c.x, c.y, d.x, d.y}; }
                    if (ACT == 2) {
#pragma unroll
                        for (int j = 0; j < 4; ++j) { v0[j] = 0.5f * v0[j] * (1.0f + erff(v0[j] * 0.70710678f)); v1[j] = 0.5f * v1[j] * (1.0f + erff(v1[j] * 0.70710678f)); } }
                    u32x4 w; w.x = cvt_pk_bf16(v0[0], v0[1]); w.y = cvt_pk_bf16(v0[2], v0[3]); w.z = cvt_pk_bf16(v1[0], v1[1]); w.w = cvt_pk_bf16(v1[2], v1[3]);
                    *(u32x4*)(rowp + bj * HALF) = w; } }
    }
};

template <class Epi, class Sched, bool STAMP = false>
__device__ __forceinline__ void gemm_phase(PG8_LAS unsigned char* lds, const Gemm g, const Sched& S, const Epi& E, unsigned long long* stamps) {
    const int tid = threadIdx.x, wid = __builtin_amdgcn_readfirstlane(tid >> 6), lane = tid & 63, wr = wid >> 2, wc = wid & 3, fr = lane & 15, fq = lane >> 4;
    const int K = g.K, nt = K / BK;
    int ts_lo = 0, ts_hi = 0, nts = 0; const unsigned long long rt_entry = STAMP ? (unsigned long long)wall_clock64() : 0ull;
#define PG8_STAMP() do { if (STAMP && wid == 0 && nts < 64) { const unsigned long long _c = (unsigned long long)clock64(); \
        ts_lo = (lane == nts) ? (int)(unsigned)_c : ts_lo; ts_hi = (lane == nts) ? (int)(unsigned)(_c >> 32) : ts_hi; ++nts; } } while (0)
    PG8_STAMP();
    unsigned voffA[2], voffB[2];
#pragma unroll
    for (int i = 0; i < 2; ++i) { int R, C; stage_rc(tid * 16 + i * 8192, R, C); const int Rb = Epi::PERM ? ((R & ~31) + perm32(R & 31)) : R;
        voffA[i] = (unsigned)(R * K + C) * 2u; voffB[i] = (unsigned)(Rb * K + C) * 2u; }
    const size_t kstep = (size_t)(BK * 2);
    const size_t hstep = (size_t)HALF * K * 2;
    const size_t tstep = 2 * hstep;
    const unsigned ldsw = (unsigned)wid * 1024u;
    const int aoff = lds_byte(wr * 64 + fr, fq * 8), boff = lds_byte(wc * 32 + fr, fq * 8);
#define PG8_SA(b, h) (((b) * 2 + (h)) * HTB)
#define PG8_SB(b, h) ((4 + (b) * 2 + (h)) * HTB)
#define PG8_STAGE(bufoff, gbase, voff) do { _Pragma("unroll") for (int _i = 0; _i < 2; ++_i) \
        __builtin_amdgcn_global_load_lds((const unsigned*)((const char*)(gbase) + (voff)[_i]), (PG8_LAS unsigned*)(lds + (bufoff) + ldsw + _i * 8192), 16, 0, 0); } while (0)
#define PG8_LDA(dst, b, h) do { _Pragma("unroll") for (int m = 0; m < 4; ++m) _Pragma("unroll") for (int k = 0; k < 2; ++k) dst[m][k] = *(const PG8_LAS bf16x8*)(lds + PG8_SA(b, h) + aoff + m * 2048 + k * 1024); } while (0)
#define PG8_LDB(dst, b, h) do { _Pragma("unroll") for (int n = 0; n < 2; ++n) _Pragma("unroll") for (int k = 0; k < 2; ++k) dst[n][k] = *(const PG8_LAS bf16x8*)(lds + PG8_SB(b, h) + boff + n * 2048 + k * 1024); } while (0)
#define PG8_MMA(ai, bj, At, Bt) do { __builtin_amdgcn_s_setprio(1); _Pragma("unroll") for (int m = 0; m < 4; ++m) _Pragma("unroll") for (int n = 0; n < 2; ++n) _Pragma("unroll") for (int k = 0; k < 2; ++k) \
        acc[ai][bj][m][n] = __builtin_amdgcn_mfma_f32_16x16x32_bf16(Bt[n][k], At[m][k], acc[ai][bj][m][n], 0, 0, 0); __builtin_amdgcn_s_setprio(0); } while (0)
#define PG8_WAIT_V(n) asm volatile("s_waitcnt vmcnt(" #n ")" ::: "memory")
#define PG8_WAIT_L(n) asm volatile("s_waitcnt lgkmcnt(" #n ")" ::: "memory")
#define PG8_BAR __builtin_amdgcn_s_barrier()
#define PG8_SCHED __builtin_amdgcn_sched_barrier(0)
    Unit cur, nxt; int ui = 0;
    if (!S.next(0, cur)) return;
    f32x4 acc[2][2][4][2];
#pragma unroll
    for (int a = 0; a < 2; ++a)
#pragma unroll
        for (int b = 0; b < 2; ++b)
#pragma unroll
            for (int m = 0; m < 4; ++m)
#pragma unroll
                for (int n = 0; n < 2; ++n) acc[a][b][m][n] = (f32x4){0.f, 0.f, 0.f, 0.f};
    bf16x8 At[4][2], B0[2][2], B1[2][2];
    const char* cA = (const char*)g.A + (size_t)cur.pm * tstep; const char* cB = (const char*)g.Bt + (size_t)cur.pn * tstep;
    S.a_ready(cur);
    PG8_STAGE(PG8_SB(0, 0), cB, voffB); PG8_STAGE(PG8_SA(0, 0), cA, voffA); PG8_STAGE(PG8_SB(0, 1), cB + hstep, voffB); PG8_STAGE(PG8_SA(0, 1), cA + hstep, voffA);
    if (wr == 1) PG8_BAR;
    PG8_WAIT_V(4); PG8_BAR;
    PG8_STAGE(PG8_SB(1, 0), cB + kstep, voffB); PG8_STAGE(PG8_SA(1, 0), cA + kstep, voffA); PG8_STAGE(PG8_SB(1, 1), cB + hstep + kstep, voffB);
    PG8_WAIT_V(6); PG8_BAR;
    PG8_STAMP();
    for (;;) {
        const bool has_next = S.next(ui + 1, nxt);
        const char* nA = has_next ? (const char*)g.A + (size_t)nxt.pm * tstep : cA; const char* nB = has_next ? (const char*)g.Bt + (size_t)nxt.pn * tstep : cB;
        for (int t = 0; t < nt; t += 2) {
            const bool last = (t == nt - 2);
            const char* a1 = cA + (size_t)(t + 1) * kstep;
            const char* a2 = last ? nA : cA + (size_t)(t + 2) * kstep; const char* b2 = last ? nB : cB + (size_t)(t + 2) * kstep;
            const char* a3 = a2 + kstep; const char* b3 = b2 + kstep;
            if (last && has_next) S.a_ready(nxt);
            PG8_LDB(B0, 0, 0); PG8_SCHED; PG8_LDA(At, 0, 0); PG8_STAGE(PG8_SA(1, 1), a1 + hstep, voffA);
            PG8_WAIT_L(8); PG8_BAR; PG8_WAIT_L(0); PG8_MMA(0, 0, At, B0); PG8_BAR; PG8_SCHED;
            PG8_LDB(B1, 0, 1); PG8_STAGE(PG8_SB(0, 0), b2, voffB);
            PG8_BAR; PG8_WAIT_L(0); PG8_MMA(0, 1, At, B1); PG8_BAR;
            PG8_LDA(At, 0, 1); PG8_STAGE(PG8_SA(0, 0), a2, voffA);
            PG8_BAR; PG8_WAIT_L(0); PG8_MMA(1, 0, At, B0); PG8_BAR; PG8_SCHED;
            PG8_STAGE(PG8_SB(0, 1), b2 + hstep, voffB);
            PG8_WAIT_V(6); PG8_BAR; PG8_MMA(1, 1, At, B1); PG8_BAR;
            PG8_LDB(B0, 1, 0); PG8_SCHED; PG8_LDA(At, 1, 0); PG8_STAGE(PG8_SA(0, 1), a2 + hstep, voffA);
            PG8_WAIT_L(8); PG8_BAR; PG8_WAIT_L(0); PG8_MMA(0, 0, At, B0); PG8_BAR; PG8_SCHED;
            PG8_LDB(B1, 1, 1); PG8_STAGE(PG8_SB(1, 0), b3, voffB);
            PG8_BAR; PG8_WAIT_L(0); PG8_MMA(0, 1, At, B1); PG8_BAR;
            PG8_LDA(At, 1, 1); PG8_STAGE(PG8_SA(1, 0), a3, voffA);
            PG8_BAR; PG8_WAIT_L(0); PG8_MMA(1, 0, At, B0); PG8_BAR; PG8_SCHED;
            PG8_STAGE(PG8_SB(1, 1), b3 + hstep, voffB);
            PG8_WAIT_V(6); PG8_BAR; PG8_MMA(1, 1, At, B1); PG8_BAR;
        }
        PG8_STAMP();
        if constexpr (!Epi::AFTER_DRAIN) { E(acc, cur, wr, wc, fr, fq); S.done(cur); }
        PG8_STAMP();
        if (!has_next) break;
#pragma unroll
        for (int a = 0; a < 2; ++a)
#pragma unroll
            for (int b = 0; b < 2; ++b)
#pragma unroll
                for (int m = 0; m < 4; ++m)
#pragma unroll
                    for (int n = 0; n < 2; ++n) acc[a][b][m][n] = (f32x4){0.f, 0.f, 0.f, 0.f};
        cur = nxt; cA = nA; cB = nB; ++ui;
    }
    PG8_WAIT_V(0);
    if (wr == 0) PG8_BAR;
    PG8_BAR;
    if constexpr (Epi::AFTER_DRAIN) { E.fused(acc, cur, wr, wc, fr, fq, lds, wid, lane); S.done(cur); }
    PG8_STAMP();
    if (STAMP && wid == 0) { stamps[lane] = lane < nts ? (((unsigned long long)(unsigned)ts_hi << 32) | (unsigned)ts_lo) : 0ull;
        if (lane == 62) stamps[62] = rt_entry; if (lane == 63) stamps[63] = (unsigned long long)wall_clock64(); }
#undef PG8_STAMP
#undef PG8_SA
#undef PG8_SB
#undef PG8_STAGE
#undef PG8_LDA
#undef PG8_LDB
#undef PG8_MMA
#undef PG8_WAIT_V
#undef PG8_WAIT_L
#undef PG8_BAR
#undef PG8_SCHED
}
}


#define LAS __attribute__((address_space(3)))
typedef unsigned short bf16_t;
typedef float f32x4 __attribute__((ext_vector_type(4)));
typedef unsigned u32x4 __attribute__((ext_vector_type(4)));
typedef unsigned u32x2 __attribute__((ext_vector_type(2)));
typedef short bf16x8 __attribute__((ext_vector_type(8)));
typedef short s16x4 __attribute__((ext_vector_type(4)));
typedef float f32x16 __attribute__((ext_vector_type(16)));

constexpr int MTOK = 16384, DM = 2048, SEQ = 8192, NHEAD = 16;
constexpr float ALPHA = 1.41421356237309515f;
constexpr size_t MiB = (size_t)1 << 20;
constexpr size_t WS_WIN = 0, WS_WOUT = 32 * MiB, WS_WKVQ = 40 * MiB, WS_WO = 64 * MiB, WS_WC = 72 * MiB, WS_UB = 88 * MiB, WS_VB = 152 * MiB, WS_USC = 216 * MiB, WS_VSC = 217 * MiB, WS_H = 224 * MiB, WS_XQ = 232 * MiB, WS_XS = 264 * MiB, WS_W = 272 * MiB, WS_CS = 280 * MiB, WS_SLOT = 344 * MiB;
constexpr size_t WS_EID = 920 * MiB, WS_GATE = 928 * MiB, WS_COS = 936 * MiB, WS_SIN = 938 * MiB, WS_KMEAN = 940 * MiB, WS_LB = 941 * MiB, WS_LS = 942 * MiB, WS_SUB = 946 * MiB, WS_CNT = 962 * MiB, WS_CTR = 963 * MiB, WS_DEC = 964 * MiB, WS_END = 966 * MiB;
constexpr size_t WS_KNMAX = WS_KMEAN + 768 * 1024;
__host__ __device__ constexpr size_t slot(int i) { return WS_SLOT + (size_t)i * 64 * MiB; }
constexpr int LDS_BYTES = 144 * 1024;
constexpr int NPH = 20;

struct Args { const float* in[14]; float* out; unsigned char* ws; int ph_lo, ph_hi; };

__device__ __forceinline__ float bflo(unsigned w) { return __uint_as_float(w << 16); }
__device__ __forceinline__ float bfhi(unsigned w) { return __uint_as_float(w & 0xffff0000u); }
__device__ __forceinline__ float bf2f(bf16_t b) { return __uint_as_float(((unsigned)b) << 16); }
typedef __bf16 bf16x2_t __attribute__((ext_vector_type(2)));
typedef float f32x2_t __attribute__((ext_vector_type(2)));
__device__ __forceinline__ unsigned pk_bf16(float lo, float hi) { const f32x2_t f = {lo, hi}; return __builtin_bit_cast(unsigned, __builtin_convertvector(f, bf16x2_t)); }
__device__ __forceinline__ float wave_sum(float v) {
#pragma unroll
    for (int o = 32; o >= 1; o >>= 1) v += __shfl_xor(v, o);
    return v;
}
__device__ __forceinline__ float wave_max(float v) {
#pragma unroll
    for (int o = 32; o >= 1; o >>= 1) v = fmaxf(v, __shfl_xor(v, o));
    return v;
}
__device__ __forceinline__ float sigmoidf_(float z) { return 1.0f / (1.0f + __expf(-z)); }


__device__ __forceinline__ void store_wt16(void* p, u32x4 v) {
    __hip_atomic_store((unsigned long long*)p, ((unsigned long long)v.y << 32) | v.x, __ATOMIC_RELAXED, __HIP_MEMORY_SCOPE_AGENT);
    __hip_atomic_store((unsigned long long*)p + 1, ((unsigned long long)v.w << 32) | v.z, __ATOMIC_RELAXED, __HIP_MEMORY_SCOPE_AGENT);
}
__device__ __forceinline__ void store_wt8(void* p, u32x2 v) {
    __hip_atomic_store((unsigned long long*)p, ((unsigned long long)v.y << 32) | v.x, __ATOMIC_RELAXED, __HIP_MEMORY_SCOPE_AGENT);
}
struct EpiIn {
    static constexpr bool PERM = true, AFTER_DRAIN = false;
    bf16_t* Q1; float* LF; bf16_t* I1; bf16_t* G1; const float* LB;
    __device__ __forceinline__ void operator()(const pg8::f32x4 (&acc)[2][2][4][2], const pg8::Unit& u, int wr, int wc, int fr, int fq) const {
        const int type = u.pn >> 3;
        const int row0 = u.pm * 256 + wr * 64 + fr, col0 = (u.pn & 7) * 256 + wc * 32 + 8 * fq;
        if (type == 1) {
#pragma unroll
            for (int bj = 0; bj < 2; ++bj) {
                const int c = col0 + bj * 128;
                const f32x4 lb0 = *(const f32x4*)(LB + c), lb1 = *(const f32x4*)(LB + c + 4);
#pragma unroll
                for (int ai = 0; ai < 2; ++ai)
#pragma unroll
                    for (int m = 0; m < 4; ++m) {
                        float* p = LF + (size_t)(row0 + ai * 128 + m * 16) * DM + c;
                        f32x4 o0, o1;
#pragma unroll
                        for (int j = 0; j < 4; ++j) {
                            o0[j] = __logf(lb0[j] + (1.0f - lb0[j]) * sigmoidf_(acc[ai][bj][m][0][j]));
                            o1[j] = __logf(lb1[j] + (1.0f - lb1[j]) * sigmoidf_(acc[ai][bj][m][1][j]));
                        }
                        *(f32x4*)p = o0; *(f32x4*)(p + 4) = o1;
                    }
            }
        } else {
            bf16_t* dst = Q1 + (size_t)(type - (type > 0 ? 1 : 0)) * ((size_t)32 << 20);
            const bool act = (type != 2);
#pragma unroll
            for (int ai = 0; ai < 2; ++ai)
#pragma unroll
                for (int m = 0; m < 4; ++m)
#pragma unroll
                    for (int bj = 0; bj < 2; ++bj) {
                        f32x4 v0 = acc[ai][bj][m][0], v1 = acc[ai][bj][m][1];
                        if (act) {
#pragma unroll
                            for (int j = 0; j < 4; ++j) { v0[j] = v0[j] * sigmoidf_(v0[j]); v1[j] = v1[j] * sigmoidf_(v1[j]); }
                        }
                        u32x4 w; w.x = pk_bf16(v0[0], v0[1]); w.y = pk_bf16(v0[2], v0[3]); w.z = pk_bf16(v1[0], v1[1]); w.w = pk_bf16(v1[2], v1[3]);
                        *(u32x4*)(dst + (size_t)(row0 + ai * 128 + m * 16) * DM + col0 + bj * 128) = w;
                    }
        }
    }
};
struct EpiRes {
    static constexpr bool PERM = false, AFTER_DRAIN = false;
    const float* res; float* Y;
    __device__ __forceinline__ void operator()(const pg8::f32x4 (&acc)[2][2][4][2], const pg8::Unit& u, int wr, int wc, int fr, int fq) const {
        const int row0 = u.pm * 256 + wr * 64 + fr, col0 = u.pn * 256 + wc * 32 + 4 * fq;
#pragma unroll
        for (int ai = 0; ai < 2; ++ai)
#pragma unroll
            for (int m = 0; m < 4; ++m) {
                const size_t off = (size_t)(row0 + ai * 128 + m * 16) * DM + col0;
#pragma unroll
                for (int bj = 0; bj < 2; ++bj)
#pragma unroll
                    for (int n = 0; n < 2; ++n) {
                        const f32x4 r = *(const f32x4*)(res + off + bj * 128 + n * 16);
                        *(f32x4*)(Y + off + bj * 128 + n * 16) = r * ALPHA + acc[ai][bj][m][n];
                    }
            }
    }
};
struct EpiF32 {
    static constexpr bool PERM = false, AFTER_DRAIN = false;
    float* C; int ldc;
    __device__ __forceinline__ void operator()(const pg8::f32x4 (&acc)[2][2][4][2], const pg8::Unit& u, int wr, int wc, int fr, int fq) const {
        const int row0 = u.pm * 256 + wr * 64 + fr, col0 = u.pn * 256 + wc * 32 + 4 * fq;
#pragma unroll
        for (int ai = 0; ai < 2; ++ai)
#pragma unroll
            for (int m = 0; m < 4; ++m) {
                float* p = C + (size_t)(row0 + ai * 128 + m * 16) * ldc + col0;
#pragma unroll
                for (int bj = 0; bj < 2; ++bj)
#pragma unroll
                    for (int n = 0; n < 2; ++n) *(f32x4*)(p + bj * 128 + n * 16) = acc[ai][bj][m][n];
            }
    }
};
struct EpiKVQ {
    static constexpr bool PERM = true, AFTER_DRAIN = false;
    bf16_t* K; bf16_t* V; bf16_t* Q;
    __device__ __forceinline__ void operator()(const pg8::f32x4 (&acc)[2][2][4][2], const pg8::Unit& u, int wr, int wc, int fr, int fq) const {
        const int t = u.pn >> 3;
        bf16_t* dst = K + (size_t)t * ((size_t)32 << 20);
        const int row0 = u.pm * 256 + wr * 64 + fr, col0 = (u.pn & 7) * 256 + wc * 32 + 8 * fq;
#pragma unroll
        for (int ai = 0; ai < 2; ++ai)
#pragma unroll
            for (int m = 0; m < 4; ++m)
#pragma unroll
                for (int bj = 0; bj < 2; ++bj) {
                    const f32x4 v0 = acc[ai][bj][m][0], v1 = acc[ai][bj][m][1];
                    u32x4 w; w.x = pk_bf16(v0[0], v0[1]); w.y = pk_bf16(v0[2], v0[3]); w.z = pk_bf16(v1[0], v1[1]); w.w = pk_bf16(v1[2], v1[3]);
                    *(u32x4*)(dst + (size_t)(row0 + ai * 128 + m * 16) * DM + col0 + bj * 128) = w;
                }
    }
};

__device__ __forceinline__ void transpose_tiles(LAS float* tile, const float* src, int ldn, int K, int N, bf16_t* dst) {
    const int tid = threadIdx.x;
    const int tn = N / 64, ntiles = tn * (K / 64);
    for (int tI = blockIdx.x; tI < ntiles; tI += gridDim.x) {
        const int k0 = (tI / tn) * 64, n0 = (tI % tn) * 64;
#pragma unroll
        for (int r = 0; r < 2; ++r) {
            const int kk = (tid >> 4) + 32 * r, nn = (tid & 15) * 4;
            const f32x4 v = *(const f32x4*)(src + (size_t)(k0 + kk) * ldn + n0 + nn);
            tile[kk * 65 + nn + 0] = v[0]; tile[kk * 65 + nn + 1] = v[1]; tile[kk * 65 + nn + 2] = v[2]; tile[kk * 65 + nn + 3] = v[3];
        }
        __syncthreads();
        {
            const int nn = tid >> 3, kk8 = (tid & 7) * 8;
            float f[8];
#pragma unroll
            for (int j = 0; j < 8; ++j) f[j] = tile[(kk8 + j) * 65 + nn];
            u32x4 w; w.x = pk_bf16(f[0], f[1]); w.y = pk_bf16(f[2], f[3]); w.z = pk_bf16(f[4], f[5]); w.w = pk_bf16(f[6], f[7]);
            *(u32x4*)(dst + (size_t)(n0 + nn) * K + k0 + kk8) = w;
        }
        __syncthreads();
    }
}
__device__ __forceinline__ void convert_bf16(const float* src, bf16_t* dst, size_t n) {
    const size_t stride = (size_t)gridDim.x * 512 * 8;
    for (size_t i = ((size_t)blockIdx.x * 512 + threadIdx.x) * 8; i < n; i += stride) {
        const f32x4 a = *(const f32x4*)(src + i), b = *(const f32x4*)(src + i + 4);
        u32x4 w; w.x = pk_bf16(a[0], a[1]); w.y = pk_bf16(a[2], a[3]); w.z = pk_bf16(b[0], b[1]); w.w = pk_bf16(b[2], b[3]);
        *(u32x4*)(dst + i) = w;
    }
}
__device__ __forceinline__ void fold_peer_keys(LAS float* lds, const float* w_query, const float* sub_keys, bf16_t* WcT) {
    const int tid = threadIdx.x;
    LAS float* Ss = lds;
    LAS float* Ws = lds + 128 * 132;
    for (int item = blockIdx.x; item < 1024; item += gridDim.x) {
        const int l = item >> 9, rem = item & 511, hh = rem >> 5, kb = rem & 31, h = hh >> 1, half = hh & 1;
        const float* sk = sub_keys + (size_t)(((l * 2 + half) * 8 + h) * 128) * 128;
        const float* wq = w_query + (size_t)l * DM * DM + (size_t)(kb * 64) * DM + h * 256 + half * 128;
#pragma unroll
        for (int r = 0; r < 8; ++r) { const int idx = tid + 512 * r, key = idx >> 5, d4 = (idx & 31) * 4; *(LAS f32x4*)(Ss + key * 132 + d4) = *(const f32x4*)(sk + key * 128 + d4); }
#pragma unroll
        for (int r = 0; r < 4; ++r) { const int idx = tid + 512 * r, kin = idx >> 5, d4 = (idx & 31) * 4; *(LAS f32x4*)(Ws + kin * 128 + d4) = *(const f32x4*)(wq + (size_t)kin * DM + d4); }
        __syncthreads();
        const int key = tid & 127, kq = tid >> 7;
        float acc[16];
#pragma unroll
        for (int j = 0; j < 16; ++j) acc[j] = 0.f;
        for (int d4 = 0; d4 < 32; ++d4) {
            const f32x4 s4 = *(const LAS f32x4*)(Ss + key * 132 + d4 * 4);
#pragma unroll
            for (int j = 0; j < 16; ++j) { const f32x4 w4 = *(const LAS f32x4*)(Ws + (kq * 16 + j) * 128 + d4 * 4); acc[j] += s4[0] * w4[0] + s4[1] * w4[1] + s4[2] * w4[2] + s4[3] * w4[3]; }
        }
        bf16_t* o = WcT + (size_t)l * DM * DM + (size_t)(h * 256 + half * 128 + key) * DM + kb * 64 + kq * 16;
        u32x4 w0, w1;
        w0.x = pk_bf16(acc[0], acc[1]); w0.y = pk_bf16(acc[2], acc[3]); w0.z = pk_bf16(acc[4], acc[5]); w0.w = pk_bf16(acc[6], acc[7]);
        w1.x = pk_bf16(acc[8], acc[9]); w1.y = pk_bf16(acc[10], acc[11]); w1.z = pk_bf16(acc[12], acc[13]); w1.w = pk_bf16(acc[14], acc[15]);
        *(u32x4*)o = w0; *(u32x4*)(o + 8) = w1;
        __syncthreads();
    }
}

__device__ __forceinline__ void quant_rows(const float* src, unsigned char* dst, float* scl, int nrows) {
    const int lane = threadIdx.x & 63, gw = blockIdx.x * 8 + (threadIdx.x >> 6), nw = gridDim.x * 8;
    for (int row = gw; row < nrows; row += nw) {
        const float* p = src + (size_t)row * DM;
        f32x4 v[8];
#pragma unroll
        for (int i = 0; i < 2; ++i)
#pragma unroll
            for (int q = 0; q < 4; ++q) v[i * 4 + q] = *(const f32x4*)(p + 1024 * i + 16 * lane + 4 * q);
        float am = 0.f;
#pragma unroll
        for (int i = 0; i < 8; ++i) am = fmaxf(am, fmaxf(fmaxf(fabsf(v[i][0]), fabsf(v[i][1])), fmaxf(fabsf(v[i][2]), fabsf(v[i][3]))));
        am = fmaxf(wave_max(am), 1e-30f);
        const float inv = 127.0f / am;
        if (lane == 0) scl[row] = am * (1.0f / 127.0f);
#pragma unroll
        for (int i = 0; i < 2; ++i) {
            u32x4 w;
#pragma unroll
            for (int q = 0; q < 4; ++q) {
                const f32x4 t = v[i * 4 + q];
                const unsigned b0 = (unsigned)(int)(rintf(t[0] * inv) + 128.0f), b1 = (unsigned)(int)(rintf(t[1] * inv) + 128.0f), b2 = (unsigned)(int)(rintf(t[2] * inv) + 128.0f), b3 = (unsigned)(int)(rintf(t[3] * inv) + 128.0f);
                w[q] = b0 | (b1 << 8) | (b2 << 16) | (b3 << 24);
            }
            *(u32x4*)(dst + (size_t)row * DM + 1024 * i + 16 * lane) = w;
        }
    }
}
__device__ __forceinline__ void phase_prep(const Args& a, LAS unsigned char* lds) {
    unsigned char* ws = a.ws;
    LAS float* tile = (LAS float*)lds;
    transpose_tiles(tile, a.in[1], 4 * DM, DM, 4 * DM, (bf16_t*)(ws + WS_WIN));
    transpose_tiles(tile, a.in[3], DM, DM, DM, (bf16_t*)(ws + WS_WOUT));
    transpose_tiles(tile, a.in[5], 2 * DM, DM, 2 * DM, (bf16_t*)(ws + WS_WKVQ));
    transpose_tiles(tile, a.in[6], DM, DM, DM, (bf16_t*)(ws + WS_WKVQ) + (size_t)2 * DM * DM);
    transpose_tiles(tile, a.in[7], DM, DM, DM, (bf16_t*)(ws + WS_WO));
    fold_peer_keys((LAS float*)lds, a.in[8], a.in[9], (bf16_t*)(ws + WS_WC));
    convert_bf16(a.in[0], (bf16_t*)(ws + slot(0)), (size_t)MTOK * DM);
    quant_rows(a.in[10], ws + WS_UB, (float*)(ws + WS_USC), 2 * 16384);
    quant_rows(a.in[11], ws + WS_VB, (float*)(ws + WS_VSC), 2 * 16384);
    const int gtid = blockIdx.x * 512 + threadIdx.x, gthreads = gridDim.x * 512;
    float* COS = (float*)(ws + WS_COS); float* SIN = (float*)(ws + WS_SIN); float* LB = (float*)(ws + WS_LB);
    for (int i = gtid; i < SEQ * 64; i += gthreads) {
        const int pos = i >> 6, j = i & 63;
        double inv = 1.0; const double r = 0.86596432336006535;
        for (int q = 0; q < j; ++q) inv *= r;
        const float ang = (float)pos * (float)inv;
        const double x = (double)ang;
        const double n = __builtin_rint(x * 0.15915494309189535);
        const float rf = (float)__builtin_fma(-n, 6.283185307179586, x);
        COS[i] = cosf(rf); SIN[i] = sinf(rf);
    }
    for (int c = gtid; c < DM; c += gthreads) { const float l0 = a.in[4][c], l1 = a.in[4][DM + c]; LB[c] = 1.0f / (1.0f + expf(l1 - l0)); }
}

__device__ __forceinline__ void phase_scan_naive(const bf16_t* Q1, const float* LF, const bf16_t* I1, float* O) {
    const int lane = threadIdx.x & 63, gw = blockIdx.x * 8 + (threadIdx.x >> 6), nw = gridDim.x * 8;
    for (int item = gw; item < 2 * NHEAD * 128; item += nw) {
        const int bh = item >> 7, v = item & 127, b = bh >> 4, h = bh & 15;
        const size_t base = (size_t)b * SEQ * DM + h * 128;
        float S0 = 0.f, S1 = 0.f;
#pragma unroll 4
        for (int t = 0; t < SEQ; ++t) {
            const size_t ro = base + (size_t)t * DM;
            const float f0 = __expf(LF[ro + lane]), f1 = __expf(LF[ro + 64 + lane]);
            const float q0 = bf2f(Q1[ro + lane]), q1 = bf2f(Q1[ro + 64 + lane]);
            const float iv = bf2f(I1[ro + v]);
            S0 = f0 * S0 + (1.0f - f0) * iv; S1 = f1 * S1 + (1.0f - f1) * iv;
            const float p = wave_sum(q0 * S0 + q1 * S1);
            if (lane == 0) O[ro + v] = p;
        }
    }
}
__device__ __forceinline__ void phase_onorm(const float* O, const bf16_t* G1, const float* gnorm, bf16_t* OG) {
    const int lane = threadIdx.x & 63, gw = blockIdx.x * 8 + (threadIdx.x >> 6), nw = gridDim.x * 8;
    const float gn0 = gnorm[2 * lane], gn1 = gnorm[2 * lane + 1];
    for (int item = gw; item < MTOK * NHEAD; item += nw) {
        const size_t off = (size_t)item * 128 + 2 * lane;
        const float o0 = O[off], o1 = O[off + 1];
        const float ss = wave_sum(o0 * o0 + o1 * o1);
        const float r = rsqrtf(ss * (1.0f / 128.0f) + 1e-6f);
        const unsigned g = *(const unsigned*)(G1 + off);
        *(unsigned*)(OG + off) = pk_bf16(o0 * r * gn0 * bflo(g), o1 * r * gn1 * bfhi(g));
    }
}

__device__ __forceinline__ void ln_row_store(float (&v)[32], const float* g, const float* bta, float* outf, bf16_t* outb, int lane, signed char* outq = nullptr, float* outs = nullptr) {
    float s = 0.f;
#pragma unroll
    for (int i = 0; i < 32; ++i) s += v[i];
    const float mu = wave_sum(s) * (1.0f / DM);
    float q = 0.f;
#pragma unroll
    for (int i = 0; i < 32; ++i) { v[i] -= mu; q += v[i] * v[i]; }
    const float rstd = rsqrtf(wave_sum(q) * (1.0f / DM) + 1e-5f);
    float am = 0.f;
#pragma unroll
    for (int i = 0; i < 4; ++i) {
        const int c = 512 * i + 8 * lane;
        const f32x4 g0 = *(const f32x4*)(g + c), g1 = *(const f32x4*)(g + c + 4), b0 = *(const f32x4*)(bta + c), b1 = *(const f32x4*)(bta + c + 4);
        f32x4 o0, o1;
#pragma unroll
        for (int j = 0; j < 4; ++j) { o0[j] = v[i * 8 + j] * rstd * g0[j] + b0[j]; o1[j] = v[i * 8 + 4 + j] * rstd * g1[j] + b1[j]; v[i * 8 + j] = o0[j]; v[i * 8 + 4 + j] = o1[j]; am = fmaxf(am, fmaxf(fabsf(o0[j]), fabsf(o1[j]))); }
        *(f32x4*)(outf + c) = o0; *(f32x4*)(outf + c + 4) = o1;
        if (outb) { u32x4 w; w.x = pk_bf16(o0[0], o0[1]); w.y = pk_bf16(o0[2], o0[3]); w.z = pk_bf16(o1[0], o1[1]); w.w = pk_bf16(o1[2], o1[3]); *(u32x4*)(outb + c) = w; }
    }
    if (outq) {
        am = fmaxf(wave_max(am), 1e-30f);
        const float inv = 127.0f / am;
        if (lane == 0) *outs = am * (1.0f / 127.0f);
#pragma unroll
        for (int i = 0; i < 4; ++i) {
            u32x2 w;
            w.x = ((unsigned)(int)rintf(v[i * 8 + 0] * inv) & 0xffu) | (((unsigned)(int)rintf(v[i * 8 + 1] * inv) & 0xffu) << 8) | (((unsigned)(int)rintf(v[i * 8 + 2] * inv) & 0xffu) << 16) | (((unsigned)(int)rintf(v[i * 8 + 3] * inv) & 0xffu) << 24);
            w.y = ((unsigned)(int)rintf(v[i * 8 + 4] * inv) & 0xffu) | (((unsigned)(int)rintf(v[i * 8 + 5] * inv) & 0xffu) << 8) | (((unsigned)(int)rintf(v[i * 8 + 6] * inv) & 0xffu) << 16) | (((unsigned)(int)rintf(v[i * 8 + 7] * inv) & 0xffu) << 24);
            *(u32x2*)(outq + 512 * i + 8 * lane) = w;
        }
    }
}
__device__ __forceinline__ void ln_row_store16(float (&v)[32], const float* g, const float* bta, float* outf, bf16_t* outb, int lane) {
    float s = 0.f;
#pragma unroll
    for (int i = 0; i < 32; ++i) s += v[i];
    const float mu = wave_sum(s) * (1.0f / DM);
    float q = 0.f;
#pragma unroll
    for (int i = 0; i < 32; ++i) { v[i] -= mu; q += v[i] * v[i]; }
    const float rstd = rsqrtf(wave_sum(q) * (1.0f / DM) + 1e-5f);
#pragma unroll
    for (int i = 0; i < 2; ++i) {
        const int c = 1024 * i + 16 * lane;
        f32x4 o[4];
#pragma unroll
        for (int qd = 0; qd < 4; ++qd) {
            const f32x4 gg = *(const f32x4*)(g + c + 4 * qd), bb = *(const f32x4*)(bta + c + 4 * qd);
#pragma unroll
            for (int j = 0; j < 4; ++j) o[qd][j] = v[16 * i + 4 * qd + j] * rstd * gg[j] + bb[j];
            *(f32x4*)(outf + c + 4 * qd) = o[qd];
        }
        if (outb) {
            u32x4 w0, w1;
            w0.x = pk_bf16(o[0][0], o[0][1]); w0.y = pk_bf16(o[0][2], o[0][3]); w0.z = pk_bf16(o[1][0], o[1][1]); w0.w = pk_bf16(o[1][2], o[1][3]);
            w1.x = pk_bf16(o[2][0], o[2][1]); w1.y = pk_bf16(o[2][2], o[2][3]); w1.z = pk_bf16(o[3][0], o[3][1]); w1.w = pk_bf16(o[3][2], o[3][3]);
            *(u32x4*)(outb + c) = w0; *(u32x4*)(outb + c + 8) = w1;
        }
    }
}
__device__ __forceinline__ void phase_ln(const float* Y, const float* g, const float* bta, float* outf, bf16_t* outb, signed char* outq = nullptr, float* outs = nullptr) {
    const int lane = threadIdx.x & 63, gw = blockIdx.x * 8 + (threadIdx.x >> 6), nw = gridDim.x * 8;
    for (int row = gw; row < MTOK; row += nw) {
        float v[32];
        const float* p = Y + (size_t)row * DM;
#pragma unroll
        for (int i = 0; i < 4; ++i) {
            const f32x4 a = *(const f32x4*)(p + 512 * i + 8 * lane), b = *(const f32x4*)(p + 512 * i + 8 * lane + 4);
#pragma unroll
            for (int j = 0; j < 4; ++j) { v[i * 8 + j] = a[j]; v[i * 8 + 4 + j] = b[j]; }
        }
        ln_row_store(v, g, bta, outf + (size_t)row * DM, outb ? outb + (size_t)row * DM : nullptr, lane, outq ? outq + (size_t)row * DM : nullptr, outs ? outs + row : nullptr);
    }
}

__device__ __forceinline__ void wave_argmax(float& v, int& idx) {
#pragma unroll
    for (int o = 32; o >= 1; o >>= 1) {
        const float ov = __shfl_xor(v, o); const int oi = __shfl_xor(idx, o);
        if (ov > v || (ov == v && oi < idx)) { v = ov; idx = oi; }
    }
}
__device__ __forceinline__ unsigned fkey(float x) { const unsigned u = __float_as_uint(x); return u ^ (unsigned)(((int)u >> 31) | 0x80000000); }
__device__ __forceinline__ float funkey(unsigned k) { const unsigned u = (k & 0x80000000u) ? (k ^ 0x80000000u) : ~k; return __uint_as_float(u); }
__device__ __forceinline__ void sort16_insert(unsigned (&r)[16], unsigned v) {
#pragma unroll
    for (int i = 0; i < 16; ++i) { const unsigned m = r[i] > v ? r[i] : v; v = r[i] > v ? v : r[i]; r[i] = m; }
}
__device__ __forceinline__ void phase_topk(LAS unsigned char* lds, const float* SCT, int* EID, float* GATE) {
    LAS unsigned char* ib = lds + threadIdx.x * 32;
    for (int item = blockIdx.x * 512 + threadIdx.x; item < MTOK * 8; item += gridDim.x * 512) {
        const int h = item >> 14, tok = item & (MTOK - 1);
        const float* p = SCT + (size_t)(h * 256) * MTOK + tok;
        unsigned r1[16], r2[16];
#pragma unroll
        for (int i = 0; i < 16; ++i) { r1[i] = 0u; r2[i] = 0u; }
#pragma unroll 8
        for (int e = 0; e < 128; ++e) {
            const float x1 = p[(size_t)e * MTOK], x2 = p[(size_t)(128 + e) * MTOK];
            sort16_insert(r1, (fkey(x1) & ~0x7Fu) | (unsigned)e);
            sort16_insert(r2, (fkey(x2) & ~0x7Fu) | (unsigned)e);
        }
        float v1[16], v2[16];
#pragma unroll
        for (int i = 0; i < 16; ++i) { v1[i] = funkey(r1[i] & ~0x7Fu); v2[i] = funkey(r2[i] & ~0x7Fu); ib[i] = (unsigned char)(r1[i] & 0x7Fu); ib[16 + i] = (unsigned char)(r2[i] & 0x7Fu); }
        unsigned r3[16];
#pragma unroll
        for (int i = 0; i < 16; ++i) r3[i] = 0u;
#pragma unroll
        for (int a = 0; a < 16; ++a)
#pragma unroll
            for (int bq = 0; bq < 16; ++bq)
                if ((a + 1) * (bq + 1) <= 16) sort16_insert(r3, (fkey(v1[a] + v2[bq]) & ~0xFFu) | (unsigned)(a * 16 + bq));
        const float mx = funkey(r3[0] & ~0xFFu);
        float ev[16]; float sum = 0.f;
#pragma unroll
        for (int i = 0; i < 16; ++i) { ev[i] = __expf(funkey(r3[i] & ~0xFFu) - mx); sum += ev[i]; }
        const float rs = 1.0f / sum;
        int eid[16];
#pragma unroll
        for (int i = 0; i < 16; ++i) { const unsigned f = r3[i] & 0xFFu; eid[i] = (int)ib[f >> 4] * 128 + (int)ib[16 + (f & 15u)]; }
        int* eo = EID + (size_t)tok * 128 + h * 16; float* go = GATE + (size_t)tok * 128 + h * 16;
#pragma unroll
        for (int q = 0; q < 4; ++q) {
            *(u32x4*)(eo + 4 * q) = (u32x4){(unsigned)eid[4 * q], (unsigned)eid[4 * q + 1], (unsigned)eid[4 * q + 2], (unsigned)eid[4 * q + 3]};
            *(f32x4*)(go + 4 * q) = (f32x4){ev[4 * q] * rs, ev[4 * q + 1] * rs, ev[4 * q + 2] * rs, ev[4 * q + 3] * rs};
        }
    }
}

__device__ __forceinline__ float gelu_erf(float x) { return 0.5f * x * (1.0f + erff(x * 0.70710678118654752f)); }
__device__ __forceinline__ float ub0(unsigned w) { return (float)(w & 0xffu); }
__device__ __forceinline__ float ub1(unsigned w) { return (float)((w >> 8) & 0xffu); }
__device__ __forceinline__ float ub2(unsigned w) { return (float)((w >> 16) & 0xffu); }
__device__ __forceinline__ float ub3(unsigned w) { return (float)(w >> 24); }
__device__ __forceinline__ void phase_peer(LAS unsigned char* lds, const float* X, const int* EID, const float* GATE, const unsigned char* U, const unsigned char* V, const float* USC, const float* VSC,
                                           const float* g, const float* bta, float* outf, bf16_t* outb) {
    const int lane = threadIdx.x & 63, wv = threadIdx.x >> 6, gw = blockIdx.x * 8 + wv, nw = gridDim.x * 8;
    LAS float* hb = (LAS float*)(lds + wv * 512);
    for (int tok = gw; tok < MTOK; tok += nw) {
        float x[32];
        const float* xp = X + (size_t)tok * DM;
#pragma unroll
        for (int i = 0; i < 2; ++i)
#pragma unroll
            for (int q = 0; q < 4; ++q) { const f32x4 t = *(const f32x4*)(xp + 1024 * i + 16 * lane + 4 * q); x[16 * i + 4 * q] = t[0]; x[16 * i + 4 * q + 1] = t[1]; x[16 * i + 4 * q + 2] = t[2]; x[16 * i + 4 * q + 3] = t[3]; }
        float sx = 0.f;
#pragma unroll
        for (int j = 0; j < 32; ++j) sx += x[j];
        const float d0 = -128.0f * sx;
        const int e0 = EID[(size_t)tok * 128 + lane], e1 = EID[(size_t)tok * 128 + 64 + lane];
        const float g0 = GATE[(size_t)tok * 128 + lane], g1 = GATE[(size_t)tok * 128 + 64 + lane];
        for (int bt = 0; bt < 16; ++bt) {
            float d[8];
#pragma unroll
            for (int r = 0; r < 8; ++r) {
                const int e = bt * 8 + r;
                const int idx = __builtin_amdgcn_readfirstlane(__shfl(bt < 8 ? e0 : e1, e & 63));
                const u32x4* up = (const u32x4*)(U + (size_t)idx * DM) + lane;
                float acc = d0;
#pragma unroll
                for (int i = 0; i < 2; ++i) {
                    const u32x4 w = up[i * 64];
                    acc += x[16 * i + 0] * ub0(w.x) + x[16 * i + 1] * ub1(w.x) + x[16 * i + 2] * ub2(w.x) + x[16 * i + 3] * ub3(w.x)
                         + x[16 * i + 4] * ub0(w.y) + x[16 * i + 5] * ub1(w.y) + x[16 * i + 6] * ub2(w.y) + x[16 * i + 7] * ub3(w.y)
                         + x[16 * i + 8] * ub0(w.z) + x[16 * i + 9] * ub1(w.z) + x[16 * i + 10] * ub2(w.z) + x[16 * i + 11] * ub3(w.z)
                         + x[16 * i + 12] * ub0(w.w) + x[16 * i + 13] * ub1(w.w) + x[16 * i + 14] * ub2(w.w) + x[16 * i + 15] * ub3(w.w);
                }
                d[r] = acc;
            }
            const bool b5 = lane & 32, b4 = lane & 16, b3 = lane & 8;
            float t4[4];
#pragma unroll
            for (int q = 0; q < 4; ++q) { const float keep = b5 ? d[4 + q] : d[q], send = b5 ? d[q] : d[4 + q]; t4[q] = keep + __shfl_xor(send, 32); }
            float t2[2];
#pragma unroll
            for (int q = 0; q < 2; ++q) { const float keep = b4 ? t4[2 + q] : t4[q], send = b4 ? t4[q] : t4[2 + q]; t2[q] = keep + __shfl_xor(send, 16); }
            float t1;
            { const float keep = b3 ? t2[1] : t2[0], send = b3 ? t2[0] : t2[1]; t1 = keep + __shfl_xor(send, 8); }
            t1 += __shfl_xor(t1, 4); t1 += __shfl_xor(t1, 2); t1 += __shfl_xor(t1, 1);
            if ((lane & 7) == 0) hb[bt * 8 + (lane >> 3 & 1) + 2 * (lane >> 4 & 1) + 4 * (lane >> 5 & 1)] = t1;
        }
        asm volatile("s_waitcnt lgkmcnt(0)" ::: "memory");
        const float h0 = hb[lane] * USC[e0], h1 = hb[64 + lane] * USC[e1];
        const float w0 = g0 * gelu_erf(h0) * VSC[e0], w1 = g1 * gelu_erf(h1) * VSC[e1];
        float wsum = wave_sum(w0 + w1);
        float y[32];
#pragma unroll
        for (int i = 0; i < 32; ++i) y[i] = 0.f;
#pragma unroll 8
        for (int e = 0; e < 128; ++e) {
            const int idx = __builtin_amdgcn_readfirstlane(__shfl(e < 64 ? e0 : e1, e & 63));
            const float wt = __shfl(e < 64 ? w0 : w1, e & 63);
            const u32x4* vp = (const u32x4*)(V + (size_t)idx * DM) + lane;
#pragma unroll
            for (int i = 0; i < 2; ++i) {
                const u32x4 w = vp[i * 64];
                y[16 * i + 0] += wt * ub0(w.x); y[16 * i + 1] += wt * ub1(w.x); y[16 * i + 2] += wt * ub2(w.x); y[16 * i + 3] += wt * ub3(w.x);
                y[16 * i + 4] += wt * ub0(w.y); y[16 * i + 5] += wt * ub1(w.y); y[16 * i + 6] += wt * ub2(w.y); y[16 * i + 7] += wt * ub3(w.y);
                y[16 * i + 8] += wt * ub0(w.z); y[16 * i + 9] += wt * ub1(w.z); y[16 * i + 10] += wt * ub2(w.z); y[16 * i + 11] += wt * ub3(w.z);
                y[16 * i + 12] += wt * ub0(w.w); y[16 * i + 13] += wt * ub1(w.w); y[16 * i + 14] += wt * ub2(w.w); y[16 * i + 15] += wt * ub3(w.w);
            }
        }
        const float corr = -128.0f * wsum;
#pragma unroll
        for (int i = 0; i < 32; ++i) y[i] = y[i] + corr + ALPHA * x[i];
        ln_row_store16(y, g, bta, outf + (size_t)tok * DM, outb ? outb + (size_t)tok * DM : nullptr, lane);
        asm volatile("s_waitcnt lgkmcnt(0)" ::: "memory");
    }
}

__device__ __forceinline__ int row_dot_i8(const u32x4 (&xq)[2], const unsigned char* rowp, int lane) {
    const u32x4* up = (const u32x4*)rowp + lane;
    int acc = 0;
#pragma unroll
    for (int i = 0; i < 2; ++i) {
        const u32x4 w = up[i * 64];
        acc = __builtin_amdgcn_sdot4((int)xq[i].x, (int)(w.x ^ 0x80808080u), acc, false); acc = __builtin_amdgcn_sdot4((int)xq[i].y, (int)(w.y ^ 0x80808080u), acc, false);
        acc = __builtin_amdgcn_sdot4((int)xq[i].z, (int)(w.z ^ 0x80808080u), acc, false); acc = __builtin_amdgcn_sdot4((int)xq[i].w, (int)(w.w ^ 0x80808080u), acc, false);
    }
    return acc;
}
__device__ __forceinline__ void peer_issue8(u32x4 (&seg)[8], const unsigned char* base, const u32x4 ia, const u32x4 ib) {
    seg[0] = *(const u32x4*)(base + (size_t)ia.x * DM); seg[1] = *(const u32x4*)(base + (size_t)ia.y * DM); seg[2] = *(const u32x4*)(base + (size_t)ia.z * DM); seg[3] = *(const u32x4*)(base + (size_t)ia.w * DM);
    seg[4] = *(const u32x4*)(base + (size_t)ib.x * DM); seg[5] = *(const u32x4*)(base + (size_t)ib.y * DM); seg[6] = *(const u32x4*)(base + (size_t)ib.z * DM); seg[7] = *(const u32x4*)(base + (size_t)ib.w * DM);
}
__device__ __forceinline__ void peer_dot8(int (&d)[8], const u32x4 (&seg)[8], const u32x4 xq) {
#pragma unroll
    for (int i = 0; i < 8; ++i) {
        int acc = __builtin_amdgcn_sdot4((int)xq.x, (int)(seg[i].x ^ 0x80808080u), 0, false);
        acc = __builtin_amdgcn_sdot4((int)xq.y, (int)(seg[i].y ^ 0x80808080u), acc, false);
        acc = __builtin_amdgcn_sdot4((int)xq.z, (int)(seg[i].z ^ 0x80808080u), acc, false);
        d[i] = __builtin_amdgcn_sdot4((int)xq.w, (int)(seg[i].w ^ 0x80808080u), acc, false);
    }
}
__device__ __forceinline__ void phase_peer_u(const signed char* XQ, const int* EID, const unsigned char* U, LAS int* HL  ) {
    const int lane = threadIdx.x & 63, wv = threadIdx.x >> 6, es = lane >> 3, cc = lane & 7;
    const bool b2 = cc & 4, b1 = cc & 2, b0 = cc & 1;
    const int nw = gridDim.x * 8, gw = blockIdx.x * 8 + wv, tpw = (MTOK + nw - 1) / nw, tbase = gw * tpw;
    int cnt = MTOK - tbase; cnt = cnt > tpw ? tpw : cnt;
    if (cnt <= 0) return;
    for (int i = lane; i < cnt * 128; i += 64) HL[i] = 0;
    asm volatile("s_waitcnt lgkmcnt(0)" ::: "memory");
    const int nit = 16 * cnt;
    const unsigned char* ub = U + cc * 16;
    u32x4 idA0, idA1, idB0, idB1, xqA; u32x4 sA[8], sB[8];
#define PU_META(k_, half_, I0, I1) { const int* ep_ = EID + (size_t)(tbase + (k_)) * 128 + es * 16 + (half_) * 8; I0 = *(const u32x4*)ep_; I1 = *(const u32x4*)(ep_ + 4); }
#define PU_XQ(sl_, k_, XQv) { XQv = *(const u32x4*)(XQ + (size_t)(tbase + (k_)) * DM + (sl_) * 128 + cc * 16); }
    PU_META(0, 0, idA0, idA1) PU_XQ(0, 0, xqA)
    peer_issue8(sA, ub, idA0, idA1);
    PU_META(0, 1, idB0, idB1)
    int sl = 0, k = 0;
    for (int it = 0; it < nit; ++it) {
        int kn = k + 1, sln = sl; if (kn == cnt) { kn = 0; ++sln; } if (it + 1 == nit) { kn = k; sln = sl; }
        peer_issue8(sB, ub + sl * 128, idB0, idB1);
        const u32x4 xq = xqA;
        PU_META(kn, 0, idA0, idA1) PU_XQ(sln, kn, xqA)
        int dlo[8]; peer_dot8(dlo, sA, xq);
        peer_issue8(sA, ub + sln * 128, idA0, idA1);
        PU_META(kn, 1, idB0, idB1)
        int dhi[8]; peer_dot8(dhi, sB, xq);
        int t8[8], t4[4], t2[2];
#pragma unroll
        for (int q = 0; q < 8; ++q) { const int keep = b2 ? dhi[q] : dlo[q], send = b2 ? dlo[q] : dhi[q]; t8[q] = keep + __shfl_xor(send, 4); }
#pragma unroll
        for (int q = 0; q < 4; ++q) { const int keep = b1 ? t8[4 + q] : t8[q], send = b1 ? t8[q] : t8[4 + q]; t4[q] = keep + __shfl_xor(send, 2); }
#pragma unroll
        for (int q = 0; q < 2; ++q) { const int keep = b0 ? t4[2 + q] : t4[q], send = b0 ? t4[q] : t4[2 + q]; t2[q] = keep + __shfl_xor(send, 1); }
        { LAS int* hp = HL + k * 128 + es * 16 + (b2 ? 8 : 0) + (b1 ? 4 : 0) + (b0 ? 2 : 0);
          __hip_atomic_fetch_add(hp, t2[0], __ATOMIC_RELAXED, __HIP_MEMORY_SCOPE_WORKGROUP); __hip_atomic_fetch_add(hp + 1, t2[1], __ATOMIC_RELAXED, __HIP_MEMORY_SCOPE_WORKGROUP); }
        k = kn; sl = sln;
    }
#undef PU_META
#undef PU_XQ
}
__device__ __forceinline__ void phase_peer_w(const LAS int* HL, const float* XS, const int* EID, const float* GATE, const float* USC, const float* VSC, float* W, float* CS) {
    const int lane = threadIdx.x & 63, gw = blockIdx.x * 8 + (threadIdx.x >> 6), nw = gridDim.x * 8, tpw = (MTOK + nw - 1) / nw, tbase = gw * tpw;
    const int tend = tbase + tpw < MTOK ? tbase + tpw : MTOK;
    for (int tok = tbase; tok < tend; ++tok) {
        const int h0 = HL[(tok - tbase) * 128 + lane], h1 = HL[(tok - tbase) * 128 + 64 + lane];
        const int e0 = EID[(size_t)tok * 128 + lane], e1 = EID[(size_t)tok * 128 + 64 + lane];
        const float xs = XS[tok];
        const float w0 = GATE[(size_t)tok * 128 + lane] * gelu_erf((float)h0 * xs * USC[e0]) * VSC[e0];
        const float w1 = GATE[(size_t)tok * 128 + 64 + lane] * gelu_erf((float)h1 * xs * USC[e1]) * VSC[e1];
        W[(size_t)tok * 128 + lane] = w0; W[(size_t)tok * 128 + 64 + lane] = w1;
        const float cs = wave_sum(w0 + w1);
        if (lane == 0) CS[tok] = cs;
    }
}
__device__ __forceinline__ void peer_fma8(f32x2_t (&ya)[8], const u32x4 (&seg)[8], const f32x4 wa, const f32x4 wb2) {
#pragma unroll
    for (int i = 0; i < 8; ++i) {
        const float wt = i < 4 ? wa[i & 3] : wb2[i & 3];
        const f32x2_t wt2 = {wt, wt};
        const u32x4 w = seg[i];
        ya[0] = __builtin_elementwise_fma(wt2, (f32x2_t){ub0(w.x), ub1(w.x)}, ya[0]); ya[1] = __builtin_elementwise_fma(wt2, (f32x2_t){ub2(w.x), ub3(w.x)}, ya[1]);
        ya[2] = __builtin_elementwise_fma(wt2, (f32x2_t){ub0(w.y), ub1(w.y)}, ya[2]); ya[3] = __builtin_elementwise_fma(wt2, (f32x2_t){ub2(w.y), ub3(w.y)}, ya[3]);
        ya[4] = __builtin_elementwise_fma(wt2, (f32x2_t){ub0(w.z), ub1(w.z)}, ya[4]); ya[5] = __builtin_elementwise_fma(wt2, (f32x2_t){ub2(w.z), ub3(w.z)}, ya[5]);
        ya[6] = __builtin_elementwise_fma(wt2, (f32x2_t){ub0(w.w), ub1(w.w)}, ya[6]); ya[7] = __builtin_elementwise_fma(wt2, (f32x2_t){ub2(w.w), ub3(w.w)}, ya[7]);
    }
}
__device__ __forceinline__ void phase_peer_v(const float* X, const int* EID, const float* W, const float* CS, const unsigned char* V, float* Y) {
    const int lane = threadIdx.x & 63, wv = threadIdx.x >> 6, es = lane >> 3, cc = lane & 7;
    const bool b5 = lane & 32, b4 = lane & 16, b3 = lane & 8;
    const int nw = gridDim.x * 8, gw = blockIdx.x * 8 + wv, tpw = (MTOK + nw - 1) / nw, tbase = gw * tpw;
    int cnt = MTOK - tbase; cnt = cnt > tpw ? tpw : cnt;
    if (cnt <= 0) return;
    const int nit = 16 * cnt;
    const unsigned char* vb = V + cc * 16;
    const int colo = cc * 16 + (b5 ? 8 : 0) + (b4 ? 4 : 0) + (b3 ? 2 : 0);
    u32x4 idA0, idA1, idB0, idB1; f32x4 wA0, wA1, wB0, wB1; f32x2_t xr; float cs; u32x4 sA[8], sB[8];
#define PV_META(k_, half_, I0, I1, W0, W1) { const size_t o_ = (size_t)(tbase + (k_)) * 128 + es * 16 + (half_) * 8; \
        I0 = *(const u32x4*)(EID + o_); I1 = *(const u32x4*)(EID + o_ + 4); W0 = *(const f32x4*)(W + o_); W1 = *(const f32x4*)(W + o_ + 4); }
#define PV_XR(sl_, k_) { xr = *(const f32x2_t*)(X + (size_t)(tbase + (k_)) * DM + (sl_) * 128 + colo); cs = CS[tbase + (k_)]; }
    PV_META(0, 0, idA0, idA1, wA0, wA1)
    peer_issue8(sA, vb, idA0, idA1);
    PV_META(0, 1, idB0, idB1, wB0, wB1) PV_XR(0, 0)
    int sl = 0, k = 0;
    for (int it = 0; it < nit; ++it) {
        int kn = k + 1, sln = sl; if (kn == cnt) { kn = 0; ++sln; } if (it + 1 == nit) { kn = k; sln = sl; }
        peer_issue8(sB, vb + sl * 128, idB0, idB1);
        const f32x4 w0 = wA0, w1 = wA1, w2 = wB0, w3 = wB1; const f32x2_t xrc = xr; const float csc = cs;
        PV_META(kn, 0, idA0, idA1, wA0, wA1)
        f32x2_t ya[8];
#pragma unroll
        for (int j = 0; j < 8; ++j) ya[j] = (f32x2_t){0.f, 0.f};
        peer_fma8(ya, sA, w0, w1);
        peer_issue8(sA, vb + sln * 128, idA0, idA1);
        PV_META(kn, 1, idB0, idB1, wB0, wB1) PV_XR(sln, kn)
        peer_fma8(ya, sB, w2, w3);
        f32x2_t t4[4], t2[2], t1;
#pragma unroll
        for (int q = 0; q < 4; ++q) { const f32x2_t keep = b5 ? ya[4 + q] : ya[q], send = b5 ? ya[q] : ya[4 + q]; t4[q][0] = keep[0] + __shfl_xor(send[0], 32); t4[q][1] = keep[1] + __shfl_xor(send[1], 32); }
#pragma unroll
        for (int q = 0; q < 2; ++q) { const f32x2_t keep = b4 ? t4[2 + q] : t4[q], send = b4 ? t4[q] : t4[2 + q]; t2[q][0] = keep[0] + __shfl_xor(send[0], 16); t2[q][1] = keep[1] + __shfl_xor(send[1], 16); }
        { const f32x2_t keep = b3 ? t2[1] : t2[0], send = b3 ? t2[0] : t2[1]; t1[0] = keep[0] + __shfl_xor(send[0], 8); t1[1] = keep[1] + __shfl_xor(send[1], 8); }
        f32x2_t o; o[0] = t1[0] - 128.0f * csc + ALPHA * xrc[0]; o[1] = t1[1] - 128.0f * csc + ALPHA * xrc[1];
        *(f32x2_t*)(Y + (size_t)(tbase + k) * DM + sl * 128 + colo) = o;
        k = kn; sl = sln;
    }
#undef PV_META
#undef PV_XR
}

__device__ __forceinline__ void rot8(const u32x4 lo, const u32x4 hi, const f32x4 c0, const f32x4 c1, const f32x4 s0, const f32x4 s1, float (&o1)[8], float (&o2)[8]) {
    const float a[8] = {bflo(lo.x), bfhi(lo.x), bflo(lo.y), bfhi(lo.y), bflo(lo.z), bfhi(lo.z), bflo(lo.w), bfhi(lo.w)};
    const float b[8] = {bflo(hi.x), bfhi(hi.x), bflo(hi.y), bfhi(hi.y), bflo(hi.z), bfhi(hi.z), bflo(hi.w), bfhi(hi.w)};
    const float c[8] = {c0[0], c0[1], c0[2], c0[3], c1[0], c1[1], c1[2], c1[3]}, sn[8] = {s0[0], s0[1], s0[2], s0[3], s1[0], s1[1], s1[2], s1[3]};
#pragma unroll
    for (int j = 0; j < 8; ++j) { o1[j] = a[j] * c[j] - b[j] * sn[j]; o2[j] = a[j] * sn[j] + b[j] * c[j]; }
}
__device__ __forceinline__ u32x4 pack8(const float (&o)[8]) { u32x4 w; w.x = pk_bf16(o[0], o[1]); w.y = pk_bf16(o[2], o[3]); w.z = pk_bf16(o[4], o[5]); w.w = pk_bf16(o[6], o[7]); return w; }
__device__ __forceinline__ void phase_rot(LAS float* red, bf16_t* KR, bf16_t* QR, const float* COS, const float* SIN, float* KMEAN, float* KNMAX) {
    const int tid = threadIdx.x, ch = tid & 7, rr = tid >> 3, wv = tid >> 6, lane = tid & 63;
    for (int item = blockIdx.x; item < 2 * NHEAD * 32; item += gridDim.x) {
        const int bh = item >> 5, j = item & 31, b = bh >> 4, h = bh & 15;
        float sm1[8], sm2[8]; float nmax = 0.f;
#pragma unroll
        for (int q = 0; q < 8; ++q) { sm1[q] = 0.f; sm2[q] = 0.f; }
#pragma unroll
        for (int ps = 0; ps < 4; ++ps) {
            const int pos = j * 256 + ps * 64 + rr;
            const size_t off = ((size_t)b * SEQ + pos) * DM + h * 128 + ch * 8;
            const f32x4 c0 = *(const f32x4*)(COS + pos * 64 + ch * 8), c1 = *(const f32x4*)(COS + pos * 64 + ch * 8 + 4);
            const f32x4 s0 = *(const f32x4*)(SIN + pos * 64 + ch * 8), s1 = *(const f32x4*)(SIN + pos * 64 + ch * 8 + 4);
            float o1[8], o2[8];
            rot8(*(const u32x4*)(KR + off), *(const u32x4*)(KR + off + 64), c0, c1, s0, s1, o1, o2);
            *(u32x4*)(KR + off) = pack8(o1); *(u32x4*)(KR + off + 64) = pack8(o2);
            float nq = 0.f;
#pragma unroll
            for (int q = 0; q < 8; ++q) { sm1[q] += o1[q]; sm2[q] += o2[q]; nq += o1[q] * o1[q] + o2[q] * o2[q]; }
            nq += __shfl_xor(nq, 1); nq += __shfl_xor(nq, 2); nq += __shfl_xor(nq, 4);
            nmax = fmaxf(nmax, nq);
            rot8(*(const u32x4*)(QR + off), *(const u32x4*)(QR + off + 64), c0, c1, s0, s1, o1, o2);
            *(u32x4*)(QR + off) = pack8(o1); *(u32x4*)(QR + off + 64) = pack8(o2);
        }
#pragma unroll
        for (int q = 0; q < 8; ++q) {
            sm1[q] += __shfl_xor(sm1[q], 8); sm1[q] += __shfl_xor(sm1[q], 16); sm1[q] += __shfl_xor(sm1[q], 32);
            sm2[q] += __shfl_xor(sm2[q], 8); sm2[q] += __shfl_xor(sm2[q], 16); sm2[q] += __shfl_xor(sm2[q], 32);
        }
        nmax = wave_max(nmax);
        if (lane < 8) {
#pragma unroll
            for (int q = 0; q < 8; ++q) { red[wv * 128 + lane * 8 + q] = sm1[q]; red[wv * 128 + 64 + lane * 8 + q] = sm2[q]; }
        }
        if (lane == 0) red[1024 + wv] = nmax;
        __syncthreads();
        if (tid < 128) {
            float s2 = 0.f;
#pragma unroll
            for (int r = 0; r < 8; ++r) s2 += red[r * 128 + tid];
            KMEAN[(size_t)item * 128 + tid] = s2 * (1.0f / 256.0f);
        }
        if (tid == 0) {
            float m = 0.f;
#pragma unroll
            for (int r = 0; r < 8; ++r) m = fmaxf(m, red[1024 + r]);
            KNMAX[item] = sqrtf(m);
        }
        __syncthreads();
    }
}

__device__ __forceinline__ void top3_insert(float x, int m, float& v0, int& i0, float& v1, int& i1, float& v2, int& i2) {
    const bool c0 = x > v0 || (x == v0 && m < i0), c1 = x > v1 || (x == v1 && m < i1), c2 = x > v2 || (x == v2 && m < i2);
    v2 = c1 ? v1 : (c2 ? x : v2); i2 = c1 ? i1 : (c2 ? m : i2);
    v1 = c0 ? v0 : (c1 ? x : v1); i1 = c0 ? i0 : (c1 ? m : i1);
    v0 = c0 ? x : v0; i0 = c0 ? m : i0;
}
__device__ __forceinline__ void phase_sel(LAS unsigned char* lds, const bf16_t* QR, const float* KMEAN, unsigned short* SUB, int* CNT, int* ctr) {
    const int tid = threadIdx.x, lane = tid & 63, wv = tid >> 6, r32 = lane & 31, hh = lane >> 5;
    LAS unsigned short* bucket = (LAS unsigned short*)lds;
    LAS int* cnt = (LAS int*)(lds + 16384);
    const float NEG = -1e30f;
    if (blockIdx.x == 0 && tid == 0) *ctr = 0;
    for (int item = blockIdx.x; item < 2 * NHEAD * 32; item += gridDim.x) {
        const int bh = item >> 5, i = item & 31, b = bh >> 4, h = bh & 15;
        if (i == 0) continue;
        if (tid < 32) cnt[tid] = 0;
        __syncthreads();
        const float* kmp = KMEAN + ((size_t)bh * 32 + r32) * 128 + 8 * hh;
        const size_t tok = (size_t)b * SEQ + i * 256 + wv * 32 + r32;
        const bf16_t* qp = QR + tok * DM + h * 128 + 8 * hh;
        f32x16 S;
#pragma unroll
        for (int e = 0; e < 16; ++e) S[e] = 0.f;
#pragma unroll
        for (int s2 = 0; s2 < 8; ++s2) {
            const f32x4 ka = *(const f32x4*)(kmp + 16 * s2), kb = *(const f32x4*)(kmp + 16 * s2 + 4);
            const bf16x8 qf = *(const bf16x8*)(qp + 16 * s2);
            u32x4 hi, lo;
            hi.x = pk_bf16(ka[0], ka[1]); hi.y = pk_bf16(ka[2], ka[3]); hi.z = pk_bf16(kb[0], kb[1]); hi.w = pk_bf16(kb[2], kb[3]);
            lo.x = pk_bf16(ka[0] - bflo(hi.x), ka[1] - bfhi(hi.x)); lo.y = pk_bf16(ka[2] - bflo(hi.y), ka[3] - bfhi(hi.y));
            lo.z = pk_bf16(kb[0] - bflo(hi.z), kb[1] - bfhi(hi.z)); lo.w = pk_bf16(kb[2] - bflo(hi.w), kb[3] - bfhi(hi.w));
            S = __builtin_amdgcn_mfma_f32_32x32x16_bf16(__builtin_bit_cast(bf16x8, hi), qf, S, 0, 0, 0);
            S = __builtin_amdgcn_mfma_f32_32x32x16_bf16(__builtin_bit_cast(bf16x8, lo), qf, S, 0, 0, 0);
        }
        float v0 = -3e38f, v1 = -3e38f, v2 = -3e38f; int i0 = 99, i1 = 99, i2 = 99;
#pragma unroll
        for (int e = 0; e < 16; ++e) {
            const int m = (e & 3) + 8 * (e >> 2) + 4 * hh;
            const float x = m < i ? S[e] : NEG;
            top3_insert(x, m, v0, i0, v1, i1, v2, i2);
        }
        {
            const float pv0 = __shfl_xor(v0, 32), pv1 = __shfl_xor(v1, 32), pv2 = __shfl_xor(v2, 32);
            const int pi0 = __shfl_xor(i0, 32), pi1 = __shfl_xor(i1, 32), pi2 = __shfl_xor(i2, 32);
            top3_insert(pv0, pi0, v0, i0, v1, i1, v2, i2); top3_insert(pv1, pi1, v0, i0, v1, i1, v2, i2); top3_insert(pv2, pi2, v0, i0, v1, i1, v2, i2);
        }
        if (hh == 0) {
            const int tl = wv * 32 + r32;
            if (v0 > 0.5f * NEG) { const int p = __hip_atomic_fetch_add(cnt + i0, 1, __ATOMIC_RELAXED, __HIP_MEMORY_SCOPE_WORKGROUP); bucket[i0 * 256 + p] = (unsigned short)(tl | (0 << 8)); }
            if (v1 > 0.5f * NEG) { const int p = __hip_atomic_fetch_add(cnt + i1, 1, __ATOMIC_RELAXED, __HIP_MEMORY_SCOPE_WORKGROUP); bucket[i1 * 256 + p] = (unsigned short)(tl | (1 << 8)); }
            if (v2 > 0.5f * NEG) { const int p = __hip_atomic_fetch_add(cnt + i2, 1, __ATOMIC_RELAXED, __HIP_MEMORY_SCOPE_WORKGROUP); bucket[i2 * 256 + p] = (unsigned short)(tl | (2 << 8)); }
        }
        __syncthreads();
        for (int idx = tid; idx < 32 * 256; idx += 512) {
            const int j = idx >> 8, p = idx & 255;
            if (j < i && p < cnt[j]) SUB[(((size_t)bh * 32 + j) * 32 + i) * 256 + p] = bucket[idx];
        }
        if (tid < i) CNT[((size_t)bh * 32 + tid) * 32 + i] = cnt[tid];
        __syncthreads();
    }
}

__device__ __forceinline__ unsigned off_b(unsigned row, unsigned ch) { return 256u * row + 16u * (ch ^ (((row & 3u) << 2) | ((row >> 2) & 3u))); }
__device__ __forceinline__ unsigned pi32(unsigned m) { return (m & ~12u) | ((m & 4u) << 1) | ((m & 8u) >> 1); }
__device__ __forceinline__ bf16x8 tr_frag(LAS unsigned char* img, unsigned lane, unsigned c, unsigned ks) {
    const unsigned hh = lane >> 5, blk = (lane >> 4) & 1, q = (lane & 15) >> 2, p = lane & 3;
    const unsigned a0 = off_b(16 * ks + 8 * hh + q, 4 * c + 2 * blk + (p >> 1)) + 8 * (p & 1);
    const unsigned a1 = off_b(16 * ks + 8 * hh + 4 + q, 4 * c + 2 * blk + (p >> 1)) + 8 * (p & 1);
    const s16x4 lo = __builtin_amdgcn_ds_read_tr16_b64_v4i16((LAS s16x4*)(img + a0));
    const s16x4 hi = __builtin_amdgcn_ds_read_tr16_b64_v4i16((LAS s16x4*)(img + a1));
    bf16x8 r; r[0] = lo[0]; r[1] = lo[1]; r[2] = lo[2]; r[3] = lo[3]; r[4] = hi[0]; r[5] = hi[1]; r[6] = hi[2]; r[7] = hi[3];
    return r;
}
__device__ __forceinline__ void phase_att(LAS unsigned char* lds, const bf16_t* QR, const bf16_t* KR, const bf16_t* V, const float* KNMAX, const unsigned short* SUB, const int* CNT, int* ctr,
                                          bf16_t* P012, bf16_t* P3, float* LS) {
    const int tid = threadIdx.x, lane = tid & 63, wv = tid >> 6, r32 = lane & 31, hh = lane >> 5;
    LAS unsigned char* Kimg = lds;
    LAS unsigned char* Vimg = lds + 65536;
    LAS int* misc = (LAS int*)(lds + 131072);
    const float SCL2 = 0.08838834764831845f * 1.4426950408889634f;
    for (;;) {
        __syncthreads();
        if (tid == 0) misc[40] = __hip_atomic_fetch_add(ctr, 1, __ATOMIC_RELAXED, __HIP_MEMORY_SCOPE_AGENT);
        __syncthreads();
        const int item = misc[40];
        if (item >= 2 * NHEAD * 32) break;
        const int j = item >> 5, bh = item & 31, b = bh >> 4, h = bh & 15;
#pragma unroll
        for (int r = 0; r < 8; ++r) {
            const int idx = tid + 512 * r, row = idx >> 4, ch = idx & 15;
            const size_t g = ((size_t)b * SEQ + j * 256 + row) * DM + h * 128 + ch * 8;
            const u32x4 kv = *(const u32x4*)(KR + g), vv = *(const u32x4*)(V + g);
            *(LAS u32x4*)(Kimg + off_b(row, ch)) = kv; *(LAS u32x4*)(Vimg + off_b(row, ch)) = vv;
        }
        if (tid <= 32) { int pre = 0; for (int u = j + 1; u < tid; ++u) pre += CNT[((size_t)bh * 32 + j) * 32 + u]; misc[tid] = pre; }
        float kn = (lane < 32) ? KNMAX[bh * 32 + lane] : 0.f;
        kn = wave_max(kn);
        __syncthreads();
        const int total = misc[32], ntile = (256 + total + 31) >> 5;
        for (int tile = wv; tile < ntile; tile += 8) {
            const int gr = tile * 32 + r32;
            int pos, slot; bool valid = true;
            if (gr < 256) { pos = j * 256 + gr; slot = 3; }
            else {
                const int x = gr - 256; valid = x < total;
                int ii = j + 1;
                for (int u = j + 1; u < 32; ++u) if (misc[u] <= x) ii = u;
                if (valid) { const unsigned e = SUB[(((size_t)bh * 32 + j) * 32 + ii) * 256 + (x - misc[ii])]; pos = ii * 256 + (int)(e & 255u); slot = (int)(e >> 8); }
                else { pos = j * 256; slot = 3; }
            }
            const size_t tok = (size_t)b * SEQ + pos;
            bf16x8 qf[8];
            const bf16_t* qp = QR + tok * DM + h * 128 + 8 * hh;
#pragma unroll
            for (int s = 0; s < 8; ++s) qf[s] = *(const bf16x8*)(qp + 16 * s);
            float qn2 = 0.f;
#pragma unroll
            for (int s = 0; s < 8; ++s)
#pragma unroll
                for (int e = 0; e < 8; ++e) { const float f = bf2f((bf16_t)qf[s][e]); qn2 += f * f; }
            qn2 += __shfl_xor(qn2, 32);
            const float c2 = sqrtf(qn2) * kn * SCL2;
            f32x16 O[4];
#pragma unroll
            for (int dt = 0; dt < 4; ++dt)
#pragma unroll
                for (int e = 0; e < 16; ++e) O[dt][e] = 0.f;
            float l = 0.f;
            const bool own = tile < 8;
            const int kcn = own ? tile + 1 : 8;
            const unsigned krow = pi32((unsigned)r32);
            for (int kc = 0; kc < kcn; ++kc) {
                f32x16 S;
#pragma unroll
                for (int e = 0; e < 16; ++e) S[e] = 0.f;
#pragma unroll
                for (int s = 0; s < 8; ++s) {
                    const bf16x8 kf = *(const LAS bf16x8*)(Kimg + off_b(32 * kc + krow, 2 * s + hh));
                    S = __builtin_amdgcn_mfma_f32_32x32x16_bf16(kf, qf[s], S, 0, 0, 0);
                }
                float p[16];
#pragma unroll
                for (int e = 0; e < 16; ++e) {
                    const unsigned m = (e & 3) + 8 * (e >> 2) + 4 * hh;
                    const int key = j * 256 + 32 * kc + (int)pi32(m);
                    float pe = __builtin_amdgcn_exp2f(S[e] * SCL2 - c2);
                    if (own && key > pos) pe = 0.f;
                    p[e] = pe; l += pe;
                }
                u32x4 w0, w1;
                w0.x = pk_bf16(p[0], p[1]); w0.y = pk_bf16(p[2], p[3]); w0.z = pk_bf16(p[4], p[5]); w0.w = pk_bf16(p[6], p[7]);
                w1.x = pk_bf16(p[8], p[9]); w1.y = pk_bf16(p[10], p[11]); w1.z = pk_bf16(p[12], p[13]); w1.w = pk_bf16(p[14], p[15]);
                const bf16x8 pf0 = __builtin_bit_cast(bf16x8, w0), pf1 = __builtin_bit_cast(bf16x8, w1);
#pragma unroll
                for (int dt = 0; dt < 4; ++dt) {
                    const bf16x8 v0 = tr_frag(Vimg, lane, dt, 2 * kc), v1 = tr_frag(Vimg, lane, dt, 2 * kc + 1);
                    O[dt] = __builtin_amdgcn_mfma_f32_32x32x16_bf16(v0, pf0, O[dt], 0, 0, 0);
                    O[dt] = __builtin_amdgcn_mfma_f32_32x32x16_bf16(v1, pf1, O[dt], 0, 0, 0);
                }
            }
            l += __shfl_xor(l, 32);
            if (valid) {
                bf16_t* pl = (slot < 3 ? P012 + (size_t)slot * ((size_t)32 << 20) : P3) + (tok * NHEAD + h) * 128 + 4 * hh;
#pragma unroll
                for (int dt = 0; dt < 4; ++dt)
#pragma unroll
                    for (int g = 0; g < 4; ++g) {
                        u32x2 w; w.x = pk_bf16(O[dt][4 * g], O[dt][4 * g + 1]); w.y = pk_bf16(O[dt][4 * g + 2], O[dt][4 * g + 3]);
                        *(u32x2*)(pl + 32 * dt + 8 * g) = w;
                    }
                if (hh == 0) LS[(size_t)slot * MTOK * NHEAD + tok * NHEAD + h] = l;
            }
        }
    }
}
__device__ __forceinline__ void phase_comb(const bf16_t* P012, const bf16_t* P3, const float* LS, bf16_t* AO) {
    const size_t n = (size_t)MTOK * NHEAD * 16, stride = (size_t)gridDim.x * 512;
    for (size_t idx = (size_t)blockIdx.x * 512 + threadIdx.x; idx < n; idx += stride) {
        const size_t th = idx >> 4; const int ch = (int)(idx & 15);
        const int t = (int)((th >> 4) & (SEQ - 1)), blk = t >> 8, nsel = blk < 3 ? blk : 3;
        float acc[8];
        float l = LS[(size_t)3 * MTOK * NHEAD + th];
        { const u32x4 w = *(const u32x4*)(P3 + th * 128 + ch * 8);
          acc[0] = bflo(w.x); acc[1] = bfhi(w.x); acc[2] = bflo(w.y); acc[3] = bfhi(w.y); acc[4] = bflo(w.z); acc[5] = bfhi(w.z); acc[6] = bflo(w.w); acc[7] = bfhi(w.w); }
        for (int s = 0; s < nsel; ++s) {
            const u32x4 w = *(const u32x4*)(P012 + (size_t)s * ((size_t)32 << 20) + th * 128 + ch * 8);
            acc[0] += bflo(w.x); acc[1] += bfhi(w.x); acc[2] += bflo(w.y); acc[3] += bfhi(w.y); acc[4] += bflo(w.z); acc[5] += bfhi(w.z); acc[6] += bflo(w.w); acc[7] += bfhi(w.w);
            l += LS[(size_t)s * MTOK * NHEAD + th];
        }
        const float rl = 1.0f / l;
        u32x4 o; o.x = pk_bf16(acc[0] * rl, acc[1] * rl); o.y = pk_bf16(acc[2] * rl, acc[3] * rl); o.z = pk_bf16(acc[4] * rl, acc[5] * rl); o.w = pk_bf16(acc[6] * rl, acc[7] * rl);
        *(u32x4*)(AO + th * 128 + ch * 8) = o;
    }
}

__device__ __forceinline__ void phase_scan_a(LAS unsigned char* lds, const float* LF, const bf16_t* I1, bf16_t* LT, float* DEC, unsigned* dbgc = nullptr) {
    unsigned dbg_kt = 0, dbg_acc = 0;
    const int tid = threadIdx.x, lane = tid & 63, wv = tid >> 6, k = tid & 127, part = tid >> 7;
    LAS unsigned char* Iimg = lds; LAS unsigned char* KTimg = lds + 16384;
    LAS float* psum = (LAS float*)(lds + 32768);
    LAS unsigned char* Lst = lds + 36864;
#if SCAN_A_VALU == 2
    for (int item = blockIdx.x; item < 2 * NHEAD * 128; item += gridDim.x) {
        const int bh = item >> 7, c = item & 127, b = bh >> 4, h = bh & 15;
        const size_t tok0 = (size_t)b * SEQ + c * 64;
        for (int idx = tid; idx < 16384; idx += 512) {
            const int v = idx >> 7, kk = idx & 127;
            float g = 1.f, L = 0.f;
            for (int s2 = 63; s2 >= 0; --s2) { const size_t o = (tok0 + s2) * DM + h * 128; const float f = __expf(LF[o + kk]); L += bf2f(I1[o + v]) * (1.0f - f) * g; g *= f; }
            LT[(size_t)item * 16384 + idx] = (bf16_t)(pk_bf16(L, 0.f) & 0xffffu);
        }
    }
    return;
#endif
    for (int item = blockIdx.x; item < 2 * NHEAD * 128; item += gridDim.x) {
        const int bh = item >> 7, c = item & 127, b = bh >> 4, h = bh & 15;
        const size_t tok0 = (size_t)b * SEQ + c * 64;
        float lf[16];
#pragma unroll
        for (int i = 0; i < 16; ++i) lf[i] = LF[(tok0 + 16 * part + i) * DM + h * 128 + k];
#pragma unroll
        for (int r = 0; r < 2; ++r) { const int idx = tid + 512 * r, row = idx >> 4, ch = idx & 15; *(LAS u32x4*)(Iimg + off_b(row, ch)) = *(const u32x4*)(I1 + (tok0 + row) * DM + h * 128 + ch * 8); }
        float cs = 0.f;
#pragma unroll
        for (int i = 0; i < 16; ++i) cs += lf[i];
        psum[part * 128 + k] = cs;
        __syncthreads();
        const float p0 = psum[k], p1 = psum[128 + k], p2 = psum[256 + k], p3 = psum[384 + k];
        const float blast = (p0 + p1) + (p2 + p3);
        float bb = part == 0 ? 0.f : (part == 1 ? p0 : (part == 2 ? p0 + p1 : p0 + p1 + p2));
#pragma unroll
        for (int i = 0; i < 16; ++i) {
            bb += lf[i];
            const float kt = (1.0f - __expf(lf[i])) * __expf(blast - bb);
            if (!(kt - kt == 0.f)) ++dbg_kt;
            const int srow = 16 * part + i;
            *(LAS bf16_t*)(KTimg + off_b(srow, k >> 3) + 2 * (k & 7)) = (bf16_t)(pk_bf16(kt, 0.f) & 0xffffu);
        }
        if (part == 0) DEC[(size_t)item * 128 + k] = __expf(blast);
        __syncthreads();
#if SCAN_A_VALU
        for (int idx = tid; idx < 16384; idx += 512) {
            const int v = idx >> 7, kk = idx & 127;
            float accv = 0.f;
            for (int s2 = 0; s2 < 64; ++s2) accv += bf2f(*(const LAS bf16_t*)(Iimg + off_b(s2, v >> 3) + 2 * (v & 7))) * bf2f(*(const LAS bf16_t*)(KTimg + off_b(s2, kk >> 3) + 2 * (kk & 7)));
            *(LAS bf16_t*)(Lst + v * 272 + 2 * kk) = (bf16_t)(pk_bf16(accv, 0.f) & 0xffffu);
        }
        if (0)
#endif
        {
            const int vt = wv >> 1;
            f32x16 acc0, acc1;
#pragma unroll
            for (int e = 0; e < 16; ++e) { acc0[e] = 0.f; acc1[e] = 0.f; }
#pragma unroll
            for (int ks = 0; ks < 4; ++ks) {
                const bf16x8 af = tr_frag(Iimg, lane, vt, ks);
                const bf16x8 b0 = tr_frag(KTimg, lane, 2 * (wv & 1), ks), b1 = tr_frag(KTimg, lane, 2 * (wv & 1) + 1, ks);
                acc0 = __builtin_amdgcn_mfma_f32_32x32x16_bf16(af, b0, acc0, 0, 0, 0);
                acc1 = __builtin_amdgcn_mfma_f32_32x32x16_bf16(af, b1, acc1, 0, 0, 0);
            }
            const int r32 = lane & 31, hh = lane >> 5;
#pragma unroll
            for (int e = 0; e < 16; ++e) {
                if (!(acc0[e] - acc0[e] == 0.f)) ++dbg_acc; if (!(acc1[e] - acc1[e] == 0.f)) ++dbg_acc;
                const int v = 32 * vt + (e & 3) + 8 * (e >> 2) + 4 * hh;
                *(LAS bf16_t*)(Lst + v * 272 + 2 * (64 * (wv & 1) + r32)) = (bf16_t)(pk_bf16(acc0[e], 0.f) & 0xffffu);
                *(LAS bf16_t*)(Lst + v * 272 + 2 * (64 * (wv & 1) + 32 + r32)) = (bf16_t)(pk_bf16(acc1[e], 0.f) & 0xffffu);
            }
        }
        __syncthreads();
#pragma unroll
        for (int r = 0; r < 4; ++r) { const int idx = tid + 512 * r, row = idx >> 4, ch = idx & 15; store_wt16(LT + (size_t)item * 16384 + row * 128 + ch * 8, *(const LAS u32x4*)(Lst + row * 272 + ch * 16)); }
        __syncthreads();
    }
    if (dbgc) { if (dbg_kt) atomicAdd(dbgc + 0, dbg_kt); if (dbg_acc) atomicAdd(dbgc + 1, dbg_acc); }
}
__device__ __forceinline__ void phase_scan_b(bf16_t* LT, const float* DEC) {
    const int n = 2 * NHEAD * 128 * 32;
    for (int idx = blockIdx.x * 512 + threadIdx.x; idx < n; idx += gridDim.x * 512) {
        const int bh = idx >> 12, vk = idx & 4095, k4 = (vk & 31) * 4;
        float S0 = 0.f, S1 = 0.f, S2 = 0.f, S3 = 0.f;
        bf16_t* p = LT + (size_t)bh * 128 * 16384 + (size_t)vk * 4;
        const float* dp = DEC + (size_t)bh * 128 * 128 + k4;
#pragma unroll 8
        for (int c = 0; c < 128; ++c) {
            const u32x2 w = *(const u32x2*)(p + (size_t)c * 16384);
            const f32x4 d = *(const f32x4*)(dp + c * 128);
            u32x2 o; o.x = pk_bf16(S0, S1); o.y = pk_bf16(S2, S3);
            store_wt8(p + (size_t)c * 16384, o);
            S0 = d[0] * S0 + bflo(w.x); S1 = d[1] * S1 + bfhi(w.x); S2 = d[2] * S2 + bflo(w.y); S3 = d[3] * S3 + bfhi(w.y);
        }
    }
}
__device__ __forceinline__ void phase_scan_c(LAS unsigned char* lds, const bf16_t* Q1, const float* LF, const bf16_t* I1, const bf16_t* G1, const bf16_t* SP, const float* gnorm, bf16_t* OG) {
    const int tid = threadIdx.x, lane = tid & 63, wv = tid >> 6, k = tid & 127, part = tid >> 7, r32 = lane & 31, hh = lane >> 5;
    LAS unsigned char* QTimg = lds; LAS unsigned char* QPimg = lds + 16384; LAS unsigned char* KPimg = lds + 32768; LAS unsigned char* Iimg = lds + 49152; LAS unsigned char* SPimg = lds + 65536;
    LAS float* psum = (LAS float*)(lds + 98304);
    LAS float* ssq = (LAS float*)(lds + 100352);
    LAS unsigned char* OT = lds + 102400;
    for (int item = blockIdx.x; item < 2 * NHEAD * 128; item += gridDim.x) {
        const int bh = item >> 7, c = item & 127, b = bh >> 4, h = bh & 15;
        const size_t tok0 = (size_t)b * SEQ + c * 64;
        float lf[16], qv[16];
#pragma unroll
        for (int i = 0; i < 16; ++i) { const size_t o = (tok0 + 16 * part + i) * DM + h * 128 + k; lf[i] = LF[o]; qv[i] = bf2f(Q1[o]); }
#pragma unroll
        for (int r = 0; r < 2; ++r) { const int idx = tid + 512 * r, row = idx >> 4, ch = idx & 15; *(LAS u32x4*)(Iimg + off_b(row, ch)) = *(const u32x4*)(I1 + (tok0 + row) * DM + h * 128 + ch * 8); }
#pragma unroll
        for (int r = 0; r < 4; ++r) { const int idx = tid + 512 * r, row = idx >> 4, ch = idx & 15; *(LAS u32x4*)(SPimg + off_b(row, ch)) = *(const u32x4*)(SP + (size_t)item * 16384 + row * 128 + ch * 8); }
        float cs = 0.f;
#pragma unroll
        for (int i = 0; i < 16; ++i) cs += lf[i];
        psum[part * 128 + k] = cs;
        __syncthreads();
        const float p0 = psum[k], p1 = psum[128 + k], p2 = psum[256 + k];
        const float rr = p0 + p1;
        float bb = part == 0 ? 0.f : (part == 1 ? p0 : (part == 2 ? p0 + p1 : p0 + p1 + p2));
#pragma unroll
        for (int i = 0; i < 16; ++i) {
            bb += lf[i];
            const float qt = qv[i] * __expf(bb), qp = qv[i] * __expf(bb - rr), kp = (1.0f - __expf(lf[i])) * __expf(rr - bb);
            const unsigned o = off_b(16 * part + i, k >> 3) + 2 * (k & 7);
            *(LAS bf16_t*)(QTimg + o) = (bf16_t)(pk_bf16(qt, 0.f) & 0xffffu);
            *(LAS bf16_t*)(QPimg + o) = (bf16_t)(pk_bf16(qp, 0.f) & 0xffffu);
            *(LAS bf16_t*)(KPimg + o) = (bf16_t)(pk_bf16(kp, 0.f) & 0xffffu);
        }
        __syncthreads();
        const int tt = wv & 1, vt = wv >> 1;
        f32x16 O;
#pragma unroll
        for (int e = 0; e < 16; ++e) O[e] = 0.f;
#pragma unroll
        for (int ks = 0; ks < 8; ++ks) {
            const bf16x8 af = *(const LAS bf16x8*)(SPimg + off_b(32 * vt + r32, 2 * ks + hh));
            const bf16x8 bf = *(const LAS bf16x8*)(QTimg + off_b(32 * tt + r32, 2 * ks + hh));
            O = __builtin_amdgcn_mfma_f32_32x32x16_bf16(af, bf, O, 0, 0, 0);
        }
        const unsigned krow = pi32((unsigned)r32);
        for (int st = 0; st <= tt; ++st) {
            f32x16 S;
#pragma unroll
            for (int e = 0; e < 16; ++e) S[e] = 0.f;
#pragma unroll
            for (int ks = 0; ks < 8; ++ks) {
                const bf16x8 af = *(const LAS bf16x8*)(KPimg + off_b(32 * st + krow, 2 * ks + hh));
                const bf16x8 bf = *(const LAS bf16x8*)(QPimg + off_b(32 * tt + r32, 2 * ks + hh));
                S = __builtin_amdgcn_mfma_f32_32x32x16_bf16(af, bf, S, 0, 0, 0);
            }
            float p[16];
#pragma unroll
            for (int e = 0; e < 16; ++e) {
                const unsigned m = (e & 3) + 8 * (e >> 2) + 4 * hh;
                const int sidx = 32 * st + (int)pi32(m), tidx = 32 * tt + r32;
                p[e] = sidx <= tidx ? S[e] : 0.f;
            }
            u32x4 w0, w1;
            w0.x = pk_bf16(p[0], p[1]); w0.y = pk_bf16(p[2], p[3]); w0.z = pk_bf16(p[4], p[5]); w0.w = pk_bf16(p[6], p[7]);
            w1.x = pk_bf16(p[8], p[9]); w1.y = pk_bf16(p[10], p[11]); w1.z = pk_bf16(p[12], p[13]); w1.w = pk_bf16(p[14], p[15]);
            const bf16x8 pf0 = __builtin_bit_cast(bf16x8, w0), pf1 = __builtin_bit_cast(bf16x8, w1);
            const bf16x8 i0 = tr_frag(Iimg, lane, vt, 2 * st), i1 = tr_frag(Iimg, lane, vt, 2 * st + 1);
            O = __builtin_amdgcn_mfma_f32_32x32x16_bf16(i0, pf0, O, 0, 0, 0);
            O = __builtin_amdgcn_mfma_f32_32x32x16_bf16(i1, pf1, O, 0, 0, 0);
        }
        float sq = 0.f;
#pragma unroll
        for (int e = 0; e < 16; ++e) sq += O[e] * O[e];
        sq += __shfl_xor(sq, 32);
        if (hh == 0) ssq[vt * 64 + 32 * tt + r32] = sq;
        __syncthreads();
        const int tl = 32 * tt + r32;
        const float rstd = rsqrtf((ssq[tl] + ssq[64 + tl] + ssq[128 + tl] + ssq[192 + tl]) * (1.0f / 128.0f) + 1e-6f);
#pragma unroll
        for (int g = 0; g < 4; ++g) {
            const int v0 = 32 * vt + 8 * g + 4 * hh;
            const f32x4 gn = *(const f32x4*)(gnorm + v0);
            u32x2 w; w.x = pk_bf16(O[4 * g] * rstd * gn[0], O[4 * g + 1] * rstd * gn[1]); w.y = pk_bf16(O[4 * g + 2] * rstd * gn[2], O[4 * g + 3] * rstd * gn[3]);
            *(LAS u32x2*)(OT + tl * 272 + v0 * 2) = w;
        }
        __syncthreads();
#pragma unroll
        for (int r = 0; r < 2; ++r) {
            const int idx = tid + 512 * r, row = idx >> 4, ch = idx & 15;
            const u32x4 ov = *(const LAS u32x4*)(OT + row * 272 + ch * 16);
            const size_t go = (tok0 + row) * DM + h * 128 + ch * 8;
            const u32x4 gv = *(const u32x4*)(G1 + go);
            u32x4 w;
            w.x = pk_bf16(bflo(ov.x) * bflo(gv.x), bfhi(ov.x) * bfhi(gv.x)); w.y = pk_bf16(bflo(ov.y) * bflo(gv.y), bfhi(ov.y) * bfhi(gv.y));
            w.z = pk_bf16(bflo(ov.z) * bflo(gv.z), bfhi(ov.z) * bfhi(gv.z)); w.w = pk_bf16(bflo(ov.w) * bflo(gv.w), bfhi(ov.w) * bfhi(gv.w));
            *(u32x4*)(OG + go) = w;
        }
        __syncthreads();
    }
}


#if SCAN_DBG == 2
__device__ __forceinline__ void dbg_compare(LAS float* red, const bf16_t* A, const bf16_t* B, float* DBG) {
    float sd = 0.f, sr = 0.f, nn = 0.f;
    const size_t n = (size_t)MTOK * DM;
    for (size_t i = (size_t)blockIdx.x * 512 + threadIdx.x; i < n; i += (size_t)gridDim.x * 512) {
        const float x = bf2f(A[i]), y = bf2f(B[i]);
        if (!(x - x == 0.f)) nn += 1.f; else { sd += (x - y) * (x - y); sr += y * y; }
    }
    sd = wave_sum(sd); sr = wave_sum(sr); nn = wave_sum(nn);
    const int wv = threadIdx.x >> 6;
    if ((threadIdx.x & 63) == 0) { red[wv * 3] = sd; red[wv * 3 + 1] = sr; red[wv * 3 + 2] = nn; }
    __syncthreads();
    if (threadIdx.x == 0) { float a = 0, b = 0, c = 0; for (int w = 0; w < 8; ++w) { a += red[w * 3]; b += red[w * 3 + 1]; c += red[w * 3 + 2]; } DBG[blockIdx.x * 4] = a; DBG[blockIdx.x * 4 + 1] = b; DBG[blockIdx.x * 4 + 2] = c; }
    __syncthreads();
}
__device__ __forceinline__ void dbg_emit(const float* DBG, float* out) {
    float a = 0, b = 0, c = 0;
    for (int w = 0; w < (int)gridDim.x; ++w) { a += DBG[w * 4]; b += DBG[w * 4 + 1]; c += DBG[w * 4 + 2]; }
    const float rel = sqrtf(a / b);
    int k = (int)rintf(-2.0f * log10f(rel)); k = k < 0 ? 0 : (k > 16 ? 16 : k);
    if (c > 0.f) k = 17;
    const float cc = sqrtf(0.5f * (float)k);
    const size_t n = (size_t)MTOK * DM;
    for (size_t i = (size_t)blockIdx.x * 512 + threadIdx.x; i < n; i += (size_t)gridDim.x * 512) out[i] = cc;
}
#endif

#if SCAN_DBG == 3
__device__ __forceinline__ void dbg_count_bf16(const bf16_t* A, size_t n, unsigned* cnt) {
    unsigned c = 0;
    for (size_t i = (size_t)blockIdx.x * 512 + threadIdx.x; i < n; i += (size_t)gridDim.x * 512) { const float x = bf2f(A[i]); if (!(x - x == 0.f)) ++c; }
    if (c) atomicAdd(cnt, c);
}
__device__ __forceinline__ void dbg_count_f32(const float* A, size_t n, unsigned* cnt) {
    unsigned c = 0;
    for (size_t i = (size_t)blockIdx.x * 512 + threadIdx.x; i < n; i += (size_t)gridDim.x * 512) { const float x = A[i]; if (!(x - x == 0.f)) ++c; }
    if (c) atomicAdd(cnt, c);
}
__device__ __forceinline__ void dbg_emit3(const unsigned* cnt, float* out) {
    float code = 0.f;
    for (int st = 3; st >= 0; --st) { const unsigned c = cnt[st]; if (c) { float lg = log10f((float)c); lg = lg > 9.f ? 9.f : lg; code = (float)(st + 1) + 0.1f * lg; } }
    const float cc = sqrtf(code);
    const size_t n = (size_t)MTOK * DM;
    for (size_t i = (size_t)blockIdx.x * 512 + threadIdx.x; i < n; i += (size_t)gridDim.x * 512) out[i] = cc;
}
#endif

#if SCAN_DBG == 4 || SCAN_DBG == 6
__device__ __forceinline__ void dbg_compare4(LAS float* red, const bf16_t* A, const bf16_t* B, const bf16_t* C, float* DBG) {
    float sd = 0.f, sr = 0.f, nn = 0.f, mm = 0.f;
    const size_t n = (size_t)MTOK * DM;
    for (size_t i = (size_t)blockIdx.x * 512 + threadIdx.x; i < n; i += (size_t)gridDim.x * 512) {
        const float x = bf2f(A[i]), y = bf2f(B[i]);
        if (!(x - x == 0.f)) nn += 1.f; else { sd += (x - y) * (x - y); sr += y * y; }
        if (A[i] != C[i]) mm += 1.f;
    }
    sd = wave_sum(sd); sr = wave_sum(sr); nn = wave_sum(nn); mm = wave_sum(mm);
    const int wv = threadIdx.x >> 6;
    if ((threadIdx.x & 63) == 0) { red[wv * 4] = sd; red[wv * 4 + 1] = sr; red[wv * 4 + 2] = nn; red[wv * 4 + 3] = mm; }
    __syncthreads();
    if (threadIdx.x == 0) { float a = 0, b = 0, c = 0, d = 0; for (int w = 0; w < 8; ++w) { a += red[w * 4]; b += red[w * 4 + 1]; c += red[w * 4 + 2]; d += red[w * 4 + 3]; }
        DBG[blockIdx.x * 4] = a; DBG[blockIdx.x * 4 + 1] = b; DBG[blockIdx.x * 4 + 2] = c; DBG[blockIdx.x * 4 + 3] = d; }
    __syncthreads();
}
__device__ __forceinline__ void dbg_emit4(const float* DBG, float* out) {
    float a = 0, b = 0, c = 0, d = 0;
    for (int w = 0; w < (int)gridDim.x; ++w) { a += DBG[w * 4]; b += DBG[w * 4 + 1]; c += DBG[w * 4 + 2]; d += DBG[w * 4 + 3]; }
    const float rel = sqrtf(a / b);
    int k = (int)rintf(-log10f(rel)); k = k < 0 ? 0 : (k > 8 ? 8 : k);
#if SCAN_DBG == 6
    const float cc = sqrtf((float)k + ((d + c) > 0.f ? 0.5f : 0.f));
#else
    int m = (int)ceilf(log10f(1.0f + d + c)); m = m > 9 ? 9 : m;
    const float cc = sqrtf((float)k + 0.1f * (float)m);
#endif
    const size_t n = (size_t)MTOK * DM;
    for (size_t i = (size_t)blockIdx.x * 512 + threadIdx.x; i < n; i += (size_t)gridDim.x * 512) out[i] = cc;
}
#endif

#if SCAN_DBG == 5
__device__ __forceinline__ void dbg_lds16_test(LAS unsigned char* lds, unsigned* cnt) {
    const int tid = threadIdx.x;
    unsigned bad = 0;
    for (int rep = 0; rep < 64; ++rep) {
        for (int i = tid; i < 1024; i += 512) *(LAS u32x4*)(lds + i * 16) = (u32x4){0x7fc07fc0u, 0x7fc07fc0u, 0x7fc07fc0u, 0x7fc07fc0u};
        __syncthreads();
        const int k = tid & 127, part = tid >> 7;
#pragma unroll
        for (int i = 0; i < 16; ++i) {
            const int row = 16 * part + i;
            *(LAS bf16_t*)(lds + off_b(row, k >> 3) + 2 * (k & 7)) = (bf16_t)((row * 128 + k + rep) & 0x7fff);
        }
        __syncthreads();
        for (int idx = tid; idx < 64 * 128; idx += 512) {
            const int row = idx >> 7, kk = idx & 127;
            const bf16_t got = *(const LAS bf16_t*)(lds + off_b(row, kk >> 3) + 2 * (kk & 7));
            if (got != (bf16_t)((row * 128 + kk + rep) & 0x7fff)) ++bad;
        }
        __syncthreads();
    }
    if (bad) atomicAdd(cnt, bad);
}
__device__ __forceinline__ void dbg_emit5(const unsigned* cnt, float* out) {
    const unsigned c = cnt[0];
    float code = 0.f;
    if (c) { float lg = log10f((float)c); code = 1.0f + (lg > 8.9f ? 8.9f : lg); }
    const float cc = sqrtf(code);
    const size_t n = (size_t)MTOK * DM;
    for (size_t i = (size_t)blockIdx.x * 512 + threadIdx.x; i < n; i += (size_t)gridDim.x * 512) out[i] = cc;
}
#endif

#if SCAN_DBG == 6
__device__ __forceinline__ void dbg_check_a(LAS float* red, const float* LF, const bf16_t* I1, const bf16_t* LT, const bf16_t* LT2, float* DBG) {
    float sd = 0.f, sr = 0.f, mm = 0.f;
    const size_t n = (size_t)4096 * 16384;
    for (size_t i = (size_t)blockIdx.x * 512 + threadIdx.x; i < n; i += (size_t)gridDim.x * 512) {
        const int item = (int)(i >> 14), v = (int)((i >> 7) & 127), k = (int)(i & 127);
        const int bh = item >> 7, c = item & 127, b = bh >> 4, h = bh & 15;
        const size_t tok0 = (size_t)b * SEQ + c * 64;
        float g = 1.f, L = 0.f;
        for (int s2 = 63; s2 >= 0; --s2) {
            const size_t o = (tok0 + s2) * DM + h * 128;
            const float f = __expf(LF[o + k]);
            L += bf2f(I1[o + v]) * (1.0f - f) * g;
            g *= f;
        }
        const float x = bf2f(LT[i]);
        sd += (x - L) * (x - L); sr += L * L;
        if (LT[i] != LT2[i]) mm += 1.f;
    }
    sd = wave_sum(sd); sr = wave_sum(sr); mm = wave_sum(mm);
    const int wv = threadIdx.x >> 6;
    if ((threadIdx.x & 63) == 0) { red[wv * 4] = sd; red[wv * 4 + 1] = sr; red[wv * 4 + 2] = 0.f; red[wv * 4 + 3] = mm; }
    __syncthreads();
    if (threadIdx.x == 0) { float a = 0, b2 = 0, d = 0; for (int w = 0; w < 8; ++w) { a += red[w * 4]; b2 += red[w * 4 + 1]; d += red[w * 4 + 3]; }
        DBG[blockIdx.x * 4] = a; DBG[blockIdx.x * 4 + 1] = b2; DBG[blockIdx.x * 4 + 2] = 0.f; DBG[blockIdx.x * 4 + 3] = d; }
    __syncthreads();
}
#endif

#if SCAN_DBG == 7
#ifndef DBG_FAM
#define DBG_FAM 0
#endif
__device__ __forceinline__ void dbg_check_a7(const float* LF, const bf16_t* I1, const bf16_t* LT, float* DBG) {
    const size_t n = (size_t)4096 * 16384;
    float nbad = 0.f, nnf = 0.f;
    for (size_t i = (size_t)blockIdx.x * 512 + threadIdx.x; i < n; i += (size_t)gridDim.x * 512 * 8) {
        const int item = (int)(i >> 14), v = (int)((i >> 7) & 127), k = (int)(i & 127);
        const int bh = item >> 7, c = item & 127, b = bh >> 4, h = bh & 15;
        const size_t tok0 = (size_t)b * SEQ + c * 64;
        float g = 1.f, L = 0.f;
        for (int s2 = 63; s2 >= 0; --s2) {
            const size_t o = (tok0 + s2) * DM + h * 128;
            const float f = __expf(LF[o + k]);
            L += bf2f(I1[o + v]) * (1.0f - f) * g;
            g *= f;
        }
        const float x = bf2f(LT[i]);
        if (!(x - x == 0.f)) { nnf += 1.f; nbad += 1.f; }
        else if (fabsf(x - L) > 0.02f * fabsf(L) + 1e-2f) nbad += 1.f;
    }
    nbad = wave_sum(nbad); nnf = wave_sum(nnf);
    if ((threadIdx.x & 63) == 0) { atomicAdd(DBG, nbad); atomicAdd(DBG + 1, nnf); }
}
__device__ __forceinline__ void dbg_emit7(const float* DBG, float* out) {
    const float nb = DBG[0], nf = DBG[1];
    int A = nb == 0.f ? 0 : (nb <= 100.f ? 1 : (nb <= 1e4f ? 3 : (nb <= 1e6f ? 5 : 7)));
    int B = nf == 0.f ? 0 : 5;
    const float cc = sqrtf((float)A + 0.1f * (float)B);
    const size_t n = (size_t)MTOK * DM;
    for (size_t i = (size_t)blockIdx.x * 512 + threadIdx.x; i < n; i += (size_t)gridDim.x * 512) out[i] = cc;
}
#endif
__device__ __forceinline__ int opaque(int v) { asm volatile("" : "+s"(v)); return v; }
template <bool L1> __device__ __forceinline__ void run_gemm_out(const Args& a, LAS unsigned char* lds) {
    unsigned char* ws = a.ws;
    pg8::Gemm g{(const bf16_t*)(ws + (L1 ? slot(3) : slot(0))), (const bf16_t*)(ws + (L1 ? WS_WO : WS_WOUT)), opaque(MTOK), opaque(DM), opaque(DM)};
    pg8::StaticOrder S; S.init(g.M, g.N, (int)gridDim.x, (int)blockIdx.x);
    EpiRes E{L1 ? (const float*)(ws + slot(0)) : a.in[0], (float*)(ws + (L1 ? slot(4) : slot(1)))};
    pg8::gemm_phase<EpiRes, pg8::StaticOrder>(lds, g, S, E, nullptr);
}
template <bool L1> __device__ __forceinline__ void run_ln(const Args& a) {
    unsigned char* ws = a.ws;
    phase_ln((const float*)(ws + (L1 ? slot(4) : slot(1))), a.in[12] + (L1 ? 2 : 0) * DM, a.in[13] + (L1 ? 2 : 0) * DM,
             (float*)(ws + (L1 ? slot(6) : slot(3))), (bf16_t*)(ws + (L1 ? slot(8) : slot(5))), (signed char*)(ws + WS_XQ), (float*)(ws + WS_XS));
}
template <bool L1> __device__ __forceinline__ void run_gemm_sc(const Args& a, LAS unsigned char* lds) {
    unsigned char* ws = a.ws;
    pg8::Gemm g{(const bf16_t*)(ws + WS_WC) + (L1 ? (size_t)DM * DM : 0), (const bf16_t*)(ws + (L1 ? slot(8) : slot(5))), opaque(DM), opaque(MTOK), opaque(DM)};
    pg8::StaticOrder S; S.init(g.M, g.N, (int)gridDim.x, (int)blockIdx.x);
    EpiF32 E{(float*)(ws + (L1 ? slot(0) : slot(6))), MTOK};
    pg8::gemm_phase<EpiF32, pg8::StaticOrder>(lds, g, S, E, nullptr);
}
template <bool L1> __device__ __forceinline__ void run_topk(const Args& a, LAS unsigned char* lds) {
    unsigned char* ws = a.ws;
    phase_topk(lds, (const float*)(ws + (L1 ? slot(0) : slot(6))), (int*)(ws + WS_EID), (float*)(ws + WS_GATE));
}
template <bool L1> __device__ __forceinline__ void run_peer(const Args& a, LAS unsigned char* lds) {
    unsigned char* ws = a.ws;
    LAS int* HL = (LAS int*)(lds + (threadIdx.x >> 6) * 8192);
    float* Y = (float*)(ws + (L1 ? slot(0) : slot(6)));
    phase_peer_u((const signed char*)(ws + WS_XQ), (const int*)(ws + WS_EID), ws + WS_UB + (L1 ? (size_t)16384 * DM : 0), HL);
    asm volatile("s_waitcnt vmcnt(0) lgkmcnt(0)" ::: "memory");
    phase_peer_w(HL, (const float*)(ws + WS_XS), (const int*)(ws + WS_EID), (const float*)(ws + WS_GATE),
                 (const float*)(ws + WS_USC) + (L1 ? 16384 : 0), (const float*)(ws + WS_VSC) + (L1 ? 16384 : 0), (float*)(ws + WS_W), (float*)(ws + WS_CS));
    asm volatile("s_waitcnt vmcnt(0)" ::: "memory");
    phase_peer_v((const float*)(ws + (L1 ? slot(6) : slot(3))), (const int*)(ws + WS_EID), (const float*)(ws + WS_W), (const float*)(ws + WS_CS),
                 ws + WS_VB + (L1 ? (size_t)16384 * DM : 0), Y);
    asm volatile("s_waitcnt vmcnt(0)" ::: "memory");
    {
        const int lane = threadIdx.x & 63, gw = blockIdx.x * 8 + (threadIdx.x >> 6), nw = gridDim.x * 8, tpw = (MTOK + nw - 1) / nw, tbase = gw * tpw;
        const int tend = tbase + tpw < MTOK ? tbase + tpw : MTOK;
        const float* g = a.in[12] + (L1 ? 3 : 1) * DM; const float* bta = a.in[13] + (L1 ? 3 : 1) * DM;
        float* outf = L1 ? a.out : (float*)(ws + slot(0)); bf16_t* outb = L1 ? (bf16_t*)nullptr : (bf16_t*)(ws + slot(2));
        for (int row = tbase; row < tend; ++row) {
            float v[32];
            const float* p = Y + (size_t)row * DM;
#pragma unroll
            for (int i = 0; i < 4; ++i) {
                const f32x4 x0 = *(const f32x4*)(p + 512 * i + 8 * lane), x1 = *(const f32x4*)(p + 512 * i + 8 * lane + 4);
#pragma unroll
                for (int j = 0; j < 4; ++j) { v[i * 8 + j] = x0[j]; v[i * 8 + 4 + j] = x1[j]; }
            }
            ln_row_store(v, g, bta, outf + (size_t)row * DM, outb ? outb + (size_t)row * DM : nullptr, lane);
        }
    }
}

__global__ void __launch_bounds__(512, 2) mk_fwd(Args a) {
    extern __shared__ __attribute__((aligned(16))) unsigned char lds_raw[];
    LAS unsigned char* lds = (LAS unsigned char*)lds_raw;
    cg::grid_group grid = cg::this_grid();
    unsigned char* ws = a.ws;
#define PHASE_BEGIN(k) if (a.ph_lo <= (k) && (k) < a.ph_hi && EN(k)) {
#define PHASE_END(k) asm volatile("s_waitcnt vmcnt(0)" ::: "memory"); __syncthreads(); if ((k) + 1 < a.ph_hi) { grid.sync(); if (threadIdx.x < 64) { __builtin_amdgcn_fence(__ATOMIC_ACQUIRE, "agent"); asm volatile("s_waitcnt vmcnt(0)" ::: "memory"); } __syncthreads(); } }
    PHASE_BEGIN(0) phase_prep(a, lds);
#if SCAN_DBG == 3 || SCAN_DBG == 5
        if (blockIdx.x == 0 && threadIdx.x < 8) ((unsigned*)(ws + WS_CTR + 8192))[threadIdx.x] = 0u;
#endif
#if SCAN_DBG == 7
        if (blockIdx.x == 0 && threadIdx.x < 32) ((float*)(ws + WS_CTR + 4096))[threadIdx.x] = 0.f;
#endif
    PHASE_END(0)
#if SCAN_DBG == 5
    PHASE_BEGIN(1) dbg_lds16_test(lds, (unsigned*)(ws + WS_CTR + 8192)); PHASE_END(1)
#define SKIP_REST 1
#endif
    PHASE_BEGIN(1) {
        pg8::Gemm g{(const bf16_t*)(ws + slot(0)), (const bf16_t*)(ws + WS_WIN), opaque(MTOK), opaque(4 * DM), opaque(DM)};
        pg8::StaticOrder S; S.init(g.M, g.N, (int)gridDim.x, (int)blockIdx.x);
        EpiIn E{(bf16_t*)(ws + slot(1)), (float*)(ws + slot(4)), (bf16_t*)(ws + slot(2)), (bf16_t*)(ws + slot(3)), (const float*)(ws + WS_LB)};
        pg8::gemm_phase<EpiIn, pg8::StaticOrder>(lds, g, S, E, nullptr);
    } PHASE_END(1)
    PHASE_BEGIN(2) phase_scan_a(lds, (const float*)(ws + slot(4)), (const bf16_t*)(ws + slot(2)), (bf16_t*)(ws + slot(6)), (float*)(ws + WS_DEC)
#if SCAN_DBG == 3
        , (unsigned*)(ws + WS_CTR + 8192)
#endif
        );
#if SCAN_DBG == 7
        asm volatile("s_waitcnt vmcnt(0)" ::: "memory"); __syncthreads(); grid.sync(); if (threadIdx.x < 64) { __builtin_amdgcn_fence(__ATOMIC_ACQUIRE, "agent"); asm volatile("s_waitcnt vmcnt(0)" ::: "memory"); } __syncthreads();
        dbg_check_a7((const float*)(ws + slot(4)), (const bf16_t*)(ws + slot(2)), (const bf16_t*)(ws + slot(6)), (float*)(ws + WS_CTR + 4096));
#endif
#if SCAN_DBG == 6
#define DSYNC6() asm volatile("s_waitcnt vmcnt(0)" ::: "memory"); __syncthreads(); grid.sync(); if (threadIdx.x < 64) { __builtin_amdgcn_fence(__ATOMIC_ACQUIRE, "agent"); asm volatile("s_waitcnt vmcnt(0)" ::: "memory"); } __syncthreads();
        DSYNC6()
        phase_scan_a(lds, (const float*)(ws + slot(4)), (const bf16_t*)(ws + slot(2)), (bf16_t*)a.out, (float*)(ws + WS_DEC));
        DSYNC6()
        dbg_check_a((LAS float*)lds, (const float*)(ws + slot(4)), (const bf16_t*)(ws + slot(2)), (const bf16_t*)(ws + slot(6)), (const bf16_t*)a.out, (float*)(ws + WS_CTR + 4096));
#endif
#if SCAN_DBG == 3
        asm volatile("s_waitcnt vmcnt(0)" ::: "memory"); __syncthreads(); grid.sync();
        dbg_count_bf16((const bf16_t*)(ws + slot(6)), (size_t)4096 * 16384, (unsigned*)(ws + WS_CTR + 8192) + 2);
#endif
    PHASE_END(2)
    PHASE_BEGIN(3) phase_scan_b((bf16_t*)(ws + slot(6)), (const float*)(ws + WS_DEC));
#if SCAN_DBG == 3
        asm volatile("s_waitcnt vmcnt(0)" ::: "memory"); __syncthreads(); grid.sync();

#endif
    PHASE_END(3)
    PHASE_BEGIN(4) phase_scan_c(lds, (const bf16_t*)(ws + slot(1)), (const float*)(ws + slot(4)), (const bf16_t*)(ws + slot(2)), (const bf16_t*)(ws + slot(3)), (const bf16_t*)(ws + slot(6)), a.in[2], (bf16_t*)(ws + slot(0)));
#if SCAN_DBG == 1
        asm volatile("s_waitcnt vmcnt(0)" ::: "memory"); __syncthreads(); grid.sync();
        phase_scan_naive((const bf16_t*)(ws + slot(1)), (const float*)(ws + slot(4)), (const bf16_t*)(ws + slot(2)), (float*)(ws + slot(6)));
        asm volatile("s_waitcnt vmcnt(0)" ::: "memory"); __syncthreads(); grid.sync();
        phase_onorm((const float*)(ws + slot(6)), (const bf16_t*)(ws + slot(3)), a.in[2], (bf16_t*)(ws + slot(0)));
#endif
#if SCAN_DBG == 3
        asm volatile("s_waitcnt vmcnt(0)" ::: "memory"); __syncthreads(); grid.sync();

#endif
#if SCAN_DBG == 4
#define DSYNC() asm volatile("s_waitcnt vmcnt(0)" ::: "memory"); __syncthreads(); grid.sync(); if (threadIdx.x < 64) { __builtin_amdgcn_fence(__ATOMIC_ACQUIRE, "agent"); asm volatile("s_waitcnt vmcnt(0)" ::: "memory"); } __syncthreads();
        DSYNC()
        phase_scan_naive((const bf16_t*)(ws + slot(1)), (const float*)(ws + slot(4)), (const bf16_t*)(ws + slot(2)), (float*)(ws + slot(6)));
        DSYNC()
        phase_onorm((const float*)(ws + slot(6)), (const bf16_t*)(ws + slot(3)), a.in[2], (bf16_t*)(ws + slot(8)));
        DSYNC()
        phase_scan_a(lds, (const float*)(ws + slot(4)), (const bf16_t*)(ws + slot(2)), (bf16_t*)(ws + slot(6)), (float*)(ws + WS_DEC));
        DSYNC()
        phase_scan_b((bf16_t*)(ws + slot(6)), (const float*)(ws + WS_DEC));
        DSYNC()
        phase_scan_c(lds, (const bf16_t*)(ws + slot(1)), (const float*)(ws + slot(4)), (const bf16_t*)(ws + slot(2)), (const bf16_t*)(ws + slot(3)), (const bf16_t*)(ws + slot(6)), a.in[2], (bf16_t*)a.out);
        DSYNC()
        dbg_compare4((LAS float*)lds, (const bf16_t*)(ws + slot(0)), (const bf16_t*)(ws + slot(8)), (const bf16_t*)a.out, (float*)(ws + WS_CTR + 4096));
#endif
#if SCAN_DBG == 2
        asm volatile("s_waitcnt vmcnt(0)" ::: "memory"); __syncthreads(); grid.sync();
        phase_scan_naive((const bf16_t*)(ws + slot(1)), (const float*)(ws + slot(4)), (const bf16_t*)(ws + slot(2)), (float*)(ws + slot(6)));
        asm volatile("s_waitcnt vmcnt(0)" ::: "memory"); __syncthreads(); grid.sync();
        phase_onorm((const float*)(ws + slot(6)), (const bf16_t*)(ws + slot(3)), a.in[2], (bf16_t*)(ws + slot(8)));
        asm volatile("s_waitcnt vmcnt(0)" ::: "memory"); __syncthreads(); grid.sync();
        dbg_compare((LAS float*)lds, (const bf16_t*)(ws + slot(0)), (const bf16_t*)(ws + slot(8)), (float*)(ws + WS_CTR + 4096));
#endif
    PHASE_END(4)
    PHASE_BEGIN(5) run_gemm_out<false>(a, lds); PHASE_END(5)
    PHASE_BEGIN(6) run_ln<false>(a); PHASE_END(6)
    PHASE_BEGIN(7) run_gemm_sc<false>(a, lds); PHASE_END(7)
    PHASE_BEGIN(8) run_topk<false>(a, lds); PHASE_END(8)
    PHASE_BEGIN(9) run_peer<false>(a, lds); PHASE_END(9)
    PHASE_BEGIN(10) {
        pg8::Gemm g{(const bf16_t*)(ws + slot(2)), (const bf16_t*)(ws + WS_WKVQ), opaque(MTOK), opaque(3 * DM), opaque(DM)};
        pg8::StaticOrder S; S.init(g.M, g.N, (int)gridDim.x, (int)blockIdx.x);
        EpiKVQ E{(bf16_t*)(ws + slot(3)), (bf16_t*)(ws + slot(4)), (bf16_t*)(ws + slot(5))};
        pg8::gemm_phase<EpiKVQ, pg8::StaticOrder>(lds, g, S, E, nullptr);
    } PHASE_END(10)
    PHASE_BEGIN(11) phase_rot((LAS float*)lds, (bf16_t*)(ws + slot(3)), (bf16_t*)(ws + slot(5)), (const float*)(ws + WS_COS), (const float*)(ws + WS_SIN), (float*)(ws + WS_KMEAN), (float*)(ws + WS_KNMAX)); PHASE_END(11)
    PHASE_BEGIN(12) phase_sel(lds, (const bf16_t*)(ws + slot(5)), (const float*)(ws + WS_KMEAN), (unsigned short*)(ws + WS_SUB), (int*)(ws + WS_CNT), (int*)(ws + WS_CTR)); PHASE_END(12)
    PHASE_BEGIN(13) phase_att(lds, (const bf16_t*)(ws + slot(5)), (const bf16_t*)(ws + slot(3)), (const bf16_t*)(ws + slot(4)), (const float*)(ws + WS_KNMAX), (const unsigned short*)(ws + WS_SUB),
                              (const int*)(ws + WS_CNT), (int*)(ws + WS_CTR), (bf16_t*)(ws + slot(6)), (bf16_t*)(ws + slot(2)), (float*)(ws + WS_LS)); PHASE_END(13)
    PHASE_BEGIN(14) phase_comb((const bf16_t*)(ws + slot(6)), (const bf16_t*)(ws + slot(2)), (const float*)(ws + WS_LS), (bf16_t*)(ws + slot(3))); PHASE_END(14)
    PHASE_BEGIN(15) run_gemm_out<true>(a, lds); PHASE_END(15)
    PHASE_BEGIN(16) run_ln<true>(a); PHASE_END(16)
    PHASE_BEGIN(17) run_gemm_sc<true>(a, lds); PHASE_END(17)
    PHASE_BEGIN(18) run_topk<true>(a, lds); PHASE_END(18)
#if SCAN_DBG == 7
    PHASE_BEGIN(19) dbg_emit7((const float*)(ws + WS_CTR + 4096), a.out); PHASE_END(19)
#elif SCAN_DBG == 6
    PHASE_BEGIN(19) dbg_emit4((const float*)(ws + WS_CTR + 4096), a.out); PHASE_END(19)
#elif SCAN_DBG == 5
    PHASE_BEGIN(19) dbg_emit5((const unsigned*)(ws + WS_CTR + 8192), a.out); PHASE_END(19)
#elif SCAN_DBG == 4
    PHASE_BEGIN(19) dbg_emit4((const float*)(ws + WS_CTR + 4096), a.out); PHASE_END(19)
#elif SCAN_DBG == 3
    PHASE_BEGIN(19) dbg_emit3((const unsigned*)(ws + WS_CTR + 8192), a.out); PHASE_END(19)
#elif SCAN_DBG == 2
    PHASE_BEGIN(19) dbg_emit((const float*)(ws + WS_CTR + 4096), a.out); PHASE_END(19)
#else
    PHASE_BEGIN(19) run_peer<true>(a, lds); PHASE_END(19)
#endif
}

extern "C" void kernel_launch(void* const* d_in, const int* in_sizes, int n_in, void* d_out, int out_size, void* d_ws, size_t ws_size, hipStream_t stream) {
    static int grid = 0;
    if (grid == 0) {
        if (n_in != 14 || out_size != MTOK * DM || ws_size < WS_END) { fprintf(stderr, "kernel_launch: unexpected shapes (n_in %d, out %d, ws %zu)\n", n_in, out_size, ws_size); grid = -1; return; }
        int dev = 0, cus = 0, per_cu = 0;
        if (hipGetDevice(&dev) != hipSuccess || hipDeviceGetAttribute(&cus, hipDeviceAttributeMultiprocessorCount, dev) != hipSuccess) { grid = -1; return; }
        if (hipFuncSetAttribute((const void*)mk_fwd, hipFuncAttributeMaxDynamicSharedMemorySize, LDS_BYTES) != hipSuccess) { fprintf(stderr, "kernel_launch: hipFuncSetAttribute failed\n"); grid = -1; return; }
        if (hipOccupancyMaxActiveBlocksPerMultiprocessor(&per_cu, (const void*)mk_fwd, 512, LDS_BYTES) != hipSuccess || per_cu < 1) { fprintf(stderr, "kernel_launch: occupancy query failed (%d)\n", per_cu); (void)hipGetLastError(); per_cu = 1; }
        grid = cus * (per_cu > 1 ? 1 : per_cu);
    }
    if (grid < 0) return;
    Args a{};
    for (int i = 0; i < 14; ++i) a.in[i] = (const float*)d_in[i];
    a.out = (float*)d_out; a.ws = (unsigned char*)d_ws;
#if ONE_LAUNCH
    a.ph_lo = 0; a.ph_hi = NPH;
    void* args[] = {&a};
    hipError_t e = hipLaunchCooperativeKernel((const void*)mk_fwd, dim3(grid), dim3(512), args, LDS_BYTES, stream);
    if (e != hipSuccess) fprintf(stderr, "cooperative launch failed: %s (grid %d)\n", hipGetErrorString(e), grid);
#else
    for (int ph = 0; ph < NPH; ++ph) {
        a.ph_lo = ph; a.ph_hi = ph + 1;
        hipLaunchKernelGGL(mk_fwd, dim3(grid), dim3(512), LDS_BYTES, stream, a);
    }
#endif
}
```

```cpp
#define ONE_LAUNCH 1
#include <hip/hip_runtime.h>
#include <hip/hip_cooperative_groups.h>
#include <cstdio>
namespace cg = cooperative_groups;

#ifndef ONE_LAUNCH
#define ONE_LAUNCH 0
#endif
#ifndef SCAN_DBG
#define SCAN_DBG 0
#endif
#ifndef SCAN_A_VALU
#define SCAN_A_VALU 0
#endif
#ifndef ENMASK
#define ENMASK 0xffffffffu
#endif
#define EN(k) ((ENMASK >> (k)) & 1u)

namespace pg8 {
#define PG8_LAS __attribute__((address_space(3)))
typedef unsigned short bf16_t;
typedef short bf16x8 __attribute__((ext_vector_type(8)));
typedef float f32x4 __attribute__((ext_vector_type(4)));
typedef unsigned u32x4 __attribute__((ext_vector_type(4)));
constexpr int BM = 256, BK = 64, HALF = 128, HTB = HALF * BK * 2  , STAGE_BYTES = 8 * HTB, NXCD = 8, WGM = 8;

__host__ __device__ __forceinline__ int lds_byte(int r, int c) { const int st = (r >> 4) * 2 + (c >> 5), rr = r & 15, cc = c & 31, ob = rr * 64 + cc * 2; return st * 1024 + (ob ^ (((ob >> 9) & 1) << 5)); }
__host__ __device__ __forceinline__ void stage_rc(int b, int& R, int& C) { const int st = b / 1024, sb = b % 1024, swz = sb ^ (((sb >> 9) & 1) << 5); R = (st >> 1) * 16 + swz / 64; C = (st & 1) * 32 + (swz % 64) / 2; }
__host__ __device__ __forceinline__ int perm32(int rho) { const int n = rho >> 4, i = rho & 15; return 8 * (i >> 2) + 4 * n + (i & 3); }

struct Unit { int pm, pn; };
struct Gemm { const bf16_t* A; const bf16_t* Bt; int M, N, K; };

struct StaticOrder {
    int nM, nN, nwg, G, c;
    __host__ __device__ void init(int M, int N, int G_, int c_) { nM = M / BM; nN = N / BM; nwg = nM * nN; G = G_; c = c_; }
    __host__ __device__ bool next(int i, Unit& u) const {
        const long L = (long)i * G + c; if (L >= nwg) return false;
        int wgid = (int)L; { const int q = nwg / NXCD, r = nwg % NXCD, xcd = wgid % NXCD, off = wgid / NXCD; wgid = (xcd < r ? xcd * (q + 1) : r * (q + 1) + (xcd - r) * q) + off; }
        const int nig = WGM * nN, gid = wgid / nig, fm = gid * WGM, gsz = (nM - fm) < WGM ? (nM - fm) : WGM;
        u.pm = fm + ((wgid % nig) % gsz); u.pn = (wgid % nig) / gsz; return true;
    }
    __device__ __forceinline__ void a_ready(const Unit&) const {}
    __device__ __forceinline__ void done(const Unit&) const {}
};
struct CountedOrder : StaticOrder {
    const unsigned* ready; unsigned need; unsigned* tmo;
    __device__ __forceinline__ void a_ready(const Unit& u) const {
        if (threadIdx.x < 64) {
            const unsigned long long t0 = __builtin_amdgcn_s_memrealtime(); unsigned polls = 0;
            while ((unsigned)__builtin_amdgcn_readfirstlane(__hip_atomic_load(ready + 64 * u.pm, __ATOMIC_RELAXED, __HIP_MEMORY_SCOPE_AGENT)) < need) {
                if ((++polls & 255u) == 0u && __builtin_amdgcn_readfirstlane(__hip_atomic_load(tmo, __ATOMIC_RELAXED, __HIP_MEMORY_SCOPE_AGENT)) != 0u) break;
                if (__builtin_amdgcn_s_memrealtime() - t0 > 2000000ull) {
                    if (threadIdx.x == 0) { unsigned expect = 0u; __hip_atomic_compare_exchange_strong(tmo + 1, &expect, 0x600u | (unsigned)(u.pm & 0xff), __ATOMIC_RELAXED, __ATOMIC_RELAXED, __HIP_MEMORY_SCOPE_AGENT); __hip_atomic_store(tmo, 1u, __ATOMIC_RELAXED, __HIP_MEMORY_SCOPE_AGENT); }
                    break; }
                __builtin_amdgcn_s_sleep(2); }
            __builtin_amdgcn_fence(__ATOMIC_ACQUIRE, "agent");
            asm volatile("s_waitcnt vmcnt(0)" ::: "memory");
        }
#if !defined(BROKEN_HOOK_NO_BARRIER)
        asm volatile("" ::: "memory"); __builtin_amdgcn_s_barrier(); asm volatile("" ::: "memory");
#endif
    }
};

__device__ __forceinline__ unsigned cvt_pk_bf16(float lo, float hi) { unsigned r; asm volatile("v_cvt_pk_bf16_f32 %0, %1, %2" : "=v"(r) : "v"(lo), "v"(hi)); return r; }
typedef float f32x2 __attribute__((ext_vector_type(2)));
__device__ __forceinline__ f32x2 gelu_pk(f32x2 v) {
    const f32x2 av = __builtin_elementwise_abs(v), d = av * 0.2316418882f + 1.0f;
    f32x2 t; t.x = __builtin_amdgcn_rcpf(d.x); t.y = __builtin_amdgcn_rcpf(d.y);
    f32x2 q = t * 0.5307027145f + (-0.7265760135f); q = q * t + 0.7107068705f; q = q * t + (-0.142248368f); q = q * t + 0.127414796f; q = q * t;
    const f32x2 s = (v * v) * (-0.72134752044f);
    f32x2 e; e.x = __builtin_amdgcn_exp2f(s.x); e.y = __builtin_amdgcn_exp2f(s.y);
    const f32x2 m = v * (q * e), r = v - m;
    f32x2 o; o.x = v.x < 0.f ? m.x : r.x; o.y = v.y < 0.f ? m.y : r.y; return o;
}

struct EpiF32 {
    static constexpr bool PERM = false, AFTER_DRAIN = false;
    float* C; int ldc; const float* bias;
    __device__ __forceinline__ void operator()(const f32x4 (&acc)[2][2][4][2], const Unit& u, int wr, int wc, int fr, int fq) const {
        const int row0 = u.pm * BM + wr * 64 + fr, col0 = u.pn * BM + wc * 32 + 4 * fq;
        f32x4 bv[2][2];
#pragma unroll
        for (int bj = 0; bj < 2; ++bj)
#pragma unroll
            for (int n = 0; n < 2; ++n) bv[bj][n] = bias ? *(const f32x4*)(bias + col0 + bj * HALF + n * 16) : (f32x4){0.f, 0.f, 0.f, 0.f};
#pragma unroll
        for (int ai = 0; ai < 2; ++ai)
#pragma unroll
            for (int m = 0; m < 4; ++m) { float* rowp = C + (size_t)(row0 + ai * HALF + m * 16) * ldc + col0;
#pragma unroll
                for (int bj = 0; bj < 2; ++bj)
#pragma unroll
                    for (int n = 0; n < 2; ++n) *(f32x4*)(rowp + bj * HALF + n * 16) = acc[ai][bj][m][n] + bv[bj][n]; }
    }
};
template <int ACT  > struct EpiBf16 {
    static constexpr bool PERM = true, AFTER_DRAIN = false;
    bf16_t* O; int ldc; const float* bias; int split_cols; size_t split_stride;
    __device__ __forceinline__ void operator()(const f32x4 (&acc)[2][2][4][2], const Unit& u, int wr, int wc, int fr, int fq) const {
        const int row0 = u.pm * BM + wr * 64 + fr; int colt = u.pn * BM; bf16_t* base = O;
        if (split_cols) { const int t = colt / split_cols; base += (size_t)t * split_stride; colt -= t * split_cols; }
        const int col0 = colt + wc * 32 + 8 * fq, bcol0 = u.pn * BM + wc * 32 + 8 * fq;
        f32x4 bv[2][2];
#pragma unroll
        for (int bj = 0; bj < 2; ++bj)
#pragma unroll
            for (int n = 0; n < 2; ++n) bv[bj][n] = bias ? *(const f32x4*)(bias + bcol0 + bj * HALF + 4 * n) : (f32x4){0.f, 0.f, 0.f, 0.f};
#pragma unroll
        for (int ai = 0; ai < 2; ++ai)
#pragma unroll
            for (int m = 0; m < 4; ++m) { bf16_t* rowp = base + (size_t)(row0 + ai * HALF + m * 16) * ldc + col0;
#pragma unroll
                for (int bj = 0; bj < 2; ++bj) { f32x4 v0 = acc[ai][bj][m][0] + bv[bj][0], v1 = acc[ai][bj][m][1] + bv[bj][1];
                    if (ACT == 1) { f32x2 a = gelu_pk((f32x2){v0[0], v0[1]}), b = gelu_pk((f32x2){v0[2], v0[3]}), c = gelu_pk((f32x2){v1[0], v1[1]}), d = gelu_pk((f32x2){v1[2], v1[3]});
                        v0 = (f32x4){a.x, a.y, b.x, b.y}; v1 = (f32x4){c.x, c.y, d.x, d.y}; }
                    if (ACT == 2) {
#pragma unroll
                        for (int j = 0; j < 4; ++j) { v0[j] = 0.5f * v0[j] * (1.0f + erff(v0[j] * 0.70710678f)); v1[j] = 0.5f * v1[j] * (1.0f + erff(v1[j] * 0.70710678f)); } }
                    u32x4 w; w.x = cvt_pk_bf16(v0[0], v0[1]); w.y = cvt_pk_bf16(v0[2], v0[3]); w.z = cvt_pk_bf16(v1[0], v1[1]); w.w = cvt_pk_bf16(v1[2], v1[3]);
                    *(u32x4*)(rowp + bj * HALF) = w; } }
    }
};

template <class Epi, class Sched, bool STAMP = false>
__device__ __forceinline__ void gemm_phase(PG8_LAS unsigned char* lds, const Gemm g, const Sched& S, const Epi& E, unsigned long long* stamps) {
    const int tid = threadIdx.x, wid = __builtin_amdgcn_readfirstlane(tid >> 6), lane = tid & 63, wr = wid >> 2, wc = wid & 3, fr = lane & 15, fq = lane >> 4;
    const int K = g.K, nt = K / BK;
    int ts_lo = 0, ts_hi = 0, nts = 0; const unsigned long long rt_entry = STAMP ? (unsigned long long)wall_clock64() : 0ull;
#define PG8_STAMP() do { if (STAMP && wid == 0 && nts < 64) { const unsigned long long _c = (unsigned long long)clock64(); \
        ts_lo = (lane == nts) ? (int)(unsigned)_c : ts_lo; ts_hi = (lane == nts) ? (int)(unsigned)(_c >> 32) : ts_hi; ++nts; } } while (0)
    PG8_STAMP();
    unsigned voffA[2], voffB[2];
#pragma unroll
    for (int i = 0; i < 2; ++i) { int R, C; stage_rc(tid * 16 + i * 8192, R, C); const int Rb = Epi::PERM ? ((R & ~31) + perm32(R & 31)) : R;
        voffA[i] = (unsigned)(R * K + C) * 2u; voffB[i] = (unsigned)(Rb * K + C) * 2u; }
    const size_t kstep = (size_t)(BK * 2);
    const size_t hstep = (size_t)HALF * K * 2;
    const size_t tstep = 2 * hstep;
    const unsigned ldsw = (unsigned)wid * 1024u;
    const int aoff = lds_byte(wr * 64 + fr, fq * 8), boff = lds_byte(wc * 32 + fr, fq * 8);
#define PG8_SA(b, h) (((b) * 2 + (h)) * HTB)
#define PG8_SB(b, h) ((4 + (b) * 2 + (h)) * HTB)
#define PG8_STAGE(bufoff, gbase, voff) do { _Pragma("unroll") for (int _i = 0; _i < 2; ++_i) \
        __builtin_amdgcn_global_load_lds((const unsigned*)((const char*)(gbase) + (voff)[_i]), (PG8_LAS unsigned*)(lds + (bufoff) + ldsw + _i * 8192), 16, 0, 0); } while (0)
#define PG8_LDA(dst, b, h) do { _Pragma("unroll") for (int m = 0; m < 4; ++m) _Pragma("unroll") for (int k = 0; k < 2; ++k) dst[m][k] = *(const PG8_LAS bf16x8*)(lds + PG8_SA(b, h) + aoff + m * 2048 + k * 1024); } while (0)
#define PG8_LDB(dst, b, h) do { _Pragma("unroll") for (int n = 0; n < 2; ++n) _Pragma("unroll") for (int k = 0; k < 2; ++k) dst[n][k] = *(const PG8_LAS bf16x8*)(lds + PG8_SB(b, h) + boff + n * 2048 + k * 1024); } while (0)
#define PG8_MMA(ai, bj, At, Bt) do { __builtin_amdgcn_s_setprio(1); _Pragma("unroll") for (int m = 0; m < 4; ++m) _Pragma("unroll") for (int n = 0; n < 2; ++n) _Pragma("unroll") for (int k = 0; k < 2; ++k) \
        acc[ai][bj][m][n] = __builtin_amdgcn_mfma_f32_16x16x32_bf16(Bt[n][k], At[m][k], acc[ai][bj][m][n], 0, 0, 0); __builtin_amdgcn_s_setprio(0); } while (0)
#define PG8_WAIT_V(n) asm volatile("s_waitcnt vmcnt(" #n ")" ::: "memory")
#define PG8_WAIT_L(n) asm volatile("s_waitcnt lgkmcnt(" #n ")" ::: "memory")
#define PG8_BAR __builtin_amdgcn_s_barrier()
#define PG8_SCHED __builtin_amdgcn_sched_barrier(0)
    Unit cur, nxt; int ui = 0;
    if (!S.next(0, cur)) return;
    f32x4 acc[2][2][4][2];
#pragma unroll
    for (int a = 0; a < 2; ++a)
#pragma unroll
        for (int b = 0; b < 2; ++b)
#pragma unroll
            for (int m = 0; m < 4; ++m)
#pragma unroll
                for (int n = 0; n < 2; ++n) acc[a][b][m][n] = (f32x4){0.f, 0.f, 0.f, 0.f};
    bf16x8 At[4][2], B0[2][2], B1[2][2];
    const char* cA = (const char*)g.A + (size_t)cur.pm * tstep; const char* cB = (const char*)g.Bt + (size_t)cur.pn * tstep;
    S.a_ready(cur);
    PG8_STAGE(PG8_SB(0, 0), cB, voffB); PG8_STAGE(PG8_SA(0, 0), cA, voffA); PG8_STAGE(PG8_SB(0, 1), cB + hstep, voffB); PG8_STAGE(PG8_SA(0, 1), cA + hstep, voffA);
    if (wr == 1) PG8_BAR;
    PG8_WAIT_V(4); PG8_BAR;
    PG8_STAGE(PG8_SB(1, 0), cB + kstep, voffB); PG8_STAGE(PG8_SA(1, 0), cA + kstep, voffA); PG8_STAGE(PG8_SB(1, 1), cB + hstep + kstep, voffB);
    PG8_WAIT_V(6); PG8_BAR;
    PG8_STAMP();
    for (;;) {
        const bool has_next = S.next(ui + 1, nxt);
        const char* nA = has_next ? (const char*)g.A + (size_t)nxt.pm * tstep : cA; const char* nB = has_next ? (const char*)g.Bt + (size_t)nxt.pn * tstep : cB;
        for (int t = 0; t < nt; t += 2) {
            const bool last = (t == nt - 2);
            const char* a1 = cA + (size_t)(t + 1) * kstep;
            const char* a2 = last ? nA : cA + (size_t)(t + 2) * kstep; const char* b2 = last ? nB : cB + (size_t)(t + 2) * kstep;
            const char* a3 = a2 + kstep; const char* b3 = b2 + kstep;
            if (last && has_next) S.a_ready(nxt);
            PG8_LDB(B0, 0, 0); PG8_SCHED; PG8_LDA(At, 0, 0); PG8_STAGE(PG8_SA(1, 1), a1 + hstep, voffA);
            PG8_WAIT_L(8); PG8_BAR; PG8_WAIT_L(0); PG8_MMA(0, 0, At, B0); PG8_BAR; PG8_SCHED;
            PG8_LDB(B1, 0, 1); PG8_STAGE(PG8_SB(0, 0), b2, voffB);
            PG8_BAR; PG8_WAIT_L(0); PG8_MMA(0, 1, At, B1); PG8_BAR;
            PG8_LDA(At, 0, 1); PG8_STAGE(PG8_SA(0, 0), a2, voffA);
            PG8_BAR; PG8_WAIT_L(0); PG8_MMA(1, 0, At, B0); PG8_BAR; PG8_SCHED;
            PG8_STAGE(PG8_SB(0, 1), b2 + hstep, voffB);
            PG8_WAIT_V(6); PG8_BAR; PG8_MMA(1, 1, At, B1); PG8_BAR;
            PG8_LDB(B0, 1, 0); PG8_SCHED; PG8_LDA(At, 1, 0); PG8_STAGE(PG8_SA(0, 1), a2 + hstep, voffA);
            PG8_WAIT_L(8); PG8_BAR; PG8_WAIT_L(0); PG8_MMA(0, 0, At, B0); PG8_BAR; PG8_SCHED;
            PG8_LDB(B1, 1, 1); PG8_STAGE(PG8_SB(1, 0), b3, voffB);
            PG8_BAR; PG8_WAIT_L(0); PG8_MMA(0, 1, At, B1); PG8_BAR;
            PG8_LDA(At, 1, 1); PG8_STAGE(PG8_SA(1, 0), a3, voffA);
            PG8_BAR; PG8_WAIT_L(0); PG8_MMA(1, 0, At, B0); PG8_BAR; PG8_SCHED;
            PG8_STAGE(PG8_SB(1, 1), b3 + hstep, voffB);
            PG8_WAIT_V(6); PG8_BAR; PG8_MMA(1, 1, At, B1); PG8_BAR;
        }
        PG8_STAMP();
        if constexpr (!Epi::AFTER_DRAIN) { E(acc, cur, wr, wc, fr, fq); S.done(cur); }
        PG8_STAMP();
        if (!has_next) break;
#pragma unroll
        for (int a = 0; a < 2; ++a)
#pragma unroll
            for (int b = 0; b < 2; ++b)
#pragma unroll
                for (int m = 0; m < 4; ++m)
#pragma unroll
                    for (int n = 0; n < 2; ++n) acc[a][b][m][n] = (f32x4){0.f, 0.f, 0.f, 0.f};
        cur = nxt; cA = nA; cB = nB; ++ui;
    }
    PG8_WAIT_V(0);
    if (wr == 0) PG8_BAR;
    PG8_BAR;
    if constexpr (Epi::AFTER_DRAIN) { E.fused(acc, cur, wr, wc, fr, fq, lds, wid, lane); S.done(cur); }
    PG8_STAMP();
    if (STAMP && wid == 0) { stamps[lane] = lane < nts ? (((unsigned long long)(unsigned)ts_hi << 32) | (unsigned)ts_lo) : 0ull;
        if (lane == 62) stamps[62] = rt_entry; if (lane == 63) stamps[63] = (unsigned long long)wall_clock64(); }
#undef PG8_STAMP
#undef PG8_SA
#undef PG8_SB
#undef PG8_STAGE
#undef PG8_LDA
#undef PG8_LDB
#undef PG8_MMA
#undef PG8_WAIT_V
#undef PG8_WAIT_L
#undef PG8_BAR
#undef PG8_SCHED
}
}


#define LAS __attribute__((address_space(3)))
typedef unsigned short bf16_t;
typedef float f32x4 __attribute__((ext_vector_type(4)));
typedef unsigned u32x4 __attribute__((ext_vector_type(4)));
typedef unsigned u32x2 __attribute__((ext_vector_type(2)));
typedef short bf16x8 __attribute__((ext_vector_type(8)));
typedef short s16x4 __attribute__((ext_vector_type(4)));
typedef float f32x16 __attribute__((ext_vector_type(16)));

constexpr int MTOK = 16384, DM = 2048, SEQ = 8192, NHEAD = 16;
constexpr float ALPHA = 1.41421356237309515f;
constexpr size_t MiB = (size_t)1 << 20;
constexpr size_t WS_WIN = 0, WS_WOUT = 32 * MiB, WS_WKVQ = 40 * MiB, WS_WO = 64 * MiB, WS_WC = 72 * MiB, WS_UB = 88 * MiB, WS_VB = 152 * MiB, WS_USC = 216 * MiB, WS_VSC = 217 * MiB, WS_H = 224 * MiB, WS_XQ = 232 * MiB, WS_XS = 264 * MiB, WS_W = 272 * MiB, WS_CS = 280 * MiB, WS_SLOT = 344 * MiB;
constexpr size_t WS_EID = 920 * MiB, WS_GATE = 928 * MiB, WS_COS = 936 * MiB, WS_SIN = 938 * MiB, WS_KMEAN = 940 * MiB, WS_LB = 941 * MiB, WS_LS = 942 * MiB, WS_SUB = 946 * MiB, WS_CNT = 962 * MiB, WS_CTR = 963 * MiB, WS_DEC = 964 * MiB, WS_END = 966 * MiB;
constexpr size_t WS_KNMAX = WS_KMEAN + 768 * 1024;
__host__ __device__ constexpr size_t slot(int i) { return WS_SLOT + (size_t)i * 64 * MiB; }
constexpr int LDS_BYTES = 144 * 1024;
constexpr int NPH = 20;

struct Args { const float* in[14]; float* out; unsigned char* ws; int ph_lo, ph_hi; };

__device__ __forceinline__ float bflo(unsigned w) { return __uint_as_float(w << 16); }
__device__ __forceinline__ float bfhi(unsigned w) { return __uint_as_float(w & 0xffff0000u); }
__device__ __forceinline__ float bf2f(bf16_t b) { return __uint_as_float(((unsigned)b) << 16); }
typedef __bf16 bf16x2_t __attribute__((ext_vector_type(2)));
typedef float f32x2_t __attribute__((ext_vector_type(2)));
__device__ __forceinline__ unsigned pk_bf16(float lo, float hi) { const f32x2_t f = {lo, hi}; return __builtin_bit_cast(unsigned, __builtin_convertvector(f, bf16x2_t)); }
__device__ __forceinline__ float wave_sum(float v) {
#pragma unroll
    for (int o = 32; o >= 1; o >>= 1) v += __shfl_xor(v, o);
    return v;
}
__device__ __forceinline__ float wave_max(float v) {
#pragma unroll
    for (int o = 32; o >= 1; o >>= 1) v = fmaxf(v, __shfl_xor(v, o));
    return v;
}
__device__ __forceinline__ float sigmoidf_(float z) { return 1.0f / (1.0f + __expf(-z)); }


__device__ __forceinline__ void store_wt16(void* p, u32x4 v) {
    __hip_atomic_store((unsigned long long*)p, ((unsigned long long)v.y << 32) | v.x, __ATOMIC_RELAXED, __HIP_MEMORY_SCOPE_AGENT);
    __hip_atomic_store((unsigned long long*)p + 1, ((unsigned long long)v.w << 32) | v.z, __ATOMIC_RELAXED, __HIP_MEMORY_SCOPE_AGENT);
}
__device__ __forceinline__ void store_wt8(void* p, u32x2 v) {
    __hip_atomic_store((unsigned long long*)p, ((unsigned long long)v.y << 32) | v.x, __ATOMIC_RELAXED, __HIP_MEMORY_SCOPE_AGENT);
}
struct EpiIn {
    static constexpr bool PERM = true, AFTER_DRAIN = false;
    bf16_t* Q1; float* LF; bf16_t* I1; bf16_t* G1; const float* LB;
    __device__ __forceinline__ void operator()(const pg8::f32x4 (&acc)[2][2][4][2], const pg8::Unit& u, int wr, int wc, int fr, int fq) const {
        const int type = u.pn >> 3;
        const int row0 = u.pm * 256 + wr * 64 + fr, col0 = (u.pn & 7) * 256 + wc * 32 + 8 * fq;
        if (type == 1) {
#pragma unroll
            for (int bj = 0; bj < 2; ++bj) {
                const int c = col0 + bj * 128;
                const f32x4 lb0 = *(const f32x4*)(LB + c), lb1 = *(const f32x4*)(LB + c + 4);
#pragma unroll
                for (int ai = 0; ai < 2; ++ai)
#pragma unroll
                    for (int m = 0; m < 4; ++m) {
                        float* p = LF + (size_t)(row0 + ai * 128 + m * 16) * DM + c;
                        f32x4 o0, o1;
#pragma unroll
                        for (int j = 0; j < 4; ++j) {
                            o0[j] = __logf(lb0[j] + (1.0f - lb0[j]) * sigmoidf_(acc[ai][bj][m][0][j]));
                            o1[j] = __logf(lb1[j] + (1.0f - lb1[j]) * sigmoidf_(acc[ai][bj][m][1][j]));
                        }
                        *(f32x4*)p = o0; *(f32x4*)(p + 4) = o1;
                    }
            }
        } else {
            bf16_t* dst = Q1 + (size_t)(type - (type > 0 ? 1 : 0)) * ((size_t)32 << 20);
            const bool act = (type != 2);
#pragma unroll
            for (int ai = 0; ai < 2; ++ai)
#pragma unroll
                for (int m = 0; m < 4; ++m)
#pragma unroll
                    for (int bj = 0; bj < 2; ++bj) {
                        f32x4 v0 = acc[ai][bj][m][0], v1 = acc[ai][bj][m][1];
                        if (act) {
#pragma unroll
                            for (int j = 0; j < 4; ++j) { v0[j] = v0[j] * sigmoidf_(v0[j]); v1[j] = v1[j] * sigmoidf_(v1[j]); }
                        }
                        u32x4 w; w.x = pk_bf16(v0[0], v0[1]); w.y = pk_bf16(v0[2], v0[3]); w.z = pk_bf16(v1[0], v1[1]); w.w = pk_bf16(v1[2], v1[3]);
                        *(u32x4*)(dst + (size_t)(row0 + ai * 128 + m * 16) * DM + col0 + bj * 128) = w;
                    }
        }
    }
};
struct EpiRes {
    static constexpr bool PERM = false, AFTER_DRAIN = false;
    const float* res; float* Y;
    __device__ __forceinline__ void operator()(const pg8::f32x4 (&acc)[2][2][4][2], const pg8::Unit& u, int wr, int wc, int fr, int fq) const {
        const int row0 = u.pm * 256 + wr * 64 + fr, col0 = u.pn * 256 + wc * 32 + 4 * fq;
#pragma unroll
        for (int ai = 0; ai < 2; ++ai)
#pragma unroll
            for (int m = 0; m < 4; ++m) {
                const size_t off = (size_t)(row0 + ai * 128 + m * 16) * DM + col0;
#pragma unroll
                for (int bj = 0; bj < 2; ++bj)
#pragma unroll
                    for (int n = 0; n < 2; ++n) {
                        const f32x4 r = *(const f32x4*)(res + off + bj * 128 + n * 16);
                        *(f32x4*)(Y + off + bj * 128 + n * 16) = r * ALPHA + acc[ai][bj][m][n];
                    }
            }
    }
};
struct EpiF32 {
    static constexpr bool PERM = false, AFTER_DRAIN = false;
    float* C; int ldc;
    __device__ __forceinline__ void operator()(const pg8::f32x4 (&acc)[2][2][4][2], const pg8::Unit& u, int wr, int wc, int fr, int fq) const {
        const int row0 = u.pm * 256 + wr * 64 + fr, col0 = u.pn * 256 + wc * 32 + 4 * fq;
#pragma unroll
        for (int ai = 0; ai < 2; ++ai)
#pragma unroll
            for (int m = 0; m < 4; ++m) {
                float* p = C + (size_t)(row0 + ai * 128 + m * 16) * ldc + col0;
#pragma unroll
                for (int bj = 0; bj < 2; ++bj)
#pragma unroll
                    for (int n = 0; n < 2; ++n) *(f32x4*)(p + bj * 128 + n * 16) = acc[ai][bj][m][n];
            }
    }
};
struct EpiKVQ {
    static constexpr bool PERM = true, AFTER_DRAIN = false;
    bf16_t* K; bf16_t* V; bf16_t* Q;
    __device__ __forceinline__ void operator()(const pg8::f32x4 (&acc)[2][2][4][2], const pg8::Unit& u, int wr, int wc, int fr, int fq) const {
        const int t = u.pn >> 3;
        bf16_t* dst = K + (size_t)t * ((size_t)32 << 20);
        const int row0 = u.pm * 256 + wr * 64 + fr, col0 = (u.pn & 7) * 256 + wc * 32 + 8 * fq;
#pragma unroll
        for (int ai = 0; ai < 2; ++ai)
#pragma unroll
            for (int m = 0; m < 4; ++m)
#pragma unroll
                for (int bj = 0; bj < 2; ++bj) {
                    const f32x4 v0 = acc[ai][bj][m][0], v1 = acc[ai][bj][m][1];
                    u32x4 w; w.x = pk_bf16(v0[0], v0[1]); w.y = pk_bf16(v0[2], v0[3]); w.z = pk_bf16(v1[0], v1[1]); w.w = pk_bf16(v1[2], v1[3]);
                    *(u32x4*)(dst + (size_t)(row0 + ai * 128 + m * 16) * DM + col0 + bj * 128) = w;
                }
    }
};

__device__ __forceinline__ void transpose_tiles(LAS float* tile, const float* src, int ldn, int K, int N, bf16_t* dst) {
    const int tid = threadIdx.x;
    const int tn = N / 64, ntiles = tn * (K / 64);
    for (int tI = blockIdx.x; tI < ntiles; tI += gridDim.x) {
        const int k0 = (tI / tn) * 64, n0 = (tI % tn) * 64;
#pragma unroll
        for (int r = 0; r < 2; ++r) {
            const int kk = (tid >> 4) + 32 * r, nn = (tid & 15) * 4;
            const f32x4 v = *(const f32x4*)(src + (size_t)(k0 + kk) * ldn + n0 + nn);
            tile[kk * 65 + nn + 0] = v[0]; tile[kk * 65 + nn + 1] = v[1]; tile[kk * 65 + nn + 2] = v[2]; tile[kk * 65 + nn + 3] = v[3];
        }
        __syncthreads();
        {
            const int nn = tid >> 3, kk8 = (tid & 7) * 8;
            float f[8];
#pragma unroll
            for (int j = 0; j < 8; ++j) f[j] = tile[(kk8 + j) * 65 + nn];
            u32x4 w; w.x = pk_bf16(f[0], f[1]); w.y = pk_bf16(f[2], f[3]); w.z = pk_bf16(f[4], f[5]); w.w = pk_bf16(f[6], f[7]);
            *(u32x4*)(dst + (size_t)(n0 + nn) * K + k0 + kk8) = w;
        }
        __syncthreads();
    }
}
__device__ __forceinline__ void convert_bf16(const float* src, bf16_t* dst, size_t n) {
    const size_t stride = (size_t)gridDim.x * 512 * 8;
    for (size_t i = ((size_t)blockIdx.x * 512 + threadIdx.x) * 8; i < n; i += stride) {
        const f32x4 a = *(const f32x4*)(src + i), b = *(const f32x4*)(src + i + 4);
        u32x4 w; w.x = pk_bf16(a[0], a[1]); w.y = pk_bf16(a[2], a[3]); w.z = pk_bf16(b[0], b[1]); w.w = pk_bf16(b[2], b[3]);
        *(u32x4*)(dst + i) = w;
    }
}
__device__ __forceinline__ void fold_peer_keys(LAS float* lds, const float* w_query, const float* sub_keys, bf16_t* WcT) {
    const int tid = threadIdx.x;
    LAS float* Ss = lds;
    LAS float* Ws = lds + 128 * 132;
    for (int item = blockIdx.x; item < 1024; item += gridDim.x) {
        const int l = item >> 9, rem = item & 511, hh = rem >> 5, kb = rem & 31, h = hh >> 1, half = hh & 1;
        const float* sk = sub_keys + (size_t)(((l * 2 + half) * 8 + h) * 128) * 128;
        const float* wq = w_query + (size_t)l * DM * DM + (size_t)(kb * 64) * DM + h * 256 + half * 128;
#pragma unroll
        for (int r = 0; r < 8; ++r) { const int idx = tid + 512 * r, key = idx >> 5, d4 = (idx & 31) * 4; *(LAS f32x4*)(Ss + key * 132 + d4) = *(const f32x4*)(sk + key * 128 + d4); }
#pragma unroll
        for (int r = 0; r < 4; ++r) { const int idx = tid + 512 * r, kin = idx >> 5, d4 = (idx & 31) * 4; *(LAS f32x4*)(Ws + kin * 128 + d4) = *(const f32x4*)(wq + (size_t)kin * DM + d4); }
        __syncthreads();
        const int key = tid & 127, kq = tid >> 7;
        float acc[16];
#pragma unroll
        for (int j = 0; j < 16; ++j) acc[j] = 0.f;
        for (int d4 = 0; d4 < 32; ++d4) {
            const f32x4 s4 = *(const LAS f32x4*)(Ss + key * 132 + d4 * 4);
#pragma unroll
            for (int j = 0; j < 16; ++j) { const f32x4 w4 = *(const LAS f32x4*)(Ws + (kq * 16 + j) * 128 + d4 * 4); acc[j] += s4[0] * w4[0] + s4[1] * w4[1] + s4[2] * w4[2] + s4[3] * w4[3]; }
        }
        bf16_t* o = WcT + (size_t)l * DM * DM + (size_t)(h * 256 + half * 128 + key) * DM + kb * 64 + kq * 16;
        u32x4 w0, w1;
        w0.x = pk_bf16(acc[0], acc[1]); w0.y = pk_bf16(acc[2], acc[3]); w0.z = pk_bf16(acc[4], acc[5]); w0.w = pk_bf16(acc[6], acc[7]);
        w1.x = pk_bf16(acc[8], acc[9]); w1.y = pk_bf16(acc[10], acc[11]); w1.z = pk_bf16(acc[12], acc[13]); w1.w = pk_bf16(acc[14], acc[15]);
        *(u32x4*)o = w0; *(u32x4*)(o + 8) = w1;
        __syncthreads();
    }
}

__device__ __forceinline__ void quant_rows(const float* src, unsigned char* dst, float* scl, int nrows) {
    const int lane = threadIdx.x & 63, gw = blockIdx.x * 8 + (threadIdx.x >> 6), nw = gridDim.x * 8;
    for (int row = gw; row < nrows; row += nw) {
        const float* p = src + (size_t)row * DM;
        f32x4 v[8];
#pragma unroll
        for (int i = 0; i < 2; ++i)
#pragma unroll
            for (int q = 0; q < 4; ++q) v[i * 4 + q] = *(const f32x4*)(p + 1024 * i + 16 * lane + 4 * q);
        float am = 0.f;
#pragma unroll
        for (int i = 0; i < 8; ++i) am = fmaxf(am, fmaxf(fmaxf(fabsf(v[i][0]), fabsf(v[i][1])), fmaxf(fabsf(v[i][2]), fabsf(v[i][3]))));
        am = fmaxf(wave_max(am), 1e-30f);
        const float inv = 127.0f / am;
        if (lane == 0) scl[row] = am * (1.0f / 127.0f);
#pragma unroll
        for (int i = 0; i < 2; ++i) {
            u32x4 w;
#pragma unroll
            for (int q = 0; q < 4; ++q) {
                const f32x4 t = v[i * 4 + q];
                const unsigned b0 = (unsigned)(int)(rintf(t[0] * inv) + 128.0f), b1 = (unsigned)(int)(rintf(t[1] * inv) + 128.0f), b2 = (unsigned)(int)(rintf(t[2] * inv) + 128.0f), b3 = (unsigned)(int)(rintf(t[3] * inv) + 128.0f);
                w[q] = b0 | (b1 << 8) | (b2 << 16) | (b3 << 24);
            }
            *(u32x4*)(dst + (size_t)row * DM + 1024 * i + 16 * lane) = w;
        }
    }
}
__device__ __forceinline__ void phase_prep(const Args& a, LAS unsigned char* lds) {
    unsigned char* ws = a.ws;
    LAS float* tile = (LAS float*)lds;
    transpose_tiles(tile, a.in[1], 4 * DM, DM, 4 * DM, (bf16_t*)(ws + WS_WIN));
    transpose_tiles(tile, a.in[3], DM, DM, DM, (bf16_t*)(ws + WS_WOUT));
    transpose_tiles(tile, a.in[5], 2 * DM, DM, 2 * DM, (bf16_t*)(ws + WS_WKVQ));
    transpose_tiles(tile, a.in[6], DM, DM, DM, (bf16_t*)(ws + WS_WKVQ) + (size_t)2 * DM * DM);
    transpose_tiles(tile, a.in[7], DM, DM, DM, (bf16_t*)(ws + WS_WO));
    fold_peer_keys((LAS float*)lds, a.in[8], a.in[9], (bf16_t*)(ws + WS_WC));
    convert_bf16(a.in[0], (bf16_t*)(ws + slot(0)), (size_t)MTOK * DM);
    quant_rows(a.in[10], ws + WS_UB, (float*)(ws + WS_USC), 2 * 16384);
    quant_rows(a.in[11], ws + WS_VB, (float*)(ws + WS_VSC), 2 * 16384);
    const int gtid = blockIdx.x * 512 + threadIdx.x, gthreads = gridDim.x * 512;
    float* COS = (float*)(ws + WS_COS); float* SIN = (float*)(ws + WS_SIN); float* LB = (float*)(ws + WS_LB);
    for (int i = gtid; i < SEQ * 64; i += gthreads) {
        const int pos = i >> 6, j = i & 63;
        double inv = 1.0; const double r = 0.86596432336006535;
        for (int q = 0; q < j; ++q) inv *= r;
        const float ang = (float)pos * (float)inv;
        const double x = (double)ang;
        const double n = __builtin_rint(x * 0.15915494309189535);
        const float rf = (float)__builtin_fma(-n, 6.283185307179586, x);
        COS[i] = cosf(rf); SIN[i] = sinf(rf);
    }
    for (int c = gtid; c < DM; c += gthreads) { const float l0 = a.in[4][c], l1 = a.in[4][DM + c]; LB[c] = 1.0f / (1.0f + expf(l1 - l0)); }
}

__device__ __forceinline__ void phase_scan_naive(const bf16_t* Q1, const float* LF, const bf16_t* I1, float* O) {
    const int lane = threadIdx.x & 63, gw = blockIdx.x * 8 + (threadIdx.x >> 6), nw = gridDim.x * 8;
    for (int item = gw; item < 2 * NHEAD * 128; item += nw) {
        const int bh = item >> 7, v = item & 127, b = bh >> 4, h = bh & 15;
        const size_t base = (size_t)b * SEQ * DM + h * 128;
        float S0 = 0.f, S1 = 0.f;
#pragma unroll 4
        for (int t = 0; t < SEQ; ++t) {
            const size_t ro = base + (size_t)t * DM;
            const float f0 = __expf(LF[ro + lane]), f1 = __expf(LF[ro + 64 + lane]);
            const float q0 = bf2f(Q1[ro + lane]), q1 = bf2f(Q1[ro + 64 + lane]);
            const float iv = bf2f(I1[ro + v]);
            S0 = f0 * S0 + (1.0f - f0) * iv; S1 = f1 * S1 + (1.0f - f1) * iv;
            const float p = wave_sum(q0 * S0 + q1 * S1);
            if (lane == 0) O[ro + v] = p;
        }
    }
}
__device__ __forceinline__ void phase_onorm(const float* O, const bf16_t* G1, const float* gnorm, bf16_t* OG) {
    const int lane = threadIdx.x & 63, gw = blockIdx.x * 8 + (threadIdx.x >> 6), nw = gridDim.x * 8;
    const float gn0 = gnorm[2 * lane], gn1 = gnorm[2 * lane + 1];
    for (int item = gw; item < MTOK * NHEAD; item += nw) {
        const size_t off = (size_t)item * 128 + 2 * lane;
        const float o0 = O[off], o1 = O[off + 1];
        const float ss = wave_sum(o0 * o0 + o1 * o1);
        const float r = rsqrtf(ss * (1.0f / 128.0f) + 1e-6f);
        const unsigned g = *(const unsigned*)(G1 + off);
        *(unsigned*)(OG + off) = pk_bf16(o0 * r * gn0 * bflo(g), o1 * r * gn1 * bfhi(g));
    }
}

__device__ __forceinline__ void ln_row_store(float (&v)[32], const float* g, const float* bta, float* outf, bf16_t* outb, int lane, signed char* outq = nullptr, float* outs = nullptr) {
    float s = 0.f;
#pragma unroll
    for (int i = 0; i < 32; ++i) s += v[i];
    const float mu = wave_sum(s) * (1.0f / DM);
    float q = 0.f;
#pragma unroll
    for (int i = 0; i < 32; ++i) { v[i] -= mu; q += v[i] * v[i]; }
    const float rstd = rsqrtf(wave_sum(q) * (1.0f / DM) + 1e-5f);
    float am = 0.f;
#pragma unroll
    for (int i = 0; i < 4; ++i) {
        const int c = 512 * i + 8 * lane;
        const f32x4 g0 = *(const f32x4*)(g + c), g1 = *(const f32x4*)(g + c + 4), b0 = *(const f32x4*)(bta + c), b1 = *(const f32x4*)(bta + c + 4);
        f32x4 o0, o1;
#pragma unroll
        for (int j = 0; j < 4; ++j) { o0[j] = v[i * 8 + j] * rstd * g0[j] + b0[j]; o1[j] = v[i * 8 + 4 + j] * rstd * g1[j] + b1[j]; v[i * 8 + j] = o0[j]; v[i * 8 + 4 + j] = o1[j]; am = fmaxf(am, fmaxf(fabsf(o0[j]), fabsf(o1[j]))); }
        *(f32x4*)(outf + c) = o0; *(f32x4*)(outf + c + 4) = o1;
        if (outb) { u32x4 w; w.x = pk_bf16(o0[0], o0[1]); w.y = pk_bf16(o0[2], o0[3]); w.z = pk_bf16(o1[0], o1[1]); w.w = pk_bf16(o1[2], o1[3]); *(u32x4*)(outb + c) = w; }
    }
    if (outq) {
        am = fmaxf(wave_max(am), 1e-30f);
        const float inv = 127.0f / am;
        if (lane == 0) *outs = am * (1.0f / 127.0f);
#pragma unroll
        for (int i = 0; i < 4; ++i) {
            u32x2 w;
            w.x = ((unsigned)(int)rintf(v[i * 8 + 0] * inv) & 0xffu) | (((unsigned)(int)rintf(v[i * 8 + 1] * inv) & 0xffu) << 8) | (((unsigned)(int)rintf(v[i * 8 + 2] * inv) & 0xffu) << 16) | (((unsigned)(int)rintf(v[i * 8 + 3] * inv) & 0xffu) << 24);
            w.y = ((unsigned)(int)rintf(v[i * 8 + 4] * inv) & 0xffu) | (((unsigned)(int)rintf(v[i * 8 + 5] * inv) & 0xffu) << 8) | (((unsigned)(int)rintf(v[i * 8 + 6] * inv) & 0xffu) << 16) | (((unsigned)(int)rintf(v[i * 8 + 7] * inv) & 0xffu) << 24);
            *(u32x2*)(outq + 512 * i + 8 * lane) = w;
        }
    }
}
__device__ __forceinline__ void ln_row_store16(float (&v)[32], const float* g, const float* bta, float* outf, bf16_t* outb, int lane) {
    float s = 0.f;
#pragma unroll
    for (int i = 0; i < 32; ++i) s += v[i];
    const float mu = wave_sum(s) * (1.0f / DM);
    float q = 0.f;
#pragma unroll
    for (int i = 0; i < 32; ++i) { v[i] -= mu; q += v[i] * v[i]; }
    const float rstd = rsqrtf(wave_sum(q) * (1.0f / DM) + 1e-5f);
#pragma unroll
    for (int i = 0; i < 2; ++i) {
        const int c = 1024 * i + 16 * lane;
        f32x4 o[4];
#pragma unroll
        for (int qd = 0; qd < 4; ++qd) {
            const f32x4 gg = *(const f32x4*)(g + c + 4 * qd), bb = *(const f32x4*)(bta + c + 4 * qd);
#pragma unroll
            for (int j = 0; j < 4; ++j) o[qd][j] = v[16 * i + 4 * qd + j] * rstd * gg[j] + bb[j];
            *(f32x4*)(outf + c + 4 * qd) = o[qd];
        }
        if (outb) {
            u32x4 w0, w1;
            w0.x = pk_bf16(o[0][0], o[0][1]); w0.y = pk_bf16(o[0][2], o[0][3]); w0.z = pk_bf16(o[1][0], o[1][1]); w0.w = pk_bf16(o[1][2], o[1][3]);
            w1.x = pk_bf16(o[2][0], o[2][1]); w1.y = pk_bf16(o[2][2], o[2][3]); w1.z = pk_bf16(o[3][0], o[3][1]); w1.w = pk_bf16(o[3][2], o[3][3]);
            *(u32x4*)(outb + c) = w0; *(u32x4*)(outb + c + 8) = w1;
        }
    }
}
__device__ __forceinline__ void phase_ln(const float* Y, const float* RES, const float* g, const float* bta, float* outf, bf16_t* outb, signed char* outq = nullptr, float* outs = nullptr) {
    const int lane = threadIdx.x & 63, gw = blockIdx.x * 8 + (threadIdx.x >> 6), nw = gridDim.x * 8;
    for (int row = gw; row < MTOK; row += nw) {
        float v[32];
        const float* p = Y + (size_t)row * DM; const float* rp = RES + (size_t)row * DM;
#pragma unroll
        for (int i = 0; i < 4; ++i) {
            const f32x4 a = *(const f32x4*)(p + 512 * i + 8 * lane), b = *(const f32x4*)(p + 512 * i + 8 * lane + 4);
            const f32x4 ra = *(const f32x4*)(rp + 512 * i + 8 * lane), rb = *(const f32x4*)(rp + 512 * i + 8 * lane + 4);
#pragma unroll
            for (int j = 0; j < 4; ++j) { v[i * 8 + j] = a[j] + ALPHA * ra[j]; v[i * 8 + 4 + j] = b[j] + ALPHA * rb[j]; }
        }
        ln_row_store(v, g, bta, outf + (size_t)row * DM, outb ? outb + (size_t)row * DM : nullptr, lane, outq ? outq + (size_t)row * DM : nullptr, outs ? outs + row : nullptr);
    }
}

__device__ __forceinline__ void wave_argmax(float& v, int& idx) {
#pragma unroll
    for (int o = 32; o >= 1; o >>= 1) {
        const float ov = __shfl_xor(v, o); const int oi = __shfl_xor(idx, o);
        if (ov > v || (ov == v && oi < idx)) { v = ov; idx = oi; }
    }
}
__device__ __forceinline__ unsigned fkey(float x) { const unsigned u = __float_as_uint(x); return u ^ (unsigned)(((int)u >> 31) | 0x80000000); }
__device__ __forceinline__ float funkey(unsigned k) { const unsigned u = (k & 0x80000000u) ? (k ^ 0x80000000u) : ~k; return __uint_as_float(u); }
__device__ __forceinline__ void sort16_insert(unsigned (&r)[16], unsigned v) {
#pragma unroll
    for (int i = 0; i < 16; ++i) { const unsigned m = r[i] > v ? r[i] : v; v = r[i] > v ? v : r[i]; r[i] = m; }
}
__device__ __forceinline__ void phase_topk(LAS unsigned char* lds, const float* SCT, int* EID, float* GATE) {
    LAS unsigned char* ib = lds + threadIdx.x * 32;
    for (int item = blockIdx.x * 512 + threadIdx.x; item < MTOK * 8; item += gridDim.x * 512) {
        const int h = item >> 14, tok = item & (MTOK - 1);
        const float* p = SCT + (size_t)(h * 256) * MTOK + tok;
        unsigned r1[16], r2[16];
#pragma unroll
        for (int i = 0; i < 16; ++i) { r1[i] = 0u; r2[i] = 0u; }
#pragma unroll 8
        for (int e = 0; e < 128; ++e) {
            const float x1 = p[(size_t)e * MTOK], x2 = p[(size_t)(128 + e) * MTOK];
            sort16_insert(r1, (fkey(x1) & ~0x7Fu) | (unsigned)e);
            sort16_insert(r2, (fkey(x2) & ~0x7Fu) | (unsigned)e);
        }
        float v1[16], v2[16];
#pragma unroll
        for (int i = 0; i < 16; ++i) { v1[i] = funkey(r1[i] & ~0x7Fu); v2[i] = funkey(r2[i] & ~0x7Fu); ib[i] = (unsigned char)(r1[i] & 0x7Fu); ib[16 + i] = (unsigned char)(r2[i] & 0x7Fu); }
        unsigned r3[16];
#pragma unroll
        for (int i = 0; i < 16; ++i) r3[i] = 0u;
#pragma unroll
        for (int a = 0; a < 16; ++a)
#pragma unroll
            for (int bq = 0; bq < 16; ++bq)
                if ((a + 1) * (bq + 1) <= 16) sort16_insert(r3, (fkey(v1[a] + v2[bq]) & ~0xFFu) | (unsigned)(a * 16 + bq));
        const float mx = funkey(r3[0] & ~0xFFu);
        float ev[16]; float sum = 0.f;
#pragma unroll
        for (int i = 0; i < 16; ++i) { ev[i] = __expf(funkey(r3[i] & ~0xFFu) - mx); sum += ev[i]; }
        const float rs = 1.0f / sum;
        int eid[16];
#pragma unroll
        for (int i = 0; i < 16; ++i) { const unsigned f = r3[i] & 0xFFu; eid[i] = (int)ib[f >> 4] * 128 + (int)ib[16 + (f & 15u)]; }
        int* eo = EID + (size_t)tok * 128 + h * 16; float* go = GATE + (size_t)tok * 128 + h * 16;
#pragma unroll
        for (int q = 0; q < 4; ++q) {
            *(u32x4*)(eo + 4 * q) = (u32x4){(unsigned)eid[4 * q], (unsigned)eid[4 * q + 1], (unsigned)eid[4 * q + 2], (unsigned)eid[4 * q + 3]};
            *(f32x4*)(go + 4 * q) = (f32x4){ev[4 * q] * rs, ev[4 * q + 1] * rs, ev[4 * q + 2] * rs, ev[4 * q + 3] * rs};
        }
    }
}

__device__ __forceinline__ float gelu_erf(float x) { return 0.5f * x * (1.0f + erff(x * 0.70710678118654752f)); }
__device__ __forceinline__ float ub0(unsigned w) { return (float)(w & 0xffu); }
__device__ __forceinline__ float ub1(unsigned w) { return (float)((w >> 8) & 0xffu); }
__device__ __forceinline__ float ub2(unsigned w) { return (float)((w >> 16) & 0xffu); }
__device__ __forceinline__ float ub3(unsigned w) { return (float)(w >> 24); }
__device__ __forceinline__ void phase_peer(LAS unsigned char* lds, const float* X, const int* EID, const float* GATE, const unsigned char* U, const unsigned char* V, const float* USC, const float* VSC,
                                           const float* g, const float* bta, float* outf, bf16_t* outb) {
    const int lane = threadIdx.x & 63, wv = threadIdx.x >> 6, gw = blockIdx.x * 8 + wv, nw = gridDim.x * 8;
    LAS float* hb = (LAS float*)(lds + wv * 512);
    for (int tok = gw; tok < MTOK; tok += nw) {
        float x[32];
        const float* xp = X + (size_t)tok * DM;
#pragma unroll
        for (int i = 0; i < 2; ++i)
#pragma unroll
            for (int q = 0; q < 4; ++q) { const f32x4 t = *(const f32x4*)(xp + 1024 * i + 16 * lane + 4 * q); x[16 * i + 4 * q] = t[0]; x[16 * i + 4 * q + 1] = t[1]; x[16 * i + 4 * q + 2] = t[2]; x[16 * i + 4 * q + 3] = t[3]; }
        float sx = 0.f;
#pragma unroll
        for (int j = 0; j < 32; ++j) sx += x[j];
        const float d0 = -128.0f * sx;
        const int e0 = EID[(size_t)tok * 128 + lane], e1 = EID[(size_t)tok * 128 + 64 + lane];
        const float g0 = GATE[(size_t)tok * 128 + lane], g1 = GATE[(size_t)tok * 128 + 64 + lane];
        for (int bt = 0; bt < 16; ++bt) {
            float d[8];
#pragma unroll
            for (int r = 0; r < 8; ++r) {
                const int e = bt * 8 + r;
                const int idx = __builtin_amdgcn_readfirstlane(__shfl(bt < 8 ? e0 : e1, e & 63));
                const u32x4* up = (const u32x4*)(U + (size_t)idx * DM) + lane;
                float acc = d0;
#pragma unroll
                for (int i = 0; i < 2; ++i) {
                    const u32x4 w = up[i * 64];
                    acc += x[16 * i + 0] * ub0(w.x) + x[16 * i + 1] * ub1(w.x) + x[16 * i + 2] * ub2(w.x) + x[16 * i + 3] * ub3(w.x)
                         + x[16 * i + 4] * ub0(w.y) + x[16 * i + 5] * ub1(w.y) + x[16 * i + 6] * ub2(w.y) + x[16 * i + 7] * ub3(w.y)
                         + x[16 * i + 8] * ub0(w.z) + x[16 * i + 9] * ub1(w.z) + x[16 * i + 10] * ub2(w.z) + x[16 * i + 11] * ub3(w.z)
                         + x[16 * i + 12] * ub0(w.w) + x[16 * i + 13] * ub1(w.w) + x[16 * i + 14] * ub2(w.w) + x[16 * i + 15] * ub3(w.w);
                }
                d[r] = acc;
            }
            const bool b5 = lane & 32, b4 = lane & 16, b3 = lane & 8;
            float t4[4];
#pragma unroll
            for (int q = 0; q < 4; ++q) { const float keep = b5 ? d[4 + q] : d[q], send = b5 ? d[q] : d[4 + q]; t4[q] = keep + __shfl_xor(send, 32); }
            float t2[2];
#pragma unroll
            for (int q = 0; q < 2; ++q) { const float keep = b4 ? t4[2 + q] : t4[q], send = b4 ? t4[q] : t4[2 + q]; t2[q] = keep + __shfl_xor(send, 16); }
            float t1;
            { const float keep = b3 ? t2[1] : t2[0], send = b3 ? t2[0] : t2[1]; t1 = keep + __shfl_xor(send, 8); }
            t1 += __shfl_xor(t1, 4); t1 += __shfl_xor(t1, 2); t1 += __shfl_xor(t1, 1);
            if ((lane & 7) == 0) hb[bt * 8 + (lane >> 3 & 1) + 2 * (lane >> 4 & 1) + 4 * (lane >> 5 & 1)] = t1;
        }
        asm volatile("s_waitcnt lgkmcnt(0)" ::: "memory");
        const float h0 = hb[lane] * USC[e0], h1 = hb[64 + lane] * USC[e1];
        const float w0 = g0 * gelu_erf(h0) * VSC[e0], w1 = g1 * gelu_erf(h1) * VSC[e1];
        float wsum = wave_sum(w0 + w1);
        float y[32];
#pragma unroll
        for (int i = 0; i < 32; ++i) y[i] = 0.f;
#pragma unroll 8
        for (int e = 0; e < 128; ++e) {
            const int idx = __builtin_amdgcn_readfirstlane(__shfl(e < 64 ? e0 : e1, e & 63));
            const float wt = __shfl(e < 64 ? w0 : w1, e & 63);
            const u32x4* vp = (const u32x4*)(V + (size_t)idx * DM) + lane;
#pragma unroll
            for (int i = 0; i < 2; ++i) {
                const u32x4 w = vp[i * 64];
                y[16 * i + 0] += wt * ub0(w.x); y[16 * i + 1] += wt * ub1(w.x); y[16 * i + 2] += wt * ub2(w.x); y[16 * i + 3] += wt * ub3(w.x);
                y[16 * i + 4] += wt * ub0(w.y); y[16 * i + 5] += wt * ub1(w.y); y[16 * i + 6] += wt * ub2(w.y); y[16 * i + 7] += wt * ub3(w.y);
                y[16 * i + 8] += wt * ub0(w.z); y[16 * i + 9] += wt * ub1(w.z); y[16 * i + 10] += wt * ub2(w.z); y[16 * i + 11] += wt * ub3(w.z);
                y[16 * i + 12] += wt * ub0(w.w); y[16 * i + 13] += wt * ub1(w.w); y[16 * i + 14] += wt * ub2(w.w); y[16 * i + 15] += wt * ub3(w.w);
            }
        }
        const float corr = -128.0f * wsum;
#pragma unroll
        for (int i = 0; i < 32; ++i) y[i] = y[i] + corr + ALPHA * x[i];
        ln_row_store16(y, g, bta, outf + (size_t)tok * DM, outb ? outb + (size_t)tok * DM : nullptr, lane);
        asm volatile("s_waitcnt lgkmcnt(0)" ::: "memory");
    }
}

__device__ __forceinline__ int row_dot_i8(const u32x4 (&xq)[2], const unsigned char* rowp, int lane) {
    const u32x4* up = (const u32x4*)rowp + lane;
    int acc = 0;
#pragma unroll
    for (int i = 0; i < 2; ++i) {
        const u32x4 w = up[i * 64];
        acc = __builtin_amdgcn_sdot4((int)xq[i].x, (int)(w.x ^ 0x80808080u), acc, false); acc = __builtin_amdgcn_sdot4((int)xq[i].y, (int)(w.y ^ 0x80808080u), acc, false);
        acc = __builtin_amdgcn_sdot4((int)xq[i].z, (int)(w.z ^ 0x80808080u), acc, false); acc = __builtin_amdgcn_sdot4((int)xq[i].w, (int)(w.w ^ 0x80808080u), acc, false);
    }
    return acc;
}
__device__ __forceinline__ void peer_issue8(u32x4 (&seg)[8], const unsigned char* base, const u32x4 ia, const u32x4 ib) {
    seg[0] = *(const u32x4*)(base + (size_t)ia.x * DM); seg[1] = *(const u32x4*)(base + (size_t)ia.y * DM); seg[2] = *(const u32x4*)(base + (size_t)ia.z * DM); seg[3] = *(const u32x4*)(base + (size_t)ia.w * DM);
    seg[4] = *(const u32x4*)(base + (size_t)ib.x * DM); seg[5] = *(const u32x4*)(base + (size_t)ib.y * DM); seg[6] = *(const u32x4*)(base + (size_t)ib.z * DM); seg[7] = *(const u32x4*)(base + (size_t)ib.w * DM);
}
__device__ __forceinline__ void peer_dot8(int (&d)[8], const u32x4 (&seg)[8], const u32x4 xq) {
#pragma unroll
    for (int i = 0; i < 8; ++i) {
        int acc = __builtin_amdgcn_sdot4((int)xq.x, (int)(seg[i].x ^ 0x80808080u), 0, false);
        acc = __builtin_amdgcn_sdot4((int)xq.y, (int)(seg[i].y ^ 0x80808080u), acc, false);
        acc = __builtin_amdgcn_sdot4((int)xq.z, (int)(seg[i].z ^ 0x80808080u), acc, false);
        d[i] = __builtin_amdgcn_sdot4((int)xq.w, (int)(seg[i].w ^ 0x80808080u), acc, false);
    }
}
__device__ __forceinline__ void phase_peer_u(const signed char* XQ, const int* EID, const unsigned char* U, LAS int* HL  ) {
    const int lane = threadIdx.x & 63, wv = threadIdx.x >> 6, es = lane >> 3, cc = lane & 7;
    const bool b2 = cc & 4, b1 = cc & 2, b0 = cc & 1;
    const int nw = gridDim.x * 8, gw = blockIdx.x * 8 + wv, tpw = (MTOK + nw - 1) / nw, tbase = gw * tpw;
    int cnt = MTOK - tbase; cnt = cnt > tpw ? tpw : cnt;
    if (cnt <= 0) return;
    for (int i = lane; i < cnt * 128; i += 64) HL[i] = 0;
    asm volatile("s_waitcnt lgkmcnt(0)" ::: "memory");
    const int nit = 16 * cnt;
    const unsigned char* ub = U + cc * 16;
    u32x4 idA0, idA1, idB0, idB1, xqA; u32x4 sA[8], sB[8];
#define PU_META(k_, half_, I0, I1) { const int* ep_ = EID + (size_t)(tbase + (k_)) * 128 + es * 16 + (half_) * 8; I0 = *(const u32x4*)ep_; I1 = *(const u32x4*)(ep_ + 4); }
#define PU_XQ(sl_, k_, XQv) { XQv = *(const u32x4*)(XQ + (size_t)(tbase + (k_)) * DM + (sl_) * 128 + cc * 16); }
    PU_META(0, 0, idA0, idA1) PU_XQ(0, 0, xqA)
    peer_issue8(sA, ub, idA0, idA1);
    PU_META(0, 1, idB0, idB1)
    int sl = 0, k = 0;
    for (int it = 0; it < nit; ++it) {
        int kn = k + 1, sln = sl; if (kn == cnt) { kn = 0; ++sln; } if (it + 1 == nit) { kn = k; sln = sl; }
        peer_issue8(sB, ub + sl * 128, idB0, idB1);
        const u32x4 xq = xqA;
        PU_META(kn, 0, idA0, idA1) PU_XQ(sln, kn, xqA)
        int dlo[8]; peer_dot8(dlo, sA, xq);
        peer_issue8(sA, ub + sln * 128, idA0, idA1);
        PU_META(kn, 1, idB0, idB1)
        int dhi[8]; peer_dot8(dhi, sB, xq);
        int t8[8], t4[4], t2[2];
#pragma unroll
        for (int q = 0; q < 8; ++q) { const int keep = b2 ? dhi[q] : dlo[q], send = b2 ? dlo[q] : dhi[q]; t8[q] = keep + __shfl_xor(send, 4); }
#pragma unroll
        for (int q = 0; q < 4; ++q) { const int keep = b1 ? t8[4 + q] : t8[q], send = b1 ? t8[q] : t8[4 + q]; t4[q] = keep + __shfl_xor(send, 2); }
#pragma unroll
        for (int q = 0; q < 2; ++q) { const int keep = b0 ? t4[2 + q] : t4[q], send = b0 ? t4[q] : t4[2 + q]; t2[q] = keep + __shfl_xor(send, 1); }
        { LAS int* hp = HL + k * 128 + es * 16 + (b2 ? 8 : 0) + (b1 ? 4 : 0) + (b0 ? 2 : 0);
          __hip_atomic_fetch_add(hp, t2[0], __ATOMIC_RELAXED, __HIP_MEMORY_SCOPE_WORKGROUP); __hip_atomic_fetch_add(hp + 1, t2[1], __ATOMIC_RELAXED, __HIP_MEMORY_SCOPE_WORKGROUP); }
        k = kn; sl = sln;
    }
#undef PU_META
#undef PU_XQ
}
__device__ __forceinline__ void phase_peer_w(const LAS int* HL, const float* XS, const int* EID, const float* GATE, const float* USC, const float* VSC, float* W, float* CS) {
    const int lane = threadIdx.x & 63, gw = blockIdx.x * 8 + (threadIdx.x >> 6), nw = gridDim.x * 8, tpw = (MTOK + nw - 1) / nw, tbase = gw * tpw;
    const int tend = tbase + tpw < MTOK ? tbase + tpw : MTOK;
    for (int tok = tbase; tok < tend; ++tok) {
        const int h0 = HL[(tok - tbase) * 128 + lane], h1 = HL[(tok - tbase) * 128 + 64 + lane];
        const int e0 = EID[(size_t)tok * 128 + lane], e1 = EID[(size_t)tok * 128 + 64 + lane];
        const float xs = XS[tok];
        const float w0 = GATE[(size_t)tok * 128 + lane] * gelu_erf((float)h0 * xs * USC[e0]) * VSC[e0];
        const float w1 = GATE[(size_t)tok * 128 + 64 + lane] * gelu_erf((float)h1 * xs * USC[e1]) * VSC[e1];
        W[(size_t)tok * 128 + lane] = w0; W[(size_t)tok * 128 + 64 + lane] = w1;
        const float cs = wave_sum(w0 + w1);
        if (lane == 0) CS[tok] = cs;
    }
}
__device__ __forceinline__ void peer_fma8(f32x2_t (&ya)[8], const u32x4 (&seg)[8], const f32x4 wa, const f32x4 wb2) {
#pragma unroll
    for (int i = 0; i < 8; ++i) {
        const float wt = i < 4 ? wa[i & 3] : wb2[i & 3];
        const f32x2_t wt2 = {wt, wt};
        const u32x4 w = seg[i];
        ya[0] = __builtin_elementwise_fma(wt2, (f32x2_t){ub0(w.x), ub1(w.x)}, ya[0]); ya[1] = __builtin_elementwise_fma(wt2, (f32x2_t){ub2(w.x), ub3(w.x)}, ya[1]);
        ya[2] = __builtin_elementwise_fma(wt2, (f32x2_t){ub0(w.y), ub1(w.y)}, ya[2]); ya[3] = __builtin_elementwise_fma(wt2, (f32x2_t){ub2(w.y), ub3(w.y)}, ya[3]);
        ya[4] = __builtin_elementwise_fma(wt2, (f32x2_t){ub0(w.z), ub1(w.z)}, ya[4]); ya[5] = __builtin_elementwise_fma(wt2, (f32x2_t){ub2(w.z), ub3(w.z)}, ya[5]);
        ya[6] = __builtin_elementwise_fma(wt2, (f32x2_t){ub0(w.w), ub1(w.w)}, ya[6]); ya[7] = __builtin_elementwise_fma(wt2, (f32x2_t){ub2(w.w), ub3(w.w)}, ya[7]);
    }
}
__device__ __forceinline__ void phase_peer_v(const float* X, const int* EID, const float* W, const float* CS, const unsigned char* V, float* Y) {
    const int lane = threadIdx.x & 63, wv = threadIdx.x >> 6, es = lane >> 3, cc = lane & 7;
    const bool b5 = lane & 32, b4 = lane & 16, b3 = lane & 8;
    const int nw = gridDim.x * 8, gw = blockIdx.x * 8 + wv, tpw = (MTOK + nw - 1) / nw, tbase = gw * tpw;
    int cnt = MTOK - tbase; cnt = cnt > tpw ? tpw : cnt;
    if (cnt <= 0) return;
    const int nit = 16 * cnt;
    const unsigned char* vb = V + cc * 16;
    const int colo = cc * 16 + (b5 ? 8 : 0) + (b4 ? 4 : 0) + (b3 ? 2 : 0);
    u32x4 idA0, idA1, idB0, idB1; f32x4 wA0, wA1, wB0, wB1; f32x2_t xr; float cs; u32x4 sA[8], sB[8];
#define PV_META(k_, half_, I0, I1, W0, W1) { const size_t o_ = (size_t)(tbase + (k_)) * 128 + es * 16 + (half_) * 8; \
        I0 = *(const u32x4*)(EID + o_); I1 = *(const u32x4*)(EID + o_ + 4); W0 = *(const f32x4*)(W + o_); W1 = *(const f32x4*)(W + o_ + 4); }
#define PV_XR(sl_, k_) { xr = *(const f32x2_t*)(X + (size_t)(tbase + (k_)) * DM + (sl_) * 128 + colo); cs = CS[tbase + (k_)]; }
    PV_META(0, 0, idA0, idA1, wA0, wA1)
    peer_issue8(sA, vb, idA0, idA1);
    PV_META(0, 1, idB0, idB1, wB0, wB1) PV_XR(0, 0)
    int sl = 0, k = 0;
    for (int it = 0; it < nit; ++it) {
        int kn = k + 1, sln = sl; if (kn == cnt) { kn = 0; ++sln; } if (it + 1 == nit) { kn = k; sln = sl; }
        peer_issue8(sB, vb + sl * 128, idB0, idB1);
        const f32x4 w0 = wA0, w1 = wA1, w2 = wB0, w3 = wB1; const f32x2_t xrc = xr; const float csc = cs;
        PV_META(kn, 0, idA0, idA1, wA0, wA1)
        f32x2_t ya[8];
#pragma unroll
        for (int j = 0; j < 8; ++j) ya[j] = (f32x2_t){0.f, 0.f};
        peer_fma8(ya, sA, w0, w1);
        peer_issue8(sA, vb + sln * 128, idA0, idA1);
        PV_META(kn, 1, idB0, idB1, wB0, wB1) PV_XR(sln, kn)
        peer_fma8(ya, sB, w2, w3);
        f32x2_t t4[4], t2[2], t1;
#pragma unroll
        for (int q = 0; q < 4; ++q) { const f32x2_t keep = b5 ? ya[4 + q] : ya[q], send = b5 ? ya[q] : ya[4 + q]; t4[q][0] = keep[0] + __shfl_xor(send[0], 32); t4[q][1] = keep[1] + __shfl_xor(send[1], 32); }
#pragma unroll
        for (int q = 0; q < 2; ++q) { const f32x2_t keep = b4 ? t4[2 + q] : t4[q], send = b4 ? t4[q] : t4[2 + q]; t2[q][0] = keep[0] + __shfl_xor(send[0], 16); t2[q][1] = keep[1] + __shfl_xor(send[1], 16); }
        { const f32x2_t keep = b3 ? t2[1] : t2[0], send = b3 ? t2[0] : t2[1]; t1[0] = keep[0] + __shfl_xor(send[0], 8); t1[1] = keep[1] + __shfl_xor(send[1], 8); }
        f32x2_t o; o[0] = t1[0] - 128.0f * csc + ALPHA * xrc[0]; o[1] = t1[1] - 128.0f * csc + ALPHA * xrc[1];
        *(f32x2_t*)(Y + (size_t)(tbase + k) * DM + sl * 128 + colo) = o;
        k = kn; sl = sln;
    }
#undef PV_META
#undef PV_XR
}

__device__ __forceinline__ void rot8(const u32x4 lo, const u32x4 hi, const f32x4 c0, const f32x4 c1, const f32x4 s0, const f32x4 s1, float (&o1)[8], float (&o2)[8]) {
    const float a[8] = {bflo(lo.x), bfhi(lo.x), bflo(lo.y), bfhi(lo.y), bflo(lo.z), bfhi(lo.z), bflo(lo.w), bfhi(lo.w)};
    const float b[8] = {bflo(hi.x), bfhi(hi.x), bflo(hi.y), bfhi(hi.y), bflo(hi.z), bfhi(hi.z), bflo(hi.w), bfhi(hi.w)};
    const float c[8] = {c0[0], c0[1], c0[2], c0[3], c1[0], c1[1], c1[2], c1[3]}, sn[8] = {s0[0], s0[1], s0[2], s0[3], s1[0], s1[1], s1[2], s1[3]};
#pragma unroll
    for (int j = 0; j < 8; ++j) { o1[j] = a[j] * c[j] - b[j] * sn[j]; o2[j] = a[j] * sn[j] + b[j] * c[j]; }
}
__device__ __forceinline__ u32x4 pack8(const float (&o)[8]) { u32x4 w; w.x = pk_bf16(o[0], o[1]); w.y = pk_bf16(o[2], o[3]); w.z = pk_bf16(o[4], o[5]); w.w = pk_bf16(o[6], o[7]); return w; }
__device__ __forceinline__ void phase_rot(LAS float* red, bf16_t* KR, bf16_t* QR, const float* COS, const float* SIN, float* KMEAN, float* KNMAX) {
    const int tid = threadIdx.x, ch = tid & 7, rr = tid >> 3, wv = tid >> 6, lane = tid & 63;
    for (int item = blockIdx.x; item < 2 * NHEAD * 32; item += gridDim.x) {
        const int bh = item >> 5, j = item & 31, b = bh >> 4, h = bh & 15;
        float sm1[8], sm2[8]; float nmax = 0.f;
#pragma unroll
        for (int q = 0; q < 8; ++q) { sm1[q] = 0.f; sm2[q] = 0.f; }
#pragma unroll
        for (int ps = 0; ps < 4; ++ps) {
            const int pos = j * 256 + ps * 64 + rr;
            const size_t off = ((size_t)b * SEQ + pos) * DM + h * 128 + ch * 8;
            const f32x4 c0 = *(const f32x4*)(COS + pos * 64 + ch * 8), c1 = *(const f32x4*)(COS + pos * 64 + ch * 8 + 4);
            const f32x4 s0 = *(const f32x4*)(SIN + pos * 64 + ch * 8), s1 = *(const f32x4*)(SIN + pos * 64 + ch * 8 + 4);
            float o1[8], o2[8];
            rot8(*(const u32x4*)(KR + off), *(const u32x4*)(KR + off + 64), c0, c1, s0, s1, o1, o2);
            *(u32x4*)(KR + off) = pack8(o1); *(u32x4*)(KR + off + 64) = pack8(o2);
            float nq = 0.f;
#pragma unroll
            for (int q = 0; q < 8; ++q) { sm1[q] += o1[q]; sm2[q] += o2[q]; nq += o1[q] * o1[q] + o2[q] * o2[q]; }
            nq += __shfl_xor(nq, 1); nq += __shfl_xor(nq, 2); nq += __shfl_xor(nq, 4);
            nmax = fmaxf(nmax, nq);
            rot8(*(const u32x4*)(QR + off), *(const u32x4*)(QR + off + 64), c0, c1, s0, s1, o1, o2);
            *(u32x4*)(QR + off) = pack8(o1); *(u32x4*)(QR + off + 64) = pack8(o2);
        }
#pragma unroll
        for (int q = 0; q < 8; ++q) {
            sm1[q] += __shfl_xor(sm1[q], 8); sm1[q] += __shfl_xor(sm1[q], 16); sm1[q] += __shfl_xor(sm1[q], 32);
            sm2[q] += __shfl_xor(sm2[q], 8); sm2[q] += __shfl_xor(sm2[q], 16); sm2[q] += __shfl_xor(sm2[q], 32);
        }
        nmax = wave_max(nmax);
        if (lane < 8) {
#pragma unroll
            for (int q = 0; q < 8; ++q) { red[wv * 128 + lane * 8 + q] = sm1[q]; red[wv * 128 + 64 + lane * 8 + q] = sm2[q]; }
        }
        if (lane == 0) red[1024 + wv] = nmax;
        __syncthreads();
        if (tid < 128) {
            float s2 = 0.f;
#pragma unroll
            for (int r = 0; r < 8; ++r) s2 += red[r * 128 + tid];
            KMEAN[(size_t)item * 128 + tid] = s2 * (1.0f / 256.0f);
        }
        if (tid == 0) {
            float m = 0.f;
#pragma unroll
            for (int r = 0; r < 8; ++r) m = fmaxf(m, red[1024 + r]);
            KNMAX[item] = sqrtf(m);
        }
        __syncthreads();
    }
}

__device__ __forceinline__ void top3_insert(float x, int m, float& v0, int& i0, float& v1, int& i1, float& v2, int& i2) {
    const bool c0 = x > v0 || (x == v0 && m < i0), c1 = x > v1 || (x == v1 && m < i1), c2 = x > v2 || (x == v2 && m < i2);
    v2 = c1 ? v1 : (c2 ? x : v2); i2 = c1 ? i1 : (c2 ? m : i2);
    v1 = c0 ? v0 : (c1 ? x : v1); i1 = c0 ? i0 : (c1 ? m : i1);
    v0 = c0 ? x : v0; i0 = c0 ? m : i0;
}
__device__ __forceinline__ void phase_sel(LAS unsigned char* lds, const bf16_t* QR, const float* KMEAN, unsigned short* SUB, int* CNT, int* ctr) {
    const int tid = threadIdx.x, lane = tid & 63, wv = tid >> 6, r32 = lane & 31, hh = lane >> 5;
    LAS unsigned short* bucket = (LAS unsigned short*)lds;
    LAS int* cnt = (LAS int*)(lds + 16384);
    const float NEG = -1e30f;
    if (blockIdx.x == 0 && tid == 0) *ctr = 0;
    for (int item = blockIdx.x; item < 2 * NHEAD * 32; item += gridDim.x) {
        const int bh = item >> 5, i = item & 31, b = bh >> 4, h = bh & 15;
        if (i == 0) continue;
        if (tid < 32) cnt[tid] = 0;
        __syncthreads();
        const float* kmp = KMEAN + ((size_t)bh * 32 + r32) * 128 + 8 * hh;
        const size_t tok = (size_t)b * SEQ + i * 256 + wv * 32 + r32;
        const bf16_t* qp = QR + tok * DM + h * 128 + 8 * hh;
        f32x16 S;
#pragma unroll
        for (int e = 0; e < 16; ++e) S[e] = 0.f;
#pragma unroll
        for (int s2 = 0; s2 < 8; ++s2) {
            const f32x4 ka = *(const f32x4*)(kmp + 16 * s2), kb = *(const f32x4*)(kmp + 16 * s2 + 4);
            const bf16x8 qf = *(const bf16x8*)(qp + 16 * s2);
            u32x4 hi, lo;
            hi.x = pk_bf16(ka[0], ka[1]); hi.y = pk_bf16(ka[2], ka[3]); hi.z = pk_bf16(kb[0], kb[1]); hi.w = pk_bf16(kb[2], kb[3]);
            lo.x = pk_bf16(ka[0] - bflo(hi.x), ka[1] - bfhi(hi.x)); lo.y = pk_bf16(ka[2] - bflo(hi.y), ka[3] - bfhi(hi.y));
            lo.z = pk_bf16(kb[0] - bflo(hi.z), kb[1] - bfhi(hi.z)); lo.w = pk_bf16(kb[2] - bflo(hi.w), kb[3] - bfhi(hi.w));
            S = __builtin_amdgcn_mfma_f32_32x32x16_bf16(__builtin_bit_cast(bf16x8, hi), qf, S, 0, 0, 0);
            S = __builtin_amdgcn_mfma_f32_32x32x16_bf16(__builtin_bit_cast(bf16x8, lo), qf, S, 0, 0, 0);
        }
        float v0 = -3e38f, v1 = -3e38f, v2 = -3e38f; int i0 = 99, i1 = 99, i2 = 99;
#pragma unroll
        for (int e = 0; e < 16; ++e) {
            const int m = (e & 3) + 8 * (e >> 2) + 4 * hh;
            const float x = m < i ? S[e] : NEG;
            top3_insert(x, m, v0, i0, v1, i1, v2, i2);
        }
        {
            const float pv0 = __shfl_xor(v0, 32), pv1 = __shfl_xor(v1, 32), pv2 = __shfl_xor(v2, 32);
            const int pi0 = __shfl_xor(i0, 32), pi1 = __shfl_xor(i1, 32), pi2 = __shfl_xor(i2, 32);
            top3_insert(pv0, pi0, v0, i0, v1, i1, v2, i2); top3_insert(pv1, pi1, v0, i0, v1, i1, v2, i2); top3_insert(pv2, pi2, v0, i0, v1, i1, v2, i2);
        }
        if (hh == 0) {
            const int tl = wv * 32 + r32;
            if (v0 > 0.5f * NEG) { const int p = __hip_atomic_fetch_add(cnt + i0, 1, __ATOMIC_RELAXED, __HIP_MEMORY_SCOPE_WORKGROUP); bucket[i0 * 256 + p] = (unsigned short)(tl | (0 << 8)); }
            if (v1 > 0.5f * NEG) { const int p = __hip_atomic_fetch_add(cnt + i1, 1, __ATOMIC_RELAXED, __HIP_MEMORY_SCOPE_WORKGROUP); bucket[i1 * 256 + p] = (unsigned short)(tl | (1 << 8)); }
            if (v2 > 0.5f * NEG) { const int p = __hip_atomic_fetch_add(cnt + i2, 1, __ATOMIC_RELAXED, __HIP_MEMORY_SCOPE_WORKGROUP); bucket[i2 * 256 + p] = (unsigned short)(tl | (2 << 8)); }
        }
        __syncthreads();
        for (int idx = tid; idx < 32 * 256; idx += 512) {
            const int j = idx >> 8, p = idx & 255;
            if (j < i && p < cnt[j]) SUB[(((size_t)bh * 32 + j) * 32 + i) * 256 + p] = bucket[idx];
        }
        if (tid < i) CNT[((size_t)bh * 32 + tid) * 32 + i] = cnt[tid];
        __syncthreads();
    }
}

__device__ __forceinline__ unsigned off_b(unsigned row, unsigned ch) { return 256u * row + 16u * (ch ^ (((row & 3u) << 2) | ((row >> 2) & 3u))); }
__device__ __forceinline__ unsigned pi32(unsigned m) { return (m & ~12u) | ((m & 4u) << 1) | ((m & 8u) >> 1); }
__device__ __forceinline__ bf16x8 tr_frag(LAS unsigned char* img, unsigned lane, unsigned c, unsigned ks) {
    const unsigned hh = lane >> 5, blk = (lane >> 4) & 1, q = (lane & 15) >> 2, p = lane & 3;
    const unsigned a0 = off_b(16 * ks + 8 * hh + q, 4 * c + 2 * blk + (p >> 1)) + 8 * (p & 1);
    const unsigned a1 = off_b(16 * ks + 8 * hh + 4 + q, 4 * c + 2 * blk + (p >> 1)) + 8 * (p & 1);
    const s16x4 lo = __builtin_amdgcn_ds_read_tr16_b64_v4i16((LAS s16x4*)(img + a0));
    const s16x4 hi = __builtin_amdgcn_ds_read_tr16_b64_v4i16((LAS s16x4*)(img + a1));
    bf16x8 r; r[0] = lo[0]; r[1] = lo[1]; r[2] = lo[2]; r[3] = lo[3]; r[4] = hi[0]; r[5] = hi[1]; r[6] = hi[2]; r[7] = hi[3];
    return r;
}
__device__ __forceinline__ void phase_att(LAS unsigned char* lds, const bf16_t* QR, const bf16_t* KR, const bf16_t* V, const float* KNMAX, const unsigned short* SUB, const int* CNT, int* ctr,
                                          bf16_t* P012, bf16_t* P3, float* LS) {
    const int tid = threadIdx.x, lane = tid & 63, wv = tid >> 6, r32 = lane & 31, hh = lane >> 5;
    LAS unsigned char* Kimg = lds;
    LAS unsigned char* Vimg = lds + 65536;
    LAS int* misc = (LAS int*)(lds + 131072);
    const float SCL2 = 0.08838834764831845f * 1.4426950408889634f;
    for (;;) {
        __syncthreads();
        if (tid == 0) misc[40] = __hip_atomic_fetch_add(ctr, 1, __ATOMIC_RELAXED, __HIP_MEMORY_SCOPE_AGENT);
        __syncthreads();
        const int item = misc[40];
        if (item >= 2 * NHEAD * 32) break;
        const int j = item >> 5, bh = item & 31, b = bh >> 4, h = bh & 15;
#pragma unroll
        for (int r = 0; r < 8; ++r) {
            const int idx = tid + 512 * r, row = idx >> 4, ch = idx & 15;
            const size_t g = ((size_t)b * SEQ + j * 256 + row) * DM + h * 128 + ch * 8;
            const u32x4 kv = *(const u32x4*)(KR + g), vv = *(const u32x4*)(V + g);
            *(LAS u32x4*)(Kimg + off_b(row, ch)) = kv; *(LAS u32x4*)(Vimg + off_b(row, ch)) = vv;
        }
        if (tid <= 32) { int pre = 0; for (int u = j + 1; u < tid; ++u) pre += CNT[((size_t)bh * 32 + j) * 32 + u]; misc[tid] = pre; }
        float kn = (lane < 32) ? KNMAX[bh * 32 + lane] : 0.f;
        kn = wave_max(kn);
        __syncthreads();
        const int total = misc[32], ntile = (256 + total + 31) >> 5;
        for (int tile = wv; tile < ntile; tile += 8) {
            const int gr = tile * 32 + r32;
            int pos, slot; bool valid = true;
            if (gr < 256) { pos = j * 256 + gr; slot = 3; }
            else {
                const int x = gr - 256; valid = x < total;
                int ii = j + 1;
                for (int u = j + 1; u < 32; ++u) if (misc[u] <= x) ii = u;
                if (valid) { const unsigned e = SUB[(((size_t)bh * 32 + j) * 32 + ii) * 256 + (x - misc[ii])]; pos = ii * 256 + (int)(e & 255u); slot = (int)(e >> 8); }
                else { pos = j * 256; slot = 3; }
            }
            const size_t tok = (size_t)b * SEQ + pos;
            bf16x8 qf[8];
            const bf16_t* qp = QR + tok * DM + h * 128 + 8 * hh;
#pragma unroll
            for (int s = 0; s < 8; ++s) qf[s] = *(const bf16x8*)(qp + 16 * s);
            float qn2 = 0.f;
#pragma unroll
            for (int s = 0; s < 8; ++s)
#pragma unroll
                for (int e = 0; e < 8; ++e) { const float f = bf2f((bf16_t)qf[s][e]); qn2 += f * f; }
            qn2 += __shfl_xor(qn2, 32);
            const float c2 = sqrtf(qn2) * kn * SCL2;
            f32x16 O[4];
#pragma unroll
            for (int dt = 0; dt < 4; ++dt)
#pragma unroll
                for (int e = 0; e < 16; ++e) O[dt][e] = 0.f;
            float l = 0.f;
            const bool own = tile < 8;
            const int kcn = own ? tile + 1 : 8;
            const unsigned krow = pi32((unsigned)r32);
            for (int kc = 0; kc < kcn; ++kc) {
                f32x16 S;
#pragma unroll
                for (int e = 0; e < 16; ++e) S[e] = 0.f;
#pragma unroll
                for (int s = 0; s < 8; ++s) {
                    const bf16x8 kf = *(const LAS bf16x8*)(Kimg + off_b(32 * kc + krow, 2 * s + hh));
                    S = __builtin_amdgcn_mfma_f32_32x32x16_bf16(kf, qf[s], S, 0, 0, 0);
                }
                float p[16];
#pragma unroll
                for (int e = 0; e < 16; ++e) {
                    const unsigned m = (e & 3) + 8 * (e >> 2) + 4 * hh;
                    const int key = j * 256 + 32 * kc + (int)pi32(m);
                    float pe = __builtin_amdgcn_exp2f(S[e] * SCL2 - c2);
                    if (own && key > pos) pe = 0.f;
                    p[e] = pe; l += pe;
                }
                u32x4 w0, w1;
                w0.x = pk_bf16(p[0], p[1]); w0.y = pk_bf16(p[2], p[3]); w0.z = pk_bf16(p[4], p[5]); w0.w = pk_bf16(p[6], p[7]);
                w1.x = pk_bf16(p[8], p[9]); w1.y = pk_bf16(p[10], p[11]); w1.z = pk_bf16(p[12], p[13]); w1.w = pk_bf16(p[14], p[15]);
                const bf16x8 pf0 = __builtin_bit_cast(bf16x8, w0), pf1 = __builtin_bit_cast(bf16x8, w1);
#pragma unroll
                for (int dt = 0; dt < 4; ++dt) {
                    const bf16x8 v0 = tr_frag(Vimg, lane, dt, 2 * kc), v1 = tr_frag(Vimg, lane, dt, 2 * kc + 1);
                    O[dt] = __builtin_amdgcn_mfma_f32_32x32x16_bf16(v0, pf0, O[dt], 0, 0, 0);
                    O[dt] = __builtin_amdgcn_mfma_f32_32x32x16_bf16(v1, pf1, O[dt], 0, 0, 0);
                }
            }
            l += __shfl_xor(l, 32);
            if (valid) {
                bf16_t* pl = (slot < 3 ? P012 + (size_t)slot * ((size_t)32 << 20) : P3) + (tok * NHEAD + h) * 128 + 4 * hh;
#pragma unroll
                for (int dt = 0; dt < 4; ++dt)
#pragma unroll
                    for (int g = 0; g < 4; ++g) {
                        u32x2 w; w.x = pk_bf16(O[dt][4 * g], O[dt][4 * g + 1]); w.y = pk_bf16(O[dt][4 * g + 2], O[dt][4 * g + 3]);
                        *(u32x2*)(pl + 32 * dt + 8 * g) = w;
                    }
                if (hh == 0) LS[(size_t)slot * MTOK * NHEAD + tok * NHEAD + h] = l;
            }
        }
    }
}
__device__ __forceinline__ void phase_comb(const bf16_t* P012, const bf16_t* P3, const float* LS, bf16_t* AO) {
    const size_t n = (size_t)MTOK * NHEAD * 16, stride = (size_t)gridDim.x * 512;
    for (size_t idx = (size_t)blockIdx.x * 512 + threadIdx.x; idx < n; idx += stride) {
        const size_t th = idx >> 4; const int ch = (int)(idx & 15);
        const int t = (int)((th >> 4) & (SEQ - 1)), blk = t >> 8, nsel = blk < 3 ? blk : 3;
        float acc[8];
        float l = LS[(size_t)3 * MTOK * NHEAD + th];
        { const u32x4 w = *(const u32x4*)(P3 + th * 128 + ch * 8);
          acc[0] = bflo(w.x); acc[1] = bfhi(w.x); acc[2] = bflo(w.y); acc[3] = bfhi(w.y); acc[4] = bflo(w.z); acc[5] = bfhi(w.z); acc[6] = bflo(w.w); acc[7] = bfhi(w.w); }
        for (int s = 0; s < nsel; ++s) {
            const u32x4 w = *(const u32x4*)(P012 + (size_t)s * ((size_t)32 << 20) + th * 128 + ch * 8);
            acc[0] += bflo(w.x); acc[1] += bfhi(w.x); acc[2] += bflo(w.y); acc[3] += bfhi(w.y); acc[4] += bflo(w.z); acc[5] += bfhi(w.z); acc[6] += bflo(w.w); acc[7] += bfhi(w.w);
            l += LS[(size_t)s * MTOK * NHEAD + th];
        }
        const float rl = 1.0f / l;
        u32x4 o; o.x = pk_bf16(acc[0] * rl, acc[1] * rl); o.y = pk_bf16(acc[2] * rl, acc[3] * rl); o.z = pk_bf16(acc[4] * rl, acc[5] * rl); o.w = pk_bf16(acc[6] * rl, acc[7] * rl);
        *(u32x4*)(AO + th * 128 + ch * 8) = o;
    }
}

__device__ __forceinline__ float logf_gate(float z, float lb) { return __logf(lb + (1.0f - lb) * sigmoidf_(z)); }
__device__ __forceinline__ void phase_scan_a(LAS unsigned char* lds, const bf16_t* FZ, const float* LB, const bf16_t* I1, bf16_t* LT, float* DEC, unsigned* dbgc = nullptr) {
    unsigned dbg_kt = 0, dbg_acc = 0;
    const int tid = threadIdx.x, lane = tid & 63, wv = tid >> 6, k = tid & 127, part = tid >> 7;
    LAS unsigned char* Iimg = lds; LAS unsigned char* KTimg = lds + 16384;
    LAS float* psum = (LAS float*)(lds + 32768);
    LAS unsigned char* Lst = lds + 36864;
#if SCAN_A_VALU == 2
    for (int item = blockIdx.x; item < 2 * NHEAD * 128; item += gridDim.x) {
        const int bh = item >> 7, c = item & 127, b = bh >> 4, h = bh & 15;
        const size_t tok0 = (size_t)b * SEQ + c * 64;
        for (int idx = tid; idx < 16384; idx += 512) {
            const int v = idx >> 7, kk = idx & 127;
            float g = 1.f, L = 0.f;
            for (int s2 = 63; s2 >= 0; --s2) { const size_t o = (tok0 + s2) * DM + h * 128; const float f = __expf(logf_gate(bf2f(FZ[o + kk]), LB[h * 128 + kk])); L += bf2f(I1[o + v]) * (1.0f - f) * g; g *= f; }
            LT[(size_t)item * 16384 + idx] = (bf16_t)(pk_bf16(L, 0.f) & 0xffffu);
        }
    }
    return;
#endif
    bf16_t nfz[16]; u32x4 nit_[2];
#define SA_LOAD(item_) { const int bh_ = (item_) >> 7, c_ = (item_) & 127; const size_t t0_ = (size_t)(bh_ >> 4) * SEQ + c_ * 64; const int h_ = bh_ & 15; \
        _Pragma("unroll") for (int i = 0; i < 16; ++i) nfz[i] = FZ[(t0_ + 16 * part + i) * DM + h_ * 128 + k]; \
        _Pragma("unroll") for (int r = 0; r < 2; ++r) { const int idx = tid + 512 * r, row = idx >> 4, ch = idx & 15; nit_[r] = *(const u32x4*)(I1 + (t0_ + row) * DM + h_ * 128 + ch * 8); } }
    if ((int)blockIdx.x < 2 * NHEAD * 128) SA_LOAD((int)blockIdx.x)
    for (int item = blockIdx.x; item < 2 * NHEAD * 128; item += gridDim.x) {
        const int bh = item >> 7, c = item & 127, b = bh >> 4, h = bh & 15;
        const size_t tok0 = (size_t)b * SEQ + c * 64;
        float lf[16];
        const float lbk = LB[h * 128 + k];
#pragma unroll
        for (int i = 0; i < 16; ++i) lf[i] = logf_gate(bf2f(nfz[i]), lbk);
#pragma unroll
        for (int r = 0; r < 2; ++r) { const int idx = tid + 512 * r, row = idx >> 4, ch = idx & 15; *(LAS u32x4*)(Iimg + off_b(row, ch)) = nit_[r]; }
        if (item + (int)gridDim.x < 2 * NHEAD * 128) SA_LOAD(item + (int)gridDim.x)
        float cs = 0.f;
#pragma unroll
        for (int i = 0; i < 16; ++i) cs += lf[i];
        psum[part * 128 + k] = cs;
        __syncthreads();
        const float p0 = psum[k], p1 = psum[128 + k], p2 = psum[256 + k], p3 = psum[384 + k];
        const float blast = (p0 + p1) + (p2 + p3);
        float bb = part == 0 ? 0.f : (part == 1 ? p0 : (part == 2 ? p0 + p1 : p0 + p1 + p2));
#pragma unroll
        for (int i = 0; i < 16; ++i) {
            bb += lf[i];
            const float kt = (1.0f - __expf(lf[i])) * __expf(blast - bb);
            if (!(kt - kt == 0.f)) ++dbg_kt;
            const int srow = 16 * part + i;
            *(LAS bf16_t*)(KTimg + off_b(srow, k >> 3) + 2 * (k & 7)) = (bf16_t)(pk_bf16(kt, 0.f) & 0xffffu);
        }
        if (part == 0) DEC[(size_t)item * 128 + k] = __expf(blast);
        __syncthreads();
#if SCAN_A_VALU
        for (int idx = tid; idx < 16384; idx += 512) {
            const int v = idx >> 7, kk = idx & 127;
            float accv = 0.f;
            for (int s2 = 0; s2 < 64; ++s2) accv += bf2f(*(const LAS bf16_t*)(Iimg + off_b(s2, v >> 3) + 2 * (v & 7))) * bf2f(*(const LAS bf16_t*)(KTimg + off_b(s2, kk >> 3) + 2 * (kk & 7)));
            *(LAS bf16_t*)(Lst + v * 272 + 2 * kk) = (bf16_t)(pk_bf16(accv, 0.f) & 0xffffu);
        }
        if (0)
#endif
        {
            const int vt = wv >> 1;
            f32x16 acc0, acc1;
#pragma unroll
            for (int e = 0; e < 16; ++e) { acc0[e] = 0.f; acc1[e] = 0.f; }
#pragma unroll
            for (int ks = 0; ks < 4; ++ks) {
                const bf16x8 af = tr_frag(Iimg, lane, vt, ks);
                const bf16x8 b0 = tr_frag(KTimg, lane, 2 * (wv & 1), ks), b1 = tr_frag(KTimg, lane, 2 * (wv & 1) + 1, ks);
                acc0 = __builtin_amdgcn_mfma_f32_32x32x16_bf16(af, b0, acc0, 0, 0, 0);
                acc1 = __builtin_amdgcn_mfma_f32_32x32x16_bf16(af, b1, acc1, 0, 0, 0);
            }
            const int r32 = lane & 31, hh = lane >> 5;
#pragma unroll
            for (int e = 0; e < 16; ++e) {
                if (!(acc0[e] - acc0[e] == 0.f)) ++dbg_acc; if (!(acc1[e] - acc1[e] == 0.f)) ++dbg_acc;
                const int v = 32 * vt + (e & 3) + 8 * (e >> 2) + 4 * hh;
                *(LAS bf16_t*)(Lst + v * 272 + 2 * (64 * (wv & 1) + r32)) = (bf16_t)(pk_bf16(acc0[e], 0.f) & 0xffffu);
                *(LAS bf16_t*)(Lst + v * 272 + 2 * (64 * (wv & 1) + 32 + r32)) = (bf16_t)(pk_bf16(acc1[e], 0.f) & 0xffffu);
            }
        }
        __syncthreads();
#pragma unroll
        for (int r = 0; r < 4; ++r) { const int idx = tid + 512 * r, row = idx >> 4, ch = idx & 15; *(u32x4*)(LT + (size_t)item * 16384 + row * 128 + ch * 8) = *(const LAS u32x4*)(Lst + row * 272 + ch * 16); }
        __syncthreads();
    }
    if (dbgc) { if (dbg_kt) atomicAdd(dbgc + 0, dbg_kt); if (dbg_acc) atomicAdd(dbgc + 1, dbg_acc); }
}
__device__ __forceinline__ void phase_scan_b(bf16_t* LT, const float* DEC) {
    const int n = 2 * NHEAD * 128 * 32;
    for (int idx = blockIdx.x * 512 + threadIdx.x; idx < n; idx += gridDim.x * 512) {
        const int bh = idx >> 12, vk = idx & 4095, k4 = (vk & 31) * 4;
        float S0 = 0.f, S1 = 0.f, S2 = 0.f, S3 = 0.f;
        bf16_t* p = LT + (size_t)bh * 128 * 16384 + (size_t)vk * 4;
        const float* dp = DEC + (size_t)bh * 128 * 128 + k4;
#pragma unroll 16
        for (int c = 0; c < 128; ++c) {
            const u32x2 w = *(const u32x2*)(p + (size_t)c * 16384);
            const f32x4 d = *(const f32x4*)(dp + c * 128);
            u32x2 o; o.x = pk_bf16(S0, S1); o.y = pk_bf16(S2, S3);
            *(u32x2*)(p + (size_t)c * 16384) = o;
            S0 = d[0] * S0 + bflo(w.x); S1 = d[1] * S1 + bfhi(w.x); S2 = d[2] * S2 + bflo(w.y); S3 = d[3] * S3 + bfhi(w.y);
        }
    }
}
__device__ __forceinline__ void phase_scan_c(LAS unsigned char* lds, const bf16_t* Q1, const bf16_t* FZ, const float* LB, const bf16_t* I1, const bf16_t* G1, const bf16_t* SP, const float* gnorm, bf16_t* OG) {
    const int tid = threadIdx.x, lane = tid & 63, wv = tid >> 6, k = tid & 127, part = tid >> 7, r32 = lane & 31, hh = lane >> 5;
    LAS unsigned char* QTimg = lds; LAS unsigned char* QPimg = lds + 16384; LAS unsigned char* KPimg = lds + 32768; LAS unsigned char* Iimg = lds + 49152; LAS unsigned char* SPimg = lds + 65536;
    LAS float* psum = (LAS float*)(lds + 98304);
    LAS float* ssq = (LAS float*)(lds + 100352);
    LAS unsigned char* OT = lds + 102400;
    bf16_t nfz[16], nq[16]; u32x4 nit_[2], nsp[4], ngt[2];
#define SC_LOAD(item_) { const int bh_ = (item_) >> 7, c_ = (item_) & 127; const size_t t0_ = (size_t)(bh_ >> 4) * SEQ + c_ * 64; const int h_ = bh_ & 15; \
        _Pragma("unroll") for (int i = 0; i < 16; ++i) { const size_t o_ = (t0_ + 16 * part + i) * DM + h_ * 128 + k; nfz[i] = FZ[o_]; nq[i] = Q1[o_]; } \
        _Pragma("unroll") for (int r = 0; r < 2; ++r) { const int idx = tid + 512 * r, row = idx >> 4, ch = idx & 15; nit_[r] = *(const u32x4*)(I1 + (t0_ + row) * DM + h_ * 128 + ch * 8); ngt[r] = *(const u32x4*)(G1 + (t0_ + row) * DM + h_ * 128 + ch * 8); } \
        _Pragma("unroll") for (int r = 0; r < 4; ++r) { const int idx = tid + 512 * r, row = idx >> 4, ch = idx & 15; nsp[r] = *(const u32x4*)(SP + (size_t)(item_) * 16384 + row * 128 + ch * 8); } }
    if ((int)blockIdx.x < 2 * NHEAD * 128) SC_LOAD((int)blockIdx.x)
    for (int item = blockIdx.x; item < 2 * NHEAD * 128; item += gridDim.x) {
        const int bh = item >> 7, c = item & 127, b = bh >> 4, h = bh & 15;
        const size_t tok0 = (size_t)b * SEQ + c * 64;
        float lf[16], qv[16];
        const float lbk = LB[h * 128 + k];
#pragma unroll
        for (int i = 0; i < 16; ++i) { lf[i] = logf_gate(bf2f(nfz[i]), lbk); const float qr = bf2f(nq[i]); qv[i] = qr * sigmoidf_(qr); }
#pragma unroll
        for (int r = 0; r < 2; ++r) { const int idx = tid + 512 * r, row = idx >> 4, ch = idx & 15; *(LAS u32x4*)(Iimg + off_b(row, ch)) = nit_[r]; }
#pragma unroll
        for (int r = 0; r < 4; ++r) { const int idx = tid + 512 * r, row = idx >> 4, ch = idx & 15; *(LAS u32x4*)(SPimg + off_b(row, ch)) = nsp[r]; }
        const u32x4 gcur0 = ngt[0], gcur1 = ngt[1];
        if (item + (int)gridDim.x < 2 * NHEAD * 128) SC_LOAD(item + (int)gridDim.x)
        float cs = 0.f;
#pragma unroll
        for (int i = 0; i < 16; ++i) cs += lf[i];
        psum[part * 128 + k] = cs;
        __syncthreads();
        const float p0 = psum[k], p1 = psum[128 + k], p2 = psum[256 + k];
        const float rr = p0 + p1;
        float bb = part == 0 ? 0.f : (part == 1 ? p0 : (part == 2 ? p0 + p1 : p0 + p1 + p2));
#pragma unroll
        for (int i = 0; i < 16; ++i) {
            bb += lf[i];
            const float qt = qv[i] * __expf(bb), qp = qv[i] * __expf(bb - rr), kp = (1.0f - __expf(lf[i])) * __expf(rr - bb);
            const unsigned o = off_b(16 * part + i, k >> 3) + 2 * (k & 7);
            *(LAS bf16_t*)(QTimg + o) = (bf16_t)(pk_bf16(qt, 0.f) & 0xffffu);
            *(LAS bf16_t*)(QPimg + o) = (bf16_t)(pk_bf16(qp, 0.f) & 0xffffu);
            *(LAS bf16_t*)(KPimg + o) = (bf16_t)(pk_bf16(kp, 0.f) & 0xffffu);
        }
        __syncthreads();
        const int tt = wv & 1, vt = wv >> 1;
        f32x16 O;
#pragma unroll
        for (int e = 0; e < 16; ++e) O[e] = 0.f;
#pragma unroll
        for (int ks = 0; ks < 8; ++ks) {
            const bf16x8 af = *(const LAS bf16x8*)(SPimg + off_b(32 * vt + r32, 2 * ks + hh));
            const bf16x8 bf = *(const LAS bf16x8*)(QTimg + off_b(32 * tt + r32, 2 * ks + hh));
            O = __builtin_amdgcn_mfma_f32_32x32x16_bf16(af, bf, O, 0, 0, 0);
        }
        const unsigned krow = pi32((unsigned)r32);
        for (int st = 0; st <= tt; ++st) {
            f32x16 S;
#pragma unroll
            for (int e = 0; e < 16; ++e) S[e] = 0.f;
#pragma unroll
            for (int ks = 0; ks < 8; ++ks) {
                const bf16x8 af = *(const LAS bf16x8*)(KPimg + off_b(32 * st + krow, 2 * ks + hh));
                const bf16x8 bf = *(const LAS bf16x8*)(QPimg + off_b(32 * tt + r32, 2 * ks + hh));
                S = __builtin_amdgcn_mfma_f32_32x32x16_bf16(af, bf, S, 0, 0, 0);
            }
            float p[16];
#pragma unroll
            for (int e = 0; e < 16; ++e) {
                const unsigned m = (e & 3) + 8 * (e >> 2) + 4 * hh;
                const int sidx = 32 * st + (int)pi32(m), tidx = 32 * tt + r32;
                p[e] = sidx <= tidx ? S[e] : 0.f;
            }
            u32x4 w0, w1;
            w0.x = pk_bf16(p[0], p[1]); w0.y = pk_bf16(p[2], p[3]); w0.z = pk_bf16(p[4], p[5]); w0.w = pk_bf16(p[6], p[7]);
            w1.x = pk_bf16(p[8], p[9]); w1.y = pk_bf16(p[10], p[11]); w1.z = pk_bf16(p[12], p[13]); w1.w = pk_bf16(p[14], p[15]);
            const bf16x8 pf0 = __builtin_bit_cast(bf16x8, w0), pf1 = __builtin_bit_cast(bf16x8, w1);
            const bf16x8 i0 = tr_frag(Iimg, lane, vt, 2 * st), i1 = tr_frag(Iimg, lane, vt, 2 * st + 1);
            O = __builtin_amdgcn_mfma_f32_32x32x16_bf16(i0, pf0, O, 0, 0, 0);
            O = __builtin_amdgcn_mfma_f32_32x32x16_bf16(i1, pf1, O, 0, 0, 0);
        }
        float sq = 0.f;
#pragma unroll
        for (int e = 0; e < 16; ++e) sq += O[e] * O[e];
        sq += __shfl_xor(sq, 32);
        if (hh == 0) ssq[vt * 64 + 32 * tt + r32] = sq;
        __syncthreads();
        const int tl = 32 * tt + r32;
        const float rstd = rsqrtf((ssq[tl] + ssq[64 + tl] + ssq[128 + tl] + ssq[192 + tl]) * (1.0f / 128.0f) + 1e-6f);
#pragma unroll
        for (int g = 0; g < 4; ++g) {
            const int v0 = 32 * vt + 8 * g + 4 * hh;
            const f32x4 gn = *(const f32x4*)(gnorm + v0);
            u32x2 w; w.x = pk_bf16(O[4 * g] * rstd * gn[0], O[4 * g + 1] * rstd * gn[1]); w.y = pk_bf16(O[4 * g + 2] * rstd * gn[2], O[4 * g + 3] * rstd * gn[3]);
            *(LAS u32x2*)(OT + tl * 272 + v0 * 2) = w;
        }
        __syncthreads();
#pragma unroll
        for (int r = 0; r < 2; ++r) {
            const int idx = tid + 512 * r, row = idx >> 4, ch = idx & 15;
            const u32x4 ov = *(const LAS u32x4*)(OT + row * 272 + ch * 16);
            const size_t go = (tok0 + row) * DM + h * 128 + ch * 8;
            const u32x4 gv = r == 0 ? gcur0 : gcur1;
            u32x4 w;
#define SILU_(x_) ((x_) * sigmoidf_(x_))
            w.x = pk_bf16(bflo(ov.x) * SILU_(bflo(gv.x)), bfhi(ov.x) * SILU_(bfhi(gv.x))); w.y = pk_bf16(bflo(ov.y) * SILU_(bflo(gv.y)), bfhi(ov.y) * SILU_(bfhi(gv.y)));
            w.z = pk_bf16(bflo(ov.z) * SILU_(bflo(gv.z)), bfhi(ov.z) * SILU_(bfhi(gv.z))); w.w = pk_bf16(bflo(ov.w) * SILU_(bflo(gv.w)), bfhi(ov.w) * SILU_(bfhi(gv.w)));
#undef SILU_
            *(u32x4*)(OG + go) = w;
        }
        __syncthreads();
    }
}


#if SCAN_DBG == 2
__device__ __forceinline__ void dbg_compare(LAS float* red, const bf16_t* A, const bf16_t* B, float* DBG) {
    float sd = 0.f, sr = 0.f, nn = 0.f;
    const size_t n = (size_t)MTOK * DM;
    for (size_t i = (size_t)blockIdx.x * 512 + threadIdx.x; i < n; i += (size_t)gridDim.x * 512) {
        const float x = bf2f(A[i]), y = bf2f(B[i]);
        if (!(x - x == 0.f)) nn += 1.f; else { sd += (x - y) * (x - y); sr += y * y; }
    }
    sd = wave_sum(sd); sr = wave_sum(sr); nn = wave_sum(nn);
    const int wv = threadIdx.x >> 6;
    if ((threadIdx.x & 63) == 0) { red[wv * 3] = sd; red[wv * 3 + 1] = sr; red[wv * 3 + 2] = nn; }
    __syncthreads();
    if (threadIdx.x == 0) { float a = 0, b = 0, c = 0; for (int w = 0; w < 8; ++w) { a += red[w * 3]; b += red[w * 3 + 1]; c += red[w * 3 + 2]; } DBG[blockIdx.x * 4] = a; DBG[blockIdx.x * 4 + 1] = b; DBG[blockIdx.x * 4 + 2] = c; }
    __syncthreads();
}
__device__ __forceinline__ void dbg_emit(const float* DBG, float* out) {
    float a = 0, b = 0, c = 0;
    for (int w = 0; w < (int)gridDim.x; ++w) { a += DBG[w * 4]; b += DBG[w * 4 + 1]; c += DBG[w * 4 + 2]; }
    const float rel = sqrtf(a / b);
    int k = (int)rintf(-2.0f * log10f(rel)); k = k < 0 ? 0 : (k > 16 ? 16 : k);
    if (c > 0.f) k = 17;
    const float cc = sqrtf(0.5f * (float)k);
    const size_t n = (size_t)MTOK * DM;
    for (size_t i = (size_t)blockIdx.x * 512 + threadIdx.x; i < n; i += (size_t)gridDim.x * 512) out[i] = cc;
}
#endif

#if SCAN_DBG == 3
__device__ __forceinline__ void dbg_count_bf16(const bf16_t* A, size_t n, unsigned* cnt) {
    unsigned c = 0;
    for (size_t i = (size_t)blockIdx.x * 512 + threadIdx.x; i < n; i += (size_t)gridDim.x * 512) { const float x = bf2f(A[i]); if (!(x - x == 0.f)) ++c; }
    if (c) atomicAdd(cnt, c);
}
__device__ __forceinline__ void dbg_count_f32(const float* A, size_t n, unsigned* cnt) {
    unsigned c = 0;
    for (size_t i = (size_t)blockIdx.x * 512 + threadIdx.x; i < n; i += (size_t)gridDim.x * 512) { const float x = A[i]; if (!(x - x == 0.f)) ++c; }
    if (c) atomicAdd(cnt, c);
}
__device__ __forceinline__ void dbg_emit3(const unsigned* cnt, float* out) {
    float code = 0.f;
    for (int st = 3; st >= 0; --st) { const unsigned c = cnt[st]; if (c) { float lg = log10f((float)c); lg = lg > 9.f ? 9.f : lg; code = (float)(st + 1) + 0.1f * lg; } }
    const float cc = sqrtf(code);
    const size_t n = (size_t)MTOK * DM;
    for (size_t i = (size_t)blockIdx.x * 512 + threadIdx.x; i < n; i += (size_t)gridDim.x * 512) out[i] = cc;
}
#endif

#if SCAN_DBG == 4 || SCAN_DBG == 6
__device__ __forceinline__ void dbg_compare4(LAS float* red, const bf16_t* A, const bf16_t* B, const bf16_t* C, float* DBG) {
    float sd = 0.f, sr = 0.f, nn = 0.f, mm = 0.f;
    const size_t n = (size_t)MTOK * DM;
    for (size_t i = (size_t)blockIdx.x * 512 + threadIdx.x; i < n; i += (size_t)gridDim.x * 512) {
        const float x = bf2f(A[i]), y = bf2f(B[i]);
        if (!(x - x == 0.f)) nn += 1.f; else { sd += (x - y) * (x - y); sr += y * y; }
        if (A[i] != C[i]) mm += 1.f;
    }
    sd = wave_sum(sd); sr = wave_sum(sr); nn = wave_sum(nn); mm = wave_sum(mm);
    const int wv = threadIdx.x >> 6;
    if ((threadIdx.x & 63) == 0) { red[wv * 4] = sd; red[wv * 4 + 1] = sr; red[wv * 4 + 2] = nn; red[wv * 4 + 3] = mm; }
    __syncthreads();
    if (threadIdx.x == 0) { float a = 0, b = 0, c = 0, d = 0; for (int w = 0; w < 8; ++w) { a += red[w * 4]; b += red[w * 4 + 1]; c += red[w * 4 + 2]; d += red[w * 4 + 3]; }
        DBG[blockIdx.x * 4] = a; DBG[blockIdx.x * 4 + 1] = b; DBG[blockIdx.x * 4 + 2] = c; DBG[blockIdx.x * 4 + 3] = d; }
    __syncthreads();
}
__device__ __forceinline__ void dbg_emit4(const float* DBG, float* out) {
    float a = 0, b = 0, c = 0, d = 0;
    for (int w = 0; w < (int)gridDim.x; ++w) { a += DBG[w * 4]; b += DBG[w * 4 + 1]; c += DBG[w * 4 + 2]; d += DBG[w * 4 + 3]; }
    const float rel = sqrtf(a / b);
    int k = (int)rintf(-log10f(rel)); k = k < 0 ? 0 : (k > 8 ? 8 : k);
#if SCAN_DBG == 6
    const float cc = sqrtf((float)k + ((d + c) > 0.f ? 0.5f : 0.f));
#else
    int m = (int)ceilf(log10f(1.0f + d + c)); m = m > 9 ? 9 : m;
    const float cc = sqrtf((float)k + 0.1f * (float)m);
#endif
    const size_t n = (size_t)MTOK * DM;
    for (size_t i = (size_t)blockIdx.x * 512 + threadIdx.x; i < n; i += (size_t)gridDim.x * 512) out[i] = cc;
}
#endif

#if SCAN_DBG == 5
__device__ __forceinline__ void dbg_lds16_test(LAS unsigned char* lds, unsigned* cnt) {
    const int tid = threadIdx.x;
    unsigned bad = 0;
    for (int rep = 0; rep < 64; ++rep) {
        for (int i = tid; i < 1024; i += 512) *(LAS u32x4*)(lds + i * 16) = (u32x4){0x7fc07fc0u, 0x7fc07fc0u, 0x7fc07fc0u, 0x7fc07fc0u};
        __syncthreads();
        const int k = tid & 127, part = tid >> 7;
#pragma unroll
        for (int i = 0; i < 16; ++i) {
            const int row = 16 * part + i;
            *(LAS bf16_t*)(lds + off_b(row, k >> 3) + 2 * (k & 7)) = (bf16_t)((row * 128 + k + rep) & 0x7fff);
        }
        __syncthreads();
        for (int idx = tid; idx < 64 * 128; idx += 512) {
            const int row = idx >> 7, kk = idx & 127;
            const bf16_t got = *(const LAS bf16_t*)(lds + off_b(row, kk >> 3) + 2 * (kk & 7));
            if (got != (bf16_t)((row * 128 + kk + rep) & 0x7fff)) ++bad;
        }
        __syncthreads();
    }
    if (bad) atomicAdd(cnt, bad);
}
__device__ __forceinline__ void dbg_emit5(const unsigned* cnt, float* out) {
    const unsigned c = cnt[0];
    float code = 0.f;
    if (c) { float lg = log10f((float)c); code = 1.0f + (lg > 8.9f ? 8.9f : lg); }
    const float cc = sqrtf(code);
    const size_t n = (size_t)MTOK * DM;
    for (size_t i = (size_t)blockIdx.x * 512 + threadIdx.x; i < n; i += (size_t)gridDim.x * 512) out[i] = cc;
}
#endif

#if SCAN_DBG == 6
__device__ __forceinline__ void dbg_check_a(LAS float* red, const float* LF, const bf16_t* I1, const bf16_t* LT, const bf16_t* LT2, float* DBG) {
    float sd = 0.f, sr = 0.f, mm = 0.f;
    const size_t n = (size_t)4096 * 16384;
    for (size_t i = (size_t)blockIdx.x * 512 + threadIdx.x; i < n; i += (size_t)gridDim.x * 512) {
        const int item = (int)(i >> 14), v = (int)((i >> 7) & 127), k = (int)(i & 127);
        const int bh = item >> 7, c = item & 127, b = bh >> 4, h = bh & 15;
        const size_t tok0 = (size_t)b * SEQ + c * 64;
        float g = 1.f, L = 0.f;
        for (int s2 = 63; s2 >= 0; --s2) {
            const size_t o = (tok0 + s2) * DM + h * 128;
            const float f = __expf(LF[o + k]);
            L += bf2f(I1[o + v]) * (1.0f - f) * g;
            g *= f;
        }
        const float x = bf2f(LT[i]);
        sd += (x - L) * (x - L); sr += L * L;
        if (LT[i] != LT2[i]) mm += 1.f;
    }
    sd = wave_sum(sd); sr = wave_sum(sr); mm = wave_sum(mm);
    const int wv = threadIdx.x >> 6;
    if ((threadIdx.x & 63) == 0) { red[wv * 4] = sd; red[wv * 4 + 1] = sr; red[wv * 4 + 2] = 0.f; red[wv * 4 + 3] = mm; }
    __syncthreads();
    if (threadIdx.x == 0) { float a = 0, b2 = 0, d = 0; for (int w = 0; w < 8; ++w) { a += red[w * 4]; b2 += red[w * 4 + 1]; d += red[w * 4 + 3]; }
        DBG[blockIdx.x * 4] = a; DBG[blockIdx.x * 4 + 1] = b2; DBG[blockIdx.x * 4 + 2] = 0.f; DBG[blockIdx.x * 4 + 3] = d; }
    __syncthreads();
}
#endif

#if SCAN_DBG == 7
#ifndef DBG_FAM
#define DBG_FAM 0
#endif
__device__ __forceinline__ void dbg_check_a7(const float* LF, const bf16_t* I1, const bf16_t* LT, float* DBG) {
    const size_t n = (size_t)4096 * 16384;
    float nbad = 0.f, nnf = 0.f;
    for (size_t i = (size_t)blockIdx.x * 512 + threadIdx.x; i < n; i += (size_t)gridDim.x * 512 * 8) {
        const int item = (int)(i >> 14), v = (int)((i >> 7) & 127), k = (int)(i & 127);
        const int bh = item >> 7, c = item & 127, b = bh >> 4, h = bh & 15;
        const size_t tok0 = (size_t)b * SEQ + c * 64;
        float g = 1.f, L = 0.f;
        for (int s2 = 63; s2 >= 0; --s2) {
            const size_t o = (tok0 + s2) * DM + h * 128;
            const float f = __expf(LF[o + k]);
            L += bf2f(I1[o + v]) * (1.0f - f) * g;
            g *= f;
        }
        const float x = bf2f(LT[i]);
        if (!(x - x == 0.f)) { nnf += 1.f; nbad += 1.f; }
        else if (fabsf(x - L) > 0.02f * fabsf(L) + 1e-2f) nbad += 1.f;
    }
    nbad = wave_sum(nbad); nnf = wave_sum(nnf);
    if ((threadIdx.x & 63) == 0) { atomicAdd(DBG, nbad); atomicAdd(DBG + 1, nnf); }
}
__device__ __forceinline__ void dbg_emit7(const float* DBG, float* out) {
    const float nb = DBG[0], nf = DBG[1];
    int A = nb == 0.f ? 0 : (nb <= 100.f ? 1 : (nb <= 1e4f ? 3 : (nb <= 1e6f ? 5 : 7)));
    int B = nf == 0.f ? 0 : 5;
    const float cc = sqrtf((float)A + 0.1f * (float)B);
    const size_t n = (size_t)MTOK * DM;
    for (size_t i = (size_t)blockIdx.x * 512 + threadIdx.x; i < n; i += (size_t)gridDim.x * 512) out[i] = cc;
}
#endif
__device__ __forceinline__ int opaque(int v) { asm volatile("" : "+s"(v)); return v; }
template <bool L1> __device__ __forceinline__ void run_gemm_out(const Args& a, LAS unsigned char* lds) {
    unsigned char* ws = a.ws;
    pg8::Gemm g{(const bf16_t*)(ws + (L1 ? slot(3) : slot(0))), (const bf16_t*)(ws + (L1 ? WS_WO : WS_WOUT)), opaque(MTOK), opaque(DM), opaque(DM)};
    pg8::StaticOrder S; S.init(g.M, g.N, (int)gridDim.x, (int)blockIdx.x);
    EpiF32 E{(float*)(ws + (L1 ? slot(4) : slot(1))), DM};
    pg8::gemm_phase<EpiF32, pg8::StaticOrder>(lds, g, S, E, nullptr);
}
template <bool L1> __device__ __forceinline__ void run_ln(const Args& a) {
    unsigned char* ws = a.ws;
    phase_ln((const float*)(ws + (L1 ? slot(4) : slot(1))), L1 ? (const float*)(ws + slot(0)) : a.in[0], a.in[12] + (L1 ? 2 : 0) * DM, a.in[13] + (L1 ? 2 : 0) * DM,
             (float*)(ws + (L1 ? slot(6) : slot(3))), (bf16_t*)(ws + (L1 ? slot(8) : slot(5))), (signed char*)(ws + WS_XQ), (float*)(ws + WS_XS));
}
template <bool L1> __device__ __forceinline__ void run_gemm_sc(const Args& a, LAS unsigned char* lds) {
    unsigned char* ws = a.ws;
    pg8::Gemm g{(const bf16_t*)(ws + WS_WC) + (L1 ? (size_t)DM * DM : 0), (const bf16_t*)(ws + (L1 ? slot(8) : slot(5))), opaque(DM), opaque(MTOK), opaque(DM)};
    pg8::StaticOrder S; S.init(g.M, g.N, (int)gridDim.x, (int)blockIdx.x);
    EpiF32 E{(float*)(ws + (L1 ? slot(0) : slot(6))), MTOK};
    pg8::gemm_phase<EpiF32, pg8::StaticOrder>(lds, g, S, E, nullptr);
}
template <bool L1> __device__ __forceinline__ void run_topk(const Args& a, LAS unsigned char* lds) {
    unsigned char* ws = a.ws;
    phase_topk(lds, (const float*)(ws + (L1 ? slot(0) : slot(6))), (int*)(ws + WS_EID), (float*)(ws + WS_GATE));
}
template <bool L1> __device__ __forceinline__ void run_peer(const Args& a, LAS unsigned char* lds) {
    unsigned char* ws = a.ws;
    LAS int* HL = (LAS int*)(lds + (threadIdx.x >> 6) * 8192);
    float* Y = (float*)(ws + (L1 ? slot(0) : slot(6)));
    phase_peer_u((const signed char*)(ws + WS_XQ), (const int*)(ws + WS_EID), ws + WS_UB + (L1 ? (size_t)16384 * DM : 0), HL);
    asm volatile("s_waitcnt vmcnt(0) lgkmcnt(0)" ::: "memory");
    phase_peer_w(HL, (const float*)(ws + WS_XS), (const int*)(ws + WS_EID), (const float*)(ws + WS_GATE),
                 (const float*)(ws + WS_USC) + (L1 ? 16384 : 0), (const float*)(ws + WS_VSC) + (L1 ? 16384 : 0), (float*)(ws + WS_W), (float*)(ws + WS_CS));
    asm volatile("s_waitcnt vmcnt(0)" ::: "memory");
    phase_peer_v((const float*)(ws + (L1 ? slot(6) : slot(3))), (const int*)(ws + WS_EID), (const float*)(ws + WS_W), (const float*)(ws + WS_CS),
                 ws + WS_VB + (L1 ? (size_t)16384 * DM : 0), Y);
    asm volatile("s_waitcnt vmcnt(0)" ::: "memory");
    {
        const int lane = threadIdx.x & 63, gw = blockIdx.x * 8 + (threadIdx.x >> 6), nw = gridDim.x * 8, tpw = (MTOK + nw - 1) / nw, tbase = gw * tpw;
        const int tend = tbase + tpw < MTOK ? tbase + tpw : MTOK;
        const float* g = a.in[12] + (L1 ? 3 : 1) * DM; const float* bta = a.in[13] + (L1 ? 3 : 1) * DM;
        float* outf = L1 ? a.out : (float*)(ws + slot(0)); bf16_t* outb = L1 ? (bf16_t*)nullptr : (bf16_t*)(ws + slot(2));
        for (int row = tbase; row < tend; ++row) {
            float v[32];
            const float* p = Y + (size_t)row * DM;
#pragma unroll
            for (int i = 0; i < 4; ++i) {
                const f32x4 x0 = *(const f32x4*)(p + 512 * i + 8 * lane), x1 = *(const f32x4*)(p + 512 * i + 8 * lane + 4);
#pragma unroll
                for (int j = 0; j < 4; ++j) { v[i * 8 + j] = x0[j]; v[i * 8 + 4 + j] = x1[j]; }
            }
            ln_row_store(v, g, bta, outf + (size_t)row * DM, outb ? outb + (size_t)row * DM : nullptr, lane);
        }
    }
}

__global__ void __launch_bounds__(512, 2) mk_fwd(Args a) {
    extern __shared__ __attribute__((aligned(16))) unsigned char lds_raw[];
    LAS unsigned char* lds = (LAS unsigned char*)lds_raw;
    cg::grid_group grid = cg::this_grid();
    unsigned char* ws = a.ws;
#define PHASE_BEGIN(k) if (a.ph_lo <= (k) && (k) < a.ph_hi && EN(k)) {
#define PHASE_END(k) asm volatile("s_waitcnt vmcnt(0)" ::: "memory"); __syncthreads(); if ((k) + 1 < a.ph_hi) { grid.sync(); if (threadIdx.x < 64) { __builtin_amdgcn_fence(__ATOMIC_ACQUIRE, "agent"); asm volatile("s_waitcnt vmcnt(0)" ::: "memory"); } __syncthreads(); } }
    PHASE_BEGIN(0) phase_prep(a, lds);
#if SCAN_DBG == 3 || SCAN_DBG == 5
        if (blockIdx.x == 0 && threadIdx.x < 8) ((unsigned*)(ws + WS_CTR + 8192))[threadIdx.x] = 0u;
#endif
#if SCAN_DBG == 7
        if (blockIdx.x == 0 && threadIdx.x < 32) ((float*)(ws + WS_CTR + 4096))[threadIdx.x] = 0.f;
#endif
    PHASE_END(0)
#if SCAN_DBG == 5
    PHASE_BEGIN(1) dbg_lds16_test(lds, (unsigned*)(ws + WS_CTR + 8192)); PHASE_END(1)
#define SKIP_REST 1
#endif
    PHASE_BEGIN(1) {
        pg8::Gemm g{(const bf16_t*)(ws + slot(0)), (const bf16_t*)(ws + WS_WIN), opaque(MTOK), opaque(4 * DM), opaque(DM)};
        pg8::StaticOrder S; S.init(g.M, g.N, (int)gridDim.x, (int)blockIdx.x);
        EpiKVQ E{(bf16_t*)(ws + slot(1)), (bf16_t*)(ws + slot(2)), (bf16_t*)(ws + slot(3))};
        pg8::gemm_phase<EpiKVQ, pg8::StaticOrder>(lds, g, S, E, nullptr);
    } PHASE_END(1)
    PHASE_BEGIN(2) phase_scan_a(lds, (const bf16_t*)(ws + slot(2)), (const float*)(ws + WS_LB), (const bf16_t*)(ws + slot(3)), (bf16_t*)(ws + slot(6)), (float*)(ws + WS_DEC)
#if SCAN_DBG == 3
        , (unsigned*)(ws + WS_CTR + 8192)
#endif
        );
#if SCAN_DBG == 7
        asm volatile("s_waitcnt vmcnt(0)" ::: "memory"); __syncthreads(); grid.sync(); if (threadIdx.x < 64) { __builtin_amdgcn_fence(__ATOMIC_ACQUIRE, "agent"); asm volatile("s_waitcnt vmcnt(0)" ::: "memory"); } __syncthreads();
        dbg_check_a7((const float*)(ws + slot(4)), (const bf16_t*)(ws + slot(2)), (const bf16_t*)(ws + slot(6)), (float*)(ws + WS_CTR + 4096));
#endif
#if SCAN_DBG == 6
#define DSYNC6() asm volatile("s_waitcnt vmcnt(0)" ::: "memory"); __syncthreads(); grid.sync(); if (threadIdx.x < 64) { __builtin_amdgcn_fence(__ATOMIC_ACQUIRE, "agent"); asm volatile("s_waitcnt vmcnt(0)" ::: "memory"); } __syncthreads();
        DSYNC6()
        phase_scan_a(lds, (const bf16_t*)(ws + slot(2)), (const float*)(ws + WS_LB), (const bf16_t*)(ws + slot(3)), (bf16_t*)a.out, (float*)(ws + WS_DEC));
        DSYNC6()
        dbg_check_a((LAS float*)lds, (const float*)(ws + slot(4)), (const bf16_t*)(ws + slot(2)), (const bf16_t*)(ws + slot(6)), (const bf16_t*)a.out, (float*)(ws + WS_CTR + 4096));
#endif
#if SCAN_DBG == 3
        asm volatile("s_waitcnt vmcnt(0)" ::: "memory"); __syncthreads(); grid.sync();
        dbg_count_bf16((const bf16_t*)(ws + slot(6)), (size_t)4096 * 16384, (unsigned*)(ws + WS_CTR + 8192) + 2);
#endif
    PHASE_END(2)
    PHASE_BEGIN(3) phase_scan_b((bf16_t*)(ws + slot(6)), (const float*)(ws + WS_DEC));
#if SCAN_DBG == 3
        asm volatile("s_waitcnt vmcnt(0)" ::: "memory"); __syncthreads(); grid.sync();

#endif
    PHASE_END(3)
    PHASE_BEGIN(4) phase_scan_c(lds, (const bf16_t*)(ws + slot(1)), (const bf16_t*)(ws + slot(2)), (const float*)(ws + WS_LB), (const bf16_t*)(ws + slot(3)), (const bf16_t*)(ws + slot(4)), (const bf16_t*)(ws + slot(6)), a.in[2], (bf16_t*)(ws + slot(0)));
#if SCAN_DBG == 1
        asm volatile("s_waitcnt vmcnt(0)" ::: "memory"); __syncthreads(); grid.sync();
        phase_scan_naive((const bf16_t*)(ws + slot(1)), (const float*)(ws + slot(4)), (const bf16_t*)(ws + slot(2)), (float*)(ws + slot(6)));
        asm volatile("s_waitcnt vmcnt(0)" ::: "memory"); __syncthreads(); grid.sync();
        phase_onorm((const float*)(ws + slot(6)), (const bf16_t*)(ws + slot(3)), a.in[2], (bf16_t*)(ws + slot(0)));
#endif
#if SCAN_DBG == 3
        asm volatile("s_waitcnt vmcnt(0)" ::: "memory"); __syncthreads(); grid.sync();

#endif
#if SCAN_DBG == 4
#define DSYNC() asm volatile("s_waitcnt vmcnt(0)" ::: "memory"); __syncthreads(); grid.sync(); if (threadIdx.x < 64) { __builtin_amdgcn_fence(__ATOMIC_ACQUIRE, "agent"); asm volatile("s_waitcnt vmcnt(0)" ::: "memory"); } __syncthreads();
        DSYNC()
        phase_scan_naive((const bf16_t*)(ws + slot(1)), (const float*)(ws + slot(4)), (const bf16_t*)(ws + slot(2)), (float*)(ws + slot(6)));
        DSYNC()
        phase_onorm((const float*)(ws + slot(6)), (const bf16_t*)(ws + slot(3)), a.in[2], (bf16_t*)(ws + slot(8)));
        DSYNC()
        phase_scan_a(lds, (const bf16_t*)(ws + slot(2)), (const float*)(ws + WS_LB), (const bf16_t*)(ws + slot(3)), (bf16_t*)(ws + slot(6)), (float*)(ws + WS_DEC));
        DSYNC()
        phase_scan_b((bf16_t*)(ws + slot(6)), (const float*)(ws + WS_DEC));
        DSYNC()
        phase_scan_c(lds, (const bf16_t*)(ws + slot(1)), (const bf16_t*)(ws + slot(2)), (const float*)(ws + WS_LB), (const bf16_t*)(ws + slot(3)), (const bf16_t*)(ws + slot(4)), (const bf16_t*)(ws + slot(6)), a.in[2], (bf16_t*)a.out);
        DSYNC()
        dbg_compare4((LAS float*)lds, (const bf16_t*)(ws + slot(0)), (const bf16_t*)(ws + slot(8)), (const bf16_t*)a.out, (float*)(ws + WS_CTR + 4096));
#endif
#if SCAN_DBG == 2
        asm volatile("s_waitcnt vmcnt(0)" ::: "memory"); __syncthreads(); grid.sync();
        phase_scan_naive((const bf16_t*)(ws + slot(1)), (const float*)(ws + slot(4)), (const bf16_t*)(ws + slot(2)), (float*)(ws + slot(6)));
        asm volatile("s_waitcnt vmcnt(0)" ::: "memory"); __syncthreads(); grid.sync();
        phase_onorm((const float*)(ws + slot(6)), (const bf16_t*)(ws + slot(3)), a.in[2], (bf16_t*)(ws + slot(8)));
        asm volatile("s_waitcnt vmcnt(0)" ::: "memory"); __syncthreads(); grid.sync();
        dbg_compare((LAS float*)lds, (const bf16_t*)(ws + slot(0)), (const bf16_t*)(ws + slot(8)), (float*)(ws + WS_CTR + 4096));
#endif
    PHASE_END(4)
    PHASE_BEGIN(5) run_gemm_out<false>(a, lds); PHASE_END(5)
    PHASE_BEGIN(6) run_ln<false>(a); PHASE_END(6)
    PHASE_BEGIN(7) run_gemm_sc<false>(a, lds); PHASE_END(7)
    PHASE_BEGIN(8) run_topk<false>(a, lds); PHASE_END(8)
    PHASE_BEGIN(9) run_peer<false>(a, lds); PHASE_END(9)
    PHASE_BEGIN(10) {
        pg8::Gemm g{(const bf16_t*)(ws + slot(2)), (const bf16_t*)(ws + WS_WKVQ), opaque(MTOK), opaque(3 * DM), opaque(DM)};
        pg8::StaticOrder S; S.init(g.M, g.N, (int)gridDim.x, (int)blockIdx.x);
        EpiKVQ E{(bf16_t*)(ws + slot(3)), (bf16_t*)(ws + slot(4)), (bf16_t*)(ws + slot(5))};
        pg8::gemm_phase<EpiKVQ, pg8::StaticOrder>(lds, g, S, E, nullptr);
    } PHASE_END(10)
    PHASE_BEGIN(11) phase_rot((LAS float*)lds, (bf16_t*)(ws + slot(3)), (bf16_t*)(ws + slot(5)), (const float*)(ws + WS_COS), (const float*)(ws + WS_SIN), (float*)(ws + WS_KMEAN), (float*)(ws + WS_KNMAX)); PHASE_END(11)
    PHASE_BEGIN(12) phase_sel(lds, (const bf16_t*)(ws + slot(5)), (const float*)(ws + WS_KMEAN), (unsigned short*)(ws + WS_SUB), (int*)(ws + WS_CNT), (int*)(ws + WS_CTR)); PHASE_END(12)
    PHASE_BEGIN(13) phase_att(lds, (const bf16_t*)(ws + slot(5)), (const bf16_t*)(ws + slot(3)), (const bf16_t*)(ws + slot(4)), (const float*)(ws + WS_KNMAX), (const unsigned short*)(ws + WS_SUB),
                              (const int*)(ws + WS_CNT), (int*)(ws + WS_CTR), (bf16_t*)(ws + slot(6)), (bf16_t*)(ws + slot(2)), (float*)(ws + WS_LS)); PHASE_END(13)
    PHASE_BEGIN(14) phase_comb((const bf16_t*)(ws + slot(6)), (const bf16_t*)(ws + slot(2)), (const float*)(ws + WS_LS), (bf16_t*)(ws + slot(3))); PHASE_END(14)
    PHASE_BEGIN(15) run_gemm_out<true>(a, lds); PHASE_END(15)
    PHASE_BEGIN(16) run_ln<true>(a); PHASE_END(16)
    PHASE_BEGIN(17) run_gemm_sc<true>(a, lds); PHASE_END(17)
    PHASE_BEGIN(18) run_topk<true>(a, lds); PHASE_END(18)
#if SCAN_DBG == 7
    PHASE_BEGIN(19) dbg_emit7((const float*)(ws + WS_CTR + 4096), a.out); PHASE_END(19)
#elif SCAN_DBG == 6
    PHASE_BEGIN(19) dbg_emit4((const float*)(ws + WS_CTR + 4096), a.out); PHASE_END(19)
#elif SCAN_DBG == 5
    PHASE_BEGIN(19) dbg_emit5((const unsigned*)(ws + WS_CTR + 8192), a.out); PHASE_END(19)
#elif SCAN_DBG == 4
    PHASE_BEGIN(19) dbg_emit4((const float*)(ws + WS_CTR + 4096), a.out); PHASE_END(19)
#elif SCAN_DBG == 3
    PHASE_BEGIN(19) dbg_emit3((const unsigned*)(ws + WS_CTR + 8192), a.out); PHASE_END(19)
#elif SCAN_DBG == 2
    PHASE_BEGIN(19) dbg_emit((const float*)(ws + WS_CTR + 4096), a.out); PHASE_END(19)
#else
    PHASE_BEGIN(19) run_peer<true>(a, lds); PHASE_END(19)
#endif
}

extern "C" void kernel_launch(void* const* d_in, const int* in_sizes, int n_in, void* d_out, int out_size, void* d_ws, size_t ws_size, hipStream_t stream) {
    static int grid = 0;
    if (grid == 0) {
        if (n_in != 14 || out_size != MTOK * DM || ws_size < WS_END) { fprintf(stderr, "kernel_launch: unexpected shapes (n_in %d, out %d, ws %zu)\n", n_in, out_size, ws_size); grid = -1; return; }
        int dev = 0, cus = 0, per_cu = 0;
        if (hipGetDevice(&dev) != hipSuccess || hipDeviceGetAttribute(&cus, hipDeviceAttributeMultiprocessorCount, dev) != hipSuccess) { grid = -1; return; }
        if (hipFuncSetAttribute((const void*)mk_fwd, hipFuncAttributeMaxDynamicSharedMemorySize, LDS_BYTES) != hipSuccess) { fprintf(stderr, "kernel_launch: hipFuncSetAttribute failed\n"); grid = -1; return; }
        if (hipOccupancyMaxActiveBlocksPerMultiprocessor(&per_cu, (const void*)mk_fwd, 512, LDS_BYTES) != hipSuccess || per_cu < 1) { fprintf(stderr, "kernel_launch: occupancy query failed (%d)\n", per_cu); (void)hipGetLastError(); per_cu = 1; }
        grid = cus * (per_cu > 1 ? 1 : per_cu);
    }
    if (grid < 0) return;
    Args a{};
    for (int i = 0; i < 14; ++i) a.in[i] = (const float*)d_in[i];
    a.out = (float*)d_out; a.ws = (unsigned char*)d_ws;
#if ONE_LAUNCH
    a.ph_lo = 0; a.ph_hi = NPH;
    void* args[] = {&a};
    hipError_t e = hipLaunchCooperativeKernel((const void*)mk_fwd, dim3(grid), dim3(512), args, LDS_BYTES, stream);
    if (e != hipSuccess) fprintf(stderr, "cooperative launch failed: %s (grid %d)\n", hipGetErrorString(e), grid);
#else
    for (int ph = 0; ph < NPH; ++ph) {
        a.ph_lo = ph; a.ph_hi = ph + 1;
        hipLaunchKernelGGL(mk_fwd, dim3(grid), dim3(512), LDS_BYTES, stream, a);
    }
#endif
}
```

```cpp
#define ONE_LAUNCH 1
#include <hip/hip_runtime.h>
#include <hip/hip_cooperative_groups.h>
#include <cstdio>
namespace cg = cooperative_groups;

#ifndef ONE_LAUNCH
#define ONE_LAUNCH 0
#endif
#ifndef SCAN_DBG
#define SCAN_DBG 0
#endif
#ifndef SCAN_A_VALU
#define SCAN_A_VALU 0
#endif
#ifndef ENMASK
#define ENMASK 0xffffffffu
#endif
#define EN(k) ((ENMASK >> (k)) & 1u)

namespace pg8 {
#define PG8_LAS __attribute__((address_space(3)))
typedef unsigned short bf16_t;
typedef short bf16x8 __attribute__((ext_vector_type(8)));
typedef float f32x4 __attribute__((ext_vector_type(4)));
typedef unsigned u32x4 __attribute__((ext_vector_type(4)));
constexpr int BM = 256, BK = 64, HALF = 128, HTB = HALF * BK * 2  , STAGE_BYTES = 8 * HTB, NXCD = 8, WGM = 8;

__host__ __device__ __forceinline__ int lds_byte(int r, int c) { const int st = (r >> 4) * 2 + (c >> 5), rr = r & 15, cc = c & 31, ob = rr * 64 + cc * 2; return st * 1024 + (ob ^ (((ob >> 9) & 1) << 5)); }
__host__ __device__ __forceinline__ void stage_rc(int b, int& R, int& C) { const int st = b / 1024, sb = b % 1024, swz = sb ^ (((sb >> 9) & 1) << 5); R = (st >> 1) * 16 + swz / 64; C = (st & 1) * 32 + (swz % 64) / 2; }
__host__ __device__ __forceinline__ int perm32(int rho) { const int n = rho >> 4, i = rho & 15; return 8 * (i >> 2) + 4 * n + (i & 3); }

struct Unit { int pm, pn; };
struct Gemm { const bf16_t* A; const bf16_t* Bt; int M, N, K; };

struct StaticOrder {
    int nM, nN, nwg, G, c;
    __host__ __device__ void init(int M, int N, int G_, int c_) { nM = M / BM; nN = N / BM; nwg = nM * nN; G = G_; c = c_; }
    __host__ __device__ bool next(int i, Unit& u) const {
        const long L = (long)i * G + c; if (L >= nwg) return false;
        int wgid = (int)L; { const int q = nwg / NXCD, r = nwg % NXCD, xcd = wgid % NXCD, off = wgid / NXCD; wgid = (xcd < r ? xcd * (q + 1) : r * (q + 1) + (xcd - r) * q) + off; }
        const int nig = WGM * nN, gid = wgid / nig, fm = gid * WGM, gsz = (nM - fm) < WGM ? (nM - fm) : WGM;
        u.pm = fm + ((wgid % nig) % gsz); u.pn = (wgid % nig) / gsz; return true;
    }
    __device__ __forceinline__ void a_ready(const Unit&) const {}
    __device__ __forceinline__ void done(const Unit&) const {}
};
struct CountedOrder : StaticOrder {
    const unsigned* ready; unsigned need; unsigned* tmo;
    __device__ __forceinline__ void a_ready(const Unit& u) const {
        if (threadIdx.x < 64) {
            const unsigned long long t0 = __builtin_amdgcn_s_memrealtime(); unsigned polls = 0;
            while ((unsigned)__builtin_amdgcn_readfirstlane(__hip_atomic_load(ready + 64 * u.pm, __ATOMIC_RELAXED, __HIP_MEMORY_SCOPE_AGENT)) < need) {
                if ((++polls & 255u) == 0u && __builtin_amdgcn_readfirstlane(__hip_atomic_load(tmo, __ATOMIC_RELAXED, __HIP_MEMORY_SCOPE_AGENT)) != 0u) break;
                if (__builtin_amdgcn_s_memrealtime() - t0 > 2000000ull) {
                    if (threadIdx.x == 0) { unsigned expect = 0u; __hip_atomic_compare_exchange_strong(tmo + 1, &expect, 0x600u | (unsigned)(u.pm & 0xff), __ATOMIC_RELAXED, __ATOMIC_RELAXED, __HIP_MEMORY_SCOPE_AGENT); __hip_atomic_store(tmo, 1u, __ATOMIC_RELAXED, __HIP_MEMORY_SCOPE_AGENT); }
                    break; }
                __builtin_amdgcn_s_sleep(2); }
            __builtin_amdgcn_fence(__ATOMIC_ACQUIRE, "agent");
            asm volatile("s_waitcnt vmcnt(0)" ::: "memory");
        }
#if !defined(BROKEN_HOOK_NO_BARRIER)
        asm volatile("" ::: "memory"); __builtin_amdgcn_s_barrier(); asm volatile("" ::: "memory");
#endif
    }
};

__device__ __forceinline__ unsigned cvt_pk_bf16(float lo, float hi) { unsigned r; asm volatile("v_cvt_pk_bf16_f32 %0, %1, %2" : "=v"(r) : "v"(lo), "v"(hi)); return r; }
typedef float f32x2 __attribute__((ext_vector_type(2)));
__device__ __forceinline__ f32x2 gelu_pk(f32x2 v) {
    const f32x2 av = __builtin_elementwise_abs(v), d = av * 0.2316418882f + 1.0f;
    f32x2 t; t.x = __builtin_amdgcn_rcpf(d.x); t.y = __builtin_amdgcn_rcpf(d.y);
    f32x2 q = t * 0.5307027145f + (-0.7265760135f); q = q * t + 0.7107068705f; q = q * t + (-0.142248368f); q = q * t + 0.127414796f; q = q * t;
    const f32x2 s = (v * v) * (-0.72134752044f);
    f32x2 e; e.x = __builtin_amdgcn_exp2f(s.x); e.y = __builtin_amdgcn_exp2f(s.y);
    const f32x2 m = v * (q * e), r = v - m;
    f32x2 o; o.x = v.x < 0.f ? m.x : r.x; o.y = v.y < 0.f ? m.y : r.y; return o;
}

struct EpiF32 {
    static constexpr bool PERM = false, AFTER_DRAIN = false;
    float* C; int ldc; const float* bias;
    __device__ __forceinline__ void operator()(const f32x4 (&acc)[2][2][4][2], const Unit& u, int wr, int wc, int fr, int fq) const {
        const int row0 = u.pm * BM + wr * 64 + fr, col0 = u.pn * BM + wc * 32 + 4 * fq;
        f32x4 bv[2][2];
#pragma unroll
        for (int bj = 0; bj < 2; ++bj)
#pragma unroll
            for (int n = 0; n < 2; ++n) bv[bj][n] = bias ? *(const f32x4*)(bias + col0 + bj * HALF + n * 16) : (f32x4){0.f, 0.f, 0.f, 0.f};
#pragma unroll
        for (int ai = 0; ai < 2; ++ai)
#pragma unroll
            for (int m = 0; m < 4; ++m) { float* rowp = C + (size_t)(row0 + ai * HALF + m * 16) * ldc + col0;
#pragma unroll
                for (int bj = 0; bj < 2; ++bj)
#pragma unroll
                    for (int n = 0; n < 2; ++n) *(f32x4*)(rowp + bj * HALF + n * 16) = acc[ai][bj][m][n] + bv[bj][n]; }
    }
};
template <int ACT  > struct EpiBf16 {
    static constexpr bool PERM = true, AFTER_DRAIN = false;
    bf16_t* O; int ldc; const float* bias; int split_cols; size_t split_stride;
    __device__ __forceinline__ void operator()(const f32x4 (&acc)[2][2][4][2], const Unit& u, int wr, int wc, int fr, int fq) const {
        const int row0 = u.pm * BM + wr * 64 + fr; int colt = u.pn * BM; bf16_t* base = O;
        if (split_cols) { const int t = colt / split_cols; base += (size_t)t * split_stride; colt -= t * split_cols; }
        const int col0 = colt + wc * 32 + 8 * fq, bcol0 = u.pn * BM + wc * 32 + 8 * fq;
        f32x4 bv[2][2];
#pragma unroll
        for (int bj = 0; bj < 2; ++bj)
#pragma unroll
            for (int n = 0; n < 2; ++n) bv[bj][n] = bias ? *(const f32x4*)(bias + bcol0 + bj * HALF + 4 * n) : (f32x4){0.f, 0.f, 0.f, 0.f};
#pragma unroll
        for (int ai = 0; ai < 2; ++ai)
#pragma unroll
            for (int m = 0; m < 4; ++m) { bf16_t* rowp = base + (size_t)(row0 + ai * HALF + m * 16) * ldc + col0;
#pragma unroll
                for (int bj = 0; bj < 2; ++bj) { f32x4 v0 = acc[ai][bj][m][0] + bv[bj][0], v1 = acc[ai][bj][m][1] + bv[bj][1];
                    if (ACT == 1) { f32x2 a = gelu_pk((f32x2){v0[0], v0[1]}), b = gelu_pk((f32x2){v0[2], v0[3]}), c = gelu_pk((f32x2){v1[0], v1[1]}), d = gelu_pk((f32x2){v1[2], v1[3]});
                        v0 = (f32x4){a.x, a.y, b.x, b.y}; v1 = (f32x4){c.x, c.y, d.x, d.y}; }
                    if (ACT == 2) {
#pragma unroll
                        for (int j = 0; j < 4; ++j) { v0[j] = 0.5f * v0[j] * (1.0f + erff(v0[j] * 0.70710678f)); v1[j] = 0.5f * v1[j] * (1.0f + erff(v1[j] * 0.70710678f)); } }
                    u32x4 w; w.x = cvt_pk_bf16(v0[0], v0[1]); w.y = cvt_pk_bf16(v0[2], v0[3]); w.z = cvt_pk_bf16(v1[0], v1[1]); w.w = cvt_pk_bf16(v1[2], v1[3]);
                    *(u32x4*)(rowp + bj * HALF) = w; } }
    }
};

template <class Epi, class Sched, bool STAMP = false>
__device__ __forceinline__ void gemm_phase(PG8_LAS unsigned char* lds, const Gemm g, const Sched& S, const Epi& E, unsigned long long* stamps) {
    const int tid = threadIdx.x, wid = __builtin_amdgcn_readfirstlane(tid >> 6), lane = tid & 63, wr = wid >> 2, wc = wid & 3, fr = lane & 15, fq = lane >> 4;
    const int K = g.K, nt = K / BK;
    int ts_lo = 0, ts_hi = 0, nts = 0; const unsigned long long rt_entry = STAMP ? (unsigned long long)wall_clock64() : 0ull;
#define PG8_STAMP() do { if (STAMP && wid == 0 && nts < 64) { const unsigned long long _c = (unsigned long long)clock64(); \
        ts_lo = (lane == nts) ? (int)(unsigned)_c : ts_lo; ts_hi = (lane == nts) ? (int)(unsigned)(_c >> 32) : ts_hi; ++nts; } } while (0)
    PG8_STAMP();
    unsigned voffA[2], voffB[2];
#pragma unroll
    for (int i = 0; i < 2; ++i) { int R, C; stage_rc(tid * 16 + i * 8192, R, C); const int Rb = Epi::PERM ? ((R & ~31) + perm32(R & 31)) : R;
        voffA[i] = (unsigned)(R * K + C) * 2u; voffB[i] = (unsigned)(Rb * K + C) * 2u; }
    const size_t kstep = (size_t)(BK * 2);
    const size_t hstep = (size_t)HALF * K * 2;
    const size_t tstep = 2 * hstep;
    const unsigned ldsw = (unsigned)wid * 1024u;
    const int aoff = lds_byte(wr * 64 + fr, fq * 8), boff = lds_byte(wc * 32 + fr, fq * 8);
#define PG8_SA(b, h) (((b) * 2 + (h)) * HTB)
#define PG8_SB(b, h) ((4 + (b) * 2 + (h)) * HTB)
#define PG8_STAGE(bufoff, gbase, voff) do { _Pragma("unroll") for (int _i = 0; _i < 2; ++_i) \
        __builtin_amdgcn_global_load_lds((const unsigned*)((const char*)(gbase) + (voff)[_i]), (PG8_LAS unsigned*)(lds + (bufoff) + ldsw + _i * 8192), 16, 0, 0); } while (0)
#define PG8_LDA(dst, b, h) do { _Pragma("unroll") for (int m = 0; m < 4; ++m) _Pragma("unroll") for (int k = 0; k < 2; ++k) dst[m][k] = *(const PG8_LAS bf16x8*)(lds + PG8_SA(b, h) + aoff + m * 2048 + k * 1024); } while (0)
#define PG8_LDB(dst, b, h) do { _Pragma("unroll") for (int n = 0; n < 2; ++n) _Pragma("unroll") for (int k = 0; k < 2; ++k) dst[n][k] = *(const PG8_LAS bf16x8*)(lds + PG8_SB(b, h) + boff + n * 2048 + k * 1024); } while (0)
#define PG8_MMA(ai, bj, At, Bt) do { __builtin_amdgcn_s_setprio(1); _Pragma("unroll") for (int m = 0; m < 4; ++m) _Pragma("unroll") for (int n = 0; n < 2; ++n) _Pragma("unroll") for (int k = 0; k < 2; ++k) \
        acc[ai][bj][m][n] = __builtin_amdgcn_mfma_f32_16x16x32_bf16(Bt[n][k], At[m][k], acc[ai][bj][m][n], 0, 0, 0); __builtin_amdgcn_s_setprio(0); } while (0)
#define PG8_WAIT_V(n) asm volatile("s_waitcnt vmcnt(" #n ")" ::: "memory")
#define PG8_WAIT_L(n) asm volatile("s_waitcnt lgkmcnt(" #n ")" ::: "memory")
#define PG8_BAR __builtin_amdgcn_s_barrier()
#define PG8_SCHED __builtin_amdgcn_sched_barrier(0)
    Unit cur, nxt; int ui = 0;
    if (!S.next(0, cur)) return;
    f32x4 acc[2][2][4][2];
#pragma unroll
    for (int a = 0; a < 2; ++a)
#pragma unroll
        for (int b = 0; b < 2; ++b)
#pragma unroll
            for (int m = 0; m < 4; ++m)
#pragma unroll
                for (int n = 0; n < 2; ++n) acc[a][b][m][n] = (f32x4){0.f, 0.f, 0.f, 0.f};
    bf16x8 At[4][2], B0[2][2], B1[2][2];
    const char* cA = (const char*)g.A + (size_t)cur.pm * tstep; const char* cB = (const char*)g.Bt + (size_t)cur.pn * tstep;
    S.a_ready(cur);
    PG8_STAGE(PG8_SB(0, 0), cB, voffB); PG8_STAGE(PG8_SA(0, 0), cA, voffA); PG8_STAGE(PG8_SB(0, 1), cB + hstep, voffB); PG8_STAGE(PG8_SA(0, 1), cA + hstep, voffA);
    if (wr == 1) PG8_BAR;
    PG8_WAIT_V(4); PG8_BAR;
    PG8_STAGE(PG8_SB(1, 0), cB + kstep, voffB); PG8_STAGE(PG8_SA(1, 0), cA + kstep, voffA); PG8_STAGE(PG8_SB(1, 1), cB + hstep + kstep, voffB);
    PG8_WAIT_V(6); PG8_BAR;
    PG8_STAMP();
    for (;;) {
        const bool has_next = S.next(ui + 1, nxt);
        const char* nA = has_next ? (const char*)g.A + (size_t)nxt.pm * tstep : cA; const char* nB = has_next ? (const char*)g.Bt + (size_t)nxt.pn * tstep : cB;
        for (int t = 0; t < nt; t += 2) {
            const bool last = (t == nt - 2);
            const char* a1 = cA + (size_t)(t + 1) * kstep;
            const char* a2 = last ? nA : cA + (size_t)(t + 2) * kstep; const char* b2 = last ? nB : cB + (size_t)(t + 2) * kstep;
            const char* a3 = a2 + kstep; const char* b3 = b2 + kstep;
            if (last && has_next) S.a_ready(nxt);
            PG8_LDB(B0, 0, 0); PG8_SCHED; PG8_LDA(At, 0, 0); PG8_STAGE(PG8_SA(1, 1), a1 + hstep, voffA);
            PG8_WAIT_L(8); PG8_BAR; PG8_WAIT_L(0); PG8_MMA(0, 0, At, B0); PG8_BAR; PG8_SCHED;
            PG8_LDB(B1, 0, 1); PG8_STAGE(PG8_SB(0, 0), b2, voffB);
            PG8_BAR; PG8_WAIT_L(0); PG8_MMA(0, 1, At, B1); PG8_BAR;
            PG8_LDA(At, 0, 1); PG8_STAGE(PG8_SA(0, 0), a2, voffA);
            PG8_BAR; PG8_WAIT_L(0); PG8_MMA(1, 0, At, B0); PG8_BAR; PG8_SCHED;
            PG8_STAGE(PG8_SB(0, 1), b2 + hstep, voffB);
            PG8_WAIT_V(6); PG8_BAR; PG8_MMA(1, 1, At, B1); PG8_BAR;
            PG8_LDB(B0, 1, 0); PG8_SCHED; PG8_LDA(At, 1, 0); PG8_STAGE(PG8_SA(0, 1), a2 + hstep, voffA);
            PG8_WAIT_L(8); PG8_BAR; PG8_WAIT_L(0); PG8_MMA(0, 0, At, B0); PG8_BAR; PG8_SCHED;
            PG8_LDB(B1, 1, 1); PG8_STAGE(PG8_SB(1, 0), b3, voffB);
            PG8_BAR; PG8_WAIT_L(0); PG8_MMA(0, 1, At, B1); PG8_BAR;
            PG8_LDA(At, 1, 1); PG8_STAGE(PG8_SA(1, 0), a3, voffA);
            PG8_BAR; PG8_WAIT_L(0); PG8_MMA(1, 0, At, B0); PG8_BAR; PG8_SCHED;
            PG8_STAGE(PG8_SB(1, 1), b3 + hstep, voffB);
            PG8_WAIT_V(6); PG8_BAR; PG8_MMA(1, 1, At, B1); PG8_BAR;
        }
        PG8_STAMP();
        if constexpr (!Epi::AFTER_DRAIN) { E(acc, cur, wr, wc, fr, fq); S.done(cur); }
        PG8_STAMP();
        if (!has_next) break;
#pragma unroll
        for (int a = 0; a < 2; ++a)
#pragma unroll
            for (int b = 0; b < 2; ++b)
#pragma unroll
                for (int m = 0; m < 4; ++m)
#pragma unroll
                    for (int n = 0; n < 2; ++n) acc[a][b][m][n] = (f32x4){0.f, 0.f, 0.f, 0.f};
        cur = nxt; cA = nA; cB = nB; ++ui;
    }
    PG8_WAIT_V(0);
    if (wr == 0) PG8_BAR;
    PG8_BAR;
    if constexpr (Epi::AFTER_DRAIN) { E.fused(acc, cur, wr, wc, fr, fq, lds, wid, lane); S.done(cur); }
    PG8_STAMP();
    if (STAMP && wid == 0) { stamps[lane] = lane < nts ? (((unsigned long long)(unsigned)ts_hi << 32) | (unsigned)ts_lo) : 0ull;
        if (lane == 62) stamps[62] = rt_entry; if (lane == 63) stamps[63] = (unsigned long long)wall_clock64(); }
#undef PG8_STAMP
#undef PG8_SA
#undef PG8_SB
#undef PG8_STAGE
#undef PG8_LDA
#undef PG8_LDB
#undef PG8_MMA
#undef PG8_WAIT_V
#undef PG8_WAIT_L
#undef PG8_BAR
#undef PG8_SCHED
}
}


#define LAS __attribute__((address_space(3)))
typedef unsigned short bf16_t;
typedef float f32x4 __attribute__((ext_vector_type(4)));
typedef unsigned u32x4 __attribute__((ext_vector_type(4)));
typedef unsigned u32x2 __attribute__((ext_vector_type(2)));
typedef short bf16x8 __attribute__((ext_vector_type(8)));
typedef short s16x4 __attribute__((ext_vector_type(4)));
typedef float f32x16 __attribute__((ext_vector_type(16)));

constexpr int MTOK = 16384, DM = 2048, SEQ = 8192, NHEAD = 16;
constexpr float ALPHA = 1.41421356237309515f;
constexpr size_t MiB = (size_t)1 << 20;
constexpr size_t WS_WIN = 0, WS_WOUT = 32 * MiB, WS_WKVQ = 40 * MiB, WS_WO = 64 * MiB, WS_WC = 72 * MiB, WS_UB = 88 * MiB, WS_VB = 152 * MiB, WS_USC = 216 * MiB, WS_VSC = 217 * MiB, WS_H = 224 * MiB, WS_XQ = 232 * MiB, WS_XS = 264 * MiB, WS_W = 272 * MiB, WS_CS = 280 * MiB, WS_SLOT = 344 * MiB;
constexpr size_t WS_EID = 920 * MiB, WS_GATE = 928 * MiB, WS_COS = 936 * MiB, WS_SIN = 938 * MiB, WS_KMEAN = 940 * MiB, WS_LB = 941 * MiB, WS_LS = 942 * MiB, WS_SUB = 946 * MiB, WS_CNT = 962 * MiB, WS_CTR = 963 * MiB, WS_DEC = 964 * MiB, WS_END = 966 * MiB;
constexpr size_t WS_KNMAX = WS_KMEAN + 768 * 1024;
__host__ __device__ constexpr size_t slot(int i) { return WS_SLOT + (size_t)i * 64 * MiB; }
constexpr int LDS_BYTES = 144 * 1024;
constexpr int NPH = 20;

struct Args { const float* in[14]; float* out; unsigned char* ws; int ph_lo, ph_hi; };

__device__ __forceinline__ float bflo(unsigned w) { return __uint_as_float(w << 16); }
__device__ __forceinline__ float bfhi(unsigned w) { return __uint_as_float(w & 0xffff0000u); }
__device__ __forceinline__ float bf2f(bf16_t b) { return __uint_as_float(((unsigned)b) << 16); }
typedef __bf16 bf16x2_t __attribute__((ext_vector_type(2)));
typedef float f32x2_t __attribute__((ext_vector_type(2)));
__device__ __forceinline__ unsigned pk_bf16(float lo, float hi) { const f32x2_t f = {lo, hi}; return __builtin_bit_cast(unsigned, __builtin_convertvector(f, bf16x2_t)); }
__device__ __forceinline__ float wave_sum(float v) {
#pragma unroll
    for (int o = 32; o >= 1; o >>= 1) v += __shfl_xor(v, o);
    return v;
}
__device__ __forceinline__ float wave_max(float v) {
#pragma unroll
    for (int o = 32; o >= 1; o >>= 1) v = fmaxf(v, __shfl_xor(v, o));
    return v;
}
__device__ __forceinline__ float sigmoidf_(float z) { return 1.0f / (1.0f + __expf(-z)); }


__device__ __forceinline__ void store_wt16(void* p, u32x4 v) {
    __hip_atomic_store((unsigned long long*)p, ((unsigned long long)v.y << 32) | v.x, __ATOMIC_RELAXED, __HIP_MEMORY_SCOPE_AGENT);
    __hip_atomic_store((unsigned long long*)p + 1, ((unsigned long long)v.w << 32) | v.z, __ATOMIC_RELAXED, __HIP_MEMORY_SCOPE_AGENT);
}
__device__ __forceinline__ void store_wt8(void* p, u32x2 v) {
    __hip_atomic_store((unsigned long long*)p, ((unsigned long long)v.y << 32) | v.x, __ATOMIC_RELAXED, __HIP_MEMORY_SCOPE_AGENT);
}
struct EpiIn {
    static constexpr bool PERM = true, AFTER_DRAIN = false;
    bf16_t* Q1; float* LF; bf16_t* I1; bf16_t* G1; const float* LB;
    __device__ __forceinline__ void operator()(const pg8::f32x4 (&acc)[2][2][4][2], const pg8::Unit& u, int wr, int wc, int fr, int fq) const {
        const int type = u.pn >> 3;
        const int row0 = u.pm * 256 + wr * 64 + fr, col0 = (u.pn & 7) * 256 + wc * 32 + 8 * fq;
        if (type == 1) {
#pragma unroll
            for (int bj = 0; bj < 2; ++bj) {
                const int c = col0 + bj * 128;
                const f32x4 lb0 = *(const f32x4*)(LB + c), lb1 = *(const f32x4*)(LB + c + 4);
#pragma unroll
                for (int ai = 0; ai < 2; ++ai)
#pragma unroll
                    for (int m = 0; m < 4; ++m) {
                        float* p = LF + (size_t)(row0 + ai * 128 + m * 16) * DM + c;
                        f32x4 o0, o1;
#pragma unroll
                        for (int j = 0; j < 4; ++j) {
                            o0[j] = __logf(lb0[j] + (1.0f - lb0[j]) * sigmoidf_(acc[ai][bj][m][0][j]));
                            o1[j] = __logf(lb1[j] + (1.0f - lb1[j]) * sigmoidf_(acc[ai][bj][m][1][j]));
                        }
                        *(f32x4*)p = o0; *(f32x4*)(p + 4) = o1;
                    }
            }
        } else {
            bf16_t* dst = Q1 + (size_t)(type - (type > 0 ? 1 : 0)) * ((size_t)32 << 20);
            const bool act = (type != 2);
#pragma unroll
            for (int ai = 0; ai < 2; ++ai)
#pragma unroll
                for (int m = 0; m < 4; ++m)
#pragma unroll
                    for (int bj = 0; bj < 2; ++bj) {
                        f32x4 v0 = acc[ai][bj][m][0], v1 = acc[ai][bj][m][1];
                        if (act) {
#pragma unroll
                            for (int j = 0; j < 4; ++j) { v0[j] = v0[j] * sigmoidf_(v0[j]); v1[j] = v1[j] * sigmoidf_(v1[j]); }
                        }
                        u32x4 w; w.x = pk_bf16(v0[0], v0[1]); w.y = pk_bf16(v0[2], v0[3]); w.z = pk_bf16(v1[0], v1[1]); w.w = pk_bf16(v1[2], v1[3]);
                        *(u32x4*)(dst + (size_t)(row0 + ai * 128 + m * 16) * DM + col0 + bj * 128) = w;
                    }
        }
    }
};
struct EpiRes {
    static constexpr bool PERM = false, AFTER_DRAIN = false;
    const float* res; float* Y;
    __device__ __forceinline__ void operator()(const pg8::f32x4 (&acc)[2][2][4][2], const pg8::Unit& u, int wr, int wc, int fr, int fq) const {
        const int row0 = u.pm * 256 + wr * 64 + fr, col0 = u.pn * 256 + wc * 32 + 4 * fq;
#pragma unroll
        for (int ai = 0; ai < 2; ++ai)
#pragma unroll
            for (int m = 0; m < 4; ++m) {
                const size_t off = (size_t)(row0 + ai * 128 + m * 16) * DM + col0;
#pragma unroll
                for (int bj = 0; bj < 2; ++bj)
#pragma unroll
                    for (int n = 0; n < 2; ++n) {
                        const f32x4 r = *(const f32x4*)(res + off + bj * 128 + n * 16);
                        *(f32x4*)(Y + off + bj * 128 + n * 16) = r * ALPHA + acc[ai][bj][m][n];
                    }
            }
    }
};
struct EpiF32 {
    static constexpr bool PERM = false, AFTER_DRAIN = false;
    float* C; int ldc;
    __device__ __forceinline__ void operator()(const pg8::f32x4 (&acc)[2][2][4][2], const pg8::Unit& u, int wr, int wc, int fr, int fq) const {
        const int row0 = u.pm * 256 + wr * 64 + fr, col0 = u.pn * 256 + wc * 32 + 4 * fq;
#pragma unroll
        for (int ai = 0; ai < 2; ++ai)
#pragma unroll
            for (int m = 0; m < 4; ++m) {
                float* p = C + (size_t)(row0 + ai * 128 + m * 16) * ldc + col0;
#pragma unroll
                for (int bj = 0; bj < 2; ++bj)
#pragma unroll
                    for (int n = 0; n < 2; ++n) *(f32x4*)(p + bj * 128 + n * 16) = acc[ai][bj][m][n];
            }
    }
};
struct EpiKVQ {
    static constexpr bool PERM = true, AFTER_DRAIN = false;
    bf16_t* K; bf16_t* V; bf16_t* Q;
    __device__ __forceinline__ void operator()(const pg8::f32x4 (&acc)[2][2][4][2], const pg8::Unit& u, int wr, int wc, int fr, int fq) const {
        const int t = u.pn >> 3;
        bf16_t* dst = K + (size_t)t * ((size_t)32 << 20);
        const int row0 = u.pm * 256 + wr * 64 + fr, col0 = (u.pn & 7) * 256 + wc * 32 + 8 * fq;
#pragma unroll
        for (int ai = 0; ai < 2; ++ai)
#pragma unroll
            for (int m = 0; m < 4; ++m)
#pragma unroll
                for (int bj = 0; bj < 2; ++bj) {
                    const f32x4 v0 = acc[ai][bj][m][0], v1 = acc[ai][bj][m][1];
                    u32x4 w; w.x = pk_bf16(v0[0], v0[1]); w.y = pk_bf16(v0[2], v0[3]); w.z = pk_bf16(v1[0], v1[1]); w.w = pk_bf16(v1[2], v1[3]);
                    *(u32x4*)(dst + (size_t)(row0 + ai * 128 + m * 16) * DM + col0 + bj * 128) = w;
                }
    }
};

__device__ __forceinline__ void transpose_tiles(LAS float* tile, const float* src, int ldn, int K, int N, bf16_t* dst) {
    const int tid = threadIdx.x;
    const int tn = N / 64, ntiles = tn * (K / 64);
    for (int tI = blockIdx.x; tI < ntiles; tI += gridDim.x) {
        const int k0 = (tI / tn) * 64, n0 = (tI % tn) * 64;
#pragma unroll
        for (int r = 0; r < 2; ++r) {
            const int kk = (tid >> 4) + 32 * r, nn = (tid & 15) * 4;
            const f32x4 v = *(const f32x4*)(src + (size_t)(k0 + kk) * ldn + n0 + nn);
            tile[kk * 65 + nn + 0] = v[0]; tile[kk * 65 + nn + 1] = v[1]; tile[kk * 65 + nn + 2] = v[2]; tile[kk * 65 + nn + 3] = v[3];
        }
        __syncthreads();
        {
            const int nn = tid >> 3, kk8 = (tid & 7) * 8;
            float f[8];
#pragma unroll
            for (int j = 0; j < 8; ++j) f[j] = tile[(kk8 + j) * 65 + nn];
            u32x4 w; w.x = pk_bf16(f[0], f[1]); w.y = pk_bf16(f[2], f[3]); w.z = pk_bf16(f[4], f[5]); w.w = pk_bf16(f[6], f[7]);
            *(u32x4*)(dst + (size_t)(n0 + nn) * K + k0 + kk8) = w;
        }
        __syncthreads();
    }
}
__device__ __forceinline__ void convert_bf16(const float* src, bf16_t* dst, size_t n) {
    const size_t stride = (size_t)gridDim.x * 512 * 8;
    for (size_t i = ((size_t)blockIdx.x * 512 + threadIdx.x) * 8; i < n; i += stride) {
        const f32x4 a = *(const f32x4*)(src + i), b = *(const f32x4*)(src + i + 4);
        u32x4 w; w.x = pk_bf16(a[0], a[1]); w.y = pk_bf16(a[2], a[3]); w.z = pk_bf16(b[0], b[1]); w.w = pk_bf16(b[2], b[3]);
        *(u32x4*)(dst + i) = w;
    }
}
__device__ __forceinline__ void fold_peer_keys(LAS float* lds, const float* w_query, const float* sub_keys, bf16_t* WcT) {
    const int tid = threadIdx.x;
    LAS float* Ss = lds;
    LAS float* Ws = lds + 128 * 132;
    for (int item = blockIdx.x; item < 1024; item += gridDim.x) {
        const int l = item >> 9, rem = item & 511, hh = rem >> 5, kb = rem & 31, h = hh >> 1, half = hh & 1;
        const float* sk = sub_keys + (size_t)(((l * 2 + half) * 8 + h) * 128) * 128;
        const float* wq = w_query + (size_t)l * DM * DM + (size_t)(kb * 64) * DM + h * 256 + half * 128;
#pragma unroll
        for (int r = 0; r < 8; ++r) { const int idx = tid + 512 * r, key = idx >> 5, d4 = (idx & 31) * 4; *(LAS f32x4*)(Ss + key * 132 + d4) = *(const f32x4*)(sk + key * 128 + d4); }
#pragma unroll
        for (int r = 0; r < 4; ++r) { const int idx = tid + 512 * r, kin = idx >> 5, d4 = (idx & 31) * 4; *(LAS f32x4*)(Ws + kin * 128 + d4) = *(const f32x4*)(wq + (size_t)kin * DM + d4); }
        __syncthreads();
        const int key = tid & 127, kq = tid >> 7;
        float acc[16];
#pragma unroll
        for (int j = 0; j < 16; ++j) acc[j] = 0.f;
        for (int d4 = 0; d4 < 32; ++d4) {
            const f32x4 s4 = *(const LAS f32x4*)(Ss + key * 132 + d4 * 4);
#pragma unroll
            for (int j = 0; j < 16; ++j) { const f32x4 w4 = *(const LAS f32x4*)(Ws + (kq * 16 + j) * 128 + d4 * 4); acc[j] += s4[0] * w4[0] + s4[1] * w4[1] + s4[2] * w4[2] + s4[3] * w4[3]; }
        }
        bf16_t* o = WcT + (size_t)l * DM * DM + (size_t)(h * 256 + half * 128 + key) * DM + kb * 64 + kq * 16;
        u32x4 w0, w1;
        w0.x = pk_bf16(acc[0], acc[1]); w0.y = pk_bf16(acc[2], acc[3]); w0.z = pk_bf16(acc[4], acc[5]); w0.w = pk_bf16(acc[6], acc[7]);
        w1.x = pk_bf16(acc[8], acc[9]); w1.y = pk_bf16(acc[10], acc[11]); w1.z = pk_bf16(acc[12], acc[13]); w1.w = pk_bf16(acc[14], acc[15]);
        *(u32x4*)o = w0; *(u32x4*)(o + 8) = w1;
        __syncthreads();
    }
}

__device__ __forceinline__ void quant_rows(const float* src, unsigned char* dst, float* scl, int nrows) {
    const int lane = threadIdx.x & 63, gw = blockIdx.x * 8 + (threadIdx.x >> 6), nw = gridDim.x * 8;
    for (int row = gw; row < nrows; row += nw) {
        const float* p = src + (size_t)row * DM;
        f32x4 v[8];
#pragma unroll
        for (int i = 0; i < 2; ++i)
#pragma unroll
            for (int q = 0; q < 4; ++q) v[i * 4 + q] = *(const f32x4*)(p + 1024 * i + 16 * lane + 4 * q);
        float am = 0.f;
#pragma unroll
        for (int i = 0; i < 8; ++i) am = fmaxf(am, fmaxf(fmaxf(fabsf(v[i][0]), fabsf(v[i][1])), fmaxf(fabsf(v[i][2]), fabsf(v[i][3]))));
        am = fmaxf(wave_max(am), 1e-30f);
        const float inv = 127.0f / am;
        if (lane == 0) scl[row] = am * (1.0f / 127.0f);
#pragma unroll
        for (int i = 0; i < 2; ++i) {
            u32x4 w;
#pragma unroll
            for (int q = 0; q < 4; ++q) {
                const f32x4 t = v[i * 4 + q];
                const unsigned b0 = (unsigned)(int)(rintf(t[0] * inv) + 128.0f), b1 = (unsigned)(int)(rintf(t[1] * inv) + 128.0f), b2 = (unsigned)(int)(rintf(t[2] * inv) + 128.0f), b3 = (unsigned)(int)(rintf(t[3] * inv) + 128.0f);
                w[q] = b0 | (b1 << 8) | (b2 << 16) | (b3 << 24);
            }
            *(u32x4*)(dst + (size_t)row * DM + 1024 * i + 16 * lane) = w;
        }
    }
}
__device__ __forceinline__ void phase_prep(const Args& a, LAS unsigned char* lds) {
    unsigned char* ws = a.ws;
    LAS float* tile = (LAS float*)lds;
    transpose_tiles(tile, a.in[1], 4 * DM, DM, 4 * DM, (bf16_t*)(ws + WS_WIN));
    transpose_tiles(tile, a.in[3], DM, DM, DM, (bf16_t*)(ws + WS_WOUT));
    transpose_tiles(tile, a.in[5], 2 * DM, DM, 2 * DM, (bf16_t*)(ws + WS_WKVQ));
    transpose_tiles(tile, a.in[6], DM, DM, DM, (bf16_t*)(ws + WS_WKVQ) + (size_t)2 * DM * DM);
    transpose_tiles(tile, a.in[7], DM, DM, DM, (bf16_t*)(ws + WS_WO));
    fold_peer_keys((LAS float*)lds, a.in[8], a.in[9], (bf16_t*)(ws + WS_WC));
    convert_bf16(a.in[0], (bf16_t*)(ws + slot(0)), (size_t)MTOK * DM);
    quant_rows(a.in[10], ws + WS_UB, (float*)(ws + WS_USC), 2 * 16384);
    quant_rows(a.in[11], ws + WS_VB, (float*)(ws + WS_VSC), 2 * 16384);
    const int gtid = blockIdx.x * 512 + threadIdx.x, gthreads = gridDim.x * 512;
    float* COS = (float*)(ws + WS_COS); float* SIN = (float*)(ws + WS_SIN); float* LB = (float*)(ws + WS_LB);
    for (int i = gtid; i < SEQ * 64; i += gthreads) {
        const int pos = i >> 6, j = i & 63;
        double inv = 1.0; const double r = 0.86596432336006535;
        for (int q = 0; q < j; ++q) inv *= r;
        const float ang = (float)pos * (float)inv;
        const double x = (double)ang;
        const double n = __builtin_rint(x * 0.15915494309189535);
        const float rf = (float)__builtin_fma(-n, 6.283185307179586, x);
        COS[i] = cosf(rf); SIN[i] = sinf(rf);
    }
    for (int c = gtid; c < DM; c += gthreads) { const float l0 = a.in[4][c], l1 = a.in[4][DM + c]; LB[c] = 1.0f / (1.0f + expf(l1 - l0)); }
}

__device__ __forceinline__ void phase_scan_naive(const bf16_t* Q1, const float* LF, const bf16_t* I1, float* O) {
    const int lane = threadIdx.x & 63, gw = blockIdx.x * 8 + (threadIdx.x >> 6), nw = gridDim.x * 8;
    for (int item = gw; item < 2 * NHEAD * 128; item += nw) {
        const int bh = item >> 7, v = item & 127, b = bh >> 4, h = bh & 15;
        const size_t base = (size_t)b * SEQ * DM + h * 128;
        float S0 = 0.f, S1 = 0.f;
#pragma unroll 4
        for (int t = 0; t < SEQ; ++t) {
            const size_t ro = base + (size_t)t * DM;
            const float f0 = __expf(LF[ro + lane]), f1 = __expf(LF[ro + 64 + lane]);
            const float q0 = bf2f(Q1[ro + lane]), q1 = bf2f(Q1[ro + 64 + lane]);
            const float iv = bf2f(I1[ro + v]);
            S0 = f0 * S0 + (1.0f - f0) * iv; S1 = f1 * S1 + (1.0f - f1) * iv;
            const float p = wave_sum(q0 * S0 + q1 * S1);
            if (lane == 0) O[ro + v] = p;
        }
    }
}
__device__ __forceinline__ void phase_onorm(const float* O, const bf16_t* G1, const float* gnorm, bf16_t* OG) {
    const int lane = threadIdx.x & 63, gw = blockIdx.x * 8 + (threadIdx.x >> 6), nw = gridDim.x * 8;
    const float gn0 = gnorm[2 * lane], gn1 = gnorm[2 * lane + 1];
    for (int item = gw; item < MTOK * NHEAD; item += nw) {
        const size_t off = (size_t)item * 128 + 2 * lane;
        const float o0 = O[off], o1 = O[off + 1];
        const float ss = wave_sum(o0 * o0 + o1 * o1);
        const float r = rsqrtf(ss * (1.0f / 128.0f) + 1e-6f);
        const unsigned g = *(const unsigned*)(G1 + off);
        *(unsigned*)(OG + off) = pk_bf16(o0 * r * gn0 * bflo(g), o1 * r * gn1 * bfhi(g));
    }
}

__device__ __forceinline__ void ln_row_store(float (&v)[32], const float* g, const float* bta, float* outf, bf16_t* outb, int lane, signed char* outq = nullptr, float* outs = nullptr) {
    float s = 0.f;
#pragma unroll
    for (int i = 0; i < 32; ++i) s += v[i];
    const float mu = wave_sum(s) * (1.0f / DM);
    float q = 0.f;
#pragma unroll
    for (int i = 0; i < 32; ++i) { v[i] -= mu; q += v[i] * v[i]; }
    const float rstd = rsqrtf(wave_sum(q) * (1.0f / DM) + 1e-5f);
    float am = 0.f;
#pragma unroll
    for (int i = 0; i < 4; ++i) {
        const int c = 512 * i + 8 * lane;
        const f32x4 g0 = *(const f32x4*)(g + c), g1 = *(const f32x4*)(g + c + 4), b0 = *(const f32x4*)(bta + c), b1 = *(const f32x4*)(bta + c + 4);
        f32x4 o0, o1;
#pragma unroll
        for (int j = 0; j < 4; ++j) { o0[j] = v[i * 8 + j] * rstd * g0[j] + b0[j]; o1[j] = v[i * 8 + 4 + j] * rstd * g1[j] + b1[j]; v[i * 8 + j] = o0[j]; v[i * 8 + 4 + j] = o1[j]; am = fmaxf(am, fmaxf(fabsf(o0[j]), fabsf(o1[j]))); }
        if (outf) { *(f32x4*)(outf + c) = o0; *(f32x4*)(outf + c + 4) = o1; }
        if (outb) { u32x4 w; w.x = pk_bf16(o0[0], o0[1]); w.y = pk_bf16(o0[2], o0[3]); w.z = pk_bf16(o1[0], o1[1]); w.w = pk_bf16(o1[2], o1[3]); *(u32x4*)(outb + c) = w; }
    }
    if (outq) {
        am = fmaxf(wave_max(am), 1e-30f);
        const float inv = 127.0f / am;
        if (lane == 0) *outs = am * (1.0f / 127.0f);
#pragma unroll
        for (int i = 0; i < 4; ++i) {
            u32x2 w;
            w.x = ((unsigned)(int)rintf(v[i * 8 + 0] * inv) & 0xffu) | (((unsigned)(int)rintf(v[i * 8 + 1] * inv) & 0xffu) << 8) | (((unsigned)(int)rintf(v[i * 8 + 2] * inv) & 0xffu) << 16) | (((unsigned)(int)rintf(v[i * 8 + 3] * inv) & 0xffu) << 24);
            w.y = ((unsigned)(int)rintf(v[i * 8 + 4] * inv) & 0xffu) | (((unsigned)(int)rintf(v[i * 8 + 5] * inv) & 0xffu) << 8) | (((unsigned)(int)rintf(v[i * 8 + 6] * inv) & 0xffu) << 16) | (((unsigned)(int)rintf(v[i * 8 + 7] * inv) & 0xffu) << 24);
            *(u32x2*)(outq + 512 * i + 8 * lane) = w;
        }
    }
}
__device__ __forceinline__ void ln_row_store16(float (&v)[32], const float* g, const float* bta, float* outf, bf16_t* outb, int lane) {
    float s = 0.f;
#pragma unroll
    for (int i = 0; i < 32; ++i) s += v[i];
    const float mu = wave_sum(s) * (1.0f / DM);
    float q = 0.f;
#pragma unroll
    for (int i = 0; i < 32; ++i) { v[i] -= mu; q += v[i] * v[i]; }
    const float rstd = rsqrtf(wave_sum(q) * (1.0f / DM) + 1e-5f);
#pragma unroll
    for (int i = 0; i < 2; ++i) {
        const int c = 1024 * i + 16 * lane;
        f32x4 o[4];
#pragma unroll
        for (int qd = 0; qd < 4; ++qd) {
            const f32x4 gg = *(const f32x4*)(g + c + 4 * qd), bb = *(const f32x4*)(bta + c + 4 * qd);
#pragma unroll
            for (int j = 0; j < 4; ++j) o[qd][j] = v[16 * i + 4 * qd + j] * rstd * gg[j] + bb[j];
            *(f32x4*)(outf + c + 4 * qd) = o[qd];
        }
        if (outb) {
            u32x4 w0, w1;
            w0.x = pk_bf16(o[0][0], o[0][1]); w0.y = pk_bf16(o[0][2], o[0][3]); w0.z = pk_bf16(o[1][0], o[1][1]); w0.w = pk_bf16(o[1][2], o[1][3]);
            w1.x = pk_bf16(o[2][0], o[2][1]); w1.y = pk_bf16(o[2][2], o[2][3]); w1.z = pk_bf16(o[3][0], o[3][1]); w1.w = pk_bf16(o[3][2], o[3][3]);
            *(u32x4*)(outb + c) = w0; *(u32x4*)(outb + c + 8) = w1;
        }
    }
}
template <bool RES16> __device__ __forceinline__ void phase_ln(const float* Y, const void* RESv, const float* g, const float* bta, float* outf, bf16_t* outb, signed char* outq = nullptr, float* outs = nullptr) {
    const int lane = threadIdx.x & 63, gw = blockIdx.x * 8 + (threadIdx.x >> 6), nw = gridDim.x * 8;
    for (int row = gw; row < MTOK; row += nw) {
        float v[32];
        const float* p = Y + (size_t)row * DM;
#pragma unroll
        for (int i = 0; i < 4; ++i) {
            const f32x4 a = *(const f32x4*)(p + 512 * i + 8 * lane), b = *(const f32x4*)(p + 512 * i + 8 * lane + 4);
            f32x4 ra, rb;
            if (RES16) { const u32x4 w = *(const u32x4*)((const bf16_t*)RESv + (size_t)row * DM + 512 * i + 8 * lane); ra = (f32x4){bflo(w.x), bfhi(w.x), bflo(w.y), bfhi(w.y)}; rb = (f32x4){bflo(w.z), bfhi(w.z), bflo(w.w), bfhi(w.w)}; }
            else { const float* rp = (const float*)RESv + (size_t)row * DM; ra = *(const f32x4*)(rp + 512 * i + 8 * lane); rb = *(const f32x4*)(rp + 512 * i + 8 * lane + 4); }
#pragma unroll
            for (int j = 0; j < 4; ++j) { v[i * 8 + j] = a[j] + ALPHA * ra[j]; v[i * 8 + 4 + j] = b[j] + ALPHA * rb[j]; }
        }
        ln_row_store(v, g, bta, outf ? outf + (size_t)row * DM : nullptr, outb ? outb + (size_t)row * DM : nullptr, lane, outq ? outq + (size_t)row * DM : nullptr, outs ? outs + row : nullptr);
    }
}

__device__ __forceinline__ void wave_argmax(float& v, int& idx) {
#pragma unroll
    for (int o = 32; o >= 1; o >>= 1) {
        const float ov = __shfl_xor(v, o); const int oi = __shfl_xor(idx, o);
        if (ov > v || (ov == v && oi < idx)) { v = ov; idx = oi; }
    }
}
__device__ __forceinline__ unsigned fkey(float x) { const unsigned u = __float_as_uint(x); return u ^ (unsigned)(((int)u >> 31) | 0x80000000); }
__device__ __forceinline__ float funkey(unsigned k) { const unsigned u = (k & 0x80000000u) ? (k ^ 0x80000000u) : ~k; return __uint_as_float(u); }
__device__ __forceinline__ void sort16_insert(unsigned (&r)[16], unsigned v) {
#pragma unroll
    for (int i = 0; i < 16; ++i) { const unsigned m = r[i] > v ? r[i] : v; v = r[i] > v ? v : r[i]; r[i] = m; }
}
__device__ __forceinline__ void phase_topk(LAS unsigned char* lds, const float* SCT, int* EID, float* GATE) {
    LAS unsigned char* ib = lds + threadIdx.x * 32;
    for (int item = blockIdx.x * 512 + threadIdx.x; item < MTOK * 8; item += gridDim.x * 512) {
        const int h = item >> 14, tok = item & (MTOK - 1);
        const float* p = SCT + (size_t)(h * 256) * MTOK + tok;
        unsigned r1[16], r2[16];
#pragma unroll
        for (int i = 0; i < 16; ++i) { r1[i] = 0u; r2[i] = 0u; }
#pragma unroll 8
        for (int e = 0; e < 128; ++e) {
            const float x1 = p[(size_t)e * MTOK], x2 = p[(size_t)(128 + e) * MTOK];
            sort16_insert(r1, (fkey(x1) & ~0x7Fu) | (unsigned)e);
            sort16_insert(r2, (fkey(x2) & ~0x7Fu) | (unsigned)e);
        }
        float v1[16], v2[16];
#pragma unroll
        for (int i = 0; i < 16; ++i) { v1[i] = funkey(r1[i] & ~0x7Fu); v2[i] = funkey(r2[i] & ~0x7Fu); ib[i] = (unsigned char)(r1[i] & 0x7Fu); ib[16 + i] = (unsigned char)(r2[i] & 0x7Fu); }
        unsigned r3[16];
#pragma unroll
        for (int i = 0; i < 16; ++i) r3[i] = 0u;
#pragma unroll
        for (int a = 0; a < 16; ++a)
#pragma unroll
            for (int bq = 0; bq < 16; ++bq)
                if ((a + 1) * (bq + 1) <= 16) sort16_insert(r3, (fkey(v1[a] + v2[bq]) & ~0xFFu) | (unsigned)(a * 16 + bq));
        const float mx = funkey(r3[0] & ~0xFFu);
        float ev[16]; float sum = 0.f;
#pragma unroll
        for (int i = 0; i < 16; ++i) { ev[i] = __expf(funkey(r3[i] & ~0xFFu) - mx); sum += ev[i]; }
        const float rs = 1.0f / sum;
        int eid[16];
#pragma unroll
        for (int i = 0; i < 16; ++i) { const unsigned f = r3[i] & 0xFFu; eid[i] = (int)ib[f >> 4] * 128 + (int)ib[16 + (f & 15u)]; }
        int* eo = EID + (size_t)tok * 128 + h * 16; float* go = GATE + (size_t)tok * 128 + h * 16;
#pragma unroll
        for (int q = 0; q < 4; ++q) {
            *(u32x4*)(eo + 4 * q) = (u32x4){(unsigned)eid[4 * q], (unsigned)eid[4 * q + 1], (unsigned)eid[4 * q + 2], (unsigned)eid[4 * q + 3]};
            *(f32x4*)(go + 4 * q) = (f32x4){ev[4 * q] * rs, ev[4 * q + 1] * rs, ev[4 * q + 2] * rs, ev[4 * q + 3] * rs};
        }
    }
}

__device__ __forceinline__ float gelu_erf(float x) { return 0.5f * x * (1.0f + erff(x * 0.70710678118654752f)); }
__device__ __forceinline__ float ub0(unsigned w) { return (float)(w & 0xffu); }
__device__ __forceinline__ float ub1(unsigned w) { return (float)((w >> 8) & 0xffu); }
__device__ __forceinline__ float ub2(unsigned w) { return (float)((w >> 16) & 0xffu); }
__device__ __forceinline__ float ub3(unsigned w) { return (float)(w >> 24); }
__device__ __forceinline__ void phase_peer(LAS unsigned char* lds, const float* X, const int* EID, const float* GATE, const unsigned char* U, const unsigned char* V, const float* USC, const float* VSC,
                                           const float* g, const float* bta, float* outf, bf16_t* outb) {
    const int lane = threadIdx.x & 63, wv = threadIdx.x >> 6, gw = blockIdx.x * 8 + wv, nw = gridDim.x * 8;
    LAS float* hb = (LAS float*)(lds + wv * 512);
    for (int tok = gw; tok < MTOK; tok += nw) {
        float x[32];
        const float* xp = X + (size_t)tok * DM;
#pragma unroll
        for (int i = 0; i < 2; ++i)
#pragma unroll
            for (int q = 0; q < 4; ++q) { const f32x4 t = *(const f32x4*)(xp + 1024 * i + 16 * lane + 4 * q); x[16 * i + 4 * q] = t[0]; x[16 * i + 4 * q + 1] = t[1]; x[16 * i + 4 * q + 2] = t[2]; x[16 * i + 4 * q + 3] = t[3]; }
        float sx = 0.f;
#pragma unroll
        for (int j = 0; j < 32; ++j) sx += x[j];
        const float d0 = -128.0f * sx;
        const int e0 = EID[(size_t)tok * 128 + lane], e1 = EID[(size_t)tok * 128 + 64 + lane];
        const float g0 = GATE[(size_t)tok * 128 + lane], g1 = GATE[(size_t)tok * 128 + 64 + lane];
        for (int bt = 0; bt < 16; ++bt) {
            float d[8];
#pragma unroll
            for (int r = 0; r < 8; ++r) {
                const int e = bt * 8 + r;
                const int idx = __builtin_amdgcn_readfirstlane(__shfl(bt < 8 ? e0 : e1, e & 63));
                const u32x4* up = (const u32x4*)(U + (size_t)idx * DM) + lane;
                float acc = d0;
#pragma unroll
                for (int i = 0; i < 2; ++i) {
                    const u32x4 w = up[i * 64];
                    acc += x[16 * i + 0] * ub0(w.x) + x[16 * i + 1] * ub1(w.x) + x[16 * i + 2] * ub2(w.x) + x[16 * i + 3] * ub3(w.x)
                         + x[16 * i + 4] * ub0(w.y) + x[16 * i + 5] * ub1(w.y) + x[16 * i + 6] * ub2(w.y) + x[16 * i + 7] * ub3(w.y)
                         + x[16 * i + 8] * ub0(w.z) + x[16 * i + 9] * ub1(w.z) + x[16 * i + 10] * ub2(w.z) + x[16 * i + 11] * ub3(w.z)
                         + x[16 * i + 12] * ub0(w.w) + x[16 * i + 13] * ub1(w.w) + x[16 * i + 14] * ub2(w.w) + x[16 * i + 15] * ub3(w.w);
                }
                d[r] = acc;
            }
            const bool b5 = lane & 32, b4 = lane & 16, b3 = lane & 8;
            float t4[4];
#pragma unroll
            for (int q = 0; q < 4; ++q) { const float keep = b5 ? d[4 + q] : d[q], send = b5 ? d[q] : d[4 + q]; t4[q] = keep + __shfl_xor(send, 32); }
            float t2[2];
#pragma unroll
            for (int q = 0; q < 2; ++q) { const float keep = b4 ? t4[2 + q] : t4[q], send = b4 ? t4[q] : t4[2 + q]; t2[q] = keep + __shfl_xor(send, 16); }
            float t1;
            { const float keep = b3 ? t2[1] : t2[0], send = b3 ? t2[0] : t2[1]; t1 = keep + __shfl_xor(send, 8); }
            t1 += __shfl_xor(t1, 4); t1 += __shfl_xor(t1, 2); t1 += __shfl_xor(t1, 1);
            if ((lane & 7) == 0) hb[bt * 8 + (lane >> 3 & 1) + 2 * (lane >> 4 & 1) + 4 * (lane >> 5 & 1)] = t1;
        }
        asm volatile("s_waitcnt lgkmcnt(0)" ::: "memory");
        const float h0 = hb[lane] * USC[e0], h1 = hb[64 + lane] * USC[e1];
        const float w0 = g0 * gelu_erf(h0) * VSC[e0], w1 = g1 * gelu_erf(h1) * VSC[e1];
        float wsum = wave_sum(w0 + w1);
        float y[32];
#pragma unroll
        for (int i = 0; i < 32; ++i) y[i] = 0.f;
#pragma unroll 8
        for (int e = 0; e < 128; ++e) {
            const int idx = __builtin_amdgcn_readfirstlane(__shfl(e < 64 ? e0 : e1, e & 63));
            const float wt = __shfl(e < 64 ? w0 : w1, e & 63);
            const u32x4* vp = (const u32x4*)(V + (size_t)idx * DM) + lane;
#pragma unroll
            for (int i = 0; i < 2; ++i) {
                const u32x4 w = vp[i * 64];
                y[16 * i + 0] += wt * ub0(w.x); y[16 * i + 1] += wt * ub1(w.x); y[16 * i + 2] += wt * ub2(w.x); y[16 * i + 3] += wt * ub3(w.x);
                y[16 * i + 4] += wt * ub0(w.y); y[16 * i + 5] += wt * ub1(w.y); y[16 * i + 6] += wt * ub2(w.y); y[16 * i + 7] += wt * ub3(w.y);
                y[16 * i + 8] += wt * ub0(w.z); y[16 * i + 9] += wt * ub1(w.z); y[16 * i + 10] += wt * ub2(w.z); y[16 * i + 11] += wt * ub3(w.z);
                y[16 * i + 12] += wt * ub0(w.w); y[16 * i + 13] += wt * ub1(w.w); y[16 * i + 14] += wt * ub2(w.w); y[16 * i + 15] += wt * ub3(w.w);
            }
        }
        const float corr = -128.0f * wsum;
#pragma unroll
        for (int i = 0; i < 32; ++i) y[i] = y[i] + corr + ALPHA * x[i];
        ln_row_store16(y, g, bta, outf + (size_t)tok * DM, outb ? outb + (size_t)tok * DM : nullptr, lane);
        asm volatile("s_waitcnt lgkmcnt(0)" ::: "memory");
    }
}

__device__ __forceinline__ int row_dot_i8(const u32x4 (&xq)[2], const unsigned char* rowp, int lane) {
    const u32x4* up = (const u32x4*)rowp + lane;
    int acc = 0;
#pragma unroll
    for (int i = 0; i < 2; ++i) {
        const u32x4 w = up[i * 64];
        acc = __builtin_amdgcn_sdot4((int)xq[i].x, (int)(w.x ^ 0x80808080u), acc, false); acc = __builtin_amdgcn_sdot4((int)xq[i].y, (int)(w.y ^ 0x80808080u), acc, false);
        acc = __builtin_amdgcn_sdot4((int)xq[i].z, (int)(w.z ^ 0x80808080u), acc, false); acc = __builtin_amdgcn_sdot4((int)xq[i].w, (int)(w.w ^ 0x80808080u), acc, false);
    }
    return acc;
}
__device__ __forceinline__ void peer_issue8(u32x4 (&seg)[8], const unsigned char* base, const u32x4 ia, const u32x4 ib) {
    seg[0] = *(const u32x4*)(base + (size_t)ia.x * DM); seg[1] = *(const u32x4*)(base + (size_t)ia.y * DM); seg[2] = *(const u32x4*)(base + (size_t)ia.z * DM); seg[3] = *(const u32x4*)(base + (size_t)ia.w * DM);
    seg[4] = *(const u32x4*)(base + (size_t)ib.x * DM); seg[5] = *(const u32x4*)(base + (size_t)ib.y * DM); seg[6] = *(const u32x4*)(base + (size_t)ib.z * DM); seg[7] = *(const u32x4*)(base + (size_t)ib.w * DM);
}
__device__ __forceinline__ void peer_dot8(int (&d)[8], const u32x4 (&seg)[8], const u32x4 xq) {
#pragma unroll
    for (int i = 0; i < 8; ++i) {
        int acc = __builtin_amdgcn_sdot4((int)xq.x, (int)(seg[i].x ^ 0x80808080u), 0, false);
        acc = __builtin_amdgcn_sdot4((int)xq.y, (int)(seg[i].y ^ 0x80808080u), acc, false);
        acc = __builtin_amdgcn_sdot4((int)xq.z, (int)(seg[i].z ^ 0x80808080u), acc, false);
        d[i] = __builtin_amdgcn_sdot4((int)xq.w, (int)(seg[i].w ^ 0x80808080u), acc, false);
    }
}
__device__ __forceinline__ void phase_peer_u(const signed char* XQ, const int* EID, const unsigned char* U, LAS int* HL  ) {
    const int lane = threadIdx.x & 63, wv = threadIdx.x >> 6, es = lane >> 3, cc = lane & 7;
    const bool b2 = cc & 4, b1 = cc & 2, b0 = cc & 1;
    const int nw = gridDim.x * 8, gw = blockIdx.x * 8 + wv, tpw = (MTOK + nw - 1) / nw, tbase = gw * tpw;
    int cnt = MTOK - tbase; cnt = cnt > tpw ? tpw : cnt;
    if (cnt <= 0) return;
    for (int i = lane; i < cnt * 128; i += 64) HL[i] = 0;
    asm volatile("s_waitcnt lgkmcnt(0)" ::: "memory");
    const int nit = 16 * cnt;
    const unsigned char* ub = U + cc * 16;
    u32x4 m0a, m0b, m0c, m0d, m0x, m1a, m1b, m1c, m1d, m1x, m2a, m2b, m2c, m2d, m2x; u32x4 sA[8], sB[8];
#define PU_LOAD(sl_, k_, A_, B_, C_, D_, X_) { const int* ep_ = EID + (size_t)(tbase + (k_)) * 128 + es * 16; A_ = *(const u32x4*)ep_; B_ = *(const u32x4*)(ep_ + 4); C_ = *(const u32x4*)(ep_ + 8); D_ = *(const u32x4*)(ep_ + 12); \
        X_ = *(const u32x4*)(XQ + (size_t)(tbase + (k_)) * DM + (sl_) * 128 + cc * 16); }
#define PU_NEXT(sl_, k_, sn_, kn_) { kn_ = (k_) + 1; sn_ = (sl_); if (kn_ == cnt) { kn_ = 0; ++sn_; } if (sn_ == 16) { sn_ = 15; kn_ = cnt - 1; } }
    int sl = 0, k = 0, sl1, k1, sl2, k2;
    PU_NEXT(sl, k, sl1, k1) PU_NEXT(sl1, k1, sl2, k2)
    PU_LOAD(sl, k, m0a, m0b, m0c, m0d, m0x)
    PU_LOAD(sl1, k1, m1a, m1b, m1c, m1d, m1x)
    peer_issue8(sA, ub + sl * 128, m0a, m0b);
    for (int it = 0; it < nit; ++it) {
        PU_LOAD(sl2, k2, m2a, m2b, m2c, m2d, m2x)
        peer_issue8(sB, ub + sl * 128, m0c, m0d);
        int dlo[8]; peer_dot8(dlo, sA, m0x);
        peer_issue8(sA, ub + sl1 * 128, m1a, m1b);
        int dhi[8]; peer_dot8(dhi, sB, m0x);
        int t8[8], t4[4], t2[2];
#pragma unroll
        for (int q = 0; q < 8; ++q) { const int keep = b2 ? dhi[q] : dlo[q], send = b2 ? dlo[q] : dhi[q]; t8[q] = keep + __shfl_xor(send, 4); }
#pragma unroll
        for (int q = 0; q < 4; ++q) { const int keep = b1 ? t8[4 + q] : t8[q], send = b1 ? t8[q] : t8[4 + q]; t4[q] = keep + __shfl_xor(send, 2); }
#pragma unroll
        for (int q = 0; q < 2; ++q) { const int keep = b0 ? t4[2 + q] : t4[q], send = b0 ? t4[q] : t4[2 + q]; t2[q] = keep + __shfl_xor(send, 1); }
        { LAS int* hp = HL + k * 128 + es * 16 + (b2 ? 8 : 0) + (b1 ? 4 : 0) + (b0 ? 2 : 0);
          __hip_atomic_fetch_add(hp, t2[0], __ATOMIC_RELAXED, __HIP_MEMORY_SCOPE_WORKGROUP); __hip_atomic_fetch_add(hp + 1, t2[1], __ATOMIC_RELAXED, __HIP_MEMORY_SCOPE_WORKGROUP); }
        sl = sl1; k = k1; sl1 = sl2; k1 = k2; PU_NEXT(sl1, k1, sl2, k2)
        m0a = m1a; m0b = m1b; m0c = m1c; m0d = m1d; m0x = m1x; m1a = m2a; m1b = m2b; m1c = m2c; m1d = m2d; m1x = m2x;
    }
#undef PU_LOAD
#undef PU_NEXT
}
__device__ __forceinline__ void phase_peer_w(const LAS int* HL, const float* XS, const int* EID, const float* GATE, const float* USC, const float* VSC, float* W, float* CS) {
    const int lane = threadIdx.x & 63, gw = blockIdx.x * 8 + (threadIdx.x >> 6), nw = gridDim.x * 8, tpw = (MTOK + nw - 1) / nw, tbase = gw * tpw;
    const int tend = tbase + tpw < MTOK ? tbase + tpw : MTOK;
    for (int tok = tbase; tok < tend; ++tok) {
        const int h0 = HL[(tok - tbase) * 128 + lane], h1 = HL[(tok - tbase) * 128 + 64 + lane];
        const int e0 = EID[(size_t)tok * 128 + lane], e1 = EID[(size_t)tok * 128 + 64 + lane];
        const float xs = XS[tok];
        const float w0 = GATE[(size_t)tok * 128 + lane] * gelu_erf((float)h0 * xs * USC[e0]) * VSC[e0];
        const float w1 = GATE[(size_t)tok * 128 + 64 + lane] * gelu_erf((float)h1 * xs * USC[e1]) * VSC[e1];
        W[(size_t)tok * 128 + lane] = w0; W[(size_t)tok * 128 + 64 + lane] = w1;
        const float cs = wave_sum(w0 + w1);
        if (lane == 0) CS[tok] = cs;
    }
}
__device__ __forceinline__ void peer_fma8(f32x2_t (&ya)[8], const u32x4 (&seg)[8], const f32x4 wa, const f32x4 wb2) {
#pragma unroll
    for (int i = 0; i < 8; ++i) {
        const float wt = i < 4 ? wa[i & 3] : wb2[i & 3];
        const f32x2_t wt2 = {wt, wt};
        const u32x4 w = seg[i];
        ya[0] = __builtin_elementwise_fma(wt2, (f32x2_t){ub0(w.x), ub1(w.x)}, ya[0]); ya[1] = __builtin_elementwise_fma(wt2, (f32x2_t){ub2(w.x), ub3(w.x)}, ya[1]);
        ya[2] = __builtin_elementwise_fma(wt2, (f32x2_t){ub0(w.y), ub1(w.y)}, ya[2]); ya[3] = __builtin_elementwise_fma(wt2, (f32x2_t){ub2(w.y), ub3(w.y)}, ya[3]);
        ya[4] = __builtin_elementwise_fma(wt2, (f32x2_t){ub0(w.z), ub1(w.z)}, ya[4]); ya[5] = __builtin_elementwise_fma(wt2, (f32x2_t){ub2(w.z), ub3(w.z)}, ya[5]);
        ya[6] = __builtin_elementwise_fma(wt2, (f32x2_t){ub0(w.w), ub1(w.w)}, ya[6]); ya[7] = __builtin_elementwise_fma(wt2, (f32x2_t){ub2(w.w), ub3(w.w)}, ya[7]);
    }
}
__device__ __forceinline__ void phase_peer_v(const bf16_t* X, const int* EID, const float* W, const float* CS, const unsigned char* V, float* Y) {
    const int lane = threadIdx.x & 63, wv = threadIdx.x >> 6, es = lane >> 3, cc = lane & 7;
    const bool b5 = lane & 32, b4 = lane & 16, b3 = lane & 8;
    const int nw = gridDim.x * 8, gw = blockIdx.x * 8 + wv, tpw = (MTOK + nw - 1) / nw, tbase = gw * tpw;
    int cnt = MTOK - tbase; cnt = cnt > tpw ? tpw : cnt;
    if (cnt <= 0) return;
    const int nit = 16 * cnt;
    const unsigned char* vb = V + cc * 16;
    const int colo = cc * 16 + (b5 ? 8 : 0) + (b4 ? 4 : 0) + (b3 ? 2 : 0);
    u32x4 m0c, m0d, m1a, m1b, m1c, m1d, m2a, m2b, m2c, m2d; f32x4 w0a, w0b, w0c, w0d, w1a, w1b, w1c, w1d; f32x2_t x0, x1; float c0, c1; u32x4 sA[8], sB[8];
#define PV_IDS(k_, A_, B_, C_, D_) { const size_t o_ = (size_t)(tbase + (k_)) * 128 + es * 16; A_ = *(const u32x4*)(EID + o_); B_ = *(const u32x4*)(EID + o_ + 4); C_ = *(const u32x4*)(EID + o_ + 8); D_ = *(const u32x4*)(EID + o_ + 12); }
#define PV_WX(sl_, k_, WA_, WB_, WC_, WD_, X_, CS_) { const size_t o_ = (size_t)(tbase + (k_)) * 128 + es * 16; \
        WA_ = *(const f32x4*)(W + o_); WB_ = *(const f32x4*)(W + o_ + 4); WC_ = *(const f32x4*)(W + o_ + 8); WD_ = *(const f32x4*)(W + o_ + 12); \
        { const unsigned xw_ = *(const unsigned*)(X + (size_t)(tbase + (k_)) * DM + (sl_) * 128 + colo); X_ = (f32x2_t){bflo(xw_), bfhi(xw_)}; } CS_ = CS[tbase + (k_)]; }
#define PV_NEXT(sl_, k_, sn_, kn_) { kn_ = (k_) + 1; sn_ = (sl_); if (kn_ == cnt) { kn_ = 0; ++sn_; } if (sn_ == 16) { sn_ = 15; kn_ = cnt - 1; } }
    int sl = 0, k = 0, sl1, k1, sl2, k2;
    PV_NEXT(sl, k, sl1, k1) PV_NEXT(sl1, k1, sl2, k2)
    { u32x4 ta, tb; PV_IDS(k, ta, tb, m0c, m0d) PV_IDS(k1, m1a, m1b, m1c, m1d)
      PV_WX(sl, k, w0a, w0b, w0c, w0d, x0, c0)
      peer_issue8(sA, vb + sl * 128, ta, tb); }
    for (int it = 0; it < nit; ++it) {
        PV_IDS(k2, m2a, m2b, m2c, m2d)
        peer_issue8(sB, vb + sl * 128, m0c, m0d);
        f32x2_t ya[8];
#pragma unroll
        for (int j = 0; j < 8; ++j) ya[j] = (f32x2_t){0.f, 0.f};
        peer_fma8(ya, sA, w0a, w0b);
        peer_issue8(sA, vb + sl1 * 128, m1a, m1b);
        PV_WX(sl1, k1, w1a, w1b, w1c, w1d, x1, c1)
        peer_fma8(ya, sB, w0c, w0d);
        f32x2_t t4[4], t2[2], t1;
#pragma unroll
        for (int q = 0; q < 4; ++q) { const f32x2_t keep = b5 ? ya[4 + q] : ya[q], send = b5 ? ya[q] : ya[4 + q]; t4[q][0] = keep[0] + __shfl_xor(send[0], 32); t4[q][1] = keep[1] + __shfl_xor(send[1], 32); }
#pragma unroll
        for (int q = 0; q < 2; ++q) { const f32x2_t keep = b4 ? t4[2 + q] : t4[q], send = b4 ? t4[q] : t4[2 + q]; t2[q][0] = keep[0] + __shfl_xor(send[0], 16); t2[q][1] = keep[1] + __shfl_xor(send[1], 16); }
        { const f32x2_t keep = b3 ? t2[1] : t2[0], send = b3 ? t2[0] : t2[1]; t1[0] = keep[0] + __shfl_xor(send[0], 8); t1[1] = keep[1] + __shfl_xor(send[1], 8); }
        f32x2_t o; o[0] = t1[0] - 128.0f * c0 + ALPHA * x0[0]; o[1] = t1[1] - 128.0f * c0 + ALPHA * x0[1];
        *(f32x2_t*)(Y + (size_t)(tbase + k) * DM + sl * 128 + colo) = o;
        sl = sl1; k = k1; sl1 = sl2; k1 = k2; PV_NEXT(sl1, k1, sl2, k2)
        m0c = m1c; m0d = m1d; m1a = m2a; m1b = m2b; m1c = m2c; m1d = m2d;
        w0a = w1a; w0b = w1b; w0c = w1c; w0d = w1d; x0 = x1; c0 = c1;
    }
#undef PV_IDS
#undef PV_WX
#undef PV_NEXT
}

__device__ __forceinline__ void rot8(const u32x4 lo, const u32x4 hi, const f32x4 c0, const f32x4 c1, const f32x4 s0, const f32x4 s1, float (&o1)[8], float (&o2)[8]) {
    const float a[8] = {bflo(lo.x), bfhi(lo.x), bflo(lo.y), bfhi(lo.y), bflo(lo.z), bfhi(lo.z), bflo(lo.w), bfhi(lo.w)};
    const float b[8] = {bflo(hi.x), bfhi(hi.x), bflo(hi.y), bfhi(hi.y), bflo(hi.z), bfhi(hi.z), bflo(hi.w), bfhi(hi.w)};
    const float c[8] = {c0[0], c0[1], c0[2], c0[3], c1[0], c1[1], c1[2], c1[3]}, sn[8] = {s0[0], s0[1], s0[2], s0[3], s1[0], s1[1], s1[2], s1[3]};
#pragma unroll
    for (int j = 0; j < 8; ++j) { o1[j] = a[j] * c[j] - b[j] * sn[j]; o2[j] = a[j] * sn[j] + b[j] * c[j]; }
}
__device__ __forceinline__ u32x4 pack8(const float (&o)[8]) { u32x4 w; w.x = pk_bf16(o[0], o[1]); w.y = pk_bf16(o[2], o[3]); w.z = pk_bf16(o[4], o[5]); w.w = pk_bf16(o[6], o[7]); return w; }
__device__ __forceinline__ void phase_rot(LAS float* red, bf16_t* KR, bf16_t* QR, const float* COS, const float* SIN, float* KMEAN, float* KNMAX) {
    const int tid = threadIdx.x, ch = tid & 7, rr = tid >> 3, wv = tid >> 6, lane = tid & 63;
    for (int item = blockIdx.x; item < 2 * NHEAD * 32; item += gridDim.x) {
        const int bh = item >> 5, j = item & 31, b = bh >> 4, h = bh & 15;
        float sm1[8], sm2[8]; float nmax = 0.f;
#pragma unroll
        for (int q = 0; q < 8; ++q) { sm1[q] = 0.f; sm2[q] = 0.f; }
#pragma unroll
        for (int ps = 0; ps < 4; ++ps) {
            const int pos = j * 256 + ps * 64 + rr;
            const size_t off = ((size_t)b * SEQ + pos) * DM + h * 128 + ch * 8;
            const f32x4 c0 = *(const f32x4*)(COS + pos * 64 + ch * 8), c1 = *(const f32x4*)(COS + pos * 64 + ch * 8 + 4);
            const f32x4 s0 = *(const f32x4*)(SIN + pos * 64 + ch * 8), s1 = *(const f32x4*)(SIN + pos * 64 + ch * 8 + 4);
            float o1[8], o2[8];
            rot8(*(const u32x4*)(KR + off), *(const u32x4*)(KR + off + 64), c0, c1, s0, s1, o1, o2);
            *(u32x4*)(KR + off) = pack8(o1); *(u32x4*)(KR + off + 64) = pack8(o2);
            float nq = 0.f;
#pragma unroll
            for (int q = 0; q < 8; ++q) { sm1[q] += o1[q]; sm2[q] += o2[q]; nq += o1[q] * o1[q] + o2[q] * o2[q]; }
            nq += __shfl_xor(nq, 1); nq += __shfl_xor(nq, 2); nq += __shfl_xor(nq, 4);
            nmax = fmaxf(nmax, nq);
            rot8(*(const u32x4*)(QR + off), *(const u32x4*)(QR + off + 64), c0, c1, s0, s1, o1, o2);
            *(u32x4*)(QR + off) = pack8(o1); *(u32x4*)(QR + off + 64) = pack8(o2);
        }
#pragma unroll
        for (int q = 0; q < 8; ++q) {
            sm1[q] += __shfl_xor(sm1[q], 8); sm1[q] += __shfl_xor(sm1[q], 16); sm1[q] += __shfl_xor(sm1[q], 32);
            sm2[q] += __shfl_xor(sm2[q], 8); sm2[q] += __shfl_xor(sm2[q], 16); sm2[q] += __shfl_xor(sm2[q], 32);
        }
        nmax = wave_max(nmax);
        if (lane < 8) {
#pragma unroll
            for (int q = 0; q < 8; ++q) { red[wv * 128 + lane * 8 + q] = sm1[q]; red[wv * 128 + 64 + lane * 8 + q] = sm2[q]; }
        }
        if (lane == 0) red[1024 + wv] = nmax;
        __syncthreads();
        if (tid < 128) {
            float s2 = 0.f;
#pragma unroll
            for (int r = 0; r < 8; ++r) s2 += red[r * 128 + tid];
            KMEAN[(size_t)item * 128 + tid] = s2 * (1.0f / 256.0f);
        }
        if (tid == 0) {
            float m = 0.f;
#pragma unroll
            for (int r = 0; r < 8; ++r) m = fmaxf(m, red[1024 + r]);
            KNMAX[item] = sqrtf(m);
        }
        __syncthreads();
    }
}

__device__ __forceinline__ void top3_insert(float x, int m, float& v0, int& i0, float& v1, int& i1, float& v2, int& i2) {
    const bool c0 = x > v0 || (x == v0 && m < i0), c1 = x > v1 || (x == v1 && m < i1), c2 = x > v2 || (x == v2 && m < i2);
    v2 = c1 ? v1 : (c2 ? x : v2); i2 = c1 ? i1 : (c2 ? m : i2);
    v1 = c0 ? v0 : (c1 ? x : v1); i1 = c0 ? i0 : (c1 ? m : i1);
    v0 = c0 ? x : v0; i0 = c0 ? m : i0;
}
__device__ __forceinline__ void phase_sel(LAS unsigned char* lds, const bf16_t* QR, const float* KMEAN, unsigned short* SUB, int* CNT, int* ctr) {
    const int tid = threadIdx.x, lane = tid & 63, wv = tid >> 6, r32 = lane & 31, hh = lane >> 5;
    LAS unsigned short* bucket = (LAS unsigned short*)lds;
    LAS int* cnt = (LAS int*)(lds + 16384);
    const float NEG = -1e30f;
    if (blockIdx.x == 0 && tid == 0) *ctr = 0;
    for (int item = blockIdx.x; item < 2 * NHEAD * 32; item += gridDim.x) {
        const int bh = item >> 5, i = item & 31, b = bh >> 4, h = bh & 15;
        if (i == 0) continue;
        if (tid < 32) cnt[tid] = 0;
        __syncthreads();
        const float* kmp = KMEAN + ((size_t)bh * 32 + r32) * 128 + 8 * hh;
        const size_t tok = (size_t)b * SEQ + i * 256 + wv * 32 + r32;
        const bf16_t* qp = QR + tok * DM + h * 128 + 8 * hh;
        f32x16 S;
#pragma unroll
        for (int e = 0; e < 16; ++e) S[e] = 0.f;
#pragma unroll
        for (int s2 = 0; s2 < 8; ++s2) {
            const f32x4 ka = *(const f32x4*)(kmp + 16 * s2), kb = *(const f32x4*)(kmp + 16 * s2 + 4);
            const bf16x8 qf = *(const bf16x8*)(qp + 16 * s2);
            u32x4 hi, lo;
            hi.x = pk_bf16(ka[0], ka[1]); hi.y = pk_bf16(ka[2], ka[3]); hi.z = pk_bf16(kb[0], kb[1]); hi.w = pk_bf16(kb[2], kb[3]);
            lo.x = pk_bf16(ka[0] - bflo(hi.x), ka[1] - bfhi(hi.x)); lo.y = pk_bf16(ka[2] - bflo(hi.y), ka[3] - bfhi(hi.y));
            lo.z = pk_bf16(kb[0] - bflo(hi.z), kb[1] - bfhi(hi.z)); lo.w = pk_bf16(kb[2] - bflo(hi.w), kb[3] - bfhi(hi.w));
            S = __builtin_amdgcn_mfma_f32_32x32x16_bf16(__builtin_bit_cast(bf16x8, hi), qf, S, 0, 0, 0);
            S = __builtin_amdgcn_mfma_f32_32x32x16_bf16(__builtin_bit_cast(bf16x8, lo), qf, S, 0, 0, 0);
        }
        float v0 = -3e38f, v1 = -3e38f, v2 = -3e38f; int i0 = 99, i1 = 99, i2 = 99;
#pragma unroll
        for (int e = 0; e < 16; ++e) {
            const int m = (e & 3) + 8 * (e >> 2) + 4 * hh;
            const float x = m < i ? S[e] : NEG;
            top3_insert(x, m, v0, i0, v1, i1, v2, i2);
        }
        {
            const float pv0 = __shfl_xor(v0, 32), pv1 = __shfl_xor(v1, 32), pv2 = __shfl_xor(v2, 32);
            const int pi0 = __shfl_xor(i0, 32), pi1 = __shfl_xor(i1, 32), pi2 = __shfl_xor(i2, 32);
            top3_insert(pv0, pi0, v0, i0, v1, i1, v2, i2); top3_insert(pv1, pi1, v0, i0, v1, i1, v2, i2); top3_insert(pv2, pi2, v0, i0, v1, i1, v2, i2);
        }
        if (hh == 0) {
            const int tl = wv * 32 + r32;
            if (v0 > 0.5f * NEG) { const int p = __hip_atomic_fetch_add(cnt + i0, 1, __ATOMIC_RELAXED, __HIP_MEMORY_SCOPE_WORKGROUP); bucket[i0 * 256 + p] = (unsigned short)(tl | (0 << 8)); }
            if (v1 > 0.5f * NEG) { const int p = __hip_atomic_fetch_add(cnt + i1, 1, __ATOMIC_RELAXED, __HIP_MEMORY_SCOPE_WORKGROUP); bucket[i1 * 256 + p] = (unsigned short)(tl | (1 << 8)); }
            if (v2 > 0.5f * NEG) { const int p = __hip_atomic_fetch_add(cnt + i2, 1, __ATOMIC_RELAXED, __HIP_MEMORY_SCOPE_WORKGROUP); bucket[i2 * 256 + p] = (unsigned short)(tl | (2 << 8)); }
        }
        __syncthreads();
        for (int idx = tid; idx < 32 * 256; idx += 512) {
            const int j = idx >> 8, p = idx & 255;
            if (j < i && p < cnt[j]) SUB[(((size_t)bh * 32 + j) * 32 + i) * 256 + p] = bucket[idx];
        }
        if (tid < i) CNT[((size_t)bh * 32 + tid) * 32 + i] = cnt[tid];
        __syncthreads();
    }
}

__device__ __forceinline__ unsigned off_b(unsigned row, unsigned ch) { return 256u * row + 16u * (ch ^ (((row & 3u) << 2) | ((row >> 2) & 3u))); }
__device__ __forceinline__ unsigned pi32(unsigned m) { return (m & ~12u) | ((m & 4u) << 1) | ((m & 8u) >> 1); }
__device__ __forceinline__ bf16x8 tr_frag(LAS unsigned char* img, unsigned lane, unsigned c, unsigned ks) {
    const unsigned hh = lane >> 5, blk = (lane >> 4) & 1, q = (lane & 15) >> 2, p = lane & 3;
    const unsigned a0 = off_b(16 * ks + 8 * hh + q, 4 * c + 2 * blk + (p >> 1)) + 8 * (p & 1);
    const unsigned a1 = off_b(16 * ks + 8 * hh + 4 + q, 4 * c + 2 * blk + (p >> 1)) + 8 * (p & 1);
    const s16x4 lo = __builtin_amdgcn_ds_read_tr16_b64_v4i16((LAS s16x4*)(img + a0));
    const s16x4 hi = __builtin_amdgcn_ds_read_tr16_b64_v4i16((LAS s16x4*)(img + a1));
    bf16x8 r; r[0] = lo[0]; r[1] = lo[1]; r[2] = lo[2]; r[3] = lo[3]; r[4] = hi[0]; r[5] = hi[1]; r[6] = hi[2]; r[7] = hi[3];
    return r;
}
__device__ __forceinline__ void phase_att(LAS unsigned char* lds, const bf16_t* QR, const bf16_t* KR, const bf16_t* V, const float* KNMAX, const unsigned short* SUB, const int* CNT, int* ctr,
                                          bf16_t* P012, bf16_t* P3, float* LS) {
    const int tid = threadIdx.x, lane = tid & 63, wv = tid >> 6, r32 = lane & 31, hh = lane >> 5;
    LAS unsigned char* Kimg = lds;
    LAS unsigned char* Vimg = lds + 65536;
    LAS int* misc = (LAS int*)(lds + 131072);
    const float SCL2 = 0.08838834764831845f * 1.4426950408889634f;
    for (;;) {
        __syncthreads();
        if (tid == 0) misc[40] = __hip_atomic_fetch_add(ctr, 1, __ATOMIC_RELAXED, __HIP_MEMORY_SCOPE_AGENT);
        __syncthreads();
        const int item = misc[40];
        if (item >= 2 * NHEAD * 32) break;
        const int j = item >> 5, bh = item & 31, b = bh >> 4, h = bh & 15;
#pragma unroll
        for (int r = 0; r < 8; ++r) {
            const int idx = tid + 512 * r, row = idx >> 4, ch = idx & 15;
            const size_t g = ((size_t)b * SEQ + j * 256 + row) * DM + h * 128 + ch * 8;
            const u32x4 kv = *(const u32x4*)(KR + g), vv = *(const u32x4*)(V + g);
            *(LAS u32x4*)(Kimg + off_b(row, ch)) = kv; *(LAS u32x4*)(Vimg + off_b(row, ch)) = vv;
        }
        if (tid <= 32) { int pre = 0; for (int u = j + 1; u < tid; ++u) pre += CNT[((size_t)bh * 32 + j) * 32 + u]; misc[tid] = pre; }
        float kn = (lane < 32) ? KNMAX[bh * 32 + lane] : 0.f;
        kn = wave_max(kn);
        __syncthreads();
        const int total = misc[32], ntile = (256 + total + 31) >> 5;
        for (int tile = wv; tile < ntile; tile += 8) {
            const int gr = tile * 32 + r32;
            int pos, slot; bool valid = true;
            if (gr < 256) { pos = j * 256 + gr; slot = 3; }
            else {
                const int x = gr - 256; valid = x < total;
                int ii = j + 1;
                for (int u = j + 1; u < 32; ++u) if (misc[u] <= x) ii = u;
                if (valid) { const unsigned e = SUB[(((size_t)bh * 32 + j) * 32 + ii) * 256 + (x - misc[ii])]; pos = ii * 256 + (int)(e & 255u); slot = (int)(e >> 8); }
                else { pos = j * 256; slot = 3; }
            }
            const size_t tok = (size_t)b * SEQ + pos;
            bf16x8 qf[8];
            const bf16_t* qp = QR + tok * DM + h * 128 + 8 * hh;
#pragma unroll
            for (int s = 0; s < 8; ++s) qf[s] = *(const bf16x8*)(qp + 16 * s);
            float qn2 = 0.f;
#pragma unroll
            for (int s = 0; s < 8; ++s)
#pragma unroll
                for (int e = 0; e < 8; ++e) { const float f = bf2f((bf16_t)qf[s][e]); qn2 += f * f; }
            qn2 += __shfl_xor(qn2, 32);
            const float c2 = sqrtf(qn2) * kn * SCL2;
            f32x16 O[4];
#pragma unroll
            for (int dt = 0; dt < 4; ++dt)
#pragma unroll
                for (int e = 0; e < 16; ++e) O[dt][e] = 0.f;
            float l = 0.f;
            const bool own = tile < 8;
            const int kcn = own ? tile + 1 : 8;
            const unsigned krow = pi32((unsigned)r32);
            for (int kc = 0; kc < kcn; ++kc) {
                f32x16 S;
#pragma unroll
                for (int e = 0; e < 16; ++e) S[e] = 0.f;
#pragma unroll
                for (int s = 0; s < 8; ++s) {
                    const bf16x8 kf = *(const LAS bf16x8*)(Kimg + off_b(32 * kc + krow, 2 * s + hh));
                    S = __builtin_amdgcn_mfma_f32_32x32x16_bf16(kf, qf[s], S, 0, 0, 0);
                }
                float p[16];
#pragma unroll
                for (int e = 0; e < 16; ++e) {
                    const unsigned m = (e & 3) + 8 * (e >> 2) + 4 * hh;
                    const int key = j * 256 + 32 * kc + (int)pi32(m);
                    float pe = __builtin_amdgcn_exp2f(S[e] * SCL2 - c2);
                    if (own && key > pos) pe = 0.f;
                    p[e] = pe; l += pe;
                }
                u32x4 w0, w1;
                w0.x = pk_bf16(p[0], p[1]); w0.y = pk_bf16(p[2], p[3]); w0.z = pk_bf16(p[4], p[5]); w0.w = pk_bf16(p[6], p[7]);
                w1.x = pk_bf16(p[8], p[9]); w1.y = pk_bf16(p[10], p[11]); w1.z = pk_bf16(p[12], p[13]); w1.w = pk_bf16(p[14], p[15]);
                const bf16x8 pf0 = __builtin_bit_cast(bf16x8, w0), pf1 = __builtin_bit_cast(bf16x8, w1);
#pragma unroll
                for (int dt = 0; dt < 4; ++dt) {
                    const bf16x8 v0 = tr_frag(Vimg, lane, dt, 2 * kc), v1 = tr_frag(Vimg, lane, dt, 2 * kc + 1);
                    O[dt] = __builtin_amdgcn_mfma_f32_32x32x16_bf16(v0, pf0, O[dt], 0, 0, 0);
                    O[dt] = __builtin_amdgcn_mfma_f32_32x32x16_bf16(v1, pf1, O[dt], 0, 0, 0);
                }
            }
            l += __shfl_xor(l, 32);
            if (valid) {
                bf16_t* pl = (slot < 3 ? P012 + (size_t)slot * ((size_t)32 << 20) : P3) + (tok * NHEAD + h) * 128 + 4 * hh;
#pragma unroll
                for (int dt = 0; dt < 4; ++dt)
#pragma unroll
                    for (int g = 0; g < 4; ++g) {
                        u32x2 w; w.x = pk_bf16(O[dt][4 * g], O[dt][4 * g + 1]); w.y = pk_bf16(O[dt][4 * g + 2], O[dt][4 * g + 3]);
                        *(u32x2*)(pl + 32 * dt + 8 * g) = w;
                    }
                if (hh == 0) LS[(size_t)slot * MTOK * NHEAD + tok * NHEAD + h] = l;
            }
        }
    }
}
__device__ __forceinline__ void phase_comb(const bf16_t* P012, const bf16_t* P3, const float* LS, bf16_t* AO) {
    const size_t n = (size_t)MTOK * NHEAD * 16, stride = (size_t)gridDim.x * 512;
    for (size_t idx = (size_t)blockIdx.x * 512 + threadIdx.x; idx < n; idx += stride) {
        const size_t th = idx >> 4; const int ch = (int)(idx & 15);
        const int t = (int)((th >> 4) & (SEQ - 1)), blk = t >> 8, nsel = blk < 3 ? blk : 3;
        float acc[8];
        float l = LS[(size_t)3 * MTOK * NHEAD + th];
        { const u32x4 w = *(const u32x4*)(P3 + th * 128 + ch * 8);
          acc[0] = bflo(w.x); acc[1] = bfhi(w.x); acc[2] = bflo(w.y); acc[3] = bfhi(w.y); acc[4] = bflo(w.z); acc[5] = bfhi(w.z); acc[6] = bflo(w.w); acc[7] = bfhi(w.w); }
        for (int s = 0; s < nsel; ++s) {
            const u32x4 w = *(const u32x4*)(P012 + (size_t)s * ((size_t)32 << 20) + th * 128 + ch * 8);
            acc[0] += bflo(w.x); acc[1] += bfhi(w.x); acc[2] += bflo(w.y); acc[3] += bfhi(w.y); acc[4] += bflo(w.z); acc[5] += bfhi(w.z); acc[6] += bflo(w.w); acc[7] += bfhi(w.w);
            l += LS[(size_t)s * MTOK * NHEAD + th];
        }
        const float rl = 1.0f / l;
        u32x4 o; o.x = pk_bf16(acc[0] * rl, acc[1] * rl); o.y = pk_bf16(acc[2] * rl, acc[3] * rl); o.z = pk_bf16(acc[4] * rl, acc[5] * rl); o.w = pk_bf16(acc[6] * rl, acc[7] * rl);
        *(u32x4*)(AO + th * 128 + ch * 8) = o;
    }
}

__device__ __forceinline__ float logf_gate(float z, float lb) { return __logf(lb + (1.0f - lb) * sigmoidf_(z)); }
__device__ __forceinline__ void phase_scan_a(LAS unsigned char* lds, const bf16_t* FZ, const float* LB, const bf16_t* I1, bf16_t* LT, float* DEC, unsigned* dbgc = nullptr) {
    unsigned dbg_kt = 0, dbg_acc = 0;
    const int tid = threadIdx.x, lane = tid & 63, wv = tid >> 6, k = tid & 127, part = tid >> 7;
    LAS unsigned char* Iimg = lds; LAS unsigned char* KTimg = lds + 16384;
    LAS float* psum = (LAS float*)(lds + 32768);
    LAS unsigned char* Lst = lds + 36864;
#if SCAN_A_VALU == 2
    for (int item = blockIdx.x; item < 2 * NHEAD * 128; item += gridDim.x) {
        const int bh = item >> 7, c = item & 127, b = bh >> 4, h = bh & 15;
        const size_t tok0 = (size_t)b * SEQ + c * 64;
        for (int idx = tid; idx < 16384; idx += 512) {
            const int v = idx >> 7, kk = idx & 127;
            float g = 1.f, L = 0.f;
            for (int s2 = 63; s2 >= 0; --s2) { const size_t o = (tok0 + s2) * DM + h * 128; const float f = __expf(logf_gate(bf2f(FZ[o + kk]), LB[h * 128 + kk])); L += bf2f(I1[o + v]) * (1.0f - f) * g; g *= f; }
            LT[(size_t)item * 16384 + idx] = (bf16_t)(pk_bf16(L, 0.f) & 0xffffu);
        }
    }
    return;
#endif
    bf16_t nfz[16]; u32x4 nit_[2];
#define SA_LOAD(item_) { const int bh_ = (item_) >> 7, c_ = (item_) & 127; const size_t t0_ = (size_t)(bh_ >> 4) * SEQ + c_ * 64; const int h_ = bh_ & 15; \
        _Pragma("unroll") for (int i = 0; i < 16; ++i) nfz[i] = FZ[(t0_ + 16 * part + i) * DM + h_ * 128 + k]; \
        _Pragma("unroll") for (int r = 0; r < 2; ++r) { const int idx = tid + 512 * r, row = idx >> 4, ch = idx & 15; nit_[r] = *(const u32x4*)(I1 + (t0_ + row) * DM + h_ * 128 + ch * 8); } }
    if ((int)blockIdx.x < 2 * NHEAD * 128) SA_LOAD((int)blockIdx.x)
    for (int item = blockIdx.x; item < 2 * NHEAD * 128; item += gridDim.x) {
        const int bh = item >> 7, c = item & 127, b = bh >> 4, h = bh & 15;
        const size_t tok0 = (size_t)b * SEQ + c * 64;
        float lf[16];
        const float lbk = LB[h * 128 + k];
#pragma unroll
        for (int i = 0; i < 16; ++i) lf[i] = logf_gate(bf2f(nfz[i]), lbk);
#pragma unroll
        for (int r = 0; r < 2; ++r) { const int idx = tid + 512 * r, row = idx >> 4, ch = idx & 15; *(LAS u32x4*)(Iimg + off_b(row, ch)) = nit_[r]; }
        if (item + (int)gridDim.x < 2 * NHEAD * 128) SA_LOAD(item + (int)gridDim.x)
        float cs = 0.f;
#pragma unroll
        for (int i = 0; i < 16; ++i) cs += lf[i];
        psum[part * 128 + k] = cs;
        __syncthreads();
        const float p0 = psum[k], p1 = psum[128 + k], p2 = psum[256 + k], p3 = psum[384 + k];
        const float blast = (p0 + p1) + (p2 + p3);
        float bb = part == 0 ? 0.f : (part == 1 ? p0 : (part == 2 ? p0 + p1 : p0 + p1 + p2));
#pragma unroll
        for (int i = 0; i < 16; ++i) {
            bb += lf[i];
            const float kt = (1.0f - __expf(lf[i])) * __expf(blast - bb);
            if (!(kt - kt == 0.f)) ++dbg_kt;
            const int srow = 16 * part + i;
            *(LAS bf16_t*)(KTimg + off_b(srow, k >> 3) + 2 * (k & 7)) = (bf16_t)(pk_bf16(kt, 0.f) & 0xffffu);
        }
        if (part == 0) DEC[(size_t)item * 128 + k] = __expf(blast);
        __syncthreads();
#if SCAN_A_VALU
        for (int idx = tid; idx < 16384; idx += 512) {
            const int v = idx >> 7, kk = idx & 127;
            float accv = 0.f;
            for (int s2 = 0; s2 < 64; ++s2) accv += bf2f(*(const LAS bf16_t*)(Iimg + off_b(s2, v >> 3) + 2 * (v & 7))) * bf2f(*(const LAS bf16_t*)(KTimg + off_b(s2, kk >> 3) + 2 * (kk & 7)));
            *(LAS bf16_t*)(Lst + v * 272 + 2 * kk) = (bf16_t)(pk_bf16(accv, 0.f) & 0xffffu);
        }
        if (0)
#endif
        {
            const int vt = wv >> 1;
            f32x16 acc0, acc1;
#pragma unroll
            for (int e = 0; e < 16; ++e) { acc0[e] = 0.f; acc1[e] = 0.f; }
#pragma unroll
            for (int ks = 0; ks < 4; ++ks) {
                const bf16x8 af = tr_frag(Iimg, lane, vt, ks);
                const bf16x8 b0 = tr_frag(KTimg, lane, 2 * (wv & 1), ks), b1 = tr_frag(KTimg, lane, 2 * (wv & 1) + 1, ks);
                acc0 = __builtin_amdgcn_mfma_f32_32x32x16_bf16(af, b0, acc0, 0, 0, 0);
                acc1 = __builtin_amdgcn_mfma_f32_32x32x16_bf16(af, b1, acc1, 0, 0, 0);
            }
            const int r32 = lane & 31, hh = lane >> 5;
#pragma unroll
            for (int e = 0; e < 16; ++e) {
                if (!(acc0[e] - acc0[e] == 0.f)) ++dbg_acc; if (!(acc1[e] - acc1[e] == 0.f)) ++dbg_acc;
                const int v = 32 * vt + (e & 3) + 8 * (e >> 2) + 4 * hh;
                *(LAS bf16_t*)(Lst + v * 272 + 2 * (64 * (wv & 1) + r32)) = (bf16_t)(pk_bf16(acc0[e], 0.f) & 0xffffu);
                *(LAS bf16_t*)(Lst + v * 272 + 2 * (64 * (wv & 1) + 32 + r32)) = (bf16_t)(pk_bf16(acc1[e], 0.f) & 0xffffu);
            }
        }
        __syncthreads();
#pragma unroll
        for (int r = 0; r < 4; ++r) { const int idx = tid + 512 * r, row = idx >> 4, ch = idx & 15; *(u32x4*)(LT + (size_t)item * 16384 + row * 128 + ch * 8) = *(const LAS u32x4*)(Lst + row * 272 + ch * 16); }
        __syncthreads();
    }
    if (dbgc) { if (dbg_kt) atomicAdd(dbgc + 0, dbg_kt); if (dbg_acc) atomicAdd(dbgc + 1, dbg_acc); }
}
__device__ __forceinline__ void phase_scan_b(bf16_t* LT, const float* DEC) {
    const int n = 2 * NHEAD * 128 * 32;
    for (int idx = blockIdx.x * 512 + threadIdx.x; idx < n; idx += gridDim.x * 512) {
        const int bh = idx >> 12, vk = idx & 4095, k4 = (vk & 31) * 4;
        float S0 = 0.f, S1 = 0.f, S2 = 0.f, S3 = 0.f;
        bf16_t* p = LT + (size_t)bh * 128 * 16384 + (size_t)vk * 4;
        const float* dp = DEC + (size_t)bh * 128 * 128 + k4;
#pragma unroll 16
        for (int c = 0; c < 128; ++c) {
            const u32x2 w = *(const u32x2*)(p + (size_t)c * 16384);
            const f32x4 d = *(const f32x4*)(dp + c * 128);
            u32x2 o; o.x = pk_bf16(S0, S1); o.y = pk_bf16(S2, S3);
            *(u32x2*)(p + (size_t)c * 16384) = o;
            S0 = d[0] * S0 + bflo(w.x); S1 = d[1] * S1 + bfhi(w.x); S2 = d[2] * S2 + bflo(w.y); S3 = d[3] * S3 + bfhi(w.y);
        }
    }
}
__device__ __forceinline__ void phase_scan_c(LAS unsigned char* lds, const bf16_t* Q1, const bf16_t* FZ, const float* LB, const bf16_t* I1, const bf16_t* G1, const bf16_t* SP, const float* gnorm, bf16_t* OG) {
    const int tid = threadIdx.x, lane = tid & 63, wv = tid >> 6, k = tid & 127, part = tid >> 7, r32 = lane & 31, hh = lane >> 5;
    LAS unsigned char* QTimg = lds; LAS unsigned char* QPimg = lds + 16384; LAS unsigned char* KPimg = lds + 32768; LAS unsigned char* Iimg = lds + 49152; LAS unsigned char* SPimg = lds + 65536;
    LAS float* psum = (LAS float*)(lds + 98304);
    LAS float* ssq = (LAS float*)(lds + 100352);
    LAS unsigned char* OT = lds + 102400;
    bf16_t nfz[16], nq[16]; u32x4 nit_[2], nsp[4], ngt[2];
#define SC_LOAD(item_) { const int bh_ = (item_) >> 7, c_ = (item_) & 127; const size_t t0_ = (size_t)(bh_ >> 4) * SEQ + c_ * 64; const int h_ = bh_ & 15; \
        _Pragma("unroll") for (int i = 0; i < 16; ++i) { const size_t o_ = (t0_ + 16 * part + i) * DM + h_ * 128 + k; nfz[i] = FZ[o_]; nq[i] = Q1[o_]; } \
        _Pragma("unroll") for (int r = 0; r < 2; ++r) { const int idx = tid + 512 * r, row = idx >> 4, ch = idx & 15; nit_[r] = *(const u32x4*)(I1 + (t0_ + row) * DM + h_ * 128 + ch * 8); ngt[r] = *(const u32x4*)(G1 + (t0_ + row) * DM + h_ * 128 + ch * 8); } \
        _Pragma("unroll") for (int r = 0; r < 4; ++r) { const int idx = tid + 512 * r, row = idx >> 4, ch = idx & 15; nsp[r] = *(const u32x4*)(SP + (size_t)(item_) * 16384 + row * 128 + ch * 8); } }
    if ((int)blockIdx.x < 2 * NHEAD * 128) SC_LOAD((int)blockIdx.x)
    for (int item = blockIdx.x; item < 2 * NHEAD * 128; item += gridDim.x) {
        const int bh = item >> 7, c = item & 127, b = bh >> 4, h = bh & 15;
        const size_t tok0 = (size_t)b * SEQ + c * 64;
        float lf[16], qv[16];
        const float lbk = LB[h * 128 + k];
#pragma unroll
        for (int i = 0; i < 16; ++i) { lf[i] = logf_gate(bf2f(nfz[i]), lbk); const float qr = bf2f(nq[i]); qv[i] = qr * sigmoidf_(qr); }
#pragma unroll
        for (int r = 0; r < 2; ++r) { const int idx = tid + 512 * r, row = idx >> 4, ch = idx & 15; *(LAS u32x4*)(Iimg + off_b(row, ch)) = nit_[r]; }
#pragma unroll
        for (int r = 0; r < 4; ++r) { const int idx = tid + 512 * r, row = idx >> 4, ch = idx & 15; *(LAS u32x4*)(SPimg + off_b(row, ch)) = nsp[r]; }
        const u32x4 gcur0 = ngt[0], gcur1 = ngt[1];
        if (item + (int)gridDim.x < 2 * NHEAD * 128) SC_LOAD(item + (int)gridDim.x)
        float cs = 0.f;
#pragma unroll
        for (int i = 0; i < 16; ++i) cs += lf[i];
        psum[part * 128 + k] = cs;
        __syncthreads();
        const float p0 = psum[k], p1 = psum[128 + k], p2 = psum[256 + k];
        const float rr = p0 + p1;
        float bb = part == 0 ? 0.f : (part == 1 ? p0 : (part == 2 ? p0 + p1 : p0 + p1 + p2));
#pragma unroll
        for (int i = 0; i < 16; ++i) {
            bb += lf[i];
            const float qt = qv[i] * __expf(bb), qp = qv[i] * __expf(bb - rr), kp = (1.0f - __expf(lf[i])) * __expf(rr - bb);
            const unsigned o = off_b(16 * part + i, k >> 3) + 2 * (k & 7);
            *(LAS bf16_t*)(QTimg + o) = (bf16_t)(pk_bf16(qt, 0.f) & 0xffffu);
            *(LAS bf16_t*)(QPimg + o) = (bf16_t)(pk_bf16(qp, 0.f) & 0xffffu);
            *(LAS bf16_t*)(KPimg + o) = (bf16_t)(pk_bf16(kp, 0.f) & 0xffffu);
        }
        __syncthreads();
        const int tt = wv & 1, vt = wv >> 1;
        f32x16 O;
#pragma unroll
        for (int e = 0; e < 16; ++e) O[e] = 0.f;
#pragma unroll
        for (int ks = 0; ks < 8; ++ks) {
            const bf16x8 af = *(const LAS bf16x8*)(SPimg + off_b(32 * vt + r32, 2 * ks + hh));
            const bf16x8 bf = *(const LAS bf16x8*)(QTimg + off_b(32 * tt + r32, 2 * ks + hh));
            O = __builtin_amdgcn_mfma_f32_32x32x16_bf16(af, bf, O, 0, 0, 0);
        }
        const unsigned krow = pi32((unsigned)r32);
        for (int st = 0; st <= tt; ++st) {
            f32x16 S;
#pragma unroll
            for (int e = 0; e < 16; ++e) S[e] = 0.f;
#pragma unroll
            for (int ks = 0; ks < 8; ++ks) {
                const bf16x8 af = *(const LAS bf16x8*)(KPimg + off_b(32 * st + krow, 2 * ks + hh));
                const bf16x8 bf = *(const LAS bf16x8*)(QPimg + off_b(32 * tt + r32, 2 * ks + hh));
                S = __builtin_amdgcn_mfma_f32_32x32x16_bf16(af, bf, S, 0, 0, 0);
            }
            float p[16];
#pragma unroll
            for (int e = 0; e < 16; ++e) {
                const unsigned m = (e & 3) + 8 * (e >> 2) + 4 * hh;
                const int sidx = 32 * st + (int)pi32(m), tidx = 32 * tt + r32;
                p[e] = sidx <= tidx ? S[e] : 0.f;
            }
            u32x4 w0, w1;
            w0.x = pk_bf16(p[0], p[1]); w0.y = pk_bf16(p[2], p[3]); w0.z = pk_bf16(p[4], p[5]); w0.w = pk_bf16(p[6], p[7]);
            w1.x = pk_bf16(p[8], p[9]); w1.y = pk_bf16(p[10], p[11]); w1.z = pk_bf16(p[12], p[13]); w1.w = pk_bf16(p[14], p[15]);
            const bf16x8 pf0 = __builtin_bit_cast(bf16x8, w0), pf1 = __builtin_bit_cast(bf16x8, w1);
            const bf16x8 i0 = tr_frag(Iimg, lane, vt, 2 * st), i1 = tr_frag(Iimg, lane, vt, 2 * st + 1);
            O = __builtin_amdgcn_mfma_f32_32x32x16_bf16(i0, pf0, O, 0, 0, 0);
            O = __builtin_amdgcn_mfma_f32_32x32x16_bf16(i1, pf1, O, 0, 0, 0);
        }
        float sq = 0.f;
#pragma unroll
        for (int e = 0; e < 16; ++e) sq += O[e] * O[e];
        sq += __shfl_xor(sq, 32);
        if (hh == 0) ssq[vt * 64 + 32 * tt + r32] = sq;
        __syncthreads();
        const int tl = 32 * tt + r32;
        const float rstd = rsqrtf((ssq[tl] + ssq[64 + tl] + ssq[128 + tl] + ssq[192 + tl]) * (1.0f / 128.0f) + 1e-6f);
#pragma unroll
        for (int g = 0; g < 4; ++g) {
            const int v0 = 32 * vt + 8 * g + 4 * hh;
            const f32x4 gn = *(const f32x4*)(gnorm + v0);
            u32x2 w; w.x = pk_bf16(O[4 * g] * rstd * gn[0], O[4 * g + 1] * rstd * gn[1]); w.y = pk_bf16(O[4 * g + 2] * rstd * gn[2], O[4 * g + 3] * rstd * gn[3]);
            *(LAS u32x2*)(OT + tl * 272 + v0 * 2) = w;
        }
        __syncthreads();
#pragma unroll
        for (int r = 0; r < 2; ++r) {
            const int idx = tid + 512 * r, row = idx >> 4, ch = idx & 15;
            const u32x4 ov = *(const LAS u32x4*)(OT + row * 272 + ch * 16);
            const size_t go = (tok0 + row) * DM + h * 128 + ch * 8;
            const u32x4 gv = r == 0 ? gcur0 : gcur1;
            u32x4 w;
#define SILU_(x_) ((x_) * sigmoidf_(x_))
            w.x = pk_bf16(bflo(ov.x) * SILU_(bflo(gv.x)), bfhi(ov.x) * SILU_(bfhi(gv.x))); w.y = pk_bf16(bflo(ov.y) * SILU_(bflo(gv.y)), bfhi(ov.y) * SILU_(bfhi(gv.y)));
            w.z = pk_bf16(bflo(ov.z) * SILU_(bflo(gv.z)), bfhi(ov.z) * SILU_(bfhi(gv.z))); w.w = pk_bf16(bflo(ov.w) * SILU_(bflo(gv.w)), bfhi(ov.w) * SILU_(bfhi(gv.w)));
#undef SILU_
            *(u32x4*)(OG + go) = w;
        }
        __syncthreads();
    }
}


#if SCAN_DBG == 2
__device__ __forceinline__ void dbg_compare(LAS float* red, const bf16_t* A, const bf16_t* B, float* DBG) {
    float sd = 0.f, sr = 0.f, nn = 0.f;
    const size_t n = (size_t)MTOK * DM;
    for (size_t i = (size_t)blockIdx.x * 512 + threadIdx.x; i < n; i += (size_t)gridDim.x * 512) {
        const float x = bf2f(A[i]), y = bf2f(B[i]);
        if (!(x - x == 0.f)) nn += 1.f; else { sd += (x - y) * (x - y); sr += y * y; }
    }
    sd = wave_sum(sd); sr = wave_sum(sr); nn = wave_sum(nn);
    const int wv = threadIdx.x >> 6;
    if ((threadIdx.x & 63) == 0) { red[wv * 3] = sd; red[wv * 3 + 1] = sr; red[wv * 3 + 2] = nn; }
    __syncthreads();
    if (threadIdx.x == 0) { float a = 0, b = 0, c = 0; for (int w = 0; w < 8; ++w) { a += red[w * 3]; b += red[w * 3 + 1]; c += red[w * 3 + 2]; } DBG[blockIdx.x * 4] = a; DBG[blockIdx.x * 4 + 1] = b; DBG[blockIdx.x * 4 + 2] = c; }
    __syncthreads();
}
__device__ __forceinline__ void dbg_emit(const float* DBG, float* out) {
    float a = 0, b = 0, c = 0;
    for (int w = 0; w < (int)gridDim.x; ++w) { a += DBG[w * 4]; b += DBG[w * 4 + 1]; c += DBG[w * 4 + 2]; }
    const float rel = sqrtf(a / b);
    int k = (int)rintf(-2.0f * log10f(rel)); k = k < 0 ? 0 : (k > 16 ? 16 : k);
    if (c > 0.f) k = 17;
    const float cc = sqrtf(0.5f * (float)k);
    const size_t n = (size_t)MTOK * DM;
    for (size_t i = (size_t)blockIdx.x * 512 + threadIdx.x; i < n; i += (size_t)gridDim.x * 512) out[i] = cc;
}
#endif

#if SCAN_DBG == 3
__device__ __forceinline__ void dbg_count_bf16(const bf16_t* A, size_t n, unsigned* cnt) {
    unsigned c = 0;
    for (size_t i = (size_t)blockIdx.x * 512 + threadIdx.x; i < n; i += (size_t)gridDim.x * 512) { const float x = bf2f(A[i]); if (!(x - x == 0.f)) ++c; }
    if (c) atomicAdd(cnt, c);
}
__device__ __forceinline__ void dbg_count_f32(const float* A, size_t n, unsigned* cnt) {
    unsigned c = 0;
    for (size_t i = (size_t)blockIdx.x * 512 + threadIdx.x; i < n; i += (size_t)gridDim.x * 512) { const float x = A[i]; if (!(x - x == 0.f)) ++c; }
    if (c) atomicAdd(cnt, c);
}
__device__ __forceinline__ void dbg_emit3(const unsigned* cnt, float* out) {
    float code = 0.f;
    for (int st = 3; st >= 0; --st) { const unsigned c = cnt[st]; if (c) { float lg = log10f((float)c); lg = lg > 9.f ? 9.f : lg; code = (float)(st + 1) + 0.1f * lg; } }
    const float cc = sqrtf(code);
    const size_t n = (size_t)MTOK * DM;
    for (size_t i = (size_t)blockIdx.x * 512 + threadIdx.x; i < n; i += (size_t)gridDim.x * 512) out[i] = cc;
}
#endif

#if SCAN_DBG == 4 || SCAN_DBG == 6
__device__ __forceinline__ void dbg_compare4(LAS float* red, const bf16_t* A, const bf16_t* B, const bf16_t* C, float* DBG) {
    float sd = 0.f, sr = 0.f, nn = 0.f, mm = 0.f;
    const size_t n = (size_t)MTOK * DM;
    for (size_t i = (size_t)blockIdx.x * 512 + threadIdx.x; i < n; i += (size_t)gridDim.x * 512) {
        const float x = bf2f(A[i]), y = bf2f(B[i]);
        if (!(x - x == 0.f)) nn += 1.f; else { sd += (x - y) * (x - y); sr += y * y; }
        if (A[i] != C[i]) mm += 1.f;
    }
    sd = wave_sum(sd); sr = wave_sum(sr); nn = wave_sum(nn); mm = wave_sum(mm);
    const int wv = threadIdx.x >> 6;
    if ((threadIdx.x & 63) == 0) { red[wv * 4] = sd; red[wv * 4 + 1] = sr; red[wv * 4 + 2] = nn; red[wv * 4 + 3] = mm; }
    __syncthreads();
    if (threadIdx.x == 0) { float a = 0, b = 0, c = 0, d = 0; for (int w = 0; w < 8; ++w) { a += red[w * 4]; b += red[w * 4 + 1]; c += red[w * 4 + 2]; d += red[w * 4 + 3]; }
        DBG[blockIdx.x * 4] = a; DBG[blockIdx.x * 4 + 1] = b; DBG[blockIdx.x * 4 + 2] = c; DBG[blockIdx.x * 4 + 3] = d; }
    __syncthreads();
}
__device__ __forceinline__ void dbg_emit4(const float* DBG, float* out) {
    float a = 0, b = 0, c = 0, d = 0;
    for (int w = 0; w < (int)gridDim.x; ++w) { a += DBG[w * 4]; b += DBG[w * 4 + 1]; c += DBG[w * 4 + 2]; d += DBG[w * 4 + 3]; }
    const float rel = sqrtf(a / b);
    int k = (int)rintf(-log10f(rel)); k = k < 0 ? 0 : (k > 8 ? 8 : k);
#if SCAN_DBG == 6
    const float cc = sqrtf((float)k + ((d + c) > 0.f ? 0.5f : 0.f));
#else
    int m = (int)ceilf(log10f(1.0f + d + c)); m = m > 9 ? 9 : m;
    const float cc = sqrtf((float)k + 0.1f * (float)m);
#endif
    const size_t n = (size_t)MTOK * DM;
    for (size_t i = (size_t)blockIdx.x * 512 + threadIdx.x; i < n; i += (size_t)gridDim.x * 512) out[i] = cc;
}
#endif

#if SCAN_DBG == 5
__device__ __forceinline__ void dbg_lds16_test(LAS unsigned char* lds, unsigned* cnt) {
    const int tid = threadIdx.x;
    unsigned bad = 0;
    for (int rep = 0; rep < 64; ++rep) {
        for (int i = tid; i < 1024; i += 512) *(LAS u32x4*)(lds + i * 16) = (u32x4){0x7fc07fc0u, 0x7fc07fc0u, 0x7fc07fc0u, 0x7fc07fc0u};
        __syncthreads();
        const int k = tid & 127, part = tid >> 7;
#pragma unroll
        for (int i = 0; i < 16; ++i) {
            const int row = 16 * part + i;
            *(LAS bf16_t*)(lds + off_b(row, k >> 3) + 2 * (k & 7)) = (bf16_t)((row * 128 + k + rep) & 0x7fff);
        }
        __syncthreads();
        for (int idx = tid; idx < 64 * 128; idx += 512) {
            const int row = idx >> 7, kk = idx & 127;
            const bf16_t got = *(const LAS bf16_t*)(lds + off_b(row, kk >> 3) + 2 * (kk & 7));
            if (got != (bf16_t)((row * 128 + kk + rep) & 0x7fff)) ++bad;
        }
        __syncthreads();
    }
    if (bad) atomicAdd(cnt, bad);
}
__device__ __forceinline__ void dbg_emit5(const unsigned* cnt, float* out) {
    const unsigned c = cnt[0];
    float code = 0.f;
    if (c) { float lg = log10f((float)c); code = 1.0f + (lg > 8.9f ? 8.9f : lg); }
    const float cc = sqrtf(code);
    const size_t n = (size_t)MTOK * DM;
    for (size_t i = (size_t)blockIdx.x * 512 + threadIdx.x; i < n; i += (size_t)gridDim.x * 512) out[i] = cc;
}
#endif

#if SCAN_DBG == 6
__device__ __forceinline__ void dbg_check_a(LAS float* red, const float* LF, const bf16_t* I1, const bf16_t* LT, const bf16_t* LT2, float* DBG) {
    float sd = 0.f, sr = 0.f, mm = 0.f;
    const size_t n = (size_t)4096 * 16384;
    for (size_t i = (size_t)blockIdx.x * 512 + threadIdx.x; i < n; i += (size_t)gridDim.x * 512) {
        const int item = (int)(i >> 14), v = (int)((i >> 7) & 127), k = (int)(i & 127);
        const int bh = item >> 7, c = item & 127, b = bh >> 4, h = bh & 15;
        const size_t tok0 = (size_t)b * SEQ + c * 64;
        float g = 1.f, L = 0.f;
        for (int s2 = 63; s2 >= 0; --s2) {
            const size_t o = (tok0 + s2) * DM + h * 128;
            const float f = __expf(LF[o + k]);
            L += bf2f(I1[o + v]) * (1.0f - f) * g;
            g *= f;
        }
        const float x = bf2f(LT[i]);
        sd += (x - L) * (x - L); sr += L * L;
        if (LT[i] != LT2[i]) mm += 1.f;
    }
    sd = wave_sum(sd); sr = wave_sum(sr); mm = wave_sum(mm);
    const int wv = threadIdx.x >> 6;
    if ((threadIdx.x & 63) == 0) { red[wv * 4] = sd; red[wv * 4 + 1] = sr; red[wv * 4 + 2] = 0.f; red[wv * 4 + 3] = mm; }
    __syncthreads();
    if (threadIdx.x == 0) { float a = 0, b2 = 0, d = 0; for (int w = 0; w < 8; ++w) { a += red[w * 4]; b2 += red[w * 4 + 1]; d += red[w * 4 + 3]; }
        DBG[blockIdx.x * 4] = a; DBG[blockIdx.x * 4 + 1] = b2; DBG[blockIdx.x * 4 + 2] = 0.f; DBG[blockIdx.x * 4 + 3] = d; }
    __syncthreads();
}
#endif

#if SCAN_DBG == 7
#ifndef DBG_FAM
#define DBG_FAM 0
#endif
__device__ __forceinline__ void dbg_check_a7(const float* LF, const bf16_t* I1, const bf16_t* LT, float* DBG) {
    const size_t n = (size_t)4096 * 16384;
    float nbad = 0.f, nnf = 0.f;
    for (size_t i = (size_t)blockIdx.x * 512 + threadIdx.x; i < n; i += (size_t)gridDim.x * 512 * 8) {
        const int item = (int)(i >> 14), v = (int)((i >> 7) & 127), k = (int)(i & 127);
        const int bh = item >> 7, c = item & 127, b = bh >> 4, h = bh & 15;
        const size_t tok0 = (size_t)b * SEQ + c * 64;
        float g = 1.f, L = 0.f;
        for (int s2 = 63; s2 >= 0; --s2) {
            const size_t o = (tok0 + s2) * DM + h * 128;
            const float f = __expf(LF[o + k]);
            L += bf2f(I1[o + v]) * (1.0f - f) * g;
            g *= f;
        }
        const float x = bf2f(LT[i]);
        if (!(x - x == 0.f)) { nnf += 1.f; nbad += 1.f; }
        else if (fabsf(x - L) > 0.02f * fabsf(L) + 1e-2f) nbad += 1.f;
    }
    nbad = wave_sum(nbad); nnf = wave_sum(nnf);
    if ((threadIdx.x & 63) == 0) { atomicAdd(DBG, nbad); atomicAdd(DBG + 1, nnf); }
}
__device__ __forceinline__ void dbg_emit7(const float* DBG, float* out) {
    const float nb = DBG[0], nf = DBG[1];
    int A = nb == 0.f ? 0 : (nb <= 100.f ? 1 : (nb <= 1e4f ? 3 : (nb <= 1e6f ? 5 : 7)));
    int B = nf == 0.f ? 0 : 5;
    const float cc = sqrtf((float)A + 0.1f * (float)B);
    const size_t n = (size_t)MTOK * DM;
    for (size_t i = (size_t)blockIdx.x * 512 + threadIdx.x; i < n; i += (size_t)gridDim.x * 512) out[i] = cc;
}
#endif
__device__ __forceinline__ int opaque(int v) { asm volatile("" : "+s"(v)); return v; }
template <bool L1> __device__ __forceinline__ void run_gemm_out(const Args& a, LAS unsigned char* lds) {
    unsigned char* ws = a.ws;
    pg8::Gemm g{(const bf16_t*)(ws + (L1 ? slot(3) : slot(0))), (const bf16_t*)(ws + (L1 ? WS_WO : WS_WOUT)), opaque(MTOK), opaque(DM), opaque(DM)};
    pg8::StaticOrder S; S.init(g.M, g.N, (int)gridDim.x, (int)blockIdx.x);
    EpiF32 E{(float*)(ws + (L1 ? slot(4) : slot(1))), DM};
    pg8::gemm_phase<EpiF32, pg8::StaticOrder>(lds, g, S, E, nullptr);
}
template <bool L1> __device__ __forceinline__ void run_ln(const Args& a) {
    unsigned char* ws = a.ws;
    phase_ln<L1>((const float*)(ws + (L1 ? slot(4) : slot(1))), L1 ? (const void*)(ws + slot(2)) : (const void*)a.in[0], a.in[12] + (L1 ? 2 : 0) * DM, a.in[13] + (L1 ? 2 : 0) * DM,
                 (float*)nullptr, (bf16_t*)(ws + (L1 ? slot(8) : slot(5))), (signed char*)(ws + WS_XQ), (float*)(ws + WS_XS));
}
template <bool L1> __device__ __forceinline__ void run_gemm_sc(const Args& a, LAS unsigned char* lds) {
    unsigned char* ws = a.ws;
    pg8::Gemm g{(const bf16_t*)(ws + WS_WC) + (L1 ? (size_t)DM * DM : 0), (const bf16_t*)(ws + (L1 ? slot(8) : slot(5))), opaque(DM), opaque(MTOK), opaque(DM)};
    pg8::StaticOrder S; S.init(g.M, g.N, (int)gridDim.x, (int)blockIdx.x);
    EpiF32 E{(float*)(ws + (L1 ? slot(0) : slot(6))), MTOK};
    pg8::gemm_phase<EpiF32, pg8::StaticOrder>(lds, g, S, E, nullptr);
}
template <bool L1> __device__ __forceinline__ void run_topk(const Args& a, LAS unsigned char* lds) {
    unsigned char* ws = a.ws;
    phase_topk(lds, (const float*)(ws + (L1 ? slot(0) : slot(6))), (int*)(ws + WS_EID), (float*)(ws + WS_GATE));
}
template <bool L1> __device__ __forceinline__ void run_peer(const Args& a, LAS unsigned char* lds) {
    unsigned char* ws = a.ws;
    LAS int* HL = (LAS int*)(lds + (threadIdx.x >> 6) * 8192);
    float* Y = (float*)(ws + (L1 ? slot(0) : slot(6)));
    phase_peer_u((const signed char*)(ws + WS_XQ), (const int*)(ws + WS_EID), ws + WS_UB + (L1 ? (size_t)16384 * DM : 0), HL);
    asm volatile("s_waitcnt vmcnt(0) lgkmcnt(0)" ::: "memory");
    phase_peer_w(HL, (const float*)(ws + WS_XS), (const int*)(ws + WS_EID), (const float*)(ws + WS_GATE),
                 (const float*)(ws + WS_USC) + (L1 ? 16384 : 0), (const float*)(ws + WS_VSC) + (L1 ? 16384 : 0), (float*)(ws + WS_W), (float*)(ws + WS_CS));
    asm volatile("s_waitcnt vmcnt(0)" ::: "memory");
    phase_peer_v((const bf16_t*)(ws + (L1 ? slot(8) : slot(5))), (const int*)(ws + WS_EID), (const float*)(ws + WS_W), (const float*)(ws + WS_CS),
                 ws + WS_VB + (L1 ? (size_t)16384 * DM : 0), Y);
    asm volatile("s_waitcnt vmcnt(0)" ::: "memory");
    {
        const int lane = threadIdx.x & 63, gw = blockIdx.x * 8 + (threadIdx.x >> 6), nw = gridDim.x * 8, tpw = (MTOK + nw - 1) / nw, tbase = gw * tpw;
        const int tend = tbase + tpw < MTOK ? tbase + tpw : MTOK;
        const float* g = a.in[12] + (L1 ? 3 : 1) * DM; const float* bta = a.in[13] + (L1 ? 3 : 1) * DM;
        float* outf = L1 ? a.out : (float*)nullptr; bf16_t* outb = L1 ? (bf16_t*)nullptr : (bf16_t*)(ws + slot(2));
        for (int row = tbase; row < tend; ++row) {
            float v[32];
            const float* p = Y + (size_t)row * DM;
#pragma unroll
            for (int i = 0; i < 4; ++i) {
                const f32x4 x0 = *(const f32x4*)(p + 512 * i + 8 * lane), x1 = *(const f32x4*)(p + 512 * i + 8 * lane + 4);
#pragma unroll
                for (int j = 0; j < 4; ++j) { v[i * 8 + j] = x0[j]; v[i * 8 + 4 + j] = x1[j]; }
            }
            ln_row_store(v, g, bta, outf ? outf + (size_t)row * DM : nullptr, outb ? outb + (size_t)row * DM : nullptr, lane);
        }
    }
}

__global__ void __launch_bounds__(512, 2) mk_fwd(Args a) {
    extern __shared__ __attribute__((aligned(16))) unsigned char lds_raw[];
    LAS unsigned char* lds = (LAS unsigned char*)lds_raw;
    cg::grid_group grid = cg::this_grid();
    unsigned char* ws = a.ws;
#define PHASE_BEGIN(k) if (a.ph_lo <= (k) && (k) < a.ph_hi && EN(k)) {
#define PHASE_END(k) asm volatile("s_waitcnt vmcnt(0)" ::: "memory"); __syncthreads(); if ((k) + 1 < a.ph_hi) { grid.sync(); if (threadIdx.x < 64) { __builtin_amdgcn_fence(__ATOMIC_ACQUIRE, "agent"); asm volatile("s_waitcnt vmcnt(0)" ::: "memory"); } __syncthreads(); } }
    PHASE_BEGIN(0) phase_prep(a, lds);
#if SCAN_DBG == 3 || SCAN_DBG == 5
        if (blockIdx.x == 0 && threadIdx.x < 8) ((unsigned*)(ws + WS_CTR + 8192))[threadIdx.x] = 0u;
#endif
#if SCAN_DBG == 7
        if (blockIdx.x == 0 && threadIdx.x < 32) ((float*)(ws + WS_CTR + 4096))[threadIdx.x] = 0.f;
#endif
    PHASE_END(0)
#if SCAN_DBG == 5
    PHASE_BEGIN(1) dbg_lds16_test(lds, (unsigned*)(ws + WS_CTR + 8192)); PHASE_END(1)
#define SKIP_REST 1
#endif
    PHASE_BEGIN(1) {
        pg8::Gemm g{(const bf16_t*)(ws + slot(0)), (const bf16_t*)(ws + WS_WIN), opaque(MTOK), opaque(4 * DM), opaque(DM)};
        pg8::StaticOrder S; S.init(g.M, g.N, (int)gridDim.x, (int)blockIdx.x);
        EpiKVQ E{(bf16_t*)(ws + slot(1)), (bf16_t*)(ws + slot(2)), (bf16_t*)(ws + slot(3))};
        pg8::gemm_phase<EpiKVQ, pg8::StaticOrder>(lds, g, S, E, nullptr);
    } PHASE_END(1)
    PHASE_BEGIN(2) phase_scan_a(lds, (const bf16_t*)(ws + slot(2)), (const float*)(ws + WS_LB), (const bf16_t*)(ws + slot(3)), (bf16_t*)(ws + slot(6)), (float*)(ws + WS_DEC)
#if SCAN_DBG == 3
        , (unsigned*)(ws + WS_CTR + 8192)
#endif
        );
#if SCAN_DBG == 7
        asm volatile("s_waitcnt vmcnt(0)" ::: "memory"); __syncthreads(); grid.sync(); if (threadIdx.x < 64) { __builtin_amdgcn_fence(__ATOMIC_ACQUIRE, "agent"); asm volatile("s_waitcnt vmcnt(0)" ::: "memory"); } __syncthreads();
        dbg_check_a7((const float*)(ws + slot(4)), (const bf16_t*)(ws + slot(2)), (const bf16_t*)(ws + slot(6)), (float*)(ws + WS_CTR + 4096));
#endif
#if SCAN_DBG == 6
#define DSYNC6() asm volatile("s_waitcnt vmcnt(0)" ::: "memory"); __syncthreads(); grid.sync(); if (threadIdx.x < 64) { __builtin_amdgcn_fence(__ATOMIC_ACQUIRE, "agent"); asm volatile("s_waitcnt vmcnt(0)" ::: "memory"); } __syncthreads();
        DSYNC6()
        phase_scan_a(lds, (const bf16_t*)(ws + slot(2)), (const float*)(ws + WS_LB), (const bf16_t*)(ws + slot(3)), (bf16_t*)a.out, (float*)(ws + WS_DEC));
        DSYNC6()
        dbg_check_a((LAS float*)lds, (const float*)(ws + slot(4)), (const bf16_t*)(ws + slot(2)), (const bf16_t*)(ws + slot(6)), (const bf16_t*)a.out, (float*)(ws + WS_CTR + 4096));
#endif
#if SCAN_DBG == 3
        asm volatile("s_waitcnt vmcnt(0)" ::: "memory"); __syncthreads(); grid.sync();
        dbg_count_bf16((const bf16_t*)(ws + slot(6)), (size_t)4096 * 16384, (unsigned*)(ws + WS_CTR + 8192) + 2);
#endif
    PHASE_END(2)
    PHASE_BEGIN(3) phase_scan_b((bf16_t*)(ws + slot(6)), (const float*)(ws + WS_DEC));
#if SCAN_DBG == 3
        asm volatile("s_waitcnt vmcnt(0)" ::: "memory"); __syncthreads(); grid.sync();

#endif
    PHASE_END(3)
    PHASE_BEGIN(4) phase_scan_c(lds, (const bf16_t*)(ws + slot(1)), (const bf16_t*)(ws + slot(2)), (const float*)(ws + WS_LB), (const bf16_t*)(ws + slot(3)), (const bf16_t*)(ws + slot(4)), (const bf16_t*)(ws + slot(6)), a.in[2], (bf16_t*)(ws + slot(0)));
#if SCAN_DBG == 1
        asm volatile("s_waitcnt vmcnt(0)" ::: "memory"); __syncthreads(); grid.sync();
        phase_scan_naive((const bf16_t*)(ws + slot(1)), (const float*)(ws + slot(4)), (const bf16_t*)(ws + slot(2)), (float*)(ws + slot(6)));
        asm volatile("s_waitcnt vmcnt(0)" ::: "memory"); __syncthreads(); grid.sync();
        phase_onorm((const float*)(ws + slot(6)), (const bf16_t*)(ws + slot(3)), a.in[2], (bf16_t*)(ws + slot(0)));
#endif
#if SCAN_DBG == 3
        asm volatile("s_waitcnt vmcnt(0)" ::: "memory"); __syncthreads(); grid.sync();

#endif
#if SCAN_DBG == 4
#define DSYNC() asm volatile("s_waitcnt vmcnt(0)" ::: "memory"); __syncthreads(); grid.sync(); if (threadIdx.x < 64) { __builtin_amdgcn_fence(__ATOMIC_ACQUIRE, "agent"); asm volatile("s_waitcnt vmcnt(0)" ::: "memory"); } __syncthreads();
        DSYNC()
        phase_scan_naive((const bf16_t*)(ws + slot(1)), (const float*)(ws + slot(4)), (const bf16_t*)(ws + slot(2)), (float*)(ws + slot(6)));
        DSYNC()
        phase_onorm((const float*)(ws + slot(6)), (const bf16_t*)(ws + slot(3)), a.in[2], (bf16_t*)(ws + slot(8)));
        DSYNC()
        phase_scan_a(lds, (const bf16_t*)(ws + slot(2)), (const float*)(ws + WS_LB), (const bf16_t*)(ws + slot(3)), (bf16_t*)(ws + slot(6)), (float*)(ws + WS_DEC));
        DSYNC()
        phase_scan_b((bf16_t*)(ws + slot(6)), (const float*)(ws + WS_DEC));
        DSYNC()
        phase_scan_c(lds, (const bf16_t*)(ws + slot(1)), (const bf16_t*)(ws + slot(2)), (const float*)(ws + WS_LB), (const bf16_t*)(ws + slot(3)), (const bf16_t*)(ws + slot(4)), (const bf16_t*)(ws + slot(6)), a.in[2], (bf16_t*)a.out);
        DSYNC()
        dbg_compare4((LAS float*)lds, (const bf16_t*)(ws + slot(0)), (const bf16_t*)(ws + slot(8)), (const bf16_t*)a.out, (float*)(ws + WS_CTR + 4096));
#endif
#if SCAN_DBG == 2
        asm volatile("s_waitcnt vmcnt(0)" ::: "memory"); __syncthreads(); grid.sync();
        phase_scan_naive((const bf16_t*)(ws + slot(1)), (const float*)(ws + slot(4)), (const bf16_t*)(ws + slot(2)), (float*)(ws + slot(6)));
        asm volatile("s_waitcnt vmcnt(0)" ::: "memory"); __syncthreads(); grid.sync();
        phase_onorm((const float*)(ws + slot(6)), (const bf16_t*)(ws + slot(3)), a.in[2], (bf16_t*)(ws + slot(8)));
        asm volatile("s_waitcnt vmcnt(0)" ::: "memory"); __syncthreads(); grid.sync();
        dbg_compare((LAS float*)lds, (const bf16_t*)(ws + slot(0)), (const bf16_t*)(ws + slot(8)), (float*)(ws + WS_CTR + 4096));
#endif
    PHASE_END(4)
    PHASE_BEGIN(5) run_gemm_out<false>(a, lds); PHASE_END(5)
    PHASE_BEGIN(6) run_ln<false>(a); PHASE_END(6)
    PHASE_BEGIN(7) run_gemm_sc<false>(a, lds); PHASE_END(7)
    PHASE_BEGIN(8) run_topk<false>(a, lds); PHASE_END(8)
    PHASE_BEGIN(9) run_peer<false>(a, lds); PHASE_END(9)
    PHASE_BEGIN(10) {
        pg8::Gemm g{(const bf16_t*)(ws + slot(2)), (const bf16_t*)(ws + WS_WKVQ), opaque(MTOK), opaque(3 * DM), opaque(DM)};
        pg8::StaticOrder S; S.init(g.M, g.N, (int)gridDim.x, (int)blockIdx.x);
        EpiKVQ E{(bf16_t*)(ws + slot(3)), (bf16_t*)(ws + slot(4)), (bf16_t*)(ws + slot(5))};
        pg8::gemm_phase<EpiKVQ, pg8::StaticOrder>(lds, g, S, E, nullptr);
    } PHASE_END(10)
    PHASE_BEGIN(11) phase_rot((LAS float*)lds, (bf16_t*)(ws + slot(3)), (bf16_t*)(ws + slot(5)), (const float*)(ws + WS_COS), (const float*)(ws + WS_SIN), (float*)(ws + WS_KMEAN), (float*)(ws + WS_KNMAX)); PHASE_END(11)
    PHASE_BEGIN(12) phase_sel(lds, (const bf16_t*)(ws + slot(5)), (const float*)(ws + WS_KMEAN), (unsigned short*)(ws + WS_SUB), (int*)(ws + WS_CNT), (int*)(ws + WS_CTR)); PHASE_END(12)
    PHASE_BEGIN(13) phase_att(lds, (const bf16_t*)(ws + slot(5)), (const bf16_t*)(ws + slot(3)), (const bf16_t*)(ws + slot(4)), (const float*)(ws + WS_KNMAX), (const unsigned short*)(ws + WS_SUB),
                              (const int*)(ws + WS_CNT), (int*)(ws + WS_CTR), (bf16_t*)(ws + slot(6)), (bf16_t*)(ws + slot(0)), (float*)(ws + WS_LS)); PHASE_END(13)
    PHASE_BEGIN(14) phase_comb((const bf16_t*)(ws + slot(6)), (const bf16_t*)(ws + slot(0)), (const float*)(ws + WS_LS), (bf16_t*)(ws + slot(3))); PHASE_END(14)
    PHASE_BEGIN(15) run_gemm_out<true>(a, lds); PHASE_END(15)
    PHASE_BEGIN(16) run_ln<true>(a); PHASE_END(16)
    PHASE_BEGIN(17) run_gemm_sc<true>(a, lds); PHASE_END(17)
    PHASE_BEGIN(18) run_topk<true>(a, lds); PHASE_END(18)
#if SCAN_DBG == 7
    PHASE_BEGIN(19) dbg_emit7((const float*)(ws + WS_CTR + 4096), a.out); PHASE_END(19)
#elif SCAN_DBG == 6
    PHASE_BEGIN(19) dbg_emit4((const float*)(ws + WS_CTR + 4096), a.out); PHASE_END(19)
#elif SCAN_DBG == 5
    PHASE_BEGIN(19) dbg_emit5((const unsigned*)(ws + WS_CTR + 8192), a.out); PHASE_END(19)
#elif SCAN_DBG == 4
    PHASE_BEGIN(19) dbg_emit4((const float*)(ws + WS_CTR + 4096), a.out); PHASE_END(19)
#elif SCAN_DBG == 3
    PHASE_BEGIN(19) dbg_emit3((const unsigned*)(ws + WS_CTR + 8192), a.out); PHASE_END(19)
#elif SCAN_DBG == 2
    PHASE_BEGIN(19) dbg_emit((const float*)(ws + WS_CTR + 4096), a.out); PHASE_END(19)
#else
    PHASE_BEGIN(19) run_peer<true>(a, lds); PHASE_END(19)
#endif
}

extern "C" void kernel_launch(void* const* d_in, const int* in_sizes, int n_in, void* d_out, int out_size, void* d_ws, size_t ws_size, hipStream_t stream) {
    static int grid = 0;
    if (grid == 0) {
        if (n_in != 14 || out_size != MTOK * DM || ws_size < WS_END) { fprintf(stderr, "kernel_launch: unexpected shapes (n_in %d, out %d, ws %zu)\n", n_in, out_size, ws_size); grid = -1; return; }
        int dev = 0, cus = 0, per_cu = 0;
        if (hipGetDevice(&dev) != hipSuccess || hipDeviceGetAttribute(&cus, hipDeviceAttributeMultiprocessorCount, dev) != hipSuccess) { grid = -1; return; }
        if (hipFuncSetAttribute((const void*)mk_fwd, hipFuncAttributeMaxDynamicSharedMemorySize, LDS_BYTES) != hipSuccess) { fprintf(stderr, "kernel_launch: hipFuncSetAttribute failed\n"); grid = -1; return; }
        if (hipOccupancyMaxActiveBlocksPerMultiprocessor(&per_cu, (const void*)mk_fwd, 512, LDS_BYTES) != hipSuccess || per_cu < 1) { fprintf(stderr, "kernel_launch: occupancy query failed (%d)\n", per_cu); (void)hipGetLastError(); per_cu = 1; }
        grid = cus * (per_cu > 1 ? 1 : per_cu);
    }
    if (grid < 0) return;
    Args a{};
    for (int i = 0; i < 14; ++i) a.in[i] = (const float*)d_in[i];
    a.out = (float*)d_out; a.ws = (unsigned char*)d_ws;
#if ONE_LAUNCH
    a.ph_lo = 0; a.ph_hi = NPH;
    void* args[] = {&a};
    hipError_t e = hipLaunchCooperativeKernel((const void*)mk_fwd, dim3(grid), dim3(512), args, LDS_BYTES, stream);
    if (e != hipSuccess) fprintf(stderr, "cooperative launch failed: %s (grid %d)\n", hipGetErrorString(e), grid);
#else
    for (int ph = 0; ph < NPH; ++ph) {
        a.ph_lo = ph; a.ph_hi = ph + 1;
        hipLaunchKernelGGL(mk_fwd, dim3(grid), dim3(512), LDS_BYTES, stream, a);
    }
#endif
}
```

```cpp
#define ONE_LAUNCH 1
#include <hip/hip_runtime.h>
#include <hip/hip_cooperative_groups.h>
#include <cstdio>
namespace cg = cooperative_groups;

#ifndef ONE_LAUNCH
#define ONE_LAUNCH 0
#endif
#ifndef SCAN_DBG
#define SCAN_DBG 0
#endif
#ifndef SCAN_A_VALU
#define SCAN_A_VALU 0
#endif
#ifndef ENMASK
#define ENMASK 0xffffffffu
#endif
#define EN(k) ((ENMASK >> (k)) & 1u)

namespace pg8 {
#define PG8_LAS __attribute__((address_space(3)))
typedef unsigned short bf16_t;
typedef short bf16x8 __attribute__((ext_vector_type(8)));
typedef float f32x4 __attribute__((ext_vector_type(4)));
typedef unsigned u32x4 __attribute__((ext_vector_type(4)));
constexpr int BM = 256, BK = 64, HALF = 128, HTB = HALF * BK * 2  , STAGE_BYTES = 8 * HTB, NXCD = 8, WGM = 8;

__host__ __device__ __forceinline__ int lds_byte(int r, int c) { const int st = (r >> 4) * 2 + (c >> 5), rr = r & 15, cc = c & 31, ob = rr * 64 + cc * 2; return st * 1024 + (ob ^ (((ob >> 9) & 1) << 5)); }
__host__ __device__ __forceinline__ void stage_rc(int b, int& R, int& C) { const int st = b / 1024, sb = b % 1024, swz = sb ^ (((sb >> 9) & 1) << 5); R = (st >> 1) * 16 + swz / 64; C = (st & 1) * 32 + (swz % 64) / 2; }
__host__ __device__ __forceinline__ int perm32(int rho) { const int n = rho >> 4, i = rho & 15; return 8 * (i >> 2) + 4 * n + (i & 3); }

struct Unit { int pm, pn; };
struct Gemm { const bf16_t* A; const bf16_t* Bt; int M, N, K; };

struct StaticOrder {
    int nM, nN, nwg, G, c;
    __host__ __device__ void init(int M, int N, int G_, int c_) { nM = M / BM; nN = N / BM; nwg = nM * nN; G = G_; c = c_; }
    __host__ __device__ bool next(int i, Unit& u) const {
        const long L = (long)i * G + c; if (L >= nwg) return false;
        int wgid = (int)L; { const int q = nwg / NXCD, r = nwg % NXCD, xcd = wgid % NXCD, off = wgid / NXCD; wgid = (xcd < r ? xcd * (q + 1) : r * (q + 1) + (xcd - r) * q) + off; }
        const int nig = WGM * nN, gid = wgid / nig, fm = gid * WGM, gsz = (nM - fm) < WGM ? (nM - fm) : WGM;
        u.pm = fm + ((wgid % nig) % gsz); u.pn = (wgid % nig) / gsz; return true;
    }
    __device__ __forceinline__ void a_ready(const Unit&) const {}
    __device__ __forceinline__ void done(const Unit&) const {}
};
struct CountedOrder : StaticOrder {
    const unsigned* ready; unsigned need; unsigned* tmo;
    __device__ __forceinline__ void a_ready(const Unit& u) const {
        if (threadIdx.x < 64) {
            const unsigned long long t0 = __builtin_amdgcn_s_memrealtime(); unsigned polls = 0;
            while ((unsigned)__builtin_amdgcn_readfirstlane(__hip_atomic_load(ready + 64 * u.pm, __ATOMIC_RELAXED, __HIP_MEMORY_SCOPE_AGENT)) < need) {
                if ((++polls & 255u) == 0u && __builtin_amdgcn_readfirstlane(__hip_atomic_load(tmo, __ATOMIC_RELAXED, __HIP_MEMORY_SCOPE_AGENT)) != 0u) break;
                if (__builtin_amdgcn_s_memrealtime() - t0 > 2000000ull) {
                    if (threadIdx.x == 0) { unsigned expect = 0u; __hip_atomic_compare_exchange_strong(tmo + 1, &expect, 0x600u | (unsigned)(u.pm & 0xff), __ATOMIC_RELAXED, __ATOMIC_RELAXED, __HIP_MEMORY_SCOPE_AGENT); __hip_atomic_store(tmo, 1u, __ATOMIC_RELAXED, __HIP_MEMORY_SCOPE_AGENT); }
                    break; }
                __builtin_amdgcn_s_sleep(2); }
            __builtin_amdgcn_fence(__ATOMIC_ACQUIRE, "agent");
            asm volatile("s_waitcnt vmcnt(0)" ::: "memory");
        }
#if !defined(BROKEN_HOOK_NO_BARRIER)
        asm volatile("" ::: "memory"); __builtin_amdgcn_s_barrier(); asm volatile("" ::: "memory");
#endif
    }
};

__device__ __forceinline__ unsigned cvt_pk_bf16(float lo, float hi) { unsigned r; asm volatile("v_cvt_pk_bf16_f32 %0, %1, %2" : "=v"(r) : "v"(lo), "v"(hi)); return r; }
typedef float f32x2 __attribute__((ext_vector_type(2)));
__device__ __forceinline__ f32x2 gelu_pk(f32x2 v) {
    const f32x2 av = __builtin_elementwise_abs(v), d = av * 0.2316418882f + 1.0f;
    f32x2 t; t.x = __builtin_amdgcn_rcpf(d.x); t.y = __builtin_amdgcn_rcpf(d.y);
    f32x2 q = t * 0.5307027145f + (-0.7265760135f); q = q * t + 0.7107068705f; q = q * t + (-0.142248368f); q = q * t + 0.127414796f; q = q * t;
    const f32x2 s = (v * v) * (-0.72134752044f);
    f32x2 e; e.x = __builtin_amdgcn_exp2f(s.x); e.y = __builtin_amdgcn_exp2f(s.y);
    const f32x2 m = v * (q * e), r = v - m;
    f32x2 o; o.x = v.x < 0.f ? m.x : r.x; o.y = v.y < 0.f ? m.y : r.y; return o;
}

struct EpiF32 {
    static constexpr bool PERM = false, AFTER_DRAIN = false;
    float* C; int ldc; const float* bias;
    __device__ __forceinline__ void operator()(const f32x4 (&acc)[2][2][4][2], const Unit& u, int wr, int wc, int fr, int fq) const {
        const int row0 = u.pm * BM + wr * 64 + fr, col0 = u.pn * BM + wc * 32 + 4 * fq;
        f32x4 bv[2][2];
#pragma unroll
        for (int bj = 0; bj < 2; ++bj)
#pragma unroll
            for (int n = 0; n < 2; ++n) bv[bj][n] = bias ? *(const f32x4*)(bias + col0 + bj * HALF + n * 16) : (f32x4){0.f, 0.f, 0.f, 0.f};
#pragma unroll
        for (int ai = 0; ai < 2; ++ai)
#pragma unroll
            for (int m = 0; m < 4; ++m) { float* rowp = C + (size_t)(row0 + ai * HALF + m * 16) * ldc + col0;
#pragma unroll
                for (int bj = 0; bj < 2; ++bj)
#pragma unroll
                    for (int n = 0; n < 2; ++n) *(f32x4*)(rowp + bj * HALF + n * 16) = acc[ai][bj][m][n] + bv[bj][n]; }
    }
};
template <int ACT  > struct EpiBf16 {
    static constexpr bool PERM = true, AFTER_DRAIN = false;
    bf16_t* O; int ldc; const float* bias; int split_cols; size_t split_stride;
    __device__ __forceinline__ void operator()(const f32x4 (&acc)[2][2][4][2], const Unit& u, int wr, int wc, int fr, int fq) const {
        const int row0 = u.pm * BM + wr * 64 + fr; int colt = u.pn * BM; bf16_t* base = O;
        if (split_cols) { const int t = colt / split_cols; base += (size_t)t * split_stride; colt -= t * split_cols; }
        const int col0 = colt + wc * 32 + 8 * fq, bcol0 = u.pn * BM + wc * 32 + 8 * fq;
        f32x4 bv[2][2];
#pragma unroll
        for (int bj = 0; bj < 2; ++bj)
#pragma unroll
            for (int n = 0; n < 2; ++n) bv[bj][n] = bias ? *(const f32x4*)(bias + bcol0 + bj * HALF + 4 * n) : (f32x4){0.f, 0.f, 0.f, 0.f};
#pragma unroll
        for (int ai = 0; ai < 2; ++ai)
#pragma unroll
            for (int m = 0; m < 4; ++m) { bf16_t* rowp = base + (size_t)(row0 + ai * HALF + m * 16) * ldc + col0;
#pragma unroll
                for (int bj = 0; bj < 2; ++bj) { f32x4 v0 = acc[ai][bj][m][0] + bv[bj][0], v1 = acc[ai][bj][m][1] + bv[bj][1];
                    if (ACT == 1) { f32x2 a = gelu_pk((f32x2){v0[0], v0[1]}), b = gelu_pk((f32x2){v0[2], v0[3]}), c = gelu_pk((f32x2){v1[0], v1[1]}), d = gelu_pk((f32x2){v1[2], v1[3]});
                        v0 = (f32x4){a.x, a.y, b.x, b.y}; v1 = (f32x4){c.x, c.y, d.x, d.y}; }
                    if (ACT == 2) {
#pragma unroll
                        for (int j = 0; j < 4; ++j) { v0[j] = 0.5f * v0[j] * (1.0f + erff(v0[j] * 0.70710678f)); v1[j] = 0.5f * v1[j] * (1.0f + erff(v1[j] * 0.70710678f)); } }
                    u32x4 w; w.x = cvt_pk_bf16(v0[0], v0[1]); w.y = cvt_pk_bf16(v0[2], v0[3]); w.z = cvt_pk_bf16(v1[0], v1[1]); w.w = cvt_pk_bf16(v1[2], v1[3]);
                    *(u32x4*)(rowp + bj * HALF) = w; } }
    }
};

template <class Epi, class Sched, bool STAMP = false>
__device__ __forceinline__ void gemm_phase(PG8_LAS unsigned char* lds, const Gemm g, const Sched& S, const Epi& E, unsigned long long* stamps) {
    const int tid = threadIdx.x, wid = __builtin_amdgcn_readfirstlane(tid >> 6), lane = tid & 63, wr = wid >> 2, wc = wid & 3, fr = lane & 15, fq = lane >> 4;
    const int K = g.K, nt = K / BK;
    int ts_lo = 0, ts_hi = 0, nts = 0; const unsigned long long rt_entry = STAMP ? (unsigned long long)wall_clock64() : 0ull;
#define PG8_STAMP() do { if (STAMP && wid == 0 && nts < 64) { const unsigned long long _c = (unsigned long long)clock64(); \
        ts_lo = (lane == nts) ? (int)(unsigned)_c : ts_lo; ts_hi = (lane == nts) ? (int)(unsigned)(_c >> 32) : ts_hi; ++nts; } } while (0)
    PG8_STAMP();
    unsigned voffA[2], voffB[2];
#pragma unroll
    for (int i = 0; i < 2; ++i) { int R, C; stage_rc(tid * 16 + i * 8192, R, C); const int Rb = Epi::PERM ? ((R & ~31) + perm32(R & 31)) : R;
        voffA[i] = (unsigned)(R * K + C) * 2u; voffB[i] = (unsigned)(Rb * K + C) * 2u; }
    const size_t kstep = (size_t)(BK * 2);
    const size_t hstep = (size_t)HALF * K * 2;
    const size_t tstep = 2 * hstep;
    const unsigned ldsw = (unsigned)wid * 1024u;
    const int aoff = lds_byte(wr * 64 + fr, fq * 8), boff = lds_byte(wc * 32 + fr, fq * 8);
#define PG8_SA(b, h) (((b) * 2 + (h)) * HTB)
#define PG8_SB(b, h) ((4 + (b) * 2 + (h)) * HTB)
#define PG8_STAGE(bufoff, gbase, voff) do { _Pragma("unroll") for (int _i = 0; _i < 2; ++_i) \
        __builtin_amdgcn_global_load_lds((const unsigned*)((const char*)(gbase) + (voff)[_i]), (PG8_LAS unsigned*)(lds + (bufoff) + ldsw + _i * 8192), 16, 0, 0); } while (0)
#define PG8_LDA(dst, b, h) do { _Pragma("unroll") for (int m = 0; m < 4; ++m) _Pragma("unroll") for (int k = 0; k < 2; ++k) dst[m][k] = *(const PG8_LAS bf16x8*)(lds + PG8_SA(b, h) + aoff + m * 2048 + k * 1024); } while (0)
#define PG8_LDB(dst, b, h) do { _Pragma("unroll") for (int n = 0; n < 2; ++n) _Pragma("unroll") for (int k = 0; k < 2; ++k) dst[n][k] = *(const PG8_LAS bf16x8*)(lds + PG8_SB(b, h) + boff + n * 2048 + k * 1024); } while (0)
#define PG8_MMA(ai, bj, At, Bt) do { __builtin_amdgcn_s_setprio(1); _Pragma("unroll") for (int m = 0; m < 4; ++m) _Pragma("unroll") for (int n = 0; n < 2; ++n) _Pragma("unroll") for (int k = 0; k < 2; ++k) \
        acc[ai][bj][m][n] = __builtin_amdgcn_mfma_f32_16x16x32_bf16(Bt[n][k], At[m][k], acc[ai][bj][m][n], 0, 0, 0); __builtin_amdgcn_s_setprio(0); } while (0)
#define PG8_WAIT_V(n) asm volatile("s_waitcnt vmcnt(" #n ")" ::: "memory")
#define PG8_WAIT_L(n) asm volatile("s_waitcnt lgkmcnt(" #n ")" ::: "memory")
#define PG8_BAR __builtin_amdgcn_s_barrier()
#define PG8_SCHED __builtin_amdgcn_sched_barrier(0)
    Unit cur, nxt; int ui = 0;
    if (!S.next(0, cur)) return;
    f32x4 acc[2][2][4][2];
#pragma unroll
    for (int a = 0; a < 2; ++a)
#pragma unroll
        for (int b = 0; b < 2; ++b)
#pragma unroll
            for (int m = 0; m < 4; ++m)
#pragma unroll
                for (int n = 0; n < 2; ++n) acc[a][b][m][n] = (f32x4){0.f, 0.f, 0.f, 0.f};
    bf16x8 At[4][2], B0[2][2], B1[2][2];
    const char* cA = (const char*)g.A + (size_t)cur.pm * tstep; const char* cB = (const char*)g.Bt + (size_t)cur.pn * tstep;
    S.a_ready(cur);
    PG8_STAGE(PG8_SB(0, 0), cB, voffB); PG8_STAGE(PG8_SA(0, 0), cA, voffA); PG8_STAGE(PG8_SB(0, 1), cB + hstep, voffB); PG8_STAGE(PG8_SA(0, 1), cA + hstep, voffA);
    if (wr == 1) PG8_BAR;
    PG8_WAIT_V(4); PG8_BAR;
    PG8_STAGE(PG8_SB(1, 0), cB + kstep, voffB); PG8_STAGE(PG8_SA(1, 0), cA + kstep, voffA); PG8_STAGE(PG8_SB(1, 1), cB + hstep + kstep, voffB);
    PG8_WAIT_V(6); PG8_BAR;
    PG8_STAMP();
    for (;;) {
        const bool has_next = S.next(ui + 1, nxt);
        const char* nA = has_next ? (const char*)g.A + (size_t)nxt.pm * tstep : cA; const char* nB = has_next ? (const char*)g.Bt + (size_t)nxt.pn * tstep : cB;
        for (int t = 0; t < nt; t += 2) {
            const bool last = (t == nt - 2);
            const char* a1 = cA + (size_t)(t + 1) * kstep;
            const char* a2 = last ? nA : cA + (size_t)(t + 2) * kstep; const char* b2 = last ? nB : cB + (size_t)(t + 2) * kstep;
            const char* a3 = a2 + kstep; const char* b3 = b2 + kstep;
            if (last && has_next) S.a_ready(nxt);
            PG8_LDB(B0, 0, 0); PG8_SCHED; PG8_LDA(At, 0, 0); PG8_STAGE(PG8_SA(1, 1), a1 + hstep, voffA);
            PG8_WAIT_L(8); PG8_BAR; PG8_WAIT_L(0); PG8_MMA(0, 0, At, B0); PG8_BAR; PG8_SCHED;
            PG8_LDB(B1, 0, 1); PG8_STAGE(PG8_SB(0, 0), b2, voffB);
            PG8_BAR; PG8_WAIT_L(0); PG8_MMA(0, 1, At, B1); PG8_BAR;
            PG8_LDA(At, 0, 1); PG8_STAGE(PG8_SA(0, 0), a2, voffA);
            PG8_BAR; PG8_WAIT_L(0); PG8_MMA(1, 0, At, B0); PG8_BAR; PG8_SCHED;
            PG8_STAGE(PG8_SB(0, 1), b2 + hstep, voffB);
            PG8_WAIT_V(6); PG8_BAR; PG8_MMA(1, 1, At, B1); PG8_BAR;
            PG8_LDB(B0, 1, 0); PG8_SCHED; PG8_LDA(At, 1, 0); PG8_STAGE(PG8_SA(0, 1), a2 + hstep, voffA);
            PG8_WAIT_L(8); PG8_BAR; PG8_WAIT_L(0); PG8_MMA(0, 0, At, B0); PG8_BAR; PG8_SCHED;
            PG8_LDB(B1, 1, 1); PG8_STAGE(PG8_SB(1, 0), b3, voffB);
            PG8_BAR; PG8_WAIT_L(0); PG8_MMA(0, 1, At, B1); PG8_BAR;
            PG8_LDA(At, 1, 1); PG8_STAGE(PG8_SA(1, 0), a3, voffA);
            PG8_BAR; PG8_WAIT_L(0); PG8_MMA(1, 0, At, B0); PG8_BAR; PG8_SCHED;
            PG8_STAGE(PG8_SB(1, 1), b3 + hstep, voffB);
            PG8_WAIT_V(6); PG8_BAR; PG8_MMA(1, 1, At, B1); PG8_BAR;
        }
        PG8_STAMP();
        if constexpr (!Epi::AFTER_DRAIN) { E(acc, cur, wr, wc, fr, fq); S.done(cur); }
        PG8_STAMP();
        if (!has_next) break;
#pragma unroll
        for (int a = 0; a < 2; ++a)
#pragma unroll
            for (int b = 0; b < 2; ++b)
#pragma unroll
                for (int m = 0; m < 4; ++m)
#pragma unroll
                    for (int n = 0; n < 2; ++n) acc[a][b][m][n] = (f32x4){0.f, 0.f, 0.f, 0.f};
        cur = nxt; cA = nA; cB = nB; ++ui;
    }
    PG8_WAIT_V(0);
    if (wr == 0) PG8_BAR;
    PG8_BAR;
    if constexpr (Epi::AFTER_DRAIN) { E.fused(acc, cur, wr, wc, fr, fq, lds, wid, lane); S.done(cur); }
    PG8_STAMP();
    if (STAMP && wid == 0) { stamps[lane] = lane < nts ? (((unsigned long long)(unsigned)ts_hi << 32) | (unsigned)ts_lo) : 0ull;
        if (lane == 62) stamps[62] = rt_entry; if (lane == 63) stamps[63] = (unsigned long long)wall_clock64(); }
#undef PG8_STAMP
#undef PG8_SA
#undef PG8_SB
#undef PG8_STAGE
#undef PG8_LDA
#undef PG8_LDB
#undef PG8_MMA
#undef PG8_WAIT_V
#undef PG8_WAIT_L
#undef PG8_BAR
#undef PG8_SCHED
}
}


#define LAS __attribute__((address_space(3)))
typedef unsigned short bf16_t;
typedef float f32x4 __attribute__((ext_vector_type(4)));
typedef unsigned u32x4 __attribute__((ext_vector_type(4)));
typedef unsigned u32x2 __attribute__((ext_vector_type(2)));
typedef short bf16x8 __attribute__((ext_vector_type(8)));
typedef short s16x4 __attribute__((ext_vector_type(4)));
typedef float f32x16 __attribute__((ext_vector_type(16)));

constexpr int MTOK = 16384, DM = 2048, SEQ = 8192, NHEAD = 16;
constexpr float ALPHA = 1.41421356237309515f;
constexpr size_t MiB = (size_t)1 << 20;
constexpr size_t WS_WIN = 0, WS_WOUT = 32 * MiB, WS_WKVQ = 40 * MiB, WS_WO = 64 * MiB, WS_WC = 72 * MiB, WS_UB = 88 * MiB, WS_VB = 152 * MiB, WS_USC = 216 * MiB, WS_VSC = 217 * MiB, WS_H = 224 * MiB, WS_XQ = 232 * MiB, WS_XS = 264 * MiB, WS_W = 272 * MiB, WS_CS = 280 * MiB, WS_SLOT = 344 * MiB;
constexpr size_t WS_EID = 920 * MiB, WS_GATE = 928 * MiB, WS_COS = 936 * MiB, WS_SIN = 938 * MiB, WS_KMEAN = 940 * MiB, WS_LB = 941 * MiB, WS_LS = 942 * MiB, WS_SUB = 946 * MiB, WS_CNT = 962 * MiB, WS_CTR = 963 * MiB, WS_DEC = 964 * MiB, WS_END = 966 * MiB;
constexpr size_t WS_BAR = WS_CTR + 65536;
constexpr size_t WS_KNMAX = WS_KMEAN + 768 * 1024;
__host__ __device__ constexpr size_t slot(int i) { return WS_SLOT + (size_t)i * 64 * MiB; }
constexpr int LDS_BYTES = 144 * 1024;
constexpr int NPH = 20;

struct Args { const float* in[14]; float* out; unsigned char* ws; int ph_lo, ph_hi; };

__device__ __forceinline__ float bflo(unsigned w) { return __uint_as_float(w << 16); }
__device__ __forceinline__ float bfhi(unsigned w) { return __uint_as_float(w & 0xffff0000u); }
__device__ __forceinline__ float bf2f(bf16_t b) { return __uint_as_float(((unsigned)b) << 16); }
typedef __bf16 bf16x2_t __attribute__((ext_vector_type(2)));
typedef float f32x2_t __attribute__((ext_vector_type(2)));
__device__ __forceinline__ unsigned pk_bf16(float lo, float hi) { const f32x2_t f = {lo, hi}; return __builtin_bit_cast(unsigned, __builtin_convertvector(f, bf16x2_t)); }
__device__ __forceinline__ float wave_sum(float v) {
#pragma unroll
    for (int o = 32; o >= 1; o >>= 1) v += __shfl_xor(v, o);
    return v;
}
__device__ __forceinline__ float wave_max(float v) {
#pragma unroll
    for (int o = 32; o >= 1; o >>= 1) v = fmaxf(v, __shfl_xor(v, o));
    return v;
}
__device__ __forceinline__ float sigmoidf_(float z) { return 1.0f / (1.0f + __expf(-z)); }


__device__ __forceinline__ void store_wt16(void* p, u32x4 v) {
    __hip_atomic_store((unsigned long long*)p, ((unsigned long long)v.y << 32) | v.x, __ATOMIC_RELAXED, __HIP_MEMORY_SCOPE_AGENT);
    __hip_atomic_store((unsigned long long*)p + 1, ((unsigned long long)v.w << 32) | v.z, __ATOMIC_RELAXED, __HIP_MEMORY_SCOPE_AGENT);
}
__device__ __forceinline__ void store_wt8(void* p, u32x2 v) {
    __hip_atomic_store((unsigned long long*)p, ((unsigned long long)v.y << 32) | v.x, __ATOMIC_RELAXED, __HIP_MEMORY_SCOPE_AGENT);
}
struct EpiIn {
    static constexpr bool PERM = true, AFTER_DRAIN = false;
    bf16_t* Q1; float* LF; bf16_t* I1; bf16_t* G1; const float* LB;
    __device__ __forceinline__ void operator()(const pg8::f32x4 (&acc)[2][2][4][2], const pg8::Unit& u, int wr, int wc, int fr, int fq) const {
        const int type = u.pn >> 3;
        const int row0 = u.pm * 256 + wr * 64 + fr, col0 = (u.pn & 7) * 256 + wc * 32 + 8 * fq;
        if (type == 1) {
#pragma unroll
            for (int bj = 0; bj < 2; ++bj) {
                const int c = col0 + bj * 128;
                const f32x4 lb0 = *(const f32x4*)(LB + c), lb1 = *(const f32x4*)(LB + c + 4);
#pragma unroll
                for (int ai = 0; ai < 2; ++ai)
#pragma unroll
                    for (int m = 0; m < 4; ++m) {
                        float* p = LF + (size_t)(row0 + ai * 128 + m * 16) * DM + c;
                        f32x4 o0, o1;
#pragma unroll
                        for (int j = 0; j < 4; ++j) {
                            o0[j] = __logf(lb0[j] + (1.0f - lb0[j]) * sigmoidf_(acc[ai][bj][m][0][j]));
                            o1[j] = __logf(lb1[j] + (1.0f - lb1[j]) * sigmoidf_(acc[ai][bj][m][1][j]));
                        }
                        *(f32x4*)p = o0; *(f32x4*)(p + 4) = o1;
                    }
            }
        } else {
            bf16_t* dst = Q1 + (size_t)(type - (type > 0 ? 1 : 0)) * ((size_t)32 << 20);
            const bool act = (type != 2);
#pragma unroll
            for (int ai = 0; ai < 2; ++ai)
#pragma unroll
                for (int m = 0; m < 4; ++m)
#pragma unroll
                    for (int bj = 0; bj < 2; ++bj) {
                        f32x4 v0 = acc[ai][bj][m][0], v1 = acc[ai][bj][m][1];
                        if (act) {
#pragma unroll
                            for (int j = 0; j < 4; ++j) { v0[j] = v0[j] * sigmoidf_(v0[j]); v1[j] = v1[j] * sigmoidf_(v1[j]); }
                        }
                        u32x4 w; w.x = pk_bf16(v0[0], v0[1]); w.y = pk_bf16(v0[2], v0[3]); w.z = pk_bf16(v1[0], v1[1]); w.w = pk_bf16(v1[2], v1[3]);
                        *(u32x4*)(dst + (size_t)(row0 + ai * 128 + m * 16) * DM + col0 + bj * 128) = w;
                    }
        }
    }
};
struct EpiRes {
    static constexpr bool PERM = false, AFTER_DRAIN = false;
    const float* res; float* Y;
    __device__ __forceinline__ void operator()(const pg8::f32x4 (&acc)[2][2][4][2], const pg8::Unit& u, int wr, int wc, int fr, int fq) const {
        const int row0 = u.pm * 256 + wr * 64 + fr, col0 = u.pn * 256 + wc * 32 + 4 * fq;
#pragma unroll
        for (int ai = 0; ai < 2; ++ai)
#pragma unroll
            for (int m = 0; m < 4; ++m) {
                const size_t off = (size_t)(row0 + ai * 128 + m * 16) * DM + col0;
#pragma unroll
                for (int bj = 0; bj < 2; ++bj)
#pragma unroll
                    for (int n = 0; n < 2; ++n) {
                        const f32x4 r = *(const f32x4*)(res + off + bj * 128 + n * 16);
                        *(f32x4*)(Y + off + bj * 128 + n * 16) = r * ALPHA + acc[ai][bj][m][n];
                    }
            }
    }
};
struct EpiF32 {
    static constexpr bool PERM = false, AFTER_DRAIN = false;
    float* C; int ldc;
    __device__ __forceinline__ void operator()(const pg8::f32x4 (&acc)[2][2][4][2], const pg8::Unit& u, int wr, int wc, int fr, int fq) const {
        const int row0 = u.pm * 256 + wr * 64 + fr, col0 = u.pn * 256 + wc * 32 + 4 * fq;
#pragma unroll
        for (int ai = 0; ai < 2; ++ai)
#pragma unroll
            for (int m = 0; m < 4; ++m) {
                float* p = C + (size_t)(row0 + ai * 128 + m * 16) * ldc + col0;
#pragma unroll
                for (int bj = 0; bj < 2; ++bj)
#pragma unroll
                    for (int n = 0; n < 2; ++n) *(f32x4*)(p + bj * 128 + n * 16) = acc[ai][bj][m][n];
            }
    }
};
struct EpiKVQ {
    static constexpr bool PERM = true, AFTER_DRAIN = false;
    bf16_t* K; bf16_t* V; bf16_t* Q;
    __device__ __forceinline__ void operator()(const pg8::f32x4 (&acc)[2][2][4][2], const pg8::Unit& u, int wr, int wc, int fr, int fq) const {
        const int t = u.pn >> 3;
        bf16_t* dst = K + (size_t)t * ((size_t)32 << 20);
        const int row0 = u.pm * 256 + wr * 64 + fr, col0 = (u.pn & 7) * 256 + wc * 32 + 8 * fq;
#pragma unroll
        for (int ai = 0; ai < 2; ++ai)
#pragma unroll
            for (int m = 0; m < 4; ++m)
#pragma unroll
                for (int bj = 0; bj < 2; ++bj) {
                    const f32x4 v0 = acc[ai][bj][m][0], v1 = acc[ai][bj][m][1];
                    u32x4 w; w.x = pk_bf16(v0[0], v0[1]); w.y = pk_bf16(v0[2], v0[3]); w.z = pk_bf16(v1[0], v1[1]); w.w = pk_bf16(v1[2], v1[3]);
                    *(u32x4*)(dst + (size_t)(row0 + ai * 128 + m * 16) * DM + col0 + bj * 128) = w;
                }
    }
};


struct EpiKVQR {
    static constexpr bool PERM = true, AFTER_DRAIN = false;
    bf16_t* K; const float* COS; const float* SIN;
    __device__ __forceinline__ void operator()(const pg8::f32x4 (&acc)[2][2][4][2], const pg8::Unit& u, int wr, int wc, int fr, int fq) const {
        const int t = u.pn >> 3;
        bf16_t* dst = K + (size_t)t * ((size_t)32 << 20);
        const int row0 = u.pm * 256 + wr * 64 + fr;
        if (t == 1) {
            const int col0 = (u.pn & 7) * 256 + wc * 32 + 8 * fq;
#pragma unroll
            for (int ai = 0; ai < 2; ++ai)
#pragma unroll
                for (int m = 0; m < 4; ++m)
#pragma unroll
                    for (int bj = 0; bj < 2; ++bj) {
                        const f32x4 v0 = acc[ai][bj][m][0], v1 = acc[ai][bj][m][1];
                        u32x4 w; w.x = pk_bf16(v0[0], v0[1]); w.y = pk_bf16(v0[2], v0[3]); w.z = pk_bf16(v1[0], v1[1]); w.w = pk_bf16(v1[2], v1[3]);
                        *(u32x4*)(dst + (size_t)(row0 + ai * 128 + m * 16) * DM + col0 + bj * 128) = w;
                    }
        } else {
            const int g = 4 * wc + fq;
#pragma unroll
            for (int ai = 0; ai < 2; ++ai)
#pragma unroll
                for (int m = 0; m < 4; ++m) {
                    const int row = row0 + ai * 128 + m * 16, pos = row & (SEQ - 1);
                    const f32x4 c = *(const f32x4*)(COS + pos * 64 + 4 * g), sn = *(const f32x4*)(SIN + pos * 64 + 4 * g);
#pragma unroll
                    for (int bj = 0; bj < 2; ++bj) {
                        const f32x4 a = acc[ai][bj][m][0], b = acc[ai][bj][m][1];
                        bf16_t* p = dst + (size_t)row * DM + ((u.pn & 7) * 2 + bj) * 128 + 4 * g;
                        u32x2 w1, w2;
                        w1.x = pk_bf16(a[0] * c[0] - b[0] * sn[0], a[1] * c[1] - b[1] * sn[1]); w1.y = pk_bf16(a[2] * c[2] - b[2] * sn[2], a[3] * c[3] - b[3] * sn[3]);
                        w2.x = pk_bf16(a[0] * sn[0] + b[0] * c[0], a[1] * sn[1] + b[1] * c[1]); w2.y = pk_bf16(a[2] * sn[2] + b[2] * c[2], a[3] * sn[3] + b[3] * c[3]);
                        *(u32x2*)p = w1; *(u32x2*)(p + 64) = w2;
                    }
                }
        }
    }
};

__host__ __device__ __forceinline__ int rot_pos(int d) { return d < 64 ? 8 * (d >> 2) + (d & 3) : 8 * ((d - 64) >> 2) + 4 + (d & 3); }
__device__ __forceinline__ void transpose_tiles(LAS float* tile, const float* src, int ldn, int K, int N, bf16_t* dst, int nperm = 0) {
    const int tid = threadIdx.x;
    const int tn = N / 64, ntiles = tn * (K / 64);
    for (int tI = blockIdx.x; tI < ntiles; tI += gridDim.x) {
        const int k0 = (tI / tn) * 64, n0 = (tI % tn) * 64;
#pragma unroll
        for (int r = 0; r < 2; ++r) {
            const int kk = (tid >> 4) + 32 * r, nn = (tid & 15) * 4;
            const f32x4 v = *(const f32x4*)(src + (size_t)(k0 + kk) * ldn + n0 + nn);
            tile[kk * 65 + nn + 0] = v[0]; tile[kk * 65 + nn + 1] = v[1]; tile[kk * 65 + nn + 2] = v[2]; tile[kk * 65 + nn + 3] = v[3];
        }
        __syncthreads();
        {
            const int nn = tid >> 3, kk8 = (tid & 7) * 8;
            float f[8];
#pragma unroll
            for (int j = 0; j < 8; ++j) f[j] = tile[(kk8 + j) * 65 + nn];
            u32x4 w; w.x = pk_bf16(f[0], f[1]); w.y = pk_bf16(f[2], f[3]); w.z = pk_bf16(f[4], f[5]); w.w = pk_bf16(f[6], f[7]);
            const int nsrc = n0 + nn, nrow = nsrc < nperm ? (nsrc & ~127) + rot_pos(nsrc & 127) : nsrc;
            *(u32x4*)(dst + (size_t)nrow * K + k0 + kk8) = w;
        }
        __syncthreads();
    }
}
__device__ __forceinline__ void convert_bf16(const float* src, bf16_t* dst, size_t n) {
    const size_t stride = (size_t)gridDim.x * 512 * 8;
    for (size_t i = ((size_t)blockIdx.x * 512 + threadIdx.x) * 8; i < n; i += stride) {
        const f32x4 a = *(const f32x4*)(src + i), b = *(const f32x4*)(src + i + 4);
        u32x4 w; w.x = pk_bf16(a[0], a[1]); w.y = pk_bf16(a[2], a[3]); w.z = pk_bf16(b[0], b[1]); w.w = pk_bf16(b[2], b[3]);
        *(u32x4*)(dst + i) = w;
    }
}
__device__ __forceinline__ void fold_peer_keys(LAS float* lds, const float* w_query, const float* sub_keys, bf16_t* WcT) {
    const int tid = threadIdx.x;
    LAS float* Ss = lds;
    LAS float* Ws = lds + 128 * 132;
    for (int item = blockIdx.x; item < 1024; item += gridDim.x) {
        const int l = item >> 9, rem = item & 511, hh = rem >> 5, kb = rem & 31, h = hh >> 1, half = hh & 1;
        const float* sk = sub_keys + (size_t)(((l * 2 + half) * 8 + h) * 128) * 128;
        const float* wq = w_query + (size_t)l * DM * DM + (size_t)(kb * 64) * DM + h * 256 + half * 128;
#pragma unroll
        for (int r = 0; r < 8; ++r) { const int idx = tid + 512 * r, key = idx >> 5, d4 = (idx & 31) * 4; *(LAS f32x4*)(Ss + key * 132 + d4) = *(const f32x4*)(sk + key * 128 + d4); }
#pragma unroll
        for (int r = 0; r < 4; ++r) { const int idx = tid + 512 * r, kin = idx >> 5, d4 = (idx & 31) * 4; *(LAS f32x4*)(Ws + kin * 128 + d4) = *(const f32x4*)(wq + (size_t)kin * DM + d4); }
        __syncthreads();
        const int key = tid & 127, kq = tid >> 7;
        float acc[16];
#pragma unroll
        for (int j = 0; j < 16; ++j) acc[j] = 0.f;
        for (int d4 = 0; d4 < 32; ++d4) {
            const f32x4 s4 = *(const LAS f32x4*)(Ss + key * 132 + d4 * 4);
#pragma unroll
            for (int j = 0; j < 16; ++j) { const f32x4 w4 = *(const LAS f32x4*)(Ws + (kq * 16 + j) * 128 + d4 * 4); acc[j] += s4[0] * w4[0] + s4[1] * w4[1] + s4[2] * w4[2] + s4[3] * w4[3]; }
        }
        bf16_t* o = WcT + (size_t)l * DM * DM + (size_t)(h * 256 + half * 128 + key) * DM + kb * 64 + kq * 16;
        u32x4 w0, w1;
        w0.x = pk_bf16(acc[0], acc[1]); w0.y = pk_bf16(acc[2], acc[3]); w0.z = pk_bf16(acc[4], acc[5]); w0.w = pk_bf16(acc[6], acc[7]);
        w1.x = pk_bf16(acc[8], acc[9]); w1.y = pk_bf16(acc[10], acc[11]); w1.z = pk_bf16(acc[12], acc[13]); w1.w = pk_bf16(acc[14], acc[15]);
        *(u32x4*)o = w0; *(u32x4*)(o + 8) = w1;
        __syncthreads();
    }
}

__device__ __forceinline__ void quant_rows(const float* src, unsigned char* dst, float* scl, int nrows) {
    const int lane = threadIdx.x & 63, gw = blockIdx.x * 8 + (threadIdx.x >> 6), nw = gridDim.x * 8;
    for (int row = gw; row < nrows; row += nw) {
        const float* p = src + (size_t)row * DM;
        f32x4 v[8];
#pragma unroll
        for (int i = 0; i < 2; ++i)
#pragma unroll
            for (int q = 0; q < 4; ++q) v[i * 4 + q] = *(const f32x4*)(p + 1024 * i + 16 * lane + 4 * q);
        float am = 0.f;
#pragma unroll
        for (int i = 0; i < 8; ++i) am = fmaxf(am, fmaxf(fmaxf(fabsf(v[i][0]), fabsf(v[i][1])), fmaxf(fabsf(v[i][2]), fabsf(v[i][3]))));
        am = fmaxf(wave_max(am), 1e-30f);
        const float inv = 127.0f / am;
        if (lane == 0) scl[row] = am * (1.0f / 127.0f);
#pragma unroll
        for (int i = 0; i < 2; ++i) {
            u32x4 w;
#pragma unroll
            for (int q = 0; q < 4; ++q) {
                const f32x4 t = v[i * 4 + q];
                const unsigned b0 = (unsigned)(int)(rintf(t[0] * inv) + 128.0f), b1 = (unsigned)(int)(rintf(t[1] * inv) + 128.0f), b2 = (unsigned)(int)(rintf(t[2] * inv) + 128.0f), b3 = (unsigned)(int)(rintf(t[3] * inv) + 128.0f);
                w[q] = b0 | (b1 << 8) | (b2 << 16) | (b3 << 24);
            }
            *(u32x4*)(dst + (size_t)row * DM + 1024 * i + 16 * lane) = w;
        }
    }
}
__device__ __forceinline__ void phase_prep(const Args& a, LAS unsigned char* lds) {
    unsigned char* ws = a.ws;
    LAS float* tile = (LAS float*)lds;
    transpose_tiles(tile, a.in[1], 4 * DM, DM, 4 * DM, (bf16_t*)(ws + WS_WIN));
    transpose_tiles(tile, a.in[3], DM, DM, DM, (bf16_t*)(ws + WS_WOUT));
    transpose_tiles(tile, a.in[5], 2 * DM, DM, 2 * DM, (bf16_t*)(ws + WS_WKVQ), DM);
    transpose_tiles(tile, a.in[6], DM, DM, DM, (bf16_t*)(ws + WS_WKVQ) + (size_t)2 * DM * DM, DM);
    transpose_tiles(tile, a.in[7], DM, DM, DM, (bf16_t*)(ws + WS_WO));
    fold_peer_keys((LAS float*)lds, a.in[8], a.in[9], (bf16_t*)(ws + WS_WC));
    convert_bf16(a.in[0], (bf16_t*)(ws + slot(0)), (size_t)MTOK * DM);
    quant_rows(a.in[10], ws + WS_UB, (float*)(ws + WS_USC), 2 * 16384);
    quant_rows(a.in[11], ws + WS_VB, (float*)(ws + WS_VSC), 2 * 16384);
    const int gtid = blockIdx.x * 512 + threadIdx.x, gthreads = gridDim.x * 512;
    float* COS = (float*)(ws + WS_COS); float* SIN = (float*)(ws + WS_SIN); float* LB = (float*)(ws + WS_LB);
    for (int i = gtid; i < SEQ * 64; i += gthreads) {
        const int pos = i >> 6, j = i & 63;
        double inv = 1.0; const double r = 0.86596432336006535;
        for (int q = 0; q < j; ++q) inv *= r;
        const float ang = (float)pos * (float)inv;
        const double x = (double)ang;
        const double n = __builtin_rint(x * 0.15915494309189535);
        const float rf = (float)__builtin_fma(-n, 6.283185307179586, x);
        COS[i] = cosf(rf); SIN[i] = sinf(rf);
    }
    for (int c = gtid; c < DM; c += gthreads) { const float l0 = a.in[4][c], l1 = a.in[4][DM + c]; LB[c] = 1.0f / (1.0f + expf(l1 - l0)); }
}

__device__ __forceinline__ void phase_scan_naive(const bf16_t* Q1, const float* LF, const bf16_t* I1, float* O) {
    const int lane = threadIdx.x & 63, gw = blockIdx.x * 8 + (threadIdx.x >> 6), nw = gridDim.x * 8;
    for (int item = gw; item < 2 * NHEAD * 128; item += nw) {
        const int bh = item >> 7, v = item & 127, b = bh >> 4, h = bh & 15;
        const size_t base = (size_t)b * SEQ * DM + h * 128;
        float S0 = 0.f, S1 = 0.f;
#pragma unroll 4
        for (int t = 0; t < SEQ; ++t) {
            const size_t ro = base + (size_t)t * DM;
            const float f0 = __expf(LF[ro + lane]), f1 = __expf(LF[ro + 64 + lane]);
            const float q0 = bf2f(Q1[ro + lane]), q1 = bf2f(Q1[ro + 64 + lane]);
            const float iv = bf2f(I1[ro + v]);
            S0 = f0 * S0 + (1.0f - f0) * iv; S1 = f1 * S1 + (1.0f - f1) * iv;
            const float p = wave_sum(q0 * S0 + q1 * S1);
            if (lane == 0) O[ro + v] = p;
        }
    }
}
__device__ __forceinline__ void phase_onorm(const float* O, const bf16_t* G1, const float* gnorm, bf16_t* OG) {
    const int lane = threadIdx.x & 63, gw = blockIdx.x * 8 + (threadIdx.x >> 6), nw = gridDim.x * 8;
    const float gn0 = gnorm[2 * lane], gn1 = gnorm[2 * lane + 1];
    for (int item = gw; item < MTOK * NHEAD; item += nw) {
        const size_t off = (size_t)item * 128 + 2 * lane;
        const float o0 = O[off], o1 = O[off + 1];
        const float ss = wave_sum(o0 * o0 + o1 * o1);
        const float r = rsqrtf(ss * (1.0f / 128.0f) + 1e-6f);
        const unsigned g = *(const unsigned*)(G1 + off);
        *(unsigned*)(OG + off) = pk_bf16(o0 * r * gn0 * bflo(g), o1 * r * gn1 * bfhi(g));
    }
}

__device__ __forceinline__ void ln_row_store(float (&v)[32], const float* g, const float* bta, float* outf, bf16_t* outb, int lane, signed char* outq = nullptr, float* outs = nullptr) {
    float s = 0.f;
#pragma unroll
    for (int i = 0; i < 32; ++i) s += v[i];
    const float mu = wave_sum(s) * (1.0f / DM);
    float q = 0.f;
#pragma unroll
    for (int i = 0; i < 32; ++i) { v[i] -= mu; q += v[i] * v[i]; }
    const float rstd = rsqrtf(wave_sum(q) * (1.0f / DM) + 1e-5f);
    float am = 0.f;
#pragma unroll
    for (int i = 0; i < 4; ++i) {
        const int c = 512 * i + 8 * lane;
        const f32x4 g0 = *(const f32x4*)(g + c), g1 = *(const f32x4*)(g + c + 4), b0 = *(const f32x4*)(bta + c), b1 = *(const f32x4*)(bta + c + 4);
        f32x4 o0, o1;
#pragma unroll
        for (int j = 0; j < 4; ++j) { o0[j] = v[i * 8 + j] * rstd * g0[j] + b0[j]; o1[j] = v[i * 8 + 4 + j] * rstd * g1[j] + b1[j]; v[i * 8 + j] = o0[j]; v[i * 8 + 4 + j] = o1[j]; am = fmaxf(am, fmaxf(fabsf(o0[j]), fabsf(o1[j]))); }
        if (outf) { *(f32x4*)(outf + c) = o0; *(f32x4*)(outf + c + 4) = o1; }
        if (outb) { u32x4 w; w.x = pk_bf16(o0[0], o0[1]); w.y = pk_bf16(o0[2], o0[3]); w.z = pk_bf16(o1[0], o1[1]); w.w = pk_bf16(o1[2], o1[3]); *(u32x4*)(outb + c) = w; }
    }
    if (outq) {
        am = fmaxf(wave_max(am), 1e-30f);
        const float inv = 127.0f / am;
        if (lane == 0) *outs = am * (1.0f / 127.0f);
#pragma unroll
        for (int i = 0; i < 4; ++i) {
            u32x2 w;
            w.x = ((unsigned)(int)rintf(v[i * 8 + 0] * inv) & 0xffu) | (((unsigned)(int)rintf(v[i * 8 + 1] * inv) & 0xffu) << 8) | (((unsigned)(int)rintf(v[i * 8 + 2] * inv) & 0xffu) << 16) | (((unsigned)(int)rintf(v[i * 8 + 3] * inv) & 0xffu) << 24);
            w.y = ((unsigned)(int)rintf(v[i * 8 + 4] * inv) & 0xffu) | (((unsigned)(int)rintf(v[i * 8 + 5] * inv) & 0xffu) << 8) | (((unsigned)(int)rintf(v[i * 8 + 6] * inv) & 0xffu) << 16) | (((unsigned)(int)rintf(v[i * 8 + 7] * inv) & 0xffu) << 24);
            *(u32x2*)(outq + 512 * i + 8 * lane) = w;
        }
    }
}
__device__ __forceinline__ void ln_row_store16(float (&v)[32], const float* g, const float* bta, float* outf, bf16_t* outb, int lane) {
    float s = 0.f;
#pragma unroll
    for (int i = 0; i < 32; ++i) s += v[i];
    const float mu = wave_sum(s) * (1.0f / DM);
    float q = 0.f;
#pragma unroll
    for (int i = 0; i < 32; ++i) { v[i] -= mu; q += v[i] * v[i]; }
    const float rstd = rsqrtf(wave_sum(q) * (1.0f / DM) + 1e-5f);
#pragma unroll
    for (int i = 0; i < 2; ++i) {
        const int c = 1024 * i + 16 * lane;
        f32x4 o[4];
#pragma unroll
        for (int qd = 0; qd < 4; ++qd) {
            const f32x4 gg = *(const f32x4*)(g + c + 4 * qd), bb = *(const f32x4*)(bta + c + 4 * qd);
#pragma unroll
            for (int j = 0; j < 4; ++j) o[qd][j] = v[16 * i + 4 * qd + j] * rstd * gg[j] + bb[j];
            *(f32x4*)(outf + c + 4 * qd) = o[qd];
        }
        if (outb) {
            u32x4 w0, w1;
            w0.x = pk_bf16(o[0][0], o[0][1]); w0.y = pk_bf16(o[0][2], o[0][3]); w0.z = pk_bf16(o[1][0], o[1][1]); w0.w = pk_bf16(o[1][2], o[1][3]);
            w1.x = pk_bf16(o[2][0], o[2][1]); w1.y = pk_bf16(o[2][2], o[2][3]); w1.z = pk_bf16(o[3][0], o[3][1]); w1.w = pk_bf16(o[3][2], o[3][3]);
            *(u32x4*)(outb + c) = w0; *(u32x4*)(outb + c + 8) = w1;
        }
    }
}
template <bool RES16> __device__ __forceinline__ void phase_ln(const float* Y, const void* RESv, const float* g, const float* bta, float* outf, bf16_t* outb, signed char* outq = nullptr, float* outs = nullptr) {
    const int lane = threadIdx.x & 63, gw = blockIdx.x * 8 + (threadIdx.x >> 6), nw = gridDim.x * 8;
    for (int row = gw; row < MTOK; row += nw) {
        float v[32];
        const float* p = Y + (size_t)row * DM;
#pragma unroll
        for (int i = 0; i < 4; ++i) {
            const f32x4 a = *(const f32x4*)(p + 512 * i + 8 * lane), b = *(const f32x4*)(p + 512 * i + 8 * lane + 4);
            f32x4 ra, rb;
            if (RES16) { const u32x4 w = *(const u32x4*)((const bf16_t*)RESv + (size_t)row * DM + 512 * i + 8 * lane); ra = (f32x4){bflo(w.x), bfhi(w.x), bflo(w.y), bfhi(w.y)}; rb = (f32x4){bflo(w.z), bfhi(w.z), bflo(w.w), bfhi(w.w)}; }
            else { const float* rp = (const float*)RESv + (size_t)row * DM; ra = *(const f32x4*)(rp + 512 * i + 8 * lane); rb = *(const f32x4*)(rp + 512 * i + 8 * lane + 4); }
#pragma unroll
            for (int j = 0; j < 4; ++j) { v[i * 8 + j] = a[j] + ALPHA * ra[j]; v[i * 8 + 4 + j] = b[j] + ALPHA * rb[j]; }
        }
        ln_row_store(v, g, bta, outf ? outf + (size_t)row * DM : nullptr, outb ? outb + (size_t)row * DM : nullptr, lane, outq ? outq + (size_t)row * DM : nullptr, outs ? outs + row : nullptr);
    }
}

__device__ __forceinline__ void wave_argmax(float& v, int& idx) {
#pragma unroll
    for (int o = 32; o >= 1; o >>= 1) {
        const float ov = __shfl_xor(v, o); const int oi = __shfl_xor(idx, o);
        if (ov > v || (ov == v && oi < idx)) { v = ov; idx = oi; }
    }
}
__device__ __forceinline__ unsigned fkey(float x) { const unsigned u = __float_as_uint(x); return u ^ (unsigned)(((int)u >> 31) | 0x80000000); }
__device__ __forceinline__ float funkey(unsigned k) { const unsigned u = (k & 0x80000000u) ? (k ^ 0x80000000u) : ~k; return __uint_as_float(u); }
__device__ __forceinline__ void sort16_insert(unsigned (&r)[16], unsigned v) {
#pragma unroll
    for (int i = 0; i < 16; ++i) { const unsigned m = r[i] > v ? r[i] : v; v = r[i] > v ? v : r[i]; r[i] = m; }
}
__device__ __forceinline__ void phase_topk(LAS unsigned char* lds, const float* SCT, int* EID, float* GATE) {
    LAS unsigned char* ib = lds + threadIdx.x * 32;
    for (int item = blockIdx.x * 512 + threadIdx.x; item < MTOK * 8; item += gridDim.x * 512) {
        const int h = item >> 14, tok = item & (MTOK - 1);
        const float* p = SCT + (size_t)(h * 256) * MTOK + tok;
        unsigned r1[16], r2[16];
#pragma unroll
        for (int i = 0; i < 16; ++i) { r1[i] = 0u; r2[i] = 0u; }
#pragma unroll 8
        for (int e = 0; e < 128; ++e) {
            const float x1 = p[(size_t)e * MTOK], x2 = p[(size_t)(128 + e) * MTOK];
            sort16_insert(r1, (fkey(x1) & ~0x7Fu) | (unsigned)e);
            sort16_insert(r2, (fkey(x2) & ~0x7Fu) | (unsigned)e);
        }
        float v1[16], v2[16];
#pragma unroll
        for (int i = 0; i < 16; ++i) { v1[i] = funkey(r1[i] & ~0x7Fu); v2[i] = funkey(r2[i] & ~0x7Fu); ib[i] = (unsigned char)(r1[i] & 0x7Fu); ib[16 + i] = (unsigned char)(r2[i] & 0x7Fu); }
        unsigned r3[16];
#pragma unroll
        for (int i = 0; i < 16; ++i) r3[i] = 0u;
#pragma unroll
        for (int a = 0; a < 16; ++a)
#pragma unroll
            for (int bq = 0; bq < 16; ++bq)
                if ((a + 1) * (bq + 1) <= 16) sort16_insert(r3, (fkey(v1[a] + v2[bq]) & ~0xFFu) | (unsigned)(a * 16 + bq));
        const float mx = funkey(r3[0] & ~0xFFu);
        float ev[16]; float sum = 0.f;
#pragma unroll
        for (int i = 0; i < 16; ++i) { ev[i] = __expf(funkey(r3[i] & ~0xFFu) - mx); sum += ev[i]; }
        const float rs = 1.0f / sum;
        int eid[16];
#pragma unroll
        for (int i = 0; i < 16; ++i) { const unsigned f = r3[i] & 0xFFu; eid[i] = (int)ib[f >> 4] * 128 + (int)ib[16 + (f & 15u)]; }
        int* eo = EID + (size_t)tok * 128 + h * 16; float* go = GATE + (size_t)tok * 128 + h * 16;
#pragma unroll
        for (int q = 0; q < 4; ++q) {
            *(u32x4*)(eo + 4 * q) = (u32x4){(unsigned)eid[4 * q], (unsigned)eid[4 * q + 1], (unsigned)eid[4 * q + 2], (unsigned)eid[4 * q + 3]};
            *(f32x4*)(go + 4 * q) = (f32x4){ev[4 * q] * rs, ev[4 * q + 1] * rs, ev[4 * q + 2] * rs, ev[4 * q + 3] * rs};
        }
    }
}

__device__ __forceinline__ float gelu_erf(float x) { return 0.5f * x * (1.0f + erff(x * 0.70710678118654752f)); }
__device__ __forceinline__ float ub0(unsigned w) { return (float)(w & 0xffu); }
__device__ __forceinline__ float ub1(unsigned w) { return (float)((w >> 8) & 0xffu); }
__device__ __forceinline__ float ub2(unsigned w) { return (float)((w >> 16) & 0xffu); }
__device__ __forceinline__ float ub3(unsigned w) { return (float)(w >> 24); }
__device__ __forceinline__ void phase_peer(LAS unsigned char* lds, const float* X, const int* EID, const float* GATE, const unsigned char* U, const unsigned char* V, const float* USC, const float* VSC,
                                           const float* g, const float* bta, float* outf, bf16_t* outb) {
    const int lane = threadIdx.x & 63, wv = threadIdx.x >> 6, gw = blockIdx.x * 8 + wv, nw = gridDim.x * 8;
    LAS float* hb = (LAS float*)(lds + wv * 512);
    for (int tok = gw; tok < MTOK; tok += nw) {
        float x[32];
        const float* xp = X + (size_t)tok * DM;
#pragma unroll
        for (int i = 0; i < 2; ++i)
#pragma unroll
            for (int q = 0; q < 4; ++q) { const f32x4 t = *(const f32x4*)(xp + 1024 * i + 16 * lane + 4 * q); x[16 * i + 4 * q] = t[0]; x[16 * i + 4 * q + 1] = t[1]; x[16 * i + 4 * q + 2] = t[2]; x[16 * i + 4 * q + 3] = t[3]; }
        float sx = 0.f;
#pragma unroll
        for (int j = 0; j < 32; ++j) sx += x[j];
        const float d0 = -128.0f * sx;
        const int e0 = EID[(size_t)tok * 128 + lane], e1 = EID[(size_t)tok * 128 + 64 + lane];
        const float g0 = GATE[(size_t)tok * 128 + lane], g1 = GATE[(size_t)tok * 128 + 64 + lane];
        for (int bt = 0; bt < 16; ++bt) {
            float d[8];
#pragma unroll
            for (int r = 0; r < 8; ++r) {
                const int e = bt * 8 + r;
                const int idx = __builtin_amdgcn_readfirstlane(__shfl(bt < 8 ? e0 : e1, e & 63));
                const u32x4* up = (const u32x4*)(U + (size_t)idx * DM) + lane;
                float acc = d0;
#pragma unroll
                for (int i = 0; i < 2; ++i) {
                    const u32x4 w = up[i * 64];
                    acc += x[16 * i + 0] * ub0(w.x) + x[16 * i + 1] * ub1(w.x) + x[16 * i + 2] * ub2(w.x) + x[16 * i + 3] * ub3(w.x)
                         + x[16 * i + 4] * ub0(w.y) + x[16 * i + 5] * ub1(w.y) + x[16 * i + 6] * ub2(w.y) + x[16 * i + 7] * ub3(w.y)
                         + x[16 * i + 8] * ub0(w.z) + x[16 * i + 9] * ub1(w.z) + x[16 * i + 10] * ub2(w.z) + x[16 * i + 11] * ub3(w.z)
                         + x[16 * i + 12] * ub0(w.w) + x[16 * i + 13] * ub1(w.w) + x[16 * i + 14] * ub2(w.w) + x[16 * i + 15] * ub3(w.w);
                }
                d[r] = acc;
            }
            const bool b5 = lane & 32, b4 = lane & 16, b3 = lane & 8;
            float t4[4];
#pragma unroll
            for (int q = 0; q < 4; ++q) { const float keep = b5 ? d[4 + q] : d[q], send = b5 ? d[q] : d[4 + q]; t4[q] = keep + __shfl_xor(send, 32); }
            float t2[2];
#pragma unroll
            for (int q = 0; q < 2; ++q) { const float keep = b4 ? t4[2 + q] : t4[q], send = b4 ? t4[q] : t4[2 + q]; t2[q] = keep + __shfl_xor(send, 16); }
            float t1;
            { const float keep = b3 ? t2[1] : t2[0], send = b3 ? t2[0] : t2[1]; t1 = keep + __shfl_xor(send, 8); }
            t1 += __shfl_xor(t1, 4); t1 += __shfl_xor(t1, 2); t1 += __shfl_xor(t1, 1);
            if ((lane & 7) == 0) hb[bt * 8 + (lane >> 3 & 1) + 2 * (lane >> 4 & 1) + 4 * (lane >> 5 & 1)] = t1;
        }
        asm volatile("s_waitcnt lgkmcnt(0)" ::: "memory");
        const float h0 = hb[lane] * USC[e0], h1 = hb[64 + lane] * USC[e1];
        const float w0 = g0 * gelu_erf(h0) * VSC[e0], w1 = g1 * gelu_erf(h1) * VSC[e1];
        float wsum = wave_sum(w0 + w1);
        float y[32];
#pragma unroll
        for (int i = 0; i < 32; ++i) y[i] = 0.f;
#pragma unroll 8
        for (int e = 0; e < 128; ++e) {
            const int idx = __builtin_amdgcn_readfirstlane(__shfl(e < 64 ? e0 : e1, e & 63));
            const float wt = __shfl(e < 64 ? w0 : w1, e & 63);
            const u32x4* vp = (const u32x4*)(V + (size_t)idx * DM) + lane;
#pragma unroll
            for (int i = 0; i < 2; ++i) {
                const u32x4 w = vp[i * 64];
                y[16 * i + 0] += wt * ub0(w.x); y[16 * i + 1] += wt * ub1(w.x); y[16 * i + 2] += wt * ub2(w.x); y[16 * i + 3] += wt * ub3(w.x);
                y[16 * i + 4] += wt * ub0(w.y); y[16 * i + 5] += wt * ub1(w.y); y[16 * i + 6] += wt * ub2(w.y); y[16 * i + 7] += wt * ub3(w.y);
                y[16 * i + 8] += wt * ub0(w.z); y[16 * i + 9] += wt * ub1(w.z); y[16 * i + 10] += wt * ub2(w.z); y[16 * i + 11] += wt * ub3(w.z);
                y[16 * i + 12] += wt * ub0(w.w); y[16 * i + 13] += wt * ub1(w.w); y[16 * i + 14] += wt * ub2(w.w); y[16 * i + 15] += wt * ub3(w.w);
            }
        }
        const float corr = -128.0f * wsum;
#pragma unroll
        for (int i = 0; i < 32; ++i) y[i] = y[i] + corr + ALPHA * x[i];
        ln_row_store16(y, g, bta, outf + (size_t)tok * DM, outb ? outb + (size_t)tok * DM : nullptr, lane);
        asm volatile("s_waitcnt lgkmcnt(0)" ::: "memory");
    }
}

__device__ __forceinline__ int row_dot_i8(const u32x4 (&xq)[2], const unsigned char* rowp, int lane) {
    const u32x4* up = (const u32x4*)rowp + lane;
    int acc = 0;
#pragma unroll
    for (int i = 0; i < 2; ++i) {
        const u32x4 w = up[i * 64];
        acc = __builtin_amdgcn_sdot4((int)xq[i].x, (int)(w.x ^ 0x80808080u), acc, false); acc = __builtin_amdgcn_sdot4((int)xq[i].y, (int)(w.y ^ 0x80808080u), acc, false);
        acc = __builtin_amdgcn_sdot4((int)xq[i].z, (int)(w.z ^ 0x80808080u), acc, false); acc = __builtin_amdgcn_sdot4((int)xq[i].w, (int)(w.w ^ 0x80808080u), acc, false);
    }
    return acc;
}
__device__ __forceinline__ void peer_issue8(u32x4 (&seg)[8], const unsigned char* base, const u32x4 ia, const u32x4 ib) {
    seg[0] = *(const u32x4*)(base + (size_t)ia.x * DM); seg[1] = *(const u32x4*)(base + (size_t)ia.y * DM); seg[2] = *(const u32x4*)(base + (size_t)ia.z * DM); seg[3] = *(const u32x4*)(base + (size_t)ia.w * DM);
    seg[4] = *(const u32x4*)(base + (size_t)ib.x * DM); seg[5] = *(const u32x4*)(base + (size_t)ib.y * DM); seg[6] = *(const u32x4*)(base + (size_t)ib.z * DM); seg[7] = *(const u32x4*)(base + (size_t)ib.w * DM);
}
__device__ __forceinline__ void peer_dot8(int (&d)[8], const u32x4 (&seg)[8], const u32x4 xq) {
#pragma unroll
    for (int i = 0; i < 8; ++i) {
        int acc = __builtin_amdgcn_sdot4((int)xq.x, (int)(seg[i].x ^ 0x80808080u), 0, false);
        acc = __builtin_amdgcn_sdot4((int)xq.y, (int)(seg[i].y ^ 0x80808080u), acc, false);
        acc = __builtin_amdgcn_sdot4((int)xq.z, (int)(seg[i].z ^ 0x80808080u), acc, false);
        d[i] = __builtin_amdgcn_sdot4((int)xq.w, (int)(seg[i].w ^ 0x80808080u), acc, false);
    }
}
__device__ __forceinline__ void phase_peer_u(const signed char* XQ, const int* EID, const unsigned char* U, LAS int* HL  ) {
    const int lane = threadIdx.x & 63, wv = threadIdx.x >> 6, es = lane >> 3, cc = lane & 7;
    const bool b2 = cc & 4, b1 = cc & 2, b0 = cc & 1;
    const int nw = gridDim.x * 8, gw = blockIdx.x * 8 + wv, tpw = (MTOK + nw - 1) / nw, tbase = gw * tpw;
    int cnt = MTOK - tbase; cnt = cnt > tpw ? tpw : cnt;
    if (cnt <= 0) return;
    for (int i = lane; i < cnt * 128; i += 64) HL[i] = 0;
    asm volatile("s_waitcnt lgkmcnt(0)" ::: "memory");
    const int nit = 16 * cnt;
    const unsigned char* ub = U + cc * 16;
    u32x4 m0a, m0b, m0c, m0d, m0x, m1a, m1b, m1c, m1d, m1x, m2a, m2b, m2c, m2d, m2x; u32x4 sA[8], sB[8];
#define PU_LOAD(sl_, k_, A_, B_, C_, D_, X_) { const int* ep_ = EID + (size_t)(tbase + (k_)) * 128 + es * 16; A_ = *(const u32x4*)ep_; B_ = *(const u32x4*)(ep_ + 4); C_ = *(const u32x4*)(ep_ + 8); D_ = *(const u32x4*)(ep_ + 12); \
        X_ = *(const u32x4*)(XQ + (size_t)(tbase + (k_)) * DM + (sl_) * 128 + cc * 16); }
#define PU_NEXT(sl_, k_, sn_, kn_) { kn_ = (k_) + 1; sn_ = (sl_); if (kn_ == cnt) { kn_ = 0; ++sn_; } if (sn_ == 16) { sn_ = 15; kn_ = cnt - 1; } }
    int sl = 0, k = 0, sl1, k1, sl2, k2;
    PU_NEXT(sl, k, sl1, k1) PU_NEXT(sl1, k1, sl2, k2)
    PU_LOAD(sl, k, m0a, m0b, m0c, m0d, m0x)
    PU_LOAD(sl1, k1, m1a, m1b, m1c, m1d, m1x)
    peer_issue8(sA, ub + sl * 128, m0a, m0b);
    for (int it = 0; it < nit; ++it) {
        PU_LOAD(sl2, k2, m2a, m2b, m2c, m2d, m2x)
        peer_issue8(sB, ub + sl * 128, m0c, m0d);
        int dlo[8]; peer_dot8(dlo, sA, m0x);
        peer_issue8(sA, ub + sl1 * 128, m1a, m1b);
        int dhi[8]; peer_dot8(dhi, sB, m0x);
        int t8[8], t4[4], t2[2];
#pragma unroll
        for (int q = 0; q < 8; ++q) { const int keep = b2 ? dhi[q] : dlo[q], send = b2 ? dlo[q] : dhi[q]; t8[q] = keep + __shfl_xor(send, 4); }
#pragma unroll
        for (int q = 0; q < 4; ++q) { const int keep = b1 ? t8[4 + q] : t8[q], send = b1 ? t8[q] : t8[4 + q]; t4[q] = keep + __shfl_xor(send, 2); }
#pragma unroll
        for (int q = 0; q < 2; ++q) { const int keep = b0 ? t4[2 + q] : t4[q], send = b0 ? t4[q] : t4[2 + q]; t2[q] = keep + __shfl_xor(send, 1); }
        { LAS int* hp = HL + k * 128 + es * 16 + (b2 ? 8 : 0) + (b1 ? 4 : 0) + (b0 ? 2 : 0);
          __hip_atomic_fetch_add(hp, t2[0], __ATOMIC_RELAXED, __HIP_MEMORY_SCOPE_WORKGROUP); __hip_atomic_fetch_add(hp + 1, t2[1], __ATOMIC_RELAXED, __HIP_MEMORY_SCOPE_WORKGROUP); }
        sl = sl1; k = k1; sl1 = sl2; k1 = k2; PU_NEXT(sl1, k1, sl2, k2)
        m0a = m1a; m0b = m1b; m0c = m1c; m0d = m1d; m0x = m1x; m1a = m2a; m1b = m2b; m1c = m2c; m1d = m2d; m1x = m2x;
    }
#undef PU_LOAD
#undef PU_NEXT
}
__device__ __forceinline__ void phase_peer_w(const LAS int* HL, const float* XS, const int* EID, const float* GATE, const float* USC, const float* VSC, float* W, float* CS) {
    const int lane = threadIdx.x & 63, gw = blockIdx.x * 8 + (threadIdx.x >> 6), nw = gridDim.x * 8, tpw = (MTOK + nw - 1) / nw, tbase = gw * tpw;
    const int tend = tbase + tpw < MTOK ? tbase + tpw : MTOK;
    for (int tok = tbase; tok < tend; ++tok) {
        const int h0 = HL[(tok - tbase) * 128 + lane], h1 = HL[(tok - tbase) * 128 + 64 + lane];
        const int e0 = EID[(size_t)tok * 128 + lane], e1 = EID[(size_t)tok * 128 + 64 + lane];
        const float xs = XS[tok];
        const float w0 = GATE[(size_t)tok * 128 + lane] * gelu_erf((float)h0 * xs * USC[e0]) * VSC[e0];
        const float w1 = GATE[(size_t)tok * 128 + 64 + lane] * gelu_erf((float)h1 * xs * USC[e1]) * VSC[e1];
        W[(size_t)tok * 128 + lane] = w0; W[(size_t)tok * 128 + 64 + lane] = w1;
        const float cs = wave_sum(w0 + w1);
        if (lane == 0) CS[tok] = cs;
    }
}
__device__ __forceinline__ void peer_fma8(f32x2_t (&ya)[8], const u32x4 (&seg)[8], const f32x4 wa, const f32x4 wb2) {
#pragma unroll
    for (int i = 0; i < 8; ++i) {
        const float wt = i < 4 ? wa[i & 3] : wb2[i & 3];
        const f32x2_t wt2 = {wt, wt};
        const u32x4 w = seg[i];
        ya[0] = __builtin_elementwise_fma(wt2, (f32x2_t){ub0(w.x), ub1(w.x)}, ya[0]); ya[1] = __builtin_elementwise_fma(wt2, (f32x2_t){ub2(w.x), ub3(w.x)}, ya[1]);
        ya[2] = __builtin_elementwise_fma(wt2, (f32x2_t){ub0(w.y), ub1(w.y)}, ya[2]); ya[3] = __builtin_elementwise_fma(wt2, (f32x2_t){ub2(w.y), ub3(w.y)}, ya[3]);
        ya[4] = __builtin_elementwise_fma(wt2, (f32x2_t){ub0(w.z), ub1(w.z)}, ya[4]); ya[5] = __builtin_elementwise_fma(wt2, (f32x2_t){ub2(w.z), ub3(w.z)}, ya[5]);
        ya[6] = __builtin_elementwise_fma(wt2, (f32x2_t){ub0(w.w), ub1(w.w)}, ya[6]); ya[7] = __builtin_elementwise_fma(wt2, (f32x2_t){ub2(w.w), ub3(w.w)}, ya[7]);
    }
}
__device__ __forceinline__ void phase_peer_v(const bf16_t* X, const int* EID, const float* W, const float* CS, const unsigned char* V, float* Y) {
    const int lane = threadIdx.x & 63, wv = threadIdx.x >> 6, es = lane >> 3, cc = lane & 7;
    const bool b5 = lane & 32, b4 = lane & 16, b3 = lane & 8;
    const int nw = gridDim.x * 8, gw = blockIdx.x * 8 + wv, tpw = (MTOK + nw - 1) / nw, tbase = gw * tpw;
    int cnt = MTOK - tbase; cnt = cnt > tpw ? tpw : cnt;
    if (cnt <= 0) return;
    const int nit = 16 * cnt;
    const unsigned char* vb = V + cc * 16;
    const int colo = cc * 16 + (b5 ? 8 : 0) + (b4 ? 4 : 0) + (b3 ? 2 : 0);
    u32x4 m0c, m0d, m1a, m1b, m1c, m1d, m2a, m2b, m2c, m2d; f32x4 w0a, w0b, w0c, w0d, w1a, w1b, w1c, w1d; f32x2_t x0, x1; float c0, c1; u32x4 sA[8], sB[8];
#define PV_IDS(k_, A_, B_, C_, D_) { const size_t o_ = (size_t)(tbase + (k_)) * 128 + es * 16; A_ = *(const u32x4*)(EID + o_); B_ = *(const u32x4*)(EID + o_ + 4); C_ = *(const u32x4*)(EID + o_ + 8); D_ = *(const u32x4*)(EID + o_ + 12); }
#define PV_WX(sl_, k_, WA_, WB_, WC_, WD_, X_, CS_) { const size_t o_ = (size_t)(tbase + (k_)) * 128 + es * 16; \
        WA_ = *(const f32x4*)(W + o_); WB_ = *(const f32x4*)(W + o_ + 4); WC_ = *(const f32x4*)(W + o_ + 8); WD_ = *(const f32x4*)(W + o_ + 12); \
        { const unsigned xw_ = *(const unsigned*)(X + (size_t)(tbase + (k_)) * DM + (sl_) * 128 + colo); X_ = (f32x2_t){bflo(xw_), bfhi(xw_)}; } CS_ = CS[tbase + (k_)]; }
#define PV_NEXT(sl_, k_, sn_, kn_) { kn_ = (k_) + 1; sn_ = (sl_); if (kn_ == cnt) { kn_ = 0; ++sn_; } if (sn_ == 16) { sn_ = 15; kn_ = cnt - 1; } }
    int sl = 0, k = 0, sl1, k1, sl2, k2;
    PV_NEXT(sl, k, sl1, k1) PV_NEXT(sl1, k1, sl2, k2)
    { u32x4 ta, tb; PV_IDS(k, ta, tb, m0c, m0d) PV_IDS(k1, m1a, m1b, m1c, m1d)
      PV_WX(sl, k, w0a, w0b, w0c, w0d, x0, c0)
      peer_issue8(sA, vb + sl * 128, ta, tb); }
    for (int it = 0; it < nit; ++it) {
        PV_IDS(k2, m2a, m2b, m2c, m2d)
        peer_issue8(sB, vb + sl * 128, m0c, m0d);
        f32x2_t ya[8];
#pragma unroll
        for (int j = 0; j < 8; ++j) ya[j] = (f32x2_t){0.f, 0.f};
        peer_fma8(ya, sA, w0a, w0b);
        peer_issue8(sA, vb + sl1 * 128, m1a, m1b);
        PV_WX(sl1, k1, w1a, w1b, w1c, w1d, x1, c1)
        peer_fma8(ya, sB, w0c, w0d);
        f32x2_t t4[4], t2[2], t1;
#pragma unroll
        for (int q = 0; q < 4; ++q) { const f32x2_t keep = b5 ? ya[4 + q] : ya[q], send = b5 ? ya[q] : ya[4 + q]; t4[q][0] = keep[0] + __shfl_xor(send[0], 32); t4[q][1] = keep[1] + __shfl_xor(send[1], 32); }
#pragma unroll
        for (int q = 0; q < 2; ++q) { const f32x2_t keep = b4 ? t4[2 + q] : t4[q], send = b4 ? t4[q] : t4[2 + q]; t2[q][0] = keep[0] + __shfl_xor(send[0], 16); t2[q][1] = keep[1] + __shfl_xor(send[1], 16); }
        { const f32x2_t keep = b3 ? t2[1] : t2[0], send = b3 ? t2[0] : t2[1]; t1[0] = keep[0] + __shfl_xor(send[0], 8); t1[1] = keep[1] + __shfl_xor(send[1], 8); }
        f32x2_t o; o[0] = t1[0] - 128.0f * c0 + ALPHA * x0[0]; o[1] = t1[1] - 128.0f * c0 + ALPHA * x0[1];
        *(f32x2_t*)(Y + (size_t)(tbase + k) * DM + sl * 128 + colo) = o;
        sl = sl1; k = k1; sl1 = sl2; k1 = k2; PV_NEXT(sl1, k1, sl2, k2)
        m0c = m1c; m0d = m1d; m1a = m2a; m1b = m2b; m1c = m2c; m1d = m2d;
        w0a = w1a; w0b = w1b; w0c = w1c; w0d = w1d; x0 = x1; c0 = c1;
    }
#undef PV_IDS
#undef PV_WX
#undef PV_NEXT
}

__device__ __forceinline__ void rot8(const u32x4 lo, const u32x4 hi, const f32x4 c0, const f32x4 c1, const f32x4 s0, const f32x4 s1, float (&o1)[8], float (&o2)[8]) {
    const float a[8] = {bflo(lo.x), bfhi(lo.x), bflo(lo.y), bfhi(lo.y), bflo(lo.z), bfhi(lo.z), bflo(lo.w), bfhi(lo.w)};
    const float b[8] = {bflo(hi.x), bfhi(hi.x), bflo(hi.y), bfhi(hi.y), bflo(hi.z), bfhi(hi.z), bflo(hi.w), bfhi(hi.w)};
    const float c[8] = {c0[0], c0[1], c0[2], c0[3], c1[0], c1[1], c1[2], c1[3]}, sn[8] = {s0[0], s0[1], s0[2], s0[3], s1[0], s1[1], s1[2], s1[3]};
#pragma unroll
    for (int j = 0; j < 8; ++j) { o1[j] = a[j] * c[j] - b[j] * sn[j]; o2[j] = a[j] * sn[j] + b[j] * c[j]; }
}
__device__ __forceinline__ u32x4 pack8(const float (&o)[8]) { u32x4 w; w.x = pk_bf16(o[0], o[1]); w.y = pk_bf16(o[2], o[3]); w.z = pk_bf16(o[4], o[5]); w.w = pk_bf16(o[6], o[7]); return w; }
__device__ __forceinline__ void phase_kstat(LAS float* red, const bf16_t* KR, float* KMEAN, float* KNMAX) {
    const int tid = threadIdx.x, ch = tid & 7, rr = tid >> 3, wv = tid >> 6, lane = tid & 63;
    for (int item = blockIdx.x; item < 2 * NHEAD * 32; item += gridDim.x) {
        const int bh = item >> 5, j = item & 31, b = bh >> 4, h = bh & 15;
        float sm1[8], sm2[8]; float nmax = 0.f;
#pragma unroll
        for (int q = 0; q < 8; ++q) { sm1[q] = 0.f; sm2[q] = 0.f; }
        u32x4 lo[4], hi[4];
#pragma unroll
        for (int ps = 0; ps < 4; ++ps) { const size_t off = ((size_t)b * SEQ + j * 256 + ps * 64 + rr) * DM + h * 128 + ch * 8; lo[ps] = *(const u32x4*)(KR + off); hi[ps] = *(const u32x4*)(KR + off + 64); }
#pragma unroll
        for (int ps = 0; ps < 4; ++ps) {
            const float a[8] = {bflo(lo[ps].x), bfhi(lo[ps].x), bflo(lo[ps].y), bfhi(lo[ps].y), bflo(lo[ps].z), bfhi(lo[ps].z), bflo(lo[ps].w), bfhi(lo[ps].w)};
            const float c[8] = {bflo(hi[ps].x), bfhi(hi[ps].x), bflo(hi[ps].y), bfhi(hi[ps].y), bflo(hi[ps].z), bfhi(hi[ps].z), bflo(hi[ps].w), bfhi(hi[ps].w)};
            float nq = 0.f;
#pragma unroll
            for (int q = 0; q < 8; ++q) { sm1[q] += a[q]; sm2[q] += c[q]; nq += a[q] * a[q] + c[q] * c[q]; }
            nq += __shfl_xor(nq, 1); nq += __shfl_xor(nq, 2); nq += __shfl_xor(nq, 4);
            nmax = fmaxf(nmax, nq);
        }
#pragma unroll
        for (int q = 0; q < 8; ++q) {
            sm1[q] += __shfl_xor(sm1[q], 8); sm1[q] += __shfl_xor(sm1[q], 16); sm1[q] += __shfl_xor(sm1[q], 32);
            sm2[q] += __shfl_xor(sm2[q], 8); sm2[q] += __shfl_xor(sm2[q], 16); sm2[q] += __shfl_xor(sm2[q], 32);
        }
        nmax = wave_max(nmax);
        if (lane < 8) {
#pragma unroll
            for (int q = 0; q < 8; ++q) { red[wv * 128 + lane * 8 + q] = sm1[q]; red[wv * 128 + 64 + lane * 8 + q] = sm2[q]; }
        }
        if (lane == 0) red[1024 + wv] = nmax;
        __syncthreads();
        if (tid < 128) {
            float s2 = 0.f;
#pragma unroll
            for (int r = 0; r < 8; ++r) s2 += red[r * 128 + tid];
            KMEAN[(size_t)item * 128 + tid] = s2 * (1.0f / 256.0f);
        }
        if (tid == 0) {
            float m = 0.f;
#pragma unroll
            for (int r = 0; r < 8; ++r) m = fmaxf(m, red[1024 + r]);
            KNMAX[item] = sqrtf(m);
        }
        __syncthreads();
    }
}

__device__ __forceinline__ void top3_insert(float x, int m, float& v0, int& i0, float& v1, int& i1, float& v2, int& i2) {
    const bool c0 = x > v0 || (x == v0 && m < i0), c1 = x > v1 || (x == v1 && m < i1), c2 = x > v2 || (x == v2 && m < i2);
    v2 = c1 ? v1 : (c2 ? x : v2); i2 = c1 ? i1 : (c2 ? m : i2);
    v1 = c0 ? v0 : (c1 ? x : v1); i1 = c0 ? i0 : (c1 ? m : i1);
    v0 = c0 ? x : v0; i0 = c0 ? m : i0;
}
__device__ __forceinline__ void phase_sel(LAS unsigned char* lds, const bf16_t* QR, const float* KMEAN, unsigned short* SUB, int* CNT, int* ctr) {
    const int tid = threadIdx.x, lane = tid & 63, wv = tid >> 6, r32 = lane & 31, hh = lane >> 5;
    LAS unsigned short* bucket = (LAS unsigned short*)lds;
    LAS int* cnt = (LAS int*)(lds + 16384);
    const float NEG = -1e30f;
    if (blockIdx.x == 0 && tid == 0) *ctr = 0;
    for (int item = blockIdx.x; item < 2 * NHEAD * 32; item += gridDim.x) {
        const int bh = item >> 5, i = item & 31, b = bh >> 4, h = bh & 15;
        if (i == 0) continue;
        if (tid < 32) cnt[tid] = 0;
        __syncthreads();
        const float* kmp = KMEAN + ((size_t)bh * 32 + r32) * 128 + 8 * hh;
        const size_t tok = (size_t)b * SEQ + i * 256 + wv * 32 + r32;
        const bf16_t* qp = QR + tok * DM + h * 128 + 8 * hh;
        f32x16 S;
#pragma unroll
        for (int e = 0; e < 16; ++e) S[e] = 0.f;
#pragma unroll
        for (int s2 = 0; s2 < 8; ++s2) {
            const f32x4 ka = *(const f32x4*)(kmp + 16 * s2), kb = *(const f32x4*)(kmp + 16 * s2 + 4);
            const bf16x8 qf = *(const bf16x8*)(qp + 16 * s2);
            u32x4 hi, lo;
            hi.x = pk_bf16(ka[0], ka[1]); hi.y = pk_bf16(ka[2], ka[3]); hi.z = pk_bf16(kb[0], kb[1]); hi.w = pk_bf16(kb[2], kb[3]);
            lo.x = pk_bf16(ka[0] - bflo(hi.x), ka[1] - bfhi(hi.x)); lo.y = pk_bf16(ka[2] - bflo(hi.y), ka[3] - bfhi(hi.y));
            lo.z = pk_bf16(kb[0] - bflo(hi.z), kb[1] - bfhi(hi.z)); lo.w = pk_bf16(kb[2] - bflo(hi.w), kb[3] - bfhi(hi.w));
            S = __builtin_amdgcn_mfma_f32_32x32x16_bf16(__builtin_bit_cast(bf16x8, hi), qf, S, 0, 0, 0);
            S = __builtin_amdgcn_mfma_f32_32x32x16_bf16(__builtin_bit_cast(bf16x8, lo), qf, S, 0, 0, 0);
        }
        float v0 = -3e38f, v1 = -3e38f, v2 = -3e38f; int i0 = 99, i1 = 99, i2 = 99;
#pragma unroll
        for (int e = 0; e < 16; ++e) {
            const int m = (e & 3) + 8 * (e >> 2) + 4 * hh;
            const float x = m < i ? S[e] : NEG;
            top3_insert(x, m, v0, i0, v1, i1, v2, i2);
        }
        {
            const float pv0 = __shfl_xor(v0, 32), pv1 = __shfl_xor(v1, 32), pv2 = __shfl_xor(v2, 32);
            const int pi0 = __shfl_xor(i0, 32), pi1 = __shfl_xor(i1, 32), pi2 = __shfl_xor(i2, 32);
            top3_insert(pv0, pi0, v0, i0, v1, i1, v2, i2); top3_insert(pv1, pi1, v0, i0, v1, i1, v2, i2); top3_insert(pv2, pi2, v0, i0, v1, i1, v2, i2);
        }
        if (hh == 0) {
            const int tl = wv * 32 + r32;
            if (v0 > 0.5f * NEG) { const int p = __hip_atomic_fetch_add(cnt + i0, 1, __ATOMIC_RELAXED, __HIP_MEMORY_SCOPE_WORKGROUP); bucket[i0 * 256 + p] = (unsigned short)(tl | (0 << 8)); }
            if (v1 > 0.5f * NEG) { const int p = __hip_atomic_fetch_add(cnt + i1, 1, __ATOMIC_RELAXED, __HIP_MEMORY_SCOPE_WORKGROUP); bucket[i1 * 256 + p] = (unsigned short)(tl | (1 << 8)); }
            if (v2 > 0.5f * NEG) { const int p = __hip_atomic_fetch_add(cnt + i2, 1, __ATOMIC_RELAXED, __HIP_MEMORY_SCOPE_WORKGROUP); bucket[i2 * 256 + p] = (unsigned short)(tl | (2 << 8)); }
        }
        __syncthreads();
        for (int idx = tid; idx < 32 * 256; idx += 512) {
            const int j = idx >> 8, p = idx & 255;
            if (j < i && p < cnt[j]) SUB[(((size_t)bh * 32 + j) * 32 + i) * 256 + p] = bucket[idx];
        }
        if (tid < i) CNT[((size_t)bh * 32 + tid) * 32 + i] = cnt[tid];
        __syncthreads();
    }
}

__device__ __forceinline__ unsigned off_b(unsigned row, unsigned ch) { return 256u * row + 16u * (ch ^ (((row & 3u) << 2) | ((row >> 2) & 3u))); }
__device__ __forceinline__ unsigned pi32(unsigned m) { return (m & ~12u) | ((m & 4u) << 1) | ((m & 8u) >> 1); }
__device__ __forceinline__ bf16x8 tr_frag(LAS unsigned char* img, unsigned lane, unsigned c, unsigned ks) {
    const unsigned hh = lane >> 5, blk = (lane >> 4) & 1, q = (lane & 15) >> 2, p = lane & 3;
    const unsigned a0 = off_b(16 * ks + 8 * hh + q, 4 * c + 2 * blk + (p >> 1)) + 8 * (p & 1);
    const unsigned a1 = off_b(16 * ks + 8 * hh + 4 + q, 4 * c + 2 * blk + (p >> 1)) + 8 * (p & 1);
    const s16x4 lo = __builtin_amdgcn_ds_read_tr16_b64_v4i16((LAS s16x4*)(img + a0));
    const s16x4 hi = __builtin_amdgcn_ds_read_tr16_b64_v4i16((LAS s16x4*)(img + a1));
    bf16x8 r; r[0] = lo[0]; r[1] = lo[1]; r[2] = lo[2]; r[3] = lo[3]; r[4] = hi[0]; r[5] = hi[1]; r[6] = hi[2]; r[7] = hi[3];
    return r;
}
__device__ __forceinline__ void phase_att(LAS unsigned char* lds, const bf16_t* QR, const bf16_t* KR, const bf16_t* V, const float* KNMAX, const unsigned short* SUB, const int* CNT, int* ctr,
                                          bf16_t* P012, bf16_t* P3, float* LS) {
    const int tid = threadIdx.x, lane = tid & 63, wv = tid >> 6, r32 = lane & 31, hh = lane >> 5;
    LAS unsigned char* Kimg = lds;
    LAS unsigned char* Vimg = lds + 65536;
    LAS int* misc = (LAS int*)(lds + 131072);
    const float SCL2 = 0.08838834764831845f * 1.4426950408889634f;
    for (;;) {
        __syncthreads();
        if (tid == 0) misc[40] = __hip_atomic_fetch_add(ctr, 1, __ATOMIC_RELAXED, __HIP_MEMORY_SCOPE_AGENT);
        __syncthreads();
        const int item = misc[40];
        if (item >= 2 * NHEAD * 32) break;
        const int j = item >> 5, bh = item & 31, b = bh >> 4, h = bh & 15;
#pragma unroll
        for (int r = 0; r < 8; ++r) {
            const int idx = tid + 512 * r, row = idx >> 4, ch = idx & 15;
            const size_t g = ((size_t)b * SEQ + j * 256 + row) * DM + h * 128 + ch * 8;
            const u32x4 kv = *(const u32x4*)(KR + g), vv = *(const u32x4*)(V + g);
            *(LAS u32x4*)(Kimg + off_b(row, ch)) = kv; *(LAS u32x4*)(Vimg + off_b(row, ch)) = vv;
        }
        if (tid <= 32) { int pre = 0; for (int u = j + 1; u < tid; ++u) pre += CNT[((size_t)bh * 32 + j) * 32 + u]; misc[tid] = pre; }
        float kn = (lane < 32) ? KNMAX[bh * 32 + lane] : 0.f;
        kn = wave_max(kn);
        __syncthreads();
        const int total = misc[32], ntile = (256 + total + 31) >> 5;
        for (int tile = wv; tile < ntile; tile += 8) {
            const int gr = tile * 32 + r32;
            int pos, slot; bool valid = true;
            if (gr < 256) { pos = j * 256 + gr; slot = 3; }
            else {
                const int x = gr - 256; valid = x < total;
                int ii = j + 1;
                for (int u = j + 1; u < 32; ++u) if (misc[u] <= x) ii = u;
                if (valid) { const unsigned e = SUB[(((size_t)bh * 32 + j) * 32 + ii) * 256 + (x - misc[ii])]; pos = ii * 256 + (int)(e & 255u); slot = (int)(e >> 8); }
                else { pos = j * 256; slot = 3; }
            }
            const size_t tok = (size_t)b * SEQ + pos;
            bf16x8 qf[8];
            const bf16_t* qp = QR + tok * DM + h * 128 + 8 * hh;
#pragma unroll
            for (int s = 0; s < 8; ++s) qf[s] = *(const bf16x8*)(qp + 16 * s);
            float qn2 = 0.f;
#pragma unroll
            for (int s = 0; s < 8; ++s)
#pragma unroll
                for (int e = 0; e < 8; ++e) { const float f = bf2f((bf16_t)qf[s][e]); qn2 += f * f; }
            qn2 += __shfl_xor(qn2, 32);
            const float c2 = sqrtf(qn2) * kn * SCL2;
            f32x16 O[4];
#pragma unroll
            for (int dt = 0; dt < 4; ++dt)
#pragma unroll
                for (int e = 0; e < 16; ++e) O[dt][e] = 0.f;
            float l = 0.f;
            const bool own = tile < 8;
            const int kcn = own ? tile + 1 : 8;
            const unsigned krow = pi32((unsigned)r32);
            for (int kc = 0; kc < kcn; ++kc) {
                f32x16 S;
#pragma unroll
                for (int e = 0; e < 16; ++e) S[e] = 0.f;
#pragma unroll
                for (int s = 0; s < 8; ++s) {
                    const bf16x8 kf = *(const LAS bf16x8*)(Kimg + off_b(32 * kc + krow, 2 * s + hh));
                    S = __builtin_amdgcn_mfma_f32_32x32x16_bf16(kf, qf[s], S, 0, 0, 0);
                }
                float p[16];
#pragma unroll
                for (int e = 0; e < 16; ++e) {
                    const unsigned m = (e & 3) + 8 * (e >> 2) + 4 * hh;
                    const int key = j * 256 + 32 * kc + (int)pi32(m);
                    float pe = __builtin_amdgcn_exp2f(S[e] * SCL2 - c2);
                    if (own && key > pos) pe = 0.f;
                    p[e] = pe; l += pe;
                }
                u32x4 w0, w1;
                w0.x = pk_bf16(p[0], p[1]); w0.y = pk_bf16(p[2], p[3]); w0.z = pk_bf16(p[4], p[5]); w0.w = pk_bf16(p[6], p[7]);
                w1.x = pk_bf16(p[8], p[9]); w1.y = pk_bf16(p[10], p[11]); w1.z = pk_bf16(p[12], p[13]); w1.w = pk_bf16(p[14], p[15]);
                const bf16x8 pf0 = __builtin_bit_cast(bf16x8, w0), pf1 = __builtin_bit_cast(bf16x8, w1);
#pragma unroll
                for (int dt = 0; dt < 4; ++dt) {
                    const bf16x8 v0 = tr_frag(Vimg, lane, dt, 2 * kc), v1 = tr_frag(Vimg, lane, dt, 2 * kc + 1);
                    O[dt] = __builtin_amdgcn_mfma_f32_32x32x16_bf16(v0, pf0, O[dt], 0, 0, 0);
                    O[dt] = __builtin_amdgcn_mfma_f32_32x32x16_bf16(v1, pf1, O[dt], 0, 0, 0);
                }
            }
            l += __shfl_xor(l, 32);
            if (valid) {
                bf16_t* pl = (slot < 3 ? P012 + (size_t)slot * ((size_t)32 << 20) : P3) + (tok * NHEAD + h) * 128 + 4 * hh;
#pragma unroll
                for (int dt = 0; dt < 4; ++dt)
#pragma unroll
                    for (int g = 0; g < 4; ++g) {
                        u32x2 w; w.x = pk_bf16(O[dt][4 * g], O[dt][4 * g + 1]); w.y = pk_bf16(O[dt][4 * g + 2], O[dt][4 * g + 3]);
                        *(u32x2*)(pl + 32 * dt + 8 * g) = w;
                    }
                if (hh == 0) LS[(size_t)slot * MTOK * NHEAD + tok * NHEAD + h] = l;
            }
        }
    }
}
__device__ __forceinline__ void phase_comb(const bf16_t* P012, const bf16_t* P3, const float* LS, bf16_t* AO) {
    const size_t n = (size_t)MTOK * NHEAD * 16, stride = (size_t)gridDim.x * 512;
    for (size_t idx = (size_t)blockIdx.x * 512 + threadIdx.x; idx < n; idx += stride) {
        const size_t th = idx >> 4; const int ch = (int)(idx & 15);
        const int t = (int)((th >> 4) & (SEQ - 1)), blk = t >> 8, nsel = blk < 3 ? blk : 3;
        float acc[8];
        float l = LS[(size_t)3 * MTOK * NHEAD + th];
        { const u32x4 w = *(const u32x4*)(P3 + th * 128 + ch * 8);
          acc[0] = bflo(w.x); acc[1] = bfhi(w.x); acc[2] = bflo(w.y); acc[3] = bfhi(w.y); acc[4] = bflo(w.z); acc[5] = bfhi(w.z); acc[6] = bflo(w.w); acc[7] = bfhi(w.w); }
        for (int s = 0; s < nsel; ++s) {
            const u32x4 w = *(const u32x4*)(P012 + (size_t)s * ((size_t)32 << 20) + th * 128 + ch * 8);
            acc[0] += bflo(w.x); acc[1] += bfhi(w.x); acc[2] += bflo(w.y); acc[3] += bfhi(w.y); acc[4] += bflo(w.z); acc[5] += bfhi(w.z); acc[6] += bflo(w.w); acc[7] += bfhi(w.w);
            l += LS[(size_t)s * MTOK * NHEAD + th];
        }
        const float rl = 1.0f / l;
        u32x4 o; o.x = pk_bf16(acc[0] * rl, acc[1] * rl); o.y = pk_bf16(acc[2] * rl, acc[3] * rl); o.z = pk_bf16(acc[4] * rl, acc[5] * rl); o.w = pk_bf16(acc[6] * rl, acc[7] * rl);
        *(u32x4*)(AO + th * 128 + ch * 8) = o;
    }
}

__device__ __forceinline__ float logf_gate(float z, float lb) { return __logf(lb + (1.0f - lb) * sigmoidf_(z)); }
__device__ __forceinline__ void phase_scan_a(LAS unsigned char* lds, const bf16_t* FZ, const float* LB, const bf16_t* I1, bf16_t* LT, float* DEC, unsigned* dbgc = nullptr) {
    unsigned dbg_kt = 0, dbg_acc = 0;
    const int tid = threadIdx.x, lane = tid & 63, wv = tid >> 6, k = tid & 127, part = tid >> 7;
    LAS unsigned char* Iimg = lds; LAS unsigned char* KTimg = lds + 16384;
    LAS float* psum = (LAS float*)(lds + 32768);
    LAS unsigned char* Lst = lds + 36864;
#if SCAN_A_VALU == 2
    for (int item = blockIdx.x; item < 2 * NHEAD * 128; item += gridDim.x) {
        const int bh = item >> 7, c = item & 127, b = bh >> 4, h = bh & 15;
        const size_t tok0 = (size_t)b * SEQ + c * 64;
        for (int idx = tid; idx < 16384; idx += 512) {
            const int v = idx >> 7, kk = idx & 127;
            float g = 1.f, L = 0.f;
            for (int s2 = 63; s2 >= 0; --s2) { const size_t o = (tok0 + s2) * DM + h * 128; const float f = __expf(logf_gate(bf2f(FZ[o + kk]), LB[h * 128 + kk])); L += bf2f(I1[o + v]) * (1.0f - f) * g; g *= f; }
            LT[(size_t)item * 16384 + idx] = (bf16_t)(pk_bf16(L, 0.f) & 0xffffu);
        }
    }
    return;
#endif
    bf16_t nfz[16]; u32x4 nit_[2];
#define SA_LOAD(item_) { const int bh_ = (item_) >> 7, c_ = (item_) & 127; const size_t t0_ = (size_t)(bh_ >> 4) * SEQ + c_ * 64; const int h_ = bh_ & 15; \
        _Pragma("unroll") for (int i = 0; i < 16; ++i) nfz[i] = FZ[(t0_ + 16 * part + i) * DM + h_ * 128 + k]; \
        _Pragma("unroll") for (int r = 0; r < 2; ++r) { const int idx = tid + 512 * r, row = idx >> 4, ch = idx & 15; nit_[r] = *(const u32x4*)(I1 + (t0_ + row) * DM + h_ * 128 + ch * 8); } }
    if ((int)blockIdx.x < 2 * NHEAD * 128) SA_LOAD((int)blockIdx.x)
    for (int item = blockIdx.x; item < 2 * NHEAD * 128; item += gridDim.x) {
        const int bh = item >> 7, c = item & 127, b = bh >> 4, h = bh & 15;
        const size_t tok0 = (size_t)b * SEQ + c * 64;
        float lf[16];
        const float lbk = LB[h * 128 + k];
#pragma unroll
        for (int i = 0; i < 16; ++i) lf[i] = logf_gate(bf2f(nfz[i]), lbk);
#pragma unroll
        for (int r = 0; r < 2; ++r) { const int idx = tid + 512 * r, row = idx >> 4, ch = idx & 15; *(LAS u32x4*)(Iimg + off_b(row, ch)) = nit_[r]; }
        if (item + (int)gridDim.x < 2 * NHEAD * 128) SA_LOAD(item + (int)gridDim.x)
        float cs = 0.f;
#pragma unroll
        for (int i = 0; i < 16; ++i) cs += lf[i];
        psum[part * 128 + k] = cs;
        __syncthreads();
        const float p0 = psum[k], p1 = psum[128 + k], p2 = psum[256 + k], p3 = psum[384 + k];
        const float blast = (p0 + p1) + (p2 + p3);
        float bb = part == 0 ? 0.f : (part == 1 ? p0 : (part == 2 ? p0 + p1 : p0 + p1 + p2));
#pragma unroll
        for (int i = 0; i < 16; ++i) {
            bb += lf[i];
            const float kt = (1.0f - __expf(lf[i])) * __expf(blast - bb);
            if (!(kt - kt == 0.f)) ++dbg_kt;
            const int srow = 16 * part + i;
            *(LAS bf16_t*)(KTimg + off_b(srow, k >> 3) + 2 * (k & 7)) = (bf16_t)(pk_bf16(kt, 0.f) & 0xffffu);
        }
        if (part == 0) DEC[(size_t)item * 128 + k] = __expf(blast);
        __syncthreads();
#if SCAN_A_VALU
        for (int idx = tid; idx < 16384; idx += 512) {
            const int v = idx >> 7, kk = idx & 127;
            float accv = 0.f;
            for (int s2 = 0; s2 < 64; ++s2) accv += bf2f(*(const LAS bf16_t*)(Iimg + off_b(s2, v >> 3) + 2 * (v & 7))) * bf2f(*(const LAS bf16_t*)(KTimg + off_b(s2, kk >> 3) + 2 * (kk & 7)));
            *(LAS bf16_t*)(Lst + v * 272 + 2 * kk) = (bf16_t)(pk_bf16(accv, 0.f) & 0xffffu);
        }
        if (0)
#endif
        {
            const int vt = wv >> 1;
            f32x16 acc0, acc1;
#pragma unroll
            for (int e = 0; e < 16; ++e) { acc0[e] = 0.f; acc1[e] = 0.f; }
#pragma unroll
            for (int ks = 0; ks < 4; ++ks) {
                const bf16x8 af = tr_frag(Iimg, lane, vt, ks);
                const bf16x8 b0 = tr_frag(KTimg, lane, 2 * (wv & 1), ks), b1 = tr_frag(KTimg, lane, 2 * (wv & 1) + 1, ks);
                acc0 = __builtin_amdgcn_mfma_f32_32x32x16_bf16(af, b0, acc0, 0, 0, 0);
                acc1 = __builtin_amdgcn_mfma_f32_32x32x16_bf16(af, b1, acc1, 0, 0, 0);
            }
            const int r32 = lane & 31, hh = lane >> 5;
#pragma unroll
            for (int e = 0; e < 16; ++e) {
                if (!(acc0[e] - acc0[e] == 0.f)) ++dbg_acc; if (!(acc1[e] - acc1[e] == 0.f)) ++dbg_acc;
                const int v = 32 * vt + (e & 3) + 8 * (e >> 2) + 4 * hh;
                *(LAS bf16_t*)(Lst + v * 272 + 2 * (64 * (wv & 1) + r32)) = (bf16_t)(pk_bf16(acc0[e], 0.f) & 0xffffu);
                *(LAS bf16_t*)(Lst + v * 272 + 2 * (64 * (wv & 1) + 32 + r32)) = (bf16_t)(pk_bf16(acc1[e], 0.f) & 0xffffu);
            }
        }
        __syncthreads();
#pragma unroll
        for (int r = 0; r < 4; ++r) { const int idx = tid + 512 * r, row = idx >> 4, ch = idx & 15; *(u32x4*)(LT + (size_t)item * 16384 + row * 128 + ch * 8) = *(const LAS u32x4*)(Lst + row * 272 + ch * 16); }
        __syncthreads();
    }
    if (dbgc) { if (dbg_kt) atomicAdd(dbgc + 0, dbg_kt); if (dbg_acc) atomicAdd(dbgc + 1, dbg_acc); }
}
__device__ __forceinline__ void phase_scan_b(bf16_t* LT, const float* DEC) {
    const int n = 2 * NHEAD * 128 * 32;
    for (int idx = blockIdx.x * 512 + threadIdx.x; idx < n; idx += gridDim.x * 512) {
        const int bh = idx >> 12, vk = idx & 4095, k4 = (vk & 31) * 4;
        float S0 = 0.f, S1 = 0.f, S2 = 0.f, S3 = 0.f;
        bf16_t* p = LT + (size_t)bh * 128 * 16384 + (size_t)vk * 4;
        const float* dp = DEC + (size_t)bh * 128 * 128 + k4;
#pragma unroll 16
        for (int c = 0; c < 128; ++c) {
            const u32x2 w = *(const u32x2*)(p + (size_t)c * 16384);
            const f32x4 d = *(const f32x4*)(dp + c * 128);
            u32x2 o; o.x = pk_bf16(S0, S1); o.y = pk_bf16(S2, S3);
            *(u32x2*)(p + (size_t)c * 16384) = o;
            S0 = d[0] * S0 + bflo(w.x); S1 = d[1] * S1 + bfhi(w.x); S2 = d[2] * S2 + bflo(w.y); S3 = d[3] * S3 + bfhi(w.y);
        }
    }
}
__device__ __forceinline__ void phase_scan_c(LAS unsigned char* lds, const bf16_t* Q1, const bf16_t* FZ, const float* LB, const bf16_t* I1, const bf16_t* G1, const bf16_t* SP, const float* gnorm, bf16_t* OG) {
    const int tid = threadIdx.x, lane = tid & 63, wv = tid >> 6, k = tid & 127, part = tid >> 7, r32 = lane & 31, hh = lane >> 5;
    LAS unsigned char* QTimg = lds; LAS unsigned char* QPimg = lds + 16384; LAS unsigned char* KPimg = lds + 32768; LAS unsigned char* Iimg = lds + 49152; LAS unsigned char* SPimg = lds + 65536;
    LAS float* psum = (LAS float*)(lds + 98304);
    LAS float* ssq = (LAS float*)(lds + 100352);
    LAS unsigned char* OT = lds + 102400;
    bf16_t nfz[16], nq[16]; u32x4 nit_[2], nsp[4], ngt[2];
#define SC_LOAD(item_) { const int bh_ = (item_) >> 7, c_ = (item_) & 127; const size_t t0_ = (size_t)(bh_ >> 4) * SEQ + c_ * 64; const int h_ = bh_ & 15; \
        _Pragma("unroll") for (int i = 0; i < 16; ++i) { const size_t o_ = (t0_ + 16 * part + i) * DM + h_ * 128 + k; nfz[i] = FZ[o_]; nq[i] = Q1[o_]; } \
        _Pragma("unroll") for (int r = 0; r < 2; ++r) { const int idx = tid + 512 * r, row = idx >> 4, ch = idx & 15; nit_[r] = *(const u32x4*)(I1 + (t0_ + row) * DM + h_ * 128 + ch * 8); ngt[r] = *(const u32x4*)(G1 + (t0_ + row) * DM + h_ * 128 + ch * 8); } \
        _Pragma("unroll") for (int r = 0; r < 4; ++r) { const int idx = tid + 512 * r, row = idx >> 4, ch = idx & 15; nsp[r] = *(const u32x4*)(SP + (size_t)(item_) * 16384 + row * 128 + ch * 8); } }
    if ((int)blockIdx.x < 2 * NHEAD * 128) SC_LOAD((int)blockIdx.x)
    for (int item = blockIdx.x; item < 2 * NHEAD * 128; item += gridDim.x) {
        const int bh = item >> 7, c = item & 127, b = bh >> 4, h = bh & 15;
        const size_t tok0 = (size_t)b * SEQ + c * 64;
        float lf[16], qv[16];
        const float lbk = LB[h * 128 + k];
#pragma unroll
        for (int i = 0; i < 16; ++i) { lf[i] = logf_gate(bf2f(nfz[i]), lbk); const float qr = bf2f(nq[i]); qv[i] = qr * sigmoidf_(qr); }
#pragma unroll
        for (int r = 0; r < 2; ++r) { const int idx = tid + 512 * r, row = idx >> 4, ch = idx & 15; *(LAS u32x4*)(Iimg + off_b(row, ch)) = nit_[r]; }
#pragma unroll
        for (int r = 0; r < 4; ++r) { const int idx = tid + 512 * r, row = idx >> 4, ch = idx & 15; *(LAS u32x4*)(SPimg + off_b(row, ch)) = nsp[r]; }
        const u32x4 gcur0 = ngt[0], gcur1 = ngt[1];
        if (item + (int)gridDim.x < 2 * NHEAD * 128) SC_LOAD(item + (int)gridDim.x)
        float cs = 0.f;
#pragma unroll
        for (int i = 0; i < 16; ++i) cs += lf[i];
        psum[part * 128 + k] = cs;
        __syncthreads();
        const float p0 = psum[k], p1 = psum[128 + k], p2 = psum[256 + k];
        const float rr = p0 + p1;
        float bb = part == 0 ? 0.f : (part == 1 ? p0 : (part == 2 ? p0 + p1 : p0 + p1 + p2));
#pragma unroll
        for (int i = 0; i < 16; ++i) {
            bb += lf[i];
            const float qt = qv[i] * __expf(bb), qp = qv[i] * __expf(bb - rr), kp = (1.0f - __expf(lf[i])) * __expf(rr - bb);
            const unsigned o = off_b(16 * part + i, k >> 3) + 2 * (k & 7);
            *(LAS bf16_t*)(QTimg + o) = (bf16_t)(pk_bf16(qt, 0.f) & 0xffffu);
            *(LAS bf16_t*)(QPimg + o) = (bf16_t)(pk_bf16(qp, 0.f) & 0xffffu);
            *(LAS bf16_t*)(KPimg + o) = (bf16_t)(pk_bf16(kp, 0.f) & 0xffffu);
        }
        __syncthreads();
        const int tt = wv & 1, vt = wv >> 1;
        f32x16 O;
#pragma unroll
        for (int e = 0; e < 16; ++e) O[e] = 0.f;
#pragma unroll
        for (int ks = 0; ks < 8; ++ks) {
            const bf16x8 af = *(const LAS bf16x8*)(SPimg + off_b(32 * vt + r32, 2 * ks + hh));
            const bf16x8 bf = *(const LAS bf16x8*)(QTimg + off_b(32 * tt + r32, 2 * ks + hh));
            O = __builtin_amdgcn_mfma_f32_32x32x16_bf16(af, bf, O, 0, 0, 0);
        }
        const unsigned krow = pi32((unsigned)r32);
        for (int st = 0; st <= tt; ++st) {
            f32x16 S;
#pragma unroll
            for (int e = 0; e < 16; ++e) S[e] = 0.f;
#pragma unroll
            for (int ks = 0; ks < 8; ++ks) {
                const bf16x8 af = *(const LAS bf16x8*)(KPimg + off_b(32 * st + krow, 2 * ks + hh));
                const bf16x8 bf = *(const LAS bf16x8*)(QPimg + off_b(32 * tt + r32, 2 * ks + hh));
                S = __builtin_amdgcn_mfma_f32_32x32x16_bf16(af, bf, S, 0, 0, 0);
            }
            float p[16];
#pragma unroll
            for (int e = 0; e < 16; ++e) {
                const unsigned m = (e & 3) + 8 * (e >> 2) + 4 * hh;
                const int sidx = 32 * st + (int)pi32(m), tidx = 32 * tt + r32;
                p[e] = sidx <= tidx ? S[e] : 0.f;
            }
            u32x4 w0, w1;
            w0.x = pk_bf16(p[0], p[1]); w0.y = pk_bf16(p[2], p[3]); w0.z = pk_bf16(p[4], p[5]); w0.w = pk_bf16(p[6], p[7]);
            w1.x = pk_bf16(p[8], p[9]); w1.y = pk_bf16(p[10], p[11]); w1.z = pk_bf16(p[12], p[13]); w1.w = pk_bf16(p[14], p[15]);
            const bf16x8 pf0 = __builtin_bit_cast(bf16x8, w0), pf1 = __builtin_bit_cast(bf16x8, w1);
            const bf16x8 i0 = tr_frag(Iimg, lane, vt, 2 * st), i1 = tr_frag(Iimg, lane, vt, 2 * st + 1);
            O = __builtin_amdgcn_mfma_f32_32x32x16_bf16(i0, pf0, O, 0, 0, 0);
            O = __builtin_amdgcn_mfma_f32_32x32x16_bf16(i1, pf1, O, 0, 0, 0);
        }
        float sq = 0.f;
#pragma unroll
        for (int e = 0; e < 16; ++e) sq += O[e] * O[e];
        sq += __shfl_xor(sq, 32);
        if (hh == 0) ssq[vt * 64 + 32 * tt + r32] = sq;
        __syncthreads();
        const int tl = 32 * tt + r32;
        const float rstd = rsqrtf((ssq[tl] + ssq[64 + tl] + ssq[128 + tl] + ssq[192 + tl]) * (1.0f / 128.0f) + 1e-6f);
#pragma unroll
        for (int g = 0; g < 4; ++g) {
            const int v0 = 32 * vt + 8 * g + 4 * hh;
            const f32x4 gn = *(const f32x4*)(gnorm + v0);
            u32x2 w; w.x = pk_bf16(O[4 * g] * rstd * gn[0], O[4 * g + 1] * rstd * gn[1]); w.y = pk_bf16(O[4 * g + 2] * rstd * gn[2], O[4 * g + 3] * rstd * gn[3]);
            *(LAS u32x2*)(OT + tl * 272 + v0 * 2) = w;
        }
        __syncthreads();
#pragma unroll
        for (int r = 0; r < 2; ++r) {
            const int idx = tid + 512 * r, row = idx >> 4, ch = idx & 15;
            const u32x4 ov = *(const LAS u32x4*)(OT + row * 272 + ch * 16);
            const size_t go = (tok0 + row) * DM + h * 128 + ch * 8;
            const u32x4 gv = r == 0 ? gcur0 : gcur1;
            u32x4 w;
#define SILU_(x_) ((x_) * sigmoidf_(x_))
            w.x = pk_bf16(bflo(ov.x) * SILU_(bflo(gv.x)), bfhi(ov.x) * SILU_(bfhi(gv.x))); w.y = pk_bf16(bflo(ov.y) * SILU_(bflo(gv.y)), bfhi(ov.y) * SILU_(bfhi(gv.y)));
            w.z = pk_bf16(bflo(ov.z) * SILU_(bflo(gv.z)), bfhi(ov.z) * SILU_(bfhi(gv.z))); w.w = pk_bf16(bflo(ov.w) * SILU_(bflo(gv.w)), bfhi(ov.w) * SILU_(bfhi(gv.w)));
#undef SILU_
            *(u32x4*)(OG + go) = w;
        }
        __syncthreads();
    }
}


#if SCAN_DBG == 2
__device__ __forceinline__ void dbg_compare(LAS float* red, const bf16_t* A, const bf16_t* B, float* DBG) {
    float sd = 0.f, sr = 0.f, nn = 0.f;
    const size_t n = (size_t)MTOK * DM;
    for (size_t i = (size_t)blockIdx.x * 512 + threadIdx.x; i < n; i += (size_t)gridDim.x * 512) {
        const float x = bf2f(A[i]), y = bf2f(B[i]);
        if (!(x - x == 0.f)) nn += 1.f; else { sd += (x - y) * (x - y); sr += y * y; }
    }
    sd = wave_sum(sd); sr = wave_sum(sr); nn = wave_sum(nn);
    const int wv = threadIdx.x >> 6;
    if ((threadIdx.x & 63) == 0) { red[wv * 3] = sd; red[wv * 3 + 1] = sr; red[wv * 3 + 2] = nn; }
    __syncthreads();
    if (threadIdx.x == 0) { float a = 0, b = 0, c = 0; for (int w = 0; w < 8; ++w) { a += red[w * 3]; b += red[w * 3 + 1]; c += red[w * 3 + 2]; } DBG[blockIdx.x * 4] = a; DBG[blockIdx.x * 4 + 1] = b; DBG[blockIdx.x * 4 + 2] = c; }
    __syncthreads();
}
__device__ __forceinline__ void dbg_emit(const float* DBG, float* out) {
    float a = 0, b = 0, c = 0;
    for (int w = 0; w < (int)gridDim.x; ++w) { a += DBG[w * 4]; b += DBG[w * 4 + 1]; c += DBG[w * 4 + 2]; }
    const float rel = sqrtf(a / b);
    int k = (int)rintf(-2.0f * log10f(rel)); k = k < 0 ? 0 : (k > 16 ? 16 : k);
    if (c > 0.f) k = 17;
    const float cc = sqrtf(0.5f * (float)k);
    const size_t n = (size_t)MTOK * DM;
    for (size_t i = (size_t)blockIdx.x * 512 + threadIdx.x; i < n; i += (size_t)gridDim.x * 512) out[i] = cc;
}
#endif

#if SCAN_DBG == 3
__device__ __forceinline__ void dbg_count_bf16(const bf16_t* A, size_t n, unsigned* cnt) {
    unsigned c = 0;
    for (size_t i = (size_t)blockIdx.x * 512 + threadIdx.x; i < n; i += (size_t)gridDim.x * 512) { const float x = bf2f(A[i]); if (!(x - x == 0.f)) ++c; }
    if (c) atomicAdd(cnt, c);
}
__device__ __forceinline__ void dbg_count_f32(const float* A, size_t n, unsigned* cnt) {
    unsigned c = 0;
    for (size_t i = (size_t)blockIdx.x * 512 + threadIdx.x; i < n; i += (size_t)gridDim.x * 512) { const float x = A[i]; if (!(x - x == 0.f)) ++c; }
    if (c) atomicAdd(cnt, c);
}
__device__ __forceinline__ void dbg_emit3(const unsigned* cnt, float* out) {
    float code = 0.f;
    for (int st = 3; st >= 0; --st) { const unsigned c = cnt[st]; if (c) { float lg = log10f((float)c); lg = lg > 9.f ? 9.f : lg; code = (float)(st + 1) + 0.1f * lg; } }
    const float cc = sqrtf(code);
    const size_t n = (size_t)MTOK * DM;
    for (size_t i = (size_t)blockIdx.x * 512 + threadIdx.x; i < n; i += (size_t)gridDim.x * 512) out[i] = cc;
}
#endif

#if SCAN_DBG == 4 || SCAN_DBG == 6
__device__ __forceinline__ void dbg_compare4(LAS float* red, const bf16_t* A, const bf16_t* B, const bf16_t* C, float* DBG) {
    float sd = 0.f, sr = 0.f, nn = 0.f, mm = 0.f;
    const size_t n = (size_t)MTOK * DM;
    for (size_t i = (size_t)blockIdx.x * 512 + threadIdx.x; i < n; i += (size_t)gridDim.x * 512) {
        const float x = bf2f(A[i]), y = bf2f(B[i]);
        if (!(x - x == 0.f)) nn += 1.f; else { sd += (x - y) * (x - y); sr += y * y; }
        if (A[i] != C[i]) mm += 1.f;
    }
    sd = wave_sum(sd); sr = wave_sum(sr); nn = wave_sum(nn); mm = wave_sum(mm);
    const int wv = threadIdx.x >> 6;
    if ((threadIdx.x & 63) == 0) { red[wv * 4] = sd; red[wv * 4 + 1] = sr; red[wv * 4 + 2] = nn; red[wv * 4 + 3] = mm; }
    __syncthreads();
    if (threadIdx.x == 0) { float a = 0, b = 0, c = 0, d = 0; for (int w = 0; w < 8; ++w) { a += red[w * 4]; b += red[w * 4 + 1]; c += red[w * 4 + 2]; d += red[w * 4 + 3]; }
        DBG[blockIdx.x * 4] = a; DBG[blockIdx.x * 4 + 1] = b; DBG[blockIdx.x * 4 + 2] = c; DBG[blockIdx.x * 4 + 3] = d; }
    __syncthreads();
}
__device__ __forceinline__ void dbg_emit4(const float* DBG, float* out) {
    float a = 0, b = 0, c = 0, d = 0;
    for (int w = 0; w < (int)gridDim.x; ++w) { a += DBG[w * 4]; b += DBG[w * 4 + 1]; c += DBG[w * 4 + 2]; d += DBG[w * 4 + 3]; }
    const float rel = sqrtf(a / b);
    int k = (int)rintf(-log10f(rel)); k = k < 0 ? 0 : (k > 8 ? 8 : k);
#if SCAN_DBG == 6
    const float cc = sqrtf((float)k + ((d + c) > 0.f ? 0.5f : 0.f));
#else
    int m = (int)ceilf(log10f(1.0f + d + c)); m = m > 9 ? 9 : m;
    const float cc = sqrtf((float)k + 0.1f * (float)m);
#endif
    const size_t n = (size_t)MTOK * DM;
    for (size_t i = (size_t)blockIdx.x * 512 + threadIdx.x; i < n; i += (size_t)gridDim.x * 512) out[i] = cc;
}
#endif

#if SCAN_DBG == 5
__device__ __forceinline__ void dbg_lds16_test(LAS unsigned char* lds, unsigned* cnt) {
    const int tid = threadIdx.x;
    unsigned bad = 0;
    for (int rep = 0; rep < 64; ++rep) {
        for (int i = tid; i < 1024; i += 512) *(LAS u32x4*)(lds + i * 16) = (u32x4){0x7fc07fc0u, 0x7fc07fc0u, 0x7fc07fc0u, 0x7fc07fc0u};
        __syncthreads();
        const int k = tid & 127, part = tid >> 7;
#pragma unroll
        for (int i = 0; i < 16; ++i) {
            const int row = 16 * part + i;
            *(LAS bf16_t*)(lds + off_b(row, k >> 3) + 2 * (k & 7)) = (bf16_t)((row * 128 + k + rep) & 0x7fff);
        }
        __syncthreads();
        for (int idx = tid; idx < 64 * 128; idx += 512) {
            const int row = idx >> 7, kk = idx & 127;
            const bf16_t got = *(const LAS bf16_t*)(lds + off_b(row, kk >> 3) + 2 * (kk & 7));
            if (got != (bf16_t)((row * 128 + kk + rep) & 0x7fff)) ++bad;
        }
        __syncthreads();
    }
    if (bad) atomicAdd(cnt, bad);
}
__device__ __forceinline__ void dbg_emit5(const unsigned* cnt, float* out) {
    const unsigned c = cnt[0];
    float code = 0.f;
    if (c) { float lg = log10f((float)c); code = 1.0f + (lg > 8.9f ? 8.9f : lg); }
    const float cc = sqrtf(code);
    const size_t n = (size_t)MTOK * DM;
    for (size_t i = (size_t)blockIdx.x * 512 + threadIdx.x; i < n; i += (size_t)gridDim.x * 512) out[i] = cc;
}
#endif

#if SCAN_DBG == 6
__device__ __forceinline__ void dbg_check_a(LAS float* red, const float* LF, const bf16_t* I1, const bf16_t* LT, const bf16_t* LT2, float* DBG) {
    float sd = 0.f, sr = 0.f, mm = 0.f;
    const size_t n = (size_t)4096 * 16384;
    for (size_t i = (size_t)blockIdx.x * 512 + threadIdx.x; i < n; i += (size_t)gridDim.x * 512) {
        const int item = (int)(i >> 14), v = (int)((i >> 7) & 127), k = (int)(i & 127);
        const int bh = item >> 7, c = item & 127, b = bh >> 4, h = bh & 15;
        const size_t tok0 = (size_t)b * SEQ + c * 64;
        float g = 1.f, L = 0.f;
        for (int s2 = 63; s2 >= 0; --s2) {
            const size_t o = (tok0 + s2) * DM + h * 128;
            const float f = __expf(LF[o + k]);
            L += bf2f(I1[o + v]) * (1.0f - f) * g;
            g *= f;
        }
        const float x = bf2f(LT[i]);
        sd += (x - L) * (x - L); sr += L * L;
        if (LT[i] != LT2[i]) mm += 1.f;
    }
    sd = wave_sum(sd); sr = wave_sum(sr); mm = wave_sum(mm);
    const int wv = threadIdx.x >> 6;
    if ((threadIdx.x & 63) == 0) { red[wv * 4] = sd; red[wv * 4 + 1] = sr; red[wv * 4 + 2] = 0.f; red[wv * 4 + 3] = mm; }
    __syncthreads();
    if (threadIdx.x == 0) { float a = 0, b2 = 0, d = 0; for (int w = 0; w < 8; ++w) { a += red[w * 4]; b2 += red[w * 4 + 1]; d += red[w * 4 + 3]; }
        DBG[blockIdx.x * 4] = a; DBG[blockIdx.x * 4 + 1] = b2; DBG[blockIdx.x * 4 + 2] = 0.f; DBG[blockIdx.x * 4 + 3] = d; }
    __syncthreads();
}
#endif

#if SCAN_DBG == 7
#ifndef DBG_FAM
#define DBG_FAM 0
#endif
__device__ __forceinline__ void dbg_check_a7(const float* LF, const bf16_t* I1, const bf16_t* LT, float* DBG) {
    const size_t n = (size_t)4096 * 16384;
    float nbad = 0.f, nnf = 0.f;
    for (size_t i = (size_t)blockIdx.x * 512 + threadIdx.x; i < n; i += (size_t)gridDim.x * 512 * 8) {
        const int item = (int)(i >> 14), v = (int)((i >> 7) & 127), k = (int)(i & 127);
        const int bh = item >> 7, c = item & 127, b = bh >> 4, h = bh & 15;
        const size_t tok0 = (size_t)b * SEQ + c * 64;
        float g = 1.f, L = 0.f;
        for (int s2 = 63; s2 >= 0; --s2) {
            const size_t o = (tok0 + s2) * DM + h * 128;
            const float f = __expf(LF[o + k]);
            L += bf2f(I1[o + v]) * (1.0f - f) * g;
            g *= f;
        }
        const float x = bf2f(LT[i]);
        if (!(x - x == 0.f)) { nnf += 1.f; nbad += 1.f; }
        else if (fabsf(x - L) > 0.02f * fabsf(L) + 1e-2f) nbad += 1.f;
    }
    nbad = wave_sum(nbad); nnf = wave_sum(nnf);
    if ((threadIdx.x & 63) == 0) { atomicAdd(DBG, nbad); atomicAdd(DBG + 1, nnf); }
}
__device__ __forceinline__ void dbg_emit7(const float* DBG, float* out) {
    const float nb = DBG[0], nf = DBG[1];
    int A = nb == 0.f ? 0 : (nb <= 100.f ? 1 : (nb <= 1e4f ? 3 : (nb <= 1e6f ? 5 : 7)));
    int B = nf == 0.f ? 0 : 5;
    const float cc = sqrtf((float)A + 0.1f * (float)B);
    const size_t n = (size_t)MTOK * DM;
    for (size_t i = (size_t)blockIdx.x * 512 + threadIdx.x; i < n; i += (size_t)gridDim.x * 512) out[i] = cc;
}
#endif
__device__ __forceinline__ int opaque(int v) { asm volatile("" : "+s"(v)); return v; }
template <bool L1> __device__ __forceinline__ void run_gemm_out(const Args& a, LAS unsigned char* lds) {
    unsigned char* ws = a.ws;
    pg8::Gemm g{(const bf16_t*)(ws + (L1 ? slot(3) : slot(0))), (const bf16_t*)(ws + (L1 ? WS_WO : WS_WOUT)), opaque(MTOK), opaque(DM), opaque(DM)};
    pg8::StaticOrder S; S.init(g.M, g.N, (int)gridDim.x, (int)blockIdx.x);
    EpiF32 E{(float*)(ws + (L1 ? slot(4) : slot(1))), DM};
    pg8::gemm_phase<EpiF32, pg8::StaticOrder>(lds, g, S, E, nullptr);
}
template <bool L1> __device__ __forceinline__ void run_ln(const Args& a) {
    unsigned char* ws = a.ws;
    phase_ln<L1>((const float*)(ws + (L1 ? slot(4) : slot(1))), L1 ? (const void*)(ws + slot(2)) : (const void*)a.in[0], a.in[12] + (L1 ? 2 : 0) * DM, a.in[13] + (L1 ? 2 : 0) * DM,
                 (float*)nullptr, (bf16_t*)(ws + (L1 ? slot(8) : slot(5))), (signed char*)(ws + WS_XQ), (float*)(ws + WS_XS));
}
template <bool L1> __device__ __forceinline__ void run_gemm_sc(const Args& a, LAS unsigned char* lds) {
    unsigned char* ws = a.ws;
    pg8::Gemm g{(const bf16_t*)(ws + WS_WC) + (L1 ? (size_t)DM * DM : 0), (const bf16_t*)(ws + (L1 ? slot(8) : slot(5))), opaque(DM), opaque(MTOK), opaque(DM)};
    pg8::StaticOrder S; S.init(g.M, g.N, (int)gridDim.x, (int)blockIdx.x);
    EpiF32 E{(float*)(ws + (L1 ? slot(0) : slot(6))), MTOK};
    pg8::gemm_phase<EpiF32, pg8::StaticOrder>(lds, g, S, E, nullptr);
}
template <bool L1> __device__ __forceinline__ void run_topk(const Args& a, LAS unsigned char* lds) {
    unsigned char* ws = a.ws;
    phase_topk(lds, (const float*)(ws + (L1 ? slot(0) : slot(6))), (int*)(ws + WS_EID), (float*)(ws + WS_GATE));
}
template <bool L1> __device__ __forceinline__ void run_peer(const Args& a, LAS unsigned char* lds) {
    unsigned char* ws = a.ws;
    LAS int* HL = (LAS int*)(lds + (threadIdx.x >> 6) * 8192);
    float* Y = (float*)(ws + (L1 ? slot(0) : slot(6)));
    phase_peer_u((const signed char*)(ws + WS_XQ), (const int*)(ws + WS_EID), ws + WS_UB + (L1 ? (size_t)16384 * DM : 0), HL);
    asm volatile("s_waitcnt vmcnt(0) lgkmcnt(0)" ::: "memory");
    phase_peer_w(HL, (const float*)(ws + WS_XS), (const int*)(ws + WS_EID), (const float*)(ws + WS_GATE),
                 (const float*)(ws + WS_USC) + (L1 ? 16384 : 0), (const float*)(ws + WS_VSC) + (L1 ? 16384 : 0), (float*)(ws + WS_W), (float*)(ws + WS_CS));
    asm volatile("s_waitcnt vmcnt(0)" ::: "memory");
    phase_peer_v((const bf16_t*)(ws + (L1 ? slot(8) : slot(5))), (const int*)(ws + WS_EID), (const float*)(ws + WS_W), (const float*)(ws + WS_CS),
                 ws + WS_VB + (L1 ? (size_t)16384 * DM : 0), Y);
    asm volatile("s_waitcnt vmcnt(0)" ::: "memory");
    {
        const int lane = threadIdx.x & 63, gw = blockIdx.x * 8 + (threadIdx.x >> 6), nw = gridDim.x * 8, tpw = (MTOK + nw - 1) / nw, tbase = gw * tpw;
        const int tend = tbase + tpw < MTOK ? tbase + tpw : MTOK;
        const float* g = a.in[12] + (L1 ? 3 : 1) * DM; const float* bta = a.in[13] + (L1 ? 3 : 1) * DM;
        float* outf = L1 ? a.out : (float*)nullptr; bf16_t* outb = L1 ? (bf16_t*)nullptr : (bf16_t*)(ws + slot(2));
        for (int row = tbase; row < tend; ++row) {
            float v[32];
            const float* p = Y + (size_t)row * DM;
#pragma unroll
            for (int i = 0; i < 4; ++i) {
                const f32x4 x0 = *(const f32x4*)(p + 512 * i + 8 * lane), x1 = *(const f32x4*)(p + 512 * i + 8 * lane + 4);
#pragma unroll
                for (int j = 0; j < 4; ++j) { v[i * 8 + j] = x0[j]; v[i * 8 + 4 + j] = x1[j]; }
            }
            ln_row_store(v, g, bta, outf ? outf + (size_t)row * DM : nullptr, outb ? outb + (size_t)row * DM : nullptr, lane);
        }
    }
}


#define XB_TMO      128
#define XB_XCNT(j)  (256  + 64 * (j))
#define XB_XSUB(j)  (1280 + 64 * (j))
#define XB_XGEN(j)  (2304 + 64 * (j))
#define XB_TOP      3328
#define XB_TOPGEN   3392
#define XCD_BAR_WORDS 3456
#define XB_SPIN_CAP (1u << 20)
__device__ __forceinline__ unsigned xb_ld(unsigned* p)              { return __hip_atomic_load(p, __ATOMIC_RELAXED, __HIP_MEMORY_SCOPE_AGENT); }
__device__ __forceinline__ unsigned xb_add(unsigned* p, unsigned v) { return __hip_atomic_fetch_add(p, v, __ATOMIC_RELAXED, __HIP_MEMORY_SCOPE_AGENT); }
__device__ __forceinline__ unsigned xb_xcc_id() { return (unsigned)__builtin_amdgcn_s_getreg((3 << 11) | 20) & 0xFu; }
#define XB_SPIN(cond, bar) do { unsigned _sp = 0; while (cond) { __builtin_amdgcn_s_sleep(1); \
    if ((++_sp & 255u) == 0u) { if (xb_ld(&(bar)[XB_TMO])) break; if (_sp > XB_SPIN_CAP) { atomicAdd(&(bar)[XB_TMO], 1u); break; } } } } while (0)
struct XcdBarrier { unsigned* bar; unsigned x; volatile LAS unsigned* st; };
__device__ __forceinline__ XcdBarrier xcd_barrier_post(unsigned* bar, volatile LAS unsigned* st) {
    XcdBarrier b; b.bar = bar; b.x = xb_xcc_id(); b.st = st;
    if (threadIdx.x == 0) (void)xb_add(&bar[XB_XCNT(b.x)], 1u);
    return b;
}
__device__ __forceinline__ void xcd_barrier_complete(unsigned* bar, unsigned x, unsigned& nloc, unsigned& nx) {
    const unsigned G = gridDim.x * gridDim.y * gridDim.z;
    unsigned sum, cnt, mine, sp = 0u;
    for (;;) {
        sum = 0u; cnt = 0u; mine = 0u;
#pragma unroll
        for (unsigned j = 0; j < 16; ++j) { const unsigned c = xb_ld(&bar[XB_XCNT(j)]); sum += c; cnt += (c > 0u) ? 1u : 0u; mine = (j == x) ? c : mine; }
        if (sum == G) break;
        __builtin_amdgcn_s_sleep(1);
        if ((++sp & 255u) == 0u) { if (xb_ld(&bar[XB_TMO])) break; if (sp > XB_SPIN_CAP) { atomicAdd(&bar[XB_TMO], 1u); break; } }
    }
    nloc = mine > 0u ? mine : 1u; nx = cnt > 0u ? cnt : 1u;
}
__device__ __forceinline__ void xcd_barrier(const XcdBarrier& b) {
    asm volatile("s_waitcnt vmcnt(0)" ::: "memory");
    __syncthreads();
    if (threadIdx.x == 0) {
        unsigned* bar = b.bar;
        __builtin_amdgcn_s_waitcnt(0);
        unsigned nloc = b.st[0], nx = b.st[1];
        if (nloc == 0u) { xcd_barrier_complete(bar, b.x, nloc, nx); b.st[0] = nloc; b.st[1] = nx; }
        const unsigned old = xb_add(&bar[XB_XSUB(b.x)], 1u);
        const unsigned gen = old / nloc;
        if (old + 1u == (gen + 1u) * nloc) {
            __builtin_amdgcn_fence(__ATOMIC_RELEASE, "agent");
            asm volatile("s_waitcnt vmcnt(0)" ::: "memory");
            const unsigned og = xb_add(&bar[XB_TOP], 1u);
            const unsigned tg = og / nx;
            if (og + 1u == (tg + 1u) * nx) xb_add(&bar[XB_TOPGEN], 1u);
            else XB_SPIN(xb_ld(&bar[XB_TOPGEN]) == tg, bar);
            __builtin_amdgcn_fence(__ATOMIC_ACQUIRE, "agent");
            xb_add(&bar[XB_XGEN(b.x)], 1u);
            asm volatile("s_waitcnt vmcnt(0)" ::: "memory");
        } else {
            XB_SPIN(xb_ld(&bar[XB_XGEN(b.x)]) == gen, bar);
            __builtin_amdgcn_fence(__ATOMIC_ACQUIRE, "agent");
            asm volatile("s_waitcnt vmcnt(0)" ::: "memory");
        }
    }
    __syncthreads();
}

__global__ void __launch_bounds__(512, 2) mk_fwd(Args a) {
    extern __shared__ __attribute__((aligned(16))) unsigned char lds_raw[];
    LAS unsigned char* lds = (LAS unsigned char*)lds_raw;
    cg::grid_group grid = cg::this_grid();
    unsigned char* ws = a.ws;
#define PHASE_BEGIN(k) if (a.ph_lo <= (k) && (k) < a.ph_hi && EN(k)) {
    volatile LAS unsigned* xb_st = (volatile LAS unsigned*)(lds + LDS_BYTES - 16);
    if (threadIdx.x < 4) xb_st[threadIdx.x] = 0u;
    unsigned* xb_words = (unsigned*)(ws + WS_BAR);
    if (a.ph_lo == 0 && blockIdx.x == 0) for (int i = threadIdx.x; i < XCD_BAR_WORDS; i += 512) xb_words[i] = 0u;
    __syncthreads();
    XcdBarrier xbar; xbar.bar = xb_words; xbar.x = 0u; xbar.st = xb_st;
    bool xb_posted = false;
#define PHASE_END(k) if ((k) + 1 < a.ph_hi) { \
        if (!xb_posted) { asm volatile("s_waitcnt vmcnt(0)" ::: "memory"); __syncthreads(); grid.sync(); if (threadIdx.x < 64) { __builtin_amdgcn_fence(__ATOMIC_ACQUIRE, "agent"); asm volatile("s_waitcnt vmcnt(0)" ::: "memory"); } __syncthreads(); \
                          xbar = xcd_barrier_post(xb_words, xb_st); xb_posted = true; } \
        else xcd_barrier(xbar); } }
    PHASE_BEGIN(0) phase_prep(a, lds);
#if SCAN_DBG == 3 || SCAN_DBG == 5
        if (blockIdx.x == 0 && threadIdx.x < 8) ((unsigned*)(ws + WS_CTR + 8192))[threadIdx.x] = 0u;
#endif
#if SCAN_DBG == 7
        if (blockIdx.x == 0 && threadIdx.x < 32) ((float*)(ws + WS_CTR + 4096))[threadIdx.x] = 0.f;
#endif
    PHASE_END(0)
#if SCAN_DBG == 5
    PHASE_BEGIN(1) dbg_lds16_test(lds, (unsigned*)(ws + WS_CTR + 8192)); PHASE_END(1)
#define SKIP_REST 1
#endif
    PHASE_BEGIN(1) {
        pg8::Gemm g{(const bf16_t*)(ws + slot(0)), (const bf16_t*)(ws + WS_WIN), opaque(MTOK), opaque(4 * DM), opaque(DM)};
        pg8::StaticOrder S; S.init(g.M, g.N, (int)gridDim.x, (int)blockIdx.x);
        EpiKVQ E{(bf16_t*)(ws + slot(1)), (bf16_t*)(ws + slot(2)), (bf16_t*)(ws + slot(3))};
        pg8::gemm_phase<EpiKVQ, pg8::StaticOrder>(lds, g, S, E, nullptr);
    } PHASE_END(1)
    PHASE_BEGIN(2) phase_scan_a(lds, (const bf16_t*)(ws + slot(2)), (const float*)(ws + WS_LB), (const bf16_t*)(ws + slot(3)), (bf16_t*)(ws + slot(6)), (float*)(ws + WS_DEC)
#if SCAN_DBG == 3
        , (unsigned*)(ws + WS_CTR + 8192)
#endif
        );
#if SCAN_DBG == 7
        asm volatile("s_waitcnt vmcnt(0)" ::: "memory"); __syncthreads(); grid.sync(); if (threadIdx.x < 64) { __builtin_amdgcn_fence(__ATOMIC_ACQUIRE, "agent"); asm volatile("s_waitcnt vmcnt(0)" ::: "memory"); } __syncthreads();
        dbg_check_a7((const float*)(ws + slot(4)), (const bf16_t*)(ws + slot(2)), (const bf16_t*)(ws + slot(6)), (float*)(ws + WS_CTR + 4096));
#endif
#if SCAN_DBG == 6
#define DSYNC6() asm volatile("s_waitcnt vmcnt(0)" ::: "memory"); __syncthreads(); grid.sync(); if (threadIdx.x < 64) { __builtin_amdgcn_fence(__ATOMIC_ACQUIRE, "agent"); asm volatile("s_waitcnt vmcnt(0)" ::: "memory"); } __syncthreads();
        DSYNC6()
        phase_scan_a(lds, (const bf16_t*)(ws + slot(2)), (const float*)(ws + WS_LB), (const bf16_t*)(ws + slot(3)), (bf16_t*)a.out, (float*)(ws + WS_DEC));
        DSYNC6()
        dbg_check_a((LAS float*)lds, (const float*)(ws + slot(4)), (const bf16_t*)(ws + slot(2)), (const bf16_t*)(ws + slot(6)), (const bf16_t*)a.out, (float*)(ws + WS_CTR + 4096));
#endif
#if SCAN_DBG == 3
        asm volatile("s_waitcnt vmcnt(0)" ::: "memory"); __syncthreads(); grid.sync();
        dbg_count_bf16((const bf16_t*)(ws + slot(6)), (size_t)4096 * 16384, (unsigned*)(ws + WS_CTR + 8192) + 2);
#endif
    PHASE_END(2)
    PHASE_BEGIN(3) phase_scan_b((bf16_t*)(ws + slot(6)), (const float*)(ws + WS_DEC));
#if SCAN_DBG == 3
        asm volatile("s_waitcnt vmcnt(0)" ::: "memory"); __syncthreads(); grid.sync();

#endif
    PHASE_END(3)
    PHASE_BEGIN(4) phase_scan_c(lds, (const bf16_t*)(ws + slot(1)), (const bf16_t*)(ws + slot(2)), (const float*)(ws + WS_LB), (const bf16_t*)(ws + slot(3)), (const bf16_t*)(ws + slot(4)), (const bf16_t*)(ws + slot(6)), a.in[2], (bf16_t*)(ws + slot(0)));
#if SCAN_DBG == 1
        asm volatile("s_waitcnt vmcnt(0)" ::: "memory"); __syncthreads(); grid.sync();
        phase_scan_naive((const bf16_t*)(ws + slot(1)), (const float*)(ws + slot(4)), (const bf16_t*)(ws + slot(2)), (float*)(ws + slot(6)));
        asm volatile("s_waitcnt vmcnt(0)" ::: "memory"); __syncthreads(); grid.sync();
        phase_onorm((const float*)(ws + slot(6)), (const bf16_t*)(ws + slot(3)), a.in[2], (bf16_t*)(ws + slot(0)));
#endif
#if SCAN_DBG == 3
        asm volatile("s_waitcnt vmcnt(0)" ::: "memory"); __syncthreads(); grid.sync();

#endif
#if SCAN_DBG == 4
#define DSYNC() asm volatile("s_waitcnt vmcnt(0)" ::: "memory"); __syncthreads(); grid.sync(); if (threadIdx.x < 64) { __builtin_amdgcn_fence(__ATOMIC_ACQUIRE, "agent"); asm volatile("s_waitcnt vmcnt(0)" ::: "memory"); } __syncthreads();
        DSYNC()
        phase_scan_naive((const bf16_t*)(ws + slot(1)), (const float*)(ws + slot(4)), (const bf16_t*)(ws + slot(2)), (float*)(ws + slot(6)));
        DSYNC()
        phase_onorm((const float*)(ws + slot(6)), (const bf16_t*)(ws + slot(3)), a.in[2], (bf16_t*)(ws + slot(8)));
        DSYNC()
        phase_scan_a(lds, (const bf16_t*)(ws + slot(2)), (const float*)(ws + WS_LB), (const bf16_t*)(ws + slot(3)), (bf16_t*)(ws + slot(6)), (float*)(ws + WS_DEC));
        DSYNC()
        phase_scan_b((bf16_t*)(ws + slot(6)), (const float*)(ws + WS_DEC));
        DSYNC()
        phase_scan_c(lds, (const bf16_t*)(ws + slot(1)), (const bf16_t*)(ws + slot(2)), (const float*)(ws + WS_LB), (const bf16_t*)(ws + slot(3)), (const bf16_t*)(ws + slot(4)), (const bf16_t*)(ws + slot(6)), a.in[2], (bf16_t*)a.out);
        DSYNC()
        dbg_compare4((LAS float*)lds, (const bf16_t*)(ws + slot(0)), (const bf16_t*)(ws + slot(8)), (const bf16_t*)a.out, (float*)(ws + WS_CTR + 4096));
#endif
#if SCAN_DBG == 2
        asm volatile("s_waitcnt vmcnt(0)" ::: "memory"); __syncthreads(); grid.sync();
        phase_scan_naive((const bf16_t*)(ws + slot(1)), (const float*)(ws + slot(4)), (const bf16_t*)(ws + slot(2)), (float*)(ws + slot(6)));
        asm volatile("s_waitcnt vmcnt(0)" ::: "memory"); __syncthreads(); grid.sync();
        phase_onorm((const float*)(ws + slot(6)), (const bf16_t*)(ws + slot(3)), a.in[2], (bf16_t*)(ws + slot(8)));
        asm volatile("s_waitcnt vmcnt(0)" ::: "memory"); __syncthreads(); grid.sync();
        dbg_compare((LAS float*)lds, (const bf16_t*)(ws + slot(0)), (const bf16_t*)(ws + slot(8)), (float*)(ws + WS_CTR + 4096));
#endif
    PHASE_END(4)
    PHASE_BEGIN(5) run_gemm_out<false>(a, lds); PHASE_END(5)
    PHASE_BEGIN(6) run_ln<false>(a); PHASE_END(6)
    PHASE_BEGIN(7) run_gemm_sc<false>(a, lds); PHASE_END(7)
    PHASE_BEGIN(8) run_topk<false>(a, lds); PHASE_END(8)
    PHASE_BEGIN(9) run_peer<false>(a, lds); PHASE_END(9)
    PHASE_BEGIN(10) {
        pg8::Gemm g{(const bf16_t*)(ws + slot(2)), (const bf16_t*)(ws + WS_WKVQ), opaque(MTOK), opaque(3 * DM), opaque(DM)};
        pg8::StaticOrder S; S.init(g.M, g.N, (int)gridDim.x, (int)blockIdx.x);
        EpiKVQR E{(bf16_t*)(ws + slot(3)), (const float*)(ws + WS_COS), (const float*)(ws + WS_SIN)};
        pg8::gemm_phase<EpiKVQR, pg8::StaticOrder>(lds, g, S, E, nullptr);
    } PHASE_END(10)
    PHASE_BEGIN(11) phase_kstat((LAS float*)lds, (const bf16_t*)(ws + slot(3)), (float*)(ws + WS_KMEAN), (float*)(ws + WS_KNMAX)); PHASE_END(11)
    PHASE_BEGIN(12) phase_sel(lds, (const bf16_t*)(ws + slot(5)), (const float*)(ws + WS_KMEAN), (unsigned short*)(ws + WS_SUB), (int*)(ws + WS_CNT), (int*)(ws + WS_CTR)); PHASE_END(12)
    PHASE_BEGIN(13) phase_att(lds, (const bf16_t*)(ws + slot(5)), (const bf16_t*)(ws + slot(3)), (const bf16_t*)(ws + slot(4)), (const float*)(ws + WS_KNMAX), (const unsigned short*)(ws + WS_SUB),
                              (const int*)(ws + WS_CNT), (int*)(ws + WS_CTR), (bf16_t*)(ws + slot(6)), (bf16_t*)(ws + slot(0)), (float*)(ws + WS_LS)); PHASE_END(13)
    PHASE_BEGIN(14) phase_comb((const bf16_t*)(ws + slot(6)), (const bf16_t*)(ws + slot(0)), (const float*)(ws + WS_LS), (bf16_t*)(ws + slot(3))); PHASE_END(14)
    PHASE_BEGIN(15) run_gemm_out<true>(a, lds); PHASE_END(15)
    PHASE_BEGIN(16) run_ln<true>(a); PHASE_END(16)
    PHASE_BEGIN(17) run_gemm_sc<true>(a, lds); PHASE_END(17)
    PHASE_BEGIN(18) run_topk<true>(a, lds); PHASE_END(18)
#if SCAN_DBG == 7
    PHASE_BEGIN(19) dbg_emit7((const float*)(ws + WS_CTR + 4096), a.out); PHASE_END(19)
#elif SCAN_DBG == 6
    PHASE_BEGIN(19) dbg_emit4((const float*)(ws + WS_CTR + 4096), a.out); PHASE_END(19)
#elif SCAN_DBG == 5
    PHASE_BEGIN(19) dbg_emit5((const unsigned*)(ws + WS_CTR + 8192), a.out); PHASE_END(19)
#elif SCAN_DBG == 4
    PHASE_BEGIN(19) dbg_emit4((const float*)(ws + WS_CTR + 4096), a.out); PHASE_END(19)
#elif SCAN_DBG == 3
    PHASE_BEGIN(19) dbg_emit3((const unsigned*)(ws + WS_CTR + 8192), a.out); PHASE_END(19)
#elif SCAN_DBG == 2
    PHASE_BEGIN(19) dbg_emit((const float*)(ws + WS_CTR + 4096), a.out); PHASE_END(19)
#else
    PHASE_BEGIN(19) run_peer<true>(a, lds); PHASE_END(19)
#endif
}

extern "C" void kernel_launch(void* const* d_in, const int* in_sizes, int n_in, void* d_out, int out_size, void* d_ws, size_t ws_size, hipStream_t stream) {
    static int grid = 0;
    if (grid == 0) {
        if (n_in != 14 || out_size != MTOK * DM || ws_size < WS_END) { fprintf(stderr, "kernel_launch: unexpected shapes (n_in %d, out %d, ws %zu)\n", n_in, out_size, ws_size); grid = -1; return; }
        int dev = 0, cus = 0, per_cu = 0;
        if (hipGetDevice(&dev) != hipSuccess || hipDeviceGetAttribute(&cus, hipDeviceAttributeMultiprocessorCount, dev) != hipSuccess) { grid = -1; return; }
        if (hipFuncSetAttribute((const void*)mk_fwd, hipFuncAttributeMaxDynamicSharedMemorySize, LDS_BYTES) != hipSuccess) { fprintf(stderr, "kernel_launch: hipFuncSetAttribute failed\n"); grid = -1; return; }
        if (hipOccupancyMaxActiveBlocksPerMultiprocessor(&per_cu, (const void*)mk_fwd, 512, LDS_BYTES) != hipSuccess || per_cu < 1) { fprintf(stderr, "kernel_launch: occupancy query failed (%d)\n", per_cu); (void)hipGetLastError(); per_cu = 1; }
        grid = cus * (per_cu > 1 ? 1 : per_cu);
    }
    if (grid < 0) return;
    Args a{};
    for (int i = 0; i < 14; ++i) a.in[i] = (const float*)d_in[i];
    a.out = (float*)d_out; a.ws = (unsigned char*)d_ws;
#if ONE_LAUNCH
    a.ph_lo = 0; a.ph_hi = NPH;
    void* args[] = {&a};
    hipError_t e = hipLaunchCooperativeKernel((const void*)mk_fwd, dim3(grid), dim3(512), args, LDS_BYTES, stream);
    if (e != hipSuccess) fprintf(stderr, "cooperative launch failed: %s (grid %d)\n", hipGetErrorString(e), grid);
#else
    for (int ph = 0; ph < NPH; ++ph) {
        a.ph_lo = ph; a.ph_hi = ph + 1;
        hipLaunchKernelGGL(mk_fwd, dim3(grid), dim3(512), LDS_BYTES, stream, a);
    }
#endif
}
```

```cpp
#define ONE_LAUNCH 1
#include <hip/hip_runtime.h>
#include <hip/hip_cooperative_groups.h>
#include <cstdio>
namespace cg = cooperative_groups;

#ifndef ONE_LAUNCH
#define ONE_LAUNCH 0
#endif
#ifndef SCAN_DBG
#define SCAN_DBG 0
#endif
#ifndef SCAN_A_VALU
#define SCAN_A_VALU 0
#endif
#ifndef ENMASK
#define ENMASK 0xffffffffu
#endif
#define EN(k) ((ENMASK >> (k)) & 1u)

namespace pg8 {
#define PG8_LAS __attribute__((address_space(3)))
typedef unsigned short bf16_t;
typedef short bf16x8 __attribute__((ext_vector_type(8)));
typedef float f32x4 __attribute__((ext_vector_type(4)));
typedef unsigned u32x4 __attribute__((ext_vector_type(4)));
constexpr int BM = 256, BK = 64, HALF = 128, HTB = HALF * BK * 2  , STAGE_BYTES = 8 * HTB, NXCD = 8, WGM = 8;

__host__ __device__ __forceinline__ int lds_byte(int r, int c) { const int st = (r >> 4) * 2 + (c >> 5), rr = r & 15, cc = c & 31, ob = rr * 64 + cc * 2; return st * 1024 + (ob ^ (((ob >> 9) & 1) << 5)); }
__host__ __device__ __forceinline__ void stage_rc(int b, int& R, int& C) { const int st = b / 1024, sb = b % 1024, swz = sb ^ (((sb >> 9) & 1) << 5); R = (st >> 1) * 16 + swz / 64; C = (st & 1) * 32 + (swz % 64) / 2; }
__host__ __device__ __forceinline__ int perm32(int rho) { const int n = rho >> 4, i = rho & 15; return 8 * (i >> 2) + 4 * n + (i & 3); }

struct Unit { int pm, pn; };
struct Gemm { const bf16_t* A; const bf16_t* Bt; int M, N, K; };

struct StaticOrder {
    int nM, nN, nwg, G, c;
    __host__ __device__ void init(int M, int N, int G_, int c_) { nM = M / BM; nN = N / BM; nwg = nM * nN; G = G_; c = c_; }
    __host__ __device__ bool next(int i, Unit& u) const {
        const long L = (long)i * G + c; if (L >= nwg) return false;
        int wgid = (int)L; { const int q = nwg / NXCD, r = nwg % NXCD, xcd = wgid % NXCD, off = wgid / NXCD; wgid = (xcd < r ? xcd * (q + 1) : r * (q + 1) + (xcd - r) * q) + off; }
        const int nig = WGM * nN, gid = wgid / nig, fm = gid * WGM, gsz = (nM - fm) < WGM ? (nM - fm) : WGM;
        u.pm = fm + ((wgid % nig) % gsz); u.pn = (wgid % nig) / gsz; return true;
    }
    __device__ __forceinline__ void a_ready(const Unit&) const {}
    __device__ __forceinline__ void done(const Unit&) const {}
};
struct CountedOrder : StaticOrder {
    const unsigned* ready; unsigned need; unsigned* tmo;
    __device__ __forceinline__ void a_ready(const Unit& u) const {
        if (threadIdx.x < 64) {
            const unsigned long long t0 = __builtin_amdgcn_s_memrealtime(); unsigned polls = 0;
            while ((unsigned)__builtin_amdgcn_readfirstlane(__hip_atomic_load(ready + 64 * u.pm, __ATOMIC_RELAXED, __HIP_MEMORY_SCOPE_AGENT)) < need) {
                if ((++polls & 255u) == 0u && __builtin_amdgcn_readfirstlane(__hip_atomic_load(tmo, __ATOMIC_RELAXED, __HIP_MEMORY_SCOPE_AGENT)) != 0u) break;
                if (__builtin_amdgcn_s_memrealtime() - t0 > 2000000ull) {
                    if (threadIdx.x == 0) { unsigned expect = 0u; __hip_atomic_compare_exchange_strong(tmo + 1, &expect, 0x600u | (unsigned)(u.pm & 0xff), __ATOMIC_RELAXED, __ATOMIC_RELAXED, __HIP_MEMORY_SCOPE_AGENT); __hip_atomic_store(tmo, 1u, __ATOMIC_RELAXED, __HIP_MEMORY_SCOPE_AGENT); }
                    break; }
                __builtin_amdgcn_s_sleep(2); }
            __builtin_amdgcn_fence(__ATOMIC_ACQUIRE, "agent");
            asm volatile("s_waitcnt vmcnt(0)" ::: "memory");
        }
#if !defined(BROKEN_HOOK_NO_BARRIER)
        asm volatile("" ::: "memory"); __builtin_amdgcn_s_barrier(); asm volatile("" ::: "memory");
#endif
    }
};

__device__ __forceinline__ unsigned cvt_pk_bf16(float lo, float hi) { unsigned r; asm volatile("v_cvt_pk_bf16_f32 %0, %1, %2" : "=v"(r) : "v"(lo), "v"(hi)); return r; }
typedef float f32x2 __attribute__((ext_vector_type(2)));
__device__ __forceinline__ f32x2 gelu_pk(f32x2 v) {
    const f32x2 av = __builtin_elementwise_abs(v), d = av * 0.2316418882f + 1.0f;
    f32x2 t; t.x = __builtin_amdgcn_rcpf(d.x); t.y = __builtin_amdgcn_rcpf(d.y);
    f32x2 q = t * 0.5307027145f + (-0.7265760135f); q = q * t + 0.7107068705f; q = q * t + (-0.142248368f); q = q * t + 0.127414796f; q = q * t;
    const f32x2 s = (v * v) * (-0.72134752044f);
    f32x2 e; e.x = __builtin_amdgcn_exp2f(s.x); e.y = __builtin_amdgcn_exp2f(s.y);
    const f32x2 m = v * (q * e), r = v - m;
    f32x2 o; o.x = v.x < 0.f ? m.x : r.x; o.y = v.y < 0.f ? m.y : r.y; return o;
}

struct EpiF32 {
    static constexpr bool PERM = false, AFTER_DRAIN = false;
    float* C; int ldc; const float* bias;
    __device__ __forceinline__ void operator()(const f32x4 (&acc)[2][2][4][2], const Unit& u, int wr, int wc, int fr, int fq) const {
        const int row0 = u.pm * BM + wr * 64 + fr, col0 = u.pn * BM + wc * 32 + 4 * fq;
        f32x4 bv[2][2];
#pragma unroll
        for (int bj = 0; bj < 2; ++bj)
#pragma unroll
            for (int n = 0; n < 2; ++n) bv[bj][n] = bias ? *(const f32x4*)(bias + col0 + bj * HALF + n * 16) : (f32x4){0.f, 0.f, 0.f, 0.f};
#pragma unroll
        for (int ai = 0; ai < 2; ++ai)
#pragma unroll
            for (int m = 0; m < 4; ++m) { float* rowp = C + (size_t)(row0 + ai * HALF + m * 16) * ldc + col0;
#pragma unroll
                for (int bj = 0; bj < 2; ++bj)
#pragma unroll
                    for (int n = 0; n < 2; ++n) *(f32x4*)(rowp + bj * HALF + n * 16) = acc[ai][bj][m][n] + bv[bj][n]; }
    }
};
template <int ACT  > struct EpiBf16 {
    static constexpr bool PERM = true, AFTER_DRAIN = false;
    bf16_t* O; int ldc; const float* bias; int split_cols; size_t split_stride;
    __device__ __forceinline__ void operator()(const f32x4 (&acc)[2][2][4][2], const Unit& u, int wr, int wc, int fr, int fq) const {
        const int row0 = u.pm * BM + wr * 64 + fr; int colt = u.pn * BM; bf16_t* base = O;
        if (split_cols) { const int t = colt / split_cols; base += (size_t)t * split_stride; colt -= t * split_cols; }
        const int col0 = colt + wc * 32 + 8 * fq, bcol0 = u.pn * BM + wc * 32 + 8 * fq;
        f32x4 bv[2][2];
#pragma unroll
        for (int bj = 0; bj < 2; ++bj)
#pragma unroll
            for (int n = 0; n < 2; ++n) bv[bj][n] = bias ? *(const f32x4*)(bias + bcol0 + bj * HALF + 4 * n) : (f32x4){0.f, 0.f, 0.f, 0.f};
#pragma unroll
        for (int ai = 0; ai < 2; ++ai)
#pragma unroll
            for (int m = 0; m < 4; ++m) { bf16_t* rowp = base + (size_t)(row0 + ai * HALF + m * 16) * ldc + col0;
#pragma unroll
                for (int bj = 0; bj < 2; ++bj) { f32x4 v0 = acc[ai][bj][m][0] + bv[bj][0], v1 = acc[ai][bj][m][1] + bv[bj][1];
                    if (ACT == 1) { f32x2 a = gelu_pk((f32x2){v0[0], v0[1]}), b = gelu_pk((f32x2){v0[2], v0[3]}), c = gelu_pk((f32x2){v1[0], v1[1]}), d = gelu_pk((f32x2){v1[2], v1[3]});
                        v0 = (f32x4){a.x, a.y, b.x, b.y}; v1 = (f32x4){c.x, c.y, d.x, d.y}; }
                    if (ACT == 2) {
#pragma unroll
                        for (int j = 0; j < 4; ++j) { v0[j] = 0.5f * v0[j] * (1.0f + erff(v0[j] * 0.70710678f)); v1[j] = 0.5f * v1[j] * (1.0f + erff(v1[j] * 0.70710678f)); } }
                    u32x4 w; w.x = cvt_pk_bf16(v0[0], v0[1]); w.y = cvt_pk_bf16(v0[2], v0[3]); w.z = cvt_pk_bf16(v1[0], v1[1]); w.w = cvt_pk_bf16(v1[2], v1[3]);
                    *(u32x4*)(rowp + bj * HALF) = w; } }
    }
};

template <class Epi, class Sched, bool STAMP = false>
__device__ __forceinline__ void gemm_phase(PG8_LAS unsigned char* lds, const Gemm g, const Sched& S, const Epi& E, unsigned long long* stamps) {
    const int tid = threadIdx.x, wid = __builtin_amdgcn_readfirstlane(tid >> 6), lane = tid & 63, wr = wid >> 2, wc = wid & 3, fr = lane & 15, fq = lane >> 4;
    const int K = g.K, nt = K / BK;
    int ts_lo = 0, ts_hi = 0, nts = 0; const unsigned long long rt_entry = STAMP ? (unsigned long long)wall_clock64() : 0ull;
#define PG8_STAMP() do { if (STAMP && wid == 0 && nts < 64) { const unsigned long long _c = (unsigned long long)clock64(); \
        ts_lo = (lane == nts) ? (int)(unsigned)_c : ts_lo; ts_hi = (lane == nts) ? (int)(unsigned)(_c >> 32) : ts_hi; ++nts; } } while (0)
    PG8_STAMP();
    unsigned voffA[2], voffB[2];
#pragma unroll
    for (int i = 0; i < 2; ++i) { int R, C; stage_rc(tid * 16 + i * 8192, R, C); const int Rb = Epi::PERM ? ((R & ~31) + perm32(R & 31)) : R;
        voffA[i] = (unsigned)(R * K + C) * 2u; voffB[i] = (unsigned)(Rb * K + C) * 2u; }
    const size_t kstep = (size_t)(BK * 2);
    const size_t hstep = (size_t)HALF * K * 2;
    const size_t tstep = 2 * hstep;
    const unsigned ldsw = (unsigned)wid * 1024u;
    const int aoff = lds_byte(wr * 64 + fr, fq * 8), boff = lds_byte(wc * 32 + fr, fq * 8);
#define PG8_SA(b, h) (((b) * 2 + (h)) * HTB)
#define PG8_SB(b, h) ((4 + (b) * 2 + (h)) * HTB)
#define PG8_STAGE(bufoff, gbase, voff) do { _Pragma("unroll") for (int _i = 0; _i < 2; ++_i) \
        __builtin_amdgcn_global_load_lds((const unsigned*)((const char*)(gbase) + (voff)[_i]), (PG8_LAS unsigned*)(lds + (bufoff) + ldsw + _i * 8192), 16, 0, 0); } while (0)
#define PG8_LDA(dst, b, h) do { _Pragma("unroll") for (int m = 0; m < 4; ++m) _Pragma("unroll") for (int k = 0; k < 2; ++k) dst[m][k] = *(const PG8_LAS bf16x8*)(lds + PG8_SA(b, h) + aoff + m * 2048 + k * 1024); } while (0)
#define PG8_LDB(dst, b, h) do { _Pragma("unroll") for (int n = 0; n < 2; ++n) _Pragma("unroll") for (int k = 0; k < 2; ++k) dst[n][k] = *(const PG8_LAS bf16x8*)(lds + PG8_SB(b, h) + boff + n * 2048 + k * 1024); } while (0)
#define PG8_MMA(ai, bj, At, Bt) do { __builtin_amdgcn_s_setprio(1); _Pragma("unroll") for (int m = 0; m < 4; ++m) _Pragma("unroll") for (int n = 0; n < 2; ++n) _Pragma("unroll") for (int k = 0; k < 2; ++k) \
        acc[ai][bj][m][n] = __builtin_amdgcn_mfma_f32_16x16x32_bf16(Bt[n][k], At[m][k], acc[ai][bj][m][n], 0, 0, 0); __builtin_amdgcn_s_setprio(0); } while (0)
#define PG8_WAIT_V(n) asm volatile("s_waitcnt vmcnt(" #n ")" ::: "memory")
#define PG8_WAIT_L(n) asm volatile("s_waitcnt lgkmcnt(" #n ")" ::: "memory")
#define PG8_BAR __builtin_amdgcn_s_barrier()
#define PG8_SCHED __builtin_amdgcn_sched_barrier(0)
    Unit cur, nxt; int ui = 0;
    if (!S.next(0, cur)) return;
    f32x4 acc[2][2][4][2];
#pragma unroll
    for (int a = 0; a < 2; ++a)
#pragma unroll
        for (int b = 0; b < 2; ++b)
#pragma unroll
            for (int m = 0; m < 4; ++m)
#pragma unroll
                for (int n = 0; n < 2; ++n) acc[a][b][m][n] = (f32x4){0.f, 0.f, 0.f, 0.f};
    bf16x8 At[4][2], B0[2][2], B1[2][2];
    const char* cA = (const char*)g.A + (size_t)cur.pm * tstep; const char* cB = (const char*)g.Bt + (size_t)cur.pn * tstep;
    S.a_ready(cur);
    PG8_STAGE(PG8_SB(0, 0), cB, voffB); PG8_STAGE(PG8_SA(0, 0), cA, voffA); PG8_STAGE(PG8_SB(0, 1), cB + hstep, voffB); PG8_STAGE(PG8_SA(0, 1), cA + hstep, voffA);
    if (wr == 1) PG8_BAR;
    PG8_WAIT_V(4); PG8_BAR;
    PG8_STAGE(PG8_SB(1, 0), cB + kstep, voffB); PG8_STAGE(PG8_SA(1, 0), cA + kstep, voffA); PG8_STAGE(PG8_SB(1, 1), cB + hstep + kstep, voffB);
    PG8_WAIT_V(6); PG8_BAR;
    PG8_STAMP();
    for (;;) {
        const bool has_next = S.next(ui + 1, nxt);
        const char* nA = has_next ? (const char*)g.A + (size_t)nxt.pm * tstep : cA; const char* nB = has_next ? (const char*)g.Bt + (size_t)nxt.pn * tstep : cB;
        for (int t = 0; t < nt; t += 2) {
            const bool last = (t == nt - 2);
            const char* a1 = cA + (size_t)(t + 1) * kstep;
            const char* a2 = last ? nA : cA + (size_t)(t + 2) * kstep; const char* b2 = last ? nB : cB + (size_t)(t + 2) * kstep;
            const char* a3 = a2 + kstep; const char* b3 = b2 + kstep;
            if (last && has_next) S.a_ready(nxt);
            PG8_LDB(B0, 0, 0); PG8_SCHED; PG8_LDA(At, 0, 0); PG8_STAGE(PG8_SA(1, 1), a1 + hstep, voffA);
            PG8_WAIT_L(8); PG8_BAR; PG8_WAIT_L(0); PG8_MMA(0, 0, At, B0); PG8_BAR; PG8_SCHED;
            PG8_LDB(B1, 0, 1); PG8_STAGE(PG8_SB(0, 0), b2, voffB);
            PG8_BAR; PG8_WAIT_L(0); PG8_MMA(0, 1, At, B1); PG8_BAR;
            PG8_LDA(At, 0, 1); PG8_STAGE(PG8_SA(0, 0), a2, voffA);
            PG8_BAR; PG8_WAIT_L(0); PG8_MMA(1, 0, At, B0); PG8_BAR; PG8_SCHED;
            PG8_STAGE(PG8_SB(0, 1), b2 + hstep, voffB);
            PG8_WAIT_V(6); PG8_BAR; PG8_MMA(1, 1, At, B1); PG8_BAR;
            PG8_LDB(B0, 1, 0); PG8_SCHED; PG8_LDA(At, 1, 0); PG8_STAGE(PG8_SA(0, 1), a2 + hstep, voffA);
            PG8_WAIT_L(8); PG8_BAR; PG8_WAIT_L(0); PG8_MMA(0, 0, At, B0); PG8_BAR; PG8_SCHED;
            PG8_LDB(B1, 1, 1); PG8_STAGE(PG8_SB(1, 0), b3, voffB);
            PG8_BAR; PG8_WAIT_L(0); PG8_MMA(0, 1, At, B1); PG8_BAR;
            PG8_LDA(At, 1, 1); PG8_STAGE(PG8_SA(1, 0), a3, voffA);
            PG8_BAR; PG8_WAIT_L(0); PG8_MMA(1, 0, At, B0); PG8_BAR; PG8_SCHED;
            PG8_STAGE(PG8_SB(1, 1), b3 + hstep, voffB);
            PG8_WAIT_V(6); PG8_BAR; PG8_MMA(1, 1, At, B1); PG8_BAR;
        }
        PG8_STAMP();
        if constexpr (!Epi::AFTER_DRAIN) { E(acc, cur, wr, wc, fr, fq); S.done(cur); }
        PG8_STAMP();
        if (!has_next) break;
#pragma unroll
        for (int a = 0; a < 2; ++a)
#pragma unroll
            for (int b = 0; b < 2; ++b)
#pragma unroll
                for (int m = 0; m < 4; ++m)
#pragma unroll
                    for (int n = 0; n < 2; ++n) acc[a][b][m][n] = (f32x4){0.f, 0.f, 0.f, 0.f};
        cur = nxt; cA = nA; cB = nB; ++ui;
    }
    PG8_WAIT_V(0);
    if (wr == 0) PG8_BAR;
    PG8_BAR;
    if constexpr (Epi::AFTER_DRAIN) { E.fused(acc, cur, wr, wc, fr, fq, lds, wid, lane); S.done(cur); }
    PG8_STAMP();
    if (STAMP && wid == 0) { stamps[lane] = lane < nts ? (((unsigned long long)(unsigned)ts_hi << 32) | (unsigned)ts_lo) : 0ull;
        if (lane == 62) stamps[62] = rt_entry; if (lane == 63) stamps[63] = (unsigned long long)wall_clock64(); }
#undef PG8_STAMP
#undef PG8_SA
#undef PG8_SB
#undef PG8_STAGE
#undef PG8_LDA
#undef PG8_LDB
#undef PG8_MMA
#undef PG8_WAIT_V
#undef PG8_WAIT_L
#undef PG8_BAR
#undef PG8_SCHED
}
}


#define LAS __attribute__((address_space(3)))
typedef unsigned short bf16_t;
typedef float f32x4 __attribute__((ext_vector_type(4)));
typedef unsigned u32x4 __attribute__((ext_vector_type(4)));
typedef unsigned u32x2 __attribute__((ext_vector_type(2)));
typedef short bf16x8 __attribute__((ext_vector_type(8)));
typedef short s16x4 __attribute__((ext_vector_type(4)));
typedef float f32x16 __attribute__((ext_vector_type(16)));

constexpr int MTOK = 16384, DM = 2048, SEQ = 8192, NHEAD = 16;
constexpr float ALPHA = 1.41421356237309515f;
constexpr size_t MiB = (size_t)1 << 20;
constexpr size_t WS_WIN = 0, WS_WOUT = 32 * MiB, WS_WKVQ = 40 * MiB, WS_WO = 64 * MiB, WS_WC = 72 * MiB, WS_UB = 88 * MiB, WS_VB = 152 * MiB, WS_USC = 216 * MiB, WS_VSC = 217 * MiB, WS_H = 224 * MiB, WS_XQ = 232 * MiB, WS_XS = 264 * MiB, WS_W = 272 * MiB, WS_CS = 280 * MiB, WS_SLOT = 344 * MiB;
constexpr size_t WS_EID = 920 * MiB, WS_GATE = 928 * MiB, WS_COS = 936 * MiB, WS_SIN = 938 * MiB, WS_KMEAN = 940 * MiB, WS_LB = 941 * MiB, WS_LS = 942 * MiB, WS_SUB = 946 * MiB, WS_CNT = 962 * MiB, WS_CTR = 963 * MiB, WS_DEC = 964 * MiB, WS_END = 966 * MiB;
constexpr size_t WS_BAR = WS_CTR + 65536;
constexpr size_t WS_KNMAX = WS_KMEAN + 768 * 1024;
__host__ __device__ constexpr size_t slot(int i) { return WS_SLOT + (size_t)i * 64 * MiB; }
constexpr int LDS_BYTES = 144 * 1024;
constexpr int NPH = 20;

struct Args { const float* in[14]; float* out; unsigned char* ws; int ph_lo, ph_hi; };

__device__ __forceinline__ float bflo(unsigned w) { return __uint_as_float(w << 16); }
__device__ __forceinline__ float bfhi(unsigned w) { return __uint_as_float(w & 0xffff0000u); }
__device__ __forceinline__ float bf2f(bf16_t b) { return __uint_as_float(((unsigned)b) << 16); }
typedef __bf16 bf16x2_t __attribute__((ext_vector_type(2)));
typedef float f32x2_t __attribute__((ext_vector_type(2)));
__device__ __forceinline__ unsigned pk_bf16(float lo, float hi) { const f32x2_t f = {lo, hi}; return __builtin_bit_cast(unsigned, __builtin_convertvector(f, bf16x2_t)); }
__device__ __forceinline__ float wave_sum(float v) {
#pragma unroll
    for (int o = 32; o >= 1; o >>= 1) v += __shfl_xor(v, o);
    return v;
}
__device__ __forceinline__ float wave_max(float v) {
#pragma unroll
    for (int o = 32; o >= 1; o >>= 1) v = fmaxf(v, __shfl_xor(v, o));
    return v;
}
__device__ __forceinline__ float sigmoidf_(float z) { return 1.0f / (1.0f + __expf(-z)); }


__device__ __forceinline__ void store_wt16(void* p, u32x4 v) {
    __hip_atomic_store((unsigned long long*)p, ((unsigned long long)v.y << 32) | v.x, __ATOMIC_RELAXED, __HIP_MEMORY_SCOPE_AGENT);
    __hip_atomic_store((unsigned long long*)p + 1, ((unsigned long long)v.w << 32) | v.z, __ATOMIC_RELAXED, __HIP_MEMORY_SCOPE_AGENT);
}
__device__ __forceinline__ void store_wt8(void* p, u32x2 v) {
    __hip_atomic_store((unsigned long long*)p, ((unsigned long long)v.y << 32) | v.x, __ATOMIC_RELAXED, __HIP_MEMORY_SCOPE_AGENT);
}
struct EpiIn {
    static constexpr bool PERM = true, AFTER_DRAIN = false;
    bf16_t* Q1; float* LF; bf16_t* I1; bf16_t* G1; const float* LB;
    __device__ __forceinline__ void operator()(const pg8::f32x4 (&acc)[2][2][4][2], const pg8::Unit& u, int wr, int wc, int fr, int fq) const {
        const int type = u.pn >> 3;
        const int row0 = u.pm * 256 + wr * 64 + fr, col0 = (u.pn & 7) * 256 + wc * 32 + 8 * fq;
        if (type == 1) {
#pragma unroll
            for (int bj = 0; bj < 2; ++bj) {
                const int c = col0 + bj * 128;
                const f32x4 lb0 = *(const f32x4*)(LB + c), lb1 = *(const f32x4*)(LB + c + 4);
#pragma unroll
                for (int ai = 0; ai < 2; ++ai)
#pragma unroll
                    for (int m = 0; m < 4; ++m) {
                        float* p = LF + (size_t)(row0 + ai * 128 + m * 16) * DM + c;
                        f32x4 o0, o1;
#pragma unroll
                        for (int j = 0; j < 4; ++j) {
                            o0[j] = __logf(lb0[j] + (1.0f - lb0[j]) * sigmoidf_(acc[ai][bj][m][0][j]));
                            o1[j] = __logf(lb1[j] + (1.0f - lb1[j]) * sigmoidf_(acc[ai][bj][m][1][j]));
                        }
                        *(f32x4*)p = o0; *(f32x4*)(p + 4) = o1;
                    }
            }
        } else {
            bf16_t* dst = Q1 + (size_t)(type - (type > 0 ? 1 : 0)) * ((size_t)32 << 20);
            const bool act = (type != 2);
#pragma unroll
            for (int ai = 0; ai < 2; ++ai)
#pragma unroll
                for (int m = 0; m < 4; ++m)
#pragma unroll
                    for (int bj = 0; bj < 2; ++bj) {
                        f32x4 v0 = acc[ai][bj][m][0], v1 = acc[ai][bj][m][1];
                        if (act) {
#pragma unroll
                            for (int j = 0; j < 4; ++j) { v0[j] = v0[j] * sigmoidf_(v0[j]); v1[j] = v1[j] * sigmoidf_(v1[j]); }
                        }
                        u32x4 w; w.x = pk_bf16(v0[0], v0[1]); w.y = pk_bf16(v0[2], v0[3]); w.z = pk_bf16(v1[0], v1[1]); w.w = pk_bf16(v1[2], v1[3]);
                        *(u32x4*)(dst + (size_t)(row0 + ai * 128 + m * 16) * DM + col0 + bj * 128) = w;
                    }
        }
    }
};
struct EpiRes {
    static constexpr bool PERM = false, AFTER_DRAIN = false;
    const float* res; float* Y;
    __device__ __forceinline__ void operator()(const pg8::f32x4 (&acc)[2][2][4][2], const pg8::Unit& u, int wr, int wc, int fr, int fq) const {
        const int row0 = u.pm * 256 + wr * 64 + fr, col0 = u.pn * 256 + wc * 32 + 4 * fq;
#pragma unroll
        for (int ai = 0; ai < 2; ++ai)
#pragma unroll
            for (int m = 0; m < 4; ++m) {
                const size_t off = (size_t)(row0 + ai * 128 + m * 16) * DM + col0;
#pragma unroll
                for (int bj = 0; bj < 2; ++bj)
#pragma unroll
                    for (int n = 0; n < 2; ++n) {
                        const f32x4 r = *(const f32x4*)(res + off + bj * 128 + n * 16);
                        *(f32x4*)(Y + off + bj * 128 + n * 16) = r * ALPHA + acc[ai][bj][m][n];
                    }
            }
    }
};
struct EpiF32 {
    static constexpr bool PERM = false, AFTER_DRAIN = false;
    float* C; int ldc;
    __device__ __forceinline__ void operator()(const pg8::f32x4 (&acc)[2][2][4][2], const pg8::Unit& u, int wr, int wc, int fr, int fq) const {
        const int row0 = u.pm * 256 + wr * 64 + fr, col0 = u.pn * 256 + wc * 32 + 4 * fq;
#pragma unroll
        for (int ai = 0; ai < 2; ++ai)
#pragma unroll
            for (int m = 0; m < 4; ++m) {
                float* p = C + (size_t)(row0 + ai * 128 + m * 16) * ldc + col0;
#pragma unroll
                for (int bj = 0; bj < 2; ++bj)
#pragma unroll
                    for (int n = 0; n < 2; ++n) *(f32x4*)(p + bj * 128 + n * 16) = acc[ai][bj][m][n];
            }
    }
};
struct EpiKVQ {
    static constexpr bool PERM = true, AFTER_DRAIN = false;
    bf16_t* K; bf16_t* V; bf16_t* Q;
    __device__ __forceinline__ void operator()(const pg8::f32x4 (&acc)[2][2][4][2], const pg8::Unit& u, int wr, int wc, int fr, int fq) const {
        const int t = u.pn >> 3;
        bf16_t* dst = K + (size_t)t * ((size_t)32 << 20);
        const int row0 = u.pm * 256 + wr * 64 + fr, col0 = (u.pn & 7) * 256 + wc * 32 + 8 * fq;
#pragma unroll
        for (int ai = 0; ai < 2; ++ai)
#pragma unroll
            for (int m = 0; m < 4; ++m)
#pragma unroll
                for (int bj = 0; bj < 2; ++bj) {
                    const f32x4 v0 = acc[ai][bj][m][0], v1 = acc[ai][bj][m][1];
                    u32x4 w; w.x = pk_bf16(v0[0], v0[1]); w.y = pk_bf16(v0[2], v0[3]); w.z = pk_bf16(v1[0], v1[1]); w.w = pk_bf16(v1[2], v1[3]);
                    *(u32x4*)(dst + (size_t)(row0 + ai * 128 + m * 16) * DM + col0 + bj * 128) = w;
                }
    }
};


struct EpiKVQR {
    static constexpr bool PERM = true, AFTER_DRAIN = false;
    bf16_t* K; const float* COS; const float* SIN;
    __device__ __forceinline__ void operator()(const pg8::f32x4 (&acc)[2][2][4][2], const pg8::Unit& u, int wr, int wc, int fr, int fq) const {
        const int t = u.pn >> 3;
        bf16_t* dst = K + (size_t)t * ((size_t)32 << 20);
        const int row0 = u.pm * 256 + wr * 64 + fr;
        if (t == 1) {
            const int col0 = (u.pn & 7) * 256 + wc * 32 + 8 * fq;
#pragma unroll
            for (int ai = 0; ai < 2; ++ai)
#pragma unroll
                for (int m = 0; m < 4; ++m)
#pragma unroll
                    for (int bj = 0; bj < 2; ++bj) {
                        const f32x4 v0 = acc[ai][bj][m][0], v1 = acc[ai][bj][m][1];
                        u32x4 w; w.x = pk_bf16(v0[0], v0[1]); w.y = pk_bf16(v0[2], v0[3]); w.z = pk_bf16(v1[0], v1[1]); w.w = pk_bf16(v1[2], v1[3]);
                        *(u32x4*)(dst + (size_t)(row0 + ai * 128 + m * 16) * DM + col0 + bj * 128) = w;
                    }
        } else {
            const int g = 4 * wc + fq;
#pragma unroll
            for (int ai = 0; ai < 2; ++ai)
#pragma unroll
                for (int m = 0; m < 4; ++m) {
                    const int row = row0 + ai * 128 + m * 16, pos = row & (SEQ - 1);
                    const f32x4 c = *(const f32x4*)(COS + pos * 64 + 4 * g), sn = *(const f32x4*)(SIN + pos * 64 + 4 * g);
#pragma unroll
                    for (int bj = 0; bj < 2; ++bj) {
                        const f32x4 a = acc[ai][bj][m][0], b = acc[ai][bj][m][1];
                        bf16_t* p = dst + (size_t)row * DM + ((u.pn & 7) * 2 + bj) * 128 + 4 * g;
                        u32x2 w1, w2;
                        w1.x = pk_bf16(a[0] * c[0] - b[0] * sn[0], a[1] * c[1] - b[1] * sn[1]); w1.y = pk_bf16(a[2] * c[2] - b[2] * sn[2], a[3] * c[3] - b[3] * sn[3]);
                        w2.x = pk_bf16(a[0] * sn[0] + b[0] * c[0], a[1] * sn[1] + b[1] * c[1]); w2.y = pk_bf16(a[2] * sn[2] + b[2] * c[2], a[3] * sn[3] + b[3] * c[3]);
                        *(u32x2*)p = w1; *(u32x2*)(p + 64) = w2;
                    }
                }
        }
    }
};

__host__ __device__ __forceinline__ int rot_pos(int d) { return d < 64 ? 8 * (d >> 2) + (d & 3) : 8 * ((d - 64) >> 2) + 4 + (d & 3); }
__device__ __forceinline__ void transpose_tiles(LAS float* tile, const float* src, int ldn, int K, int N, bf16_t* dst, int nperm = 0) {
    const int tid = threadIdx.x;
    const int tn = N / 64, ntiles = tn * (K / 64);
    for (int tI = blockIdx.x; tI < ntiles; tI += gridDim.x) {
        const int k0 = (tI / tn) * 64, n0 = (tI % tn) * 64;
#pragma unroll
        for (int r = 0; r < 2; ++r) {
            const int kk = (tid >> 4) + 32 * r, nn = (tid & 15) * 4;
            const f32x4 v = *(const f32x4*)(src + (size_t)(k0 + kk) * ldn + n0 + nn);
            tile[kk * 65 + nn + 0] = v[0]; tile[kk * 65 + nn + 1] = v[1]; tile[kk * 65 + nn + 2] = v[2]; tile[kk * 65 + nn + 3] = v[3];
        }
        __syncthreads();
        {
            const int nn = tid >> 3, kk8 = (tid & 7) * 8;
            float f[8];
#pragma unroll
            for (int j = 0; j < 8; ++j) f[j] = tile[(kk8 + j) * 65 + nn];
            u32x4 w; w.x = pk_bf16(f[0], f[1]); w.y = pk_bf16(f[2], f[3]); w.z = pk_bf16(f[4], f[5]); w.w = pk_bf16(f[6], f[7]);
            const int nsrc = n0 + nn, nrow = nsrc < nperm ? (nsrc & ~127) + rot_pos(nsrc & 127) : nsrc;
            *(u32x4*)(dst + (size_t)nrow * K + k0 + kk8) = w;
        }
        __syncthreads();
    }
}
__device__ __forceinline__ void convert_bf16(const float* src, bf16_t* dst, size_t n) {
    const size_t stride = (size_t)gridDim.x * 512 * 8;
    for (size_t i = ((size_t)blockIdx.x * 512 + threadIdx.x) * 8; i < n; i += stride) {
        const f32x4 a = *(const f32x4*)(src + i), b = *(const f32x4*)(src + i + 4);
        u32x4 w; w.x = pk_bf16(a[0], a[1]); w.y = pk_bf16(a[2], a[3]); w.z = pk_bf16(b[0], b[1]); w.w = pk_bf16(b[2], b[3]);
        *(u32x4*)(dst + i) = w;
    }
}
__device__ __forceinline__ void fold_peer_keys(LAS float* lds, const float* w_query, const float* sub_keys, bf16_t* WcT) {
    const int tid = threadIdx.x;
    LAS float* Ss = lds;
    LAS float* Ws = lds + 128 * 132;
    for (int item = blockIdx.x; item < 1024; item += gridDim.x) {
        const int l = item >> 9, rem = item & 511, hh = rem >> 5, kb = rem & 31, h = hh >> 1, half = hh & 1;
        const float* sk = sub_keys + (size_t)(((l * 2 + half) * 8 + h) * 128) * 128;
        const float* wq = w_query + (size_t)l * DM * DM + (size_t)(kb * 64) * DM + h * 256 + half * 128;
#pragma unroll
        for (int r = 0; r < 8; ++r) { const int idx = tid + 512 * r, key = idx >> 5, d4 = (idx & 31) * 4; *(LAS f32x4*)(Ss + key * 132 + d4) = *(const f32x4*)(sk + key * 128 + d4); }
#pragma unroll
        for (int r = 0; r < 4; ++r) { const int idx = tid + 512 * r, kin = idx >> 5, d4 = (idx & 31) * 4; *(LAS f32x4*)(Ws + kin * 128 + d4) = *(const f32x4*)(wq + (size_t)kin * DM + d4); }
        __syncthreads();
        const int key = tid & 127, kq = tid >> 7;
        float acc[16];
#pragma unroll
        for (int j = 0; j < 16; ++j) acc[j] = 0.f;
        for (int d4 = 0; d4 < 32; ++d4) {
            const f32x4 s4 = *(const LAS f32x4*)(Ss + key * 132 + d4 * 4);
#pragma unroll
            for (int j = 0; j < 16; ++j) { const f32x4 w4 = *(const LAS f32x4*)(Ws + (kq * 16 + j) * 128 + d4 * 4); acc[j] += s4[0] * w4[0] + s4[1] * w4[1] + s4[2] * w4[2] + s4[3] * w4[3]; }
        }
        bf16_t* o = WcT + (size_t)l * DM * DM + (size_t)(h * 256 + half * 128 + key) * DM + kb * 64 + kq * 16;
        u32x4 w0, w1;
        w0.x = pk_bf16(acc[0], acc[1]); w0.y = pk_bf16(acc[2], acc[3]); w0.z = pk_bf16(acc[4], acc[5]); w0.w = pk_bf16(acc[6], acc[7]);
        w1.x = pk_bf16(acc[8], acc[9]); w1.y = pk_bf16(acc[10], acc[11]); w1.z = pk_bf16(acc[12], acc[13]); w1.w = pk_bf16(acc[14], acc[15]);
        *(u32x4*)o = w0; *(u32x4*)(o + 8) = w1;
        __syncthreads();
    }
}

__device__ __forceinline__ void quant_rows(const float* src, unsigned char* dst, float* scl, int nrows) {
    const int lane = threadIdx.x & 63, gw = blockIdx.x * 8 + (threadIdx.x >> 6), nw = gridDim.x * 8;
    for (int row = gw; row < nrows; row += nw) {
        const float* p = src + (size_t)row * DM;
        f32x4 v[8];
#pragma unroll
        for (int i = 0; i < 2; ++i)
#pragma unroll
            for (int q = 0; q < 4; ++q) v[i * 4 + q] = *(const f32x4*)(p + 1024 * i + 16 * lane + 4 * q);
        float am = 0.f;
#pragma unroll
        for (int i = 0; i < 8; ++i) am = fmaxf(am, fmaxf(fmaxf(fabsf(v[i][0]), fabsf(v[i][1])), fmaxf(fabsf(v[i][2]), fabsf(v[i][3]))));
        am = fmaxf(wave_max(am), 1e-30f);
        const float inv = 127.0f / am;
        if (lane == 0) scl[row] = am * (1.0f / 127.0f);
#pragma unroll
        for (int i = 0; i < 2; ++i) {
            u32x4 w;
#pragma unroll
            for (int q = 0; q < 4; ++q) {
                const f32x4 t = v[i * 4 + q];
                const unsigned b0 = (unsigned)(int)(rintf(t[0] * inv) + 128.0f), b1 = (unsigned)(int)(rintf(t[1] * inv) + 128.0f), b2 = (unsigned)(int)(rintf(t[2] * inv) + 128.0f), b3 = (unsigned)(int)(rintf(t[3] * inv) + 128.0f);
                w[q] = b0 | (b1 << 8) | (b2 << 16) | (b3 << 24);
            }
            *(u32x4*)(dst + (size_t)row * DM + 1024 * i + 16 * lane) = w;
        }
    }
}
__device__ __forceinline__ void phase_prep(const Args& a, LAS unsigned char* lds) {
    unsigned char* ws = a.ws;
    LAS float* tile = (LAS float*)lds;
    transpose_tiles(tile, a.in[1], 4 * DM, DM, 4 * DM, (bf16_t*)(ws + WS_WIN));
    transpose_tiles(tile, a.in[3], DM, DM, DM, (bf16_t*)(ws + WS_WOUT));
    transpose_tiles(tile, a.in[5], 2 * DM, DM, 2 * DM, (bf16_t*)(ws + WS_WKVQ), DM);
    transpose_tiles(tile, a.in[6], DM, DM, DM, (bf16_t*)(ws + WS_WKVQ) + (size_t)2 * DM * DM, DM);
    transpose_tiles(tile, a.in[7], DM, DM, DM, (bf16_t*)(ws + WS_WO));
    fold_peer_keys((LAS float*)lds, a.in[8], a.in[9], (bf16_t*)(ws + WS_WC));
    convert_bf16(a.in[0], (bf16_t*)(ws + slot(0)), (size_t)MTOK * DM);
    const int gtid = blockIdx.x * 512 + threadIdx.x, gthreads = gridDim.x * 512;
    float* COS = (float*)(ws + WS_COS); float* SIN = (float*)(ws + WS_SIN); float* LB = (float*)(ws + WS_LB);
    for (int i = gtid; i < SEQ * 64; i += gthreads) {
        const int pos = i >> 6, j = i & 63;
        double inv = 1.0; const double r = 0.86596432336006535;
        for (int q = 0; q < j; ++q) inv *= r;
        const float ang = (float)pos * (float)inv;
        const double x = (double)ang;
        const double n = __builtin_rint(x * 0.15915494309189535);
        const float rf = (float)__builtin_fma(-n, 6.283185307179586, x);
        COS[i] = cosf(rf); SIN[i] = sinf(rf);
    }
    for (int c = gtid; c < DM; c += gthreads) { const float l0 = a.in[4][c], l1 = a.in[4][DM + c]; LB[c] = 1.0f / (1.0f + expf(l1 - l0)); }
}

__device__ __forceinline__ void phase_scan_naive(const bf16_t* Q1, const float* LF, const bf16_t* I1, float* O) {
    const int lane = threadIdx.x & 63, gw = blockIdx.x * 8 + (threadIdx.x >> 6), nw = gridDim.x * 8;
    for (int item = gw; item < 2 * NHEAD * 128; item += nw) {
        const int bh = item >> 7, v = item & 127, b = bh >> 4, h = bh & 15;
        const size_t base = (size_t)b * SEQ * DM + h * 128;
        float S0 = 0.f, S1 = 0.f;
#pragma unroll 4
        for (int t = 0; t < SEQ; ++t) {
            const size_t ro = base + (size_t)t * DM;
            const float f0 = __expf(LF[ro + lane]), f1 = __expf(LF[ro + 64 + lane]);
            const float q0 = bf2f(Q1[ro + lane]), q1 = bf2f(Q1[ro + 64 + lane]);
            const float iv = bf2f(I1[ro + v]);
            S0 = f0 * S0 + (1.0f - f0) * iv; S1 = f1 * S1 + (1.0f - f1) * iv;
            const float p = wave_sum(q0 * S0 + q1 * S1);
            if (lane == 0) O[ro + v] = p;
        }
    }
}
__device__ __forceinline__ void phase_onorm(const float* O, const bf16_t* G1, const float* gnorm, bf16_t* OG) {
    const int lane = threadIdx.x & 63, gw = blockIdx.x * 8 + (threadIdx.x >> 6), nw = gridDim.x * 8;
    const float gn0 = gnorm[2 * lane], gn1 = gnorm[2 * lane + 1];
    for (int item = gw; item < MTOK * NHEAD; item += nw) {
        const size_t off = (size_t)item * 128 + 2 * lane;
        const float o0 = O[off], o1 = O[off + 1];
        const float ss = wave_sum(o0 * o0 + o1 * o1);
        const float r = rsqrtf(ss * (1.0f / 128.0f) + 1e-6f);
        const unsigned g = *(const unsigned*)(G1 + off);
        *(unsigned*)(OG + off) = pk_bf16(o0 * r * gn0 * bflo(g), o1 * r * gn1 * bfhi(g));
    }
}

__device__ __forceinline__ void ln_row_store(float (&v)[32], const float* g, const float* bta, float* outf, bf16_t* outb, int lane, signed char* outq = nullptr, float* outs = nullptr) {
    float s = 0.f;
#pragma unroll
    for (int i = 0; i < 32; ++i) s += v[i];
    const float mu = wave_sum(s) * (1.0f / DM);
    float q = 0.f;
#pragma unroll
    for (int i = 0; i < 32; ++i) { v[i] -= mu; q += v[i] * v[i]; }
    const float rstd = rsqrtf(wave_sum(q) * (1.0f / DM) + 1e-5f);
    float am = 0.f;
#pragma unroll
    for (int i = 0; i < 4; ++i) {
        const int c = 512 * i + 8 * lane;
        const f32x4 g0 = *(const f32x4*)(g + c), g1 = *(const f32x4*)(g + c + 4), b0 = *(const f32x4*)(bta + c), b1 = *(const f32x4*)(bta + c + 4);
        f32x4 o0, o1;
#pragma unroll
        for (int j = 0; j < 4; ++j) { o0[j] = v[i * 8 + j] * rstd * g0[j] + b0[j]; o1[j] = v[i * 8 + 4 + j] * rstd * g1[j] + b1[j]; v[i * 8 + j] = o0[j]; v[i * 8 + 4 + j] = o1[j]; am = fmaxf(am, fmaxf(fabsf(o0[j]), fabsf(o1[j]))); }
        if (outf) { *(f32x4*)(outf + c) = o0; *(f32x4*)(outf + c + 4) = o1; }
        if (outb) { u32x4 w; w.x = pk_bf16(o0[0], o0[1]); w.y = pk_bf16(o0[2], o0[3]); w.z = pk_bf16(o1[0], o1[1]); w.w = pk_bf16(o1[2], o1[3]); *(u32x4*)(outb + c) = w; }
    }
    if (outq) {
        am = fmaxf(wave_max(am), 1e-30f);
        const float inv = 127.0f / am;
        if (lane == 0) *outs = am * (1.0f / 127.0f);
#pragma unroll
        for (int i = 0; i < 4; ++i) {
            u32x2 w;
            w.x = ((unsigned)(int)rintf(v[i * 8 + 0] * inv) & 0xffu) | (((unsigned)(int)rintf(v[i * 8 + 1] * inv) & 0xffu) << 8) | (((unsigned)(int)rintf(v[i * 8 + 2] * inv) & 0xffu) << 16) | (((unsigned)(int)rintf(v[i * 8 + 3] * inv) & 0xffu) << 24);
            w.y = ((unsigned)(int)rintf(v[i * 8 + 4] * inv) & 0xffu) | (((unsigned)(int)rintf(v[i * 8 + 5] * inv) & 0xffu) << 8) | (((unsigned)(int)rintf(v[i * 8 + 6] * inv) & 0xffu) << 16) | (((unsigned)(int)rintf(v[i * 8 + 7] * inv) & 0xffu) << 24);
            *(u32x2*)(outq + 512 * i + 8 * lane) = w;
        }
    }
}
__device__ __forceinline__ void ln_row_store16(float (&v)[32], const float* g, const float* bta, float* outf, bf16_t* outb, int lane) {
    float s = 0.f;
#pragma unroll
    for (int i = 0; i < 32; ++i) s += v[i];
    const float mu = wave_sum(s) * (1.0f / DM);
    float q = 0.f;
#pragma unroll
    for (int i = 0; i < 32; ++i) { v[i] -= mu; q += v[i] * v[i]; }
    const float rstd = rsqrtf(wave_sum(q) * (1.0f / DM) + 1e-5f);
#pragma unroll
    for (int i = 0; i < 2; ++i) {
        const int c = 1024 * i + 16 * lane;
        f32x4 o[4];
#pragma unroll
        for (int qd = 0; qd < 4; ++qd) {
            const f32x4 gg = *(const f32x4*)(g + c + 4 * qd), bb = *(const f32x4*)(bta + c + 4 * qd);
#pragma unroll
            for (int j = 0; j < 4; ++j) o[qd][j] = v[16 * i + 4 * qd + j] * rstd * gg[j] + bb[j];
            *(f32x4*)(outf + c + 4 * qd) = o[qd];
        }
        if (outb) {
            u32x4 w0, w1;
            w0.x = pk_bf16(o[0][0], o[0][1]); w0.y = pk_bf16(o[0][2], o[0][3]); w0.z = pk_bf16(o[1][0], o[1][1]); w0.w = pk_bf16(o[1][2], o[1][3]);
            w1.x = pk_bf16(o[2][0], o[2][1]); w1.y = pk_bf16(o[2][2], o[2][3]); w1.z = pk_bf16(o[3][0], o[3][1]); w1.w = pk_bf16(o[3][2], o[3][3]);
            *(u32x4*)(outb + c) = w0; *(u32x4*)(outb + c + 8) = w1;
        }
    }
}
template <bool RES16> __device__ __forceinline__ void phase_ln(const float* Y, const void* RESv, const float* g, const float* bta, float* outf, bf16_t* outb, signed char* outq = nullptr, float* outs = nullptr) {
    const int lane = threadIdx.x & 63, gw = blockIdx.x * 8 + (threadIdx.x >> 6), nw = gridDim.x * 8;
    for (int row = gw; row < MTOK; row += nw) {
        float v[32];
        const float* p = Y + (size_t)row * DM;
#pragma unroll
        for (int i = 0; i < 4; ++i) {
            const f32x4 a = *(const f32x4*)(p + 512 * i + 8 * lane), b = *(const f32x4*)(p + 512 * i + 8 * lane + 4);
            f32x4 ra, rb;
            if (RES16) { const u32x4 w = *(const u32x4*)((const bf16_t*)RESv + (size_t)row * DM + 512 * i + 8 * lane); ra = (f32x4){bflo(w.x), bfhi(w.x), bflo(w.y), bfhi(w.y)}; rb = (f32x4){bflo(w.z), bfhi(w.z), bflo(w.w), bfhi(w.w)}; }
            else { const float* rp = (const float*)RESv + (size_t)row * DM; ra = *(const f32x4*)(rp + 512 * i + 8 * lane); rb = *(const f32x4*)(rp + 512 * i + 8 * lane + 4); }
#pragma unroll
            for (int j = 0; j < 4; ++j) { v[i * 8 + j] = a[j] + ALPHA * ra[j]; v[i * 8 + 4 + j] = b[j] + ALPHA * rb[j]; }
        }
        ln_row_store(v, g, bta, outf ? outf + (size_t)row * DM : nullptr, outb ? outb + (size_t)row * DM : nullptr, lane, outq ? outq + (size_t)row * DM : nullptr, outs ? outs + row : nullptr);
    }
}

__device__ __forceinline__ void wave_argmax(float& v, int& idx) {
#pragma unroll
    for (int o = 32; o >= 1; o >>= 1) {
        const float ov = __shfl_xor(v, o); const int oi = __shfl_xor(idx, o);
        if (ov > v || (ov == v && oi < idx)) { v = ov; idx = oi; }
    }
}
__device__ __forceinline__ unsigned fkey(float x) { const unsigned u = __float_as_uint(x); return u ^ (unsigned)(((int)u >> 31) | 0x80000000); }
__device__ __forceinline__ float funkey(unsigned k) { const unsigned u = (k & 0x80000000u) ? (k ^ 0x80000000u) : ~k; return __uint_as_float(u); }
__device__ __forceinline__ void sort16_insert(unsigned (&r)[16], unsigned v) {
#pragma unroll
    for (int i = 0; i < 16; ++i) { const unsigned m = r[i] > v ? r[i] : v; v = r[i] > v ? v : r[i]; r[i] = m; }
}
__device__ __forceinline__ void phase_topk(LAS unsigned char* lds, const float* SCT, int* EID, float* GATE) {
    LAS unsigned char* ib = lds + threadIdx.x * 32;
    for (int item = blockIdx.x * 512 + threadIdx.x; item < MTOK * 8; item += gridDim.x * 512) {
        const int h = item >> 14, tok = item & (MTOK - 1);
        const float* p = SCT + (size_t)(h * 256) * MTOK + tok;
        unsigned r1[16], r2[16];
#pragma unroll
        for (int i = 0; i < 16; ++i) { r1[i] = 0u; r2[i] = 0u; }
#pragma unroll 8
        for (int e = 0; e < 128; ++e) {
            const float x1 = p[(size_t)e * MTOK], x2 = p[(size_t)(128 + e) * MTOK];
            sort16_insert(r1, (fkey(x1) & ~0x7Fu) | (unsigned)e);
            sort16_insert(r2, (fkey(x2) & ~0x7Fu) | (unsigned)e);
        }
        float v1[16], v2[16];
#pragma unroll
        for (int i = 0; i < 16; ++i) { v1[i] = funkey(r1[i] & ~0x7Fu); v2[i] = funkey(r2[i] & ~0x7Fu); ib[i] = (unsigned char)(r1[i] & 0x7Fu); ib[16 + i] = (unsigned char)(r2[i] & 0x7Fu); }
        unsigned r3[16];
#pragma unroll
        for (int i = 0; i < 16; ++i) r3[i] = 0u;
#pragma unroll
        for (int a = 0; a < 16; ++a)
#pragma unroll
            for (int bq = 0; bq < 16; ++bq)
                if ((a + 1) * (bq + 1) <= 16) sort16_insert(r3, (fkey(v1[a] + v2[bq]) & ~0xFFu) | (unsigned)(a * 16 + bq));
        const float mx = funkey(r3[0] & ~0xFFu);
        float ev[16]; float sum = 0.f;
#pragma unroll
        for (int i = 0; i < 16; ++i) { ev[i] = __expf(funkey(r3[i] & ~0xFFu) - mx); sum += ev[i]; }
        const float rs = 1.0f / sum;
        int eid[16];
#pragma unroll
        for (int i = 0; i < 16; ++i) { const unsigned f = r3[i] & 0xFFu; eid[i] = (int)ib[f >> 4] * 128 + (int)ib[16 + (f & 15u)]; }
        int* eo = EID + (size_t)tok * 128 + h * 16; float* go = GATE + (size_t)tok * 128 + h * 16;
#pragma unroll
        for (int q = 0; q < 4; ++q) {
            *(u32x4*)(eo + 4 * q) = (u32x4){(unsigned)eid[4 * q], (unsigned)eid[4 * q + 1], (unsigned)eid[4 * q + 2], (unsigned)eid[4 * q + 3]};
            *(f32x4*)(go + 4 * q) = (f32x4){ev[4 * q] * rs, ev[4 * q + 1] * rs, ev[4 * q + 2] * rs, ev[4 * q + 3] * rs};
        }
    }
}

__device__ __forceinline__ float gelu_erf(float x) { return 0.5f * x * (1.0f + erff(x * 0.70710678118654752f)); }
__device__ __forceinline__ float ub0(unsigned w) { return (float)(w & 0xffu); }
__device__ __forceinline__ float ub1(unsigned w) { return (float)((w >> 8) & 0xffu); }
__device__ __forceinline__ float ub2(unsigned w) { return (float)((w >> 16) & 0xffu); }
__device__ __forceinline__ float ub3(unsigned w) { return (float)(w >> 24); }
__device__ __forceinline__ void phase_peer(LAS unsigned char* lds, const float* X, const int* EID, const float* GATE, const unsigned char* U, const unsigned char* V, const float* USC, const float* VSC,
                                           const float* g, const float* bta, float* outf, bf16_t* outb) {
    const int lane = threadIdx.x & 63, wv = threadIdx.x >> 6, gw = blockIdx.x * 8 + wv, nw = gridDim.x * 8;
    LAS float* hb = (LAS float*)(lds + wv * 512);
    for (int tok = gw; tok < MTOK; tok += nw) {
        float x[32];
        const float* xp = X + (size_t)tok * DM;
#pragma unroll
        for (int i = 0; i < 2; ++i)
#pragma unroll
            for (int q = 0; q < 4; ++q) { const f32x4 t = *(const f32x4*)(xp + 1024 * i + 16 * lane + 4 * q); x[16 * i + 4 * q] = t[0]; x[16 * i + 4 * q + 1] = t[1]; x[16 * i + 4 * q + 2] = t[2]; x[16 * i + 4 * q + 3] = t[3]; }
        float sx = 0.f;
#pragma unroll
        for (int j = 0; j < 32; ++j) sx += x[j];
        const float d0 = -128.0f * sx;
        const int e0 = EID[(size_t)tok * 128 + lane], e1 = EID[(size_t)tok * 128 + 64 + lane];
        const float g0 = GATE[(size_t)tok * 128 + lane], g1 = GATE[(size_t)tok * 128 + 64 + lane];
        for (int bt = 0; bt < 16; ++bt) {
            float d[8];
#pragma unroll
            for (int r = 0; r < 8; ++r) {
                const int e = bt * 8 + r;
                const int idx = __builtin_amdgcn_readfirstlane(__shfl(bt < 8 ? e0 : e1, e & 63));
                const u32x4* up = (const u32x4*)(U + (size_t)idx * DM) + lane;
                float acc = d0;
#pragma unroll
                for (int i = 0; i < 2; ++i) {
                    const u32x4 w = up[i * 64];
                    acc += x[16 * i + 0] * ub0(w.x) + x[16 * i + 1] * ub1(w.x) + x[16 * i + 2] * ub2(w.x) + x[16 * i + 3] * ub3(w.x)
                         + x[16 * i + 4] * ub0(w.y) + x[16 * i + 5] * ub1(w.y) + x[16 * i + 6] * ub2(w.y) + x[16 * i + 7] * ub3(w.y)
                         + x[16 * i + 8] * ub0(w.z) + x[16 * i + 9] * ub1(w.z) + x[16 * i + 10] * ub2(w.z) + x[16 * i + 11] * ub3(w.z)
                         + x[16 * i + 12] * ub0(w.w) + x[16 * i + 13] * ub1(w.w) + x[16 * i + 14] * ub2(w.w) + x[16 * i + 15] * ub3(w.w);
                }
                d[r] = acc;
            }
            const bool b5 = lane & 32, b4 = lane & 16, b3 = lane & 8;
            float t4[4];
#pragma unroll
            for (int q = 0; q < 4; ++q) { const float keep = b5 ? d[4 + q] : d[q], send = b5 ? d[q] : d[4 + q]; t4[q] = keep + __shfl_xor(send, 32); }
            float t2[2];
#pragma unroll
            for (int q = 0; q < 2; ++q) { const float keep = b4 ? t4[2 + q] : t4[q], send = b4 ? t4[q] : t4[2 + q]; t2[q] = keep + __shfl_xor(send, 16); }
            float t1;
            { const float keep = b3 ? t2[1] : t2[0], send = b3 ? t2[0] : t2[1]; t1 = keep + __shfl_xor(send, 8); }
            t1 += __shfl_xor(t1, 4); t1 += __shfl_xor(t1, 2); t1 += __shfl_xor(t1, 1);
            if ((lane & 7) == 0) hb[bt * 8 + (lane >> 3 & 1) + 2 * (lane >> 4 & 1) + 4 * (lane >> 5 & 1)] = t1;
        }
        asm volatile("s_waitcnt lgkmcnt(0)" ::: "memory");
        const float h0 = hb[lane] * USC[e0], h1 = hb[64 + lane] * USC[e1];
        const float w0 = g0 * gelu_erf(h0) * VSC[e0], w1 = g1 * gelu_erf(h1) * VSC[e1];
        float wsum = wave_sum(w0 + w1);
        float y[32];
#pragma unroll
        for (int i = 0; i < 32; ++i) y[i] = 0.f;
#pragma unroll 8
        for (int e = 0; e < 128; ++e) {
            const int idx = __builtin_amdgcn_readfirstlane(__shfl(e < 64 ? e0 : e1, e & 63));
            const float wt = __shfl(e < 64 ? w0 : w1, e & 63);
            const u32x4* vp = (const u32x4*)(V + (size_t)idx * DM) + lane;
#pragma unroll
            for (int i = 0; i < 2; ++i) {
                const u32x4 w = vp[i * 64];
                y[16 * i + 0] += wt * ub0(w.x); y[16 * i + 1] += wt * ub1(w.x); y[16 * i + 2] += wt * ub2(w.x); y[16 * i + 3] += wt * ub3(w.x);
                y[16 * i + 4] += wt * ub0(w.y); y[16 * i + 5] += wt * ub1(w.y); y[16 * i + 6] += wt * ub2(w.y); y[16 * i + 7] += wt * ub3(w.y);
                y[16 * i + 8] += wt * ub0(w.z); y[16 * i + 9] += wt * ub1(w.z); y[16 * i + 10] += wt * ub2(w.z); y[16 * i + 11] += wt * ub3(w.z);
                y[16 * i + 12] += wt * ub0(w.w); y[16 * i + 13] += wt * ub1(w.w); y[16 * i + 14] += wt * ub2(w.w); y[16 * i + 15] += wt * ub3(w.w);
            }
        }
        const float corr = -128.0f * wsum;
#pragma unroll
        for (int i = 0; i < 32; ++i) y[i] = y[i] + corr + ALPHA * x[i];
        ln_row_store16(y, g, bta, outf + (size_t)tok * DM, outb ? outb + (size_t)tok * DM : nullptr, lane);
        asm volatile("s_waitcnt lgkmcnt(0)" ::: "memory");
    }
}

__device__ __forceinline__ int row_dot_i8(const u32x4 (&xq)[2], const unsigned char* rowp, int lane) {
    const u32x4* up = (const u32x4*)rowp + lane;
    int acc = 0;
#pragma unroll
    for (int i = 0; i < 2; ++i) {
        const u32x4 w = up[i * 64];
        acc = __builtin_amdgcn_sdot4((int)xq[i].x, (int)(w.x ^ 0x80808080u), acc, false); acc = __builtin_amdgcn_sdot4((int)xq[i].y, (int)(w.y ^ 0x80808080u), acc, false);
        acc = __builtin_amdgcn_sdot4((int)xq[i].z, (int)(w.z ^ 0x80808080u), acc, false); acc = __builtin_amdgcn_sdot4((int)xq[i].w, (int)(w.w ^ 0x80808080u), acc, false);
    }
    return acc;
}
__device__ __forceinline__ void peer_issue8(u32x4 (&seg)[8], const unsigned char* base, const u32x4 ia, const u32x4 ib) {
    seg[0] = *(const u32x4*)(base + (size_t)ia.x * DM); seg[1] = *(const u32x4*)(base + (size_t)ia.y * DM); seg[2] = *(const u32x4*)(base + (size_t)ia.z * DM); seg[3] = *(const u32x4*)(base + (size_t)ia.w * DM);
    seg[4] = *(const u32x4*)(base + (size_t)ib.x * DM); seg[5] = *(const u32x4*)(base + (size_t)ib.y * DM); seg[6] = *(const u32x4*)(base + (size_t)ib.z * DM); seg[7] = *(const u32x4*)(base + (size_t)ib.w * DM);
}
__device__ __forceinline__ void peer_dot8(int (&d)[8], const u32x4 (&seg)[8], const u32x4 xq) {
#pragma unroll
    for (int i = 0; i < 8; ++i) {
        int acc = __builtin_amdgcn_sdot4((int)xq.x, (int)(seg[i].x ^ 0x80808080u), 0, false);
        acc = __builtin_amdgcn_sdot4((int)xq.y, (int)(seg[i].y ^ 0x80808080u), acc, false);
        acc = __builtin_amdgcn_sdot4((int)xq.z, (int)(seg[i].z ^ 0x80808080u), acc, false);
        d[i] = __builtin_amdgcn_sdot4((int)xq.w, (int)(seg[i].w ^ 0x80808080u), acc, false);
    }
}
__device__ __forceinline__ void phase_peer_u(const signed char* XQ, const int* EID, const unsigned char* U, LAS int* HL  ) {
    const int lane = threadIdx.x & 63, wv = threadIdx.x >> 6, es = lane >> 3, cc = lane & 7;
    const bool b2 = cc & 4, b1 = cc & 2, b0 = cc & 1;
    const int nw = gridDim.x * 8, gw = blockIdx.x * 8 + wv, tpw = (MTOK + nw - 1) / nw, tbase = gw * tpw;
    int cnt = MTOK - tbase; cnt = cnt > tpw ? tpw : cnt;
    if (cnt <= 0) return;
    for (int i = lane; i < cnt * 128; i += 64) HL[i] = 0;
    asm volatile("s_waitcnt lgkmcnt(0)" ::: "memory");
    const int nit = 16 * cnt;
    const unsigned char* ub = U + cc * 16;
    u32x4 m0a, m0b, m0c, m0d, m0x, m1a, m1b, m1c, m1d, m1x, m2a, m2b, m2c, m2d, m2x; u32x4 sA[8], sB[8];
#define PU_LOAD(sl_, k_, A_, B_, C_, D_, X_) { const int* ep_ = EID + (size_t)(tbase + (k_)) * 128 + es * 16; A_ = *(const u32x4*)ep_; B_ = *(const u32x4*)(ep_ + 4); C_ = *(const u32x4*)(ep_ + 8); D_ = *(const u32x4*)(ep_ + 12); \
        X_ = *(const u32x4*)(XQ + (size_t)(tbase + (k_)) * DM + (sl_) * 128 + cc * 16); }
#define PU_NEXT(sl_, k_, sn_, kn_) { kn_ = (k_) + 1; sn_ = (sl_); if (kn_ == cnt) { kn_ = 0; ++sn_; } if (sn_ == 16) { sn_ = 15; kn_ = cnt - 1; } }
    int sl = 0, k = 0, sl1, k1, sl2, k2;
    PU_NEXT(sl, k, sl1, k1) PU_NEXT(sl1, k1, sl2, k2)
    PU_LOAD(sl, k, m0a, m0b, m0c, m0d, m0x)
    PU_LOAD(sl1, k1, m1a, m1b, m1c, m1d, m1x)
    peer_issue8(sA, ub + sl * 128, m0a, m0b);
    for (int it = 0; it < nit; ++it) {
        PU_LOAD(sl2, k2, m2a, m2b, m2c, m2d, m2x)
        peer_issue8(sB, ub + sl * 128, m0c, m0d);
        int dlo[8]; peer_dot8(dlo, sA, m0x);
        peer_issue8(sA, ub + sl1 * 128, m1a, m1b);
        int dhi[8]; peer_dot8(dhi, sB, m0x);
        int t8[8], t4[4], t2[2];
#pragma unroll
        for (int q = 0; q < 8; ++q) { const int keep = b2 ? dhi[q] : dlo[q], send = b2 ? dlo[q] : dhi[q]; t8[q] = keep + __shfl_xor(send, 4); }
#pragma unroll
        for (int q = 0; q < 4; ++q) { const int keep = b1 ? t8[4 + q] : t8[q], send = b1 ? t8[q] : t8[4 + q]; t4[q] = keep + __shfl_xor(send, 2); }
#pragma unroll
        for (int q = 0; q < 2; ++q) { const int keep = b0 ? t4[2 + q] : t4[q], send = b0 ? t4[q] : t4[2 + q]; t2[q] = keep + __shfl_xor(send, 1); }
        { LAS int* hp = HL + k * 128 + es * 16 + (b2 ? 8 : 0) + (b1 ? 4 : 0) + (b0 ? 2 : 0);
          __hip_atomic_fetch_add(hp, t2[0], __ATOMIC_RELAXED, __HIP_MEMORY_SCOPE_WORKGROUP); __hip_atomic_fetch_add(hp + 1, t2[1], __ATOMIC_RELAXED, __HIP_MEMORY_SCOPE_WORKGROUP); }
        sl = sl1; k = k1; sl1 = sl2; k1 = k2; PU_NEXT(sl1, k1, sl2, k2)
        m0a = m1a; m0b = m1b; m0c = m1c; m0d = m1d; m0x = m1x; m1a = m2a; m1b = m2b; m1c = m2c; m1d = m2d; m1x = m2x;
    }
#undef PU_LOAD
#undef PU_NEXT
}
__device__ __forceinline__ void phase_peer_w(const LAS int* HL, const float* XS, const int* EID, const float* GATE, const float* USC, const float* VSC, float* W, float* CS) {
    const int lane = threadIdx.x & 63, gw = blockIdx.x * 8 + (threadIdx.x >> 6), nw = gridDim.x * 8, tpw = (MTOK + nw - 1) / nw, tbase = gw * tpw;
    const int tend = tbase + tpw < MTOK ? tbase + tpw : MTOK;
    for (int tok = tbase; tok < tend; ++tok) {
        const int h0 = HL[(tok - tbase) * 128 + lane], h1 = HL[(tok - tbase) * 128 + 64 + lane];
        const int e0 = EID[(size_t)tok * 128 + lane], e1 = EID[(size_t)tok * 128 + 64 + lane];
        const float xs = XS[tok];
        const float w0 = GATE[(size_t)tok * 128 + lane] * gelu_erf((float)h0 * xs * USC[e0]) * VSC[e0];
        const float w1 = GATE[(size_t)tok * 128 + 64 + lane] * gelu_erf((float)h1 * xs * USC[e1]) * VSC[e1];
        W[(size_t)tok * 128 + lane] = w0; W[(size_t)tok * 128 + 64 + lane] = w1;
        const float cs = wave_sum(w0 + w1);
        if (lane == 0) CS[tok] = cs;
    }
}
__device__ __forceinline__ void peer_fma8(f32x2_t (&ya)[8], const u32x4 (&seg)[8], const f32x4 wa, const f32x4 wb2) {
#pragma unroll
    for (int i = 0; i < 8; ++i) {
        const float wt = i < 4 ? wa[i & 3] : wb2[i & 3];
        const f32x2_t wt2 = {wt, wt};
        const u32x4 w = seg[i];
        ya[0] = __builtin_elementwise_fma(wt2, (f32x2_t){ub0(w.x), ub1(w.x)}, ya[0]); ya[1] = __builtin_elementwise_fma(wt2, (f32x2_t){ub2(w.x), ub3(w.x)}, ya[1]);
        ya[2] = __builtin_elementwise_fma(wt2, (f32x2_t){ub0(w.y), ub1(w.y)}, ya[2]); ya[3] = __builtin_elementwise_fma(wt2, (f32x2_t){ub2(w.y), ub3(w.y)}, ya[3]);
        ya[4] = __builtin_elementwise_fma(wt2, (f32x2_t){ub0(w.z), ub1(w.z)}, ya[4]); ya[5] = __builtin_elementwise_fma(wt2, (f32x2_t){ub2(w.z), ub3(w.z)}, ya[5]);
        ya[6] = __builtin_elementwise_fma(wt2, (f32x2_t){ub0(w.w), ub1(w.w)}, ya[6]); ya[7] = __builtin_elementwise_fma(wt2, (f32x2_t){ub2(w.w), ub3(w.w)}, ya[7]);
    }
}
__device__ __forceinline__ void phase_peer_v(const bf16_t* X, const int* EID, const float* W, const float* CS, const unsigned char* V, float* Y) {
    const int lane = threadIdx.x & 63, wv = threadIdx.x >> 6, es = lane >> 3, cc = lane & 7;
    const bool b5 = lane & 32, b4 = lane & 16, b3 = lane & 8;
    const int nw = gridDim.x * 8, gw = blockIdx.x * 8 + wv, tpw = (MTOK + nw - 1) / nw, tbase = gw * tpw;
    int cnt = MTOK - tbase; cnt = cnt > tpw ? tpw : cnt;
    if (cnt <= 0) return;
    const int nit = 16 * cnt;
    const unsigned char* vb = V + cc * 16;
    const int colo = cc * 16 + (b5 ? 8 : 0) + (b4 ? 4 : 0) + (b3 ? 2 : 0);
    u32x4 m0c, m0d, m1a, m1b, m1c, m1d, m2a, m2b, m2c, m2d; f32x4 w0a, w0b, w0c, w0d, w1a, w1b, w1c, w1d; f32x2_t x0, x1; float c0, c1; u32x4 sA[8], sB[8];
#define PV_IDS(k_, A_, B_, C_, D_) { const size_t o_ = (size_t)(tbase + (k_)) * 128 + es * 16; A_ = *(const u32x4*)(EID + o_); B_ = *(const u32x4*)(EID + o_ + 4); C_ = *(const u32x4*)(EID + o_ + 8); D_ = *(const u32x4*)(EID + o_ + 12); }
#define PV_WX(sl_, k_, WA_, WB_, WC_, WD_, X_, CS_) { const size_t o_ = (size_t)(tbase + (k_)) * 128 + es * 16; \
        WA_ = *(const f32x4*)(W + o_); WB_ = *(const f32x4*)(W + o_ + 4); WC_ = *(const f32x4*)(W + o_ + 8); WD_ = *(const f32x4*)(W + o_ + 12); \
        { const unsigned xw_ = *(const unsigned*)(X + (size_t)(tbase + (k_)) * DM + (sl_) * 128 + colo); X_ = (f32x2_t){bflo(xw_), bfhi(xw_)}; } CS_ = CS[tbase + (k_)]; }
#define PV_NEXT(sl_, k_, sn_, kn_) { kn_ = (k_) + 1; sn_ = (sl_); if (kn_ == cnt) { kn_ = 0; ++sn_; } if (sn_ == 16) { sn_ = 15; kn_ = cnt - 1; } }
    int sl = 0, k = 0, sl1, k1, sl2, k2;
    PV_NEXT(sl, k, sl1, k1) PV_NEXT(sl1, k1, sl2, k2)
    { u32x4 ta, tb; PV_IDS(k, ta, tb, m0c, m0d) PV_IDS(k1, m1a, m1b, m1c, m1d)
      PV_WX(sl, k, w0a, w0b, w0c, w0d, x0, c0)
      peer_issue8(sA, vb + sl * 128, ta, tb); }
    for (int it = 0; it < nit; ++it) {
        PV_IDS(k2, m2a, m2b, m2c, m2d)
        peer_issue8(sB, vb + sl * 128, m0c, m0d);
        f32x2_t ya[8];
#pragma unroll
        for (int j = 0; j < 8; ++j) ya[j] = (f32x2_t){0.f, 0.f};
        peer_fma8(ya, sA, w0a, w0b);
        peer_issue8(sA, vb + sl1 * 128, m1a, m1b);
        PV_WX(sl1, k1, w1a, w1b, w1c, w1d, x1, c1)
        peer_fma8(ya, sB, w0c, w0d);
        f32x2_t t4[4], t2[2], t1;
#pragma unroll
        for (int q = 0; q < 4; ++q) { const f32x2_t keep = b5 ? ya[4 + q] : ya[q], send = b5 ? ya[q] : ya[4 + q]; t4[q][0] = keep[0] + __shfl_xor(send[0], 32); t4[q][1] = keep[1] + __shfl_xor(send[1], 32); }
#pragma unroll
        for (int q = 0; q < 2; ++q) { const f32x2_t keep = b4 ? t4[2 + q] : t4[q], send = b4 ? t4[q] : t4[2 + q]; t2[q][0] = keep[0] + __shfl_xor(send[0], 16); t2[q][1] = keep[1] + __shfl_xor(send[1], 16); }
        { const f32x2_t keep = b3 ? t2[1] : t2[0], send = b3 ? t2[0] : t2[1]; t1[0] = keep[0] + __shfl_xor(send[0], 8); t1[1] = keep[1] + __shfl_xor(send[1], 8); }
        f32x2_t o; o[0] = t1[0] - 128.0f * c0 + ALPHA * x0[0]; o[1] = t1[1] - 128.0f * c0 + ALPHA * x0[1];
        *(f32x2_t*)(Y + (size_t)(tbase + k) * DM + sl * 128 + colo) = o;
        sl = sl1; k = k1; sl1 = sl2; k1 = k2; PV_NEXT(sl1, k1, sl2, k2)
        m0c = m1c; m0d = m1d; m1a = m2a; m1b = m2b; m1c = m2c; m1d = m2d;
        w0a = w1a; w0b = w1b; w0c = w1c; w0d = w1d; x0 = x1; c0 = c1;
    }
#undef PV_IDS
#undef PV_WX
#undef PV_NEXT
}

__device__ __forceinline__ void rot8(const u32x4 lo, const u32x4 hi, const f32x4 c0, const f32x4 c1, const f32x4 s0, const f32x4 s1, float (&o1)[8], float (&o2)[8]) {
    const float a[8] = {bflo(lo.x), bfhi(lo.x), bflo(lo.y), bfhi(lo.y), bflo(lo.z), bfhi(lo.z), bflo(lo.w), bfhi(lo.w)};
    const float b[8] = {bflo(hi.x), bfhi(hi.x), bflo(hi.y), bfhi(hi.y), bflo(hi.z), bfhi(hi.z), bflo(hi.w), bfhi(hi.w)};
    const float c[8] = {c0[0], c0[1], c0[2], c0[3], c1[0], c1[1], c1[2], c1[3]}, sn[8] = {s0[0], s0[1], s0[2], s0[3], s1[0], s1[1], s1[2], s1[3]};
#pragma unroll
    for (int j = 0; j < 8; ++j) { o1[j] = a[j] * c[j] - b[j] * sn[j]; o2[j] = a[j] * sn[j] + b[j] * c[j]; }
}
__device__ __forceinline__ u32x4 pack8(const float (&o)[8]) { u32x4 w; w.x = pk_bf16(o[0], o[1]); w.y = pk_bf16(o[2], o[3]); w.z = pk_bf16(o[4], o[5]); w.w = pk_bf16(o[6], o[7]); return w; }
__device__ __forceinline__ void phase_kstat(LAS float* red, const bf16_t* KR, float* KMEAN, float* KNMAX) {
    const int tid = threadIdx.x, ch = tid & 7, rr = tid >> 3, wv = tid >> 6, lane = tid & 63;
    for (int item = blockIdx.x; item < 2 * NHEAD * 32; item += gridDim.x) {
        const int bh = item >> 5, j = item & 31, b = bh >> 4, h = bh & 15;
        float sm1[8], sm2[8]; float nmax = 0.f;
#pragma unroll
        for (int q = 0; q < 8; ++q) { sm1[q] = 0.f; sm2[q] = 0.f; }
        u32x4 lo[4], hi[4];
#pragma unroll
        for (int ps = 0; ps < 4; ++ps) { const size_t off = ((size_t)b * SEQ + j * 256 + ps * 64 + rr) * DM + h * 128 + ch * 8; lo[ps] = *(const u32x4*)(KR + off); hi[ps] = *(const u32x4*)(KR + off + 64); }
#pragma unroll
        for (int ps = 0; ps < 4; ++ps) {
            const float a[8] = {bflo(lo[ps].x), bfhi(lo[ps].x), bflo(lo[ps].y), bfhi(lo[ps].y), bflo(lo[ps].z), bfhi(lo[ps].z), bflo(lo[ps].w), bfhi(lo[ps].w)};
            const float c[8] = {bflo(hi[ps].x), bfhi(hi[ps].x), bflo(hi[ps].y), bfhi(hi[ps].y), bflo(hi[ps].z), bfhi(hi[ps].z), bflo(hi[ps].w), bfhi(hi[ps].w)};
            float nq = 0.f;
#pragma unroll
            for (int q = 0; q < 8; ++q) { sm1[q] += a[q]; sm2[q] += c[q]; nq += a[q] * a[q] + c[q] * c[q]; }
            nq += __shfl_xor(nq, 1); nq += __shfl_xor(nq, 2); nq += __shfl_xor(nq, 4);
            nmax = fmaxf(nmax, nq);
        }
#pragma unroll
        for (int q = 0; q < 8; ++q) {
            sm1[q] += __shfl_xor(sm1[q], 8); sm1[q] += __shfl_xor(sm1[q], 16); sm1[q] += __shfl_xor(sm1[q], 32);
            sm2[q] += __shfl_xor(sm2[q], 8); sm2[q] += __shfl_xor(sm2[q], 16); sm2[q] += __shfl_xor(sm2[q], 32);
        }
        nmax = wave_max(nmax);
        if (lane < 8) {
#pragma unroll
            for (int q = 0; q < 8; ++q) { red[wv * 128 + lane * 8 + q] = sm1[q]; red[wv * 128 + 64 + lane * 8 + q] = sm2[q]; }
        }
        if (lane == 0) red[1024 + wv] = nmax;
        __syncthreads();
        if (tid < 128) {
            float s2 = 0.f;
#pragma unroll
            for (int r = 0; r < 8; ++r) s2 += red[r * 128 + tid];
            KMEAN[(size_t)item * 128 + tid] = s2 * (1.0f / 256.0f);
        }
        if (tid == 0) {
            float m = 0.f;
#pragma unroll
            for (int r = 0; r < 8; ++r) m = fmaxf(m, red[1024 + r]);
            KNMAX[item] = sqrtf(m);
        }
        __syncthreads();
    }
}

__device__ __forceinline__ void top3_insert(float x, int m, float& v0, int& i0, float& v1, int& i1, float& v2, int& i2) {
    const bool c0 = x > v0 || (x == v0 && m < i0), c1 = x > v1 || (x == v1 && m < i1), c2 = x > v2 || (x == v2 && m < i2);
    v2 = c1 ? v1 : (c2 ? x : v2); i2 = c1 ? i1 : (c2 ? m : i2);
    v1 = c0 ? v0 : (c1 ? x : v1); i1 = c0 ? i0 : (c1 ? m : i1);
    v0 = c0 ? x : v0; i0 = c0 ? m : i0;
}
__device__ __forceinline__ void phase_sel(LAS unsigned char* lds, const bf16_t* QR, const float* KMEAN, unsigned short* SUB, int* CNT, int* ctr) {
    const int tid = threadIdx.x, lane = tid & 63, wv = tid >> 6, r32 = lane & 31, hh = lane >> 5;
    LAS unsigned short* bucket = (LAS unsigned short*)lds;
    LAS int* cnt = (LAS int*)(lds + 16384);
    const float NEG = -1e30f;
    if (blockIdx.x == 0 && tid == 0) *ctr = 0;
    for (int item = blockIdx.x; item < 2 * NHEAD * 32; item += gridDim.x) {
        const int bh = item >> 5, i = item & 31, b = bh >> 4, h = bh & 15;
        if (i == 0) continue;
        if (tid < 32) cnt[tid] = 0;
        __syncthreads();
        const float* kmp = KMEAN + ((size_t)bh * 32 + r32) * 128 + 8 * hh;
        const size_t tok = (size_t)b * SEQ + i * 256 + wv * 32 + r32;
        const bf16_t* qp = QR + tok * DM + h * 128 + 8 * hh;
        f32x16 S;
#pragma unroll
        for (int e = 0; e < 16; ++e) S[e] = 0.f;
#pragma unroll
        for (int s2 = 0; s2 < 8; ++s2) {
            const f32x4 ka = *(const f32x4*)(kmp + 16 * s2), kb = *(const f32x4*)(kmp + 16 * s2 + 4);
            const bf16x8 qf = *(const bf16x8*)(qp + 16 * s2);
            u32x4 hi, lo;
            hi.x = pk_bf16(ka[0], ka[1]); hi.y = pk_bf16(ka[2], ka[3]); hi.z = pk_bf16(kb[0], kb[1]); hi.w = pk_bf16(kb[2], kb[3]);
            lo.x = pk_bf16(ka[0] - bflo(hi.x), ka[1] - bfhi(hi.x)); lo.y = pk_bf16(ka[2] - bflo(hi.y), ka[3] - bfhi(hi.y));
            lo.z = pk_bf16(kb[0] - bflo(hi.z), kb[1] - bfhi(hi.z)); lo.w = pk_bf16(kb[2] - bflo(hi.w), kb[3] - bfhi(hi.w));
            S = __builtin_amdgcn_mfma_f32_32x32x16_bf16(__builtin_bit_cast(bf16x8, hi), qf, S, 0, 0, 0);
            S = __builtin_amdgcn_mfma_f32_32x32x16_bf16(__builtin_bit_cast(bf16x8, lo), qf, S, 0, 0, 0);
        }
        float v0 = -3e38f, v1 = -3e38f, v2 = -3e38f; int i0 = 99, i1 = 99, i2 = 99;
#pragma unroll
        for (int e = 0; e < 16; ++e) {
            const int m = (e & 3) + 8 * (e >> 2) + 4 * hh;
            const float x = m < i ? S[e] : NEG;
            top3_insert(x, m, v0, i0, v1, i1, v2, i2);
        }
        {
            const float pv0 = __shfl_xor(v0, 32), pv1 = __shfl_xor(v1, 32), pv2 = __shfl_xor(v2, 32);
            const int pi0 = __shfl_xor(i0, 32), pi1 = __shfl_xor(i1, 32), pi2 = __shfl_xor(i2, 32);
            top3_insert(pv0, pi0, v0, i0, v1, i1, v2, i2); top3_insert(pv1, pi1, v0, i0, v1, i1, v2, i2); top3_insert(pv2, pi2, v0, i0, v1, i1, v2, i2);
        }
        if (hh == 0) {
            const int tl = wv * 32 + r32;
            if (v0 > 0.5f * NEG) { const int p = __hip_atomic_fetch_add(cnt + i0, 1, __ATOMIC_RELAXED, __HIP_MEMORY_SCOPE_WORKGROUP); bucket[i0 * 256 + p] = (unsigned short)(tl | (0 << 8)); }
            if (v1 > 0.5f * NEG) { const int p = __hip_atomic_fetch_add(cnt + i1, 1, __ATOMIC_RELAXED, __HIP_MEMORY_SCOPE_WORKGROUP); bucket[i1 * 256 + p] = (unsigned short)(tl | (1 << 8)); }
            if (v2 > 0.5f * NEG) { const int p = __hip_atomic_fetch_add(cnt + i2, 1, __ATOMIC_RELAXED, __HIP_MEMORY_SCOPE_WORKGROUP); bucket[i2 * 256 + p] = (unsigned short)(tl | (2 << 8)); }
        }
        __syncthreads();
        for (int idx = tid; idx < 32 * 256; idx += 512) {
            const int j = idx >> 8, p = idx & 255;
            if (j < i && p < cnt[j]) SUB[(((size_t)bh * 32 + j) * 32 + i) * 256 + p] = bucket[idx];
        }
        if (tid < i) CNT[((size_t)bh * 32 + tid) * 32 + i] = cnt[tid];
        __syncthreads();
    }
}

__device__ __forceinline__ unsigned off_b(unsigned row, unsigned ch) { return 256u * row + 16u * (ch ^ (((row & 3u) << 2) | ((row >> 2) & 3u))); }
__device__ __forceinline__ unsigned pi32(unsigned m) { return (m & ~12u) | ((m & 4u) << 1) | ((m & 8u) >> 1); }
__device__ __forceinline__ bf16x8 tr_frag(LAS unsigned char* img, unsigned lane, unsigned c, unsigned ks) {
    const unsigned hh = lane >> 5, blk = (lane >> 4) & 1, q = (lane & 15) >> 2, p = lane & 3;
    const unsigned a0 = off_b(16 * ks + 8 * hh + q, 4 * c + 2 * blk + (p >> 1)) + 8 * (p & 1);
    const unsigned a1 = off_b(16 * ks + 8 * hh + 4 + q, 4 * c + 2 * blk + (p >> 1)) + 8 * (p & 1);
    const s16x4 lo = __builtin_amdgcn_ds_read_tr16_b64_v4i16((LAS s16x4*)(img + a0));
    const s16x4 hi = __builtin_amdgcn_ds_read_tr16_b64_v4i16((LAS s16x4*)(img + a1));
    bf16x8 r; r[0] = lo[0]; r[1] = lo[1]; r[2] = lo[2]; r[3] = lo[3]; r[4] = hi[0]; r[5] = hi[1]; r[6] = hi[2]; r[7] = hi[3];
    return r;
}
__device__ __forceinline__ void phase_att(LAS unsigned char* lds, const bf16_t* QR, const bf16_t* KR, const bf16_t* V, const float* KNMAX, const unsigned short* SUB, const int* CNT, int* ctr,
                                          bf16_t* P012, bf16_t* P3, float* LS) {
    const int tid = threadIdx.x, lane = tid & 63, wv = tid >> 6, r32 = lane & 31, hh = lane >> 5;
    LAS unsigned char* Kimg = lds;
    LAS unsigned char* Vimg = lds + 65536;
    LAS int* misc = (LAS int*)(lds + 131072);
    const float SCL2 = 0.08838834764831845f * 1.4426950408889634f;
    for (;;) {
        __syncthreads();
        if (tid == 0) misc[40] = __hip_atomic_fetch_add(ctr, 1, __ATOMIC_RELAXED, __HIP_MEMORY_SCOPE_AGENT);
        __syncthreads();
        const int item = misc[40];
        if (item >= 2 * NHEAD * 32) break;
        const int j = item >> 5, bh = item & 31, b = bh >> 4, h = bh & 15;
#pragma unroll
        for (int r = 0; r < 8; ++r) {
            const int idx = tid + 512 * r, row = idx >> 4, ch = idx & 15;
            const size_t g = ((size_t)b * SEQ + j * 256 + row) * DM + h * 128 + ch * 8;
            const u32x4 kv = *(const u32x4*)(KR + g), vv = *(const u32x4*)(V + g);
            *(LAS u32x4*)(Kimg + off_b(row, ch)) = kv; *(LAS u32x4*)(Vimg + off_b(row, ch)) = vv;
        }
        if (tid <= 32) { int pre = 0; for (int u = j + 1; u < tid; ++u) pre += CNT[((size_t)bh * 32 + j) * 32 + u]; misc[tid] = pre; }
        float kn = (lane < 32) ? KNMAX[bh * 32 + lane] : 0.f;
        kn = wave_max(kn);
        __syncthreads();
        const int total = misc[32], ntile = (256 + total + 31) >> 5;
        for (int tile = wv; tile < ntile; tile += 8) {
            const int gr = tile * 32 + r32;
            int pos, slot; bool valid = true;
            if (gr < 256) { pos = j * 256 + gr; slot = 3; }
            else {
                const int x = gr - 256; valid = x < total;
                int ii = j + 1;
                for (int u = j + 1; u < 32; ++u) if (misc[u] <= x) ii = u;
                if (valid) { const unsigned e = SUB[(((size_t)bh * 32 + j) * 32 + ii) * 256 + (x - misc[ii])]; pos = ii * 256 + (int)(e & 255u); slot = (int)(e >> 8); }
                else { pos = j * 256; slot = 3; }
            }
            const size_t tok = (size_t)b * SEQ + pos;
            bf16x8 qf[8];
            const bf16_t* qp = QR + tok * DM + h * 128 + 8 * hh;
#pragma unroll
            for (int s = 0; s < 8; ++s) qf[s] = *(const bf16x8*)(qp + 16 * s);
            float qn2 = 0.f;
#pragma unroll
            for (int s = 0; s < 8; ++s)
#pragma unroll
                for (int e = 0; e < 8; ++e) { const float f = bf2f((bf16_t)qf[s][e]); qn2 += f * f; }
            qn2 += __shfl_xor(qn2, 32);
            const float c2 = sqrtf(qn2) * kn * SCL2;
            f32x16 O[4];
#pragma unroll
            for (int dt = 0; dt < 4; ++dt)
#pragma unroll
                for (int e = 0; e < 16; ++e) O[dt][e] = 0.f;
            float l = 0.f;
            const bool own = tile < 8;
            const int kcn = own ? tile + 1 : 8;
            const unsigned krow = pi32((unsigned)r32);
            for (int kc = 0; kc < kcn; ++kc) {
                f32x16 S;
#pragma unroll
                for (int e = 0; e < 16; ++e) S[e] = 0.f;
#pragma unroll
                for (int s = 0; s < 8; ++s) {
                    const bf16x8 kf = *(const LAS bf16x8*)(Kimg + off_b(32 * kc + krow, 2 * s + hh));
                    S = __builtin_amdgcn_mfma_f32_32x32x16_bf16(kf, qf[s], S, 0, 0, 0);
                }
                float p[16];
#pragma unroll
                for (int e = 0; e < 16; ++e) {
                    const unsigned m = (e & 3) + 8 * (e >> 2) + 4 * hh;
                    const int key = j * 256 + 32 * kc + (int)pi32(m);
                    float pe = __builtin_amdgcn_exp2f(S[e] * SCL2 - c2);
                    if (own && key > pos) pe = 0.f;
                    p[e] = pe; l += pe;
                }
                u32x4 w0, w1;
                w0.x = pk_bf16(p[0], p[1]); w0.y = pk_bf16(p[2], p[3]); w0.z = pk_bf16(p[4], p[5]); w0.w = pk_bf16(p[6], p[7]);
                w1.x = pk_bf16(p[8], p[9]); w1.y = pk_bf16(p[10], p[11]); w1.z = pk_bf16(p[12], p[13]); w1.w = pk_bf16(p[14], p[15]);
                const bf16x8 pf0 = __builtin_bit_cast(bf16x8, w0), pf1 = __builtin_bit_cast(bf16x8, w1);
#pragma unroll
                for (int dt = 0; dt < 4; ++dt) {
                    const bf16x8 v0 = tr_frag(Vimg, lane, dt, 2 * kc), v1 = tr_frag(Vimg, lane, dt, 2 * kc + 1);
                    O[dt] = __builtin_amdgcn_mfma_f32_32x32x16_bf16(v0, pf0, O[dt], 0, 0, 0);
                    O[dt] = __builtin_amdgcn_mfma_f32_32x32x16_bf16(v1, pf1, O[dt], 0, 0, 0);
                }
            }
            l += __shfl_xor(l, 32);
            if (valid) {
                bf16_t* pl = (slot < 3 ? P012 + (size_t)slot * ((size_t)32 << 20) : P3) + (tok * NHEAD + h) * 128 + 4 * hh;
#pragma unroll
                for (int dt = 0; dt < 4; ++dt)
#pragma unroll
                    for (int g = 0; g < 4; ++g) {
                        u32x2 w; w.x = pk_bf16(O[dt][4 * g], O[dt][4 * g + 1]); w.y = pk_bf16(O[dt][4 * g + 2], O[dt][4 * g + 3]);
                        *(u32x2*)(pl + 32 * dt + 8 * g) = w;
                    }
                if (hh == 0) LS[(size_t)slot * MTOK * NHEAD + tok * NHEAD + h] = l;
            }
        }
    }
}
__device__ __forceinline__ void phase_comb(const bf16_t* P012, const bf16_t* P3, const float* LS, bf16_t* AO) {
    const size_t n = (size_t)MTOK * NHEAD * 16, stride = (size_t)gridDim.x * 512;
    for (size_t idx = (size_t)blockIdx.x * 512 + threadIdx.x; idx < n; idx += stride) {
        const size_t th = idx >> 4; const int ch = (int)(idx & 15);
        const int t = (int)((th >> 4) & (SEQ - 1)), blk = t >> 8, nsel = blk < 3 ? blk : 3;
        float acc[8];
        float l = LS[(size_t)3 * MTOK * NHEAD + th];
        { const u32x4 w = *(const u32x4*)(P3 + th * 128 + ch * 8);
          acc[0] = bflo(w.x); acc[1] = bfhi(w.x); acc[2] = bflo(w.y); acc[3] = bfhi(w.y); acc[4] = bflo(w.z); acc[5] = bfhi(w.z); acc[6] = bflo(w.w); acc[7] = bfhi(w.w); }
        for (int s = 0; s < nsel; ++s) {
            const u32x4 w = *(const u32x4*)(P012 + (size_t)s * ((size_t)32 << 20) + th * 128 + ch * 8);
            acc[0] += bflo(w.x); acc[1] += bfhi(w.x); acc[2] += bflo(w.y); acc[3] += bfhi(w.y); acc[4] += bflo(w.z); acc[5] += bfhi(w.z); acc[6] += bflo(w.w); acc[7] += bfhi(w.w);
            l += LS[(size_t)s * MTOK * NHEAD + th];
        }
        const float rl = 1.0f / l;
        u32x4 o; o.x = pk_bf16(acc[0] * rl, acc[1] * rl); o.y = pk_bf16(acc[2] * rl, acc[3] * rl); o.z = pk_bf16(acc[4] * rl, acc[5] * rl); o.w = pk_bf16(acc[6] * rl, acc[7] * rl);
        *(u32x4*)(AO + th * 128 + ch * 8) = o;
    }
}


__device__ __forceinline__ void qrow_issue(f32x4 (&v)[8], const float* p, int lane) {
#pragma unroll
    for (int i = 0; i < 2; ++i)
#pragma unroll
        for (int q = 0; q < 4; ++q) v[i * 4 + q] = *(const f32x4*)(p + 1024 * i + 16 * lane + 4 * q);
}
__device__ __forceinline__ void qrow_finish(const f32x4 (&v)[8], unsigned char* dst, float* scl, int lane) {
    float am = 0.f;
#pragma unroll
    for (int i = 0; i < 8; ++i) am = fmaxf(am, fmaxf(fmaxf(fabsf(v[i][0]), fabsf(v[i][1])), fmaxf(fabsf(v[i][2]), fabsf(v[i][3]))));
    am = fmaxf(wave_max(am), 1e-30f);
    const float inv = 127.0f / am;
    if (lane == 0) *scl = am * (1.0f / 127.0f);
#pragma unroll
    for (int i = 0; i < 2; ++i) {
        u32x4 w;
#pragma unroll
        for (int q = 0; q < 4; ++q) {
            const f32x4 t = v[i * 4 + q];
            const unsigned b0 = (unsigned)(int)(rintf(t[0] * inv) + 128.0f), b1 = (unsigned)(int)(rintf(t[1] * inv) + 128.0f), b2 = (unsigned)(int)(rintf(t[2] * inv) + 128.0f), b3 = (unsigned)(int)(rintf(t[3] * inv) + 128.0f);
            w[q] = b0 | (b1 << 8) | (b2 << 16) | (b3 << 24);
        }
        *(u32x4*)(dst + 1024 * i + 16 * lane) = w;
    }
}
struct QuantJob { const float* TU; const float* TV; unsigned char* QU; unsigned char* QV; float* SU; float* SV; };
__device__ __forceinline__ const float* qj_src(const QuantJob& q, int r) { return (r < 16384 ? q.TU : q.TV) + (size_t)(r & 16383) * DM; }
__device__ __forceinline__ unsigned char* qj_dst(const QuantJob& q, int r) { return (r < 16384 ? q.QU : q.QV) + (size_t)(r & 16383) * DM; }
__device__ __forceinline__ float* qj_scl(const QuantJob& q, int r) { return (r < 16384 ? q.SU : q.SV) + (r & 16383); }
__device__ __forceinline__ void qj_tail(const QuantJob& q, int done_iters) {
    const int lane = threadIdx.x & 63, gw = blockIdx.x * 8 + (threadIdx.x >> 6), nw = gridDim.x * 8;
    for (int r = gw + done_iters * nw; r < 32768; r += nw) { f32x4 v[8]; qrow_issue(v, qj_src(q, r), lane); qrow_finish(v, qj_dst(q, r), qj_scl(q, r), lane); }
}
__device__ __forceinline__ float logf_gate(float z, float lb) { return __logf(lb + (1.0f - lb) * sigmoidf_(z)); }
__device__ __forceinline__ void phase_scan_a(LAS unsigned char* lds, const bf16_t* FZ, const float* LB, const bf16_t* I1, bf16_t* LT, float* DEC, const QuantJob qj, unsigned* dbgc = nullptr) {
    unsigned dbg_kt = 0, dbg_acc = 0;
    const int tid = threadIdx.x, lane = tid & 63, wv = tid >> 6, k = tid & 127, part = tid >> 7;
    LAS unsigned char* Iimg = lds; LAS unsigned char* KTimg = lds + 16384;
    LAS float* psum = (LAS float*)(lds + 32768);
    LAS unsigned char* Lst = lds + 36864;
#if SCAN_A_VALU == 2
    for (int item = blockIdx.x; item < 2 * NHEAD * 128; item += gridDim.x) {
        const int bh = item >> 7, c = item & 127, b = bh >> 4, h = bh & 15;
        const size_t tok0 = (size_t)b * SEQ + c * 64;
        for (int idx = tid; idx < 16384; idx += 512) {
            const int v = idx >> 7, kk = idx & 127;
            float g = 1.f, L = 0.f;
            for (int s2 = 63; s2 >= 0; --s2) { const size_t o = (tok0 + s2) * DM + h * 128; const float f = __expf(logf_gate(bf2f(FZ[o + kk]), LB[h * 128 + kk])); L += bf2f(I1[o + v]) * (1.0f - f) * g; g *= f; }
            LT[(size_t)item * 16384 + idx] = (bf16_t)(pk_bf16(L, 0.f) & 0xffffu);
        }
    }
    return;
#endif
    bf16_t nfz[16]; u32x4 nit_[2];
#define SA_LOAD(item_) { const int bh_ = (item_) >> 7, c_ = (item_) & 127; const size_t t0_ = (size_t)(bh_ >> 4) * SEQ + c_ * 64; const int h_ = bh_ & 15; \
        _Pragma("unroll") for (int i = 0; i < 16; ++i) nfz[i] = FZ[(t0_ + 16 * part + i) * DM + h_ * 128 + k]; \
        _Pragma("unroll") for (int r = 0; r < 2; ++r) { const int idx = tid + 512 * r, row = idx >> 4, ch = idx & 15; nit_[r] = *(const u32x4*)(I1 + (t0_ + row) * DM + h_ * 128 + ch * 8); } }
    if ((int)blockIdx.x < 2 * NHEAD * 128) SA_LOAD((int)blockIdx.x)
    int qiter = 0;
    for (int item = blockIdx.x; item < 2 * NHEAD * 128; item += gridDim.x, ++qiter) {
        const int bh = item >> 7, c = item & 127, b = bh >> 4, h = bh & 15;
        const size_t tok0 = (size_t)b * SEQ + c * 64;
        float lf[16];
        const float lbk = LB[h * 128 + k];
#pragma unroll
        for (int i = 0; i < 16; ++i) lf[i] = logf_gate(bf2f(nfz[i]), lbk);
#pragma unroll
        for (int r = 0; r < 2; ++r) { const int idx = tid + 512 * r, row = idx >> 4, ch = idx & 15; *(LAS u32x4*)(Iimg + off_b(row, ch)) = nit_[r]; }
        if (item + (int)gridDim.x < 2 * NHEAD * 128) SA_LOAD(item + (int)gridDim.x)
        const int qrow = qiter * (int)gridDim.x * 8 + (int)blockIdx.x * 8 + wv; const bool doq = qrow < 32768; f32x4 qv8[8];
        if (doq) qrow_issue(qv8, qj_src(qj, qrow), lane);
        float cs = 0.f;
#pragma unroll
        for (int i = 0; i < 16; ++i) cs += lf[i];
        psum[part * 128 + k] = cs;
        __syncthreads();
        const float p0 = psum[k], p1 = psum[128 + k], p2 = psum[256 + k], p3 = psum[384 + k];
        const float blast = (p0 + p1) + (p2 + p3);
        float bb = part == 0 ? 0.f : (part == 1 ? p0 : (part == 2 ? p0 + p1 : p0 + p1 + p2));
#pragma unroll
        for (int i = 0; i < 16; ++i) {
            bb += lf[i];
            const float kt = (1.0f - __expf(lf[i])) * __expf(blast - bb);
            if (!(kt - kt == 0.f)) ++dbg_kt;
            const int srow = 16 * part + i;
            *(LAS bf16_t*)(KTimg + off_b(srow, k >> 3) + 2 * (k & 7)) = (bf16_t)(pk_bf16(kt, 0.f) & 0xffffu);
        }
        if (part == 0) DEC[(size_t)item * 128 + k] = __expf(blast);
        __syncthreads();
#if SCAN_A_VALU
        for (int idx = tid; idx < 16384; idx += 512) {
            const int v = idx >> 7, kk = idx & 127;
            float accv = 0.f;
            for (int s2 = 0; s2 < 64; ++s2) accv += bf2f(*(const LAS bf16_t*)(Iimg + off_b(s2, v >> 3) + 2 * (v & 7))) * bf2f(*(const LAS bf16_t*)(KTimg + off_b(s2, kk >> 3) + 2 * (kk & 7)));
            *(LAS bf16_t*)(Lst + v * 272 + 2 * kk) = (bf16_t)(pk_bf16(accv, 0.f) & 0xffffu);
        }
        if (0)
#endif
        {
            const int vt = wv >> 1;
            f32x16 acc0, acc1;
#pragma unroll
            for (int e = 0; e < 16; ++e) { acc0[e] = 0.f; acc1[e] = 0.f; }
#pragma unroll
            for (int ks = 0; ks < 4; ++ks) {
                const bf16x8 af = tr_frag(Iimg, lane, vt, ks);
                const bf16x8 b0 = tr_frag(KTimg, lane, 2 * (wv & 1), ks), b1 = tr_frag(KTimg, lane, 2 * (wv & 1) + 1, ks);
                acc0 = __builtin_amdgcn_mfma_f32_32x32x16_bf16(af, b0, acc0, 0, 0, 0);
                acc1 = __builtin_amdgcn_mfma_f32_32x32x16_bf16(af, b1, acc1, 0, 0, 0);
            }
            const int r32 = lane & 31, hh = lane >> 5;
#pragma unroll
            for (int e = 0; e < 16; ++e) {
                if (!(acc0[e] - acc0[e] == 0.f)) ++dbg_acc; if (!(acc1[e] - acc1[e] == 0.f)) ++dbg_acc;
                const int v = 32 * vt + (e & 3) + 8 * (e >> 2) + 4 * hh;
                *(LAS bf16_t*)(Lst + v * 272 + 2 * (64 * (wv & 1) + r32)) = (bf16_t)(pk_bf16(acc0[e], 0.f) & 0xffffu);
                *(LAS bf16_t*)(Lst + v * 272 + 2 * (64 * (wv & 1) + 32 + r32)) = (bf16_t)(pk_bf16(acc1[e], 0.f) & 0xffffu);
            }
        }
        __syncthreads();
#pragma unroll
        for (int r = 0; r < 4; ++r) { const int idx = tid + 512 * r, row = idx >> 4, ch = idx & 15; *(u32x4*)(LT + (size_t)item * 16384 + row * 128 + ch * 8) = *(const LAS u32x4*)(Lst + row * 272 + ch * 16); }
        if (doq) qrow_finish(qv8, qj_dst(qj, qrow), qj_scl(qj, qrow), lane);
        __syncthreads();
    }
    qj_tail(qj, qiter);
    if (dbgc) { if (dbg_kt) atomicAdd(dbgc + 0, dbg_kt); if (dbg_acc) atomicAdd(dbgc + 1, dbg_acc); }
}
__device__ __forceinline__ void phase_scan_b(bf16_t* LT, const float* DEC, const QuantJob qj) {
    const int n = 2 * NHEAD * 128 * 32;
    const int lane = threadIdx.x & 63, gw = blockIdx.x * 8 + (threadIdx.x >> 6), nw = gridDim.x * 8;
    int qdone = 0;
    for (int idx = blockIdx.x * 512 + threadIdx.x; idx < n; idx += gridDim.x * 512) {
        const int bh = idx >> 12, vk = idx & 4095, k4 = (vk & 31) * 4;
        float S0 = 0.f, S1 = 0.f, S2 = 0.f, S3 = 0.f;
        bf16_t* p = LT + (size_t)bh * 128 * 16384 + (size_t)vk * 4;
        const float* dp = DEC + (size_t)bh * 128 * 128 + k4;
        for (int c8 = 0; c8 < 16; ++c8) {
            const int qrow = (qdone + c8) * nw + gw; const bool doq = qrow < 32768; f32x4 qv8[8];
            if (doq) qrow_issue(qv8, qj_src(qj, qrow), lane);
#pragma unroll
            for (int c2 = 0; c2 < 8; ++c2) {
                const int c = c8 * 8 + c2;
                const u32x2 w = *(const u32x2*)(p + (size_t)c * 16384);
                const f32x4 d = *(const f32x4*)(dp + c * 128);
                u32x2 o; o.x = pk_bf16(S0, S1); o.y = pk_bf16(S2, S3);
                *(u32x2*)(p + (size_t)c * 16384) = o;
                S0 = d[0] * S0 + bflo(w.x); S1 = d[1] * S1 + bfhi(w.x); S2 = d[2] * S2 + bflo(w.y); S3 = d[3] * S3 + bfhi(w.y);
            }
            if (doq) qrow_finish(qv8, qj_dst(qj, qrow), qj_scl(qj, qrow), lane);
        }
        qdone += 16;
    }
    qj_tail(qj, qdone);
}
__device__ __forceinline__ void phase_scan_c(LAS unsigned char* lds, const bf16_t* Q1, const bf16_t* FZ, const float* LB, const bf16_t* I1, const bf16_t* G1, const bf16_t* SP, const float* gnorm, bf16_t* OG) {
    const int tid = threadIdx.x, lane = tid & 63, wv = tid >> 6, k = tid & 127, part = tid >> 7, r32 = lane & 31, hh = lane >> 5;
    LAS unsigned char* QTimg = lds; LAS unsigned char* QPimg = lds + 16384; LAS unsigned char* KPimg = lds + 32768; LAS unsigned char* Iimg = lds + 49152; LAS unsigned char* SPimg = lds + 65536;
    LAS float* psum = (LAS float*)(lds + 98304);
    LAS float* ssq = (LAS float*)(lds + 100352);
    LAS unsigned char* OT = lds + 102400;
    bf16_t nfz[16], nq[16]; u32x4 nit_[2], nsp[4], ngt[2];
#define SC_LOAD(item_) { const int bh_ = (item_) >> 7, c_ = (item_) & 127; const size_t t0_ = (size_t)(bh_ >> 4) * SEQ + c_ * 64; const int h_ = bh_ & 15; \
        _Pragma("unroll") for (int i = 0; i < 16; ++i) { const size_t o_ = (t0_ + 16 * part + i) * DM + h_ * 128 + k; nfz[i] = FZ[o_]; nq[i] = Q1[o_]; } \
        _Pragma("unroll") for (int r = 0; r < 2; ++r) { const int idx = tid + 512 * r, row = idx >> 4, ch = idx & 15; nit_[r] = *(const u32x4*)(I1 + (t0_ + row) * DM + h_ * 128 + ch * 8); ngt[r] = *(const u32x4*)(G1 + (t0_ + row) * DM + h_ * 128 + ch * 8); } \
        _Pragma("unroll") for (int r = 0; r < 4; ++r) { const int idx = tid + 512 * r, row = idx >> 4, ch = idx & 15; nsp[r] = *(const u32x4*)(SP + (size_t)(item_) * 16384 + row * 128 + ch * 8); } }
    if ((int)blockIdx.x < 2 * NHEAD * 128) SC_LOAD((int)blockIdx.x)
    for (int item = blockIdx.x; item < 2 * NHEAD * 128; item += gridDim.x) {
        const int bh = item >> 7, c = item & 127, b = bh >> 4, h = bh & 15;
        const size_t tok0 = (size_t)b * SEQ + c * 64;
        float lf[16], qv[16];
        const float lbk = LB[h * 128 + k];
#pragma unroll
        for (int i = 0; i < 16; ++i) { lf[i] = logf_gate(bf2f(nfz[i]), lbk); const float qr = bf2f(nq[i]); qv[i] = qr * sigmoidf_(qr); }
#pragma unroll
        for (int r = 0; r < 2; ++r) { const int idx = tid + 512 * r, row = idx >> 4, ch = idx & 15; *(LAS u32x4*)(Iimg + off_b(row, ch)) = nit_[r]; }
#pragma unroll
        for (int r = 0; r < 4; ++r) { const int idx = tid + 512 * r, row = idx >> 4, ch = idx & 15; *(LAS u32x4*)(SPimg + off_b(row, ch)) = nsp[r]; }
        const u32x4 gcur0 = ngt[0], gcur1 = ngt[1];
        if (item + (int)gridDim.x < 2 * NHEAD * 128) SC_LOAD(item + (int)gridDim.x)
        float cs = 0.f;
#pragma unroll
        for (int i = 0; i < 16; ++i) cs += lf[i];
        psum[part * 128 + k] = cs;
        __syncthreads();
        const float p0 = psum[k], p1 = psum[128 + k], p2 = psum[256 + k];
        const float rr = p0 + p1;
        float bb = part == 0 ? 0.f : (part == 1 ? p0 : (part == 2 ? p0 + p1 : p0 + p1 + p2));
#pragma unroll
        for (int i = 0; i < 16; ++i) {
            bb += lf[i];
            const float qt = qv[i] * __expf(bb), qp = qv[i] * __expf(bb - rr), kp = (1.0f - __expf(lf[i])) * __expf(rr - bb);
            const unsigned o = off_b(16 * part + i, k >> 3) + 2 * (k & 7);
            *(LAS bf16_t*)(QTimg + o) = (bf16_t)(pk_bf16(qt, 0.f) & 0xffffu);
            *(LAS bf16_t*)(QPimg + o) = (bf16_t)(pk_bf16(qp, 0.f) & 0xffffu);
            *(LAS bf16_t*)(KPimg + o) = (bf16_t)(pk_bf16(kp, 0.f) & 0xffffu);
        }
        __syncthreads();
        const int tt = wv & 1, vt = wv >> 1;
        f32x16 O;
#pragma unroll
        for (int e = 0; e < 16; ++e) O[e] = 0.f;
#pragma unroll
        for (int ks = 0; ks < 8; ++ks) {
            const bf16x8 af = *(const LAS bf16x8*)(SPimg + off_b(32 * vt + r32, 2 * ks + hh));
            const bf16x8 bf = *(const LAS bf16x8*)(QTimg + off_b(32 * tt + r32, 2 * ks + hh));
            O = __builtin_amdgcn_mfma_f32_32x32x16_bf16(af, bf, O, 0, 0, 0);
        }
        const unsigned krow = pi32((unsigned)r32);
        for (int st = 0; st <= tt; ++st) {
            f32x16 S;
#pragma unroll
            for (int e = 0; e < 16; ++e) S[e] = 0.f;
#pragma unroll
            for (int ks = 0; ks < 8; ++ks) {
                const bf16x8 af = *(const LAS bf16x8*)(KPimg + off_b(32 * st + krow, 2 * ks + hh));
                const bf16x8 bf = *(const LAS bf16x8*)(QPimg + off_b(32 * tt + r32, 2 * ks + hh));
                S = __builtin_amdgcn_mfma_f32_32x32x16_bf16(af, bf, S, 0, 0, 0);
            }
            float p[16];
#pragma unroll
            for (int e = 0; e < 16; ++e) {
                const unsigned m = (e & 3) + 8 * (e >> 2) + 4 * hh;
                const int sidx = 32 * st + (int)pi32(m), tidx = 32 * tt + r32;
                p[e] = sidx <= tidx ? S[e] : 0.f;
            }
            u32x4 w0, w1;
            w0.x = pk_bf16(p[0], p[1]); w0.y = pk_bf16(p[2], p[3]); w0.z = pk_bf16(p[4], p[5]); w0.w = pk_bf16(p[6], p[7]);
            w1.x = pk_bf16(p[8], p[9]); w1.y = pk_bf16(p[10], p[11]); w1.z = pk_bf16(p[12], p[13]); w1.w = pk_bf16(p[14], p[15]);
            const bf16x8 pf0 = __builtin_bit_cast(bf16x8, w0), pf1 = __builtin_bit_cast(bf16x8, w1);
            const bf16x8 i0 = tr_frag(Iimg, lane, vt, 2 * st), i1 = tr_frag(Iimg, lane, vt, 2 * st + 1);
            O = __builtin_amdgcn_mfma_f32_32x32x16_bf16(i0, pf0, O, 0, 0, 0);
            O = __builtin_amdgcn_mfma_f32_32x32x16_bf16(i1, pf1, O, 0, 0, 0);
        }
        float sq = 0.f;
#pragma unroll
        for (int e = 0; e < 16; ++e) sq += O[e] * O[e];
        sq += __shfl_xor(sq, 32);
        if (hh == 0) ssq[vt * 64 + 32 * tt + r32] = sq;
        __syncthreads();
        const int tl = 32 * tt + r32;
        const float rstd = rsqrtf((ssq[tl] + ssq[64 + tl] + ssq[128 + tl] + ssq[192 + tl]) * (1.0f / 128.0f) + 1e-6f);
#pragma unroll
        for (int g = 0; g < 4; ++g) {
            const int v0 = 32 * vt + 8 * g + 4 * hh;
            const f32x4 gn = *(const f32x4*)(gnorm + v0);
            u32x2 w; w.x = pk_bf16(O[4 * g] * rstd * gn[0], O[4 * g + 1] * rstd * gn[1]); w.y = pk_bf16(O[4 * g + 2] * rstd * gn[2], O[4 * g + 3] * rstd * gn[3]);
            *(LAS u32x2*)(OT + tl * 272 + v0 * 2) = w;
        }
        __syncthreads();
#pragma unroll
        for (int r = 0; r < 2; ++r) {
            const int idx = tid + 512 * r, row = idx >> 4, ch = idx & 15;
            const u32x4 ov = *(const LAS u32x4*)(OT + row * 272 + ch * 16);
            const size_t go = (tok0 + row) * DM + h * 128 + ch * 8;
            const u32x4 gv = r == 0 ? gcur0 : gcur1;
            u32x4 w;
#define SILU_(x_) ((x_) * sigmoidf_(x_))
            w.x = pk_bf16(bflo(ov.x) * SILU_(bflo(gv.x)), bfhi(ov.x) * SILU_(bfhi(gv.x))); w.y = pk_bf16(bflo(ov.y) * SILU_(bflo(gv.y)), bfhi(ov.y) * SILU_(bfhi(gv.y)));
            w.z = pk_bf16(bflo(ov.z) * SILU_(bflo(gv.z)), bfhi(ov.z) * SILU_(bfhi(gv.z))); w.w = pk_bf16(bflo(ov.w) * SILU_(bflo(gv.w)), bfhi(ov.w) * SILU_(bfhi(gv.w)));
#undef SILU_
            *(u32x4*)(OG + go) = w;
        }
        __syncthreads();
    }
}


#if SCAN_DBG == 2
__device__ __forceinline__ void dbg_compare(LAS float* red, const bf16_t* A, const bf16_t* B, float* DBG) {
    float sd = 0.f, sr = 0.f, nn = 0.f;
    const size_t n = (size_t)MTOK * DM;
    for (size_t i = (size_t)blockIdx.x * 512 + threadIdx.x; i < n; i += (size_t)gridDim.x * 512) {
        const float x = bf2f(A[i]), y = bf2f(B[i]);
        if (!(x - x == 0.f)) nn += 1.f; else { sd += (x - y) * (x - y); sr += y * y; }
    }
    sd = wave_sum(sd); sr = wave_sum(sr); nn = wave_sum(nn);
    const int wv = threadIdx.x >> 6;
    if ((threadIdx.x & 63) == 0) { red[wv * 3] = sd; red[wv * 3 + 1] = sr; red[wv * 3 + 2] = nn; }
    __syncthreads();
    if (threadIdx.x == 0) { float a = 0, b = 0, c = 0; for (int w = 0; w < 8; ++w) { a += red[w * 3]; b += red[w * 3 + 1]; c += red[w * 3 + 2]; } DBG[blockIdx.x * 4] = a; DBG[blockIdx.x * 4 + 1] = b; DBG[blockIdx.x * 4 + 2] = c; }
    __syncthreads();
}
__device__ __forceinline__ void dbg_emit(const float* DBG, float* out) {
    float a = 0, b = 0, c = 0;
    for (int w = 0; w < (int)gridDim.x; ++w) { a += DBG[w * 4]; b += DBG[w * 4 + 1]; c += DBG[w * 4 + 2]; }
    const float rel = sqrtf(a / b);
    int k = (int)rintf(-2.0f * log10f(rel)); k = k < 0 ? 0 : (k > 16 ? 16 : k);
    if (c > 0.f) k = 17;
    const float cc = sqrtf(0.5f * (float)k);
    const size_t n = (size_t)MTOK * DM;
    for (size_t i = (size_t)blockIdx.x * 512 + threadIdx.x; i < n; i += (size_t)gridDim.x * 512) out[i] = cc;
}
#endif

#if SCAN_DBG == 3
__device__ __forceinline__ void dbg_count_bf16(const bf16_t* A, size_t n, unsigned* cnt) {
    unsigned c = 0;
    for (size_t i = (size_t)blockIdx.x * 512 + threadIdx.x; i < n; i += (size_t)gridDim.x * 512) { const float x = bf2f(A[i]); if (!(x - x == 0.f)) ++c; }
    if (c) atomicAdd(cnt, c);
}
__device__ __forceinline__ void dbg_count_f32(const float* A, size_t n, unsigned* cnt) {
    unsigned c = 0;
    for (size_t i = (size_t)blockIdx.x * 512 + threadIdx.x; i < n; i += (size_t)gridDim.x * 512) { const float x = A[i]; if (!(x - x == 0.f)) ++c; }
    if (c) atomicAdd(cnt, c);
}
__device__ __forceinline__ void dbg_emit3(const unsigned* cnt, float* out) {
    float code = 0.f;
    for (int st = 3; st >= 0; --st) { const unsigned c = cnt[st]; if (c) { float lg = log10f((float)c); lg = lg > 9.f ? 9.f : lg; code = (float)(st + 1) + 0.1f * lg; } }
    const float cc = sqrtf(code);
    const size_t n = (size_t)MTOK * DM;
    for (size_t i = (size_t)blockIdx.x * 512 + threadIdx.x; i < n; i += (size_t)gridDim.x * 512) out[i] = cc;
}
#endif

#if SCAN_DBG == 4 || SCAN_DBG == 6
__device__ __forceinline__ void dbg_compare4(LAS float* red, const bf16_t* A, const bf16_t* B, const bf16_t* C, float* DBG) {
    float sd = 0.f, sr = 0.f, nn = 0.f, mm = 0.f;
    const size_t n = (size_t)MTOK * DM;
    for (size_t i = (size_t)blockIdx.x * 512 + threadIdx.x; i < n; i += (size_t)gridDim.x * 512) {
        const float x = bf2f(A[i]), y = bf2f(B[i]);
        if (!(x - x == 0.f)) nn += 1.f; else { sd += (x - y) * (x - y); sr += y * y; }
        if (A[i] != C[i]) mm += 1.f;
    }
    sd = wave_sum(sd); sr = wave_sum(sr); nn = wave_sum(nn); mm = wave_sum(mm);
    const int wv = threadIdx.x >> 6;
    if ((threadIdx.x & 63) == 0) { red[wv * 4] = sd; red[wv * 4 + 1] = sr; red[wv * 4 + 2] = nn; red[wv * 4 + 3] = mm; }
    __syncthreads();
    if (threadIdx.x == 0) { float a = 0, b = 0, c = 0, d = 0; for (int w = 0; w < 8; ++w) { a += red[w * 4]; b += red[w * 4 + 1]; c += red[w * 4 + 2]; d += red[w * 4 + 3]; }
        DBG[blockIdx.x * 4] = a; DBG[blockIdx.x * 4 + 1] = b; DBG[blockIdx.x * 4 + 2] = c; DBG[blockIdx.x * 4 + 3] = d; }
    __syncthreads();
}
__device__ __forceinline__ void dbg_emit4(const float* DBG, float* out) {
    float a = 0, b = 0, c = 0, d = 0;
    for (int w = 0; w < (int)gridDim.x; ++w) { a += DBG[w * 4]; b += DBG[w * 4 + 1]; c += DBG[w * 4 + 2]; d += DBG[w * 4 + 3]; }
    const float rel = sqrtf(a / b);
    int k = (int)rintf(-log10f(rel)); k = k < 0 ? 0 : (k > 8 ? 8 : k);
#if SCAN_DBG == 6
    const float cc = sqrtf((float)k + ((d + c) > 0.f ? 0.5f : 0.f));
#else
    int m = (int)ceilf(log10f(1.0f + d + c)); m = m > 9 ? 9 : m;
    const float cc = sqrtf((float)k + 0.1f * (float)m);
#endif
    const size_t n = (size_t)MTOK * DM;
    for (size_t i = (size_t)blockIdx.x * 512 + threadIdx.x; i < n; i += (size_t)gridDim.x * 512) out[i] = cc;
}
#endif

#if SCAN_DBG == 5
__device__ __forceinline__ void dbg_lds16_test(LAS unsigned char* lds, unsigned* cnt) {
    const int tid = threadIdx.x;
    unsigned bad = 0;
    for (int rep = 0; rep < 64; ++rep) {
        for (int i = tid; i < 1024; i += 512) *(LAS u32x4*)(lds + i * 16) = (u32x4){0x7fc07fc0u, 0x7fc07fc0u, 0x7fc07fc0u, 0x7fc07fc0u};
        __syncthreads();
        const int k = tid & 127, part = tid >> 7;
#pragma unroll
        for (int i = 0; i < 16; ++i) {
            const int row = 16 * part + i;
            *(LAS bf16_t*)(lds + off_b(row, k >> 3) + 2 * (k & 7)) = (bf16_t)((row * 128 + k + rep) & 0x7fff);
        }
        __syncthreads();
        for (int idx = tid; idx < 64 * 128; idx += 512) {
            const int row = idx >> 7, kk = idx & 127;
            const bf16_t got = *(const LAS bf16_t*)(lds + off_b(row, kk >> 3) + 2 * (kk & 7));
            if (got != (bf16_t)((row * 128 + kk + rep) & 0x7fff)) ++bad;
        }
        __syncthreads();
    }
    if (bad) atomicAdd(cnt, bad);
}
__device__ __forceinline__ void dbg_emit5(const unsigned* cnt, float* out) {
    const unsigned c = cnt[0];
    float code = 0.f;
    if (c) { float lg = log10f((float)c); code = 1.0f + (lg > 8.9f ? 8.9f : lg); }
    const float cc = sqrtf(code);
    const size_t n = (size_t)MTOK * DM;
    for (size_t i = (size_t)blockIdx.x * 512 + threadIdx.x; i < n; i += (size_t)gridDim.x * 512) out[i] = cc;
}
#endif

#if SCAN_DBG == 6
__device__ __forceinline__ void dbg_check_a(LAS float* red, const float* LF, const bf16_t* I1, const bf16_t* LT, const bf16_t* LT2, float* DBG) {
    float sd = 0.f, sr = 0.f, mm = 0.f;
    const size_t n = (size_t)4096 * 16384;
    for (size_t i = (size_t)blockIdx.x * 512 + threadIdx.x; i < n; i += (size_t)gridDim.x * 512) {
        const int item = (int)(i >> 14), v = (int)((i >> 7) & 127), k = (int)(i & 127);
        const int bh = item >> 7, c = item & 127, b = bh >> 4, h = bh & 15;
        const size_t tok0 = (size_t)b * SEQ + c * 64;
        float g = 1.f, L = 0.f;
        for (int s2 = 63; s2 >= 0; --s2) {
            const size_t o = (tok0 + s2) * DM + h * 128;
            const float f = __expf(LF[o + k]);
            L += bf2f(I1[o + v]) * (1.0f - f) * g;
            g *= f;
        }
        const float x = bf2f(LT[i]);
        sd += (x - L) * (x - L); sr += L * L;
        if (LT[i] != LT2[i]) mm += 1.f;
    }
    sd = wave_sum(sd); sr = wave_sum(sr); mm = wave_sum(mm);
    const int wv = threadIdx.x >> 6;
    if ((threadIdx.x & 63) == 0) { red[wv * 4] = sd; red[wv * 4 + 1] = sr; red[wv * 4 + 2] = 0.f; red[wv * 4 + 3] = mm; }
    __syncthreads();
    if (threadIdx.x == 0) { float a = 0, b2 = 0, d = 0; for (int w = 0; w < 8; ++w) { a += red[w * 4]; b2 += red[w * 4 + 1]; d += red[w * 4 + 3]; }
        DBG[blockIdx.x * 4] = a; DBG[blockIdx.x * 4 + 1] = b2; DBG[blockIdx.x * 4 + 2] = 0.f; DBG[blockIdx.x * 4 + 3] = d; }
    __syncthreads();
}
#endif

#if SCAN_DBG == 7
#ifndef DBG_FAM
#define DBG_FAM 0
#endif
__device__ __forceinline__ void dbg_check_a7(const float* LF, const bf16_t* I1, const bf16_t* LT, float* DBG) {
    const size_t n = (size_t)4096 * 16384;
    float nbad = 0.f, nnf = 0.f;
    for (size_t i = (size_t)blockIdx.x * 512 + threadIdx.x; i < n; i += (size_t)gridDim.x * 512 * 8) {
        const int item = (int)(i >> 14), v = (int)((i >> 7) & 127), k = (int)(i & 127);
        const int bh = item >> 7, c = item & 127, b = bh >> 4, h = bh & 15;
        const size_t tok0 = (size_t)b * SEQ + c * 64;
        float g = 1.f, L = 0.f;
        for (int s2 = 63; s2 >= 0; --s2) {
            const size_t o = (tok0 + s2) * DM + h * 128;
            const float f = __expf(LF[o + k]);
            L += bf2f(I1[o + v]) * (1.0f - f) * g;
            g *= f;
        }
        const float x = bf2f(LT[i]);
        if (!(x - x == 0.f)) { nnf += 1.f; nbad += 1.f; }
        else if (fabsf(x - L) > 0.02f * fabsf(L) + 1e-2f) nbad += 1.f;
    }
    nbad = wave_sum(nbad); nnf = wave_sum(nnf);
    if ((threadIdx.x & 63) == 0) { atomicAdd(DBG, nbad); atomicAdd(DBG + 1, nnf); }
}
__device__ __forceinline__ void dbg_emit7(const float* DBG, float* out) {
    const float nb = DBG[0], nf = DBG[1];
    int A = nb == 0.f ? 0 : (nb <= 100.f ? 1 : (nb <= 1e4f ? 3 : (nb <= 1e6f ? 5 : 7)));
    int B = nf == 0.f ? 0 : 5;
    const float cc = sqrtf((float)A + 0.1f * (float)B);
    const size_t n = (size_t)MTOK * DM;
    for (size_t i = (size_t)blockIdx.x * 512 + threadIdx.x; i < n; i += (size_t)gridDim.x * 512) out[i] = cc;
}
#endif
__device__ __forceinline__ int opaque(int v) { asm volatile("" : "+s"(v)); return v; }
template <bool L1> __device__ __forceinline__ void run_gemm_out(const Args& a, LAS unsigned char* lds) {
    unsigned char* ws = a.ws;
    pg8::Gemm g{(const bf16_t*)(ws + (L1 ? slot(3) : slot(0))), (const bf16_t*)(ws + (L1 ? WS_WO : WS_WOUT)), opaque(MTOK), opaque(DM), opaque(DM)};
    pg8::StaticOrder S; S.init(g.M, g.N, (int)gridDim.x, (int)blockIdx.x);
    EpiF32 E{(float*)(ws + (L1 ? slot(4) : slot(1))), DM};
    pg8::gemm_phase<EpiF32, pg8::StaticOrder>(lds, g, S, E, nullptr);
}
template <bool L1> __device__ __forceinline__ void run_ln(const Args& a) {
    unsigned char* ws = a.ws;
    phase_ln<L1>((const float*)(ws + (L1 ? slot(4) : slot(1))), L1 ? (const void*)(ws + slot(2)) : (const void*)a.in[0], a.in[12] + (L1 ? 2 : 0) * DM, a.in[13] + (L1 ? 2 : 0) * DM,
                 (float*)nullptr, (bf16_t*)(ws + (L1 ? slot(8) : slot(5))), (signed char*)(ws + WS_XQ), (float*)(ws + WS_XS));
}
template <bool L1> __device__ __forceinline__ void run_gemm_sc(const Args& a, LAS unsigned char* lds) {
    unsigned char* ws = a.ws;
    pg8::Gemm g{(const bf16_t*)(ws + WS_WC) + (L1 ? (size_t)DM * DM : 0), (const bf16_t*)(ws + (L1 ? slot(8) : slot(5))), opaque(DM), opaque(MTOK), opaque(DM)};
    pg8::StaticOrder S; S.init(g.M, g.N, (int)gridDim.x, (int)blockIdx.x);
    EpiF32 E{(float*)(ws + (L1 ? slot(0) : slot(6))), MTOK};
    pg8::gemm_phase<EpiF32, pg8::StaticOrder>(lds, g, S, E, nullptr);
}
template <bool L1> __device__ __forceinline__ void run_topk(const Args& a, LAS unsigned char* lds) {
    unsigned char* ws = a.ws;
    phase_topk(lds, (const float*)(ws + (L1 ? slot(0) : slot(6))), (int*)(ws + WS_EID), (float*)(ws + WS_GATE));
}
template <bool L1> __device__ __forceinline__ void run_peer(const Args& a, LAS unsigned char* lds) {
    unsigned char* ws = a.ws;
    LAS int* HL = (LAS int*)(lds + (threadIdx.x >> 6) * 8192);
    float* Y = (float*)(ws + (L1 ? slot(0) : slot(6)));
    phase_peer_u((const signed char*)(ws + WS_XQ), (const int*)(ws + WS_EID), ws + WS_UB + (L1 ? (size_t)16384 * DM : 0), HL);
    asm volatile("s_waitcnt vmcnt(0) lgkmcnt(0)" ::: "memory");
    phase_peer_w(HL, (const float*)(ws + WS_XS), (const int*)(ws + WS_EID), (const float*)(ws + WS_GATE),
                 (const float*)(ws + WS_USC) + (L1 ? 16384 : 0), (const float*)(ws + WS_VSC) + (L1 ? 16384 : 0), (float*)(ws + WS_W), (float*)(ws + WS_CS));
    asm volatile("s_waitcnt vmcnt(0)" ::: "memory");
    phase_peer_v((const bf16_t*)(ws + (L1 ? slot(8) : slot(5))), (const int*)(ws + WS_EID), (const float*)(ws + WS_W), (const float*)(ws + WS_CS),
                 ws + WS_VB + (L1 ? (size_t)16384 * DM : 0), Y);
    asm volatile("s_waitcnt vmcnt(0)" ::: "memory");
    {
        const int lane = threadIdx.x & 63, gw = blockIdx.x * 8 + (threadIdx.x >> 6), nw = gridDim.x * 8, tpw = (MTOK + nw - 1) / nw, tbase = gw * tpw;
        const int tend = tbase + tpw < MTOK ? tbase + tpw : MTOK;
        const float* g = a.in[12] + (L1 ? 3 : 1) * DM; const float* bta = a.in[13] + (L1 ? 3 : 1) * DM;
        float* outf = L1 ? a.out : (float*)nullptr; bf16_t* outb = L1 ? (bf16_t*)nullptr : (bf16_t*)(ws + slot(2));
        for (int row = tbase; row < tend; ++row) {
            float v[32];
            const float* p = Y + (size_t)row * DM;
#pragma unroll
            for (int i = 0; i < 4; ++i) {
                const f32x4 x0 = *(const f32x4*)(p + 512 * i + 8 * lane), x1 = *(const f32x4*)(p + 512 * i + 8 * lane + 4);
#pragma unroll
                for (int j = 0; j < 4; ++j) { v[i * 8 + j] = x0[j]; v[i * 8 + 4 + j] = x1[j]; }
            }
            ln_row_store(v, g, bta, outf ? outf + (size_t)row * DM : nullptr, outb ? outb + (size_t)row * DM : nullptr, lane);
        }
    }
}


#define XB_TMO      128
#define XB_XCNT(j)  (256  + 64 * (j))
#define XB_XSUB(j)  (1280 + 64 * (j))
#define XB_XGEN(j)  (2304 + 64 * (j))
#define XB_TOP      3328
#define XB_TOPGEN   3392
#define XCD_BAR_WORDS 3456
#define XB_SPIN_CAP (1u << 20)
__device__ __forceinline__ unsigned xb_ld(unsigned* p)              { return __hip_atomic_load(p, __ATOMIC_RELAXED, __HIP_MEMORY_SCOPE_AGENT); }
__device__ __forceinline__ unsigned xb_add(unsigned* p, unsigned v) { return __hip_atomic_fetch_add(p, v, __ATOMIC_RELAXED, __HIP_MEMORY_SCOPE_AGENT); }
__device__ __forceinline__ unsigned xb_xcc_id() { return (unsigned)__builtin_amdgcn_s_getreg((3 << 11) | 20) & 0xFu; }
#define XB_SPIN(cond, bar) do { unsigned _sp = 0; while (cond) { __builtin_amdgcn_s_sleep(1); \
    if ((++_sp & 255u) == 0u) { if (xb_ld(&(bar)[XB_TMO])) break; if (_sp > XB_SPIN_CAP) { atomicAdd(&(bar)[XB_TMO], 1u); break; } } } } while (0)
struct XcdBarrier { unsigned* bar; unsigned x; volatile LAS unsigned* st; };
__device__ __forceinline__ XcdBarrier xcd_barrier_post(unsigned* bar, volatile LAS unsigned* st) {
    XcdBarrier b; b.bar = bar; b.x = xb_xcc_id(); b.st = st;
    if (threadIdx.x == 0) (void)xb_add(&bar[XB_XCNT(b.x)], 1u);
    return b;
}
__device__ __forceinline__ void xcd_barrier_complete(unsigned* bar, unsigned x, unsigned& nloc, unsigned& nx) {
    const unsigned G = gridDim.x * gridDim.y * gridDim.z;
    unsigned sum, cnt, mine, sp = 0u;
    for (;;) {
        sum = 0u; cnt = 0u; mine = 0u;
#pragma unroll
        for (unsigned j = 0; j < 16; ++j) { const unsigned c = xb_ld(&bar[XB_XCNT(j)]); sum += c; cnt += (c > 0u) ? 1u : 0u; mine = (j == x) ? c : mine; }
        if (sum == G) break;
        __builtin_amdgcn_s_sleep(1);
        if ((++sp & 255u) == 0u) { if (xb_ld(&bar[XB_TMO])) break; if (sp > XB_SPIN_CAP) { atomicAdd(&bar[XB_TMO], 1u); break; } }
    }
    nloc = mine > 0u ? mine : 1u; nx = cnt > 0u ? cnt : 1u;
}
__device__ __forceinline__ void xcd_barrier(const XcdBarrier& b) {
    asm volatile("s_waitcnt vmcnt(0)" ::: "memory");
    __syncthreads();
    if (threadIdx.x == 0) {
        unsigned* bar = b.bar;
        __builtin_amdgcn_s_waitcnt(0);
        unsigned nloc = b.st[0], nx = b.st[1];
        if (nloc == 0u) { xcd_barrier_complete(bar, b.x, nloc, nx); b.st[0] = nloc; b.st[1] = nx; }
        const unsigned old = xb_add(&bar[XB_XSUB(b.x)], 1u);
        const unsigned gen = old / nloc;
        if (old + 1u == (gen + 1u) * nloc) {
            __builtin_amdgcn_fence(__ATOMIC_RELEASE, "agent");
            asm volatile("s_waitcnt vmcnt(0)" ::: "memory");
            const unsigned og = xb_add(&bar[XB_TOP], 1u);
            const unsigned tg = og / nx;
            if (og + 1u == (tg + 1u) * nx) xb_add(&bar[XB_TOPGEN], 1u);
            else XB_SPIN(xb_ld(&bar[XB_TOPGEN]) == tg, bar);
            __builtin_amdgcn_fence(__ATOMIC_ACQUIRE, "agent");
            xb_add(&bar[XB_XGEN(b.x)], 1u);
            asm volatile("s_waitcnt vmcnt(0)" ::: "memory");
        } else {
            XB_SPIN(xb_ld(&bar[XB_XGEN(b.x)]) == gen, bar);
            __builtin_amdgcn_fence(__ATOMIC_ACQUIRE, "agent");
            asm volatile("s_waitcnt vmcnt(0)" ::: "memory");
        }
    }
    __syncthreads();
}

__global__ void __launch_bounds__(512, 2) mk_fwd(Args a) {
    extern __shared__ __attribute__((aligned(16))) unsigned char lds_raw[];
    LAS unsigned char* lds = (LAS unsigned char*)lds_raw;
    cg::grid_group grid = cg::this_grid();
    unsigned char* ws = a.ws;
#define PHASE_BEGIN(k) if (a.ph_lo <= (k) && (k) < a.ph_hi && EN(k)) {
    volatile LAS unsigned* xb_st = (volatile LAS unsigned*)(lds + LDS_BYTES - 16);
    if (threadIdx.x < 4) xb_st[threadIdx.x] = 0u;
    unsigned* xb_words = (unsigned*)(ws + WS_BAR);
    if (a.ph_lo == 0 && blockIdx.x == 0) for (int i = threadIdx.x; i < XCD_BAR_WORDS; i += 512) xb_words[i] = 0u;
    __syncthreads();
    XcdBarrier xbar; xbar.bar = xb_words; xbar.x = 0u; xbar.st = xb_st;
    bool xb_posted = false;
#define PHASE_END(k) if ((k) + 1 < a.ph_hi) { \
        if (!xb_posted) { asm volatile("s_waitcnt vmcnt(0)" ::: "memory"); __syncthreads(); grid.sync(); if (threadIdx.x < 64) { __builtin_amdgcn_fence(__ATOMIC_ACQUIRE, "agent"); asm volatile("s_waitcnt vmcnt(0)" ::: "memory"); } __syncthreads(); \
                          xbar = xcd_barrier_post(xb_words, xb_st); xb_posted = true; } \
        else xcd_barrier(xbar); } }
    PHASE_BEGIN(0) phase_prep(a, lds);
#if SCAN_DBG == 3 || SCAN_DBG == 5
        if (blockIdx.x == 0 && threadIdx.x < 8) ((unsigned*)(ws + WS_CTR + 8192))[threadIdx.x] = 0u;
#endif
#if SCAN_DBG == 7
        if (blockIdx.x == 0 && threadIdx.x < 32) ((float*)(ws + WS_CTR + 4096))[threadIdx.x] = 0.f;
#endif
    PHASE_END(0)
#if SCAN_DBG == 5
    PHASE_BEGIN(1) dbg_lds16_test(lds, (unsigned*)(ws + WS_CTR + 8192)); PHASE_END(1)
#define SKIP_REST 1
#endif
    PHASE_BEGIN(1) {
        pg8::Gemm g{(const bf16_t*)(ws + slot(0)), (const bf16_t*)(ws + WS_WIN), opaque(MTOK), opaque(4 * DM), opaque(DM)};
        pg8::StaticOrder S; S.init(g.M, g.N, (int)gridDim.x, (int)blockIdx.x);
        EpiKVQ E{(bf16_t*)(ws + slot(1)), (bf16_t*)(ws + slot(2)), (bf16_t*)(ws + slot(3))};
        pg8::gemm_phase<EpiKVQ, pg8::StaticOrder>(lds, g, S, E, nullptr);
    } PHASE_END(1)
    PHASE_BEGIN(2) phase_scan_a(lds, (const bf16_t*)(ws + slot(2)), (const float*)(ws + WS_LB), (const bf16_t*)(ws + slot(3)), (bf16_t*)(ws + slot(6)), (float*)(ws + WS_DEC), QuantJob{a.in[10], a.in[11], ws + WS_UB, ws + WS_VB, (float*)(ws + WS_USC), (float*)(ws + WS_VSC)}
#if SCAN_DBG == 3
        , (unsigned*)(ws + WS_CTR + 8192)
#endif
        );
#if SCAN_DBG == 7
        asm volatile("s_waitcnt vmcnt(0)" ::: "memory"); __syncthreads(); grid.sync(); if (threadIdx.x < 64) { __builtin_amdgcn_fence(__ATOMIC_ACQUIRE, "agent"); asm volatile("s_waitcnt vmcnt(0)" ::: "memory"); } __syncthreads();
        dbg_check_a7((const float*)(ws + slot(4)), (const bf16_t*)(ws + slot(2)), (const bf16_t*)(ws + slot(6)), (float*)(ws + WS_CTR + 4096));
#endif
#if SCAN_DBG == 6
#define DSYNC6() asm volatile("s_waitcnt vmcnt(0)" ::: "memory"); __syncthreads(); grid.sync(); if (threadIdx.x < 64) { __builtin_amdgcn_fence(__ATOMIC_ACQUIRE, "agent"); asm volatile("s_waitcnt vmcnt(0)" ::: "memory"); } __syncthreads();
        DSYNC6()
        phase_scan_a(lds, (const bf16_t*)(ws + slot(2)), (const float*)(ws + WS_LB), (const bf16_t*)(ws + slot(3)), (bf16_t*)a.out, (float*)(ws + WS_DEC), QuantJob{a.in[10], a.in[11], ws + WS_UB, ws + WS_VB, (float*)(ws + WS_USC), (float*)(ws + WS_VSC)});
        DSYNC6()
        dbg_check_a((LAS float*)lds, (const float*)(ws + slot(4)), (const bf16_t*)(ws + slot(2)), (const bf16_t*)(ws + slot(6)), (const bf16_t*)a.out, (float*)(ws + WS_CTR + 4096));
#endif
#if SCAN_DBG == 3
        asm volatile("s_waitcnt vmcnt(0)" ::: "memory"); __syncthreads(); grid.sync();
        dbg_count_bf16((const bf16_t*)(ws + slot(6)), (size_t)4096 * 16384, (unsigned*)(ws + WS_CTR + 8192) + 2);
#endif
    PHASE_END(2)
    PHASE_BEGIN(3) phase_scan_b((bf16_t*)(ws + slot(6)), (const float*)(ws + WS_DEC), QuantJob{a.in[10] + (size_t)16384 * DM, a.in[11] + (size_t)16384 * DM, ws + WS_UB + (size_t)16384 * DM, ws + WS_VB + (size_t)16384 * DM, (float*)(ws + WS_USC) + 16384, (float*)(ws + WS_VSC) + 16384});
#if SCAN_DBG == 3
        asm volatile("s_waitcnt vmcnt(0)" ::: "memory"); __syncthreads(); grid.sync();

#endif
    PHASE_END(3)
    PHASE_BEGIN(4) phase_scan_c(lds, (const bf16_t*)(ws + slot(1)), (const bf16_t*)(ws + slot(2)), (const float*)(ws + WS_LB), (const bf16_t*)(ws + slot(3)), (const bf16_t*)(ws + slot(4)), (const bf16_t*)(ws + slot(6)), a.in[2], (bf16_t*)(ws + slot(0)));
#if SCAN_DBG == 1
        asm volatile("s_waitcnt vmcnt(0)" ::: "memory"); __syncthreads(); grid.sync();
        phase_scan_naive((const bf16_t*)(ws + slot(1)), (const float*)(ws + slot(4)), (const bf16_t*)(ws + slot(2)), (float*)(ws + slot(6)));
        asm volatile("s_waitcnt vmcnt(0)" ::: "memory"); __syncthreads(); grid.sync();
        phase_onorm((const float*)(ws + slot(6)), (const bf16_t*)(ws + slot(3)), a.in[2], (bf16_t*)(ws + slot(0)));
#endif
#if SCAN_DBG == 3
        asm volatile("s_waitcnt vmcnt(0)" ::: "memory"); __syncthreads(); grid.sync();

#endif
#if SCAN_DBG == 4
#define DSYNC() asm volatile("s_waitcnt vmcnt(0)" ::: "memory"); __syncthreads(); grid.sync(); if (threadIdx.x < 64) { __builtin_amdgcn_fence(__ATOMIC_ACQUIRE, "agent"); asm volatile("s_waitcnt vmcnt(0)" ::: "memory"); } __syncthreads();
        DSYNC()
        phase_scan_naive((const bf16_t*)(ws + slot(1)), (const float*)(ws + slot(4)), (const bf16_t*)(ws + slot(2)), (float*)(ws + slot(6)));
        DSYNC()
        phase_onorm((const float*)(ws + slot(6)), (const bf16_t*)(ws + slot(3)), a.in[2], (bf16_t*)(ws + slot(8)));
        DSYNC()
        phase_scan_a(lds, (const bf16_t*)(ws + slot(2)), (const float*)(ws + WS_LB), (const bf16_t*)(ws + slot(3)), (bf16_t*)(ws + slot(6)), (float*)(ws + WS_DEC), QuantJob{a.in[10], a.in[11], ws + WS_UB, ws + WS_VB, (float*)(ws + WS_USC), (float*)(ws + WS_VSC)});
        DSYNC()
        phase_scan_b((bf16_t*)(ws + slot(6)), (const float*)(ws + WS_DEC), QuantJob{a.in[10] + (size_t)16384 * DM, a.in[11] + (size_t)16384 * DM, ws + WS_UB + (size_t)16384 * DM, ws + WS_VB + (size_t)16384 * DM, (float*)(ws + WS_USC) + 16384, (float*)(ws + WS_VSC) + 16384});
        DSYNC()
        phase_scan_c(lds, (const bf16_t*)(ws + slot(1)), (const bf16_t*)(ws + slot(2)), (const float*)(ws + WS_LB), (const bf16_t*)(ws + slot(3)), (const bf16_t*)(ws + slot(4)), (const bf16_t*)(ws + slot(6)), a.in[2], (bf16_t*)a.out);
        DSYNC()
        dbg_compare4((LAS float*)lds, (const bf16_t*)(ws + slot(0)), (const bf16_t*)(ws + slot(8)), (const bf16_t*)a.out, (float*)(ws + WS_CTR + 4096));
#endif
#if SCAN_DBG == 2
        asm volatile("s_waitcnt vmcnt(0)" ::: "memory"); __syncthreads(); grid.sync();
        phase_scan_naive((const bf16_t*)(ws + slot(1)), (const float*)(ws + slot(4)), (const bf16_t*)(ws + slot(2)), (float*)(ws + slot(6)));
        asm volatile("s_waitcnt vmcnt(0)" ::: "memory"); __syncthreads(); grid.sync();
        phase_onorm((const float*)(ws + slot(6)), (const bf16_t*)(ws + slot(3)), a.in[2], (bf16_t*)(ws + slot(8)));
        asm volatile("s_waitcnt vmcnt(0)" ::: "memory"); __syncthreads(); grid.sync();
        dbg_compare((LAS float*)lds, (const bf16_t*)(ws + slot(0)), (const bf16_t*)(ws + slot(8)), (float*)(ws + WS_CTR + 4096));
#endif
    PHASE_END(4)
    PHASE_BEGIN(5) run_gemm_out<false>(a, lds); PHASE_END(5)
    PHASE_BEGIN(6) run_ln<false>(a); PHASE_END(6)
    PHASE_BEGIN(7) run_gemm_sc<false>(a, lds); PHASE_END(7)
    PHASE_BEGIN(8) run_topk<false>(a, lds); PHASE_END(8)
    PHASE_BEGIN(9) run_peer<false>(a, lds); PHASE_END(9)
    PHASE_BEGIN(10) {
        pg8::Gemm g{(const bf16_t*)(ws + slot(2)), (const bf16_t*)(ws + WS_WKVQ), opaque(MTOK), opaque(3 * DM), opaque(DM)};
        pg8::StaticOrder S; S.init(g.M, g.N, (int)gridDim.x, (int)blockIdx.x);
        EpiKVQR E{(bf16_t*)(ws + slot(3)), (const float*)(ws + WS_COS), (const float*)(ws + WS_SIN)};
        pg8::gemm_phase<EpiKVQR, pg8::StaticOrder>(lds, g, S, E, nullptr);
    } PHASE_END(10)
    PHASE_BEGIN(11) phase_kstat((LAS float*)lds, (const bf16_t*)(ws + slot(3)), (float*)(ws + WS_KMEAN), (float*)(ws + WS_KNMAX)); PHASE_END(11)
    PHASE_BEGIN(12) phase_sel(lds, (const bf16_t*)(ws + slot(5)), (const float*)(ws + WS_KMEAN), (unsigned short*)(ws + WS_SUB), (int*)(ws + WS_CNT), (int*)(ws + WS_CTR)); PHASE_END(12)
    PHASE_BEGIN(13) phase_att(lds, (const bf16_t*)(ws + slot(5)), (const bf16_t*)(ws + slot(3)), (const bf16_t*)(ws + slot(4)), (const float*)(ws + WS_KNMAX), (const unsigned short*)(ws + WS_SUB),
                              (const int*)(ws + WS_CNT), (int*)(ws + WS_CTR), (bf16_t*)(ws + slot(6)), (bf16_t*)(ws + slot(0)), (float*)(ws + WS_LS)); PHASE_END(13)
    PHASE_BEGIN(14) phase_comb((const bf16_t*)(ws + slot(6)), (const bf16_t*)(ws + slot(0)), (const float*)(ws + WS_LS), (bf16_t*)(ws + slot(3))); PHASE_END(14)
    PHASE_BEGIN(15) run_gemm_out<true>(a, lds); PHASE_END(15)
    PHASE_BEGIN(16) run_ln<true>(a); PHASE_END(16)
    PHASE_BEGIN(17) run_gemm_sc<true>(a, lds); PHASE_END(17)
    PHASE_BEGIN(18) run_topk<true>(a, lds); PHASE_END(18)
#if SCAN_DBG == 7
    PHASE_BEGIN(19) dbg_emit7((const float*)(ws + WS_CTR + 4096), a.out); PHASE_END(19)
#elif SCAN_DBG == 6
    PHASE_BEGIN(19) dbg_emit4((const float*)(ws + WS_CTR + 4096), a.out); PHASE_END(19)
#elif SCAN_DBG == 5
    PHASE_BEGIN(19) dbg_emit5((const unsigned*)(ws + WS_CTR + 8192), a.out); PHASE_END(19)
#elif SCAN_DBG == 4
    PHASE_BEGIN(19) dbg_emit4((const float*)(ws + WS_CTR + 4096), a.out); PHASE_END(19)
#elif SCAN_DBG == 3
    PHASE_BEGIN(19) dbg_emit3((const unsigned*)(ws + WS_CTR + 8192), a.out); PHASE_END(19)
#elif SCAN_DBG == 2
    PHASE_BEGIN(19) dbg_emit((const float*)(ws + WS_CTR + 4096), a.out); PHASE_END(19)
#else
    PHASE_BEGIN(19) run_peer<true>(a, lds); PHASE_END(19)
#endif
}

extern "C" void kernel_launch(void* const* d_in, const int* in_sizes, int n_in, void* d_out, int out_size, void* d_ws, size_t ws_size, hipStream_t stream) {
    static int grid = 0;
    if (grid == 0) {
        if (n_in != 14 || out_size != MTOK * DM || ws_size < WS_END) { fprintf(stderr, "kernel_launch: unexpected shapes (n_in %d, out %d, ws %zu)\n", n_in, out_size, ws_size); grid = -1; return; }
        int dev = 0, cus = 0, per_cu = 0;
        if (hipGetDevice(&dev) != hipSuccess || hipDeviceGetAttribute(&cus, hipDeviceAttributeMultiprocessorCount, dev) != hipSuccess) { grid = -1; return; }
        if (hipFuncSetAttribute((const void*)mk_fwd, hipFuncAttributeMaxDynamicSharedMemorySize, LDS_BYTES) != hipSuccess) { fprintf(stderr, "kernel_launch: hipFuncSetAttribute failed\n"); grid = -1; return; }
        if (hipOccupancyMaxActiveBlocksPerMultiprocessor(&per_cu, (const void*)mk_fwd, 512, LDS_BYTES) != hipSuccess || per_cu < 1) { fprintf(stderr, "kernel_launch: occupancy query failed (%d)\n", per_cu); (void)hipGetLastError(); per_cu = 1; }
        grid = cus * (per_cu > 1 ? 1 : per_cu);
    }
    if (grid < 0) return;
    Args a{};
    for (int i = 0; i < 14; ++i) a.in[i] = (const float*)d_in[i];
    a.out = (float*)d_out; a.ws = (unsigned char*)d_ws;
#if ONE_LAUNCH
    a.ph_lo = 0; a.ph_hi = NPH;
    void* args[] = {&a};
    hipError_t e = hipLaunchCooperativeKernel((const void*)mk_fwd, dim3(grid), dim3(512), args, LDS_BYTES, stream);
    if (e != hipSuccess) fprintf(stderr, "cooperative launch failed: %s (grid %d)\n", hipGetErrorString(e), grid);
#else
    for (int ph = 0; ph < NPH; ++ph) {
        a.ph_lo = ph; a.ph_hi = ph + 1;
        hipLaunchKernelGGL(mk_fwd, dim3(grid), dim3(512), LDS_BYTES, stream, a);
    }
#endif
}
```

```cpp
#define ONE_LAUNCH 1
#include <hip/hip_runtime.h>
#include <hip/hip_cooperative_groups.h>
#include <cstdio>
namespace cg = cooperative_groups;

#ifndef ONE_LAUNCH
#define ONE_LAUNCH 0
#endif
#ifndef SCAN_DBG
#define SCAN_DBG 0
#endif
#ifndef SCAN_A_VALU
#define SCAN_A_VALU 0
#endif
#ifndef ENMASK
#define ENMASK 0xffffffffu
#endif
#define EN(k) ((ENMASK >> (k)) & 1u)

namespace pg8 {
#define PG8_LAS __attribute__((address_space(3)))
typedef unsigned short bf16_t;
typedef short bf16x8 __attribute__((ext_vector_type(8)));
typedef float f32x4 __attribute__((ext_vector_type(4)));
typedef unsigned u32x4 __attribute__((ext_vector_type(4)));
constexpr int BM = 256, BK = 64, HALF = 128, HTB = HALF * BK * 2  , STAGE_BYTES = 8 * HTB, NXCD = 8, WGM = 8;

__host__ __device__ __forceinline__ int lds_byte(int r, int c) { const int st = (r >> 4) * 2 + (c >> 5), rr = r & 15, cc = c & 31, ob = rr * 64 + cc * 2; return st * 1024 + (ob ^ (((ob >> 9) & 1) << 5)); }
__host__ __device__ __forceinline__ void stage_rc(int b, int& R, int& C) { const int st = b / 1024, sb = b % 1024, swz = sb ^ (((sb >> 9) & 1) << 5); R = (st >> 1) * 16 + swz / 64; C = (st & 1) * 32 + (swz % 64) / 2; }
__host__ __device__ __forceinline__ int perm32(int rho) { const int n = rho >> 4, i = rho & 15; return 8 * (i >> 2) + 4 * n + (i & 3); }

struct Unit { int pm, pn; };
struct Gemm { const bf16_t* A; const bf16_t* Bt; int M, N, K; };

struct StaticOrder {
    int nM, nN, nwg, G, c;
    __host__ __device__ void init(int M, int N, int G_, int c_) { nM = M / BM; nN = N / BM; nwg = nM * nN; G = G_; c = c_; }
    __host__ __device__ bool next(int i, Unit& u) const {
        const long L = (long)i * G + c; if (L >= nwg) return false;
        int wgid = (int)L; { const int q = nwg / NXCD, r = nwg % NXCD, xcd = wgid % NXCD, off = wgid / NXCD; wgid = (xcd < r ? xcd * (q + 1) : r * (q + 1) + (xcd - r) * q) + off; }
        const int nig = WGM * nN, gid = wgid / nig, fm = gid * WGM, gsz = (nM - fm) < WGM ? (nM - fm) : WGM;
        u.pm = fm + ((wgid % nig) % gsz); u.pn = (wgid % nig) / gsz; return true;
    }
    __device__ __forceinline__ void a_ready(const Unit&) const {}
    __device__ __forceinline__ void done(const Unit&) const {}
};
struct CountedOrder : StaticOrder {
    const unsigned* ready; unsigned need; unsigned* tmo;
    __device__ __forceinline__ void a_ready(const Unit& u) const {
        if (threadIdx.x < 64) {
            const unsigned long long t0 = __builtin_amdgcn_s_memrealtime(); unsigned polls = 0;
            while ((unsigned)__builtin_amdgcn_readfirstlane(__hip_atomic_load(ready + 64 * u.pm, __ATOMIC_RELAXED, __HIP_MEMORY_SCOPE_AGENT)) < need) {
                if ((++polls & 255u) == 0u && __builtin_amdgcn_readfirstlane(__hip_atomic_load(tmo, __ATOMIC_RELAXED, __HIP_MEMORY_SCOPE_AGENT)) != 0u) break;
                if (__builtin_amdgcn_s_memrealtime() - t0 > 2000000ull) {
                    if (threadIdx.x == 0) { unsigned expect = 0u; __hip_atomic_compare_exchange_strong(tmo + 1, &expect, 0x600u | (unsigned)(u.pm & 0xff), __ATOMIC_RELAXED, __ATOMIC_RELAXED, __HIP_MEMORY_SCOPE_AGENT); __hip_atomic_store(tmo, 1u, __ATOMIC_RELAXED, __HIP_MEMORY_SCOPE_AGENT); }
                    break; }
                __builtin_amdgcn_s_sleep(2); }
            __builtin_amdgcn_fence(__ATOMIC_ACQUIRE, "agent");
            asm volatile("s_waitcnt vmcnt(0)" ::: "memory");
        }
#if !defined(BROKEN_HOOK_NO_BARRIER)
        asm volatile("" ::: "memory"); __builtin_amdgcn_s_barrier(); asm volatile("" ::: "memory");
#endif
    }
};

__device__ __forceinline__ unsigned cvt_pk_bf16(float lo, float hi) { unsigned r; asm volatile("v_cvt_pk_bf16_f32 %0, %1, %2" : "=v"(r) : "v"(lo), "v"(hi)); return r; }
typedef float f32x2 __attribute__((ext_vector_type(2)));
__device__ __forceinline__ f32x2 gelu_pk(f32x2 v) {
    const f32x2 av = __builtin_elementwise_abs(v), d = av * 0.2316418882f + 1.0f;
    f32x2 t; t.x = __builtin_amdgcn_rcpf(d.x); t.y = __builtin_amdgcn_rcpf(d.y);
    f32x2 q = t * 0.5307027145f + (-0.7265760135f); q = q * t + 0.7107068705f; q = q * t + (-0.142248368f); q = q * t + 0.127414796f; q = q * t;
    const f32x2 s = (v * v) * (-0.72134752044f);
    f32x2 e; e.x = __builtin_amdgcn_exp2f(s.x); e.y = __builtin_amdgcn_exp2f(s.y);
    const f32x2 m = v * (q * e), r = v - m;
    f32x2 o; o.x = v.x < 0.f ? m.x : r.x; o.y = v.y < 0.f ? m.y : r.y; return o;
}

struct EpiF32 {
    static constexpr bool PERM = false, AFTER_DRAIN = false;
    float* C; int ldc; const float* bias;
    __device__ __forceinline__ void operator()(const f32x4 (&acc)[2][2][4][2], const Unit& u, int wr, int wc, int fr, int fq) const {
        const int row0 = u.pm * BM + wr * 64 + fr, col0 = u.pn * BM + wc * 32 + 4 * fq;
        f32x4 bv[2][2];
#pragma unroll
        for (int bj = 0; bj < 2; ++bj)
#pragma unroll
            for (int n = 0; n < 2; ++n) bv[bj][n] = bias ? *(const f32x4*)(bias + col0 + bj * HALF + n * 16) : (f32x4){0.f, 0.f, 0.f, 0.f};
#pragma unroll
        for (int ai = 0; ai < 2; ++ai)
#pragma unroll
            for (int m = 0; m < 4; ++m) { float* rowp = C + (size_t)(row0 + ai * HALF + m * 16) * ldc + col0;
#pragma unroll
                for (int bj = 0; bj < 2; ++bj)
#pragma unroll
                    for (int n = 0; n < 2; ++n) *(f32x4*)(rowp + bj * HALF + n * 16) = acc[ai][bj][m][n] + bv[bj][n]; }
    }
};
template <int ACT  > struct EpiBf16 {
    static constexpr bool PERM = true, AFTER_DRAIN = false;
    bf16_t* O; int ldc; const float* bias; int split_cols; size_t split_stride;
    __device__ __forceinline__ void operator()(const f32x4 (&acc)[2][2][4][2], const Unit& u, int wr, int wc, int fr, int fq) const {
        const int row0 = u.pm * BM + wr * 64 + fr; int colt = u.pn * BM; bf16_t* base = O;
        if (split_cols) { const int t = colt / split_cols; base += (size_t)t * split_stride; colt -= t * split_cols; }
        const int col0 = colt + wc * 32 + 8 * fq, bcol0 = u.pn * BM + wc * 32 + 8 * fq;
        f32x4 bv[2][2];
#pragma unroll
        for (int bj = 0; bj < 2; ++bj)
#pragma unroll
            for (int n = 0; n < 2; ++n) bv[bj][n] = bias ? *(const f32x4*)(bias + bcol0 + bj * HALF + 4 * n) : (f32x4){0.f, 0.f, 0.f, 0.f};
#pragma unroll
        for (int ai = 0; ai < 2; ++ai)
#pragma unroll
            for (int m = 0; m < 4; ++m) { bf16_t* rowp = base + (size_t)(row0 + ai * HALF + m * 16) * ldc + col0;
#pragma unroll
                for (int bj = 0; bj < 2; ++bj) { f32x4 v0 = acc[ai][bj][m][0] + bv[bj][0], v1 = acc[ai][bj][m][1] + bv[bj][1];
                    if (ACT == 1) { f32x2 a = gelu_pk((f32x2){v0[0], v0[1]}), b = gelu_pk((f32x2){v0[2], v0[3]}), c = gelu_pk((f32x2){v1[0], v1[1]}), d = gelu_pk((f32x2){v1[2], v1[3]});
                        v0 = (f32x4){a.x, a.y, b.x, b.y}; v1 = (f32x4){c.x, c.y, d.x, d.y}; }
                    if (ACT == 2) {
#pragma unroll
                        for (int j = 0; j < 4; ++j) { v0[j] = 0.5f * v0[j] * (1.0f + erff(v0[j] * 0.70710678f)); v1[j] = 0.5f * v1[j] * (1.0f + erff(v1[j] * 0.70710678f)); } }
                    u32x4 w; w.x = cvt_pk_bf16(v0[0], v0[1]); w.y = cvt_pk_bf16(v0[2], v0[3]); w.z = cvt_pk_bf16(v1[0], v1[1]); w.w = cvt_pk_bf16(v1[2], v1[3]);
                    *(u32x4*)(rowp + bj * HALF) = w; } }
    }
};

template <class Epi, class Sched, bool STAMP = false>
__device__ __forceinline__ void gemm_phase(PG8_LAS unsigned char* lds, const Gemm g, const Sched& S, const Epi& E, unsigned long long* stamps) {
    const int tid = threadIdx.x, wid = __builtin_amdgcn_readfirstlane(tid >> 6), lane = tid & 63, wr = wid >> 2, wc = wid & 3, fr = lane & 15, fq = lane >> 4;
    const int K = g.K, nt = K / BK;
    int ts_lo = 0, ts_hi = 0, nts = 0; const unsigned long long rt_entry = STAMP ? (unsigned long long)wall_clock64() : 0ull;
#define PG8_STAMP() do { if (STAMP && wid == 0 && nts < 64) { const unsigned long long _c = (unsigned long long)clock64(); \
        ts_lo = (lane == nts) ? (int)(unsigned)_c : ts_lo; ts_hi = (lane == nts) ? (int)(unsigned)(_c >> 32) : ts_hi; ++nts; } } while (0)
    PG8_STAMP();
    unsigned voffA[2], voffB[2];
#pragma unroll
    for (int i = 0; i < 2; ++i) { int R, C; stage_rc(tid * 16 + i * 8192, R, C); const int Rb = Epi::PERM ? ((R & ~31) + perm32(R & 31)) : R;
        voffA[i] = (unsigned)(R * K + C) * 2u; voffB[i] = (unsigned)(Rb * K + C) * 2u; }
    const size_t kstep = (size_t)(BK * 2);
    const size_t hstep = (size_t)HALF * K * 2;
    const size_t tstep = 2 * hstep;
    const unsigned ldsw = (unsigned)wid * 1024u;
    const int aoff = lds_byte(wr * 64 + fr, fq * 8), boff = lds_byte(wc * 32 + fr, fq * 8);
#define PG8_SA(b, h) (((b) * 2 + (h)) * HTB)
#define PG8_SB(b, h) ((4 + (b) * 2 + (h)) * HTB)
#define PG8_STAGE(bufoff, gbase, voff) do { _Pragma("unroll") for (int _i = 0; _i < 2; ++_i) \
        __builtin_amdgcn_global_load_lds((const unsigned*)((const char*)(gbase) + (voff)[_i]), (PG8_LAS unsigned*)(lds + (bufoff) + ldsw + _i * 8192), 16, 0, 0); } while (0)
#define PG8_LDA(dst, b, h) do { _Pragma("unroll") for (int m = 0; m < 4; ++m) _Pragma("unroll") for (int k = 0; k < 2; ++k) dst[m][k] = *(const PG8_LAS bf16x8*)(lds + PG8_SA(b, h) + aoff + m * 2048 + k * 1024); } while (0)
#define PG8_LDB(dst, b, h) do { _Pragma("unroll") for (int n = 0; n < 2; ++n) _Pragma("unroll") for (int k = 0; k < 2; ++k) dst[n][k] = *(const PG8_LAS bf16x8*)(lds + PG8_SB(b, h) + boff + n * 2048 + k * 1024); } while (0)
#define PG8_MMA(ai, bj, At, Bt) do { __builtin_amdgcn_s_setprio(1); _Pragma("unroll") for (int m = 0; m < 4; ++m) _Pragma("unroll") for (int n = 0; n < 2; ++n) _Pragma("unroll") for (int k = 0; k < 2; ++k) \
        acc[ai][bj][m][n] = __builtin_amdgcn_mfma_f32_16x16x32_bf16(Bt[n][k], At[m][k], acc[ai][bj][m][n], 0, 0, 0); __builtin_amdgcn_s_setprio(0); } while (0)
#define PG8_WAIT_V(n) asm volatile("s_waitcnt vmcnt(" #n ")" ::: "memory")
#define PG8_WAIT_L(n) asm volatile("s_waitcnt lgkmcnt(" #n ")" ::: "memory")
#define PG8_BAR __builtin_amdgcn_s_barrier()
#define PG8_SCHED __builtin_amdgcn_sched_barrier(0)
    Unit cur, nxt; int ui = 0;
    if (!S.next(0, cur)) return;
    f32x4 acc[2][2][4][2];
#pragma unroll
    for (int a = 0; a < 2; ++a)
#pragma unroll
        for (int b = 0; b < 2; ++b)
#pragma unroll
            for (int m = 0; m < 4; ++m)
#pragma unroll
                for (int n = 0; n < 2; ++n) acc[a][b][m][n] = (f32x4){0.f, 0.f, 0.f, 0.f};
    bf16x8 At[4][2], B0[2][2], B1[2][2];
    const char* cA = (const char*)g.A + (size_t)cur.pm * tstep; const char* cB = (const char*)g.Bt + (size_t)cur.pn * tstep;
    S.a_ready(cur);
    PG8_STAGE(PG8_SB(0, 0), cB, voffB); PG8_STAGE(PG8_SA(0, 0), cA, voffA); PG8_STAGE(PG8_SB(0, 1), cB + hstep, voffB); PG8_STAGE(PG8_SA(0, 1), cA + hstep, voffA);
    if (wr == 1) PG8_BAR;
    PG8_WAIT_V(4); PG8_BAR;
    PG8_STAGE(PG8_SB(1, 0), cB + kstep, voffB); PG8_STAGE(PG8_SA(1, 0), cA + kstep, voffA); PG8_STAGE(PG8_SB(1, 1), cB + hstep + kstep, voffB);
    PG8_WAIT_V(6); PG8_BAR;
    PG8_STAMP();
    for (;;) {
        const bool has_next = S.next(ui + 1, nxt);
        const char* nA = has_next ? (const char*)g.A + (size_t)nxt.pm * tstep : cA; const char* nB = has_next ? (const char*)g.Bt + (size_t)nxt.pn * tstep : cB;
        for (int t = 0; t < nt; t += 2) {
            const bool last = (t == nt - 2);
            const char* a1 = cA + (size_t)(t + 1) * kstep;
            const char* a2 = last ? nA : cA + (size_t)(t + 2) * kstep; const char* b2 = last ? nB : cB + (size_t)(t + 2) * kstep;
            const char* a3 = a2 + kstep; const char* b3 = b2 + kstep;
            if (last && has_next) S.a_ready(nxt);
            PG8_LDB(B0, 0, 0); PG8_SCHED; PG8_LDA(At, 0, 0); PG8_STAGE(PG8_SA(1, 1), a1 + hstep, voffA);
            PG8_WAIT_L(8); PG8_BAR; PG8_WAIT_L(0); PG8_MMA(0, 0, At, B0); PG8_BAR; PG8_SCHED;
            PG8_LDB(B1, 0, 1); PG8_STAGE(PG8_SB(0, 0), b2, voffB);
            PG8_BAR; PG8_WAIT_L(0); PG8_MMA(0, 1, At, B1); PG8_BAR;
            PG8_LDA(At, 0, 1); PG8_STAGE(PG8_SA(0, 0), a2, voffA);
            PG8_BAR; PG8_WAIT_L(0); PG8_MMA(1, 0, At, B0); PG8_BAR; PG8_SCHED;
            PG8_STAGE(PG8_SB(0, 1), b2 + hstep, voffB);
            PG8_WAIT_V(6); PG8_BAR; PG8_MMA(1, 1, At, B1); PG8_BAR;
            PG8_LDB(B0, 1, 0); PG8_SCHED; PG8_LDA(At, 1, 0); PG8_STAGE(PG8_SA(0, 1), a2 + hstep, voffA);
            PG8_WAIT_L(8); PG8_BAR; PG8_WAIT_L(0); PG8_MMA(0, 0, At, B0); PG8_BAR; PG8_SCHED;
            PG8_LDB(B1, 1, 1); PG8_STAGE(PG8_SB(1, 0), b3, voffB);
            PG8_BAR; PG8_WAIT_L(0); PG8_MMA(0, 1, At, B1); PG8_BAR;
            PG8_LDA(At, 1, 1); PG8_STAGE(PG8_SA(1, 0), a3, voffA);
            PG8_BAR; PG8_WAIT_L(0); PG8_MMA(1, 0, At, B0); PG8_BAR; PG8_SCHED;
            PG8_STAGE(PG8_SB(1, 1), b3 + hstep, voffB);
            PG8_WAIT_V(6); PG8_BAR; PG8_MMA(1, 1, At, B1); PG8_BAR;
        }
        PG8_STAMP();
        if constexpr (!Epi::AFTER_DRAIN) { E(acc, cur, wr, wc, fr, fq); S.done(cur); }
        PG8_STAMP();
        if (!has_next) break;
#pragma unroll
        for (int a = 0; a < 2; ++a)
#pragma unroll
            for (int b = 0; b < 2; ++b)
#pragma unroll
                for (int m = 0; m < 4; ++m)
#pragma unroll
                    for (int n = 0; n < 2; ++n) acc[a][b][m][n] = (f32x4){0.f, 0.f, 0.f, 0.f};
        cur = nxt; cA = nA; cB = nB; ++ui;
    }
    PG8_WAIT_V(0);
    if (wr == 0) PG8_BAR;
    PG8_BAR;
    if constexpr (Epi::AFTER_DRAIN) { E.fused(acc, cur, wr, wc, fr, fq, lds, wid, lane); S.done(cur); }
    PG8_STAMP();
    if (STAMP && wid == 0) { stamps[lane] = lane < nts ? (((unsigned long long)(unsigned)ts_hi << 32) | (unsigned)ts_lo) : 0ull;
        if (lane == 62) stamps[62] = rt_entry; if (lane == 63) stamps[63] = (unsigned long long)wall_clock64(); }
#undef PG8_STAMP
#undef PG8_SA
#undef PG8_SB
#undef PG8_STAGE
#undef PG8_LDA
#undef PG8_LDB
#undef PG8_MMA
#undef PG8_WAIT_V
#undef PG8_WAIT_L
#undef PG8_BAR
#undef PG8_SCHED
}
}


#define LAS __attribute__((address_space(3)))
typedef unsigned short bf16_t;
typedef float f32x4 __attribute__((ext_vector_type(4)));
typedef unsigned u32x4 __attribute__((ext_vector_type(4)));
typedef unsigned u32x2 __attribute__((ext_vector_type(2)));
typedef short bf16x8 __attribute__((ext_vector_type(8)));
typedef short s16x4 __attribute__((ext_vector_type(4)));
typedef float f32x16 __attribute__((ext_vector_type(16)));

constexpr int MTOK = 16384, DM = 2048, SEQ = 8192, NHEAD = 16;
constexpr float ALPHA = 1.41421356237309515f;
constexpr size_t MiB = (size_t)1 << 20;
constexpr size_t WS_WIN = 0, WS_WOUT = 32 * MiB, WS_WKVQ = 40 * MiB, WS_WO = 64 * MiB, WS_WC = 72 * MiB, WS_UB = 88 * MiB, WS_VB = 152 * MiB, WS_USC = 216 * MiB, WS_VSC = 217 * MiB, WS_H = 224 * MiB, WS_XQ = 232 * MiB, WS_XS = 264 * MiB, WS_W = 272 * MiB, WS_CS = 280 * MiB, WS_SLOT = 344 * MiB;
constexpr size_t WS_EID = 920 * MiB, WS_GATE = 928 * MiB, WS_COS = 936 * MiB, WS_SIN = 938 * MiB, WS_KMEAN = 940 * MiB, WS_LB = 941 * MiB, WS_LS = 942 * MiB, WS_SUB = 946 * MiB, WS_CNT = 962 * MiB, WS_CTR = 963 * MiB, WS_DEC = 964 * MiB, WS_END = 966 * MiB;
constexpr size_t WS_BAR = WS_CTR + 65536;
constexpr size_t WS_KNMAX = WS_KMEAN + 768 * 1024;
__host__ __device__ constexpr size_t slot(int i) { return WS_SLOT + (size_t)i * 64 * MiB; }
constexpr int LDS_BYTES = 144 * 1024;
constexpr int NPH = 20;

struct Args { const float* in[14]; float* out; unsigned char* ws; int ph_lo, ph_hi; };

__device__ __forceinline__ float bflo(unsigned w) { return __uint_as_float(w << 16); }
__device__ __forceinline__ float bfhi(unsigned w) { return __uint_as_float(w & 0xffff0000u); }
__device__ __forceinline__ float bf2f(bf16_t b) { return __uint_as_float(((unsigned)b) << 16); }
typedef __bf16 bf16x2_t __attribute__((ext_vector_type(2)));
typedef float f32x2_t __attribute__((ext_vector_type(2)));
__device__ __forceinline__ unsigned pk_bf16(float lo, float hi) { const f32x2_t f = {lo, hi}; return __builtin_bit_cast(unsigned, __builtin_convertvector(f, bf16x2_t)); }
__device__ __forceinline__ float wave_sum(float v) {
#pragma unroll
    for (int o = 32; o >= 1; o >>= 1) v += __shfl_xor(v, o);
    return v;
}
__device__ __forceinline__ float wave_max(float v) {
#pragma unroll
    for (int o = 32; o >= 1; o >>= 1) v = fmaxf(v, __shfl_xor(v, o));
    return v;
}
__device__ __forceinline__ float sigmoidf_(float z) { return 1.0f / (1.0f + __expf(-z)); }


__device__ __forceinline__ void store_wt16(void* p, u32x4 v) {
    __hip_atomic_store((unsigned long long*)p, ((unsigned long long)v.y << 32) | v.x, __ATOMIC_RELAXED, __HIP_MEMORY_SCOPE_AGENT);
    __hip_atomic_store((unsigned long long*)p + 1, ((unsigned long long)v.w << 32) | v.z, __ATOMIC_RELAXED, __HIP_MEMORY_SCOPE_AGENT);
}
__device__ __forceinline__ void store_wt8(void* p, u32x2 v) {
    __hip_atomic_store((unsigned long long*)p, ((unsigned long long)v.y << 32) | v.x, __ATOMIC_RELAXED, __HIP_MEMORY_SCOPE_AGENT);
}
struct EpiIn {
    static constexpr bool PERM = true, AFTER_DRAIN = false;
    bf16_t* Q1; float* LF; bf16_t* I1; bf16_t* G1; const float* LB;
    __device__ __forceinline__ void operator()(const pg8::f32x4 (&acc)[2][2][4][2], const pg8::Unit& u, int wr, int wc, int fr, int fq) const {
        const int type = u.pn >> 3;
        const int row0 = u.pm * 256 + wr * 64 + fr, col0 = (u.pn & 7) * 256 + wc * 32 + 8 * fq;
        if (type == 1) {
#pragma unroll
            for (int bj = 0; bj < 2; ++bj) {
                const int c = col0 + bj * 128;
                const f32x4 lb0 = *(const f32x4*)(LB + c), lb1 = *(const f32x4*)(LB + c + 4);
#pragma unroll
                for (int ai = 0; ai < 2; ++ai)
#pragma unroll
                    for (int m = 0; m < 4; ++m) {
                        float* p = LF + (size_t)(row0 + ai * 128 + m * 16) * DM + c;
                        f32x4 o0, o1;
#pragma unroll
                        for (int j = 0; j < 4; ++j) {
                            o0[j] = __logf(lb0[j] + (1.0f - lb0[j]) * sigmoidf_(acc[ai][bj][m][0][j]));
                            o1[j] = __logf(lb1[j] + (1.0f - lb1[j]) * sigmoidf_(acc[ai][bj][m][1][j]));
                        }
                        *(f32x4*)p = o0; *(f32x4*)(p + 4) = o1;
                    }
            }
        } else {
            bf16_t* dst = Q1 + (size_t)(type - (type > 0 ? 1 : 0)) * ((size_t)32 << 20);
            const bool act = (type != 2);
#pragma unroll
            for (int ai = 0; ai < 2; ++ai)
#pragma unroll
                for (int m = 0; m < 4; ++m)
#pragma unroll
                    for (int bj = 0; bj < 2; ++bj) {
                        f32x4 v0 = acc[ai][bj][m][0], v1 = acc[ai][bj][m][1];
                        if (act) {
#pragma unroll
                            for (int j = 0; j < 4; ++j) { v0[j] = v0[j] * sigmoidf_(v0[j]); v1[j] = v1[j] * sigmoidf_(v1[j]); }
                        }
                        u32x4 w; w.x = pk_bf16(v0[0], v0[1]); w.y = pk_bf16(v0[2], v0[3]); w.z = pk_bf16(v1[0], v1[1]); w.w = pk_bf16(v1[2], v1[3]);
                        *(u32x4*)(dst + (size_t)(row0 + ai * 128 + m * 16) * DM + col0 + bj * 128) = w;
                    }
        }
    }
};
struct EpiRes {
    static constexpr bool PERM = false, AFTER_DRAIN = false;
    const float* res; float* Y;
    __device__ __forceinline__ void operator()(const pg8::f32x4 (&acc)[2][2][4][2], const pg8::Unit& u, int wr, int wc, int fr, int fq) const {
        const int row0 = u.pm * 256 + wr * 64 + fr, col0 = u.pn * 256 + wc * 32 + 4 * fq;
#pragma unroll
        for (int ai = 0; ai < 2; ++ai)
#pragma unroll
            for (int m = 0; m < 4; ++m) {
                const size_t off = (size_t)(row0 + ai * 128 + m * 16) * DM + col0;
#pragma unroll
                for (int bj = 0; bj < 2; ++bj)
#pragma unroll
                    for (int n = 0; n < 2; ++n) {
                        const f32x4 r = *(const f32x4*)(res + off + bj * 128 + n * 16);
                        *(f32x4*)(Y + off + bj * 128 + n * 16) = r * ALPHA + acc[ai][bj][m][n];
                    }
            }
    }
};
struct EpiF32 {
    static constexpr bool PERM = false, AFTER_DRAIN = false;
    float* C; int ldc;
    __device__ __forceinline__ void operator()(const pg8::f32x4 (&acc)[2][2][4][2], const pg8::Unit& u, int wr, int wc, int fr, int fq) const {
        const int row0 = u.pm * 256 + wr * 64 + fr, col0 = u.pn * 256 + wc * 32 + 4 * fq;
#pragma unroll
        for (int ai = 0; ai < 2; ++ai)
#pragma unroll
            for (int m = 0; m < 4; ++m) {
                float* p = C + (size_t)(row0 + ai * 128 + m * 16) * ldc + col0;
#pragma unroll
                for (int bj = 0; bj < 2; ++bj)
#pragma unroll
                    for (int n = 0; n < 2; ++n) *(f32x4*)(p + bj * 128 + n * 16) = acc[ai][bj][m][n];
            }
    }
};
struct EpiKVQ {
    static constexpr bool PERM = true, AFTER_DRAIN = false;
    bf16_t* K; bf16_t* V; bf16_t* Q;
    __device__ __forceinline__ void operator()(const pg8::f32x4 (&acc)[2][2][4][2], const pg8::Unit& u, int wr, int wc, int fr, int fq) const {
        const int t = u.pn >> 3;
        bf16_t* dst = K + (size_t)t * ((size_t)32 << 20);
        const int row0 = u.pm * 256 + wr * 64 + fr, col0 = (u.pn & 7) * 256 + wc * 32 + 8 * fq;
#pragma unroll
        for (int ai = 0; ai < 2; ++ai)
#pragma unroll
            for (int m = 0; m < 4; ++m)
#pragma unroll
                for (int bj = 0; bj < 2; ++bj) {
                    const f32x4 v0 = acc[ai][bj][m][0], v1 = acc[ai][bj][m][1];
                    u32x4 w; w.x = pk_bf16(v0[0], v0[1]); w.y = pk_bf16(v0[2], v0[3]); w.z = pk_bf16(v1[0], v1[1]); w.w = pk_bf16(v1[2], v1[3]);
                    *(u32x4*)(dst + (size_t)(row0 + ai * 128 + m * 16) * DM + col0 + bj * 128) = w;
                }
    }
};


struct EpiKVQR {
    static constexpr bool PERM = true, AFTER_DRAIN = false;
    bf16_t* K; const float* COS; const float* SIN;
    __device__ __forceinline__ void operator()(const pg8::f32x4 (&acc)[2][2][4][2], const pg8::Unit& u, int wr, int wc, int fr, int fq) const {
        const int t = u.pn >> 3;
        bf16_t* dst = K + (size_t)t * ((size_t)32 << 20);
        const int row0 = u.pm * 256 + wr * 64 + fr;
        if (t == 1) {
            const int col0 = (u.pn & 7) * 256 + wc * 32 + 8 * fq;
#pragma unroll
            for (int ai = 0; ai < 2; ++ai)
#pragma unroll
                for (int m = 0; m < 4; ++m)
#pragma unroll
                    for (int bj = 0; bj < 2; ++bj) {
                        const f32x4 v0 = acc[ai][bj][m][0], v1 = acc[ai][bj][m][1];
                        u32x4 w; w.x = pk_bf16(v0[0], v0[1]); w.y = pk_bf16(v0[2], v0[3]); w.z = pk_bf16(v1[0], v1[1]); w.w = pk_bf16(v1[2], v1[3]);
                        *(u32x4*)(dst + (size_t)(row0 + ai * 128 + m * 16) * DM + col0 + bj * 128) = w;
                    }
        } else {
            const int g = 4 * wc + fq;
#pragma unroll
            for (int ai = 0; ai < 2; ++ai)
#pragma unroll
                for (int m = 0; m < 4; ++m) {
                    const int row = row0 + ai * 128 + m * 16, pos = row & (SEQ - 1);
                    const f32x4 c = *(const f32x4*)(COS + pos * 64 + 4 * g), sn = *(const f32x4*)(SIN + pos * 64 + 4 * g);
#pragma unroll
                    for (int bj = 0; bj < 2; ++bj) {
                        const f32x4 a = acc[ai][bj][m][0], b = acc[ai][bj][m][1];
                        bf16_t* p = dst + (size_t)row * DM + ((u.pn & 7) * 2 + bj) * 128 + 4 * g;
                        u32x2 w1, w2;
                        w1.x = pk_bf16(a[0] * c[0] - b[0] * sn[0], a[1] * c[1] - b[1] * sn[1]); w1.y = pk_bf16(a[2] * c[2] - b[2] * sn[2], a[3] * c[3] - b[3] * sn[3]);
                        w2.x = pk_bf16(a[0] * sn[0] + b[0] * c[0], a[1] * sn[1] + b[1] * c[1]); w2.y = pk_bf16(a[2] * sn[2] + b[2] * c[2], a[3] * sn[3] + b[3] * c[3]);
                        *(u32x2*)p = w1; *(u32x2*)(p + 64) = w2;
                    }
                }
        }
    }
};

__host__ __device__ __forceinline__ int rot_pos(int d) { return d < 64 ? 8 * (d >> 2) + (d & 3) : 8 * ((d - 64) >> 2) + 4 + (d & 3); }
__device__ __forceinline__ void transpose_tiles(LAS float* tile, const float* src, int ldn, int K, int N, bf16_t* dst, int nperm = 0) {
    const int tid = threadIdx.x;
    const int tn = N / 64, ntiles = tn * (K / 64);
    for (int tI = blockIdx.x; tI < ntiles; tI += gridDim.x) {
        const int k0 = (tI / tn) * 64, n0 = (tI % tn) * 64;
#pragma unroll
        for (int r = 0; r < 2; ++r) {
            const int kk = (tid >> 4) + 32 * r, nn = (tid & 15) * 4;
            const f32x4 v = *(const f32x4*)(src + (size_t)(k0 + kk) * ldn + n0 + nn);
            tile[kk * 65 + nn + 0] = v[0]; tile[kk * 65 + nn + 1] = v[1]; tile[kk * 65 + nn + 2] = v[2]; tile[kk * 65 + nn + 3] = v[3];
        }
        __syncthreads();
        {
            const int nn = tid >> 3, kk8 = (tid & 7) * 8;
            float f[8];
#pragma unroll
            for (int j = 0; j < 8; ++j) f[j] = tile[(kk8 + j) * 65 + nn];
            u32x4 w; w.x = pk_bf16(f[0], f[1]); w.y = pk_bf16(f[2], f[3]); w.z = pk_bf16(f[4], f[5]); w.w = pk_bf16(f[6], f[7]);
            const int nsrc = n0 + nn, nrow = nsrc < nperm ? (nsrc & ~127) + rot_pos(nsrc & 127) : nsrc;
            *(u32x4*)(dst + (size_t)nrow * K + k0 + kk8) = w;
        }
        __syncthreads();
    }
}
__device__ __forceinline__ void convert_bf16(const float* src, bf16_t* dst, size_t n) {
    const size_t stride = (size_t)gridDim.x * 512 * 8;
    for (size_t i = ((size_t)blockIdx.x * 512 + threadIdx.x) * 8; i < n; i += stride) {
        const f32x4 a = *(const f32x4*)(src + i), b = *(const f32x4*)(src + i + 4);
        u32x4 w; w.x = pk_bf16(a[0], a[1]); w.y = pk_bf16(a[2], a[3]); w.z = pk_bf16(b[0], b[1]); w.w = pk_bf16(b[2], b[3]);
        *(u32x4*)(dst + i) = w;
    }
}
__device__ __forceinline__ void fold_peer_keys(LAS float* lds, const float* w_query, const float* sub_keys, bf16_t* WcT) {
    const int tid = threadIdx.x;
    LAS float* Ss = lds;
    LAS float* Ws = lds + 128 * 132;
    for (int item = blockIdx.x; item < 1024; item += gridDim.x) {
        const int l = item >> 9, rem = item & 511, hh = rem >> 5, kb = rem & 31, h = hh >> 1, half = hh & 1;
        const float* sk = sub_keys + (size_t)(((l * 2 + half) * 8 + h) * 128) * 128;
        const float* wq = w_query + (size_t)l * DM * DM + (size_t)(kb * 64) * DM + h * 256 + half * 128;
#pragma unroll
        for (int r = 0; r < 8; ++r) { const int idx = tid + 512 * r, key = idx >> 5, d4 = (idx & 31) * 4; *(LAS f32x4*)(Ss + key * 132 + d4) = *(const f32x4*)(sk + key * 128 + d4); }
#pragma unroll
        for (int r = 0; r < 4; ++r) { const int idx = tid + 512 * r, kin = idx >> 5, d4 = (idx & 31) * 4; *(LAS f32x4*)(Ws + kin * 128 + d4) = *(const f32x4*)(wq + (size_t)kin * DM + d4); }
        __syncthreads();
        const int key = tid & 127, kq = tid >> 7;
        float acc[16];
#pragma unroll
        for (int j = 0; j < 16; ++j) acc[j] = 0.f;
        for (int d4 = 0; d4 < 32; ++d4) {
            const f32x4 s4 = *(const LAS f32x4*)(Ss + key * 132 + d4 * 4);
#pragma unroll
            for (int j = 0; j < 16; ++j) { const f32x4 w4 = *(const LAS f32x4*)(Ws + (kq * 16 + j) * 128 + d4 * 4); acc[j] += s4[0] * w4[0] + s4[1] * w4[1] + s4[2] * w4[2] + s4[3] * w4[3]; }
        }
        bf16_t* o = WcT + (size_t)l * DM * DM + (size_t)(h * 256 + half * 128 + key) * DM + kb * 64 + kq * 16;
        u32x4 w0, w1;
        w0.x = pk_bf16(acc[0], acc[1]); w0.y = pk_bf16(acc[2], acc[3]); w0.z = pk_bf16(acc[4], acc[5]); w0.w = pk_bf16(acc[6], acc[7]);
        w1.x = pk_bf16(acc[8], acc[9]); w1.y = pk_bf16(acc[10], acc[11]); w1.z = pk_bf16(acc[12], acc[13]); w1.w = pk_bf16(acc[14], acc[15]);
        *(u32x4*)o = w0; *(u32x4*)(o + 8) = w1;
        __syncthreads();
    }
}

__device__ __forceinline__ void quant_rows(const float* src, unsigned char* dst, float* scl, int nrows) {
    const int lane = threadIdx.x & 63, gw = blockIdx.x * 8 + (threadIdx.x >> 6), nw = gridDim.x * 8;
    for (int row = gw; row < nrows; row += nw) {
        const float* p = src + (size_t)row * DM;
        f32x4 v[8];
#pragma unroll
        for (int i = 0; i < 2; ++i)
#pragma unroll
            for (int q = 0; q < 4; ++q) v[i * 4 + q] = *(const f32x4*)(p + 1024 * i + 16 * lane + 4 * q);
        float am = 0.f;
#pragma unroll
        for (int i = 0; i < 8; ++i) am = fmaxf(am, fmaxf(fmaxf(fabsf(v[i][0]), fabsf(v[i][1])), fmaxf(fabsf(v[i][2]), fabsf(v[i][3]))));
        am = fmaxf(wave_max(am), 1e-30f);
        const float inv = 127.0f / am;
        if (lane == 0) scl[row] = am * (1.0f / 127.0f);
#pragma unroll
        for (int i = 0; i < 2; ++i) {
            u32x4 w;
#pragma unroll
            for (int q = 0; q < 4; ++q) {
                const f32x4 t = v[i * 4 + q];
                const unsigned b0 = (unsigned)(int)(rintf(t[0] * inv) + 128.0f), b1 = (unsigned)(int)(rintf(t[1] * inv) + 128.0f), b2 = (unsigned)(int)(rintf(t[2] * inv) + 128.0f), b3 = (unsigned)(int)(rintf(t[3] * inv) + 128.0f);
                w[q] = b0 | (b1 << 8) | (b2 << 16) | (b3 << 24);
            }
            *(u32x4*)(dst + (size_t)row * DM + 1024 * i + 16 * lane) = w;
        }
    }
}
__device__ __forceinline__ void phase_prep(const Args& a, LAS unsigned char* lds) {
    unsigned char* ws = a.ws;
    LAS float* tile = (LAS float*)lds;
    transpose_tiles(tile, a.in[1], 4 * DM, DM, 4 * DM, (bf16_t*)(ws + WS_WIN));
    transpose_tiles(tile, a.in[3], DM, DM, DM, (bf16_t*)(ws + WS_WOUT));
    transpose_tiles(tile, a.in[5], 2 * DM, DM, 2 * DM, (bf16_t*)(ws + WS_WKVQ), DM);
    transpose_tiles(tile, a.in[6], DM, DM, DM, (bf16_t*)(ws + WS_WKVQ) + (size_t)2 * DM * DM, DM);
    transpose_tiles(tile, a.in[7], DM, DM, DM, (bf16_t*)(ws + WS_WO));
    fold_peer_keys((LAS float*)lds, a.in[8], a.in[9], (bf16_t*)(ws + WS_WC));
    convert_bf16(a.in[0], (bf16_t*)(ws + slot(0)), (size_t)MTOK * DM);
    const int gtid = blockIdx.x * 512 + threadIdx.x, gthreads = gridDim.x * 512;
    float* COS = (float*)(ws + WS_COS); float* SIN = (float*)(ws + WS_SIN); float* LB = (float*)(ws + WS_LB);
    for (int i = gtid; i < SEQ * 64; i += gthreads) {
        const int pos = i >> 6, j = i & 63;
        double inv = 1.0; const double r = 0.86596432336006535;
        for (int q = 0; q < j; ++q) inv *= r;
        const float ang = (float)pos * (float)inv;
        const double x = (double)ang;
        const double n = __builtin_rint(x * 0.15915494309189535);
        const float rf = (float)__builtin_fma(-n, 6.283185307179586, x);
        COS[i] = cosf(rf); SIN[i] = sinf(rf);
    }
    for (int c = gtid; c < DM; c += gthreads) { const float l0 = a.in[4][c], l1 = a.in[4][DM + c]; LB[c] = 1.0f / (1.0f + expf(l1 - l0)); }
}

__device__ __forceinline__ void phase_scan_naive(const bf16_t* Q1, const float* LF, const bf16_t* I1, float* O) {
    const int lane = threadIdx.x & 63, gw = blockIdx.x * 8 + (threadIdx.x >> 6), nw = gridDim.x * 8;
    for (int item = gw; item < 2 * NHEAD * 128; item += nw) {
        const int bh = item >> 7, v = item & 127, b = bh >> 4, h = bh & 15;
        const size_t base = (size_t)b * SEQ * DM + h * 128;
        float S0 = 0.f, S1 = 0.f;
#pragma unroll 4
        for (int t = 0; t < SEQ; ++t) {
            const size_t ro = base + (size_t)t * DM;
            const float f0 = __expf(LF[ro + lane]), f1 = __expf(LF[ro + 64 + lane]);
            const float q0 = bf2f(Q1[ro + lane]), q1 = bf2f(Q1[ro + 64 + lane]);
            const float iv = bf2f(I1[ro + v]);
            S0 = f0 * S0 + (1.0f - f0) * iv; S1 = f1 * S1 + (1.0f - f1) * iv;
            const float p = wave_sum(q0 * S0 + q1 * S1);
            if (lane == 0) O[ro + v] = p;
        }
    }
}
__device__ __forceinline__ void phase_onorm(const float* O, const bf16_t* G1, const float* gnorm, bf16_t* OG) {
    const int lane = threadIdx.x & 63, gw = blockIdx.x * 8 + (threadIdx.x >> 6), nw = gridDim.x * 8;
    const float gn0 = gnorm[2 * lane], gn1 = gnorm[2 * lane + 1];
    for (int item = gw; item < MTOK * NHEAD; item += nw) {
        const size_t off = (size_t)item * 128 + 2 * lane;
        const float o0 = O[off], o1 = O[off + 1];
        const float ss = wave_sum(o0 * o0 + o1 * o1);
        const float r = rsqrtf(ss * (1.0f / 128.0f) + 1e-6f);
        const unsigned g = *(const unsigned*)(G1 + off);
        *(unsigned*)(OG + off) = pk_bf16(o0 * r * gn0 * bflo(g), o1 * r * gn1 * bfhi(g));
    }
}

__device__ __forceinline__ void ln_row_store(float (&v)[32], const float* g, const float* bta, float* outf, bf16_t* outb, int lane, signed char* outq = nullptr, float* outs = nullptr) {
    float s = 0.f;
#pragma unroll
    for (int i = 0; i < 32; ++i) s += v[i];
    const float mu = wave_sum(s) * (1.0f / DM);
    float q = 0.f;
#pragma unroll
    for (int i = 0; i < 32; ++i) { v[i] -= mu; q += v[i] * v[i]; }
    const float rstd = rsqrtf(wave_sum(q) * (1.0f / DM) + 1e-5f);
    float am = 0.f;
#pragma unroll
    for (int i = 0; i < 4; ++i) {
        const int c = 512 * i + 8 * lane;
        const f32x4 g0 = *(const f32x4*)(g + c), g1 = *(const f32x4*)(g + c + 4), b0 = *(const f32x4*)(bta + c), b1 = *(const f32x4*)(bta + c + 4);
        f32x4 o0, o1;
#pragma unroll
        for (int j = 0; j < 4; ++j) { o0[j] = v[i * 8 + j] * rstd * g0[j] + b0[j]; o1[j] = v[i * 8 + 4 + j] * rstd * g1[j] + b1[j]; v[i * 8 + j] = o0[j]; v[i * 8 + 4 + j] = o1[j]; am = fmaxf(am, fmaxf(fabsf(o0[j]), fabsf(o1[j]))); }
        if (outf) { *(f32x4*)(outf + c) = o0; *(f32x4*)(outf + c + 4) = o1; }
        if (outb) { u32x4 w; w.x = pk_bf16(o0[0], o0[1]); w.y = pk_bf16(o0[2], o0[3]); w.z = pk_bf16(o1[0], o1[1]); w.w = pk_bf16(o1[2], o1[3]); *(u32x4*)(outb + c) = w; }
    }
    if (outq) {
        am = fmaxf(wave_max(am), 1e-30f);
        const float inv = 127.0f / am;
        if (lane == 0) *outs = am * (1.0f / 127.0f);
#pragma unroll
        for (int i = 0; i < 4; ++i) {
            u32x2 w;
            w.x = ((unsigned)(int)rintf(v[i * 8 + 0] * inv) & 0xffu) | (((unsigned)(int)rintf(v[i * 8 + 1] * inv) & 0xffu) << 8) | (((unsigned)(int)rintf(v[i * 8 + 2] * inv) & 0xffu) << 16) | (((unsigned)(int)rintf(v[i * 8 + 3] * inv) & 0xffu) << 24);
            w.y = ((unsigned)(int)rintf(v[i * 8 + 4] * inv) & 0xffu) | (((unsigned)(int)rintf(v[i * 8 + 5] * inv) & 0xffu) << 8) | (((unsigned)(int)rintf(v[i * 8 + 6] * inv) & 0xffu) << 16) | (((unsigned)(int)rintf(v[i * 8 + 7] * inv) & 0xffu) << 24);
            *(u32x2*)(outq + 512 * i + 8 * lane) = w;
        }
    }
}
__device__ __forceinline__ void ln_row_store16(float (&v)[32], const float* g, const float* bta, float* outf, bf16_t* outb, int lane) {
    float s = 0.f;
#pragma unroll
    for (int i = 0; i < 32; ++i) s += v[i];
    const float mu = wave_sum(s) * (1.0f / DM);
    float q = 0.f;
#pragma unroll
    for (int i = 0; i < 32; ++i) { v[i] -= mu; q += v[i] * v[i]; }
    const float rstd = rsqrtf(wave_sum(q) * (1.0f / DM) + 1e-5f);
#pragma unroll
    for (int i = 0; i < 2; ++i) {
        const int c = 1024 * i + 16 * lane;
        f32x4 o[4];
#pragma unroll
        for (int qd = 0; qd < 4; ++qd) {
            const f32x4 gg = *(const f32x4*)(g + c + 4 * qd), bb = *(const f32x4*)(bta + c + 4 * qd);
#pragma unroll
            for (int j = 0; j < 4; ++j) o[qd][j] = v[16 * i + 4 * qd + j] * rstd * gg[j] + bb[j];
            *(f32x4*)(outf + c + 4 * qd) = o[qd];
        }
        if (outb) {
            u32x4 w0, w1;
            w0.x = pk_bf16(o[0][0], o[0][1]); w0.y = pk_bf16(o[0][2], o[0][3]); w0.z = pk_bf16(o[1][0], o[1][1]); w0.w = pk_bf16(o[1][2], o[1][3]);
            w1.x = pk_bf16(o[2][0], o[2][1]); w1.y = pk_bf16(o[2][2], o[2][3]); w1.z = pk_bf16(o[3][0], o[3][1]); w1.w = pk_bf16(o[3][2], o[3][3]);
            *(u32x4*)(outb + c) = w0; *(u32x4*)(outb + c + 8) = w1;
        }
    }
}
template <bool RES16> __device__ __forceinline__ void phase_ln(const bf16_t* Y, const void* RESv, const float* g, const float* bta, float* outf, bf16_t* outb, signed char* outq = nullptr, float* outs = nullptr) {
    const int lane = threadIdx.x & 63, gw = blockIdx.x * 8 + (threadIdx.x >> 6), nw = gridDim.x * 8;
    for (int row = gw; row < MTOK; row += nw) {
        float v[32];
        const bf16_t* p = Y + (size_t)row * DM;
#pragma unroll
        for (int i = 0; i < 4; ++i) {
            const u32x4 yw = *(const u32x4*)(p + 512 * i + 8 * lane);
            const f32x4 a = {bflo(yw.x), bfhi(yw.x), bflo(yw.y), bfhi(yw.y)}, b = {bflo(yw.z), bfhi(yw.z), bflo(yw.w), bfhi(yw.w)};
            f32x4 ra, rb;
            if (RES16) { const u32x4 w = *(const u32x4*)((const bf16_t*)RESv + (size_t)row * DM + 512 * i + 8 * lane); ra = (f32x4){bflo(w.x), bfhi(w.x), bflo(w.y), bfhi(w.y)}; rb = (f32x4){bflo(w.z), bfhi(w.z), bflo(w.w), bfhi(w.w)}; }
            else { const float* rp = (const float*)RESv + (size_t)row * DM; ra = *(const f32x4*)(rp + 512 * i + 8 * lane); rb = *(const f32x4*)(rp + 512 * i + 8 * lane + 4); }
#pragma unroll
            for (int j = 0; j < 4; ++j) { v[i * 8 + j] = a[j] + ALPHA * ra[j]; v[i * 8 + 4 + j] = b[j] + ALPHA * rb[j]; }
        }
        ln_row_store(v, g, bta, outf ? outf + (size_t)row * DM : nullptr, outb ? outb + (size_t)row * DM : nullptr, lane, outq ? outq + (size_t)row * DM : nullptr, outs ? outs + row : nullptr);
    }
}

__device__ __forceinline__ void wave_argmax(float& v, int& idx) {
#pragma unroll
    for (int o = 32; o >= 1; o >>= 1) {
        const float ov = __shfl_xor(v, o); const int oi = __shfl_xor(idx, o);
        if (ov > v || (ov == v && oi < idx)) { v = ov; idx = oi; }
    }
}
__device__ __forceinline__ unsigned fkey(float x) { const unsigned u = __float_as_uint(x); return u ^ (unsigned)(((int)u >> 31) | 0x80000000); }
__device__ __forceinline__ float funkey(unsigned k) { const unsigned u = (k & 0x80000000u) ? (k ^ 0x80000000u) : ~k; return __uint_as_float(u); }
__device__ __forceinline__ void sort16_insert(unsigned (&r)[16], unsigned v) {
#pragma unroll
    for (int i = 0; i < 16; ++i) { const unsigned m = r[i] > v ? r[i] : v; v = r[i] > v ? v : r[i]; r[i] = m; }
}
__device__ __forceinline__ void phase_topk(LAS unsigned char* lds, const float* SCT, int* EID, float* GATE) {
    LAS unsigned char* ib = lds + threadIdx.x * 32;
    for (int item = blockIdx.x * 512 + threadIdx.x; item < MTOK * 8; item += gridDim.x * 512) {
        const int h = item >> 14, tok = item & (MTOK - 1);
        const float* p = SCT + (size_t)(h * 256) * MTOK + tok;
        unsigned r1[16], r2[16];
#pragma unroll
        for (int i = 0; i < 16; ++i) { r1[i] = 0u; r2[i] = 0u; }
#pragma unroll 8
        for (int e = 0; e < 128; ++e) {
            const float x1 = p[(size_t)e * MTOK], x2 = p[(size_t)(128 + e) * MTOK];
            sort16_insert(r1, (fkey(x1) & ~0x7Fu) | (unsigned)e);
            sort16_insert(r2, (fkey(x2) & ~0x7Fu) | (unsigned)e);
        }
        float v1[16], v2[16];
#pragma unroll
        for (int i = 0; i < 16; ++i) { v1[i] = funkey(r1[i] & ~0x7Fu); v2[i] = funkey(r2[i] & ~0x7Fu); ib[i] = (unsigned char)(r1[i] & 0x7Fu); ib[16 + i] = (unsigned char)(r2[i] & 0x7Fu); }
        unsigned r3[16];
#pragma unroll
        for (int i = 0; i < 16; ++i) r3[i] = 0u;
#pragma unroll
        for (int a = 0; a < 16; ++a)
#pragma unroll
            for (int bq = 0; bq < 16; ++bq)
                if ((a + 1) * (bq + 1) <= 16) sort16_insert(r3, (fkey(v1[a] + v2[bq]) & ~0xFFu) | (unsigned)(a * 16 + bq));
        const float mx = funkey(r3[0] & ~0xFFu);
        float ev[16]; float sum = 0.f;
#pragma unroll
        for (int i = 0; i < 16; ++i) { ev[i] = __expf(funkey(r3[i] & ~0xFFu) - mx); sum += ev[i]; }
        const float rs = 1.0f / sum;
        int eid[16];
#pragma unroll
        for (int i = 0; i < 16; ++i) { const unsigned f = r3[i] & 0xFFu; eid[i] = (int)ib[f >> 4] * 128 + (int)ib[16 + (f & 15u)]; }
        int* eo = EID + (size_t)tok * 128 + h * 16; float* go = GATE + (size_t)tok * 128 + h * 16;
#pragma unroll
        for (int q = 0; q < 4; ++q) {
            *(u32x4*)(eo + 4 * q) = (u32x4){(unsigned)eid[4 * q], (unsigned)eid[4 * q + 1], (unsigned)eid[4 * q + 2], (unsigned)eid[4 * q + 3]};
            *(f32x4*)(go + 4 * q) = (f32x4){ev[4 * q] * rs, ev[4 * q + 1] * rs, ev[4 * q + 2] * rs, ev[4 * q + 3] * rs};
        }
    }
}

__device__ __forceinline__ float gelu_erf(float x) { return 0.5f * x * (1.0f + erff(x * 0.70710678118654752f)); }
__device__ __forceinline__ float ub0(unsigned w) { return (float)(w & 0xffu); }
__device__ __forceinline__ float ub1(unsigned w) { return (float)((w >> 8) & 0xffu); }
__device__ __forceinline__ float ub2(unsigned w) { return (float)((w >> 16) & 0xffu); }
__device__ __forceinline__ float ub3(unsigned w) { return (float)(w >> 24); }
__device__ __forceinline__ void phase_peer(LAS unsigned char* lds, const float* X, const int* EID, const float* GATE, const unsigned char* U, const unsigned char* V, const float* USC, const float* VSC,
                                           const float* g, const float* bta, float* outf, bf16_t* outb) {
    const int lane = threadIdx.x & 63, wv = threadIdx.x >> 6, gw = blockIdx.x * 8 + wv, nw = gridDim.x * 8;
    LAS float* hb = (LAS float*)(lds + wv * 512);
    for (int tok = gw; tok < MTOK; tok += nw) {
        float x[32];
        const float* xp = X + (size_t)tok * DM;
#pragma unroll
        for (int i = 0; i < 2; ++i)
#pragma unroll
            for (int q = 0; q < 4; ++q) { const f32x4 t = *(const f32x4*)(xp + 1024 * i + 16 * lane + 4 * q); x[16 * i + 4 * q] = t[0]; x[16 * i + 4 * q + 1] = t[1]; x[16 * i + 4 * q + 2] = t[2]; x[16 * i + 4 * q + 3] = t[3]; }
        float sx = 0.f;
#pragma unroll
        for (int j = 0; j < 32; ++j) sx += x[j];
        const float d0 = -128.0f * sx;
        const int e0 = EID[(size_t)tok * 128 + lane], e1 = EID[(size_t)tok * 128 + 64 + lane];
        const float g0 = GATE[(size_t)tok * 128 + lane], g1 = GATE[(size_t)tok * 128 + 64 + lane];
        for (int bt = 0; bt < 16; ++bt) {
            float d[8];
#pragma unroll
            for (int r = 0; r < 8; ++r) {
                const int e = bt * 8 + r;
                const int idx = __builtin_amdgcn_readfirstlane(__shfl(bt < 8 ? e0 : e1, e & 63));
                const u32x4* up = (const u32x4*)(U + (size_t)idx * DM) + lane;
                float acc = d0;
#pragma unroll
                for (int i = 0; i < 2; ++i) {
                    const u32x4 w = up[i * 64];
                    acc += x[16 * i + 0] * ub0(w.x) + x[16 * i + 1] * ub1(w.x) + x[16 * i + 2] * ub2(w.x) + x[16 * i + 3] * ub3(w.x)
                         + x[16 * i + 4] * ub0(w.y) + x[16 * i + 5] * ub1(w.y) + x[16 * i + 6] * ub2(w.y) + x[16 * i + 7] * ub3(w.y)
                         + x[16 * i + 8] * ub0(w.z) + x[16 * i + 9] * ub1(w.z) + x[16 * i + 10] * ub2(w.z) + x[16 * i + 11] * ub3(w.z)
                         + x[16 * i + 12] * ub0(w.w) + x[16 * i + 13] * ub1(w.w) + x[16 * i + 14] * ub2(w.w) + x[16 * i + 15] * ub3(w.w);
                }
                d[r] = acc;
            }
            const bool b5 = lane & 32, b4 = lane & 16, b3 = lane & 8;
            float t4[4];
#pragma unroll
            for (int q = 0; q < 4; ++q) { const float keep = b5 ? d[4 + q] : d[q], send = b5 ? d[q] : d[4 + q]; t4[q] = keep + __shfl_xor(send, 32); }
            float t2[2];
#pragma unroll
            for (int q = 0; q < 2; ++q) { const float keep = b4 ? t4[2 + q] : t4[q], send = b4 ? t4[q] : t4[2 + q]; t2[q] = keep + __shfl_xor(send, 16); }
            float t1;
            { const float keep = b3 ? t2[1] : t2[0], send = b3 ? t2[0] : t2[1]; t1 = keep + __shfl_xor(send, 8); }
            t1 += __shfl_xor(t1, 4); t1 += __shfl_xor(t1, 2); t1 += __shfl_xor(t1, 1);
            if ((lane & 7) == 0) hb[bt * 8 + (lane >> 3 & 1) + 2 * (lane >> 4 & 1) + 4 * (lane >> 5 & 1)] = t1;
        }
        asm volatile("s_waitcnt lgkmcnt(0)" ::: "memory");
        const float h0 = hb[lane] * USC[e0], h1 = hb[64 + lane] * USC[e1];
        const float w0 = g0 * gelu_erf(h0) * VSC[e0], w1 = g1 * gelu_erf(h1) * VSC[e1];
        float wsum = wave_sum(w0 + w1);
        float y[32];
#pragma unroll
        for (int i = 0; i < 32; ++i) y[i] = 0.f;
#pragma unroll 8
        for (int e = 0; e < 128; ++e) {
            const int idx = __builtin_amdgcn_readfirstlane(__shfl(e < 64 ? e0 : e1, e & 63));
            const float wt = __shfl(e < 64 ? w0 : w1, e & 63);
            const u32x4* vp = (const u32x4*)(V + (size_t)idx * DM) + lane;
#pragma unroll
            for (int i = 0; i < 2; ++i) {
                const u32x4 w = vp[i * 64];
                y[16 * i + 0] += wt * ub0(w.x); y[16 * i + 1] += wt * ub1(w.x); y[16 * i + 2] += wt * ub2(w.x); y[16 * i + 3] += wt * ub3(w.x);
                y[16 * i + 4] += wt * ub0(w.y); y[16 * i + 5] += wt * ub1(w.y); y[16 * i + 6] += wt * ub2(w.y); y[16 * i + 7] += wt * ub3(w.y);
                y[16 * i + 8] += wt * ub0(w.z); y[16 * i + 9] += wt * ub1(w.z); y[16 * i + 10] += wt * ub2(w.z); y[16 * i + 11] += wt * ub3(w.z);
                y[16 * i + 12] += wt * ub0(w.w); y[16 * i + 13] += wt * ub1(w.w); y[16 * i + 14] += wt * ub2(w.w); y[16 * i + 15] += wt * ub3(w.w);
            }
        }
        const float corr = -128.0f * wsum;
#pragma unroll
        for (int i = 0; i < 32; ++i) y[i] = y[i] + corr + ALPHA * x[i];
        ln_row_store16(y, g, bta, outf + (size_t)tok * DM, outb ? outb + (size_t)tok * DM : nullptr, lane);
        asm volatile("s_waitcnt lgkmcnt(0)" ::: "memory");
    }
}

__device__ __forceinline__ int row_dot_i8(const u32x4 (&xq)[2], const unsigned char* rowp, int lane) {
    const u32x4* up = (const u32x4*)rowp + lane;
    int acc = 0;
#pragma unroll
    for (int i = 0; i < 2; ++i) {
        const u32x4 w = up[i * 64];
        acc = __builtin_amdgcn_sdot4((int)xq[i].x, (int)(w.x ^ 0x80808080u), acc, false); acc = __builtin_amdgcn_sdot4((int)xq[i].y, (int)(w.y ^ 0x80808080u), acc, false);
        acc = __builtin_amdgcn_sdot4((int)xq[i].z, (int)(w.z ^ 0x80808080u), acc, false); acc = __builtin_amdgcn_sdot4((int)xq[i].w, (int)(w.w ^ 0x80808080u), acc, false);
    }
    return acc;
}
__device__ __forceinline__ void peer_issue8(u32x4 (&seg)[8], const unsigned char* base, const u32x4 ia, const u32x4 ib) {
    seg[0] = *(const u32x4*)(base + (size_t)ia.x * DM); seg[1] = *(const u32x4*)(base + (size_t)ia.y * DM); seg[2] = *(const u32x4*)(base + (size_t)ia.z * DM); seg[3] = *(const u32x4*)(base + (size_t)ia.w * DM);
    seg[4] = *(const u32x4*)(base + (size_t)ib.x * DM); seg[5] = *(const u32x4*)(base + (size_t)ib.y * DM); seg[6] = *(const u32x4*)(base + (size_t)ib.z * DM); seg[7] = *(const u32x4*)(base + (size_t)ib.w * DM);
}
__device__ __forceinline__ void peer_dot8(int (&d)[8], const u32x4 (&seg)[8], const u32x4 xq) {
#pragma unroll
    for (int i = 0; i < 8; ++i) {
        int acc = __builtin_amdgcn_sdot4((int)xq.x, (int)(seg[i].x ^ 0x80808080u), 0, false);
        acc = __builtin_amdgcn_sdot4((int)xq.y, (int)(seg[i].y ^ 0x80808080u), acc, false);
        acc = __builtin_amdgcn_sdot4((int)xq.z, (int)(seg[i].z ^ 0x80808080u), acc, false);
        d[i] = __builtin_amdgcn_sdot4((int)xq.w, (int)(seg[i].w ^ 0x80808080u), acc, false);
    }
}
__device__ __forceinline__ void phase_peer_u(const signed char* XQ, const int* EID, const unsigned char* U, LAS int* HL  ) {
    const int lane = threadIdx.x & 63, wv = threadIdx.x >> 6, es = lane >> 3, cc = lane & 7;
    const bool b2 = cc & 4, b1 = cc & 2, b0 = cc & 1;
    const int nw = gridDim.x * 8, gw = blockIdx.x * 8 + wv, tpw = (MTOK + nw - 1) / nw, tbase = gw * tpw;
    int cnt = MTOK - tbase; cnt = cnt > tpw ? tpw : cnt;
    if (cnt <= 0) return;
    for (int i = lane; i < cnt * 128; i += 64) HL[i] = 0;
    asm volatile("s_waitcnt lgkmcnt(0)" ::: "memory");
    const int nit = 16 * cnt;
    const unsigned char* ub = U + cc * 16;
    u32x4 m0a, m0b, m0c, m0d, m0x, m1a, m1b, m1c, m1d, m1x, m2a, m2b, m2c, m2d, m2x; u32x4 sA[8], sB[8];
#define PU_LOAD(sl_, k_, A_, B_, C_, D_, X_) { const int* ep_ = EID + (size_t)(tbase + (k_)) * 128 + es * 16; A_ = *(const u32x4*)ep_; B_ = *(const u32x4*)(ep_ + 4); C_ = *(const u32x4*)(ep_ + 8); D_ = *(const u32x4*)(ep_ + 12); \
        X_ = *(const u32x4*)(XQ + (size_t)(tbase + (k_)) * DM + (sl_) * 128 + cc * 16); }
#define PU_NEXT(sl_, k_, sn_, kn_) { kn_ = (k_) + 1; sn_ = (sl_); if (kn_ == cnt) { kn_ = 0; ++sn_; } if (sn_ == 16) { sn_ = 15; kn_ = cnt - 1; } }
    int sl = 0, k = 0, sl1, k1, sl2, k2;
    PU_NEXT(sl, k, sl1, k1) PU_NEXT(sl1, k1, sl2, k2)
    PU_LOAD(sl, k, m0a, m0b, m0c, m0d, m0x)
    PU_LOAD(sl1, k1, m1a, m1b, m1c, m1d, m1x)
    peer_issue8(sA, ub + sl * 128, m0a, m0b);
    for (int it = 0; it < nit; ++it) {
        PU_LOAD(sl2, k2, m2a, m2b, m2c, m2d, m2x)
        peer_issue8(sB, ub + sl * 128, m0c, m0d);
        int dlo[8]; peer_dot8(dlo, sA, m0x);
        peer_issue8(sA, ub + sl1 * 128, m1a, m1b);
        int dhi[8]; peer_dot8(dhi, sB, m0x);
        int t8[8], t4[4], t2[2];
#pragma unroll
        for (int q = 0; q < 8; ++q) { const int keep = b2 ? dhi[q] : dlo[q], send = b2 ? dlo[q] : dhi[q]; t8[q] = keep + __shfl_xor(send, 4); }
#pragma unroll
        for (int q = 0; q < 4; ++q) { const int keep = b1 ? t8[4 + q] : t8[q], send = b1 ? t8[q] : t8[4 + q]; t4[q] = keep + __shfl_xor(send, 2); }
#pragma unroll
        for (int q = 0; q < 2; ++q) { const int keep = b0 ? t4[2 + q] : t4[q], send = b0 ? t4[q] : t4[2 + q]; t2[q] = keep + __shfl_xor(send, 1); }
        { LAS int* hp = HL + k * 128 + es * 16 + (b2 ? 8 : 0) + (b1 ? 4 : 0) + (b0 ? 2 : 0);
          __hip_atomic_fetch_add(hp, t2[0], __ATOMIC_RELAXED, __HIP_MEMORY_SCOPE_WORKGROUP); __hip_atomic_fetch_add(hp + 1, t2[1], __ATOMIC_RELAXED, __HIP_MEMORY_SCOPE_WORKGROUP); }
        sl = sl1; k = k1; sl1 = sl2; k1 = k2; PU_NEXT(sl1, k1, sl2, k2)
        m0a = m1a; m0b = m1b; m0c = m1c; m0d = m1d; m0x = m1x; m1a = m2a; m1b = m2b; m1c = m2c; m1d = m2d; m1x = m2x;
    }
#undef PU_LOAD
#undef PU_NEXT
}
__device__ __forceinline__ void phase_peer_w(const LAS int* HL, const float* XS, const int* EID, const float* GATE, const float* USC, const float* VSC, float* W, float* CS) {
    const int lane = threadIdx.x & 63, gw = blockIdx.x * 8 + (threadIdx.x >> 6), nw = gridDim.x * 8, tpw = (MTOK + nw - 1) / nw, tbase = gw * tpw;
    const int tend = tbase + tpw < MTOK ? tbase + tpw : MTOK;
    for (int tok = tbase; tok < tend; ++tok) {
        const int h0 = HL[(tok - tbase) * 128 + lane], h1 = HL[(tok - tbase) * 128 + 64 + lane];
        const int e0 = EID[(size_t)tok * 128 + lane], e1 = EID[(size_t)tok * 128 + 64 + lane];
        const float xs = XS[tok];
        const float w0 = GATE[(size_t)tok * 128 + lane] * gelu_erf((float)h0 * xs * USC[e0]) * VSC[e0];
        const float w1 = GATE[(size_t)tok * 128 + 64 + lane] * gelu_erf((float)h1 * xs * USC[e1]) * VSC[e1];
        W[(size_t)tok * 128 + lane] = w0; W[(size_t)tok * 128 + 64 + lane] = w1;
        const float cs = wave_sum(w0 + w1);
        if (lane == 0) CS[tok] = cs;
    }
}
__device__ __forceinline__ void peer_fma8(f32x2_t (&ya)[8], const u32x4 (&seg)[8], const f32x4 wa, const f32x4 wb2) {
#pragma unroll
    for (int i = 0; i < 8; ++i) {
        const float wt = i < 4 ? wa[i & 3] : wb2[i & 3];
        const f32x2_t wt2 = {wt, wt};
        const u32x4 w = seg[i];
        ya[0] = __builtin_elementwise_fma(wt2, (f32x2_t){ub0(w.x), ub1(w.x)}, ya[0]); ya[1] = __builtin_elementwise_fma(wt2, (f32x2_t){ub2(w.x), ub3(w.x)}, ya[1]);
        ya[2] = __builtin_elementwise_fma(wt2, (f32x2_t){ub0(w.y), ub1(w.y)}, ya[2]); ya[3] = __builtin_elementwise_fma(wt2, (f32x2_t){ub2(w.y), ub3(w.y)}, ya[3]);
        ya[4] = __builtin_elementwise_fma(wt2, (f32x2_t){ub0(w.z), ub1(w.z)}, ya[4]); ya[5] = __builtin_elementwise_fma(wt2, (f32x2_t){ub2(w.z), ub3(w.z)}, ya[5]);
        ya[6] = __builtin_elementwise_fma(wt2, (f32x2_t){ub0(w.w), ub1(w.w)}, ya[6]); ya[7] = __builtin_elementwise_fma(wt2, (f32x2_t){ub2(w.w), ub3(w.w)}, ya[7]);
    }
}
__device__ __forceinline__ void phase_peer_v(const bf16_t* X, const int* EID, const float* W, const float* CS, const unsigned char* V, float* Y) {
    const int lane = threadIdx.x & 63, wv = threadIdx.x >> 6, es = lane >> 3, cc = lane & 7;
    const bool b5 = lane & 32, b4 = lane & 16, b3 = lane & 8;
    const int nw = gridDim.x * 8, gw = blockIdx.x * 8 + wv, tpw = (MTOK + nw - 1) / nw, tbase = gw * tpw;
    int cnt = MTOK - tbase; cnt = cnt > tpw ? tpw : cnt;
    if (cnt <= 0) return;
    const int nit = 16 * cnt;
    const unsigned char* vb = V + cc * 16;
    const int colo = cc * 16 + (b5 ? 8 : 0) + (b4 ? 4 : 0) + (b3 ? 2 : 0);
    u32x4 m0c, m0d, m1a, m1b, m1c, m1d, m2a, m2b, m2c, m2d; f32x4 w0a, w0b, w0c, w0d, w1a, w1b, w1c, w1d; f32x2_t x0, x1; float c0, c1; u32x4 sA[8], sB[8];
#define PV_IDS(k_, A_, B_, C_, D_) { const size_t o_ = (size_t)(tbase + (k_)) * 128 + es * 16; A_ = *(const u32x4*)(EID + o_); B_ = *(const u32x4*)(EID + o_ + 4); C_ = *(const u32x4*)(EID + o_ + 8); D_ = *(const u32x4*)(EID + o_ + 12); }
#define PV_WX(sl_, k_, WA_, WB_, WC_, WD_, X_, CS_) { const size_t o_ = (size_t)(tbase + (k_)) * 128 + es * 16; \
        WA_ = *(const f32x4*)(W + o_); WB_ = *(const f32x4*)(W + o_ + 4); WC_ = *(const f32x4*)(W + o_ + 8); WD_ = *(const f32x4*)(W + o_ + 12); \
        { const unsigned xw_ = *(const unsigned*)(X + (size_t)(tbase + (k_)) * DM + (sl_) * 128 + colo); X_ = (f32x2_t){bflo(xw_), bfhi(xw_)}; } CS_ = CS[tbase + (k_)]; }
#define PV_NEXT(sl_, k_, sn_, kn_) { kn_ = (k_) + 1; sn_ = (sl_); if (kn_ == cnt) { kn_ = 0; ++sn_; } if (sn_ == 16) { sn_ = 15; kn_ = cnt - 1; } }
    int sl = 0, k = 0, sl1, k1, sl2, k2;
    PV_NEXT(sl, k, sl1, k1) PV_NEXT(sl1, k1, sl2, k2)
    { u32x4 ta, tb; PV_IDS(k, ta, tb, m0c, m0d) PV_IDS(k1, m1a, m1b, m1c, m1d)
      PV_WX(sl, k, w0a, w0b, w0c, w0d, x0, c0)
      peer_issue8(sA, vb + sl * 128, ta, tb); }
    for (int it = 0; it < nit; ++it) {
        PV_IDS(k2, m2a, m2b, m2c, m2d)
        peer_issue8(sB, vb + sl * 128, m0c, m0d);
        f32x2_t ya[8];
#pragma unroll
        for (int j = 0; j < 8; ++j) ya[j] = (f32x2_t){0.f, 0.f};
        peer_fma8(ya, sA, w0a, w0b);
        peer_issue8(sA, vb + sl1 * 128, m1a, m1b);
        PV_WX(sl1, k1, w1a, w1b, w1c, w1d, x1, c1)
        peer_fma8(ya, sB, w0c, w0d);
        f32x2_t t4[4], t2[2], t1;
#pragma unroll
        for (int q = 0; q < 4; ++q) { const f32x2_t keep = b5 ? ya[4 + q] : ya[q], send = b5 ? ya[q] : ya[4 + q]; t4[q][0] = keep[0] + __shfl_xor(send[0], 32); t4[q][1] = keep[1] + __shfl_xor(send[1], 32); }
#pragma unroll
        for (int q = 0; q < 2; ++q) { const f32x2_t keep = b4 ? t4[2 + q] : t4[q], send = b4 ? t4[q] : t4[2 + q]; t2[q][0] = keep[0] + __shfl_xor(send[0], 16); t2[q][1] = keep[1] + __shfl_xor(send[1], 16); }
        { const f32x2_t keep = b3 ? t2[1] : t2[0], send = b3 ? t2[0] : t2[1]; t1[0] = keep[0] + __shfl_xor(send[0], 8); t1[1] = keep[1] + __shfl_xor(send[1], 8); }
        f32x2_t o; o[0] = t1[0] - 128.0f * c0 + ALPHA * x0[0]; o[1] = t1[1] - 128.0f * c0 + ALPHA * x0[1];
        *(f32x2_t*)(Y + (size_t)(tbase + k) * DM + sl * 128 + colo) = o;
        sl = sl1; k = k1; sl1 = sl2; k1 = k2; PV_NEXT(sl1, k1, sl2, k2)
        m0c = m1c; m0d = m1d; m1a = m2a; m1b = m2b; m1c = m2c; m1d = m2d;
        w0a = w1a; w0b = w1b; w0c = w1c; w0d = w1d; x0 = x1; c0 = c1;
    }
#undef PV_IDS
#undef PV_WX
#undef PV_NEXT
}

__device__ __forceinline__ void rot8(const u32x4 lo, const u32x4 hi, const f32x4 c0, const f32x4 c1, const f32x4 s0, const f32x4 s1, float (&o1)[8], float (&o2)[8]) {
    const float a[8] = {bflo(lo.x), bfhi(lo.x), bflo(lo.y), bfhi(lo.y), bflo(lo.z), bfhi(lo.z), bflo(lo.w), bfhi(lo.w)};
    const float b[8] = {bflo(hi.x), bfhi(hi.x), bflo(hi.y), bfhi(hi.y), bflo(hi.z), bfhi(hi.z), bflo(hi.w), bfhi(hi.w)};
    const float c[8] = {c0[0], c0[1], c0[2], c0[3], c1[0], c1[1], c1[2], c1[3]}, sn[8] = {s0[0], s0[1], s0[2], s0[3], s1[0], s1[1], s1[2], s1[3]};
#pragma unroll
    for (int j = 0; j < 8; ++j) { o1[j] = a[j] * c[j] - b[j] * sn[j]; o2[j] = a[j] * sn[j] + b[j] * c[j]; }
}
__device__ __forceinline__ u32x4 pack8(const float (&o)[8]) { u32x4 w; w.x = pk_bf16(o[0], o[1]); w.y = pk_bf16(o[2], o[3]); w.z = pk_bf16(o[4], o[5]); w.w = pk_bf16(o[6], o[7]); return w; }
__device__ __forceinline__ void phase_kstat(LAS float* red, const bf16_t* KR, float* KMEAN, float* KNMAX) {
    const int tid = threadIdx.x, ch = tid & 7, rr = tid >> 3, wv = tid >> 6, lane = tid & 63;
    for (int item = blockIdx.x; item < 2 * NHEAD * 32; item += gridDim.x) {
        const int bh = item >> 5, j = item & 31, b = bh >> 4, h = bh & 15;
        float sm1[8], sm2[8]; float nmax = 0.f;
#pragma unroll
        for (int q = 0; q < 8; ++q) { sm1[q] = 0.f; sm2[q] = 0.f; }
        u32x4 lo[4], hi[4];
#pragma unroll
        for (int ps = 0; ps < 4; ++ps) { const size_t off = ((size_t)b * SEQ + j * 256 + ps * 64 + rr) * DM + h * 128 + ch * 8; lo[ps] = *(const u32x4*)(KR + off); hi[ps] = *(const u32x4*)(KR + off + 64); }
#pragma unroll
        for (int ps = 0; ps < 4; ++ps) {
            const float a[8] = {bflo(lo[ps].x), bfhi(lo[ps].x), bflo(lo[ps].y), bfhi(lo[ps].y), bflo(lo[ps].z), bfhi(lo[ps].z), bflo(lo[ps].w), bfhi(lo[ps].w)};
            const float c[8] = {bflo(hi[ps].x), bfhi(hi[ps].x), bflo(hi[ps].y), bfhi(hi[ps].y), bflo(hi[ps].z), bfhi(hi[ps].z), bflo(hi[ps].w), bfhi(hi[ps].w)};
            float nq = 0.f;
#pragma unroll
            for (int q = 0; q < 8; ++q) { sm1[q] += a[q]; sm2[q] += c[q]; nq += a[q] * a[q] + c[q] * c[q]; }
            nq += __shfl_xor(nq, 1); nq += __shfl_xor(nq, 2); nq += __shfl_xor(nq, 4);
            nmax = fmaxf(nmax, nq);
        }
#pragma unroll
        for (int q = 0; q < 8; ++q) {
            sm1[q] += __shfl_xor(sm1[q], 8); sm1[q] += __shfl_xor(sm1[q], 16); sm1[q] += __shfl_xor(sm1[q], 32);
            sm2[q] += __shfl_xor(sm2[q], 8); sm2[q] += __shfl_xor(sm2[q], 16); sm2[q] += __shfl_xor(sm2[q], 32);
        }
        nmax = wave_max(nmax);
        if (lane < 8) {
#pragma unroll
            for (int q = 0; q < 8; ++q) { red[wv * 128 + lane * 8 + q] = sm1[q]; red[wv * 128 + 64 + lane * 8 + q] = sm2[q]; }
        }
        if (lane == 0) red[1024 + wv] = nmax;
        __syncthreads();
        if (tid < 128) {
            float s2 = 0.f;
#pragma unroll
            for (int r = 0; r < 8; ++r) s2 += red[r * 128 + tid];
            KMEAN[(size_t)item * 128 + tid] = s2 * (1.0f / 256.0f);
        }
        if (tid == 0) {
            float m = 0.f;
#pragma unroll
            for (int r = 0; r < 8; ++r) m = fmaxf(m, red[1024 + r]);
            KNMAX[item] = sqrtf(m);
        }
        __syncthreads();
    }
}

__device__ __forceinline__ void top3_insert(float x, int m, float& v0, int& i0, float& v1, int& i1, float& v2, int& i2) {
    const bool c0 = x > v0 || (x == v0 && m < i0), c1 = x > v1 || (x == v1 && m < i1), c2 = x > v2 || (x == v2 && m < i2);
    v2 = c1 ? v1 : (c2 ? x : v2); i2 = c1 ? i1 : (c2 ? m : i2);
    v1 = c0 ? v0 : (c1 ? x : v1); i1 = c0 ? i0 : (c1 ? m : i1);
    v0 = c0 ? x : v0; i0 = c0 ? m : i0;
}
__device__ __forceinline__ void phase_sel(LAS unsigned char* lds, const bf16_t* QR, const float* KMEAN, unsigned short* SUB, int* CNT, int* ctr) {
    const int tid = threadIdx.x, lane = tid & 63, wv = tid >> 6, r32 = lane & 31, hh = lane >> 5;
    LAS unsigned short* bucket = (LAS unsigned short*)lds;
    LAS int* cnt = (LAS int*)(lds + 16384);
    const float NEG = -1e30f;
    if (blockIdx.x == 0 && tid == 0) *ctr = 0;
    for (int item = blockIdx.x; item < 2 * NHEAD * 32; item += gridDim.x) {
        const int bh = item >> 5, i = item & 31, b = bh >> 4, h = bh & 15;
        if (i == 0) continue;
        if (tid < 32) cnt[tid] = 0;
        __syncthreads();
        const float* kmp = KMEAN + ((size_t)bh * 32 + r32) * 128 + 8 * hh;
        const size_t tok = (size_t)b * SEQ + i * 256 + wv * 32 + r32;
        const bf16_t* qp = QR + tok * DM + h * 128 + 8 * hh;
        f32x16 S;
#pragma unroll
        for (int e = 0; e < 16; ++e) S[e] = 0.f;
#pragma unroll
        for (int s2 = 0; s2 < 8; ++s2) {
            const f32x4 ka = *(const f32x4*)(kmp + 16 * s2), kb = *(const f32x4*)(kmp + 16 * s2 + 4);
            const bf16x8 qf = *(const bf16x8*)(qp + 16 * s2);
            u32x4 hi, lo;
            hi.x = pk_bf16(ka[0], ka[1]); hi.y = pk_bf16(ka[2], ka[3]); hi.z = pk_bf16(kb[0], kb[1]); hi.w = pk_bf16(kb[2], kb[3]);
            lo.x = pk_bf16(ka[0] - bflo(hi.x), ka[1] - bfhi(hi.x)); lo.y = pk_bf16(ka[2] - bflo(hi.y), ka[3] - bfhi(hi.y));
            lo.z = pk_bf16(kb[0] - bflo(hi.z), kb[1] - bfhi(hi.z)); lo.w = pk_bf16(kb[2] - bflo(hi.w), kb[3] - bfhi(hi.w));
            S = __builtin_amdgcn_mfma_f32_32x32x16_bf16(__builtin_bit_cast(bf16x8, hi), qf, S, 0, 0, 0);
            S = __builtin_amdgcn_mfma_f32_32x32x16_bf16(__builtin_bit_cast(bf16x8, lo), qf, S, 0, 0, 0);
        }
        float v0 = -3e38f, v1 = -3e38f, v2 = -3e38f; int i0 = 99, i1 = 99, i2 = 99;
#pragma unroll
        for (int e = 0; e < 16; ++e) {
            const int m = (e & 3) + 8 * (e >> 2) + 4 * hh;
            const float x = m < i ? S[e] : NEG;
            top3_insert(x, m, v0, i0, v1, i1, v2, i2);
        }
        {
            const float pv0 = __shfl_xor(v0, 32), pv1 = __shfl_xor(v1, 32), pv2 = __shfl_xor(v2, 32);
            const int pi0 = __shfl_xor(i0, 32), pi1 = __shfl_xor(i1, 32), pi2 = __shfl_xor(i2, 32);
            top3_insert(pv0, pi0, v0, i0, v1, i1, v2, i2); top3_insert(pv1, pi1, v0, i0, v1, i1, v2, i2); top3_insert(pv2, pi2, v0, i0, v1, i1, v2, i2);
        }
        if (hh == 0) {
            const int tl = wv * 32 + r32;
            if (v0 > 0.5f * NEG) { const int p = __hip_atomic_fetch_add(cnt + i0, 1, __ATOMIC_RELAXED, __HIP_MEMORY_SCOPE_WORKGROUP); bucket[i0 * 256 + p] = (unsigned short)(tl | (0 << 8)); }
            if (v1 > 0.5f * NEG) { const int p = __hip_atomic_fetch_add(cnt + i1, 1, __ATOMIC_RELAXED, __HIP_MEMORY_SCOPE_WORKGROUP); bucket[i1 * 256 + p] = (unsigned short)(tl | (1 << 8)); }
            if (v2 > 0.5f * NEG) { const int p = __hip_atomic_fetch_add(cnt + i2, 1, __ATOMIC_RELAXED, __HIP_MEMORY_SCOPE_WORKGROUP); bucket[i2 * 256 + p] = (unsigned short)(tl | (2 << 8)); }
        }
        __syncthreads();
        for (int idx = tid; idx < 32 * 256; idx += 512) {
            const int j = idx >> 8, p = idx & 255;
            if (j < i && p < cnt[j]) SUB[(((size_t)bh * 32 + j) * 32 + i) * 256 + p] = bucket[idx];
        }
        if (tid < i) CNT[((size_t)bh * 32 + tid) * 32 + i] = cnt[tid];
        __syncthreads();
    }
}

__device__ __forceinline__ unsigned off_b(unsigned row, unsigned ch) { return 256u * row + 16u * (ch ^ (((row & 3u) << 2) | ((row >> 2) & 3u))); }
__device__ __forceinline__ unsigned pi32(unsigned m) { return (m & ~12u) | ((m & 4u) << 1) | ((m & 8u) >> 1); }
__device__ __forceinline__ bf16x8 tr_frag(LAS unsigned char* img, unsigned lane, unsigned c, unsigned ks) {
    const unsigned hh = lane >> 5, blk = (lane >> 4) & 1, q = (lane & 15) >> 2, p = lane & 3;
    const unsigned a0 = off_b(16 * ks + 8 * hh + q, 4 * c + 2 * blk + (p >> 1)) + 8 * (p & 1);
    const unsigned a1 = off_b(16 * ks + 8 * hh + 4 + q, 4 * c + 2 * blk + (p >> 1)) + 8 * (p & 1);
    const s16x4 lo = __builtin_amdgcn_ds_read_tr16_b64_v4i16((LAS s16x4*)(img + a0));
    const s16x4 hi = __builtin_amdgcn_ds_read_tr16_b64_v4i16((LAS s16x4*)(img + a1));
    bf16x8 r; r[0] = lo[0]; r[1] = lo[1]; r[2] = lo[2]; r[3] = lo[3]; r[4] = hi[0]; r[5] = hi[1]; r[6] = hi[2]; r[7] = hi[3];
    return r;
}
__device__ __forceinline__ void phase_att(LAS unsigned char* lds, const bf16_t* QR, const bf16_t* KR, const bf16_t* V, const float* KNMAX, const unsigned short* SUB, const int* CNT, int* ctr,
                                          bf16_t* P012, bf16_t* P3, float* LS) {
    const int tid = threadIdx.x, lane = tid & 63, wv = tid >> 6, r32 = lane & 31, hh = lane >> 5;
    LAS unsigned char* Kimg = lds;
    LAS unsigned char* Vimg = lds + 65536;
    LAS int* misc = (LAS int*)(lds + 131072);
    const float SCL2 = 0.08838834764831845f * 1.4426950408889634f;
    for (;;) {
        __syncthreads();
        if (tid == 0) misc[40] = __hip_atomic_fetch_add(ctr, 1, __ATOMIC_RELAXED, __HIP_MEMORY_SCOPE_AGENT);
        __syncthreads();
        const int item = misc[40];
        if (item >= 2 * NHEAD * 32) break;
        const int j = item >> 5, bh = item & 31, b = bh >> 4, h = bh & 15;
#pragma unroll
        for (int r = 0; r < 8; ++r) {
            const int idx = tid + 512 * r, row = idx >> 4, ch = idx & 15;
            const size_t g = ((size_t)b * SEQ + j * 256 + row) * DM + h * 128 + ch * 8;
            const u32x4 kv = *(const u32x4*)(KR + g), vv = *(const u32x4*)(V + g);
            *(LAS u32x4*)(Kimg + off_b(row, ch)) = kv; *(LAS u32x4*)(Vimg + off_b(row, ch)) = vv;
        }
        if (tid <= 32) { int pre = 0; for (int u = j + 1; u < tid; ++u) pre += CNT[((size_t)bh * 32 + j) * 32 + u]; misc[tid] = pre; }
        float kn = (lane < 32) ? KNMAX[bh * 32 + lane] : 0.f;
        kn = wave_max(kn);
        __syncthreads();
        const int total = misc[32], ntile = (256 + total + 31) >> 5;
        for (int tile = wv; tile < ntile; tile += 8) {
            const int gr = tile * 32 + r32;
            int pos, slot; bool valid = true;
            if (gr < 256) { pos = j * 256 + gr; slot = 3; }
            else {
                const int x = gr - 256; valid = x < total;
                int ii = j + 1;
                for (int u = j + 1; u < 32; ++u) if (misc[u] <= x) ii = u;
                if (valid) { const unsigned e = SUB[(((size_t)bh * 32 + j) * 32 + ii) * 256 + (x - misc[ii])]; pos = ii * 256 + (int)(e & 255u); slot = (int)(e >> 8); }
                else { pos = j * 256; slot = 3; }
            }
            const size_t tok = (size_t)b * SEQ + pos;
            bf16x8 qf[8];
            const bf16_t* qp = QR + tok * DM + h * 128 + 8 * hh;
#pragma unroll
            for (int s = 0; s < 8; ++s) qf[s] = *(const bf16x8*)(qp + 16 * s);
            float qn2 = 0.f;
#pragma unroll
            for (int s = 0; s < 8; ++s)
#pragma unroll
                for (int e = 0; e < 8; ++e) { const float f = bf2f((bf16_t)qf[s][e]); qn2 += f * f; }
            qn2 += __shfl_xor(qn2, 32);
            const float c2 = sqrtf(qn2) * kn * SCL2;
            f32x16 O[4];
#pragma unroll
            for (int dt = 0; dt < 4; ++dt)
#pragma unroll
                for (int e = 0; e < 16; ++e) O[dt][e] = 0.f;
            float l = 0.f;
            const bool own = tile < 8;
            const int kcn = own ? tile + 1 : 8;
            const unsigned krow = pi32((unsigned)r32);
            for (int kc = 0; kc < kcn; ++kc) {
                f32x16 S, S1;
#pragma unroll
                for (int e = 0; e < 16; ++e) { S[e] = 0.f; S1[e] = 0.f; }
#pragma unroll
                for (int s = 0; s < 8; s += 2) {
                    const bf16x8 kf = *(const LAS bf16x8*)(Kimg + off_b(32 * kc + krow, 2 * s + hh));
                    const bf16x8 kf1 = *(const LAS bf16x8*)(Kimg + off_b(32 * kc + krow, 2 * s + 2 + hh));
                    S = __builtin_amdgcn_mfma_f32_32x32x16_bf16(kf, qf[s], S, 0, 0, 0);
                    S1 = __builtin_amdgcn_mfma_f32_32x32x16_bf16(kf1, qf[s + 1], S1, 0, 0, 0);
                }
                float p[16];
                if (own) {
#pragma unroll
                    for (int e = 0; e < 16; ++e) {
                        const unsigned m = (e & 3) + 8 * (e >> 2) + 4 * hh;
                        const int key = j * 256 + 32 * kc + (int)pi32(m);
                        float pe = __builtin_amdgcn_exp2f((S[e] + S1[e]) * SCL2 - c2);
                        if (key > pos) pe = 0.f;
                        p[e] = pe; l += pe;
                    }
                } else {
#pragma unroll
                    for (int e = 0; e < 16; ++e) { const float pe = __builtin_amdgcn_exp2f((S[e] + S1[e]) * SCL2 - c2); p[e] = pe; l += pe; }
                }
                u32x4 w0, w1;
                w0.x = pk_bf16(p[0], p[1]); w0.y = pk_bf16(p[2], p[3]); w0.z = pk_bf16(p[4], p[5]); w0.w = pk_bf16(p[6], p[7]);
                w1.x = pk_bf16(p[8], p[9]); w1.y = pk_bf16(p[10], p[11]); w1.z = pk_bf16(p[12], p[13]); w1.w = pk_bf16(p[14], p[15]);
                const bf16x8 pf0 = __builtin_bit_cast(bf16x8, w0), pf1 = __builtin_bit_cast(bf16x8, w1);
#pragma unroll
                for (int dt = 0; dt < 4; ++dt) {
                    const bf16x8 v0 = tr_frag(Vimg, lane, dt, 2 * kc), v1 = tr_frag(Vimg, lane, dt, 2 * kc + 1);
                    O[dt] = __builtin_amdgcn_mfma_f32_32x32x16_bf16(v0, pf0, O[dt], 0, 0, 0);
                    O[dt] = __builtin_amdgcn_mfma_f32_32x32x16_bf16(v1, pf1, O[dt], 0, 0, 0);
                }
            }
            l += __shfl_xor(l, 32);
            if (valid) {
                bf16_t* pl = (slot < 3 ? P012 + (size_t)slot * ((size_t)32 << 20) : P3) + (tok * NHEAD + h) * 128 + 4 * hh;
#pragma unroll
                for (int dt = 0; dt < 4; ++dt)
#pragma unroll
                    for (int g = 0; g < 4; ++g) {
                        u32x2 w; w.x = pk_bf16(O[dt][4 * g], O[dt][4 * g + 1]); w.y = pk_bf16(O[dt][4 * g + 2], O[dt][4 * g + 3]);
                        *(u32x2*)(pl + 32 * dt + 8 * g) = w;
                    }
                if (hh == 0) LS[(size_t)slot * MTOK * NHEAD + tok * NHEAD + h] = l;
            }
        }
    }
}
__device__ __forceinline__ void phase_comb(const bf16_t* P012, const bf16_t* P3, const float* LS, bf16_t* AO) {
    const size_t n = (size_t)MTOK * NHEAD * 16, stride = (size_t)gridDim.x * 512;
    for (size_t idx = (size_t)blockIdx.x * 512 + threadIdx.x; idx < n; idx += stride) {
        const size_t th = idx >> 4; const int ch = (int)(idx & 15);
        const int t = (int)((th >> 4) & (SEQ - 1)), blk = t >> 8, nsel = blk < 3 ? blk : 3;
        float acc[8];
        float l = LS[(size_t)3 * MTOK * NHEAD + th];
        { const u32x4 w = *(const u32x4*)(P3 + th * 128 + ch * 8);
          acc[0] = bflo(w.x); acc[1] = bfhi(w.x); acc[2] = bflo(w.y); acc[3] = bfhi(w.y); acc[4] = bflo(w.z); acc[5] = bfhi(w.z); acc[6] = bflo(w.w); acc[7] = bfhi(w.w); }
        for (int s = 0; s < nsel; ++s) {
            const u32x4 w = *(const u32x4*)(P012 + (size_t)s * ((size_t)32 << 20) + th * 128 + ch * 8);
            acc[0] += bflo(w.x); acc[1] += bfhi(w.x); acc[2] += bflo(w.y); acc[3] += bfhi(w.y); acc[4] += bflo(w.z); acc[5] += bfhi(w.z); acc[6] += bflo(w.w); acc[7] += bfhi(w.w);
            l += LS[(size_t)s * MTOK * NHEAD + th];
        }
        const float rl = 1.0f / l;
        u32x4 o; o.x = pk_bf16(acc[0] * rl, acc[1] * rl); o.y = pk_bf16(acc[2] * rl, acc[3] * rl); o.z = pk_bf16(acc[4] * rl, acc[5] * rl); o.w = pk_bf16(acc[6] * rl, acc[7] * rl);
        *(u32x4*)(AO + th * 128 + ch * 8) = o;
    }
}


__device__ __forceinline__ void qrow_issue(f32x4 (&v)[8], const float* p, int lane) {
#pragma unroll
    for (int i = 0; i < 2; ++i)
#pragma unroll
        for (int q = 0; q < 4; ++q) v[i * 4 + q] = *(const f32x4*)(p + 1024 * i + 16 * lane + 4 * q);
}
__device__ __forceinline__ void qrow_finish(const f32x4 (&v)[8], unsigned char* dst, float* scl, int lane) {
    float am = 0.f;
#pragma unroll
    for (int i = 0; i < 8; ++i) am = fmaxf(am, fmaxf(fmaxf(fabsf(v[i][0]), fabsf(v[i][1])), fmaxf(fabsf(v[i][2]), fabsf(v[i][3]))));
    am = fmaxf(wave_max(am), 1e-30f);
    const float inv = 127.0f / am;
    if (lane == 0) *scl = am * (1.0f / 127.0f);
#pragma unroll
    for (int i = 0; i < 2; ++i) {
        u32x4 w;
#pragma unroll
        for (int q = 0; q < 4; ++q) {
            const f32x4 t = v[i * 4 + q];
            const unsigned b0 = (unsigned)(int)(rintf(t[0] * inv) + 128.0f), b1 = (unsigned)(int)(rintf(t[1] * inv) + 128.0f), b2 = (unsigned)(int)(rintf(t[2] * inv) + 128.0f), b3 = (unsigned)(int)(rintf(t[3] * inv) + 128.0f);
            w[q] = b0 | (b1 << 8) | (b2 << 16) | (b3 << 24);
        }
        *(u32x4*)(dst + 1024 * i + 16 * lane) = w;
    }
}
struct QuantJob { const float* TU; const float* TV; unsigned char* QU; unsigned char* QV; float* SU; float* SV; };
__device__ __forceinline__ const float* qj_src(const QuantJob& q, int r) { return (r < 16384 ? q.TU : q.TV) + (size_t)(r & 16383) * DM; }
__device__ __forceinline__ unsigned char* qj_dst(const QuantJob& q, int r) { return (r < 16384 ? q.QU : q.QV) + (size_t)(r & 16383) * DM; }
__device__ __forceinline__ float* qj_scl(const QuantJob& q, int r) { return (r < 16384 ? q.SU : q.SV) + (r & 16383); }
__device__ __forceinline__ void qj_tail(const QuantJob& q, int done_iters) {
    const int lane = threadIdx.x & 63, gw = blockIdx.x * 8 + (threadIdx.x >> 6), nw = gridDim.x * 8;
    for (int r = gw + done_iters * nw; r < 32768; r += nw) { f32x4 v[8]; qrow_issue(v, qj_src(q, r), lane); qrow_finish(v, qj_dst(q, r), qj_scl(q, r), lane); }
}
__device__ __forceinline__ float logf_gate(float z, float lb) { return __logf(lb + (1.0f - lb) * sigmoidf_(z)); }
__device__ __forceinline__ void phase_scan_a(LAS unsigned char* lds, const bf16_t* FZ, const float* LB, const bf16_t* I1, bf16_t* LT, float* DEC, const QuantJob qj, unsigned* dbgc = nullptr) {
    unsigned dbg_kt = 0, dbg_acc = 0;
    const int tid = threadIdx.x, lane = tid & 63, wv = tid >> 6, k = tid & 127, part = tid >> 7;
    LAS unsigned char* Iimg = lds; LAS unsigned char* KTimg = lds + 16384;
    LAS float* psum = (LAS float*)(lds + 32768);
    LAS unsigned char* Lst = lds + 36864;
#if SCAN_A_VALU == 2
    for (int item = blockIdx.x; item < 2 * NHEAD * 128; item += gridDim.x) {
        const int bh = item >> 7, c = item & 127, b = bh >> 4, h = bh & 15;
        const size_t tok0 = (size_t)b * SEQ + c * 64;
        for (int idx = tid; idx < 16384; idx += 512) {
            const int v = idx >> 7, kk = idx & 127;
            float g = 1.f, L = 0.f;
            for (int s2 = 63; s2 >= 0; --s2) { const size_t o = (tok0 + s2) * DM + h * 128; const float f = __expf(logf_gate(bf2f(FZ[o + kk]), LB[h * 128 + kk])); L += bf2f(I1[o + v]) * (1.0f - f) * g; g *= f; }
            LT[(size_t)item * 16384 + idx] = (bf16_t)(pk_bf16(L, 0.f) & 0xffffu);
        }
    }
    return;
#endif
    bf16_t nfz[16]; u32x4 nit_[2];
#define SA_LOAD(item_) { const int bh_ = (item_) >> 7, c_ = (item_) & 127; const size_t t0_ = (size_t)(bh_ >> 4) * SEQ + c_ * 64; const int h_ = bh_ & 15; \
        _Pragma("unroll") for (int i = 0; i < 16; ++i) nfz[i] = FZ[(t0_ + 16 * part + i) * DM + h_ * 128 + k]; \
        _Pragma("unroll") for (int r = 0; r < 2; ++r) { const int idx = tid + 512 * r, row = idx >> 4, ch = idx & 15; nit_[r] = *(const u32x4*)(I1 + (t0_ + row) * DM + h_ * 128 + ch * 8); } }
    if ((int)blockIdx.x < 2 * NHEAD * 128) SA_LOAD((int)blockIdx.x)
    int qiter = 0;
    for (int item = blockIdx.x; item < 2 * NHEAD * 128; item += gridDim.x, ++qiter) {
        const int bh = item >> 7, c = item & 127, b = bh >> 4, h = bh & 15;
        const size_t tok0 = (size_t)b * SEQ + c * 64;
        float lf[16];
        const float lbk = LB[h * 128 + k];
#pragma unroll
        for (int i = 0; i < 16; ++i) lf[i] = logf_gate(bf2f(nfz[i]), lbk);
#pragma unroll
        for (int r = 0; r < 2; ++r) { const int idx = tid + 512 * r, row = idx >> 4, ch = idx & 15; *(LAS u32x4*)(Iimg + off_b(row, ch)) = nit_[r]; }
        if (item + (int)gridDim.x < 2 * NHEAD * 128) SA_LOAD(item + (int)gridDim.x)
        const int qrow = qiter * (int)gridDim.x * 8 + (int)blockIdx.x * 8 + wv; const bool doq = qrow < 32768; f32x4 qv8[8];
        if (doq) qrow_issue(qv8, qj_src(qj, qrow), lane);
        float cs = 0.f;
#pragma unroll
        for (int i = 0; i < 16; ++i) cs += lf[i];
        psum[part * 128 + k] = cs;
        __syncthreads();
        const float p0 = psum[k], p1 = psum[128 + k], p2 = psum[256 + k], p3 = psum[384 + k];
        const float blast = (p0 + p1) + (p2 + p3);
        float bb = part == 0 ? 0.f : (part == 1 ? p0 : (part == 2 ? p0 + p1 : p0 + p1 + p2));
#pragma unroll
        for (int i = 0; i < 16; ++i) {
            bb += lf[i];
            const float kt = (1.0f - __expf(lf[i])) * __expf(blast - bb);
            if (!(kt - kt == 0.f)) ++dbg_kt;
            const int srow = 16 * part + i;
            *(LAS bf16_t*)(KTimg + off_b(srow, k >> 3) + 2 * (k & 7)) = (bf16_t)(pk_bf16(kt, 0.f) & 0xffffu);
        }
        if (part == 0) DEC[(size_t)item * 128 + k] = __expf(blast);
        __syncthreads();
#if SCAN_A_VALU
        for (int idx = tid; idx < 16384; idx += 512) {
            const int v = idx >> 7, kk = idx & 127;
            float accv = 0.f;
            for (int s2 = 0; s2 < 64; ++s2) accv += bf2f(*(const LAS bf16_t*)(Iimg + off_b(s2, v >> 3) + 2 * (v & 7))) * bf2f(*(const LAS bf16_t*)(KTimg + off_b(s2, kk >> 3) + 2 * (kk & 7)));
            *(LAS bf16_t*)(Lst + v * 272 + 2 * kk) = (bf16_t)(pk_bf16(accv, 0.f) & 0xffffu);
        }
        if (0)
#endif
        {
            const int vt = wv >> 1;
            f32x16 acc0, acc1;
#pragma unroll
            for (int e = 0; e < 16; ++e) { acc0[e] = 0.f; acc1[e] = 0.f; }
#pragma unroll
            for (int ks = 0; ks < 4; ++ks) {
                const bf16x8 af = tr_frag(Iimg, lane, vt, ks);
                const bf16x8 b0 = tr_frag(KTimg, lane, 2 * (wv & 1), ks), b1 = tr_frag(KTimg, lane, 2 * (wv & 1) + 1, ks);
                acc0 = __builtin_amdgcn_mfma_f32_32x32x16_bf16(af, b0, acc0, 0, 0, 0);
                acc1 = __builtin_amdgcn_mfma_f32_32x32x16_bf16(af, b1, acc1, 0, 0, 0);
            }
            const int r32 = lane & 31, hh = lane >> 5;
#pragma unroll
            for (int e = 0; e < 16; ++e) {
                if (!(acc0[e] - acc0[e] == 0.f)) ++dbg_acc; if (!(acc1[e] - acc1[e] == 0.f)) ++dbg_acc;
                const int v = 32 * vt + (e & 3) + 8 * (e >> 2) + 4 * hh;
                *(LAS bf16_t*)(Lst + v * 272 + 2 * (64 * (wv & 1) + r32)) = (bf16_t)(pk_bf16(acc0[e], 0.f) & 0xffffu);
                *(LAS bf16_t*)(Lst + v * 272 + 2 * (64 * (wv & 1) + 32 + r32)) = (bf16_t)(pk_bf16(acc1[e], 0.f) & 0xffffu);
            }
        }
        __syncthreads();
#pragma unroll
        for (int r = 0; r < 4; ++r) { const int idx = tid + 512 * r, row = idx >> 4, ch = idx & 15; *(u32x4*)(LT + (size_t)item * 16384 + row * 128 + ch * 8) = *(const LAS u32x4*)(Lst + row * 272 + ch * 16); }
        if (doq) qrow_finish(qv8, qj_dst(qj, qrow), qj_scl(qj, qrow), lane);
        __syncthreads();
    }
    qj_tail(qj, qiter);
    if (dbgc) { if (dbg_kt) atomicAdd(dbgc + 0, dbg_kt); if (dbg_acc) atomicAdd(dbgc + 1, dbg_acc); }
}
__device__ __forceinline__ void phase_scan_b(bf16_t* LT, const float* DEC, const QuantJob qj) {
    const int n = 2 * NHEAD * 128 * 32;
    const int lane = threadIdx.x & 63, gw = blockIdx.x * 8 + (threadIdx.x >> 6), nw = gridDim.x * 8;
    int qdone = 0;
    for (int idx = blockIdx.x * 512 + threadIdx.x; idx < n; idx += gridDim.x * 512) {
        const int bh = idx >> 12, vk = idx & 4095, k4 = (vk & 31) * 4;
        float S0 = 0.f, S1 = 0.f, S2 = 0.f, S3 = 0.f;
        bf16_t* p = LT + (size_t)bh * 128 * 16384 + (size_t)vk * 4;
        const float* dp = DEC + (size_t)bh * 128 * 128 + k4;
        for (int c8 = 0; c8 < 16; ++c8) {
            const int qrow = (qdone + c8) * nw + gw; const bool doq = qrow < 32768; f32x4 qv8[8];
            if (doq) qrow_issue(qv8, qj_src(qj, qrow), lane);
#pragma unroll
            for (int c2 = 0; c2 < 8; ++c2) {
                const int c = c8 * 8 + c2;
                const u32x2 w = *(const u32x2*)(p + (size_t)c * 16384);
                const f32x4 d = *(const f32x4*)(dp + c * 128);
                u32x2 o; o.x = pk_bf16(S0, S1); o.y = pk_bf16(S2, S3);
                *(u32x2*)(p + (size_t)c * 16384) = o;
                S0 = d[0] * S0 + bflo(w.x); S1 = d[1] * S1 + bfhi(w.x); S2 = d[2] * S2 + bflo(w.y); S3 = d[3] * S3 + bfhi(w.y);
            }
            if (doq) qrow_finish(qv8, qj_dst(qj, qrow), qj_scl(qj, qrow), lane);
        }
        qdone += 16;
    }
    qj_tail(qj, qdone);
}
__device__ __forceinline__ void phase_scan_c(LAS unsigned char* lds, const bf16_t* Q1, const bf16_t* FZ, const float* LB, const bf16_t* I1, const bf16_t* G1, const bf16_t* SP, const float* gnorm, bf16_t* OG) {
    const int tid = threadIdx.x, lane = tid & 63, wv = tid >> 6, k = tid & 127, part = tid >> 7, r32 = lane & 31, hh = lane >> 5;
    LAS unsigned char* QTimg = lds; LAS unsigned char* QPimg = lds + 16384; LAS unsigned char* KPimg = lds + 32768; LAS unsigned char* Iimg = lds + 49152; LAS unsigned char* SPimg = lds + 65536;
    LAS float* psum = (LAS float*)(lds + 98304);
    LAS float* ssq = (LAS float*)(lds + 100352);
    LAS unsigned char* OT = lds + 102400;
    bf16_t nfz[16], nq[16]; u32x4 nit_[2], nsp[4], ngt[2];
#define SC_LOAD(item_) { const int bh_ = (item_) >> 7, c_ = (item_) & 127; const size_t t0_ = (size_t)(bh_ >> 4) * SEQ + c_ * 64; const int h_ = bh_ & 15; \
        _Pragma("unroll") for (int i = 0; i < 16; ++i) { const size_t o_ = (t0_ + 16 * part + i) * DM + h_ * 128 + k; nfz[i] = FZ[o_]; nq[i] = Q1[o_]; } \
        _Pragma("unroll") for (int r = 0; r < 2; ++r) { const int idx = tid + 512 * r, row = idx >> 4, ch = idx & 15; nit_[r] = *(const u32x4*)(I1 + (t0_ + row) * DM + h_ * 128 + ch * 8); ngt[r] = *(const u32x4*)(G1 + (t0_ + row) * DM + h_ * 128 + ch * 8); } \
        _Pragma("unroll") for (int r = 0; r < 4; ++r) { const int idx = tid + 512 * r, row = idx >> 4, ch = idx & 15; nsp[r] = *(const u32x4*)(SP + (size_t)(item_) * 16384 + row * 128 + ch * 8); } }
    if ((int)blockIdx.x < 2 * NHEAD * 128) SC_LOAD((int)blockIdx.x)
    for (int item = blockIdx.x; item < 2 * NHEAD * 128; item += gridDim.x) {
        const int bh = item >> 7, c = item & 127, b = bh >> 4, h = bh & 15;
        const size_t tok0 = (size_t)b * SEQ + c * 64;
        float lf[16], qv[16];
        const float lbk = LB[h * 128 + k];
#pragma unroll
        for (int i = 0; i < 16; ++i) { lf[i] = logf_gate(bf2f(nfz[i]), lbk); const float qr = bf2f(nq[i]); qv[i] = qr * sigmoidf_(qr); }
#pragma unroll
        for (int r = 0; r < 2; ++r) { const int idx = tid + 512 * r, row = idx >> 4, ch = idx & 15; *(LAS u32x4*)(Iimg + off_b(row, ch)) = nit_[r]; }
#pragma unroll
        for (int r = 0; r < 4; ++r) { const int idx = tid + 512 * r, row = idx >> 4, ch = idx & 15; *(LAS u32x4*)(SPimg + off_b(row, ch)) = nsp[r]; }
        const u32x4 gcur0 = ngt[0], gcur1 = ngt[1];
        if (item + (int)gridDim.x < 2 * NHEAD * 128) SC_LOAD(item + (int)gridDim.x)
        float cs = 0.f;
#pragma unroll
        for (int i = 0; i < 16; ++i) cs += lf[i];
        psum[part * 128 + k] = cs;
        __syncthreads();
        const float p0 = psum[k], p1 = psum[128 + k], p2 = psum[256 + k];
        const float rr = p0 + p1;
        float bb = part == 0 ? 0.f : (part == 1 ? p0 : (part == 2 ? p0 + p1 : p0 + p1 + p2));
#pragma unroll
        for (int i = 0; i < 16; ++i) {
            bb += lf[i];
            const float qt = qv[i] * __expf(bb), qp = qv[i] * __expf(bb - rr), kp = (1.0f - __expf(lf[i])) * __expf(rr - bb);
            const unsigned o = off_b(16 * part + i, k >> 3) + 2 * (k & 7);
            *(LAS bf16_t*)(QTimg + o) = (bf16_t)(pk_bf16(qt, 0.f) & 0xffffu);
            *(LAS bf16_t*)(QPimg + o) = (bf16_t)(pk_bf16(qp, 0.f) & 0xffffu);
            *(LAS bf16_t*)(KPimg + o) = (bf16_t)(pk_bf16(kp, 0.f) & 0xffffu);
        }
        __syncthreads();
        const int tt = wv & 1, vt = wv >> 1;
        f32x16 O;
#pragma unroll
        for (int e = 0; e < 16; ++e) O[e] = 0.f;
#pragma unroll
        for (int ks = 0; ks < 8; ++ks) {
            const bf16x8 af = *(const LAS bf16x8*)(SPimg + off_b(32 * vt + r32, 2 * ks + hh));
            const bf16x8 bf = *(const LAS bf16x8*)(QTimg + off_b(32 * tt + r32, 2 * ks + hh));
            O = __builtin_amdgcn_mfma_f32_32x32x16_bf16(af, bf, O, 0, 0, 0);
        }
        const unsigned krow = pi32((unsigned)r32);
        for (int st = 0; st <= tt; ++st) {
            f32x16 S;
#pragma unroll
            for (int e = 0; e < 16; ++e) S[e] = 0.f;
#pragma unroll
            for (int ks = 0; ks < 8; ++ks) {
                const bf16x8 af = *(const LAS bf16x8*)(KPimg + off_b(32 * st + krow, 2 * ks + hh));
                const bf16x8 bf = *(const LAS bf16x8*)(QPimg + off_b(32 * tt + r32, 2 * ks + hh));
                S = __builtin_amdgcn_mfma_f32_32x32x16_bf16(af, bf, S, 0, 0, 0);
            }
            float p[16];
#pragma unroll
            for (int e = 0; e < 16; ++e) {
                const unsigned m = (e & 3) + 8 * (e >> 2) + 4 * hh;
                const int sidx = 32 * st + (int)pi32(m), tidx = 32 * tt + r32;
                p[e] = sidx <= tidx ? S[e] : 0.f;
            }
            u32x4 w0, w1;
            w0.x = pk_bf16(p[0], p[1]); w0.y = pk_bf16(p[2], p[3]); w0.z = pk_bf16(p[4], p[5]); w0.w = pk_bf16(p[6], p[7]);
            w1.x = pk_bf16(p[8], p[9]); w1.y = pk_bf16(p[10], p[11]); w1.z = pk_bf16(p[12], p[13]); w1.w = pk_bf16(p[14], p[15]);
            const bf16x8 pf0 = __builtin_bit_cast(bf16x8, w0), pf1 = __builtin_bit_cast(bf16x8, w1);
            const bf16x8 i0 = tr_frag(Iimg, lane, vt, 2 * st), i1 = tr_frag(Iimg, lane, vt, 2 * st + 1);
            O = __builtin_amdgcn_mfma_f32_32x32x16_bf16(i0, pf0, O, 0, 0, 0);
            O = __builtin_amdgcn_mfma_f32_32x32x16_bf16(i1, pf1, O, 0, 0, 0);
        }
        float sq = 0.f;
#pragma unroll
        for (int e = 0; e < 16; ++e) sq += O[e] * O[e];
        sq += __shfl_xor(sq, 32);
        if (hh == 0) ssq[vt * 64 + 32 * tt + r32] = sq;
        __syncthreads();
        const int tl = 32 * tt + r32;
        const float rstd = rsqrtf((ssq[tl] + ssq[64 + tl] + ssq[128 + tl] + ssq[192 + tl]) * (1.0f / 128.0f) + 1e-6f);
#pragma unroll
        for (int g = 0; g < 4; ++g) {
            const int v0 = 32 * vt + 8 * g + 4 * hh;
            const f32x4 gn = *(const f32x4*)(gnorm + v0);
            u32x2 w; w.x = pk_bf16(O[4 * g] * rstd * gn[0], O[4 * g + 1] * rstd * gn[1]); w.y = pk_bf16(O[4 * g + 2] * rstd * gn[2], O[4 * g + 3] * rstd * gn[3]);
            *(LAS u32x2*)(OT + tl * 272 + v0 * 2) = w;
        }
        __syncthreads();
#pragma unroll
        for (int r = 0; r < 2; ++r) {
            const int idx = tid + 512 * r, row = idx >> 4, ch = idx & 15;
            const u32x4 ov = *(const LAS u32x4*)(OT + row * 272 + ch * 16);
            const size_t go = (tok0 + row) * DM + h * 128 + ch * 8;
            const u32x4 gv = r == 0 ? gcur0 : gcur1;
            u32x4 w;
#define SILU_(x_) ((x_) * sigmoidf_(x_))
            w.x = pk_bf16(bflo(ov.x) * SILU_(bflo(gv.x)), bfhi(ov.x) * SILU_(bfhi(gv.x))); w.y = pk_bf16(bflo(ov.y) * SILU_(bflo(gv.y)), bfhi(ov.y) * SILU_(bfhi(gv.y)));
            w.z = pk_bf16(bflo(ov.z) * SILU_(bflo(gv.z)), bfhi(ov.z) * SILU_(bfhi(gv.z))); w.w = pk_bf16(bflo(ov.w) * SILU_(bflo(gv.w)), bfhi(ov.w) * SILU_(bfhi(gv.w)));
#undef SILU_
            *(u32x4*)(OG + go) = w;
        }
        __syncthreads();
    }
}


#if SCAN_DBG == 2
__device__ __forceinline__ void dbg_compare(LAS float* red, const bf16_t* A, const bf16_t* B, float* DBG) {
    float sd = 0.f, sr = 0.f, nn = 0.f;
    const size_t n = (size_t)MTOK * DM;
    for (size_t i = (size_t)blockIdx.x * 512 + threadIdx.x; i < n; i += (size_t)gridDim.x * 512) {
        const float x = bf2f(A[i]), y = bf2f(B[i]);
        if (!(x - x == 0.f)) nn += 1.f; else { sd += (x - y) * (x - y); sr += y * y; }
    }
    sd = wave_sum(sd); sr = wave_sum(sr); nn = wave_sum(nn);
    const int wv = threadIdx.x >> 6;
    if ((threadIdx.x & 63) == 0) { red[wv * 3] = sd; red[wv * 3 + 1] = sr; red[wv * 3 + 2] = nn; }
    __syncthreads();
    if (threadIdx.x == 0) { float a = 0, b = 0, c = 0; for (int w = 0; w < 8; ++w) { a += red[w * 3]; b += red[w * 3 + 1]; c += red[w * 3 + 2]; } DBG[blockIdx.x * 4] = a; DBG[blockIdx.x * 4 + 1] = b; DBG[blockIdx.x * 4 + 2] = c; }
    __syncthreads();
}
__device__ __forceinline__ void dbg_emit(const float* DBG, float* out) {
    float a = 0, b = 0, c = 0;
    for (int w = 0; w < (int)gridDim.x; ++w) { a += DBG[w * 4]; b += DBG[w * 4 + 1]; c += DBG[w * 4 + 2]; }
    const float rel = sqrtf(a / b);
    int k = (int)rintf(-2.0f * log10f(rel)); k = k < 0 ? 0 : (k > 16 ? 16 : k);
    if (c > 0.f) k = 17;
    const float cc = sqrtf(0.5f * (float)k);
    const size_t n = (size_t)MTOK * DM;
    for (size_t i = (size_t)blockIdx.x * 512 + threadIdx.x; i < n; i += (size_t)gridDim.x * 512) out[i] = cc;
}
#endif

#if SCAN_DBG == 3
__device__ __forceinline__ void dbg_count_bf16(const bf16_t* A, size_t n, unsigned* cnt) {
    unsigned c = 0;
    for (size_t i = (size_t)blockIdx.x * 512 + threadIdx.x; i < n; i += (size_t)gridDim.x * 512) { const float x = bf2f(A[i]); if (!(x - x == 0.f)) ++c; }
    if (c) atomicAdd(cnt, c);
}
__device__ __forceinline__ void dbg_count_f32(const float* A, size_t n, unsigned* cnt) {
    unsigned c = 0;
    for (size_t i = (size_t)blockIdx.x * 512 + threadIdx.x; i < n; i += (size_t)gridDim.x * 512) { const float x = A[i]; if (!(x - x == 0.f)) ++c; }
    if (c) atomicAdd(cnt, c);
}
__device__ __forceinline__ void dbg_emit3(const unsigned* cnt, float* out) {
    float code = 0.f;
    for (int st = 3; st >= 0; --st) { const unsigned c = cnt[st]; if (c) { float lg = log10f((float)c); lg = lg > 9.f ? 9.f : lg; code = (float)(st + 1) + 0.1f * lg; } }
    const float cc = sqrtf(code);
    const size_t n = (size_t)MTOK * DM;
    for (size_t i = (size_t)blockIdx.x * 512 + threadIdx.x; i < n; i += (size_t)gridDim.x * 512) out[i] = cc;
}
#endif

#if SCAN_DBG == 4 || SCAN_DBG == 6
__device__ __forceinline__ void dbg_compare4(LAS float* red, const bf16_t* A, const bf16_t* B, const bf16_t* C, float* DBG) {
    float sd = 0.f, sr = 0.f, nn = 0.f, mm = 0.f;
    const size_t n = (size_t)MTOK * DM;
    for (size_t i = (size_t)blockIdx.x * 512 + threadIdx.x; i < n; i += (size_t)gridDim.x * 512) {
        const float x = bf2f(A[i]), y = bf2f(B[i]);
        if (!(x - x == 0.f)) nn += 1.f; else { sd += (x - y) * (x - y); sr += y * y; }
        if (A[i] != C[i]) mm += 1.f;
    }
    sd = wave_sum(sd); sr = wave_sum(sr); nn = wave_sum(nn); mm = wave_sum(mm);
    const int wv = threadIdx.x >> 6;
    if ((threadIdx.x & 63) == 0) { red[wv * 4] = sd; red[wv * 4 + 1] = sr; red[wv * 4 + 2] = nn; red[wv * 4 + 3] = mm; }
    __syncthreads();
    if (threadIdx.x == 0) { float a = 0, b = 0, c = 0, d = 0; for (int w = 0; w < 8; ++w) { a += red[w * 4]; b += red[w * 4 + 1]; c += red[w * 4 + 2]; d += red[w * 4 + 3]; }
        DBG[blockIdx.x * 4] = a; DBG[blockIdx.x * 4 + 1] = b; DBG[blockIdx.x * 4 + 2] = c; DBG[blockIdx.x * 4 + 3] = d; }
    __syncthreads();
}
__device__ __forceinline__ void dbg_emit4(const float* DBG, float* out) {
    float a = 0, b = 0, c = 0, d = 0;
    for (int w = 0; w < (int)gridDim.x; ++w) { a += DBG[w * 4]; b += DBG[w * 4 + 1]; c += DBG[w * 4 + 2]; d += DBG[w * 4 + 3]; }
    const float rel = sqrtf(a / b);
    int k = (int)rintf(-log10f(rel)); k = k < 0 ? 0 : (k > 8 ? 8 : k);
#if SCAN_DBG == 6
    const float cc = sqrtf((float)k + ((d + c) > 0.f ? 0.5f : 0.f));
#else
    int m = (int)ceilf(log10f(1.0f + d + c)); m = m > 9 ? 9 : m;
    const float cc = sqrtf((float)k + 0.1f * (float)m);
#endif
    const size_t n = (size_t)MTOK * DM;
    for (size_t i = (size_t)blockIdx.x * 512 + threadIdx.x; i < n; i += (size_t)gridDim.x * 512) out[i] = cc;
}
#endif

#if SCAN_DBG == 5
__device__ __forceinline__ void dbg_lds16_test(LAS unsigned char* lds, unsigned* cnt) {
    const int tid = threadIdx.x;
    unsigned bad = 0;
    for (int rep = 0; rep < 64; ++rep) {
        for (int i = tid; i < 1024; i += 512) *(LAS u32x4*)(lds + i * 16) = (u32x4){0x7fc07fc0u, 0x7fc07fc0u, 0x7fc07fc0u, 0x7fc07fc0u};
        __syncthreads();
        const int k = tid & 127, part = tid >> 7;
#pragma unroll
        for (int i = 0; i < 16; ++i) {
            const int row = 16 * part + i;
            *(LAS bf16_t*)(lds + off_b(row, k >> 3) + 2 * (k & 7)) = (bf16_t)((row * 128 + k + rep) & 0x7fff);
        }
        __syncthreads();
        for (int idx = tid; idx < 64 * 128; idx += 512) {
            const int row = idx >> 7, kk = idx & 127;
            const bf16_t got = *(const LAS bf16_t*)(lds + off_b(row, kk >> 3) + 2 * (kk & 7));
            if (got != (bf16_t)((row * 128 + kk + rep) & 0x7fff)) ++bad;
        }
        __syncthreads();
    }
    if (bad) atomicAdd(cnt, bad);
}
__device__ __forceinline__ void dbg_emit5(const unsigned* cnt, float* out) {
    const unsigned c = cnt[0];
    float code = 0.f;
    if (c) { float lg = log10f((float)c); code = 1.0f + (lg > 8.9f ? 8.9f : lg); }
    const float cc = sqrtf(code);
    const size_t n = (size_t)MTOK * DM;
    for (size_t i = (size_t)blockIdx.x * 512 + threadIdx.x; i < n; i += (size_t)gridDim.x * 512) out[i] = cc;
}
#endif

#if SCAN_DBG == 6
__device__ __forceinline__ void dbg_check_a(LAS float* red, const float* LF, const bf16_t* I1, const bf16_t* LT, const bf16_t* LT2, float* DBG) {
    float sd = 0.f, sr = 0.f, mm = 0.f;
    const size_t n = (size_t)4096 * 16384;
    for (size_t i = (size_t)blockIdx.x * 512 + threadIdx.x; i < n; i += (size_t)gridDim.x * 512) {
        const int item = (int)(i >> 14), v = (int)((i >> 7) & 127), k = (int)(i & 127);
        const int bh = item >> 7, c = item & 127, b = bh >> 4, h = bh & 15;
        const size_t tok0 = (size_t)b * SEQ + c * 64;
        float g = 1.f, L = 0.f;
        for (int s2 = 63; s2 >= 0; --s2) {
            const size_t o = (tok0 + s2) * DM + h * 128;
            const float f = __expf(LF[o + k]);
            L += bf2f(I1[o + v]) * (1.0f - f) * g;
            g *= f;
        }
        const float x = bf2f(LT[i]);
        sd += (x - L) * (x - L); sr += L * L;
        if (LT[i] != LT2[i]) mm += 1.f;
    }
    sd = wave_sum(sd); sr = wave_sum(sr); mm = wave_sum(mm);
    const int wv = threadIdx.x >> 6;
    if ((threadIdx.x & 63) == 0) { red[wv * 4] = sd; red[wv * 4 + 1] = sr; red[wv * 4 + 2] = 0.f; red[wv * 4 + 3] = mm; }
    __syncthreads();
    if (threadIdx.x == 0) { float a = 0, b2 = 0, d = 0; for (int w = 0; w < 8; ++w) { a += red[w * 4]; b2 += red[w * 4 + 1]; d += red[w * 4 + 3]; }
        DBG[blockIdx.x * 4] = a; DBG[blockIdx.x * 4 + 1] = b2; DBG[blockIdx.x * 4 + 2] = 0.f; DBG[blockIdx.x * 4 + 3] = d; }
    __syncthreads();
}
#endif

#if SCAN_DBG == 7
#ifndef DBG_FAM
#define DBG_FAM 0
#endif
__device__ __forceinline__ void dbg_check_a7(const float* LF, const bf16_t* I1, const bf16_t* LT, float* DBG) {
    const size_t n = (size_t)4096 * 16384;
    float nbad = 0.f, nnf = 0.f;
    for (size_t i = (size_t)blockIdx.x * 512 + threadIdx.x; i < n; i += (size_t)gridDim.x * 512 * 8) {
        const int item = (int)(i >> 14), v = (int)((i >> 7) & 127), k = (int)(i & 127);
        const int bh = item >> 7, c = item & 127, b = bh >> 4, h = bh & 15;
        const size_t tok0 = (size_t)b * SEQ + c * 64;
        float g = 1.f, L = 0.f;
        for (int s2 = 63; s2 >= 0; --s2) {
            const size_t o = (tok0 + s2) * DM + h * 128;
            const float f = __expf(LF[o + k]);
            L += bf2f(I1[o + v]) * (1.0f - f) * g;
            g *= f;
        }
        const float x = bf2f(LT[i]);
        if (!(x - x == 0.f)) { nnf += 1.f; nbad += 1.f; }
        else if (fabsf(x - L) > 0.02f * fabsf(L) + 1e-2f) nbad += 1.f;
    }
    nbad = wave_sum(nbad); nnf = wave_sum(nnf);
    if ((threadIdx.x & 63) == 0) { atomicAdd(DBG, nbad); atomicAdd(DBG + 1, nnf); }
}
__device__ __forceinline__ void dbg_emit7(const float* DBG, float* out) {
    const float nb = DBG[0], nf = DBG[1];
    int A = nb == 0.f ? 0 : (nb <= 100.f ? 1 : (nb <= 1e4f ? 3 : (nb <= 1e6f ? 5 : 7)));
    int B = nf == 0.f ? 0 : 5;
    const float cc = sqrtf((float)A + 0.1f * (float)B);
    const size_t n = (size_t)MTOK * DM;
    for (size_t i = (size_t)blockIdx.x * 512 + threadIdx.x; i < n; i += (size_t)gridDim.x * 512) out[i] = cc;
}
#endif
__device__ __forceinline__ int opaque(int v) { asm volatile("" : "+s"(v)); return v; }
template <bool L1> __device__ __forceinline__ void run_gemm_out(const Args& a, LAS unsigned char* lds) {
    unsigned char* ws = a.ws;
    pg8::Gemm g{(const bf16_t*)(ws + (L1 ? slot(3) : slot(0))), (const bf16_t*)(ws + (L1 ? WS_WO : WS_WOUT)), opaque(MTOK), opaque(DM), opaque(DM)};
    pg8::StaticOrder S; S.init(g.M, g.N, (int)gridDim.x, (int)blockIdx.x);
    EpiKVQ E{(bf16_t*)(ws + (L1 ? slot(4) : slot(1))), nullptr, nullptr};
    pg8::gemm_phase<EpiKVQ, pg8::StaticOrder>(lds, g, S, E, nullptr);
}
template <bool L1> __device__ __forceinline__ void run_ln(const Args& a) {
    unsigned char* ws = a.ws;
    phase_ln<L1>((const bf16_t*)(ws + (L1 ? slot(4) : slot(1))), L1 ? (const void*)(ws + slot(2)) : (const void*)a.in[0], a.in[12] + (L1 ? 2 : 0) * DM, a.in[13] + (L1 ? 2 : 0) * DM,
                 (float*)nullptr, (bf16_t*)(ws + (L1 ? slot(8) : slot(5))), (signed char*)(ws + WS_XQ), (float*)(ws + WS_XS));
}
template <bool L1> __device__ __forceinline__ void run_gemm_sc(const Args& a, LAS unsigned char* lds) {
    unsigned char* ws = a.ws;
    pg8::Gemm g{(const bf16_t*)(ws + WS_WC) + (L1 ? (size_t)DM * DM : 0), (const bf16_t*)(ws + (L1 ? slot(8) : slot(5))), opaque(DM), opaque(MTOK), opaque(DM)};
    pg8::StaticOrder S; S.init(g.M, g.N, (int)gridDim.x, (int)blockIdx.x);
    EpiF32 E{(float*)(ws + (L1 ? slot(0) : slot(6))), MTOK};
    pg8::gemm_phase<EpiF32, pg8::StaticOrder>(lds, g, S, E, nullptr);
}
template <bool L1> __device__ __forceinline__ void run_topk(const Args& a, LAS unsigned char* lds) {
    unsigned char* ws = a.ws;
    phase_topk(lds, (const float*)(ws + (L1 ? slot(0) : slot(6))), (int*)(ws + WS_EID), (float*)(ws + WS_GATE));
}
template <bool L1> __device__ __forceinline__ void run_peer(const Args& a, LAS unsigned char* lds) {
    unsigned char* ws = a.ws;
    LAS int* HL = (LAS int*)(lds + (threadIdx.x >> 6) * 8192);
    float* Y = (float*)(ws + (L1 ? slot(0) : slot(6)));
    phase_peer_u((const signed char*)(ws + WS_XQ), (const int*)(ws + WS_EID), ws + WS_UB + (L1 ? (size_t)16384 * DM : 0), HL);
    asm volatile("s_waitcnt vmcnt(0) lgkmcnt(0)" ::: "memory");
    phase_peer_w(HL, (const float*)(ws + WS_XS), (const int*)(ws + WS_EID), (const float*)(ws + WS_GATE),
                 (const float*)(ws + WS_USC) + (L1 ? 16384 : 0), (const float*)(ws + WS_VSC) + (L1 ? 16384 : 0), (float*)(ws + WS_W), (float*)(ws + WS_CS));
    asm volatile("s_waitcnt vmcnt(0)" ::: "memory");
    phase_peer_v((const bf16_t*)(ws + (L1 ? slot(8) : slot(5))), (const int*)(ws + WS_EID), (const float*)(ws + WS_W), (const float*)(ws + WS_CS),
                 ws + WS_VB + (L1 ? (size_t)16384 * DM : 0), Y);
    asm volatile("s_waitcnt vmcnt(0)" ::: "memory");
    {
        const int lane = threadIdx.x & 63, gw = blockIdx.x * 8 + (threadIdx.x >> 6), nw = gridDim.x * 8, tpw = (MTOK + nw - 1) / nw, tbase = gw * tpw;
        const int tend = tbase + tpw < MTOK ? tbase + tpw : MTOK;
        const float* g = a.in[12] + (L1 ? 3 : 1) * DM; const float* bta = a.in[13] + (L1 ? 3 : 1) * DM;
        float* outf = L1 ? a.out : (float*)nullptr; bf16_t* outb = L1 ? (bf16_t*)nullptr : (bf16_t*)(ws + slot(2));
        for (int row = tbase; row < tend; ++row) {
            float v[32];
            const float* p = Y + (size_t)row * DM;
#pragma unroll
            for (int i = 0; i < 4; ++i) {
                const f32x4 x0 = *(const f32x4*)(p + 512 * i + 8 * lane), x1 = *(const f32x4*)(p + 512 * i + 8 * lane + 4);
#pragma unroll
                for (int j = 0; j < 4; ++j) { v[i * 8 + j] = x0[j]; v[i * 8 + 4 + j] = x1[j]; }
            }
            ln_row_store(v, g, bta, outf ? outf + (size_t)row * DM : nullptr, outb ? outb + (size_t)row * DM : nullptr, lane);
        }
    }
}


#define XB_TMO      128
#define XB_XCNT(j)  (256  + 64 * (j))
#define XB_XSUB(j)  (1280 + 64 * (j))
#define XB_XGEN(j)  (2304 + 64 * (j))
#define XB_TOP      3328
#define XB_TOPGEN   3392
#define XCD_BAR_WORDS 3456
#define XB_SPIN_CAP (1u << 20)
__device__ __forceinline__ unsigned xb_ld(unsigned* p)              { return __hip_atomic_load(p, __ATOMIC_RELAXED, __HIP_MEMORY_SCOPE_AGENT); }
__device__ __forceinline__ unsigned xb_add(unsigned* p, unsigned v) { return __hip_atomic_fetch_add(p, v, __ATOMIC_RELAXED, __HIP_MEMORY_SCOPE_AGENT); }
__device__ __forceinline__ unsigned xb_xcc_id() { return (unsigned)__builtin_amdgcn_s_getreg((3 << 11) | 20) & 0xFu; }
#define XB_SPIN(cond, bar) do { unsigned _sp = 0; while (cond) { __builtin_amdgcn_s_sleep(1); \
    if ((++_sp & 255u) == 0u) { if (xb_ld(&(bar)[XB_TMO])) break; if (_sp > XB_SPIN_CAP) { atomicAdd(&(bar)[XB_TMO], 1u); break; } } } } while (0)
struct XcdBarrier { unsigned* bar; unsigned x; volatile LAS unsigned* st; };
__device__ __forceinline__ XcdBarrier xcd_barrier_post(unsigned* bar, volatile LAS unsigned* st) {
    XcdBarrier b; b.bar = bar; b.x = xb_xcc_id(); b.st = st;
    if (threadIdx.x == 0) (void)xb_add(&bar[XB_XCNT(b.x)], 1u);
    return b;
}
__device__ __forceinline__ void xcd_barrier_complete(unsigned* bar, unsigned x, unsigned& nloc, unsigned& nx) {
    const unsigned G = gridDim.x * gridDim.y * gridDim.z;
    unsigned sum, cnt, mine, sp = 0u;
    for (;;) {
        sum = 0u; cnt = 0u; mine = 0u;
#pragma unroll
        for (unsigned j = 0; j < 16; ++j) { const unsigned c = xb_ld(&bar[XB_XCNT(j)]); sum += c; cnt += (c > 0u) ? 1u : 0u; mine = (j == x) ? c : mine; }
        if (sum == G) break;
        __builtin_amdgcn_s_sleep(1);
        if ((++sp & 255u) == 0u) { if (xb_ld(&bar[XB_TMO])) break; if (sp > XB_SPIN_CAP) { atomicAdd(&bar[XB_TMO], 1u); break; } }
    }
    nloc = mine > 0u ? mine : 1u; nx = cnt > 0u ? cnt : 1u;
}
__device__ __forceinline__ void xcd_barrier(const XcdBarrier& b) {
    asm volatile("s_waitcnt vmcnt(0)" ::: "memory");
    __syncthreads();
    if (threadIdx.x == 0) {
        unsigned* bar = b.bar;
        __builtin_amdgcn_s_waitcnt(0);
        unsigned nloc = b.st[0], nx = b.st[1];
        if (nloc == 0u) { xcd_barrier_complete(bar, b.x, nloc, nx); b.st[0] = nloc; b.st[1] = nx; }
        const unsigned old = xb_add(&bar[XB_XSUB(b.x)], 1u);
        const unsigned gen = old / nloc;
        if (old + 1u == (gen + 1u) * nloc) {
            __builtin_amdgcn_fence(__ATOMIC_RELEASE, "agent");
            asm volatile("s_waitcnt vmcnt(0)" ::: "memory");
            const unsigned og = xb_add(&bar[XB_TOP], 1u);
            const unsigned tg = og / nx;
            if (og + 1u == (tg + 1u) * nx) xb_add(&bar[XB_TOPGEN], 1u);
            else XB_SPIN(xb_ld(&bar[XB_TOPGEN]) == tg, bar);
            __builtin_amdgcn_fence(__ATOMIC_ACQUIRE, "agent");
            xb_add(&bar[XB_XGEN(b.x)], 1u);
            asm volatile("s_waitcnt vmcnt(0)" ::: "memory");
        } else {
            XB_SPIN(xb_ld(&bar[XB_XGEN(b.x)]) == gen, bar);
            __builtin_amdgcn_fence(__ATOMIC_ACQUIRE, "agent");
            asm volatile("s_waitcnt vmcnt(0)" ::: "memory");
        }
    }
    __syncthreads();
}

__global__ void __launch_bounds__(512, 2) mk_fwd(Args a) {
    extern __shared__ __attribute__((aligned(16))) unsigned char lds_raw[];
    LAS unsigned char* lds = (LAS unsigned char*)lds_raw;
    cg::grid_group grid = cg::this_grid();
    unsigned char* ws = a.ws;
#define PHASE_BEGIN(k) if (a.ph_lo <= (k) && (k) < a.ph_hi && EN(k)) {
    volatile LAS unsigned* xb_st = (volatile LAS unsigned*)(lds + LDS_BYTES - 16);
    if (threadIdx.x < 4) xb_st[threadIdx.x] = 0u;
    unsigned* xb_words = (unsigned*)(ws + WS_BAR);
    __syncthreads();
    XcdBarrier xbar = xcd_barrier_post(xb_words, xb_st);
    if (a.ph_lo < 0) grid.sync();
#define PHASE_END(k) if ((k) + 1 < a.ph_hi) xcd_barrier(xbar); }
    PHASE_BEGIN(0) phase_prep(a, lds);
#if SCAN_DBG == 3 || SCAN_DBG == 5
        if (blockIdx.x == 0 && threadIdx.x < 8) ((unsigned*)(ws + WS_CTR + 8192))[threadIdx.x] = 0u;
#endif
#if SCAN_DBG == 7
        if (blockIdx.x == 0 && threadIdx.x < 32) ((float*)(ws + WS_CTR + 4096))[threadIdx.x] = 0.f;
#endif
    PHASE_END(0)
#if SCAN_DBG == 5
    PHASE_BEGIN(1) dbg_lds16_test(lds, (unsigned*)(ws + WS_CTR + 8192)); PHASE_END(1)
#define SKIP_REST 1
#endif
    PHASE_BEGIN(1) {
        pg8::Gemm g{(const bf16_t*)(ws + slot(0)), (const bf16_t*)(ws + WS_WIN), opaque(MTOK), opaque(4 * DM), opaque(DM)};
        pg8::StaticOrder S; S.init(g.M, g.N, (int)gridDim.x, (int)blockIdx.x);
        EpiKVQ E{(bf16_t*)(ws + slot(1)), (bf16_t*)(ws + slot(2)), (bf16_t*)(ws + slot(3))};
        pg8::gemm_phase<EpiKVQ, pg8::StaticOrder>(lds, g, S, E, nullptr);
    } PHASE_END(1)
    PHASE_BEGIN(2) phase_scan_a(lds, (const bf16_t*)(ws + slot(2)), (const float*)(ws + WS_LB), (const bf16_t*)(ws + slot(3)), (bf16_t*)(ws + slot(6)), (float*)(ws + WS_DEC), QuantJob{a.in[10], a.in[11], ws + WS_UB, ws + WS_VB, (float*)(ws + WS_USC), (float*)(ws + WS_VSC)}
#if SCAN_DBG == 3
        , (unsigned*)(ws + WS_CTR + 8192)
#endif
        );
#if SCAN_DBG == 7
        asm volatile("s_waitcnt vmcnt(0)" ::: "memory"); __syncthreads(); grid.sync(); if (threadIdx.x < 64) { __builtin_amdgcn_fence(__ATOMIC_ACQUIRE, "agent"); asm volatile("s_waitcnt vmcnt(0)" ::: "memory"); } __syncthreads();
        dbg_check_a7((const float*)(ws + slot(4)), (const bf16_t*)(ws + slot(2)), (const bf16_t*)(ws + slot(6)), (float*)(ws + WS_CTR + 4096));
#endif
#if SCAN_DBG == 6
#define DSYNC6() asm volatile("s_waitcnt vmcnt(0)" ::: "memory"); __syncthreads(); grid.sync(); if (threadIdx.x < 64) { __builtin_amdgcn_fence(__ATOMIC_ACQUIRE, "agent"); asm volatile("s_waitcnt vmcnt(0)" ::: "memory"); } __syncthreads();
        DSYNC6()
        phase_scan_a(lds, (const bf16_t*)(ws + slot(2)), (const float*)(ws + WS_LB), (const bf16_t*)(ws + slot(3)), (bf16_t*)a.out, (float*)(ws + WS_DEC), QuantJob{a.in[10], a.in[11], ws + WS_UB, ws + WS_VB, (float*)(ws + WS_USC), (float*)(ws + WS_VSC)});
        DSYNC6()
        dbg_check_a((LAS float*)lds, (const float*)(ws + slot(4)), (const bf16_t*)(ws + slot(2)), (const bf16_t*)(ws + slot(6)), (const bf16_t*)a.out, (float*)(ws + WS_CTR + 4096));
#endif
#if SCAN_DBG == 3
        asm volatile("s_waitcnt vmcnt(0)" ::: "memory"); __syncthreads(); grid.sync();
        dbg_count_bf16((const bf16_t*)(ws + slot(6)), (size_t)4096 * 16384, (unsigned*)(ws + WS_CTR + 8192) + 2);
#endif
    PHASE_END(2)
    PHASE_BEGIN(3) phase_scan_b((bf16_t*)(ws + slot(6)), (const float*)(ws + WS_DEC), QuantJob{a.in[10] + (size_t)16384 * DM, a.in[11] + (size_t)16384 * DM, ws + WS_UB + (size_t)16384 * DM, ws + WS_VB + (size_t)16384 * DM, (float*)(ws + WS_USC) + 16384, (float*)(ws + WS_VSC) + 16384});
#if SCAN_DBG == 3
        asm volatile("s_waitcnt vmcnt(0)" ::: "memory"); __syncthreads(); grid.sync();

#endif
    PHASE_END(3)
    PHASE_BEGIN(4) phase_scan_c(lds, (const bf16_t*)(ws + slot(1)), (const bf16_t*)(ws + slot(2)), (const float*)(ws + WS_LB), (const bf16_t*)(ws + slot(3)), (const bf16_t*)(ws + slot(4)), (const bf16_t*)(ws + slot(6)), a.in[2], (bf16_t*)(ws + slot(0)));
#if SCAN_DBG == 1
        asm volatile("s_waitcnt vmcnt(0)" ::: "memory"); __syncthreads(); grid.sync();
        phase_scan_naive((const bf16_t*)(ws + slot(1)), (const float*)(ws + slot(4)), (const bf16_t*)(ws + slot(2)), (float*)(ws + slot(6)));
        asm volatile("s_waitcnt vmcnt(0)" ::: "memory"); __syncthreads(); grid.sync();
        phase_onorm((const float*)(ws + slot(6)), (const bf16_t*)(ws + slot(3)), a.in[2], (bf16_t*)(ws + slot(0)));
#endif
#if SCAN_DBG == 3
        asm volatile("s_waitcnt vmcnt(0)" ::: "memory"); __syncthreads(); grid.sync();

#endif
#if SCAN_DBG == 4
#define DSYNC() asm volatile("s_waitcnt vmcnt(0)" ::: "memory"); __syncthreads(); grid.sync(); if (threadIdx.x < 64) { __builtin_amdgcn_fence(__ATOMIC_ACQUIRE, "agent"); asm volatile("s_waitcnt vmcnt(0)" ::: "memory"); } __syncthreads();
        DSYNC()
        phase_scan_naive((const bf16_t*)(ws + slot(1)), (const float*)(ws + slot(4)), (const bf16_t*)(ws + slot(2)), (float*)(ws + slot(6)));
        DSYNC()
        phase_onorm((const float*)(ws + slot(6)), (const bf16_t*)(ws + slot(3)), a.in[2], (bf16_t*)(ws + slot(8)));
        DSYNC()
        phase_scan_a(lds, (const bf16_t*)(ws + slot(2)), (const float*)(ws + WS_LB), (const bf16_t*)(ws + slot(3)), (bf16_t*)(ws + slot(6)), (float*)(ws + WS_DEC), QuantJob{a.in[10], a.in[11], ws + WS_UB, ws + WS_VB, (float*)(ws + WS_USC), (float*)(ws + WS_VSC)});
        DSYNC()
        phase_scan_b((bf16_t*)(ws + slot(6)), (const float*)(ws + WS_DEC), QuantJob{a.in[10] + (size_t)16384 * DM, a.in[11] + (size_t)16384 * DM, ws + WS_UB + (size_t)16384 * DM, ws + WS_VB + (size_t)16384 * DM, (float*)(ws + WS_USC) + 16384, (float*)(ws + WS_VSC) + 16384});
        DSYNC()
        phase_scan_c(lds, (const bf16_t*)(ws + slot(1)), (const bf16_t*)(ws + slot(2)), (const float*)(ws + WS_LB), (const bf16_t*)(ws + slot(3)), (const bf16_t*)(ws + slot(4)), (const bf16_t*)(ws + slot(6)), a.in[2], (bf16_t*)a.out);
        DSYNC()
        dbg_compare4((LAS float*)lds, (const bf16_t*)(ws + slot(0)), (const bf16_t*)(ws + slot(8)), (const bf16_t*)a.out, (float*)(ws + WS_CTR + 4096));
#endif
#if SCAN_DBG == 2
        asm volatile("s_waitcnt vmcnt(0)" ::: "memory"); __syncthreads(); grid.sync();
        phase_scan_naive((const bf16_t*)(ws + slot(1)), (const float*)(ws + slot(4)), (const bf16_t*)(ws + slot(2)), (float*)(ws + slot(6)));
        asm volatile("s_waitcnt vmcnt(0)" ::: "memory"); __syncthreads(); grid.sync();
        phase_onorm((const float*)(ws + slot(6)), (const bf16_t*)(ws + slot(3)), a.in[2], (bf16_t*)(ws + slot(8)));
        asm volatile("s_waitcnt vmcnt(0)" ::: "memory"); __syncthreads(); grid.sync();
        dbg_compare((LAS float*)lds, (const bf16_t*)(ws + slot(0)), (const bf16_t*)(ws + slot(8)), (float*)(ws + WS_CTR + 4096));
#endif
    PHASE_END(4)
    PHASE_BEGIN(5) run_gemm_out<false>(a, lds); PHASE_END(5)
    PHASE_BEGIN(6) run_ln<false>(a); PHASE_END(6)
    PHASE_BEGIN(7) run_gemm_sc<false>(a, lds); PHASE_END(7)
    PHASE_BEGIN(8) run_topk<false>(a, lds); PHASE_END(8)
    PHASE_BEGIN(9) run_peer<false>(a, lds); PHASE_END(9)
    PHASE_BEGIN(10) {
        pg8::Gemm g{(const bf16_t*)(ws + slot(2)), (const bf16_t*)(ws + WS_WKVQ), opaque(MTOK), opaque(3 * DM), opaque(DM)};
        pg8::StaticOrder S; S.init(g.M, g.N, (int)gridDim.x, (int)blockIdx.x);
        EpiKVQR E{(bf16_t*)(ws + slot(3)), (const float*)(ws + WS_COS), (const float*)(ws + WS_SIN)};
        pg8::gemm_phase<EpiKVQR, pg8::StaticOrder>(lds, g, S, E, nullptr);
    } PHASE_END(10)
    PHASE_BEGIN(11) phase_kstat((LAS float*)lds, (const bf16_t*)(ws + slot(3)), (float*)(ws + WS_KMEAN), (float*)(ws + WS_KNMAX)); PHASE_END(11)
    PHASE_BEGIN(12) phase_sel(lds, (const bf16_t*)(ws + slot(5)), (const float*)(ws + WS_KMEAN), (unsigned short*)(ws + WS_SUB), (int*)(ws + WS_CNT), (int*)(ws + WS_CTR)); PHASE_END(12)
    PHASE_BEGIN(13) phase_att(lds, (const bf16_t*)(ws + slot(5)), (const bf16_t*)(ws + slot(3)), (const bf16_t*)(ws + slot(4)), (const float*)(ws + WS_KNMAX), (const unsigned short*)(ws + WS_SUB),
                              (const int*)(ws + WS_CNT), (int*)(ws + WS_CTR), (bf16_t*)(ws + slot(6)), (bf16_t*)(ws + slot(0)), (float*)(ws + WS_LS)); PHASE_END(13)
    PHASE_BEGIN(14) phase_comb((const bf16_t*)(ws + slot(6)), (const bf16_t*)(ws + slot(0)), (const float*)(ws + WS_LS), (bf16_t*)(ws + slot(3))); PHASE_END(14)
    PHASE_BEGIN(15) run_gemm_out<true>(a, lds); PHASE_END(15)
    PHASE_BEGIN(16) run_ln<true>(a); PHASE_END(16)
    PHASE_BEGIN(17) run_gemm_sc<true>(a, lds); PHASE_END(17)
    PHASE_BEGIN(18) run_topk<true>(a, lds); PHASE_END(18)
#if SCAN_DBG == 7
    PHASE_BEGIN(19) dbg_emit7((const float*)(ws + WS_CTR + 4096), a.out); PHASE_END(19)
#elif SCAN_DBG == 6
    PHASE_BEGIN(19) dbg_emit4((const float*)(ws + WS_CTR + 4096), a.out); PHASE_END(19)
#elif SCAN_DBG == 5
    PHASE_BEGIN(19) dbg_emit5((const unsigned*)(ws + WS_CTR + 8192), a.out); PHASE_END(19)
#elif SCAN_DBG == 4
    PHASE_BEGIN(19) dbg_emit4((const float*)(ws + WS_CTR + 4096), a.out); PHASE_END(19)
#elif SCAN_DBG == 3
    PHASE_BEGIN(19) dbg_emit3((const unsigned*)(ws + WS_CTR + 8192), a.out); PHASE_END(19)
#elif SCAN_DBG == 2
    PHASE_BEGIN(19) dbg_emit((const float*)(ws + WS_CTR + 4096), a.out); PHASE_END(19)
#else
    PHASE_BEGIN(19) run_peer<true>(a, lds); PHASE_END(19)
#endif
}

extern "C" void kernel_launch(void* const* d_in, const int* in_sizes, int n_in, void* d_out, int out_size, void* d_ws, size_t ws_size, hipStream_t stream) {
    static int grid = 0;
    if (grid == 0) {
        if (n_in != 14 || out_size != MTOK * DM || ws_size < WS_END) { fprintf(stderr, "kernel_launch: unexpected shapes (n_in %d, out %d, ws %zu)\n", n_in, out_size, ws_size); grid = -1; return; }
        int dev = 0, cus = 0, per_cu = 0;
        if (hipGetDevice(&dev) != hipSuccess || hipDeviceGetAttribute(&cus, hipDeviceAttributeMultiprocessorCount, dev) != hipSuccess) { grid = -1; return; }
        if (hipFuncSetAttribute((const void*)mk_fwd, hipFuncAttributeMaxDynamicSharedMemorySize, LDS_BYTES) != hipSuccess) { fprintf(stderr, "kernel_launch: hipFuncSetAttribute failed\n"); grid = -1; return; }
        if (hipOccupancyMaxActiveBlocksPerMultiprocessor(&per_cu, (const void*)mk_fwd, 512, LDS_BYTES) != hipSuccess || per_cu < 1) { fprintf(stderr, "kernel_launch: occupancy query failed (%d)\n", per_cu); (void)hipGetLastError(); per_cu = 1; }
        grid = cus * (per_cu > 1 ? 1 : per_cu);
    }
    if (grid < 0) return;
    Args a{};
    for (int i = 0; i < 14; ++i) a.in[i] = (const float*)d_in[i];
    a.out = (float*)d_out; a.ws = (unsigned char*)d_ws;
#if ONE_LAUNCH
    a.ph_lo = 0; a.ph_hi = NPH;
    (void)hipMemsetAsync((unsigned char*)d_ws + WS_BAR, 0, XCD_BAR_WORDS * sizeof(unsigned), stream);
    void* args[] = {&a};
    hipError_t e = hipLaunchCooperativeKernel((const void*)mk_fwd, dim3(grid), dim3(512), args, LDS_BYTES, stream);
    if (e != hipSuccess) fprintf(stderr, "cooperative launch failed: %s (grid %d)\n", hipGetErrorString(e), grid);
#else
    for (int ph = 0; ph < NPH; ++ph) {
        a.ph_lo = ph; a.ph_hi = ph + 1;
        hipLaunchKernelGGL(mk_fwd, dim3(grid), dim3(512), LDS_BYTES, stream, a);
    }
#endif
}
```

```cpp
#define ONE_LAUNCH 1
#include <hip/hip_runtime.h>
#include <hip/hip_cooperative_groups.h>
#include <cstdio>
namespace cg = cooperative_groups;

#ifndef ONE_LAUNCH
#define ONE_LAUNCH 0
#endif
#ifndef SCAN_DBG
#define SCAN_DBG 0
#endif
#ifndef SCAN_A_VALU
#define SCAN_A_VALU 0
#endif
#ifndef ENMASK
#define ENMASK 0xffffffffu
#endif
#define EN(k) ((ENMASK >> (k)) & 1u)

namespace pg8 {
#define PG8_LAS __attribute__((address_space(3)))
typedef unsigned short bf16_t;
typedef short bf16x8 __attribute__((ext_vector_type(8)));
typedef float f32x4 __attribute__((ext_vector_type(4)));
typedef unsigned u32x4 __attribute__((ext_vector_type(4)));
constexpr int BM = 256, BK = 64, HALF = 128, HTB = HALF * BK * 2  , STAGE_BYTES = 8 * HTB, NXCD = 8, WGM = 8;

__host__ __device__ __forceinline__ int lds_byte(int r, int c) { const int st = (r >> 4) * 2 + (c >> 5), rr = r & 15, cc = c & 31, ob = rr * 64 + cc * 2; return st * 1024 + (ob ^ (((ob >> 9) & 1) << 5)); }
__host__ __device__ __forceinline__ void stage_rc(int b, int& R, int& C) { const int st = b / 1024, sb = b % 1024, swz = sb ^ (((sb >> 9) & 1) << 5); R = (st >> 1) * 16 + swz / 64; C = (st & 1) * 32 + (swz % 64) / 2; }
__host__ __device__ __forceinline__ int perm32(int rho) { const int n = rho >> 4, i = rho & 15; return 8 * (i >> 2) + 4 * n + (i & 3); }

struct Unit { int pm, pn; };
struct Gemm { const bf16_t* A; const bf16_t* Bt; int M, N, K; };

struct StaticOrder {
    int nM, nN, nwg, G, c;
    __host__ __device__ void init(int M, int N, int G_, int c_) { nM = M / BM; nN = N / BM; nwg = nM * nN; G = G_; c = c_; }
    __host__ __device__ bool next(int i, Unit& u) const {
        const long L = (long)i * G + c; if (L >= nwg) return false;
        int wgid = (int)L; { const int q = nwg / NXCD, r = nwg % NXCD, xcd = wgid % NXCD, off = wgid / NXCD; wgid = (xcd < r ? xcd * (q + 1) : r * (q + 1) + (xcd - r) * q) + off; }
        const int nig = WGM * nN, gid = wgid / nig, fm = gid * WGM, gsz = (nM - fm) < WGM ? (nM - fm) : WGM;
        u.pm = fm + ((wgid % nig) % gsz); u.pn = (wgid % nig) / gsz; return true;
    }
    __device__ __forceinline__ void a_ready(const Unit&) const {}
    __device__ __forceinline__ void done(const Unit&) const {}
};
struct CountedOrder : StaticOrder {
    const unsigned* ready; unsigned need; unsigned* tmo;
    __device__ __forceinline__ void a_ready(const Unit& u) const {
        if (threadIdx.x < 64) {
            const unsigned long long t0 = __builtin_amdgcn_s_memrealtime(); unsigned polls = 0;
            while ((unsigned)__builtin_amdgcn_readfirstlane(__hip_atomic_load(ready + 64 * u.pm, __ATOMIC_RELAXED, __HIP_MEMORY_SCOPE_AGENT)) < need) {
                if ((++polls & 255u) == 0u && __builtin_amdgcn_readfirstlane(__hip_atomic_load(tmo, __ATOMIC_RELAXED, __HIP_MEMORY_SCOPE_AGENT)) != 0u) break;
                if (__builtin_amdgcn_s_memrealtime() - t0 > 2000000ull) {
                    if (threadIdx.x == 0) { unsigned expect = 0u; __hip_atomic_compare_exchange_strong(tmo + 1, &expect, 0x600u | (unsigned)(u.pm & 0xff), __ATOMIC_RELAXED, __ATOMIC_RELAXED, __HIP_MEMORY_SCOPE_AGENT); __hip_atomic_store(tmo, 1u, __ATOMIC_RELAXED, __HIP_MEMORY_SCOPE_AGENT); }
                    break; }
                __builtin_amdgcn_s_sleep(2); }
            __builtin_amdgcn_fence(__ATOMIC_ACQUIRE, "agent");
            asm volatile("s_waitcnt vmcnt(0)" ::: "memory");
        }
#if !defined(BROKEN_HOOK_NO_BARRIER)
        asm volatile("" ::: "memory"); __builtin_amdgcn_s_barrier(); asm volatile("" ::: "memory");
#endif
    }
};

__device__ __forceinline__ unsigned cvt_pk_bf16(float lo, float hi) { unsigned r; asm volatile("v_cvt_pk_bf16_f32 %0, %1, %2" : "=v"(r) : "v"(lo), "v"(hi)); return r; }
typedef float f32x2 __attribute__((ext_vector_type(2)));
__device__ __forceinline__ f32x2 gelu_pk(f32x2 v) {
    const f32x2 av = __builtin_elementwise_abs(v), d = av * 0.2316418882f + 1.0f;
    f32x2 t; t.x = __builtin_amdgcn_rcpf(d.x); t.y = __builtin_amdgcn_rcpf(d.y);
    f32x2 q = t * 0.5307027145f + (-0.7265760135f); q = q * t + 0.7107068705f; q = q * t + (-0.142248368f); q = q * t + 0.127414796f; q = q * t;
    const f32x2 s = (v * v) * (-0.72134752044f);
    f32x2 e; e.x = __builtin_amdgcn_exp2f(s.x); e.y = __builtin_amdgcn_exp2f(s.y);
    const f32x2 m = v * (q * e), r = v - m;
    f32x2 o; o.x = v.x < 0.f ? m.x : r.x; o.y = v.y < 0.f ? m.y : r.y; return o;
}

struct EpiF32 {
    static constexpr bool PERM = false, AFTER_DRAIN = false;
    float* C; int ldc; const float* bias;
    __device__ __forceinline__ void operator()(const f32x4 (&acc)[2][2][4][2], const Unit& u, int wr, int wc, int fr, int fq) const {
        const int row0 = u.pm * BM + wr * 64 + fr, col0 = u.pn * BM + wc * 32 + 4 * fq;
        f32x4 bv[2][2];
#pragma unroll
        for (int bj = 0; bj < 2; ++bj)
#pragma unroll
            for (int n = 0; n < 2; ++n) bv[bj][n] = bias ? *(const f32x4*)(bias + col0 + bj * HALF + n * 16) : (f32x4){0.f, 0.f, 0.f, 0.f};
#pragma unroll
        for (int ai = 0; ai < 2; ++ai)
#pragma unroll
            for (int m = 0; m < 4; ++m) { float* rowp = C + (size_t)(row0 + ai * HALF + m * 16) * ldc + col0;
#pragma unroll
                for (int bj = 0; bj < 2; ++bj)
#pragma unroll
                    for (int n = 0; n < 2; ++n) *(f32x4*)(rowp + bj * HALF + n * 16) = acc[ai][bj][m][n] + bv[bj][n]; }
    }
};
template <int ACT  > struct EpiBf16 {
    static constexpr bool PERM = true, AFTER_DRAIN = false;
    bf16_t* O; int ldc; const float* bias; int split_cols; size_t split_stride;
    __device__ __forceinline__ void operator()(const f32x4 (&acc)[2][2][4][2], const Unit& u, int wr, int wc, int fr, int fq) const {
        const int row0 = u.pm * BM + wr * 64 + fr; int colt = u.pn * BM; bf16_t* base = O;
        if (split_cols) { const int t = colt / split_cols; base += (size_t)t * split_stride; colt -= t * split_cols; }
        const int col0 = colt + wc * 32 + 8 * fq, bcol0 = u.pn * BM + wc * 32 + 8 * fq;
        f32x4 bv[2][2];
#pragma unroll
        for (int bj = 0; bj < 2; ++bj)
#pragma unroll
            for (int n = 0; n < 2; ++n) bv[bj][n] = bias ? *(const f32x4*)(bias + bcol0 + bj * HALF + 4 * n) : (f32x4){0.f, 0.f, 0.f, 0.f};
#pragma unroll
        for (int ai = 0; ai < 2; ++ai)
#pragma unroll
            for (int m = 0; m < 4; ++m) { bf16_t* rowp = base + (size_t)(row0 + ai * HALF + m * 16) * ldc + col0;
#pragma unroll
                for (int bj = 0; bj < 2; ++bj) { f32x4 v0 = acc[ai][bj][m][0] + bv[bj][0], v1 = acc[ai][bj][m][1] + bv[bj][1];
                    if (ACT == 1) { f32x2 a = gelu_pk((f32x2){v0[0], v0[1]}), b = gelu_pk((f32x2){v0[2], v0[3]}), c = gelu_pk((f32x2){v1[0], v1[1]}), d = gelu_pk((f32x2){v1[2], v1[3]});
                        v0 = (f32x4){a.x, a.y, b.x, b.y}; v1 = (f32x4){c.x, c.y, d.x, d.y}; }
                    if (ACT == 2) {
#pragma unroll
                        for (int j = 0; j < 4; ++j) { v0[j] = 0.5f * v0[j] * (1.0f + erff(v0[j] * 0.70710678f)); v1[j] = 0.5f * v1[j] * (1.0f + erff(v1[j] * 0.70710678f)); } }
                    u32x4 w; w.x = cvt_pk_bf16(v0[0], v0[1]); w.y = cvt_pk_bf16(v0[2], v0[3]); w.z = cvt_pk_bf16(v1[0], v1[1]); w.w = cvt_pk_bf16(v1[2], v1[3]);
                    *(u32x4*)(rowp + bj * HALF) = w; } }
    }
};

template <class Epi, class Sched, bool STAMP = false>
__device__ __forceinline__ void gemm_phase(PG8_LAS unsigned char* lds, const Gemm g, const Sched& S, const Epi& E, unsigned long long* stamps) {
    const int tid = threadIdx.x, wid = __builtin_amdgcn_readfirstlane(tid >> 6), lane = tid & 63, wr = wid >> 2, wc = wid & 3, fr = lane & 15, fq = lane >> 4;
    const int K = g.K, nt = K / BK;
    int ts_lo = 0, ts_hi = 0, nts = 0; const unsigned long long rt_entry = STAMP ? (unsigned long long)wall_clock64() : 0ull;
#define PG8_STAMP() do { if (STAMP && wid == 0 && nts < 64) { const unsigned long long _c = (unsigned long long)clock64(); \
        ts_lo = (lane == nts) ? (int)(unsigned)_c : ts_lo; ts_hi = (lane == nts) ? (int)(unsigned)(_c >> 32) : ts_hi; ++nts; } } while (0)
    PG8_STAMP();
    unsigned voffA[2], voffB[2];
#pragma unroll
    for (int i = 0; i < 2; ++i) { int R, C; stage_rc(tid * 16 + i * 8192, R, C); const int Rb = Epi::PERM ? ((R & ~31) + perm32(R & 31)) : R;
        voffA[i] = (unsigned)(R * K + C) * 2u; voffB[i] = (unsigned)(Rb * K + C) * 2u; }
    const size_t kstep = (size_t)(BK * 2);
    const size_t hstep = (size_t)HALF * K * 2;
    const size_t tstep = 2 * hstep;
    const unsigned ldsw = (unsigned)wid * 1024u;
    const int aoff = lds_byte(wr * 64 + fr, fq * 8), boff = lds_byte(wc * 32 + fr, fq * 8);
#define PG8_SA(b, h) (((b) * 2 + (h)) * HTB)
#define PG8_SB(b, h) ((4 + (b) * 2 + (h)) * HTB)
#define PG8_STAGE(bufoff, gbase, voff) do { _Pragma("unroll") for (int _i = 0; _i < 2; ++_i) \
        __builtin_amdgcn_global_load_lds((const unsigned*)((const char*)(gbase) + (voff)[_i]), (PG8_LAS unsigned*)(lds + (bufoff) + ldsw + _i * 8192), 16, 0, 0); } while (0)
#define PG8_LDA(dst, b, h) do { _Pragma("unroll") for (int m = 0; m < 4; ++m) _Pragma("unroll") for (int k = 0; k < 2; ++k) dst[m][k] = *(const PG8_LAS bf16x8*)(lds + PG8_SA(b, h) + aoff + m * 2048 + k * 1024); } while (0)
#define PG8_LDB(dst, b, h) do { _Pragma("unroll") for (int n = 0; n < 2; ++n) _Pragma("unroll") for (int k = 0; k < 2; ++k) dst[n][k] = *(const PG8_LAS bf16x8*)(lds + PG8_SB(b, h) + boff + n * 2048 + k * 1024); } while (0)
#define PG8_MMA(ai, bj, At, Bt) do { __builtin_amdgcn_s_setprio(1); _Pragma("unroll") for (int m = 0; m < 4; ++m) _Pragma("unroll") for (int n = 0; n < 2; ++n) _Pragma("unroll") for (int k = 0; k < 2; ++k) \
        acc[ai][bj][m][n] = __builtin_amdgcn_mfma_f32_16x16x32_bf16(Bt[n][k], At[m][k], acc[ai][bj][m][n], 0, 0, 0); __builtin_amdgcn_s_setprio(0); } while (0)
#define PG8_WAIT_V(n) asm volatile("s_waitcnt vmcnt(" #n ")" ::: "memory")
#define PG8_WAIT_L(n) asm volatile("s_waitcnt lgkmcnt(" #n ")" ::: "memory")
#define PG8_BAR __builtin_amdgcn_s_barrier()
#define PG8_SCHED __builtin_amdgcn_sched_barrier(0)
    Unit cur, nxt; int ui = 0;
    if (!S.next(0, cur)) return;
    f32x4 acc[2][2][4][2];
#pragma unroll
    for (int a = 0; a < 2; ++a)
#pragma unroll
        for (int b = 0; b < 2; ++b)
#pragma unroll
            for (int m = 0; m < 4; ++m)
#pragma unroll
                for (int n = 0; n < 2; ++n) acc[a][b][m][n] = (f32x4){0.f, 0.f, 0.f, 0.f};
    bf16x8 At[4][2], B0[2][2], B1[2][2];
    const char* cA = (const char*)g.A + (size_t)cur.pm * tstep; const char* cB = (const char*)g.Bt + (size_t)cur.pn * tstep;
    S.a_ready(cur);
    PG8_STAGE(PG8_SB(0, 0), cB, voffB); PG8_STAGE(PG8_SA(0, 0), cA, voffA); PG8_STAGE(PG8_SB(0, 1), cB + hstep, voffB); PG8_STAGE(PG8_SA(0, 1), cA + hstep, voffA);
    if (wr == 1) PG8_BAR;
    PG8_WAIT_V(4); PG8_BAR;
    PG8_STAGE(PG8_SB(1, 0), cB + kstep, voffB); PG8_STAGE(PG8_SA(1, 0), cA + kstep, voffA); PG8_STAGE(PG8_SB(1, 1), cB + hstep + kstep, voffB);
    PG8_WAIT_V(6); PG8_BAR;
    PG8_STAMP();
    for (;;) {
        const bool has_next = S.next(ui + 1, nxt);
        const char* nA = has_next ? (const char*)g.A + (size_t)nxt.pm * tstep : cA; const char* nB = has_next ? (const char*)g.Bt + (size_t)nxt.pn * tstep : cB;
        for (int t = 0; t < nt; t += 2) {
            const bool last = (t == nt - 2);
            const char* a1 = cA + (size_t)(t + 1) * kstep;
            const char* a2 = last ? nA : cA + (size_t)(t + 2) * kstep; const char* b2 = last ? nB : cB + (size_t)(t + 2) * kstep;
            const char* a3 = a2 + kstep; const char* b3 = b2 + kstep;
            if (last && has_next) S.a_ready(nxt);
            PG8_LDB(B0, 0, 0); PG8_SCHED; PG8_LDA(At, 0, 0); PG8_STAGE(PG8_SA(1, 1), a1 + hstep, voffA);
            PG8_WAIT_L(8); PG8_BAR; PG8_WAIT_L(0); PG8_MMA(0, 0, At, B0); PG8_BAR; PG8_SCHED;
            PG8_LDB(B1, 0, 1); PG8_STAGE(PG8_SB(0, 0), b2, voffB);
            PG8_BAR; PG8_WAIT_L(0); PG8_MMA(0, 1, At, B1); PG8_BAR;
            PG8_LDA(At, 0, 1); PG8_STAGE(PG8_SA(0, 0), a2, voffA);
            PG8_BAR; PG8_WAIT_L(0); PG8_MMA(1, 0, At, B0); PG8_BAR; PG8_SCHED;
            PG8_STAGE(PG8_SB(0, 1), b2 + hstep, voffB);
            PG8_WAIT_V(6); PG8_BAR; PG8_MMA(1, 1, At, B1); PG8_BAR;
            PG8_LDB(B0, 1, 0); PG8_SCHED; PG8_LDA(At, 1, 0); PG8_STAGE(PG8_SA(0, 1), a2 + hstep, voffA);
            PG8_WAIT_L(8); PG8_BAR; PG8_WAIT_L(0); PG8_MMA(0, 0, At, B0); PG8_BAR; PG8_SCHED;
            PG8_LDB(B1, 1, 1); PG8_STAGE(PG8_SB(1, 0), b3, voffB);
            PG8_BAR; PG8_WAIT_L(0); PG8_MMA(0, 1, At, B1); PG8_BAR;
            PG8_LDA(At, 1, 1); PG8_STAGE(PG8_SA(1, 0), a3, voffA);
            PG8_BAR; PG8_WAIT_L(0); PG8_MMA(1, 0, At, B0); PG8_BAR; PG8_SCHED;
            PG8_STAGE(PG8_SB(1, 1), b3 + hstep, voffB);
            PG8_WAIT_V(6); PG8_BAR; PG8_MMA(1, 1, At, B1); PG8_BAR;
        }
        PG8_STAMP();
        if constexpr (!Epi::AFTER_DRAIN) { E(acc, cur, wr, wc, fr, fq); S.done(cur); }
        PG8_STAMP();
        if (!has_next) break;
#pragma unroll
        for (int a = 0; a < 2; ++a)
#pragma unroll
            for (int b = 0; b < 2; ++b)
#pragma unroll
                for (int m = 0; m < 4; ++m)
#pragma unroll
                    for (int n = 0; n < 2; ++n) acc[a][b][m][n] = (f32x4){0.f, 0.f, 0.f, 0.f};
        cur = nxt; cA = nA; cB = nB; ++ui;
    }
    PG8_WAIT_V(0);
    if (wr == 0) PG8_BAR;
    PG8_BAR;
    if constexpr (Epi::AFTER_DRAIN) { E.fused(acc, cur, wr, wc, fr, fq, lds, wid, lane); S.done(cur); }
    PG8_STAMP();
    if (STAMP && wid == 0) { stamps[lane] = lane < nts ? (((unsigned long long)(unsigned)ts_hi << 32) | (unsigned)ts_lo) : 0ull;
        if (lane == 62) stamps[62] = rt_entry; if (lane == 63) stamps[63] = (unsigned long long)wall_clock64(); }
#undef PG8_STAMP
#undef PG8_SA
#undef PG8_SB
#undef PG8_STAGE
#undef PG8_LDA
#undef PG8_LDB
#undef PG8_MMA
#undef PG8_WAIT_V
#undef PG8_WAIT_L
#undef PG8_BAR
#undef PG8_SCHED
}
}


#define LAS __attribute__((address_space(3)))
typedef unsigned short bf16_t;
typedef float f32x4 __attribute__((ext_vector_type(4)));
typedef unsigned u32x4 __attribute__((ext_vector_type(4)));
typedef unsigned u32x2 __attribute__((ext_vector_type(2)));
typedef short bf16x8 __attribute__((ext_vector_type(8)));
typedef short s16x4 __attribute__((ext_vector_type(4)));
typedef float f32x16 __attribute__((ext_vector_type(16)));

constexpr int MTOK = 16384, DM = 2048, SEQ = 8192, NHEAD = 16;
constexpr float ALPHA = 1.41421356237309515f;
constexpr size_t MiB = (size_t)1 << 20;
constexpr size_t WS_WIN = 0, WS_WOUT = 32 * MiB, WS_WKVQ = 40 * MiB, WS_WO = 64 * MiB, WS_WC = 72 * MiB, WS_UB = 88 * MiB, WS_VB = 152 * MiB, WS_USC = 216 * MiB, WS_VSC = 217 * MiB, WS_H = 224 * MiB, WS_XQ = 232 * MiB, WS_XS = 264 * MiB, WS_W = 272 * MiB, WS_CS = 280 * MiB, WS_SLOT = 344 * MiB;
constexpr size_t WS_EID = 920 * MiB, WS_GATE = 928 * MiB, WS_COS = 936 * MiB, WS_SIN = 938 * MiB, WS_KMEAN = 940 * MiB, WS_LB = 941 * MiB, WS_LS = 942 * MiB, WS_SUB = 946 * MiB, WS_CNT = 962 * MiB, WS_CTR = 963 * MiB, WS_DEC = 964 * MiB, WS_END = 966 * MiB;
constexpr size_t WS_BAR = WS_CTR + 65536;
constexpr size_t WS_KNMAX = WS_KMEAN + 768 * 1024;
__host__ __device__ constexpr size_t slot(int i) { return WS_SLOT + (size_t)i * 64 * MiB; }
constexpr int LDS_BYTES = 144 * 1024;
constexpr int NPH = 20;

struct Args { const float* in[14]; float* out; unsigned char* ws; int ph_lo, ph_hi; };

__device__ __forceinline__ float bflo(unsigned w) { return __uint_as_float(w << 16); }
__device__ __forceinline__ float bfhi(unsigned w) { return __uint_as_float(w & 0xffff0000u); }
__device__ __forceinline__ float bf2f(bf16_t b) { return __uint_as_float(((unsigned)b) << 16); }
typedef __bf16 bf16x2_t __attribute__((ext_vector_type(2)));
typedef float f32x2_t __attribute__((ext_vector_type(2)));
__device__ __forceinline__ unsigned pk_bf16(float lo, float hi) { const f32x2_t f = {lo, hi}; return __builtin_bit_cast(unsigned, __builtin_convertvector(f, bf16x2_t)); }
__device__ __forceinline__ float wave_sum(float v) {
#pragma unroll
    for (int o = 32; o >= 1; o >>= 1) v += __shfl_xor(v, o);
    return v;
}
__device__ __forceinline__ float wave_max(float v) {
#pragma unroll
    for (int o = 32; o >= 1; o >>= 1) v = fmaxf(v, __shfl_xor(v, o));
    return v;
}
__device__ __forceinline__ float sigmoidf_(float z) { return 1.0f / (1.0f + __expf(-z)); }


__device__ __forceinline__ void store_wt16(void* p, u32x4 v) {
    __hip_atomic_store((unsigned long long*)p, ((unsigned long long)v.y << 32) | v.x, __ATOMIC_RELAXED, __HIP_MEMORY_SCOPE_AGENT);
    __hip_atomic_store((unsigned long long*)p + 1, ((unsigned long long)v.w << 32) | v.z, __ATOMIC_RELAXED, __HIP_MEMORY_SCOPE_AGENT);
}
__device__ __forceinline__ void store_wt8(void* p, u32x2 v) {
    __hip_atomic_store((unsigned long long*)p, ((unsigned long long)v.y << 32) | v.x, __ATOMIC_RELAXED, __HIP_MEMORY_SCOPE_AGENT);
}
struct EpiIn {
    static constexpr bool PERM = true, AFTER_DRAIN = false;
    bf16_t* Q1; float* LF; bf16_t* I1; bf16_t* G1; const float* LB;
    __device__ __forceinline__ void operator()(const pg8::f32x4 (&acc)[2][2][4][2], const pg8::Unit& u, int wr, int wc, int fr, int fq) const {
        const int type = u.pn >> 3;
        const int row0 = u.pm * 256 + wr * 64 + fr, col0 = (u.pn & 7) * 256 + wc * 32 + 8 * fq;
        if (type == 1) {
#pragma unroll
            for (int bj = 0; bj < 2; ++bj) {
                const int c = col0 + bj * 128;
                const f32x4 lb0 = *(const f32x4*)(LB + c), lb1 = *(const f32x4*)(LB + c + 4);
#pragma unroll
                for (int ai = 0; ai < 2; ++ai)
#pragma unroll
                    for (int m = 0; m < 4; ++m) {
                        float* p = LF + (size_t)(row0 + ai * 128 + m * 16) * DM + c;
                        f32x4 o0, o1;
#pragma unroll
                        for (int j = 0; j < 4; ++j) {
                            o0[j] = __logf(lb0[j] + (1.0f - lb0[j]) * sigmoidf_(acc[ai][bj][m][0][j]));
                            o1[j] = __logf(lb1[j] + (1.0f - lb1[j]) * sigmoidf_(acc[ai][bj][m][1][j]));
                        }
                        *(f32x4*)p = o0; *(f32x4*)(p + 4) = o1;
                    }
            }
        } else {
            bf16_t* dst = Q1 + (size_t)(type - (type > 0 ? 1 : 0)) * ((size_t)32 << 20);
            const bool act = (type != 2);
#pragma unroll
            for (int ai = 0; ai < 2; ++ai)
#pragma unroll
                for (int m = 0; m < 4; ++m)
#pragma unroll
                    for (int bj = 0; bj < 2; ++bj) {
                        f32x4 v0 = acc[ai][bj][m][0], v1 = acc[ai][bj][m][1];
                        if (act) {
#pragma unroll
                            for (int j = 0; j < 4; ++j) { v0[j] = v0[j] * sigmoidf_(v0[j]); v1[j] = v1[j] * sigmoidf_(v1[j]); }
                        }
                        u32x4 w; w.x = pk_bf16(v0[0], v0[1]); w.y = pk_bf16(v0[2], v0[3]); w.z = pk_bf16(v1[0], v1[1]); w.w = pk_bf16(v1[2], v1[3]);
                        *(u32x4*)(dst + (size_t)(row0 + ai * 128 + m * 16) * DM + col0 + bj * 128) = w;
                    }
        }
    }
};
struct EpiRes {
    static constexpr bool PERM = false, AFTER_DRAIN = false;
    const float* res; float* Y;
    __device__ __forceinline__ void operator()(const pg8::f32x4 (&acc)[2][2][4][2], const pg8::Unit& u, int wr, int wc, int fr, int fq) const {
        const int row0 = u.pm * 256 + wr * 64 + fr, col0 = u.pn * 256 + wc * 32 + 4 * fq;
#pragma unroll
        for (int ai = 0; ai < 2; ++ai)
#pragma unroll
            for (int m = 0; m < 4; ++m) {
                const size_t off = (size_t)(row0 + ai * 128 + m * 16) * DM + col0;
#pragma unroll
                for (int bj = 0; bj < 2; ++bj)
#pragma unroll
                    for (int n = 0; n < 2; ++n) {
                        const f32x4 r = *(const f32x4*)(res + off + bj * 128 + n * 16);
                        *(f32x4*)(Y + off + bj * 128 + n * 16) = r * ALPHA + acc[ai][bj][m][n];
                    }
            }
    }
};
struct EpiF32 {
    static constexpr bool PERM = false, AFTER_DRAIN = false;
    float* C; int ldc;
    __device__ __forceinline__ void operator()(const pg8::f32x4 (&acc)[2][2][4][2], const pg8::Unit& u, int wr, int wc, int fr, int fq) const {
        const int row0 = u.pm * 256 + wr * 64 + fr, col0 = u.pn * 256 + wc * 32 + 4 * fq;
#pragma unroll
        for (int ai = 0; ai < 2; ++ai)
#pragma unroll
            for (int m = 0; m < 4; ++m) {
                float* p = C + (size_t)(row0 + ai * 128 + m * 16) * ldc + col0;
#pragma unroll
                for (int bj = 0; bj < 2; ++bj)
#pragma unroll
                    for (int n = 0; n < 2; ++n) *(f32x4*)(p + bj * 128 + n * 16) = acc[ai][bj][m][n];
            }
    }
};
struct EpiKVQ {
    static constexpr bool PERM = true, AFTER_DRAIN = false;
    bf16_t* K; bf16_t* V; bf16_t* Q;
    __device__ __forceinline__ void operator()(const pg8::f32x4 (&acc)[2][2][4][2], const pg8::Unit& u, int wr, int wc, int fr, int fq) const {
        const int t = u.pn >> 3;
        bf16_t* dst = K + (size_t)t * ((size_t)32 << 20);
        const int row0 = u.pm * 256 + wr * 64 + fr, col0 = (u.pn & 7) * 256 + wc * 32 + 8 * fq;
#pragma unroll
        for (int ai = 0; ai < 2; ++ai)
#pragma unroll
            for (int m = 0; m < 4; ++m)
#pragma unroll
                for (int bj = 0; bj < 2; ++bj) {
                    const f32x4 v0 = acc[ai][bj][m][0], v1 = acc[ai][bj][m][1];
                    u32x4 w; w.x = pk_bf16(v0[0], v0[1]); w.y = pk_bf16(v0[2], v0[3]); w.z = pk_bf16(v1[0], v1[1]); w.w = pk_bf16(v1[2], v1[3]);
                    *(u32x4*)(dst + (size_t)(row0 + ai * 128 + m * 16) * DM + col0 + bj * 128) = w;
                }
    }
};


struct EpiKVQR {
    static constexpr bool PERM = true, AFTER_DRAIN = false;
    bf16_t* K; const float* COS; const float* SIN;
    __device__ __forceinline__ void operator()(const pg8::f32x4 (&acc)[2][2][4][2], const pg8::Unit& u, int wr, int wc, int fr, int fq) const {
        const int t = u.pn >> 3;
        bf16_t* dst = K + (size_t)t * ((size_t)32 << 20);
        const int row0 = u.pm * 256 + wr * 64 + fr;
        if (t == 1) {
            const int col0 = (u.pn & 7) * 256 + wc * 32 + 8 * fq;
#pragma unroll
            for (int ai = 0; ai < 2; ++ai)
#pragma unroll
                for (int m = 0; m < 4; ++m)
#pragma unroll
                    for (int bj = 0; bj < 2; ++bj) {
                        const f32x4 v0 = acc[ai][bj][m][0], v1 = acc[ai][bj][m][1];
                        u32x4 w; w.x = pk_bf16(v0[0], v0[1]); w.y = pk_bf16(v0[2], v0[3]); w.z = pk_bf16(v1[0], v1[1]); w.w = pk_bf16(v1[2], v1[3]);
                        *(u32x4*)(dst + (size_t)(row0 + ai * 128 + m * 16) * DM + col0 + bj * 128) = w;
                    }
        } else {
            const int g = 4 * wc + fq;
#pragma unroll
            for (int ai = 0; ai < 2; ++ai)
#pragma unroll
                for (int m = 0; m < 4; ++m) {
                    const int row = row0 + ai * 128 + m * 16, pos = row & (SEQ - 1);
                    const f32x4 c = *(const f32x4*)(COS + pos * 64 + 4 * g), sn = *(const f32x4*)(SIN + pos * 64 + 4 * g);
#pragma unroll
                    for (int bj = 0; bj < 2; ++bj) {
                        const f32x4 a = acc[ai][bj][m][0], b = acc[ai][bj][m][1];
                        bf16_t* p = dst + (size_t)row * DM + ((u.pn & 7) * 2 + bj) * 128 + 4 * g;
                        u32x2 w1, w2;
                        w1.x = pk_bf16(a[0] * c[0] - b[0] * sn[0], a[1] * c[1] - b[1] * sn[1]); w1.y = pk_bf16(a[2] * c[2] - b[2] * sn[2], a[3] * c[3] - b[3] * sn[3]);
                        w2.x = pk_bf16(a[0] * sn[0] + b[0] * c[0], a[1] * sn[1] + b[1] * c[1]); w2.y = pk_bf16(a[2] * sn[2] + b[2] * c[2], a[3] * sn[3] + b[3] * c[3]);
                        *(u32x2*)p = w1; *(u32x2*)(p + 64) = w2;
                    }
                }
        }
    }
};

__host__ __device__ __forceinline__ int rot_pos(int d) { return d < 64 ? 8 * (d >> 2) + (d & 3) : 8 * ((d - 64) >> 2) + 4 + (d & 3); }
__device__ __forceinline__ void transpose_tiles(LAS float* tile, const float* src, int ldn, int K, int N, bf16_t* dst, int nperm = 0) {
    const int tid = threadIdx.x;
    const int tn = N / 64, ntiles = tn * (K / 64);
    f32x4 nx[2];
#define TT_LOAD(tI_) { const int k0_ = ((tI_) / tn) * 64, n0_ = ((tI_) % tn) * 64; _Pragma("unroll") for (int r = 0; r < 2; ++r) nx[r] = *(const f32x4*)(src + (size_t)(k0_ + (tid >> 4) + 32 * r) * ldn + n0_ + (tid & 15) * 4); }
    if ((int)blockIdx.x < ntiles) TT_LOAD((int)blockIdx.x)
    for (int tI = blockIdx.x; tI < ntiles; tI += gridDim.x) {
        const int k0 = (tI / tn) * 64, n0 = (tI % tn) * 64;
        const f32x4 c0 = nx[0], c1 = nx[1];
        if (tI + (int)gridDim.x < ntiles) TT_LOAD(tI + (int)gridDim.x)
#pragma unroll
        for (int r = 0; r < 2; ++r) {
            const int kk = (tid >> 4) + 32 * r, nn = (tid & 15) * 4;
            const f32x4 v = r == 0 ? c0 : c1;
            tile[kk * 65 + nn + 0] = v[0]; tile[kk * 65 + nn + 1] = v[1]; tile[kk * 65 + nn + 2] = v[2]; tile[kk * 65 + nn + 3] = v[3];
        }
        __syncthreads();
        {
            const int nn = tid >> 3, kk8 = (tid & 7) * 8;
            float f[8];
#pragma unroll
            for (int j = 0; j < 8; ++j) f[j] = tile[(kk8 + j) * 65 + nn];
            u32x4 w; w.x = pk_bf16(f[0], f[1]); w.y = pk_bf16(f[2], f[3]); w.z = pk_bf16(f[4], f[5]); w.w = pk_bf16(f[6], f[7]);
            const int nsrc = n0 + nn, nrow = nsrc < nperm ? (nsrc & ~127) + rot_pos(nsrc & 127) : nsrc;
            *(u32x4*)(dst + (size_t)nrow * K + k0 + kk8) = w;
        }
        __syncthreads();
    }
}
#undef TT_LOAD
__device__ __forceinline__ void convert_bf16(const float* src, bf16_t* dst, size_t n) {
    const size_t stride = (size_t)gridDim.x * 512 * 8;
    for (size_t i = ((size_t)blockIdx.x * 512 + threadIdx.x) * 8; i < n; i += stride) {
        const f32x4 a = *(const f32x4*)(src + i), b = *(const f32x4*)(src + i + 4);
        u32x4 w; w.x = pk_bf16(a[0], a[1]); w.y = pk_bf16(a[2], a[3]); w.z = pk_bf16(b[0], b[1]); w.w = pk_bf16(b[2], b[3]);
        *(u32x4*)(dst + i) = w;
    }
}
__device__ __forceinline__ void fold_peer_keys(LAS float* lds, const float* w_query, const float* sub_keys, bf16_t* WcT) {
    const int tid = threadIdx.x;
    LAS float* Ss = lds;
    LAS float* Ws = lds + 128 * 132;
    for (int item = blockIdx.x; item < 1024; item += gridDim.x) {
        const int l = item >> 9, rem = item & 511, hh = rem >> 5, kb = rem & 31, h = hh >> 1, half = hh & 1;
        const float* sk = sub_keys + (size_t)(((l * 2 + half) * 8 + h) * 128) * 128;
        const float* wq = w_query + (size_t)l * DM * DM + (size_t)(kb * 64) * DM + h * 256 + half * 128;
#pragma unroll
        for (int r = 0; r < 8; ++r) { const int idx = tid + 512 * r, key = idx >> 5, d4 = (idx & 31) * 4; *(LAS f32x4*)(Ss + key * 132 + d4) = *(const f32x4*)(sk + key * 128 + d4); }
#pragma unroll
        for (int r = 0; r < 4; ++r) { const int idx = tid + 512 * r, kin = idx >> 5, d4 = (idx & 31) * 4; *(LAS f32x4*)(Ws + kin * 128 + d4) = *(const f32x4*)(wq + (size_t)kin * DM + d4); }
        __syncthreads();
        const int key = tid & 127, kq = tid >> 7;
        float acc[16];
#pragma unroll
        for (int j = 0; j < 16; ++j) acc[j] = 0.f;
        for (int d4 = 0; d4 < 32; ++d4) {
            const f32x4 s4 = *(const LAS f32x4*)(Ss + key * 132 + d4 * 4);
#pragma unroll
            for (int j = 0; j < 16; ++j) { const f32x4 w4 = *(const LAS f32x4*)(Ws + (kq * 16 + j) * 128 + d4 * 4); acc[j] += s4[0] * w4[0] + s4[1] * w4[1] + s4[2] * w4[2] + s4[3] * w4[3]; }
        }
        bf16_t* o = WcT + (size_t)l * DM * DM + (size_t)(h * 256 + half * 128 + key) * DM + kb * 64 + kq * 16;
        u32x4 w0, w1;
        w0.x = pk_bf16(acc[0], acc[1]); w0.y = pk_bf16(acc[2], acc[3]); w0.z = pk_bf16(acc[4], acc[5]); w0.w = pk_bf16(acc[6], acc[7]);
        w1.x = pk_bf16(acc[8], acc[9]); w1.y = pk_bf16(acc[10], acc[11]); w1.z = pk_bf16(acc[12], acc[13]); w1.w = pk_bf16(acc[14], acc[15]);
        *(u32x4*)o = w0; *(u32x4*)(o + 8) = w1;
        __syncthreads();
    }
}

__device__ __forceinline__ void quant_rows(const float* src, unsigned char* dst, float* scl, int nrows) {
    const int lane = threadIdx.x & 63, gw = blockIdx.x * 8 + (threadIdx.x >> 6), nw = gridDim.x * 8;
    for (int row = gw; row < nrows; row += nw) {
        const float* p = src + (size_t)row * DM;
        f32x4 v[8];
#pragma unroll
        for (int i = 0; i < 2; ++i)
#pragma unroll
            for (int q = 0; q < 4; ++q) v[i * 4 + q] = *(const f32x4*)(p + 1024 * i + 16 * lane + 4 * q);
        float am = 0.f;
#pragma unroll
        for (int i = 0; i < 8; ++i) am = fmaxf(am, fmaxf(fmaxf(fabsf(v[i][0]), fabsf(v[i][1])), fmaxf(fabsf(v[i][2]), fabsf(v[i][3]))));
        am = fmaxf(wave_max(am), 1e-30f);
        const float inv = 127.0f / am;
        if (lane == 0) scl[row] = am * (1.0f / 127.0f);
#pragma unroll
        for (int i = 0; i < 2; ++i) {
            u32x4 w;
#pragma unroll
            for (int q = 0; q < 4; ++q) {
                const f32x4 t = v[i * 4 + q];
                const unsigned b0 = (unsigned)(int)(rintf(t[0] * inv) + 128.0f), b1 = (unsigned)(int)(rintf(t[1] * inv) + 128.0f), b2 = (unsigned)(int)(rintf(t[2] * inv) + 128.0f), b3 = (unsigned)(int)(rintf(t[3] * inv) + 128.0f);
                w[q] = b0 | (b1 << 8) | (b2 << 16) | (b3 << 24);
            }
            *(u32x4*)(dst + (size_t)row * DM + 1024 * i + 16 * lane) = w;
        }
    }
}
__device__ __forceinline__ void phase_prep(const Args& a, LAS unsigned char* lds) {
    unsigned char* ws = a.ws;
    LAS float* tile = (LAS float*)lds;
    transpose_tiles(tile, a.in[1], 4 * DM, DM, 4 * DM, (bf16_t*)(ws + WS_WIN));
    transpose_tiles(tile, a.in[3], DM, DM, DM, (bf16_t*)(ws + WS_WOUT));
    transpose_tiles(tile, a.in[5], 2 * DM, DM, 2 * DM, (bf16_t*)(ws + WS_WKVQ), DM);
    transpose_tiles(tile, a.in[6], DM, DM, DM, (bf16_t*)(ws + WS_WKVQ) + (size_t)2 * DM * DM, DM);
    transpose_tiles(tile, a.in[7], DM, DM, DM, (bf16_t*)(ws + WS_WO));
    fold_peer_keys((LAS float*)lds, a.in[8], a.in[9], (bf16_t*)(ws + WS_WC));
    convert_bf16(a.in[0], (bf16_t*)(ws + slot(0)), (size_t)MTOK * DM);
    const int gtid = blockIdx.x * 512 + threadIdx.x, gthreads = gridDim.x * 512;
    float* COS = (float*)(ws + WS_COS); float* SIN = (float*)(ws + WS_SIN); float* LB = (float*)(ws + WS_LB);
    for (int i = gtid; i < SEQ * 64; i += gthreads) {
        const int pos = i >> 6, j = i & 63;
        double inv = 1.0; const double r = 0.86596432336006535;
        for (int q = 0; q < j; ++q) inv *= r;
        const float ang = (float)pos * (float)inv;
        const double x = (double)ang;
        const double n = __builtin_rint(x * 0.15915494309189535);
        const float rf = (float)__builtin_fma(-n, 6.283185307179586, x);
        COS[i] = cosf(rf); SIN[i] = sinf(rf);
    }
    for (int c = gtid; c < DM; c += gthreads) { const float l0 = a.in[4][c], l1 = a.in[4][DM + c]; LB[c] = 1.0f / (1.0f + expf(l1 - l0)); }
}

__device__ __forceinline__ void phase_scan_naive(const bf16_t* Q1, const float* LF, const bf16_t* I1, float* O) {
    const int lane = threadIdx.x & 63, gw = blockIdx.x * 8 + (threadIdx.x >> 6), nw = gridDim.x * 8;
    for (int item = gw; item < 2 * NHEAD * 128; item += nw) {
        const int bh = item >> 7, v = item & 127, b = bh >> 4, h = bh & 15;
        const size_t base = (size_t)b * SEQ * DM + h * 128;
        float S0 = 0.f, S1 = 0.f;
#pragma unroll 4
        for (int t = 0; t < SEQ; ++t) {
            const size_t ro = base + (size_t)t * DM;
            const float f0 = __expf(LF[ro + lane]), f1 = __expf(LF[ro + 64 + lane]);
            const float q0 = bf2f(Q1[ro + lane]), q1 = bf2f(Q1[ro + 64 + lane]);
            const float iv = bf2f(I1[ro + v]);
            S0 = f0 * S0 + (1.0f - f0) * iv; S1 = f1 * S1 + (1.0f - f1) * iv;
            const float p = wave_sum(q0 * S0 + q1 * S1);
            if (lane == 0) O[ro + v] = p;
        }
    }
}
__device__ __forceinline__ void phase_onorm(const float* O, const bf16_t* G1, const float* gnorm, bf16_t* OG) {
    const int lane = threadIdx.x & 63, gw = blockIdx.x * 8 + (threadIdx.x >> 6), nw = gridDim.x * 8;
    const float gn0 = gnorm[2 * lane], gn1 = gnorm[2 * lane + 1];
    for (int item = gw; item < MTOK * NHEAD; item += nw) {
        const size_t off = (size_t)item * 128 + 2 * lane;
        const float o0 = O[off], o1 = O[off + 1];
        const float ss = wave_sum(o0 * o0 + o1 * o1);
        const float r = rsqrtf(ss * (1.0f / 128.0f) + 1e-6f);
        const unsigned g = *(const unsigned*)(G1 + off);
        *(unsigned*)(OG + off) = pk_bf16(o0 * r * gn0 * bflo(g), o1 * r * gn1 * bfhi(g));
    }
}

__device__ __forceinline__ void ln_row_store(float (&v)[32], const float* g, const float* bta, float* outf, bf16_t* outb, int lane, signed char* outq = nullptr, float* outs = nullptr) {
    float s = 0.f;
#pragma unroll
    for (int i = 0; i < 32; ++i) s += v[i];
    const float mu = wave_sum(s) * (1.0f / DM);
    float q = 0.f;
#pragma unroll
    for (int i = 0; i < 32; ++i) { v[i] -= mu; q += v[i] * v[i]; }
    const float rstd = rsqrtf(wave_sum(q) * (1.0f / DM) + 1e-5f);
    float am = 0.f;
#pragma unroll
    for (int i = 0; i < 4; ++i) {
        const int c = 512 * i + 8 * lane;
        const f32x4 g0 = *(const f32x4*)(g + c), g1 = *(const f32x4*)(g + c + 4), b0 = *(const f32x4*)(bta + c), b1 = *(const f32x4*)(bta + c + 4);
        f32x4 o0, o1;
#pragma unroll
        for (int j = 0; j < 4; ++j) { o0[j] = v[i * 8 + j] * rstd * g0[j] + b0[j]; o1[j] = v[i * 8 + 4 + j] * rstd * g1[j] + b1[j]; v[i * 8 + j] = o0[j]; v[i * 8 + 4 + j] = o1[j]; am = fmaxf(am, fmaxf(fabsf(o0[j]), fabsf(o1[j]))); }
        if (outf) { *(f32x4*)(outf + c) = o0; *(f32x4*)(outf + c + 4) = o1; }
        if (outb) { u32x4 w; w.x = pk_bf16(o0[0], o0[1]); w.y = pk_bf16(o0[2], o0[3]); w.z = pk_bf16(o1[0], o1[1]); w.w = pk_bf16(o1[2], o1[3]); *(u32x4*)(outb + c) = w; }
    }
    if (outq) {
        am = fmaxf(wave_max(am), 1e-30f);
        const float inv = 127.0f / am;
        if (lane == 0) *outs = am * (1.0f / 127.0f);
#pragma unroll
        for (int i = 0; i < 4; ++i) {
            u32x2 w;
            w.x = ((unsigned)(int)rintf(v[i * 8 + 0] * inv) & 0xffu) | (((unsigned)(int)rintf(v[i * 8 + 1] * inv) & 0xffu) << 8) | (((unsigned)(int)rintf(v[i * 8 + 2] * inv) & 0xffu) << 16) | (((unsigned)(int)rintf(v[i * 8 + 3] * inv) & 0xffu) << 24);
            w.y = ((unsigned)(int)rintf(v[i * 8 + 4] * inv) & 0xffu) | (((unsigned)(int)rintf(v[i * 8 + 5] * inv) & 0xffu) << 8) | (((unsigned)(int)rintf(v[i * 8 + 6] * inv) & 0xffu) << 16) | (((unsigned)(int)rintf(v[i * 8 + 7] * inv) & 0xffu) << 24);
            *(u32x2*)(outq + 512 * i + 8 * lane) = w;
        }
    }
}
__device__ __forceinline__ void ln_row_store16(float (&v)[32], const float* g, const float* bta, float* outf, bf16_t* outb, int lane) {
    float s = 0.f;
#pragma unroll
    for (int i = 0; i < 32; ++i) s += v[i];
    const float mu = wave_sum(s) * (1.0f / DM);
    float q = 0.f;
#pragma unroll
    for (int i = 0; i < 32; ++i) { v[i] -= mu; q += v[i] * v[i]; }
    const float rstd = rsqrtf(wave_sum(q) * (1.0f / DM) + 1e-5f);
#pragma unroll
    for (int i = 0; i < 2; ++i) {
        const int c = 1024 * i + 16 * lane;
        f32x4 o[4];
#pragma unroll
        for (int qd = 0; qd < 4; ++qd) {
            const f32x4 gg = *(const f32x4*)(g + c + 4 * qd), bb = *(const f32x4*)(bta + c + 4 * qd);
#pragma unroll
            for (int j = 0; j < 4; ++j) o[qd][j] = v[16 * i + 4 * qd + j] * rstd * gg[j] + bb[j];
            *(f32x4*)(outf + c + 4 * qd) = o[qd];
        }
        if (outb) {
            u32x4 w0, w1;
            w0.x = pk_bf16(o[0][0], o[0][1]); w0.y = pk_bf16(o[0][2], o[0][3]); w0.z = pk_bf16(o[1][0], o[1][1]); w0.w = pk_bf16(o[1][2], o[1][3]);
            w1.x = pk_bf16(o[2][0], o[2][1]); w1.y = pk_bf16(o[2][2], o[2][3]); w1.z = pk_bf16(o[3][0], o[3][1]); w1.w = pk_bf16(o[3][2], o[3][3]);
            *(u32x4*)(outb + c) = w0; *(u32x4*)(outb + c + 8) = w1;
        }
    }
}
template <bool RES16> __device__ __forceinline__ void phase_ln(const bf16_t* Y, const void* RESv, const float* g, const float* bta, float* outf, bf16_t* outb, signed char* outq = nullptr, float* outs = nullptr) {
    const int lane = threadIdx.x & 63, gw = blockIdx.x * 8 + (threadIdx.x >> 6), nw = gridDim.x * 8;
    for (int row = gw; row < MTOK; row += nw) {
        float v[32];
        const bf16_t* p = Y + (size_t)row * DM;
#pragma unroll
        for (int i = 0; i < 4; ++i) {
            const u32x4 yw = *(const u32x4*)(p + 512 * i + 8 * lane);
            const f32x4 a = {bflo(yw.x), bfhi(yw.x), bflo(yw.y), bfhi(yw.y)}, b = {bflo(yw.z), bfhi(yw.z), bflo(yw.w), bfhi(yw.w)};
            f32x4 ra, rb;
            if (RES16) { const u32x4 w = *(const u32x4*)((const bf16_t*)RESv + (size_t)row * DM + 512 * i + 8 * lane); ra = (f32x4){bflo(w.x), bfhi(w.x), bflo(w.y), bfhi(w.y)}; rb = (f32x4){bflo(w.z), bfhi(w.z), bflo(w.w), bfhi(w.w)}; }
            else { const float* rp = (const float*)RESv + (size_t)row * DM; ra = *(const f32x4*)(rp + 512 * i + 8 * lane); rb = *(const f32x4*)(rp + 512 * i + 8 * lane + 4); }
#pragma unroll
            for (int j = 0; j < 4; ++j) { v[i * 8 + j] = a[j] + ALPHA * ra[j]; v[i * 8 + 4 + j] = b[j] + ALPHA * rb[j]; }
        }
        ln_row_store(v, g, bta, outf ? outf + (size_t)row * DM : nullptr, outb ? outb + (size_t)row * DM : nullptr, lane, outq ? outq + (size_t)row * DM : nullptr, outs ? outs + row : nullptr);
    }
}

__device__ __forceinline__ void wave_argmax(float& v, int& idx) {
#pragma unroll
    for (int o = 32; o >= 1; o >>= 1) {
        const float ov = __shfl_xor(v, o); const int oi = __shfl_xor(idx, o);
        if (ov > v || (ov == v && oi < idx)) { v = ov; idx = oi; }
    }
}
__device__ __forceinline__ unsigned fkey(float x) { const unsigned u = __float_as_uint(x); return u ^ (unsigned)(((int)u >> 31) | 0x80000000); }
__device__ __forceinline__ float funkey(unsigned k) { const unsigned u = (k & 0x80000000u) ? (k ^ 0x80000000u) : ~k; return __uint_as_float(u); }
__device__ __forceinline__ void sort16_insert(unsigned (&r)[16], unsigned v) {
#pragma unroll
    for (int i = 0; i < 16; ++i) { const unsigned m = r[i] > v ? r[i] : v; v = r[i] > v ? v : r[i]; r[i] = m; }
}
__device__ __forceinline__ void phase_topk(LAS unsigned char* lds, const float* SCT, int* EID, float* GATE) {
    LAS unsigned char* ib = lds + threadIdx.x * 32;
    for (int item = blockIdx.x * 512 + threadIdx.x; item < MTOK * 8; item += gridDim.x * 512) {
        const int h = item >> 14, tok = item & (MTOK - 1);
        const float* p = SCT + (size_t)(h * 256) * MTOK + tok;
        unsigned r1[16], r2[16];
#pragma unroll
        for (int i = 0; i < 16; ++i) { r1[i] = 0u; r2[i] = 0u; }
#pragma unroll 8
        for (int e = 0; e < 128; ++e) {
            const float x1 = p[(size_t)e * MTOK], x2 = p[(size_t)(128 + e) * MTOK];
            sort16_insert(r1, (fkey(x1) & ~0x7Fu) | (unsigned)e);
            sort16_insert(r2, (fkey(x2) & ~0x7Fu) | (unsigned)e);
        }
        float v1[16], v2[16];
#pragma unroll
        for (int i = 0; i < 16; ++i) { v1[i] = funkey(r1[i] & ~0x7Fu); v2[i] = funkey(r2[i] & ~0x7Fu); ib[i] = (unsigned char)(r1[i] & 0x7Fu); ib[16 + i] = (unsigned char)(r2[i] & 0x7Fu); }
        unsigned r3[16];
#pragma unroll
        for (int i = 0; i < 16; ++i) r3[i] = 0u;
#pragma unroll
        for (int a = 0; a < 16; ++a)
#pragma unroll
            for (int bq = 0; bq < 16; ++bq)
                if ((a + 1) * (bq + 1) <= 16) sort16_insert(r3, (fkey(v1[a] + v2[bq]) & ~0xFFu) | (unsigned)(a * 16 + bq));
        const float mx = funkey(r3[0] & ~0xFFu);
        float ev[16]; float sum = 0.f;
#pragma unroll
        for (int i = 0; i < 16; ++i) { ev[i] = __expf(funkey(r3[i] & ~0xFFu) - mx); sum += ev[i]; }
        const float rs = 1.0f / sum;
        int eid[16];
#pragma unroll
        for (int i = 0; i < 16; ++i) { const unsigned f = r3[i] & 0xFFu; eid[i] = (int)ib[f >> 4] * 128 + (int)ib[16 + (f & 15u)]; }
        int* eo = EID + (size_t)tok * 128 + h * 16; float* go = GATE + (size_t)tok * 128 + h * 16;
#pragma unroll
        for (int q = 0; q < 4; ++q) {
            *(u32x4*)(eo + 4 * q) = (u32x4){(unsigned)eid[4 * q], (unsigned)eid[4 * q + 1], (unsigned)eid[4 * q + 2], (unsigned)eid[4 * q + 3]};
            *(f32x4*)(go + 4 * q) = (f32x4){ev[4 * q] * rs, ev[4 * q + 1] * rs, ev[4 * q + 2] * rs, ev[4 * q + 3] * rs};
        }
    }
}

__device__ __forceinline__ float gelu_erf(float x) { return 0.5f * x * (1.0f + erff(x * 0.70710678118654752f)); }
__device__ __forceinline__ float ub0(unsigned w) { return (float)(w & 0xffu); }
__device__ __forceinline__ float ub1(unsigned w) { return (float)((w >> 8) & 0xffu); }
__device__ __forceinline__ float ub2(unsigned w) { return (float)((w >> 16) & 0xffu); }
__device__ __forceinline__ float ub3(unsigned w) { return (float)(w >> 24); }
__device__ __forceinline__ void phase_peer(LAS unsigned char* lds, const float* X, const int* EID, const float* GATE, const unsigned char* U, const unsigned char* V, const float* USC, const float* VSC,
                                           const float* g, const float* bta, float* outf, bf16_t* outb) {
    const int lane = threadIdx.x & 63, wv = threadIdx.x >> 6, gw = blockIdx.x * 8 + wv, nw = gridDim.x * 8;
    LAS float* hb = (LAS float*)(lds + wv * 512);
    for (int tok = gw; tok < MTOK; tok += nw) {
        float x[32];
        const float* xp = X + (size_t)tok * DM;
#pragma unroll
        for (int i = 0; i < 2; ++i)
#pragma unroll
            for (int q = 0; q < 4; ++q) { const f32x4 t = *(const f32x4*)(xp + 1024 * i + 16 * lane + 4 * q); x[16 * i + 4 * q] = t[0]; x[16 * i + 4 * q + 1] = t[1]; x[16 * i + 4 * q + 2] = t[2]; x[16 * i + 4 * q + 3] = t[3]; }
        float sx = 0.f;
#pragma unroll
        for (int j = 0; j < 32; ++j) sx += x[j];
        const float d0 = -128.0f * sx;
        const int e0 = EID[(size_t)tok * 128 + lane], e1 = EID[(size_t)tok * 128 + 64 + lane];
        const float g0 = GATE[(size_t)tok * 128 + lane], g1 = GATE[(size_t)tok * 128 + 64 + lane];
        for (int bt = 0; bt < 16; ++bt) {
            float d[8];
#pragma unroll
            for (int r = 0; r < 8; ++r) {
                const int e = bt * 8 + r;
                const int idx = __builtin_amdgcn_readfirstlane(__shfl(bt < 8 ? e0 : e1, e & 63));
                const u32x4* up = (const u32x4*)(U + (size_t)idx * DM) + lane;
                float acc = d0;
#pragma unroll
                for (int i = 0; i < 2; ++i) {
                    const u32x4 w = up[i * 64];
                    acc += x[16 * i + 0] * ub0(w.x) + x[16 * i + 1] * ub1(w.x) + x[16 * i + 2] * ub2(w.x) + x[16 * i + 3] * ub3(w.x)
                         + x[16 * i + 4] * ub0(w.y) + x[16 * i + 5] * ub1(w.y) + x[16 * i + 6] * ub2(w.y) + x[16 * i + 7] * ub3(w.y)
                         + x[16 * i + 8] * ub0(w.z) + x[16 * i + 9] * ub1(w.z) + x[16 * i + 10] * ub2(w.z) + x[16 * i + 11] * ub3(w.z)
                         + x[16 * i + 12] * ub0(w.w) + x[16 * i + 13] * ub1(w.w) + x[16 * i + 14] * ub2(w.w) + x[16 * i + 15] * ub3(w.w);
                }
                d[r] = acc;
            }
            const bool b5 = lane & 32, b4 = lane & 16, b3 = lane & 8;
            float t4[4];
#pragma unroll
            for (int q = 0; q < 4; ++q) { const float keep = b5 ? d[4 + q] : d[q], send = b5 ? d[q] : d[4 + q]; t4[q] = keep + __shfl_xor(send, 32); }
            float t2[2];
#pragma unroll
            for (int q = 0; q < 2; ++q) { const float keep = b4 ? t4[2 + q] : t4[q], send = b4 ? t4[q] : t4[2 + q]; t2[q] = keep + __shfl_xor(send, 16); }
            float t1;
            { const float keep = b3 ? t2[1] : t2[0], send = b3 ? t2[0] : t2[1]; t1 = keep + __shfl_xor(send, 8); }
            t1 += __shfl_xor(t1, 4); t1 += __shfl_xor(t1, 2); t1 += __shfl_xor(t1, 1);
            if ((lane & 7) == 0) hb[bt * 8 + (lane >> 3 & 1) + 2 * (lane >> 4 & 1) + 4 * (lane >> 5 & 1)] = t1;
        }
        asm volatile("s_waitcnt lgkmcnt(0)" ::: "memory");
        const float h0 = hb[lane] * USC[e0], h1 = hb[64 + lane] * USC[e1];
        const float w0 = g0 * gelu_erf(h0) * VSC[e0], w1 = g1 * gelu_erf(h1) * VSC[e1];
        float wsum = wave_sum(w0 + w1);
        float y[32];
#pragma unroll
        for (int i = 0; i < 32; ++i) y[i] = 0.f;
#pragma unroll 8
        for (int e = 0; e < 128; ++e) {
            const int idx = __builtin_amdgcn_readfirstlane(__shfl(e < 64 ? e0 : e1, e & 63));
            const float wt = __shfl(e < 64 ? w0 : w1, e & 63);
            const u32x4* vp = (const u32x4*)(V + (size_t)idx * DM) + lane;
#pragma unroll
            for (int i = 0; i < 2; ++i) {
                const u32x4 w = vp[i * 64];
                y[16 * i + 0] += wt * ub0(w.x); y[16 * i + 1] += wt * ub1(w.x); y[16 * i + 2] += wt * ub2(w.x); y[16 * i + 3] += wt * ub3(w.x);
                y[16 * i + 4] += wt * ub0(w.y); y[16 * i + 5] += wt * ub1(w.y); y[16 * i + 6] += wt * ub2(w.y); y[16 * i + 7] += wt * ub3(w.y);
                y[16 * i + 8] += wt * ub0(w.z); y[16 * i + 9] += wt * ub1(w.z); y[16 * i + 10] += wt * ub2(w.z); y[16 * i + 11] += wt * ub3(w.z);
                y[16 * i + 12] += wt * ub0(w.w); y[16 * i + 13] += wt * ub1(w.w); y[16 * i + 14] += wt * ub2(w.w); y[16 * i + 15] += wt * ub3(w.w);
            }
        }
        const float corr = -128.0f * wsum;
#pragma unroll
        for (int i = 0; i < 32; ++i) y[i] = y[i] + corr + ALPHA * x[i];
        ln_row_store16(y, g, bta, outf + (size_t)tok * DM, outb ? outb + (size_t)tok * DM : nullptr, lane);
        asm volatile("s_waitcnt lgkmcnt(0)" ::: "memory");
    }
}

__device__ __forceinline__ int row_dot_i8(const u32x4 (&xq)[2], const unsigned char* rowp, int lane) {
    const u32x4* up = (const u32x4*)rowp + lane;
    int acc = 0;
#pragma unroll
    for (int i = 0; i < 2; ++i) {
        const u32x4 w = up[i * 64];
        acc = __builtin_amdgcn_sdot4((int)xq[i].x, (int)(w.x ^ 0x80808080u), acc, false); acc = __builtin_amdgcn_sdot4((int)xq[i].y, (int)(w.y ^ 0x80808080u), acc, false);
        acc = __builtin_amdgcn_sdot4((int)xq[i].z, (int)(w.z ^ 0x80808080u), acc, false); acc = __builtin_amdgcn_sdot4((int)xq[i].w, (int)(w.w ^ 0x80808080u), acc, false);
    }
    return acc;
}
__device__ __forceinline__ void peer_issue8(u32x4 (&seg)[8], const unsigned char* base, const u32x4 ia, const u32x4 ib) {
    seg[0] = *(const u32x4*)(base + (size_t)ia.x * DM); seg[1] = *(const u32x4*)(base + (size_t)ia.y * DM); seg[2] = *(const u32x4*)(base + (size_t)ia.z * DM); seg[3] = *(const u32x4*)(base + (size_t)ia.w * DM);
    seg[4] = *(const u32x4*)(base + (size_t)ib.x * DM); seg[5] = *(const u32x4*)(base + (size_t)ib.y * DM); seg[6] = *(const u32x4*)(base + (size_t)ib.z * DM); seg[7] = *(const u32x4*)(base + (size_t)ib.w * DM);
}
__device__ __forceinline__ void peer_dot8(int (&d)[8], const u32x4 (&seg)[8], const u32x4 xq) {
#pragma unroll
    for (int i = 0; i < 8; ++i) {
        int acc = __builtin_amdgcn_sdot4((int)xq.x, (int)(seg[i].x ^ 0x80808080u), 0, false);
        acc = __builtin_amdgcn_sdot4((int)xq.y, (int)(seg[i].y ^ 0x80808080u), acc, false);
        acc = __builtin_amdgcn_sdot4((int)xq.z, (int)(seg[i].z ^ 0x80808080u), acc, false);
        d[i] = __builtin_amdgcn_sdot4((int)xq.w, (int)(seg[i].w ^ 0x80808080u), acc, false);
    }
}
__device__ __forceinline__ void phase_peer_u(const signed char* XQ, const int* EID, const unsigned char* U, LAS int* HL  ) {
    const int lane = threadIdx.x & 63, wv = threadIdx.x >> 6, es = lane >> 3, cc = lane & 7;
    const bool b2 = cc & 4, b1 = cc & 2, b0 = cc & 1;
    const int nw = gridDim.x * 8, gw = blockIdx.x * 8 + wv, tpw = (MTOK + nw - 1) / nw, tbase = gw * tpw;
    int cnt = MTOK - tbase; cnt = cnt > tpw ? tpw : cnt;
    if (cnt <= 0) return;
    for (int i = lane; i < cnt * 128; i += 64) HL[i] = 0;
    asm volatile("s_waitcnt lgkmcnt(0)" ::: "memory");
    const int nit = 16 * cnt;
    const unsigned char* ub = U + cc * 16;
    u32x4 m0a, m0b, m0c, m0d, m0x, m1a, m1b, m1c, m1d, m1x, m2a, m2b, m2c, m2d, m2x; u32x4 sA[8], sB[8];
#define PU_LOAD(sl_, k_, A_, B_, C_, D_, X_) { const int* ep_ = EID + (size_t)(tbase + (k_)) * 128 + es * 16; A_ = *(const u32x4*)ep_; B_ = *(const u32x4*)(ep_ + 4); C_ = *(const u32x4*)(ep_ + 8); D_ = *(const u32x4*)(ep_ + 12); \
        X_ = *(const u32x4*)(XQ + (size_t)(tbase + (k_)) * DM + (sl_) * 128 + cc * 16); }
#define PU_NEXT(sl_, k_, sn_, kn_) { kn_ = (k_) + 1; sn_ = (sl_); if (kn_ == cnt) { kn_ = 0; ++sn_; } if (sn_ == 16) { sn_ = 15; kn_ = cnt - 1; } }
    int sl = 0, k = 0, sl1, k1, sl2, k2;
    PU_NEXT(sl, k, sl1, k1) PU_NEXT(sl1, k1, sl2, k2)
    PU_LOAD(sl, k, m0a, m0b, m0c, m0d, m0x)
    PU_LOAD(sl1, k1, m1a, m1b, m1c, m1d, m1x)
    peer_issue8(sA, ub + sl * 128, m0a, m0b);
    for (int it = 0; it < nit; ++it) {
        PU_LOAD(sl2, k2, m2a, m2b, m2c, m2d, m2x)
        peer_issue8(sB, ub + sl * 128, m0c, m0d);
        int dlo[8]; peer_dot8(dlo, sA, m0x);
        peer_issue8(sA, ub + sl1 * 128, m1a, m1b);
        int dhi[8]; peer_dot8(dhi, sB, m0x);
        int t8[8], t4[4], t2[2];
#pragma unroll
        for (int q = 0; q < 8; ++q) { const int keep = b2 ? dhi[q] : dlo[q], send = b2 ? dlo[q] : dhi[q]; t8[q] = keep + __shfl_xor(send, 4); }
#pragma unroll
        for (int q = 0; q < 4; ++q) { const int keep = b1 ? t8[4 + q] : t8[q], send = b1 ? t8[q] : t8[4 + q]; t4[q] = keep + __shfl_xor(send, 2); }
#pragma unroll
        for (int q = 0; q < 2; ++q) { const int keep = b0 ? t4[2 + q] : t4[q], send = b0 ? t4[q] : t4[2 + q]; t2[q] = keep + __shfl_xor(send, 1); }
        { LAS int* hp = HL + k * 128 + es * 16 + (b2 ? 8 : 0) + (b1 ? 4 : 0) + (b0 ? 2 : 0);
          __hip_atomic_fetch_add(hp, t2[0], __ATOMIC_RELAXED, __HIP_MEMORY_SCOPE_WORKGROUP); __hip_atomic_fetch_add(hp + 1, t2[1], __ATOMIC_RELAXED, __HIP_MEMORY_SCOPE_WORKGROUP); }
        sl = sl1; k = k1; sl1 = sl2; k1 = k2; PU_NEXT(sl1, k1, sl2, k2)
        m0a = m1a; m0b = m1b; m0c = m1c; m0d = m1d; m0x = m1x; m1a = m2a; m1b = m2b; m1c = m2c; m1d = m2d; m1x = m2x;
    }
#undef PU_LOAD
#undef PU_NEXT
}
__device__ __forceinline__ void phase_peer_w(const LAS int* HL, const float* XS, const int* EID, const float* GATE, const float* USC, const float* VSC, float* W, float* CS) {
    const int lane = threadIdx.x & 63, gw = blockIdx.x * 8 + (threadIdx.x >> 6), nw = gridDim.x * 8, tpw = (MTOK + nw - 1) / nw, tbase = gw * tpw;
    const int tend = tbase + tpw < MTOK ? tbase + tpw : MTOK;
    for (int tok = tbase; tok < tend; ++tok) {
        const int h0 = HL[(tok - tbase) * 128 + lane], h1 = HL[(tok - tbase) * 128 + 64 + lane];
        const int e0 = EID[(size_t)tok * 128 + lane], e1 = EID[(size_t)tok * 128 + 64 + lane];
        const float xs = XS[tok];
        const float w0 = GATE[(size_t)tok * 128 + lane] * gelu_erf((float)h0 * xs * USC[e0]) * VSC[e0];
        const float w1 = GATE[(size_t)tok * 128 + 64 + lane] * gelu_erf((float)h1 * xs * USC[e1]) * VSC[e1];
        W[(size_t)tok * 128 + lane] = w0; W[(size_t)tok * 128 + 64 + lane] = w1;
        const float cs = wave_sum(w0 + w1);
        if (lane == 0) CS[tok] = cs;
    }
}
__device__ __forceinline__ void peer_fma8(f32x2_t (&ya)[8], const u32x4 (&seg)[8], const f32x4 wa, const f32x4 wb2) {
#pragma unroll
    for (int i = 0; i < 8; ++i) {
        const float wt = i < 4 ? wa[i & 3] : wb2[i & 3];
        const f32x2_t wt2 = {wt, wt};
        const u32x4 w = seg[i];
        ya[0] = __builtin_elementwise_fma(wt2, (f32x2_t){ub0(w.x), ub1(w.x)}, ya[0]); ya[1] = __builtin_elementwise_fma(wt2, (f32x2_t){ub2(w.x), ub3(w.x)}, ya[1]);
        ya[2] = __builtin_elementwise_fma(wt2, (f32x2_t){ub0(w.y), ub1(w.y)}, ya[2]); ya[3] = __builtin_elementwise_fma(wt2, (f32x2_t){ub2(w.y), ub3(w.y)}, ya[3]);
        ya[4] = __builtin_elementwise_fma(wt2, (f32x2_t){ub0(w.z), ub1(w.z)}, ya[4]); ya[5] = __builtin_elementwise_fma(wt2, (f32x2_t){ub2(w.z), ub3(w.z)}, ya[5]);
        ya[6] = __builtin_elementwise_fma(wt2, (f32x2_t){ub0(w.w), ub1(w.w)}, ya[6]); ya[7] = __builtin_elementwise_fma(wt2, (f32x2_t){ub2(w.w), ub3(w.w)}, ya[7]);
    }
}
__device__ __forceinline__ void phase_peer_v(const bf16_t* X, const int* EID, const float* W, const float* CS, const unsigned char* V, float* Y) {
    const int lane = threadIdx.x & 63, wv = threadIdx.x >> 6, es = lane >> 3, cc = lane & 7;
    const bool b5 = lane & 32, b4 = lane & 16, b3 = lane & 8;
    const int nw = gridDim.x * 8, gw = blockIdx.x * 8 + wv, tpw = (MTOK + nw - 1) / nw, tbase = gw * tpw;
    int cnt = MTOK - tbase; cnt = cnt > tpw ? tpw : cnt;
    if (cnt <= 0) return;
    const int nit = 16 * cnt;
    const unsigned char* vb = V + cc * 16;
    const int colo = cc * 16 + (b5 ? 8 : 0) + (b4 ? 4 : 0) + (b3 ? 2 : 0);
    u32x4 m0c, m0d, m1a, m1b, m1c, m1d, m2a, m2b, m2c, m2d; f32x4 w0a, w0b, w0c, w0d, w1a, w1b, w1c, w1d; f32x2_t x0, x1; float c0, c1; u32x4 sA[8], sB[8];
#define PV_IDS(k_, A_, B_, C_, D_) { const size_t o_ = (size_t)(tbase + (k_)) * 128 + es * 16; A_ = *(const u32x4*)(EID + o_); B_ = *(const u32x4*)(EID + o_ + 4); C_ = *(const u32x4*)(EID + o_ + 8); D_ = *(const u32x4*)(EID + o_ + 12); }
#define PV_WX(sl_, k_, WA_, WB_, WC_, WD_, X_, CS_) { const size_t o_ = (size_t)(tbase + (k_)) * 128 + es * 16; \
        WA_ = *(const f32x4*)(W + o_); WB_ = *(const f32x4*)(W + o_ + 4); WC_ = *(const f32x4*)(W + o_ + 8); WD_ = *(const f32x4*)(W + o_ + 12); \
        { const unsigned xw_ = *(const unsigned*)(X + (size_t)(tbase + (k_)) * DM + (sl_) * 128 + colo); X_ = (f32x2_t){bflo(xw_), bfhi(xw_)}; } CS_ = CS[tbase + (k_)]; }
#define PV_NEXT(sl_, k_, sn_, kn_) { kn_ = (k_) + 1; sn_ = (sl_); if (kn_ == cnt) { kn_ = 0; ++sn_; } if (sn_ == 16) { sn_ = 15; kn_ = cnt - 1; } }
    int sl = 0, k = 0, sl1, k1, sl2, k2;
    PV_NEXT(sl, k, sl1, k1) PV_NEXT(sl1, k1, sl2, k2)
    { u32x4 ta, tb; PV_IDS(k, ta, tb, m0c, m0d) PV_IDS(k1, m1a, m1b, m1c, m1d)
      PV_WX(sl, k, w0a, w0b, w0c, w0d, x0, c0)
      peer_issue8(sA, vb + sl * 128, ta, tb); }
    for (int it = 0; it < nit; ++it) {
        PV_IDS(k2, m2a, m2b, m2c, m2d)
        peer_issue8(sB, vb + sl * 128, m0c, m0d);
        f32x2_t ya[8];
#pragma unroll
        for (int j = 0; j < 8; ++j) ya[j] = (f32x2_t){0.f, 0.f};
        peer_fma8(ya, sA, w0a, w0b);
        peer_issue8(sA, vb + sl1 * 128, m1a, m1b);
        PV_WX(sl1, k1, w1a, w1b, w1c, w1d, x1, c1)
        peer_fma8(ya, sB, w0c, w0d);
        f32x2_t t4[4], t2[2], t1;
#pragma unroll
        for (int q = 0; q < 4; ++q) { const f32x2_t keep = b5 ? ya[4 + q] : ya[q], send = b5 ? ya[q] : ya[4 + q]; t4[q][0] = keep[0] + __shfl_xor(send[0], 32); t4[q][1] = keep[1] + __shfl_xor(send[1], 32); }
#pragma unroll
        for (int q = 0; q < 2; ++q) { const f32x2_t keep = b4 ? t4[2 + q] : t4[q], send = b4 ? t4[q] : t4[2 + q]; t2[q][0] = keep[0] + __shfl_xor(send[0], 16); t2[q][1] = keep[1] + __shfl_xor(send[1], 16); }
        { const f32x2_t keep = b3 ? t2[1] : t2[0], send = b3 ? t2[0] : t2[1]; t1[0] = keep[0] + __shfl_xor(send[0], 8); t1[1] = keep[1] + __shfl_xor(send[1], 8); }
        f32x2_t o; o[0] = t1[0] - 128.0f * c0 + ALPHA * x0[0]; o[1] = t1[1] - 128.0f * c0 + ALPHA * x0[1];
        *(f32x2_t*)(Y + (size_t)(tbase + k) * DM + sl * 128 + colo) = o;
        sl = sl1; k = k1; sl1 = sl2; k1 = k2; PV_NEXT(sl1, k1, sl2, k2)
        m0c = m1c; m0d = m1d; m1a = m2a; m1b = m2b; m1c = m2c; m1d = m2d;
        w0a = w1a; w0b = w1b; w0c = w1c; w0d = w1d; x0 = x1; c0 = c1;
    }
#undef PV_IDS
#undef PV_WX
#undef PV_NEXT
}

__device__ __forceinline__ void rot8(const u32x4 lo, const u32x4 hi, const f32x4 c0, const f32x4 c1, const f32x4 s0, const f32x4 s1, float (&o1)[8], float (&o2)[8]) {
    const float a[8] = {bflo(lo.x), bfhi(lo.x), bflo(lo.y), bfhi(lo.y), bflo(lo.z), bfhi(lo.z), bflo(lo.w), bfhi(lo.w)};
    const float b[8] = {bflo(hi.x), bfhi(hi.x), bflo(hi.y), bfhi(hi.y), bflo(hi.z), bfhi(hi.z), bflo(hi.w), bfhi(hi.w)};
    const float c[8] = {c0[0], c0[1], c0[2], c0[3], c1[0], c1[1], c1[2], c1[3]}, sn[8] = {s0[0], s0[1], s0[2], s0[3], s1[0], s1[1], s1[2], s1[3]};
#pragma unroll
    for (int j = 0; j < 8; ++j) { o1[j] = a[j] * c[j] - b[j] * sn[j]; o2[j] = a[j] * sn[j] + b[j] * c[j]; }
}
__device__ __forceinline__ u32x4 pack8(const float (&o)[8]) { u32x4 w; w.x = pk_bf16(o[0], o[1]); w.y = pk_bf16(o[2], o[3]); w.z = pk_bf16(o[4], o[5]); w.w = pk_bf16(o[6], o[7]); return w; }
__device__ __forceinline__ void phase_kstat(LAS float* red, const bf16_t* KR, float* KMEAN, float* KNMAX) {
    const int tid = threadIdx.x, ch = tid & 7, rr = tid >> 3, wv = tid >> 6, lane = tid & 63;
    for (int item = blockIdx.x; item < 2 * NHEAD * 32; item += gridDim.x) {
        const int bh = item >> 5, j = item & 31, b = bh >> 4, h = bh & 15;
        float sm1[8], sm2[8]; float nmax = 0.f;
#pragma unroll
        for (int q = 0; q < 8; ++q) { sm1[q] = 0.f; sm2[q] = 0.f; }
        u32x4 lo[4], hi[4];
#pragma unroll
        for (int ps = 0; ps < 4; ++ps) { const size_t off = ((size_t)b * SEQ + j * 256 + ps * 64 + rr) * DM + h * 128 + ch * 8; lo[ps] = *(const u32x4*)(KR + off); hi[ps] = *(const u32x4*)(KR + off + 64); }
#pragma unroll
        for (int ps = 0; ps < 4; ++ps) {
            const float a[8] = {bflo(lo[ps].x), bfhi(lo[ps].x), bflo(lo[ps].y), bfhi(lo[ps].y), bflo(lo[ps].z), bfhi(lo[ps].z), bflo(lo[ps].w), bfhi(lo[ps].w)};
            const float c[8] = {bflo(hi[ps].x), bfhi(hi[ps].x), bflo(hi[ps].y), bfhi(hi[ps].y), bflo(hi[ps].z), bfhi(hi[ps].z), bflo(hi[ps].w), bfhi(hi[ps].w)};
            float nq = 0.f;
#pragma unroll
            for (int q = 0; q < 8; ++q) { sm1[q] += a[q]; sm2[q] += c[q]; nq += a[q] * a[q] + c[q] * c[q]; }
            nq += __shfl_xor(nq, 1); nq += __shfl_xor(nq, 2); nq += __shfl_xor(nq, 4);
            nmax = fmaxf(nmax, nq);
        }
#pragma unroll
        for (int q = 0; q < 8; ++q) {
            sm1[q] += __shfl_xor(sm1[q], 8); sm1[q] += __shfl_xor(sm1[q], 16); sm1[q] += __shfl_xor(sm1[q], 32);
            sm2[q] += __shfl_xor(sm2[q], 8); sm2[q] += __shfl_xor(sm2[q], 16); sm2[q] += __shfl_xor(sm2[q], 32);
        }
        nmax = wave_max(nmax);
        if (lane < 8) {
#pragma unroll
            for (int q = 0; q < 8; ++q) { red[wv * 128 + lane * 8 + q] = sm1[q]; red[wv * 128 + 64 + lane * 8 + q] = sm2[q]; }
        }
        if (lane == 0) red[1024 + wv] = nmax;
        __syncthreads();
        if (tid < 128) {
            float s2 = 0.f;
#pragma unroll
            for (int r = 0; r < 8; ++r) s2 += red[r * 128 + tid];
            KMEAN[(size_t)item * 128 + tid] = s2 * (1.0f / 256.0f);
        }
        if (tid == 0) {
            float m = 0.f;
#pragma unroll
            for (int r = 0; r < 8; ++r) m = fmaxf(m, red[1024 + r]);
            KNMAX[item] = sqrtf(m);
        }
        __syncthreads();
    }
}

__device__ __forceinline__ void top3_insert(float x, int m, float& v0, int& i0, float& v1, int& i1, float& v2, int& i2) {
    const bool c0 = x > v0 || (x == v0 && m < i0), c1 = x > v1 || (x == v1 && m < i1), c2 = x > v2 || (x == v2 && m < i2);
    v2 = c1 ? v1 : (c2 ? x : v2); i2 = c1 ? i1 : (c2 ? m : i2);
    v1 = c0 ? v0 : (c1 ? x : v1); i1 = c0 ? i0 : (c1 ? m : i1);
    v0 = c0 ? x : v0; i0 = c0 ? m : i0;
}
__device__ __forceinline__ void phase_sel(LAS unsigned char* lds, const bf16_t* QR, const float* KMEAN, unsigned short* SUB, int* CNT, int* ctr) {
    const int tid = threadIdx.x, lane = tid & 63, wv = tid >> 6, r32 = lane & 31, hh = lane >> 5;
    LAS unsigned short* bucket = (LAS unsigned short*)lds;
    LAS int* cnt = (LAS int*)(lds + 16384);
    const float NEG = -1e30f;
    if (blockIdx.x == 0 && tid == 0) *ctr = 0;
    for (int item = blockIdx.x; item < 2 * NHEAD * 32; item += gridDim.x) {
        const int bh = item >> 5, i = item & 31, b = bh >> 4, h = bh & 15;
        if (i == 0) continue;
        if (tid < 32) cnt[tid] = 0;
        __syncthreads();
        const float* kmp = KMEAN + ((size_t)bh * 32 + r32) * 128 + 8 * hh;
        const size_t tok = (size_t)b * SEQ + i * 256 + wv * 32 + r32;
        const bf16_t* qp = QR + tok * DM + h * 128 + 8 * hh;
        f32x16 S;
#pragma unroll
        for (int e = 0; e < 16; ++e) S[e] = 0.f;
#pragma unroll
        for (int s2 = 0; s2 < 8; ++s2) {
            const f32x4 ka = *(const f32x4*)(kmp + 16 * s2), kb = *(const f32x4*)(kmp + 16 * s2 + 4);
            const bf16x8 qf = *(const bf16x8*)(qp + 16 * s2);
            u32x4 hi, lo;
            hi.x = pk_bf16(ka[0], ka[1]); hi.y = pk_bf16(ka[2], ka[3]); hi.z = pk_bf16(kb[0], kb[1]); hi.w = pk_bf16(kb[2], kb[3]);
            lo.x = pk_bf16(ka[0] - bflo(hi.x), ka[1] - bfhi(hi.x)); lo.y = pk_bf16(ka[2] - bflo(hi.y), ka[3] - bfhi(hi.y));
            lo.z = pk_bf16(kb[0] - bflo(hi.z), kb[1] - bfhi(hi.z)); lo.w = pk_bf16(kb[2] - bflo(hi.w), kb[3] - bfhi(hi.w));
            S = __builtin_amdgcn_mfma_f32_32x32x16_bf16(__builtin_bit_cast(bf16x8, hi), qf, S, 0, 0, 0);
            S = __builtin_amdgcn_mfma_f32_32x32x16_bf16(__builtin_bit_cast(bf16x8, lo), qf, S, 0, 0, 0);
        }
        float v0 = -3e38f, v1 = -3e38f, v2 = -3e38f; int i0 = 99, i1 = 99, i2 = 99;
#pragma unroll
        for (int e = 0; e < 16; ++e) {
            const int m = (e & 3) + 8 * (e >> 2) + 4 * hh;
            const float x = m < i ? S[e] : NEG;
            top3_insert(x, m, v0, i0, v1, i1, v2, i2);
        }
        {
            const float pv0 = __shfl_xor(v0, 32), pv1 = __shfl_xor(v1, 32), pv2 = __shfl_xor(v2, 32);
            const int pi0 = __shfl_xor(i0, 32), pi1 = __shfl_xor(i1, 32), pi2 = __shfl_xor(i2, 32);
            top3_insert(pv0, pi0, v0, i0, v1, i1, v2, i2); top3_insert(pv1, pi1, v0, i0, v1, i1, v2, i2); top3_insert(pv2, pi2, v0, i0, v1, i1, v2, i2);
        }
        if (hh == 0) {
            const int tl = wv * 32 + r32;
            if (v0 > 0.5f * NEG) { const int p = __hip_atomic_fetch_add(cnt + i0, 1, __ATOMIC_RELAXED, __HIP_MEMORY_SCOPE_WORKGROUP); bucket[i0 * 256 + p] = (unsigned short)(tl | (0 << 8)); }
            if (v1 > 0.5f * NEG) { const int p = __hip_atomic_fetch_add(cnt + i1, 1, __ATOMIC_RELAXED, __HIP_MEMORY_SCOPE_WORKGROUP); bucket[i1 * 256 + p] = (unsigned short)(tl | (1 << 8)); }
            if (v2 > 0.5f * NEG) { const int p = __hip_atomic_fetch_add(cnt + i2, 1, __ATOMIC_RELAXED, __HIP_MEMORY_SCOPE_WORKGROUP); bucket[i2 * 256 + p] = (unsigned short)(tl | (2 << 8)); }
        }
        __syncthreads();
        for (int idx = tid; idx < 32 * 256; idx += 512) {
            const int j = idx >> 8, p = idx & 255;
            if (j < i && p < cnt[j]) SUB[(((size_t)bh * 32 + j) * 32 + i) * 256 + p] = bucket[idx];
        }
        if (tid < i) CNT[((size_t)bh * 32 + tid) * 32 + i] = cnt[tid];
        __syncthreads();
    }
}

__device__ __forceinline__ unsigned off_b(unsigned row, unsigned ch) { return 256u * row + 16u * (ch ^ (((row & 3u) << 2) | ((row >> 2) & 3u))); }
__device__ __forceinline__ unsigned pi32(unsigned m) { return (m & ~12u) | ((m & 4u) << 1) | ((m & 8u) >> 1); }
__device__ __forceinline__ bf16x8 tr_frag(LAS unsigned char* img, unsigned lane, unsigned c, unsigned ks) {
    const unsigned hh = lane >> 5, blk = (lane >> 4) & 1, q = (lane & 15) >> 2, p = lane & 3;
    const unsigned a0 = off_b(16 * ks + 8 * hh + q, 4 * c + 2 * blk + (p >> 1)) + 8 * (p & 1);
    const unsigned a1 = off_b(16 * ks + 8 * hh + 4 + q, 4 * c + 2 * blk + (p >> 1)) + 8 * (p & 1);
    const s16x4 lo = __builtin_amdgcn_ds_read_tr16_b64_v4i16((LAS s16x4*)(img + a0));
    const s16x4 hi = __builtin_amdgcn_ds_read_tr16_b64_v4i16((LAS s16x4*)(img + a1));
    bf16x8 r; r[0] = lo[0]; r[1] = lo[1]; r[2] = lo[2]; r[3] = lo[3]; r[4] = hi[0]; r[5] = hi[1]; r[6] = hi[2]; r[7] = hi[3];
    return r;
}
__device__ __forceinline__ void phase_att(LAS unsigned char* lds, const bf16_t* QR, const bf16_t* KR, const bf16_t* V, const float* KNMAX, const unsigned short* SUB, const int* CNT, int* ctr,
                                          bf16_t* P012, bf16_t* P3, float* LS) {
    const int tid = threadIdx.x, lane = tid & 63, wv = tid >> 6, r32 = lane & 31, hh = lane >> 5;
    LAS unsigned char* Kimg = lds;
    LAS unsigned char* Vimg = lds + 65536;
    LAS int* misc = (LAS int*)(lds + 131072);
    const float SCL2 = 0.08838834764831845f * 1.4426950408889634f;
    for (;;) {
        __syncthreads();
        if (tid == 0) misc[40] = __hip_atomic_fetch_add(ctr, 1, __ATOMIC_RELAXED, __HIP_MEMORY_SCOPE_AGENT);
        __syncthreads();
        const int item = misc[40];
        if (item >= 2 * NHEAD * 32) break;
        const int j = item >> 5, bh = item & 31, b = bh >> 4, h = bh & 15;
#pragma unroll
        for (int r = 0; r < 8; ++r) {
            const int idx = tid + 512 * r, row = idx >> 4, ch = idx & 15;
            const size_t g = ((size_t)b * SEQ + j * 256 + row) * DM + h * 128 + ch * 8;
            const u32x4 kv = *(const u32x4*)(KR + g), vv = *(const u32x4*)(V + g);
            *(LAS u32x4*)(Kimg + off_b(row, ch)) = kv; *(LAS u32x4*)(Vimg + off_b(row, ch)) = vv;
        }
        if (tid <= 32) { int pre = 0; for (int u = j + 1; u < tid; ++u) pre += CNT[((size_t)bh * 32 + j) * 32 + u]; misc[tid] = pre; }
        float kn = (lane < 32) ? KNMAX[bh * 32 + lane] : 0.f;
        kn = wave_max(kn);
        __syncthreads();
        const int total = misc[32], ntile = (256 + total + 31) >> 5;
        for (int tile = wv; tile < ntile; tile += 8) {
            const int gr = tile * 32 + r32;
            int pos, slot; bool valid = true;
            if (gr < 256) { pos = j * 256 + gr; slot = 3; }
            else {
                const int x = gr - 256; valid = x < total;
                int ii = j + 1;
                for (int u = j + 1; u < 32; ++u) if (misc[u] <= x) ii = u;
                if (valid) { const unsigned e = SUB[(((size_t)bh * 32 + j) * 32 + ii) * 256 + (x - misc[ii])]; pos = ii * 256 + (int)(e & 255u); slot = (int)(e >> 8); }
                else { pos = j * 256; slot = 3; }
            }
            const size_t tok = (size_t)b * SEQ + pos;
            bf16x8 qf[8];
            const bf16_t* qp = QR + tok * DM + h * 128 + 8 * hh;
#pragma unroll
            for (int s = 0; s < 8; ++s) qf[s] = *(const bf16x8*)(qp + 16 * s);
            float qn2 = 0.f;
#pragma unroll
            for (int s = 0; s < 8; ++s)
#pragma unroll
                for (int e = 0; e < 8; ++e) { const float f = bf2f((bf16_t)qf[s][e]); qn2 += f * f; }
            qn2 += __shfl_xor(qn2, 32);
            const float c2 = sqrtf(qn2) * kn * SCL2;
            f32x16 O[4];
#pragma unroll
            for (int dt = 0; dt < 4; ++dt)
#pragma unroll
                for (int e = 0; e < 16; ++e) O[dt][e] = 0.f;
            float l = 0.f;
            const bool own = tile < 8;
            const int kcn = own ? tile + 1 : 8;
            const unsigned krow = pi32((unsigned)r32);
            for (int kc = 0; kc < kcn; ++kc) {
                f32x16 S, S1;
#pragma unroll
                for (int e = 0; e < 16; ++e) { S[e] = 0.f; S1[e] = 0.f; }
#pragma unroll
                for (int s = 0; s < 8; s += 2) {
                    const bf16x8 kf = *(const LAS bf16x8*)(Kimg + off_b(32 * kc + krow, 2 * s + hh));
                    const bf16x8 kf1 = *(const LAS bf16x8*)(Kimg + off_b(32 * kc + krow, 2 * s + 2 + hh));
                    S = __builtin_amdgcn_mfma_f32_32x32x16_bf16(kf, qf[s], S, 0, 0, 0);
                    S1 = __builtin_amdgcn_mfma_f32_32x32x16_bf16(kf1, qf[s + 1], S1, 0, 0, 0);
                }
                float p[16];
                if (own) {
#pragma unroll
                    for (int e = 0; e < 16; ++e) {
                        const unsigned m = (e & 3) + 8 * (e >> 2) + 4 * hh;
                        const int key = j * 256 + 32 * kc + (int)pi32(m);
                        float pe = __builtin_amdgcn_exp2f((S[e] + S1[e]) * SCL2 - c2);
                        if (key > pos) pe = 0.f;
                        p[e] = pe; l += pe;
                    }
                } else {
#pragma unroll
                    for (int e = 0; e < 16; ++e) { const float pe = __builtin_amdgcn_exp2f((S[e] + S1[e]) * SCL2 - c2); p[e] = pe; l += pe; }
                }
                u32x4 w0, w1;
                w0.x = pk_bf16(p[0], p[1]); w0.y = pk_bf16(p[2], p[3]); w0.z = pk_bf16(p[4], p[5]); w0.w = pk_bf16(p[6], p[7]);
                w1.x = pk_bf16(p[8], p[9]); w1.y = pk_bf16(p[10], p[11]); w1.z = pk_bf16(p[12], p[13]); w1.w = pk_bf16(p[14], p[15]);
                const bf16x8 pf0 = __builtin_bit_cast(bf16x8, w0), pf1 = __builtin_bit_cast(bf16x8, w1);
#pragma unroll
                for (int dt = 0; dt < 4; ++dt) {
                    const bf16x8 v0 = tr_frag(Vimg, lane, dt, 2 * kc), v1 = tr_frag(Vimg, lane, dt, 2 * kc + 1);
                    O[dt] = __builtin_amdgcn_mfma_f32_32x32x16_bf16(v0, pf0, O[dt], 0, 0, 0);
                    O[dt] = __builtin_amdgcn_mfma_f32_32x32x16_bf16(v1, pf1, O[dt], 0, 0, 0);
                }
            }
            l += __shfl_xor(l, 32);
            if (valid) {
                bf16_t* pl = (slot < 3 ? P012 + (size_t)slot * ((size_t)32 << 20) : P3) + (tok * NHEAD + h) * 128 + 4 * hh;
#pragma unroll
                for (int dt = 0; dt < 4; ++dt)
#pragma unroll
                    for (int g = 0; g < 4; ++g) {
                        u32x2 w; w.x = pk_bf16(O[dt][4 * g], O[dt][4 * g + 1]); w.y = pk_bf16(O[dt][4 * g + 2], O[dt][4 * g + 3]);
                        *(u32x2*)(pl + 32 * dt + 8 * g) = w;
                    }
                if (hh == 0) LS[(size_t)slot * MTOK * NHEAD + tok * NHEAD + h] = l;
            }
        }
    }
}
__device__ __forceinline__ void phase_comb(const bf16_t* P012, const bf16_t* P3, const float* LS, bf16_t* AO) {
    const size_t n = (size_t)MTOK * NHEAD * 16, stride = (size_t)gridDim.x * 512;
    for (size_t idx = (size_t)blockIdx.x * 512 + threadIdx.x; idx < n; idx += stride) {
        const size_t th = idx >> 4; const int ch = (int)(idx & 15);
        const int t = (int)((th >> 4) & (SEQ - 1)), blk = t >> 8, nsel = blk < 3 ? blk : 3;
        float acc[8];
        float l = LS[(size_t)3 * MTOK * NHEAD + th];
        { const u32x4 w = *(const u32x4*)(P3 + th * 128 + ch * 8);
          acc[0] = bflo(w.x); acc[1] = bfhi(w.x); acc[2] = bflo(w.y); acc[3] = bfhi(w.y); acc[4] = bflo(w.z); acc[5] = bfhi(w.z); acc[6] = bflo(w.w); acc[7] = bfhi(w.w); }
        for (int s = 0; s < nsel; ++s) {
            const u32x4 w = *(const u32x4*)(P012 + (size_t)s * ((size_t)32 << 20) + th * 128 + ch * 8);
            acc[0] += bflo(w.x); acc[1] += bfhi(w.x); acc[2] += bflo(w.y); acc[3] += bfhi(w.y); acc[4] += bflo(w.z); acc[5] += bfhi(w.z); acc[6] += bflo(w.w); acc[7] += bfhi(w.w);
            l += LS[(size_t)s * MTOK * NHEAD + th];
        }
        const float rl = 1.0f / l;
        u32x4 o; o.x = pk_bf16(acc[0] * rl, acc[1] * rl); o.y = pk_bf16(acc[2] * rl, acc[3] * rl); o.z = pk_bf16(acc[4] * rl, acc[5] * rl); o.w = pk_bf16(acc[6] * rl, acc[7] * rl);
        *(u32x4*)(AO + th * 128 + ch * 8) = o;
    }
}


__device__ __forceinline__ void qrow_issue(f32x4 (&v)[8], const float* p, int lane) {
#pragma unroll
    for (int i = 0; i < 2; ++i)
#pragma unroll
        for (int q = 0; q < 4; ++q) v[i * 4 + q] = *(const f32x4*)(p + 1024 * i + 16 * lane + 4 * q);
}
__device__ __forceinline__ void qrow_finish(const f32x4 (&v)[8], unsigned char* dst, float* scl, int lane) {
    float am = 0.f;
#pragma unroll
    for (int i = 0; i < 8; ++i) am = fmaxf(am, fmaxf(fmaxf(fabsf(v[i][0]), fabsf(v[i][1])), fmaxf(fabsf(v[i][2]), fabsf(v[i][3]))));
    am = fmaxf(wave_max(am), 1e-30f);
    const float inv = 127.0f / am;
    if (lane == 0) *scl = am * (1.0f / 127.0f);
#pragma unroll
    for (int i = 0; i < 2; ++i) {
        u32x4 w;
#pragma unroll
        for (int q = 0; q < 4; ++q) {
            const f32x4 t = v[i * 4 + q];
            const unsigned b0 = (unsigned)(int)(rintf(t[0] * inv) + 128.0f), b1 = (unsigned)(int)(rintf(t[1] * inv) + 128.0f), b2 = (unsigned)(int)(rintf(t[2] * inv) + 128.0f), b3 = (unsigned)(int)(rintf(t[3] * inv) + 128.0f);
            w[q] = b0 | (b1 << 8) | (b2 << 16) | (b3 << 24);
        }
        *(u32x4*)(dst + 1024 * i + 16 * lane) = w;
    }
}
struct QuantJob { const float* TU; const float* TV; unsigned char* QU; unsigned char* QV; float* SU; float* SV; };
__device__ __forceinline__ const float* qj_src(const QuantJob& q, int r) { return (r < 16384 ? q.TU : q.TV) + (size_t)(r & 16383) * DM; }
__device__ __forceinline__ unsigned char* qj_dst(const QuantJob& q, int r) { return (r < 16384 ? q.QU : q.QV) + (size_t)(r & 16383) * DM; }
__device__ __forceinline__ float* qj_scl(const QuantJob& q, int r) { return (r < 16384 ? q.SU : q.SV) + (r & 16383); }
__device__ __forceinline__ void qj_tail(const QuantJob& q, int done_iters) {
    const int lane = threadIdx.x & 63, gw = blockIdx.x * 8 + (threadIdx.x >> 6), nw = gridDim.x * 8;
    for (int r = gw + done_iters * nw; r < 32768; r += nw) { f32x4 v[8]; qrow_issue(v, qj_src(q, r), lane); qrow_finish(v, qj_dst(q, r), qj_scl(q, r), lane); }
}
__device__ __forceinline__ float logf_gate(float z, float lb) { return __logf(lb + (1.0f - lb) * sigmoidf_(z)); }
__device__ __forceinline__ void phase_scan_a(LAS unsigned char* lds, const bf16_t* FZ, const float* LB, const bf16_t* I1, bf16_t* LT, float* DEC, const QuantJob qj, unsigned* dbgc = nullptr) {
    unsigned dbg_kt = 0, dbg_acc = 0;
    const int tid = threadIdx.x, lane = tid & 63, wv = tid >> 6, k = tid & 127, part = tid >> 7;
    LAS unsigned char* Iimg = lds; LAS unsigned char* KTimg = lds + 16384;
    LAS float* psum = (LAS float*)(lds + 32768);
    LAS unsigned char* Lst = lds + 36864;
#if SCAN_A_VALU == 2
    for (int item = blockIdx.x; item < 2 * NHEAD * 128; item += gridDim.x) {
        const int bh = item >> 7, c = item & 127, b = bh >> 4, h = bh & 15;
        const size_t tok0 = (size_t)b * SEQ + c * 64;
        for (int idx = tid; idx < 16384; idx += 512) {
            const int v = idx >> 7, kk = idx & 127;
            float g = 1.f, L = 0.f;
            for (int s2 = 63; s2 >= 0; --s2) { const size_t o = (tok0 + s2) * DM + h * 128; const float f = __expf(logf_gate(bf2f(FZ[o + kk]), LB[h * 128 + kk])); L += bf2f(I1[o + v]) * (1.0f - f) * g; g *= f; }
            LT[(size_t)item * 16384 + idx] = (bf16_t)(pk_bf16(L, 0.f) & 0xffffu);
        }
    }
    return;
#endif
    bf16_t nfz[16]; u32x4 nit_[2];
#define SA_LOAD(item_) { const int bh_ = (item_) >> 7, c_ = (item_) & 127; const size_t t0_ = (size_t)(bh_ >> 4) * SEQ + c_ * 64; const int h_ = bh_ & 15; \
        _Pragma("unroll") for (int i = 0; i < 16; ++i) nfz[i] = FZ[(t0_ + 16 * part + i) * DM + h_ * 128 + k]; \
        _Pragma("unroll") for (int r = 0; r < 2; ++r) { const int idx = tid + 512 * r, row = idx >> 4, ch = idx & 15; nit_[r] = *(const u32x4*)(I1 + (t0_ + row) * DM + h_ * 128 + ch * 8); } }
    if ((int)blockIdx.x < 2 * NHEAD * 128) SA_LOAD((int)blockIdx.x)
    int qiter = 0;
    for (int item = blockIdx.x; item < 2 * NHEAD * 128; item += gridDim.x, ++qiter) {
        const int bh = item >> 7, c = item & 127, b = bh >> 4, h = bh & 15;
        const size_t tok0 = (size_t)b * SEQ + c * 64;
        float lf[16];
        const float lbk = LB[h * 128 + k];
#pragma unroll
        for (int i = 0; i < 16; ++i) lf[i] = logf_gate(bf2f(nfz[i]), lbk);
#pragma unroll
        for (int r = 0; r < 2; ++r) { const int idx = tid + 512 * r, row = idx >> 4, ch = idx & 15; *(LAS u32x4*)(Iimg + off_b(row, ch)) = nit_[r]; }
        if (item + (int)gridDim.x < 2 * NHEAD * 128) SA_LOAD(item + (int)gridDim.x)
        const int qrow = qiter * (int)gridDim.x * 8 + (int)blockIdx.x * 8 + wv; const bool doq = qrow < 32768; f32x4 qv8[8];
        if (doq) qrow_issue(qv8, qj_src(qj, qrow), lane);
        float cs = 0.f;
#pragma unroll
        for (int i = 0; i < 16; ++i) cs += lf[i];
        psum[part * 128 + k] = cs;
        __syncthreads();
        const float p0 = psum[k], p1 = psum[128 + k], p2 = psum[256 + k], p3 = psum[384 + k];
        const float blast = (p0 + p1) + (p2 + p3);
        float bb = part == 0 ? 0.f : (part == 1 ? p0 : (part == 2 ? p0 + p1 : p0 + p1 + p2));
#pragma unroll
        for (int i = 0; i < 16; ++i) {
            bb += lf[i];
            const float kt = (1.0f - __expf(lf[i])) * __expf(blast - bb);
            if (!(kt - kt == 0.f)) ++dbg_kt;
            const int srow = 16 * part + i;
            *(LAS bf16_t*)(KTimg + off_b(srow, k >> 3) + 2 * (k & 7)) = (bf16_t)(pk_bf16(kt, 0.f) & 0xffffu);
        }
        if (part == 0) DEC[(size_t)item * 128 + k] = __expf(blast);
        __syncthreads();
#if SCAN_A_VALU
        for (int idx = tid; idx < 16384; idx += 512) {
            const int v = idx >> 7, kk = idx & 127;
            float accv = 0.f;
            for (int s2 = 0; s2 < 64; ++s2) accv += bf2f(*(const LAS bf16_t*)(Iimg + off_b(s2, v >> 3) + 2 * (v & 7))) * bf2f(*(const LAS bf16_t*)(KTimg + off_b(s2, kk >> 3) + 2 * (kk & 7)));
            *(LAS bf16_t*)(Lst + v * 272 + 2 * kk) = (bf16_t)(pk_bf16(accv, 0.f) & 0xffffu);
        }
        if (0)
#endif
        {
            const int vt = wv >> 1;
            f32x16 acc0, acc1;
#pragma unroll
            for (int e = 0; e < 16; ++e) { acc0[e] = 0.f; acc1[e] = 0.f; }
#pragma unroll
            for (int ks = 0; ks < 4; ++ks) {
                const bf16x8 af = tr_frag(Iimg, lane, vt, ks);
                const bf16x8 b0 = tr_frag(KTimg, lane, 2 * (wv & 1), ks), b1 = tr_frag(KTimg, lane, 2 * (wv & 1) + 1, ks);
                acc0 = __builtin_amdgcn_mfma_f32_32x32x16_bf16(af, b0, acc0, 0, 0, 0);
                acc1 = __builtin_amdgcn_mfma_f32_32x32x16_bf16(af, b1, acc1, 0, 0, 0);
            }
            const int r32 = lane & 31, hh = lane >> 5;
#pragma unroll
            for (int e = 0; e < 16; ++e) {
                if (!(acc0[e] - acc0[e] == 0.f)) ++dbg_acc; if (!(acc1[e] - acc1[e] == 0.f)) ++dbg_acc;
                const int v = 32 * vt + (e & 3) + 8 * (e >> 2) + 4 * hh;
                *(LAS bf16_t*)(Lst + v * 272 + 2 * (64 * (wv & 1) + r32)) = (bf16_t)(pk_bf16(acc0[e], 0.f) & 0xffffu);
                *(LAS bf16_t*)(Lst + v * 272 + 2 * (64 * (wv & 1) + 32 + r32)) = (bf16_t)(pk_bf16(acc1[e], 0.f) & 0xffffu);
            }
        }
        __syncthreads();
#pragma unroll
        for (int r = 0; r < 4; ++r) { const int idx = tid + 512 * r, row = idx >> 4, ch = idx & 15; *(u32x4*)(LT + (size_t)item * 16384 + row * 128 + ch * 8) = *(const LAS u32x4*)(Lst + row * 272 + ch * 16); }
        if (doq) qrow_finish(qv8, qj_dst(qj, qrow), qj_scl(qj, qrow), lane);
        __syncthreads();
    }
    qj_tail(qj, qiter);
    if (dbgc) { if (dbg_kt) atomicAdd(dbgc + 0, dbg_kt); if (dbg_acc) atomicAdd(dbgc + 1, dbg_acc); }
}
__device__ __forceinline__ void phase_scan_b(bf16_t* LT, const float* DEC, const QuantJob qj) {
    const int n = 2 * NHEAD * 128 * 32;
    const int lane = threadIdx.x & 63, gw = blockIdx.x * 8 + (threadIdx.x >> 6), nw = gridDim.x * 8;
    int qdone = 0;
    for (int idx = blockIdx.x * 512 + threadIdx.x; idx < n; idx += gridDim.x * 512) {
        const int bh = idx >> 12, vk = idx & 4095, k4 = (vk & 31) * 4;
        float S0 = 0.f, S1 = 0.f, S2 = 0.f, S3 = 0.f;
        bf16_t* p = LT + (size_t)bh * 128 * 16384 + (size_t)vk * 4;
        const float* dp = DEC + (size_t)bh * 128 * 128 + k4;
        for (int c8 = 0; c8 < 16; ++c8) {
            const int qrow = (qdone + c8) * nw + gw; const bool doq = qrow < 32768; f32x4 qv8[8];
            if (doq) qrow_issue(qv8, qj_src(qj, qrow), lane);
#pragma unroll
            for (int c2 = 0; c2 < 8; ++c2) {
                const int c = c8 * 8 + c2;
                const u32x2 w = *(const u32x2*)(p + (size_t)c * 16384);
                const f32x4 d = *(const f32x4*)(dp + c * 128);
                u32x2 o; o.x = pk_bf16(S0, S1); o.y = pk_bf16(S2, S3);
                *(u32x2*)(p + (size_t)c * 16384) = o;
                S0 = d[0] * S0 + bflo(w.x); S1 = d[1] * S1 + bfhi(w.x); S2 = d[2] * S2 + bflo(w.y); S3 = d[3] * S3 + bfhi(w.y);
            }
            if (doq) qrow_finish(qv8, qj_dst(qj, qrow), qj_scl(qj, qrow), lane);
        }
        qdone += 16;
    }
    qj_tail(qj, qdone);
}
__device__ __forceinline__ void phase_scan_c(LAS unsigned char* lds, const bf16_t* Q1, const bf16_t* FZ, const float* LB, const bf16_t* I1, const bf16_t* G1, const bf16_t* SP, const float* gnorm, bf16_t* OG) {
    const int tid = threadIdx.x, lane = tid & 63, wv = tid >> 6, k = tid & 127, part = tid >> 7, r32 = lane & 31, hh = lane >> 5;
    LAS unsigned char* QTimg = lds; LAS unsigned char* QPimg = lds + 16384; LAS unsigned char* KPimg = lds + 32768; LAS unsigned char* Iimg = lds + 49152; LAS unsigned char* SPimg = lds + 65536;
    LAS float* psum = (LAS float*)(lds + 98304);
    LAS float* ssq = (LAS float*)(lds + 100352);
    LAS unsigned char* OT = lds + 102400;
    bf16_t nfz[16], nq[16]; u32x4 nit_[2], nsp[4], ngt[2];
#define SC_LOAD(item_) { const int bh_ = (item_) >> 7, c_ = (item_) & 127; const size_t t0_ = (size_t)(bh_ >> 4) * SEQ + c_ * 64; const int h_ = bh_ & 15; \
        _Pragma("unroll") for (int i = 0; i < 16; ++i) { const size_t o_ = (t0_ + 16 * part + i) * DM + h_ * 128 + k; nfz[i] = FZ[o_]; nq[i] = Q1[o_]; } \
        _Pragma("unroll") for (int r = 0; r < 2; ++r) { const int idx = tid + 512 * r, row = idx >> 4, ch = idx & 15; nit_[r] = *(const u32x4*)(I1 + (t0_ + row) * DM + h_ * 128 + ch * 8); ngt[r] = *(const u32x4*)(G1 + (t0_ + row) * DM + h_ * 128 + ch * 8); } \
        _Pragma("unroll") for (int r = 0; r < 4; ++r) { const int idx = tid + 512 * r, row = idx >> 4, ch = idx & 15; nsp[r] = *(const u32x4*)(SP + (size_t)(item_) * 16384 + row * 128 + ch * 8); } }
    if ((int)blockIdx.x < 2 * NHEAD * 128) SC_LOAD((int)blockIdx.x)
    for (int item = blockIdx.x; item < 2 * NHEAD * 128; item += gridDim.x) {
        const int bh = item >> 7, c = item & 127, b = bh >> 4, h = bh & 15;
        const size_t tok0 = (size_t)b * SEQ + c * 64;
        float lf[16], qv[16];
        const float lbk = LB[h * 128 + k];
#pragma unroll
        for (int i = 0; i < 16; ++i) { lf[i] = logf_gate(bf2f(nfz[i]), lbk); const float qr = bf2f(nq[i]); qv[i] = qr * sigmoidf_(qr); }
#pragma unroll
        for (int r = 0; r < 2; ++r) { const int idx = tid + 512 * r, row = idx >> 4, ch = idx & 15; *(LAS u32x4*)(Iimg + off_b(row, ch)) = nit_[r]; }
#pragma unroll
        for (int r = 0; r < 4; ++r) { const int idx = tid + 512 * r, row = idx >> 4, ch = idx & 15; *(LAS u32x4*)(SPimg + off_b(row, ch)) = nsp[r]; }
        const u32x4 gcur0 = ngt[0], gcur1 = ngt[1];
        if (item + (int)gridDim.x < 2 * NHEAD * 128) SC_LOAD(item + (int)gridDim.x)
        float cs = 0.f;
#pragma unroll
        for (int i = 0; i < 16; ++i) cs += lf[i];
        psum[part * 128 + k] = cs;
        __syncthreads();
        const float p0 = psum[k], p1 = psum[128 + k], p2 = psum[256 + k];
        const float rr = p0 + p1;
        float bb = part == 0 ? 0.f : (part == 1 ? p0 : (part == 2 ? p0 + p1 : p0 + p1 + p2));
#pragma unroll
        for (int i = 0; i < 16; ++i) {
            bb += lf[i];
            const float qt = qv[i] * __expf(bb), qp = qv[i] * __expf(bb - rr), kp = (1.0f - __expf(lf[i])) * __expf(rr - bb);
            const unsigned o = off_b(16 * part + i, k >> 3) + 2 * (k & 7);
            *(LAS bf16_t*)(QTimg + o) = (bf16_t)(pk_bf16(qt, 0.f) & 0xffffu);
            *(LAS bf16_t*)(QPimg + o) = (bf16_t)(pk_bf16(qp, 0.f) & 0xffffu);
            *(LAS bf16_t*)(KPimg + o) = (bf16_t)(pk_bf16(kp, 0.f) & 0xffffu);
        }
        __syncthreads();
        const int tt = wv & 1, vt = wv >> 1;
        f32x16 O;
#pragma unroll
        for (int e = 0; e < 16; ++e) O[e] = 0.f;
#pragma unroll
        for (int ks = 0; ks < 8; ++ks) {
            const bf16x8 af = *(const LAS bf16x8*)(SPimg + off_b(32 * vt + r32, 2 * ks + hh));
            const bf16x8 bf = *(const LAS bf16x8*)(QTimg + off_b(32 * tt + r32, 2 * ks + hh));
            O = __builtin_amdgcn_mfma_f32_32x32x16_bf16(af, bf, O, 0, 0, 0);
        }
        const unsigned krow = pi32((unsigned)r32);
        for (int st = 0; st <= tt; ++st) {
            f32x16 S;
#pragma unroll
            for (int e = 0; e < 16; ++e) S[e] = 0.f;
#pragma unroll
            for (int ks = 0; ks < 8; ++ks) {
                const bf16x8 af = *(const LAS bf16x8*)(KPimg + off_b(32 * st + krow, 2 * ks + hh));
                const bf16x8 bf = *(const LAS bf16x8*)(QPimg + off_b(32 * tt + r32, 2 * ks + hh));
                S = __builtin_amdgcn_mfma_f32_32x32x16_bf16(af, bf, S, 0, 0, 0);
            }
            float p[16];
#pragma unroll
            for (int e = 0; e < 16; ++e) {
                const unsigned m = (e & 3) + 8 * (e >> 2) + 4 * hh;
                const int sidx = 32 * st + (int)pi32(m), tidx = 32 * tt + r32;
                p[e] = sidx <= tidx ? S[e] : 0.f;
            }
            u32x4 w0, w1;
            w0.x = pk_bf16(p[0], p[1]); w0.y = pk_bf16(p[2], p[3]); w0.z = pk_bf16(p[4], p[5]); w0.w = pk_bf16(p[6], p[7]);
            w1.x = pk_bf16(p[8], p[9]); w1.y = pk_bf16(p[10], p[11]); w1.z = pk_bf16(p[12], p[13]); w1.w = pk_bf16(p[14], p[15]);
            const bf16x8 pf0 = __builtin_bit_cast(bf16x8, w0), pf1 = __builtin_bit_cast(bf16x8, w1);
            const bf16x8 i0 = tr_frag(Iimg, lane, vt, 2 * st), i1 = tr_frag(Iimg, lane, vt, 2 * st + 1);
            O = __builtin_amdgcn_mfma_f32_32x32x16_bf16(i0, pf0, O, 0, 0, 0);
            O = __builtin_amdgcn_mfma_f32_32x32x16_bf16(i1, pf1, O, 0, 0, 0);
        }
        float sq = 0.f;
#pragma unroll
        for (int e = 0; e < 16; ++e) sq += O[e] * O[e];
        sq += __shfl_xor(sq, 32);
        if (hh == 0) ssq[vt * 64 + 32 * tt + r32] = sq;
        __syncthreads();
        const int tl = 32 * tt + r32;
        const float rstd = rsqrtf((ssq[tl] + ssq[64 + tl] + ssq[128 + tl] + ssq[192 + tl]) * (1.0f / 128.0f) + 1e-6f);
#pragma unroll
        for (int g = 0; g < 4; ++g) {
            const int v0 = 32 * vt + 8 * g + 4 * hh;
            const f32x4 gn = *(const f32x4*)(gnorm + v0);
            u32x2 w; w.x = pk_bf16(O[4 * g] * rstd * gn[0], O[4 * g + 1] * rstd * gn[1]); w.y = pk_bf16(O[4 * g + 2] * rstd * gn[2], O[4 * g + 3] * rstd * gn[3]);
            *(LAS u32x2*)(OT + tl * 272 + v0 * 2) = w;
        }
        __syncthreads();
#pragma unroll
        for (int r = 0; r < 2; ++r) {
            const int idx = tid + 512 * r, row = idx >> 4, ch = idx & 15;
            const u32x4 ov = *(const LAS u32x4*)(OT + row * 272 + ch * 16);
            const size_t go = (tok0 + row) * DM + h * 128 + ch * 8;
            const u32x4 gv = r == 0 ? gcur0 : gcur1;
            u32x4 w;
#define SILU_(x_) ((x_) * sigmoidf_(x_))
            w.x = pk_bf16(bflo(ov.x) * SILU_(bflo(gv.x)), bfhi(ov.x) * SILU_(bfhi(gv.x))); w.y = pk_bf16(bflo(ov.y) * SILU_(bflo(gv.y)), bfhi(ov.y) * SILU_(bfhi(gv.y)));
            w.z = pk_bf16(bflo(ov.z) * SILU_(bflo(gv.z)), bfhi(ov.z) * SILU_(bfhi(gv.z))); w.w = pk_bf16(bflo(ov.w) * SILU_(bflo(gv.w)), bfhi(ov.w) * SILU_(bfhi(gv.w)));
#undef SILU_
            *(u32x4*)(OG + go) = w;
        }
        __syncthreads();
    }
}


#if SCAN_DBG == 2
__device__ __forceinline__ void dbg_compare(LAS float* red, const bf16_t* A, const bf16_t* B, float* DBG) {
    float sd = 0.f, sr = 0.f, nn = 0.f;
    const size_t n = (size_t)MTOK * DM;
    for (size_t i = (size_t)blockIdx.x * 512 + threadIdx.x; i < n; i += (size_t)gridDim.x * 512) {
        const float x = bf2f(A[i]), y = bf2f(B[i]);
        if (!(x - x == 0.f)) nn += 1.f; else { sd += (x - y) * (x - y); sr += y * y; }
    }
    sd = wave_sum(sd); sr = wave_sum(sr); nn = wave_sum(nn);
    const int wv = threadIdx.x >> 6;
    if ((threadIdx.x & 63) == 0) { red[wv * 3] = sd; red[wv * 3 + 1] = sr; red[wv * 3 + 2] = nn; }
    __syncthreads();
    if (threadIdx.x == 0) { float a = 0, b = 0, c = 0; for (int w = 0; w < 8; ++w) { a += red[w * 3]; b += red[w * 3 + 1]; c += red[w * 3 + 2]; } DBG[blockIdx.x * 4] = a; DBG[blockIdx.x * 4 + 1] = b; DBG[blockIdx.x * 4 + 2] = c; }
    __syncthreads();
}
__device__ __forceinline__ void dbg_emit(const float* DBG, float* out) {
    float a = 0, b = 0, c = 0;
    for (int w = 0; w < (int)gridDim.x; ++w) { a += DBG[w * 4]; b += DBG[w * 4 + 1]; c += DBG[w * 4 + 2]; }
    const float rel = sqrtf(a / b);
    int k = (int)rintf(-2.0f * log10f(rel)); k = k < 0 ? 0 : (k > 16 ? 16 : k);
    if (c > 0.f) k = 17;
    const float cc = sqrtf(0.5f * (float)k);
    const size_t n = (size_t)MTOK * DM;
    for (size_t i = (size_t)blockIdx.x * 512 + threadIdx.x; i < n; i += (size_t)gridDim.x * 512) out[i] = cc;
}
#endif

#if SCAN_DBG == 3
__device__ __forceinline__ void dbg_count_bf16(const bf16_t* A, size_t n, unsigned* cnt) {
    unsigned c = 0;
    for (size_t i = (size_t)blockIdx.x * 512 + threadIdx.x; i < n; i += (size_t)gridDim.x * 512) { const float x = bf2f(A[i]); if (!(x - x == 0.f)) ++c; }
    if (c) atomicAdd(cnt, c);
}
__device__ __forceinline__ void dbg_count_f32(const float* A, size_t n, unsigned* cnt) {
    unsigned c = 0;
    for (size_t i = (size_t)blockIdx.x * 512 + threadIdx.x; i < n; i += (size_t)gridDim.x * 512) { const float x = A[i]; if (!(x - x == 0.f)) ++c; }
    if (c) atomicAdd(cnt, c);
}
__device__ __forceinline__ void dbg_emit3(const unsigned* cnt, float* out) {
    float code = 0.f;
    for (int st = 3; st >= 0; --st) { const unsigned c = cnt[st]; if (c) { float lg = log10f((float)c); lg = lg > 9.f ? 9.f : lg; code = (float)(st + 1) + 0.1f * lg; } }
    const float cc = sqrtf(code);
    const size_t n = (size_t)MTOK * DM;
    for (size_t i = (size_t)blockIdx.x * 512 + threadIdx.x; i < n; i += (size_t)gridDim.x * 512) out[i] = cc;
}
#endif

#if SCAN_DBG == 4 || SCAN_DBG == 6
__device__ __forceinline__ void dbg_compare4(LAS float* red, const bf16_t* A, const bf16_t* B, const bf16_t* C, float* DBG) {
    float sd = 0.f, sr = 0.f, nn = 0.f, mm = 0.f;
    const size_t n = (size_t)MTOK * DM;
    for (size_t i = (size_t)blockIdx.x * 512 + threadIdx.x; i < n; i += (size_t)gridDim.x * 512) {
        const float x = bf2f(A[i]), y = bf2f(B[i]);
        if (!(x - x == 0.f)) nn += 1.f; else { sd += (x - y) * (x - y); sr += y * y; }
        if (A[i] != C[i]) mm += 1.f;
    }
    sd = wave_sum(sd); sr = wave_sum(sr); nn = wave_sum(nn); mm = wave_sum(mm);
    const int wv = threadIdx.x >> 6;
    if ((threadIdx.x & 63) == 0) { red[wv * 4] = sd; red[wv * 4 + 1] = sr; red[wv * 4 + 2] = nn; red[wv * 4 + 3] = mm; }
    __syncthreads();
    if (threadIdx.x == 0) { float a = 0, b = 0, c = 0, d = 0; for (int w = 0; w < 8; ++w) { a += red[w * 4]; b += red[w * 4 + 1]; c += red[w * 4 + 2]; d += red[w * 4 + 3]; }
        DBG[blockIdx.x * 4] = a; DBG[blockIdx.x * 4 + 1] = b; DBG[blockIdx.x * 4 + 2] = c; DBG[blockIdx.x * 4 + 3] = d; }
    __syncthreads();
}
__device__ __forceinline__ void dbg_emit4(const float* DBG, float* out) {
    float a = 0, b = 0, c = 0, d = 0;
    for (int w = 0; w < (int)gridDim.x; ++w) { a += DBG[w * 4]; b += DBG[w * 4 + 1]; c += DBG[w * 4 + 2]; d += DBG[w * 4 + 3]; }
    const float rel = sqrtf(a / b);
    int k = (int)rintf(-log10f(rel)); k = k < 0 ? 0 : (k > 8 ? 8 : k);
#if SCAN_DBG == 6
    const float cc = sqrtf((float)k + ((d + c) > 0.f ? 0.5f : 0.f));
#else
    int m = (int)ceilf(log10f(1.0f + d + c)); m = m > 9 ? 9 : m;
    const float cc = sqrtf((float)k + 0.1f * (float)m);
#endif
    const size_t n = (size_t)MTOK * DM;
    for (size_t i = (size_t)blockIdx.x * 512 + threadIdx.x; i < n; i += (size_t)gridDim.x * 512) out[i] = cc;
}
#endif

#if SCAN_DBG == 5
__device__ __forceinline__ void dbg_lds16_test(LAS unsigned char* lds, unsigned* cnt) {
    const int tid = threadIdx.x;
    unsigned bad = 0;
    for (int rep = 0; rep < 64; ++rep) {
        for (int i = tid; i < 1024; i += 512) *(LAS u32x4*)(lds + i * 16) = (u32x4){0x7fc07fc0u, 0x7fc07fc0u, 0x7fc07fc0u, 0x7fc07fc0u};
        __syncthreads();
        const int k = tid & 127, part = tid >> 7;
#pragma unroll
        for (int i = 0; i < 16; ++i) {
            const int row = 16 * part + i;
            *(LAS bf16_t*)(lds + off_b(row, k >> 3) + 2 * (k & 7)) = (bf16_t)((row * 128 + k + rep) & 0x7fff);
        }
        __syncthreads();
        for (int idx = tid; idx < 64 * 128; idx += 512) {
            const int row = idx >> 7, kk = idx & 127;
            const bf16_t got = *(const LAS bf16_t*)(lds + off_b(row, kk >> 3) + 2 * (kk & 7));
            if (got != (bf16_t)((row * 128 + kk + rep) & 0x7fff)) ++bad;
        }
        __syncthreads();
    }
    if (bad) atomicAdd(cnt, bad);
}
__device__ __forceinline__ void dbg_emit5(const unsigned* cnt, float* out) {
    const unsigned c = cnt[0];
    float code = 0.f;
    if (c) { float lg = log10f((float)c); code = 1.0f + (lg > 8.9f ? 8.9f : lg); }
    const float cc = sqrtf(code);
    const size_t n = (size_t)MTOK * DM;
    for (size_t i = (size_t)blockIdx.x * 512 + threadIdx.x; i < n; i += (size_t)gridDim.x * 512) out[i] = cc;
}
#endif

#if SCAN_DBG == 6
__device__ __forceinline__ void dbg_check_a(LAS float* red, const float* LF, const bf16_t* I1, const bf16_t* LT, const bf16_t* LT2, float* DBG) {
    float sd = 0.f, sr = 0.f, mm = 0.f;
    const size_t n = (size_t)4096 * 16384;
    for (size_t i = (size_t)blockIdx.x * 512 + threadIdx.x; i < n; i += (size_t)gridDim.x * 512) {
        const int item = (int)(i >> 14), v = (int)((i >> 7) & 127), k = (int)(i & 127);
        const int bh = item >> 7, c = item & 127, b = bh >> 4, h = bh & 15;
        const size_t tok0 = (size_t)b * SEQ + c * 64;
        float g = 1.f, L = 0.f;
        for (int s2 = 63; s2 >= 0; --s2) {
            const size_t o = (tok0 + s2) * DM + h * 128;
            const float f = __expf(LF[o + k]);
            L += bf2f(I1[o + v]) * (1.0f - f) * g;
            g *= f;
        }
        const float x = bf2f(LT[i]);
        sd += (x - L) * (x - L); sr += L * L;
        if (LT[i] != LT2[i]) mm += 1.f;
    }
    sd = wave_sum(sd); sr = wave_sum(sr); mm = wave_sum(mm);
    const int wv = threadIdx.x >> 6;
    if ((threadIdx.x & 63) == 0) { red[wv * 4] = sd; red[wv * 4 + 1] = sr; red[wv * 4 + 2] = 0.f; red[wv * 4 + 3] = mm; }
    __syncthreads();
    if (threadIdx.x == 0) { float a = 0, b2 = 0, d = 0; for (int w = 0; w < 8; ++w) { a += red[w * 4]; b2 += red[w * 4 + 1]; d += red[w * 4 + 3]; }
        DBG[blockIdx.x * 4] = a; DBG[blockIdx.x * 4 + 1] = b2; DBG[blockIdx.x * 4 + 2] = 0.f; DBG[blockIdx.x * 4 + 3] = d; }
    __syncthreads();
}
#endif

#if SCAN_DBG == 7
#ifndef DBG_FAM
#define DBG_FAM 0
#endif
__device__ __forceinline__ void dbg_check_a7(const float* LF, const bf16_t* I1, const bf16_t* LT, float* DBG) {
    const size_t n = (size_t)4096 * 16384;
    float nbad = 0.f, nnf = 0.f;
    for (size_t i = (size_t)blockIdx.x * 512 + threadIdx.x; i < n; i += (size_t)gridDim.x * 512 * 8) {
        const int item = (int)(i >> 14), v = (int)((i >> 7) & 127), k = (int)(i & 127);
        const int bh = item >> 7, c = item & 127, b = bh >> 4, h = bh & 15;
        const size_t tok0 = (size_t)b * SEQ + c * 64;
        float g = 1.f, L = 0.f;
        for (int s2 = 63; s2 >= 0; --s2) {
            const size_t o = (tok0 + s2) * DM + h * 128;
            const float f = __expf(LF[o + k]);
            L += bf2f(I1[o + v]) * (1.0f - f) * g;
            g *= f;
        }
        const float x = bf2f(LT[i]);
        if (!(x - x == 0.f)) { nnf += 1.f; nbad += 1.f; }
        else if (fabsf(x - L) > 0.02f * fabsf(L) + 1e-2f) nbad += 1.f;
    }
    nbad = wave_sum(nbad); nnf = wave_sum(nnf);
    if ((threadIdx.x & 63) == 0) { atomicAdd(DBG, nbad); atomicAdd(DBG + 1, nnf); }
}
__device__ __forceinline__ void dbg_emit7(const float* DBG, float* out) {
    const float nb = DBG[0], nf = DBG[1];
    int A = nb == 0.f ? 0 : (nb <= 100.f ? 1 : (nb <= 1e4f ? 3 : (nb <= 1e6f ? 5 : 7)));
    int B = nf == 0.f ? 0 : 5;
    const float cc = sqrtf((float)A + 0.1f * (float)B);
    const size_t n = (size_t)MTOK * DM;
    for (size_t i = (size_t)blockIdx.x * 512 + threadIdx.x; i < n; i += (size_t)gridDim.x * 512) out[i] = cc;
}
#endif
__device__ __forceinline__ int opaque(int v) { asm volatile("" : "+s"(v)); return v; }
template <bool L1> __device__ __forceinline__ void run_gemm_out(const Args& a, LAS unsigned char* lds) {
    unsigned char* ws = a.ws;
    pg8::Gemm g{(const bf16_t*)(ws + (L1 ? slot(3) : slot(0))), (const bf16_t*)(ws + (L1 ? WS_WO : WS_WOUT)), opaque(MTOK), opaque(DM), opaque(DM)};
    pg8::StaticOrder S; S.init(g.M, g.N, (int)gridDim.x, (int)blockIdx.x);
    EpiKVQ E{(bf16_t*)(ws + (L1 ? slot(4) : slot(1))), nullptr, nullptr};
    pg8::gemm_phase<EpiKVQ, pg8::StaticOrder>(lds, g, S, E, nullptr);
}
template <bool L1> __device__ __forceinline__ void run_ln(const Args& a) {
    unsigned char* ws = a.ws;
    phase_ln<L1>((const bf16_t*)(ws + (L1 ? slot(4) : slot(1))), L1 ? (const void*)(ws + slot(2)) : (const void*)a.in[0], a.in[12] + (L1 ? 2 : 0) * DM, a.in[13] + (L1 ? 2 : 0) * DM,
                 (float*)nullptr, (bf16_t*)(ws + (L1 ? slot(8) : slot(5))), (signed char*)(ws + WS_XQ), (float*)(ws + WS_XS));
}
template <bool L1> __device__ __forceinline__ void run_gemm_sc(const Args& a, LAS unsigned char* lds) {
    unsigned char* ws = a.ws;
    pg8::Gemm g{(const bf16_t*)(ws + WS_WC) + (L1 ? (size_t)DM * DM : 0), (const bf16_t*)(ws + (L1 ? slot(8) : slot(5))), opaque(DM), opaque(MTOK), opaque(DM)};
    pg8::StaticOrder S; S.init(g.M, g.N, (int)gridDim.x, (int)blockIdx.x);
    EpiF32 E{(float*)(ws + (L1 ? slot(0) : slot(6))), MTOK};
    pg8::gemm_phase<EpiF32, pg8::StaticOrder>(lds, g, S, E, nullptr);
}
template <bool L1> __device__ __forceinline__ void run_topk(const Args& a, LAS unsigned char* lds) {
    unsigned char* ws = a.ws;
    phase_topk(lds, (const float*)(ws + (L1 ? slot(0) : slot(6))), (int*)(ws + WS_EID), (float*)(ws + WS_GATE));
}
template <bool L1> __device__ __forceinline__ void run_peer(const Args& a, LAS unsigned char* lds) {
    unsigned char* ws = a.ws;
    LAS int* HL = (LAS int*)(lds + (threadIdx.x >> 6) * 8192);
    float* Y = (float*)(ws + (L1 ? slot(0) : slot(6)));
    phase_peer_u((const signed char*)(ws + WS_XQ), (const int*)(ws + WS_EID), ws + WS_UB + (L1 ? (size_t)16384 * DM : 0), HL);
    asm volatile("s_waitcnt vmcnt(0) lgkmcnt(0)" ::: "memory");
    phase_peer_w(HL, (const float*)(ws + WS_XS), (const int*)(ws + WS_EID), (const float*)(ws + WS_GATE),
                 (const float*)(ws + WS_USC) + (L1 ? 16384 : 0), (const float*)(ws + WS_VSC) + (L1 ? 16384 : 0), (float*)(ws + WS_W), (float*)(ws + WS_CS));
    asm volatile("s_waitcnt vmcnt(0)" ::: "memory");
    phase_peer_v((const bf16_t*)(ws + (L1 ? slot(8) : slot(5))), (const int*)(ws + WS_EID), (const float*)(ws + WS_W), (const float*)(ws + WS_CS),
                 ws + WS_VB + (L1 ? (size_t)16384 * DM : 0), Y);
    asm volatile("s_waitcnt vmcnt(0)" ::: "memory");
    {
        const int lane = threadIdx.x & 63, gw = blockIdx.x * 8 + (threadIdx.x >> 6), nw = gridDim.x * 8, tpw = (MTOK + nw - 1) / nw, tbase = gw * tpw;
        const int tend = tbase + tpw < MTOK ? tbase + tpw : MTOK;
        const float* g = a.in[12] + (L1 ? 3 : 1) * DM; const float* bta = a.in[13] + (L1 ? 3 : 1) * DM;
        float* outf = L1 ? a.out : (float*)nullptr; bf16_t* outb = L1 ? (bf16_t*)nullptr : (bf16_t*)(ws + slot(2));
        for (int row = tbase; row < tend; ++row) {
            float v[32];
            const float* p = Y + (size_t)row * DM;
#pragma unroll
            for (int i = 0; i < 4; ++i) {
                const f32x4 x0 = *(const f32x4*)(p + 512 * i + 8 * lane), x1 = *(const f32x4*)(p + 512 * i + 8 * lane + 4);
#pragma unroll
                for (int j = 0; j < 4; ++j) { v[i * 8 + j] = x0[j]; v[i * 8 + 4 + j] = x1[j]; }
            }
            ln_row_store(v, g, bta, outf ? outf + (size_t)row * DM : nullptr, outb ? outb + (size_t)row * DM : nullptr, lane);
        }
    }
}


#define XB_TMO      128
#define XB_XCNT(j)  (256  + 64 * (j))
#define XB_XSUB(j)  (1280 + 64 * (j))
#define XB_XGEN(j)  (2304 + 64 * (j))
#define XB_TOP      3328
#define XB_TOPGEN   3392
#define XCD_BAR_WORDS 3456
#define XB_SPIN_CAP (1u << 20)
__device__ __forceinline__ unsigned xb_ld(unsigned* p)              { return __hip_atomic_load(p, __ATOMIC_RELAXED, __HIP_MEMORY_SCOPE_AGENT); }
__device__ __forceinline__ unsigned xb_add(unsigned* p, unsigned v) { return __hip_atomic_fetch_add(p, v, __ATOMIC_RELAXED, __HIP_MEMORY_SCOPE_AGENT); }
__device__ __forceinline__ unsigned xb_xcc_id() { return (unsigned)__builtin_amdgcn_s_getreg((3 << 11) | 20) & 0xFu; }
#define XB_SPIN(cond, bar) do { unsigned _sp = 0; while (cond) { __builtin_amdgcn_s_sleep(1); \
    if ((++_sp & 255u) == 0u) { if (xb_ld(&(bar)[XB_TMO])) break; if (_sp > XB_SPIN_CAP) { atomicAdd(&(bar)[XB_TMO], 1u); break; } } } } while (0)
struct XcdBarrier { unsigned* bar; unsigned x; volatile LAS unsigned* st; };
__device__ __forceinline__ XcdBarrier xcd_barrier_post(unsigned* bar, volatile LAS unsigned* st) {
    XcdBarrier b; b.bar = bar; b.x = xb_xcc_id(); b.st = st;
    if (threadIdx.x == 0) (void)xb_add(&bar[XB_XCNT(b.x)], 1u);
    return b;
}
__device__ __forceinline__ void xcd_barrier_complete(unsigned* bar, unsigned x, unsigned& nloc, unsigned& nx) {
    const unsigned G = gridDim.x * gridDim.y * gridDim.z;
    unsigned sum, cnt, mine, sp = 0u;
    for (;;) {
        sum = 0u; cnt = 0u; mine = 0u;
#pragma unroll
        for (unsigned j = 0; j < 16; ++j) { const unsigned c = xb_ld(&bar[XB_XCNT(j)]); sum += c; cnt += (c > 0u) ? 1u : 0u; mine = (j == x) ? c : mine; }
        if (sum == G) break;
        __builtin_amdgcn_s_sleep(1);
        if ((++sp & 255u) == 0u) { if (xb_ld(&bar[XB_TMO])) break; if (sp > XB_SPIN_CAP) { atomicAdd(&bar[XB_TMO], 1u); break; } }
    }
    nloc = mine > 0u ? mine : 1u; nx = cnt > 0u ? cnt : 1u;
}
__device__ __forceinline__ void xcd_barrier(const XcdBarrier& b) {
    asm volatile("s_waitcnt vmcnt(0)" ::: "memory");
    __syncthreads();
    if (threadIdx.x == 0) {
        unsigned* bar = b.bar;
        __builtin_amdgcn_s_waitcnt(0);
        unsigned nloc = b.st[0], nx = b.st[1];
        if (nloc == 0u) { xcd_barrier_complete(bar, b.x, nloc, nx); b.st[0] = nloc; b.st[1] = nx; }
        const unsigned old = xb_add(&bar[XB_XSUB(b.x)], 1u);
        const unsigned gen = old / nloc;
        if (old + 1u == (gen + 1u) * nloc) {
            __builtin_amdgcn_fence(__ATOMIC_RELEASE, "agent");
            asm volatile("s_waitcnt vmcnt(0)" ::: "memory");
            const unsigned og = xb_add(&bar[XB_TOP], 1u);
            const unsigned tg = og / nx;
            if (og + 1u == (tg + 1u) * nx) xb_add(&bar[XB_TOPGEN], 1u);
            else XB_SPIN(xb_ld(&bar[XB_TOPGEN]) == tg, bar);
            __builtin_amdgcn_fence(__ATOMIC_ACQUIRE, "agent");
            xb_add(&bar[XB_XGEN(b.x)], 1u);
            asm volatile("s_waitcnt vmcnt(0)" ::: "memory");
        } else {
            XB_SPIN(xb_ld(&bar[XB_XGEN(b.x)]) == gen, bar);
            __builtin_amdgcn_fence(__ATOMIC_ACQUIRE, "agent");
            asm volatile("s_waitcnt vmcnt(0)" ::: "memory");
        }
    }
    __syncthreads();
}

__global__ void __launch_bounds__(512, 2) mk_fwd(Args a) {
    extern __shared__ __attribute__((aligned(16))) unsigned char lds_raw[];
    LAS unsigned char* lds = (LAS unsigned char*)lds_raw;
    cg::grid_group grid = cg::this_grid();
    unsigned char* ws = a.ws;
#define PHASE_BEGIN(k) if (a.ph_lo <= (k) && (k) < a.ph_hi && EN(k)) {
    volatile LAS unsigned* xb_st = (volatile LAS unsigned*)(lds + LDS_BYTES - 16);
    if (threadIdx.x < 4) xb_st[threadIdx.x] = 0u;
    unsigned* xb_words = (unsigned*)(ws + WS_BAR);
    __syncthreads();
    XcdBarrier xbar = xcd_barrier_post(xb_words, xb_st);
    if (a.ph_lo < 0) grid.sync();
#define PHASE_END(k) if ((k) + 1 < a.ph_hi) xcd_barrier(xbar); }
    PHASE_BEGIN(0) phase_prep(a, lds);
#if SCAN_DBG == 3 || SCAN_DBG == 5
        if (blockIdx.x == 0 && threadIdx.x < 8) ((unsigned*)(ws + WS_CTR + 8192))[threadIdx.x] = 0u;
#endif
#if SCAN_DBG == 7
        if (blockIdx.x == 0 && threadIdx.x < 32) ((float*)(ws + WS_CTR + 4096))[threadIdx.x] = 0.f;
#endif
    PHASE_END(0)
#if SCAN_DBG == 5
    PHASE_BEGIN(1) dbg_lds16_test(lds, (unsigned*)(ws + WS_CTR + 8192)); PHASE_END(1)
#define SKIP_REST 1
#endif
    PHASE_BEGIN(1) {
        pg8::Gemm g{(const bf16_t*)(ws + slot(0)), (const bf16_t*)(ws + WS_WIN), opaque(MTOK), opaque(4 * DM), opaque(DM)};
        pg8::StaticOrder S; S.init(g.M, g.N, (int)gridDim.x, (int)blockIdx.x);
        EpiKVQ E{(bf16_t*)(ws + slot(1)), (bf16_t*)(ws + slot(2)), (bf16_t*)(ws + slot(3))};
        pg8::gemm_phase<EpiKVQ, pg8::StaticOrder>(lds, g, S, E, nullptr);
    } PHASE_END(1)
    PHASE_BEGIN(2) phase_scan_a(lds, (const bf16_t*)(ws + slot(2)), (const float*)(ws + WS_LB), (const bf16_t*)(ws + slot(3)), (bf16_t*)(ws + slot(6)), (float*)(ws + WS_DEC), QuantJob{a.in[10], a.in[11], ws + WS_UB, ws + WS_VB, (float*)(ws + WS_USC), (float*)(ws + WS_VSC)}
#if SCAN_DBG == 3
        , (unsigned*)(ws + WS_CTR + 8192)
#endif
        );
#if SCAN_DBG == 7
        asm volatile("s_waitcnt vmcnt(0)" ::: "memory"); __syncthreads(); grid.sync(); if (threadIdx.x < 64) { __builtin_amdgcn_fence(__ATOMIC_ACQUIRE, "agent"); asm volatile("s_waitcnt vmcnt(0)" ::: "memory"); } __syncthreads();
        dbg_check_a7((const float*)(ws + slot(4)), (const bf16_t*)(ws + slot(2)), (const bf16_t*)(ws + slot(6)), (float*)(ws + WS_CTR + 4096));
#endif
#if SCAN_DBG == 6
#define DSYNC6() asm volatile("s_waitcnt vmcnt(0)" ::: "memory"); __syncthreads(); grid.sync(); if (threadIdx.x < 64) { __builtin_amdgcn_fence(__ATOMIC_ACQUIRE, "agent"); asm volatile("s_waitcnt vmcnt(0)" ::: "memory"); } __syncthreads();
        DSYNC6()
        phase_scan_a(lds, (const bf16_t*)(ws + slot(2)), (const float*)(ws + WS_LB), (const bf16_t*)(ws + slot(3)), (bf16_t*)a.out, (float*)(ws + WS_DEC), QuantJob{a.in[10], a.in[11], ws + WS_UB, ws + WS_VB, (float*)(ws + WS_USC), (float*)(ws + WS_VSC)});
        DSYNC6()
        dbg_check_a((LAS float*)lds, (const float*)(ws + slot(4)), (const bf16_t*)(ws + slot(2)), (const bf16_t*)(ws + slot(6)), (const bf16_t*)a.out, (float*)(ws + WS_CTR + 4096));
#endif
#if SCAN_DBG == 3
        asm volatile("s_waitcnt vmcnt(0)" ::: "memory"); __syncthreads(); grid.sync();
        dbg_count_bf16((const bf16_t*)(ws + slot(6)), (size_t)4096 * 16384, (unsigned*)(ws + WS_CTR + 8192) + 2);
#endif
    PHASE_END(2)
    PHASE_BEGIN(3) phase_scan_b((bf16_t*)(ws + slot(6)), (const float*)(ws + WS_DEC), QuantJob{a.in[10] + (size_t)16384 * DM, a.in[11] + (size_t)16384 * DM, ws + WS_UB + (size_t)16384 * DM, ws + WS_VB + (size_t)16384 * DM, (float*)(ws + WS_USC) + 16384, (float*)(ws + WS_VSC) + 16384});
#if SCAN_DBG == 3
        asm volatile("s_waitcnt vmcnt(0)" ::: "memory"); __syncthreads(); grid.sync();

#endif
    PHASE_END(3)
    PHASE_BEGIN(4) phase_scan_c(lds, (const bf16_t*)(ws + slot(1)), (const bf16_t*)(ws + slot(2)), (const float*)(ws + WS_LB), (const bf16_t*)(ws + slot(3)), (const bf16_t*)(ws + slot(4)), (const bf16_t*)(ws + slot(6)), a.in[2], (bf16_t*)(ws + slot(0)));
#if SCAN_DBG == 1
        asm volatile("s_waitcnt vmcnt(0)" ::: "memory"); __syncthreads(); grid.sync();
        phase_scan_naive((const bf16_t*)(ws + slot(1)), (const float*)(ws + slot(4)), (const bf16_t*)(ws + slot(2)), (float*)(ws + slot(6)));
        asm volatile("s_waitcnt vmcnt(0)" ::: "memory"); __syncthreads(); grid.sync();
        phase_onorm((const float*)(ws + slot(6)), (const bf16_t*)(ws + slot(3)), a.in[2], (bf16_t*)(ws + slot(0)));
#endif
#if SCAN_DBG == 3
        asm volatile("s_waitcnt vmcnt(0)" ::: "memory"); __syncthreads(); grid.sync();

#endif
#if SCAN_DBG == 4
#define DSYNC() asm volatile("s_waitcnt vmcnt(0)" ::: "memory"); __syncthreads(); grid.sync(); if (threadIdx.x < 64) { __builtin_amdgcn_fence(__ATOMIC_ACQUIRE, "agent"); asm volatile("s_waitcnt vmcnt(0)" ::: "memory"); } __syncthreads();
        DSYNC()
        phase_scan_naive((const bf16_t*)(ws + slot(1)), (const float*)(ws + slot(4)), (const bf16_t*)(ws + slot(2)), (float*)(ws + slot(6)));
        DSYNC()
        phase_onorm((const float*)(ws + slot(6)), (const bf16_t*)(ws + slot(3)), a.in[2], (bf16_t*)(ws + slot(8)));
        DSYNC()
        phase_scan_a(lds, (const bf16_t*)(ws + slot(2)), (const float*)(ws + WS_LB), (const bf16_t*)(ws + slot(3)), (bf16_t*)(ws + slot(6)), (float*)(ws + WS_DEC), QuantJob{a.in[10], a.in[11], ws + WS_UB, ws + WS_VB, (float*)(ws + WS_USC), (float*)(ws + WS_VSC)});
        DSYNC()
        phase_scan_b((bf16_t*)(ws + slot(6)), (const float*)(ws + WS_DEC), QuantJob{a.in[10] + (size_t)16384 * DM, a.in[11] + (size_t)16384 * DM, ws + WS_UB + (size_t)16384 * DM, ws + WS_VB + (size_t)16384 * DM, (float*)(ws + WS_USC) + 16384, (float*)(ws + WS_VSC) + 16384});
        DSYNC()
        phase_scan_c(lds, (const bf16_t*)(ws + slot(1)), (const bf16_t*)(ws + slot(2)), (const float*)(ws + WS_LB), (const bf16_t*)(ws + slot(3)), (const bf16_t*)(ws + slot(4)), (const bf16_t*)(ws + slot(6)), a.in[2], (bf16_t*)a.out);
        DSYNC()
        dbg_compare4((LAS float*)lds, (const bf16_t*)(ws + slot(0)), (const bf16_t*)(ws + slot(8)), (const bf16_t*)a.out, (float*)(ws + WS_CTR + 4096));
#endif
#if SCAN_DBG == 2
        asm volatile("s_waitcnt vmcnt(0)" ::: "memory"); __syncthreads(); grid.sync();
        phase_scan_naive((const bf16_t*)(ws + slot(1)), (const float*)(ws + slot(4)), (const bf16_t*)(ws + slot(2)), (float*)(ws + slot(6)));
        asm volatile("s_waitcnt vmcnt(0)" ::: "memory"); __syncthreads(); grid.sync();
        phase_onorm((const float*)(ws + slot(6)), (const bf16_t*)(ws + slot(3)), a.in[2], (bf16_t*)(ws + slot(8)));
        asm volatile("s_waitcnt vmcnt(0)" ::: "memory"); __syncthreads(); grid.sync();
        dbg_compare((LAS float*)lds, (const bf16_t*)(ws + slot(0)), (const bf16_t*)(ws + slot(8)), (float*)(ws + WS_CTR + 4096));
#endif
    PHASE_END(4)
    PHASE_BEGIN(5) run_gemm_out<false>(a, lds); PHASE_END(5)
    PHASE_BEGIN(6) run_ln<false>(a); PHASE_END(6)
    PHASE_BEGIN(7) run_gemm_sc<false>(a, lds); PHASE_END(7)
    PHASE_BEGIN(8) run_topk<false>(a, lds); PHASE_END(8)
    PHASE_BEGIN(9) run_peer<false>(a, lds); PHASE_END(9)
    PHASE_BEGIN(10) {
        pg8::Gemm g{(const bf16_t*)(ws + slot(2)), (const bf16_t*)(ws + WS_WKVQ), opaque(MTOK), opaque(3 * DM), opaque(DM)};
        pg8::StaticOrder S; S.init(g.M, g.N, (int)gridDim.x, (int)blockIdx.x);
        EpiKVQR E{(bf16_t*)(ws + slot(3)), (const float*)(ws + WS_COS), (const float*)(ws + WS_SIN)};
        pg8::gemm_phase<EpiKVQR, pg8::StaticOrder>(lds, g, S, E, nullptr);
    } PHASE_END(10)
    PHASE_BEGIN(11) phase_kstat((LAS float*)lds, (const bf16_t*)(ws + slot(3)), (float*)(ws + WS_KMEAN), (float*)(ws + WS_KNMAX)); PHASE_END(11)
    PHASE_BEGIN(12) phase_sel(lds, (const bf16_t*)(ws + slot(5)), (const float*)(ws + WS_KMEAN), (unsigned short*)(ws + WS_SUB), (int*)(ws + WS_CNT), (int*)(ws + WS_CTR)); PHASE_END(12)
    PHASE_BEGIN(13) phase_att(lds, (const bf16_t*)(ws + slot(5)), (const bf16_t*)(ws + slot(3)), (const bf16_t*)(ws + slot(4)), (const float*)(ws + WS_KNMAX), (const unsigned short*)(ws + WS_SUB),
                              (const int*)(ws + WS_CNT), (int*)(ws + WS_CTR), (bf16_t*)(ws + slot(6)), (bf16_t*)(ws + slot(0)), (float*)(ws + WS_LS)); PHASE_END(13)
    PHASE_BEGIN(14) phase_comb((const bf16_t*)(ws + slot(6)), (const bf16_t*)(ws + slot(0)), (const float*)(ws + WS_LS), (bf16_t*)(ws + slot(3))); PHASE_END(14)
    PHASE_BEGIN(15) run_gemm_out<true>(a, lds); PHASE_END(15)
    PHASE_BEGIN(16) run_ln<true>(a); PHASE_END(16)
    PHASE_BEGIN(17) run_gemm_sc<true>(a, lds); PHASE_END(17)
    PHASE_BEGIN(18) run_topk<true>(a, lds); PHASE_END(18)
#if SCAN_DBG == 7
    PHASE_BEGIN(19) dbg_emit7((const float*)(ws + WS_CTR + 4096), a.out); PHASE_END(19)
#elif SCAN_DBG == 6
    PHASE_BEGIN(19) dbg_emit4((const float*)(ws + WS_CTR + 4096), a.out); PHASE_END(19)
#elif SCAN_DBG == 5
    PHASE_BEGIN(19) dbg_emit5((const unsigned*)(ws + WS_CTR + 8192), a.out); PHASE_END(19)
#elif SCAN_DBG == 4
    PHASE_BEGIN(19) dbg_emit4((const float*)(ws + WS_CTR + 4096), a.out); PHASE_END(19)
#elif SCAN_DBG == 3
    PHASE_BEGIN(19) dbg_emit3((const unsigned*)(ws + WS_CTR + 8192), a.out); PHASE_END(19)
#elif SCAN_DBG == 2
    PHASE_BEGIN(19) dbg_emit((const float*)(ws + WS_CTR + 4096), a.out); PHASE_END(19)
#else
    PHASE_BEGIN(19) run_peer<true>(a, lds); PHASE_END(19)
#endif
}

extern "C" void kernel_launch(void* const* d_in, const int* in_sizes, int n_in, void* d_out, int out_size, void* d_ws, size_t ws_size, hipStream_t stream) {
    static int grid = 0;
    if (grid == 0) {
        if (n_in != 14 || out_size != MTOK * DM || ws_size < WS_END) { fprintf(stderr, "kernel_launch: unexpected shapes (n_in %d, out %d, ws %zu)\n", n_in, out_size, ws_size); grid = -1; return; }
        int dev = 0, cus = 0, per_cu = 0;
        if (hipGetDevice(&dev) != hipSuccess || hipDeviceGetAttribute(&cus, hipDeviceAttributeMultiprocessorCount, dev) != hipSuccess) { grid = -1; return; }
        if (hipFuncSetAttribute((const void*)mk_fwd, hipFuncAttributeMaxDynamicSharedMemorySize, LDS_BYTES) != hipSuccess) { fprintf(stderr, "kernel_launch: hipFuncSetAttribute failed\n"); grid = -1; return; }
        if (hipOccupancyMaxActiveBlocksPerMultiprocessor(&per_cu, (const void*)mk_fwd, 512, LDS_BYTES) != hipSuccess || per_cu < 1) { fprintf(stderr, "kernel_launch: occupancy query failed (%d)\n", per_cu); (void)hipGetLastError(); per_cu = 1; }
        grid = cus * (per_cu > 1 ? 1 : per_cu);
    }
    if (grid < 0) return;
    Args a{};
    for (int i = 0; i < 14; ++i) a.in[i] = (const float*)d_in[i];
    a.out = (float*)d_out; a.ws = (unsigned char*)d_ws;
#if ONE_LAUNCH
    a.ph_lo = 0; a.ph_hi = NPH;
    (void)hipMemsetAsync((unsigned char*)d_ws + WS_BAR, 0, XCD_BAR_WORDS * sizeof(unsigned), stream);
    void* args[] = {&a};
    hipError_t e = hipLaunchCooperativeKernel((const void*)mk_fwd, dim3(grid), dim3(512), args, LDS_BYTES, stream);
    if (e != hipSuccess) fprintf(stderr, "cooperative launch failed: %s (grid %d)\n", hipGetErrorString(e), grid);
#else
    for (int ph = 0; ph < NPH; ++ph) {
        a.ph_lo = ph; a.ph_hi = ph + 1;
        hipLaunchKernelGGL(mk_fwd, dim3(grid), dim3(512), LDS_BYTES, stream, a);
    }
#endif
}
```

```cpp
#define ONE_LAUNCH 1
#include <hip/hip_runtime.h>
#include <hip/hip_cooperative_groups.h>
#include <cstdio>
namespace cg = cooperative_groups;

#ifndef ONE_LAUNCH
#define ONE_LAUNCH 0
#endif
#ifndef SCAN_DBG
#define SCAN_DBG 0
#endif
#ifndef SCAN_A_VALU
#define SCAN_A_VALU 0
#endif
#ifndef ENMASK
#define ENMASK 0xffffffffu
#endif
#define EN(k) ((ENMASK >> (k)) & 1u)

namespace pg8 {
#define PG8_LAS __attribute__((address_space(3)))
typedef unsigned short bf16_t;
typedef short bf16x8 __attribute__((ext_vector_type(8)));
typedef float f32x4 __attribute__((ext_vector_type(4)));
typedef unsigned u32x4 __attribute__((ext_vector_type(4)));
constexpr int BM = 256, BK = 64, HALF = 128, HTB = HALF * BK * 2  , STAGE_BYTES = 8 * HTB, NXCD = 8, WGM = 8;

__host__ __device__ __forceinline__ int lds_byte(int r, int c) { const int st = (r >> 4) * 2 + (c >> 5), rr = r & 15, cc = c & 31, ob = rr * 64 + cc * 2; return st * 1024 + (ob ^ (((ob >> 9) & 1) << 5)); }
__host__ __device__ __forceinline__ void stage_rc(int b, int& R, int& C) { const int st = b / 1024, sb = b % 1024, swz = sb ^ (((sb >> 9) & 1) << 5); R = (st >> 1) * 16 + swz / 64; C = (st & 1) * 32 + (swz % 64) / 2; }
__host__ __device__ __forceinline__ int perm32(int rho) { const int n = rho >> 4, i = rho & 15; return 8 * (i >> 2) + 4 * n + (i & 3); }

struct Unit { int pm, pn; };
struct Gemm { const bf16_t* A; const bf16_t* Bt; int M, N, K; };

struct StaticOrder {
    int nM, nN, nwg, G, c;
    __host__ __device__ void init(int M, int N, int G_, int c_) { nM = M / BM; nN = N / BM; nwg = nM * nN; G = G_; c = c_; }
    __host__ __device__ bool next(int i, Unit& u) const {
        const long L = (long)i * G + c; if (L >= nwg) return false;
        int wgid = (int)L; { const int q = nwg / NXCD, r = nwg % NXCD, xcd = wgid % NXCD, off = wgid / NXCD; wgid = (xcd < r ? xcd * (q + 1) : r * (q + 1) + (xcd - r) * q) + off; }
        const int nig = WGM * nN, gid = wgid / nig, fm = gid * WGM, gsz = (nM - fm) < WGM ? (nM - fm) : WGM;
        u.pm = fm + ((wgid % nig) % gsz); u.pn = (wgid % nig) / gsz; return true;
    }
    __device__ __forceinline__ void a_ready(const Unit&) const {}
    __device__ __forceinline__ void done(const Unit&) const {}
};
struct CountedOrder : StaticOrder {
    const unsigned* ready; unsigned need; unsigned* tmo;
    __device__ __forceinline__ void a_ready(const Unit& u) const {
        if (threadIdx.x < 64) {
            const unsigned long long t0 = __builtin_amdgcn_s_memrealtime(); unsigned polls = 0;
            while ((unsigned)__builtin_amdgcn_readfirstlane(__hip_atomic_load(ready + 64 * u.pm, __ATOMIC_RELAXED, __HIP_MEMORY_SCOPE_AGENT)) < need) {
                if ((++polls & 255u) == 0u && __builtin_amdgcn_readfirstlane(__hip_atomic_load(tmo, __ATOMIC_RELAXED, __HIP_MEMORY_SCOPE_AGENT)) != 0u) break;
                if (__builtin_amdgcn_s_memrealtime() - t0 > 2000000ull) {
                    if (threadIdx.x == 0) { unsigned expect = 0u; __hip_atomic_compare_exchange_strong(tmo + 1, &expect, 0x600u | (unsigned)(u.pm & 0xff), __ATOMIC_RELAXED, __ATOMIC_RELAXED, __HIP_MEMORY_SCOPE_AGENT); __hip_atomic_store(tmo, 1u, __ATOMIC_RELAXED, __HIP_MEMORY_SCOPE_AGENT); }
                    break; }
                __builtin_amdgcn_s_sleep(2); }
            __builtin_amdgcn_fence(__ATOMIC_ACQUIRE, "agent");
            asm volatile("s_waitcnt vmcnt(0)" ::: "memory");
        }
#if !defined(BROKEN_HOOK_NO_BARRIER)
        asm volatile("" ::: "memory"); __builtin_amdgcn_s_barrier(); asm volatile("" ::: "memory");
#endif
    }
};

__device__ __forceinline__ unsigned cvt_pk_bf16(float lo, float hi) { unsigned r; asm volatile("v_cvt_pk_bf16_f32 %0, %1, %2" : "=v"(r) : "v"(lo), "v"(hi)); return r; }
typedef float f32x2 __attribute__((ext_vector_type(2)));
__device__ __forceinline__ f32x2 gelu_pk(f32x2 v) {
    const f32x2 av = __builtin_elementwise_abs(v), d = av * 0.2316418882f + 1.0f;
    f32x2 t; t.x = __builtin_amdgcn_rcpf(d.x); t.y = __builtin_amdgcn_rcpf(d.y);
    f32x2 q = t * 0.5307027145f + (-0.7265760135f); q = q * t + 0.7107068705f; q = q * t + (-0.142248368f); q = q * t + 0.127414796f; q = q * t;
    const f32x2 s = (v * v) * (-0.72134752044f);
    f32x2 e; e.x = __builtin_amdgcn_exp2f(s.x); e.y = __builtin_amdgcn_exp2f(s.y);
    const f32x2 m = v * (q * e), r = v - m;
    f32x2 o; o.x = v.x < 0.f ? m.x : r.x; o.y = v.y < 0.f ? m.y : r.y; return o;
}

struct EpiF32 {
    static constexpr bool PERM = false, AFTER_DRAIN = false;
    float* C; int ldc; const float* bias;
    __device__ __forceinline__ void operator()(const f32x4 (&acc)[2][2][4][2], const Unit& u, int wr, int wc, int fr, int fq) const {
        const int row0 = u.pm * BM + wr * 64 + fr, col0 = u.pn * BM + wc * 32 + 4 * fq;
        f32x4 bv[2][2];
#pragma unroll
        for (int bj = 0; bj < 2; ++bj)
#pragma unroll
            for (int n = 0; n < 2; ++n) bv[bj][n] = bias ? *(const f32x4*)(bias + col0 + bj * HALF + n * 16) : (f32x4){0.f, 0.f, 0.f, 0.f};
#pragma unroll
        for (int ai = 0; ai < 2; ++ai)
#pragma unroll
            for (int m = 0; m < 4; ++m) { float* rowp = C + (size_t)(row0 + ai * HALF + m * 16) * ldc + col0;
#pragma unroll
                for (int bj = 0; bj < 2; ++bj)
#pragma unroll
                    for (int n = 0; n < 2; ++n) *(f32x4*)(rowp + bj * HALF + n * 16) = acc[ai][bj][m][n] + bv[bj][n]; }
    }
};
template <int ACT  > struct EpiBf16 {
    static constexpr bool PERM = true, AFTER_DRAIN = false;
    bf16_t* O; int ldc; const float* bias; int split_cols; size_t split_stride;
    __device__ __forceinline__ void operator()(const f32x4 (&acc)[2][2][4][2], const Unit& u, int wr, int wc, int fr, int fq) const {
        const int row0 = u.pm * BM + wr * 64 + fr; int colt = u.pn * BM; bf16_t* base = O;
        if (split_cols) { const int t = colt / split_cols; base += (size_t)t * split_stride; colt -= t * split_cols; }
        const int col0 = colt + wc * 32 + 8 * fq, bcol0 = u.pn * BM + wc * 32 + 8 * fq;
        f32x4 bv[2][2];
#pragma unroll
        for (int bj = 0; bj < 2; ++bj)
#pragma unroll
            for (int n = 0; n < 2; ++n) bv[bj][n] = bias ? *(const f32x4*)(bias + bcol0 + bj * HALF + 4 * n) : (f32x4){0.f, 0.f, 0.f, 0.f};
#pragma unroll
        for (int ai = 0; ai < 2; ++ai)
#pragma unroll
            for (int m = 0; m < 4; ++m) { bf16_t* rowp = base + (size_t)(row0 + ai * HALF + m * 16) * ldc + col0;
#pragma unroll
                for (int bj = 0; bj < 2; ++bj) { f32x4 v0 = acc[ai][bj][m][0] + bv[bj][0], v1 = acc[ai][bj][m][1] + bv[bj][1];
                    if (ACT == 1) { f32x2 a = gelu_pk((f32x2){v0[0], v0[1]}), b = gelu_pk((f32x2){v0[2], v0[3]}), c = gelu_pk((f32x2){v1[0], v1[1]}), d = gelu_pk((f32x2){v1[2], v1[3]});
                        v0 = (f32x4){a.x, a.y, b.x, b.y}; v1 = (f32x4){c.x, c.y, d.x, d.y}; }
                    if (ACT == 2) {
#pragma unroll
                        for (int j = 0; j < 4; ++j) { v0[j] = 0.5f * v0[j] * (1.0f + erff(v0[j] * 0.70710678f)); v1[j] = 0.5f * v1[j] * (1.0f + erff(v1[j] * 0.70710678f)); } }
                    u32x4 w; w.x = cvt_pk_bf16(v0[0], v0[1]); w.y = cvt_pk_bf16(v0[2], v0[3]); w.z = cvt_pk_bf16(v1[0], v1[1]); w.w = cvt_pk_bf16(v1[2], v1[3]);
                    *(u32x4*)(rowp + bj * HALF) = w; } }
    }
};

template <class Epi, class Sched, bool STAMP = false>
__device__ __forceinline__ void gemm_phase(PG8_LAS unsigned char* lds, const Gemm g, const Sched& S, const Epi& E, unsigned long long* stamps) {
    const int tid = threadIdx.x, wid = __builtin_amdgcn_readfirstlane(tid >> 6), lane = tid & 63, wr = wid >> 2, wc = wid & 3, fr = lane & 15, fq = lane >> 4;
    const int K = g.K, nt = K / BK;
    int ts_lo = 0, ts_hi = 0, nts = 0; const unsigned long long rt_entry = STAMP ? (unsigned long long)wall_clock64() : 0ull;
#define PG8_STAMP() do { if (STAMP && wid == 0 && nts < 64) { const unsigned long long _c = (unsigned long long)clock64(); \
        ts_lo = (lane == nts) ? (int)(unsigned)_c : ts_lo; ts_hi = (lane == nts) ? (int)(unsigned)(_c >> 32) : ts_hi; ++nts; } } while (0)
    PG8_STAMP();
    unsigned voffA[2], voffB[2];
#pragma unroll
    for (int i = 0; i < 2; ++i) { int R, C; stage_rc(tid * 16 + i * 8192, R, C); const int Rb = Epi::PERM ? ((R & ~31) + perm32(R & 31)) : R;
        voffA[i] = (unsigned)(R * K + C) * 2u; voffB[i] = (unsigned)(Rb * K + C) * 2u; }
    const size_t kstep = (size_t)(BK * 2);
    const size_t hstep = (size_t)HALF * K * 2;
    const size_t tstep = 2 * hstep;
    const unsigned ldsw = (unsigned)wid * 1024u;
    const int aoff = lds_byte(wr * 64 + fr, fq * 8), boff = lds_byte(wc * 32 + fr, fq * 8);
#define PG8_SA(b, h) (((b) * 2 + (h)) * HTB)
#define PG8_SB(b, h) ((4 + (b) * 2 + (h)) * HTB)
#define PG8_STAGE(bufoff, gbase, voff) do { _Pragma("unroll") for (int _i = 0; _i < 2; ++_i) \
        __builtin_amdgcn_global_load_lds((const unsigned*)((const char*)(gbase) + (voff)[_i]), (PG8_LAS unsigned*)(lds + (bufoff) + ldsw + _i * 8192), 16, 0, 0); } while (0)
#define PG8_LDA(dst, b, h) do { _Pragma("unroll") for (int m = 0; m < 4; ++m) _Pragma("unroll") for (int k = 0; k < 2; ++k) dst[m][k] = *(const PG8_LAS bf16x8*)(lds + PG8_SA(b, h) + aoff + m * 2048 + k * 1024); } while (0)
#define PG8_LDB(dst, b, h) do { _Pragma("unroll") for (int n = 0; n < 2; ++n) _Pragma("unroll") for (int k = 0; k < 2; ++k) dst[n][k] = *(const PG8_LAS bf16x8*)(lds + PG8_SB(b, h) + boff + n * 2048 + k * 1024); } while (0)
#define PG8_MMA(ai, bj, At, Bt) do { __builtin_amdgcn_s_setprio(1); _Pragma("unroll") for (int m = 0; m < 4; ++m) _Pragma("unroll") for (int n = 0; n < 2; ++n) _Pragma("unroll") for (int k = 0; k < 2; ++k) \
        acc[ai][bj][m][n] = __builtin_amdgcn_mfma_f32_16x16x32_bf16(Bt[n][k], At[m][k], acc[ai][bj][m][n], 0, 0, 0); __builtin_amdgcn_s_setprio(0); } while (0)
#define PG8_WAIT_V(n) asm volatile("s_waitcnt vmcnt(" #n ")" ::: "memory")
#define PG8_WAIT_L(n) asm volatile("s_waitcnt lgkmcnt(" #n ")" ::: "memory")
#define PG8_BAR __builtin_amdgcn_s_barrier()
#define PG8_SCHED __builtin_amdgcn_sched_barrier(0)
    Unit cur, nxt; int ui = 0;
    if (!S.next(0, cur)) return;
    f32x4 acc[2][2][4][2];
#pragma unroll
    for (int a = 0; a < 2; ++a)
#pragma unroll
        for (int b = 0; b < 2; ++b)
#pragma unroll
            for (int m = 0; m < 4; ++m)
#pragma unroll
                for (int n = 0; n < 2; ++n) acc[a][b][m][n] = (f32x4){0.f, 0.f, 0.f, 0.f};
    bf16x8 At[4][2], B0[2][2], B1[2][2];
    const char* cA = (const char*)g.A + (size_t)cur.pm * tstep; const char* cB = (const char*)g.Bt + (size_t)cur.pn * tstep;
    S.a_ready(cur);
    PG8_STAGE(PG8_SB(0, 0), cB, voffB); PG8_STAGE(PG8_SA(0, 0), cA, voffA); PG8_STAGE(PG8_SB(0, 1), cB + hstep, voffB); PG8_STAGE(PG8_SA(0, 1), cA + hstep, voffA);
    if (wr == 1) PG8_BAR;
    PG8_WAIT_V(4); PG8_BAR;
    PG8_STAGE(PG8_SB(1, 0), cB + kstep, voffB); PG8_STAGE(PG8_SA(1, 0), cA + kstep, voffA); PG8_STAGE(PG8_SB(1, 1), cB + hstep + kstep, voffB);
    PG8_WAIT_V(6); PG8_BAR;
    PG8_STAMP();
    for (;;) {
        const bool has_next = S.next(ui + 1, nxt);
        const char* nA = has_next ? (const char*)g.A + (size_t)nxt.pm * tstep : cA; const char* nB = has_next ? (const char*)g.Bt + (size_t)nxt.pn * tstep : cB;
        for (int t = 0; t < nt; t += 2) {
            const bool last = (t == nt - 2);
            const char* a1 = cA + (size_t)(t + 1) * kstep;
            const char* a2 = last ? nA : cA + (size_t)(t + 2) * kstep; const char* b2 = last ? nB : cB + (size_t)(t + 2) * kstep;
            const char* a3 = a2 + kstep; const char* b3 = b2 + kstep;
            if (last && has_next) S.a_ready(nxt);
            PG8_LDB(B0, 0, 0); PG8_SCHED; PG8_LDA(At, 0, 0); PG8_STAGE(PG8_SA(1, 1), a1 + hstep, voffA);
            PG8_WAIT_L(8); PG8_BAR; PG8_WAIT_L(0); PG8_MMA(0, 0, At, B0); PG8_BAR; PG8_SCHED;
            PG8_LDB(B1, 0, 1); PG8_STAGE(PG8_SB(0, 0), b2, voffB);
            PG8_BAR; PG8_WAIT_L(0); PG8_MMA(0, 1, At, B1); PG8_BAR;
            PG8_LDA(At, 0, 1); PG8_STAGE(PG8_SA(0, 0), a2, voffA);
            PG8_BAR; PG8_WAIT_L(0); PG8_MMA(1, 0, At, B0); PG8_BAR; PG8_SCHED;
            PG8_STAGE(PG8_SB(0, 1), b2 + hstep, voffB);
            PG8_WAIT_V(6); PG8_BAR; PG8_MMA(1, 1, At, B1); PG8_BAR;
            PG8_LDB(B0, 1, 0); PG8_SCHED; PG8_LDA(At, 1, 0); PG8_STAGE(PG8_SA(0, 1), a2 + hstep, voffA);
            PG8_WAIT_L(8); PG8_BAR; PG8_WAIT_L(0); PG8_MMA(0, 0, At, B0); PG8_BAR; PG8_SCHED;
            PG8_LDB(B1, 1, 1); PG8_STAGE(PG8_SB(1, 0), b3, voffB);
            PG8_BAR; PG8_WAIT_L(0); PG8_MMA(0, 1, At, B1); PG8_BAR;
            PG8_LDA(At, 1, 1); PG8_STAGE(PG8_SA(1, 0), a3, voffA);
            PG8_BAR; PG8_WAIT_L(0); PG8_MMA(1, 0, At, B0); PG8_BAR; PG8_SCHED;
            PG8_STAGE(PG8_SB(1, 1), b3 + hstep, voffB);
            PG8_WAIT_V(6); PG8_BAR; PG8_MMA(1, 1, At, B1); PG8_BAR;
        }
        PG8_STAMP();
        if constexpr (!Epi::AFTER_DRAIN) { E(acc, cur, wr, wc, fr, fq); S.done(cur); }
        PG8_STAMP();
        if (!has_next) break;
#pragma unroll
        for (int a = 0; a < 2; ++a)
#pragma unroll
            for (int b = 0; b < 2; ++b)
#pragma unroll
                for (int m = 0; m < 4; ++m)
#pragma unroll
                    for (int n = 0; n < 2; ++n) acc[a][b][m][n] = (f32x4){0.f, 0.f, 0.f, 0.f};
        cur = nxt; cA = nA; cB = nB; ++ui;
    }
    PG8_WAIT_V(0);
    if (wr == 0) PG8_BAR;
    PG8_BAR;
    if constexpr (Epi::AFTER_DRAIN) { E.fused(acc, cur, wr, wc, fr, fq, lds, wid, lane); S.done(cur); }
    PG8_STAMP();
    if (STAMP && wid == 0) { stamps[lane] = lane < nts ? (((unsigned long long)(unsigned)ts_hi << 32) | (unsigned)ts_lo) : 0ull;
        if (lane == 62) stamps[62] = rt_entry; if (lane == 63) stamps[63] = (unsigned long long)wall_clock64(); }
#undef PG8_STAMP
#undef PG8_SA
#undef PG8_SB
#undef PG8_STAGE
#undef PG8_LDA
#undef PG8_LDB
#undef PG8_MMA
#undef PG8_WAIT_V
#undef PG8_WAIT_L
#undef PG8_BAR
#undef PG8_SCHED
}
}


#define LAS __attribute__((address_space(3)))
typedef unsigned short bf16_t;
typedef float f32x4 __attribute__((ext_vector_type(4)));
typedef unsigned u32x4 __attribute__((ext_vector_type(4)));
typedef unsigned u32x2 __attribute__((ext_vector_type(2)));
typedef short bf16x8 __attribute__((ext_vector_type(8)));
typedef short s16x4 __attribute__((ext_vector_type(4)));
typedef float f32x16 __attribute__((ext_vector_type(16)));

constexpr int MTOK = 16384, DM = 2048, SEQ = 8192, NHEAD = 16;
constexpr float ALPHA = 1.41421356237309515f;
constexpr size_t MiB = (size_t)1 << 20;
constexpr size_t WS_WIN = 0, WS_WOUT = 32 * MiB, WS_WKVQ = 40 * MiB, WS_WO = 64 * MiB, WS_WC = 72 * MiB, WS_UB = 88 * MiB, WS_VB = 152 * MiB, WS_USC = 216 * MiB, WS_VSC = 217 * MiB, WS_H = 224 * MiB, WS_XQ = 232 * MiB, WS_XS = 264 * MiB, WS_W = 272 * MiB, WS_CS = 280 * MiB, WS_SLOT = 344 * MiB;
constexpr size_t WS_EID = 920 * MiB, WS_GATE = 928 * MiB, WS_COS = 936 * MiB, WS_SIN = 938 * MiB, WS_KMEAN = 940 * MiB, WS_LB = 941 * MiB, WS_LS = 942 * MiB, WS_SUB = 946 * MiB, WS_CNT = 962 * MiB, WS_CTR = 963 * MiB, WS_DEC = 964 * MiB, WS_END = 966 * MiB;
constexpr size_t WS_BAR = WS_CTR + 65536;
constexpr size_t WS_KNMAX = WS_KMEAN + 768 * 1024;
__host__ __device__ constexpr size_t slot(int i) { return WS_SLOT + (size_t)i * 64 * MiB; }
constexpr int LDS_BYTES = 144 * 1024;
constexpr int NPH = 20;

struct Args { const float* in[14]; float* out; unsigned char* ws; int ph_lo, ph_hi; };

__device__ __forceinline__ float bflo(unsigned w) { return __uint_as_float(w << 16); }
__device__ __forceinline__ float bfhi(unsigned w) { return __uint_as_float(w & 0xffff0000u); }
__device__ __forceinline__ float bf2f(bf16_t b) { return __uint_as_float(((unsigned)b) << 16); }
typedef __bf16 bf16x2_t __attribute__((ext_vector_type(2)));
typedef float f32x2_t __attribute__((ext_vector_type(2)));
__device__ __forceinline__ unsigned pk_bf16(float lo, float hi) { const f32x2_t f = {lo, hi}; return __builtin_bit_cast(unsigned, __builtin_convertvector(f, bf16x2_t)); }
__device__ __forceinline__ float wave_sum(float v) {
#pragma unroll
    for (int o = 32; o >= 1; o >>= 1) v += __shfl_xor(v, o);
    return v;
}
__device__ __forceinline__ float wave_max(float v) {
#pragma unroll
    for (int o = 32; o >= 1; o >>= 1) v = fmaxf(v, __shfl_xor(v, o));
    return v;
}
__device__ __forceinline__ float sigmoidf_(float z) { return 1.0f / (1.0f + __expf(-z)); }


__device__ __forceinline__ void store_wt16(void* p, u32x4 v) {
    __hip_atomic_store((unsigned long long*)p, ((unsigned long long)v.y << 32) | v.x, __ATOMIC_RELAXED, __HIP_MEMORY_SCOPE_AGENT);
    __hip_atomic_store((unsigned long long*)p + 1, ((unsigned long long)v.w << 32) | v.z, __ATOMIC_RELAXED, __HIP_MEMORY_SCOPE_AGENT);
}
__device__ __forceinline__ void store_wt8(void* p, u32x2 v) {
    __hip_atomic_store((unsigned long long*)p, ((unsigned long long)v.y << 32) | v.x, __ATOMIC_RELAXED, __HIP_MEMORY_SCOPE_AGENT);
}
struct EpiIn {
    static constexpr bool PERM = true, AFTER_DRAIN = false;
    bf16_t* Q1; float* LF; bf16_t* I1; bf16_t* G1; const float* LB;
    __device__ __forceinline__ void operator()(const pg8::f32x4 (&acc)[2][2][4][2], const pg8::Unit& u, int wr, int wc, int fr, int fq) const {
        const int type = u.pn >> 3;
        const int row0 = u.pm * 256 + wr * 64 + fr, col0 = (u.pn & 7) * 256 + wc * 32 + 8 * fq;
        if (type == 1) {
#pragma unroll
            for (int bj = 0; bj < 2; ++bj) {
                const int c = col0 + bj * 128;
                const f32x4 lb0 = *(const f32x4*)(LB + c), lb1 = *(const f32x4*)(LB + c + 4);
#pragma unroll
                for (int ai = 0; ai < 2; ++ai)
#pragma unroll
                    for (int m = 0; m < 4; ++m) {
                        float* p = LF + (size_t)(row0 + ai * 128 + m * 16) * DM + c;
                        f32x4 o0, o1;
#pragma unroll
                        for (int j = 0; j < 4; ++j) {
                            o0[j] = __logf(lb0[j] + (1.0f - lb0[j]) * sigmoidf_(acc[ai][bj][m][0][j]));
                            o1[j] = __logf(lb1[j] + (1.0f - lb1[j]) * sigmoidf_(acc[ai][bj][m][1][j]));
                        }
                        *(f32x4*)p = o0; *(f32x4*)(p + 4) = o1;
                    }
            }
        } else {
            bf16_t* dst = Q1 + (size_t)(type - (type > 0 ? 1 : 0)) * ((size_t)32 << 20);
            const bool act = (type != 2);
#pragma unroll
            for (int ai = 0; ai < 2; ++ai)
#pragma unroll
                for (int m = 0; m < 4; ++m)
#pragma unroll
                    for (int bj = 0; bj < 2; ++bj) {
                        f32x4 v0 = acc[ai][bj][m][0], v1 = acc[ai][bj][m][1];
                        if (act) {
#pragma unroll
                            for (int j = 0; j < 4; ++j) { v0[j] = v0[j] * sigmoidf_(v0[j]); v1[j] = v1[j] * sigmoidf_(v1[j]); }
                        }
                        u32x4 w; w.x = pk_bf16(v0[0], v0[1]); w.y = pk_bf16(v0[2], v0[3]); w.z = pk_bf16(v1[0], v1[1]); w.w = pk_bf16(v1[2], v1[3]);
                        *(u32x4*)(dst + (size_t)(row0 + ai * 128 + m * 16) * DM + col0 + bj * 128) = w;
                    }
        }
    }
};
struct EpiRes {
    static constexpr bool PERM = false, AFTER_DRAIN = false;
    const float* res; float* Y;
    __device__ __forceinline__ void operator()(const pg8::f32x4 (&acc)[2][2][4][2], const pg8::Unit& u, int wr, int wc, int fr, int fq) const {
        const int row0 = u.pm * 256 + wr * 64 + fr, col0 = u.pn * 256 + wc * 32 + 4 * fq;
#pragma unroll
        for (int ai = 0; ai < 2; ++ai)
#pragma unroll
            for (int m = 0; m < 4; ++m) {
                const size_t off = (size_t)(row0 + ai * 128 + m * 16) * DM + col0;
#pragma unroll
                for (int bj = 0; bj < 2; ++bj)
#pragma unroll
                    for (int n = 0; n < 2; ++n) {
                        const f32x4 r = *(const f32x4*)(res + off + bj * 128 + n * 16);
                        *(f32x4*)(Y + off + bj * 128 + n * 16) = r * ALPHA + acc[ai][bj][m][n];
                    }
            }
    }
};
struct EpiF32 {
    static constexpr bool PERM = false, AFTER_DRAIN = false;
    float* C; int ldc;
    __device__ __forceinline__ void operator()(const pg8::f32x4 (&acc)[2][2][4][2], const pg8::Unit& u, int wr, int wc, int fr, int fq) const {
        const int row0 = u.pm * 256 + wr * 64 + fr, col0 = u.pn * 256 + wc * 32 + 4 * fq;
#pragma unroll
        for (int ai = 0; ai < 2; ++ai)
#pragma unroll
            for (int m = 0; m < 4; ++m) {
                float* p = C + (size_t)(row0 + ai * 128 + m * 16) * ldc + col0;
#pragma unroll
                for (int bj = 0; bj < 2; ++bj)
#pragma unroll
                    for (int n = 0; n < 2; ++n) *(f32x4*)(p + bj * 128 + n * 16) = acc[ai][bj][m][n];
            }
    }
};
struct EpiKVQ {
    static constexpr bool PERM = true, AFTER_DRAIN = false;
    bf16_t* K; bf16_t* V; bf16_t* Q;
    __device__ __forceinline__ void operator()(const pg8::f32x4 (&acc)[2][2][4][2], const pg8::Unit& u, int wr, int wc, int fr, int fq) const {
        const int t = u.pn >> 3;
        bf16_t* dst = K + (size_t)t * ((size_t)32 << 20);
        const int row0 = u.pm * 256 + wr * 64 + fr, col0 = (u.pn & 7) * 256 + wc * 32 + 8 * fq;
#pragma unroll
        for (int ai = 0; ai < 2; ++ai)
#pragma unroll
            for (int m = 0; m < 4; ++m)
#pragma unroll
                for (int bj = 0; bj < 2; ++bj) {
                    const f32x4 v0 = acc[ai][bj][m][0], v1 = acc[ai][bj][m][1];
                    u32x4 w; w.x = pk_bf16(v0[0], v0[1]); w.y = pk_bf16(v0[2], v0[3]); w.z = pk_bf16(v1[0], v1[1]); w.w = pk_bf16(v1[2], v1[3]);
                    *(u32x4*)(dst + (size_t)(row0 + ai * 128 + m * 16) * DM + col0 + bj * 128) = w;
                }
    }
};


struct EpiKVQR {
    static constexpr bool PERM = true, AFTER_DRAIN = false;
    bf16_t* K; const float* COS; const float* SIN;
    __device__ __forceinline__ void operator()(const pg8::f32x4 (&acc)[2][2][4][2], const pg8::Unit& u, int wr, int wc, int fr, int fq) const {
        const int t = u.pn >> 3;
        bf16_t* dst = K + (size_t)t * ((size_t)32 << 20);
        const int row0 = u.pm * 256 + wr * 64 + fr;
        if (t == 1) {
            const int col0 = (u.pn & 7) * 256 + wc * 32 + 8 * fq;
#pragma unroll
            for (int ai = 0; ai < 2; ++ai)
#pragma unroll
                for (int m = 0; m < 4; ++m)
#pragma unroll
                    for (int bj = 0; bj < 2; ++bj) {
                        const f32x4 v0 = acc[ai][bj][m][0], v1 = acc[ai][bj][m][1];
                        u32x4 w; w.x = pk_bf16(v0[0], v0[1]); w.y = pk_bf16(v0[2], v0[3]); w.z = pk_bf16(v1[0], v1[1]); w.w = pk_bf16(v1[2], v1[3]);
                        *(u32x4*)(dst + (size_t)(row0 + ai * 128 + m * 16) * DM + col0 + bj * 128) = w;
                    }
        } else {
            const int g = 4 * wc + fq;
#pragma unroll
            for (int ai = 0; ai < 2; ++ai)
#pragma unroll
                for (int m = 0; m < 4; ++m) {
                    const int row = row0 + ai * 128 + m * 16, pos = row & (SEQ - 1);
                    const f32x4 c = *(const f32x4*)(COS + pos * 64 + 4 * g), sn = *(const f32x4*)(SIN + pos * 64 + 4 * g);
#pragma unroll
                    for (int bj = 0; bj < 2; ++bj) {
                        const f32x4 a = acc[ai][bj][m][0], b = acc[ai][bj][m][1];
                        bf16_t* p = dst + (size_t)row * DM + ((u.pn & 7) * 2 + bj) * 128 + 4 * g;
                        u32x2 w1, w2;
                        w1.x = pk_bf16(a[0] * c[0] - b[0] * sn[0], a[1] * c[1] - b[1] * sn[1]); w1.y = pk_bf16(a[2] * c[2] - b[2] * sn[2], a[3] * c[3] - b[3] * sn[3]);
                        w2.x = pk_bf16(a[0] * sn[0] + b[0] * c[0], a[1] * sn[1] + b[1] * c[1]); w2.y = pk_bf16(a[2] * sn[2] + b[2] * c[2], a[3] * sn[3] + b[3] * c[3]);
                        *(u32x2*)p = w1; *(u32x2*)(p + 64) = w2;
                    }
                }
        }
    }
};

__host__ __device__ __forceinline__ int rot_pos(int d) { return d < 64 ? 8 * (d >> 2) + (d & 3) : 8 * ((d - 64) >> 2) + 4 + (d & 3); }
__device__ __forceinline__ void transpose_tiles(LAS float* tile, const float* src, int ldn, int K, int N, bf16_t* dst, int nperm = 0) {
    const int tid = threadIdx.x;
    const int tn = N / 64, ntiles = tn * (K / 64);
    f32x4 nx[2];
#define TT_LOAD(tI_) { const int k0_ = ((tI_) / tn) * 64, n0_ = ((tI_) % tn) * 64; _Pragma("unroll") for (int r = 0; r < 2; ++r) nx[r] = *(const f32x4*)(src + (size_t)(k0_ + (tid >> 4) + 32 * r) * ldn + n0_ + (tid & 15) * 4); }
    if ((int)blockIdx.x < ntiles) TT_LOAD((int)blockIdx.x)
    for (int tI = blockIdx.x; tI < ntiles; tI += gridDim.x) {
        const int k0 = (tI / tn) * 64, n0 = (tI % tn) * 64;
        const f32x4 c0 = nx[0], c1 = nx[1];
        if (tI + (int)gridDim.x < ntiles) TT_LOAD(tI + (int)gridDim.x)
#pragma unroll
        for (int r = 0; r < 2; ++r) {
            const int kk = (tid >> 4) + 32 * r, nn = (tid & 15) * 4;
            const f32x4 v = r == 0 ? c0 : c1;
            tile[kk * 65 + nn + 0] = v[0]; tile[kk * 65 + nn + 1] = v[1]; tile[kk * 65 + nn + 2] = v[2]; tile[kk * 65 + nn + 3] = v[3];
        }
        __syncthreads();
        {
            const int nn = tid >> 3, kk8 = (tid & 7) * 8;
            float f[8];
#pragma unroll
            for (int j = 0; j < 8; ++j) f[j] = tile[(kk8 + j) * 65 + nn];
            u32x4 w; w.x = pk_bf16(f[0], f[1]); w.y = pk_bf16(f[2], f[3]); w.z = pk_bf16(f[4], f[5]); w.w = pk_bf16(f[6], f[7]);
            const int nsrc = n0 + nn, nrow = nsrc < nperm ? (nsrc & ~127) + rot_pos(nsrc & 127) : nsrc;
            *(u32x4*)(dst + (size_t)nrow * K + k0 + kk8) = w;
        }
        __syncthreads();
    }
}
#undef TT_LOAD
__device__ __forceinline__ void convert_bf16(const float* src, bf16_t* dst, size_t n) {
    const size_t stride = (size_t)gridDim.x * 512 * 8;
    for (size_t i = ((size_t)blockIdx.x * 512 + threadIdx.x) * 8; i < n; i += stride) {
        const f32x4 a = *(const f32x4*)(src + i), b = *(const f32x4*)(src + i + 4);
        u32x4 w; w.x = pk_bf16(a[0], a[1]); w.y = pk_bf16(a[2], a[3]); w.z = pk_bf16(b[0], b[1]); w.w = pk_bf16(b[2], b[3]);
        *(u32x4*)(dst + i) = w;
    }
}
__device__ __forceinline__ void fold_peer_keys(LAS float* lds, const float* w_query, const float* sub_keys, bf16_t* WcT) {
    const int tid = threadIdx.x;
    LAS float* Ss = lds;
    LAS float* Ws = lds + 128 * 132;
    for (int item = blockIdx.x; item < 1024; item += gridDim.x) {
        const int l = item >> 9, rem = item & 511, hh = rem >> 5, kb = rem & 31, h = hh >> 1, half = hh & 1;
        const float* sk = sub_keys + (size_t)(((l * 2 + half) * 8 + h) * 128) * 128;
        const float* wq = w_query + (size_t)l * DM * DM + (size_t)(kb * 64) * DM + h * 256 + half * 128;
#pragma unroll
        for (int r = 0; r < 8; ++r) { const int idx = tid + 512 * r, key = idx >> 5, d4 = (idx & 31) * 4; *(LAS f32x4*)(Ss + key * 132 + d4) = *(const f32x4*)(sk + key * 128 + d4); }
#pragma unroll
        for (int r = 0; r < 4; ++r) { const int idx = tid + 512 * r, kin = idx >> 5, d4 = (idx & 31) * 4; *(LAS f32x4*)(Ws + kin * 128 + d4) = *(const f32x4*)(wq + (size_t)kin * DM + d4); }
        __syncthreads();
        const int key = tid & 127, kq = tid >> 7;
        float acc[16];
#pragma unroll
        for (int j = 0; j < 16; ++j) acc[j] = 0.f;
        for (int d4 = 0; d4 < 32; ++d4) {
            const f32x4 s4 = *(const LAS f32x4*)(Ss + key * 132 + d4 * 4);
#pragma unroll
            for (int j = 0; j < 16; ++j) { const f32x4 w4 = *(const LAS f32x4*)(Ws + (kq * 16 + j) * 128 + d4 * 4); acc[j] += s4[0] * w4[0] + s4[1] * w4[1] + s4[2] * w4[2] + s4[3] * w4[3]; }
        }
        bf16_t* o = WcT + (size_t)l * DM * DM + (size_t)(h * 256 + half * 128 + key) * DM + kb * 64 + kq * 16;
        u32x4 w0, w1;
        w0.x = pk_bf16(acc[0], acc[1]); w0.y = pk_bf16(acc[2], acc[3]); w0.z = pk_bf16(acc[4], acc[5]); w0.w = pk_bf16(acc[6], acc[7]);
        w1.x = pk_bf16(acc[8], acc[9]); w1.y = pk_bf16(acc[10], acc[11]); w1.z = pk_bf16(acc[12], acc[13]); w1.w = pk_bf16(acc[14], acc[15]);
        *(u32x4*)o = w0; *(u32x4*)(o + 8) = w1;
        __syncthreads();
    }
}

__device__ __forceinline__ void quant_rows(const float* src, unsigned char* dst, float* scl, int nrows) {
    const int lane = threadIdx.x & 63, gw = blockIdx.x * 8 + (threadIdx.x >> 6), nw = gridDim.x * 8;
    for (int row = gw; row < nrows; row += nw) {
        const float* p = src + (size_t)row * DM;
        f32x4 v[8];
#pragma unroll
        for (int i = 0; i < 2; ++i)
#pragma unroll
            for (int q = 0; q < 4; ++q) v[i * 4 + q] = *(const f32x4*)(p + 1024 * i + 16 * lane + 4 * q);
        float am = 0.f;
#pragma unroll
        for (int i = 0; i < 8; ++i) am = fmaxf(am, fmaxf(fmaxf(fabsf(v[i][0]), fabsf(v[i][1])), fmaxf(fabsf(v[i][2]), fabsf(v[i][3]))));
        am = fmaxf(wave_max(am), 1e-30f);
        const float inv = 127.0f / am;
        if (lane == 0) scl[row] = am * (1.0f / 127.0f);
#pragma unroll
        for (int i = 0; i < 2; ++i) {
            u32x4 w;
#pragma unroll
            for (int q = 0; q < 4; ++q) {
                const f32x4 t = v[i * 4 + q];
                const unsigned b0 = (unsigned)(int)(rintf(t[0] * inv) + 128.0f), b1 = (unsigned)(int)(rintf(t[1] * inv) + 128.0f), b2 = (unsigned)(int)(rintf(t[2] * inv) + 128.0f), b3 = (unsigned)(int)(rintf(t[3] * inv) + 128.0f);
                w[q] = b0 | (b1 << 8) | (b2 << 16) | (b3 << 24);
            }
            *(u32x4*)(dst + (size_t)row * DM + 1024 * i + 16 * lane) = w;
        }
    }
}
__device__ __forceinline__ void phase_prep(const Args& a, LAS unsigned char* lds) {
    unsigned char* ws = a.ws;
    LAS float* tile = (LAS float*)lds;
    transpose_tiles(tile, a.in[1], 4 * DM, DM, 4 * DM, (bf16_t*)(ws + WS_WIN));
    transpose_tiles(tile, a.in[3], DM, DM, DM, (bf16_t*)(ws + WS_WOUT));
    transpose_tiles(tile, a.in[5], 2 * DM, DM, 2 * DM, (bf16_t*)(ws + WS_WKVQ), DM);
    transpose_tiles(tile, a.in[6], DM, DM, DM, (bf16_t*)(ws + WS_WKVQ) + (size_t)2 * DM * DM, DM);
    transpose_tiles(tile, a.in[7], DM, DM, DM, (bf16_t*)(ws + WS_WO));
    fold_peer_keys((LAS float*)lds, a.in[8], a.in[9], (bf16_t*)(ws + WS_WC));
    convert_bf16(a.in[0], (bf16_t*)(ws + slot(0)), (size_t)MTOK * DM);
    const int gtid = blockIdx.x * 512 + threadIdx.x, gthreads = gridDim.x * 512;
    float* COS = (float*)(ws + WS_COS); float* SIN = (float*)(ws + WS_SIN); float* LB = (float*)(ws + WS_LB);
    for (int i = gtid; i < SEQ * 64; i += gthreads) {
        const int pos = i >> 6, j = i & 63;
        double inv = 1.0; const double r = 0.86596432336006535;
        for (int q = 0; q < j; ++q) inv *= r;
        const float ang = (float)pos * (float)inv;
        const double x = (double)ang;
        const double n = __builtin_rint(x * 0.15915494309189535);
        const float rf = (float)__builtin_fma(-n, 6.283185307179586, x);
        COS[i] = cosf(rf); SIN[i] = sinf(rf);
    }
    for (int c = gtid; c < DM; c += gthreads) { const float l0 = a.in[4][c], l1 = a.in[4][DM + c]; LB[c] = 1.0f / (1.0f + expf(l1 - l0)); }
}

__device__ __forceinline__ void phase_scan_naive(const bf16_t* Q1, const float* LF, const bf16_t* I1, float* O) {
    const int lane = threadIdx.x & 63, gw = blockIdx.x * 8 + (threadIdx.x >> 6), nw = gridDim.x * 8;
    for (int item = gw; item < 2 * NHEAD * 128; item += nw) {
        const int bh = item >> 7, v = item & 127, b = bh >> 4, h = bh & 15;
        const size_t base = (size_t)b * SEQ * DM + h * 128;
        float S0 = 0.f, S1 = 0.f;
#pragma unroll 4
        for (int t = 0; t < SEQ; ++t) {
            const size_t ro = base + (size_t)t * DM;
            const float f0 = __expf(LF[ro + lane]), f1 = __expf(LF[ro + 64 + lane]);
            const float q0 = bf2f(Q1[ro + lane]), q1 = bf2f(Q1[ro + 64 + lane]);
            const float iv = bf2f(I1[ro + v]);
            S0 = f0 * S0 + (1.0f - f0) * iv; S1 = f1 * S1 + (1.0f - f1) * iv;
            const float p = wave_sum(q0 * S0 + q1 * S1);
            if (lane == 0) O[ro + v] = p;
        }
    }
}
__device__ __forceinline__ void phase_onorm(const float* O, const bf16_t* G1, const float* gnorm, bf16_t* OG) {
    const int lane = threadIdx.x & 63, gw = blockIdx.x * 8 + (threadIdx.x >> 6), nw = gridDim.x * 8;
    const float gn0 = gnorm[2 * lane], gn1 = gnorm[2 * lane + 1];
    for (int item = gw; item < MTOK * NHEAD; item += nw) {
        const size_t off = (size_t)item * 128 + 2 * lane;
        const float o0 = O[off], o1 = O[off + 1];
        const float ss = wave_sum(o0 * o0 + o1 * o1);
        const float r = rsqrtf(ss * (1.0f / 128.0f) + 1e-6f);
        const unsigned g = *(const unsigned*)(G1 + off);
        *(unsigned*)(OG + off) = pk_bf16(o0 * r * gn0 * bflo(g), o1 * r * gn1 * bfhi(g));
    }
}

__device__ __forceinline__ void ln_row_store(float (&v)[32], const float* g, const float* bta, float* outf, bf16_t* outb, int lane, signed char* outq = nullptr, float* outs = nullptr) {
    float s = 0.f;
#pragma unroll
    for (int i = 0; i < 32; ++i) s += v[i];
    const float mu = wave_sum(s) * (1.0f / DM);
    float q = 0.f;
#pragma unroll
    for (int i = 0; i < 32; ++i) { v[i] -= mu; q += v[i] * v[i]; }
    const float rstd = rsqrtf(wave_sum(q) * (1.0f / DM) + 1e-5f);
    float am = 0.f;
#pragma unroll
    for (int i = 0; i < 4; ++i) {
        const int c = 512 * i + 8 * lane;
        const f32x4 g0 = *(const f32x4*)(g + c), g1 = *(const f32x4*)(g + c + 4), b0 = *(const f32x4*)(bta + c), b1 = *(const f32x4*)(bta + c + 4);
        f32x4 o0, o1;
#pragma unroll
        for (int j = 0; j < 4; ++j) { o0[j] = v[i * 8 + j] * rstd * g0[j] + b0[j]; o1[j] = v[i * 8 + 4 + j] * rstd * g1[j] + b1[j]; v[i * 8 + j] = o0[j]; v[i * 8 + 4 + j] = o1[j]; am = fmaxf(am, fmaxf(fabsf(o0[j]), fabsf(o1[j]))); }
        if (outf) { *(f32x4*)(outf + c) = o0; *(f32x4*)(outf + c + 4) = o1; }
        if (outb) { u32x4 w; w.x = pk_bf16(o0[0], o0[1]); w.y = pk_bf16(o0[2], o0[3]); w.z = pk_bf16(o1[0], o1[1]); w.w = pk_bf16(o1[2], o1[3]); *(u32x4*)(outb + c) = w; }
    }
    if (outq) {
        am = fmaxf(wave_max(am), 1e-30f);
        const float inv = 127.0f / am;
        if (lane == 0) *outs = am * (1.0f / 127.0f);
#pragma unroll
        for (int i = 0; i < 4; ++i) {
            u32x2 w;
            w.x = ((unsigned)(int)rintf(v[i * 8 + 0] * inv) & 0xffu) | (((unsigned)(int)rintf(v[i * 8 + 1] * inv) & 0xffu) << 8) | (((unsigned)(int)rintf(v[i * 8 + 2] * inv) & 0xffu) << 16) | (((unsigned)(int)rintf(v[i * 8 + 3] * inv) & 0xffu) << 24);
            w.y = ((unsigned)(int)rintf(v[i * 8 + 4] * inv) & 0xffu) | (((unsigned)(int)rintf(v[i * 8 + 5] * inv) & 0xffu) << 8) | (((unsigned)(int)rintf(v[i * 8 + 6] * inv) & 0xffu) << 16) | (((unsigned)(int)rintf(v[i * 8 + 7] * inv) & 0xffu) << 24);
            *(u32x2*)(outq + 512 * i + 8 * lane) = w;
        }
    }
}
__device__ __forceinline__ void ln_row_store16(float (&v)[32], const float* g, const float* bta, float* outf, bf16_t* outb, int lane) {
    float s = 0.f;
#pragma unroll
    for (int i = 0; i < 32; ++i) s += v[i];
    const float mu = wave_sum(s) * (1.0f / DM);
    float q = 0.f;
#pragma unroll
    for (int i = 0; i < 32; ++i) { v[i] -= mu; q += v[i] * v[i]; }
    const float rstd = rsqrtf(wave_sum(q) * (1.0f / DM) + 1e-5f);
#pragma unroll
    for (int i = 0; i < 2; ++i) {
        const int c = 1024 * i + 16 * lane;
        f32x4 o[4];
#pragma unroll
        for (int qd = 0; qd < 4; ++qd) {
            const f32x4 gg = *(const f32x4*)(g + c + 4 * qd), bb = *(const f32x4*)(bta + c + 4 * qd);
#pragma unroll
            for (int j = 0; j < 4; ++j) o[qd][j] = v[16 * i + 4 * qd + j] * rstd * gg[j] + bb[j];
            *(f32x4*)(outf + c + 4 * qd) = o[qd];
        }
        if (outb) {
            u32x4 w0, w1;
            w0.x = pk_bf16(o[0][0], o[0][1]); w0.y = pk_bf16(o[0][2], o[0][3]); w0.z = pk_bf16(o[1][0], o[1][1]); w0.w = pk_bf16(o[1][2], o[1][3]);
            w1.x = pk_bf16(o[2][0], o[2][1]); w1.y = pk_bf16(o[2][2], o[2][3]); w1.z = pk_bf16(o[3][0], o[3][1]); w1.w = pk_bf16(o[3][2], o[3][3]);
            *(u32x4*)(outb + c) = w0; *(u32x4*)(outb + c + 8) = w1;
        }
    }
}
template <bool RES16> __device__ __forceinline__ void phase_ln(const bf16_t* Y, const void* RESv, const float* g, const float* bta, float* outf, bf16_t* outb, signed char* outq = nullptr, float* outs = nullptr) {
    const int lane = threadIdx.x & 63, gw = blockIdx.x * 8 + (threadIdx.x >> 6), nw = gridDim.x * 8;
    for (int row = gw; row < MTOK; row += nw) {
        float v[32];
        const bf16_t* p = Y + (size_t)row * DM;
#pragma unroll
        for (int i = 0; i < 4; ++i) {
            const u32x4 yw = *(const u32x4*)(p + 512 * i + 8 * lane);
            const f32x4 a = {bflo(yw.x), bfhi(yw.x), bflo(yw.y), bfhi(yw.y)}, b = {bflo(yw.z), bfhi(yw.z), bflo(yw.w), bfhi(yw.w)};
            f32x4 ra, rb;
            if (RES16) { const u32x4 w = *(const u32x4*)((const bf16_t*)RESv + (size_t)row * DM + 512 * i + 8 * lane); ra = (f32x4){bflo(w.x), bfhi(w.x), bflo(w.y), bfhi(w.y)}; rb = (f32x4){bflo(w.z), bfhi(w.z), bflo(w.w), bfhi(w.w)}; }
            else { const float* rp = (const float*)RESv + (size_t)row * DM; ra = *(const f32x4*)(rp + 512 * i + 8 * lane); rb = *(const f32x4*)(rp + 512 * i + 8 * lane + 4); }
#pragma unroll
            for (int j = 0; j < 4; ++j) { v[i * 8 + j] = a[j] + ALPHA * ra[j]; v[i * 8 + 4 + j] = b[j] + ALPHA * rb[j]; }
        }
        ln_row_store(v, g, bta, outf ? outf + (size_t)row * DM : nullptr, outb ? outb + (size_t)row * DM : nullptr, lane, outq ? outq + (size_t)row * DM : nullptr, outs ? outs + row : nullptr);
    }
}

__device__ __forceinline__ void wave_argmax(float& v, int& idx) {
#pragma unroll
    for (int o = 32; o >= 1; o >>= 1) {
        const float ov = __shfl_xor(v, o); const int oi = __shfl_xor(idx, o);
        if (ov > v || (ov == v && oi < idx)) { v = ov; idx = oi; }
    }
}
__device__ __forceinline__ unsigned fkey(float x) { const unsigned u = __float_as_uint(x); return u ^ (unsigned)(((int)u >> 31) | 0x80000000); }
__device__ __forceinline__ float funkey(unsigned k) { const unsigned u = (k & 0x80000000u) ? (k ^ 0x80000000u) : ~k; return __uint_as_float(u); }
__device__ __forceinline__ void sort16_insert(unsigned (&r)[16], unsigned v) {
#pragma unroll
    for (int i = 0; i < 16; ++i) { const unsigned m = r[i] > v ? r[i] : v; v = r[i] > v ? v : r[i]; r[i] = m; }
}
__device__ __forceinline__ void phase_topk(LAS unsigned char* lds, const float* SCT, int* EID, float* GATE) {
    LAS unsigned char* ib = lds + threadIdx.x * 32;
    for (int item = blockIdx.x * 512 + threadIdx.x; item < MTOK * 8; item += gridDim.x * 512) {
        const int h = item >> 14, tok = item & (MTOK - 1);
        const float* p = SCT + (size_t)(h * 256) * MTOK + tok;
        unsigned r1[16], r2[16];
#pragma unroll
        for (int i = 0; i < 16; ++i) { r1[i] = 0u; r2[i] = 0u; }
#pragma unroll 8
        for (int e = 0; e < 128; ++e) {
            const float x1 = p[(size_t)e * MTOK], x2 = p[(size_t)(128 + e) * MTOK];
            sort16_insert(r1, (fkey(x1) & ~0x7Fu) | (unsigned)e);
            sort16_insert(r2, (fkey(x2) & ~0x7Fu) | (unsigned)e);
        }
        float v1[16], v2[16];
#pragma unroll
        for (int i = 0; i < 16; ++i) { v1[i] = funkey(r1[i] & ~0x7Fu); v2[i] = funkey(r2[i] & ~0x7Fu); ib[i] = (unsigned char)(r1[i] & 0x7Fu); ib[16 + i] = (unsigned char)(r2[i] & 0x7Fu); }
        unsigned r3[16];
#pragma unroll
        for (int i = 0; i < 16; ++i) r3[i] = 0u;
#pragma unroll
        for (int a = 0; a < 16; ++a)
#pragma unroll
            for (int bq = 0; bq < 16; ++bq)
                if ((a + 1) * (bq + 1) <= 16) sort16_insert(r3, (fkey(v1[a] + v2[bq]) & ~0xFFu) | (unsigned)(a * 16 + bq));
        const float mx = funkey(r3[0] & ~0xFFu);
        float ev[16]; float sum = 0.f;
#pragma unroll
        for (int i = 0; i < 16; ++i) { ev[i] = __expf(funkey(r3[i] & ~0xFFu) - mx); sum += ev[i]; }
        const float rs = 1.0f / sum;
        int eid[16];
#pragma unroll
        for (int i = 0; i < 16; ++i) { const unsigned f = r3[i] & 0xFFu; eid[i] = (int)ib[f >> 4] * 128 + (int)ib[16 + (f & 15u)]; }
        int* eo = EID + (size_t)tok * 128 + h * 16; float* go = GATE + (size_t)tok * 128 + h * 16;
#pragma unroll
        for (int q = 0; q < 4; ++q) {
            *(u32x4*)(eo + 4 * q) = (u32x4){(unsigned)eid[4 * q], (unsigned)eid[4 * q + 1], (unsigned)eid[4 * q + 2], (unsigned)eid[4 * q + 3]};
            *(f32x4*)(go + 4 * q) = (f32x4){ev[4 * q] * rs, ev[4 * q + 1] * rs, ev[4 * q + 2] * rs, ev[4 * q + 3] * rs};
        }
    }
}

__device__ __forceinline__ float gelu_erf(float x) { return 0.5f * x * (1.0f + erff(x * 0.70710678118654752f)); }
__device__ __forceinline__ float ub0(unsigned w) { return (float)(w & 0xffu); }
__device__ __forceinline__ float ub1(unsigned w) { return (float)((w >> 8) & 0xffu); }
__device__ __forceinline__ float ub2(unsigned w) { return (float)((w >> 16) & 0xffu); }
__device__ __forceinline__ float ub3(unsigned w) { return (float)(w >> 24); }
__device__ __forceinline__ void phase_peer(LAS unsigned char* lds, const float* X, const int* EID, const float* GATE, const unsigned char* U, const unsigned char* V, const float* USC, const float* VSC,
                                           const float* g, const float* bta, float* outf, bf16_t* outb) {
    const int lane = threadIdx.x & 63, wv = threadIdx.x >> 6, gw = blockIdx.x * 8 + wv, nw = gridDim.x * 8;
    LAS float* hb = (LAS float*)(lds + wv * 512);
    for (int tok = gw; tok < MTOK; tok += nw) {
        float x[32];
        const float* xp = X + (size_t)tok * DM;
#pragma unroll
        for (int i = 0; i < 2; ++i)
#pragma unroll
            for (int q = 0; q < 4; ++q) { const f32x4 t = *(const f32x4*)(xp + 1024 * i + 16 * lane + 4 * q); x[16 * i + 4 * q] = t[0]; x[16 * i + 4 * q + 1] = t[1]; x[16 * i + 4 * q + 2] = t[2]; x[16 * i + 4 * q + 3] = t[3]; }
        float sx = 0.f;
#pragma unroll
        for (int j = 0; j < 32; ++j) sx += x[j];
        const float d0 = -128.0f * sx;
        const int e0 = EID[(size_t)tok * 128 + lane], e1 = EID[(size_t)tok * 128 + 64 + lane];
        const float g0 = GATE[(size_t)tok * 128 + lane], g1 = GATE[(size_t)tok * 128 + 64 + lane];
        for (int bt = 0; bt < 16; ++bt) {
            float d[8];
#pragma unroll
            for (int r = 0; r < 8; ++r) {
                const int e = bt * 8 + r;
                const int idx = __builtin_amdgcn_readfirstlane(__shfl(bt < 8 ? e0 : e1, e & 63));
                const u32x4* up = (const u32x4*)(U + (size_t)idx * DM) + lane;
                float acc = d0;
#pragma unroll
                for (int i = 0; i < 2; ++i) {
                    const u32x4 w = up[i * 64];
                    acc += x[16 * i + 0] * ub0(w.x) + x[16 * i + 1] * ub1(w.x) + x[16 * i + 2] * ub2(w.x) + x[16 * i + 3] * ub3(w.x)
                         + x[16 * i + 4] * ub0(w.y) + x[16 * i + 5] * ub1(w.y) + x[16 * i + 6] * ub2(w.y) + x[16 * i + 7] * ub3(w.y)
                         + x[16 * i + 8] * ub0(w.z) + x[16 * i + 9] * ub1(w.z) + x[16 * i + 10] * ub2(w.z) + x[16 * i + 11] * ub3(w.z)
                         + x[16 * i + 12] * ub0(w.w) + x[16 * i + 13] * ub1(w.w) + x[16 * i + 14] * ub2(w.w) + x[16 * i + 15] * ub3(w.w);
                }
                d[r] = acc;
            }
            const bool b5 = lane & 32, b4 = lane & 16, b3 = lane & 8;
            float t4[4];
#pragma unroll
            for (int q = 0; q < 4; ++q) { const float keep = b5 ? d[4 + q] : d[q], send = b5 ? d[q] : d[4 + q]; t4[q] = keep + __shfl_xor(send, 32); }
            float t2[2];
#pragma unroll
            for (int q = 0; q < 2; ++q) { const float keep = b4 ? t4[2 + q] : t4[q], send = b4 ? t4[q] : t4[2 + q]; t2[q] = keep + __shfl_xor(send, 16); }
            float t1;
            { const float keep = b3 ? t2[1] : t2[0], send = b3 ? t2[0] : t2[1]; t1 = keep + __shfl_xor(send, 8); }
            t1 += __shfl_xor(t1, 4); t1 += __shfl_xor(t1, 2); t1 += __shfl_xor(t1, 1);
            if ((lane & 7) == 0) hb[bt * 8 + (lane >> 3 & 1) + 2 * (lane >> 4 & 1) + 4 * (lane >> 5 & 1)] = t1;
        }
        asm volatile("s_waitcnt lgkmcnt(0)" ::: "memory");
        const float h0 = hb[lane] * USC[e0], h1 = hb[64 + lane] * USC[e1];
        const float w0 = g0 * gelu_erf(h0) * VSC[e0], w1 = g1 * gelu_erf(h1) * VSC[e1];
        float wsum = wave_sum(w0 + w1);
        float y[32];
#pragma unroll
        for (int i = 0; i < 32; ++i) y[i] = 0.f;
#pragma unroll 8
        for (int e = 0; e < 128; ++e) {
            const int idx = __builtin_amdgcn_readfirstlane(__shfl(e < 64 ? e0 : e1, e & 63));
            const float wt = __shfl(e < 64 ? w0 : w1, e & 63);
            const u32x4* vp = (const u32x4*)(V + (size_t)idx * DM) + lane;
#pragma unroll
            for (int i = 0; i < 2; ++i) {
                const u32x4 w = vp[i * 64];
                y[16 * i + 0] += wt * ub0(w.x); y[16 * i + 1] += wt * ub1(w.x); y[16 * i + 2] += wt * ub2(w.x); y[16 * i + 3] += wt * ub3(w.x);
                y[16 * i + 4] += wt * ub0(w.y); y[16 * i + 5] += wt * ub1(w.y); y[16 * i + 6] += wt * ub2(w.y); y[16 * i + 7] += wt * ub3(w.y);
                y[16 * i + 8] += wt * ub0(w.z); y[16 * i + 9] += wt * ub1(w.z); y[16 * i + 10] += wt * ub2(w.z); y[16 * i + 11] += wt * ub3(w.z);
                y[16 * i + 12] += wt * ub0(w.w); y[16 * i + 13] += wt * ub1(w.w); y[16 * i + 14] += wt * ub2(w.w); y[16 * i + 15] += wt * ub3(w.w);
            }
        }
        const float corr = -128.0f * wsum;
#pragma unroll
        for (int i = 0; i < 32; ++i) y[i] = y[i] + corr + ALPHA * x[i];
        ln_row_store16(y, g, bta, outf + (size_t)tok * DM, outb ? outb + (size_t)tok * DM : nullptr, lane);
        asm volatile("s_waitcnt lgkmcnt(0)" ::: "memory");
    }
}

__device__ __forceinline__ int row_dot_i8(const u32x4 (&xq)[2], const unsigned char* rowp, int lane) {
    const u32x4* up = (const u32x4*)rowp + lane;
    int acc = 0;
#pragma unroll
    for (int i = 0; i < 2; ++i) {
        const u32x4 w = up[i * 64];
        acc = __builtin_amdgcn_sdot4((int)xq[i].x, (int)(w.x ^ 0x80808080u), acc, false); acc = __builtin_amdgcn_sdot4((int)xq[i].y, (int)(w.y ^ 0x80808080u), acc, false);
        acc = __builtin_amdgcn_sdot4((int)xq[i].z, (int)(w.z ^ 0x80808080u), acc, false); acc = __builtin_amdgcn_sdot4((int)xq[i].w, (int)(w.w ^ 0x80808080u), acc, false);
    }
    return acc;
}
__device__ __forceinline__ void peer_issue8(u32x4 (&seg)[8], const unsigned char* base, const u32x4 ia, const u32x4 ib) {
    seg[0] = *(const u32x4*)(base + (size_t)ia.x * DM); seg[1] = *(const u32x4*)(base + (size_t)ia.y * DM); seg[2] = *(const u32x4*)(base + (size_t)ia.z * DM); seg[3] = *(const u32x4*)(base + (size_t)ia.w * DM);
    seg[4] = *(const u32x4*)(base + (size_t)ib.x * DM); seg[5] = *(const u32x4*)(base + (size_t)ib.y * DM); seg[6] = *(const u32x4*)(base + (size_t)ib.z * DM); seg[7] = *(const u32x4*)(base + (size_t)ib.w * DM);
}
__device__ __forceinline__ void peer_dot8(int (&d)[8], const u32x4 (&seg)[8], const u32x4 xq) {
#pragma unroll
    for (int i = 0; i < 8; ++i) {
        int acc = __builtin_amdgcn_sdot4((int)xq.x, (int)(seg[i].x ^ 0x80808080u), 0, false);
        acc = __builtin_amdgcn_sdot4((int)xq.y, (int)(seg[i].y ^ 0x80808080u), acc, false);
        acc = __builtin_amdgcn_sdot4((int)xq.z, (int)(seg[i].z ^ 0x80808080u), acc, false);
        d[i] = __builtin_amdgcn_sdot4((int)xq.w, (int)(seg[i].w ^ 0x80808080u), acc, false);
    }
}
__device__ __forceinline__ void phase_peer_u(const signed char* XQ, const int* EID, const unsigned char* U, LAS int* HL  ) {
    const int lane = threadIdx.x & 63, wv = threadIdx.x >> 6, es = lane >> 3, cc = lane & 7;
    const bool b2 = cc & 4, b1 = cc & 2, b0 = cc & 1;
    const int nw = gridDim.x * 8, gw = blockIdx.x * 8 + wv, tpw = (MTOK + nw - 1) / nw, tbase = gw * tpw;
    int cnt = MTOK - tbase; cnt = cnt > tpw ? tpw : cnt;
    if (cnt <= 0) return;
    for (int i = lane; i < cnt * 128; i += 64) HL[i] = 0;
    asm volatile("s_waitcnt lgkmcnt(0)" ::: "memory");
    const int nit = 16 * cnt;
    const unsigned char* ub = U + cc * 16;
    u32x4 m0a, m0b, m0c, m0d, m0x, m1a, m1b, m1c, m1d, m1x, m2a, m2b, m2c, m2d, m2x; u32x4 sA[8], sB[8];
#define PU_LOAD(sl_, k_, A_, B_, C_, D_, X_) { const int* ep_ = EID + (size_t)(tbase + (k_)) * 128 + es * 16; A_ = *(const u32x4*)ep_; B_ = *(const u32x4*)(ep_ + 4); C_ = *(const u32x4*)(ep_ + 8); D_ = *(const u32x4*)(ep_ + 12); \
        X_ = *(const u32x4*)(XQ + (size_t)(tbase + (k_)) * DM + (sl_) * 128 + cc * 16); }
#define PU_NEXT(sl_, k_, sn_, kn_) { kn_ = (k_) + 1; sn_ = (sl_); if (kn_ == cnt) { kn_ = 0; ++sn_; } if (sn_ == 16) { sn_ = 15; kn_ = cnt - 1; } }
    int sl = 0, k = 0, sl1, k1, sl2, k2;
    PU_NEXT(sl, k, sl1, k1) PU_NEXT(sl1, k1, sl2, k2)
    PU_LOAD(sl, k, m0a, m0b, m0c, m0d, m0x)
    PU_LOAD(sl1, k1, m1a, m1b, m1c, m1d, m1x)
    peer_issue8(sA, ub + sl * 128, m0a, m0b);
    for (int it = 0; it < nit; ++it) {
        PU_LOAD(sl2, k2, m2a, m2b, m2c, m2d, m2x)
        peer_issue8(sB, ub + sl * 128, m0c, m0d);
        int dlo[8]; peer_dot8(dlo, sA, m0x);
        peer_issue8(sA, ub + sl1 * 128, m1a, m1b);
        int dhi[8]; peer_dot8(dhi, sB, m0x);
        int t8[8], t4[4], t2[2];
#pragma unroll
        for (int q = 0; q < 8; ++q) { const int keep = b2 ? dhi[q] : dlo[q], send = b2 ? dlo[q] : dhi[q]; t8[q] = keep + __shfl_xor(send, 4); }
#pragma unroll
        for (int q = 0; q < 4; ++q) { const int keep = b1 ? t8[4 + q] : t8[q], send = b1 ? t8[q] : t8[4 + q]; t4[q] = keep + __shfl_xor(send, 2); }
#pragma unroll
        for (int q = 0; q < 2; ++q) { const int keep = b0 ? t4[2 + q] : t4[q], send = b0 ? t4[q] : t4[2 + q]; t2[q] = keep + __shfl_xor(send, 1); }
        { LAS int* hp = HL + k * 128 + es * 16 + (b2 ? 8 : 0) + (b1 ? 4 : 0) + (b0 ? 2 : 0);
          __hip_atomic_fetch_add(hp, t2[0], __ATOMIC_RELAXED, __HIP_MEMORY_SCOPE_WORKGROUP); __hip_atomic_fetch_add(hp + 1, t2[1], __ATOMIC_RELAXED, __HIP_MEMORY_SCOPE_WORKGROUP); }
        sl = sl1; k = k1; sl1 = sl2; k1 = k2; PU_NEXT(sl1, k1, sl2, k2)
        m0a = m1a; m0b = m1b; m0c = m1c; m0d = m1d; m0x = m1x; m1a = m2a; m1b = m2b; m1c = m2c; m1d = m2d; m1x = m2x;
    }
#undef PU_LOAD
#undef PU_NEXT
}
__device__ __forceinline__ void phase_peer_w(const LAS int* HL, const float* XS, const int* EID, const float* GATE, const float* USC, const float* VSC, float* W, float* CS) {
    const int lane = threadIdx.x & 63, gw = blockIdx.x * 8 + (threadIdx.x >> 6), nw = gridDim.x * 8, tpw = (MTOK + nw - 1) / nw, tbase = gw * tpw;
    const int tend = tbase + tpw < MTOK ? tbase + tpw : MTOK;
    for (int tok = tbase; tok < tend; ++tok) {
        const int h0 = HL[(tok - tbase) * 128 + lane], h1 = HL[(tok - tbase) * 128 + 64 + lane];
        const int e0 = EID[(size_t)tok * 128 + lane], e1 = EID[(size_t)tok * 128 + 64 + lane];
        const float xs = XS[tok];
        const float w0 = GATE[(size_t)tok * 128 + lane] * gelu_erf((float)h0 * xs * USC[e0]) * VSC[e0];
        const float w1 = GATE[(size_t)tok * 128 + 64 + lane] * gelu_erf((float)h1 * xs * USC[e1]) * VSC[e1];
        W[(size_t)tok * 128 + lane] = w0; W[(size_t)tok * 128 + 64 + lane] = w1;
        const float cs = wave_sum(w0 + w1);
        if (lane == 0) CS[tok] = cs;
    }
}
__device__ __forceinline__ void peer_fma8(f32x2_t (&ya)[8], const u32x4 (&seg)[8], const f32x4 wa, const f32x4 wb2) {
#pragma unroll
    for (int i = 0; i < 8; ++i) {
        const float wt = i < 4 ? wa[i & 3] : wb2[i & 3];
        const f32x2_t wt2 = {wt, wt};
        const u32x4 w = seg[i];
        ya[0] = __builtin_elementwise_fma(wt2, (f32x2_t){ub0(w.x), ub1(w.x)}, ya[0]); ya[1] = __builtin_elementwise_fma(wt2, (f32x2_t){ub2(w.x), ub3(w.x)}, ya[1]);
        ya[2] = __builtin_elementwise_fma(wt2, (f32x2_t){ub0(w.y), ub1(w.y)}, ya[2]); ya[3] = __builtin_elementwise_fma(wt2, (f32x2_t){ub2(w.y), ub3(w.y)}, ya[3]);
        ya[4] = __builtin_elementwise_fma(wt2, (f32x2_t){ub0(w.z), ub1(w.z)}, ya[4]); ya[5] = __builtin_elementwise_fma(wt2, (f32x2_t){ub2(w.z), ub3(w.z)}, ya[5]);
        ya[6] = __builtin_elementwise_fma(wt2, (f32x2_t){ub0(w.w), ub1(w.w)}, ya[6]); ya[7] = __builtin_elementwise_fma(wt2, (f32x2_t){ub2(w.w), ub3(w.w)}, ya[7]);
    }
}
__device__ __forceinline__ void phase_peer_v(const bf16_t* X, const int* EID, const float* W, const float* CS, const unsigned char* V, float* Y) {
    const int lane = threadIdx.x & 63, wv = threadIdx.x >> 6, es = lane >> 3, cc = lane & 7;
    const bool b5 = lane & 32, b4 = lane & 16, b3 = lane & 8;
    const int nw = gridDim.x * 8, gw = blockIdx.x * 8 + wv, tpw = (MTOK + nw - 1) / nw, tbase = gw * tpw;
    int cnt = MTOK - tbase; cnt = cnt > tpw ? tpw : cnt;
    if (cnt <= 0) return;
    const int nit = 16 * cnt;
    const unsigned char* vb = V + cc * 16;
    const int colo = cc * 16 + (b5 ? 8 : 0) + (b4 ? 4 : 0) + (b3 ? 2 : 0);
    u32x4 m0c, m0d, m1a, m1b, m1c, m1d, m2a, m2b, m2c, m2d; f32x4 w0a, w0b, w0c, w0d, w1a, w1b, w1c, w1d; f32x2_t x0, x1; float c0, c1; u32x4 sA[8], sB[8];
#define PV_IDS(k_, A_, B_, C_, D_) { const size_t o_ = (size_t)(tbase + (k_)) * 128 + es * 16; A_ = *(const u32x4*)(EID + o_); B_ = *(const u32x4*)(EID + o_ + 4); C_ = *(const u32x4*)(EID + o_ + 8); D_ = *(const u32x4*)(EID + o_ + 12); }
#define PV_WX(sl_, k_, WA_, WB_, WC_, WD_, X_, CS_) { const size_t o_ = (size_t)(tbase + (k_)) * 128 + es * 16; \
        WA_ = *(const f32x4*)(W + o_); WB_ = *(const f32x4*)(W + o_ + 4); WC_ = *(const f32x4*)(W + o_ + 8); WD_ = *(const f32x4*)(W + o_ + 12); \
        { const unsigned xw_ = *(const unsigned*)(X + (size_t)(tbase + (k_)) * DM + (sl_) * 128 + colo); X_ = (f32x2_t){bflo(xw_), bfhi(xw_)}; } CS_ = CS[tbase + (k_)]; }
#define PV_NEXT(sl_, k_, sn_, kn_) { kn_ = (k_) + 1; sn_ = (sl_); if (kn_ == cnt) { kn_ = 0; ++sn_; } if (sn_ == 16) { sn_ = 15; kn_ = cnt - 1; } }
    int sl = 0, k = 0, sl1, k1, sl2, k2;
    PV_NEXT(sl, k, sl1, k1) PV_NEXT(sl1, k1, sl2, k2)
    { u32x4 ta, tb; PV_IDS(k, ta, tb, m0c, m0d) PV_IDS(k1, m1a, m1b, m1c, m1d)
      PV_WX(sl, k, w0a, w0b, w0c, w0d, x0, c0)
      peer_issue8(sA, vb + sl * 128, ta, tb); }
    for (int it = 0; it < nit; ++it) {
        PV_IDS(k2, m2a, m2b, m2c, m2d)
        peer_issue8(sB, vb + sl * 128, m0c, m0d);
        f32x2_t ya[8];
#pragma unroll
        for (int j = 0; j < 8; ++j) ya[j] = (f32x2_t){0.f, 0.f};
        peer_fma8(ya, sA, w0a, w0b);
        peer_issue8(sA, vb + sl1 * 128, m1a, m1b);
        PV_WX(sl1, k1, w1a, w1b, w1c, w1d, x1, c1)
        peer_fma8(ya, sB, w0c, w0d);
        f32x2_t t4[4], t2[2], t1;
#pragma unroll
        for (int q = 0; q < 4; ++q) { const f32x2_t keep = b5 ? ya[4 + q] : ya[q], send = b5 ? ya[q] : ya[4 + q]; t4[q][0] = keep[0] + __shfl_xor(send[0], 32); t4[q][1] = keep[1] + __shfl_xor(send[1], 32); }
#pragma unroll
        for (int q = 0; q < 2; ++q) { const f32x2_t keep = b4 ? t4[2 + q] : t4[q], send = b4 ? t4[q] : t4[2 + q]; t2[q][0] = keep[0] + __shfl_xor(send[0], 16); t2[q][1] = keep[1] + __shfl_xor(send[1], 16); }
        { const f32x2_t keep = b3 ? t2[1] : t2[0], send = b3 ? t2[0] : t2[1]; t1[0] = keep[0] + __shfl_xor(send[0], 8); t1[1] = keep[1] + __shfl_xor(send[1], 8); }
        f32x2_t o; o[0] = t1[0] - 128.0f * c0 + ALPHA * x0[0]; o[1] = t1[1] - 128.0f * c0 + ALPHA * x0[1];
        *(f32x2_t*)(Y + (size_t)(tbase + k) * DM + sl * 128 + colo) = o;
        sl = sl1; k = k1; sl1 = sl2; k1 = k2; PV_NEXT(sl1, k1, sl2, k2)
        m0c = m1c; m0d = m1d; m1a = m2a; m1b = m2b; m1c = m2c; m1d = m2d;
        w0a = w1a; w0b = w1b; w0c = w1c; w0d = w1d; x0 = x1; c0 = c1;
    }
#undef PV_IDS
#undef PV_WX
#undef PV_NEXT
}

__device__ __forceinline__ void rot8(const u32x4 lo, const u32x4 hi, const f32x4 c0, const f32x4 c1, const f32x4 s0, const f32x4 s1, float (&o1)[8], float (&o2)[8]) {
    const float a[8] = {bflo(lo.x), bfhi(lo.x), bflo(lo.y), bfhi(lo.y), bflo(lo.z), bfhi(lo.z), bflo(lo.w), bfhi(lo.w)};
    const float b[8] = {bflo(hi.x), bfhi(hi.x), bflo(hi.y), bfhi(hi.y), bflo(hi.z), bfhi(hi.z), bflo(hi.w), bfhi(hi.w)};
    const float c[8] = {c0[0], c0[1], c0[2], c0[3], c1[0], c1[1], c1[2], c1[3]}, sn[8] = {s0[0], s0[1], s0[2], s0[3], s1[0], s1[1], s1[2], s1[3]};
#pragma unroll
    for (int j = 0; j < 8; ++j) { o1[j] = a[j] * c[j] - b[j] * sn[j]; o2[j] = a[j] * sn[j] + b[j] * c[j]; }
}
__device__ __forceinline__ u32x4 pack8(const float (&o)[8]) { u32x4 w; w.x = pk_bf16(o[0], o[1]); w.y = pk_bf16(o[2], o[3]); w.z = pk_bf16(o[4], o[5]); w.w = pk_bf16(o[6], o[7]); return w; }
__device__ __forceinline__ void phase_kstat(LAS float* red, const bf16_t* KR, float* KMEAN, float* KNMAX) {
    const int tid = threadIdx.x, ch = tid & 7, rr = tid >> 3, wv = tid >> 6, lane = tid & 63;
    for (int item = blockIdx.x; item < 2 * NHEAD * 32; item += gridDim.x) {
        const int bh = item >> 5, j = item & 31, b = bh >> 4, h = bh & 15;
        float sm1[8], sm2[8]; float nmax = 0.f;
#pragma unroll
        for (int q = 0; q < 8; ++q) { sm1[q] = 0.f; sm2[q] = 0.f; }
        u32x4 lo[4], hi[4];
#pragma unroll
        for (int ps = 0; ps < 4; ++ps) { const size_t off = ((size_t)b * SEQ + j * 256 + ps * 64 + rr) * DM + h * 128 + ch * 8; lo[ps] = *(const u32x4*)(KR + off); hi[ps] = *(const u32x4*)(KR + off + 64); }
#pragma unroll
        for (int ps = 0; ps < 4; ++ps) {
            const float a[8] = {bflo(lo[ps].x), bfhi(lo[ps].x), bflo(lo[ps].y), bfhi(lo[ps].y), bflo(lo[ps].z), bfhi(lo[ps].z), bflo(lo[ps].w), bfhi(lo[ps].w)};
            const float c[8] = {bflo(hi[ps].x), bfhi(hi[ps].x), bflo(hi[ps].y), bfhi(hi[ps].y), bflo(hi[ps].z), bfhi(hi[ps].z), bflo(hi[ps].w), bfhi(hi[ps].w)};
            float nq = 0.f;
#pragma unroll
            for (int q = 0; q < 8; ++q) { sm1[q] += a[q]; sm2[q] += c[q]; nq += a[q] * a[q] + c[q] * c[q]; }
            nq += __shfl_xor(nq, 1); nq += __shfl_xor(nq, 2); nq += __shfl_xor(nq, 4);
            nmax = fmaxf(nmax, nq);
        }
#pragma unroll
        for (int q = 0; q < 8; ++q) {
            sm1[q] += __shfl_xor(sm1[q], 8); sm1[q] += __shfl_xor(sm1[q], 16); sm1[q] += __shfl_xor(sm1[q], 32);
            sm2[q] += __shfl_xor(sm2[q], 8); sm2[q] += __shfl_xor(sm2[q], 16); sm2[q] += __shfl_xor(sm2[q], 32);
        }
        nmax = wave_max(nmax);
        if (lane < 8) {
#pragma unroll
            for (int q = 0; q < 8; ++q) { red[wv * 128 + lane * 8 + q] = sm1[q]; red[wv * 128 + 64 + lane * 8 + q] = sm2[q]; }
        }
        if (lane == 0) red[1024 + wv] = nmax;
        __syncthreads();
        if (tid < 128) {
            float s2 = 0.f;
#pragma unroll
            for (int r = 0; r < 8; ++r) s2 += red[r * 128 + tid];
            KMEAN[(size_t)item * 128 + tid] = s2 * (1.0f / 256.0f);
        }
        if (tid == 0) {
            float m = 0.f;
#pragma unroll
            for (int r = 0; r < 8; ++r) m = fmaxf(m, red[1024 + r]);
            KNMAX[item] = sqrtf(m);
        }
        __syncthreads();
    }
}

__device__ __forceinline__ void top3_insert(float x, int m, float& v0, int& i0, float& v1, int& i1, float& v2, int& i2) {
    const bool c0 = x > v0 || (x == v0 && m < i0), c1 = x > v1 || (x == v1 && m < i1), c2 = x > v2 || (x == v2 && m < i2);
    v2 = c1 ? v1 : (c2 ? x : v2); i2 = c1 ? i1 : (c2 ? m : i2);
    v1 = c0 ? v0 : (c1 ? x : v1); i1 = c0 ? i0 : (c1 ? m : i1);
    v0 = c0 ? x : v0; i0 = c0 ? m : i0;
}
__device__ __forceinline__ void phase_sel(LAS unsigned char* lds, const bf16_t* QR, const float* KMEAN, unsigned short* SUB, int* CNT, int* ctr) {
    const int tid = threadIdx.x, lane = tid & 63, wv = tid >> 6, r32 = lane & 31, hh = lane >> 5;
    LAS unsigned short* bucket = (LAS unsigned short*)lds;
    LAS int* cnt = (LAS int*)(lds + 16384);
    const float NEG = -1e30f;
    if (blockIdx.x == 0 && tid == 0) *ctr = 0;
    for (int item = blockIdx.x; item < 2 * NHEAD * 32; item += gridDim.x) {
        const int bh = item >> 5, i = item & 31, b = bh >> 4, h = bh & 15;
        if (i == 0) continue;
        if (tid < 32) cnt[tid] = 0;
        __syncthreads();
        const float* kmp = KMEAN + ((size_t)bh * 32 + r32) * 128 + 8 * hh;
        const size_t tok = (size_t)b * SEQ + i * 256 + wv * 32 + r32;
        const bf16_t* qp = QR + tok * DM + h * 128 + 8 * hh;
        f32x16 S;
#pragma unroll
        for (int e = 0; e < 16; ++e) S[e] = 0.f;
#pragma unroll
        for (int s2 = 0; s2 < 8; ++s2) {
            const f32x4 ka = *(const f32x4*)(kmp + 16 * s2), kb = *(const f32x4*)(kmp + 16 * s2 + 4);
            const bf16x8 qf = *(const bf16x8*)(qp + 16 * s2);
            u32x4 hi, lo;
            hi.x = pk_bf16(ka[0], ka[1]); hi.y = pk_bf16(ka[2], ka[3]); hi.z = pk_bf16(kb[0], kb[1]); hi.w = pk_bf16(kb[2], kb[3]);
            lo.x = pk_bf16(ka[0] - bflo(hi.x), ka[1] - bfhi(hi.x)); lo.y = pk_bf16(ka[2] - bflo(hi.y), ka[3] - bfhi(hi.y));
            lo.z = pk_bf16(kb[0] - bflo(hi.z), kb[1] - bfhi(hi.z)); lo.w = pk_bf16(kb[2] - bflo(hi.w), kb[3] - bfhi(hi.w));
            S = __builtin_amdgcn_mfma_f32_32x32x16_bf16(__builtin_bit_cast(bf16x8, hi), qf, S, 0, 0, 0);
            S = __builtin_amdgcn_mfma_f32_32x32x16_bf16(__builtin_bit_cast(bf16x8, lo), qf, S, 0, 0, 0);
        }
        float v0 = -3e38f, v1 = -3e38f, v2 = -3e38f; int i0 = 99, i1 = 99, i2 = 99;
#pragma unroll
        for (int e = 0; e < 16; ++e) {
            const int m = (e & 3) + 8 * (e >> 2) + 4 * hh;
            const float x = m < i ? S[e] : NEG;
            top3_insert(x, m, v0, i0, v1, i1, v2, i2);
        }
        {
            const float pv0 = __shfl_xor(v0, 32), pv1 = __shfl_xor(v1, 32), pv2 = __shfl_xor(v2, 32);
            const int pi0 = __shfl_xor(i0, 32), pi1 = __shfl_xor(i1, 32), pi2 = __shfl_xor(i2, 32);
            top3_insert(pv0, pi0, v0, i0, v1, i1, v2, i2); top3_insert(pv1, pi1, v0, i0, v1, i1, v2, i2); top3_insert(pv2, pi2, v0, i0, v1, i1, v2, i2);
        }
        if (hh == 0) {
            const int tl = wv * 32 + r32;
            if (v0 > 0.5f * NEG) { const int p = __hip_atomic_fetch_add(cnt + i0, 1, __ATOMIC_RELAXED, __HIP_MEMORY_SCOPE_WORKGROUP); bucket[i0 * 256 + p] = (unsigned short)(tl | (0 << 8)); }
            if (v1 > 0.5f * NEG) { const int p = __hip_atomic_fetch_add(cnt + i1, 1, __ATOMIC_RELAXED, __HIP_MEMORY_SCOPE_WORKGROUP); bucket[i1 * 256 + p] = (unsigned short)(tl | (1 << 8)); }
            if (v2 > 0.5f * NEG) { const int p = __hip_atomic_fetch_add(cnt + i2, 1, __ATOMIC_RELAXED, __HIP_MEMORY_SCOPE_WORKGROUP); bucket[i2 * 256 + p] = (unsigned short)(tl | (2 << 8)); }
        }
        __syncthreads();
        for (int idx = tid; idx < 32 * 256; idx += 512) {
            const int j = idx >> 8, p = idx & 255;
            if (j < i && p < cnt[j]) SUB[(((size_t)bh * 32 + j) * 32 + i) * 256 + p] = bucket[idx];
        }
        if (tid < i) CNT[((size_t)bh * 32 + tid) * 32 + i] = cnt[tid];
        __syncthreads();
    }
}

__device__ __forceinline__ unsigned off_b(unsigned row, unsigned ch) { return 256u * row + 16u * (ch ^ (((row & 3u) << 2) | ((row >> 2) & 3u))); }
__device__ __forceinline__ unsigned pi32(unsigned m) { return (m & ~12u) | ((m & 4u) << 1) | ((m & 8u) >> 1); }
__device__ __forceinline__ bf16x8 tr_frag(LAS unsigned char* img, unsigned lane, unsigned c, unsigned ks) {
    const unsigned hh = lane >> 5, blk = (lane >> 4) & 1, q = (lane & 15) >> 2, p = lane & 3;
    const unsigned a0 = off_b(16 * ks + 8 * hh + q, 4 * c + 2 * blk + (p >> 1)) + 8 * (p & 1);
    const unsigned a1 = off_b(16 * ks + 8 * hh + 4 + q, 4 * c + 2 * blk + (p >> 1)) + 8 * (p & 1);
    const s16x4 lo = __builtin_amdgcn_ds_read_tr16_b64_v4i16((LAS s16x4*)(img + a0));
    const s16x4 hi = __builtin_amdgcn_ds_read_tr16_b64_v4i16((LAS s16x4*)(img + a1));
    bf16x8 r; r[0] = lo[0]; r[1] = lo[1]; r[2] = lo[2]; r[3] = lo[3]; r[4] = hi[0]; r[5] = hi[1]; r[6] = hi[2]; r[7] = hi[3];
    return r;
}
__device__ __forceinline__ void phase_att(LAS unsigned char* lds, const bf16_t* QR, const bf16_t* KR, const bf16_t* V, const float* KNMAX, const unsigned short* SUB, const int* CNT, int* ctr,
                                          bf16_t* P012, bf16_t* P3, float* LS) {
    const int tid = threadIdx.x, lane = tid & 63, wv = tid >> 6, r32 = lane & 31, hh = lane >> 5;
    LAS unsigned char* Kimg = lds;
    LAS unsigned char* Vimg = lds + 65536;
    LAS int* misc = (LAS int*)(lds + 131072);
    const float SCL2 = 0.08838834764831845f * 1.4426950408889634f;
    for (;;) {
        __syncthreads();
        if (tid == 0) misc[40] = __hip_atomic_fetch_add(ctr, 1, __ATOMIC_RELAXED, __HIP_MEMORY_SCOPE_AGENT);
        __syncthreads();
        const int item = misc[40];
        if (item >= 2 * NHEAD * 32) break;
        const int j = item >> 5, bh = item & 31, b = bh >> 4, h = bh & 15;
#pragma unroll
        for (int r = 0; r < 8; ++r) {
            const int idx = tid + 512 * r, row = idx >> 4, ch = idx & 15;
            const size_t g = ((size_t)b * SEQ + j * 256 + row) * DM + h * 128 + ch * 8;
            const u32x4 kv = *(const u32x4*)(KR + g), vv = *(const u32x4*)(V + g);
            *(LAS u32x4*)(Kimg + off_b(row, ch)) = kv; *(LAS u32x4*)(Vimg + off_b(row, ch)) = vv;
        }
        if (tid <= 32) { int pre = 0; for (int u = j + 1; u < tid; ++u) pre += CNT[((size_t)bh * 32 + j) * 32 + u]; misc[tid] = pre; }
        float kn = (lane < 32) ? KNMAX[bh * 32 + lane] : 0.f;
        kn = wave_max(kn);
        __syncthreads();
        const int total = misc[32], ntile = (256 + total + 31) >> 5;
        for (int tile = wv; tile < ntile; tile += 8) {
            const int gr = tile * 32 + r32;
            int pos, slot; bool valid = true;
            if (gr < 256) { pos = j * 256 + gr; slot = 3; }
            else {
                const int x = gr - 256; valid = x < total;
                int ii = j + 1;
                for (int u = j + 1; u < 32; ++u) if (misc[u] <= x) ii = u;
                if (valid) { const unsigned e = SUB[(((size_t)bh * 32 + j) * 32 + ii) * 256 + (x - misc[ii])]; pos = ii * 256 + (int)(e & 255u); slot = (int)(e >> 8); }
                else { pos = j * 256; slot = 3; }
            }
            const size_t tok = (size_t)b * SEQ + pos;
            bf16x8 qf[8];
            const bf16_t* qp = QR + tok * DM + h * 128 + 8 * hh;
#pragma unroll
            for (int s = 0; s < 8; ++s) qf[s] = *(const bf16x8*)(qp + 16 * s);
            float qn2 = 0.f;
#pragma unroll
            for (int s = 0; s < 8; ++s)
#pragma unroll
                for (int e = 0; e < 8; ++e) { const float f = bf2f((bf16_t)qf[s][e]); qn2 += f * f; }
            qn2 += __shfl_xor(qn2, 32);
            const float c2 = sqrtf(qn2) * kn * SCL2;
            f32x16 O[4];
#pragma unroll
            for (int dt = 0; dt < 4; ++dt)
#pragma unroll
                for (int e = 0; e < 16; ++e) O[dt][e] = 0.f;
            float l = 0.f;
            const bool own = tile < 8;
            const int kcn = own ? tile + 1 : 8;
            const unsigned krow = pi32((unsigned)r32);
            for (int kc = 0; kc < kcn; ++kc) {
                f32x16 S, S1;
#pragma unroll
                for (int e = 0; e < 16; ++e) { S[e] = 0.f; S1[e] = 0.f; }
#pragma unroll
                for (int s = 0; s < 8; s += 2) {
                    const bf16x8 kf = *(const LAS bf16x8*)(Kimg + off_b(32 * kc + krow, 2 * s + hh));
                    const bf16x8 kf1 = *(const LAS bf16x8*)(Kimg + off_b(32 * kc + krow, 2 * s + 2 + hh));
                    S = __builtin_amdgcn_mfma_f32_32x32x16_bf16(kf, qf[s], S, 0, 0, 0);
                    S1 = __builtin_amdgcn_mfma_f32_32x32x16_bf16(kf1, qf[s + 1], S1, 0, 0, 0);
                }
                float p[16];
                if (own) {
#pragma unroll
                    for (int e = 0; e < 16; ++e) {
                        const unsigned m = (e & 3) + 8 * (e >> 2) + 4 * hh;
                        const int key = j * 256 + 32 * kc + (int)pi32(m);
                        float pe = __builtin_amdgcn_exp2f((S[e] + S1[e]) * SCL2 - c2);
                        if (key > pos) pe = 0.f;
                        p[e] = pe; l += pe;
                    }
                } else {
#pragma unroll
                    for (int e = 0; e < 16; ++e) { const float pe = __builtin_amdgcn_exp2f((S[e] + S1[e]) * SCL2 - c2); p[e] = pe; l += pe; }
                }
                u32x4 w0, w1;
                w0.x = pk_bf16(p[0], p[1]); w0.y = pk_bf16(p[2], p[3]); w0.z = pk_bf16(p[4], p[5]); w0.w = pk_bf16(p[6], p[7]);
                w1.x = pk_bf16(p[8], p[9]); w1.y = pk_bf16(p[10], p[11]); w1.z = pk_bf16(p[12], p[13]); w1.w = pk_bf16(p[14], p[15]);
                const bf16x8 pf0 = __builtin_bit_cast(bf16x8, w0), pf1 = __builtin_bit_cast(bf16x8, w1);
#pragma unroll
                for (int dt = 0; dt < 4; ++dt) {
                    const bf16x8 v0 = tr_frag(Vimg, lane, dt, 2 * kc), v1 = tr_frag(Vimg, lane, dt, 2 * kc + 1);
                    O[dt] = __builtin_amdgcn_mfma_f32_32x32x16_bf16(v0, pf0, O[dt], 0, 0, 0);
                    O[dt] = __builtin_amdgcn_mfma_f32_32x32x16_bf16(v1, pf1, O[dt], 0, 0, 0);
                }
            }
            l += __shfl_xor(l, 32);
            if (valid) {
                bf16_t* pl = (slot < 3 ? P012 + (size_t)slot * ((size_t)32 << 20) : P3) + (tok * NHEAD + h) * 128 + 4 * hh;
#pragma unroll
                for (int dt = 0; dt < 4; ++dt)
#pragma unroll
                    for (int g = 0; g < 4; ++g) {
                        u32x2 w; w.x = pk_bf16(O[dt][4 * g], O[dt][4 * g + 1]); w.y = pk_bf16(O[dt][4 * g + 2], O[dt][4 * g + 3]);
                        *(u32x2*)(pl + 32 * dt + 8 * g) = w;
                    }
                if (hh == 0) LS[(size_t)slot * MTOK * NHEAD + tok * NHEAD + h] = l;
            }
        }
    }
}
__device__ __forceinline__ void phase_comb(const bf16_t* P012, const bf16_t* P3, const float* LS, bf16_t* AO) {
    const size_t n = (size_t)MTOK * NHEAD * 16, stride = (size_t)gridDim.x * 512;
    for (size_t idx = (size_t)blockIdx.x * 512 + threadIdx.x; idx < n; idx += stride) {
        const size_t th = idx >> 4; const int ch = (int)(idx & 15);
        const int t = (int)((th >> 4) & (SEQ - 1)), blk = t >> 8, nsel = blk < 3 ? blk : 3;
        float acc[8];
        float l = LS[(size_t)3 * MTOK * NHEAD + th];
        { const u32x4 w = *(const u32x4*)(P3 + th * 128 + ch * 8);
          acc[0] = bflo(w.x); acc[1] = bfhi(w.x); acc[2] = bflo(w.y); acc[3] = bfhi(w.y); acc[4] = bflo(w.z); acc[5] = bfhi(w.z); acc[6] = bflo(w.w); acc[7] = bfhi(w.w); }
#pragma unroll
        for (int s = 0; s < 3; ++s) {
            u32x4 w = *(const u32x4*)(P012 + (size_t)s * ((size_t)32 << 20) + th * 128 + ch * 8);
            float ls = LS[(size_t)s * MTOK * NHEAD + th];
            if (s >= nsel) { w = (u32x4){0u, 0u, 0u, 0u}; ls = 0.f; }
            acc[0] += bflo(w.x); acc[1] += bfhi(w.x); acc[2] += bflo(w.y); acc[3] += bfhi(w.y); acc[4] += bflo(w.z); acc[5] += bfhi(w.z); acc[6] += bflo(w.w); acc[7] += bfhi(w.w);
            l += ls;
        }
        const float rl = 1.0f / l;
        u32x4 o; o.x = pk_bf16(acc[0] * rl, acc[1] * rl); o.y = pk_bf16(acc[2] * rl, acc[3] * rl); o.z = pk_bf16(acc[4] * rl, acc[5] * rl); o.w = pk_bf16(acc[6] * rl, acc[7] * rl);
        *(u32x4*)(AO + th * 128 + ch * 8) = o;
    }
}


__device__ __forceinline__ void qrow_issue(f32x4 (&v)[8], const float* p, int lane) {
#pragma unroll
    for (int i = 0; i < 2; ++i)
#pragma unroll
        for (int q = 0; q < 4; ++q) v[i * 4 + q] = *(const f32x4*)(p + 1024 * i + 16 * lane + 4 * q);
}
__device__ __forceinline__ void qrow_finish(const f32x4 (&v)[8], unsigned char* dst, float* scl, int lane) {
    float am = 0.f;
#pragma unroll
    for (int i = 0; i < 8; ++i) am = fmaxf(am, fmaxf(fmaxf(fabsf(v[i][0]), fabsf(v[i][1])), fmaxf(fabsf(v[i][2]), fabsf(v[i][3]))));
    am = fmaxf(wave_max(am), 1e-30f);
    const float inv = 127.0f / am;
    if (lane == 0) *scl = am * (1.0f / 127.0f);
#pragma unroll
    for (int i = 0; i < 2; ++i) {
        u32x4 w;
#pragma unroll
        for (int q = 0; q < 4; ++q) {
            const f32x4 t = v[i * 4 + q];
            const unsigned b0 = (unsigned)(int)(rintf(t[0] * inv) + 128.0f), b1 = (unsigned)(int)(rintf(t[1] * inv) + 128.0f), b2 = (unsigned)(int)(rintf(t[2] * inv) + 128.0f), b3 = (unsigned)(int)(rintf(t[3] * inv) + 128.0f);
            w[q] = b0 | (b1 << 8) | (b2 << 16) | (b3 << 24);
        }
        *(u32x4*)(dst + 1024 * i + 16 * lane) = w;
    }
}
struct QuantJob { const float* TU; const float* TV; unsigned char* QU; unsigned char* QV; float* SU; float* SV; };
__device__ __forceinline__ const float* qj_src(const QuantJob& q, int r) { return (r < 16384 ? q.TU : q.TV) + (size_t)(r & 16383) * DM; }
__device__ __forceinline__ unsigned char* qj_dst(const QuantJob& q, int r) { return (r < 16384 ? q.QU : q.QV) + (size_t)(r & 16383) * DM; }
__device__ __forceinline__ float* qj_scl(const QuantJob& q, int r) { return (r < 16384 ? q.SU : q.SV) + (r & 16383); }
__device__ __forceinline__ void qj_tail(const QuantJob& q, int done_iters) {
    const int lane = threadIdx.x & 63, gw = blockIdx.x * 8 + (threadIdx.x >> 6), nw = gridDim.x * 8;
    for (int r = gw + done_iters * nw; r < 32768; r += nw) { f32x4 v[8]; qrow_issue(v, qj_src(q, r), lane); qrow_finish(v, qj_dst(q, r), qj_scl(q, r), lane); }
}
__device__ __forceinline__ float logf_gate(float z, float lb) { return __logf(lb + (1.0f - lb) * sigmoidf_(z)); }
__device__ __forceinline__ void phase_scan_a(LAS unsigned char* lds, const bf16_t* FZ, const float* LB, const bf16_t* I1, bf16_t* LT, float* DEC, const QuantJob qj, unsigned* dbgc = nullptr) {
    unsigned dbg_kt = 0, dbg_acc = 0;
    const int tid = threadIdx.x, lane = tid & 63, wv = tid >> 6, k = tid & 127, part = tid >> 7;
    LAS unsigned char* Iimg = lds; LAS unsigned char* KTimg = lds + 16384;
    LAS float* psum = (LAS float*)(lds + 32768);
    LAS unsigned char* Lst = lds + 36864;
#if SCAN_A_VALU == 2
    for (int item = blockIdx.x; item < 2 * NHEAD * 128; item += gridDim.x) {
        const int bh = item >> 7, c = item & 127, b = bh >> 4, h = bh & 15;
        const size_t tok0 = (size_t)b * SEQ + c * 64;
        for (int idx = tid; idx < 16384; idx += 512) {
            const int v = idx >> 7, kk = idx & 127;
            float g = 1.f, L = 0.f;
            for (int s2 = 63; s2 >= 0; --s2) { const size_t o = (tok0 + s2) * DM + h * 128; const float f = __expf(logf_gate(bf2f(FZ[o + kk]), LB[h * 128 + kk])); L += bf2f(I1[o + v]) * (1.0f - f) * g; g *= f; }
            LT[(size_t)item * 16384 + idx] = (bf16_t)(pk_bf16(L, 0.f) & 0xffffu);
        }
    }
    return;
#endif
    bf16_t nfz[16]; u32x4 nit_[2];
#define SA_LOAD(item_) { const int bh_ = (item_) >> 7, c_ = (item_) & 127; const size_t t0_ = (size_t)(bh_ >> 4) * SEQ + c_ * 64; const int h_ = bh_ & 15; \
        _Pragma("unroll") for (int i = 0; i < 16; ++i) nfz[i] = FZ[(t0_ + 16 * part + i) * DM + h_ * 128 + k]; \
        _Pragma("unroll") for (int r = 0; r < 2; ++r) { const int idx = tid + 512 * r, row = idx >> 4, ch = idx & 15; nit_[r] = *(const u32x4*)(I1 + (t0_ + row) * DM + h_ * 128 + ch * 8); } }
    if ((int)blockIdx.x < 2 * NHEAD * 128) SA_LOAD((int)blockIdx.x)
    int qiter = 0;
    for (int item = blockIdx.x; item < 2 * NHEAD * 128; item += gridDim.x, ++qiter) {
        const int bh = item >> 7, c = item & 127, b = bh >> 4, h = bh & 15;
        const size_t tok0 = (size_t)b * SEQ + c * 64;
        float lf[16];
        const float lbk = LB[h * 128 + k];
#pragma unroll
        for (int i = 0; i < 16; ++i) lf[i] = logf_gate(bf2f(nfz[i]), lbk);
#pragma unroll
        for (int r = 0; r < 2; ++r) { const int idx = tid + 512 * r, row = idx >> 4, ch = idx & 15; *(LAS u32x4*)(Iimg + off_b(row, ch)) = nit_[r]; }
        if (item + (int)gridDim.x < 2 * NHEAD * 128) SA_LOAD(item + (int)gridDim.x)
        const int qrow = qiter * (int)gridDim.x * 8 + (int)blockIdx.x * 8 + wv; const bool doq = qrow < 32768; f32x4 qv8[8];
        if (doq) qrow_issue(qv8, qj_src(qj, qrow), lane);
        float cs = 0.f;
#pragma unroll
        for (int i = 0; i < 16; ++i) cs += lf[i];
        psum[part * 128 + k] = cs;
        __syncthreads();
        const float p0 = psum[k], p1 = psum[128 + k], p2 = psum[256 + k], p3 = psum[384 + k];
        const float blast = (p0 + p1) + (p2 + p3);
        float bb = part == 0 ? 0.f : (part == 1 ? p0 : (part == 2 ? p0 + p1 : p0 + p1 + p2));
#pragma unroll
        for (int i = 0; i < 16; ++i) {
            bb += lf[i];
            const float kt = (1.0f - __expf(lf[i])) * __expf(blast - bb);
            if (!(kt - kt == 0.f)) ++dbg_kt;
            const int srow = 16 * part + i;
            *(LAS bf16_t*)(KTimg + off_b(srow, k >> 3) + 2 * (k & 7)) = (bf16_t)(pk_bf16(kt, 0.f) & 0xffffu);
        }
        if (part == 0) DEC[(size_t)item * 128 + k] = __expf(blast);
        __syncthreads();
#if SCAN_A_VALU
        for (int idx = tid; idx < 16384; idx += 512) {
            const int v = idx >> 7, kk = idx & 127;
            float accv = 0.f;
            for (int s2 = 0; s2 < 64; ++s2) accv += bf2f(*(const LAS bf16_t*)(Iimg + off_b(s2, v >> 3) + 2 * (v & 7))) * bf2f(*(const LAS bf16_t*)(KTimg + off_b(s2, kk >> 3) + 2 * (kk & 7)));
            *(LAS bf16_t*)(Lst + v * 272 + 2 * kk) = (bf16_t)(pk_bf16(accv, 0.f) & 0xffffu);
        }
        if (0)
#endif
        {
            const int vt = wv >> 1;
            f32x16 acc0, acc1;
#pragma unroll
            for (int e = 0; e < 16; ++e) { acc0[e] = 0.f; acc1[e] = 0.f; }
#pragma unroll
            for (int ks = 0; ks < 4; ++ks) {
                const bf16x8 af = tr_frag(Iimg, lane, vt, ks);
                const bf16x8 b0 = tr_frag(KTimg, lane, 2 * (wv & 1), ks), b1 = tr_frag(KTimg, lane, 2 * (wv & 1) + 1, ks);
                acc0 = __builtin_amdgcn_mfma_f32_32x32x16_bf16(af, b0, acc0, 0, 0, 0);
                acc1 = __builtin_amdgcn_mfma_f32_32x32x16_bf16(af, b1, acc1, 0, 0, 0);
            }
            const int r32 = lane & 31, hh = lane >> 5;
#pragma unroll
            for (int e = 0; e < 16; ++e) {
                if (!(acc0[e] - acc0[e] == 0.f)) ++dbg_acc; if (!(acc1[e] - acc1[e] == 0.f)) ++dbg_acc;
                const int v = 32 * vt + (e & 3) + 8 * (e >> 2) + 4 * hh;
                *(LAS bf16_t*)(Lst + v * 272 + 2 * (64 * (wv & 1) + r32)) = (bf16_t)(pk_bf16(acc0[e], 0.f) & 0xffffu);
                *(LAS bf16_t*)(Lst + v * 272 + 2 * (64 * (wv & 1) + 32 + r32)) = (bf16_t)(pk_bf16(acc1[e], 0.f) & 0xffffu);
            }
        }
        __syncthreads();
#pragma unroll
        for (int r = 0; r < 4; ++r) { const int idx = tid + 512 * r, row = idx >> 4, ch = idx & 15; *(u32x4*)(LT + (size_t)item * 16384 + row * 128 + ch * 8) = *(const LAS u32x4*)(Lst + row * 272 + ch * 16); }
        if (doq) qrow_finish(qv8, qj_dst(qj, qrow), qj_scl(qj, qrow), lane);
        __syncthreads();
    }
    qj_tail(qj, qiter);
    if (dbgc) { if (dbg_kt) atomicAdd(dbgc + 0, dbg_kt); if (dbg_acc) atomicAdd(dbgc + 1, dbg_acc); }
}
__device__ __forceinline__ void phase_scan_b(bf16_t* LT, const float* DEC, const QuantJob qj) {
    const int n = 2 * NHEAD * 128 * 32;
    const int lane = threadIdx.x & 63, gw = blockIdx.x * 8 + (threadIdx.x >> 6), nw = gridDim.x * 8;
    int qdone = 0;
    for (int idx = blockIdx.x * 512 + threadIdx.x; idx < n; idx += gridDim.x * 512) {
        const int bh = idx >> 12, vk = idx & 4095, k4 = (vk & 31) * 4;
        float S0 = 0.f, S1 = 0.f, S2 = 0.f, S3 = 0.f;
        bf16_t* p = LT + (size_t)bh * 128 * 16384 + (size_t)vk * 4;
        const float* dp = DEC + (size_t)bh * 128 * 128 + k4;
        for (int c8 = 0; c8 < 16; ++c8) {
            const int qrow = (qdone + c8) * nw + gw; const bool doq = qrow < 32768; f32x4 qv8[8];
            if (doq) qrow_issue(qv8, qj_src(qj, qrow), lane);
#pragma unroll
            for (int c2 = 0; c2 < 8; ++c2) {
                const int c = c8 * 8 + c2;
                const u32x2 w = *(const u32x2*)(p + (size_t)c * 16384);
                const f32x4 d = *(const f32x4*)(dp + c * 128);
                u32x2 o; o.x = pk_bf16(S0, S1); o.y = pk_bf16(S2, S3);
                *(u32x2*)(p + (size_t)c * 16384) = o;
                S0 = d[0] * S0 + bflo(w.x); S1 = d[1] * S1 + bfhi(w.x); S2 = d[2] * S2 + bflo(w.y); S3 = d[3] * S3 + bfhi(w.y);
            }
            if (doq) qrow_finish(qv8, qj_dst(qj, qrow), qj_scl(qj, qrow), lane);
        }
        qdone += 16;
    }
    qj_tail(qj, qdone);
}
__device__ __forceinline__ void phase_scan_c(LAS unsigned char* lds, const bf16_t* Q1, const bf16_t* FZ, const float* LB, const bf16_t* I1, const bf16_t* G1, const bf16_t* SP, const float* gnorm, bf16_t* OG) {
    const int tid = threadIdx.x, lane = tid & 63, wv = tid >> 6, k = tid & 127, part = tid >> 7, r32 = lane & 31, hh = lane >> 5;
    LAS unsigned char* QTimg = lds; LAS unsigned char* QPimg = lds + 16384; LAS unsigned char* KPimg = lds + 32768; LAS unsigned char* Iimg = lds + 49152; LAS unsigned char* SPimg = lds + 65536;
    LAS float* psum = (LAS float*)(lds + 98304);
    LAS float* ssq = (LAS float*)(lds + 100352);
    LAS unsigned char* OT = lds + 102400;
    bf16_t nfz[16], nq[16]; u32x4 nit_[2], nsp[4], ngt[2];
#define SC_LOAD(item_) { const int bh_ = (item_) >> 7, c_ = (item_) & 127; const size_t t0_ = (size_t)(bh_ >> 4) * SEQ + c_ * 64; const int h_ = bh_ & 15; \
        _Pragma("unroll") for (int i = 0; i < 16; ++i) { const size_t o_ = (t0_ + 16 * part + i) * DM + h_ * 128 + k; nfz[i] = FZ[o_]; nq[i] = Q1[o_]; } \
        _Pragma("unroll") for (int r = 0; r < 2; ++r) { const int idx = tid + 512 * r, row = idx >> 4, ch = idx & 15; nit_[r] = *(const u32x4*)(I1 + (t0_ + row) * DM + h_ * 128 + ch * 8); ngt[r] = *(const u32x4*)(G1 + (t0_ + row) * DM + h_ * 128 + ch * 8); } \
        _Pragma("unroll") for (int r = 0; r < 4; ++r) { const int idx = tid + 512 * r, row = idx >> 4, ch = idx & 15; nsp[r] = *(const u32x4*)(SP + (size_t)(item_) * 16384 + row * 128 + ch * 8); } }
    if ((int)blockIdx.x < 2 * NHEAD * 128) SC_LOAD((int)blockIdx.x)
    for (int item = blockIdx.x; item < 2 * NHEAD * 128; item += gridDim.x) {
        const int bh = item >> 7, c = item & 127, b = bh >> 4, h = bh & 15;
        const size_t tok0 = (size_t)b * SEQ + c * 64;
        float lf[16], qv[16];
        const float lbk = LB[h * 128 + k];
#pragma unroll
        for (int i = 0; i < 16; ++i) { lf[i] = logf_gate(bf2f(nfz[i]), lbk); const float qr = bf2f(nq[i]); qv[i] = qr * sigmoidf_(qr); }
#pragma unroll
        for (int r = 0; r < 2; ++r) { const int idx = tid + 512 * r, row = idx >> 4, ch = idx & 15; *(LAS u32x4*)(Iimg + off_b(row, ch)) = nit_[r]; }
#pragma unroll
        for (int r = 0; r < 4; ++r) { const int idx = tid + 512 * r, row = idx >> 4, ch = idx & 15; *(LAS u32x4*)(SPimg + off_b(row, ch)) = nsp[r]; }
        const u32x4 gcur0 = ngt[0], gcur1 = ngt[1];
        if (item + (int)gridDim.x < 2 * NHEAD * 128) SC_LOAD(item + (int)gridDim.x)
        float cs = 0.f;
#pragma unroll
        for (int i = 0; i < 16; ++i) cs += lf[i];
        psum[part * 128 + k] = cs;
        __syncthreads();
        const float p0 = psum[k], p1 = psum[128 + k], p2 = psum[256 + k];
        const float rr = p0 + p1;
        float bb = part == 0 ? 0.f : (part == 1 ? p0 : (part == 2 ? p0 + p1 : p0 + p1 + p2));
#pragma unroll
        for (int i = 0; i < 16; ++i) {
            bb += lf[i];
            const float qt = qv[i] * __expf(bb), qp = qv[i] * __expf(bb - rr), kp = (1.0f - __expf(lf[i])) * __expf(rr - bb);
            const unsigned o = off_b(16 * part + i, k >> 3) + 2 * (k & 7);
            *(LAS bf16_t*)(QTimg + o) = (bf16_t)(pk_bf16(qt, 0.f) & 0xffffu);
            *(LAS bf16_t*)(QPimg + o) = (bf16_t)(pk_bf16(qp, 0.f) & 0xffffu);
            *(LAS bf16_t*)(KPimg + o) = (bf16_t)(pk_bf16(kp, 0.f) & 0xffffu);
        }
        __syncthreads();
        const int tt = wv & 1, vt = wv >> 1;
        f32x16 O;
#pragma unroll
        for (int e = 0; e < 16; ++e) O[e] = 0.f;
#pragma unroll
        for (int ks = 0; ks < 8; ++ks) {
            const bf16x8 af = *(const LAS bf16x8*)(SPimg + off_b(32 * vt + r32, 2 * ks + hh));
            const bf16x8 bf = *(const LAS bf16x8*)(QTimg + off_b(32 * tt + r32, 2 * ks + hh));
            O = __builtin_amdgcn_mfma_f32_32x32x16_bf16(af, bf, O, 0, 0, 0);
        }
        const unsigned krow = pi32((unsigned)r32);
        for (int st = 0; st <= tt; ++st) {
            f32x16 S;
#pragma unroll
            for (int e = 0; e < 16; ++e) S[e] = 0.f;
#pragma unroll
            for (int ks = 0; ks < 8; ++ks) {
                const bf16x8 af = *(const LAS bf16x8*)(KPimg + off_b(32 * st + krow, 2 * ks + hh));
                const bf16x8 bf = *(const LAS bf16x8*)(QPimg + off_b(32 * tt + r32, 2 * ks + hh));
                S = __builtin_amdgcn_mfma_f32_32x32x16_bf16(af, bf, S, 0, 0, 0);
            }
            float p[16];
#pragma unroll
            for (int e = 0; e < 16; ++e) {
                const unsigned m = (e & 3) + 8 * (e >> 2) + 4 * hh;
                const int sidx = 32 * st + (int)pi32(m), tidx = 32 * tt + r32;
                p[e] = sidx <= tidx ? S[e] : 0.f;
            }
            u32x4 w0, w1;
            w0.x = pk_bf16(p[0], p[1]); w0.y = pk_bf16(p[2], p[3]); w0.z = pk_bf16(p[4], p[5]); w0.w = pk_bf16(p[6], p[7]);
            w1.x = pk_bf16(p[8], p[9]); w1.y = pk_bf16(p[10], p[11]); w1.z = pk_bf16(p[12], p[13]); w1.w = pk_bf16(p[14], p[15]);
            const bf16x8 pf0 = __builtin_bit_cast(bf16x8, w0), pf1 = __builtin_bit_cast(bf16x8, w1);
            const bf16x8 i0 = tr_frag(Iimg, lane, vt, 2 * st), i1 = tr_frag(Iimg, lane, vt, 2 * st + 1);
            O = __builtin_amdgcn_mfma_f32_32x32x16_bf16(i0, pf0, O, 0, 0, 0);
            O = __builtin_amdgcn_mfma_f32_32x32x16_bf16(i1, pf1, O, 0, 0, 0);
        }
        float sq = 0.f;
#pragma unroll
        for (int e = 0; e < 16; ++e) sq += O[e] * O[e];
        sq += __shfl_xor(sq, 32);
        if (hh == 0) ssq[vt * 64 + 32 * tt + r32] = sq;
        __syncthreads();
        const int tl = 32 * tt + r32;
        const float rstd = rsqrtf((ssq[tl] + ssq[64 + tl] + ssq[128 + tl] + ssq[192 + tl]) * (1.0f / 128.0f) + 1e-6f);
#pragma unroll
        for (int g = 0; g < 4; ++g) {
            const int v0 = 32 * vt + 8 * g + 4 * hh;
            const f32x4 gn = *(const f32x4*)(gnorm + v0);
            u32x2 w; w.x = pk_bf16(O[4 * g] * rstd * gn[0], O[4 * g + 1] * rstd * gn[1]); w.y = pk_bf16(O[4 * g + 2] * rstd * gn[2], O[4 * g + 3] * rstd * gn[3]);
            *(LAS u32x2*)(OT + tl * 272 + v0 * 2) = w;
        }
        __syncthreads();
#pragma unroll
        for (int r = 0; r < 2; ++r) {
            const int idx = tid + 512 * r, row = idx >> 4, ch = idx & 15;
            const u32x4 ov = *(const LAS u32x4*)(OT + row * 272 + ch * 16);
            const size_t go = (tok0 + row) * DM + h * 128 + ch * 8;
            const u32x4 gv = r == 0 ? gcur0 : gcur1;
            u32x4 w;
#define SILU_(x_) ((x_) * sigmoidf_(x_))
            w.x = pk_bf16(bflo(ov.x) * SILU_(bflo(gv.x)), bfhi(ov.x) * SILU_(bfhi(gv.x))); w.y = pk_bf16(bflo(ov.y) * SILU_(bflo(gv.y)), bfhi(ov.y) * SILU_(bfhi(gv.y)));
            w.z = pk_bf16(bflo(ov.z) * SILU_(bflo(gv.z)), bfhi(ov.z) * SILU_(bfhi(gv.z))); w.w = pk_bf16(bflo(ov.w) * SILU_(bflo(gv.w)), bfhi(ov.w) * SILU_(bfhi(gv.w)));
#undef SILU_
            *(u32x4*)(OG + go) = w;
        }
        __syncthreads();
    }
}


#if SCAN_DBG == 2
__device__ __forceinline__ void dbg_compare(LAS float* red, const bf16_t* A, const bf16_t* B, float* DBG) {
    float sd = 0.f, sr = 0.f, nn = 0.f;
    const size_t n = (size_t)MTOK * DM;
    for (size_t i = (size_t)blockIdx.x * 512 + threadIdx.x; i < n; i += (size_t)gridDim.x * 512) {
        const float x = bf2f(A[i]), y = bf2f(B[i]);
        if (!(x - x == 0.f)) nn += 1.f; else { sd += (x - y) * (x - y); sr += y * y; }
    }
    sd = wave_sum(sd); sr = wave_sum(sr); nn = wave_sum(nn);
    const int wv = threadIdx.x >> 6;
    if ((threadIdx.x & 63) == 0) { red[wv * 3] = sd; red[wv * 3 + 1] = sr; red[wv * 3 + 2] = nn; }
    __syncthreads();
    if (threadIdx.x == 0) { float a = 0, b = 0, c = 0; for (int w = 0; w < 8; ++w) { a += red[w * 3]; b += red[w * 3 + 1]; c += red[w * 3 + 2]; } DBG[blockIdx.x * 4] = a; DBG[blockIdx.x * 4 + 1] = b; DBG[blockIdx.x * 4 + 2] = c; }
    __syncthreads();
}
__device__ __forceinline__ void dbg_emit(const float* DBG, float* out) {
    float a = 0, b = 0, c = 0;
    for (int w = 0; w < (int)gridDim.x; ++w) { a += DBG[w * 4]; b += DBG[w * 4 + 1]; c += DBG[w * 4 + 2]; }
    const float rel = sqrtf(a / b);
    int k = (int)rintf(-2.0f * log10f(rel)); k = k < 0 ? 0 : (k > 16 ? 16 : k);
    if (c > 0.f) k = 17;
    const float cc = sqrtf(0.5f * (float)k);
    const size_t n = (size_t)MTOK * DM;
    for (size_t i = (size_t)blockIdx.x * 512 + threadIdx.x; i < n; i += (size_t)gridDim.x * 512) out[i] = cc;
}
#endif

#if SCAN_DBG == 3
__device__ __forceinline__ void dbg_count_bf16(const bf16_t* A, size_t n, unsigned* cnt) {
    unsigned c = 0;
    for (size_t i = (size_t)blockIdx.x * 512 + threadIdx.x; i < n; i += (size_t)gridDim.x * 512) { const float x = bf2f(A[i]); if (!(x - x == 0.f)) ++c; }
    if (c) atomicAdd(cnt, c);
}
__device__ __forceinline__ void dbg_count_f32(const float* A, size_t n, unsigned* cnt) {
    unsigned c = 0;
    for (size_t i = (size_t)blockIdx.x * 512 + threadIdx.x; i < n; i += (size_t)gridDim.x * 512) { const float x = A[i]; if (!(x - x == 0.f)) ++c; }
    if (c) atomicAdd(cnt, c);
}
__device__ __forceinline__ void dbg_emit3(const unsigned* cnt, float* out) {
    float code = 0.f;
    for (int st = 3; st >= 0; --st) { const unsigned c = cnt[st]; if (c) { float lg = log10f((float)c); lg = lg > 9.f ? 9.f : lg; code = (float)(st + 1) + 0.1f * lg; } }
    const float cc = sqrtf(code);
    const size_t n = (size_t)MTOK * DM;
    for (size_t i = (size_t)blockIdx.x * 512 + threadIdx.x; i < n; i += (size_t)gridDim.x * 512) out[i] = cc;
}
#endif

#if SCAN_DBG == 4 || SCAN_DBG == 6
__device__ __forceinline__ void dbg_compare4(LAS float* red, const bf16_t* A, const bf16_t* B, const bf16_t* C, float* DBG) {
    float sd = 0.f, sr = 0.f, nn = 0.f, mm = 0.f;
    const size_t n = (size_t)MTOK * DM;
    for (size_t i = (size_t)blockIdx.x * 512 + threadIdx.x; i < n; i += (size_t)gridDim.x * 512) {
        const float x = bf2f(A[i]), y = bf2f(B[i]);
        if (!(x - x == 0.f)) nn += 1.f; else { sd += (x - y) * (x - y); sr += y * y; }
        if (A[i] != C[i]) mm += 1.f;
    }
    sd = wave_sum(sd); sr = wave_sum(sr); nn = wave_sum(nn); mm = wave_sum(mm);
    const int wv = threadIdx.x >> 6;
    if ((threadIdx.x & 63) == 0) { red[wv * 4] = sd; red[wv * 4 + 1] = sr; red[wv * 4 + 2] = nn; red[wv * 4 + 3] = mm; }
    __syncthreads();
    if (threadIdx.x == 0) { float a = 0, b = 0, c = 0, d = 0; for (int w = 0; w < 8; ++w) { a += red[w * 4]; b += red[w * 4 + 1]; c += red[w * 4 + 2]; d += red[w * 4 + 3]; }
        DBG[blockIdx.x * 4] = a; DBG[blockIdx.x * 4 + 1] = b; DBG[blockIdx.x * 4 + 2] = c; DBG[blockIdx.x * 4 + 3] = d; }
    __syncthreads();
}
__device__ __forceinline__ void dbg_emit4(const float* DBG, float* out) {
    float a = 0, b = 0, c = 0, d = 0;
    for (int w = 0; w < (int)gridDim.x; ++w) { a += DBG[w * 4]; b += DBG[w * 4 + 1]; c += DBG[w * 4 + 2]; d += DBG[w * 4 + 3]; }
    const float rel = sqrtf(a / b);
    int k = (int)rintf(-log10f(rel)); k = k < 0 ? 0 : (k > 8 ? 8 : k);
#if SCAN_DBG == 6
    const float cc = sqrtf((float)k + ((d + c) > 0.f ? 0.5f : 0.f));
#else
    int m = (int)ceilf(log10f(1.0f + d + c)); m = m > 9 ? 9 : m;
    const float cc = sqrtf((float)k + 0.1f * (float)m);
#endif
    const size_t n = (size_t)MTOK * DM;
    for (size_t i = (size_t)blockIdx.x * 512 + threadIdx.x; i < n; i += (size_t)gridDim.x * 512) out[i] = cc;
}
#endif

#if SCAN_DBG == 5
__device__ __forceinline__ void dbg_lds16_test(LAS unsigned char* lds, unsigned* cnt) {
    const int tid = threadIdx.x;
    unsigned bad = 0;
    for (int rep = 0; rep < 64; ++rep) {
        for (int i = tid; i < 1024; i += 512) *(LAS u32x4*)(lds + i * 16) = (u32x4){0x7fc07fc0u, 0x7fc07fc0u, 0x7fc07fc0u, 0x7fc07fc0u};
        __syncthreads();
        const int k = tid & 127, part = tid >> 7;
#pragma unroll
        for (int i = 0; i < 16; ++i) {
            const int row = 16 * part + i;
            *(LAS bf16_t*)(lds + off_b(row, k >> 3) + 2 * (k & 7)) = (bf16_t)((row * 128 + k + rep) & 0x7fff);
        }
        __syncthreads();
        for (int idx = tid; idx < 64 * 128; idx += 512) {
            const int row = idx >> 7, kk = idx & 127;
            const bf16_t got = *(const LAS bf16_t*)(lds + off_b(row, kk >> 3) + 2 * (kk & 7));
            if (got != (bf16_t)((row * 128 + kk + rep) & 0x7fff)) ++bad;
        }
        __syncthreads();
    }
    if (bad) atomicAdd(cnt, bad);
}
__device__ __forceinline__ void dbg_emit5(const unsigned* cnt, float* out) {
    const unsigned c = cnt[0];
    float code = 0.f;
    if (c) { float lg = log10f((float)c); code = 1.0f + (lg > 8.9f ? 8.9f : lg); }
    const float cc = sqrtf(code);
    const size_t n = (size_t)MTOK * DM;
    for (size_t i = (size_t)blockIdx.x * 512 + threadIdx.x; i < n; i += (size_t)gridDim.x * 512) out[i] = cc;
}
#endif

#if SCAN_DBG == 6
__device__ __forceinline__ void dbg_check_a(LAS float* red, const float* LF, const bf16_t* I1, const bf16_t* LT, const bf16_t* LT2, float* DBG) {
    float sd = 0.f, sr = 0.f, mm = 0.f;
    const size_t n = (size_t)4096 * 16384;
    for (size_t i = (size_t)blockIdx.x * 512 + threadIdx.x; i < n; i += (size_t)gridDim.x * 512) {
        const int item = (int)(i >> 14), v = (int)((i >> 7) & 127), k = (int)(i & 127);
        const int bh = item >> 7, c = item & 127, b = bh >> 4, h = bh & 15;
        const size_t tok0 = (size_t)b * SEQ + c * 64;
        float g = 1.f, L = 0.f;
        for (int s2 = 63; s2 >= 0; --s2) {
            const size_t o = (tok0 + s2) * DM + h * 128;
            const float f = __expf(LF[o + k]);
            L += bf2f(I1[o + v]) * (1.0f - f) * g;
            g *= f;
        }
        const float x = bf2f(LT[i]);
        sd += (x - L) * (x - L); sr += L * L;
        if (LT[i] != LT2[i]) mm += 1.f;
    }
    sd = wave_sum(sd); sr = wave_sum(sr); mm = wave_sum(mm);
    const int wv = threadIdx.x >> 6;
    if ((threadIdx.x & 63) == 0) { red[wv * 4] = sd; red[wv * 4 + 1] = sr; red[wv * 4 + 2] = 0.f; red[wv * 4 + 3] = mm; }
    __syncthreads();
    if (threadIdx.x == 0) { float a = 0, b2 = 0, d = 0; for (int w = 0; w < 8; ++w) { a += red[w * 4]; b2 += red[w * 4 + 1]; d += red[w * 4 + 3]; }
        DBG[blockIdx.x * 4] = a; DBG[blockIdx.x * 4 + 1] = b2; DBG[blockIdx.x * 4 + 2] = 0.f; DBG[blockIdx.x * 4 + 3] = d; }
    __syncthreads();
}
#endif

#if SCAN_DBG == 7
#ifndef DBG_FAM
#define DBG_FAM 0
#endif
__device__ __forceinline__ void dbg_check_a7(const float* LF, const bf16_t* I1, const bf16_t* LT, float* DBG) {
    const size_t n = (size_t)4096 * 16384;
    float nbad = 0.f, nnf = 0.f;
    for (size_t i = (size_t)blockIdx.x * 512 + threadIdx.x; i < n; i += (size_t)gridDim.x * 512 * 8) {
        const int item = (int)(i >> 14), v = (int)((i >> 7) & 127), k = (int)(i & 127);
        const int bh = item >> 7, c = item & 127, b = bh >> 4, h = bh & 15;
        const size_t tok0 = (size_t)b * SEQ + c * 64;
        float g = 1.f, L = 0.f;
        for (int s2 = 63; s2 >= 0; --s2) {
            const size_t o = (tok0 + s2) * DM + h * 128;
            const float f = __expf(LF[o + k]);
            L += bf2f(I1[o + v]) * (1.0f - f) * g;
            g *= f;
        }
        const float x = bf2f(LT[i]);
        if (!(x - x == 0.f)) { nnf += 1.f; nbad += 1.f; }
        else if (fabsf(x - L) > 0.02f * fabsf(L) + 1e-2f) nbad += 1.f;
    }
    nbad = wave_sum(nbad); nnf = wave_sum(nnf);
    if ((threadIdx.x & 63) == 0) { atomicAdd(DBG, nbad); atomicAdd(DBG + 1, nnf); }
}
__device__ __forceinline__ void dbg_emit7(const float* DBG, float* out) {
    const float nb = DBG[0], nf = DBG[1];
    int A = nb == 0.f ? 0 : (nb <= 100.f ? 1 : (nb <= 1e4f ? 3 : (nb <= 1e6f ? 5 : 7)));
    int B = nf == 0.f ? 0 : 5;
    const float cc = sqrtf((float)A + 0.1f * (float)B);
    const size_t n = (size_t)MTOK * DM;
    for (size_t i = (size_t)blockIdx.x * 512 + threadIdx.x; i < n; i += (size_t)gridDim.x * 512) out[i] = cc;
}
#endif
__device__ __forceinline__ int opaque(int v) { asm volatile("" : "+s"(v)); return v; }
template <bool L1> __device__ __forceinline__ void run_gemm_out(const Args& a, LAS unsigned char* lds) {
    unsigned char* ws = a.ws;
    pg8::Gemm g{(const bf16_t*)(ws + (L1 ? slot(3) : slot(0))), (const bf16_t*)(ws + (L1 ? WS_WO : WS_WOUT)), opaque(MTOK), opaque(DM), opaque(DM)};
    pg8::StaticOrder S; S.init(g.M, g.N, (int)gridDim.x, (int)blockIdx.x);
    EpiKVQ E{(bf16_t*)(ws + (L1 ? slot(4) : slot(1))), nullptr, nullptr};
    pg8::gemm_phase<EpiKVQ, pg8::StaticOrder>(lds, g, S, E, nullptr);
}
template <bool L1> __device__ __forceinline__ void run_ln(const Args& a) {
    unsigned char* ws = a.ws;
    phase_ln<L1>((const bf16_t*)(ws + (L1 ? slot(4) : slot(1))), L1 ? (const void*)(ws + slot(2)) : (const void*)a.in[0], a.in[12] + (L1 ? 2 : 0) * DM, a.in[13] + (L1 ? 2 : 0) * DM,
                 (float*)nullptr, (bf16_t*)(ws + (L1 ? slot(8) : slot(5))), (signed char*)(ws + WS_XQ), (float*)(ws + WS_XS));
}
template <bool L1> __device__ __forceinline__ void run_gemm_sc(const Args& a, LAS unsigned char* lds) {
    unsigned char* ws = a.ws;
    pg8::Gemm g{(const bf16_t*)(ws + WS_WC) + (L1 ? (size_t)DM * DM : 0), (const bf16_t*)(ws + (L1 ? slot(8) : slot(5))), opaque(DM), opaque(MTOK), opaque(DM)};
    pg8::StaticOrder S; S.init(g.M, g.N, (int)gridDim.x, (int)blockIdx.x);
    EpiF32 E{(float*)(ws + (L1 ? slot(0) : slot(6))), MTOK};
    pg8::gemm_phase<EpiF32, pg8::StaticOrder>(lds, g, S, E, nullptr);
}
template <bool L1> __device__ __forceinline__ void run_topk(const Args& a, LAS unsigned char* lds) {
    unsigned char* ws = a.ws;
    phase_topk(lds, (const float*)(ws + (L1 ? slot(0) : slot(6))), (int*)(ws + WS_EID), (float*)(ws + WS_GATE));
}
template <bool L1> __device__ __forceinline__ void run_peer(const Args& a, LAS unsigned char* lds) {
    unsigned char* ws = a.ws;
    LAS int* HL = (LAS int*)(lds + (threadIdx.x >> 6) * 8192);
    float* Y = (float*)(ws + (L1 ? slot(0) : slot(6)));
    phase_peer_u((const signed char*)(ws + WS_XQ), (const int*)(ws + WS_EID), ws + WS_UB + (L1 ? (size_t)16384 * DM : 0), HL);
    asm volatile("s_waitcnt vmcnt(0) lgkmcnt(0)" ::: "memory");
    phase_peer_w(HL, (const float*)(ws + WS_XS), (const int*)(ws + WS_EID), (const float*)(ws + WS_GATE),
                 (const float*)(ws + WS_USC) + (L1 ? 16384 : 0), (const float*)(ws + WS_VSC) + (L1 ? 16384 : 0), (float*)(ws + WS_W), (float*)(ws + WS_CS));
    asm volatile("s_waitcnt vmcnt(0)" ::: "memory");
    phase_peer_v((const bf16_t*)(ws + (L1 ? slot(8) : slot(5))), (const int*)(ws + WS_EID), (const float*)(ws + WS_W), (const float*)(ws + WS_CS),
                 ws + WS_VB + (L1 ? (size_t)16384 * DM : 0), Y);
    asm volatile("s_waitcnt vmcnt(0)" ::: "memory");
    {
        const int lane = threadIdx.x & 63, gw = blockIdx.x * 8 + (threadIdx.x >> 6), nw = gridDim.x * 8, tpw = (MTOK + nw - 1) / nw, tbase = gw * tpw;
        const int tend = tbase + tpw < MTOK ? tbase + tpw : MTOK;
        const float* g = a.in[12] + (L1 ? 3 : 1) * DM; const float* bta = a.in[13] + (L1 ? 3 : 1) * DM;
        float* outf = L1 ? a.out : (float*)nullptr; bf16_t* outb = L1 ? (bf16_t*)nullptr : (bf16_t*)(ws + slot(2));
        for (int row = tbase; row < tend; ++row) {
            float v[32];
            const float* p = Y + (size_t)row * DM;
#pragma unroll
            for (int i = 0; i < 4; ++i) {
                const f32x4 x0 = *(const f32x4*)(p + 512 * i + 8 * lane), x1 = *(const f32x4*)(p + 512 * i + 8 * lane + 4);
#pragma unroll
                for (int j = 0; j < 4; ++j) { v[i * 8 + j] = x0[j]; v[i * 8 + 4 + j] = x1[j]; }
            }
            ln_row_store(v, g, bta, outf ? outf + (size_t)row * DM : nullptr, outb ? outb + (size_t)row * DM : nullptr, lane);
        }
    }
}


#define XB_TMO      128
#define XB_XCNT(j)  (256  + 64 * (j))
#define XB_XSUB(j)  (1280 + 64 * (j))
#define XB_XGEN(j)  (2304 + 64 * (j))
#define XB_TOP      3328
#define XB_TOPGEN   3392
#define XCD_BAR_WORDS 3456
#define XB_SPIN_CAP (1u << 20)
__device__ __forceinline__ unsigned xb_ld(unsigned* p)              { return __hip_atomic_load(p, __ATOMIC_RELAXED, __HIP_MEMORY_SCOPE_AGENT); }
__device__ __forceinline__ unsigned xb_add(unsigned* p, unsigned v) { return __hip_atomic_fetch_add(p, v, __ATOMIC_RELAXED, __HIP_MEMORY_SCOPE_AGENT); }
__device__ __forceinline__ unsigned xb_xcc_id() { return (unsigned)__builtin_amdgcn_s_getreg((3 << 11) | 20) & 0xFu; }
#define XB_SPIN(cond, bar) do { unsigned _sp = 0; while (cond) { __builtin_amdgcn_s_sleep(1); \
    if ((++_sp & 255u) == 0u) { if (xb_ld(&(bar)[XB_TMO])) break; if (_sp > XB_SPIN_CAP) { atomicAdd(&(bar)[XB_TMO], 1u); break; } } } } while (0)
struct XcdBarrier { unsigned* bar; unsigned x; volatile LAS unsigned* st; };
__device__ __forceinline__ XcdBarrier xcd_barrier_post(unsigned* bar, volatile LAS unsigned* st) {
    XcdBarrier b; b.bar = bar; b.x = xb_xcc_id(); b.st = st;
    if (threadIdx.x == 0) (void)xb_add(&bar[XB_XCNT(b.x)], 1u);
    return b;
}
__device__ __forceinline__ void xcd_barrier_complete(unsigned* bar, unsigned x, unsigned& nloc, unsigned& nx) {
    const unsigned G = gridDim.x * gridDim.y * gridDim.z;
    unsigned sum, cnt, mine, sp = 0u;
    for (;;) {
        sum = 0u; cnt = 0u; mine = 0u;
#pragma unroll
        for (unsigned j = 0; j < 16; ++j) { const unsigned c = xb_ld(&bar[XB_XCNT(j)]); sum += c; cnt += (c > 0u) ? 1u : 0u; mine = (j == x) ? c : mine; }
        if (sum == G) break;
        __builtin_amdgcn_s_sleep(1);
        if ((++sp & 255u) == 0u) { if (xb_ld(&bar[XB_TMO])) break; if (sp > XB_SPIN_CAP) { atomicAdd(&bar[XB_TMO], 1u); break; } }
    }
    nloc = mine > 0u ? mine : 1u; nx = cnt > 0u ? cnt : 1u;
}
__device__ __forceinline__ void xcd_barrier(const XcdBarrier& b) {
    asm volatile("s_waitcnt vmcnt(0)" ::: "memory");
    __syncthreads();
    if (threadIdx.x == 0) {
        unsigned* bar = b.bar;
        __builtin_amdgcn_s_waitcnt(0);
        unsigned nloc = b.st[0], nx = b.st[1];
        if (nloc == 0u) { xcd_barrier_complete(bar, b.x, nloc, nx); b.st[0] = nloc; b.st[1] = nx; }
        const unsigned old = xb_add(&bar[XB_XSUB(b.x)], 1u);
        const unsigned gen = old / nloc;
        if (old + 1u == (gen + 1u) * nloc) {
            __builtin_amdgcn_fence(__ATOMIC_RELEASE, "agent");
            asm volatile("s_waitcnt vmcnt(0)" ::: "memory");
            const unsigned og = xb_add(&bar[XB_TOP], 1u);
            const unsigned tg = og / nx;
            if (og + 1u == (tg + 1u) * nx) xb_add(&bar[XB_TOPGEN], 1u);
            else XB_SPIN(xb_ld(&bar[XB_TOPGEN]) == tg, bar);
            __builtin_amdgcn_fence(__ATOMIC_ACQUIRE, "agent");
            xb_add(&bar[XB_XGEN(b.x)], 1u);
            asm volatile("s_waitcnt vmcnt(0)" ::: "memory");
        } else {
            XB_SPIN(xb_ld(&bar[XB_XGEN(b.x)]) == gen, bar);
            __builtin_amdgcn_fence(__ATOMIC_ACQUIRE, "agent");
            asm volatile("s_waitcnt vmcnt(0)" ::: "memory");
        }
    }
    __syncthreads();
}

__global__ void __launch_bounds__(512, 2) mk_fwd(Args a) {
    extern __shared__ __attribute__((aligned(16))) unsigned char lds_raw[];
    LAS unsigned char* lds = (LAS unsigned char*)lds_raw;
    cg::grid_group grid = cg::this_grid();
    unsigned char* ws = a.ws;
#define PHASE_BEGIN(k) if (a.ph_lo <= (k) && (k) < a.ph_hi && EN(k)) {
    volatile LAS unsigned* xb_st = (volatile LAS unsigned*)(lds + LDS_BYTES - 16);
    if (threadIdx.x < 4) xb_st[threadIdx.x] = 0u;
    unsigned* xb_words = (unsigned*)(ws + WS_BAR);
    __syncthreads();
    XcdBarrier xbar = xcd_barrier_post(xb_words, xb_st);
    if (a.ph_lo < 0) grid.sync();
#define PHASE_END(k) if ((k) + 1 < a.ph_hi) xcd_barrier(xbar); }
    PHASE_BEGIN(0) phase_prep(a, lds);
#if SCAN_DBG == 3 || SCAN_DBG == 5
        if (blockIdx.x == 0 && threadIdx.x < 8) ((unsigned*)(ws + WS_CTR + 8192))[threadIdx.x] = 0u;
#endif
#if SCAN_DBG == 7
        if (blockIdx.x == 0 && threadIdx.x < 32) ((float*)(ws + WS_CTR + 4096))[threadIdx.x] = 0.f;
#endif
    PHASE_END(0)
#if SCAN_DBG == 5
    PHASE_BEGIN(1) dbg_lds16_test(lds, (unsigned*)(ws + WS_CTR + 8192)); PHASE_END(1)
#define SKIP_REST 1
#endif
    PHASE_BEGIN(1) {
        pg8::Gemm g{(const bf16_t*)(ws + slot(0)), (const bf16_t*)(ws + WS_WIN), opaque(MTOK), opaque(4 * DM), opaque(DM)};
        pg8::StaticOrder S; S.init(g.M, g.N, (int)gridDim.x, (int)blockIdx.x);
        EpiKVQ E{(bf16_t*)(ws + slot(1)), (bf16_t*)(ws + slot(2)), (bf16_t*)(ws + slot(3))};
        pg8::gemm_phase<EpiKVQ, pg8::StaticOrder>(lds, g, S, E, nullptr);
    } PHASE_END(1)
    PHASE_BEGIN(2) phase_scan_a(lds, (const bf16_t*)(ws + slot(2)), (const float*)(ws + WS_LB), (const bf16_t*)(ws + slot(3)), (bf16_t*)(ws + slot(6)), (float*)(ws + WS_DEC), QuantJob{a.in[10], a.in[11], ws + WS_UB, ws + WS_VB, (float*)(ws + WS_USC), (float*)(ws + WS_VSC)}
#if SCAN_DBG == 3
        , (unsigned*)(ws + WS_CTR + 8192)
#endif
        );
#if SCAN_DBG == 7
        asm volatile("s_waitcnt vmcnt(0)" ::: "memory"); __syncthreads(); grid.sync(); if (threadIdx.x < 64) { __builtin_amdgcn_fence(__ATOMIC_ACQUIRE, "agent"); asm volatile("s_waitcnt vmcnt(0)" ::: "memory"); } __syncthreads();
        dbg_check_a7((const float*)(ws + slot(4)), (const bf16_t*)(ws + slot(2)), (const bf16_t*)(ws + slot(6)), (float*)(ws + WS_CTR + 4096));
#endif
#if SCAN_DBG == 6
#define DSYNC6() asm volatile("s_waitcnt vmcnt(0)" ::: "memory"); __syncthreads(); grid.sync(); if (threadIdx.x < 64) { __builtin_amdgcn_fence(__ATOMIC_ACQUIRE, "agent"); asm volatile("s_waitcnt vmcnt(0)" ::: "memory"); } __syncthreads();
        DSYNC6()
        phase_scan_a(lds, (const bf16_t*)(ws + slot(2)), (const float*)(ws + WS_LB), (const bf16_t*)(ws + slot(3)), (bf16_t*)a.out, (float*)(ws + WS_DEC), QuantJob{a.in[10], a.in[11], ws + WS_UB, ws + WS_VB, (float*)(ws + WS_USC), (float*)(ws + WS_VSC)});
        DSYNC6()
        dbg_check_a((LAS float*)lds, (const float*)(ws + slot(4)), (const bf16_t*)(ws + slot(2)), (const bf16_t*)(ws + slot(6)), (const bf16_t*)a.out, (float*)(ws + WS_CTR + 4096));
#endif
#if SCAN_DBG == 3
        asm volatile("s_waitcnt vmcnt(0)" ::: "memory"); __syncthreads(); grid.sync();
        dbg_count_bf16((const bf16_t*)(ws + slot(6)), (size_t)4096 * 16384, (unsigned*)(ws + WS_CTR + 8192) + 2);
#endif
    PHASE_END(2)
    PHASE_BEGIN(3) phase_scan_b((bf16_t*)(ws + slot(6)), (const float*)(ws + WS_DEC), QuantJob{a.in[10] + (size_t)16384 * DM, a.in[11] + (size_t)16384 * DM, ws + WS_UB + (size_t)16384 * DM, ws + WS_VB + (size_t)16384 * DM, (float*)(ws + WS_USC) + 16384, (float*)(ws + WS_VSC) + 16384});
#if SCAN_DBG == 3
        asm volatile("s_waitcnt vmcnt(0)" ::: "memory"); __syncthreads(); grid.sync();

#endif
    PHASE_END(3)
    PHASE_BEGIN(4) phase_scan_c(lds, (const bf16_t*)(ws + slot(1)), (const bf16_t*)(ws + slot(2)), (const float*)(ws + WS_LB), (const bf16_t*)(ws + slot(3)), (const bf16_t*)(ws + slot(4)), (const bf16_t*)(ws + slot(6)), a.in[2], (bf16_t*)(ws + slot(0)));
#if SCAN_DBG == 1
        asm volatile("s_waitcnt vmcnt(0)" ::: "memory"); __syncthreads(); grid.sync();
        phase_scan_naive((const bf16_t*)(ws + slot(1)), (const float*)(ws + slot(4)), (const bf16_t*)(ws + slot(2)), (float*)(ws + slot(6)));
        asm volatile("s_waitcnt vmcnt(0)" ::: "memory"); __syncthreads(); grid.sync();
        phase_onorm((const float*)(ws + slot(6)), (const bf16_t*)(ws + slot(3)), a.in[2], (bf16_t*)(ws + slot(0)));
#endif
#if SCAN_DBG == 3
        asm volatile("s_waitcnt vmcnt(0)" ::: "memory"); __syncthreads(); grid.sync();

#endif
#if SCAN_DBG == 4
#define DSYNC() asm volatile("s_waitcnt vmcnt(0)" ::: "memory"); __syncthreads(); grid.sync(); if (threadIdx.x < 64) { __builtin_amdgcn_fence(__ATOMIC_ACQUIRE, "agent"); asm volatile("s_waitcnt vmcnt(0)" ::: "memory"); } __syncthreads();
        DSYNC()
        phase_scan_naive((const bf16_t*)(ws + slot(1)), (const float*)(ws + slot(4)), (const bf16_t*)(ws + slot(2)), (float*)(ws + slot(6)));
        DSYNC()
        phase_onorm((const float*)(ws + slot(6)), (const bf16_t*)(ws + slot(3)), a.in[2], (bf16_t*)(ws + slot(8)));
        DSYNC()
        phase_scan_a(lds, (const bf16_t*)(ws + slot(2)), (const float*)(ws + WS_LB), (const bf16_t*)(ws + slot(3)), (bf16_t*)(ws + slot(6)), (float*)(ws + WS_DEC), QuantJob{a.in[10], a.in[11], ws + WS_UB, ws + WS_VB, (float*)(ws + WS_USC), (float*)(ws + WS_VSC)});
        DSYNC()
        phase_scan_b((bf16_t*)(ws + slot(6)), (const float*)(ws + WS_DEC), QuantJob{a.in[10] + (size_t)16384 * DM, a.in[11] + (size_t)16384 * DM, ws + WS_UB + (size_t)16384 * DM, ws + WS_VB + (size_t)16384 * DM, (float*)(ws + WS_USC) + 16384, (float*)(ws + WS_VSC) + 16384});
        DSYNC()
        phase_scan_c(lds, (const bf16_t*)(ws + slot(1)), (const bf16_t*)(ws + slot(2)), (const float*)(ws + WS_LB), (const bf16_t*)(ws + slot(3)), (const bf16_t*)(ws + slot(4)), (const bf16_t*)(ws + slot(6)), a.in[2], (bf16_t*)a.out);
        DSYNC()
        dbg_compare4((LAS float*)lds, (const bf16_t*)(ws + slot(0)), (const bf16_t*)(ws + slot(8)), (const bf16_t*)a.out, (float*)(ws + WS_CTR + 4096));
#endif
#if SCAN_DBG == 2
        asm volatile("s_waitcnt vmcnt(0)" ::: "memory"); __syncthreads(); grid.sync();
        phase_scan_naive((const bf16_t*)(ws + slot(1)), (const float*)(ws + slot(4)), (const bf16_t*)(ws + slot(2)), (float*)(ws + slot(6)));
        asm volatile("s_waitcnt vmcnt(0)" ::: "memory"); __syncthreads(); grid.sync();
        phase_onorm((const float*)(ws + slot(6)), (const bf16_t*)(ws + slot(3)), a.in[2], (bf16_t*)(ws + slot(8)));
        asm volatile("s_waitcnt vmcnt(0)" ::: "memory"); __syncthreads(); grid.sync();
        dbg_compare((LAS float*)lds, (const bf16_t*)(ws + slot(0)), (const bf16_t*)(ws + slot(8)), (float*)(ws + WS_CTR + 4096));
#endif
    PHASE_END(4)
    PHASE_BEGIN(5) run_gemm_out<false>(a, lds); PHASE_END(5)
    PHASE_BEGIN(6) run_ln<false>(a); PHASE_END(6)
    PHASE_BEGIN(7) run_gemm_sc<false>(a, lds); PHASE_END(7)
    PHASE_BEGIN(8) run_topk<false>(a, lds); PHASE_END(8)
    PHASE_BEGIN(9) run_peer<false>(a, lds); PHASE_END(9)
    PHASE_BEGIN(10) {
        pg8::Gemm g{(const bf16_t*)(ws + slot(2)), (const bf16_t*)(ws + WS_WKVQ), opaque(MTOK), opaque(3 * DM), opaque(DM)};
        pg8::StaticOrder S; S.init(g.M, g.N, (int)gridDim.x, (int)blockIdx.x);
        EpiKVQR E{(bf16_t*)(ws + slot(3)), (const float*)(ws + WS_COS), (const float*)(ws + WS_SIN)};
        pg8::gemm_phase<EpiKVQR, pg8::StaticOrder>(lds, g, S, E, nullptr);
    } PHASE_END(10)
    PHASE_BEGIN(11) phase_kstat((LAS float*)lds, (const bf16_t*)(ws + slot(3)), (float*)(ws + WS_KMEAN), (float*)(ws + WS_KNMAX)); PHASE_END(11)
    PHASE_BEGIN(12) phase_sel(lds, (const bf16_t*)(ws + slot(5)), (const float*)(ws + WS_KMEAN), (unsigned short*)(ws + WS_SUB), (int*)(ws + WS_CNT), (int*)(ws + WS_CTR)); PHASE_END(12)
    PHASE_BEGIN(13) phase_att(lds, (const bf16_t*)(ws + slot(5)), (const bf16_t*)(ws + slot(3)), (const bf16_t*)(ws + slot(4)), (const float*)(ws + WS_KNMAX), (const unsigned short*)(ws + WS_SUB),
                              (const int*)(ws + WS_CNT), (int*)(ws + WS_CTR), (bf16_t*)(ws + slot(6)), (bf16_t*)(ws + slot(0)), (float*)(ws + WS_LS)); PHASE_END(13)
    PHASE_BEGIN(14) phase_comb((const bf16_t*)(ws + slot(6)), (const bf16_t*)(ws + slot(0)), (const float*)(ws + WS_LS), (bf16_t*)(ws + slot(3))); PHASE_END(14)
    PHASE_BEGIN(15) run_gemm_out<true>(a, lds); PHASE_END(15)
    PHASE_BEGIN(16) run_ln<true>(a); PHASE_END(16)
    PHASE_BEGIN(17) run_gemm_sc<true>(a, lds); PHASE_END(17)
    PHASE_BEGIN(18) run_topk<true>(a, lds); PHASE_END(18)
#if SCAN_DBG == 7
    PHASE_BEGIN(19) dbg_emit7((const float*)(ws + WS_CTR + 4096), a.out); PHASE_END(19)
#elif SCAN_DBG == 6
    PHASE_BEGIN(19) dbg_emit4((const float*)(ws + WS_CTR + 4096), a.out); PHASE_END(19)
#elif SCAN_DBG == 5
    PHASE_BEGIN(19) dbg_emit5((const unsigned*)(ws + WS_CTR + 8192), a.out); PHASE_END(19)
#elif SCAN_DBG == 4
    PHASE_BEGIN(19) dbg_emit4((const float*)(ws + WS_CTR + 4096), a.out); PHASE_END(19)
#elif SCAN_DBG == 3
    PHASE_BEGIN(19) dbg_emit3((const unsigned*)(ws + WS_CTR + 8192), a.out); PHASE_END(19)
#elif SCAN_DBG == 2
    PHASE_BEGIN(19) dbg_emit((const float*)(ws + WS_CTR + 4096), a.out); PHASE_END(19)
#else
    PHASE_BEGIN(19) run_peer<true>(a, lds); PHASE_END(19)
#endif
}

extern "C" void kernel_launch(void* const* d_in, const int* in_sizes, int n_in, void* d_out, int out_size, void* d_ws, size_t ws_size, hipStream_t stream) {
    static int grid = 0;
    if (grid == 0) {
        if (n_in != 14 || out_size != MTOK * DM || ws_size < WS_END) { fprintf(stderr, "kernel_launch: unexpected shapes (n_in %d, out %d, ws %zu)\n", n_in, out_size, ws_size); grid = -1; return; }
        int dev = 0, cus = 0, per_cu = 0;
        if (hipGetDevice(&dev) != hipSuccess || hipDeviceGetAttribute(&cus, hipDeviceAttributeMultiprocessorCount, dev) != hipSuccess) { grid = -1; return; }
        if (hipFuncSetAttribute((const void*)mk_fwd, hipFuncAttributeMaxDynamicSharedMemorySize, LDS_BYTES) != hipSuccess) { fprintf(stderr, "kernel_launch: hipFuncSetAttribute failed\n"); grid = -1; return; }
        if (hipOccupancyMaxActiveBlocksPerMultiprocessor(&per_cu, (const void*)mk_fwd, 512, LDS_BYTES) != hipSuccess || per_cu < 1) { fprintf(stderr, "kernel_launch: occupancy query failed (%d)\n", per_cu); (void)hipGetLastError(); per_cu = 1; }
        grid = cus * (per_cu > 1 ? 1 : per_cu);
    }
    if (grid < 0) return;
    Args a{};
    for (int i = 0; i < 14; ++i) a.in[i] = (const float*)d_in[i];
    a.out = (float*)d_out; a.ws = (unsigned char*)d_ws;
#if ONE_LAUNCH
    a.ph_lo = 0; a.ph_hi = NPH;
    (void)hipMemsetAsync((unsigned char*)d_ws + WS_BAR, 0, XCD_BAR_WORDS * sizeof(unsigned), stream);
    void* args[] = {&a};
    hipError_t e = hipLaunchCooperativeKernel((const void*)mk_fwd, dim3(grid), dim3(512), args, LDS_BYTES, stream);
    if (e != hipSuccess) fprintf(stderr, "cooperative launch failed: %s (grid %d)\n", hipGetErrorString(e), grid);
#else
    for (int ph = 0; ph < NPH; ++ph) {
        a.ph_lo = ph; a.ph_hi = ph + 1;
        hipLaunchKernelGGL(mk_fwd, dim3(grid), dim3(512), LDS_BYTES, stream, a);
    }
#endif
}
```

```cpp
#define ONE_LAUNCH 1
#include <hip/hip_runtime.h>
#include <hip/hip_cooperative_groups.h>
#include <cstdio>
namespace cg = cooperative_groups;

#ifndef ONE_LAUNCH
#define ONE_LAUNCH 0
#endif
#ifndef SCAN_DBG
#define SCAN_DBG 0
#endif
#ifndef SCAN_A_VALU
#define SCAN_A_VALU 0
#endif
#ifndef ENMASK
#define ENMASK 0xffffffffu
#endif
#define EN(k) ((ENMASK >> (k)) & 1u)

namespace pg8 {
#define PG8_LAS __attribute__((address_space(3)))
typedef unsigned short bf16_t;
typedef short bf16x8 __attribute__((ext_vector_type(8)));
typedef float f32x4 __attribute__((ext_vector_type(4)));
typedef unsigned u32x4 __attribute__((ext_vector_type(4)));
constexpr int BM = 256, BK = 64, HALF = 128, HTB = HALF * BK * 2  , STAGE_BYTES = 8 * HTB, NXCD = 8, WGM = 8;

__host__ __device__ __forceinline__ int lds_byte(int r, int c) { const int st = (r >> 4) * 2 + (c >> 5), rr = r & 15, cc = c & 31, ob = rr * 64 + cc * 2; return st * 1024 + (ob ^ (((ob >> 9) & 1) << 5)); }
__host__ __device__ __forceinline__ void stage_rc(int b, int& R, int& C) { const int st = b / 1024, sb = b % 1024, swz = sb ^ (((sb >> 9) & 1) << 5); R = (st >> 1) * 16 + swz / 64; C = (st & 1) * 32 + (swz % 64) / 2; }
__host__ __device__ __forceinline__ int perm32(int rho) { const int n = rho >> 4, i = rho & 15; return 8 * (i >> 2) + 4 * n + (i & 3); }

struct Unit { int pm, pn; };
struct Gemm { const bf16_t* A; const bf16_t* Bt; int M, N, K; };

struct StaticOrder {
    int nM, nN, nwg, G, c;
    __host__ __device__ void init(int M, int N, int G_, int c_) { nM = M / BM; nN = N / BM; nwg = nM * nN; G = G_; c = c_; }
    __host__ __device__ bool next(int i, Unit& u) const {
        const long L = (long)i * G + c; if (L >= nwg) return false;
        int wgid = (int)L; { const int q = nwg / NXCD, r = nwg % NXCD, xcd = wgid % NXCD, off = wgid / NXCD; wgid = (xcd < r ? xcd * (q + 1) : r * (q + 1) + (xcd - r) * q) + off; }
        const int nig = WGM * nN, gid = wgid / nig, fm = gid * WGM, gsz = (nM - fm) < WGM ? (nM - fm) : WGM;
        u.pm = fm + ((wgid % nig) % gsz); u.pn = (wgid % nig) / gsz; return true;
    }
    __device__ __forceinline__ void a_ready(const Unit&) const {}
    __device__ __forceinline__ void done(const Unit&) const {}
};
struct CountedOrder : StaticOrder {
    const unsigned* ready; unsigned need; unsigned* tmo;
    __device__ __forceinline__ void a_ready(const Unit& u) const {
        if (threadIdx.x < 64) {
            const unsigned long long t0 = __builtin_amdgcn_s_memrealtime(); unsigned polls = 0;
            while ((unsigned)__builtin_amdgcn_readfirstlane(__hip_atomic_load(ready + 64 * u.pm, __ATOMIC_RELAXED, __HIP_MEMORY_SCOPE_AGENT)) < need) {
                if ((++polls & 255u) == 0u && __builtin_amdgcn_readfirstlane(__hip_atomic_load(tmo, __ATOMIC_RELAXED, __HIP_MEMORY_SCOPE_AGENT)) != 0u) break;
                if (__builtin_amdgcn_s_memrealtime() - t0 > 2000000ull) {
                    if (threadIdx.x == 0) { unsigned expect = 0u; __hip_atomic_compare_exchange_strong(tmo + 1, &expect, 0x600u | (unsigned)(u.pm & 0xff), __ATOMIC_RELAXED, __ATOMIC_RELAXED, __HIP_MEMORY_SCOPE_AGENT); __hip_atomic_store(tmo, 1u, __ATOMIC_RELAXED, __HIP_MEMORY_SCOPE_AGENT); }
                    break; }
                __builtin_amdgcn_s_sleep(2); }
            __builtin_amdgcn_fence(__ATOMIC_ACQUIRE, "agent");
            asm volatile("s_waitcnt vmcnt(0)" ::: "memory");
        }
#if !defined(BROKEN_HOOK_NO_BARRIER)
        asm volatile("" ::: "memory"); __builtin_amdgcn_s_barrier(); asm volatile("" ::: "memory");
#endif
    }
};

__device__ __forceinline__ unsigned cvt_pk_bf16(float lo, float hi) { unsigned r; asm volatile("v_cvt_pk_bf16_f32 %0, %1, %2" : "=v"(r) : "v"(lo), "v"(hi)); return r; }
typedef float f32x2 __attribute__((ext_vector_type(2)));
__device__ __forceinline__ f32x2 gelu_pk(f32x2 v) {
    const f32x2 av = __builtin_elementwise_abs(v), d = av * 0.2316418882f + 1.0f;
    f32x2 t; t.x = __builtin_amdgcn_rcpf(d.x); t.y = __builtin_amdgcn_rcpf(d.y);
    f32x2 q = t * 0.5307027145f + (-0.7265760135f); q = q * t + 0.7107068705f; q = q * t + (-0.142248368f); q = q * t + 0.127414796f; q = q * t;
    const f32x2 s = (v * v) * (-0.72134752044f);
    f32x2 e; e.x = __builtin_amdgcn_exp2f(s.x); e.y = __builtin_amdgcn_exp2f(s.y);
    const f32x2 m = v * (q * e), r = v - m;
    f32x2 o; o.x = v.x < 0.f ? m.x : r.x; o.y = v.y < 0.f ? m.y : r.y; return o;
}

struct EpiF32 {
    static constexpr bool PERM = false, AFTER_DRAIN = false;
    float* C; int ldc; const float* bias;
    __device__ __forceinline__ void operator()(const f32x4 (&acc)[2][2][4][2], const Unit& u, int wr, int wc, int fr, int fq) const {
        const int row0 = u.pm * BM + wr * 64 + fr, col0 = u.pn * BM + wc * 32 + 4 * fq;
        f32x4 bv[2][2];
#pragma unroll
        for (int bj = 0; bj < 2; ++bj)
#pragma unroll
            for (int n = 0; n < 2; ++n) bv[bj][n] = bias ? *(const f32x4*)(bias + col0 + bj * HALF + n * 16) : (f32x4){0.f, 0.f, 0.f, 0.f};
#pragma unroll
        for (int ai = 0; ai < 2; ++ai)
#pragma unroll
            for (int m = 0; m < 4; ++m) { float* rowp = C + (size_t)(row0 + ai * HALF + m * 16) * ldc + col0;
#pragma unroll
                for (int bj = 0; bj < 2; ++bj)
#pragma unroll
                    for (int n = 0; n < 2; ++n) *(f32x4*)(rowp + bj * HALF + n * 16) = acc[ai][bj][m][n] + bv[bj][n]; }
    }
};
template <int ACT  > struct EpiBf16 {
    static constexpr bool PERM = true, AFTER_DRAIN = false;
    bf16_t* O; int ldc; const float* bias; int split_cols; size_t split_stride;
    __device__ __forceinline__ void operator()(const f32x4 (&acc)[2][2][4][2], const Unit& u, int wr, int wc, int fr, int fq) const {
        const int row0 = u.pm * BM + wr * 64 + fr; int colt = u.pn * BM; bf16_t* base = O;
        if (split_cols) { const int t = colt / split_cols; base += (size_t)t * split_stride; colt -= t * split_cols; }
        const int col0 = colt + wc * 32 + 8 * fq, bcol0 = u.pn * BM + wc * 32 + 8 * fq;
        f32x4 bv[2][2];
#pragma unroll
        for (int bj = 0; bj < 2; ++bj)
#pragma unroll
            for (int n = 0; n < 2; ++n) bv[bj][n] = bias ? *(const f32x4*)(bias + bcol0 + bj * HALF + 4 * n) : (f32x4){0.f, 0.f, 0.f, 0.f};
#pragma unroll
        for (int ai = 0; ai < 2; ++ai)
#pragma unroll
            for (int m = 0; m < 4; ++m) { bf16_t* rowp = base + (size_t)(row0 + ai * HALF + m * 16) * ldc + col0;
#pragma unroll
                for (int bj = 0; bj < 2; ++bj) { f32x4 v0 = acc[ai][bj][m][0] + bv[bj][0], v1 = acc[ai][bj][m][1] + bv[bj][1];
                    if (ACT == 1) { f32x2 a = gelu_pk((f32x2){v0[0], v0[1]}), b = gelu_pk((f32x2){v0[2], v0[3]}), c = gelu_pk((f32x2){v1[0], v1[1]}), d = gelu_pk((f32x2){v1[2], v1[3]});
                        v0 = (f32x4){a.x, a.y, b.x, b.y}; v1 = (f32x4){c.x, c.y, d.x, d.y}; }
                    if (ACT == 2) {
#pragma unroll
                        for (int j = 0; j < 4; ++j) { v0[j] = 0.5f * v0[j] * (1.0f + erff(v0[j] * 0.70710678f)); v1[j] = 0.5f * v1[j] * (1.0f + erff(v1[j] * 0.70710678f)); } }
                    u32x4 w; w.x = cvt_pk_bf16(v0[0], v0[1]); w.y = cvt_pk_bf16(v0[2], v0[3]); w.z = cvt_pk_bf16(v1[0], v1[1]); w.w = cvt_pk_bf16(v1[2], v1[3]);
                    *(u32x4*)(rowp + bj * HALF) = w; } }
    }
};

template <class Epi, class Sched, bool STAMP = false>
__device__ __forceinline__ void gemm_phase(PG8_LAS unsigned char* lds, const Gemm g, const Sched& S, const Epi& E, unsigned long long* stamps) {
    const int tid = threadIdx.x, wid = __builtin_amdgcn_readfirstlane(tid >> 6), lane = tid & 63, wr = wid >> 2, wc = wid & 3, fr = lane & 15, fq = lane >> 4;
    const int K = g.K, nt = K / BK;
    int ts_lo = 0, ts_hi = 0, nts = 0; const unsigned long long rt_entry = STAMP ? (unsigned long long)wall_clock64() : 0ull;
#define PG8_STAMP() do { if (STAMP && wid == 0 && nts < 64) { const unsigned long long _c = (unsigned long long)clock64(); \
        ts_lo = (lane == nts) ? (int)(unsigned)_c : ts_lo; ts_hi = (lane == nts) ? (int)(unsigned)(_c >> 32) : ts_hi; ++nts; } } while (0)
    PG8_STAMP();
    unsigned voffA[2], voffB[2];
#pragma unroll
    for (int i = 0; i < 2; ++i) { int R, C; stage_rc(tid * 16 + i * 8192, R, C); const int Rb = Epi::PERM ? ((R & ~31) + perm32(R & 31)) : R;
        voffA[i] = (unsigned)(R * K + C) * 2u; voffB[i] = (unsigned)(Rb * K + C) * 2u; }
    const size_t kstep = (size_t)(BK * 2);
    const size_t hstep = (size_t)HALF * K * 2;
    const size_t tstep = 2 * hstep;
    const unsigned ldsw = (unsigned)wid * 1024u;
    const int aoff = lds_byte(wr * 64 + fr, fq * 8), boff = lds_byte(wc * 32 + fr, fq * 8);
#define PG8_SA(b, h) (((b) * 2 + (h)) * HTB)
#define PG8_SB(b, h) ((4 + (b) * 2 + (h)) * HTB)
#define PG8_STAGE(bufoff, gbase, voff) do { _Pragma("unroll") for (int _i = 0; _i < 2; ++_i) \
        __builtin_amdgcn_global_load_lds((const unsigned*)((const char*)(gbase) + (voff)[_i]), (PG8_LAS unsigned*)(lds + (bufoff) + ldsw + _i * 8192), 16, 0, 0); } while (0)
#define PG8_LDA(dst, b, h) do { _Pragma("unroll") for (int m = 0; m < 4; ++m) _Pragma("unroll") for (int k = 0; k < 2; ++k) dst[m][k] = *(const PG8_LAS bf16x8*)(lds + PG8_SA(b, h) + aoff + m * 2048 + k * 1024); } while (0)
#define PG8_LDB(dst, b, h) do { _Pragma("unroll") for (int n = 0; n < 2; ++n) _Pragma("unroll") for (int k = 0; k < 2; ++k) dst[n][k] = *(const PG8_LAS bf16x8*)(lds + PG8_SB(b, h) + boff + n * 2048 + k * 1024); } while (0)
#define PG8_MMA(ai, bj, At, Bt) do { __builtin_amdgcn_s_setprio(1); _Pragma("unroll") for (int m = 0; m < 4; ++m) _Pragma("unroll") for (int n = 0; n < 2; ++n) _Pragma("unroll") for (int k = 0; k < 2; ++k) \
        acc[ai][bj][m][n] = __builtin_amdgcn_mfma_f32_16x16x32_bf16(Bt[n][k], At[m][k], acc[ai][bj][m][n], 0, 0, 0); __builtin_amdgcn_s_setprio(0); } while (0)
#define PG8_WAIT_V(n) asm volatile("s_waitcnt vmcnt(" #n ")" ::: "memory")
#define PG8_WAIT_L(n) asm volatile("s_waitcnt lgkmcnt(" #n ")" ::: "memory")
#define PG8_BAR __builtin_amdgcn_s_barrier()
#define PG8_SCHED __builtin_amdgcn_sched_barrier(0)
    Unit cur, nxt; int ui = 0;
    if (!S.next(0, cur)) return;
    f32x4 acc[2][2][4][2];
#pragma unroll
    for (int a = 0; a < 2; ++a)
#pragma unroll
        for (int b = 0; b < 2; ++b)
#pragma unroll
            for (int m = 0; m < 4; ++m)
#pragma unroll
                for (int n = 0; n < 2; ++n) acc[a][b][m][n] = (f32x4){0.f, 0.f, 0.f, 0.f};
    bf16x8 At[4][2], B0[2][2], B1[2][2];
    const char* cA = (const char*)g.A + (size_t)cur.pm * tstep; const char* cB = (const char*)g.Bt + (size_t)cur.pn * tstep;
    S.a_ready(cur);
    PG8_STAGE(PG8_SB(0, 0), cB, voffB); PG8_STAGE(PG8_SA(0, 0), cA, voffA); PG8_STAGE(PG8_SB(0, 1), cB + hstep, voffB); PG8_STAGE(PG8_SA(0, 1), cA + hstep, voffA);
    if (wr == 1) PG8_BAR;
    PG8_WAIT_V(4); PG8_BAR;
    PG8_STAGE(PG8_SB(1, 0), cB + kstep, voffB); PG8_STAGE(PG8_SA(1, 0), cA + kstep, voffA); PG8_STAGE(PG8_SB(1, 1), cB + hstep + kstep, voffB);
    PG8_WAIT_V(6); PG8_BAR;
    PG8_STAMP();
    for (;;) {
        const bool has_next = S.next(ui + 1, nxt);
        const char* nA = has_next ? (const char*)g.A + (size_t)nxt.pm * tstep : cA; const char* nB = has_next ? (const char*)g.Bt + (size_t)nxt.pn * tstep : cB;
        for (int t = 0; t < nt; t += 2) {
            const bool last = (t == nt - 2);
            const char* a1 = cA + (size_t)(t + 1) * kstep;
            const char* a2 = last ? nA : cA + (size_t)(t + 2) * kstep; const char* b2 = last ? nB : cB + (size_t)(t + 2) * kstep;
            const char* a3 = a2 + kstep; const char* b3 = b2 + kstep;
            if (last && has_next) S.a_ready(nxt);
            PG8_LDB(B0, 0, 0); PG8_SCHED; PG8_LDA(At, 0, 0); PG8_STAGE(PG8_SA(1, 1), a1 + hstep, voffA);
            PG8_WAIT_L(8); PG8_BAR; PG8_WAIT_L(0); PG8_MMA(0, 0, At, B0); PG8_BAR; PG8_SCHED;
            PG8_LDB(B1, 0, 1); PG8_STAGE(PG8_SB(0, 0), b2, voffB);
            PG8_BAR; PG8_WAIT_L(0); PG8_MMA(0, 1, At, B1); PG8_BAR;
            PG8_LDA(At, 0, 1); PG8_STAGE(PG8_SA(0, 0), a2, voffA);
            PG8_BAR; PG8_WAIT_L(0); PG8_MMA(1, 0, At, B0); PG8_BAR; PG8_SCHED;
            PG8_STAGE(PG8_SB(0, 1), b2 + hstep, voffB);
            PG8_WAIT_V(6); PG8_BAR; PG8_MMA(1, 1, At, B1); PG8_BAR;
            PG8_LDB(B0, 1, 0); PG8_SCHED; PG8_LDA(At, 1, 0); PG8_STAGE(PG8_SA(0, 1), a2 + hstep, voffA);
            PG8_WAIT_L(8); PG8_BAR; PG8_WAIT_L(0); PG8_MMA(0, 0, At, B0); PG8_BAR; PG8_SCHED;
            PG8_LDB(B1, 1, 1); PG8_STAGE(PG8_SB(1, 0), b3, voffB);
            PG8_BAR; PG8_WAIT_L(0); PG8_MMA(0, 1, At, B1); PG8_BAR;
            PG8_LDA(At, 1, 1); PG8_STAGE(PG8_SA(1, 0), a3, voffA);
            PG8_BAR; PG8_WAIT_L(0); PG8_MMA(1, 0, At, B0); PG8_BAR; PG8_SCHED;
            PG8_STAGE(PG8_SB(1, 1), b3 + hstep, voffB);
            PG8_WAIT_V(6); PG8_BAR; PG8_MMA(1, 1, At, B1); PG8_BAR;
        }
        PG8_STAMP();
        if constexpr (!Epi::AFTER_DRAIN) { E(acc, cur, wr, wc, fr, fq); S.done(cur); }
        PG8_STAMP();
        if (!has_next) break;
#pragma unroll
        for (int a = 0; a < 2; ++a)
#pragma unroll
            for (int b = 0; b < 2; ++b)
#pragma unroll
                for (int m = 0; m < 4; ++m)
#pragma unroll
                    for (int n = 0; n < 2; ++n) acc[a][b][m][n] = (f32x4){0.f, 0.f, 0.f, 0.f};
        cur = nxt; cA = nA; cB = nB; ++ui;
    }
    PG8_WAIT_V(0);
    if (wr == 0) PG8_BAR;
    PG8_BAR;
    if constexpr (Epi::AFTER_DRAIN) { E.fused(acc, cur, wr, wc, fr, fq, lds, wid, lane); S.done(cur); }
    PG8_STAMP();
    if (STAMP && wid == 0) { stamps[lane] = lane < nts ? (((unsigned long long)(unsigned)ts_hi << 32) | (unsigned)ts_lo) : 0ull;
        if (lane == 62) stamps[62] = rt_entry; if (lane == 63) stamps[63] = (unsigned long long)wall_clock64(); }
#undef PG8_STAMP
#undef PG8_SA
#undef PG8_SB
#undef PG8_STAGE
#undef PG8_LDA
#undef PG8_LDB
#undef PG8_MMA
#undef PG8_WAIT_V
#undef PG8_WAIT_L
#undef PG8_BAR
#undef PG8_SCHED
}
}


#define LAS __attribute__((address_space(3)))
typedef unsigned short bf16_t;
typedef float f32x4 __attribute__((ext_vector_type(4)));
typedef unsigned u32x4 __attribute__((ext_vector_type(4)));
typedef unsigned u32x2 __attribute__((ext_vector_type(2)));
typedef short bf16x8 __attribute__((ext_vector_type(8)));
typedef short s16x4 __attribute__((ext_vector_type(4)));
typedef float f32x16 __attribute__((ext_vector_type(16)));

constexpr int MTOK = 16384, DM = 2048, SEQ = 8192, NHEAD = 16;
constexpr float ALPHA = 1.41421356237309515f;
constexpr size_t MiB = (size_t)1 << 20;
constexpr size_t WS_WIN = 0, WS_WOUT = 32 * MiB, WS_WKVQ = 40 * MiB, WS_WO = 64 * MiB, WS_WC = 72 * MiB, WS_UB = 88 * MiB, WS_VB = 152 * MiB, WS_USC = 216 * MiB, WS_VSC = 217 * MiB, WS_H = 224 * MiB, WS_XQ = 232 * MiB, WS_XS = 264 * MiB, WS_W = 272 * MiB, WS_CS = 280 * MiB, WS_SLOT = 344 * MiB;
constexpr size_t WS_EID = 920 * MiB, WS_GATE = 928 * MiB, WS_COS = 936 * MiB, WS_SIN = 938 * MiB, WS_KMEAN = 940 * MiB, WS_LB = 941 * MiB, WS_LS = 942 * MiB, WS_SUB = 946 * MiB, WS_CNT = 962 * MiB, WS_CTR = 963 * MiB, WS_DEC = 964 * MiB, WS_END = 966 * MiB;
constexpr size_t WS_BAR = WS_CTR + 65536;
constexpr size_t WS_KNMAX = WS_KMEAN + 768 * 1024;
__host__ __device__ constexpr size_t slot(int i) { return WS_SLOT + (size_t)i * 64 * MiB; }
constexpr int LDS_BYTES = 144 * 1024;
constexpr int NPH = 20;

struct Args { const float* in[14]; float* out; unsigned char* ws; int ph_lo, ph_hi; };

__device__ __forceinline__ float bflo(unsigned w) { return __uint_as_float(w << 16); }
__device__ __forceinline__ float bfhi(unsigned w) { return __uint_as_float(w & 0xffff0000u); }
__device__ __forceinline__ float bf2f(bf16_t b) { return __uint_as_float(((unsigned)b) << 16); }
typedef __bf16 bf16x2_t __attribute__((ext_vector_type(2)));
typedef float f32x2_t __attribute__((ext_vector_type(2)));
__device__ __forceinline__ unsigned pk_bf16(float lo, float hi) { const f32x2_t f = {lo, hi}; return __builtin_bit_cast(unsigned, __builtin_convertvector(f, bf16x2_t)); }
__device__ __forceinline__ float wave_sum(float v) {
#pragma unroll
    for (int o = 32; o >= 1; o >>= 1) v += __shfl_xor(v, o);
    return v;
}
__device__ __forceinline__ float wave_max(float v) {
#pragma unroll
    for (int o = 32; o >= 1; o >>= 1) v = fmaxf(v, __shfl_xor(v, o));
    return v;
}
__device__ __forceinline__ float sigmoidf_(float z) { return 1.0f / (1.0f + __expf(-z)); }


__device__ __forceinline__ void store_wt16(void* p, u32x4 v) {
    __hip_atomic_store((unsigned long long*)p, ((unsigned long long)v.y << 32) | v.x, __ATOMIC_RELAXED, __HIP_MEMORY_SCOPE_AGENT);
    __hip_atomic_store((unsigned long long*)p + 1, ((unsigned long long)v.w << 32) | v.z, __ATOMIC_RELAXED, __HIP_MEMORY_SCOPE_AGENT);
}
__device__ __forceinline__ void store_wt8(void* p, u32x2 v) {
    __hip_atomic_store((unsigned long long*)p, ((unsigned long long)v.y << 32) | v.x, __ATOMIC_RELAXED, __HIP_MEMORY_SCOPE_AGENT);
}
struct EpiIn {
    static constexpr bool PERM = true, AFTER_DRAIN = false;
    bf16_t* Q1; float* LF; bf16_t* I1; bf16_t* G1; const float* LB;
    __device__ __forceinline__ void operator()(const pg8::f32x4 (&acc)[2][2][4][2], const pg8::Unit& u, int wr, int wc, int fr, int fq) const {
        const int type = u.pn >> 3;
        const int row0 = u.pm * 256 + wr * 64 + fr, col0 = (u.pn & 7) * 256 + wc * 32 + 8 * fq;
        if (type == 1) {
#pragma unroll
            for (int bj = 0; bj < 2; ++bj) {
                const int c = col0 + bj * 128;
                const f32x4 lb0 = *(const f32x4*)(LB + c), lb1 = *(const f32x4*)(LB + c + 4);
#pragma unroll
                for (int ai = 0; ai < 2; ++ai)
#pragma unroll
                    for (int m = 0; m < 4; ++m) {
                        float* p = LF + (size_t)(row0 + ai * 128 + m * 16) * DM + c;
                        f32x4 o0, o1;
#pragma unroll
                        for (int j = 0; j < 4; ++j) {
                            o0[j] = __logf(lb0[j] + (1.0f - lb0[j]) * sigmoidf_(acc[ai][bj][m][0][j]));
                            o1[j] = __logf(lb1[j] + (1.0f - lb1[j]) * sigmoidf_(acc[ai][bj][m][1][j]));
                        }
                        *(f32x4*)p = o0; *(f32x4*)(p + 4) = o1;
                    }
            }
        } else {
            bf16_t* dst = Q1 + (size_t)(type - (type > 0 ? 1 : 0)) * ((size_t)32 << 20);
            const bool act = (type != 2);
#pragma unroll
            for (int ai = 0; ai < 2; ++ai)
#pragma unroll
                for (int m = 0; m < 4; ++m)
#pragma unroll
                    for (int bj = 0; bj < 2; ++bj) {
                        f32x4 v0 = acc[ai][bj][m][0], v1 = acc[ai][bj][m][1];
                        if (act) {
#pragma unroll
                            for (int j = 0; j < 4; ++j) { v0[j] = v0[j] * sigmoidf_(v0[j]); v1[j] = v1[j] * sigmoidf_(v1[j]); }
                        }
                        u32x4 w; w.x = pk_bf16(v0[0], v0[1]); w.y = pk_bf16(v0[2], v0[3]); w.z = pk_bf16(v1[0], v1[1]); w.w = pk_bf16(v1[2], v1[3]);
                        *(u32x4*)(dst + (size_t)(row0 + ai * 128 + m * 16) * DM + col0 + bj * 128) = w;
                    }
        }
    }
};
struct EpiRes {
    static constexpr bool PERM = false, AFTER_DRAIN = false;
    const float* res; float* Y;
    __device__ __forceinline__ void operator()(const pg8::f32x4 (&acc)[2][2][4][2], const pg8::Unit& u, int wr, int wc, int fr, int fq) const {
        const int row0 = u.pm * 256 + wr * 64 + fr, col0 = u.pn * 256 + wc * 32 + 4 * fq;
#pragma unroll
        for (int ai = 0; ai < 2; ++ai)
#pragma unroll
            for (int m = 0; m < 4; ++m) {
                const size_t off = (size_t)(row0 + ai * 128 + m * 16) * DM + col0;
#pragma unroll
                for (int bj = 0; bj < 2; ++bj)
#pragma unroll
                    for (int n = 0; n < 2; ++n) {
                        const f32x4 r = *(const f32x4*)(res + off + bj * 128 + n * 16);
                        *(f32x4*)(Y + off + bj * 128 + n * 16) = r * ALPHA + acc[ai][bj][m][n];
                    }
            }
    }
};
struct EpiF32 {
    static constexpr bool PERM = false, AFTER_DRAIN = false;
    float* C; int ldc;
    __device__ __forceinline__ void operator()(const pg8::f32x4 (&acc)[2][2][4][2], const pg8::Unit& u, int wr, int wc, int fr, int fq) const {
        const int row0 = u.pm * 256 + wr * 64 + fr, col0 = u.pn * 256 + wc * 32 + 4 * fq;
#pragma unroll
        for (int ai = 0; ai < 2; ++ai)
#pragma unroll
            for (int m = 0; m < 4; ++m) {
                float* p = C + (size_t)(row0 + ai * 128 + m * 16) * ldc + col0;
#pragma unroll
                for (int bj = 0; bj < 2; ++bj)
#pragma unroll
                    for (int n = 0; n < 2; ++n) *(f32x4*)(p + bj * 128 + n * 16) = acc[ai][bj][m][n];
            }
    }
};
struct EpiKVQ {
    static constexpr bool PERM = true, AFTER_DRAIN = false;
    bf16_t* K; bf16_t* V; bf16_t* Q;
    __device__ __forceinline__ void operator()(const pg8::f32x4 (&acc)[2][2][4][2], const pg8::Unit& u, int wr, int wc, int fr, int fq) const {
        const int t = u.pn >> 3;
        bf16_t* dst = K + (size_t)t * ((size_t)32 << 20);
        const int row0 = u.pm * 256 + wr * 64 + fr, col0 = (u.pn & 7) * 256 + wc * 32 + 8 * fq;
#pragma unroll
        for (int ai = 0; ai < 2; ++ai)
#pragma unroll
            for (int m = 0; m < 4; ++m)
#pragma unroll
                for (int bj = 0; bj < 2; ++bj) {
                    const f32x4 v0 = acc[ai][bj][m][0], v1 = acc[ai][bj][m][1];
                    u32x4 w; w.x = pk_bf16(v0[0], v0[1]); w.y = pk_bf16(v0[2], v0[3]); w.z = pk_bf16(v1[0], v1[1]); w.w = pk_bf16(v1[2], v1[3]);
                    *(u32x4*)(dst + (size_t)(row0 + ai * 128 + m * 16) * DM + col0 + bj * 128) = w;
                }
    }
};


struct EpiKVQR {
    static constexpr bool PERM = true, AFTER_DRAIN = false;
    bf16_t* K; const float* COS; const float* SIN;
    __device__ __forceinline__ void operator()(const pg8::f32x4 (&acc)[2][2][4][2], const pg8::Unit& u, int wr, int wc, int fr, int fq) const {
        const int t = u.pn >> 3;
        bf16_t* dst = K + (size_t)t * ((size_t)32 << 20);
        const int row0 = u.pm * 256 + wr * 64 + fr;
        if (t == 1) {
            const int col0 = (u.pn & 7) * 256 + wc * 32 + 8 * fq;
#pragma unroll
            for (int ai = 0; ai < 2; ++ai)
#pragma unroll
                for (int m = 0; m < 4; ++m)
#pragma unroll
                    for (int bj = 0; bj < 2; ++bj) {
                        const f32x4 v0 = acc[ai][bj][m][0], v1 = acc[ai][bj][m][1];
                        u32x4 w; w.x = pk_bf16(v0[0], v0[1]); w.y = pk_bf16(v0[2], v0[3]); w.z = pk_bf16(v1[0], v1[1]); w.w = pk_bf16(v1[2], v1[3]);
                        *(u32x4*)(dst + (size_t)(row0 + ai * 128 + m * 16) * DM + col0 + bj * 128) = w;
                    }
        } else {
            const int g = 4 * wc + fq;
#pragma unroll
            for (int ai = 0; ai < 2; ++ai)
#pragma unroll
                for (int m = 0; m < 4; ++m) {
                    const int row = row0 + ai * 128 + m * 16, pos = row & (SEQ - 1);
                    const f32x4 c = *(const f32x4*)(COS + pos * 64 + 4 * g), sn = *(const f32x4*)(SIN + pos * 64 + 4 * g);
#pragma unroll
                    for (int bj = 0; bj < 2; ++bj) {
                        const f32x4 a = acc[ai][bj][m][0], b = acc[ai][bj][m][1];
                        bf16_t* p = dst + (size_t)row * DM + ((u.pn & 7) * 2 + bj) * 128 + 4 * g;
                        u32x2 w1, w2;
                        w1.x = pk_bf16(a[0] * c[0] - b[0] * sn[0], a[1] * c[1] - b[1] * sn[1]); w1.y = pk_bf16(a[2] * c[2] - b[2] * sn[2], a[3] * c[3] - b[3] * sn[3]);
                        w2.x = pk_bf16(a[0] * sn[0] + b[0] * c[0], a[1] * sn[1] + b[1] * c[1]); w2.y = pk_bf16(a[2] * sn[2] + b[2] * c[2], a[3] * sn[3] + b[3] * c[3]);
                        *(u32x2*)p = w1; *(u32x2*)(p + 64) = w2;
                    }
                }
        }
    }
};

__host__ __device__ __forceinline__ int rot_pos(int d) { return d < 64 ? 8 * (d >> 2) + (d & 3) : 8 * ((d - 64) >> 2) + 4 + (d & 3); }
__device__ __forceinline__ void transpose_tiles(LAS float* tile, const float* src, int ldn, int K, int N, bf16_t* dst, int nperm = 0) {
    const int tid = threadIdx.x;
    const int tn = N / 64, ntiles = tn * (K / 64);
    f32x4 nx[2];
#define TT_LOAD(tI_) { const int k0_ = ((tI_) / tn) * 64, n0_ = ((tI_) % tn) * 64; _Pragma("unroll") for (int r = 0; r < 2; ++r) nx[r] = *(const f32x4*)(src + (size_t)(k0_ + (tid >> 4) + 32 * r) * ldn + n0_ + (tid & 15) * 4); }
    if ((int)blockIdx.x < ntiles) TT_LOAD((int)blockIdx.x)
    for (int tI = blockIdx.x; tI < ntiles; tI += gridDim.x) {
        const int k0 = (tI / tn) * 64, n0 = (tI % tn) * 64;
        const f32x4 c0 = nx[0], c1 = nx[1];
        if (tI + (int)gridDim.x < ntiles) TT_LOAD(tI + (int)gridDim.x)
#pragma unroll
        for (int r = 0; r < 2; ++r) {
            const int kk = (tid >> 4) + 32 * r, nn = (tid & 15) * 4;
            const f32x4 v = r == 0 ? c0 : c1;
            tile[kk * 65 + nn + 0] = v[0]; tile[kk * 65 + nn + 1] = v[1]; tile[kk * 65 + nn + 2] = v[2]; tile[kk * 65 + nn + 3] = v[3];
        }
        __syncthreads();
        {
            const int nn = tid >> 3, kk8 = (tid & 7) * 8;
            float f[8];
#pragma unroll
            for (int j = 0; j < 8; ++j) f[j] = tile[(kk8 + j) * 65 + nn];
            u32x4 w; w.x = pk_bf16(f[0], f[1]); w.y = pk_bf16(f[2], f[3]); w.z = pk_bf16(f[4], f[5]); w.w = pk_bf16(f[6], f[7]);
            const int nsrc = n0 + nn, nrow = nsrc < nperm ? (nsrc & ~127) + rot_pos(nsrc & 127) : nsrc;
            *(u32x4*)(dst + (size_t)nrow * K + k0 + kk8) = w;
        }
        __syncthreads();
    }
}
#undef TT_LOAD
__device__ __forceinline__ void convert_bf16(const float* src, bf16_t* dst, size_t n) {
    const size_t stride = (size_t)gridDim.x * 512 * 8;
    for (size_t i = ((size_t)blockIdx.x * 512 + threadIdx.x) * 8; i < n; i += stride) {
        const f32x4 a = *(const f32x4*)(src + i), b = *(const f32x4*)(src + i + 4);
        u32x4 w; w.x = pk_bf16(a[0], a[1]); w.y = pk_bf16(a[2], a[3]); w.z = pk_bf16(b[0], b[1]); w.w = pk_bf16(b[2], b[3]);
        *(u32x4*)(dst + i) = w;
    }
}
__device__ __forceinline__ void fold_peer_keys(LAS float* lds, const float* w_query, const float* sub_keys, bf16_t* WcT) {
    const int tid = threadIdx.x;
    LAS float* Ss = lds;
    LAS float* Ws = lds + 128 * 132;
    for (int item = blockIdx.x; item < 1024; item += gridDim.x) {
        const int l = item >> 9, rem = item & 511, hh = rem >> 5, kb = rem & 31, h = hh >> 1, half = hh & 1;
        const float* sk = sub_keys + (size_t)(((l * 2 + half) * 8 + h) * 128) * 128;
        const float* wq = w_query + (size_t)l * DM * DM + (size_t)(kb * 64) * DM + h * 256 + half * 128;
#pragma unroll
        for (int r = 0; r < 8; ++r) { const int idx = tid + 512 * r, key = idx >> 5, d4 = (idx & 31) * 4; *(LAS f32x4*)(Ss + key * 132 + d4) = *(const f32x4*)(sk + key * 128 + d4); }
#pragma unroll
        for (int r = 0; r < 4; ++r) { const int idx = tid + 512 * r, kin = idx >> 5, d4 = (idx & 31) * 4; *(LAS f32x4*)(Ws + kin * 128 + d4) = *(const f32x4*)(wq + (size_t)kin * DM + d4); }
        __syncthreads();
        const int key = tid & 127, kq = tid >> 7;
        float acc[16];
#pragma unroll
        for (int j = 0; j < 16; ++j) acc[j] = 0.f;
        for (int d4 = 0; d4 < 32; ++d4) {
            const f32x4 s4 = *(const LAS f32x4*)(Ss + key * 132 + d4 * 4);
#pragma unroll
            for (int j = 0; j < 16; ++j) { const f32x4 w4 = *(const LAS f32x4*)(Ws + (kq * 16 + j) * 128 + d4 * 4); acc[j] += s4[0] * w4[0] + s4[1] * w4[1] + s4[2] * w4[2] + s4[3] * w4[3]; }
        }
        bf16_t* o = WcT + (size_t)l * DM * DM + (size_t)(h * 256 + half * 128 + key) * DM + kb * 64 + kq * 16;
        u32x4 w0, w1;
        w0.x = pk_bf16(acc[0], acc[1]); w0.y = pk_bf16(acc[2], acc[3]); w0.z = pk_bf16(acc[4], acc[5]); w0.w = pk_bf16(acc[6], acc[7]);
        w1.x = pk_bf16(acc[8], acc[9]); w1.y = pk_bf16(acc[10], acc[11]); w1.z = pk_bf16(acc[12], acc[13]); w1.w = pk_bf16(acc[14], acc[15]);
        *(u32x4*)o = w0; *(u32x4*)(o + 8) = w1;
        __syncthreads();
    }
}

__device__ __forceinline__ void quant_rows(const float* src, unsigned char* dst, float* scl, int nrows) {
    const int lane = threadIdx.x & 63, gw = blockIdx.x * 8 + (threadIdx.x >> 6), nw = gridDim.x * 8;
    for (int row = gw; row < nrows; row += nw) {
        const float* p = src + (size_t)row * DM;
        f32x4 v[8];
#pragma unroll
        for (int i = 0; i < 2; ++i)
#pragma unroll
            for (int q = 0; q < 4; ++q) v[i * 4 + q] = *(const f32x4*)(p + 1024 * i + 16 * lane + 4 * q);
        float am = 0.f;
#pragma unroll
        for (int i = 0; i < 8; ++i) am = fmaxf(am, fmaxf(fmaxf(fabsf(v[i][0]), fabsf(v[i][1])), fmaxf(fabsf(v[i][2]), fabsf(v[i][3]))));
        am = fmaxf(wave_max(am), 1e-30f);
        const float inv = 127.0f / am;
        if (lane == 0) scl[row] = am * (1.0f / 127.0f);
#pragma unroll
        for (int i = 0; i < 2; ++i) {
            u32x4 w;
#pragma unroll
            for (int q = 0; q < 4; ++q) {
                const f32x4 t = v[i * 4 + q];
                const unsigned b0 = (unsigned)(int)(rintf(t[0] * inv) + 128.0f), b1 = (unsigned)(int)(rintf(t[1] * inv) + 128.0f), b2 = (unsigned)(int)(rintf(t[2] * inv) + 128.0f), b3 = (unsigned)(int)(rintf(t[3] * inv) + 128.0f);
                w[q] = b0 | (b1 << 8) | (b2 << 16) | (b3 << 24);
            }
            *(u32x4*)(dst + (size_t)row * DM + 1024 * i + 16 * lane) = w;
        }
    }
}
__device__ __forceinline__ void phase_prep(const Args& a, LAS unsigned char* lds) {
    unsigned char* ws = a.ws;
    LAS float* tile = (LAS float*)lds;
    transpose_tiles(tile, a.in[1], 4 * DM, DM, 4 * DM, (bf16_t*)(ws + WS_WIN));
    transpose_tiles(tile, a.in[3], DM, DM, DM, (bf16_t*)(ws + WS_WOUT));
    transpose_tiles(tile, a.in[5], 2 * DM, DM, 2 * DM, (bf16_t*)(ws + WS_WKVQ), DM);
    transpose_tiles(tile, a.in[6], DM, DM, DM, (bf16_t*)(ws + WS_WKVQ) + (size_t)2 * DM * DM, DM);
    transpose_tiles(tile, a.in[7], DM, DM, DM, (bf16_t*)(ws + WS_WO));
    fold_peer_keys((LAS float*)lds, a.in[8], a.in[9], (bf16_t*)(ws + WS_WC));
    convert_bf16(a.in[0], (bf16_t*)(ws + slot(0)), (size_t)MTOK * DM);
    const int gtid = blockIdx.x * 512 + threadIdx.x, gthreads = gridDim.x * 512;
    float* COS = (float*)(ws + WS_COS); float* SIN = (float*)(ws + WS_SIN); float* LB = (float*)(ws + WS_LB);
    for (int i = gtid; i < SEQ * 64; i += gthreads) {
        const int pos = i >> 6, j = i & 63;
        double inv = 1.0; const double r = 0.86596432336006535;
        for (int q = 0; q < j; ++q) inv *= r;
        const float ang = (float)pos * (float)inv;
        const double x = (double)ang;
        const double n = __builtin_rint(x * 0.15915494309189535);
        const float rf = (float)__builtin_fma(-n, 6.283185307179586, x);
        COS[i] = cosf(rf); SIN[i] = sinf(rf);
    }
    for (int c = gtid; c < DM; c += gthreads) { const float l0 = a.in[4][c], l1 = a.in[4][DM + c]; LB[c] = 1.0f / (1.0f + expf(l1 - l0)); }
}

__device__ __forceinline__ void phase_scan_naive(const bf16_t* Q1, const float* LF, const bf16_t* I1, float* O) {
    const int lane = threadIdx.x & 63, gw = blockIdx.x * 8 + (threadIdx.x >> 6), nw = gridDim.x * 8;
    for (int item = gw; item < 2 * NHEAD * 128; item += nw) {
        const int bh = item >> 7, v = item & 127, b = bh >> 4, h = bh & 15;
        const size_t base = (size_t)b * SEQ * DM + h * 128;
        float S0 = 0.f, S1 = 0.f;
#pragma unroll 4
        for (int t = 0; t < SEQ; ++t) {
            const size_t ro = base + (size_t)t * DM;
            const float f0 = __expf(LF[ro + lane]), f1 = __expf(LF[ro + 64 + lane]);
            const float q0 = bf2f(Q1[ro + lane]), q1 = bf2f(Q1[ro + 64 + lane]);
            const float iv = bf2f(I1[ro + v]);
            S0 = f0 * S0 + (1.0f - f0) * iv; S1 = f1 * S1 + (1.0f - f1) * iv;
            const float p = wave_sum(q0 * S0 + q1 * S1);
            if (lane == 0) O[ro + v] = p;
        }
    }
}
__device__ __forceinline__ void phase_onorm(const float* O, const bf16_t* G1, const float* gnorm, bf16_t* OG) {
    const int lane = threadIdx.x & 63, gw = blockIdx.x * 8 + (threadIdx.x >> 6), nw = gridDim.x * 8;
    const float gn0 = gnorm[2 * lane], gn1 = gnorm[2 * lane + 1];
    for (int item = gw; item < MTOK * NHEAD; item += nw) {
        const size_t off = (size_t)item * 128 + 2 * lane;
        const float o0 = O[off], o1 = O[off + 1];
        const float ss = wave_sum(o0 * o0 + o1 * o1);
        const float r = rsqrtf(ss * (1.0f / 128.0f) + 1e-6f);
        const unsigned g = *(const unsigned*)(G1 + off);
        *(unsigned*)(OG + off) = pk_bf16(o0 * r * gn0 * bflo(g), o1 * r * gn1 * bfhi(g));
    }
}

__device__ __forceinline__ void ln_row_store(float (&v)[32], const float* g, const float* bta, float* outf, bf16_t* outb, int lane, signed char* outq = nullptr, float* outs = nullptr) {
    float s = 0.f;
#pragma unroll
    for (int i = 0; i < 32; ++i) s += v[i];
    const float mu = wave_sum(s) * (1.0f / DM);
    float q = 0.f;
#pragma unroll
    for (int i = 0; i < 32; ++i) { v[i] -= mu; q += v[i] * v[i]; }
    const float rstd = rsqrtf(wave_sum(q) * (1.0f / DM) + 1e-5f);
    float am = 0.f;
#pragma unroll
    for (int i = 0; i < 4; ++i) {
        const int c = 512 * i + 8 * lane;
        const f32x4 g0 = *(const f32x4*)(g + c), g1 = *(const f32x4*)(g + c + 4), b0 = *(const f32x4*)(bta + c), b1 = *(const f32x4*)(bta + c + 4);
        f32x4 o0, o1;
#pragma unroll
        for (int j = 0; j < 4; ++j) { o0[j] = v[i * 8 + j] * rstd * g0[j] + b0[j]; o1[j] = v[i * 8 + 4 + j] * rstd * g1[j] + b1[j]; v[i * 8 + j] = o0[j]; v[i * 8 + 4 + j] = o1[j]; am = fmaxf(am, fmaxf(fabsf(o0[j]), fabsf(o1[j]))); }
        if (outf) { *(f32x4*)(outf + c) = o0; *(f32x4*)(outf + c + 4) = o1; }
        if (outb) { u32x4 w; w.x = pk_bf16(o0[0], o0[1]); w.y = pk_bf16(o0[2], o0[3]); w.z = pk_bf16(o1[0], o1[1]); w.w = pk_bf16(o1[2], o1[3]); *(u32x4*)(outb + c) = w; }
    }
    if (outq) {
        am = fmaxf(wave_max(am), 1e-30f);
        const float inv = 127.0f / am;
        if (lane == 0) *outs = am * (1.0f / 127.0f);
#pragma unroll
        for (int i = 0; i < 4; ++i) {
            u32x2 w;
            w.x = ((unsigned)(int)rintf(v[i * 8 + 0] * inv) & 0xffu) | (((unsigned)(int)rintf(v[i * 8 + 1] * inv) & 0xffu) << 8) | (((unsigned)(int)rintf(v[i * 8 + 2] * inv) & 0xffu) << 16) | (((unsigned)(int)rintf(v[i * 8 + 3] * inv) & 0xffu) << 24);
            w.y = ((unsigned)(int)rintf(v[i * 8 + 4] * inv) & 0xffu) | (((unsigned)(int)rintf(v[i * 8 + 5] * inv) & 0xffu) << 8) | (((unsigned)(int)rintf(v[i * 8 + 6] * inv) & 0xffu) << 16) | (((unsigned)(int)rintf(v[i * 8 + 7] * inv) & 0xffu) << 24);
            *(u32x2*)(outq + 512 * i + 8 * lane) = w;
        }
    }
}
__device__ __forceinline__ void ln_row_store16(float (&v)[32], const float* g, const float* bta, float* outf, bf16_t* outb, int lane) {
    float s = 0.f;
#pragma unroll
    for (int i = 0; i < 32; ++i) s += v[i];
    const float mu = wave_sum(s) * (1.0f / DM);
    float q = 0.f;
#pragma unroll
    for (int i = 0; i < 32; ++i) { v[i] -= mu; q += v[i] * v[i]; }
    const float rstd = rsqrtf(wave_sum(q) * (1.0f / DM) + 1e-5f);
#pragma unroll
    for (int i = 0; i < 2; ++i) {
        const int c = 1024 * i + 16 * lane;
        f32x4 o[4];
#pragma unroll
        for (int qd = 0; qd < 4; ++qd) {
            const f32x4 gg = *(const f32x4*)(g + c + 4 * qd), bb = *(const f32x4*)(bta + c + 4 * qd);
#pragma unroll
            for (int j = 0; j < 4; ++j) o[qd][j] = v[16 * i + 4 * qd + j] * rstd * gg[j] + bb[j];
            *(f32x4*)(outf + c + 4 * qd) = o[qd];
        }
        if (outb) {
            u32x4 w0, w1;
            w0.x = pk_bf16(o[0][0], o[0][1]); w0.y = pk_bf16(o[0][2], o[0][3]); w0.z = pk_bf16(o[1][0], o[1][1]); w0.w = pk_bf16(o[1][2], o[1][3]);
            w1.x = pk_bf16(o[2][0], o[2][1]); w1.y = pk_bf16(o[2][2], o[2][3]); w1.z = pk_bf16(o[3][0], o[3][1]); w1.w = pk_bf16(o[3][2], o[3][3]);
            *(u32x4*)(outb + c) = w0; *(u32x4*)(outb + c + 8) = w1;
        }
    }
}
template <bool RES16> __device__ __forceinline__ void phase_ln(const bf16_t* Y, const void* RESv, const float* g, const float* bta, float* outf, bf16_t* outb, signed char* outq = nullptr, float* outs = nullptr) {
    const int lane = threadIdx.x & 63, gw = blockIdx.x * 8 + (threadIdx.x >> 6), nw = gridDim.x * 8;
    for (int row = gw; row < MTOK; row += nw) {
        float v[32];
        const bf16_t* p = Y + (size_t)row * DM;
#pragma unroll
        for (int i = 0; i < 4; ++i) {
            const u32x4 yw = *(const u32x4*)(p + 512 * i + 8 * lane);
            const f32x4 a = {bflo(yw.x), bfhi(yw.x), bflo(yw.y), bfhi(yw.y)}, b = {bflo(yw.z), bfhi(yw.z), bflo(yw.w), bfhi(yw.w)};
            f32x4 ra, rb;
            if (RES16) { const u32x4 w = *(const u32x4*)((const bf16_t*)RESv + (size_t)row * DM + 512 * i + 8 * lane); ra = (f32x4){bflo(w.x), bfhi(w.x), bflo(w.y), bfhi(w.y)}; rb = (f32x4){bflo(w.z), bfhi(w.z), bflo(w.w), bfhi(w.w)}; }
            else { const float* rp = (const float*)RESv + (size_t)row * DM; ra = *(const f32x4*)(rp + 512 * i + 8 * lane); rb = *(const f32x4*)(rp + 512 * i + 8 * lane + 4); }
#pragma unroll
            for (int j = 0; j < 4; ++j) { v[i * 8 + j] = a[j] + ALPHA * ra[j]; v[i * 8 + 4 + j] = b[j] + ALPHA * rb[j]; }
        }
        ln_row_store(v, g, bta, outf ? outf + (size_t)row * DM : nullptr, outb ? outb + (size_t)row * DM : nullptr, lane, outq ? outq + (size_t)row * DM : nullptr, outs ? outs + row : nullptr);
    }
}

__device__ __forceinline__ void wave_argmax(float& v, int& idx) {
#pragma unroll
    for (int o = 32; o >= 1; o >>= 1) {
        const float ov = __shfl_xor(v, o); const int oi = __shfl_xor(idx, o);
        if (ov > v || (ov == v && oi < idx)) { v = ov; idx = oi; }
    }
}
__device__ __forceinline__ unsigned fkey(float x) { const unsigned u = __float_as_uint(x); return u ^ (unsigned)(((int)u >> 31) | 0x80000000); }
__device__ __forceinline__ float funkey(unsigned k) { const unsigned u = (k & 0x80000000u) ? (k ^ 0x80000000u) : ~k; return __uint_as_float(u); }
__device__ __forceinline__ void sort16_insert(unsigned (&r)[16], unsigned v) {
#pragma unroll
    for (int i = 0; i < 16; ++i) { const unsigned m = r[i] > v ? r[i] : v; v = r[i] > v ? v : r[i]; r[i] = m; }
}
__device__ __forceinline__ void phase_topk(LAS unsigned char* lds, const float* SCT, int* EID, float* GATE) {
    LAS unsigned char* ib = lds + threadIdx.x * 32;
    for (int item = blockIdx.x * 512 + threadIdx.x; item < MTOK * 8; item += gridDim.x * 512) {
        const int h = item >> 14, tok = item & (MTOK - 1);
        const float* p = SCT + (size_t)(h * 256) * MTOK + tok;
        unsigned r1[16], r2[16];
#pragma unroll
        for (int i = 0; i < 16; ++i) { r1[i] = 0u; r2[i] = 0u; }
#pragma unroll 8
        for (int e = 0; e < 128; ++e) {
            const float x1 = p[(size_t)e * MTOK], x2 = p[(size_t)(128 + e) * MTOK];
            sort16_insert(r1, (fkey(x1) & ~0x7Fu) | (unsigned)e);
            sort16_insert(r2, (fkey(x2) & ~0x7Fu) | (unsigned)e);
        }
        float v1[16], v2[16];
#pragma unroll
        for (int i = 0; i < 16; ++i) { v1[i] = funkey(r1[i] & ~0x7Fu); v2[i] = funkey(r2[i] & ~0x7Fu); ib[i] = (unsigned char)(r1[i] & 0x7Fu); ib[16 + i] = (unsigned char)(r2[i] & 0x7Fu); }
        unsigned r3[16];
#pragma unroll
        for (int i = 0; i < 16; ++i) r3[i] = 0u;
#pragma unroll
        for (int a = 0; a < 16; ++a)
#pragma unroll
            for (int bq = 0; bq < 16; ++bq)
                if ((a + 1) * (bq + 1) <= 16) sort16_insert(r3, (fkey(v1[a] + v2[bq]) & ~0xFFu) | (unsigned)(a * 16 + bq));
        const float mx = funkey(r3[0] & ~0xFFu);
        float ev[16]; float sum = 0.f;
#pragma unroll
        for (int i = 0; i < 16; ++i) { ev[i] = __expf(funkey(r3[i] & ~0xFFu) - mx); sum += ev[i]; }
        const float rs = 1.0f / sum;
        int eid[16];
#pragma unroll
        for (int i = 0; i < 16; ++i) { const unsigned f = r3[i] & 0xFFu; eid[i] = (int)ib[f >> 4] * 128 + (int)ib[16 + (f & 15u)]; }
        int* eo = EID + (size_t)tok * 128 + h * 16; float* go = GATE + (size_t)tok * 128 + h * 16;
#pragma unroll
        for (int q = 0; q < 4; ++q) {
            *(u32x4*)(eo + 4 * q) = (u32x4){(unsigned)eid[4 * q], (unsigned)eid[4 * q + 1], (unsigned)eid[4 * q + 2], (unsigned)eid[4 * q + 3]};
            *(f32x4*)(go + 4 * q) = (f32x4){ev[4 * q] * rs, ev[4 * q + 1] * rs, ev[4 * q + 2] * rs, ev[4 * q + 3] * rs};
        }
    }
}

__device__ __forceinline__ float gelu_erf(float x) { return 0.5f * x * (1.0f + erff(x * 0.70710678118654752f)); }
__device__ __forceinline__ float ub0(unsigned w) { return (float)(w & 0xffu); }
__device__ __forceinline__ float ub1(unsigned w) { return (float)((w >> 8) & 0xffu); }
__device__ __forceinline__ float ub2(unsigned w) { return (float)((w >> 16) & 0xffu); }
__device__ __forceinline__ float ub3(unsigned w) { return (float)(w >> 24); }
__device__ __forceinline__ void phase_peer(LAS unsigned char* lds, const float* X, const int* EID, const float* GATE, const unsigned char* U, const unsigned char* V, const float* USC, const float* VSC,
                                           const float* g, const float* bta, float* outf, bf16_t* outb) {
    const int lane = threadIdx.x & 63, wv = threadIdx.x >> 6, gw = blockIdx.x * 8 + wv, nw = gridDim.x * 8;
    LAS float* hb = (LAS float*)(lds + wv * 512);
    for (int tok = gw; tok < MTOK; tok += nw) {
        float x[32];
        const float* xp = X + (size_t)tok * DM;
#pragma unroll
        for (int i = 0; i < 2; ++i)
#pragma unroll
            for (int q = 0; q < 4; ++q) { const f32x4 t = *(const f32x4*)(xp + 1024 * i + 16 * lane + 4 * q); x[16 * i + 4 * q] = t[0]; x[16 * i + 4 * q + 1] = t[1]; x[16 * i + 4 * q + 2] = t[2]; x[16 * i + 4 * q + 3] = t[3]; }
        float sx = 0.f;
#pragma unroll
        for (int j = 0; j < 32; ++j) sx += x[j];
        const float d0 = -128.0f * sx;
        const int e0 = EID[(size_t)tok * 128 + lane], e1 = EID[(size_t)tok * 128 + 64 + lane];
        const float g0 = GATE[(size_t)tok * 128 + lane], g1 = GATE[(size_t)tok * 128 + 64 + lane];
        for (int bt = 0; bt < 16; ++bt) {
            float d[8];
#pragma unroll
            for (int r = 0; r < 8; ++r) {
                const int e = bt * 8 + r;
                const int idx = __builtin_amdgcn_readfirstlane(__shfl(bt < 8 ? e0 : e1, e & 63));
                const u32x4* up = (const u32x4*)(U + (size_t)idx * DM) + lane;
                float acc = d0;
#pragma unroll
                for (int i = 0; i < 2; ++i) {
                    const u32x4 w = up[i * 64];
                    acc += x[16 * i + 0] * ub0(w.x) + x[16 * i + 1] * ub1(w.x) + x[16 * i + 2] * ub2(w.x) + x[16 * i + 3] * ub3(w.x)
                         + x[16 * i + 4] * ub0(w.y) + x[16 * i + 5] * ub1(w.y) + x[16 * i + 6] * ub2(w.y) + x[16 * i + 7] * ub3(w.y)
                         + x[16 * i + 8] * ub0(w.z) + x[16 * i + 9] * ub1(w.z) + x[16 * i + 10] * ub2(w.z) + x[16 * i + 11] * ub3(w.z)
                         + x[16 * i + 12] * ub0(w.w) + x[16 * i + 13] * ub1(w.w) + x[16 * i + 14] * ub2(w.w) + x[16 * i + 15] * ub3(w.w);
                }
                d[r] = acc;
            }
            const bool b5 = lane & 32, b4 = lane & 16, b3 = lane & 8;
            float t4[4];
#pragma unroll
            for (int q = 0; q < 4; ++q) { const float keep = b5 ? d[4 + q] : d[q], send = b5 ? d[q] : d[4 + q]; t4[q] = keep + __shfl_xor(send, 32); }
            float t2[2];
#pragma unroll
            for (int q = 0; q < 2; ++q) { const float keep = b4 ? t4[2 + q] : t4[q], send = b4 ? t4[q] : t4[2 + q]; t2[q] = keep + __shfl_xor(send, 16); }
            float t1;
            { const float keep = b3 ? t2[1] : t2[0], send = b3 ? t2[0] : t2[1]; t1 = keep + __shfl_xor(send, 8); }
            t1 += __shfl_xor(t1, 4); t1 += __shfl_xor(t1, 2); t1 += __shfl_xor(t1, 1);
            if ((lane & 7) == 0) hb[bt * 8 + (lane >> 3 & 1) + 2 * (lane >> 4 & 1) + 4 * (lane >> 5 & 1)] = t1;
        }
        asm volatile("s_waitcnt lgkmcnt(0)" ::: "memory");
        const float h0 = hb[lane] * USC[e0], h1 = hb[64 + lane] * USC[e1];
        const float w0 = g0 * gelu_erf(h0) * VSC[e0], w1 = g1 * gelu_erf(h1) * VSC[e1];
        float wsum = wave_sum(w0 + w1);
        float y[32];
#pragma unroll
        for (int i = 0; i < 32; ++i) y[i] = 0.f;
#pragma unroll 8
        for (int e = 0; e < 128; ++e) {
            const int idx = __builtin_amdgcn_readfirstlane(__shfl(e < 64 ? e0 : e1, e & 63));
            const float wt = __shfl(e < 64 ? w0 : w1, e & 63);
            const u32x4* vp = (const u32x4*)(V + (size_t)idx * DM) + lane;
#pragma unroll
            for (int i = 0; i < 2; ++i) {
                const u32x4 w = vp[i * 64];
                y[16 * i + 0] += wt * ub0(w.x); y[16 * i + 1] += wt * ub1(w.x); y[16 * i + 2] += wt * ub2(w.x); y[16 * i + 3] += wt * ub3(w.x);
                y[16 * i + 4] += wt * ub0(w.y); y[16 * i + 5] += wt * ub1(w.y); y[16 * i + 6] += wt * ub2(w.y); y[16 * i + 7] += wt * ub3(w.y);
                y[16 * i + 8] += wt * ub0(w.z); y[16 * i + 9] += wt * ub1(w.z); y[16 * i + 10] += wt * ub2(w.z); y[16 * i + 11] += wt * ub3(w.z);
                y[16 * i + 12] += wt * ub0(w.w); y[16 * i + 13] += wt * ub1(w.w); y[16 * i + 14] += wt * ub2(w.w); y[16 * i + 15] += wt * ub3(w.w);
            }
        }
        const float corr = -128.0f * wsum;
#pragma unroll
        for (int i = 0; i < 32; ++i) y[i] = y[i] + corr + ALPHA * x[i];
        ln_row_store16(y, g, bta, outf + (size_t)tok * DM, outb ? outb + (size_t)tok * DM : nullptr, lane);
        asm volatile("s_waitcnt lgkmcnt(0)" ::: "memory");
    }
}

__device__ __forceinline__ int row_dot_i8(const u32x4 (&xq)[2], const unsigned char* rowp, int lane) {
    const u32x4* up = (const u32x4*)rowp + lane;
    int acc = 0;
#pragma unroll
    for (int i = 0; i < 2; ++i) {
        const u32x4 w = up[i * 64];
        acc = __builtin_amdgcn_sdot4((int)xq[i].x, (int)(w.x ^ 0x80808080u), acc, false); acc = __builtin_amdgcn_sdot4((int)xq[i].y, (int)(w.y ^ 0x80808080u), acc, false);
        acc = __builtin_amdgcn_sdot4((int)xq[i].z, (int)(w.z ^ 0x80808080u), acc, false); acc = __builtin_amdgcn_sdot4((int)xq[i].w, (int)(w.w ^ 0x80808080u), acc, false);
    }
    return acc;
}
__device__ __forceinline__ void peer_issue8(u32x4 (&seg)[8], const unsigned char* base, const u32x4 ia, const u32x4 ib) {
    seg[0] = *(const u32x4*)(base + (size_t)ia.x * DM); seg[1] = *(const u32x4*)(base + (size_t)ia.y * DM); seg[2] = *(const u32x4*)(base + (size_t)ia.z * DM); seg[3] = *(const u32x4*)(base + (size_t)ia.w * DM);
    seg[4] = *(const u32x4*)(base + (size_t)ib.x * DM); seg[5] = *(const u32x4*)(base + (size_t)ib.y * DM); seg[6] = *(const u32x4*)(base + (size_t)ib.z * DM); seg[7] = *(const u32x4*)(base + (size_t)ib.w * DM);
}
__device__ __forceinline__ void peer_dot8(int (&d)[8], const u32x4 (&seg)[8], const u32x4 xq) {
#pragma unroll
    for (int i = 0; i < 8; ++i) {
        int acc = __builtin_amdgcn_sdot4((int)xq.x, (int)(seg[i].x ^ 0x80808080u), 0, false);
        acc = __builtin_amdgcn_sdot4((int)xq.y, (int)(seg[i].y ^ 0x80808080u), acc, false);
        acc = __builtin_amdgcn_sdot4((int)xq.z, (int)(seg[i].z ^ 0x80808080u), acc, false);
        d[i] = __builtin_amdgcn_sdot4((int)xq.w, (int)(seg[i].w ^ 0x80808080u), acc, false);
    }
}
__device__ __forceinline__ void phase_peer_u(const signed char* XQ, const int* EID, const unsigned char* U, LAS int* HL  ) {
    const int lane = threadIdx.x & 63, wv = threadIdx.x >> 6, es = lane >> 3, cc = lane & 7;
    const bool b2 = cc & 4, b1 = cc & 2, b0 = cc & 1;
    const int nw = gridDim.x * 8, gw = blockIdx.x * 8 + wv, tpw = (MTOK + nw - 1) / nw, tbase = gw * tpw;
    int cnt = MTOK - tbase; cnt = cnt > tpw ? tpw : cnt;
    if (cnt <= 0) return;
    for (int i = lane; i < cnt * 128; i += 64) HL[i] = 0;
    asm volatile("s_waitcnt lgkmcnt(0)" ::: "memory");
    const int nit = 16 * cnt;
    const unsigned char* ub = U + cc * 16;
    u32x4 m0a, m0b, m0c, m0d, m0x, m1a, m1b, m1c, m1d, m1x, m2a, m2b, m2c, m2d, m2x; u32x4 sA[8], sB[8];
#define PU_LOAD(sl_, k_, A_, B_, C_, D_, X_) { const int* ep_ = EID + (size_t)(tbase + (k_)) * 128 + es * 16; A_ = *(const u32x4*)ep_; B_ = *(const u32x4*)(ep_ + 4); C_ = *(const u32x4*)(ep_ + 8); D_ = *(const u32x4*)(ep_ + 12); \
        X_ = *(const u32x4*)(XQ + (size_t)(tbase + (k_)) * DM + (sl_) * 128 + cc * 16); }
#define PU_NEXT(sl_, k_, sn_, kn_) { kn_ = (k_) + 1; sn_ = (sl_); if (kn_ == cnt) { kn_ = 0; ++sn_; } if (sn_ == 16) { sn_ = 15; kn_ = cnt - 1; } }
    int sl = 0, k = 0, sl1, k1, sl2, k2;
    PU_NEXT(sl, k, sl1, k1) PU_NEXT(sl1, k1, sl2, k2)
    PU_LOAD(sl, k, m0a, m0b, m0c, m0d, m0x)
    PU_LOAD(sl1, k1, m1a, m1b, m1c, m1d, m1x)
    peer_issue8(sA, ub + sl * 128, m0a, m0b);
    for (int it = 0; it < nit; ++it) {
        PU_LOAD(sl2, k2, m2a, m2b, m2c, m2d, m2x)
        peer_issue8(sB, ub + sl * 128, m0c, m0d);
        int dlo[8]; peer_dot8(dlo, sA, m0x);
        peer_issue8(sA, ub + sl1 * 128, m1a, m1b);
        int dhi[8]; peer_dot8(dhi, sB, m0x);
        int t8[8], t4[4], t2[2];
#pragma unroll
        for (int q = 0; q < 8; ++q) { const int keep = b2 ? dhi[q] : dlo[q], send = b2 ? dlo[q] : dhi[q]; t8[q] = keep + __shfl_xor(send, 4); }
#pragma unroll
        for (int q = 0; q < 4; ++q) { const int keep = b1 ? t8[4 + q] : t8[q], send = b1 ? t8[q] : t8[4 + q]; t4[q] = keep + __shfl_xor(send, 2); }
#pragma unroll
        for (int q = 0; q < 2; ++q) { const int keep = b0 ? t4[2 + q] : t4[q], send = b0 ? t4[q] : t4[2 + q]; t2[q] = keep + __shfl_xor(send, 1); }
        { LAS int* hp = HL + k * 128 + es * 16 + (b2 ? 8 : 0) + (b1 ? 4 : 0) + (b0 ? 2 : 0);
          __hip_atomic_fetch_add(hp, t2[0], __ATOMIC_RELAXED, __HIP_MEMORY_SCOPE_WORKGROUP); __hip_atomic_fetch_add(hp + 1, t2[1], __ATOMIC_RELAXED, __HIP_MEMORY_SCOPE_WORKGROUP); }
        sl = sl1; k = k1; sl1 = sl2; k1 = k2; PU_NEXT(sl1, k1, sl2, k2)
        m0a = m1a; m0b = m1b; m0c = m1c; m0d = m1d; m0x = m1x; m1a = m2a; m1b = m2b; m1c = m2c; m1d = m2d; m1x = m2x;
    }
#undef PU_LOAD
#undef PU_NEXT
}
__device__ __forceinline__ void phase_peer_w(const LAS int* HL, const float* XS, const int* EID, const float* GATE, const float* USC, const float* VSC, signed char* WQ, float* SW) {
    const int lane = threadIdx.x & 63, gw = blockIdx.x * 8 + (threadIdx.x >> 6), nw = gridDim.x * 8, tpw = (MTOK + nw - 1) / nw, tbase = gw * tpw;
    const int tend = tbase + tpw < MTOK ? tbase + tpw : MTOK;
    for (int tok = tbase; tok < tend; ++tok) {
        const int h0 = HL[(tok - tbase) * 128 + lane], h1 = HL[(tok - tbase) * 128 + 64 + lane];
        const int e0 = EID[(size_t)tok * 128 + lane], e1 = EID[(size_t)tok * 128 + 64 + lane];
        const float xs = XS[tok];
        const float w0 = GATE[(size_t)tok * 128 + lane] * gelu_erf((float)h0 * xs * USC[e0]) * VSC[e0];
        const float w1 = GATE[(size_t)tok * 128 + 64 + lane] * gelu_erf((float)h1 * xs * USC[e1]) * VSC[e1];
        const float am = fmaxf(wave_max(fmaxf(fabsf(w0), fabsf(w1))), 1e-30f), inv = 127.0f / am;
        WQ[(size_t)tok * 128 + lane] = (signed char)(int)rintf(w0 * inv); WQ[(size_t)tok * 128 + 64 + lane] = (signed char)(int)rintf(w1 * inv);
        if (lane == 0) SW[tok] = am * (1.0f / 127.0f);
    }
}
__device__ __forceinline__ void peer_dot4x4(int (&acc)[16], const u32x4 sa, const u32x4 sb, const u32x4 sc, const u32x4 sd, const unsigned w4) {
#pragma unroll
    for (int k = 0; k < 4; ++k) {
        const unsigned A = sa[k], B = sb[k], C = sc[k], D = sd[k];
        const unsigned p0 = __builtin_amdgcn_perm(B, A, 0x05010400u);
        const unsigned p1 = __builtin_amdgcn_perm(B, A, 0x07030602u);
        const unsigned p2 = __builtin_amdgcn_perm(D, C, 0x05010400u);
        const unsigned p3 = __builtin_amdgcn_perm(D, C, 0x07030602u);
        const unsigned t0 = __builtin_amdgcn_perm(p2, p0, 0x05040100u);
        const unsigned t1 = __builtin_amdgcn_perm(p2, p0, 0x07060302u);
        const unsigned t2 = __builtin_amdgcn_perm(p3, p1, 0x05040100u);
        const unsigned t3 = __builtin_amdgcn_perm(p3, p1, 0x07060302u);
        acc[4 * k + 0] = __builtin_amdgcn_sdot4((int)t0, (int)w4, acc[4 * k + 0], false);
        acc[4 * k + 1] = __builtin_amdgcn_sdot4((int)t1, (int)w4, acc[4 * k + 1], false);
        acc[4 * k + 2] = __builtin_amdgcn_sdot4((int)t2, (int)w4, acc[4 * k + 2], false);
        acc[4 * k + 3] = __builtin_amdgcn_sdot4((int)t3, (int)w4, acc[4 * k + 3], false);
    }
}
__device__ __forceinline__ void phase_peer_v(const bf16_t* X, const int* EID, const signed char* WQ, const float* SW, const unsigned char* V, float* Y) {
    const int lane = threadIdx.x & 63, wv = threadIdx.x >> 6, es = lane >> 3, cc = lane & 7;
    const bool b5 = lane & 32, b4 = lane & 16, b3 = lane & 8;
    const int nw = gridDim.x * 8, gw = blockIdx.x * 8 + wv, tpw = (MTOK + nw - 1) / nw, tbase = gw * tpw;
    int cnt = MTOK - tbase; cnt = cnt > tpw ? tpw : cnt;
    if (cnt <= 0) return;
    const int nit = 16 * cnt;
    const unsigned char* vb = V + cc * 16;
    const int colo = cc * 16 + (b5 ? 8 : 0) + (b4 ? 4 : 0) + (b3 ? 2 : 0);
    u32x4 m0c, m0d, m1a, m1b, m1c, m1d, m2a, m2b, m2c, m2d; u32x4 w0, w1; unsigned x0, x1; float c0, c1; u32x4 sA[8], sB[8];
#define PV_IDS(k_, A_, B_, C_, D_) { const size_t o_ = (size_t)(tbase + (k_)) * 128 + es * 16; A_ = *(const u32x4*)(EID + o_); B_ = *(const u32x4*)(EID + o_ + 4); C_ = *(const u32x4*)(EID + o_ + 8); D_ = *(const u32x4*)(EID + o_ + 12); }
#define PV_WX(sl_, k_, W_, X_, CS_) { W_ = *(const u32x4*)(WQ + (size_t)(tbase + (k_)) * 128 + es * 16); \
        X_ = *(const unsigned*)(X + (size_t)(tbase + (k_)) * DM + (sl_) * 128 + colo); CS_ = SW[tbase + (k_)]; }
#define PV_NEXT(sl_, k_, sn_, kn_) { kn_ = (k_) + 1; sn_ = (sl_); if (kn_ == cnt) { kn_ = 0; ++sn_; } if (sn_ == 16) { sn_ = 15; kn_ = cnt - 1; } }
    int sl = 0, k = 0, sl1, k1, sl2, k2;
    PV_NEXT(sl, k, sl1, k1) PV_NEXT(sl1, k1, sl2, k2)
    { u32x4 ta, tb; PV_IDS(k, ta, tb, m0c, m0d) PV_IDS(k1, m1a, m1b, m1c, m1d)
      PV_WX(sl, k, w0, x0, c0)
      peer_issue8(sA, vb + sl * 128, ta, tb); }
    for (int it = 0; it < nit; ++it) {
        PV_IDS(k2, m2a, m2b, m2c, m2d)
        peer_issue8(sB, vb + sl * 128, m0c, m0d);
        int ya[16];
#pragma unroll
        for (int j = 0; j < 16; ++j) ya[j] = 0;
        peer_dot4x4(ya, sA[0], sA[1], sA[2], sA[3], w0.x); peer_dot4x4(ya, sA[4], sA[5], sA[6], sA[7], w0.y);
        peer_issue8(sA, vb + sl1 * 128, m1a, m1b);
        PV_WX(sl1, k1, w1, x1, c1)
        peer_dot4x4(ya, sB[0], sB[1], sB[2], sB[3], w0.z); peer_dot4x4(ya, sB[4], sB[5], sB[6], sB[7], w0.w);
        int t8[8], t4[4], t2[2];
#pragma unroll
        for (int q = 0; q < 8; ++q) { const int keep = b5 ? ya[8 + q] : ya[q], send = b5 ? ya[q] : ya[8 + q]; t8[q] = keep + __shfl_xor(send, 32); }
#pragma unroll
        for (int q = 0; q < 4; ++q) { const int keep = b4 ? t8[4 + q] : t8[q], send = b4 ? t8[q] : t8[4 + q]; t4[q] = keep + __shfl_xor(send, 16); }
#pragma unroll
        for (int q = 0; q < 2; ++q) { const int keep = b3 ? t4[2 + q] : t4[q], send = b3 ? t4[q] : t4[2 + q]; t2[q] = keep + __shfl_xor(send, 8); }
        f32x2_t o; o[0] = (float)t2[0] * c0 + ALPHA * bflo(x0); o[1] = (float)t2[1] * c0 + ALPHA * bfhi(x0);
        *(f32x2_t*)(Y + (size_t)(tbase + k) * DM + sl * 128 + colo) = o;
        sl = sl1; k = k1; sl1 = sl2; k1 = k2; PV_NEXT(sl1, k1, sl2, k2)
        m0c = m1c; m0d = m1d; m1a = m2a; m1b = m2b; m1c = m2c; m1d = m2d;
        w0 = w1; x0 = x1; c0 = c1;
    }
#undef PV_IDS
#undef PV_WX
#undef PV_NEXT
}

__device__ __forceinline__ void rot8(const u32x4 lo, const u32x4 hi, const f32x4 c0, const f32x4 c1, const f32x4 s0, const f32x4 s1, float (&o1)[8], float (&o2)[8]) {
    const float a[8] = {bflo(lo.x), bfhi(lo.x), bflo(lo.y), bfhi(lo.y), bflo(lo.z), bfhi(lo.z), bflo(lo.w), bfhi(lo.w)};
    const float b[8] = {bflo(hi.x), bfhi(hi.x), bflo(hi.y), bfhi(hi.y), bflo(hi.z), bfhi(hi.z), bflo(hi.w), bfhi(hi.w)};
    const float c[8] = {c0[0], c0[1], c0[2], c0[3], c1[0], c1[1], c1[2], c1[3]}, sn[8] = {s0[0], s0[1], s0[2], s0[3], s1[0], s1[1], s1[2], s1[3]};
#pragma unroll
    for (int j = 0; j < 8; ++j) { o1[j] = a[j] * c[j] - b[j] * sn[j]; o2[j] = a[j] * sn[j] + b[j] * c[j]; }
}
__device__ __forceinline__ u32x4 pack8(const float (&o)[8]) { u32x4 w; w.x = pk_bf16(o[0], o[1]); w.y = pk_bf16(o[2], o[3]); w.z = pk_bf16(o[4], o[5]); w.w = pk_bf16(o[6], o[7]); return w; }
__device__ __forceinline__ void phase_kstat(LAS float* red, const bf16_t* KR, float* KMEAN, float* KNMAX) {
    const int tid = threadIdx.x, ch = tid & 7, rr = tid >> 3, wv = tid >> 6, lane = tid & 63;
    for (int item = blockIdx.x; item < 2 * NHEAD * 32; item += gridDim.x) {
        const int bh = item >> 5, j = item & 31, b = bh >> 4, h = bh & 15;
        float sm1[8], sm2[8]; float nmax = 0.f;
#pragma unroll
        for (int q = 0; q < 8; ++q) { sm1[q] = 0.f; sm2[q] = 0.f; }
        u32x4 lo[4], hi[4];
#pragma unroll
        for (int ps = 0; ps < 4; ++ps) { const size_t off = ((size_t)b * SEQ + j * 256 + ps * 64 + rr) * DM + h * 128 + ch * 8; lo[ps] = *(const u32x4*)(KR + off); hi[ps] = *(const u32x4*)(KR + off + 64); }
#pragma unroll
        for (int ps = 0; ps < 4; ++ps) {
            const float a[8] = {bflo(lo[ps].x), bfhi(lo[ps].x), bflo(lo[ps].y), bfhi(lo[ps].y), bflo(lo[ps].z), bfhi(lo[ps].z), bflo(lo[ps].w), bfhi(lo[ps].w)};
            const float c[8] = {bflo(hi[ps].x), bfhi(hi[ps].x), bflo(hi[ps].y), bfhi(hi[ps].y), bflo(hi[ps].z), bfhi(hi[ps].z), bflo(hi[ps].w), bfhi(hi[ps].w)};
            float nq = 0.f;
#pragma unroll
            for (int q = 0; q < 8; ++q) { sm1[q] += a[q]; sm2[q] += c[q]; nq += a[q] * a[q] + c[q] * c[q]; }
            nq += __shfl_xor(nq, 1); nq += __shfl_xor(nq, 2); nq += __shfl_xor(nq, 4);
            nmax = fmaxf(nmax, nq);
        }
#pragma unroll
        for (int q = 0; q < 8; ++q) {
            sm1[q] += __shfl_xor(sm1[q], 8); sm1[q] += __shfl_xor(sm1[q], 16); sm1[q] += __shfl_xor(sm1[q], 32);
            sm2[q] += __shfl_xor(sm2[q], 8); sm2[q] += __shfl_xor(sm2[q], 16); sm2[q] += __shfl_xor(sm2[q], 32);
        }
        nmax = wave_max(nmax);
        if (lane < 8) {
#pragma unroll
            for (int q = 0; q < 8; ++q) { red[wv * 128 + lane * 8 + q] = sm1[q]; red[wv * 128 + 64 + lane * 8 + q] = sm2[q]; }
        }
        if (lane == 0) red[1024 + wv] = nmax;
        __syncthreads();
        if (tid < 128) {
            float s2 = 0.f;
#pragma unroll
            for (int r = 0; r < 8; ++r) s2 += red[r * 128 + tid];
            KMEAN[(size_t)item * 128 + tid] = s2 * (1.0f / 256.0f);
        }
        if (tid == 0) {
            float m = 0.f;
#pragma unroll
            for (int r = 0; r < 8; ++r) m = fmaxf(m, red[1024 + r]);
            KNMAX[item] = sqrtf(m);
        }
        __syncthreads();
    }
}

__device__ __forceinline__ void top3_insert(float x, int m, float& v0, int& i0, float& v1, int& i1, float& v2, int& i2) {
    const bool c0 = x > v0 || (x == v0 && m < i0), c1 = x > v1 || (x == v1 && m < i1), c2 = x > v2 || (x == v2 && m < i2);
    v2 = c1 ? v1 : (c2 ? x : v2); i2 = c1 ? i1 : (c2 ? m : i2);
    v1 = c0 ? v0 : (c1 ? x : v1); i1 = c0 ? i0 : (c1 ? m : i1);
    v0 = c0 ? x : v0; i0 = c0 ? m : i0;
}
__device__ __forceinline__ void phase_sel(LAS unsigned char* lds, const bf16_t* QR, const float* KMEAN, unsigned short* SUB, int* CNT, int* ctr) {
    const int tid = threadIdx.x, lane = tid & 63, wv = tid >> 6, r32 = lane & 31, hh = lane >> 5;
    LAS unsigned short* bucket = (LAS unsigned short*)lds;
    LAS int* cnt = (LAS int*)(lds + 16384);
    const float NEG = -1e30f;
    if (blockIdx.x == 0 && tid == 0) *ctr = 0;
    for (int item = blockIdx.x; item < 2 * NHEAD * 32; item += gridDim.x) {
        const int bh = item >> 5, i = item & 31, b = bh >> 4, h = bh & 15;
        if (i == 0) continue;
        if (tid < 32) cnt[tid] = 0;
        __syncthreads();
        const float* kmp = KMEAN + ((size_t)bh * 32 + r32) * 128 + 8 * hh;
        const size_t tok = (size_t)b * SEQ + i * 256 + wv * 32 + r32;
        const bf16_t* qp = QR + tok * DM + h * 128 + 8 * hh;
        f32x16 S;
#pragma unroll
        for (int e = 0; e < 16; ++e) S[e] = 0.f;
#pragma unroll
        for (int s2 = 0; s2 < 8; ++s2) {
            const f32x4 ka = *(const f32x4*)(kmp + 16 * s2), kb = *(const f32x4*)(kmp + 16 * s2 + 4);
            const bf16x8 qf = *(const bf16x8*)(qp + 16 * s2);
            u32x4 hi, lo;
            hi.x = pk_bf16(ka[0], ka[1]); hi.y = pk_bf16(ka[2], ka[3]); hi.z = pk_bf16(kb[0], kb[1]); hi.w = pk_bf16(kb[2], kb[3]);
            lo.x = pk_bf16(ka[0] - bflo(hi.x), ka[1] - bfhi(hi.x)); lo.y = pk_bf16(ka[2] - bflo(hi.y), ka[3] - bfhi(hi.y));
            lo.z = pk_bf16(kb[0] - bflo(hi.z), kb[1] - bfhi(hi.z)); lo.w = pk_bf16(kb[2] - bflo(hi.w), kb[3] - bfhi(hi.w));
            S = __builtin_amdgcn_mfma_f32_32x32x16_bf16(__builtin_bit_cast(bf16x8, hi), qf, S, 0, 0, 0);
            S = __builtin_amdgcn_mfma_f32_32x32x16_bf16(__builtin_bit_cast(bf16x8, lo), qf, S, 0, 0, 0);
        }
        float v0 = -3e38f, v1 = -3e38f, v2 = -3e38f; int i0 = 99, i1 = 99, i2 = 99;
#pragma unroll
        for (int e = 0; e < 16; ++e) {
            const int m = (e & 3) + 8 * (e >> 2) + 4 * hh;
            const float x = m < i ? S[e] : NEG;
            top3_insert(x, m, v0, i0, v1, i1, v2, i2);
        }
        {
            const float pv0 = __shfl_xor(v0, 32), pv1 = __shfl_xor(v1, 32), pv2 = __shfl_xor(v2, 32);
            const int pi0 = __shfl_xor(i0, 32), pi1 = __shfl_xor(i1, 32), pi2 = __shfl_xor(i2, 32);
            top3_insert(pv0, pi0, v0, i0, v1, i1, v2, i2); top3_insert(pv1, pi1, v0, i0, v1, i1, v2, i2); top3_insert(pv2, pi2, v0, i0, v1, i1, v2, i2);
        }
        if (hh == 0) {
            const int tl = wv * 32 + r32;
            if (v0 > 0.5f * NEG) { const int p = __hip_atomic_fetch_add(cnt + i0, 1, __ATOMIC_RELAXED, __HIP_MEMORY_SCOPE_WORKGROUP); bucket[i0 * 256 + p] = (unsigned short)(tl | (0 << 8)); }
            if (v1 > 0.5f * NEG) { const int p = __hip_atomic_fetch_add(cnt + i1, 1, __ATOMIC_RELAXED, __HIP_MEMORY_SCOPE_WORKGROUP); bucket[i1 * 256 + p] = (unsigned short)(tl | (1 << 8)); }
            if (v2 > 0.5f * NEG) { const int p = __hip_atomic_fetch_add(cnt + i2, 1, __ATOMIC_RELAXED, __HIP_MEMORY_SCOPE_WORKGROUP); bucket[i2 * 256 + p] = (unsigned short)(tl | (2 << 8)); }
        }
        __syncthreads();
        for (int idx = tid; idx < 32 * 256; idx += 512) {
            const int j = idx >> 8, p = idx & 255;
            if (j < i && p < cnt[j]) SUB[(((size_t)bh * 32 + j) * 32 + i) * 256 + p] = bucket[idx];
        }
        if (tid < i) CNT[((size_t)bh * 32 + tid) * 32 + i] = cnt[tid];
        __syncthreads();
    }
}

__device__ __forceinline__ unsigned off_b(unsigned row, unsigned ch) { return 256u * row + 16u * (ch ^ (((row & 3u) << 2) | ((row >> 2) & 3u))); }
__device__ __forceinline__ unsigned pi32(unsigned m) { return (m & ~12u) | ((m & 4u) << 1) | ((m & 8u) >> 1); }
__device__ __forceinline__ bf16x8 tr_frag(LAS unsigned char* img, unsigned lane, unsigned c, unsigned ks) {
    const unsigned hh = lane >> 5, blk = (lane >> 4) & 1, q = (lane & 15) >> 2, p = lane & 3;
    const unsigned a0 = off_b(16 * ks + 8 * hh + q, 4 * c + 2 * blk + (p >> 1)) + 8 * (p & 1);
    const unsigned a1 = off_b(16 * ks + 8 * hh + 4 + q, 4 * c + 2 * blk + (p >> 1)) + 8 * (p & 1);
    const s16x4 lo = __builtin_amdgcn_ds_read_tr16_b64_v4i16((LAS s16x4*)(img + a0));
    const s16x4 hi = __builtin_amdgcn_ds_read_tr16_b64_v4i16((LAS s16x4*)(img + a1));
    bf16x8 r; r[0] = lo[0]; r[1] = lo[1]; r[2] = lo[2]; r[3] = lo[3]; r[4] = hi[0]; r[5] = hi[1]; r[6] = hi[2]; r[7] = hi[3];
    return r;
}
__device__ __forceinline__ void phase_att(LAS unsigned char* lds, const bf16_t* QR, const bf16_t* KR, const bf16_t* V, const float* KNMAX, const unsigned short* SUB, const int* CNT, int* ctr,
                                          bf16_t* P012, bf16_t* P3, float* LS) {
    const int tid = threadIdx.x, lane = tid & 63, wv = tid >> 6, r32 = lane & 31, hh = lane >> 5;
    LAS unsigned char* Kimg = lds;
    LAS unsigned char* Vimg = lds + 65536;
    LAS int* misc = (LAS int*)(lds + 131072);
    const float SCL2 = 0.08838834764831845f * 1.4426950408889634f;
    for (;;) {
        __syncthreads();
        if (tid == 0) misc[40] = __hip_atomic_fetch_add(ctr, 1, __ATOMIC_RELAXED, __HIP_MEMORY_SCOPE_AGENT);
        __syncthreads();
        const int item = misc[40];
        if (item >= 2 * NHEAD * 32) break;
        const int j = item >> 5, bh = item & 31, b = bh >> 4, h = bh & 15;
#pragma unroll
        for (int r = 0; r < 8; ++r) {
            const int idx = tid + 512 * r, row = idx >> 4, ch = idx & 15;
            const size_t g = ((size_t)b * SEQ + j * 256 + row) * DM + h * 128 + ch * 8;
            const u32x4 kv = *(const u32x4*)(KR + g), vv = *(const u32x4*)(V + g);
            *(LAS u32x4*)(Kimg + off_b(row, ch)) = kv; *(LAS u32x4*)(Vimg + off_b(row, ch)) = vv;
        }
        if (tid <= 32) { int pre = 0; for (int u = j + 1; u < tid; ++u) pre += CNT[((size_t)bh * 32 + j) * 32 + u]; misc[tid] = pre; }
        float kn = (lane < 32) ? KNMAX[bh * 32 + lane] : 0.f;
        kn = wave_max(kn);
        __syncthreads();
        const int total = misc[32], ntile = (256 + total + 31) >> 5;
        for (int tile = wv; tile < ntile; tile += 8) {
            const int gr = tile * 32 + r32;
            int pos, slot; bool valid = true;
            if (gr < 256) { pos = j * 256 + gr; slot = 3; }
            else {
                const int x = gr - 256; valid = x < total;
                int ii = j + 1;
                for (int u = j + 1; u < 32; ++u) if (misc[u] <= x) ii = u;
                if (valid) { const unsigned e = SUB[(((size_t)bh * 32 + j) * 32 + ii) * 256 + (x - misc[ii])]; pos = ii * 256 + (int)(e & 255u); slot = (int)(e >> 8); }
                else { pos = j * 256; slot = 3; }
            }
            const size_t tok = (size_t)b * SEQ + pos;
            bf16x8 qf[8];
            const bf16_t* qp = QR + tok * DM + h * 128 + 8 * hh;
#pragma unroll
            for (int s = 0; s < 8; ++s) qf[s] = *(const bf16x8*)(qp + 16 * s);
            float qn2 = 0.f;
#pragma unroll
            for (int s = 0; s < 8; ++s)
#pragma unroll
                for (int e = 0; e < 8; ++e) { const float f = bf2f((bf16_t)qf[s][e]); qn2 += f * f; }
            qn2 += __shfl_xor(qn2, 32);
            const float c2 = sqrtf(qn2) * kn * SCL2;
            f32x16 O[4];
#pragma unroll
            for (int dt = 0; dt < 4; ++dt)
#pragma unroll
                for (int e = 0; e < 16; ++e) O[dt][e] = 0.f;
            float l = 0.f;
            const bool own = tile < 8;
            const int kcn = own ? tile + 1 : 8;
            const unsigned krow = pi32((unsigned)r32);
            for (int kc = 0; kc < kcn; ++kc) {
                f32x16 S, S1;
#pragma unroll
                for (int e = 0; e < 16; ++e) { S[e] = 0.f; S1[e] = 0.f; }
#pragma unroll
                for (int s = 0; s < 8; s += 2) {
                    const bf16x8 kf = *(const LAS bf16x8*)(Kimg + off_b(32 * kc + krow, 2 * s + hh));
                    const bf16x8 kf1 = *(const LAS bf16x8*)(Kimg + off_b(32 * kc + krow, 2 * s + 2 + hh));
                    S = __builtin_amdgcn_mfma_f32_32x32x16_bf16(kf, qf[s], S, 0, 0, 0);
                    S1 = __builtin_amdgcn_mfma_f32_32x32x16_bf16(kf1, qf[s + 1], S1, 0, 0, 0);
                }
                float p[16];
                if (own) {
#pragma unroll
                    for (int e = 0; e < 16; ++e) {
                        const unsigned m = (e & 3) + 8 * (e >> 2) + 4 * hh;
                        const int key = j * 256 + 32 * kc + (int)pi32(m);
                        float pe = __builtin_amdgcn_exp2f((S[e] + S1[e]) * SCL2 - c2);
                        if (key > pos) pe = 0.f;
                        p[e] = pe; l += pe;
                    }
                } else {
#pragma unroll
                    for (int e = 0; e < 16; ++e) { const float pe = __builtin_amdgcn_exp2f((S[e] + S1[e]) * SCL2 - c2); p[e] = pe; l += pe; }
                }
                u32x4 w0, w1;
                w0.x = pk_bf16(p[0], p[1]); w0.y = pk_bf16(p[2], p[3]); w0.z = pk_bf16(p[4], p[5]); w0.w = pk_bf16(p[6], p[7]);
                w1.x = pk_bf16(p[8], p[9]); w1.y = pk_bf16(p[10], p[11]); w1.z = pk_bf16(p[12], p[13]); w1.w = pk_bf16(p[14], p[15]);
                const bf16x8 pf0 = __builtin_bit_cast(bf16x8, w0), pf1 = __builtin_bit_cast(bf16x8, w1);
#pragma unroll
                for (int dt = 0; dt < 4; ++dt) {
                    const bf16x8 v0 = tr_frag(Vimg, lane, dt, 2 * kc), v1 = tr_frag(Vimg, lane, dt, 2 * kc + 1);
                    O[dt] = __builtin_amdgcn_mfma_f32_32x32x16_bf16(v0, pf0, O[dt], 0, 0, 0);
                    O[dt] = __builtin_amdgcn_mfma_f32_32x32x16_bf16(v1, pf1, O[dt], 0, 0, 0);
                }
            }
            l += __shfl_xor(l, 32);
            if (valid) {
                bf16_t* pl = (slot < 3 ? P012 + (size_t)slot * ((size_t)32 << 20) : P3) + (tok * NHEAD + h) * 128 + 4 * hh;
#pragma unroll
                for (int dt = 0; dt < 4; ++dt)
#pragma unroll
                    for (int g = 0; g < 4; ++g) {
                        u32x2 w; w.x = pk_bf16(O[dt][4 * g], O[dt][4 * g + 1]); w.y = pk_bf16(O[dt][4 * g + 2], O[dt][4 * g + 3]);
                        *(u32x2*)(pl + 32 * dt + 8 * g) = w;
                    }
                if (hh == 0) LS[(size_t)slot * MTOK * NHEAD + tok * NHEAD + h] = l;
            }
        }
    }
}
__device__ __forceinline__ void phase_comb(const bf16_t* P012, const bf16_t* P3, const float* LS, bf16_t* AO) {
    const size_t n = (size_t)MTOK * NHEAD * 16, stride = (size_t)gridDim.x * 512;
    for (size_t idx = (size_t)blockIdx.x * 512 + threadIdx.x; idx < n; idx += stride) {
        const size_t th = idx >> 4; const int ch = (int)(idx & 15);
        const int t = (int)((th >> 4) & (SEQ - 1)), blk = t >> 8, nsel = blk < 3 ? blk : 3;
        float acc[8];
        float l = LS[(size_t)3 * MTOK * NHEAD + th];
        { const u32x4 w = *(const u32x4*)(P3 + th * 128 + ch * 8);
          acc[0] = bflo(w.x); acc[1] = bfhi(w.x); acc[2] = bflo(w.y); acc[3] = bfhi(w.y); acc[4] = bflo(w.z); acc[5] = bfhi(w.z); acc[6] = bflo(w.w); acc[7] = bfhi(w.w); }
#pragma unroll
        for (int s = 0; s < 3; ++s) {
            u32x4 w = *(const u32x4*)(P012 + (size_t)s * ((size_t)32 << 20) + th * 128 + ch * 8);
            float ls = LS[(size_t)s * MTOK * NHEAD + th];
            if (s >= nsel) { w = (u32x4){0u, 0u, 0u, 0u}; ls = 0.f; }
            acc[0] += bflo(w.x); acc[1] += bfhi(w.x); acc[2] += bflo(w.y); acc[3] += bfhi(w.y); acc[4] += bflo(w.z); acc[5] += bfhi(w.z); acc[6] += bflo(w.w); acc[7] += bfhi(w.w);
            l += ls;
        }
        const float rl = 1.0f / l;
        u32x4 o; o.x = pk_bf16(acc[0] * rl, acc[1] * rl); o.y = pk_bf16(acc[2] * rl, acc[3] * rl); o.z = pk_bf16(acc[4] * rl, acc[5] * rl); o.w = pk_bf16(acc[6] * rl, acc[7] * rl);
        *(u32x4*)(AO + th * 128 + ch * 8) = o;
    }
}


__device__ __forceinline__ void qrow_issue(f32x4 (&v)[8], const float* p, int lane) {
#pragma unroll
    for (int i = 0; i < 2; ++i)
#pragma unroll
        for (int q = 0; q < 4; ++q) v[i * 4 + q] = *(const f32x4*)(p + 1024 * i + 16 * lane + 4 * q);
}
__device__ __forceinline__ void qrow_finish(const f32x4 (&v)[8], unsigned char* dst, float* scl, int lane, bool sgn = false) {
    float am = 0.f;
#pragma unroll
    for (int i = 0; i < 8; ++i) am = fmaxf(am, fmaxf(fmaxf(fabsf(v[i][0]), fabsf(v[i][1])), fmaxf(fabsf(v[i][2]), fabsf(v[i][3]))));
    am = fmaxf(wave_max(am), 1e-30f);
    const float inv = 127.0f / am;
    if (lane == 0) *scl = am * (1.0f / 127.0f);
#pragma unroll
    for (int i = 0; i < 2; ++i) {
        u32x4 w;
#pragma unroll
        for (int q = 0; q < 4; ++q) {
            const f32x4 t = v[i * 4 + q];
            const float off = sgn ? 0.0f : 128.0f;
            const unsigned b0 = (unsigned)(int)(rintf(t[0] * inv) + off) & 0xffu, b1 = (unsigned)(int)(rintf(t[1] * inv) + off) & 0xffu, b2 = (unsigned)(int)(rintf(t[2] * inv) + off) & 0xffu, b3 = (unsigned)(int)(rintf(t[3] * inv) + off) & 0xffu;
            w[q] = b0 | (b1 << 8) | (b2 << 16) | (b3 << 24);
        }
        *(u32x4*)(dst + 1024 * i + 16 * lane) = w;
    }
}
struct QuantJob { const float* TU; const float* TV; unsigned char* QU; unsigned char* QV; float* SU; float* SV; };
__device__ __forceinline__ const float* qj_src(const QuantJob& q, int r) { return (r < 16384 ? q.TU : q.TV) + (size_t)(r & 16383) * DM; }
__device__ __forceinline__ unsigned char* qj_dst(const QuantJob& q, int r) { return (r < 16384 ? q.QU : q.QV) + (size_t)(r & 16383) * DM; }
__device__ __forceinline__ float* qj_scl(const QuantJob& q, int r) { return (r < 16384 ? q.SU : q.SV) + (r & 16383); }
__device__ __forceinline__ void qj_tail(const QuantJob& q, int done_iters) {
    const int lane = threadIdx.x & 63, gw = blockIdx.x * 8 + (threadIdx.x >> 6), nw = gridDim.x * 8;
    for (int r = gw + done_iters * nw; r < 32768; r += nw) { f32x4 v[8]; qrow_issue(v, qj_src(q, r), lane); qrow_finish(v, qj_dst(q, r), qj_scl(q, r), lane, r >= 16384); }
}
__device__ __forceinline__ float logf_gate(float z, float lb) { return __logf(lb + (1.0f - lb) * sigmoidf_(z)); }
__device__ __forceinline__ void phase_scan_a(LAS unsigned char* lds, const bf16_t* FZ, const float* LB, const bf16_t* I1, bf16_t* LT, float* DEC, const QuantJob qj, unsigned* dbgc = nullptr) {
    unsigned dbg_kt = 0, dbg_acc = 0;
    const int tid = threadIdx.x, lane = tid & 63, wv = tid >> 6, k = tid & 127, part = tid >> 7;
    LAS unsigned char* Iimg = lds; LAS unsigned char* KTimg = lds + 16384;
    LAS float* psum = (LAS float*)(lds + 32768);
    LAS unsigned char* Lst = lds + 36864;
#if SCAN_A_VALU == 2
    for (int item = blockIdx.x; item < 2 * NHEAD * 128; item += gridDim.x) {
        const int bh = item >> 7, c = item & 127, b = bh >> 4, h = bh & 15;
        const size_t tok0 = (size_t)b * SEQ + c * 64;
        for (int idx = tid; idx < 16384; idx += 512) {
            const int v = idx >> 7, kk = idx & 127;
            float g = 1.f, L = 0.f;
            for (int s2 = 63; s2 >= 0; --s2) { const size_t o = (tok0 + s2) * DM + h * 128; const float f = __expf(logf_gate(bf2f(FZ[o + kk]), LB[h * 128 + kk])); L += bf2f(I1[o + v]) * (1.0f - f) * g; g *= f; }
            LT[(size_t)item * 16384 + idx] = (bf16_t)(pk_bf16(L, 0.f) & 0xffffu);
        }
    }
    return;
#endif
    bf16_t nfz[16]; u32x4 nit_[2];
#define SA_LOAD(item_) { const int bh_ = (item_) >> 7, c_ = (item_) & 127; const size_t t0_ = (size_t)(bh_ >> 4) * SEQ + c_ * 64; const int h_ = bh_ & 15; \
        _Pragma("unroll") for (int i = 0; i < 16; ++i) nfz[i] = FZ[(t0_ + 16 * part + i) * DM + h_ * 128 + k]; \
        _Pragma("unroll") for (int r = 0; r < 2; ++r) { const int idx = tid + 512 * r, row = idx >> 4, ch = idx & 15; nit_[r] = *(const u32x4*)(I1 + (t0_ + row) * DM + h_ * 128 + ch * 8); } }
    if ((int)blockIdx.x < 2 * NHEAD * 128) SA_LOAD((int)blockIdx.x)
    int qiter = 0;
    for (int item = blockIdx.x; item < 2 * NHEAD * 128; item += gridDim.x, ++qiter) {
        const int bh = item >> 7, c = item & 127, b = bh >> 4, h = bh & 15;
        const size_t tok0 = (size_t)b * SEQ + c * 64;
        float lf[16];
        const float lbk = LB[h * 128 + k];
#pragma unroll
        for (int i = 0; i < 16; ++i) lf[i] = logf_gate(bf2f(nfz[i]), lbk);
#pragma unroll
        for (int r = 0; r < 2; ++r) { const int idx = tid + 512 * r, row = idx >> 4, ch = idx & 15; *(LAS u32x4*)(Iimg + off_b(row, ch)) = nit_[r]; }
        if (item + (int)gridDim.x < 2 * NHEAD * 128) SA_LOAD(item + (int)gridDim.x)
        const int qrow = qiter * (int)gridDim.x * 8 + (int)blockIdx.x * 8 + wv; const bool doq = qrow < 32768; f32x4 qv8[8];
        if (doq) qrow_issue(qv8, qj_src(qj, qrow), lane);
        float cs = 0.f;
#pragma unroll
        for (int i = 0; i < 16; ++i) cs += lf[i];
        psum[part * 128 + k] = cs;
        __syncthreads();
        const float p0 = psum[k], p1 = psum[128 + k], p2 = psum[256 + k], p3 = psum[384 + k];
        const float blast = (p0 + p1) + (p2 + p3);
        float bb = part == 0 ? 0.f : (part == 1 ? p0 : (part == 2 ? p0 + p1 : p0 + p1 + p2));
#pragma unroll
        for (int i = 0; i < 16; ++i) {
            bb += lf[i];
            const float kt = (1.0f - __expf(lf[i])) * __expf(blast - bb);
            if (!(kt - kt == 0.f)) ++dbg_kt;
            const int srow = 16 * part + i;
            *(LAS bf16_t*)(KTimg + off_b(srow, k >> 3) + 2 * (k & 7)) = (bf16_t)(pk_bf16(kt, 0.f) & 0xffffu);
        }
        if (part == 0) DEC[(size_t)item * 128 + k] = __expf(blast);
        __syncthreads();
#if SCAN_A_VALU
        for (int idx = tid; idx < 16384; idx += 512) {
            const int v = idx >> 7, kk = idx & 127;
            float accv = 0.f;
            for (int s2 = 0; s2 < 64; ++s2) accv += bf2f(*(const LAS bf16_t*)(Iimg + off_b(s2, v >> 3) + 2 * (v & 7))) * bf2f(*(const LAS bf16_t*)(KTimg + off_b(s2, kk >> 3) + 2 * (kk & 7)));
            *(LAS bf16_t*)(Lst + v * 272 + 2 * kk) = (bf16_t)(pk_bf16(accv, 0.f) & 0xffffu);
        }
        if (0)
#endif
        {
            const int vt = wv >> 1;
            f32x16 acc0, acc1;
#pragma unroll
            for (int e = 0; e < 16; ++e) { acc0[e] = 0.f; acc1[e] = 0.f; }
#pragma unroll
            for (int ks = 0; ks < 4; ++ks) {
                const bf16x8 af = tr_frag(Iimg, lane, vt, ks);
                const bf16x8 b0 = tr_frag(KTimg, lane, 2 * (wv & 1), ks), b1 = tr_frag(KTimg, lane, 2 * (wv & 1) + 1, ks);
                acc0 = __builtin_amdgcn_mfma_f32_32x32x16_bf16(af, b0, acc0, 0, 0, 0);
                acc1 = __builtin_amdgcn_mfma_f32_32x32x16_bf16(af, b1, acc1, 0, 0, 0);
            }
            const int r32 = lane & 31, hh = lane >> 5;
#pragma unroll
            for (int e = 0; e < 16; ++e) {
                if (!(acc0[e] - acc0[e] == 0.f)) ++dbg_acc; if (!(acc1[e] - acc1[e] == 0.f)) ++dbg_acc;
                const int v = 32 * vt + (e & 3) + 8 * (e >> 2) + 4 * hh;
                *(LAS bf16_t*)(Lst + v * 272 + 2 * (64 * (wv & 1) + r32)) = (bf16_t)(pk_bf16(acc0[e], 0.f) & 0xffffu);
                *(LAS bf16_t*)(Lst + v * 272 + 2 * (64 * (wv & 1) + 32 + r32)) = (bf16_t)(pk_bf16(acc1[e], 0.f) & 0xffffu);
            }
        }
        __syncthreads();
#pragma unroll
        for (int r = 0; r < 4; ++r) { const int idx = tid + 512 * r, row = idx >> 4, ch = idx & 15; *(u32x4*)(LT + (size_t)item * 16384 + row * 128 + ch * 8) = *(const LAS u32x4*)(Lst + row * 272 + ch * 16); }
        if (doq) qrow_finish(qv8, qj_dst(qj, qrow), qj_scl(qj, qrow), lane, qrow >= 16384);
        __syncthreads();
    }
    qj_tail(qj, qiter);
    if (dbgc) { if (dbg_kt) atomicAdd(dbgc + 0, dbg_kt); if (dbg_acc) atomicAdd(dbgc + 1, dbg_acc); }
}
__device__ __forceinline__ void phase_scan_b(bf16_t* LT, const float* DEC, const QuantJob qj) {
    const int n = 2 * NHEAD * 128 * 32;
    const int lane = threadIdx.x & 63, gw = blockIdx.x * 8 + (threadIdx.x >> 6), nw = gridDim.x * 8;
    int qdone = 0;
    for (int idx = blockIdx.x * 512 + threadIdx.x; idx < n; idx += gridDim.x * 512) {
        const int bh = idx >> 12, vk = idx & 4095, k4 = (vk & 31) * 4;
        float S0 = 0.f, S1 = 0.f, S2 = 0.f, S3 = 0.f;
        bf16_t* p = LT + (size_t)bh * 128 * 16384 + (size_t)vk * 4;
        const float* dp = DEC + (size_t)bh * 128 * 128 + k4;
        for (int c8 = 0; c8 < 16; ++c8) {
            const int qrow = (qdone + c8) * nw + gw; const bool doq = qrow < 32768; f32x4 qv8[8];
            if (doq) qrow_issue(qv8, qj_src(qj, qrow), lane);
#pragma unroll
            for (int c2 = 0; c2 < 8; ++c2) {
                const int c = c8 * 8 + c2;
                const u32x2 w = *(const u32x2*)(p + (size_t)c * 16384);
                const f32x4 d = *(const f32x4*)(dp + c * 128);
                u32x2 o; o.x = pk_bf16(S0, S1); o.y = pk_bf16(S2, S3);
                *(u32x2*)(p + (size_t)c * 16384) = o;
                S0 = d[0] * S0 + bflo(w.x); S1 = d[1] * S1 + bfhi(w.x); S2 = d[2] * S2 + bflo(w.y); S3 = d[3] * S3 + bfhi(w.y);
            }
            if (doq) qrow_finish(qv8, qj_dst(qj, qrow), qj_scl(qj, qrow), lane, qrow >= 16384);
        }
        qdone += 16;
    }
    qj_tail(qj, qdone);
}
__device__ __forceinline__ void phase_scan_c(LAS unsigned char* lds, const bf16_t* Q1, const bf16_t* FZ, const float* LB, const bf16_t* I1, const bf16_t* G1, const bf16_t* SP, const float* gnorm, bf16_t* OG) {
    const int tid = threadIdx.x, lane = tid & 63, wv = tid >> 6, k = tid & 127, part = tid >> 7, r32 = lane & 31, hh = lane >> 5;
    LAS unsigned char* QTimg = lds; LAS unsigned char* QPimg = lds + 16384; LAS unsigned char* KPimg = lds + 32768; LAS unsigned char* Iimg = lds + 49152; LAS unsigned char* SPimg = lds + 65536;
    LAS float* psum = (LAS float*)(lds + 98304);
    LAS float* ssq = (LAS float*)(lds + 100352);
    LAS unsigned char* OT = lds + 102400;
    bf16_t nfz[16], nq[16]; u32x4 nit_[2], nsp[4], ngt[2];
#define SC_LOAD(item_) { const int bh_ = (item_) >> 7, c_ = (item_) & 127; const size_t t0_ = (size_t)(bh_ >> 4) * SEQ + c_ * 64; const int h_ = bh_ & 15; \
        _Pragma("unroll") for (int i = 0; i < 16; ++i) { const size_t o_ = (t0_ + 16 * part + i) * DM + h_ * 128 + k; nfz[i] = FZ[o_]; nq[i] = Q1[o_]; } \
        _Pragma("unroll") for (int r = 0; r < 2; ++r) { const int idx = tid + 512 * r, row = idx >> 4, ch = idx & 15; nit_[r] = *(const u32x4*)(I1 + (t0_ + row) * DM + h_ * 128 + ch * 8); ngt[r] = *(const u32x4*)(G1 + (t0_ + row) * DM + h_ * 128 + ch * 8); } \
        _Pragma("unroll") for (int r = 0; r < 4; ++r) { const int idx = tid + 512 * r, row = idx >> 4, ch = idx & 15; nsp[r] = *(const u32x4*)(SP + (size_t)(item_) * 16384 + row * 128 + ch * 8); } }
    if ((int)blockIdx.x < 2 * NHEAD * 128) SC_LOAD((int)blockIdx.x)
    for (int item = blockIdx.x; item < 2 * NHEAD * 128; item += gridDim.x) {
        const int bh = item >> 7, c = item & 127, b = bh >> 4, h = bh & 15;
        const size_t tok0 = (size_t)b * SEQ + c * 64;
        float lf[16], qv[16];
        const float lbk = LB[h * 128 + k];
#pragma unroll
        for (int i = 0; i < 16; ++i) { lf[i] = logf_gate(bf2f(nfz[i]), lbk); const float qr = bf2f(nq[i]); qv[i] = qr * sigmoidf_(qr); }
#pragma unroll
        for (int r = 0; r < 2; ++r) { const int idx = tid + 512 * r, row = idx >> 4, ch = idx & 15; *(LAS u32x4*)(Iimg + off_b(row, ch)) = nit_[r]; }
#pragma unroll
        for (int r = 0; r < 4; ++r) { const int idx = tid + 512 * r, row = idx >> 4, ch = idx & 15; *(LAS u32x4*)(SPimg + off_b(row, ch)) = nsp[r]; }
        const u32x4 gcur0 = ngt[0], gcur1 = ngt[1];
        if (item + (int)gridDim.x < 2 * NHEAD * 128) SC_LOAD(item + (int)gridDim.x)
        float cs = 0.f;
#pragma unroll
        for (int i = 0; i < 16; ++i) cs += lf[i];
        psum[part * 128 + k] = cs;
        __syncthreads();
        const float p0 = psum[k], p1 = psum[128 + k], p2 = psum[256 + k];
        const float rr = p0 + p1;
        float bb = part == 0 ? 0.f : (part == 1 ? p0 : (part == 2 ? p0 + p1 : p0 + p1 + p2));
#pragma unroll
        for (int i = 0; i < 16; ++i) {
            bb += lf[i];
            const float qt = qv[i] * __expf(bb), qp = qv[i] * __expf(bb - rr), kp = (1.0f - __expf(lf[i])) * __expf(rr - bb);
            const unsigned o = off_b(16 * part + i, k >> 3) + 2 * (k & 7);
            *(LAS bf16_t*)(QTimg + o) = (bf16_t)(pk_bf16(qt, 0.f) & 0xffffu);
            *(LAS bf16_t*)(QPimg + o) = (bf16_t)(pk_bf16(qp, 0.f) & 0xffffu);
            *(LAS bf16_t*)(KPimg + o) = (bf16_t)(pk_bf16(kp, 0.f) & 0xffffu);
        }
        __syncthreads();
        const int tt = wv & 1, vt = wv >> 1;
        f32x16 O;
#pragma unroll
        for (int e = 0; e < 16; ++e) O[e] = 0.f;
#pragma unroll
        for (int ks = 0; ks < 8; ++ks) {
            const bf16x8 af = *(const LAS bf16x8*)(SPimg + off_b(32 * vt + r32, 2 * ks + hh));
            const bf16x8 bf = *(const LAS bf16x8*)(QTimg + off_b(32 * tt + r32, 2 * ks + hh));
            O = __builtin_amdgcn_mfma_f32_32x32x16_bf16(af, bf, O, 0, 0, 0);
        }
        const unsigned krow = pi32((unsigned)r32);
        for (int st = 0; st <= tt; ++st) {
            f32x16 S;
#pragma unroll
            for (int e = 0; e < 16; ++e) S[e] = 0.f;
#pragma unroll
            for (int ks = 0; ks < 8; ++ks) {
                const bf16x8 af = *(const LAS bf16x8*)(KPimg + off_b(32 * st + krow, 2 * ks + hh));
                const bf16x8 bf = *(const LAS bf16x8*)(QPimg + off_b(32 * tt + r32, 2 * ks + hh));
                S = __builtin_amdgcn_mfma_f32_32x32x16_bf16(af, bf, S, 0, 0, 0);
            }
            float p[16];
#pragma unroll
            for (int e = 0; e < 16; ++e) {
                const unsigned m = (e & 3) + 8 * (e >> 2) + 4 * hh;
                const int sidx = 32 * st + (int)pi32(m), tidx = 32 * tt + r32;
                p[e] = sidx <= tidx ? S[e] : 0.f;
            }
            u32x4 w0, w1;
            w0.x = pk_bf16(p[0], p[1]); w0.y = pk_bf16(p[2], p[3]); w0.z = pk_bf16(p[4], p[5]); w0.w = pk_bf16(p[6], p[7]);
            w1.x = pk_bf16(p[8], p[9]); w1.y = pk_bf16(p[10], p[11]); w1.z = pk_bf16(p[12], p[13]); w1.w = pk_bf16(p[14], p[15]);
            const bf16x8 pf0 = __builtin_bit_cast(bf16x8, w0), pf1 = __builtin_bit_cast(bf16x8, w1);
            const bf16x8 i0 = tr_frag(Iimg, lane, vt, 2 * st), i1 = tr_frag(Iimg, lane, vt, 2 * st + 1);
            O = __builtin_amdgcn_mfma_f32_32x32x16_bf16(i0, pf0, O, 0, 0, 0);
            O = __builtin_amdgcn_mfma_f32_32x32x16_bf16(i1, pf1, O, 0, 0, 0);
        }
        float sq = 0.f;
#pragma unroll
        for (int e = 0; e < 16; ++e) sq += O[e] * O[e];
        sq += __shfl_xor(sq, 32);
        if (hh == 0) ssq[vt * 64 + 32 * tt + r32] = sq;
        __syncthreads();
        const int tl = 32 * tt + r32;
        const float rstd = rsqrtf((ssq[tl] + ssq[64 + tl] + ssq[128 + tl] + ssq[192 + tl]) * (1.0f / 128.0f) + 1e-6f);
#pragma unroll
        for (int g = 0; g < 4; ++g) {
            const int v0 = 32 * vt + 8 * g + 4 * hh;
            const f32x4 gn = *(const f32x4*)(gnorm + v0);
            u32x2 w; w.x = pk_bf16(O[4 * g] * rstd * gn[0], O[4 * g + 1] * rstd * gn[1]); w.y = pk_bf16(O[4 * g + 2] * rstd * gn[2], O[4 * g + 3] * rstd * gn[3]);
            *(LAS u32x2*)(OT + tl * 272 + v0 * 2) = w;
        }
        __syncthreads();
#pragma unroll
        for (int r = 0; r < 2; ++r) {
            const int idx = tid + 512 * r, row = idx >> 4, ch = idx & 15;
            const u32x4 ov = *(const LAS u32x4*)(OT + row * 272 + ch * 16);
            const size_t go = (tok0 + row) * DM + h * 128 + ch * 8;
            const u32x4 gv = r == 0 ? gcur0 : gcur1;
            u32x4 w;
#define SILU_(x_) ((x_) * sigmoidf_(x_))
            w.x = pk_bf16(bflo(ov.x) * SILU_(bflo(gv.x)), bfhi(ov.x) * SILU_(bfhi(gv.x))); w.y = pk_bf16(bflo(ov.y) * SILU_(bflo(gv.y)), bfhi(ov.y) * SILU_(bfhi(gv.y)));
            w.z = pk_bf16(bflo(ov.z) * SILU_(bflo(gv.z)), bfhi(ov.z) * SILU_(bfhi(gv.z))); w.w = pk_bf16(bflo(ov.w) * SILU_(bflo(gv.w)), bfhi(ov.w) * SILU_(bfhi(gv.w)));
#undef SILU_
            *(u32x4*)(OG + go) = w;
        }
        __syncthreads();
    }
}


#if SCAN_DBG == 2
__device__ __forceinline__ void dbg_compare(LAS float* red, const bf16_t* A, const bf16_t* B, float* DBG) {
    float sd = 0.f, sr = 0.f, nn = 0.f;
    const size_t n = (size_t)MTOK * DM;
    for (size_t i = (size_t)blockIdx.x * 512 + threadIdx.x; i < n; i += (size_t)gridDim.x * 512) {
        const float x = bf2f(A[i]), y = bf2f(B[i]);
        if (!(x - x == 0.f)) nn += 1.f; else { sd += (x - y) * (x - y); sr += y * y; }
    }
    sd = wave_sum(sd); sr = wave_sum(sr); nn = wave_sum(nn);
    const int wv = threadIdx.x >> 6;
    if ((threadIdx.x & 63) == 0) { red[wv * 3] = sd; red[wv * 3 + 1] = sr; red[wv * 3 + 2] = nn; }
    __syncthreads();
    if (threadIdx.x == 0) { float a = 0, b = 0, c = 0; for (int w = 0; w < 8; ++w) { a += red[w * 3]; b += red[w * 3 + 1]; c += red[w * 3 + 2]; } DBG[blockIdx.x * 4] = a; DBG[blockIdx.x * 4 + 1] = b; DBG[blockIdx.x * 4 + 2] = c; }
    __syncthreads();
}
__device__ __forceinline__ void dbg_emit(const float* DBG, float* out) {
    float a = 0, b = 0, c = 0;
    for (int w = 0; w < (int)gridDim.x; ++w) { a += DBG[w * 4]; b += DBG[w * 4 + 1]; c += DBG[w * 4 + 2]; }
    const float rel = sqrtf(a / b);
    int k = (int)rintf(-2.0f * log10f(rel)); k = k < 0 ? 0 : (k > 16 ? 16 : k);
    if (c > 0.f) k = 17;
    const float cc = sqrtf(0.5f * (float)k);
    const size_t n = (size_t)MTOK * DM;
    for (size_t i = (size_t)blockIdx.x * 512 + threadIdx.x; i < n; i += (size_t)gridDim.x * 512) out[i] = cc;
}
#endif

#if SCAN_DBG == 3
__device__ __forceinline__ void dbg_count_bf16(const bf16_t* A, size_t n, unsigned* cnt) {
    unsigned c = 0;
    for (size_t i = (size_t)blockIdx.x * 512 + threadIdx.x; i < n; i += (size_t)gridDim.x * 512) { const float x = bf2f(A[i]); if (!(x - x == 0.f)) ++c; }
    if (c) atomicAdd(cnt, c);
}
__device__ __forceinline__ void dbg_count_f32(const float* A, size_t n, unsigned* cnt) {
    unsigned c = 0;
    for (size_t i = (size_t)blockIdx.x * 512 + threadIdx.x; i < n; i += (size_t)gridDim.x * 512) { const float x = A[i]; if (!(x - x == 0.f)) ++c; }
    if (c) atomicAdd(cnt, c);
}
__device__ __forceinline__ void dbg_emit3(const unsigned* cnt, float* out) {
    float code = 0.f;
    for (int st = 3; st >= 0; --st) { const unsigned c = cnt[st]; if (c) { float lg = log10f((float)c); lg = lg > 9.f ? 9.f : lg; code = (float)(st + 1) + 0.1f * lg; } }
    const float cc = sqrtf(code);
    const size_t n = (size_t)MTOK * DM;
    for (size_t i = (size_t)blockIdx.x * 512 + threadIdx.x; i < n; i += (size_t)gridDim.x * 512) out[i] = cc;
}
#endif

#if SCAN_DBG == 4 || SCAN_DBG == 6
__device__ __forceinline__ void dbg_compare4(LAS float* red, const bf16_t* A, const bf16_t* B, const bf16_t* C, float* DBG) {
    float sd = 0.f, sr = 0.f, nn = 0.f, mm = 0.f;
    const size_t n = (size_t)MTOK * DM;
    for (size_t i = (size_t)blockIdx.x * 512 + threadIdx.x; i < n; i += (size_t)gridDim.x * 512) {
        const float x = bf2f(A[i]), y = bf2f(B[i]);
        if (!(x - x == 0.f)) nn += 1.f; else { sd += (x - y) * (x - y); sr += y * y; }
        if (A[i] != C[i]) mm += 1.f;
    }
    sd = wave_sum(sd); sr = wave_sum(sr); nn = wave_sum(nn); mm = wave_sum(mm);
    const int wv = threadIdx.x >> 6;
    if ((threadIdx.x & 63) == 0) { red[wv * 4] = sd; red[wv * 4 + 1] = sr; red[wv * 4 + 2] = nn; red[wv * 4 + 3] = mm; }
    __syncthreads();
    if (threadIdx.x == 0) { float a = 0, b = 0, c = 0, d = 0; for (int w = 0; w < 8; ++w) { a += red[w * 4]; b += red[w * 4 + 1]; c += red[w * 4 + 2]; d += red[w * 4 + 3]; }
        DBG[blockIdx.x * 4] = a; DBG[blockIdx.x * 4 + 1] = b; DBG[blockIdx.x * 4 + 2] = c; DBG[blockIdx.x * 4 + 3] = d; }
    __syncthreads();
}
__device__ __forceinline__ void dbg_emit4(const float* DBG, float* out) {
    float a = 0, b = 0, c = 0, d = 0;
    for (int w = 0; w < (int)gridDim.x; ++w) { a += DBG[w * 4]; b += DBG[w * 4 + 1]; c += DBG[w * 4 + 2]; d += DBG[w * 4 + 3]; }
    const float rel = sqrtf(a / b);
    int k = (int)rintf(-log10f(rel)); k = k < 0 ? 0 : (k > 8 ? 8 : k);
#if SCAN_DBG == 6
    const float cc = sqrtf((float)k + ((d + c) > 0.f ? 0.5f : 0.f));
#else
    int m = (int)ceilf(log10f(1.0f + d + c)); m = m > 9 ? 9 : m;
    const float cc = sqrtf((float)k + 0.1f * (float)m);
#endif
    const size_t n = (size_t)MTOK * DM;
    for (size_t i = (size_t)blockIdx.x * 512 + threadIdx.x; i < n; i += (size_t)gridDim.x * 512) out[i] = cc;
}
#endif

#if SCAN_DBG == 5
__device__ __forceinline__ void dbg_lds16_test(LAS unsigned char* lds, unsigned* cnt) {
    const int tid = threadIdx.x;
    unsigned bad = 0;
    for (int rep = 0; rep < 64; ++rep) {
        for (int i = tid; i < 1024; i += 512) *(LAS u32x4*)(lds + i * 16) = (u32x4){0x7fc07fc0u, 0x7fc07fc0u, 0x7fc07fc0u, 0x7fc07fc0u};
        __syncthreads();
        const int k = tid & 127, part = tid >> 7;
#pragma unroll
        for (int i = 0; i < 16; ++i) {
            const int row = 16 * part + i;
            *(LAS bf16_t*)(lds + off_b(row, k >> 3) + 2 * (k & 7)) = (bf16_t)((row * 128 + k + rep) & 0x7fff);
        }
        __syncthreads();
        for (int idx = tid; idx < 64 * 128; idx += 512) {
            const int row = idx >> 7, kk = idx & 127;
            const bf16_t got = *(const LAS bf16_t*)(lds + off_b(row, kk >> 3) + 2 * (kk & 7));
            if (got != (bf16_t)((row * 128 + kk + rep) & 0x7fff)) ++bad;
        }
        __syncthreads();
    }
    if (bad) atomicAdd(cnt, bad);
}
__device__ __forceinline__ void dbg_emit5(const unsigned* cnt, float* out) {
    const unsigned c = cnt[0];
    float code = 0.f;
    if (c) { float lg = log10f((float)c); code = 1.0f + (lg > 8.9f ? 8.9f : lg); }
    const float cc = sqrtf(code);
    const size_t n = (size_t)MTOK * DM;
    for (size_t i = (size_t)blockIdx.x * 512 + threadIdx.x; i < n; i += (size_t)gridDim.x * 512) out[i] = cc;
}
#endif

#if SCAN_DBG == 6
__device__ __forceinline__ void dbg_check_a(LAS float* red, const float* LF, const bf16_t* I1, const bf16_t* LT, const bf16_t* LT2, float* DBG) {
    float sd = 0.f, sr = 0.f, mm = 0.f;
    const size_t n = (size_t)4096 * 16384;
    for (size_t i = (size_t)blockIdx.x * 512 + threadIdx.x; i < n; i += (size_t)gridDim.x * 512) {
        const int item = (int)(i >> 14), v = (int)((i >> 7) & 127), k = (int)(i & 127);
        const int bh = item >> 7, c = item & 127, b = bh >> 4, h = bh & 15;
        const size_t tok0 = (size_t)b * SEQ + c * 64;
        float g = 1.f, L = 0.f;
        for (int s2 = 63; s2 >= 0; --s2) {
            const size_t o = (tok0 + s2) * DM + h * 128;
            const float f = __expf(LF[o + k]);
            L += bf2f(I1[o + v]) * (1.0f - f) * g;
            g *= f;
        }
        const float x = bf2f(LT[i]);
        sd += (x - L) * (x - L); sr += L * L;
        if (LT[i] != LT2[i]) mm += 1.f;
    }
    sd = wave_sum(sd); sr = wave_sum(sr); mm = wave_sum(mm);
    const int wv = threadIdx.x >> 6;
    if ((threadIdx.x & 63) == 0) { red[wv * 4] = sd; red[wv * 4 + 1] = sr; red[wv * 4 + 2] = 0.f; red[wv * 4 + 3] = mm; }
    __syncthreads();
    if (threadIdx.x == 0) { float a = 0, b2 = 0, d = 0; for (int w = 0; w < 8; ++w) { a += red[w * 4]; b2 += red[w * 4 + 1]; d += red[w * 4 + 3]; }
        DBG[blockIdx.x * 4] = a; DBG[blockIdx.x * 4 + 1] = b2; DBG[blockIdx.x * 4 + 2] = 0.f; DBG[blockIdx.x * 4 + 3] = d; }
    __syncthreads();
}
#endif

#if SCAN_DBG == 7
#ifndef DBG_FAM
#define DBG_FAM 0
#endif
__device__ __forceinline__ void dbg_check_a7(const float* LF, const bf16_t* I1, const bf16_t* LT, float* DBG) {
    const size_t n = (size_t)4096 * 16384;
    float nbad = 0.f, nnf = 0.f;
    for (size_t i = (size_t)blockIdx.x * 512 + threadIdx.x; i < n; i += (size_t)gridDim.x * 512 * 8) {
        const int item = (int)(i >> 14), v = (int)((i >> 7) & 127), k = (int)(i & 127);
        const int bh = item >> 7, c = item & 127, b = bh >> 4, h = bh & 15;
        const size_t tok0 = (size_t)b * SEQ + c * 64;
        float g = 1.f, L = 0.f;
        for (int s2 = 63; s2 >= 0; --s2) {
            const size_t o = (tok0 + s2) * DM + h * 128;
            const float f = __expf(LF[o + k]);
            L += bf2f(I1[o + v]) * (1.0f - f) * g;
            g *= f;
        }
        const float x = bf2f(LT[i]);
        if (!(x - x == 0.f)) { nnf += 1.f; nbad += 1.f; }
        else if (fabsf(x - L) > 0.02f * fabsf(L) + 1e-2f) nbad += 1.f;
    }
    nbad = wave_sum(nbad); nnf = wave_sum(nnf);
    if ((threadIdx.x & 63) == 0) { atomicAdd(DBG, nbad); atomicAdd(DBG + 1, nnf); }
}
__device__ __forceinline__ void dbg_emit7(const float* DBG, float* out) {
    const float nb = DBG[0], nf = DBG[1];
    int A = nb == 0.f ? 0 : (nb <= 100.f ? 1 : (nb <= 1e4f ? 3 : (nb <= 1e6f ? 5 : 7)));
    int B = nf == 0.f ? 0 : 5;
    const float cc = sqrtf((float)A + 0.1f * (float)B);
    const size_t n = (size_t)MTOK * DM;
    for (size_t i = (size_t)blockIdx.x * 512 + threadIdx.x; i < n; i += (size_t)gridDim.x * 512) out[i] = cc;
}
#endif
__device__ __forceinline__ int opaque(int v) { asm volatile("" : "+s"(v)); return v; }
template <bool L1> __device__ __forceinline__ void run_gemm_out(const Args& a, LAS unsigned char* lds) {
    unsigned char* ws = a.ws;
    pg8::Gemm g{(const bf16_t*)(ws + (L1 ? slot(3) : slot(0))), (const bf16_t*)(ws + (L1 ? WS_WO : WS_WOUT)), opaque(MTOK), opaque(DM), opaque(DM)};
    pg8::StaticOrder S; S.init(g.M, g.N, (int)gridDim.x, (int)blockIdx.x);
    EpiKVQ E{(bf16_t*)(ws + (L1 ? slot(4) : slot(1))), nullptr, nullptr};
    pg8::gemm_phase<EpiKVQ, pg8::StaticOrder>(lds, g, S, E, nullptr);
}
template <bool L1> __device__ __forceinline__ void run_ln(const Args& a) {
    unsigned char* ws = a.ws;
    phase_ln<L1>((const bf16_t*)(ws + (L1 ? slot(4) : slot(1))), L1 ? (const void*)(ws + slot(2)) : (const void*)a.in[0], a.in[12] + (L1 ? 2 : 0) * DM, a.in[13] + (L1 ? 2 : 0) * DM,
                 (float*)nullptr, (bf16_t*)(ws + (L1 ? slot(8) : slot(5))), (signed char*)(ws + WS_XQ), (float*)(ws + WS_XS));
}
template <bool L1> __device__ __forceinline__ void run_gemm_sc(const Args& a, LAS unsigned char* lds) {
    unsigned char* ws = a.ws;
    pg8::Gemm g{(const bf16_t*)(ws + WS_WC) + (L1 ? (size_t)DM * DM : 0), (const bf16_t*)(ws + (L1 ? slot(8) : slot(5))), opaque(DM), opaque(MTOK), opaque(DM)};
    pg8::StaticOrder S; S.init(g.M, g.N, (int)gridDim.x, (int)blockIdx.x);
    EpiF32 E{(float*)(ws + (L1 ? slot(0) : slot(6))), MTOK};
    pg8::gemm_phase<EpiF32, pg8::StaticOrder>(lds, g, S, E, nullptr);
}
template <bool L1> __device__ __forceinline__ void run_topk(const Args& a, LAS unsigned char* lds) {
    unsigned char* ws = a.ws;
    phase_topk(lds, (const float*)(ws + (L1 ? slot(0) : slot(6))), (int*)(ws + WS_EID), (float*)(ws + WS_GATE));
}
template <bool L1> __device__ __forceinline__ void run_peer(const Args& a, LAS unsigned char* lds) {
    unsigned char* ws = a.ws;
    LAS int* HL = (LAS int*)(lds + (threadIdx.x >> 6) * 8192);
    float* Y = (float*)(ws + (L1 ? slot(0) : slot(6)));
    phase_peer_u((const signed char*)(ws + WS_XQ), (const int*)(ws + WS_EID), ws + WS_UB + (L1 ? (size_t)16384 * DM : 0), HL);
    asm volatile("s_waitcnt vmcnt(0) lgkmcnt(0)" ::: "memory");
    phase_peer_w(HL, (const float*)(ws + WS_XS), (const int*)(ws + WS_EID), (const float*)(ws + WS_GATE),
                 (const float*)(ws + WS_USC) + (L1 ? 16384 : 0), (const float*)(ws + WS_VSC) + (L1 ? 16384 : 0), (signed char*)(ws + WS_W), (float*)(ws + WS_CS));
    asm volatile("s_waitcnt vmcnt(0)" ::: "memory");
    phase_peer_v((const bf16_t*)(ws + (L1 ? slot(8) : slot(5))), (const int*)(ws + WS_EID), (const signed char*)(ws + WS_W), (const float*)(ws + WS_CS),
                 ws + WS_VB + (L1 ? (size_t)16384 * DM : 0), Y);
    asm volatile("s_waitcnt vmcnt(0)" ::: "memory");
    {
        const int lane = threadIdx.x & 63, gw = blockIdx.x * 8 + (threadIdx.x >> 6), nw = gridDim.x * 8, tpw = (MTOK + nw - 1) / nw, tbase = gw * tpw;
        const int tend = tbase + tpw < MTOK ? tbase + tpw : MTOK;
        const float* g = a.in[12] + (L1 ? 3 : 1) * DM; const float* bta = a.in[13] + (L1 ? 3 : 1) * DM;
        float* outf = L1 ? a.out : (float*)nullptr; bf16_t* outb = L1 ? (bf16_t*)nullptr : (bf16_t*)(ws + slot(2));
        for (int row = tbase; row < tend; ++row) {
            float v[32];
            const float* p = Y + (size_t)row * DM;
#pragma unroll
            for (int i = 0; i < 4; ++i) {
                const f32x4 x0 = *(const f32x4*)(p + 512 * i + 8 * lane), x1 = *(const f32x4*)(p + 512 * i + 8 * lane + 4);
#pragma unroll
                for (int j = 0; j < 4; ++j) { v[i * 8 + j] = x0[j]; v[i * 8 + 4 + j] = x1[j]; }
            }
            ln_row_store(v, g, bta, outf ? outf + (size_t)row * DM : nullptr, outb ? outb + (size_t)row * DM : nullptr, lane);
        }
    }
}


#define XB_TMO      128
#define XB_XCNT(j)  (256  + 64 * (j))
#define XB_XSUB(j)  (1280 + 64 * (j))
#define XB_XGEN(j)  (2304 + 64 * (j))
#define XB_TOP      3328
#define XB_TOPGEN   3392
#define XCD_BAR_WORDS 3456
#define XB_SPIN_CAP (1u << 20)
__device__ __forceinline__ unsigned xb_ld(unsigned* p)              { return __hip_atomic_load(p, __ATOMIC_RELAXED, __HIP_MEMORY_SCOPE_AGENT); }
__device__ __forceinline__ unsigned xb_add(unsigned* p, unsigned v) { return __hip_atomic_fetch_add(p, v, __ATOMIC_RELAXED, __HIP_MEMORY_SCOPE_AGENT); }
__device__ __forceinline__ unsigned xb_xcc_id() { return (unsigned)__builtin_amdgcn_s_getreg((3 << 11) | 20) & 0xFu; }
#define XB_SPIN(cond, bar) do { unsigned _sp = 0; while (cond) { __builtin_amdgcn_s_sleep(1); \
    if ((++_sp & 255u) == 0u) { if (xb_ld(&(bar)[XB_TMO])) break; if (_sp > XB_SPIN_CAP) { atomicAdd(&(bar)[XB_TMO], 1u); break; } } } } while (0)
struct XcdBarrier { unsigned* bar; unsigned x; volatile LAS unsigned* st; };
__device__ __forceinline__ XcdBarrier xcd_barrier_post(unsigned* bar, volatile LAS unsigned* st) {
    XcdBarrier b; b.bar = bar; b.x = xb_xcc_id(); b.st = st;
    if (threadIdx.x == 0) (void)xb_add(&bar[XB_XCNT(b.x)], 1u);
    return b;
}
__device__ __forceinline__ void xcd_barrier_complete(unsigned* bar, unsigned x, unsigned& nloc, unsigned& nx) {
    const unsigned G = gridDim.x * gridDim.y * gridDim.z;
    unsigned sum, cnt, mine, sp = 0u;
    for (;;) {
        sum = 0u; cnt = 0u; mine = 0u;
#pragma unroll
        for (unsigned j = 0; j < 16; ++j) { const unsigned c = xb_ld(&bar[XB_XCNT(j)]); sum += c; cnt += (c > 0u) ? 1u : 0u; mine = (j == x) ? c : mine; }
        if (sum == G) break;
        __builtin_amdgcn_s_sleep(1);
        if ((++sp & 255u) == 0u) { if (xb_ld(&bar[XB_TMO])) break; if (sp > XB_SPIN_CAP) { atomicAdd(&bar[XB_TMO], 1u); break; } }
    }
    nloc = mine > 0u ? mine : 1u; nx = cnt > 0u ? cnt : 1u;
}
__device__ __forceinline__ void xcd_barrier(const XcdBarrier& b) {
    asm volatile("s_waitcnt vmcnt(0)" ::: "memory");
    __syncthreads();
    if (threadIdx.x == 0) {
        unsigned* bar = b.bar;
        __builtin_amdgcn_s_waitcnt(0);
        unsigned nloc = b.st[0], nx = b.st[1];
        if (nloc == 0u) { xcd_barrier_complete(bar, b.x, nloc, nx); b.st[0] = nloc; b.st[1] = nx; }
        const unsigned old = xb_add(&bar[XB_XSUB(b.x)], 1u);
        const unsigned gen = old / nloc;
        if (old + 1u == (gen + 1u) * nloc) {
            __builtin_amdgcn_fence(__ATOMIC_RELEASE, "agent");
            asm volatile("s_waitcnt vmcnt(0)" ::: "memory");
            const unsigned og = xb_add(&bar[XB_TOP], 1u);
            const unsigned tg = og / nx;
            if (og + 1u == (tg + 1u) * nx) xb_add(&bar[XB_TOPGEN], 1u);
            else XB_SPIN(xb_ld(&bar[XB_TOPGEN]) == tg, bar);
            __builtin_amdgcn_fence(__ATOMIC_ACQUIRE, "agent");
            xb_add(&bar[XB_XGEN(b.x)], 1u);
            asm volatile("s_waitcnt vmcnt(0)" ::: "memory");
        } else {
            XB_SPIN(xb_ld(&bar[XB_XGEN(b.x)]) == gen, bar);
            __builtin_amdgcn_fence(__ATOMIC_ACQUIRE, "agent");
            asm volatile("s_waitcnt vmcnt(0)" ::: "memory");
        }
    }
    __syncthreads();
}

__global__ void __launch_bounds__(512, 2) mk_fwd(Args a) {
    extern __shared__ __attribute__((aligned(16))) unsigned char lds_raw[];
    LAS unsigned char* lds = (LAS unsigned char*)lds_raw;
    cg::grid_group grid = cg::this_grid();
    unsigned char* ws = a.ws;
#define PHASE_BEGIN(k) if (a.ph_lo <= (k) && (k) < a.ph_hi && EN(k)) {
    volatile LAS unsigned* xb_st = (volatile LAS unsigned*)(lds + LDS_BYTES - 16);
    if (threadIdx.x < 4) xb_st[threadIdx.x] = 0u;
    unsigned* xb_words = (unsigned*)(ws + WS_BAR);
    __syncthreads();
    XcdBarrier xbar = xcd_barrier_post(xb_words, xb_st);
    if (a.ph_lo < 0) grid.sync();
#define PHASE_END(k) if ((k) + 1 < a.ph_hi) xcd_barrier(xbar); }
    PHASE_BEGIN(0) phase_prep(a, lds);
#if SCAN_DBG == 3 || SCAN_DBG == 5
        if (blockIdx.x == 0 && threadIdx.x < 8) ((unsigned*)(ws + WS_CTR + 8192))[threadIdx.x] = 0u;
#endif
#if SCAN_DBG == 7
        if (blockIdx.x == 0 && threadIdx.x < 32) ((float*)(ws + WS_CTR + 4096))[threadIdx.x] = 0.f;
#endif
    PHASE_END(0)
#if SCAN_DBG == 5
    PHASE_BEGIN(1) dbg_lds16_test(lds, (unsigned*)(ws + WS_CTR + 8192)); PHASE_END(1)
#define SKIP_REST 1
#endif
    PHASE_BEGIN(1) {
        pg8::Gemm g{(const bf16_t*)(ws + slot(0)), (const bf16_t*)(ws + WS_WIN), opaque(MTOK), opaque(4 * DM), opaque(DM)};
        pg8::StaticOrder S; S.init(g.M, g.N, (int)gridDim.x, (int)blockIdx.x);
        EpiKVQ E{(bf16_t*)(ws + slot(1)), (bf16_t*)(ws + slot(2)), (bf16_t*)(ws + slot(3))};
        pg8::gemm_phase<EpiKVQ, pg8::StaticOrder>(lds, g, S, E, nullptr);
    } PHASE_END(1)
    PHASE_BEGIN(2) phase_scan_a(lds, (const bf16_t*)(ws + slot(2)), (const float*)(ws + WS_LB), (const bf16_t*)(ws + slot(3)), (bf16_t*)(ws + slot(6)), (float*)(ws + WS_DEC), QuantJob{a.in[10], a.in[11], ws + WS_UB, ws + WS_VB, (float*)(ws + WS_USC), (float*)(ws + WS_VSC)}
#if SCAN_DBG == 3
        , (unsigned*)(ws + WS_CTR + 8192)
#endif
        );
#if SCAN_DBG == 7
        asm volatile("s_waitcnt vmcnt(0)" ::: "memory"); __syncthreads(); grid.sync(); if (threadIdx.x < 64) { __builtin_amdgcn_fence(__ATOMIC_ACQUIRE, "agent"); asm volatile("s_waitcnt vmcnt(0)" ::: "memory"); } __syncthreads();
        dbg_check_a7((const float*)(ws + slot(4)), (const bf16_t*)(ws + slot(2)), (const bf16_t*)(ws + slot(6)), (float*)(ws + WS_CTR + 4096));
#endif
#if SCAN_DBG == 6
#define DSYNC6() asm volatile("s_waitcnt vmcnt(0)" ::: "memory"); __syncthreads(); grid.sync(); if (threadIdx.x < 64) { __builtin_amdgcn_fence(__ATOMIC_ACQUIRE, "agent"); asm volatile("s_waitcnt vmcnt(0)" ::: "memory"); } __syncthreads();
        DSYNC6()
        phase_scan_a(lds, (const bf16_t*)(ws + slot(2)), (const float*)(ws + WS_LB), (const bf16_t*)(ws + slot(3)), (bf16_t*)a.out, (float*)(ws + WS_DEC), QuantJob{a.in[10], a.in[11], ws + WS_UB, ws + WS_VB, (float*)(ws + WS_USC), (float*)(ws + WS_VSC)});
        DSYNC6()
        dbg_check_a((LAS float*)lds, (const float*)(ws + slot(4)), (const bf16_t*)(ws + slot(2)), (const bf16_t*)(ws + slot(6)), (const bf16_t*)a.out, (float*)(ws + WS_CTR + 4096));
#endif
#if SCAN_DBG == 3
        asm volatile("s_waitcnt vmcnt(0)" ::: "memory"); __syncthreads(); grid.sync();
        dbg_count_bf16((const bf16_t*)(ws + slot(6)), (size_t)4096 * 16384, (unsigned*)(ws + WS_CTR + 8192) + 2);
#endif
    PHASE_END(2)
    PHASE_BEGIN(3) phase_scan_b((bf16_t*)(ws + slot(6)), (const float*)(ws + WS_DEC), QuantJob{a.in[10] + (size_t)16384 * DM, a.in[11] + (size_t)16384 * DM, ws + WS_UB + (size_t)16384 * DM, ws + WS_VB + (size_t)16384 * DM, (float*)(ws + WS_USC) + 16384, (float*)(ws + WS_VSC) + 16384});
#if SCAN_DBG == 3
        asm volatile("s_waitcnt vmcnt(0)" ::: "memory"); __syncthreads(); grid.sync();

#endif
    PHASE_END(3)
    PHASE_BEGIN(4) phase_scan_c(lds, (const bf16_t*)(ws + slot(1)), (const bf16_t*)(ws + slot(2)), (const float*)(ws + WS_LB), (const bf16_t*)(ws + slot(3)), (const bf16_t*)(ws + slot(4)), (const bf16_t*)(ws + slot(6)), a.in[2], (bf16_t*)(ws + slot(0)));
#if SCAN_DBG == 1
        asm volatile("s_waitcnt vmcnt(0)" ::: "memory"); __syncthreads(); grid.sync();
        phase_scan_naive((const bf16_t*)(ws + slot(1)), (const float*)(ws + slot(4)), (const bf16_t*)(ws + slot(2)), (float*)(ws + slot(6)));
        asm volatile("s_waitcnt vmcnt(0)" ::: "memory"); __syncthreads(); grid.sync();
        phase_onorm((const float*)(ws + slot(6)), (const bf16_t*)(ws + slot(3)), a.in[2], (bf16_t*)(ws + slot(0)));
#endif
#if SCAN_DBG == 3
        asm volatile("s_waitcnt vmcnt(0)" ::: "memory"); __syncthreads(); grid.sync();

#endif
#if SCAN_DBG == 4
#define DSYNC() asm volatile("s_waitcnt vmcnt(0)" ::: "memory"); __syncthreads(); grid.sync(); if (threadIdx.x < 64) { __builtin_amdgcn_fence(__ATOMIC_ACQUIRE, "agent"); asm volatile("s_waitcnt vmcnt(0)" ::: "memory"); } __syncthreads();
        DSYNC()
        phase_scan_naive((const bf16_t*)(ws + slot(1)), (const float*)(ws + slot(4)), (const bf16_t*)(ws + slot(2)), (float*)(ws + slot(6)));
        DSYNC()
        phase_onorm((const float*)(ws + slot(6)), (const bf16_t*)(ws + slot(3)), a.in[2], (bf16_t*)(ws + slot(8)));
        DSYNC()
        phase_scan_a(lds, (const bf16_t*)(ws + slot(2)), (const float*)(ws + WS_LB), (const bf16_t*)(ws + slot(3)), (bf16_t*)(ws + slot(6)), (float*)(ws + WS_DEC), QuantJob{a.in[10], a.in[11], ws + WS_UB, ws + WS_VB, (float*)(ws + WS_USC), (float*)(ws + WS_VSC)});
        DSYNC()
        phase_scan_b((bf16_t*)(ws + slot(6)), (const float*)(ws + WS_DEC), QuantJob{a.in[10] + (size_t)16384 * DM, a.in[11] + (size_t)16384 * DM, ws + WS_UB + (size_t)16384 * DM, ws + WS_VB + (size_t)16384 * DM, (float*)(ws + WS_USC) + 16384, (float*)(ws + WS_VSC) + 16384});
        DSYNC()
        phase_scan_c(lds, (const bf16_t*)(ws + slot(1)), (const bf16_t*)(ws + slot(2)), (const float*)(ws + WS_LB), (const bf16_t*)(ws + slot(3)), (const bf16_t*)(ws + slot(4)), (const bf16_t*)(ws + slot(6)), a.in[2], (bf16_t*)a.out);
        DSYNC()
        dbg_compare4((LAS float*)lds, (const bf16_t*)(ws + slot(0)), (const bf16_t*)(ws + slot(8)), (const bf16_t*)a.out, (float*)(ws + WS_CTR + 4096));
#endif
#if SCAN_DBG == 2
        asm volatile("s_waitcnt vmcnt(0)" ::: "memory"); __syncthreads(); grid.sync();
        phase_scan_naive((const bf16_t*)(ws + slot(1)), (const float*)(ws + slot(4)), (const bf16_t*)(ws + slot(2)), (float*)(ws + slot(6)));
        asm volatile("s_waitcnt vmcnt(0)" ::: "memory"); __syncthreads(); grid.sync();
        phase_onorm((const float*)(ws + slot(6)), (const bf16_t*)(ws + slot(3)), a.in[2], (bf16_t*)(ws + slot(8)));
        asm volatile("s_waitcnt vmcnt(0)" ::: "memory"); __syncthreads(); grid.sync();
        dbg_compare((LAS float*)lds, (const bf16_t*)(ws + slot(0)), (const bf16_t*)(ws + slot(8)), (float*)(ws + WS_CTR + 4096));
#endif
    PHASE_END(4)
    PHASE_BEGIN(5) run_gemm_out<false>(a, lds); PHASE_END(5)
    PHASE_BEGIN(6) run_ln<false>(a); PHASE_END(6)
    PHASE_BEGIN(7) run_gemm_sc<false>(a, lds); PHASE_END(7)
    PHASE_BEGIN(8) run_topk<false>(a, lds); PHASE_END(8)
    PHASE_BEGIN(9) run_peer<false>(a, lds); PHASE_END(9)
    PHASE_BEGIN(10) {
        pg8::Gemm g{(const bf16_t*)(ws + slot(2)), (const bf16_t*)(ws + WS_WKVQ), opaque(MTOK), opaque(3 * DM), opaque(DM)};
        pg8::StaticOrder S; S.init(g.M, g.N, (int)gridDim.x, (int)blockIdx.x);
        EpiKVQR E{(bf16_t*)(ws + slot(3)), (const float*)(ws + WS_COS), (const float*)(ws + WS_SIN)};
        pg8::gemm_phase<EpiKVQR, pg8::StaticOrder>(lds, g, S, E, nullptr);
    } PHASE_END(10)
    PHASE_BEGIN(11) phase_kstat((LAS float*)lds, (const bf16_t*)(ws + slot(3)), (float*)(ws + WS_KMEAN), (float*)(ws + WS_KNMAX)); PHASE_END(11)
    PHASE_BEGIN(12) phase_sel(lds, (const bf16_t*)(ws + slot(5)), (const float*)(ws + WS_KMEAN), (unsigned short*)(ws + WS_SUB), (int*)(ws + WS_CNT), (int*)(ws + WS_CTR)); PHASE_END(12)
    PHASE_BEGIN(13) phase_att(lds, (const bf16_t*)(ws + slot(5)), (const bf16_t*)(ws + slot(3)), (const bf16_t*)(ws + slot(4)), (const float*)(ws + WS_KNMAX), (const unsigned short*)(ws + WS_SUB),
                              (const int*)(ws + WS_CNT), (int*)(ws + WS_CTR), (bf16_t*)(ws + slot(6)), (bf16_t*)(ws + slot(0)), (float*)(ws + WS_LS)); PHASE_END(13)
    PHASE_BEGIN(14) phase_comb((const bf16_t*)(ws + slot(6)), (const bf16_t*)(ws + slot(0)), (const float*)(ws + WS_LS), (bf16_t*)(ws + slot(3))); PHASE_END(14)
    PHASE_BEGIN(15) run_gemm_out<true>(a, lds); PHASE_END(15)
    PHASE_BEGIN(16) run_ln<true>(a); PHASE_END(16)
    PHASE_BEGIN(17) run_gemm_sc<true>(a, lds); PHASE_END(17)
    PHASE_BEGIN(18) run_topk<true>(a, lds); PHASE_END(18)
#if SCAN_DBG == 7
    PHASE_BEGIN(19) dbg_emit7((const float*)(ws + WS_CTR + 4096), a.out); PHASE_END(19)
#elif SCAN_DBG == 6
    PHASE_BEGIN(19) dbg_emit4((const float*)(ws + WS_CTR + 4096), a.out); PHASE_END(19)
#elif SCAN_DBG == 5
    PHASE_BEGIN(19) dbg_emit5((const unsigned*)(ws + WS_CTR + 8192), a.out); PHASE_END(19)
#elif SCAN_DBG == 4
    PHASE_BEGIN(19) dbg_emit4((const float*)(ws + WS_CTR + 4096), a.out); PHASE_END(19)
#elif SCAN_DBG == 3
    PHASE_BEGIN(19) dbg_emit3((const unsigned*)(ws + WS_CTR + 8192), a.out); PHASE_END(19)
#elif SCAN_DBG == 2
    PHASE_BEGIN(19) dbg_emit((const float*)(ws + WS_CTR + 4096), a.out); PHASE_END(19)
#else
    PHASE_BEGIN(19) run_peer<true>(a, lds); PHASE_END(19)
#endif
}

extern "C" void kernel_launch(void* const* d_in, const int* in_sizes, int n_in, void* d_out, int out_size, void* d_ws, size_t ws_size, hipStream_t stream) {
    static int grid = 0;
    if (grid == 0) {
        if (n_in != 14 || out_size != MTOK * DM || ws_size < WS_END) { fprintf(stderr, "kernel_launch: unexpected shapes (n_in %d, out %d, ws %zu)\n", n_in, out_size, ws_size); grid = -1; return; }
        int dev = 0, cus = 0, per_cu = 0;
        if (hipGetDevice(&dev) != hipSuccess || hipDeviceGetAttribute(&cus, hipDeviceAttributeMultiprocessorCount, dev) != hipSuccess) { grid = -1; return; }
        if (hipFuncSetAttribute((const void*)mk_fwd, hipFuncAttributeMaxDynamicSharedMemorySize, LDS_BYTES) != hipSuccess) { fprintf(stderr, "kernel_launch: hipFuncSetAttribute failed\n"); grid = -1; return; }
        if (hipOccupancyMaxActiveBlocksPerMultiprocessor(&per_cu, (const void*)mk_fwd, 512, LDS_BYTES) != hipSuccess || per_cu < 1) { fprintf(stderr, "kernel_launch: occupancy query failed (%d)\n", per_cu); (void)hipGetLastError(); per_cu = 1; }
        grid = cus * (per_cu > 1 ? 1 : per_cu);
    }
    if (grid < 0) return;
    Args a{};
    for (int i = 0; i < 14; ++i) a.in[i] = (const float*)d_in[i];
    a.out = (float*)d_out; a.ws = (unsigned char*)d_ws;
#if ONE_LAUNCH
    a.ph_lo = 0; a.ph_hi = NPH;
    (void)hipMemsetAsync((unsigned char*)d_ws + WS_BAR, 0, XCD_BAR_WORDS * sizeof(unsigned), stream);
    void* args[] = {&a};
    hipError_t e = hipLaunchCooperativeKernel((const void*)mk_fwd, dim3(grid), dim3(512), args, LDS_BYTES, stream);
    if (e != hipSuccess) fprintf(stderr, "cooperative launch failed: %s (grid %d)\n", hipGetErrorString(e), grid);
#else
    for (int ph = 0; ph < NPH; ++ph) {
        a.ph_lo = ph; a.ph_hi = ph + 1;
        hipLaunchKernelGGL(mk_fwd, dim3(grid), dim3(512), LDS_BYTES, stream, a);
    }
#endif
}
```

```cpp
#define ONE_LAUNCH 1
#include <hip/hip_runtime.h>
#include <hip/hip_cooperative_groups.h>
#include <cstdio>
namespace cg = cooperative_groups;

#ifndef ONE_LAUNCH
#define ONE_LAUNCH 0
#endif
#ifndef SCAN_DBG
#define SCAN_DBG 0
#endif
#ifndef SCAN_A_VALU
#define SCAN_A_VALU 0
#endif
#ifndef ENMASK
#define ENMASK 0xffffffffu
#endif
#define EN(k) ((ENMASK >> (k)) & 1u)

namespace pg8 {
#define PG8_LAS __attribute__((address_space(3)))
typedef unsigned short bf16_t;
typedef short bf16x8 __attribute__((ext_vector_type(8)));
typedef float f32x4 __attribute__((ext_vector_type(4)));
typedef unsigned u32x4 __attribute__((ext_vector_type(4)));
constexpr int BM = 256, BK = 64, HALF = 128, HTB = HALF * BK * 2  , STAGE_BYTES = 8 * HTB, NXCD = 8, WGM = 8;

__host__ __device__ __forceinline__ int lds_byte(int r, int c) { const int st = (r >> 4) * 2 + (c >> 5), rr = r & 15, cc = c & 31, ob = rr * 64 + cc * 2; return st * 1024 + (ob ^ (((ob >> 9) & 1) << 5)); }
__host__ __device__ __forceinline__ void stage_rc(int b, int& R, int& C) { const int st = b / 1024, sb = b % 1024, swz = sb ^ (((sb >> 9) & 1) << 5); R = (st >> 1) * 16 + swz / 64; C = (st & 1) * 32 + (swz % 64) / 2; }
__host__ __device__ __forceinline__ int perm32(int rho) { const int n = rho >> 4, i = rho & 15; return 8 * (i >> 2) + 4 * n + (i & 3); }

struct Unit { int pm, pn; };
struct Gemm { const bf16_t* A; const bf16_t* Bt; int M, N, K; };

struct StaticOrder {
    int nM, nN, nwg, G, c;
    __host__ __device__ void init(int M, int N, int G_, int c_) { nM = M / BM; nN = N / BM; nwg = nM * nN; G = G_; c = c_; }
    __host__ __device__ bool next(int i, Unit& u) const {
        const long L = (long)i * G + c; if (L >= nwg) return false;
        int wgid = (int)L; { const int q = nwg / NXCD, r = nwg % NXCD, xcd = wgid % NXCD, off = wgid / NXCD; wgid = (xcd < r ? xcd * (q + 1) : r * (q + 1) + (xcd - r) * q) + off; }
        const int nig = WGM * nN, gid = wgid / nig, fm = gid * WGM, gsz = (nM - fm) < WGM ? (nM - fm) : WGM;
        u.pm = fm + ((wgid % nig) % gsz); u.pn = (wgid % nig) / gsz; return true;
    }
    __device__ __forceinline__ void a_ready(const Unit&) const {}
    __device__ __forceinline__ void done(const Unit&) const {}
};
struct CountedOrder : StaticOrder {
    const unsigned* ready; unsigned need; unsigned* tmo;
    __device__ __forceinline__ void a_ready(const Unit& u) const {
        if (threadIdx.x < 64) {
            const unsigned long long t0 = __builtin_amdgcn_s_memrealtime(); unsigned polls = 0;
            while ((unsigned)__builtin_amdgcn_readfirstlane(__hip_atomic_load(ready + 64 * u.pm, __ATOMIC_RELAXED, __HIP_MEMORY_SCOPE_AGENT)) < need) {
                if ((++polls & 255u) == 0u && __builtin_amdgcn_readfirstlane(__hip_atomic_load(tmo, __ATOMIC_RELAXED, __HIP_MEMORY_SCOPE_AGENT)) != 0u) break;
                if (__builtin_amdgcn_s_memrealtime() - t0 > 2000000ull) {
                    if (threadIdx.x == 0) { unsigned expect = 0u; __hip_atomic_compare_exchange_strong(tmo + 1, &expect, 0x600u | (unsigned)(u.pm & 0xff), __ATOMIC_RELAXED, __ATOMIC_RELAXED, __HIP_MEMORY_SCOPE_AGENT); __hip_atomic_store(tmo, 1u, __ATOMIC_RELAXED, __HIP_MEMORY_SCOPE_AGENT); }
                    break; }
                __builtin_amdgcn_s_sleep(2); }
            __builtin_amdgcn_fence(__ATOMIC_ACQUIRE, "agent");
            asm volatile("s_waitcnt vmcnt(0)" ::: "memory");
        }
#if !defined(BROKEN_HOOK_NO_BARRIER)
        asm volatile("" ::: "memory"); __builtin_amdgcn_s_barrier(); asm volatile("" ::: "memory");
#endif
    }
};

__device__ __forceinline__ unsigned cvt_pk_bf16(float lo, float hi) { unsigned r; asm volatile("v_cvt_pk_bf16_f32 %0, %1, %2" : "=v"(r) : "v"(lo), "v"(hi)); return r; }
typedef float f32x2 __attribute__((ext_vector_type(2)));
__device__ __forceinline__ f32x2 gelu_pk(f32x2 v) {
    const f32x2 av = __builtin_elementwise_abs(v), d = av * 0.2316418882f + 1.0f;
    f32x2 t; t.x = __builtin_amdgcn_rcpf(d.x); t.y = __builtin_amdgcn_rcpf(d.y);
    f32x2 q = t * 0.5307027145f + (-0.7265760135f); q = q * t + 0.7107068705f; q = q * t + (-0.142248368f); q = q * t + 0.127414796f; q = q * t;
    const f32x2 s = (v * v) * (-0.72134752044f);
    f32x2 e; e.x = __builtin_amdgcn_exp2f(s.x); e.y = __builtin_amdgcn_exp2f(s.y);
    const f32x2 m = v * (q * e), r = v - m;
    f32x2 o; o.x = v.x < 0.f ? m.x : r.x; o.y = v.y < 0.f ? m.y : r.y; return o;
}

struct EpiF32 {
    static constexpr bool PERM = false, AFTER_DRAIN = false, I8 = false;
    float* C; int ldc; const float* bias;
    __device__ __forceinline__ void operator()(const f32x4 (&acc)[2][2][4][2], const Unit& u, int wr, int wc, int fr, int fq) const {
        const int row0 = u.pm * BM + wr * 64 + fr, col0 = u.pn * BM + wc * 32 + 4 * fq;
        f32x4 bv[2][2];
#pragma unroll
        for (int bj = 0; bj < 2; ++bj)
#pragma unroll
            for (int n = 0; n < 2; ++n) bv[bj][n] = bias ? *(const f32x4*)(bias + col0 + bj * HALF + n * 16) : (f32x4){0.f, 0.f, 0.f, 0.f};
#pragma unroll
        for (int ai = 0; ai < 2; ++ai)
#pragma unroll
            for (int m = 0; m < 4; ++m) { float* rowp = C + (size_t)(row0 + ai * HALF + m * 16) * ldc + col0;
#pragma unroll
                for (int bj = 0; bj < 2; ++bj)
#pragma unroll
                    for (int n = 0; n < 2; ++n) *(f32x4*)(rowp + bj * HALF + n * 16) = acc[ai][bj][m][n] + bv[bj][n]; }
    }
};
template <int ACT  > struct EpiBf16 {
    static constexpr bool PERM = true, AFTER_DRAIN = false, I8 = false;
    bf16_t* O; int ldc; const float* bias; int split_cols; size_t split_stride;
    __device__ __forceinline__ void operator()(const f32x4 (&acc)[2][2][4][2], const Unit& u, int wr, int wc, int fr, int fq) const {
        const int row0 = u.pm * BM + wr * 64 + fr; int colt = u.pn * BM; bf16_t* base = O;
        if (split_cols) { const int t = colt / split_cols; base += (size_t)t * split_stride; colt -= t * split_cols; }
        const int col0 = colt + wc * 32 + 8 * fq, bcol0 = u.pn * BM + wc * 32 + 8 * fq;
        f32x4 bv[2][2];
#pragma unroll
        for (int bj = 0; bj < 2; ++bj)
#pragma unroll
            for (int n = 0; n < 2; ++n) bv[bj][n] = bias ? *(const f32x4*)(bias + bcol0 + bj * HALF + 4 * n) : (f32x4){0.f, 0.f, 0.f, 0.f};
#pragma unroll
        for (int ai = 0; ai < 2; ++ai)
#pragma unroll
            for (int m = 0; m < 4; ++m) { bf16_t* rowp = base + (size_t)(row0 + ai * HALF + m * 16) * ldc + col0;
#pragma unroll
                for (int bj = 0; bj < 2; ++bj) { f32x4 v0 = acc[ai][bj][m][0] + bv[bj][0], v1 = acc[ai][bj][m][1] + bv[bj][1];
                    if (ACT == 1) { f32x2 a = gelu_pk((f32x2){v0[0], v0[1]}), b = gelu_pk((f32x2){v0[2], v0[3]}), c = gelu_pk((f32x2){v1[0], v1[1]}), d = gelu_pk((f32x2){v1[2], v1[3]});
                        v0 = (f32x4){a.x, a.y, b.x, b.y}; v1 = (f32x4){c.x, c.y, d.x, d.y}; }
                    if (ACT == 2) {
#pragma unroll
                        for (int j = 0; j < 4; ++j) { v0[j] = 0.5f * v0[j] * (1.0f + erff(v0[j] * 0.70710678f)); v1[j] = 0.5f * v1[j] * (1.0f + erff(v1[j] * 0.70710678f)); } }
                    u32x4 w; w.x = cvt_pk_bf16(v0[0], v0[1]); w.y = cvt_pk_bf16(v0[2], v0[3]); w.z = cvt_pk_bf16(v1[0], v1[1]); w.w = cvt_pk_bf16(v1[2], v1[3]);
                    *(u32x4*)(rowp + bj * HALF) = w; } }
    }
};

typedef int i32x4 __attribute__((ext_vector_type(4)));
template <bool I8> __device__ __forceinline__ f32x4 mma16(bf16x8 b, bf16x8 a, f32x4 c) {
    if constexpr (I8) return __builtin_bit_cast(f32x4, __builtin_amdgcn_mfma_i32_16x16x64_i8(__builtin_bit_cast(i32x4, b), __builtin_bit_cast(i32x4, a), __builtin_bit_cast(i32x4, c), 0, 0, 0));
    else return __builtin_amdgcn_mfma_f32_16x16x32_bf16(b, a, c, 0, 0, 0);
}
template <bool I8> __device__ __forceinline__ f32x4 accf(f32x4 a) { if constexpr (I8) return __builtin_convertvector(__builtin_bit_cast(i32x4, a), f32x4); else return a; }
template <class Epi, class Sched, bool STAMP = false>
__device__ __forceinline__ void gemm_phase(PG8_LAS unsigned char* lds, const Gemm g, const Sched& S, const Epi& E, unsigned long long* stamps) {
    const int tid = threadIdx.x, wid = __builtin_amdgcn_readfirstlane(tid >> 6), lane = tid & 63, wr = wid >> 2, wc = wid & 3, fr = lane & 15, fq = lane >> 4;
    const int K = g.K, nt = K / BK;
    int ts_lo = 0, ts_hi = 0, nts = 0; const unsigned long long rt_entry = STAMP ? (unsigned long long)wall_clock64() : 0ull;
#define PG8_STAMP() do { if (STAMP && wid == 0 && nts < 64) { const unsigned long long _c = (unsigned long long)clock64(); \
        ts_lo = (lane == nts) ? (int)(unsigned)_c : ts_lo; ts_hi = (lane == nts) ? (int)(unsigned)(_c >> 32) : ts_hi; ++nts; } } while (0)
    PG8_STAMP();
    unsigned voffA[2], voffB[2];
#pragma unroll
    for (int i = 0; i < 2; ++i) { int R, C; stage_rc(tid * 16 + i * 8192, R, C); const int Rb = Epi::PERM ? ((R & ~31) + perm32(R & 31)) : R;
        voffA[i] = (unsigned)(R * K + C) * 2u; voffB[i] = (unsigned)(Rb * K + C) * 2u; }
    const size_t kstep = (size_t)(BK * 2);
    const size_t hstep = (size_t)HALF * K * 2;
    const size_t tstep = 2 * hstep;
    const unsigned ldsw = (unsigned)wid * 1024u;
    const int aoff = lds_byte(wr * 64 + fr, fq * 8), boff = lds_byte(wc * 32 + fr, fq * 8);
#define PG8_SA(b, h) (((b) * 2 + (h)) * HTB)
#define PG8_SB(b, h) ((4 + (b) * 2 + (h)) * HTB)
#define PG8_STAGE(bufoff, gbase, voff) do { _Pragma("unroll") for (int _i = 0; _i < 2; ++_i) \
        __builtin_amdgcn_global_load_lds((const unsigned*)((const char*)(gbase) + (voff)[_i]), (PG8_LAS unsigned*)(lds + (bufoff) + ldsw + _i * 8192), 16, 0, 0); } while (0)
#define PG8_LDA(dst, b, h) do { _Pragma("unroll") for (int m = 0; m < 4; ++m) _Pragma("unroll") for (int k = 0; k < 2; ++k) dst[m][k] = *(const PG8_LAS bf16x8*)(lds + PG8_SA(b, h) + aoff + m * 2048 + k * 1024); } while (0)
#define PG8_LDB(dst, b, h) do { _Pragma("unroll") for (int n = 0; n < 2; ++n) _Pragma("unroll") for (int k = 0; k < 2; ++k) dst[n][k] = *(const PG8_LAS bf16x8*)(lds + PG8_SB(b, h) + boff + n * 2048 + k * 1024); } while (0)
#define PG8_MMA(ai, bj, At, Bt) do { __builtin_amdgcn_s_setprio(1); _Pragma("unroll") for (int m = 0; m < 4; ++m) _Pragma("unroll") for (int n = 0; n < 2; ++n) _Pragma("unroll") for (int k = 0; k < 2; ++k) \
        acc[ai][bj][m][n] = mma16<Epi::I8>(Bt[n][k], At[m][k], acc[ai][bj][m][n]); __builtin_amdgcn_s_setprio(0); } while (0)
#define PG8_WAIT_V(n) asm volatile("s_waitcnt vmcnt(" #n ")" ::: "memory")
#define PG8_WAIT_L(n) asm volatile("s_waitcnt lgkmcnt(" #n ")" ::: "memory")
#define PG8_BAR __builtin_amdgcn_s_barrier()
#define PG8_SCHED __builtin_amdgcn_sched_barrier(0)
    Unit cur, nxt; int ui = 0;
    if (!S.next(0, cur)) return;
    f32x4 acc[2][2][4][2];
#pragma unroll
    for (int a = 0; a < 2; ++a)
#pragma unroll
        for (int b = 0; b < 2; ++b)
#pragma unroll
            for (int m = 0; m < 4; ++m)
#pragma unroll
                for (int n = 0; n < 2; ++n) acc[a][b][m][n] = (f32x4){0.f, 0.f, 0.f, 0.f};
    bf16x8 At[4][2], B0[2][2], B1[2][2];
    const char* cA = (const char*)g.A + (size_t)cur.pm * tstep; const char* cB = (const char*)g.Bt + (size_t)cur.pn * tstep;
    S.a_ready(cur);
    PG8_STAGE(PG8_SB(0, 0), cB, voffB); PG8_STAGE(PG8_SA(0, 0), cA, voffA); PG8_STAGE(PG8_SB(0, 1), cB + hstep, voffB); PG8_STAGE(PG8_SA(0, 1), cA + hstep, voffA);
    if (wr == 1) PG8_BAR;
    PG8_WAIT_V(4); PG8_BAR;
    PG8_STAGE(PG8_SB(1, 0), cB + kstep, voffB); PG8_STAGE(PG8_SA(1, 0), cA + kstep, voffA); PG8_STAGE(PG8_SB(1, 1), cB + hstep + kstep, voffB);
    PG8_WAIT_V(6); PG8_BAR;
    PG8_STAMP();
    for (;;) {
        const bool has_next = S.next(ui + 1, nxt);
        const char* nA = has_next ? (const char*)g.A + (size_t)nxt.pm * tstep : cA; const char* nB = has_next ? (const char*)g.Bt + (size_t)nxt.pn * tstep : cB;
        for (int t = 0; t < nt; t += 2) {
            const bool last = (t == nt - 2);
            const char* a1 = cA + (size_t)(t + 1) * kstep;
            const char* a2 = last ? nA : cA + (size_t)(t + 2) * kstep; const char* b2 = last ? nB : cB + (size_t)(t + 2) * kstep;
            const char* a3 = a2 + kstep; const char* b3 = b2 + kstep;
            if (last && has_next) S.a_ready(nxt);
            PG8_LDB(B0, 0, 0); PG8_SCHED; PG8_LDA(At, 0, 0); PG8_STAGE(PG8_SA(1, 1), a1 + hstep, voffA);
            PG8_WAIT_L(8); PG8_BAR; PG8_WAIT_L(0); PG8_MMA(0, 0, At, B0); PG8_BAR; PG8_SCHED;
            PG8_LDB(B1, 0, 1); PG8_STAGE(PG8_SB(0, 0), b2, voffB);
            PG8_BAR; PG8_WAIT_L(0); PG8_MMA(0, 1, At, B1); PG8_BAR;
            PG8_LDA(At, 0, 1); PG8_STAGE(PG8_SA(0, 0), a2, voffA);
            PG8_BAR; PG8_WAIT_L(0); PG8_MMA(1, 0, At, B0); PG8_BAR; PG8_SCHED;
            PG8_STAGE(PG8_SB(0, 1), b2 + hstep, voffB);
            PG8_WAIT_V(6); PG8_BAR; PG8_MMA(1, 1, At, B1); PG8_BAR;
            PG8_LDB(B0, 1, 0); PG8_SCHED; PG8_LDA(At, 1, 0); PG8_STAGE(PG8_SA(0, 1), a2 + hstep, voffA);
            PG8_WAIT_L(8); PG8_BAR; PG8_WAIT_L(0); PG8_MMA(0, 0, At, B0); PG8_BAR; PG8_SCHED;
            PG8_LDB(B1, 1, 1); PG8_STAGE(PG8_SB(1, 0), b3, voffB);
            PG8_BAR; PG8_WAIT_L(0); PG8_MMA(0, 1, At, B1); PG8_BAR;
            PG8_LDA(At, 1, 1); PG8_STAGE(PG8_SA(1, 0), a3, voffA);
            PG8_BAR; PG8_WAIT_L(0); PG8_MMA(1, 0, At, B0); PG8_BAR; PG8_SCHED;
            PG8_STAGE(PG8_SB(1, 1), b3 + hstep, voffB);
            PG8_WAIT_V(6); PG8_BAR; PG8_MMA(1, 1, At, B1); PG8_BAR;
        }
        PG8_STAMP();
        if constexpr (!Epi::AFTER_DRAIN) { E(acc, cur, wr, wc, fr, fq); S.done(cur); }
        PG8_STAMP();
        if (!has_next) break;
#pragma unroll
        for (int a = 0; a < 2; ++a)
#pragma unroll
            for (int b = 0; b < 2; ++b)
#pragma unroll
                for (int m = 0; m < 4; ++m)
#pragma unroll
                    for (int n = 0; n < 2; ++n) acc[a][b][m][n] = (f32x4){0.f, 0.f, 0.f, 0.f};
        cur = nxt; cA = nA; cB = nB; ++ui;
    }
    PG8_WAIT_V(0);
    if (wr == 0) PG8_BAR;
    PG8_BAR;
    if constexpr (Epi::AFTER_DRAIN) { E.fused(acc, cur, wr, wc, fr, fq, lds, wid, lane); S.done(cur); }
    PG8_STAMP();
    if (STAMP && wid == 0) { stamps[lane] = lane < nts ? (((unsigned long long)(unsigned)ts_hi << 32) | (unsigned)ts_lo) : 0ull;
        if (lane == 62) stamps[62] = rt_entry; if (lane == 63) stamps[63] = (unsigned long long)wall_clock64(); }
#undef PG8_STAMP
#undef PG8_SA
#undef PG8_SB
#undef PG8_STAGE
#undef PG8_LDA
#undef PG8_LDB
#undef PG8_MMA
#undef PG8_WAIT_V
#undef PG8_WAIT_L
#undef PG8_BAR
#undef PG8_SCHED
}
}


#define LAS __attribute__((address_space(3)))
typedef unsigned short bf16_t;
typedef float f32x4 __attribute__((ext_vector_type(4)));
typedef unsigned u32x4 __attribute__((ext_vector_type(4)));
typedef unsigned u32x2 __attribute__((ext_vector_type(2)));
typedef short bf16x8 __attribute__((ext_vector_type(8)));
typedef short s16x4 __attribute__((ext_vector_type(4)));
typedef float f32x16 __attribute__((ext_vector_type(16)));

constexpr int MTOK = 16384, DM = 2048, SEQ = 8192, NHEAD = 16;
constexpr float ALPHA = 1.41421356237309515f;
constexpr size_t MiB = (size_t)1 << 20;
constexpr size_t WS_WIN = 0, WS_WOUT = 32 * MiB, WS_WKVQ = 40 * MiB, WS_WO = 64 * MiB, WS_WC = 72 * MiB, WS_UB = 88 * MiB, WS_VB = 152 * MiB, WS_USC = 216 * MiB, WS_VSC = 217 * MiB, WS_H = 224 * MiB, WS_XQ = 232 * MiB, WS_XS = 264 * MiB, WS_W = 272 * MiB, WS_CS = 280 * MiB, WS_SLOT = 344 * MiB;
constexpr size_t WS_EID = 920 * MiB, WS_GATE = 928 * MiB, WS_COS = 936 * MiB, WS_SIN = 938 * MiB, WS_KMEAN = 940 * MiB, WS_LB = 941 * MiB, WS_LS = 942 * MiB, WS_SUB = 946 * MiB, WS_CNT = 962 * MiB, WS_CTR = 963 * MiB, WS_DEC = 964 * MiB, WS_END = 966 * MiB;
constexpr size_t WS_BAR = WS_CTR + 65536;
constexpr size_t WS_XS0 = WS_XS + 1 * MiB, WS_SWIN = WS_XS + 2 * MiB, WS_SWKVQ = WS_XS + 3 * MiB, WS_XS1 = WS_XS + 4 * MiB;
constexpr size_t WS_KNMAX = WS_KMEAN + 768 * 1024;
__host__ __device__ constexpr size_t slot(int i) { return WS_SLOT + (size_t)i * 64 * MiB; }
constexpr int LDS_BYTES = 144 * 1024;
constexpr int NPH = 20;

struct Args { const float* in[14]; float* out; unsigned char* ws; int ph_lo, ph_hi; };

__device__ __forceinline__ float bflo(unsigned w) { return __uint_as_float(w << 16); }
__device__ __forceinline__ float bfhi(unsigned w) { return __uint_as_float(w & 0xffff0000u); }
__device__ __forceinline__ float bf2f(bf16_t b) { return __uint_as_float(((unsigned)b) << 16); }
typedef __bf16 bf16x2_t __attribute__((ext_vector_type(2)));
typedef float f32x2_t __attribute__((ext_vector_type(2)));
__device__ __forceinline__ unsigned pk_bf16(float lo, float hi) { const f32x2_t f = {lo, hi}; return __builtin_bit_cast(unsigned, __builtin_convertvector(f, bf16x2_t)); }
__device__ __forceinline__ float wave_sum(float v) {
#pragma unroll
    for (int o = 32; o >= 1; o >>= 1) v += __shfl_xor(v, o);
    return v;
}
__device__ __forceinline__ float wave_max(float v) {
#pragma unroll
    for (int o = 32; o >= 1; o >>= 1) v = fmaxf(v, __shfl_xor(v, o));
    return v;
}
__device__ __forceinline__ float sigmoidf_(float z) { return 1.0f / (1.0f + __expf(-z)); }


__device__ __forceinline__ void store_wt16(void* p, u32x4 v) {
    __hip_atomic_store((unsigned long long*)p, ((unsigned long long)v.y << 32) | v.x, __ATOMIC_RELAXED, __HIP_MEMORY_SCOPE_AGENT);
    __hip_atomic_store((unsigned long long*)p + 1, ((unsigned long long)v.w << 32) | v.z, __ATOMIC_RELAXED, __HIP_MEMORY_SCOPE_AGENT);
}
__device__ __forceinline__ void store_wt8(void* p, u32x2 v) {
    __hip_atomic_store((unsigned long long*)p, ((unsigned long long)v.y << 32) | v.x, __ATOMIC_RELAXED, __HIP_MEMORY_SCOPE_AGENT);
}
struct EpiIn {
    static constexpr bool PERM = true, AFTER_DRAIN = false, I8 = false;
    bf16_t* Q1; float* LF; bf16_t* I1; bf16_t* G1; const float* LB;
    __device__ __forceinline__ void operator()(const pg8::f32x4 (&acc)[2][2][4][2], const pg8::Unit& u, int wr, int wc, int fr, int fq) const {
        const int type = u.pn >> 3;
        const int row0 = u.pm * 256 + wr * 64 + fr, col0 = (u.pn & 7) * 256 + wc * 32 + 8 * fq;
        if (type == 1) {
#pragma unroll
            for (int bj = 0; bj < 2; ++bj) {
                const int c = col0 + bj * 128;
                const f32x4 lb0 = *(const f32x4*)(LB + c), lb1 = *(const f32x4*)(LB + c + 4);
#pragma unroll
                for (int ai = 0; ai < 2; ++ai)
#pragma unroll
                    for (int m = 0; m < 4; ++m) {
                        float* p = LF + (size_t)(row0 + ai * 128 + m * 16) * DM + c;
                        f32x4 o0, o1;
#pragma unroll
                        for (int j = 0; j < 4; ++j) {
                            o0[j] = __logf(lb0[j] + (1.0f - lb0[j]) * sigmoidf_(acc[ai][bj][m][0][j]));
                            o1[j] = __logf(lb1[j] + (1.0f - lb1[j]) * sigmoidf_(acc[ai][bj][m][1][j]));
                        }
                        *(f32x4*)p = o0; *(f32x4*)(p + 4) = o1;
                    }
            }
        } else {
            bf16_t* dst = Q1 + (size_t)(type - (type > 0 ? 1 : 0)) * ((size_t)32 << 20);
            const bool act = (type != 2);
#pragma unroll
            for (int ai = 0; ai < 2; ++ai)
#pragma unroll
                for (int m = 0; m < 4; ++m)
#pragma unroll
                    for (int bj = 0; bj < 2; ++bj) {
                        f32x4 v0 = acc[ai][bj][m][0], v1 = acc[ai][bj][m][1];
                        if (act) {
#pragma unroll
                            for (int j = 0; j < 4; ++j) { v0[j] = v0[j] * sigmoidf_(v0[j]); v1[j] = v1[j] * sigmoidf_(v1[j]); }
                        }
                        u32x4 w; w.x = pk_bf16(v0[0], v0[1]); w.y = pk_bf16(v0[2], v0[3]); w.z = pk_bf16(v1[0], v1[1]); w.w = pk_bf16(v1[2], v1[3]);
                        *(u32x4*)(dst + (size_t)(row0 + ai * 128 + m * 16) * DM + col0 + bj * 128) = w;
                    }
        }
    }
};
struct EpiRes {
    static constexpr bool PERM = false, AFTER_DRAIN = false, I8 = false;
    const float* res; float* Y;
    __device__ __forceinline__ void operator()(const pg8::f32x4 (&acc)[2][2][4][2], const pg8::Unit& u, int wr, int wc, int fr, int fq) const {
        const int row0 = u.pm * 256 + wr * 64 + fr, col0 = u.pn * 256 + wc * 32 + 4 * fq;
#pragma unroll
        for (int ai = 0; ai < 2; ++ai)
#pragma unroll
            for (int m = 0; m < 4; ++m) {
                const size_t off = (size_t)(row0 + ai * 128 + m * 16) * DM + col0;
#pragma unroll
                for (int bj = 0; bj < 2; ++bj)
#pragma unroll
                    for (int n = 0; n < 2; ++n) {
                        const f32x4 r = *(const f32x4*)(res + off + bj * 128 + n * 16);
                        *(f32x4*)(Y + off + bj * 128 + n * 16) = r * ALPHA + acc[ai][bj][m][n];
                    }
            }
    }
};
struct EpiF32 {
    static constexpr bool PERM = false, AFTER_DRAIN = false, I8 = false;
    float* C; int ldc;
    __device__ __forceinline__ void operator()(const pg8::f32x4 (&acc)[2][2][4][2], const pg8::Unit& u, int wr, int wc, int fr, int fq) const {
        const int row0 = u.pm * 256 + wr * 64 + fr, col0 = u.pn * 256 + wc * 32 + 4 * fq;
#pragma unroll
        for (int ai = 0; ai < 2; ++ai)
#pragma unroll
            for (int m = 0; m < 4; ++m) {
                float* p = C + (size_t)(row0 + ai * 128 + m * 16) * ldc + col0;
#pragma unroll
                for (int bj = 0; bj < 2; ++bj)
#pragma unroll
                    for (int n = 0; n < 2; ++n) *(f32x4*)(p + bj * 128 + n * 16) = acc[ai][bj][m][n];
            }
    }
};
template <bool Q8> struct EpiKVQ_ {
    static constexpr bool PERM = true, AFTER_DRAIN = false, I8 = Q8;
    bf16_t* K; const float* SA; const float* SB;
    __device__ __forceinline__ void operator()(const pg8::f32x4 (&acc)[2][2][4][2], const pg8::Unit& u, int wr, int wc, int fr, int fq) const {
        const int t = u.pn >> 3;
        bf16_t* dst = K + (size_t)t * ((size_t)32 << 20);
        const int row0 = u.pm * 256 + wr * 64 + fr, col0 = (u.pn & 7) * 256 + wc * 32 + 8 * fq;
#pragma unroll
        for (int bj = 0; bj < 2; ++bj) {
            f32x4 sb0 = {1.f, 1.f, 1.f, 1.f}, sb1 = sb0;
            if (Q8) { const float* sp = SB + u.pn * 256 + bj * 128 + wc * 32 + 8 * fq; sb0 = *(const f32x4*)sp; sb1 = *(const f32x4*)(sp + 4); }
#pragma unroll
            for (int ai = 0; ai < 2; ++ai)
#pragma unroll
                for (int m = 0; m < 4; ++m) {
                    const int row = row0 + ai * 128 + m * 16;
                    f32x4 v0 = pg8::accf<Q8>(acc[ai][bj][m][0]), v1 = pg8::accf<Q8>(acc[ai][bj][m][1]);
                    if (Q8) { const float sa = SA[row]; v0 = v0 * sb0 * sa; v1 = v1 * sb1 * sa; }
                    u32x4 w; w.x = pk_bf16(v0[0], v0[1]); w.y = pk_bf16(v0[2], v0[3]); w.z = pk_bf16(v1[0], v1[1]); w.w = pk_bf16(v1[2], v1[3]);
                    *(u32x4*)(dst + (size_t)row * DM + col0 + bj * 128) = w;
                }
        }
    }
};
typedef EpiKVQ_<false> EpiKVQ;

template <bool Q8> struct EpiKVQR_ {
    static constexpr bool PERM = true, AFTER_DRAIN = false, I8 = Q8;
    bf16_t* K; const float* COS; const float* SIN; const float* SA; const float* SB;
    __device__ __forceinline__ void operator()(const pg8::f32x4 (&acc)[2][2][4][2], const pg8::Unit& u, int wr, int wc, int fr, int fq) const {
        const int t = u.pn >> 3;
        bf16_t* dst = K + (size_t)t * ((size_t)32 << 20);
        const int row0 = u.pm * 256 + wr * 64 + fr;
        const int g = 4 * wc + fq;
        const int col0 = (u.pn & 7) * 256 + wc * 32 + 8 * fq;
#pragma unroll
        for (int bj = 0; bj < 2; ++bj) {
            f32x4 sb0 = {1.f, 1.f, 1.f, 1.f}, sb1 = sb0;
            if (Q8) { const float* sp = SB + u.pn * 256 + bj * 128 + wc * 32 + 8 * fq; sb0 = *(const f32x4*)sp; sb1 = *(const f32x4*)(sp + 4); }
#pragma unroll
            for (int ai = 0; ai < 2; ++ai)
#pragma unroll
                for (int m = 0; m < 4; ++m) {
                    const int row = row0 + ai * 128 + m * 16, pos = row & (SEQ - 1);
                    f32x4 a = pg8::accf<Q8>(acc[ai][bj][m][0]), b = pg8::accf<Q8>(acc[ai][bj][m][1]);
                    if (Q8) { const float sa = SA[row]; a = a * sb0 * sa; b = b * sb1 * sa; }
                    if (t == 1) {
                        u32x4 w; w.x = pk_bf16(a[0], a[1]); w.y = pk_bf16(a[2], a[3]); w.z = pk_bf16(b[0], b[1]); w.w = pk_bf16(b[2], b[3]);
                        *(u32x4*)(dst + (size_t)row * DM + col0 + bj * 128) = w;
                    } else {
                        const f32x4 c = *(const f32x4*)(COS + pos * 64 + 4 * g), sn = *(const f32x4*)(SIN + pos * 64 + 4 * g);
                        bf16_t* p = dst + (size_t)row * DM + ((u.pn & 7) * 2 + bj) * 128 + 4 * g;
                        u32x2 w1, w2;
                        w1.x = pk_bf16(a[0] * c[0] - b[0] * sn[0], a[1] * c[1] - b[1] * sn[1]); w1.y = pk_bf16(a[2] * c[2] - b[2] * sn[2], a[3] * c[3] - b[3] * sn[3]);
                        w2.x = pk_bf16(a[0] * sn[0] + b[0] * c[0], a[1] * sn[1] + b[1] * c[1]); w2.y = pk_bf16(a[2] * sn[2] + b[2] * c[2], a[3] * sn[3] + b[3] * c[3]);
                        *(u32x2*)p = w1; *(u32x2*)(p + 64) = w2;
                    }
                }
        }
    }
};

__host__ __device__ __forceinline__ int rot_pos(int d) { return d < 64 ? 8 * (d >> 2) + (d & 3) : 8 * ((d - 64) >> 2) + 4 + (d & 3); }
__device__ __forceinline__ void transpose_tiles(LAS float* tile, const float* src, int ldn, int K, int N, bf16_t* dst, int nperm = 0) {
    const int tid = threadIdx.x;
    const int tn = N / 64, ntiles = tn * (K / 64);
    f32x4 nx[2];
#define TT_LOAD(tI_) { const int k0_ = ((tI_) / tn) * 64, n0_ = ((tI_) % tn) * 64; _Pragma("unroll") for (int r = 0; r < 2; ++r) nx[r] = *(const f32x4*)(src + (size_t)(k0_ + (tid >> 4) + 32 * r) * ldn + n0_ + (tid & 15) * 4); }
    if ((int)blockIdx.x < ntiles) TT_LOAD((int)blockIdx.x)
    for (int tI = blockIdx.x; tI < ntiles; tI += gridDim.x) {
        const int k0 = (tI / tn) * 64, n0 = (tI % tn) * 64;
        const f32x4 c0 = nx[0], c1 = nx[1];
        if (tI + (int)gridDim.x < ntiles) TT_LOAD(tI + (int)gridDim.x)
#pragma unroll
        for (int r = 0; r < 2; ++r) {
            const int kk = (tid >> 4) + 32 * r, nn = (tid & 15) * 4;
            const f32x4 v = r == 0 ? c0 : c1;
            tile[kk * 65 + nn + 0] = v[0]; tile[kk * 65 + nn + 1] = v[1]; tile[kk * 65 + nn + 2] = v[2]; tile[kk * 65 + nn + 3] = v[3];
        }
        __syncthreads();
        {
            const int nn = tid >> 3, kk8 = (tid & 7) * 8;
            float f[8];
#pragma unroll
            for (int j = 0; j < 8; ++j) f[j] = tile[(kk8 + j) * 65 + nn];
            u32x4 w; w.x = pk_bf16(f[0], f[1]); w.y = pk_bf16(f[2], f[3]); w.z = pk_bf16(f[4], f[5]); w.w = pk_bf16(f[6], f[7]);
            const int nsrc = n0 + nn, nrow = nsrc < nperm ? (nsrc & ~127) + rot_pos(nsrc & 127) : nsrc;
            *(u32x4*)(dst + (size_t)nrow * K + k0 + kk8) = w;
        }
        __syncthreads();
    }
}
#undef TT_LOAD
__device__ __forceinline__ void convert_bf16(const float* src, bf16_t* dst, size_t n) {
    const size_t stride = (size_t)gridDim.x * 512 * 8;
    for (size_t i = ((size_t)blockIdx.x * 512 + threadIdx.x) * 8; i < n; i += stride) {
        const f32x4 a = *(const f32x4*)(src + i), b = *(const f32x4*)(src + i + 4);
        u32x4 w; w.x = pk_bf16(a[0], a[1]); w.y = pk_bf16(a[2], a[3]); w.z = pk_bf16(b[0], b[1]); w.w = pk_bf16(b[2], b[3]);
        *(u32x4*)(dst + i) = w;
    }
}
__device__ __forceinline__ void fold_peer_keys(LAS float* lds, const float* w_query, const float* sub_keys, bf16_t* WcT) {
    const int tid = threadIdx.x;
    LAS float* Ss = lds;
    LAS float* Ws = lds + 128 * 132;
    for (int item = blockIdx.x; item < 1024; item += gridDim.x) {
        const int l = item >> 9, rem = item & 511, hh = rem >> 5, kb = rem & 31, h = hh >> 1, half = hh & 1;
        const float* sk = sub_keys + (size_t)(((l * 2 + half) * 8 + h) * 128) * 128;
        const float* wq = w_query + (size_t)l * DM * DM + (size_t)(kb * 64) * DM + h * 256 + half * 128;
#pragma unroll
        for (int r = 0; r < 8; ++r) { const int idx = tid + 512 * r, key = idx >> 5, d4 = (idx & 31) * 4; *(LAS f32x4*)(Ss + key * 132 + d4) = *(const f32x4*)(sk + key * 128 + d4); }
#pragma unroll
        for (int r = 0; r < 4; ++r) { const int idx = tid + 512 * r, kin = idx >> 5, d4 = (idx & 31) * 4; *(LAS f32x4*)(Ws + kin * 128 + d4) = *(const f32x4*)(wq + (size_t)kin * DM + d4); }
        __syncthreads();
        const int key = tid & 127, kq = tid >> 7;
        float acc[16];
#pragma unroll
        for (int j = 0; j < 16; ++j) acc[j] = 0.f;
        for (int d4 = 0; d4 < 32; ++d4) {
            const f32x4 s4 = *(const LAS f32x4*)(Ss + key * 132 + d4 * 4);
#pragma unroll
            for (int j = 0; j < 16; ++j) { const f32x4 w4 = *(const LAS f32x4*)(Ws + (kq * 16 + j) * 128 + d4 * 4); acc[j] += s4[0] * w4[0] + s4[1] * w4[1] + s4[2] * w4[2] + s4[3] * w4[3]; }
        }
        bf16_t* o = WcT + (size_t)l * DM * DM + (size_t)(h * 256 + half * 128 + key) * DM + kb * 64 + kq * 16;
        u32x4 w0, w1;
        w0.x = pk_bf16(acc[0], acc[1]); w0.y = pk_bf16(acc[2], acc[3]); w0.z = pk_bf16(acc[4], acc[5]); w0.w = pk_bf16(acc[6], acc[7]);
        w1.x = pk_bf16(acc[8], acc[9]); w1.y = pk_bf16(acc[10], acc[11]); w1.z = pk_bf16(acc[12], acc[13]); w1.w = pk_bf16(acc[14], acc[15]);
        *(u32x4*)o = w0; *(u32x4*)(o + 8) = w1;
        __syncthreads();
    }
}

__device__ __forceinline__ void quant_rows(const float* src, unsigned char* dst, float* scl, int nrows) {
    const int lane = threadIdx.x & 63, gw = blockIdx.x * 8 + (threadIdx.x >> 6), nw = gridDim.x * 8;
    for (int row = gw; row < nrows; row += nw) {
        const float* p = src + (size_t)row * DM;
        f32x4 v[8];
#pragma unroll
        for (int i = 0; i < 2; ++i)
#pragma unroll
            for (int q = 0; q < 4; ++q) v[i * 4 + q] = *(const f32x4*)(p + 1024 * i + 16 * lane + 4 * q);
        float am = 0.f;
#pragma unroll
        for (int i = 0; i < 8; ++i) am = fmaxf(am, fmaxf(fmaxf(fabsf(v[i][0]), fabsf(v[i][1])), fmaxf(fabsf(v[i][2]), fabsf(v[i][3]))));
        am = fmaxf(wave_max(am), 1e-30f);
        const float inv = 127.0f / am;
        if (lane == 0) scl[row] = am * (1.0f / 127.0f);
#pragma unroll
        for (int i = 0; i < 2; ++i) {
            u32x4 w;
#pragma unroll
            for (int q = 0; q < 4; ++q) {
                const f32x4 t = v[i * 4 + q];
                const unsigned b0 = (unsigned)(int)(rintf(t[0] * inv) + 128.0f), b1 = (unsigned)(int)(rintf(t[1] * inv) + 128.0f), b2 = (unsigned)(int)(rintf(t[2] * inv) + 128.0f), b3 = (unsigned)(int)(rintf(t[3] * inv) + 128.0f);
                w[q] = b0 | (b1 << 8) | (b2 << 16) | (b3 << 24);
            }
            *(u32x4*)(dst + (size_t)row * DM + 1024 * i + 16 * lane) = w;
        }
    }
}
__device__ __forceinline__ void quant_transpose(LAS unsigned char* lds, const float* src, int ldn, int N, signed char* dst, float* scl, int nperm = 0) {
    const int tid = threadIdx.x;
    LAS bf16_t* st = (LAS bf16_t*)lds;
    LAS float* red = (LAS float*)(lds + 131072);
    for (int sI = blockIdx.x; sI < N / 32; sI += gridDim.x) {
        const int n0 = sI * 32;
#pragma unroll 8
        for (int it = 0; it < 32; ++it) {
            const int k = it * 64 + (tid >> 3), c4 = (tid & 7) * 4;
            const f32x4 v = *(const f32x4*)(src + (size_t)k * ldn + n0 + c4);
            u32x2 w; w.x = pk_bf16(v[0], v[1]); w.y = pk_bf16(v[2], v[3]);
            *(LAS u32x2*)(st + k * 32 + c4) = w;
        }
        __syncthreads();
        const int n = tid & 31, part = tid >> 5;
        float am = 0.f;
#pragma unroll 16
        for (int i = 0; i < 128; ++i) am = fmaxf(am, fabsf(bf2f(st[(part * 128 + i) * 32 + n])));
        red[part * 32 + n] = am;
        __syncthreads();
#pragma unroll
        for (int p = 0; p < 16; ++p) am = fmaxf(am, red[p * 32 + n]);
        am = fmaxf(am, 1e-30f);
        const float inv = 127.0f / am;
        const int nsrc = n0 + n, nrow = nsrc < nperm ? (nsrc & ~127) + rot_pos(nsrc & 127) : nsrc;
        if (part == 0) scl[nrow] = am * (1.0f / 127.0f);
        signed char* o = dst + (size_t)nrow * DM + part * 128;
#pragma unroll
        for (int q = 0; q < 8; ++q) {
            u32x4 w;
#pragma unroll
            for (int d = 0; d < 4; ++d) {
                unsigned b = 0;
#pragma unroll
                for (int j = 0; j < 4; ++j) b |= ((unsigned)(int)rintf(bf2f(st[(part * 128 + q * 16 + d * 4 + j) * 32 + n]) * inv) & 0xffu) << (8 * j);
                w[d] = b;
            }
            *(u32x4*)(o + q * 16) = w;
        }
        __syncthreads();
    }
}
__device__ __forceinline__ void quant_rows_s(const float* src, signed char* dst, float* scl, int nrows) {
    const int lane = threadIdx.x & 63, gw = blockIdx.x * 8 + (threadIdx.x >> 6), nw = gridDim.x * 8;
    for (int row = gw; row < nrows; row += nw) {
        const float* p = src + (size_t)row * DM;
        f32x4 v[8];
#pragma unroll
        for (int i = 0; i < 2; ++i)
#pragma unroll
            for (int q = 0; q < 4; ++q) v[i * 4 + q] = *(const f32x4*)(p + 1024 * i + 16 * lane + 4 * q);
        float am = 0.f;
#pragma unroll
        for (int i = 0; i < 8; ++i) am = fmaxf(am, fmaxf(fmaxf(fabsf(v[i][0]), fabsf(v[i][1])), fmaxf(fabsf(v[i][2]), fabsf(v[i][3]))));
        am = fmaxf(wave_max(am), 1e-30f);
        const float inv = 127.0f / am;
        if (lane == 0) scl[row] = am * (1.0f / 127.0f);
#pragma unroll
        for (int i = 0; i < 2; ++i) {
            u32x4 w;
#pragma unroll
            for (int q = 0; q < 4; ++q) {
                const f32x4 t = v[i * 4 + q];
                w[q] = ((unsigned)(int)rintf(t[0] * inv) & 0xffu) | (((unsigned)(int)rintf(t[1] * inv) & 0xffu) << 8) | (((unsigned)(int)rintf(t[2] * inv) & 0xffu) << 16) | (((unsigned)(int)rintf(t[3] * inv) & 0xffu) << 24);
            }
            *(u32x4*)(dst + (size_t)row * DM + 1024 * i + 16 * lane) = w;
        }
    }
}
__device__ __forceinline__ void phase_prep(const Args& a, LAS unsigned char* lds) {
    unsigned char* ws = a.ws;
    LAS float* tile = (LAS float*)lds;
    quant_transpose(lds, a.in[1], 4 * DM, 4 * DM, (signed char*)(ws + WS_WIN), (float*)(ws + WS_SWIN));
    transpose_tiles(tile, a.in[3], DM, DM, DM, (bf16_t*)(ws + WS_WOUT));
    quant_transpose(lds, a.in[5], 2 * DM, 2 * DM, (signed char*)(ws + WS_WKVQ), (float*)(ws + WS_SWKVQ), DM);
    quant_transpose(lds, a.in[6], DM, DM, (signed char*)(ws + WS_WKVQ) + (size_t)2 * DM * DM, (float*)(ws + WS_SWKVQ) + 2 * DM, DM);
    transpose_tiles(tile, a.in[7], DM, DM, DM, (bf16_t*)(ws + WS_WO));
    fold_peer_keys((LAS float*)lds, a.in[8], a.in[9], (bf16_t*)(ws + WS_WC));
    quant_rows_s(a.in[0], (signed char*)(ws + slot(0)), (float*)(ws + WS_XS0), MTOK);
    const int gtid = blockIdx.x * 512 + threadIdx.x, gthreads = gridDim.x * 512;
    float* COS = (float*)(ws + WS_COS); float* SIN = (float*)(ws + WS_SIN); float* LB = (float*)(ws + WS_LB);
    for (int i = gtid; i < SEQ * 64; i += gthreads) {
        const int pos = i >> 6, j = i & 63;
        double inv = 1.0; const double r = 0.86596432336006535;
        for (int q = 0; q < j; ++q) inv *= r;
        const float ang = (float)pos * (float)inv;
        const double x = (double)ang;
        const double n = __builtin_rint(x * 0.15915494309189535);
        const float rf = (float)__builtin_fma(-n, 6.283185307179586, x);
        COS[i] = cosf(rf); SIN[i] = sinf(rf);
    }
    for (int c = gtid; c < DM; c += gthreads) { const float l0 = a.in[4][c], l1 = a.in[4][DM + c]; LB[c] = 1.0f / (1.0f + expf(l1 - l0)); }
}

__device__ __forceinline__ void phase_scan_naive(const bf16_t* Q1, const float* LF, const bf16_t* I1, float* O) {
    const int lane = threadIdx.x & 63, gw = blockIdx.x * 8 + (threadIdx.x >> 6), nw = gridDim.x * 8;
    for (int item = gw; item < 2 * NHEAD * 128; item += nw) {
        const int bh = item >> 7, v = item & 127, b = bh >> 4, h = bh & 15;
        const size_t base = (size_t)b * SEQ * DM + h * 128;
        float S0 = 0.f, S1 = 0.f;
#pragma unroll 4
        for (int t = 0; t < SEQ; ++t) {
            const size_t ro = base + (size_t)t * DM;
            const float f0 = __expf(LF[ro + lane]), f1 = __expf(LF[ro + 64 + lane]);
            const float q0 = bf2f(Q1[ro + lane]), q1 = bf2f(Q1[ro + 64 + lane]);
            const float iv = bf2f(I1[ro + v]);
            S0 = f0 * S0 + (1.0f - f0) * iv; S1 = f1 * S1 + (1.0f - f1) * iv;
            const float p = wave_sum(q0 * S0 + q1 * S1);
            if (lane == 0) O[ro + v] = p;
        }
    }
}
__device__ __forceinline__ void phase_onorm(const float* O, const bf16_t* G1, const float* gnorm, bf16_t* OG) {
    const int lane = threadIdx.x & 63, gw = blockIdx.x * 8 + (threadIdx.x >> 6), nw = gridDim.x * 8;
    const float gn0 = gnorm[2 * lane], gn1 = gnorm[2 * lane + 1];
    for (int item = gw; item < MTOK * NHEAD; item += nw) {
        const size_t off = (size_t)item * 128 + 2 * lane;
        const float o0 = O[off], o1 = O[off + 1];
        const float ss = wave_sum(o0 * o0 + o1 * o1);
        const float r = rsqrtf(ss * (1.0f / 128.0f) + 1e-6f);
        const unsigned g = *(const unsigned*)(G1 + off);
        *(unsigned*)(OG + off) = pk_bf16(o0 * r * gn0 * bflo(g), o1 * r * gn1 * bfhi(g));
    }
}

__device__ __forceinline__ void ln_row_store(float (&v)[32], const float* g, const float* bta, float* outf, bf16_t* outb, int lane, signed char* outq = nullptr, float* outs = nullptr) {
    float s = 0.f;
#pragma unroll
    for (int i = 0; i < 32; ++i) s += v[i];
    const float mu = wave_sum(s) * (1.0f / DM);
    float q = 0.f;
#pragma unroll
    for (int i = 0; i < 32; ++i) { v[i] -= mu; q += v[i] * v[i]; }
    const float rstd = rsqrtf(wave_sum(q) * (1.0f / DM) + 1e-5f);
    float am = 0.f;
#pragma unroll
    for (int i = 0; i < 4; ++i) {
        const int c = 512 * i + 8 * lane;
        const f32x4 g0 = *(const f32x4*)(g + c), g1 = *(const f32x4*)(g + c + 4), b0 = *(const f32x4*)(bta + c), b1 = *(const f32x4*)(bta + c + 4);
        f32x4 o0, o1;
#pragma unroll
        for (int j = 0; j < 4; ++j) { o0[j] = v[i * 8 + j] * rstd * g0[j] + b0[j]; o1[j] = v[i * 8 + 4 + j] * rstd * g1[j] + b1[j]; v[i * 8 + j] = o0[j]; v[i * 8 + 4 + j] = o1[j]; am = fmaxf(am, fmaxf(fabsf(o0[j]), fabsf(o1[j]))); }
        if (outf) { *(f32x4*)(outf + c) = o0; *(f32x4*)(outf + c + 4) = o1; }
        if (outb) { u32x4 w; w.x = pk_bf16(o0[0], o0[1]); w.y = pk_bf16(o0[2], o0[3]); w.z = pk_bf16(o1[0], o1[1]); w.w = pk_bf16(o1[2], o1[3]); *(u32x4*)(outb + c) = w; }
    }
    if (outq) {
        am = fmaxf(wave_max(am), 1e-30f);
        const float inv = 127.0f / am;
        if (lane == 0) *outs = am * (1.0f / 127.0f);
#pragma unroll
        for (int i = 0; i < 4; ++i) {
            u32x2 w;
            w.x = ((unsigned)(int)rintf(v[i * 8 + 0] * inv) & 0xffu) | (((unsigned)(int)rintf(v[i * 8 + 1] * inv) & 0xffu) << 8) | (((unsigned)(int)rintf(v[i * 8 + 2] * inv) & 0xffu) << 16) | (((unsigned)(int)rintf(v[i * 8 + 3] * inv) & 0xffu) << 24);
            w.y = ((unsigned)(int)rintf(v[i * 8 + 4] * inv) & 0xffu) | (((unsigned)(int)rintf(v[i * 8 + 5] * inv) & 0xffu) << 8) | (((unsigned)(int)rintf(v[i * 8 + 6] * inv) & 0xffu) << 16) | (((unsigned)(int)rintf(v[i * 8 + 7] * inv) & 0xffu) << 24);
            *(u32x2*)(outq + 512 * i + 8 * lane) = w;
        }
    }
}
__device__ __forceinline__ void ln_row_store16(float (&v)[32], const float* g, const float* bta, float* outf, bf16_t* outb, int lane) {
    float s = 0.f;
#pragma unroll
    for (int i = 0; i < 32; ++i) s += v[i];
    const float mu = wave_sum(s) * (1.0f / DM);
    float q = 0.f;
#pragma unroll
    for (int i = 0; i < 32; ++i) { v[i] -= mu; q += v[i] * v[i]; }
    const float rstd = rsqrtf(wave_sum(q) * (1.0f / DM) + 1e-5f);
#pragma unroll
    for (int i = 0; i < 2; ++i) {
        const int c = 1024 * i + 16 * lane;
        f32x4 o[4];
#pragma unroll
        for (int qd = 0; qd < 4; ++qd) {
            const f32x4 gg = *(const f32x4*)(g + c + 4 * qd), bb = *(const f32x4*)(bta + c + 4 * qd);
#pragma unroll
            for (int j = 0; j < 4; ++j) o[qd][j] = v[16 * i + 4 * qd + j] * rstd * gg[j] + bb[j];
            *(f32x4*)(outf + c + 4 * qd) = o[qd];
        }
        if (outb) {
            u32x4 w0, w1;
            w0.x = pk_bf16(o[0][0], o[0][1]); w0.y = pk_bf16(o[0][2], o[0][3]); w0.z = pk_bf16(o[1][0], o[1][1]); w0.w = pk_bf16(o[1][2], o[1][3]);
            w1.x = pk_bf16(o[2][0], o[2][1]); w1.y = pk_bf16(o[2][2], o[2][3]); w1.z = pk_bf16(o[3][0], o[3][1]); w1.w = pk_bf16(o[3][2], o[3][3]);
            *(u32x4*)(outb + c) = w0; *(u32x4*)(outb + c + 8) = w1;
        }
    }
}
template <bool RES16> __device__ __forceinline__ void phase_ln(const bf16_t* Y, const void* RESv, const float* g, const float* bta, float* outf, bf16_t* outb, signed char* outq = nullptr, float* outs = nullptr) {
    const int lane = threadIdx.x & 63, gw = blockIdx.x * 8 + (threadIdx.x >> 6), nw = gridDim.x * 8;
    for (int row = gw; row < MTOK; row += nw) {
        float v[32];
        const bf16_t* p = Y + (size_t)row * DM;
#pragma unroll
        for (int i = 0; i < 4; ++i) {
            const u32x4 yw = *(const u32x4*)(p + 512 * i + 8 * lane);
            const f32x4 a = {bflo(yw.x), bfhi(yw.x), bflo(yw.y), bfhi(yw.y)}, b = {bflo(yw.z), bfhi(yw.z), bflo(yw.w), bfhi(yw.w)};
            f32x4 ra, rb;
            if (RES16) { const u32x4 w = *(const u32x4*)((const bf16_t*)RESv + (size_t)row * DM + 512 * i + 8 * lane); ra = (f32x4){bflo(w.x), bfhi(w.x), bflo(w.y), bfhi(w.y)}; rb = (f32x4){bflo(w.z), bfhi(w.z), bflo(w.w), bfhi(w.w)}; }
            else { const float* rp = (const float*)RESv + (size_t)row * DM; ra = *(const f32x4*)(rp + 512 * i + 8 * lane); rb = *(const f32x4*)(rp + 512 * i + 8 * lane + 4); }
#pragma unroll
            for (int j = 0; j < 4; ++j) { v[i * 8 + j] = a[j] + ALPHA * ra[j]; v[i * 8 + 4 + j] = b[j] + ALPHA * rb[j]; }
        }
        ln_row_store(v, g, bta, outf ? outf + (size_t)row * DM : nullptr, outb ? outb + (size_t)row * DM : nullptr, lane, outq ? outq + (size_t)row * DM : nullptr, outs ? outs + row : nullptr);
    }
}

__device__ __forceinline__ void wave_argmax(float& v, int& idx) {
#pragma unroll
    for (int o = 32; o >= 1; o >>= 1) {
        const float ov = __shfl_xor(v, o); const int oi = __shfl_xor(idx, o);
        if (ov > v || (ov == v && oi < idx)) { v = ov; idx = oi; }
    }
}
__device__ __forceinline__ unsigned fkey(float x) { const unsigned u = __float_as_uint(x); return u ^ (unsigned)(((int)u >> 31) | 0x80000000); }
__device__ __forceinline__ float funkey(unsigned k) { const unsigned u = (k & 0x80000000u) ? (k ^ 0x80000000u) : ~k; return __uint_as_float(u); }
__device__ __forceinline__ void sort16_insert(unsigned (&r)[16], unsigned v) {
#pragma unroll
    for (int i = 0; i < 16; ++i) { const unsigned m = r[i] > v ? r[i] : v; v = r[i] > v ? v : r[i]; r[i] = m; }
}
__device__ __forceinline__ void phase_topk(LAS unsigned char* lds, const float* SCT, int* EID, float* GATE) {
    LAS unsigned char* ib = lds + threadIdx.x * 32;
    for (int item = blockIdx.x * 512 + threadIdx.x; item < MTOK * 8; item += gridDim.x * 512) {
        const int h = item >> 14, tok = item & (MTOK - 1);
        const float* p = SCT + (size_t)(h * 256) * MTOK + tok;
        unsigned r1[16], r2[16];
#pragma unroll
        for (int i = 0; i < 16; ++i) { r1[i] = 0u; r2[i] = 0u; }
#pragma unroll 8
        for (int e = 0; e < 128; ++e) {
            const float x1 = p[(size_t)e * MTOK], x2 = p[(size_t)(128 + e) * MTOK];
            sort16_insert(r1, (fkey(x1) & ~0x7Fu) | (unsigned)e);
            sort16_insert(r2, (fkey(x2) & ~0x7Fu) | (unsigned)e);
        }
        float v1[16], v2[16];
#pragma unroll
        for (int i = 0; i < 16; ++i) { v1[i] = funkey(r1[i] & ~0x7Fu); v2[i] = funkey(r2[i] & ~0x7Fu); ib[i] = (unsigned char)(r1[i] & 0x7Fu); ib[16 + i] = (unsigned char)(r2[i] & 0x7Fu); }
        unsigned r3[16];
#pragma unroll
        for (int i = 0; i < 16; ++i) r3[i] = 0u;
#pragma unroll
        for (int a = 0; a < 16; ++a)
#pragma unroll
            for (int bq = 0; bq < 16; ++bq)
                if ((a + 1) * (bq + 1) <= 16) sort16_insert(r3, (fkey(v1[a] + v2[bq]) & ~0xFFu) | (unsigned)(a * 16 + bq));
        const float mx = funkey(r3[0] & ~0xFFu);
        float ev[16]; float sum = 0.f;
#pragma unroll
        for (int i = 0; i < 16; ++i) { ev[i] = __expf(funkey(r3[i] & ~0xFFu) - mx); sum += ev[i]; }
        const float rs = 1.0f / sum;
        int eid[16];
#pragma unroll
        for (int i = 0; i < 16; ++i) { const unsigned f = r3[i] & 0xFFu; eid[i] = (int)ib[f >> 4] * 128 + (int)ib[16 + (f & 15u)]; }
        int* eo = EID + (size_t)tok * 128 + h * 16; float* go = GATE + (size_t)tok * 128 + h * 16;
#pragma unroll
        for (int q = 0; q < 4; ++q) {
            *(u32x4*)(eo + 4 * q) = (u32x4){(unsigned)eid[4 * q], (unsigned)eid[4 * q + 1], (unsigned)eid[4 * q + 2], (unsigned)eid[4 * q + 3]};
            *(f32x4*)(go + 4 * q) = (f32x4){ev[4 * q] * rs, ev[4 * q + 1] * rs, ev[4 * q + 2] * rs, ev[4 * q + 3] * rs};
        }
    }
}

__device__ __forceinline__ float gelu_erf(float x) { return 0.5f * x * (1.0f + erff(x * 0.70710678118654752f)); }
__device__ __forceinline__ float ub0(unsigned w) { return (float)(w & 0xffu); }
__device__ __forceinline__ float ub1(unsigned w) { return (float)((w >> 8) & 0xffu); }
__device__ __forceinline__ float ub2(unsigned w) { return (float)((w >> 16) & 0xffu); }
__device__ __forceinline__ float ub3(unsigned w) { return (float)(w >> 24); }
__device__ __forceinline__ void phase_peer(LAS unsigned char* lds, const float* X, const int* EID, const float* GATE, const unsigned char* U, const unsigned char* V, const float* USC, const float* VSC,
                                           const float* g, const float* bta, float* outf, bf16_t* outb) {
    const int lane = threadIdx.x & 63, wv = threadIdx.x >> 6, gw = blockIdx.x * 8 + wv, nw = gridDim.x * 8;
    LAS float* hb = (LAS float*)(lds + wv * 512);
    for (int tok = gw; tok < MTOK; tok += nw) {
        float x[32];
        const float* xp = X + (size_t)tok * DM;
#pragma unroll
        for (int i = 0; i < 2; ++i)
#pragma unroll
            for (int q = 0; q < 4; ++q) { const f32x4 t = *(const f32x4*)(xp + 1024 * i + 16 * lane + 4 * q); x[16 * i + 4 * q] = t[0]; x[16 * i + 4 * q + 1] = t[1]; x[16 * i + 4 * q + 2] = t[2]; x[16 * i + 4 * q + 3] = t[3]; }
        float sx = 0.f;
#pragma unroll
        for (int j = 0; j < 32; ++j) sx += x[j];
        const float d0 = -128.0f * sx;
        const int e0 = EID[(size_t)tok * 128 + lane], e1 = EID[(size_t)tok * 128 + 64 + lane];
        const float g0 = GATE[(size_t)tok * 128 + lane], g1 = GATE[(size_t)tok * 128 + 64 + lane];
        for (int bt = 0; bt < 16; ++bt) {
            float d[8];
#pragma unroll
            for (int r = 0; r < 8; ++r) {
                const int e = bt * 8 + r;
                const int idx = __builtin_amdgcn_readfirstlane(__shfl(bt < 8 ? e0 : e1, e & 63));
                const u32x4* up = (const u32x4*)(U + (size_t)idx * DM) + lane;
                float acc = d0;
#pragma unroll
                for (int i = 0; i < 2; ++i) {
                    const u32x4 w = up[i * 64];
                    acc += x[16 * i + 0] * ub0(w.x) + x[16 * i + 1] * ub1(w.x) + x[16 * i + 2] * ub2(w.x) + x[16 * i + 3] * ub3(w.x)
                         + x[16 * i + 4] * ub0(w.y) + x[16 * i + 5] * ub1(w.y) + x[16 * i + 6] * ub2(w.y) + x[16 * i + 7] * ub3(w.y)
                         + x[16 * i + 8] * ub0(w.z) + x[16 * i + 9] * ub1(w.z) + x[16 * i + 10] * ub2(w.z) + x[16 * i + 11] * ub3(w.z)
                         + x[16 * i + 12] * ub0(w.w) + x[16 * i + 13] * ub1(w.w) + x[16 * i + 14] * ub2(w.w) + x[16 * i + 15] * ub3(w.w);
                }
                d[r] = acc;
            }
            const bool b5 = lane & 32, b4 = lane & 16, b3 = lane & 8;
            float t4[4];
#pragma unroll
            for (int q = 0; q < 4; ++q) { const float keep = b5 ? d[4 + q] : d[q], send = b5 ? d[q] : d[4 + q]; t4[q] = keep + __shfl_xor(send, 32); }
            float t2[2];
#pragma unroll
            for (int q = 0; q < 2; ++q) { const float keep = b4 ? t4[2 + q] : t4[q], send = b4 ? t4[q] : t4[2 + q]; t2[q] = keep + __shfl_xor(send, 16); }
            float t1;
            { const float keep = b3 ? t2[1] : t2[0], send = b3 ? t2[0] : t2[1]; t1 = keep + __shfl_xor(send, 8); }
            t1 += __shfl_xor(t1, 4); t1 += __shfl_xor(t1, 2); t1 += __shfl_xor(t1, 1);
            if ((lane & 7) == 0) hb[bt * 8 + (lane >> 3 & 1) + 2 * (lane >> 4 & 1) + 4 * (lane >> 5 & 1)] = t1;
        }
        asm volatile("s_waitcnt lgkmcnt(0)" ::: "memory");
        const float h0 = hb[lane] * USC[e0], h1 = hb[64 + lane] * USC[e1];
        const float w0 = g0 * gelu_erf(h0) * VSC[e0], w1 = g1 * gelu_erf(h1) * VSC[e1];
        float wsum = wave_sum(w0 + w1);
        float y[32];
#pragma unroll
        for (int i = 0; i < 32; ++i) y[i] = 0.f;
#pragma unroll 8
        for (int e = 0; e < 128; ++e) {
            const int idx = __builtin_amdgcn_readfirstlane(__shfl(e < 64 ? e0 : e1, e & 63));
            const float wt = __shfl(e < 64 ? w0 : w1, e & 63);
            const u32x4* vp = (const u32x4*)(V + (size_t)idx * DM) + lane;
#pragma unroll
            for (int i = 0; i < 2; ++i) {
                const u32x4 w = vp[i * 64];
                y[16 * i + 0] += wt * ub0(w.x); y[16 * i + 1] += wt * ub1(w.x); y[16 * i + 2] += wt * ub2(w.x); y[16 * i + 3] += wt * ub3(w.x);
                y[16 * i + 4] += wt * ub0(w.y); y[16 * i + 5] += wt * ub1(w.y); y[16 * i + 6] += wt * ub2(w.y); y[16 * i + 7] += wt * ub3(w.y);
                y[16 * i + 8] += wt * ub0(w.z); y[16 * i + 9] += wt * ub1(w.z); y[16 * i + 10] += wt * ub2(w.z); y[16 * i + 11] += wt * ub3(w.z);
                y[16 * i + 12] += wt * ub0(w.w); y[16 * i + 13] += wt * ub1(w.w); y[16 * i + 14] += wt * ub2(w.w); y[16 * i + 15] += wt * ub3(w.w);
            }
        }
        const float corr = -128.0f * wsum;
#pragma unroll
        for (int i = 0; i < 32; ++i) y[i] = y[i] + corr + ALPHA * x[i];
        ln_row_store16(y, g, bta, outf + (size_t)tok * DM, outb ? outb + (size_t)tok * DM : nullptr, lane);
        asm volatile("s_waitcnt lgkmcnt(0)" ::: "memory");
    }
}

__device__ __forceinline__ int row_dot_i8(const u32x4 (&xq)[2], const unsigned char* rowp, int lane) {
    const u32x4* up = (const u32x4*)rowp + lane;
    int acc = 0;
#pragma unroll
    for (int i = 0; i < 2; ++i) {
        const u32x4 w = up[i * 64];
        acc = __builtin_amdgcn_sdot4((int)xq[i].x, (int)(w.x ^ 0x80808080u), acc, false); acc = __builtin_amdgcn_sdot4((int)xq[i].y, (int)(w.y ^ 0x80808080u), acc, false);
        acc = __builtin_amdgcn_sdot4((int)xq[i].z, (int)(w.z ^ 0x80808080u), acc, false); acc = __builtin_amdgcn_sdot4((int)xq[i].w, (int)(w.w ^ 0x80808080u), acc, false);
    }
    return acc;
}
__device__ __forceinline__ void peer_issue8(u32x4 (&seg)[8], const unsigned char* base, const u32x4 ia, const u32x4 ib) {
    seg[0] = *(const u32x4*)(base + (size_t)ia.x * DM); seg[1] = *(const u32x4*)(base + (size_t)ia.y * DM); seg[2] = *(const u32x4*)(base + (size_t)ia.z * DM); seg[3] = *(const u32x4*)(base + (size_t)ia.w * DM);
    seg[4] = *(const u32x4*)(base + (size_t)ib.x * DM); seg[5] = *(const u32x4*)(base + (size_t)ib.y * DM); seg[6] = *(const u32x4*)(base + (size_t)ib.z * DM); seg[7] = *(const u32x4*)(base + (size_t)ib.w * DM);
}
__device__ __forceinline__ void peer_dot8(int (&d)[8], const u32x4 (&seg)[8], const u32x4 xq) {
#pragma unroll
    for (int i = 0; i < 8; ++i) {
        int acc = __builtin_amdgcn_sdot4((int)xq.x, (int)(seg[i].x ^ 0x80808080u), 0, false);
        acc = __builtin_amdgcn_sdot4((int)xq.y, (int)(seg[i].y ^ 0x80808080u), acc, false);
        acc = __builtin_amdgcn_sdot4((int)xq.z, (int)(seg[i].z ^ 0x80808080u), acc, false);
        d[i] = __builtin_amdgcn_sdot4((int)xq.w, (int)(seg[i].w ^ 0x80808080u), acc, false);
    }
}
__device__ __forceinline__ void phase_peer_u(const signed char* XQ, const int* EID, const unsigned char* U, LAS int* HL  ) {
    const int lane = threadIdx.x & 63, wv = threadIdx.x >> 6, es = lane >> 3, cc = lane & 7;
    const bool b2 = cc & 4, b1 = cc & 2, b0 = cc & 1;
    const int nw = gridDim.x * 8, gw = blockIdx.x * 8 + wv, tpw = (MTOK + nw - 1) / nw, tbase = gw * tpw;
    int cnt = MTOK - tbase; cnt = cnt > tpw ? tpw : cnt;
    if (cnt <= 0) return;
    for (int i = lane; i < cnt * 128; i += 64) HL[i] = 0;
    asm volatile("s_waitcnt lgkmcnt(0)" ::: "memory");
    const int nit = 16 * cnt;
    const unsigned char* ub = U + cc * 16;
    u32x4 m0a, m0b, m0c, m0d, m0x, m1a, m1b, m1c, m1d, m1x, m2a, m2b, m2c, m2d, m2x; u32x4 sA[8], sB[8];
#define PU_LOAD(sl_, k_, A_, B_, C_, D_, X_) { const int* ep_ = EID + (size_t)(tbase + (k_)) * 128 + es * 16; A_ = *(const u32x4*)ep_; B_ = *(const u32x4*)(ep_ + 4); C_ = *(const u32x4*)(ep_ + 8); D_ = *(const u32x4*)(ep_ + 12); \
        X_ = *(const u32x4*)(XQ + (size_t)(tbase + (k_)) * DM + (sl_) * 128 + cc * 16); }
#define PU_NEXT(sl_, k_, sn_, kn_) { kn_ = (k_) + 1; sn_ = (sl_); if (kn_ == cnt) { kn_ = 0; ++sn_; } if (sn_ == 16) { sn_ = 15; kn_ = cnt - 1; } }
    int sl = 0, k = 0, sl1, k1, sl2, k2;
    PU_NEXT(sl, k, sl1, k1) PU_NEXT(sl1, k1, sl2, k2)
    PU_LOAD(sl, k, m0a, m0b, m0c, m0d, m0x)
    PU_LOAD(sl1, k1, m1a, m1b, m1c, m1d, m1x)
    peer_issue8(sA, ub + sl * 128, m0a, m0b);
    for (int it = 0; it < nit; ++it) {
        PU_LOAD(sl2, k2, m2a, m2b, m2c, m2d, m2x)
        peer_issue8(sB, ub + sl * 128, m0c, m0d);
        int dlo[8]; peer_dot8(dlo, sA, m0x);
        peer_issue8(sA, ub + sl1 * 128, m1a, m1b);
        int dhi[8]; peer_dot8(dhi, sB, m0x);
        int t8[8], t4[4], t2[2];
#pragma unroll
        for (int q = 0; q < 8; ++q) { const int keep = b2 ? dhi[q] : dlo[q], send = b2 ? dlo[q] : dhi[q]; t8[q] = keep + __shfl_xor(send, 4); }
#pragma unroll
        for (int q = 0; q < 4; ++q) { const int keep = b1 ? t8[4 + q] : t8[q], send = b1 ? t8[q] : t8[4 + q]; t4[q] = keep + __shfl_xor(send, 2); }
#pragma unroll
        for (int q = 0; q < 2; ++q) { const int keep = b0 ? t4[2 + q] : t4[q], send = b0 ? t4[q] : t4[2 + q]; t2[q] = keep + __shfl_xor(send, 1); }
        { LAS int* hp = HL + k * 128 + es * 16 + (b2 ? 8 : 0) + (b1 ? 4 : 0) + (b0 ? 2 : 0);
          __hip_atomic_fetch_add(hp, t2[0], __ATOMIC_RELAXED, __HIP_MEMORY_SCOPE_WORKGROUP); __hip_atomic_fetch_add(hp + 1, t2[1], __ATOMIC_RELAXED, __HIP_MEMORY_SCOPE_WORKGROUP); }
        sl = sl1; k = k1; sl1 = sl2; k1 = k2; PU_NEXT(sl1, k1, sl2, k2)
        m0a = m1a; m0b = m1b; m0c = m1c; m0d = m1d; m0x = m1x; m1a = m2a; m1b = m2b; m1c = m2c; m1d = m2d; m1x = m2x;
    }
#undef PU_LOAD
#undef PU_NEXT
}
__device__ __forceinline__ void phase_peer_w(const LAS int* HL, const float* XS, const int* EID, const float* GATE, const float* USC, const float* VSC, signed char* WQ, float* SW) {
    const int lane = threadIdx.x & 63, gw = blockIdx.x * 8 + (threadIdx.x >> 6), nw = gridDim.x * 8, tpw = (MTOK + nw - 1) / nw, tbase = gw * tpw;
    const int tend = tbase + tpw < MTOK ? tbase + tpw : MTOK;
    for (int tok = tbase; tok < tend; ++tok) {
        const int h0 = HL[(tok - tbase) * 128 + lane], h1 = HL[(tok - tbase) * 128 + 64 + lane];
        const int e0 = EID[(size_t)tok * 128 + lane], e1 = EID[(size_t)tok * 128 + 64 + lane];
        const float xs = XS[tok];
        const float w0 = GATE[(size_t)tok * 128 + lane] * gelu_erf((float)h0 * xs * USC[e0]) * VSC[e0];
        const float w1 = GATE[(size_t)tok * 128 + 64 + lane] * gelu_erf((float)h1 * xs * USC[e1]) * VSC[e1];
        const float am = fmaxf(wave_max(fmaxf(fabsf(w0), fabsf(w1))), 1e-30f), inv = 127.0f / am;
        WQ[(size_t)tok * 128 + lane] = (signed char)(int)rintf(w0 * inv); WQ[(size_t)tok * 128 + 64 + lane] = (signed char)(int)rintf(w1 * inv);
        if (lane == 0) SW[tok] = am * (1.0f / 127.0f);
    }
}
__device__ __forceinline__ void peer_dot4x4(int (&acc)[16], const u32x4 sa, const u32x4 sb, const u32x4 sc, const u32x4 sd, const unsigned w4) {
#pragma unroll
    for (int k = 0; k < 4; ++k) {
        const unsigned A = sa[k], B = sb[k], C = sc[k], D = sd[k];
        const unsigned p0 = __builtin_amdgcn_perm(B, A, 0x05010400u);
        const unsigned p1 = __builtin_amdgcn_perm(B, A, 0x07030602u);
        const unsigned p2 = __builtin_amdgcn_perm(D, C, 0x05010400u);
        const unsigned p3 = __builtin_amdgcn_perm(D, C, 0x07030602u);
        const unsigned t0 = __builtin_amdgcn_perm(p2, p0, 0x05040100u);
        const unsigned t1 = __builtin_amdgcn_perm(p2, p0, 0x07060302u);
        const unsigned t2 = __builtin_amdgcn_perm(p3, p1, 0x05040100u);
        const unsigned t3 = __builtin_amdgcn_perm(p3, p1, 0x07060302u);
        acc[4 * k + 0] = __builtin_amdgcn_sdot4((int)t0, (int)w4, acc[4 * k + 0], false);
        acc[4 * k + 1] = __builtin_amdgcn_sdot4((int)t1, (int)w4, acc[4 * k + 1], false);
        acc[4 * k + 2] = __builtin_amdgcn_sdot4((int)t2, (int)w4, acc[4 * k + 2], false);
        acc[4 * k + 3] = __builtin_amdgcn_sdot4((int)t3, (int)w4, acc[4 * k + 3], false);
    }
}
__device__ __forceinline__ void phase_peer_v(const bf16_t* X, const int* EID, const signed char* WQ, const float* SW, const unsigned char* V, float* Y) {
    const int lane = threadIdx.x & 63, wv = threadIdx.x >> 6, es = lane >> 3, cc = lane & 7;
    const bool b5 = lane & 32, b4 = lane & 16, b3 = lane & 8;
    const int nw = gridDim.x * 8, gw = blockIdx.x * 8 + wv, tpw = (MTOK + nw - 1) / nw, tbase = gw * tpw;
    int cnt = MTOK - tbase; cnt = cnt > tpw ? tpw : cnt;
    if (cnt <= 0) return;
    const int nit = 16 * cnt;
    const unsigned char* vb = V + cc * 16;
    const int colo = cc * 16 + (b5 ? 8 : 0) + (b4 ? 4 : 0) + (b3 ? 2 : 0);
    u32x4 m0c, m0d, m1a, m1b, m1c, m1d, m2a, m2b, m2c, m2d; u32x4 w0, w1; unsigned x0, x1; float c0, c1; u32x4 sA[8], sB[8];
#define PV_IDS(k_, A_, B_, C_, D_) { const size_t o_ = (size_t)(tbase + (k_)) * 128 + es * 16; A_ = *(const u32x4*)(EID + o_); B_ = *(const u32x4*)(EID + o_ + 4); C_ = *(const u32x4*)(EID + o_ + 8); D_ = *(const u32x4*)(EID + o_ + 12); }
#define PV_WX(sl_, k_, W_, X_, CS_) { W_ = *(const u32x4*)(WQ + (size_t)(tbase + (k_)) * 128 + es * 16); \
        X_ = *(const unsigned*)(X + (size_t)(tbase + (k_)) * DM + (sl_) * 128 + colo); CS_ = SW[tbase + (k_)]; }
#define PV_NEXT(sl_, k_, sn_, kn_) { kn_ = (k_) + 1; sn_ = (sl_); if (kn_ == cnt) { kn_ = 0; ++sn_; } if (sn_ == 16) { sn_ = 15; kn_ = cnt - 1; } }
    int sl = 0, k = 0, sl1, k1, sl2, k2;
    PV_NEXT(sl, k, sl1, k1) PV_NEXT(sl1, k1, sl2, k2)
    { u32x4 ta, tb; PV_IDS(k, ta, tb, m0c, m0d) PV_IDS(k1, m1a, m1b, m1c, m1d)
      PV_WX(sl, k, w0, x0, c0)
      peer_issue8(sA, vb + sl * 128, ta, tb); }
    for (int it = 0; it < nit; ++it) {
        PV_IDS(k2, m2a, m2b, m2c, m2d)
        peer_issue8(sB, vb + sl * 128, m0c, m0d);
        int ya[16];
#pragma unroll
        for (int j = 0; j < 16; ++j) ya[j] = 0;
        peer_dot4x4(ya, sA[0], sA[1], sA[2], sA[3], w0.x); peer_dot4x4(ya, sA[4], sA[5], sA[6], sA[7], w0.y);
        peer_issue8(sA, vb + sl1 * 128, m1a, m1b);
        PV_WX(sl1, k1, w1, x1, c1)
        peer_dot4x4(ya, sB[0], sB[1], sB[2], sB[3], w0.z); peer_dot4x4(ya, sB[4], sB[5], sB[6], sB[7], w0.w);
        int t8[8], t4[4], t2[2];
#pragma unroll
        for (int q = 0; q < 8; ++q) { const int keep = b5 ? ya[8 + q] : ya[q], send = b5 ? ya[q] : ya[8 + q]; t8[q] = keep + __shfl_xor(send, 32); }
#pragma unroll
        for (int q = 0; q < 4; ++q) { const int keep = b4 ? t8[4 + q] : t8[q], send = b4 ? t8[q] : t8[4 + q]; t4[q] = keep + __shfl_xor(send, 16); }
#pragma unroll
        for (int q = 0; q < 2; ++q) { const int keep = b3 ? t4[2 + q] : t4[q], send = b3 ? t4[q] : t4[2 + q]; t2[q] = keep + __shfl_xor(send, 8); }
        f32x2_t o; o[0] = (float)t2[0] * c0 + ALPHA * bflo(x0); o[1] = (float)t2[1] * c0 + ALPHA * bfhi(x0);
        *(f32x2_t*)(Y + (size_t)(tbase + k) * DM + sl * 128 + colo) = o;
        sl = sl1; k = k1; sl1 = sl2; k1 = k2; PV_NEXT(sl1, k1, sl2, k2)
        m0c = m1c; m0d = m1d; m1a = m2a; m1b = m2b; m1c = m2c; m1d = m2d;
        w0 = w1; x0 = x1; c0 = c1;
    }
#undef PV_IDS
#undef PV_WX
#undef PV_NEXT
}

__device__ __forceinline__ void rot8(const u32x4 lo, const u32x4 hi, const f32x4 c0, const f32x4 c1, const f32x4 s0, const f32x4 s1, float (&o1)[8], float (&o2)[8]) {
    const float a[8] = {bflo(lo.x), bfhi(lo.x), bflo(lo.y), bfhi(lo.y), bflo(lo.z), bfhi(lo.z), bflo(lo.w), bfhi(lo.w)};
    const float b[8] = {bflo(hi.x), bfhi(hi.x), bflo(hi.y), bfhi(hi.y), bflo(hi.z), bfhi(hi.z), bflo(hi.w), bfhi(hi.w)};
    const float c[8] = {c0[0], c0[1], c0[2], c0[3], c1[0], c1[1], c1[2], c1[3]}, sn[8] = {s0[0], s0[1], s0[2], s0[3], s1[0], s1[1], s1[2], s1[3]};
#pragma unroll
    for (int j = 0; j < 8; ++j) { o1[j] = a[j] * c[j] - b[j] * sn[j]; o2[j] = a[j] * sn[j] + b[j] * c[j]; }
}
__device__ __forceinline__ u32x4 pack8(const float (&o)[8]) { u32x4 w; w.x = pk_bf16(o[0], o[1]); w.y = pk_bf16(o[2], o[3]); w.z = pk_bf16(o[4], o[5]); w.w = pk_bf16(o[6], o[7]); return w; }
__device__ __forceinline__ void phase_kstat(LAS float* red, const bf16_t* KR, float* KMEAN, float* KNMAX) {
    const int tid = threadIdx.x, ch = tid & 7, rr = tid >> 3, wv = tid >> 6, lane = tid & 63;
    for (int item = blockIdx.x; item < 2 * NHEAD * 32; item += gridDim.x) {
        const int bh = item >> 5, j = item & 31, b = bh >> 4, h = bh & 15;
        float sm1[8], sm2[8]; float nmax = 0.f;
#pragma unroll
        for (int q = 0; q < 8; ++q) { sm1[q] = 0.f; sm2[q] = 0.f; }
        u32x4 lo[4], hi[4];
#pragma unroll
        for (int ps = 0; ps < 4; ++ps) { const size_t off = ((size_t)b * SEQ + j * 256 + ps * 64 + rr) * DM + h * 128 + ch * 8; lo[ps] = *(const u32x4*)(KR + off); hi[ps] = *(const u32x4*)(KR + off + 64); }
#pragma unroll
        for (int ps = 0; ps < 4; ++ps) {
            const float a[8] = {bflo(lo[ps].x), bfhi(lo[ps].x), bflo(lo[ps].y), bfhi(lo[ps].y), bflo(lo[ps].z), bfhi(lo[ps].z), bflo(lo[ps].w), bfhi(lo[ps].w)};
            const float c[8] = {bflo(hi[ps].x), bfhi(hi[ps].x), bflo(hi[ps].y), bfhi(hi[ps].y), bflo(hi[ps].z), bfhi(hi[ps].z), bflo(hi[ps].w), bfhi(hi[ps].w)};
            float nq = 0.f;
#pragma unroll
            for (int q = 0; q < 8; ++q) { sm1[q] += a[q]; sm2[q] += c[q]; nq += a[q] * a[q] + c[q] * c[q]; }
            nq += __shfl_xor(nq, 1); nq += __shfl_xor(nq, 2); nq += __shfl_xor(nq, 4);
            nmax = fmaxf(nmax, nq);
        }
#pragma unroll
        for (int q = 0; q < 8; ++q) {
            sm1[q] += __shfl_xor(sm1[q], 8); sm1[q] += __shfl_xor(sm1[q], 16); sm1[q] += __shfl_xor(sm1[q], 32);
            sm2[q] += __shfl_xor(sm2[q], 8); sm2[q] += __shfl_xor(sm2[q], 16); sm2[q] += __shfl_xor(sm2[q], 32);
        }
        nmax = wave_max(nmax);
        if (lane < 8) {
#pragma unroll
            for (int q = 0; q < 8; ++q) { red[wv * 128 + lane * 8 + q] = sm1[q]; red[wv * 128 + 64 + lane * 8 + q] = sm2[q]; }
        }
        if (lane == 0) red[1024 + wv] = nmax;
        __syncthreads();
        if (tid < 128) {
            float s2 = 0.f;
#pragma unroll
            for (int r = 0; r < 8; ++r) s2 += red[r * 128 + tid];
            KMEAN[(size_t)item * 128 + tid] = s2 * (1.0f / 256.0f);
        }
        if (tid == 0) {
            float m = 0.f;
#pragma unroll
            for (int r = 0; r < 8; ++r) m = fmaxf(m, red[1024 + r]);
            KNMAX[item] = sqrtf(m);
        }
        __syncthreads();
    }
}

__device__ __forceinline__ void top3_insert(float x, int m, float& v0, int& i0, float& v1, int& i1, float& v2, int& i2) {
    const bool c0 = x > v0 || (x == v0 && m < i0), c1 = x > v1 || (x == v1 && m < i1), c2 = x > v2 || (x == v2 && m < i2);
    v2 = c1 ? v1 : (c2 ? x : v2); i2 = c1 ? i1 : (c2 ? m : i2);
    v1 = c0 ? v0 : (c1 ? x : v1); i1 = c0 ? i0 : (c1 ? m : i1);
    v0 = c0 ? x : v0; i0 = c0 ? m : i0;
}
__device__ __forceinline__ void phase_sel(LAS unsigned char* lds, const bf16_t* QR, const float* KMEAN, unsigned short* SUB, int* CNT, int* ctr) {
    const int tid = threadIdx.x, lane = tid & 63, wv = tid >> 6, r32 = lane & 31, hh = lane >> 5;
    LAS unsigned short* bucket = (LAS unsigned short*)lds;
    LAS int* cnt = (LAS int*)(lds + 16384);
    const float NEG = -1e30f;
    if (blockIdx.x == 0 && tid == 0) *ctr = 0;
    for (int item = blockIdx.x; item < 2 * NHEAD * 32; item += gridDim.x) {
        const int bh = item >> 5, i = item & 31, b = bh >> 4, h = bh & 15;
        if (i == 0) continue;
        if (tid < 32) cnt[tid] = 0;
        __syncthreads();
        const float* kmp = KMEAN + ((size_t)bh * 32 + r32) * 128 + 8 * hh;
        const size_t tok = (size_t)b * SEQ + i * 256 + wv * 32 + r32;
        const bf16_t* qp = QR + tok * DM + h * 128 + 8 * hh;
        f32x16 S;
#pragma unroll
        for (int e = 0; e < 16; ++e) S[e] = 0.f;
#pragma unroll
        for (int s2 = 0; s2 < 8; ++s2) {
            const f32x4 ka = *(const f32x4*)(kmp + 16 * s2), kb = *(const f32x4*)(kmp + 16 * s2 + 4);
            const bf16x8 qf = *(const bf16x8*)(qp + 16 * s2);
            u32x4 hi, lo;
            hi.x = pk_bf16(ka[0], ka[1]); hi.y = pk_bf16(ka[2], ka[3]); hi.z = pk_bf16(kb[0], kb[1]); hi.w = pk_bf16(kb[2], kb[3]);
            lo.x = pk_bf16(ka[0] - bflo(hi.x), ka[1] - bfhi(hi.x)); lo.y = pk_bf16(ka[2] - bflo(hi.y), ka[3] - bfhi(hi.y));
            lo.z = pk_bf16(kb[0] - bflo(hi.z), kb[1] - bfhi(hi.z)); lo.w = pk_bf16(kb[2] - bflo(hi.w), kb[3] - bfhi(hi.w));
            S = __builtin_amdgcn_mfma_f32_32x32x16_bf16(__builtin_bit_cast(bf16x8, hi), qf, S, 0, 0, 0);
            S = __builtin_amdgcn_mfma_f32_32x32x16_bf16(__builtin_bit_cast(bf16x8, lo), qf, S, 0, 0, 0);
        }
        float v0 = -3e38f, v1 = -3e38f, v2 = -3e38f; int i0 = 99, i1 = 99, i2 = 99;
#pragma unroll
        for (int e = 0; e < 16; ++e) {
            const int m = (e & 3) + 8 * (e >> 2) + 4 * hh;
            const float x = m < i ? S[e] : NEG;
            top3_insert(x, m, v0, i0, v1, i1, v2, i2);
        }
        {
            const float pv0 = __shfl_xor(v0, 32), pv1 = __shfl_xor(v1, 32), pv2 = __shfl_xor(v2, 32);
            const int pi0 = __shfl_xor(i0, 32), pi1 = __shfl_xor(i1, 32), pi2 = __shfl_xor(i2, 32);
            top3_insert(pv0, pi0, v0, i0, v1, i1, v2, i2); top3_insert(pv1, pi1, v0, i0, v1, i1, v2, i2); top3_insert(pv2, pi2, v0, i0, v1, i1, v2, i2);
        }
        if (hh == 0) {
            const int tl = wv * 32 + r32;
            if (v0 > 0.5f * NEG) { const int p = __hip_atomic_fetch_add(cnt + i0, 1, __ATOMIC_RELAXED, __HIP_MEMORY_SCOPE_WORKGROUP); bucket[i0 * 256 + p] = (unsigned short)(tl | (0 << 8)); }
            if (v1 > 0.5f * NEG) { const int p = __hip_atomic_fetch_add(cnt + i1, 1, __ATOMIC_RELAXED, __HIP_MEMORY_SCOPE_WORKGROUP); bucket[i1 * 256 + p] = (unsigned short)(tl | (1 << 8)); }
            if (v2 > 0.5f * NEG) { const int p = __hip_atomic_fetch_add(cnt + i2, 1, __ATOMIC_RELAXED, __HIP_MEMORY_SCOPE_WORKGROUP); bucket[i2 * 256 + p] = (unsigned short)(tl | (2 << 8)); }
        }
        __syncthreads();
        for (int idx = tid; idx < 32 * 256; idx += 512) {
            const int j = idx >> 8, p = idx & 255;
            if (j < i && p < cnt[j]) SUB[(((size_t)bh * 32 + j) * 32 + i) * 256 + p] = bucket[idx];
        }
        if (tid < i) CNT[((size_t)bh * 32 + tid) * 32 + i] = cnt[tid];
        __syncthreads();
    }
}

__device__ __forceinline__ unsigned off_b(unsigned row, unsigned ch) { return 256u * row + 16u * (ch ^ (((row & 3u) << 2) | ((row >> 2) & 3u))); }
__device__ __forceinline__ unsigned pi32(unsigned m) { return (m & ~12u) | ((m & 4u) << 1) | ((m & 8u) >> 1); }
__device__ __forceinline__ bf16x8 tr_frag(LAS unsigned char* img, unsigned lane, unsigned c, unsigned ks) {
    const unsigned hh = lane >> 5, blk = (lane >> 4) & 1, q = (lane & 15) >> 2, p = lane & 3;
    const unsigned a0 = off_b(16 * ks + 8 * hh + q, 4 * c + 2 * blk + (p >> 1)) + 8 * (p & 1);
    const unsigned a1 = off_b(16 * ks + 8 * hh + 4 + q, 4 * c + 2 * blk + (p >> 1)) + 8 * (p & 1);
    const s16x4 lo = __builtin_amdgcn_ds_read_tr16_b64_v4i16((LAS s16x4*)(img + a0));
    const s16x4 hi = __builtin_amdgcn_ds_read_tr16_b64_v4i16((LAS s16x4*)(img + a1));
    bf16x8 r; r[0] = lo[0]; r[1] = lo[1]; r[2] = lo[2]; r[3] = lo[3]; r[4] = hi[0]; r[5] = hi[1]; r[6] = hi[2]; r[7] = hi[3];
    return r;
}
__device__ __forceinline__ void phase_att(LAS unsigned char* lds, const bf16_t* QR, const bf16_t* KR, const bf16_t* V, const float* KNMAX, const unsigned short* SUB, const int* CNT, int* ctr,
                                          bf16_t* P012, bf16_t* P3, float* LS) {
    const int tid = threadIdx.x, lane = tid & 63, wv = tid >> 6, r32 = lane & 31, hh = lane >> 5;
    LAS unsigned char* Kimg = lds;
    LAS unsigned char* Vimg = lds + 65536;
    LAS int* misc = (LAS int*)(lds + 131072);
    const float SCL2 = 0.08838834764831845f * 1.4426950408889634f;
    for (;;) {
        __syncthreads();
        if (tid == 0) misc[40] = __hip_atomic_fetch_add(ctr, 1, __ATOMIC_RELAXED, __HIP_MEMORY_SCOPE_AGENT);
        __syncthreads();
        const int item = misc[40];
        if (item >= 2 * NHEAD * 32) break;
        const int j = item >> 5, bh = item & 31, b = bh >> 4, h = bh & 15;
#pragma unroll
        for (int r = 0; r < 8; ++r) {
            const int idx = tid + 512 * r, row = idx >> 4, ch = idx & 15;
            const size_t g = ((size_t)b * SEQ + j * 256 + row) * DM + h * 128 + ch * 8;
            const u32x4 kv = *(const u32x4*)(KR + g), vv = *(const u32x4*)(V + g);
            *(LAS u32x4*)(Kimg + off_b(row, ch)) = kv; *(LAS u32x4*)(Vimg + off_b(row, ch)) = vv;
        }
        if (tid <= 32) { int pre = 0; for (int u = j + 1; u < tid; ++u) pre += CNT[((size_t)bh * 32 + j) * 32 + u]; misc[tid] = pre; }
        float kn = (lane < 32) ? KNMAX[bh * 32 + lane] : 0.f;
        kn = wave_max(kn);
        __syncthreads();
        const int total = misc[32], ntile = (256 + total + 31) >> 5;
        for (int tile = wv; tile < ntile; tile += 8) {
            const int gr = tile * 32 + r32;
            int pos, slot; bool valid = true;
            if (gr < 256) { pos = j * 256 + gr; slot = 3; }
            else {
                const int x = gr - 256; valid = x < total;
                int ii = j + 1;
                for (int u = j + 1; u < 32; ++u) if (misc[u] <= x) ii = u;
                if (valid) { const unsigned e = SUB[(((size_t)bh * 32 + j) * 32 + ii) * 256 + (x - misc[ii])]; pos = ii * 256 + (int)(e & 255u); slot = (int)(e >> 8); }
                else { pos = j * 256; slot = 3; }
            }
            const size_t tok = (size_t)b * SEQ + pos;
            bf16x8 qf[8];
            const bf16_t* qp = QR + tok * DM + h * 128 + 8 * hh;
#pragma unroll
            for (int s = 0; s < 8; ++s) qf[s] = *(const bf16x8*)(qp + 16 * s);
            float qn2 = 0.f;
#pragma unroll
            for (int s = 0; s < 8; ++s)
#pragma unroll
                for (int e = 0; e < 8; ++e) { const float f = bf2f((bf16_t)qf[s][e]); qn2 += f * f; }
            qn2 += __shfl_xor(qn2, 32);
            const float c2 = sqrtf(qn2) * kn * SCL2;
            f32x16 O[4];
#pragma unroll
            for (int dt = 0; dt < 4; ++dt)
#pragma unroll
                for (int e = 0; e < 16; ++e) O[dt][e] = 0.f;
            float l = 0.f;
            const bool own = tile < 8;
            const int kcn = own ? tile + 1 : 8;
            const unsigned krow = pi32((unsigned)r32);
            for (int kc = 0; kc < kcn; ++kc) {
                f32x16 S, S1;
#pragma unroll
                for (int e = 0; e < 16; ++e) { S[e] = 0.f; S1[e] = 0.f; }
#pragma unroll
                for (int s = 0; s < 8; s += 2) {
                    const bf16x8 kf = *(const LAS bf16x8*)(Kimg + off_b(32 * kc + krow, 2 * s + hh));
                    const bf16x8 kf1 = *(const LAS bf16x8*)(Kimg + off_b(32 * kc + krow, 2 * s + 2 + hh));
                    S = __builtin_amdgcn_mfma_f32_32x32x16_bf16(kf, qf[s], S, 0, 0, 0);
                    S1 = __builtin_amdgcn_mfma_f32_32x32x16_bf16(kf1, qf[s + 1], S1, 0, 0, 0);
                }
                float p[16];
                if (own) {
#pragma unroll
                    for (int e = 0; e < 16; ++e) {
                        const unsigned m = (e & 3) + 8 * (e >> 2) + 4 * hh;
                        const int key = j * 256 + 32 * kc + (int)pi32(m);
                        float pe = __builtin_amdgcn_exp2f((S[e] + S1[e]) * SCL2 - c2);
                        if (key > pos) pe = 0.f;
                        p[e] = pe; l += pe;
                    }
                } else {
#pragma unroll
                    for (int e = 0; e < 16; ++e) { const float pe = __builtin_amdgcn_exp2f((S[e] + S1[e]) * SCL2 - c2); p[e] = pe; l += pe; }
                }
                u32x4 w0, w1;
                w0.x = pk_bf16(p[0], p[1]); w0.y = pk_bf16(p[2], p[3]); w0.z = pk_bf16(p[4], p[5]); w0.w = pk_bf16(p[6], p[7]);
                w1.x = pk_bf16(p[8], p[9]); w1.y = pk_bf16(p[10], p[11]); w1.z = pk_bf16(p[12], p[13]); w1.w = pk_bf16(p[14], p[15]);
                const bf16x8 pf0 = __builtin_bit_cast(bf16x8, w0), pf1 = __builtin_bit_cast(bf16x8, w1);
#pragma unroll
                for (int dt = 0; dt < 4; ++dt) {
                    const bf16x8 v0 = tr_frag(Vimg, lane, dt, 2 * kc), v1 = tr_frag(Vimg, lane, dt, 2 * kc + 1);
                    O[dt] = __builtin_amdgcn_mfma_f32_32x32x16_bf16(v0, pf0, O[dt], 0, 0, 0);
                    O[dt] = __builtin_amdgcn_mfma_f32_32x32x16_bf16(v1, pf1, O[dt], 0, 0, 0);
                }
            }
            l += __shfl_xor(l, 32);
            if (valid) {
                bf16_t* pl = (slot < 3 ? P012 + (size_t)slot * ((size_t)32 << 20) : P3) + (tok * NHEAD + h) * 128 + 4 * hh;
#pragma unroll
                for (int dt = 0; dt < 4; ++dt)
#pragma unroll
                    for (int g = 0; g < 4; ++g) {
                        u32x2 w; w.x = pk_bf16(O[dt][4 * g], O[dt][4 * g + 1]); w.y = pk_bf16(O[dt][4 * g + 2], O[dt][4 * g + 3]);
                        *(u32x2*)(pl + 32 * dt + 8 * g) = w;
                    }
                if (hh == 0) LS[(size_t)slot * MTOK * NHEAD + tok * NHEAD + h] = l;
            }
        }
    }
}
__device__ __forceinline__ void phase_comb(const bf16_t* P012, const bf16_t* P3, const float* LS, bf16_t* AO) {
    const size_t n = (size_t)MTOK * NHEAD * 16, stride = (size_t)gridDim.x * 512;
    for (size_t idx = (size_t)blockIdx.x * 512 + threadIdx.x; idx < n; idx += stride) {
        const size_t th = idx >> 4; const int ch = (int)(idx & 15);
        const int t = (int)((th >> 4) & (SEQ - 1)), blk = t >> 8, nsel = blk < 3 ? blk : 3;
        float acc[8];
        float l = LS[(size_t)3 * MTOK * NHEAD + th];
        { const u32x4 w = *(const u32x4*)(P3 + th * 128 + ch * 8);
          acc[0] = bflo(w.x); acc[1] = bfhi(w.x); acc[2] = bflo(w.y); acc[3] = bfhi(w.y); acc[4] = bflo(w.z); acc[5] = bfhi(w.z); acc[6] = bflo(w.w); acc[7] = bfhi(w.w); }
#pragma unroll
        for (int s = 0; s < 3; ++s) {
            u32x4 w = *(const u32x4*)(P012 + (size_t)s * ((size_t)32 << 20) + th * 128 + ch * 8);
            float ls = LS[(size_t)s * MTOK * NHEAD + th];
            if (s >= nsel) { w = (u32x4){0u, 0u, 0u, 0u}; ls = 0.f; }
            acc[0] += bflo(w.x); acc[1] += bfhi(w.x); acc[2] += bflo(w.y); acc[3] += bfhi(w.y); acc[4] += bflo(w.z); acc[5] += bfhi(w.z); acc[6] += bflo(w.w); acc[7] += bfhi(w.w);
            l += ls;
        }
        const float rl = 1.0f / l;
        u32x4 o; o.x = pk_bf16(acc[0] * rl, acc[1] * rl); o.y = pk_bf16(acc[2] * rl, acc[3] * rl); o.z = pk_bf16(acc[4] * rl, acc[5] * rl); o.w = pk_bf16(acc[6] * rl, acc[7] * rl);
        *(u32x4*)(AO + th * 128 + ch * 8) = o;
    }
}


__device__ __forceinline__ void qrow_issue(f32x4 (&v)[8], const float* p, int lane) {
#pragma unroll
    for (int i = 0; i < 2; ++i)
#pragma unroll
        for (int q = 0; q < 4; ++q) v[i * 4 + q] = *(const f32x4*)(p + 1024 * i + 16 * lane + 4 * q);
}
__device__ __forceinline__ void qrow_finish(const f32x4 (&v)[8], unsigned char* dst, float* scl, int lane, bool sgn = false) {
    float am = 0.f;
#pragma unroll
    for (int i = 0; i < 8; ++i) am = fmaxf(am, fmaxf(fmaxf(fabsf(v[i][0]), fabsf(v[i][1])), fmaxf(fabsf(v[i][2]), fabsf(v[i][3]))));
    am = fmaxf(wave_max(am), 1e-30f);
    const float inv = 127.0f / am;
    if (lane == 0) *scl = am * (1.0f / 127.0f);
#pragma unroll
    for (int i = 0; i < 2; ++i) {
        u32x4 w;
#pragma unroll
        for (int q = 0; q < 4; ++q) {
            const f32x4 t = v[i * 4 + q];
            const float off = sgn ? 0.0f : 128.0f;
            const unsigned b0 = (unsigned)(int)(rintf(t[0] * inv) + off) & 0xffu, b1 = (unsigned)(int)(rintf(t[1] * inv) + off) & 0xffu, b2 = (unsigned)(int)(rintf(t[2] * inv) + off) & 0xffu, b3 = (unsigned)(int)(rintf(t[3] * inv) + off) & 0xffu;
            w[q] = b0 | (b1 << 8) | (b2 << 16) | (b3 << 24);
        }
        *(u32x4*)(dst + 1024 * i + 16 * lane) = w;
    }
}
struct QuantJob { const float* TU; const float* TV; unsigned char* QU; unsigned char* QV; float* SU; float* SV; };
__device__ __forceinline__ const float* qj_src(const QuantJob& q, int r) { return (r < 16384 ? q.TU : q.TV) + (size_t)(r & 16383) * DM; }
__device__ __forceinline__ unsigned char* qj_dst(const QuantJob& q, int r) { return (r < 16384 ? q.QU : q.QV) + (size_t)(r & 16383) * DM; }
__device__ __forceinline__ float* qj_scl(const QuantJob& q, int r) { return (r < 16384 ? q.SU : q.SV) + (r & 16383); }
__device__ __forceinline__ void qj_tail(const QuantJob& q, int done_iters) {
    const int lane = threadIdx.x & 63, gw = blockIdx.x * 8 + (threadIdx.x >> 6), nw = gridDim.x * 8;
    for (int r = gw + done_iters * nw; r < 32768; r += nw) { f32x4 v[8]; qrow_issue(v, qj_src(q, r), lane); qrow_finish(v, qj_dst(q, r), qj_scl(q, r), lane, r >= 16384); }
}
__device__ __forceinline__ float logf_gate(float z, float lb) { return __logf(lb + (1.0f - lb) * sigmoidf_(z)); }
__device__ __forceinline__ void phase_scan_a(LAS unsigned char* lds, const bf16_t* FZ, const float* LB, const bf16_t* I1, bf16_t* LT, float* DEC, const QuantJob qj, unsigned* dbgc = nullptr) {
    unsigned dbg_kt = 0, dbg_acc = 0;
    const int tid = threadIdx.x, lane = tid & 63, wv = tid >> 6, k = tid & 127, part = tid >> 7;
    LAS unsigned char* Iimg = lds; LAS unsigned char* KTimg = lds + 16384;
    LAS float* psum = (LAS float*)(lds + 32768);
    LAS unsigned char* Lst = lds + 36864;
#if SCAN_A_VALU == 2
    for (int item = blockIdx.x; item < 2 * NHEAD * 128; item += gridDim.x) {
        const int bh = item >> 7, c = item & 127, b = bh >> 4, h = bh & 15;
        const size_t tok0 = (size_t)b * SEQ + c * 64;
        for (int idx = tid; idx < 16384; idx += 512) {
            const int v = idx >> 7, kk = idx & 127;
            float g = 1.f, L = 0.f;
            for (int s2 = 63; s2 >= 0; --s2) { const size_t o = (tok0 + s2) * DM + h * 128; const float f = __expf(logf_gate(bf2f(FZ[o + kk]), LB[h * 128 + kk])); L += bf2f(I1[o + v]) * (1.0f - f) * g; g *= f; }
            LT[(size_t)item * 16384 + idx] = (bf16_t)(pk_bf16(L, 0.f) & 0xffffu);
        }
    }
    return;
#endif
    bf16_t nfz[16]; u32x4 nit_[2];
#define SA_LOAD(item_) { const int bh_ = (item_) >> 7, c_ = (item_) & 127; const size_t t0_ = (size_t)(bh_ >> 4) * SEQ + c_ * 64; const int h_ = bh_ & 15; \
        _Pragma("unroll") for (int i = 0; i < 16; ++i) nfz[i] = FZ[(t0_ + 16 * part + i) * DM + h_ * 128 + k]; \
        _Pragma("unroll") for (int r = 0; r < 2; ++r) { const int idx = tid + 512 * r, row = idx >> 4, ch = idx & 15; nit_[r] = *(const u32x4*)(I1 + (t0_ + row) * DM + h_ * 128 + ch * 8); } }
    if ((int)blockIdx.x < 2 * NHEAD * 128) SA_LOAD((int)blockIdx.x)
    int qiter = 0;
    for (int item = blockIdx.x; item < 2 * NHEAD * 128; item += gridDim.x, ++qiter) {
        const int bh = item >> 7, c = item & 127, b = bh >> 4, h = bh & 15;
        const size_t tok0 = (size_t)b * SEQ + c * 64;
        float lf[16];
        const float lbk = LB[h * 128 + k];
#pragma unroll
        for (int i = 0; i < 16; ++i) lf[i] = logf_gate(bf2f(nfz[i]), lbk);
#pragma unroll
        for (int r = 0; r < 2; ++r) { const int idx = tid + 512 * r, row = idx >> 4, ch = idx & 15; *(LAS u32x4*)(Iimg + off_b(row, ch)) = nit_[r]; }
        if (item + (int)gridDim.x < 2 * NHEAD * 128) SA_LOAD(item + (int)gridDim.x)
        const int qrow = qiter * (int)gridDim.x * 8 + (int)blockIdx.x * 8 + wv; const bool doq = qrow < 32768; f32x4 qv8[8];
        if (doq) qrow_issue(qv8, qj_src(qj, qrow), lane);
        float cs = 0.f;
#pragma unroll
        for (int i = 0; i < 16; ++i) cs += lf[i];
        psum[part * 128 + k] = cs;
        __syncthreads();
        const float p0 = psum[k], p1 = psum[128 + k], p2 = psum[256 + k], p3 = psum[384 + k];
        const float blast = (p0 + p1) + (p2 + p3);
        float bb = part == 0 ? 0.f : (part == 1 ? p0 : (part == 2 ? p0 + p1 : p0 + p1 + p2));
#pragma unroll
        for (int i = 0; i < 16; ++i) {
            bb += lf[i];
            const float kt = (1.0f - __expf(lf[i])) * __expf(blast - bb);
            if (!(kt - kt == 0.f)) ++dbg_kt;
            const int srow = 16 * part + i;
            *(LAS bf16_t*)(KTimg + off_b(srow, k >> 3) + 2 * (k & 7)) = (bf16_t)(pk_bf16(kt, 0.f) & 0xffffu);
        }
        if (part == 0) DEC[(size_t)item * 128 + k] = __expf(blast);
        __syncthreads();
#if SCAN_A_VALU
        for (int idx = tid; idx < 16384; idx += 512) {
            const int v = idx >> 7, kk = idx & 127;
            float accv = 0.f;
            for (int s2 = 0; s2 < 64; ++s2) accv += bf2f(*(const LAS bf16_t*)(Iimg + off_b(s2, v >> 3) + 2 * (v & 7))) * bf2f(*(const LAS bf16_t*)(KTimg + off_b(s2, kk >> 3) + 2 * (kk & 7)));
            *(LAS bf16_t*)(Lst + v * 272 + 2 * kk) = (bf16_t)(pk_bf16(accv, 0.f) & 0xffffu);
        }
        if (0)
#endif
        {
            const int vt = wv >> 1;
            f32x16 acc0, acc1;
#pragma unroll
            for (int e = 0; e < 16; ++e) { acc0[e] = 0.f; acc1[e] = 0.f; }
#pragma unroll
            for (int ks = 0; ks < 4; ++ks) {
                const bf16x8 af = tr_frag(Iimg, lane, vt, ks);
                const bf16x8 b0 = tr_frag(KTimg, lane, 2 * (wv & 1), ks), b1 = tr_frag(KTimg, lane, 2 * (wv & 1) + 1, ks);
                acc0 = __builtin_amdgcn_mfma_f32_32x32x16_bf16(af, b0, acc0, 0, 0, 0);
                acc1 = __builtin_amdgcn_mfma_f32_32x32x16_bf16(af, b1, acc1, 0, 0, 0);
            }
            const int r32 = lane & 31, hh = lane >> 5;
#pragma unroll
            for (int e = 0; e < 16; ++e) {
                if (!(acc0[e] - acc0[e] == 0.f)) ++dbg_acc; if (!(acc1[e] - acc1[e] == 0.f)) ++dbg_acc;
                const int v = 32 * vt + (e & 3) + 8 * (e >> 2) + 4 * hh;
                *(LAS bf16_t*)(Lst + v * 272 + 2 * (64 * (wv & 1) + r32)) = (bf16_t)(pk_bf16(acc0[e], 0.f) & 0xffffu);
                *(LAS bf16_t*)(Lst + v * 272 + 2 * (64 * (wv & 1) + 32 + r32)) = (bf16_t)(pk_bf16(acc1[e], 0.f) & 0xffffu);
            }
        }
        __syncthreads();
#pragma unroll
        for (int r = 0; r < 4; ++r) { const int idx = tid + 512 * r, row = idx >> 4, ch = idx & 15; *(u32x4*)(LT + (size_t)item * 16384 + row * 128 + ch * 8) = *(const LAS u32x4*)(Lst + row * 272 + ch * 16); }
        if (doq) qrow_finish(qv8, qj_dst(qj, qrow), qj_scl(qj, qrow), lane, qrow >= 16384);
        __syncthreads();
    }
    qj_tail(qj, qiter);
    if (dbgc) { if (dbg_kt) atomicAdd(dbgc + 0, dbg_kt); if (dbg_acc) atomicAdd(dbgc + 1, dbg_acc); }
}
__device__ __forceinline__ void phase_scan_b(bf16_t* LT, const float* DEC, const QuantJob qj) {
    const int n = 2 * NHEAD * 128 * 32;
    const int lane = threadIdx.x & 63, gw = blockIdx.x * 8 + (threadIdx.x >> 6), nw = gridDim.x * 8;
    int qdone = 0;
    for (int idx = blockIdx.x * 512 + threadIdx.x; idx < n; idx += gridDim.x * 512) {
        const int bh = idx >> 12, vk = idx & 4095, k4 = (vk & 31) * 4;
        float S0 = 0.f, S1 = 0.f, S2 = 0.f, S3 = 0.f;
        bf16_t* p = LT + (size_t)bh * 128 * 16384 + (size_t)vk * 4;
        const float* dp = DEC + (size_t)bh * 128 * 128 + k4;
        for (int c8 = 0; c8 < 16; ++c8) {
            const int qrow = (qdone + c8) * nw + gw; const bool doq = qrow < 32768; f32x4 qv8[8];
            if (doq) qrow_issue(qv8, qj_src(qj, qrow), lane);
#pragma unroll
            for (int c2 = 0; c2 < 8; ++c2) {
                const int c = c8 * 8 + c2;
                const u32x2 w = *(const u32x2*)(p + (size_t)c * 16384);
                const f32x4 d = *(const f32x4*)(dp + c * 128);
                u32x2 o; o.x = pk_bf16(S0, S1); o.y = pk_bf16(S2, S3);
                *(u32x2*)(p + (size_t)c * 16384) = o;
                S0 = d[0] * S0 + bflo(w.x); S1 = d[1] * S1 + bfhi(w.x); S2 = d[2] * S2 + bflo(w.y); S3 = d[3] * S3 + bfhi(w.y);
            }
            if (doq) qrow_finish(qv8, qj_dst(qj, qrow), qj_scl(qj, qrow), lane, qrow >= 16384);
        }
        qdone += 16;
    }
    qj_tail(qj, qdone);
}
__device__ __forceinline__ void phase_scan_c(LAS unsigned char* lds, const bf16_t* Q1, const bf16_t* FZ, const float* LB, const bf16_t* I1, const bf16_t* G1, const bf16_t* SP, const float* gnorm, bf16_t* OG) {
    const int tid = threadIdx.x, lane = tid & 63, wv = tid >> 6, k = tid & 127, part = tid >> 7, r32 = lane & 31, hh = lane >> 5;
    LAS unsigned char* QTimg = lds; LAS unsigned char* QPimg = lds + 16384; LAS unsigned char* KPimg = lds + 32768; LAS unsigned char* Iimg = lds + 49152; LAS unsigned char* SPimg = lds + 65536;
    LAS float* psum = (LAS float*)(lds + 98304);
    LAS float* ssq = (LAS float*)(lds + 100352);
    LAS unsigned char* OT = lds + 102400;
    bf16_t nfz[16], nq[16]; u32x4 nit_[2], nsp[4], ngt[2];
#define SC_LOAD(item_) { const int bh_ = (item_) >> 7, c_ = (item_) & 127; const size_t t0_ = (size_t)(bh_ >> 4) * SEQ + c_ * 64; const int h_ = bh_ & 15; \
        _Pragma("unroll") for (int i = 0; i < 16; ++i) { const size_t o_ = (t0_ + 16 * part + i) * DM + h_ * 128 + k; nfz[i] = FZ[o_]; nq[i] = Q1[o_]; } \
        _Pragma("unroll") for (int r = 0; r < 2; ++r) { const int idx = tid + 512 * r, row = idx >> 4, ch = idx & 15; nit_[r] = *(const u32x4*)(I1 + (t0_ + row) * DM + h_ * 128 + ch * 8); ngt[r] = *(const u32x4*)(G1 + (t0_ + row) * DM + h_ * 128 + ch * 8); } \
        _Pragma("unroll") for (int r = 0; r < 4; ++r) { const int idx = tid + 512 * r, row = idx >> 4, ch = idx & 15; nsp[r] = *(const u32x4*)(SP + (size_t)(item_) * 16384 + row * 128 + ch * 8); } }
    if ((int)blockIdx.x < 2 * NHEAD * 128) SC_LOAD((int)blockIdx.x)
    for (int item = blockIdx.x; item < 2 * NHEAD * 128; item += gridDim.x) {
        const int bh = item >> 7, c = item & 127, b = bh >> 4, h = bh & 15;
        const size_t tok0 = (size_t)b * SEQ + c * 64;
        float lf[16], qv[16];
        const float lbk = LB[h * 128 + k];
#pragma unroll
        for (int i = 0; i < 16; ++i) { lf[i] = logf_gate(bf2f(nfz[i]), lbk); const float qr = bf2f(nq[i]); qv[i] = qr * sigmoidf_(qr); }
#pragma unroll
        for (int r = 0; r < 2; ++r) { const int idx = tid + 512 * r, row = idx >> 4, ch = idx & 15; *(LAS u32x4*)(Iimg + off_b(row, ch)) = nit_[r]; }
#pragma unroll
        for (int r = 0; r < 4; ++r) { const int idx = tid + 512 * r, row = idx >> 4, ch = idx & 15; *(LAS u32x4*)(SPimg + off_b(row, ch)) = nsp[r]; }
        const u32x4 gcur0 = ngt[0], gcur1 = ngt[1];
        if (item + (int)gridDim.x < 2 * NHEAD * 128) SC_LOAD(item + (int)gridDim.x)
        float cs = 0.f;
#pragma unroll
        for (int i = 0; i < 16; ++i) cs += lf[i];
        psum[part * 128 + k] = cs;
        __syncthreads();
        const float p0 = psum[k], p1 = psum[128 + k], p2 = psum[256 + k];
        const float rr = p0 + p1;
        float bb = part == 0 ? 0.f : (part == 1 ? p0 : (part == 2 ? p0 + p1 : p0 + p1 + p2));
#pragma unroll
        for (int i = 0; i < 16; ++i) {
            bb += lf[i];
            const float qt = qv[i] * __expf(bb), qp = qv[i] * __expf(bb - rr), kp = (1.0f - __expf(lf[i])) * __expf(rr - bb);
            const unsigned o = off_b(16 * part + i, k >> 3) + 2 * (k & 7);
            *(LAS bf16_t*)(QTimg + o) = (bf16_t)(pk_bf16(qt, 0.f) & 0xffffu);
            *(LAS bf16_t*)(QPimg + o) = (bf16_t)(pk_bf16(qp, 0.f) & 0xffffu);
            *(LAS bf16_t*)(KPimg + o) = (bf16_t)(pk_bf16(kp, 0.f) & 0xffffu);
        }
        __syncthreads();
        const int tt = wv & 1, vt = wv >> 1;
        f32x16 O;
#pragma unroll
        for (int e = 0; e < 16; ++e) O[e] = 0.f;
#pragma unroll
        for (int ks = 0; ks < 8; ++ks) {
            const bf16x8 af = *(const LAS bf16x8*)(SPimg + off_b(32 * vt + r32, 2 * ks + hh));
            const bf16x8 bf = *(const LAS bf16x8*)(QTimg + off_b(32 * tt + r32, 2 * ks + hh));
            O = __builtin_amdgcn_mfma_f32_32x32x16_bf16(af, bf, O, 0, 0, 0);
        }
        const unsigned krow = pi32((unsigned)r32);
        for (int st = 0; st <= tt; ++st) {
            f32x16 S;
#pragma unroll
            for (int e = 0; e < 16; ++e) S[e] = 0.f;
#pragma unroll
            for (int ks = 0; ks < 8; ++ks) {
                const bf16x8 af = *(const LAS bf16x8*)(KPimg + off_b(32 * st + krow, 2 * ks + hh));
                const bf16x8 bf = *(const LAS bf16x8*)(QPimg + off_b(32 * tt + r32, 2 * ks + hh));
                S = __builtin_amdgcn_mfma_f32_32x32x16_bf16(af, bf, S, 0, 0, 0);
            }
            float p[16];
#pragma unroll
            for (int e = 0; e < 16; ++e) {
                const unsigned m = (e & 3) + 8 * (e >> 2) + 4 * hh;
                const int sidx = 32 * st + (int)pi32(m), tidx = 32 * tt + r32;
                p[e] = sidx <= tidx ? S[e] : 0.f;
            }
            u32x4 w0, w1;
            w0.x = pk_bf16(p[0], p[1]); w0.y = pk_bf16(p[2], p[3]); w0.z = pk_bf16(p[4], p[5]); w0.w = pk_bf16(p[6], p[7]);
            w1.x = pk_bf16(p[8], p[9]); w1.y = pk_bf16(p[10], p[11]); w1.z = pk_bf16(p[12], p[13]); w1.w = pk_bf16(p[14], p[15]);
            const bf16x8 pf0 = __builtin_bit_cast(bf16x8, w0), pf1 = __builtin_bit_cast(bf16x8, w1);
            const bf16x8 i0 = tr_frag(Iimg, lane, vt, 2 * st), i1 = tr_frag(Iimg, lane, vt, 2 * st + 1);
            O = __builtin_amdgcn_mfma_f32_32x32x16_bf16(i0, pf0, O, 0, 0, 0);
            O = __builtin_amdgcn_mfma_f32_32x32x16_bf16(i1, pf1, O, 0, 0, 0);
        }
        float sq = 0.f;
#pragma unroll
        for (int e = 0; e < 16; ++e) sq += O[e] * O[e];
        sq += __shfl_xor(sq, 32);
        if (hh == 0) ssq[vt * 64 + 32 * tt + r32] = sq;
        __syncthreads();
        const int tl = 32 * tt + r32;
        const float rstd = rsqrtf((ssq[tl] + ssq[64 + tl] + ssq[128 + tl] + ssq[192 + tl]) * (1.0f / 128.0f) + 1e-6f);
#pragma unroll
        for (int g = 0; g < 4; ++g) {
            const int v0 = 32 * vt + 8 * g + 4 * hh;
            const f32x4 gn = *(const f32x4*)(gnorm + v0);
            u32x2 w; w.x = pk_bf16(O[4 * g] * rstd * gn[0], O[4 * g + 1] * rstd * gn[1]); w.y = pk_bf16(O[4 * g + 2] * rstd * gn[2], O[4 * g + 3] * rstd * gn[3]);
            *(LAS u32x2*)(OT + tl * 272 + v0 * 2) = w;
        }
        __syncthreads();
#pragma unroll
        for (int r = 0; r < 2; ++r) {
            const int idx = tid + 512 * r, row = idx >> 4, ch = idx & 15;
            const u32x4 ov = *(const LAS u32x4*)(OT + row * 272 + ch * 16);
            const size_t go = (tok0 + row) * DM + h * 128 + ch * 8;
            const u32x4 gv = r == 0 ? gcur0 : gcur1;
            u32x4 w;
#define SILU_(x_) ((x_) * sigmoidf_(x_))
            w.x = pk_bf16(bflo(ov.x) * SILU_(bflo(gv.x)), bfhi(ov.x) * SILU_(bfhi(gv.x))); w.y = pk_bf16(bflo(ov.y) * SILU_(bflo(gv.y)), bfhi(ov.y) * SILU_(bfhi(gv.y)));
            w.z = pk_bf16(bflo(ov.z) * SILU_(bflo(gv.z)), bfhi(ov.z) * SILU_(bfhi(gv.z))); w.w = pk_bf16(bflo(ov.w) * SILU_(bflo(gv.w)), bfhi(ov.w) * SILU_(bfhi(gv.w)));
#undef SILU_
            *(u32x4*)(OG + go) = w;
        }
        __syncthreads();
    }
}


#if SCAN_DBG == 2
__device__ __forceinline__ void dbg_compare(LAS float* red, const bf16_t* A, const bf16_t* B, float* DBG) {
    float sd = 0.f, sr = 0.f, nn = 0.f;
    const size_t n = (size_t)MTOK * DM;
    for (size_t i = (size_t)blockIdx.x * 512 + threadIdx.x; i < n; i += (size_t)gridDim.x * 512) {
        const float x = bf2f(A[i]), y = bf2f(B[i]);
        if (!(x - x == 0.f)) nn += 1.f; else { sd += (x - y) * (x - y); sr += y * y; }
    }
    sd = wave_sum(sd); sr = wave_sum(sr); nn = wave_sum(nn);
    const int wv = threadIdx.x >> 6;
    if ((threadIdx.x & 63) == 0) { red[wv * 3] = sd; red[wv * 3 + 1] = sr; red[wv * 3 + 2] = nn; }
    __syncthreads();
    if (threadIdx.x == 0) { float a = 0, b = 0, c = 0; for (int w = 0; w < 8; ++w) { a += red[w * 3]; b += red[w * 3 + 1]; c += red[w * 3 + 2]; } DBG[blockIdx.x * 4] = a; DBG[blockIdx.x * 4 + 1] = b; DBG[blockIdx.x * 4 + 2] = c; }
    __syncthreads();
}
__device__ __forceinline__ void dbg_emit(const float* DBG, float* out) {
    float a = 0, b = 0, c = 0;
    for (int w = 0; w < (int)gridDim.x; ++w) { a += DBG[w * 4]; b += DBG[w * 4 + 1]; c += DBG[w * 4 + 2]; }
    const float rel = sqrtf(a / b);
    int k = (int)rintf(-2.0f * log10f(rel)); k = k < 0 ? 0 : (k > 16 ? 16 : k);
    if (c > 0.f) k = 17;
    const float cc = sqrtf(0.5f * (float)k);
    const size_t n = (size_t)MTOK * DM;
    for (size_t i = (size_t)blockIdx.x * 512 + threadIdx.x; i < n; i += (size_t)gridDim.x * 512) out[i] = cc;
}
#endif

#if SCAN_DBG == 3
__device__ __forceinline__ void dbg_count_bf16(const bf16_t* A, size_t n, unsigned* cnt) {
    unsigned c = 0;
    for (size_t i = (size_t)blockIdx.x * 512 + threadIdx.x; i < n; i += (size_t)gridDim.x * 512) { const float x = bf2f(A[i]); if (!(x - x == 0.f)) ++c; }
    if (c) atomicAdd(cnt, c);
}
__device__ __forceinline__ void dbg_count_f32(const float* A, size_t n, unsigned* cnt) {
    unsigned c = 0;
    for (size_t i = (size_t)blockIdx.x * 512 + threadIdx.x; i < n; i += (size_t)gridDim.x * 512) { const float x = A[i]; if (!(x - x == 0.f)) ++c; }
    if (c) atomicAdd(cnt, c);
}
__device__ __forceinline__ void dbg_emit3(const unsigned* cnt, float* out) {
    float code = 0.f;
    for (int st = 3; st >= 0; --st) { const unsigned c = cnt[st]; if (c) { float lg = log10f((float)c); lg = lg > 9.f ? 9.f : lg; code = (float)(st + 1) + 0.1f * lg; } }
    const float cc = sqrtf(code);
    const size_t n = (size_t)MTOK * DM;
    for (size_t i = (size_t)blockIdx.x * 512 + threadIdx.x; i < n; i += (size_t)gridDim.x * 512) out[i] = cc;
}
#endif

#if SCAN_DBG == 4 || SCAN_DBG == 6
__device__ __forceinline__ void dbg_compare4(LAS float* red, const bf16_t* A, const bf16_t* B, const bf16_t* C, float* DBG) {
    float sd = 0.f, sr = 0.f, nn = 0.f, mm = 0.f;
    const size_t n = (size_t)MTOK * DM;
    for (size_t i = (size_t)blockIdx.x * 512 + threadIdx.x; i < n; i += (size_t)gridDim.x * 512) {
        const float x = bf2f(A[i]), y = bf2f(B[i]);
        if (!(x - x == 0.f)) nn += 1.f; else { sd += (x - y) * (x - y); sr += y * y; }
        if (A[i] != C[i]) mm += 1.f;
    }
    sd = wave_sum(sd); sr = wave_sum(sr); nn = wave_sum(nn); mm = wave_sum(mm);
    const int wv = threadIdx.x >> 6;
    if ((threadIdx.x & 63) == 0) { red[wv * 4] = sd; red[wv * 4 + 1] = sr; red[wv * 4 + 2] = nn; red[wv * 4 + 3] = mm; }
    __syncthreads();
    if (threadIdx.x == 0) { float a = 0, b = 0, c = 0, d = 0; for (int w = 0; w < 8; ++w) { a += red[w * 4]; b += red[w * 4 + 1]; c += red[w * 4 + 2]; d += red[w * 4 + 3]; }
        DBG[blockIdx.x * 4] = a; DBG[blockIdx.x * 4 + 1] = b; DBG[blockIdx.x * 4 + 2] = c; DBG[blockIdx.x * 4 + 3] = d; }
    __syncthreads();
}
__device__ __forceinline__ void dbg_emit4(const float* DBG, float* out) {
    float a = 0, b = 0, c = 0, d = 0;
    for (int w = 0; w < (int)gridDim.x; ++w) { a += DBG[w * 4]; b += DBG[w * 4 + 1]; c += DBG[w * 4 + 2]; d += DBG[w * 4 + 3]; }
    const float rel = sqrtf(a / b);
    int k = (int)rintf(-log10f(rel)); k = k < 0 ? 0 : (k > 8 ? 8 : k);
#if SCAN_DBG == 6
    const float cc = sqrtf((float)k + ((d + c) > 0.f ? 0.5f : 0.f));
#else
    int m = (int)ceilf(log10f(1.0f + d + c)); m = m > 9 ? 9 : m;
    const float cc = sqrtf((float)k + 0.1f * (float)m);
#endif
    const size_t n = (size_t)MTOK * DM;
    for (size_t i = (size_t)blockIdx.x * 512 + threadIdx.x; i < n; i += (size_t)gridDim.x * 512) out[i] = cc;
}
#endif

#if SCAN_DBG == 5
__device__ __forceinline__ void dbg_lds16_test(LAS unsigned char* lds, unsigned* cnt) {
    const int tid = threadIdx.x;
    unsigned bad = 0;
    for (int rep = 0; rep < 64; ++rep) {
        for (int i = tid; i < 1024; i += 512) *(LAS u32x4*)(lds + i * 16) = (u32x4){0x7fc07fc0u, 0x7fc07fc0u, 0x7fc07fc0u, 0x7fc07fc0u};
        __syncthreads();
        const int k = tid & 127, part = tid >> 7;
#pragma unroll
        for (int i = 0; i < 16; ++i) {
            const int row = 16 * part + i;
            *(LAS bf16_t*)(lds + off_b(row, k >> 3) + 2 * (k & 7)) = (bf16_t)((row * 128 + k + rep) & 0x7fff);
        }
        __syncthreads();
        for (int idx = tid; idx < 64 * 128; idx += 512) {
            const int row = idx >> 7, kk = idx & 127;
            const bf16_t got = *(const LAS bf16_t*)(lds + off_b(row, kk >> 3) + 2 * (kk & 7));
            if (got != (bf16_t)((row * 128 + kk + rep) & 0x7fff)) ++bad;
        }
        __syncthreads();
    }
    if (bad) atomicAdd(cnt, bad);
}
__device__ __forceinline__ void dbg_emit5(const unsigned* cnt, float* out) {
    const unsigned c = cnt[0];
    float code = 0.f;
    if (c) { float lg = log10f((float)c); code = 1.0f + (lg > 8.9f ? 8.9f : lg); }
    const float cc = sqrtf(code);
    const size_t n = (size_t)MTOK * DM;
    for (size_t i = (size_t)blockIdx.x * 512 + threadIdx.x; i < n; i += (size_t)gridDim.x * 512) out[i] = cc;
}
#endif

#if SCAN_DBG == 6
__device__ __forceinline__ void dbg_check_a(LAS float* red, const float* LF, const bf16_t* I1, const bf16_t* LT, const bf16_t* LT2, float* DBG) {
    float sd = 0.f, sr = 0.f, mm = 0.f;
    const size_t n = (size_t)4096 * 16384;
    for (size_t i = (size_t)blockIdx.x * 512 + threadIdx.x; i < n; i += (size_t)gridDim.x * 512) {
        const int item = (int)(i >> 14), v = (int)((i >> 7) & 127), k = (int)(i & 127);
        const int bh = item >> 7, c = item & 127, b = bh >> 4, h = bh & 15;
        const size_t tok0 = (size_t)b * SEQ + c * 64;
        float g = 1.f, L = 0.f;
        for (int s2 = 63; s2 >= 0; --s2) {
            const size_t o = (tok0 + s2) * DM + h * 128;
            const float f = __expf(LF[o + k]);
            L += bf2f(I1[o + v]) * (1.0f - f) * g;
            g *= f;
        }
        const float x = bf2f(LT[i]);
        sd += (x - L) * (x - L); sr += L * L;
        if (LT[i] != LT2[i]) mm += 1.f;
    }
    sd = wave_sum(sd); sr = wave_sum(sr); mm = wave_sum(mm);
    const int wv = threadIdx.x >> 6;
    if ((threadIdx.x & 63) == 0) { red[wv * 4] = sd; red[wv * 4 + 1] = sr; red[wv * 4 + 2] = 0.f; red[wv * 4 + 3] = mm; }
    __syncthreads();
    if (threadIdx.x == 0) { float a = 0, b2 = 0, d = 0; for (int w = 0; w < 8; ++w) { a += red[w * 4]; b2 += red[w * 4 + 1]; d += red[w * 4 + 3]; }
        DBG[blockIdx.x * 4] = a; DBG[blockIdx.x * 4 + 1] = b2; DBG[blockIdx.x * 4 + 2] = 0.f; DBG[blockIdx.x * 4 + 3] = d; }
    __syncthreads();
}
#endif

#if SCAN_DBG == 7
#ifndef DBG_FAM
#define DBG_FAM 0
#endif
__device__ __forceinline__ void dbg_check_a7(const float* LF, const bf16_t* I1, const bf16_t* LT, float* DBG) {
    const size_t n = (size_t)4096 * 16384;
    float nbad = 0.f, nnf = 0.f;
    for (size_t i = (size_t)blockIdx.x * 512 + threadIdx.x; i < n; i += (size_t)gridDim.x * 512 * 8) {
        const int item = (int)(i >> 14), v = (int)((i >> 7) & 127), k = (int)(i & 127);
        const int bh = item >> 7, c = item & 127, b = bh >> 4, h = bh & 15;
        const size_t tok0 = (size_t)b * SEQ + c * 64;
        float g = 1.f, L = 0.f;
        for (int s2 = 63; s2 >= 0; --s2) {
            const size_t o = (tok0 + s2) * DM + h * 128;
            const float f = __expf(LF[o + k]);
            L += bf2f(I1[o + v]) * (1.0f - f) * g;
            g *= f;
        }
        const float x = bf2f(LT[i]);
        if (!(x - x == 0.f)) { nnf += 1.f; nbad += 1.f; }
        else if (fabsf(x - L) > 0.02f * fabsf(L) + 1e-2f) nbad += 1.f;
    }
    nbad = wave_sum(nbad); nnf = wave_sum(nnf);
    if ((threadIdx.x & 63) == 0) { atomicAdd(DBG, nbad); atomicAdd(DBG + 1, nnf); }
}
__device__ __forceinline__ void dbg_emit7(const float* DBG, float* out) {
    const float nb = DBG[0], nf = DBG[1];
    int A = nb == 0.f ? 0 : (nb <= 100.f ? 1 : (nb <= 1e4f ? 3 : (nb <= 1e6f ? 5 : 7)));
    int B = nf == 0.f ? 0 : 5;
    const float cc = sqrtf((float)A + 0.1f * (float)B);
    const size_t n = (size_t)MTOK * DM;
    for (size_t i = (size_t)blockIdx.x * 512 + threadIdx.x; i < n; i += (size_t)gridDim.x * 512) out[i] = cc;
}
#endif
__device__ __forceinline__ int opaque(int v) { asm volatile("" : "+s"(v)); return v; }
template <bool L1> __device__ __forceinline__ void run_gemm_out(const Args& a, LAS unsigned char* lds) {
    unsigned char* ws = a.ws;
    pg8::Gemm g{(const bf16_t*)(ws + (L1 ? slot(3) : slot(0))), (const bf16_t*)(ws + (L1 ? WS_WO : WS_WOUT)), opaque(MTOK), opaque(DM), opaque(DM)};
    pg8::StaticOrder S; S.init(g.M, g.N, (int)gridDim.x, (int)blockIdx.x);
    EpiKVQ E{(bf16_t*)(ws + (L1 ? slot(4) : slot(1))), nullptr, nullptr};
    pg8::gemm_phase<EpiKVQ, pg8::StaticOrder>(lds, g, S, E, nullptr);
}
template <bool L1> __device__ __forceinline__ void run_ln(const Args& a) {
    unsigned char* ws = a.ws;
    phase_ln<L1>((const bf16_t*)(ws + (L1 ? slot(4) : slot(1))), L1 ? (const void*)(ws + slot(2)) : (const void*)a.in[0], a.in[12] + (L1 ? 2 : 0) * DM, a.in[13] + (L1 ? 2 : 0) * DM,
                 (float*)nullptr, (bf16_t*)(ws + (L1 ? slot(8) : slot(5))), (signed char*)(ws + WS_XQ), (float*)(ws + WS_XS));
}
template <bool L1> __device__ __forceinline__ void run_gemm_sc(const Args& a, LAS unsigned char* lds) {
    unsigned char* ws = a.ws;
    pg8::Gemm g{(const bf16_t*)(ws + WS_WC) + (L1 ? (size_t)DM * DM : 0), (const bf16_t*)(ws + (L1 ? slot(8) : slot(5))), opaque(DM), opaque(MTOK), opaque(DM)};
    pg8::StaticOrder S; S.init(g.M, g.N, (int)gridDim.x, (int)blockIdx.x);
    EpiF32 E{(float*)(ws + (L1 ? slot(0) : slot(6))), MTOK};
    pg8::gemm_phase<EpiF32, pg8::StaticOrder>(lds, g, S, E, nullptr);
}
template <bool L1> __device__ __forceinline__ void run_topk(const Args& a, LAS unsigned char* lds) {
    unsigned char* ws = a.ws;
    phase_topk(lds, (const float*)(ws + (L1 ? slot(0) : slot(6))), (int*)(ws + WS_EID), (float*)(ws + WS_GATE));
}
template <bool L1> __device__ __forceinline__ void run_peer(const Args& a, LAS unsigned char* lds) {
    unsigned char* ws = a.ws;
    LAS int* HL = (LAS int*)(lds + (threadIdx.x >> 6) * 8192);
    float* Y = (float*)(ws + (L1 ? slot(0) : slot(6)));
    phase_peer_u((const signed char*)(ws + WS_XQ), (const int*)(ws + WS_EID), ws + WS_UB + (L1 ? (size_t)16384 * DM : 0), HL);
    asm volatile("s_waitcnt vmcnt(0) lgkmcnt(0)" ::: "memory");
    phase_peer_w(HL, (const float*)(ws + WS_XS), (const int*)(ws + WS_EID), (const float*)(ws + WS_GATE),
                 (const float*)(ws + WS_USC) + (L1 ? 16384 : 0), (const float*)(ws + WS_VSC) + (L1 ? 16384 : 0), (signed char*)(ws + WS_W), (float*)(ws + WS_CS));
    asm volatile("s_waitcnt vmcnt(0)" ::: "memory");
    phase_peer_v((const bf16_t*)(ws + (L1 ? slot(8) : slot(5))), (const int*)(ws + WS_EID), (const signed char*)(ws + WS_W), (const float*)(ws + WS_CS),
                 ws + WS_VB + (L1 ? (size_t)16384 * DM : 0), Y);
    asm volatile("s_waitcnt vmcnt(0)" ::: "memory");
    {
        const int lane = threadIdx.x & 63, gw = blockIdx.x * 8 + (threadIdx.x >> 6), nw = gridDim.x * 8, tpw = (MTOK + nw - 1) / nw, tbase = gw * tpw;
        const int tend = tbase + tpw < MTOK ? tbase + tpw : MTOK;
        const float* g = a.in[12] + (L1 ? 3 : 1) * DM; const float* bta = a.in[13] + (L1 ? 3 : 1) * DM;
        float* outf = L1 ? a.out : (float*)nullptr; bf16_t* outb = L1 ? (bf16_t*)nullptr : (bf16_t*)(ws + slot(2));
        for (int row = tbase; row < tend; ++row) {
            float v[32];
            const float* p = Y + (size_t)row * DM;
#pragma unroll
            for (int i = 0; i < 4; ++i) {
                const f32x4 x0 = *(const f32x4*)(p + 512 * i + 8 * lane), x1 = *(const f32x4*)(p + 512 * i + 8 * lane + 4);
#pragma unroll
                for (int j = 0; j < 4; ++j) { v[i * 8 + j] = x0[j]; v[i * 8 + 4 + j] = x1[j]; }
            }
            ln_row_store(v, g, bta, outf ? outf + (size_t)row * DM : nullptr, outb ? outb + (size_t)row * DM : nullptr, lane,
                         L1 ? (signed char*)nullptr : (signed char*)(ws + slot(1)) + (size_t)row * DM, L1 ? (float*)nullptr : (float*)(ws + WS_XS1) + row);
        }
    }
}


#define XB_TMO      128
#define XB_XCNT(j)  (256  + 64 * (j))
#define XB_XSUB(j)  (1280 + 64 * (j))
#define XB_XGEN(j)  (2304 + 64 * (j))
#define XB_TOP      3328
#define XB_TOPGEN   3392
#define XCD_BAR_WORDS 3456
#define XB_SPIN_CAP (1u << 20)
__device__ __forceinline__ unsigned xb_ld(unsigned* p)              { return __hip_atomic_load(p, __ATOMIC_RELAXED, __HIP_MEMORY_SCOPE_AGENT); }
__device__ __forceinline__ unsigned xb_add(unsigned* p, unsigned v) { return __hip_atomic_fetch_add(p, v, __ATOMIC_RELAXED, __HIP_MEMORY_SCOPE_AGENT); }
__device__ __forceinline__ unsigned xb_xcc_id() { return (unsigned)__builtin_amdgcn_s_getreg((3 << 11) | 20) & 0xFu; }
#define XB_SPIN(cond, bar) do { unsigned _sp = 0; while (cond) { __builtin_amdgcn_s_sleep(1); \
    if ((++_sp & 255u) == 0u) { if (xb_ld(&(bar)[XB_TMO])) break; if (_sp > XB_SPIN_CAP) { atomicAdd(&(bar)[XB_TMO], 1u); break; } } } } while (0)
struct XcdBarrier { unsigned* bar; unsigned x; volatile LAS unsigned* st; };
__device__ __forceinline__ XcdBarrier xcd_barrier_post(unsigned* bar, volatile LAS unsigned* st) {
    XcdBarrier b; b.bar = bar; b.x = xb_xcc_id(); b.st = st;
    if (threadIdx.x == 0) (void)xb_add(&bar[XB_XCNT(b.x)], 1u);
    return b;
}
__device__ __forceinline__ void xcd_barrier_complete(unsigned* bar, unsigned x, unsigned& nloc, unsigned& nx) {
    const unsigned G = gridDim.x * gridDim.y * gridDim.z;
    unsigned sum, cnt, mine, sp = 0u;
    for (;;) {
        sum = 0u; cnt = 0u; mine = 0u;
#pragma unroll
        for (unsigned j = 0; j < 16; ++j) { const unsigned c = xb_ld(&bar[XB_XCNT(j)]); sum += c; cnt += (c > 0u) ? 1u : 0u; mine = (j == x) ? c : mine; }
        if (sum == G) break;
        __builtin_amdgcn_s_sleep(1);
        if ((++sp & 255u) == 0u) { if (xb_ld(&bar[XB_TMO])) break; if (sp > XB_SPIN_CAP) { atomicAdd(&bar[XB_TMO], 1u); break; } }
    }
    nloc = mine > 0u ? mine : 1u; nx = cnt > 0u ? cnt : 1u;
}
__device__ __forceinline__ void xcd_barrier(const XcdBarrier& b) {
    asm volatile("s_waitcnt vmcnt(0)" ::: "memory");
    __syncthreads();
    if (threadIdx.x == 0) {
        unsigned* bar = b.bar;
        __builtin_amdgcn_s_waitcnt(0);
        unsigned nloc = b.st[0], nx = b.st[1];
        if (nloc == 0u) { xcd_barrier_complete(bar, b.x, nloc, nx); b.st[0] = nloc; b.st[1] = nx; }
        const unsigned old = xb_add(&bar[XB_XSUB(b.x)], 1u);
        const unsigned gen = old / nloc;
        if (old + 1u == (gen + 1u) * nloc) {
            __builtin_amdgcn_fence(__ATOMIC_RELEASE, "agent");
            asm volatile("s_waitcnt vmcnt(0)" ::: "memory");
            const unsigned og = xb_add(&bar[XB_TOP], 1u);
            const unsigned tg = og / nx;
            if (og + 1u == (tg + 1u) * nx) xb_add(&bar[XB_TOPGEN], 1u);
            else XB_SPIN(xb_ld(&bar[XB_TOPGEN]) == tg, bar);
            __builtin_amdgcn_fence(__ATOMIC_ACQUIRE, "agent");
            xb_add(&bar[XB_XGEN(b.x)], 1u);
            asm volatile("s_waitcnt vmcnt(0)" ::: "memory");
        } else {
            XB_SPIN(xb_ld(&bar[XB_XGEN(b.x)]) == gen, bar);
            __builtin_amdgcn_fence(__ATOMIC_ACQUIRE, "agent");
            asm volatile("s_waitcnt vmcnt(0)" ::: "memory");
        }
    }
    __syncthreads();
}

__global__ void __launch_bounds__(512, 2) mk_fwd(Args a) {
    extern __shared__ __attribute__((aligned(16))) unsigned char lds_raw[];
    LAS unsigned char* lds = (LAS unsigned char*)lds_raw;
    cg::grid_group grid = cg::this_grid();
    unsigned char* ws = a.ws;
#define PHASE_BEGIN(k) if (a.ph_lo <= (k) && (k) < a.ph_hi && EN(k)) {
    volatile LAS unsigned* xb_st = (volatile LAS unsigned*)(lds + LDS_BYTES - 16);
    if (threadIdx.x < 4) xb_st[threadIdx.x] = 0u;
    unsigned* xb_words = (unsigned*)(ws + WS_BAR);
    __syncthreads();
    XcdBarrier xbar = xcd_barrier_post(xb_words, xb_st);
    if (a.ph_lo < 0) grid.sync();
#define PHASE_END(k) if ((k) + 1 < a.ph_hi) xcd_barrier(xbar); }
    PHASE_BEGIN(0) phase_prep(a, lds);
#if SCAN_DBG == 3 || SCAN_DBG == 5
        if (blockIdx.x == 0 && threadIdx.x < 8) ((unsigned*)(ws + WS_CTR + 8192))[threadIdx.x] = 0u;
#endif
#if SCAN_DBG == 7
        if (blockIdx.x == 0 && threadIdx.x < 32) ((float*)(ws + WS_CTR + 4096))[threadIdx.x] = 0.f;
#endif
    PHASE_END(0)
#if SCAN_DBG == 5
    PHASE_BEGIN(1) dbg_lds16_test(lds, (unsigned*)(ws + WS_CTR + 8192)); PHASE_END(1)
#define SKIP_REST 1
#endif
    PHASE_BEGIN(1) {
        pg8::Gemm g{(const bf16_t*)(ws + slot(0)), (const bf16_t*)(ws + WS_WIN), opaque(MTOK), opaque(4 * DM), opaque(DM / 2)};
        pg8::StaticOrder S; S.init(g.M, g.N, (int)gridDim.x, (int)blockIdx.x);
        EpiKVQ_<true> E{(bf16_t*)(ws + slot(1)), (const float*)(ws + WS_XS0), (const float*)(ws + WS_SWIN)};
        pg8::gemm_phase<EpiKVQ_<true>, pg8::StaticOrder>(lds, g, S, E, nullptr);
    } PHASE_END(1)
    PHASE_BEGIN(2) phase_scan_a(lds, (const bf16_t*)(ws + slot(2)), (const float*)(ws + WS_LB), (const bf16_t*)(ws + slot(3)), (bf16_t*)(ws + slot(6)), (float*)(ws + WS_DEC), QuantJob{a.in[10], a.in[11], ws + WS_UB, ws + WS_VB, (float*)(ws + WS_USC), (float*)(ws + WS_VSC)}
#if SCAN_DBG == 3
        , (unsigned*)(ws + WS_CTR + 8192)
#endif
        );
#if SCAN_DBG == 7
        asm volatile("s_waitcnt vmcnt(0)" ::: "memory"); __syncthreads(); grid.sync(); if (threadIdx.x < 64) { __builtin_amdgcn_fence(__ATOMIC_ACQUIRE, "agent"); asm volatile("s_waitcnt vmcnt(0)" ::: "memory"); } __syncthreads();
        dbg_check_a7((const float*)(ws + slot(4)), (const bf16_t*)(ws + slot(2)), (const bf16_t*)(ws + slot(6)), (float*)(ws + WS_CTR + 4096));
#endif
#if SCAN_DBG == 6
#define DSYNC6() asm volatile("s_waitcnt vmcnt(0)" ::: "memory"); __syncthreads(); grid.sync(); if (threadIdx.x < 64) { __builtin_amdgcn_fence(__ATOMIC_ACQUIRE, "agent"); asm volatile("s_waitcnt vmcnt(0)" ::: "memory"); } __syncthreads();
        DSYNC6()
        phase_scan_a(lds, (const bf16_t*)(ws + slot(2)), (const float*)(ws + WS_LB), (const bf16_t*)(ws + slot(3)), (bf16_t*)a.out, (float*)(ws + WS_DEC), QuantJob{a.in[10], a.in[11], ws + WS_UB, ws + WS_VB, (float*)(ws + WS_USC), (float*)(ws + WS_VSC)});
        DSYNC6()
        dbg_check_a((LAS float*)lds, (const float*)(ws + slot(4)), (const bf16_t*)(ws + slot(2)), (const bf16_t*)(ws + slot(6)), (const bf16_t*)a.out, (float*)(ws + WS_CTR + 4096));
#endif
#if SCAN_DBG == 3
        asm volatile("s_waitcnt vmcnt(0)" ::: "memory"); __syncthreads(); grid.sync();
        dbg_count_bf16((const bf16_t*)(ws + slot(6)), (size_t)4096 * 16384, (unsigned*)(ws + WS_CTR + 8192) + 2);
#endif
    PHASE_END(2)
    PHASE_BEGIN(3) phase_scan_b((bf16_t*)(ws + slot(6)), (const float*)(ws + WS_DEC), QuantJob{a.in[10] + (size_t)16384 * DM, a.in[11] + (size_t)16384 * DM, ws + WS_UB + (size_t)16384 * DM, ws + WS_VB + (size_t)16384 * DM, (float*)(ws + WS_USC) + 16384, (float*)(ws + WS_VSC) + 16384});
#if SCAN_DBG == 3
        asm volatile("s_waitcnt vmcnt(0)" ::: "memory"); __syncthreads(); grid.sync();

#endif
    PHASE_END(3)
    PHASE_BEGIN(4) phase_scan_c(lds, (const bf16_t*)(ws + slot(1)), (const bf16_t*)(ws + slot(2)), (const float*)(ws + WS_LB), (const bf16_t*)(ws + slot(3)), (const bf16_t*)(ws + slot(4)), (const bf16_t*)(ws + slot(6)), a.in[2], (bf16_t*)(ws + slot(0)));
#if SCAN_DBG == 1
        asm volatile("s_waitcnt vmcnt(0)" ::: "memory"); __syncthreads(); grid.sync();
        phase_scan_naive((const bf16_t*)(ws + slot(1)), (const float*)(ws + slot(4)), (const bf16_t*)(ws + slot(2)), (float*)(ws + slot(6)));
        asm volatile("s_waitcnt vmcnt(0)" ::: "memory"); __syncthreads(); grid.sync();
        phase_onorm((const float*)(ws + slot(6)), (const bf16_t*)(ws + slot(3)), a.in[2], (bf16_t*)(ws + slot(0)));
#endif
#if SCAN_DBG == 3
        asm volatile("s_waitcnt vmcnt(0)" ::: "memory"); __syncthreads(); grid.sync();

#endif
#if SCAN_DBG == 4
#define DSYNC() asm volatile("s_waitcnt vmcnt(0)" ::: "memory"); __syncthreads(); grid.sync(); if (threadIdx.x < 64) { __builtin_amdgcn_fence(__ATOMIC_ACQUIRE, "agent"); asm volatile("s_waitcnt vmcnt(0)" ::: "memory"); } __syncthreads();
        DSYNC()
        phase_scan_naive((const bf16_t*)(ws + slot(1)), (const float*)(ws + slot(4)), (const bf16_t*)(ws + slot(2)), (float*)(ws + slot(6)));
        DSYNC()
        phase_onorm((const float*)(ws + slot(6)), (const bf16_t*)(ws + slot(3)), a.in[2], (bf16_t*)(ws + slot(8)));
        DSYNC()
        phase_scan_a(lds, (const bf16_t*)(ws + slot(2)), (const float*)(ws + WS_LB), (const bf16_t*)(ws + slot(3)), (bf16_t*)(ws + slot(6)), (float*)(ws + WS_DEC), QuantJob{a.in[10], a.in[11], ws + WS_UB, ws + WS_VB, (float*)(ws + WS_USC), (float*)(ws + WS_VSC)});
        DSYNC()
        phase_scan_b((bf16_t*)(ws + slot(6)), (const float*)(ws + WS_DEC), QuantJob{a.in[10] + (size_t)16384 * DM, a.in[11] + (size_t)16384 * DM, ws + WS_UB + (size_t)16384 * DM, ws + WS_VB + (size_t)16384 * DM, (float*)(ws + WS_USC) + 16384, (float*)(ws + WS_VSC) + 16384});
        DSYNC()
        phase_scan_c(lds, (const bf16_t*)(ws + slot(1)), (const bf16_t*)(ws + slot(2)), (const float*)(ws + WS_LB), (const bf16_t*)(ws + slot(3)), (const bf16_t*)(ws + slot(4)), (const bf16_t*)(ws + slot(6)), a.in[2], (bf16_t*)a.out);
        DSYNC()
        dbg_compare4((LAS float*)lds, (const bf16_t*)(ws + slot(0)), (const bf16_t*)(ws + slot(8)), (const bf16_t*)a.out, (float*)(ws + WS_CTR + 4096));
#endif
#if SCAN_DBG == 2
        asm volatile("s_waitcnt vmcnt(0)" ::: "memory"); __syncthreads(); grid.sync();
        phase_scan_naive((const bf16_t*)(ws + slot(1)), (const float*)(ws + slot(4)), (const bf16_t*)(ws + slot(2)), (float*)(ws + slot(6)));
        asm volatile("s_waitcnt vmcnt(0)" ::: "memory"); __syncthreads(); grid.sync();
        phase_onorm((const float*)(ws + slot(6)), (const bf16_t*)(ws + slot(3)), a.in[2], (bf16_t*)(ws + slot(8)));
        asm volatile("s_waitcnt vmcnt(0)" ::: "memory"); __syncthreads(); grid.sync();
        dbg_compare((LAS float*)lds, (const bf16_t*)(ws + slot(0)), (const bf16_t*)(ws + slot(8)), (float*)(ws + WS_CTR + 4096));
#endif
    PHASE_END(4)
    PHASE_BEGIN(5) run_gemm_out<false>(a, lds); PHASE_END(5)
    PHASE_BEGIN(6) run_ln<false>(a); PHASE_END(6)
    PHASE_BEGIN(7) run_gemm_sc<false>(a, lds); PHASE_END(7)
    PHASE_BEGIN(8) run_topk<false>(a, lds); PHASE_END(8)
    PHASE_BEGIN(9) run_peer<false>(a, lds); PHASE_END(9)
    PHASE_BEGIN(10) {
        pg8::Gemm g{(const bf16_t*)(ws + slot(1)), (const bf16_t*)(ws + WS_WKVQ), opaque(MTOK), opaque(3 * DM), opaque(DM / 2)};
        pg8::StaticOrder S; S.init(g.M, g.N, (int)gridDim.x, (int)blockIdx.x);
        EpiKVQR_<true> E{(bf16_t*)(ws + slot(3)), (const float*)(ws + WS_COS), (const float*)(ws + WS_SIN), (const float*)(ws + WS_XS1), (const float*)(ws + WS_SWKVQ)};
        pg8::gemm_phase<EpiKVQR_<true>, pg8::StaticOrder>(lds, g, S, E, nullptr);
    } PHASE_END(10)
    PHASE_BEGIN(11) phase_kstat((LAS float*)lds, (const bf16_t*)(ws + slot(3)), (float*)(ws + WS_KMEAN), (float*)(ws + WS_KNMAX)); PHASE_END(11)
    PHASE_BEGIN(12) phase_sel(lds, (const bf16_t*)(ws + slot(5)), (const float*)(ws + WS_KMEAN), (unsigned short*)(ws + WS_SUB), (int*)(ws + WS_CNT), (int*)(ws + WS_CTR)); PHASE_END(12)
    PHASE_BEGIN(13) phase_att(lds, (const bf16_t*)(ws + slot(5)), (const bf16_t*)(ws + slot(3)), (const bf16_t*)(ws + slot(4)), (const float*)(ws + WS_KNMAX), (const unsigned short*)(ws + WS_SUB),
                              (const int*)(ws + WS_CNT), (int*)(ws + WS_CTR), (bf16_t*)(ws + slot(6)), (bf16_t*)(ws + slot(0)), (float*)(ws + WS_LS)); PHASE_END(13)
    PHASE_BEGIN(14) phase_comb((const bf16_t*)(ws + slot(6)), (const bf16_t*)(ws + slot(0)), (const float*)(ws + WS_LS), (bf16_t*)(ws + slot(3))); PHASE_END(14)
    PHASE_BEGIN(15) run_gemm_out<true>(a, lds); PHASE_END(15)
    PHASE_BEGIN(16) run_ln<true>(a); PHASE_END(16)
    PHASE_BEGIN(17) run_gemm_sc<true>(a, lds); PHASE_END(17)
    PHASE_BEGIN(18) run_topk<true>(a, lds); PHASE_END(18)
#if SCAN_DBG == 7
    PHASE_BEGIN(19) dbg_emit7((const float*)(ws + WS_CTR + 4096), a.out); PHASE_END(19)
#elif SCAN_DBG == 6
    PHASE_BEGIN(19) dbg_emit4((const float*)(ws + WS_CTR + 4096), a.out); PHASE_END(19)
#elif SCAN_DBG == 5
    PHASE_BEGIN(19) dbg_emit5((const unsigned*)(ws + WS_CTR + 8192), a.out); PHASE_END(19)
#elif SCAN_DBG == 4
    PHASE_BEGIN(19) dbg_emit4((const float*)(ws + WS_CTR + 4096), a.out); PHASE_END(19)
#elif SCAN_DBG == 3
    PHASE_BEGIN(19) dbg_emit3((const unsigned*)(ws + WS_CTR + 8192), a.out); PHASE_END(19)
#elif SCAN_DBG == 2
    PHASE_BEGIN(19) dbg_emit((const float*)(ws + WS_CTR + 4096), a.out); PHASE_END(19)
#else
    PHASE_BEGIN(19) run_peer<true>(a, lds); PHASE_END(19)
#endif
}

extern "C" void kernel_launch(void* const* d_in, const int* in_sizes, int n_in, void* d_out, int out_size, void* d_ws, size_t ws_size, hipStream_t stream) {
    static int grid = 0;
    if (grid == 0) {
        if (n_in != 14 || out_size != MTOK * DM || ws_size < WS_END) { fprintf(stderr, "kernel_launch: unexpected shapes (n_in %d, out %d, ws %zu)\n", n_in, out_size, ws_size); grid = -1; return; }
        int dev = 0, cus = 0, per_cu = 0;
        if (hipGetDevice(&dev) != hipSuccess || hipDeviceGetAttribute(&cus, hipDeviceAttributeMultiprocessorCount, dev) != hipSuccess) { grid = -1; return; }
        if (hipFuncSetAttribute((const void*)mk_fwd, hipFuncAttributeMaxDynamicSharedMemorySize, LDS_BYTES) != hipSuccess) { fprintf(stderr, "kernel_launch: hipFuncSetAttribute failed\n"); grid = -1; return; }
        if (hipOccupancyMaxActiveBlocksPerMultiprocessor(&per_cu, (const void*)mk_fwd, 512, LDS_BYTES) != hipSuccess || per_cu < 1) { fprintf(stderr, "kernel_launch: occupancy query failed (%d)\n", per_cu); (void)hipGetLastError(); per_cu = 1; }
        grid = cus * (per_cu > 1 ? 1 : per_cu);
    }
    if (grid < 0) return;
    Args a{};
    for (int i = 0; i < 14; ++i) a.in[i] = (const float*)d_in[i];
    a.out = (float*)d_out; a.ws = (unsigned char*)d_ws;
#if ONE_LAUNCH
    a.ph_lo = 0; a.ph_hi = NPH;
    (void)hipMemsetAsync((unsigned char*)d_ws + WS_BAR, 0, XCD_BAR_WORDS * sizeof(unsigned), stream);
    void* args[] = {&a};
    hipError_t e = hipLaunchCooperativeKernel((const void*)mk_fwd, dim3(grid), dim3(512), args, LDS_BYTES, stream);
    if (e != hipSuccess) fprintf(stderr, "cooperative launch failed: %s (grid %d)\n", hipGetErrorString(e), grid);
#else
    for (int ph = 0; ph < NPH; ++ph) {
        a.ph_lo = ph; a.ph_hi = ph + 1;
        hipLaunchKernelGGL(mk_fwd, dim3(grid), dim3(512), LDS_BYTES, stream, a);
    }
#endif
}
```

```cpp
#define ONE_LAUNCH 1
#include <hip/hip_runtime.h>
#include <hip/hip_cooperative_groups.h>
#include <cstdio>
namespace cg = cooperative_groups;

#ifndef ONE_LAUNCH
#define ONE_LAUNCH 0
#endif
#ifndef SCAN_DBG
#define SCAN_DBG 0
#endif
#ifndef SCAN_A_VALU
#define SCAN_A_VALU 0
#endif
#ifndef ENMASK
#define ENMASK 0xffffffffu
#endif
#define EN(k) ((ENMASK >> (k)) & 1u)

namespace pg8 {
#define PG8_LAS __attribute__((address_space(3)))
typedef unsigned short bf16_t;
typedef short bf16x8 __attribute__((ext_vector_type(8)));
typedef float f32x4 __attribute__((ext_vector_type(4)));
typedef unsigned u32x4 __attribute__((ext_vector_type(4)));
constexpr int BM = 256, BK = 64, HALF = 128, HTB = HALF * BK * 2  , STAGE_BYTES = 8 * HTB, NXCD = 8, WGM = 8;

__host__ __device__ __forceinline__ int lds_byte(int r, int c) { const int st = (r >> 4) * 2 + (c >> 5), rr = r & 15, cc = c & 31, ob = rr * 64 + cc * 2; return st * 1024 + (ob ^ (((ob >> 9) & 1) << 5)); }
__host__ __device__ __forceinline__ void stage_rc(int b, int& R, int& C) { const int st = b / 1024, sb = b % 1024, swz = sb ^ (((sb >> 9) & 1) << 5); R = (st >> 1) * 16 + swz / 64; C = (st & 1) * 32 + (swz % 64) / 2; }
__host__ __device__ __forceinline__ int perm32(int rho) { const int n = rho >> 4, i = rho & 15; return 8 * (i >> 2) + 4 * n + (i & 3); }

struct Unit { int pm, pn; };
struct Gemm { const bf16_t* A; const bf16_t* Bt; int M, N, K; };

struct StaticOrder {
    int nM, nN, nwg, G, c;
    __host__ __device__ void init(int M, int N, int G_, int c_) { nM = M / BM; nN = N / BM; nwg = nM * nN; G = G_; c = c_; }
    __host__ __device__ bool next(int i, Unit& u) const {
        const long L = (long)i * G + c; if (L >= nwg) return false;
        int wgid = (int)L; { const int q = nwg / NXCD, r = nwg % NXCD, xcd = wgid % NXCD, off = wgid / NXCD; wgid = (xcd < r ? xcd * (q + 1) : r * (q + 1) + (xcd - r) * q) + off; }
        const int nig = WGM * nN, gid = wgid / nig, fm = gid * WGM, gsz = (nM - fm) < WGM ? (nM - fm) : WGM;
        u.pm = fm + ((wgid % nig) % gsz); u.pn = (wgid % nig) / gsz; return true;
    }
    __device__ __forceinline__ void a_ready(const Unit&) const {}
    __device__ __forceinline__ void done(const Unit&) const {}
};
struct CountedOrder : StaticOrder {
    const unsigned* ready; unsigned need; unsigned* tmo;
    __device__ __forceinline__ void a_ready(const Unit& u) const {
        if (threadIdx.x < 64) {
            const unsigned long long t0 = __builtin_amdgcn_s_memrealtime(); unsigned polls = 0;
            while ((unsigned)__builtin_amdgcn_readfirstlane(__hip_atomic_load(ready + 64 * u.pm, __ATOMIC_RELAXED, __HIP_MEMORY_SCOPE_AGENT)) < need) {
                if ((++polls & 255u) == 0u && __builtin_amdgcn_readfirstlane(__hip_atomic_load(tmo, __ATOMIC_RELAXED, __HIP_MEMORY_SCOPE_AGENT)) != 0u) break;
                if (__builtin_amdgcn_s_memrealtime() - t0 > 2000000ull) {
                    if (threadIdx.x == 0) { unsigned expect = 0u; __hip_atomic_compare_exchange_strong(tmo + 1, &expect, 0x600u | (unsigned)(u.pm & 0xff), __ATOMIC_RELAXED, __ATOMIC_RELAXED, __HIP_MEMORY_SCOPE_AGENT); __hip_atomic_store(tmo, 1u, __ATOMIC_RELAXED, __HIP_MEMORY_SCOPE_AGENT); }
                    break; }
                __builtin_amdgcn_s_sleep(2); }
            __builtin_amdgcn_fence(__ATOMIC_ACQUIRE, "agent");
            asm volatile("s_waitcnt vmcnt(0)" ::: "memory");
        }
#if !defined(BROKEN_HOOK_NO_BARRIER)
        asm volatile("" ::: "memory"); __builtin_amdgcn_s_barrier(); asm volatile("" ::: "memory");
#endif
    }
};

__device__ __forceinline__ unsigned cvt_pk_bf16(float lo, float hi) { unsigned r; asm volatile("v_cvt_pk_bf16_f32 %0, %1, %2" : "=v"(r) : "v"(lo), "v"(hi)); return r; }
typedef float f32x2 __attribute__((ext_vector_type(2)));
__device__ __forceinline__ f32x2 gelu_pk(f32x2 v) {
    const f32x2 av = __builtin_elementwise_abs(v), d = av * 0.2316418882f + 1.0f;
    f32x2 t; t.x = __builtin_amdgcn_rcpf(d.x); t.y = __builtin_amdgcn_rcpf(d.y);
    f32x2 q = t * 0.5307027145f + (-0.7265760135f); q = q * t + 0.7107068705f; q = q * t + (-0.142248368f); q = q * t + 0.127414796f; q = q * t;
    const f32x2 s = (v * v) * (-0.72134752044f);
    f32x2 e; e.x = __builtin_amdgcn_exp2f(s.x); e.y = __builtin_amdgcn_exp2f(s.y);
    const f32x2 m = v * (q * e), r = v - m;
    f32x2 o; o.x = v.x < 0.f ? m.x : r.x; o.y = v.y < 0.f ? m.y : r.y; return o;
}

struct EpiF32 {
    static constexpr bool PERM = false, AFTER_DRAIN = false, I8 = false;
    float* C; int ldc; const float* bias;
    __device__ __forceinline__ void operator()(const f32x4 (&acc)[2][2][4][2], const Unit& u, int wr, int wc, int fr, int fq) const {
        const int row0 = u.pm * BM + wr * 64 + fr, col0 = u.pn * BM + wc * 32 + 4 * fq;
        f32x4 bv[2][2];
#pragma unroll
        for (int bj = 0; bj < 2; ++bj)
#pragma unroll
            for (int n = 0; n < 2; ++n) bv[bj][n] = bias ? *(const f32x4*)(bias + col0 + bj * HALF + n * 16) : (f32x4){0.f, 0.f, 0.f, 0.f};
#pragma unroll
        for (int ai = 0; ai < 2; ++ai)
#pragma unroll
            for (int m = 0; m < 4; ++m) { float* rowp = C + (size_t)(row0 + ai * HALF + m * 16) * ldc + col0;
#pragma unroll
                for (int bj = 0; bj < 2; ++bj)
#pragma unroll
                    for (int n = 0; n < 2; ++n) *(f32x4*)(rowp + bj * HALF + n * 16) = acc[ai][bj][m][n] + bv[bj][n]; }
    }
};
template <int ACT  > struct EpiBf16 {
    static constexpr bool PERM = true, AFTER_DRAIN = false, I8 = false;
    bf16_t* O; int ldc; const float* bias; int split_cols; size_t split_stride;
    __device__ __forceinline__ void operator()(const f32x4 (&acc)[2][2][4][2], const Unit& u, int wr, int wc, int fr, int fq) const {
        const int row0 = u.pm * BM + wr * 64 + fr; int colt = u.pn * BM; bf16_t* base = O;
        if (split_cols) { const int t = colt / split_cols; base += (size_t)t * split_stride; colt -= t * split_cols; }
        const int col0 = colt + wc * 32 + 8 * fq, bcol0 = u.pn * BM + wc * 32 + 8 * fq;
        f32x4 bv[2][2];
#pragma unroll
        for (int bj = 0; bj < 2; ++bj)
#pragma unroll
            for (int n = 0; n < 2; ++n) bv[bj][n] = bias ? *(const f32x4*)(bias + bcol0 + bj * HALF + 4 * n) : (f32x4){0.f, 0.f, 0.f, 0.f};
#pragma unroll
        for (int ai = 0; ai < 2; ++ai)
#pragma unroll
            for (int m = 0; m < 4; ++m) { bf16_t* rowp = base + (size_t)(row0 + ai * HALF + m * 16) * ldc + col0;
#pragma unroll
                for (int bj = 0; bj < 2; ++bj) { f32x4 v0 = acc[ai][bj][m][0] + bv[bj][0], v1 = acc[ai][bj][m][1] + bv[bj][1];
                    if (ACT == 1) { f32x2 a = gelu_pk((f32x2){v0[0], v0[1]}), b = gelu_pk((f32x2){v0[2], v0[3]}), c = gelu_pk((f32x2){v1[0], v1[1]}), d = gelu_pk((f32x2){v1[2], v1[3]});
                        v0 = (f32x4){a.x, a.y, b.x, b.y}; v1 = (f32x4){c.x, c.y, d.x, d.y}; }
                    if (ACT == 2) {
#pragma unroll
                        for (int j = 0; j < 4; ++j) { v0[j] = 0.5f * v0[j] * (1.0f + erff(v0[j] * 0.70710678f)); v1[j] = 0.5f * v1[j] * (1.0f + erff(v1[j] * 0.70710678f)); } }
                    u32x4 w; w.x = cvt_pk_bf16(v0[0], v0[1]); w.y = cvt_pk_bf16(v0[2], v0[3]); w.z = cvt_pk_bf16(v1[0], v1[1]); w.w = cvt_pk_bf16(v1[2], v1[3]);
                    *(u32x4*)(rowp + bj * HALF) = w; } }
    }
};

typedef int i32x4 __attribute__((ext_vector_type(4)));
template <bool I8> __device__ __forceinline__ f32x4 mma16(bf16x8 b, bf16x8 a, f32x4 c) {
    if constexpr (I8) return __builtin_bit_cast(f32x4, __builtin_amdgcn_mfma_i32_16x16x64_i8(__builtin_bit_cast(i32x4, b), __builtin_bit_cast(i32x4, a), __builtin_bit_cast(i32x4, c), 0, 0, 0));
    else return __builtin_amdgcn_mfma_f32_16x16x32_bf16(b, a, c, 0, 0, 0);
}
template <bool I8> __device__ __forceinline__ f32x4 accf(f32x4 a) { if constexpr (I8) return __builtin_convertvector(__builtin_bit_cast(i32x4, a), f32x4); else return a; }
template <class Epi, class Sched, bool STAMP = false>
__device__ __forceinline__ void gemm_phase(PG8_LAS unsigned char* lds, const Gemm g, const Sched& S, const Epi& E, unsigned long long* stamps) {
    const int tid = threadIdx.x, wid = __builtin_amdgcn_readfirstlane(tid >> 6), lane = tid & 63, wr = wid >> 2, wc = wid & 3, fr = lane & 15, fq = lane >> 4;
    const int K = g.K, nt = K / BK;
    int ts_lo = 0, ts_hi = 0, nts = 0; const unsigned long long rt_entry = STAMP ? (unsigned long long)wall_clock64() : 0ull;
#define PG8_STAMP() do { if (STAMP && wid == 0 && nts < 64) { const unsigned long long _c = (unsigned long long)clock64(); \
        ts_lo = (lane == nts) ? (int)(unsigned)_c : ts_lo; ts_hi = (lane == nts) ? (int)(unsigned)(_c >> 32) : ts_hi; ++nts; } } while (0)
    PG8_STAMP();
    unsigned voffA[2], voffB[2];
#pragma unroll
    for (int i = 0; i < 2; ++i) { int R, C; stage_rc(tid * 16 + i * 8192, R, C); const int Rb = Epi::PERM ? ((R & ~31) + perm32(R & 31)) : R;
        voffA[i] = (unsigned)(R * K + C) * 2u; voffB[i] = (unsigned)(Rb * K + C) * 2u; }
    const size_t kstep = (size_t)(BK * 2);
    const size_t hstep = (size_t)HALF * K * 2;
    const size_t tstep = 2 * hstep;
    const unsigned ldsw = (unsigned)wid * 1024u;
    const int aoff = lds_byte(wr * 64 + fr, fq * 8), boff = lds_byte(wc * 32 + fr, fq * 8);
#define PG8_SA(b, h) (((b) * 2 + (h)) * HTB)
#define PG8_SB(b, h) ((4 + (b) * 2 + (h)) * HTB)
#define PG8_STAGE(bufoff, gbase, voff) do { _Pragma("unroll") for (int _i = 0; _i < 2; ++_i) \
        __builtin_amdgcn_global_load_lds((const unsigned*)((const char*)(gbase) + (voff)[_i]), (PG8_LAS unsigned*)(lds + (bufoff) + ldsw + _i * 8192), 16, 0, 0); } while (0)
#define PG8_LDA(dst, b, h) do { _Pragma("unroll") for (int m = 0; m < 4; ++m) _Pragma("unroll") for (int k = 0; k < 2; ++k) dst[m][k] = *(const PG8_LAS bf16x8*)(lds + PG8_SA(b, h) + aoff + m * 2048 + k * 1024); } while (0)
#define PG8_LDB(dst, b, h) do { _Pragma("unroll") for (int n = 0; n < 2; ++n) _Pragma("unroll") for (int k = 0; k < 2; ++k) dst[n][k] = *(const PG8_LAS bf16x8*)(lds + PG8_SB(b, h) + boff + n * 2048 + k * 1024); } while (0)
#define PG8_MMA(ai, bj, At, Bt) do { __builtin_amdgcn_s_setprio(1); _Pragma("unroll") for (int m = 0; m < 4; ++m) _Pragma("unroll") for (int n = 0; n < 2; ++n) _Pragma("unroll") for (int k = 0; k < 2; ++k) \
        acc[ai][bj][m][n] = mma16<Epi::I8>(Bt[n][k], At[m][k], acc[ai][bj][m][n]); __builtin_amdgcn_s_setprio(0); } while (0)
#define PG8_WAIT_V(n) asm volatile("s_waitcnt vmcnt(" #n ")" ::: "memory")
#define PG8_WAIT_L(n) asm volatile("s_waitcnt lgkmcnt(" #n ")" ::: "memory")
#define PG8_BAR __builtin_amdgcn_s_barrier()
#define PG8_SCHED __builtin_amdgcn_sched_barrier(0)
    Unit cur, nxt; int ui = 0;
    if (!S.next(0, cur)) return;
    f32x4 acc[2][2][4][2];
#pragma unroll
    for (int a = 0; a < 2; ++a)
#pragma unroll
        for (int b = 0; b < 2; ++b)
#pragma unroll
            for (int m = 0; m < 4; ++m)
#pragma unroll
                for (int n = 0; n < 2; ++n) acc[a][b][m][n] = (f32x4){0.f, 0.f, 0.f, 0.f};
    bf16x8 At[4][2], B0[2][2], B1[2][2];
    const char* cA = (const char*)g.A + (size_t)cur.pm * tstep; const char* cB = (const char*)g.Bt + (size_t)cur.pn * tstep;
    S.a_ready(cur);
    PG8_STAGE(PG8_SB(0, 0), cB, voffB); PG8_STAGE(PG8_SA(0, 0), cA, voffA); PG8_STAGE(PG8_SB(0, 1), cB + hstep, voffB); PG8_STAGE(PG8_SA(0, 1), cA + hstep, voffA);
    if (wr == 1) PG8_BAR;
    PG8_WAIT_V(4); PG8_BAR;
    PG8_STAGE(PG8_SB(1, 0), cB + kstep, voffB); PG8_STAGE(PG8_SA(1, 0), cA + kstep, voffA); PG8_STAGE(PG8_SB(1, 1), cB + hstep + kstep, voffB);
    PG8_WAIT_V(6); PG8_BAR;
    PG8_STAMP();
    for (;;) {
        const bool has_next = S.next(ui + 1, nxt);
        const char* nA = has_next ? (const char*)g.A + (size_t)nxt.pm * tstep : cA; const char* nB = has_next ? (const char*)g.Bt + (size_t)nxt.pn * tstep : cB;
        for (int t = 0; t < nt; t += 2) {
            const bool last = (t == nt - 2);
            const char* a1 = cA + (size_t)(t + 1) * kstep;
            const char* a2 = last ? nA : cA + (size_t)(t + 2) * kstep; const char* b2 = last ? nB : cB + (size_t)(t + 2) * kstep;
            const char* a3 = a2 + kstep; const char* b3 = b2 + kstep;
            if (last && has_next) S.a_ready(nxt);
            PG8_LDB(B0, 0, 0); PG8_SCHED; PG8_LDA(At, 0, 0); PG8_STAGE(PG8_SA(1, 1), a1 + hstep, voffA);
            PG8_WAIT_L(8); PG8_BAR; PG8_WAIT_L(0); PG8_MMA(0, 0, At, B0); PG8_BAR; PG8_SCHED;
            PG8_LDB(B1, 0, 1); PG8_STAGE(PG8_SB(0, 0), b2, voffB);
            PG8_BAR; PG8_WAIT_L(0); PG8_MMA(0, 1, At, B1); PG8_BAR;
            PG8_LDA(At, 0, 1); PG8_STAGE(PG8_SA(0, 0), a2, voffA);
            PG8_BAR; PG8_WAIT_L(0); PG8_MMA(1, 0, At, B0); PG8_BAR; PG8_SCHED;
            PG8_STAGE(PG8_SB(0, 1), b2 + hstep, voffB);
            PG8_WAIT_V(6); PG8_BAR; PG8_MMA(1, 1, At, B1); PG8_BAR;
            PG8_LDB(B0, 1, 0); PG8_SCHED; PG8_LDA(At, 1, 0); PG8_STAGE(PG8_SA(0, 1), a2 + hstep, voffA);
            PG8_WAIT_L(8); PG8_BAR; PG8_WAIT_L(0); PG8_MMA(0, 0, At, B0); PG8_BAR; PG8_SCHED;
            PG8_LDB(B1, 1, 1); PG8_STAGE(PG8_SB(1, 0), b3, voffB);
            PG8_BAR; PG8_WAIT_L(0); PG8_MMA(0, 1, At, B1); PG8_BAR;
            PG8_LDA(At, 1, 1); PG8_STAGE(PG8_SA(1, 0), a3, voffA);
            PG8_BAR; PG8_WAIT_L(0); PG8_MMA(1, 0, At, B0); PG8_BAR; PG8_SCHED;
            PG8_STAGE(PG8_SB(1, 1), b3 + hstep, voffB);
            PG8_WAIT_V(6); PG8_BAR; PG8_MMA(1, 1, At, B1); PG8_BAR;
        }
        PG8_STAMP();
        if constexpr (!Epi::AFTER_DRAIN) { E(acc, cur, wr, wc, fr, fq); S.done(cur); }
        PG8_STAMP();
        if (!has_next) break;
#pragma unroll
        for (int a = 0; a < 2; ++a)
#pragma unroll
            for (int b = 0; b < 2; ++b)
#pragma unroll
                for (int m = 0; m < 4; ++m)
#pragma unroll
                    for (int n = 0; n < 2; ++n) acc[a][b][m][n] = (f32x4){0.f, 0.f, 0.f, 0.f};
        cur = nxt; cA = nA; cB = nB; ++ui;
    }
    PG8_WAIT_V(0);
    if (wr == 0) PG8_BAR;
    PG8_BAR;
    if constexpr (Epi::AFTER_DRAIN) { E.fused(acc, cur, wr, wc, fr, fq, lds, wid, lane); S.done(cur); }
    PG8_STAMP();
    if (STAMP && wid == 0) { stamps[lane] = lane < nts ? (((unsigned long long)(unsigned)ts_hi << 32) | (unsigned)ts_lo) : 0ull;
        if (lane == 62) stamps[62] = rt_entry; if (lane == 63) stamps[63] = (unsigned long long)wall_clock64(); }
#undef PG8_STAMP
#undef PG8_SA
#undef PG8_SB
#undef PG8_STAGE
#undef PG8_LDA
#undef PG8_LDB
#undef PG8_MMA
#undef PG8_WAIT_V
#undef PG8_WAIT_L
#undef PG8_BAR
#undef PG8_SCHED
}
}


#define LAS __attribute__((address_space(3)))
typedef unsigned short bf16_t;
typedef float f32x4 __attribute__((ext_vector_type(4)));
typedef unsigned u32x4 __attribute__((ext_vector_type(4)));
typedef unsigned u32x2 __attribute__((ext_vector_type(2)));
typedef short bf16x8 __attribute__((ext_vector_type(8)));
typedef short s16x4 __attribute__((ext_vector_type(4)));
typedef float f32x16 __attribute__((ext_vector_type(16)));

constexpr int MTOK = 16384, DM = 2048, SEQ = 8192, NHEAD = 16;
constexpr float ALPHA = 1.41421356237309515f;
constexpr size_t MiB = (size_t)1 << 20;
constexpr size_t WS_WIN = 0, WS_WOUT = 32 * MiB, WS_WKVQ = 40 * MiB, WS_WO = 64 * MiB, WS_WC = 72 * MiB, WS_UB = 88 * MiB, WS_VB = 152 * MiB, WS_USC = 216 * MiB, WS_VSC = 217 * MiB, WS_H = 224 * MiB, WS_XQ = 232 * MiB, WS_XS = 264 * MiB, WS_W = 272 * MiB, WS_CS = 280 * MiB, WS_SLOT = 344 * MiB;
constexpr size_t WS_EID = 920 * MiB, WS_GATE = 928 * MiB, WS_COS = 936 * MiB, WS_SIN = 938 * MiB, WS_KMEAN = 940 * MiB, WS_LB = 941 * MiB, WS_LS = 942 * MiB, WS_SUB = 946 * MiB, WS_CNT = 962 * MiB, WS_CTR = 963 * MiB, WS_DEC = 964 * MiB, WS_END = 966 * MiB;
constexpr size_t WS_BAR = WS_CTR + 65536;
constexpr size_t WS_XS0 = WS_XS + 1 * MiB, WS_SWIN = WS_XS + 2 * MiB, WS_SWKVQ = WS_XS + 3 * MiB, WS_XS1 = WS_XS + 4 * MiB;
constexpr size_t WS_KNMAX = WS_KMEAN + 768 * 1024;
__host__ __device__ constexpr size_t slot(int i) { return WS_SLOT + (size_t)i * 64 * MiB; }
constexpr int LDS_BYTES = 144 * 1024;
constexpr int NPH = 20;

struct Args { const float* in[14]; float* out; unsigned char* ws; int ph_lo, ph_hi; };

__device__ __forceinline__ float bflo(unsigned w) { return __uint_as_float(w << 16); }
__device__ __forceinline__ float bfhi(unsigned w) { return __uint_as_float(w & 0xffff0000u); }
__device__ __forceinline__ float bf2f(bf16_t b) { return __uint_as_float(((unsigned)b) << 16); }
typedef __bf16 bf16x2_t __attribute__((ext_vector_type(2)));
typedef float f32x2_t __attribute__((ext_vector_type(2)));
__device__ __forceinline__ unsigned pk_bf16(float lo, float hi) { const f32x2_t f = {lo, hi}; return __builtin_bit_cast(unsigned, __builtin_convertvector(f, bf16x2_t)); }
__device__ __forceinline__ float wave_sum(float v) {
#pragma unroll
    for (int o = 32; o >= 1; o >>= 1) v += __shfl_xor(v, o);
    return v;
}
__device__ __forceinline__ float wave_max(float v) {
#pragma unroll
    for (int o = 32; o >= 1; o >>= 1) v = fmaxf(v, __shfl_xor(v, o));
    return v;
}
__device__ __forceinline__ float sigmoidf_(float z) { return 1.0f / (1.0f + __expf(-z)); }


__device__ __forceinline__ void store_wt16(void* p, u32x4 v) {
    __hip_atomic_store((unsigned long long*)p, ((unsigned long long)v.y << 32) | v.x, __ATOMIC_RELAXED, __HIP_MEMORY_SCOPE_AGENT);
    __hip_atomic_store((unsigned long long*)p + 1, ((unsigned long long)v.w << 32) | v.z, __ATOMIC_RELAXED, __HIP_MEMORY_SCOPE_AGENT);
}
__device__ __forceinline__ void store_wt8(void* p, u32x2 v) {
    __hip_atomic_store((unsigned long long*)p, ((unsigned long long)v.y << 32) | v.x, __ATOMIC_RELAXED, __HIP_MEMORY_SCOPE_AGENT);
}
struct EpiIn {
    static constexpr bool PERM = true, AFTER_DRAIN = false, I8 = false;
    bf16_t* Q1; float* LF; bf16_t* I1; bf16_t* G1; const float* LB;
    __device__ __forceinline__ void operator()(const pg8::f32x4 (&acc)[2][2][4][2], const pg8::Unit& u, int wr, int wc, int fr, int fq) const {
        const int type = u.pn >> 3;
        const int row0 = u.pm * 256 + wr * 64 + fr, col0 = (u.pn & 7) * 256 + wc * 32 + 8 * fq;
        if (type == 1) {
#pragma unroll
            for (int bj = 0; bj < 2; ++bj) {
                const int c = col0 + bj * 128;
                const f32x4 lb0 = *(const f32x4*)(LB + c), lb1 = *(const f32x4*)(LB + c + 4);
#pragma unroll
                for (int ai = 0; ai < 2; ++ai)
#pragma unroll
                    for (int m = 0; m < 4; ++m) {
                        float* p = LF + (size_t)(row0 + ai * 128 + m * 16) * DM + c;
                        f32x4 o0, o1;
#pragma unroll
                        for (int j = 0; j < 4; ++j) {
                            o0[j] = __logf(lb0[j] + (1.0f - lb0[j]) * sigmoidf_(acc[ai][bj][m][0][j]));
                            o1[j] = __logf(lb1[j] + (1.0f - lb1[j]) * sigmoidf_(acc[ai][bj][m][1][j]));
                        }
                        *(f32x4*)p = o0; *(f32x4*)(p + 4) = o1;
                    }
            }
        } else {
            bf16_t* dst = Q1 + (size_t)(type - (type > 0 ? 1 : 0)) * ((size_t)32 << 20);
            const bool act = (type != 2);
#pragma unroll
            for (int ai = 0; ai < 2; ++ai)
#pragma unroll
                for (int m = 0; m < 4; ++m)
#pragma unroll
                    for (int bj = 0; bj < 2; ++bj) {
                        f32x4 v0 = acc[ai][bj][m][0], v1 = acc[ai][bj][m][1];
                        if (act) {
#pragma unroll
                            for (int j = 0; j < 4; ++j) { v0[j] = v0[j] * sigmoidf_(v0[j]); v1[j] = v1[j] * sigmoidf_(v1[j]); }
                        }
                        u32x4 w; w.x = pk_bf16(v0[0], v0[1]); w.y = pk_bf16(v0[2], v0[3]); w.z = pk_bf16(v1[0], v1[1]); w.w = pk_bf16(v1[2], v1[3]);
                        *(u32x4*)(dst + (size_t)(row0 + ai * 128 + m * 16) * DM + col0 + bj * 128) = w;
                    }
        }
    }
};
struct EpiRes {
    static constexpr bool PERM = false, AFTER_DRAIN = false, I8 = false;
    const float* res; float* Y;
    __device__ __forceinline__ void operator()(const pg8::f32x4 (&acc)[2][2][4][2], const pg8::Unit& u, int wr, int wc, int fr, int fq) const {
        const int row0 = u.pm * 256 + wr * 64 + fr, col0 = u.pn * 256 + wc * 32 + 4 * fq;
#pragma unroll
        for (int ai = 0; ai < 2; ++ai)
#pragma unroll
            for (int m = 0; m < 4; ++m) {
                const size_t off = (size_t)(row0 + ai * 128 + m * 16) * DM + col0;
#pragma unroll
                for (int bj = 0; bj < 2; ++bj)
#pragma unroll
                    for (int n = 0; n < 2; ++n) {
                        const f32x4 r = *(const f32x4*)(res + off + bj * 128 + n * 16);
                        *(f32x4*)(Y + off + bj * 128 + n * 16) = r * ALPHA + acc[ai][bj][m][n];
                    }
            }
    }
};
struct EpiF32 {
    static constexpr bool PERM = false, AFTER_DRAIN = false, I8 = false;
    float* C; int ldc;
    __device__ __forceinline__ void operator()(const pg8::f32x4 (&acc)[2][2][4][2], const pg8::Unit& u, int wr, int wc, int fr, int fq) const {
        const int row0 = u.pm * 256 + wr * 64 + fr, col0 = u.pn * 256 + wc * 32 + 4 * fq;
#pragma unroll
        for (int ai = 0; ai < 2; ++ai)
#pragma unroll
            for (int m = 0; m < 4; ++m) {
                float* p = C + (size_t)(row0 + ai * 128 + m * 16) * ldc + col0;
#pragma unroll
                for (int bj = 0; bj < 2; ++bj)
#pragma unroll
                    for (int n = 0; n < 2; ++n) *(f32x4*)(p + bj * 128 + n * 16) = acc[ai][bj][m][n];
            }
    }
};
template <bool Q8> struct EpiKVQ_ {
    static constexpr bool PERM = true, AFTER_DRAIN = false, I8 = Q8;
    bf16_t* K; const float* SA; const float* SB;
    __device__ __forceinline__ void operator()(const pg8::f32x4 (&acc)[2][2][4][2], const pg8::Unit& u, int wr, int wc, int fr, int fq) const {
        const int t = u.pn >> 3;
        bf16_t* dst = K + (size_t)t * ((size_t)32 << 20);
        const int row0 = u.pm * 256 + wr * 64 + fr, col0 = (u.pn & 7) * 256 + wc * 32 + 8 * fq;
#pragma unroll
        for (int bj = 0; bj < 2; ++bj) {
            f32x4 sb0 = {1.f, 1.f, 1.f, 1.f}, sb1 = sb0;
            if (Q8) { const float* sp = SB + u.pn * 256 + bj * 128 + wc * 32 + 8 * fq; sb0 = *(const f32x4*)sp; sb1 = *(const f32x4*)(sp + 4); }
#pragma unroll
            for (int ai = 0; ai < 2; ++ai)
#pragma unroll
                for (int m = 0; m < 4; ++m) {
                    const int row = row0 + ai * 128 + m * 16;
                    f32x4 v0 = pg8::accf<Q8>(acc[ai][bj][m][0]), v1 = pg8::accf<Q8>(acc[ai][bj][m][1]);
                    if (Q8) { const float sa = SA[row]; v0 = v0 * sb0 * sa; v1 = v1 * sb1 * sa; }
                    u32x4 w; w.x = pk_bf16(v0[0], v0[1]); w.y = pk_bf16(v0[2], v0[3]); w.z = pk_bf16(v1[0], v1[1]); w.w = pk_bf16(v1[2], v1[3]);
                    *(u32x4*)(dst + (size_t)row * DM + col0 + bj * 128) = w;
                }
        }
    }
};
typedef EpiKVQ_<false> EpiKVQ;

template <bool Q8> struct EpiKVQR_ {
    static constexpr bool PERM = true, AFTER_DRAIN = false, I8 = Q8;
    bf16_t* K; const float* COS; const float* SIN; const float* SA; const float* SB;
    __device__ __forceinline__ void operator()(const pg8::f32x4 (&acc)[2][2][4][2], const pg8::Unit& u, int wr, int wc, int fr, int fq) const {
        const int t = u.pn >> 3;
        bf16_t* dst = K + (size_t)t * ((size_t)32 << 20);
        const int row0 = u.pm * 256 + wr * 64 + fr;
        const int g = 4 * wc + fq;
        const int col0 = (u.pn & 7) * 256 + wc * 32 + 8 * fq;
#pragma unroll
        for (int bj = 0; bj < 2; ++bj) {
            f32x4 sb0 = {1.f, 1.f, 1.f, 1.f}, sb1 = sb0;
            if (Q8) { const float* sp = SB + u.pn * 256 + bj * 128 + wc * 32 + 8 * fq; sb0 = *(const f32x4*)sp; sb1 = *(const f32x4*)(sp + 4); }
#pragma unroll
            for (int ai = 0; ai < 2; ++ai)
#pragma unroll
                for (int m = 0; m < 4; ++m) {
                    const int row = row0 + ai * 128 + m * 16, pos = row & (SEQ - 1);
                    f32x4 a = pg8::accf<Q8>(acc[ai][bj][m][0]), b = pg8::accf<Q8>(acc[ai][bj][m][1]);
                    if (Q8) { const float sa = SA[row]; a = a * sb0 * sa; b = b * sb1 * sa; }
                    if (t == 1) {
                        u32x4 w; w.x = pk_bf16(a[0], a[1]); w.y = pk_bf16(a[2], a[3]); w.z = pk_bf16(b[0], b[1]); w.w = pk_bf16(b[2], b[3]);
                        *(u32x4*)(dst + (size_t)row * DM + col0 + bj * 128) = w;
                    } else {
                        const f32x4 c = *(const f32x4*)(COS + pos * 64 + 4 * g), sn = *(const f32x4*)(SIN + pos * 64 + 4 * g);
                        bf16_t* p = dst + (size_t)row * DM + ((u.pn & 7) * 2 + bj) * 128 + 4 * g;
                        u32x2 w1, w2;
                        w1.x = pk_bf16(a[0] * c[0] - b[0] * sn[0], a[1] * c[1] - b[1] * sn[1]); w1.y = pk_bf16(a[2] * c[2] - b[2] * sn[2], a[3] * c[3] - b[3] * sn[3]);
                        w2.x = pk_bf16(a[0] * sn[0] + b[0] * c[0], a[1] * sn[1] + b[1] * c[1]); w2.y = pk_bf16(a[2] * sn[2] + b[2] * c[2], a[3] * sn[3] + b[3] * c[3]);
                        *(u32x2*)p = w1; *(u32x2*)(p + 64) = w2;
                    }
                }
        }
    }
};

__host__ __device__ __forceinline__ int rot_pos(int d) { return d < 64 ? 8 * (d >> 2) + (d & 3) : 8 * ((d - 64) >> 2) + 4 + (d & 3); }
__device__ __forceinline__ void transpose_tiles(LAS float* tile, const float* src, int ldn, int K, int N, bf16_t* dst, int nperm = 0) {
    const int tid = threadIdx.x;
    const int tn = N / 64, ntiles = tn * (K / 64);
    f32x4 nx[2];
#define TT_LOAD(tI_) { const int k0_ = ((tI_) / tn) * 64, n0_ = ((tI_) % tn) * 64; _Pragma("unroll") for (int r = 0; r < 2; ++r) nx[r] = *(const f32x4*)(src + (size_t)(k0_ + (tid >> 4) + 32 * r) * ldn + n0_ + (tid & 15) * 4); }
    if ((int)blockIdx.x < ntiles) TT_LOAD((int)blockIdx.x)
    for (int tI = blockIdx.x; tI < ntiles; tI += gridDim.x) {
        const int k0 = (tI / tn) * 64, n0 = (tI % tn) * 64;
        const f32x4 c0 = nx[0], c1 = nx[1];
        if (tI + (int)gridDim.x < ntiles) TT_LOAD(tI + (int)gridDim.x)
#pragma unroll
        for (int r = 0; r < 2; ++r) {
            const int kk = (tid >> 4) + 32 * r, nn = (tid & 15) * 4;
            const f32x4 v = r == 0 ? c0 : c1;
            tile[kk * 65 + nn + 0] = v[0]; tile[kk * 65 + nn + 1] = v[1]; tile[kk * 65 + nn + 2] = v[2]; tile[kk * 65 + nn + 3] = v[3];
        }
        __syncthreads();
        {
            const int nn = tid >> 3, kk8 = (tid & 7) * 8;
            float f[8];
#pragma unroll
            for (int j = 0; j < 8; ++j) f[j] = tile[(kk8 + j) * 65 + nn];
            u32x4 w; w.x = pk_bf16(f[0], f[1]); w.y = pk_bf16(f[2], f[3]); w.z = pk_bf16(f[4], f[5]); w.w = pk_bf16(f[6], f[7]);
            const int nsrc = n0 + nn, nrow = nsrc < nperm ? (nsrc & ~127) + rot_pos(nsrc & 127) : nsrc;
            *(u32x4*)(dst + (size_t)nrow * K + k0 + kk8) = w;
        }
        __syncthreads();
    }
}
#undef TT_LOAD
__device__ __forceinline__ void convert_bf16(const float* src, bf16_t* dst, size_t n) {
    const size_t stride = (size_t)gridDim.x * 512 * 8;
    for (size_t i = ((size_t)blockIdx.x * 512 + threadIdx.x) * 8; i < n; i += stride) {
        const f32x4 a = *(const f32x4*)(src + i), b = *(const f32x4*)(src + i + 4);
        u32x4 w; w.x = pk_bf16(a[0], a[1]); w.y = pk_bf16(a[2], a[3]); w.z = pk_bf16(b[0], b[1]); w.w = pk_bf16(b[2], b[3]);
        *(u32x4*)(dst + i) = w;
    }
}
__device__ __forceinline__ void split8(const f32x4 x0, const f32x4 x1, bf16x8& hi, bf16x8& lo) {
    u32x4 h, l;
    h.x = pk_bf16(x0[0], x0[1]); h.y = pk_bf16(x0[2], x0[3]); h.z = pk_bf16(x1[0], x1[1]); h.w = pk_bf16(x1[2], x1[3]);
    l.x = pk_bf16(x0[0] - bflo(h.x), x0[1] - bfhi(h.x)); l.y = pk_bf16(x0[2] - bflo(h.y), x0[3] - bfhi(h.y)); l.z = pk_bf16(x1[0] - bflo(h.z), x1[1] - bfhi(h.z)); l.w = pk_bf16(x1[2] - bflo(h.w), x1[3] - bfhi(h.w));
    hi = __builtin_bit_cast(bf16x8, h); lo = __builtin_bit_cast(bf16x8, l);
}
__device__ __forceinline__ void fold_peer_keys(const float* w_query, const float* sub_keys, bf16_t* WcT) {
    const int lane = threadIdx.x & 63, gw = blockIdx.x * 8 + (threadIdx.x >> 6), nw = gridDim.x * 8, r32 = lane & 31, hh2 = lane >> 5;
    for (int wt = gw; wt < 8192; wt += nw) {
        const int item = wt >> 3, sub = wt & 7, keyt = sub & 3, kint = sub >> 2;
        const int l = item >> 9, rem = item & 511, hh = rem >> 5, kb = rem & 31, h = hh >> 1, half = hh & 1;
        const float* sk = sub_keys + (size_t)(((l * 2 + half) * 8 + h) * 128 + keyt * 32 + r32) * 128 + 8 * hh2;
        const float* wq = w_query + (size_t)l * DM * DM + (size_t)(kb * 64 + kint * 32 + r32) * DM + h * 256 + half * 128 + 8 * hh2;
        f32x16 acc;
#pragma unroll
        for (int i = 0; i < 16; ++i) acc[i] = 0.f;
#pragma unroll 1
        for (int kh = 0; kh < 2; ++kh) {
            f32x4 av[8], bv[8];
#pragma unroll
            for (int ks = 0; ks < 4; ++ks) { const int kk = 64 * kh + 16 * ks; av[2 * ks] = *(const f32x4*)(wq + kk); av[2 * ks + 1] = *(const f32x4*)(wq + kk + 4); bv[2 * ks] = *(const f32x4*)(sk + kk); bv[2 * ks + 1] = *(const f32x4*)(sk + kk + 4); }
#pragma unroll
            for (int ks = 0; ks < 4; ++ks) {
                bf16x8 ah, al, bh, bl;
                split8(av[2 * ks], av[2 * ks + 1], ah, al); split8(bv[2 * ks], bv[2 * ks + 1], bh, bl);
                acc = __builtin_amdgcn_mfma_f32_32x32x16_bf16(al, bh, acc, 0, 0, 0);
                acc = __builtin_amdgcn_mfma_f32_32x32x16_bf16(ah, bl, acc, 0, 0, 0);
                acc = __builtin_amdgcn_mfma_f32_32x32x16_bf16(ah, bh, acc, 0, 0, 0);
            }
        }
        bf16_t* o = WcT + (size_t)l * DM * DM + (size_t)(h * 256 + half * 128 + keyt * 32 + r32) * DM + kb * 64 + kint * 32 + 4 * hh2;
#pragma unroll
        for (int q = 0; q < 4; ++q) { u32x2 w; w.x = pk_bf16(acc[4 * q], acc[4 * q + 1]); w.y = pk_bf16(acc[4 * q + 2], acc[4 * q + 3]); *(u32x2*)(o + 8 * q) = w; }
    }
}

__device__ __forceinline__ void quant_rows(const float* src, unsigned char* dst, float* scl, int nrows) {
    const int lane = threadIdx.x & 63, gw = blockIdx.x * 8 + (threadIdx.x >> 6), nw = gridDim.x * 8;
    for (int row = gw; row < nrows; row += nw) {
        const float* p = src + (size_t)row * DM;
        f32x4 v[8];
#pragma unroll
        for (int i = 0; i < 2; ++i)
#pragma unroll
            for (int q = 0; q < 4; ++q) v[i * 4 + q] = *(const f32x4*)(p + 1024 * i + 16 * lane + 4 * q);
        float am = 0.f;
#pragma unroll
        for (int i = 0; i < 8; ++i) am = fmaxf(am, fmaxf(fmaxf(fabsf(v[i][0]), fabsf(v[i][1])), fmaxf(fabsf(v[i][2]), fabsf(v[i][3]))));
        am = fmaxf(wave_max(am), 1e-30f);
        const float inv = 127.0f / am;
        if (lane == 0) scl[row] = am * (1.0f / 127.0f);
#pragma unroll
        for (int i = 0; i < 2; ++i) {
            u32x4 w;
#pragma unroll
            for (int q = 0; q < 4; ++q) {
                const f32x4 t = v[i * 4 + q];
                const unsigned b0 = (unsigned)(int)(rintf(t[0] * inv) + 128.0f), b1 = (unsigned)(int)(rintf(t[1] * inv) + 128.0f), b2 = (unsigned)(int)(rintf(t[2] * inv) + 128.0f), b3 = (unsigned)(int)(rintf(t[3] * inv) + 128.0f);
                w[q] = b0 | (b1 << 8) | (b2 << 16) | (b3 << 24);
            }
            *(u32x4*)(dst + (size_t)row * DM + 1024 * i + 16 * lane) = w;
        }
    }
}
__device__ __forceinline__ void quant_transpose(LAS unsigned char* lds, const float* src, int ldn, int N, signed char* dst, float* scl, int nperm = 0) {
    const int tid = threadIdx.x, kg = tid >> 3, c4 = (tid & 7) * 4, wv = tid >> 6;
    LAS float* red = (LAS float*)lds;
    for (int sI = blockIdx.x; sI < N / 32; sI += gridDim.x) {
        const int n0 = sI * 32;
        f32x4 v[32];
        const float* p = src + (size_t)(kg * 32) * ldn + n0 + c4;
#pragma unroll
        for (int it = 0; it < 32; ++it) v[it] = *(const f32x4*)(p + (size_t)it * ldn);
        f32x4 am = {0.f, 0.f, 0.f, 0.f};
#pragma unroll
        for (int it = 0; it < 32; ++it)
#pragma unroll
            for (int j = 0; j < 4; ++j) am[j] = fmaxf(am[j], fabsf(v[it][j]));
#pragma unroll
        for (int o = 8; o <= 32; o <<= 1)
#pragma unroll
            for (int j = 0; j < 4; ++j) am[j] = fmaxf(am[j], __shfl_xor(am[j], o));
        if ((tid & 63) < 8) *(LAS f32x4*)(red + wv * 32 + c4) = am;
        __syncthreads();
#pragma unroll
        for (int w = 0; w < 8; ++w) { const f32x4 r = *(const LAS f32x4*)(red + w * 32 + c4);
#pragma unroll
            for (int j = 0; j < 4; ++j) am[j] = fmaxf(am[j], r[j]); }
#pragma unroll
        for (int j = 0; j < 4; ++j) {
            const float m = fmaxf(am[j], 1e-30f), inv = 127.0f / m;
            const int nsrc = n0 + c4 + j, nrow = nsrc < nperm ? (nsrc & ~127) + rot_pos(nsrc & 127) : nsrc;
            if (kg == 0) scl[nrow] = m * (1.0f / 127.0f);
            signed char* o = dst + (size_t)nrow * DM + kg * 32;
#pragma unroll
            for (int h = 0; h < 2; ++h) {
                u32x4 w;
#pragma unroll
                for (int d = 0; d < 4; ++d) {
                    unsigned bb = 0;
#pragma unroll
                    for (int e = 0; e < 4; ++e) bb |= ((unsigned)(int)rintf(v[h * 16 + d * 4 + e][j] * inv) & 0xffu) << (8 * e);
                    w[d] = bb;
                }
                *(u32x4*)(o + h * 16) = w;
            }
        }
        __syncthreads();
    }
}
__device__ __forceinline__ void quant_rows_s(const float* src, signed char* dst, float* scl, int nrows) {
    const int lane = threadIdx.x & 63, gw = blockIdx.x * 8 + (threadIdx.x >> 6), nw = gridDim.x * 8;
    for (int row = gw; row < nrows; row += nw) {
        const float* p = src + (size_t)row * DM;
        f32x4 v[8];
#pragma unroll
        for (int i = 0; i < 2; ++i)
#pragma unroll
            for (int q = 0; q < 4; ++q) v[i * 4 + q] = *(const f32x4*)(p + 1024 * i + 16 * lane + 4 * q);
        float am = 0.f;
#pragma unroll
        for (int i = 0; i < 8; ++i) am = fmaxf(am, fmaxf(fmaxf(fabsf(v[i][0]), fabsf(v[i][1])), fmaxf(fabsf(v[i][2]), fabsf(v[i][3]))));
        am = fmaxf(wave_max(am), 1e-30f);
        const float inv = 127.0f / am;
        if (lane == 0) scl[row] = am * (1.0f / 127.0f);
#pragma unroll
        for (int i = 0; i < 2; ++i) {
            u32x4 w;
#pragma unroll
            for (int q = 0; q < 4; ++q) {
                const f32x4 t = v[i * 4 + q];
                w[q] = ((unsigned)(int)rintf(t[0] * inv) & 0xffu) | (((unsigned)(int)rintf(t[1] * inv) & 0xffu) << 8) | (((unsigned)(int)rintf(t[2] * inv) & 0xffu) << 16) | (((unsigned)(int)rintf(t[3] * inv) & 0xffu) << 24);
            }
            *(u32x4*)(dst + (size_t)row * DM + 1024 * i + 16 * lane) = w;
        }
    }
}
__device__ __forceinline__ void phase_prep(const Args& a, LAS unsigned char* lds) {
    unsigned char* ws = a.ws;
    LAS float* tile = (LAS float*)lds;
    quant_transpose(lds, a.in[1], 4 * DM, 4 * DM, (signed char*)(ws + WS_WIN), (float*)(ws + WS_SWIN));
    transpose_tiles(tile, a.in[3], DM, DM, DM, (bf16_t*)(ws + WS_WOUT));
    quant_transpose(lds, a.in[5], 2 * DM, 2 * DM, (signed char*)(ws + WS_WKVQ), (float*)(ws + WS_SWKVQ), DM);
    quant_transpose(lds, a.in[6], DM, DM, (signed char*)(ws + WS_WKVQ) + (size_t)2 * DM * DM, (float*)(ws + WS_SWKVQ) + 2 * DM, DM);
    transpose_tiles(tile, a.in[7], DM, DM, DM, (bf16_t*)(ws + WS_WO));
    fold_peer_keys(a.in[8], a.in[9], (bf16_t*)(ws + WS_WC));
    quant_rows_s(a.in[0], (signed char*)(ws + slot(0)), (float*)(ws + WS_XS0), MTOK);
    const int gtid = blockIdx.x * 512 + threadIdx.x, gthreads = gridDim.x * 512;
    float* COS = (float*)(ws + WS_COS); float* SIN = (float*)(ws + WS_SIN); float* LB = (float*)(ws + WS_LB);
    for (int i = gtid; i < SEQ * 64; i += gthreads) {
        const int pos = i >> 6, j = i & 63;
        double inv = 1.0; const double r = 0.86596432336006535;
        for (int q = 0; q < j; ++q) inv *= r;
        const float ang = (float)pos * (float)inv;
        const double x = (double)ang;
        const double n = __builtin_rint(x * 0.15915494309189535);
        const float rf = (float)__builtin_fma(-n, 6.283185307179586, x);
        COS[i] = cosf(rf); SIN[i] = sinf(rf);
    }
    for (int c = gtid; c < DM; c += gthreads) { const float l0 = a.in[4][c], l1 = a.in[4][DM + c]; LB[c] = 1.0f / (1.0f + expf(l1 - l0)); }
}

__device__ __forceinline__ void phase_scan_naive(const bf16_t* Q1, const float* LF, const bf16_t* I1, float* O) {
    const int lane = threadIdx.x & 63, gw = blockIdx.x * 8 + (threadIdx.x >> 6), nw = gridDim.x * 8;
    for (int item = gw; item < 2 * NHEAD * 128; item += nw) {
        const int bh = item >> 7, v = item & 127, b = bh >> 4, h = bh & 15;
        const size_t base = (size_t)b * SEQ * DM + h * 128;
        float S0 = 0.f, S1 = 0.f;
#pragma unroll 4
        for (int t = 0; t < SEQ; ++t) {
            const size_t ro = base + (size_t)t * DM;
            const float f0 = __expf(LF[ro + lane]), f1 = __expf(LF[ro + 64 + lane]);
            const float q0 = bf2f(Q1[ro + lane]), q1 = bf2f(Q1[ro + 64 + lane]);
            const float iv = bf2f(I1[ro + v]);
            S0 = f0 * S0 + (1.0f - f0) * iv; S1 = f1 * S1 + (1.0f - f1) * iv;
            const float p = wave_sum(q0 * S0 + q1 * S1);
            if (lane == 0) O[ro + v] = p;
        }
    }
}
__device__ __forceinline__ void phase_onorm(const float* O, const bf16_t* G1, const float* gnorm, bf16_t* OG) {
    const int lane = threadIdx.x & 63, gw = blockIdx.x * 8 + (threadIdx.x >> 6), nw = gridDim.x * 8;
    const float gn0 = gnorm[2 * lane], gn1 = gnorm[2 * lane + 1];
    for (int item = gw; item < MTOK * NHEAD; item += nw) {
        const size_t off = (size_t)item * 128 + 2 * lane;
        const float o0 = O[off], o1 = O[off + 1];
        const float ss = wave_sum(o0 * o0 + o1 * o1);
        const float r = rsqrtf(ss * (1.0f / 128.0f) + 1e-6f);
        const unsigned g = *(const unsigned*)(G1 + off);
        *(unsigned*)(OG + off) = pk_bf16(o0 * r * gn0 * bflo(g), o1 * r * gn1 * bfhi(g));
    }
}

__device__ __forceinline__ void ln_row_store(float (&v)[32], const float* g, const float* bta, float* outf, bf16_t* outb, int lane, signed char* outq = nullptr, float* outs = nullptr) {
    float s = 0.f;
#pragma unroll
    for (int i = 0; i < 32; ++i) s += v[i];
    const float mu = wave_sum(s) * (1.0f / DM);
    float q = 0.f;
#pragma unroll
    for (int i = 0; i < 32; ++i) { v[i] -= mu; q += v[i] * v[i]; }
    const float rstd = rsqrtf(wave_sum(q) * (1.0f / DM) + 1e-5f);
    float am = 0.f;
#pragma unroll
    for (int i = 0; i < 4; ++i) {
        const int c = 512 * i + 8 * lane;
        const f32x4 g0 = *(const f32x4*)(g + c), g1 = *(const f32x4*)(g + c + 4), b0 = *(const f32x4*)(bta + c), b1 = *(const f32x4*)(bta + c + 4);
        f32x4 o0, o1;
#pragma unroll
        for (int j = 0; j < 4; ++j) { o0[j] = v[i * 8 + j] * rstd * g0[j] + b0[j]; o1[j] = v[i * 8 + 4 + j] * rstd * g1[j] + b1[j]; v[i * 8 + j] = o0[j]; v[i * 8 + 4 + j] = o1[j]; am = fmaxf(am, fmaxf(fabsf(o0[j]), fabsf(o1[j]))); }
        if (outf) { *(f32x4*)(outf + c) = o0; *(f32x4*)(outf + c + 4) = o1; }
        if (outb) { u32x4 w; w.x = pk_bf16(o0[0], o0[1]); w.y = pk_bf16(o0[2], o0[3]); w.z = pk_bf16(o1[0], o1[1]); w.w = pk_bf16(o1[2], o1[3]); *(u32x4*)(outb + c) = w; }
    }
    if (outq) {
        am = fmaxf(wave_max(am), 1e-30f);
        const float inv = 127.0f / am;
        if (lane == 0) *outs = am * (1.0f / 127.0f);
#pragma unroll
        for (int i = 0; i < 4; ++i) {
            u32x2 w;
            w.x = ((unsigned)(int)rintf(v[i * 8 + 0] * inv) & 0xffu) | (((unsigned)(int)rintf(v[i * 8 + 1] * inv) & 0xffu) << 8) | (((unsigned)(int)rintf(v[i * 8 + 2] * inv) & 0xffu) << 16) | (((unsigned)(int)rintf(v[i * 8 + 3] * inv) & 0xffu) << 24);
            w.y = ((unsigned)(int)rintf(v[i * 8 + 4] * inv) & 0xffu) | (((unsigned)(int)rintf(v[i * 8 + 5] * inv) & 0xffu) << 8) | (((unsigned)(int)rintf(v[i * 8 + 6] * inv) & 0xffu) << 16) | (((unsigned)(int)rintf(v[i * 8 + 7] * inv) & 0xffu) << 24);
            *(u32x2*)(outq + 512 * i + 8 * lane) = w;
        }
    }
}
__device__ __forceinline__ void ln_row_store16(float (&v)[32], const float* g, const float* bta, float* outf, bf16_t* outb, int lane) {
    float s = 0.f;
#pragma unroll
    for (int i = 0; i < 32; ++i) s += v[i];
    const float mu = wave_sum(s) * (1.0f / DM);
    float q = 0.f;
#pragma unroll
    for (int i = 0; i < 32; ++i) { v[i] -= mu; q += v[i] * v[i]; }
    const float rstd = rsqrtf(wave_sum(q) * (1.0f / DM) + 1e-5f);
#pragma unroll
    for (int i = 0; i < 2; ++i) {
        const int c = 1024 * i + 16 * lane;
        f32x4 o[4];
#pragma unroll
        for (int qd = 0; qd < 4; ++qd) {
            const f32x4 gg = *(const f32x4*)(g + c + 4 * qd), bb = *(const f32x4*)(bta + c + 4 * qd);
#pragma unroll
            for (int j = 0; j < 4; ++j) o[qd][j] = v[16 * i + 4 * qd + j] * rstd * gg[j] + bb[j];
            *(f32x4*)(outf + c + 4 * qd) = o[qd];
        }
        if (outb) {
            u32x4 w0, w1;
            w0.x = pk_bf16(o[0][0], o[0][1]); w0.y = pk_bf16(o[0][2], o[0][3]); w0.z = pk_bf16(o[1][0], o[1][1]); w0.w = pk_bf16(o[1][2], o[1][3]);
            w1.x = pk_bf16(o[2][0], o[2][1]); w1.y = pk_bf16(o[2][2], o[2][3]); w1.z = pk_bf16(o[3][0], o[3][1]); w1.w = pk_bf16(o[3][2], o[3][3]);
            *(u32x4*)(outb + c) = w0; *(u32x4*)(outb + c + 8) = w1;
        }
    }
}
template <bool RES16> __device__ __forceinline__ void phase_ln(const bf16_t* Y, const void* RESv, const float* g, const float* bta, float* outf, bf16_t* outb, signed char* outq = nullptr, float* outs = nullptr) {
    const int lane = threadIdx.x & 63, gw = blockIdx.x * 8 + (threadIdx.x >> 6), nw = gridDim.x * 8;
    for (int row = gw; row < MTOK; row += nw) {
        float v[32];
        const bf16_t* p = Y + (size_t)row * DM;
#pragma unroll
        for (int i = 0; i < 4; ++i) {
            const u32x4 yw = *(const u32x4*)(p + 512 * i + 8 * lane);
            const f32x4 a = {bflo(yw.x), bfhi(yw.x), bflo(yw.y), bfhi(yw.y)}, b = {bflo(yw.z), bfhi(yw.z), bflo(yw.w), bfhi(yw.w)};
            f32x4 ra, rb;
            if (RES16) { const u32x4 w = *(const u32x4*)((const bf16_t*)RESv + (size_t)row * DM + 512 * i + 8 * lane); ra = (f32x4){bflo(w.x), bfhi(w.x), bflo(w.y), bfhi(w.y)}; rb = (f32x4){bflo(w.z), bfhi(w.z), bflo(w.w), bfhi(w.w)}; }
            else { const float* rp = (const float*)RESv + (size_t)row * DM; ra = *(const f32x4*)(rp + 512 * i + 8 * lane); rb = *(const f32x4*)(rp + 512 * i + 8 * lane + 4); }
#pragma unroll
            for (int j = 0; j < 4; ++j) { v[i * 8 + j] = a[j] + ALPHA * ra[j]; v[i * 8 + 4 + j] = b[j] + ALPHA * rb[j]; }
        }
        ln_row_store(v, g, bta, outf ? outf + (size_t)row * DM : nullptr, outb ? outb + (size_t)row * DM : nullptr, lane, outq ? outq + (size_t)row * DM : nullptr, outs ? outs + row : nullptr);
    }
}

__device__ __forceinline__ void wave_argmax(float& v, int& idx) {
#pragma unroll
    for (int o = 32; o >= 1; o >>= 1) {
        const float ov = __shfl_xor(v, o); const int oi = __shfl_xor(idx, o);
        if (ov > v || (ov == v && oi < idx)) { v = ov; idx = oi; }
    }
}
__device__ __forceinline__ unsigned fkey(float x) { const unsigned u = __float_as_uint(x); return u ^ (unsigned)(((int)u >> 31) | 0x80000000); }
__device__ __forceinline__ float funkey(unsigned k) { const unsigned u = (k & 0x80000000u) ? (k ^ 0x80000000u) : ~k; return __uint_as_float(u); }
__device__ __forceinline__ void sort16_insert(unsigned (&r)[16], unsigned v) {
#pragma unroll
    for (int i = 0; i < 16; ++i) { const unsigned m = r[i] > v ? r[i] : v; v = r[i] > v ? v : r[i]; r[i] = m; }
}
__device__ __forceinline__ void phase_topk(LAS unsigned char* lds, const float* SCT, int* EID, float* GATE) {
    LAS unsigned char* ib = lds + threadIdx.x * 32;
    for (int item = blockIdx.x * 512 + threadIdx.x; item < MTOK * 8; item += gridDim.x * 512) {
        const int h = item >> 14, tok = item & (MTOK - 1);
        const float* p = SCT + (size_t)(h * 256) * MTOK + tok;
        unsigned r1[16], r2[16];
#pragma unroll
        for (int i = 0; i < 16; ++i) { r1[i] = 0u; r2[i] = 0u; }
#pragma unroll 8
        for (int e = 0; e < 128; ++e) {
            const float x1 = p[(size_t)e * MTOK], x2 = p[(size_t)(128 + e) * MTOK];
            sort16_insert(r1, (fkey(x1) & ~0x7Fu) | (unsigned)e);
            sort16_insert(r2, (fkey(x2) & ~0x7Fu) | (unsigned)e);
        }
        float v1[16], v2[16];
#pragma unroll
        for (int i = 0; i < 16; ++i) { v1[i] = funkey(r1[i] & ~0x7Fu); v2[i] = funkey(r2[i] & ~0x7Fu); ib[i] = (unsigned char)(r1[i] & 0x7Fu); ib[16 + i] = (unsigned char)(r2[i] & 0x7Fu); }
        unsigned r3[16];
#pragma unroll
        for (int i = 0; i < 16; ++i) r3[i] = 0u;
#pragma unroll
        for (int a = 0; a < 16; ++a)
#pragma unroll
            for (int bq = 0; bq < 16; ++bq)
                if ((a + 1) * (bq + 1) <= 16) sort16_insert(r3, (fkey(v1[a] + v2[bq]) & ~0xFFu) | (unsigned)(a * 16 + bq));
        const float mx = funkey(r3[0] & ~0xFFu);
        float ev[16]; float sum = 0.f;
#pragma unroll
        for (int i = 0; i < 16; ++i) { ev[i] = __expf(funkey(r3[i] & ~0xFFu) - mx); sum += ev[i]; }
        const float rs = 1.0f / sum;
        int eid[16];
#pragma unroll
        for (int i = 0; i < 16; ++i) { const unsigned f = r3[i] & 0xFFu; eid[i] = (int)ib[f >> 4] * 128 + (int)ib[16 + (f & 15u)]; }
        int* eo = EID + (size_t)tok * 128 + h * 16; float* go = GATE + (size_t)tok * 128 + h * 16;
#pragma unroll
        for (int q = 0; q < 4; ++q) {
            *(u32x4*)(eo + 4 * q) = (u32x4){(unsigned)eid[4 * q], (unsigned)eid[4 * q + 1], (unsigned)eid[4 * q + 2], (unsigned)eid[4 * q + 3]};
            *(f32x4*)(go + 4 * q) = (f32x4){ev[4 * q] * rs, ev[4 * q + 1] * rs, ev[4 * q + 2] * rs, ev[4 * q + 3] * rs};
        }
    }
}

__device__ __forceinline__ float gelu_erf(float x) { return 0.5f * x * (1.0f + erff(x * 0.70710678118654752f)); }
__device__ __forceinline__ float ub0(unsigned w) { return (float)(w & 0xffu); }
__device__ __forceinline__ float ub1(unsigned w) { return (float)((w >> 8) & 0xffu); }
__device__ __forceinline__ float ub2(unsigned w) { return (float)((w >> 16) & 0xffu); }
__device__ __forceinline__ float ub3(unsigned w) { return (float)(w >> 24); }
__device__ __forceinline__ void phase_peer(LAS unsigned char* lds, const float* X, const int* EID, const float* GATE, const unsigned char* U, const unsigned char* V, const float* USC, const float* VSC,
                                           const float* g, const float* bta, float* outf, bf16_t* outb) {
    const int lane = threadIdx.x & 63, wv = threadIdx.x >> 6, gw = blockIdx.x * 8 + wv, nw = gridDim.x * 8;
    LAS float* hb = (LAS float*)(lds + wv * 512);
    for (int tok = gw; tok < MTOK; tok += nw) {
        float x[32];
        const float* xp = X + (size_t)tok * DM;
#pragma unroll
        for (int i = 0; i < 2; ++i)
#pragma unroll
            for (int q = 0; q < 4; ++q) { const f32x4 t = *(const f32x4*)(xp + 1024 * i + 16 * lane + 4 * q); x[16 * i + 4 * q] = t[0]; x[16 * i + 4 * q + 1] = t[1]; x[16 * i + 4 * q + 2] = t[2]; x[16 * i + 4 * q + 3] = t[3]; }
        float sx = 0.f;
#pragma unroll
        for (int j = 0; j < 32; ++j) sx += x[j];
        const float d0 = -128.0f * sx;
        const int e0 = EID[(size_t)tok * 128 + lane], e1 = EID[(size_t)tok * 128 + 64 + lane];
        const float g0 = GATE[(size_t)tok * 128 + lane], g1 = GATE[(size_t)tok * 128 + 64 + lane];
        for (int bt = 0; bt < 16; ++bt) {
            float d[8];
#pragma unroll
            for (int r = 0; r < 8; ++r) {
                const int e = bt * 8 + r;
                const int idx = __builtin_amdgcn_readfirstlane(__shfl(bt < 8 ? e0 : e1, e & 63));
                const u32x4* up = (const u32x4*)(U + (size_t)idx * DM) + lane;
                float acc = d0;
#pragma unroll
                for (int i = 0; i < 2; ++i) {
                    const u32x4 w = up[i * 64];
                    acc += x[16 * i + 0] * ub0(w.x) + x[16 * i + 1] * ub1(w.x) + x[16 * i + 2] * ub2(w.x) + x[16 * i + 3] * ub3(w.x)
                         + x[16 * i + 4] * ub0(w.y) + x[16 * i + 5] * ub1(w.y) + x[16 * i + 6] * ub2(w.y) + x[16 * i + 7] * ub3(w.y)
                         + x[16 * i + 8] * ub0(w.z) + x[16 * i + 9] * ub1(w.z) + x[16 * i + 10] * ub2(w.z) + x[16 * i + 11] * ub3(w.z)
                         + x[16 * i + 12] * ub0(w.w) + x[16 * i + 13] * ub1(w.w) + x[16 * i + 14] * ub2(w.w) + x[16 * i + 15] * ub3(w.w);
                }
                d[r] = acc;
            }
            const bool b5 = lane & 32, b4 = lane & 16, b3 = lane & 8;
            float t4[4];
#pragma unroll
            for (int q = 0; q < 4; ++q) { const float keep = b5 ? d[4 + q] : d[q], send = b5 ? d[q] : d[4 + q]; t4[q] = keep + __shfl_xor(send, 32); }
            float t2[2];
#pragma unroll
            for (int q = 0; q < 2; ++q) { const float keep = b4 ? t4[2 + q] : t4[q], send = b4 ? t4[q] : t4[2 + q]; t2[q] = keep + __shfl_xor(send, 16); }
            float t1;
            { const float keep = b3 ? t2[1] : t2[0], send = b3 ? t2[0] : t2[1]; t1 = keep + __shfl_xor(send, 8); }
            t1 += __shfl_xor(t1, 4); t1 += __shfl_xor(t1, 2); t1 += __shfl_xor(t1, 1);
            if ((lane & 7) == 0) hb[bt * 8 + (lane >> 3 & 1) + 2 * (lane >> 4 & 1) + 4 * (lane >> 5 & 1)] = t1;
        }
        asm volatile("s_waitcnt lgkmcnt(0)" ::: "memory");
        const float h0 = hb[lane] * USC[e0], h1 = hb[64 + lane] * USC[e1];
        const float w0 = g0 * gelu_erf(h0) * VSC[e0], w1 = g1 * gelu_erf(h1) * VSC[e1];
        float wsum = wave_sum(w0 + w1);
        float y[32];
#pragma unroll
        for (int i = 0; i < 32; ++i) y[i] = 0.f;
#pragma unroll 8
        for (int e = 0; e < 128; ++e) {
            const int idx = __builtin_amdgcn_readfirstlane(__shfl(e < 64 ? e0 : e1, e & 63));
            const float wt = __shfl(e < 64 ? w0 : w1, e & 63);
            const u32x4* vp = (const u32x4*)(V + (size_t)idx * DM) + lane;
#pragma unroll
            for (int i = 0; i < 2; ++i) {
                const u32x4 w = vp[i * 64];
                y[16 * i + 0] += wt * ub0(w.x); y[16 * i + 1] += wt * ub1(w.x); y[16 * i + 2] += wt * ub2(w.x); y[16 * i + 3] += wt * ub3(w.x);
                y[16 * i + 4] += wt * ub0(w.y); y[16 * i + 5] += wt * ub1(w.y); y[16 * i + 6] += wt * ub2(w.y); y[16 * i + 7] += wt * ub3(w.y);
                y[16 * i + 8] += wt * ub0(w.z); y[16 * i + 9] += wt * ub1(w.z); y[16 * i + 10] += wt * ub2(w.z); y[16 * i + 11] += wt * ub3(w.z);
                y[16 * i + 12] += wt * ub0(w.w); y[16 * i + 13] += wt * ub1(w.w); y[16 * i + 14] += wt * ub2(w.w); y[16 * i + 15] += wt * ub3(w.w);
            }
        }
        const float corr = -128.0f * wsum;
#pragma unroll
        for (int i = 0; i < 32; ++i) y[i] = y[i] + corr + ALPHA * x[i];
        ln_row_store16(y, g, bta, outf + (size_t)tok * DM, outb ? outb + (size_t)tok * DM : nullptr, lane);
        asm volatile("s_waitcnt lgkmcnt(0)" ::: "memory");
    }
}

__device__ __forceinline__ int row_dot_i8(const u32x4 (&xq)[2], const unsigned char* rowp, int lane) {
    const u32x4* up = (const u32x4*)rowp + lane;
    int acc = 0;
#pragma unroll
    for (int i = 0; i < 2; ++i) {
        const u32x4 w = up[i * 64];
        acc = __builtin_amdgcn_sdot4((int)xq[i].x, (int)(w.x ^ 0x80808080u), acc, false); acc = __builtin_amdgcn_sdot4((int)xq[i].y, (int)(w.y ^ 0x80808080u), acc, false);
        acc = __builtin_amdgcn_sdot4((int)xq[i].z, (int)(w.z ^ 0x80808080u), acc, false); acc = __builtin_amdgcn_sdot4((int)xq[i].w, (int)(w.w ^ 0x80808080u), acc, false);
    }
    return acc;
}
__device__ __forceinline__ void peer_issue8(u32x4 (&seg)[8], const unsigned char* base, const u32x4 ia, const u32x4 ib) {
    seg[0] = *(const u32x4*)(base + (size_t)ia.x * DM); seg[1] = *(const u32x4*)(base + (size_t)ia.y * DM); seg[2] = *(const u32x4*)(base + (size_t)ia.z * DM); seg[3] = *(const u32x4*)(base + (size_t)ia.w * DM);
    seg[4] = *(const u32x4*)(base + (size_t)ib.x * DM); seg[5] = *(const u32x4*)(base + (size_t)ib.y * DM); seg[6] = *(const u32x4*)(base + (size_t)ib.z * DM); seg[7] = *(const u32x4*)(base + (size_t)ib.w * DM);
}
__device__ __forceinline__ void peer_dot8(int (&d)[8], const u32x4 (&seg)[8], const u32x4 xq) {
#pragma unroll
    for (int i = 0; i < 8; ++i) {
        int acc = __builtin_amdgcn_sdot4((int)xq.x, (int)(seg[i].x ^ 0x80808080u), 0, false);
        acc = __builtin_amdgcn_sdot4((int)xq.y, (int)(seg[i].y ^ 0x80808080u), acc, false);
        acc = __builtin_amdgcn_sdot4((int)xq.z, (int)(seg[i].z ^ 0x80808080u), acc, false);
        d[i] = __builtin_amdgcn_sdot4((int)xq.w, (int)(seg[i].w ^ 0x80808080u), acc, false);
    }
}
__device__ __forceinline__ void phase_peer_u(const signed char* XQ, const int* EID, const unsigned char* U, LAS int* HL  ) {
    const int lane = threadIdx.x & 63, wv = threadIdx.x >> 6, es = lane >> 3, cc = lane & 7;
    const bool b2 = cc & 4, b1 = cc & 2, b0 = cc & 1;
    const int nw = gridDim.x * 8, gw = blockIdx.x * 8 + wv, tpw = (MTOK + nw - 1) / nw, tbase = gw * tpw;
    int cnt = MTOK - tbase; cnt = cnt > tpw ? tpw : cnt;
    if (cnt <= 0) return;
    for (int i = lane; i < cnt * 128; i += 64) HL[i] = 0;
    asm volatile("s_waitcnt lgkmcnt(0)" ::: "memory");
    const int nit = 16 * cnt;
    const unsigned char* ub = U + cc * 16;
    u32x4 m0a, m0b, m0c, m0d, m0x, m1a, m1b, m1c, m1d, m1x, m2a, m2b, m2c, m2d, m2x; u32x4 sA[8], sB[8];
#define PU_LOAD(sl_, k_, A_, B_, C_, D_, X_) { const int* ep_ = EID + (size_t)(tbase + (k_)) * 128 + es * 16; A_ = *(const u32x4*)ep_; B_ = *(const u32x4*)(ep_ + 4); C_ = *(const u32x4*)(ep_ + 8); D_ = *(const u32x4*)(ep_ + 12); \
        X_ = *(const u32x4*)(XQ + (size_t)(tbase + (k_)) * DM + (sl_) * 128 + cc * 16); }
#define PU_NEXT(sl_, k_, sn_, kn_) { kn_ = (k_) + 1; sn_ = (sl_); if (kn_ == cnt) { kn_ = 0; ++sn_; } if (sn_ == 16) { sn_ = 15; kn_ = cnt - 1; } }
    int sl = 0, k = 0, sl1, k1, sl2, k2;
    PU_NEXT(sl, k, sl1, k1) PU_NEXT(sl1, k1, sl2, k2)
    PU_LOAD(sl, k, m0a, m0b, m0c, m0d, m0x)
    PU_LOAD(sl1, k1, m1a, m1b, m1c, m1d, m1x)
    peer_issue8(sA, ub + sl * 128, m0a, m0b);
    for (int it = 0; it < nit; ++it) {
        PU_LOAD(sl2, k2, m2a, m2b, m2c, m2d, m2x)
        peer_issue8(sB, ub + sl * 128, m0c, m0d);
        int dlo[8]; peer_dot8(dlo, sA, m0x);
        peer_issue8(sA, ub + sl1 * 128, m1a, m1b);
        int dhi[8]; peer_dot8(dhi, sB, m0x);
        int t8[8], t4[4], t2[2];
#pragma unroll
        for (int q = 0; q < 8; ++q) { const int keep = b2 ? dhi[q] : dlo[q], send = b2 ? dlo[q] : dhi[q]; t8[q] = keep + __shfl_xor(send, 4); }
#pragma unroll
        for (int q = 0; q < 4; ++q) { const int keep = b1 ? t8[4 + q] : t8[q], send = b1 ? t8[q] : t8[4 + q]; t4[q] = keep + __shfl_xor(send, 2); }
#pragma unroll
        for (int q = 0; q < 2; ++q) { const int keep = b0 ? t4[2 + q] : t4[q], send = b0 ? t4[q] : t4[2 + q]; t2[q] = keep + __shfl_xor(send, 1); }
        { LAS int* hp = HL + k * 128 + es * 16 + (b2 ? 8 : 0) + (b1 ? 4 : 0) + (b0 ? 2 : 0);
          __hip_atomic_fetch_add(hp, t2[0], __ATOMIC_RELAXED, __HIP_MEMORY_SCOPE_WORKGROUP); __hip_atomic_fetch_add(hp + 1, t2[1], __ATOMIC_RELAXED, __HIP_MEMORY_SCOPE_WORKGROUP); }
        sl = sl1; k = k1; sl1 = sl2; k1 = k2; PU_NEXT(sl1, k1, sl2, k2)
        m0a = m1a; m0b = m1b; m0c = m1c; m0d = m1d; m0x = m1x; m1a = m2a; m1b = m2b; m1c = m2c; m1d = m2d; m1x = m2x;
    }
#undef PU_LOAD
#undef PU_NEXT
}
__device__ __forceinline__ void phase_peer_w(const LAS int* HL, const float* XS, const int* EID, const float* GATE, const float* USC, const float* VSC, signed char* WQ, float* SW) {
    const int lane = threadIdx.x & 63, gw = blockIdx.x * 8 + (threadIdx.x >> 6), nw = gridDim.x * 8, tpw = (MTOK + nw - 1) / nw, tbase = gw * tpw;
    const int tend = tbase + tpw < MTOK ? tbase + tpw : MTOK;
    for (int tok = tbase; tok < tend; ++tok) {
        const int h0 = HL[(tok - tbase) * 128 + lane], h1 = HL[(tok - tbase) * 128 + 64 + lane];
        const int e0 = EID[(size_t)tok * 128 + lane], e1 = EID[(size_t)tok * 128 + 64 + lane];
        const float xs = XS[tok];
        const float w0 = GATE[(size_t)tok * 128 + lane] * gelu_erf((float)h0 * xs * USC[e0]) * VSC[e0];
        const float w1 = GATE[(size_t)tok * 128 + 64 + lane] * gelu_erf((float)h1 * xs * USC[e1]) * VSC[e1];
        const float am = fmaxf(wave_max(fmaxf(fabsf(w0), fabsf(w1))), 1e-30f), inv = 127.0f / am;
        WQ[(size_t)tok * 128 + lane] = (signed char)(int)rintf(w0 * inv); WQ[(size_t)tok * 128 + 64 + lane] = (signed char)(int)rintf(w1 * inv);
        if (lane == 0) SW[tok] = am * (1.0f / 127.0f);
    }
}
__device__ __forceinline__ void peer_dot4x4(int (&acc)[16], const u32x4 sa, const u32x4 sb, const u32x4 sc, const u32x4 sd, const unsigned w4) {
#pragma unroll
    for (int k = 0; k < 4; ++k) {
        const unsigned A = sa[k], B = sb[k], C = sc[k], D = sd[k];
        const unsigned p0 = __builtin_amdgcn_perm(B, A, 0x05010400u);
        const unsigned p1 = __builtin_amdgcn_perm(B, A, 0x07030602u);
        const unsigned p2 = __builtin_amdgcn_perm(D, C, 0x05010400u);
        const unsigned p3 = __builtin_amdgcn_perm(D, C, 0x07030602u);
        const unsigned t0 = __builtin_amdgcn_perm(p2, p0, 0x05040100u);
        const unsigned t1 = __builtin_amdgcn_perm(p2, p0, 0x07060302u);
        const unsigned t2 = __builtin_amdgcn_perm(p3, p1, 0x05040100u);
        const unsigned t3 = __builtin_amdgcn_perm(p3, p1, 0x07060302u);
        acc[4 * k + 0] = __builtin_amdgcn_sdot4((int)t0, (int)w4, acc[4 * k + 0], false);
        acc[4 * k + 1] = __builtin_amdgcn_sdot4((int)t1, (int)w4, acc[4 * k + 1], false);
        acc[4 * k + 2] = __builtin_amdgcn_sdot4((int)t2, (int)w4, acc[4 * k + 2], false);
        acc[4 * k + 3] = __builtin_amdgcn_sdot4((int)t3, (int)w4, acc[4 * k + 3], false);
    }
}
__device__ __forceinline__ void phase_peer_v(const bf16_t* X, const int* EID, const signed char* WQ, const float* SW, const unsigned char* V, float* Y) {
    const int lane = threadIdx.x & 63, wv = threadIdx.x >> 6, es = lane >> 3, cc = lane & 7;
    const bool b5 = lane & 32, b4 = lane & 16, b3 = lane & 8;
    const int nw = gridDim.x * 8, gw = blockIdx.x * 8 + wv, tpw = (MTOK + nw - 1) / nw, tbase = gw * tpw;
    int cnt = MTOK - tbase; cnt = cnt > tpw ? tpw : cnt;
    if (cnt <= 0) return;
    const int nit = 16 * cnt;
    const unsigned char* vb = V + cc * 16;
    const int colo = cc * 16 + (b5 ? 8 : 0) + (b4 ? 4 : 0) + (b3 ? 2 : 0);
    u32x4 m0c, m0d, m1a, m1b, m1c, m1d, m2a, m2b, m2c, m2d; u32x4 w0, w1; unsigned x0, x1; float c0, c1; u32x4 sA[8], sB[8];
#define PV_IDS(k_, A_, B_, C_, D_) { const size_t o_ = (size_t)(tbase + (k_)) * 128 + es * 16; A_ = *(const u32x4*)(EID + o_); B_ = *(const u32x4*)(EID + o_ + 4); C_ = *(const u32x4*)(EID + o_ + 8); D_ = *(const u32x4*)(EID + o_ + 12); }
#define PV_WX(sl_, k_, W_, X_, CS_) { W_ = *(const u32x4*)(WQ + (size_t)(tbase + (k_)) * 128 + es * 16); \
        X_ = *(const unsigned*)(X + (size_t)(tbase + (k_)) * DM + (sl_) * 128 + colo); CS_ = SW[tbase + (k_)]; }
#define PV_NEXT(sl_, k_, sn_, kn_) { kn_ = (k_) + 1; sn_ = (sl_); if (kn_ == cnt) { kn_ = 0; ++sn_; } if (sn_ == 16) { sn_ = 15; kn_ = cnt - 1; } }
    int sl = 0, k = 0, sl1, k1, sl2, k2;
    PV_NEXT(sl, k, sl1, k1) PV_NEXT(sl1, k1, sl2, k2)
    { u32x4 ta, tb; PV_IDS(k, ta, tb, m0c, m0d) PV_IDS(k1, m1a, m1b, m1c, m1d)
      PV_WX(sl, k, w0, x0, c0)
      peer_issue8(sA, vb + sl * 128, ta, tb); }
    for (int it = 0; it < nit; ++it) {
        PV_IDS(k2, m2a, m2b, m2c, m2d)
        peer_issue8(sB, vb + sl * 128, m0c, m0d);
        int ya[16];
#pragma unroll
        for (int j = 0; j < 16; ++j) ya[j] = 0;
        peer_dot4x4(ya, sA[0], sA[1], sA[2], sA[3], w0.x); peer_dot4x4(ya, sA[4], sA[5], sA[6], sA[7], w0.y);
        peer_issue8(sA, vb + sl1 * 128, m1a, m1b);
        PV_WX(sl1, k1, w1, x1, c1)
        peer_dot4x4(ya, sB[0], sB[1], sB[2], sB[3], w0.z); peer_dot4x4(ya, sB[4], sB[5], sB[6], sB[7], w0.w);
        int t8[8], t4[4], t2[2];
#pragma unroll
        for (int q = 0; q < 8; ++q) { const int keep = b5 ? ya[8 + q] : ya[q], send = b5 ? ya[q] : ya[8 + q]; t8[q] = keep + __shfl_xor(send, 32); }
#pragma unroll
        for (int q = 0; q < 4; ++q) { const int keep = b4 ? t8[4 + q] : t8[q], send = b4 ? t8[q] : t8[4 + q]; t4[q] = keep + __shfl_xor(send, 16); }
#pragma unroll
        for (int q = 0; q < 2; ++q) { const int keep = b3 ? t4[2 + q] : t4[q], send = b3 ? t4[q] : t4[2 + q]; t2[q] = keep + __shfl_xor(send, 8); }
        f32x2_t o; o[0] = (float)t2[0] * c0 + ALPHA * bflo(x0); o[1] = (float)t2[1] * c0 + ALPHA * bfhi(x0);
        *(f32x2_t*)(Y + (size_t)(tbase + k) * DM + sl * 128 + colo) = o;
        sl = sl1; k = k1; sl1 = sl2; k1 = k2; PV_NEXT(sl1, k1, sl2, k2)
        m0c = m1c; m0d = m1d; m1a = m2a; m1b = m2b; m1c = m2c; m1d = m2d;
        w0 = w1; x0 = x1; c0 = c1;
    }
#undef PV_IDS
#undef PV_WX
#undef PV_NEXT
}

__device__ __forceinline__ void rot8(const u32x4 lo, const u32x4 hi, const f32x4 c0, const f32x4 c1, const f32x4 s0, const f32x4 s1, float (&o1)[8], float (&o2)[8]) {
    const float a[8] = {bflo(lo.x), bfhi(lo.x), bflo(lo.y), bfhi(lo.y), bflo(lo.z), bfhi(lo.z), bflo(lo.w), bfhi(lo.w)};
    const float b[8] = {bflo(hi.x), bfhi(hi.x), bflo(hi.y), bfhi(hi.y), bflo(hi.z), bfhi(hi.z), bflo(hi.w), bfhi(hi.w)};
    const float c[8] = {c0[0], c0[1], c0[2], c0[3], c1[0], c1[1], c1[2], c1[3]}, sn[8] = {s0[0], s0[1], s0[2], s0[3], s1[0], s1[1], s1[2], s1[3]};
#pragma unroll
    for (int j = 0; j < 8; ++j) { o1[j] = a[j] * c[j] - b[j] * sn[j]; o2[j] = a[j] * sn[j] + b[j] * c[j]; }
}
__device__ __forceinline__ u32x4 pack8(const float (&o)[8]) { u32x4 w; w.x = pk_bf16(o[0], o[1]); w.y = pk_bf16(o[2], o[3]); w.z = pk_bf16(o[4], o[5]); w.w = pk_bf16(o[6], o[7]); return w; }
__device__ __forceinline__ void phase_kstat(LAS float* red, const bf16_t* KR, float* KMEAN, float* KNMAX) {
    const int tid = threadIdx.x, ch = tid & 7, rr = tid >> 3, wv = tid >> 6, lane = tid & 63;
    for (int item = blockIdx.x; item < 2 * NHEAD * 32; item += gridDim.x) {
        const int bh = item >> 5, j = item & 31, b = bh >> 4, h = bh & 15;
        float sm1[8], sm2[8]; float nmax = 0.f;
#pragma unroll
        for (int q = 0; q < 8; ++q) { sm1[q] = 0.f; sm2[q] = 0.f; }
        u32x4 lo[4], hi[4];
#pragma unroll
        for (int ps = 0; ps < 4; ++ps) { const size_t off = ((size_t)b * SEQ + j * 256 + ps * 64 + rr) * DM + h * 128 + ch * 8; lo[ps] = *(const u32x4*)(KR + off); hi[ps] = *(const u32x4*)(KR + off + 64); }
#pragma unroll
        for (int ps = 0; ps < 4; ++ps) {
            const float a[8] = {bflo(lo[ps].x), bfhi(lo[ps].x), bflo(lo[ps].y), bfhi(lo[ps].y), bflo(lo[ps].z), bfhi(lo[ps].z), bflo(lo[ps].w), bfhi(lo[ps].w)};
            const float c[8] = {bflo(hi[ps].x), bfhi(hi[ps].x), bflo(hi[ps].y), bfhi(hi[ps].y), bflo(hi[ps].z), bfhi(hi[ps].z), bflo(hi[ps].w), bfhi(hi[ps].w)};
            float nq = 0.f;
#pragma unroll
            for (int q = 0; q < 8; ++q) { sm1[q] += a[q]; sm2[q] += c[q]; nq += a[q] * a[q] + c[q] * c[q]; }
            nq += __shfl_xor(nq, 1); nq += __shfl_xor(nq, 2); nq += __shfl_xor(nq, 4);
            nmax = fmaxf(nmax, nq);
        }
#pragma unroll
        for (int q = 0; q < 8; ++q) {
            sm1[q] += __shfl_xor(sm1[q], 8); sm1[q] += __shfl_xor(sm1[q], 16); sm1[q] += __shfl_xor(sm1[q], 32);
            sm2[q] += __shfl_xor(sm2[q], 8); sm2[q] += __shfl_xor(sm2[q], 16); sm2[q] += __shfl_xor(sm2[q], 32);
        }
        nmax = wave_max(nmax);
        if (lane < 8) {
#pragma unroll
            for (int q = 0; q < 8; ++q) { red[wv * 128 + lane * 8 + q] = sm1[q]; red[wv * 128 + 64 + lane * 8 + q] = sm2[q]; }
        }
        if (lane == 0) red[1024 + wv] = nmax;
        __syncthreads();
        if (tid < 128) {
            float s2 = 0.f;
#pragma unroll
            for (int r = 0; r < 8; ++r) s2 += red[r * 128 + tid];
            KMEAN[(size_t)item * 128 + tid] = s2 * (1.0f / 256.0f);
        }
        if (tid == 0) {
            float m = 0.f;
#pragma unroll
            for (int r = 0; r < 8; ++r) m = fmaxf(m, red[1024 + r]);
            KNMAX[item] = sqrtf(m);
        }
        __syncthreads();
    }
}

__device__ __forceinline__ void top3_insert(float x, int m, float& v0, int& i0, float& v1, int& i1, float& v2, int& i2) {
    const bool c0 = x > v0 || (x == v0 && m < i0), c1 = x > v1 || (x == v1 && m < i1), c2 = x > v2 || (x == v2 && m < i2);
    v2 = c1 ? v1 : (c2 ? x : v2); i2 = c1 ? i1 : (c2 ? m : i2);
    v1 = c0 ? v0 : (c1 ? x : v1); i1 = c0 ? i0 : (c1 ? m : i1);
    v0 = c0 ? x : v0; i0 = c0 ? m : i0;
}
__device__ __forceinline__ void phase_sel(LAS unsigned char* lds, const bf16_t* QR, const float* KMEAN, unsigned short* SUB, int* CNT, int* ctr) {
    const int tid = threadIdx.x, lane = tid & 63, wv = tid >> 6, r32 = lane & 31, hh = lane >> 5;
    LAS unsigned short* bucket = (LAS unsigned short*)lds;
    LAS int* cnt = (LAS int*)(lds + 16384);
    const float NEG = -1e30f;
    if (blockIdx.x == 0 && tid == 0) *ctr = 0;
    for (int item = blockIdx.x; item < 2 * NHEAD * 32; item += gridDim.x) {
        const int bh = item >> 5, i = item & 31, b = bh >> 4, h = bh & 15;
        if (i == 0) continue;
        if (tid < 32) cnt[tid] = 0;
        __syncthreads();
        const float* kmp = KMEAN + ((size_t)bh * 32 + r32) * 128 + 8 * hh;
        const size_t tok = (size_t)b * SEQ + i * 256 + wv * 32 + r32;
        const bf16_t* qp = QR + tok * DM + h * 128 + 8 * hh;
        f32x16 S;
#pragma unroll
        for (int e = 0; e < 16; ++e) S[e] = 0.f;
#pragma unroll
        for (int s2 = 0; s2 < 8; ++s2) {
            const f32x4 ka = *(const f32x4*)(kmp + 16 * s2), kb = *(const f32x4*)(kmp + 16 * s2 + 4);
            const bf16x8 qf = *(const bf16x8*)(qp + 16 * s2);
            u32x4 hi, lo;
            hi.x = pk_bf16(ka[0], ka[1]); hi.y = pk_bf16(ka[2], ka[3]); hi.z = pk_bf16(kb[0], kb[1]); hi.w = pk_bf16(kb[2], kb[3]);
            lo.x = pk_bf16(ka[0] - bflo(hi.x), ka[1] - bfhi(hi.x)); lo.y = pk_bf16(ka[2] - bflo(hi.y), ka[3] - bfhi(hi.y));
            lo.z = pk_bf16(kb[0] - bflo(hi.z), kb[1] - bfhi(hi.z)); lo.w = pk_bf16(kb[2] - bflo(hi.w), kb[3] - bfhi(hi.w));
            S = __builtin_amdgcn_mfma_f32_32x32x16_bf16(__builtin_bit_cast(bf16x8, hi), qf, S, 0, 0, 0);
            S = __builtin_amdgcn_mfma_f32_32x32x16_bf16(__builtin_bit_cast(bf16x8, lo), qf, S, 0, 0, 0);
        }
        float v0 = -3e38f, v1 = -3e38f, v2 = -3e38f; int i0 = 99, i1 = 99, i2 = 99;
#pragma unroll
        for (int e = 0; e < 16; ++e) {
            const int m = (e & 3) + 8 * (e >> 2) + 4 * hh;
            const float x = m < i ? S[e] : NEG;
            top3_insert(x, m, v0, i0, v1, i1, v2, i2);
        }
        {
            const float pv0 = __shfl_xor(v0, 32), pv1 = __shfl_xor(v1, 32), pv2 = __shfl_xor(v2, 32);
            const int pi0 = __shfl_xor(i0, 32), pi1 = __shfl_xor(i1, 32), pi2 = __shfl_xor(i2, 32);
            top3_insert(pv0, pi0, v0, i0, v1, i1, v2, i2); top3_insert(pv1, pi1, v0, i0, v1, i1, v2, i2); top3_insert(pv2, pi2, v0, i0, v1, i1, v2, i2);
        }
        if (hh == 0) {
            const int tl = wv * 32 + r32;
            if (v0 > 0.5f * NEG) { const int p = __hip_atomic_fetch_add(cnt + i0, 1, __ATOMIC_RELAXED, __HIP_MEMORY_SCOPE_WORKGROUP); bucket[i0 * 256 + p] = (unsigned short)(tl | (0 << 8)); }
            if (v1 > 0.5f * NEG) { const int p = __hip_atomic_fetch_add(cnt + i1, 1, __ATOMIC_RELAXED, __HIP_MEMORY_SCOPE_WORKGROUP); bucket[i1 * 256 + p] = (unsigned short)(tl | (1 << 8)); }
            if (v2 > 0.5f * NEG) { const int p = __hip_atomic_fetch_add(cnt + i2, 1, __ATOMIC_RELAXED, __HIP_MEMORY_SCOPE_WORKGROUP); bucket[i2 * 256 + p] = (unsigned short)(tl | (2 << 8)); }
        }
        __syncthreads();
        for (int idx = tid; idx < 32 * 256; idx += 512) {
            const int j = idx >> 8, p = idx & 255;
            if (j < i && p < cnt[j]) SUB[(((size_t)bh * 32 + j) * 32 + i) * 256 + p] = bucket[idx];
        }
        if (tid < i) CNT[((size_t)bh * 32 + tid) * 32 + i] = cnt[tid];
        __syncthreads();
    }
}

__device__ __forceinline__ unsigned off_b(unsigned row, unsigned ch) { return 256u * row + 16u * (ch ^ (((row & 3u) << 2) | ((row >> 2) & 3u))); }
__device__ __forceinline__ unsigned pi32(unsigned m) { return (m & ~12u) | ((m & 4u) << 1) | ((m & 8u) >> 1); }
__device__ __forceinline__ bf16x8 tr_frag(LAS unsigned char* img, unsigned lane, unsigned c, unsigned ks) {
    const unsigned hh = lane >> 5, blk = (lane >> 4) & 1, q = (lane & 15) >> 2, p = lane & 3;
    const unsigned a0 = off_b(16 * ks + 8 * hh + q, 4 * c + 2 * blk + (p >> 1)) + 8 * (p & 1);
    const unsigned a1 = off_b(16 * ks + 8 * hh + 4 + q, 4 * c + 2 * blk + (p >> 1)) + 8 * (p & 1);
    const s16x4 lo = __builtin_amdgcn_ds_read_tr16_b64_v4i16((LAS s16x4*)(img + a0));
    const s16x4 hi = __builtin_amdgcn_ds_read_tr16_b64_v4i16((LAS s16x4*)(img + a1));
    bf16x8 r; r[0] = lo[0]; r[1] = lo[1]; r[2] = lo[2]; r[3] = lo[3]; r[4] = hi[0]; r[5] = hi[1]; r[6] = hi[2]; r[7] = hi[3];
    return r;
}
__device__ __forceinline__ void phase_att(LAS unsigned char* lds, const bf16_t* QR, const bf16_t* KR, const bf16_t* V, const float* KNMAX, const unsigned short* SUB, const int* CNT, int* ctr,
                                          bf16_t* P012, bf16_t* P3, float* LS) {
    const int tid = threadIdx.x, lane = tid & 63, wv = tid >> 6, r32 = lane & 31, hh = lane >> 5;
    LAS unsigned char* Kimg = lds;
    LAS unsigned char* Vimg = lds + 65536;
    LAS int* misc = (LAS int*)(lds + 131072);
    const float SCL2 = 0.08838834764831845f * 1.4426950408889634f;
    for (;;) {
        __syncthreads();
        if (tid == 0) misc[40] = __hip_atomic_fetch_add(ctr, 1, __ATOMIC_RELAXED, __HIP_MEMORY_SCOPE_AGENT);
        __syncthreads();
        const int item = misc[40];
        if (item >= 2 * NHEAD * 32) break;
        const int j = item >> 5, bh = item & 31, b = bh >> 4, h = bh & 15;
#pragma unroll
        for (int r = 0; r < 8; ++r) {
            const int idx = tid + 512 * r, row = idx >> 4, ch = idx & 15;
            const size_t g = ((size_t)b * SEQ + j * 256 + row) * DM + h * 128 + ch * 8;
            const u32x4 kv = *(const u32x4*)(KR + g), vv = *(const u32x4*)(V + g);
            *(LAS u32x4*)(Kimg + off_b(row, ch)) = kv; *(LAS u32x4*)(Vimg + off_b(row, ch)) = vv;
        }
        if (tid <= 32) { int pre = 0; for (int u = j + 1; u < tid; ++u) pre += CNT[((size_t)bh * 32 + j) * 32 + u]; misc[tid] = pre; }
        float kn = (lane < 32) ? KNMAX[bh * 32 + lane] : 0.f;
        kn = wave_max(kn);
        __syncthreads();
        const int total = misc[32], ntile = (256 + total + 31) >> 5;
        for (int tile = wv; tile < ntile; tile += 8) {
            const int gr = tile * 32 + r32;
            int pos, slot; bool valid = true;
            if (gr < 256) { pos = j * 256 + gr; slot = 3; }
            else {
                const int x = gr - 256; valid = x < total;
                int ii = j + 1;
                for (int u = j + 1; u < 32; ++u) if (misc[u] <= x) ii = u;
                if (valid) { const unsigned e = SUB[(((size_t)bh * 32 + j) * 32 + ii) * 256 + (x - misc[ii])]; pos = ii * 256 + (int)(e & 255u); slot = (int)(e >> 8); }
                else { pos = j * 256; slot = 3; }
            }
            const size_t tok = (size_t)b * SEQ + pos;
            bf16x8 qf[8];
            const bf16_t* qp = QR + tok * DM + h * 128 + 8 * hh;
#pragma unroll
            for (int s = 0; s < 8; ++s) qf[s] = *(const bf16x8*)(qp + 16 * s);
            float qn2 = 0.f;
#pragma unroll
            for (int s = 0; s < 8; ++s)
#pragma unroll
                for (int e = 0; e < 8; ++e) { const float f = bf2f((bf16_t)qf[s][e]); qn2 += f * f; }
            qn2 += __shfl_xor(qn2, 32);
            const float c2 = sqrtf(qn2) * kn * SCL2;
            f32x16 O[4];
#pragma unroll
            for (int dt = 0; dt < 4; ++dt)
#pragma unroll
                for (int e = 0; e < 16; ++e) O[dt][e] = 0.f;
            float l = 0.f;
            const bool own = tile < 8;
            const int kcn = own ? tile + 1 : 8;
            const unsigned krow = pi32((unsigned)r32);
            for (int kc = 0; kc < kcn; ++kc) {
                f32x16 S, S1;
#pragma unroll
                for (int e = 0; e < 16; ++e) { S[e] = 0.f; S1[e] = 0.f; }
#pragma unroll
                for (int s = 0; s < 8; s += 2) {
                    const bf16x8 kf = *(const LAS bf16x8*)(Kimg + off_b(32 * kc + krow, 2 * s + hh));
                    const bf16x8 kf1 = *(const LAS bf16x8*)(Kimg + off_b(32 * kc + krow, 2 * s + 2 + hh));
                    S = __builtin_amdgcn_mfma_f32_32x32x16_bf16(kf, qf[s], S, 0, 0, 0);
                    S1 = __builtin_amdgcn_mfma_f32_32x32x16_bf16(kf1, qf[s + 1], S1, 0, 0, 0);
                }
                float p[16];
                if (own) {
#pragma unroll
                    for (int e = 0; e < 16; ++e) {
                        const unsigned m = (e & 3) + 8 * (e >> 2) + 4 * hh;
                        const int key = j * 256 + 32 * kc + (int)pi32(m);
                        float pe = __builtin_amdgcn_exp2f((S[e] + S1[e]) * SCL2 - c2);
                        if (key > pos) pe = 0.f;
                        p[e] = pe; l += pe;
                    }
                } else {
#pragma unroll
                    for (int e = 0; e < 16; ++e) { const float pe = __builtin_amdgcn_exp2f((S[e] + S1[e]) * SCL2 - c2); p[e] = pe; l += pe; }
                }
                u32x4 w0, w1;
                w0.x = pk_bf16(p[0], p[1]); w0.y = pk_bf16(p[2], p[3]); w0.z = pk_bf16(p[4], p[5]); w0.w = pk_bf16(p[6], p[7]);
                w1.x = pk_bf16(p[8], p[9]); w1.y = pk_bf16(p[10], p[11]); w1.z = pk_bf16(p[12], p[13]); w1.w = pk_bf16(p[14], p[15]);
                const bf16x8 pf0 = __builtin_bit_cast(bf16x8, w0), pf1 = __builtin_bit_cast(bf16x8, w1);
#pragma unroll
                for (int dt = 0; dt < 4; ++dt) {
                    const bf16x8 v0 = tr_frag(Vimg, lane, dt, 2 * kc), v1 = tr_frag(Vimg, lane, dt, 2 * kc + 1);
                    O[dt] = __builtin_amdgcn_mfma_f32_32x32x16_bf16(v0, pf0, O[dt], 0, 0, 0);
                    O[dt] = __builtin_amdgcn_mfma_f32_32x32x16_bf16(v1, pf1, O[dt], 0, 0, 0);
                }
            }
            l += __shfl_xor(l, 32);
            if (valid) {
                bf16_t* pl = (slot < 3 ? P012 + (size_t)slot * ((size_t)32 << 20) : P3) + (tok * NHEAD + h) * 128 + 4 * hh;
#pragma unroll
                for (int dt = 0; dt < 4; ++dt)
#pragma unroll
                    for (int g = 0; g < 4; ++g) {
                        u32x2 w; w.x = pk_bf16(O[dt][4 * g], O[dt][4 * g + 1]); w.y = pk_bf16(O[dt][4 * g + 2], O[dt][4 * g + 3]);
                        *(u32x2*)(pl + 32 * dt + 8 * g) = w;
                    }
                if (hh == 0) LS[(size_t)slot * MTOK * NHEAD + tok * NHEAD + h] = l;
            }
        }
    }
}
__device__ __forceinline__ void phase_comb(const bf16_t* P012, const bf16_t* P3, const float* LS, bf16_t* AO) {
    const size_t n = (size_t)MTOK * NHEAD * 16, stride = (size_t)gridDim.x * 512;
    for (size_t idx = (size_t)blockIdx.x * 512 + threadIdx.x; idx < n; idx += stride) {
        const size_t th = idx >> 4; const int ch = (int)(idx & 15);
        const int t = (int)((th >> 4) & (SEQ - 1)), blk = t >> 8, nsel = blk < 3 ? blk : 3;
        float acc[8];
        float l = LS[(size_t)3 * MTOK * NHEAD + th];
        { const u32x4 w = *(const u32x4*)(P3 + th * 128 + ch * 8);
          acc[0] = bflo(w.x); acc[1] = bfhi(w.x); acc[2] = bflo(w.y); acc[3] = bfhi(w.y); acc[4] = bflo(w.z); acc[5] = bfhi(w.z); acc[6] = bflo(w.w); acc[7] = bfhi(w.w); }
#pragma unroll
        for (int s = 0; s < 3; ++s) {
            u32x4 w = *(const u32x4*)(P012 + (size_t)s * ((size_t)32 << 20) + th * 128 + ch * 8);
            float ls = LS[(size_t)s * MTOK * NHEAD + th];
            if (s >= nsel) { w = (u32x4){0u, 0u, 0u, 0u}; ls = 0.f; }
            acc[0] += bflo(w.x); acc[1] += bfhi(w.x); acc[2] += bflo(w.y); acc[3] += bfhi(w.y); acc[4] += bflo(w.z); acc[5] += bfhi(w.z); acc[6] += bflo(w.w); acc[7] += bfhi(w.w);
            l += ls;
        }
        const float rl = 1.0f / l;
        u32x4 o; o.x = pk_bf16(acc[0] * rl, acc[1] * rl); o.y = pk_bf16(acc[2] * rl, acc[3] * rl); o.z = pk_bf16(acc[4] * rl, acc[5] * rl); o.w = pk_bf16(acc[6] * rl, acc[7] * rl);
        *(u32x4*)(AO + th * 128 + ch * 8) = o;
    }
}


__device__ __forceinline__ void qrow_issue(f32x4 (&v)[8], const float* p, int lane) {
#pragma unroll
    for (int i = 0; i < 2; ++i)
#pragma unroll
        for (int q = 0; q < 4; ++q) v[i * 4 + q] = *(const f32x4*)(p + 1024 * i + 16 * lane + 4 * q);
}
__device__ __forceinline__ void qrow_finish(const f32x4 (&v)[8], unsigned char* dst, float* scl, int lane, bool sgn = false) {
    float am = 0.f;
#pragma unroll
    for (int i = 0; i < 8; ++i) am = fmaxf(am, fmaxf(fmaxf(fabsf(v[i][0]), fabsf(v[i][1])), fmaxf(fabsf(v[i][2]), fabsf(v[i][3]))));
    am = fmaxf(wave_max(am), 1e-30f);
    const float inv = 127.0f / am;
    if (lane == 0) *scl = am * (1.0f / 127.0f);
#pragma unroll
    for (int i = 0; i < 2; ++i) {
        u32x4 w;
#pragma unroll
        for (int q = 0; q < 4; ++q) {
            const f32x4 t = v[i * 4 + q];
            const float off = sgn ? 0.0f : 128.0f;
            const unsigned b0 = (unsigned)(int)(rintf(t[0] * inv) + off) & 0xffu, b1 = (unsigned)(int)(rintf(t[1] * inv) + off) & 0xffu, b2 = (unsigned)(int)(rintf(t[2] * inv) + off) & 0xffu, b3 = (unsigned)(int)(rintf(t[3] * inv) + off) & 0xffu;
            w[q] = b0 | (b1 << 8) | (b2 << 16) | (b3 << 24);
        }
        *(u32x4*)(dst + 1024 * i + 16 * lane) = w;
    }
}
struct QuantJob { const float* TU; const float* TV; unsigned char* QU; unsigned char* QV; float* SU; float* SV; };
__device__ __forceinline__ const float* qj_src(const QuantJob& q, int r) { return (r < 16384 ? q.TU : q.TV) + (size_t)(r & 16383) * DM; }
__device__ __forceinline__ unsigned char* qj_dst(const QuantJob& q, int r) { return (r < 16384 ? q.QU : q.QV) + (size_t)(r & 16383) * DM; }
__device__ __forceinline__ float* qj_scl(const QuantJob& q, int r) { return (r < 16384 ? q.SU : q.SV) + (r & 16383); }
__device__ __forceinline__ void qj_tail(const QuantJob& q, int done_iters) {
    const int lane = threadIdx.x & 63, gw = blockIdx.x * 8 + (threadIdx.x >> 6), nw = gridDim.x * 8;
    for (int r = gw + done_iters * nw; r < 32768; r += nw) { f32x4 v[8]; qrow_issue(v, qj_src(q, r), lane); qrow_finish(v, qj_dst(q, r), qj_scl(q, r), lane, r >= 16384); }
}
__device__ __forceinline__ float logf_gate(float z, float lb) { return __logf(lb + (1.0f - lb) * sigmoidf_(z)); }
__device__ __forceinline__ void phase_scan_a(LAS unsigned char* lds, const bf16_t* FZ, const float* LB, const bf16_t* I1, bf16_t* LT, float* DEC, const QuantJob qj, unsigned* dbgc = nullptr) {
    unsigned dbg_kt = 0, dbg_acc = 0;
    const int tid = threadIdx.x, lane = tid & 63, wv = tid >> 6, k = tid & 127, part = tid >> 7;
    LAS unsigned char* Iimg = lds; LAS unsigned char* KTimg = lds + 16384;
    LAS float* psum = (LAS float*)(lds + 32768);
    LAS unsigned char* Lst = lds + 36864;
#if SCAN_A_VALU == 2
    for (int item = blockIdx.x; item < 2 * NHEAD * 128; item += gridDim.x) {
        const int bh = item >> 7, c = item & 127, b = bh >> 4, h = bh & 15;
        const size_t tok0 = (size_t)b * SEQ + c * 64;
        for (int idx = tid; idx < 16384; idx += 512) {
            const int v = idx >> 7, kk = idx & 127;
            float g = 1.f, L = 0.f;
            for (int s2 = 63; s2 >= 0; --s2) { const size_t o = (tok0 + s2) * DM + h * 128; const float f = __expf(logf_gate(bf2f(FZ[o + kk]), LB[h * 128 + kk])); L += bf2f(I1[o + v]) * (1.0f - f) * g; g *= f; }
            LT[(size_t)item * 16384 + idx] = (bf16_t)(pk_bf16(L, 0.f) & 0xffffu);
        }
    }
    return;
#endif
    bf16_t nfz[16]; u32x4 nit_[2];
#define SA_LOAD(item_) { const int bh_ = (item_) >> 7, c_ = (item_) & 127; const size_t t0_ = (size_t)(bh_ >> 4) * SEQ + c_ * 64; const int h_ = bh_ & 15; \
        _Pragma("unroll") for (int i = 0; i < 16; ++i) nfz[i] = FZ[(t0_ + 16 * part + i) * DM + h_ * 128 + k]; \
        _Pragma("unroll") for (int r = 0; r < 2; ++r) { const int idx = tid + 512 * r, row = idx >> 4, ch = idx & 15; nit_[r] = *(const u32x4*)(I1 + (t0_ + row) * DM + h_ * 128 + ch * 8); } }
    if ((int)blockIdx.x < 2 * NHEAD * 128) SA_LOAD((int)blockIdx.x)
    int qiter = 0;
    for (int item = blockIdx.x; item < 2 * NHEAD * 128; item += gridDim.x, ++qiter) {
        const int bh = item >> 7, c = item & 127, b = bh >> 4, h = bh & 15;
        const size_t tok0 = (size_t)b * SEQ + c * 64;
        float lf[16];
        const float lbk = LB[h * 128 + k];
#pragma unroll
        for (int i = 0; i < 16; ++i) lf[i] = logf_gate(bf2f(nfz[i]), lbk);
#pragma unroll
        for (int r = 0; r < 2; ++r) { const int idx = tid + 512 * r, row = idx >> 4, ch = idx & 15; *(LAS u32x4*)(Iimg + off_b(row, ch)) = nit_[r]; }
        if (item + (int)gridDim.x < 2 * NHEAD * 128) SA_LOAD(item + (int)gridDim.x)
        const int qrow = qiter * (int)gridDim.x * 8 + (int)blockIdx.x * 8 + wv; const bool doq = qrow < 32768; f32x4 qv8[8];
        if (doq) qrow_issue(qv8, qj_src(qj, qrow), lane);
        float cs = 0.f;
#pragma unroll
        for (int i = 0; i < 16; ++i) cs += lf[i];
        psum[part * 128 + k] = cs;
        __syncthreads();
        const float p0 = psum[k], p1 = psum[128 + k], p2 = psum[256 + k], p3 = psum[384 + k];
        const float blast = (p0 + p1) + (p2 + p3);
        float bb = part == 0 ? 0.f : (part == 1 ? p0 : (part == 2 ? p0 + p1 : p0 + p1 + p2));
#pragma unroll
        for (int i = 0; i < 16; ++i) {
            bb += lf[i];
            const float kt = (1.0f - __expf(lf[i])) * __expf(blast - bb);
            if (!(kt - kt == 0.f)) ++dbg_kt;
            const int srow = 16 * part + i;
            *(LAS bf16_t*)(KTimg + off_b(srow, k >> 3) + 2 * (k & 7)) = (bf16_t)(pk_bf16(kt, 0.f) & 0xffffu);
        }
        if (part == 0) DEC[(size_t)item * 128 + k] = __expf(blast);
        __syncthreads();
#if SCAN_A_VALU
        for (int idx = tid; idx < 16384; idx += 512) {
            const int v = idx >> 7, kk = idx & 127;
            float accv = 0.f;
            for (int s2 = 0; s2 < 64; ++s2) accv += bf2f(*(const LAS bf16_t*)(Iimg + off_b(s2, v >> 3) + 2 * (v & 7))) * bf2f(*(const LAS bf16_t*)(KTimg + off_b(s2, kk >> 3) + 2 * (kk & 7)));
            *(LAS bf16_t*)(Lst + v * 272 + 2 * kk) = (bf16_t)(pk_bf16(accv, 0.f) & 0xffffu);
        }
        if (0)
#endif
        {
            const int vt = wv >> 1;
            f32x16 acc0, acc1;
#pragma unroll
            for (int e = 0; e < 16; ++e) { acc0[e] = 0.f; acc1[e] = 0.f; }
#pragma unroll
            for (int ks = 0; ks < 4; ++ks) {
                const bf16x8 af = tr_frag(Iimg, lane, vt, ks);
                const bf16x8 b0 = tr_frag(KTimg, lane, 2 * (wv & 1), ks), b1 = tr_frag(KTimg, lane, 2 * (wv & 1) + 1, ks);
                acc0 = __builtin_amdgcn_mfma_f32_32x32x16_bf16(af, b0, acc0, 0, 0, 0);
                acc1 = __builtin_amdgcn_mfma_f32_32x32x16_bf16(af, b1, acc1, 0, 0, 0);
            }
            const int r32 = lane & 31, hh = lane >> 5;
#pragma unroll
            for (int e = 0; e < 16; ++e) {
                if (!(acc0[e] - acc0[e] == 0.f)) ++dbg_acc; if (!(acc1[e] - acc1[e] == 0.f)) ++dbg_acc;
                const int v = 32 * vt + (e & 3) + 8 * (e >> 2) + 4 * hh;
                *(LAS bf16_t*)(Lst + v * 272 + 2 * (64 * (wv & 1) + r32)) = (bf16_t)(pk_bf16(acc0[e], 0.f) & 0xffffu);
                *(LAS bf16_t*)(Lst + v * 272 + 2 * (64 * (wv & 1) + 32 + r32)) = (bf16_t)(pk_bf16(acc1[e], 0.f) & 0xffffu);
            }
        }
        __syncthreads();
#pragma unroll
        for (int r = 0; r < 4; ++r) { const int idx = tid + 512 * r, row = idx >> 4, ch = idx & 15; *(u32x4*)(LT + (size_t)item * 16384 + row * 128 + ch * 8) = *(const LAS u32x4*)(Lst + row * 272 + ch * 16); }
        if (doq) qrow_finish(qv8, qj_dst(qj, qrow), qj_scl(qj, qrow), lane, qrow >= 16384);
        __syncthreads();
    }
    qj_tail(qj, qiter);
    if (dbgc) { if (dbg_kt) atomicAdd(dbgc + 0, dbg_kt); if (dbg_acc) atomicAdd(dbgc + 1, dbg_acc); }
}
__device__ __forceinline__ void phase_scan_b(bf16_t* LT, const float* DEC, const QuantJob qj) {
    const int n = 2 * NHEAD * 128 * 32;
    const int lane = threadIdx.x & 63, gw = blockIdx.x * 8 + (threadIdx.x >> 6), nw = gridDim.x * 8;
    int qdone = 0;
    for (int idx = blockIdx.x * 512 + threadIdx.x; idx < n; idx += gridDim.x * 512) {
        const int bh = idx >> 12, vk = idx & 4095, k4 = (vk & 31) * 4;
        float S0 = 0.f, S1 = 0.f, S2 = 0.f, S3 = 0.f;
        bf16_t* p = LT + (size_t)bh * 128 * 16384 + (size_t)vk * 4;
        const float* dp = DEC + (size_t)bh * 128 * 128 + k4;
        for (int c8 = 0; c8 < 16; ++c8) {
            const int qrow = (qdone + c8) * nw + gw; const bool doq = qrow < 32768; f32x4 qv8[8];
            if (doq) qrow_issue(qv8, qj_src(qj, qrow), lane);
#pragma unroll
            for (int c2 = 0; c2 < 8; ++c2) {
                const int c = c8 * 8 + c2;
                const u32x2 w = *(const u32x2*)(p + (size_t)c * 16384);
                const f32x4 d = *(const f32x4*)(dp + c * 128);
                u32x2 o; o.x = pk_bf16(S0, S1); o.y = pk_bf16(S2, S3);
                *(u32x2*)(p + (size_t)c * 16384) = o;
                S0 = d[0] * S0 + bflo(w.x); S1 = d[1] * S1 + bfhi(w.x); S2 = d[2] * S2 + bflo(w.y); S3 = d[3] * S3 + bfhi(w.y);
            }
            if (doq) qrow_finish(qv8, qj_dst(qj, qrow), qj_scl(qj, qrow), lane, qrow >= 16384);
        }
        qdone += 16;
    }
    qj_tail(qj, qdone);
}
__device__ __forceinline__ void phase_scan_c(LAS unsigned char* lds, const bf16_t* Q1, const bf16_t* FZ, const float* LB, const bf16_t* I1, const bf16_t* G1, const bf16_t* SP, const float* gnorm, bf16_t* OG) {
    const int tid = threadIdx.x, lane = tid & 63, wv = tid >> 6, k = tid & 127, part = tid >> 7, r32 = lane & 31, hh = lane >> 5;
    LAS unsigned char* QTimg = lds; LAS unsigned char* QPimg = lds + 16384; LAS unsigned char* KPimg = lds + 32768; LAS unsigned char* Iimg = lds + 49152; LAS unsigned char* SPimg = lds + 65536;
    LAS float* psum = (LAS float*)(lds + 98304);
    LAS float* ssq = (LAS float*)(lds + 100352);
    LAS unsigned char* OT = lds + 102400;
    bf16_t nfz[16], nq[16]; u32x4 nit_[2], nsp[4], ngt[2];
#define SC_LOAD(item_) { const int bh_ = (item_) >> 7, c_ = (item_) & 127; const size_t t0_ = (size_t)(bh_ >> 4) * SEQ + c_ * 64; const int h_ = bh_ & 15; \
        _Pragma("unroll") for (int i = 0; i < 16; ++i) { const size_t o_ = (t0_ + 16 * part + i) * DM + h_ * 128 + k; nfz[i] = FZ[o_]; nq[i] = Q1[o_]; } \
        _Pragma("unroll") for (int r = 0; r < 2; ++r) { const int idx = tid + 512 * r, row = idx >> 4, ch = idx & 15; nit_[r] = *(const u32x4*)(I1 + (t0_ + row) * DM + h_ * 128 + ch * 8); ngt[r] = *(const u32x4*)(G1 + (t0_ + row) * DM + h_ * 128 + ch * 8); } \
        _Pragma("unroll") for (int r = 0; r < 4; ++r) { const int idx = tid + 512 * r, row = idx >> 4, ch = idx & 15; nsp[r] = *(const u32x4*)(SP + (size_t)(item_) * 16384 + row * 128 + ch * 8); } }
    if ((int)blockIdx.x < 2 * NHEAD * 128) SC_LOAD((int)blockIdx.x)
    for (int item = blockIdx.x; item < 2 * NHEAD * 128; item += gridDim.x) {
        const int bh = item >> 7, c = item & 127, b = bh >> 4, h = bh & 15;
        const size_t tok0 = (size_t)b * SEQ + c * 64;
        float lf[16], qv[16];
        const float lbk = LB[h * 128 + k];
#pragma unroll
        for (int i = 0; i < 16; ++i) { lf[i] = logf_gate(bf2f(nfz[i]), lbk); const float qr = bf2f(nq[i]); qv[i] = qr * sigmoidf_(qr); }
#pragma unroll
        for (int r = 0; r < 2; ++r) { const int idx = tid + 512 * r, row = idx >> 4, ch = idx & 15; *(LAS u32x4*)(Iimg + off_b(row, ch)) = nit_[r]; }
#pragma unroll
        for (int r = 0; r < 4; ++r) { const int idx = tid + 512 * r, row = idx >> 4, ch = idx & 15; *(LAS u32x4*)(SPimg + off_b(row, ch)) = nsp[r]; }
        const u32x4 gcur0 = ngt[0], gcur1 = ngt[1];
        if (item + (int)gridDim.x < 2 * NHEAD * 128) SC_LOAD(item + (int)gridDim.x)
        float cs = 0.f;
#pragma unroll
        for (int i = 0; i < 16; ++i) cs += lf[i];
        psum[part * 128 + k] = cs;
        __syncthreads();
        const float p0 = psum[k], p1 = psum[128 + k], p2 = psum[256 + k];
        const float rr = p0 + p1;
        float bb = part == 0 ? 0.f : (part == 1 ? p0 : (part == 2 ? p0 + p1 : p0 + p1 + p2));
#pragma unroll
        for (int i = 0; i < 16; ++i) {
            bb += lf[i];
            const float qt = qv[i] * __expf(bb), qp = qv[i] * __expf(bb - rr), kp = (1.0f - __expf(lf[i])) * __expf(rr - bb);
            const unsigned o = off_b(16 * part + i, k >> 3) + 2 * (k & 7);
            *(LAS bf16_t*)(QTimg + o) = (bf16_t)(pk_bf16(qt, 0.f) & 0xffffu);
            *(LAS bf16_t*)(QPimg + o) = (bf16_t)(pk_bf16(qp, 0.f) & 0xffffu);
            *(LAS bf16_t*)(KPimg + o) = (bf16_t)(pk_bf16(kp, 0.f) & 0xffffu);
        }
        __syncthreads();
        const int tt = wv & 1, vt = wv >> 1;
        f32x16 O;
#pragma unroll
        for (int e = 0; e < 16; ++e) O[e] = 0.f;
#pragma unroll
        for (int ks = 0; ks < 8; ++ks) {
            const bf16x8 af = *(const LAS bf16x8*)(SPimg + off_b(32 * vt + r32, 2 * ks + hh));
            const bf16x8 bf = *(const LAS bf16x8*)(QTimg + off_b(32 * tt + r32, 2 * ks + hh));
            O = __builtin_amdgcn_mfma_f32_32x32x16_bf16(af, bf, O, 0, 0, 0);
        }
        const unsigned krow = pi32((unsigned)r32);
        for (int st = 0; st <= tt; ++st) {
            f32x16 S;
#pragma unroll
            for (int e = 0; e < 16; ++e) S[e] = 0.f;
#pragma unroll
            for (int ks = 0; ks < 8; ++ks) {
                const bf16x8 af = *(const LAS bf16x8*)(KPimg + off_b(32 * st + krow, 2 * ks + hh));
                const bf16x8 bf = *(const LAS bf16x8*)(QPimg + off_b(32 * tt + r32, 2 * ks + hh));
                S = __builtin_amdgcn_mfma_f32_32x32x16_bf16(af, bf, S, 0, 0, 0);
            }
            float p[16];
#pragma unroll
            for (int e = 0; e < 16; ++e) {
                const unsigned m = (e & 3) + 8 * (e >> 2) + 4 * hh;
                const int sidx = 32 * st + (int)pi32(m), tidx = 32 * tt + r32;
                p[e] = sidx <= tidx ? S[e] : 0.f;
            }
            u32x4 w0, w1;
            w0.x = pk_bf16(p[0], p[1]); w0.y = pk_bf16(p[2], p[3]); w0.z = pk_bf16(p[4], p[5]); w0.w = pk_bf16(p[6], p[7]);
            w1.x = pk_bf16(p[8], p[9]); w1.y = pk_bf16(p[10], p[11]); w1.z = pk_bf16(p[12], p[13]); w1.w = pk_bf16(p[14], p[15]);
            const bf16x8 pf0 = __builtin_bit_cast(bf16x8, w0), pf1 = __builtin_bit_cast(bf16x8, w1);
            const bf16x8 i0 = tr_frag(Iimg, lane, vt, 2 * st), i1 = tr_frag(Iimg, lane, vt, 2 * st + 1);
            O = __builtin_amdgcn_mfma_f32_32x32x16_bf16(i0, pf0, O, 0, 0, 0);
            O = __builtin_amdgcn_mfma_f32_32x32x16_bf16(i1, pf1, O, 0, 0, 0);
        }
        float sq = 0.f;
#pragma unroll
        for (int e = 0; e < 16; ++e) sq += O[e] * O[e];
        sq += __shfl_xor(sq, 32);
        if (hh == 0) ssq[vt * 64 + 32 * tt + r32] = sq;
        __syncthreads();
        const int tl = 32 * tt + r32;
        const float rstd = rsqrtf((ssq[tl] + ssq[64 + tl] + ssq[128 + tl] + ssq[192 + tl]) * (1.0f / 128.0f) + 1e-6f);
#pragma unroll
        for (int g = 0; g < 4; ++g) {
            const int v0 = 32 * vt + 8 * g + 4 * hh;
            const f32x4 gn = *(const f32x4*)(gnorm + v0);
            u32x2 w; w.x = pk_bf16(O[4 * g] * rstd * gn[0], O[4 * g + 1] * rstd * gn[1]); w.y = pk_bf16(O[4 * g + 2] * rstd * gn[2], O[4 * g + 3] * rstd * gn[3]);
            *(LAS u32x2*)(OT + tl * 272 + v0 * 2) = w;
        }
        __syncthreads();
#pragma unroll
        for (int r = 0; r < 2; ++r) {
            const int idx = tid + 512 * r, row = idx >> 4, ch = idx & 15;
            const u32x4 ov = *(const LAS u32x4*)(OT + row * 272 + ch * 16);
            const size_t go = (tok0 + row) * DM + h * 128 + ch * 8;
            const u32x4 gv = r == 0 ? gcur0 : gcur1;
            u32x4 w;
#define SILU_(x_) ((x_) * sigmoidf_(x_))
            w.x = pk_bf16(bflo(ov.x) * SILU_(bflo(gv.x)), bfhi(ov.x) * SILU_(bfhi(gv.x))); w.y = pk_bf16(bflo(ov.y) * SILU_(bflo(gv.y)), bfhi(ov.y) * SILU_(bfhi(gv.y)));
            w.z = pk_bf16(bflo(ov.z) * SILU_(bflo(gv.z)), bfhi(ov.z) * SILU_(bfhi(gv.z))); w.w = pk_bf16(bflo(ov.w) * SILU_(bflo(gv.w)), bfhi(ov.w) * SILU_(bfhi(gv.w)));
#undef SILU_
            *(u32x4*)(OG + go) = w;
        }
        __syncthreads();
    }
}


#if SCAN_DBG == 2
__device__ __forceinline__ void dbg_compare(LAS float* red, const bf16_t* A, const bf16_t* B, float* DBG) {
    float sd = 0.f, sr = 0.f, nn = 0.f;
    const size_t n = (size_t)MTOK * DM;
    for (size_t i = (size_t)blockIdx.x * 512 + threadIdx.x; i < n; i += (size_t)gridDim.x * 512) {
        const float x = bf2f(A[i]), y = bf2f(B[i]);
        if (!(x - x == 0.f)) nn += 1.f; else { sd += (x - y) * (x - y); sr += y * y; }
    }
    sd = wave_sum(sd); sr = wave_sum(sr); nn = wave_sum(nn);
    const int wv = threadIdx.x >> 6;
    if ((threadIdx.x & 63) == 0) { red[wv * 3] = sd; red[wv * 3 + 1] = sr; red[wv * 3 + 2] = nn; }
    __syncthreads();
    if (threadIdx.x == 0) { float a = 0, b = 0, c = 0; for (int w = 0; w < 8; ++w) { a += red[w * 3]; b += red[w * 3 + 1]; c += red[w * 3 + 2]; } DBG[blockIdx.x * 4] = a; DBG[blockIdx.x * 4 + 1] = b; DBG[blockIdx.x * 4 + 2] = c; }
    __syncthreads();
}
__device__ __forceinline__ void dbg_emit(const float* DBG, float* out) {
    float a = 0, b = 0, c = 0;
    for (int w = 0; w < (int)gridDim.x; ++w) { a += DBG[w * 4]; b += DBG[w * 4 + 1]; c += DBG[w * 4 + 2]; }
    const float rel = sqrtf(a / b);
    int k = (int)rintf(-2.0f * log10f(rel)); k = k < 0 ? 0 : (k > 16 ? 16 : k);
    if (c > 0.f) k = 17;
    const float cc = sqrtf(0.5f * (float)k);
    const size_t n = (size_t)MTOK * DM;
    for (size_t i = (size_t)blockIdx.x * 512 + threadIdx.x; i < n; i += (size_t)gridDim.x * 512) out[i] = cc;
}
#endif

#if SCAN_DBG == 3
__device__ __forceinline__ void dbg_count_bf16(const bf16_t* A, size_t n, unsigned* cnt) {
    unsigned c = 0;
    for (size_t i = (size_t)blockIdx.x * 512 + threadIdx.x; i < n; i += (size_t)gridDim.x * 512) { const float x = bf2f(A[i]); if (!(x - x == 0.f)) ++c; }
    if (c) atomicAdd(cnt, c);
}
__device__ __forceinline__ void dbg_count_f32(const float* A, size_t n, unsigned* cnt) {
    unsigned c = 0;
    for (size_t i = (size_t)blockIdx.x * 512 + threadIdx.x; i < n; i += (size_t)gridDim.x * 512) { const float x = A[i]; if (!(x - x == 0.f)) ++c; }
    if (c) atomicAdd(cnt, c);
}
__device__ __forceinline__ void dbg_emit3(const unsigned* cnt, float* out) {
    float code = 0.f;
    for (int st = 3; st >= 0; --st) { const unsigned c = cnt[st]; if (c) { float lg = log10f((float)c); lg = lg > 9.f ? 9.f : lg; code = (float)(st + 1) + 0.1f * lg; } }
    const float cc = sqrtf(code);
    const size_t n = (size_t)MTOK * DM;
    for (size_t i = (size_t)blockIdx.x * 512 + threadIdx.x; i < n; i += (size_t)gridDim.x * 512) out[i] = cc;
}
#endif

#if SCAN_DBG == 4 || SCAN_DBG == 6
__device__ __forceinline__ void dbg_compare4(LAS float* red, const bf16_t* A, const bf16_t* B, const bf16_t* C, float* DBG) {
    float sd = 0.f, sr = 0.f, nn = 0.f, mm = 0.f;
    const size_t n = (size_t)MTOK * DM;
    for (size_t i = (size_t)blockIdx.x * 512 + threadIdx.x; i < n; i += (size_t)gridDim.x * 512) {
        const float x = bf2f(A[i]), y = bf2f(B[i]);
        if (!(x - x == 0.f)) nn += 1.f; else { sd += (x - y) * (x - y); sr += y * y; }
        if (A[i] != C[i]) mm += 1.f;
    }
    sd = wave_sum(sd); sr = wave_sum(sr); nn = wave_sum(nn); mm = wave_sum(mm);
    const int wv = threadIdx.x >> 6;
    if ((threadIdx.x & 63) == 0) { red[wv * 4] = sd; red[wv * 4 + 1] = sr; red[wv * 4 + 2] = nn; red[wv * 4 + 3] = mm; }
    __syncthreads();
    if (threadIdx.x == 0) { float a = 0, b = 0, c = 0, d = 0; for (int w = 0; w < 8; ++w) { a += red[w * 4]; b += red[w * 4 + 1]; c += red[w * 4 + 2]; d += red[w * 4 + 3]; }
        DBG[blockIdx.x * 4] = a; DBG[blockIdx.x * 4 + 1] = b; DBG[blockIdx.x * 4 + 2] = c; DBG[blockIdx.x * 4 + 3] = d; }
    __syncthreads();
}
__device__ __forceinline__ void dbg_emit4(const float* DBG, float* out) {
    float a = 0, b = 0, c = 0, d = 0;
    for (int w = 0; w < (int)gridDim.x; ++w) { a += DBG[w * 4]; b += DBG[w * 4 + 1]; c += DBG[w * 4 + 2]; d += DBG[w * 4 + 3]; }
    const float rel = sqrtf(a / b);
    int k = (int)rintf(-log10f(rel)); k = k < 0 ? 0 : (k > 8 ? 8 : k);
#if SCAN_DBG == 6
    const float cc = sqrtf((float)k + ((d + c) > 0.f ? 0.5f : 0.f));
#else
    int m = (int)ceilf(log10f(1.0f + d + c)); m = m > 9 ? 9 : m;
    const float cc = sqrtf((float)k + 0.1f * (float)m);
#endif
    const size_t n = (size_t)MTOK * DM;
    for (size_t i = (size_t)blockIdx.x * 512 + threadIdx.x; i < n; i += (size_t)gridDim.x * 512) out[i] = cc;
}
#endif

#if SCAN_DBG == 5
__device__ __forceinline__ void dbg_lds16_test(LAS unsigned char* lds, unsigned* cnt) {
    const int tid = threadIdx.x;
    unsigned bad = 0;
    for (int rep = 0; rep < 64; ++rep) {
        for (int i = tid; i < 1024; i += 512) *(LAS u32x4*)(lds + i * 16) = (u32x4){0x7fc07fc0u, 0x7fc07fc0u, 0x7fc07fc0u, 0x7fc07fc0u};
        __syncthreads();
        const int k = tid & 127, part = tid >> 7;
#pragma unroll
        for (int i = 0; i < 16; ++i) {
            const int row = 16 * part + i;
            *(LAS bf16_t*)(lds + off_b(row, k >> 3) + 2 * (k & 7)) = (bf16_t)((row * 128 + k + rep) & 0x7fff);
        }
        __syncthreads();
        for (int idx = tid; idx < 64 * 128; idx += 512) {
            const int row = idx >> 7, kk = idx & 127;
            const bf16_t got = *(const LAS bf16_t*)(lds + off_b(row, kk >> 3) + 2 * (kk & 7));
            if (got != (bf16_t)((row * 128 + kk + rep) & 0x7fff)) ++bad;
        }
        __syncthreads();
    }
    if (bad) atomicAdd(cnt, bad);
}
__device__ __forceinline__ void dbg_emit5(const unsigned* cnt, float* out) {
    const unsigned c = cnt[0];
    float code = 0.f;
    if (c) { float lg = log10f((float)c); code = 1.0f + (lg > 8.9f ? 8.9f : lg); }
    const float cc = sqrtf(code);
    const size_t n = (size_t)MTOK * DM;
    for (size_t i = (size_t)blockIdx.x * 512 + threadIdx.x; i < n; i += (size_t)gridDim.x * 512) out[i] = cc;
}
#endif

#if SCAN_DBG == 6
__device__ __forceinline__ void dbg_check_a(LAS float* red, const float* LF, const bf16_t* I1, const bf16_t* LT, const bf16_t* LT2, float* DBG) {
    float sd = 0.f, sr = 0.f, mm = 0.f;
    const size_t n = (size_t)4096 * 16384;
    for (size_t i = (size_t)blockIdx.x * 512 + threadIdx.x; i < n; i += (size_t)gridDim.x * 512) {
        const int item = (int)(i >> 14), v = (int)((i >> 7) & 127), k = (int)(i & 127);
        const int bh = item >> 7, c = item & 127, b = bh >> 4, h = bh & 15;
        const size_t tok0 = (size_t)b * SEQ + c * 64;
        float g = 1.f, L = 0.f;
        for (int s2 = 63; s2 >= 0; --s2) {
            const size_t o = (tok0 + s2) * DM + h * 128;
            const float f = __expf(LF[o + k]);
            L += bf2f(I1[o + v]) * (1.0f - f) * g;
            g *= f;
        }
        const float x = bf2f(LT[i]);
        sd += (x - L) * (x - L); sr += L * L;
        if (LT[i] != LT2[i]) mm += 1.f;
    }
    sd = wave_sum(sd); sr = wave_sum(sr); mm = wave_sum(mm);
    const int wv = threadIdx.x >> 6;
    if ((threadIdx.x & 63) == 0) { red[wv * 4] = sd; red[wv * 4 + 1] = sr; red[wv * 4 + 2] = 0.f; red[wv * 4 + 3] = mm; }
    __syncthreads();
    if (threadIdx.x == 0) { float a = 0, b2 = 0, d = 0; for (int w = 0; w < 8; ++w) { a += red[w * 4]; b2 += red[w * 4 + 1]; d += red[w * 4 + 3]; }
        DBG[blockIdx.x * 4] = a; DBG[blockIdx.x * 4 + 1] = b2; DBG[blockIdx.x * 4 + 2] = 0.f; DBG[blockIdx.x * 4 + 3] = d; }
    __syncthreads();
}
#endif

#if SCAN_DBG == 7
#ifndef DBG_FAM
#define DBG_FAM 0
#endif
__device__ __forceinline__ void dbg_check_a7(const float* LF, const bf16_t* I1, const bf16_t* LT, float* DBG) {
    const size_t n = (size_t)4096 * 16384;
    float nbad = 0.f, nnf = 0.f;
    for (size_t i = (size_t)blockIdx.x * 512 + threadIdx.x; i < n; i += (size_t)gridDim.x * 512 * 8) {
        const int item = (int)(i >> 14), v = (int)((i >> 7) & 127), k = (int)(i & 127);
        const int bh = item >> 7, c = item & 127, b = bh >> 4, h = bh & 15;
        const size_t tok0 = (size_t)b * SEQ + c * 64;
        float g = 1.f, L = 0.f;
        for (int s2 = 63; s2 >= 0; --s2) {
            const size_t o = (tok0 + s2) * DM + h * 128;
            const float f = __expf(LF[o + k]);
            L += bf2f(I1[o + v]) * (1.0f - f) * g;
            g *= f;
        }
        const float x = bf2f(LT[i]);
        if (!(x - x == 0.f)) { nnf += 1.f; nbad += 1.f; }
        else if (fabsf(x - L) > 0.02f * fabsf(L) + 1e-2f) nbad += 1.f;
    }
    nbad = wave_sum(nbad); nnf = wave_sum(nnf);
    if ((threadIdx.x & 63) == 0) { atomicAdd(DBG, nbad); atomicAdd(DBG + 1, nnf); }
}
__device__ __forceinline__ void dbg_emit7(const float* DBG, float* out) {
    const float nb = DBG[0], nf = DBG[1];
    int A = nb == 0.f ? 0 : (nb <= 100.f ? 1 : (nb <= 1e4f ? 3 : (nb <= 1e6f ? 5 : 7)));
    int B = nf == 0.f ? 0 : 5;
    const float cc = sqrtf((float)A + 0.1f * (float)B);
    const size_t n = (size_t)MTOK * DM;
    for (size_t i = (size_t)blockIdx.x * 512 + threadIdx.x; i < n; i += (size_t)gridDim.x * 512) out[i] = cc;
}
#endif
__device__ __forceinline__ int opaque(int v) { asm volatile("" : "+s"(v)); return v; }
template <bool L1> __device__ __forceinline__ void run_gemm_out(const Args& a, LAS unsigned char* lds) {
    unsigned char* ws = a.ws;
    pg8::Gemm g{(const bf16_t*)(ws + (L1 ? slot(3) : slot(0))), (const bf16_t*)(ws + (L1 ? WS_WO : WS_WOUT)), opaque(MTOK), opaque(DM), opaque(DM)};
    pg8::StaticOrder S; S.init(g.M, g.N, (int)gridDim.x, (int)blockIdx.x);
    EpiKVQ E{(bf16_t*)(ws + (L1 ? slot(4) : slot(1))), nullptr, nullptr};
    pg8::gemm_phase<EpiKVQ, pg8::StaticOrder>(lds, g, S, E, nullptr);
}
template <bool L1> __device__ __forceinline__ void run_ln(const Args& a) {
    unsigned char* ws = a.ws;
    phase_ln<L1>((const bf16_t*)(ws + (L1 ? slot(4) : slot(1))), L1 ? (const void*)(ws + slot(2)) : (const void*)a.in[0], a.in[12] + (L1 ? 2 : 0) * DM, a.in[13] + (L1 ? 2 : 0) * DM,
                 (float*)nullptr, (bf16_t*)(ws + (L1 ? slot(8) : slot(5))), (signed char*)(ws + WS_XQ), (float*)(ws + WS_XS));
}
template <bool L1> __device__ __forceinline__ void run_gemm_sc(const Args& a, LAS unsigned char* lds) {
    unsigned char* ws = a.ws;
    pg8::Gemm g{(const bf16_t*)(ws + WS_WC) + (L1 ? (size_t)DM * DM : 0), (const bf16_t*)(ws + (L1 ? slot(8) : slot(5))), opaque(DM), opaque(MTOK), opaque(DM)};
    pg8::StaticOrder S; S.init(g.M, g.N, (int)gridDim.x, (int)blockIdx.x);
    EpiF32 E{(float*)(ws + (L1 ? slot(0) : slot(6))), MTOK};
    pg8::gemm_phase<EpiF32, pg8::StaticOrder>(lds, g, S, E, nullptr);
}
template <bool L1> __device__ __forceinline__ void run_topk(const Args& a, LAS unsigned char* lds) {
    unsigned char* ws = a.ws;
    phase_topk(lds, (const float*)(ws + (L1 ? slot(0) : slot(6))), (int*)(ws + WS_EID), (float*)(ws + WS_GATE));
}
template <bool L1> __device__ __forceinline__ void run_peer(const Args& a, LAS unsigned char* lds) {
    unsigned char* ws = a.ws;
    LAS int* HL = (LAS int*)(lds + (threadIdx.x >> 6) * 8192);
    float* Y = (float*)(ws + (L1 ? slot(0) : slot(6)));
    phase_peer_u((const signed char*)(ws + WS_XQ), (const int*)(ws + WS_EID), ws + WS_UB + (L1 ? (size_t)16384 * DM : 0), HL);
    asm volatile("s_waitcnt vmcnt(0) lgkmcnt(0)" ::: "memory");
    phase_peer_w(HL, (const float*)(ws + WS_XS), (const int*)(ws + WS_EID), (const float*)(ws + WS_GATE),
                 (const float*)(ws + WS_USC) + (L1 ? 16384 : 0), (const float*)(ws + WS_VSC) + (L1 ? 16384 : 0), (signed char*)(ws + WS_W), (float*)(ws + WS_CS));
    asm volatile("s_waitcnt vmcnt(0)" ::: "memory");
    phase_peer_v((const bf16_t*)(ws + (L1 ? slot(8) : slot(5))), (const int*)(ws + WS_EID), (const signed char*)(ws + WS_W), (const float*)(ws + WS_CS),
                 ws + WS_VB + (L1 ? (size_t)16384 * DM : 0), Y);
    asm volatile("s_waitcnt vmcnt(0)" ::: "memory");
    {
        const int lane = threadIdx.x & 63, gw = blockIdx.x * 8 + (threadIdx.x >> 6), nw = gridDim.x * 8, tpw = (MTOK + nw - 1) / nw, tbase = gw * tpw;
        const int tend = tbase + tpw < MTOK ? tbase + tpw : MTOK;
        const float* g = a.in[12] + (L1 ? 3 : 1) * DM; const float* bta = a.in[13] + (L1 ? 3 : 1) * DM;
        float* outf = L1 ? a.out : (float*)nullptr; bf16_t* outb = L1 ? (bf16_t*)nullptr : (bf16_t*)(ws + slot(2));
        for (int row = tbase; row < tend; ++row) {
            float v[32];
            const float* p = Y + (size_t)row * DM;
#pragma unroll
            for (int i = 0; i < 4; ++i) {
                const f32x4 x0 = *(const f32x4*)(p + 512 * i + 8 * lane), x1 = *(const f32x4*)(p + 512 * i + 8 * lane + 4);
#pragma unroll
                for (int j = 0; j < 4; ++j) { v[i * 8 + j] = x0[j]; v[i * 8 + 4 + j] = x1[j]; }
            }
            ln_row_store(v, g, bta, outf ? outf + (size_t)row * DM : nullptr, outb ? outb + (size_t)row * DM : nullptr, lane,
                         L1 ? (signed char*)nullptr : (signed char*)(ws + slot(1)) + (size_t)row * DM, L1 ? (float*)nullptr : (float*)(ws + WS_XS1) + row);
        }
    }
}


#define XB_TMO      128
#define XB_XCNT(j)  (256  + 64 * (j))
#define XB_XSUB(j)  (1280 + 64 * (j))
#define XB_XGEN(j)  (2304 + 64 * (j))
#define XB_TOP      3328
#define XB_TOPGEN   3392
#define XCD_BAR_WORDS 3456
#define XB_SPIN_CAP (1u << 20)
__device__ __forceinline__ unsigned xb_ld(unsigned* p)              { return __hip_atomic_load(p, __ATOMIC_RELAXED, __HIP_MEMORY_SCOPE_AGENT); }
__device__ __forceinline__ unsigned xb_add(unsigned* p, unsigned v) { return __hip_atomic_fetch_add(p, v, __ATOMIC_RELAXED, __HIP_MEMORY_SCOPE_AGENT); }
__device__ __forceinline__ unsigned xb_xcc_id() { return (unsigned)__builtin_amdgcn_s_getreg((3 << 11) | 20) & 0xFu; }
#define XB_SPIN(cond, bar) do { unsigned _sp = 0; while (cond) { __builtin_amdgcn_s_sleep(1); \
    if ((++_sp & 255u) == 0u) { if (xb_ld(&(bar)[XB_TMO])) break; if (_sp > XB_SPIN_CAP) { atomicAdd(&(bar)[XB_TMO], 1u); break; } } } } while (0)
struct XcdBarrier { unsigned* bar; unsigned x; volatile LAS unsigned* st; };
__device__ __forceinline__ XcdBarrier xcd_barrier_post(unsigned* bar, volatile LAS unsigned* st) {
    XcdBarrier b; b.bar = bar; b.x = xb_xcc_id(); b.st = st;
    if (threadIdx.x == 0) (void)xb_add(&bar[XB_XCNT(b.x)], 1u);
    return b;
}
__device__ __forceinline__ void xcd_barrier_complete(unsigned* bar, unsigned x, unsigned& nloc, unsigned& nx) {
    const unsigned G = gridDim.x * gridDim.y * gridDim.z;
    unsigned sum, cnt, mine, sp = 0u;
    for (;;) {
        sum = 0u; cnt = 0u; mine = 0u;
#pragma unroll
        for (unsigned j = 0; j < 16; ++j) { const unsigned c = xb_ld(&bar[XB_XCNT(j)]); sum += c; cnt += (c > 0u) ? 1u : 0u; mine = (j == x) ? c : mine; }
        if (sum == G) break;
        __builtin_amdgcn_s_sleep(1);
        if ((++sp & 255u) == 0u) { if (xb_ld(&bar[XB_TMO])) break; if (sp > XB_SPIN_CAP) { atomicAdd(&bar[XB_TMO], 1u); break; } }
    }
    nloc = mine > 0u ? mine : 1u; nx = cnt > 0u ? cnt : 1u;
}
__device__ __forceinline__ void xcd_barrier(const XcdBarrier& b) {
    asm volatile("s_waitcnt vmcnt(0)" ::: "memory");
    __syncthreads();
    if (threadIdx.x == 0) {
        unsigned* bar = b.bar;
        __builtin_amdgcn_s_waitcnt(0);
        unsigned nloc = b.st[0], nx = b.st[1];
        if (nloc == 0u) { xcd_barrier_complete(bar, b.x, nloc, nx); b.st[0] = nloc; b.st[1] = nx; }
        const unsigned old = xb_add(&bar[XB_XSUB(b.x)], 1u);
        const unsigned gen = old / nloc;
        if (old + 1u == (gen + 1u) * nloc) {
            __builtin_amdgcn_fence(__ATOMIC_RELEASE, "agent");
            asm volatile("s_waitcnt vmcnt(0)" ::: "memory");
            const unsigned og = xb_add(&bar[XB_TOP], 1u);
            const unsigned tg = og / nx;
            if (og + 1u == (tg + 1u) * nx) xb_add(&bar[XB_TOPGEN], 1u);
            else XB_SPIN(xb_ld(&bar[XB_TOPGEN]) == tg, bar);
            __builtin_amdgcn_fence(__ATOMIC_ACQUIRE, "agent");
            xb_add(&bar[XB_XGEN(b.x)], 1u);
            asm volatile("s_waitcnt vmcnt(0)" ::: "memory");
        } else {
            XB_SPIN(xb_ld(&bar[XB_XGEN(b.x)]) == gen, bar);
            __builtin_amdgcn_fence(__ATOMIC_ACQUIRE, "agent");
            asm volatile("s_waitcnt vmcnt(0)" ::: "memory");
        }
    }
    __syncthreads();
}

__global__ void __launch_bounds__(512, 2) mk_fwd(Args a) {
    extern __shared__ __attribute__((aligned(16))) unsigned char lds_raw[];
    LAS unsigned char* lds = (LAS unsigned char*)lds_raw;
    cg::grid_group grid = cg::this_grid();
    unsigned char* ws = a.ws;
#define PHASE_BEGIN(k) if (a.ph_lo <= (k) && (k) < a.ph_hi && EN(k)) {
    volatile LAS unsigned* xb_st = (volatile LAS unsigned*)(lds + LDS_BYTES - 16);
    if (threadIdx.x < 4) xb_st[threadIdx.x] = 0u;
    unsigned* xb_words = (unsigned*)(ws + WS_BAR);
    __syncthreads();
    XcdBarrier xbar = xcd_barrier_post(xb_words, xb_st);
    if (a.ph_lo < 0) grid.sync();
#define PHASE_END(k) if ((k) + 1 < a.ph_hi) xcd_barrier(xbar); }
    PHASE_BEGIN(0) phase_prep(a, lds);
#if SCAN_DBG == 3 || SCAN_DBG == 5
        if (blockIdx.x == 0 && threadIdx.x < 8) ((unsigned*)(ws + WS_CTR + 8192))[threadIdx.x] = 0u;
#endif
#if SCAN_DBG == 7
        if (blockIdx.x == 0 && threadIdx.x < 32) ((float*)(ws + WS_CTR + 4096))[threadIdx.x] = 0.f;
#endif
    PHASE_END(0)
#if SCAN_DBG == 5
    PHASE_BEGIN(1) dbg_lds16_test(lds, (unsigned*)(ws + WS_CTR + 8192)); PHASE_END(1)
#define SKIP_REST 1
#endif
    PHASE_BEGIN(1) {
        pg8::Gemm g{(const bf16_t*)(ws + slot(0)), (const bf16_t*)(ws + WS_WIN), opaque(MTOK), opaque(4 * DM), opaque(DM / 2)};
        pg8::StaticOrder S; S.init(g.M, g.N, (int)gridDim.x, (int)blockIdx.x);
        EpiKVQ_<true> E{(bf16_t*)(ws + slot(1)), (const float*)(ws + WS_XS0), (const float*)(ws + WS_SWIN)};
        pg8::gemm_phase<EpiKVQ_<true>, pg8::StaticOrder>(lds, g, S, E, nullptr);
    } PHASE_END(1)
    PHASE_BEGIN(2) phase_scan_a(lds, (const bf16_t*)(ws + slot(2)), (const float*)(ws + WS_LB), (const bf16_t*)(ws + slot(3)), (bf16_t*)(ws + slot(6)), (float*)(ws + WS_DEC), QuantJob{a.in[10], a.in[11], ws + WS_UB, ws + WS_VB, (float*)(ws + WS_USC), (float*)(ws + WS_VSC)}
#if SCAN_DBG == 3
        , (unsigned*)(ws + WS_CTR + 8192)
#endif
        );
#if SCAN_DBG == 7
        asm volatile("s_waitcnt vmcnt(0)" ::: "memory"); __syncthreads(); grid.sync(); if (threadIdx.x < 64) { __builtin_amdgcn_fence(__ATOMIC_ACQUIRE, "agent"); asm volatile("s_waitcnt vmcnt(0)" ::: "memory"); } __syncthreads();
        dbg_check_a7((const float*)(ws + slot(4)), (const bf16_t*)(ws + slot(2)), (const bf16_t*)(ws + slot(6)), (float*)(ws + WS_CTR + 4096));
#endif
#if SCAN_DBG == 6
#define DSYNC6() asm volatile("s_waitcnt vmcnt(0)" ::: "memory"); __syncthreads(); grid.sync(); if (threadIdx.x < 64) { __builtin_amdgcn_fence(__ATOMIC_ACQUIRE, "agent"); asm volatile("s_waitcnt vmcnt(0)" ::: "memory"); } __syncthreads();
        DSYNC6()
        phase_scan_a(lds, (const bf16_t*)(ws + slot(2)), (const float*)(ws + WS_LB), (const bf16_t*)(ws + slot(3)), (bf16_t*)a.out, (float*)(ws + WS_DEC), QuantJob{a.in[10], a.in[11], ws + WS_UB, ws + WS_VB, (float*)(ws + WS_USC), (float*)(ws + WS_VSC)});
        DSYNC6()
        dbg_check_a((LAS float*)lds, (const float*)(ws + slot(4)), (const bf16_t*)(ws + slot(2)), (const bf16_t*)(ws + slot(6)), (const bf16_t*)a.out, (float*)(ws + WS_CTR + 4096));
#endif
#if SCAN_DBG == 3
        asm volatile("s_waitcnt vmcnt(0)" ::: "memory"); __syncthreads(); grid.sync();
        dbg_count_bf16((const bf16_t*)(ws + slot(6)), (size_t)4096 * 16384, (unsigned*)(ws + WS_CTR + 8192) + 2);
#endif
    PHASE_END(2)
    PHASE_BEGIN(3) phase_scan_b((bf16_t*)(ws + slot(6)), (const float*)(ws + WS_DEC), QuantJob{a.in[10] + (size_t)16384 * DM, a.in[11] + (size_t)16384 * DM, ws + WS_UB + (size_t)16384 * DM, ws + WS_VB + (size_t)16384 * DM, (float*)(ws + WS_USC) + 16384, (float*)(ws + WS_VSC) + 16384});
#if SCAN_DBG == 3
        asm volatile("s_waitcnt vmcnt(0)" ::: "memory"); __syncthreads(); grid.sync();

#endif
    PHASE_END(3)
    PHASE_BEGIN(4) phase_scan_c(lds, (const bf16_t*)(ws + slot(1)), (const bf16_t*)(ws + slot(2)), (const float*)(ws + WS_LB), (const bf16_t*)(ws + slot(3)), (const bf16_t*)(ws + slot(4)), (const bf16_t*)(ws + slot(6)), a.in[2], (bf16_t*)(ws + slot(0)));
#if SCAN_DBG == 1
        asm volatile("s_waitcnt vmcnt(0)" ::: "memory"); __syncthreads(); grid.sync();
        phase_scan_naive((const bf16_t*)(ws + slot(1)), (const float*)(ws + slot(4)), (const bf16_t*)(ws + slot(2)), (float*)(ws + slot(6)));
        asm volatile("s_waitcnt vmcnt(0)" ::: "memory"); __syncthreads(); grid.sync();
        phase_onorm((const float*)(ws + slot(6)), (const bf16_t*)(ws + slot(3)), a.in[2], (bf16_t*)(ws + slot(0)));
#endif
#if SCAN_DBG == 3
        asm volatile("s_waitcnt vmcnt(0)" ::: "memory"); __syncthreads(); grid.sync();

#endif
#if SCAN_DBG == 4
#define DSYNC() asm volatile("s_waitcnt vmcnt(0)" ::: "memory"); __syncthreads(); grid.sync(); if (threadIdx.x < 64) { __builtin_amdgcn_fence(__ATOMIC_ACQUIRE, "agent"); asm volatile("s_waitcnt vmcnt(0)" ::: "memory"); } __syncthreads();
        DSYNC()
        phase_scan_naive((const bf16_t*)(ws + slot(1)), (const float*)(ws + slot(4)), (const bf16_t*)(ws + slot(2)), (float*)(ws + slot(6)));
        DSYNC()
        phase_onorm((const float*)(ws + slot(6)), (const bf16_t*)(ws + slot(3)), a.in[2], (bf16_t*)(ws + slot(8)));
        DSYNC()
        phase_scan_a(lds, (const bf16_t*)(ws + slot(2)), (const float*)(ws + WS_LB), (const bf16_t*)(ws + slot(3)), (bf16_t*)(ws + slot(6)), (float*)(ws + WS_DEC), QuantJob{a.in[10], a.in[11], ws + WS_UB, ws + WS_VB, (float*)(ws + WS_USC), (float*)(ws + WS_VSC)});
        DSYNC()
        phase_scan_b((bf16_t*)(ws + slot(6)), (const float*)(ws + WS_DEC), QuantJob{a.in[10] + (size_t)16384 * DM, a.in[11] + (size_t)16384 * DM, ws + WS_UB + (size_t)16384 * DM, ws + WS_VB + (size_t)16384 * DM, (float*)(ws + WS_USC) + 16384, (float*)(ws + WS_VSC) + 16384});
        DSYNC()
        phase_scan_c(lds, (const bf16_t*)(ws + slot(1)), (const bf16_t*)(ws + slot(2)), (const float*)(ws + WS_LB), (const bf16_t*)(ws + slot(3)), (const bf16_t*)(ws + slot(4)), (const bf16_t*)(ws + slot(6)), a.in[2], (bf16_t*)a.out);
        DSYNC()
        dbg_compare4((LAS float*)lds, (const bf16_t*)(ws + slot(0)), (const bf16_t*)(ws + slot(8)), (const bf16_t*)a.out, (float*)(ws + WS_CTR + 4096));
#endif
#if SCAN_DBG == 2
        asm volatile("s_waitcnt vmcnt(0)" ::: "memory"); __syncthreads(); grid.sync();
        phase_scan_naive((const bf16_t*)(ws + slot(1)), (const float*)(ws + slot(4)), (const bf16_t*)(ws + slot(2)), (float*)(ws + slot(6)));
        asm volatile("s_waitcnt vmcnt(0)" ::: "memory"); __syncthreads(); grid.sync();
        phase_onorm((const float*)(ws + slot(6)), (const bf16_t*)(ws + slot(3)), a.in[2], (bf16_t*)(ws + slot(8)));
        asm volatile("s_waitcnt vmcnt(0)" ::: "memory"); __syncthreads(); grid.sync();
        dbg_compare((LAS float*)lds, (const bf16_t*)(ws + slot(0)), (const bf16_t*)(ws + slot(8)), (float*)(ws + WS_CTR + 4096));
#endif
    PHASE_END(4)
    PHASE_BEGIN(5) run_gemm_out<false>(a, lds); PHASE_END(5)
    PHASE_BEGIN(6) run_ln<false>(a); PHASE_END(6)
    PHASE_BEGIN(7) run_gemm_sc<false>(a, lds); PHASE_END(7)
    PHASE_BEGIN(8) run_topk<false>(a, lds); PHASE_END(8)
    PHASE_BEGIN(9) run_peer<false>(a, lds); PHASE_END(9)
    PHASE_BEGIN(10) {
        pg8::Gemm g{(const bf16_t*)(ws + slot(1)), (const bf16_t*)(ws + WS_WKVQ), opaque(MTOK), opaque(3 * DM), opaque(DM / 2)};
        pg8::StaticOrder S; S.init(g.M, g.N, (int)gridDim.x, (int)blockIdx.x);
        EpiKVQR_<true> E{(bf16_t*)(ws + slot(3)), (const float*)(ws + WS_COS), (const float*)(ws + WS_SIN), (const float*)(ws + WS_XS1), (const float*)(ws + WS_SWKVQ)};
        pg8::gemm_phase<EpiKVQR_<true>, pg8::StaticOrder>(lds, g, S, E, nullptr);
    } PHASE_END(10)
    PHASE_BEGIN(11) phase_kstat((LAS float*)lds, (const bf16_t*)(ws + slot(3)), (float*)(ws + WS_KMEAN), (float*)(ws + WS_KNMAX)); PHASE_END(11)
    PHASE_BEGIN(12) phase_sel(lds, (const bf16_t*)(ws + slot(5)), (const float*)(ws + WS_KMEAN), (unsigned short*)(ws + WS_SUB), (int*)(ws + WS_CNT), (int*)(ws + WS_CTR)); PHASE_END(12)
    PHASE_BEGIN(13) phase_att(lds, (const bf16_t*)(ws + slot(5)), (const bf16_t*)(ws + slot(3)), (const bf16_t*)(ws + slot(4)), (const float*)(ws + WS_KNMAX), (const unsigned short*)(ws + WS_SUB),
                              (const int*)(ws + WS_CNT), (int*)(ws + WS_CTR), (bf16_t*)(ws + slot(6)), (bf16_t*)(ws + slot(0)), (float*)(ws + WS_LS)); PHASE_END(13)
    PHASE_BEGIN(14) phase_comb((const bf16_t*)(ws + slot(6)), (const bf16_t*)(ws + slot(0)), (const float*)(ws + WS_LS), (bf16_t*)(ws + slot(3))); PHASE_END(14)
    PHASE_BEGIN(15) run_gemm_out<true>(a, lds); PHASE_END(15)
    PHASE_BEGIN(16) run_ln<true>(a); PHASE_END(16)
    PHASE_BEGIN(17) run_gemm_sc<true>(a, lds); PHASE_END(17)
    PHASE_BEGIN(18) run_topk<true>(a, lds); PHASE_END(18)
#if SCAN_DBG == 7
    PHASE_BEGIN(19) dbg_emit7((const float*)(ws + WS_CTR + 4096), a.out); PHASE_END(19)
#elif SCAN_DBG == 6
    PHASE_BEGIN(19) dbg_emit4((const float*)(ws + WS_CTR + 4096), a.out); PHASE_END(19)
#elif SCAN_DBG == 5
    PHASE_BEGIN(19) dbg_emit5((const unsigned*)(ws + WS_CTR + 8192), a.out); PHASE_END(19)
#elif SCAN_DBG == 4
    PHASE_BEGIN(19) dbg_emit4((const float*)(ws + WS_CTR + 4096), a.out); PHASE_END(19)
#elif SCAN_DBG == 3
    PHASE_BEGIN(19) dbg_emit3((const unsigned*)(ws + WS_CTR + 8192), a.out); PHASE_END(19)
#elif SCAN_DBG == 2
    PHASE_BEGIN(19) dbg_emit((const float*)(ws + WS_CTR + 4096), a.out); PHASE_END(19)
#else
    PHASE_BEGIN(19) run_peer<true>(a, lds); PHASE_END(19)
#endif
}

extern "C" void kernel_launch(void* const* d_in, const int* in_sizes, int n_in, void* d_out, int out_size, void* d_ws, size_t ws_size, hipStream_t stream) {
    static int grid = 0;
    if (grid == 0) {
        if (n_in != 14 || out_size != MTOK * DM || ws_size < WS_END) { fprintf(stderr, "kernel_launch: unexpected shapes (n_in %d, out %d, ws %zu)\n", n_in, out_size, ws_size); grid = -1; return; }
        int dev = 0, cus = 0, per_cu = 0;
        if (hipGetDevice(&dev) != hipSuccess || hipDeviceGetAttribute(&cus, hipDeviceAttributeMultiprocessorCount, dev) != hipSuccess) { grid = -1; return; }
        if (hipFuncSetAttribute((const void*)mk_fwd, hipFuncAttributeMaxDynamicSharedMemorySize, LDS_BYTES) != hipSuccess) { fprintf(stderr, "kernel_launch: hipFuncSetAttribute failed\n"); grid = -1; return; }
        if (hipOccupancyMaxActiveBlocksPerMultiprocessor(&per_cu, (const void*)mk_fwd, 512, LDS_BYTES) != hipSuccess || per_cu < 1) { fprintf(stderr, "kernel_launch: occupancy query failed (%d)\n", per_cu); (void)hipGetLastError(); per_cu = 1; }
        grid = cus * (per_cu > 1 ? 1 : per_cu);
    }
    if (grid < 0) return;
    Args a{};
    for (int i = 0; i < 14; ++i) a.in[i] = (const float*)d_in[i];
    a.out = (float*)d_out; a.ws = (unsigned char*)d_ws;
#if ONE_LAUNCH
    a.ph_lo = 0; a.ph_hi = NPH;
    (void)hipMemsetAsync((unsigned char*)d_ws + WS_BAR, 0, XCD_BAR_WORDS * sizeof(unsigned), stream);
    void* args[] = {&a};
    hipError_t e = hipLaunchCooperativeKernel((const void*)mk_fwd, dim3(grid), dim3(512), args, LDS_BYTES, stream);
    if (e != hipSuccess) fprintf(stderr, "cooperative launch failed: %s (grid %d)\n", hipGetErrorString(e), grid);
#else
    for (int ph = 0; ph < NPH; ++ph) {
        a.ph_lo = ph; a.ph_hi = ph + 1;
        hipLaunchKernelGGL(mk_fwd, dim3(grid), dim3(512), LDS_BYTES, stream, a);
    }
#endif
}
```

```cpp
#define ONE_LAUNCH 1
#include <hip/hip_runtime.h>
#include <hip/hip_cooperative_groups.h>
#include <cstdio>
namespace cg = cooperative_groups;

#ifndef ONE_LAUNCH
#define ONE_LAUNCH 0
#endif
#ifndef SCAN_DBG
#define SCAN_DBG 0
#endif
#ifndef SCAN_A_VALU
#define SCAN_A_VALU 0
#endif
#ifndef SC8
#define SC8 1
#endif
#ifndef ENMASK
#define ENMASK 0xffffffffu
#endif
#define EN(k) ((ENMASK >> (k)) & 1u)

namespace pg8 {
#define PG8_LAS __attribute__((address_space(3)))
typedef unsigned short bf16_t;
typedef short bf16x8 __attribute__((ext_vector_type(8)));
typedef float f32x4 __attribute__((ext_vector_type(4)));
typedef unsigned u32x4 __attribute__((ext_vector_type(4)));
constexpr int BM = 256, BK = 64, HALF = 128, HTB = HALF * BK * 2  , STAGE_BYTES = 8 * HTB, NXCD = 8, WGM = 8;

__host__ __device__ __forceinline__ int lds_byte(int r, int c) { const int st = (r >> 4) * 2 + (c >> 5), rr = r & 15, cc = c & 31, ob = rr * 64 + cc * 2; return st * 1024 + (ob ^ (((ob >> 9) & 1) << 5)); }
__host__ __device__ __forceinline__ void stage_rc(int b, int& R, int& C) { const int st = b / 1024, sb = b % 1024, swz = sb ^ (((sb >> 9) & 1) << 5); R = (st >> 1) * 16 + swz / 64; C = (st & 1) * 32 + (swz % 64) / 2; }
__host__ __device__ __forceinline__ int perm32(int rho) { const int n = rho >> 4, i = rho & 15; return 8 * (i >> 2) + 4 * n + (i & 3); }

struct Unit { int pm, pn; };
struct Gemm { const bf16_t* A; const bf16_t* Bt; int M, N, K; };

struct StaticOrder {
    int nM, nN, nwg, G, c;
    __host__ __device__ void init(int M, int N, int G_, int c_) { nM = M / BM; nN = N / BM; nwg = nM * nN; G = G_; c = c_; }
    __host__ __device__ bool next(int i, Unit& u) const {
        const long L = (long)i * G + c; if (L >= nwg) return false;
        int wgid = (int)L; { const int q = nwg / NXCD, r = nwg % NXCD, xcd = wgid % NXCD, off = wgid / NXCD; wgid = (xcd < r ? xcd * (q + 1) : r * (q + 1) + (xcd - r) * q) + off; }
        const int nig = WGM * nN, gid = wgid / nig, fm = gid * WGM, gsz = (nM - fm) < WGM ? (nM - fm) : WGM;
        u.pm = fm + ((wgid % nig) % gsz); u.pn = (wgid % nig) / gsz; return true;
    }
    __device__ __forceinline__ void a_ready(const Unit&) const {}
    __device__ __forceinline__ void done(const Unit&) const {}
};
struct CountedOrder : StaticOrder {
    const unsigned* ready; unsigned need; unsigned* tmo;
    __device__ __forceinline__ void a_ready(const Unit& u) const {
        if (threadIdx.x < 64) {
            const unsigned long long t0 = __builtin_amdgcn_s_memrealtime(); unsigned polls = 0;
            while ((unsigned)__builtin_amdgcn_readfirstlane(__hip_atomic_load(ready + 64 * u.pm, __ATOMIC_RELAXED, __HIP_MEMORY_SCOPE_AGENT)) < need) {
                if ((++polls & 255u) == 0u && __builtin_amdgcn_readfirstlane(__hip_atomic_load(tmo, __ATOMIC_RELAXED, __HIP_MEMORY_SCOPE_AGENT)) != 0u) break;
                if (__builtin_amdgcn_s_memrealtime() - t0 > 2000000ull) {
                    if (threadIdx.x == 0) { unsigned expect = 0u; __hip_atomic_compare_exchange_strong(tmo + 1, &expect, 0x600u | (unsigned)(u.pm & 0xff), __ATOMIC_RELAXED, __ATOMIC_RELAXED, __HIP_MEMORY_SCOPE_AGENT); __hip_atomic_store(tmo, 1u, __ATOMIC_RELAXED, __HIP_MEMORY_SCOPE_AGENT); }
                    break; }
                __builtin_amdgcn_s_sleep(2); }
            __builtin_amdgcn_fence(__ATOMIC_ACQUIRE, "agent");
            asm volatile("s_waitcnt vmcnt(0)" ::: "memory");
        }
#if !defined(BROKEN_HOOK_NO_BARRIER)
        asm volatile("" ::: "memory"); __builtin_amdgcn_s_barrier(); asm volatile("" ::: "memory");
#endif
    }
};

__device__ __forceinline__ unsigned cvt_pk_bf16(float lo, float hi) { unsigned r; asm volatile("v_cvt_pk_bf16_f32 %0, %1, %2" : "=v"(r) : "v"(lo), "v"(hi)); return r; }
typedef float f32x2 __attribute__((ext_vector_type(2)));
__device__ __forceinline__ f32x2 gelu_pk(f32x2 v) {
    const f32x2 av = __builtin_elementwise_abs(v), d = av * 0.2316418882f + 1.0f;
    f32x2 t; t.x = __builtin_amdgcn_rcpf(d.x); t.y = __builtin_amdgcn_rcpf(d.y);
    f32x2 q = t * 0.5307027145f + (-0.7265760135f); q = q * t + 0.7107068705f; q = q * t + (-0.142248368f); q = q * t + 0.127414796f; q = q * t;
    const f32x2 s = (v * v) * (-0.72134752044f);
    f32x2 e; e.x = __builtin_amdgcn_exp2f(s.x); e.y = __builtin_amdgcn_exp2f(s.y);
    const f32x2 m = v * (q * e), r = v - m;
    f32x2 o; o.x = v.x < 0.f ? m.x : r.x; o.y = v.y < 0.f ? m.y : r.y; return o;
}

struct EpiF32 {
    static constexpr bool PERM = false, AFTER_DRAIN = false, I8 = false;
    float* C; int ldc; const float* bias;
    __device__ __forceinline__ void operator()(const f32x4 (&acc)[2][2][4][2], const Unit& u, int wr, int wc, int fr, int fq) const {
        const int row0 = u.pm * BM + wr * 64 + fr, col0 = u.pn * BM + wc * 32 + 4 * fq;
        f32x4 bv[2][2];
#pragma unroll
        for (int bj = 0; bj < 2; ++bj)
#pragma unroll
            for (int n = 0; n < 2; ++n) bv[bj][n] = bias ? *(const f32x4*)(bias + col0 + bj * HALF + n * 16) : (f32x4){0.f, 0.f, 0.f, 0.f};
#pragma unroll
        for (int ai = 0; ai < 2; ++ai)
#pragma unroll
            for (int m = 0; m < 4; ++m) { float* rowp = C + (size_t)(row0 + ai * HALF + m * 16) * ldc + col0;
#pragma unroll
                for (int bj = 0; bj < 2; ++bj)
#pragma unroll
                    for (int n = 0; n < 2; ++n) *(f32x4*)(rowp + bj * HALF + n * 16) = acc[ai][bj][m][n] + bv[bj][n]; }
    }
};
template <int ACT  > struct EpiBf16 {
    static constexpr bool PERM = true, AFTER_DRAIN = false, I8 = false;
    bf16_t* O; int ldc; const float* bias; int split_cols; size_t split_stride;
    __device__ __forceinline__ void operator()(const f32x4 (&acc)[2][2][4][2], const Unit& u, int wr, int wc, int fr, int fq) const {
        const int row0 = u.pm * BM + wr * 64 + fr; int colt = u.pn * BM; bf16_t* base = O;
        if (split_cols) { const int t = colt / split_cols; base += (size_t)t * split_stride; colt -= t * split_cols; }
        const int col0 = colt + wc * 32 + 8 * fq, bcol0 = u.pn * BM + wc * 32 + 8 * fq;
        f32x4 bv[2][2];
#pragma unroll
        for (int bj = 0; bj < 2; ++bj)
#pragma unroll
            for (int n = 0; n < 2; ++n) bv[bj][n] = bias ? *(const f32x4*)(bias + bcol0 + bj * HALF + 4 * n) : (f32x4){0.f, 0.f, 0.f, 0.f};
#pragma unroll
        for (int ai = 0; ai < 2; ++ai)
#pragma unroll
            for (int m = 0; m < 4; ++m) { bf16_t* rowp = base + (size_t)(row0 + ai * HALF + m * 16) * ldc + col0;
#pragma unroll
                for (int bj = 0; bj < 2; ++bj) { f32x4 v0 = acc[ai][bj][m][0] + bv[bj][0], v1 = acc[ai][bj][m][1] + bv[bj][1];
                    if (ACT == 1) { f32x2 a = gelu_pk((f32x2){v0[0], v0[1]}), b = gelu_pk((f32x2){v0[2], v0[3]}), c = gelu_pk((f32x2){v1[0], v1[1]}), d = gelu_pk((f32x2){v1[2], v1[3]});
                        v0 = (f32x4){a.x, a.y, b.x, b.y}; v1 = (f32x4){c.x, c.y, d.x, d.y}; }
                    if (ACT == 2) {
#pragma unroll
                        for (int j = 0; j < 4; ++j) { v0[j] = 0.5f * v0[j] * (1.0f + erff(v0[j] * 0.70710678f)); v1[j] = 0.5f * v1[j] * (1.0f + erff(v1[j] * 0.70710678f)); } }
                    u32x4 w; w.x = cvt_pk_bf16(v0[0], v0[1]); w.y = cvt_pk_bf16(v0[2], v0[3]); w.z = cvt_pk_bf16(v1[0], v1[1]); w.w = cvt_pk_bf16(v1[2], v1[3]);
                    *(u32x4*)(rowp + bj * HALF) = w; } }
    }
};

typedef int i32x4 __attribute__((ext_vector_type(4)));
template <bool I8> __device__ __forceinline__ f32x4 mma16(bf16x8 b, bf16x8 a, f32x4 c) {
    if constexpr (I8) return __builtin_bit_cast(f32x4, __builtin_amdgcn_mfma_i32_16x16x64_i8(__builtin_bit_cast(i32x4, b), __builtin_bit_cast(i32x4, a), __builtin_bit_cast(i32x4, c), 0, 0, 0));
    else return __builtin_amdgcn_mfma_f32_16x16x32_bf16(b, a, c, 0, 0, 0);
}
template <bool I8> __device__ __forceinline__ f32x4 accf(f32x4 a) { if constexpr (I8) return __builtin_convertvector(__builtin_bit_cast(i32x4, a), f32x4); else return a; }
template <class Epi, class Sched, bool STAMP = false>
__device__ __forceinline__ void gemm_phase(PG8_LAS unsigned char* lds, const Gemm g, const Sched& S, const Epi& E, unsigned long long* stamps) {
    const int tid = threadIdx.x, wid = __builtin_amdgcn_readfirstlane(tid >> 6), lane = tid & 63, wr = wid >> 2, wc = wid & 3, fr = lane & 15, fq = lane >> 4;
    const int K = g.K, nt = K / BK;
    int ts_lo = 0, ts_hi = 0, nts = 0; const unsigned long long rt_entry = STAMP ? (unsigned long long)wall_clock64() : 0ull;
#define PG8_STAMP() do { if (STAMP && wid == 0 && nts < 64) { const unsigned long long _c = (unsigned long long)clock64(); \
        ts_lo = (lane == nts) ? (int)(unsigned)_c : ts_lo; ts_hi = (lane == nts) ? (int)(unsigned)(_c >> 32) : ts_hi; ++nts; } } while (0)
    PG8_STAMP();
    unsigned voffA[2], voffB[2];
#pragma unroll
    for (int i = 0; i < 2; ++i) { int R, C; stage_rc(tid * 16 + i * 8192, R, C); const int Rb = Epi::PERM ? ((R & ~31) + perm32(R & 31)) : R;
        voffA[i] = (unsigned)(R * K + C) * 2u; voffB[i] = (unsigned)(Rb * K + C) * 2u; }
    const size_t kstep = (size_t)(BK * 2);
    const size_t hstep = (size_t)HALF * K * 2;
    const size_t tstep = 2 * hstep;
    const unsigned ldsw = (unsigned)wid * 1024u;
    const int aoff = lds_byte(wr * 64 + fr, fq * 8), boff = lds_byte(wc * 32 + fr, fq * 8);
#define PG8_SA(b, h) (((b) * 2 + (h)) * HTB)
#define PG8_SB(b, h) ((4 + (b) * 2 + (h)) * HTB)
#define PG8_STAGE(bufoff, gbase, voff) do { _Pragma("unroll") for (int _i = 0; _i < 2; ++_i) \
        __builtin_amdgcn_global_load_lds((const unsigned*)((const char*)(gbase) + (voff)[_i]), (PG8_LAS unsigned*)(lds + (bufoff) + ldsw + _i * 8192), 16, 0, 0); } while (0)
#define PG8_LDA(dst, b, h) do { _Pragma("unroll") for (int m = 0; m < 4; ++m) _Pragma("unroll") for (int k = 0; k < 2; ++k) dst[m][k] = *(const PG8_LAS bf16x8*)(lds + PG8_SA(b, h) + aoff + m * 2048 + k * 1024); } while (0)
#define PG8_LDB(dst, b, h) do { _Pragma("unroll") for (int n = 0; n < 2; ++n) _Pragma("unroll") for (int k = 0; k < 2; ++k) dst[n][k] = *(const PG8_LAS bf16x8*)(lds + PG8_SB(b, h) + boff + n * 2048 + k * 1024); } while (0)
#define PG8_MMA(ai, bj, At, Bt) do { __builtin_amdgcn_s_setprio(1); _Pragma("unroll") for (int m = 0; m < 4; ++m) _Pragma("unroll") for (int n = 0; n < 2; ++n) _Pragma("unroll") for (int k = 0; k < 2; ++k) \
        acc[ai][bj][m][n] = mma16<Epi::I8>(Bt[n][k], At[m][k], acc[ai][bj][m][n]); __builtin_amdgcn_s_setprio(0); } while (0)
#define PG8_WAIT_V(n) asm volatile("s_waitcnt vmcnt(" #n ")" ::: "memory")
#define PG8_WAIT_L(n) asm volatile("s_waitcnt lgkmcnt(" #n ")" ::: "memory")
#define PG8_BAR __builtin_amdgcn_s_barrier()
#define PG8_SCHED __builtin_amdgcn_sched_barrier(0)
    Unit cur, nxt; int ui = 0;
    if (!S.next(0, cur)) return;
    f32x4 acc[2][2][4][2];
#pragma unroll
    for (int a = 0; a < 2; ++a)
#pragma unroll
        for (int b = 0; b < 2; ++b)
#pragma unroll
            for (int m = 0; m < 4; ++m)
#pragma unroll
                for (int n = 0; n < 2; ++n) acc[a][b][m][n] = (f32x4){0.f, 0.f, 0.f, 0.f};
    bf16x8 At[4][2], B0[2][2], B1[2][2];
    const char* cA = (const char*)g.A + (size_t)cur.pm * tstep; const char* cB = (const char*)g.Bt + (size_t)cur.pn * tstep;
    S.a_ready(cur);
    PG8_STAGE(PG8_SB(0, 0), cB, voffB); PG8_STAGE(PG8_SA(0, 0), cA, voffA); PG8_STAGE(PG8_SB(0, 1), cB + hstep, voffB); PG8_STAGE(PG8_SA(0, 1), cA + hstep, voffA);
    if (wr == 1) PG8_BAR;
    PG8_WAIT_V(4); PG8_BAR;
    PG8_STAGE(PG8_SB(1, 0), cB + kstep, voffB); PG8_STAGE(PG8_SA(1, 0), cA + kstep, voffA); PG8_STAGE(PG8_SB(1, 1), cB + hstep + kstep, voffB);
    PG8_WAIT_V(6); PG8_BAR;
    PG8_STAMP();
    for (;;) {
        const bool has_next = S.next(ui + 1, nxt);
        const char* nA = has_next ? (const char*)g.A + (size_t)nxt.pm * tstep : cA; const char* nB = has_next ? (const char*)g.Bt + (size_t)nxt.pn * tstep : cB;
        for (int t = 0; t < nt; t += 2) {
            const bool last = (t == nt - 2);
            const char* a1 = cA + (size_t)(t + 1) * kstep;
            const char* a2 = last ? nA : cA + (size_t)(t + 2) * kstep; const char* b2 = last ? nB : cB + (size_t)(t + 2) * kstep;
            const char* a3 = a2 + kstep; const char* b3 = b2 + kstep;
            if (last && has_next) S.a_ready(nxt);
            PG8_LDB(B0, 0, 0); PG8_SCHED; PG8_LDA(At, 0, 0); PG8_STAGE(PG8_SA(1, 1), a1 + hstep, voffA);
            PG8_WAIT_L(8); PG8_BAR; PG8_WAIT_L(0); PG8_MMA(0, 0, At, B0); PG8_BAR; PG8_SCHED;
            PG8_LDB(B1, 0, 1); PG8_STAGE(PG8_SB(0, 0), b2, voffB);
            PG8_BAR; PG8_WAIT_L(0); PG8_MMA(0, 1, At, B1); PG8_BAR;
            PG8_LDA(At, 0, 1); PG8_STAGE(PG8_SA(0, 0), a2, voffA);
            PG8_BAR; PG8_WAIT_L(0); PG8_MMA(1, 0, At, B0); PG8_BAR; PG8_SCHED;
            PG8_STAGE(PG8_SB(0, 1), b2 + hstep, voffB);
            PG8_WAIT_V(6); PG8_BAR; PG8_MMA(1, 1, At, B1); PG8_BAR;
            PG8_LDB(B0, 1, 0); PG8_SCHED; PG8_LDA(At, 1, 0); PG8_STAGE(PG8_SA(0, 1), a2 + hstep, voffA);
            PG8_WAIT_L(8); PG8_BAR; PG8_WAIT_L(0); PG8_MMA(0, 0, At, B0); PG8_BAR; PG8_SCHED;
            PG8_LDB(B1, 1, 1); PG8_STAGE(PG8_SB(1, 0), b3, voffB);
            PG8_BAR; PG8_WAIT_L(0); PG8_MMA(0, 1, At, B1); PG8_BAR;
            PG8_LDA(At, 1, 1); PG8_STAGE(PG8_SA(1, 0), a3, voffA);
            PG8_BAR; PG8_WAIT_L(0); PG8_MMA(1, 0, At, B0); PG8_BAR; PG8_SCHED;
            PG8_STAGE(PG8_SB(1, 1), b3 + hstep, voffB);
            PG8_WAIT_V(6); PG8_BAR; PG8_MMA(1, 1, At, B1); PG8_BAR;
        }
        PG8_STAMP();
        if constexpr (!Epi::AFTER_DRAIN) { E(acc, cur, wr, wc, fr, fq); S.done(cur); }
        PG8_STAMP();
        if (!has_next) break;
#pragma unroll
        for (int a = 0; a < 2; ++a)
#pragma unroll
            for (int b = 0; b < 2; ++b)
#pragma unroll
                for (int m = 0; m < 4; ++m)
#pragma unroll
                    for (int n = 0; n < 2; ++n) acc[a][b][m][n] = (f32x4){0.f, 0.f, 0.f, 0.f};
        cur = nxt; cA = nA; cB = nB; ++ui;
    }
    PG8_WAIT_V(0);
    if (wr == 0) PG8_BAR;
    PG8_BAR;
    if constexpr (Epi::AFTER_DRAIN) { E.fused(acc, cur, wr, wc, fr, fq, lds, wid, lane); S.done(cur); }
    PG8_STAMP();
    if (STAMP && wid == 0) { stamps[lane] = lane < nts ? (((unsigned long long)(unsigned)ts_hi << 32) | (unsigned)ts_lo) : 0ull;
        if (lane == 62) stamps[62] = rt_entry; if (lane == 63) stamps[63] = (unsigned long long)wall_clock64(); }
#undef PG8_STAMP
#undef PG8_SA
#undef PG8_SB
#undef PG8_STAGE
#undef PG8_LDA
#undef PG8_LDB
#undef PG8_MMA
#undef PG8_WAIT_V
#undef PG8_WAIT_L
#undef PG8_BAR
#undef PG8_SCHED
}
}


#define LAS __attribute__((address_space(3)))
typedef unsigned short bf16_t;
typedef float f32x4 __attribute__((ext_vector_type(4)));
typedef unsigned u32x4 __attribute__((ext_vector_type(4)));
typedef unsigned u32x2 __attribute__((ext_vector_type(2)));
typedef short bf16x8 __attribute__((ext_vector_type(8)));
typedef short s16x4 __attribute__((ext_vector_type(4)));
typedef float f32x16 __attribute__((ext_vector_type(16)));

constexpr int MTOK = 16384, DM = 2048, SEQ = 8192, NHEAD = 16;
constexpr float ALPHA = 1.41421356237309515f;
constexpr size_t MiB = (size_t)1 << 20;
constexpr size_t WS_WIN = 0, WS_WOUT = 32 * MiB, WS_WKVQ = 40 * MiB, WS_WO = 64 * MiB, WS_WC = 72 * MiB, WS_UB = 88 * MiB, WS_VB = 152 * MiB, WS_USC = 216 * MiB, WS_VSC = 217 * MiB, WS_H = 224 * MiB, WS_XQ = 232 * MiB, WS_XS = 264 * MiB, WS_W = 272 * MiB, WS_CS = 280 * MiB, WS_SLOT = 344 * MiB;
constexpr size_t WS_EID = 920 * MiB, WS_GATE = 928 * MiB, WS_COS = 936 * MiB, WS_SIN = 938 * MiB, WS_KMEAN = 940 * MiB, WS_LB = 941 * MiB, WS_LS = 942 * MiB, WS_SUB = 946 * MiB, WS_CNT = 962 * MiB, WS_CTR = 963 * MiB, WS_DEC = 964 * MiB, WS_END = 966 * MiB;
constexpr size_t WS_BAR = WS_CTR + 65536;
constexpr size_t WS_WC8 = WS_H, WS_SWC = WS_XS + 5 * MiB, WS_XSO = WS_XS + 6 * MiB, WS_SWO = WS_XS + 7 * MiB;
constexpr size_t WS_XS0 = WS_XS + 1 * MiB, WS_SWIN = WS_XS + 2 * MiB, WS_SWKVQ = WS_XS + 3 * MiB, WS_XS1 = WS_XS + 4 * MiB;
constexpr size_t WS_KNMAX = WS_KMEAN + 768 * 1024;
__host__ __device__ constexpr size_t slot(int i) { return WS_SLOT + (size_t)i * 64 * MiB; }
constexpr int LDS_BYTES = 144 * 1024;
constexpr int NPH = 20;

struct Args { const float* in[14]; float* out; unsigned char* ws; int ph_lo, ph_hi; };

__device__ __forceinline__ float bflo(unsigned w) { return __uint_as_float(w << 16); }
__device__ __forceinline__ float bfhi(unsigned w) { return __uint_as_float(w & 0xffff0000u); }
__device__ __forceinline__ float bf2f(bf16_t b) { return __uint_as_float(((unsigned)b) << 16); }
typedef __bf16 bf16x2_t __attribute__((ext_vector_type(2)));
typedef float f32x2_t __attribute__((ext_vector_type(2)));
__device__ __forceinline__ unsigned pk_bf16(float lo, float hi) { const f32x2_t f = {lo, hi}; return __builtin_bit_cast(unsigned, __builtin_convertvector(f, bf16x2_t)); }
__device__ __forceinline__ float wave_sum(float v) {
#pragma unroll
    for (int o = 32; o >= 1; o >>= 1) v += __shfl_xor(v, o);
    return v;
}
__device__ __forceinline__ float wave_max(float v) {
#pragma unroll
    for (int o = 32; o >= 1; o >>= 1) v = fmaxf(v, __shfl_xor(v, o));
    return v;
}
__device__ __forceinline__ float sigmoidf_(float z) { return 1.0f / (1.0f + __expf(-z)); }


__device__ __forceinline__ void store_wt16(void* p, u32x4 v) {
    __hip_atomic_store((unsigned long long*)p, ((unsigned long long)v.y << 32) | v.x, __ATOMIC_RELAXED, __HIP_MEMORY_SCOPE_AGENT);
    __hip_atomic_store((unsigned long long*)p + 1, ((unsigned long long)v.w << 32) | v.z, __ATOMIC_RELAXED, __HIP_MEMORY_SCOPE_AGENT);
}
__device__ __forceinline__ void store_wt8(void* p, u32x2 v) {
    __hip_atomic_store((unsigned long long*)p, ((unsigned long long)v.y << 32) | v.x, __ATOMIC_RELAXED, __HIP_MEMORY_SCOPE_AGENT);
}
struct EpiIn {
    static constexpr bool PERM = true, AFTER_DRAIN = false, I8 = false;
    bf16_t* Q1; float* LF; bf16_t* I1; bf16_t* G1; const float* LB;
    __device__ __forceinline__ void operator()(const pg8::f32x4 (&acc)[2][2][4][2], const pg8::Unit& u, int wr, int wc, int fr, int fq) const {
        const int type = u.pn >> 3;
        const int row0 = u.pm * 256 + wr * 64 + fr, col0 = (u.pn & 7) * 256 + wc * 32 + 8 * fq;
        if (type == 1) {
#pragma unroll
            for (int bj = 0; bj < 2; ++bj) {
                const int c = col0 + bj * 128;
                const f32x4 lb0 = *(const f32x4*)(LB + c), lb1 = *(const f32x4*)(LB + c + 4);
#pragma unroll
                for (int ai = 0; ai < 2; ++ai)
#pragma unroll
                    for (int m = 0; m < 4; ++m) {
                        float* p = LF + (size_t)(row0 + ai * 128 + m * 16) * DM + c;
                        f32x4 o0, o1;
#pragma unroll
                        for (int j = 0; j < 4; ++j) {
                            o0[j] = __logf(lb0[j] + (1.0f - lb0[j]) * sigmoidf_(acc[ai][bj][m][0][j]));
                            o1[j] = __logf(lb1[j] + (1.0f - lb1[j]) * sigmoidf_(acc[ai][bj][m][1][j]));
                        }
                        *(f32x4*)p = o0; *(f32x4*)(p + 4) = o1;
                    }
            }
        } else {
            bf16_t* dst = Q1 + (size_t)(type - (type > 0 ? 1 : 0)) * ((size_t)32 << 20);
            const bool act = (type != 2);
#pragma unroll
            for (int ai = 0; ai < 2; ++ai)
#pragma unroll
                for (int m = 0; m < 4; ++m)
#pragma unroll
                    for (int bj = 0; bj < 2; ++bj) {
                        f32x4 v0 = acc[ai][bj][m][0], v1 = acc[ai][bj][m][1];
                        if (act) {
#pragma unroll
                            for (int j = 0; j < 4; ++j) { v0[j] = v0[j] * sigmoidf_(v0[j]); v1[j] = v1[j] * sigmoidf_(v1[j]); }
                        }
                        u32x4 w; w.x = pk_bf16(v0[0], v0[1]); w.y = pk_bf16(v0[2], v0[3]); w.z = pk_bf16(v1[0], v1[1]); w.w = pk_bf16(v1[2], v1[3]);
                        *(u32x4*)(dst + (size_t)(row0 + ai * 128 + m * 16) * DM + col0 + bj * 128) = w;
                    }
        }
    }
};
struct EpiRes {
    static constexpr bool PERM = false, AFTER_DRAIN = false, I8 = false;
    const float* res; float* Y;
    __device__ __forceinline__ void operator()(const pg8::f32x4 (&acc)[2][2][4][2], const pg8::Unit& u, int wr, int wc, int fr, int fq) const {
        const int row0 = u.pm * 256 + wr * 64 + fr, col0 = u.pn * 256 + wc * 32 + 4 * fq;
#pragma unroll
        for (int ai = 0; ai < 2; ++ai)
#pragma unroll
            for (int m = 0; m < 4; ++m) {
                const size_t off = (size_t)(row0 + ai * 128 + m * 16) * DM + col0;
#pragma unroll
                for (int bj = 0; bj < 2; ++bj)
#pragma unroll
                    for (int n = 0; n < 2; ++n) {
                        const f32x4 r = *(const f32x4*)(res + off + bj * 128 + n * 16);
                        *(f32x4*)(Y + off + bj * 128 + n * 16) = r * ALPHA + acc[ai][bj][m][n];
                    }
            }
    }
};
template <bool Q8> struct EpiF32_ {
    static constexpr bool PERM = false, AFTER_DRAIN = false, I8 = Q8;
    float* C; int ldc; const float* SA; const float* SB;
    __device__ __forceinline__ void operator()(const pg8::f32x4 (&acc)[2][2][4][2], const pg8::Unit& u, int wr, int wc, int fr, int fq) const {
        const int row0 = u.pm * 256 + wr * 64 + fr, col0 = u.pn * 256 + wc * 32 + 4 * fq;
#pragma unroll
        for (int bj = 0; bj < 2; ++bj)
#pragma unroll
            for (int n = 0; n < 2; ++n) {
                f32x4 sb = {1.f, 1.f, 1.f, 1.f};
                if (Q8) sb = *(const f32x4*)(SB + col0 + bj * 128 + n * 16);
#pragma unroll
                for (int ai = 0; ai < 2; ++ai)
#pragma unroll
                    for (int m = 0; m < 4; ++m) {
                        const int row = row0 + ai * 128 + m * 16;
                        f32x4 v = pg8::accf<Q8>(acc[ai][bj][m][n]);
                        if (Q8) v = v * sb * SA[row];
                        *(f32x4*)(C + (size_t)row * ldc + col0 + bj * 128 + n * 16) = v;
                    }
            }
    }
};
typedef EpiF32_<false> EpiF32;
template <bool Q8> struct EpiKVQ_ {
    static constexpr bool PERM = true, AFTER_DRAIN = false, I8 = Q8;
    bf16_t* K; const float* SA; const float* SB;
    __device__ __forceinline__ void operator()(const pg8::f32x4 (&acc)[2][2][4][2], const pg8::Unit& u, int wr, int wc, int fr, int fq) const {
        const int t = u.pn >> 3;
        bf16_t* dst = K + (size_t)t * ((size_t)32 << 20);
        const int row0 = u.pm * 256 + wr * 64 + fr, col0 = (u.pn & 7) * 256 + wc * 32 + 8 * fq;
#pragma unroll
        for (int bj = 0; bj < 2; ++bj) {
            f32x4 sb0 = {1.f, 1.f, 1.f, 1.f}, sb1 = sb0;
            if (Q8) { const float* sp = SB + u.pn * 256 + bj * 128 + wc * 32 + 8 * fq; sb0 = *(const f32x4*)sp; sb1 = *(const f32x4*)(sp + 4); }
#pragma unroll
            for (int ai = 0; ai < 2; ++ai)
#pragma unroll
                for (int m = 0; m < 4; ++m) {
                    const int row = row0 + ai * 128 + m * 16;
                    f32x4 v0 = pg8::accf<Q8>(acc[ai][bj][m][0]), v1 = pg8::accf<Q8>(acc[ai][bj][m][1]);
                    if (Q8) { const float sa = SA[row]; v0 = v0 * sb0 * sa; v1 = v1 * sb1 * sa; }
                    u32x4 w; w.x = pk_bf16(v0[0], v0[1]); w.y = pk_bf16(v0[2], v0[3]); w.z = pk_bf16(v1[0], v1[1]); w.w = pk_bf16(v1[2], v1[3]);
                    *(u32x4*)(dst + (size_t)row * DM + col0 + bj * 128) = w;
                }
        }
    }
};
typedef EpiKVQ_<false> EpiKVQ;

template <bool Q8> struct EpiKVQR_ {
    static constexpr bool PERM = true, AFTER_DRAIN = false, I8 = Q8;
    bf16_t* K; const float* COS; const float* SIN; const float* SA; const float* SB;
    __device__ __forceinline__ void operator()(const pg8::f32x4 (&acc)[2][2][4][2], const pg8::Unit& u, int wr, int wc, int fr, int fq) const {
        const int t = u.pn >> 3;
        bf16_t* dst = K + (size_t)t * ((size_t)32 << 20);
        const int row0 = u.pm * 256 + wr * 64 + fr;
        const int g = 4 * wc + fq;
        const int col0 = (u.pn & 7) * 256 + wc * 32 + 8 * fq;
#pragma unroll
        for (int bj = 0; bj < 2; ++bj) {
            f32x4 sb0 = {1.f, 1.f, 1.f, 1.f}, sb1 = sb0;
            if (Q8) { const float* sp = SB + u.pn * 256 + bj * 128 + wc * 32 + 8 * fq; sb0 = *(const f32x4*)sp; sb1 = *(const f32x4*)(sp + 4); }
#pragma unroll
            for (int ai = 0; ai < 2; ++ai)
#pragma unroll
                for (int m = 0; m < 4; ++m) {
                    const int row = row0 + ai * 128 + m * 16, pos = row & (SEQ - 1);
                    f32x4 a = pg8::accf<Q8>(acc[ai][bj][m][0]), b = pg8::accf<Q8>(acc[ai][bj][m][1]);
                    if (Q8) { const float sa = SA[row]; a = a * sb0 * sa; b = b * sb1 * sa; }
                    if (t == 1) {
                        u32x4 w; w.x = pk_bf16(a[0], a[1]); w.y = pk_bf16(a[2], a[3]); w.z = pk_bf16(b[0], b[1]); w.w = pk_bf16(b[2], b[3]);
                        *(u32x4*)(dst + (size_t)row * DM + col0 + bj * 128) = w;
                    } else {
                        const f32x4 c = *(const f32x4*)(COS + pos * 64 + 4 * g), sn = *(const f32x4*)(SIN + pos * 64 + 4 * g);
                        bf16_t* p = dst + (size_t)row * DM + ((u.pn & 7) * 2 + bj) * 128 + 4 * g;
                        u32x2 w1, w2;
                        w1.x = pk_bf16(a[0] * c[0] - b[0] * sn[0], a[1] * c[1] - b[1] * sn[1]); w1.y = pk_bf16(a[2] * c[2] - b[2] * sn[2], a[3] * c[3] - b[3] * sn[3]);
                        w2.x = pk_bf16(a[0] * sn[0] + b[0] * c[0], a[1] * sn[1] + b[1] * c[1]); w2.y = pk_bf16(a[2] * sn[2] + b[2] * c[2], a[3] * sn[3] + b[3] * c[3]);
                        *(u32x2*)p = w1; *(u32x2*)(p + 64) = w2;
                    }
                }
        }
    }
};

__host__ __device__ __forceinline__ int rot_pos(int d) { return d < 64 ? 8 * (d >> 2) + (d & 3) : 8 * ((d - 64) >> 2) + 4 + (d & 3); }
__device__ __forceinline__ void transpose_tiles(LAS float* tile, const float* src, int ldn, int K, int N, bf16_t* dst, int nperm = 0) {
    const int tid = threadIdx.x;
    const int tn = N / 64, ntiles = tn * (K / 64);
    f32x4 nx[2];
#define TT_LOAD(tI_) { const int k0_ = ((tI_) / tn) * 64, n0_ = ((tI_) % tn) * 64; _Pragma("unroll") for (int r = 0; r < 2; ++r) nx[r] = *(const f32x4*)(src + (size_t)(k0_ + (tid >> 4) + 32 * r) * ldn + n0_ + (tid & 15) * 4); }
    if ((int)blockIdx.x < ntiles) TT_LOAD((int)blockIdx.x)
    for (int tI = blockIdx.x; tI < ntiles; tI += gridDim.x) {
        const int k0 = (tI / tn) * 64, n0 = (tI % tn) * 64;
        const f32x4 c0 = nx[0], c1 = nx[1];
        if (tI + (int)gridDim.x < ntiles) TT_LOAD(tI + (int)gridDim.x)
#pragma unroll
        for (int r = 0; r < 2; ++r) {
            const int kk = (tid >> 4) + 32 * r, nn = (tid & 15) * 4;
            const f32x4 v = r == 0 ? c0 : c1;
            tile[kk * 65 + nn + 0] = v[0]; tile[kk * 65 + nn + 1] = v[1]; tile[kk * 65 + nn + 2] = v[2]; tile[kk * 65 + nn + 3] = v[3];
        }
        __syncthreads();
        {
            const int nn = tid >> 3, kk8 = (tid & 7) * 8;
            float f[8];
#pragma unroll
            for (int j = 0; j < 8; ++j) f[j] = tile[(kk8 + j) * 65 + nn];
            u32x4 w; w.x = pk_bf16(f[0], f[1]); w.y = pk_bf16(f[2], f[3]); w.z = pk_bf16(f[4], f[5]); w.w = pk_bf16(f[6], f[7]);
            const int nsrc = n0 + nn, nrow = nsrc < nperm ? (nsrc & ~127) + rot_pos(nsrc & 127) : nsrc;
            *(u32x4*)(dst + (size_t)nrow * K + k0 + kk8) = w;
        }
        __syncthreads();
    }
}
#undef TT_LOAD
__device__ __forceinline__ void convert_bf16(const float* src, bf16_t* dst, size_t n) {
    const size_t stride = (size_t)gridDim.x * 512 * 8;
    for (size_t i = ((size_t)blockIdx.x * 512 + threadIdx.x) * 8; i < n; i += stride) {
        const f32x4 a = *(const f32x4*)(src + i), b = *(const f32x4*)(src + i + 4);
        u32x4 w; w.x = pk_bf16(a[0], a[1]); w.y = pk_bf16(a[2], a[3]); w.z = pk_bf16(b[0], b[1]); w.w = pk_bf16(b[2], b[3]);
        *(u32x4*)(dst + i) = w;
    }
}
__device__ __forceinline__ void split8(const f32x4 x0, const f32x4 x1, bf16x8& hi, bf16x8& lo) {
    u32x4 h, l;
    h.x = pk_bf16(x0[0], x0[1]); h.y = pk_bf16(x0[2], x0[3]); h.z = pk_bf16(x1[0], x1[1]); h.w = pk_bf16(x1[2], x1[3]);
    l.x = pk_bf16(x0[0] - bflo(h.x), x0[1] - bfhi(h.x)); l.y = pk_bf16(x0[2] - bflo(h.y), x0[3] - bfhi(h.y)); l.z = pk_bf16(x1[0] - bflo(h.z), x1[1] - bfhi(h.z)); l.w = pk_bf16(x1[2] - bflo(h.w), x1[3] - bfhi(h.w));
    hi = __builtin_bit_cast(bf16x8, h); lo = __builtin_bit_cast(bf16x8, l);
}
__device__ __forceinline__ void fold_peer_keys(const float* w_query, const float* sub_keys, bf16_t* WcT) {
    const int lane = threadIdx.x & 63, gw = blockIdx.x * 8 + (threadIdx.x >> 6), nw = gridDim.x * 8, r32 = lane & 31, hh2 = lane >> 5;
    for (int wt = gw; wt < 8192; wt += nw) {
        const int item = wt >> 3, sub = wt & 7, keyt = sub & 3, kint = sub >> 2;
        const int l = item >> 9, rem = item & 511, hh = rem >> 5, kb = rem & 31, h = hh >> 1, half = hh & 1;
        const float* sk = sub_keys + (size_t)(((l * 2 + half) * 8 + h) * 128 + keyt * 32 + r32) * 128 + 8 * hh2;
        const float* wq = w_query + (size_t)l * DM * DM + (size_t)(kb * 64 + kint * 32 + r32) * DM + h * 256 + half * 128 + 8 * hh2;
        f32x16 acc;
#pragma unroll
        for (int i = 0; i < 16; ++i) acc[i] = 0.f;
#pragma unroll 1
        for (int kh = 0; kh < 2; ++kh) {
            f32x4 av[8], bv[8];
#pragma unroll
            for (int ks = 0; ks < 4; ++ks) { const int kk = 64 * kh + 16 * ks; av[2 * ks] = *(const f32x4*)(wq + kk); av[2 * ks + 1] = *(const f32x4*)(wq + kk + 4); bv[2 * ks] = *(const f32x4*)(sk + kk); bv[2 * ks + 1] = *(const f32x4*)(sk + kk + 4); }
#pragma unroll
            for (int ks = 0; ks < 4; ++ks) {
                bf16x8 ah, al, bh, bl;
                split8(av[2 * ks], av[2 * ks + 1], ah, al); split8(bv[2 * ks], bv[2 * ks + 1], bh, bl);
                acc = __builtin_amdgcn_mfma_f32_32x32x16_bf16(al, bh, acc, 0, 0, 0);
                acc = __builtin_amdgcn_mfma_f32_32x32x16_bf16(ah, bl, acc, 0, 0, 0);
                acc = __builtin_amdgcn_mfma_f32_32x32x16_bf16(ah, bh, acc, 0, 0, 0);
            }
        }
        bf16_t* o = WcT + (size_t)l * DM * DM + (size_t)(h * 256 + half * 128 + keyt * 32 + r32) * DM + kb * 64 + kint * 32 + 4 * hh2;
#pragma unroll
        for (int q = 0; q < 4; ++q) { u32x2 w; w.x = pk_bf16(acc[4 * q], acc[4 * q + 1]); w.y = pk_bf16(acc[4 * q + 2], acc[4 * q + 3]); *(u32x2*)(o + 8 * q) = w; }
    }
}

__device__ __forceinline__ void quant_rows(const float* src, unsigned char* dst, float* scl, int nrows) {
    const int lane = threadIdx.x & 63, gw = blockIdx.x * 8 + (threadIdx.x >> 6), nw = gridDim.x * 8;
    for (int row = gw; row < nrows; row += nw) {
        const float* p = src + (size_t)row * DM;
        f32x4 v[8];
#pragma unroll
        for (int i = 0; i < 2; ++i)
#pragma unroll
            for (int q = 0; q < 4; ++q) v[i * 4 + q] = *(const f32x4*)(p + 1024 * i + 16 * lane + 4 * q);
        float am = 0.f;
#pragma unroll
        for (int i = 0; i < 8; ++i) am = fmaxf(am, fmaxf(fmaxf(fabsf(v[i][0]), fabsf(v[i][1])), fmaxf(fabsf(v[i][2]), fabsf(v[i][3]))));
        am = fmaxf(wave_max(am), 1e-30f);
        const float inv = 127.0f / am;
        if (lane == 0) scl[row] = am * (1.0f / 127.0f);
#pragma unroll
        for (int i = 0; i < 2; ++i) {
            u32x4 w;
#pragma unroll
            for (int q = 0; q < 4; ++q) {
                const f32x4 t = v[i * 4 + q];
                const unsigned b0 = (unsigned)(int)(rintf(t[0] * inv) + 128.0f), b1 = (unsigned)(int)(rintf(t[1] * inv) + 128.0f), b2 = (unsigned)(int)(rintf(t[2] * inv) + 128.0f), b3 = (unsigned)(int)(rintf(t[3] * inv) + 128.0f);
                w[q] = b0 | (b1 << 8) | (b2 << 16) | (b3 << 24);
            }
            *(u32x4*)(dst + (size_t)row * DM + 1024 * i + 16 * lane) = w;
        }
    }
}
__device__ __forceinline__ void quant_transpose(LAS unsigned char* lds, const float* src, int ldn, int N, signed char* dst, float* scl, int nperm = 0) {
    const int tid = threadIdx.x, kg = tid >> 3, c4 = (tid & 7) * 4, wv = tid >> 6;
    LAS float* red = (LAS float*)lds;
    for (int sI = blockIdx.x; sI < N / 32; sI += gridDim.x) {
        const int n0 = sI * 32;
        f32x4 v[32];
        const float* p = src + (size_t)(kg * 32) * ldn + n0 + c4;
#pragma unroll
        for (int it = 0; it < 32; ++it) v[it] = *(const f32x4*)(p + (size_t)it * ldn);
        f32x4 am = {0.f, 0.f, 0.f, 0.f};
#pragma unroll
        for (int it = 0; it < 32; ++it)
#pragma unroll
            for (int j = 0; j < 4; ++j) am[j] = fmaxf(am[j], fabsf(v[it][j]));
#pragma unroll
        for (int o = 8; o <= 32; o <<= 1)
#pragma unroll
            for (int j = 0; j < 4; ++j) am[j] = fmaxf(am[j], __shfl_xor(am[j], o));
        if ((tid & 63) < 8) *(LAS f32x4*)(red + wv * 32 + c4) = am;
        __syncthreads();
#pragma unroll
        for (int w = 0; w < 8; ++w) { const f32x4 r = *(const LAS f32x4*)(red + w * 32 + c4);
#pragma unroll
            for (int j = 0; j < 4; ++j) am[j] = fmaxf(am[j], r[j]); }
#pragma unroll
        for (int j = 0; j < 4; ++j) {
            const float m = fmaxf(am[j], 1e-30f), inv = 127.0f / m;
            const int nsrc = n0 + c4 + j, nrow = nsrc < nperm ? (nsrc & ~127) + rot_pos(nsrc & 127) : nsrc;
            if (kg == 0) scl[nrow] = m * (1.0f / 127.0f);
            signed char* o = dst + (size_t)nrow * DM + kg * 32;
#pragma unroll
            for (int h = 0; h < 2; ++h) {
                u32x4 w;
#pragma unroll
                for (int d = 0; d < 4; ++d) {
                    unsigned bb = 0;
#pragma unroll
                    for (int e = 0; e < 4; ++e) bb |= ((unsigned)(int)rintf(v[h * 16 + d * 4 + e][j] * inv) & 0xffu) << (8 * e);
                    w[d] = bb;
                }
                *(u32x4*)(o + h * 16) = w;
            }
        }
        __syncthreads();
    }
}
__device__ __forceinline__ void quant_rows_s(const float* src, signed char* dst, float* scl, int nrows) {
    const int lane = threadIdx.x & 63, gw = blockIdx.x * 8 + (threadIdx.x >> 6), nw = gridDim.x * 8;
    for (int row = gw; row < nrows; row += nw) {
        const float* p = src + (size_t)row * DM;
        f32x4 v[8];
#pragma unroll
        for (int i = 0; i < 2; ++i)
#pragma unroll
            for (int q = 0; q < 4; ++q) v[i * 4 + q] = *(const f32x4*)(p + 1024 * i + 16 * lane + 4 * q);
        float am = 0.f;
#pragma unroll
        for (int i = 0; i < 8; ++i) am = fmaxf(am, fmaxf(fmaxf(fabsf(v[i][0]), fabsf(v[i][1])), fmaxf(fabsf(v[i][2]), fabsf(v[i][3]))));
        am = fmaxf(wave_max(am), 1e-30f);
        const float inv = 127.0f / am;
        if (lane == 0) scl[row] = am * (1.0f / 127.0f);
#pragma unroll
        for (int i = 0; i < 2; ++i) {
            u32x4 w;
#pragma unroll
            for (int q = 0; q < 4; ++q) {
                const f32x4 t = v[i * 4 + q];
                w[q] = ((unsigned)(int)rintf(t[0] * inv) & 0xffu) | (((unsigned)(int)rintf(t[1] * inv) & 0xffu) << 8) | (((unsigned)(int)rintf(t[2] * inv) & 0xffu) << 16) | (((unsigned)(int)rintf(t[3] * inv) & 0xffu) << 24);
            }
            *(u32x4*)(dst + (size_t)row * DM + 1024 * i + 16 * lane) = w;
        }
    }
}
__device__ __forceinline__ void quant_rows_bf16(const bf16_t* src, signed char* dst, float* scl, int nrows) {
    const int lane = threadIdx.x & 63, gw = blockIdx.x * 8 + (threadIdx.x >> 6), nw = gridDim.x * 8;
    for (int row = gw; row < nrows; row += nw) {
        u32x4 v[4];
#pragma unroll
        for (int i = 0; i < 4; ++i) v[i] = *(const u32x4*)(src + (size_t)row * DM + 512 * i + 8 * lane);
        float am = 0.f;
#pragma unroll
        for (int i = 0; i < 4; ++i)
#pragma unroll
            for (int d = 0; d < 4; ++d) am = fmaxf(am, fmaxf(fabsf(bflo(v[i][d])), fabsf(bfhi(v[i][d]))));
        am = fmaxf(wave_max(am), 1e-30f);
        const float inv = 127.0f / am;
        if (lane == 0) scl[row] = am * (1.0f / 127.0f);
#pragma unroll
        for (int i = 0; i < 4; ++i) {
            u32x2 w;
            w.x = ((unsigned)(int)rintf(bflo(v[i].x) * inv) & 0xffu) | (((unsigned)(int)rintf(bfhi(v[i].x) * inv) & 0xffu) << 8) | (((unsigned)(int)rintf(bflo(v[i].y) * inv) & 0xffu) << 16) | (((unsigned)(int)rintf(bfhi(v[i].y) * inv) & 0xffu) << 24);
            w.y = ((unsigned)(int)rintf(bflo(v[i].z) * inv) & 0xffu) | (((unsigned)(int)rintf(bfhi(v[i].z) * inv) & 0xffu) << 8) | (((unsigned)(int)rintf(bflo(v[i].w) * inv) & 0xffu) << 16) | (((unsigned)(int)rintf(bfhi(v[i].w) * inv) & 0xffu) << 24);
            *(u32x2*)(dst + (size_t)row * DM + 512 * i + 8 * lane) = w;
        }
    }
}
__device__ __forceinline__ void phase_prep(const Args& a, LAS unsigned char* lds) {
    unsigned char* ws = a.ws;
    LAS float* tile = (LAS float*)lds;
    quant_transpose(lds, a.in[1], 4 * DM, 4 * DM, (signed char*)(ws + WS_WIN), (float*)(ws + WS_SWIN));
    transpose_tiles(tile, a.in[3], DM, DM, DM, (bf16_t*)(ws + WS_WOUT));
    quant_transpose(lds, a.in[5], 2 * DM, 2 * DM, (signed char*)(ws + WS_WKVQ), (float*)(ws + WS_SWKVQ), DM);
    quant_transpose(lds, a.in[6], DM, DM, (signed char*)(ws + WS_WKVQ) + (size_t)2 * DM * DM, (float*)(ws + WS_SWKVQ) + 2 * DM, DM);
    quant_transpose(lds, a.in[7], DM, DM, (signed char*)(ws + WS_WO), (float*)(ws + WS_SWO));
    fold_peer_keys(a.in[8], a.in[9], (bf16_t*)(ws + WS_WC));
    quant_rows_s(a.in[0], (signed char*)(ws + slot(0)), (float*)(ws + WS_XS0), MTOK);
    const int gtid = blockIdx.x * 512 + threadIdx.x, gthreads = gridDim.x * 512;
    float* COS = (float*)(ws + WS_COS); float* SIN = (float*)(ws + WS_SIN); float* LB = (float*)(ws + WS_LB);
    for (int i = gtid; i < SEQ * 64; i += gthreads) {
        const int pos = i >> 6, j = i & 63;
        double inv = 1.0; const double r = 0.86596432336006535;
        for (int q = 0; q < j; ++q) inv *= r;
        const float ang = (float)pos * (float)inv;
        const double x = (double)ang;
        const double n = __builtin_rint(x * 0.15915494309189535);
        const float rf = (float)__builtin_fma(-n, 6.283185307179586, x);
        COS[i] = cosf(rf); SIN[i] = sinf(rf);
    }
    for (int c = gtid; c < DM; c += gthreads) { const float l0 = a.in[4][c], l1 = a.in[4][DM + c]; LB[c] = 1.0f / (1.0f + expf(l1 - l0)); }
}

__device__ __forceinline__ void phase_scan_naive(const bf16_t* Q1, const float* LF, const bf16_t* I1, float* O) {
    const int lane = threadIdx.x & 63, gw = blockIdx.x * 8 + (threadIdx.x >> 6), nw = gridDim.x * 8;
    for (int item = gw; item < 2 * NHEAD * 128; item += nw) {
        const int bh = item >> 7, v = item & 127, b = bh >> 4, h = bh & 15;
        const size_t base = (size_t)b * SEQ * DM + h * 128;
        float S0 = 0.f, S1 = 0.f;
#pragma unroll 4
        for (int t = 0; t < SEQ; ++t) {
            const size_t ro = base + (size_t)t * DM;
            const float f0 = __expf(LF[ro + lane]), f1 = __expf(LF[ro + 64 + lane]);
            const float q0 = bf2f(Q1[ro + lane]), q1 = bf2f(Q1[ro + 64 + lane]);
            const float iv = bf2f(I1[ro + v]);
            S0 = f0 * S0 + (1.0f - f0) * iv; S1 = f1 * S1 + (1.0f - f1) * iv;
            const float p = wave_sum(q0 * S0 + q1 * S1);
            if (lane == 0) O[ro + v] = p;
        }
    }
}
__device__ __forceinline__ void phase_onorm(const float* O, const bf16_t* G1, const float* gnorm, bf16_t* OG) {
    const int lane = threadIdx.x & 63, gw = blockIdx.x * 8 + (threadIdx.x >> 6), nw = gridDim.x * 8;
    const float gn0 = gnorm[2 * lane], gn1 = gnorm[2 * lane + 1];
    for (int item = gw; item < MTOK * NHEAD; item += nw) {
        const size_t off = (size_t)item * 128 + 2 * lane;
        const float o0 = O[off], o1 = O[off + 1];
        const float ss = wave_sum(o0 * o0 + o1 * o1);
        const float r = rsqrtf(ss * (1.0f / 128.0f) + 1e-6f);
        const unsigned g = *(const unsigned*)(G1 + off);
        *(unsigned*)(OG + off) = pk_bf16(o0 * r * gn0 * bflo(g), o1 * r * gn1 * bfhi(g));
    }
}

__device__ __forceinline__ void ln_row_store(float (&v)[32], const float* g, const float* bta, float* outf, bf16_t* outb, int lane, signed char* outq = nullptr, float* outs = nullptr) {
    float s = 0.f;
#pragma unroll
    for (int i = 0; i < 32; ++i) s += v[i];
    const float mu = wave_sum(s) * (1.0f / DM);
    float q = 0.f;
#pragma unroll
    for (int i = 0; i < 32; ++i) { v[i] -= mu; q += v[i] * v[i]; }
    const float rstd = rsqrtf(wave_sum(q) * (1.0f / DM) + 1e-5f);
    float am = 0.f;
#pragma unroll
    for (int i = 0; i < 4; ++i) {
        const int c = 512 * i + 8 * lane;
        const f32x4 g0 = *(const f32x4*)(g + c), g1 = *(const f32x4*)(g + c + 4), b0 = *(const f32x4*)(bta + c), b1 = *(const f32x4*)(bta + c + 4);
        f32x4 o0, o1;
#pragma unroll
        for (int j = 0; j < 4; ++j) { o0[j] = v[i * 8 + j] * rstd * g0[j] + b0[j]; o1[j] = v[i * 8 + 4 + j] * rstd * g1[j] + b1[j]; v[i * 8 + j] = o0[j]; v[i * 8 + 4 + j] = o1[j]; am = fmaxf(am, fmaxf(fabsf(o0[j]), fabsf(o1[j]))); }
        if (outf) { *(f32x4*)(outf + c) = o0; *(f32x4*)(outf + c + 4) = o1; }
        if (outb) { u32x4 w; w.x = pk_bf16(o0[0], o0[1]); w.y = pk_bf16(o0[2], o0[3]); w.z = pk_bf16(o1[0], o1[1]); w.w = pk_bf16(o1[2], o1[3]); *(u32x4*)(outb + c) = w; }
    }
    if (outq) {
        am = fmaxf(wave_max(am), 1e-30f);
        const float inv = 127.0f / am;
        if (lane == 0) *outs = am * (1.0f / 127.0f);
#pragma unroll
        for (int i = 0; i < 4; ++i) {
            u32x2 w;
            w.x = ((unsigned)(int)rintf(v[i * 8 + 0] * inv) & 0xffu) | (((unsigned)(int)rintf(v[i * 8 + 1] * inv) & 0xffu) << 8) | (((unsigned)(int)rintf(v[i * 8 + 2] * inv) & 0xffu) << 16) | (((unsigned)(int)rintf(v[i * 8 + 3] * inv) & 0xffu) << 24);
            w.y = ((unsigned)(int)rintf(v[i * 8 + 4] * inv) & 0xffu) | (((unsigned)(int)rintf(v[i * 8 + 5] * inv) & 0xffu) << 8) | (((unsigned)(int)rintf(v[i * 8 + 6] * inv) & 0xffu) << 16) | (((unsigned)(int)rintf(v[i * 8 + 7] * inv) & 0xffu) << 24);
            *(u32x2*)(outq + 512 * i + 8 * lane) = w;
        }
    }
}
__device__ __forceinline__ void ln_row_store16(float (&v)[32], const float* g, const float* bta, float* outf, bf16_t* outb, int lane) {
    float s = 0.f;
#pragma unroll
    for (int i = 0; i < 32; ++i) s += v[i];
    const float mu = wave_sum(s) * (1.0f / DM);
    float q = 0.f;
#pragma unroll
    for (int i = 0; i < 32; ++i) { v[i] -= mu; q += v[i] * v[i]; }
    const float rstd = rsqrtf(wave_sum(q) * (1.0f / DM) + 1e-5f);
#pragma unroll
    for (int i = 0; i < 2; ++i) {
        const int c = 1024 * i + 16 * lane;
        f32x4 o[4];
#pragma unroll
        for (int qd = 0; qd < 4; ++qd) {
            const f32x4 gg = *(const f32x4*)(g + c + 4 * qd), bb = *(const f32x4*)(bta + c + 4 * qd);
#pragma unroll
            for (int j = 0; j < 4; ++j) o[qd][j] = v[16 * i + 4 * qd + j] * rstd * gg[j] + bb[j];
            *(f32x4*)(outf + c + 4 * qd) = o[qd];
        }
        if (outb) {
            u32x4 w0, w1;
            w0.x = pk_bf16(o[0][0], o[0][1]); w0.y = pk_bf16(o[0][2], o[0][3]); w0.z = pk_bf16(o[1][0], o[1][1]); w0.w = pk_bf16(o[1][2], o[1][3]);
            w1.x = pk_bf16(o[2][0], o[2][1]); w1.y = pk_bf16(o[2][2], o[2][3]); w1.z = pk_bf16(o[3][0], o[3][1]); w1.w = pk_bf16(o[3][2], o[3][3]);
            *(u32x4*)(outb + c) = w0; *(u32x4*)(outb + c + 8) = w1;
        }
    }
}
template <bool RES16> __device__ __forceinline__ void phase_ln(const bf16_t* Y, const void* RESv, const float* g, const float* bta, float* outf, bf16_t* outb, signed char* outq = nullptr, float* outs = nullptr) {
    const int lane = threadIdx.x & 63, gw = blockIdx.x * 8 + (threadIdx.x >> 6), nw = gridDim.x * 8;
    for (int row = gw; row < MTOK; row += nw) {
        float v[32];
        const bf16_t* p = Y + (size_t)row * DM;
#pragma unroll
        for (int i = 0; i < 4; ++i) {
            const u32x4 yw = *(const u32x4*)(p + 512 * i + 8 * lane);
            const f32x4 a = {bflo(yw.x), bfhi(yw.x), bflo(yw.y), bfhi(yw.y)}, b = {bflo(yw.z), bfhi(yw.z), bflo(yw.w), bfhi(yw.w)};
            f32x4 ra, rb;
            if (RES16) { const u32x4 w = *(const u32x4*)((const bf16_t*)RESv + (size_t)row * DM + 512 * i + 8 * lane); ra = (f32x4){bflo(w.x), bfhi(w.x), bflo(w.y), bfhi(w.y)}; rb = (f32x4){bflo(w.z), bfhi(w.z), bflo(w.w), bfhi(w.w)}; }
            else { const float* rp = (const float*)RESv + (size_t)row * DM; ra = *(const f32x4*)(rp + 512 * i + 8 * lane); rb = *(const f32x4*)(rp + 512 * i + 8 * lane + 4); }
#pragma unroll
            for (int j = 0; j < 4; ++j) { v[i * 8 + j] = a[j] + ALPHA * ra[j]; v[i * 8 + 4 + j] = b[j] + ALPHA * rb[j]; }
        }
        ln_row_store(v, g, bta, outf ? outf + (size_t)row * DM : nullptr, outb ? outb + (size_t)row * DM : nullptr, lane, outq ? outq + (size_t)row * DM : nullptr, outs ? outs + row : nullptr);
    }
}

__device__ __forceinline__ void wave_argmax(float& v, int& idx) {
#pragma unroll
    for (int o = 32; o >= 1; o >>= 1) {
        const float ov = __shfl_xor(v, o); const int oi = __shfl_xor(idx, o);
        if (ov > v || (ov == v && oi < idx)) { v = ov; idx = oi; }
    }
}
__device__ __forceinline__ unsigned fkey(float x) { const unsigned u = __float_as_uint(x); return u ^ (unsigned)(((int)u >> 31) | 0x80000000); }
__device__ __forceinline__ float funkey(unsigned k) { const unsigned u = (k & 0x80000000u) ? (k ^ 0x80000000u) : ~k; return __uint_as_float(u); }
__device__ __forceinline__ void sort16_insert(unsigned (&r)[16], unsigned v) {
#pragma unroll
    for (int i = 0; i < 16; ++i) { const unsigned m = r[i] > v ? r[i] : v; v = r[i] > v ? v : r[i]; r[i] = m; }
}
__device__ __forceinline__ void phase_topk(LAS unsigned char* lds, const float* SCT, int* EID, float* GATE) {
    LAS unsigned char* ib = lds + threadIdx.x * 32;
    for (int item = blockIdx.x * 512 + threadIdx.x; item < MTOK * 8; item += gridDim.x * 512) {
        const int h = item >> 14, tok = item & (MTOK - 1);
        const float* p = SCT + (size_t)(h * 256) * MTOK + tok;
        unsigned r1[16], r2[16];
#pragma unroll
        for (int i = 0; i < 16; ++i) { r1[i] = 0u; r2[i] = 0u; }
#pragma unroll 8
        for (int e = 0; e < 128; ++e) {
            const float x1 = p[(size_t)e * MTOK], x2 = p[(size_t)(128 + e) * MTOK];
            sort16_insert(r1, (fkey(x1) & ~0x7Fu) | (unsigned)e);
            sort16_insert(r2, (fkey(x2) & ~0x7Fu) | (unsigned)e);
        }
        float v1[16], v2[16];
#pragma unroll
        for (int i = 0; i < 16; ++i) { v1[i] = funkey(r1[i] & ~0x7Fu); v2[i] = funkey(r2[i] & ~0x7Fu); ib[i] = (unsigned char)(r1[i] & 0x7Fu); ib[16 + i] = (unsigned char)(r2[i] & 0x7Fu); }
        unsigned r3[16];
#pragma unroll
        for (int i = 0; i < 16; ++i) r3[i] = 0u;
#pragma unroll
        for (int a = 0; a < 16; ++a)
#pragma unroll
            for (int bq = 0; bq < 16; ++bq)
                if ((a + 1) * (bq + 1) <= 16) sort16_insert(r3, (fkey(v1[a] + v2[bq]) & ~0xFFu) | (unsigned)(a * 16 + bq));
        const float mx = funkey(r3[0] & ~0xFFu);
        float ev[16]; float sum = 0.f;
#pragma unroll
        for (int i = 0; i < 16; ++i) { ev[i] = __expf(funkey(r3[i] & ~0xFFu) - mx); sum += ev[i]; }
        const float rs = 1.0f / sum;
        int eid[16];
#pragma unroll
        for (int i = 0; i < 16; ++i) { const unsigned f = r3[i] & 0xFFu; eid[i] = (int)ib[f >> 4] * 128 + (int)ib[16 + (f & 15u)]; }
        int* eo = EID + (size_t)tok * 128 + h * 16; float* go = GATE + (size_t)tok * 128 + h * 16;
#pragma unroll
        for (int q = 0; q < 4; ++q) {
            *(u32x4*)(eo + 4 * q) = (u32x4){(unsigned)eid[4 * q], (unsigned)eid[4 * q + 1], (unsigned)eid[4 * q + 2], (unsigned)eid[4 * q + 3]};
            *(f32x4*)(go + 4 * q) = (f32x4){ev[4 * q] * rs, ev[4 * q + 1] * rs, ev[4 * q + 2] * rs, ev[4 * q + 3] * rs};
        }
    }
}

__device__ __forceinline__ float gelu_erf(float x) { return 0.5f * x * (1.0f + erff(x * 0.70710678118654752f)); }
__device__ __forceinline__ float ub0(unsigned w) { return (float)(w & 0xffu); }
__device__ __forceinline__ float ub1(unsigned w) { return (float)((w >> 8) & 0xffu); }
__device__ __forceinline__ float ub2(unsigned w) { return (float)((w >> 16) & 0xffu); }
__device__ __forceinline__ float ub3(unsigned w) { return (float)(w >> 24); }
__device__ __forceinline__ void phase_peer(LAS unsigned char* lds, const float* X, const int* EID, const float* GATE, const unsigned char* U, const unsigned char* V, const float* USC, const float* VSC,
                                           const float* g, const float* bta, float* outf, bf16_t* outb) {
    const int lane = threadIdx.x & 63, wv = threadIdx.x >> 6, gw = blockIdx.x * 8 + wv, nw = gridDim.x * 8;
    LAS float* hb = (LAS float*)(lds + wv * 512);
    for (int tok = gw; tok < MTOK; tok += nw) {
        float x[32];
        const float* xp = X + (size_t)tok * DM;
#pragma unroll
        for (int i = 0; i < 2; ++i)
#pragma unroll
            for (int q = 0; q < 4; ++q) { const f32x4 t = *(const f32x4*)(xp + 1024 * i + 16 * lane + 4 * q); x[16 * i + 4 * q] = t[0]; x[16 * i + 4 * q + 1] = t[1]; x[16 * i + 4 * q + 2] = t[2]; x[16 * i + 4 * q + 3] = t[3]; }
        float sx = 0.f;
#pragma unroll
        for (int j = 0; j < 32; ++j) sx += x[j];
        const float d0 = -128.0f * sx;
        const int e0 = EID[(size_t)tok * 128 + lane], e1 = EID[(size_t)tok * 128 + 64 + lane];
        const float g0 = GATE[(size_t)tok * 128 + lane], g1 = GATE[(size_t)tok * 128 + 64 + lane];
        for (int bt = 0; bt < 16; ++bt) {
            float d[8];
#pragma unroll
            for (int r = 0; r < 8; ++r) {
                const int e = bt * 8 + r;
                const int idx = __builtin_amdgcn_readfirstlane(__shfl(bt < 8 ? e0 : e1, e & 63));
                const u32x4* up = (const u32x4*)(U + (size_t)idx * DM) + lane;
                float acc = d0;
#pragma unroll
                for (int i = 0; i < 2; ++i) {
                    const u32x4 w = up[i * 64];
                    acc += x[16 * i + 0] * ub0(w.x) + x[16 * i + 1] * ub1(w.x) + x[16 * i + 2] * ub2(w.x) + x[16 * i + 3] * ub3(w.x)
                         + x[16 * i + 4] * ub0(w.y) + x[16 * i + 5] * ub1(w.y) + x[16 * i + 6] * ub2(w.y) + x[16 * i + 7] * ub3(w.y)
                         + x[16 * i + 8] * ub0(w.z) + x[16 * i + 9] * ub1(w.z) + x[16 * i + 10] * ub2(w.z) + x[16 * i + 11] * ub3(w.z)
                         + x[16 * i + 12] * ub0(w.w) + x[16 * i + 13] * ub1(w.w) + x[16 * i + 14] * ub2(w.w) + x[16 * i + 15] * ub3(w.w);
                }
                d[r] = acc;
            }
            const bool b5 = lane & 32, b4 = lane & 16, b3 = lane & 8;
            float t4[4];
#pragma unroll
            for (int q = 0; q < 4; ++q) { const float keep = b5 ? d[4 + q] : d[q], send = b5 ? d[q] : d[4 + q]; t4[q] = keep + __shfl_xor(send, 32); }
            float t2[2];
#pragma unroll
            for (int q = 0; q < 2; ++q) { const float keep = b4 ? t4[2 + q] : t4[q], send = b4 ? t4[q] : t4[2 + q]; t2[q] = keep + __shfl_xor(send, 16); }
            float t1;
            { const float keep = b3 ? t2[1] : t2[0], send = b3 ? t2[0] : t2[1]; t1 = keep + __shfl_xor(send, 8); }
            t1 += __shfl_xor(t1, 4); t1 += __shfl_xor(t1, 2); t1 += __shfl_xor(t1, 1);
            if ((lane & 7) == 0) hb[bt * 8 + (lane >> 3 & 1) + 2 * (lane >> 4 & 1) + 4 * (lane >> 5 & 1)] = t1;
        }
        asm volatile("s_waitcnt lgkmcnt(0)" ::: "memory");
        const float h0 = hb[lane] * USC[e0], h1 = hb[64 + lane] * USC[e1];
        const float w0 = g0 * gelu_erf(h0) * VSC[e0], w1 = g1 * gelu_erf(h1) * VSC[e1];
        float wsum = wave_sum(w0 + w1);
        float y[32];
#pragma unroll
        for (int i = 0; i < 32; ++i) y[i] = 0.f;
#pragma unroll 8
        for (int e = 0; e < 128; ++e) {
            const int idx = __builtin_amdgcn_readfirstlane(__shfl(e < 64 ? e0 : e1, e & 63));
            const float wt = __shfl(e < 64 ? w0 : w1, e & 63);
            const u32x4* vp = (const u32x4*)(V + (size_t)idx * DM) + lane;
#pragma unroll
            for (int i = 0; i < 2; ++i) {
                const u32x4 w = vp[i * 64];
                y[16 * i + 0] += wt * ub0(w.x); y[16 * i + 1] += wt * ub1(w.x); y[16 * i + 2] += wt * ub2(w.x); y[16 * i + 3] += wt * ub3(w.x);
                y[16 * i + 4] += wt * ub0(w.y); y[16 * i + 5] += wt * ub1(w.y); y[16 * i + 6] += wt * ub2(w.y); y[16 * i + 7] += wt * ub3(w.y);
                y[16 * i + 8] += wt * ub0(w.z); y[16 * i + 9] += wt * ub1(w.z); y[16 * i + 10] += wt * ub2(w.z); y[16 * i + 11] += wt * ub3(w.z);
                y[16 * i + 12] += wt * ub0(w.w); y[16 * i + 13] += wt * ub1(w.w); y[16 * i + 14] += wt * ub2(w.w); y[16 * i + 15] += wt * ub3(w.w);
            }
        }
        const float corr = -128.0f * wsum;
#pragma unroll
        for (int i = 0; i < 32; ++i) y[i] = y[i] + corr + ALPHA * x[i];
        ln_row_store16(y, g, bta, outf + (size_t)tok * DM, outb ? outb + (size_t)tok * DM : nullptr, lane);
        asm volatile("s_waitcnt lgkmcnt(0)" ::: "memory");
    }
}

__device__ __forceinline__ int row_dot_i8(const u32x4 (&xq)[2], const unsigned char* rowp, int lane) {
    const u32x4* up = (const u32x4*)rowp + lane;
    int acc = 0;
#pragma unroll
    for (int i = 0; i < 2; ++i) {
        const u32x4 w = up[i * 64];
        acc = __builtin_amdgcn_sdot4((int)xq[i].x, (int)(w.x ^ 0x80808080u), acc, false); acc = __builtin_amdgcn_sdot4((int)xq[i].y, (int)(w.y ^ 0x80808080u), acc, false);
        acc = __builtin_amdgcn_sdot4((int)xq[i].z, (int)(w.z ^ 0x80808080u), acc, false); acc = __builtin_amdgcn_sdot4((int)xq[i].w, (int)(w.w ^ 0x80808080u), acc, false);
    }
    return acc;
}
__device__ __forceinline__ void peer_issue8(u32x4 (&seg)[8], const unsigned char* base, const u32x4 ia, const u32x4 ib) {
    seg[0] = *(const u32x4*)(base + (size_t)ia.x * DM); seg[1] = *(const u32x4*)(base + (size_t)ia.y * DM); seg[2] = *(const u32x4*)(base + (size_t)ia.z * DM); seg[3] = *(const u32x4*)(base + (size_t)ia.w * DM);
    seg[4] = *(const u32x4*)(base + (size_t)ib.x * DM); seg[5] = *(const u32x4*)(base + (size_t)ib.y * DM); seg[6] = *(const u32x4*)(base + (size_t)ib.z * DM); seg[7] = *(const u32x4*)(base + (size_t)ib.w * DM);
}
__device__ __forceinline__ void peer_dot8(int (&d)[8], const u32x4 (&seg)[8], const u32x4 xq) {
#pragma unroll
    for (int i = 0; i < 8; ++i) {
        int acc = __builtin_amdgcn_sdot4((int)xq.x, (int)(seg[i].x ^ 0x80808080u), 0, false);
        acc = __builtin_amdgcn_sdot4((int)xq.y, (int)(seg[i].y ^ 0x80808080u), acc, false);
        acc = __builtin_amdgcn_sdot4((int)xq.z, (int)(seg[i].z ^ 0x80808080u), acc, false);
        d[i] = __builtin_amdgcn_sdot4((int)xq.w, (int)(seg[i].w ^ 0x80808080u), acc, false);
    }
}
__device__ __forceinline__ void phase_peer_u(const signed char* XQ, const int* EID, const unsigned char* U, LAS int* HL  ) {
    const int lane = threadIdx.x & 63, wv = threadIdx.x >> 6, es = lane >> 3, cc = lane & 7;
    const bool b2 = cc & 4, b1 = cc & 2, b0 = cc & 1;
    const int nw = gridDim.x * 8, gw = blockIdx.x * 8 + wv, tpw = (MTOK + nw - 1) / nw, tbase = gw * tpw;
    int cnt = MTOK - tbase; cnt = cnt > tpw ? tpw : cnt;
    if (cnt <= 0) return;
    for (int i = lane; i < cnt * 128; i += 64) HL[i] = 0;
    asm volatile("s_waitcnt lgkmcnt(0)" ::: "memory");
    const int nit = 16 * cnt;
    const unsigned char* ub = U + cc * 16;
    u32x4 m0a, m0b, m0c, m0d, m0x, m1a, m1b, m1c, m1d, m1x, m2a, m2b, m2c, m2d, m2x; u32x4 sA[8], sB[8];
#define PU_LOAD(sl_, k_, A_, B_, C_, D_, X_) { const int* ep_ = EID + (size_t)(tbase + (k_)) * 128 + es * 16; A_ = *(const u32x4*)ep_; B_ = *(const u32x4*)(ep_ + 4); C_ = *(const u32x4*)(ep_ + 8); D_ = *(const u32x4*)(ep_ + 12); \
        X_ = *(const u32x4*)(XQ + (size_t)(tbase + (k_)) * DM + (sl_) * 128 + cc * 16); }
#define PU_NEXT(sl_, k_, sn_, kn_) { kn_ = (k_) + 1; sn_ = (sl_); if (kn_ == cnt) { kn_ = 0; ++sn_; } if (sn_ == 16) { sn_ = 15; kn_ = cnt - 1; } }
    int sl = 0, k = 0, sl1, k1, sl2, k2;
    PU_NEXT(sl, k, sl1, k1) PU_NEXT(sl1, k1, sl2, k2)
    PU_LOAD(sl, k, m0a, m0b, m0c, m0d, m0x)
    PU_LOAD(sl1, k1, m1a, m1b, m1c, m1d, m1x)
    peer_issue8(sA, ub + sl * 128, m0a, m0b);
    for (int it = 0; it < nit; ++it) {
        PU_LOAD(sl2, k2, m2a, m2b, m2c, m2d, m2x)
        peer_issue8(sB, ub + sl * 128, m0c, m0d);
        int dlo[8]; peer_dot8(dlo, sA, m0x);
        peer_issue8(sA, ub + sl1 * 128, m1a, m1b);
        int dhi[8]; peer_dot8(dhi, sB, m0x);
        int t8[8], t4[4], t2[2];
#pragma unroll
        for (int q = 0; q < 8; ++q) { const int keep = b2 ? dhi[q] : dlo[q], send = b2 ? dlo[q] : dhi[q]; t8[q] = keep + __shfl_xor(send, 4); }
#pragma unroll
        for (int q = 0; q < 4; ++q) { const int keep = b1 ? t8[4 + q] : t8[q], send = b1 ? t8[q] : t8[4 + q]; t4[q] = keep + __shfl_xor(send, 2); }
#pragma unroll
        for (int q = 0; q < 2; ++q) { const int keep = b0 ? t4[2 + q] : t4[q], send = b0 ? t4[q] : t4[2 + q]; t2[q] = keep + __shfl_xor(send, 1); }
        { LAS int* hp = HL + k * 128 + es * 16 + (b2 ? 8 : 0) + (b1 ? 4 : 0) + (b0 ? 2 : 0);
          __hip_atomic_fetch_add(hp, t2[0], __ATOMIC_RELAXED, __HIP_MEMORY_SCOPE_WORKGROUP); __hip_atomic_fetch_add(hp + 1, t2[1], __ATOMIC_RELAXED, __HIP_MEMORY_SCOPE_WORKGROUP); }
        sl = sl1; k = k1; sl1 = sl2; k1 = k2; PU_NEXT(sl1, k1, sl2, k2)
        m0a = m1a; m0b = m1b; m0c = m1c; m0d = m1d; m0x = m1x; m1a = m2a; m1b = m2b; m1c = m2c; m1d = m2d; m1x = m2x;
    }
#undef PU_LOAD
#undef PU_NEXT
}
__device__ __forceinline__ void phase_peer_w(const LAS int* HL, const float* XS, const int* EID, const float* GATE, const float* USC, const float* VSC, signed char* WQ, float* SW) {
    const int lane = threadIdx.x & 63, gw = blockIdx.x * 8 + (threadIdx.x >> 6), nw = gridDim.x * 8, tpw = (MTOK + nw - 1) / nw, tbase = gw * tpw;
    const int tend = tbase + tpw < MTOK ? tbase + tpw : MTOK;
    for (int tok = tbase; tok < tend; ++tok) {
        const int h0 = HL[(tok - tbase) * 128 + lane], h1 = HL[(tok - tbase) * 128 + 64 + lane];
        const int e0 = EID[(size_t)tok * 128 + lane], e1 = EID[(size_t)tok * 128 + 64 + lane];
        const float xs = XS[tok];
        const float w0 = GATE[(size_t)tok * 128 + lane] * gelu_erf((float)h0 * xs * USC[e0]) * VSC[e0];
        const float w1 = GATE[(size_t)tok * 128 + 64 + lane] * gelu_erf((float)h1 * xs * USC[e1]) * VSC[e1];
        const float am = fmaxf(wave_max(fmaxf(fabsf(w0), fabsf(w1))), 1e-30f), inv = 127.0f / am;
        WQ[(size_t)tok * 128 + lane] = (signed char)(int)rintf(w0 * inv); WQ[(size_t)tok * 128 + 64 + lane] = (signed char)(int)rintf(w1 * inv);
        if (lane == 0) SW[tok] = am * (1.0f / 127.0f);
    }
}
__device__ __forceinline__ void peer_dot4x4(int (&acc)[16], const u32x4 sa, const u32x4 sb, const u32x4 sc, const u32x4 sd, const unsigned w4) {
#pragma unroll
    for (int k = 0; k < 4; ++k) {
        const unsigned A = sa[k], B = sb[k], C = sc[k], D = sd[k];
        const unsigned p0 = __builtin_amdgcn_perm(B, A, 0x05010400u);
        const unsigned p1 = __builtin_amdgcn_perm(B, A, 0x07030602u);
        const unsigned p2 = __builtin_amdgcn_perm(D, C, 0x05010400u);
        const unsigned p3 = __builtin_amdgcn_perm(D, C, 0x07030602u);
        const unsigned t0 = __builtin_amdgcn_perm(p2, p0, 0x05040100u);
        const unsigned t1 = __builtin_amdgcn_perm(p2, p0, 0x07060302u);
        const unsigned t2 = __builtin_amdgcn_perm(p3, p1, 0x05040100u);
        const unsigned t3 = __builtin_amdgcn_perm(p3, p1, 0x07060302u);
        acc[4 * k + 0] = __builtin_amdgcn_sdot4((int)t0, (int)w4, acc[4 * k + 0], false);
        acc[4 * k + 1] = __builtin_amdgcn_sdot4((int)t1, (int)w4, acc[4 * k + 1], false);
        acc[4 * k + 2] = __builtin_amdgcn_sdot4((int)t2, (int)w4, acc[4 * k + 2], false);
        acc[4 * k + 3] = __builtin_amdgcn_sdot4((int)t3, (int)w4, acc[4 * k + 3], false);
    }
}
__device__ __forceinline__ void phase_peer_v(const bf16_t* X, const int* EID, const signed char* WQ, const float* SW, const unsigned char* V, float* Y) {
    const int lane = threadIdx.x & 63, wv = threadIdx.x >> 6, es = lane >> 3, cc = lane & 7;
    const bool b5 = lane & 32, b4 = lane & 16, b3 = lane & 8;
    const int nw = gridDim.x * 8, gw = blockIdx.x * 8 + wv, tpw = (MTOK + nw - 1) / nw, tbase = gw * tpw;
    int cnt = MTOK - tbase; cnt = cnt > tpw ? tpw : cnt;
    if (cnt <= 0) return;
    const int nit = 16 * cnt;
    const unsigned char* vb = V + cc * 16;
    const int colo = cc * 16 + (b5 ? 8 : 0) + (b4 ? 4 : 0) + (b3 ? 2 : 0);
    u32x4 m0c, m0d, m1a, m1b, m1c, m1d, m2a, m2b, m2c, m2d; u32x4 w0, w1; unsigned x0, x1; float c0, c1; u32x4 sA[8], sB[8];
#define PV_IDS(k_, A_, B_, C_, D_) { const size_t o_ = (size_t)(tbase + (k_)) * 128 + es * 16; A_ = *(const u32x4*)(EID + o_); B_ = *(const u32x4*)(EID + o_ + 4); C_ = *(const u32x4*)(EID + o_ + 8); D_ = *(const u32x4*)(EID + o_ + 12); }
#define PV_WX(sl_, k_, W_, X_, CS_) { W_ = *(const u32x4*)(WQ + (size_t)(tbase + (k_)) * 128 + es * 16); \
        X_ = *(const unsigned*)(X + (size_t)(tbase + (k_)) * DM + (sl_) * 128 + colo); CS_ = SW[tbase + (k_)]; }
#define PV_NEXT(sl_, k_, sn_, kn_) { kn_ = (k_) + 1; sn_ = (sl_); if (kn_ == cnt) { kn_ = 0; ++sn_; } if (sn_ == 16) { sn_ = 15; kn_ = cnt - 1; } }
    int sl = 0, k = 0, sl1, k1, sl2, k2;
    PV_NEXT(sl, k, sl1, k1) PV_NEXT(sl1, k1, sl2, k2)
    { u32x4 ta, tb; PV_IDS(k, ta, tb, m0c, m0d) PV_IDS(k1, m1a, m1b, m1c, m1d)
      PV_WX(sl, k, w0, x0, c0)
      peer_issue8(sA, vb + sl * 128, ta, tb); }
    for (int it = 0; it < nit; ++it) {
        PV_IDS(k2, m2a, m2b, m2c, m2d)
        peer_issue8(sB, vb + sl * 128, m0c, m0d);
        int ya[16];
#pragma unroll
        for (int j = 0; j < 16; ++j) ya[j] = 0;
        peer_dot4x4(ya, sA[0], sA[1], sA[2], sA[3], w0.x); peer_dot4x4(ya, sA[4], sA[5], sA[6], sA[7], w0.y);
        peer_issue8(sA, vb + sl1 * 128, m1a, m1b);
        PV_WX(sl1, k1, w1, x1, c1)
        peer_dot4x4(ya, sB[0], sB[1], sB[2], sB[3], w0.z); peer_dot4x4(ya, sB[4], sB[5], sB[6], sB[7], w0.w);
        int t8[8], t4[4], t2[2];
#pragma unroll
        for (int q = 0; q < 8; ++q) { const int keep = b5 ? ya[8 + q] : ya[q], send = b5 ? ya[q] : ya[8 + q]; t8[q] = keep + __shfl_xor(send, 32); }
#pragma unroll
        for (int q = 0; q < 4; ++q) { const int keep = b4 ? t8[4 + q] : t8[q], send = b4 ? t8[q] : t8[4 + q]; t4[q] = keep + __shfl_xor(send, 16); }
#pragma unroll
        for (int q = 0; q < 2; ++q) { const int keep = b3 ? t4[2 + q] : t4[q], send = b3 ? t4[q] : t4[2 + q]; t2[q] = keep + __shfl_xor(send, 8); }
        f32x2_t o; o[0] = (float)t2[0] * c0 + ALPHA * bflo(x0); o[1] = (float)t2[1] * c0 + ALPHA * bfhi(x0);
        *(f32x2_t*)(Y + (size_t)(tbase + k) * DM + sl * 128 + colo) = o;
        sl = sl1; k = k1; sl1 = sl2; k1 = k2; PV_NEXT(sl1, k1, sl2, k2)
        m0c = m1c; m0d = m1d; m1a = m2a; m1b = m2b; m1c = m2c; m1d = m2d;
        w0 = w1; x0 = x1; c0 = c1;
    }
#undef PV_IDS
#undef PV_WX
#undef PV_NEXT
}

__device__ __forceinline__ void rot8(const u32x4 lo, const u32x4 hi, const f32x4 c0, const f32x4 c1, const f32x4 s0, const f32x4 s1, float (&o1)[8], float (&o2)[8]) {
    const float a[8] = {bflo(lo.x), bfhi(lo.x), bflo(lo.y), bfhi(lo.y), bflo(lo.z), bfhi(lo.z), bflo(lo.w), bfhi(lo.w)};
    const float b[8] = {bflo(hi.x), bfhi(hi.x), bflo(hi.y), bfhi(hi.y), bflo(hi.z), bfhi(hi.z), bflo(hi.w), bfhi(hi.w)};
    const float c[8] = {c0[0], c0[1], c0[2], c0[3], c1[0], c1[1], c1[2], c1[3]}, sn[8] = {s0[0], s0[1], s0[2], s0[3], s1[0], s1[1], s1[2], s1[3]};
#pragma unroll
    for (int j = 0; j < 8; ++j) { o1[j] = a[j] * c[j] - b[j] * sn[j]; o2[j] = a[j] * sn[j] + b[j] * c[j]; }
}
__device__ __forceinline__ u32x4 pack8(const float (&o)[8]) { u32x4 w; w.x = pk_bf16(o[0], o[1]); w.y = pk_bf16(o[2], o[3]); w.z = pk_bf16(o[4], o[5]); w.w = pk_bf16(o[6], o[7]); return w; }
__device__ __forceinline__ void phase_kstat(LAS float* red, const bf16_t* KR, float* KMEAN, float* KNMAX) {
    const int tid = threadIdx.x, ch = tid & 7, rr = tid >> 3, wv = tid >> 6, lane = tid & 63;
    for (int item = blockIdx.x; item < 2 * NHEAD * 32; item += gridDim.x) {
        const int bh = item >> 5, j = item & 31, b = bh >> 4, h = bh & 15;
        float sm1[8], sm2[8]; float nmax = 0.f;
#pragma unroll
        for (int q = 0; q < 8; ++q) { sm1[q] = 0.f; sm2[q] = 0.f; }
        u32x4 lo[4], hi[4];
#pragma unroll
        for (int ps = 0; ps < 4; ++ps) { const size_t off = ((size_t)b * SEQ + j * 256 + ps * 64 + rr) * DM + h * 128 + ch * 8; lo[ps] = *(const u32x4*)(KR + off); hi[ps] = *(const u32x4*)(KR + off + 64); }
#pragma unroll
        for (int ps = 0; ps < 4; ++ps) {
            const float a[8] = {bflo(lo[ps].x), bfhi(lo[ps].x), bflo(lo[ps].y), bfhi(lo[ps].y), bflo(lo[ps].z), bfhi(lo[ps].z), bflo(lo[ps].w), bfhi(lo[ps].w)};
            const float c[8] = {bflo(hi[ps].x), bfhi(hi[ps].x), bflo(hi[ps].y), bfhi(hi[ps].y), bflo(hi[ps].z), bfhi(hi[ps].z), bflo(hi[ps].w), bfhi(hi[ps].w)};
            float nq = 0.f;
#pragma unroll
            for (int q = 0; q < 8; ++q) { sm1[q] += a[q]; sm2[q] += c[q]; nq += a[q] * a[q] + c[q] * c[q]; }
            nq += __shfl_xor(nq, 1); nq += __shfl_xor(nq, 2); nq += __shfl_xor(nq, 4);
            nmax = fmaxf(nmax, nq);
        }
#pragma unroll
        for (int q = 0; q < 8; ++q) {
            sm1[q] += __shfl_xor(sm1[q], 8); sm1[q] += __shfl_xor(sm1[q], 16); sm1[q] += __shfl_xor(sm1[q], 32);
            sm2[q] += __shfl_xor(sm2[q], 8); sm2[q] += __shfl_xor(sm2[q], 16); sm2[q] += __shfl_xor(sm2[q], 32);
        }
        nmax = wave_max(nmax);
        if (lane < 8) {
#pragma unroll
            for (int q = 0; q < 8; ++q) { red[wv * 128 + lane * 8 + q] = sm1[q]; red[wv * 128 + 64 + lane * 8 + q] = sm2[q]; }
        }
        if (lane == 0) red[1024 + wv] = nmax;
        __syncthreads();
        if (tid < 128) {
            float s2 = 0.f;
#pragma unroll
            for (int r = 0; r < 8; ++r) s2 += red[r * 128 + tid];
            KMEAN[(size_t)item * 128 + tid] = s2 * (1.0f / 256.0f);
        }
        if (tid == 0) {
            float m = 0.f;
#pragma unroll
            for (int r = 0; r < 8; ++r) m = fmaxf(m, red[1024 + r]);
            KNMAX[item] = sqrtf(m);
        }
        __syncthreads();
    }
}

__device__ __forceinline__ void top3_insert(float x, int m, float& v0, int& i0, float& v1, int& i1, float& v2, int& i2) {
    const bool c0 = x > v0 || (x == v0 && m < i0), c1 = x > v1 || (x == v1 && m < i1), c2 = x > v2 || (x == v2 && m < i2);
    v2 = c1 ? v1 : (c2 ? x : v2); i2 = c1 ? i1 : (c2 ? m : i2);
    v1 = c0 ? v0 : (c1 ? x : v1); i1 = c0 ? i0 : (c1 ? m : i1);
    v0 = c0 ? x : v0; i0 = c0 ? m : i0;
}
__device__ __forceinline__ void phase_sel(LAS unsigned char* lds, const bf16_t* QR, const float* KMEAN, unsigned short* SUB, int* CNT, int* ctr) {
    const int tid = threadIdx.x, lane = tid & 63, wv = tid >> 6, r32 = lane & 31, hh = lane >> 5;
    LAS unsigned short* bucket = (LAS unsigned short*)lds;
    LAS int* cnt = (LAS int*)(lds + 16384);
    const float NEG = -1e30f;
    if (blockIdx.x == 0 && tid == 0) *ctr = 0;
    for (int item = blockIdx.x; item < 2 * NHEAD * 32; item += gridDim.x) {
        const int bh = item >> 5, i = item & 31, b = bh >> 4, h = bh & 15;
        if (i == 0) continue;
        if (tid < 32) cnt[tid] = 0;
        __syncthreads();
        const float* kmp = KMEAN + ((size_t)bh * 32 + r32) * 128 + 8 * hh;
        const size_t tok = (size_t)b * SEQ + i * 256 + wv * 32 + r32;
        const bf16_t* qp = QR + tok * DM + h * 128 + 8 * hh;
        f32x16 S;
#pragma unroll
        for (int e = 0; e < 16; ++e) S[e] = 0.f;
#pragma unroll
        for (int s2 = 0; s2 < 8; ++s2) {
            const f32x4 ka = *(const f32x4*)(kmp + 16 * s2), kb = *(const f32x4*)(kmp + 16 * s2 + 4);
            const bf16x8 qf = *(const bf16x8*)(qp + 16 * s2);
            u32x4 hi, lo;
            hi.x = pk_bf16(ka[0], ka[1]); hi.y = pk_bf16(ka[2], ka[3]); hi.z = pk_bf16(kb[0], kb[1]); hi.w = pk_bf16(kb[2], kb[3]);
            lo.x = pk_bf16(ka[0] - bflo(hi.x), ka[1] - bfhi(hi.x)); lo.y = pk_bf16(ka[2] - bflo(hi.y), ka[3] - bfhi(hi.y));
            lo.z = pk_bf16(kb[0] - bflo(hi.z), kb[1] - bfhi(hi.z)); lo.w = pk_bf16(kb[2] - bflo(hi.w), kb[3] - bfhi(hi.w));
            S = __builtin_amdgcn_mfma_f32_32x32x16_bf16(__builtin_bit_cast(bf16x8, hi), qf, S, 0, 0, 0);
            S = __builtin_amdgcn_mfma_f32_32x32x16_bf16(__builtin_bit_cast(bf16x8, lo), qf, S, 0, 0, 0);
        }
        float v0 = -3e38f, v1 = -3e38f, v2 = -3e38f; int i0 = 99, i1 = 99, i2 = 99;
#pragma unroll
        for (int e = 0; e < 16; ++e) {
            const int m = (e & 3) + 8 * (e >> 2) + 4 * hh;
            const float x = m < i ? S[e] : NEG;
            top3_insert(x, m, v0, i0, v1, i1, v2, i2);
        }
        {
            const float pv0 = __shfl_xor(v0, 32), pv1 = __shfl_xor(v1, 32), pv2 = __shfl_xor(v2, 32);
            const int pi0 = __shfl_xor(i0, 32), pi1 = __shfl_xor(i1, 32), pi2 = __shfl_xor(i2, 32);
            top3_insert(pv0, pi0, v0, i0, v1, i1, v2, i2); top3_insert(pv1, pi1, v0, i0, v1, i1, v2, i2); top3_insert(pv2, pi2, v0, i0, v1, i1, v2, i2);
        }
        if (hh == 0) {
            const int tl = wv * 32 + r32;
            if (v0 > 0.5f * NEG) { const int p = __hip_atomic_fetch_add(cnt + i0, 1, __ATOMIC_RELAXED, __HIP_MEMORY_SCOPE_WORKGROUP); bucket[i0 * 256 + p] = (unsigned short)(tl | (0 << 8)); }
            if (v1 > 0.5f * NEG) { const int p = __hip_atomic_fetch_add(cnt + i1, 1, __ATOMIC_RELAXED, __HIP_MEMORY_SCOPE_WORKGROUP); bucket[i1 * 256 + p] = (unsigned short)(tl | (1 << 8)); }
            if (v2 > 0.5f * NEG) { const int p = __hip_atomic_fetch_add(cnt + i2, 1, __ATOMIC_RELAXED, __HIP_MEMORY_SCOPE_WORKGROUP); bucket[i2 * 256 + p] = (unsigned short)(tl | (2 << 8)); }
        }
        __syncthreads();
        for (int idx = tid; idx < 32 * 256; idx += 512) {
            const int j = idx >> 8, p = idx & 255;
            if (j < i && p < cnt[j]) SUB[(((size_t)bh * 32 + j) * 32 + i) * 256 + p] = bucket[idx];
        }
        if (tid < i) CNT[((size_t)bh * 32 + tid) * 32 + i] = cnt[tid];
        __syncthreads();
    }
}

__device__ __forceinline__ unsigned off_b(unsigned row, unsigned ch) { return 256u * row + 16u * (ch ^ (((row & 3u) << 2) | ((row >> 2) & 3u))); }
__device__ __forceinline__ unsigned pi32(unsigned m) { return (m & ~12u) | ((m & 4u) << 1) | ((m & 8u) >> 1); }
__device__ __forceinline__ bf16x8 tr_frag(LAS unsigned char* img, unsigned lane, unsigned c, unsigned ks) {
    const unsigned hh = lane >> 5, blk = (lane >> 4) & 1, q = (lane & 15) >> 2, p = lane & 3;
    const unsigned a0 = off_b(16 * ks + 8 * hh + q, 4 * c + 2 * blk + (p >> 1)) + 8 * (p & 1);
    const unsigned a1 = off_b(16 * ks + 8 * hh + 4 + q, 4 * c + 2 * blk + (p >> 1)) + 8 * (p & 1);
    const s16x4 lo = __builtin_amdgcn_ds_read_tr16_b64_v4i16((LAS s16x4*)(img + a0));
    const s16x4 hi = __builtin_amdgcn_ds_read_tr16_b64_v4i16((LAS s16x4*)(img + a1));
    bf16x8 r; r[0] = lo[0]; r[1] = lo[1]; r[2] = lo[2]; r[3] = lo[3]; r[4] = hi[0]; r[5] = hi[1]; r[6] = hi[2]; r[7] = hi[3];
    return r;
}
__device__ __forceinline__ void phase_att(LAS unsigned char* lds, const bf16_t* QR, const bf16_t* KR, const bf16_t* V, const float* KNMAX, const unsigned short* SUB, const int* CNT, int* ctr,
                                          bf16_t* P012, bf16_t* P3, float* LS) {
    const int tid = threadIdx.x, lane = tid & 63, wv = tid >> 6, r32 = lane & 31, hh = lane >> 5;
    LAS unsigned char* Kimg = lds;
    LAS unsigned char* Vimg = lds + 65536;
    LAS int* misc = (LAS int*)(lds + 131072);
    const float SCL2 = 0.08838834764831845f * 1.4426950408889634f;
    for (;;) {
        __syncthreads();
        if (tid == 0) misc[40] = __hip_atomic_fetch_add(ctr, 1, __ATOMIC_RELAXED, __HIP_MEMORY_SCOPE_AGENT);
        __syncthreads();
        const int item = misc[40];
        if (item >= 2 * NHEAD * 32) break;
        const int j = item >> 5, bh = item & 31, b = bh >> 4, h = bh & 15;
#pragma unroll
        for (int r = 0; r < 8; ++r) {
            const int idx = tid + 512 * r, row = idx >> 4, ch = idx & 15;
            const size_t g = ((size_t)b * SEQ + j * 256 + row) * DM + h * 128 + ch * 8;
            const u32x4 kv = *(const u32x4*)(KR + g), vv = *(const u32x4*)(V + g);
            *(LAS u32x4*)(Kimg + off_b(row, ch)) = kv; *(LAS u32x4*)(Vimg + off_b(row, ch)) = vv;
        }
        if (tid <= 32) { int pre = 0; for (int u = j + 1; u < tid; ++u) pre += CNT[((size_t)bh * 32 + j) * 32 + u]; misc[tid] = pre; }
        float kn = (lane < 32) ? KNMAX[bh * 32 + lane] : 0.f;
        kn = wave_max(kn);
        __syncthreads();
        const int total = misc[32], ntile = (256 + total + 31) >> 5;
        for (int tile = wv; tile < ntile; tile += 8) {
            const int gr = tile * 32 + r32;
            int pos, slot; bool valid = true;
            if (gr < 256) { pos = j * 256 + gr; slot = 3; }
            else {
                const int x = gr - 256; valid = x < total;
                int ii = j + 1;
                for (int u = j + 1; u < 32; ++u) if (misc[u] <= x) ii = u;
                if (valid) { const unsigned e = SUB[(((size_t)bh * 32 + j) * 32 + ii) * 256 + (x - misc[ii])]; pos = ii * 256 + (int)(e & 255u); slot = (int)(e >> 8); }
                else { pos = j * 256; slot = 3; }
            }
            const size_t tok = (size_t)b * SEQ + pos;
            bf16x8 qf[8];
            const bf16_t* qp = QR + tok * DM + h * 128 + 8 * hh;
#pragma unroll
            for (int s = 0; s < 8; ++s) qf[s] = *(const bf16x8*)(qp + 16 * s);
            float qn2 = 0.f;
#pragma unroll
            for (int s = 0; s < 8; ++s)
#pragma unroll
                for (int e = 0; e < 8; ++e) { const float f = bf2f((bf16_t)qf[s][e]); qn2 += f * f; }
            qn2 += __shfl_xor(qn2, 32);
            const float c2 = sqrtf(qn2) * kn * SCL2;
            f32x16 O[4];
#pragma unroll
            for (int dt = 0; dt < 4; ++dt)
#pragma unroll
                for (int e = 0; e < 16; ++e) O[dt][e] = 0.f;
            float l = 0.f;
            const bool own = tile < 8;
            const int kcn = own ? tile + 1 : 8;
            const unsigned krow = pi32((unsigned)r32);
            for (int kc = 0; kc < kcn; ++kc) {
                f32x16 S, S1;
#pragma unroll
                for (int e = 0; e < 16; ++e) { S[e] = 0.f; S1[e] = 0.f; }
#pragma unroll
                for (int s = 0; s < 8; s += 2) {
                    const bf16x8 kf = *(const LAS bf16x8*)(Kimg + off_b(32 * kc + krow, 2 * s + hh));
                    const bf16x8 kf1 = *(const LAS bf16x8*)(Kimg + off_b(32 * kc + krow, 2 * s + 2 + hh));
                    S = __builtin_amdgcn_mfma_f32_32x32x16_bf16(kf, qf[s], S, 0, 0, 0);
                    S1 = __builtin_amdgcn_mfma_f32_32x32x16_bf16(kf1, qf[s + 1], S1, 0, 0, 0);
                }
                float p[16];
                if (own) {
#pragma unroll
                    for (int e = 0; e < 16; ++e) {
                        const unsigned m = (e & 3) + 8 * (e >> 2) + 4 * hh;
                        const int key = j * 256 + 32 * kc + (int)pi32(m);
                        float pe = __builtin_amdgcn_exp2f((S[e] + S1[e]) * SCL2 - c2);
                        if (key > pos) pe = 0.f;
                        p[e] = pe; l += pe;
                    }
                } else {
#pragma unroll
                    for (int e = 0; e < 16; ++e) { const float pe = __builtin_amdgcn_exp2f((S[e] + S1[e]) * SCL2 - c2); p[e] = pe; l += pe; }
                }
                u32x4 w0, w1;
                w0.x = pk_bf16(p[0], p[1]); w0.y = pk_bf16(p[2], p[3]); w0.z = pk_bf16(p[4], p[5]); w0.w = pk_bf16(p[6], p[7]);
                w1.x = pk_bf16(p[8], p[9]); w1.y = pk_bf16(p[10], p[11]); w1.z = pk_bf16(p[12], p[13]); w1.w = pk_bf16(p[14], p[15]);
                const bf16x8 pf0 = __builtin_bit_cast(bf16x8, w0), pf1 = __builtin_bit_cast(bf16x8, w1);
#pragma unroll
                for (int dt = 0; dt < 4; ++dt) {
                    const bf16x8 v0 = tr_frag(Vimg, lane, dt, 2 * kc), v1 = tr_frag(Vimg, lane, dt, 2 * kc + 1);
                    O[dt] = __builtin_amdgcn_mfma_f32_32x32x16_bf16(v0, pf0, O[dt], 0, 0, 0);
                    O[dt] = __builtin_amdgcn_mfma_f32_32x32x16_bf16(v1, pf1, O[dt], 0, 0, 0);
                }
            }
            l += __shfl_xor(l, 32);
            if (valid) {
                bf16_t* pl = (slot < 3 ? P012 + (size_t)slot * ((size_t)32 << 20) : P3) + (tok * NHEAD + h) * 128 + 4 * hh;
#pragma unroll
                for (int dt = 0; dt < 4; ++dt)
#pragma unroll
                    for (int g = 0; g < 4; ++g) {
                        u32x2 w; w.x = pk_bf16(O[dt][4 * g], O[dt][4 * g + 1]); w.y = pk_bf16(O[dt][4 * g + 2], O[dt][4 * g + 3]);
                        *(u32x2*)(pl + 32 * dt + 8 * g) = w;
                    }
                if (hh == 0) LS[(size_t)slot * MTOK * NHEAD + tok * NHEAD + h] = l;
            }
        }
    }
}
__device__ __forceinline__ void phase_comb(LAS float* red, const bf16_t* P012, const bf16_t* P3, const float* LS, signed char* AO8, float* XSO) {
    const int tid = threadIdx.x, tsel = tid >> 8, hd = (tid & 255) >> 4, ch = tid & 15, wv = tid >> 6;
    u32x4 nw[4]; float nl[4];
#define CB_LOAD(pair_) { const size_t th_ = ((size_t)(2 * (pair_) + tsel)) * NHEAD + hd; nw[3] = *(const u32x4*)(P3 + th_ * 128 + ch * 8); nl[3] = LS[(size_t)3 * MTOK * NHEAD + th_]; \
        _Pragma("unroll") for (int s_ = 0; s_ < 3; ++s_) { nw[s_] = *(const u32x4*)(P012 + (size_t)s_ * ((size_t)32 << 20) + th_ * 128 + ch * 8); nl[s_] = LS[(size_t)s_ * MTOK * NHEAD + th_]; } }
    if ((int)blockIdx.x < MTOK / 2) CB_LOAD((int)blockIdx.x)
    int par = 0;
    for (int pair = blockIdx.x; pair < MTOK / 2; pair += gridDim.x, par ^= 1) {
        const int token = 2 * pair + tsel;
        const int t = token & (SEQ - 1), blk = t >> 8, nsel = blk < 3 ? blk : 3;
        float acc[8];
        float l = nl[3];
        { const u32x4 w = nw[3];
          acc[0] = bflo(w.x); acc[1] = bfhi(w.x); acc[2] = bflo(w.y); acc[3] = bfhi(w.y); acc[4] = bflo(w.z); acc[5] = bfhi(w.z); acc[6] = bflo(w.w); acc[7] = bfhi(w.w); }
#pragma unroll
        for (int s = 0; s < 3; ++s) {
            u32x4 w = nw[s]; float ls = nl[s];
            if (s >= nsel) { w = (u32x4){0u, 0u, 0u, 0u}; ls = 0.f; }
            acc[0] += bflo(w.x); acc[1] += bfhi(w.x); acc[2] += bflo(w.y); acc[3] += bfhi(w.y); acc[4] += bflo(w.z); acc[5] += bfhi(w.z); acc[6] += bflo(w.w); acc[7] += bfhi(w.w);
            l += ls;
        }
        if (pair + (int)gridDim.x < MTOK / 2) CB_LOAD(pair + (int)gridDim.x)
        const float rl = 1.0f / l;
        float am = 0.f;
#pragma unroll
        for (int j = 0; j < 8; ++j) { acc[j] *= rl; am = fmaxf(am, fabsf(acc[j])); }
        am = wave_max(am);
        if ((tid & 63) == 0) red[par * 8 + wv] = am;
        __syncthreads();
        am = fmaxf(fmaxf(fmaxf(red[par * 8 + 4 * tsel], red[par * 8 + 4 * tsel + 1]), fmaxf(red[par * 8 + 4 * tsel + 2], red[par * 8 + 4 * tsel + 3])), 1e-30f);
        const float inv = 127.0f / am;
        if ((tid & 255) == 0) XSO[token] = am * (1.0f / 127.0f);
        u32x2 o;
        o.x = ((unsigned)(int)rintf(acc[0] * inv) & 0xffu) | (((unsigned)(int)rintf(acc[1] * inv) & 0xffu) << 8) | (((unsigned)(int)rintf(acc[2] * inv) & 0xffu) << 16) | (((unsigned)(int)rintf(acc[3] * inv) & 0xffu) << 24);
        o.y = ((unsigned)(int)rintf(acc[4] * inv) & 0xffu) | (((unsigned)(int)rintf(acc[5] * inv) & 0xffu) << 8) | (((unsigned)(int)rintf(acc[6] * inv) & 0xffu) << 16) | (((unsigned)(int)rintf(acc[7] * inv) & 0xffu) << 24);
        *(u32x2*)(AO8 + (size_t)token * DM + hd * 128 + ch * 8) = o;
    }
#undef CB_LOAD
}


__device__ __forceinline__ void qrow_issue(f32x4 (&v)[8], const float* p, int lane) {
#pragma unroll
    for (int i = 0; i < 2; ++i)
#pragma unroll
        for (int q = 0; q < 4; ++q) v[i * 4 + q] = *(const f32x4*)(p + 1024 * i + 16 * lane + 4 * q);
}
__device__ __forceinline__ void qrow_finish(const f32x4 (&v)[8], unsigned char* dst, float* scl, int lane, bool sgn = false) {
    float am = 0.f;
#pragma unroll
    for (int i = 0; i < 8; ++i) am = fmaxf(am, fmaxf(fmaxf(fabsf(v[i][0]), fabsf(v[i][1])), fmaxf(fabsf(v[i][2]), fabsf(v[i][3]))));
    am = fmaxf(wave_max(am), 1e-30f);
    const float inv = 127.0f / am;
    if (lane == 0) *scl = am * (1.0f / 127.0f);
#pragma unroll
    for (int i = 0; i < 2; ++i) {
        u32x4 w;
#pragma unroll
        for (int q = 0; q < 4; ++q) {
            const f32x4 t = v[i * 4 + q];
            const float off = sgn ? 0.0f : 128.0f;
            const unsigned b0 = (unsigned)(int)(rintf(t[0] * inv) + off) & 0xffu, b1 = (unsigned)(int)(rintf(t[1] * inv) + off) & 0xffu, b2 = (unsigned)(int)(rintf(t[2] * inv) + off) & 0xffu, b3 = (unsigned)(int)(rintf(t[3] * inv) + off) & 0xffu;
            w[q] = b0 | (b1 << 8) | (b2 << 16) | (b3 << 24);
        }
        *(u32x4*)(dst + 1024 * i + 16 * lane) = w;
    }
}
struct QuantJob { const float* TU; const float* TV; unsigned char* QU; unsigned char* QV; float* SU; float* SV; };
__device__ __forceinline__ const float* qj_src(const QuantJob& q, int r) { return (r < 16384 ? q.TU : q.TV) + (size_t)(r & 16383) * DM; }
__device__ __forceinline__ unsigned char* qj_dst(const QuantJob& q, int r) { return (r < 16384 ? q.QU : q.QV) + (size_t)(r & 16383) * DM; }
__device__ __forceinline__ float* qj_scl(const QuantJob& q, int r) { return (r < 16384 ? q.SU : q.SV) + (r & 16383); }
__device__ __forceinline__ void qj_tail(const QuantJob& q, int done_iters) {
    const int lane = threadIdx.x & 63, gw = blockIdx.x * 8 + (threadIdx.x >> 6), nw = gridDim.x * 8;
    for (int r = gw + done_iters * nw; r < 32768; r += nw) { f32x4 v[8]; qrow_issue(v, qj_src(q, r), lane); qrow_finish(v, qj_dst(q, r), qj_scl(q, r), lane, r >= 16384); }
}
__device__ __forceinline__ float logf_gate(float z, float lb) { return __logf(lb + (1.0f - lb) * sigmoidf_(z)); }
__device__ __forceinline__ void phase_scan_a(LAS unsigned char* lds, const bf16_t* FZ, const float* LB, const bf16_t* I1, bf16_t* LT, float* DEC, const QuantJob qj, unsigned* dbgc = nullptr) {
    unsigned dbg_kt = 0, dbg_acc = 0;
    const int tid = threadIdx.x, lane = tid & 63, wv = tid >> 6, k = tid & 127, part = tid >> 7;
    LAS unsigned char* Iimg = lds; LAS unsigned char* KTimg = lds + 16384;
    LAS float* psum = (LAS float*)(lds + 32768);
    LAS unsigned char* Lst = lds + 36864;
#if SCAN_A_VALU == 2
    for (int item = blockIdx.x; item < 2 * NHEAD * 128; item += gridDim.x) {
        const int bh = item >> 7, c = item & 127, b = bh >> 4, h = bh & 15;
        const size_t tok0 = (size_t)b * SEQ + c * 64;
        for (int idx = tid; idx < 16384; idx += 512) {
            const int v = idx >> 7, kk = idx & 127;
            float g = 1.f, L = 0.f;
            for (int s2 = 63; s2 >= 0; --s2) { const size_t o = (tok0 + s2) * DM + h * 128; const float f = __expf(logf_gate(bf2f(FZ[o + kk]), LB[h * 128 + kk])); L += bf2f(I1[o + v]) * (1.0f - f) * g; g *= f; }
            LT[(size_t)item * 16384 + idx] = (bf16_t)(pk_bf16(L, 0.f) & 0xffffu);
        }
    }
    return;
#endif
    bf16_t nfz[16]; u32x4 nit_[2];
#define SA_LOAD(item_) { const int bh_ = (item_) >> 7, c_ = (item_) & 127; const size_t t0_ = (size_t)(bh_ >> 4) * SEQ + c_ * 64; const int h_ = bh_ & 15; \
        _Pragma("unroll") for (int i = 0; i < 16; ++i) nfz[i] = FZ[(t0_ + 16 * part + i) * DM + h_ * 128 + k]; \
        _Pragma("unroll") for (int r = 0; r < 2; ++r) { const int idx = tid + 512 * r, row = idx >> 4, ch = idx & 15; nit_[r] = *(const u32x4*)(I1 + (t0_ + row) * DM + h_ * 128 + ch * 8); } }
    if ((int)blockIdx.x < 2 * NHEAD * 128) SA_LOAD((int)blockIdx.x)
    int qiter = 0;
    for (int item = blockIdx.x; item < 2 * NHEAD * 128; item += gridDim.x, ++qiter) {
        const int bh = item >> 7, c = item & 127, b = bh >> 4, h = bh & 15;
        const size_t tok0 = (size_t)b * SEQ + c * 64;
        float lf[16];
        const float lbk = LB[h * 128 + k];
#pragma unroll
        for (int i = 0; i < 16; ++i) lf[i] = logf_gate(bf2f(nfz[i]), lbk);
#pragma unroll
        for (int r = 0; r < 2; ++r) { const int idx = tid + 512 * r, row = idx >> 4, ch = idx & 15; *(LAS u32x4*)(Iimg + off_b(row, ch)) = nit_[r]; }
        if (item + (int)gridDim.x < 2 * NHEAD * 128) SA_LOAD(item + (int)gridDim.x)
        const int qrow = qiter * (int)gridDim.x * 8 + (int)blockIdx.x * 8 + wv; const bool doq = qrow < 32768; f32x4 qv8[8];
        if (doq) qrow_issue(qv8, qj_src(qj, qrow), lane);
        float cs = 0.f;
#pragma unroll
        for (int i = 0; i < 16; ++i) cs += lf[i];
        psum[part * 128 + k] = cs;
        __syncthreads();
        const float p0 = psum[k], p1 = psum[128 + k], p2 = psum[256 + k], p3 = psum[384 + k];
        const float blast = (p0 + p1) + (p2 + p3);
        float bb = part == 0 ? 0.f : (part == 1 ? p0 : (part == 2 ? p0 + p1 : p0 + p1 + p2));
#pragma unroll
        for (int i = 0; i < 16; ++i) {
            bb += lf[i];
            const float kt = (1.0f - __expf(lf[i])) * __expf(blast - bb);
            if (!(kt - kt == 0.f)) ++dbg_kt;
            const int srow = 16 * part + i;
            *(LAS bf16_t*)(KTimg + off_b(srow, k >> 3) + 2 * (k & 7)) = (bf16_t)(pk_bf16(kt, 0.f) & 0xffffu);
        }
        if (part == 0) DEC[(size_t)item * 128 + k] = __expf(blast);
        __syncthreads();
#if SCAN_A_VALU
        for (int idx = tid; idx < 16384; idx += 512) {
            const int v = idx >> 7, kk = idx & 127;
            float accv = 0.f;
            for (int s2 = 0; s2 < 64; ++s2) accv += bf2f(*(const LAS bf16_t*)(Iimg + off_b(s2, v >> 3) + 2 * (v & 7))) * bf2f(*(const LAS bf16_t*)(KTimg + off_b(s2, kk >> 3) + 2 * (kk & 7)));
            *(LAS bf16_t*)(Lst + v * 272 + 2 * kk) = (bf16_t)(pk_bf16(accv, 0.f) & 0xffffu);
        }
        if (0)
#endif
        {
            const int vt = wv >> 1;
            f32x16 acc0, acc1;
#pragma unroll
            for (int e = 0; e < 16; ++e) { acc0[e] = 0.f; acc1[e] = 0.f; }
#pragma unroll
            for (int ks = 0; ks < 4; ++ks) {
                const bf16x8 af = tr_frag(Iimg, lane, vt, ks);
                const bf16x8 b0 = tr_frag(KTimg, lane, 2 * (wv & 1), ks), b1 = tr_frag(KTimg, lane, 2 * (wv & 1) + 1, ks);
                acc0 = __builtin_amdgcn_mfma_f32_32x32x16_bf16(af, b0, acc0, 0, 0, 0);
                acc1 = __builtin_amdgcn_mfma_f32_32x32x16_bf16(af, b1, acc1, 0, 0, 0);
            }
            const int r32 = lane & 31, hh = lane >> 5;
#pragma unroll
            for (int e = 0; e < 16; ++e) {
                if (!(acc0[e] - acc0[e] == 0.f)) ++dbg_acc; if (!(acc1[e] - acc1[e] == 0.f)) ++dbg_acc;
                const int v = 32 * vt + (e & 3) + 8 * (e >> 2) + 4 * hh;
                *(LAS bf16_t*)(Lst + v * 272 + 2 * (64 * (wv & 1) + r32)) = (bf16_t)(pk_bf16(acc0[e], 0.f) & 0xffffu);
                *(LAS bf16_t*)(Lst + v * 272 + 2 * (64 * (wv & 1) + 32 + r32)) = (bf16_t)(pk_bf16(acc1[e], 0.f) & 0xffffu);
            }
        }
        __syncthreads();
#pragma unroll
        for (int r = 0; r < 4; ++r) { const int idx = tid + 512 * r, row = idx >> 4, ch = idx & 15; *(u32x4*)(LT + (size_t)item * 16384 + row * 128 + ch * 8) = *(const LAS u32x4*)(Lst + row * 272 + ch * 16); }
        if (doq) qrow_finish(qv8, qj_dst(qj, qrow), qj_scl(qj, qrow), lane, qrow >= 16384);
        __syncthreads();
    }
    qj_tail(qj, qiter);
    if (dbgc) { if (dbg_kt) atomicAdd(dbgc + 0, dbg_kt); if (dbg_acc) atomicAdd(dbgc + 1, dbg_acc); }
}
__device__ __forceinline__ void phase_scan_b(bf16_t* LT, const float* DEC, const QuantJob qj) {
    const int n = 2 * NHEAD * 128 * 32;
    const int lane = threadIdx.x & 63, gw = blockIdx.x * 8 + (threadIdx.x >> 6), nw = gridDim.x * 8;
    int qdone = 0;
    for (int idx = blockIdx.x * 512 + threadIdx.x; idx < n; idx += gridDim.x * 512) {
        const int bh = idx >> 12, vk = idx & 4095, k4 = (vk & 31) * 4;
        float S0 = 0.f, S1 = 0.f, S2 = 0.f, S3 = 0.f;
        bf16_t* p = LT + (size_t)bh * 128 * 16384 + (size_t)vk * 4;
        const float* dp = DEC + (size_t)bh * 128 * 128 + k4;
        for (int c8 = 0; c8 < 16; ++c8) {
            const int qrow = (qdone + c8) * nw + gw; const bool doq = qrow < 32768; f32x4 qv8[8];
            if (doq) qrow_issue(qv8, qj_src(qj, qrow), lane);
#pragma unroll
            for (int c2 = 0; c2 < 8; ++c2) {
                const int c = c8 * 8 + c2;
                const u32x2 w = *(const u32x2*)(p + (size_t)c * 16384);
                const f32x4 d = *(const f32x4*)(dp + c * 128);
                u32x2 o; o.x = pk_bf16(S0, S1); o.y = pk_bf16(S2, S3);
                *(u32x2*)(p + (size_t)c * 16384) = o;
                S0 = d[0] * S0 + bflo(w.x); S1 = d[1] * S1 + bfhi(w.x); S2 = d[2] * S2 + bflo(w.y); S3 = d[3] * S3 + bfhi(w.y);
            }
            if (doq) qrow_finish(qv8, qj_dst(qj, qrow), qj_scl(qj, qrow), lane, qrow >= 16384);
        }
        qdone += 16;
    }
    qj_tail(qj, qdone);
}
__device__ __forceinline__ void phase_scan_c(LAS unsigned char* lds, const bf16_t* Q1, const bf16_t* FZ, const float* LB, const bf16_t* I1, const bf16_t* G1, const bf16_t* SP, const float* gnorm, bf16_t* OG) {
    const int tid = threadIdx.x, lane = tid & 63, wv = tid >> 6, k = tid & 127, part = tid >> 7, r32 = lane & 31, hh = lane >> 5;
    LAS unsigned char* QTimg = lds; LAS unsigned char* QPimg = lds + 16384; LAS unsigned char* KPimg = lds + 32768; LAS unsigned char* Iimg = lds + 49152; LAS unsigned char* SPimg = lds + 65536;
    LAS float* psum = (LAS float*)(lds + 98304);
    LAS float* ssq = (LAS float*)(lds + 100352);
    LAS unsigned char* OT = lds + 102400;
    bf16_t nfz[16], nq[16]; u32x4 nit_[2], nsp[4], ngt[2];
#define SC_LOAD(item_) { const int bh_ = (item_) >> 7, c_ = (item_) & 127; const size_t t0_ = (size_t)(bh_ >> 4) * SEQ + c_ * 64; const int h_ = bh_ & 15; \
        _Pragma("unroll") for (int i = 0; i < 16; ++i) { const size_t o_ = (t0_ + 16 * part + i) * DM + h_ * 128 + k; nfz[i] = FZ[o_]; nq[i] = Q1[o_]; } \
        _Pragma("unroll") for (int r = 0; r < 2; ++r) { const int idx = tid + 512 * r, row = idx >> 4, ch = idx & 15; nit_[r] = *(const u32x4*)(I1 + (t0_ + row) * DM + h_ * 128 + ch * 8); ngt[r] = *(const u32x4*)(G1 + (t0_ + row) * DM + h_ * 128 + ch * 8); } \
        _Pragma("unroll") for (int r = 0; r < 4; ++r) { const int idx = tid + 512 * r, row = idx >> 4, ch = idx & 15; nsp[r] = *(const u32x4*)(SP + (size_t)(item_) * 16384 + row * 128 + ch * 8); } }
    if ((int)blockIdx.x < 2 * NHEAD * 128) SC_LOAD((int)blockIdx.x)
    for (int item = blockIdx.x; item < 2 * NHEAD * 128; item += gridDim.x) {
        const int bh = item >> 7, c = item & 127, b = bh >> 4, h = bh & 15;
        const size_t tok0 = (size_t)b * SEQ + c * 64;
        float lf[16], qv[16];
        const float lbk = LB[h * 128 + k];
#pragma unroll
        for (int i = 0; i < 16; ++i) { lf[i] = logf_gate(bf2f(nfz[i]), lbk); const float qr = bf2f(nq[i]); qv[i] = qr * sigmoidf_(qr); }
#pragma unroll
        for (int r = 0; r < 2; ++r) { const int idx = tid + 512 * r, row = idx >> 4, ch = idx & 15; *(LAS u32x4*)(Iimg + off_b(row, ch)) = nit_[r]; }
#pragma unroll
        for (int r = 0; r < 4; ++r) { const int idx = tid + 512 * r, row = idx >> 4, ch = idx & 15; *(LAS u32x4*)(SPimg + off_b(row, ch)) = nsp[r]; }
        const u32x4 gcur0 = ngt[0], gcur1 = ngt[1];
        if (item + (int)gridDim.x < 2 * NHEAD * 128) SC_LOAD(item + (int)gridDim.x)
        float cs = 0.f;
#pragma unroll
        for (int i = 0; i < 16; ++i) cs += lf[i];
        psum[part * 128 + k] = cs;
        __syncthreads();
        const float p0 = psum[k], p1 = psum[128 + k], p2 = psum[256 + k];
        const float rr = p0 + p1;
        float bb = part == 0 ? 0.f : (part == 1 ? p0 : (part == 2 ? p0 + p1 : p0 + p1 + p2));
#pragma unroll
        for (int i = 0; i < 16; ++i) {
            bb += lf[i];
            const float qt = qv[i] * __expf(bb), qp = qv[i] * __expf(bb - rr), kp = (1.0f - __expf(lf[i])) * __expf(rr - bb);
            const unsigned o = off_b(16 * part + i, k >> 3) + 2 * (k & 7);
            *(LAS bf16_t*)(QTimg + o) = (bf16_t)(pk_bf16(qt, 0.f) & 0xffffu);
            *(LAS bf16_t*)(QPimg + o) = (bf16_t)(pk_bf16(qp, 0.f) & 0xffffu);
            *(LAS bf16_t*)(KPimg + o) = (bf16_t)(pk_bf16(kp, 0.f) & 0xffffu);
        }
        __syncthreads();
        const int tt = wv & 1, vt = wv >> 1;
        f32x16 O;
#pragma unroll
        for (int e = 0; e < 16; ++e) O[e] = 0.f;
#pragma unroll
        for (int ks = 0; ks < 8; ++ks) {
            const bf16x8 af = *(const LAS bf16x8*)(SPimg + off_b(32 * vt + r32, 2 * ks + hh));
            const bf16x8 bf = *(const LAS bf16x8*)(QTimg + off_b(32 * tt + r32, 2 * ks + hh));
            O = __builtin_amdgcn_mfma_f32_32x32x16_bf16(af, bf, O, 0, 0, 0);
        }
        const unsigned krow = pi32((unsigned)r32);
        for (int st = 0; st <= tt; ++st) {
            f32x16 S;
#pragma unroll
            for (int e = 0; e < 16; ++e) S[e] = 0.f;
#pragma unroll
            for (int ks = 0; ks < 8; ++ks) {
                const bf16x8 af = *(const LAS bf16x8*)(KPimg + off_b(32 * st + krow, 2 * ks + hh));
                const bf16x8 bf = *(const LAS bf16x8*)(QPimg + off_b(32 * tt + r32, 2 * ks + hh));
                S = __builtin_amdgcn_mfma_f32_32x32x16_bf16(af, bf, S, 0, 0, 0);
            }
            float p[16];
#pragma unroll
            for (int e = 0; e < 16; ++e) {
                const unsigned m = (e & 3) + 8 * (e >> 2) + 4 * hh;
                const int sidx = 32 * st + (int)pi32(m), tidx = 32 * tt + r32;
                p[e] = sidx <= tidx ? S[e] : 0.f;
            }
            u32x4 w0, w1;
            w0.x = pk_bf16(p[0], p[1]); w0.y = pk_bf16(p[2], p[3]); w0.z = pk_bf16(p[4], p[5]); w0.w = pk_bf16(p[6], p[7]);
            w1.x = pk_bf16(p[8], p[9]); w1.y = pk_bf16(p[10], p[11]); w1.z = pk_bf16(p[12], p[13]); w1.w = pk_bf16(p[14], p[15]);
            const bf16x8 pf0 = __builtin_bit_cast(bf16x8, w0), pf1 = __builtin_bit_cast(bf16x8, w1);
            const bf16x8 i0 = tr_frag(Iimg, lane, vt, 2 * st), i1 = tr_frag(Iimg, lane, vt, 2 * st + 1);
            O = __builtin_amdgcn_mfma_f32_32x32x16_bf16(i0, pf0, O, 0, 0, 0);
            O = __builtin_amdgcn_mfma_f32_32x32x16_bf16(i1, pf1, O, 0, 0, 0);
        }
        float sq = 0.f;
#pragma unroll
        for (int e = 0; e < 16; ++e) sq += O[e] * O[e];
        sq += __shfl_xor(sq, 32);
        if (hh == 0) ssq[vt * 64 + 32 * tt + r32] = sq;
        __syncthreads();
        const int tl = 32 * tt + r32;
        const float rstd = rsqrtf((ssq[tl] + ssq[64 + tl] + ssq[128 + tl] + ssq[192 + tl]) * (1.0f / 128.0f) + 1e-6f);
#pragma unroll
        for (int g = 0; g < 4; ++g) {
            const int v0 = 32 * vt + 8 * g + 4 * hh;
            const f32x4 gn = *(const f32x4*)(gnorm + v0);
            u32x2 w; w.x = pk_bf16(O[4 * g] * rstd * gn[0], O[4 * g + 1] * rstd * gn[1]); w.y = pk_bf16(O[4 * g + 2] * rstd * gn[2], O[4 * g + 3] * rstd * gn[3]);
            *(LAS u32x2*)(OT + tl * 272 + v0 * 2) = w;
        }
        __syncthreads();
#pragma unroll
        for (int r = 0; r < 2; ++r) {
            const int idx = tid + 512 * r, row = idx >> 4, ch = idx & 15;
            const u32x4 ov = *(const LAS u32x4*)(OT + row * 272 + ch * 16);
            const size_t go = (tok0 + row) * DM + h * 128 + ch * 8;
            const u32x4 gv = r == 0 ? gcur0 : gcur1;
            u32x4 w;
#define SILU_(x_) ((x_) * sigmoidf_(x_))
            w.x = pk_bf16(bflo(ov.x) * SILU_(bflo(gv.x)), bfhi(ov.x) * SILU_(bfhi(gv.x))); w.y = pk_bf16(bflo(ov.y) * SILU_(bflo(gv.y)), bfhi(ov.y) * SILU_(bfhi(gv.y)));
            w.z = pk_bf16(bflo(ov.z) * SILU_(bflo(gv.z)), bfhi(ov.z) * SILU_(bfhi(gv.z))); w.w = pk_bf16(bflo(ov.w) * SILU_(bflo(gv.w)), bfhi(ov.w) * SILU_(bfhi(gv.w)));
#undef SILU_
            *(u32x4*)(OG + go) = w;
        }
        __syncthreads();
    }
}


#if SCAN_DBG == 2
__device__ __forceinline__ void dbg_compare(LAS float* red, const bf16_t* A, const bf16_t* B, float* DBG) {
    float sd = 0.f, sr = 0.f, nn = 0.f;
    const size_t n = (size_t)MTOK * DM;
    for (size_t i = (size_t)blockIdx.x * 512 + threadIdx.x; i < n; i += (size_t)gridDim.x * 512) {
        const float x = bf2f(A[i]), y = bf2f(B[i]);
        if (!(x - x == 0.f)) nn += 1.f; else { sd += (x - y) * (x - y); sr += y * y; }
    }
    sd = wave_sum(sd); sr = wave_sum(sr); nn = wave_sum(nn);
    const int wv = threadIdx.x >> 6;
    if ((threadIdx.x & 63) == 0) { red[wv * 3] = sd; red[wv * 3 + 1] = sr; red[wv * 3 + 2] = nn; }
    __syncthreads();
    if (threadIdx.x == 0) { float a = 0, b = 0, c = 0; for (int w = 0; w < 8; ++w) { a += red[w * 3]; b += red[w * 3 + 1]; c += red[w * 3 + 2]; } DBG[blockIdx.x * 4] = a; DBG[blockIdx.x * 4 + 1] = b; DBG[blockIdx.x * 4 + 2] = c; }
    __syncthreads();
}
__device__ __forceinline__ void dbg_emit(const float* DBG, float* out) {
    float a = 0, b = 0, c = 0;
    for (int w = 0; w < (int)gridDim.x; ++w) { a += DBG[w * 4]; b += DBG[w * 4 + 1]; c += DBG[w * 4 + 2]; }
    const float rel = sqrtf(a / b);
    int k = (int)rintf(-2.0f * log10f(rel)); k = k < 0 ? 0 : (k > 16 ? 16 : k);
    if (c > 0.f) k = 17;
    const float cc = sqrtf(0.5f * (float)k);
    const size_t n = (size_t)MTOK * DM;
    for (size_t i = (size_t)blockIdx.x * 512 + threadIdx.x; i < n; i += (size_t)gridDim.x * 512) out[i] = cc;
}
#endif

#if SCAN_DBG == 3
__device__ __forceinline__ void dbg_count_bf16(const bf16_t* A, size_t n, unsigned* cnt) {
    unsigned c = 0;
    for (size_t i = (size_t)blockIdx.x * 512 + threadIdx.x; i < n; i += (size_t)gridDim.x * 512) { const float x = bf2f(A[i]); if (!(x - x == 0.f)) ++c; }
    if (c) atomicAdd(cnt, c);
}
__device__ __forceinline__ void dbg_count_f32(const float* A, size_t n, unsigned* cnt) {
    unsigned c = 0;
    for (size_t i = (size_t)blockIdx.x * 512 + threadIdx.x; i < n; i += (size_t)gridDim.x * 512) { const float x = A[i]; if (!(x - x == 0.f)) ++c; }
    if (c) atomicAdd(cnt, c);
}
__device__ __forceinline__ void dbg_emit3(const unsigned* cnt, float* out) {
    float code = 0.f;
    for (int st = 3; st >= 0; --st) { const unsigned c = cnt[st]; if (c) { float lg = log10f((float)c); lg = lg > 9.f ? 9.f : lg; code = (float)(st + 1) + 0.1f * lg; } }
    const float cc = sqrtf(code);
    const size_t n = (size_t)MTOK * DM;
    for (size_t i = (size_t)blockIdx.x * 512 + threadIdx.x; i < n; i += (size_t)gridDim.x * 512) out[i] = cc;
}
#endif

#if SCAN_DBG == 4 || SCAN_DBG == 6
__device__ __forceinline__ void dbg_compare4(LAS float* red, const bf16_t* A, const bf16_t* B, const bf16_t* C, float* DBG) {
    float sd = 0.f, sr = 0.f, nn = 0.f, mm = 0.f;
    const size_t n = (size_t)MTOK * DM;
    for (size_t i = (size_t)blockIdx.x * 512 + threadIdx.x; i < n; i += (size_t)gridDim.x * 512) {
        const float x = bf2f(A[i]), y = bf2f(B[i]);
        if (!(x - x == 0.f)) nn += 1.f; else { sd += (x - y) * (x - y); sr += y * y; }
        if (A[i] != C[i]) mm += 1.f;
    }
    sd = wave_sum(sd); sr = wave_sum(sr); nn = wave_sum(nn); mm = wave_sum(mm);
    const int wv = threadIdx.x >> 6;
    if ((threadIdx.x & 63) == 0) { red[wv * 4] = sd; red[wv * 4 + 1] = sr; red[wv * 4 + 2] = nn; red[wv * 4 + 3] = mm; }
    __syncthreads();
    if (threadIdx.x == 0) { float a = 0, b = 0, c = 0, d = 0; for (int w = 0; w < 8; ++w) { a += red[w * 4]; b += red[w * 4 + 1]; c += red[w * 4 + 2]; d += red[w * 4 + 3]; }
        DBG[blockIdx.x * 4] = a; DBG[blockIdx.x * 4 + 1] = b; DBG[blockIdx.x * 4 + 2] = c; DBG[blockIdx.x * 4 + 3] = d; }
    __syncthreads();
}
__device__ __forceinline__ void dbg_emit4(const float* DBG, float* out) {
    float a = 0, b = 0, c = 0, d = 0;
    for (int w = 0; w < (int)gridDim.x; ++w) { a += DBG[w * 4]; b += DBG[w * 4 + 1]; c += DBG[w * 4 + 2]; d += DBG[w * 4 + 3]; }
    const float rel = sqrtf(a / b);
    int k = (int)rintf(-log10f(rel)); k = k < 0 ? 0 : (k > 8 ? 8 : k);
#if SCAN_DBG == 6
    const float cc = sqrtf((float)k + ((d + c) > 0.f ? 0.5f : 0.f));
#else
    int m = (int)ceilf(log10f(1.0f + d + c)); m = m > 9 ? 9 : m;
    const float cc = sqrtf((float)k + 0.1f * (float)m);
#endif
    const size_t n = (size_t)MTOK * DM;
    for (size_t i = (size_t)blockIdx.x * 512 + threadIdx.x; i < n; i += (size_t)gridDim.x * 512) out[i] = cc;
}
#endif

#if SCAN_DBG == 5
__device__ __forceinline__ void dbg_lds16_test(LAS unsigned char* lds, unsigned* cnt) {
    const int tid = threadIdx.x;
    unsigned bad = 0;
    for (int rep = 0; rep < 64; ++rep) {
        for (int i = tid; i < 1024; i += 512) *(LAS u32x4*)(lds + i * 16) = (u32x4){0x7fc07fc0u, 0x7fc07fc0u, 0x7fc07fc0u, 0x7fc07fc0u};
        __syncthreads();
        const int k = tid & 127, part = tid >> 7;
#pragma unroll
        for (int i = 0; i < 16; ++i) {
            const int row = 16 * part + i;
            *(LAS bf16_t*)(lds + off_b(row, k >> 3) + 2 * (k & 7)) = (bf16_t)((row * 128 + k + rep) & 0x7fff);
        }
        __syncthreads();
        for (int idx = tid; idx < 64 * 128; idx += 512) {
            const int row = idx >> 7, kk = idx & 127;
            const bf16_t got = *(const LAS bf16_t*)(lds + off_b(row, kk >> 3) + 2 * (kk & 7));
            if (got != (bf16_t)((row * 128 + kk + rep) & 0x7fff)) ++bad;
        }
        __syncthreads();
    }
    if (bad) atomicAdd(cnt, bad);
}
__device__ __forceinline__ void dbg_emit5(const unsigned* cnt, float* out) {
    const unsigned c = cnt[0];
    float code = 0.f;
    if (c) { float lg = log10f((float)c); code = 1.0f + (lg > 8.9f ? 8.9f : lg); }
    const float cc = sqrtf(code);
    const size_t n = (size_t)MTOK * DM;
    for (size_t i = (size_t)blockIdx.x * 512 + threadIdx.x; i < n; i += (size_t)gridDim.x * 512) out[i] = cc;
}
#endif

#if SCAN_DBG == 6
__device__ __forceinline__ void dbg_check_a(LAS float* red, const float* LF, const bf16_t* I1, const bf16_t* LT, const bf16_t* LT2, float* DBG) {
    float sd = 0.f, sr = 0.f, mm = 0.f;
    const size_t n = (size_t)4096 * 16384;
    for (size_t i = (size_t)blockIdx.x * 512 + threadIdx.x; i < n; i += (size_t)gridDim.x * 512) {
        const int item = (int)(i >> 14), v = (int)((i >> 7) & 127), k = (int)(i & 127);
        const int bh = item >> 7, c = item & 127, b = bh >> 4, h = bh & 15;
        const size_t tok0 = (size_t)b * SEQ + c * 64;
        float g = 1.f, L = 0.f;
        for (int s2 = 63; s2 >= 0; --s2) {
            const size_t o = (tok0 + s2) * DM + h * 128;
            const float f = __expf(LF[o + k]);
            L += bf2f(I1[o + v]) * (1.0f - f) * g;
            g *= f;
        }
        const float x = bf2f(LT[i]);
        sd += (x - L) * (x - L); sr += L * L;
        if (LT[i] != LT2[i]) mm += 1.f;
    }
    sd = wave_sum(sd); sr = wave_sum(sr); mm = wave_sum(mm);
    const int wv = threadIdx.x >> 6;
    if ((threadIdx.x & 63) == 0) { red[wv * 4] = sd; red[wv * 4 + 1] = sr; red[wv * 4 + 2] = 0.f; red[wv * 4 + 3] = mm; }
    __syncthreads();
    if (threadIdx.x == 0) { float a = 0, b2 = 0, d = 0; for (int w = 0; w < 8; ++w) { a += red[w * 4]; b2 += red[w * 4 + 1]; d += red[w * 4 + 3]; }
        DBG[blockIdx.x * 4] = a; DBG[blockIdx.x * 4 + 1] = b2; DBG[blockIdx.x * 4 + 2] = 0.f; DBG[blockIdx.x * 4 + 3] = d; }
    __syncthreads();
}
#endif

#if SCAN_DBG == 7
#ifndef DBG_FAM
#define DBG_FAM 0
#endif
__device__ __forceinline__ void dbg_check_a7(const float* LF, const bf16_t* I1, const bf16_t* LT, float* DBG) {
    const size_t n = (size_t)4096 * 16384;
    float nbad = 0.f, nnf = 0.f;
    for (size_t i = (size_t)blockIdx.x * 512 + threadIdx.x; i < n; i += (size_t)gridDim.x * 512 * 8) {
        const int item = (int)(i >> 14), v = (int)((i >> 7) & 127), k = (int)(i & 127);
        const int bh = item >> 7, c = item & 127, b = bh >> 4, h = bh & 15;
        const size_t tok0 = (size_t)b * SEQ + c * 64;
        float g = 1.f, L = 0.f;
        for (int s2 = 63; s2 >= 0; --s2) {
            const size_t o = (tok0 + s2) * DM + h * 128;
            const float f = __expf(LF[o + k]);
            L += bf2f(I1[o + v]) * (1.0f - f) * g;
            g *= f;
        }
        const float x = bf2f(LT[i]);
        if (!(x - x == 0.f)) { nnf += 1.f; nbad += 1.f; }
        else if (fabsf(x - L) > 0.02f * fabsf(L) + 1e-2f) nbad += 1.f;
    }
    nbad = wave_sum(nbad); nnf = wave_sum(nnf);
    if ((threadIdx.x & 63) == 0) { atomicAdd(DBG, nbad); atomicAdd(DBG + 1, nnf); }
}
__device__ __forceinline__ void dbg_emit7(const float* DBG, float* out) {
    const float nb = DBG[0], nf = DBG[1];
    int A = nb == 0.f ? 0 : (nb <= 100.f ? 1 : (nb <= 1e4f ? 3 : (nb <= 1e6f ? 5 : 7)));
    int B = nf == 0.f ? 0 : 5;
    const float cc = sqrtf((float)A + 0.1f * (float)B);
    const size_t n = (size_t)MTOK * DM;
    for (size_t i = (size_t)blockIdx.x * 512 + threadIdx.x; i < n; i += (size_t)gridDim.x * 512) out[i] = cc;
}
#endif
__device__ __forceinline__ int opaque(int v) { asm volatile("" : "+s"(v)); return v; }
template <bool L1> __device__ __forceinline__ void run_gemm_out(const Args& a, LAS unsigned char* lds) {
    unsigned char* ws = a.ws;
    pg8::Gemm g{(const bf16_t*)(ws + (L1 ? slot(3) : slot(0))), (const bf16_t*)(ws + (L1 ? WS_WO : WS_WOUT)), opaque(MTOK), opaque(DM), opaque(L1 ? DM / 2 : DM)};
    pg8::StaticOrder S; S.init(g.M, g.N, (int)gridDim.x, (int)blockIdx.x);
    EpiKVQ_<L1> E{(bf16_t*)(ws + (L1 ? slot(4) : slot(1))), (const float*)(ws + WS_XSO), (const float*)(ws + WS_SWO)};
    pg8::gemm_phase<EpiKVQ_<L1>, pg8::StaticOrder>(lds, g, S, E, nullptr);
}
template <bool L1> __device__ __forceinline__ void run_ln(const Args& a) {
    unsigned char* ws = a.ws;
    phase_ln<L1>((const bf16_t*)(ws + (L1 ? slot(4) : slot(1))), L1 ? (const void*)(ws + slot(2)) : (const void*)a.in[0], a.in[12] + (L1 ? 2 : 0) * DM, a.in[13] + (L1 ? 2 : 0) * DM,
                 (float*)nullptr, (bf16_t*)(ws + (L1 ? slot(8) : slot(5))), (signed char*)(ws + WS_XQ), (float*)(ws + WS_XS));
}
template <bool L1> __device__ __forceinline__ void run_gemm_sc(const Args& a, LAS unsigned char* lds) {
    unsigned char* ws = a.ws;
#if SC8
    pg8::Gemm g{(const bf16_t*)(ws + WS_WC8 + (L1 ? (size_t)DM * DM : 0)), (const bf16_t*)(ws + WS_XQ), opaque(DM), opaque(MTOK), opaque(DM / 2)};
    pg8::StaticOrder S; S.init(g.M, g.N, (int)gridDim.x, (int)blockIdx.x);
    EpiF32_<true> E{(float*)(ws + (L1 ? slot(0) : slot(6))), MTOK, (const float*)(ws + WS_SWC) + (L1 ? DM : 0), (const float*)(ws + WS_XS)};
    pg8::gemm_phase<EpiF32_<true>, pg8::StaticOrder>(lds, g, S, E, nullptr);
#else
    pg8::Gemm g{(const bf16_t*)(ws + WS_WC) + (L1 ? (size_t)DM * DM : 0), (const bf16_t*)(ws + (L1 ? slot(8) : slot(5))), opaque(DM), opaque(MTOK), opaque(DM)};
    pg8::StaticOrder S; S.init(g.M, g.N, (int)gridDim.x, (int)blockIdx.x);
    EpiF32 E{(float*)(ws + (L1 ? slot(0) : slot(6))), MTOK, nullptr, nullptr};
    pg8::gemm_phase<EpiF32, pg8::StaticOrder>(lds, g, S, E, nullptr);
#endif
}
template <bool L1> __device__ __forceinline__ void run_topk(const Args& a, LAS unsigned char* lds) {
    unsigned char* ws = a.ws;
    phase_topk(lds, (const float*)(ws + (L1 ? slot(0) : slot(6))), (int*)(ws + WS_EID), (float*)(ws + WS_GATE));
}
template <bool L1> __device__ __forceinline__ void run_peer(const Args& a, LAS unsigned char* lds) {
    unsigned char* ws = a.ws;
    LAS int* HL = (LAS int*)(lds + (threadIdx.x >> 6) * 8192);
    float* Y = (float*)(ws + (L1 ? slot(0) : slot(6)));
    phase_peer_u((const signed char*)(ws + WS_XQ), (const int*)(ws + WS_EID), ws + WS_UB + (L1 ? (size_t)16384 * DM : 0), HL);
    asm volatile("s_waitcnt vmcnt(0) lgkmcnt(0)" ::: "memory");
    phase_peer_w(HL, (const float*)(ws + WS_XS), (const int*)(ws + WS_EID), (const float*)(ws + WS_GATE),
                 (const float*)(ws + WS_USC) + (L1 ? 16384 : 0), (const float*)(ws + WS_VSC) + (L1 ? 16384 : 0), (signed char*)(ws + WS_W), (float*)(ws + WS_CS));
    asm volatile("s_waitcnt vmcnt(0)" ::: "memory");
    phase_peer_v((const bf16_t*)(ws + (L1 ? slot(8) : slot(5))), (const int*)(ws + WS_EID), (const signed char*)(ws + WS_W), (const float*)(ws + WS_CS),
                 ws + WS_VB + (L1 ? (size_t)16384 * DM : 0), Y);
    asm volatile("s_waitcnt vmcnt(0)" ::: "memory");
    {
        const int lane = threadIdx.x & 63, gw = blockIdx.x * 8 + (threadIdx.x >> 6), nw = gridDim.x * 8, tpw = (MTOK + nw - 1) / nw, tbase = gw * tpw;
        const int tend = tbase + tpw < MTOK ? tbase + tpw : MTOK;
        const float* g = a.in[12] + (L1 ? 3 : 1) * DM; const float* bta = a.in[13] + (L1 ? 3 : 1) * DM;
        float* outf = L1 ? a.out : (float*)nullptr; bf16_t* outb = L1 ? (bf16_t*)nullptr : (bf16_t*)(ws + slot(2));
        for (int row = tbase; row < tend; ++row) {
            float v[32];
            const float* p = Y + (size_t)row * DM;
#pragma unroll
            for (int i = 0; i < 4; ++i) {
                const f32x4 x0 = *(const f32x4*)(p + 512 * i + 8 * lane), x1 = *(const f32x4*)(p + 512 * i + 8 * lane + 4);
#pragma unroll
                for (int j = 0; j < 4; ++j) { v[i * 8 + j] = x0[j]; v[i * 8 + 4 + j] = x1[j]; }
            }
            ln_row_store(v, g, bta, outf ? outf + (size_t)row * DM : nullptr, outb ? outb + (size_t)row * DM : nullptr, lane,
                         L1 ? (signed char*)nullptr : (signed char*)(ws + slot(1)) + (size_t)row * DM, L1 ? (float*)nullptr : (float*)(ws + WS_XS1) + row);
        }
    }
}


#define XB_TMO      128
#define XB_XCNT(j)  (256  + 64 * (j))
#define XB_XSUB(j)  (1280 + 64 * (j))
#define XB_XGEN(j)  (2304 + 64 * (j))
#define XB_TOP      3328
#define XB_TOPGEN   3392
#define XCD_BAR_WORDS 3456
#define XB_SPIN_CAP (1u << 20)
__device__ __forceinline__ unsigned xb_ld(unsigned* p)              { return __hip_atomic_load(p, __ATOMIC_RELAXED, __HIP_MEMORY_SCOPE_AGENT); }
__device__ __forceinline__ unsigned xb_add(unsigned* p, unsigned v) { return __hip_atomic_fetch_add(p, v, __ATOMIC_RELAXED, __HIP_MEMORY_SCOPE_AGENT); }
__device__ __forceinline__ unsigned xb_xcc_id() { return (unsigned)__builtin_amdgcn_s_getreg((3 << 11) | 20) & 0xFu; }
#define XB_SPIN(cond, bar) do { unsigned _sp = 0; while (cond) { __builtin_amdgcn_s_sleep(1); \
    if ((++_sp & 255u) == 0u) { if (xb_ld(&(bar)[XB_TMO])) break; if (_sp > XB_SPIN_CAP) { atomicAdd(&(bar)[XB_TMO], 1u); break; } } } } while (0)
struct XcdBarrier { unsigned* bar; unsigned x; volatile LAS unsigned* st; };
__device__ __forceinline__ XcdBarrier xcd_barrier_post(unsigned* bar, volatile LAS unsigned* st) {
    XcdBarrier b; b.bar = bar; b.x = xb_xcc_id(); b.st = st;
    if (threadIdx.x == 0) (void)xb_add(&bar[XB_XCNT(b.x)], 1u);
    return b;
}
__device__ __forceinline__ void xcd_barrier_complete(unsigned* bar, unsigned x, unsigned& nloc, unsigned& nx) {
    const unsigned G = gridDim.x * gridDim.y * gridDim.z;
    unsigned sum, cnt, mine, sp = 0u;
    for (;;) {
        sum = 0u; cnt = 0u; mine = 0u;
#pragma unroll
        for (unsigned j = 0; j < 16; ++j) { const unsigned c = xb_ld(&bar[XB_XCNT(j)]); sum += c; cnt += (c > 0u) ? 1u : 0u; mine = (j == x) ? c : mine; }
        if (sum == G) break;
        __builtin_amdgcn_s_sleep(1);
        if ((++sp & 255u) == 0u) { if (xb_ld(&bar[XB_TMO])) break; if (sp > XB_SPIN_CAP) { atomicAdd(&bar[XB_TMO], 1u); break; } }
    }
    nloc = mine > 0u ? mine : 1u; nx = cnt > 0u ? cnt : 1u;
}
__device__ __forceinline__ void xcd_barrier(const XcdBarrier& b) {
    asm volatile("s_waitcnt vmcnt(0)" ::: "memory");
    __syncthreads();
    if (threadIdx.x == 0) {
        unsigned* bar = b.bar;
        __builtin_amdgcn_s_waitcnt(0);
        unsigned nloc = b.st[0], nx = b.st[1];
        if (nloc == 0u) { xcd_barrier_complete(bar, b.x, nloc, nx); b.st[0] = nloc; b.st[1] = nx; }
        const unsigned old = xb_add(&bar[XB_XSUB(b.x)], 1u);
        const unsigned gen = old / nloc;
        if (old + 1u == (gen + 1u) * nloc) {
            __builtin_amdgcn_fence(__ATOMIC_RELEASE, "agent");
            asm volatile("s_waitcnt vmcnt(0)" ::: "memory");
            const unsigned og = xb_add(&bar[XB_TOP], 1u);
            const unsigned tg = og / nx;
            if (og + 1u == (tg + 1u) * nx) xb_add(&bar[XB_TOPGEN], 1u);
            else XB_SPIN(xb_ld(&bar[XB_TOPGEN]) == tg, bar);
            __builtin_amdgcn_fence(__ATOMIC_ACQUIRE, "agent");
            xb_add(&bar[XB_XGEN(b.x)], 1u);
            asm volatile("s_waitcnt vmcnt(0)" ::: "memory");
        } else {
            XB_SPIN(xb_ld(&bar[XB_XGEN(b.x)]) == gen, bar);
            __builtin_amdgcn_fence(__ATOMIC_ACQUIRE, "agent");
            asm volatile("s_waitcnt vmcnt(0)" ::: "memory");
        }
    }
    __syncthreads();
}

__global__ void __launch_bounds__(512, 2) mk_fwd(Args a) {
    extern __shared__ __attribute__((aligned(16))) unsigned char lds_raw[];
    LAS unsigned char* lds = (LAS unsigned char*)lds_raw;
    cg::grid_group grid = cg::this_grid();
    unsigned char* ws = a.ws;
#define PHASE_BEGIN(k) if (a.ph_lo <= (k) && (k) < a.ph_hi && EN(k)) {
    volatile LAS unsigned* xb_st = (volatile LAS unsigned*)(lds + LDS_BYTES - 16);
    if (threadIdx.x < 4) xb_st[threadIdx.x] = 0u;
    unsigned* xb_words = (unsigned*)(ws + WS_BAR);
    __syncthreads();
    XcdBarrier xbar = xcd_barrier_post(xb_words, xb_st);
    if (a.ph_lo < 0) grid.sync();
#define PHASE_END(k) if ((k) + 1 < a.ph_hi) xcd_barrier(xbar); }
    PHASE_BEGIN(0) phase_prep(a, lds);
#if SCAN_DBG == 3 || SCAN_DBG == 5
        if (blockIdx.x == 0 && threadIdx.x < 8) ((unsigned*)(ws + WS_CTR + 8192))[threadIdx.x] = 0u;
#endif
#if SCAN_DBG == 7
        if (blockIdx.x == 0 && threadIdx.x < 32) ((float*)(ws + WS_CTR + 4096))[threadIdx.x] = 0.f;
#endif
    PHASE_END(0)
#if SCAN_DBG == 5
    PHASE_BEGIN(1) dbg_lds16_test(lds, (unsigned*)(ws + WS_CTR + 8192)); PHASE_END(1)
#define SKIP_REST 1
#endif
    PHASE_BEGIN(1) {
        pg8::Gemm g{(const bf16_t*)(ws + slot(0)), (const bf16_t*)(ws + WS_WIN), opaque(MTOK), opaque(4 * DM), opaque(DM / 2)};
        pg8::StaticOrder S; S.init(g.M, g.N, (int)gridDim.x, (int)blockIdx.x);
        EpiKVQ_<true> E{(bf16_t*)(ws + slot(1)), (const float*)(ws + WS_XS0), (const float*)(ws + WS_SWIN)};
        pg8::gemm_phase<EpiKVQ_<true>, pg8::StaticOrder>(lds, g, S, E, nullptr);
    } PHASE_END(1)
    PHASE_BEGIN(2) quant_rows_bf16((const bf16_t*)(ws + WS_WC), (signed char*)(ws + WS_WC8), (float*)(ws + WS_SWC), 2 * DM);
        phase_scan_a(lds, (const bf16_t*)(ws + slot(2)), (const float*)(ws + WS_LB), (const bf16_t*)(ws + slot(3)), (bf16_t*)(ws + slot(6)), (float*)(ws + WS_DEC), QuantJob{a.in[10], a.in[11], ws + WS_UB, ws + WS_VB, (float*)(ws + WS_USC), (float*)(ws + WS_VSC)}
#if SCAN_DBG == 3
        , (unsigned*)(ws + WS_CTR + 8192)
#endif
        );
#if SCAN_DBG == 7
        asm volatile("s_waitcnt vmcnt(0)" ::: "memory"); __syncthreads(); grid.sync(); if (threadIdx.x < 64) { __builtin_amdgcn_fence(__ATOMIC_ACQUIRE, "agent"); asm volatile("s_waitcnt vmcnt(0)" ::: "memory"); } __syncthreads();
        dbg_check_a7((const float*)(ws + slot(4)), (const bf16_t*)(ws + slot(2)), (const bf16_t*)(ws + slot(6)), (float*)(ws + WS_CTR + 4096));
#endif
#if SCAN_DBG == 6
#define DSYNC6() asm volatile("s_waitcnt vmcnt(0)" ::: "memory"); __syncthreads(); grid.sync(); if (threadIdx.x < 64) { __builtin_amdgcn_fence(__ATOMIC_ACQUIRE, "agent"); asm volatile("s_waitcnt vmcnt(0)" ::: "memory"); } __syncthreads();
        DSYNC6()
        phase_scan_a(lds, (const bf16_t*)(ws + slot(2)), (const float*)(ws + WS_LB), (const bf16_t*)(ws + slot(3)), (bf16_t*)a.out, (float*)(ws + WS_DEC), QuantJob{a.in[10], a.in[11], ws + WS_UB, ws + WS_VB, (float*)(ws + WS_USC), (float*)(ws + WS_VSC)});
        DSYNC6()
        dbg_check_a((LAS float*)lds, (const float*)(ws + slot(4)), (const bf16_t*)(ws + slot(2)), (const bf16_t*)(ws + slot(6)), (const bf16_t*)a.out, (float*)(ws + WS_CTR + 4096));
#endif
#if SCAN_DBG == 3
        asm volatile("s_waitcnt vmcnt(0)" ::: "memory"); __syncthreads(); grid.sync();
        dbg_count_bf16((const bf16_t*)(ws + slot(6)), (size_t)4096 * 16384, (unsigned*)(ws + WS_CTR + 8192) + 2);
#endif
    PHASE_END(2)
    PHASE_BEGIN(3) phase_scan_b((bf16_t*)(ws + slot(6)), (const float*)(ws + WS_DEC), QuantJob{a.in[10] + (size_t)16384 * DM, a.in[11] + (size_t)16384 * DM, ws + WS_UB + (size_t)16384 * DM, ws + WS_VB + (size_t)16384 * DM, (float*)(ws + WS_USC) + 16384, (float*)(ws + WS_VSC) + 16384});
#if SCAN_DBG == 3
        asm volatile("s_waitcnt vmcnt(0)" ::: "memory"); __syncthreads(); grid.sync();

#endif
    PHASE_END(3)
    PHASE_BEGIN(4) phase_scan_c(lds, (const bf16_t*)(ws + slot(1)), (const bf16_t*)(ws + slot(2)), (const float*)(ws + WS_LB), (const bf16_t*)(ws + slot(3)), (const bf16_t*)(ws + slot(4)), (const bf16_t*)(ws + slot(6)), a.in[2], (bf16_t*)(ws + slot(0)));
#if SCAN_DBG == 1
        asm volatile("s_waitcnt vmcnt(0)" ::: "memory"); __syncthreads(); grid.sync();
        phase_scan_naive((const bf16_t*)(ws + slot(1)), (const float*)(ws + slot(4)), (const bf16_t*)(ws + slot(2)), (float*)(ws + slot(6)));
        asm volatile("s_waitcnt vmcnt(0)" ::: "memory"); __syncthreads(); grid.sync();
        phase_onorm((const float*)(ws + slot(6)), (const bf16_t*)(ws + slot(3)), a.in[2], (bf16_t*)(ws + slot(0)));
#endif
#if SCAN_DBG == 3
        asm volatile("s_waitcnt vmcnt(0)" ::: "memory"); __syncthreads(); grid.sync();

#endif
#if SCAN_DBG == 4
#define DSYNC() asm volatile("s_waitcnt vmcnt(0)" ::: "memory"); __syncthreads(); grid.sync(); if (threadIdx.x < 64) { __builtin_amdgcn_fence(__ATOMIC_ACQUIRE, "agent"); asm volatile("s_waitcnt vmcnt(0)" ::: "memory"); } __syncthreads();
        DSYNC()
        phase_scan_naive((const bf16_t*)(ws + slot(1)), (const float*)(ws + slot(4)), (const bf16_t*)(ws + slot(2)), (float*)(ws + slot(6)));
        DSYNC()
        phase_onorm((const float*)(ws + slot(6)), (const bf16_t*)(ws + slot(3)), a.in[2], (bf16_t*)(ws + slot(8)));
        DSYNC()
        phase_scan_a(lds, (const bf16_t*)(ws + slot(2)), (const float*)(ws + WS_LB), (const bf16_t*)(ws + slot(3)), (bf16_t*)(ws + slot(6)), (float*)(ws + WS_DEC), QuantJob{a.in[10], a.in[11], ws + WS_UB, ws + WS_VB, (float*)(ws + WS_USC), (float*)(ws + WS_VSC)});
        DSYNC()
        phase_scan_b((bf16_t*)(ws + slot(6)), (const float*)(ws + WS_DEC), QuantJob{a.in[10] + (size_t)16384 * DM, a.in[11] + (size_t)16384 * DM, ws + WS_UB + (size_t)16384 * DM, ws + WS_VB + (size_t)16384 * DM, (float*)(ws + WS_USC) + 16384, (float*)(ws + WS_VSC) + 16384});
        DSYNC()
        phase_scan_c(lds, (const bf16_t*)(ws + slot(1)), (const bf16_t*)(ws + slot(2)), (const float*)(ws + WS_LB), (const bf16_t*)(ws + slot(3)), (const bf16_t*)(ws + slot(4)), (const bf16_t*)(ws + slot(6)), a.in[2], (bf16_t*)a.out);
        DSYNC()
        dbg_compare4((LAS float*)lds, (const bf16_t*)(ws + slot(0)), (const bf16_t*)(ws + slot(8)), (const bf16_t*)a.out, (float*)(ws + WS_CTR + 4096));
#endif
#if SCAN_DBG == 2
        asm volatile("s_waitcnt vmcnt(0)" ::: "memory"); __syncthreads(); grid.sync();
        phase_scan_naive((const bf16_t*)(ws + slot(1)), (const float*)(ws + slot(4)), (const bf16_t*)(ws + slot(2)), (float*)(ws + slot(6)));
        asm volatile("s_waitcnt vmcnt(0)" ::: "memory"); __syncthreads(); grid.sync();
        phase_onorm((const float*)(ws + slot(6)), (const bf16_t*)(ws + slot(3)), a.in[2], (bf16_t*)(ws + slot(8)));
        asm volatile("s_waitcnt vmcnt(0)" ::: "memory"); __syncthreads(); grid.sync();
        dbg_compare((LAS float*)lds, (const bf16_t*)(ws + slot(0)), (const bf16_t*)(ws + slot(8)), (float*)(ws + WS_CTR + 4096));
#endif
    PHASE_END(4)
    PHASE_BEGIN(5) run_gemm_out<false>(a, lds); PHASE_END(5)
    PHASE_BEGIN(6) run_ln<false>(a); PHASE_END(6)
    PHASE_BEGIN(7) run_gemm_sc<false>(a, lds); PHASE_END(7)
    PHASE_BEGIN(8) run_topk<false>(a, lds); PHASE_END(8)
    PHASE_BEGIN(9) run_peer<false>(a, lds); PHASE_END(9)
    PHASE_BEGIN(10) {
        pg8::Gemm g{(const bf16_t*)(ws + slot(1)), (const bf16_t*)(ws + WS_WKVQ), opaque(MTOK), opaque(3 * DM), opaque(DM / 2)};
        pg8::StaticOrder S; S.init(g.M, g.N, (int)gridDim.x, (int)blockIdx.x);
        EpiKVQR_<true> E{(bf16_t*)(ws + slot(3)), (const float*)(ws + WS_COS), (const float*)(ws + WS_SIN), (const float*)(ws + WS_XS1), (const float*)(ws + WS_SWKVQ)};
        pg8::gemm_phase<EpiKVQR_<true>, pg8::StaticOrder>(lds, g, S, E, nullptr);
    } PHASE_END(10)
    PHASE_BEGIN(11) phase_kstat((LAS float*)lds, (const bf16_t*)(ws + slot(3)), (float*)(ws + WS_KMEAN), (float*)(ws + WS_KNMAX)); PHASE_END(11)
    PHASE_BEGIN(12) phase_sel(lds, (const bf16_t*)(ws + slot(5)), (const float*)(ws + WS_KMEAN), (unsigned short*)(ws + WS_SUB), (int*)(ws + WS_CNT), (int*)(ws + WS_CTR)); PHASE_END(12)
    PHASE_BEGIN(13) phase_att(lds, (const bf16_t*)(ws + slot(5)), (const bf16_t*)(ws + slot(3)), (const bf16_t*)(ws + slot(4)), (const float*)(ws + WS_KNMAX), (const unsigned short*)(ws + WS_SUB),
                              (const int*)(ws + WS_CNT), (int*)(ws + WS_CTR), (bf16_t*)(ws + slot(6)), (bf16_t*)(ws + slot(0)), (float*)(ws + WS_LS)); PHASE_END(13)
    PHASE_BEGIN(14) phase_comb((LAS float*)lds, (const bf16_t*)(ws + slot(6)), (const bf16_t*)(ws + slot(0)), (const float*)(ws + WS_LS), (signed char*)(ws + slot(3)), (float*)(ws + WS_XSO)); PHASE_END(14)
    PHASE_BEGIN(15) run_gemm_out<true>(a, lds); PHASE_END(15)
    PHASE_BEGIN(16) run_ln<true>(a); PHASE_END(16)
    PHASE_BEGIN(17) run_gemm_sc<true>(a, lds); PHASE_END(17)
    PHASE_BEGIN(18) run_topk<true>(a, lds); PHASE_END(18)
#if SCAN_DBG == 7
    PHASE_BEGIN(19) dbg_emit7((const float*)(ws + WS_CTR + 4096), a.out); PHASE_END(19)
#elif SCAN_DBG == 6
    PHASE_BEGIN(19) dbg_emit4((const float*)(ws + WS_CTR + 4096), a.out); PHASE_END(19)
#elif SCAN_DBG == 5
    PHASE_BEGIN(19) dbg_emit5((const unsigned*)(ws + WS_CTR + 8192), a.out); PHASE_END(19)
#elif SCAN_DBG == 4
    PHASE_BEGIN(19) dbg_emit4((const float*)(ws + WS_CTR + 4096), a.out); PHASE_END(19)
#elif SCAN_DBG == 3
    PHASE_BEGIN(19) dbg_emit3((const unsigned*)(ws + WS_CTR + 8192), a.out); PHASE_END(19)
#elif SCAN_DBG == 2
    PHASE_BEGIN(19) dbg_emit((const float*)(ws + WS_CTR + 4096), a.out); PHASE_END(19)
#else
    PHASE_BEGIN(19) run_peer<true>(a, lds); PHASE_END(19)
#endif
}

extern "C" void kernel_launch(void* const* d_in, const int* in_sizes, int n_in, void* d_out, int out_size, void* d_ws, size_t ws_size, hipStream_t stream) {
    static int grid = 0;
    if (grid == 0) {
        if (n_in != 14 || out_size != MTOK * DM || ws_size < WS_END) { fprintf(stderr, "kernel_launch: unexpected shapes (n_in %d, out %d, ws %zu)\n", n_in, out_size, ws_size); grid = -1; return; }
        int dev = 0, cus = 0, per_cu = 0;
        if (hipGetDevice(&dev) != hipSuccess || hipDeviceGetAttribute(&cus, hipDeviceAttributeMultiprocessorCount, dev) != hipSuccess) { grid = -1; return; }
        if (hipFuncSetAttribute((const void*)mk_fwd, hipFuncAttributeMaxDynamicSharedMemorySize, LDS_BYTES) != hipSuccess) { fprintf(stderr, "kernel_launch: hipFuncSetAttribute failed\n"); grid = -1; return; }
        if (hipOccupancyMaxActiveBlocksPerMultiprocessor(&per_cu, (const void*)mk_fwd, 512, LDS_BYTES) != hipSuccess || per_cu < 1) { fprintf(stderr, "kernel_launch: occupancy query failed (%d)\n", per_cu); (void)hipGetLastError(); per_cu = 1; }
        grid = cus * (per_cu > 1 ? 1 : per_cu);
    }
    if (grid < 0) return;
    Args a{};
    for (int i = 0; i < 14; ++i) a.in[i] = (const float*)d_in[i];
    a.out = (float*)d_out; a.ws = (unsigned char*)d_ws;
#if ONE_LAUNCH
    a.ph_lo = 0; a.ph_hi = NPH;
    (void)hipMemsetAsync((unsigned char*)d_ws + WS_BAR, 0, XCD_BAR_WORDS * sizeof(unsigned), stream);
    void* args[] = {&a};
    hipError_t e = hipLaunchCooperativeKernel((const void*)mk_fwd, dim3(grid), dim3(512), args, LDS_BYTES, stream);
    if (e != hipSuccess) fprintf(stderr, "cooperative launch failed: %s (grid %d)\n", hipGetErrorString(e), grid);
#else
    for (int ph = 0; ph < NPH; ++ph) {
        a.ph_lo = ph; a.ph_hi = ph + 1;
        hipLaunchKernelGGL(mk_fwd, dim3(grid), dim3(512), LDS_BYTES, stream, a);
    }
#endif
}
```

```cpp
#define ONE_LAUNCH 1
#include <hip/hip_runtime.h>
#include <hip/hip_cooperative_groups.h>
#include <cstdio>
namespace cg = cooperative_groups;

#ifndef ONE_LAUNCH
#define ONE_LAUNCH 0
#endif
#ifndef SCAN_DBG
#define SCAN_DBG 0
#endif
#ifndef SCAN_A_VALU
#define SCAN_A_VALU 0
#endif
#ifndef SC8
#define SC8 1
#endif
#ifndef ENMASK
#define ENMASK 0xffffffffu
#endif
#define EN(k) ((ENMASK >> (k)) & 1u)

namespace pg8 {
#define PG8_LAS __attribute__((address_space(3)))
typedef unsigned short bf16_t;
typedef short bf16x8 __attribute__((ext_vector_type(8)));
typedef float f32x4 __attribute__((ext_vector_type(4)));
typedef unsigned u32x4 __attribute__((ext_vector_type(4)));
constexpr int BM = 256, BK = 64, HALF = 128, HTB = HALF * BK * 2  , STAGE_BYTES = 8 * HTB, NXCD = 8, WGM = 8;

__host__ __device__ __forceinline__ int lds_byte(int r, int c) { const int st = (r >> 4) * 2 + (c >> 5), rr = r & 15, cc = c & 31, ob = rr * 64 + cc * 2; return st * 1024 + (ob ^ (((ob >> 9) & 1) << 5)); }
__host__ __device__ __forceinline__ void stage_rc(int b, int& R, int& C) { const int st = b / 1024, sb = b % 1024, swz = sb ^ (((sb >> 9) & 1) << 5); R = (st >> 1) * 16 + swz / 64; C = (st & 1) * 32 + (swz % 64) / 2; }
__host__ __device__ __forceinline__ int perm32(int rho) { const int n = rho >> 4, i = rho & 15; return 8 * (i >> 2) + 4 * n + (i & 3); }

struct Unit { int pm, pn; };
struct Gemm { const bf16_t* A; const bf16_t* Bt; int M, N, K; };

struct StaticOrder {
    int nM, nN, nwg, G, c;
    __host__ __device__ void init(int M, int N, int G_, int c_) { nM = M / BM; nN = N / BM; nwg = nM * nN; G = G_; c = c_; }
    __host__ __device__ bool next(int i, Unit& u) const {
        const long L = (long)i * G + c; if (L >= nwg) return false;
        int wgid = (int)L; { const int q = nwg / NXCD, r = nwg % NXCD, xcd = wgid % NXCD, off = wgid / NXCD; wgid = (xcd < r ? xcd * (q + 1) : r * (q + 1) + (xcd - r) * q) + off; }
        const int nig = WGM * nN, gid = wgid / nig, fm = gid * WGM, gsz = (nM - fm) < WGM ? (nM - fm) : WGM;
        u.pm = fm + ((wgid % nig) % gsz); u.pn = (wgid % nig) / gsz; return true;
    }
    __device__ __forceinline__ void a_ready(const Unit&) const {}
    __device__ __forceinline__ void done(const Unit&) const {}
};
struct CountedOrder : StaticOrder {
    const unsigned* ready; unsigned need; unsigned* tmo;
    __device__ __forceinline__ void a_ready(const Unit& u) const {
        if (threadIdx.x < 64) {
            const unsigned long long t0 = __builtin_amdgcn_s_memrealtime(); unsigned polls = 0;
            while ((unsigned)__builtin_amdgcn_readfirstlane(__hip_atomic_load(ready + 64 * u.pm, __ATOMIC_RELAXED, __HIP_MEMORY_SCOPE_AGENT)) < need) {
                if ((++polls & 255u) == 0u && __builtin_amdgcn_readfirstlane(__hip_atomic_load(tmo, __ATOMIC_RELAXED, __HIP_MEMORY_SCOPE_AGENT)) != 0u) break;
                if (__builtin_amdgcn_s_memrealtime() - t0 > 2000000ull) {
                    if (threadIdx.x == 0) { unsigned expect = 0u; __hip_atomic_compare_exchange_strong(tmo + 1, &expect, 0x600u | (unsigned)(u.pm & 0xff), __ATOMIC_RELAXED, __ATOMIC_RELAXED, __HIP_MEMORY_SCOPE_AGENT); __hip_atomic_store(tmo, 1u, __ATOMIC_RELAXED, __HIP_MEMORY_SCOPE_AGENT); }
                    break; }
                __builtin_amdgcn_s_sleep(2); }
            __builtin_amdgcn_fence(__ATOMIC_ACQUIRE, "agent");
            asm volatile("s_waitcnt vmcnt(0)" ::: "memory");
        }
#if !defined(BROKEN_HOOK_NO_BARRIER)
        asm volatile("" ::: "memory"); __builtin_amdgcn_s_barrier(); asm volatile("" ::: "memory");
#endif
    }
};

__device__ __forceinline__ unsigned cvt_pk_bf16(float lo, float hi) { unsigned r; asm volatile("v_cvt_pk_bf16_f32 %0, %1, %2" : "=v"(r) : "v"(lo), "v"(hi)); return r; }
typedef float f32x2 __attribute__((ext_vector_type(2)));
__device__ __forceinline__ f32x2 gelu_pk(f32x2 v) {
    const f32x2 av = __builtin_elementwise_abs(v), d = av * 0.2316418882f + 1.0f;
    f32x2 t; t.x = __builtin_amdgcn_rcpf(d.x); t.y = __builtin_amdgcn_rcpf(d.y);
    f32x2 q = t * 0.5307027145f + (-0.7265760135f); q = q * t + 0.7107068705f; q = q * t + (-0.142248368f); q = q * t + 0.127414796f; q = q * t;
    const f32x2 s = (v * v) * (-0.72134752044f);
    f32x2 e; e.x = __builtin_amdgcn_exp2f(s.x); e.y = __builtin_amdgcn_exp2f(s.y);
    const f32x2 m = v * (q * e), r = v - m;
    f32x2 o; o.x = v.x < 0.f ? m.x : r.x; o.y = v.y < 0.f ? m.y : r.y; return o;
}

struct EpiF32 {
    static constexpr bool PERM = false, AFTER_DRAIN = false, I8 = false;
    float* C; int ldc; const float* bias;
    __device__ __forceinline__ void operator()(const f32x4 (&acc)[2][2][4][2], const Unit& u, int wr, int wc, int fr, int fq) const {
        const int row0 = u.pm * BM + wr * 64 + fr, col0 = u.pn * BM + wc * 32 + 4 * fq;
        f32x4 bv[2][2];
#pragma unroll
        for (int bj = 0; bj < 2; ++bj)
#pragma unroll
            for (int n = 0; n < 2; ++n) bv[bj][n] = bias ? *(const f32x4*)(bias + col0 + bj * HALF + n * 16) : (f32x4){0.f, 0.f, 0.f, 0.f};
#pragma unroll
        for (int ai = 0; ai < 2; ++ai)
#pragma unroll
            for (int m = 0; m < 4; ++m) { float* rowp = C + (size_t)(row0 + ai * HALF + m * 16) * ldc + col0;
#pragma unroll
                for (int bj = 0; bj < 2; ++bj)
#pragma unroll
                    for (int n = 0; n < 2; ++n) *(f32x4*)(rowp + bj * HALF + n * 16) = acc[ai][bj][m][n] + bv[bj][n]; }
    }
};
template <int ACT  > struct EpiBf16 {
    static constexpr bool PERM = true, AFTER_DRAIN = false, I8 = false;
    bf16_t* O; int ldc; const float* bias; int split_cols; size_t split_stride;
    __device__ __forceinline__ void operator()(const f32x4 (&acc)[2][2][4][2], const Unit& u, int wr, int wc, int fr, int fq) const {
        const int row0 = u.pm * BM + wr * 64 + fr; int colt = u.pn * BM; bf16_t* base = O;
        if (split_cols) { const int t = colt / split_cols; base += (size_t)t * split_stride; colt -= t * split_cols; }
        const int col0 = colt + wc * 32 + 8 * fq, bcol0 = u.pn * BM + wc * 32 + 8 * fq;
        f32x4 bv[2][2];
#pragma unroll
        for (int bj = 0; bj < 2; ++bj)
#pragma unroll
            for (int n = 0; n < 2; ++n) bv[bj][n] = bias ? *(const f32x4*)(bias + bcol0 + bj * HALF + 4 * n) : (f32x4){0.f, 0.f, 0.f, 0.f};
#pragma unroll
        for (int ai = 0; ai < 2; ++ai)
#pragma unroll
            for (int m = 0; m < 4; ++m) { bf16_t* rowp = base + (size_t)(row0 + ai * HALF + m * 16) * ldc + col0;
#pragma unroll
                for (int bj = 0; bj < 2; ++bj) { f32x4 v0 = acc[ai][bj][m][0] + bv[bj][0], v1 = acc[ai][bj][m][1] + bv[bj][1];
                    if (ACT == 1) { f32x2 a = gelu_pk((f32x2){v0[0], v0[1]}), b = gelu_pk((f32x2){v0[2], v0[3]}), c = gelu_pk((f32x2){v1[0], v1[1]}), d = gelu_pk((f32x2){v1[2], v1[3]});
                        v0 = (f32x4){a.x, a.y, b.x, b.y}; v1 = (f32x4){c.x, c.y, d.x, d.y}; }
                    if (ACT == 2) {
#pragma unroll
                        for (int j = 0; j < 4; ++j) { v0[j] = 0.5f * v0[j] * (1.0f + erff(v0[j] * 0.70710678f)); v1[j] = 0.5f * v1[j] * (1.0f + erff(v1[j] * 0.70710678f)); } }
                    u32x4 w; w.x = cvt_pk_bf16(v0[0], v0[1]); w.y = cvt_pk_bf16(v0[2], v0[3]); w.z = cvt_pk_bf16(v1[0], v1[1]); w.w = cvt_pk_bf16(v1[2], v1[3]);
                    *(u32x4*)(rowp + bj * HALF) = w; } }
    }
};

typedef int i32x4 __attribute__((ext_vector_type(4)));
template <bool I8> __device__ __forceinline__ f32x4 mma16(bf16x8 b, bf16x8 a, f32x4 c) {
    if constexpr (I8) return __builtin_bit_cast(f32x4, __builtin_amdgcn_mfma_i32_16x16x64_i8(__builtin_bit_cast(i32x4, b), __builtin_bit_cast(i32x4, a), __builtin_bit_cast(i32x4, c), 0, 0, 0));
    else return __builtin_amdgcn_mfma_f32_16x16x32_bf16(b, a, c, 0, 0, 0);
}
template <bool I8> __device__ __forceinline__ f32x4 accf(f32x4 a) { if constexpr (I8) return __builtin_convertvector(__builtin_bit_cast(i32x4, a), f32x4); else return a; }
template <class Epi, class Sched, bool STAMP = false>
__device__ __forceinline__ void gemm_phase(PG8_LAS unsigned char* lds, const Gemm g, const Sched& S, const Epi& E, unsigned long long* stamps) {
    const int tid = threadIdx.x, wid = __builtin_amdgcn_readfirstlane(tid >> 6), lane = tid & 63, wr = wid >> 2, wc = wid & 3, fr = lane & 15, fq = lane >> 4;
    const int K = g.K, nt = K / BK;
    int ts_lo = 0, ts_hi = 0, nts = 0; const unsigned long long rt_entry = STAMP ? (unsigned long long)wall_clock64() : 0ull;
#define PG8_STAMP() do { if (STAMP && wid == 0 && nts < 64) { const unsigned long long _c = (unsigned long long)clock64(); \
        ts_lo = (lane == nts) ? (int)(unsigned)_c : ts_lo; ts_hi = (lane == nts) ? (int)(unsigned)(_c >> 32) : ts_hi; ++nts; } } while (0)
    PG8_STAMP();
    unsigned voffA[2], voffB[2];
#pragma unroll
    for (int i = 0; i < 2; ++i) { int R, C; stage_rc(tid * 16 + i * 8192, R, C); const int Rb = Epi::PERM ? ((R & ~31) + perm32(R & 31)) : R;
        voffA[i] = (unsigned)(R * K + C) * 2u; voffB[i] = (unsigned)(Rb * K + C) * 2u; }
    const size_t kstep = (size_t)(BK * 2);
    const size_t hstep = (size_t)HALF * K * 2;
    const size_t tstep = 2 * hstep;
    const unsigned ldsw = (unsigned)wid * 1024u;
    const int aoff = lds_byte(wr * 64 + fr, fq * 8), boff = lds_byte(wc * 32 + fr, fq * 8);
#define PG8_SA(b, h) (((b) * 2 + (h)) * HTB)
#define PG8_SB(b, h) ((4 + (b) * 2 + (h)) * HTB)
#define PG8_STAGE(bufoff, gbase, voff) do { _Pragma("unroll") for (int _i = 0; _i < 2; ++_i) \
        __builtin_amdgcn_global_load_lds((const unsigned*)((const char*)(gbase) + (voff)[_i]), (PG8_LAS unsigned*)(lds + (bufoff) + ldsw + _i * 8192), 16, 0, 0); } while (0)
#define PG8_LDA(dst, b, h) do { _Pragma("unroll") for (int m = 0; m < 4; ++m) _Pragma("unroll") for (int k = 0; k < 2; ++k) dst[m][k] = *(const PG8_LAS bf16x8*)(lds + PG8_SA(b, h) + aoff + m * 2048 + k * 1024); } while (0)
#define PG8_LDB(dst, b, h) do { _Pragma("unroll") for (int n = 0; n < 2; ++n) _Pragma("unroll") for (int k = 0; k < 2; ++k) dst[n][k] = *(const PG8_LAS bf16x8*)(lds + PG8_SB(b, h) + boff + n * 2048 + k * 1024); } while (0)
#define PG8_MMA(ai, bj, At, Bt) do { __builtin_amdgcn_s_setprio(1); _Pragma("unroll") for (int m = 0; m < 4; ++m) _Pragma("unroll") for (int n = 0; n < 2; ++n) _Pragma("unroll") for (int k = 0; k < 2; ++k) \
        acc[ai][bj][m][n] = mma16<Epi::I8>(Bt[n][k], At[m][k], acc[ai][bj][m][n]); __builtin_amdgcn_s_setprio(0); } while (0)
#define PG8_WAIT_V(n) asm volatile("s_waitcnt vmcnt(" #n ")" ::: "memory")
#define PG8_WAIT_L(n) asm volatile("s_waitcnt lgkmcnt(" #n ")" ::: "memory")
#define PG8_BAR __builtin_amdgcn_s_barrier()
#define PG8_SCHED __builtin_amdgcn_sched_barrier(0)
    Unit cur, nxt; int ui = 0;
    if (!S.next(0, cur)) return;
    f32x4 acc[2][2][4][2];
#pragma unroll
    for (int a = 0; a < 2; ++a)
#pragma unroll
        for (int b = 0; b < 2; ++b)
#pragma unroll
            for (int m = 0; m < 4; ++m)
#pragma unroll
                for (int n = 0; n < 2; ++n) acc[a][b][m][n] = (f32x4){0.f, 0.f, 0.f, 0.f};
    bf16x8 At[4][2], B0[2][2], B1[2][2];
    const char* cA = (const char*)g.A + (size_t)cur.pm * tstep; const char* cB = (const char*)g.Bt + (size_t)cur.pn * tstep;
    S.a_ready(cur);
    PG8_STAGE(PG8_SB(0, 0), cB, voffB); PG8_STAGE(PG8_SA(0, 0), cA, voffA); PG8_STAGE(PG8_SB(0, 1), cB + hstep, voffB); PG8_STAGE(PG8_SA(0, 1), cA + hstep, voffA);
    if (wr == 1) PG8_BAR;
    PG8_WAIT_V(4); PG8_BAR;
    PG8_STAGE(PG8_SB(1, 0), cB + kstep, voffB); PG8_STAGE(PG8_SA(1, 0), cA + kstep, voffA); PG8_STAGE(PG8_SB(1, 1), cB + hstep + kstep, voffB);
    PG8_WAIT_V(6); PG8_BAR;
    PG8_STAMP();
    for (;;) {
        const bool has_next = S.next(ui + 1, nxt);
        const char* nA = has_next ? (const char*)g.A + (size_t)nxt.pm * tstep : cA; const char* nB = has_next ? (const char*)g.Bt + (size_t)nxt.pn * tstep : cB;
        for (int t = 0; t < nt; t += 2) {
            const bool last = (t == nt - 2);
            const char* a1 = cA + (size_t)(t + 1) * kstep;
            const char* a2 = last ? nA : cA + (size_t)(t + 2) * kstep; const char* b2 = last ? nB : cB + (size_t)(t + 2) * kstep;
            const char* a3 = a2 + kstep; const char* b3 = b2 + kstep;
            if (last && has_next) S.a_ready(nxt);
            PG8_LDB(B0, 0, 0); PG8_SCHED; PG8_LDA(At, 0, 0); PG8_STAGE(PG8_SA(1, 1), a1 + hstep, voffA);
            PG8_WAIT_L(8); PG8_BAR; PG8_WAIT_L(0); PG8_MMA(0, 0, At, B0); PG8_BAR; PG8_SCHED;
            PG8_LDB(B1, 0, 1); PG8_STAGE(PG8_SB(0, 0), b2, voffB);
            PG8_BAR; PG8_WAIT_L(0); PG8_MMA(0, 1, At, B1); PG8_BAR;
            PG8_LDA(At, 0, 1); PG8_STAGE(PG8_SA(0, 0), a2, voffA);
            PG8_BAR; PG8_WAIT_L(0); PG8_MMA(1, 0, At, B0); PG8_BAR; PG8_SCHED;
            PG8_STAGE(PG8_SB(0, 1), b2 + hstep, voffB);
            PG8_WAIT_V(6); PG8_BAR; PG8_MMA(1, 1, At, B1); PG8_BAR;
            PG8_LDB(B0, 1, 0); PG8_SCHED; PG8_LDA(At, 1, 0); PG8_STAGE(PG8_SA(0, 1), a2 + hstep, voffA);
            PG8_WAIT_L(8); PG8_BAR; PG8_WAIT_L(0); PG8_MMA(0, 0, At, B0); PG8_BAR; PG8_SCHED;
            PG8_LDB(B1, 1, 1); PG8_STAGE(PG8_SB(1, 0), b3, voffB);
            PG8_BAR; PG8_WAIT_L(0); PG8_MMA(0, 1, At, B1); PG8_BAR;
            PG8_LDA(At, 1, 1); PG8_STAGE(PG8_SA(1, 0), a3, voffA);
            PG8_BAR; PG8_WAIT_L(0); PG8_MMA(1, 0, At, B0); PG8_BAR; PG8_SCHED;
            PG8_STAGE(PG8_SB(1, 1), b3 + hstep, voffB);
            PG8_WAIT_V(6); PG8_BAR; PG8_MMA(1, 1, At, B1); PG8_BAR;
        }
        PG8_STAMP();
        if constexpr (!Epi::AFTER_DRAIN) { E(acc, cur, wr, wc, fr, fq); S.done(cur); }
        PG8_STAMP();
        if (!has_next) break;
#pragma unroll
        for (int a = 0; a < 2; ++a)
#pragma unroll
            for (int b = 0; b < 2; ++b)
#pragma unroll
                for (int m = 0; m < 4; ++m)
#pragma unroll
                    for (int n = 0; n < 2; ++n) acc[a][b][m][n] = (f32x4){0.f, 0.f, 0.f, 0.f};
        cur = nxt; cA = nA; cB = nB; ++ui;
    }
    PG8_WAIT_V(0);
    if (wr == 0) PG8_BAR;
    PG8_BAR;
    if constexpr (Epi::AFTER_DRAIN) { E.fused(acc, cur, wr, wc, fr, fq, lds, wid, lane); S.done(cur); }
    PG8_STAMP();
    if (STAMP && wid == 0) { stamps[lane] = lane < nts ? (((unsigned long long)(unsigned)ts_hi << 32) | (unsigned)ts_lo) : 0ull;
        if (lane == 62) stamps[62] = rt_entry; if (lane == 63) stamps[63] = (unsigned long long)wall_clock64(); }
#undef PG8_STAMP
#undef PG8_SA
#undef PG8_SB
#undef PG8_STAGE
#undef PG8_LDA
#undef PG8_LDB
#undef PG8_MMA
#undef PG8_WAIT_V
#undef PG8_WAIT_L
#undef PG8_BAR
#undef PG8_SCHED
}
}


#define LAS __attribute__((address_space(3)))
typedef unsigned short bf16_t;
typedef float f32x4 __attribute__((ext_vector_type(4)));
typedef unsigned u32x4 __attribute__((ext_vector_type(4)));
typedef unsigned u32x2 __attribute__((ext_vector_type(2)));
typedef short bf16x8 __attribute__((ext_vector_type(8)));
typedef short s16x4 __attribute__((ext_vector_type(4)));
typedef float f32x16 __attribute__((ext_vector_type(16)));

constexpr int MTOK = 16384, DM = 2048, SEQ = 8192, NHEAD = 16;
constexpr float ALPHA = 1.41421356237309515f;
constexpr size_t MiB = (size_t)1 << 20;
constexpr size_t WS_WIN = 0, WS_WOUT = 32 * MiB, WS_WKVQ = 40 * MiB, WS_WO = 64 * MiB, WS_WC = 72 * MiB, WS_UB = 88 * MiB, WS_VB = 152 * MiB, WS_USC = 216 * MiB, WS_VSC = 217 * MiB, WS_H = 224 * MiB, WS_XQ = 232 * MiB, WS_XS = 264 * MiB, WS_W = 272 * MiB, WS_CS = 280 * MiB, WS_SLOT = 344 * MiB;
constexpr size_t WS_EID = 920 * MiB, WS_GATE = 928 * MiB, WS_COS = 936 * MiB, WS_SIN = 938 * MiB, WS_KMEAN = 940 * MiB, WS_LB = 941 * MiB, WS_LS = 942 * MiB, WS_SUB = 946 * MiB, WS_CNT = 962 * MiB, WS_CTR = 963 * MiB, WS_DEC = 964 * MiB, WS_END = 966 * MiB;
constexpr size_t WS_BAR = WS_CTR + 65536;
constexpr size_t WS_WC8 = WS_H, WS_SWC = WS_XS + 5 * MiB, WS_XSO = WS_XS + 6 * MiB, WS_SWO = WS_XS + 7 * MiB;
constexpr size_t WS_XS0 = WS_XS + 1 * MiB, WS_SWIN = WS_XS + 2 * MiB, WS_SWKVQ = WS_XS + 3 * MiB, WS_XS1 = WS_XS + 4 * MiB;
constexpr size_t WS_KNMAX = WS_KMEAN + 768 * 1024;
__host__ __device__ constexpr size_t slot(int i) { return WS_SLOT + (size_t)i * 64 * MiB; }
constexpr int LDS_BYTES = 144 * 1024;
constexpr int NPH = 20;

struct Args { const float* in[14]; float* out; unsigned char* ws; int ph_lo, ph_hi; };

__device__ __forceinline__ float bflo(unsigned w) { return __uint_as_float(w << 16); }
__device__ __forceinline__ float bfhi(unsigned w) { return __uint_as_float(w & 0xffff0000u); }
__device__ __forceinline__ float bf2f(bf16_t b) { return __uint_as_float(((unsigned)b) << 16); }
typedef __bf16 bf16x2_t __attribute__((ext_vector_type(2)));
typedef float f32x2_t __attribute__((ext_vector_type(2)));
__device__ __forceinline__ unsigned pk_bf16(float lo, float hi) { const f32x2_t f = {lo, hi}; return __builtin_bit_cast(unsigned, __builtin_convertvector(f, bf16x2_t)); }
__device__ __forceinline__ float wave_sum(float v) {
#pragma unroll
    for (int o = 32; o >= 1; o >>= 1) v += __shfl_xor(v, o);
    return v;
}
__device__ __forceinline__ float wave_max(float v) {
#pragma unroll
    for (int o = 32; o >= 1; o >>= 1) v = fmaxf(v, __shfl_xor(v, o));
    return v;
}
__device__ __forceinline__ float sigmoidf_(float z) { return 1.0f / (1.0f + __expf(-z)); }


__device__ __forceinline__ void store_wt16(void* p, u32x4 v) {
    __hip_atomic_store((unsigned long long*)p, ((unsigned long long)v.y << 32) | v.x, __ATOMIC_RELAXED, __HIP_MEMORY_SCOPE_AGENT);
    __hip_atomic_store((unsigned long long*)p + 1, ((unsigned long long)v.w << 32) | v.z, __ATOMIC_RELAXED, __HIP_MEMORY_SCOPE_AGENT);
}
__device__ __forceinline__ void store_wt8(void* p, u32x2 v) {
    __hip_atomic_store((unsigned long long*)p, ((unsigned long long)v.y << 32) | v.x, __ATOMIC_RELAXED, __HIP_MEMORY_SCOPE_AGENT);
}
struct EpiIn {
    static constexpr bool PERM = true, AFTER_DRAIN = false, I8 = false;
    bf16_t* Q1; float* LF; bf16_t* I1; bf16_t* G1; const float* LB;
    __device__ __forceinline__ void operator()(const pg8::f32x4 (&acc)[2][2][4][2], const pg8::Unit& u, int wr, int wc, int fr, int fq) const {
        const int type = u.pn >> 3;
        const int row0 = u.pm * 256 + wr * 64 + fr, col0 = (u.pn & 7) * 256 + wc * 32 + 8 * fq;
        if (type == 1) {
#pragma unroll
            for (int bj = 0; bj < 2; ++bj) {
                const int c = col0 + bj * 128;
                const f32x4 lb0 = *(const f32x4*)(LB + c), lb1 = *(const f32x4*)(LB + c + 4);
#pragma unroll
                for (int ai = 0; ai < 2; ++ai)
#pragma unroll
                    for (int m = 0; m < 4; ++m) {
                        float* p = LF + (size_t)(row0 + ai * 128 + m * 16) * DM + c;
                        f32x4 o0, o1;
#pragma unroll
                        for (int j = 0; j < 4; ++j) {
                            o0[j] = __logf(lb0[j] + (1.0f - lb0[j]) * sigmoidf_(acc[ai][bj][m][0][j]));
                            o1[j] = __logf(lb1[j] + (1.0f - lb1[j]) * sigmoidf_(acc[ai][bj][m][1][j]));
                        }
                        *(f32x4*)p = o0; *(f32x4*)(p + 4) = o1;
                    }
            }
        } else {
            bf16_t* dst = Q1 + (size_t)(type - (type > 0 ? 1 : 0)) * ((size_t)32 << 20);
            const bool act = (type != 2);
#pragma unroll
            for (int ai = 0; ai < 2; ++ai)
#pragma unroll
                for (int m = 0; m < 4; ++m)
#pragma unroll
                    for (int bj = 0; bj < 2; ++bj) {
                        f32x4 v0 = acc[ai][bj][m][0], v1 = acc[ai][bj][m][1];
                        if (act) {
#pragma unroll
                            for (int j = 0; j < 4; ++j) { v0[j] = v0[j] * sigmoidf_(v0[j]); v1[j] = v1[j] * sigmoidf_(v1[j]); }
                        }
                        u32x4 w; w.x = pk_bf16(v0[0], v0[1]); w.y = pk_bf16(v0[2], v0[3]); w.z = pk_bf16(v1[0], v1[1]); w.w = pk_bf16(v1[2], v1[3]);
                        *(u32x4*)(dst + (size_t)(row0 + ai * 128 + m * 16) * DM + col0 + bj * 128) = w;
                    }
        }
    }
};
struct EpiRes {
    static constexpr bool PERM = false, AFTER_DRAIN = false, I8 = false;
    const float* res; float* Y;
    __device__ __forceinline__ void operator()(const pg8::f32x4 (&acc)[2][2][4][2], const pg8::Unit& u, int wr, int wc, int fr, int fq) const {
        const int row0 = u.pm * 256 + wr * 64 + fr, col0 = u.pn * 256 + wc * 32 + 4 * fq;
#pragma unroll
        for (int ai = 0; ai < 2; ++ai)
#pragma unroll
            for (int m = 0; m < 4; ++m) {
                const size_t off = (size_t)(row0 + ai * 128 + m * 16) * DM + col0;
#pragma unroll
                for (int bj = 0; bj < 2; ++bj)
#pragma unroll
                    for (int n = 0; n < 2; ++n) {
                        const f32x4 r = *(const f32x4*)(res + off + bj * 128 + n * 16);
                        *(f32x4*)(Y + off + bj * 128 + n * 16) = r * ALPHA + acc[ai][bj][m][n];
                    }
            }
    }
};
template <bool Q8> struct EpiF32_ {
    static constexpr bool PERM = false, AFTER_DRAIN = false, I8 = Q8;
    float* C; int ldc; const float* SA; const float* SB;
    __device__ __forceinline__ void operator()(const pg8::f32x4 (&acc)[2][2][4][2], const pg8::Unit& u, int wr, int wc, int fr, int fq) const {
        const int row0 = u.pm * 256 + wr * 64 + fr, col0 = u.pn * 256 + wc * 32 + 4 * fq;
        float sa[2][4]; f32x4 sb[2][2];
#pragma unroll
        for (int ai = 0; ai < 2; ++ai)
#pragma unroll
            for (int m = 0; m < 4; ++m) sa[ai][m] = Q8 ? SA[row0 + ai * 128 + m * 16] : 1.0f;
#pragma unroll
        for (int bj = 0; bj < 2; ++bj)
#pragma unroll
            for (int n = 0; n < 2; ++n) sb[bj][n] = Q8 ? *(const f32x4*)(SB + col0 + bj * 128 + n * 16) : (f32x4){1.f, 1.f, 1.f, 1.f};
#pragma unroll
        for (int ai = 0; ai < 2; ++ai)
#pragma unroll
            for (int m = 0; m < 4; ++m) {
                const int row = row0 + ai * 128 + m * 16;
#pragma unroll
                for (int bj = 0; bj < 2; ++bj)
#pragma unroll
                    for (int n = 0; n < 2; ++n) {
                        f32x4 v = pg8::accf<Q8>(acc[ai][bj][m][n]);
                        if (Q8) v = v * sb[bj][n] * sa[ai][m];
                        *(f32x4*)(C + (size_t)row * ldc + col0 + bj * 128 + n * 16) = v;
                    }
            }
    }
};
typedef EpiF32_<false> EpiF32;
template <bool Q8> struct EpiKVQ_ {
    static constexpr bool PERM = true, AFTER_DRAIN = false, I8 = Q8;
    bf16_t* K; const float* SA; const float* SB;
    __device__ __forceinline__ void operator()(const pg8::f32x4 (&acc)[2][2][4][2], const pg8::Unit& u, int wr, int wc, int fr, int fq) const {
        const int t = u.pn >> 3;
        bf16_t* dst = K + (size_t)t * ((size_t)32 << 20);
        const int row0 = u.pm * 256 + wr * 64 + fr, col0 = (u.pn & 7) * 256 + wc * 32 + 8 * fq;
        float sa[2][4]; f32x4 sb[2][2];
#pragma unroll
        for (int ai = 0; ai < 2; ++ai)
#pragma unroll
            for (int m = 0; m < 4; ++m) sa[ai][m] = Q8 ? SA[row0 + ai * 128 + m * 16] : 1.0f;
#pragma unroll
        for (int bj = 0; bj < 2; ++bj)
#pragma unroll
            for (int n = 0; n < 2; ++n) sb[bj][n] = Q8 ? *(const f32x4*)(SB + u.pn * 256 + bj * 128 + wc * 32 + 8 * fq + 4 * n) : (f32x4){1.f, 1.f, 1.f, 1.f};
#pragma unroll
        for (int ai = 0; ai < 2; ++ai)
#pragma unroll
            for (int m = 0; m < 4; ++m)
#pragma unroll
                for (int bj = 0; bj < 2; ++bj) {
                    const int row = row0 + ai * 128 + m * 16;
                    f32x4 v0 = pg8::accf<Q8>(acc[ai][bj][m][0]), v1 = pg8::accf<Q8>(acc[ai][bj][m][1]);
                    if (Q8) { v0 = v0 * sb[bj][0] * sa[ai][m]; v1 = v1 * sb[bj][1] * sa[ai][m]; }
                    u32x4 w; w.x = pk_bf16(v0[0], v0[1]); w.y = pk_bf16(v0[2], v0[3]); w.z = pk_bf16(v1[0], v1[1]); w.w = pk_bf16(v1[2], v1[3]);
                    *(u32x4*)(dst + (size_t)row * DM + col0 + bj * 128) = w;
                }
    }
};
typedef EpiKVQ_<false> EpiKVQ;

template <bool Q8> struct EpiKVQR_ {
    static constexpr bool PERM = true, AFTER_DRAIN = false, I8 = Q8;
    bf16_t* K; const float* COS; const float* SIN; const float* SA; const float* SB;
    __device__ __forceinline__ void operator()(const pg8::f32x4 (&acc)[2][2][4][2], const pg8::Unit& u, int wr, int wc, int fr, int fq) const {
        const int t = u.pn >> 3;
        bf16_t* dst = K + (size_t)t * ((size_t)32 << 20);
        const int row0 = u.pm * 256 + wr * 64 + fr;
        const int g = 4 * wc + fq;
        const int col0 = (u.pn & 7) * 256 + wc * 32 + 8 * fq;
        float sa[2][4]; f32x4 sb[2][2];
#pragma unroll
        for (int ai = 0; ai < 2; ++ai)
#pragma unroll
            for (int m = 0; m < 4; ++m) sa[ai][m] = Q8 ? SA[row0 + ai * 128 + m * 16] : 1.0f;
#pragma unroll
        for (int bj = 0; bj < 2; ++bj)
#pragma unroll
            for (int n = 0; n < 2; ++n) sb[bj][n] = Q8 ? *(const f32x4*)(SB + u.pn * 256 + bj * 128 + wc * 32 + 8 * fq + 4 * n) : (f32x4){1.f, 1.f, 1.f, 1.f};
        if (t == 1) {
#pragma unroll
            for (int ai = 0; ai < 2; ++ai)
#pragma unroll
                for (int m = 0; m < 4; ++m)
#pragma unroll
                    for (int bj = 0; bj < 2; ++bj) {
                        const int row = row0 + ai * 128 + m * 16;
                        f32x4 a = pg8::accf<Q8>(acc[ai][bj][m][0]), b = pg8::accf<Q8>(acc[ai][bj][m][1]);
                        if (Q8) { a = a * sb[bj][0] * sa[ai][m]; b = b * sb[bj][1] * sa[ai][m]; }
                        u32x4 w; w.x = pk_bf16(a[0], a[1]); w.y = pk_bf16(a[2], a[3]); w.z = pk_bf16(b[0], b[1]); w.w = pk_bf16(b[2], b[3]);
                        *(u32x4*)(dst + (size_t)row * DM + col0 + bj * 128) = w;
                    }
        } else {
            const int pos0 = row0 & (SEQ - 1);
            f32x4 c = *(const f32x4*)(COS + pos0 * 64 + 4 * g), s_ = *(const f32x4*)(SIN + pos0 * 64 + 4 * g);
            const f32x4 c16 = *(const f32x4*)(COS + 16 * 64 + 4 * g), s16 = *(const f32x4*)(SIN + 16 * 64 + 4 * g), c128 = *(const f32x4*)(COS + 128 * 64 + 4 * g), s128 = *(const f32x4*)(SIN + 128 * 64 + 4 * g);
#pragma unroll
            for (int q = 0; q < 8; ++q) {
                const int ai = q >> 2, m = ai ? 7 - q : q;
#pragma unroll
                for (int bj = 0; bj < 2; ++bj) {
                    f32x4 a = pg8::accf<Q8>(acc[ai][bj][m][0]), b = pg8::accf<Q8>(acc[ai][bj][m][1]);
                    if (Q8) { a = a * sb[bj][0] * sa[ai][m]; b = b * sb[bj][1] * sa[ai][m]; }
                    u32x2 w1, w2;
                    w1.x = pk_bf16(a[0] * c[0] - b[0] * s_[0], a[1] * c[1] - b[1] * s_[1]); w1.y = pk_bf16(a[2] * c[2] - b[2] * s_[2], a[3] * c[3] - b[3] * s_[3]);
                    w2.x = pk_bf16(a[0] * s_[0] + b[0] * c[0], a[1] * s_[1] + b[1] * c[1]); w2.y = pk_bf16(a[2] * s_[2] + b[2] * c[2], a[3] * s_[3] + b[3] * c[3]);
                    bf16_t* p = dst + (size_t)(row0 + ai * 128 + m * 16) * DM + ((u.pn & 7) * 2 + bj) * 128 + 4 * g;
                    *(u32x2*)p = w1; *(u32x2*)(p + 64) = w2;
                }
                if (q < 3) { const f32x4 cn = c * c16 - s_ * s16, sn = s_ * c16 + c * s16; c = cn; s_ = sn; }
                else if (q == 3) { const f32x4 cn = c * c128 - s_ * s128, sn = s_ * c128 + c * s128; c = cn; s_ = sn; }
                else if (q < 7) { const f32x4 cn = c * c16 + s_ * s16, sn = s_ * c16 - c * s16; c = cn; s_ = sn; }
            }
        }
    }
};

__host__ __device__ __forceinline__ int rot_pos(int d) { return d < 64 ? 8 * (d >> 2) + (d & 3) : 8 * ((d - 64) >> 2) + 4 + (d & 3); }
__device__ __forceinline__ void transpose_tiles(LAS float* tile, const float* src, int ldn, int K, int N, bf16_t* dst, int nperm = 0) {
    const int tid = threadIdx.x;
    const int tn = N / 64, ntiles = tn * (K / 64);
    f32x4 nx[2];
#define TT_LOAD(tI_) { const int k0_ = ((tI_) / tn) * 64, n0_ = ((tI_) % tn) * 64; _Pragma("unroll") for (int r = 0; r < 2; ++r) nx[r] = *(const f32x4*)(src + (size_t)(k0_ + (tid >> 4) + 32 * r) * ldn + n0_ + (tid & 15) * 4); }
    if ((int)blockIdx.x < ntiles) TT_LOAD((int)blockIdx.x)
    for (int tI = blockIdx.x; tI < ntiles; tI += gridDim.x) {
        const int k0 = (tI / tn) * 64, n0 = (tI % tn) * 64;
        const f32x4 c0 = nx[0], c1 = nx[1];
        if (tI + (int)gridDim.x < ntiles) TT_LOAD(tI + (int)gridDim.x)
#pragma unroll
        for (int r = 0; r < 2; ++r) {
            const int kk = (tid >> 4) + 32 * r, nn = (tid & 15) * 4;
            const f32x4 v = r == 0 ? c0 : c1;
            tile[kk * 65 + nn + 0] = v[0]; tile[kk * 65 + nn + 1] = v[1]; tile[kk * 65 + nn + 2] = v[2]; tile[kk * 65 + nn + 3] = v[3];
        }
        __syncthreads();
        {
            const int nn = tid >> 3, kk8 = (tid & 7) * 8;
            float f[8];
#pragma unroll
            for (int j = 0; j < 8; ++j) f[j] = tile[(kk8 + j) * 65 + nn];
            u32x4 w; w.x = pk_bf16(f[0], f[1]); w.y = pk_bf16(f[2], f[3]); w.z = pk_bf16(f[4], f[5]); w.w = pk_bf16(f[6], f[7]);
            const int nsrc = n0 + nn, nrow = nsrc < nperm ? (nsrc & ~127) + rot_pos(nsrc & 127) : nsrc;
            *(u32x4*)(dst + (size_t)nrow * K + k0 + kk8) = w;
        }
        __syncthreads();
    }
}
#undef TT_LOAD
__device__ __forceinline__ void convert_bf16(const float* src, bf16_t* dst, size_t n) {
    const size_t stride = (size_t)gridDim.x * 512 * 8;
    for (size_t i = ((size_t)blockIdx.x * 512 + threadIdx.x) * 8; i < n; i += stride) {
        const f32x4 a = *(const f32x4*)(src + i), b = *(const f32x4*)(src + i + 4);
        u32x4 w; w.x = pk_bf16(a[0], a[1]); w.y = pk_bf16(a[2], a[3]); w.z = pk_bf16(b[0], b[1]); w.w = pk_bf16(b[2], b[3]);
        *(u32x4*)(dst + i) = w;
    }
}
__device__ __forceinline__ void split8(const f32x4 x0, const f32x4 x1, bf16x8& hi, bf16x8& lo) {
    u32x4 h, l;
    h.x = pk_bf16(x0[0], x0[1]); h.y = pk_bf16(x0[2], x0[3]); h.z = pk_bf16(x1[0], x1[1]); h.w = pk_bf16(x1[2], x1[3]);
    l.x = pk_bf16(x0[0] - bflo(h.x), x0[1] - bfhi(h.x)); l.y = pk_bf16(x0[2] - bflo(h.y), x0[3] - bfhi(h.y)); l.z = pk_bf16(x1[0] - bflo(h.z), x1[1] - bfhi(h.z)); l.w = pk_bf16(x1[2] - bflo(h.w), x1[3] - bfhi(h.w));
    hi = __builtin_bit_cast(bf16x8, h); lo = __builtin_bit_cast(bf16x8, l);
}
__device__ __forceinline__ void fold_peer_keys(const float* w_query, const float* sub_keys, bf16_t* WcT) {
    const int lane = threadIdx.x & 63, gw = blockIdx.x * 8 + (threadIdx.x >> 6), nw = gridDim.x * 8, r32 = lane & 31, hh2 = lane >> 5;
    for (int wt = gw; wt < 8192; wt += nw) {
        const int item = wt >> 3, sub = wt & 7, keyt = sub & 3, kint = sub >> 2;
        const int l = item >> 9, rem = item & 511, hh = rem >> 5, kb = rem & 31, h = hh >> 1, half = hh & 1;
        const float* sk = sub_keys + (size_t)(((l * 2 + half) * 8 + h) * 128 + keyt * 32 + r32) * 128 + 8 * hh2;
        const float* wq = w_query + (size_t)l * DM * DM + (size_t)(kb * 64 + kint * 32 + r32) * DM + h * 256 + half * 128 + 8 * hh2;
        f32x16 acc;
#pragma unroll
        for (int i = 0; i < 16; ++i) acc[i] = 0.f;
#pragma unroll 1
        for (int kh = 0; kh < 2; ++kh) {
            f32x4 av[8], bv[8];
#pragma unroll
            for (int ks = 0; ks < 4; ++ks) { const int kk = 64 * kh + 16 * ks; av[2 * ks] = *(const f32x4*)(wq + kk); av[2 * ks + 1] = *(const f32x4*)(wq + kk + 4); bv[2 * ks] = *(const f32x4*)(sk + kk); bv[2 * ks + 1] = *(const f32x4*)(sk + kk + 4); }
#pragma unroll
            for (int ks = 0; ks < 4; ++ks) {
                bf16x8 ah, al, bh, bl;
                split8(av[2 * ks], av[2 * ks + 1], ah, al); split8(bv[2 * ks], bv[2 * ks + 1], bh, bl);
                acc = __builtin_amdgcn_mfma_f32_32x32x16_bf16(al, bh, acc, 0, 0, 0);
                acc = __builtin_amdgcn_mfma_f32_32x32x16_bf16(ah, bl, acc, 0, 0, 0);
                acc = __builtin_amdgcn_mfma_f32_32x32x16_bf16(ah, bh, acc, 0, 0, 0);
            }
        }
        bf16_t* o = WcT + (size_t)l * DM * DM + (size_t)(h * 256 + half * 128 + keyt * 32 + r32) * DM + kb * 64 + kint * 32 + 4 * hh2;
#pragma unroll
        for (int q = 0; q < 4; ++q) { u32x2 w; w.x = pk_bf16(acc[4 * q], acc[4 * q + 1]); w.y = pk_bf16(acc[4 * q + 2], acc[4 * q + 3]); *(u32x2*)(o + 8 * q) = w; }
    }
}

__device__ __forceinline__ void quant_rows(const float* src, unsigned char* dst, float* scl, int nrows) {
    const int lane = threadIdx.x & 63, gw = blockIdx.x * 8 + (threadIdx.x >> 6), nw = gridDim.x * 8;
    for (int row = gw; row < nrows; row += nw) {
        const float* p = src + (size_t)row * DM;
        f32x4 v[8];
#pragma unroll
        for (int i = 0; i < 2; ++i)
#pragma unroll
            for (int q = 0; q < 4; ++q) v[i * 4 + q] = *(const f32x4*)(p + 1024 * i + 16 * lane + 4 * q);
        float am = 0.f;
#pragma unroll
        for (int i = 0; i < 8; ++i) am = fmaxf(am, fmaxf(fmaxf(fabsf(v[i][0]), fabsf(v[i][1])), fmaxf(fabsf(v[i][2]), fabsf(v[i][3]))));
        am = fmaxf(wave_max(am), 1e-30f);
        const float inv = 127.0f / am;
        if (lane == 0) scl[row] = am * (1.0f / 127.0f);
#pragma unroll
        for (int i = 0; i < 2; ++i) {
            u32x4 w;
#pragma unroll
            for (int q = 0; q < 4; ++q) {
                const f32x4 t = v[i * 4 + q];
                const unsigned b0 = (unsigned)(int)(rintf(t[0] * inv) + 128.0f), b1 = (unsigned)(int)(rintf(t[1] * inv) + 128.0f), b2 = (unsigned)(int)(rintf(t[2] * inv) + 128.0f), b3 = (unsigned)(int)(rintf(t[3] * inv) + 128.0f);
                w[q] = b0 | (b1 << 8) | (b2 << 16) | (b3 << 24);
            }
            *(u32x4*)(dst + (size_t)row * DM + 1024 * i + 16 * lane) = w;
        }
    }
}
__device__ __forceinline__ void quant_transpose(LAS unsigned char* lds, const float* src, int ldn, int N, signed char* dst, float* scl, int nperm = 0) {
    const int tid = threadIdx.x, kg = tid >> 3, c4 = (tid & 7) * 4, wv = tid >> 6;
    LAS float* red = (LAS float*)lds;
    for (int sI = blockIdx.x; sI < N / 32; sI += gridDim.x) {
        const int n0 = sI * 32;
        f32x4 v[32];
        const float* p = src + (size_t)(kg * 32) * ldn + n0 + c4;
#pragma unroll
        for (int it = 0; it < 32; ++it) v[it] = *(const f32x4*)(p + (size_t)it * ldn);
        f32x4 am = {0.f, 0.f, 0.f, 0.f};
#pragma unroll
        for (int it = 0; it < 32; ++it)
#pragma unroll
            for (int j = 0; j < 4; ++j) am[j] = fmaxf(am[j], fabsf(v[it][j]));
#pragma unroll
        for (int o = 8; o <= 32; o <<= 1)
#pragma unroll
            for (int j = 0; j < 4; ++j) am[j] = fmaxf(am[j], __shfl_xor(am[j], o));
        if ((tid & 63) < 8) *(LAS f32x4*)(red + wv * 32 + c4) = am;
        __syncthreads();
#pragma unroll
        for (int w = 0; w < 8; ++w) { const f32x4 r = *(const LAS f32x4*)(red + w * 32 + c4);
#pragma unroll
            for (int j = 0; j < 4; ++j) am[j] = fmaxf(am[j], r[j]); }
#pragma unroll
        for (int j = 0; j < 4; ++j) {
            const float m = fmaxf(am[j], 1e-30f), inv = 127.0f / m;
            const int nsrc = n0 + c4 + j, nrow = nsrc < nperm ? (nsrc & ~127) + rot_pos(nsrc & 127) : nsrc;
            if (kg == 0) scl[nrow] = m * (1.0f / 127.0f);
            signed char* o = dst + (size_t)nrow * DM + kg * 32;
#pragma unroll
            for (int h = 0; h < 2; ++h) {
                u32x4 w;
#pragma unroll
                for (int d = 0; d < 4; ++d) {
                    unsigned bb = 0;
#pragma unroll
                    for (int e = 0; e < 4; ++e) bb |= ((unsigned)(int)rintf(v[h * 16 + d * 4 + e][j] * inv) & 0xffu) << (8 * e);
                    w[d] = bb;
                }
                *(u32x4*)(o + h * 16) = w;
            }
        }
        __syncthreads();
    }
}
__device__ __forceinline__ void quant_rows_s(const float* src, signed char* dst, float* scl, int nrows) {
    const int lane = threadIdx.x & 63, gw = blockIdx.x * 8 + (threadIdx.x >> 6), nw = gridDim.x * 8;
    for (int row = gw; row < nrows; row += nw) {
        const float* p = src + (size_t)row * DM;
        f32x4 v[8];
#pragma unroll
        for (int i = 0; i < 2; ++i)
#pragma unroll
            for (int q = 0; q < 4; ++q) v[i * 4 + q] = *(const f32x4*)(p + 1024 * i + 16 * lane + 4 * q);
        float am = 0.f;
#pragma unroll
        for (int i = 0; i < 8; ++i) am = fmaxf(am, fmaxf(fmaxf(fabsf(v[i][0]), fabsf(v[i][1])), fmaxf(fabsf(v[i][2]), fabsf(v[i][3]))));
        am = fmaxf(wave_max(am), 1e-30f);
        const float inv = 127.0f / am;
        if (lane == 0) scl[row] = am * (1.0f / 127.0f);
#pragma unroll
        for (int i = 0; i < 2; ++i) {
            u32x4 w;
#pragma unroll
            for (int q = 0; q < 4; ++q) {
                const f32x4 t = v[i * 4 + q];
                w[q] = ((unsigned)(int)rintf(t[0] * inv) & 0xffu) | (((unsigned)(int)rintf(t[1] * inv) & 0xffu) << 8) | (((unsigned)(int)rintf(t[2] * inv) & 0xffu) << 16) | (((unsigned)(int)rintf(t[3] * inv) & 0xffu) << 24);
            }
            *(u32x4*)(dst + (size_t)row * DM + 1024 * i + 16 * lane) = w;
        }
    }
}
__device__ __forceinline__ void quant_rows_bf16(const bf16_t* src, signed char* dst, float* scl, int nrows) {
    const int lane = threadIdx.x & 63, gw = blockIdx.x * 8 + (threadIdx.x >> 6), nw = gridDim.x * 8;
    for (int row = gw; row < nrows; row += nw) {
        u32x4 v[4];
#pragma unroll
        for (int i = 0; i < 4; ++i) v[i] = *(const u32x4*)(src + (size_t)row * DM + 512 * i + 8 * lane);
        float am = 0.f;
#pragma unroll
        for (int i = 0; i < 4; ++i)
#pragma unroll
            for (int d = 0; d < 4; ++d) am = fmaxf(am, fmaxf(fabsf(bflo(v[i][d])), fabsf(bfhi(v[i][d]))));
        am = fmaxf(wave_max(am), 1e-30f);
        const float inv = 127.0f / am;
        if (lane == 0) scl[row] = am * (1.0f / 127.0f);
#pragma unroll
        for (int i = 0; i < 4; ++i) {
            u32x2 w;
            w.x = ((unsigned)(int)rintf(bflo(v[i].x) * inv) & 0xffu) | (((unsigned)(int)rintf(bfhi(v[i].x) * inv) & 0xffu) << 8) | (((unsigned)(int)rintf(bflo(v[i].y) * inv) & 0xffu) << 16) | (((unsigned)(int)rintf(bfhi(v[i].y) * inv) & 0xffu) << 24);
            w.y = ((unsigned)(int)rintf(bflo(v[i].z) * inv) & 0xffu) | (((unsigned)(int)rintf(bfhi(v[i].z) * inv) & 0xffu) << 8) | (((unsigned)(int)rintf(bflo(v[i].w) * inv) & 0xffu) << 16) | (((unsigned)(int)rintf(bfhi(v[i].w) * inv) & 0xffu) << 24);
            *(u32x2*)(dst + (size_t)row * DM + 512 * i + 8 * lane) = w;
        }
    }
}
__device__ __forceinline__ void phase_prep(const Args& a, LAS unsigned char* lds) {
    unsigned char* ws = a.ws;
    LAS float* tile = (LAS float*)lds;
    quant_transpose(lds, a.in[1], 4 * DM, 4 * DM, (signed char*)(ws + WS_WIN), (float*)(ws + WS_SWIN));
    transpose_tiles(tile, a.in[3], DM, DM, DM, (bf16_t*)(ws + WS_WOUT));
    quant_transpose(lds, a.in[5], 2 * DM, 2 * DM, (signed char*)(ws + WS_WKVQ), (float*)(ws + WS_SWKVQ), DM);
    quant_transpose(lds, a.in[6], DM, DM, (signed char*)(ws + WS_WKVQ) + (size_t)2 * DM * DM, (float*)(ws + WS_SWKVQ) + 2 * DM, DM);
    quant_transpose(lds, a.in[7], DM, DM, (signed char*)(ws + WS_WO), (float*)(ws + WS_SWO));
    fold_peer_keys(a.in[8], a.in[9], (bf16_t*)(ws + WS_WC));
    quant_rows_s(a.in[0], (signed char*)(ws + slot(0)), (float*)(ws + WS_XS0), MTOK);
    const int gtid = blockIdx.x * 512 + threadIdx.x, gthreads = gridDim.x * 512;
    float* COS = (float*)(ws + WS_COS); float* SIN = (float*)(ws + WS_SIN); float* LB = (float*)(ws + WS_LB);
    for (int i = gtid; i < SEQ * 64; i += gthreads) {
        const int pos = i >> 6, j = i & 63;
        double inv = 1.0; const double r = 0.86596432336006535;
        for (int q = 0; q < j; ++q) inv *= r;
        const float ang = (float)pos * (float)inv;
        const double x = (double)ang;
        const double n = __builtin_rint(x * 0.15915494309189535);
        const float rf = (float)__builtin_fma(-n, 6.283185307179586, x);
        COS[i] = cosf(rf); SIN[i] = sinf(rf);
    }
    for (int c = gtid; c < DM; c += gthreads) { const float l0 = a.in[4][c], l1 = a.in[4][DM + c]; LB[c] = 1.0f / (1.0f + expf(l1 - l0)); }
}

__device__ __forceinline__ void phase_scan_naive(const bf16_t* Q1, const float* LF, const bf16_t* I1, float* O) {
    const int lane = threadIdx.x & 63, gw = blockIdx.x * 8 + (threadIdx.x >> 6), nw = gridDim.x * 8;
    for (int item = gw; item < 2 * NHEAD * 128; item += nw) {
        const int bh = item >> 7, v = item & 127, b = bh >> 4, h = bh & 15;
        const size_t base = (size_t)b * SEQ * DM + h * 128;
        float S0 = 0.f, S1 = 0.f;
#pragma unroll 4
        for (int t = 0; t < SEQ; ++t) {
            const size_t ro = base + (size_t)t * DM;
            const float f0 = __expf(LF[ro + lane]), f1 = __expf(LF[ro + 64 + lane]);
            const float q0 = bf2f(Q1[ro + lane]), q1 = bf2f(Q1[ro + 64 + lane]);
            const float iv = bf2f(I1[ro + v]);
            S0 = f0 * S0 + (1.0f - f0) * iv; S1 = f1 * S1 + (1.0f - f1) * iv;
            const float p = wave_sum(q0 * S0 + q1 * S1);
            if (lane == 0) O[ro + v] = p;
        }
    }
}
__device__ __forceinline__ void phase_onorm(const float* O, const bf16_t* G1, const float* gnorm, bf16_t* OG) {
    const int lane = threadIdx.x & 63, gw = blockIdx.x * 8 + (threadIdx.x >> 6), nw = gridDim.x * 8;
    const float gn0 = gnorm[2 * lane], gn1 = gnorm[2 * lane + 1];
    for (int item = gw; item < MTOK * NHEAD; item += nw) {
        const size_t off = (size_t)item * 128 + 2 * lane;
        const float o0 = O[off], o1 = O[off + 1];
        const float ss = wave_sum(o0 * o0 + o1 * o1);
        const float r = rsqrtf(ss * (1.0f / 128.0f) + 1e-6f);
        const unsigned g = *(const unsigned*)(G1 + off);
        *(unsigned*)(OG + off) = pk_bf16(o0 * r * gn0 * bflo(g), o1 * r * gn1 * bfhi(g));
    }
}

__device__ __forceinline__ void ln_row_store(float (&v)[32], const float* g, const float* bta, float* outf, bf16_t* outb, int lane, signed char* outq = nullptr, float* outs = nullptr) {
    float s = 0.f;
#pragma unroll
    for (int i = 0; i < 32; ++i) s += v[i];
    const float mu = wave_sum(s) * (1.0f / DM);
    float q = 0.f;
#pragma unroll
    for (int i = 0; i < 32; ++i) { v[i] -= mu; q += v[i] * v[i]; }
    const float rstd = rsqrtf(wave_sum(q) * (1.0f / DM) + 1e-5f);
    float am = 0.f;
#pragma unroll
    for (int i = 0; i < 4; ++i) {
        const int c = 512 * i + 8 * lane;
        const f32x4 g0 = *(const f32x4*)(g + c), g1 = *(const f32x4*)(g + c + 4), b0 = *(const f32x4*)(bta + c), b1 = *(const f32x4*)(bta + c + 4);
        f32x4 o0, o1;
#pragma unroll
        for (int j = 0; j < 4; ++j) { o0[j] = v[i * 8 + j] * rstd * g0[j] + b0[j]; o1[j] = v[i * 8 + 4 + j] * rstd * g1[j] + b1[j]; v[i * 8 + j] = o0[j]; v[i * 8 + 4 + j] = o1[j]; am = fmaxf(am, fmaxf(fabsf(o0[j]), fabsf(o1[j]))); }
        if (outf) { *(f32x4*)(outf + c) = o0; *(f32x4*)(outf + c + 4) = o1; }
        if (outb) { u32x4 w; w.x = pk_bf16(o0[0], o0[1]); w.y = pk_bf16(o0[2], o0[3]); w.z = pk_bf16(o1[0], o1[1]); w.w = pk_bf16(o1[2], o1[3]); *(u32x4*)(outb + c) = w; }
    }
    if (outq) {
        am = fmaxf(wave_max(am), 1e-30f);
        const float inv = 127.0f / am;
        if (lane == 0) *outs = am * (1.0f / 127.0f);
#pragma unroll
        for (int i = 0; i < 4; ++i) {
            u32x2 w;
            w.x = ((unsigned)(int)rintf(v[i * 8 + 0] * inv) & 0xffu) | (((unsigned)(int)rintf(v[i * 8 + 1] * inv) & 0xffu) << 8) | (((unsigned)(int)rintf(v[i * 8 + 2] * inv) & 0xffu) << 16) | (((unsigned)(int)rintf(v[i * 8 + 3] * inv) & 0xffu) << 24);
            w.y = ((unsigned)(int)rintf(v[i * 8 + 4] * inv) & 0xffu) | (((unsigned)(int)rintf(v[i * 8 + 5] * inv) & 0xffu) << 8) | (((unsigned)(int)rintf(v[i * 8 + 6] * inv) & 0xffu) << 16) | (((unsigned)(int)rintf(v[i * 8 + 7] * inv) & 0xffu) << 24);
            *(u32x2*)(outq + 512 * i + 8 * lane) = w;
        }
    }
}
__device__ __forceinline__ void ln_row_store16(float (&v)[32], const float* g, const float* bta, float* outf, bf16_t* outb, int lane) {
    float s = 0.f;
#pragma unroll
    for (int i = 0; i < 32; ++i) s += v[i];
    const float mu = wave_sum(s) * (1.0f / DM);
    float q = 0.f;
#pragma unroll
    for (int i = 0; i < 32; ++i) { v[i] -= mu; q += v[i] * v[i]; }
    const float rstd = rsqrtf(wave_sum(q) * (1.0f / DM) + 1e-5f);
#pragma unroll
    for (int i = 0; i < 2; ++i) {
        const int c = 1024 * i + 16 * lane;
        f32x4 o[4];
#pragma unroll
        for (int qd = 0; qd < 4; ++qd) {
            const f32x4 gg = *(const f32x4*)(g + c + 4 * qd), bb = *(const f32x4*)(bta + c + 4 * qd);
#pragma unroll
            for (int j = 0; j < 4; ++j) o[qd][j] = v[16 * i + 4 * qd + j] * rstd * gg[j] + bb[j];
            *(f32x4*)(outf + c + 4 * qd) = o[qd];
        }
        if (outb) {
            u32x4 w0, w1;
            w0.x = pk_bf16(o[0][0], o[0][1]); w0.y = pk_bf16(o[0][2], o[0][3]); w0.z = pk_bf16(o[1][0], o[1][1]); w0.w = pk_bf16(o[1][2], o[1][3]);
            w1.x = pk_bf16(o[2][0], o[2][1]); w1.y = pk_bf16(o[2][2], o[2][3]); w1.z = pk_bf16(o[3][0], o[3][1]); w1.w = pk_bf16(o[3][2], o[3][3]);
            *(u32x4*)(outb + c) = w0; *(u32x4*)(outb + c + 8) = w1;
        }
    }
}
template <bool RES16> __device__ __forceinline__ void phase_ln(const bf16_t* Y, const void* RESv, const float* g, const float* bta, float* outf, bf16_t* outb, signed char* outq = nullptr, float* outs = nullptr) {
    const int lane = threadIdx.x & 63, gw = blockIdx.x * 8 + (threadIdx.x >> 6), nw = gridDim.x * 8;
    for (int row = gw; row < MTOK; row += nw) {
        float v[32];
        const bf16_t* p = Y + (size_t)row * DM;
#pragma unroll
        for (int i = 0; i < 4; ++i) {
            const u32x4 yw = *(const u32x4*)(p + 512 * i + 8 * lane);
            const f32x4 a = {bflo(yw.x), bfhi(yw.x), bflo(yw.y), bfhi(yw.y)}, b = {bflo(yw.z), bfhi(yw.z), bflo(yw.w), bfhi(yw.w)};
            f32x4 ra, rb;
            if (RES16) { const u32x4 w = *(const u32x4*)((const bf16_t*)RESv + (size_t)row * DM + 512 * i + 8 * lane); ra = (f32x4){bflo(w.x), bfhi(w.x), bflo(w.y), bfhi(w.y)}; rb = (f32x4){bflo(w.z), bfhi(w.z), bflo(w.w), bfhi(w.w)}; }
            else { const float* rp = (const float*)RESv + (size_t)row * DM; ra = *(const f32x4*)(rp + 512 * i + 8 * lane); rb = *(const f32x4*)(rp + 512 * i + 8 * lane + 4); }
#pragma unroll
            for (int j = 0; j < 4; ++j) { v[i * 8 + j] = a[j] + ALPHA * ra[j]; v[i * 8 + 4 + j] = b[j] + ALPHA * rb[j]; }
        }
        ln_row_store(v, g, bta, outf ? outf + (size_t)row * DM : nullptr, outb ? outb + (size_t)row * DM : nullptr, lane, outq ? outq + (size_t)row * DM : nullptr, outs ? outs + row : nullptr);
    }
}

__device__ __forceinline__ void wave_argmax(float& v, int& idx) {
#pragma unroll
    for (int o = 32; o >= 1; o >>= 1) {
        const float ov = __shfl_xor(v, o); const int oi = __shfl_xor(idx, o);
        if (ov > v || (ov == v && oi < idx)) { v = ov; idx = oi; }
    }
}
__device__ __forceinline__ unsigned fkey(float x) { const unsigned u = __float_as_uint(x); return u ^ (unsigned)(((int)u >> 31) | 0x80000000); }
__device__ __forceinline__ float funkey(unsigned k) { const unsigned u = (k & 0x80000000u) ? (k ^ 0x80000000u) : ~k; return __uint_as_float(u); }
__device__ __forceinline__ void sort16_insert(unsigned (&r)[16], unsigned v) {
#pragma unroll
    for (int i = 0; i < 16; ++i) { const unsigned m = r[i] > v ? r[i] : v; v = r[i] > v ? v : r[i]; r[i] = m; }
}
__device__ __forceinline__ void phase_topk(LAS unsigned char* lds, const float* SCT, int* EID, float* GATE) {
    LAS unsigned char* ib = lds + threadIdx.x * 32;
    for (int item = blockIdx.x * 512 + threadIdx.x; item < MTOK * 8; item += gridDim.x * 512) {
        const int h = item >> 14, tok = item & (MTOK - 1);
        const float* p = SCT + (size_t)(h * 256) * MTOK + tok;
        unsigned r1[16], r2[16];
#pragma unroll
        for (int i = 0; i < 16; ++i) { r1[i] = 0u; r2[i] = 0u; }
#pragma unroll 8
        for (int e = 0; e < 128; ++e) {
            const float x1 = p[(size_t)e * MTOK], x2 = p[(size_t)(128 + e) * MTOK];
            sort16_insert(r1, (fkey(x1) & ~0x7Fu) | (unsigned)e);
            sort16_insert(r2, (fkey(x2) & ~0x7Fu) | (unsigned)e);
        }
        float v1[16], v2[16];
#pragma unroll
        for (int i = 0; i < 16; ++i) { v1[i] = funkey(r1[i] & ~0x7Fu); v2[i] = funkey(r2[i] & ~0x7Fu); ib[i] = (unsigned char)(r1[i] & 0x7Fu); ib[16 + i] = (unsigned char)(r2[i] & 0x7Fu); }
        unsigned r3[16];
#pragma unroll
        for (int i = 0; i < 16; ++i) r3[i] = 0u;
#pragma unroll
        for (int a = 0; a < 16; ++a)
#pragma unroll
            for (int bq = 0; bq < 16; ++bq)
                if ((a + 1) * (bq + 1) <= 16) sort16_insert(r3, (fkey(v1[a] + v2[bq]) & ~0xFFu) | (unsigned)(a * 16 + bq));
        const float mx = funkey(r3[0] & ~0xFFu);
        float ev[16]; float sum = 0.f;
#pragma unroll
        for (int i = 0; i < 16; ++i) { ev[i] = __expf(funkey(r3[i] & ~0xFFu) - mx); sum += ev[i]; }
        const float rs = 1.0f / sum;
        int eid[16];
#pragma unroll
        for (int i = 0; i < 16; ++i) { const unsigned f = r3[i] & 0xFFu; eid[i] = (int)ib[f >> 4] * 128 + (int)ib[16 + (f & 15u)]; }
        int* eo = EID + (size_t)tok * 128 + h * 16; float* go = GATE + (size_t)tok * 128 + h * 16;
#pragma unroll
        for (int q = 0; q < 4; ++q) {
            *(u32x4*)(eo + 4 * q) = (u32x4){(unsigned)eid[4 * q], (unsigned)eid[4 * q + 1], (unsigned)eid[4 * q + 2], (unsigned)eid[4 * q + 3]};
            *(f32x4*)(go + 4 * q) = (f32x4){ev[4 * q] * rs, ev[4 * q + 1] * rs, ev[4 * q + 2] * rs, ev[4 * q + 3] * rs};
        }
    }
}

__device__ __forceinline__ float gelu_erf(float x) { return 0.5f * x * (1.0f + erff(x * 0.70710678118654752f)); }
__device__ __forceinline__ float ub0(unsigned w) { return (float)(w & 0xffu); }
__device__ __forceinline__ float ub1(unsigned w) { return (float)((w >> 8) & 0xffu); }
__device__ __forceinline__ float ub2(unsigned w) { return (float)((w >> 16) & 0xffu); }
__device__ __forceinline__ float ub3(unsigned w) { return (float)(w >> 24); }
__device__ __forceinline__ void phase_peer(LAS unsigned char* lds, const float* X, const int* EID, const float* GATE, const unsigned char* U, const unsigned char* V, const float* USC, const float* VSC,
                                           const float* g, const float* bta, float* outf, bf16_t* outb) {
    const int lane = threadIdx.x & 63, wv = threadIdx.x >> 6, gw = blockIdx.x * 8 + wv, nw = gridDim.x * 8;
    LAS float* hb = (LAS float*)(lds + wv * 512);
    for (int tok = gw; tok < MTOK; tok += nw) {
        float x[32];
        const float* xp = X + (size_t)tok * DM;
#pragma unroll
        for (int i = 0; i < 2; ++i)
#pragma unroll
            for (int q = 0; q < 4; ++q) { const f32x4 t = *(const f32x4*)(xp + 1024 * i + 16 * lane + 4 * q); x[16 * i + 4 * q] = t[0]; x[16 * i + 4 * q + 1] = t[1]; x[16 * i + 4 * q + 2] = t[2]; x[16 * i + 4 * q + 3] = t[3]; }
        float sx = 0.f;
#pragma unroll
        for (int j = 0; j < 32; ++j) sx += x[j];
        const float d0 = -128.0f * sx;
        const int e0 = EID[(size_t)tok * 128 + lane], e1 = EID[(size_t)tok * 128 + 64 + lane];
        const float g0 = GATE[(size_t)tok * 128 + lane], g1 = GATE[(size_t)tok * 128 + 64 + lane];
        for (int bt = 0; bt < 16; ++bt) {
            float d[8];
#pragma unroll
            for (int r = 0; r < 8; ++r) {
                const int e = bt * 8 + r;
                const int idx = __builtin_amdgcn_readfirstlane(__shfl(bt < 8 ? e0 : e1, e & 63));
                const u32x4* up = (const u32x4*)(U + (size_t)idx * DM) + lane;
                float acc = d0;
#pragma unroll
                for (int i = 0; i < 2; ++i) {
                    const u32x4 w = up[i * 64];
                    acc += x[16 * i + 0] * ub0(w.x) + x[16 * i + 1] * ub1(w.x) + x[16 * i + 2] * ub2(w.x) + x[16 * i + 3] * ub3(w.x)
                         + x[16 * i + 4] * ub0(w.y) + x[16 * i + 5] * ub1(w.y) + x[16 * i + 6] * ub2(w.y) + x[16 * i + 7] * ub3(w.y)
                         + x[16 * i + 8] * ub0(w.z) + x[16 * i + 9] * ub1(w.z) + x[16 * i + 10] * ub2(w.z) + x[16 * i + 11] * ub3(w.z)
                         + x[16 * i + 12] * ub0(w.w) + x[16 * i + 13] * ub1(w.w) + x[16 * i + 14] * ub2(w.w) + x[16 * i + 15] * ub3(w.w);
                }
                d[r] = acc;
            }
            const bool b5 = lane & 32, b4 = lane & 16, b3 = lane & 8;
            float t4[4];
#pragma unroll
            for (int q = 0; q < 4; ++q) { const float keep = b5 ? d[4 + q] : d[q], send = b5 ? d[q] : d[4 + q]; t4[q] = keep + __shfl_xor(send, 32); }
            float t2[2];
#pragma unroll
            for (int q = 0; q < 2; ++q) { const float keep = b4 ? t4[2 + q] : t4[q], send = b4 ? t4[q] : t4[2 + q]; t2[q] = keep + __shfl_xor(send, 16); }
            float t1;
            { const float keep = b3 ? t2[1] : t2[0], send = b3 ? t2[0] : t2[1]; t1 = keep + __shfl_xor(send, 8); }
            t1 += __shfl_xor(t1, 4); t1 += __shfl_xor(t1, 2); t1 += __shfl_xor(t1, 1);
            if ((lane & 7) == 0) hb[bt * 8 + (lane >> 3 & 1) + 2 * (lane >> 4 & 1) + 4 * (lane >> 5 & 1)] = t1;
        }
        asm volatile("s_waitcnt lgkmcnt(0)" ::: "memory");
        const float h0 = hb[lane] * USC[e0], h1 = hb[64 + lane] * USC[e1];
        const float w0 = g0 * gelu_erf(h0) * VSC[e0], w1 = g1 * gelu_erf(h1) * VSC[e1];
        float wsum = wave_sum(w0 + w1);
        float y[32];
#pragma unroll
        for (int i = 0; i < 32; ++i) y[i] = 0.f;
#pragma unroll 8
        for (int e = 0; e < 128; ++e) {
            const int idx = __builtin_amdgcn_readfirstlane(__shfl(e < 64 ? e0 : e1, e & 63));
            const float wt = __shfl(e < 64 ? w0 : w1, e & 63);
            const u32x4* vp = (const u32x4*)(V + (size_t)idx * DM) + lane;
#pragma unroll
            for (int i = 0; i < 2; ++i) {
                const u32x4 w = vp[i * 64];
                y[16 * i + 0] += wt * ub0(w.x); y[16 * i + 1] += wt * ub1(w.x); y[16 * i + 2] += wt * ub2(w.x); y[16 * i + 3] += wt * ub3(w.x);
                y[16 * i + 4] += wt * ub0(w.y); y[16 * i + 5] += wt * ub1(w.y); y[16 * i + 6] += wt * ub2(w.y); y[16 * i + 7] += wt * ub3(w.y);
                y[16 * i + 8] += wt * ub0(w.z); y[16 * i + 9] += wt * ub1(w.z); y[16 * i + 10] += wt * ub2(w.z); y[16 * i + 11] += wt * ub3(w.z);
                y[16 * i + 12] += wt * ub0(w.w); y[16 * i + 13] += wt * ub1(w.w); y[16 * i + 14] += wt * ub2(w.w); y[16 * i + 15] += wt * ub3(w.w);
            }
        }
        const float corr = -128.0f * wsum;
#pragma unroll
        for (int i = 0; i < 32; ++i) y[i] = y[i] + corr + ALPHA * x[i];
        ln_row_store16(y, g, bta, outf + (size_t)tok * DM, outb ? outb + (size_t)tok * DM : nullptr, lane);
        asm volatile("s_waitcnt lgkmcnt(0)" ::: "memory");
    }
}

__device__ __forceinline__ int row_dot_i8(const u32x4 (&xq)[2], const unsigned char* rowp, int lane) {
    const u32x4* up = (const u32x4*)rowp + lane;
    int acc = 0;
#pragma unroll
    for (int i = 0; i < 2; ++i) {
        const u32x4 w = up[i * 64];
        acc = __builtin_amdgcn_sdot4((int)xq[i].x, (int)(w.x ^ 0x80808080u), acc, false); acc = __builtin_amdgcn_sdot4((int)xq[i].y, (int)(w.y ^ 0x80808080u), acc, false);
        acc = __builtin_amdgcn_sdot4((int)xq[i].z, (int)(w.z ^ 0x80808080u), acc, false); acc = __builtin_amdgcn_sdot4((int)xq[i].w, (int)(w.w ^ 0x80808080u), acc, false);
    }
    return acc;
}
__device__ __forceinline__ void peer_issue8(u32x4 (&seg)[8], const unsigned char* base, const u32x4 ia, const u32x4 ib) {
    seg[0] = *(const u32x4*)(base + (size_t)ia.x * DM); seg[1] = *(const u32x4*)(base + (size_t)ia.y * DM); seg[2] = *(const u32x4*)(base + (size_t)ia.z * DM); seg[3] = *(const u32x4*)(base + (size_t)ia.w * DM);
    seg[4] = *(const u32x4*)(base + (size_t)ib.x * DM); seg[5] = *(const u32x4*)(base + (size_t)ib.y * DM); seg[6] = *(const u32x4*)(base + (size_t)ib.z * DM); seg[7] = *(const u32x4*)(base + (size_t)ib.w * DM);
}
__device__ __forceinline__ void peer_dot8(int (&d)[8], const u32x4 (&seg)[8], const u32x4 xq) {
#pragma unroll
    for (int i = 0; i < 8; ++i) {
        int acc = __builtin_amdgcn_sdot4((int)xq.x, (int)(seg[i].x ^ 0x80808080u), 0, false);
        acc = __builtin_amdgcn_sdot4((int)xq.y, (int)(seg[i].y ^ 0x80808080u), acc, false);
        acc = __builtin_amdgcn_sdot4((int)xq.z, (int)(seg[i].z ^ 0x80808080u), acc, false);
        d[i] = __builtin_amdgcn_sdot4((int)xq.w, (int)(seg[i].w ^ 0x80808080u), acc, false);
    }
}
__device__ __forceinline__ void phase_peer_u(const signed char* XQ, const int* EID, const unsigned char* U, LAS int* HL  ) {
    const int lane = threadIdx.x & 63, wv = threadIdx.x >> 6, es = lane >> 3, cc = lane & 7;
    const bool b2 = cc & 4, b1 = cc & 2, b0 = cc & 1;
    const int nw = gridDim.x * 8, gw = blockIdx.x * 8 + wv, tpw = (MTOK + nw - 1) / nw, tbase = gw * tpw;
    int cnt = MTOK - tbase; cnt = cnt > tpw ? tpw : cnt;
    if (cnt <= 0) return;
    for (int i = lane; i < cnt * 128; i += 64) HL[i] = 0;
    asm volatile("s_waitcnt lgkmcnt(0)" ::: "memory");
    const int nit = 16 * cnt;
    const unsigned char* ub = U + cc * 16;
    u32x4 m0a, m0b, m0c, m0d, m0x, m1a, m1b, m1c, m1d, m1x, m2a, m2b, m2c, m2d, m2x; u32x4 sA[8], sB[8];
#define PU_LOAD(sl_, k_, A_, B_, C_, D_, X_) { const int* ep_ = EID + (size_t)(tbase + (k_)) * 128 + es * 16; A_ = *(const u32x4*)ep_; B_ = *(const u32x4*)(ep_ + 4); C_ = *(const u32x4*)(ep_ + 8); D_ = *(const u32x4*)(ep_ + 12); \
        X_ = *(const u32x4*)(XQ + (size_t)(tbase + (k_)) * DM + (sl_) * 128 + cc * 16); }
#define PU_NEXT(sl_, k_, sn_, kn_) { kn_ = (k_) + 1; sn_ = (sl_); if (kn_ == cnt) { kn_ = 0; ++sn_; } if (sn_ == 16) { sn_ = 15; kn_ = cnt - 1; } }
    int sl = 0, k = 0, sl1, k1, sl2, k2;
    PU_NEXT(sl, k, sl1, k1) PU_NEXT(sl1, k1, sl2, k2)
    PU_LOAD(sl, k, m0a, m0b, m0c, m0d, m0x)
    PU_LOAD(sl1, k1, m1a, m1b, m1c, m1d, m1x)
    peer_issue8(sA, ub + sl * 128, m0a, m0b);
    for (int it = 0; it < nit; ++it) {
        PU_LOAD(sl2, k2, m2a, m2b, m2c, m2d, m2x)
        peer_issue8(sB, ub + sl * 128, m0c, m0d);
        int dlo[8]; peer_dot8(dlo, sA, m0x);
        peer_issue8(sA, ub + sl1 * 128, m1a, m1b);
        int dhi[8]; peer_dot8(dhi, sB, m0x);
        int t8[8], t4[4], t2[2];
#pragma unroll
        for (int q = 0; q < 8; ++q) { const int keep = b2 ? dhi[q] : dlo[q], send = b2 ? dlo[q] : dhi[q]; t8[q] = keep + __shfl_xor(send, 4); }
#pragma unroll
        for (int q = 0; q < 4; ++q) { const int keep = b1 ? t8[4 + q] : t8[q], send = b1 ? t8[q] : t8[4 + q]; t4[q] = keep + __shfl_xor(send, 2); }
#pragma unroll
        for (int q = 0; q < 2; ++q) { const int keep = b0 ? t4[2 + q] : t4[q], send = b0 ? t4[q] : t4[2 + q]; t2[q] = keep + __shfl_xor(send, 1); }
        { LAS int* hp = HL + k * 128 + es * 16 + (b2 ? 8 : 0) + (b1 ? 4 : 0) + (b0 ? 2 : 0);
          __hip_atomic_fetch_add(hp, t2[0], __ATOMIC_RELAXED, __HIP_MEMORY_SCOPE_WORKGROUP); __hip_atomic_fetch_add(hp + 1, t2[1], __ATOMIC_RELAXED, __HIP_MEMORY_SCOPE_WORKGROUP); }
        sl = sl1; k = k1; sl1 = sl2; k1 = k2; PU_NEXT(sl1, k1, sl2, k2)
        m0a = m1a; m0b = m1b; m0c = m1c; m0d = m1d; m0x = m1x; m1a = m2a; m1b = m2b; m1c = m2c; m1d = m2d; m1x = m2x;
    }
#undef PU_LOAD
#undef PU_NEXT
}
__device__ __forceinline__ void phase_peer_w(const LAS int* HL, const float* XS, const int* EID, const float* GATE, const float* USC, const float* VSC, signed char* WQ, float* SW) {
    const int lane = threadIdx.x & 63, gw = blockIdx.x * 8 + (threadIdx.x >> 6), nw = gridDim.x * 8, tpw = (MTOK + nw - 1) / nw, tbase = gw * tpw;
    const int tend = tbase + tpw < MTOK ? tbase + tpw : MTOK;
    for (int tok = tbase; tok < tend; ++tok) {
        const int h0 = HL[(tok - tbase) * 128 + lane], h1 = HL[(tok - tbase) * 128 + 64 + lane];
        const int e0 = EID[(size_t)tok * 128 + lane], e1 = EID[(size_t)tok * 128 + 64 + lane];
        const float xs = XS[tok];
        const float w0 = GATE[(size_t)tok * 128 + lane] * gelu_erf((float)h0 * xs * USC[e0]) * VSC[e0];
        const float w1 = GATE[(size_t)tok * 128 + 64 + lane] * gelu_erf((float)h1 * xs * USC[e1]) * VSC[e1];
        const float am = fmaxf(wave_max(fmaxf(fabsf(w0), fabsf(w1))), 1e-30f), inv = 127.0f / am;
        WQ[(size_t)tok * 128 + lane] = (signed char)(int)rintf(w0 * inv); WQ[(size_t)tok * 128 + 64 + lane] = (signed char)(int)rintf(w1 * inv);
        if (lane == 0) SW[tok] = am * (1.0f / 127.0f);
    }
}
__device__ __forceinline__ void peer_dot4x4(int (&acc)[16], const u32x4 sa, const u32x4 sb, const u32x4 sc, const u32x4 sd, const unsigned w4) {
#pragma unroll
    for (int k = 0; k < 4; ++k) {
        const unsigned A = sa[k], B = sb[k], C = sc[k], D = sd[k];
        const unsigned p0 = __builtin_amdgcn_perm(B, A, 0x05010400u);
        const unsigned p1 = __builtin_amdgcn_perm(B, A, 0x07030602u);
        const unsigned p2 = __builtin_amdgcn_perm(D, C, 0x05010400u);
        const unsigned p3 = __builtin_amdgcn_perm(D, C, 0x07030602u);
        const unsigned t0 = __builtin_amdgcn_perm(p2, p0, 0x05040100u);
        const unsigned t1 = __builtin_amdgcn_perm(p2, p0, 0x07060302u);
        const unsigned t2 = __builtin_amdgcn_perm(p3, p1, 0x05040100u);
        const unsigned t3 = __builtin_amdgcn_perm(p3, p1, 0x07060302u);
        acc[4 * k + 0] = __builtin_amdgcn_sdot4((int)t0, (int)w4, acc[4 * k + 0], false);
        acc[4 * k + 1] = __builtin_amdgcn_sdot4((int)t1, (int)w4, acc[4 * k + 1], false);
        acc[4 * k + 2] = __builtin_amdgcn_sdot4((int)t2, (int)w4, acc[4 * k + 2], false);
        acc[4 * k + 3] = __builtin_amdgcn_sdot4((int)t3, (int)w4, acc[4 * k + 3], false);
    }
}
__device__ __forceinline__ void phase_peer_v(const bf16_t* X, const int* EID, const signed char* WQ, const float* SW, const unsigned char* V, float* Y) {
    const int lane = threadIdx.x & 63, wv = threadIdx.x >> 6, es = lane >> 3, cc = lane & 7;
    const bool b5 = lane & 32, b4 = lane & 16, b3 = lane & 8;
    const int nw = gridDim.x * 8, gw = blockIdx.x * 8 + wv, tpw = (MTOK + nw - 1) / nw, tbase = gw * tpw;
    int cnt = MTOK - tbase; cnt = cnt > tpw ? tpw : cnt;
    if (cnt <= 0) return;
    const int nit = 16 * cnt;
    const unsigned char* vb = V + cc * 16;
    const int colo = cc * 16 + (b5 ? 8 : 0) + (b4 ? 4 : 0) + (b3 ? 2 : 0);
    u32x4 m0c, m0d, m1a, m1b, m1c, m1d, m2a, m2b, m2c, m2d; u32x4 w0, w1; unsigned x0, x1; float c0, c1; u32x4 sA[8], sB[8];
#define PV_IDS(k_, A_, B_, C_, D_) { const size_t o_ = (size_t)(tbase + (k_)) * 128 + es * 16; A_ = *(const u32x4*)(EID + o_); B_ = *(const u32x4*)(EID + o_ + 4); C_ = *(const u32x4*)(EID + o_ + 8); D_ = *(const u32x4*)(EID + o_ + 12); }
#define PV_WX(sl_, k_, W_, X_, CS_) { W_ = *(const u32x4*)(WQ + (size_t)(tbase + (k_)) * 128 + es * 16); \
        X_ = *(const unsigned*)(X + (size_t)(tbase + (k_)) * DM + (sl_) * 128 + colo); CS_ = SW[tbase + (k_)]; }
#define PV_NEXT(sl_, k_, sn_, kn_) { kn_ = (k_) + 1; sn_ = (sl_); if (kn_ == cnt) { kn_ = 0; ++sn_; } if (sn_ == 16) { sn_ = 15; kn_ = cnt - 1; } }
    int sl = 0, k = 0, sl1, k1, sl2, k2;
    PV_NEXT(sl, k, sl1, k1) PV_NEXT(sl1, k1, sl2, k2)
    { u32x4 ta, tb; PV_IDS(k, ta, tb, m0c, m0d) PV_IDS(k1, m1a, m1b, m1c, m1d)
      PV_WX(sl, k, w0, x0, c0)
      peer_issue8(sA, vb + sl * 128, ta, tb); }
    for (int it = 0; it < nit; ++it) {
        PV_IDS(k2, m2a, m2b, m2c, m2d)
        peer_issue8(sB, vb + sl * 128, m0c, m0d);
        int ya[16];
#pragma unroll
        for (int j = 0; j < 16; ++j) ya[j] = 0;
        peer_dot4x4(ya, sA[0], sA[1], sA[2], sA[3], w0.x); peer_dot4x4(ya, sA[4], sA[5], sA[6], sA[7], w0.y);
        peer_issue8(sA, vb + sl1 * 128, m1a, m1b);
        PV_WX(sl1, k1, w1, x1, c1)
        peer_dot4x4(ya, sB[0], sB[1], sB[2], sB[3], w0.z); peer_dot4x4(ya, sB[4], sB[5], sB[6], sB[7], w0.w);
        int t8[8], t4[4], t2[2];
#pragma unroll
        for (int q = 0; q < 8; ++q) { const int keep = b5 ? ya[8 + q] : ya[q], send = b5 ? ya[q] : ya[8 + q]; t8[q] = keep + __shfl_xor(send, 32); }
#pragma unroll
        for (int q = 0; q < 4; ++q) { const int keep = b4 ? t8[4 + q] : t8[q], send = b4 ? t8[q] : t8[4 + q]; t4[q] = keep + __shfl_xor(send, 16); }
#pragma unroll
        for (int q = 0; q < 2; ++q) { const int keep = b3 ? t4[2 + q] : t4[q], send = b3 ? t4[q] : t4[2 + q]; t2[q] = keep + __shfl_xor(send, 8); }
        f32x2_t o; o[0] = (float)t2[0] * c0 + ALPHA * bflo(x0); o[1] = (float)t2[1] * c0 + ALPHA * bfhi(x0);
        *(f32x2_t*)(Y + (size_t)(tbase + k) * DM + sl * 128 + colo) = o;
        sl = sl1; k = k1; sl1 = sl2; k1 = k2; PV_NEXT(sl1, k1, sl2, k2)
        m0c = m1c; m0d = m1d; m1a = m2a; m1b = m2b; m1c = m2c; m1d = m2d;
        w0 = w1; x0 = x1; c0 = c1;
    }
#undef PV_IDS
#undef PV_WX
#undef PV_NEXT
}

__device__ __forceinline__ void rot8(const u32x4 lo, const u32x4 hi, const f32x4 c0, const f32x4 c1, const f32x4 s0, const f32x4 s1, float (&o1)[8], float (&o2)[8]) {
    const float a[8] = {bflo(lo.x), bfhi(lo.x), bflo(lo.y), bfhi(lo.y), bflo(lo.z), bfhi(lo.z), bflo(lo.w), bfhi(lo.w)};
    const float b[8] = {bflo(hi.x), bfhi(hi.x), bflo(hi.y), bfhi(hi.y), bflo(hi.z), bfhi(hi.z), bflo(hi.w), bfhi(hi.w)};
    const float c[8] = {c0[0], c0[1], c0[2], c0[3], c1[0], c1[1], c1[2], c1[3]}, sn[8] = {s0[0], s0[1], s0[2], s0[3], s1[0], s1[1], s1[2], s1[3]};
#pragma unroll
    for (int j = 0; j < 8; ++j) { o1[j] = a[j] * c[j] - b[j] * sn[j]; o2[j] = a[j] * sn[j] + b[j] * c[j]; }
}
__device__ __forceinline__ u32x4 pack8(const float (&o)[8]) { u32x4 w; w.x = pk_bf16(o[0], o[1]); w.y = pk_bf16(o[2], o[3]); w.z = pk_bf16(o[4], o[5]); w.w = pk_bf16(o[6], o[7]); return w; }
__device__ __forceinline__ void phase_kstat(LAS float* red, const bf16_t* KR, float* KMEAN, float* KNMAX) {
    const int tid = threadIdx.x, ch = tid & 7, rr = tid >> 3, wv = tid >> 6, lane = tid & 63;
    for (int item = blockIdx.x; item < 2 * NHEAD * 32; item += gridDim.x) {
        const int bh = item >> 5, j = item & 31, b = bh >> 4, h = bh & 15;
        float sm1[8], sm2[8]; float nmax = 0.f;
#pragma unroll
        for (int q = 0; q < 8; ++q) { sm1[q] = 0.f; sm2[q] = 0.f; }
        u32x4 lo[4], hi[4];
#pragma unroll
        for (int ps = 0; ps < 4; ++ps) { const size_t off = ((size_t)b * SEQ + j * 256 + ps * 64 + rr) * DM + h * 128 + ch * 8; lo[ps] = *(const u32x4*)(KR + off); hi[ps] = *(const u32x4*)(KR + off + 64); }
#pragma unroll
        for (int ps = 0; ps < 4; ++ps) {
            const float a[8] = {bflo(lo[ps].x), bfhi(lo[ps].x), bflo(lo[ps].y), bfhi(lo[ps].y), bflo(lo[ps].z), bfhi(lo[ps].z), bflo(lo[ps].w), bfhi(lo[ps].w)};
            const float c[8] = {bflo(hi[ps].x), bfhi(hi[ps].x), bflo(hi[ps].y), bfhi(hi[ps].y), bflo(hi[ps].z), bfhi(hi[ps].z), bflo(hi[ps].w), bfhi(hi[ps].w)};
            float nq = 0.f;
#pragma unroll
            for (int q = 0; q < 8; ++q) { sm1[q] += a[q]; sm2[q] += c[q]; nq += a[q] * a[q] + c[q] * c[q]; }
            nq += __shfl_xor(nq, 1); nq += __shfl_xor(nq, 2); nq += __shfl_xor(nq, 4);
            nmax = fmaxf(nmax, nq);
        }
#pragma unroll
        for (int q = 0; q < 8; ++q) {
            sm1[q] += __shfl_xor(sm1[q], 8); sm1[q] += __shfl_xor(sm1[q], 16); sm1[q] += __shfl_xor(sm1[q], 32);
            sm2[q] += __shfl_xor(sm2[q], 8); sm2[q] += __shfl_xor(sm2[q], 16); sm2[q] += __shfl_xor(sm2[q], 32);
        }
        nmax = wave_max(nmax);
        if (lane < 8) {
#pragma unroll
            for (int q = 0; q < 8; ++q) { red[wv * 128 + lane * 8 + q] = sm1[q]; red[wv * 128 + 64 + lane * 8 + q] = sm2[q]; }
        }
        if (lane == 0) red[1024 + wv] = nmax;
        __syncthreads();
        if (tid < 128) {
            float s2 = 0.f;
#pragma unroll
            for (int r = 0; r < 8; ++r) s2 += red[r * 128 + tid];
            KMEAN[(size_t)item * 128 + tid] = s2 * (1.0f / 256.0f);
        }
        if (tid == 0) {
            float m = 0.f;
#pragma unroll
            for (int r = 0; r < 8; ++r) m = fmaxf(m, red[1024 + r]);
            KNMAX[item] = sqrtf(m);
        }
        __syncthreads();
    }
}

__device__ __forceinline__ void top3_insert(float x, int m, float& v0, int& i0, float& v1, int& i1, float& v2, int& i2) {
    const bool c0 = x > v0 || (x == v0 && m < i0), c1 = x > v1 || (x == v1 && m < i1), c2 = x > v2 || (x == v2 && m < i2);
    v2 = c1 ? v1 : (c2 ? x : v2); i2 = c1 ? i1 : (c2 ? m : i2);
    v1 = c0 ? v0 : (c1 ? x : v1); i1 = c0 ? i0 : (c1 ? m : i1);
    v0 = c0 ? x : v0; i0 = c0 ? m : i0;
}
__device__ __forceinline__ void phase_sel(LAS unsigned char* lds, const bf16_t* QR, const float* KMEAN, unsigned short* SUB, int* CNT, int* ctr) {
    const int tid = threadIdx.x, lane = tid & 63, wv = tid >> 6, r32 = lane & 31, hh = lane >> 5;
    LAS unsigned short* bucket = (LAS unsigned short*)lds;
    LAS int* cnt = (LAS int*)(lds + 16384);
    const float NEG = -1e30f;
    if (blockIdx.x == 0 && tid == 0) *ctr = 0;
    for (int item = blockIdx.x; item < 2 * NHEAD * 32; item += gridDim.x) {
        const int bh = item >> 5, i = item & 31, b = bh >> 4, h = bh & 15;
        if (i == 0) continue;
        if (tid < 32) cnt[tid] = 0;
        __syncthreads();
        const float* kmp = KMEAN + ((size_t)bh * 32 + r32) * 128 + 8 * hh;
        const size_t tok = (size_t)b * SEQ + i * 256 + wv * 32 + r32;
        const bf16_t* qp = QR + tok * DM + h * 128 + 8 * hh;
        f32x16 S;
#pragma unroll
        for (int e = 0; e < 16; ++e) S[e] = 0.f;
#pragma unroll
        for (int s2 = 0; s2 < 8; ++s2) {
            const f32x4 ka = *(const f32x4*)(kmp + 16 * s2), kb = *(const f32x4*)(kmp + 16 * s2 + 4);
            const bf16x8 qf = *(const bf16x8*)(qp + 16 * s2);
            u32x4 hi, lo;
            hi.x = pk_bf16(ka[0], ka[1]); hi.y = pk_bf16(ka[2], ka[3]); hi.z = pk_bf16(kb[0], kb[1]); hi.w = pk_bf16(kb[2], kb[3]);
            lo.x = pk_bf16(ka[0] - bflo(hi.x), ka[1] - bfhi(hi.x)); lo.y = pk_bf16(ka[2] - bflo(hi.y), ka[3] - bfhi(hi.y));
            lo.z = pk_bf16(kb[0] - bflo(hi.z), kb[1] - bfhi(hi.z)); lo.w = pk_bf16(kb[2] - bflo(hi.w), kb[3] - bfhi(hi.w));
            S = __builtin_amdgcn_mfma_f32_32x32x16_bf16(__builtin_bit_cast(bf16x8, hi), qf, S, 0, 0, 0);
            S = __builtin_amdgcn_mfma_f32_32x32x16_bf16(__builtin_bit_cast(bf16x8, lo), qf, S, 0, 0, 0);
        }
        float v0 = -3e38f, v1 = -3e38f, v2 = -3e38f; int i0 = 99, i1 = 99, i2 = 99;
#pragma unroll
        for (int e = 0; e < 16; ++e) {
            const int m = (e & 3) + 8 * (e >> 2) + 4 * hh;
            const float x = m < i ? S[e] : NEG;
            top3_insert(x, m, v0, i0, v1, i1, v2, i2);
        }
        {
            const float pv0 = __shfl_xor(v0, 32), pv1 = __shfl_xor(v1, 32), pv2 = __shfl_xor(v2, 32);
            const int pi0 = __shfl_xor(i0, 32), pi1 = __shfl_xor(i1, 32), pi2 = __shfl_xor(i2, 32);
            top3_insert(pv0, pi0, v0, i0, v1, i1, v2, i2); top3_insert(pv1, pi1, v0, i0, v1, i1, v2, i2); top3_insert(pv2, pi2, v0, i0, v1, i1, v2, i2);
        }
        if (hh == 0) {
            const int tl = wv * 32 + r32;
            if (v0 > 0.5f * NEG) { const int p = __hip_atomic_fetch_add(cnt + i0, 1, __ATOMIC_RELAXED, __HIP_MEMORY_SCOPE_WORKGROUP); bucket[i0 * 256 + p] = (unsigned short)(tl | (0 << 8)); }
            if (v1 > 0.5f * NEG) { const int p = __hip_atomic_fetch_add(cnt + i1, 1, __ATOMIC_RELAXED, __HIP_MEMORY_SCOPE_WORKGROUP); bucket[i1 * 256 + p] = (unsigned short)(tl | (1 << 8)); }
            if (v2 > 0.5f * NEG) { const int p = __hip_atomic_fetch_add(cnt + i2, 1, __ATOMIC_RELAXED, __HIP_MEMORY_SCOPE_WORKGROUP); bucket[i2 * 256 + p] = (unsigned short)(tl | (2 << 8)); }
        }
        __syncthreads();
        for (int idx = tid; idx < 32 * 256; idx += 512) {
            const int j = idx >> 8, p = idx & 255;
            if (j < i && p < cnt[j]) SUB[(((size_t)bh * 32 + j) * 32 + i) * 256 + p] = bucket[idx];
        }
        if (tid < i) CNT[((size_t)bh * 32 + tid) * 32 + i] = cnt[tid];
        __syncthreads();
    }
}

__device__ __forceinline__ unsigned off_b(unsigned row, unsigned ch) { return 256u * row + 16u * (ch ^ (((row & 3u) << 2) | ((row >> 2) & 3u))); }
__device__ __forceinline__ unsigned pi32(unsigned m) { return (m & ~12u) | ((m & 4u) << 1) | ((m & 8u) >> 1); }
__device__ __forceinline__ bf16x8 tr_frag(LAS unsigned char* img, unsigned lane, unsigned c, unsigned ks) {
    const unsigned hh = lane >> 5, blk = (lane >> 4) & 1, q = (lane & 15) >> 2, p = lane & 3;
    const unsigned a0 = off_b(16 * ks + 8 * hh + q, 4 * c + 2 * blk + (p >> 1)) + 8 * (p & 1);
    const unsigned a1 = off_b(16 * ks + 8 * hh + 4 + q, 4 * c + 2 * blk + (p >> 1)) + 8 * (p & 1);
    const s16x4 lo = __builtin_amdgcn_ds_read_tr16_b64_v4i16((LAS s16x4*)(img + a0));
    const s16x4 hi = __builtin_amdgcn_ds_read_tr16_b64_v4i16((LAS s16x4*)(img + a1));
    bf16x8 r; r[0] = lo[0]; r[1] = lo[1]; r[2] = lo[2]; r[3] = lo[3]; r[4] = hi[0]; r[5] = hi[1]; r[6] = hi[2]; r[7] = hi[3];
    return r;
}
__device__ __forceinline__ void phase_att(LAS unsigned char* lds, const bf16_t* QR, const bf16_t* KR, const bf16_t* V, const float* KNMAX, const unsigned short* SUB, const int* CNT, int* ctr,
                                          bf16_t* P012, bf16_t* P3, float* LS) {
    const int tid = threadIdx.x, lane = tid & 63, wv = tid >> 6, r32 = lane & 31, hh = lane >> 5;
    LAS unsigned char* Kimg = lds;
    LAS unsigned char* Vimg = lds + 65536;
    LAS int* misc = (LAS int*)(lds + 131072);
    const float SCL2 = 0.08838834764831845f * 1.4426950408889634f;
    for (;;) {
        __syncthreads();
        if (tid == 0) misc[40] = __hip_atomic_fetch_add(ctr, 1, __ATOMIC_RELAXED, __HIP_MEMORY_SCOPE_AGENT);
        __syncthreads();
        const int item = misc[40];
        if (item >= 2 * NHEAD * 32) break;
        const int j = item >> 5, bh = item & 31, b = bh >> 4, h = bh & 15;
#pragma unroll
        for (int r = 0; r < 8; ++r) {
            const int idx = tid + 512 * r, row = idx >> 4, ch = idx & 15;
            const size_t g = ((size_t)b * SEQ + j * 256 + row) * DM + h * 128 + ch * 8;
            const u32x4 kv = *(const u32x4*)(KR + g), vv = *(const u32x4*)(V + g);
            *(LAS u32x4*)(Kimg + off_b(row, ch)) = kv; *(LAS u32x4*)(Vimg + off_b(row, ch)) = vv;
        }
        if (tid <= 32) { int pre = 0; for (int u = j + 1; u < tid; ++u) pre += CNT[((size_t)bh * 32 + j) * 32 + u]; misc[tid] = pre; }
        float kn = (lane < 32) ? KNMAX[bh * 32 + lane] : 0.f;
        kn = wave_max(kn);
        __syncthreads();
        const int total = misc[32], ntile = (256 + total + 31) >> 5;
        for (int tile = wv; tile < ntile; tile += 8) {
            const int gr = tile * 32 + r32;
            int pos, slot; bool valid = true;
            if (gr < 256) { pos = j * 256 + gr; slot = 3; }
            else {
                const int x = gr - 256; valid = x < total;
                int ii = j + 1;
                for (int u = j + 1; u < 32; ++u) if (misc[u] <= x) ii = u;
                if (valid) { const unsigned e = SUB[(((size_t)bh * 32 + j) * 32 + ii) * 256 + (x - misc[ii])]; pos = ii * 256 + (int)(e & 255u); slot = (int)(e >> 8); }
                else { pos = j * 256; slot = 3; }
            }
            const size_t tok = (size_t)b * SEQ + pos;
            bf16x8 qf[8];
            const bf16_t* qp = QR + tok * DM + h * 128 + 8 * hh;
#pragma unroll
            for (int s = 0; s < 8; ++s) qf[s] = *(const bf16x8*)(qp + 16 * s);
            float qn2 = 0.f;
#pragma unroll
            for (int s = 0; s < 8; ++s)
#pragma unroll
                for (int e = 0; e < 8; ++e) { const float f = bf2f((bf16_t)qf[s][e]); qn2 += f * f; }
            qn2 += __shfl_xor(qn2, 32);
            const float c2 = sqrtf(qn2) * kn * SCL2;
            f32x16 O[4];
#pragma unroll
            for (int dt = 0; dt < 4; ++dt)
#pragma unroll
                for (int e = 0; e < 16; ++e) O[dt][e] = 0.f;
            float l = 0.f;
            const bool own = tile < 8;
            const int kcn = own ? tile + 1 : 8;
            const unsigned krow = pi32((unsigned)r32);
            for (int kc = 0; kc < kcn; ++kc) {
                f32x16 S, S1;
#pragma unroll
                for (int e = 0; e < 16; ++e) { S[e] = 0.f; S1[e] = 0.f; }
#pragma unroll
                for (int s = 0; s < 8; s += 2) {
                    const bf16x8 kf = *(const LAS bf16x8*)(Kimg + off_b(32 * kc + krow, 2 * s + hh));
                    const bf16x8 kf1 = *(const LAS bf16x8*)(Kimg + off_b(32 * kc + krow, 2 * s + 2 + hh));
                    S = __builtin_amdgcn_mfma_f32_32x32x16_bf16(kf, qf[s], S, 0, 0, 0);
                    S1 = __builtin_amdgcn_mfma_f32_32x32x16_bf16(kf1, qf[s + 1], S1, 0, 0, 0);
                }
                float p[16];
                if (own) {
#pragma unroll
                    for (int e = 0; e < 16; ++e) {
                        const unsigned m = (e & 3) + 8 * (e >> 2) + 4 * hh;
                        const int key = j * 256 + 32 * kc + (int)pi32(m);
                        float pe = __builtin_amdgcn_exp2f((S[e] + S1[e]) * SCL2 - c2);
                        if (key > pos) pe = 0.f;
                        p[e] = pe; l += pe;
                    }
                } else {
#pragma unroll
                    for (int e = 0; e < 16; ++e) { const float pe = __builtin_amdgcn_exp2f((S[e] + S1[e]) * SCL2 - c2); p[e] = pe; l += pe; }
                }
                u32x4 w0, w1;
                w0.x = pk_bf16(p[0], p[1]); w0.y = pk_bf16(p[2], p[3]); w0.z = pk_bf16(p[4], p[5]); w0.w = pk_bf16(p[6], p[7]);
                w1.x = pk_bf16(p[8], p[9]); w1.y = pk_bf16(p[10], p[11]); w1.z = pk_bf16(p[12], p[13]); w1.w = pk_bf16(p[14], p[15]);
                const bf16x8 pf0 = __builtin_bit_cast(bf16x8, w0), pf1 = __builtin_bit_cast(bf16x8, w1);
#pragma unroll
                for (int dt = 0; dt < 4; ++dt) {
                    const bf16x8 v0 = tr_frag(Vimg, lane, dt, 2 * kc), v1 = tr_frag(Vimg, lane, dt, 2 * kc + 1);
                    O[dt] = __builtin_amdgcn_mfma_f32_32x32x16_bf16(v0, pf0, O[dt], 0, 0, 0);
                    O[dt] = __builtin_amdgcn_mfma_f32_32x32x16_bf16(v1, pf1, O[dt], 0, 0, 0);
                }
            }
            l += __shfl_xor(l, 32);
            if (valid) {
                bf16_t* pl = (slot < 3 ? P012 + (size_t)slot * ((size_t)32 << 20) : P3) + (tok * NHEAD + h) * 128 + 4 * hh;
#pragma unroll
                for (int dt = 0; dt < 4; ++dt)
#pragma unroll
                    for (int g = 0; g < 4; ++g) {
                        u32x2 w; w.x = pk_bf16(O[dt][4 * g], O[dt][4 * g + 1]); w.y = pk_bf16(O[dt][4 * g + 2], O[dt][4 * g + 3]);
                        *(u32x2*)(pl + 32 * dt + 8 * g) = w;
                    }
                if (hh == 0) LS[(size_t)slot * MTOK * NHEAD + tok * NHEAD + h] = l;
            }
        }
    }
}
__device__ __forceinline__ void phase_comb(LAS float* red, const bf16_t* P012, const bf16_t* P3, const float* LS, signed char* AO8, float* XSO) {
    const int tid = threadIdx.x, tsel = tid >> 8, hd = (tid & 255) >> 4, ch = tid & 15, wv = tid >> 6;
    u32x4 nw[4]; float nl[4];
#define CB_LOAD(pair_) { const size_t th_ = ((size_t)(2 * (pair_) + tsel)) * NHEAD + hd; nw[3] = *(const u32x4*)(P3 + th_ * 128 + ch * 8); nl[3] = LS[(size_t)3 * MTOK * NHEAD + th_]; \
        _Pragma("unroll") for (int s_ = 0; s_ < 3; ++s_) { nw[s_] = *(const u32x4*)(P012 + (size_t)s_ * ((size_t)32 << 20) + th_ * 128 + ch * 8); nl[s_] = LS[(size_t)s_ * MTOK * NHEAD + th_]; } }
    if ((int)blockIdx.x < MTOK / 2) CB_LOAD((int)blockIdx.x)
    int par = 0;
    for (int pair = blockIdx.x; pair < MTOK / 2; pair += gridDim.x, par ^= 1) {
        const int token = 2 * pair + tsel;
        const int t = token & (SEQ - 1), blk = t >> 8, nsel = blk < 3 ? blk : 3;
        float acc[8];
        float l = nl[3];
        { const u32x4 w = nw[3];
          acc[0] = bflo(w.x); acc[1] = bfhi(w.x); acc[2] = bflo(w.y); acc[3] = bfhi(w.y); acc[4] = bflo(w.z); acc[5] = bfhi(w.z); acc[6] = bflo(w.w); acc[7] = bfhi(w.w); }
#pragma unroll
        for (int s = 0; s < 3; ++s) {
            u32x4 w = nw[s]; float ls = nl[s];
            if (s >= nsel) { w = (u32x4){0u, 0u, 0u, 0u}; ls = 0.f; }
            acc[0] += bflo(w.x); acc[1] += bfhi(w.x); acc[2] += bflo(w.y); acc[3] += bfhi(w.y); acc[4] += bflo(w.z); acc[5] += bfhi(w.z); acc[6] += bflo(w.w); acc[7] += bfhi(w.w);
            l += ls;
        }
        if (pair + (int)gridDim.x < MTOK / 2) CB_LOAD(pair + (int)gridDim.x)
        const float rl = 1.0f / l;
        float am = 0.f;
#pragma unroll
        for (int j = 0; j < 8; ++j) { acc[j] *= rl; am = fmaxf(am, fabsf(acc[j])); }
        am = wave_max(am);
        if ((tid & 63) == 0) red[par * 8 + wv] = am;
        __syncthreads();
        am = fmaxf(fmaxf(fmaxf(red[par * 8 + 4 * tsel], red[par * 8 + 4 * tsel + 1]), fmaxf(red[par * 8 + 4 * tsel + 2], red[par * 8 + 4 * tsel + 3])), 1e-30f);
        const float inv = 127.0f / am;
        if ((tid & 255) == 0) XSO[token] = am * (1.0f / 127.0f);
        u32x2 o;
        o.x = ((unsigned)(int)rintf(acc[0] * inv) & 0xffu) | (((unsigned)(int)rintf(acc[1] * inv) & 0xffu) << 8) | (((unsigned)(int)rintf(acc[2] * inv) & 0xffu) << 16) | (((unsigned)(int)rintf(acc[3] * inv) & 0xffu) << 24);
        o.y = ((unsigned)(int)rintf(acc[4] * inv) & 0xffu) | (((unsigned)(int)rintf(acc[5] * inv) & 0xffu) << 8) | (((unsigned)(int)rintf(acc[6] * inv) & 0xffu) << 16) | (((unsigned)(int)rintf(acc[7] * inv) & 0xffu) << 24);
        *(u32x2*)(AO8 + (size_t)token * DM + hd * 128 + ch * 8) = o;
    }
#undef CB_LOAD
}


__device__ __forceinline__ void qrow_issue(f32x4 (&v)[8], const float* p, int lane) {
#pragma unroll
    for (int i = 0; i < 2; ++i)
#pragma unroll
        for (int q = 0; q < 4; ++q) v[i * 4 + q] = *(const f32x4*)(p + 1024 * i + 16 * lane + 4 * q);
}
__device__ __forceinline__ void qrow_finish(const f32x4 (&v)[8], unsigned char* dst, float* scl, int lane, bool sgn = false) {
    float am = 0.f;
#pragma unroll
    for (int i = 0; i < 8; ++i) am = fmaxf(am, fmaxf(fmaxf(fabsf(v[i][0]), fabsf(v[i][1])), fmaxf(fabsf(v[i][2]), fabsf(v[i][3]))));
    am = fmaxf(wave_max(am), 1e-30f);
    const float inv = 127.0f / am;
    if (lane == 0) *scl = am * (1.0f / 127.0f);
#pragma unroll
    for (int i = 0; i < 2; ++i) {
        u32x4 w;
#pragma unroll
        for (int q = 0; q < 4; ++q) {
            const f32x4 t = v[i * 4 + q];
            const float off = sgn ? 0.0f : 128.0f;
            const unsigned b0 = (unsigned)(int)(rintf(t[0] * inv) + off) & 0xffu, b1 = (unsigned)(int)(rintf(t[1] * inv) + off) & 0xffu, b2 = (unsigned)(int)(rintf(t[2] * inv) + off) & 0xffu, b3 = (unsigned)(int)(rintf(t[3] * inv) + off) & 0xffu;
            w[q] = b0 | (b1 << 8) | (b2 << 16) | (b3 << 24);
        }
        *(u32x4*)(dst + 1024 * i + 16 * lane) = w;
    }
}
struct QuantJob { const float* TU; const float* TV; unsigned char* QU; unsigned char* QV; float* SU; float* SV; };
__device__ __forceinline__ const float* qj_src(const QuantJob& q, int r) { return (r < 16384 ? q.TU : q.TV) + (size_t)(r & 16383) * DM; }
__device__ __forceinline__ unsigned char* qj_dst(const QuantJob& q, int r) { return (r < 16384 ? q.QU : q.QV) + (size_t)(r & 16383) * DM; }
__device__ __forceinline__ float* qj_scl(const QuantJob& q, int r) { return (r < 16384 ? q.SU : q.SV) + (r & 16383); }
__device__ __forceinline__ void qj_tail(const QuantJob& q, int done_iters) {
    const int lane = threadIdx.x & 63, gw = blockIdx.x * 8 + (threadIdx.x >> 6), nw = gridDim.x * 8;
    for (int r = gw + done_iters * nw; r < 32768; r += nw) { f32x4 v[8]; qrow_issue(v, qj_src(q, r), lane); qrow_finish(v, qj_dst(q, r), qj_scl(q, r), lane, r >= 16384); }
}
__device__ __forceinline__ float logf_gate(float z, float lb) { return __logf(lb + (1.0f - lb) * sigmoidf_(z)); }
__device__ __forceinline__ void phase_scan_a(LAS unsigned char* lds, const bf16_t* FZ, const float* LB, const bf16_t* I1, bf16_t* LT, float* DEC, const QuantJob qj, unsigned* dbgc = nullptr) {
    unsigned dbg_kt = 0, dbg_acc = 0;
    const int tid = threadIdx.x, lane = tid & 63, wv = tid >> 6, k = tid & 127, part = tid >> 7;
    LAS unsigned char* Iimg = lds; LAS unsigned char* KTimg = lds + 16384;
    LAS float* psum = (LAS float*)(lds + 32768);
    LAS unsigned char* Lst = lds + 36864;
#if SCAN_A_VALU == 2
    for (int item = blockIdx.x; item < 2 * NHEAD * 128; item += gridDim.x) {
        const int bh = item >> 7, c = item & 127, b = bh >> 4, h = bh & 15;
        const size_t tok0 = (size_t)b * SEQ + c * 64;
        for (int idx = tid; idx < 16384; idx += 512) {
            const int v = idx >> 7, kk = idx & 127;
            float g = 1.f, L = 0.f;
            for (int s2 = 63; s2 >= 0; --s2) { const size_t o = (tok0 + s2) * DM + h * 128; const float f = __expf(logf_gate(bf2f(FZ[o + kk]), LB[h * 128 + kk])); L += bf2f(I1[o + v]) * (1.0f - f) * g; g *= f; }
            LT[(size_t)item * 16384 + idx] = (bf16_t)(pk_bf16(L, 0.f) & 0xffffu);
        }
    }
    return;
#endif
    bf16_t nfz[16]; u32x4 nit_[2];
#define SA_LOAD(item_) { const int bh_ = (item_) >> 7, c_ = (item_) & 127; const size_t t0_ = (size_t)(bh_ >> 4) * SEQ + c_ * 64; const int h_ = bh_ & 15; \
        _Pragma("unroll") for (int i = 0; i < 16; ++i) nfz[i] = FZ[(t0_ + 16 * part + i) * DM + h_ * 128 + k]; \
        _Pragma("unroll") for (int r = 0; r < 2; ++r) { const int idx = tid + 512 * r, row = idx >> 4, ch = idx & 15; nit_[r] = *(const u32x4*)(I1 + (t0_ + row) * DM + h_ * 128 + ch * 8); } }
    if ((int)blockIdx.x < 2 * NHEAD * 128) SA_LOAD((int)blockIdx.x)
    int qiter = 0;
    for (int item = blockIdx.x; item < 2 * NHEAD * 128; item += gridDim.x, ++qiter) {
        const int bh = item >> 7, c = item & 127, b = bh >> 4, h = bh & 15;
        const size_t tok0 = (size_t)b * SEQ + c * 64;
        float lf[16];
        const float lbk = LB[h * 128 + k];
#pragma unroll
        for (int i = 0; i < 16; ++i) lf[i] = logf_gate(bf2f(nfz[i]), lbk);
#pragma unroll
        for (int r = 0; r < 2; ++r) { const int idx = tid + 512 * r, row = idx >> 4, ch = idx & 15; *(LAS u32x4*)(Iimg + off_b(row, ch)) = nit_[r]; }
        if (item + (int)gridDim.x < 2 * NHEAD * 128) SA_LOAD(item + (int)gridDim.x)
        const int qrow = qiter * (int)gridDim.x * 8 + (int)blockIdx.x * 8 + wv; const bool doq = qrow < 32768; f32x4 qv8[8];
        if (doq) qrow_issue(qv8, qj_src(qj, qrow), lane);
        float cs = 0.f;
#pragma unroll
        for (int i = 0; i < 16; ++i) cs += lf[i];
        psum[part * 128 + k] = cs;
        __syncthreads();
        const float p0 = psum[k], p1 = psum[128 + k], p2 = psum[256 + k], p3 = psum[384 + k];
        const float blast = (p0 + p1) + (p2 + p3);
        float bb = part == 0 ? 0.f : (part == 1 ? p0 : (part == 2 ? p0 + p1 : p0 + p1 + p2));
#pragma unroll
        for (int i = 0; i < 16; ++i) {
            bb += lf[i];
            const float kt = (1.0f - __expf(lf[i])) * __expf(blast - bb);
            if (!(kt - kt == 0.f)) ++dbg_kt;
            const int srow = 16 * part + i;
            *(LAS bf16_t*)(KTimg + off_b(srow, k >> 3) + 2 * (k & 7)) = (bf16_t)(pk_bf16(kt, 0.f) & 0xffffu);
        }
        if (part == 0) DEC[(size_t)item * 128 + k] = __expf(blast);
        __syncthreads();
#if SCAN_A_VALU
        for (int idx = tid; idx < 16384; idx += 512) {
            const int v = idx >> 7, kk = idx & 127;
            float accv = 0.f;
            for (int s2 = 0; s2 < 64; ++s2) accv += bf2f(*(const LAS bf16_t*)(Iimg + off_b(s2, v >> 3) + 2 * (v & 7))) * bf2f(*(const LAS bf16_t*)(KTimg + off_b(s2, kk >> 3) + 2 * (kk & 7)));
            *(LAS bf16_t*)(Lst + v * 272 + 2 * kk) = (bf16_t)(pk_bf16(accv, 0.f) & 0xffffu);
        }
        if (0)
#endif
        {
            const int vt = wv >> 1;
            f32x16 acc0, acc1;
#pragma unroll
            for (int e = 0; e < 16; ++e) { acc0[e] = 0.f; acc1[e] = 0.f; }
#pragma unroll
            for (int ks = 0; ks < 4; ++ks) {
                const bf16x8 af = tr_frag(Iimg, lane, vt, ks);
                const bf16x8 b0 = tr_frag(KTimg, lane, 2 * (wv & 1), ks), b1 = tr_frag(KTimg, lane, 2 * (wv & 1) + 1, ks);
                acc0 = __builtin_amdgcn_mfma_f32_32x32x16_bf16(af, b0, acc0, 0, 0, 0);
                acc1 = __builtin_amdgcn_mfma_f32_32x32x16_bf16(af, b1, acc1, 0, 0, 0);
            }
            const int r32 = lane & 31, hh = lane >> 5;
#pragma unroll
            for (int e = 0; e < 16; ++e) {
                if (!(acc0[e] - acc0[e] == 0.f)) ++dbg_acc; if (!(acc1[e] - acc1[e] == 0.f)) ++dbg_acc;
                const int v = 32 * vt + (e & 3) + 8 * (e >> 2) + 4 * hh;
                *(LAS bf16_t*)(Lst + v * 272 + 2 * (64 * (wv & 1) + r32)) = (bf16_t)(pk_bf16(acc0[e], 0.f) & 0xffffu);
                *(LAS bf16_t*)(Lst + v * 272 + 2 * (64 * (wv & 1) + 32 + r32)) = (bf16_t)(pk_bf16(acc1[e], 0.f) & 0xffffu);
            }
        }
        __syncthreads();
#pragma unroll
        for (int r = 0; r < 4; ++r) { const int idx = tid + 512 * r, row = idx >> 4, ch = idx & 15; *(u32x4*)(LT + (size_t)item * 16384 + row * 128 + ch * 8) = *(const LAS u32x4*)(Lst + row * 272 + ch * 16); }
        if (doq) qrow_finish(qv8, qj_dst(qj, qrow), qj_scl(qj, qrow), lane, qrow >= 16384);
        __syncthreads();
    }
    qj_tail(qj, qiter);
    if (dbgc) { if (dbg_kt) atomicAdd(dbgc + 0, dbg_kt); if (dbg_acc) atomicAdd(dbgc + 1, dbg_acc); }
}
__device__ __forceinline__ void phase_scan_b(bf16_t* LT, const float* DEC, const QuantJob qj) {
    const int n = 2 * NHEAD * 128 * 32;
    const int lane = threadIdx.x & 63, gw = blockIdx.x * 8 + (threadIdx.x >> 6), nw = gridDim.x * 8;
    int qdone = 0;
    for (int idx = blockIdx.x * 512 + threadIdx.x; idx < n; idx += gridDim.x * 512) {
        const int bh = idx >> 12, vk = idx & 4095, k4 = (vk & 31) * 4;
        float S0 = 0.f, S1 = 0.f, S2 = 0.f, S3 = 0.f;
        bf16_t* p = LT + (size_t)bh * 128 * 16384 + (size_t)vk * 4;
        const float* dp = DEC + (size_t)bh * 128 * 128 + k4;
        for (int c8 = 0; c8 < 16; ++c8) {
            const int qrow = (qdone + c8) * nw + gw; const bool doq = qrow < 32768; f32x4 qv8[8];
            if (doq) qrow_issue(qv8, qj_src(qj, qrow), lane);
#pragma unroll
            for (int c2 = 0; c2 < 8; ++c2) {
                const int c = c8 * 8 + c2;
                const u32x2 w = *(const u32x2*)(p + (size_t)c * 16384);
                const f32x4 d = *(const f32x4*)(dp + c * 128);
                u32x2 o; o.x = pk_bf16(S0, S1); o.y = pk_bf16(S2, S3);
                *(u32x2*)(p + (size_t)c * 16384) = o;
                S0 = d[0] * S0 + bflo(w.x); S1 = d[1] * S1 + bfhi(w.x); S2 = d[2] * S2 + bflo(w.y); S3 = d[3] * S3 + bfhi(w.y);
            }
            if (doq) qrow_finish(qv8, qj_dst(qj, qrow), qj_scl(qj, qrow), lane, qrow >= 16384);
        }
        qdone += 16;
    }
    qj_tail(qj, qdone);
}
__device__ __forceinline__ void phase_scan_c(LAS unsigned char* lds, const bf16_t* Q1, const bf16_t* FZ, const float* LB, const bf16_t* I1, const bf16_t* G1, const bf16_t* SP, const float* gnorm, bf16_t* OG) {
    const int tid = threadIdx.x, lane = tid & 63, wv = tid >> 6, k = tid & 127, part = tid >> 7, r32 = lane & 31, hh = lane >> 5;
    LAS unsigned char* QTimg = lds; LAS unsigned char* QPimg = lds + 16384; LAS unsigned char* KPimg = lds + 32768; LAS unsigned char* Iimg = lds + 49152; LAS unsigned char* SPimg = lds + 65536;
    LAS float* psum = (LAS float*)(lds + 98304);
    LAS float* ssq = (LAS float*)(lds + 100352);
    LAS unsigned char* OT = lds + 102400;
    bf16_t nfz[16], nq[16]; u32x4 nit_[2], nsp[4], ngt[2];
#define SC_LOAD(item_) { const int bh_ = (item_) >> 7, c_ = (item_) & 127; const size_t t0_ = (size_t)(bh_ >> 4) * SEQ + c_ * 64; const int h_ = bh_ & 15; \
        _Pragma("unroll") for (int i = 0; i < 16; ++i) { const size_t o_ = (t0_ + 16 * part + i) * DM + h_ * 128 + k; nfz[i] = FZ[o_]; nq[i] = Q1[o_]; } \
        _Pragma("unroll") for (int r = 0; r < 2; ++r) { const int idx = tid + 512 * r, row = idx >> 4, ch = idx & 15; nit_[r] = *(const u32x4*)(I1 + (t0_ + row) * DM + h_ * 128 + ch * 8); ngt[r] = *(const u32x4*)(G1 + (t0_ + row) * DM + h_ * 128 + ch * 8); } \
        _Pragma("unroll") for (int r = 0; r < 4; ++r) { const int idx = tid + 512 * r, row = idx >> 4, ch = idx & 15; nsp[r] = *(const u32x4*)(SP + (size_t)(item_) * 16384 + row * 128 + ch * 8); } }
    if ((int)blockIdx.x < 2 * NHEAD * 128) SC_LOAD((int)blockIdx.x)
    for (int item = blockIdx.x; item < 2 * NHEAD * 128; item += gridDim.x) {
        const int bh = item >> 7, c = item & 127, b = bh >> 4, h = bh & 15;
        const size_t tok0 = (size_t)b * SEQ + c * 64;
        float lf[16], qv[16];
        const float lbk = LB[h * 128 + k];
#pragma unroll
        for (int i = 0; i < 16; ++i) { lf[i] = logf_gate(bf2f(nfz[i]), lbk); const float qr = bf2f(nq[i]); qv[i] = qr * sigmoidf_(qr); }
#pragma unroll
        for (int r = 0; r < 2; ++r) { const int idx = tid + 512 * r, row = idx >> 4, ch = idx & 15; *(LAS u32x4*)(Iimg + off_b(row, ch)) = nit_[r]; }
#pragma unroll
        for (int r = 0; r < 4; ++r) { const int idx = tid + 512 * r, row = idx >> 4, ch = idx & 15; *(LAS u32x4*)(SPimg + off_b(row, ch)) = nsp[r]; }
        const u32x4 gcur0 = ngt[0], gcur1 = ngt[1];
        if (item + (int)gridDim.x < 2 * NHEAD * 128) SC_LOAD(item + (int)gridDim.x)
        float cs = 0.f;
#pragma unroll
        for (int i = 0; i < 16; ++i) cs += lf[i];
        psum[part * 128 + k] = cs;
        __syncthreads();
        const float p0 = psum[k], p1 = psum[128 + k], p2 = psum[256 + k];
        const float rr = p0 + p1;
        float bb = part == 0 ? 0.f : (part == 1 ? p0 : (part == 2 ? p0 + p1 : p0 + p1 + p2));
#pragma unroll
        for (int i = 0; i < 16; ++i) {
            bb += lf[i];
            const float qt = qv[i] * __expf(bb), qp = qv[i] * __expf(bb - rr), kp = (1.0f - __expf(lf[i])) * __expf(rr - bb);
            const unsigned o = off_b(16 * part + i, k >> 3) + 2 * (k & 7);
            *(LAS bf16_t*)(QTimg + o) = (bf16_t)(pk_bf16(qt, 0.f) & 0xffffu);
            *(LAS bf16_t*)(QPimg + o) = (bf16_t)(pk_bf16(qp, 0.f) & 0xffffu);
            *(LAS bf16_t*)(KPimg + o) = (bf16_t)(pk_bf16(kp, 0.f) & 0xffffu);
        }
        __syncthreads();
        const int tt = wv & 1, vt = wv >> 1;
        f32x16 O;
#pragma unroll
        for (int e = 0; e < 16; ++e) O[e] = 0.f;
#pragma unroll
        for (int ks = 0; ks < 8; ++ks) {
            const bf16x8 af = *(const LAS bf16x8*)(SPimg + off_b(32 * vt + r32, 2 * ks + hh));
            const bf16x8 bf = *(const LAS bf16x8*)(QTimg + off_b(32 * tt + r32, 2 * ks + hh));
            O = __builtin_amdgcn_mfma_f32_32x32x16_bf16(af, bf, O, 0, 0, 0);
        }
        const unsigned krow = pi32((unsigned)r32);
        for (int st = 0; st <= tt; ++st) {
            f32x16 S;
#pragma unroll
            for (int e = 0; e < 16; ++e) S[e] = 0.f;
#pragma unroll
            for (int ks = 0; ks < 8; ++ks) {
                const bf16x8 af = *(const LAS bf16x8*)(KPimg + off_b(32 * st + krow, 2 * ks + hh));
                const bf16x8 bf = *(const LAS bf16x8*)(QPimg + off_b(32 * tt + r32, 2 * ks + hh));
                S = __builtin_amdgcn_mfma_f32_32x32x16_bf16(af, bf, S, 0, 0, 0);
            }
            float p[16];
#pragma unroll
            for (int e = 0; e < 16; ++e) {
                const unsigned m = (e & 3) + 8 * (e >> 2) + 4 * hh;
                const int sidx = 32 * st + (int)pi32(m), tidx = 32 * tt + r32;
                p[e] = sidx <= tidx ? S[e] : 0.f;
            }
            u32x4 w0, w1;
            w0.x = pk_bf16(p[0], p[1]); w0.y = pk_bf16(p[2], p[3]); w0.z = pk_bf16(p[4], p[5]); w0.w = pk_bf16(p[6], p[7]);
            w1.x = pk_bf16(p[8], p[9]); w1.y = pk_bf16(p[10], p[11]); w1.z = pk_bf16(p[12], p[13]); w1.w = pk_bf16(p[14], p[15]);
            const bf16x8 pf0 = __builtin_bit_cast(bf16x8, w0), pf1 = __builtin_bit_cast(bf16x8, w1);
            const bf16x8 i0 = tr_frag(Iimg, lane, vt, 2 * st), i1 = tr_frag(Iimg, lane, vt, 2 * st + 1);
            O = __builtin_amdgcn_mfma_f32_32x32x16_bf16(i0, pf0, O, 0, 0, 0);
            O = __builtin_amdgcn_mfma_f32_32x32x16_bf16(i1, pf1, O, 0, 0, 0);
        }
        float sq = 0.f;
#pragma unroll
        for (int e = 0; e < 16; ++e) sq += O[e] * O[e];
        sq += __shfl_xor(sq, 32);
        if (hh == 0) ssq[vt * 64 + 32 * tt + r32] = sq;
        __syncthreads();
        const int tl = 32 * tt + r32;
        const float rstd = rsqrtf((ssq[tl] + ssq[64 + tl] + ssq[128 + tl] + ssq[192 + tl]) * (1.0f / 128.0f) + 1e-6f);
#pragma unroll
        for (int g = 0; g < 4; ++g) {
            const int v0 = 32 * vt + 8 * g + 4 * hh;
            const f32x4 gn = *(const f32x4*)(gnorm + v0);
            u32x2 w; w.x = pk_bf16(O[4 * g] * rstd * gn[0], O[4 * g + 1] * rstd * gn[1]); w.y = pk_bf16(O[4 * g + 2] * rstd * gn[2], O[4 * g + 3] * rstd * gn[3]);
            *(LAS u32x2*)(OT + tl * 272 + v0 * 2) = w;
        }
        __syncthreads();
#pragma unroll
        for (int r = 0; r < 2; ++r) {
            const int idx = tid + 512 * r, row = idx >> 4, ch = idx & 15;
            const u32x4 ov = *(const LAS u32x4*)(OT + row * 272 + ch * 16);
            const size_t go = (tok0 + row) * DM + h * 128 + ch * 8;
            const u32x4 gv = r == 0 ? gcur0 : gcur1;
            u32x4 w;
#define SILU_(x_) ((x_) * sigmoidf_(x_))
            w.x = pk_bf16(bflo(ov.x) * SILU_(bflo(gv.x)), bfhi(ov.x) * SILU_(bfhi(gv.x))); w.y = pk_bf16(bflo(ov.y) * SILU_(bflo(gv.y)), bfhi(ov.y) * SILU_(bfhi(gv.y)));
            w.z = pk_bf16(bflo(ov.z) * SILU_(bflo(gv.z)), bfhi(ov.z) * SILU_(bfhi(gv.z))); w.w = pk_bf16(bflo(ov.w) * SILU_(bflo(gv.w)), bfhi(ov.w) * SILU_(bfhi(gv.w)));
#undef SILU_
            *(u32x4*)(OG + go) = w;
        }
        __syncthreads();
    }
}


#if SCAN_DBG == 2
__device__ __forceinline__ void dbg_compare(LAS float* red, const bf16_t* A, const bf16_t* B, float* DBG) {
    float sd = 0.f, sr = 0.f, nn = 0.f;
    const size_t n = (size_t)MTOK * DM;
    for (size_t i = (size_t)blockIdx.x * 512 + threadIdx.x; i < n; i += (size_t)gridDim.x * 512) {
        const float x = bf2f(A[i]), y = bf2f(B[i]);
        if (!(x - x == 0.f)) nn += 1.f; else { sd += (x - y) * (x - y); sr += y * y; }
    }
    sd = wave_sum(sd); sr = wave_sum(sr); nn = wave_sum(nn);
    const int wv = threadIdx.x >> 6;
    if ((threadIdx.x & 63) == 0) { red[wv * 3] = sd; red[wv * 3 + 1] = sr; red[wv * 3 + 2] = nn; }
    __syncthreads();
    if (threadIdx.x == 0) { float a = 0, b = 0, c = 0; for (int w = 0; w < 8; ++w) { a += red[w * 3]; b += red[w * 3 + 1]; c += red[w * 3 + 2]; } DBG[blockIdx.x * 4] = a; DBG[blockIdx.x * 4 + 1] = b; DBG[blockIdx.x * 4 + 2] = c; }
    __syncthreads();
}
__device__ __forceinline__ void dbg_emit(const float* DBG, float* out) {
    float a = 0, b = 0, c = 0;
    for (int w = 0; w < (int)gridDim.x; ++w) { a += DBG[w * 4]; b += DBG[w * 4 + 1]; c += DBG[w * 4 + 2]; }
    const float rel = sqrtf(a / b);
    int k = (int)rintf(-2.0f * log10f(rel)); k = k < 0 ? 0 : (k > 16 ? 16 : k);
    if (c > 0.f) k = 17;
    const float cc = sqrtf(0.5f * (float)k);
    const size_t n = (size_t)MTOK * DM;
    for (size_t i = (size_t)blockIdx.x * 512 + threadIdx.x; i < n; i += (size_t)gridDim.x * 512) out[i] = cc;
}
#endif

#if SCAN_DBG == 3
__device__ __forceinline__ void dbg_count_bf16(const bf16_t* A, size_t n, unsigned* cnt) {
    unsigned c = 0;
    for (size_t i = (size_t)blockIdx.x * 512 + threadIdx.x; i < n; i += (size_t)gridDim.x * 512) { const float x = bf2f(A[i]); if (!(x - x == 0.f)) ++c; }
    if (c) atomicAdd(cnt, c);
}
__device__ __forceinline__ void dbg_count_f32(const float* A, size_t n, unsigned* cnt) {
    unsigned c = 0;
    for (size_t i = (size_t)blockIdx.x * 512 + threadIdx.x; i < n; i += (size_t)gridDim.x * 512) { const float x = A[i]; if (!(x - x == 0.f)) ++c; }
    if (c) atomicAdd(cnt, c);
}
__device__ __forceinline__ void dbg_emit3(const unsigned* cnt, float* out) {
    float code = 0.f;
    for (int st = 3; st >= 0; --st) { const unsigned c = cnt[st]; if (c) { float lg = log10f((float)c); lg = lg > 9.f ? 9.f : lg; code = (float)(st + 1) + 0.1f * lg; } }
    const float cc = sqrtf(code);
    const size_t n = (size_t)MTOK * DM;
    for (size_t i = (size_t)blockIdx.x * 512 + threadIdx.x; i < n; i += (size_t)gridDim.x * 512) out[i] = cc;
}
#endif

#if SCAN_DBG == 4 || SCAN_DBG == 6
__device__ __forceinline__ void dbg_compare4(LAS float* red, const bf16_t* A, const bf16_t* B, const bf16_t* C, float* DBG) {
    float sd = 0.f, sr = 0.f, nn = 0.f, mm = 0.f;
    const size_t n = (size_t)MTOK * DM;
    for (size_t i = (size_t)blockIdx.x * 512 + threadIdx.x; i < n; i += (size_t)gridDim.x * 512) {
        const float x = bf2f(A[i]), y = bf2f(B[i]);
        if (!(x - x == 0.f)) nn += 1.f; else { sd += (x - y) * (x - y); sr += y * y; }
        if (A[i] != C[i]) mm += 1.f;
    }
    sd = wave_sum(sd); sr = wave_sum(sr); nn = wave_sum(nn); mm = wave_sum(mm);
    const int wv = threadIdx.x >> 6;
    if ((threadIdx.x & 63) == 0) { red[wv * 4] = sd; red[wv * 4 + 1] = sr; red[wv * 4 + 2] = nn; red[wv * 4 + 3] = mm; }
    __syncthreads();
    if (threadIdx.x == 0) { float a = 0, b = 0, c = 0, d = 0; for (int w = 0; w < 8; ++w) { a += red[w * 4]; b += red[w * 4 + 1]; c += red[w * 4 + 2]; d += red[w * 4 + 3]; }
        DBG[blockIdx.x * 4] = a; DBG[blockIdx.x * 4 + 1] = b; DBG[blockIdx.x * 4 + 2] = c; DBG[blockIdx.x * 4 + 3] = d; }
    __syncthreads();
}
__device__ __forceinline__ void dbg_emit4(const float* DBG, float* out) {
    float a = 0, b = 0, c = 0, d = 0;
    for (int w = 0; w < (int)gridDim.x; ++w) { a += DBG[w * 4]; b += DBG[w * 4 + 1]; c += DBG[w * 4 + 2]; d += DBG[w * 4 + 3]; }
    const float rel = sqrtf(a / b);
    int k = (int)rintf(-log10f(rel)); k = k < 0 ? 0 : (k > 8 ? 8 : k);
#if SCAN_DBG == 6
    const float cc = sqrtf((float)k + ((d + c) > 0.f ? 0.5f : 0.f));
#else
    int m = (int)ceilf(log10f(1.0f + d + c)); m = m > 9 ? 9 : m;
    const float cc = sqrtf((float)k + 0.1f * (float)m);
#endif
    const size_t n = (size_t)MTOK * DM;
    for (size_t i = (size_t)blockIdx.x * 512 + threadIdx.x; i < n; i += (size_t)gridDim.x * 512) out[i] = cc;
}
#endif

#if SCAN_DBG == 5
__device__ __forceinline__ void dbg_lds16_test(LAS unsigned char* lds, unsigned* cnt) {
    const int tid = threadIdx.x;
    unsigned bad = 0;
    for (int rep = 0; rep < 64; ++rep) {
        for (int i = tid; i < 1024; i += 512) *(LAS u32x4*)(lds + i * 16) = (u32x4){0x7fc07fc0u, 0x7fc07fc0u, 0x7fc07fc0u, 0x7fc07fc0u};
        __syncthreads();
        const int k = tid & 127, part = tid >> 7;
#pragma unroll
        for (int i = 0; i < 16; ++i) {
            const int row = 16 * part + i;
            *(LAS bf16_t*)(lds + off_b(row, k >> 3) + 2 * (k & 7)) = (bf16_t)((row * 128 + k + rep) & 0x7fff);
        }
        __syncthreads();
        for (int idx = tid; idx < 64 * 128; idx += 512) {
            const int row = idx >> 7, kk = idx & 127;
            const bf16_t got = *(const LAS bf16_t*)(lds + off_b(row, kk >> 3) + 2 * (kk & 7));
            if (got != (bf16_t)((row * 128 + kk + rep) & 0x7fff)) ++bad;
        }
        __syncthreads();
    }
    if (bad) atomicAdd(cnt, bad);
}
__device__ __forceinline__ void dbg_emit5(const unsigned* cnt, float* out) {
    const unsigned c = cnt[0];
    float code = 0.f;
    if (c) { float lg = log10f((float)c); code = 1.0f + (lg > 8.9f ? 8.9f : lg); }
    const float cc = sqrtf(code);
    const size_t n = (size_t)MTOK * DM;
    for (size_t i = (size_t)blockIdx.x * 512 + threadIdx.x; i < n; i += (size_t)gridDim.x * 512) out[i] = cc;
}
#endif

#if SCAN_DBG == 6
__device__ __forceinline__ void dbg_check_a(LAS float* red, const float* LF, const bf16_t* I1, const bf16_t* LT, const bf16_t* LT2, float* DBG) {
    float sd = 0.f, sr = 0.f, mm = 0.f;
    const size_t n = (size_t)4096 * 16384;
    for (size_t i = (size_t)blockIdx.x * 512 + threadIdx.x; i < n; i += (size_t)gridDim.x * 512) {
        const int item = (int)(i >> 14), v = (int)((i >> 7) & 127), k = (int)(i & 127);
        const int bh = item >> 7, c = item & 127, b = bh >> 4, h = bh & 15;
        const size_t tok0 = (size_t)b * SEQ + c * 64;
        float g = 1.f, L = 0.f;
        for (int s2 = 63; s2 >= 0; --s2) {
            const size_t o = (tok0 + s2) * DM + h * 128;
            const float f = __expf(LF[o + k]);
            L += bf2f(I1[o + v]) * (1.0f - f) * g;
            g *= f;
        }
        const float x = bf2f(LT[i]);
        sd += (x - L) * (x - L); sr += L * L;
        if (LT[i] != LT2[i]) mm += 1.f;
    }
    sd = wave_sum(sd); sr = wave_sum(sr); mm = wave_sum(mm);
    const int wv = threadIdx.x >> 6;
    if ((threadIdx.x & 63) == 0) { red[wv * 4] = sd; red[wv * 4 + 1] = sr; red[wv * 4 + 2] = 0.f; red[wv * 4 + 3] = mm; }
    __syncthreads();
    if (threadIdx.x == 0) { float a = 0, b2 = 0, d = 0; for (int w = 0; w < 8; ++w) { a += red[w * 4]; b2 += red[w * 4 + 1]; d += red[w * 4 + 3]; }
        DBG[blockIdx.x * 4] = a; DBG[blockIdx.x * 4 + 1] = b2; DBG[blockIdx.x * 4 + 2] = 0.f; DBG[blockIdx.x * 4 + 3] = d; }
    __syncthreads();
}
#endif

#if SCAN_DBG == 7
#ifndef DBG_FAM
#define DBG_FAM 0
#endif
__device__ __forceinline__ void dbg_check_a7(const float* LF, const bf16_t* I1, const bf16_t* LT, float* DBG) {
    const size_t n = (size_t)4096 * 16384;
    float nbad = 0.f, nnf = 0.f;
    for (size_t i = (size_t)blockIdx.x * 512 + threadIdx.x; i < n; i += (size_t)gridDim.x * 512 * 8) {
        const int item = (int)(i >> 14), v = (int)((i >> 7) & 127), k = (int)(i & 127);
        const int bh = item >> 7, c = item & 127, b = bh >> 4, h = bh & 15;
        const size_t tok0 = (size_t)b * SEQ + c * 64;
        float g = 1.f, L = 0.f;
        for (int s2 = 63; s2 >= 0; --s2) {
            const size_t o = (tok0 + s2) * DM + h * 128;
            const float f = __expf(LF[o + k]);
            L += bf2f(I1[o + v]) * (1.0f - f) * g;
            g *= f;
        }
        const float x = bf2f(LT[i]);
        if (!(x - x == 0.f)) { nnf += 1.f; nbad += 1.f; }
        else if (fabsf(x - L) > 0.02f * fabsf(L) + 1e-2f) nbad += 1.f;
    }
    nbad = wave_sum(nbad); nnf = wave_sum(nnf);
    if ((threadIdx.x & 63) == 0) { atomicAdd(DBG, nbad); atomicAdd(DBG + 1, nnf); }
}
__device__ __forceinline__ void dbg_emit7(const float* DBG, float* out) {
    const float nb = DBG[0], nf = DBG[1];
    int A = nb == 0.f ? 0 : (nb <= 100.f ? 1 : (nb <= 1e4f ? 3 : (nb <= 1e6f ? 5 : 7)));
    int B = nf == 0.f ? 0 : 5;
    const float cc = sqrtf((float)A + 0.1f * (float)B);
    const size_t n = (size_t)MTOK * DM;
    for (size_t i = (size_t)blockIdx.x * 512 + threadIdx.x; i < n; i += (size_t)gridDim.x * 512) out[i] = cc;
}
#endif
__device__ __forceinline__ int opaque(int v) { asm volatile("" : "+s"(v)); return v; }
template <bool L1> __device__ __forceinline__ void run_gemm_out(const Args& a, LAS unsigned char* lds) {
    unsigned char* ws = a.ws;
    pg8::Gemm g{(const bf16_t*)(ws + (L1 ? slot(3) : slot(0))), (const bf16_t*)(ws + (L1 ? WS_WO : WS_WOUT)), opaque(MTOK), opaque(DM), opaque(L1 ? DM / 2 : DM)};
    pg8::StaticOrder S; S.init(g.M, g.N, (int)gridDim.x, (int)blockIdx.x);
    EpiKVQ_<L1> E{(bf16_t*)(ws + (L1 ? slot(4) : slot(1))), (const float*)(ws + WS_XSO), (const float*)(ws + WS_SWO)};
    pg8::gemm_phase<EpiKVQ_<L1>, pg8::StaticOrder>(lds, g, S, E, nullptr);
}
template <bool L1> __device__ __forceinline__ void run_ln(const Args& a) {
    unsigned char* ws = a.ws;
    phase_ln<L1>((const bf16_t*)(ws + (L1 ? slot(4) : slot(1))), L1 ? (const void*)(ws + slot(2)) : (const void*)a.in[0], a.in[12] + (L1 ? 2 : 0) * DM, a.in[13] + (L1 ? 2 : 0) * DM,
                 (float*)nullptr, (bf16_t*)(ws + (L1 ? slot(8) : slot(5))), (signed char*)(ws + WS_XQ), (float*)(ws + WS_XS));
}
template <bool L1> __device__ __forceinline__ void run_gemm_sc(const Args& a, LAS unsigned char* lds) {
    unsigned char* ws = a.ws;
#if SC8
    pg8::Gemm g{(const bf16_t*)(ws + WS_WC8 + (L1 ? (size_t)DM * DM : 0)), (const bf16_t*)(ws + WS_XQ), opaque(DM), opaque(MTOK), opaque(DM / 2)};
    pg8::StaticOrder S; S.init(g.M, g.N, (int)gridDim.x, (int)blockIdx.x);
    EpiF32_<true> E{(float*)(ws + (L1 ? slot(0) : slot(6))), MTOK, (const float*)(ws + WS_SWC) + (L1 ? DM : 0), (const float*)(ws + WS_XS)};
    pg8::gemm_phase<EpiF32_<true>, pg8::StaticOrder>(lds, g, S, E, nullptr);
#else
    pg8::Gemm g{(const bf16_t*)(ws + WS_WC) + (L1 ? (size_t)DM * DM : 0), (const bf16_t*)(ws + (L1 ? slot(8) : slot(5))), opaque(DM), opaque(MTOK), opaque(DM)};
    pg8::StaticOrder S; S.init(g.M, g.N, (int)gridDim.x, (int)blockIdx.x);
    EpiF32 E{(float*)(ws + (L1 ? slot(0) : slot(6))), MTOK, nullptr, nullptr};
    pg8::gemm_phase<EpiF32, pg8::StaticOrder>(lds, g, S, E, nullptr);
#endif
}
template <bool L1> __device__ __forceinline__ void run_topk(const Args& a, LAS unsigned char* lds) {
    unsigned char* ws = a.ws;
    phase_topk(lds, (const float*)(ws + (L1 ? slot(0) : slot(6))), (int*)(ws + WS_EID), (float*)(ws + WS_GATE));
}
template <bool L1> __device__ __forceinline__ void run_peer(const Args& a, LAS unsigned char* lds) {
    unsigned char* ws = a.ws;
    LAS int* HL = (LAS int*)(lds + (threadIdx.x >> 6) * 8192);
    float* Y = (float*)(ws + (L1 ? slot(0) : slot(6)));
    phase_peer_u((const signed char*)(ws + WS_XQ), (const int*)(ws + WS_EID), ws + WS_UB + (L1 ? (size_t)16384 * DM : 0), HL);
    asm volatile("s_waitcnt vmcnt(0) lgkmcnt(0)" ::: "memory");
    phase_peer_w(HL, (const float*)(ws + WS_XS), (const int*)(ws + WS_EID), (const float*)(ws + WS_GATE),
                 (const float*)(ws + WS_USC) + (L1 ? 16384 : 0), (const float*)(ws + WS_VSC) + (L1 ? 16384 : 0), (signed char*)(ws + WS_W), (float*)(ws + WS_CS));
    asm volatile("s_waitcnt vmcnt(0)" ::: "memory");
    phase_peer_v((const bf16_t*)(ws + (L1 ? slot(8) : slot(5))), (const int*)(ws + WS_EID), (const signed char*)(ws + WS_W), (const float*)(ws + WS_CS),
                 ws + WS_VB + (L1 ? (size_t)16384 * DM : 0), Y);
    asm volatile("s_waitcnt vmcnt(0)" ::: "memory");
    {
        const int lane = threadIdx.x & 63, gw = blockIdx.x * 8 + (threadIdx.x >> 6), nw = gridDim.x * 8, tpw = (MTOK + nw - 1) / nw, tbase = gw * tpw;
        const int tend = tbase + tpw < MTOK ? tbase + tpw : MTOK;
        const float* g = a.in[12] + (L1 ? 3 : 1) * DM; const float* bta = a.in[13] + (L1 ? 3 : 1) * DM;
        float* outf = L1 ? a.out : (float*)nullptr; bf16_t* outb = L1 ? (bf16_t*)nullptr : (bf16_t*)(ws + slot(2));
        for (int row = tbase; row < tend; ++row) {
            float v[32];
            const float* p = Y + (size_t)row * DM;
#pragma unroll
            for (int i = 0; i < 4; ++i) {
                const f32x4 x0 = *(const f32x4*)(p + 512 * i + 8 * lane), x1 = *(const f32x4*)(p + 512 * i + 8 * lane + 4);
#pragma unroll
                for (int j = 0; j < 4; ++j) { v[i * 8 + j] = x0[j]; v[i * 8 + 4 + j] = x1[j]; }
            }
            ln_row_store(v, g, bta, outf ? outf + (size_t)row * DM : nullptr, outb ? outb + (size_t)row * DM : nullptr, lane,
                         L1 ? (signed char*)nullptr : (signed char*)(ws + slot(1)) + (size_t)row * DM, L1 ? (float*)nullptr : (float*)(ws + WS_XS1) + row);
        }
    }
}


#define XB_TMO      128
#define XB_XCNT(j)  (256  + 64 * (j))
#define XB_XSUB(j)  (1280 + 64 * (j))
#define XB_XGEN(j)  (2304 + 64 * (j))
#define XB_TOP      3328
#define XB_TOPGEN   3392
#define XCD_BAR_WORDS 3456
#define XB_SPIN_CAP (1u << 20)
__device__ __forceinline__ unsigned xb_ld(unsigned* p)              { return __hip_atomic_load(p, __ATOMIC_RELAXED, __HIP_MEMORY_SCOPE_AGENT); }
__device__ __forceinline__ unsigned xb_add(unsigned* p, unsigned v) { return __hip_atomic_fetch_add(p, v, __ATOMIC_RELAXED, __HIP_MEMORY_SCOPE_AGENT); }
__device__ __forceinline__ unsigned xb_xcc_id() { return (unsigned)__builtin_amdgcn_s_getreg((3 << 11) | 20) & 0xFu; }
#define XB_SPIN(cond, bar) do { unsigned _sp = 0; while (cond) { __builtin_amdgcn_s_sleep(1); \
    if ((++_sp & 255u) == 0u) { if (xb_ld(&(bar)[XB_TMO])) break; if (_sp > XB_SPIN_CAP) { atomicAdd(&(bar)[XB_TMO], 1u); break; } } } } while (0)
struct XcdBarrier { unsigned* bar; unsigned x; volatile LAS unsigned* st; };
__device__ __forceinline__ XcdBarrier xcd_barrier_post(unsigned* bar, volatile LAS unsigned* st) {
    XcdBarrier b; b.bar = bar; b.x = xb_xcc_id(); b.st = st;
    if (threadIdx.x == 0) (void)xb_add(&bar[XB_XCNT(b.x)], 1u);
    return b;
}
__device__ __forceinline__ void xcd_barrier_complete(unsigned* bar, unsigned x, unsigned& nloc, unsigned& nx) {
    const unsigned G = gridDim.x * gridDim.y * gridDim.z;
    unsigned sum, cnt, mine, sp = 0u;
    for (;;) {
        sum = 0u; cnt = 0u; mine = 0u;
#pragma unroll
        for (unsigned j = 0; j < 16; ++j) { const unsigned c = xb_ld(&bar[XB_XCNT(j)]); sum += c; cnt += (c > 0u) ? 1u : 0u; mine = (j == x) ? c : mine; }
        if (sum == G) break;
        __builtin_amdgcn_s_sleep(1);
        if ((++sp & 255u) == 0u) { if (xb_ld(&bar[XB_TMO])) break; if (sp > XB_SPIN_CAP) { atomicAdd(&bar[XB_TMO], 1u); break; } }
    }
    nloc = mine > 0u ? mine : 1u; nx = cnt > 0u ? cnt : 1u;
}
__device__ __forceinline__ void xcd_barrier(const XcdBarrier& b) {
    asm volatile("s_waitcnt vmcnt(0)" ::: "memory");
    __syncthreads();
    if (threadIdx.x == 0) {
        unsigned* bar = b.bar;
        __builtin_amdgcn_s_waitcnt(0);
        unsigned nloc = b.st[0], nx = b.st[1];
        if (nloc == 0u) { xcd_barrier_complete(bar, b.x, nloc, nx); b.st[0] = nloc; b.st[1] = nx; }
        const unsigned old = xb_add(&bar[XB_XSUB(b.x)], 1u);
        const unsigned gen = old / nloc;
        if (old + 1u == (gen + 1u) * nloc) {
            __builtin_amdgcn_fence(__ATOMIC_RELEASE, "agent");
            asm volatile("s_waitcnt vmcnt(0)" ::: "memory");
            const unsigned og = xb_add(&bar[XB_TOP], 1u);
            const unsigned tg = og / nx;
            if (og + 1u == (tg + 1u) * nx) xb_add(&bar[XB_TOPGEN], 1u);
            else XB_SPIN(xb_ld(&bar[XB_TOPGEN]) == tg, bar);
            __builtin_amdgcn_fence(__ATOMIC_ACQUIRE, "agent");
            xb_add(&bar[XB_XGEN(b.x)], 1u);
            asm volatile("s_waitcnt vmcnt(0)" ::: "memory");
        } else {
            XB_SPIN(xb_ld(&bar[XB_XGEN(b.x)]) == gen, bar);
            __builtin_amdgcn_fence(__ATOMIC_ACQUIRE, "agent");
            asm volatile("s_waitcnt vmcnt(0)" ::: "memory");
        }
    }
    __syncthreads();
}

__global__ void __launch_bounds__(512, 2) mk_fwd(Args a) {
    extern __shared__ __attribute__((aligned(16))) unsigned char lds_raw[];
    LAS unsigned char* lds = (LAS unsigned char*)lds_raw;
    cg::grid_group grid = cg::this_grid();
    unsigned char* ws = a.ws;
#define PHASE_BEGIN(k) if (a.ph_lo <= (k) && (k) < a.ph_hi && EN(k)) {
    volatile LAS unsigned* xb_st = (volatile LAS unsigned*)(lds + LDS_BYTES - 16);
    if (threadIdx.x < 4) xb_st[threadIdx.x] = 0u;
    unsigned* xb_words = (unsigned*)(ws + WS_BAR);
    __syncthreads();
    XcdBarrier xbar = xcd_barrier_post(xb_words, xb_st);
    if (a.ph_lo < 0) grid.sync();
#define PHASE_END(k) if ((k) + 1 < a.ph_hi) xcd_barrier(xbar); }
    PHASE_BEGIN(0) phase_prep(a, lds);
#if SCAN_DBG == 3 || SCAN_DBG == 5
        if (blockIdx.x == 0 && threadIdx.x < 8) ((unsigned*)(ws + WS_CTR + 8192))[threadIdx.x] = 0u;
#endif
#if SCAN_DBG == 7
        if (blockIdx.x == 0 && threadIdx.x < 32) ((float*)(ws + WS_CTR + 4096))[threadIdx.x] = 0.f;
#endif
    PHASE_END(0)
#if SCAN_DBG == 5
    PHASE_BEGIN(1) dbg_lds16_test(lds, (unsigned*)(ws + WS_CTR + 8192)); PHASE_END(1)
#define SKIP_REST 1
#endif
    PHASE_BEGIN(1) {
        pg8::Gemm g{(const bf16_t*)(ws + slot(0)), (const bf16_t*)(ws + WS_WIN), opaque(MTOK), opaque(4 * DM), opaque(DM / 2)};
        pg8::StaticOrder S; S.init(g.M, g.N, (int)gridDim.x, (int)blockIdx.x);
        EpiKVQ_<true> E{(bf16_t*)(ws + slot(1)), (const float*)(ws + WS_XS0), (const float*)(ws + WS_SWIN)};
        pg8::gemm_phase<EpiKVQ_<true>, pg8::StaticOrder>(lds, g, S, E, nullptr);
    } PHASE_END(1)
    PHASE_BEGIN(2) quant_rows_bf16((const bf16_t*)(ws + WS_WC), (signed char*)(ws + WS_WC8), (float*)(ws + WS_SWC), 2 * DM);
        phase_scan_a(lds, (const bf16_t*)(ws + slot(2)), (const float*)(ws + WS_LB), (const bf16_t*)(ws + slot(3)), (bf16_t*)(ws + slot(6)), (float*)(ws + WS_DEC), QuantJob{a.in[10], a.in[11], ws + WS_UB, ws + WS_VB, (float*)(ws + WS_USC), (float*)(ws + WS_VSC)}
#if SCAN_DBG == 3
        , (unsigned*)(ws + WS_CTR + 8192)
#endif
        );
#if SCAN_DBG == 7
        asm volatile("s_waitcnt vmcnt(0)" ::: "memory"); __syncthreads(); grid.sync(); if (threadIdx.x < 64) { __builtin_amdgcn_fence(__ATOMIC_ACQUIRE, "agent"); asm volatile("s_waitcnt vmcnt(0)" ::: "memory"); } __syncthreads();
        dbg_check_a7((const float*)(ws + slot(4)), (const bf16_t*)(ws + slot(2)), (const bf16_t*)(ws + slot(6)), (float*)(ws + WS_CTR + 4096));
#endif
#if SCAN_DBG == 6
#define DSYNC6() asm volatile("s_waitcnt vmcnt(0)" ::: "memory"); __syncthreads(); grid.sync(); if (threadIdx.x < 64) { __builtin_amdgcn_fence(__ATOMIC_ACQUIRE, "agent"); asm volatile("s_waitcnt vmcnt(0)" ::: "memory"); } __syncthreads();
        DSYNC6()
        phase_scan_a(lds, (const bf16_t*)(ws + slot(2)), (const float*)(ws + WS_LB), (const bf16_t*)(ws + slot(3)), (bf16_t*)a.out, (float*)(ws + WS_DEC), QuantJob{a.in[10], a.in[11], ws + WS_UB, ws + WS_VB, (float*)(ws + WS_USC), (float*)(ws + WS_VSC)});
        DSYNC6()
        dbg_check_a((LAS float*)lds, (const float*)(ws + slot(4)), (const bf16_t*)(ws + slot(2)), (const bf16_t*)(ws + slot(6)), (const bf16_t*)a.out, (float*)(ws + WS_CTR + 4096));
#endif
#if SCAN_DBG == 3
        asm volatile("s_waitcnt vmcnt(0)" ::: "memory"); __syncthreads(); grid.sync();
        dbg_count_bf16((const bf16_t*)(ws + slot(6)), (size_t)4096 * 16384, (unsigned*)(ws + WS_CTR + 8192) + 2);
#endif
    PHASE_END(2)
    PHASE_BEGIN(3) phase_scan_b((bf16_t*)(ws + slot(6)), (const float*)(ws + WS_DEC), QuantJob{a.in[10] + (size_t)16384 * DM, a.in[11] + (size_t)16384 * DM, ws + WS_UB + (size_t)16384 * DM, ws + WS_VB + (size_t)16384 * DM, (float*)(ws + WS_USC) + 16384, (float*)(ws + WS_VSC) + 16384});
#if SCAN_DBG == 3
        asm volatile("s_waitcnt vmcnt(0)" ::: "memory"); __syncthreads(); grid.sync();

#endif
    PHASE_END(3)
    PHASE_BEGIN(4) phase_scan_c(lds, (const bf16_t*)(ws + slot(1)), (const bf16_t*)(ws + slot(2)), (const float*)(ws + WS_LB), (const bf16_t*)(ws + slot(3)), (const bf16_t*)(ws + slot(4)), (const bf16_t*)(ws + slot(6)), a.in[2], (bf16_t*)(ws + slot(0)));
#if SCAN_DBG == 1
        asm volatile("s_waitcnt vmcnt(0)" ::: "memory"); __syncthreads(); grid.sync();
        phase_scan_naive((const bf16_t*)(ws + slot(1)), (const float*)(ws + slot(4)), (const bf16_t*)(ws + slot(2)), (float*)(ws + slot(6)));
        asm volatile("s_waitcnt vmcnt(0)" ::: "memory"); __syncthreads(); grid.sync();
        phase_onorm((const float*)(ws + slot(6)), (const bf16_t*)(ws + slot(3)), a.in[2], (bf16_t*)(ws + slot(0)));
#endif
#if SCAN_DBG == 3
        asm volatile("s_waitcnt vmcnt(0)" ::: "memory"); __syncthreads(); grid.sync();

#endif
#if SCAN_DBG == 4
#define DSYNC() asm volatile("s_waitcnt vmcnt(0)" ::: "memory"); __syncthreads(); grid.sync(); if (threadIdx.x < 64) { __builtin_amdgcn_fence(__ATOMIC_ACQUIRE, "agent"); asm volatile("s_waitcnt vmcnt(0)" ::: "memory"); } __syncthreads();
        DSYNC()
        phase_scan_naive((const bf16_t*)(ws + slot(1)), (const float*)(ws + slot(4)), (const bf16_t*)(ws + slot(2)), (float*)(ws + slot(6)));
        DSYNC()
        phase_onorm((const float*)(ws + slot(6)), (const bf16_t*)(ws + slot(3)), a.in[2], (bf16_t*)(ws + slot(8)));
        DSYNC()
        phase_scan_a(lds, (const bf16_t*)(ws + slot(2)), (const float*)(ws + WS_LB), (const bf16_t*)(ws + slot(3)), (bf16_t*)(ws + slot(6)), (float*)(ws + WS_DEC), QuantJob{a.in[10], a.in[11], ws + WS_UB, ws + WS_VB, (float*)(ws + WS_USC), (float*)(ws + WS_VSC)});
        DSYNC()
        phase_scan_b((bf16_t*)(ws + slot(6)), (const float*)(ws + WS_DEC), QuantJob{a.in[10] + (size_t)16384 * DM, a.in[11] + (size_t)16384 * DM, ws + WS_UB + (size_t)16384 * DM, ws + WS_VB + (size_t)16384 * DM, (float*)(ws + WS_USC) + 16384, (float*)(ws + WS_VSC) + 16384});
        DSYNC()
        phase_scan_c(lds, (const bf16_t*)(ws + slot(1)), (const bf16_t*)(ws + slot(2)), (const float*)(ws + WS_LB), (const bf16_t*)(ws + slot(3)), (const bf16_t*)(ws + slot(4)), (const bf16_t*)(ws + slot(6)), a.in[2], (bf16_t*)a.out);
        DSYNC()
        dbg_compare4((LAS float*)lds, (const bf16_t*)(ws + slot(0)), (const bf16_t*)(ws + slot(8)), (const bf16_t*)a.out, (float*)(ws + WS_CTR + 4096));
#endif
#if SCAN_DBG == 2
        asm volatile("s_waitcnt vmcnt(0)" ::: "memory"); __syncthreads(); grid.sync();
        phase_scan_naive((const bf16_t*)(ws + slot(1)), (const float*)(ws + slot(4)), (const bf16_t*)(ws + slot(2)), (float*)(ws + slot(6)));
        asm volatile("s_waitcnt vmcnt(0)" ::: "memory"); __syncthreads(); grid.sync();
        phase_onorm((const float*)(ws + slot(6)), (const bf16_t*)(ws + slot(3)), a.in[2], (bf16_t*)(ws + slot(8)));
        asm volatile("s_waitcnt vmcnt(0)" ::: "memory"); __syncthreads(); grid.sync();
        dbg_compare((LAS float*)lds, (const bf16_t*)(ws + slot(0)), (const bf16_t*)(ws + slot(8)), (float*)(ws + WS_CTR + 4096));
#endif
    PHASE_END(4)
    PHASE_BEGIN(5) run_gemm_out<false>(a, lds); PHASE_END(5)
    PHASE_BEGIN(6) run_ln<false>(a); PHASE_END(6)
    PHASE_BEGIN(7) run_gemm_sc<false>(a, lds); PHASE_END(7)
    PHASE_BEGIN(8) run_topk<false>(a, lds); PHASE_END(8)
    PHASE_BEGIN(9) run_peer<false>(a, lds); PHASE_END(9)
    PHASE_BEGIN(10) {
        pg8::Gemm g{(const bf16_t*)(ws + slot(1)), (const bf16_t*)(ws + WS_WKVQ), opaque(MTOK), opaque(3 * DM), opaque(DM / 2)};
        pg8::StaticOrder S; S.init(g.M, g.N, (int)gridDim.x, (int)blockIdx.x);
        EpiKVQR_<true> E{(bf16_t*)(ws + slot(3)), (const float*)(ws + WS_COS), (const float*)(ws + WS_SIN), (const float*)(ws + WS_XS1), (const float*)(ws + WS_SWKVQ)};
        pg8::gemm_phase<EpiKVQR_<true>, pg8::StaticOrder>(lds, g, S, E, nullptr);
    } PHASE_END(10)
    PHASE_BEGIN(11) phase_kstat((LAS float*)lds, (const bf16_t*)(ws + slot(3)), (float*)(ws + WS_KMEAN), (float*)(ws + WS_KNMAX)); PHASE_END(11)
    PHASE_BEGIN(12) phase_sel(lds, (const bf16_t*)(ws + slot(5)), (const float*)(ws + WS_KMEAN), (unsigned short*)(ws + WS_SUB), (int*)(ws + WS_CNT), (int*)(ws + WS_CTR)); PHASE_END(12)
    PHASE_BEGIN(13) phase_att(lds, (const bf16_t*)(ws + slot(5)), (const bf16_t*)(ws + slot(3)), (const bf16_t*)(ws + slot(4)), (const float*)(ws + WS_KNMAX), (const unsigned short*)(ws + WS_SUB),
                              (const int*)(ws + WS_CNT), (int*)(ws + WS_CTR), (bf16_t*)(ws + slot(6)), (bf16_t*)(ws + slot(0)), (float*)(ws + WS_LS)); PHASE_END(13)
    PHASE_BEGIN(14) phase_comb((LAS float*)lds, (const bf16_t*)(ws + slot(6)), (const bf16_t*)(ws + slot(0)), (const float*)(ws + WS_LS), (signed char*)(ws + slot(3)), (float*)(ws + WS_XSO)); PHASE_END(14)
    PHASE_BEGIN(15) run_gemm_out<true>(a, lds); PHASE_END(15)
    PHASE_BEGIN(16) run_ln<true>(a); PHASE_END(16)
    PHASE_BEGIN(17) run_gemm_sc<true>(a, lds); PHASE_END(17)
    PHASE_BEGIN(18) run_topk<true>(a, lds); PHASE_END(18)
#if SCAN_DBG == 7
    PHASE_BEGIN(19) dbg_emit7((const float*)(ws + WS_CTR + 4096), a.out); PHASE_END(19)
#elif SCAN_DBG == 6
    PHASE_BEGIN(19) dbg_emit4((const float*)(ws + WS_CTR + 4096), a.out); PHASE_END(19)
#elif SCAN_DBG == 5
    PHASE_BEGIN(19) dbg_emit5((const unsigned*)(ws + WS_CTR + 8192), a.out); PHASE_END(19)
#elif SCAN_DBG == 4
    PHASE_BEGIN(19) dbg_emit4((const float*)(ws + WS_CTR + 4096), a.out); PHASE_END(19)
#elif SCAN_DBG == 3
    PHASE_BEGIN(19) dbg_emit3((const unsigned*)(ws + WS_CTR + 8192), a.out); PHASE_END(19)
#elif SCAN_DBG == 2
    PHASE_BEGIN(19) dbg_emit((const float*)(ws + WS_CTR + 4096), a.out); PHASE_END(19)
#else
    PHASE_BEGIN(19) run_peer<true>(a, lds); PHASE_END(19)
#endif
}

extern "C" void kernel_launch(void* const* d_in, const int* in_sizes, int n_in, void* d_out, int out_size, void* d_ws, size_t ws_size, hipStream_t stream) {
    static int grid = 0;
    if (grid == 0) {
        if (n_in != 14 || out_size != MTOK * DM || ws_size < WS_END) { fprintf(stderr, "kernel_launch: unexpected shapes (n_in %d, out %d, ws %zu)\n", n_in, out_size, ws_size); grid = -1; return; }
        int dev = 0, cus = 0, per_cu = 0;
        if (hipGetDevice(&dev) != hipSuccess || hipDeviceGetAttribute(&cus, hipDeviceAttributeMultiprocessorCount, dev) != hipSuccess) { grid = -1; return; }
        if (hipFuncSetAttribute((const void*)mk_fwd, hipFuncAttributeMaxDynamicSharedMemorySize, LDS_BYTES) != hipSuccess) { fprintf(stderr, "kernel_launch: hipFuncSetAttribute failed\n"); grid = -1; return; }
        if (hipOccupancyMaxActiveBlocksPerMultiprocessor(&per_cu, (const void*)mk_fwd, 512, LDS_BYTES) != hipSuccess || per_cu < 1) { fprintf(stderr, "kernel_launch: occupancy query failed (%d)\n", per_cu); (void)hipGetLastError(); per_cu = 1; }
        grid = cus * (per_cu > 1 ? 1 : per_cu);
    }
    if (grid < 0) return;
    Args a{};
    for (int i = 0; i < 14; ++i) a.in[i] = (const float*)d_in[i];
    a.out = (float*)d_out; a.ws = (unsigned char*)d_ws;
#if ONE_LAUNCH
    a.ph_lo = 0; a.ph_hi = NPH;
    (void)hipMemsetAsync((unsigned char*)d_ws + WS_BAR, 0, XCD_BAR_WORDS * sizeof(unsigned), stream);
    void* args[] = {&a};
    hipError_t e = hipLaunchCooperativeKernel((const void*)mk_fwd, dim3(grid), dim3(512), args, LDS_BYTES, stream);
    if (e != hipSuccess) fprintf(stderr, "cooperative launch failed: %s (grid %d)\n", hipGetErrorString(e), grid);
#else
    for (int ph = 0; ph < NPH; ++ph) {
        a.ph_lo = ph; a.ph_hi = ph + 1;
        hipLaunchKernelGGL(mk_fwd, dim3(grid), dim3(512), LDS_BYTES, stream, a);
    }
#endif
}
```

```cpp
#define ONE_LAUNCH 1
#include <hip/hip_runtime.h>
#include <hip/hip_cooperative_groups.h>
#include <cstdio>
namespace cg = cooperative_groups;

#ifndef ONE_LAUNCH
#define ONE_LAUNCH 0
#endif
#ifndef SCAN_DBG
#define SCAN_DBG 0
#endif
#ifndef SCAN_A_VALU
#define SCAN_A_VALU 0
#endif
#ifndef SC8
#define SC8 1
#endif
#ifndef ENMASK
#define ENMASK 0xffffffffu
#endif
#define EN(k) ((ENMASK >> (k)) & 1u)

namespace pg8 {
#define PG8_LAS __attribute__((address_space(3)))
typedef unsigned short bf16_t;
typedef short bf16x8 __attribute__((ext_vector_type(8)));
typedef float f32x4 __attribute__((ext_vector_type(4)));
typedef unsigned u32x4 __attribute__((ext_vector_type(4)));
constexpr int BM = 256, BK = 64, HALF = 128, HTB = HALF * BK * 2  , STAGE_BYTES = 8 * HTB, NXCD = 8, WGM = 8;

__host__ __device__ __forceinline__ int lds_byte(int r, int c) { const int st = (r >> 4) * 2 + (c >> 5), rr = r & 15, cc = c & 31, ob = rr * 64 + cc * 2; return st * 1024 + (ob ^ (((ob >> 9) & 1) << 5)); }
__host__ __device__ __forceinline__ void stage_rc(int b, int& R, int& C) { const int st = b / 1024, sb = b % 1024, swz = sb ^ (((sb >> 9) & 1) << 5); R = (st >> 1) * 16 + swz / 64; C = (st & 1) * 32 + (swz % 64) / 2; }
__host__ __device__ __forceinline__ int perm32(int rho) { const int n = rho >> 4, i = rho & 15; return 8 * (i >> 2) + 4 * n + (i & 3); }

struct Unit { int pm, pn; };
struct Gemm { const bf16_t* A; const bf16_t* Bt; int M, N, K; };

struct StaticOrder {
    int nM, nN, nwg, G, c;
    __host__ __device__ void init(int M, int N, int G_, int c_) { nM = M / BM; nN = N / BM; nwg = nM * nN; G = G_; c = c_; }
    __host__ __device__ bool next(int i, Unit& u) const {
        const long L = (long)i * G + c; if (L >= nwg) return false;
        int wgid = (int)L; { const int q = nwg / NXCD, r = nwg % NXCD, xcd = wgid % NXCD, off = wgid / NXCD; wgid = (xcd < r ? xcd * (q + 1) : r * (q + 1) + (xcd - r) * q) + off; }
        const int nig = WGM * nN, gid = wgid / nig, fm = gid * WGM, gsz = (nM - fm) < WGM ? (nM - fm) : WGM;
        u.pm = fm + ((wgid % nig) % gsz); u.pn = (wgid % nig) / gsz; return true;
    }
    __device__ __forceinline__ void a_ready(const Unit&) const {}
    __device__ __forceinline__ void done(const Unit&) const {}
};
struct CountedOrder : StaticOrder {
    const unsigned* ready; unsigned need; unsigned* tmo;
    __device__ __forceinline__ void a_ready(const Unit& u) const {
        if (threadIdx.x < 64) {
            const unsigned long long t0 = __builtin_amdgcn_s_memrealtime(); unsigned polls = 0;
            while ((unsigned)__builtin_amdgcn_readfirstlane(__hip_atomic_load(ready + 64 * u.pm, __ATOMIC_RELAXED, __HIP_MEMORY_SCOPE_AGENT)) < need) {
                if ((++polls & 255u) == 0u && __builtin_amdgcn_readfirstlane(__hip_atomic_load(tmo, __ATOMIC_RELAXED, __HIP_MEMORY_SCOPE_AGENT)) != 0u) break;
                if (__builtin_amdgcn_s_memrealtime() - t0 > 2000000ull) {
                    if (threadIdx.x == 0) { unsigned expect = 0u; __hip_atomic_compare_exchange_strong(tmo + 1, &expect, 0x600u | (unsigned)(u.pm & 0xff), __ATOMIC_RELAXED, __ATOMIC_RELAXED, __HIP_MEMORY_SCOPE_AGENT); __hip_atomic_store(tmo, 1u, __ATOMIC_RELAXED, __HIP_MEMORY_SCOPE_AGENT); }
                    break; }
                __builtin_amdgcn_s_sleep(2); }
            __builtin_amdgcn_fence(__ATOMIC_ACQUIRE, "agent");
            asm volatile("s_waitcnt vmcnt(0)" ::: "memory");
        }
#if !defined(BROKEN_HOOK_NO_BARRIER)
        asm volatile("" ::: "memory"); __builtin_amdgcn_s_barrier(); asm volatile("" ::: "memory");
#endif
    }
};

__device__ __forceinline__ unsigned cvt_pk_bf16(float lo, float hi) { unsigned r; asm volatile("v_cvt_pk_bf16_f32 %0, %1, %2" : "=v"(r) : "v"(lo), "v"(hi)); return r; }
typedef float f32x2 __attribute__((ext_vector_type(2)));
__device__ __forceinline__ f32x2 gelu_pk(f32x2 v) {
    const f32x2 av = __builtin_elementwise_abs(v), d = av * 0.2316418882f + 1.0f;
    f32x2 t; t.x = __builtin_amdgcn_rcpf(d.x); t.y = __builtin_amdgcn_rcpf(d.y);
    f32x2 q = t * 0.5307027145f + (-0.7265760135f); q = q * t + 0.7107068705f; q = q * t + (-0.142248368f); q = q * t + 0.127414796f; q = q * t;
    const f32x2 s = (v * v) * (-0.72134752044f);
    f32x2 e; e.x = __builtin_amdgcn_exp2f(s.x); e.y = __builtin_amdgcn_exp2f(s.y);
    const f32x2 m = v * (q * e), r = v - m;
    f32x2 o; o.x = v.x < 0.f ? m.x : r.x; o.y = v.y < 0.f ? m.y : r.y; return o;
}

struct EpiF32 {
    static constexpr bool PERM = false, AFTER_DRAIN = false, I8 = false;
    float* C; int ldc; const float* bias;
    __device__ __forceinline__ void operator()(const f32x4 (&acc)[2][2][4][2], const Unit& u, int wr, int wc, int fr, int fq) const {
        const int row0 = u.pm * BM + wr * 64 + fr, col0 = u.pn * BM + wc * 32 + 4 * fq;
        f32x4 bv[2][2];
#pragma unroll
        for (int bj = 0; bj < 2; ++bj)
#pragma unroll
            for (int n = 0; n < 2; ++n) bv[bj][n] = bias ? *(const f32x4*)(bias + col0 + bj * HALF + n * 16) : (f32x4){0.f, 0.f, 0.f, 0.f};
#pragma unroll
        for (int ai = 0; ai < 2; ++ai)
#pragma unroll
            for (int m = 0; m < 4; ++m) { float* rowp = C + (size_t)(row0 + ai * HALF + m * 16) * ldc + col0;
#pragma unroll
                for (int bj = 0; bj < 2; ++bj)
#pragma unroll
                    for (int n = 0; n < 2; ++n) *(f32x4*)(rowp + bj * HALF + n * 16) = acc[ai][bj][m][n] + bv[bj][n]; }
    }
};
template <int ACT  > struct EpiBf16 {
    static constexpr bool PERM = true, AFTER_DRAIN = false, I8 = false;
    bf16_t* O; int ldc; const float* bias; int split_cols; size_t split_stride;
    __device__ __forceinline__ void operator()(const f32x4 (&acc)[2][2][4][2], const Unit& u, int wr, int wc, int fr, int fq) const {
        const int row0 = u.pm * BM + wr * 64 + fr; int colt = u.pn * BM; bf16_t* base = O;
        if (split_cols) { const int t = colt / split_cols; base += (size_t)t * split_stride; colt -= t * split_cols; }
        const int col0 = colt + wc * 32 + 8 * fq, bcol0 = u.pn * BM + wc * 32 + 8 * fq;
        f32x4 bv[2][2];
#pragma unroll
        for (int bj = 0; bj < 2; ++bj)
#pragma unroll
            for (int n = 0; n < 2; ++n) bv[bj][n] = bias ? *(const f32x4*)(bias + bcol0 + bj * HALF + 4 * n) : (f32x4){0.f, 0.f, 0.f, 0.f};
#pragma unroll
        for (int ai = 0; ai < 2; ++ai)
#pragma unroll
            for (int m = 0; m < 4; ++m) { bf16_t* rowp = base + (size_t)(row0 + ai * HALF + m * 16) * ldc + col0;
#pragma unroll
                for (int bj = 0; bj < 2; ++bj) { f32x4 v0 = acc[ai][bj][m][0] + bv[bj][0], v1 = acc[ai][bj][m][1] + bv[bj][1];
                    if (ACT == 1) { f32x2 a = gelu_pk((f32x2){v0[0], v0[1]}), b = gelu_pk((f32x2){v0[2], v0[3]}), c = gelu_pk((f32x2){v1[0], v1[1]}), d = gelu_pk((f32x2){v1[2], v1[3]});
                        v0 = (f32x4){a.x, a.y, b.x, b.y}; v1 = (f32x4){c.x, c.y, d.x, d.y}; }
                    if (ACT == 2) {
#pragma unroll
                        for (int j = 0; j < 4; ++j) { v0[j] = 0.5f * v0[j] * (1.0f + erff(v0[j] * 0.70710678f)); v1[j] = 0.5f * v1[j] * (1.0f + erff(v1[j] * 0.70710678f)); } }
                    u32x4 w; w.x = cvt_pk_bf16(v0[0], v0[1]); w.y = cvt_pk_bf16(v0[2], v0[3]); w.z = cvt_pk_bf16(v1[0], v1[1]); w.w = cvt_pk_bf16(v1[2], v1[3]);
                    *(u32x4*)(rowp + bj * HALF) = w; } }
    }
};

typedef int i32x4 __attribute__((ext_vector_type(4)));
template <bool I8> __device__ __forceinline__ f32x4 mma16(bf16x8 b, bf16x8 a, f32x4 c) {
    if constexpr (I8) return __builtin_bit_cast(f32x4, __builtin_amdgcn_mfma_i32_16x16x64_i8(__builtin_bit_cast(i32x4, b), __builtin_bit_cast(i32x4, a), __builtin_bit_cast(i32x4, c), 0, 0, 0));
    else return __builtin_amdgcn_mfma_f32_16x16x32_bf16(b, a, c, 0, 0, 0);
}
template <bool I8> __device__ __forceinline__ f32x4 accf(f32x4 a) { if constexpr (I8) return __builtin_convertvector(__builtin_bit_cast(i32x4, a), f32x4); else return a; }
template <class Epi, class Sched, bool STAMP = false>
__device__ __forceinline__ void gemm_phase(PG8_LAS unsigned char* lds, const Gemm g, const Sched& S, const Epi& E, unsigned long long* stamps) {
    const int tid = threadIdx.x, wid = __builtin_amdgcn_readfirstlane(tid >> 6), lane = tid & 63, wr = wid >> 2, wc = wid & 3, fr = lane & 15, fq = lane >> 4;
    const int K = g.K, nt = K / BK;
    int ts_lo = 0, ts_hi = 0, nts = 0; const unsigned long long rt_entry = STAMP ? (unsigned long long)wall_clock64() : 0ull;
#define PG8_STAMP() do { if (STAMP && wid == 0 && nts < 64) { const unsigned long long _c = (unsigned long long)clock64(); \
        ts_lo = (lane == nts) ? (int)(unsigned)_c : ts_lo; ts_hi = (lane == nts) ? (int)(unsigned)(_c >> 32) : ts_hi; ++nts; } } while (0)
    PG8_STAMP();
    unsigned voffA[2], voffB[2];
#pragma unroll
    for (int i = 0; i < 2; ++i) { int R, C; stage_rc(tid * 16 + i * 8192, R, C); const int Rb = Epi::PERM ? ((R & ~31) + perm32(R & 31)) : R;
        voffA[i] = (unsigned)(R * K + C) * 2u; voffB[i] = (unsigned)(Rb * K + C) * 2u; }
    const size_t kstep = (size_t)(BK * 2);
    const size_t hstep = (size_t)HALF * K * 2;
    const size_t tstep = 2 * hstep;
    const unsigned ldsw = (unsigned)wid * 1024u;
    const int aoff = lds_byte(wr * 64 + fr, fq * 8), boff = lds_byte(wc * 32 + fr, fq * 8);
#define PG8_SA(b, h) (((b) * 2 + (h)) * HTB)
#define PG8_SB(b, h) ((4 + (b) * 2 + (h)) * HTB)
#define PG8_STAGE(bufoff, gbase, voff) do { _Pragma("unroll") for (int _i = 0; _i < 2; ++_i) \
        __builtin_amdgcn_global_load_lds((const unsigned*)((const char*)(gbase) + (voff)[_i]), (PG8_LAS unsigned*)(lds + (bufoff) + ldsw + _i * 8192), 16, 0, 0); } while (0)
#define PG8_LDA(dst, b, h) do { _Pragma("unroll") for (int m = 0; m < 4; ++m) _Pragma("unroll") for (int k = 0; k < 2; ++k) dst[m][k] = *(const PG8_LAS bf16x8*)(lds + PG8_SA(b, h) + aoff + m * 2048 + k * 1024); } while (0)
#define PG8_LDB(dst, b, h) do { _Pragma("unroll") for (int n = 0; n < 2; ++n) _Pragma("unroll") for (int k = 0; k < 2; ++k) dst[n][k] = *(const PG8_LAS bf16x8*)(lds + PG8_SB(b, h) + boff + n * 2048 + k * 1024); } while (0)
#define PG8_MMA(ai, bj, At, Bt) do { __builtin_amdgcn_s_setprio(1); _Pragma("unroll") for (int m = 0; m < 4; ++m) _Pragma("unroll") for (int n = 0; n < 2; ++n) _Pragma("unroll") for (int k = 0; k < 2; ++k) \
        acc[ai][bj][m][n] = mma16<Epi::I8>(Bt[n][k], At[m][k], acc[ai][bj][m][n]); __builtin_amdgcn_s_setprio(0); } while (0)
#define PG8_WAIT_V(n) asm volatile("s_waitcnt vmcnt(" #n ")" ::: "memory")
#define PG8_WAIT_L(n) asm volatile("s_waitcnt lgkmcnt(" #n ")" ::: "memory")
#define PG8_BAR __builtin_amdgcn_s_barrier()
#define PG8_SCHED __builtin_amdgcn_sched_barrier(0)
    Unit cur, nxt; int ui = 0;
    if (!S.next(0, cur)) return;
    f32x4 acc[2][2][4][2];
#pragma unroll
    for (int a = 0; a < 2; ++a)
#pragma unroll
        for (int b = 0; b < 2; ++b)
#pragma unroll
            for (int m = 0; m < 4; ++m)
#pragma unroll
                for (int n = 0; n < 2; ++n) acc[a][b][m][n] = (f32x4){0.f, 0.f, 0.f, 0.f};
    bf16x8 At[4][2], B0[2][2], B1[2][2];
    const char* cA = (const char*)g.A + (size_t)cur.pm * tstep; const char* cB = (const char*)g.Bt + (size_t)cur.pn * tstep;
    S.a_ready(cur);
    PG8_STAGE(PG8_SB(0, 0), cB, voffB); PG8_STAGE(PG8_SA(0, 0), cA, voffA); PG8_STAGE(PG8_SB(0, 1), cB + hstep, voffB); PG8_STAGE(PG8_SA(0, 1), cA + hstep, voffA);
    if (wr == 1) PG8_BAR;
    PG8_WAIT_V(4); PG8_BAR;
    PG8_STAGE(PG8_SB(1, 0), cB + kstep, voffB); PG8_STAGE(PG8_SA(1, 0), cA + kstep, voffA); PG8_STAGE(PG8_SB(1, 1), cB + hstep + kstep, voffB);
    PG8_WAIT_V(6); PG8_BAR;
    PG8_STAMP();
    for (;;) {
        const bool has_next = S.next(ui + 1, nxt);
        const char* nA = has_next ? (const char*)g.A + (size_t)nxt.pm * tstep : cA; const char* nB = has_next ? (const char*)g.Bt + (size_t)nxt.pn * tstep : cB;
        for (int t = 0; t < nt; t += 2) {
            const bool last = (t == nt - 2);
            const char* a1 = cA + (size_t)(t + 1) * kstep;
            const char* a2 = last ? nA : cA + (size_t)(t + 2) * kstep; const char* b2 = last ? nB : cB + (size_t)(t + 2) * kstep;
            const char* a3 = a2 + kstep; const char* b3 = b2 + kstep;
            if (last && has_next) S.a_ready(nxt);
            PG8_LDB(B0, 0, 0); PG8_SCHED; PG8_LDA(At, 0, 0); PG8_STAGE(PG8_SA(1, 1), a1 + hstep, voffA);
            PG8_WAIT_L(8); PG8_BAR; PG8_WAIT_L(0); PG8_MMA(0, 0, At, B0); PG8_BAR; PG8_SCHED;
            PG8_LDB(B1, 0, 1); PG8_STAGE(PG8_SB(0, 0), b2, voffB);
            PG8_BAR; PG8_WAIT_L(0); PG8_MMA(0, 1, At, B1); PG8_BAR;
            PG8_LDA(At, 0, 1); PG8_STAGE(PG8_SA(0, 0), a2, voffA);
            PG8_BAR; PG8_WAIT_L(0); PG8_MMA(1, 0, At, B0); PG8_BAR; PG8_SCHED;
            PG8_STAGE(PG8_SB(0, 1), b2 + hstep, voffB);
            PG8_WAIT_V(6); PG8_BAR; PG8_MMA(1, 1, At, B1); PG8_BAR;
            PG8_LDB(B0, 1, 0); PG8_SCHED; PG8_LDA(At, 1, 0); PG8_STAGE(PG8_SA(0, 1), a2 + hstep, voffA);
            PG8_WAIT_L(8); PG8_BAR; PG8_WAIT_L(0); PG8_MMA(0, 0, At, B0); PG8_BAR; PG8_SCHED;
            PG8_LDB(B1, 1, 1); PG8_STAGE(PG8_SB(1, 0), b3, voffB);
            PG8_BAR; PG8_WAIT_L(0); PG8_MMA(0, 1, At, B1); PG8_BAR;
            PG8_LDA(At, 1, 1); PG8_STAGE(PG8_SA(1, 0), a3, voffA);
            PG8_BAR; PG8_WAIT_L(0); PG8_MMA(1, 0, At, B0); PG8_BAR; PG8_SCHED;
            PG8_STAGE(PG8_SB(1, 1), b3 + hstep, voffB);
            PG8_WAIT_V(6); PG8_BAR; PG8_MMA(1, 1, At, B1); PG8_BAR;
        }
        PG8_STAMP();
        if constexpr (!Epi::AFTER_DRAIN) { E(acc, cur, wr, wc, fr, fq); S.done(cur); }
        PG8_STAMP();
        if (!has_next) break;
#pragma unroll
        for (int a = 0; a < 2; ++a)
#pragma unroll
            for (int b = 0; b < 2; ++b)
#pragma unroll
                for (int m = 0; m < 4; ++m)
#pragma unroll
                    for (int n = 0; n < 2; ++n) acc[a][b][m][n] = (f32x4){0.f, 0.f, 0.f, 0.f};
        cur = nxt; cA = nA; cB = nB; ++ui;
    }
    PG8_WAIT_V(0);
    if (wr == 0) PG8_BAR;
    PG8_BAR;
    if constexpr (Epi::AFTER_DRAIN) { E.fused(acc, cur, wr, wc, fr, fq, lds, wid, lane); S.done(cur); }
    PG8_STAMP();
    if (STAMP && wid == 0) { stamps[lane] = lane < nts ? (((unsigned long long)(unsigned)ts_hi << 32) | (unsigned)ts_lo) : 0ull;
        if (lane == 62) stamps[62] = rt_entry; if (lane == 63) stamps[63] = (unsigned long long)wall_clock64(); }
#undef PG8_STAMP
#undef PG8_SA
#undef PG8_SB
#undef PG8_STAGE
#undef PG8_LDA
#undef PG8_LDB
#undef PG8_MMA
#undef PG8_WAIT_V
#undef PG8_WAIT_L
#undef PG8_BAR
#undef PG8_SCHED
}
}


#define LAS __attribute__((address_space(3)))
typedef unsigned short bf16_t;
typedef float f32x4 __attribute__((ext_vector_type(4)));
typedef unsigned u32x4 __attribute__((ext_vector_type(4)));
typedef unsigned u32x2 __attribute__((ext_vector_type(2)));
typedef short bf16x8 __attribute__((ext_vector_type(8)));
typedef short s16x4 __attribute__((ext_vector_type(4)));
typedef float f32x16 __attribute__((ext_vector_type(16)));

constexpr int MTOK = 16384, DM = 2048, SEQ = 8192, NHEAD = 16;
constexpr float ALPHA = 1.41421356237309515f;
constexpr size_t MiB = (size_t)1 << 20;
constexpr size_t WS_WIN = 0, WS_WOUT = 32 * MiB, WS_WKVQ = 40 * MiB, WS_WO = 64 * MiB, WS_WC = 72 * MiB, WS_UB = 88 * MiB, WS_VB = 152 * MiB, WS_USC = 216 * MiB, WS_VSC = 217 * MiB, WS_H = 224 * MiB, WS_XQ = 232 * MiB, WS_XS = 264 * MiB, WS_W = 272 * MiB, WS_CS = 280 * MiB, WS_SLOT = 344 * MiB;
constexpr size_t WS_EID = 920 * MiB, WS_GATE = 928 * MiB, WS_COS = 936 * MiB, WS_SIN = 938 * MiB, WS_KMEAN = 940 * MiB, WS_LB = 941 * MiB, WS_LS = 942 * MiB, WS_SUB = 946 * MiB, WS_CNT = 962 * MiB, WS_CTR = 963 * MiB, WS_DEC = 964 * MiB, WS_END = 966 * MiB;
constexpr size_t WS_BAR = WS_CTR + 65536;
constexpr size_t WS_SWOUT = WS_XS + 512 * 1024;
constexpr size_t WS_WC8 = WS_H, WS_SWC = WS_XS + 5 * MiB, WS_XSO = WS_XS + 6 * MiB, WS_SWO = WS_XS + 7 * MiB;
constexpr size_t WS_XS0 = WS_XS + 1 * MiB, WS_SWIN = WS_XS + 2 * MiB, WS_SWKVQ = WS_XS + 3 * MiB, WS_XS1 = WS_XS + 4 * MiB;
constexpr size_t WS_KNMAX = WS_KMEAN + 768 * 1024;
__host__ __device__ constexpr size_t slot(int i) { return WS_SLOT + (size_t)i * 64 * MiB; }
constexpr int LDS_BYTES = 144 * 1024;
constexpr int NPH = 20;

struct Args { const float* in[14]; float* out; unsigned char* ws; int ph_lo, ph_hi; };

__device__ __forceinline__ float bflo(unsigned w) { return __uint_as_float(w << 16); }
__device__ __forceinline__ float bfhi(unsigned w) { return __uint_as_float(w & 0xffff0000u); }
__device__ __forceinline__ float bf2f(bf16_t b) { return __uint_as_float(((unsigned)b) << 16); }
typedef __bf16 bf16x2_t __attribute__((ext_vector_type(2)));
typedef float f32x2_t __attribute__((ext_vector_type(2)));
__device__ __forceinline__ unsigned pk_bf16(float lo, float hi) { const f32x2_t f = {lo, hi}; return __builtin_bit_cast(unsigned, __builtin_convertvector(f, bf16x2_t)); }
__device__ __forceinline__ float wave_sum(float v) {
#pragma unroll
    for (int o = 32; o >= 1; o >>= 1) v += __shfl_xor(v, o);
    return v;
}
__device__ __forceinline__ float wave_max(float v) {
#pragma unroll
    for (int o = 32; o >= 1; o >>= 1) v = fmaxf(v, __shfl_xor(v, o));
    return v;
}
__device__ __forceinline__ float sigmoidf_(float z) { return 1.0f / (1.0f + __expf(-z)); }


__device__ __forceinline__ void store_wt16(void* p, u32x4 v) {
    __hip_atomic_store((unsigned long long*)p, ((unsigned long long)v.y << 32) | v.x, __ATOMIC_RELAXED, __HIP_MEMORY_SCOPE_AGENT);
    __hip_atomic_store((unsigned long long*)p + 1, ((unsigned long long)v.w << 32) | v.z, __ATOMIC_RELAXED, __HIP_MEMORY_SCOPE_AGENT);
}
__device__ __forceinline__ void store_wt8(void* p, u32x2 v) {
    __hip_atomic_store((unsigned long long*)p, ((unsigned long long)v.y << 32) | v.x, __ATOMIC_RELAXED, __HIP_MEMORY_SCOPE_AGENT);
}
struct EpiIn {
    static constexpr bool PERM = true, AFTER_DRAIN = false, I8 = false;
    bf16_t* Q1; float* LF; bf16_t* I1; bf16_t* G1; const float* LB;
    __device__ __forceinline__ void operator()(const pg8::f32x4 (&acc)[2][2][4][2], const pg8::Unit& u, int wr, int wc, int fr, int fq) const {
        const int type = u.pn >> 3;
        const int row0 = u.pm * 256 + wr * 64 + fr, col0 = (u.pn & 7) * 256 + wc * 32 + 8 * fq;
        if (type == 1) {
#pragma unroll
            for (int bj = 0; bj < 2; ++bj) {
                const int c = col0 + bj * 128;
                const f32x4 lb0 = *(const f32x4*)(LB + c), lb1 = *(const f32x4*)(LB + c + 4);
#pragma unroll
                for (int ai = 0; ai < 2; ++ai)
#pragma unroll
                    for (int m = 0; m < 4; ++m) {
                        float* p = LF + (size_t)(row0 + ai * 128 + m * 16) * DM + c;
                        f32x4 o0, o1;
#pragma unroll
                        for (int j = 0; j < 4; ++j) {
                            o0[j] = __logf(lb0[j] + (1.0f - lb0[j]) * sigmoidf_(acc[ai][bj][m][0][j]));
                            o1[j] = __logf(lb1[j] + (1.0f - lb1[j]) * sigmoidf_(acc[ai][bj][m][1][j]));
                        }
                        *(f32x4*)p = o0; *(f32x4*)(p + 4) = o1;
                    }
            }
        } else {
            bf16_t* dst = Q1 + (size_t)(type - (type > 0 ? 1 : 0)) * ((size_t)32 << 20);
            const bool act = (type != 2);
#pragma unroll
            for (int ai = 0; ai < 2; ++ai)
#pragma unroll
                for (int m = 0; m < 4; ++m)
#pragma unroll
                    for (int bj = 0; bj < 2; ++bj) {
                        f32x4 v0 = acc[ai][bj][m][0], v1 = acc[ai][bj][m][1];
                        if (act) {
#pragma unroll
                            for (int j = 0; j < 4; ++j) { v0[j] = v0[j] * sigmoidf_(v0[j]); v1[j] = v1[j] * sigmoidf_(v1[j]); }
                        }
                        u32x4 w; w.x = pk_bf16(v0[0], v0[1]); w.y = pk_bf16(v0[2], v0[3]); w.z = pk_bf16(v1[0], v1[1]); w.w = pk_bf16(v1[2], v1[3]);
                        *(u32x4*)(dst + (size_t)(row0 + ai * 128 + m * 16) * DM + col0 + bj * 128) = w;
                    }
        }
    }
};
struct EpiRes {
    static constexpr bool PERM = false, AFTER_DRAIN = false, I8 = false;
    const float* res; float* Y;
    __device__ __forceinline__ void operator()(const pg8::f32x4 (&acc)[2][2][4][2], const pg8::Unit& u, int wr, int wc, int fr, int fq) const {
        const int row0 = u.pm * 256 + wr * 64 + fr, col0 = u.pn * 256 + wc * 32 + 4 * fq;
#pragma unroll
        for (int ai = 0; ai < 2; ++ai)
#pragma unroll
            for (int m = 0; m < 4; ++m) {
                const size_t off = (size_t)(row0 + ai * 128 + m * 16) * DM + col0;
#pragma unroll
                for (int bj = 0; bj < 2; ++bj)
#pragma unroll
                    for (int n = 0; n < 2; ++n) {
                        const f32x4 r = *(const f32x4*)(res + off + bj * 128 + n * 16);
                        *(f32x4*)(Y + off + bj * 128 + n * 16) = r * ALPHA + acc[ai][bj][m][n];
                    }
            }
    }
};
template <bool Q8> struct EpiF32_ {
    static constexpr bool PERM = false, AFTER_DRAIN = false, I8 = Q8;
    float* C; int ldc; const float* SA; const float* SB;
    __device__ __forceinline__ void operator()(const pg8::f32x4 (&acc)[2][2][4][2], const pg8::Unit& u, int wr, int wc, int fr, int fq) const {
        const int row0 = u.pm * 256 + wr * 64 + fr, col0 = u.pn * 256 + wc * 32 + 4 * fq;
        float sa[2][4]; f32x4 sb[2][2];
#pragma unroll
        for (int ai = 0; ai < 2; ++ai)
#pragma unroll
            for (int m = 0; m < 4; ++m) sa[ai][m] = Q8 ? SA[row0 + ai * 128 + m * 16] : 1.0f;
#pragma unroll
        for (int bj = 0; bj < 2; ++bj)
#pragma unroll
            for (int n = 0; n < 2; ++n) sb[bj][n] = Q8 ? *(const f32x4*)(SB + col0 + bj * 128 + n * 16) : (f32x4){1.f, 1.f, 1.f, 1.f};
#pragma unroll
        for (int ai = 0; ai < 2; ++ai)
#pragma unroll
            for (int m = 0; m < 4; ++m) {
                const int row = row0 + ai * 128 + m * 16;
#pragma unroll
                for (int bj = 0; bj < 2; ++bj)
#pragma unroll
                    for (int n = 0; n < 2; ++n) {
                        f32x4 v = pg8::accf<Q8>(acc[ai][bj][m][n]);
                        if (Q8) v = v * sb[bj][n] * sa[ai][m];
                        *(f32x4*)(C + (size_t)row * ldc + col0 + bj * 128 + n * 16) = v;
                    }
            }
    }
};
typedef EpiF32_<false> EpiF32;
template <bool Q8> struct EpiKVQ_ {
    static constexpr bool PERM = true, AFTER_DRAIN = false, I8 = Q8;
    bf16_t* K; const float* SA; const float* SB;
    __device__ __forceinline__ void operator()(const pg8::f32x4 (&acc)[2][2][4][2], const pg8::Unit& u, int wr, int wc, int fr, int fq) const {
        const int t = u.pn >> 3;
        bf16_t* dst = K + (size_t)t * ((size_t)32 << 20);
        const int row0 = u.pm * 256 + wr * 64 + fr, col0 = (u.pn & 7) * 256 + wc * 32 + 8 * fq;
        float sa[2][4]; f32x4 sb[2][2];
#pragma unroll
        for (int ai = 0; ai < 2; ++ai)
#pragma unroll
            for (int m = 0; m < 4; ++m) sa[ai][m] = Q8 ? SA[row0 + ai * 128 + m * 16] : 1.0f;
#pragma unroll
        for (int bj = 0; bj < 2; ++bj)
#pragma unroll
            for (int n = 0; n < 2; ++n) sb[bj][n] = Q8 ? *(const f32x4*)(SB + u.pn * 256 + bj * 128 + wc * 32 + 8 * fq + 4 * n) : (f32x4){1.f, 1.f, 1.f, 1.f};
#pragma unroll
        for (int ai = 0; ai < 2; ++ai)
#pragma unroll
            for (int m = 0; m < 4; ++m)
#pragma unroll
                for (int bj = 0; bj < 2; ++bj) {
                    const int row = row0 + ai * 128 + m * 16;
                    f32x4 v0 = pg8::accf<Q8>(acc[ai][bj][m][0]), v1 = pg8::accf<Q8>(acc[ai][bj][m][1]);
                    if (Q8) { v0 = v0 * sb[bj][0] * sa[ai][m]; v1 = v1 * sb[bj][1] * sa[ai][m]; }
                    u32x4 w; w.x = pk_bf16(v0[0], v0[1]); w.y = pk_bf16(v0[2], v0[3]); w.z = pk_bf16(v1[0], v1[1]); w.w = pk_bf16(v1[2], v1[3]);
                    *(u32x4*)(dst + (size_t)row * DM + col0 + bj * 128) = w;
                }
    }
};
typedef EpiKVQ_<false> EpiKVQ;

template <bool Q8> struct EpiKVQR_ {
    static constexpr bool PERM = true, AFTER_DRAIN = false, I8 = Q8;
    bf16_t* K; const float* COS; const float* SIN; const float* SA; const float* SB;
    __device__ __forceinline__ void operator()(const pg8::f32x4 (&acc)[2][2][4][2], const pg8::Unit& u, int wr, int wc, int fr, int fq) const {
        const int t = u.pn >> 3;
        bf16_t* dst = K + (size_t)t * ((size_t)32 << 20);
        const int row0 = u.pm * 256 + wr * 64 + fr;
        const int g = 4 * wc + fq;
        const int col0 = (u.pn & 7) * 256 + wc * 32 + 8 * fq;
        float sa[2][4]; f32x4 sb[2][2];
#pragma unroll
        for (int ai = 0; ai < 2; ++ai)
#pragma unroll
            for (int m = 0; m < 4; ++m) sa[ai][m] = Q8 ? SA[row0 + ai * 128 + m * 16] : 1.0f;
#pragma unroll
        for (int bj = 0; bj < 2; ++bj)
#pragma unroll
            for (int n = 0; n < 2; ++n) sb[bj][n] = Q8 ? *(const f32x4*)(SB + u.pn * 256 + bj * 128 + wc * 32 + 8 * fq + 4 * n) : (f32x4){1.f, 1.f, 1.f, 1.f};
        if (t == 1) {
#pragma unroll
            for (int ai = 0; ai < 2; ++ai)
#pragma unroll
                for (int m = 0; m < 4; ++m)
#pragma unroll
                    for (int bj = 0; bj < 2; ++bj) {
                        const int row = row0 + ai * 128 + m * 16;
                        f32x4 a = pg8::accf<Q8>(acc[ai][bj][m][0]), b = pg8::accf<Q8>(acc[ai][bj][m][1]);
                        if (Q8) { a = a * sb[bj][0] * sa[ai][m]; b = b * sb[bj][1] * sa[ai][m]; }
                        u32x4 w; w.x = pk_bf16(a[0], a[1]); w.y = pk_bf16(a[2], a[3]); w.z = pk_bf16(b[0], b[1]); w.w = pk_bf16(b[2], b[3]);
                        *(u32x4*)(dst + (size_t)row * DM + col0 + bj * 128) = w;
                    }
        } else {
            const int pos0 = row0 & (SEQ - 1);
            f32x4 c = *(const f32x4*)(COS + pos0 * 64 + 4 * g), s_ = *(const f32x4*)(SIN + pos0 * 64 + 4 * g);
            const f32x4 c16 = *(const f32x4*)(COS + 16 * 64 + 4 * g), s16 = *(const f32x4*)(SIN + 16 * 64 + 4 * g), c128 = *(const f32x4*)(COS + 128 * 64 + 4 * g), s128 = *(const f32x4*)(SIN + 128 * 64 + 4 * g);
#pragma unroll
            for (int q = 0; q < 8; ++q) {
                const int ai = q >> 2, m = ai ? 7 - q : q;
#pragma unroll
                for (int bj = 0; bj < 2; ++bj) {
                    f32x4 a = pg8::accf<Q8>(acc[ai][bj][m][0]), b = pg8::accf<Q8>(acc[ai][bj][m][1]);
                    if (Q8) { a = a * sb[bj][0] * sa[ai][m]; b = b * sb[bj][1] * sa[ai][m]; }
                    u32x2 w1, w2;
                    w1.x = pk_bf16(a[0] * c[0] - b[0] * s_[0], a[1] * c[1] - b[1] * s_[1]); w1.y = pk_bf16(a[2] * c[2] - b[2] * s_[2], a[3] * c[3] - b[3] * s_[3]);
                    w2.x = pk_bf16(a[0] * s_[0] + b[0] * c[0], a[1] * s_[1] + b[1] * c[1]); w2.y = pk_bf16(a[2] * s_[2] + b[2] * c[2], a[3] * s_[3] + b[3] * c[3]);
                    bf16_t* p = dst + (size_t)(row0 + ai * 128 + m * 16) * DM + ((u.pn & 7) * 2 + bj) * 128 + 4 * g;
                    *(u32x2*)p = w1; *(u32x2*)(p + 64) = w2;
                }
                if (q < 3) { const f32x4 cn = c * c16 - s_ * s16, sn = s_ * c16 + c * s16; c = cn; s_ = sn; }
                else if (q == 3) { const f32x4 cn = c * c128 - s_ * s128, sn = s_ * c128 + c * s128; c = cn; s_ = sn; }
                else if (q < 7) { const f32x4 cn = c * c16 + s_ * s16, sn = s_ * c16 - c * s16; c = cn; s_ = sn; }
            }
        }
    }
};

__host__ __device__ __forceinline__ int rot_pos(int d) { return d < 64 ? 8 * (d >> 2) + (d & 3) : 8 * ((d - 64) >> 2) + 4 + (d & 3); }
__device__ __forceinline__ void transpose_tiles(LAS float* tile, const float* src, int ldn, int K, int N, bf16_t* dst, int nperm = 0) {
    const int tid = threadIdx.x;
    const int tn = N / 64, ntiles = tn * (K / 64);
    f32x4 nx[2];
#define TT_LOAD(tI_) { const int k0_ = ((tI_) / tn) * 64, n0_ = ((tI_) % tn) * 64; _Pragma("unroll") for (int r = 0; r < 2; ++r) nx[r] = *(const f32x4*)(src + (size_t)(k0_ + (tid >> 4) + 32 * r) * ldn + n0_ + (tid & 15) * 4); }
    if ((int)blockIdx.x < ntiles) TT_LOAD((int)blockIdx.x)
    for (int tI = blockIdx.x; tI < ntiles; tI += gridDim.x) {
        const int k0 = (tI / tn) * 64, n0 = (tI % tn) * 64;
        const f32x4 c0 = nx[0], c1 = nx[1];
        if (tI + (int)gridDim.x < ntiles) TT_LOAD(tI + (int)gridDim.x)
#pragma unroll
        for (int r = 0; r < 2; ++r) {
            const int kk = (tid >> 4) + 32 * r, nn = (tid & 15) * 4;
            const f32x4 v = r == 0 ? c0 : c1;
            tile[kk * 65 + nn + 0] = v[0]; tile[kk * 65 + nn + 1] = v[1]; tile[kk * 65 + nn + 2] = v[2]; tile[kk * 65 + nn + 3] = v[3];
        }
        __syncthreads();
        {
            const int nn = tid >> 3, kk8 = (tid & 7) * 8;
            float f[8];
#pragma unroll
            for (int j = 0; j < 8; ++j) f[j] = tile[(kk8 + j) * 65 + nn];
            u32x4 w; w.x = pk_bf16(f[0], f[1]); w.y = pk_bf16(f[2], f[3]); w.z = pk_bf16(f[4], f[5]); w.w = pk_bf16(f[6], f[7]);
            const int nsrc = n0 + nn, nrow = nsrc < nperm ? (nsrc & ~127) + rot_pos(nsrc & 127) : nsrc;
            *(u32x4*)(dst + (size_t)nrow * K + k0 + kk8) = w;
        }
        __syncthreads();
    }
}
#undef TT_LOAD
__device__ __forceinline__ void convert_bf16(const float* src, bf16_t* dst, size_t n) {
    const size_t stride = (size_t)gridDim.x * 512 * 8;
    for (size_t i = ((size_t)blockIdx.x * 512 + threadIdx.x) * 8; i < n; i += stride) {
        const f32x4 a = *(const f32x4*)(src + i), b = *(const f32x4*)(src + i + 4);
        u32x4 w; w.x = pk_bf16(a[0], a[1]); w.y = pk_bf16(a[2], a[3]); w.z = pk_bf16(b[0], b[1]); w.w = pk_bf16(b[2], b[3]);
        *(u32x4*)(dst + i) = w;
    }
}
__device__ __forceinline__ void split8(const f32x4 x0, const f32x4 x1, bf16x8& hi, bf16x8& lo) {
    u32x4 h, l;
    h.x = pk_bf16(x0[0], x0[1]); h.y = pk_bf16(x0[2], x0[3]); h.z = pk_bf16(x1[0], x1[1]); h.w = pk_bf16(x1[2], x1[3]);
    l.x = pk_bf16(x0[0] - bflo(h.x), x0[1] - bfhi(h.x)); l.y = pk_bf16(x0[2] - bflo(h.y), x0[3] - bfhi(h.y)); l.z = pk_bf16(x1[0] - bflo(h.z), x1[1] - bfhi(h.z)); l.w = pk_bf16(x1[2] - bflo(h.w), x1[3] - bfhi(h.w));
    hi = __builtin_bit_cast(bf16x8, h); lo = __builtin_bit_cast(bf16x8, l);
}
__device__ __forceinline__ void fold_peer_keys(const float* w_query, const float* sub_keys, bf16_t* WcT) {
    const int lane = threadIdx.x & 63, gw = blockIdx.x * 8 + (threadIdx.x >> 6), nw = gridDim.x * 8, r32 = lane & 31, hh2 = lane >> 5;
    for (int wt = gw; wt < 8192; wt += nw) {
        const int item = wt >> 3, sub = wt & 7, keyt = sub & 3, kint = sub >> 2;
        const int l = item >> 9, rem = item & 511, hh = rem >> 5, kb = rem & 31, h = hh >> 1, half = hh & 1;
        const float* sk = sub_keys + (size_t)(((l * 2 + half) * 8 + h) * 128 + keyt * 32 + r32) * 128 + 8 * hh2;
        const float* wq = w_query + (size_t)l * DM * DM + (size_t)(kb * 64 + kint * 32 + r32) * DM + h * 256 + half * 128 + 8 * hh2;
        f32x16 acc;
#pragma unroll
        for (int i = 0; i < 16; ++i) acc[i] = 0.f;
#pragma unroll 1
        for (int kh = 0; kh < 2; ++kh) {
            f32x4 av[8], bv[8];
#pragma unroll
            for (int ks = 0; ks < 4; ++ks) { const int kk = 64 * kh + 16 * ks; av[2 * ks] = *(const f32x4*)(wq + kk); av[2 * ks + 1] = *(const f32x4*)(wq + kk + 4); bv[2 * ks] = *(const f32x4*)(sk + kk); bv[2 * ks + 1] = *(const f32x4*)(sk + kk + 4); }
#pragma unroll
            for (int ks = 0; ks < 4; ++ks) {
                bf16x8 ah, al, bh, bl;
                split8(av[2 * ks], av[2 * ks + 1], ah, al); split8(bv[2 * ks], bv[2 * ks + 1], bh, bl);
                acc = __builtin_amdgcn_mfma_f32_32x32x16_bf16(al, bh, acc, 0, 0, 0);
                acc = __builtin_amdgcn_mfma_f32_32x32x16_bf16(ah, bl, acc, 0, 0, 0);
                acc = __builtin_amdgcn_mfma_f32_32x32x16_bf16(ah, bh, acc, 0, 0, 0);
            }
        }
        bf16_t* o = WcT + (size_t)l * DM * DM + (size_t)(h * 256 + half * 128 + keyt * 32 + r32) * DM + kb * 64 + kint * 32 + 4 * hh2;
#pragma unroll
        for (int q = 0; q < 4; ++q) { u32x2 w; w.x = pk_bf16(acc[4 * q], acc[4 * q + 1]); w.y = pk_bf16(acc[4 * q + 2], acc[4 * q + 3]); *(u32x2*)(o + 8 * q) = w; }
    }
}

__device__ __forceinline__ void quant_rows(const float* src, unsigned char* dst, float* scl, int nrows) {
    const int lane = threadIdx.x & 63, gw = blockIdx.x * 8 + (threadIdx.x >> 6), nw = gridDim.x * 8;
    for (int row = gw; row < nrows; row += nw) {
        const float* p = src + (size_t)row * DM;
        f32x4 v[8];
#pragma unroll
        for (int i = 0; i < 2; ++i)
#pragma unroll
            for (int q = 0; q < 4; ++q) v[i * 4 + q] = *(const f32x4*)(p + 1024 * i + 16 * lane + 4 * q);
        float am = 0.f;
#pragma unroll
        for (int i = 0; i < 8; ++i) am = fmaxf(am, fmaxf(fmaxf(fabsf(v[i][0]), fabsf(v[i][1])), fmaxf(fabsf(v[i][2]), fabsf(v[i][3]))));
        am = fmaxf(wave_max(am), 1e-30f);
        const float inv = 127.0f / am;
        if (lane == 0) scl[row] = am * (1.0f / 127.0f);
#pragma unroll
        for (int i = 0; i < 2; ++i) {
            u32x4 w;
#pragma unroll
            for (int q = 0; q < 4; ++q) {
                const f32x4 t = v[i * 4 + q];
                const unsigned b0 = (unsigned)(int)(rintf(t[0] * inv) + 128.0f), b1 = (unsigned)(int)(rintf(t[1] * inv) + 128.0f), b2 = (unsigned)(int)(rintf(t[2] * inv) + 128.0f), b3 = (unsigned)(int)(rintf(t[3] * inv) + 128.0f);
                w[q] = b0 | (b1 << 8) | (b2 << 16) | (b3 << 24);
            }
            *(u32x4*)(dst + (size_t)row * DM + 1024 * i + 16 * lane) = w;
        }
    }
}
__device__ __forceinline__ void quant_transpose(LAS unsigned char* lds, const float* src, int ldn, int N, signed char* dst, float* scl, int nperm = 0) {
    const int tid = threadIdx.x, kg = tid >> 3, c4 = (tid & 7) * 4, wv = tid >> 6;
    LAS float* red = (LAS float*)lds;
    for (int sI = blockIdx.x; sI < N / 32; sI += gridDim.x) {
        const int n0 = sI * 32;
        f32x4 v[32];
        const float* p = src + (size_t)(kg * 32) * ldn + n0 + c4;
#pragma unroll
        for (int it = 0; it < 32; ++it) v[it] = *(const f32x4*)(p + (size_t)it * ldn);
        f32x4 am = {0.f, 0.f, 0.f, 0.f};
#pragma unroll
        for (int it = 0; it < 32; ++it)
#pragma unroll
            for (int j = 0; j < 4; ++j) am[j] = fmaxf(am[j], fabsf(v[it][j]));
#pragma unroll
        for (int o = 8; o <= 32; o <<= 1)
#pragma unroll
            for (int j = 0; j < 4; ++j) am[j] = fmaxf(am[j], __shfl_xor(am[j], o));
        if ((tid & 63) < 8) *(LAS f32x4*)(red + wv * 32 + c4) = am;
        __syncthreads();
#pragma unroll
        for (int w = 0; w < 8; ++w) { const f32x4 r = *(const LAS f32x4*)(red + w * 32 + c4);
#pragma unroll
            for (int j = 0; j < 4; ++j) am[j] = fmaxf(am[j], r[j]); }
#pragma unroll
        for (int j = 0; j < 4; ++j) {
            const float m = fmaxf(am[j], 1e-30f), inv = 127.0f / m;
            const int nsrc = n0 + c4 + j, nrow = nsrc < nperm ? (nsrc & ~127) + rot_pos(nsrc & 127) : nsrc;
            if (kg == 0) scl[nrow] = m * (1.0f / 127.0f);
            signed char* o = dst + (size_t)nrow * DM + kg * 32;
#pragma unroll
            for (int h = 0; h < 2; ++h) {
                u32x4 w;
#pragma unroll
                for (int d = 0; d < 4; ++d) {
                    unsigned bb = 0;
#pragma unroll
                    for (int e = 0; e < 4; ++e) bb |= ((unsigned)(int)rintf(v[h * 16 + d * 4 + e][j] * inv) & 0xffu) << (8 * e);
                    w[d] = bb;
                }
                *(u32x4*)(o + h * 16) = w;
            }
        }
        __syncthreads();
    }
}
__device__ __forceinline__ void quant_rows_s(const float* src, signed char* dst, float* scl, int nrows) {
    const int lane = threadIdx.x & 63, gw = blockIdx.x * 8 + (threadIdx.x >> 6), nw = gridDim.x * 8;
    for (int row = gw; row < nrows; row += nw) {
        const float* p = src + (size_t)row * DM;
        f32x4 v[8];
#pragma unroll
        for (int i = 0; i < 2; ++i)
#pragma unroll
            for (int q = 0; q < 4; ++q) v[i * 4 + q] = *(const f32x4*)(p + 1024 * i + 16 * lane + 4 * q);
        float am = 0.f;
#pragma unroll
        for (int i = 0; i < 8; ++i) am = fmaxf(am, fmaxf(fmaxf(fabsf(v[i][0]), fabsf(v[i][1])), fmaxf(fabsf(v[i][2]), fabsf(v[i][3]))));
        am = fmaxf(wave_max(am), 1e-30f);
        const float inv = 127.0f / am;
        if (lane == 0) scl[row] = am * (1.0f / 127.0f);
#pragma unroll
        for (int i = 0; i < 2; ++i) {
            u32x4 w;
#pragma unroll
            for (int q = 0; q < 4; ++q) {
                const f32x4 t = v[i * 4 + q];
                w[q] = ((unsigned)(int)rintf(t[0] * inv) & 0xffu) | (((unsigned)(int)rintf(t[1] * inv) & 0xffu) << 8) | (((unsigned)(int)rintf(t[2] * inv) & 0xffu) << 16) | (((unsigned)(int)rintf(t[3] * inv) & 0xffu) << 24);
            }
            *(u32x4*)(dst + (size_t)row * DM + 1024 * i + 16 * lane) = w;
        }
    }
}
__device__ __forceinline__ void quant_rows_bf16(const bf16_t* src, signed char* dst, float* scl, int nrows) {
    const int lane = threadIdx.x & 63, gw = blockIdx.x * 8 + (threadIdx.x >> 6), nw = gridDim.x * 8;
    for (int row = gw; row < nrows; row += nw) {
        u32x4 v[4];
#pragma unroll
        for (int i = 0; i < 4; ++i) v[i] = *(const u32x4*)(src + (size_t)row * DM + 512 * i + 8 * lane);
        float am = 0.f;
#pragma unroll
        for (int i = 0; i < 4; ++i)
#pragma unroll
            for (int d = 0; d < 4; ++d) am = fmaxf(am, fmaxf(fabsf(bflo(v[i][d])), fabsf(bfhi(v[i][d]))));
        am = fmaxf(wave_max(am), 1e-30f);
        const float inv = 127.0f / am;
        if (lane == 0) scl[row] = am * (1.0f / 127.0f);
#pragma unroll
        for (int i = 0; i < 4; ++i) {
            u32x2 w;
            w.x = ((unsigned)(int)rintf(bflo(v[i].x) * inv) & 0xffu) | (((unsigned)(int)rintf(bfhi(v[i].x) * inv) & 0xffu) << 8) | (((unsigned)(int)rintf(bflo(v[i].y) * inv) & 0xffu) << 16) | (((unsigned)(int)rintf(bfhi(v[i].y) * inv) & 0xffu) << 24);
            w.y = ((unsigned)(int)rintf(bflo(v[i].z) * inv) & 0xffu) | (((unsigned)(int)rintf(bfhi(v[i].z) * inv) & 0xffu) << 8) | (((unsigned)(int)rintf(bflo(v[i].w) * inv) & 0xffu) << 16) | (((unsigned)(int)rintf(bfhi(v[i].w) * inv) & 0xffu) << 24);
            *(u32x2*)(dst + (size_t)row * DM + 512 * i + 8 * lane) = w;
        }
    }
}
__device__ __forceinline__ void phase_prep(const Args& a, LAS unsigned char* lds) {
    unsigned char* ws = a.ws;
    LAS float* tile = (LAS float*)lds;
    quant_transpose(lds, a.in[1], 4 * DM, 4 * DM, (signed char*)(ws + WS_WIN), (float*)(ws + WS_SWIN));
    quant_transpose(lds, a.in[3], DM, DM, (signed char*)(ws + WS_WOUT), (float*)(ws + WS_SWOUT));
    quant_transpose(lds, a.in[5], 2 * DM, 2 * DM, (signed char*)(ws + WS_WKVQ), (float*)(ws + WS_SWKVQ), DM);
    quant_transpose(lds, a.in[6], DM, DM, (signed char*)(ws + WS_WKVQ) + (size_t)2 * DM * DM, (float*)(ws + WS_SWKVQ) + 2 * DM, DM);
    quant_transpose(lds, a.in[7], DM, DM, (signed char*)(ws + WS_WO), (float*)(ws + WS_SWO));
    fold_peer_keys(a.in[8], a.in[9], (bf16_t*)(ws + WS_WC));
    quant_rows_s(a.in[0], (signed char*)(ws + slot(0)), (float*)(ws + WS_XS0), MTOK);
    const int gtid = blockIdx.x * 512 + threadIdx.x, gthreads = gridDim.x * 512;
    float* COS = (float*)(ws + WS_COS); float* SIN = (float*)(ws + WS_SIN); float* LB = (float*)(ws + WS_LB);
    for (int i = gtid; i < SEQ * 64; i += gthreads) {
        const int pos = i >> 6, j = i & 63;
        double inv = 1.0; const double r = 0.86596432336006535;
        for (int q = 0; q < j; ++q) inv *= r;
        const float ang = (float)pos * (float)inv;
        const double x = (double)ang;
        const double n = __builtin_rint(x * 0.15915494309189535);
        const float rf = (float)__builtin_fma(-n, 6.283185307179586, x);
        COS[i] = cosf(rf); SIN[i] = sinf(rf);
    }
    for (int c = gtid; c < DM; c += gthreads) { const float l0 = a.in[4][c], l1 = a.in[4][DM + c]; LB[c] = 1.0f / (1.0f + expf(l1 - l0)); }
}

__device__ __forceinline__ void phase_scan_naive(const bf16_t* Q1, const float* LF, const bf16_t* I1, float* O) {
    const int lane = threadIdx.x & 63, gw = blockIdx.x * 8 + (threadIdx.x >> 6), nw = gridDim.x * 8;
    for (int item = gw; item < 2 * NHEAD * 128; item += nw) {
        const int bh = item >> 7, v = item & 127, b = bh >> 4, h = bh & 15;
        const size_t base = (size_t)b * SEQ * DM + h * 128;
        float S0 = 0.f, S1 = 0.f;
#pragma unroll 4
        for (int t = 0; t < SEQ; ++t) {
            const size_t ro = base + (size_t)t * DM;
            const float f0 = __expf(LF[ro + lane]), f1 = __expf(LF[ro + 64 + lane]);
            const float q0 = bf2f(Q1[ro + lane]), q1 = bf2f(Q1[ro + 64 + lane]);
            const float iv = bf2f(I1[ro + v]);
            S0 = f0 * S0 + (1.0f - f0) * iv; S1 = f1 * S1 + (1.0f - f1) * iv;
            const float p = wave_sum(q0 * S0 + q1 * S1);
            if (lane == 0) O[ro + v] = p;
        }
    }
}
__device__ __forceinline__ void phase_onorm(const float* O, const bf16_t* G1, const float* gnorm, bf16_t* OG) {
    const int lane = threadIdx.x & 63, gw = blockIdx.x * 8 + (threadIdx.x >> 6), nw = gridDim.x * 8;
    const float gn0 = gnorm[2 * lane], gn1 = gnorm[2 * lane + 1];
    for (int item = gw; item < MTOK * NHEAD; item += nw) {
        const size_t off = (size_t)item * 128 + 2 * lane;
        const float o0 = O[off], o1 = O[off + 1];
        const float ss = wave_sum(o0 * o0 + o1 * o1);
        const float r = rsqrtf(ss * (1.0f / 128.0f) + 1e-6f);
        const unsigned g = *(const unsigned*)(G1 + off);
        *(unsigned*)(OG + off) = pk_bf16(o0 * r * gn0 * bflo(g), o1 * r * gn1 * bfhi(g));
    }
}

__device__ __forceinline__ void ln_row_store(float (&v)[32], const float* g, const float* bta, float* outf, bf16_t* outb, int lane, signed char* outq = nullptr, float* outs = nullptr) {
    float s = 0.f;
#pragma unroll
    for (int i = 0; i < 32; ++i) s += v[i];
    const float mu = wave_sum(s) * (1.0f / DM);
    float q = 0.f;
#pragma unroll
    for (int i = 0; i < 32; ++i) { v[i] -= mu; q += v[i] * v[i]; }
    const float rstd = rsqrtf(wave_sum(q) * (1.0f / DM) + 1e-5f);
    float am = 0.f;
#pragma unroll
    for (int i = 0; i < 4; ++i) {
        const int c = 512 * i + 8 * lane;
        const f32x4 g0 = *(const f32x4*)(g + c), g1 = *(const f32x4*)(g + c + 4), b0 = *(const f32x4*)(bta + c), b1 = *(const f32x4*)(bta + c + 4);
        f32x4 o0, o1;
#pragma unroll
        for (int j = 0; j < 4; ++j) { o0[j] = v[i * 8 + j] * rstd * g0[j] + b0[j]; o1[j] = v[i * 8 + 4 + j] * rstd * g1[j] + b1[j]; v[i * 8 + j] = o0[j]; v[i * 8 + 4 + j] = o1[j]; am = fmaxf(am, fmaxf(fabsf(o0[j]), fabsf(o1[j]))); }
        if (outf) { *(f32x4*)(outf + c) = o0; *(f32x4*)(outf + c + 4) = o1; }
        if (outb) { u32x4 w; w.x = pk_bf16(o0[0], o0[1]); w.y = pk_bf16(o0[2], o0[3]); w.z = pk_bf16(o1[0], o1[1]); w.w = pk_bf16(o1[2], o1[3]); *(u32x4*)(outb + c) = w; }
    }
    if (outq) {
        am = fmaxf(wave_max(am), 1e-30f);
        const float inv = 127.0f / am;
        if (lane == 0) *outs = am * (1.0f / 127.0f);
#pragma unroll
        for (int i = 0; i < 4; ++i) {
            u32x2 w;
            w.x = ((unsigned)(int)rintf(v[i * 8 + 0] * inv) & 0xffu) | (((unsigned)(int)rintf(v[i * 8 + 1] * inv) & 0xffu) << 8) | (((unsigned)(int)rintf(v[i * 8 + 2] * inv) & 0xffu) << 16) | (((unsigned)(int)rintf(v[i * 8 + 3] * inv) & 0xffu) << 24);
            w.y = ((unsigned)(int)rintf(v[i * 8 + 4] * inv) & 0xffu) | (((unsigned)(int)rintf(v[i * 8 + 5] * inv) & 0xffu) << 8) | (((unsigned)(int)rintf(v[i * 8 + 6] * inv) & 0xffu) << 16) | (((unsigned)(int)rintf(v[i * 8 + 7] * inv) & 0xffu) << 24);
            *(u32x2*)(outq + 512 * i + 8 * lane) = w;
        }
    }
}
__device__ __forceinline__ void ln_row_store16(float (&v)[32], const float* g, const float* bta, float* outf, bf16_t* outb, int lane) {
    float s = 0.f;
#pragma unroll
    for (int i = 0; i < 32; ++i) s += v[i];
    const float mu = wave_sum(s) * (1.0f / DM);
    float q = 0.f;
#pragma unroll
    for (int i = 0; i < 32; ++i) { v[i] -= mu; q += v[i] * v[i]; }
    const float rstd = rsqrtf(wave_sum(q) * (1.0f / DM) + 1e-5f);
#pragma unroll
    for (int i = 0; i < 2; ++i) {
        const int c = 1024 * i + 16 * lane;
        f32x4 o[4];
#pragma unroll
        for (int qd = 0; qd < 4; ++qd) {
            const f32x4 gg = *(const f32x4*)(g + c + 4 * qd), bb = *(const f32x4*)(bta + c + 4 * qd);
#pragma unroll
            for (int j = 0; j < 4; ++j) o[qd][j] = v[16 * i + 4 * qd + j] * rstd * gg[j] + bb[j];
            *(f32x4*)(outf + c + 4 * qd) = o[qd];
        }
        if (outb) {
            u32x4 w0, w1;
            w0.x = pk_bf16(o[0][0], o[0][1]); w0.y = pk_bf16(o[0][2], o[0][3]); w0.z = pk_bf16(o[1][0], o[1][1]); w0.w = pk_bf16(o[1][2], o[1][3]);
            w1.x = pk_bf16(o[2][0], o[2][1]); w1.y = pk_bf16(o[2][2], o[2][3]); w1.z = pk_bf16(o[3][0], o[3][1]); w1.w = pk_bf16(o[3][2], o[3][3]);
            *(u32x4*)(outb + c) = w0; *(u32x4*)(outb + c + 8) = w1;
        }
    }
}
template <bool RES16> __device__ __forceinline__ void phase_ln(const bf16_t* Y, const void* RESv, const float* g, const float* bta, float* outf, bf16_t* outb, signed char* outq = nullptr, float* outs = nullptr) {
    const int lane = threadIdx.x & 63, gw = blockIdx.x * 8 + (threadIdx.x >> 6), nw = gridDim.x * 8;
    for (int row = gw; row < MTOK; row += nw) {
        float v[32];
        const bf16_t* p = Y + (size_t)row * DM;
#pragma unroll
        for (int i = 0; i < 4; ++i) {
            const u32x4 yw = *(const u32x4*)(p + 512 * i + 8 * lane);
            const f32x4 a = {bflo(yw.x), bfhi(yw.x), bflo(yw.y), bfhi(yw.y)}, b = {bflo(yw.z), bfhi(yw.z), bflo(yw.w), bfhi(yw.w)};
            f32x4 ra, rb;
            if (RES16) { const u32x4 w = *(const u32x4*)((const bf16_t*)RESv + (size_t)row * DM + 512 * i + 8 * lane); ra = (f32x4){bflo(w.x), bfhi(w.x), bflo(w.y), bfhi(w.y)}; rb = (f32x4){bflo(w.z), bfhi(w.z), bflo(w.w), bfhi(w.w)}; }
            else { const float* rp = (const float*)RESv + (size_t)row * DM; ra = *(const f32x4*)(rp + 512 * i + 8 * lane); rb = *(const f32x4*)(rp + 512 * i + 8 * lane + 4); }
#pragma unroll
            for (int j = 0; j < 4; ++j) { v[i * 8 + j] = a[j] + ALPHA * ra[j]; v[i * 8 + 4 + j] = b[j] + ALPHA * rb[j]; }
        }
        ln_row_store(v, g, bta, outf ? outf + (size_t)row * DM : nullptr, outb ? outb + (size_t)row * DM : nullptr, lane, outq ? outq + (size_t)row * DM : nullptr, outs ? outs + row : nullptr);
    }
}

__device__ __forceinline__ void wave_argmax(float& v, int& idx) {
#pragma unroll
    for (int o = 32; o >= 1; o >>= 1) {
        const float ov = __shfl_xor(v, o); const int oi = __shfl_xor(idx, o);
        if (ov > v || (ov == v && oi < idx)) { v = ov; idx = oi; }
    }
}
__device__ __forceinline__ unsigned fkey(float x) { const unsigned u = __float_as_uint(x); return u ^ (unsigned)(((int)u >> 31) | 0x80000000); }
__device__ __forceinline__ float funkey(unsigned k) { const unsigned u = (k & 0x80000000u) ? (k ^ 0x80000000u) : ~k; return __uint_as_float(u); }
__device__ __forceinline__ void sort16_insert(unsigned (&r)[16], unsigned v) {
#pragma unroll
    for (int i = 0; i < 16; ++i) { const unsigned m = r[i] > v ? r[i] : v; v = r[i] > v ? v : r[i]; r[i] = m; }
}
__device__ __forceinline__ void phase_topk(LAS unsigned char* lds, const float* SCT, int* EID, float* GATE) {
    LAS unsigned char* ib = lds + threadIdx.x * 32;
    for (int item = blockIdx.x * 512 + threadIdx.x; item < MTOK * 8; item += gridDim.x * 512) {
        const int h = item >> 14, tok = item & (MTOK - 1);
        const float* p = SCT + (size_t)(h * 256) * MTOK + tok;
        unsigned r1[16], r2[16];
#pragma unroll
        for (int i = 0; i < 16; ++i) { r1[i] = 0u; r2[i] = 0u; }
#pragma unroll 8
        for (int e = 0; e < 128; ++e) {
            const float x1 = p[(size_t)e * MTOK], x2 = p[(size_t)(128 + e) * MTOK];
            sort16_insert(r1, (fkey(x1) & ~0x7Fu) | (unsigned)e);
            sort16_insert(r2, (fkey(x2) & ~0x7Fu) | (unsigned)e);
        }
        float v1[16], v2[16];
#pragma unroll
        for (int i = 0; i < 16; ++i) { v1[i] = funkey(r1[i] & ~0x7Fu); v2[i] = funkey(r2[i] & ~0x7Fu); ib[i] = (unsigned char)(r1[i] & 0x7Fu); ib[16 + i] = (unsigned char)(r2[i] & 0x7Fu); }
        unsigned r3[16];
#pragma unroll
        for (int i = 0; i < 16; ++i) r3[i] = 0u;
#pragma unroll
        for (int a = 0; a < 16; ++a)
#pragma unroll
            for (int bq = 0; bq < 16; ++bq)
                if ((a + 1) * (bq + 1) <= 16) sort16_insert(r3, (fkey(v1[a] + v2[bq]) & ~0xFFu) | (unsigned)(a * 16 + bq));
        const float mx = funkey(r3[0] & ~0xFFu);
        float ev[16]; float sum = 0.f;
#pragma unroll
        for (int i = 0; i < 16; ++i) { ev[i] = __expf(funkey(r3[i] & ~0xFFu) - mx); sum += ev[i]; }
        const float rs = 1.0f / sum;
        int eid[16];
#pragma unroll
        for (int i = 0; i < 16; ++i) { const unsigned f = r3[i] & 0xFFu; eid[i] = (int)ib[f >> 4] * 128 + (int)ib[16 + (f & 15u)]; }
        int* eo = EID + (size_t)tok * 128 + h * 16; float* go = GATE + (size_t)tok * 128 + h * 16;
#pragma unroll
        for (int q = 0; q < 4; ++q) {
            *(u32x4*)(eo + 4 * q) = (u32x4){(unsigned)eid[4 * q], (unsigned)eid[4 * q + 1], (unsigned)eid[4 * q + 2], (unsigned)eid[4 * q + 3]};
            *(f32x4*)(go + 4 * q) = (f32x4){ev[4 * q] * rs, ev[4 * q + 1] * rs, ev[4 * q + 2] * rs, ev[4 * q + 3] * rs};
        }
    }
}

__device__ __forceinline__ float gelu_erf(float x) { return 0.5f * x * (1.0f + erff(x * 0.70710678118654752f)); }
__device__ __forceinline__ float ub0(unsigned w) { return (float)(w & 0xffu); }
__device__ __forceinline__ float ub1(unsigned w) { return (float)((w >> 8) & 0xffu); }
__device__ __forceinline__ float ub2(unsigned w) { return (float)((w >> 16) & 0xffu); }
__device__ __forceinline__ float ub3(unsigned w) { return (float)(w >> 24); }
__device__ __forceinline__ void phase_peer(LAS unsigned char* lds, const float* X, const int* EID, const float* GATE, const unsigned char* U, const unsigned char* V, const float* USC, const float* VSC,
                                           const float* g, const float* bta, float* outf, bf16_t* outb) {
    const int lane = threadIdx.x & 63, wv = threadIdx.x >> 6, gw = blockIdx.x * 8 + wv, nw = gridDim.x * 8;
    LAS float* hb = (LAS float*)(lds + wv * 512);
    for (int tok = gw; tok < MTOK; tok += nw) {
        float x[32];
        const float* xp = X + (size_t)tok * DM;
#pragma unroll
        for (int i = 0; i < 2; ++i)
#pragma unroll
            for (int q = 0; q < 4; ++q) { const f32x4 t = *(const f32x4*)(xp + 1024 * i + 16 * lane + 4 * q); x[16 * i + 4 * q] = t[0]; x[16 * i + 4 * q + 1] = t[1]; x[16 * i + 4 * q + 2] = t[2]; x[16 * i + 4 * q + 3] = t[3]; }
        float sx = 0.f;
#pragma unroll
        for (int j = 0; j < 32; ++j) sx += x[j];
        const float d0 = -128.0f * sx;
        const int e0 = EID[(size_t)tok * 128 + lane], e1 = EID[(size_t)tok * 128 + 64 + lane];
        const float g0 = GATE[(size_t)tok * 128 + lane], g1 = GATE[(size_t)tok * 128 + 64 + lane];
        for (int bt = 0; bt < 16; ++bt) {
            float d[8];
#pragma unroll
            for (int r = 0; r < 8; ++r) {
                const int e = bt * 8 + r;
                const int idx = __builtin_amdgcn_readfirstlane(__shfl(bt < 8 ? e0 : e1, e & 63));
                const u32x4* up = (const u32x4*)(U + (size_t)idx * DM) + lane;
                float acc = d0;
#pragma unroll
                for (int i = 0; i < 2; ++i) {
                    const u32x4 w = up[i * 64];
                    acc += x[16 * i + 0] * ub0(w.x) + x[16 * i + 1] * ub1(w.x) + x[16 * i + 2] * ub2(w.x) + x[16 * i + 3] * ub3(w.x)
                         + x[16 * i + 4] * ub0(w.y) + x[16 * i + 5] * ub1(w.y) + x[16 * i + 6] * ub2(w.y) + x[16 * i + 7] * ub3(w.y)
                         + x[16 * i + 8] * ub0(w.z) + x[16 * i + 9] * ub1(w.z) + x[16 * i + 10] * ub2(w.z) + x[16 * i + 11] * ub3(w.z)
                         + x[16 * i + 12] * ub0(w.w) + x[16 * i + 13] * ub1(w.w) + x[16 * i + 14] * ub2(w.w) + x[16 * i + 15] * ub3(w.w);
                }
                d[r] = acc;
            }
            const bool b5 = lane & 32, b4 = lane & 16, b3 = lane & 8;
            float t4[4];
#pragma unroll
            for (int q = 0; q < 4; ++q) { const float keep = b5 ? d[4 + q] : d[q], send = b5 ? d[q] : d[4 + q]; t4[q] = keep + __shfl_xor(send, 32); }
            float t2[2];
#pragma unroll
            for (int q = 0; q < 2; ++q) { const float keep = b4 ? t4[2 + q] : t4[q], send = b4 ? t4[q] : t4[2 + q]; t2[q] = keep + __shfl_xor(send, 16); }
            float t1;
            { const float keep = b3 ? t2[1] : t2[0], send = b3 ? t2[0] : t2[1]; t1 = keep + __shfl_xor(send, 8); }
            t1 += __shfl_xor(t1, 4); t1 += __shfl_xor(t1, 2); t1 += __shfl_xor(t1, 1);
            if ((lane & 7) == 0) hb[bt * 8 + (lane >> 3 & 1) + 2 * (lane >> 4 & 1) + 4 * (lane >> 5 & 1)] = t1;
        }
        asm volatile("s_waitcnt lgkmcnt(0)" ::: "memory");
        const float h0 = hb[lane] * USC[e0], h1 = hb[64 + lane] * USC[e1];
        const float w0 = g0 * gelu_erf(h0) * VSC[e0], w1 = g1 * gelu_erf(h1) * VSC[e1];
        float wsum = wave_sum(w0 + w1);
        float y[32];
#pragma unroll
        for (int i = 0; i < 32; ++i) y[i] = 0.f;
#pragma unroll 8
        for (int e = 0; e < 128; ++e) {
            const int idx = __builtin_amdgcn_readfirstlane(__shfl(e < 64 ? e0 : e1, e & 63));
            const float wt = __shfl(e < 64 ? w0 : w1, e & 63);
            const u32x4* vp = (const u32x4*)(V + (size_t)idx * DM) + lane;
#pragma unroll
            for (int i = 0; i < 2; ++i) {
                const u32x4 w = vp[i * 64];
                y[16 * i + 0] += wt * ub0(w.x); y[16 * i + 1] += wt * ub1(w.x); y[16 * i + 2] += wt * ub2(w.x); y[16 * i + 3] += wt * ub3(w.x);
                y[16 * i + 4] += wt * ub0(w.y); y[16 * i + 5] += wt * ub1(w.y); y[16 * i + 6] += wt * ub2(w.y); y[16 * i + 7] += wt * ub3(w.y);
                y[16 * i + 8] += wt * ub0(w.z); y[16 * i + 9] += wt * ub1(w.z); y[16 * i + 10] += wt * ub2(w.z); y[16 * i + 11] += wt * ub3(w.z);
                y[16 * i + 12] += wt * ub0(w.w); y[16 * i + 13] += wt * ub1(w.w); y[16 * i + 14] += wt * ub2(w.w); y[16 * i + 15] += wt * ub3(w.w);
            }
        }
        const float corr = -128.0f * wsum;
#pragma unroll
        for (int i = 0; i < 32; ++i) y[i] = y[i] + corr + ALPHA * x[i];
        ln_row_store16(y, g, bta, outf + (size_t)tok * DM, outb ? outb + (size_t)tok * DM : nullptr, lane);
        asm volatile("s_waitcnt lgkmcnt(0)" ::: "memory");
    }
}

__device__ __forceinline__ int row_dot_i8(const u32x4 (&xq)[2], const unsigned char* rowp, int lane) {
    const u32x4* up = (const u32x4*)rowp + lane;
    int acc = 0;
#pragma unroll
    for (int i = 0; i < 2; ++i) {
        const u32x4 w = up[i * 64];
        acc = __builtin_amdgcn_sdot4((int)xq[i].x, (int)(w.x ^ 0x80808080u), acc, false); acc = __builtin_amdgcn_sdot4((int)xq[i].y, (int)(w.y ^ 0x80808080u), acc, false);
        acc = __builtin_amdgcn_sdot4((int)xq[i].z, (int)(w.z ^ 0x80808080u), acc, false); acc = __builtin_amdgcn_sdot4((int)xq[i].w, (int)(w.w ^ 0x80808080u), acc, false);
    }
    return acc;
}
__device__ __forceinline__ void peer_issue8(u32x4 (&seg)[8], const unsigned char* base, const u32x4 ia, const u32x4 ib) {
    seg[0] = *(const u32x4*)(base + (size_t)ia.x * DM); seg[1] = *(const u32x4*)(base + (size_t)ia.y * DM); seg[2] = *(const u32x4*)(base + (size_t)ia.z * DM); seg[3] = *(const u32x4*)(base + (size_t)ia.w * DM);
    seg[4] = *(const u32x4*)(base + (size_t)ib.x * DM); seg[5] = *(const u32x4*)(base + (size_t)ib.y * DM); seg[6] = *(const u32x4*)(base + (size_t)ib.z * DM); seg[7] = *(const u32x4*)(base + (size_t)ib.w * DM);
}
__device__ __forceinline__ void peer_dot8(int (&d)[8], const u32x4 (&seg)[8], const u32x4 xq) {
#pragma unroll
    for (int i = 0; i < 8; ++i) {
        int acc = __builtin_amdgcn_sdot4((int)xq.x, (int)(seg[i].x ^ 0x80808080u), 0, false);
        acc = __builtin_amdgcn_sdot4((int)xq.y, (int)(seg[i].y ^ 0x80808080u), acc, false);
        acc = __builtin_amdgcn_sdot4((int)xq.z, (int)(seg[i].z ^ 0x80808080u), acc, false);
        d[i] = __builtin_amdgcn_sdot4((int)xq.w, (int)(seg[i].w ^ 0x80808080u), acc, false);
    }
}
__device__ __forceinline__ void phase_peer_u(const signed char* XQ, const int* EID, const unsigned char* U, LAS int* HL  ) {
    const int lane = threadIdx.x & 63, wv = threadIdx.x >> 6, es = lane >> 3, cc = lane & 7;
    const bool b2 = cc & 4, b1 = cc & 2, b0 = cc & 1;
    const int nw = gridDim.x * 8, gw = blockIdx.x * 8 + wv, tpw = (MTOK + nw - 1) / nw, tbase = gw * tpw;
    int cnt = MTOK - tbase; cnt = cnt > tpw ? tpw : cnt;
    if (cnt <= 0) return;
    for (int i = lane; i < cnt * 128; i += 64) HL[i] = 0;
    asm volatile("s_waitcnt lgkmcnt(0)" ::: "memory");
    const int nit = 16 * cnt;
    const unsigned char* ub = U + cc * 16;
    u32x4 m0a, m0b, m0c, m0d, m0x, m1a, m1b, m1c, m1d, m1x, m2a, m2b, m2c, m2d, m2x; u32x4 sA[8], sB[8];
#define PU_LOAD(sl_, k_, A_, B_, C_, D_, X_) { const int* ep_ = EID + (size_t)(tbase + (k_)) * 128 + es * 16; A_ = *(const u32x4*)ep_; B_ = *(const u32x4*)(ep_ + 4); C_ = *(const u32x4*)(ep_ + 8); D_ = *(const u32x4*)(ep_ + 12); \
        X_ = *(const u32x4*)(XQ + (size_t)(tbase + (k_)) * DM + (sl_) * 128 + cc * 16); }
#define PU_NEXT(sl_, k_, sn_, kn_) { kn_ = (k_) + 1; sn_ = (sl_); if (kn_ == cnt) { kn_ = 0; ++sn_; } if (sn_ == 16) { sn_ = 15; kn_ = cnt - 1; } }
    int sl = 0, k = 0, sl1, k1, sl2, k2;
    PU_NEXT(sl, k, sl1, k1) PU_NEXT(sl1, k1, sl2, k2)
    PU_LOAD(sl, k, m0a, m0b, m0c, m0d, m0x)
    PU_LOAD(sl1, k1, m1a, m1b, m1c, m1d, m1x)
    peer_issue8(sA, ub + sl * 128, m0a, m0b);
    for (int it = 0; it < nit; ++it) {
        PU_LOAD(sl2, k2, m2a, m2b, m2c, m2d, m2x)
        peer_issue8(sB, ub + sl * 128, m0c, m0d);
        int dlo[8]; peer_dot8(dlo, sA, m0x);
        peer_issue8(sA, ub + sl1 * 128, m1a, m1b);
        int dhi[8]; peer_dot8(dhi, sB, m0x);
        int t8[8], t4[4], t2[2];
#pragma unroll
        for (int q = 0; q < 8; ++q) { const int keep = b2 ? dhi[q] : dlo[q], send = b2 ? dlo[q] : dhi[q]; t8[q] = keep + __shfl_xor(send, 4); }
#pragma unroll
        for (int q = 0; q < 4; ++q) { const int keep = b1 ? t8[4 + q] : t8[q], send = b1 ? t8[q] : t8[4 + q]; t4[q] = keep + __shfl_xor(send, 2); }
#pragma unroll
        for (int q = 0; q < 2; ++q) { const int keep = b0 ? t4[2 + q] : t4[q], send = b0 ? t4[q] : t4[2 + q]; t2[q] = keep + __shfl_xor(send, 1); }
        { LAS int* hp = HL + k * 128 + es * 16 + (b2 ? 8 : 0) + (b1 ? 4 : 0) + (b0 ? 2 : 0);
          __hip_atomic_fetch_add(hp, t2[0], __ATOMIC_RELAXED, __HIP_MEMORY_SCOPE_WORKGROUP); __hip_atomic_fetch_add(hp + 1, t2[1], __ATOMIC_RELAXED, __HIP_MEMORY_SCOPE_WORKGROUP); }
        sl = sl1; k = k1; sl1 = sl2; k1 = k2; PU_NEXT(sl1, k1, sl2, k2)
        m0a = m1a; m0b = m1b; m0c = m1c; m0d = m1d; m0x = m1x; m1a = m2a; m1b = m2b; m1c = m2c; m1d = m2d; m1x = m2x;
    }
#undef PU_LOAD
#undef PU_NEXT
}
__device__ __forceinline__ void phase_peer_w(const LAS int* HL, const float* XS, const int* EID, const float* GATE, const float* USC, const float* VSC, signed char* WQ, float* SW) {
    const int lane = threadIdx.x & 63, gw = blockIdx.x * 8 + (threadIdx.x >> 6), nw = gridDim.x * 8, tpw = (MTOK + nw - 1) / nw, tbase = gw * tpw;
    const int tend = tbase + tpw < MTOK ? tbase + tpw : MTOK;
    for (int tok = tbase; tok < tend; ++tok) {
        const int h0 = HL[(tok - tbase) * 128 + lane], h1 = HL[(tok - tbase) * 128 + 64 + lane];
        const int e0 = EID[(size_t)tok * 128 + lane], e1 = EID[(size_t)tok * 128 + 64 + lane];
        const float xs = XS[tok];
        const float w0 = GATE[(size_t)tok * 128 + lane] * gelu_erf((float)h0 * xs * USC[e0]) * VSC[e0];
        const float w1 = GATE[(size_t)tok * 128 + 64 + lane] * gelu_erf((float)h1 * xs * USC[e1]) * VSC[e1];
        const float am = fmaxf(wave_max(fmaxf(fabsf(w0), fabsf(w1))), 1e-30f), inv = 127.0f / am;
        WQ[(size_t)tok * 128 + lane] = (signed char)(int)rintf(w0 * inv); WQ[(size_t)tok * 128 + 64 + lane] = (signed char)(int)rintf(w1 * inv);
        if (lane == 0) SW[tok] = am * (1.0f / 127.0f);
    }
}
__device__ __forceinline__ void peer_dot4x4(int (&acc)[16], const u32x4 sa, const u32x4 sb, const u32x4 sc, const u32x4 sd, const unsigned w4) {
#pragma unroll
    for (int k = 0; k < 4; ++k) {
        const unsigned A = sa[k], B = sb[k], C = sc[k], D = sd[k];
        const unsigned p0 = __builtin_amdgcn_perm(B, A, 0x05010400u);
        const unsigned p1 = __builtin_amdgcn_perm(B, A, 0x07030602u);
        const unsigned p2 = __builtin_amdgcn_perm(D, C, 0x05010400u);
        const unsigned p3 = __builtin_amdgcn_perm(D, C, 0x07030602u);
        const unsigned t0 = __builtin_amdgcn_perm(p2, p0, 0x05040100u);
        const unsigned t1 = __builtin_amdgcn_perm(p2, p0, 0x07060302u);
        const unsigned t2 = __builtin_amdgcn_perm(p3, p1, 0x05040100u);
        const unsigned t3 = __builtin_amdgcn_perm(p3, p1, 0x07060302u);
        acc[4 * k + 0] = __builtin_amdgcn_sdot4((int)t0, (int)w4, acc[4 * k + 0], false);
        acc[4 * k + 1] = __builtin_amdgcn_sdot4((int)t1, (int)w4, acc[4 * k + 1], false);
        acc[4 * k + 2] = __builtin_amdgcn_sdot4((int)t2, (int)w4, acc[4 * k + 2], false);
        acc[4 * k + 3] = __builtin_amdgcn_sdot4((int)t3, (int)w4, acc[4 * k + 3], false);
    }
}
__device__ __forceinline__ void phase_peer_v(const bf16_t* X, const int* EID, const signed char* WQ, const float* SW, const unsigned char* V, float* Y) {
    const int lane = threadIdx.x & 63, wv = threadIdx.x >> 6, es = lane >> 3, cc = lane & 7;
    const bool b5 = lane & 32, b4 = lane & 16, b3 = lane & 8;
    const int nw = gridDim.x * 8, gw = blockIdx.x * 8 + wv, tpw = (MTOK + nw - 1) / nw, tbase = gw * tpw;
    int cnt = MTOK - tbase; cnt = cnt > tpw ? tpw : cnt;
    if (cnt <= 0) return;
    const int nit = 16 * cnt;
    const unsigned char* vb = V + cc * 16;
    const int colo = cc * 16 + (b5 ? 8 : 0) + (b4 ? 4 : 0) + (b3 ? 2 : 0);
    u32x4 m0c, m0d, m1a, m1b, m1c, m1d, m2a, m2b, m2c, m2d; u32x4 w0, w1; unsigned x0, x1; float c0, c1; u32x4 sA[8], sB[8];
#define PV_IDS(k_, A_, B_, C_, D_) { const size_t o_ = (size_t)(tbase + (k_)) * 128 + es * 16; A_ = *(const u32x4*)(EID + o_); B_ = *(const u32x4*)(EID + o_ + 4); C_ = *(const u32x4*)(EID + o_ + 8); D_ = *(const u32x4*)(EID + o_ + 12); }
#define PV_WX(sl_, k_, W_, X_, CS_) { W_ = *(const u32x4*)(WQ + (size_t)(tbase + (k_)) * 128 + es * 16); \
        X_ = *(const unsigned*)(X + (size_t)(tbase + (k_)) * DM + (sl_) * 128 + colo); CS_ = SW[tbase + (k_)]; }
#define PV_NEXT(sl_, k_, sn_, kn_) { kn_ = (k_) + 1; sn_ = (sl_); if (kn_ == cnt) { kn_ = 0; ++sn_; } if (sn_ == 16) { sn_ = 15; kn_ = cnt - 1; } }
    int sl = 0, k = 0, sl1, k1, sl2, k2;
    PV_NEXT(sl, k, sl1, k1) PV_NEXT(sl1, k1, sl2, k2)
    { u32x4 ta, tb; PV_IDS(k, ta, tb, m0c, m0d) PV_IDS(k1, m1a, m1b, m1c, m1d)
      PV_WX(sl, k, w0, x0, c0)
      peer_issue8(sA, vb + sl * 128, ta, tb); }
    for (int it = 0; it < nit; ++it) {
        PV_IDS(k2, m2a, m2b, m2c, m2d)
        peer_issue8(sB, vb + sl * 128, m0c, m0d);
        int ya[16];
#pragma unroll
        for (int j = 0; j < 16; ++j) ya[j] = 0;
        peer_dot4x4(ya, sA[0], sA[1], sA[2], sA[3], w0.x); peer_dot4x4(ya, sA[4], sA[5], sA[6], sA[7], w0.y);
        peer_issue8(sA, vb + sl1 * 128, m1a, m1b);
        PV_WX(sl1, k1, w1, x1, c1)
        peer_dot4x4(ya, sB[0], sB[1], sB[2], sB[3], w0.z); peer_dot4x4(ya, sB[4], sB[5], sB[6], sB[7], w0.w);
        int t8[8], t4[4], t2[2];
#pragma unroll
        for (int q = 0; q < 8; ++q) { const int keep = b5 ? ya[8 + q] : ya[q], send = b5 ? ya[q] : ya[8 + q]; t8[q] = keep + __shfl_xor(send, 32); }
#pragma unroll
        for (int q = 0; q < 4; ++q) { const int keep = b4 ? t8[4 + q] : t8[q], send = b4 ? t8[q] : t8[4 + q]; t4[q] = keep + __shfl_xor(send, 16); }
#pragma unroll
        for (int q = 0; q < 2; ++q) { const int keep = b3 ? t4[2 + q] : t4[q], send = b3 ? t4[q] : t4[2 + q]; t2[q] = keep + __shfl_xor(send, 8); }
        f32x2_t o; o[0] = (float)t2[0] * c0 + ALPHA * bflo(x0); o[1] = (float)t2[1] * c0 + ALPHA * bfhi(x0);
        *(f32x2_t*)(Y + (size_t)(tbase + k) * DM + sl * 128 + colo) = o;
        sl = sl1; k = k1; sl1 = sl2; k1 = k2; PV_NEXT(sl1, k1, sl2, k2)
        m0c = m1c; m0d = m1d; m1a = m2a; m1b = m2b; m1c = m2c; m1d = m2d;
        w0 = w1; x0 = x1; c0 = c1;
    }
#undef PV_IDS
#undef PV_WX
#undef PV_NEXT
}

__device__ __forceinline__ void rot8(const u32x4 lo, const u32x4 hi, const f32x4 c0, const f32x4 c1, const f32x4 s0, const f32x4 s1, float (&o1)[8], float (&o2)[8]) {
    const float a[8] = {bflo(lo.x), bfhi(lo.x), bflo(lo.y), bfhi(lo.y), bflo(lo.z), bfhi(lo.z), bflo(lo.w), bfhi(lo.w)};
    const float b[8] = {bflo(hi.x), bfhi(hi.x), bflo(hi.y), bfhi(hi.y), bflo(hi.z), bfhi(hi.z), bflo(hi.w), bfhi(hi.w)};
    const float c[8] = {c0[0], c0[1], c0[2], c0[3], c1[0], c1[1], c1[2], c1[3]}, sn[8] = {s0[0], s0[1], s0[2], s0[3], s1[0], s1[1], s1[2], s1[3]};
#pragma unroll
    for (int j = 0; j < 8; ++j) { o1[j] = a[j] * c[j] - b[j] * sn[j]; o2[j] = a[j] * sn[j] + b[j] * c[j]; }
}
__device__ __forceinline__ u32x4 pack8(const float (&o)[8]) { u32x4 w; w.x = pk_bf16(o[0], o[1]); w.y = pk_bf16(o[2], o[3]); w.z = pk_bf16(o[4], o[5]); w.w = pk_bf16(o[6], o[7]); return w; }
__device__ __forceinline__ void phase_kstat(LAS float* red, const bf16_t* KR, float* KMEAN, float* KNMAX) {
    const int tid = threadIdx.x, ch = tid & 7, rr = tid >> 3, wv = tid >> 6, lane = tid & 63;
    for (int item = blockIdx.x; item < 2 * NHEAD * 32; item += gridDim.x) {
        const int bh = item >> 5, j = item & 31, b = bh >> 4, h = bh & 15;
        float sm1[8], sm2[8]; float nmax = 0.f;
#pragma unroll
        for (int q = 0; q < 8; ++q) { sm1[q] = 0.f; sm2[q] = 0.f; }
        u32x4 lo[4], hi[4];
#pragma unroll
        for (int ps = 0; ps < 4; ++ps) { const size_t off = ((size_t)b * SEQ + j * 256 + ps * 64 + rr) * DM + h * 128 + ch * 8; lo[ps] = *(const u32x4*)(KR + off); hi[ps] = *(const u32x4*)(KR + off + 64); }
#pragma unroll
        for (int ps = 0; ps < 4; ++ps) {
            const float a[8] = {bflo(lo[ps].x), bfhi(lo[ps].x), bflo(lo[ps].y), bfhi(lo[ps].y), bflo(lo[ps].z), bfhi(lo[ps].z), bflo(lo[ps].w), bfhi(lo[ps].w)};
            const float c[8] = {bflo(hi[ps].x), bfhi(hi[ps].x), bflo(hi[ps].y), bfhi(hi[ps].y), bflo(hi[ps].z), bfhi(hi[ps].z), bflo(hi[ps].w), bfhi(hi[ps].w)};
            float nq = 0.f;
#pragma unroll
            for (int q = 0; q < 8; ++q) { sm1[q] += a[q]; sm2[q] += c[q]; nq += a[q] * a[q] + c[q] * c[q]; }
            nq += __shfl_xor(nq, 1); nq += __shfl_xor(nq, 2); nq += __shfl_xor(nq, 4);
            nmax = fmaxf(nmax, nq);
        }
#pragma unroll
        for (int q = 0; q < 8; ++q) {
            sm1[q] += __shfl_xor(sm1[q], 8); sm1[q] += __shfl_xor(sm1[q], 16); sm1[q] += __shfl_xor(sm1[q], 32);
            sm2[q] += __shfl_xor(sm2[q], 8); sm2[q] += __shfl_xor(sm2[q], 16); sm2[q] += __shfl_xor(sm2[q], 32);
        }
        nmax = wave_max(nmax);
        if (lane < 8) {
#pragma unroll
            for (int q = 0; q < 8; ++q) { red[wv * 128 + lane * 8 + q] = sm1[q]; red[wv * 128 + 64 + lane * 8 + q] = sm2[q]; }
        }
        if (lane == 0) red[1024 + wv] = nmax;
        __syncthreads();
        if (tid < 128) {
            float s2 = 0.f;
#pragma unroll
            for (int r = 0; r < 8; ++r) s2 += red[r * 128 + tid];
            KMEAN[(size_t)item * 128 + tid] = s2 * (1.0f / 256.0f);
        }
        if (tid == 0) {
            float m = 0.f;
#pragma unroll
            for (int r = 0; r < 8; ++r) m = fmaxf(m, red[1024 + r]);
            KNMAX[item] = sqrtf(m);
        }
        __syncthreads();
    }
}

__device__ __forceinline__ void top3_insert(float x, int m, float& v0, int& i0, float& v1, int& i1, float& v2, int& i2) {
    const bool c0 = x > v0 || (x == v0 && m < i0), c1 = x > v1 || (x == v1 && m < i1), c2 = x > v2 || (x == v2 && m < i2);
    v2 = c1 ? v1 : (c2 ? x : v2); i2 = c1 ? i1 : (c2 ? m : i2);
    v1 = c0 ? v0 : (c1 ? x : v1); i1 = c0 ? i0 : (c1 ? m : i1);
    v0 = c0 ? x : v0; i0 = c0 ? m : i0;
}
__device__ __forceinline__ void phase_sel(LAS unsigned char* lds, const bf16_t* QR, const float* KMEAN, unsigned short* SUB, int* CNT, int* ctr) {
    const int tid = threadIdx.x, lane = tid & 63, wv = tid >> 6, r32 = lane & 31, hh = lane >> 5;
    LAS unsigned short* bucket = (LAS unsigned short*)lds;
    LAS int* cnt = (LAS int*)(lds + 16384);
    const float NEG = -1e30f;
    if (blockIdx.x == 0 && tid == 0) *ctr = 0;
    for (int item = blockIdx.x; item < 2 * NHEAD * 32; item += gridDim.x) {
        const int bh = item >> 5, i = item & 31, b = bh >> 4, h = bh & 15;
        if (i == 0) continue;
        if (tid < 32) cnt[tid] = 0;
        __syncthreads();
        const float* kmp = KMEAN + ((size_t)bh * 32 + r32) * 128 + 8 * hh;
        const size_t tok = (size_t)b * SEQ + i * 256 + wv * 32 + r32;
        const bf16_t* qp = QR + tok * DM + h * 128 + 8 * hh;
        f32x16 S;
#pragma unroll
        for (int e = 0; e < 16; ++e) S[e] = 0.f;
#pragma unroll
        for (int s2 = 0; s2 < 8; ++s2) {
            const f32x4 ka = *(const f32x4*)(kmp + 16 * s2), kb = *(const f32x4*)(kmp + 16 * s2 + 4);
            const bf16x8 qf = *(const bf16x8*)(qp + 16 * s2);
            u32x4 hi, lo;
            hi.x = pk_bf16(ka[0], ka[1]); hi.y = pk_bf16(ka[2], ka[3]); hi.z = pk_bf16(kb[0], kb[1]); hi.w = pk_bf16(kb[2], kb[3]);
            lo.x = pk_bf16(ka[0] - bflo(hi.x), ka[1] - bfhi(hi.x)); lo.y = pk_bf16(ka[2] - bflo(hi.y), ka[3] - bfhi(hi.y));
            lo.z = pk_bf16(kb[0] - bflo(hi.z), kb[1] - bfhi(hi.z)); lo.w = pk_bf16(kb[2] - bflo(hi.w), kb[3] - bfhi(hi.w));
            S = __builtin_amdgcn_mfma_f32_32x32x16_bf16(__builtin_bit_cast(bf16x8, hi), qf, S, 0, 0, 0);
            S = __builtin_amdgcn_mfma_f32_32x32x16_bf16(__builtin_bit_cast(bf16x8, lo), qf, S, 0, 0, 0);
        }
        float v0 = -3e38f, v1 = -3e38f, v2 = -3e38f; int i0 = 99, i1 = 99, i2 = 99;
#pragma unroll
        for (int e = 0; e < 16; ++e) {
            const int m = (e & 3) + 8 * (e >> 2) + 4 * hh;
            const float x = m < i ? S[e] : NEG;
            top3_insert(x, m, v0, i0, v1, i1, v2, i2);
        }
        {
            const float pv0 = __shfl_xor(v0, 32), pv1 = __shfl_xor(v1, 32), pv2 = __shfl_xor(v2, 32);
            const int pi0 = __shfl_xor(i0, 32), pi1 = __shfl_xor(i1, 32), pi2 = __shfl_xor(i2, 32);
            top3_insert(pv0, pi0, v0, i0, v1, i1, v2, i2); top3_insert(pv1, pi1, v0, i0, v1, i1, v2, i2); top3_insert(pv2, pi2, v0, i0, v1, i1, v2, i2);
        }
        if (hh == 0) {
            const int tl = wv * 32 + r32;
            if (v0 > 0.5f * NEG) { const int p = __hip_atomic_fetch_add(cnt + i0, 1, __ATOMIC_RELAXED, __HIP_MEMORY_SCOPE_WORKGROUP); bucket[i0 * 256 + p] = (unsigned short)(tl | (0 << 8)); }
            if (v1 > 0.5f * NEG) { const int p = __hip_atomic_fetch_add(cnt + i1, 1, __ATOMIC_RELAXED, __HIP_MEMORY_SCOPE_WORKGROUP); bucket[i1 * 256 + p] = (unsigned short)(tl | (1 << 8)); }
            if (v2 > 0.5f * NEG) { const int p = __hip_atomic_fetch_add(cnt + i2, 1, __ATOMIC_RELAXED, __HIP_MEMORY_SCOPE_WORKGROUP); bucket[i2 * 256 + p] = (unsigned short)(tl | (2 << 8)); }
        }
        __syncthreads();
        for (int idx = tid; idx < 32 * 256; idx += 512) {
            const int j = idx >> 8, p = idx & 255;
            if (j < i && p < cnt[j]) SUB[(((size_t)bh * 32 + j) * 32 + i) * 256 + p] = bucket[idx];
        }
        if (tid < i) CNT[((size_t)bh * 32 + tid) * 32 + i] = cnt[tid];
        __syncthreads();
    }
}

__device__ __forceinline__ unsigned off_b(unsigned row, unsigned ch) { return 256u * row + 16u * (ch ^ (((row & 3u) << 2) | ((row >> 2) & 3u))); }
__device__ __forceinline__ unsigned pi32(unsigned m) { return (m & ~12u) | ((m & 4u) << 1) | ((m & 8u) >> 1); }
__device__ __forceinline__ bf16x8 tr_frag(LAS unsigned char* img, unsigned lane, unsigned c, unsigned ks) {
    const unsigned hh = lane >> 5, blk = (lane >> 4) & 1, q = (lane & 15) >> 2, p = lane & 3;
    const unsigned a0 = off_b(16 * ks + 8 * hh + q, 4 * c + 2 * blk + (p >> 1)) + 8 * (p & 1);
    const unsigned a1 = off_b(16 * ks + 8 * hh + 4 + q, 4 * c + 2 * blk + (p >> 1)) + 8 * (p & 1);
    const s16x4 lo = __builtin_amdgcn_ds_read_tr16_b64_v4i16((LAS s16x4*)(img + a0));
    const s16x4 hi = __builtin_amdgcn_ds_read_tr16_b64_v4i16((LAS s16x4*)(img + a1));
    bf16x8 r; r[0] = lo[0]; r[1] = lo[1]; r[2] = lo[2]; r[3] = lo[3]; r[4] = hi[0]; r[5] = hi[1]; r[6] = hi[2]; r[7] = hi[3];
    return r;
}
__device__ __forceinline__ void phase_att(LAS unsigned char* lds, const bf16_t* QR, const bf16_t* KR, const bf16_t* V, const float* KNMAX, const unsigned short* SUB, const int* CNT, int* ctr,
                                          bf16_t* P012, bf16_t* P3, float* LS) {
    const int tid = threadIdx.x, lane = tid & 63, wv = tid >> 6, r32 = lane & 31, hh = lane >> 5;
    LAS unsigned char* Kimg = lds;
    LAS unsigned char* Vimg = lds + 65536;
    LAS int* misc = (LAS int*)(lds + 131072);
    const float SCL2 = 0.08838834764831845f * 1.4426950408889634f;
    for (;;) {
        __syncthreads();
        if (tid == 0) misc[40] = __hip_atomic_fetch_add(ctr, 1, __ATOMIC_RELAXED, __HIP_MEMORY_SCOPE_AGENT);
        __syncthreads();
        const int item = misc[40];
        if (item >= 2 * NHEAD * 32) break;
        const int j = item >> 5, bh = item & 31, b = bh >> 4, h = bh & 15;
#pragma unroll
        for (int r = 0; r < 8; ++r) {
            const int idx = tid + 512 * r, row = idx >> 4, ch = idx & 15;
            const size_t g = ((size_t)b * SEQ + j * 256 + row) * DM + h * 128 + ch * 8;
            const u32x4 kv = *(const u32x4*)(KR + g), vv = *(const u32x4*)(V + g);
            *(LAS u32x4*)(Kimg + off_b(row, ch)) = kv; *(LAS u32x4*)(Vimg + off_b(row, ch)) = vv;
        }
        if (tid <= 32) { int pre = 0; for (int u = j + 1; u < tid; ++u) pre += CNT[((size_t)bh * 32 + j) * 32 + u]; misc[tid] = pre; }
        float kn = (lane < 32) ? KNMAX[bh * 32 + lane] : 0.f;
        kn = wave_max(kn);
        __syncthreads();
        const int total = misc[32], ntile = (256 + total + 31) >> 5;
        for (int tile = wv; tile < ntile; tile += 8) {
            const int gr = tile * 32 + r32;
            int pos, slot; bool valid = true;
            if (gr < 256) { pos = j * 256 + gr; slot = 3; }
            else {
                const int x = gr - 256; valid = x < total;
                int ii = j + 1;
                for (int u = j + 1; u < 32; ++u) if (misc[u] <= x) ii = u;
                if (valid) { const unsigned e = SUB[(((size_t)bh * 32 + j) * 32 + ii) * 256 + (x - misc[ii])]; pos = ii * 256 + (int)(e & 255u); slot = (int)(e >> 8); }
                else { pos = j * 256; slot = 3; }
            }
            const size_t tok = (size_t)b * SEQ + pos;
            bf16x8 qf[8];
            const bf16_t* qp = QR + tok * DM + h * 128 + 8 * hh;
#pragma unroll
            for (int s = 0; s < 8; ++s) qf[s] = *(const bf16x8*)(qp + 16 * s);
            float qn2 = 0.f;
#pragma unroll
            for (int s = 0; s < 8; ++s)
#pragma unroll
                for (int e = 0; e < 8; ++e) { const float f = bf2f((bf16_t)qf[s][e]); qn2 += f * f; }
            qn2 += __shfl_xor(qn2, 32);
            const float c2 = sqrtf(qn2) * kn * SCL2;
            f32x16 O[4];
#pragma unroll
            for (int dt = 0; dt < 4; ++dt)
#pragma unroll
                for (int e = 0; e < 16; ++e) O[dt][e] = 0.f;
            float l = 0.f;
            const bool own = tile < 8;
            const int kcn = own ? tile + 1 : 8;
            const unsigned krow = pi32((unsigned)r32);
            for (int kc = 0; kc < kcn; ++kc) {
                f32x16 S, S1;
#pragma unroll
                for (int e = 0; e < 16; ++e) { S[e] = 0.f; S1[e] = 0.f; }
#pragma unroll
                for (int s = 0; s < 8; s += 2) {
                    const bf16x8 kf = *(const LAS bf16x8*)(Kimg + off_b(32 * kc + krow, 2 * s + hh));
                    const bf16x8 kf1 = *(const LAS bf16x8*)(Kimg + off_b(32 * kc + krow, 2 * s + 2 + hh));
                    S = __builtin_amdgcn_mfma_f32_32x32x16_bf16(kf, qf[s], S, 0, 0, 0);
                    S1 = __builtin_amdgcn_mfma_f32_32x32x16_bf16(kf1, qf[s + 1], S1, 0, 0, 0);
                }
                float p[16];
                if (own) {
#pragma unroll
                    for (int e = 0; e < 16; ++e) {
                        const unsigned m = (e & 3) + 8 * (e >> 2) + 4 * hh;
                        const int key = j * 256 + 32 * kc + (int)pi32(m);
                        float pe = __builtin_amdgcn_exp2f((S[e] + S1[e]) * SCL2 - c2);
                        if (key > pos) pe = 0.f;
                        p[e] = pe; l += pe;
                    }
                } else {
#pragma unroll
                    for (int e = 0; e < 16; ++e) { const float pe = __builtin_amdgcn_exp2f((S[e] + S1[e]) * SCL2 - c2); p[e] = pe; l += pe; }
                }
                u32x4 w0, w1;
                w0.x = pk_bf16(p[0], p[1]); w0.y = pk_bf16(p[2], p[3]); w0.z = pk_bf16(p[4], p[5]); w0.w = pk_bf16(p[6], p[7]);
                w1.x = pk_bf16(p[8], p[9]); w1.y = pk_bf16(p[10], p[11]); w1.z = pk_bf16(p[12], p[13]); w1.w = pk_bf16(p[14], p[15]);
                const bf16x8 pf0 = __builtin_bit_cast(bf16x8, w0), pf1 = __builtin_bit_cast(bf16x8, w1);
#pragma unroll
                for (int dt = 0; dt < 4; ++dt) {
                    const bf16x8 v0 = tr_frag(Vimg, lane, dt, 2 * kc), v1 = tr_frag(Vimg, lane, dt, 2 * kc + 1);
                    O[dt] = __builtin_amdgcn_mfma_f32_32x32x16_bf16(v0, pf0, O[dt], 0, 0, 0);
                    O[dt] = __builtin_amdgcn_mfma_f32_32x32x16_bf16(v1, pf1, O[dt], 0, 0, 0);
                }
            }
            l += __shfl_xor(l, 32);
            if (valid) {
                bf16_t* pl = (slot < 3 ? P012 + (size_t)slot * ((size_t)32 << 20) : P3) + (tok * NHEAD + h) * 128 + 4 * hh;
#pragma unroll
                for (int dt = 0; dt < 4; ++dt)
#pragma unroll
                    for (int g = 0; g < 4; ++g) {
                        u32x2 w; w.x = pk_bf16(O[dt][4 * g], O[dt][4 * g + 1]); w.y = pk_bf16(O[dt][4 * g + 2], O[dt][4 * g + 3]);
                        *(u32x2*)(pl + 32 * dt + 8 * g) = w;
                    }
                if (hh == 0) LS[(size_t)slot * MTOK * NHEAD + tok * NHEAD + h] = l;
            }
        }
    }
}
__device__ __forceinline__ void phase_comb(LAS float* red, const bf16_t* P012, const bf16_t* P3, const float* LS, signed char* AO8, float* XSO) {
    const int tid = threadIdx.x, tsel = tid >> 8, hd = (tid & 255) >> 4, ch = tid & 15, wv = tid >> 6;
    u32x4 nw[4]; float nl[4];
#define CB_LOAD(pair_) { const size_t th_ = ((size_t)(2 * (pair_) + tsel)) * NHEAD + hd; nw[3] = *(const u32x4*)(P3 + th_ * 128 + ch * 8); nl[3] = LS[(size_t)3 * MTOK * NHEAD + th_]; \
        _Pragma("unroll") for (int s_ = 0; s_ < 3; ++s_) { nw[s_] = *(const u32x4*)(P012 + (size_t)s_ * ((size_t)32 << 20) + th_ * 128 + ch * 8); nl[s_] = LS[(size_t)s_ * MTOK * NHEAD + th_]; } }
    if ((int)blockIdx.x < MTOK / 2) CB_LOAD((int)blockIdx.x)
    int par = 0;
    for (int pair = blockIdx.x; pair < MTOK / 2; pair += gridDim.x, par ^= 1) {
        const int token = 2 * pair + tsel;
        const int t = token & (SEQ - 1), blk = t >> 8, nsel = blk < 3 ? blk : 3;
        float acc[8];
        float l = nl[3];
        { const u32x4 w = nw[3];
          acc[0] = bflo(w.x); acc[1] = bfhi(w.x); acc[2] = bflo(w.y); acc[3] = bfhi(w.y); acc[4] = bflo(w.z); acc[5] = bfhi(w.z); acc[6] = bflo(w.w); acc[7] = bfhi(w.w); }
#pragma unroll
        for (int s = 0; s < 3; ++s) {
            u32x4 w = nw[s]; float ls = nl[s];
            if (s >= nsel) { w = (u32x4){0u, 0u, 0u, 0u}; ls = 0.f; }
            acc[0] += bflo(w.x); acc[1] += bfhi(w.x); acc[2] += bflo(w.y); acc[3] += bfhi(w.y); acc[4] += bflo(w.z); acc[5] += bfhi(w.z); acc[6] += bflo(w.w); acc[7] += bfhi(w.w);
            l += ls;
        }
        if (pair + (int)gridDim.x < MTOK / 2) CB_LOAD(pair + (int)gridDim.x)
        const float rl = 1.0f / l;
        float am = 0.f;
#pragma unroll
        for (int j = 0; j < 8; ++j) { acc[j] *= rl; am = fmaxf(am, fabsf(acc[j])); }
        am = wave_max(am);
        if ((tid & 63) == 0) red[par * 8 + wv] = am;
        __syncthreads();
        am = fmaxf(fmaxf(fmaxf(red[par * 8 + 4 * tsel], red[par * 8 + 4 * tsel + 1]), fmaxf(red[par * 8 + 4 * tsel + 2], red[par * 8 + 4 * tsel + 3])), 1e-30f);
        const float inv = 127.0f / am;
        if ((tid & 255) == 0) XSO[token] = am * (1.0f / 127.0f);
        u32x2 o;
        o.x = ((unsigned)(int)rintf(acc[0] * inv) & 0xffu) | (((unsigned)(int)rintf(acc[1] * inv) & 0xffu) << 8) | (((unsigned)(int)rintf(acc[2] * inv) & 0xffu) << 16) | (((unsigned)(int)rintf(acc[3] * inv) & 0xffu) << 24);
        o.y = ((unsigned)(int)rintf(acc[4] * inv) & 0xffu) | (((unsigned)(int)rintf(acc[5] * inv) & 0xffu) << 8) | (((unsigned)(int)rintf(acc[6] * inv) & 0xffu) << 16) | (((unsigned)(int)rintf(acc[7] * inv) & 0xffu) << 24);
        *(u32x2*)(AO8 + (size_t)token * DM + hd * 128 + ch * 8) = o;
    }
#undef CB_LOAD
}


__device__ __forceinline__ void qrow_issue(f32x4 (&v)[8], const float* p, int lane) {
#pragma unroll
    for (int i = 0; i < 2; ++i)
#pragma unroll
        for (int q = 0; q < 4; ++q) v[i * 4 + q] = *(const f32x4*)(p + 1024 * i + 16 * lane + 4 * q);
}
__device__ __forceinline__ void qrow_finish(const f32x4 (&v)[8], unsigned char* dst, float* scl, int lane, bool sgn = false) {
    float am = 0.f;
#pragma unroll
    for (int i = 0; i < 8; ++i) am = fmaxf(am, fmaxf(fmaxf(fabsf(v[i][0]), fabsf(v[i][1])), fmaxf(fabsf(v[i][2]), fabsf(v[i][3]))));
    am = fmaxf(wave_max(am), 1e-30f);
    const float inv = 127.0f / am;
    if (lane == 0) *scl = am * (1.0f / 127.0f);
#pragma unroll
    for (int i = 0; i < 2; ++i) {
        u32x4 w;
#pragma unroll
        for (int q = 0; q < 4; ++q) {
            const f32x4 t = v[i * 4 + q];
            const float off = sgn ? 0.0f : 128.0f;
            const unsigned b0 = (unsigned)(int)(rintf(t[0] * inv) + off) & 0xffu, b1 = (unsigned)(int)(rintf(t[1] * inv) + off) & 0xffu, b2 = (unsigned)(int)(rintf(t[2] * inv) + off) & 0xffu, b3 = (unsigned)(int)(rintf(t[3] * inv) + off) & 0xffu;
            w[q] = b0 | (b1 << 8) | (b2 << 16) | (b3 << 24);
        }
        *(u32x4*)(dst + 1024 * i + 16 * lane) = w;
    }
}
struct QuantJob { const float* TU; const float* TV; unsigned char* QU; unsigned char* QV; float* SU; float* SV; };
__device__ __forceinline__ const float* qj_src(const QuantJob& q, int r) { return (r < 16384 ? q.TU : q.TV) + (size_t)(r & 16383) * DM; }
__device__ __forceinline__ unsigned char* qj_dst(const QuantJob& q, int r) { return (r < 16384 ? q.QU : q.QV) + (size_t)(r & 16383) * DM; }
__device__ __forceinline__ float* qj_scl(const QuantJob& q, int r) { return (r < 16384 ? q.SU : q.SV) + (r & 16383); }
__device__ __forceinline__ void qj_tail(const QuantJob& q, int done_iters) {
    const int lane = threadIdx.x & 63, gw = blockIdx.x * 8 + (threadIdx.x >> 6), nw = gridDim.x * 8;
    for (int r = gw + done_iters * nw; r < 32768; r += nw) { f32x4 v[8]; qrow_issue(v, qj_src(q, r), lane); qrow_finish(v, qj_dst(q, r), qj_scl(q, r), lane, r >= 16384); }
}
__device__ __forceinline__ float logf_gate(float z, float lb) { return __logf(lb + (1.0f - lb) * sigmoidf_(z)); }
__device__ __forceinline__ void phase_scan_a(LAS unsigned char* lds, const bf16_t* FZ, const float* LB, const bf16_t* I1, bf16_t* LT, float* DEC, const QuantJob qj, unsigned* dbgc = nullptr) {
    unsigned dbg_kt = 0, dbg_acc = 0;
    const int tid = threadIdx.x, lane = tid & 63, wv = tid >> 6, k = tid & 127, part = tid >> 7;
    LAS unsigned char* Iimg = lds; LAS unsigned char* KTimg = lds + 16384;
    LAS float* psum = (LAS float*)(lds + 32768);
    LAS unsigned char* Lst = lds + 36864;
#if SCAN_A_VALU == 2
    for (int item = blockIdx.x; item < 2 * NHEAD * 128; item += gridDim.x) {
        const int bh = item >> 7, c = item & 127, b = bh >> 4, h = bh & 15;
        const size_t tok0 = (size_t)b * SEQ + c * 64;
        for (int idx = tid; idx < 16384; idx += 512) {
            const int v = idx >> 7, kk = idx & 127;
            float g = 1.f, L = 0.f;
            for (int s2 = 63; s2 >= 0; --s2) { const size_t o = (tok0 + s2) * DM + h * 128; const float f = __expf(logf_gate(bf2f(FZ[o + kk]), LB[h * 128 + kk])); L += bf2f(I1[o + v]) * (1.0f - f) * g; g *= f; }
            LT[(size_t)item * 16384 + idx] = (bf16_t)(pk_bf16(L, 0.f) & 0xffffu);
        }
    }
    return;
#endif
    bf16_t nfz[16]; u32x4 nit_[2];
#define SA_LOAD(item_) { const int bh_ = (item_) >> 7, c_ = (item_) & 127; const size_t t0_ = (size_t)(bh_ >> 4) * SEQ + c_ * 64; const int h_ = bh_ & 15; \
        _Pragma("unroll") for (int i = 0; i < 16; ++i) nfz[i] = FZ[(t0_ + 16 * part + i) * DM + h_ * 128 + k]; \
        _Pragma("unroll") for (int r = 0; r < 2; ++r) { const int idx = tid + 512 * r, row = idx >> 4, ch = idx & 15; nit_[r] = *(const u32x4*)(I1 + (t0_ + row) * DM + h_ * 128 + ch * 8); } }
    if ((int)blockIdx.x < 2 * NHEAD * 128) SA_LOAD((int)blockIdx.x)
    int qiter = 0;
    for (int item = blockIdx.x; item < 2 * NHEAD * 128; item += gridDim.x, ++qiter) {
        const int bh = item >> 7, c = item & 127, b = bh >> 4, h = bh & 15;
        const size_t tok0 = (size_t)b * SEQ + c * 64;
        float lf[16];
        const float lbk = LB[h * 128 + k];
        unsigned fz2[8];
#pragma unroll
        for (int i = 0; i < 8; ++i) fz2[i] = (unsigned)nfz[2 * i] | ((unsigned)nfz[2 * i + 1] << 16);
#pragma unroll
        for (int r = 0; r < 2; ++r) { const int idx = tid + 512 * r, row = idx >> 4, ch = idx & 15; *(LAS u32x4*)(Iimg + off_b(row, ch)) = nit_[r]; }
        asm volatile("" ::: "memory");
        if (item + (int)gridDim.x < 2 * NHEAD * 128) SA_LOAD(item + (int)gridDim.x)
        const int qrow = qiter * (int)gridDim.x * 8 + (int)blockIdx.x * 8 + wv; const bool doq = qrow < 32768; f32x4 qv8[8];
        if (doq) qrow_issue(qv8, qj_src(qj, qrow), lane);
        asm volatile("" ::: "memory");
#pragma unroll
        for (int i = 0; i < 8; ++i) { lf[2 * i] = logf_gate(bflo(fz2[i]), lbk); lf[2 * i + 1] = logf_gate(bfhi(fz2[i]), lbk); }
        float cs = 0.f;
#pragma unroll
        for (int i = 0; i < 16; ++i) cs += lf[i];
        psum[part * 128 + k] = cs;
        __syncthreads();
        const float p0 = psum[k], p1 = psum[128 + k], p2 = psum[256 + k], p3 = psum[384 + k];
        const float blast = (p0 + p1) + (p2 + p3);
        float bb = part == 0 ? 0.f : (part == 1 ? p0 : (part == 2 ? p0 + p1 : p0 + p1 + p2));
#pragma unroll
        for (int i = 0; i < 16; ++i) {
            bb += lf[i];
            const float kt = (1.0f - __expf(lf[i])) * __expf(blast - bb);
            if (!(kt - kt == 0.f)) ++dbg_kt;
            const int srow = 16 * part + i;
            *(LAS bf16_t*)(KTimg + off_b(srow, k >> 3) + 2 * (k & 7)) = (bf16_t)(pk_bf16(kt, 0.f) & 0xffffu);
        }
        if (part == 0) DEC[(size_t)item * 128 + k] = __expf(blast);
        __syncthreads();
#if SCAN_A_VALU
        for (int idx = tid; idx < 16384; idx += 512) {
            const int v = idx >> 7, kk = idx & 127;
            float accv = 0.f;
            for (int s2 = 0; s2 < 64; ++s2) accv += bf2f(*(const LAS bf16_t*)(Iimg + off_b(s2, v >> 3) + 2 * (v & 7))) * bf2f(*(const LAS bf16_t*)(KTimg + off_b(s2, kk >> 3) + 2 * (kk & 7)));
            *(LAS bf16_t*)(Lst + v * 272 + 2 * kk) = (bf16_t)(pk_bf16(accv, 0.f) & 0xffffu);
        }
        if (0)
#endif
        {
            const int vt = wv >> 1;
            f32x16 acc0, acc1;
#pragma unroll
            for (int e = 0; e < 16; ++e) { acc0[e] = 0.f; acc1[e] = 0.f; }
#pragma unroll
            for (int ks = 0; ks < 4; ++ks) {
                const bf16x8 af = tr_frag(Iimg, lane, vt, ks);
                const bf16x8 b0 = tr_frag(KTimg, lane, 2 * (wv & 1), ks), b1 = tr_frag(KTimg, lane, 2 * (wv & 1) + 1, ks);
                acc0 = __builtin_amdgcn_mfma_f32_32x32x16_bf16(af, b0, acc0, 0, 0, 0);
                acc1 = __builtin_amdgcn_mfma_f32_32x32x16_bf16(af, b1, acc1, 0, 0, 0);
            }
            const int r32 = lane & 31, hh = lane >> 5;
#pragma unroll
            for (int e = 0; e < 16; ++e) {
                if (!(acc0[e] - acc0[e] == 0.f)) ++dbg_acc; if (!(acc1[e] - acc1[e] == 0.f)) ++dbg_acc;
                const int v = 32 * vt + (e & 3) + 8 * (e >> 2) + 4 * hh;
                *(LAS bf16_t*)(Lst + v * 272 + 2 * (64 * (wv & 1) + r32)) = (bf16_t)(pk_bf16(acc0[e], 0.f) & 0xffffu);
                *(LAS bf16_t*)(Lst + v * 272 + 2 * (64 * (wv & 1) + 32 + r32)) = (bf16_t)(pk_bf16(acc1[e], 0.f) & 0xffffu);
            }
        }
        __syncthreads();
#pragma unroll
        for (int r = 0; r < 4; ++r) { const int idx = tid + 512 * r, row = idx >> 4, ch = idx & 15; *(u32x4*)(LT + (size_t)item * 16384 + row * 128 + ch * 8) = *(const LAS u32x4*)(Lst + row * 272 + ch * 16); }
        if (doq) qrow_finish(qv8, qj_dst(qj, qrow), qj_scl(qj, qrow), lane, qrow >= 16384);
        __syncthreads();
    }
    qj_tail(qj, qiter);
    if (dbgc) { if (dbg_kt) atomicAdd(dbgc + 0, dbg_kt); if (dbg_acc) atomicAdd(dbgc + 1, dbg_acc); }
}
__device__ __forceinline__ void phase_scan_b(bf16_t* LT, const float* DEC, const QuantJob qj) {
    const int n = 2 * NHEAD * 128 * 32;
    const int lane = threadIdx.x & 63, gw = blockIdx.x * 8 + (threadIdx.x >> 6), nw = gridDim.x * 8;
    int qdone = 0;
    for (int idx = blockIdx.x * 512 + threadIdx.x; idx < n; idx += gridDim.x * 512) {
        const int bh = idx >> 12, vk = idx & 4095, k4 = (vk & 31) * 4;
        float S0 = 0.f, S1 = 0.f, S2 = 0.f, S3 = 0.f;
        bf16_t* p = LT + (size_t)bh * 128 * 16384 + (size_t)vk * 4;
        const float* dp = DEC + (size_t)bh * 128 * 128 + k4;
        for (int c8 = 0; c8 < 16; ++c8) {
            const int qrow = (qdone + c8) * nw + gw; const bool doq = qrow < 32768; f32x4 qv8[8];
            if (doq) qrow_issue(qv8, qj_src(qj, qrow), lane);
#pragma unroll
            for (int c2 = 0; c2 < 8; ++c2) {
                const int c = c8 * 8 + c2;
                const u32x2 w = *(const u32x2*)(p + (size_t)c * 16384);
                const f32x4 d = *(const f32x4*)(dp + c * 128);
                u32x2 o; o.x = pk_bf16(S0, S1); o.y = pk_bf16(S2, S3);
                *(u32x2*)(p + (size_t)c * 16384) = o;
                S0 = d[0] * S0 + bflo(w.x); S1 = d[1] * S1 + bfhi(w.x); S2 = d[2] * S2 + bflo(w.y); S3 = d[3] * S3 + bfhi(w.y);
            }
            if (doq) qrow_finish(qv8, qj_dst(qj, qrow), qj_scl(qj, qrow), lane, qrow >= 16384);
        }
        qdone += 16;
    }
    qj_tail(qj, qdone);
}
__device__ __forceinline__ void phase_scan_c(LAS unsigned char* lds, const bf16_t* Q1, const bf16_t* FZ, const float* LB, const bf16_t* I1, const bf16_t* G1, const bf16_t* SP, const float* gnorm, bf16_t* OG) {
    const int tid = threadIdx.x, lane = tid & 63, wv = tid >> 6, k = tid & 127, part = tid >> 7, r32 = lane & 31, hh = lane >> 5;
    LAS unsigned char* QTimg = lds; LAS unsigned char* QPimg = lds + 16384; LAS unsigned char* KPimg = lds + 32768; LAS unsigned char* Iimg = lds + 49152; LAS unsigned char* SPimg = lds + 65536;
    LAS float* psum = (LAS float*)(lds + 98304);
    LAS float* ssq = (LAS float*)(lds + 100352);
    LAS unsigned char* OT = lds + 102400;
    bf16_t nfz[16], nq[16]; u32x4 nit_[2], nsp[4], ngt[2];
#define SC_LOAD(item_) { const int bh_ = (item_) >> 7, c_ = (item_) & 127; const size_t t0_ = (size_t)(bh_ >> 4) * SEQ + c_ * 64; const int h_ = bh_ & 15; \
        _Pragma("unroll") for (int i = 0; i < 16; ++i) { const size_t o_ = (t0_ + 16 * part + i) * DM + h_ * 128 + k; nfz[i] = FZ[o_]; nq[i] = Q1[o_]; } \
        _Pragma("unroll") for (int r = 0; r < 2; ++r) { const int idx = tid + 512 * r, row = idx >> 4, ch = idx & 15; nit_[r] = *(const u32x4*)(I1 + (t0_ + row) * DM + h_ * 128 + ch * 8); ngt[r] = *(const u32x4*)(G1 + (t0_ + row) * DM + h_ * 128 + ch * 8); } \
        _Pragma("unroll") for (int r = 0; r < 4; ++r) { const int idx = tid + 512 * r, row = idx >> 4, ch = idx & 15; nsp[r] = *(const u32x4*)(SP + (size_t)(item_) * 16384 + row * 128 + ch * 8); } }
    if ((int)blockIdx.x < 2 * NHEAD * 128) SC_LOAD((int)blockIdx.x)
    for (int item = blockIdx.x; item < 2 * NHEAD * 128; item += gridDim.x) {
        const int bh = item >> 7, c = item & 127, b = bh >> 4, h = bh & 15;
        const size_t tok0 = (size_t)b * SEQ + c * 64;
        float lf[16], qv[16];
        const float lbk = LB[h * 128 + k];
        unsigned fzq[16];
#pragma unroll
        for (int i = 0; i < 16; ++i) fzq[i] = (unsigned)nfz[i] | ((unsigned)nq[i] << 16);
#pragma unroll
        for (int r = 0; r < 2; ++r) { const int idx = tid + 512 * r, row = idx >> 4, ch = idx & 15; *(LAS u32x4*)(Iimg + off_b(row, ch)) = nit_[r]; }
#pragma unroll
        for (int r = 0; r < 4; ++r) { const int idx = tid + 512 * r, row = idx >> 4, ch = idx & 15; *(LAS u32x4*)(SPimg + off_b(row, ch)) = nsp[r]; }
        const u32x4 gcur0 = ngt[0], gcur1 = ngt[1];
        asm volatile("" ::: "memory");
        if (item + (int)gridDim.x < 2 * NHEAD * 128) SC_LOAD(item + (int)gridDim.x)
        asm volatile("" ::: "memory");
#pragma unroll
        for (int i = 0; i < 16; ++i) { lf[i] = logf_gate(bflo(fzq[i]), lbk); const float qr = bfhi(fzq[i]); qv[i] = qr * sigmoidf_(qr); }
        float cs = 0.f;
#pragma unroll
        for (int i = 0; i < 16; ++i) cs += lf[i];
        psum[part * 128 + k] = cs;
        __syncthreads();
        const float p0 = psum[k], p1 = psum[128 + k], p2 = psum[256 + k];
        const float rr = p0 + p1;
        float bb = part == 0 ? 0.f : (part == 1 ? p0 : (part == 2 ? p0 + p1 : p0 + p1 + p2));
#pragma unroll
        for (int i = 0; i < 16; ++i) {
            bb += lf[i];
            const float qt = qv[i] * __expf(bb), qp = qv[i] * __expf(bb - rr), kp = (1.0f - __expf(lf[i])) * __expf(rr - bb);
            const unsigned o = off_b(16 * part + i, k >> 3) + 2 * (k & 7);
            *(LAS bf16_t*)(QTimg + o) = (bf16_t)(pk_bf16(qt, 0.f) & 0xffffu);
            *(LAS bf16_t*)(QPimg + o) = (bf16_t)(pk_bf16(qp, 0.f) & 0xffffu);
            *(LAS bf16_t*)(KPimg + o) = (bf16_t)(pk_bf16(kp, 0.f) & 0xffffu);
        }
        __syncthreads();
        const int tt = wv & 1, vt = wv >> 1;
        f32x16 O;
#pragma unroll
        for (int e = 0; e < 16; ++e) O[e] = 0.f;
#pragma unroll
        for (int ks = 0; ks < 8; ++ks) {
            const bf16x8 af = *(const LAS bf16x8*)(SPimg + off_b(32 * vt + r32, 2 * ks + hh));
            const bf16x8 bf = *(const LAS bf16x8*)(QTimg + off_b(32 * tt + r32, 2 * ks + hh));
            O = __builtin_amdgcn_mfma_f32_32x32x16_bf16(af, bf, O, 0, 0, 0);
        }
        const unsigned krow = pi32((unsigned)r32);
        for (int st = 0; st <= tt; ++st) {
            f32x16 S;
#pragma unroll
            for (int e = 0; e < 16; ++e) S[e] = 0.f;
#pragma unroll
            for (int ks = 0; ks < 8; ++ks) {
                const bf16x8 af = *(const LAS bf16x8*)(KPimg + off_b(32 * st + krow, 2 * ks + hh));
                const bf16x8 bf = *(const LAS bf16x8*)(QPimg + off_b(32 * tt + r32, 2 * ks + hh));
                S = __builtin_amdgcn_mfma_f32_32x32x16_bf16(af, bf, S, 0, 0, 0);
            }
            float p[16];
#pragma unroll
            for (int e = 0; e < 16; ++e) {
                const unsigned m = (e & 3) + 8 * (e >> 2) + 4 * hh;
                const int sidx = 32 * st + (int)pi32(m), tidx = 32 * tt + r32;
                p[e] = sidx <= tidx ? S[e] : 0.f;
            }
            u32x4 w0, w1;
            w0.x = pk_bf16(p[0], p[1]); w0.y = pk_bf16(p[2], p[3]); w0.z = pk_bf16(p[4], p[5]); w0.w = pk_bf16(p[6], p[7]);
            w1.x = pk_bf16(p[8], p[9]); w1.y = pk_bf16(p[10], p[11]); w1.z = pk_bf16(p[12], p[13]); w1.w = pk_bf16(p[14], p[15]);
            const bf16x8 pf0 = __builtin_bit_cast(bf16x8, w0), pf1 = __builtin_bit_cast(bf16x8, w1);
            const bf16x8 i0 = tr_frag(Iimg, lane, vt, 2 * st), i1 = tr_frag(Iimg, lane, vt, 2 * st + 1);
            O = __builtin_amdgcn_mfma_f32_32x32x16_bf16(i0, pf0, O, 0, 0, 0);
            O = __builtin_amdgcn_mfma_f32_32x32x16_bf16(i1, pf1, O, 0, 0, 0);
        }
        float sq = 0.f;
#pragma unroll
        for (int e = 0; e < 16; ++e) sq += O[e] * O[e];
        sq += __shfl_xor(sq, 32);
        if (hh == 0) ssq[vt * 64 + 32 * tt + r32] = sq;
        __syncthreads();
        const int tl = 32 * tt + r32;
        const float rstd = rsqrtf((ssq[tl] + ssq[64 + tl] + ssq[128 + tl] + ssq[192 + tl]) * (1.0f / 128.0f) + 1e-6f);
#pragma unroll
        for (int g = 0; g < 4; ++g) {
            const int v0 = 32 * vt + 8 * g + 4 * hh;
            const f32x4 gn = *(const f32x4*)(gnorm + v0);
            u32x2 w; w.x = pk_bf16(O[4 * g] * rstd * gn[0], O[4 * g + 1] * rstd * gn[1]); w.y = pk_bf16(O[4 * g + 2] * rstd * gn[2], O[4 * g + 3] * rstd * gn[3]);
            *(LAS u32x2*)(OT + tl * 272 + v0 * 2) = w;
        }
        __syncthreads();
#pragma unroll
        for (int r = 0; r < 2; ++r) {
            const int idx = tid + 512 * r, row = idx >> 4, ch = idx & 15;
            const u32x4 ov = *(const LAS u32x4*)(OT + row * 272 + ch * 16);
            const size_t go = (tok0 + row) * DM + h * 128 + ch * 8;
            const u32x4 gv = r == 0 ? gcur0 : gcur1;
            u32x4 w;
#define SILU_(x_) ((x_) * sigmoidf_(x_))
            w.x = pk_bf16(bflo(ov.x) * SILU_(bflo(gv.x)), bfhi(ov.x) * SILU_(bfhi(gv.x))); w.y = pk_bf16(bflo(ov.y) * SILU_(bflo(gv.y)), bfhi(ov.y) * SILU_(bfhi(gv.y)));
            w.z = pk_bf16(bflo(ov.z) * SILU_(bflo(gv.z)), bfhi(ov.z) * SILU_(bfhi(gv.z))); w.w = pk_bf16(bflo(ov.w) * SILU_(bflo(gv.w)), bfhi(ov.w) * SILU_(bfhi(gv.w)));
#undef SILU_
            *(u32x4*)(OG + go) = w;
        }
        __syncthreads();
    }
}


#if SCAN_DBG == 2
__device__ __forceinline__ void dbg_compare(LAS float* red, const bf16_t* A, const bf16_t* B, float* DBG) {
    float sd = 0.f, sr = 0.f, nn = 0.f;
    const size_t n = (size_t)MTOK * DM;
    for (size_t i = (size_t)blockIdx.x * 512 + threadIdx.x; i < n; i += (size_t)gridDim.x * 512) {
        const float x = bf2f(A[i]), y = bf2f(B[i]);
        if (!(x - x == 0.f)) nn += 1.f; else { sd += (x - y) * (x - y); sr += y * y; }
    }
    sd = wave_sum(sd); sr = wave_sum(sr); nn = wave_sum(nn);
    const int wv = threadIdx.x >> 6;
    if ((threadIdx.x & 63) == 0) { red[wv * 3] = sd; red[wv * 3 + 1] = sr; red[wv * 3 + 2] = nn; }
    __syncthreads();
    if (threadIdx.x == 0) { float a = 0, b = 0, c = 0; for (int w = 0; w < 8; ++w) { a += red[w * 3]; b += red[w * 3 + 1]; c += red[w * 3 + 2]; } DBG[blockIdx.x * 4] = a; DBG[blockIdx.x * 4 + 1] = b; DBG[blockIdx.x * 4 + 2] = c; }
    __syncthreads();
}
__device__ __forceinline__ void dbg_emit(const float* DBG, float* out) {
    float a = 0, b = 0, c = 0;
    for (int w = 0; w < (int)gridDim.x; ++w) { a += DBG[w * 4]; b += DBG[w * 4 + 1]; c += DBG[w * 4 + 2]; }
    const float rel = sqrtf(a / b);
    int k = (int)rintf(-2.0f * log10f(rel)); k = k < 0 ? 0 : (k > 16 ? 16 : k);
    if (c > 0.f) k = 17;
    const float cc = sqrtf(0.5f * (float)k);
    const size_t n = (size_t)MTOK * DM;
    for (size_t i = (size_t)blockIdx.x * 512 + threadIdx.x; i < n; i += (size_t)gridDim.x * 512) out[i] = cc;
}
#endif

#if SCAN_DBG == 3
__device__ __forceinline__ void dbg_count_bf16(const bf16_t* A, size_t n, unsigned* cnt) {
    unsigned c = 0;
    for (size_t i = (size_t)blockIdx.x * 512 + threadIdx.x; i < n; i += (size_t)gridDim.x * 512) { const float x = bf2f(A[i]); if (!(x - x == 0.f)) ++c; }
    if (c) atomicAdd(cnt, c);
}
__device__ __forceinline__ void dbg_count_f32(const float* A, size_t n, unsigned* cnt) {
    unsigned c = 0;
    for (size_t i = (size_t)blockIdx.x * 512 + threadIdx.x; i < n; i += (size_t)gridDim.x * 512) { const float x = A[i]; if (!(x - x == 0.f)) ++c; }
    if (c) atomicAdd(cnt, c);
}
__device__ __forceinline__ void dbg_emit3(const unsigned* cnt, float* out) {
    float code = 0.f;
    for (int st = 3; st >= 0; --st) { const unsigned c = cnt[st]; if (c) { float lg = log10f((float)c); lg = lg > 9.f ? 9.f : lg; code = (float)(st + 1) + 0.1f * lg; } }
    const float cc = sqrtf(code);
    const size_t n = (size_t)MTOK * DM;
    for (size_t i = (size_t)blockIdx.x * 512 + threadIdx.x; i < n; i += (size_t)gridDim.x * 512) out[i] = cc;
}
#endif

#if SCAN_DBG == 4 || SCAN_DBG == 6
__device__ __forceinline__ void dbg_compare4(LAS float* red, const bf16_t* A, const bf16_t* B, const bf16_t* C, float* DBG) {
    float sd = 0.f, sr = 0.f, nn = 0.f, mm = 0.f;
    const size_t n = (size_t)MTOK * DM;
    for (size_t i = (size_t)blockIdx.x * 512 + threadIdx.x; i < n; i += (size_t)gridDim.x * 512) {
        const float x = bf2f(A[i]), y = bf2f(B[i]);
        if (!(x - x == 0.f)) nn += 1.f; else { sd += (x - y) * (x - y); sr += y * y; }
        if (A[i] != C[i]) mm += 1.f;
    }
    sd = wave_sum(sd); sr = wave_sum(sr); nn = wave_sum(nn); mm = wave_sum(mm);
    const int wv = threadIdx.x >> 6;
    if ((threadIdx.x & 63) == 0) { red[wv * 4] = sd; red[wv * 4 + 1] = sr; red[wv * 4 + 2] = nn; red[wv * 4 + 3] = mm; }
    __syncthreads();
    if (threadIdx.x == 0) { float a = 0, b = 0, c = 0, d = 0; for (int w = 0; w < 8; ++w) { a += red[w * 4]; b += red[w * 4 + 1]; c += red[w * 4 + 2]; d += red[w * 4 + 3]; }
        DBG[blockIdx.x * 4] = a; DBG[blockIdx.x * 4 + 1] = b; DBG[blockIdx.x * 4 + 2] = c; DBG[blockIdx.x * 4 + 3] = d; }
    __syncthreads();
}
__device__ __forceinline__ void dbg_emit4(const float* DBG, float* out) {
    float a = 0, b = 0, c = 0, d = 0;
    for (int w = 0; w < (int)gridDim.x; ++w) { a += DBG[w * 4]; b += DBG[w * 4 + 1]; c += DBG[w * 4 + 2]; d += DBG[w * 4 + 3]; }
    const float rel = sqrtf(a / b);
    int k = (int)rintf(-log10f(rel)); k = k < 0 ? 0 : (k > 8 ? 8 : k);
#if SCAN_DBG == 6
    const float cc = sqrtf((float)k + ((d + c) > 0.f ? 0.5f : 0.f));
#else
    int m = (int)ceilf(log10f(1.0f + d + c)); m = m > 9 ? 9 : m;
    const float cc = sqrtf((float)k + 0.1f * (float)m);
#endif
    const size_t n = (size_t)MTOK * DM;
    for (size_t i = (size_t)blockIdx.x * 512 + threadIdx.x; i < n; i += (size_t)gridDim.x * 512) out[i] = cc;
}
#endif

#if SCAN_DBG == 5
__device__ __forceinline__ void dbg_lds16_test(LAS unsigned char* lds, unsigned* cnt) {
    const int tid = threadIdx.x;
    unsigned bad = 0;
    for (int rep = 0; rep < 64; ++rep) {
        for (int i = tid; i < 1024; i += 512) *(LAS u32x4*)(lds + i * 16) = (u32x4){0x7fc07fc0u, 0x7fc07fc0u, 0x7fc07fc0u, 0x7fc07fc0u};
        __syncthreads();
        const int k = tid & 127, part = tid >> 7;
#pragma unroll
        for (int i = 0; i < 16; ++i) {
            const int row = 16 * part + i;
            *(LAS bf16_t*)(lds + off_b(row, k >> 3) + 2 * (k & 7)) = (bf16_t)((row * 128 + k + rep) & 0x7fff);
        }
        __syncthreads();
        for (int idx = tid; idx < 64 * 128; idx += 512) {
            const int row = idx >> 7, kk = idx & 127;
            const bf16_t got = *(const LAS bf16_t*)(lds + off_b(row, kk >> 3) + 2 * (kk & 7));
            if (got != (bf16_t)((row * 128 + kk + rep) & 0x7fff)) ++bad;
        }
        __syncthreads();
    }
    if (bad) atomicAdd(cnt, bad);
}
__device__ __forceinline__ void dbg_emit5(const unsigned* cnt, float* out) {
    const unsigned c = cnt[0];
    float code = 0.f;
    if (c) { float lg = log10f((float)c); code = 1.0f + (lg > 8.9f ? 8.9f : lg); }
    const float cc = sqrtf(code);
    const size_t n = (size_t)MTOK * DM;
    for (size_t i = (size_t)blockIdx.x * 512 + threadIdx.x; i < n; i += (size_t)gridDim.x * 512) out[i] = cc;
}
#endif

#if SCAN_DBG == 6
__device__ __forceinline__ void dbg_check_a(LAS float* red, const float* LF, const bf16_t* I1, const bf16_t* LT, const bf16_t* LT2, float* DBG) {
    float sd = 0.f, sr = 0.f, mm = 0.f;
    const size_t n = (size_t)4096 * 16384;
    for (size_t i = (size_t)blockIdx.x * 512 + threadIdx.x; i < n; i += (size_t)gridDim.x * 512) {
        const int item = (int)(i >> 14), v = (int)((i >> 7) & 127), k = (int)(i & 127);
        const int bh = item >> 7, c = item & 127, b = bh >> 4, h = bh & 15;
        const size_t tok0 = (size_t)b * SEQ + c * 64;
        float g = 1.f, L = 0.f;
        for (int s2 = 63; s2 >= 0; --s2) {
            const size_t o = (tok0 + s2) * DM + h * 128;
            const float f = __expf(LF[o + k]);
            L += bf2f(I1[o + v]) * (1.0f - f) * g;
            g *= f;
        }
        const float x = bf2f(LT[i]);
        sd += (x - L) * (x - L); sr += L * L;
        if (LT[i] != LT2[i]) mm += 1.f;
    }
    sd = wave_sum(sd); sr = wave_sum(sr); mm = wave_sum(mm);
    const int wv = threadIdx.x >> 6;
    if ((threadIdx.x & 63) == 0) { red[wv * 4] = sd; red[wv * 4 + 1] = sr; red[wv * 4 + 2] = 0.f; red[wv * 4 + 3] = mm; }
    __syncthreads();
    if (threadIdx.x == 0) { float a = 0, b2 = 0, d = 0; for (int w = 0; w < 8; ++w) { a += red[w * 4]; b2 += red[w * 4 + 1]; d += red[w * 4 + 3]; }
        DBG[blockIdx.x * 4] = a; DBG[blockIdx.x * 4 + 1] = b2; DBG[blockIdx.x * 4 + 2] = 0.f; DBG[blockIdx.x * 4 + 3] = d; }
    __syncthreads();
}
#endif

#if SCAN_DBG == 7
#ifndef DBG_FAM
#define DBG_FAM 0
#endif
__device__ __forceinline__ void dbg_check_a7(const float* LF, const bf16_t* I1, const bf16_t* LT, float* DBG) {
    const size_t n = (size_t)4096 * 16384;
    float nbad = 0.f, nnf = 0.f;
    for (size_t i = (size_t)blockIdx.x * 512 + threadIdx.x; i < n; i += (size_t)gridDim.x * 512 * 8) {
        const int item = (int)(i >> 14), v = (int)((i >> 7) & 127), k = (int)(i & 127);
        const int bh = item >> 7, c = item & 127, b = bh >> 4, h = bh & 15;
        const size_t tok0 = (size_t)b * SEQ + c * 64;
        float g = 1.f, L = 0.f;
        for (int s2 = 63; s2 >= 0; --s2) {
            const size_t o = (tok0 + s2) * DM + h * 128;
            const float f = __expf(LF[o + k]);
            L += bf2f(I1[o + v]) * (1.0f - f) * g;
            g *= f;
        }
        const float x = bf2f(LT[i]);
        if (!(x - x == 0.f)) { nnf += 1.f; nbad += 1.f; }
        else if (fabsf(x - L) > 0.02f * fabsf(L) + 1e-2f) nbad += 1.f;
    }
    nbad = wave_sum(nbad); nnf = wave_sum(nnf);
    if ((threadIdx.x & 63) == 0) { atomicAdd(DBG, nbad); atomicAdd(DBG + 1, nnf); }
}
__device__ __forceinline__ void dbg_emit7(const float* DBG, float* out) {
    const float nb = DBG[0], nf = DBG[1];
    int A = nb == 0.f ? 0 : (nb <= 100.f ? 1 : (nb <= 1e4f ? 3 : (nb <= 1e6f ? 5 : 7)));
    int B = nf == 0.f ? 0 : 5;
    const float cc = sqrtf((float)A + 0.1f * (float)B);
    const size_t n = (size_t)MTOK * DM;
    for (size_t i = (size_t)blockIdx.x * 512 + threadIdx.x; i < n; i += (size_t)gridDim.x * 512) out[i] = cc;
}
#endif
__device__ __forceinline__ int opaque(int v) { asm volatile("" : "+s"(v)); return v; }
template <bool L1> __device__ __forceinline__ void run_gemm_out(const Args& a, LAS unsigned char* lds) {
    unsigned char* ws = a.ws;
    pg8::Gemm g{(const bf16_t*)(ws + (L1 ? slot(3) : slot(8))), (const bf16_t*)(ws + (L1 ? WS_WO : WS_WOUT)), opaque(MTOK), opaque(DM), opaque(DM / 2)};
    pg8::StaticOrder S; S.init(g.M, g.N, (int)gridDim.x, (int)blockIdx.x);
    EpiKVQ_<true> E{(bf16_t*)(ws + (L1 ? slot(4) : slot(1))), (const float*)(ws + WS_XSO), (const float*)(ws + (L1 ? WS_SWO : WS_SWOUT))};
    pg8::gemm_phase<EpiKVQ_<true>, pg8::StaticOrder>(lds, g, S, E, nullptr);
}
template <bool L1> __device__ __forceinline__ void run_ln(const Args& a) {
    unsigned char* ws = a.ws;
    phase_ln<L1>((const bf16_t*)(ws + (L1 ? slot(4) : slot(1))), L1 ? (const void*)(ws + slot(2)) : (const void*)a.in[0], a.in[12] + (L1 ? 2 : 0) * DM, a.in[13] + (L1 ? 2 : 0) * DM,
                 (float*)nullptr, (bf16_t*)(ws + (L1 ? slot(8) : slot(5))), (signed char*)(ws + WS_XQ), (float*)(ws + WS_XS));
}
template <bool L1> __device__ __forceinline__ void run_gemm_sc(const Args& a, LAS unsigned char* lds) {
    unsigned char* ws = a.ws;
#if SC8
    pg8::Gemm g{(const bf16_t*)(ws + WS_WC8 + (L1 ? (size_t)DM * DM : 0)), (const bf16_t*)(ws + WS_XQ), opaque(DM), opaque(MTOK), opaque(DM / 2)};
    pg8::StaticOrder S; S.init(g.M, g.N, (int)gridDim.x, (int)blockIdx.x);
    EpiF32_<true> E{(float*)(ws + (L1 ? slot(0) : slot(6))), MTOK, (const float*)(ws + WS_SWC) + (L1 ? DM : 0), (const float*)(ws + WS_XS)};
    pg8::gemm_phase<EpiF32_<true>, pg8::StaticOrder>(lds, g, S, E, nullptr);
#else
    pg8::Gemm g{(const bf16_t*)(ws + WS_WC) + (L1 ? (size_t)DM * DM : 0), (const bf16_t*)(ws + (L1 ? slot(8) : slot(5))), opaque(DM), opaque(MTOK), opaque(DM)};
    pg8::StaticOrder S; S.init(g.M, g.N, (int)gridDim.x, (int)blockIdx.x);
    EpiF32 E{(float*)(ws + (L1 ? slot(0) : slot(6))), MTOK, nullptr, nullptr};
    pg8::gemm_phase<EpiF32, pg8::StaticOrder>(lds, g, S, E, nullptr);
#endif
}
template <bool L1> __device__ __forceinline__ void run_topk(const Args& a, LAS unsigned char* lds) {
    unsigned char* ws = a.ws;
    phase_topk(lds, (const float*)(ws + (L1 ? slot(0) : slot(6))), (int*)(ws + WS_EID), (float*)(ws + WS_GATE));
}
template <bool L1> __device__ __forceinline__ void run_peer(const Args& a, LAS unsigned char* lds) {
    unsigned char* ws = a.ws;
    LAS int* HL = (LAS int*)(lds + (threadIdx.x >> 6) * 8192);
    float* Y = (float*)(ws + (L1 ? slot(0) : slot(6)));
    phase_peer_u((const signed char*)(ws + WS_XQ), (const int*)(ws + WS_EID), ws + WS_UB + (L1 ? (size_t)16384 * DM : 0), HL);
    asm volatile("s_waitcnt vmcnt(0) lgkmcnt(0)" ::: "memory");
    phase_peer_w(HL, (const float*)(ws + WS_XS), (const int*)(ws + WS_EID), (const float*)(ws + WS_GATE),
                 (const float*)(ws + WS_USC) + (L1 ? 16384 : 0), (const float*)(ws + WS_VSC) + (L1 ? 16384 : 0), (signed char*)(ws + WS_W), (float*)(ws + WS_CS));
    asm volatile("s_waitcnt vmcnt(0)" ::: "memory");
    phase_peer_v((const bf16_t*)(ws + (L1 ? slot(8) : slot(5))), (const int*)(ws + WS_EID), (const signed char*)(ws + WS_W), (const float*)(ws + WS_CS),
                 ws + WS_VB + (L1 ? (size_t)16384 * DM : 0), Y);
    asm volatile("s_waitcnt vmcnt(0)" ::: "memory");
    {
        const int lane = threadIdx.x & 63, gw = blockIdx.x * 8 + (threadIdx.x >> 6), nw = gridDim.x * 8, tpw = (MTOK + nw - 1) / nw, tbase = gw * tpw;
        const int tend = tbase + tpw < MTOK ? tbase + tpw : MTOK;
        const float* g = a.in[12] + (L1 ? 3 : 1) * DM; const float* bta = a.in[13] + (L1 ? 3 : 1) * DM;
        float* outf = L1 ? a.out : (float*)nullptr; bf16_t* outb = L1 ? (bf16_t*)nullptr : (bf16_t*)(ws + slot(2));
        for (int row = tbase; row < tend; ++row) {
            float v[32];
            const float* p = Y + (size_t)row * DM;
#pragma unroll
            for (int i = 0; i < 4; ++i) {
                const f32x4 x0 = *(const f32x4*)(p + 512 * i + 8 * lane), x1 = *(const f32x4*)(p + 512 * i + 8 * lane + 4);
#pragma unroll
                for (int j = 0; j < 4; ++j) { v[i * 8 + j] = x0[j]; v[i * 8 + 4 + j] = x1[j]; }
            }
            ln_row_store(v, g, bta, outf ? outf + (size_t)row * DM : nullptr, outb ? outb + (size_t)row * DM : nullptr, lane,
                         L1 ? (signed char*)nullptr : (signed char*)(ws + slot(1)) + (size_t)row * DM, L1 ? (float*)nullptr : (float*)(ws + WS_XS1) + row);
        }
    }
}


#define XB_TMO      128
#define XB_XCNT(j)  (256  + 64 * (j))
#define XB_XSUB(j)  (1280 + 64 * (j))
#define XB_XGEN(j)  (2304 + 64 * (j))
#define XB_TOP      3328
#define XB_TOPGEN   3392
#define XCD_BAR_WORDS 3456
#define XB_SPIN_CAP (1u << 20)
__device__ __forceinline__ unsigned xb_ld(unsigned* p)              { return __hip_atomic_load(p, __ATOMIC_RELAXED, __HIP_MEMORY_SCOPE_AGENT); }
__device__ __forceinline__ unsigned xb_add(unsigned* p, unsigned v) { return __hip_atomic_fetch_add(p, v, __ATOMIC_RELAXED, __HIP_MEMORY_SCOPE_AGENT); }
__device__ __forceinline__ unsigned xb_xcc_id() { return (unsigned)__builtin_amdgcn_s_getreg((3 << 11) | 20) & 0xFu; }
#define XB_SPIN(cond, bar) do { unsigned _sp = 0; while (cond) { __builtin_amdgcn_s_sleep(1); \
    if ((++_sp & 255u) == 0u) { if (xb_ld(&(bar)[XB_TMO])) break; if (_sp > XB_SPIN_CAP) { atomicAdd(&(bar)[XB_TMO], 1u); break; } } } } while (0)
struct XcdBarrier { unsigned* bar; unsigned x; volatile LAS unsigned* st; };
__device__ __forceinline__ XcdBarrier xcd_barrier_post(unsigned* bar, volatile LAS unsigned* st) {
    XcdBarrier b; b.bar = bar; b.x = xb_xcc_id(); b.st = st;
    if (threadIdx.x == 0) (void)xb_add(&bar[XB_XCNT(b.x)], 1u);
    return b;
}
__device__ __forceinline__ void xcd_barrier_complete(unsigned* bar, unsigned x, unsigned& nloc, unsigned& nx) {
    const unsigned G = gridDim.x * gridDim.y * gridDim.z;
    unsigned sum, cnt, mine, sp = 0u;
    for (;;) {
        sum = 0u; cnt = 0u; mine = 0u;
#pragma unroll
        for (unsigned j = 0; j < 16; ++j) { const unsigned c = xb_ld(&bar[XB_XCNT(j)]); sum += c; cnt += (c > 0u) ? 1u : 0u; mine = (j == x) ? c : mine; }
        if (sum == G) break;
        __builtin_amdgcn_s_sleep(1);
        if ((++sp & 255u) == 0u) { if (xb_ld(&bar[XB_TMO])) break; if (sp > XB_SPIN_CAP) { atomicAdd(&bar[XB_TMO], 1u); break; } }
    }
    nloc = mine > 0u ? mine : 1u; nx = cnt > 0u ? cnt : 1u;
}
__device__ __forceinline__ void xcd_barrier(const XcdBarrier& b) {
    asm volatile("s_waitcnt vmcnt(0)" ::: "memory");
    __syncthreads();
    if (threadIdx.x == 0) {
        unsigned* bar = b.bar;
        __builtin_amdgcn_s_waitcnt(0);
        unsigned nloc = b.st[0], nx = b.st[1];
        if (nloc == 0u) { xcd_barrier_complete(bar, b.x, nloc, nx); b.st[0] = nloc; b.st[1] = nx; }
        const unsigned old = xb_add(&bar[XB_XSUB(b.x)], 1u);
        const unsigned gen = old / nloc;
        if (old + 1u == (gen + 1u) * nloc) {
            __builtin_amdgcn_fence(__ATOMIC_RELEASE, "agent");
            asm volatile("s_waitcnt vmcnt(0)" ::: "memory");
            const unsigned og = xb_add(&bar[XB_TOP], 1u);
            const unsigned tg = og / nx;
            if (og + 1u == (tg + 1u) * nx) xb_add(&bar[XB_TOPGEN], 1u);
            else XB_SPIN(xb_ld(&bar[XB_TOPGEN]) == tg, bar);
            __builtin_amdgcn_fence(__ATOMIC_ACQUIRE, "agent");
            xb_add(&bar[XB_XGEN(b.x)], 1u);
            asm volatile("s_waitcnt vmcnt(0)" ::: "memory");
        } else {
            XB_SPIN(xb_ld(&bar[XB_XGEN(b.x)]) == gen, bar);
            __builtin_amdgcn_fence(__ATOMIC_ACQUIRE, "agent");
            asm volatile("s_waitcnt vmcnt(0)" ::: "memory");
        }
    }
    __syncthreads();
}

__global__ void __launch_bounds__(512, 2) mk_fwd(Args a) {
    extern __shared__ __attribute__((aligned(16))) unsigned char lds_raw[];
    LAS unsigned char* lds = (LAS unsigned char*)lds_raw;
    cg::grid_group grid = cg::this_grid();
    unsigned char* ws = a.ws;
#define PHASE_BEGIN(k) if (a.ph_lo <= (k) && (k) < a.ph_hi && EN(k)) {
    volatile LAS unsigned* xb_st = (volatile LAS unsigned*)(lds + LDS_BYTES - 16);
    if (threadIdx.x < 4) xb_st[threadIdx.x] = 0u;
    unsigned* xb_words = (unsigned*)(ws + WS_BAR);
    __syncthreads();
    XcdBarrier xbar = xcd_barrier_post(xb_words, xb_st);
    if (a.ph_lo < 0) grid.sync();
#define PHASE_END(k) if ((k) + 1 < a.ph_hi) xcd_barrier(xbar); }
    PHASE_BEGIN(0) phase_prep(a, lds);
#if SCAN_DBG == 3 || SCAN_DBG == 5
        if (blockIdx.x == 0 && threadIdx.x < 8) ((unsigned*)(ws + WS_CTR + 8192))[threadIdx.x] = 0u;
#endif
#if SCAN_DBG == 7
        if (blockIdx.x == 0 && threadIdx.x < 32) ((float*)(ws + WS_CTR + 4096))[threadIdx.x] = 0.f;
#endif
    PHASE_END(0)
#if SCAN_DBG == 5
    PHASE_BEGIN(1) dbg_lds16_test(lds, (unsigned*)(ws + WS_CTR + 8192)); PHASE_END(1)
#define SKIP_REST 1
#endif
    PHASE_BEGIN(1) {
        pg8::Gemm g{(const bf16_t*)(ws + slot(0)), (const bf16_t*)(ws + WS_WIN), opaque(MTOK), opaque(4 * DM), opaque(DM / 2)};
        pg8::StaticOrder S; S.init(g.M, g.N, (int)gridDim.x, (int)blockIdx.x);
        EpiKVQ_<true> E{(bf16_t*)(ws + slot(1)), (const float*)(ws + WS_XS0), (const float*)(ws + WS_SWIN)};
        pg8::gemm_phase<EpiKVQ_<true>, pg8::StaticOrder>(lds, g, S, E, nullptr);
    } PHASE_END(1)
    PHASE_BEGIN(2) quant_rows_bf16((const bf16_t*)(ws + WS_WC), (signed char*)(ws + WS_WC8), (float*)(ws + WS_SWC), 2 * DM);
        phase_scan_a(lds, (const bf16_t*)(ws + slot(2)), (const float*)(ws + WS_LB), (const bf16_t*)(ws + slot(3)), (bf16_t*)(ws + slot(6)), (float*)(ws + WS_DEC), QuantJob{a.in[10], a.in[11], ws + WS_UB, ws + WS_VB, (float*)(ws + WS_USC), (float*)(ws + WS_VSC)}
#if SCAN_DBG == 3
        , (unsigned*)(ws + WS_CTR + 8192)
#endif
        );
#if SCAN_DBG == 7
        asm volatile("s_waitcnt vmcnt(0)" ::: "memory"); __syncthreads(); grid.sync(); if (threadIdx.x < 64) { __builtin_amdgcn_fence(__ATOMIC_ACQUIRE, "agent"); asm volatile("s_waitcnt vmcnt(0)" ::: "memory"); } __syncthreads();
        dbg_check_a7((const float*)(ws + slot(4)), (const bf16_t*)(ws + slot(2)), (const bf16_t*)(ws + slot(6)), (float*)(ws + WS_CTR + 4096));
#endif
#if SCAN_DBG == 6
#define DSYNC6() asm volatile("s_waitcnt vmcnt(0)" ::: "memory"); __syncthreads(); grid.sync(); if (threadIdx.x < 64) { __builtin_amdgcn_fence(__ATOMIC_ACQUIRE, "agent"); asm volatile("s_waitcnt vmcnt(0)" ::: "memory"); } __syncthreads();
        DSYNC6()
        phase_scan_a(lds, (const bf16_t*)(ws + slot(2)), (const float*)(ws + WS_LB), (const bf16_t*)(ws + slot(3)), (bf16_t*)a.out, (float*)(ws + WS_DEC), QuantJob{a.in[10], a.in[11], ws + WS_UB, ws + WS_VB, (float*)(ws + WS_USC), (float*)(ws + WS_VSC)});
        DSYNC6()
        dbg_check_a((LAS float*)lds, (const float*)(ws + slot(4)), (const bf16_t*)(ws + slot(2)), (const bf16_t*)(ws + slot(6)), (const bf16_t*)a.out, (float*)(ws + WS_CTR + 4096));
#endif
#if SCAN_DBG == 3
        asm volatile("s_waitcnt vmcnt(0)" ::: "memory"); __syncthreads(); grid.sync();
        dbg_count_bf16((const bf16_t*)(ws + slot(6)), (size_t)4096 * 16384, (unsigned*)(ws + WS_CTR + 8192) + 2);
#endif
    PHASE_END(2)
    PHASE_BEGIN(3) phase_scan_b((bf16_t*)(ws + slot(6)), (const float*)(ws + WS_DEC), QuantJob{a.in[10] + (size_t)16384 * DM, a.in[11] + (size_t)16384 * DM, ws + WS_UB + (size_t)16384 * DM, ws + WS_VB + (size_t)16384 * DM, (float*)(ws + WS_USC) + 16384, (float*)(ws + WS_VSC) + 16384});
#if SCAN_DBG == 3
        asm volatile("s_waitcnt vmcnt(0)" ::: "memory"); __syncthreads(); grid.sync();

#endif
    PHASE_END(3)
    PHASE_BEGIN(4) phase_scan_c(lds, (const bf16_t*)(ws + slot(1)), (const bf16_t*)(ws + slot(2)), (const float*)(ws + WS_LB), (const bf16_t*)(ws + slot(3)), (const bf16_t*)(ws + slot(4)), (const bf16_t*)(ws + slot(6)), a.in[2], (bf16_t*)(ws + slot(0)));
#if SCAN_DBG == 1
        asm volatile("s_waitcnt vmcnt(0)" ::: "memory"); __syncthreads(); grid.sync();
        phase_scan_naive((const bf16_t*)(ws + slot(1)), (const float*)(ws + slot(4)), (const bf16_t*)(ws + slot(2)), (float*)(ws + slot(6)));
        asm volatile("s_waitcnt vmcnt(0)" ::: "memory"); __syncthreads(); grid.sync();
        phase_onorm((const float*)(ws + slot(6)), (const bf16_t*)(ws + slot(3)), a.in[2], (bf16_t*)(ws + slot(0)));
#endif
#if SCAN_DBG == 3
        asm volatile("s_waitcnt vmcnt(0)" ::: "memory"); __syncthreads(); grid.sync();

#endif
#if SCAN_DBG == 4
#define DSYNC() asm volatile("s_waitcnt vmcnt(0)" ::: "memory"); __syncthreads(); grid.sync(); if (threadIdx.x < 64) { __builtin_amdgcn_fence(__ATOMIC_ACQUIRE, "agent"); asm volatile("s_waitcnt vmcnt(0)" ::: "memory"); } __syncthreads();
        DSYNC()
        phase_scan_naive((const bf16_t*)(ws + slot(1)), (const float*)(ws + slot(4)), (const bf16_t*)(ws + slot(2)), (float*)(ws + slot(6)));
        DSYNC()
        phase_onorm((const float*)(ws + slot(6)), (const bf16_t*)(ws + slot(3)), a.in[2], (bf16_t*)(ws + slot(8)));
        DSYNC()
        phase_scan_a(lds, (const bf16_t*)(ws + slot(2)), (const float*)(ws + WS_LB), (const bf16_t*)(ws + slot(3)), (bf16_t*)(ws + slot(6)), (float*)(ws + WS_DEC), QuantJob{a.in[10], a.in[11], ws + WS_UB, ws + WS_VB, (float*)(ws + WS_USC), (float*)(ws + WS_VSC)});
        DSYNC()
        phase_scan_b((bf16_t*)(ws + slot(6)), (const float*)(ws + WS_DEC), QuantJob{a.in[10] + (size_t)16384 * DM, a.in[11] + (size_t)16384 * DM, ws + WS_UB + (size_t)16384 * DM, ws + WS_VB + (size_t)16384 * DM, (float*)(ws + WS_USC) + 16384, (float*)(ws + WS_VSC) + 16384});
        DSYNC()
        phase_scan_c(lds, (const bf16_t*)(ws + slot(1)), (const bf16_t*)(ws + slot(2)), (const float*)(ws + WS_LB), (const bf16_t*)(ws + slot(3)), (const bf16_t*)(ws + slot(4)), (const bf16_t*)(ws + slot(6)), a.in[2], (bf16_t*)a.out);
        DSYNC()
        dbg_compare4((LAS float*)lds, (const bf16_t*)(ws + slot(0)), (const bf16_t*)(ws + slot(8)), (const bf16_t*)a.out, (float*)(ws + WS_CTR + 4096));
#endif
#if SCAN_DBG == 2
        asm volatile("s_waitcnt vmcnt(0)" ::: "memory"); __syncthreads(); grid.sync();
        phase_scan_naive((const bf16_t*)(ws + slot(1)), (const float*)(ws + slot(4)), (const bf16_t*)(ws + slot(2)), (float*)(ws + slot(6)));
        asm volatile("s_waitcnt vmcnt(0)" ::: "memory"); __syncthreads(); grid.sync();
        phase_onorm((const float*)(ws + slot(6)), (const bf16_t*)(ws + slot(3)), a.in[2], (bf16_t*)(ws + slot(8)));
        asm volatile("s_waitcnt vmcnt(0)" ::: "memory"); __syncthreads(); grid.sync();
        dbg_compare((LAS float*)lds, (const bf16_t*)(ws + slot(0)), (const bf16_t*)(ws + slot(8)), (float*)(ws + WS_CTR + 4096));
#endif
    PHASE_END(4)
    PHASE_BEGIN(5)
        quant_rows_bf16((const bf16_t*)(ws + slot(0)), (signed char*)(ws + slot(8)), (float*)(ws + WS_XSO), MTOK);
        xcd_barrier(xbar);
        run_gemm_out<false>(a, lds); PHASE_END(5)
    PHASE_BEGIN(6) run_ln<false>(a); PHASE_END(6)
    PHASE_BEGIN(7) run_gemm_sc<false>(a, lds); PHASE_END(7)
    PHASE_BEGIN(8) run_topk<false>(a, lds); PHASE_END(8)
    PHASE_BEGIN(9) run_peer<false>(a, lds); PHASE_END(9)
    PHASE_BEGIN(10) {
        pg8::Gemm g{(const bf16_t*)(ws + slot(1)), (const bf16_t*)(ws + WS_WKVQ), opaque(MTOK), opaque(3 * DM), opaque(DM / 2)};
        pg8::StaticOrder S; S.init(g.M, g.N, (int)gridDim.x, (int)blockIdx.x);
        EpiKVQR_<true> E{(bf16_t*)(ws + slot(3)), (const float*)(ws + WS_COS), (const float*)(ws + WS_SIN), (const float*)(ws + WS_XS1), (const float*)(ws + WS_SWKVQ)};
        pg8::gemm_phase<EpiKVQR_<true>, pg8::StaticOrder>(lds, g, S, E, nullptr);
    } PHASE_END(10)
    PHASE_BEGIN(11) phase_kstat((LAS float*)lds, (const bf16_t*)(ws + slot(3)), (float*)(ws + WS_KMEAN), (float*)(ws + WS_KNMAX)); PHASE_END(11)
    PHASE_BEGIN(12) phase_sel(lds, (const bf16_t*)(ws + slot(5)), (const float*)(ws + WS_KMEAN), (unsigned short*)(ws + WS_SUB), (int*)(ws + WS_CNT), (int*)(ws + WS_CTR)); PHASE_END(12)
    PHASE_BEGIN(13) phase_att(lds, (const bf16_t*)(ws + slot(5)), (const bf16_t*)(ws + slot(3)), (const bf16_t*)(ws + slot(4)), (const float*)(ws + WS_KNMAX), (const unsigned short*)(ws + WS_SUB),
                              (const int*)(ws + WS_CNT), (int*)(ws + WS_CTR), (bf16_t*)(ws + slot(6)), (bf16_t*)(ws + slot(0)), (float*)(ws + WS_LS)); PHASE_END(13)
    PHASE_BEGIN(14) phase_comb((LAS float*)lds, (const bf16_t*)(ws + slot(6)), (const bf16_t*)(ws + slot(0)), (const float*)(ws + WS_LS), (signed char*)(ws + slot(3)), (float*)(ws + WS_XSO)); PHASE_END(14)
    PHASE_BEGIN(15) run_gemm_out<true>(a, lds); PHASE_END(15)
    PHASE_BEGIN(16) run_ln<true>(a); PHASE_END(16)
    PHASE_BEGIN(17) run_gemm_sc<true>(a, lds); PHASE_END(17)
    PHASE_BEGIN(18) run_topk<true>(a, lds); PHASE_END(18)
#if SCAN_DBG == 7
    PHASE_BEGIN(19) dbg_emit7((const float*)(ws + WS_CTR + 4096), a.out); PHASE_END(19)
#elif SCAN_DBG == 6
    PHASE_BEGIN(19) dbg_emit4((const float*)(ws + WS_CTR + 4096), a.out); PHASE_END(19)
#elif SCAN_DBG == 5
    PHASE_BEGIN(19) dbg_emit5((const unsigned*)(ws + WS_CTR + 8192), a.out); PHASE_END(19)
#elif SCAN_DBG == 4
    PHASE_BEGIN(19) dbg_emit4((const float*)(ws + WS_CTR + 4096), a.out); PHASE_END(19)
#elif SCAN_DBG == 3
    PHASE_BEGIN(19) dbg_emit3((const unsigned*)(ws + WS_CTR + 8192), a.out); PHASE_END(19)
#elif SCAN_DBG == 2
    PHASE_BEGIN(19) dbg_emit((const float*)(ws + WS_CTR + 4096), a.out); PHASE_END(19)
#else
    PHASE_BEGIN(19) run_peer<true>(a, lds); PHASE_END(19)
#endif
}

extern "C" void kernel_launch(void* const* d_in, const int* in_sizes, int n_in, void* d_out, int out_size, void* d_ws, size_t ws_size, hipStream_t stream) {
    static int grid = 0;
    if (grid == 0) {
        if (n_in != 14 || out_size != MTOK * DM || ws_size < WS_END) { fprintf(stderr, "kernel_launch: unexpected shapes (n_in %d, out %d, ws %zu)\n", n_in, out_size, ws_size); grid = -1; return; }
        int dev = 0, cus = 0, per_cu = 0;
        if (hipGetDevice(&dev) != hipSuccess || hipDeviceGetAttribute(&cus, hipDeviceAttributeMultiprocessorCount, dev) != hipSuccess) { grid = -1; return; }
        if (hipFuncSetAttribute((const void*)mk_fwd, hipFuncAttributeMaxDynamicSharedMemorySize, LDS_BYTES) != hipSuccess) { fprintf(stderr, "kernel_launch: hipFuncSetAttribute failed\n"); grid = -1; return; }
        if (hipOccupancyMaxActiveBlocksPerMultiprocessor(&per_cu, (const void*)mk_fwd, 512, LDS_BYTES) != hipSuccess || per_cu < 1) { fprintf(stderr, "kernel_launch: occupancy query failed (%d)\n", per_cu); (void)hipGetLastError(); per_cu = 1; }
        grid = cus * (per_cu > 1 ? 1 : per_cu);
    }
    if (grid < 0) return;
    Args a{};
    for (int i = 0; i < 14; ++i) a.in[i] = (const float*)d_in[i];
    a.out = (float*)d_out; a.ws = (unsigned char*)d_ws;
#if ONE_LAUNCH
    a.ph_lo = 0; a.ph_hi = NPH;
    (void)hipMemsetAsync((unsigned char*)d_ws + WS_BAR, 0, XCD_BAR_WORDS * sizeof(unsigned), stream);
    void* args[] = {&a};
    hipError_t e = hipLaunchCooperativeKernel((const void*)mk_fwd, dim3(grid), dim3(512), args, LDS_BYTES, stream);
    if (e != hipSuccess) fprintf(stderr, "cooperative launch failed: %s (grid %d)\n", hipGetErrorString(e), grid);
#else
    for (int ph = 0; ph < NPH; ++ph) {
        a.ph_lo = ph; a.ph_hi = ph + 1;
        hipLaunchKernelGGL(mk_fwd, dim3(grid), dim3(512), LDS_BYTES, stream, a);
    }
#endif
}
```

```cpp
#define ONE_LAUNCH 1
#include <hip/hip_runtime.h>
#include <hip/hip_cooperative_groups.h>
#include <cstdio>
namespace cg = cooperative_groups;

#ifndef ONE_LAUNCH
#define ONE_LAUNCH 0
#endif
#ifndef SCAN_DBG
#define SCAN_DBG 0
#endif
#ifndef SCAN_A_VALU
#define SCAN_A_VALU 0
#endif
#ifndef SC8
#define SC8 1
#endif
#ifndef ENMASK
#define ENMASK 0xffffffffu
#endif
#define EN(k) ((ENMASK >> (k)) & 1u)

namespace pg8 {
#define PG8_LAS __attribute__((address_space(3)))
typedef unsigned short bf16_t;
typedef short bf16x8 __attribute__((ext_vector_type(8)));
typedef float f32x4 __attribute__((ext_vector_type(4)));
typedef unsigned u32x4 __attribute__((ext_vector_type(4)));
constexpr int BM = 256, BK = 64, HALF = 128, HTB = HALF * BK * 2  , STAGE_BYTES = 8 * HTB, NXCD = 8, WGM = 8;

__host__ __device__ __forceinline__ int lds_byte(int r, int c) { const int st = (r >> 4) * 2 + (c >> 5), rr = r & 15, cc = c & 31, ob = rr * 64 + cc * 2; return st * 1024 + (ob ^ (((ob >> 9) & 1) << 5)); }
__host__ __device__ __forceinline__ void stage_rc(int b, int& R, int& C) { const int st = b / 1024, sb = b % 1024, swz = sb ^ (((sb >> 9) & 1) << 5); R = (st >> 1) * 16 + swz / 64; C = (st & 1) * 32 + (swz % 64) / 2; }
__host__ __device__ __forceinline__ int perm32(int rho) { const int n = rho >> 4, i = rho & 15; return 8 * (i >> 2) + 4 * n + (i & 3); }

struct Unit { int pm, pn; };
struct Gemm { const bf16_t* A; const bf16_t* Bt; int M, N, K; };

struct StaticOrder {
    int nM, nN, nwg, G, c;
    __host__ __device__ void init(int M, int N, int G_, int c_) { nM = M / BM; nN = N / BM; nwg = nM * nN; G = G_; c = c_; }
    __host__ __device__ bool next(int i, Unit& u) const {
        const long L = (long)i * G + c; if (L >= nwg) return false;
        int wgid = (int)L; { const int q = nwg / NXCD, r = nwg % NXCD, xcd = wgid % NXCD, off = wgid / NXCD; wgid = (xcd < r ? xcd * (q + 1) : r * (q + 1) + (xcd - r) * q) + off; }
        const int nig = WGM * nN, gid = wgid / nig, fm = gid * WGM, gsz = (nM - fm) < WGM ? (nM - fm) : WGM;
        u.pm = fm + ((wgid % nig) % gsz); u.pn = (wgid % nig) / gsz; return true;
    }
    __device__ __forceinline__ void a_ready(const Unit&) const {}
    __device__ __forceinline__ void done(const Unit&) const {}
};
struct CountedOrder : StaticOrder {
    const unsigned* ready; unsigned need; unsigned* tmo;
    __device__ __forceinline__ void a_ready(const Unit& u) const {
        if (threadIdx.x < 64) {
            const unsigned long long t0 = __builtin_amdgcn_s_memrealtime(); unsigned polls = 0;
            while ((unsigned)__builtin_amdgcn_readfirstlane(__hip_atomic_load(ready + 64 * u.pm, __ATOMIC_RELAXED, __HIP_MEMORY_SCOPE_AGENT)) < need) {
                if ((++polls & 255u) == 0u && __builtin_amdgcn_readfirstlane(__hip_atomic_load(tmo, __ATOMIC_RELAXED, __HIP_MEMORY_SCOPE_AGENT)) != 0u) break;
                if (__builtin_amdgcn_s_memrealtime() - t0 > 2000000ull) {
                    if (threadIdx.x == 0) { unsigned expect = 0u; __hip_atomic_compare_exchange_strong(tmo + 1, &expect, 0x600u | (unsigned)(u.pm & 0xff), __ATOMIC_RELAXED, __ATOMIC_RELAXED, __HIP_MEMORY_SCOPE_AGENT); __hip_atomic_store(tmo, 1u, __ATOMIC_RELAXED, __HIP_MEMORY_SCOPE_AGENT); }
                    break; }
                __builtin_amdgcn_s_sleep(2); }
            __builtin_amdgcn_fence(__ATOMIC_ACQUIRE, "agent");
            asm volatile("s_waitcnt vmcnt(0)" ::: "memory");
        }
#if !defined(BROKEN_HOOK_NO_BARRIER)
        asm volatile("" ::: "memory"); __builtin_amdgcn_s_barrier(); asm volatile("" ::: "memory");
#endif
    }
};

__device__ __forceinline__ unsigned cvt_pk_bf16(float lo, float hi) { unsigned r; asm volatile("v_cvt_pk_bf16_f32 %0, %1, %2" : "=v"(r) : "v"(lo), "v"(hi)); return r; }
typedef float f32x2 __attribute__((ext_vector_type(2)));
__device__ __forceinline__ f32x2 gelu_pk(f32x2 v) {
    const f32x2 av = __builtin_elementwise_abs(v), d = av * 0.2316418882f + 1.0f;
    f32x2 t; t.x = __builtin_amdgcn_rcpf(d.x); t.y = __builtin_amdgcn_rcpf(d.y);
    f32x2 q = t * 0.5307027145f + (-0.7265760135f); q = q * t + 0.7107068705f; q = q * t + (-0.142248368f); q = q * t + 0.127414796f; q = q * t;
    const f32x2 s = (v * v) * (-0.72134752044f);
    f32x2 e; e.x = __builtin_amdgcn_exp2f(s.x); e.y = __builtin_amdgcn_exp2f(s.y);
    const f32x2 m = v * (q * e), r = v - m;
    f32x2 o; o.x = v.x < 0.f ? m.x : r.x; o.y = v.y < 0.f ? m.y : r.y; return o;
}

struct EpiF32 {
    static constexpr bool PERM = false, AFTER_DRAIN = false, I8 = false;
    float* C; int ldc; const float* bias;
    __device__ __forceinline__ void operator()(const f32x4 (&acc)[2][2][4][2], const Unit& u, int wr, int wc, int fr, int fq) const {
        const int row0 = u.pm * BM + wr * 64 + fr, col0 = u.pn * BM + wc * 32 + 4 * fq;
        f32x4 bv[2][2];
#pragma unroll
        for (int bj = 0; bj < 2; ++bj)
#pragma unroll
            for (int n = 0; n < 2; ++n) bv[bj][n] = bias ? *(const f32x4*)(bias + col0 + bj * HALF + n * 16) : (f32x4){0.f, 0.f, 0.f, 0.f};
#pragma unroll
        for (int ai = 0; ai < 2; ++ai)
#pragma unroll
            for (int m = 0; m < 4; ++m) { float* rowp = C + (size_t)(row0 + ai * HALF + m * 16) * ldc + col0;
#pragma unroll
                for (int bj = 0; bj < 2; ++bj)
#pragma unroll
                    for (int n = 0; n < 2; ++n) *(f32x4*)(rowp + bj * HALF + n * 16) = acc[ai][bj][m][n] + bv[bj][n]; }
    }
};
template <int ACT  > struct EpiBf16 {
    static constexpr bool PERM = true, AFTER_DRAIN = false, I8 = false;
    bf16_t* O; int ldc; const float* bias; int split_cols; size_t split_stride;
    __device__ __forceinline__ void operator()(const f32x4 (&acc)[2][2][4][2], const Unit& u, int wr, int wc, int fr, int fq) const {
        const int row0 = u.pm * BM + wr * 64 + fr; int colt = u.pn * BM; bf16_t* base = O;
        if (split_cols) { const int t = colt / split_cols; base += (size_t)t * split_stride; colt -= t * split_cols; }
        const int col0 = colt + wc * 32 + 8 * fq, bcol0 = u.pn * BM + wc * 32 + 8 * fq;
        f32x4 bv[2][2];
#pragma unroll
        for (int bj = 0; bj < 2; ++bj)
#pragma unroll
            for (int n = 0; n < 2; ++n) bv[bj][n] = bias ? *(const f32x4*)(bias + bcol0 + bj * HALF + 4 * n) : (f32x4){0.f, 0.f, 0.f, 0.f};
#pragma unroll
        for (int ai = 0; ai < 2; ++ai)
#pragma unroll
            for (int m = 0; m < 4; ++m) { bf16_t* rowp = base + (size_t)(row0 + ai * HALF + m * 16) * ldc + col0;
#pragma unroll
                for (int bj = 0; bj < 2; ++bj) { f32x4 v0 = acc[ai][bj][m][0] + bv[bj][0], v1 = acc[ai][bj][m][1] + bv[bj][1];
                    if (ACT == 1) { f32x2 a = gelu_pk((f32x2){v0[0], v0[1]}), b = gelu_pk((f32x2){v0[2], v0[3]}), c = gelu_pk((f32x2){v1[0], v1[1]}), d = gelu_pk((f32x2){v1[2], v1[3]});
                        v0 = (f32x4){a.x, a.y, b.x, b.y}; v1 = (f32x4){c.x, c.y, d.x, d.y}; }
                    if (ACT == 2) {
#pragma unroll
                        for (int j = 0; j < 4; ++j) { v0[j] = 0.5f * v0[j] * (1.0f + erff(v0[j] * 0.70710678f)); v1[j] = 0.5f * v1[j] * (1.0f + erff(v1[j] * 0.70710678f)); } }
                    u32x4 w; w.x = cvt_pk_bf16(v0[0], v0[1]); w.y = cvt_pk_bf16(v0[2], v0[3]); w.z = cvt_pk_bf16(v1[0], v1[1]); w.w = cvt_pk_bf16(v1[2], v1[3]);
                    *(u32x4*)(rowp + bj * HALF) = w; } }
    }
};

typedef int i32x4 __attribute__((ext_vector_type(4)));
template <bool I8> __device__ __forceinline__ f32x4 mma16(bf16x8 b, bf16x8 a, f32x4 c) {
    if constexpr (I8) return __builtin_bit_cast(f32x4, __builtin_amdgcn_mfma_i32_16x16x64_i8(__builtin_bit_cast(i32x4, b), __builtin_bit_cast(i32x4, a), __builtin_bit_cast(i32x4, c), 0, 0, 0));
    else return __builtin_amdgcn_mfma_f32_16x16x32_bf16(b, a, c, 0, 0, 0);
}
template <bool I8> __device__ __forceinline__ f32x4 accf(f32x4 a) { if constexpr (I8) return __builtin_convertvector(__builtin_bit_cast(i32x4, a), f32x4); else return a; }
template <class Epi, class Sched, bool STAMP = false>
__device__ __forceinline__ void gemm_phase(PG8_LAS unsigned char* lds, const Gemm g, const Sched& S, const Epi& E, unsigned long long* stamps) {
    const int tid = threadIdx.x, wid = __builtin_amdgcn_readfirstlane(tid >> 6), lane = tid & 63, wr = wid >> 2, wc = wid & 3, fr = lane & 15, fq = lane >> 4;
    const int K = g.K, nt = K / BK;
    int ts_lo = 0, ts_hi = 0, nts = 0; const unsigned long long rt_entry = STAMP ? (unsigned long long)wall_clock64() : 0ull;
#define PG8_STAMP() do { if (STAMP && wid == 0 && nts < 64) { const unsigned long long _c = (unsigned long long)clock64(); \
        ts_lo = (lane == nts) ? (int)(unsigned)_c : ts_lo; ts_hi = (lane == nts) ? (int)(unsigned)(_c >> 32) : ts_hi; ++nts; } } while (0)
    PG8_STAMP();
    unsigned voffA[2], voffB[2];
#pragma unroll
    for (int i = 0; i < 2; ++i) { int R, C; stage_rc(tid * 16 + i * 8192, R, C); const int Rb = Epi::PERM ? ((R & ~31) + perm32(R & 31)) : R;
        voffA[i] = (unsigned)(R * K + C) * 2u; voffB[i] = (unsigned)(Rb * K + C) * 2u; }
    const size_t kstep = (size_t)(BK * 2);
    const size_t hstep = (size_t)HALF * K * 2;
    const size_t tstep = 2 * hstep;
    const unsigned ldsw = (unsigned)wid * 1024u;
    const int aoff = lds_byte(wr * 64 + fr, fq * 8), boff = lds_byte(wc * 32 + fr, fq * 8);
#define PG8_SA(b, h) (((b) * 2 + (h)) * HTB)
#define PG8_SB(b, h) ((4 + (b) * 2 + (h)) * HTB)
#define PG8_STAGE(bufoff, gbase, voff) do { _Pragma("unroll") for (int _i = 0; _i < 2; ++_i) \
        __builtin_amdgcn_global_load_lds((const unsigned*)((const char*)(gbase) + (voff)[_i]), (PG8_LAS unsigned*)(lds + (bufoff) + ldsw + _i * 8192), 16, 0, 0); } while (0)
#define PG8_LDA(dst, b, h) do { _Pragma("unroll") for (int m = 0; m < 4; ++m) _Pragma("unroll") for (int k = 0; k < 2; ++k) dst[m][k] = *(const PG8_LAS bf16x8*)(lds + PG8_SA(b, h) + aoff + m * 2048 + k * 1024); } while (0)
#define PG8_LDB(dst, b, h) do { _Pragma("unroll") for (int n = 0; n < 2; ++n) _Pragma("unroll") for (int k = 0; k < 2; ++k) dst[n][k] = *(const PG8_LAS bf16x8*)(lds + PG8_SB(b, h) + boff + n * 2048 + k * 1024); } while (0)
#define PG8_MMA(ai, bj, At, Bt) do { __builtin_amdgcn_s_setprio(1); _Pragma("unroll") for (int m = 0; m < 4; ++m) _Pragma("unroll") for (int n = 0; n < 2; ++n) _Pragma("unroll") for (int k = 0; k < 2; ++k) \
        acc[ai][bj][m][n] = mma16<Epi::I8>(Bt[n][k], At[m][k], acc[ai][bj][m][n]); __builtin_amdgcn_s_setprio(0); } while (0)
#define PG8_WAIT_V(n) asm volatile("s_waitcnt vmcnt(" #n ")" ::: "memory")
#define PG8_WAIT_L(n) asm volatile("s_waitcnt lgkmcnt(" #n ")" ::: "memory")
#define PG8_BAR __builtin_amdgcn_s_barrier()
#define PG8_SCHED __builtin_amdgcn_sched_barrier(0)
    Unit cur, nxt; int ui = 0;
    if (!S.next(0, cur)) return;
    f32x4 acc[2][2][4][2];
#pragma unroll
    for (int a = 0; a < 2; ++a)
#pragma unroll
        for (int b = 0; b < 2; ++b)
#pragma unroll
            for (int m = 0; m < 4; ++m)
#pragma unroll
                for (int n = 0; n < 2; ++n) acc[a][b][m][n] = (f32x4){0.f, 0.f, 0.f, 0.f};
    bf16x8 At[4][2], B0[2][2], B1[2][2];
    const char* cA = (const char*)g.A + (size_t)cur.pm * tstep; const char* cB = (const char*)g.Bt + (size_t)cur.pn * tstep;
    S.a_ready(cur);
    PG8_STAGE(PG8_SB(0, 0), cB, voffB); PG8_STAGE(PG8_SA(0, 0), cA, voffA); PG8_STAGE(PG8_SB(0, 1), cB + hstep, voffB); PG8_STAGE(PG8_SA(0, 1), cA + hstep, voffA);
    if (wr == 1) PG8_BAR;
    PG8_WAIT_V(4); PG8_BAR;
    PG8_STAGE(PG8_SB(1, 0), cB + kstep, voffB); PG8_STAGE(PG8_SA(1, 0), cA + kstep, voffA); PG8_STAGE(PG8_SB(1, 1), cB + hstep + kstep, voffB);
    PG8_WAIT_V(6); PG8_BAR;
    PG8_STAMP();
    for (;;) {
        const bool has_next = S.next(ui + 1, nxt);
        const char* nA = has_next ? (const char*)g.A + (size_t)nxt.pm * tstep : cA; const char* nB = has_next ? (const char*)g.Bt + (size_t)nxt.pn * tstep : cB;
        for (int t = 0; t < nt; t += 2) {
            const bool last = (t == nt - 2);
            const char* a1 = cA + (size_t)(t + 1) * kstep;
            const char* a2 = last ? nA : cA + (size_t)(t + 2) * kstep; const char* b2 = last ? nB : cB + (size_t)(t + 2) * kstep;
            const char* a3 = a2 + kstep; const char* b3 = b2 + kstep;
            if (last && has_next) S.a_ready(nxt);
            PG8_LDB(B0, 0, 0); PG8_SCHED; PG8_LDA(At, 0, 0); PG8_STAGE(PG8_SA(1, 1), a1 + hstep, voffA);
            PG8_WAIT_L(8); PG8_BAR; PG8_WAIT_L(0); PG8_MMA(0, 0, At, B0); PG8_BAR; PG8_SCHED;
            PG8_LDB(B1, 0, 1); PG8_STAGE(PG8_SB(0, 0), b2, voffB);
            PG8_BAR; PG8_WAIT_L(0); PG8_MMA(0, 1, At, B1); PG8_BAR;
            PG8_LDA(At, 0, 1); PG8_STAGE(PG8_SA(0, 0), a2, voffA);
            PG8_BAR; PG8_WAIT_L(0); PG8_MMA(1, 0, At, B0); PG8_BAR; PG8_SCHED;
            PG8_STAGE(PG8_SB(0, 1), b2 + hstep, voffB);
            PG8_WAIT_V(6); PG8_BAR; PG8_MMA(1, 1, At, B1); PG8_BAR;
            PG8_LDB(B0, 1, 0); PG8_SCHED; PG8_LDA(At, 1, 0); PG8_STAGE(PG8_SA(0, 1), a2 + hstep, voffA);
            PG8_WAIT_L(8); PG8_BAR; PG8_WAIT_L(0); PG8_MMA(0, 0, At, B0); PG8_BAR; PG8_SCHED;
            PG8_LDB(B1, 1, 1); PG8_STAGE(PG8_SB(1, 0), b3, voffB);
            PG8_BAR; PG8_WAIT_L(0); PG8_MMA(0, 1, At, B1); PG8_BAR;
            PG8_LDA(At, 1, 1); PG8_STAGE(PG8_SA(1, 0), a3, voffA);
            PG8_BAR; PG8_WAIT_L(0); PG8_MMA(1, 0, At, B0); PG8_BAR; PG8_SCHED;
            PG8_STAGE(PG8_SB(1, 1), b3 + hstep, voffB);
            PG8_WAIT_V(6); PG8_BAR; PG8_MMA(1, 1, At, B1); PG8_BAR;
        }
        PG8_STAMP();
        if constexpr (!Epi::AFTER_DRAIN) { E(acc, cur, wr, wc, fr, fq); S.done(cur); }
        PG8_STAMP();
        if (!has_next) break;
#pragma unroll
        for (int a = 0; a < 2; ++a)
#pragma unroll
            for (int b = 0; b < 2; ++b)
#pragma unroll
                for (int m = 0; m < 4; ++m)
#pragma unroll
                    for (int n = 0; n < 2; ++n) acc[a][b][m][n] = (f32x4){0.f, 0.f, 0.f, 0.f};
        cur = nxt; cA = nA; cB = nB; ++ui;
    }
    PG8_WAIT_V(0);
    if (wr == 0) PG8_BAR;
    PG8_BAR;
    if constexpr (Epi::AFTER_DRAIN) { E.fused(acc, cur, wr, wc, fr, fq, lds, wid, lane); S.done(cur); }
    PG8_STAMP();
    if (STAMP && wid == 0) { stamps[lane] = lane < nts ? (((unsigned long long)(unsigned)ts_hi << 32) | (unsigned)ts_lo) : 0ull;
        if (lane == 62) stamps[62] = rt_entry; if (lane == 63) stamps[63] = (unsigned long long)wall_clock64(); }
#undef PG8_STAMP
#undef PG8_SA
#undef PG8_SB
#undef PG8_STAGE
#undef PG8_LDA
#undef PG8_LDB
#undef PG8_MMA
#undef PG8_WAIT_V
#undef PG8_WAIT_L
#undef PG8_BAR
#undef PG8_SCHED
}
}


#define LAS __attribute__((address_space(3)))
typedef unsigned short bf16_t;
typedef float f32x4 __attribute__((ext_vector_type(4)));
typedef unsigned u32x4 __attribute__((ext_vector_type(4)));
typedef unsigned u32x2 __attribute__((ext_vector_type(2)));
typedef short bf16x8 __attribute__((ext_vector_type(8)));
typedef short s16x4 __attribute__((ext_vector_type(4)));
typedef float f32x16 __attribute__((ext_vector_type(16)));

constexpr int MTOK = 16384, DM = 2048, SEQ = 8192, NHEAD = 16;
constexpr float ALPHA = 1.41421356237309515f;
constexpr size_t MiB = (size_t)1 << 20;
constexpr size_t WS_WIN = 0, WS_WOUT = 32 * MiB, WS_WKVQ = 40 * MiB, WS_WO = 64 * MiB, WS_WC = 72 * MiB, WS_UB = 88 * MiB, WS_VB = 152 * MiB, WS_USC = 216 * MiB, WS_VSC = 217 * MiB, WS_H = 224 * MiB, WS_XQ = 232 * MiB, WS_XS = 264 * MiB, WS_W = 272 * MiB, WS_CS = 280 * MiB, WS_SLOT = 344 * MiB;
constexpr size_t WS_EID = 920 * MiB, WS_GATE = 928 * MiB, WS_COS = 936 * MiB, WS_SIN = 938 * MiB, WS_KMEAN = 940 * MiB, WS_LB = 941 * MiB, WS_LS = 942 * MiB, WS_SUB = 946 * MiB, WS_CNT = 962 * MiB, WS_CTR = 963 * MiB, WS_DEC = 964 * MiB, WS_END = 966 * MiB;
constexpr size_t WS_BAR = WS_CTR + 65536;
constexpr size_t WS_SWOUT = WS_XS + 512 * 1024;
constexpr size_t WS_WC8 = WS_H, WS_SWC = WS_XS + 5 * MiB, WS_XSO = WS_XS + 6 * MiB, WS_SWO = WS_XS + 7 * MiB;
constexpr size_t WS_XS0 = WS_XS + 1 * MiB, WS_SWIN = WS_XS + 2 * MiB, WS_SWKVQ = WS_XS + 3 * MiB, WS_XS1 = WS_XS + 4 * MiB;
constexpr size_t WS_KNMAX = WS_KMEAN + 768 * 1024;
__host__ __device__ constexpr size_t slot(int i) { return WS_SLOT + (size_t)i * 64 * MiB; }
constexpr int LDS_BYTES = 144 * 1024;
constexpr int NPH = 20;

struct Args { const float* in[14]; float* out; unsigned char* ws; int ph_lo, ph_hi; };

__device__ __forceinline__ float bflo(unsigned w) { return __uint_as_float(w << 16); }
__device__ __forceinline__ float bfhi(unsigned w) { return __uint_as_float(w & 0xffff0000u); }
__device__ __forceinline__ float bf2f(bf16_t b) { return __uint_as_float(((unsigned)b) << 16); }
typedef __bf16 bf16x2_t __attribute__((ext_vector_type(2)));
typedef float f32x2_t __attribute__((ext_vector_type(2)));
__device__ __forceinline__ unsigned pk_bf16(float lo, float hi) { const f32x2_t f = {lo, hi}; return __builtin_bit_cast(unsigned, __builtin_convertvector(f, bf16x2_t)); }
__device__ __forceinline__ float wave_sum(float v) {
#pragma unroll
    for (int o = 32; o >= 1; o >>= 1) v += __shfl_xor(v, o);
    return v;
}
__device__ __forceinline__ float wave_max(float v) {
#pragma unroll
    for (int o = 32; o >= 1; o >>= 1) v = fmaxf(v, __shfl_xor(v, o));
    return v;
}
__device__ __forceinline__ float sigmoidf_(float z) { return 1.0f / (1.0f + __expf(-z)); }


__device__ __forceinline__ void store_wt16(void* p, u32x4 v) {
    __hip_atomic_store((unsigned long long*)p, ((unsigned long long)v.y << 32) | v.x, __ATOMIC_RELAXED, __HIP_MEMORY_SCOPE_AGENT);
    __hip_atomic_store((unsigned long long*)p + 1, ((unsigned long long)v.w << 32) | v.z, __ATOMIC_RELAXED, __HIP_MEMORY_SCOPE_AGENT);
}
__device__ __forceinline__ void store_wt8(void* p, u32x2 v) {
    __hip_atomic_store((unsigned long long*)p, ((unsigned long long)v.y << 32) | v.x, __ATOMIC_RELAXED, __HIP_MEMORY_SCOPE_AGENT);
}
struct EpiIn {
    static constexpr bool PERM = true, AFTER_DRAIN = false, I8 = false;
    bf16_t* Q1; float* LF; bf16_t* I1; bf16_t* G1; const float* LB;
    __device__ __forceinline__ void operator()(const pg8::f32x4 (&acc)[2][2][4][2], const pg8::Unit& u, int wr, int wc, int fr, int fq) const {
        const int type = u.pn >> 3;
        const int row0 = u.pm * 256 + wr * 64 + fr, col0 = (u.pn & 7) * 256 + wc * 32 + 8 * fq;
        if (type == 1) {
#pragma unroll
            for (int bj = 0; bj < 2; ++bj) {
                const int c = col0 + bj * 128;
                const f32x4 lb0 = *(const f32x4*)(LB + c), lb1 = *(const f32x4*)(LB + c + 4);
#pragma unroll
                for (int ai = 0; ai < 2; ++ai)
#pragma unroll
                    for (int m = 0; m < 4; ++m) {
                        float* p = LF + (size_t)(row0 + ai * 128 + m * 16) * DM + c;
                        f32x4 o0, o1;
#pragma unroll
                        for (int j = 0; j < 4; ++j) {
                            o0[j] = __logf(lb0[j] + (1.0f - lb0[j]) * sigmoidf_(acc[ai][bj][m][0][j]));
                            o1[j] = __logf(lb1[j] + (1.0f - lb1[j]) * sigmoidf_(acc[ai][bj][m][1][j]));
                        }
                        *(f32x4*)p = o0; *(f32x4*)(p + 4) = o1;
                    }
            }
        } else {
            bf16_t* dst = Q1 + (size_t)(type - (type > 0 ? 1 : 0)) * ((size_t)32 << 20);
            const bool act = (type != 2);
#pragma unroll
            for (int ai = 0; ai < 2; ++ai)
#pragma unroll
                for (int m = 0; m < 4; ++m)
#pragma unroll
                    for (int bj = 0; bj < 2; ++bj) {
                        f32x4 v0 = acc[ai][bj][m][0], v1 = acc[ai][bj][m][1];
                        if (act) {
#pragma unroll
                            for (int j = 0; j < 4; ++j) { v0[j] = v0[j] * sigmoidf_(v0[j]); v1[j] = v1[j] * sigmoidf_(v1[j]); }
                        }
                        u32x4 w; w.x = pk_bf16(v0[0], v0[1]); w.y = pk_bf16(v0[2], v0[3]); w.z = pk_bf16(v1[0], v1[1]); w.w = pk_bf16(v1[2], v1[3]);
                        *(u32x4*)(dst + (size_t)(row0 + ai * 128 + m * 16) * DM + col0 + bj * 128) = w;
                    }
        }
    }
};
struct EpiRes {
    static constexpr bool PERM = false, AFTER_DRAIN = false, I8 = false;
    const float* res; float* Y;
    __device__ __forceinline__ void operator()(const pg8::f32x4 (&acc)[2][2][4][2], const pg8::Unit& u, int wr, int wc, int fr, int fq) const {
        const int row0 = u.pm * 256 + wr * 64 + fr, col0 = u.pn * 256 + wc * 32 + 4 * fq;
#pragma unroll
        for (int ai = 0; ai < 2; ++ai)
#pragma unroll
            for (int m = 0; m < 4; ++m) {
                const size_t off = (size_t)(row0 + ai * 128 + m * 16) * DM + col0;
#pragma unroll
                for (int bj = 0; bj < 2; ++bj)
#pragma unroll
                    for (int n = 0; n < 2; ++n) {
                        const f32x4 r = *(const f32x4*)(res + off + bj * 128 + n * 16);
                        *(f32x4*)(Y + off + bj * 128 + n * 16) = r * ALPHA + acc[ai][bj][m][n];
                    }
            }
    }
};
template <bool Q8> struct EpiF32_ {
    static constexpr bool PERM = false, AFTER_DRAIN = false, I8 = Q8;
    float* C; int ldc; const float* SA; const float* SB;
    __device__ __forceinline__ void operator()(const pg8::f32x4 (&acc)[2][2][4][2], const pg8::Unit& u, int wr, int wc, int fr, int fq) const {
        const int row0 = u.pm * 256 + wr * 64 + fr, col0 = u.pn * 256 + wc * 32 + 4 * fq;
        float sa[2][4]; f32x4 sb[2][2];
#pragma unroll
        for (int ai = 0; ai < 2; ++ai)
#pragma unroll
            for (int m = 0; m < 4; ++m) sa[ai][m] = Q8 ? SA[row0 + ai * 128 + m * 16] : 1.0f;
#pragma unroll
        for (int bj = 0; bj < 2; ++bj)
#pragma unroll
            for (int n = 0; n < 2; ++n) sb[bj][n] = Q8 ? *(const f32x4*)(SB + col0 + bj * 128 + n * 16) : (f32x4){1.f, 1.f, 1.f, 1.f};
#pragma unroll
        for (int ai = 0; ai < 2; ++ai)
#pragma unroll
            for (int m = 0; m < 4; ++m) {
                const int row = row0 + ai * 128 + m * 16;
#pragma unroll
                for (int bj = 0; bj < 2; ++bj)
#pragma unroll
                    for (int n = 0; n < 2; ++n) {
                        f32x4 v = pg8::accf<Q8>(acc[ai][bj][m][n]);
                        if (Q8) v = v * sb[bj][n] * sa[ai][m];
                        *(f32x4*)(C + (size_t)row * ldc + col0 + bj * 128 + n * 16) = v;
                    }
            }
    }
};
typedef EpiF32_<false> EpiF32;
template <bool Q8> struct EpiKVQ_ {
    static constexpr bool PERM = true, AFTER_DRAIN = false, I8 = Q8;
    bf16_t* K; const float* SA; const float* SB;
    __device__ __forceinline__ void operator()(const pg8::f32x4 (&acc)[2][2][4][2], const pg8::Unit& u, int wr, int wc, int fr, int fq) const {
        const int t = u.pn >> 3;
        bf16_t* dst = K + (size_t)t * ((size_t)32 << 20);
        const int row0 = u.pm * 256 + wr * 64 + fr, col0 = (u.pn & 7) * 256 + wc * 32 + 8 * fq;
        float sa[2][4]; f32x4 sb[2][2];
#pragma unroll
        for (int ai = 0; ai < 2; ++ai)
#pragma unroll
            for (int m = 0; m < 4; ++m) sa[ai][m] = Q8 ? SA[row0 + ai * 128 + m * 16] : 1.0f;
#pragma unroll
        for (int bj = 0; bj < 2; ++bj)
#pragma unroll
            for (int n = 0; n < 2; ++n) sb[bj][n] = Q8 ? *(const f32x4*)(SB + u.pn * 256 + bj * 128 + wc * 32 + 8 * fq + 4 * n) : (f32x4){1.f, 1.f, 1.f, 1.f};
#pragma unroll
        for (int ai = 0; ai < 2; ++ai)
#pragma unroll
            for (int m = 0; m < 4; ++m)
#pragma unroll
                for (int bj = 0; bj < 2; ++bj) {
                    const int row = row0 + ai * 128 + m * 16;
                    f32x4 v0 = pg8::accf<Q8>(acc[ai][bj][m][0]), v1 = pg8::accf<Q8>(acc[ai][bj][m][1]);
                    if (Q8) { v0 = v0 * sb[bj][0] * sa[ai][m]; v1 = v1 * sb[bj][1] * sa[ai][m]; }
                    u32x4 w; w.x = pk_bf16(v0[0], v0[1]); w.y = pk_bf16(v0[2], v0[3]); w.z = pk_bf16(v1[0], v1[1]); w.w = pk_bf16(v1[2], v1[3]);
                    *(u32x4*)(dst + (size_t)row * DM + col0 + bj * 128) = w;
                }
    }
};
typedef EpiKVQ_<false> EpiKVQ;

template <bool Q8> struct EpiKVQR_ {
    static constexpr bool PERM = true, AFTER_DRAIN = false, I8 = Q8;
    bf16_t* K; const float* COS; const float* SIN; const float* SA; const float* SB;
    __device__ __forceinline__ void operator()(const pg8::f32x4 (&acc)[2][2][4][2], const pg8::Unit& u, int wr, int wc, int fr, int fq) const {
        const int t = u.pn >> 3;
        bf16_t* dst = K + (size_t)t * ((size_t)32 << 20);
        const int row0 = u.pm * 256 + wr * 64 + fr;
        const int g = 4 * wc + fq;
        const int col0 = (u.pn & 7) * 256 + wc * 32 + 8 * fq;
        float sa[2][4]; f32x4 sb[2][2];
#pragma unroll
        for (int ai = 0; ai < 2; ++ai)
#pragma unroll
            for (int m = 0; m < 4; ++m) sa[ai][m] = Q8 ? SA[row0 + ai * 128 + m * 16] : 1.0f;
#pragma unroll
        for (int bj = 0; bj < 2; ++bj)
#pragma unroll
            for (int n = 0; n < 2; ++n) sb[bj][n] = Q8 ? *(const f32x4*)(SB + u.pn * 256 + bj * 128 + wc * 32 + 8 * fq + 4 * n) : (f32x4){1.f, 1.f, 1.f, 1.f};
        if (t == 1) {
#pragma unroll
            for (int ai = 0; ai < 2; ++ai)
#pragma unroll
                for (int m = 0; m < 4; ++m)
#pragma unroll
                    for (int bj = 0; bj < 2; ++bj) {
                        const int row = row0 + ai * 128 + m * 16;
                        f32x4 a = pg8::accf<Q8>(acc[ai][bj][m][0]), b = pg8::accf<Q8>(acc[ai][bj][m][1]);
                        if (Q8) { a = a * sb[bj][0] * sa[ai][m]; b = b * sb[bj][1] * sa[ai][m]; }
                        u32x4 w; w.x = pk_bf16(a[0], a[1]); w.y = pk_bf16(a[2], a[3]); w.z = pk_bf16(b[0], b[1]); w.w = pk_bf16(b[2], b[3]);
                        *(u32x4*)(dst + (size_t)row * DM + col0 + bj * 128) = w;
                    }
        } else {
            const int pos0 = row0 & (SEQ - 1);
            f32x4 c = *(const f32x4*)(COS + pos0 * 64 + 4 * g), s_ = *(const f32x4*)(SIN + pos0 * 64 + 4 * g);
            const f32x4 c16 = *(const f32x4*)(COS + 16 * 64 + 4 * g), s16 = *(const f32x4*)(SIN + 16 * 64 + 4 * g), c128 = *(const f32x4*)(COS + 128 * 64 + 4 * g), s128 = *(const f32x4*)(SIN + 128 * 64 + 4 * g);
#pragma unroll
            for (int q = 0; q < 8; ++q) {
                const int ai = q >> 2, m = ai ? 7 - q : q;
#pragma unroll
                for (int bj = 0; bj < 2; ++bj) {
                    f32x4 a = pg8::accf<Q8>(acc[ai][bj][m][0]), b = pg8::accf<Q8>(acc[ai][bj][m][1]);
                    if (Q8) { a = a * sb[bj][0] * sa[ai][m]; b = b * sb[bj][1] * sa[ai][m]; }
                    u32x2 w1, w2;
                    w1.x = pk_bf16(a[0] * c[0] - b[0] * s_[0], a[1] * c[1] - b[1] * s_[1]); w1.y = pk_bf16(a[2] * c[2] - b[2] * s_[2], a[3] * c[3] - b[3] * s_[3]);
                    w2.x = pk_bf16(a[0] * s_[0] + b[0] * c[0], a[1] * s_[1] + b[1] * c[1]); w2.y = pk_bf16(a[2] * s_[2] + b[2] * c[2], a[3] * s_[3] + b[3] * c[3]);
                    bf16_t* p = dst + (size_t)(row0 + ai * 128 + m * 16) * DM + ((u.pn & 7) * 2 + bj) * 128 + 4 * g;
                    *(u32x2*)p = w1; *(u32x2*)(p + 64) = w2;
                }
                if (q < 3) { const f32x4 cn = c * c16 - s_ * s16, sn = s_ * c16 + c * s16; c = cn; s_ = sn; }
                else if (q == 3) { const f32x4 cn = c * c128 - s_ * s128, sn = s_ * c128 + c * s128; c = cn; s_ = sn; }
                else if (q < 7) { const f32x4 cn = c * c16 + s_ * s16, sn = s_ * c16 - c * s16; c = cn; s_ = sn; }
            }
        }
    }
};

__host__ __device__ __forceinline__ int rot_pos(int d) { return d < 64 ? 8 * (d >> 2) + (d & 3) : 8 * ((d - 64) >> 2) + 4 + (d & 3); }
__device__ __forceinline__ void transpose_tiles(LAS float* tile, const float* src, int ldn, int K, int N, bf16_t* dst, int nperm = 0) {
    const int tid = threadIdx.x;
    const int tn = N / 64, ntiles = tn * (K / 64);
    f32x4 nx[2];
#define TT_LOAD(tI_) { const int k0_ = ((tI_) / tn) * 64, n0_ = ((tI_) % tn) * 64; _Pragma("unroll") for (int r = 0; r < 2; ++r) nx[r] = *(const f32x4*)(src + (size_t)(k0_ + (tid >> 4) + 32 * r) * ldn + n0_ + (tid & 15) * 4); }
    if ((int)blockIdx.x < ntiles) TT_LOAD((int)blockIdx.x)
    for (int tI = blockIdx.x; tI < ntiles; tI += gridDim.x) {
        const int k0 = (tI / tn) * 64, n0 = (tI % tn) * 64;
        const f32x4 c0 = nx[0], c1 = nx[1];
        if (tI + (int)gridDim.x < ntiles) TT_LOAD(tI + (int)gridDim.x)
#pragma unroll
        for (int r = 0; r < 2; ++r) {
            const int kk = (tid >> 4) + 32 * r, nn = (tid & 15) * 4;
            const f32x4 v = r == 0 ? c0 : c1;
            tile[kk * 65 + nn + 0] = v[0]; tile[kk * 65 + nn + 1] = v[1]; tile[kk * 65 + nn + 2] = v[2]; tile[kk * 65 + nn + 3] = v[3];
        }
        __syncthreads();
        {
            const int nn = tid >> 3, kk8 = (tid & 7) * 8;
            float f[8];
#pragma unroll
            for (int j = 0; j < 8; ++j) f[j] = tile[(kk8 + j) * 65 + nn];
            u32x4 w; w.x = pk_bf16(f[0], f[1]); w.y = pk_bf16(f[2], f[3]); w.z = pk_bf16(f[4], f[5]); w.w = pk_bf16(f[6], f[7]);
            const int nsrc = n0 + nn, nrow = nsrc < nperm ? (nsrc & ~127) + rot_pos(nsrc & 127) : nsrc;
            *(u32x4*)(dst + (size_t)nrow * K + k0 + kk8) = w;
        }
        __syncthreads();
    }
}
#undef TT_LOAD
__device__ __forceinline__ void convert_bf16(const float* src, bf16_t* dst, size_t n) {
    const size_t stride = (size_t)gridDim.x * 512 * 8;
    for (size_t i = ((size_t)blockIdx.x * 512 + threadIdx.x) * 8; i < n; i += stride) {
        const f32x4 a = *(const f32x4*)(src + i), b = *(const f32x4*)(src + i + 4);
        u32x4 w; w.x = pk_bf16(a[0], a[1]); w.y = pk_bf16(a[2], a[3]); w.z = pk_bf16(b[0], b[1]); w.w = pk_bf16(b[2], b[3]);
        *(u32x4*)(dst + i) = w;
    }
}
__device__ __forceinline__ void split8(const f32x4 x0, const f32x4 x1, bf16x8& hi, bf16x8& lo) {
    u32x4 h, l;
    h.x = pk_bf16(x0[0], x0[1]); h.y = pk_bf16(x0[2], x0[3]); h.z = pk_bf16(x1[0], x1[1]); h.w = pk_bf16(x1[2], x1[3]);
    l.x = pk_bf16(x0[0] - bflo(h.x), x0[1] - bfhi(h.x)); l.y = pk_bf16(x0[2] - bflo(h.y), x0[3] - bfhi(h.y)); l.z = pk_bf16(x1[0] - bflo(h.z), x1[1] - bfhi(h.z)); l.w = pk_bf16(x1[2] - bflo(h.w), x1[3] - bfhi(h.w));
    hi = __builtin_bit_cast(bf16x8, h); lo = __builtin_bit_cast(bf16x8, l);
}
__device__ __forceinline__ void fold_peer_keys(const float* w_query, const float* sub_keys, bf16_t* WcT) {
    const int lane = threadIdx.x & 63, gw = blockIdx.x * 8 + (threadIdx.x >> 6), nw = gridDim.x * 8, r32 = lane & 31, hh2 = lane >> 5;
    for (int wt = gw; wt < 8192; wt += nw) {
        const int item = wt >> 3, sub = wt & 7, keyt = sub & 3, kint = sub >> 2;
        const int l = item >> 9, rem = item & 511, hh = rem >> 5, kb = rem & 31, h = hh >> 1, half = hh & 1;
        const float* sk = sub_keys + (size_t)(((l * 2 + half) * 8 + h) * 128 + keyt * 32 + r32) * 128 + 8 * hh2;
        const float* wq = w_query + (size_t)l * DM * DM + (size_t)(kb * 64 + kint * 32 + r32) * DM + h * 256 + half * 128 + 8 * hh2;
        f32x16 acc;
#pragma unroll
        for (int i = 0; i < 16; ++i) acc[i] = 0.f;
#pragma unroll 1
        for (int kh = 0; kh < 2; ++kh) {
            f32x4 av[8], bv[8];
#pragma unroll
            for (int ks = 0; ks < 4; ++ks) { const int kk = 64 * kh + 16 * ks; av[2 * ks] = *(const f32x4*)(wq + kk); av[2 * ks + 1] = *(const f32x4*)(wq + kk + 4); bv[2 * ks] = *(const f32x4*)(sk + kk); bv[2 * ks + 1] = *(const f32x4*)(sk + kk + 4); }
#pragma unroll
            for (int ks = 0; ks < 4; ++ks) {
                bf16x8 ah, al, bh, bl;
                split8(av[2 * ks], av[2 * ks + 1], ah, al); split8(bv[2 * ks], bv[2 * ks + 1], bh, bl);
                acc = __builtin_amdgcn_mfma_f32_32x32x16_bf16(al, bh, acc, 0, 0, 0);
                acc = __builtin_amdgcn_mfma_f32_32x32x16_bf16(ah, bl, acc, 0, 0, 0);
                acc = __builtin_amdgcn_mfma_f32_32x32x16_bf16(ah, bh, acc, 0, 0, 0);
            }
        }
        bf16_t* o = WcT + (size_t)l * DM * DM + (size_t)(h * 256 + half * 128 + keyt * 32 + r32) * DM + kb * 64 + kint * 32 + 4 * hh2;
#pragma unroll
        for (int q = 0; q < 4; ++q) { u32x2 w; w.x = pk_bf16(acc[4 * q], acc[4 * q + 1]); w.y = pk_bf16(acc[4 * q + 2], acc[4 * q + 3]); *(u32x2*)(o + 8 * q) = w; }
    }
}

__device__ __forceinline__ void quant_rows(const float* src, unsigned char* dst, float* scl, int nrows) {
    const int lane = threadIdx.x & 63, gw = blockIdx.x * 8 + (threadIdx.x >> 6), nw = gridDim.x * 8;
    for (int row = gw; row < nrows; row += nw) {
        const float* p = src + (size_t)row * DM;
        f32x4 v[8];
#pragma unroll
        for (int i = 0; i < 2; ++i)
#pragma unroll
            for (int q = 0; q < 4; ++q) v[i * 4 + q] = *(const f32x4*)(p + 1024 * i + 16 * lane + 4 * q);
        float am = 0.f;
#pragma unroll
        for (int i = 0; i < 8; ++i) am = fmaxf(am, fmaxf(fmaxf(fabsf(v[i][0]), fabsf(v[i][1])), fmaxf(fabsf(v[i][2]), fabsf(v[i][3]))));
        am = fmaxf(wave_max(am), 1e-30f);
        const float inv = 127.0f / am;
        if (lane == 0) scl[row] = am * (1.0f / 127.0f);
#pragma unroll
        for (int i = 0; i < 2; ++i) {
            u32x4 w;
#pragma unroll
            for (int q = 0; q < 4; ++q) {
                const f32x4 t = v[i * 4 + q];
                const unsigned b0 = (unsigned)(int)(rintf(t[0] * inv) + 128.0f), b1 = (unsigned)(int)(rintf(t[1] * inv) + 128.0f), b2 = (unsigned)(int)(rintf(t[2] * inv) + 128.0f), b3 = (unsigned)(int)(rintf(t[3] * inv) + 128.0f);
                w[q] = b0 | (b1 << 8) | (b2 << 16) | (b3 << 24);
            }
            *(u32x4*)(dst + (size_t)row * DM + 1024 * i + 16 * lane) = w;
        }
    }
}
__device__ __forceinline__ void quant_transpose(LAS unsigned char* lds, const float* src, int ldn, int N, signed char* dst, float* scl, int nperm = 0) {
    const int tid = threadIdx.x, kg = tid >> 3, c4 = (tid & 7) * 4, wv = tid >> 6;
    LAS float* red = (LAS float*)lds;
    for (int sI = blockIdx.x; sI < N / 32; sI += gridDim.x) {
        const int n0 = sI * 32;
        f32x4 v[32];
        const float* p = src + (size_t)(kg * 32) * ldn + n0 + c4;
#pragma unroll
        for (int it = 0; it < 32; ++it) v[it] = *(const f32x4*)(p + (size_t)it * ldn);
        f32x4 am = {0.f, 0.f, 0.f, 0.f};
#pragma unroll
        for (int it = 0; it < 32; ++it)
#pragma unroll
            for (int j = 0; j < 4; ++j) am[j] = fmaxf(am[j], fabsf(v[it][j]));
#pragma unroll
        for (int o = 8; o <= 32; o <<= 1)
#pragma unroll
            for (int j = 0; j < 4; ++j) am[j] = fmaxf(am[j], __shfl_xor(am[j], o));
        if ((tid & 63) < 8) *(LAS f32x4*)(red + wv * 32 + c4) = am;
        __syncthreads();
#pragma unroll
        for (int w = 0; w < 8; ++w) { const f32x4 r = *(const LAS f32x4*)(red + w * 32 + c4);
#pragma unroll
            for (int j = 0; j < 4; ++j) am[j] = fmaxf(am[j], r[j]); }
#pragma unroll
        for (int j = 0; j < 4; ++j) {
            const float m = fmaxf(am[j], 1e-30f), inv = 127.0f / m;
            const int nsrc = n0 + c4 + j, nrow = nsrc < nperm ? (nsrc & ~127) + rot_pos(nsrc & 127) : nsrc;
            if (kg == 0) scl[nrow] = m * (1.0f / 127.0f);
            signed char* o = dst + (size_t)nrow * DM + kg * 32;
#pragma unroll
            for (int h = 0; h < 2; ++h) {
                u32x4 w;
#pragma unroll
                for (int d = 0; d < 4; ++d) {
                    unsigned bb = 0;
#pragma unroll
                    for (int e = 0; e < 4; ++e) bb |= ((unsigned)(int)rintf(v[h * 16 + d * 4 + e][j] * inv) & 0xffu) << (8 * e);
                    w[d] = bb;
                }
                *(u32x4*)(o + h * 16) = w;
            }
        }
        __syncthreads();
    }
}
__device__ __forceinline__ void quant_rows_s(const float* src, signed char* dst, float* scl, int nrows) {
    const int lane = threadIdx.x & 63, gw = blockIdx.x * 8 + (threadIdx.x >> 6), nw = gridDim.x * 8;
    for (int row = gw; row < nrows; row += nw) {
        const float* p = src + (size_t)row * DM;
        f32x4 v[8];
#pragma unroll
        for (int i = 0; i < 2; ++i)
#pragma unroll
            for (int q = 0; q < 4; ++q) v[i * 4 + q] = *(const f32x4*)(p + 1024 * i + 16 * lane + 4 * q);
        float am = 0.f;
#pragma unroll
        for (int i = 0; i < 8; ++i) am = fmaxf(am, fmaxf(fmaxf(fabsf(v[i][0]), fabsf(v[i][1])), fmaxf(fabsf(v[i][2]), fabsf(v[i][3]))));
        am = fmaxf(wave_max(am), 1e-30f);
        const float inv = 127.0f / am;
        if (lane == 0) scl[row] = am * (1.0f / 127.0f);
#pragma unroll
        for (int i = 0; i < 2; ++i) {
            u32x4 w;
#pragma unroll
            for (int q = 0; q < 4; ++q) {
                const f32x4 t = v[i * 4 + q];
                w[q] = ((unsigned)(int)rintf(t[0] * inv) & 0xffu) | (((unsigned)(int)rintf(t[1] * inv) & 0xffu) << 8) | (((unsigned)(int)rintf(t[2] * inv) & 0xffu) << 16) | (((unsigned)(int)rintf(t[3] * inv) & 0xffu) << 24);
            }
            *(u32x4*)(dst + (size_t)row * DM + 1024 * i + 16 * lane) = w;
        }
    }
}
__device__ __forceinline__ void quant_rows_bf16(const bf16_t* src, signed char* dst, float* scl, int nrows) {
    const int lane = threadIdx.x & 63, gw = blockIdx.x * 8 + (threadIdx.x >> 6), nw = gridDim.x * 8;
    for (int row = gw; row < nrows; row += nw) {
        u32x4 v[4];
#pragma unroll
        for (int i = 0; i < 4; ++i) v[i] = *(const u32x4*)(src + (size_t)row * DM + 512 * i + 8 * lane);
        float am = 0.f;
#pragma unroll
        for (int i = 0; i < 4; ++i)
#pragma unroll
            for (int d = 0; d < 4; ++d) am = fmaxf(am, fmaxf(fabsf(bflo(v[i][d])), fabsf(bfhi(v[i][d]))));
        am = fmaxf(wave_max(am), 1e-30f);
        const float inv = 127.0f / am;
        if (lane == 0) scl[row] = am * (1.0f / 127.0f);
#pragma unroll
        for (int i = 0; i < 4; ++i) {
            u32x2 w;
            w.x = ((unsigned)(int)rintf(bflo(v[i].x) * inv) & 0xffu) | (((unsigned)(int)rintf(bfhi(v[i].x) * inv) & 0xffu) << 8) | (((unsigned)(int)rintf(bflo(v[i].y) * inv) & 0xffu) << 16) | (((unsigned)(int)rintf(bfhi(v[i].y) * inv) & 0xffu) << 24);
            w.y = ((unsigned)(int)rintf(bflo(v[i].z) * inv) & 0xffu) | (((unsigned)(int)rintf(bfhi(v[i].z) * inv) & 0xffu) << 8) | (((unsigned)(int)rintf(bflo(v[i].w) * inv) & 0xffu) << 16) | (((unsigned)(int)rintf(bfhi(v[i].w) * inv) & 0xffu) << 24);
            *(u32x2*)(dst + (size_t)row * DM + 512 * i + 8 * lane) = w;
        }
    }
}
__device__ __forceinline__ void phase_prep(const Args& a, LAS unsigned char* lds) {
    unsigned char* ws = a.ws;
    LAS float* tile = (LAS float*)lds;
    quant_transpose(lds, a.in[1], 4 * DM, 4 * DM, (signed char*)(ws + WS_WIN), (float*)(ws + WS_SWIN));
    quant_transpose(lds, a.in[3], DM, DM, (signed char*)(ws + WS_WOUT), (float*)(ws + WS_SWOUT));
    quant_transpose(lds, a.in[5], 2 * DM, 2 * DM, (signed char*)(ws + WS_WKVQ), (float*)(ws + WS_SWKVQ), DM);
    quant_transpose(lds, a.in[6], DM, DM, (signed char*)(ws + WS_WKVQ) + (size_t)2 * DM * DM, (float*)(ws + WS_SWKVQ) + 2 * DM, DM);
    quant_transpose(lds, a.in[7], DM, DM, (signed char*)(ws + WS_WO), (float*)(ws + WS_SWO));
    fold_peer_keys(a.in[8], a.in[9], (bf16_t*)(ws + WS_WC));
    quant_rows_s(a.in[0], (signed char*)(ws + slot(0)), (float*)(ws + WS_XS0), MTOK);
    const int gtid = blockIdx.x * 512 + threadIdx.x, gthreads = gridDim.x * 512;
    float* COS = (float*)(ws + WS_COS); float* SIN = (float*)(ws + WS_SIN); float* LB = (float*)(ws + WS_LB);
    for (int i = gtid; i < SEQ * 64; i += gthreads) {
        const int pos = i >> 6, j = i & 63;
        double inv = 1.0; const double r = 0.86596432336006535;
        for (int q = 0; q < j; ++q) inv *= r;
        const float ang = (float)pos * (float)inv;
        const double x = (double)ang;
        const double n = __builtin_rint(x * 0.15915494309189535);
        const float rf = (float)__builtin_fma(-n, 6.283185307179586, x);
        COS[i] = cosf(rf); SIN[i] = sinf(rf);
    }
    for (int c = gtid; c < DM; c += gthreads) { const float l0 = a.in[4][c], l1 = a.in[4][DM + c]; LB[c] = 1.0f / (1.0f + expf(l1 - l0)); }
}

__device__ __forceinline__ void phase_scan_naive(const bf16_t* Q1, const float* LF, const bf16_t* I1, float* O) {
    const int lane = threadIdx.x & 63, gw = blockIdx.x * 8 + (threadIdx.x >> 6), nw = gridDim.x * 8;
    for (int item = gw; item < 2 * NHEAD * 128; item += nw) {
        const int bh = item >> 7, v = item & 127, b = bh >> 4, h = bh & 15;
        const size_t base = (size_t)b * SEQ * DM + h * 128;
        float S0 = 0.f, S1 = 0.f;
#pragma unroll 4
        for (int t = 0; t < SEQ; ++t) {
            const size_t ro = base + (size_t)t * DM;
            const float f0 = __expf(LF[ro + lane]), f1 = __expf(LF[ro + 64 + lane]);
            const float q0 = bf2f(Q1[ro + lane]), q1 = bf2f(Q1[ro + 64 + lane]);
            const float iv = bf2f(I1[ro + v]);
            S0 = f0 * S0 + (1.0f - f0) * iv; S1 = f1 * S1 + (1.0f - f1) * iv;
            const float p = wave_sum(q0 * S0 + q1 * S1);
            if (lane == 0) O[ro + v] = p;
        }
    }
}
__device__ __forceinline__ void phase_onorm(const float* O, const bf16_t* G1, const float* gnorm, bf16_t* OG) {
    const int lane = threadIdx.x & 63, gw = blockIdx.x * 8 + (threadIdx.x >> 6), nw = gridDim.x * 8;
    const float gn0 = gnorm[2 * lane], gn1 = gnorm[2 * lane + 1];
    for (int item = gw; item < MTOK * NHEAD; item += nw) {
        const size_t off = (size_t)item * 128 + 2 * lane;
        const float o0 = O[off], o1 = O[off + 1];
        const float ss = wave_sum(o0 * o0 + o1 * o1);
        const float r = rsqrtf(ss * (1.0f / 128.0f) + 1e-6f);
        const unsigned g = *(const unsigned*)(G1 + off);
        *(unsigned*)(OG + off) = pk_bf16(o0 * r * gn0 * bflo(g), o1 * r * gn1 * bfhi(g));
    }
}

__device__ __forceinline__ void ln_row_store(float (&v)[32], const float* g, const float* bta, float* outf, bf16_t* outb, int lane, signed char* outq = nullptr, float* outs = nullptr) {
    float s = 0.f;
#pragma unroll
    for (int i = 0; i < 32; ++i) s += v[i];
    const float mu = wave_sum(s) * (1.0f / DM);
    float q = 0.f;
#pragma unroll
    for (int i = 0; i < 32; ++i) { v[i] -= mu; q += v[i] * v[i]; }
    const float rstd = rsqrtf(wave_sum(q) * (1.0f / DM) + 1e-5f);
    float am = 0.f;
#pragma unroll
    for (int i = 0; i < 4; ++i) {
        const int c = 512 * i + 8 * lane;
        const f32x4 g0 = *(const f32x4*)(g + c), g1 = *(const f32x4*)(g + c + 4), b0 = *(const f32x4*)(bta + c), b1 = *(const f32x4*)(bta + c + 4);
        f32x4 o0, o1;
#pragma unroll
        for (int j = 0; j < 4; ++j) { o0[j] = v[i * 8 + j] * rstd * g0[j] + b0[j]; o1[j] = v[i * 8 + 4 + j] * rstd * g1[j] + b1[j]; v[i * 8 + j] = o0[j]; v[i * 8 + 4 + j] = o1[j]; am = fmaxf(am, fmaxf(fabsf(o0[j]), fabsf(o1[j]))); }
        if (outf) { *(f32x4*)(outf + c) = o0; *(f32x4*)(outf + c + 4) = o1; }
        if (outb) { u32x4 w; w.x = pk_bf16(o0[0], o0[1]); w.y = pk_bf16(o0[2], o0[3]); w.z = pk_bf16(o1[0], o1[1]); w.w = pk_bf16(o1[2], o1[3]); *(u32x4*)(outb + c) = w; }
    }
    if (outq) {
        am = fmaxf(wave_max(am), 1e-30f);
        const float inv = 127.0f / am;
        if (lane == 0) *outs = am * (1.0f / 127.0f);
#pragma unroll
        for (int i = 0; i < 4; ++i) {
            u32x2 w;
            w.x = ((unsigned)(int)rintf(v[i * 8 + 0] * inv) & 0xffu) | (((unsigned)(int)rintf(v[i * 8 + 1] * inv) & 0xffu) << 8) | (((unsigned)(int)rintf(v[i * 8 + 2] * inv) & 0xffu) << 16) | (((unsigned)(int)rintf(v[i * 8 + 3] * inv) & 0xffu) << 24);
            w.y = ((unsigned)(int)rintf(v[i * 8 + 4] * inv) & 0xffu) | (((unsigned)(int)rintf(v[i * 8 + 5] * inv) & 0xffu) << 8) | (((unsigned)(int)rintf(v[i * 8 + 6] * inv) & 0xffu) << 16) | (((unsigned)(int)rintf(v[i * 8 + 7] * inv) & 0xffu) << 24);
            *(u32x2*)(outq + 512 * i + 8 * lane) = w;
        }
    }
}
__device__ __forceinline__ void ln_row_store16(float (&v)[32], const float* g, const float* bta, float* outf, bf16_t* outb, int lane) {
    float s = 0.f;
#pragma unroll
    for (int i = 0; i < 32; ++i) s += v[i];
    const float mu = wave_sum(s) * (1.0f / DM);
    float q = 0.f;
#pragma unroll
    for (int i = 0; i < 32; ++i) { v[i] -= mu; q += v[i] * v[i]; }
    const float rstd = rsqrtf(wave_sum(q) * (1.0f / DM) + 1e-5f);
#pragma unroll
    for (int i = 0; i < 2; ++i) {
        const int c = 1024 * i + 16 * lane;
        f32x4 o[4];
#pragma unroll
        for (int qd = 0; qd < 4; ++qd) {
            const f32x4 gg = *(const f32x4*)(g + c + 4 * qd), bb = *(const f32x4*)(bta + c + 4 * qd);
#pragma unroll
            for (int j = 0; j < 4; ++j) o[qd][j] = v[16 * i + 4 * qd + j] * rstd * gg[j] + bb[j];
            *(f32x4*)(outf + c + 4 * qd) = o[qd];
        }
        if (outb) {
            u32x4 w0, w1;
            w0.x = pk_bf16(o[0][0], o[0][1]); w0.y = pk_bf16(o[0][2], o[0][3]); w0.z = pk_bf16(o[1][0], o[1][1]); w0.w = pk_bf16(o[1][2], o[1][3]);
            w1.x = pk_bf16(o[2][0], o[2][1]); w1.y = pk_bf16(o[2][2], o[2][3]); w1.z = pk_bf16(o[3][0], o[3][1]); w1.w = pk_bf16(o[3][2], o[3][3]);
            *(u32x4*)(outb + c) = w0; *(u32x4*)(outb + c + 8) = w1;
        }
    }
}
template <bool RES16> __device__ __forceinline__ void phase_ln(const bf16_t* Y, const void* RESv, const float* g, const float* bta, float* outf, bf16_t* outb, signed char* outq = nullptr, float* outs = nullptr) {
    const int lane = threadIdx.x & 63, gw = blockIdx.x * 8 + (threadIdx.x >> 6), nw = gridDim.x * 8;
    for (int row = gw; row < MTOK; row += nw) {
        float v[32];
        const bf16_t* p = Y + (size_t)row * DM;
#pragma unroll
        for (int i = 0; i < 4; ++i) {
            const u32x4 yw = *(const u32x4*)(p + 512 * i + 8 * lane);
            const f32x4 a = {bflo(yw.x), bfhi(yw.x), bflo(yw.y), bfhi(yw.y)}, b = {bflo(yw.z), bfhi(yw.z), bflo(yw.w), bfhi(yw.w)};
            f32x4 ra, rb;
            if (RES16) { const u32x4 w = *(const u32x4*)((const bf16_t*)RESv + (size_t)row * DM + 512 * i + 8 * lane); ra = (f32x4){bflo(w.x), bfhi(w.x), bflo(w.y), bfhi(w.y)}; rb = (f32x4){bflo(w.z), bfhi(w.z), bflo(w.w), bfhi(w.w)}; }
            else { const float* rp = (const float*)RESv + (size_t)row * DM; ra = *(const f32x4*)(rp + 512 * i + 8 * lane); rb = *(const f32x4*)(rp + 512 * i + 8 * lane + 4); }
#pragma unroll
            for (int j = 0; j < 4; ++j) { v[i * 8 + j] = a[j] + ALPHA * ra[j]; v[i * 8 + 4 + j] = b[j] + ALPHA * rb[j]; }
        }
        ln_row_store(v, g, bta, outf ? outf + (size_t)row * DM : nullptr, outb ? outb + (size_t)row * DM : nullptr, lane, outq ? outq + (size_t)row * DM : nullptr, outs ? outs + row : nullptr);
    }
}

__device__ __forceinline__ void wave_argmax(float& v, int& idx) {
#pragma unroll
    for (int o = 32; o >= 1; o >>= 1) {
        const float ov = __shfl_xor(v, o); const int oi = __shfl_xor(idx, o);
        if (ov > v || (ov == v && oi < idx)) { v = ov; idx = oi; }
    }
}
__device__ __forceinline__ unsigned fkey(float x) { const unsigned u = __float_as_uint(x); return u ^ (unsigned)(((int)u >> 31) | 0x80000000); }
__device__ __forceinline__ float funkey(unsigned k) { const unsigned u = (k & 0x80000000u) ? (k ^ 0x80000000u) : ~k; return __uint_as_float(u); }
__device__ __forceinline__ void sort16_insert(unsigned (&r)[16], unsigned v) {
#pragma unroll
    for (int i = 0; i < 16; ++i) { const unsigned m = r[i] > v ? r[i] : v; v = r[i] > v ? v : r[i]; r[i] = m; }
}
__device__ __forceinline__ void sort16_desc(unsigned (&x)[16]) {
#define CE(i_, j_) { const unsigned mx_ = x[i_] > x[j_] ? x[i_] : x[j_], mn_ = x[i_] > x[j_] ? x[j_] : x[i_]; x[i_] = mx_; x[j_] = mn_; }
    CE(0,1) CE(2,3) CE(0,2) CE(1,3) CE(1,2) CE(4,5) CE(6,7) CE(4,6) CE(5,7) CE(5,6) CE(0,4) CE(2,6) CE(2,4) CE(1,5) CE(3,7) CE(3,5) CE(1,2) CE(3,4) CE(5,6) CE(8,9) CE(10,11) CE(8,10) CE(9,11) CE(9,10) CE(12,13) CE(14,15) CE(12,14) CE(13,15) CE(13,14) CE(8,12) CE(10,14) CE(10,12) CE(9,13) CE(11,15) CE(11,13) CE(9,10) CE(11,12) CE(13,14) CE(0,8) CE(4,12) CE(4,8) CE(2,10) CE(6,14) CE(6,10) CE(2,4) CE(6,8) CE(10,12) CE(1,9) CE(5,13) CE(5,9) CE(3,11) CE(7,15) CE(7,11) CE(3,5) CE(7,9) CE(11,13) CE(1,2) CE(3,4) CE(5,6) CE(7,8) CE(9,10) CE(11,12) CE(13,14)
#undef CE
}
__device__ __forceinline__ void merge16_desc(unsigned (&r)[16], const unsigned (&s)[16]) {
#pragma unroll
    for (int i = 0; i < 16; ++i) r[i] = r[i] > s[15 - i] ? r[i] : s[15 - i];
#pragma unroll
    for (int st = 8; st >= 1; st >>= 1)
#pragma unroll
        for (int i = 0; i < 16; ++i)
            if ((i & st) == 0) { const unsigned mx_ = r[i] > r[i + st] ? r[i] : r[i + st], mn_ = r[i] > r[i + st] ? r[i + st] : r[i]; r[i] = mx_; r[i + st] = mn_; }
}
__device__ __forceinline__ void phase_topk(LAS unsigned char* lds, const float* SCT, int* EID, float* GATE) {
    LAS unsigned char* ib = lds + threadIdx.x * 32;
    for (int item = blockIdx.x * 512 + threadIdx.x; item < MTOK * 8; item += gridDim.x * 512) {
        const int h = item >> 14, tok = item & (MTOK - 1);
        const float* p = SCT + (size_t)(h * 256) * MTOK + tok;
        unsigned r1[16], r2[16];
#pragma unroll
        for (int i = 0; i < 16; ++i) { r1[i] = (fkey(p[(size_t)i * MTOK]) & ~0x7Fu) | (unsigned)i; r2[i] = (fkey(p[(size_t)(128 + i) * MTOK]) & ~0x7Fu) | (unsigned)i; }
        sort16_desc(r1); sort16_desc(r2);
#pragma unroll 1
        for (int g = 1; g < 8; ++g) {
            unsigned s1[16], s2[16];
#pragma unroll
            for (int i = 0; i < 16; ++i) { const int e = g * 16 + i; s1[i] = (fkey(p[(size_t)e * MTOK]) & ~0x7Fu) | (unsigned)e; s2[i] = (fkey(p[(size_t)(128 + e) * MTOK]) & ~0x7Fu) | (unsigned)e; }
            sort16_desc(s1); sort16_desc(s2);
            merge16_desc(r1, s1); merge16_desc(r2, s2);
        }
        float v1[16], v2[16];
#pragma unroll
        for (int i = 0; i < 16; ++i) { v1[i] = funkey(r1[i] & ~0x7Fu); v2[i] = funkey(r2[i] & ~0x7Fu); ib[i] = (unsigned char)(r1[i] & 0x7Fu); ib[16 + i] = (unsigned char)(r2[i] & 0x7Fu); }
#define CK(a_, b_) ((fkey(v1[a_] + v2[b_]) & ~0xFFu) | (unsigned)((a_) * 16 + (b_)))
        unsigned r3[16] = {CK(0, 0), CK(0, 1), CK(0, 2), CK(0, 3), CK(0, 4), CK(0, 5), CK(0, 6), CK(0, 7), CK(0, 8), CK(0, 9), CK(0, 10), CK(0, 11), CK(0, 12), CK(0, 13), CK(0, 14), CK(0, 15)};
        sort16_desc(r3);
        { unsigned sB[16] = {CK(1, 0), CK(1, 1), CK(1, 2), CK(1, 3), CK(1, 4), CK(1, 5), CK(1, 6), CK(1, 7), CK(2, 0), CK(2, 1), CK(2, 2), CK(2, 3), CK(2, 4), CK(3, 0), CK(3, 1), CK(3, 2)}; sort16_desc(sB); merge16_desc(r3, sB); }
        { unsigned sC[16] = {CK(3, 3), CK(4, 0), CK(4, 1), CK(4, 2), CK(5, 0), CK(5, 1), CK(6, 0), CK(6, 1), CK(7, 0), CK(7, 1), CK(8, 0), CK(9, 0), CK(10, 0), CK(11, 0), CK(12, 0), CK(13, 0)}; sort16_desc(sC); merge16_desc(r3, sC); }
        sort16_insert(r3, CK(14, 0)); sort16_insert(r3, CK(15, 0));
#undef CK
        const float mx = funkey(r3[0] & ~0xFFu);
        float ev[16]; float sum = 0.f;
#pragma unroll
        for (int i = 0; i < 16; ++i) { ev[i] = __expf(funkey(r3[i] & ~0xFFu) - mx); sum += ev[i]; }
        const float rs = 1.0f / sum;
        int eid[16];
#pragma unroll
        for (int i = 0; i < 16; ++i) { const unsigned f = r3[i] & 0xFFu; eid[i] = (int)ib[f >> 4] * 128 + (int)ib[16 + (f & 15u)]; }
        int* eo = EID + (size_t)tok * 128 + h * 16; float* go = GATE + (size_t)tok * 128 + h * 16;
#pragma unroll
        for (int q = 0; q < 4; ++q) {
            *(u32x4*)(eo + 4 * q) = (u32x4){(unsigned)eid[4 * q], (unsigned)eid[4 * q + 1], (unsigned)eid[4 * q + 2], (unsigned)eid[4 * q + 3]};
            *(f32x4*)(go + 4 * q) = (f32x4){ev[4 * q] * rs, ev[4 * q + 1] * rs, ev[4 * q + 2] * rs, ev[4 * q + 3] * rs};
        }
    }
}

__device__ __forceinline__ float gelu_erf(float x) { return 0.5f * x * (1.0f + erff(x * 0.70710678118654752f)); }
__device__ __forceinline__ float ub0(unsigned w) { return (float)(w & 0xffu); }
__device__ __forceinline__ float ub1(unsigned w) { return (float)((w >> 8) & 0xffu); }
__device__ __forceinline__ float ub2(unsigned w) { return (float)((w >> 16) & 0xffu); }
__device__ __forceinline__ float ub3(unsigned w) { return (float)(w >> 24); }
__device__ __forceinline__ void phase_peer(LAS unsigned char* lds, const float* X, const int* EID, const float* GATE, const unsigned char* U, const unsigned char* V, const float* USC, const float* VSC,
                                           const float* g, const float* bta, float* outf, bf16_t* outb) {
    const int lane = threadIdx.x & 63, wv = threadIdx.x >> 6, gw = blockIdx.x * 8 + wv, nw = gridDim.x * 8;
    LAS float* hb = (LAS float*)(lds + wv * 512);
    for (int tok = gw; tok < MTOK; tok += nw) {
        float x[32];
        const float* xp = X + (size_t)tok * DM;
#pragma unroll
        for (int i = 0; i < 2; ++i)
#pragma unroll
            for (int q = 0; q < 4; ++q) { const f32x4 t = *(const f32x4*)(xp + 1024 * i + 16 * lane + 4 * q); x[16 * i + 4 * q] = t[0]; x[16 * i + 4 * q + 1] = t[1]; x[16 * i + 4 * q + 2] = t[2]; x[16 * i + 4 * q + 3] = t[3]; }
        float sx = 0.f;
#pragma unroll
        for (int j = 0; j < 32; ++j) sx += x[j];
        const float d0 = -128.0f * sx;
        const int e0 = EID[(size_t)tok * 128 + lane], e1 = EID[(size_t)tok * 128 + 64 + lane];
        const float g0 = GATE[(size_t)tok * 128 + lane], g1 = GATE[(size_t)tok * 128 + 64 + lane];
        for (int bt = 0; bt < 16; ++bt) {
            float d[8];
#pragma unroll
            for (int r = 0; r < 8; ++r) {
                const int e = bt * 8 + r;
                const int idx = __builtin_amdgcn_readfirstlane(__shfl(bt < 8 ? e0 : e1, e & 63));
                const u32x4* up = (const u32x4*)(U + (size_t)idx * DM) + lane;
                float acc = d0;
#pragma unroll
                for (int i = 0; i < 2; ++i) {
                    const u32x4 w = up[i * 64];
                    acc += x[16 * i + 0] * ub0(w.x) + x[16 * i + 1] * ub1(w.x) + x[16 * i + 2] * ub2(w.x) + x[16 * i + 3] * ub3(w.x)
                         + x[16 * i + 4] * ub0(w.y) + x[16 * i + 5] * ub1(w.y) + x[16 * i + 6] * ub2(w.y) + x[16 * i + 7] * ub3(w.y)
                         + x[16 * i + 8] * ub0(w.z) + x[16 * i + 9] * ub1(w.z) + x[16 * i + 10] * ub2(w.z) + x[16 * i + 11] * ub3(w.z)
                         + x[16 * i + 12] * ub0(w.w) + x[16 * i + 13] * ub1(w.w) + x[16 * i + 14] * ub2(w.w) + x[16 * i + 15] * ub3(w.w);
                }
                d[r] = acc;
            }
            const bool b5 = lane & 32, b4 = lane & 16, b3 = lane & 8;
            float t4[4];
#pragma unroll
            for (int q = 0; q < 4; ++q) { const float keep = b5 ? d[4 + q] : d[q], send = b5 ? d[q] : d[4 + q]; t4[q] = keep + __shfl_xor(send, 32); }
            float t2[2];
#pragma unroll
            for (int q = 0; q < 2; ++q) { const float keep = b4 ? t4[2 + q] : t4[q], send = b4 ? t4[q] : t4[2 + q]; t2[q] = keep + __shfl_xor(send, 16); }
            float t1;
            { const float keep = b3 ? t2[1] : t2[0], send = b3 ? t2[0] : t2[1]; t1 = keep + __shfl_xor(send, 8); }
            t1 += __shfl_xor(t1, 4); t1 += __shfl_xor(t1, 2); t1 += __shfl_xor(t1, 1);
            if ((lane & 7) == 0) hb[bt * 8 + (lane >> 3 & 1) + 2 * (lane >> 4 & 1) + 4 * (lane >> 5 & 1)] = t1;
        }
        asm volatile("s_waitcnt lgkmcnt(0)" ::: "memory");
        const float h0 = hb[lane] * USC[e0], h1 = hb[64 + lane] * USC[e1];
        const float w0 = g0 * gelu_erf(h0) * VSC[e0], w1 = g1 * gelu_erf(h1) * VSC[e1];
        float wsum = wave_sum(w0 + w1);
        float y[32];
#pragma unroll
        for (int i = 0; i < 32; ++i) y[i] = 0.f;
#pragma unroll 8
        for (int e = 0; e < 128; ++e) {
            const int idx = __builtin_amdgcn_readfirstlane(__shfl(e < 64 ? e0 : e1, e & 63));
            const float wt = __shfl(e < 64 ? w0 : w1, e & 63);
            const u32x4* vp = (const u32x4*)(V + (size_t)idx * DM) + lane;
#pragma unroll
            for (int i = 0; i < 2; ++i) {
                const u32x4 w = vp[i * 64];
                y[16 * i + 0] += wt * ub0(w.x); y[16 * i + 1] += wt * ub1(w.x); y[16 * i + 2] += wt * ub2(w.x); y[16 * i + 3] += wt * ub3(w.x);
                y[16 * i + 4] += wt * ub0(w.y); y[16 * i + 5] += wt * ub1(w.y); y[16 * i + 6] += wt * ub2(w.y); y[16 * i + 7] += wt * ub3(w.y);
                y[16 * i + 8] += wt * ub0(w.z); y[16 * i + 9] += wt * ub1(w.z); y[16 * i + 10] += wt * ub2(w.z); y[16 * i + 11] += wt * ub3(w.z);
                y[16 * i + 12] += wt * ub0(w.w); y[16 * i + 13] += wt * ub1(w.w); y[16 * i + 14] += wt * ub2(w.w); y[16 * i + 15] += wt * ub3(w.w);
            }
        }
        const float corr = -128.0f * wsum;
#pragma unroll
        for (int i = 0; i < 32; ++i) y[i] = y[i] + corr + ALPHA * x[i];
        ln_row_store16(y, g, bta, outf + (size_t)tok * DM, outb ? outb + (size_t)tok * DM : nullptr, lane);
        asm volatile("s_waitcnt lgkmcnt(0)" ::: "memory");
    }
}

__device__ __forceinline__ int row_dot_i8(const u32x4 (&xq)[2], const unsigned char* rowp, int lane) {
    const u32x4* up = (const u32x4*)rowp + lane;
    int acc = 0;
#pragma unroll
    for (int i = 0; i < 2; ++i) {
        const u32x4 w = up[i * 64];
        acc = __builtin_amdgcn_sdot4((int)xq[i].x, (int)(w.x ^ 0x80808080u), acc, false); acc = __builtin_amdgcn_sdot4((int)xq[i].y, (int)(w.y ^ 0x80808080u), acc, false);
        acc = __builtin_amdgcn_sdot4((int)xq[i].z, (int)(w.z ^ 0x80808080u), acc, false); acc = __builtin_amdgcn_sdot4((int)xq[i].w, (int)(w.w ^ 0x80808080u), acc, false);
    }
    return acc;
}
__device__ __forceinline__ void peer_issue8(u32x4 (&seg)[8], const unsigned char* base, const u32x4 ia, const u32x4 ib) {
    seg[0] = *(const u32x4*)(base + (size_t)ia.x * DM); seg[1] = *(const u32x4*)(base + (size_t)ia.y * DM); seg[2] = *(const u32x4*)(base + (size_t)ia.z * DM); seg[3] = *(const u32x4*)(base + (size_t)ia.w * DM);
    seg[4] = *(const u32x4*)(base + (size_t)ib.x * DM); seg[5] = *(const u32x4*)(base + (size_t)ib.y * DM); seg[6] = *(const u32x4*)(base + (size_t)ib.z * DM); seg[7] = *(const u32x4*)(base + (size_t)ib.w * DM);
}
__device__ __forceinline__ void peer_dot8(int (&d)[8], const u32x4 (&seg)[8], const u32x4 xq) {
#pragma unroll
    for (int i = 0; i < 8; ++i) {
        int acc = __builtin_amdgcn_sdot4((int)xq.x, (int)(seg[i].x ^ 0x80808080u), 0, false);
        acc = __builtin_amdgcn_sdot4((int)xq.y, (int)(seg[i].y ^ 0x80808080u), acc, false);
        acc = __builtin_amdgcn_sdot4((int)xq.z, (int)(seg[i].z ^ 0x80808080u), acc, false);
        d[i] = __builtin_amdgcn_sdot4((int)xq.w, (int)(seg[i].w ^ 0x80808080u), acc, false);
    }
}
__device__ __forceinline__ void phase_peer_u(const signed char* XQ, const int* EID, const unsigned char* U, LAS int* HL  ) {
    const int lane = threadIdx.x & 63, wv = threadIdx.x >> 6, es = lane >> 3, cc = lane & 7;
    const bool b2 = cc & 4, b1 = cc & 2, b0 = cc & 1;
    const int nw = gridDim.x * 8, gw = blockIdx.x * 8 + wv, tpw = (MTOK + nw - 1) / nw, tbase = gw * tpw;
    int cnt = MTOK - tbase; cnt = cnt > tpw ? tpw : cnt;
    if (cnt <= 0) return;
    for (int i = lane; i < cnt * 128; i += 64) HL[i] = 0;
    asm volatile("s_waitcnt lgkmcnt(0)" ::: "memory");
    const int nit = 16 * cnt;
    const unsigned char* ub = U + cc * 16;
    u32x4 m0a, m0b, m0c, m0d, m0x, m1a, m1b, m1c, m1d, m1x, m2a, m2b, m2c, m2d, m2x; u32x4 sA[8], sB[8];
#define PU_LOAD(sl_, k_, A_, B_, C_, D_, X_) { const int* ep_ = EID + (size_t)(tbase + (k_)) * 128 + es * 16; A_ = *(const u32x4*)ep_; B_ = *(const u32x4*)(ep_ + 4); C_ = *(const u32x4*)(ep_ + 8); D_ = *(const u32x4*)(ep_ + 12); \
        X_ = *(const u32x4*)(XQ + (size_t)(tbase + (k_)) * DM + (sl_) * 128 + cc * 16); }
#define PU_NEXT(sl_, k_, sn_, kn_) { kn_ = (k_) + 1; sn_ = (sl_); if (kn_ == cnt) { kn_ = 0; ++sn_; } if (sn_ == 16) { sn_ = 15; kn_ = cnt - 1; } }
    int sl = 0, k = 0, sl1, k1, sl2, k2;
    PU_NEXT(sl, k, sl1, k1) PU_NEXT(sl1, k1, sl2, k2)
    PU_LOAD(sl, k, m0a, m0b, m0c, m0d, m0x)
    PU_LOAD(sl1, k1, m1a, m1b, m1c, m1d, m1x)
    peer_issue8(sA, ub + sl * 128, m0a, m0b);
    for (int it = 0; it < nit; ++it) {
        PU_LOAD(sl2, k2, m2a, m2b, m2c, m2d, m2x)
        peer_issue8(sB, ub + sl * 128, m0c, m0d);
        int dlo[8]; peer_dot8(dlo, sA, m0x);
        peer_issue8(sA, ub + sl1 * 128, m1a, m1b);
        int dhi[8]; peer_dot8(dhi, sB, m0x);
        int t8[8], t4[4], t2[2];
#pragma unroll
        for (int q = 0; q < 8; ++q) { const int keep = b2 ? dhi[q] : dlo[q], send = b2 ? dlo[q] : dhi[q]; t8[q] = keep + __shfl_xor(send, 4); }
#pragma unroll
        for (int q = 0; q < 4; ++q) { const int keep = b1 ? t8[4 + q] : t8[q], send = b1 ? t8[q] : t8[4 + q]; t4[q] = keep + __shfl_xor(send, 2); }
#pragma unroll
        for (int q = 0; q < 2; ++q) { const int keep = b0 ? t4[2 + q] : t4[q], send = b0 ? t4[q] : t4[2 + q]; t2[q] = keep + __shfl_xor(send, 1); }
        { LAS int* hp = HL + k * 128 + es * 16 + (b2 ? 8 : 0) + (b1 ? 4 : 0) + (b0 ? 2 : 0);
          __hip_atomic_fetch_add(hp, t2[0], __ATOMIC_RELAXED, __HIP_MEMORY_SCOPE_WORKGROUP); __hip_atomic_fetch_add(hp + 1, t2[1], __ATOMIC_RELAXED, __HIP_MEMORY_SCOPE_WORKGROUP); }
        sl = sl1; k = k1; sl1 = sl2; k1 = k2; PU_NEXT(sl1, k1, sl2, k2)
        m0a = m1a; m0b = m1b; m0c = m1c; m0d = m1d; m0x = m1x; m1a = m2a; m1b = m2b; m1c = m2c; m1d = m2d; m1x = m2x;
    }
#undef PU_LOAD
#undef PU_NEXT
}
__device__ __forceinline__ void phase_peer_w(const LAS int* HL, const float* XS, const int* EID, const float* GATE, const float* USC, const float* VSC, signed char* WQ, float* SW) {
    const int lane = threadIdx.x & 63, gw = blockIdx.x * 8 + (threadIdx.x >> 6), nw = gridDim.x * 8, tpw = (MTOK + nw - 1) / nw, tbase = gw * tpw;
    const int tend = tbase + tpw < MTOK ? tbase + tpw : MTOK;
    for (int tok = tbase; tok < tend; ++tok) {
        const int h0 = HL[(tok - tbase) * 128 + lane], h1 = HL[(tok - tbase) * 128 + 64 + lane];
        const int e0 = EID[(size_t)tok * 128 + lane], e1 = EID[(size_t)tok * 128 + 64 + lane];
        const float xs = XS[tok];
        const float w0 = GATE[(size_t)tok * 128 + lane] * gelu_erf((float)h0 * xs * USC[e0]) * VSC[e0];
        const float w1 = GATE[(size_t)tok * 128 + 64 + lane] * gelu_erf((float)h1 * xs * USC[e1]) * VSC[e1];
        const float am = fmaxf(wave_max(fmaxf(fabsf(w0), fabsf(w1))), 1e-30f), inv = 127.0f / am;
        WQ[(size_t)tok * 128 + lane] = (signed char)(int)rintf(w0 * inv); WQ[(size_t)tok * 128 + 64 + lane] = (signed char)(int)rintf(w1 * inv);
        if (lane == 0) SW[tok] = am * (1.0f / 127.0f);
    }
}
__device__ __forceinline__ void peer_dot4x4(int (&acc)[16], const u32x4 sa, const u32x4 sb, const u32x4 sc, const u32x4 sd, const unsigned w4) {
#pragma unroll
    for (int k = 0; k < 4; ++k) {
        const unsigned A = sa[k], B = sb[k], C = sc[k], D = sd[k];
        const unsigned p0 = __builtin_amdgcn_perm(B, A, 0x05010400u);
        const unsigned p1 = __builtin_amdgcn_perm(B, A, 0x07030602u);
        const unsigned p2 = __builtin_amdgcn_perm(D, C, 0x05010400u);
        const unsigned p3 = __builtin_amdgcn_perm(D, C, 0x07030602u);
        const unsigned t0 = __builtin_amdgcn_perm(p2, p0, 0x05040100u);
        const unsigned t1 = __builtin_amdgcn_perm(p2, p0, 0x07060302u);
        const unsigned t2 = __builtin_amdgcn_perm(p3, p1, 0x05040100u);
        const unsigned t3 = __builtin_amdgcn_perm(p3, p1, 0x07060302u);
        acc[4 * k + 0] = __builtin_amdgcn_sdot4((int)t0, (int)w4, acc[4 * k + 0], false);
        acc[4 * k + 1] = __builtin_amdgcn_sdot4((int)t1, (int)w4, acc[4 * k + 1], false);
        acc[4 * k + 2] = __builtin_amdgcn_sdot4((int)t2, (int)w4, acc[4 * k + 2], false);
        acc[4 * k + 3] = __builtin_amdgcn_sdot4((int)t3, (int)w4, acc[4 * k + 3], false);
    }
}
__device__ __forceinline__ void phase_peer_v(const bf16_t* X, const int* EID, const signed char* WQ, const float* SW, const unsigned char* V, float* Y) {
    const int lane = threadIdx.x & 63, wv = threadIdx.x >> 6, es = lane >> 3, cc = lane & 7;
    const bool b5 = lane & 32, b4 = lane & 16, b3 = lane & 8;
    const int nw = gridDim.x * 8, gw = blockIdx.x * 8 + wv, tpw = (MTOK + nw - 1) / nw, tbase = gw * tpw;
    int cnt = MTOK - tbase; cnt = cnt > tpw ? tpw : cnt;
    if (cnt <= 0) return;
    const int nit = 16 * cnt;
    const unsigned char* vb = V + cc * 16;
    const int colo = cc * 16 + (b5 ? 8 : 0) + (b4 ? 4 : 0) + (b3 ? 2 : 0);
    u32x4 m0c, m0d, m1a, m1b, m1c, m1d, m2a, m2b, m2c, m2d; u32x4 w0, w1; unsigned x0, x1; float c0, c1; u32x4 sA[8], sB[8];
#define PV_IDS(k_, A_, B_, C_, D_) { const size_t o_ = (size_t)(tbase + (k_)) * 128 + es * 16; A_ = *(const u32x4*)(EID + o_); B_ = *(const u32x4*)(EID + o_ + 4); C_ = *(const u32x4*)(EID + o_ + 8); D_ = *(const u32x4*)(EID + o_ + 12); }
#define PV_WX(sl_, k_, W_, X_, CS_) { W_ = *(const u32x4*)(WQ + (size_t)(tbase + (k_)) * 128 + es * 16); \
        X_ = *(const unsigned*)(X + (size_t)(tbase + (k_)) * DM + (sl_) * 128 + colo); CS_ = SW[tbase + (k_)]; }
#define PV_NEXT(sl_, k_, sn_, kn_) { kn_ = (k_) + 1; sn_ = (sl_); if (kn_ == cnt) { kn_ = 0; ++sn_; } if (sn_ == 16) { sn_ = 15; kn_ = cnt - 1; } }
    int sl = 0, k = 0, sl1, k1, sl2, k2;
    PV_NEXT(sl, k, sl1, k1) PV_NEXT(sl1, k1, sl2, k2)
    { u32x4 ta, tb; PV_IDS(k, ta, tb, m0c, m0d) PV_IDS(k1, m1a, m1b, m1c, m1d)
      PV_WX(sl, k, w0, x0, c0)
      peer_issue8(sA, vb + sl * 128, ta, tb); }
    for (int it = 0; it < nit; ++it) {
        PV_IDS(k2, m2a, m2b, m2c, m2d)
        peer_issue8(sB, vb + sl * 128, m0c, m0d);
        int ya[16];
#pragma unroll
        for (int j = 0; j < 16; ++j) ya[j] = 0;
        peer_dot4x4(ya, sA[0], sA[1], sA[2], sA[3], w0.x); peer_dot4x4(ya, sA[4], sA[5], sA[6], sA[7], w0.y);
        peer_issue8(sA, vb + sl1 * 128, m1a, m1b);
        PV_WX(sl1, k1, w1, x1, c1)
        peer_dot4x4(ya, sB[0], sB[1], sB[2], sB[3], w0.z); peer_dot4x4(ya, sB[4], sB[5], sB[6], sB[7], w0.w);
        int t8[8], t4[4], t2[2];
#pragma unroll
        for (int q = 0; q < 8; ++q) { const int keep = b5 ? ya[8 + q] : ya[q], send = b5 ? ya[q] : ya[8 + q]; t8[q] = keep + __shfl_xor(send, 32); }
#pragma unroll
        for (int q = 0; q < 4; ++q) { const int keep = b4 ? t8[4 + q] : t8[q], send = b4 ? t8[q] : t8[4 + q]; t4[q] = keep + __shfl_xor(send, 16); }
#pragma unroll
        for (int q = 0; q < 2; ++q) { const int keep = b3 ? t4[2 + q] : t4[q], send = b3 ? t4[q] : t4[2 + q]; t2[q] = keep + __shfl_xor(send, 8); }
        f32x2_t o; o[0] = (float)t2[0] * c0 + ALPHA * bflo(x0); o[1] = (float)t2[1] * c0 + ALPHA * bfhi(x0);
        *(f32x2_t*)(Y + (size_t)(tbase + k) * DM + sl * 128 + colo) = o;
        sl = sl1; k = k1; sl1 = sl2; k1 = k2; PV_NEXT(sl1, k1, sl2, k2)
        m0c = m1c; m0d = m1d; m1a = m2a; m1b = m2b; m1c = m2c; m1d = m2d;
        w0 = w1; x0 = x1; c0 = c1;
    }
#undef PV_IDS
#undef PV_WX
#undef PV_NEXT
}

__device__ __forceinline__ void rot8(const u32x4 lo, const u32x4 hi, const f32x4 c0, const f32x4 c1, const f32x4 s0, const f32x4 s1, float (&o1)[8], float (&o2)[8]) {
    const float a[8] = {bflo(lo.x), bfhi(lo.x), bflo(lo.y), bfhi(lo.y), bflo(lo.z), bfhi(lo.z), bflo(lo.w), bfhi(lo.w)};
    const float b[8] = {bflo(hi.x), bfhi(hi.x), bflo(hi.y), bfhi(hi.y), bflo(hi.z), bfhi(hi.z), bflo(hi.w), bfhi(hi.w)};
    const float c[8] = {c0[0], c0[1], c0[2], c0[3], c1[0], c1[1], c1[2], c1[3]}, sn[8] = {s0[0], s0[1], s0[2], s0[3], s1[0], s1[1], s1[2], s1[3]};
#pragma unroll
    for (int j = 0; j < 8; ++j) { o1[j] = a[j] * c[j] - b[j] * sn[j]; o2[j] = a[j] * sn[j] + b[j] * c[j]; }
}
__device__ __forceinline__ u32x4 pack8(const float (&o)[8]) { u32x4 w; w.x = pk_bf16(o[0], o[1]); w.y = pk_bf16(o[2], o[3]); w.z = pk_bf16(o[4], o[5]); w.w = pk_bf16(o[6], o[7]); return w; }
__device__ __forceinline__ void phase_kstat(LAS float* red, const bf16_t* KR, float* KMEAN, float* KNMAX) {
    const int tid = threadIdx.x, ch = tid & 7, rr = tid >> 3, wv = tid >> 6, lane = tid & 63;
    for (int item = blockIdx.x; item < 2 * NHEAD * 32; item += gridDim.x) {
        const int bh = item >> 5, j = item & 31, b = bh >> 4, h = bh & 15;
        float sm1[8], sm2[8]; float nmax = 0.f;
#pragma unroll
        for (int q = 0; q < 8; ++q) { sm1[q] = 0.f; sm2[q] = 0.f; }
        u32x4 lo[4], hi[4];
#pragma unroll
        for (int ps = 0; ps < 4; ++ps) { const size_t off = ((size_t)b * SEQ + j * 256 + ps * 64 + rr) * DM + h * 128 + ch * 8; lo[ps] = *(const u32x4*)(KR + off); hi[ps] = *(const u32x4*)(KR + off + 64); }
#pragma unroll
        for (int ps = 0; ps < 4; ++ps) {
            const float a[8] = {bflo(lo[ps].x), bfhi(lo[ps].x), bflo(lo[ps].y), bfhi(lo[ps].y), bflo(lo[ps].z), bfhi(lo[ps].z), bflo(lo[ps].w), bfhi(lo[ps].w)};
            const float c[8] = {bflo(hi[ps].x), bfhi(hi[ps].x), bflo(hi[ps].y), bfhi(hi[ps].y), bflo(hi[ps].z), bfhi(hi[ps].z), bflo(hi[ps].w), bfhi(hi[ps].w)};
            float nq = 0.f;
#pragma unroll
            for (int q = 0; q < 8; ++q) { sm1[q] += a[q]; sm2[q] += c[q]; nq += a[q] * a[q] + c[q] * c[q]; }
            nq += __shfl_xor(nq, 1); nq += __shfl_xor(nq, 2); nq += __shfl_xor(nq, 4);
            nmax = fmaxf(nmax, nq);
        }
#pragma unroll
        for (int q = 0; q < 8; ++q) {
            sm1[q] += __shfl_xor(sm1[q], 8); sm1[q] += __shfl_xor(sm1[q], 16); sm1[q] += __shfl_xor(sm1[q], 32);
            sm2[q] += __shfl_xor(sm2[q], 8); sm2[q] += __shfl_xor(sm2[q], 16); sm2[q] += __shfl_xor(sm2[q], 32);
        }
        nmax = wave_max(nmax);
        if (lane < 8) {
#pragma unroll
            for (int q = 0; q < 8; ++q) { red[wv * 128 + lane * 8 + q] = sm1[q]; red[wv * 128 + 64 + lane * 8 + q] = sm2[q]; }
        }
        if (lane == 0) red[1024 + wv] = nmax;
        __syncthreads();
        if (tid < 128) {
            float s2 = 0.f;
#pragma unroll
            for (int r = 0; r < 8; ++r) s2 += red[r * 128 + tid];
            KMEAN[(size_t)item * 128 + tid] = s2 * (1.0f / 256.0f);
        }
        if (tid == 0) {
            float m = 0.f;
#pragma unroll
            for (int r = 0; r < 8; ++r) m = fmaxf(m, red[1024 + r]);
            KNMAX[item] = sqrtf(m);
        }
        __syncthreads();
    }
}

__device__ __forceinline__ void top3_insert(float x, int m, float& v0, int& i0, float& v1, int& i1, float& v2, int& i2) {
    const bool c0 = x > v0 || (x == v0 && m < i0), c1 = x > v1 || (x == v1 && m < i1), c2 = x > v2 || (x == v2 && m < i2);
    v2 = c1 ? v1 : (c2 ? x : v2); i2 = c1 ? i1 : (c2 ? m : i2);
    v1 = c0 ? v0 : (c1 ? x : v1); i1 = c0 ? i0 : (c1 ? m : i1);
    v0 = c0 ? x : v0; i0 = c0 ? m : i0;
}
__device__ __forceinline__ void phase_sel(LAS unsigned char* lds, const bf16_t* QR, const float* KMEAN, unsigned short* SUB, int* CNT, int* ctr) {
    const int tid = threadIdx.x, lane = tid & 63, wv = tid >> 6, r32 = lane & 31, hh = lane >> 5;
    LAS unsigned short* bucket = (LAS unsigned short*)lds;
    LAS int* cnt = (LAS int*)(lds + 16384);
    const float NEG = -1e30f;
    if (blockIdx.x == 0 && tid == 0) *ctr = 0;
    for (int item = blockIdx.x; item < 2 * NHEAD * 32; item += gridDim.x) {
        const int bh = item >> 5, i = item & 31, b = bh >> 4, h = bh & 15;
        if (i == 0) continue;
        if (tid < 32) cnt[tid] = 0;
        __syncthreads();
        const float* kmp = KMEAN + ((size_t)bh * 32 + r32) * 128 + 8 * hh;
        const size_t tok = (size_t)b * SEQ + i * 256 + wv * 32 + r32;
        const bf16_t* qp = QR + tok * DM + h * 128 + 8 * hh;
        f32x16 S;
#pragma unroll
        for (int e = 0; e < 16; ++e) S[e] = 0.f;
#pragma unroll
        for (int s2 = 0; s2 < 8; ++s2) {
            const f32x4 ka = *(const f32x4*)(kmp + 16 * s2), kb = *(const f32x4*)(kmp + 16 * s2 + 4);
            const bf16x8 qf = *(const bf16x8*)(qp + 16 * s2);
            u32x4 hi, lo;
            hi.x = pk_bf16(ka[0], ka[1]); hi.y = pk_bf16(ka[2], ka[3]); hi.z = pk_bf16(kb[0], kb[1]); hi.w = pk_bf16(kb[2], kb[3]);
            lo.x = pk_bf16(ka[0] - bflo(hi.x), ka[1] - bfhi(hi.x)); lo.y = pk_bf16(ka[2] - bflo(hi.y), ka[3] - bfhi(hi.y));
            lo.z = pk_bf16(kb[0] - bflo(hi.z), kb[1] - bfhi(hi.z)); lo.w = pk_bf16(kb[2] - bflo(hi.w), kb[3] - bfhi(hi.w));
            S = __builtin_amdgcn_mfma_f32_32x32x16_bf16(__builtin_bit_cast(bf16x8, hi), qf, S, 0, 0, 0);
            S = __builtin_amdgcn_mfma_f32_32x32x16_bf16(__builtin_bit_cast(bf16x8, lo), qf, S, 0, 0, 0);
        }
        float v0 = -3e38f, v1 = -3e38f, v2 = -3e38f; int i0 = 99, i1 = 99, i2 = 99;
#pragma unroll
        for (int e = 0; e < 16; ++e) {
            const int m = (e & 3) + 8 * (e >> 2) + 4 * hh;
            const float x = m < i ? S[e] : NEG;
            top3_insert(x, m, v0, i0, v1, i1, v2, i2);
        }
        {
            const float pv0 = __shfl_xor(v0, 32), pv1 = __shfl_xor(v1, 32), pv2 = __shfl_xor(v2, 32);
            const int pi0 = __shfl_xor(i0, 32), pi1 = __shfl_xor(i1, 32), pi2 = __shfl_xor(i2, 32);
            top3_insert(pv0, pi0, v0, i0, v1, i1, v2, i2); top3_insert(pv1, pi1, v0, i0, v1, i1, v2, i2); top3_insert(pv2, pi2, v0, i0, v1, i1, v2, i2);
        }
        if (hh == 0) {
            const int tl = wv * 32 + r32;
            if (v0 > 0.5f * NEG) { const int p = __hip_atomic_fetch_add(cnt + i0, 1, __ATOMIC_RELAXED, __HIP_MEMORY_SCOPE_WORKGROUP); bucket[i0 * 256 + p] = (unsigned short)(tl | (0 << 8)); }
            if (v1 > 0.5f * NEG) { const int p = __hip_atomic_fetch_add(cnt + i1, 1, __ATOMIC_RELAXED, __HIP_MEMORY_SCOPE_WORKGROUP); bucket[i1 * 256 + p] = (unsigned short)(tl | (1 << 8)); }
            if (v2 > 0.5f * NEG) { const int p = __hip_atomic_fetch_add(cnt + i2, 1, __ATOMIC_RELAXED, __HIP_MEMORY_SCOPE_WORKGROUP); bucket[i2 * 256 + p] = (unsigned short)(tl | (2 << 8)); }
        }
        __syncthreads();
        for (int idx = tid; idx < 32 * 256; idx += 512) {
            const int j = idx >> 8, p = idx & 255;
            if (j < i && p < cnt[j]) SUB[(((size_t)bh * 32 + j) * 32 + i) * 256 + p] = bucket[idx];
        }
        if (tid < i) CNT[((size_t)bh * 32 + tid) * 32 + i] = cnt[tid];
        __syncthreads();
    }
}

__device__ __forceinline__ unsigned off_b(unsigned row, unsigned ch) { return 256u * row + 16u * (ch ^ (((row & 3u) << 2) | ((row >> 2) & 3u))); }
__device__ __forceinline__ unsigned pi32(unsigned m) { return (m & ~12u) | ((m & 4u) << 1) | ((m & 8u) >> 1); }
__device__ __forceinline__ bf16x8 tr_frag(LAS unsigned char* img, unsigned lane, unsigned c, unsigned ks) {
    const unsigned hh = lane >> 5, blk = (lane >> 4) & 1, q = (lane & 15) >> 2, p = lane & 3;
    const unsigned a0 = off_b(16 * ks + 8 * hh + q, 4 * c + 2 * blk + (p >> 1)) + 8 * (p & 1);
    const unsigned a1 = off_b(16 * ks + 8 * hh + 4 + q, 4 * c + 2 * blk + (p >> 1)) + 8 * (p & 1);
    const s16x4 lo = __builtin_amdgcn_ds_read_tr16_b64_v4i16((LAS s16x4*)(img + a0));
    const s16x4 hi = __builtin_amdgcn_ds_read_tr16_b64_v4i16((LAS s16x4*)(img + a1));
    bf16x8 r; r[0] = lo[0]; r[1] = lo[1]; r[2] = lo[2]; r[3] = lo[3]; r[4] = hi[0]; r[5] = hi[1]; r[6] = hi[2]; r[7] = hi[3];
    return r;
}
__device__ __forceinline__ void phase_att(LAS unsigned char* lds, const bf16_t* QR, const bf16_t* KR, const bf16_t* V, const float* KNMAX, const unsigned short* SUB, const int* CNT, int* ctr,
                                          bf16_t* P012, bf16_t* P3, float* LS) {
    const int tid = threadIdx.x, lane = tid & 63, wv = tid >> 6, r32 = lane & 31, hh = lane >> 5;
    LAS unsigned char* Kimg = lds;
    LAS unsigned char* Vimg = lds + 65536;
    LAS int* misc = (LAS int*)(lds + 131072);
    const float SCL2 = 0.08838834764831845f * 1.4426950408889634f;
    for (;;) {
        __syncthreads();
        if (tid == 0) misc[40] = __hip_atomic_fetch_add(ctr, 1, __ATOMIC_RELAXED, __HIP_MEMORY_SCOPE_AGENT);
        __syncthreads();
        const int item = misc[40];
        if (item >= 2 * NHEAD * 32) break;
        const int j = item >> 5, bh = item & 31, b = bh >> 4, h = bh & 15;
#pragma unroll
        for (int r = 0; r < 8; ++r) {
            const int idx = tid + 512 * r, row = idx >> 4, ch = idx & 15;
            const size_t g = ((size_t)b * SEQ + j * 256 + row) * DM + h * 128 + ch * 8;
            const u32x4 kv = *(const u32x4*)(KR + g), vv = *(const u32x4*)(V + g);
            *(LAS u32x4*)(Kimg + off_b(row, ch)) = kv; *(LAS u32x4*)(Vimg + off_b(row, ch)) = vv;
        }
        if (tid <= 32) { int pre = 0; for (int u = j + 1; u < tid; ++u) pre += CNT[((size_t)bh * 32 + j) * 32 + u]; misc[tid] = pre; }
        float kn = (lane < 32) ? KNMAX[bh * 32 + lane] : 0.f;
        kn = wave_max(kn);
        __syncthreads();
        const int total = misc[32], ntile = (256 + total + 31) >> 5;
        for (int tile = wv; tile < ntile; tile += 8) {
            const int gr = tile * 32 + r32;
            int pos, slot; bool valid = true;
            if (gr < 256) { pos = j * 256 + gr; slot = 3; }
            else {
                const int x = gr - 256; valid = x < total;
                int ii = j + 1;
                for (int u = j + 1; u < 32; ++u) if (misc[u] <= x) ii = u;
                if (valid) { const unsigned e = SUB[(((size_t)bh * 32 + j) * 32 + ii) * 256 + (x - misc[ii])]; pos = ii * 256 + (int)(e & 255u); slot = (int)(e >> 8); }
                else { pos = j * 256; slot = 3; }
            }
            const size_t tok = (size_t)b * SEQ + pos;
            bf16x8 qf[8];
            const bf16_t* qp = QR + tok * DM + h * 128 + 8 * hh;
#pragma unroll
            for (int s = 0; s < 8; ++s) qf[s] = *(const bf16x8*)(qp + 16 * s);
            float qn2 = 0.f;
#pragma unroll
            for (int s = 0; s < 8; ++s)
#pragma unroll
                for (int e = 0; e < 8; ++e) { const float f = bf2f((bf16_t)qf[s][e]); qn2 += f * f; }
            qn2 += __shfl_xor(qn2, 32);
            const float c2 = sqrtf(qn2) * kn * SCL2;
            f32x16 O[4];
#pragma unroll
            for (int dt = 0; dt < 4; ++dt)
#pragma unroll
                for (int e = 0; e < 16; ++e) O[dt][e] = 0.f;
            float l = 0.f;
            const bool own = tile < 8;
            const int kcn = own ? tile + 1 : 8;
            const unsigned krow = pi32((unsigned)r32);
            for (int kc = 0; kc < kcn; ++kc) {
                f32x16 S, S1;
#pragma unroll
                for (int e = 0; e < 16; ++e) { S[e] = 0.f; S1[e] = 0.f; }
#pragma unroll
                for (int s = 0; s < 8; s += 2) {
                    const bf16x8 kf = *(const LAS bf16x8*)(Kimg + off_b(32 * kc + krow, 2 * s + hh));
                    const bf16x8 kf1 = *(const LAS bf16x8*)(Kimg + off_b(32 * kc + krow, 2 * s + 2 + hh));
                    S = __builtin_amdgcn_mfma_f32_32x32x16_bf16(kf, qf[s], S, 0, 0, 0);
                    S1 = __builtin_amdgcn_mfma_f32_32x32x16_bf16(kf1, qf[s + 1], S1, 0, 0, 0);
                }
                float p[16];
                if (own) {
#pragma unroll
                    for (int e = 0; e < 16; ++e) {
                        const unsigned m = (e & 3) + 8 * (e >> 2) + 4 * hh;
                        const int key = j * 256 + 32 * kc + (int)pi32(m);
                        float pe = __builtin_amdgcn_exp2f((S[e] + S1[e]) * SCL2 - c2);
                        if (key > pos) pe = 0.f;
                        p[e] = pe; l += pe;
                    }
                } else {
#pragma unroll
                    for (int e = 0; e < 16; ++e) { const float pe = __builtin_amdgcn_exp2f((S[e] + S1[e]) * SCL2 - c2); p[e] = pe; l += pe; }
                }
                u32x4 w0, w1;
                w0.x = pk_bf16(p[0], p[1]); w0.y = pk_bf16(p[2], p[3]); w0.z = pk_bf16(p[4], p[5]); w0.w = pk_bf16(p[6], p[7]);
                w1.x = pk_bf16(p[8], p[9]); w1.y = pk_bf16(p[10], p[11]); w1.z = pk_bf16(p[12], p[13]); w1.w = pk_bf16(p[14], p[15]);
                const bf16x8 pf0 = __builtin_bit_cast(bf16x8, w0), pf1 = __builtin_bit_cast(bf16x8, w1);
#pragma unroll
                for (int dt = 0; dt < 4; ++dt) {
                    const bf16x8 v0 = tr_frag(Vimg, lane, dt, 2 * kc), v1 = tr_frag(Vimg, lane, dt, 2 * kc + 1);
                    O[dt] = __builtin_amdgcn_mfma_f32_32x32x16_bf16(v0, pf0, O[dt], 0, 0, 0);
                    O[dt] = __builtin_amdgcn_mfma_f32_32x32x16_bf16(v1, pf1, O[dt], 0, 0, 0);
                }
            }
            l += __shfl_xor(l, 32);
            if (valid) {
                bf16_t* pl = (slot < 3 ? P012 + (size_t)slot * ((size_t)32 << 20) : P3) + (tok * NHEAD + h) * 128 + 4 * hh;
#pragma unroll
                for (int dt = 0; dt < 4; ++dt)
#pragma unroll
                    for (int g = 0; g < 4; ++g) {
                        u32x2 w; w.x = pk_bf16(O[dt][4 * g], O[dt][4 * g + 1]); w.y = pk_bf16(O[dt][4 * g + 2], O[dt][4 * g + 3]);
                        *(u32x2*)(pl + 32 * dt + 8 * g) = w;
                    }
                if (hh == 0) LS[(size_t)slot * MTOK * NHEAD + tok * NHEAD + h] = l;
            }
        }
    }
}
__device__ __forceinline__ void phase_comb(LAS float* red, const bf16_t* P012, const bf16_t* P3, const float* LS, signed char* AO8, float* XSO) {
    const int tid = threadIdx.x, tsel = tid >> 8, hd = (tid & 255) >> 4, ch = tid & 15, wv = tid >> 6;
    u32x4 nw[4]; float nl[4];
#define CB_LOAD(pair_) { const size_t th_ = ((size_t)(2 * (pair_) + tsel)) * NHEAD + hd; nw[3] = *(const u32x4*)(P3 + th_ * 128 + ch * 8); nl[3] = LS[(size_t)3 * MTOK * NHEAD + th_]; \
        _Pragma("unroll") for (int s_ = 0; s_ < 3; ++s_) { nw[s_] = *(const u32x4*)(P012 + (size_t)s_ * ((size_t)32 << 20) + th_ * 128 + ch * 8); nl[s_] = LS[(size_t)s_ * MTOK * NHEAD + th_]; } }
    if ((int)blockIdx.x < MTOK / 2) CB_LOAD((int)blockIdx.x)
    int par = 0;
    for (int pair = blockIdx.x; pair < MTOK / 2; pair += gridDim.x, par ^= 1) {
        const int token = 2 * pair + tsel;
        const int t = token & (SEQ - 1), blk = t >> 8, nsel = blk < 3 ? blk : 3;
        float acc[8];
        float l = nl[3];
        { const u32x4 w = nw[3];
          acc[0] = bflo(w.x); acc[1] = bfhi(w.x); acc[2] = bflo(w.y); acc[3] = bfhi(w.y); acc[4] = bflo(w.z); acc[5] = bfhi(w.z); acc[6] = bflo(w.w); acc[7] = bfhi(w.w); }
#pragma unroll
        for (int s = 0; s < 3; ++s) {
            u32x4 w = nw[s]; float ls = nl[s];
            if (s >= nsel) { w = (u32x4){0u, 0u, 0u, 0u}; ls = 0.f; }
            acc[0] += bflo(w.x); acc[1] += bfhi(w.x); acc[2] += bflo(w.y); acc[3] += bfhi(w.y); acc[4] += bflo(w.z); acc[5] += bfhi(w.z); acc[6] += bflo(w.w); acc[7] += bfhi(w.w);
            l += ls;
        }
        if (pair + (int)gridDim.x < MTOK / 2) CB_LOAD(pair + (int)gridDim.x)
        const float rl = 1.0f / l;
        float am = 0.f;
#pragma unroll
        for (int j = 0; j < 8; ++j) { acc[j] *= rl; am = fmaxf(am, fabsf(acc[j])); }
        am = wave_max(am);
        if ((tid & 63) == 0) red[par * 8 + wv] = am;
        __syncthreads();
        am = fmaxf(fmaxf(fmaxf(red[par * 8 + 4 * tsel], red[par * 8 + 4 * tsel + 1]), fmaxf(red[par * 8 + 4 * tsel + 2], red[par * 8 + 4 * tsel + 3])), 1e-30f);
        const float inv = 127.0f / am;
        if ((tid & 255) == 0) XSO[token] = am * (1.0f / 127.0f);
        u32x2 o;
        o.x = ((unsigned)(int)rintf(acc[0] * inv) & 0xffu) | (((unsigned)(int)rintf(acc[1] * inv) & 0xffu) << 8) | (((unsigned)(int)rintf(acc[2] * inv) & 0xffu) << 16) | (((unsigned)(int)rintf(acc[3] * inv) & 0xffu) << 24);
        o.y = ((unsigned)(int)rintf(acc[4] * inv) & 0xffu) | (((unsigned)(int)rintf(acc[5] * inv) & 0xffu) << 8) | (((unsigned)(int)rintf(acc[6] * inv) & 0xffu) << 16) | (((unsigned)(int)rintf(acc[7] * inv) & 0xffu) << 24);
        *(u32x2*)(AO8 + (size_t)token * DM + hd * 128 + ch * 8) = o;
    }
#undef CB_LOAD
}


__device__ __forceinline__ void qrow_issue(f32x4 (&v)[8], const float* p, int lane) {
#pragma unroll
    for (int i = 0; i < 2; ++i)
#pragma unroll
        for (int q = 0; q < 4; ++q) v[i * 4 + q] = *(const f32x4*)(p + 1024 * i + 16 * lane + 4 * q);
}
__device__ __forceinline__ void qrow_finish(const f32x4 (&v)[8], unsigned char* dst, float* scl, int lane, bool sgn = false) {
    float am = 0.f;
#pragma unroll
    for (int i = 0; i < 8; ++i) am = fmaxf(am, fmaxf(fmaxf(fabsf(v[i][0]), fabsf(v[i][1])), fmaxf(fabsf(v[i][2]), fabsf(v[i][3]))));
    am = fmaxf(wave_max(am), 1e-30f);
    const float inv = 127.0f / am;
    if (lane == 0) *scl = am * (1.0f / 127.0f);
#pragma unroll
    for (int i = 0; i < 2; ++i) {
        u32x4 w;
#pragma unroll
        for (int q = 0; q < 4; ++q) {
            const f32x4 t = v[i * 4 + q];
            const float off = sgn ? 0.0f : 128.0f;
            const unsigned b0 = (unsigned)(int)(rintf(t[0] * inv) + off) & 0xffu, b1 = (unsigned)(int)(rintf(t[1] * inv) + off) & 0xffu, b2 = (unsigned)(int)(rintf(t[2] * inv) + off) & 0xffu, b3 = (unsigned)(int)(rintf(t[3] * inv) + off) & 0xffu;
            w[q] = b0 | (b1 << 8) | (b2 << 16) | (b3 << 24);
        }
        *(u32x4*)(dst + 1024 * i + 16 * lane) = w;
    }
}
struct QuantJob { const float* TU; const float* TV; unsigned char* QU; unsigned char* QV; float* SU; float* SV; };
__device__ __forceinline__ const float* qj_src(const QuantJob& q, int r) { return (r < 16384 ? q.TU : q.TV) + (size_t)(r & 16383) * DM; }
__device__ __forceinline__ unsigned char* qj_dst(const QuantJob& q, int r) { return (r < 16384 ? q.QU : q.QV) + (size_t)(r & 16383) * DM; }
__device__ __forceinline__ float* qj_scl(const QuantJob& q, int r) { return (r < 16384 ? q.SU : q.SV) + (r & 16383); }
__device__ __forceinline__ void qj_tail(const QuantJob& q, int done_iters) {
    const int lane = threadIdx.x & 63, gw = blockIdx.x * 8 + (threadIdx.x >> 6), nw = gridDim.x * 8;
    for (int r = gw + done_iters * nw; r < 32768; r += nw) { f32x4 v[8]; qrow_issue(v, qj_src(q, r), lane); qrow_finish(v, qj_dst(q, r), qj_scl(q, r), lane, r >= 16384); }
}
__device__ __forceinline__ float logf_gate(float z, float lb) { return __logf(lb + (1.0f - lb) * sigmoidf_(z)); }
__device__ __forceinline__ void phase_scan_a(LAS unsigned char* lds, const bf16_t* FZ, const float* LB, const bf16_t* I1, bf16_t* LT, float* DEC, const QuantJob qj, unsigned* dbgc = nullptr) {
    unsigned dbg_kt = 0, dbg_acc = 0;
    const int tid = threadIdx.x, lane = tid & 63, wv = tid >> 6, k = tid & 127, part = tid >> 7;
    LAS unsigned char* Iimg = lds; LAS unsigned char* KTimg = lds + 16384;
    LAS float* psum = (LAS float*)(lds + 32768);
    LAS unsigned char* Lst = lds + 36864;
#if SCAN_A_VALU == 2
    for (int item = blockIdx.x; item < 2 * NHEAD * 128; item += gridDim.x) {
        const int bh = item >> 7, c = item & 127, b = bh >> 4, h = bh & 15;
        const size_t tok0 = (size_t)b * SEQ + c * 64;
        for (int idx = tid; idx < 16384; idx += 512) {
            const int v = idx >> 7, kk = idx & 127;
            float g = 1.f, L = 0.f;
            for (int s2 = 63; s2 >= 0; --s2) { const size_t o = (tok0 + s2) * DM + h * 128; const float f = __expf(logf_gate(bf2f(FZ[o + kk]), LB[h * 128 + kk])); L += bf2f(I1[o + v]) * (1.0f - f) * g; g *= f; }
            LT[(size_t)item * 16384 + idx] = (bf16_t)(pk_bf16(L, 0.f) & 0xffffu);
        }
    }
    return;
#endif
    bf16_t nfz[16]; u32x4 nit_[2];
#define SA_LOAD(item_) { const int bh_ = (item_) >> 7, c_ = (item_) & 127; const size_t t0_ = (size_t)(bh_ >> 4) * SEQ + c_ * 64; const int h_ = bh_ & 15; \
        _Pragma("unroll") for (int i = 0; i < 16; ++i) nfz[i] = FZ[(t0_ + 16 * part + i) * DM + h_ * 128 + k]; \
        _Pragma("unroll") for (int r = 0; r < 2; ++r) { const int idx = tid + 512 * r, row = idx >> 4, ch = idx & 15; nit_[r] = *(const u32x4*)(I1 + (t0_ + row) * DM + h_ * 128 + ch * 8); } }
    if ((int)blockIdx.x < 2 * NHEAD * 128) SA_LOAD((int)blockIdx.x)
    int qiter = 0;
    for (int item = blockIdx.x; item < 2 * NHEAD * 128; item += gridDim.x, ++qiter) {
        const int bh = item >> 7, c = item & 127, b = bh >> 4, h = bh & 15;
        const size_t tok0 = (size_t)b * SEQ + c * 64;
        float lf[16];
        const float lbk = LB[h * 128 + k];
        unsigned fz2[8];
#pragma unroll
        for (int i = 0; i < 8; ++i) fz2[i] = (unsigned)nfz[2 * i] | ((unsigned)nfz[2 * i + 1] << 16);
#pragma unroll
        for (int r = 0; r < 2; ++r) { const int idx = tid + 512 * r, row = idx >> 4, ch = idx & 15; *(LAS u32x4*)(Iimg + off_b(row, ch)) = nit_[r]; }
        asm volatile("" ::: "memory");
        if (item + (int)gridDim.x < 2 * NHEAD * 128) SA_LOAD(item + (int)gridDim.x)
        const int qrow = qiter * (int)gridDim.x * 8 + (int)blockIdx.x * 8 + wv; const bool doq = qrow < 32768; f32x4 qv8[8];
        if (doq) qrow_issue(qv8, qj_src(qj, qrow), lane);
        asm volatile("" ::: "memory");
#pragma unroll
        for (int i = 0; i < 8; ++i) { lf[2 * i] = logf_gate(bflo(fz2[i]), lbk); lf[2 * i + 1] = logf_gate(bfhi(fz2[i]), lbk); }
        float cs = 0.f;
#pragma unroll
        for (int i = 0; i < 16; ++i) cs += lf[i];
        psum[part * 128 + k] = cs;
        __syncthreads();
        const float p0 = psum[k], p1 = psum[128 + k], p2 = psum[256 + k], p3 = psum[384 + k];
        const float blast = (p0 + p1) + (p2 + p3);
        float bb = part == 0 ? 0.f : (part == 1 ? p0 : (part == 2 ? p0 + p1 : p0 + p1 + p2));
#pragma unroll
        for (int i = 0; i < 16; ++i) {
            bb += lf[i];
            const float kt = (1.0f - __expf(lf[i])) * __expf(blast - bb);
            if (!(kt - kt == 0.f)) ++dbg_kt;
            const int srow = 16 * part + i;
            *(LAS bf16_t*)(KTimg + off_b(srow, k >> 3) + 2 * (k & 7)) = (bf16_t)(pk_bf16(kt, 0.f) & 0xffffu);
        }
        if (part == 0) DEC[(size_t)item * 128 + k] = __expf(blast);
        __syncthreads();
#if SCAN_A_VALU
        for (int idx = tid; idx < 16384; idx += 512) {
            const int v = idx >> 7, kk = idx & 127;
            float accv = 0.f;
            for (int s2 = 0; s2 < 64; ++s2) accv += bf2f(*(const LAS bf16_t*)(Iimg + off_b(s2, v >> 3) + 2 * (v & 7))) * bf2f(*(const LAS bf16_t*)(KTimg + off_b(s2, kk >> 3) + 2 * (kk & 7)));
            *(LAS bf16_t*)(Lst + v * 272 + 2 * kk) = (bf16_t)(pk_bf16(accv, 0.f) & 0xffffu);
        }
        if (0)
#endif
        {
            const int vt = wv >> 1;
            f32x16 acc0, acc1;
#pragma unroll
            for (int e = 0; e < 16; ++e) { acc0[e] = 0.f; acc1[e] = 0.f; }
#pragma unroll
            for (int ks = 0; ks < 4; ++ks) {
                const bf16x8 af = tr_frag(Iimg, lane, vt, ks);
                const bf16x8 b0 = tr_frag(KTimg, lane, 2 * (wv & 1), ks), b1 = tr_frag(KTimg, lane, 2 * (wv & 1) + 1, ks);
                acc0 = __builtin_amdgcn_mfma_f32_32x32x16_bf16(af, b0, acc0, 0, 0, 0);
                acc1 = __builtin_amdgcn_mfma_f32_32x32x16_bf16(af, b1, acc1, 0, 0, 0);
            }
            const int r32 = lane & 31, hh = lane >> 5;
#pragma unroll
            for (int e = 0; e < 16; ++e) {
                if (!(acc0[e] - acc0[e] == 0.f)) ++dbg_acc; if (!(acc1[e] - acc1[e] == 0.f)) ++dbg_acc;
                const int v = 32 * vt + (e & 3) + 8 * (e >> 2) + 4 * hh;
                *(LAS bf16_t*)(Lst + v * 272 + 2 * (64 * (wv & 1) + r32)) = (bf16_t)(pk_bf16(acc0[e], 0.f) & 0xffffu);
                *(LAS bf16_t*)(Lst + v * 272 + 2 * (64 * (wv & 1) + 32 + r32)) = (bf16_t)(pk_bf16(acc1[e], 0.f) & 0xffffu);
            }
        }
        __syncthreads();
#pragma unroll
        for (int r = 0; r < 4; ++r) { const int idx = tid + 512 * r, row = idx >> 4, ch = idx & 15; *(u32x4*)(LT + (size_t)item * 16384 + row * 128 + ch * 8) = *(const LAS u32x4*)(Lst + row * 272 + ch * 16); }
        if (doq) qrow_finish(qv8, qj_dst(qj, qrow), qj_scl(qj, qrow), lane, qrow >= 16384);
        __syncthreads();
    }
    qj_tail(qj, qiter);
    if (dbgc) { if (dbg_kt) atomicAdd(dbgc + 0, dbg_kt); if (dbg_acc) atomicAdd(dbgc + 1, dbg_acc); }
}
__device__ __forceinline__ void phase_scan_b(bf16_t* LT, const float* DEC, const QuantJob qj) {
    const int n = 2 * NHEAD * 128 * 32;
    const int lane = threadIdx.x & 63, gw = blockIdx.x * 8 + (threadIdx.x >> 6), nw = gridDim.x * 8;
    int qdone = 0;
    for (int idx = blockIdx.x * 512 + threadIdx.x; idx < n; idx += gridDim.x * 512) {
        const int bh = idx >> 12, vk = idx & 4095, k4 = (vk & 31) * 4;
        float S0 = 0.f, S1 = 0.f, S2 = 0.f, S3 = 0.f;
        bf16_t* p = LT + (size_t)bh * 128 * 16384 + (size_t)vk * 4;
        const float* dp = DEC + (size_t)bh * 128 * 128 + k4;
        for (int c8 = 0; c8 < 16; ++c8) {
            const int qrow = (qdone + c8) * nw + gw; const bool doq = qrow < 32768; f32x4 qv8[8];
            if (doq) qrow_issue(qv8, qj_src(qj, qrow), lane);
#pragma unroll
            for (int c2 = 0; c2 < 8; ++c2) {
                const int c = c8 * 8 + c2;
                const u32x2 w = *(const u32x2*)(p + (size_t)c * 16384);
                const f32x4 d = *(const f32x4*)(dp + c * 128);
                u32x2 o; o.x = pk_bf16(S0, S1); o.y = pk_bf16(S2, S3);
                *(u32x2*)(p + (size_t)c * 16384) = o;
                S0 = d[0] * S0 + bflo(w.x); S1 = d[1] * S1 + bfhi(w.x); S2 = d[2] * S2 + bflo(w.y); S3 = d[3] * S3 + bfhi(w.y);
            }
            if (doq) qrow_finish(qv8, qj_dst(qj, qrow), qj_scl(qj, qrow), lane, qrow >= 16384);
        }
        qdone += 16;
    }
    qj_tail(qj, qdone);
}
__device__ __forceinline__ void phase_scan_c(LAS unsigned char* lds, const bf16_t* Q1, const bf16_t* FZ, const float* LB, const bf16_t* I1, const bf16_t* G1, const bf16_t* SP, const float* gnorm, bf16_t* OG) {
    const int tid = threadIdx.x, lane = tid & 63, wv = tid >> 6, k = tid & 127, part = tid >> 7, r32 = lane & 31, hh = lane >> 5;
    LAS unsigned char* QTimg = lds; LAS unsigned char* QPimg = lds + 16384; LAS unsigned char* KPimg = lds + 32768; LAS unsigned char* Iimg = lds + 49152; LAS unsigned char* SPimg = lds + 65536;
    LAS float* psum = (LAS float*)(lds + 98304);
    LAS float* ssq = (LAS float*)(lds + 100352);
    LAS unsigned char* OT = lds + 102400;
    bf16_t nfz[16], nq[16]; u32x4 nit_[2], nsp[4], ngt[2];
#define SC_LOAD(item_) { const int bh_ = (item_) >> 7, c_ = (item_) & 127; const size_t t0_ = (size_t)(bh_ >> 4) * SEQ + c_ * 64; const int h_ = bh_ & 15; \
        _Pragma("unroll") for (int i = 0; i < 16; ++i) { const size_t o_ = (t0_ + 16 * part + i) * DM + h_ * 128 + k; nfz[i] = FZ[o_]; nq[i] = Q1[o_]; } \
        _Pragma("unroll") for (int r = 0; r < 2; ++r) { const int idx = tid + 512 * r, row = idx >> 4, ch = idx & 15; nit_[r] = *(const u32x4*)(I1 + (t0_ + row) * DM + h_ * 128 + ch * 8); ngt[r] = *(const u32x4*)(G1 + (t0_ + row) * DM + h_ * 128 + ch * 8); } \
        _Pragma("unroll") for (int r = 0; r < 4; ++r) { const int idx = tid + 512 * r, row = idx >> 4, ch = idx & 15; nsp[r] = *(const u32x4*)(SP + (size_t)(item_) * 16384 + row * 128 + ch * 8); } }
    if ((int)blockIdx.x < 2 * NHEAD * 128) SC_LOAD((int)blockIdx.x)
    for (int item = blockIdx.x; item < 2 * NHEAD * 128; item += gridDim.x) {
        const int bh = item >> 7, c = item & 127, b = bh >> 4, h = bh & 15;
        const size_t tok0 = (size_t)b * SEQ + c * 64;
        float lf[16], qv[16];
        const float lbk = LB[h * 128 + k];
        unsigned fzq[16];
#pragma unroll
        for (int i = 0; i < 16; ++i) fzq[i] = (unsigned)nfz[i] | ((unsigned)nq[i] << 16);
#pragma unroll
        for (int r = 0; r < 2; ++r) { const int idx = tid + 512 * r, row = idx >> 4, ch = idx & 15; *(LAS u32x4*)(Iimg + off_b(row, ch)) = nit_[r]; }
#pragma unroll
        for (int r = 0; r < 4; ++r) { const int idx = tid + 512 * r, row = idx >> 4, ch = idx & 15; *(LAS u32x4*)(SPimg + off_b(row, ch)) = nsp[r]; }
        const u32x4 gcur0 = ngt[0], gcur1 = ngt[1];
        asm volatile("" ::: "memory");
        if (item + (int)gridDim.x < 2 * NHEAD * 128) SC_LOAD(item + (int)gridDim.x)
        asm volatile("" ::: "memory");
#pragma unroll
        for (int i = 0; i < 16; ++i) { lf[i] = logf_gate(bflo(fzq[i]), lbk); const float qr = bfhi(fzq[i]); qv[i] = qr * sigmoidf_(qr); }
        float cs = 0.f;
#pragma unroll
        for (int i = 0; i < 16; ++i) cs += lf[i];
        psum[part * 128 + k] = cs;
        __syncthreads();
        const float p0 = psum[k], p1 = psum[128 + k], p2 = psum[256 + k];
        const float rr = p0 + p1;
        float bb = part == 0 ? 0.f : (part == 1 ? p0 : (part == 2 ? p0 + p1 : p0 + p1 + p2));
#pragma unroll
        for (int i = 0; i < 16; ++i) {
            bb += lf[i];
            const float qt = qv[i] * __expf(bb), qp = qv[i] * __expf(bb - rr), kp = (1.0f - __expf(lf[i])) * __expf(rr - bb);
            const unsigned o = off_b(16 * part + i, k >> 3) + 2 * (k & 7);
            *(LAS bf16_t*)(QTimg + o) = (bf16_t)(pk_bf16(qt, 0.f) & 0xffffu);
            *(LAS bf16_t*)(QPimg + o) = (bf16_t)(pk_bf16(qp, 0.f) & 0xffffu);
            *(LAS bf16_t*)(KPimg + o) = (bf16_t)(pk_bf16(kp, 0.f) & 0xffffu);
        }
        __syncthreads();
        const int tt = wv & 1, vt = wv >> 1;
        f32x16 O;
#pragma unroll
        for (int e = 0; e < 16; ++e) O[e] = 0.f;
#pragma unroll
        for (int ks = 0; ks < 8; ++ks) {
            const bf16x8 af = *(const LAS bf16x8*)(SPimg + off_b(32 * vt + r32, 2 * ks + hh));
            const bf16x8 bf = *(const LAS bf16x8*)(QTimg + off_b(32 * tt + r32, 2 * ks + hh));
            O = __builtin_amdgcn_mfma_f32_32x32x16_bf16(af, bf, O, 0, 0, 0);
        }
        const unsigned krow = pi32((unsigned)r32);
        for (int st = 0; st <= tt; ++st) {
            f32x16 S;
#pragma unroll
            for (int e = 0; e < 16; ++e) S[e] = 0.f;
#pragma unroll
            for (int ks = 0; ks < 8; ++ks) {
                const bf16x8 af = *(const LAS bf16x8*)(KPimg + off_b(32 * st + krow, 2 * ks + hh));
                const bf16x8 bf = *(const LAS bf16x8*)(QPimg + off_b(32 * tt + r32, 2 * ks + hh));
                S = __builtin_amdgcn_mfma_f32_32x32x16_bf16(af, bf, S, 0, 0, 0);
            }
            float p[16];
#pragma unroll
            for (int e = 0; e < 16; ++e) {
                const unsigned m = (e & 3) + 8 * (e >> 2) + 4 * hh;
                const int sidx = 32 * st + (int)pi32(m), tidx = 32 * tt + r32;
                p[e] = sidx <= tidx ? S[e] : 0.f;
            }
            u32x4 w0, w1;
            w0.x = pk_bf16(p[0], p[1]); w0.y = pk_bf16(p[2], p[3]); w0.z = pk_bf16(p[4], p[5]); w0.w = pk_bf16(p[6], p[7]);
            w1.x = pk_bf16(p[8], p[9]); w1.y = pk_bf16(p[10], p[11]); w1.z = pk_bf16(p[12], p[13]); w1.w = pk_bf16(p[14], p[15]);
            const bf16x8 pf0 = __builtin_bit_cast(bf16x8, w0), pf1 = __builtin_bit_cast(bf16x8, w1);
            const bf16x8 i0 = tr_frag(Iimg, lane, vt, 2 * st), i1 = tr_frag(Iimg, lane, vt, 2 * st + 1);
            O = __builtin_amdgcn_mfma_f32_32x32x16_bf16(i0, pf0, O, 0, 0, 0);
            O = __builtin_amdgcn_mfma_f32_32x32x16_bf16(i1, pf1, O, 0, 0, 0);
        }
        float sq = 0.f;
#pragma unroll
        for (int e = 0; e < 16; ++e) sq += O[e] * O[e];
        sq += __shfl_xor(sq, 32);
        if (hh == 0) ssq[vt * 64 + 32 * tt + r32] = sq;
        __syncthreads();
        const int tl = 32 * tt + r32;
        const float rstd = rsqrtf((ssq[tl] + ssq[64 + tl] + ssq[128 + tl] + ssq[192 + tl]) * (1.0f / 128.0f) + 1e-6f);
#pragma unroll
        for (int g = 0; g < 4; ++g) {
            const int v0 = 32 * vt + 8 * g + 4 * hh;
            const f32x4 gn = *(const f32x4*)(gnorm + v0);
            u32x2 w; w.x = pk_bf16(O[4 * g] * rstd * gn[0], O[4 * g + 1] * rstd * gn[1]); w.y = pk_bf16(O[4 * g + 2] * rstd * gn[2], O[4 * g + 3] * rstd * gn[3]);
            *(LAS u32x2*)(OT + tl * 272 + v0 * 2) = w;
        }
        __syncthreads();
#pragma unroll
        for (int r = 0; r < 2; ++r) {
            const int idx = tid + 512 * r, row = idx >> 4, ch = idx & 15;
            const u32x4 ov = *(const LAS u32x4*)(OT + row * 272 + ch * 16);
            const size_t go = (tok0 + row) * DM + h * 128 + ch * 8;
            const u32x4 gv = r == 0 ? gcur0 : gcur1;
            u32x4 w;
#define SILU_(x_) ((x_) * sigmoidf_(x_))
            w.x = pk_bf16(bflo(ov.x) * SILU_(bflo(gv.x)), bfhi(ov.x) * SILU_(bfhi(gv.x))); w.y = pk_bf16(bflo(ov.y) * SILU_(bflo(gv.y)), bfhi(ov.y) * SILU_(bfhi(gv.y)));
            w.z = pk_bf16(bflo(ov.z) * SILU_(bflo(gv.z)), bfhi(ov.z) * SILU_(bfhi(gv.z))); w.w = pk_bf16(bflo(ov.w) * SILU_(bflo(gv.w)), bfhi(ov.w) * SILU_(bfhi(gv.w)));
#undef SILU_
            *(u32x4*)(OG + go) = w;
        }
        __syncthreads();
    }
}


#if SCAN_DBG == 2
__device__ __forceinline__ void dbg_compare(LAS float* red, const bf16_t* A, const bf16_t* B, float* DBG) {
    float sd = 0.f, sr = 0.f, nn = 0.f;
    const size_t n = (size_t)MTOK * DM;
    for (size_t i = (size_t)blockIdx.x * 512 + threadIdx.x; i < n; i += (size_t)gridDim.x * 512) {
        const float x = bf2f(A[i]), y = bf2f(B[i]);
        if (!(x - x == 0.f)) nn += 1.f; else { sd += (x - y) * (x - y); sr += y * y; }
    }
    sd = wave_sum(sd); sr = wave_sum(sr); nn = wave_sum(nn);
    const int wv = threadIdx.x >> 6;
    if ((threadIdx.x & 63) == 0) { red[wv * 3] = sd; red[wv * 3 + 1] = sr; red[wv * 3 + 2] = nn; }
    __syncthreads();
    if (threadIdx.x == 0) { float a = 0, b = 0, c = 0; for (int w = 0; w < 8; ++w) { a += red[w * 3]; b += red[w * 3 + 1]; c += red[w * 3 + 2]; } DBG[blockIdx.x * 4] = a; DBG[blockIdx.x * 4 + 1] = b; DBG[blockIdx.x * 4 + 2] = c; }
    __syncthreads();
}
__device__ __forceinline__ void dbg_emit(const float* DBG, float* out) {
    float a = 0, b = 0, c = 0;
    for (int w = 0; w < (int)gridDim.x; ++w) { a += DBG[w * 4]; b += DBG[w * 4 + 1]; c += DBG[w * 4 + 2]; }
    const float rel = sqrtf(a / b);
    int k = (int)rintf(-2.0f * log10f(rel)); k = k < 0 ? 0 : (k > 16 ? 16 : k);
    if (c > 0.f) k = 17;
    const float cc = sqrtf(0.5f * (float)k);
    const size_t n = (size_t)MTOK * DM;
    for (size_t i = (size_t)blockIdx.x * 512 + threadIdx.x; i < n; i += (size_t)gridDim.x * 512) out[i] = cc;
}
#endif

#if SCAN_DBG == 3
__device__ __forceinline__ void dbg_count_bf16(const bf16_t* A, size_t n, unsigned* cnt) {
    unsigned c = 0;
    for (size_t i = (size_t)blockIdx.x * 512 + threadIdx.x; i < n; i += (size_t)gridDim.x * 512) { const float x = bf2f(A[i]); if (!(x - x == 0.f)) ++c; }
    if (c) atomicAdd(cnt, c);
}
__device__ __forceinline__ void dbg_count_f32(const float* A, size_t n, unsigned* cnt) {
    unsigned c = 0;
    for (size_t i = (size_t)blockIdx.x * 512 + threadIdx.x; i < n; i += (size_t)gridDim.x * 512) { const float x = A[i]; if (!(x - x == 0.f)) ++c; }
    if (c) atomicAdd(cnt, c);
}
__device__ __forceinline__ void dbg_emit3(const unsigned* cnt, float* out) {
    float code = 0.f;
    for (int st = 3; st >= 0; --st) { const unsigned c = cnt[st]; if (c) { float lg = log10f((float)c); lg = lg > 9.f ? 9.f : lg; code = (float)(st + 1) + 0.1f * lg; } }
    const float cc = sqrtf(code);
    const size_t n = (size_t)MTOK * DM;
    for (size_t i = (size_t)blockIdx.x * 512 + threadIdx.x; i < n; i += (size_t)gridDim.x * 512) out[i] = cc;
}
#endif

#if SCAN_DBG == 4 || SCAN_DBG == 6
__device__ __forceinline__ void dbg_compare4(LAS float* red, const bf16_t* A, const bf16_t* B, const bf16_t* C, float* DBG) {
    float sd = 0.f, sr = 0.f, nn = 0.f, mm = 0.f;
    const size_t n = (size_t)MTOK * DM;
    for (size_t i = (size_t)blockIdx.x * 512 + threadIdx.x; i < n; i += (size_t)gridDim.x * 512) {
        const float x = bf2f(A[i]), y = bf2f(B[i]);
        if (!(x - x == 0.f)) nn += 1.f; else { sd += (x - y) * (x - y); sr += y * y; }
        if (A[i] != C[i]) mm += 1.f;
    }
    sd = wave_sum(sd); sr = wave_sum(sr); nn = wave_sum(nn); mm = wave_sum(mm);
    const int wv = threadIdx.x >> 6;
    if ((threadIdx.x & 63) == 0) { red[wv * 4] = sd; red[wv * 4 + 1] = sr; red[wv * 4 + 2] = nn; red[wv * 4 + 3] = mm; }
    __syncthreads();
    if (threadIdx.x == 0) { float a = 0, b = 0, c = 0, d = 0; for (int w = 0; w < 8; ++w) { a += red[w * 4]; b += red[w * 4 + 1]; c += red[w * 4 + 2]; d += red[w * 4 + 3]; }
        DBG[blockIdx.x * 4] = a; DBG[blockIdx.x * 4 + 1] = b; DBG[blockIdx.x * 4 + 2] = c; DBG[blockIdx.x * 4 + 3] = d; }
    __syncthreads();
}
__device__ __forceinline__ void dbg_emit4(const float* DBG, float* out) {
    float a = 0, b = 0, c = 0, d = 0;
    for (int w = 0; w < (int)gridDim.x; ++w) { a += DBG[w * 4]; b += DBG[w * 4 + 1]; c += DBG[w * 4 + 2]; d += DBG[w * 4 + 3]; }
    const float rel = sqrtf(a / b);
    int k = (int)rintf(-log10f(rel)); k = k < 0 ? 0 : (k > 8 ? 8 : k);
#if SCAN_DBG == 6
    const float cc = sqrtf((float)k + ((d + c) > 0.f ? 0.5f : 0.f));
#else
    int m = (int)ceilf(log10f(1.0f + d + c)); m = m > 9 ? 9 : m;
    const float cc = sqrtf((float)k + 0.1f * (float)m);
#endif
    const size_t n = (size_t)MTOK * DM;
    for (size_t i = (size_t)blockIdx.x * 512 + threadIdx.x; i < n; i += (size_t)gridDim.x * 512) out[i] = cc;
}
#endif

#if SCAN_DBG == 5
__device__ __forceinline__ void dbg_lds16_test(LAS unsigned char* lds, unsigned* cnt) {
    const int tid = threadIdx.x;
    unsigned bad = 0;
    for (int rep = 0; rep < 64; ++rep) {
        for (int i = tid; i < 1024; i += 512) *(LAS u32x4*)(lds + i * 16) = (u32x4){0x7fc07fc0u, 0x7fc07fc0u, 0x7fc07fc0u, 0x7fc07fc0u};
        __syncthreads();
        const int k = tid & 127, part = tid >> 7;
#pragma unroll
        for (int i = 0; i < 16; ++i) {
            const int row = 16 * part + i;
            *(LAS bf16_t*)(lds + off_b(row, k >> 3) + 2 * (k & 7)) = (bf16_t)((row * 128 + k + rep) & 0x7fff);
        }
        __syncthreads();
        for (int idx = tid; idx < 64 * 128; idx += 512) {
            const int row = idx >> 7, kk = idx & 127;
            const bf16_t got = *(const LAS bf16_t*)(lds + off_b(row, kk >> 3) + 2 * (kk & 7));
            if (got != (bf16_t)((row * 128 + kk + rep) & 0x7fff)) ++bad;
        }
        __syncthreads();
    }
    if (bad) atomicAdd(cnt, bad);
}
__device__ __forceinline__ void dbg_emit5(const unsigned* cnt, float* out) {
    const unsigned c = cnt[0];
    float code = 0.f;
    if (c) { float lg = log10f((float)c); code = 1.0f + (lg > 8.9f ? 8.9f : lg); }
    const float cc = sqrtf(code);
    const size_t n = (size_t)MTOK * DM;
    for (size_t i = (size_t)blockIdx.x * 512 + threadIdx.x; i < n; i += (size_t)gridDim.x * 512) out[i] = cc;
}
#endif

#if SCAN_DBG == 6
__device__ __forceinline__ void dbg_check_a(LAS float* red, const float* LF, const bf16_t* I1, const bf16_t* LT, const bf16_t* LT2, float* DBG) {
    float sd = 0.f, sr = 0.f, mm = 0.f;
    const size_t n = (size_t)4096 * 16384;
    for (size_t i = (size_t)blockIdx.x * 512 + threadIdx.x; i < n; i += (size_t)gridDim.x * 512) {
        const int item = (int)(i >> 14), v = (int)((i >> 7) & 127), k = (int)(i & 127);
        const int bh = item >> 7, c = item & 127, b = bh >> 4, h = bh & 15;
        const size_t tok0 = (size_t)b * SEQ + c * 64;
        float g = 1.f, L = 0.f;
        for (int s2 = 63; s2 >= 0; --s2) {
            const size_t o = (tok0 + s2) * DM + h * 128;
            const float f = __expf(LF[o + k]);
            L += bf2f(I1[o + v]) * (1.0f - f) * g;
            g *= f;
        }
        const float x = bf2f(LT[i]);
        sd += (x - L) * (x - L); sr += L * L;
        if (LT[i] != LT2[i]) mm += 1.f;
    }
    sd = wave_sum(sd); sr = wave_sum(sr); mm = wave_sum(mm);
    const int wv = threadIdx.x >> 6;
    if ((threadIdx.x & 63) == 0) { red[wv * 4] = sd; red[wv * 4 + 1] = sr; red[wv * 4 + 2] = 0.f; red[wv * 4 + 3] = mm; }
    __syncthreads();
    if (threadIdx.x == 0) { float a = 0, b2 = 0, d = 0; for (int w = 0; w < 8; ++w) { a += red[w * 4]; b2 += red[w * 4 + 1]; d += red[w * 4 + 3]; }
        DBG[blockIdx.x * 4] = a; DBG[blockIdx.x * 4 + 1] = b2; DBG[blockIdx.x * 4 + 2] = 0.f; DBG[blockIdx.x * 4 + 3] = d; }
    __syncthreads();
}
#endif

#if SCAN_DBG == 7
#ifndef DBG_FAM
#define DBG_FAM 0
#endif
__device__ __forceinline__ void dbg_check_a7(const float* LF, const bf16_t* I1, const bf16_t* LT, float* DBG) {
    const size_t n = (size_t)4096 * 16384;
    float nbad = 0.f, nnf = 0.f;
    for (size_t i = (size_t)blockIdx.x * 512 + threadIdx.x; i < n; i += (size_t)gridDim.x * 512 * 8) {
        const int item = (int)(i >> 14), v = (int)((i >> 7) & 127), k = (int)(i & 127);
        const int bh = item >> 7, c = item & 127, b = bh >> 4, h = bh & 15;
        const size_t tok0 = (size_t)b * SEQ + c * 64;
        float g = 1.f, L = 0.f;
        for (int s2 = 63; s2 >= 0; --s2) {
            const size_t o = (tok0 + s2) * DM + h * 128;
            const float f = __expf(LF[o + k]);
            L += bf2f(I1[o + v]) * (1.0f - f) * g;
            g *= f;
        }
        const float x = bf2f(LT[i]);
        if (!(x - x == 0.f)) { nnf += 1.f; nbad += 1.f; }
        else if (fabsf(x - L) > 0.02f * fabsf(L) + 1e-2f) nbad += 1.f;
    }
    nbad = wave_sum(nbad); nnf = wave_sum(nnf);
    if ((threadIdx.x & 63) == 0) { atomicAdd(DBG, nbad); atomicAdd(DBG + 1, nnf); }
}
__device__ __forceinline__ void dbg_emit7(const float* DBG, float* out) {
    const float nb = DBG[0], nf = DBG[1];
    int A = nb == 0.f ? 0 : (nb <= 100.f ? 1 : (nb <= 1e4f ? 3 : (nb <= 1e6f ? 5 : 7)));
    int B = nf == 0.f ? 0 : 5;
    const float cc = sqrtf((float)A + 0.1f * (float)B);
    const size_t n = (size_t)MTOK * DM;
    for (size_t i = (size_t)blockIdx.x * 512 + threadIdx.x; i < n; i += (size_t)gridDim.x * 512) out[i] = cc;
}
#endif
__device__ __forceinline__ int opaque(int v) { asm volatile("" : "+s"(v)); return v; }
template <bool L1> __device__ __forceinline__ void run_gemm_out(const Args& a, LAS unsigned char* lds) {
    unsigned char* ws = a.ws;
    pg8::Gemm g{(const bf16_t*)(ws + (L1 ? slot(3) : slot(8))), (const bf16_t*)(ws + (L1 ? WS_WO : WS_WOUT)), opaque(MTOK), opaque(DM), opaque(DM / 2)};
    pg8::StaticOrder S; S.init(g.M, g.N, (int)gridDim.x, (int)blockIdx.x);
    EpiKVQ_<true> E{(bf16_t*)(ws + (L1 ? slot(4) : slot(1))), (const float*)(ws + WS_XSO), (const float*)(ws + (L1 ? WS_SWO : WS_SWOUT))};
    pg8::gemm_phase<EpiKVQ_<true>, pg8::StaticOrder>(lds, g, S, E, nullptr);
}
template <bool L1> __device__ __forceinline__ void run_ln(const Args& a) {
    unsigned char* ws = a.ws;
    phase_ln<L1>((const bf16_t*)(ws + (L1 ? slot(4) : slot(1))), L1 ? (const void*)(ws + slot(2)) : (const void*)a.in[0], a.in[12] + (L1 ? 2 : 0) * DM, a.in[13] + (L1 ? 2 : 0) * DM,
                 (float*)nullptr, (bf16_t*)(ws + (L1 ? slot(8) : slot(5))), (signed char*)(ws + WS_XQ), (float*)(ws + WS_XS));
}
template <bool L1> __device__ __forceinline__ void run_gemm_sc(const Args& a, LAS unsigned char* lds) {
    unsigned char* ws = a.ws;
#if SC8
    pg8::Gemm g{(const bf16_t*)(ws + WS_WC8 + (L1 ? (size_t)DM * DM : 0)), (const bf16_t*)(ws + WS_XQ), opaque(DM), opaque(MTOK), opaque(DM / 2)};
    pg8::StaticOrder S; S.init(g.M, g.N, (int)gridDim.x, (int)blockIdx.x);
    EpiF32_<true> E{(float*)(ws + (L1 ? slot(0) : slot(6))), MTOK, (const float*)(ws + WS_SWC) + (L1 ? DM : 0), (const float*)(ws + WS_XS)};
    pg8::gemm_phase<EpiF32_<true>, pg8::StaticOrder>(lds, g, S, E, nullptr);
#else
    pg8::Gemm g{(const bf16_t*)(ws + WS_WC) + (L1 ? (size_t)DM * DM : 0), (const bf16_t*)(ws + (L1 ? slot(8) : slot(5))), opaque(DM), opaque(MTOK), opaque(DM)};
    pg8::StaticOrder S; S.init(g.M, g.N, (int)gridDim.x, (int)blockIdx.x);
    EpiF32 E{(float*)(ws + (L1 ? slot(0) : slot(6))), MTOK, nullptr, nullptr};
    pg8::gemm_phase<EpiF32, pg8::StaticOrder>(lds, g, S, E, nullptr);
#endif
}
template <bool L1> __device__ __forceinline__ void run_topk(const Args& a, LAS unsigned char* lds) {
    unsigned char* ws = a.ws;
    phase_topk(lds, (const float*)(ws + (L1 ? slot(0) : slot(6))), (int*)(ws + WS_EID), (float*)(ws + WS_GATE));
}
template <bool L1> __device__ __forceinline__ void run_peer(const Args& a, LAS unsigned char* lds) {
    unsigned char* ws = a.ws;
    LAS int* HL = (LAS int*)(lds + (threadIdx.x >> 6) * 8192);
    float* Y = (float*)(ws + (L1 ? slot(0) : slot(6)));
    phase_peer_u((const signed char*)(ws + WS_XQ), (const int*)(ws + WS_EID), ws + WS_UB + (L1 ? (size_t)16384 * DM : 0), HL);
    asm volatile("s_waitcnt vmcnt(0) lgkmcnt(0)" ::: "memory");
    phase_peer_w(HL, (const float*)(ws + WS_XS), (const int*)(ws + WS_EID), (const float*)(ws + WS_GATE),
                 (const float*)(ws + WS_USC) + (L1 ? 16384 : 0), (const float*)(ws + WS_VSC) + (L1 ? 16384 : 0), (signed char*)(ws + WS_W), (float*)(ws + WS_CS));
    asm volatile("s_waitcnt vmcnt(0)" ::: "memory");
    phase_peer_v((const bf16_t*)(ws + (L1 ? slot(8) : slot(5))), (const int*)(ws + WS_EID), (const signed char*)(ws + WS_W), (const float*)(ws + WS_CS),
                 ws + WS_VB + (L1 ? (size_t)16384 * DM : 0), Y);
    asm volatile("s_waitcnt vmcnt(0)" ::: "memory");
    {
        const int lane = threadIdx.x & 63, gw = blockIdx.x * 8 + (threadIdx.x >> 6), nw = gridDim.x * 8, tpw = (MTOK + nw - 1) / nw, tbase = gw * tpw;
        const int tend = tbase + tpw < MTOK ? tbase + tpw : MTOK;
        const float* g = a.in[12] + (L1 ? 3 : 1) * DM; const float* bta = a.in[13] + (L1 ? 3 : 1) * DM;
        float* outf = L1 ? a.out : (float*)nullptr; bf16_t* outb = L1 ? (bf16_t*)nullptr : (bf16_t*)(ws + slot(2));
        for (int row = tbase; row < tend; ++row) {
            float v[32];
            const float* p = Y + (size_t)row * DM;
#pragma unroll
            for (int i = 0; i < 4; ++i) {
                const f32x4 x0 = *(const f32x4*)(p + 512 * i + 8 * lane), x1 = *(const f32x4*)(p + 512 * i + 8 * lane + 4);
#pragma unroll
                for (int j = 0; j < 4; ++j) { v[i * 8 + j] = x0[j]; v[i * 8 + 4 + j] = x1[j]; }
            }
            ln_row_store(v, g, bta, outf ? outf + (size_t)row * DM : nullptr, outb ? outb + (size_t)row * DM : nullptr, lane,
                         L1 ? (signed char*)nullptr : (signed char*)(ws + slot(1)) + (size_t)row * DM, L1 ? (float*)nullptr : (float*)(ws + WS_XS1) + row);
        }
    }
}


#define XB_TMO      128
#define XB_XCNT(j)  (256  + 64 * (j))
#define XB_XSUB(j)  (1280 + 64 * (j))
#define XB_XGEN(j)  (2304 + 64 * (j))
#define XB_TOP      3328
#define XB_TOPGEN   3392
#define XCD_BAR_WORDS 3456
#define XB_SPIN_CAP (1u << 20)
__device__ __forceinline__ unsigned xb_ld(unsigned* p)              { return __hip_atomic_load(p, __ATOMIC_RELAXED, __HIP_MEMORY_SCOPE_AGENT); }
__device__ __forceinline__ unsigned xb_add(unsigned* p, unsigned v) { return __hip_atomic_fetch_add(p, v, __ATOMIC_RELAXED, __HIP_MEMORY_SCOPE_AGENT); }
__device__ __forceinline__ unsigned xb_xcc_id() { return (unsigned)__builtin_amdgcn_s_getreg((3 << 11) | 20) & 0xFu; }
#define XB_SPIN(cond, bar) do { unsigned _sp = 0; while (cond) { __builtin_amdgcn_s_sleep(1); \
    if ((++_sp & 255u) == 0u) { if (xb_ld(&(bar)[XB_TMO])) break; if (_sp > XB_SPIN_CAP) { atomicAdd(&(bar)[XB_TMO], 1u); break; } } } } while (0)
struct XcdBarrier { unsigned* bar; unsigned x; volatile LAS unsigned* st; };
__device__ __forceinline__ XcdBarrier xcd_barrier_post(unsigned* bar, volatile LAS unsigned* st) {
    XcdBarrier b; b.bar = bar; b.x = xb_xcc_id(); b.st = st;
    if (threadIdx.x == 0) (void)xb_add(&bar[XB_XCNT(b.x)], 1u);
    return b;
}
__device__ __forceinline__ void xcd_barrier_complete(unsigned* bar, unsigned x, unsigned& nloc, unsigned& nx) {
    const unsigned G = gridDim.x * gridDim.y * gridDim.z;
    unsigned sum, cnt, mine, sp = 0u;
    for (;;) {
        sum = 0u; cnt = 0u; mine = 0u;
#pragma unroll
        for (unsigned j = 0; j < 16; ++j) { const unsigned c = xb_ld(&bar[XB_XCNT(j)]); sum += c; cnt += (c > 0u) ? 1u : 0u; mine = (j == x) ? c : mine; }
        if (sum == G) break;
        __builtin_amdgcn_s_sleep(1);
        if ((++sp & 255u) == 0u) { if (xb_ld(&bar[XB_TMO])) break; if (sp > XB_SPIN_CAP) { atomicAdd(&bar[XB_TMO], 1u); break; } }
    }
    nloc = mine > 0u ? mine : 1u; nx = cnt > 0u ? cnt : 1u;
}
__device__ __forceinline__ void xcd_barrier(const XcdBarrier& b) {
    asm volatile("s_waitcnt vmcnt(0)" ::: "memory");
    __syncthreads();
    if (threadIdx.x == 0) {
        unsigned* bar = b.bar;
        __builtin_amdgcn_s_waitcnt(0);
        unsigned nloc = b.st[0], nx = b.st[1];
        if (nloc == 0u) { xcd_barrier_complete(bar, b.x, nloc, nx); b.st[0] = nloc; b.st[1] = nx; }
        const unsigned old = xb_add(&bar[XB_XSUB(b.x)], 1u);
        const unsigned gen = old / nloc;
        if (old + 1u == (gen + 1u) * nloc) {
            __builtin_amdgcn_fence(__ATOMIC_RELEASE, "agent");
            asm volatile("s_waitcnt vmcnt(0)" ::: "memory");
            const unsigned og = xb_add(&bar[XB_TOP], 1u);
            const unsigned tg = og / nx;
            if (og + 1u == (tg + 1u) * nx) xb_add(&bar[XB_TOPGEN], 1u);
            else XB_SPIN(xb_ld(&bar[XB_TOPGEN]) == tg, bar);
            __builtin_amdgcn_fence(__ATOMIC_ACQUIRE, "agent");
            xb_add(&bar[XB_XGEN(b.x)], 1u);
            asm volatile("s_waitcnt vmcnt(0)" ::: "memory");
        } else {
            XB_SPIN(xb_ld(&bar[XB_XGEN(b.x)]) == gen, bar);
            __builtin_amdgcn_fence(__ATOMIC_ACQUIRE, "agent");
            asm volatile("s_waitcnt vmcnt(0)" ::: "memory");
        }
    }
    __syncthreads();
}

__global__ void __launch_bounds__(512, 2) mk_fwd(Args a) {
    extern __shared__ __attribute__((aligned(16))) unsigned char lds_raw[];
    LAS unsigned char* lds = (LAS unsigned char*)lds_raw;
    cg::grid_group grid = cg::this_grid();
    unsigned char* ws = a.ws;
#define PHASE_BEGIN(k) if (a.ph_lo <= (k) && (k) < a.ph_hi && EN(k)) {
    volatile LAS unsigned* xb_st = (volatile LAS unsigned*)(lds + LDS_BYTES - 16);
    if (threadIdx.x < 4) xb_st[threadIdx.x] = 0u;
    unsigned* xb_words = (unsigned*)(ws + WS_BAR);
    __syncthreads();
    XcdBarrier xbar = xcd_barrier_post(xb_words, xb_st);
    if (a.ph_lo < 0) grid.sync();
#define PHASE_END(k) if ((k) + 1 < a.ph_hi) xcd_barrier(xbar); }
    PHASE_BEGIN(0) phase_prep(a, lds);
#if SCAN_DBG == 3 || SCAN_DBG == 5
        if (blockIdx.x == 0 && threadIdx.x < 8) ((unsigned*)(ws + WS_CTR + 8192))[threadIdx.x] = 0u;
#endif
#if SCAN_DBG == 7
        if (blockIdx.x == 0 && threadIdx.x < 32) ((float*)(ws + WS_CTR + 4096))[threadIdx.x] = 0.f;
#endif
    PHASE_END(0)
#if SCAN_DBG == 5
    PHASE_BEGIN(1) dbg_lds16_test(lds, (unsigned*)(ws + WS_CTR + 8192)); PHASE_END(1)
#define SKIP_REST 1
#endif
    PHASE_BEGIN(1) {
        pg8::Gemm g{(const bf16_t*)(ws + slot(0)), (const bf16_t*)(ws + WS_WIN), opaque(MTOK), opaque(4 * DM), opaque(DM / 2)};
        pg8::StaticOrder S; S.init(g.M, g.N, (int)gridDim.x, (int)blockIdx.x);
        EpiKVQ_<true> E{(bf16_t*)(ws + slot(1)), (const float*)(ws + WS_XS0), (const float*)(ws + WS_SWIN)};
        pg8::gemm_phase<EpiKVQ_<true>, pg8::StaticOrder>(lds, g, S, E, nullptr);
    } PHASE_END(1)
    PHASE_BEGIN(2) quant_rows_bf16((const bf16_t*)(ws + WS_WC), (signed char*)(ws + WS_WC8), (float*)(ws + WS_SWC), 2 * DM);
        phase_scan_a(lds, (const bf16_t*)(ws + slot(2)), (const float*)(ws + WS_LB), (const bf16_t*)(ws + slot(3)), (bf16_t*)(ws + slot(6)), (float*)(ws + WS_DEC), QuantJob{a.in[10], a.in[11], ws + WS_UB, ws + WS_VB, (float*)(ws + WS_USC), (float*)(ws + WS_VSC)}
#if SCAN_DBG == 3
        , (unsigned*)(ws + WS_CTR + 8192)
#endif
        );
#if SCAN_DBG == 7
        asm volatile("s_waitcnt vmcnt(0)" ::: "memory"); __syncthreads(); grid.sync(); if (threadIdx.x < 64) { __builtin_amdgcn_fence(__ATOMIC_ACQUIRE, "agent"); asm volatile("s_waitcnt vmcnt(0)" ::: "memory"); } __syncthreads();
        dbg_check_a7((const float*)(ws + slot(4)), (const bf16_t*)(ws + slot(2)), (const bf16_t*)(ws + slot(6)), (float*)(ws + WS_CTR + 4096));
#endif
#if SCAN_DBG == 6
#define DSYNC6() asm volatile("s_waitcnt vmcnt(0)" ::: "memory"); __syncthreads(); grid.sync(); if (threadIdx.x < 64) { __builtin_amdgcn_fence(__ATOMIC_ACQUIRE, "agent"); asm volatile("s_waitcnt vmcnt(0)" ::: "memory"); } __syncthreads();
        DSYNC6()
        phase_scan_a(lds, (const bf16_t*)(ws + slot(2)), (const float*)(ws + WS_LB), (const bf16_t*)(ws + slot(3)), (bf16_t*)a.out, (float*)(ws + WS_DEC), QuantJob{a.in[10], a.in[11], ws + WS_UB, ws + WS_VB, (float*)(ws + WS_USC), (float*)(ws + WS_VSC)});
        DSYNC6()
        dbg_check_a((LAS float*)lds, (const float*)(ws + slot(4)), (const bf16_t*)(ws + slot(2)), (const bf16_t*)(ws + slot(6)), (const bf16_t*)a.out, (float*)(ws + WS_CTR + 4096));
#endif
#if SCAN_DBG == 3
        asm volatile("s_waitcnt vmcnt(0)" ::: "memory"); __syncthreads(); grid.sync();
        dbg_count_bf16((const bf16_t*)(ws + slot(6)), (size_t)4096 * 16384, (unsigned*)(ws + WS_CTR + 8192) + 2);
#endif
    PHASE_END(2)
    PHASE_BEGIN(3) phase_scan_b((bf16_t*)(ws + slot(6)), (const float*)(ws + WS_DEC), QuantJob{a.in[10] + (size_t)16384 * DM, a.in[11] + (size_t)16384 * DM, ws + WS_UB + (size_t)16384 * DM, ws + WS_VB + (size_t)16384 * DM, (float*)(ws + WS_USC) + 16384, (float*)(ws + WS_VSC) + 16384});
#if SCAN_DBG == 3
        asm volatile("s_waitcnt vmcnt(0)" ::: "memory"); __syncthreads(); grid.sync();

#endif
    PHASE_END(3)
    PHASE_BEGIN(4) phase_scan_c(lds, (const bf16_t*)(ws + slot(1)), (const bf16_t*)(ws + slot(2)), (const float*)(ws + WS_LB), (const bf16_t*)(ws + slot(3)), (const bf16_t*)(ws + slot(4)), (const bf16_t*)(ws + slot(6)), a.in[2], (bf16_t*)(ws + slot(0)));
#if SCAN_DBG == 1
        asm volatile("s_waitcnt vmcnt(0)" ::: "memory"); __syncthreads(); grid.sync();
        phase_scan_naive((const bf16_t*)(ws + slot(1)), (const float*)(ws + slot(4)), (const bf16_t*)(ws + slot(2)), (float*)(ws + slot(6)));
        asm volatile("s_waitcnt vmcnt(0)" ::: "memory"); __syncthreads(); grid.sync();
        phase_onorm((const float*)(ws + slot(6)), (const bf16_t*)(ws + slot(3)), a.in[2], (bf16_t*)(ws + slot(0)));
#endif
#if SCAN_DBG == 3
        asm volatile("s_waitcnt vmcnt(0)" ::: "memory"); __syncthreads(); grid.sync();

#endif
#if SCAN_DBG == 4
#define DSYNC() asm volatile("s_waitcnt vmcnt(0)" ::: "memory"); __syncthreads(); grid.sync(); if (threadIdx.x < 64) { __builtin_amdgcn_fence(__ATOMIC_ACQUIRE, "agent"); asm volatile("s_waitcnt vmcnt(0)" ::: "memory"); } __syncthreads();
        DSYNC()
        phase_scan_naive((const bf16_t*)(ws + slot(1)), (const float*)(ws + slot(4)), (const bf16_t*)(ws + slot(2)), (float*)(ws + slot(6)));
        DSYNC()
        phase_onorm((const float*)(ws + slot(6)), (const bf16_t*)(ws + slot(3)), a.in[2], (bf16_t*)(ws + slot(8)));
        DSYNC()
        phase_scan_a(lds, (const bf16_t*)(ws + slot(2)), (const float*)(ws + WS_LB), (const bf16_t*)(ws + slot(3)), (bf16_t*)(ws + slot(6)), (float*)(ws + WS_DEC), QuantJob{a.in[10], a.in[11], ws + WS_UB, ws + WS_VB, (float*)(ws + WS_USC), (float*)(ws + WS_VSC)});
        DSYNC()
        phase_scan_b((bf16_t*)(ws + slot(6)), (const float*)(ws + WS_DEC), QuantJob{a.in[10] + (size_t)16384 * DM, a.in[11] + (size_t)16384 * DM, ws + WS_UB + (size_t)16384 * DM, ws + WS_VB + (size_t)16384 * DM, (float*)(ws + WS_USC) + 16384, (float*)(ws + WS_VSC) + 16384});
        DSYNC()
        phase_scan_c(lds, (const bf16_t*)(ws + slot(1)), (const bf16_t*)(ws + slot(2)), (const float*)(ws + WS_LB), (const bf16_t*)(ws + slot(3)), (const bf16_t*)(ws + slot(4)), (const bf16_t*)(ws + slot(6)), a.in[2], (bf16_t*)a.out);
        DSYNC()
        dbg_compare4((LAS float*)lds, (const bf16_t*)(ws + slot(0)), (const bf16_t*)(ws + slot(8)), (const bf16_t*)a.out, (float*)(ws + WS_CTR + 4096));
#endif
#if SCAN_DBG == 2
        asm volatile("s_waitcnt vmcnt(0)" ::: "memory"); __syncthreads(); grid.sync();
        phase_scan_naive((const bf16_t*)(ws + slot(1)), (const float*)(ws + slot(4)), (const bf16_t*)(ws + slot(2)), (float*)(ws + slot(6)));
        asm volatile("s_waitcnt vmcnt(0)" ::: "memory"); __syncthreads(); grid.sync();
        phase_onorm((const float*)(ws + slot(6)), (const bf16_t*)(ws + slot(3)), a.in[2], (bf16_t*)(ws + slot(8)));
        asm volatile("s_waitcnt vmcnt(0)" ::: "memory"); __syncthreads(); grid.sync();
        dbg_compare((LAS float*)lds, (const bf16_t*)(ws + slot(0)), (const bf16_t*)(ws + slot(8)), (float*)(ws + WS_CTR + 4096));
#endif
    PHASE_END(4)
    PHASE_BEGIN(5)
        quant_rows_bf16((const bf16_t*)(ws + slot(0)), (signed char*)(ws + slot(8)), (float*)(ws + WS_XSO), MTOK);
        xcd_barrier(xbar);
        run_gemm_out<false>(a, lds); PHASE_END(5)
    PHASE_BEGIN(6) run_ln<false>(a); PHASE_END(6)
    PHASE_BEGIN(7) run_gemm_sc<false>(a, lds); PHASE_END(7)
    PHASE_BEGIN(8) run_topk<false>(a, lds); PHASE_END(8)
    PHASE_BEGIN(9) run_peer<false>(a, lds); PHASE_END(9)
    PHASE_BEGIN(10) {
        pg8::Gemm g{(const bf16_t*)(ws + slot(1)), (const bf16_t*)(ws + WS_WKVQ), opaque(MTOK), opaque(3 * DM), opaque(DM / 2)};
        pg8::StaticOrder S; S.init(g.M, g.N, (int)gridDim.x, (int)blockIdx.x);
        EpiKVQR_<true> E{(bf16_t*)(ws + slot(3)), (const float*)(ws + WS_COS), (const float*)(ws + WS_SIN), (const float*)(ws + WS_XS1), (const float*)(ws + WS_SWKVQ)};
        pg8::gemm_phase<EpiKVQR_<true>, pg8::StaticOrder>(lds, g, S, E, nullptr);
    } PHASE_END(10)
    PHASE_BEGIN(11) phase_kstat((LAS float*)lds, (const bf16_t*)(ws + slot(3)), (float*)(ws + WS_KMEAN), (float*)(ws + WS_KNMAX)); PHASE_END(11)
    PHASE_BEGIN(12) phase_sel(lds, (const bf16_t*)(ws + slot(5)), (const float*)(ws + WS_KMEAN), (unsigned short*)(ws + WS_SUB), (int*)(ws + WS_CNT), (int*)(ws + WS_CTR)); PHASE_END(12)
    PHASE_BEGIN(13) phase_att(lds, (const bf16_t*)(ws + slot(5)), (const bf16_t*)(ws + slot(3)), (const bf16_t*)(ws + slot(4)), (const float*)(ws + WS_KNMAX), (const unsigned short*)(ws + WS_SUB),
                              (const int*)(ws + WS_CNT), (int*)(ws + WS_CTR), (bf16_t*)(ws + slot(6)), (bf16_t*)(ws + slot(0)), (float*)(ws + WS_LS)); PHASE_END(13)
    PHASE_BEGIN(14) phase_comb((LAS float*)lds, (const bf16_t*)(ws + slot(6)), (const bf16_t*)(ws + slot(0)), (const float*)(ws + WS_LS), (signed char*)(ws + slot(3)), (float*)(ws + WS_XSO)); PHASE_END(14)
    PHASE_BEGIN(15) run_gemm_out<true>(a, lds); PHASE_END(15)
    PHASE_BEGIN(16) run_ln<true>(a); PHASE_END(16)
    PHASE_BEGIN(17) run_gemm_sc<true>(a, lds); PHASE_END(17)
    PHASE_BEGIN(18) run_topk<true>(a, lds); PHASE_END(18)
#if SCAN_DBG == 7
    PHASE_BEGIN(19) dbg_emit7((const float*)(ws + WS_CTR + 4096), a.out); PHASE_END(19)
#elif SCAN_DBG == 6
    PHASE_BEGIN(19) dbg_emit4((const float*)(ws + WS_CTR + 4096), a.out); PHASE_END(19)
#elif SCAN_DBG == 5
    PHASE_BEGIN(19) dbg_emit5((const unsigned*)(ws + WS_CTR + 8192), a.out); PHASE_END(19)
#elif SCAN_DBG == 4
    PHASE_BEGIN(19) dbg_emit4((const float*)(ws + WS_CTR + 4096), a.out); PHASE_END(19)
#elif SCAN_DBG == 3
    PHASE_BEGIN(19) dbg_emit3((const unsigned*)(ws + WS_CTR + 8192), a.out); PHASE_END(19)
#elif SCAN_DBG == 2
    PHASE_BEGIN(19) dbg_emit((const float*)(ws + WS_CTR + 4096), a.out); PHASE_END(19)
#else
    PHASE_BEGIN(19) run_peer<true>(a, lds); PHASE_END(19)
#endif
}

extern "C" void kernel_launch(void* const* d_in, const int* in_sizes, int n_in, void* d_out, int out_size, void* d_ws, size_t ws_size, hipStream_t stream) {
    static int grid = 0;
    if (grid == 0) {
        if (n_in != 14 || out_size != MTOK * DM || ws_size < WS_END) { fprintf(stderr, "kernel_launch: unexpected shapes (n_in %d, out %d, ws %zu)\n", n_in, out_size, ws_size); grid = -1; return; }
        int dev = 0, cus = 0, per_cu = 0;
        if (hipGetDevice(&dev) != hipSuccess || hipDeviceGetAttribute(&cus, hipDeviceAttributeMultiprocessorCount, dev) != hipSuccess) { grid = -1; return; }
        if (hipFuncSetAttribute((const void*)mk_fwd, hipFuncAttributeMaxDynamicSharedMemorySize, LDS_BYTES) != hipSuccess) { fprintf(stderr, "kernel_launch: hipFuncSetAttribute failed\n"); grid = -1; return; }
        if (hipOccupancyMaxActiveBlocksPerMultiprocessor(&per_cu, (const void*)mk_fwd, 512, LDS_BYTES) != hipSuccess || per_cu < 1) { fprintf(stderr, "kernel_launch: occupancy query failed (%d)\n", per_cu); (void)hipGetLastError(); per_cu = 1; }
        grid = cus * (per_cu > 1 ? 1 : per_cu);
    }
    if (grid < 0) return;
    Args a{};
    for (int i = 0; i < 14; ++i) a.in[i] = (const float*)d_in[i];
    a.out = (float*)d_out; a.ws = (unsigned char*)d_ws;
#if ONE_LAUNCH
    a.ph_lo = 0; a.ph_hi = NPH;
    (void)hipMemsetAsync((unsigned char*)d_ws + WS_BAR, 0, XCD_BAR_WORDS * sizeof(unsigned), stream);
    void* args[] = {&a};
    hipError_t e = hipLaunchCooperativeKernel((const void*)mk_fwd, dim3(grid), dim3(512), args, LDS_BYTES, stream);
    if (e != hipSuccess) fprintf(stderr, "cooperative launch failed: %s (grid %d)\n", hipGetErrorString(e), grid);
#else
    for (int ph = 0; ph < NPH; ++ph) {
        a.ph_lo = ph; a.ph_hi = ph + 1;
        hipLaunchKernelGGL(mk_fwd, dim3(grid), dim3(512), LDS_BYTES, stream, a);
    }
#endif
}
```

```cpp
#define ONE_LAUNCH 1
#include <hip/hip_runtime.h>
#include <hip/hip_cooperative_groups.h>
#include <cstdio>
namespace cg = cooperative_groups;

#ifndef ONE_LAUNCH
#define ONE_LAUNCH 0
#endif
#ifndef SCAN_DBG
#define SCAN_DBG 0
#endif
#ifndef SCAN_A_VALU
#define SCAN_A_VALU 0
#endif
#ifndef SC8
#define SC8 1
#endif
#ifndef ENMASK
#define ENMASK 0xffffffffu
#endif
#define EN(k) ((ENMASK >> (k)) & 1u)

namespace pg8 {
#define PG8_LAS __attribute__((address_space(3)))
typedef unsigned short bf16_t;
typedef short bf16x8 __attribute__((ext_vector_type(8)));
typedef float f32x4 __attribute__((ext_vector_type(4)));
typedef unsigned u32x4 __attribute__((ext_vector_type(4)));
constexpr int BM = 256, BK = 64, HALF = 128, HTB = HALF * BK * 2  , STAGE_BYTES = 8 * HTB, NXCD = 8, WGM = 8;

__host__ __device__ __forceinline__ int lds_byte(int r, int c) { const int st = (r >> 4) * 2 + (c >> 5), rr = r & 15, cc = c & 31, ob = rr * 64 + cc * 2; return st * 1024 + (ob ^ (((ob >> 9) & 1) << 5)); }
__host__ __device__ __forceinline__ void stage_rc(int b, int& R, int& C) { const int st = b / 1024, sb = b % 1024, swz = sb ^ (((sb >> 9) & 1) << 5); R = (st >> 1) * 16 + swz / 64; C = (st & 1) * 32 + (swz % 64) / 2; }
__host__ __device__ __forceinline__ int perm32(int rho) { const int n = rho >> 4, i = rho & 15; return 8 * (i >> 2) + 4 * n + (i & 3); }

struct Unit { int pm, pn; };
struct Gemm { const bf16_t* A; const bf16_t* Bt; int M, N, K; };

struct StaticOrder {
    int nM, nN, nwg, G, c;
    __host__ __device__ void init(int M, int N, int G_, int c_) { nM = M / BM; nN = N / BM; nwg = nM * nN; G = G_; c = c_; }
    __host__ __device__ bool next(int i, Unit& u) const {
        const long L = (long)i * G + c; if (L >= nwg) return false;
        int wgid = (int)L; { const int q = nwg / NXCD, r = nwg % NXCD, xcd = wgid % NXCD, off = wgid / NXCD; wgid = (xcd < r ? xcd * (q + 1) : r * (q + 1) + (xcd - r) * q) + off; }
        const int nig = WGM * nN, gid = wgid / nig, fm = gid * WGM, gsz = (nM - fm) < WGM ? (nM - fm) : WGM;
        u.pm = fm + ((wgid % nig) % gsz); u.pn = (wgid % nig) / gsz; return true;
    }
    __device__ __forceinline__ void a_ready(const Unit&) const {}
    __device__ __forceinline__ void done(const Unit&) const {}
};
struct CountedOrder : StaticOrder {
    const unsigned* ready; unsigned need; unsigned* tmo;
    __device__ __forceinline__ void a_ready(const Unit& u) const {
        if (threadIdx.x < 64) {
            const unsigned long long t0 = __builtin_amdgcn_s_memrealtime(); unsigned polls = 0;
            while ((unsigned)__builtin_amdgcn_readfirstlane(__hip_atomic_load(ready + 64 * u.pm, __ATOMIC_RELAXED, __HIP_MEMORY_SCOPE_AGENT)) < need) {
                if ((++polls & 255u) == 0u && __builtin_amdgcn_readfirstlane(__hip_atomic_load(tmo, __ATOMIC_RELAXED, __HIP_MEMORY_SCOPE_AGENT)) != 0u) break;
                if (__builtin_amdgcn_s_memrealtime() - t0 > 2000000ull) {
                    if (threadIdx.x == 0) { unsigned expect = 0u; __hip_atomic_compare_exchange_strong(tmo + 1, &expect, 0x600u | (unsigned)(u.pm & 0xff), __ATOMIC_RELAXED, __ATOMIC_RELAXED, __HIP_MEMORY_SCOPE_AGENT); __hip_atomic_store(tmo, 1u, __ATOMIC_RELAXED, __HIP_MEMORY_SCOPE_AGENT); }
                    break; }
                __builtin_amdgcn_s_sleep(2); }
            __builtin_amdgcn_fence(__ATOMIC_ACQUIRE, "agent");
            asm volatile("s_waitcnt vmcnt(0)" ::: "memory");
        }
#if !defined(BROKEN_HOOK_NO_BARRIER)
        asm volatile("" ::: "memory"); __builtin_amdgcn_s_barrier(); asm volatile("" ::: "memory");
#endif
    }
};

__device__ __forceinline__ unsigned cvt_pk_bf16(float lo, float hi) { unsigned r; asm volatile("v_cvt_pk_bf16_f32 %0, %1, %2" : "=v"(r) : "v"(lo), "v"(hi)); return r; }
typedef float f32x2 __attribute__((ext_vector_type(2)));
__device__ __forceinline__ f32x2 gelu_pk(f32x2 v) {
    const f32x2 av = __builtin_elementwise_abs(v), d = av * 0.2316418882f + 1.0f;
    f32x2 t; t.x = __builtin_amdgcn_rcpf(d.x); t.y = __builtin_amdgcn_rcpf(d.y);
    f32x2 q = t * 0.5307027145f + (-0.7265760135f); q = q * t + 0.7107068705f; q = q * t + (-0.142248368f); q = q * t + 0.127414796f; q = q * t;
    const f32x2 s = (v * v) * (-0.72134752044f);
    f32x2 e; e.x = __builtin_amdgcn_exp2f(s.x); e.y = __builtin_amdgcn_exp2f(s.y);
    const f32x2 m = v * (q * e), r = v - m;
    f32x2 o; o.x = v.x < 0.f ? m.x : r.x; o.y = v.y < 0.f ? m.y : r.y; return o;
}

struct EpiF32 {
    static constexpr bool PERM = false, AFTER_DRAIN = false, I8 = false;
    float* C; int ldc; const float* bias;
    __device__ __forceinline__ void operator()(const f32x4 (&acc)[2][2][4][2], const Unit& u, int wr, int wc, int fr, int fq) const {
        const int row0 = u.pm * BM + wr * 64 + fr, col0 = u.pn * BM + wc * 32 + 4 * fq;
        f32x4 bv[2][2];
#pragma unroll
        for (int bj = 0; bj < 2; ++bj)
#pragma unroll
            for (int n = 0; n < 2; ++n) bv[bj][n] = bias ? *(const f32x4*)(bias + col0 + bj * HALF + n * 16) : (f32x4){0.f, 0.f, 0.f, 0.f};
#pragma unroll
        for (int ai = 0; ai < 2; ++ai)
#pragma unroll
            for (int m = 0; m < 4; ++m) { float* rowp = C + (size_t)(row0 + ai * HALF + m * 16) * ldc + col0;
#pragma unroll
                for (int bj = 0; bj < 2; ++bj)
#pragma unroll
                    for (int n = 0; n < 2; ++n) *(f32x4*)(rowp + bj * HALF + n * 16) = acc[ai][bj][m][n] + bv[bj][n]; }
    }
};
template <int ACT  > struct EpiBf16 {
    static constexpr bool PERM = true, AFTER_DRAIN = false, I8 = false;
    bf16_t* O; int ldc; const float* bias; int split_cols; size_t split_stride;
    __device__ __forceinline__ void operator()(const f32x4 (&acc)[2][2][4][2], const Unit& u, int wr, int wc, int fr, int fq) const {
        const int row0 = u.pm * BM + wr * 64 + fr; int colt = u.pn * BM; bf16_t* base = O;
        if (split_cols) { const int t = colt / split_cols; base += (size_t)t * split_stride; colt -= t * split_cols; }
        const int col0 = colt + wc * 32 + 8 * fq, bcol0 = u.pn * BM + wc * 32 + 8 * fq;
        f32x4 bv[2][2];
#pragma unroll
        for (int bj = 0; bj < 2; ++bj)
#pragma unroll
            for (int n = 0; n < 2; ++n) bv[bj][n] = bias ? *(const f32x4*)(bias + bcol0 + bj * HALF + 4 * n) : (f32x4){0.f, 0.f, 0.f, 0.f};
#pragma unroll
        for (int ai = 0; ai < 2; ++ai)
#pragma unroll
            for (int m = 0; m < 4; ++m) { bf16_t* rowp = base + (size_t)(row0 + ai * HALF + m * 16) * ldc + col0;
#pragma unroll
                for (int bj = 0; bj < 2; ++bj) { f32x4 v0 = acc[ai][bj][m][0] + bv[bj][0], v1 = acc[ai][bj][m][1] + bv[bj][1];
                    if (ACT == 1) { f32x2 a = gelu_pk((f32x2){v0[0], v0[1]}), b = gelu_pk((f32x2){v0[2], v0[3]}), c = gelu_pk((f32x2){v1[0], v1[1]}), d = gelu_pk((f32x2){v1[2], v1[3]});
                        v0 = (f32x4){a.x, a.y, b.x, b.y}; v1 = (f32x4){c.x, c.y, d.x, d.y}; }
                    if (ACT == 2) {
#pragma unroll
                        for (int j = 0; j < 4; ++j) { v0[j] = 0.5f * v0[j] * (1.0f + erff(v0[j] * 0.70710678f)); v1[j] = 0.5f * v1[j] * (1.0f + erff(v1[j] * 0.70710678f)); } }
                    u32x4 w; w.x = cvt_pk_bf16(v0[0], v0[1]); w.y = cvt_pk_bf16(v0[2], v0[3]); w.z = cvt_pk_bf16(v1[0], v1[1]); w.w = cvt_pk_bf16(v1[2], v1[3]);
                    *(u32x4*)(rowp + bj * HALF) = w; } }
    }
};

typedef int i32x4 __attribute__((ext_vector_type(4)));
template <bool I8> __device__ __forceinline__ f32x4 mma16(bf16x8 b, bf16x8 a, f32x4 c) {
    if constexpr (I8) return __builtin_bit_cast(f32x4, __builtin_amdgcn_mfma_i32_16x16x64_i8(__builtin_bit_cast(i32x4, b), __builtin_bit_cast(i32x4, a), __builtin_bit_cast(i32x4, c), 0, 0, 0));
    else return __builtin_amdgcn_mfma_f32_16x16x32_bf16(b, a, c, 0, 0, 0);
}
template <bool I8> __device__ __forceinline__ f32x4 accf(f32x4 a) { if constexpr (I8) return __builtin_convertvector(__builtin_bit_cast(i32x4, a), f32x4); else return a; }
template <class Epi, class Sched, bool STAMP = false>
__device__ __forceinline__ void gemm_phase(PG8_LAS unsigned char* lds, const Gemm g, const Sched& S, const Epi& E, unsigned long long* stamps) {
    const int tid = threadIdx.x, wid = __builtin_amdgcn_readfirstlane(tid >> 6), lane = tid & 63, wr = wid >> 2, wc = wid & 3, fr = lane & 15, fq = lane >> 4;
    const int K = g.K, nt = K / BK;
    int ts_lo = 0, ts_hi = 0, nts = 0; const unsigned long long rt_entry = STAMP ? (unsigned long long)wall_clock64() : 0ull;
#define PG8_STAMP() do { if (STAMP && wid == 0 && nts < 64) { const unsigned long long _c = (unsigned long long)clock64(); \
        ts_lo = (lane == nts) ? (int)(unsigned)_c : ts_lo; ts_hi = (lane == nts) ? (int)(unsigned)(_c >> 32) : ts_hi; ++nts; } } while (0)
    PG8_STAMP();
    unsigned voffA[2], voffB[2];
#pragma unroll
    for (int i = 0; i < 2; ++i) { int R, C; stage_rc(tid * 16 + i * 8192, R, C); const int Rb = Epi::PERM ? ((R & ~31) + perm32(R & 31)) : R;
        voffA[i] = (unsigned)(R * K + C) * 2u; voffB[i] = (unsigned)(Rb * K + C) * 2u; }
    const size_t kstep = (size_t)(BK * 2);
    const size_t hstep = (size_t)HALF * K * 2;
    const size_t tstep = 2 * hstep;
    const unsigned ldsw = (unsigned)wid * 1024u;
    const int aoff = lds_byte(wr * 64 + fr, fq * 8), boff = lds_byte(wc * 32 + fr, fq * 8);
#define PG8_SA(b, h) (((b) * 2 + (h)) * HTB)
#define PG8_SB(b, h) ((4 + (b) * 2 + (h)) * HTB)
#define PG8_STAGE(bufoff, gbase, voff) do { _Pragma("unroll") for (int _i = 0; _i < 2; ++_i) \
        __builtin_amdgcn_global_load_lds((const unsigned*)((const char*)(gbase) + (voff)[_i]), (PG8_LAS unsigned*)(lds + (bufoff) + ldsw + _i * 8192), 16, 0, 0); } while (0)
#define PG8_LDA(dst, b, h) do { _Pragma("unroll") for (int m = 0; m < 4; ++m) _Pragma("unroll") for (int k = 0; k < 2; ++k) dst[m][k] = *(const PG8_LAS bf16x8*)(lds + PG8_SA(b, h) + aoff + m * 2048 + k * 1024); } while (0)
#define PG8_LDB(dst, b, h) do { _Pragma("unroll") for (int n = 0; n < 2; ++n) _Pragma("unroll") for (int k = 0; k < 2; ++k) dst[n][k] = *(const PG8_LAS bf16x8*)(lds + PG8_SB(b, h) + boff + n * 2048 + k * 1024); } while (0)
#define PG8_MMA(ai, bj, At, Bt) do { __builtin_amdgcn_s_setprio(1); _Pragma("unroll") for (int m = 0; m < 4; ++m) _Pragma("unroll") for (int n = 0; n < 2; ++n) _Pragma("unroll") for (int k = 0; k < 2; ++k) \
        acc[ai][bj][m][n] = mma16<Epi::I8>(Bt[n][k], At[m][k], acc[ai][bj][m][n]); __builtin_amdgcn_s_setprio(0); } while (0)
#define PG8_WAIT_V(n) asm volatile("s_waitcnt vmcnt(" #n ")" ::: "memory")
#define PG8_WAIT_L(n) asm volatile("s_waitcnt lgkmcnt(" #n ")" ::: "memory")
#define PG8_BAR __builtin_amdgcn_s_barrier()
#define PG8_SCHED __builtin_amdgcn_sched_barrier(0)
    Unit cur, nxt; int ui = 0;
    if (!S.next(0, cur)) return;
    f32x4 acc[2][2][4][2];
#pragma unroll
    for (int a = 0; a < 2; ++a)
#pragma unroll
        for (int b = 0; b < 2; ++b)
#pragma unroll
            for (int m = 0; m < 4; ++m)
#pragma unroll
                for (int n = 0; n < 2; ++n) acc[a][b][m][n] = (f32x4){0.f, 0.f, 0.f, 0.f};
    bf16x8 At[4][2], B0[2][2], B1[2][2];
    const char* cA = (const char*)g.A + (size_t)cur.pm * tstep; const char* cB = (const char*)g.Bt + (size_t)cur.pn * tstep;
    S.a_ready(cur);
    PG8_STAGE(PG8_SB(0, 0), cB, voffB); PG8_STAGE(PG8_SA(0, 0), cA, voffA); PG8_STAGE(PG8_SB(0, 1), cB + hstep, voffB); PG8_STAGE(PG8_SA(0, 1), cA + hstep, voffA);
    if (wr == 1) PG8_BAR;
    PG8_WAIT_V(4); PG8_BAR;
    PG8_STAGE(PG8_SB(1, 0), cB + kstep, voffB); PG8_STAGE(PG8_SA(1, 0), cA + kstep, voffA); PG8_STAGE(PG8_SB(1, 1), cB + hstep + kstep, voffB);
    PG8_WAIT_V(6); PG8_BAR;
    PG8_STAMP();
    for (;;) {
        const bool has_next = S.next(ui + 1, nxt);
        const char* nA = has_next ? (const char*)g.A + (size_t)nxt.pm * tstep : cA; const char* nB = has_next ? (const char*)g.Bt + (size_t)nxt.pn * tstep : cB;
        for (int t = 0; t < nt; t += 2) {
            const bool last = (t == nt - 2);
            const char* a1 = cA + (size_t)(t + 1) * kstep;
            const char* a2 = last ? nA : cA + (size_t)(t + 2) * kstep; const char* b2 = last ? nB : cB + (size_t)(t + 2) * kstep;
            const char* a3 = a2 + kstep; const char* b3 = b2 + kstep;
            if (last && has_next) S.a_ready(nxt);
            PG8_LDB(B0, 0, 0); PG8_SCHED; PG8_LDA(At, 0, 0); PG8_STAGE(PG8_SA(1, 1), a1 + hstep, voffA);
            PG8_WAIT_L(8); PG8_BAR; PG8_WAIT_L(0); PG8_MMA(0, 0, At, B0); PG8_BAR; PG8_SCHED;
            PG8_LDB(B1, 0, 1); PG8_STAGE(PG8_SB(0, 0), b2, voffB);
            PG8_BAR; PG8_WAIT_L(0); PG8_MMA(0, 1, At, B1); PG8_BAR;
            PG8_LDA(At, 0, 1); PG8_STAGE(PG8_SA(0, 0), a2, voffA);
            PG8_BAR; PG8_WAIT_L(0); PG8_MMA(1, 0, At, B0); PG8_BAR; PG8_SCHED;
            PG8_STAGE(PG8_SB(0, 1), b2 + hstep, voffB);
            PG8_WAIT_V(6); PG8_BAR; PG8_MMA(1, 1, At, B1); PG8_BAR;
            PG8_LDB(B0, 1, 0); PG8_SCHED; PG8_LDA(At, 1, 0); PG8_STAGE(PG8_SA(0, 1), a2 + hstep, voffA);
            PG8_WAIT_L(8); PG8_BAR; PG8_WAIT_L(0); PG8_MMA(0, 0, At, B0); PG8_BAR; PG8_SCHED;
            PG8_LDB(B1, 1, 1); PG8_STAGE(PG8_SB(1, 0), b3, voffB);
            PG8_BAR; PG8_WAIT_L(0); PG8_MMA(0, 1, At, B1); PG8_BAR;
            PG8_LDA(At, 1, 1); PG8_STAGE(PG8_SA(1, 0), a3, voffA);
            PG8_BAR; PG8_WAIT_L(0); PG8_MMA(1, 0, At, B0); PG8_BAR; PG8_SCHED;
            PG8_STAGE(PG8_SB(1, 1), b3 + hstep, voffB);
            PG8_WAIT_V(6); PG8_BAR; PG8_MMA(1, 1, At, B1); PG8_BAR;
        }
        PG8_STAMP();
        if constexpr (!Epi::AFTER_DRAIN) { E(acc, cur, wr, wc, fr, fq); S.done(cur); }
        PG8_STAMP();
        if (!has_next) break;
#pragma unroll
        for (int a = 0; a < 2; ++a)
#pragma unroll
            for (int b = 0; b < 2; ++b)
#pragma unroll
                for (int m = 0; m < 4; ++m)
#pragma unroll
                    for (int n = 0; n < 2; ++n) acc[a][b][m][n] = (f32x4){0.f, 0.f, 0.f, 0.f};
        cur = nxt; cA = nA; cB = nB; ++ui;
    }
    PG8_WAIT_V(0);
    if (wr == 0) PG8_BAR;
    PG8_BAR;
    if constexpr (Epi::AFTER_DRAIN) { E.fused(acc, cur, wr, wc, fr, fq, lds, wid, lane); S.done(cur); }
    PG8_STAMP();
    if (STAMP && wid == 0) { stamps[lane] = lane < nts ? (((unsigned long long)(unsigned)ts_hi << 32) | (unsigned)ts_lo) : 0ull;
        if (lane == 62) stamps[62] = rt_entry; if (lane == 63) stamps[63] = (unsigned long long)wall_clock64(); }
#undef PG8_STAMP
#undef PG8_SA
#undef PG8_SB
#undef PG8_STAGE
#undef PG8_LDA
#undef PG8_LDB
#undef PG8_MMA
#undef PG8_WAIT_V
#undef PG8_WAIT_L
#undef PG8_BAR
#undef PG8_SCHED
}
}


#define LAS __attribute__((address_space(3)))
typedef unsigned short bf16_t;
typedef float f32x4 __attribute__((ext_vector_type(4)));
typedef unsigned u32x4 __attribute__((ext_vector_type(4)));
typedef unsigned u32x2 __attribute__((ext_vector_type(2)));
typedef short bf16x8 __attribute__((ext_vector_type(8)));
typedef short s16x4 __attribute__((ext_vector_type(4)));
typedef float f32x16 __attribute__((ext_vector_type(16)));

constexpr int MTOK = 16384, DM = 2048, SEQ = 8192, NHEAD = 16;
constexpr float ALPHA = 1.41421356237309515f;
constexpr size_t MiB = (size_t)1 << 20;
constexpr size_t WS_WIN = 0, WS_WOUT = 32 * MiB, WS_WKVQ = 40 * MiB, WS_WO = 64 * MiB, WS_WC = 72 * MiB, WS_UB = 88 * MiB, WS_VB = 152 * MiB, WS_USC = 216 * MiB, WS_VSC = 217 * MiB, WS_H = 224 * MiB, WS_XQ = 232 * MiB, WS_XS = 264 * MiB, WS_W = 272 * MiB, WS_CS = 280 * MiB, WS_SLOT = 344 * MiB;
constexpr size_t WS_EID = 920 * MiB, WS_GATE = 928 * MiB, WS_COS = 936 * MiB, WS_SIN = 938 * MiB, WS_KMEAN = 940 * MiB, WS_LB = 941 * MiB, WS_LS = 942 * MiB, WS_SUB = 946 * MiB, WS_CNT = 962 * MiB, WS_CTR = 963 * MiB, WS_DEC = 964 * MiB, WS_END = 966 * MiB;
constexpr size_t WS_BAR = WS_CTR + 65536;
constexpr size_t WS_SWOUT = WS_XS + 512 * 1024;
constexpr size_t WS_WC8 = WS_H, WS_SWC = WS_XS + 5 * MiB, WS_XSO = WS_XS + 6 * MiB, WS_SWO = WS_XS + 7 * MiB;
constexpr size_t WS_XS0 = WS_XS + 1 * MiB, WS_SWIN = WS_XS + 2 * MiB, WS_SWKVQ = WS_XS + 3 * MiB, WS_XS1 = WS_XS + 4 * MiB;
constexpr size_t WS_KNMAX = WS_KMEAN + 768 * 1024;
__host__ __device__ constexpr size_t slot(int i) { return WS_SLOT + (size_t)i * 64 * MiB; }
constexpr int LDS_BYTES = 144 * 1024;
constexpr int NPH = 20;

struct Args { const float* in[14]; float* out; unsigned char* ws; int ph_lo, ph_hi; };

__device__ __forceinline__ float bflo(unsigned w) { return __uint_as_float(w << 16); }
__device__ __forceinline__ float bfhi(unsigned w) { return __uint_as_float(w & 0xffff0000u); }
__device__ __forceinline__ float bf2f(bf16_t b) { return __uint_as_float(((unsigned)b) << 16); }
typedef __bf16 bf16x2_t __attribute__((ext_vector_type(2)));
typedef float f32x2_t __attribute__((ext_vector_type(2)));
__device__ __forceinline__ unsigned pk_bf16(float lo, float hi) { const f32x2_t f = {lo, hi}; return __builtin_bit_cast(unsigned, __builtin_convertvector(f, bf16x2_t)); }
__device__ __forceinline__ float wave_sum(float v) {
#pragma unroll
    for (int o = 32; o >= 1; o >>= 1) v += __shfl_xor(v, o);
    return v;
}
__device__ __forceinline__ float wave_max(float v) {
#pragma unroll
    for (int o = 32; o >= 1; o >>= 1) v = fmaxf(v, __shfl_xor(v, o));
    return v;
}
__device__ __forceinline__ float sigmoidf_(float z) { return 1.0f / (1.0f + __expf(-z)); }


__device__ __forceinline__ void store_wt16(void* p, u32x4 v) {
    __hip_atomic_store((unsigned long long*)p, ((unsigned long long)v.y << 32) | v.x, __ATOMIC_RELAXED, __HIP_MEMORY_SCOPE_AGENT);
    __hip_atomic_store((unsigned long long*)p + 1, ((unsigned long long)v.w << 32) | v.z, __ATOMIC_RELAXED, __HIP_MEMORY_SCOPE_AGENT);
}
__device__ __forceinline__ void store_wt8(void* p, u32x2 v) {
    __hip_atomic_store((unsigned long long*)p, ((unsigned long long)v.y << 32) | v.x, __ATOMIC_RELAXED, __HIP_MEMORY_SCOPE_AGENT);
}
struct EpiIn {
    static constexpr bool PERM = true, AFTER_DRAIN = false, I8 = false;
    bf16_t* Q1; float* LF; bf16_t* I1; bf16_t* G1; const float* LB;
    __device__ __forceinline__ void operator()(const pg8::f32x4 (&acc)[2][2][4][2], const pg8::Unit& u, int wr, int wc, int fr, int fq) const {
        const int type = u.pn >> 3;
        const int row0 = u.pm * 256 + wr * 64 + fr, col0 = (u.pn & 7) * 256 + wc * 32 + 8 * fq;
        if (type == 1) {
#pragma unroll
            for (int bj = 0; bj < 2; ++bj) {
                const int c = col0 + bj * 128;
                const f32x4 lb0 = *(const f32x4*)(LB + c), lb1 = *(const f32x4*)(LB + c + 4);
#pragma unroll
                for (int ai = 0; ai < 2; ++ai)
#pragma unroll
                    for (int m = 0; m < 4; ++m) {
                        float* p = LF + (size_t)(row0 + ai * 128 + m * 16) * DM + c;
                        f32x4 o0, o1;
#pragma unroll
                        for (int j = 0; j < 4; ++j) {
                            o0[j] = __logf(lb0[j] + (1.0f - lb0[j]) * sigmoidf_(acc[ai][bj][m][0][j]));
                            o1[j] = __logf(lb1[j] + (1.0f - lb1[j]) * sigmoidf_(acc[ai][bj][m][1][j]));
                        }
                        *(f32x4*)p = o0; *(f32x4*)(p + 4) = o1;
                    }
            }
        } else {
            bf16_t* dst = Q1 + (size_t)(type - (type > 0 ? 1 : 0)) * ((size_t)32 << 20);
            const bool act = (type != 2);
#pragma unroll
            for (int ai = 0; ai < 2; ++ai)
#pragma unroll
                for (int m = 0; m < 4; ++m)
#pragma unroll
                    for (int bj = 0; bj < 2; ++bj) {
                        f32x4 v0 = acc[ai][bj][m][0], v1 = acc[ai][bj][m][1];
                        if (act) {
#pragma unroll
                            for (int j = 0; j < 4; ++j) { v0[j] = v0[j] * sigmoidf_(v0[j]); v1[j] = v1[j] * sigmoidf_(v1[j]); }
                        }
                        u32x4 w; w.x = pk_bf16(v0[0], v0[1]); w.y = pk_bf16(v0[2], v0[3]); w.z = pk_bf16(v1[0], v1[1]); w.w = pk_bf16(v1[2], v1[3]);
                        *(u32x4*)(dst + (size_t)(row0 + ai * 128 + m * 16) * DM + col0 + bj * 128) = w;
                    }
        }
    }
};
struct EpiRes {
    static constexpr bool PERM = false, AFTER_DRAIN = false, I8 = false;
    const float* res; float* Y;
    __device__ __forceinline__ void operator()(const pg8::f32x4 (&acc)[2][2][4][2], const pg8::Unit& u, int wr, int wc, int fr, int fq) const {
        const int row0 = u.pm * 256 + wr * 64 + fr, col0 = u.pn * 256 + wc * 32 + 4 * fq;
#pragma unroll
        for (int ai = 0; ai < 2; ++ai)
#pragma unroll
            for (int m = 0; m < 4; ++m) {
                const size_t off = (size_t)(row0 + ai * 128 + m * 16) * DM + col0;
#pragma unroll
                for (int bj = 0; bj < 2; ++bj)
#pragma unroll
                    for (int n = 0; n < 2; ++n) {
                        const f32x4 r = *(const f32x4*)(res + off + bj * 128 + n * 16);
                        *(f32x4*)(Y + off + bj * 128 + n * 16) = r * ALPHA + acc[ai][bj][m][n];
                    }
            }
    }
};
template <bool Q8> struct EpiF32_ {
    static constexpr bool PERM = false, AFTER_DRAIN = false, I8 = Q8;
    float* C; int ldc; const float* SA; const float* SB;
    __device__ __forceinline__ void operator()(const pg8::f32x4 (&acc)[2][2][4][2], const pg8::Unit& u, int wr, int wc, int fr, int fq) const {
        const int row0 = u.pm * 256 + wr * 64 + fr, col0 = u.pn * 256 + wc * 32 + 4 * fq;
        float sa[2][4]; f32x4 sb[2][2];
#pragma unroll
        for (int ai = 0; ai < 2; ++ai)
#pragma unroll
            for (int m = 0; m < 4; ++m) sa[ai][m] = Q8 ? SA[row0 + ai * 128 + m * 16] : 1.0f;
#pragma unroll
        for (int bj = 0; bj < 2; ++bj)
#pragma unroll
            for (int n = 0; n < 2; ++n) sb[bj][n] = Q8 ? *(const f32x4*)(SB + col0 + bj * 128 + n * 16) : (f32x4){1.f, 1.f, 1.f, 1.f};
#pragma unroll
        for (int ai = 0; ai < 2; ++ai)
#pragma unroll
            for (int m = 0; m < 4; ++m) {
                const int row = row0 + ai * 128 + m * 16;
#pragma unroll
                for (int bj = 0; bj < 2; ++bj)
#pragma unroll
                    for (int n = 0; n < 2; ++n) {
                        f32x4 v = pg8::accf<Q8>(acc[ai][bj][m][n]);
                        if (Q8) v = v * sb[bj][n] * sa[ai][m];
                        *(f32x4*)(C + (size_t)row * ldc + col0 + bj * 128 + n * 16) = v;
                    }
            }
    }
};
typedef EpiF32_<false> EpiF32;
template <bool Q8> struct EpiKVQ_ {
    static constexpr bool PERM = true, AFTER_DRAIN = false, I8 = Q8;
    bf16_t* K; const float* SA; const float* SB;
    __device__ __forceinline__ void operator()(const pg8::f32x4 (&acc)[2][2][4][2], const pg8::Unit& u, int wr, int wc, int fr, int fq) const {
        const int t = u.pn >> 3;
        bf16_t* dst = K + (size_t)t * ((size_t)32 << 20);
        const int row0 = u.pm * 256 + wr * 64 + fr, col0 = (u.pn & 7) * 256 + wc * 32 + 8 * fq;
        float sa[2][4]; f32x4 sb[2][2];
#pragma unroll
        for (int ai = 0; ai < 2; ++ai)
#pragma unroll
            for (int m = 0; m < 4; ++m) sa[ai][m] = Q8 ? SA[row0 + ai * 128 + m * 16] : 1.0f;
#pragma unroll
        for (int bj = 0; bj < 2; ++bj)
#pragma unroll
            for (int n = 0; n < 2; ++n) sb[bj][n] = Q8 ? *(const f32x4*)(SB + u.pn * 256 + bj * 128 + wc * 32 + 8 * fq + 4 * n) : (f32x4){1.f, 1.f, 1.f, 1.f};
#pragma unroll
        for (int ai = 0; ai < 2; ++ai)
#pragma unroll
            for (int m = 0; m < 4; ++m)
#pragma unroll
                for (int bj = 0; bj < 2; ++bj) {
                    const int row = row0 + ai * 128 + m * 16;
                    f32x4 v0 = pg8::accf<Q8>(acc[ai][bj][m][0]), v1 = pg8::accf<Q8>(acc[ai][bj][m][1]);
                    if (Q8) { v0 = v0 * sb[bj][0] * sa[ai][m]; v1 = v1 * sb[bj][1] * sa[ai][m]; }
                    u32x4 w; w.x = pk_bf16(v0[0], v0[1]); w.y = pk_bf16(v0[2], v0[3]); w.z = pk_bf16(v1[0], v1[1]); w.w = pk_bf16(v1[2], v1[3]);
                    *(u32x4*)(dst + (size_t)row * DM + col0 + bj * 128) = w;
                }
    }
};
typedef EpiKVQ_<false> EpiKVQ;

template <bool Q8> struct EpiKVQR_ {
    static constexpr bool PERM = true, AFTER_DRAIN = false, I8 = Q8;
    bf16_t* K; const float* COS; const float* SIN; const float* SA; const float* SB;
    __device__ __forceinline__ void operator()(const pg8::f32x4 (&acc)[2][2][4][2], const pg8::Unit& u, int wr, int wc, int fr, int fq) const {
        const int t = u.pn >> 3;
        bf16_t* dst = K + (size_t)t * ((size_t)32 << 20);
        const int row0 = u.pm * 256 + wr * 64 + fr;
        const int g = 4 * wc + fq;
        const int col0 = (u.pn & 7) * 256 + wc * 32 + 8 * fq;
        float sa[2][4]; f32x4 sb[2][2];
#pragma unroll
        for (int ai = 0; ai < 2; ++ai)
#pragma unroll
            for (int m = 0; m < 4; ++m) sa[ai][m] = Q8 ? SA[row0 + ai * 128 + m * 16] : 1.0f;
#pragma unroll
        for (int bj = 0; bj < 2; ++bj)
#pragma unroll
            for (int n = 0; n < 2; ++n) sb[bj][n] = Q8 ? *(const f32x4*)(SB + u.pn * 256 + bj * 128 + wc * 32 + 8 * fq + 4 * n) : (f32x4){1.f, 1.f, 1.f, 1.f};
        if (t == 1) {
#pragma unroll
            for (int ai = 0; ai < 2; ++ai)
#pragma unroll
                for (int m = 0; m < 4; ++m)
#pragma unroll
                    for (int bj = 0; bj < 2; ++bj) {
                        const int row = row0 + ai * 128 + m * 16;
                        f32x4 a = pg8::accf<Q8>(acc[ai][bj][m][0]), b = pg8::accf<Q8>(acc[ai][bj][m][1]);
                        if (Q8) { a = a * sb[bj][0] * sa[ai][m]; b = b * sb[bj][1] * sa[ai][m]; }
                        u32x4 w; w.x = pk_bf16(a[0], a[1]); w.y = pk_bf16(a[2], a[3]); w.z = pk_bf16(b[0], b[1]); w.w = pk_bf16(b[2], b[3]);
                        *(u32x4*)(dst + (size_t)row * DM + col0 + bj * 128) = w;
                    }
        } else {
            const int pos0 = row0 & (SEQ - 1);
            f32x4 c = *(const f32x4*)(COS + pos0 * 64 + 4 * g), s_ = *(const f32x4*)(SIN + pos0 * 64 + 4 * g);
            const f32x4 c16 = *(const f32x4*)(COS + 16 * 64 + 4 * g), s16 = *(const f32x4*)(SIN + 16 * 64 + 4 * g), c128 = *(const f32x4*)(COS + 128 * 64 + 4 * g), s128 = *(const f32x4*)(SIN + 128 * 64 + 4 * g);
#pragma unroll
            for (int q = 0; q < 8; ++q) {
                const int ai = q >> 2, m = ai ? 7 - q : q;
#pragma unroll
                for (int bj = 0; bj < 2; ++bj) {
                    f32x4 a = pg8::accf<Q8>(acc[ai][bj][m][0]), b = pg8::accf<Q8>(acc[ai][bj][m][1]);
                    if (Q8) { a = a * sb[bj][0] * sa[ai][m]; b = b * sb[bj][1] * sa[ai][m]; }
                    u32x2 w1, w2;
                    w1.x = pk_bf16(a[0] * c[0] - b[0] * s_[0], a[1] * c[1] - b[1] * s_[1]); w1.y = pk_bf16(a[2] * c[2] - b[2] * s_[2], a[3] * c[3] - b[3] * s_[3]);
                    w2.x = pk_bf16(a[0] * s_[0] + b[0] * c[0], a[1] * s_[1] + b[1] * c[1]); w2.y = pk_bf16(a[2] * s_[2] + b[2] * c[2], a[3] * s_[3] + b[3] * c[3]);
                    bf16_t* p = dst + (size_t)(row0 + ai * 128 + m * 16) * DM + ((u.pn & 7) * 2 + bj) * 128 + 4 * g;
                    *(u32x2*)p = w1; *(u32x2*)(p + 64) = w2;
                }
                if (q < 3) { const f32x4 cn = c * c16 - s_ * s16, sn = s_ * c16 + c * s16; c = cn; s_ = sn; }
                else if (q == 3) { const f32x4 cn = c * c128 - s_ * s128, sn = s_ * c128 + c * s128; c = cn; s_ = sn; }
                else if (q < 7) { const f32x4 cn = c * c16 + s_ * s16, sn = s_ * c16 - c * s16; c = cn; s_ = sn; }
            }
        }
    }
};

__host__ __device__ __forceinline__ int rot_pos(int d) { return d < 64 ? 8 * (d >> 2) + (d & 3) : 8 * ((d - 64) >> 2) + 4 + (d & 3); }
__device__ __forceinline__ void transpose_tiles(LAS float* tile, const float* src, int ldn, int K, int N, bf16_t* dst, int nperm = 0) {
    const int tid = threadIdx.x;
    const int tn = N / 64, ntiles = tn * (K / 64);
    f32x4 nx[2];
#define TT_LOAD(tI_) { const int k0_ = ((tI_) / tn) * 64, n0_ = ((tI_) % tn) * 64; _Pragma("unroll") for (int r = 0; r < 2; ++r) nx[r] = *(const f32x4*)(src + (size_t)(k0_ + (tid >> 4) + 32 * r) * ldn + n0_ + (tid & 15) * 4); }
    if ((int)blockIdx.x < ntiles) TT_LOAD((int)blockIdx.x)
    for (int tI = blockIdx.x; tI < ntiles; tI += gridDim.x) {
        const int k0 = (tI / tn) * 64, n0 = (tI % tn) * 64;
        const f32x4 c0 = nx[0], c1 = nx[1];
        if (tI + (int)gridDim.x < ntiles) TT_LOAD(tI + (int)gridDim.x)
#pragma unroll
        for (int r = 0; r < 2; ++r) {
            const int kk = (tid >> 4) + 32 * r, nn = (tid & 15) * 4;
            const f32x4 v = r == 0 ? c0 : c1;
            tile[kk * 65 + nn + 0] = v[0]; tile[kk * 65 + nn + 1] = v[1]; tile[kk * 65 + nn + 2] = v[2]; tile[kk * 65 + nn + 3] = v[3];
        }
        __syncthreads();
        {
            const int nn = tid >> 3, kk8 = (tid & 7) * 8;
            float f[8];
#pragma unroll
            for (int j = 0; j < 8; ++j) f[j] = tile[(kk8 + j) * 65 + nn];
            u32x4 w; w.x = pk_bf16(f[0], f[1]); w.y = pk_bf16(f[2], f[3]); w.z = pk_bf16(f[4], f[5]); w.w = pk_bf16(f[6], f[7]);
            const int nsrc = n0 + nn, nrow = nsrc < nperm ? (nsrc & ~127) + rot_pos(nsrc & 127) : nsrc;
            *(u32x4*)(dst + (size_t)nrow * K + k0 + kk8) = w;
        }
        __syncthreads();
    }
}
#undef TT_LOAD
__device__ __forceinline__ void convert_bf16(const float* src, bf16_t* dst, size_t n) {
    const size_t stride = (size_t)gridDim.x * 512 * 8;
    for (size_t i = ((size_t)blockIdx.x * 512 + threadIdx.x) * 8; i < n; i += stride) {
        const f32x4 a = *(const f32x4*)(src + i), b = *(const f32x4*)(src + i + 4);
        u32x4 w; w.x = pk_bf16(a[0], a[1]); w.y = pk_bf16(a[2], a[3]); w.z = pk_bf16(b[0], b[1]); w.w = pk_bf16(b[2], b[3]);
        *(u32x4*)(dst + i) = w;
    }
}
__device__ __forceinline__ void split8(const f32x4 x0, const f32x4 x1, bf16x8& hi, bf16x8& lo) {
    u32x4 h, l;
    h.x = pk_bf16(x0[0], x0[1]); h.y = pk_bf16(x0[2], x0[3]); h.z = pk_bf16(x1[0], x1[1]); h.w = pk_bf16(x1[2], x1[3]);
    l.x = pk_bf16(x0[0] - bflo(h.x), x0[1] - bfhi(h.x)); l.y = pk_bf16(x0[2] - bflo(h.y), x0[3] - bfhi(h.y)); l.z = pk_bf16(x1[0] - bflo(h.z), x1[1] - bfhi(h.z)); l.w = pk_bf16(x1[2] - bflo(h.w), x1[3] - bfhi(h.w));
    hi = __builtin_bit_cast(bf16x8, h); lo = __builtin_bit_cast(bf16x8, l);
}
__device__ __forceinline__ void fold_peer_keys(const float* w_query, const float* sub_keys, bf16_t* WcT) {
    const int lane = threadIdx.x & 63, gw = blockIdx.x * 8 + (threadIdx.x >> 6), nw = gridDim.x * 8, r32 = lane & 31, hh2 = lane >> 5;
    for (int wt = gw; wt < 8192; wt += nw) {
        const int item = wt >> 3, sub = wt & 7, keyt = sub & 3, kint = sub >> 2;
        const int l = item >> 9, rem = item & 511, hh = rem >> 5, kb = rem & 31, h = hh >> 1, half = hh & 1;
        const float* sk = sub_keys + (size_t)(((l * 2 + half) * 8 + h) * 128 + keyt * 32 + r32) * 128 + 8 * hh2;
        const float* wq = w_query + (size_t)l * DM * DM + (size_t)(kb * 64 + kint * 32 + r32) * DM + h * 256 + half * 128 + 8 * hh2;
        f32x16 acc;
#pragma unroll
        for (int i = 0; i < 16; ++i) acc[i] = 0.f;
#pragma unroll 1
        for (int kh = 0; kh < 2; ++kh) {
            f32x4 av[8], bv[8];
#pragma unroll
            for (int ks = 0; ks < 4; ++ks) { const int kk = 64 * kh + 16 * ks; av[2 * ks] = *(const f32x4*)(wq + kk); av[2 * ks + 1] = *(const f32x4*)(wq + kk + 4); bv[2 * ks] = *(const f32x4*)(sk + kk); bv[2 * ks + 1] = *(const f32x4*)(sk + kk + 4); }
#pragma unroll
            for (int ks = 0; ks < 4; ++ks) {
                bf16x8 ah, al, bh, bl;
                split8(av[2 * ks], av[2 * ks + 1], ah, al); split8(bv[2 * ks], bv[2 * ks + 1], bh, bl);
                acc = __builtin_amdgcn_mfma_f32_32x32x16_bf16(al, bh, acc, 0, 0, 0);
                acc = __builtin_amdgcn_mfma_f32_32x32x16_bf16(ah, bl, acc, 0, 0, 0);
                acc = __builtin_amdgcn_mfma_f32_32x32x16_bf16(ah, bh, acc, 0, 0, 0);
            }
        }
        bf16_t* o = WcT + (size_t)l * DM * DM + (size_t)(h * 256 + half * 128 + keyt * 32 + r32) * DM + kb * 64 + kint * 32 + 4 * hh2;
#pragma unroll
        for (int q = 0; q < 4; ++q) { u32x2 w; w.x = pk_bf16(acc[4 * q], acc[4 * q + 1]); w.y = pk_bf16(acc[4 * q + 2], acc[4 * q + 3]); *(u32x2*)(o + 8 * q) = w; }
    }
}

__device__ __forceinline__ void quant_rows(const float* src, unsigned char* dst, float* scl, int nrows) {
    const int lane = threadIdx.x & 63, gw = blockIdx.x * 8 + (threadIdx.x >> 6), nw = gridDim.x * 8;
    for (int row = gw; row < nrows; row += nw) {
        const float* p = src + (size_t)row * DM;
        f32x4 v[8];
#pragma unroll
        for (int i = 0; i < 2; ++i)
#pragma unroll
            for (int q = 0; q < 4; ++q) v[i * 4 + q] = *(const f32x4*)(p + 1024 * i + 16 * lane + 4 * q);
        float am = 0.f;
#pragma unroll
        for (int i = 0; i < 8; ++i) am = fmaxf(am, fmaxf(fmaxf(fabsf(v[i][0]), fabsf(v[i][1])), fmaxf(fabsf(v[i][2]), fabsf(v[i][3]))));
        am = fmaxf(wave_max(am), 1e-30f);
        const float inv = 127.0f / am;
        if (lane == 0) scl[row] = am * (1.0f / 127.0f);
#pragma unroll
        for (int i = 0; i < 2; ++i) {
            u32x4 w;
#pragma unroll
            for (int q = 0; q < 4; ++q) {
                const f32x4 t = v[i * 4 + q];
                const unsigned b0 = (unsigned)(int)(rintf(t[0] * inv) + 128.0f), b1 = (unsigned)(int)(rintf(t[1] * inv) + 128.0f), b2 = (unsigned)(int)(rintf(t[2] * inv) + 128.0f), b3 = (unsigned)(int)(rintf(t[3] * inv) + 128.0f);
                w[q] = b0 | (b1 << 8) | (b2 << 16) | (b3 << 24);
            }
            *(u32x4*)(dst + (size_t)row * DM + 1024 * i + 16 * lane) = w;
        }
    }
}
__device__ __forceinline__ void quant_strip(LAS unsigned char* lds, const float* src, int ldn, int sI, signed char* dst, float* scl, int nperm) {
    const int tid = threadIdx.x, kg = tid >> 3, c4 = (tid & 7) * 4, wv = tid >> 6;
    LAS float* red = (LAS float*)lds;
    {
        const int n0 = sI * 32;
        f32x4 v[32];
        const float* p = src + (size_t)(kg * 32) * ldn + n0 + c4;
#pragma unroll
        for (int it = 0; it < 32; ++it) v[it] = *(const f32x4*)(p + (size_t)it * ldn);
        f32x4 am = {0.f, 0.f, 0.f, 0.f};
#pragma unroll
        for (int it = 0; it < 32; ++it)
#pragma unroll
            for (int j = 0; j < 4; ++j) am[j] = fmaxf(am[j], fabsf(v[it][j]));
#pragma unroll
        for (int o = 8; o <= 32; o <<= 1)
#pragma unroll
            for (int j = 0; j < 4; ++j) am[j] = fmaxf(am[j], __shfl_xor(am[j], o));
        if ((tid & 63) < 8) *(LAS f32x4*)(red + wv * 32 + c4) = am;
        __syncthreads();
#pragma unroll
        for (int w = 0; w < 8; ++w) { const f32x4 r = *(const LAS f32x4*)(red + w * 32 + c4);
#pragma unroll
            for (int j = 0; j < 4; ++j) am[j] = fmaxf(am[j], r[j]); }
#pragma unroll
        for (int j = 0; j < 4; ++j) {
            const float m = fmaxf(am[j], 1e-30f), inv = 127.0f / m;
            const int nsrc = n0 + c4 + j, nrow = nsrc < nperm ? (nsrc & ~127) + rot_pos(nsrc & 127) : nsrc;
            if (kg == 0) scl[nrow] = m * (1.0f / 127.0f);
            signed char* o = dst + (size_t)nrow * DM + kg * 32;
#pragma unroll
            for (int h = 0; h < 2; ++h) {
                u32x4 w;
#pragma unroll
                for (int d = 0; d < 4; ++d) {
                    unsigned bb = 0;
#pragma unroll
                    for (int e = 0; e < 4; ++e) bb |= ((unsigned)(int)rintf(v[h * 16 + d * 4 + e][j] * inv) & 0xffu) << (8 * e);
                    w[d] = bb;
                }
                *(u32x4*)(o + h * 16) = w;
            }
        }
        __syncthreads();
    }
}
__device__ __forceinline__ void quant_rows_s(const float* src, signed char* dst, float* scl, int nrows, bool local) {
    const int lane = threadIdx.x & 63, gw = local ? (int)(threadIdx.x >> 6) : (int)(blockIdx.x * 8 + (threadIdx.x >> 6)), nw = local ? 8 : (int)gridDim.x * 8;
    for (int row = gw; row < nrows; row += nw) {
        const float* p = src + (size_t)row * DM;
        f32x4 v[8];
#pragma unroll
        for (int i = 0; i < 2; ++i)
#pragma unroll
            for (int q = 0; q < 4; ++q) v[i * 4 + q] = *(const f32x4*)(p + 1024 * i + 16 * lane + 4 * q);
        float am = 0.f;
#pragma unroll
        for (int i = 0; i < 8; ++i) am = fmaxf(am, fmaxf(fmaxf(fabsf(v[i][0]), fabsf(v[i][1])), fmaxf(fabsf(v[i][2]), fabsf(v[i][3]))));
        am = fmaxf(wave_max(am), 1e-30f);
        const float inv = 127.0f / am;
        if (lane == 0) scl[row] = am * (1.0f / 127.0f);
#pragma unroll
        for (int i = 0; i < 2; ++i) {
            u32x4 w;
#pragma unroll
            for (int q = 0; q < 4; ++q) {
                const f32x4 t = v[i * 4 + q];
                w[q] = ((unsigned)(int)rintf(t[0] * inv) & 0xffu) | (((unsigned)(int)rintf(t[1] * inv) & 0xffu) << 8) | (((unsigned)(int)rintf(t[2] * inv) & 0xffu) << 16) | (((unsigned)(int)rintf(t[3] * inv) & 0xffu) << 24);
            }
            *(u32x4*)(dst + (size_t)row * DM + 1024 * i + 16 * lane) = w;
        }
    }
}
__device__ __forceinline__ void quant_rows_bf16(const bf16_t* src, signed char* dst, float* scl, int nrows) {
    const int lane = threadIdx.x & 63, gw = blockIdx.x * 8 + (threadIdx.x >> 6), nw = gridDim.x * 8;
    for (int row = gw; row < nrows; row += nw) {
        u32x4 v[4];
#pragma unroll
        for (int i = 0; i < 4; ++i) v[i] = *(const u32x4*)(src + (size_t)row * DM + 512 * i + 8 * lane);
        float am = 0.f;
#pragma unroll
        for (int i = 0; i < 4; ++i)
#pragma unroll
            for (int d = 0; d < 4; ++d) am = fmaxf(am, fmaxf(fabsf(bflo(v[i][d])), fabsf(bfhi(v[i][d]))));
        am = fmaxf(wave_max(am), 1e-30f);
        const float inv = 127.0f / am;
        if (lane == 0) scl[row] = am * (1.0f / 127.0f);
#pragma unroll
        for (int i = 0; i < 4; ++i) {
            u32x2 w;
            w.x = ((unsigned)(int)rintf(bflo(v[i].x) * inv) & 0xffu) | (((unsigned)(int)rintf(bfhi(v[i].x) * inv) & 0xffu) << 8) | (((unsigned)(int)rintf(bflo(v[i].y) * inv) & 0xffu) << 16) | (((unsigned)(int)rintf(bfhi(v[i].y) * inv) & 0xffu) << 24);
            w.y = ((unsigned)(int)rintf(bflo(v[i].z) * inv) & 0xffu) | (((unsigned)(int)rintf(bfhi(v[i].z) * inv) & 0xffu) << 8) | (((unsigned)(int)rintf(bflo(v[i].w) * inv) & 0xffu) << 16) | (((unsigned)(int)rintf(bfhi(v[i].w) * inv) & 0xffu) << 24);
            *(u32x2*)(dst + (size_t)row * DM + 512 * i + 8 * lane) = w;
        }
    }
}
__device__ __forceinline__ void phase_prep(const Args& a, LAS unsigned char* lds) {
    unsigned char* ws = a.ws;
    LAS float* tile = (LAS float*)lds;
    for (int sI = blockIdx.x; sI < 576; sI += gridDim.x) {
        if (sI < 256)      quant_strip(lds, a.in[1], 4 * DM, sI, (signed char*)(ws + WS_WIN), (float*)(ws + WS_SWIN), 0);
        else if (sI < 384) quant_strip(lds, a.in[5], 2 * DM, sI - 256, (signed char*)(ws + WS_WKVQ), (float*)(ws + WS_SWKVQ), DM);
        else if (sI < 448) quant_strip(lds, a.in[6], DM, sI - 384, (signed char*)(ws + WS_WKVQ) + (size_t)2 * DM * DM, (float*)(ws + WS_SWKVQ) + 2 * DM, DM);
        else if (sI < 512) quant_strip(lds, a.in[3], DM, sI - 448, (signed char*)(ws + WS_WOUT), (float*)(ws + WS_SWOUT), 0);
        else               quant_strip(lds, a.in[7], DM, sI - 512, (signed char*)(ws + WS_WO), (float*)(ws + WS_SWO), 0);
    }
    fold_peer_keys(a.in[8], a.in[9], (bf16_t*)(ws + WS_WC));
    if (gridDim.x == 256) {
        const int b = blockIdx.x, r0 = b < 64 ? 40 * b : 2560 + 72 * (b - 64), nr = b < 64 ? 40 : 72;
        quant_rows_s(a.in[0] + (size_t)r0 * DM, (signed char*)(ws + slot(0)) + (size_t)r0 * DM, (float*)(ws + WS_XS0) + r0, nr, true);
    } else quant_rows_s(a.in[0], (signed char*)(ws + slot(0)), (float*)(ws + WS_XS0), MTOK, false);
    const int gtid = blockIdx.x * 512 + threadIdx.x, gthreads = gridDim.x * 512;
    float* COS = (float*)(ws + WS_COS); float* SIN = (float*)(ws + WS_SIN); float* LB = (float*)(ws + WS_LB);
    for (int i = gtid; i < SEQ * 64; i += gthreads) {
        const int pos = i >> 6, j = i & 63;
        double inv = 1.0; const double r = 0.86596432336006535;
        for (int q = 0; q < j; ++q) inv *= r;
        const float ang = (float)pos * (float)inv;
        const double x = (double)ang;
        const double n = __builtin_rint(x * 0.15915494309189535);
        const float rf = (float)__builtin_fma(-n, 6.283185307179586, x);
        COS[i] = cosf(rf); SIN[i] = sinf(rf);
    }
    for (int c = gtid; c < DM; c += gthreads) { const float l0 = a.in[4][c], l1 = a.in[4][DM + c]; LB[c] = 1.0f / (1.0f + expf(l1 - l0)); }
}

__device__ __forceinline__ void phase_scan_naive(const bf16_t* Q1, const float* LF, const bf16_t* I1, float* O) {
    const int lane = threadIdx.x & 63, gw = blockIdx.x * 8 + (threadIdx.x >> 6), nw = gridDim.x * 8;
    for (int item = gw; item < 2 * NHEAD * 128; item += nw) {
        const int bh = item >> 7, v = item & 127, b = bh >> 4, h = bh & 15;
        const size_t base = (size_t)b * SEQ * DM + h * 128;
        float S0 = 0.f, S1 = 0.f;
#pragma unroll 4
        for (int t = 0; t < SEQ; ++t) {
            const size_t ro = base + (size_t)t * DM;
            const float f0 = __expf(LF[ro + lane]), f1 = __expf(LF[ro + 64 + lane]);
            const float q0 = bf2f(Q1[ro + lane]), q1 = bf2f(Q1[ro + 64 + lane]);
            const float iv = bf2f(I1[ro + v]);
            S0 = f0 * S0 + (1.0f - f0) * iv; S1 = f1 * S1 + (1.0f - f1) * iv;
            const float p = wave_sum(q0 * S0 + q1 * S1);
            if (lane == 0) O[ro + v] = p;
        }
    }
}
__device__ __forceinline__ void phase_onorm(const float* O, const bf16_t* G1, const float* gnorm, bf16_t* OG) {
    const int lane = threadIdx.x & 63, gw = blockIdx.x * 8 + (threadIdx.x >> 6), nw = gridDim.x * 8;
    const float gn0 = gnorm[2 * lane], gn1 = gnorm[2 * lane + 1];
    for (int item = gw; item < MTOK * NHEAD; item += nw) {
        const size_t off = (size_t)item * 128 + 2 * lane;
        const float o0 = O[off], o1 = O[off + 1];
        const float ss = wave_sum(o0 * o0 + o1 * o1);
        const float r = rsqrtf(ss * (1.0f / 128.0f) + 1e-6f);
        const unsigned g = *(const unsigned*)(G1 + off);
        *(unsigned*)(OG + off) = pk_bf16(o0 * r * gn0 * bflo(g), o1 * r * gn1 * bfhi(g));
    }
}

__device__ __forceinline__ void ln_row_store(float (&v)[32], const float* g, const float* bta, float* outf, bf16_t* outb, int lane, signed char* outq = nullptr, float* outs = nullptr) {
    float s = 0.f;
#pragma unroll
    for (int i = 0; i < 32; ++i) s += v[i];
    const float mu = wave_sum(s) * (1.0f / DM);
    float q = 0.f;
#pragma unroll
    for (int i = 0; i < 32; ++i) { v[i] -= mu; q += v[i] * v[i]; }
    const float rstd = rsqrtf(wave_sum(q) * (1.0f / DM) + 1e-5f);
    float am = 0.f;
#pragma unroll
    for (int i = 0; i < 4; ++i) {
        const int c = 512 * i + 8 * lane;
        const f32x4 g0 = *(const f32x4*)(g + c), g1 = *(const f32x4*)(g + c + 4), b0 = *(const f32x4*)(bta + c), b1 = *(const f32x4*)(bta + c + 4);
        f32x4 o0, o1;
#pragma unroll
        for (int j = 0; j < 4; ++j) { o0[j] = v[i * 8 + j] * rstd * g0[j] + b0[j]; o1[j] = v[i * 8 + 4 + j] * rstd * g1[j] + b1[j]; v[i * 8 + j] = o0[j]; v[i * 8 + 4 + j] = o1[j]; am = fmaxf(am, fmaxf(fabsf(o0[j]), fabsf(o1[j]))); }
        if (outf) { *(f32x4*)(outf + c) = o0; *(f32x4*)(outf + c + 4) = o1; }
        if (outb) { u32x4 w; w.x = pk_bf16(o0[0], o0[1]); w.y = pk_bf16(o0[2], o0[3]); w.z = pk_bf16(o1[0], o1[1]); w.w = pk_bf16(o1[2], o1[3]); *(u32x4*)(outb + c) = w; }
    }
    if (outq) {
        am = fmaxf(wave_max(am), 1e-30f);
        const float inv = 127.0f / am;
        if (lane == 0) *outs = am * (1.0f / 127.0f);
#pragma unroll
        for (int i = 0; i < 4; ++i) {
            u32x2 w;
            w.x = ((unsigned)(int)rintf(v[i * 8 + 0] * inv) & 0xffu) | (((unsigned)(int)rintf(v[i * 8 + 1] * inv) & 0xffu) << 8) | (((unsigned)(int)rintf(v[i * 8 + 2] * inv) & 0xffu) << 16) | (((unsigned)(int)rintf(v[i * 8 + 3] * inv) & 0xffu) << 24);
            w.y = ((unsigned)(int)rintf(v[i * 8 + 4] * inv) & 0xffu) | (((unsigned)(int)rintf(v[i * 8 + 5] * inv) & 0xffu) << 8) | (((unsigned)(int)rintf(v[i * 8 + 6] * inv) & 0xffu) << 16) | (((unsigned)(int)rintf(v[i * 8 + 7] * inv) & 0xffu) << 24);
            *(u32x2*)(outq + 512 * i + 8 * lane) = w;
        }
    }
}
__device__ __forceinline__ void ln_row_store16(float (&v)[32], const float* g, const float* bta, float* outf, bf16_t* outb, int lane) {
    float s = 0.f;
#pragma unroll
    for (int i = 0; i < 32; ++i) s += v[i];
    const float mu = wave_sum(s) * (1.0f / DM);
    float q = 0.f;
#pragma unroll
    for (int i = 0; i < 32; ++i) { v[i] -= mu; q += v[i] * v[i]; }
    const float rstd = rsqrtf(wave_sum(q) * (1.0f / DM) + 1e-5f);
#pragma unroll
    for (int i = 0; i < 2; ++i) {
        const int c = 1024 * i + 16 * lane;
        f32x4 o[4];
#pragma unroll
        for (int qd = 0; qd < 4; ++qd) {
            const f32x4 gg = *(const f32x4*)(g + c + 4 * qd), bb = *(const f32x4*)(bta + c + 4 * qd);
#pragma unroll
            for (int j = 0; j < 4; ++j) o[qd][j] = v[16 * i + 4 * qd + j] * rstd * gg[j] + bb[j];
            *(f32x4*)(outf + c + 4 * qd) = o[qd];
        }
        if (outb) {
            u32x4 w0, w1;
            w0.x = pk_bf16(o[0][0], o[0][1]); w0.y = pk_bf16(o[0][2], o[0][3]); w0.z = pk_bf16(o[1][0], o[1][1]); w0.w = pk_bf16(o[1][2], o[1][3]);
            w1.x = pk_bf16(o[2][0], o[2][1]); w1.y = pk_bf16(o[2][2], o[2][3]); w1.z = pk_bf16(o[3][0], o[3][1]); w1.w = pk_bf16(o[3][2], o[3][3]);
            *(u32x4*)(outb + c) = w0; *(u32x4*)(outb + c + 8) = w1;
        }
    }
}
template <bool RES16> __device__ __forceinline__ void phase_ln(const bf16_t* Y, const void* RESv, const float* g, const float* bta, float* outf, bf16_t* outb, signed char* outq = nullptr, float* outs = nullptr) {
    const int lane = threadIdx.x & 63, gw = blockIdx.x * 8 + (threadIdx.x >> 6), nw = gridDim.x * 8;
    for (int row = gw; row < MTOK; row += nw) {
        float v[32];
        const bf16_t* p = Y + (size_t)row * DM;
#pragma unroll
        for (int i = 0; i < 4; ++i) {
            const u32x4 yw = *(const u32x4*)(p + 512 * i + 8 * lane);
            const f32x4 a = {bflo(yw.x), bfhi(yw.x), bflo(yw.y), bfhi(yw.y)}, b = {bflo(yw.z), bfhi(yw.z), bflo(yw.w), bfhi(yw.w)};
            f32x4 ra, rb;
            if (RES16) { const u32x4 w = *(const u32x4*)((const bf16_t*)RESv + (size_t)row * DM + 512 * i + 8 * lane); ra = (f32x4){bflo(w.x), bfhi(w.x), bflo(w.y), bfhi(w.y)}; rb = (f32x4){bflo(w.z), bfhi(w.z), bflo(w.w), bfhi(w.w)}; }
            else { const float* rp = (const float*)RESv + (size_t)row * DM; ra = *(const f32x4*)(rp + 512 * i + 8 * lane); rb = *(const f32x4*)(rp + 512 * i + 8 * lane + 4); }
#pragma unroll
            for (int j = 0; j < 4; ++j) { v[i * 8 + j] = a[j] + ALPHA * ra[j]; v[i * 8 + 4 + j] = b[j] + ALPHA * rb[j]; }
        }
        ln_row_store(v, g, bta, outf ? outf + (size_t)row * DM : nullptr, outb ? outb + (size_t)row * DM : nullptr, lane, outq ? outq + (size_t)row * DM : nullptr, outs ? outs + row : nullptr);
    }
}

__device__ __forceinline__ void wave_argmax(float& v, int& idx) {
#pragma unroll
    for (int o = 32; o >= 1; o >>= 1) {
        const float ov = __shfl_xor(v, o); const int oi = __shfl_xor(idx, o);
        if (ov > v || (ov == v && oi < idx)) { v = ov; idx = oi; }
    }
}
__device__ __forceinline__ unsigned fkey(float x) { const unsigned u = __float_as_uint(x); return u ^ (unsigned)(((int)u >> 31) | 0x80000000); }
__device__ __forceinline__ float funkey(unsigned k) { const unsigned u = (k & 0x80000000u) ? (k ^ 0x80000000u) : ~k; return __uint_as_float(u); }
__device__ __forceinline__ void sort16_insert(unsigned (&r)[16], unsigned v) {
#pragma unroll
    for (int i = 0; i < 16; ++i) { const unsigned m = r[i] > v ? r[i] : v; v = r[i] > v ? v : r[i]; r[i] = m; }
}
__device__ __forceinline__ void sort16_desc(unsigned (&x)[16]) {
#define CE(i_, j_) { const unsigned mx_ = x[i_] > x[j_] ? x[i_] : x[j_], mn_ = x[i_] > x[j_] ? x[j_] : x[i_]; x[i_] = mx_; x[j_] = mn_; }
    CE(0,1) CE(2,3) CE(0,2) CE(1,3) CE(1,2) CE(4,5) CE(6,7) CE(4,6) CE(5,7) CE(5,6) CE(0,4) CE(2,6) CE(2,4) CE(1,5) CE(3,7) CE(3,5) CE(1,2) CE(3,4) CE(5,6) CE(8,9) CE(10,11) CE(8,10) CE(9,11) CE(9,10) CE(12,13) CE(14,15) CE(12,14) CE(13,15) CE(13,14) CE(8,12) CE(10,14) CE(10,12) CE(9,13) CE(11,15) CE(11,13) CE(9,10) CE(11,12) CE(13,14) CE(0,8) CE(4,12) CE(4,8) CE(2,10) CE(6,14) CE(6,10) CE(2,4) CE(6,8) CE(10,12) CE(1,9) CE(5,13) CE(5,9) CE(3,11) CE(7,15) CE(7,11) CE(3,5) CE(7,9) CE(11,13) CE(1,2) CE(3,4) CE(5,6) CE(7,8) CE(9,10) CE(11,12) CE(13,14)
#undef CE
}
__device__ __forceinline__ void merge16_desc(unsigned (&r)[16], const unsigned (&s)[16]) {
#pragma unroll
    for (int i = 0; i < 16; ++i) r[i] = r[i] > s[15 - i] ? r[i] : s[15 - i];
#pragma unroll
    for (int st = 8; st >= 1; st >>= 1)
#pragma unroll
        for (int i = 0; i < 16; ++i)
            if ((i & st) == 0) { const unsigned mx_ = r[i] > r[i + st] ? r[i] : r[i + st], mn_ = r[i] > r[i + st] ? r[i + st] : r[i]; r[i] = mx_; r[i + st] = mn_; }
}
__device__ __forceinline__ void phase_topk(LAS unsigned char* lds, const float* SCT, int* EID, float* GATE) {
    LAS unsigned char* ib = lds + threadIdx.x * 32;
    for (int item = blockIdx.x * 512 + threadIdx.x; item < MTOK * 8; item += gridDim.x * 512) {
        const int h = item >> 14, tok = item & (MTOK - 1);
        const float* p = SCT + (size_t)(h * 256) * MTOK + tok;
        unsigned r1[16], r2[16];
#pragma unroll
        for (int i = 0; i < 16; ++i) { r1[i] = (fkey(p[(size_t)i * MTOK]) & ~0x7Fu) | (unsigned)i; r2[i] = (fkey(p[(size_t)(128 + i) * MTOK]) & ~0x7Fu) | (unsigned)i; }
        sort16_desc(r1); sort16_desc(r2);
#pragma unroll 1
        for (int g = 1; g < 8; ++g) {
            unsigned s1[16], s2[16];
#pragma unroll
            for (int i = 0; i < 16; ++i) { const int e = g * 16 + i; s1[i] = (fkey(p[(size_t)e * MTOK]) & ~0x7Fu) | (unsigned)e; s2[i] = (fkey(p[(size_t)(128 + e) * MTOK]) & ~0x7Fu) | (unsigned)e; }
            sort16_desc(s1); sort16_desc(s2);
            merge16_desc(r1, s1); merge16_desc(r2, s2);
        }
        float v1[16], v2[16];
#pragma unroll
        for (int i = 0; i < 16; ++i) { v1[i] = funkey(r1[i] & ~0x7Fu); v2[i] = funkey(r2[i] & ~0x7Fu); ib[i] = (unsigned char)(r1[i] & 0x7Fu); ib[16 + i] = (unsigned char)(r2[i] & 0x7Fu); }
#define CK(a_, b_) ((fkey(v1[a_] + v2[b_]) & ~0xFFu) | (unsigned)((a_) * 16 + (b_)))
        unsigned r3[16] = {CK(0, 0), CK(0, 1), CK(0, 2), CK(0, 3), CK(0, 4), CK(0, 5), CK(0, 6), CK(0, 7), CK(0, 8), CK(0, 9), CK(0, 10), CK(0, 11), CK(0, 12), CK(0, 13), CK(0, 14), CK(0, 15)};
        sort16_desc(r3);
        { unsigned sB[16] = {CK(1, 0), CK(1, 1), CK(1, 2), CK(1, 3), CK(1, 4), CK(1, 5), CK(1, 6), CK(1, 7), CK(2, 0), CK(2, 1), CK(2, 2), CK(2, 3), CK(2, 4), CK(3, 0), CK(3, 1), CK(3, 2)}; sort16_desc(sB); merge16_desc(r3, sB); }
        { unsigned sC[16] = {CK(3, 3), CK(4, 0), CK(4, 1), CK(4, 2), CK(5, 0), CK(5, 1), CK(6, 0), CK(6, 1), CK(7, 0), CK(7, 1), CK(8, 0), CK(9, 0), CK(10, 0), CK(11, 0), CK(12, 0), CK(13, 0)}; sort16_desc(sC); merge16_desc(r3, sC); }
        sort16_insert(r3, CK(14, 0)); sort16_insert(r3, CK(15, 0));
#undef CK
        const float mx = funkey(r3[0] & ~0xFFu);
        float ev[16]; float sum = 0.f;
#pragma unroll
        for (int i = 0; i < 16; ++i) { ev[i] = __expf(funkey(r3[i] & ~0xFFu) - mx); sum += ev[i]; }
        const float rs = 1.0f / sum;
        int eid[16];
#pragma unroll
        for (int i = 0; i < 16; ++i) { const unsigned f = r3[i] & 0xFFu; eid[i] = (int)ib[f >> 4] * 128 + (int)ib[16 + (f & 15u)]; }
        int* eo = EID + (size_t)tok * 128 + h * 16; float* go = GATE + (size_t)tok * 128 + h * 16;
#pragma unroll
        for (int q = 0; q < 4; ++q) {
            *(u32x4*)(eo + 4 * q) = (u32x4){(unsigned)eid[4 * q], (unsigned)eid[4 * q + 1], (unsigned)eid[4 * q + 2], (unsigned)eid[4 * q + 3]};
            *(f32x4*)(go + 4 * q) = (f32x4){ev[4 * q] * rs, ev[4 * q + 1] * rs, ev[4 * q + 2] * rs, ev[4 * q + 3] * rs};
        }
    }
}

__device__ __forceinline__ float gelu_erf(float x) { return 0.5f * x * (1.0f + erff(x * 0.70710678118654752f)); }
__device__ __forceinline__ float ub0(unsigned w) { return (float)(w & 0xffu); }
__device__ __forceinline__ float ub1(unsigned w) { return (float)((w >> 8) & 0xffu); }
__device__ __forceinline__ float ub2(unsigned w) { return (float)((w >> 16) & 0xffu); }
__device__ __forceinline__ float ub3(unsigned w) { return (float)(w >> 24); }
__device__ __forceinline__ void phase_peer(LAS unsigned char* lds, const float* X, const int* EID, const float* GATE, const unsigned char* U, const unsigned char* V, const float* USC, const float* VSC,
                                           const float* g, const float* bta, float* outf, bf16_t* outb) {
    const int lane = threadIdx.x & 63, wv = threadIdx.x >> 6, gw = blockIdx.x * 8 + wv, nw = gridDim.x * 8;
    LAS float* hb = (LAS float*)(lds + wv * 512);
    for (int tok = gw; tok < MTOK; tok += nw) {
        float x[32];
        const float* xp = X + (size_t)tok * DM;
#pragma unroll
        for (int i = 0; i < 2; ++i)
#pragma unroll
            for (int q = 0; q < 4; ++q) { const f32x4 t = *(const f32x4*)(xp + 1024 * i + 16 * lane + 4 * q); x[16 * i + 4 * q] = t[0]; x[16 * i + 4 * q + 1] = t[1]; x[16 * i + 4 * q + 2] = t[2]; x[16 * i + 4 * q + 3] = t[3]; }
        float sx = 0.f;
#pragma unroll
        for (int j = 0; j < 32; ++j) sx += x[j];
        const float d0 = -128.0f * sx;
        const int e0 = EID[(size_t)tok * 128 + lane], e1 = EID[(size_t)tok * 128 + 64 + lane];
        const float g0 = GATE[(size_t)tok * 128 + lane], g1 = GATE[(size_t)tok * 128 + 64 + lane];
        for (int bt = 0; bt < 16; ++bt) {
            float d[8];
#pragma unroll
            for (int r = 0; r < 8; ++r) {
                const int e = bt * 8 + r;
                const int idx = __builtin_amdgcn_readfirstlane(__shfl(bt < 8 ? e0 : e1, e & 63));
                const u32x4* up = (const u32x4*)(U + (size_t)idx * DM) + lane;
                float acc = d0;
#pragma unroll
                for (int i = 0; i < 2; ++i) {
                    const u32x4 w = up[i * 64];
                    acc += x[16 * i + 0] * ub0(w.x) + x[16 * i + 1] * ub1(w.x) + x[16 * i + 2] * ub2(w.x) + x[16 * i + 3] * ub3(w.x)
                         + x[16 * i + 4] * ub0(w.y) + x[16 * i + 5] * ub1(w.y) + x[16 * i + 6] * ub2(w.y) + x[16 * i + 7] * ub3(w.y)
                         + x[16 * i + 8] * ub0(w.z) + x[16 * i + 9] * ub1(w.z) + x[16 * i + 10] * ub2(w.z) + x[16 * i + 11] * ub3(w.z)
                         + x[16 * i + 12] * ub0(w.w) + x[16 * i + 13] * ub1(w.w) + x[16 * i + 14] * ub2(w.w) + x[16 * i + 15] * ub3(w.w);
                }
                d[r] = acc;
            }
            const bool b5 = lane & 32, b4 = lane & 16, b3 = lane & 8;
            float t4[4];
#pragma unroll
            for (int q = 0; q < 4; ++q) { const float keep = b5 ? d[4 + q] : d[q], send = b5 ? d[q] : d[4 + q]; t4[q] = keep + __shfl_xor(send, 32); }
            float t2[2];
#pragma unroll
            for (int q = 0; q < 2; ++q) { const float keep = b4 ? t4[2 + q] : t4[q], send = b4 ? t4[q] : t4[2 + q]; t2[q] = keep + __shfl_xor(send, 16); }
            float t1;
            { const float keep = b3 ? t2[1] : t2[0], send = b3 ? t2[0] : t2[1]; t1 = keep + __shfl_xor(send, 8); }
            t1 += __shfl_xor(t1, 4); t1 += __shfl_xor(t1, 2); t1 += __shfl_xor(t1, 1);
            if ((lane & 7) == 0) hb[bt * 8 + (lane >> 3 & 1) + 2 * (lane >> 4 & 1) + 4 * (lane >> 5 & 1)] = t1;
        }
        asm volatile("s_waitcnt lgkmcnt(0)" ::: "memory");
        const float h0 = hb[lane] * USC[e0], h1 = hb[64 + lane] * USC[e1];
        const float w0 = g0 * gelu_erf(h0) * VSC[e0], w1 = g1 * gelu_erf(h1) * VSC[e1];
        float wsum = wave_sum(w0 + w1);
        float y[32];
#pragma unroll
        for (int i = 0; i < 32; ++i) y[i] = 0.f;
#pragma unroll 8
        for (int e = 0; e < 128; ++e) {
            const int idx = __builtin_amdgcn_readfirstlane(__shfl(e < 64 ? e0 : e1, e & 63));
            const float wt = __shfl(e < 64 ? w0 : w1, e & 63);
            const u32x4* vp = (const u32x4*)(V + (size_t)idx * DM) + lane;
#pragma unroll
            for (int i = 0; i < 2; ++i) {
                const u32x4 w = vp[i * 64];
                y[16 * i + 0] += wt * ub0(w.x); y[16 * i + 1] += wt * ub1(w.x); y[16 * i + 2] += wt * ub2(w.x); y[16 * i + 3] += wt * ub3(w.x);
                y[16 * i + 4] += wt * ub0(w.y); y[16 * i + 5] += wt * ub1(w.y); y[16 * i + 6] += wt * ub2(w.y); y[16 * i + 7] += wt * ub3(w.y);
                y[16 * i + 8] += wt * ub0(w.z); y[16 * i + 9] += wt * ub1(w.z); y[16 * i + 10] += wt * ub2(w.z); y[16 * i + 11] += wt * ub3(w.z);
                y[16 * i + 12] += wt * ub0(w.w); y[16 * i + 13] += wt * ub1(w.w); y[16 * i + 14] += wt * ub2(w.w); y[16 * i + 15] += wt * ub3(w.w);
            }
        }
        const float corr = -128.0f * wsum;
#pragma unroll
        for (int i = 0; i < 32; ++i) y[i] = y[i] + corr + ALPHA * x[i];
        ln_row_store16(y, g, bta, outf + (size_t)tok * DM, outb ? outb + (size_t)tok * DM : nullptr, lane);
        asm volatile("s_waitcnt lgkmcnt(0)" ::: "memory");
    }
}

__device__ __forceinline__ int row_dot_i8(const u32x4 (&xq)[2], const unsigned char* rowp, int lane) {
    const u32x4* up = (const u32x4*)rowp + lane;
    int acc = 0;
#pragma unroll
    for (int i = 0; i < 2; ++i) {
        const u32x4 w = up[i * 64];
        acc = __builtin_amdgcn_sdot4((int)xq[i].x, (int)(w.x ^ 0x80808080u), acc, false); acc = __builtin_amdgcn_sdot4((int)xq[i].y, (int)(w.y ^ 0x80808080u), acc, false);
        acc = __builtin_amdgcn_sdot4((int)xq[i].z, (int)(w.z ^ 0x80808080u), acc, false); acc = __builtin_amdgcn_sdot4((int)xq[i].w, (int)(w.w ^ 0x80808080u), acc, false);
    }
    return acc;
}
__device__ __forceinline__ void peer_issue8(u32x4 (&seg)[8], const unsigned char* base, const u32x4 ia, const u32x4 ib) {
    seg[0] = *(const u32x4*)(base + (size_t)ia.x * DM); seg[1] = *(const u32x4*)(base + (size_t)ia.y * DM); seg[2] = *(const u32x4*)(base + (size_t)ia.z * DM); seg[3] = *(const u32x4*)(base + (size_t)ia.w * DM);
    seg[4] = *(const u32x4*)(base + (size_t)ib.x * DM); seg[5] = *(const u32x4*)(base + (size_t)ib.y * DM); seg[6] = *(const u32x4*)(base + (size_t)ib.z * DM); seg[7] = *(const u32x4*)(base + (size_t)ib.w * DM);
}
__device__ __forceinline__ void peer_dot8(int (&d)[8], const u32x4 (&seg)[8], const u32x4 xq) {
#pragma unroll
    for (int i = 0; i < 8; ++i) {
        int acc = __builtin_amdgcn_sdot4((int)xq.x, (int)(seg[i].x ^ 0x80808080u), 0, false);
        acc = __builtin_amdgcn_sdot4((int)xq.y, (int)(seg[i].y ^ 0x80808080u), acc, false);
        acc = __builtin_amdgcn_sdot4((int)xq.z, (int)(seg[i].z ^ 0x80808080u), acc, false);
        d[i] = __builtin_amdgcn_sdot4((int)xq.w, (int)(seg[i].w ^ 0x80808080u), acc, false);
    }
}
__device__ __forceinline__ void phase_peer_u(const signed char* XQ, const int* EID, const unsigned char* U, LAS int* HL  ) {
    const int lane = threadIdx.x & 63, wv = threadIdx.x >> 6, es = lane >> 3, cc = lane & 7;
    const bool b2 = cc & 4, b1 = cc & 2, b0 = cc & 1;
    const int nw = gridDim.x * 8, gw = blockIdx.x * 8 + wv, tpw = (MTOK + nw - 1) / nw, tbase = gw * tpw;
    int cnt = MTOK - tbase; cnt = cnt > tpw ? tpw : cnt;
    if (cnt <= 0) return;
    for (int i = lane; i < cnt * 128; i += 64) HL[i] = 0;
    asm volatile("s_waitcnt lgkmcnt(0)" ::: "memory");
    const int nit = 16 * cnt;
    const unsigned char* ub = U + cc * 16;
    u32x4 m0a, m0b, m0c, m0d, m0x, m1a, m1b, m1c, m1d, m1x, m2a, m2b, m2c, m2d, m2x; u32x4 sA[8], sB[8];
#define PU_LOAD(sl_, k_, A_, B_, C_, D_, X_) { const int* ep_ = EID + (size_t)(tbase + (k_)) * 128 + es * 16; A_ = *(const u32x4*)ep_; B_ = *(const u32x4*)(ep_ + 4); C_ = *(const u32x4*)(ep_ + 8); D_ = *(const u32x4*)(ep_ + 12); \
        X_ = *(const u32x4*)(XQ + (size_t)(tbase + (k_)) * DM + (sl_) * 128 + cc * 16); }
#define PU_NEXT(sl_, k_, sn_, kn_) { kn_ = (k_) + 1; sn_ = (sl_); if (kn_ == cnt) { kn_ = 0; ++sn_; } if (sn_ == 16) { sn_ = 15; kn_ = cnt - 1; } }
    int sl = 0, k = 0, sl1, k1, sl2, k2;
    PU_NEXT(sl, k, sl1, k1) PU_NEXT(sl1, k1, sl2, k2)
    PU_LOAD(sl, k, m0a, m0b, m0c, m0d, m0x)
    PU_LOAD(sl1, k1, m1a, m1b, m1c, m1d, m1x)
    peer_issue8(sA, ub + sl * 128, m0a, m0b);
    for (int it = 0; it < nit; ++it) {
        PU_LOAD(sl2, k2, m2a, m2b, m2c, m2d, m2x)
        peer_issue8(sB, ub + sl * 128, m0c, m0d);
        int dlo[8]; peer_dot8(dlo, sA, m0x);
        peer_issue8(sA, ub + sl1 * 128, m1a, m1b);
        int dhi[8]; peer_dot8(dhi, sB, m0x);
        int t8[8], t4[4], t2[2];
#pragma unroll
        for (int q = 0; q < 8; ++q) { const int keep = b2 ? dhi[q] : dlo[q], send = b2 ? dlo[q] : dhi[q]; t8[q] = keep + __shfl_xor(send, 4); }
#pragma unroll
        for (int q = 0; q < 4; ++q) { const int keep = b1 ? t8[4 + q] : t8[q], send = b1 ? t8[q] : t8[4 + q]; t4[q] = keep + __shfl_xor(send, 2); }
#pragma unroll
        for (int q = 0; q < 2; ++q) { const int keep = b0 ? t4[2 + q] : t4[q], send = b0 ? t4[q] : t4[2 + q]; t2[q] = keep + __shfl_xor(send, 1); }
        { LAS int* hp = HL + k * 128 + es * 16 + (b2 ? 8 : 0) + (b1 ? 4 : 0) + (b0 ? 2 : 0);
          __hip_atomic_fetch_add(hp, t2[0], __ATOMIC_RELAXED, __HIP_MEMORY_SCOPE_WORKGROUP); __hip_atomic_fetch_add(hp + 1, t2[1], __ATOMIC_RELAXED, __HIP_MEMORY_SCOPE_WORKGROUP); }
        sl = sl1; k = k1; sl1 = sl2; k1 = k2; PU_NEXT(sl1, k1, sl2, k2)
        m0a = m1a; m0b = m1b; m0c = m1c; m0d = m1d; m0x = m1x; m1a = m2a; m1b = m2b; m1c = m2c; m1d = m2d; m1x = m2x;
    }
#undef PU_LOAD
#undef PU_NEXT
}
__device__ __forceinline__ void phase_peer_w(const LAS int* HL, const float* XS, const int* EID, const float* GATE, const float* USC, const float* VSC, signed char* WQ, float* SW) {
    const int lane = threadIdx.x & 63, gw = blockIdx.x * 8 + (threadIdx.x >> 6), nw = gridDim.x * 8, tpw = (MTOK + nw - 1) / nw, tbase = gw * tpw;
    const int tend = tbase + tpw < MTOK ? tbase + tpw : MTOK;
    for (int tok = tbase; tok < tend; ++tok) {
        const int h0 = HL[(tok - tbase) * 128 + lane], h1 = HL[(tok - tbase) * 128 + 64 + lane];
        const int e0 = EID[(size_t)tok * 128 + lane], e1 = EID[(size_t)tok * 128 + 64 + lane];
        const float xs = XS[tok];
        const float w0 = GATE[(size_t)tok * 128 + lane] * gelu_erf((float)h0 * xs * USC[e0]) * VSC[e0];
        const float w1 = GATE[(size_t)tok * 128 + 64 + lane] * gelu_erf((float)h1 * xs * USC[e1]) * VSC[e1];
        const float am = fmaxf(wave_max(fmaxf(fabsf(w0), fabsf(w1))), 1e-30f), inv = 127.0f / am;
        WQ[(size_t)tok * 128 + lane] = (signed char)(int)rintf(w0 * inv); WQ[(size_t)tok * 128 + 64 + lane] = (signed char)(int)rintf(w1 * inv);
        if (lane == 0) SW[tok] = am * (1.0f / 127.0f);
    }
}
__device__ __forceinline__ void peer_dot4x4(int (&acc)[16], const u32x4 sa, const u32x4 sb, const u32x4 sc, const u32x4 sd, const unsigned w4) {
#pragma unroll
    for (int k = 0; k < 4; ++k) {
        const unsigned A = sa[k], B = sb[k], C = sc[k], D = sd[k];
        const unsigned p0 = __builtin_amdgcn_perm(B, A, 0x05010400u);
        const unsigned p1 = __builtin_amdgcn_perm(B, A, 0x07030602u);
        const unsigned p2 = __builtin_amdgcn_perm(D, C, 0x05010400u);
        const unsigned p3 = __builtin_amdgcn_perm(D, C, 0x07030602u);
        const unsigned t0 = __builtin_amdgcn_perm(p2, p0, 0x05040100u);
        const unsigned t1 = __builtin_amdgcn_perm(p2, p0, 0x07060302u);
        const unsigned t2 = __builtin_amdgcn_perm(p3, p1, 0x05040100u);
        const unsigned t3 = __builtin_amdgcn_perm(p3, p1, 0x07060302u);
        acc[4 * k + 0] = __builtin_amdgcn_sdot4((int)t0, (int)w4, acc[4 * k + 0], false);
        acc[4 * k + 1] = __builtin_amdgcn_sdot4((int)t1, (int)w4, acc[4 * k + 1], false);
        acc[4 * k + 2] = __builtin_amdgcn_sdot4((int)t2, (int)w4, acc[4 * k + 2], false);
        acc[4 * k + 3] = __builtin_amdgcn_sdot4((int)t3, (int)w4, acc[4 * k + 3], false);
    }
}
__device__ __forceinline__ void phase_peer_v(const bf16_t* X, const int* EID, const signed char* WQ, const float* SW, const unsigned char* V, float* Y) {
    const int lane = threadIdx.x & 63, wv = threadIdx.x >> 6, es = lane >> 3, cc = lane & 7;
    const bool b5 = lane & 32, b4 = lane & 16, b3 = lane & 8;
    const int nw = gridDim.x * 8, gw = blockIdx.x * 8 + wv, tpw = (MTOK + nw - 1) / nw, tbase = gw * tpw;
    int cnt = MTOK - tbase; cnt = cnt > tpw ? tpw : cnt;
    if (cnt <= 0) return;
    const int nit = 16 * cnt;
    const unsigned char* vb = V + cc * 16;
    const int colo = cc * 16 + (b5 ? 8 : 0) + (b4 ? 4 : 0) + (b3 ? 2 : 0);
    u32x4 m0c, m0d, m1a, m1b, m1c, m1d, m2a, m2b, m2c, m2d; u32x4 w0, w1; unsigned x0, x1; float c0, c1; u32x4 sA[8], sB[8];
#define PV_IDS(k_, A_, B_, C_, D_) { const size_t o_ = (size_t)(tbase + (k_)) * 128 + es * 16; A_ = *(const u32x4*)(EID + o_); B_ = *(const u32x4*)(EID + o_ + 4); C_ = *(const u32x4*)(EID + o_ + 8); D_ = *(const u32x4*)(EID + o_ + 12); }
#define PV_WX(sl_, k_, W_, X_, CS_) { W_ = *(const u32x4*)(WQ + (size_t)(tbase + (k_)) * 128 + es * 16); \
        X_ = *(const unsigned*)(X + (size_t)(tbase + (k_)) * DM + (sl_) * 128 + colo); CS_ = SW[tbase + (k_)]; }
#define PV_NEXT(sl_, k_, sn_, kn_) { kn_ = (k_) + 1; sn_ = (sl_); if (kn_ == cnt) { kn_ = 0; ++sn_; } if (sn_ == 16) { sn_ = 15; kn_ = cnt - 1; } }
    int sl = 0, k = 0, sl1, k1, sl2, k2;
    PV_NEXT(sl, k, sl1, k1) PV_NEXT(sl1, k1, sl2, k2)
    { u32x4 ta, tb; PV_IDS(k, ta, tb, m0c, m0d) PV_IDS(k1, m1a, m1b, m1c, m1d)
      PV_WX(sl, k, w0, x0, c0)
      peer_issue8(sA, vb + sl * 128, ta, tb); }
    for (int it = 0; it < nit; ++it) {
        PV_IDS(k2, m2a, m2b, m2c, m2d)
        peer_issue8(sB, vb + sl * 128, m0c, m0d);
        int ya[16];
#pragma unroll
        for (int j = 0; j < 16; ++j) ya[j] = 0;
        peer_dot4x4(ya, sA[0], sA[1], sA[2], sA[3], w0.x); peer_dot4x4(ya, sA[4], sA[5], sA[6], sA[7], w0.y);
        peer_issue8(sA, vb + sl1 * 128, m1a, m1b);
        PV_WX(sl1, k1, w1, x1, c1)
        peer_dot4x4(ya, sB[0], sB[1], sB[2], sB[3], w0.z); peer_dot4x4(ya, sB[4], sB[5], sB[6], sB[7], w0.w);
        int t8[8], t4[4], t2[2];
#pragma unroll
        for (int q = 0; q < 8; ++q) { const int keep = b5 ? ya[8 + q] : ya[q], send = b5 ? ya[q] : ya[8 + q]; t8[q] = keep + __shfl_xor(send, 32); }
#pragma unroll
        for (int q = 0; q < 4; ++q) { const int keep = b4 ? t8[4 + q] : t8[q], send = b4 ? t8[q] : t8[4 + q]; t4[q] = keep + __shfl_xor(send, 16); }
#pragma unroll
        for (int q = 0; q < 2; ++q) { const int keep = b3 ? t4[2 + q] : t4[q], send = b3 ? t4[q] : t4[2 + q]; t2[q] = keep + __shfl_xor(send, 8); }
        f32x2_t o; o[0] = (float)t2[0] * c0 + ALPHA * bflo(x0); o[1] = (float)t2[1] * c0 + ALPHA * bfhi(x0);
        *(f32x2_t*)(Y + (size_t)(tbase + k) * DM + sl * 128 + colo) = o;
        sl = sl1; k = k1; sl1 = sl2; k1 = k2; PV_NEXT(sl1, k1, sl2, k2)
        m0c = m1c; m0d = m1d; m1a = m2a; m1b = m2b; m1c = m2c; m1d = m2d;
        w0 = w1; x0 = x1; c0 = c1;
    }
#undef PV_IDS
#undef PV_WX
#undef PV_NEXT
}

__device__ __forceinline__ void rot8(const u32x4 lo, const u32x4 hi, const f32x4 c0, const f32x4 c1, const f32x4 s0, const f32x4 s1, float (&o1)[8], float (&o2)[8]) {
    const float a[8] = {bflo(lo.x), bfhi(lo.x), bflo(lo.y), bfhi(lo.y), bflo(lo.z), bfhi(lo.z), bflo(lo.w), bfhi(lo.w)};
    const float b[8] = {bflo(hi.x), bfhi(hi.x), bflo(hi.y), bfhi(hi.y), bflo(hi.z), bfhi(hi.z), bflo(hi.w), bfhi(hi.w)};
    const float c[8] = {c0[0], c0[1], c0[2], c0[3], c1[0], c1[1], c1[2], c1[3]}, sn[8] = {s0[0], s0[1], s0[2], s0[3], s1[0], s1[1], s1[2], s1[3]};
#pragma unroll
    for (int j = 0; j < 8; ++j) { o1[j] = a[j] * c[j] - b[j] * sn[j]; o2[j] = a[j] * sn[j] + b[j] * c[j]; }
}
__device__ __forceinline__ u32x4 pack8(const float (&o)[8]) { u32x4 w; w.x = pk_bf16(o[0], o[1]); w.y = pk_bf16(o[2], o[3]); w.z = pk_bf16(o[4], o[5]); w.w = pk_bf16(o[6], o[7]); return w; }
__device__ __forceinline__ void phase_kstat(LAS float* red, const bf16_t* KR, float* KMEAN, float* KNMAX) {
    const int tid = threadIdx.x, ch = tid & 7, rr = tid >> 3, wv = tid >> 6, lane = tid & 63;
    for (int item = blockIdx.x; item < 2 * NHEAD * 32; item += gridDim.x) {
        const int bh = item >> 5, j = item & 31, b = bh >> 4, h = bh & 15;
        float sm1[8], sm2[8]; float nmax = 0.f;
#pragma unroll
        for (int q = 0; q < 8; ++q) { sm1[q] = 0.f; sm2[q] = 0.f; }
        u32x4 lo[4], hi[4];
#pragma unroll
        for (int ps = 0; ps < 4; ++ps) { const size_t off = ((size_t)b * SEQ + j * 256 + ps * 64 + rr) * DM + h * 128 + ch * 8; lo[ps] = *(const u32x4*)(KR + off); hi[ps] = *(const u32x4*)(KR + off + 64); }
#pragma unroll
        for (int ps = 0; ps < 4; ++ps) {
            const float a[8] = {bflo(lo[ps].x), bfhi(lo[ps].x), bflo(lo[ps].y), bfhi(lo[ps].y), bflo(lo[ps].z), bfhi(lo[ps].z), bflo(lo[ps].w), bfhi(lo[ps].w)};
            const float c[8] = {bflo(hi[ps].x), bfhi(hi[ps].x), bflo(hi[ps].y), bfhi(hi[ps].y), bflo(hi[ps].z), bfhi(hi[ps].z), bflo(hi[ps].w), bfhi(hi[ps].w)};
            float nq = 0.f;
#pragma unroll
            for (int q = 0; q < 8; ++q) { sm1[q] += a[q]; sm2[q] += c[q]; nq += a[q] * a[q] + c[q] * c[q]; }
            nq += __shfl_xor(nq, 1); nq += __shfl_xor(nq, 2); nq += __shfl_xor(nq, 4);
            nmax = fmaxf(nmax, nq);
        }
#pragma unroll
        for (int q = 0; q < 8; ++q) {
            sm1[q] += __shfl_xor(sm1[q], 8); sm1[q] += __shfl_xor(sm1[q], 16); sm1[q] += __shfl_xor(sm1[q], 32);
            sm2[q] += __shfl_xor(sm2[q], 8); sm2[q] += __shfl_xor(sm2[q], 16); sm2[q] += __shfl_xor(sm2[q], 32);
        }
        nmax = wave_max(nmax);
        if (lane < 8) {
#pragma unroll
            for (int q = 0; q < 8; ++q) { red[wv * 128 + lane * 8 + q] = sm1[q]; red[wv * 128 + 64 + lane * 8 + q] = sm2[q]; }
        }
        if (lane == 0) red[1024 + wv] = nmax;
        __syncthreads();
        if (tid < 128) {
            float s2 = 0.f;
#pragma unroll
            for (int r = 0; r < 8; ++r) s2 += red[r * 128 + tid];
            KMEAN[(size_t)item * 128 + tid] = s2 * (1.0f / 256.0f);
        }
        if (tid == 0) {
            float m = 0.f;
#pragma unroll
            for (int r = 0; r < 8; ++r) m = fmaxf(m, red[1024 + r]);
            KNMAX[item] = sqrtf(m);
        }
        __syncthreads();
    }
}

__device__ __forceinline__ void top3_insert(float x, int m, float& v0, int& i0, float& v1, int& i1, float& v2, int& i2) {
    const bool c0 = x > v0 || (x == v0 && m < i0), c1 = x > v1 || (x == v1 && m < i1), c2 = x > v2 || (x == v2 && m < i2);
    v2 = c1 ? v1 : (c2 ? x : v2); i2 = c1 ? i1 : (c2 ? m : i2);
    v1 = c0 ? v0 : (c1 ? x : v1); i1 = c0 ? i0 : (c1 ? m : i1);
    v0 = c0 ? x : v0; i0 = c0 ? m : i0;
}
__device__ __forceinline__ void phase_sel(LAS unsigned char* lds, const bf16_t* QR, const float* KMEAN, unsigned short* SUB, int* CNT, int* ctr) {
    const int tid = threadIdx.x, lane = tid & 63, wv = tid >> 6, r32 = lane & 31, hh = lane >> 5;
    LAS unsigned short* bucket = (LAS unsigned short*)lds;
    LAS int* cnt = (LAS int*)(lds + 16384);
    const float NEG = -1e30f;
    if (blockIdx.x == 0 && tid == 0) *ctr = 0;
    for (int item = blockIdx.x; item < 2 * NHEAD * 32; item += gridDim.x) {
        const int bh = item >> 5, i = item & 31, b = bh >> 4, h = bh & 15;
        if (i == 0) continue;
        if (tid < 32) cnt[tid] = 0;
        __syncthreads();
        const float* kmp = KMEAN + ((size_t)bh * 32 + r32) * 128 + 8 * hh;
        const size_t tok = (size_t)b * SEQ + i * 256 + wv * 32 + r32;
        const bf16_t* qp = QR + tok * DM + h * 128 + 8 * hh;
        f32x16 S;
#pragma unroll
        for (int e = 0; e < 16; ++e) S[e] = 0.f;
#pragma unroll
        for (int s2 = 0; s2 < 8; ++s2) {
            const f32x4 ka = *(const f32x4*)(kmp + 16 * s2), kb = *(const f32x4*)(kmp + 16 * s2 + 4);
            const bf16x8 qf = *(const bf16x8*)(qp + 16 * s2);
            u32x4 hi, lo;
            hi.x = pk_bf16(ka[0], ka[1]); hi.y = pk_bf16(ka[2], ka[3]); hi.z = pk_bf16(kb[0], kb[1]); hi.w = pk_bf16(kb[2], kb[3]);
            lo.x = pk_bf16(ka[0] - bflo(hi.x), ka[1] - bfhi(hi.x)); lo.y = pk_bf16(ka[2] - bflo(hi.y), ka[3] - bfhi(hi.y));
            lo.z = pk_bf16(kb[0] - bflo(hi.z), kb[1] - bfhi(hi.z)); lo.w = pk_bf16(kb[2] - bflo(hi.w), kb[3] - bfhi(hi.w));
            S = __builtin_amdgcn_mfma_f32_32x32x16_bf16(__builtin_bit_cast(bf16x8, hi), qf, S, 0, 0, 0);
            S = __builtin_amdgcn_mfma_f32_32x32x16_bf16(__builtin_bit_cast(bf16x8, lo), qf, S, 0, 0, 0);
        }
        float v0 = -3e38f, v1 = -3e38f, v2 = -3e38f; int i0 = 99, i1 = 99, i2 = 99;
#pragma unroll
        for (int e = 0; e < 16; ++e) {
            const int m = (e & 3) + 8 * (e >> 2) + 4 * hh;
            const float x = m < i ? S[e] : NEG;
            top3_insert(x, m, v0, i0, v1, i1, v2, i2);
        }
        {
            const float pv0 = __shfl_xor(v0, 32), pv1 = __shfl_xor(v1, 32), pv2 = __shfl_xor(v2, 32);
            const int pi0 = __shfl_xor(i0, 32), pi1 = __shfl_xor(i1, 32), pi2 = __shfl_xor(i2, 32);
            top3_insert(pv0, pi0, v0, i0, v1, i1, v2, i2); top3_insert(pv1, pi1, v0, i0, v1, i1, v2, i2); top3_insert(pv2, pi2, v0, i0, v1, i1, v2, i2);
        }
        if (hh == 0) {
            const int tl = wv * 32 + r32;
            if (v0 > 0.5f * NEG) { const int p = __hip_atomic_fetch_add(cnt + i0, 1, __ATOMIC_RELAXED, __HIP_MEMORY_SCOPE_WORKGROUP); bucket[i0 * 256 + p] = (unsigned short)(tl | (0 << 8)); }
            if (v1 > 0.5f * NEG) { const int p = __hip_atomic_fetch_add(cnt + i1, 1, __ATOMIC_RELAXED, __HIP_MEMORY_SCOPE_WORKGROUP); bucket[i1 * 256 + p] = (unsigned short)(tl | (1 << 8)); }
            if (v2 > 0.5f * NEG) { const int p = __hip_atomic_fetch_add(cnt + i2, 1, __ATOMIC_RELAXED, __HIP_MEMORY_SCOPE_WORKGROUP); bucket[i2 * 256 + p] = (unsigned short)(tl | (2 << 8)); }
        }
        __syncthreads();
        for (int idx = tid; idx < 32 * 256; idx += 512) {
            const int j = idx >> 8, p = idx & 255;
            if (j < i && p < cnt[j]) SUB[(((size_t)bh * 32 + j) * 32 + i) * 256 + p] = bucket[idx];
        }
        if (tid < i) CNT[((size_t)bh * 32 + tid) * 32 + i] = cnt[tid];
        __syncthreads();
    }
}

__device__ __forceinline__ unsigned off_b(unsigned row, unsigned ch) { return 256u * row + 16u * (ch ^ (((row & 3u) << 2) | ((row >> 2) & 3u))); }
__device__ __forceinline__ unsigned pi32(unsigned m) { return (m & ~12u) | ((m & 4u) << 1) | ((m & 8u) >> 1); }
__device__ __forceinline__ bf16x8 tr_frag(LAS unsigned char* img, unsigned lane, unsigned c, unsigned ks) {
    const unsigned hh = lane >> 5, blk = (lane >> 4) & 1, q = (lane & 15) >> 2, p = lane & 3;
    const unsigned a0 = off_b(16 * ks + 8 * hh + q, 4 * c + 2 * blk + (p >> 1)) + 8 * (p & 1);
    const unsigned a1 = off_b(16 * ks + 8 * hh + 4 + q, 4 * c + 2 * blk + (p >> 1)) + 8 * (p & 1);
    const s16x4 lo = __builtin_amdgcn_ds_read_tr16_b64_v4i16((LAS s16x4*)(img + a0));
    const s16x4 hi = __builtin_amdgcn_ds_read_tr16_b64_v4i16((LAS s16x4*)(img + a1));
    bf16x8 r; r[0] = lo[0]; r[1] = lo[1]; r[2] = lo[2]; r[3] = lo[3]; r[4] = hi[0]; r[5] = hi[1]; r[6] = hi[2]; r[7] = hi[3];
    return r;
}
__device__ __forceinline__ void phase_att(LAS unsigned char* lds, const bf16_t* QR, const bf16_t* KR, const bf16_t* V, const float* KNMAX, const unsigned short* SUB, const int* CNT, int* ctr,
                                          bf16_t* P012, bf16_t* P3, float* LS) {
    const int tid = threadIdx.x, lane = tid & 63, wv = tid >> 6, r32 = lane & 31, hh = lane >> 5;
    LAS unsigned char* Kimg = lds;
    LAS unsigned char* Vimg = lds + 65536;
    LAS int* misc = (LAS int*)(lds + 131072);
    const float SCL2 = 0.08838834764831845f * 1.4426950408889634f;
    for (;;) {
        __syncthreads();
        if (tid == 0) misc[40] = __hip_atomic_fetch_add(ctr, 1, __ATOMIC_RELAXED, __HIP_MEMORY_SCOPE_AGENT);
        __syncthreads();
        const int item = misc[40];
        if (item >= 2 * NHEAD * 32) break;
        const int j = item >> 5, bh = item & 31, b = bh >> 4, h = bh & 15;
#pragma unroll
        for (int r = 0; r < 8; ++r) {
            const int idx = tid + 512 * r, row = idx >> 4, ch = idx & 15;
            const size_t g = ((size_t)b * SEQ + j * 256 + row) * DM + h * 128 + ch * 8;
            const u32x4 kv = *(const u32x4*)(KR + g), vv = *(const u32x4*)(V + g);
            *(LAS u32x4*)(Kimg + off_b(row, ch)) = kv; *(LAS u32x4*)(Vimg + off_b(row, ch)) = vv;
        }
        if (tid <= 32) { int pre = 0; for (int u = j + 1; u < tid; ++u) pre += CNT[((size_t)bh * 32 + j) * 32 + u]; misc[tid] = pre; }
        float kn = (lane < 32) ? KNMAX[bh * 32 + lane] : 0.f;
        kn = wave_max(kn);
        __syncthreads();
        const int total = misc[32], ntile = (256 + total + 31) >> 5;
        for (int tile = wv; tile < ntile; tile += 8) {
            const int gr = tile * 32 + r32;
            int pos, slot; bool valid = true;
            if (gr < 256) { pos = j * 256 + gr; slot = 3; }
            else {
                const int x = gr - 256; valid = x < total;
                int ii = j + 1;
                for (int u = j + 1; u < 32; ++u) if (misc[u] <= x) ii = u;
                if (valid) { const unsigned e = SUB[(((size_t)bh * 32 + j) * 32 + ii) * 256 + (x - misc[ii])]; pos = ii * 256 + (int)(e & 255u); slot = (int)(e >> 8); }
                else { pos = j * 256; slot = 3; }
            }
            const size_t tok = (size_t)b * SEQ + pos;
            bf16x8 qf[8];
            const bf16_t* qp = QR + tok * DM + h * 128 + 8 * hh;
#pragma unroll
            for (int s = 0; s < 8; ++s) qf[s] = *(const bf16x8*)(qp + 16 * s);
            float qn2 = 0.f;
#pragma unroll
            for (int s = 0; s < 8; ++s)
#pragma unroll
                for (int e = 0; e < 8; ++e) { const float f = bf2f((bf16_t)qf[s][e]); qn2 += f * f; }
            qn2 += __shfl_xor(qn2, 32);
            const float c2 = sqrtf(qn2) * kn * SCL2;
            f32x16 O[4];
#pragma unroll
            for (int dt = 0; dt < 4; ++dt)
#pragma unroll
                for (int e = 0; e < 16; ++e) O[dt][e] = 0.f;
            float l = 0.f;
            const bool own = tile < 8;
            const int kcn = own ? tile + 1 : 8;
            const unsigned krow = pi32((unsigned)r32);
            for (int kc = 0; kc < kcn; ++kc) {
                f32x16 S, S1;
#pragma unroll
                for (int e = 0; e < 16; ++e) { S[e] = 0.f; S1[e] = 0.f; }
#pragma unroll
                for (int s = 0; s < 8; s += 2) {
                    const bf16x8 kf = *(const LAS bf16x8*)(Kimg + off_b(32 * kc + krow, 2 * s + hh));
                    const bf16x8 kf1 = *(const LAS bf16x8*)(Kimg + off_b(32 * kc + krow, 2 * s + 2 + hh));
                    S = __builtin_amdgcn_mfma_f32_32x32x16_bf16(kf, qf[s], S, 0, 0, 0);
                    S1 = __builtin_amdgcn_mfma_f32_32x32x16_bf16(kf1, qf[s + 1], S1, 0, 0, 0);
                }
                float p[16];
                if (own) {
#pragma unroll
                    for (int e = 0; e < 16; ++e) {
                        const unsigned m = (e & 3) + 8 * (e >> 2) + 4 * hh;
                        const int key = j * 256 + 32 * kc + (int)pi32(m);
                        float pe = __builtin_amdgcn_exp2f((S[e] + S1[e]) * SCL2 - c2);
                        if (key > pos) pe = 0.f;
                        p[e] = pe; l += pe;
                    }
                } else {
#pragma unroll
                    for (int e = 0; e < 16; ++e) { const float pe = __builtin_amdgcn_exp2f((S[e] + S1[e]) * SCL2 - c2); p[e] = pe; l += pe; }
                }
                u32x4 w0, w1;
                w0.x = pk_bf16(p[0], p[1]); w0.y = pk_bf16(p[2], p[3]); w0.z = pk_bf16(p[4], p[5]); w0.w = pk_bf16(p[6], p[7]);
                w1.x = pk_bf16(p[8], p[9]); w1.y = pk_bf16(p[10], p[11]); w1.z = pk_bf16(p[12], p[13]); w1.w = pk_bf16(p[14], p[15]);
                const bf16x8 pf0 = __builtin_bit_cast(bf16x8, w0), pf1 = __builtin_bit_cast(bf16x8, w1);
#pragma unroll
                for (int dt = 0; dt < 4; ++dt) {
                    const bf16x8 v0 = tr_frag(Vimg, lane, dt, 2 * kc), v1 = tr_frag(Vimg, lane, dt, 2 * kc + 1);
                    O[dt] = __builtin_amdgcn_mfma_f32_32x32x16_bf16(v0, pf0, O[dt], 0, 0, 0);
                    O[dt] = __builtin_amdgcn_mfma_f32_32x32x16_bf16(v1, pf1, O[dt], 0, 0, 0);
                }
            }
            l += __shfl_xor(l, 32);
            if (valid) {
                bf16_t* pl = (slot < 3 ? P012 + (size_t)slot * ((size_t)32 << 20) : P3) + (tok * NHEAD + h) * 128 + 4 * hh;
#pragma unroll
                for (int dt = 0; dt < 4; ++dt)
#pragma unroll
                    for (int g = 0; g < 4; ++g) {
                        u32x2 w; w.x = pk_bf16(O[dt][4 * g], O[dt][4 * g + 1]); w.y = pk_bf16(O[dt][4 * g + 2], O[dt][4 * g + 3]);
                        *(u32x2*)(pl + 32 * dt + 8 * g) = w;
                    }
                if (hh == 0) LS[(size_t)slot * MTOK * NHEAD + tok * NHEAD + h] = l;
            }
        }
    }
}
__device__ __forceinline__ void phase_comb(LAS float* red, const bf16_t* P012, const bf16_t* P3, const float* LS, signed char* AO8, float* XSO) {
    const int tid = threadIdx.x, tsel = tid >> 8, hd = (tid & 255) >> 4, ch = tid & 15, wv = tid >> 6;
    u32x4 nw[4]; float nl[4];
#define CB_LOAD(pair_) { const size_t th_ = ((size_t)(2 * (pair_) + tsel)) * NHEAD + hd; nw[3] = *(const u32x4*)(P3 + th_ * 128 + ch * 8); nl[3] = LS[(size_t)3 * MTOK * NHEAD + th_]; \
        _Pragma("unroll") for (int s_ = 0; s_ < 3; ++s_) { nw[s_] = *(const u32x4*)(P012 + (size_t)s_ * ((size_t)32 << 20) + th_ * 128 + ch * 8); nl[s_] = LS[(size_t)s_ * MTOK * NHEAD + th_]; } }
    if ((int)blockIdx.x < MTOK / 2) CB_LOAD((int)blockIdx.x)
    int par = 0;
    for (int pair = blockIdx.x; pair < MTOK / 2; pair += gridDim.x, par ^= 1) {
        const int token = 2 * pair + tsel;
        const int t = token & (SEQ - 1), blk = t >> 8, nsel = blk < 3 ? blk : 3;
        float acc[8];
        float l = nl[3];
        { const u32x4 w = nw[3];
          acc[0] = bflo(w.x); acc[1] = bfhi(w.x); acc[2] = bflo(w.y); acc[3] = bfhi(w.y); acc[4] = bflo(w.z); acc[5] = bfhi(w.z); acc[6] = bflo(w.w); acc[7] = bfhi(w.w); }
#pragma unroll
        for (int s = 0; s < 3; ++s) {
            u32x4 w = nw[s]; float ls = nl[s];
            if (s >= nsel) { w = (u32x4){0u, 0u, 0u, 0u}; ls = 0.f; }
            acc[0] += bflo(w.x); acc[1] += bfhi(w.x); acc[2] += bflo(w.y); acc[3] += bfhi(w.y); acc[4] += bflo(w.z); acc[5] += bfhi(w.z); acc[6] += bflo(w.w); acc[7] += bfhi(w.w);
            l += ls;
        }
        if (pair + (int)gridDim.x < MTOK / 2) CB_LOAD(pair + (int)gridDim.x)
        const float rl = 1.0f / l;
        float am = 0.f;
#pragma unroll
        for (int j = 0; j < 8; ++j) { acc[j] *= rl; am = fmaxf(am, fabsf(acc[j])); }
        am = wave_max(am);
        if ((tid & 63) == 0) red[par * 8 + wv] = am;
        __syncthreads();
        am = fmaxf(fmaxf(fmaxf(red[par * 8 + 4 * tsel], red[par * 8 + 4 * tsel + 1]), fmaxf(red[par * 8 + 4 * tsel + 2], red[par * 8 + 4 * tsel + 3])), 1e-30f);
        const float inv = 127.0f / am;
        if ((tid & 255) == 0) XSO[token] = am * (1.0f / 127.0f);
        u32x2 o;
        o.x = ((unsigned)(int)rintf(acc[0] * inv) & 0xffu) | (((unsigned)(int)rintf(acc[1] * inv) & 0xffu) << 8) | (((unsigned)(int)rintf(acc[2] * inv) & 0xffu) << 16) | (((unsigned)(int)rintf(acc[3] * inv) & 0xffu) << 24);
        o.y = ((unsigned)(int)rintf(acc[4] * inv) & 0xffu) | (((unsigned)(int)rintf(acc[5] * inv) & 0xffu) << 8) | (((unsigned)(int)rintf(acc[6] * inv) & 0xffu) << 16) | (((unsigned)(int)rintf(acc[7] * inv) & 0xffu) << 24);
        *(u32x2*)(AO8 + (size_t)token * DM + hd * 128 + ch * 8) = o;
    }
#undef CB_LOAD
}


__device__ __forceinline__ void qrow_issue(f32x4 (&v)[8], const float* p, int lane) {
#pragma unroll
    for (int i = 0; i < 2; ++i)
#pragma unroll
        for (int q = 0; q < 4; ++q) v[i * 4 + q] = *(const f32x4*)(p + 1024 * i + 16 * lane + 4 * q);
}
__device__ __forceinline__ void qrow_finish(const f32x4 (&v)[8], unsigned char* dst, float* scl, int lane, bool sgn = false) {
    float am = 0.f;
#pragma unroll
    for (int i = 0; i < 8; ++i) am = fmaxf(am, fmaxf(fmaxf(fabsf(v[i][0]), fabsf(v[i][1])), fmaxf(fabsf(v[i][2]), fabsf(v[i][3]))));
    am = fmaxf(wave_max(am), 1e-30f);
    const float inv = 127.0f / am;
    if (lane == 0) *scl = am * (1.0f / 127.0f);
#pragma unroll
    for (int i = 0; i < 2; ++i) {
        u32x4 w;
#pragma unroll
        for (int q = 0; q < 4; ++q) {
            const f32x4 t = v[i * 4 + q];
            const float off = sgn ? 0.0f : 128.0f;
            const unsigned b0 = (unsigned)(int)(rintf(t[0] * inv) + off) & 0xffu, b1 = (unsigned)(int)(rintf(t[1] * inv) + off) & 0xffu, b2 = (unsigned)(int)(rintf(t[2] * inv) + off) & 0xffu, b3 = (unsigned)(int)(rintf(t[3] * inv) + off) & 0xffu;
            w[q] = b0 | (b1 << 8) | (b2 << 16) | (b3 << 24);
        }
        *(u32x4*)(dst + 1024 * i + 16 * lane) = w;
    }
}
struct QuantJob { const float* TU; const float* TV; unsigned char* QU; unsigned char* QV; float* SU; float* SV; };
__device__ __forceinline__ const float* qj_src(const QuantJob& q, int r) { return (r < 16384 ? q.TU : q.TV) + (size_t)(r & 16383) * DM; }
__device__ __forceinline__ unsigned char* qj_dst(const QuantJob& q, int r) { return (r < 16384 ? q.QU : q.QV) + (size_t)(r & 16383) * DM; }
__device__ __forceinline__ float* qj_scl(const QuantJob& q, int r) { return (r < 16384 ? q.SU : q.SV) + (r & 16383); }
__device__ __forceinline__ void qj_tail(const QuantJob& q, int done_iters) {
    const int lane = threadIdx.x & 63, gw = blockIdx.x * 8 + (threadIdx.x >> 6), nw = gridDim.x * 8;
    for (int r = gw + done_iters * nw; r < 32768; r += nw) { f32x4 v[8]; qrow_issue(v, qj_src(q, r), lane); qrow_finish(v, qj_dst(q, r), qj_scl(q, r), lane, r >= 16384); }
}
__device__ __forceinline__ float logf_gate(float z, float lb) { return __logf(lb + (1.0f - lb) * sigmoidf_(z)); }
__device__ __forceinline__ void phase_scan_a(LAS unsigned char* lds, const bf16_t* FZ, const float* LB, const bf16_t* I1, bf16_t* LT, float* DEC, const QuantJob qj, unsigned* dbgc = nullptr) {
    unsigned dbg_kt = 0, dbg_acc = 0;
    const int tid = threadIdx.x, lane = tid & 63, wv = tid >> 6, k = tid & 127, part = tid >> 7;
    LAS unsigned char* Iimg = lds; LAS unsigned char* KTimg = lds + 16384;
    LAS float* psum = (LAS float*)(lds + 32768);
    LAS unsigned char* Lst = lds + 36864;
#if SCAN_A_VALU == 2
    for (int item = blockIdx.x; item < 2 * NHEAD * 128; item += gridDim.x) {
        const int bh = item >> 7, c = item & 127, b = bh >> 4, h = bh & 15;
        const size_t tok0 = (size_t)b * SEQ + c * 64;
        for (int idx = tid; idx < 16384; idx += 512) {
            const int v = idx >> 7, kk = idx & 127;
            float g = 1.f, L = 0.f;
            for (int s2 = 63; s2 >= 0; --s2) { const size_t o = (tok0 + s2) * DM + h * 128; const float f = __expf(logf_gate(bf2f(FZ[o + kk]), LB[h * 128 + kk])); L += bf2f(I1[o + v]) * (1.0f - f) * g; g *= f; }
            LT[(size_t)item * 16384 + idx] = (bf16_t)(pk_bf16(L, 0.f) & 0xffffu);
        }
    }
    return;
#endif
    bf16_t nfz[16]; u32x4 nit_[2];
#define SA_LOAD(item_) { const int bh_ = (item_) >> 7, c_ = (item_) & 127; const size_t t0_ = (size_t)(bh_ >> 4) * SEQ + c_ * 64; const int h_ = bh_ & 15; \
        _Pragma("unroll") for (int i = 0; i < 16; ++i) nfz[i] = FZ[(t0_ + 16 * part + i) * DM + h_ * 128 + k]; \
        _Pragma("unroll") for (int r = 0; r < 2; ++r) { const int idx = tid + 512 * r, row = idx >> 4, ch = idx & 15; nit_[r] = *(const u32x4*)(I1 + (t0_ + row) * DM + h_ * 128 + ch * 8); } }
    if ((int)blockIdx.x < 2 * NHEAD * 128) SA_LOAD((int)blockIdx.x)
    int qiter = 0;
    for (int item = blockIdx.x; item < 2 * NHEAD * 128; item += gridDim.x, ++qiter) {
        const int bh = item >> 7, c = item & 127, b = bh >> 4, h = bh & 15;
        const size_t tok0 = (size_t)b * SEQ + c * 64;
        float lf[16];
        const float lbk = LB[h * 128 + k];
        unsigned fz2[8];
#pragma unroll
        for (int i = 0; i < 8; ++i) fz2[i] = (unsigned)nfz[2 * i] | ((unsigned)nfz[2 * i + 1] << 16);
#pragma unroll
        for (int r = 0; r < 2; ++r) { const int idx = tid + 512 * r, row = idx >> 4, ch = idx & 15; *(LAS u32x4*)(Iimg + off_b(row, ch)) = nit_[r]; }
        asm volatile("" ::: "memory");
        if (item + (int)gridDim.x < 2 * NHEAD * 128) SA_LOAD(item + (int)gridDim.x)
        const int qrow = qiter * (int)gridDim.x * 8 + (int)blockIdx.x * 8 + wv; const bool doq = qrow < 32768; f32x4 qv8[8];
        if (doq) qrow_issue(qv8, qj_src(qj, qrow), lane);
        asm volatile("" ::: "memory");
#pragma unroll
        for (int i = 0; i < 8; ++i) { lf[2 * i] = logf_gate(bflo(fz2[i]), lbk); lf[2 * i + 1] = logf_gate(bfhi(fz2[i]), lbk); }
        float cs = 0.f;
#pragma unroll
        for (int i = 0; i < 16; ++i) cs += lf[i];
        psum[part * 128 + k] = cs;
        __syncthreads();
        const float p0 = psum[k], p1 = psum[128 + k], p2 = psum[256 + k], p3 = psum[384 + k];
        const float blast = (p0 + p1) + (p2 + p3);
        float bb = part == 0 ? 0.f : (part == 1 ? p0 : (part == 2 ? p0 + p1 : p0 + p1 + p2));
#pragma unroll
        for (int i = 0; i < 16; ++i) {
            bb += lf[i];
            const float kt = (1.0f - __expf(lf[i])) * __expf(blast - bb);
            if (!(kt - kt == 0.f)) ++dbg_kt;
            const int srow = 16 * part + i;
            *(LAS bf16_t*)(KTimg + off_b(srow, k >> 3) + 2 * (k & 7)) = (bf16_t)(pk_bf16(kt, 0.f) & 0xffffu);
        }
        if (part == 0) DEC[(size_t)item * 128 + k] = __expf(blast);
        __syncthreads();
#if SCAN_A_VALU
        for (int idx = tid; idx < 16384; idx += 512) {
            const int v = idx >> 7, kk = idx & 127;
            float accv = 0.f;
            for (int s2 = 0; s2 < 64; ++s2) accv += bf2f(*(const LAS bf16_t*)(Iimg + off_b(s2, v >> 3) + 2 * (v & 7))) * bf2f(*(const LAS bf16_t*)(KTimg + off_b(s2, kk >> 3) + 2 * (kk & 7)));
            *(LAS bf16_t*)(Lst + v * 272 + 2 * kk) = (bf16_t)(pk_bf16(accv, 0.f) & 0xffffu);
        }
        if (0)
#endif
        {
            const int vt = wv >> 1;
            f32x16 acc0, acc1;
#pragma unroll
            for (int e = 0; e < 16; ++e) { acc0[e] = 0.f; acc1[e] = 0.f; }
#pragma unroll
            for (int ks = 0; ks < 4; ++ks) {
                const bf16x8 af = tr_frag(Iimg, lane, vt, ks);
                const bf16x8 b0 = tr_frag(KTimg, lane, 2 * (wv & 1), ks), b1 = tr_frag(KTimg, lane, 2 * (wv & 1) + 1, ks);
                acc0 = __builtin_amdgcn_mfma_f32_32x32x16_bf16(af, b0, acc0, 0, 0, 0);
                acc1 = __builtin_amdgcn_mfma_f32_32x32x16_bf16(af, b1, acc1, 0, 0, 0);
            }
            const int r32 = lane & 31, hh = lane >> 5;
#pragma unroll
            for (int e = 0; e < 16; ++e) {
                if (!(acc0[e] - acc0[e] == 0.f)) ++dbg_acc; if (!(acc1[e] - acc1[e] == 0.f)) ++dbg_acc;
                const int v = 32 * vt + (e & 3) + 8 * (e >> 2) + 4 * hh;
                *(LAS bf16_t*)(Lst + v * 272 + 2 * (64 * (wv & 1) + r32)) = (bf16_t)(pk_bf16(acc0[e], 0.f) & 0xffffu);
                *(LAS bf16_t*)(Lst + v * 272 + 2 * (64 * (wv & 1) + 32 + r32)) = (bf16_t)(pk_bf16(acc1[e], 0.f) & 0xffffu);
            }
        }
        __syncthreads();
#pragma unroll
        for (int r = 0; r < 4; ++r) { const int idx = tid + 512 * r, row = idx >> 4, ch = idx & 15; *(u32x4*)(LT + (size_t)item * 16384 + row * 128 + ch * 8) = *(const LAS u32x4*)(Lst + row * 272 + ch * 16); }
        if (doq) qrow_finish(qv8, qj_dst(qj, qrow), qj_scl(qj, qrow), lane, qrow >= 16384);
        __syncthreads();
    }
    qj_tail(qj, qiter);
    if (dbgc) { if (dbg_kt) atomicAdd(dbgc + 0, dbg_kt); if (dbg_acc) atomicAdd(dbgc + 1, dbg_acc); }
}
__device__ __forceinline__ void phase_scan_b(bf16_t* LT, const float* DEC, const QuantJob qj) {
    const int n = 2 * NHEAD * 128 * 32;
    const int lane = threadIdx.x & 63, gw = blockIdx.x * 8 + (threadIdx.x >> 6), nw = gridDim.x * 8;
    int qdone = 0;
    for (int idx = blockIdx.x * 512 + threadIdx.x; idx < n; idx += gridDim.x * 512) {
        const int bh = idx >> 12, vk = idx & 4095, k4 = (vk & 31) * 4;
        float S0 = 0.f, S1 = 0.f, S2 = 0.f, S3 = 0.f;
        bf16_t* p = LT + (size_t)bh * 128 * 16384 + (size_t)vk * 4;
        const float* dp = DEC + (size_t)bh * 128 * 128 + k4;
        for (int c8 = 0; c8 < 16; ++c8) {
            const int qrow = (qdone + c8) * nw + gw; const bool doq = qrow < 32768; f32x4 qv8[8];
            if (doq) qrow_issue(qv8, qj_src(qj, qrow), lane);
#pragma unroll
            for (int c2 = 0; c2 < 8; ++c2) {
                const int c = c8 * 8 + c2;
                const u32x2 w = *(const u32x2*)(p + (size_t)c * 16384);
                const f32x4 d = *(const f32x4*)(dp + c * 128);
                u32x2 o; o.x = pk_bf16(S0, S1); o.y = pk_bf16(S2, S3);
                *(u32x2*)(p + (size_t)c * 16384) = o;
                S0 = d[0] * S0 + bflo(w.x); S1 = d[1] * S1 + bfhi(w.x); S2 = d[2] * S2 + bflo(w.y); S3 = d[3] * S3 + bfhi(w.y);
            }
            if (doq) qrow_finish(qv8, qj_dst(qj, qrow), qj_scl(qj, qrow), lane, qrow >= 16384);
        }
        qdone += 16;
    }
    qj_tail(qj, qdone);
}
__device__ __forceinline__ void phase_scan_c(LAS unsigned char* lds, const bf16_t* Q1, const bf16_t* FZ, const float* LB, const bf16_t* I1, const bf16_t* G1, const bf16_t* SP, const float* gnorm, bf16_t* OG) {
    const int tid = threadIdx.x, lane = tid & 63, wv = tid >> 6, k = tid & 127, part = tid >> 7, r32 = lane & 31, hh = lane >> 5;
    LAS unsigned char* QTimg = lds; LAS unsigned char* QPimg = lds + 16384; LAS unsigned char* KPimg = lds + 32768; LAS unsigned char* Iimg = lds + 49152; LAS unsigned char* SPimg = lds + 65536;
    LAS float* psum = (LAS float*)(lds + 98304);
    LAS float* ssq = (LAS float*)(lds + 100352);
    LAS unsigned char* OT = lds + 102400;
    bf16_t nfz[16], nq[16]; u32x4 nit_[2], nsp[4], ngt[2];
#define SC_LOAD(item_) { const int bh_ = (item_) >> 7, c_ = (item_) & 127; const size_t t0_ = (size_t)(bh_ >> 4) * SEQ + c_ * 64; const int h_ = bh_ & 15; \
        _Pragma("unroll") for (int i = 0; i < 16; ++i) { const size_t o_ = (t0_ + 16 * part + i) * DM + h_ * 128 + k; nfz[i] = FZ[o_]; nq[i] = Q1[o_]; } \
        _Pragma("unroll") for (int r = 0; r < 2; ++r) { const int idx = tid + 512 * r, row = idx >> 4, ch = idx & 15; nit_[r] = *(const u32x4*)(I1 + (t0_ + row) * DM + h_ * 128 + ch * 8); ngt[r] = *(const u32x4*)(G1 + (t0_ + row) * DM + h_ * 128 + ch * 8); } \
        _Pragma("unroll") for (int r = 0; r < 4; ++r) { const int idx = tid + 512 * r, row = idx >> 4, ch = idx & 15; nsp[r] = *(const u32x4*)(SP + (size_t)(item_) * 16384 + row * 128 + ch * 8); } }
    if ((int)blockIdx.x < 2 * NHEAD * 128) SC_LOAD((int)blockIdx.x)
    for (int item = blockIdx.x; item < 2 * NHEAD * 128; item += gridDim.x) {
        const int bh = item >> 7, c = item & 127, b = bh >> 4, h = bh & 15;
        const size_t tok0 = (size_t)b * SEQ + c * 64;
        float lf[16], qv[16];
        const float lbk = LB[h * 128 + k];
        unsigned fzq[16];
#pragma unroll
        for (int i = 0; i < 16; ++i) fzq[i] = (unsigned)nfz[i] | ((unsigned)nq[i] << 16);
#pragma unroll
        for (int r = 0; r < 2; ++r) { const int idx = tid + 512 * r, row = idx >> 4, ch = idx & 15; *(LAS u32x4*)(Iimg + off_b(row, ch)) = nit_[r]; }
#pragma unroll
        for (int r = 0; r < 4; ++r) { const int idx = tid + 512 * r, row = idx >> 4, ch = idx & 15; *(LAS u32x4*)(SPimg + off_b(row, ch)) = nsp[r]; }
        const u32x4 gcur0 = ngt[0], gcur1 = ngt[1];
        asm volatile("" ::: "memory");
        if (item + (int)gridDim.x < 2 * NHEAD * 128) SC_LOAD(item + (int)gridDim.x)
        asm volatile("" ::: "memory");
#pragma unroll
        for (int i = 0; i < 16; ++i) { lf[i] = logf_gate(bflo(fzq[i]), lbk); const float qr = bfhi(fzq[i]); qv[i] = qr * sigmoidf_(qr); }
        float cs = 0.f;
#pragma unroll
        for (int i = 0; i < 16; ++i) cs += lf[i];
        psum[part * 128 + k] = cs;
        __syncthreads();
        const float p0 = psum[k], p1 = psum[128 + k], p2 = psum[256 + k];
        const float rr = p0 + p1;
        float bb = part == 0 ? 0.f : (part == 1 ? p0 : (part == 2 ? p0 + p1 : p0 + p1 + p2));
#pragma unroll
        for (int i = 0; i < 16; ++i) {
            bb += lf[i];
            const float qt = qv[i] * __expf(bb), qp = qv[i] * __expf(bb - rr), kp = (1.0f - __expf(lf[i])) * __expf(rr - bb);
            const unsigned o = off_b(16 * part + i, k >> 3) + 2 * (k & 7);
            *(LAS bf16_t*)(QTimg + o) = (bf16_t)(pk_bf16(qt, 0.f) & 0xffffu);
            *(LAS bf16_t*)(QPimg + o) = (bf16_t)(pk_bf16(qp, 0.f) & 0xffffu);
            *(LAS bf16_t*)(KPimg + o) = (bf16_t)(pk_bf16(kp, 0.f) & 0xffffu);
        }
        __syncthreads();
        const int tt = wv & 1, vt = wv >> 1;
        f32x16 O;
#pragma unroll
        for (int e = 0; e < 16; ++e) O[e] = 0.f;
#pragma unroll
        for (int ks = 0; ks < 8; ++ks) {
            const bf16x8 af = *(const LAS bf16x8*)(SPimg + off_b(32 * vt + r32, 2 * ks + hh));
            const bf16x8 bf = *(const LAS bf16x8*)(QTimg + off_b(32 * tt + r32, 2 * ks + hh));
            O = __builtin_amdgcn_mfma_f32_32x32x16_bf16(af, bf, O, 0, 0, 0);
        }
        const unsigned krow = pi32((unsigned)r32);
        for (int st = 0; st <= tt; ++st) {
            f32x16 S;
#pragma unroll
            for (int e = 0; e < 16; ++e) S[e] = 0.f;
#pragma unroll
            for (int ks = 0; ks < 8; ++ks) {
                const bf16x8 af = *(const LAS bf16x8*)(KPimg + off_b(32 * st + krow, 2 * ks + hh));
                const bf16x8 bf = *(const LAS bf16x8*)(QPimg + off_b(32 * tt + r32, 2 * ks + hh));
                S = __builtin_amdgcn_mfma_f32_32x32x16_bf16(af, bf, S, 0, 0, 0);
            }
            float p[16];
#pragma unroll
            for (int e = 0; e < 16; ++e) {
                const unsigned m = (e & 3) + 8 * (e >> 2) + 4 * hh;
                const int sidx = 32 * st + (int)pi32(m), tidx = 32 * tt + r32;
                p[e] = sidx <= tidx ? S[e] : 0.f;
            }
            u32x4 w0, w1;
            w0.x = pk_bf16(p[0], p[1]); w0.y = pk_bf16(p[2], p[3]); w0.z = pk_bf16(p[4], p[5]); w0.w = pk_bf16(p[6], p[7]);
            w1.x = pk_bf16(p[8], p[9]); w1.y = pk_bf16(p[10], p[11]); w1.z = pk_bf16(p[12], p[13]); w1.w = pk_bf16(p[14], p[15]);
            const bf16x8 pf0 = __builtin_bit_cast(bf16x8, w0), pf1 = __builtin_bit_cast(bf16x8, w1);
            const bf16x8 i0 = tr_frag(Iimg, lane, vt, 2 * st), i1 = tr_frag(Iimg, lane, vt, 2 * st + 1);
            O = __builtin_amdgcn_mfma_f32_32x32x16_bf16(i0, pf0, O, 0, 0, 0);
            O = __builtin_amdgcn_mfma_f32_32x32x16_bf16(i1, pf1, O, 0, 0, 0);
        }
        float sq = 0.f;
#pragma unroll
        for (int e = 0; e < 16; ++e) sq += O[e] * O[e];
        sq += __shfl_xor(sq, 32);
        if (hh == 0) ssq[vt * 64 + 32 * tt + r32] = sq;
        __syncthreads();
        const int tl = 32 * tt + r32;
        const float rstd = rsqrtf((ssq[tl] + ssq[64 + tl] + ssq[128 + tl] + ssq[192 + tl]) * (1.0f / 128.0f) + 1e-6f);
#pragma unroll
        for (int g = 0; g < 4; ++g) {
            const int v0 = 32 * vt + 8 * g + 4 * hh;
            const f32x4 gn = *(const f32x4*)(gnorm + v0);
            u32x2 w; w.x = pk_bf16(O[4 * g] * rstd * gn[0], O[4 * g + 1] * rstd * gn[1]); w.y = pk_bf16(O[4 * g + 2] * rstd * gn[2], O[4 * g + 3] * rstd * gn[3]);
            *(LAS u32x2*)(OT + tl * 272 + v0 * 2) = w;
        }
        __syncthreads();
#pragma unroll
        for (int r = 0; r < 2; ++r) {
            const int idx = tid + 512 * r, row = idx >> 4, ch = idx & 15;
            const u32x4 ov = *(const LAS u32x4*)(OT + row * 272 + ch * 16);
            const size_t go = (tok0 + row) * DM + h * 128 + ch * 8;
            const u32x4 gv = r == 0 ? gcur0 : gcur1;
            u32x4 w;
#define SILU_(x_) ((x_) * sigmoidf_(x_))
            w.x = pk_bf16(bflo(ov.x) * SILU_(bflo(gv.x)), bfhi(ov.x) * SILU_(bfhi(gv.x))); w.y = pk_bf16(bflo(ov.y) * SILU_(bflo(gv.y)), bfhi(ov.y) * SILU_(bfhi(gv.y)));
            w.z = pk_bf16(bflo(ov.z) * SILU_(bflo(gv.z)), bfhi(ov.z) * SILU_(bfhi(gv.z))); w.w = pk_bf16(bflo(ov.w) * SILU_(bflo(gv.w)), bfhi(ov.w) * SILU_(bfhi(gv.w)));
#undef SILU_
            *(u32x4*)(OG + go) = w;
        }
        __syncthreads();
    }
}


#if SCAN_DBG == 2
__device__ __forceinline__ void dbg_compare(LAS float* red, const bf16_t* A, const bf16_t* B, float* DBG) {
    float sd = 0.f, sr = 0.f, nn = 0.f;
    const size_t n = (size_t)MTOK * DM;
    for (size_t i = (size_t)blockIdx.x * 512 + threadIdx.x; i < n; i += (size_t)gridDim.x * 512) {
        const float x = bf2f(A[i]), y = bf2f(B[i]);
        if (!(x - x == 0.f)) nn += 1.f; else { sd += (x - y) * (x - y); sr += y * y; }
    }
    sd = wave_sum(sd); sr = wave_sum(sr); nn = wave_sum(nn);
    const int wv = threadIdx.x >> 6;
    if ((threadIdx.x & 63) == 0) { red[wv * 3] = sd; red[wv * 3 + 1] = sr; red[wv * 3 + 2] = nn; }
    __syncthreads();
    if (threadIdx.x == 0) { float a = 0, b = 0, c = 0; for (int w = 0; w < 8; ++w) { a += red[w * 3]; b += red[w * 3 + 1]; c += red[w * 3 + 2]; } DBG[blockIdx.x * 4] = a; DBG[blockIdx.x * 4 + 1] = b; DBG[blockIdx.x * 4 + 2] = c; }
    __syncthreads();
}
__device__ __forceinline__ void dbg_emit(const float* DBG, float* out) {
    float a = 0, b = 0, c = 0;
    for (int w = 0; w < (int)gridDim.x; ++w) { a += DBG[w * 4]; b += DBG[w * 4 + 1]; c += DBG[w * 4 + 2]; }
    const float rel = sqrtf(a / b);
    int k = (int)rintf(-2.0f * log10f(rel)); k = k < 0 ? 0 : (k > 16 ? 16 : k);
    if (c > 0.f) k = 17;
    const float cc = sqrtf(0.5f * (float)k);
    const size_t n = (size_t)MTOK * DM;
    for (size_t i = (size_t)blockIdx.x * 512 + threadIdx.x; i < n; i += (size_t)gridDim.x * 512) out[i] = cc;
}
#endif

#if SCAN_DBG == 3
__device__ __forceinline__ void dbg_count_bf16(const bf16_t* A, size_t n, unsigned* cnt) {
    unsigned c = 0;
    for (size_t i = (size_t)blockIdx.x * 512 + threadIdx.x; i < n; i += (size_t)gridDim.x * 512) { const float x = bf2f(A[i]); if (!(x - x == 0.f)) ++c; }
    if (c) atomicAdd(cnt, c);
}
__device__ __forceinline__ void dbg_count_f32(const float* A, size_t n, unsigned* cnt) {
    unsigned c = 0;
    for (size_t i = (size_t)blockIdx.x * 512 + threadIdx.x; i < n; i += (size_t)gridDim.x * 512) { const float x = A[i]; if (!(x - x == 0.f)) ++c; }
    if (c) atomicAdd(cnt, c);
}
__device__ __forceinline__ void dbg_emit3(const unsigned* cnt, float* out) {
    float code = 0.f;
    for (int st = 3; st >= 0; --st) { const unsigned c = cnt[st]; if (c) { float lg = log10f((float)c); lg = lg > 9.f ? 9.f : lg; code = (float)(st + 1) + 0.1f * lg; } }
    const float cc = sqrtf(code);
    const size_t n = (size_t)MTOK * DM;
    for (size_t i = (size_t)blockIdx.x * 512 + threadIdx.x; i < n; i += (size_t)gridDim.x * 512) out[i] = cc;
}
#endif

#if SCAN_DBG == 4 || SCAN_DBG == 6
__device__ __forceinline__ void dbg_compare4(LAS float* red, const bf16_t* A, const bf16_t* B, const bf16_t* C, float* DBG) {
    float sd = 0.f, sr = 0.f, nn = 0.f, mm = 0.f;
    const size_t n = (size_t)MTOK * DM;
    for (size_t i = (size_t)blockIdx.x * 512 + threadIdx.x; i < n; i += (size_t)gridDim.x * 512) {
        const float x = bf2f(A[i]), y = bf2f(B[i]);
        if (!(x - x == 0.f)) nn += 1.f; else { sd += (x - y) * (x - y); sr += y * y; }
        if (A[i] != C[i]) mm += 1.f;
    }
    sd = wave_sum(sd); sr = wave_sum(sr); nn = wave_sum(nn); mm = wave_sum(mm);
    const int wv = threadIdx.x >> 6;
    if ((threadIdx.x & 63) == 0) { red[wv * 4] = sd; red[wv * 4 + 1] = sr; red[wv * 4 + 2] = nn; red[wv * 4 + 3] = mm; }
    __syncthreads();
    if (threadIdx.x == 0) { float a = 0, b = 0, c = 0, d = 0; for (int w = 0; w < 8; ++w) { a += red[w * 4]; b += red[w * 4 + 1]; c += red[w * 4 + 2]; d += red[w * 4 + 3]; }
        DBG[blockIdx.x * 4] = a; DBG[blockIdx.x * 4 + 1] = b; DBG[blockIdx.x * 4 + 2] = c; DBG[blockIdx.x * 4 + 3] = d; }
    __syncthreads();
}
__device__ __forceinline__ void dbg_emit4(const float* DBG, float* out) {
    float a = 0, b = 0, c = 0, d = 0;
    for (int w = 0; w < (int)gridDim.x; ++w) { a += DBG[w * 4]; b += DBG[w * 4 + 1]; c += DBG[w * 4 + 2]; d += DBG[w * 4 + 3]; }
    const float rel = sqrtf(a / b);
    int k = (int)rintf(-log10f(rel)); k = k < 0 ? 0 : (k > 8 ? 8 : k);
#if SCAN_DBG == 6
    const float cc = sqrtf((float)k + ((d + c) > 0.f ? 0.5f : 0.f));
#else
    int m = (int)ceilf(log10f(1.0f + d + c)); m = m > 9 ? 9 : m;
    const float cc = sqrtf((float)k + 0.1f * (float)m);
#endif
    const size_t n = (size_t)MTOK * DM;
    for (size_t i = (size_t)blockIdx.x * 512 + threadIdx.x; i < n; i += (size_t)gridDim.x * 512) out[i] = cc;
}
#endif

#if SCAN_DBG == 5
__device__ __forceinline__ void dbg_lds16_test(LAS unsigned char* lds, unsigned* cnt) {
    const int tid = threadIdx.x;
    unsigned bad = 0;
    for (int rep = 0; rep < 64; ++rep) {
        for (int i = tid; i < 1024; i += 512) *(LAS u32x4*)(lds + i * 16) = (u32x4){0x7fc07fc0u, 0x7fc07fc0u, 0x7fc07fc0u, 0x7fc07fc0u};
        __syncthreads();
        const int k = tid & 127, part = tid >> 7;
#pragma unroll
        for (int i = 0; i < 16; ++i) {
            const int row = 16 * part + i;
            *(LAS bf16_t*)(lds + off_b(row, k >> 3) + 2 * (k & 7)) = (bf16_t)((row * 128 + k + rep) & 0x7fff);
        }
        __syncthreads();
        for (int idx = tid; idx < 64 * 128; idx += 512) {
            const int row = idx >> 7, kk = idx & 127;
            const bf16_t got = *(const LAS bf16_t*)(lds + off_b(row, kk >> 3) + 2 * (kk & 7));
            if (got != (bf16_t)((row * 128 + kk + rep) & 0x7fff)) ++bad;
        }
        __syncthreads();
    }
    if (bad) atomicAdd(cnt, bad);
}
__device__ __forceinline__ void dbg_emit5(const unsigned* cnt, float* out) {
    const unsigned c = cnt[0];
    float code = 0.f;
    if (c) { float lg = log10f((float)c); code = 1.0f + (lg > 8.9f ? 8.9f : lg); }
    const float cc = sqrtf(code);
    const size_t n = (size_t)MTOK * DM;
    for (size_t i = (size_t)blockIdx.x * 512 + threadIdx.x; i < n; i += (size_t)gridDim.x * 512) out[i] = cc;
}
#endif

#if SCAN_DBG == 6
__device__ __forceinline__ void dbg_check_a(LAS float* red, const float* LF, const bf16_t* I1, const bf16_t* LT, const bf16_t* LT2, float* DBG) {
    float sd = 0.f, sr = 0.f, mm = 0.f;
    const size_t n = (size_t)4096 * 16384;
    for (size_t i = (size_t)blockIdx.x * 512 + threadIdx.x; i < n; i += (size_t)gridDim.x * 512) {
        const int item = (int)(i >> 14), v = (int)((i >> 7) & 127), k = (int)(i & 127);
        const int bh = item >> 7, c = item & 127, b = bh >> 4, h = bh & 15;
        const size_t tok0 = (size_t)b * SEQ + c * 64;
        float g = 1.f, L = 0.f;
        for (int s2 = 63; s2 >= 0; --s2) {
            const size_t o = (tok0 + s2) * DM + h * 128;
            const float f = __expf(LF[o + k]);
            L += bf2f(I1[o + v]) * (1.0f - f) * g;
            g *= f;
        }
        const float x = bf2f(LT[i]);
        sd += (x - L) * (x - L); sr += L * L;
        if (LT[i] != LT2[i]) mm += 1.f;
    }
    sd = wave_sum(sd); sr = wave_sum(sr); mm = wave_sum(mm);
    const int wv = threadIdx.x >> 6;
    if ((threadIdx.x & 63) == 0) { red[wv * 4] = sd; red[wv * 4 + 1] = sr; red[wv * 4 + 2] = 0.f; red[wv * 4 + 3] = mm; }
    __syncthreads();
    if (threadIdx.x == 0) { float a = 0, b2 = 0, d = 0; for (int w = 0; w < 8; ++w) { a += red[w * 4]; b2 += red[w * 4 + 1]; d += red[w * 4 + 3]; }
        DBG[blockIdx.x * 4] = a; DBG[blockIdx.x * 4 + 1] = b2; DBG[blockIdx.x * 4 + 2] = 0.f; DBG[blockIdx.x * 4 + 3] = d; }
    __syncthreads();
}
#endif

#if SCAN_DBG == 7
#ifndef DBG_FAM
#define DBG_FAM 0
#endif
__device__ __forceinline__ void dbg_check_a7(const float* LF, const bf16_t* I1, const bf16_t* LT, float* DBG) {
    const size_t n = (size_t)4096 * 16384;
    float nbad = 0.f, nnf = 0.f;
    for (size_t i = (size_t)blockIdx.x * 512 + threadIdx.x; i < n; i += (size_t)gridDim.x * 512 * 8) {
        const int item = (int)(i >> 14), v = (int)((i >> 7) & 127), k = (int)(i & 127);
        const int bh = item >> 7, c = item & 127, b = bh >> 4, h = bh & 15;
        const size_t tok0 = (size_t)b * SEQ + c * 64;
        float g = 1.f, L = 0.f;
        for (int s2 = 63; s2 >= 0; --s2) {
            const size_t o = (tok0 + s2) * DM + h * 128;
            const float f = __expf(LF[o + k]);
            L += bf2f(I1[o + v]) * (1.0f - f) * g;
            g *= f;
        }
        const float x = bf2f(LT[i]);
        if (!(x - x == 0.f)) { nnf += 1.f; nbad += 1.f; }
        else if (fabsf(x - L) > 0.02f * fabsf(L) + 1e-2f) nbad += 1.f;
    }
    nbad = wave_sum(nbad); nnf = wave_sum(nnf);
    if ((threadIdx.x & 63) == 0) { atomicAdd(DBG, nbad); atomicAdd(DBG + 1, nnf); }
}
__device__ __forceinline__ void dbg_emit7(const float* DBG, float* out) {
    const float nb = DBG[0], nf = DBG[1];
    int A = nb == 0.f ? 0 : (nb <= 100.f ? 1 : (nb <= 1e4f ? 3 : (nb <= 1e6f ? 5 : 7)));
    int B = nf == 0.f ? 0 : 5;
    const float cc = sqrtf((float)A + 0.1f * (float)B);
    const size_t n = (size_t)MTOK * DM;
    for (size_t i = (size_t)blockIdx.x * 512 + threadIdx.x; i < n; i += (size_t)gridDim.x * 512) out[i] = cc;
}
#endif
__device__ __forceinline__ int opaque(int v) { asm volatile("" : "+s"(v)); return v; }
template <bool L1> __device__ __forceinline__ void run_gemm_out(const Args& a, LAS unsigned char* lds) {
    unsigned char* ws = a.ws;
    pg8::Gemm g{(const bf16_t*)(ws + (L1 ? slot(3) : slot(8))), (const bf16_t*)(ws + (L1 ? WS_WO : WS_WOUT)), opaque(MTOK), opaque(DM), opaque(DM / 2)};
    pg8::StaticOrder S; S.init(g.M, g.N, (int)gridDim.x, (int)blockIdx.x);
    EpiKVQ_<true> E{(bf16_t*)(ws + (L1 ? slot(4) : slot(1))), (const float*)(ws + WS_XSO), (const float*)(ws + (L1 ? WS_SWO : WS_SWOUT))};
    pg8::gemm_phase<EpiKVQ_<true>, pg8::StaticOrder>(lds, g, S, E, nullptr);
}
template <bool L1> __device__ __forceinline__ void run_ln(const Args& a) {
    unsigned char* ws = a.ws;
    phase_ln<L1>((const bf16_t*)(ws + (L1 ? slot(4) : slot(1))), L1 ? (const void*)(ws + slot(2)) : (const void*)a.in[0], a.in[12] + (L1 ? 2 : 0) * DM, a.in[13] + (L1 ? 2 : 0) * DM,
                 (float*)nullptr, (bf16_t*)(ws + (L1 ? slot(8) : slot(5))), (signed char*)(ws + WS_XQ), (float*)(ws + WS_XS));
}
template <bool L1> __device__ __forceinline__ void run_gemm_sc(const Args& a, LAS unsigned char* lds) {
    unsigned char* ws = a.ws;
#if SC8
    pg8::Gemm g{(const bf16_t*)(ws + WS_WC8 + (L1 ? (size_t)DM * DM : 0)), (const bf16_t*)(ws + WS_XQ), opaque(DM), opaque(MTOK), opaque(DM / 2)};
    pg8::StaticOrder S; S.init(g.M, g.N, (int)gridDim.x, (int)blockIdx.x);
    EpiF32_<true> E{(float*)(ws + (L1 ? slot(0) : slot(6))), MTOK, (const float*)(ws + WS_SWC) + (L1 ? DM : 0), (const float*)(ws + WS_XS)};
    pg8::gemm_phase<EpiF32_<true>, pg8::StaticOrder>(lds, g, S, E, nullptr);
#else
    pg8::Gemm g{(const bf16_t*)(ws + WS_WC) + (L1 ? (size_t)DM * DM : 0), (const bf16_t*)(ws + (L1 ? slot(8) : slot(5))), opaque(DM), opaque(MTOK), opaque(DM)};
    pg8::StaticOrder S; S.init(g.M, g.N, (int)gridDim.x, (int)blockIdx.x);
    EpiF32 E{(float*)(ws + (L1 ? slot(0) : slot(6))), MTOK, nullptr, nullptr};
    pg8::gemm_phase<EpiF32, pg8::StaticOrder>(lds, g, S, E, nullptr);
#endif
}
template <bool L1> __device__ __forceinline__ void run_topk(const Args& a, LAS unsigned char* lds) {
    unsigned char* ws = a.ws;
    phase_topk(lds, (const float*)(ws + (L1 ? slot(0) : slot(6))), (int*)(ws + WS_EID), (float*)(ws + WS_GATE));
}
template <bool L1> __device__ __forceinline__ void run_peer(const Args& a, LAS unsigned char* lds) {
    unsigned char* ws = a.ws;
    LAS int* HL = (LAS int*)(lds + (threadIdx.x >> 6) * 8192);
    float* Y = (float*)(ws + (L1 ? slot(0) : slot(6)));
    phase_peer_u((const signed char*)(ws + WS_XQ), (const int*)(ws + WS_EID), ws + WS_UB + (L1 ? (size_t)16384 * DM : 0), HL);
    asm volatile("s_waitcnt vmcnt(0) lgkmcnt(0)" ::: "memory");
    phase_peer_w(HL, (const float*)(ws + WS_XS), (const int*)(ws + WS_EID), (const float*)(ws + WS_GATE),
                 (const float*)(ws + WS_USC) + (L1 ? 16384 : 0), (const float*)(ws + WS_VSC) + (L1 ? 16384 : 0), (signed char*)(ws + WS_W), (float*)(ws + WS_CS));
    asm volatile("s_waitcnt vmcnt(0)" ::: "memory");
    phase_peer_v((const bf16_t*)(ws + (L1 ? slot(8) : slot(5))), (const int*)(ws + WS_EID), (const signed char*)(ws + WS_W), (const float*)(ws + WS_CS),
                 ws + WS_VB + (L1 ? (size_t)16384 * DM : 0), Y);
    asm volatile("s_waitcnt vmcnt(0)" ::: "memory");
    {
        const int lane = threadIdx.x & 63, gw = blockIdx.x * 8 + (threadIdx.x >> 6), nw = gridDim.x * 8, tpw = (MTOK + nw - 1) / nw, tbase = gw * tpw;
        const int tend = tbase + tpw < MTOK ? tbase + tpw : MTOK;
        const float* g = a.in[12] + (L1 ? 3 : 1) * DM; const float* bta = a.in[13] + (L1 ? 3 : 1) * DM;
        float* outf = L1 ? a.out : (float*)nullptr; bf16_t* outb = L1 ? (bf16_t*)nullptr : (bf16_t*)(ws + slot(2));
        for (int row = tbase; row < tend; ++row) {
            float v[32];
            const float* p = Y + (size_t)row * DM;
#pragma unroll
            for (int i = 0; i < 4; ++i) {
                const f32x4 x0 = *(const f32x4*)(p + 512 * i + 8 * lane), x1 = *(const f32x4*)(p + 512 * i + 8 * lane + 4);
#pragma unroll
                for (int j = 0; j < 4; ++j) { v[i * 8 + j] = x0[j]; v[i * 8 + 4 + j] = x1[j]; }
            }
            ln_row_store(v, g, bta, outf ? outf + (size_t)row * DM : nullptr, outb ? outb + (size_t)row * DM : nullptr, lane,
                         L1 ? (signed char*)nullptr : (signed char*)(ws + slot(1)) + (size_t)row * DM, L1 ? (float*)nullptr : (float*)(ws + WS_XS1) + row);
        }
    }
}


#define XB_TMO      128
#define XB_XCNT(j)  (256  + 64 * (j))
#define XB_XSUB(j)  (1280 + 64 * (j))
#define XB_XGEN(j)  (2304 + 64 * (j))
#define XB_TOP      3328
#define XB_TOPGEN   3392
#define XCD_BAR_WORDS 3456
#define XB_SPIN_CAP (1u << 20)
__device__ __forceinline__ unsigned xb_ld(unsigned* p)              { return __hip_atomic_load(p, __ATOMIC_RELAXED, __HIP_MEMORY_SCOPE_AGENT); }
__device__ __forceinline__ unsigned xb_add(unsigned* p, unsigned v) { return __hip_atomic_fetch_add(p, v, __ATOMIC_RELAXED, __HIP_MEMORY_SCOPE_AGENT); }
__device__ __forceinline__ unsigned xb_xcc_id() { return (unsigned)__builtin_amdgcn_s_getreg((3 << 11) | 20) & 0xFu; }
#define XB_SPIN(cond, bar) do { unsigned _sp = 0; while (cond) { __builtin_amdgcn_s_sleep(1); \
    if ((++_sp & 255u) == 0u) { if (xb_ld(&(bar)[XB_TMO])) break; if (_sp > XB_SPIN_CAP) { atomicAdd(&(bar)[XB_TMO], 1u); break; } } } } while (0)
struct XcdBarrier { unsigned* bar; unsigned x; volatile LAS unsigned* st; };
__device__ __forceinline__ XcdBarrier xcd_barrier_post(unsigned* bar, volatile LAS unsigned* st) {
    XcdBarrier b; b.bar = bar; b.x = xb_xcc_id(); b.st = st;
    if (threadIdx.x == 0) (void)xb_add(&bar[XB_XCNT(b.x)], 1u);
    return b;
}
__device__ __forceinline__ void xcd_barrier_complete(unsigned* bar, unsigned x, unsigned& nloc, unsigned& nx) {
    const unsigned G = gridDim.x * gridDim.y * gridDim.z;
    unsigned sum, cnt, mine, sp = 0u;
    for (;;) {
        sum = 0u; cnt = 0u; mine = 0u;
#pragma unroll
        for (unsigned j = 0; j < 16; ++j) { const unsigned c = xb_ld(&bar[XB_XCNT(j)]); sum += c; cnt += (c > 0u) ? 1u : 0u; mine = (j == x) ? c : mine; }
        if (sum == G) break;
        __builtin_amdgcn_s_sleep(1);
        if ((++sp & 255u) == 0u) { if (xb_ld(&bar[XB_TMO])) break; if (sp > XB_SPIN_CAP) { atomicAdd(&bar[XB_TMO], 1u); break; } }
    }
    nloc = mine > 0u ? mine : 1u; nx = cnt > 0u ? cnt : 1u;
}
__device__ __forceinline__ void xcd_barrier(const XcdBarrier& b) {
    asm volatile("s_waitcnt vmcnt(0)" ::: "memory");
    __syncthreads();
    if (threadIdx.x == 0) {
        unsigned* bar = b.bar;
        __builtin_amdgcn_s_waitcnt(0);
        unsigned nloc = b.st[0], nx = b.st[1];
        if (nloc == 0u) { xcd_barrier_complete(bar, b.x, nloc, nx); b.st[0] = nloc; b.st[1] = nx; }
        const unsigned old = xb_add(&bar[XB_XSUB(b.x)], 1u);
        const unsigned gen = old / nloc;
        if (old + 1u == (gen + 1u) * nloc) {
            __builtin_amdgcn_fence(__ATOMIC_RELEASE, "agent");
            asm volatile("s_waitcnt vmcnt(0)" ::: "memory");
            const unsigned og = xb_add(&bar[XB_TOP], 1u);
            const unsigned tg = og / nx;
            if (og + 1u == (tg + 1u) * nx) xb_add(&bar[XB_TOPGEN], 1u);
            else XB_SPIN(xb_ld(&bar[XB_TOPGEN]) == tg, bar);
            __builtin_amdgcn_fence(__ATOMIC_ACQUIRE, "agent");
            xb_add(&bar[XB_XGEN(b.x)], 1u);
            asm volatile("s_waitcnt vmcnt(0)" ::: "memory");
        } else {
            XB_SPIN(xb_ld(&bar[XB_XGEN(b.x)]) == gen, bar);
            __builtin_amdgcn_fence(__ATOMIC_ACQUIRE, "agent");
            asm volatile("s_waitcnt vmcnt(0)" ::: "memory");
        }
    }
    __syncthreads();
}

__global__ void __launch_bounds__(512, 2) mk_fwd(Args a) {
    extern __shared__ __attribute__((aligned(16))) unsigned char lds_raw[];
    LAS unsigned char* lds = (LAS unsigned char*)lds_raw;
    cg::grid_group grid = cg::this_grid();
    unsigned char* ws = a.ws;
#define PHASE_BEGIN(k) if (a.ph_lo <= (k) && (k) < a.ph_hi && EN(k)) {
    volatile LAS unsigned* xb_st = (volatile LAS unsigned*)(lds + LDS_BYTES - 16);
    if (threadIdx.x < 4) xb_st[threadIdx.x] = 0u;
    unsigned* xb_words = (unsigned*)(ws + WS_BAR);
    __syncthreads();
    XcdBarrier xbar = xcd_barrier_post(xb_words, xb_st);
    if (a.ph_lo < 0) grid.sync();
#define PHASE_END(k) if ((k) + 1 < a.ph_hi) xcd_barrier(xbar); }
    PHASE_BEGIN(0) phase_prep(a, lds);
#if SCAN_DBG == 3 || SCAN_DBG == 5
        if (blockIdx.x == 0 && threadIdx.x < 8) ((unsigned*)(ws + WS_CTR + 8192))[threadIdx.x] = 0u;
#endif
#if SCAN_DBG == 7
        if (blockIdx.x == 0 && threadIdx.x < 32) ((float*)(ws + WS_CTR + 4096))[threadIdx.x] = 0.f;
#endif
    PHASE_END(0)
#if SCAN_DBG == 5
    PHASE_BEGIN(1) dbg_lds16_test(lds, (unsigned*)(ws + WS_CTR + 8192)); PHASE_END(1)
#define SKIP_REST 1
#endif
    PHASE_BEGIN(1) {
        pg8::Gemm g{(const bf16_t*)(ws + slot(0)), (const bf16_t*)(ws + WS_WIN), opaque(MTOK), opaque(4 * DM), opaque(DM / 2)};
        pg8::StaticOrder S; S.init(g.M, g.N, (int)gridDim.x, (int)blockIdx.x);
        EpiKVQ_<true> E{(bf16_t*)(ws + slot(1)), (const float*)(ws + WS_XS0), (const float*)(ws + WS_SWIN)};
        pg8::gemm_phase<EpiKVQ_<true>, pg8::StaticOrder>(lds, g, S, E, nullptr);
    } PHASE_END(1)
    PHASE_BEGIN(2) quant_rows_bf16((const bf16_t*)(ws + WS_WC), (signed char*)(ws + WS_WC8), (float*)(ws + WS_SWC), 2 * DM);
        phase_scan_a(lds, (const bf16_t*)(ws + slot(2)), (const float*)(ws + WS_LB), (const bf16_t*)(ws + slot(3)), (bf16_t*)(ws + slot(6)), (float*)(ws + WS_DEC), QuantJob{a.in[10], a.in[11], ws + WS_UB, ws + WS_VB, (float*)(ws + WS_USC), (float*)(ws + WS_VSC)}
#if SCAN_DBG == 3
        , (unsigned*)(ws + WS_CTR + 8192)
#endif
        );
#if SCAN_DBG == 7
        asm volatile("s_waitcnt vmcnt(0)" ::: "memory"); __syncthreads(); grid.sync(); if (threadIdx.x < 64) { __builtin_amdgcn_fence(__ATOMIC_ACQUIRE, "agent"); asm volatile("s_waitcnt vmcnt(0)" ::: "memory"); } __syncthreads();
        dbg_check_a7((const float*)(ws + slot(4)), (const bf16_t*)(ws + slot(2)), (const bf16_t*)(ws + slot(6)), (float*)(ws + WS_CTR + 4096));
#endif
#if SCAN_DBG == 6
#define DSYNC6() asm volatile("s_waitcnt vmcnt(0)" ::: "memory"); __syncthreads(); grid.sync(); if (threadIdx.x < 64) { __builtin_amdgcn_fence(__ATOMIC_ACQUIRE, "agent"); asm volatile("s_waitcnt vmcnt(0)" ::: "memory"); } __syncthreads();
        DSYNC6()
        phase_scan_a(lds, (const bf16_t*)(ws + slot(2)), (const float*)(ws + WS_LB), (const bf16_t*)(ws + slot(3)), (bf16_t*)a.out, (float*)(ws + WS_DEC), QuantJob{a.in[10], a.in[11], ws + WS_UB, ws + WS_VB, (float*)(ws + WS_USC), (float*)(ws + WS_VSC)});
        DSYNC6()
        dbg_check_a((LAS float*)lds, (const float*)(ws + slot(4)), (const bf16_t*)(ws + slot(2)), (const bf16_t*)(ws + slot(6)), (const bf16_t*)a.out, (float*)(ws + WS_CTR + 4096));
#endif
#if SCAN_DBG == 3
        asm volatile("s_waitcnt vmcnt(0)" ::: "memory"); __syncthreads(); grid.sync();
        dbg_count_bf16((const bf16_t*)(ws + slot(6)), (size_t)4096 * 16384, (unsigned*)(ws + WS_CTR + 8192) + 2);
#endif
    PHASE_END(2)
    PHASE_BEGIN(3) phase_scan_b((bf16_t*)(ws + slot(6)), (const float*)(ws + WS_DEC), QuantJob{a.in[10] + (size_t)16384 * DM, a.in[11] + (size_t)16384 * DM, ws + WS_UB + (size_t)16384 * DM, ws + WS_VB + (size_t)16384 * DM, (float*)(ws + WS_USC) + 16384, (float*)(ws + WS_VSC) + 16384});
#if SCAN_DBG == 3
        asm volatile("s_waitcnt vmcnt(0)" ::: "memory"); __syncthreads(); grid.sync();

#endif
    PHASE_END(3)
    PHASE_BEGIN(4) phase_scan_c(lds, (const bf16_t*)(ws + slot(1)), (const bf16_t*)(ws + slot(2)), (const float*)(ws + WS_LB), (const bf16_t*)(ws + slot(3)), (const bf16_t*)(ws + slot(4)), (const bf16_t*)(ws + slot(6)), a.in[2], (bf16_t*)(ws + slot(0)));
#if SCAN_DBG == 1
        asm volatile("s_waitcnt vmcnt(0)" ::: "memory"); __syncthreads(); grid.sync();
        phase_scan_naive((const bf16_t*)(ws + slot(1)), (const float*)(ws + slot(4)), (const bf16_t*)(ws + slot(2)), (float*)(ws + slot(6)));
        asm volatile("s_waitcnt vmcnt(0)" ::: "memory"); __syncthreads(); grid.sync();
        phase_onorm((const float*)(ws + slot(6)), (const bf16_t*)(ws + slot(3)), a.in[2], (bf16_t*)(ws + slot(0)));
#endif
#if SCAN_DBG == 3
        asm volatile("s_waitcnt vmcnt(0)" ::: "memory"); __syncthreads(); grid.sync();

#endif
#if SCAN_DBG == 4
#define DSYNC() asm volatile("s_waitcnt vmcnt(0)" ::: "memory"); __syncthreads(); grid.sync(); if (threadIdx.x < 64) { __builtin_amdgcn_fence(__ATOMIC_ACQUIRE, "agent"); asm volatile("s_waitcnt vmcnt(0)" ::: "memory"); } __syncthreads();
        DSYNC()
        phase_scan_naive((const bf16_t*)(ws + slot(1)), (const float*)(ws + slot(4)), (const bf16_t*)(ws + slot(2)), (float*)(ws + slot(6)));
        DSYNC()
        phase_onorm((const float*)(ws + slot(6)), (const bf16_t*)(ws + slot(3)), a.in[2], (bf16_t*)(ws + slot(8)));
        DSYNC()
        phase_scan_a(lds, (const bf16_t*)(ws + slot(2)), (const float*)(ws + WS_LB), (const bf16_t*)(ws + slot(3)), (bf16_t*)(ws + slot(6)), (float*)(ws + WS_DEC), QuantJob{a.in[10], a.in[11], ws + WS_UB, ws + WS_VB, (float*)(ws + WS_USC), (float*)(ws + WS_VSC)});
        DSYNC()
        phase_scan_b((bf16_t*)(ws + slot(6)), (const float*)(ws + WS_DEC), QuantJob{a.in[10] + (size_t)16384 * DM, a.in[11] + (size_t)16384 * DM, ws + WS_UB + (size_t)16384 * DM, ws + WS_VB + (size_t)16384 * DM, (float*)(ws + WS_USC) + 16384, (float*)(ws + WS_VSC) + 16384});
        DSYNC()
        phase_scan_c(lds, (const bf16_t*)(ws + slot(1)), (const bf16_t*)(ws + slot(2)), (const float*)(ws + WS_LB), (const bf16_t*)(ws + slot(3)), (const bf16_t*)(ws + slot(4)), (const bf16_t*)(ws + slot(6)), a.in[2], (bf16_t*)a.out);
        DSYNC()
        dbg_compare4((LAS float*)lds, (const bf16_t*)(ws + slot(0)), (const bf16_t*)(ws + slot(8)), (const bf16_t*)a.out, (float*)(ws + WS_CTR + 4096));
#endif
#if SCAN_DBG == 2
        asm volatile("s_waitcnt vmcnt(0)" ::: "memory"); __syncthreads(); grid.sync();
        phase_scan_naive((const bf16_t*)(ws + slot(1)), (const float*)(ws + slot(4)), (const bf16_t*)(ws + slot(2)), (float*)(ws + slot(6)));
        asm volatile("s_waitcnt vmcnt(0)" ::: "memory"); __syncthreads(); grid.sync();
        phase_onorm((const float*)(ws + slot(6)), (const bf16_t*)(ws + slot(3)), a.in[2], (bf16_t*)(ws + slot(8)));
        asm volatile("s_waitcnt vmcnt(0)" ::: "memory"); __syncthreads(); grid.sync();
        dbg_compare((LAS float*)lds, (const bf16_t*)(ws + slot(0)), (const bf16_t*)(ws + slot(8)), (float*)(ws + WS_CTR + 4096));
#endif
    PHASE_END(4)
    PHASE_BEGIN(5)
        quant_rows_bf16((const bf16_t*)(ws + slot(0)), (signed char*)(ws + slot(8)), (float*)(ws + WS_XSO), MTOK);
        xcd_barrier(xbar);
        run_gemm_out<false>(a, lds); PHASE_END(5)
    PHASE_BEGIN(6) run_ln<false>(a); PHASE_END(6)
    PHASE_BEGIN(7) run_gemm_sc<false>(a, lds); PHASE_END(7)
    PHASE_BEGIN(8) run_topk<false>(a, lds); PHASE_END(8)
    PHASE_BEGIN(9) run_peer<false>(a, lds); PHASE_END(9)
    PHASE_BEGIN(10) {
        pg8::Gemm g{(const bf16_t*)(ws + slot(1)), (const bf16_t*)(ws + WS_WKVQ), opaque(MTOK), opaque(3 * DM), opaque(DM / 2)};
        pg8::StaticOrder S; S.init(g.M, g.N, (int)gridDim.x, (int)blockIdx.x);
        EpiKVQR_<true> E{(bf16_t*)(ws + slot(3)), (const float*)(ws + WS_COS), (const float*)(ws + WS_SIN), (const float*)(ws + WS_XS1), (const float*)(ws + WS_SWKVQ)};
        pg8::gemm_phase<EpiKVQR_<true>, pg8::StaticOrder>(lds, g, S, E, nullptr);
    } PHASE_END(10)
    PHASE_BEGIN(11) phase_kstat((LAS float*)lds, (const bf16_t*)(ws + slot(3)), (float*)(ws + WS_KMEAN), (float*)(ws + WS_KNMAX)); PHASE_END(11)
    PHASE_BEGIN(12) phase_sel(lds, (const bf16_t*)(ws + slot(5)), (const float*)(ws + WS_KMEAN), (unsigned short*)(ws + WS_SUB), (int*)(ws + WS_CNT), (int*)(ws + WS_CTR)); PHASE_END(12)
    PHASE_BEGIN(13) phase_att(lds, (const bf16_t*)(ws + slot(5)), (const bf16_t*)(ws + slot(3)), (const bf16_t*)(ws + slot(4)), (const float*)(ws + WS_KNMAX), (const unsigned short*)(ws + WS_SUB),
                              (const int*)(ws + WS_CNT), (int*)(ws + WS_CTR), (bf16_t*)(ws + slot(6)), (bf16_t*)(ws + slot(0)), (float*)(ws + WS_LS)); PHASE_END(13)
    PHASE_BEGIN(14) phase_comb((LAS float*)lds, (const bf16_t*)(ws + slot(6)), (const bf16_t*)(ws + slot(0)), (const float*)(ws + WS_LS), (signed char*)(ws + slot(3)), (float*)(ws + WS_XSO)); PHASE_END(14)
    PHASE_BEGIN(15) run_gemm_out<true>(a, lds); PHASE_END(15)
    PHASE_BEGIN(16) run_ln<true>(a); PHASE_END(16)
    PHASE_BEGIN(17) run_gemm_sc<true>(a, lds); PHASE_END(17)
    PHASE_BEGIN(18) run_topk<true>(a, lds); PHASE_END(18)
#if SCAN_DBG == 7
    PHASE_BEGIN(19) dbg_emit7((const float*)(ws + WS_CTR + 4096), a.out); PHASE_END(19)
#elif SCAN_DBG == 6
    PHASE_BEGIN(19) dbg_emit4((const float*)(ws + WS_CTR + 4096), a.out); PHASE_END(19)
#elif SCAN_DBG == 5
    PHASE_BEGIN(19) dbg_emit5((const unsigned*)(ws + WS_CTR + 8192), a.out); PHASE_END(19)
#elif SCAN_DBG == 4
    PHASE_BEGIN(19) dbg_emit4((const float*)(ws + WS_CTR + 4096), a.out); PHASE_END(19)
#elif SCAN_DBG == 3
    PHASE_BEGIN(19) dbg_emit3((const unsigned*)(ws + WS_CTR + 8192), a.out); PHASE_END(19)
#elif SCAN_DBG == 2
    PHASE_BEGIN(19) dbg_emit((const float*)(ws + WS_CTR + 4096), a.out); PHASE_END(19)
#else
    PHASE_BEGIN(19) run_peer<true>(a, lds); PHASE_END(19)
#endif
}

extern "C" void kernel_launch(void* const* d_in, const int* in_sizes, int n_in, void* d_out, int out_size, void* d_ws, size_t ws_size, hipStream_t stream) {
    static int grid = 0;
    if (grid == 0) {
        if (n_in != 14 || out_size != MTOK * DM || ws_size < WS_END) { fprintf(stderr, "kernel_launch: unexpected shapes (n_in %d, out %d, ws %zu)\n", n_in, out_size, ws_size); grid = -1; return; }
        int dev = 0, cus = 0, per_cu = 0;
        if (hipGetDevice(&dev) != hipSuccess || hipDeviceGetAttribute(&cus, hipDeviceAttributeMultiprocessorCount, dev) != hipSuccess) { grid = -1; return; }
        if (hipFuncSetAttribute((const void*)mk_fwd, hipFuncAttributeMaxDynamicSharedMemorySize, LDS_BYTES) != hipSuccess) { fprintf(stderr, "kernel_launch: hipFuncSetAttribute failed\n"); grid = -1; return; }
        if (hipOccupancyMaxActiveBlocksPerMultiprocessor(&per_cu, (const void*)mk_fwd, 512, LDS_BYTES) != hipSuccess || per_cu < 1) { fprintf(stderr, "kernel_launch: occupancy query failed (%d)\n", per_cu); (void)hipGetLastError(); per_cu = 1; }
        grid = cus * (per_cu > 1 ? 1 : per_cu);
    }
    if (grid < 0) return;
    Args a{};
    for (int i = 0; i < 14; ++i) a.in[i] = (const float*)d_in[i];
    a.out = (float*)d_out; a.ws = (unsigned char*)d_ws;
#if ONE_LAUNCH
    a.ph_lo = 0; a.ph_hi = NPH;
    (void)hipMemsetAsync((unsigned char*)d_ws + WS_BAR, 0, XCD_BAR_WORDS * sizeof(unsigned), stream);
    void* args[] = {&a};
    hipError_t e = hipLaunchCooperativeKernel((const void*)mk_fwd, dim3(grid), dim3(512), args, LDS_BYTES, stream);
    if (e != hipSuccess) fprintf(stderr, "cooperative launch failed: %s (grid %d)\n", hipGetErrorString(e), grid);
#else
    for (int ph = 0; ph < NPH; ++ph) {
        a.ph_lo = ph; a.ph_hi = ph + 1;
        hipLaunchKernelGGL(mk_fwd, dim3(grid), dim3(512), LDS_BYTES, stream, a);
    }
#endif
}
```

```cpp
#define ONE_LAUNCH 1
#include <hip/hip_runtime.h>
#include <hip/hip_cooperative_groups.h>
#include <cstdio>
namespace cg = cooperative_groups;

#ifndef ONE_LAUNCH
#define ONE_LAUNCH 0
#endif
#ifndef SCAN_DBG
#define SCAN_DBG 0
#endif
#ifndef SCAN_A_VALU
#define SCAN_A_VALU 0
#endif
#ifndef SC8
#define SC8 1
#endif
#ifndef ENMASK
#define ENMASK 0xffffffffu
#endif
#define EN(k) ((ENMASK >> (k)) & 1u)

namespace pg8 {
#define PG8_LAS __attribute__((address_space(3)))
typedef unsigned short bf16_t;
typedef short bf16x8 __attribute__((ext_vector_type(8)));
typedef float f32x4 __attribute__((ext_vector_type(4)));
typedef unsigned u32x4 __attribute__((ext_vector_type(4)));
constexpr int BM = 256, BK = 64, HALF = 128, HTB = HALF * BK * 2  , STAGE_BYTES = 8 * HTB, NXCD = 8, WGM = 8;

__host__ __device__ __forceinline__ int lds_byte(int r, int c) { const int st = (r >> 4) * 2 + (c >> 5), rr = r & 15, cc = c & 31, ob = rr * 64 + cc * 2; return st * 1024 + (ob ^ (((ob >> 9) & 1) << 5)); }
__host__ __device__ __forceinline__ void stage_rc(int b, int& R, int& C) { const int st = b / 1024, sb = b % 1024, swz = sb ^ (((sb >> 9) & 1) << 5); R = (st >> 1) * 16 + swz / 64; C = (st & 1) * 32 + (swz % 64) / 2; }
__host__ __device__ __forceinline__ int perm32(int rho) { const int n = rho >> 4, i = rho & 15; return 8 * (i >> 2) + 4 * n + (i & 3); }

struct Unit { int pm, pn; };
struct Gemm { const bf16_t* A; const bf16_t* Bt; int M, N, K; };

struct StaticOrder {
    int nM, nN, nwg, G, c;
    __host__ __device__ void init(int M, int N, int G_, int c_) { nM = M / BM; nN = N / BM; nwg = nM * nN; G = G_; c = c_; }
    __host__ __device__ bool next(int i, Unit& u) const {
        const long L = (long)i * G + c; if (L >= nwg) return false;
        int wgid = (int)L; { const int q = nwg / NXCD, r = nwg % NXCD, xcd = wgid % NXCD, off = wgid / NXCD; wgid = (xcd < r ? xcd * (q + 1) : r * (q + 1) + (xcd - r) * q) + off; }
        const int nig = WGM * nN, gid = wgid / nig, fm = gid * WGM, gsz = (nM - fm) < WGM ? (nM - fm) : WGM;
        u.pm = fm + ((wgid % nig) % gsz); u.pn = (wgid % nig) / gsz; return true;
    }
    __device__ __forceinline__ void a_ready(const Unit&) const {}
    __device__ __forceinline__ void done(const Unit&) const {}
};
struct CountedOrder : StaticOrder {
    const unsigned* ready; unsigned need; unsigned* tmo;
    __device__ __forceinline__ void a_ready(const Unit& u) const {
        if (threadIdx.x < 64) {
            const unsigned long long t0 = __builtin_amdgcn_s_memrealtime(); unsigned polls = 0;
            while ((unsigned)__builtin_amdgcn_readfirstlane(__hip_atomic_load(ready + 64 * u.pm, __ATOMIC_RELAXED, __HIP_MEMORY_SCOPE_AGENT)) < need) {
                if ((++polls & 255u) == 0u && __builtin_amdgcn_readfirstlane(__hip_atomic_load(tmo, __ATOMIC_RELAXED, __HIP_MEMORY_SCOPE_AGENT)) != 0u) break;
                if (__builtin_amdgcn_s_memrealtime() - t0 > 2000000ull) {
                    if (threadIdx.x == 0) { unsigned expect = 0u; __hip_atomic_compare_exchange_strong(tmo + 1, &expect, 0x600u | (unsigned)(u.pm & 0xff), __ATOMIC_RELAXED, __ATOMIC_RELAXED, __HIP_MEMORY_SCOPE_AGENT); __hip_atomic_store(tmo, 1u, __ATOMIC_RELAXED, __HIP_MEMORY_SCOPE_AGENT); }
                    break; }
                __builtin_amdgcn_s_sleep(2); }
            __builtin_amdgcn_fence(__ATOMIC_ACQUIRE, "agent");
            asm volatile("s_waitcnt vmcnt(0)" ::: "memory");
        }
#if !defined(BROKEN_HOOK_NO_BARRIER)
        asm volatile("" ::: "memory"); __builtin_amdgcn_s_barrier(); asm volatile("" ::: "memory");
#endif
    }
};

__device__ __forceinline__ unsigned cvt_pk_bf16(float lo, float hi) { unsigned r; asm volatile("v_cvt_pk_bf16_f32 %0, %1, %2" : "=v"(r) : "v"(lo), "v"(hi)); return r; }
typedef float f32x2 __attribute__((ext_vector_type(2)));
__device__ __forceinline__ f32x2 gelu_pk(f32x2 v) {
    const f32x2 av = __builtin_elementwise_abs(v), d = av * 0.2316418882f + 1.0f;
    f32x2 t; t.x = __builtin_amdgcn_rcpf(d.x); t.y = __builtin_amdgcn_rcpf(d.y);
    f32x2 q = t * 0.5307027145f + (-0.7265760135f); q = q * t + 0.7107068705f; q = q * t + (-0.142248368f); q = q * t + 0.127414796f; q = q * t;
    const f32x2 s = (v * v) * (-0.72134752044f);
    f32x2 e; e.x = __builtin_amdgcn_exp2f(s.x); e.y = __builtin_amdgcn_exp2f(s.y);
    const f32x2 m = v * (q * e), r = v - m;
    f32x2 o; o.x = v.x < 0.f ? m.x : r.x; o.y = v.y < 0.f ? m.y : r.y; return o;
}

struct EpiF32 {
    static constexpr bool PERM = false, AFTER_DRAIN = false, I8 = false;
    float* C; int ldc; const float* bias;
    __device__ __forceinline__ void operator()(const f32x4 (&acc)[2][2][4][2], const Unit& u, int wr, int wc, int fr, int fq) const {
        const int row0 = u.pm * BM + wr * 64 + fr, col0 = u.pn * BM + wc * 32 + 4 * fq;
        f32x4 bv[2][2];
#pragma unroll
        for (int bj = 0; bj < 2; ++bj)
#pragma unroll
            for (int n = 0; n < 2; ++n) bv[bj][n] = bias ? *(const f32x4*)(bias + col0 + bj * HALF + n * 16) : (f32x4){0.f, 0.f, 0.f, 0.f};
#pragma unroll
        for (int ai = 0; ai < 2; ++ai)
#pragma unroll
            for (int m = 0; m < 4; ++m) { float* rowp = C + (size_t)(row0 + ai * HALF + m * 16) * ldc + col0;
#pragma unroll
                for (int bj = 0; bj < 2; ++bj)
#pragma unroll
                    for (int n = 0; n < 2; ++n) *(f32x4*)(rowp + bj * HALF + n * 16) = acc[ai][bj][m][n] + bv[bj][n]; }
    }
};
template <int ACT  > struct EpiBf16 {
    static constexpr bool PERM = true, AFTER_DRAIN = false, I8 = false;
    bf16_t* O; int ldc; const float* bias; int split_cols; size_t split_stride;
    __device__ __forceinline__ void operator()(const f32x4 (&acc)[2][2][4][2], const Unit& u, int wr, int wc, int fr, int fq) const {
        const int row0 = u.pm * BM + wr * 64 + fr; int colt = u.pn * BM; bf16_t* base = O;
        if (split_cols) { const int t = colt / split_cols; base += (size_t)t * split_stride; colt -= t * split_cols; }
        const int col0 = colt + wc * 32 + 8 * fq, bcol0 = u.pn * BM + wc * 32 + 8 * fq;
        f32x4 bv[2][2];
#pragma unroll
        for (int bj = 0; bj < 2; ++bj)
#pragma unroll
            for (int n = 0; n < 2; ++n) bv[bj][n] = bias ? *(const f32x4*)(bias + bcol0 + bj * HALF + 4 * n) : (f32x4){0.f, 0.f, 0.f, 0.f};
#pragma unroll
        for (int ai = 0; ai < 2; ++ai)
#pragma unroll
            for (int m = 0; m < 4; ++m) { bf16_t* rowp = base + (size_t)(row0 + ai * HALF + m * 16) * ldc + col0;
#pragma unroll
                for (int bj = 0; bj < 2; ++bj) { f32x4 v0 = acc[ai][bj][m][0] + bv[bj][0], v1 = acc[ai][bj][m][1] + bv[bj][1];
                    if (ACT == 1) { f32x2 a = gelu_pk((f32x2){v0[0], v0[1]}), b = gelu_pk((f32x2){v0[2], v0[3]}), c = gelu_pk((f32x2){v1[0], v1[1]}), d = gelu_pk((f32x2){v1[2], v1[3]});
                        v0 = (f32x4){a.x, a.y, b.x, b.y}; v1 = (f32x4){c.x, c.y, d.x, d.y}; }
                    if (ACT == 2) {
#pragma unroll
                        for (int j = 0; j < 4; ++j) { v0[j] = 0.5f * v0[j] * (1.0f + erff(v0[j] * 0.70710678f)); v1[j] = 0.5f * v1[j] * (1.0f + erff(v1[j] * 0.70710678f)); } }
                    u32x4 w; w.x = cvt_pk_bf16(v0[0], v0[1]); w.y = cvt_pk_bf16(v0[2], v0[3]); w.z = cvt_pk_bf16(v1[0], v1[1]); w.w = cvt_pk_bf16(v1[2], v1[3]);
                    *(u32x4*)(rowp + bj * HALF) = w; } }
    }
};

typedef int i32x4 __attribute__((ext_vector_type(4)));
template <bool I8> __device__ __forceinline__ f32x4 mma16(bf16x8 b, bf16x8 a, f32x4 c) {
    if constexpr (I8) return __builtin_bit_cast(f32x4, __builtin_amdgcn_mfma_i32_16x16x64_i8(__builtin_bit_cast(i32x4, b), __builtin_bit_cast(i32x4, a), __builtin_bit_cast(i32x4, c), 0, 0, 0));
    else return __builtin_amdgcn_mfma_f32_16x16x32_bf16(b, a, c, 0, 0, 0);
}
template <bool I8> __device__ __forceinline__ f32x4 accf(f32x4 a) { if constexpr (I8) return __builtin_convertvector(__builtin_bit_cast(i32x4, a), f32x4); else return a; }
template <class Epi, class Sched, bool STAMP = false>
__device__ __forceinline__ void gemm_phase(PG8_LAS unsigned char* lds, const Gemm g, const Sched& S, const Epi& E, unsigned long long* stamps) {
    const int tid = threadIdx.x, wid = __builtin_amdgcn_readfirstlane(tid >> 6), lane = tid & 63, wr = wid >> 2, wc = wid & 3, fr = lane & 15, fq = lane >> 4;
    const int K = g.K, nt = K / BK;
    int ts_lo = 0, ts_hi = 0, nts = 0; const unsigned long long rt_entry = STAMP ? (unsigned long long)wall_clock64() : 0ull;
#define PG8_STAMP() do { if (STAMP && wid == 0 && nts < 64) { const unsigned long long _c = (unsigned long long)clock64(); \
        ts_lo = (lane == nts) ? (int)(unsigned)_c : ts_lo; ts_hi = (lane == nts) ? (int)(unsigned)(_c >> 32) : ts_hi; ++nts; } } while (0)
    PG8_STAMP();
    unsigned voffA[2], voffB[2];
#pragma unroll
    for (int i = 0; i < 2; ++i) { int R, C; stage_rc(tid * 16 + i * 8192, R, C); const int Rb = Epi::PERM ? ((R & ~31) + perm32(R & 31)) : R;
        voffA[i] = (unsigned)(R * K + C) * 2u; voffB[i] = (unsigned)(Rb * K + C) * 2u; }
    const size_t kstep = (size_t)(BK * 2);
    const size_t hstep = (size_t)HALF * K * 2;
    const size_t tstep = 2 * hstep;
    const unsigned ldsw = (unsigned)wid * 1024u;
    const int aoff = lds_byte(wr * 64 + fr, fq * 8), boff = lds_byte(wc * 32 + fr, fq * 8);
#define PG8_SA(b, h) (((b) * 2 + (h)) * HTB)
#define PG8_SB(b, h) ((4 + (b) * 2 + (h)) * HTB)
#define PG8_STAGE(bufoff, gbase, voff) do { _Pragma("unroll") for (int _i = 0; _i < 2; ++_i) \
        __builtin_amdgcn_global_load_lds((const unsigned*)((const char*)(gbase) + (voff)[_i]), (PG8_LAS unsigned*)(lds + (bufoff) + ldsw + _i * 8192), 16, 0, 0); } while (0)
#define PG8_LDA(dst, b, h) do { _Pragma("unroll") for (int m = 0; m < 4; ++m) _Pragma("unroll") for (int k = 0; k < 2; ++k) dst[m][k] = *(const PG8_LAS bf16x8*)(lds + PG8_SA(b, h) + aoff + m * 2048 + k * 1024); } while (0)
#define PG8_LDB(dst, b, h) do { _Pragma("unroll") for (int n = 0; n < 2; ++n) _Pragma("unroll") for (int k = 0; k < 2; ++k) dst[n][k] = *(const PG8_LAS bf16x8*)(lds + PG8_SB(b, h) + boff + n * 2048 + k * 1024); } while (0)
#define PG8_MMA(ai, bj, At, Bt) do { __builtin_amdgcn_s_setprio(1); _Pragma("unroll") for (int m = 0; m < 4; ++m) _Pragma("unroll") for (int n = 0; n < 2; ++n) _Pragma("unroll") for (int k = 0; k < 2; ++k) \
        acc[ai][bj][m][n] = mma16<Epi::I8>(Bt[n][k], At[m][k], acc[ai][bj][m][n]); __builtin_amdgcn_s_setprio(0); } while (0)
#define PG8_WAIT_V(n) asm volatile("s_waitcnt vmcnt(" #n ")" ::: "memory")
#define PG8_WAIT_L(n) asm volatile("s_waitcnt lgkmcnt(" #n ")" ::: "memory")
#define PG8_BAR __builtin_amdgcn_s_barrier()
#define PG8_SCHED __builtin_amdgcn_sched_barrier(0)
    Unit cur, nxt; int ui = 0;
    if (!S.next(0, cur)) return;
    f32x4 acc[2][2][4][2];
#pragma unroll
    for (int a = 0; a < 2; ++a)
#pragma unroll
        for (int b = 0; b < 2; ++b)
#pragma unroll
            for (int m = 0; m < 4; ++m)
#pragma unroll
                for (int n = 0; n < 2; ++n) acc[a][b][m][n] = (f32x4){0.f, 0.f, 0.f, 0.f};
    bf16x8 At[4][2], B0[2][2], B1[2][2];
    const char* cA = (const char*)g.A + (size_t)cur.pm * tstep; const char* cB = (const char*)g.Bt + (size_t)cur.pn * tstep;
    S.a_ready(cur);
    PG8_STAGE(PG8_SB(0, 0), cB, voffB); PG8_STAGE(PG8_SA(0, 0), cA, voffA); PG8_STAGE(PG8_SB(0, 1), cB + hstep, voffB); PG8_STAGE(PG8_SA(0, 1), cA + hstep, voffA);
    if (wr == 1) PG8_BAR;
    PG8_WAIT_V(4); PG8_BAR;
    PG8_STAGE(PG8_SB(1, 0), cB + kstep, voffB); PG8_STAGE(PG8_SA(1, 0), cA + kstep, voffA); PG8_STAGE(PG8_SB(1, 1), cB + hstep + kstep, voffB);
    PG8_WAIT_V(6); PG8_BAR;
    PG8_STAMP();
    for (;;) {
        const bool has_next = S.next(ui + 1, nxt);
        const char* nA = has_next ? (const char*)g.A + (size_t)nxt.pm * tstep : cA; const char* nB = has_next ? (const char*)g.Bt + (size_t)nxt.pn * tstep : cB;
        for (int t = 0; t < nt; t += 2) {
            const bool last = (t == nt - 2);
            const char* a1 = cA + (size_t)(t + 1) * kstep;
            const char* a2 = last ? nA : cA + (size_t)(t + 2) * kstep; const char* b2 = last ? nB : cB + (size_t)(t + 2) * kstep;
            const char* a3 = a2 + kstep; const char* b3 = b2 + kstep;
            if (last && has_next) S.a_ready(nxt);
            PG8_LDB(B0, 0, 0); PG8_SCHED; PG8_LDA(At, 0, 0); PG8_STAGE(PG8_SA(1, 1), a1 + hstep, voffA);
            PG8_WAIT_L(8); PG8_BAR; PG8_WAIT_L(0); PG8_MMA(0, 0, At, B0); PG8_BAR; PG8_SCHED;
            PG8_LDB(B1, 0, 1); PG8_STAGE(PG8_SB(0, 0), b2, voffB);
            PG8_BAR; PG8_WAIT_L(0); PG8_MMA(0, 1, At, B1); PG8_BAR;
            PG8_LDA(At, 0, 1); PG8_STAGE(PG8_SA(0, 0), a2, voffA);
            PG8_BAR; PG8_WAIT_L(0); PG8_MMA(1, 0, At, B0); PG8_BAR; PG8_SCHED;
            PG8_STAGE(PG8_SB(0, 1), b2 + hstep, voffB);
            PG8_WAIT_V(6); PG8_BAR; PG8_MMA(1, 1, At, B1); PG8_BAR;
            PG8_LDB(B0, 1, 0); PG8_SCHED; PG8_LDA(At, 1, 0); PG8_STAGE(PG8_SA(0, 1), a2 + hstep, voffA);
            PG8_WAIT_L(8); PG8_BAR; PG8_WAIT_L(0); PG8_MMA(0, 0, At, B0); PG8_BAR; PG8_SCHED;
            PG8_LDB(B1, 1, 1); PG8_STAGE(PG8_SB(1, 0), b3, voffB);
            PG8_BAR; PG8_WAIT_L(0); PG8_MMA(0, 1, At, B1); PG8_BAR;
            PG8_LDA(At, 1, 1); PG8_STAGE(PG8_SA(1, 0), a3, voffA);
            PG8_BAR; PG8_WAIT_L(0); PG8_MMA(1, 0, At, B0); PG8_BAR; PG8_SCHED;
            PG8_STAGE(PG8_SB(1, 1), b3 + hstep, voffB);
            PG8_WAIT_V(6); PG8_BAR; PG8_MMA(1, 1, At, B1); PG8_BAR;
        }
        PG8_STAMP();
        if constexpr (!Epi::AFTER_DRAIN) { E(acc, cur, wr, wc, fr, fq); S.done(cur); }
        PG8_STAMP();
        if (!has_next) break;
#pragma unroll
        for (int a = 0; a < 2; ++a)
#pragma unroll
            for (int b = 0; b < 2; ++b)
#pragma unroll
                for (int m = 0; m < 4; ++m)
#pragma unroll
                    for (int n = 0; n < 2; ++n) acc[a][b][m][n] = (f32x4){0.f, 0.f, 0.f, 0.f};
        cur = nxt; cA = nA; cB = nB; ++ui;
    }
    PG8_WAIT_V(0);
    if (wr == 0) PG8_BAR;
    PG8_BAR;
    if constexpr (Epi::AFTER_DRAIN) { E.fused(acc, cur, wr, wc, fr, fq, lds, wid, lane); S.done(cur); }
    PG8_STAMP();
    if (STAMP && wid == 0) { stamps[lane] = lane < nts ? (((unsigned long long)(unsigned)ts_hi << 32) | (unsigned)ts_lo) : 0ull;
        if (lane == 62) stamps[62] = rt_entry; if (lane == 63) stamps[63] = (unsigned long long)wall_clock64(); }
#undef PG8_STAMP
#undef PG8_SA
#undef PG8_SB
#undef PG8_STAGE
#undef PG8_LDA
#undef PG8_LDB
#undef PG8_MMA
#undef PG8_WAIT_V
#undef PG8_WAIT_L
#undef PG8_BAR
#undef PG8_SCHED
}
}


#define LAS __attribute__((address_space(3)))
typedef unsigned short bf16_t;
typedef float f32x4 __attribute__((ext_vector_type(4)));
typedef unsigned u32x4 __attribute__((ext_vector_type(4)));
typedef unsigned u32x2 __attribute__((ext_vector_type(2)));
typedef short bf16x8 __attribute__((ext_vector_type(8)));
typedef short s16x4 __attribute__((ext_vector_type(4)));
typedef float f32x16 __attribute__((ext_vector_type(16)));

constexpr int MTOK = 16384, DM = 2048, SEQ = 8192, NHEAD = 16;
constexpr float ALPHA = 1.41421356237309515f;
constexpr size_t MiB = (size_t)1 << 20;
constexpr size_t WS_WIN = 0, WS_WOUT = 32 * MiB, WS_WKVQ = 40 * MiB, WS_WO = 64 * MiB, WS_WC = 72 * MiB, WS_UB = 88 * MiB, WS_VB = 152 * MiB, WS_USC = 216 * MiB, WS_VSC = 217 * MiB, WS_H = 224 * MiB, WS_XQ = 232 * MiB, WS_XS = 264 * MiB, WS_W = 272 * MiB, WS_CS = 280 * MiB, WS_SLOT = 344 * MiB;
constexpr size_t WS_EID = 920 * MiB, WS_GATE = 928 * MiB, WS_COS = 936 * MiB, WS_SIN = 938 * MiB, WS_KMEAN = 940 * MiB, WS_LB = 941 * MiB, WS_LS = 942 * MiB, WS_SUB = 946 * MiB, WS_CNT = 962 * MiB, WS_CTR = 963 * MiB, WS_DEC = 964 * MiB, WS_END = 966 * MiB;
constexpr size_t WS_BAR = WS_CTR + 65536;
constexpr size_t WS_EID16 = WS_CS + 8 * MiB;
constexpr size_t WS_SWOUT = WS_XS + 512 * 1024;
constexpr size_t WS_WC8 = WS_H, WS_SWC = WS_XS + 5 * MiB, WS_XSO = WS_XS + 6 * MiB, WS_SWO = WS_XS + 7 * MiB;
constexpr size_t WS_XS0 = WS_XS + 1 * MiB, WS_SWIN = WS_XS + 2 * MiB, WS_SWKVQ = WS_XS + 3 * MiB, WS_XS1 = WS_XS + 4 * MiB;
constexpr size_t WS_KNMAX = WS_KMEAN + 768 * 1024;
__host__ __device__ constexpr size_t slot(int i) { return WS_SLOT + (size_t)i * 64 * MiB; }
constexpr int LDS_BYTES = 144 * 1024;
constexpr int NPH = 20;

struct Args { const float* in[14]; float* out; unsigned char* ws; int ph_lo, ph_hi; };

__device__ __forceinline__ float bflo(unsigned w) { return __uint_as_float(w << 16); }
__device__ __forceinline__ float bfhi(unsigned w) { return __uint_as_float(w & 0xffff0000u); }
__device__ __forceinline__ float bf2f(bf16_t b) { return __uint_as_float(((unsigned)b) << 16); }
typedef __bf16 bf16x2_t __attribute__((ext_vector_type(2)));
typedef float f32x2_t __attribute__((ext_vector_type(2)));
__device__ __forceinline__ unsigned pk_bf16(float lo, float hi) { const f32x2_t f = {lo, hi}; return __builtin_bit_cast(unsigned, __builtin_convertvector(f, bf16x2_t)); }
__device__ __forceinline__ float wave_sum(float v) {
#pragma unroll
    for (int o = 32; o >= 1; o >>= 1) v += __shfl_xor(v, o);
    return v;
}
__device__ __forceinline__ float wave_max(float v) {
#pragma unroll
    for (int o = 32; o >= 1; o >>= 1) v = fmaxf(v, __shfl_xor(v, o));
    return v;
}
__device__ __forceinline__ float sigmoidf_(float z) { return 1.0f / (1.0f + __expf(-z)); }


__device__ __forceinline__ void store_wt16(void* p, u32x4 v) {
    __hip_atomic_store((unsigned long long*)p, ((unsigned long long)v.y << 32) | v.x, __ATOMIC_RELAXED, __HIP_MEMORY_SCOPE_AGENT);
    __hip_atomic_store((unsigned long long*)p + 1, ((unsigned long long)v.w << 32) | v.z, __ATOMIC_RELAXED, __HIP_MEMORY_SCOPE_AGENT);
}
__device__ __forceinline__ void store_wt8(void* p, u32x2 v) {
    __hip_atomic_store((unsigned long long*)p, ((unsigned long long)v.y << 32) | v.x, __ATOMIC_RELAXED, __HIP_MEMORY_SCOPE_AGENT);
}
struct EpiIn {
    static constexpr bool PERM = true, AFTER_DRAIN = false, I8 = false;
    bf16_t* Q1; float* LF; bf16_t* I1; bf16_t* G1; const float* LB;
    __device__ __forceinline__ void operator()(const pg8::f32x4 (&acc)[2][2][4][2], const pg8::Unit& u, int wr, int wc, int fr, int fq) const {
        const int type = u.pn >> 3;
        const int row0 = u.pm * 256 + wr * 64 + fr, col0 = (u.pn & 7) * 256 + wc * 32 + 8 * fq;
        if (type == 1) {
#pragma unroll
            for (int bj = 0; bj < 2; ++bj) {
                const int c = col0 + bj * 128;
                const f32x4 lb0 = *(const f32x4*)(LB + c), lb1 = *(const f32x4*)(LB + c + 4);
#pragma unroll
                for (int ai = 0; ai < 2; ++ai)
#pragma unroll
                    for (int m = 0; m < 4; ++m) {
                        float* p = LF + (size_t)(row0 + ai * 128 + m * 16) * DM + c;
                        f32x4 o0, o1;
#pragma unroll
                        for (int j = 0; j < 4; ++j) {
                            o0[j] = __logf(lb0[j] + (1.0f - lb0[j]) * sigmoidf_(acc[ai][bj][m][0][j]));
                            o1[j] = __logf(lb1[j] + (1.0f - lb1[j]) * sigmoidf_(acc[ai][bj][m][1][j]));
                        }
                        *(f32x4*)p = o0; *(f32x4*)(p + 4) = o1;
                    }
            }
        } else {
            bf16_t* dst = Q1 + (size_t)(type - (type > 0 ? 1 : 0)) * ((size_t)32 << 20);
            const bool act = (type != 2);
#pragma unroll
            for (int ai = 0; ai < 2; ++ai)
#pragma unroll
                for (int m = 0; m < 4; ++m)
#pragma unroll
                    for (int bj = 0; bj < 2; ++bj) {
                        f32x4 v0 = acc[ai][bj][m][0], v1 = acc[ai][bj][m][1];
                        if (act) {
#pragma unroll
                            for (int j = 0; j < 4; ++j) { v0[j] = v0[j] * sigmoidf_(v0[j]); v1[j] = v1[j] * sigmoidf_(v1[j]); }
                        }
                        u32x4 w; w.x = pk_bf16(v0[0], v0[1]); w.y = pk_bf16(v0[2], v0[3]); w.z = pk_bf16(v1[0], v1[1]); w.w = pk_bf16(v1[2], v1[3]);
                        *(u32x4*)(dst + (size_t)(row0 + ai * 128 + m * 16) * DM + col0 + bj * 128) = w;
                    }
        }
    }
};
struct EpiRes {
    static constexpr bool PERM = false, AFTER_DRAIN = false, I8 = false;
    const float* res; float* Y;
    __device__ __forceinline__ void operator()(const pg8::f32x4 (&acc)[2][2][4][2], const pg8::Unit& u, int wr, int wc, int fr, int fq) const {
        const int row0 = u.pm * 256 + wr * 64 + fr, col0 = u.pn * 256 + wc * 32 + 4 * fq;
#pragma unroll
        for (int ai = 0; ai < 2; ++ai)
#pragma unroll
            for (int m = 0; m < 4; ++m) {
                const size_t off = (size_t)(row0 + ai * 128 + m * 16) * DM + col0;
#pragma unroll
                for (int bj = 0; bj < 2; ++bj)
#pragma unroll
                    for (int n = 0; n < 2; ++n) {
                        const f32x4 r = *(const f32x4*)(res + off + bj * 128 + n * 16);
                        *(f32x4*)(Y + off + bj * 128 + n * 16) = r * ALPHA + acc[ai][bj][m][n];
                    }
            }
    }
};
template <bool Q8> struct EpiF32_ {
    static constexpr bool PERM = false, AFTER_DRAIN = false, I8 = Q8;
    float* C; int ldc; const float* SA; const float* SB;
    __device__ __forceinline__ void operator()(const pg8::f32x4 (&acc)[2][2][4][2], const pg8::Unit& u, int wr, int wc, int fr, int fq) const {
        const int row0 = u.pm * 256 + wr * 64 + fr, col0 = u.pn * 256 + wc * 32 + 4 * fq;
        float sa[2][4]; f32x4 sb[2][2];
#pragma unroll
        for (int ai = 0; ai < 2; ++ai)
#pragma unroll
            for (int m = 0; m < 4; ++m) sa[ai][m] = Q8 ? SA[row0 + ai * 128 + m * 16] : 1.0f;
#pragma unroll
        for (int bj = 0; bj < 2; ++bj)
#pragma unroll
            for (int n = 0; n < 2; ++n) sb[bj][n] = Q8 ? *(const f32x4*)(SB + col0 + bj * 128 + n * 16) : (f32x4){1.f, 1.f, 1.f, 1.f};
#pragma unroll
        for (int ai = 0; ai < 2; ++ai)
#pragma unroll
            for (int m = 0; m < 4; ++m) {
                const int row = row0 + ai * 128 + m * 16;
#pragma unroll
                for (int bj = 0; bj < 2; ++bj)
#pragma unroll
                    for (int n = 0; n < 2; ++n) {
                        f32x4 v = pg8::accf<Q8>(acc[ai][bj][m][n]);
                        if (Q8) v = v * sb[bj][n] * sa[ai][m];
                        *(f32x4*)(C + (size_t)row * ldc + col0 + bj * 128 + n * 16) = v;
                    }
            }
    }
};
typedef EpiF32_<false> EpiF32;
struct EpiSCT {
    static constexpr bool PERM = true, AFTER_DRAIN = false, I8 = true;
    bf16_t* C; int ldc; const float* SA; const float* SB;
    __device__ __forceinline__ void operator()(const pg8::f32x4 (&acc)[2][2][4][2], const pg8::Unit& u, int wr, int wc, int fr, int fq) const {
        const int row0 = u.pm * 256 + wr * 64 + fr, col0 = u.pn * 256 + wc * 32 + 8 * fq;
        float sa[2][4]; f32x4 sb[2][2];
#pragma unroll
        for (int ai = 0; ai < 2; ++ai)
#pragma unroll
            for (int m = 0; m < 4; ++m) sa[ai][m] = SA[row0 + ai * 128 + m * 16];
#pragma unroll
        for (int bj = 0; bj < 2; ++bj)
#pragma unroll
            for (int n = 0; n < 2; ++n) sb[bj][n] = *(const f32x4*)(SB + col0 + bj * 128 + 4 * n);
#pragma unroll
        for (int ai = 0; ai < 2; ++ai)
#pragma unroll
            for (int m = 0; m < 4; ++m)
#pragma unroll
                for (int bj = 0; bj < 2; ++bj) {
                    const int row = row0 + ai * 128 + m * 16;
                    const f32x4 v0 = pg8::accf<true>(acc[ai][bj][m][0]) * sb[bj][0] * sa[ai][m], v1 = pg8::accf<true>(acc[ai][bj][m][1]) * sb[bj][1] * sa[ai][m];
                    u32x4 w; w.x = pk_bf16(v0[0], v0[1]); w.y = pk_bf16(v0[2], v0[3]); w.z = pk_bf16(v1[0], v1[1]); w.w = pk_bf16(v1[2], v1[3]);
                    *(u32x4*)(C + (size_t)row * ldc + col0 + bj * 128) = w;
                }
    }
};
template <bool Q8> struct EpiKVQ_ {
    static constexpr bool PERM = true, AFTER_DRAIN = false, I8 = Q8;
    bf16_t* K; const float* SA; const float* SB;
    __device__ __forceinline__ void operator()(const pg8::f32x4 (&acc)[2][2][4][2], const pg8::Unit& u, int wr, int wc, int fr, int fq) const {
        const int t = u.pn >> 3;
        bf16_t* dst = K + (size_t)t * ((size_t)32 << 20);
        const int row0 = u.pm * 256 + wr * 64 + fr, col0 = (u.pn & 7) * 256 + wc * 32 + 8 * fq;
        float sa[2][4]; f32x4 sb[2][2];
#pragma unroll
        for (int ai = 0; ai < 2; ++ai)
#pragma unroll
            for (int m = 0; m < 4; ++m) sa[ai][m] = Q8 ? SA[row0 + ai * 128 + m * 16] : 1.0f;
#pragma unroll
        for (int bj = 0; bj < 2; ++bj)
#pragma unroll
            for (int n = 0; n < 2; ++n) sb[bj][n] = Q8 ? *(const f32x4*)(SB + u.pn * 256 + bj * 128 + wc * 32 + 8 * fq + 4 * n) : (f32x4){1.f, 1.f, 1.f, 1.f};
#pragma unroll
        for (int ai = 0; ai < 2; ++ai)
#pragma unroll
            for (int m = 0; m < 4; ++m)
#pragma unroll
                for (int bj = 0; bj < 2; ++bj) {
                    const int row = row0 + ai * 128 + m * 16;
                    f32x4 v0 = pg8::accf<Q8>(acc[ai][bj][m][0]), v1 = pg8::accf<Q8>(acc[ai][bj][m][1]);
                    if (Q8) { v0 = v0 * sb[bj][0] * sa[ai][m]; v1 = v1 * sb[bj][1] * sa[ai][m]; }
                    u32x4 w; w.x = pk_bf16(v0[0], v0[1]); w.y = pk_bf16(v0[2], v0[3]); w.z = pk_bf16(v1[0], v1[1]); w.w = pk_bf16(v1[2], v1[3]);
                    *(u32x4*)(dst + (size_t)row * DM + col0 + bj * 128) = w;
                }
    }
};
typedef EpiKVQ_<false> EpiKVQ;

template <bool Q8> struct EpiKVQR_ {
    static constexpr bool PERM = true, AFTER_DRAIN = false, I8 = Q8;
    bf16_t* K; const float* COS; const float* SIN; const float* SA; const float* SB;
    __device__ __forceinline__ void operator()(const pg8::f32x4 (&acc)[2][2][4][2], const pg8::Unit& u, int wr, int wc, int fr, int fq) const {
        const int t = u.pn >> 3;
        bf16_t* dst = K + (size_t)t * ((size_t)32 << 20);
        const int row0 = u.pm * 256 + wr * 64 + fr;
        const int g = 4 * wc + fq;
        const int col0 = (u.pn & 7) * 256 + wc * 32 + 8 * fq;
        float sa[2][4]; f32x4 sb[2][2];
#pragma unroll
        for (int ai = 0; ai < 2; ++ai)
#pragma unroll
            for (int m = 0; m < 4; ++m) sa[ai][m] = Q8 ? SA[row0 + ai * 128 + m * 16] : 1.0f;
#pragma unroll
        for (int bj = 0; bj < 2; ++bj)
#pragma unroll
            for (int n = 0; n < 2; ++n) sb[bj][n] = Q8 ? *(const f32x4*)(SB + u.pn * 256 + bj * 128 + wc * 32 + 8 * fq + 4 * n) : (f32x4){1.f, 1.f, 1.f, 1.f};
        if (t == 1) {
#pragma unroll
            for (int ai = 0; ai < 2; ++ai)
#pragma unroll
                for (int m = 0; m < 4; ++m)
#pragma unroll
                    for (int bj = 0; bj < 2; ++bj) {
                        const int row = row0 + ai * 128 + m * 16;
                        f32x4 a = pg8::accf<Q8>(acc[ai][bj][m][0]), b = pg8::accf<Q8>(acc[ai][bj][m][1]);
                        if (Q8) { a = a * sb[bj][0] * sa[ai][m]; b = b * sb[bj][1] * sa[ai][m]; }
                        u32x4 w; w.x = pk_bf16(a[0], a[1]); w.y = pk_bf16(a[2], a[3]); w.z = pk_bf16(b[0], b[1]); w.w = pk_bf16(b[2], b[3]);
                        *(u32x4*)(dst + (size_t)row * DM + col0 + bj * 128) = w;
                    }
        } else {
            const int pos0 = row0 & (SEQ - 1);
            f32x4 c = *(const f32x4*)(COS + pos0 * 64 + 4 * g), s_ = *(const f32x4*)(SIN + pos0 * 64 + 4 * g);
            const f32x4 c16 = *(const f32x4*)(COS + 16 * 64 + 4 * g), s16 = *(const f32x4*)(SIN + 16 * 64 + 4 * g), c128 = *(const f32x4*)(COS + 128 * 64 + 4 * g), s128 = *(const f32x4*)(SIN + 128 * 64 + 4 * g);
#pragma unroll
            for (int q = 0; q < 8; ++q) {
                const int ai = q >> 2, m = ai ? 7 - q : q;
#pragma unroll
                for (int bj = 0; bj < 2; ++bj) {
                    f32x4 a = pg8::accf<Q8>(acc[ai][bj][m][0]), b = pg8::accf<Q8>(acc[ai][bj][m][1]);
                    if (Q8) { a = a * sb[bj][0] * sa[ai][m]; b = b * sb[bj][1] * sa[ai][m]; }
                    u32x2 w1, w2;
                    w1.x = pk_bf16(a[0] * c[0] - b[0] * s_[0], a[1] * c[1] - b[1] * s_[1]); w1.y = pk_bf16(a[2] * c[2] - b[2] * s_[2], a[3] * c[3] - b[3] * s_[3]);
                    w2.x = pk_bf16(a[0] * s_[0] + b[0] * c[0], a[1] * s_[1] + b[1] * c[1]); w2.y = pk_bf16(a[2] * s_[2] + b[2] * c[2], a[3] * s_[3] + b[3] * c[3]);
                    bf16_t* p = dst + (size_t)(row0 + ai * 128 + m * 16) * DM + ((u.pn & 7) * 2 + bj) * 128 + 4 * g;
                    *(u32x2*)p = w1; *(u32x2*)(p + 64) = w2;
                }
                if (q < 3) { const f32x4 cn = c * c16 - s_ * s16, sn = s_ * c16 + c * s16; c = cn; s_ = sn; }
                else if (q == 3) { const f32x4 cn = c * c128 - s_ * s128, sn = s_ * c128 + c * s128; c = cn; s_ = sn; }
                else if (q < 7) { const f32x4 cn = c * c16 + s_ * s16, sn = s_ * c16 - c * s16; c = cn; s_ = sn; }
            }
        }
    }
};

__host__ __device__ __forceinline__ int rot_pos(int d) { return d < 64 ? 8 * (d >> 2) + (d & 3) : 8 * ((d - 64) >> 2) + 4 + (d & 3); }
__device__ __forceinline__ void transpose_tiles(LAS float* tile, const float* src, int ldn, int K, int N, bf16_t* dst, int nperm = 0) {
    const int tid = threadIdx.x;
    const int tn = N / 64, ntiles = tn * (K / 64);
    f32x4 nx[2];
#define TT_LOAD(tI_) { const int k0_ = ((tI_) / tn) * 64, n0_ = ((tI_) % tn) * 64; _Pragma("unroll") for (int r = 0; r < 2; ++r) nx[r] = *(const f32x4*)(src + (size_t)(k0_ + (tid >> 4) + 32 * r) * ldn + n0_ + (tid & 15) * 4); }
    if ((int)blockIdx.x < ntiles) TT_LOAD((int)blockIdx.x)
    for (int tI = blockIdx.x; tI < ntiles; tI += gridDim.x) {
        const int k0 = (tI / tn) * 64, n0 = (tI % tn) * 64;
        const f32x4 c0 = nx[0], c1 = nx[1];
        if (tI + (int)gridDim.x < ntiles) TT_LOAD(tI + (int)gridDim.x)
#pragma unroll
        for (int r = 0; r < 2; ++r) {
            const int kk = (tid >> 4) + 32 * r, nn = (tid & 15) * 4;
            const f32x4 v = r == 0 ? c0 : c1;
            tile[kk * 65 + nn + 0] = v[0]; tile[kk * 65 + nn + 1] = v[1]; tile[kk * 65 + nn + 2] = v[2]; tile[kk * 65 + nn + 3] = v[3];
        }
        __syncthreads();
        {
            const int nn = tid >> 3, kk8 = (tid & 7) * 8;
            float f[8];
#pragma unroll
            for (int j = 0; j < 8; ++j) f[j] = tile[(kk8 + j) * 65 + nn];
            u32x4 w; w.x = pk_bf16(f[0], f[1]); w.y = pk_bf16(f[2], f[3]); w.z = pk_bf16(f[4], f[5]); w.w = pk_bf16(f[6], f[7]);
            const int nsrc = n0 + nn, nrow = nsrc < nperm ? (nsrc & ~127) + rot_pos(nsrc & 127) : nsrc;
            *(u32x4*)(dst + (size_t)nrow * K + k0 + kk8) = w;
        }
        __syncthreads();
    }
}
#undef TT_LOAD
__device__ __forceinline__ void convert_bf16(const float* src, bf16_t* dst, size_t n) {
    const size_t stride = (size_t)gridDim.x * 512 * 8;
    for (size_t i = ((size_t)blockIdx.x * 512 + threadIdx.x) * 8; i < n; i += stride) {
        const f32x4 a = *(const f32x4*)(src + i), b = *(const f32x4*)(src + i + 4);
        u32x4 w; w.x = pk_bf16(a[0], a[1]); w.y = pk_bf16(a[2], a[3]); w.z = pk_bf16(b[0], b[1]); w.w = pk_bf16(b[2], b[3]);
        *(u32x4*)(dst + i) = w;
    }
}
__device__ __forceinline__ void split8(const f32x4 x0, const f32x4 x1, bf16x8& hi, bf16x8& lo) {
    u32x4 h, l;
    h.x = pk_bf16(x0[0], x0[1]); h.y = pk_bf16(x0[2], x0[3]); h.z = pk_bf16(x1[0], x1[1]); h.w = pk_bf16(x1[2], x1[3]);
    l.x = pk_bf16(x0[0] - bflo(h.x), x0[1] - bfhi(h.x)); l.y = pk_bf16(x0[2] - bflo(h.y), x0[3] - bfhi(h.y)); l.z = pk_bf16(x1[0] - bflo(h.z), x1[1] - bfhi(h.z)); l.w = pk_bf16(x1[2] - bflo(h.w), x1[3] - bfhi(h.w));
    hi = __builtin_bit_cast(bf16x8, h); lo = __builtin_bit_cast(bf16x8, l);
}
__device__ __forceinline__ void fold_peer_keys(LAS float* lds, const float* w_query, const float* sub_keys, bf16_t* WcT) {
    const int tid = threadIdx.x, lane = tid & 63, wv = tid >> 6, r32 = lane & 31, hh2 = lane >> 5, keyt = wv & 3, kint = wv >> 2;
    LAS float* Ss = lds;
    LAS float* Ws = lds + 128 * 132;
    for (int grp = blockIdx.x; grp < 256; grp += gridDim.x) {
        const int l = grp >> 7, hh = (grp >> 3) & 15, kb0 = (grp & 7) * 4, h = hh >> 1, half = hh & 1;
        const float* sk = sub_keys + (size_t)(((l * 2 + half) * 8 + h) * 128) * 128;
        const float* wq0 = w_query + (size_t)l * DM * DM + h * 256 + half * 128;
        f32x4 nws[4];
#define FK_WLOAD(kb_) { _Pragma("unroll") for (int r = 0; r < 4; ++r) { const int idx = tid + 512 * r, kin = idx >> 5, d4 = (idx & 31) * 4; nws[r] = *(const f32x4*)(wq0 + (size_t)((kb_) * 64 + kin) * DM + d4); } }
        FK_WLOAD(kb0)
        __syncthreads();
#pragma unroll
        for (int r = 0; r < 8; ++r) { const int idx = tid + 512 * r, key = idx >> 5, d4 = (idx & 31) * 4; *(LAS f32x4*)(Ss + key * 132 + d4) = *(const f32x4*)(sk + key * 128 + d4); }
        for (int kq = 0; kq < 4; ++kq) {
            const int kb = kb0 + kq;
            if (kq) __syncthreads();
#pragma unroll
            for (int r = 0; r < 4; ++r) { const int idx = tid + 512 * r, kin = idx >> 5, d4 = (idx & 31) * 4; *(LAS f32x4*)(Ws + kin * 132 + d4) = nws[r]; }
            if (kq < 3) FK_WLOAD(kb + 1)
            __syncthreads();
            f32x16 acc;
#pragma unroll
            for (int i = 0; i < 16; ++i) acc[i] = 0.f;
            const LAS float* ap = Ws + (kint * 32 + r32) * 132 + 8 * hh2;
            const LAS float* bp = Ss + (keyt * 32 + r32) * 132 + 8 * hh2;
#pragma unroll
            for (int ks = 0; ks < 8; ++ks) {
                bf16x8 ah, al, bh, bl;
                split8(*(const LAS f32x4*)(ap + 16 * ks), *(const LAS f32x4*)(ap + 16 * ks + 4), ah, al);
                split8(*(const LAS f32x4*)(bp + 16 * ks), *(const LAS f32x4*)(bp + 16 * ks + 4), bh, bl);
                acc = __builtin_amdgcn_mfma_f32_32x32x16_bf16(al, bh, acc, 0, 0, 0);
                acc = __builtin_amdgcn_mfma_f32_32x32x16_bf16(ah, bh, acc, 0, 0, 0);
            }
            unsigned w[4][2];
#pragma unroll
            for (int q = 0; q < 4; ++q) { w[q][0] = pk_bf16(acc[4 * q], acc[4 * q + 1]); w[q][1] = pk_bf16(acc[4 * q + 2], acc[4 * q + 3]); }
            u32x4 o0, o1;
            { const auto r0 = __builtin_amdgcn_permlane32_swap(w[0][0], w[2][0], false, false), r1 = __builtin_amdgcn_permlane32_swap(w[0][1], w[2][1], false, false);
              o0 = (u32x4){r0[0], r1[0], r0[1], r1[1]}; }
            { const auto r0 = __builtin_amdgcn_permlane32_swap(w[1][0], w[3][0], false, false), r1 = __builtin_amdgcn_permlane32_swap(w[1][1], w[3][1], false, false);
              o1 = (u32x4){r0[0], r1[0], r0[1], r1[1]}; }
            bf16_t* o = WcT + (size_t)l * DM * DM + (size_t)(h * 256 + half * 128 + keyt * 32 + r32) * DM + kb * 64 + kint * 32 + 16 * hh2;
            *(u32x4*)o = o0; *(u32x4*)(o + 8) = o1;
        }
#undef FK_WLOAD
    }
    __syncthreads();
}

__device__ __forceinline__ void quant_rows(const float* src, unsigned char* dst, float* scl, int nrows) {
    const int lane = threadIdx.x & 63, gw = blockIdx.x * 8 + (threadIdx.x >> 6), nw = gridDim.x * 8;
    for (int row = gw; row < nrows; row += nw) {
        const float* p = src + (size_t)row * DM;
        f32x4 v[8];
#pragma unroll
        for (int i = 0; i < 2; ++i)
#pragma unroll
            for (int q = 0; q < 4; ++q) v[i * 4 + q] = *(const f32x4*)(p + 1024 * i + 16 * lane + 4 * q);
        float am = 0.f;
#pragma unroll
        for (int i = 0; i < 8; ++i) am = fmaxf(am, fmaxf(fmaxf(fabsf(v[i][0]), fabsf(v[i][1])), fmaxf(fabsf(v[i][2]), fabsf(v[i][3]))));
        am = fmaxf(wave_max(am), 1e-30f);
        const float inv = 127.0f / am;
        if (lane == 0) scl[row] = am * (1.0f / 127.0f);
#pragma unroll
        for (int i = 0; i < 2; ++i) {
            u32x4 w;
#pragma unroll
            for (int q = 0; q < 4; ++q) {
                const f32x4 t = v[i * 4 + q];
                const unsigned b0 = (unsigned)(int)(rintf(t[0] * inv) + 128.0f), b1 = (unsigned)(int)(rintf(t[1] * inv) + 128.0f), b2 = (unsigned)(int)(rintf(t[2] * inv) + 128.0f), b3 = (unsigned)(int)(rintf(t[3] * inv) + 128.0f);
                w[q] = b0 | (b1 << 8) | (b2 << 16) | (b3 << 24);
            }
            *(u32x4*)(dst + (size_t)row * DM + 1024 * i + 16 * lane) = w;
        }
    }
}
__device__ __forceinline__ void quant_strip(LAS unsigned char* lds, const float* src, int ldn, int sI, signed char* dst, float* scl, int nperm) {
    const int tid = threadIdx.x, kg = tid >> 3, c4 = (tid & 7) * 4, wv = tid >> 6;
    LAS float* red = (LAS float*)lds;
    {
        const int n0 = sI * 32;
        f32x4 v[32];
        const float* p = src + (size_t)(kg * 32) * ldn + n0 + c4;
#pragma unroll
        for (int it = 0; it < 32; ++it) v[it] = *(const f32x4*)(p + (size_t)it * ldn);
        f32x4 am = {0.f, 0.f, 0.f, 0.f};
#pragma unroll
        for (int it = 0; it < 32; ++it)
#pragma unroll
            for (int j = 0; j < 4; ++j) am[j] = fmaxf(am[j], fabsf(v[it][j]));
#pragma unroll
        for (int o = 8; o <= 32; o <<= 1)
#pragma unroll
            for (int j = 0; j < 4; ++j) am[j] = fmaxf(am[j], __shfl_xor(am[j], o));
        if ((tid & 63) < 8) *(LAS f32x4*)(red + wv * 32 + c4) = am;
        __syncthreads();
#pragma unroll
        for (int w = 0; w < 8; ++w) { const f32x4 r = *(const LAS f32x4*)(red + w * 32 + c4);
#pragma unroll
            for (int j = 0; j < 4; ++j) am[j] = fmaxf(am[j], r[j]); }
#pragma unroll
        for (int j = 0; j < 4; ++j) {
            const float m = fmaxf(am[j], 1e-30f), inv = 127.0f / m;
            const int nsrc = n0 + c4 + j, nrow = nsrc < nperm ? (nsrc & ~127) + rot_pos(nsrc & 127) : nsrc;
            if (kg == 0) scl[nrow] = m * (1.0f / 127.0f);
            signed char* o = dst + (size_t)nrow * DM + kg * 32;
#pragma unroll
            for (int h = 0; h < 2; ++h) {
                u32x4 w;
#pragma unroll
                for (int d = 0; d < 4; ++d) {
                    unsigned bb = 0;
#pragma unroll
                    for (int e = 0; e < 4; ++e) bb |= ((unsigned)(int)rintf(v[h * 16 + d * 4 + e][j] * inv) & 0xffu) << (8 * e);
                    w[d] = bb;
                }
                *(u32x4*)(o + h * 16) = w;
            }
        }
        __syncthreads();
    }
}
__device__ __forceinline__ void quant_rows_s(const float* src, signed char* dst, float* scl, int nrows, bool local) {
    const int lane = threadIdx.x & 63, gw = local ? (int)(threadIdx.x >> 6) : (int)(blockIdx.x * 8 + (threadIdx.x >> 6)), nw = local ? 8 : (int)gridDim.x * 8;
    f32x4 v[8], nv[8];
#define QS_LOAD(V_, row_) { const float* p_ = src + (size_t)(row_) * DM; _Pragma("unroll") for (int i = 0; i < 2; ++i) _Pragma("unroll") for (int q = 0; q < 4; ++q) V_[i * 4 + q] = *(const f32x4*)(p_ + 1024 * i + 16 * lane + 4 * q); }
    if (gw < nrows) QS_LOAD(v, gw)
    for (int row = gw; row < nrows; row += nw) {
        if (row + nw < nrows) QS_LOAD(nv, row + nw)
        float am = 0.f;
#pragma unroll
        for (int i = 0; i < 8; ++i) am = fmaxf(am, fmaxf(fmaxf(fabsf(v[i][0]), fabsf(v[i][1])), fmaxf(fabsf(v[i][2]), fabsf(v[i][3]))));
        am = fmaxf(wave_max(am), 1e-30f);
        const float inv = 127.0f / am;
        if (lane == 0) scl[row] = am * (1.0f / 127.0f);
#pragma unroll
        for (int i = 0; i < 2; ++i) {
            u32x4 w;
#pragma unroll
            for (int q = 0; q < 4; ++q) {
                const f32x4 t = v[i * 4 + q];
                w[q] = ((unsigned)(int)rintf(t[0] * inv) & 0xffu) | (((unsigned)(int)rintf(t[1] * inv) & 0xffu) << 8) | (((unsigned)(int)rintf(t[2] * inv) & 0xffu) << 16) | (((unsigned)(int)rintf(t[3] * inv) & 0xffu) << 24);
            }
            *(u32x4*)(dst + (size_t)row * DM + 1024 * i + 16 * lane) = w;
        }
#pragma unroll
        for (int i = 0; i < 8; ++i) v[i] = nv[i];
    }
#undef QS_LOAD
}
__device__ __forceinline__ void quant_rows_bf16(const bf16_t* src, signed char* dst, float* scl, int nrows, bool local = false) {
    const int lane = threadIdx.x & 63, gw = local ? (int)(threadIdx.x >> 6) : (int)(blockIdx.x * 8 + (threadIdx.x >> 6)), nw = local ? 8 : (int)gridDim.x * 8;
    for (int row = gw; row < nrows; row += nw) {
        u32x4 v[4];
#pragma unroll
        for (int i = 0; i < 4; ++i) v[i] = *(const u32x4*)(src + (size_t)row * DM + 512 * i + 8 * lane);
        float am = 0.f;
#pragma unroll
        for (int i = 0; i < 4; ++i)
#pragma unroll
            for (int d = 0; d < 4; ++d) am = fmaxf(am, fmaxf(fabsf(bflo(v[i][d])), fabsf(bfhi(v[i][d]))));
        am = fmaxf(wave_max(am), 1e-30f);
        const float inv = 127.0f / am;
        if (lane == 0) scl[row] = am * (1.0f / 127.0f);
#pragma unroll
        for (int i = 0; i < 4; ++i) {
            u32x2 w;
            w.x = ((unsigned)(int)rintf(bflo(v[i].x) * inv) & 0xffu) | (((unsigned)(int)rintf(bfhi(v[i].x) * inv) & 0xffu) << 8) | (((unsigned)(int)rintf(bflo(v[i].y) * inv) & 0xffu) << 16) | (((unsigned)(int)rintf(bfhi(v[i].y) * inv) & 0xffu) << 24);
            w.y = ((unsigned)(int)rintf(bflo(v[i].z) * inv) & 0xffu) | (((unsigned)(int)rintf(bfhi(v[i].z) * inv) & 0xffu) << 8) | (((unsigned)(int)rintf(bflo(v[i].w) * inv) & 0xffu) << 16) | (((unsigned)(int)rintf(bfhi(v[i].w) * inv) & 0xffu) << 24);
            *(u32x2*)(dst + (size_t)row * DM + 512 * i + 8 * lane) = w;
        }
    }
}
__device__ __forceinline__ void phase_prep(const Args& a, LAS unsigned char* lds) {
    unsigned char* ws = a.ws;
    LAS float* tile = (LAS float*)lds;
    for (int sI = blockIdx.x; sI < 576; sI += gridDim.x) {
        if (sI < 256)      quant_strip(lds, a.in[1], 4 * DM, sI, (signed char*)(ws + WS_WIN), (float*)(ws + WS_SWIN), 0);
        else if (sI < 384) quant_strip(lds, a.in[5], 2 * DM, sI - 256, (signed char*)(ws + WS_WKVQ), (float*)(ws + WS_SWKVQ), DM);
        else if (sI < 448) quant_strip(lds, a.in[6], DM, sI - 384, (signed char*)(ws + WS_WKVQ) + (size_t)2 * DM * DM, (float*)(ws + WS_SWKVQ) + 2 * DM, DM);
        else if (sI < 512) quant_strip(lds, a.in[3], DM, sI - 448, (signed char*)(ws + WS_WOUT), (float*)(ws + WS_SWOUT), 0);
        else               quant_strip(lds, a.in[7], DM, sI - 512, (signed char*)(ws + WS_WO), (float*)(ws + WS_SWO), 0);
    }
    __syncthreads();
    fold_peer_keys((LAS float*)lds, a.in[8], a.in[9], (bf16_t*)(ws + WS_WC));
    if (gridDim.x == 256) {
        const int b = blockIdx.x, r0 = b < 64 ? 40 * b : 2560 + 72 * (b - 64), nr = b < 64 ? 40 : 72;
        quant_rows_s(a.in[0] + (size_t)r0 * DM, (signed char*)(ws + slot(0)) + (size_t)r0 * DM, (float*)(ws + WS_XS0) + r0, nr, true);
    } else quant_rows_s(a.in[0], (signed char*)(ws + slot(0)), (float*)(ws + WS_XS0), MTOK, false);
    const int gtid = blockIdx.x * 512 + threadIdx.x, gthreads = gridDim.x * 512;
    float* COS = (float*)(ws + WS_COS); float* SIN = (float*)(ws + WS_SIN); float* LB = (float*)(ws + WS_LB);
    for (int i = gtid; i < SEQ * 64; i += gthreads) {
        const int pos = i >> 6, j = i & 63;
        double inv = 1.0; const double r = 0.86596432336006535;
        for (int q = 0; q < j; ++q) inv *= r;
        const float ang = (float)pos * (float)inv;
        const double x = (double)ang;
        const double n = __builtin_rint(x * 0.15915494309189535);
        const float rf = (float)__builtin_fma(-n, 6.283185307179586, x);
        COS[i] = cosf(rf); SIN[i] = sinf(rf);
    }
    for (int c = gtid; c < DM; c += gthreads) { const float l0 = a.in[4][c], l1 = a.in[4][DM + c]; LB[c] = 1.0f / (1.0f + expf(l1 - l0)); }
}

__device__ __forceinline__ void phase_scan_naive(const bf16_t* Q1, const float* LF, const bf16_t* I1, float* O) {
    const int lane = threadIdx.x & 63, gw = blockIdx.x * 8 + (threadIdx.x >> 6), nw = gridDim.x * 8;
    for (int item = gw; item < 2 * NHEAD * 128; item += nw) {
        const int bh = item >> 7, v = item & 127, b = bh >> 4, h = bh & 15;
        const size_t base = (size_t)b * SEQ * DM + h * 128;
        float S0 = 0.f, S1 = 0.f;
#pragma unroll 4
        for (int t = 0; t < SEQ; ++t) {
            const size_t ro = base + (size_t)t * DM;
            const float f0 = __expf(LF[ro + lane]), f1 = __expf(LF[ro + 64 + lane]);
            const float q0 = bf2f(Q1[ro + lane]), q1 = bf2f(Q1[ro + 64 + lane]);
            const float iv = bf2f(I1[ro + v]);
            S0 = f0 * S0 + (1.0f - f0) * iv; S1 = f1 * S1 + (1.0f - f1) * iv;
            const float p = wave_sum(q0 * S0 + q1 * S1);
            if (lane == 0) O[ro + v] = p;
        }
    }
}
__device__ __forceinline__ void phase_onorm(const float* O, const bf16_t* G1, const float* gnorm, bf16_t* OG) {
    const int lane = threadIdx.x & 63, gw = blockIdx.x * 8 + (threadIdx.x >> 6), nw = gridDim.x * 8;
    const float gn0 = gnorm[2 * lane], gn1 = gnorm[2 * lane + 1];
    for (int item = gw; item < MTOK * NHEAD; item += nw) {
        const size_t off = (size_t)item * 128 + 2 * lane;
        const float o0 = O[off], o1 = O[off + 1];
        const float ss = wave_sum(o0 * o0 + o1 * o1);
        const float r = rsqrtf(ss * (1.0f / 128.0f) + 1e-6f);
        const unsigned g = *(const unsigned*)(G1 + off);
        *(unsigned*)(OG + off) = pk_bf16(o0 * r * gn0 * bflo(g), o1 * r * gn1 * bfhi(g));
    }
}

__device__ __forceinline__ void ln_row_store(float (&v)[32], const float* g, const float* bta, float* outf, bf16_t* outb, int lane, signed char* outq = nullptr, float* outs = nullptr) {
    float s = 0.f;
#pragma unroll
    for (int i = 0; i < 32; ++i) s += v[i];
    const float mu = wave_sum(s) * (1.0f / DM);
    float q = 0.f;
#pragma unroll
    for (int i = 0; i < 32; ++i) { v[i] -= mu; q += v[i] * v[i]; }
    const float rstd = rsqrtf(wave_sum(q) * (1.0f / DM) + 1e-5f);
    float am = 0.f;
#pragma unroll
    for (int i = 0; i < 4; ++i) {
        const int c = 512 * i + 8 * lane;
        const f32x4 g0 = *(const f32x4*)(g + c), g1 = *(const f32x4*)(g + c + 4), b0 = *(const f32x4*)(bta + c), b1 = *(const f32x4*)(bta + c + 4);
        f32x4 o0, o1;
#pragma unroll
        for (int j = 0; j < 4; ++j) { o0[j] = v[i * 8 + j] * rstd * g0[j] + b0[j]; o1[j] = v[i * 8 + 4 + j] * rstd * g1[j] + b1[j]; v[i * 8 + j] = o0[j]; v[i * 8 + 4 + j] = o1[j]; am = fmaxf(am, fmaxf(fabsf(o0[j]), fabsf(o1[j]))); }
        if (outf) { *(f32x4*)(outf + c) = o0; *(f32x4*)(outf + c + 4) = o1; }
        if (outb) { u32x4 w; w.x = pk_bf16(o0[0], o0[1]); w.y = pk_bf16(o0[2], o0[3]); w.z = pk_bf16(o1[0], o1[1]); w.w = pk_bf16(o1[2], o1[3]); *(u32x4*)(outb + c) = w; }
    }
    if (outq) {
        am = fmaxf(wave_max(am), 1e-30f);
        const float inv = 127.0f / am;
        if (lane == 0) *outs = am * (1.0f / 127.0f);
#pragma unroll
        for (int i = 0; i < 4; ++i) {
            u32x2 w;
            w.x = ((unsigned)(int)rintf(v[i * 8 + 0] * inv) & 0xffu) | (((unsigned)(int)rintf(v[i * 8 + 1] * inv) & 0xffu) << 8) | (((unsigned)(int)rintf(v[i * 8 + 2] * inv) & 0xffu) << 16) | (((unsigned)(int)rintf(v[i * 8 + 3] * inv) & 0xffu) << 24);
            w.y = ((unsigned)(int)rintf(v[i * 8 + 4] * inv) & 0xffu) | (((unsigned)(int)rintf(v[i * 8 + 5] * inv) & 0xffu) << 8) | (((unsigned)(int)rintf(v[i * 8 + 6] * inv) & 0xffu) << 16) | (((unsigned)(int)rintf(v[i * 8 + 7] * inv) & 0xffu) << 24);
            *(u32x2*)(outq + 512 * i + 8 * lane) = w;
        }
    }
}
__device__ __forceinline__ void ln_row_store16(float (&v)[32], const float* g, const float* bta, float* outf, bf16_t* outb, int lane) {
    float s = 0.f;
#pragma unroll
    for (int i = 0; i < 32; ++i) s += v[i];
    const float mu = wave_sum(s) * (1.0f / DM);
    float q = 0.f;
#pragma unroll
    for (int i = 0; i < 32; ++i) { v[i] -= mu; q += v[i] * v[i]; }
    const float rstd = rsqrtf(wave_sum(q) * (1.0f / DM) + 1e-5f);
#pragma unroll
    for (int i = 0; i < 2; ++i) {
        const int c = 1024 * i + 16 * lane;
        f32x4 o[4];
#pragma unroll
        for (int qd = 0; qd < 4; ++qd) {
            const f32x4 gg = *(const f32x4*)(g + c + 4 * qd), bb = *(const f32x4*)(bta + c + 4 * qd);
#pragma unroll
            for (int j = 0; j < 4; ++j) o[qd][j] = v[16 * i + 4 * qd + j] * rstd * gg[j] + bb[j];
            *(f32x4*)(outf + c + 4 * qd) = o[qd];
        }
        if (outb) {
            u32x4 w0, w1;
            w0.x = pk_bf16(o[0][0], o[0][1]); w0.y = pk_bf16(o[0][2], o[0][3]); w0.z = pk_bf16(o[1][0], o[1][1]); w0.w = pk_bf16(o[1][2], o[1][3]);
            w1.x = pk_bf16(o[2][0], o[2][1]); w1.y = pk_bf16(o[2][2], o[2][3]); w1.z = pk_bf16(o[3][0], o[3][1]); w1.w = pk_bf16(o[3][2], o[3][3]);
            *(u32x4*)(outb + c) = w0; *(u32x4*)(outb + c + 8) = w1;
        }
    }
}
template <int RES> __device__ __forceinline__ void phase_ln(const bf16_t* Y, const void* RESv, const float* RSC, const float* g, const float* bta, float* outf, bf16_t* outb, signed char* outq = nullptr, float* outs = nullptr) {
    const int lane = threadIdx.x & 63, gw = blockIdx.x * 8 + (threadIdx.x >> 6), nw = gridDim.x * 8;
    for (int row = gw; row < MTOK; row += nw) {
        float v[32];
        const bf16_t* p = Y + (size_t)row * DM;
#pragma unroll
        for (int i = 0; i < 4; ++i) {
            const u32x4 yw = *(const u32x4*)(p + 512 * i + 8 * lane);
            const f32x4 a = {bflo(yw.x), bfhi(yw.x), bflo(yw.y), bfhi(yw.y)}, b = {bflo(yw.z), bfhi(yw.z), bflo(yw.w), bfhi(yw.w)};
            f32x4 ra, rb;
            if (RES == 1) { const u32x4 w = *(const u32x4*)((const bf16_t*)RESv + (size_t)row * DM + 512 * i + 8 * lane); ra = (f32x4){bflo(w.x), bfhi(w.x), bflo(w.y), bfhi(w.y)}; rb = (f32x4){bflo(w.z), bfhi(w.z), bflo(w.w), bfhi(w.w)}; }
            else if (RES == 2) { const u32x2 w = *(const u32x2*)((const signed char*)RESv + (size_t)row * DM + 512 * i + 8 * lane); const float sc = RSC[row];
                ra = (f32x4){sc * (float)(signed char)(w.x & 0xffu), sc * (float)(signed char)((w.x >> 8) & 0xffu), sc * (float)(signed char)((w.x >> 16) & 0xffu), sc * (float)(signed char)(w.x >> 24)};
                rb = (f32x4){sc * (float)(signed char)(w.y & 0xffu), sc * (float)(signed char)((w.y >> 8) & 0xffu), sc * (float)(signed char)((w.y >> 16) & 0xffu), sc * (float)(signed char)(w.y >> 24)}; }
            else { const float* rp = (const float*)RESv + (size_t)row * DM; ra = *(const f32x4*)(rp + 512 * i + 8 * lane); rb = *(const f32x4*)(rp + 512 * i + 8 * lane + 4); }
#pragma unroll
            for (int j = 0; j < 4; ++j) { v[i * 8 + j] = a[j] + ALPHA * ra[j]; v[i * 8 + 4 + j] = b[j] + ALPHA * rb[j]; }
        }
        ln_row_store(v, g, bta, outf ? outf + (size_t)row * DM : nullptr, outb ? outb + (size_t)row * DM : nullptr, lane, outq ? outq + (size_t)row * DM : nullptr, outs ? outs + row : nullptr);
    }
}

__device__ __forceinline__ void wave_argmax(float& v, int& idx) {
#pragma unroll
    for (int o = 32; o >= 1; o >>= 1) {
        const float ov = __shfl_xor(v, o); const int oi = __shfl_xor(idx, o);
        if (ov > v || (ov == v && oi < idx)) { v = ov; idx = oi; }
    }
}
__device__ __forceinline__ unsigned fkey(float x) { const unsigned u = __float_as_uint(x); return u ^ (unsigned)(((int)u >> 31) | 0x80000000); }
__device__ __forceinline__ float funkey(unsigned k) { const unsigned u = (k & 0x80000000u) ? (k ^ 0x80000000u) : ~k; return __uint_as_float(u); }
__device__ __forceinline__ void sort16_insert(unsigned (&r)[16], unsigned v) {
#pragma unroll
    for (int i = 0; i < 16; ++i) { const unsigned m = r[i] > v ? r[i] : v; v = r[i] > v ? v : r[i]; r[i] = m; }
}
__device__ __forceinline__ void sort16_desc(unsigned (&x)[16]) {
#define CE(i_, j_) { const unsigned mx_ = x[i_] > x[j_] ? x[i_] : x[j_], mn_ = x[i_] > x[j_] ? x[j_] : x[i_]; x[i_] = mx_; x[j_] = mn_; }
    CE(0,1) CE(2,3) CE(0,2) CE(1,3) CE(1,2) CE(4,5) CE(6,7) CE(4,6) CE(5,7) CE(5,6) CE(0,4) CE(2,6) CE(2,4) CE(1,5) CE(3,7) CE(3,5) CE(1,2) CE(3,4) CE(5,6) CE(8,9) CE(10,11) CE(8,10) CE(9,11) CE(9,10) CE(12,13) CE(14,15) CE(12,14) CE(13,15) CE(13,14) CE(8,12) CE(10,14) CE(10,12) CE(9,13) CE(11,15) CE(11,13) CE(9,10) CE(11,12) CE(13,14) CE(0,8) CE(4,12) CE(4,8) CE(2,10) CE(6,14) CE(6,10) CE(2,4) CE(6,8) CE(10,12) CE(1,9) CE(5,13) CE(5,9) CE(3,11) CE(7,15) CE(7,11) CE(3,5) CE(7,9) CE(11,13) CE(1,2) CE(3,4) CE(5,6) CE(7,8) CE(9,10) CE(11,12) CE(13,14)
#undef CE
}
__device__ __forceinline__ void merge16_desc(unsigned (&r)[16], const unsigned (&s)[16]) {
#pragma unroll
    for (int i = 0; i < 16; ++i) r[i] = r[i] > s[15 - i] ? r[i] : s[15 - i];
#pragma unroll
    for (int st = 8; st >= 1; st >>= 1)
#pragma unroll
        for (int i = 0; i < 16; ++i)
            if ((i & st) == 0) { const unsigned mx_ = r[i] > r[i + st] ? r[i] : r[i + st], mn_ = r[i] > r[i + st] ? r[i + st] : r[i]; r[i] = mx_; r[i + st] = mn_; }
}
__device__ __forceinline__ void phase_topk(LAS unsigned char* lds, const bf16_t* SCT, int* EID, float* GATE, unsigned short* EID16) {
    LAS unsigned char* ib = lds + threadIdx.x * 32;
    for (int item = blockIdx.x * 512 + threadIdx.x; item < MTOK * 8; item += gridDim.x * 512) {
        const int h = item >> 14, tok = item & (MTOK - 1);
        const bf16_t* p = SCT + (size_t)(h * 256) * MTOK + tok;
        unsigned r1[16], r2[16];
#pragma unroll
        for (int i = 0; i < 16; ++i) { r1[i] = (fkey(bf2f(p[(size_t)i * MTOK])) & ~0x7Fu) | (unsigned)i; r2[i] = (fkey(bf2f(p[(size_t)(128 + i) * MTOK])) & ~0x7Fu) | (unsigned)i; }
        sort16_desc(r1); sort16_desc(r2);
#pragma unroll 1
        for (int g = 1; g < 8; ++g) {
            unsigned s1[16], s2[16];
#pragma unroll
            for (int i = 0; i < 16; ++i) { const int e = g * 16 + i; s1[i] = (fkey(bf2f(p[(size_t)e * MTOK])) & ~0x7Fu) | (unsigned)e; s2[i] = (fkey(bf2f(p[(size_t)(128 + e) * MTOK])) & ~0x7Fu) | (unsigned)e; }
            sort16_desc(s1); sort16_desc(s2);
            merge16_desc(r1, s1); merge16_desc(r2, s2);
        }
        float v1[16], v2[16];
#pragma unroll
        for (int i = 0; i < 16; ++i) { v1[i] = funkey(r1[i] & ~0x7Fu); v2[i] = funkey(r2[i] & ~0x7Fu); ib[i] = (unsigned char)(r1[i] & 0x7Fu); ib[16 + i] = (unsigned char)(r2[i] & 0x7Fu); }
#define CK(a_, b_) ((fkey(v1[a_] + v2[b_]) & ~0xFFu) | (unsigned)((a_) * 16 + (b_)))
        unsigned r3[16] = {CK(0, 0), CK(0, 1), CK(0, 2), CK(0, 3), CK(0, 4), CK(0, 5), CK(0, 6), CK(0, 7), CK(0, 8), CK(0, 9), CK(0, 10), CK(0, 11), CK(0, 12), CK(0, 13), CK(0, 14), CK(0, 15)};
        sort16_desc(r3);
        { unsigned sB[16] = {CK(1, 0), CK(1, 1), CK(1, 2), CK(1, 3), CK(1, 4), CK(1, 5), CK(1, 6), CK(1, 7), CK(2, 0), CK(2, 1), CK(2, 2), CK(2, 3), CK(2, 4), CK(3, 0), CK(3, 1), CK(3, 2)}; sort16_desc(sB); merge16_desc(r3, sB); }
        { unsigned sC[16] = {CK(3, 3), CK(4, 0), CK(4, 1), CK(4, 2), CK(5, 0), CK(5, 1), CK(6, 0), CK(6, 1), CK(7, 0), CK(7, 1), CK(8, 0), CK(9, 0), CK(10, 0), CK(11, 0), CK(12, 0), CK(13, 0)}; sort16_desc(sC); merge16_desc(r3, sC); }
        sort16_insert(r3, CK(14, 0)); sort16_insert(r3, CK(15, 0));
#undef CK
        const float mx = funkey(r3[0] & ~0xFFu);
        float ev[16]; float sum = 0.f;
#pragma unroll
        for (int i = 0; i < 16; ++i) { ev[i] = __expf(funkey(r3[i] & ~0xFFu) - mx); sum += ev[i]; }
        const float rs = 1.0f / sum;
        int eid[16];
#pragma unroll
        for (int i = 0; i < 16; ++i) { const unsigned f = r3[i] & 0xFFu; eid[i] = (int)ib[f >> 4] * 128 + (int)ib[16 + (f & 15u)]; }
        { unsigned short* e16 = EID16 + (size_t)tok * 128 + h * 16;
          u32x4 p0, p1;
          p0.x = (unsigned)eid[0] | ((unsigned)eid[1] << 16); p0.y = (unsigned)eid[2] | ((unsigned)eid[3] << 16); p0.z = (unsigned)eid[4] | ((unsigned)eid[5] << 16); p0.w = (unsigned)eid[6] | ((unsigned)eid[7] << 16);
          p1.x = (unsigned)eid[8] | ((unsigned)eid[9] << 16); p1.y = (unsigned)eid[10] | ((unsigned)eid[11] << 16); p1.z = (unsigned)eid[12] | ((unsigned)eid[13] << 16); p1.w = (unsigned)eid[14] | ((unsigned)eid[15] << 16);
          *(u32x4*)e16 = p0; *(u32x4*)(e16 + 8) = p1; }
        int* eo = EID + (size_t)tok * 128 + h * 16; float* go = GATE + (size_t)tok * 128 + h * 16;
#pragma unroll
        for (int q = 0; q < 4; ++q) {
            *(u32x4*)(eo + 4 * q) = (u32x4){(unsigned)eid[4 * q], (unsigned)eid[4 * q + 1], (unsigned)eid[4 * q + 2], (unsigned)eid[4 * q + 3]};
            *(f32x4*)(go + 4 * q) = (f32x4){ev[4 * q] * rs, ev[4 * q + 1] * rs, ev[4 * q + 2] * rs, ev[4 * q + 3] * rs};
        }
    }
}

__device__ __forceinline__ float gelu_erf(float x) { return 0.5f * x * (1.0f + erff(x * 0.70710678118654752f)); }
__device__ __forceinline__ float ub0(unsigned w) { return (float)(w & 0xffu); }
__device__ __forceinline__ float ub1(unsigned w) { return (float)((w >> 8) & 0xffu); }
__device__ __forceinline__ float ub2(unsigned w) { return (float)((w >> 16) & 0xffu); }
__device__ __forceinline__ float ub3(unsigned w) { return (float)(w >> 24); }
__device__ __forceinline__ void phase_peer(LAS unsigned char* lds, const float* X, const int* EID, const float* GATE, const unsigned char* U, const unsigned char* V, const float* USC, const float* VSC,
                                           const float* g, const float* bta, float* outf, bf16_t* outb) {
    const int lane = threadIdx.x & 63, wv = threadIdx.x >> 6, gw = blockIdx.x * 8 + wv, nw = gridDim.x * 8;
    LAS float* hb = (LAS float*)(lds + wv * 512);
    for (int tok = gw; tok < MTOK; tok += nw) {
        float x[32];
        const float* xp = X + (size_t)tok * DM;
#pragma unroll
        for (int i = 0; i < 2; ++i)
#pragma unroll
            for (int q = 0; q < 4; ++q) { const f32x4 t = *(const f32x4*)(xp + 1024 * i + 16 * lane + 4 * q); x[16 * i + 4 * q] = t[0]; x[16 * i + 4 * q + 1] = t[1]; x[16 * i + 4 * q + 2] = t[2]; x[16 * i + 4 * q + 3] = t[3]; }
        float sx = 0.f;
#pragma unroll
        for (int j = 0; j < 32; ++j) sx += x[j];
        const float d0 = -128.0f * sx;
        const int e0 = EID[(size_t)tok * 128 + lane], e1 = EID[(size_t)tok * 128 + 64 + lane];
        const float g0 = GATE[(size_t)tok * 128 + lane], g1 = GATE[(size_t)tok * 128 + 64 + lane];
        for (int bt = 0; bt < 16; ++bt) {
            float d[8];
#pragma unroll
            for (int r = 0; r < 8; ++r) {
                const int e = bt * 8 + r;
                const int idx = __builtin_amdgcn_readfirstlane(__shfl(bt < 8 ? e0 : e1, e & 63));
                const u32x4* up = (const u32x4*)(U + (size_t)idx * DM) + lane;
                float acc = d0;
#pragma unroll
                for (int i = 0; i < 2; ++i) {
                    const u32x4 w = up[i * 64];
                    acc += x[16 * i + 0] * ub0(w.x) + x[16 * i + 1] * ub1(w.x) + x[16 * i + 2] * ub2(w.x) + x[16 * i + 3] * ub3(w.x)
                         + x[16 * i + 4] * ub0(w.y) + x[16 * i + 5] * ub1(w.y) + x[16 * i + 6] * ub2(w.y) + x[16 * i + 7] * ub3(w.y)
                         + x[16 * i + 8] * ub0(w.z) + x[16 * i + 9] * ub1(w.z) + x[16 * i + 10] * ub2(w.z) + x[16 * i + 11] * ub3(w.z)
                         + x[16 * i + 12] * ub0(w.w) + x[16 * i + 13] * ub1(w.w) + x[16 * i + 14] * ub2(w.w) + x[16 * i + 15] * ub3(w.w);
                }
                d[r] = acc;
            }
            const bool b5 = lane & 32, b4 = lane & 16, b3 = lane & 8;
            float t4[4];
#pragma unroll
            for (int q = 0; q < 4; ++q) { const float keep = b5 ? d[4 + q] : d[q], send = b5 ? d[q] : d[4 + q]; t4[q] = keep + __shfl_xor(send, 32); }
            float t2[2];
#pragma unroll
            for (int q = 0; q < 2; ++q) { const float keep = b4 ? t4[2 + q] : t4[q], send = b4 ? t4[q] : t4[2 + q]; t2[q] = keep + __shfl_xor(send, 16); }
            float t1;
            { const float keep = b3 ? t2[1] : t2[0], send = b3 ? t2[0] : t2[1]; t1 = keep + __shfl_xor(send, 8); }
            t1 += __shfl_xor(t1, 4); t1 += __shfl_xor(t1, 2); t1 += __shfl_xor(t1, 1);
            if ((lane & 7) == 0) hb[bt * 8 + (lane >> 3 & 1) + 2 * (lane >> 4 & 1) + 4 * (lane >> 5 & 1)] = t1;
        }
        asm volatile("s_waitcnt lgkmcnt(0)" ::: "memory");
        const float h0 = hb[lane] * USC[e0], h1 = hb[64 + lane] * USC[e1];
        const float w0 = g0 * gelu_erf(h0) * VSC[e0], w1 = g1 * gelu_erf(h1) * VSC[e1];
        float wsum = wave_sum(w0 + w1);
        float y[32];
#pragma unroll
        for (int i = 0; i < 32; ++i) y[i] = 0.f;
#pragma unroll 8
        for (int e = 0; e < 128; ++e) {
            const int idx = __builtin_amdgcn_readfirstlane(__shfl(e < 64 ? e0 : e1, e & 63));
            const float wt = __shfl(e < 64 ? w0 : w1, e & 63);
            const u32x4* vp = (const u32x4*)(V + (size_t)idx * DM) + lane;
#pragma unroll
            for (int i = 0; i < 2; ++i) {
                const u32x4 w = vp[i * 64];
                y[16 * i + 0] += wt * ub0(w.x); y[16 * i + 1] += wt * ub1(w.x); y[16 * i + 2] += wt * ub2(w.x); y[16 * i + 3] += wt * ub3(w.x);
                y[16 * i + 4] += wt * ub0(w.y); y[16 * i + 5] += wt * ub1(w.y); y[16 * i + 6] += wt * ub2(w.y); y[16 * i + 7] += wt * ub3(w.y);
                y[16 * i + 8] += wt * ub0(w.z); y[16 * i + 9] += wt * ub1(w.z); y[16 * i + 10] += wt * ub2(w.z); y[16 * i + 11] += wt * ub3(w.z);
                y[16 * i + 12] += wt * ub0(w.w); y[16 * i + 13] += wt * ub1(w.w); y[16 * i + 14] += wt * ub2(w.w); y[16 * i + 15] += wt * ub3(w.w);
            }
        }
        const float corr = -128.0f * wsum;
#pragma unroll
        for (int i = 0; i < 32; ++i) y[i] = y[i] + corr + ALPHA * x[i];
        ln_row_store16(y, g, bta, outf + (size_t)tok * DM, outb ? outb + (size_t)tok * DM : nullptr, lane);
        asm volatile("s_waitcnt lgkmcnt(0)" ::: "memory");
    }
}

__device__ __forceinline__ int row_dot_i8(const u32x4 (&xq)[2], const unsigned char* rowp, int lane) {
    const u32x4* up = (const u32x4*)rowp + lane;
    int acc = 0;
#pragma unroll
    for (int i = 0; i < 2; ++i) {
        const u32x4 w = up[i * 64];
        acc = __builtin_amdgcn_sdot4((int)xq[i].x, (int)(w.x ^ 0x80808080u), acc, false); acc = __builtin_amdgcn_sdot4((int)xq[i].y, (int)(w.y ^ 0x80808080u), acc, false);
        acc = __builtin_amdgcn_sdot4((int)xq[i].z, (int)(w.z ^ 0x80808080u), acc, false); acc = __builtin_amdgcn_sdot4((int)xq[i].w, (int)(w.w ^ 0x80808080u), acc, false);
    }
    return acc;
}
__device__ __forceinline__ void peer_issue8(u32x4 (&seg)[8], const unsigned char* base, const u32x4 ia, const u32x4 ib) {
    seg[0] = *(const u32x4*)(base + (size_t)ia.x * DM); seg[1] = *(const u32x4*)(base + (size_t)ia.y * DM); seg[2] = *(const u32x4*)(base + (size_t)ia.z * DM); seg[3] = *(const u32x4*)(base + (size_t)ia.w * DM);
    seg[4] = *(const u32x4*)(base + (size_t)ib.x * DM); seg[5] = *(const u32x4*)(base + (size_t)ib.y * DM); seg[6] = *(const u32x4*)(base + (size_t)ib.z * DM); seg[7] = *(const u32x4*)(base + (size_t)ib.w * DM);
}
template <int K> __device__ __forceinline__ unsigned bc8(unsigned v) { return (unsigned)__builtin_amdgcn_ds_swizzle((int)v, (K << 5) | 0x18); }
__device__ __forceinline__ u32x4 ids_lo(unsigned e) { u32x4 p; p.x = bc8<0>(e); p.y = bc8<1>(e); p.z = bc8<2>(e); p.w = bc8<3>(e); return p; }
__device__ __forceinline__ u32x4 ids_hi(unsigned e) { u32x4 p; p.x = bc8<4>(e); p.y = bc8<5>(e); p.z = bc8<6>(e); p.w = bc8<7>(e); return p; }
__device__ __forceinline__ void peer_issue8p(u32x4 (&seg)[8], const unsigned char* base, const u32x4 p) {
    seg[0] = *(const u32x4*)(base + (size_t)(p.x & 0xffffu) * DM); seg[1] = *(const u32x4*)(base + (size_t)(p.x >> 16) * DM); seg[2] = *(const u32x4*)(base + (size_t)(p.y & 0xffffu) * DM); seg[3] = *(const u32x4*)(base + (size_t)(p.y >> 16) * DM);
    seg[4] = *(const u32x4*)(base + (size_t)(p.z & 0xffffu) * DM); seg[5] = *(const u32x4*)(base + (size_t)(p.z >> 16) * DM); seg[6] = *(const u32x4*)(base + (size_t)(p.w & 0xffffu) * DM); seg[7] = *(const u32x4*)(base + (size_t)(p.w >> 16) * DM);
}
__device__ __forceinline__ void peer_dot8(int (&d)[8], const u32x4 (&seg)[8], const u32x4 xq) {
#pragma unroll
    for (int i = 0; i < 8; ++i) {
        int acc = __builtin_amdgcn_sdot4((int)xq.x, (int)seg[i].x, 0, false);
        acc = __builtin_amdgcn_sdot4((int)xq.y, (int)seg[i].y, acc, false);
        acc = __builtin_amdgcn_sdot4((int)xq.z, (int)seg[i].z, acc, false);
        d[i] = __builtin_amdgcn_sdot4((int)xq.w, (int)seg[i].w, acc, false);
    }
}
__device__ __forceinline__ void phase_peer_u(const signed char* XQ, const unsigned short* EID, const unsigned char* U, LAS int* HL  ) {
    const int lane = threadIdx.x & 63, wv = threadIdx.x >> 6, es = lane >> 3, cc = lane & 7;
    const bool b2 = cc & 4, b1 = cc & 2, b0 = cc & 1;
    const int nw = gridDim.x * 8, gw = blockIdx.x * 8 + wv, tpw = (MTOK + nw - 1) / nw, tbase = gw * tpw;
    int cnt = MTOK - tbase; cnt = cnt > tpw ? tpw : cnt;
    if (cnt <= 0) return;
    for (int i = lane; i < cnt * 128; i += 64) HL[i] = 0;
    asm volatile("s_waitcnt lgkmcnt(0)" ::: "memory");
    const int nit = 16 * cnt;
    const unsigned char* ub = U + cc * 16;
    unsigned m0e, m1e, m2e; u32x4 m0x, m1x, m2x; u32x4 sA[8], sB[8];
#define PU_LOAD(sl_, k_, E_, X_) { E_ = *(const unsigned*)(EID + (size_t)(tbase + (k_)) * 128 + es * 16 + cc * 2); \
        X_ = *(const u32x4*)(XQ + (size_t)(tbase + (k_)) * DM + (sl_) * 128 + cc * 16); }
#define PU_NEXT(sl_, k_, sn_, kn_) { kn_ = (k_) + 1; sn_ = (sl_); if (kn_ == cnt) { kn_ = 0; ++sn_; } if (sn_ == 16) { sn_ = 15; kn_ = cnt - 1; } }
    int sl = 0, k = 0, sl1, k1, sl2, k2;
    PU_NEXT(sl, k, sl1, k1) PU_NEXT(sl1, k1, sl2, k2)
    PU_LOAD(sl, k, m0e, m0x)
    PU_LOAD(sl1, k1, m1e, m1x)
    peer_issue8p(sA, ub + sl * 128, ids_lo(m0e));
    for (int it = 0; it < nit; ++it) {
        PU_LOAD(sl2, k2, m2e, m2x)
        peer_issue8p(sB, ub + sl * 128, ids_hi(m0e));
        int dlo[8]; peer_dot8(dlo, sA, m0x);
        peer_issue8p(sA, ub + sl1 * 128, ids_lo(m1e));
        int dhi[8]; peer_dot8(dhi, sB, m0x);
        int t8[8], t4[4], t2[2];
#pragma unroll
        for (int q = 0; q < 8; ++q) { const int keep = b2 ? dhi[q] : dlo[q], send = b2 ? dlo[q] : dhi[q]; t8[q] = keep + __shfl_xor(send, 4); }
#pragma unroll
        for (int q = 0; q < 4; ++q) { const int keep = b1 ? t8[4 + q] : t8[q], send = b1 ? t8[q] : t8[4 + q]; t4[q] = keep + __shfl_xor(send, 2); }
#pragma unroll
        for (int q = 0; q < 2; ++q) { const int keep = b0 ? t4[2 + q] : t4[q], send = b0 ? t4[q] : t4[2 + q]; t2[q] = keep + __shfl_xor(send, 1); }
        { LAS int* hp = HL + k * 128 + es * 16 + (b2 ? 8 : 0) + (b1 ? 4 : 0) + (b0 ? 2 : 0);
          __hip_atomic_fetch_add(hp, t2[0], __ATOMIC_RELAXED, __HIP_MEMORY_SCOPE_WORKGROUP); __hip_atomic_fetch_add(hp + 1, t2[1], __ATOMIC_RELAXED, __HIP_MEMORY_SCOPE_WORKGROUP); }
        sl = sl1; k = k1; sl1 = sl2; k1 = k2; PU_NEXT(sl1, k1, sl2, k2)
        m0e = m1e; m0x = m1x; m1e = m2e; m1x = m2x;
    }
#undef PU_LOAD
#undef PU_NEXT
}
__device__ __forceinline__ void phase_peer_w(const LAS int* HL, const float* XS, const int* EID, const float* GATE, const float* USC, const float* VSC, signed char* WQ, float* SW) {
    const int lane = threadIdx.x & 63, gw = blockIdx.x * 8 + (threadIdx.x >> 6), nw = gridDim.x * 8, tpw = (MTOK + nw - 1) / nw, tbase = gw * tpw;
    const int tend = tbase + tpw < MTOK ? tbase + tpw : MTOK;
    for (int t0 = tbase; t0 < tend; t0 += 8) {
        int e0[8], e1[8]; float g0[8], g1[8], xs[8], us0[8], us1[8], vs0[8], vs1[8];
#pragma unroll
        for (int q = 0; q < 8; ++q) { const int tok = t0 + q < tend ? t0 + q : tend - 1;
            e0[q] = EID[(size_t)tok * 128 + lane]; e1[q] = EID[(size_t)tok * 128 + 64 + lane]; g0[q] = GATE[(size_t)tok * 128 + lane]; g1[q] = GATE[(size_t)tok * 128 + 64 + lane]; xs[q] = XS[tok]; }
#pragma unroll
        for (int q = 0; q < 8; ++q) { us0[q] = USC[e0[q]]; us1[q] = USC[e1[q]]; vs0[q] = VSC[e0[q]]; vs1[q] = VSC[e1[q]]; }
#pragma unroll
        for (int q = 0; q < 8; ++q) {
            const int tok = t0 + q;
            if (tok < tend) {
                const int h0 = HL[(tok - tbase) * 128 + lane], h1 = HL[(tok - tbase) * 128 + 64 + lane];
                const float w0 = g0[q] * gelu_erf((float)h0 * xs[q] * us0[q]) * vs0[q];
                const float w1 = g1[q] * gelu_erf((float)h1 * xs[q] * us1[q]) * vs1[q];
                const float am = fmaxf(wave_max(fmaxf(fabsf(w0), fabsf(w1))), 1e-30f), inv = 127.0f / am;
                WQ[(size_t)tok * 128 + lane] = (signed char)(int)rintf(w0 * inv); WQ[(size_t)tok * 128 + 64 + lane] = (signed char)(int)rintf(w1 * inv);
                if (lane == 0) SW[tok] = am * (1.0f / 127.0f);
            }
        }
    }
}
__device__ __forceinline__ void peer_dot4x4(int (&acc)[16], const u32x4 sa, const u32x4 sb, const u32x4 sc, const u32x4 sd, const unsigned w4) {
#pragma unroll
    for (int k = 0; k < 4; ++k) {
        const unsigned A = sa[k], B = sb[k], C = sc[k], D = sd[k];
        const unsigned p0 = __builtin_amdgcn_perm(B, A, 0x05010400u);
        const unsigned p1 = __builtin_amdgcn_perm(B, A, 0x07030602u);
        const unsigned p2 = __builtin_amdgcn_perm(D, C, 0x05010400u);
        const unsigned p3 = __builtin_amdgcn_perm(D, C, 0x07030602u);
        const unsigned t0 = __builtin_amdgcn_perm(p2, p0, 0x05040100u);
        const unsigned t1 = __builtin_amdgcn_perm(p2, p0, 0x07060302u);
        const unsigned t2 = __builtin_amdgcn_perm(p3, p1, 0x05040100u);
        const unsigned t3 = __builtin_amdgcn_perm(p3, p1, 0x07060302u);
        acc[4 * k + 0] = __builtin_amdgcn_sdot4((int)t0, (int)w4, acc[4 * k + 0], false);
        acc[4 * k + 1] = __builtin_amdgcn_sdot4((int)t1, (int)w4, acc[4 * k + 1], false);
        acc[4 * k + 2] = __builtin_amdgcn_sdot4((int)t2, (int)w4, acc[4 * k + 2], false);
        acc[4 * k + 3] = __builtin_amdgcn_sdot4((int)t3, (int)w4, acc[4 * k + 3], false);
    }
}
__device__ __forceinline__ void phase_peer_v(const signed char* XQ, const float* XS, const unsigned short* EID, const signed char* WQ, const float* SW, const unsigned char* V, bf16_t* Y) {
    const int lane = threadIdx.x & 63, wv = threadIdx.x >> 6, es = lane >> 3, cc = lane & 7;
    const bool b5 = lane & 32, b4 = lane & 16, b3 = lane & 8;
    const int nw = gridDim.x * 8, gw = blockIdx.x * 8 + wv, tpw = (MTOK + nw - 1) / nw, tbase = gw * tpw;
    int cnt = MTOK - tbase; cnt = cnt > tpw ? tpw : cnt;
    if (cnt <= 0) return;
    const int nit = 16 * cnt;
    const unsigned char* vb = V + cc * 16;
    const int colo = cc * 16 + (b5 ? 8 : 0) + (b4 ? 4 : 0) + (b3 ? 2 : 0);
    unsigned m0e, m1e, m2e; u32x4 w0, w1; unsigned x0, x1; float c0, c1; u32x4 sA[8], sB[8];
#define PV_IDS(k_, E_) { E_ = *(const unsigned*)(EID + (size_t)(tbase + (k_)) * 128 + es * 16 + cc * 2); }
#define PV_WX(sl_, k_, W_, X_, CS_) { W_ = *(const u32x4*)(WQ + (size_t)(tbase + (k_)) * 128 + es * 16); \
        X_ = (unsigned)*(const unsigned short*)(XQ + (size_t)(tbase + (k_)) * DM + (sl_) * 128 + colo); CS_ = SW[tbase + (k_)]; }
#define PV_NEXT(sl_, k_, sn_, kn_) { kn_ = (k_) + 1; sn_ = (sl_); if (kn_ == cnt) { kn_ = 0; ++sn_; } if (sn_ == 16) { sn_ = 15; kn_ = cnt - 1; } }
    int sl = 0, k = 0, sl1, k1, sl2, k2;
    PV_NEXT(sl, k, sl1, k1) PV_NEXT(sl1, k1, sl2, k2)
    { PV_IDS(k, m0e) PV_IDS(k1, m1e)
      PV_WX(sl, k, w0, x0, c0)
      peer_issue8p(sA, vb + sl * 128, ids_lo(m0e)); }
    for (int it = 0; it < nit; ++it) {
        PV_IDS(k2, m2e)
        peer_issue8p(sB, vb + sl * 128, ids_hi(m0e));
        int ya[16];
#pragma unroll
        for (int j = 0; j < 16; ++j) ya[j] = 0;
        peer_dot4x4(ya, sA[0], sA[1], sA[2], sA[3], w0.x); peer_dot4x4(ya, sA[4], sA[5], sA[6], sA[7], w0.y);
        peer_issue8p(sA, vb + sl1 * 128, ids_lo(m1e));
        PV_WX(sl1, k1, w1, x1, c1)
        peer_dot4x4(ya, sB[0], sB[1], sB[2], sB[3], w0.z); peer_dot4x4(ya, sB[4], sB[5], sB[6], sB[7], w0.w);
        int t8[8], t4[4], t2[2];
#pragma unroll
        for (int q = 0; q < 8; ++q) { const int keep = b5 ? ya[8 + q] : ya[q], send = b5 ? ya[q] : ya[8 + q]; t8[q] = keep + __shfl_xor(send, 32); }
#pragma unroll
        for (int q = 0; q < 4; ++q) { const int keep = b4 ? t8[4 + q] : t8[q], send = b4 ? t8[q] : t8[4 + q]; t4[q] = keep + __shfl_xor(send, 16); }
#pragma unroll
        for (int q = 0; q < 2; ++q) { const int keep = b3 ? t4[2 + q] : t4[q], send = b3 ? t4[q] : t4[2 + q]; t2[q] = keep + __shfl_xor(send, 8); }
        { const float xs = ALPHA * XS[tbase + k];
          *(unsigned*)(Y + (size_t)(tbase + k) * DM + sl * 128 + colo) = pk_bf16((float)t2[0] * c0 + xs * (float)(signed char)(x0 & 0xffu), (float)t2[1] * c0 + xs * (float)(signed char)(x0 >> 8)); }
        sl = sl1; k = k1; sl1 = sl2; k1 = k2; PV_NEXT(sl1, k1, sl2, k2)
        m0e = m1e; m1e = m2e;
        w0 = w1; x0 = x1; c0 = c1;
    }
#undef PV_IDS
#undef PV_WX
#undef PV_NEXT
}

__device__ __forceinline__ void rot8(const u32x4 lo, const u32x4 hi, const f32x4 c0, const f32x4 c1, const f32x4 s0, const f32x4 s1, float (&o1)[8], float (&o2)[8]) {
    const float a[8] = {bflo(lo.x), bfhi(lo.x), bflo(lo.y), bfhi(lo.y), bflo(lo.z), bfhi(lo.z), bflo(lo.w), bfhi(lo.w)};
    const float b[8] = {bflo(hi.x), bfhi(hi.x), bflo(hi.y), bfhi(hi.y), bflo(hi.z), bfhi(hi.z), bflo(hi.w), bfhi(hi.w)};
    const float c[8] = {c0[0], c0[1], c0[2], c0[3], c1[0], c1[1], c1[2], c1[3]}, sn[8] = {s0[0], s0[1], s0[2], s0[3], s1[0], s1[1], s1[2], s1[3]};
#pragma unroll
    for (int j = 0; j < 8; ++j) { o1[j] = a[j] * c[j] - b[j] * sn[j]; o2[j] = a[j] * sn[j] + b[j] * c[j]; }
}
__device__ __forceinline__ u32x4 pack8(const float (&o)[8]) { u32x4 w; w.x = pk_bf16(o[0], o[1]); w.y = pk_bf16(o[2], o[3]); w.z = pk_bf16(o[4], o[5]); w.w = pk_bf16(o[6], o[7]); return w; }
__device__ __forceinline__ void phase_kstat(LAS float* red, const bf16_t* KR, float* KMEAN, float* KNMAX) {
    const int tid = threadIdx.x, ch = tid & 7, rr = tid >> 3, wv = tid >> 6, lane = tid & 63;
    for (int item = blockIdx.x; item < 2 * NHEAD * 32; item += gridDim.x) {
        const int bh = item >> 5, j = item & 31, b = bh >> 4, h = bh & 15;
        float sm1[8], sm2[8]; float nmax = 0.f;
#pragma unroll
        for (int q = 0; q < 8; ++q) { sm1[q] = 0.f; sm2[q] = 0.f; }
        u32x4 lo[4], hi[4];
#pragma unroll
        for (int ps = 0; ps < 4; ++ps) { const size_t off = ((size_t)b * SEQ + j * 256 + ps * 64 + rr) * DM + h * 128 + ch * 8; lo[ps] = *(const u32x4*)(KR + off); hi[ps] = *(const u32x4*)(KR + off + 64); }
#pragma unroll
        for (int ps = 0; ps < 4; ++ps) {
            const float a[8] = {bflo(lo[ps].x), bfhi(lo[ps].x), bflo(lo[ps].y), bfhi(lo[ps].y), bflo(lo[ps].z), bfhi(lo[ps].z), bflo(lo[ps].w), bfhi(lo[ps].w)};
            const float c[8] = {bflo(hi[ps].x), bfhi(hi[ps].x), bflo(hi[ps].y), bfhi(hi[ps].y), bflo(hi[ps].z), bfhi(hi[ps].z), bflo(hi[ps].w), bfhi(hi[ps].w)};
            float nq = 0.f;
#pragma unroll
            for (int q = 0; q < 8; ++q) { sm1[q] += a[q]; sm2[q] += c[q]; nq += a[q] * a[q] + c[q] * c[q]; }
            nq += __shfl_xor(nq, 1); nq += __shfl_xor(nq, 2); nq += __shfl_xor(nq, 4);
            nmax = fmaxf(nmax, nq);
        }
#pragma unroll
        for (int q = 0; q < 8; ++q) {
            sm1[q] += __shfl_xor(sm1[q], 8); sm1[q] += __shfl_xor(sm1[q], 16); sm1[q] += __shfl_xor(sm1[q], 32);
            sm2[q] += __shfl_xor(sm2[q], 8); sm2[q] += __shfl_xor(sm2[q], 16); sm2[q] += __shfl_xor(sm2[q], 32);
        }
        nmax = wave_max(nmax);
        if (lane < 8) {
#pragma unroll
            for (int q = 0; q < 8; ++q) { red[wv * 128 + lane * 8 + q] = sm1[q]; red[wv * 128 + 64 + lane * 8 + q] = sm2[q]; }
        }
        if (lane == 0) red[1024 + wv] = nmax;
        __syncthreads();
        if (tid < 128) {
            float s2 = 0.f;
#pragma unroll
            for (int r = 0; r < 8; ++r) s2 += red[r * 128 + tid];
            KMEAN[(size_t)item * 128 + tid] = s2 * (1.0f / 256.0f);
        }
        if (tid == 0) {
            float m = 0.f;
#pragma unroll
            for (int r = 0; r < 8; ++r) m = fmaxf(m, red[1024 + r]);
            KNMAX[item] = sqrtf(m);
        }
        __syncthreads();
    }
}

__device__ __forceinline__ void top3_insert(float x, int m, float& v0, int& i0, float& v1, int& i1, float& v2, int& i2) {
    const bool c0 = x > v0 || (x == v0 && m < i0), c1 = x > v1 || (x == v1 && m < i1), c2 = x > v2 || (x == v2 && m < i2);
    v2 = c1 ? v1 : (c2 ? x : v2); i2 = c1 ? i1 : (c2 ? m : i2);
    v1 = c0 ? v0 : (c1 ? x : v1); i1 = c0 ? i0 : (c1 ? m : i1);
    v0 = c0 ? x : v0; i0 = c0 ? m : i0;
}
__device__ __forceinline__ void phase_sel(LAS unsigned char* lds, const bf16_t* QR, const float* KMEAN, unsigned short* SUB, int* CNT, int* ctr) {
    const int tid = threadIdx.x, lane = tid & 63, wv = tid >> 6, r32 = lane & 31, hh = lane >> 5;
    LAS unsigned short* bucket = (LAS unsigned short*)lds;
    LAS int* cnt = (LAS int*)(lds + 16384);
    const float NEG = -1e30f;
    if (blockIdx.x == 0 && tid == 0) *ctr = 0;
    bf16x8 nqf[8];
#define SEL_QLOAD(item_) { const int bh_ = (item_) >> 5, i_ = (item_) & 31; const size_t tok_ = (size_t)(bh_ >> 4) * SEQ + i_ * 256 + wv * 32 + r32; const bf16_t* qp_ = QR + tok_ * DM + (bh_ & 15) * 128 + 8 * hh; \
        _Pragma("unroll") for (int s2 = 0; s2 < 8; ++s2) nqf[s2] = *(const bf16x8*)(qp_ + 16 * s2); }
    if ((int)blockIdx.x < 2 * NHEAD * 32) SEL_QLOAD((int)blockIdx.x)
    for (int item = blockIdx.x; item < 2 * NHEAD * 32; item += gridDim.x) {
        const int bh = item >> 5, i = item & 31, b = bh >> 4, h = bh & 15;
        bf16x8 cqf[8];
#pragma unroll
        for (int s2 = 0; s2 < 8; ++s2) cqf[s2] = nqf[s2];
        if (item + (int)gridDim.x < 2 * NHEAD * 32) SEL_QLOAD(item + (int)gridDim.x)
        if (i == 0) continue;
        if (tid < 32) cnt[tid] = 0;
        __syncthreads();
        const float* kmp = KMEAN + ((size_t)bh * 32 + r32) * 128 + 8 * hh;
        f32x16 S;
#pragma unroll
        for (int e = 0; e < 16; ++e) S[e] = 0.f;
#pragma unroll
        for (int s2 = 0; s2 < 8; ++s2) {
            const f32x4 ka = *(const f32x4*)(kmp + 16 * s2), kb = *(const f32x4*)(kmp + 16 * s2 + 4);
            const bf16x8 qf = cqf[s2];
            u32x4 hi, lo;
            hi.x = pk_bf16(ka[0], ka[1]); hi.y = pk_bf16(ka[2], ka[3]); hi.z = pk_bf16(kb[0], kb[1]); hi.w = pk_bf16(kb[2], kb[3]);
            lo.x = pk_bf16(ka[0] - bflo(hi.x), ka[1] - bfhi(hi.x)); lo.y = pk_bf16(ka[2] - bflo(hi.y), ka[3] - bfhi(hi.y));
            lo.z = pk_bf16(kb[0] - bflo(hi.z), kb[1] - bfhi(hi.z)); lo.w = pk_bf16(kb[2] - bflo(hi.w), kb[3] - bfhi(hi.w));
            S = __builtin_amdgcn_mfma_f32_32x32x16_bf16(__builtin_bit_cast(bf16x8, hi), qf, S, 0, 0, 0);
            S = __builtin_amdgcn_mfma_f32_32x32x16_bf16(__builtin_bit_cast(bf16x8, lo), qf, S, 0, 0, 0);
        }
        float v0 = -3e38f, v1 = -3e38f, v2 = -3e38f; int i0 = 99, i1 = 99, i2 = 99;
#pragma unroll
        for (int e = 0; e < 16; ++e) {
            const int m = (e & 3) + 8 * (e >> 2) + 4 * hh;
            const float x = m < i ? S[e] : NEG;
            top3_insert(x, m, v0, i0, v1, i1, v2, i2);
        }
        {
            const float pv0 = __shfl_xor(v0, 32), pv1 = __shfl_xor(v1, 32), pv2 = __shfl_xor(v2, 32);
            const int pi0 = __shfl_xor(i0, 32), pi1 = __shfl_xor(i1, 32), pi2 = __shfl_xor(i2, 32);
            top3_insert(pv0, pi0, v0, i0, v1, i1, v2, i2); top3_insert(pv1, pi1, v0, i0, v1, i1, v2, i2); top3_insert(pv2, pi2, v0, i0, v1, i1, v2, i2);
        }
        if (hh == 0) {
            const int tl = wv * 32 + r32;
            if (v0 > 0.5f * NEG) { const int p = __hip_atomic_fetch_add(cnt + i0, 1, __ATOMIC_RELAXED, __HIP_MEMORY_SCOPE_WORKGROUP); bucket[i0 * 256 + p] = (unsigned short)(tl | (0 << 8)); }
            if (v1 > 0.5f * NEG) { const int p = __hip_atomic_fetch_add(cnt + i1, 1, __ATOMIC_RELAXED, __HIP_MEMORY_SCOPE_WORKGROUP); bucket[i1 * 256 + p] = (unsigned short)(tl | (1 << 8)); }
            if (v2 > 0.5f * NEG) { const int p = __hip_atomic_fetch_add(cnt + i2, 1, __ATOMIC_RELAXED, __HIP_MEMORY_SCOPE_WORKGROUP); bucket[i2 * 256 + p] = (unsigned short)(tl | (2 << 8)); }
        }
        __syncthreads();
        for (int idx = tid; idx < 32 * 256; idx += 512) {
            const int j = idx >> 8, p = idx & 255;
            if (j < i && p < cnt[j]) SUB[(((size_t)bh * 32 + j) * 32 + i) * 256 + p] = bucket[idx];
        }
        if (tid < i) CNT[((size_t)bh * 32 + tid) * 32 + i] = cnt[tid];
        __syncthreads();
    }
}

__device__ __forceinline__ unsigned off_b(unsigned row, unsigned ch) { return 256u * row + 16u * (ch ^ (((row & 3u) << 2) | ((row >> 2) & 3u))); }
__device__ __forceinline__ unsigned pi32(unsigned m) { return (m & ~12u) | ((m & 4u) << 1) | ((m & 8u) >> 1); }
__device__ __forceinline__ bf16x8 tr_frag(LAS unsigned char* img, unsigned lane, unsigned c, unsigned ks) {
    const unsigned hh = lane >> 5, blk = (lane >> 4) & 1, q = (lane & 15) >> 2, p = lane & 3;
    const unsigned a0 = off_b(16 * ks + 8 * hh + q, 4 * c + 2 * blk + (p >> 1)) + 8 * (p & 1);
    const unsigned a1 = off_b(16 * ks + 8 * hh + 4 + q, 4 * c + 2 * blk + (p >> 1)) + 8 * (p & 1);
    const s16x4 lo = __builtin_amdgcn_ds_read_tr16_b64_v4i16((LAS s16x4*)(img + a0));
    const s16x4 hi = __builtin_amdgcn_ds_read_tr16_b64_v4i16((LAS s16x4*)(img + a1));
    bf16x8 r; r[0] = lo[0]; r[1] = lo[1]; r[2] = lo[2]; r[3] = lo[3]; r[4] = hi[0]; r[5] = hi[1]; r[6] = hi[2]; r[7] = hi[3];
    return r;
}
__device__ __forceinline__ void phase_att(LAS unsigned char* lds, const bf16_t* QR, const bf16_t* KR, const bf16_t* V, const float* KNMAX, const unsigned short* SUB, const int* CNT, int* ctr,
                                          bf16_t* P012, bf16_t* P3, float* LS) {
    const int tid = threadIdx.x, lane = tid & 63, wv = tid >> 6, r32 = lane & 31, hh = lane >> 5;
    LAS unsigned char* Kimg = lds;
    LAS unsigned char* Vimg = lds + 65536;
    LAS int* misc = (LAS int*)(lds + 131072);
    const float SCL2 = 0.08838834764831845f * 1.4426950408889634f;
    for (;;) {
        __syncthreads();
        if (tid == 0) misc[40] = __hip_atomic_fetch_add(ctr, 1, __ATOMIC_RELAXED, __HIP_MEMORY_SCOPE_AGENT);
        __syncthreads();
        const int item = misc[40];
        if (item >= 2 * NHEAD * 32) break;
        const int j = item >> 5, bh = item & 31, b = bh >> 4, h = bh & 15;
#pragma unroll
        for (int r = 0; r < 8; ++r) {
            const int idx = tid + 512 * r, row = idx >> 4, ch = idx & 15;
            const size_t g = ((size_t)b * SEQ + j * 256 + row) * DM + h * 128 + ch * 8;
            const u32x4 kv = *(const u32x4*)(KR + g), vv = *(const u32x4*)(V + g);
            *(LAS u32x4*)(Kimg + off_b(row, ch)) = kv; *(LAS u32x4*)(Vimg + off_b(row, ch)) = vv;
        }
        if (tid < 64) {
            const int c = (lane > j && lane < 32) ? CNT[((size_t)bh * 32 + j) * 32 + lane] : 0;
            int inc = c;
#pragma unroll
            for (int o = 1; o < 32; o <<= 1) { const int t = __shfl_up(inc, o); if ((lane & 31) >= o) inc += t; }
            if (lane < 32) misc[lane] = inc - c;
            if (lane == 31) misc[32] = inc;
        }
        float kn = (lane < 32) ? KNMAX[bh * 32 + lane] : 0.f;
        kn = wave_max(kn);
        __syncthreads();
        const int total = misc[32], ntile = (256 + total + 31) >> 5;
        for (int tile = wv; tile < ntile; tile += 8) {
            const int gr = tile * 32 + r32;
            int pos, slot; bool valid = true;
            if (gr < 256) { pos = j * 256 + gr; slot = 3; }
            else {
                const int x = gr - 256; valid = x < total;
                int ii = j + 1;
                for (int u = j + 1; u < 32; ++u) if (misc[u] <= x) ii = u;
                if (valid) { const unsigned e = SUB[(((size_t)bh * 32 + j) * 32 + ii) * 256 + (x - misc[ii])]; pos = ii * 256 + (int)(e & 255u); slot = (int)(e >> 8); }
                else { pos = j * 256; slot = 3; }
            }
            const size_t tok = (size_t)b * SEQ + pos;
            bf16x8 qf[8];
            const bf16_t* qp = QR + tok * DM + h * 128 + 8 * hh;
#pragma unroll
            for (int s = 0; s < 8; ++s) qf[s] = *(const bf16x8*)(qp + 16 * s);
            float qn2 = 0.f;
#pragma unroll
            for (int s = 0; s < 8; ++s)
#pragma unroll
                for (int e = 0; e < 8; ++e) { const float f = bf2f((bf16_t)qf[s][e]); qn2 += f * f; }
            qn2 += __shfl_xor(qn2, 32);
            const float c2 = sqrtf(qn2) * kn * SCL2;
            f32x16 O[4];
#pragma unroll
            for (int dt = 0; dt < 4; ++dt)
#pragma unroll
                for (int e = 0; e < 16; ++e) O[dt][e] = 0.f;
            float l = 0.f;
            const bool own = tile < 8;
            const int kcn = own ? tile + 1 : 8;
            const unsigned krow = pi32((unsigned)r32);
            for (int kc = 0; kc < kcn; ++kc) {
                f32x16 S, S1;
#pragma unroll
                for (int e = 0; e < 16; ++e) { S[e] = 0.f; S1[e] = 0.f; }
#pragma unroll
                for (int s = 0; s < 8; s += 2) {
                    const bf16x8 kf = *(const LAS bf16x8*)(Kimg + off_b(32 * kc + krow, 2 * s + hh));
                    const bf16x8 kf1 = *(const LAS bf16x8*)(Kimg + off_b(32 * kc + krow, 2 * s + 2 + hh));
                    S = __builtin_amdgcn_mfma_f32_32x32x16_bf16(kf, qf[s], S, 0, 0, 0);
                    S1 = __builtin_amdgcn_mfma_f32_32x32x16_bf16(kf1, qf[s + 1], S1, 0, 0, 0);
                }
                float p[16];
                if (own) {
#pragma unroll
                    for (int e = 0; e < 16; ++e) {
                        const unsigned m = (e & 3) + 8 * (e >> 2) + 4 * hh;
                        const int key = j * 256 + 32 * kc + (int)pi32(m);
                        float pe = __builtin_amdgcn_exp2f((S[e] + S1[e]) * SCL2 - c2);
                        if (key > pos) pe = 0.f;
                        p[e] = pe; l += pe;
                    }
                } else {
#pragma unroll
                    for (int e = 0; e < 16; ++e) { const float pe = __builtin_amdgcn_exp2f((S[e] + S1[e]) * SCL2 - c2); p[e] = pe; l += pe; }
                }
                u32x4 w0, w1;
                w0.x = pk_bf16(p[0], p[1]); w0.y = pk_bf16(p[2], p[3]); w0.z = pk_bf16(p[4], p[5]); w0.w = pk_bf16(p[6], p[7]);
                w1.x = pk_bf16(p[8], p[9]); w1.y = pk_bf16(p[10], p[11]); w1.z = pk_bf16(p[12], p[13]); w1.w = pk_bf16(p[14], p[15]);
                const bf16x8 pf0 = __builtin_bit_cast(bf16x8, w0), pf1 = __builtin_bit_cast(bf16x8, w1);
#pragma unroll
                for (int dt = 0; dt < 4; ++dt) {
                    const bf16x8 v0 = tr_frag(Vimg, lane, dt, 2 * kc), v1 = tr_frag(Vimg, lane, dt, 2 * kc + 1);
                    O[dt] = __builtin_amdgcn_mfma_f32_32x32x16_bf16(v0, pf0, O[dt], 0, 0, 0);
                    O[dt] = __builtin_amdgcn_mfma_f32_32x32x16_bf16(v1, pf1, O[dt], 0, 0, 0);
                }
            }
            l += __shfl_xor(l, 32);
            if (valid) {
                bf16_t* pl = (slot < 3 ? P012 + (size_t)slot * ((size_t)32 << 20) : P3) + (tok * NHEAD + h) * 128 + 4 * hh;
#pragma unroll
                for (int dt = 0; dt < 4; ++dt)
#pragma unroll
                    for (int g = 0; g < 4; ++g) {
                        u32x2 w; w.x = pk_bf16(O[dt][4 * g], O[dt][4 * g + 1]); w.y = pk_bf16(O[dt][4 * g + 2], O[dt][4 * g + 3]);
                        *(u32x2*)(pl + 32 * dt + 8 * g) = w;
                    }
                if (hh == 0) LS[(size_t)slot * MTOK * NHEAD + tok * NHEAD + h] = l;
            }
        }
    }
}
__device__ __forceinline__ void phase_comb(LAS float* red, const bf16_t* P012, const bf16_t* P3, const float* LS, signed char* AO8, float* XSO) {
    const int tid = threadIdx.x, tsel = tid >> 8, hd = (tid & 255) >> 4, ch = tid & 15, wv = tid >> 6;
    u32x4 nw[4]; float nl[4];
#define CB_LOAD(pair_) { const size_t th_ = ((size_t)(2 * (pair_) + tsel)) * NHEAD + hd; nw[3] = *(const u32x4*)(P3 + th_ * 128 + ch * 8); nl[3] = LS[(size_t)3 * MTOK * NHEAD + th_]; \
        _Pragma("unroll") for (int s_ = 0; s_ < 3; ++s_) { nw[s_] = *(const u32x4*)(P012 + (size_t)s_ * ((size_t)32 << 20) + th_ * 128 + ch * 8); nl[s_] = LS[(size_t)s_ * MTOK * NHEAD + th_]; } }
    if ((int)blockIdx.x < MTOK / 2) CB_LOAD((int)blockIdx.x)
    int par = 0;
    for (int pair = blockIdx.x; pair < MTOK / 2; pair += gridDim.x, par ^= 1) {
        const int token = 2 * pair + tsel;
        const int t = token & (SEQ - 1), blk = t >> 8, nsel = blk < 3 ? blk : 3;
        float acc[8];
        float l = nl[3];
        { const u32x4 w = nw[3];
          acc[0] = bflo(w.x); acc[1] = bfhi(w.x); acc[2] = bflo(w.y); acc[3] = bfhi(w.y); acc[4] = bflo(w.z); acc[5] = bfhi(w.z); acc[6] = bflo(w.w); acc[7] = bfhi(w.w); }
#pragma unroll
        for (int s = 0; s < 3; ++s) {
            u32x4 w = nw[s]; float ls = nl[s];
            if (s >= nsel) { w = (u32x4){0u, 0u, 0u, 0u}; ls = 0.f; }
            acc[0] += bflo(w.x); acc[1] += bfhi(w.x); acc[2] += bflo(w.y); acc[3] += bfhi(w.y); acc[4] += bflo(w.z); acc[5] += bfhi(w.z); acc[6] += bflo(w.w); acc[7] += bfhi(w.w);
            l += ls;
        }
        if (pair + (int)gridDim.x < MTOK / 2) CB_LOAD(pair + (int)gridDim.x)
        const float rl = 1.0f / l;
        float am = 0.f;
#pragma unroll
        for (int j = 0; j < 8; ++j) { acc[j] *= rl; am = fmaxf(am, fabsf(acc[j])); }
        am = wave_max(am);
        if ((tid & 63) == 0) red[par * 8 + wv] = am;
        __syncthreads();
        am = fmaxf(fmaxf(fmaxf(red[par * 8 + 4 * tsel], red[par * 8 + 4 * tsel + 1]), fmaxf(red[par * 8 + 4 * tsel + 2], red[par * 8 + 4 * tsel + 3])), 1e-30f);
        const float inv = 127.0f / am;
        if ((tid & 255) == 0) XSO[token] = am * (1.0f / 127.0f);
        u32x2 o;
        o.x = ((unsigned)(int)rintf(acc[0] * inv) & 0xffu) | (((unsigned)(int)rintf(acc[1] * inv) & 0xffu) << 8) | (((unsigned)(int)rintf(acc[2] * inv) & 0xffu) << 16) | (((unsigned)(int)rintf(acc[3] * inv) & 0xffu) << 24);
        o.y = ((unsigned)(int)rintf(acc[4] * inv) & 0xffu) | (((unsigned)(int)rintf(acc[5] * inv) & 0xffu) << 8) | (((unsigned)(int)rintf(acc[6] * inv) & 0xffu) << 16) | (((unsigned)(int)rintf(acc[7] * inv) & 0xffu) << 24);
        *(u32x2*)(AO8 + (size_t)token * DM + hd * 128 + ch * 8) = o;
    }
#undef CB_LOAD
}


__device__ __forceinline__ void qrow_issue(f32x4 (&v)[8], const float* p, int lane) {
#pragma unroll
    for (int i = 0; i < 2; ++i)
#pragma unroll
        for (int q = 0; q < 4; ++q) v[i * 4 + q] = *(const f32x4*)(p + 1024 * i + 16 * lane + 4 * q);
}
__device__ __forceinline__ void qrow_finish(const f32x4 (&v)[8], unsigned char* dst, float* scl, int lane, bool sgn = false) {
    float am = 0.f;
#pragma unroll
    for (int i = 0; i < 8; ++i) am = fmaxf(am, fmaxf(fmaxf(fabsf(v[i][0]), fabsf(v[i][1])), fmaxf(fabsf(v[i][2]), fabsf(v[i][3]))));
    am = fmaxf(wave_max(am), 1e-30f);
    const float inv = 127.0f / am;
    if (lane == 0) *scl = am * (1.0f / 127.0f);
#pragma unroll
    for (int i = 0; i < 2; ++i) {
        u32x4 w;
#pragma unroll
        for (int q = 0; q < 4; ++q) {
            const f32x4 t = v[i * 4 + q];
            const float off = sgn ? 0.0f : 128.0f;
            const unsigned b0 = (unsigned)(int)(rintf(t[0] * inv) + off) & 0xffu, b1 = (unsigned)(int)(rintf(t[1] * inv) + off) & 0xffu, b2 = (unsigned)(int)(rintf(t[2] * inv) + off) & 0xffu, b3 = (unsigned)(int)(rintf(t[3] * inv) + off) & 0xffu;
            w[q] = b0 | (b1 << 8) | (b2 << 16) | (b3 << 24);
        }
        *(u32x4*)(dst + 1024 * i + 16 * lane) = w;
    }
}
struct QuantJob { const float* TU; const float* TV; unsigned char* QU; unsigned char* QV; float* SU; float* SV; };
__device__ __forceinline__ const float* qj_src(const QuantJob& q, int r) { return (r < 16384 ? q.TU : q.TV) + (size_t)(r & 16383) * DM; }
__device__ __forceinline__ unsigned char* qj_dst(const QuantJob& q, int r) { return (r < 16384 ? q.QU : q.QV) + (size_t)(r & 16383) * DM; }
__device__ __forceinline__ float* qj_scl(const QuantJob& q, int r) { return (r < 16384 ? q.SU : q.SV) + (r & 16383); }
__device__ __forceinline__ void qj_tail(const QuantJob& q, int done_iters) {
    const int lane = threadIdx.x & 63, gw = blockIdx.x * 8 + (threadIdx.x >> 6), nw = gridDim.x * 8;
    for (int r = gw + done_iters * nw; r < 32768; r += nw) { f32x4 v[8]; qrow_issue(v, qj_src(q, r), lane); qrow_finish(v, qj_dst(q, r), qj_scl(q, r), lane, true); }
}
__device__ __forceinline__ float logf_gate(float z, float lb) { return __logf(lb + (1.0f - lb) * sigmoidf_(z)); }
__device__ __forceinline__ void phase_scan_a(LAS unsigned char* lds, const bf16_t* FZ, const float* LB, const bf16_t* I1, bf16_t* LT, float* DEC, const QuantJob qj, unsigned* dbgc = nullptr) {
    unsigned dbg_kt = 0, dbg_acc = 0;
    const int tid = threadIdx.x, lane = tid & 63, wv = tid >> 6, k = tid & 127, part = tid >> 7;
    LAS unsigned char* Iimg = lds; LAS unsigned char* KTimg = lds + 16384;
    LAS float* psum = (LAS float*)(lds + 32768);
    LAS unsigned char* Lst = lds + 36864;
#if SCAN_A_VALU == 2
    for (int item = blockIdx.x; item < 2 * NHEAD * 128; item += gridDim.x) {
        const int bh = item >> 7, c = item & 127, b = bh >> 4, h = bh & 15;
        const size_t tok0 = (size_t)b * SEQ + c * 64;
        for (int idx = tid; idx < 16384; idx += 512) {
            const int v = idx >> 7, kk = idx & 127;
            float g = 1.f, L = 0.f;
            for (int s2 = 63; s2 >= 0; --s2) { const size_t o = (tok0 + s2) * DM + h * 128; const float f = __expf(logf_gate(bf2f(FZ[o + kk]), LB[h * 128 + kk])); L += bf2f(I1[o + v]) * (1.0f - f) * g; g *= f; }
            LT[(size_t)item * 16384 + idx] = (bf16_t)(pk_bf16(L, 0.f) & 0xffffu);
        }
    }
    return;
#endif
    bf16_t nfz[16]; u32x4 nit_[2];
#define SA_LOAD(item_) { const int bh_ = (item_) >> 7, c_ = (item_) & 127; const size_t t0_ = (size_t)(bh_ >> 4) * SEQ + c_ * 64; const int h_ = bh_ & 15; \
        _Pragma("unroll") for (int i = 0; i < 16; ++i) nfz[i] = FZ[(t0_ + 16 * part + i) * DM + h_ * 128 + k]; \
        _Pragma("unroll") for (int r = 0; r < 2; ++r) { const int idx = tid + 512 * r, row = idx >> 4, ch = idx & 15; nit_[r] = *(const u32x4*)(I1 + (t0_ + row) * DM + h_ * 128 + ch * 8); } }
    if ((int)blockIdx.x < 2 * NHEAD * 128) SA_LOAD((int)blockIdx.x)
    int qiter = 0;
    for (int item = blockIdx.x; item < 2 * NHEAD * 128; item += gridDim.x, ++qiter) {
        const int bh = item >> 7, c = item & 127, b = bh >> 4, h = bh & 15;
        const size_t tok0 = (size_t)b * SEQ + c * 64;
        float lf[16];
        const float lbk = LB[h * 128 + k];
        unsigned fz2[8];
#pragma unroll
        for (int i = 0; i < 8; ++i) fz2[i] = (unsigned)nfz[2 * i] | ((unsigned)nfz[2 * i + 1] << 16);
#pragma unroll
        for (int r = 0; r < 2; ++r) { const int idx = tid + 512 * r, row = idx >> 4, ch = idx & 15; *(LAS u32x4*)(Iimg + off_b(row, ch)) = nit_[r]; }
        asm volatile("" ::: "memory");
        if (item + (int)gridDim.x < 2 * NHEAD * 128) SA_LOAD(item + (int)gridDim.x)
        const int qrow = qiter * (int)gridDim.x * 8 + (int)blockIdx.x * 8 + wv; const bool doq = qrow < 32768; f32x4 qv8[8];
        if (doq) qrow_issue(qv8, qj_src(qj, qrow), lane);
        asm volatile("" ::: "memory");
#pragma unroll
        for (int i = 0; i < 8; ++i) { lf[2 * i] = lbk + (1.0f - lbk) * sigmoidf_(bflo(fz2[i])); lf[2 * i + 1] = lbk + (1.0f - lbk) * sigmoidf_(bfhi(fz2[i])); }
        float fprod = 1.0f, fprod2 = 1.0f;
#pragma unroll
        for (int i = 0; i < 8; ++i) { fprod *= lf[i]; fprod2 *= lf[8 + i]; }
        psum[part * 128 + k] = __logf(fprod) + __logf(fprod2);
        __syncthreads();
        const float p0 = psum[k], p1 = psum[128 + k], p2 = psum[256 + k], p3 = psum[384 + k];
        const float blast = (p0 + p1) + (p2 + p3);
        float S = __expf(part == 3 ? 0.f : (part == 2 ? p3 : (part == 1 ? p2 + p3 : p1 + p2 + p3)));
#pragma unroll
        for (int i = 15; i >= 0; --i) {
            const float kt = (1.0f - lf[i]) * S;
            S *= lf[i];
            if (!(kt - kt == 0.f)) ++dbg_kt;
            const int srow = 16 * part + i;
            *(LAS bf16_t*)(KTimg + off_b(srow, k >> 3) + 2 * (k & 7)) = (bf16_t)(pk_bf16(kt, 0.f) & 0xffffu);
        }
        if (part == 0) DEC[(size_t)item * 128 + k] = __expf(blast);
        __syncthreads();
#if SCAN_A_VALU
        for (int idx = tid; idx < 16384; idx += 512) {
            const int v = idx >> 7, kk = idx & 127;
            float accv = 0.f;
            for (int s2 = 0; s2 < 64; ++s2) accv += bf2f(*(const LAS bf16_t*)(Iimg + off_b(s2, v >> 3) + 2 * (v & 7))) * bf2f(*(const LAS bf16_t*)(KTimg + off_b(s2, kk >> 3) + 2 * (kk & 7)));
            *(LAS bf16_t*)(Lst + v * 272 + 2 * kk) = (bf16_t)(pk_bf16(accv, 0.f) & 0xffffu);
        }
        if (0)
#endif
        {
            const int vt = wv >> 1;
            f32x16 acc0, acc1;
#pragma unroll
            for (int e = 0; e < 16; ++e) { acc0[e] = 0.f; acc1[e] = 0.f; }
#pragma unroll
            for (int ks = 0; ks < 4; ++ks) {
                const bf16x8 af = tr_frag(Iimg, lane, vt, ks);
                const bf16x8 b0 = tr_frag(KTimg, lane, 2 * (wv & 1), ks), b1 = tr_frag(KTimg, lane, 2 * (wv & 1) + 1, ks);
                acc0 = __builtin_amdgcn_mfma_f32_32x32x16_bf16(af, b0, acc0, 0, 0, 0);
                acc1 = __builtin_amdgcn_mfma_f32_32x32x16_bf16(af, b1, acc1, 0, 0, 0);
            }
            const int r32 = lane & 31, hh = lane >> 5;
#pragma unroll
            for (int e = 0; e < 16; ++e) {
                if (!(acc0[e] - acc0[e] == 0.f)) ++dbg_acc; if (!(acc1[e] - acc1[e] == 0.f)) ++dbg_acc;
                const int v = 32 * vt + (e & 3) + 8 * (e >> 2) + 4 * hh;
                *(LAS bf16_t*)(Lst + v * 272 + 2 * (64 * (wv & 1) + r32)) = (bf16_t)(pk_bf16(acc0[e], 0.f) & 0xffffu);
                *(LAS bf16_t*)(Lst + v * 272 + 2 * (64 * (wv & 1) + 32 + r32)) = (bf16_t)(pk_bf16(acc1[e], 0.f) & 0xffffu);
            }
        }
        __syncthreads();
#pragma unroll
        for (int r = 0; r < 4; ++r) { const int idx = tid + 512 * r, row = idx >> 4, ch = idx & 15; *(u32x4*)(LT + (size_t)item * 16384 + row * 128 + ch * 8) = *(const LAS u32x4*)(Lst + row * 272 + ch * 16); }
        if (doq) qrow_finish(qv8, qj_dst(qj, qrow), qj_scl(qj, qrow), lane, true);
        __syncthreads();
    }
    qj_tail(qj, qiter);
    if (dbgc) { if (dbg_kt) atomicAdd(dbgc + 0, dbg_kt); if (dbg_acc) atomicAdd(dbgc + 1, dbg_acc); }
}
__device__ __forceinline__ void phase_scan_b(bf16_t* LT, const float* DEC, const QuantJob qj) {
    const int n = 2 * NHEAD * 128 * 32;
    const int lane = threadIdx.x & 63, gw = blockIdx.x * 8 + (threadIdx.x >> 6), nw = gridDim.x * 8;
    int qdone = 0;
    for (int idx = blockIdx.x * 512 + threadIdx.x; idx < n; idx += gridDim.x * 512) {
        const int bh = idx >> 12, vk = idx & 4095, k4 = (vk & 31) * 4;
        float S0 = 0.f, S1 = 0.f, S2 = 0.f, S3 = 0.f;
        bf16_t* p = LT + (size_t)bh * 128 * 16384 + (size_t)vk * 4;
        const float* dp = DEC + (size_t)bh * 128 * 128 + k4;
        for (int c8 = 0; c8 < 16; ++c8) {
            const int qrow = (qdone + c8) * nw + gw; const bool doq = qrow < 32768; f32x4 qv8[8];
            if (doq) qrow_issue(qv8, qj_src(qj, qrow), lane);
#pragma unroll
            for (int c2 = 0; c2 < 8; ++c2) {
                const int c = c8 * 8 + c2;
                const u32x2 w = *(const u32x2*)(p + (size_t)c * 16384);
                const f32x4 d = *(const f32x4*)(dp + c * 128);
                u32x2 o; o.x = pk_bf16(S0, S1); o.y = pk_bf16(S2, S3);
                *(u32x2*)(p + (size_t)c * 16384) = o;
                S0 = d[0] * S0 + bflo(w.x); S1 = d[1] * S1 + bfhi(w.x); S2 = d[2] * S2 + bflo(w.y); S3 = d[3] * S3 + bfhi(w.y);
            }
            if (doq) qrow_finish(qv8, qj_dst(qj, qrow), qj_scl(qj, qrow), lane, true);
        }
        qdone += 16;
    }
    qj_tail(qj, qdone);
}
__device__ __forceinline__ void phase_scan_c(LAS unsigned char* lds, const bf16_t* Q1, const bf16_t* FZ, const float* LB, const bf16_t* I1, const bf16_t* G1, const bf16_t* SP, const float* gnorm, bf16_t* OG, signed char* OG8, float* XSO) {
    const int tid = threadIdx.x, lane = tid & 63, wv = tid >> 6, k = tid & 127, part = tid >> 7, r32 = lane & 31, hh = lane >> 5;
    LAS unsigned char* QTimg = lds; LAS unsigned char* QPimg = lds + 16384; LAS unsigned char* KPimg = lds + 32768; LAS unsigned char* Iimg = lds + 49152; LAS unsigned char* SPimg = lds + 65536;
    LAS float* psum = (LAS float*)(lds + 98304);
    LAS float* ssq = (LAS float*)(lds + 100352);
    LAS unsigned char* OT = lds + 102400;
    bf16_t nfz[16], nq[16]; u32x4 nit_[2], nsp[4], ngt[2];
#define SC_LOAD(item_) { const int bh_ = (item_) >> 7, c_ = (item_) & 127; const size_t t0_ = (size_t)(bh_ >> 4) * SEQ + c_ * 64; const int h_ = bh_ & 15; \
        _Pragma("unroll") for (int i = 0; i < 16; ++i) { const size_t o_ = (t0_ + 16 * part + i) * DM + h_ * 128 + k; nfz[i] = FZ[o_]; nq[i] = Q1[o_]; } \
        _Pragma("unroll") for (int r = 0; r < 2; ++r) { const int idx = tid + 512 * r, row = idx >> 4, ch = idx & 15; nit_[r] = *(const u32x4*)(I1 + (t0_ + row) * DM + h_ * 128 + ch * 8); ngt[r] = *(const u32x4*)(G1 + (t0_ + row) * DM + h_ * 128 + ch * 8); } \
        _Pragma("unroll") for (int r = 0; r < 4; ++r) { const int idx = tid + 512 * r, row = idx >> 4, ch = idx & 15; nsp[r] = *(const u32x4*)(SP + (size_t)(item_) * 16384 + row * 128 + ch * 8); } }
#define SC_ITEM(n_) (((((int)blockIdx.x + ((n_) >> 4) * (int)gridDim.x) >> 7) * 16 + ((n_) & 15)) * 128 + (((int)blockIdx.x + ((n_) >> 4) * (int)gridDim.x) & 127))
#define SC_VALID(n_) ((int)blockIdx.x + ((n_) >> 4) * (int)gridDim.x < 2 * 128)
    if (SC_VALID(0)) SC_LOAD(SC_ITEM(0))
    for (int n = 0; SC_VALID(n); ++n) {
        const int item = SC_ITEM(n);
        const int bh = item >> 7, c = item & 127, b = bh >> 4, h = bh & 15;
        const size_t tok0 = (size_t)b * SEQ + c * 64;
        float lf[16], qv[16];
        const float lbk = LB[h * 128 + k];
        unsigned fzq[16];
#pragma unroll
        for (int i = 0; i < 16; ++i) fzq[i] = (unsigned)nfz[i] | ((unsigned)nq[i] << 16);
#pragma unroll
        for (int r = 0; r < 2; ++r) { const int idx = tid + 512 * r, row = idx >> 4, ch = idx & 15; *(LAS u32x4*)(Iimg + off_b(row, ch)) = nit_[r]; }
#pragma unroll
        for (int r = 0; r < 4; ++r) { const int idx = tid + 512 * r, row = idx >> 4, ch = idx & 15; *(LAS u32x4*)(SPimg + off_b(row, ch)) = nsp[r]; }
        const u32x4 gcur0 = ngt[0], gcur1 = ngt[1];
        asm volatile("" ::: "memory");
        if (SC_VALID(n + 1)) SC_LOAD(SC_ITEM(n + 1))
        asm volatile("" ::: "memory");
        float fprod = 1.0f, fprod2 = 1.0f;
#pragma unroll
        for (int i = 0; i < 16; ++i) { lf[i] = lbk + (1.0f - lbk) * sigmoidf_(bflo(fzq[i])); if (i < 8) fprod *= lf[i]; else fprod2 *= lf[i]; const float qr = bfhi(fzq[i]); qv[i] = qr * sigmoidf_(qr); }
        psum[part * 128 + k] = __logf(fprod) + __logf(fprod2);
        __syncthreads();
        const float p0 = psum[k], p1 = psum[128 + k], p2 = psum[256 + k];
        const float rr = p0 + p1;
        const float bb0 = part == 0 ? 0.f : (part == 1 ? p0 : (part == 2 ? p0 + p1 : p0 + p1 + p2));
        float P = __expf(bb0 - rr); const float Er = __expf(rr);
#pragma unroll
        for (int i = 0; i < 16; ++i) {
            P *= lf[i];
            const float qp = qv[i] * P, qt = qp * Er, kp = (1.0f - lf[i]) * __builtin_amdgcn_rcpf(P);
            const unsigned o = off_b(16 * part + i, k >> 3) + 2 * (k & 7);
            *(LAS bf16_t*)(QTimg + o) = (bf16_t)(pk_bf16(qt, 0.f) & 0xffffu);
            *(LAS bf16_t*)(QPimg + o) = (bf16_t)(pk_bf16(qp, 0.f) & 0xffffu);
            *(LAS bf16_t*)(KPimg + o) = (bf16_t)(pk_bf16(kp, 0.f) & 0xffffu);
        }
        __syncthreads();
        const int tt = wv & 1, vt = wv >> 1;
        f32x16 O;
#pragma unroll
        for (int e = 0; e < 16; ++e) O[e] = 0.f;
#pragma unroll
        for (int ks = 0; ks < 8; ++ks) {
            const bf16x8 af = *(const LAS bf16x8*)(SPimg + off_b(32 * vt + r32, 2 * ks + hh));
            const bf16x8 bf = *(const LAS bf16x8*)(QTimg + off_b(32 * tt + r32, 2 * ks + hh));
            O = __builtin_amdgcn_mfma_f32_32x32x16_bf16(af, bf, O, 0, 0, 0);
        }
        const unsigned krow = pi32((unsigned)r32);
        for (int st = 0; st <= tt; ++st) {
            f32x16 S;
#pragma unroll
            for (int e = 0; e < 16; ++e) S[e] = 0.f;
#pragma unroll
            for (int ks = 0; ks < 8; ++ks) {
                const bf16x8 af = *(const LAS bf16x8*)(KPimg + off_b(32 * st + krow, 2 * ks + hh));
                const bf16x8 bf = *(const LAS bf16x8*)(QPimg + off_b(32 * tt + r32, 2 * ks + hh));
                S = __builtin_amdgcn_mfma_f32_32x32x16_bf16(af, bf, S, 0, 0, 0);
            }
            float p[16];
#pragma unroll
            for (int e = 0; e < 16; ++e) {
                const unsigned m = (e & 3) + 8 * (e >> 2) + 4 * hh;
                const int sidx = 32 * st + (int)pi32(m), tidx = 32 * tt + r32;
                p[e] = sidx <= tidx ? S[e] : 0.f;
            }
            u32x4 w0, w1;
            w0.x = pk_bf16(p[0], p[1]); w0.y = pk_bf16(p[2], p[3]); w0.z = pk_bf16(p[4], p[5]); w0.w = pk_bf16(p[6], p[7]);
            w1.x = pk_bf16(p[8], p[9]); w1.y = pk_bf16(p[10], p[11]); w1.z = pk_bf16(p[12], p[13]); w1.w = pk_bf16(p[14], p[15]);
            const bf16x8 pf0 = __builtin_bit_cast(bf16x8, w0), pf1 = __builtin_bit_cast(bf16x8, w1);
            const bf16x8 i0 = tr_frag(Iimg, lane, vt, 2 * st), i1 = tr_frag(Iimg, lane, vt, 2 * st + 1);
            O = __builtin_amdgcn_mfma_f32_32x32x16_bf16(i0, pf0, O, 0, 0, 0);
            O = __builtin_amdgcn_mfma_f32_32x32x16_bf16(i1, pf1, O, 0, 0, 0);
        }
        float sq = 0.f;
#pragma unroll
        for (int e = 0; e < 16; ++e) sq += O[e] * O[e];
        sq += __shfl_xor(sq, 32);
        if (hh == 0) ssq[vt * 64 + 32 * tt + r32] = sq;
        __syncthreads();
        const int tl = 32 * tt + r32;
        const float rstd = rsqrtf((ssq[tl] + ssq[64 + tl] + ssq[128 + tl] + ssq[192 + tl]) * (1.0f / 128.0f) + 1e-6f);
#pragma unroll
        for (int g = 0; g < 4; ++g) {
            const int v0 = 32 * vt + 8 * g + 4 * hh;
            const f32x4 gn = *(const f32x4*)(gnorm + v0);
            u32x2 w; w.x = pk_bf16(O[4 * g] * rstd * gn[0], O[4 * g + 1] * rstd * gn[1]); w.y = pk_bf16(O[4 * g + 2] * rstd * gn[2], O[4 * g + 3] * rstd * gn[3]);
            *(LAS u32x2*)(OT + tl * 272 + v0 * 2) = w;
        }
        __syncthreads();
#pragma unroll
        for (int r = 0; r < 2; ++r) {
            const int idx = tid + 512 * r, row = idx >> 4, ch = idx & 15;
            const u32x4 ov = *(const LAS u32x4*)(OT + row * 272 + ch * 16);
            const size_t go = (tok0 + row) * DM + h * 128 + ch * 8;
            const u32x4 gv = r == 0 ? gcur0 : gcur1;
            u32x4 w;
#define SILU_(x_) ((x_) * sigmoidf_(x_))
            w.x = pk_bf16(bflo(ov.x) * SILU_(bflo(gv.x)), bfhi(ov.x) * SILU_(bfhi(gv.x))); w.y = pk_bf16(bflo(ov.y) * SILU_(bflo(gv.y)), bfhi(ov.y) * SILU_(bfhi(gv.y)));
            w.z = pk_bf16(bflo(ov.z) * SILU_(bflo(gv.z)), bfhi(ov.z) * SILU_(bfhi(gv.z))); w.w = pk_bf16(bflo(ov.w) * SILU_(bflo(gv.w)), bfhi(ov.w) * SILU_(bfhi(gv.w)));
#undef SILU_
            *(u32x4*)(OG + go) = w;
        }
        if (h == 15) {
            asm volatile("s_waitcnt vmcnt(0)" ::: "memory"); __syncthreads();
            __builtin_amdgcn_fence(__ATOMIC_ACQUIRE, "agent"); asm volatile("s_waitcnt vmcnt(0)" ::: "memory");
            quant_rows_bf16(OG + tok0 * DM, OG8 + tok0 * DM, XSO + tok0, 64, true);
        }
        __syncthreads();
    }
#undef SC_ITEM
#undef SC_VALID
}


#if SCAN_DBG == 2
__device__ __forceinline__ void dbg_compare(LAS float* red, const bf16_t* A, const bf16_t* B, float* DBG) {
    float sd = 0.f, sr = 0.f, nn = 0.f;
    const size_t n = (size_t)MTOK * DM;
    for (size_t i = (size_t)blockIdx.x * 512 + threadIdx.x; i < n; i += (size_t)gridDim.x * 512) {
        const float x = bf2f(A[i]), y = bf2f(B[i]);
        if (!(x - x == 0.f)) nn += 1.f; else { sd += (x - y) * (x - y); sr += y * y; }
    }
    sd = wave_sum(sd); sr = wave_sum(sr); nn = wave_sum(nn);
    const int wv = threadIdx.x >> 6;
    if ((threadIdx.x & 63) == 0) { red[wv * 3] = sd; red[wv * 3 + 1] = sr; red[wv * 3 + 2] = nn; }
    __syncthreads();
    if (threadIdx.x == 0) { float a = 0, b = 0, c = 0; for (int w = 0; w < 8; ++w) { a += red[w * 3]; b += red[w * 3 + 1]; c += red[w * 3 + 2]; } DBG[blockIdx.x * 4] = a; DBG[blockIdx.x * 4 + 1] = b; DBG[blockIdx.x * 4 + 2] = c; }
    __syncthreads();
}
__device__ __forceinline__ void dbg_emit(const float* DBG, float* out) {
    float a = 0, b = 0, c = 0;
    for (int w = 0; w < (int)gridDim.x; ++w) { a += DBG[w * 4]; b += DBG[w * 4 + 1]; c += DBG[w * 4 + 2]; }
    const float rel = sqrtf(a / b);
    int k = (int)rintf(-2.0f * log10f(rel)); k = k < 0 ? 0 : (k > 16 ? 16 : k);
    if (c > 0.f) k = 17;
    const float cc = sqrtf(0.5f * (float)k);
    const size_t n = (size_t)MTOK * DM;
    for (size_t i = (size_t)blockIdx.x * 512 + threadIdx.x; i < n; i += (size_t)gridDim.x * 512) out[i] = cc;
}
#endif

#if SCAN_DBG == 3
__device__ __forceinline__ void dbg_count_bf16(const bf16_t* A, size_t n, unsigned* cnt) {
    unsigned c = 0;
    for (size_t i = (size_t)blockIdx.x * 512 + threadIdx.x; i < n; i += (size_t)gridDim.x * 512) { const float x = bf2f(A[i]); if (!(x - x == 0.f)) ++c; }
    if (c) atomicAdd(cnt, c);
}
__device__ __forceinline__ void dbg_count_f32(const float* A, size_t n, unsigned* cnt) {
    unsigned c = 0;
    for (size_t i = (size_t)blockIdx.x * 512 + threadIdx.x; i < n; i += (size_t)gridDim.x * 512) { const float x = A[i]; if (!(x - x == 0.f)) ++c; }
    if (c) atomicAdd(cnt, c);
}
__device__ __forceinline__ void dbg_emit3(const unsigned* cnt, float* out) {
    float code = 0.f;
    for (int st = 3; st >= 0; --st) { const unsigned c = cnt[st]; if (c) { float lg = log10f((float)c); lg = lg > 9.f ? 9.f : lg; code = (float)(st + 1) + 0.1f * lg; } }
    const float cc = sqrtf(code);
    const size_t n = (size_t)MTOK * DM;
    for (size_t i = (size_t)blockIdx.x * 512 + threadIdx.x; i < n; i += (size_t)gridDim.x * 512) out[i] = cc;
}
#endif

#if SCAN_DBG == 4 || SCAN_DBG == 6
__device__ __forceinline__ void dbg_compare4(LAS float* red, const bf16_t* A, const bf16_t* B, const bf16_t* C, float* DBG) {
    float sd = 0.f, sr = 0.f, nn = 0.f, mm = 0.f;
    const size_t n = (size_t)MTOK * DM;
    for (size_t i = (size_t)blockIdx.x * 512 + threadIdx.x; i < n; i += (size_t)gridDim.x * 512) {
        const float x = bf2f(A[i]), y = bf2f(B[i]);
        if (!(x - x == 0.f)) nn += 1.f; else { sd += (x - y) * (x - y); sr += y * y; }
        if (A[i] != C[i]) mm += 1.f;
    }
    sd = wave_sum(sd); sr = wave_sum(sr); nn = wave_sum(nn); mm = wave_sum(mm);
    const int wv = threadIdx.x >> 6;
    if ((threadIdx.x & 63) == 0) { red[wv * 4] = sd; red[wv * 4 + 1] = sr; red[wv * 4 + 2] = nn; red[wv * 4 + 3] = mm; }
    __syncthreads();
    if (threadIdx.x == 0) { float a = 0, b = 0, c = 0, d = 0; for (int w = 0; w < 8; ++w) { a += red[w * 4]; b += red[w * 4 + 1]; c += red[w * 4 + 2]; d += red[w * 4 + 3]; }
        DBG[blockIdx.x * 4] = a; DBG[blockIdx.x * 4 + 1] = b; DBG[blockIdx.x * 4 + 2] = c; DBG[blockIdx.x * 4 + 3] = d; }
    __syncthreads();
}
__device__ __forceinline__ void dbg_emit4(const float* DBG, float* out) {
    float a = 0, b = 0, c = 0, d = 0;
    for (int w = 0; w < (int)gridDim.x; ++w) { a += DBG[w * 4]; b += DBG[w * 4 + 1]; c += DBG[w * 4 + 2]; d += DBG[w * 4 + 3]; }
    const float rel = sqrtf(a / b);
    int k = (int)rintf(-log10f(rel)); k = k < 0 ? 0 : (k > 8 ? 8 : k);
#if SCAN_DBG == 6
    const float cc = sqrtf((float)k + ((d + c) > 0.f ? 0.5f : 0.f));
#else
    int m = (int)ceilf(log10f(1.0f + d + c)); m = m > 9 ? 9 : m;
    const float cc = sqrtf((float)k + 0.1f * (float)m);
#endif
    const size_t n = (size_t)MTOK * DM;
    for (size_t i = (size_t)blockIdx.x * 512 + threadIdx.x; i < n; i += (size_t)gridDim.x * 512) out[i] = cc;
}
#endif

#if SCAN_DBG == 5
__device__ __forceinline__ void dbg_lds16_test(LAS unsigned char* lds, unsigned* cnt) {
    const int tid = threadIdx.x;
    unsigned bad = 0;
    for (int rep = 0; rep < 64; ++rep) {
        for (int i = tid; i < 1024; i += 512) *(LAS u32x4*)(lds + i * 16) = (u32x4){0x7fc07fc0u, 0x7fc07fc0u, 0x7fc07fc0u, 0x7fc07fc0u};
        __syncthreads();
        const int k = tid & 127, part = tid >> 7;
#pragma unroll
        for (int i = 0; i < 16; ++i) {
            const int row = 16 * part + i;
            *(LAS bf16_t*)(lds + off_b(row, k >> 3) + 2 * (k & 7)) = (bf16_t)((row * 128 + k + rep) & 0x7fff);
        }
        __syncthreads();
        for (int idx = tid; idx < 64 * 128; idx += 512) {
            const int row = idx >> 7, kk = idx & 127;
            const bf16_t got = *(const LAS bf16_t*)(lds + off_b(row, kk >> 3) + 2 * (kk & 7));
            if (got != (bf16_t)((row * 128 + kk + rep) & 0x7fff)) ++bad;
        }
        __syncthreads();
    }
    if (bad) atomicAdd(cnt, bad);
}
__device__ __forceinline__ void dbg_emit5(const unsigned* cnt, float* out) {
    const unsigned c = cnt[0];
    float code = 0.f;
    if (c) { float lg = log10f((float)c); code = 1.0f + (lg > 8.9f ? 8.9f : lg); }
    const float cc = sqrtf(code);
    const size_t n = (size_t)MTOK * DM;
    for (size_t i = (size_t)blockIdx.x * 512 + threadIdx.x; i < n; i += (size_t)gridDim.x * 512) out[i] = cc;
}
#endif

#if SCAN_DBG == 6
__device__ __forceinline__ void dbg_check_a(LAS float* red, const float* LF, const bf16_t* I1, const bf16_t* LT, const bf16_t* LT2, float* DBG) {
    float sd = 0.f, sr = 0.f, mm = 0.f;
    const size_t n = (size_t)4096 * 16384;
    for (size_t i = (size_t)blockIdx.x * 512 + threadIdx.x; i < n; i += (size_t)gridDim.x * 512) {
        const int item = (int)(i >> 14), v = (int)((i >> 7) & 127), k = (int)(i & 127);
        const int bh = item >> 7, c = item & 127, b = bh >> 4, h = bh & 15;
        const size_t tok0 = (size_t)b * SEQ + c * 64;
        float g = 1.f, L = 0.f;
        for (int s2 = 63; s2 >= 0; --s2) {
            const size_t o = (tok0 + s2) * DM + h * 128;
            const float f = __expf(LF[o + k]);
            L += bf2f(I1[o + v]) * (1.0f - f) * g;
            g *= f;
        }
        const float x = bf2f(LT[i]);
        sd += (x - L) * (x - L); sr += L * L;
        if (LT[i] != LT2[i]) mm += 1.f;
    }
    sd = wave_sum(sd); sr = wave_sum(sr); mm = wave_sum(mm);
    const int wv = threadIdx.x >> 6;
    if ((threadIdx.x & 63) == 0) { red[wv * 4] = sd; red[wv * 4 + 1] = sr; red[wv * 4 + 2] = 0.f; red[wv * 4 + 3] = mm; }
    __syncthreads();
    if (threadIdx.x == 0) { float a = 0, b2 = 0, d = 0; for (int w = 0; w < 8; ++w) { a += red[w * 4]; b2 += red[w * 4 + 1]; d += red[w * 4 + 3]; }
        DBG[blockIdx.x * 4] = a; DBG[blockIdx.x * 4 + 1] = b2; DBG[blockIdx.x * 4 + 2] = 0.f; DBG[blockIdx.x * 4 + 3] = d; }
    __syncthreads();
}
#endif

#if SCAN_DBG == 7
#ifndef DBG_FAM
#define DBG_FAM 0
#endif
__device__ __forceinline__ void dbg_check_a7(const float* LF, const bf16_t* I1, const bf16_t* LT, float* DBG) {
    const size_t n = (size_t)4096 * 16384;
    float nbad = 0.f, nnf = 0.f;
    for (size_t i = (size_t)blockIdx.x * 512 + threadIdx.x; i < n; i += (size_t)gridDim.x * 512 * 8) {
        const int item = (int)(i >> 14), v = (int)((i >> 7) & 127), k = (int)(i & 127);
        const int bh = item >> 7, c = item & 127, b = bh >> 4, h = bh & 15;
        const size_t tok0 = (size_t)b * SEQ + c * 64;
        float g = 1.f, L = 0.f;
        for (int s2 = 63; s2 >= 0; --s2) {
            const size_t o = (tok0 + s2) * DM + h * 128;
            const float f = __expf(LF[o + k]);
            L += bf2f(I1[o + v]) * (1.0f - f) * g;
            g *= f;
        }
        const float x = bf2f(LT[i]);
        if (!(x - x == 0.f)) { nnf += 1.f; nbad += 1.f; }
        else if (fabsf(x - L) > 0.02f * fabsf(L) + 1e-2f) nbad += 1.f;
    }
    nbad = wave_sum(nbad); nnf = wave_sum(nnf);
    if ((threadIdx.x & 63) == 0) { atomicAdd(DBG, nbad); atomicAdd(DBG + 1, nnf); }
}
__device__ __forceinline__ void dbg_emit7(const float* DBG, float* out) {
    const float nb = DBG[0], nf = DBG[1];
    int A = nb == 0.f ? 0 : (nb <= 100.f ? 1 : (nb <= 1e4f ? 3 : (nb <= 1e6f ? 5 : 7)));
    int B = nf == 0.f ? 0 : 5;
    const float cc = sqrtf((float)A + 0.1f * (float)B);
    const size_t n = (size_t)MTOK * DM;
    for (size_t i = (size_t)blockIdx.x * 512 + threadIdx.x; i < n; i += (size_t)gridDim.x * 512) out[i] = cc;
}
#endif
__device__ __forceinline__ int opaque(int v) { asm volatile("" : "+s"(v)); return v; }
template <bool L1> __device__ __forceinline__ void run_gemm_out(const Args& a, LAS unsigned char* lds) {
    unsigned char* ws = a.ws;
    pg8::Gemm g{(const bf16_t*)(ws + (L1 ? slot(3) : slot(8))), (const bf16_t*)(ws + (L1 ? WS_WO : WS_WOUT)), opaque(MTOK), opaque(DM), opaque(DM / 2)};
    pg8::StaticOrder S; S.init(g.M, g.N, (int)gridDim.x, (int)blockIdx.x);
    EpiKVQ_<true> E{(bf16_t*)(ws + (L1 ? slot(4) : slot(1))), (const float*)(ws + WS_XSO), (const float*)(ws + (L1 ? WS_SWO : WS_SWOUT))};
    pg8::gemm_phase<EpiKVQ_<true>, pg8::StaticOrder>(lds, g, S, E, nullptr);
}
template <bool L1> __device__ __forceinline__ void run_ln(const Args& a) {
    unsigned char* ws = a.ws;
    phase_ln<(L1 ? 2 : 0)>((const bf16_t*)(ws + (L1 ? slot(4) : slot(1))), L1 ? (const void*)(ws + slot(1)) : (const void*)a.in[0], (const float*)(ws + WS_XS1), a.in[12] + (L1 ? 2 : 0) * DM, a.in[13] + (L1 ? 2 : 0) * DM,
                 (float*)nullptr, (bf16_t*)nullptr, (signed char*)(ws + WS_XQ), (float*)(ws + WS_XS));
}
template <bool L1> __device__ __forceinline__ void run_gemm_sc(const Args& a, LAS unsigned char* lds) {
    unsigned char* ws = a.ws;
#if SC8
    pg8::Gemm g{(const bf16_t*)(ws + WS_WC8 + (L1 ? (size_t)DM * DM : 0)), (const bf16_t*)(ws + WS_XQ), opaque(DM), opaque(MTOK), opaque(DM / 2)};
    pg8::StaticOrder S; S.init(g.M, g.N, (int)gridDim.x, (int)blockIdx.x);
    EpiSCT E{(bf16_t*)(ws + (L1 ? slot(0) : slot(6))), MTOK, (const float*)(ws + WS_SWC) + (L1 ? DM : 0), (const float*)(ws + WS_XS)};
    pg8::gemm_phase<EpiSCT, pg8::StaticOrder>(lds, g, S, E, nullptr);
#else
    pg8::Gemm g{(const bf16_t*)(ws + WS_WC) + (L1 ? (size_t)DM * DM : 0), (const bf16_t*)(ws + (L1 ? slot(8) : slot(5))), opaque(DM), opaque(MTOK), opaque(DM)};
    pg8::StaticOrder S; S.init(g.M, g.N, (int)gridDim.x, (int)blockIdx.x);
    EpiF32 E{(float*)(ws + (L1 ? slot(0) : slot(6))), MTOK, nullptr, nullptr};
    pg8::gemm_phase<EpiF32, pg8::StaticOrder>(lds, g, S, E, nullptr);
#endif
}
template <bool L1> __device__ __forceinline__ void run_topk(const Args& a, LAS unsigned char* lds) {
    unsigned char* ws = a.ws;
    phase_topk(lds, (const bf16_t*)(ws + (L1 ? slot(0) : slot(6))), (int*)(ws + WS_EID), (float*)(ws + WS_GATE), (unsigned short*)(ws + WS_EID16));
}
template <bool L1> __device__ __forceinline__ void run_peer(const Args& a, LAS unsigned char* lds) {
    unsigned char* ws = a.ws;
    LAS int* HL = (LAS int*)(lds + (threadIdx.x >> 6) * 8192);
    bf16_t* Y = (bf16_t*)(ws + (L1 ? slot(0) : slot(6)));
    phase_peer_u((const signed char*)(ws + WS_XQ), (const unsigned short*)(ws + WS_EID16), ws + WS_UB + (L1 ? (size_t)16384 * DM : 0), HL);
    asm volatile("s_waitcnt vmcnt(0) lgkmcnt(0)" ::: "memory");
    phase_peer_w(HL, (const float*)(ws + WS_XS), (const int*)(ws + WS_EID), (const float*)(ws + WS_GATE),
                 (const float*)(ws + WS_USC) + (L1 ? 16384 : 0), (const float*)(ws + WS_VSC) + (L1 ? 16384 : 0), (signed char*)(ws + WS_W), (float*)(ws + WS_CS));
    asm volatile("s_waitcnt vmcnt(0)" ::: "memory");
    phase_peer_v((const signed char*)(ws + WS_XQ), (const float*)(ws + WS_XS), (const unsigned short*)(ws + WS_EID16), (const signed char*)(ws + WS_W), (const float*)(ws + WS_CS),
                 ws + WS_VB + (L1 ? (size_t)16384 * DM : 0), Y);
    asm volatile("s_waitcnt vmcnt(0)" ::: "memory");
    {
        const int lane = threadIdx.x & 63, gw = blockIdx.x * 8 + (threadIdx.x >> 6), nw = gridDim.x * 8, tpw = (MTOK + nw - 1) / nw, tbase = gw * tpw;
        const int tend = tbase + tpw < MTOK ? tbase + tpw : MTOK;
        const float* g = a.in[12] + (L1 ? 3 : 1) * DM; const float* bta = a.in[13] + (L1 ? 3 : 1) * DM;
        float* outf = L1 ? a.out : (float*)nullptr; bf16_t* outb = (bf16_t*)nullptr;
        for (int row = tbase; row < tend; ++row) {
            float v[32];
            const bf16_t* p = Y + (size_t)row * DM;
#pragma unroll
            for (int i = 0; i < 4; ++i) {
                const u32x4 w = *(const u32x4*)(p + 512 * i + 8 * lane);
                v[i * 8 + 0] = bflo(w.x); v[i * 8 + 1] = bfhi(w.x); v[i * 8 + 2] = bflo(w.y); v[i * 8 + 3] = bfhi(w.y); v[i * 8 + 4] = bflo(w.z); v[i * 8 + 5] = bfhi(w.z); v[i * 8 + 6] = bflo(w.w); v[i * 8 + 7] = bfhi(w.w);
            }
            ln_row_store(v, g, bta, outf ? outf + (size_t)row * DM : nullptr, outb ? outb + (size_t)row * DM : nullptr, lane,
                         L1 ? (signed char*)nullptr : (signed char*)(ws + slot(1)) + (size_t)row * DM, L1 ? (float*)nullptr : (float*)(ws + WS_XS1) + row);
        }
    }
}


#define XB_TMO      128
#define XB_XCNT(j)  (256  + 64 * (j))
#define XB_XSUB(j)  (1280 + 64 * (j))
#define XB_XGEN(j)  (2304 + 64 * (j))
#define XB_TOP      3328
#define XB_TOPGEN   3392
#define XCD_BAR_WORDS 3456
#define XB_SPIN_CAP (1u << 20)
__device__ __forceinline__ unsigned xb_ld(unsigned* p)              { return __hip_atomic_load(p, __ATOMIC_RELAXED, __HIP_MEMORY_SCOPE_AGENT); }
__device__ __forceinline__ unsigned xb_add(unsigned* p, unsigned v) { return __hip_atomic_fetch_add(p, v, __ATOMIC_RELAXED, __HIP_MEMORY_SCOPE_AGENT); }
__device__ __forceinline__ unsigned xb_xcc_id() { return (unsigned)__builtin_amdgcn_s_getreg((3 << 11) | 20) & 0xFu; }
#define XB_SPIN(cond, bar) do { unsigned _sp = 0; while (cond) { __builtin_amdgcn_s_sleep(1); \
    if ((++_sp & 255u) == 0u) { if (xb_ld(&(bar)[XB_TMO])) break; if (_sp > XB_SPIN_CAP) { atomicAdd(&(bar)[XB_TMO], 1u); break; } } } } while (0)
struct XcdBarrier { unsigned* bar; unsigned x; volatile LAS unsigned* st; };
__device__ __forceinline__ XcdBarrier xcd_barrier_post(unsigned* bar, volatile LAS unsigned* st) {
    XcdBarrier b; b.bar = bar; b.x = xb_xcc_id(); b.st = st;
    if (threadIdx.x == 0) (void)xb_add(&bar[XB_XCNT(b.x)], 1u);
    return b;
}
__device__ __forceinline__ void xcd_barrier_complete(unsigned* bar, unsigned x, unsigned& nloc, unsigned& nx) {
    const unsigned G = gridDim.x * gridDim.y * gridDim.z;
    unsigned sum, cnt, mine, sp = 0u;
    for (;;) {
        sum = 0u; cnt = 0u; mine = 0u;
#pragma unroll
        for (unsigned j = 0; j < 16; ++j) { const unsigned c = xb_ld(&bar[XB_XCNT(j)]); sum += c; cnt += (c > 0u) ? 1u : 0u; mine = (j == x) ? c : mine; }
        if (sum == G) break;
        __builtin_amdgcn_s_sleep(1);
        if ((++sp & 255u) == 0u) { if (xb_ld(&bar[XB_TMO])) break; if (sp > XB_SPIN_CAP) { atomicAdd(&bar[XB_TMO], 1u); break; } }
    }
    nloc = mine > 0u ? mine : 1u; nx = cnt > 0u ? cnt : 1u;
}
__device__ __forceinline__ void xcd_barrier(const XcdBarrier& b) {
    asm volatile("s_waitcnt vmcnt(0)" ::: "memory");
    __syncthreads();
    if (threadIdx.x == 0) {
        unsigned* bar = b.bar;
        __builtin_amdgcn_s_waitcnt(0);
        unsigned nloc = b.st[0], nx = b.st[1];
        if (nloc == 0u) { xcd_barrier_complete(bar, b.x, nloc, nx); b.st[0] = nloc; b.st[1] = nx; }
        const unsigned old = xb_add(&bar[XB_XSUB(b.x)], 1u);
        const unsigned gen = old / nloc;
        if (old + 1u == (gen + 1u) * nloc) {
            __builtin_amdgcn_fence(__ATOMIC_RELEASE, "agent");
            asm volatile("s_waitcnt vmcnt(0)" ::: "memory");
            const unsigned og = xb_add(&bar[XB_TOP], 1u);
            __builtin_amdgcn_fence(__ATOMIC_ACQUIRE, "agent");
            const unsigned tg = og / nx;
            if (og + 1u == (tg + 1u) * nx) xb_add(&bar[XB_TOPGEN], 1u);
            else XB_SPIN(xb_ld(&bar[XB_TOPGEN]) == tg, bar);
            xb_add(&bar[XB_XGEN(b.x)], 1u);
            asm volatile("s_waitcnt vmcnt(0)" ::: "memory");
        } else {
            __builtin_amdgcn_fence(__ATOMIC_ACQUIRE, "agent");
            XB_SPIN(xb_ld(&bar[XB_XGEN(b.x)]) == gen, bar);
            asm volatile("s_waitcnt vmcnt(0)" ::: "memory");
        }
    }
    __syncthreads();
}

__global__ void __launch_bounds__(512, 2) mk_fwd(Args a) {
    extern __shared__ __attribute__((aligned(16))) unsigned char lds_raw[];
    LAS unsigned char* lds = (LAS unsigned char*)lds_raw;
    cg::grid_group grid = cg::this_grid();
    unsigned char* ws = a.ws;
#define PHASE_BEGIN(k) if (a.ph_lo <= (k) && (k) < a.ph_hi && EN(k)) {
    volatile LAS unsigned* xb_st = (volatile LAS unsigned*)(lds + LDS_BYTES - 16);
    if (threadIdx.x < 4) xb_st[threadIdx.x] = 0u;
    unsigned* xb_words = (unsigned*)(ws + WS_BAR);
    __syncthreads();
    XcdBarrier xbar = xcd_barrier_post(xb_words, xb_st);
    if (a.ph_lo < 0) grid.sync();
#define PHASE_END(k) if ((k) + 1 < a.ph_hi) xcd_barrier(xbar); }
    PHASE_BEGIN(0) phase_prep(a, lds);
#if SCAN_DBG == 3 || SCAN_DBG == 5
        if (blockIdx.x == 0 && threadIdx.x < 8) ((unsigned*)(ws + WS_CTR + 8192))[threadIdx.x] = 0u;
#endif
#if SCAN_DBG == 7
        if (blockIdx.x == 0 && threadIdx.x < 32) ((float*)(ws + WS_CTR + 4096))[threadIdx.x] = 0.f;
#endif
    PHASE_END(0)
#if SCAN_DBG == 5
    PHASE_BEGIN(1) dbg_lds16_test(lds, (unsigned*)(ws + WS_CTR + 8192)); PHASE_END(1)
#define SKIP_REST 1
#endif
    PHASE_BEGIN(1) {
        pg8::Gemm g{(const bf16_t*)(ws + slot(0)), (const bf16_t*)(ws + WS_WIN), opaque(MTOK), opaque(4 * DM), opaque(DM / 2)};
        pg8::StaticOrder S; S.init(g.M, g.N, (int)gridDim.x, (int)blockIdx.x);
        EpiKVQ_<true> E{(bf16_t*)(ws + slot(1)), (const float*)(ws + WS_XS0), (const float*)(ws + WS_SWIN)};
        pg8::gemm_phase<EpiKVQ_<true>, pg8::StaticOrder>(lds, g, S, E, nullptr);
    } PHASE_END(1)
    PHASE_BEGIN(2) quant_rows_bf16((const bf16_t*)(ws + WS_WC), (signed char*)(ws + WS_WC8), (float*)(ws + WS_SWC), 2 * DM);
        phase_scan_a(lds, (const bf16_t*)(ws + slot(2)), (const float*)(ws + WS_LB), (const bf16_t*)(ws + slot(3)), (bf16_t*)(ws + slot(6)), (float*)(ws + WS_DEC), QuantJob{a.in[10], a.in[11], ws + WS_UB, ws + WS_VB, (float*)(ws + WS_USC), (float*)(ws + WS_VSC)}
#if SCAN_DBG == 3
        , (unsigned*)(ws + WS_CTR + 8192)
#endif
        );
#if SCAN_DBG == 7
        asm volatile("s_waitcnt vmcnt(0)" ::: "memory"); __syncthreads(); grid.sync(); if (threadIdx.x < 64) { __builtin_amdgcn_fence(__ATOMIC_ACQUIRE, "agent"); asm volatile("s_waitcnt vmcnt(0)" ::: "memory"); } __syncthreads();
        dbg_check_a7((const float*)(ws + slot(4)), (const bf16_t*)(ws + slot(2)), (const bf16_t*)(ws + slot(6)), (float*)(ws + WS_CTR + 4096));
#endif
#if SCAN_DBG == 6
#define DSYNC6() asm volatile("s_waitcnt vmcnt(0)" ::: "memory"); __syncthreads(); grid.sync(); if (threadIdx.x < 64) { __builtin_amdgcn_fence(__ATOMIC_ACQUIRE, "agent"); asm volatile("s_waitcnt vmcnt(0)" ::: "memory"); } __syncthreads();
        DSYNC6()
        phase_scan_a(lds, (const bf16_t*)(ws + slot(2)), (const float*)(ws + WS_LB), (const bf16_t*)(ws + slot(3)), (bf16_t*)a.out, (float*)(ws + WS_DEC), QuantJob{a.in[10], a.in[11], ws + WS_UB, ws + WS_VB, (float*)(ws + WS_USC), (float*)(ws + WS_VSC)});
        DSYNC6()
        dbg_check_a((LAS float*)lds, (const float*)(ws + slot(4)), (const bf16_t*)(ws + slot(2)), (const bf16_t*)(ws + slot(6)), (const bf16_t*)a.out, (float*)(ws + WS_CTR + 4096));
#endif
#if SCAN_DBG == 3
        asm volatile("s_waitcnt vmcnt(0)" ::: "memory"); __syncthreads(); grid.sync();
        dbg_count_bf16((const bf16_t*)(ws + slot(6)), (size_t)4096 * 16384, (unsigned*)(ws + WS_CTR + 8192) + 2);
#endif
    PHASE_END(2)
    PHASE_BEGIN(3) phase_scan_b((bf16_t*)(ws + slot(6)), (const float*)(ws + WS_DEC), QuantJob{a.in[10] + (size_t)16384 * DM, a.in[11] + (size_t)16384 * DM, ws + WS_UB + (size_t)16384 * DM, ws + WS_VB + (size_t)16384 * DM, (float*)(ws + WS_USC) + 16384, (float*)(ws + WS_VSC) + 16384});
#if SCAN_DBG == 3
        asm volatile("s_waitcnt vmcnt(0)" ::: "memory"); __syncthreads(); grid.sync();

#endif
    PHASE_END(3)
    PHASE_BEGIN(4) phase_scan_c(lds, (const bf16_t*)(ws + slot(1)), (const bf16_t*)(ws + slot(2)), (const float*)(ws + WS_LB), (const bf16_t*)(ws + slot(3)), (const bf16_t*)(ws + slot(4)), (const bf16_t*)(ws + slot(6)), a.in[2], (bf16_t*)(ws + slot(0)), (signed char*)(ws + slot(8)), (float*)(ws + WS_XSO));
#if SCAN_DBG == 1
        asm volatile("s_waitcnt vmcnt(0)" ::: "memory"); __syncthreads(); grid.sync();
        phase_scan_naive((const bf16_t*)(ws + slot(1)), (const float*)(ws + slot(4)), (const bf16_t*)(ws + slot(2)), (float*)(ws + slot(6)));
        asm volatile("s_waitcnt vmcnt(0)" ::: "memory"); __syncthreads(); grid.sync();
        phase_onorm((const float*)(ws + slot(6)), (const bf16_t*)(ws + slot(3)), a.in[2], (bf16_t*)(ws + slot(0)));
#endif
#if SCAN_DBG == 3
        asm volatile("s_waitcnt vmcnt(0)" ::: "memory"); __syncthreads(); grid.sync();

#endif
#if SCAN_DBG == 4
#define DSYNC() asm volatile("s_waitcnt vmcnt(0)" ::: "memory"); __syncthreads(); grid.sync(); if (threadIdx.x < 64) { __builtin_amdgcn_fence(__ATOMIC_ACQUIRE, "agent"); asm volatile("s_waitcnt vmcnt(0)" ::: "memory"); } __syncthreads();
        DSYNC()
        phase_scan_naive((const bf16_t*)(ws + slot(1)), (const float*)(ws + slot(4)), (const bf16_t*)(ws + slot(2)), (float*)(ws + slot(6)));
        DSYNC()
        phase_onorm((const float*)(ws + slot(6)), (const bf16_t*)(ws + slot(3)), a.in[2], (bf16_t*)(ws + slot(8)));
        DSYNC()
        phase_scan_a(lds, (const bf16_t*)(ws + slot(2)), (const float*)(ws + WS_LB), (const bf16_t*)(ws + slot(3)), (bf16_t*)(ws + slot(6)), (float*)(ws + WS_DEC), QuantJob{a.in[10], a.in[11], ws + WS_UB, ws + WS_VB, (float*)(ws + WS_USC), (float*)(ws + WS_VSC)});
        DSYNC()
        phase_scan_b((bf16_t*)(ws + slot(6)), (const float*)(ws + WS_DEC), QuantJob{a.in[10] + (size_t)16384 * DM, a.in[11] + (size_t)16384 * DM, ws + WS_UB + (size_t)16384 * DM, ws + WS_VB + (size_t)16384 * DM, (float*)(ws + WS_USC) + 16384, (float*)(ws + WS_VSC) + 16384});
        DSYNC()
        phase_scan_c(lds, (const bf16_t*)(ws + slot(1)), (const bf16_t*)(ws + slot(2)), (const float*)(ws + WS_LB), (const bf16_t*)(ws + slot(3)), (const bf16_t*)(ws + slot(4)), (const bf16_t*)(ws + slot(6)), a.in[2], (bf16_t*)a.out);
        DSYNC()
        dbg_compare4((LAS float*)lds, (const bf16_t*)(ws + slot(0)), (const bf16_t*)(ws + slot(8)), (const bf16_t*)a.out, (float*)(ws + WS_CTR + 4096));
#endif
#if SCAN_DBG == 2
        asm volatile("s_waitcnt vmcnt(0)" ::: "memory"); __syncthreads(); grid.sync();
        phase_scan_naive((const bf16_t*)(ws + slot(1)), (const float*)(ws + slot(4)), (const bf16_t*)(ws + slot(2)), (float*)(ws + slot(6)));
        asm volatile("s_waitcnt vmcnt(0)" ::: "memory"); __syncthreads(); grid.sync();
        phase_onorm((const float*)(ws + slot(6)), (const bf16_t*)(ws + slot(3)), a.in[2], (bf16_t*)(ws + slot(8)));
        asm volatile("s_waitcnt vmcnt(0)" ::: "memory"); __syncthreads(); grid.sync();
        dbg_compare((LAS float*)lds, (const bf16_t*)(ws + slot(0)), (const bf16_t*)(ws + slot(8)), (float*)(ws + WS_CTR + 4096));
#endif
    PHASE_END(4)
    PHASE_BEGIN(5)
        run_gemm_out<false>(a, lds); PHASE_END(5)
    PHASE_BEGIN(6) run_ln<false>(a); PHASE_END(6)
    PHASE_BEGIN(7) run_gemm_sc<false>(a, lds); PHASE_END(7)
    PHASE_BEGIN(8) run_topk<false>(a, lds); PHASE_END(8)
    PHASE_BEGIN(9) run_peer<false>(a, lds); PHASE_END(9)
    PHASE_BEGIN(10) {
        pg8::Gemm g{(const bf16_t*)(ws + slot(1)), (const bf16_t*)(ws + WS_WKVQ), opaque(MTOK), opaque(3 * DM), opaque(DM / 2)};
        pg8::StaticOrder S; S.init(g.M, g.N, (int)gridDim.x, (int)blockIdx.x);
        EpiKVQR_<true> E{(bf16_t*)(ws + slot(3)), (const float*)(ws + WS_COS), (const float*)(ws + WS_SIN), (const float*)(ws + WS_XS1), (const float*)(ws + WS_SWKVQ)};
        pg8::gemm_phase<EpiKVQR_<true>, pg8::StaticOrder>(lds, g, S, E, nullptr);
    } PHASE_END(10)
    PHASE_BEGIN(11) phase_kstat((LAS float*)lds, (const bf16_t*)(ws + slot(3)), (float*)(ws + WS_KMEAN), (float*)(ws + WS_KNMAX)); PHASE_END(11)
    PHASE_BEGIN(12) phase_sel(lds, (const bf16_t*)(ws + slot(5)), (const float*)(ws + WS_KMEAN), (unsigned short*)(ws + WS_SUB), (int*)(ws + WS_CNT), (int*)(ws + WS_CTR)); PHASE_END(12)
    PHASE_BEGIN(13) phase_att(lds, (const bf16_t*)(ws + slot(5)), (const bf16_t*)(ws + slot(3)), (const bf16_t*)(ws + slot(4)), (const float*)(ws + WS_KNMAX), (const unsigned short*)(ws + WS_SUB),
                              (const int*)(ws + WS_CNT), (int*)(ws + WS_CTR), (bf16_t*)(ws + slot(6)), (bf16_t*)(ws + slot(0)), (float*)(ws + WS_LS)); PHASE_END(13)
    PHASE_BEGIN(14) phase_comb((LAS float*)lds, (const bf16_t*)(ws + slot(6)), (const bf16_t*)(ws + slot(0)), (const float*)(ws + WS_LS), (signed char*)(ws + slot(3)), (float*)(ws + WS_XSO)); PHASE_END(14)
    PHASE_BEGIN(15) run_gemm_out<true>(a, lds); PHASE_END(15)
    PHASE_BEGIN(16) run_ln<true>(a); PHASE_END(16)
    PHASE_BEGIN(17) run_gemm_sc<true>(a, lds); PHASE_END(17)
    PHASE_BEGIN(18) run_topk<true>(a, lds); PHASE_END(18)
#if SCAN_DBG == 7
    PHASE_BEGIN(19) dbg_emit7((const float*)(ws + WS_CTR + 4096), a.out); PHASE_END(19)
#elif SCAN_DBG == 6
    PHASE_BEGIN(19) dbg_emit4((const float*)(ws + WS_CTR + 4096), a.out); PHASE_END(19)
#elif SCAN_DBG == 5
    PHASE_BEGIN(19) dbg_emit5((const unsigned*)(ws + WS_CTR + 8192), a.out); PHASE_END(19)
#elif SCAN_DBG == 4
    PHASE_BEGIN(19) dbg_emit4((const float*)(ws + WS_CTR + 4096), a.out); PHASE_END(19)
#elif SCAN_DBG == 3
    PHASE_BEGIN(19) dbg_emit3((const unsigned*)(ws + WS_CTR + 8192), a.out); PHASE_END(19)
#elif SCAN_DBG == 2
    PHASE_BEGIN(19) dbg_emit((const float*)(ws + WS_CTR + 4096), a.out); PHASE_END(19)
#else
    PHASE_BEGIN(19) run_peer<true>(a, lds); PHASE_END(19)
#endif
}

extern "C" void kernel_launch(void* const* d_in, const int* in_sizes, int n_in, void* d_out, int out_size, void* d_ws, size_t ws_size, hipStream_t stream) {
    static int grid = 0;
    if (grid == 0) {
        if (n_in != 14 || out_size != MTOK * DM || ws_size < WS_END) { fprintf(stderr, "kernel_launch: unexpected shapes (n_in %d, out %d, ws %zu)\n", n_in, out_size, ws_size); grid = -1; return; }
        int dev = 0, cus = 0, per_cu = 0;
        if (hipGetDevice(&dev) != hipSuccess || hipDeviceGetAttribute(&cus, hipDeviceAttributeMultiprocessorCount, dev) != hipSuccess) { grid = -1; return; }
        if (hipFuncSetAttribute((const void*)mk_fwd, hipFuncAttributeMaxDynamicSharedMemorySize, LDS_BYTES) != hipSuccess) { fprintf(stderr, "kernel_launch: hipFuncSetAttribute failed\n"); grid = -1; return; }
        if (hipOccupancyMaxActiveBlocksPerMultiprocessor(&per_cu, (const void*)mk_fwd, 512, LDS_BYTES) != hipSuccess || per_cu < 1) { fprintf(stderr, "kernel_launch: occupancy query failed (%d)\n", per_cu); (void)hipGetLastError(); per_cu = 1; }
        grid = cus * (per_cu > 1 ? 1 : per_cu);
    }
    if (grid < 0) return;
    Args a{};
    for (int i = 0; i < 14; ++i) a.in[i] = (const float*)d_in[i];
    a.out = (float*)d_out; a.ws = (unsigned char*)d_ws;
#if ONE_LAUNCH
    a.ph_lo = 0; a.ph_hi = NPH;
    (void)hipMemsetAsync((unsigned char*)d_ws + WS_BAR, 0, XCD_BAR_WORDS * sizeof(unsigned), stream);
    void* args[] = {&a};
    hipError_t e = hipLaunchCooperativeKernel((const void*)mk_fwd, dim3(grid), dim3(512), args, LDS_BYTES, stream);
    if (e != hipSuccess) fprintf(stderr, "cooperative launch failed: %s (grid %d)\n", hipGetErrorString(e), grid);
#else
    for (int ph = 0; ph < NPH; ++ph) {
        a.ph_lo = ph; a.ph_hi = ph + 1;
        hipLaunchKernelGGL(mk_fwd, dim3(grid), dim3(512), LDS_BYTES, stream, a);
    }
#endif
}
```
